# Optimizing an MI355X kernel written in HIP

```python
import jax, jax.numpy as jnp
from jax import lax
import numpy as np

D_MODEL = 1024
BATCH = 4
SEQ = 4096
DEPTH = 2
DEC_BATCH = 32
DEC_SEQ = 8
PAST_LEN = 8192
PAGE_SIZE = 128

NSA_HEADS = 8
NSA_KV_HEADS = 2
NSA_HPG = NSA_HEADS // NSA_KV_HEADS
NSA_HD = 64
NSA_N_KV = 4
CMP_STRIDE = 16
CMP_BLOCK = 2 * CMP_STRIDE
CMP_HIDDEN = 128
SEL_BLOCK = 64
SEL_TOPK = 16
SEL_FORCE = 1e4
WINDOW = 512
NSA_QBLOCK = 128

RET_HEADS = 4
RET_DK = 128
RET_DV = 128
RET_CHUNK = 128
ROPE_BASE = 10000.0

RNN_WIDTH = 512
RNN_BLOCKS = 8
RNN_BW = RNN_WIDTH // RNN_BLOCKS
RG_CONV = 4
RG_C = 8.0

D_FF = ((8 * D_MODEL // 3 + 127) // 128) * 128
FFN_CONV = 3

N_BRANCH = 3
EPS = 1e-6
IN_WIDTHS = (NSA_HEADS * NSA_HD, 6 * NSA_KV_HEADS * NSA_HD, 3 * NSA_HEADS,
             RET_HEADS * RET_DK, RET_HEADS * RET_DK, RET_HEADS * RET_DV, RET_HEADS * RET_DV,
             RNN_WIDTH, RNN_WIDTH, N_BRANCH * D_MODEL)
D_IN = sum(IN_WIDTHS)

kernel_name = 'hybrid_nsa_retention_rglru_decode_step'


def rmsnorm(x, g):
    xf = x.astype(jnp.float32)
    y = xf * lax.rsqrt(jnp.mean(xf * xf, axis=-1, keepdims=True) + EPS)
    return (y * g.astype(jnp.float32)).astype(x.dtype)


def masked_softmax(s, mask):
    s = jnp.where(mask, s, -jnp.inf)
    m = jnp.max(s, axis=-1, keepdims=True)
    e = jnp.where(mask, jnp.exp(s - jnp.where(jnp.isfinite(m), m, 0.0)), 0.0)
    den = jnp.sum(e, axis=-1, keepdims=True)
    return e / jnp.where(den > 0, den, 1.0)


def split_cols(u, widths):
    cuts = []
    acc = 0
    for w in widths[:-1]:
        acc += w
        cuts.append(acc)
    return jnp.split(u, cuts, axis=-1)


def causal_dwconv(x, buf, w, b):
    width = w.shape[0]
    T = x.shape[1]
    xp = jnp.concatenate([buf.astype(x.dtype), x], axis=1)
    y = b + xp[:, 0:T] * w[0]
    for k in range(1, width):
        y = y + xp[:, k:k + T] * w[k]
    return y.astype(x.dtype), xp[:, xp.shape[1] - (width - 1):]


def rotary(x, pos):
    half = x.shape[-1] // 2
    freq = ROPE_BASE ** (-jnp.arange(half, dtype=jnp.float32) / half)
    ang = pos.astype(jnp.float32)[:, None] * freq[None, :]
    cos = jnp.cos(ang)[None, :, None, :]
    sin = jnp.sin(ang)[None, :, None, :]
    xf = x.astype(jnp.float32)
    x1, x2 = xf[..., :half], xf[..., half:]
    return jnp.concatenate([x1 * cos - x2 * sin, x1 * sin + x2 * cos], axis=-1)


def nsa_compress(rows, pe, w1, b1, w2):
    B, T, K, D = rows.shape
    nch = T // CMP_STRIDE
    ch = rows[:, :nch * CMP_STRIDE].reshape(B, nch, CMP_STRIDE, K, D)
    lo = jnp.einsum('bnpkd,pdh->bnkh', ch + pe[:CMP_STRIDE][:, None, :], w1[:CMP_STRIDE])
    hi = jnp.einsum('bnpkd,pdh->bnkh', ch + pe[CMP_STRIDE:][:, None, :], w1[CMP_STRIDE:])
    hid = jax.nn.gelu(lo[:, :-1] + hi[:, 1:] + b1)
    return jnp.einsum('bnkh,hd->bnkd', hid, w2)


def nsa_branches(q, q_pos, kc, vc, ks_blk, vs_blk, sel_map, kw, vw, kw_pos):
    B, Q, K, R, D = q.shape
    N = kc.shape[1]
    NS = ks_blk.shape[2]
    scale = D ** -0.5
    qf = q.astype(jnp.float32)
    c_end = jnp.arange(N) * CMP_STRIDE + (CMP_BLOCK - 1)
    s_c = jnp.einsum('bqkrd,bnkd->bqkrn', qf, kc.astype(jnp.float32)) * scale
    p_c = masked_softmax(s_c, (c_end[None, :] <= q_pos[:, None])[None, :, None, None, :])
    o_c = jnp.einsum('bqkrn,bnkd->bqkrd', p_c, vc.astype(jnp.float32))
    imp = jnp.einsum('bqkn,ns->bqks', jnp.sum(p_c, axis=3), sel_map)
    j = jnp.arange(NS)[None, :]
    cur = (q_pos // SEL_BLOCK)[:, None]
    forced = (j == 0) | (j == cur) | (j == cur - 1)
    avail = j * SEL_BLOCK <= q_pos[:, None]
    imp = jnp.where(forced[None, :, None, :], SEL_FORCE, imp)
    imp = jnp.where(avail[None, :, None, :], imp, -SEL_FORCE)
    _, idx = lax.top_k(imp, min(SEL_TOPK, NS))
    bi = jnp.arange(B)[:, None, None, None]
    gi = jnp.arange(K)[None, None, :, None]
    k_g = ks_blk[bi, gi, idx].reshape(B, Q, K, -1, D)
    v_g = vs_blk[bi, gi, idx].reshape(B, Q, K, -1, D)
    tok = (idx[..., None] * SEL_BLOCK + jnp.arange(SEL_BLOCK)).reshape(B, Q, K, 1, -1)
    s_s = jnp.einsum('bqkrd,bqkjd->bqkrj', qf, k_g.astype(jnp.float32)) * scale
    p_s = masked_softmax(s_s, tok <= q_pos[None, :, None, None, None])
    o_s = jnp.einsum('bqkrj,bqkjd->bqkrd', p_s, v_g.astype(jnp.float32))
    s_w = jnp.einsum('bqkrd,bskd->bqkrs', qf, kw.astype(jnp.float32)) * scale
    dpos = q_pos[:, None] - kw_pos[None, :]
    wmask = (dpos >= 0) & (dpos <= WINDOW) & (kw_pos[None, :] >= 0)
    p_w = masked_softmax(s_w, wmask[None, :, None, None, :])
    o_w = jnp.einsum('bqkrs,bskd->bqkrd', p_w, vw.astype(jnp.float32))
    return o_c, o_s, o_w


def nsa_mixer(q, kv, gates, q_pos, past_rows, win_buf, pe, w1, b1, w2):
    B, Q = q.shape[0], q.shape[1]
    K, R, D = NSA_KV_HEADS, NSA_HPG, NSA_HD
    kv6 = kv.reshape(B, Q, 6, K, D)
    new_rows = kv6[:, :, :NSA_N_KV]
    win_rows = kv6[:, :, NSA_N_KV:]
    rows = new_rows if past_rows is None else jnp.concatenate([past_rows.astype(kv.dtype), new_rows], axis=1)
    T_all = rows.shape[1]
    kc = nsa_compress(rows[:, :, 0], pe[0], w1[0], b1[0], w2[0])
    vc = nsa_compress(rows[:, :, 1], pe[1], w1[1], b1[1], w2[1])
    N = kc.shape[1]
    NS = -(-T_all // SEL_BLOCK)
    sel = jnp.pad(rows[:, :, 2:], ((0, 0), (0, NS * SEL_BLOCK - T_all), (0, 0), (0, 0), (0, 0)))
    sel = sel.reshape(B, NS, SEL_BLOCK, 2, K, D).transpose(3, 0, 4, 1, 2, 5)
    ks_blk, vs_blk = sel[0], sel[1]
    ci = jnp.arange(N)[:, None] * CMP_STRIDE
    sj = jnp.arange(NS)[None, :] * SEL_BLOCK
    sel_map = ((ci < sj + SEL_BLOCK) & (ci + CMP_BLOCK > sj)).astype(jnp.float32)
    qh = q.reshape(B, Q, K, R, D)
    if past_rows is None:
        win_pad = jnp.pad(win_rows, ((0, 0), (WINDOW, 0), (0, 0), (0, 0), (0, 0)))
        nblk = Q // NSA_QBLOCK

        def body(args):
            qb, pb, b0 = args
            slab = lax.dynamic_slice_in_dim(win_pad, b0 * NSA_QBLOCK, WINDOW + NSA_QBLOCK, axis=1)
            kpos = b0 * NSA_QBLOCK - WINDOW + jnp.arange(WINDOW + NSA_QBLOCK)
            return nsa_branches(qb, pb, kc, vc, ks_blk, vs_blk, sel_map, slab[:, :, 0], slab[:, :, 1], kpos)

        outs = lax.map(body, (jnp.moveaxis(qh.reshape(B, nblk, NSA_QBLOCK, K, R, D), 1, 0),
                              q_pos.reshape(nblk, NSA_QBLOCK), jnp.arange(nblk)))
        o_c, o_s, o_w = [jnp.moveaxis(o, 0, 1).reshape(B, Q, K, R, D) for o in outs]
        new_win = win_rows[:, Q - min(WINDOW, Q):]
    else:
        P = past_rows.shape[1]
        Wb = win_buf.shape[1]
        keys = jnp.concatenate([win_buf.astype(kv.dtype), win_rows], axis=1)
        kpos = P - Wb + jnp.arange(Wb + Q)
        o_c, o_s, o_w = nsa_branches(qh, q_pos, kc, vc, ks_blk, vs_blk, sel_map, keys[:, :, 0], keys[:, :, 1], kpos)
        new_win = keys[:, Q:]
    g = jax.nn.sigmoid(gates.astype(jnp.float32)).reshape(B, Q, K, R, 3)
    o = g[..., 0:1] * o_c + g[..., 1:2] * o_s + g[..., 2:3] * o_w
    return o.reshape(B, Q, NSA_HEADS * NSA_HD).astype(q.dtype), new_rows, new_win


def retention_chunk(S, q, k, v, log_g):
    C = q.shape[1]
    qf, kf, vf = q.astype(jnp.float32), k.astype(jnp.float32), v.astype(jnp.float32)
    idx = jnp.arange(C, dtype=jnp.float32)
    diff = idx[:, None] - idx[None, :]
    decay = jnp.where(diff >= 0, jnp.exp(jnp.maximum(diff, 0.0)[None] * log_g[:, None, None]), 0.0)
    scores = jnp.einsum('bihd,bjhd->bhij', qf, kf) * decay[None]
    o_inner = jnp.einsum('bhij,bjhe->bihe', scores, vf)
    cross = jnp.exp((idx[:, None] + 1.0) * log_g[None, :])
    o_cross = jnp.einsum('bihd,bhde->bihe', qf, S) * cross[None, :, :, None]
    kw = jnp.exp((C - 1.0 - idx)[:, None] * log_g[None, :])
    S_new = jnp.exp(C * log_g)[None, :, None, None] * S + jnp.einsum('bjhd,bjhe->bhde', kf * kw[None, :, :, None], vf)
    return o_inner + o_cross, S_new


def retention(q, k, v, S0):
    B, T = q.shape[0], q.shape[1]
    log_g = jnp.log(1.0 - 2.0 ** (-5.0 - jnp.arange(RET_HEADS, dtype=jnp.float32)))
    if T >= RET_CHUNK and T % RET_CHUNK == 0:
        nC = T // RET_CHUNK

        def step(S, qkv):
            o, S = retention_chunk(S, qkv[0], qkv[1], qkv[2], log_g)
            return S, o

        def resh(a):
            return jnp.moveaxis(a.reshape(B, nC, RET_CHUNK, a.shape[2], a.shape[3]), 1, 0)

        S, o = lax.scan(step, S0, (resh(q), resh(k), resh(v)))
        o = jnp.moveaxis(o, 0, 1).reshape(B, T, RET_HEADS, RET_DV)
    else:
        o, S = retention_chunk(S0, q, k, v, log_g)
    return o, S


def head_groupnorm(o, g):
    B, T, H, E = o.shape
    mu = jnp.mean(o, axis=-1, keepdims=True)
    var = jnp.mean(jnp.square(o - mu), axis=-1, keepdims=True)
    return ((o - mu) * lax.rsqrt(var + EPS)).reshape(B, T, H * E) * g.astype(jnp.float32)


def rglru(xc, h0, w_a, b_a, w_x, b_x, lam):
    B, T, W = xc.shape
    xf = xc.astype(jnp.float32)
    xb = xf.reshape(B, T, RNN_BLOCKS, RNN_BW)
    r = jax.nn.sigmoid(jnp.einsum('btnc,ncd->btnd', xb, w_a.astype(jnp.float32)).reshape(B, T, W) + b_a)
    i = jax.nn.sigmoid(jnp.einsum('btnc,ncd->btnd', xb, w_x.astype(jnp.float32)).reshape(B, T, W) + b_x)
    log_a = -RG_C * r * jax.nn.softplus(-lam.astype(jnp.float32))
    a = jnp.exp(log_a)
    bt = jnp.sqrt(-jnp.expm1(2.0 * log_a)) * (i * xf)
    bt = bt.at[:, 0].add(a[:, 0] * h0)

    def comb(e1, e2):
        return (e1[0] * e2[0], e2[0] * e1[1] + e2[1])

    _, h = lax.associative_scan(comb, (a, bt), axis=1)
    return h, h[:, -1]


def decoder_layer(x, c, lp, q_pos, past_rows, win_buf, S0, h0, conv_buf, ffn_buf):
    B, T, _ = x.shape
    mod = jnp.einsum('bd,de->be', jax.nn.silu(c), lp['w_ada']) + lp['b_ada']
    sh1, sc1, gt1, sh2, sc2, gt2 = [m[:, None, :] for m in jnp.split(mod, 6, axis=-1)]
    h = rmsnorm(x, lp['norm1_g']) * (1.0 + sc1) + sh1
    u = h @ lp['w_in']
    nq, nkv, ngate, rq, rk, rv, rg, rx, rgate, mg = split_cols(u, IN_WIDTHS)
    o_a, nsa_rows, new_win = nsa_mixer(nq, nkv, ngate, q_pos, past_rows, win_buf,
                                       lp['cmp_pe'], lp['cmp_w1'], lp['cmp_b1'], lp['cmp_w2'])
    p_a = o_a @ lp['w_br_a']
    rqh = rotary(rq.reshape(B, T, RET_HEADS, RET_DK), q_pos)
    rkh = rotary(rk.reshape(B, T, RET_HEADS, RET_DK), q_pos) * (RET_DK ** -0.5)
    o_r, S_new = retention(rqh, rkh, rv.reshape(B, T, RET_HEADS, RET_DV), S0)
    o_r = head_groupnorm(o_r, lp['ret_gn_g']) * jax.nn.silu(rg.astype(jnp.float32))
    p_b = o_r.astype(x.dtype) @ lp['w_br_b']
    xc, conv_new = causal_dwconv(rx, conv_buf, lp['rg_conv_w'], lp['rg_conv_b'])
    hs, h_last = rglru(xc, h0, lp['rg_w_a'], lp['rg_b_a'], lp['rg_w_x'], lp['rg_b_x'], lp['rg_lambda'])
    p_c = (hs.astype(x.dtype) * jax.nn.gelu(rgate)) @ lp['w_br_c']
    gm = jax.nn.sigmoid(mg.reshape(B, T, N_BRANCH, D_MODEL))
    merged = gm[:, :, 0] * p_a + gm[:, :, 1] * p_b + gm[:, :, 2] * p_c
    x = x + gt1 * (merged @ lp['w_out'])
    h2 = rmsnorm(x, lp['norm2_g']) * (1.0 + sc2) + sh2
    gpre, val = jnp.split(h2 @ lp['ffn_w_up'], 2, axis=-1)
    gc, ffn_new = causal_dwconv(gpre, ffn_buf, lp['ffn_conv_w'], lp['ffn_conv_b'])
    x = x + gt2 * ((jax.nn.silu(gc) * val) @ lp['ffn_w_down'])
    return x, (nsa_rows, new_win, S_new, h_last, conv_new, ffn_new)


def setup_inputs(seed: int = 0) -> dict:
    key = jax.random.key(seed)
    f32 = jnp.float32
    n_pages = PAST_LEN // PAGE_SIZE
    n_used = DEC_BATCH * n_pages
    n_phys = n_used + max(1, n_used // 4)
    w_buf = min(WINDOW, PAST_LEN)
    counter = [0]

    def nrm(shape, scale):
        counter[0] += 1
        return jax.random.normal(jax.random.fold_in(key, counter[0]), shape, f32) * scale

    def gain(shape):
        return 1.0 + nrm(shape, 0.01)

    page_table = jax.random.permutation(jax.random.fold_in(key, 1000), n_phys)[:n_used]
    page_table = page_table.reshape(DEC_BATCH, n_pages).astype(jnp.int32)
    a0 = jax.random.uniform(jax.random.fold_in(key, 1001), (DEPTH, RNN_WIDTH), f32, 0.9, 0.999) ** (1.0 / RG_C)
    rg_lambda = jnp.log(a0) - jnp.log1p(-a0)
    return {
        'x_prompt': nrm((BATCH, SEQ, D_MODEL), 1.0),
        'x_sample': nrm((DEC_BATCH, DEC_SEQ, D_MODEL), 1.0),
        'cache_nsa': nrm((DEPTH, n_phys, PAGE_SIZE, NSA_N_KV, NSA_KV_HEADS, NSA_HD), 1.0),
        'cache_nsa_win': nrm((DEPTH, DEC_BATCH, w_buf, 2, NSA_KV_HEADS, NSA_HD), 1.0),
        'state_ret': nrm((DEPTH, DEC_BATCH, RET_HEADS, RET_DK, RET_DV), 0.5),
        'state_rglru_h': nrm((DEPTH, DEC_BATCH, RNN_WIDTH), 0.5),
        'state_rglru_conv': nrm((DEPTH, DEC_BATCH, RG_CONV - 1, RNN_WIDTH), 1.0),
        'state_ffn_conv': nrm((DEPTH, DEC_BATCH, FFN_CONV - 1, D_FF), 1.0),
        'page_table': page_table,
        'c_prompt': nrm((BATCH, D_MODEL), 1.0),
        'c_sample': nrm((DEC_BATCH, D_MODEL), 1.0),
        'norm1_g': gain((DEPTH, D_MODEL)),
        'norm2_g': gain((DEPTH, D_MODEL)),
        'w_ada': nrm((DEPTH, D_MODEL, 6 * D_MODEL), 0.5 * D_MODEL ** -0.5),
        'b_ada': nrm((DEPTH, 6 * D_MODEL), 0.01),
        'w_in': nrm((DEPTH, D_MODEL, D_IN), D_MODEL ** -0.5),
        'cmp_pe': nrm((DEPTH, 2, CMP_BLOCK, NSA_HD), 0.1),
        'cmp_w1': nrm((DEPTH, 2, CMP_BLOCK, NSA_HD, CMP_HIDDEN), (CMP_BLOCK * NSA_HD) ** -0.5),
        'cmp_b1': nrm((DEPTH, 2, CMP_HIDDEN), 0.01),
        'cmp_w2': nrm((DEPTH, 2, CMP_HIDDEN, NSA_HD), CMP_HIDDEN ** -0.5),
        'ret_gn_g': gain((DEPTH, RET_HEADS * RET_DV)),
        'rg_conv_w': nrm((DEPTH, RG_CONV, RNN_WIDTH), RG_CONV ** -0.5),
        'rg_conv_b': nrm((DEPTH, RNN_WIDTH), 0.01),
        'rg_w_a': nrm((DEPTH, RNN_BLOCKS, RNN_BW, RNN_BW), RNN_BW ** -0.5),
        'rg_b_a': nrm((DEPTH, RNN_WIDTH), 0.01),
        'rg_w_x': nrm((DEPTH, RNN_BLOCKS, RNN_BW, RNN_BW), RNN_BW ** -0.5),
        'rg_b_x': nrm((DEPTH, RNN_WIDTH), 0.01),
        'rg_lambda': rg_lambda,
        'w_br_a': nrm((DEPTH, NSA_HEADS * NSA_HD, D_MODEL), (NSA_HEADS * NSA_HD) ** -0.5),
        'w_br_b': nrm((DEPTH, RET_HEADS * RET_DV, D_MODEL), (RET_HEADS * RET_DV) ** -0.5),
        'w_br_c': nrm((DEPTH, RNN_WIDTH, D_MODEL), RNN_WIDTH ** -0.5),
        'w_out': nrm((DEPTH, D_MODEL, D_MODEL), D_MODEL ** -0.5),
        'ffn_w_up': nrm((DEPTH, D_MODEL, 2 * D_FF), D_MODEL ** -0.5),
        'ffn_conv_w': nrm((DEPTH, FFN_CONV, D_FF), FFN_CONV ** -0.5),
        'ffn_conv_b': nrm((DEPTH, D_FF), 0.01),
        'ffn_w_down': nrm((DEPTH, D_FF, D_MODEL), D_FF ** -0.5),
        'final_norm_g': gain((D_MODEL,)),
    }


def reference(x_prompt, x_sample, cache_nsa, cache_nsa_win, state_ret, state_rglru_h, state_rglru_conv,
              state_ffn_conv, page_table, c_prompt, c_sample, norm1_g, norm2_g, w_ada, b_ada, w_in, cmp_pe,
              cmp_w1, cmp_b1, cmp_w2, ret_gn_g, rg_conv_w, rg_conv_b, rg_w_a, rg_b_a, rg_w_x, rg_b_x, rg_lambda,
              w_br_a, w_br_b, w_br_c, w_out, ffn_w_up, ffn_conv_w, ffn_conv_b, ffn_w_down, final_norm_g):
    B, T = x_prompt.shape[0], x_prompt.shape[1]
    DB, Q = x_sample.shape[0], x_sample.shape[1]
    n_pages = page_table.shape[1]
    past_len = n_pages * cache_nsa.shape[2]
    pos_p = jnp.arange(T, dtype=jnp.int32)
    pos_s = past_len + jnp.arange(Q, dtype=jnp.int32)
    xp, xs = x_prompt, x_sample
    st_p = [[] for _ in range(6)]
    st_s = [[] for _ in range(6)]
    for l in range(DEPTH):
        lp = {'norm1_g': norm1_g[l], 'norm2_g': norm2_g[l], 'w_ada': w_ada[l], 'b_ada': b_ada[l],
              'w_in': w_in[l], 'cmp_pe': cmp_pe[l], 'cmp_w1': cmp_w1[l], 'cmp_b1': cmp_b1[l],
              'cmp_w2': cmp_w2[l], 'ret_gn_g': ret_gn_g[l], 'rg_conv_w': rg_conv_w[l],
              'rg_conv_b': rg_conv_b[l], 'rg_w_a': rg_w_a[l], 'rg_b_a': rg_b_a[l], 'rg_w_x': rg_w_x[l],
              'rg_b_x': rg_b_x[l], 'rg_lambda': rg_lambda[l], 'w_br_a': w_br_a[l], 'w_br_b': w_br_b[l],
              'w_br_c': w_br_c[l], 'w_out': w_out[l], 'ffn_w_up': ffn_w_up[l], 'ffn_conv_w': ffn_conv_w[l],
              'ffn_conv_b': ffn_conv_b[l], 'ffn_w_down': ffn_w_down[l]}
        xp, new_p = decoder_layer(
            xp, c_prompt, lp, pos_p, None, None,
            jnp.zeros((B, RET_HEADS, RET_DK, RET_DV), jnp.float32),
            jnp.zeros((B, RNN_WIDTH), jnp.float32),
            jnp.zeros((B, RG_CONV - 1, RNN_WIDTH), x_prompt.dtype),
            jnp.zeros((B, FFN_CONV - 1, D_FF), x_prompt.dtype))
        past_rows = cache_nsa[l][page_table].reshape(DB, past_len, NSA_N_KV, NSA_KV_HEADS, NSA_HD)
        xs, new_s = decoder_layer(
            xs, c_sample, lp, pos_s, past_rows, cache_nsa_win[l],
            state_ret[l].astype(jnp.float32), state_rglru_h[l].astype(jnp.float32),
            state_rglru_conv[l], state_ffn_conv[l])
        for i in range(6):
            st_p[i].append(new_p[i])
            st_s[i].append(new_s[i])
    y_prompt = rmsnorm(xp, final_norm_g)
    y_sample = rmsnorm(xs, final_norm_g)
    nsa_rows_p, nsa_win_p, ret_p, h_p, conv_p, ffn_p = [jnp.stack(a) for a in st_p]
    nsa_rows_s, nsa_win_s, ret_s, h_s, conv_s, ffn_s = [jnp.stack(a) for a in st_s]
    return (y_prompt, y_sample, nsa_rows_p, nsa_rows_s, nsa_win_p, nsa_win_s, ret_p, ret_s,
            h_p, h_s, conv_p, conv_s, ffn_p, ffn_s)
```

```cpp
#include <hip/hip_runtime.h>
#include <cstdio>
#include <cstdint>

#ifndef MK_N_LAUNCHES
#define MK_N_LAUNCHES 1
#endif

constexpr int DM = 1024, PB = 4, PT = 4096, PM = PB * PT, SB = 32, ST = 8, SM = SB * ST, MT = PM + SM;
constexpr int DEPTH = 2, PAST = 8192, PAGE = 128, NPG = PAST / PAGE, NPHYS = 2560;
constexpr int D_IN = 7448, NIN = 7680, DFF = 2816, NUP = 2 * DFF;
constexpr int WINB = 512;
constexpr float EPS = 1e-6f;
constexpr float QSCALE = 0.125f * 1.4426950408889634f;

constexpr int O_NQ = 0, O_NKV = 512, O_NG = 1280, O_RQ = 1304, O_RK = 1816, O_RV = 2328, O_RG = 2840, O_RX = 3352, O_RGATE = 3864, O_MG = 4376;

constexpr size_t OUT_Y = 0;
constexpr size_t OUT_ROWS_P = OUT_Y + (size_t)MT * DM;
constexpr size_t OUT_ROWS_S = OUT_ROWS_P + (size_t)DEPTH * PM * 512;
constexpr size_t OUT_WIN_P = OUT_ROWS_S + (size_t)DEPTH * SM * 512;
constexpr size_t OUT_WIN_S = OUT_WIN_P + (size_t)DEPTH * PB * WINB * 256;
constexpr size_t OUT_RET_P = OUT_WIN_S + (size_t)DEPTH * SB * WINB * 256;
constexpr size_t OUT_RET_S = OUT_RET_P + (size_t)DEPTH * PB * 4 * 16384;
constexpr size_t OUT_H_P = OUT_RET_S + (size_t)DEPTH * SB * 4 * 16384;
constexpr size_t OUT_H_S = OUT_H_P + (size_t)DEPTH * PB * 512;
constexpr size_t OUT_CV_P = OUT_H_S + (size_t)DEPTH * SB * 512;
constexpr size_t OUT_CV_S = OUT_CV_P + (size_t)DEPTH * PB * 3 * 512;
constexpr size_t OUT_FC_P = OUT_CV_S + (size_t)DEPTH * SB * 3 * 512;
constexpr size_t OUT_FC_S = OUT_FC_P + (size_t)DEPTH * PB * 2 * DFF;
constexpr size_t OUT_END = OUT_FC_S + (size_t)DEPTH * SB * 2 * DFF;

constexpr size_t MiB = 1u << 20;
constexpr size_t WS_CTL = 0, CTL_ZERO_BYTES = 4 * MiB;
constexpr size_t WS_MOD = 1 * MiB;
constexpr size_t WS_ROT = 4 * MiB;
constexpr size_t WS_SMALLW = 8 * MiB;
constexpr size_t WS_WIN = 16 * MiB;
constexpr size_t WS_WBR = WS_WIN + (size_t)2 * NIN * DM * 2;
constexpr size_t WS_WOUT = WS_WBR + (size_t)2 * 3 * 1024 * 512 * 2;
constexpr size_t WS_WUP = WS_WOUT + (size_t)2 * 1024 * 1024 * 2;
constexpr size_t WS_WDN = WS_WUP + (size_t)2 * NUP * DM * 2;
constexpr size_t WS_WEND = WS_WDN + (size_t)2 * DM * DFF * 2;
constexpr size_t WS_H = 128 * MiB;
constexpr size_t WS_QN = WS_H + (size_t)MT * DM * 2;
constexpr size_t WS_KVB = WS_QN + (size_t)MT * 512 * 2;
constexpr size_t WS_KVS = WS_KVB + (size_t)4 * PB * 2 * PT * 64 * 2;
constexpr size_t WS_RQ = WS_KVS + (size_t)4 * SB * 2 * ST * 64 * 2;
constexpr size_t WS_RX = WS_RQ + (size_t)4 * MT * 512 * 2;
constexpr size_t WS_GG = WS_RX + (size_t)MT * 512 * 4;
constexpr size_t WS_MGS = WS_GG + (size_t)MT * 512 * 2;
constexpr size_t WS_NG = WS_MGS + (size_t)MT * 3072 * 2;
constexpr size_t WS_OA = WS_NG + (size_t)MT * 24 * 4;
constexpr size_t WS_MRG = WS_OA + (size_t)3 * MT * 512 * 2;
constexpr size_t WS_X1 = WS_MRG + (size_t)MT * DM * 2;
constexpr size_t WS_X2 = WS_X1 + (size_t)MT * DM * 4;
constexpr size_t WS_GP = WS_X2 + (size_t)MT * DM * 4;
constexpr size_t WS_ACMP = WS_GP + (size_t)3 * MT * DFF * 2;
constexpr int CMP_ROWS_J = 34816, CMP_ROWS = 2 * CMP_ROWS_J;
constexpr size_t WS_LH = WS_ACMP + (size_t)2 * CMP_ROWS * 1024 * 2 + 4096;
constexpr size_t WS_CK = WS_LH + (size_t)(CMP_ROWS + 16) * 256 * 2;
constexpr size_t WS_LT = WS_CK + (size_t)CMP_ROWS * 64 * 2;
constexpr size_t WS_SPT = WS_LT + (size_t)16 * 32 * 16384 * 4;
constexpr size_t WS_CAR = WS_SPT + (size_t)16 * 32 * 16384 * 2;
constexpr size_t WS_END = WS_CAR + (size_t)4 * 64 * 3 * 512 * 4 + MiB;
static_assert(WS_WEND <= WS_H, "weights fit below WS_H");

constexpr size_t SW_W1T = 0;
constexpr size_t SW_W2T = SW_W1T + (size_t)2 * 2 * 256 * 1024 * 2;
constexpr size_t SW_CB = SW_W2T + (size_t)2 * 2 * 64 * 128 * 2;
constexpr size_t SW_WAT = SW_CB + (size_t)2 * 2 * 128 * 4;
constexpr size_t SW_SP = SW_WAT + (size_t)2 * 2 * 8 * 64 * 64 * 2;
constexpr size_t SW_END = SW_SP + 2 * 512 * 4;
static_assert(SW_END <= 8 * MiB, "small weights fit");

constexpr int CW_TMO = 0;
constexpr int CW_BAR = 4096;

constexpr int PH_P0 = 0, PH_L0 = 1, PH_PER_LAYER = 11, PH_FINAL = PH_L0 + DEPTH * PH_PER_LAYER, N_PHASES = PH_FINAL + 1;
enum { LP_N1 = 0, LP_WIN, LP_MIX1, LP_MIX2, LP_MIX3, LP_BR, LP_OUT, LP_N2, LP_UP, LP_CONV, LP_DOWN };

constexpr int RING_BYTES = 131072;
constexpr int MISC_OFF = RING_BYTES;
constexpr int LDS_BYTES = RING_BYTES + 1024;
constexpr int NWAVES = 8, NTHR = 512;

#define GAS __attribute__((address_space(1)))
#define LAS __attribute__((address_space(3)))
typedef unsigned short bf16;
typedef unsigned v4u __attribute__((ext_vector_type(4)));
typedef unsigned v2u __attribute__((ext_vector_type(2)));
typedef float f32x16 __attribute__((ext_vector_type(16)));
typedef short s16x4 __attribute__((ext_vector_type(4)));
namespace pg8 {
#define PG8_LAS __attribute__((address_space(3)))
typedef unsigned short bf16_t;
typedef short bf16x8 __attribute__((ext_vector_type(8)));
typedef float f32x4 __attribute__((ext_vector_type(4)));
typedef unsigned u32x4 __attribute__((ext_vector_type(4)));
constexpr int BM = 256, BK = 64, HALF = 128, HTB = HALF * BK * 2  , STAGE_BYTES = 8 * HTB, NXCD = 8, WGM = 8;

__host__ __device__ __forceinline__ int lds_byte(int r, int c) { const int st = (r >> 4) * 2 + (c >> 5), rr = r & 15, cc = c & 31, ob = rr * 64 + cc * 2; return st * 1024 + (ob ^ (((ob >> 9) & 1) << 5)); }
__host__ __device__ __forceinline__ void stage_rc(int b, int& R, int& C) { const int st = b / 1024, sb = b % 1024, swz = sb ^ (((sb >> 9) & 1) << 5); R = (st >> 1) * 16 + swz / 64; C = (st & 1) * 32 + (swz % 64) / 2; }
__host__ __device__ __forceinline__ int perm32(int rho) { const int n = rho >> 4, i = rho & 15; return 8 * (i >> 2) + 4 * n + (i & 3); }

struct Unit { int pm, pn; };
struct Gemm { const bf16_t* A; const bf16_t* Bt; int M, N, K; };

struct StaticOrder {
    int nM, nN, nwg, G, c;
    __host__ __device__ void init(int M, int N, int G_, int c_) { nM = M / BM; nN = N / BM; nwg = nM * nN; G = G_; c = c_; }
    __host__ __device__ bool next(int i, Unit& u) const {
        const long L = (long)i * G + c; if (L >= nwg) return false;
        int wgid = (int)L; { const int q = nwg / NXCD, r = nwg % NXCD, xcd = wgid % NXCD, off = wgid / NXCD; wgid = (xcd < r ? xcd * (q + 1) : r * (q + 1) + (xcd - r) * q) + off; }
        const int nig = WGM * nN, gid = wgid / nig, fm = gid * WGM, gsz = (nM - fm) < WGM ? (nM - fm) : WGM;
        u.pm = fm + ((wgid % nig) % gsz); u.pn = (wgid % nig) / gsz; return true;
    }
    __device__ __forceinline__ void a_ready(const Unit&) const {}
    __device__ __forceinline__ void done(const Unit&) const {}
};
__device__ __forceinline__ unsigned cvt_pk_bf16(float lo, float hi) { unsigned r; asm volatile("v_cvt_pk_bf16_f32 %0, %1, %2" : "=v"(r) : "v"(lo), "v"(hi)); return r; }
typedef float f32x2 __attribute__((ext_vector_type(2)));
template <class Epi, class Sched, bool ALIGN_EPI = false, bool SP2 = false>
__device__ __forceinline__ void gemm_phase(PG8_LAS unsigned char* lds, const Gemm g, const Sched& S, const Epi& E) {
    const int tid = threadIdx.x, wid = __builtin_amdgcn_readfirstlane(tid >> 6), lane = tid & 63, wr = wid >> 2, wc = wid & 3, fr = lane & 15, fq = lane >> 4;
    const int K = g.K, nt = K / BK;
    unsigned voffA[2], voffB[2];
#pragma unroll
    for (int i = 0; i < 2; ++i) { int R, C; stage_rc(tid * 16 + i * 8192, R, C); const int Rb = Epi::PERM ? ((R & ~31) + perm32(R & 31)) : R;
        voffA[i] = (unsigned)(R * K + C) * 2u; voffB[i] = (unsigned)(Rb * K + C) * 2u; }
    const size_t kstep = (size_t)(BK * 2);
    const size_t hstep = (size_t)HALF * K * 2;
    const size_t tstep = 2 * hstep;
    const unsigned ldsw = (unsigned)wid * 1024u;
    const int aoff = lds_byte(wr * 64 + fr, fq * 8), boff = lds_byte(wc * 32 + fr, fq * 8);
#define PG8_SA(b, h) (((b) * 2 + (h)) * HTB)
#define PG8_SB(b, h) ((4 + (b) * 2 + (h)) * HTB)
#define PG8_STAGE(bufoff, gbase, voff) do { _Pragma("unroll") for (int _i = 0; _i < 2; ++_i) \
        __builtin_amdgcn_global_load_lds((const unsigned*)((const char*)(gbase) + (voff)[_i]), (PG8_LAS unsigned*)(lds + (bufoff) + ldsw + _i * 8192), 16, 0, 0); } while (0)
#define PG8_LDA(dst, b, h) do { _Pragma("unroll") for (int m = 0; m < 4; ++m) _Pragma("unroll") for (int k = 0; k < 2; ++k) dst[m][k] = *(const PG8_LAS bf16x8*)(lds + PG8_SA(b, h) + aoff + m * 2048 + k * 1024); } while (0)
#define PG8_LDB(dst, b, h) do { _Pragma("unroll") for (int n = 0; n < 2; ++n) _Pragma("unroll") for (int k = 0; k < 2; ++k) dst[n][k] = *(const PG8_LAS bf16x8*)(lds + PG8_SB(b, h) + boff + n * 2048 + k * 1024); } while (0)
#define PG8_MMA(ai, bj, At, Bt) do { __builtin_amdgcn_s_setprio(1); _Pragma("unroll") for (int m = 0; m < 4; ++m) _Pragma("unroll") for (int n = 0; n < 2; ++n) _Pragma("unroll") for (int k = 0; k < 2; ++k) \
        acc[ai][bj][m][n] = __builtin_amdgcn_mfma_f32_16x16x32_bf16(Bt[n][k], At[m][k], acc[ai][bj][m][n], 0, 0, 0); __builtin_amdgcn_s_setprio(0); } while (0)
#define PG8_WAIT_V(n) asm volatile("s_waitcnt vmcnt(" #n ")" ::: "memory")
#define PG8_WAIT_L(n) asm volatile("s_waitcnt lgkmcnt(" #n ")" ::: "memory")
#define PG8_BAR __builtin_amdgcn_s_barrier()
#define PG8_SCHED __builtin_amdgcn_sched_barrier(0)
    Unit cur, nxt; int ui = 0;
    if (!S.next(0, cur)) return;
    f32x4 acc[2][2][4][2];
#pragma unroll
    for (int a = 0; a < 2; ++a)
#pragma unroll
        for (int b = 0; b < 2; ++b)
#pragma unroll
            for (int m = 0; m < 4; ++m)
#pragma unroll
                for (int n = 0; n < 2; ++n) acc[a][b][m][n] = (f32x4){0.f, 0.f, 0.f, 0.f};
    bf16x8 At[4][2], B0[2][2], B1[2][2];
    const char* cA = (const char*)g.A + (size_t)cur.pm * tstep; const char* cB = (const char*)g.Bt + (size_t)cur.pn * tstep;
    S.a_ready(cur);
    if constexpr (SP2) {
        PG8_STAGE(PG8_SB(0, 0), cB, voffB); PG8_STAGE(PG8_SB(0, 1), cB + hstep, voffB); PG8_STAGE(PG8_SA(0, 0), cA, voffA); PG8_STAGE(PG8_SA(0, 1), cA + hstep, voffA);
        if (wr == 1) PG8_BAR;
        PG8_WAIT_V(2); PG8_BAR;
        PG8_STAGE(PG8_SB(1, 0), cB + kstep, voffB); PG8_STAGE(PG8_SA(1, 0), cA + kstep, voffA); PG8_STAGE(PG8_SB(1, 1), cB + hstep + kstep, voffB);
        PG8_WAIT_V(6); PG8_BAR;
    } else {
        PG8_STAGE(PG8_SB(0, 0), cB, voffB); PG8_STAGE(PG8_SA(0, 0), cA, voffA); PG8_STAGE(PG8_SB(0, 1), cB + hstep, voffB); PG8_STAGE(PG8_SA(0, 1), cA + hstep, voffA);
        if (wr == 1) PG8_BAR;
        PG8_WAIT_V(4); PG8_BAR;
        PG8_STAGE(PG8_SB(1, 0), cB + kstep, voffB); PG8_STAGE(PG8_SA(1, 0), cA + kstep, voffA); PG8_STAGE(PG8_SB(1, 1), cB + hstep + kstep, voffB);
        PG8_WAIT_V(6); PG8_BAR;
    }
    for (;;) {
        const bool has_next = S.next(ui + 1, nxt);
        const char* nA = has_next ? (const char*)g.A + (size_t)nxt.pm * tstep : cA; const char* nB = has_next ? (const char*)g.Bt + (size_t)nxt.pn * tstep : cB;
        for (int t = 0; t < nt; t += 2) {
            const bool last = (t == nt - 2);
            const char* a1 = cA + (size_t)(t + 1) * kstep;
            const char* a2 = last ? nA : cA + (size_t)(t + 2) * kstep; const char* b2 = last ? nB : cB + (size_t)(t + 2) * kstep;
            const char* a3 = a2 + kstep; const char* b3 = b2 + kstep;
            if (last && has_next) S.a_ready(nxt);
            if constexpr (SP2) {
            PG8_LDB(B0, 0, 0); PG8_LDB(B1, 0, 1); PG8_SCHED; PG8_LDA(At, 0, 0); PG8_STAGE(PG8_SA(1, 1), a1 + hstep, voffA);
            PG8_WAIT_V(8); PG8_WAIT_L(0); PG8_BAR; PG8_MMA(0, 0, At, B0); PG8_MMA(0, 1, At, B1); PG8_BAR; PG8_SCHED;
            PG8_LDA(At, 0, 1); PG8_STAGE(PG8_SB(0, 0), b2, voffB); PG8_STAGE(PG8_SB(0, 1), b2 + hstep, voffB); PG8_STAGE(PG8_SA(0, 0), a2, voffA);
            PG8_WAIT_V(8); PG8_WAIT_L(0); PG8_BAR; PG8_MMA(1, 0, At, B0); PG8_MMA(1, 1, At, B1); PG8_BAR; PG8_SCHED;
            PG8_LDB(B0, 1, 0); PG8_LDB(B1, 1, 1); PG8_SCHED; PG8_LDA(At, 1, 0); PG8_STAGE(PG8_SA(0, 1), a2 + hstep, voffA);
            PG8_WAIT_V(8); PG8_WAIT_L(0); PG8_BAR; PG8_MMA(0, 0, At, B0); PG8_MMA(0, 1, At, B1); PG8_BAR; PG8_SCHED;
            PG8_LDA(At, 1, 1); PG8_STAGE(PG8_SB(1, 0), b3, voffB); PG8_STAGE(PG8_SB(1, 1), b3 + hstep, voffB); PG8_STAGE(PG8_SA(1, 0), a3, voffA);
            PG8_WAIT_V(8); PG8_WAIT_L(0); PG8_BAR; PG8_MMA(1, 0, At, B0); PG8_MMA(1, 1, At, B1); PG8_BAR; PG8_SCHED;
            } else {
            PG8_LDB(B0, 0, 0); PG8_SCHED; PG8_LDA(At, 0, 0); PG8_STAGE(PG8_SA(1, 1), a1 + hstep, voffA);
            PG8_WAIT_L(8); PG8_BAR; PG8_WAIT_L(0); PG8_MMA(0, 0, At, B0); PG8_BAR; PG8_SCHED;
            PG8_LDB(B1, 0, 1); PG8_STAGE(PG8_SB(0, 0), b2, voffB);
            PG8_BAR; PG8_WAIT_L(0); PG8_MMA(0, 1, At, B1); PG8_BAR;
            PG8_LDA(At, 0, 1); PG8_STAGE(PG8_SA(0, 0), a2, voffA);
            PG8_BAR; PG8_WAIT_L(0); PG8_MMA(1, 0, At, B0); PG8_BAR; PG8_SCHED;
            PG8_STAGE(PG8_SB(0, 1), b2 + hstep, voffB);
            PG8_WAIT_V(6); PG8_BAR; PG8_MMA(1, 1, At, B1); PG8_BAR;
            PG8_LDB(B0, 1, 0); PG8_SCHED; PG8_LDA(At, 1, 0); PG8_STAGE(PG8_SA(0, 1), a2 + hstep, voffA);
            PG8_WAIT_L(8); PG8_BAR; PG8_WAIT_L(0); PG8_MMA(0, 0, At, B0); PG8_BAR; PG8_SCHED;
            PG8_LDB(B1, 1, 1); PG8_STAGE(PG8_SB(1, 0), b3, voffB);
            PG8_BAR; PG8_WAIT_L(0); PG8_MMA(0, 1, At, B1); PG8_BAR;
            PG8_LDA(At, 1, 1); PG8_STAGE(PG8_SA(1, 0), a3, voffA);
            PG8_BAR; PG8_WAIT_L(0); PG8_MMA(1, 0, At, B0); PG8_BAR; PG8_SCHED;
            PG8_STAGE(PG8_SB(1, 1), b3 + hstep, voffB);
            PG8_WAIT_V(6); PG8_BAR; PG8_MMA(1, 1, At, B1); PG8_BAR;
            }
        }
        if constexpr (ALIGN_EPI) { if (wr == 0) PG8_BAR; }
        if constexpr (!Epi::AFTER_DRAIN) { E(acc, cur, wr, wc, fr, fq); S.done(cur); }
        if (!has_next) break;
#pragma unroll
        for (int a = 0; a < 2; ++a)
#pragma unroll
            for (int b = 0; b < 2; ++b)
#pragma unroll
                for (int m = 0; m < 4; ++m)
#pragma unroll
                    for (int n = 0; n < 2; ++n) acc[a][b][m][n] = (f32x4){0.f, 0.f, 0.f, 0.f};
        cur = nxt; cA = nA; cB = nB; ++ui;
        if constexpr (ALIGN_EPI) { if (wr == 1) PG8_BAR; }
    }
    PG8_WAIT_V(0);
    if constexpr (!ALIGN_EPI) { if (wr == 0) PG8_BAR; }
    PG8_BAR;
    if constexpr (Epi::AFTER_DRAIN) { E.fused(acc, cur, wr, wc, fr, fq, lds, wid, lane); S.done(cur); }
#undef PG8_SA
#undef PG8_SB
#undef PG8_STAGE
#undef PG8_LDA
#undef PG8_LDB
#undef PG8_MMA
#undef PG8_WAIT_V
#undef PG8_WAIT_L
#undef PG8_BAR
#undef PG8_SCHED
}
}

using pg8::bf16x8; using pg8::f32x4; using pg8::u32x4;
#define LDS_WAIT() asm volatile("s_waitcnt lgkmcnt(0)" ::: "memory")
#define VM_WAIT() asm volatile("s_waitcnt vmcnt(0)" ::: "memory")
typedef float f32x2_t __attribute__((ext_vector_type(2))); typedef __bf16 bf16x2_t __attribute__((ext_vector_type(2)));
__device__ __forceinline__ unsigned pk2(float lo, float hi) { f32x2_t v = {lo, hi}; bf16x2_t b = __builtin_convertvector(v, bf16x2_t); return __builtin_bit_cast(unsigned, b); }
__device__ __forceinline__ float bf_lo(unsigned w) { return __uint_as_float(w << 16); }
__device__ __forceinline__ float bf_hi(unsigned w) { return __uint_as_float(w & 0xffff0000u); }
__device__ __forceinline__ float bf1(bf16 b) { return __uint_as_float(((unsigned)b) << 16); }
__device__ __forceinline__ float fexp2(float x) { return __builtin_amdgcn_exp2f(x); }
__device__ __forceinline__ float fexp(float x) { return __builtin_amdgcn_exp2f(x * 1.4426950408889634f); }
__device__ __forceinline__ float frcp(float x) { return __builtin_amdgcn_rcpf(x); }
__device__ __forceinline__ float sigmoidf_(float x) { return frcp(1.0f + fexp(-x)); }
__device__ __forceinline__ float siluf_(float x) { return x * sigmoidf_(x); }
__device__ __forceinline__ float gelu_tanh(float x) {
    const float u = 0.7978845608028654f * (x + 0.044715f * x * x * x);
    const float e = fexp(2.0f * u);
    const float t = 1.0f - 2.0f * frcp(e + 1.0f);
    return 0.5f * x * (1.0f + t);
}
__device__ __forceinline__ float wave_sum(float v) {
#pragma unroll
    for (int o = 1; o < 64; o <<= 1) v += __shfl_xor(v, o);
    return v;
}
__device__ __forceinline__ v4u pack8(const f32x4 a, const f32x4 b) { v4u w; w.x = pk2(a[0], a[1]); w.y = pk2(a[2], a[3]); w.z = pk2(b[0], b[1]); w.w = pk2(b[2], b[3]); return w; }
__device__ __forceinline__ void unpack8(const v4u w, f32x4& a, f32x4& b) { a = (f32x4){bf_lo(w.x), bf_hi(w.x), bf_lo(w.y), bf_hi(w.y)}; b = (f32x4){bf_lo(w.z), bf_hi(w.z), bf_lo(w.w), bf_hi(w.w)}; }

#define XB_TMO      128
#define XB_XCNT(j)  (256  + 64 * (j))
#define XB_XSUB(j)  (1280 + 64 * (j))
#define XB_XGEN(j)  (2304 + 64 * (j))
#define XB_TOP      3328
#define XB_TOPGEN   3392
#define XCD_BAR_WORDS 3456
#define XB_SPIN_CAP (1u << 18)

__device__ __forceinline__ unsigned xb_ld(unsigned* p)              { return __hip_atomic_load(p, __ATOMIC_RELAXED, __HIP_MEMORY_SCOPE_AGENT); }
__device__ __forceinline__ unsigned xb_add(unsigned* p, unsigned v) { return __hip_atomic_fetch_add(p, v, __ATOMIC_RELAXED, __HIP_MEMORY_SCOPE_AGENT); }
__device__ __forceinline__ unsigned xb_xcc_id() { return (unsigned)__builtin_amdgcn_s_getreg((3 << 11) | 20) & 0xFu; }
#define XB_SPIN(cond, bar) do { unsigned _sp = 0; while (cond) { __builtin_amdgcn_s_sleep(1); \
    if ((++_sp & 255u) == 0u) { if (xb_ld(&(bar)[XB_TMO])) break; if (_sp > XB_SPIN_CAP) { atomicAdd(&(bar)[XB_TMO], 1u); break; } } } } while (0)

struct XcdBarrier {
    unsigned* bar; unsigned x;
    volatile LAS unsigned* st;
};

__device__ __forceinline__ XcdBarrier xcd_barrier_post(unsigned* bar, volatile LAS unsigned* st) {
    XcdBarrier b; b.bar = bar; b.x = xb_xcc_id(); b.st = st;
    if (threadIdx.x == 0) (void)xb_add(&bar[XB_XCNT(b.x)], 1u);
    return b;
}
__device__ __forceinline__ void xcd_barrier_complete(unsigned* bar, unsigned x, unsigned& nloc, unsigned& nx) {
    const unsigned G = gridDim.x * gridDim.y * gridDim.z;
    unsigned sum, cnt, mine, sp = 0u;
    for (;;) {
        sum = 0u; cnt = 0u; mine = 0u;
#pragma unroll
        for (unsigned j = 0; j < 16; ++j) { const unsigned c = xb_ld(&bar[XB_XCNT(j)]); sum += c; cnt += (c > 0u) ? 1u : 0u; mine = (j == x) ? c : mine; }
        if (sum == G) break;
        __builtin_amdgcn_s_sleep(1);
        if ((++sp & 255u) == 0u) { if (xb_ld(&bar[XB_TMO])) break; if (sp > XB_SPIN_CAP) { atomicAdd(&bar[XB_TMO], 1u); break; } }
    }
    nloc = mine > 0u ? mine : 1u; nx = cnt > 0u ? cnt : 1u;
}

__device__ __forceinline__ void xcd_barrier(const XcdBarrier& b) {
    asm volatile("s_waitcnt vmcnt(0)" ::: "memory");
    __syncthreads();
    if (threadIdx.x == 0) {
        unsigned* bar = b.bar;
        __builtin_amdgcn_s_waitcnt(0);
        unsigned nloc = b.st[0], nx = b.st[1];
        if (nloc == 0u) { xcd_barrier_complete(bar, b.x, nloc, nx); b.st[0] = nloc; b.st[1] = nx; }
        const unsigned old = xb_add(&bar[XB_XSUB(b.x)], 1u);
        const unsigned gen = old / nloc;
        if (old + 1u == (gen + 1u) * nloc) {
            __builtin_amdgcn_fence(__ATOMIC_RELEASE, "agent");
            asm volatile("s_waitcnt vmcnt(0)" ::: "memory");
            const unsigned og = xb_add(&bar[XB_TOP], 1u);
            const unsigned tg = og / nx;
            if (og + 1u == (tg + 1u) * nx) xb_add(&bar[XB_TOPGEN], 1u);
            else XB_SPIN(xb_ld(&bar[XB_TOPGEN]) == tg, bar);
            __builtin_amdgcn_fence(__ATOMIC_ACQUIRE, "agent");
            xb_add(&bar[XB_XGEN(b.x)], 1u);
            asm volatile("s_waitcnt vmcnt(0)" ::: "memory");
        } else {
            XB_SPIN(xb_ld(&bar[XB_XGEN(b.x)]) == gen, bar);
            __builtin_amdgcn_fence(__ATOMIC_ACQUIRE, "agent");
            asm volatile("s_waitcnt vmcnt(0)" ::: "memory");
        }
    }
    __syncthreads();
}

struct Args { const void* in[37]; float* out; unsigned char* ws; int ph_lo, ph_hi; };
enum { I_XP = 0, I_XS, I_CACHE, I_CWIN, I_SRET, I_SH, I_SCONV, I_SFFN, I_PT, I_CP, I_CS, I_N1G, I_N2G, I_WADA, I_BADA, I_WIN, I_PE, I_W1, I_B1, I_W2,
       I_GNG, I_RCW, I_RCB, I_RWA, I_RBA, I_RWX, I_RBX, I_LAM, I_WBRA, I_WBRB, I_WBRC, I_WOUT, I_WUP, I_FCW, I_FCB, I_WDN, I_FNG };

struct Frame {
    LAS unsigned char* lds;
    int tid, lane, wave, G, bid;
    const Args* a;
    unsigned char* ws;
    float* out;
};
__device__ __forceinline__ void launder(Frame& F) { asm volatile("" : "+v"(F.tid), "+v"(F.lane)); asm volatile("" : "+s"(F.wave), "+s"(F.bid), "+s"(F.G)); }
#define FIN(i) ((const float*)F.a->in[i])
#define WSP(T, off) ((T*)(F.ws + (off)))

__device__ __forceinline__ int row_bb(int row) { return row < PM ? (row >> 12) : 4 + ((row - PM) >> 3); }
__device__ __forceinline__ int row_pos(int row) { return row < PM ? (row & (PT - 1)) : PT + ((row - PM) & 7); }

__device__ __forceinline__ int win_cmap(int n) {
    if (n < 1280) return n;
    if (n < 2304) { const int c = n - 1280, isk = c >> 9, hc = c & 511, head = hc >> 7, s = hc & 127;
        const int g = s >> 3, w = s & 7, dim = (w < 4) ? (4 * g + w) : (64 + 4 * g + (w - 4)); return (isk ? O_RK : O_RQ) + head * 128 + dim; }
    if (n < 2816) return O_RV + (n - 2304);
    if (n < 3328) return O_RG + (n - 2816);
    if (n < 3840) return O_RX + (n - 3328);
    if (n < 4352) return O_RGATE + (n - 3840);
    if (n < 7424) return O_MG + (n - 4352);
    if (n < 7448) return O_NG + (n - 7424);
    return -1;
}

template <bool MAP> __device__ __forceinline__ void p0_tr_item(const float* W, int ldw, bf16* WT, int ldt, int k0, int n0, LAS float* scr, int lane) {
    const int nd = n0 + (lane & 31); const int sc = MAP ? win_cmap(nd) : nd;
#pragma unroll 8
    for (int i = 0; i < 32; ++i) { const int kk = 2 * i + (lane >> 5); scr[kk * 33 + (lane & 31)] = (sc >= 0) ? W[(size_t)(k0 + kk) * ldw + sc] : 0.f; }
    LDS_WAIT(); asm volatile("" ::: "memory");
    const int c = lane & 7;
#pragma unroll
    for (int j = 0; j < 4; ++j) { const int n = (lane >> 3) + 8 * j; const LAS float* s = scr + (8 * c) * 33 + n;
        v4u o; o.x = pk2(s[0 * 33], s[1 * 33]); o.y = pk2(s[2 * 33], s[3 * 33]); o.z = pk2(s[4 * 33], s[5 * 33]); o.w = pk2(s[6 * 33], s[7 * 33]);
        *(v4u*)(WT + (size_t)(n0 + n) * ldt + k0 + 8 * c) = o; }
    LDS_WAIT(); asm volatile("" ::: "memory");
}
__device__ __forceinline__ void sincos_acc(float ang, float& s, float& c) {
    const double a = (double)ang; const double kq = rint(a * 0.63661977236758134308); const double r = fma(-kq, 1.57079632679489661923, a);
    const double r2 = r * r;
    const double sp = r * (1.0 + r2 * (-1.6666666666666666e-1 + r2 * (8.3333333333333332e-3 + r2 * (-1.9841269841269841e-4 + r2 * (2.7557319223985893e-6 + r2 * (-2.5052108385441720e-8))))));
    const double cp = 1.0 + r2 * (-0.5 + r2 * (4.1666666666666664e-2 + r2 * (-1.3888888888888889e-3 + r2 * (2.4801587301587302e-5 + r2 * (-2.7557319223985888e-7 + r2 * 2.0876756987868099e-9)))));
    const int q = ((int)kq) & 3;
    const double ss = (q == 0) ? sp : (q == 1) ? cp : (q == 2) ? -sp : -cp;
    const double cc = (q == 0) ? cp : (q == 1) ? -sp : (q == 2) ? -cp : sp;
    s = (float)ss; c = (float)cc;
}

__device__ __forceinline__ void p0_prologue(Frame& F) {
    const int gw = F.bid * NWAVES + F.wave, NGW = F.G * NWAVES, lane = F.lane;
    LAS float* scr = (LAS float*)(F.lds + F.wave * 16384);
    {
        constexpr int I_IN = 16 * 240, I_BR = 8 * 32, I_OUT = 16 * 32, I_UP = 16 * 176, I_DN = 44 * 32, I_L = I_IN + 3 * I_BR + I_OUT + I_UP + I_DN;
        for (int it = gw; it < 2 * I_L; it += NGW) {
            const int l = it / I_L; int r = it % I_L;
            if (r < I_IN) { p0_tr_item<true>(FIN(I_WIN) + (size_t)l * DM * D_IN, D_IN, WSP(bf16, WS_WIN) + (size_t)l * NIN * DM, DM, 64 * (r / 240), 32 * (r % 240), scr, lane); continue; } r -= I_IN;
            if (r < 3 * I_BR) { const int w = r / I_BR, q = r % I_BR; const float* src = FIN(w == 0 ? I_WBRA : (w == 1 ? I_WBRB : I_WBRC)) + (size_t)l * 512 * 1024;
                p0_tr_item<false>(src, 1024, WSP(bf16, WS_WBR) + (size_t)(l * 3 + w) * 1024 * 512, 512, 64 * (q / 32), 32 * (q % 32), scr, lane); continue; } r -= 3 * I_BR;
            if (r < I_OUT) { p0_tr_item<false>(FIN(I_WOUT) + (size_t)l * 1024 * 1024, 1024, WSP(bf16, WS_WOUT) + (size_t)l * 1024 * 1024, 1024, 64 * (r / 32), 32 * (r % 32), scr, lane); continue; } r -= I_OUT;
            if (r < I_UP) { p0_tr_item<false>(FIN(I_WUP) + (size_t)l * DM * NUP, NUP, WSP(bf16, WS_WUP) + (size_t)l * NUP * DM, DM, 64 * (r / 176), 32 * (r % 176), scr, lane); continue; } r -= I_UP;
            p0_tr_item<false>(FIN(I_WDN) + (size_t)l * DFF * DM, DM, WSP(bf16, WS_WDN) + (size_t)l * DM * DFF, DFF, 64 * (r / 32), 32 * (r % 32), scr, lane);
        }
    }
    {
        constexpr int NI_W1 = 8 * 16 * 4, NI_W2 = 4 * 2 * 2, NI_RG = 32 * 2;
        for (int it = gw; it < NI_W1 + NI_W2 + NI_RG; it += NGW) {
            int r = it;
            if (r < NI_W1) { const int m = r / 64, q = r % 64, lk = m >> 1, half = m & 1;
                p0_tr_item<false>(FIN(I_W1) + ((size_t)lk * 32 + half * 16) * 64 * 128, 128, WSP(bf16, WS_SMALLW + SW_W1T) + ((size_t)lk * 256 + half * 128) * 1024, 1024, 64 * (q / 4), 32 * (q % 4), scr, lane); continue; } r -= NI_W1;
            if (r < NI_W2) { const int lk = r / 4, q = r % 4;
                p0_tr_item<false>(FIN(I_W2) + (size_t)lk * 128 * 64, 64, WSP(bf16, WS_SMALLW + SW_W2T) + (size_t)lk * 64 * 128, 128, 64 * (q / 2), 32 * (q % 2), scr, lane); continue; } r -= NI_W2;
            { const int m = r / 2, q = r % 2, l = m >> 4, which = (m >> 3) & 1, blk = m & 7;
                p0_tr_item<false>(FIN(which ? I_RWX : I_RWA) + ((size_t)l * 8 + blk) * 4096, 64, WSP(bf16, WS_SMALLW + SW_WAT) + (size_t)m * 4096, 64, 0, 32 * q, scr, lane); }
        }
    }
    for (int it = gw; it < 8; it += NGW) {
        const int lk = it >> 1, h = (it & 1) * 64 + lane; const float* pe = FIN(I_PE) + (size_t)lk * 2048; const float* w1 = FIN(I_W1) + (size_t)lk * 2048 * 128 + h;
        float acc = 0.f;
#pragma unroll 8
        for (int i = 0; i < 2048; ++i) acc += pe[i] * w1[(size_t)i * 128];
        WSP(float, WS_SMALLW + SW_CB)[lk * 128 + h] = acc + FIN(I_B1)[lk * 128 + h];
    }
    for (int i = F.bid * NTHR + F.tid; i < 1024; i += F.G * NTHR) { const float lam = FIN(I_LAM)[i]; WSP(float, WS_SMALLW + SW_SP)[i] = log1pf(expf(-lam)); }
    for (int i = F.bid * NTHR + F.tid; i < 4104 * 64; i += F.G * NTHR) {
        const int pi = i >> 6, fi = i & 63; const float pos = (float)(pi < PT ? pi : PAST + (pi - PT));
        const float freq = (float)pow(10000.0, -(double)fi / 64.0); const float ang = pos * freq; float s, c; sincos_acc(ang, s, c);
        WSP(float, WS_ROT)[i] = c; WSP(float, WS_ROT)[4104 * 64 + i] = s;
    }
    {
        LAS float* SC = (LAS float*)(F.lds + 0);
        LAS float* RED = (LAS float*)(F.lds + 40960);
        for (int u = F.bid; u < 2 * 24; u += F.G) {
            const int l = u / 24, cg = u % 24;
            f32x4 acc[36];
#pragma unroll
            for (int b = 0; b < 36; ++b) acc[b] = (f32x4){0.f, 0.f, 0.f, 0.f};
#pragma unroll 1
            for (int kq = 0; kq < 4; ++kq) {
                __syncthreads();
                for (int i = F.tid; i < 256 * 36; i += NTHR) { const int d = i / 36, bb = i % 36; const float c = (bb < 4) ? FIN(I_CP)[bb * DM + kq * 256 + d] : FIN(I_CS)[(bb - 4) * DM + kq * 256 + d]; SC[i] = siluf_(c); }
                __syncthreads();
                const float* wp = FIN(I_WADA) + ((size_t)l * DM + kq * 256 + F.wave * 32) * 6144 + cg * 256 + lane * 4;
                for (int dd = 0; dd < 32; ++dd) {
                    const f32x4 wv = *(const f32x4*)(wp + (size_t)dd * 6144);
                    const LAS f32x4* sc4 = (const LAS f32x4*)(SC + (F.wave * 32 + dd) * 36);
#pragma unroll
                    for (int g = 0; g < 9; ++g) { const f32x4 s4 = sc4[g];
                        acc[4 * g + 0] += wv * s4[0]; acc[4 * g + 1] += wv * s4[1]; acc[4 * g + 2] += wv * s4[2]; acc[4 * g + 3] += wv * s4[3]; }
                }
            }
#pragma unroll
            for (int g = 0; g < 9; ++g) {
                __syncthreads();
#pragma unroll
                for (int j = 0; j < 4; ++j) *(LAS f32x4*)(RED + ((F.wave * 4 + j) * 256 + lane * 4)) = acc[4 * g + j];
                __syncthreads();
#pragma unroll
                for (int q = 0; q < 2; ++q) { const int o = F.tid + q * NTHR, j = o >> 8, col = o & 255; float s = FIN(I_BADA)[l * 6144 + cg * 256 + col];
#pragma unroll
                    for (int w = 0; w < 8; ++w) s += RED[(w * 4 + j) * 256 + col];
                    WSP(float, WS_MOD)[((size_t)l * 36 + 4 * g + j) * 6144 + cg * 256 + col] = s; }
            }
        }
        __syncthreads();
    }
    for (int it = gw; it < 2 * SB * PAST; it += NGW) {
        const int l = it / (SB * PAST), r = it % (SB * PAST), db = r / PAST, tt = r % PAST;
        const int page = ((const int*)F.a->in[I_PT])[db * NPG + (tt >> 7)];
        const float* src = FIN(I_CACHE) + (((size_t)l * NPHYS + page) * PAGE + (tt & 127)) * 512 + lane * 4;
        const f32x4 v = __builtin_nontemporal_load((const f32x4*)src);
        const int idx = lane * 4, j = idx >> 7, k = (idx >> 6) & 1, d = idx & 63;
        bf16* dst = WSP(bf16, WS_ACMP) + ((size_t)(l * 2 + j) * CMP_ROWS_J) * 1024 + ((size_t)(db * 2 + k) * PAST + tt) * 64 + d;
        v2u o; o.x = pk2(v[0], v[1]); o.y = pk2(v[2], v[3]); *(v2u*)dst = o;
    }
    for (size_t i = (size_t)F.bid * NTHR + F.tid; i < (size_t)2 * SB * 504 * 64; i += (size_t)F.G * NTHR) {
        const size_t seq = i / (504 * 64), r = i % (504 * 64);
        const f32x4 v = *(const f32x4*)(FIN(I_CWIN) + (seq * 512 + 8) * 256 + r * 4);
        *(f32x4*)(F.out + OUT_WIN_S + seq * 512 * 256 + r * 4) = v;
    }
}

__device__ __forceinline__ const float* xrow_in(const Frame& F, int l, int row) {
    if (l == 0) return row < PM ? FIN(I_XP) + (size_t)row * DM : FIN(I_XS) + (size_t)(row - PM) * DM;
    return WSP(float, WS_X2) + (size_t)row * DM;
}
__device__ __forceinline__ void norm_phase(Frame& F, int l, int which) {
    const int gw = F.bid * NWAVES + F.wave, NGW = F.G * NWAVES, lane = F.lane;
    const float* g = FIN(which ? I_N2G : I_N1G) + l * DM;
    for (int row = gw; row < MT; row += NGW) {
        const float* xr = which ? WSP(float, WS_X1) + (size_t)row * DM : xrow_in(F, l, row);
        const float* mod = WSP(float, WS_MOD) + ((size_t)l * 36 + row_bb(row)) * 6144 + (which ? 3072 : 0);
        f32x4 v[4]; float ss = 0.f;
#pragma unroll
        for (int j = 0; j < 4; ++j) { v[j] = *(const f32x4*)(xr + lane * 4 + 256 * j); ss += (v[j][0] * v[j][0] + v[j][1] * v[j][1]) + (v[j][2] * v[j][2] + v[j][3] * v[j][3]); }
        const float rs = 1.0f / sqrtf(wave_sum(ss) * (1.0f / DM) + EPS);
        bf16* o = WSP(bf16, WS_H) + (size_t)row * DM;
#pragma unroll
        for (int j = 0; j < 4; ++j) { const int c = lane * 4 + 256 * j; const f32x4 gg = *(const f32x4*)(g + c), sh = *(const f32x4*)(mod + c), sc = *(const f32x4*)(mod + 1024 + c);
            const f32x4 y = (v[j] * rs) * gg * (sc + 1.0f) + sh; v2u w; w.x = pk2(y[0], y[1]); w.y = pk2(y[2], y[3]); *(v2u*)(o + c) = w; }
    }
}
__device__ __forceinline__ void final_phase(Frame& F) {
    const int gw = F.bid * NWAVES + F.wave, NGW = F.G * NWAVES, lane = F.lane;
    const float* g = FIN(I_FNG);
    for (int row = gw; row < MT; row += NGW) {
        const float* xr = WSP(float, WS_X2) + (size_t)row * DM;
        f32x4 v[4]; float ss = 0.f;
#pragma unroll
        for (int j = 0; j < 4; ++j) { v[j] = *(const f32x4*)(xr + lane * 4 + 256 * j); ss += (v[j][0] * v[j][0] + v[j][1] * v[j][1]) + (v[j][2] * v[j][2] + v[j][3] * v[j][3]); }
        const float rs = 1.0f / sqrtf(wave_sum(ss) * (1.0f / DM) + EPS);
        float* o = F.out + OUT_Y + (size_t)row * DM;
#pragma unroll
        for (int j = 0; j < 4; ++j) { const int c = lane * 4 + 256 * j; *(f32x4*)(o + c) = (v[j] * rs) * *(const f32x4*)(g + c); }
    }
}

#define EPI_LOOP_BEGIN \
    _Pragma("unroll") for (int ai = 0; ai < 2; ++ai) _Pragma("unroll") for (int m = 0; m < 4; ++m) { const int row = u.pm * 256 + ai * 128 + wr * 64 + m * 16 + fr; \
    _Pragma("unroll") for (int bj = 0; bj < 2; ++bj) { const int ct = bj * 128 + wc * 32 + 8 * fq; const f32x4 v0 = acc[ai][bj][m][0], v1 = acc[ai][bj][m][1];
#define EPI_LOOP_END } }

struct EpiWin {
    static constexpr bool PERM = true, AFTER_DRAIN = false;
    unsigned char* ws; float* out; int l;
    __device__ __forceinline__ void operator()(const f32x4 (&acc)[2][2][4][2], const pg8::Unit& u, int wr, int wc, int fr0, int fq0) const {
        int fr = fr0, fq = fq0; asm volatile("" : "+v"(fr), "+v"(fq));
        const int pn = u.pn;
        if (pn < 2) {
            bf16* QN = (bf16*)(ws + WS_QN);
            EPI_LOOP_BEGIN *(v4u*)(QN + (size_t)row * 512 + pn * 256 + ct) = pack8(v0 * QSCALE, v1 * QSCALE); EPI_LOOP_END
        } else if (pn < 5) {
            EPI_LOOP_BEGIN
                const int c = (pn - 2) * 256 + ct, j = c >> 7, k = (c >> 6) & 1, d = c & 63;
                const bool isp = row < PM; const int b = isp ? (row >> 12) : ((row - PM) >> 3), t = isp ? (row & (PT - 1)) : ((row - PM) & 7);
                if (j < 4) { float* o = out + (isp ? OUT_ROWS_P + ((size_t)l * PM + row) * 512 : OUT_ROWS_S + ((size_t)l * SM + (row - PM)) * 512) + c; *(f32x4*)o = v0; *(f32x4*)(o + 4) = v1; }
                else if (isp) { if (t >= PT - WINB) { float* o = out + OUT_WIN_P + (((size_t)l * PB + b) * WINB + (t - (PT - WINB))) * 256 + (c - 512); *(f32x4*)o = v0; *(f32x4*)(o + 4) = v1; } }
                else { float* o = out + OUT_WIN_S + (((size_t)l * SB + b) * WINB + (WINB - ST) + t) * 256 + (c - 512); *(f32x4*)o = v0; *(f32x4*)(o + 4) = v1; }
                const v4u w = pack8(v0, v1);
                if (isp) {
                    if (j < 2) *(v4u*)((bf16*)(ws + WS_ACMP) + ((size_t)(l * 2 + j) * CMP_ROWS_J + 32768 + (b * 2 + k) * 256) * 1024 + (size_t)t * 64 + d) = w;
                    else *(v4u*)((bf16*)(ws + WS_KVB) + ((((size_t)(j - 2) * PB + b) * 2 + k) * PT + t) * 64 + d) = w;
                } else if (j >= 2) *(v4u*)((bf16*)(ws + WS_KVS) + ((((size_t)(j - 2) * SB + b) * 2 + k) * ST + t) * 64 + d) = w;
            EPI_LOOP_END
        } else if (pn < 9) {
            const float* ROTC = (const float*)(ws + WS_ROT); const float* ROTS = ROTC + 4104 * 64;
            EPI_LOOP_BEGIN
                const int c = (pn - 5) * 256 + ct, isk = c >> 9, hc = c & 511, head = hc >> 7, d0 = ((hc & 127) >> 3) * 4;
                const int pi = row_pos(row); const f32x4 cs = *(const f32x4*)(ROTC + pi * 64 + d0), sn = *(const f32x4*)(ROTS + pi * 64 + d0);
                const float sc = isk ? 0.08838834764831845f : 1.0f;
                const f32x4 o1 = (v0 * cs - v1 * sn) * sc, o2 = (v0 * sn + v1 * cs) * sc;
                bf16* o = (bf16*)(ws + WS_RQ) + (size_t)isk * MT * 512 + (size_t)row * 512 + head * 128 + d0;
                v2u w1; w1.x = pk2(o1[0], o1[1]); w1.y = pk2(o1[2], o1[3]); *(v2u*)o = w1;
                v2u w2; w2.x = pk2(o2[0], o2[1]); w2.y = pk2(o2[2], o2[3]); *(v2u*)(o + 64) = w2;
            EPI_LOOP_END
        } else if (pn < 13) {
            bf16* RV = (bf16*)(ws + WS_RQ) + (size_t)2 * MT * 512;
            EPI_LOOP_BEGIN const int c = (pn - 9) * 256 + ct; *(v4u*)(RV + (size_t)(c >> 9) * MT * 512 + (size_t)row * 512 + (c & 511)) = pack8(v0, v1); EPI_LOOP_END
        } else if (pn < 15) {
            float* RX = (float*)(ws + WS_RX);
            EPI_LOOP_BEGIN
                const int c = (pn - 13) * 256 + ct; float* o = RX + (size_t)row * 512 + c; *(f32x4*)o = v0; *(f32x4*)(o + 4) = v1;
                if (row < PM) { const int t = row & (PT - 1); if (t >= PT - 3) { float* q = out + OUT_CV_P + (((size_t)l * PB + (row >> 12)) * 3 + (t - (PT - 3))) * 512 + c; *(f32x4*)q = v0; *(f32x4*)(q + 4) = v1; } }
                else { const int i = (row - PM) & 7; if (i >= ST - 3) { float* q = out + OUT_CV_S + (((size_t)l * SB + ((row - PM) >> 3)) * 3 + (i - (ST - 3))) * 512 + c; *(f32x4*)q = v0; *(f32x4*)(q + 4) = v1; } }
            EPI_LOOP_END
        } else if (pn < 17) {
            bf16* GG = (bf16*)(ws + WS_GG);
            EPI_LOOP_BEGIN const int c = (pn - 15) * 256 + ct;
                f32x4 a, b;
#pragma unroll
                for (int i = 0; i < 4; ++i) { a[i] = gelu_tanh(v0[i]); b[i] = gelu_tanh(v1[i]); }
                *(v4u*)(GG + (size_t)row * 512 + c) = pack8(a, b); EPI_LOOP_END
        } else if (pn < 29) {
            bf16* MG = (bf16*)(ws + WS_MGS);
            EPI_LOOP_BEGIN const int c = (pn - 17) * 256 + ct;
                f32x4 a, b;
#pragma unroll
                for (int i = 0; i < 4; ++i) { a[i] = sigmoidf_(v0[i]); b[i] = sigmoidf_(v1[i]); }
                *(v4u*)(MG + (size_t)row * 3072 + c) = pack8(a, b); EPI_LOOP_END
        } else {
            float* NG = (float*)(ws + WS_NG);
            EPI_LOOP_BEGIN if (ct < 24) { f32x4 a, b;
#pragma unroll
                for (int i = 0; i < 4; ++i) { a[i] = sigmoidf_(v0[i]); b[i] = sigmoidf_(v1[i]); }
                float* o = NG + (size_t)row * 24 + ct; *(f32x4*)o = a; *(f32x4*)(o + 4) = b; } EPI_LOOP_END
        }
    }
};

struct EpiLH {
    static constexpr bool PERM = true, AFTER_DRAIN = false;
    bf16* LH;
    __device__ __forceinline__ void operator()(const f32x4 (&acc)[2][2][4][2], const pg8::Unit& u, int wr, int wc, int fr0, int fq0) const {
        int fr = fr0, fq = fq0; asm volatile("" : "+v"(fr), "+v"(fq));
        EPI_LOOP_BEGIN *(v4u*)(LH + (size_t)row * 256 + ct) = pack8(v0, v1); EPI_LOOP_END
    }
};
struct CmpOrder {
    int G, c;
    __device__ bool next(int i, pg8::Unit& u) const { const int L = i * G + c; if (L >= CMP_ROWS / 256) return false; u.pm = L; u.pn = L / (CMP_ROWS_J / 256); return true; }
    __device__ __forceinline__ void a_ready(const pg8::Unit&) const {}
    __device__ __forceinline__ void done(const pg8::Unit&) const {}
};

template <int BR> struct EpiBr {
    static constexpr bool PERM = true, AFTER_DRAIN = false;
    unsigned char* ws;
    __device__ __forceinline__ void operator()(const f32x4 (&acc)[2][2][4][2], const pg8::Unit& u, int wr, int wc, int fr0, int fq0) const {
        int fr = fr0, fq = fq0; asm volatile("" : "+v"(fr), "+v"(fq));
        const bf16* MG = (const bf16*)(ws + WS_MGS); bf16* MR = (bf16*)(ws + WS_MRG);
        EPI_LOOP_BEGIN
            const int col = u.pn * 256 + ct; f32x4 g0, g1; unpack8(*(const v4u*)(MG + (size_t)row * 3072 + BR * 1024 + col), g0, g1);
            f32x4 r0 = v0 * g0, r1 = v1 * g1; bf16* o = MR + (size_t)row * DM + col;
            if (BR > 0) { f32x4 p0, p1; unpack8(*(const v4u*)o, p0, p1); r0 += p0; r1 += p1; }
            *(v4u*)o = pack8(r0, r1);
        EPI_LOOP_END
    }
};

struct EpiRes {
    static constexpr bool PERM = true, AFTER_DRAIN = false;
    const float* xin_p; const float* xin_s; float* xout; const float* mod; int gofs;
    __device__ __forceinline__ void operator()(const f32x4 (&acc)[2][2][4][2], const pg8::Unit& u, int wr, int wc, int fr0, int fq0) const {
        int fr = fr0, fq = fq0; asm volatile("" : "+v"(fr), "+v"(fq));
        EPI_LOOP_BEGIN
            const int col = u.pn * 256 + ct; const float* xi = (xin_s && row >= PM) ? xin_s + (size_t)(row - PM) * DM + col : xin_p + (size_t)row * DM + col;
            const float* g = mod + (size_t)row_bb(row) * 6144 + gofs + col; float* o = xout + (size_t)row * DM + col;
            *(f32x4*)o = *(const f32x4*)xi + *(const f32x4*)g * v0; *(f32x4*)(o + 4) = *(const f32x4*)(xi + 4) + *(const f32x4*)(g + 4) * v1;
        EPI_LOOP_END
    }
};

struct EpiUp {
    static constexpr bool PERM = true, AFTER_DRAIN = false;
    unsigned char* ws; float* out; int l;
    __device__ __forceinline__ void operator()(const f32x4 (&acc)[2][2][4][2], const pg8::Unit& u, int wr, int wc, int fr0, int fq0) const {
        int fr = fr0, fq = fq0; asm volatile("" : "+v"(fr), "+v"(fq));
        bf16* GP = (bf16*)(ws + WS_GP); bf16* VAL = GP + (size_t)MT * DFF;
        if (u.pn < 11) {
            EPI_LOOP_BEGIN const int c = u.pn * 256 + ct; *(v4u*)(GP + (size_t)row * DFF + c) = pack8(v0, v1);
                if (row < PM) { const int t = row & (PT - 1); if (t >= PT - 2) { float* q = out + OUT_FC_P + (((size_t)l * PB + (row >> 12)) * 2 + (t - (PT - 2))) * DFF + c; *(f32x4*)q = v0; *(f32x4*)(q + 4) = v1; } }
                else { const int i = (row - PM) & 7; if (i >= ST - 2) { float* q = out + OUT_FC_S + (((size_t)l * SB + ((row - PM) >> 3)) * 2 + (i - (ST - 2))) * DFF + c; *(f32x4*)q = v0; *(f32x4*)(q + 4) = v1; } }
            EPI_LOOP_END
        } else {
            EPI_LOOP_BEGIN const int c = (u.pn - 11) * 256 + ct; *(v4u*)(VAL + (size_t)row * DFF + c) = pack8(v0, v1); EPI_LOOP_END
        }
    }
};

__device__ __forceinline__ f32x16 mfma32(bf16x8 a, bf16x8 b, f32x16 c) { return __builtin_amdgcn_mfma_f32_32x32x16_bf16(a, b, c, 0, 0, 0); }
__device__ __forceinline__ f32x4 mfma16(bf16x8 a, bf16x8 b, f32x4 c) { return __builtin_amdgcn_mfma_f32_16x16x32_bf16(a, b, c, 0, 0, 0); }
__device__ __forceinline__ float ret_log_g(int h) { return log1pf(-exp2f(-5.0f - (float)h)); }
__device__ __forceinline__ bf16x8 tr_frag(const LAS unsigned char* base, int rs_bytes, int rowA, int rowB, int colbase, int lane) {
    const int q = (lane & 15) >> 2, p = lane & 3;
    const LAS unsigned char* pa = base + (rowA + q) * rs_bytes + (colbase + 4 * p) * 2;
    const LAS unsigned char* pb = base + (rowB + q) * rs_bytes + (colbase + 4 * p) * 2;
    const s16x4 a = __builtin_bit_cast(s16x4, __builtin_amdgcn_ds_read_tr16_b64_v4i16((LAS s16x4*)pa));
    const s16x4 b = __builtin_bit_cast(s16x4, __builtin_amdgcn_ds_read_tr16_b64_v4i16((LAS s16x4*)pb));
    return (bf16x8){a[0], a[1], a[2], a[3], b[0], b[1], b[2], b[3]};
}
__device__ __forceinline__ bf16x8 cvt_frag(const f32x16& p, int s2) {
    u32x4 w; w.x = pk2(p[8 * s2 + 0], p[8 * s2 + 1]); w.y = pk2(p[8 * s2 + 2], p[8 * s2 + 3]); w.z = pk2(p[8 * s2 + 4], p[8 * s2 + 5]); w.w = pk2(p[8 * s2 + 6], p[8 * s2 + 7]);
    return __builtin_bit_cast(bf16x8, w);
}

__device__ __forceinline__ void cmp2_phase(Frame& F, int l) {
    const int gw = F.bid * NWAVES + F.wave, NGW = F.G * NWAVES, lane = F.lane, r = lane & 15, g = lane >> 4;
    const bf16* LH = WSP(bf16, WS_LH); bf16* CK = WSP(bf16, WS_CK);
    for (int wu = gw; wu < CMP_ROWS / 16; wu += NGW) {
        const int row0 = wu * 16, j = row0 / CMP_ROWS_J, rj = (row0 % CMP_ROWS_J) + r, row = row0 + r;
        const bool valid = (rj < 32768) ? ((rj & 511) < 511) : (((rj - 32768) & 255) < 255);
        const bf16* W2T = WSP(bf16, WS_SMALLW + SW_W2T) + (size_t)(l * 2 + j) * 64 * 128; const float* CB = WSP(float, WS_SMALLW + SW_CB) + (l * 2 + j) * 128;
        f32x4 acc[4];
#pragma unroll
        for (int ct = 0; ct < 4; ++ct) acc[ct] = (f32x4){0.f, 0.f, 0.f, 0.f};
#pragma unroll
        for (int ks = 0; ks < 4; ++ks) {
            const int h0 = 32 * ks + 8 * g; f32x4 a0, a1, b0, b1;
            unpack8(*(const v4u*)(LH + (size_t)row * 256 + h0), a0, a1); unpack8(*(const v4u*)(LH + (size_t)(row + 1) * 256 + 128 + h0), b0, b1);
            const f32x4 c0 = *(const f32x4*)(CB + h0), c1 = *(const f32x4*)(CB + h0 + 4);
            f32x4 x0 = a0 + b0 + c0, x1 = a1 + b1 + c1;
#pragma unroll
            for (int i = 0; i < 4; ++i) { x0[i] = gelu_tanh(x0[i]); x1[i] = gelu_tanh(x1[i]); }
            const bf16x8 hf = __builtin_bit_cast(bf16x8, pack8(x0, x1));
#pragma unroll
            for (int ct = 0; ct < 4; ++ct) { const bf16x8 wf = *(const bf16x8*)(W2T + (size_t)(16 * ct + r) * 128 + h0); acc[ct] = mfma16(wf, hf, acc[ct]); }
        }
#pragma unroll
        for (int ct = 0; ct < 4; ++ct) { const f32x4 v = valid ? acc[ct] : (f32x4){0.f, 0.f, 0.f, 0.f}; v2u w; w.x = pk2(v[0], v[1]); w.y = pk2(v[2], v[3]);
            *(v2u*)(CK + (size_t)row * 64 + 16 * ct + 4 * g) = w; }
    }
}

constexpr int RS_KV = 272;
__device__ __forceinline__ void ret_local_unit(Frame& F, int unit) {
    const int bh = unit >> 5, c = unit & 31, b = bh >> 2, h = bh & 3, lane = F.lane, w = F.wave;
    const float lg = ret_log_g(h);
    LAS unsigned char* KS = F.lds; LAS unsigned char* VS = F.lds + 128 * RS_KV;
    const bf16* RK = WSP(bf16, WS_RQ) + (size_t)MT * 512; const bf16* RV = WSP(bf16, WS_RQ) + (size_t)2 * MT * 512;
    __syncthreads();
#pragma unroll
    for (int i = 0; i < 4; ++i) { const int p = F.tid + NTHR * i, j = p >> 4, ch = p & 15; const size_t go = (size_t)(b * PT + 128 * c + j) * 512 + h * 128 + ch * 8;
        f32x4 k0, k1; unpack8(*(const v4u*)(RK + go), k0, k1); const float kw = fexp((float)(127 - j) * lg);
        *(LAS v4u*)(KS + j * RS_KV + ch * 16) = pack8(k0 * kw, k1 * kw);
        *(LAS v4u*)(VS + j * RS_KV + ch * 16) = *(const v4u*)(RV + go); }
    __syncthreads();
    const int et = w >> 1, dt0 = 2 * (w & 1), h_ = lane >> 5, blk = (lane >> 4) & 1;
    f32x16 acc[2]; acc[0] = (f32x16){}; acc[1] = (f32x16){};
#pragma unroll
    for (int ks = 0; ks < 8; ++ks) {
        const int rA = 16 * ks + 8 * h_;
        const bf16x8 af = tr_frag(VS, RS_KV, rA, rA + 4, 32 * et + 16 * blk, lane);
#pragma unroll
        for (int dd = 0; dd < 2; ++dd) { const bf16x8 bfr = tr_frag(KS, RS_KV, rA, rA + 4, 32 * (dt0 + dd) + 16 * blk, lane); acc[dd] = mfma32(af, bfr, acc[dd]); }
    }
    float* LT = WSP(float, WS_LT) + ((size_t)bh * 32 + c) * 16384;
#pragma unroll
    for (int dd = 0; dd < 2; ++dd)
#pragma unroll
        for (int r = 0; r < 16; ++r) { const int e = 32 * et + (r & 3) + 8 * (r >> 2) + 4 * h_; LT[e * 128 + 32 * (dt0 + dd) + (lane & 31)] = acc[dd][r]; }
}
__device__ __forceinline__ void ret_scan_phase(Frame& F, int l) {
    const float* LT = WSP(float, WS_LT); bf16* SPT = WSP(bf16, WS_SPT);
    for (int idx = F.bid * NTHR + F.tid; idx < 16 * 16384; idx += F.G * NTHR) {
        const int bh = idx >> 14, ed = idx & 16383, e = ed >> 7, d = ed & 127, h = bh & 3; const float g128 = fexp(128.0f * ret_log_g(h));
        float S = 0.f;
        for (int c = 0; c < 32; ++c) { const size_t o = ((size_t)bh * 32 + c) * 16384 + ed; SPT[o] = (bf16)(pk2(S, 0.f) & 0xffffu); S = S * g128 + LT[o]; }
        F.out[OUT_RET_P + ((size_t)l * 16 + bh) * 16384 + d * 128 + e] = S;
    }
}
__device__ __forceinline__ void ret_out_unit(Frame& F, int l, int unit) {
    const int bh = unit >> 5, c = unit & 31, b = bh >> 2, h = bh & 3, lane = F.lane, w = F.wave, tid = F.tid;
    const float lg = ret_log_g(h);
    LAS unsigned char* KS = F.lds; LAS unsigned char* VS = F.lds + 128 * RS_KV; LAS float* OT = (LAS float*)F.lds; LAS float* STAT = (LAS float*)(F.lds + 2 * 128 * RS_KV);
    const bf16* RQ = WSP(bf16, WS_RQ); const bf16* RK = RQ + (size_t)MT * 512; const bf16* RV = RQ + (size_t)2 * MT * 512; const bf16* RG = RQ + (size_t)3 * MT * 512;
    const size_t row0 = (size_t)b * PT + 128 * c;
    __syncthreads();
#pragma unroll
    for (int i = 0; i < 4; ++i) { const int p = tid + NTHR * i, j = p >> 4, ch = p & 15; const size_t go = (row0 + j) * 512 + h * 128 + ch * 8;
        *(LAS v4u*)(KS + j * RS_KV + ch * 16) = *(const v4u*)(RK + go); *(LAS v4u*)(VS + j * RS_KV + ch * 16) = *(const v4u*)(RV + go); }
    const int it = w & 3, eh = w >> 2, h_ = lane >> 5, blk = (lane >> 4) & 1, il = 32 * it + (lane & 31);
    bf16x8 qf[8];
#pragma unroll
    for (int ks = 0; ks < 8; ++ks) qf[ks] = *(const bf16x8*)(RQ + (row0 + il) * 512 + h * 128 + 16 * ks + 8 * h_);
    f32x16 acc[2]; acc[0] = (f32x16){}; acc[1] = (f32x16){};
    const bf16* SP = WSP(bf16, WS_SPT) + ((size_t)bh * 32 + c) * 16384;
#pragma unroll
    for (int ks = 0; ks < 8; ++ks)
#pragma unroll
        for (int e2 = 0; e2 < 2; ++e2) { const bf16x8 af = *(const bf16x8*)(SP + (size_t)(32 * (2 * eh + e2) + (lane & 31)) * 128 + 16 * ks + 8 * h_); acc[e2] = mfma32(af, qf[ks], acc[e2]); }
    { const float cr = fexp((float)(il + 1) * lg); acc[0] *= cr; acc[1] *= cr; }
    __syncthreads();
    for (int jt = 0; jt <= it; ++jt) {
        f32x16 s = (f32x16){};
#pragma unroll
        for (int ks = 0; ks < 8; ++ks) { const bf16x8 kf = *(const LAS bf16x8*)(KS + (32 * jt + (lane & 31)) * RS_KV + (16 * ks + 8 * h_) * 2); s = mfma32(kf, qf[ks], s); }
#pragma unroll
        for (int r = 0; r < 16; ++r) { const int j = 32 * jt + (r & 3) + 8 * (r >> 2) + 4 * h_; const int df = il - j; s[r] = (df >= 0) ? s[r] * fexp((float)df * lg) : 0.f; }
#pragma unroll
        for (int s2 = 0; s2 < 2; ++s2) { const bf16x8 pf = cvt_frag(s, s2); const int rA = 32 * jt + 16 * s2 + 4 * h_;
#pragma unroll
            for (int e2 = 0; e2 < 2; ++e2) { const bf16x8 vf = tr_frag(VS, RS_KV, rA, rA + 8, 32 * (2 * eh + e2) + 16 * blk, lane); acc[e2] = mfma32(vf, pf, acc[e2]); } }
    }
    float s1 = 0.f, s2 = 0.f;
#pragma unroll
    for (int e2 = 0; e2 < 2; ++e2)
#pragma unroll
        for (int r = 0; r < 16; ++r) { const float v = acc[e2][r]; s1 += v; s2 += v * v; }
    s1 += __shfl_xor(s1, 32); s2 += __shfl_xor(s2, 32);
    if (lane < 32) { STAT[(w * 32 + lane) * 2] = s1; STAT[(w * 32 + lane) * 2 + 1] = s2; }
    __syncthreads();
    { const int pw = w ^ 4; s1 += STAT[(pw * 32 + (lane & 31)) * 2]; s2 += STAT[(pw * 32 + (lane & 31)) * 2 + 1]; }
    const float mean = s1 * (1.0f / 128.0f), var = fmaxf(s2 * (1.0f / 128.0f) - mean * mean, 0.f), rstd = 1.0f / sqrtf(var + EPS);
#pragma unroll
    for (int e2 = 0; e2 < 2; ++e2)
#pragma unroll
        for (int r4 = 0; r4 < 4; ++r4) { const int e = 32 * (2 * eh + e2) + 8 * r4 + 4 * h_;
            f32x4 v; v[0] = (acc[e2][4 * r4 + 0] - mean) * rstd; v[1] = (acc[e2][4 * r4 + 1] - mean) * rstd; v[2] = (acc[e2][4 * r4 + 2] - mean) * rstd; v[3] = (acc[e2][4 * r4 + 3] - mean) * rstd;
            *(LAS f32x4*)(OT + il * 132 + e) = v; }
    __syncthreads();
    const float* GN = FIN(I_GNG) + l * 512 + h * 128; bf16* OR_ = WSP(bf16, WS_OA) + (size_t)MT * 512;
#pragma unroll
    for (int k = 0; k < 4; ++k) { const int q = tid + NTHR * k, i = q >> 4, ch = q & 15;
        const f32x4 o0 = *(const LAS f32x4*)(OT + i * 132 + 8 * ch), o1 = *(const LAS f32x4*)(OT + i * 132 + 8 * ch + 4);
        const f32x4 g0 = *(const f32x4*)(GN + 8 * ch), g1 = *(const f32x4*)(GN + 8 * ch + 4); f32x4 r0, r1; unpack8(*(const v4u*)(RG + (row0 + i) * 512 + h * 128 + 8 * ch), r0, r1);
        f32x4 y0, y1;
#pragma unroll
        for (int x = 0; x < 4; ++x) { y0[x] = o0[x] * g0[x] * siluf_(r0[x]); y1[x] = o1[x] * g1[x] * siluf_(r1[x]); }
        *(v4u*)(OR_ + (row0 + i) * 512 + h * 128 + 8 * ch) = pack8(y0, y1); }
}
__device__ __forceinline__ void ret_sample_unit(Frame& F, int l, int unit) {
    const int db = unit >> 2, h = unit & 3, tid = F.tid, e = tid & 127, dp = tid >> 7;
    const float lg = ret_log_g(h);
    LAS float* Q = (LAS float*)F.lds; LAS float* K = Q + 1024; LAS float* V = K + 1024; LAS float* GT = V + 1024; LAS float* CR = GT + 1024;
    LAS float* SC = CR + 4096; LAS float* RED = SC + 64;
    const bf16* RQ = WSP(bf16, WS_RQ); const size_t row0 = (size_t)PM + db * 8;
    __syncthreads();
    for (int i = tid; i < 4096; i += NTHR) { const int which = i >> 10, r = (i >> 7) & 7, d = i & 127; const float v = bf1(RQ[(size_t)which * MT * 512 + (row0 + r) * 512 + h * 128 + d]); Q[which * 1024 + r * 128 + d] = v; }
    __syncthreads();
    const float* S0 = FIN(I_SRET) + (((size_t)l * SB + db) * 4 + h) * 16384; float* SN = F.out + OUT_RET_S + (((size_t)l * SB + db) * 4 + h) * 16384;
    float kwv[8], cr[8];
#pragma unroll
    for (int j = 0; j < 8; ++j) { kwv[j] = V[j * 128 + e] * fexp((float)(7 - j) * lg); cr[j] = 0.f; }
    const float g8 = fexp(8.0f * lg);
    for (int d = dp * 32; d < dp * 32 + 32; ++d) {
        const float s0 = S0[d * 128 + e]; float sn = g8 * s0;
#pragma unroll
        for (int j = 0; j < 8; ++j) { cr[j] += Q[j * 128 + d] * s0; sn += K[j * 128 + d] * kwv[j]; }
        SN[d * 128 + e] = sn;
    }
#pragma unroll
    for (int i = 0; i < 8; ++i) CR[(dp * 8 + i) * 128 + e] = cr[i];
    if (tid < 64) { const int i = tid >> 3, j = tid & 7; float s = 0.f; if (j <= i) { for (int d = 0; d < 128; ++d) s += Q[i * 128 + d] * K[j * 128 + d]; s *= fexp((float)(i - j) * lg); } SC[tid] = s; }
    __syncthreads();
    float o[2];
#pragma unroll
    for (int ii = 0; ii < 2; ++ii) { const int i = 2 * dp + ii; float x = (CR[(0 * 8 + i) * 128 + e] + CR[(1 * 8 + i) * 128 + e] + CR[(2 * 8 + i) * 128 + e] + CR[(3 * 8 + i) * 128 + e]) * fexp((float)(i + 1) * lg);
        for (int j = 0; j <= i; ++j) x += SC[i * 8 + j] * V[j * 128 + e];
        o[ii] = x; }
#pragma unroll
    for (int ii = 0; ii < 2; ++ii) { const float a = wave_sum(o[ii]), q = wave_sum(o[ii] * o[ii]); if (F.lane == 0) { RED[(F.wave * 2 + ii) * 2] = a; RED[(F.wave * 2 + ii) * 2 + 1] = q; } }
    __syncthreads();
    const float* GN = FIN(I_GNG) + l * 512 + h * 128; bf16* OR_ = WSP(bf16, WS_OA) + (size_t)MT * 512;
#pragma unroll
    for (int ii = 0; ii < 2; ++ii) { const int i = 2 * dp + ii, w0 = 2 * dp; const float s1 = RED[(w0 * 2 + ii) * 2] + RED[((w0 + 1) * 2 + ii) * 2], s2 = RED[(w0 * 2 + ii) * 2 + 1] + RED[((w0 + 1) * 2 + ii) * 2 + 1];
        const float mean = s1 * (1.0f / 128.0f), var = fmaxf(s2 * (1.0f / 128.0f) - mean * mean, 0.f), rstd = 1.0f / sqrtf(var + EPS);
        const float y = (o[ii] - mean) * rstd * GN[e] * siluf_(GT[i * 128 + e]);
        OR_[(row0 + i) * 512 + h * 128 + e] = (bf16)(pk2(y, 0.f) & 0xffffu); }
}

template <int MODE> __device__ __forceinline__ void rglru_unit(Frame& F, int l, int unit) {
    const int tid = F.tid, c = tid, lane = F.lane, w = F.wave;
    LAS bf16* XC = (LAS bf16*)F.lds; LAS float* G = (LAS float*)(F.lds + 16384);
    const int seq = (MODE == 2) ? unit : (unit >> 6), tile = (MODE == 2) ? 0 : (unit & 63);
    const size_t row0 = (MODE == 2) ? (size_t)PM + seq * 8 : (size_t)seq * PT + tile * 64;
    const int ntok = (MODE == 2) ? 8 : 64, nsub = (MODE == 2) ? 1 : 4;
    const float* RX = WSP(float, WS_RX);
    const float w0 = FIN(I_RCW)[(l * 4 + 0) * 512 + c], w1 = FIN(I_RCW)[(l * 4 + 1) * 512 + c], w2 = FIN(I_RCW)[(l * 4 + 2) * 512 + c], w3 = FIN(I_RCW)[(l * 4 + 3) * 512 + c], cb = FIN(I_RCB)[l * 512 + c];
    const float ba = FIN(I_RBA)[l * 512 + c], bx = FIN(I_RBX)[l * 512 + c], sp = WSP(float, WS_SMALLW + SW_SP)[l * 512 + c];
    float x3, x2, x1;
    if (MODE == 2) { const float* cv = FIN(I_SCONV) + ((size_t)l * SB + seq) * 3 * 512; x3 = cv[c]; x2 = cv[512 + c]; x1 = cv[1024 + c]; }
    else if (tile == 0) { x3 = 0.f; x2 = 0.f; x1 = 0.f; }
    else { x3 = RX[(row0 - 3) * 512 + c]; x2 = RX[(row0 - 2) * 512 + c]; x1 = RX[(row0 - 1) * 512 + c]; }
    float h = (MODE == 0) ? 0.f : (MODE == 1) ? WSP(float, WS_CAR)[(size_t)4 * 64 * 2 * 512 + ((size_t)seq * 64 + tile) * 512 + c] : FIN(I_SH)[((size_t)l * SB + seq) * 512 + c];
    float aprod = 1.f;
    const int r16 = lane & 15, g4 = lane >> 4;
    bf16x8 wa[4][2], wx[4][2];
    { const bf16* WA = WSP(bf16, WS_SMALLW + SW_WAT) + ((size_t)(l * 2 + 0) * 8 + w) * 4096; const bf16* WX = WSP(bf16, WS_SMALLW + SW_WAT) + ((size_t)(l * 2 + 1) * 8 + w) * 4096;
#pragma unroll
      for (int ct = 0; ct < 4; ++ct)
#pragma unroll
          for (int ks = 0; ks < 2; ++ks) { wa[ct][ks] = *(const bf16x8*)(WA + (16 * ct + r16) * 64 + 32 * ks + 8 * g4); wx[ct][ks] = *(const bf16x8*)(WX + (16 * ct + r16) * 64 + 32 * ks + 8 * g4); } }
    const bf16* GG = WSP(bf16, WS_GG); bf16* OC = WSP(bf16, WS_OA) + (size_t)2 * MT * 512;
    __syncthreads();
    for (int s = 0; s < nsub; ++s) {
        float xc[16], gg[16];
#pragma unroll
        for (int tt = 0; tt < 16; ++tt) { const int t = s * 16 + tt; xc[tt] = (t < ntok) ? RX[(row0 + t) * 512 + c] : 0.f; gg[tt] = (MODE != 0 && t < ntok) ? bf1(GG[(row0 + t) * 512 + c]) : 0.f; }
#pragma unroll
        for (int tt = 0; tt < 16; ++tt) { const float x0 = xc[tt];
            xc[tt] = cb + w0 * x3 + w1 * x2 + w2 * x1 + w3 * x0; x3 = x2; x2 = x1; x1 = x0; XC[tt * 512 + c] = (bf16)(pk2(xc[tt], 0.f) & 0xffffu); }
        __syncthreads();
        {
            bf16x8 xf[2];
#pragma unroll
            for (int ks = 0; ks < 2; ++ks) xf[ks] = *(const LAS bf16x8*)(XC + r16 * 512 + w * 64 + 32 * ks + 8 * g4);
#pragma unroll
            for (int ct = 0; ct < 4; ++ct) { f32x4 da = (f32x4){0.f, 0.f, 0.f, 0.f}, dx = da;
#pragma unroll
                for (int ks = 0; ks < 2; ++ks) { da = mfma16(wa[ct][ks], xf[ks], da); dx = mfma16(wx[ct][ks], xf[ks], dx); }
                *(LAS f32x4*)(G + r16 * 512 + w * 64 + 16 * ct + 4 * g4) = da; *(LAS f32x4*)(G + 8192 + r16 * 512 + w * 64 + 16 * ct + 4 * g4) = dx; }
        }
        __syncthreads();
#pragma unroll
        for (int tt = 0; tt < 16; ++tt) { const int t = s * 16 + tt;
            if (t < ntok) {
                const float r = sigmoidf_(G[tt * 512 + c] + ba), ig = sigmoidf_(G[8192 + tt * 512 + c] + bx);
                const float la = -8.0f * r * sp, a = expf(la), bt = sqrtf(-expm1f(2.0f * la)) * (ig * xc[tt]);
                h = a * h + bt; aprod *= a;
                if (MODE != 0) { const size_t o = (row0 + t) * 512 + c; OC[o] = (bf16)(pk2(h * gg[tt], 0.f) & 0xffffu); }
            } }
    }
    if (MODE == 0) { float* CAR = WSP(float, WS_CAR) + ((size_t)seq * 64 + tile) * 1024; CAR[c] = aprod; CAR[512 + c] = h; }
    if (MODE == 2) F.out[OUT_H_S + ((size_t)l * SB + seq) * 512 + c] = h;
}
__device__ __forceinline__ void rglru_carry_phase(Frame& F, int l) {
    const float* CAR = WSP(float, WS_CAR); float* HIN = WSP(float, WS_CAR) + (size_t)4 * 64 * 2 * 512;
    for (int idx = F.bid * NTHR + F.tid; idx < PB * 512; idx += F.G * NTHR) {
        const int b = idx >> 9, c = idx & 511; float h = 0.f;
        for (int t = 0; t < 64; ++t) { HIN[((size_t)b * 64 + t) * 512 + c] = h; const float* cr = CAR + ((size_t)b * 64 + t) * 1024; h = cr[c] * h + cr[512 + c]; }
        F.out[OUT_H_P + ((size_t)l * PB + b) * 512 + c] = h;
    }
}

__device__ __forceinline__ void convact_phase(Frame& F, int l) {
    const bf16* GP = WSP(bf16, WS_GP); const bf16* VAL = GP + (size_t)MT * DFF; bf16* ACT = WSP(bf16, WS_GP) + (size_t)2 * MT * DFF;
    const float* CW = FIN(I_FCW) + (size_t)l * 3 * DFF; const float* CBI = FIN(I_FCB) + (size_t)l * DFF;
    constexpr int NRUN = PM / 16 + SB, NCG = DFF / 8;
    for (int it = F.bid * NTHR + F.tid; it < NRUN * NCG; it += F.G * NTHR) {
        const int run = it / NCG, cg = it % NCG, c = cg * 8;
        const bool isp = run < PM / 16; const size_t row0 = isp ? (size_t)run * 16 : (size_t)PM + (run - PM / 16) * 8; const int nt = isp ? 16 : 8;
        f32x4 p2a, p2b, p1a, p1b;
        if (isp) { if ((run & 255) == 0) { p2a = p2b = p1a = p1b = (f32x4){0.f, 0.f, 0.f, 0.f}; } else { unpack8(*(const v4u*)(GP + (row0 - 2) * DFF + c), p2a, p2b); unpack8(*(const v4u*)(GP + (row0 - 1) * DFF + c), p1a, p1b); } }
        else { const float* st = FIN(I_SFFN) + (((size_t)l * SB + (run - PM / 16)) * 2) * DFF + c; p2a = *(const f32x4*)st; p2b = *(const f32x4*)(st + 4); p1a = *(const f32x4*)(st + DFF); p1b = *(const f32x4*)(st + DFF + 4); }
        const f32x4 w0a = *(const f32x4*)(CW + c), w0b = *(const f32x4*)(CW + c + 4), w1a = *(const f32x4*)(CW + DFF + c), w1b = *(const f32x4*)(CW + DFF + c + 4), w2a = *(const f32x4*)(CW + 2 * DFF + c), w2b = *(const f32x4*)(CW + 2 * DFF + c + 4);
        const f32x4 ba = *(const f32x4*)(CBI + c), bb = *(const f32x4*)(CBI + c + 4);
        for (int t0 = 0; t0 < nt; t0 += 8) {
            v4u gx[8], vx[8];
#pragma unroll
            for (int k = 0; k < 8; ++k) { gx[k] = *(const v4u*)(GP + (row0 + t0 + k) * DFF + c); vx[k] = *(const v4u*)(VAL + (row0 + t0 + k) * DFF + c); }
#pragma unroll
            for (int k = 0; k < 8; ++k) {
                f32x4 xa, xb, va, vb; unpack8(gx[k], xa, xb); unpack8(vx[k], va, vb);
                f32x4 ya = ba + w0a * p2a + w1a * p1a + w2a * xa, yb = bb + w0b * p2b + w1b * p1b + w2b * xb;
#pragma unroll
                for (int i = 0; i < 4; ++i) { ya[i] = siluf_(ya[i]) * va[i]; yb[i] = siluf_(yb[i]) * vb[i]; }
                *(v4u*)(ACT + (row0 + t0 + k) * DFF + c) = pack8(ya, yb);
                p2a = p1a; p2b = p1b; p1a = xa; p1b = xb;
            }
        }
    }
}

constexpr int AT_RS = 144;
constexpr int AT_K0 = 0, AT_V0 = 2 * 64 * AT_RS, AT_PS = 4 * 64 * AT_RS, AT_IMP = AT_PS + 69632, AT_MASK = AT_IMP + 6144, AT_LIST = AT_MASK + 2048, AT_NL = AT_LIST + 1024;
constexpr unsigned AT_MARK = 0xFFFFu;
static_assert(AT_NL + 64 <= RING_BYTES, "attention LDS map");

struct TileRegs { v4u a, b, c, d; int mode; };

template <bool SMP> __device__ __forceinline__ void at_prefetch(const Frame& F, int l, int seq, int kvh, unsigned e, TileRegs& R) {
    const int kind = (int)(e >> 14), ti = (int)(e & 0x3fffu), rr = F.tid >> 3, pc = F.tid & 7;
    R.mode = 0;
    if (kind < 2) {
        const size_t rb = SMP ? (size_t)(seq * 2 + kvh) * 512 : (size_t)32768 + (size_t)(seq * 2 + kvh) * 256;
        const bf16* ck = WSP(bf16, WS_CK) + (rb + ti * 64 + rr) * 64 + pc * 8;
        R.a = *(const v4u*)ck; R.c = *(const v4u*)(ck + (size_t)CMP_ROWS_J * 64);
    } else if (!SMP) {
        const int jb = (kind == 2) ? 0 : 2;
        const bf16* kp = WSP(bf16, WS_KVB) + ((((size_t)jb * PB + seq) * 2 + kvh) * PT + ti * 64 + rr) * 64 + pc * 8;
        R.a = *(const v4u*)kp; R.c = *(const v4u*)(kp + (size_t)PB * 2 * PT * 64);
    } else if (kind == 2) {
        if (ti < 128) {
            const int page = ((const int*)F.a->in[I_PT])[seq * NPG + (ti >> 1)], slot = (ti & 1) * 64 + rr;
            const float* kp = FIN(I_CACHE) + (((((size_t)l * NPHYS + page) * PAGE + slot) * 4 + 2) * 2 + kvh) * 64 + pc * 8;
            R.a = *(const v4u*)kp; R.b = *(const v4u*)(kp + 4); R.c = *(const v4u*)(kp + 128); R.d = *(const v4u*)(kp + 132); R.mode = 1;
        } else if (rr < ST) {
            const bf16* kp = WSP(bf16, WS_KVS) + ((((size_t)0 * SB + seq) * 2 + kvh) * ST + rr) * 64 + pc * 8;
            R.a = *(const v4u*)kp; R.c = *(const v4u*)(kp + (size_t)SB * 2 * ST * 64);
        } else R.mode = 2;
    } else {
        if (ti < 8) {
            const float* kp = FIN(I_CWIN) + (((((size_t)l * SB + seq) * WINB + ti * 64 + rr) * 2 + 0) * 2 + kvh) * 64 + pc * 8;
            R.a = *(const v4u*)kp; R.b = *(const v4u*)(kp + 4); R.c = *(const v4u*)(kp + 128); R.d = *(const v4u*)(kp + 132); R.mode = 1;
        } else if (rr < ST) {
            const bf16* kp = WSP(bf16, WS_KVS) + ((((size_t)2 * SB + seq) * 2 + kvh) * ST + rr) * 64 + pc * 8;
            R.a = *(const v4u*)kp; R.c = *(const v4u*)(kp + (size_t)SB * 2 * ST * 64);
        } else R.mode = 2;
    }
}
__device__ __forceinline__ void at_store(const Frame& F, int buf, const TileRegs& R) {
    const int rr = F.tid >> 3, pc = F.tid & 7; v4u k, v;
    if (R.mode == 0) { k = R.a; v = R.c; }
    else if (R.mode == 1) { k = pack8(__builtin_bit_cast(f32x4, R.a), __builtin_bit_cast(f32x4, R.b)); v = pack8(__builtin_bit_cast(f32x4, R.c), __builtin_bit_cast(f32x4, R.d)); }
    else { k = (v4u){0u, 0u, 0u, 0u}; v = k; }
    *(LAS v4u*)(F.lds + AT_K0 + buf * 64 * AT_RS + rr * AT_RS + pc * 16) = k;
    *(LAS v4u*)(F.lds + AT_V0 + buf * 64 * AT_RS + rr * AT_RS + pc * 16) = v;
}

template <bool SMP> __device__ __forceinline__ void attn_unit(Frame& F, int l, int unit) {
    const int tid = F.tid, lane = F.lane, w = F.wave;
    const int q = lane & 31, h_ = lane >> 5, blk = (lane >> 4) & 1, tl = q >> 2, hr = q & 3;
    int seq, kvh, qt;
    if (SMP) { seq = unit >> 1; kvh = unit & 1; qt = 128; } else { seq = unit >> 7; kvh = (unit >> 6) & 1; qt = unit & 63; }
    const int t0 = SMP ? PAST : qt * 64;
    const int tokl = SMP ? tl : 8 * w + tl, t = t0 + tokl;
    const size_t row = SMP ? (size_t)PM + seq * ST + tl : (size_t)seq * PT + t;
    const int head = kvh * 4 + hr;
    LAS float* PS = (LAS float*)(F.lds + AT_PS); LAS float* IMPw = (LAS float*)(F.lds + AT_IMP) + w * 192;
    LAS unsigned long long* MASKS = (LAS unsigned long long*)(F.lds + AT_MASK); LAS unsigned short* LIST = (LAS unsigned short*)(F.lds + AT_LIST); LAS int* NL = (LAS int*)(F.lds + AT_NL);
    constexpr int PSS = SMP ? 520 : 264;
    LAS float* PSw = SMP ? PS : PS + w * 8 * PSS;
    __syncthreads();
    bf16x8 qf[4];
    { const bf16* qp = WSP(bf16, WS_QN) + row * 512 + head * 64 + 8 * h_;
#pragma unroll
      for (int kk = 0; kk < 4; ++kk) qf[kk] = *(const bf16x8*)(qp + 16 * kk); }
    const float* ngp = WSP(float, WS_NG) + row * 24 + head * 3; const float g0 = ngp[0], g1 = ngp[1], g2 = ngp[2];
    if (!SMP) { for (int i = lane; i < 8 * PSS; i += 64) PSw[i] = 0.f; }
    const int ntc = SMP ? 8 : ((t0 + 32) >> 10) + 1;
    if (tid < 2 * ntc) LIST[tid] = (unsigned short)(((tid >= ntc ? 1u : 0u) << 14) | (unsigned)(tid >= ntc ? tid - ntc : tid));
    if (tid == 0) LIST[2 * ntc] = (unsigned short)AT_MARK;
    int nl = 2 * ntc + 1;
    TileRegs R;
    at_prefetch<SMP>(F, l, seq, kvh, (unsigned)0, R);
    at_store(F, 0, R);
    __syncthreads();
    float m = -INFINITY, lsum = 0.f, invden = 0.f;
    f32x16 O[2]; O[0] = (f32x16){}; O[1] = (f32x16){};
    LAS float* OAw = (LAS float*)(F.lds + AT_PS) + w * (SMP ? 2048 : 8 * PSS) + lane;
    unsigned long long mk0 = 0ull, mk1 = 0ull, wu = ~0ull;
    int cur_kind = -1, idx = 0;
#define AT_FINALIZE(kind) do { \
        if ((kind) == 0) { const float lt = lsum + __shfl_xor(lsum, 32); invden = lt > 0.f ? 1.0f / lt : 0.f; } \
        else if ((kind) == 1) { const float sc = g0 * invden; O[0] *= sc; O[1] *= sc; } \
        else if ((kind) == 2) { const float lt = lsum + __shfl_xor(lsum, 32); const float sc = (lt > 0.f ? 1.0f / lt : 0.f) * g1; \
            _Pragma("unroll") for (int r_ = 0; r_ < 16; ++r_) { OAw[r_ * 64] += O[0][r_] * sc; OAw[(16 + r_) * 64] += O[1][r_] * sc; } } } while (0)
    while (idx < nl) {
        const unsigned e = (unsigned)__builtin_amdgcn_readfirstlane((int)LIST[idx]);
        if (e == AT_MARK) {
            AT_FINALIZE(cur_kind); cur_kind = -1;
            LDS_WAIT(); asm volatile("" ::: "memory");
#pragma unroll 1
            for (int tk = 0; tk < 8; ++tk) {
                const LAS float* pr = PSw + tk * PSS;
                if (!SMP) {
                    const int s = lane; float imp = 0.f;
#pragma unroll
                    for (int n = 4 * s - 1; n <= 4 * s + 3; ++n) if (n >= 0) imp += pr[n];
                    const bool forced = (s == 0) || (s == qt) || (s == qt - 1), avail = s <= qt;
                    const float val = avail ? (forced ? 1e4f : imp) : -1e4f;
                    IMPw[s] = val; LDS_WAIT(); asm volatile("" ::: "memory");
                    int rank = 0;
#pragma unroll 8
                    for (int i = 0; i < 64; ++i) { const float v = IMPw[i]; rank += (v > val || (v == val && i < s)) ? 1 : 0; }
                    const unsigned long long mk = __ballot(rank < 16);
                    if (lane == 0) MASKS[(8 * w + tk) * 4] = mk;
                    LDS_WAIT(); asm volatile("" ::: "memory");
                } else {
                    const int sa = lane, sb = lane + 64; float ia = 0.f, ib = 0.f;
#pragma unroll
                    for (int n = 4 * sa - 1; n <= 4 * sa + 3; ++n) if (n >= 0) ia += pr[n];
#pragma unroll
                    for (int n = 4 * sb - 1; n <= 4 * sb + 3; ++n) ib += pr[n];
                    const bool fa = (sa == 0), fb = (sb == 127);
                    const float va = fa ? 1e4f : ia, vb = fb ? 1e4f : ib;
                    IMPw[sa] = va; IMPw[sb] = vb; LDS_WAIT(); asm volatile("" ::: "memory");
                    int ra = fa ? 0 : 1, rb = fb ? 0 : 1;
#pragma unroll 8
                    for (int i = 0; i < 128; ++i) { const float v = IMPw[i]; ra += (v > va || (v == va && i < sa)) ? 1 : 0; rb += (v > vb || (v == vb && i < sb)) ? 1 : 0; }
                    const unsigned long long ma = __ballot(ra < 16), mb = __ballot(rb < 16);
                    if (lane == 0) { MASKS[tk * 4] = ma; MASKS[tk * 4 + 1] = mb; MASKS[tk * 4 + 2] = 1ull; }
                    LDS_WAIT(); asm volatile("" ::: "memory");
                }
            }
            __syncthreads();
#pragma unroll
            for (int r_ = 0; r_ < 16; ++r_) { OAw[r_ * 64] = O[0][r_]; OAw[(16 + r_) * 64] = O[1][r_]; }
            if (tid == 0) {
                int n = idx + 1;
                if (!SMP) { unsigned long long U = 0ull; for (int i = 0; i < 64; ++i) U |= MASKS[i * 4];
                    for (int s = 0; s <= qt; ++s) if ((U >> s) & 1ull) LIST[n++] = (unsigned short)((2u << 14) | (unsigned)s);
                    for (int s = (qt > 8 ? qt - 8 : 0); s <= qt; ++s) LIST[n++] = (unsigned short)((3u << 14) | (unsigned)s);
                } else { unsigned long long U0 = 0ull, U1 = 0ull; for (int i = 0; i < 8; ++i) { U0 |= MASKS[i * 4]; U1 |= MASKS[i * 4 + 1]; }
                    for (int s = 0; s < 64; ++s) if ((U0 >> s) & 1ull) LIST[n++] = (unsigned short)((2u << 14) | (unsigned)s);
                    for (int s = 0; s < 64; ++s) if ((U1 >> s) & 1ull) LIST[n++] = (unsigned short)((2u << 14) | (unsigned)(64 + s));
                    LIST[n++] = (unsigned short)((2u << 14) | 128u);
                    for (int s = 0; s <= 8; ++s) LIST[n++] = (unsigned short)((3u << 14) | (unsigned)s); }
                NL[0] = n;
            }
            __syncthreads();
            nl = __builtin_amdgcn_readfirstlane(NL[0]);
            mk0 = MASKS[tokl * 4]; if (SMP) { mk1 = MASKS[tokl * 4 + 1]; }
            if (!SMP) { unsigned long long u = 0ull; for (int i = 0; i < 8; ++i) u |= MASKS[(8 * w + i) * 4]; wu = u; }
            if (idx + 1 < nl) { at_prefetch<SMP>(F, l, seq, kvh, (unsigned)LIST[idx + 1], R); at_store(F, (idx + 1) & 1, R); }
            __syncthreads();
            ++idx; continue;
        }
        const int kind = (int)(e >> 14), ti = (int)(e & 0x3fffu);
        if (kind != cur_kind) {
            if (cur_kind >= 0) AT_FINALIZE(cur_kind);
            if (kind != 1) m = -INFINITY;
            lsum = 0.f; O[0] = (f32x16){}; O[1] = (f32x16){}; cur_kind = kind;
        }
        const unsigned en = (idx + 1 < nl) ? (unsigned)__builtin_amdgcn_readfirstlane((int)LIST[idx + 1]) : AT_MARK;
        const bool have_next = (en != AT_MARK);
        if (have_next) at_prefetch<SMP>(F, l, seq, kvh, en, R);
        bool active = true;
        if (!SMP && kind == 2) active = ((wu >> ti) & 1ull) != 0ull;
        if (active) {
            const LAS unsigned char* Kb = F.lds + AT_K0 + (idx & 1) * 64 * AT_RS; const LAS unsigned char* Vb = F.lds + AT_V0 + (idx & 1) * 64 * AT_RS;
            int lo, hi; const int kb = 64 * ti;
            if (kind < 2) { lo = 0; hi = SMP ? 510 : ((t >= 31) ? ((t - 31) >> 4) : -1); }
            else if (kind == 2) { lo = 0; const unsigned long long mw = (ti < 64) ? mk0 : ((ti < 128) ? mk1 : 1ull); hi = ((mw >> (ti & 63)) & 1ull) ? t : -1; }
            else { if (SMP) { lo = tl; hi = WINB + tl; } else { lo = t - WINB; hi = t; } }
            f32x16 s0 = (f32x16){}, s1 = (f32x16){};
#pragma unroll
            for (int kk = 0; kk < 4; ++kk) {
                const bf16x8 k0 = *(const LAS bf16x8*)(Kb + q * AT_RS + (16 * kk + 8 * h_) * 2), k1 = *(const LAS bf16x8*)(Kb + (32 + q) * AT_RS + (16 * kk + 8 * h_) * 2);
                s0 = mfma32(k0, qf[kk], s0); s1 = mfma32(k1, qf[kk], s1);
            }
            float tmax = -INFINITY;
#pragma unroll
            for (int r = 0; r < 16; ++r) { const int key = kb + (r & 3) + 8 * (r >> 2) + 4 * h_;
                s0[r] = (key >= lo && key <= hi) ? s0[r] : -INFINITY; s1[r] = (key + 32 >= lo && key + 32 <= hi) ? s1[r] : -INFINITY;
                tmax = fmaxf(tmax, fmaxf(s0[r], s1[r])); }
            tmax = fmaxf(tmax, __shfl_xor(tmax, 32));
            const float m_new = fmaxf(m, tmax), m_use = (m_new == -INFINITY) ? 0.f : m_new;
            const float alpha = fexp2(m - m_use);
            float ps = 0.f;
#pragma unroll
            for (int r = 0; r < 16; ++r) { s0[r] = fexp2(s0[r] - m_use); s1[r] = fexp2(s1[r] - m_use); ps += s0[r] + s1[r]; }
            lsum = lsum * alpha + ps; m = m_new;
            if (kind != 0) {
                O[0] *= alpha; O[1] *= alpha;
#pragma unroll
                for (int kt2 = 0; kt2 < 2; ++kt2)
#pragma unroll
                    for (int s2 = 0; s2 < 2; ++s2) { const bf16x8 pf = cvt_frag(kt2 ? s1 : s0, s2); const int rA = 32 * kt2 + 16 * s2 + 4 * h_;
#pragma unroll
                        for (int dt = 0; dt < 2; ++dt) { const bf16x8 vf = tr_frag(Vb, AT_RS, rA, rA + 8, 32 * dt + 16 * blk, lane); O[dt] = mfma32(vf, pf, O[dt]); } }
            }
            if (kind == 1) {
#pragma unroll
                for (int r = 0; r < 16; ++r) { const int n = kb + (r & 3) + 8 * (r >> 2) + 4 * h_;
                    float a = s0[r] * invden, b = s1[r] * invden; a += __shfl_xor(a, 1); b += __shfl_xor(b, 1); a += __shfl_xor(a, 2); b += __shfl_xor(b, 2);
                    if (hr == 0) { PSw[tl * PSS + n] = a; PSw[tl * PSS + n + 32] = b; } }
            }
        }
        if (have_next) at_store(F, (idx + 1) & 1, R);
        __syncthreads();
        ++idx;
    }
#undef AT_FINALIZE
    {
        const float lt = lsum + __shfl_xor(lsum, 32); const float sc = (lt > 0.f ? 1.0f / lt : 0.f) * g2;
        if (!SMP || w == 0) {
            bf16* op = WSP(bf16, WS_OA) + row * 512 + head * 64;
#pragma unroll
            for (int dt = 0; dt < 2; ++dt)
#pragma unroll
                for (int r4 = 0; r4 < 4; ++r4) { float o_[4];
#pragma unroll
                    for (int x = 0; x < 4; ++x) o_[x] = OAw[(dt * 16 + 4 * r4 + x) * 64] + O[dt][4 * r4 + x] * sc;
                    v2u wv; wv.x = pk2(o_[0], o_[1]); wv.y = pk2(o_[2], o_[3]); *(v2u*)(op + 32 * dt + 8 * r4 + 4 * h_) = wv; }
        }
    }
}

#ifdef DBG_CHECK
__device__ __forceinline__ unsigned dbg_rand(unsigned x) { x ^= x >> 16; x *= 0x7feb352du; x ^= x >> 15; x *= 0x846ca68bu; x ^= x >> 16; return x; }
__device__ __forceinline__ bool dbg_bad(float got, float exp_, float rtol, float atol) { return !(fabsf(got - exp_) <= rtol * fabsf(exp_) + atol); }
__device__ __forceinline__ float bfr(float x) { return __uint_as_float(pk2(x, 0.f) << 16); }
__device__ __forceinline__ int dbg_row(unsigned r) { const unsigned k = r % 20u; if (k == 0) return (int)(PM + (r >> 8) % SM); if (k == 1) return (int)(((r >> 8) % PB) * PT + ((r >> 12) % 8)); if (k == 2) return (int)(((r >> 8) % PB) * PT + PT - 1 - ((r >> 12) % 8)); return (int)((r >> 5) % PM); }
__device__ __forceinline__ float dbg_rs(const Frame& F, int row, int lane) { const float* xr = xrow_in(F, 0, row); float ss = 0.f; for (int d = lane; d < DM; d += 64) ss += xr[d] * xr[d]; return 1.0f / sqrtf(wave_sum(ss) * (1.0f / DM) + EPS); }
__device__ __forceinline__ float dbg_h(const Frame& F, int row, int d, float rs) { const float* mod = WSP(float, WS_MOD) + (size_t)row_bb(row) * 6144; return bfr(xrow_in(F, 0, row)[d] * rs * FIN(I_N1G)[d] * (1.0f + mod[1024 + d]) + mod[d]); }

__device__ __forceinline__ void dbg_check_phase(Frame& F) {
    const int gw = F.bid * NWAVES + F.wave, NGW = F.G * NWAVES, lane = F.lane;
    unsigned* CNT = (unsigned*)(F.ws + WS_CTL) + 3000;
    LAS float* L = (LAS float*)(F.lds + F.wave * 16384);
#define DBG_FLAG(ch, cond) do { if (__any(cond) && lane == 0) atomicAdd(CNT + (ch), 1u); } while (0)
    for (int s = gw; s < 1536; s += NGW) {
        const unsigned r = dbg_rand(1000u + s); const int row = dbg_row(r); const float rs = dbg_rs(F, row, lane); const int kind = s % 6;
        const bool isp = row < PM; const int b = isp ? (row >> 12) : ((row - PM) >> 3), t = isp ? (row & (PT - 1)) : ((row - PM) & 7);
#define DBG_U(col, dst) do { float a_ = 0.f; for (int d_ = lane; d_ < DM; d_ += 64) a_ += dbg_h(F, row, d_, rs) * bfr(FIN(I_WIN)[(size_t)d_ * D_IN + (col)]); dst = wave_sum(a_); } while (0)
        if (kind == 0) {
            const int c = (r >> 3) % 768, j = c >> 7, k = (c >> 6) & 1, dd = c & 63; float u; DBG_U(O_NKV + c, u); bool bad = false;
            if (j < 4) bad = dbg_bad(F.out[(isp ? OUT_ROWS_P + (size_t)row * 512 : OUT_ROWS_S + (size_t)(row - PM) * 512) + c], u, 0.01f, 0.01f);
            else if (isp) { if (t >= PT - WINB) bad = dbg_bad(F.out[OUT_WIN_P + ((size_t)b * WINB + (t - (PT - WINB))) * 256 + (c - 512)], u, 0.01f, 0.01f); }
            else bad = dbg_bad(F.out[OUT_WIN_S + ((size_t)b * WINB + (WINB - ST) + t) * 256 + (c - 512)], u, 0.01f, 0.01f);
            if (isp) { if (j < 2) bad = bad || dbg_bad(bf1(WSP(bf16, WS_ACMP)[((size_t)j * CMP_ROWS_J + 32768 + (b * 2 + k) * 256 + (t >> 4)) * 1024 + (t & 15) * 64 + dd]), u, 0.01f, 0.01f);
                       else bad = bad || dbg_bad(bf1(WSP(bf16, WS_KVB)[((((size_t)(j - 2) * PB + b) * 2 + k) * PT + t) * 64 + dd]), u, 0.01f, 0.01f); }
            else if (j >= 2) bad = bad || dbg_bad(bf1(WSP(bf16, WS_KVS)[((((size_t)(j - 2) * SB + b) * 2 + k) * ST + t) * 64 + dd]), u, 0.01f, 0.01f);
            DBG_FLAG(0, bad);
        } else if (kind == 1) {
            const int gi = (r >> 3) % 24, c5 = (r >> 8) % 512, cm = (r >> 8) % 3072; float u0, u1, u2, u3; DBG_U(O_NG + gi, u0); DBG_U(O_RX + c5, u1); DBG_U(O_RGATE + c5, u2); DBG_U(O_MG + cm, u3);
            bool bad = dbg_bad(WSP(float, WS_NG)[(size_t)row * 24 + gi], 1.0f / (1.0f + expf(-u0)), 0.01f, 0.005f);
            bad = bad || dbg_bad(WSP(float, WS_RX)[(size_t)row * 512 + c5], u1, 0.01f, 0.01f);
            bad = bad || dbg_bad(bf1(WSP(bf16, WS_GG)[(size_t)row * 512 + c5]), gelu_tanh(u2), 0.02f, 0.01f);
            bad = bad || dbg_bad(bf1(WSP(bf16, WS_MGS)[(size_t)row * 3072 + cm]), 1.0f / (1.0f + expf(-u3)), 0.01f, 0.005f);
            DBG_FLAG(1, bad);
        } else if (kind == 2) {
            const int head = (r >> 13) % 4, dim = (r >> 16) % 64, c5 = (r >> 3) % 512; float x1, x2, uv, ug, uq; DBG_U(O_RQ + head * 128 + dim, x1); DBG_U(O_RQ + head * 128 + 64 + dim, x2); DBG_U(O_RV + c5, uv); DBG_U(O_RG + c5, ug); DBG_U(O_NQ + c5, uq);
            const float pos = (float)(isp ? t : PAST + t); const float ang = pos * (float)pow(10000.0, -(double)dim / 64.0); float sn, cs; sincos_acc(ang, sn, cs);
            const bf16* RQ = WSP(bf16, WS_RQ);
            bool bad = dbg_bad(bf1(RQ[(size_t)row * 512 + head * 128 + dim]), x1 * cs - x2 * sn, 0.02f, 0.02f) || dbg_bad(bf1(RQ[(size_t)row * 512 + head * 128 + 64 + dim]), x1 * sn + x2 * cs, 0.02f, 0.02f);
            bad = bad || dbg_bad(bf1(RQ[(size_t)2 * MT * 512 + (size_t)row * 512 + c5]), uv, 0.01f, 0.01f) || dbg_bad(bf1(RQ[(size_t)3 * MT * 512 + (size_t)row * 512 + c5]), ug, 0.01f, 0.01f);
            bad = bad || dbg_bad(bf1(WSP(bf16, WS_QN)[(size_t)row * 512 + c5]), uq * QSCALE, 0.01f, 0.005f);
            DBG_FLAG(2, bad);
        }
#undef DBG_U
    }
    for (int s = gw; s < 128; s += NGW) {
        const unsigned r = dbg_rand(3000u + s); const int j = r & 1; const bool smp = ((r >> 1) & 3) != 0;
        const int grp = smp ? (int)((r >> 3) % 64) : (int)((r >> 3) % 8), nmax = smp ? 511 : 255; int n = (r >> 10) % nmax; if (((r >> 20) & 7) == 0) n = nmax - 1;
        const size_t rj = smp ? (size_t)grp * 512 + n : (size_t)32768 + grp * 256 + n;
        const bf16* A = WSP(bf16, WS_ACMP) + ((size_t)j * CMP_ROWS_J + rj) * 1024;
        const float* w1 = FIN(I_W1) + (size_t)j * 2048 * 128; const float* pe = FIN(I_PE) + j * 2048;
        for (int hh = 0; hh < 2; ++hh) { const int h = lane + 64 * hh; float a = FIN(I_B1)[j * 128 + h];
            for (int i = 0; i < 1024; ++i) a += (bf1(A[i]) + pe[i]) * w1[(size_t)i * 128 + h] + (bf1(A[1024 + i]) + pe[1024 + i]) * w1[(size_t)(1024 + i) * 128 + h];
            L[h] = gelu_tanh(a); }
        LDS_WAIT(); asm volatile("" ::: "memory");
        float o = 0.f; for (int h = 0; h < 128; ++h) o += L[h] * FIN(I_W2)[((size_t)j * 128 + h) * 64 + lane];
        const float got = bf1(WSP(bf16, WS_CK)[((size_t)j * CMP_ROWS_J + rj) * 64 + lane]);
        { const bool bd = dbg_bad(got, o, 0.05f, 0.03f); const unsigned long long mk = __ballot(bd); if (lane == 0 && mk) atomicAdd(CNT + 3, (unsigned)__popcll(mk)); }
        LDS_WAIT(); asm volatile("" ::: "memory");
    }
    for (int s = gw; s < 128; s += NGW) {
        const unsigned r = dbg_rand(3500u + s); const int j = r & 1; const bool smp = ((r >> 1) & 3) != 0;
        const int grp = smp ? (int)((r >> 3) % 64) : (int)((r >> 3) % 8), nmax = smp ? 511 : 255; const int n = (r >> 10) % nmax;
        const size_t rj = smp ? (size_t)grp * 512 + n : (size_t)32768 + grp * 256 + n, row = (size_t)j * CMP_ROWS_J + rj;
        const bf16* A = WSP(bf16, WS_ACMP) + row * 1024; const float* w1 = FIN(I_W1) + (size_t)j * 2048 * 128; const bf16* LH = WSP(bf16, WS_LH);
        unsigned nb = 0;
        for (int hh = 0; hh < 2; ++hh) { const int h = lane + 64 * hh; float lo = 0.f, hi = 0.f;
            for (int i = 0; i < 1024; ++i) { const float av = bf1(A[i]); lo += av * bfr(w1[(size_t)i * 128 + h]); hi += av * bfr(w1[(size_t)(1024 + i) * 128 + h]); }
            const bool bd = dbg_bad(bf1(LH[row * 256 + h]), lo, 0.02f, 0.02f) || dbg_bad(bf1(LH[row * 256 + 128 + h]), hi, 0.02f, 0.02f); nb += (unsigned)__popcll(__ballot(bd)); }
        if (lane == 0 && nb) atomicAdd(CNT + 9, nb);
        for (int hh = 0; hh < 2; ++hh) { const int h = lane + 64 * hh; L[h] = gelu_tanh(bf1(LH[row * 256 + h]) + bf1(LH[(row + 1) * 256 + 128 + h]) + WSP(float, WS_SMALLW + SW_CB)[j * 128 + h]); }
        LDS_WAIT(); asm volatile("" ::: "memory");
        float o = 0.f; for (int h = 0; h < 128; ++h) o += bfr(L[h]) * bfr(FIN(I_W2)[((size_t)j * 128 + h) * 64 + lane]);
        { const bool bd = dbg_bad(bf1(WSP(bf16, WS_CK)[row * 64 + lane]), o, 0.03f, 0.01f); const unsigned long long mk = __ballot(bd); if (lane == 0 && mk) atomicAdd(CNT + 11, (unsigned)__popcll(mk)); }
        LDS_WAIT(); asm volatile("" ::: "memory");
    }
    for (int s = gw; s < 64; s += NGW) {
        const unsigned r = dbg_rand(3700u + s); const int j = r & 1, half = (r >> 1) & 1, h = (r >> 2) % 128; const bf16* W1T = WSP(bf16, WS_SMALLW + SW_W1T) + ((size_t)j * 256 + half * 128 + h) * 1024;
        const float* w1 = FIN(I_W1) + ((size_t)j * 32 + half * 16) * 64 * 128 + h; unsigned nb = 0;
        for (int k = lane; k < 1024; k += 64) nb += (unsigned)__popcll(__ballot(dbg_bad(bf1(W1T[k]), w1[(size_t)k * 128], 0.01f, 0.0001f)));
        if (lane == 0 && nb) atomicAdd(CNT + 12, nb);
        const bool smp = ((r >> 9) & 3) != 0; const int grp = smp ? (int)((r >> 11) % 64) : (int)((r >> 11) % 8), n = (r >> 17) % (smp ? 511 : 255);
        const size_t row = (size_t)j * CMP_ROWS_J + (smp ? (size_t)grp * 512 + n : (size_t)32768 + grp * 256 + n); const bf16* A = WSP(bf16, WS_ACMP) + row * 1024;
        float a = 0.f; for (int k = lane; k < 1024; k += 64) a += bf1(A[k]) * bf1(W1T[k]); a = wave_sum(a);
        DBG_FLAG(13, dbg_bad(bf1(WSP(bf16, WS_LH)[row * 256 + half * 128 + h]), a, 0.02f, 0.02f));
    }
    for (int s = gw; s < 4; s += NGW) {
        const int j = s >> 1, h = (s & 1) * 64 + lane; const float* w1 = FIN(I_W1) + (size_t)j * 2048 * 128; const float* pe = FIN(I_PE) + j * 2048;
        float a = FIN(I_B1)[j * 128 + h]; for (int i = 0; i < 2048; ++i) a += pe[i] * w1[(size_t)i * 128 + h];
        const unsigned long long mk = __ballot(dbg_bad(WSP(float, WS_SMALLW + SW_CB)[j * 128 + h], a, 0.001f, 0.0005f)); if (lane == 0 && mk) atomicAdd(CNT + 10, (unsigned)__popcll(mk));
    }
    for (int s = gw; s < 96; s += NGW) {
        const unsigned r = dbg_rand(4000u + s); const bool smp = (s % 3) == 2;
        int seq, kvh = (r >> 4) & 1, t, tl = 0; size_t row;
        if (smp) { seq = (r >> 5) % SB; tl = (r >> 10) % ST; t = PAST + tl; row = (size_t)PM + seq * ST + tl; }
        else { seq = (r >> 5) % PB; const unsigned k = (r >> 8) % 8u; t = (k == 0) ? (int)((r >> 12) % 40) : (k == 1) ? PT - 1 - (int)((r >> 12) % 70) : (int)((r >> 12) % PT); row = (size_t)seq * PT + t; }
        const int N = smp ? 511 : 255, NS = smp ? 129 : 64, cur = t >> 6;
        LAS float* Q = L; LAS float* SC = L + 256; LAS float* PSUM = L + 256 + 2048; LAS float* OUT = L + 256 + 2048 + 512;
        for (int i = lane; i < 256; i += 64) Q[i] = bf1(WSP(bf16, WS_QN)[row * 512 + (kvh * 4 + (i >> 6)) * 64 + (i & 63)]);
        for (int i = lane; i < 768; i += 64) OUT[i] = 0.f;
        LDS_WAIT(); asm volatile("" ::: "memory");
        const bf16* CKk = WSP(bf16, WS_CK) + (smp ? (size_t)(seq * 2 + kvh) * 512 : (size_t)32768 + (seq * 2 + kvh) * 256) * 64; const bf16* CKv = CKk + (size_t)CMP_ROWS_J * 64;
        const int nvis = smp ? 511 : ((t >= 31) ? ((t - 31) >> 4) + 1 : 0);
        for (int i = lane; i < 512; i += 64) PSUM[i] = 0.f;
        for (int hr = 0; hr < 4; ++hr) {
            float mx = -INFINITY; for (int n = lane; n < nvis; n += 64) { float a = 0.f; for (int d = 0; d < 64; ++d) a += Q[hr * 64 + d] * bf1(CKk[(size_t)n * 64 + d]); SC[n] = a; mx = fmaxf(mx, a); }
            for (int o = 1; o < 64; o <<= 1) mx = fmaxf(mx, __shfl_xor(mx, o));
            float den = 0.f; for (int n = lane; n < nvis; n += 64) { const float e = exp2f(SC[n] - mx); SC[n] = e; den += e; } den = wave_sum(den);
            LDS_WAIT(); asm volatile("" ::: "memory");
            if (nvis > 0) { float o = 0.f; for (int n = 0; n < nvis; ++n) o += SC[n] * bf1(CKv[(size_t)n * 64 + lane]); OUT[hr * 64 + lane] = o / den;
                for (int n = lane; n < nvis; n += 64) PSUM[n] += SC[n] / den; }
            LDS_WAIT(); asm volatile("" ::: "memory");
        }
        LAS float* IMP = SC; LAS float* SELB = SC + 256;
        for (int sblk = lane; sblk < NS; sblk += 64) { float imp = 0.f; for (int n = 4 * sblk - 1; n <= 4 * sblk + 3; ++n) if (n >= 0 && n < N) imp += PSUM[n];
            const bool forced = sblk == 0 || sblk == cur || sblk == cur - 1, avail = sblk * 64 <= t; IMP[sblk] = avail ? (forced ? 1e4f : imp) : -1e4f; SELB[sblk] = 0.f; }
        LDS_WAIT(); asm volatile("" ::: "memory");
        for (int pick = 0; pick < 16 && pick < NS; ++pick) { float bv = -INFINITY; int bi = 1 << 30;
            for (int sblk = lane; sblk < NS; sblk += 64) { const float v = (SELB[sblk] != 0.f) ? -INFINITY : IMP[sblk]; if (v > bv || (v == bv && sblk < bi)) { bv = v; bi = sblk; } }
            for (int o = 1; o < 64; o <<= 1) { const float ov = __shfl_xor(bv, o); const int oi = __shfl_xor(bi, o); if (ov > bv || (ov == bv && oi < bi)) { bv = ov; bi = oi; } }
            if (lane == 0) SELB[bi] = 1.f; LDS_WAIT(); asm volatile("" ::: "memory"); }
        for (int br = 1; br < 3; ++br) for (int hr = 0; hr < 4; ++hr) {
            float mx = -INFINITY, den = 0.f, o = 0.f;
            const int plo = (br == 1) ? 0 : (t - WINB < 0 ? 0 : t - WINB), phi = t;
            for (int p = plo; p <= phi; ++p) {
                if (br == 1 && SELB[p >> 6] == 0.f) { p |= 63; continue; }
                const float* kf = nullptr; const bf16* kb = nullptr; const float* vf = nullptr; const bf16* vb = nullptr;
                const int jk = (br == 1) ? 2 : 4;
                if (!smp) { kb = WSP(bf16, WS_KVB) + ((((size_t)(jk - 2) * PB + seq) * 2 + kvh) * PT + p) * 64; vb = kb + (size_t)PB * 2 * PT * 64; }
                else if (p >= PAST) { kb = WSP(bf16, WS_KVS) + ((((size_t)(jk - 2) * SB + seq) * 2 + kvh) * ST + (p - PAST)) * 64; vb = kb + (size_t)SB * 2 * ST * 64; }
                else if (br == 1) { const int page = ((const int*)F.a->in[I_PT])[seq * NPG + (p >> 7)]; kf = FIN(I_CACHE) + ((((size_t)page * PAGE + (p & 127)) * 4 + 2) * 2 + kvh) * 64; vf = kf + 128; }
                else { kf = FIN(I_CWIN) + ((((size_t)seq * WINB + (p - (PAST - WINB))) * 2 + 0) * 2 + kvh) * 64; vf = kf + 128; }
                float a = 0.f; for (int d = 0; d < 64; ++d) a += Q[hr * 64 + d] * (kb ? bf1(kb[d]) : bfr(kf[d]));
                const float vv = vb ? bf1(vb[lane]) : bfr(vf[lane]);
                const float mn = fmaxf(mx, a), al = exp2f(mx - mn), e = exp2f(a - mn); den = den * al + e; o = o * al + e * vv; mx = mn;
            }
            OUT[(br * 4 + hr) * 64 + lane] = (den > 0.f) ? o / den : 0.f;
        }
        LDS_WAIT(); asm volatile("" ::: "memory");
        bool bad = false;
        for (int hr = 0; hr < 4; ++hr) { const float* ng = WSP(float, WS_NG) + row * 24 + (kvh * 4 + hr) * 3;
            const float e = ng[0] * OUT[(0 * 4 + hr) * 64 + lane] + ng[1] * OUT[(1 * 4 + hr) * 64 + lane] + ng[2] * OUT[(2 * 4 + hr) * 64 + lane];
            bad = bad || dbg_bad(bf1(WSP(bf16, WS_OA)[row * 512 + (kvh * 4 + hr) * 64 + lane]), e, 0.04f, 0.004f); }
        DBG_FLAG(smp ? 5 : 4, bad);
        LDS_WAIT(); asm volatile("" ::: "memory");
    }
    for (int s = gw; s < 96; s += NGW) {
        const unsigned r = dbg_rand(6000u + s); const bool smp = (s % 3) == 2; const int h = (r >> 3) & 3; const float lg = ret_log_g(h);
        const bf16* RQ = WSP(bf16, WS_RQ); const bf16* RK = RQ + (size_t)MT * 512; const bf16* RV = RQ + (size_t)2 * MT * 512; const bf16* RG = RQ + (size_t)3 * MT * 512;
        int seq, t; size_t row0; if (smp) { seq = (r >> 5) % SB; t = (r >> 10) % ST; row0 = (size_t)PM + seq * ST; } else { seq = (r >> 5) % PB; const unsigned k = (r >> 8) % 4u; t = (k == 0) ? (int)((r >> 12) % 300) : (int)((r >> 12) % PT); row0 = (size_t)seq * PT; }
        float o0 = 0.f, o1 = 0.f;
        for (int d = lane; d < 128; d += 64) L[d] = bf1(RQ[(row0 + t) * 512 + h * 128 + d]);
        LDS_WAIT(); asm volatile("" ::: "memory");
        for (int j = 0; j <= t; ++j) { float a = 0.f; for (int d = 0; d < 128; ++d) a += L[d] * bf1(RK[(row0 + j) * 512 + h * 128 + d]);
            a *= expf((float)(t - j) * lg); o0 += a * bf1(RV[(row0 + j) * 512 + h * 128 + lane]); o1 += a * bf1(RV[(row0 + j) * 512 + h * 128 + 64 + lane]); }
        if (smp) { const float* S0 = FIN(I_SRET) + (((size_t)0 * SB + seq) * 4 + h) * 16384; const float cr = expf((float)(t + 1) * lg);
            for (int d = 0; d < 128; ++d) { o0 += L[d] * S0[d * 128 + lane] * cr; o1 += L[d] * S0[d * 128 + 64 + lane] * cr; } }
        const float mean = wave_sum(o0 + o1) * (1.0f / 128.0f); const float var = wave_sum((o0 - mean) * (o0 - mean) + (o1 - mean) * (o1 - mean)) * (1.0f / 128.0f), rstd = 1.0f / sqrtf(var + EPS);
        const float* GN = FIN(I_GNG) + h * 128; const bf16* OR_ = WSP(bf16, WS_OA) + (size_t)MT * 512;
        const float g0 = bf1(RG[(row0 + t) * 512 + h * 128 + lane]), g1 = bf1(RG[(row0 + t) * 512 + h * 128 + 64 + lane]);
        const float e0 = (o0 - mean) * rstd * GN[lane] * (g0 / (1.0f + expf(-g0))), e1 = (o1 - mean) * rstd * GN[64 + lane] * (g1 / (1.0f + expf(-g1)));
        DBG_FLAG(6, dbg_bad(bf1(OR_[(row0 + t) * 512 + h * 128 + lane]), e0, 0.04f, 0.02f) || dbg_bad(bf1(OR_[(row0 + t) * 512 + h * 128 + 64 + lane]), e1, 0.04f, 0.02f));
        const int d = (r >> 20) % 128, T = smp ? ST : PT; float s0 = 0.f, s1 = 0.f;
        for (int j = 0; j < T; ++j) { const float kk = bf1(RK[(row0 + j) * 512 + h * 128 + d]) * expf((float)(T - 1 - j) * lg); s0 += kk * bf1(RV[(row0 + j) * 512 + h * 128 + lane]); s1 += kk * bf1(RV[(row0 + j) * 512 + h * 128 + 64 + lane]); }
        const float* SO;
        if (smp) { const float* S0 = FIN(I_SRET) + (((size_t)0 * SB + seq) * 4 + h) * 16384; const float g8 = expf(8.0f * lg); s0 += g8 * S0[d * 128 + lane]; s1 += g8 * S0[d * 128 + 64 + lane]; SO = F.out + OUT_RET_S + (((size_t)0 * SB + seq) * 4 + h) * 16384; }
        else SO = F.out + OUT_RET_P + (((size_t)0 * PB + seq) * 4 + h) * 16384;
        DBG_FLAG(7, dbg_bad(SO[d * 128 + lane], s0, 0.02f, 0.02f) || dbg_bad(SO[d * 128 + 64 + lane], s1, 0.02f, 0.02f));
        LDS_WAIT(); asm volatile("" ::: "memory");
    }
    for (int s = gw; s < 48; s += NGW) {
        const unsigned r = dbg_rand(8000u + s); const bool smp = (s % 3) == 2; const int blk = (r >> 3) & 7, c = blk * 64 + lane;
        int seq, T; size_t row0; if (smp) { seq = (r >> 6) % SB; T = ST; row0 = (size_t)PM + seq * ST; } else { seq = (r >> 6) % PB; T = 1 + (int)((r >> 10) % ((s & 1) ? 200 : PT)); row0 = (size_t)seq * PT; }
        const float* RX = WSP(float, WS_RX); const float* cw = FIN(I_RCW); const float cb = FIN(I_RCB)[c];
        float x3 = 0.f, x2 = 0.f, x1 = 0.f, h = 0.f;
        if (smp) { const float* cv = FIN(I_SCONV) + (size_t)seq * 3 * 512; x3 = cv[c]; x2 = cv[512 + c]; x1 = cv[1024 + c]; h = FIN(I_SH)[(size_t)seq * 512 + c]; }
        const float sp = log1pf(expf(-FIN(I_LAM)[c])); const float* wa = FIN(I_RWA) + (size_t)blk * 4096; const float* wx = FIN(I_RWX) + (size_t)blk * 4096;
        for (int t = 0; t < T; ++t) { const float x0 = RX[(row0 + t) * 512 + c]; const float xc = cb + cw[c] * x3 + cw[512 + c] * x2 + cw[1024 + c] * x1 + cw[1536 + c] * x0; x3 = x2; x2 = x1; x1 = x0;
            L[lane] = xc; LDS_WAIT(); asm volatile("" ::: "memory");
            float ra = FIN(I_RBA)[c], ri = FIN(I_RBX)[c]; for (int i = 0; i < 64; ++i) { ra += L[i] * wa[i * 64 + lane]; ri += L[i] * wx[i * 64 + lane]; }
            LDS_WAIT(); asm volatile("" ::: "memory");
            const float rr = 1.0f / (1.0f + expf(-ra)), ii = 1.0f / (1.0f + expf(-ri)), la = -8.0f * rr * sp, a = expf(la); h = a * h + sqrtf(-expm1f(2.0f * la)) * (ii * xc); }
        const size_t o = (row0 + T - 1) * 512 + c; const float e = h * bf1(WSP(bf16, WS_GG)[o]);
        DBG_FLAG(8, dbg_bad(bf1((WSP(bf16, WS_OA) + (size_t)2 * MT * 512)[o]), e, 0.04f, 0.01f));
    }
    for (int s = gw; s < 512; s += NGW) {
        const unsigned r = dbg_rand(9000u + s); const int row = dbg_row(r), col = (r >> 7) % DM;
        float e = 0.f;
        for (int br = 0; br < 3; ++br) { const bf16* O = WSP(bf16, WS_OA) + (size_t)br * MT * 512 + (size_t)row * 512; const float* W = FIN(br == 0 ? I_WBRA : (br == 1 ? I_WBRB : I_WBRC));
            float a = 0.f; for (int k = lane; k < 512; k += 64) a += bf1(O[k]) * bfr(W[(size_t)k * DM + col]); a = wave_sum(a); e += bf1(WSP(bf16, WS_MGS)[(size_t)row * 3072 + br * 1024 + col]) * a; }
        DBG_FLAG(20, dbg_bad(bf1(WSP(bf16, WS_MRG)[(size_t)row * DM + col]), e, 0.03f, 0.01f));
        const float* mod = WSP(float, WS_MOD) + (size_t)row_bb(row) * 6144;
        { float a = 0.f; for (int k = lane; k < DM; k += 64) a += bf1(WSP(bf16, WS_MRG)[(size_t)row * DM + k]) * bfr(FIN(I_WOUT)[(size_t)k * DM + col]); a = wave_sum(a);
          const float ex = xrow_in(F, 0, row)[col] + mod[2048 + col] * a; DBG_FLAG(21, dbg_bad(WSP(float, WS_X1)[(size_t)row * DM + col], ex, 0.005f, 0.005f)); }
        { const float* xr = WSP(float, WS_X1) + (size_t)row * DM; float ss = 0.f; for (int d = lane; d < DM; d += 64) ss += xr[d] * xr[d]; const float rs = 1.0f / sqrtf(wave_sum(ss) * (1.0f / DM) + EPS);
          const int c2 = (r >> 9) % NUP; float a = 0.f; for (int d = lane; d < DM; d += 64) a += bfr(xr[d] * rs * FIN(I_N2G)[d] * (1.0f + mod[4096 + d]) + mod[3072 + d]) * bfr(FIN(I_WUP)[(size_t)d * NUP + c2]); a = wave_sum(a);
          const float got = c2 < DFF ? bf1(WSP(bf16, WS_GP)[(size_t)row * DFF + c2]) : bf1((WSP(bf16, WS_GP) + (size_t)MT * DFF)[(size_t)row * DFF + c2 - DFF]); DBG_FLAG(22, dbg_bad(got, a, 0.02f, 0.01f)); }
        { const int c3 = (r >> 11) % DFF; const bf16* GP = WSP(bf16, WS_GP); const bf16* VAL = GP + (size_t)MT * DFF; const float* cw = FIN(I_FCW);
          const bool isp = row < PM; const int t = isp ? (row & (PT - 1)) : ((row - PM) & 7); float xm2, xm1;
          if (t >= 2) { xm2 = bf1(GP[(size_t)(row - 2) * DFF + c3]); xm1 = bf1(GP[(size_t)(row - 1) * DFF + c3]); }
          else if (isp) { xm2 = 0.f; xm1 = (t == 1) ? bf1(GP[(size_t)(row - 1) * DFF + c3]) : 0.f; }
          else { const float* st = FIN(I_SFFN) + ((size_t)((row - PM) >> 3) * 2) * DFF + c3; xm2 = (t == 0) ? st[0] : st[DFF]; xm1 = (t == 0) ? st[DFF] : bf1(GP[(size_t)(row - 1) * DFF + c3]); }
          const float y = FIN(I_FCB)[c3] + cw[c3] * xm2 + cw[DFF + c3] * xm1 + cw[2 * DFF + c3] * bf1(GP[(size_t)row * DFF + c3]); const float ex = (y / (1.0f + expf(-y))) * bf1(VAL[(size_t)row * DFF + c3]);
          DBG_FLAG(23, dbg_bad(bf1((GP + (size_t)2 * MT * DFF)[(size_t)row * DFF + c3]), ex, 0.02f, 0.005f)); }
        { const bf16* ACT = WSP(bf16, WS_GP) + (size_t)2 * MT * DFF + (size_t)row * DFF; float a = 0.f; for (int k = lane; k < DFF; k += 64) a += bf1(ACT[k]) * bfr(FIN(I_WDN)[(size_t)k * DM + col]); a = wave_sum(a);
          const float ex = WSP(float, WS_X1)[(size_t)row * DM + col] + mod[5120 + col] * a; DBG_FLAG(24, dbg_bad(WSP(float, WS_X2)[(size_t)row * DM + col], ex, 0.005f, 0.005f)); }
    }
#undef DBG_FLAG
}
__device__ __forceinline__ void dbg_report_phase(Frame& F) {
    const unsigned* CNT = (const unsigned*)(F.ws + WS_CTL) + 3000;
    const size_t ooff[14] = {OUT_Y, OUT_Y + (size_t)PM * DM, OUT_ROWS_P, OUT_ROWS_S, OUT_WIN_P, OUT_WIN_S, OUT_RET_P, OUT_RET_S, OUT_H_P, OUT_H_S, OUT_CV_P, OUT_CV_S, OUT_FC_P, OUT_FC_S};
    if (F.bid == 0 && F.tid < 14) { const int b = F.tid; const unsigned c = CNT[b]; const int cnt = 1 + (int)(c > 1000u ? 1000u : c);
        for (int i = 0; i < cnt; ++i) ((unsigned*)F.out)[ooff[b] + 7 + 2 * i] = 0xAAAAAAAAu; }
}
#endif

#ifndef DBG_SUB
#define DBG_SUB 0xFFFF
#endif
#ifndef DBG_MAXPH
#define DBG_MAXPH N_PHASES
#endif
#ifndef DBG_MASK
#define DBG_MASK 0xFFFF
#endif
#define IN(k) (lo <= (k) && (k) < hi)
#define SEAM(k) do { if ((k) + 1 < hi) { if (MK_N_LAUNCHES == 1) xcd_barrier(bar); } } while (0)
template <int l> __device__ __forceinline__ void layer_phases(Frame& F, const XcdBarrier& bar, int lo, int hi) {
    unsigned char* ws = F.ws;
        const int pb = PH_L0 + l * PH_PER_LAYER;
        if (((DBG_MASK >> 1) & 1) && IN(pb + LP_N1)) { launder(F); norm_phase(F, l, 0); SEAM(pb + LP_N1); }
        if (((DBG_MASK >> 2) & 1) && IN(pb + LP_WIN)) { launder(F);
            pg8::Gemm g{(const pg8::bf16_t*)(ws + WS_H), (const pg8::bf16_t*)(ws + WS_WIN) + (size_t)l * NIN * DM, MT, NIN, DM};
            pg8::StaticOrder S; S.init(MT, NIN, F.G, F.bid); EpiWin E{ws, F.out, l};
            pg8::gemm_phase<EpiWin, pg8::StaticOrder, true, true>(F.lds, g, S, E);
            SEAM(pb + LP_WIN);
        }
        if (((DBG_MASK >> 3) & 1) && IN(pb + LP_MIX1)) { launder(F);
            if (DBG_SUB & 1) { launder(F);
                pg8::Gemm g{(const pg8::bf16_t*)(ws + WS_ACMP) + (size_t)l * CMP_ROWS * 1024, (const pg8::bf16_t*)(ws + WS_SMALLW + SW_W1T) + (size_t)l * 512 * 1024, CMP_ROWS, 512, 1024};
                CmpOrder S{F.G, F.bid}; EpiLH E{(bf16*)(ws + WS_LH)};
                pg8::gemm_phase<EpiLH, CmpOrder, true, true>(F.lds, g, S, E);
            }
            if (DBG_SUB & 2) for (int u = F.bid; u < 512; u += F.G) { launder(F); ret_local_unit(F, u); }
            if (DBG_SUB & 4) for (int u = F.bid; u < 256; u += F.G) { launder(F); rglru_unit<0>(F, l, u); }
            SEAM(pb + LP_MIX1);
        }
        if (((DBG_MASK >> 4) & 1) && IN(pb + LP_MIX2)) { launder(F); cmp2_phase(F, l); ret_scan_phase(F, l); rglru_carry_phase(F, l); SEAM(pb + LP_MIX2); }
        if (((DBG_MASK >> 5) & 1) && IN(pb + LP_MIX3)) { launder(F);
            for (int a = F.bid; a < 576; a += F.G) {
                if (a < 64) { if (DBG_SUB & 8) { launder(F); attn_unit<true>(F, l, a); } }
                else if (DBG_SUB & 16) { const int p = a - 64, qt = 63 - (p >> 3), bk = p & 7; launder(F); attn_unit<false>(F, l, bk * 64 + qt); }
            }
            if (DBG_SUB & 32) for (int u = F.bid; u < 512; u += F.G) { launder(F); ret_out_unit(F, l, u); }
            if (DBG_SUB & 64) for (int u = F.bid; u < 128; u += F.G) { launder(F); ret_sample_unit(F, l, u); }
            if (DBG_SUB & 128) for (int u = F.bid; u < 256; u += F.G) { launder(F); rglru_unit<1>(F, l, u); }
            if (DBG_SUB & 256) for (int u = F.bid; u < 32; u += F.G) { launder(F); rglru_unit<2>(F, l, u); }
            __syncthreads();
            SEAM(pb + LP_MIX3);
        }
        if (((DBG_MASK >> 6) & 1) && IN(pb + LP_BR)) { launder(F);
            const pg8::bf16_t* wbr = (const pg8::bf16_t*)(ws + WS_WBR) + (size_t)l * 3 * 1024 * 512;
            pg8::StaticOrder S; S.init(MT, DM, F.G, F.bid);
            { pg8::Gemm g{(const pg8::bf16_t*)(ws + WS_OA), wbr, MT, DM, 512}; EpiBr<0> E{ws}; pg8::gemm_phase<EpiBr<0>, pg8::StaticOrder, true, true>(F.lds, g, S, E); }
            { launder(F); pg8::Gemm g{(const pg8::bf16_t*)(ws + WS_OA) + (size_t)MT * 512, wbr + (size_t)1024 * 512, MT, DM, 512}; EpiBr<1> E{ws}; pg8::gemm_phase<EpiBr<1>, pg8::StaticOrder, true, true>(F.lds, g, S, E); }
            { launder(F); pg8::Gemm g{(const pg8::bf16_t*)(ws + WS_OA) + (size_t)2 * MT * 512, wbr + (size_t)2 * 1024 * 512, MT, DM, 512}; EpiBr<2> E{ws}; pg8::gemm_phase<EpiBr<2>, pg8::StaticOrder, true, true>(F.lds, g, S, E); }
            SEAM(pb + LP_BR);
        }
        if (((DBG_MASK >> 7) & 1) && IN(pb + LP_OUT)) { launder(F);
            pg8::Gemm g{(const pg8::bf16_t*)(ws + WS_MRG), (const pg8::bf16_t*)(ws + WS_WOUT) + (size_t)l * DM * DM, MT, DM, DM};
            pg8::StaticOrder S; S.init(MT, DM, F.G, F.bid);
            EpiRes E{l == 0 ? FIN(I_XP) : (const float*)(ws + WS_X2), l == 0 ? FIN(I_XS) : nullptr, (float*)(ws + WS_X1), (const float*)(ws + WS_MOD) + (size_t)l * 36 * 6144, 2048};
            pg8::gemm_phase<EpiRes, pg8::StaticOrder, true, true>(F.lds, g, S, E);
            SEAM(pb + LP_OUT);
        }
        if (((DBG_MASK >> 8) & 1) && IN(pb + LP_N2)) { launder(F); norm_phase(F, l, 1); SEAM(pb + LP_N2); }
        if (((DBG_MASK >> 9) & 1) && IN(pb + LP_UP)) { launder(F);
            pg8::Gemm g{(const pg8::bf16_t*)(ws + WS_H), (const pg8::bf16_t*)(ws + WS_WUP) + (size_t)l * NUP * DM, MT, NUP, DM};
            pg8::StaticOrder S; S.init(MT, NUP, F.G, F.bid); EpiUp E{ws, F.out, l};
            pg8::gemm_phase<EpiUp, pg8::StaticOrder, true, true>(F.lds, g, S, E);
            SEAM(pb + LP_UP);
        }
        if (((DBG_MASK >> 10) & 1) && IN(pb + LP_CONV)) { launder(F); convact_phase(F, l); SEAM(pb + LP_CONV); }
        if (((DBG_MASK >> 11) & 1) && IN(pb + LP_DOWN)) { launder(F);
            pg8::Gemm g{(const pg8::bf16_t*)(ws + WS_GP) + (size_t)2 * MT * DFF, (const pg8::bf16_t*)(ws + WS_WDN) + (size_t)l * DM * DFF, MT, DM, DFF};
            pg8::StaticOrder S; S.init(MT, DM, F.G, F.bid);
            EpiRes E{(const float*)(ws + WS_X1), nullptr, (float*)(ws + WS_X2), (const float*)(ws + WS_MOD) + (size_t)l * 36 * 6144, 5120};
            pg8::gemm_phase<EpiRes, pg8::StaticOrder, true, true>(F.lds, g, S, E);
            SEAM(pb + LP_DOWN);
        }
}

__global__ void __launch_bounds__(NTHR, 2) trunk_fwd(Args args) {
    extern __shared__ __attribute__((aligned(16))) unsigned char lds_raw[];
    Frame F;
    F.lds = (LAS unsigned char*)lds_raw;
    F.tid = threadIdx.x; F.lane = F.tid & 63; F.wave = __builtin_amdgcn_readfirstlane(F.tid >> 6);
    F.G = gridDim.x; F.bid = blockIdx.x; F.a = &args; F.ws = args.ws; F.out = args.out;
    volatile LAS unsigned* MISC = (volatile LAS unsigned*)(F.lds + MISC_OFF);
    for (int u = F.tid; u < 64; u += NTHR) MISC[u] = 0u;
    __syncthreads();
    unsigned* barw = (unsigned*)(F.ws + WS_CTL) + CW_BAR;
    XcdBarrier bar; bar.bar = barw; bar.x = 0; bar.st = nullptr;
    if (MK_N_LAUNCHES == 1) bar = xcd_barrier_post(barw, MISC + 8);
    const int lo = args.ph_lo, hi = args.ph_hi;
    unsigned char* ws = F.ws;

    if (((DBG_MASK >> 0) & 1) && IN(PH_P0)) { launder(F); p0_prologue(F); SEAM(PH_P0); }

    layer_phases<0>(F, bar, lo, hi);
    layer_phases<1>(F, bar, lo, hi);
    if (((DBG_MASK >> 12) & 1) && IN(PH_FINAL)) { launder(F); final_phase(F); }
#ifdef DBG_CHECK
    if (lo == 100) { launder(F); dbg_check_phase(F); }
    if (lo == 101) { for (size_t i = (size_t)F.bid * NTHR + F.tid; i < OUT_END; i += (size_t)F.G * NTHR) F.out[i] = 0.f; }
    if (lo == 102) { launder(F); dbg_report_phase(F); }
#endif
}

extern "C" void kernel_launch(void* const* d_in, const int* in_sizes, int n_in, void* d_out, int out_size, void* d_ws, size_t ws_size, hipStream_t stream) {
    static int grid = 0;
    if (grid == 0) {
        if (n_in != 37 || (size_t)out_size != OUT_END || ws_size < WS_END) { fprintf(stderr, "kernel_launch: unexpected shapes: n_in %d out %d (want %zu) ws %zu (want %zu)\n", n_in, out_size, (size_t)OUT_END, ws_size, (size_t)WS_END); grid = -1; return; }
        int dev = 0, cus = 0, per_cu = 0;
        if (hipGetDevice(&dev) != hipSuccess || hipDeviceGetAttribute(&cus, hipDeviceAttributeMultiprocessorCount, dev) != hipSuccess) { grid = -1; return; }
        if (hipFuncSetAttribute((const void*)trunk_fwd, hipFuncAttributeMaxDynamicSharedMemorySize, LDS_BYTES) != hipSuccess) { fprintf(stderr, "kernel_launch: hipFuncSetAttribute failed\n"); grid = -1; return; }
        if (hipOccupancyMaxActiveBlocksPerMultiprocessor(&per_cu, (const void*)trunk_fwd, NTHR, LDS_BYTES) != hipSuccess || per_cu < 1) fprintf(stderr, "kernel_launch: occupancy query reports %d\n", per_cu);
        (void)hipGetLastError();
        grid = cus;
    }
    if (grid < 0) return;
    if (hipMemsetAsync((char*)d_ws + WS_CTL, 0, CTL_ZERO_BYTES, stream) != hipSuccess) return;
#ifdef DBG_POISON
    (void)hipMemsetAsync((char*)d_ws + CTL_ZERO_BYTES, 0xAA, WS_END - CTL_ZERO_BYTES, stream);
    (void)hipMemsetAsync(d_out, 0xAA, (size_t)OUT_END * 4, stream);
#endif
    Args a{};
    for (int i = 0; i < 37; ++i) a.in[i] = d_in[i];
    a.out = (float*)d_out; a.ws = (unsigned char*)d_ws;
#if MK_N_LAUNCHES == 1
    a.ph_lo = 0; a.ph_hi = N_PHASES;
    hipLaunchKernelGGL(trunk_fwd, dim3(grid), dim3(NTHR), LDS_BYTES, stream, a);
#else
    for (int p = 0; p < DBG_MAXPH; ++p) { a.ph_lo = p; a.ph_hi = p + 1; hipLaunchKernelGGL(trunk_fwd, dim3(grid), dim3(NTHR), LDS_BYTES, stream, a); }
#ifdef DBG_CHECK
    for (int p = 100; p < 103; ++p) { a.ph_lo = p; a.ph_hi = p + 1; hipLaunchKernelGGL(trunk_fwd, dim3(grid), dim3(NTHR), LDS_BYTES, stream, a); }
#endif
#endif
    (void)in_sizes;
}
```

```cpp
#include <hip/hip_runtime.h>
#include <cstdio>
#include <cstdint>

#ifndef MK_N_LAUNCHES
#define MK_N_LAUNCHES 1
#endif

constexpr int DM = 1024, PB = 4, PT = 4096, PM = PB * PT, SB = 32, ST = 8, SM = SB * ST, MT = PM + SM;
constexpr int DEPTH = 2, PAST = 8192, PAGE = 128, NPG = PAST / PAGE, NPHYS = 2560;
constexpr int D_IN = 7448, NIN = 7680, DFF = 2816, NUP = 2 * DFF;
constexpr int WINB = 512;
constexpr float EPS = 1e-6f;
constexpr float QSCALE = 0.125f * 1.4426950408889634f;

constexpr int O_NQ = 0, O_NKV = 512, O_NG = 1280, O_RQ = 1304, O_RK = 1816, O_RV = 2328, O_RG = 2840, O_RX = 3352, O_RGATE = 3864, O_MG = 4376;

constexpr size_t OUT_Y = 0;
constexpr size_t OUT_ROWS_P = OUT_Y + (size_t)MT * DM;
constexpr size_t OUT_ROWS_S = OUT_ROWS_P + (size_t)DEPTH * PM * 512;
constexpr size_t OUT_WIN_P = OUT_ROWS_S + (size_t)DEPTH * SM * 512;
constexpr size_t OUT_WIN_S = OUT_WIN_P + (size_t)DEPTH * PB * WINB * 256;
constexpr size_t OUT_RET_P = OUT_WIN_S + (size_t)DEPTH * SB * WINB * 256;
constexpr size_t OUT_RET_S = OUT_RET_P + (size_t)DEPTH * PB * 4 * 16384;
constexpr size_t OUT_H_P = OUT_RET_S + (size_t)DEPTH * SB * 4 * 16384;
constexpr size_t OUT_H_S = OUT_H_P + (size_t)DEPTH * PB * 512;
constexpr size_t OUT_CV_P = OUT_H_S + (size_t)DEPTH * SB * 512;
constexpr size_t OUT_CV_S = OUT_CV_P + (size_t)DEPTH * PB * 3 * 512;
constexpr size_t OUT_FC_P = OUT_CV_S + (size_t)DEPTH * SB * 3 * 512;
constexpr size_t OUT_FC_S = OUT_FC_P + (size_t)DEPTH * PB * 2 * DFF;
constexpr size_t OUT_END = OUT_FC_S + (size_t)DEPTH * SB * 2 * DFF;

constexpr size_t MiB = 1u << 20;
constexpr size_t WS_CTL = 0, CTL_ZERO_BYTES = 4 * MiB;
constexpr size_t WS_MOD = 1 * MiB;
constexpr size_t WS_ROT = 4 * MiB;
constexpr size_t WS_SMALLW = 8 * MiB;
constexpr size_t WS_WIN = 16 * MiB;
constexpr size_t WS_WBR = WS_WIN + (size_t)2 * NIN * DM * 2;
constexpr size_t WS_WOUT = WS_WBR + (size_t)2 * 3 * 1024 * 512 * 2;
constexpr size_t WS_WUP = WS_WOUT + (size_t)2 * 1024 * 1024 * 2;
constexpr size_t WS_WDN = WS_WUP + (size_t)2 * NUP * DM * 2;
constexpr size_t WS_WEND = WS_WDN + (size_t)2 * DM * DFF * 2;
constexpr size_t WS_H = 128 * MiB;
constexpr size_t WS_QN = WS_H + (size_t)MT * DM * 2;
constexpr size_t WS_KVB = WS_QN + (size_t)MT * 512 * 2;
constexpr size_t WS_KVS = WS_KVB + (size_t)4 * PB * 2 * PT * 64 * 2;
constexpr size_t WS_RQ = WS_KVS + (size_t)4 * SB * 2 * ST * 64 * 2;
constexpr size_t WS_RX = WS_RQ + (size_t)4 * MT * 512 * 2;
constexpr size_t WS_GG = WS_RX + (size_t)MT * 512 * 4;
constexpr size_t WS_MGS = WS_GG + (size_t)MT * 512 * 2;
constexpr size_t WS_NG = WS_MGS + (size_t)MT * 3072 * 2;
constexpr size_t WS_OA = WS_NG + (size_t)MT * 24 * 4;
constexpr size_t WS_MRG = WS_OA + (size_t)3 * MT * 512 * 2;
constexpr size_t WS_X1 = WS_MRG + (size_t)MT * DM * 2;
constexpr size_t WS_X2 = WS_X1 + (size_t)MT * DM * 4;
constexpr size_t WS_GP = WS_X2 + (size_t)MT * DM * 4;
constexpr size_t WS_ACMP = WS_GP + (size_t)3 * MT * DFF * 2;
constexpr int CMP_ROWS_J = 34816, CMP_ROWS = 2 * CMP_ROWS_J;
constexpr size_t WS_LH = WS_ACMP + (size_t)2 * CMP_ROWS * 1024 * 2 + 4096;
constexpr size_t WS_CK = WS_LH + (size_t)(CMP_ROWS + 16) * 256 * 2;
constexpr size_t WS_LT = WS_CK + (size_t)CMP_ROWS * 64 * 2;
constexpr size_t WS_SPT = WS_LT + (size_t)16 * 32 * 16384 * 4;
constexpr size_t WS_CAR = WS_SPT + (size_t)16 * 32 * 16384 * 2;
constexpr size_t WS_END = WS_CAR + (size_t)4 * 64 * 3 * 512 * 4 + MiB;
static_assert(WS_WEND <= WS_H, "weights fit below WS_H");

constexpr size_t SW_W1T = 0;
constexpr size_t SW_W2T = SW_W1T + (size_t)2 * 2 * 256 * 1024 * 2;
constexpr size_t SW_CB = SW_W2T + (size_t)2 * 2 * 64 * 128 * 2;
constexpr size_t SW_WAT = SW_CB + (size_t)2 * 2 * 128 * 4;
constexpr size_t SW_SP = SW_WAT + (size_t)2 * 2 * 8 * 64 * 64 * 2;
constexpr size_t SW_END = SW_SP + 2 * 512 * 4;
static_assert(SW_END <= 8 * MiB, "small weights fit");

constexpr int CW_TMO = 0;
constexpr int CW_BAR = 4096;

constexpr int PH_P0 = 0, PH_L0 = 1, PH_PER_LAYER = 11, PH_FINAL = PH_L0 + DEPTH * PH_PER_LAYER, N_PHASES = PH_FINAL + 1;
enum { LP_N1 = 0, LP_WIN, LP_MIX1, LP_MIX2, LP_MIX3, LP_BR, LP_OUT, LP_N2, LP_UP, LP_CONV, LP_DOWN };

constexpr int RING_BYTES = 131072;
constexpr int MISC_OFF = RING_BYTES;
constexpr int LDS_BYTES = RING_BYTES + 1024;
constexpr int NWAVES = 8, NTHR = 512;

#define GAS __attribute__((address_space(1)))
#define LAS __attribute__((address_space(3)))
typedef unsigned short bf16;
typedef unsigned v4u __attribute__((ext_vector_type(4)));
typedef unsigned v2u __attribute__((ext_vector_type(2)));
typedef float f32x16 __attribute__((ext_vector_type(16)));
typedef short s16x4 __attribute__((ext_vector_type(4)));
namespace pg8 {
#define PG8_LAS __attribute__((address_space(3)))
typedef unsigned short bf16_t;
typedef short bf16x8 __attribute__((ext_vector_type(8)));
typedef float f32x4 __attribute__((ext_vector_type(4)));
typedef unsigned u32x4 __attribute__((ext_vector_type(4)));
constexpr int BM = 256, BK = 64, HALF = 128, HTB = HALF * BK * 2  , STAGE_BYTES = 8 * HTB, NXCD = 8, WGM = 8;

__host__ __device__ __forceinline__ int lds_byte(int r, int c) { const int st = (r >> 4) * 2 + (c >> 5), rr = r & 15, cc = c & 31, ob = rr * 64 + cc * 2; return st * 1024 + (ob ^ (((ob >> 9) & 1) << 5)); }
__host__ __device__ __forceinline__ void stage_rc(int b, int& R, int& C) { const int st = b / 1024, sb = b % 1024, swz = sb ^ (((sb >> 9) & 1) << 5); R = (st >> 1) * 16 + swz / 64; C = (st & 1) * 32 + (swz % 64) / 2; }
__host__ __device__ __forceinline__ int perm32(int rho) { const int n = rho >> 4, i = rho & 15; return 8 * (i >> 2) + 4 * n + (i & 3); }

struct Unit { int pm, pn; };
struct Gemm { const bf16_t* A; const bf16_t* Bt; int M, N, K; };

struct StaticOrder {
    int nM, nN, nwg, G, c;
    __host__ __device__ void init(int M, int N, int G_, int c_) { nM = M / BM; nN = N / BM; nwg = nM * nN; G = G_; c = c_; }
    __host__ __device__ bool next(int i, Unit& u) const {
        const long L = (long)i * G + c; if (L >= nwg) return false;
        int wgid = (int)L; { const int q = nwg / NXCD, r = nwg % NXCD, xcd = wgid % NXCD, off = wgid / NXCD; wgid = (xcd < r ? xcd * (q + 1) : r * (q + 1) + (xcd - r) * q) + off; }
        const int nig = WGM * nN, gid = wgid / nig, fm = gid * WGM, gsz = (nM - fm) < WGM ? (nM - fm) : WGM;
        u.pm = fm + ((wgid % nig) % gsz); u.pn = (wgid % nig) / gsz; return true;
    }
    __device__ __forceinline__ void a_ready(const Unit&) const {}
    __device__ __forceinline__ void done(const Unit&) const {}
};
__device__ __forceinline__ unsigned cvt_pk_bf16(float lo, float hi) { unsigned r; asm volatile("v_cvt_pk_bf16_f32 %0, %1, %2" : "=v"(r) : "v"(lo), "v"(hi)); return r; }
typedef float f32x2 __attribute__((ext_vector_type(2)));
template <class Epi, class Sched, bool ALIGN_EPI = false, bool SP2 = false>
__device__ __forceinline__ void gemm_phase(PG8_LAS unsigned char* lds, const Gemm g, const Sched& S, const Epi& E) {
    const int tid = threadIdx.x, wid = __builtin_amdgcn_readfirstlane(tid >> 6), lane = tid & 63, wr = wid >> 2, wc = wid & 3, fr = lane & 15, fq = lane >> 4;
    const int K = g.K, nt = K / BK;
    unsigned voffA[2], voffB[2];
#pragma unroll
    for (int i = 0; i < 2; ++i) { int R, C; stage_rc(tid * 16 + i * 8192, R, C); const int Rb = Epi::PERM ? ((R & ~31) + perm32(R & 31)) : R;
        voffA[i] = (unsigned)(R * K + C) * 2u; voffB[i] = (unsigned)(Rb * K + C) * 2u; }
    const size_t kstep = (size_t)(BK * 2);
    const size_t hstep = (size_t)HALF * K * 2;
    const size_t tstep = 2 * hstep;
    const unsigned ldsw = (unsigned)wid * 1024u;
    const int aoff = lds_byte(wr * 64 + fr, fq * 8), boff = lds_byte(wc * 32 + fr, fq * 8);
#define PG8_SA(b, h) (((b) * 2 + (h)) * HTB)
#define PG8_SB(b, h) ((4 + (b) * 2 + (h)) * HTB)
#define PG8_STAGE(bufoff, gbase, voff) do { _Pragma("unroll") for (int _i = 0; _i < 2; ++_i) \
        __builtin_amdgcn_global_load_lds((const unsigned*)((const char*)(gbase) + (voff)[_i]), (PG8_LAS unsigned*)(lds + (bufoff) + ldsw + _i * 8192), 16, 0, 0); } while (0)
#define PG8_LDA(dst, b, h) do { _Pragma("unroll") for (int m = 0; m < 4; ++m) _Pragma("unroll") for (int k = 0; k < 2; ++k) dst[m][k] = *(const PG8_LAS bf16x8*)(lds + PG8_SA(b, h) + aoff + m * 2048 + k * 1024); } while (0)
#define PG8_LDB(dst, b, h) do { _Pragma("unroll") for (int n = 0; n < 2; ++n) _Pragma("unroll") for (int k = 0; k < 2; ++k) dst[n][k] = *(const PG8_LAS bf16x8*)(lds + PG8_SB(b, h) + boff + n * 2048 + k * 1024); } while (0)
#define PG8_MMA(ai, bj, At, Bt) do { __builtin_amdgcn_s_setprio(1); _Pragma("unroll") for (int m = 0; m < 4; ++m) _Pragma("unroll") for (int n = 0; n < 2; ++n) _Pragma("unroll") for (int k = 0; k < 2; ++k) \
        acc[ai][bj][m][n] = __builtin_amdgcn_mfma_f32_16x16x32_bf16(Bt[n][k], At[m][k], acc[ai][bj][m][n], 0, 0, 0); __builtin_amdgcn_s_setprio(0); } while (0)
#define PG8_WAIT_V(n) asm volatile("s_waitcnt vmcnt(" #n ")" ::: "memory")
#define PG8_WAIT_L(n) asm volatile("s_waitcnt lgkmcnt(" #n ")" ::: "memory")
#define PG8_BAR __builtin_amdgcn_s_barrier()
#define PG8_SCHED __builtin_amdgcn_sched_barrier(0)
    Unit cur, nxt; int ui = 0;
    if (!S.next(0, cur)) return;
    f32x4 acc[2][2][4][2];
#pragma unroll
    for (int a = 0; a < 2; ++a)
#pragma unroll
        for (int b = 0; b < 2; ++b)
#pragma unroll
            for (int m = 0; m < 4; ++m)
#pragma unroll
                for (int n = 0; n < 2; ++n) acc[a][b][m][n] = (f32x4){0.f, 0.f, 0.f, 0.f};
    bf16x8 At[4][2], B0[2][2], B1[2][2];
    const char* cA = (const char*)g.A + (size_t)cur.pm * tstep; const char* cB = (const char*)g.Bt + (size_t)cur.pn * tstep;
    S.a_ready(cur);
    if constexpr (SP2) {
        PG8_STAGE(PG8_SB(0, 0), cB, voffB); PG8_STAGE(PG8_SB(0, 1), cB + hstep, voffB); PG8_STAGE(PG8_SA(0, 0), cA, voffA); PG8_STAGE(PG8_SA(0, 1), cA + hstep, voffA);
        if (wr == 1) PG8_BAR;
        PG8_WAIT_V(2); PG8_BAR;
        PG8_STAGE(PG8_SB(1, 0), cB + kstep, voffB); PG8_STAGE(PG8_SA(1, 0), cA + kstep, voffA); PG8_STAGE(PG8_SB(1, 1), cB + hstep + kstep, voffB);
        PG8_WAIT_V(6); PG8_BAR;
    } else {
        PG8_STAGE(PG8_SB(0, 0), cB, voffB); PG8_STAGE(PG8_SA(0, 0), cA, voffA); PG8_STAGE(PG8_SB(0, 1), cB + hstep, voffB); PG8_STAGE(PG8_SA(0, 1), cA + hstep, voffA);
        if (wr == 1) PG8_BAR;
        PG8_WAIT_V(4); PG8_BAR;
        PG8_STAGE(PG8_SB(1, 0), cB + kstep, voffB); PG8_STAGE(PG8_SA(1, 0), cA + kstep, voffA); PG8_STAGE(PG8_SB(1, 1), cB + hstep + kstep, voffB);
        PG8_WAIT_V(6); PG8_BAR;
    }
    for (;;) {
        const bool has_next = S.next(ui + 1, nxt);
        const char* nA = has_next ? (const char*)g.A + (size_t)nxt.pm * tstep : cA; const char* nB = has_next ? (const char*)g.Bt + (size_t)nxt.pn * tstep : cB;
        for (int t = 0; t < nt; t += 2) {
            const bool last = (t == nt - 2);
            const char* a1 = cA + (size_t)(t + 1) * kstep;
            const char* a2 = last ? nA : cA + (size_t)(t + 2) * kstep; const char* b2 = last ? nB : cB + (size_t)(t + 2) * kstep;
            const char* a3 = a2 + kstep; const char* b3 = b2 + kstep;
            if (last && has_next) S.a_ready(nxt);
            if constexpr (SP2) {
            PG8_LDB(B0, 0, 0); PG8_LDB(B1, 0, 1); PG8_SCHED; PG8_LDA(At, 0, 0); PG8_STAGE(PG8_SA(1, 1), a1 + hstep, voffA);
            PG8_WAIT_V(8); PG8_WAIT_L(0); PG8_BAR; PG8_MMA(0, 0, At, B0); PG8_MMA(0, 1, At, B1); PG8_BAR; PG8_SCHED;
            PG8_LDA(At, 0, 1); PG8_STAGE(PG8_SB(0, 0), b2, voffB); PG8_STAGE(PG8_SB(0, 1), b2 + hstep, voffB); PG8_STAGE(PG8_SA(0, 0), a2, voffA);
            PG8_WAIT_V(8); PG8_WAIT_L(0); PG8_BAR; PG8_MMA(1, 0, At, B0); PG8_MMA(1, 1, At, B1); PG8_BAR; PG8_SCHED;
            PG8_LDB(B0, 1, 0); PG8_LDB(B1, 1, 1); PG8_SCHED; PG8_LDA(At, 1, 0); PG8_STAGE(PG8_SA(0, 1), a2 + hstep, voffA);
            PG8_WAIT_V(8); PG8_WAIT_L(0); PG8_BAR; PG8_MMA(0, 0, At, B0); PG8_MMA(0, 1, At, B1); PG8_BAR; PG8_SCHED;
            PG8_LDA(At, 1, 1); PG8_STAGE(PG8_SB(1, 0), b3, voffB); PG8_STAGE(PG8_SB(1, 1), b3 + hstep, voffB); PG8_STAGE(PG8_SA(1, 0), a3, voffA);
            PG8_WAIT_V(8); PG8_WAIT_L(0); PG8_BAR; PG8_MMA(1, 0, At, B0); PG8_MMA(1, 1, At, B1); PG8_BAR; PG8_SCHED;
            } else {
            PG8_LDB(B0, 0, 0); PG8_SCHED; PG8_LDA(At, 0, 0); PG8_STAGE(PG8_SA(1, 1), a1 + hstep, voffA);
            PG8_WAIT_L(8); PG8_BAR; PG8_WAIT_L(0); PG8_MMA(0, 0, At, B0); PG8_BAR; PG8_SCHED;
            PG8_LDB(B1, 0, 1); PG8_STAGE(PG8_SB(0, 0), b2, voffB);
            PG8_BAR; PG8_WAIT_L(0); PG8_MMA(0, 1, At, B1); PG8_BAR;
            PG8_LDA(At, 0, 1); PG8_STAGE(PG8_SA(0, 0), a2, voffA);
            PG8_BAR; PG8_WAIT_L(0); PG8_MMA(1, 0, At, B0); PG8_BAR; PG8_SCHED;
            PG8_STAGE(PG8_SB(0, 1), b2 + hstep, voffB);
            PG8_WAIT_V(6); PG8_BAR; PG8_MMA(1, 1, At, B1); PG8_BAR;
            PG8_LDB(B0, 1, 0); PG8_SCHED; PG8_LDA(At, 1, 0); PG8_STAGE(PG8_SA(0, 1), a2 + hstep, voffA);
            PG8_WAIT_L(8); PG8_BAR; PG8_WAIT_L(0); PG8_MMA(0, 0, At, B0); PG8_BAR; PG8_SCHED;
            PG8_LDB(B1, 1, 1); PG8_STAGE(PG8_SB(1, 0), b3, voffB);
            PG8_BAR; PG8_WAIT_L(0); PG8_MMA(0, 1, At, B1); PG8_BAR;
            PG8_LDA(At, 1, 1); PG8_STAGE(PG8_SA(1, 0), a3, voffA);
            PG8_BAR; PG8_WAIT_L(0); PG8_MMA(1, 0, At, B0); PG8_BAR; PG8_SCHED;
            PG8_STAGE(PG8_SB(1, 1), b3 + hstep, voffB);
            PG8_WAIT_V(6); PG8_BAR; PG8_MMA(1, 1, At, B1); PG8_BAR;
            }
        }
        if constexpr (ALIGN_EPI) { if (wr == 0) PG8_BAR; }
        if constexpr (!Epi::AFTER_DRAIN) { E(acc, cur, wr, wc, fr, fq); S.done(cur); }
        if (!has_next) break;
#pragma unroll
        for (int a = 0; a < 2; ++a)
#pragma unroll
            for (int b = 0; b < 2; ++b)
#pragma unroll
                for (int m = 0; m < 4; ++m)
#pragma unroll
                    for (int n = 0; n < 2; ++n) acc[a][b][m][n] = (f32x4){0.f, 0.f, 0.f, 0.f};
        cur = nxt; cA = nA; cB = nB; ++ui;
        if constexpr (ALIGN_EPI) { if (wr == 1) PG8_BAR; }
    }
    PG8_WAIT_V(0);
    if constexpr (!ALIGN_EPI) { if (wr == 0) PG8_BAR; }
    PG8_BAR;
    if constexpr (Epi::AFTER_DRAIN) { E.fused(acc, cur, wr, wc, fr, fq, lds, wid, lane); S.done(cur); }
#undef PG8_SA
#undef PG8_SB
#undef PG8_STAGE
#undef PG8_LDA
#undef PG8_LDB
#undef PG8_MMA
#undef PG8_WAIT_V
#undef PG8_WAIT_L
#undef PG8_BAR
#undef PG8_SCHED
}
}

using pg8::bf16x8; using pg8::f32x4; using pg8::u32x4;
#define LDS_WAIT() asm volatile("s_waitcnt lgkmcnt(0)" ::: "memory")
#define VM_WAIT() asm volatile("s_waitcnt vmcnt(0)" ::: "memory")
typedef float f32x2_t __attribute__((ext_vector_type(2))); typedef __bf16 bf16x2_t __attribute__((ext_vector_type(2)));
__device__ __forceinline__ unsigned pk2(float lo, float hi) { f32x2_t v = {lo, hi}; bf16x2_t b = __builtin_convertvector(v, bf16x2_t); return __builtin_bit_cast(unsigned, b); }
__device__ __forceinline__ float bf_lo(unsigned w) { return __uint_as_float(w << 16); }
__device__ __forceinline__ float bf_hi(unsigned w) { return __uint_as_float(w & 0xffff0000u); }
__device__ __forceinline__ float bf1(bf16 b) { return __uint_as_float(((unsigned)b) << 16); }
__device__ __forceinline__ float fexp2(float x) { return __builtin_amdgcn_exp2f(x); }
__device__ __forceinline__ float fexp(float x) { return __builtin_amdgcn_exp2f(x * 1.4426950408889634f); }
__device__ __forceinline__ float frcp(float x) { return __builtin_amdgcn_rcpf(x); }
__device__ __forceinline__ float sigmoidf_(float x) { return frcp(1.0f + fexp(-x)); }
__device__ __forceinline__ float siluf_(float x) { return x * sigmoidf_(x); }
__device__ __forceinline__ float gelu_tanh(float x) {
    const float u = 0.7978845608028654f * (x + 0.044715f * x * x * x);
    const float e = fexp(2.0f * u);
    const float t = 1.0f - 2.0f * frcp(e + 1.0f);
    return 0.5f * x * (1.0f + t);
}
__device__ __forceinline__ float wave_sum(float v) {
#pragma unroll
    for (int o = 1; o < 64; o <<= 1) v += __shfl_xor(v, o);
    return v;
}
__device__ __forceinline__ v4u pack8(const f32x4 a, const f32x4 b) { v4u w; w.x = pk2(a[0], a[1]); w.y = pk2(a[2], a[3]); w.z = pk2(b[0], b[1]); w.w = pk2(b[2], b[3]); return w; }
__device__ __forceinline__ void unpack8(const v4u w, f32x4& a, f32x4& b) { a = (f32x4){bf_lo(w.x), bf_hi(w.x), bf_lo(w.y), bf_hi(w.y)}; b = (f32x4){bf_lo(w.z), bf_hi(w.z), bf_lo(w.w), bf_hi(w.w)}; }

#define XB_TMO      128
#define XB_XCNT(j)  (256  + 64 * (j))
#define XB_XSUB(j)  (1280 + 64 * (j))
#define XB_XGEN(j)  (2304 + 64 * (j))
#define XB_TOP      3328
#define XB_TOPGEN   3392
#define XCD_BAR_WORDS 3456
#define XB_SPIN_CAP (1u << 18)

__device__ __forceinline__ unsigned xb_ld(unsigned* p)              { return __hip_atomic_load(p, __ATOMIC_RELAXED, __HIP_MEMORY_SCOPE_AGENT); }
__device__ __forceinline__ unsigned xb_add(unsigned* p, unsigned v) { return __hip_atomic_fetch_add(p, v, __ATOMIC_RELAXED, __HIP_MEMORY_SCOPE_AGENT); }
__device__ __forceinline__ unsigned xb_xcc_id() { return (unsigned)__builtin_amdgcn_s_getreg((3 << 11) | 20) & 0xFu; }
#define XB_SPIN(cond, bar) do { unsigned _sp = 0; while (cond) { __builtin_amdgcn_s_sleep(1); \
    if ((++_sp & 255u) == 0u) { if (xb_ld(&(bar)[XB_TMO])) break; if (_sp > XB_SPIN_CAP) { atomicAdd(&(bar)[XB_TMO], 1u); break; } } } } while (0)

struct XcdBarrier {
    unsigned* bar; unsigned x;
    volatile LAS unsigned* st;
};

__device__ __forceinline__ XcdBarrier xcd_barrier_post(unsigned* bar, volatile LAS unsigned* st) {
    XcdBarrier b; b.bar = bar; b.x = xb_xcc_id(); b.st = st;
    if (threadIdx.x == 0) (void)xb_add(&bar[XB_XCNT(b.x)], 1u);
    return b;
}
__device__ __forceinline__ void xcd_barrier_complete(unsigned* bar, unsigned x, unsigned& nloc, unsigned& nx) {
    const unsigned G = gridDim.x * gridDim.y * gridDim.z;
    unsigned sum, cnt, mine, sp = 0u;
    for (;;) {
        sum = 0u; cnt = 0u; mine = 0u;
#pragma unroll
        for (unsigned j = 0; j < 16; ++j) { const unsigned c = xb_ld(&bar[XB_XCNT(j)]); sum += c; cnt += (c > 0u) ? 1u : 0u; mine = (j == x) ? c : mine; }
        if (sum == G) break;
        __builtin_amdgcn_s_sleep(1);
        if ((++sp & 255u) == 0u) { if (xb_ld(&bar[XB_TMO])) break; if (sp > XB_SPIN_CAP) { atomicAdd(&bar[XB_TMO], 1u); break; } }
    }
    nloc = mine > 0u ? mine : 1u; nx = cnt > 0u ? cnt : 1u;
}

__device__ __forceinline__ void xcd_barrier(const XcdBarrier& b) {
    asm volatile("s_waitcnt vmcnt(0)" ::: "memory");
    __syncthreads();
    if (threadIdx.x == 0) {
        unsigned* bar = b.bar;
        __builtin_amdgcn_s_waitcnt(0);
        unsigned nloc = b.st[0], nx = b.st[1];
        if (nloc == 0u) { xcd_barrier_complete(bar, b.x, nloc, nx); b.st[0] = nloc; b.st[1] = nx; }
        const unsigned old = xb_add(&bar[XB_XSUB(b.x)], 1u);
        const unsigned gen = old / nloc;
        if (old + 1u == (gen + 1u) * nloc) {
            __builtin_amdgcn_fence(__ATOMIC_RELEASE, "agent");
            asm volatile("s_waitcnt vmcnt(0)" ::: "memory");
            const unsigned og = xb_add(&bar[XB_TOP], 1u);
            const unsigned tg = og / nx;
            if (og + 1u == (tg + 1u) * nx) xb_add(&bar[XB_TOPGEN], 1u);
            else XB_SPIN(xb_ld(&bar[XB_TOPGEN]) == tg, bar);
            __builtin_amdgcn_fence(__ATOMIC_ACQUIRE, "agent");
            xb_add(&bar[XB_XGEN(b.x)], 1u);
            asm volatile("s_waitcnt vmcnt(0)" ::: "memory");
        } else {
            XB_SPIN(xb_ld(&bar[XB_XGEN(b.x)]) == gen, bar);
            __builtin_amdgcn_fence(__ATOMIC_ACQUIRE, "agent");
            asm volatile("s_waitcnt vmcnt(0)" ::: "memory");
        }
    }
    __syncthreads();
}

struct Args { const void* in[37]; float* out; unsigned char* ws; int ph_lo, ph_hi; };
enum { I_XP = 0, I_XS, I_CACHE, I_CWIN, I_SRET, I_SH, I_SCONV, I_SFFN, I_PT, I_CP, I_CS, I_N1G, I_N2G, I_WADA, I_BADA, I_WIN, I_PE, I_W1, I_B1, I_W2,
       I_GNG, I_RCW, I_RCB, I_RWA, I_RBA, I_RWX, I_RBX, I_LAM, I_WBRA, I_WBRB, I_WBRC, I_WOUT, I_WUP, I_FCW, I_FCB, I_WDN, I_FNG };

struct Frame {
    LAS unsigned char* lds;
    int tid, lane, wave, G, bid;
    const Args* a;
    unsigned char* ws;
    float* out;
};
__device__ __forceinline__ void launder(Frame& F) { asm volatile("" : "+v"(F.tid), "+v"(F.lane)); int w_ = __builtin_amdgcn_readfirstlane(F.wave), b_ = __builtin_amdgcn_readfirstlane(F.bid), g_ = __builtin_amdgcn_readfirstlane(F.G); asm volatile("" : "+s"(w_), "+s"(b_), "+s"(g_)); F.wave = w_; F.bid = b_; F.G = g_; }
#define FIN(i) ((const float*)F.a->in[i])
#define WSP(T, off) ((T*)(F.ws + (off)))

__device__ __forceinline__ int row_bb(int row) { return row < PM ? (row >> 12) : 4 + ((row - PM) >> 3); }
__device__ __forceinline__ int row_pos(int row) { return row < PM ? (row & (PT - 1)) : PT + ((row - PM) & 7); }

__device__ __forceinline__ int win_cmap(int n) {
    if (n < 1280) return n;
    if (n < 2304) { const int c = n - 1280, isk = c >> 9, hc = c & 511, head = hc >> 7, s = hc & 127;
        const int g = s >> 3, w = s & 7, dim = (w < 4) ? (4 * g + w) : (64 + 4 * g + (w - 4)); return (isk ? O_RK : O_RQ) + head * 128 + dim; }
    if (n < 2816) return O_RV + (n - 2304);
    if (n < 3328) return O_RG + (n - 2816);
    if (n < 3840) return O_RX + (n - 3328);
    if (n < 4352) return O_RGATE + (n - 3840);
    if (n < 7424) return O_MG + (n - 4352);
    if (n < 7448) return O_NG + (n - 7424);
    return -1;
}

template <bool MAP> __device__ __forceinline__ void p0_tr_item(const float* W, int ldw, bf16* WT, int ldt, int k0, int n0, LAS float* scr, int lane) {
    const int nd = n0 + (lane & 31); const int sc = MAP ? win_cmap(nd) : nd;
#pragma unroll 8
    for (int i = 0; i < 32; ++i) { const int kk = 2 * i + (lane >> 5); scr[kk * 33 + (lane & 31)] = (sc >= 0) ? W[(size_t)(k0 + kk) * ldw + sc] : 0.f; }
    LDS_WAIT(); asm volatile("" ::: "memory");
    const int c = lane & 7;
#pragma unroll
    for (int j = 0; j < 4; ++j) { const int n = (lane >> 3) + 8 * j; const LAS float* s = scr + (8 * c) * 33 + n;
        v4u o; o.x = pk2(s[0 * 33], s[1 * 33]); o.y = pk2(s[2 * 33], s[3 * 33]); o.z = pk2(s[4 * 33], s[5 * 33]); o.w = pk2(s[6 * 33], s[7 * 33]);
        *(v4u*)(WT + (size_t)(n0 + n) * ldt + k0 + 8 * c) = o; }
    LDS_WAIT(); asm volatile("" ::: "memory");
}
__device__ __forceinline__ void sincos_acc(float ang, float& s, float& c) {
    const double a = (double)ang; const double kq = rint(a * 0.63661977236758134308); const double r = fma(-kq, 1.57079632679489661923, a);
    const double r2 = r * r;
    const double sp = r * (1.0 + r2 * (-1.6666666666666666e-1 + r2 * (8.3333333333333332e-3 + r2 * (-1.9841269841269841e-4 + r2 * (2.7557319223985893e-6 + r2 * (-2.5052108385441720e-8))))));
    const double cp = 1.0 + r2 * (-0.5 + r2 * (4.1666666666666664e-2 + r2 * (-1.3888888888888889e-3 + r2 * (2.4801587301587302e-5 + r2 * (-2.7557319223985888e-7 + r2 * 2.0876756987868099e-9)))));
    const int q = ((int)kq) & 3;
    const double ss = (q == 0) ? sp : (q == 1) ? cp : (q == 2) ? -sp : -cp;
    const double cc = (q == 0) ? cp : (q == 1) ? -sp : (q == 2) ? -cp : sp;
    s = (float)ss; c = (float)cc;
}

__device__ __forceinline__ void p0_prologue(Frame& F) {
    const int gw = F.bid * NWAVES + F.wave, NGW = F.G * NWAVES, lane = F.lane;
    LAS float* scr = (LAS float*)(F.lds + F.wave * 16384);
    {
        constexpr int I_IN = 16 * 240, I_BR = 8 * 32, I_OUT = 16 * 32, I_UP = 16 * 176, I_DN = 44 * 32, I_L = I_IN + 3 * I_BR + I_OUT + I_UP + I_DN;
        for (int it = gw; it < 2 * I_L; it += NGW) {
            const int l = it / I_L; int r = it % I_L;
            if (r < I_IN) { p0_tr_item<true>(FIN(I_WIN) + (size_t)l * DM * D_IN, D_IN, WSP(bf16, WS_WIN) + (size_t)l * NIN * DM, DM, 64 * (r / 240), 32 * (r % 240), scr, lane); continue; } r -= I_IN;
            if (r < 3 * I_BR) { const int w = r / I_BR, q = r % I_BR; const float* src = FIN(w == 0 ? I_WBRA : (w == 1 ? I_WBRB : I_WBRC)) + (size_t)l * 512 * 1024;
                p0_tr_item<false>(src, 1024, WSP(bf16, WS_WBR) + (size_t)(l * 3 + w) * 1024 * 512, 512, 64 * (q / 32), 32 * (q % 32), scr, lane); continue; } r -= 3 * I_BR;
            if (r < I_OUT) { p0_tr_item<false>(FIN(I_WOUT) + (size_t)l * 1024 * 1024, 1024, WSP(bf16, WS_WOUT) + (size_t)l * 1024 * 1024, 1024, 64 * (r / 32), 32 * (r % 32), scr, lane); continue; } r -= I_OUT;
            if (r < I_UP) { p0_tr_item<false>(FIN(I_WUP) + (size_t)l * DM * NUP, NUP, WSP(bf16, WS_WUP) + (size_t)l * NUP * DM, DM, 64 * (r / 176), 32 * (r % 176), scr, lane); continue; } r -= I_UP;
            p0_tr_item<false>(FIN(I_WDN) + (size_t)l * DFF * DM, DM, WSP(bf16, WS_WDN) + (size_t)l * DM * DFF, DFF, 64 * (r / 32), 32 * (r % 32), scr, lane);
        }
    }
    {
        constexpr int NI_W1 = 8 * 16 * 4, NI_W2 = 4 * 2 * 2, NI_RG = 32 * 2;
        for (int it = gw; it < NI_W1 + NI_W2 + NI_RG; it += NGW) {
            int r = it;
            if (r < NI_W1) { const int m = r / 64, q = r % 64, lk = m >> 1, half = m & 1;
                p0_tr_item<false>(FIN(I_W1) + ((size_t)lk * 32 + half * 16) * 64 * 128, 128, WSP(bf16, WS_SMALLW + SW_W1T) + ((size_t)lk * 256 + half * 128) * 1024, 1024, 64 * (q / 4), 32 * (q % 4), scr, lane); continue; } r -= NI_W1;
            if (r < NI_W2) { const int lk = r / 4, q = r % 4;
                p0_tr_item<false>(FIN(I_W2) + (size_t)lk * 128 * 64, 64, WSP(bf16, WS_SMALLW + SW_W2T) + (size_t)lk * 64 * 128, 128, 64 * (q / 2), 32 * (q % 2), scr, lane); continue; } r -= NI_W2;
            { const int m = r / 2, q = r % 2, l = m >> 4, which = (m >> 3) & 1, blk = m & 7;
                p0_tr_item<false>(FIN(which ? I_RWX : I_RWA) + ((size_t)l * 8 + blk) * 4096, 64, WSP(bf16, WS_SMALLW + SW_WAT) + (size_t)m * 4096, 64, 0, 32 * q, scr, lane); }
        }
    }
    for (int it = gw; it < 64; it += NGW) {
        const int lk = it >> 4, h0 = (it & 15) * 8; const float* pe = FIN(I_PE) + (size_t)lk * 2048; const float* w1 = FIN(I_W1) + (size_t)lk * 2048 * 128 + h0;
        f32x4 a0 = (f32x4){0.f, 0.f, 0.f, 0.f}, a1 = a0;
#pragma unroll 8
        for (int i = lane; i < 2048; i += 64) { const float p = pe[i]; a0 += *(const f32x4*)(w1 + (size_t)i * 128) * p; a1 += *(const f32x4*)(w1 + (size_t)i * 128 + 4) * p; }
#pragma unroll
        for (int x = 0; x < 4; ++x) { a0[x] = wave_sum(a0[x]); a1[x] = wave_sum(a1[x]); }
        if (lane == 0) { float* cb = WSP(float, WS_SMALLW + SW_CB) + lk * 128 + h0; const float* b1 = FIN(I_B1) + lk * 128 + h0;
#pragma unroll
            for (int x = 0; x < 4; ++x) { cb[x] = a0[x] + b1[x]; cb[4 + x] = a1[x] + b1[4 + x]; } }
    }
    for (int i = F.bid * NTHR + F.tid; i < 1024; i += F.G * NTHR) { const float lam = FIN(I_LAM)[i]; WSP(float, WS_SMALLW + SW_SP)[i] = log1pf(expf(-lam)); }
    for (int i = F.bid * NTHR + F.tid; i < 4104 * 64; i += F.G * NTHR) {
        const int pi = i >> 6, fi = i & 63; const float pos = (float)(pi < PT ? pi : PAST + (pi - PT));
        const float freq = (float)pow(10000.0, -(double)fi / 64.0); const float ang = pos * freq; float s, c; sincos_acc(ang, s, c);
        WSP(float, WS_ROT)[i] = c; WSP(float, WS_ROT)[4104 * 64 + i] = s;
    }
    {
        LAS float* SC = (LAS float*)(F.lds + 0);
        LAS float* RED = (LAS float*)(F.lds + 40960);
        for (int u = F.bid; u < 2 * 24; u += F.G) {
            const int l = u / 24, cg = u % 24;
            f32x4 acc[36];
#pragma unroll
            for (int b = 0; b < 36; ++b) acc[b] = (f32x4){0.f, 0.f, 0.f, 0.f};
#pragma unroll 1
            for (int kq = 0; kq < 4; ++kq) {
                __syncthreads();
                for (int i = F.tid; i < 256 * 36; i += NTHR) { const int d = i / 36, bb = i % 36; const float c = (bb < 4) ? FIN(I_CP)[bb * DM + kq * 256 + d] : FIN(I_CS)[(bb - 4) * DM + kq * 256 + d]; SC[i] = siluf_(c); }
                __syncthreads();
                const float* wp = FIN(I_WADA) + ((size_t)l * DM + kq * 256 + F.wave * 32) * 6144 + cg * 256 + lane * 4;
                for (int dd = 0; dd < 32; ++dd) {
                    const f32x4 wv = *(const f32x4*)(wp + (size_t)dd * 6144);
                    const LAS f32x4* sc4 = (const LAS f32x4*)(SC + (F.wave * 32 + dd) * 36);
#pragma unroll
                    for (int g = 0; g < 9; ++g) { const f32x4 s4 = sc4[g];
                        acc[4 * g + 0] += wv * s4[0]; acc[4 * g + 1] += wv * s4[1]; acc[4 * g + 2] += wv * s4[2]; acc[4 * g + 3] += wv * s4[3]; }
                }
            }
#pragma unroll
            for (int g = 0; g < 9; ++g) {
                __syncthreads();
#pragma unroll
                for (int j = 0; j < 4; ++j) *(LAS f32x4*)(RED + ((F.wave * 4 + j) * 256 + lane * 4)) = acc[4 * g + j];
                __syncthreads();
#pragma unroll
                for (int q = 0; q < 2; ++q) { const int o = F.tid + q * NTHR, j = o >> 8, col = o & 255; float s = FIN(I_BADA)[l * 6144 + cg * 256 + col];
#pragma unroll
                    for (int w = 0; w < 8; ++w) s += RED[(w * 4 + j) * 256 + col];
                    WSP(float, WS_MOD)[((size_t)l * 36 + 4 * g + j) * 6144 + cg * 256 + col] = s; }
            }
        }
        __syncthreads();
    }
    for (int it = gw; it < 2 * SB * PAST / 8; it += NGW) {
        const int l = it / (SB * PAST / 8), r = it % (SB * PAST / 8), db = r / (PAST / 8), tt0 = (r % (PAST / 8)) * 8;
        const int page = ((const int*)F.a->in[I_PT])[db * NPG + (tt0 >> 7)];
        const float* src = FIN(I_CACHE) + (((size_t)l * NPHYS + page) * PAGE + (tt0 & 127)) * 512 + lane * 4;
        f32x4 v[8];
#pragma unroll
        for (int k = 0; k < 8; ++k) v[k] = __builtin_nontemporal_load((const f32x4*)(src + (size_t)k * 512));
        const int idx = lane * 4, j = idx >> 7, kk = (idx >> 6) & 1, d = idx & 63;
        bf16* dst = WSP(bf16, WS_ACMP) + ((size_t)(l * 2 + j) * CMP_ROWS_J) * 1024 + ((size_t)(db * 2 + kk) * PAST + tt0) * 64 + d;
#pragma unroll
        for (int k = 0; k < 8; ++k) { v2u o; o.x = pk2(v[k][0], v[k][1]); o.y = pk2(v[k][2], v[k][3]); *(v2u*)(dst + (size_t)k * 64) = o; }
    }
    for (size_t i = (size_t)F.bid * NTHR + F.tid; i < (size_t)2 * SB * 504 * 64; i += (size_t)F.G * NTHR) {
        const size_t seq = i / (504 * 64), r = i % (504 * 64);
        const f32x4 v = *(const f32x4*)(FIN(I_CWIN) + (seq * 512 + 8) * 256 + r * 4);
        *(f32x4*)(F.out + OUT_WIN_S + seq * 512 * 256 + r * 4) = v;
    }
}

__device__ __forceinline__ const float* xrow_in(const Frame& F, int l, int row) {
    if (l == 0) return row < PM ? FIN(I_XP) + (size_t)row * DM : FIN(I_XS) + (size_t)(row - PM) * DM;
    return WSP(float, WS_X2) + (size_t)row * DM;
}
__device__ __forceinline__ void norm_phase(Frame& F, int l, int which) {
    const int gw = F.bid * NWAVES + F.wave, NGW = F.G * NWAVES, lane = F.lane;
    const float* g = FIN(which ? I_N2G : I_N1G) + l * DM;
    for (int row = gw; row < MT; row += NGW) {
        const float* xr = which ? WSP(float, WS_X1) + (size_t)row * DM : xrow_in(F, l, row);
        const float* mod = WSP(float, WS_MOD) + ((size_t)l * 36 + row_bb(row)) * 6144 + (which ? 3072 : 0);
        f32x4 v[4]; float ss = 0.f;
#pragma unroll
        for (int j = 0; j < 4; ++j) { v[j] = *(const f32x4*)(xr + lane * 4 + 256 * j); ss += (v[j][0] * v[j][0] + v[j][1] * v[j][1]) + (v[j][2] * v[j][2] + v[j][3] * v[j][3]); }
        const float rs = 1.0f / sqrtf(wave_sum(ss) * (1.0f / DM) + EPS);
        bf16* o = WSP(bf16, WS_H) + (size_t)row * DM;
#pragma unroll
        for (int j = 0; j < 4; ++j) { const int c = lane * 4 + 256 * j; const f32x4 gg = *(const f32x4*)(g + c), sh = *(const f32x4*)(mod + c), sc = *(const f32x4*)(mod + 1024 + c);
            const f32x4 y = (v[j] * rs) * gg * (sc + 1.0f) + sh; v2u w; w.x = pk2(y[0], y[1]); w.y = pk2(y[2], y[3]); *(v2u*)(o + c) = w; }
    }
}
__device__ __forceinline__ void final_phase(Frame& F) {
    const int gw = F.bid * NWAVES + F.wave, NGW = F.G * NWAVES, lane = F.lane;
    const float* g = FIN(I_FNG);
    for (int row = gw; row < MT; row += NGW) {
        const float* xr = WSP(float, WS_X2) + (size_t)row * DM;
        f32x4 v[4]; float ss = 0.f;
#pragma unroll
        for (int j = 0; j < 4; ++j) { v[j] = *(const f32x4*)(xr + lane * 4 + 256 * j); ss += (v[j][0] * v[j][0] + v[j][1] * v[j][1]) + (v[j][2] * v[j][2] + v[j][3] * v[j][3]); }
        const float rs = 1.0f / sqrtf(wave_sum(ss) * (1.0f / DM) + EPS);
        float* o = F.out + OUT_Y + (size_t)row * DM;
#pragma unroll
        for (int j = 0; j < 4; ++j) { const int c = lane * 4 + 256 * j; *(f32x4*)(o + c) = (v[j] * rs) * *(const f32x4*)(g + c); }
    }
}

#define EPI_LOOP_BEGIN \
    _Pragma("unroll") for (int ai = 0; ai < 2; ++ai) _Pragma("unroll") for (int m = 0; m < 4; ++m) { const int row = u.pm * 256 + ai * 128 + wr * 64 + m * 16 + fr; \
    _Pragma("unroll") for (int bj = 0; bj < 2; ++bj) { const int ct = bj * 128 + wc * 32 + 8 * fq; const f32x4 v0 = acc[ai][bj][m][0], v1 = acc[ai][bj][m][1];
#define EPI_LOOP_END } }

struct EpiWin {
    static constexpr bool PERM = true, AFTER_DRAIN = false;
    unsigned char* ws; float* out; int l;
    __device__ __forceinline__ void operator()(const f32x4 (&acc)[2][2][4][2], const pg8::Unit& u, int wr, int wc, int fr0, int fq0) const {
        int fr = fr0, fq = fq0; asm volatile("" : "+v"(fr), "+v"(fq));
        const int pn = u.pn;
        if (pn < 2) {
            bf16* QN = (bf16*)(ws + WS_QN);
            EPI_LOOP_BEGIN *(v4u*)(QN + (size_t)row * 512 + pn * 256 + ct) = pack8(v0 * QSCALE, v1 * QSCALE); EPI_LOOP_END
        } else if (pn < 5) {
            EPI_LOOP_BEGIN
                const int c = (pn - 2) * 256 + ct, j = c >> 7, k = (c >> 6) & 1, d = c & 63;
                const bool isp = row < PM; const int b = isp ? (row >> 12) : ((row - PM) >> 3), t = isp ? (row & (PT - 1)) : ((row - PM) & 7);
                if (j < 4) { float* o = out + (isp ? OUT_ROWS_P + ((size_t)l * PM + row) * 512 : OUT_ROWS_S + ((size_t)l * SM + (row - PM)) * 512) + c; *(f32x4*)o = v0; *(f32x4*)(o + 4) = v1; }
                else if (isp) { if (t >= PT - WINB) { float* o = out + OUT_WIN_P + (((size_t)l * PB + b) * WINB + (t - (PT - WINB))) * 256 + (c - 512); *(f32x4*)o = v0; *(f32x4*)(o + 4) = v1; } }
                else { float* o = out + OUT_WIN_S + (((size_t)l * SB + b) * WINB + (WINB - ST) + t) * 256 + (c - 512); *(f32x4*)o = v0; *(f32x4*)(o + 4) = v1; }
                const v4u w = pack8(v0, v1);
                if (isp) {
                    if (j < 2) *(v4u*)((bf16*)(ws + WS_ACMP) + ((size_t)(l * 2 + j) * CMP_ROWS_J + 32768 + (b * 2 + k) * 256) * 1024 + (size_t)t * 64 + d) = w;
                    else *(v4u*)((bf16*)(ws + WS_KVB) + ((((size_t)(j - 2) * PB + b) * 2 + k) * PT + t) * 64 + d) = w;
                } else if (j >= 2) *(v4u*)((bf16*)(ws + WS_KVS) + ((((size_t)(j - 2) * SB + b) * 2 + k) * ST + t) * 64 + d) = w;
            EPI_LOOP_END
        } else if (pn < 9) {
            const float* ROTC = (const float*)(ws + WS_ROT); const float* ROTS = ROTC + 4104 * 64;
            EPI_LOOP_BEGIN
                const int c = (pn - 5) * 256 + ct, isk = c >> 9, hc = c & 511, head = hc >> 7, d0 = ((hc & 127) >> 3) * 4;
                const int pi = row_pos(row); const f32x4 cs = *(const f32x4*)(ROTC + pi * 64 + d0), sn = *(const f32x4*)(ROTS + pi * 64 + d0);
                const float sc = isk ? 0.08838834764831845f : 1.0f;
                const f32x4 o1 = (v0 * cs - v1 * sn) * sc, o2 = (v0 * sn + v1 * cs) * sc;
                bf16* o = (bf16*)(ws + WS_RQ) + (size_t)isk * MT * 512 + (size_t)row * 512 + head * 128 + d0;
                v2u w1; w1.x = pk2(o1[0], o1[1]); w1.y = pk2(o1[2], o1[3]); *(v2u*)o = w1;
                v2u w2; w2.x = pk2(o2[0], o2[1]); w2.y = pk2(o2[2], o2[3]); *(v2u*)(o + 64) = w2;
            EPI_LOOP_END
        } else if (pn < 13) {
            bf16* RV = (bf16*)(ws + WS_RQ) + (size_t)2 * MT * 512;
            EPI_LOOP_BEGIN const int c = (pn - 9) * 256 + ct; *(v4u*)(RV + (size_t)(c >> 9) * MT * 512 + (size_t)row * 512 + (c & 511)) = pack8(v0, v1); EPI_LOOP_END
        } else if (pn < 15) {
            float* RX = (float*)(ws + WS_RX);
            EPI_LOOP_BEGIN
                const int c = (pn - 13) * 256 + ct; float* o = RX + (size_t)row * 512 + c; *(f32x4*)o = v0; *(f32x4*)(o + 4) = v1;
                if (row < PM) { const int t = row & (PT - 1); if (t >= PT - 3) { float* q = out + OUT_CV_P + (((size_t)l * PB + (row >> 12)) * 3 + (t - (PT - 3))) * 512 + c; *(f32x4*)q = v0; *(f32x4*)(q + 4) = v1; } }
                else { const int i = (row - PM) & 7; if (i >= ST - 3) { float* q = out + OUT_CV_S + (((size_t)l * SB + ((row - PM) >> 3)) * 3 + (i - (ST - 3))) * 512 + c; *(f32x4*)q = v0; *(f32x4*)(q + 4) = v1; } }
            EPI_LOOP_END
        } else if (pn < 17) {
            bf16* GG = (bf16*)(ws + WS_GG);
            EPI_LOOP_BEGIN const int c = (pn - 15) * 256 + ct;
                f32x4 a, b;
#pragma unroll
                for (int i = 0; i < 4; ++i) { a[i] = gelu_tanh(v0[i]); b[i] = gelu_tanh(v1[i]); }
                *(v4u*)(GG + (size_t)row * 512 + c) = pack8(a, b); EPI_LOOP_END
        } else if (pn < 29) {
            bf16* MG = (bf16*)(ws + WS_MGS);
            EPI_LOOP_BEGIN const int c = (pn - 17) * 256 + ct;
                f32x4 a, b;
#pragma unroll
                for (int i = 0; i < 4; ++i) { a[i] = sigmoidf_(v0[i]); b[i] = sigmoidf_(v1[i]); }
                *(v4u*)(MG + (size_t)row * 3072 + c) = pack8(a, b); EPI_LOOP_END
        } else {
            float* NG = (float*)(ws + WS_NG);
            EPI_LOOP_BEGIN if (ct < 24) { f32x4 a, b;
#pragma unroll
                for (int i = 0; i < 4; ++i) { a[i] = sigmoidf_(v0[i]); b[i] = sigmoidf_(v1[i]); }
                float* o = NG + (size_t)row * 24 + ct; *(f32x4*)o = a; *(f32x4*)(o + 4) = b; } EPI_LOOP_END
        }
    }
};

struct EpiLH {
    static constexpr bool PERM = true, AFTER_DRAIN = false;
    bf16* LH;
    __device__ __forceinline__ void operator()(const f32x4 (&acc)[2][2][4][2], const pg8::Unit& u, int wr, int wc, int fr0, int fq0) const {
        int fr = fr0, fq = fq0; asm volatile("" : "+v"(fr), "+v"(fq));
        EPI_LOOP_BEGIN *(v4u*)(LH + (size_t)row * 256 + ct) = pack8(v0, v1); EPI_LOOP_END
    }
};
struct CmpOrder {
    int G, c;
    __device__ bool next(int i, pg8::Unit& u) const { const int L = i * G + c; if (L >= CMP_ROWS / 256) return false; u.pm = L; u.pn = L / (CMP_ROWS_J / 256); return true; }
    __device__ __forceinline__ void a_ready(const pg8::Unit&) const {}
    __device__ __forceinline__ void done(const pg8::Unit&) const {}
};

template <int BR> struct EpiBr {
    static constexpr bool PERM = true, AFTER_DRAIN = false;
    unsigned char* ws;
    __device__ __forceinline__ void operator()(const f32x4 (&acc)[2][2][4][2], const pg8::Unit& u, int wr, int wc, int fr0, int fq0) const {
        int fr = fr0, fq = fq0; asm volatile("" : "+v"(fr), "+v"(fq));
        const bf16* MG = (const bf16*)(ws + WS_MGS); bf16* MR = (bf16*)(ws + WS_MRG);
        EPI_LOOP_BEGIN
            const int col = u.pn * 256 + ct; f32x4 g0, g1; unpack8(*(const v4u*)(MG + (size_t)row * 3072 + BR * 1024 + col), g0, g1);
            f32x4 r0 = v0 * g0, r1 = v1 * g1; bf16* o = MR + (size_t)row * DM + col;
            if (BR > 0) { f32x4 p0, p1; unpack8(*(const v4u*)o, p0, p1); r0 += p0; r1 += p1; }
            *(v4u*)o = pack8(r0, r1);
        EPI_LOOP_END
    }
};

struct EpiRes {
    static constexpr bool PERM = true, AFTER_DRAIN = false;
    const float* xin_p; const float* xin_s; float* xout; const float* mod; int gofs;
    __device__ __forceinline__ void operator()(const f32x4 (&acc)[2][2][4][2], const pg8::Unit& u, int wr, int wc, int fr0, int fq0) const {
        int fr = fr0, fq = fq0; asm volatile("" : "+v"(fr), "+v"(fq));
        EPI_LOOP_BEGIN
            const int col = u.pn * 256 + ct; const float* xi = (xin_s && row >= PM) ? xin_s + (size_t)(row - PM) * DM + col : xin_p + (size_t)row * DM + col;
            const float* g = mod + (size_t)row_bb(row) * 6144 + gofs + col; float* o = xout + (size_t)row * DM + col;
            *(f32x4*)o = *(const f32x4*)xi + *(const f32x4*)g * v0; *(f32x4*)(o + 4) = *(const f32x4*)(xi + 4) + *(const f32x4*)(g + 4) * v1;
        EPI_LOOP_END
    }
};

struct EpiUp {
    static constexpr bool PERM = true, AFTER_DRAIN = false;
    unsigned char* ws; float* out; int l;
    __device__ __forceinline__ void operator()(const f32x4 (&acc)[2][2][4][2], const pg8::Unit& u, int wr, int wc, int fr0, int fq0) const {
        int fr = fr0, fq = fq0; asm volatile("" : "+v"(fr), "+v"(fq));
        bf16* GP = (bf16*)(ws + WS_GP); bf16* VAL = GP + (size_t)MT * DFF;
        if (u.pn < 11) {
            EPI_LOOP_BEGIN const int c = u.pn * 256 + ct; *(v4u*)(GP + (size_t)row * DFF + c) = pack8(v0, v1);
                if (row < PM) { const int t = row & (PT - 1); if (t >= PT - 2) { float* q = out + OUT_FC_P + (((size_t)l * PB + (row >> 12)) * 2 + (t - (PT - 2))) * DFF + c; *(f32x4*)q = v0; *(f32x4*)(q + 4) = v1; } }
                else { const int i = (row - PM) & 7; if (i >= ST - 2) { float* q = out + OUT_FC_S + (((size_t)l * SB + ((row - PM) >> 3)) * 2 + (i - (ST - 2))) * DFF + c; *(f32x4*)q = v0; *(f32x4*)(q + 4) = v1; } }
            EPI_LOOP_END
        } else {
            EPI_LOOP_BEGIN const int c = (u.pn - 11) * 256 + ct; *(v4u*)(VAL + (size_t)row * DFF + c) = pack8(v0, v1); EPI_LOOP_END
        }
    }
};

__device__ __forceinline__ f32x16 mfma32(bf16x8 a, bf16x8 b, f32x16 c) { return __builtin_amdgcn_mfma_f32_32x32x16_bf16(a, b, c, 0, 0, 0); }
__device__ __forceinline__ f32x4 mfma16(bf16x8 a, bf16x8 b, f32x4 c) { return __builtin_amdgcn_mfma_f32_16x16x32_bf16(a, b, c, 0, 0, 0); }
__device__ __forceinline__ float ret_log_g(int h) { return log1pf(-exp2f(-5.0f - (float)h)); }
__device__ __forceinline__ bf16x8 tr_frag(const LAS unsigned char* base, int rs_bytes, int rowA, int rowB, int colbase, int lane) {
    const int q = (lane & 15) >> 2, p = lane & 3;
    const LAS unsigned char* pa = base + (rowA + q) * rs_bytes + (colbase + 4 * p) * 2;
    const LAS unsigned char* pb = base + (rowB + q) * rs_bytes + (colbase + 4 * p) * 2;
    const s16x4 a = __builtin_bit_cast(s16x4, __builtin_amdgcn_ds_read_tr16_b64_v4i16((LAS s16x4*)pa));
    const s16x4 b = __builtin_bit_cast(s16x4, __builtin_amdgcn_ds_read_tr16_b64_v4i16((LAS s16x4*)pb));
    return (bf16x8){a[0], a[1], a[2], a[3], b[0], b[1], b[2], b[3]};
}
__device__ __forceinline__ bf16x8 cvt_frag(const f32x16& p, int s2) {
    u32x4 w; w.x = pk2(p[8 * s2 + 0], p[8 * s2 + 1]); w.y = pk2(p[8 * s2 + 2], p[8 * s2 + 3]); w.z = pk2(p[8 * s2 + 4], p[8 * s2 + 5]); w.w = pk2(p[8 * s2 + 6], p[8 * s2 + 7]);
    return __builtin_bit_cast(bf16x8, w);
}

__device__ __forceinline__ void cmp2_phase(Frame& F, int l) {
    const int gw = F.bid * NWAVES + F.wave, NGW = F.G * NWAVES, lane = F.lane, r = lane & 15, g = lane >> 4;
    const bf16* LH = WSP(bf16, WS_LH); bf16* CK = WSP(bf16, WS_CK);
    for (int wu = gw; wu < CMP_ROWS / 16; wu += NGW) {
        const int row0 = wu * 16, j = row0 / CMP_ROWS_J, rj = (row0 % CMP_ROWS_J) + r, row = row0 + r;
        const bool valid = (rj < 32768) ? ((rj & 511) < 511) : (((rj - 32768) & 255) < 255);
        const bf16* W2T = WSP(bf16, WS_SMALLW + SW_W2T) + (size_t)(l * 2 + j) * 64 * 128; const float* CB = WSP(float, WS_SMALLW + SW_CB) + (l * 2 + j) * 128;
        f32x4 acc[4];
#pragma unroll
        for (int ct = 0; ct < 4; ++ct) acc[ct] = (f32x4){0.f, 0.f, 0.f, 0.f};
#pragma unroll
        for (int ks = 0; ks < 4; ++ks) {
            const int h0 = 32 * ks + 8 * g; f32x4 a0, a1, b0, b1;
            unpack8(*(const v4u*)(LH + (size_t)row * 256 + h0), a0, a1); unpack8(*(const v4u*)(LH + (size_t)(row + 1) * 256 + 128 + h0), b0, b1);
            const f32x4 c0 = *(const f32x4*)(CB + h0), c1 = *(const f32x4*)(CB + h0 + 4);
            f32x4 x0 = a0 + b0 + c0, x1 = a1 + b1 + c1;
#pragma unroll
            for (int i = 0; i < 4; ++i) { x0[i] = gelu_tanh(x0[i]); x1[i] = gelu_tanh(x1[i]); }
            const bf16x8 hf = __builtin_bit_cast(bf16x8, pack8(x0, x1));
#pragma unroll
            for (int ct = 0; ct < 4; ++ct) { const bf16x8 wf = *(const bf16x8*)(W2T + (size_t)(16 * ct + r) * 128 + h0); acc[ct] = mfma16(wf, hf, acc[ct]); }
        }
#pragma unroll
        for (int ct = 0; ct < 4; ++ct) { const f32x4 v = valid ? acc[ct] : (f32x4){0.f, 0.f, 0.f, 0.f}; v2u w; w.x = pk2(v[0], v[1]); w.y = pk2(v[2], v[3]);
            *(v2u*)(CK + (size_t)row * 64 + 16 * ct + 4 * g) = w; }
    }
}

constexpr int RS_KV = 272;
__device__ __forceinline__ void ret_local_unit(Frame& F, int unit) {
    const int bh = unit >> 5, c = unit & 31, b = bh >> 2, h = bh & 3, lane = F.lane, w = F.wave;
    const float lg = ret_log_g(h);
    LAS unsigned char* KS = F.lds; LAS unsigned char* VS = F.lds + 128 * RS_KV;
    const bf16* RK = WSP(bf16, WS_RQ) + (size_t)MT * 512; const bf16* RV = WSP(bf16, WS_RQ) + (size_t)2 * MT * 512;
    __syncthreads();
#pragma unroll
    for (int i = 0; i < 4; ++i) { const int p = F.tid + NTHR * i, j = p >> 4, ch = p & 15; const size_t go = (size_t)(b * PT + 128 * c + j) * 512 + h * 128 + ch * 8;
        f32x4 k0, k1; unpack8(*(const v4u*)(RK + go), k0, k1); const float kw = fexp((float)(127 - j) * lg);
        *(LAS v4u*)(KS + j * RS_KV + ch * 16) = pack8(k0 * kw, k1 * kw);
        *(LAS v4u*)(VS + j * RS_KV + ch * 16) = *(const v4u*)(RV + go); }
    __syncthreads();
    const int et = w >> 1, dt0 = 2 * (w & 1), h_ = lane >> 5, blk = (lane >> 4) & 1;
    f32x16 acc[2]; acc[0] = (f32x16){}; acc[1] = (f32x16){};
#pragma unroll
    for (int ks = 0; ks < 8; ++ks) {
        const int rA = 16 * ks + 8 * h_;
        const bf16x8 af = tr_frag(VS, RS_KV, rA, rA + 4, 32 * et + 16 * blk, lane);
#pragma unroll
        for (int dd = 0; dd < 2; ++dd) { const bf16x8 bfr = tr_frag(KS, RS_KV, rA, rA + 4, 32 * (dt0 + dd) + 16 * blk, lane); acc[dd] = mfma32(af, bfr, acc[dd]); }
    }
    float* LT = WSP(float, WS_LT) + ((size_t)bh * 32 + c) * 16384;
#pragma unroll
    for (int dd = 0; dd < 2; ++dd)
#pragma unroll
        for (int r = 0; r < 16; ++r) { const int e = 32 * et + (r & 3) + 8 * (r >> 2) + 4 * h_; LT[e * 128 + 32 * (dt0 + dd) + (lane & 31)] = acc[dd][r]; }
}
__device__ __forceinline__ void ret_scan_phase(Frame& F, int l) {
    const float* LT = WSP(float, WS_LT); bf16* SPT = WSP(bf16, WS_SPT);
    for (int idx = F.bid * NTHR + F.tid; idx < 16 * 16384; idx += F.G * NTHR) {
        const int bh = idx >> 14, ed = idx & 16383, e = ed >> 7, d = ed & 127, h = bh & 3; const float g128 = fexp(128.0f * ret_log_g(h));
        float S = 0.f;
        for (int c = 0; c < 32; ++c) { const size_t o = ((size_t)bh * 32 + c) * 16384 + ed; SPT[o] = (bf16)(pk2(S, 0.f) & 0xffffu); S = S * g128 + LT[o]; }
        F.out[OUT_RET_P + ((size_t)l * 16 + bh) * 16384 + d * 128 + e] = S;
    }
}
__device__ __forceinline__ void ret_out_unit(Frame& F, int l, int unit) {
    const int bh = unit >> 5, c = unit & 31, b = bh >> 2, h = bh & 3, lane = F.lane, w = F.wave, tid = F.tid;
    const float lg = ret_log_g(h);
    LAS unsigned char* KS = F.lds; LAS unsigned char* VS = F.lds + 128 * RS_KV; LAS float* OT = (LAS float*)F.lds; LAS float* STAT = (LAS float*)(F.lds + 2 * 128 * RS_KV);
    const bf16* RQ = WSP(bf16, WS_RQ); const bf16* RK = RQ + (size_t)MT * 512; const bf16* RV = RQ + (size_t)2 * MT * 512; const bf16* RG = RQ + (size_t)3 * MT * 512;
    const size_t row0 = (size_t)b * PT + 128 * c;
    __syncthreads();
#pragma unroll
    for (int i = 0; i < 4; ++i) { const int p = tid + NTHR * i, j = p >> 4, ch = p & 15; const size_t go = (row0 + j) * 512 + h * 128 + ch * 8;
        *(LAS v4u*)(KS + j * RS_KV + ch * 16) = *(const v4u*)(RK + go); *(LAS v4u*)(VS + j * RS_KV + ch * 16) = *(const v4u*)(RV + go); }
    const int it = w & 3, eh = w >> 2, h_ = lane >> 5, blk = (lane >> 4) & 1, il = 32 * it + (lane & 31);
    bf16x8 qf[8];
#pragma unroll
    for (int ks = 0; ks < 8; ++ks) qf[ks] = *(const bf16x8*)(RQ + (row0 + il) * 512 + h * 128 + 16 * ks + 8 * h_);
    f32x16 acc[2]; acc[0] = (f32x16){}; acc[1] = (f32x16){};
    const bf16* SP = WSP(bf16, WS_SPT) + ((size_t)bh * 32 + c) * 16384;
#pragma unroll
    for (int ks = 0; ks < 8; ++ks)
#pragma unroll
        for (int e2 = 0; e2 < 2; ++e2) { const bf16x8 af = *(const bf16x8*)(SP + (size_t)(32 * (2 * eh + e2) + (lane & 31)) * 128 + 16 * ks + 8 * h_); acc[e2] = mfma32(af, qf[ks], acc[e2]); }
    { const float cr = fexp((float)(il + 1) * lg); acc[0] *= cr; acc[1] *= cr; }
    __syncthreads();
    for (int jt = 0; jt <= it; ++jt) {
        f32x16 s = (f32x16){};
#pragma unroll
        for (int ks = 0; ks < 8; ++ks) { const bf16x8 kf = *(const LAS bf16x8*)(KS + (32 * jt + (lane & 31)) * RS_KV + (16 * ks + 8 * h_) * 2); s = mfma32(kf, qf[ks], s); }
#pragma unroll
        for (int r = 0; r < 16; ++r) { const int j = 32 * jt + (r & 3) + 8 * (r >> 2) + 4 * h_; const int df = il - j; s[r] = (df >= 0) ? s[r] * fexp((float)df * lg) : 0.f; }
#pragma unroll
        for (int s2 = 0; s2 < 2; ++s2) { const bf16x8 pf = cvt_frag(s, s2); const int rA = 32 * jt + 16 * s2 + 4 * h_;
#pragma unroll
            for (int e2 = 0; e2 < 2; ++e2) { const bf16x8 vf = tr_frag(VS, RS_KV, rA, rA + 8, 32 * (2 * eh + e2) + 16 * blk, lane); acc[e2] = mfma32(vf, pf, acc[e2]); } }
    }
    float s1 = 0.f, s2 = 0.f;
#pragma unroll
    for (int e2 = 0; e2 < 2; ++e2)
#pragma unroll
        for (int r = 0; r < 16; ++r) { const float v = acc[e2][r]; s1 += v; s2 += v * v; }
    s1 += __shfl_xor(s1, 32); s2 += __shfl_xor(s2, 32);
    if (lane < 32) { STAT[(w * 32 + lane) * 2] = s1; STAT[(w * 32 + lane) * 2 + 1] = s2; }
    __syncthreads();
    { const int pw = w ^ 4; s1 += STAT[(pw * 32 + (lane & 31)) * 2]; s2 += STAT[(pw * 32 + (lane & 31)) * 2 + 1]; }
    const float mean = s1 * (1.0f / 128.0f), var = fmaxf(s2 * (1.0f / 128.0f) - mean * mean, 0.f), rstd = 1.0f / sqrtf(var + EPS);
#pragma unroll
    for (int e2 = 0; e2 < 2; ++e2)
#pragma unroll
        for (int r4 = 0; r4 < 4; ++r4) { const int e = 32 * (2 * eh + e2) + 8 * r4 + 4 * h_;
            f32x4 v; v[0] = (acc[e2][4 * r4 + 0] - mean) * rstd; v[1] = (acc[e2][4 * r4 + 1] - mean) * rstd; v[2] = (acc[e2][4 * r4 + 2] - mean) * rstd; v[3] = (acc[e2][4 * r4 + 3] - mean) * rstd;
            *(LAS f32x4*)(OT + il * 132 + e) = v; }
    __syncthreads();
    const float* GN = FIN(I_GNG) + l * 512 + h * 128; bf16* OR_ = WSP(bf16, WS_OA) + (size_t)MT * 512;
#pragma unroll
    for (int k = 0; k < 4; ++k) { const int q = tid + NTHR * k, i = q >> 4, ch = q & 15;
        const f32x4 o0 = *(const LAS f32x4*)(OT + i * 132 + 8 * ch), o1 = *(const LAS f32x4*)(OT + i * 132 + 8 * ch + 4);
        const f32x4 g0 = *(const f32x4*)(GN + 8 * ch), g1 = *(const f32x4*)(GN + 8 * ch + 4); f32x4 r0, r1; unpack8(*(const v4u*)(RG + (row0 + i) * 512 + h * 128 + 8 * ch), r0, r1);
        f32x4 y0, y1;
#pragma unroll
        for (int x = 0; x < 4; ++x) { y0[x] = o0[x] * g0[x] * siluf_(r0[x]); y1[x] = o1[x] * g1[x] * siluf_(r1[x]); }
        *(v4u*)(OR_ + (row0 + i) * 512 + h * 128 + 8 * ch) = pack8(y0, y1); }
}
__device__ __forceinline__ void ret_sample_unit(Frame& F, int l, int unit) {
    const int db = unit >> 2, h = unit & 3, tid = F.tid, e = tid & 127, dp = tid >> 7;
    const float lg = ret_log_g(h);
    LAS float* Q = (LAS float*)F.lds; LAS float* K = Q + 1024; LAS float* V = K + 1024; LAS float* GT = V + 1024; LAS float* CR = GT + 1024;
    LAS float* SC = CR + 4096; LAS float* RED = SC + 64;
    const bf16* RQ = WSP(bf16, WS_RQ); const size_t row0 = (size_t)PM + db * 8;
    __syncthreads();
    for (int i = tid; i < 4096; i += NTHR) { const int which = i >> 10, r = (i >> 7) & 7, d = i & 127; const float v = bf1(RQ[(size_t)which * MT * 512 + (row0 + r) * 512 + h * 128 + d]); Q[which * 1024 + r * 128 + d] = v; }
    __syncthreads();
    const float* S0 = FIN(I_SRET) + (((size_t)l * SB + db) * 4 + h) * 16384; float* SN = F.out + OUT_RET_S + (((size_t)l * SB + db) * 4 + h) * 16384;
    float kwv[8], cr[8];
#pragma unroll
    for (int j = 0; j < 8; ++j) { kwv[j] = V[j * 128 + e] * fexp((float)(7 - j) * lg); cr[j] = 0.f; }
    const float g8 = fexp(8.0f * lg);
    for (int d = dp * 32; d < dp * 32 + 32; ++d) {
        const float s0 = S0[d * 128 + e]; float sn = g8 * s0;
#pragma unroll
        for (int j = 0; j < 8; ++j) { cr[j] += Q[j * 128 + d] * s0; sn += K[j * 128 + d] * kwv[j]; }
        SN[d * 128 + e] = sn;
    }
#pragma unroll
    for (int i = 0; i < 8; ++i) CR[(dp * 8 + i) * 128 + e] = cr[i];
    if (tid < 64) { const int i = tid >> 3, j = tid & 7; float s = 0.f; if (j <= i) { for (int d = 0; d < 128; ++d) s += Q[i * 128 + d] * K[j * 128 + d]; s *= fexp((float)(i - j) * lg); } SC[tid] = s; }
    __syncthreads();
    float o[2];
#pragma unroll
    for (int ii = 0; ii < 2; ++ii) { const int i = 2 * dp + ii; float x = (CR[(0 * 8 + i) * 128 + e] + CR[(1 * 8 + i) * 128 + e] + CR[(2 * 8 + i) * 128 + e] + CR[(3 * 8 + i) * 128 + e]) * fexp((float)(i + 1) * lg);
        for (int j = 0; j <= i; ++j) x += SC[i * 8 + j] * V[j * 128 + e];
        o[ii] = x; }
#pragma unroll
    for (int ii = 0; ii < 2; ++ii) { const float a = wave_sum(o[ii]), q = wave_sum(o[ii] * o[ii]); if (F.lane == 0) { RED[(F.wave * 2 + ii) * 2] = a; RED[(F.wave * 2 + ii) * 2 + 1] = q; } }
    __syncthreads();
    const float* GN = FIN(I_GNG) + l * 512 + h * 128; bf16* OR_ = WSP(bf16, WS_OA) + (size_t)MT * 512;
#pragma unroll
    for (int ii = 0; ii < 2; ++ii) { const int i = 2 * dp + ii, w0 = 2 * dp; const float s1 = RED[(w0 * 2 + ii) * 2] + RED[((w0 + 1) * 2 + ii) * 2], s2 = RED[(w0 * 2 + ii) * 2 + 1] + RED[((w0 + 1) * 2 + ii) * 2 + 1];
        const float mean = s1 * (1.0f / 128.0f), var = fmaxf(s2 * (1.0f / 128.0f) - mean * mean, 0.f), rstd = 1.0f / sqrtf(var + EPS);
        const float y = (o[ii] - mean) * rstd * GN[e] * siluf_(GT[i * 128 + e]);
        OR_[(row0 + i) * 512 + h * 128 + e] = (bf16)(pk2(y, 0.f) & 0xffffu); }
}

template <int MODE> __device__ __forceinline__ void rglru_unit(Frame& F, int l, int unit) {
    const int tid = F.tid, c = tid, lane = F.lane, w = F.wave;
    LAS bf16* XC = (LAS bf16*)F.lds; LAS float* G = (LAS float*)(F.lds + 16384);
    const int seq = (MODE == 2) ? unit : (unit >> 6), tile = (MODE == 2) ? 0 : (unit & 63);
    const size_t row0 = (MODE == 2) ? (size_t)PM + seq * 8 : (size_t)seq * PT + tile * 64;
    const int ntok = (MODE == 2) ? 8 : 64, nsub = (MODE == 2) ? 1 : 4;
    const float* RX = WSP(float, WS_RX);
    const float w0 = FIN(I_RCW)[(l * 4 + 0) * 512 + c], w1 = FIN(I_RCW)[(l * 4 + 1) * 512 + c], w2 = FIN(I_RCW)[(l * 4 + 2) * 512 + c], w3 = FIN(I_RCW)[(l * 4 + 3) * 512 + c], cb = FIN(I_RCB)[l * 512 + c];
    const float ba = FIN(I_RBA)[l * 512 + c], bx = FIN(I_RBX)[l * 512 + c], sp = WSP(float, WS_SMALLW + SW_SP)[l * 512 + c];
    float x3, x2, x1;
    if (MODE == 2) { const float* cv = FIN(I_SCONV) + ((size_t)l * SB + seq) * 3 * 512; x3 = cv[c]; x2 = cv[512 + c]; x1 = cv[1024 + c]; }
    else if (tile == 0) { x3 = 0.f; x2 = 0.f; x1 = 0.f; }
    else { x3 = RX[(row0 - 3) * 512 + c]; x2 = RX[(row0 - 2) * 512 + c]; x1 = RX[(row0 - 1) * 512 + c]; }
    float h = (MODE == 0) ? 0.f : (MODE == 1) ? WSP(float, WS_CAR)[(size_t)4 * 64 * 2 * 512 + ((size_t)seq * 64 + tile) * 512 + c] : FIN(I_SH)[((size_t)l * SB + seq) * 512 + c];
    float aprod = 1.f;
    const int r16 = lane & 15, g4 = lane >> 4;
    bf16x8 wa[4][2], wx[4][2];
    { const bf16* WA = WSP(bf16, WS_SMALLW + SW_WAT) + ((size_t)(l * 2 + 0) * 8 + w) * 4096; const bf16* WX = WSP(bf16, WS_SMALLW + SW_WAT) + ((size_t)(l * 2 + 1) * 8 + w) * 4096;
#pragma unroll
      for (int ct = 0; ct < 4; ++ct)
#pragma unroll
          for (int ks = 0; ks < 2; ++ks) { wa[ct][ks] = *(const bf16x8*)(WA + (16 * ct + r16) * 64 + 32 * ks + 8 * g4); wx[ct][ks] = *(const bf16x8*)(WX + (16 * ct + r16) * 64 + 32 * ks + 8 * g4); } }
    const bf16* GG = WSP(bf16, WS_GG); bf16* OC = WSP(bf16, WS_OA) + (size_t)2 * MT * 512;
    __syncthreads();
    for (int s = 0; s < nsub; ++s) {
        float xc[16], gg[16];
#pragma unroll
        for (int tt = 0; tt < 16; ++tt) { const int t = s * 16 + tt; xc[tt] = (t < ntok) ? RX[(row0 + t) * 512 + c] : 0.f; gg[tt] = (MODE != 0 && t < ntok) ? bf1(GG[(row0 + t) * 512 + c]) : 0.f; }
#pragma unroll
        for (int tt = 0; tt < 16; ++tt) { const float x0 = xc[tt];
            xc[tt] = cb + w0 * x3 + w1 * x2 + w2 * x1 + w3 * x0; x3 = x2; x2 = x1; x1 = x0; XC[tt * 512 + c] = (bf16)(pk2(xc[tt], 0.f) & 0xffffu); }
        __syncthreads();
        {
            bf16x8 xf[2];
#pragma unroll
            for (int ks = 0; ks < 2; ++ks) xf[ks] = *(const LAS bf16x8*)(XC + r16 * 512 + w * 64 + 32 * ks + 8 * g4);
#pragma unroll
            for (int ct = 0; ct < 4; ++ct) { f32x4 da = (f32x4){0.f, 0.f, 0.f, 0.f}, dx = da;
#pragma unroll
                for (int ks = 0; ks < 2; ++ks) { da = mfma16(wa[ct][ks], xf[ks], da); dx = mfma16(wx[ct][ks], xf[ks], dx); }
                *(LAS f32x4*)(G + r16 * 512 + w * 64 + 16 * ct + 4 * g4) = da; *(LAS f32x4*)(G + 8192 + r16 * 512 + w * 64 + 16 * ct + 4 * g4) = dx; }
        }
        __syncthreads();
#pragma unroll
        for (int tt = 0; tt < 16; ++tt) { const int t = s * 16 + tt;
            if (t < ntok) {
                const float r = sigmoidf_(G[tt * 512 + c] + ba), ig = sigmoidf_(G[8192 + tt * 512 + c] + bx);
                const float la = -8.0f * r * sp, a = expf(la), bt = sqrtf(-expm1f(2.0f * la)) * (ig * xc[tt]);
                h = a * h + bt; aprod *= a;
                if (MODE != 0) { const size_t o = (row0 + t) * 512 + c; OC[o] = (bf16)(pk2(h * gg[tt], 0.f) & 0xffffu); }
            } }
    }
    if (MODE == 0) { float* CAR = WSP(float, WS_CAR) + ((size_t)seq * 64 + tile) * 1024; CAR[c] = aprod; CAR[512 + c] = h; }
    if (MODE == 2) F.out[OUT_H_S + ((size_t)l * SB + seq) * 512 + c] = h;
}
__device__ __forceinline__ void rglru_carry_phase(Frame& F, int l) {
    const float* CAR = WSP(float, WS_CAR); float* HIN = WSP(float, WS_CAR) + (size_t)4 * 64 * 2 * 512;
    for (int idx = F.bid * NTHR + F.tid; idx < PB * 512; idx += F.G * NTHR) {
        const int b = idx >> 9, c = idx & 511; float h = 0.f;
        for (int t = 0; t < 64; ++t) { HIN[((size_t)b * 64 + t) * 512 + c] = h; const float* cr = CAR + ((size_t)b * 64 + t) * 1024; h = cr[c] * h + cr[512 + c]; }
        F.out[OUT_H_P + ((size_t)l * PB + b) * 512 + c] = h;
    }
}

__device__ __forceinline__ void convact_phase(Frame& F, int l) {
    const bf16* GP = WSP(bf16, WS_GP); const bf16* VAL = GP + (size_t)MT * DFF; bf16* ACT = WSP(bf16, WS_GP) + (size_t)2 * MT * DFF;
    const float* CW = FIN(I_FCW) + (size_t)l * 3 * DFF; const float* CBI = FIN(I_FCB) + (size_t)l * DFF;
    constexpr int NRUN = PM / 16 + SB, NCG = DFF / 8;
    for (int it = F.bid * NTHR + F.tid; it < NRUN * NCG; it += F.G * NTHR) {
        const int run = it / NCG, cg = it % NCG, c = cg * 8;
        const bool isp = run < PM / 16; const size_t row0 = isp ? (size_t)run * 16 : (size_t)PM + (run - PM / 16) * 8; const int nt = isp ? 16 : 8;
        f32x4 p2a, p2b, p1a, p1b;
        if (isp) { if ((run & 255) == 0) { p2a = p2b = p1a = p1b = (f32x4){0.f, 0.f, 0.f, 0.f}; } else { unpack8(*(const v4u*)(GP + (row0 - 2) * DFF + c), p2a, p2b); unpack8(*(const v4u*)(GP + (row0 - 1) * DFF + c), p1a, p1b); } }
        else { const float* st = FIN(I_SFFN) + (((size_t)l * SB + (run - PM / 16)) * 2) * DFF + c; p2a = *(const f32x4*)st; p2b = *(const f32x4*)(st + 4); p1a = *(const f32x4*)(st + DFF); p1b = *(const f32x4*)(st + DFF + 4); }
        const f32x4 w0a = *(const f32x4*)(CW + c), w0b = *(const f32x4*)(CW + c + 4), w1a = *(const f32x4*)(CW + DFF + c), w1b = *(const f32x4*)(CW + DFF + c + 4), w2a = *(const f32x4*)(CW + 2 * DFF + c), w2b = *(const f32x4*)(CW + 2 * DFF + c + 4);
        const f32x4 ba = *(const f32x4*)(CBI + c), bb = *(const f32x4*)(CBI + c + 4);
        for (int t0 = 0; t0 < nt; t0 += 8) {
            v4u gx[8], vx[8];
#pragma unroll
            for (int k = 0; k < 8; ++k) { gx[k] = *(const v4u*)(GP + (row0 + t0 + k) * DFF + c); vx[k] = *(const v4u*)(VAL + (row0 + t0 + k) * DFF + c); }
#pragma unroll
            for (int k = 0; k < 8; ++k) {
                f32x4 xa, xb, va, vb; unpack8(gx[k], xa, xb); unpack8(vx[k], va, vb);
                f32x4 ya = ba + w0a * p2a + w1a * p1a + w2a * xa, yb = bb + w0b * p2b + w1b * p1b + w2b * xb;
#pragma unroll
                for (int i = 0; i < 4; ++i) { ya[i] = siluf_(ya[i]) * va[i]; yb[i] = siluf_(yb[i]) * vb[i]; }
                *(v4u*)(ACT + (row0 + t0 + k) * DFF + c) = pack8(ya, yb);
                p2a = p1a; p2b = p1b; p1a = xa; p1b = xb;
            }
        }
    }
}

constexpr int AT_RS = 144;
constexpr int AT_K0 = 0, AT_V0 = 2 * 64 * AT_RS, AT_PS = 4 * 64 * AT_RS, AT_IMP = AT_PS + 69632, AT_MASK = AT_IMP + 6144, AT_LIST = AT_MASK + 2048, AT_NL = AT_LIST + 1024;
constexpr unsigned AT_MARK = 0xFFFFu;
static_assert(AT_NL + 64 <= RING_BYTES, "attention LDS map");

struct TileRegs { v4u a, b, c, d; int mode; };

template <bool SMP> __device__ __forceinline__ void at_prefetch(const Frame& F, int l, int seq, int kvh, unsigned e, TileRegs& R) {
    const int kind = (int)(e >> 14), ti = (int)(e & 0x3fffu), rr = F.tid >> 3, pc = F.tid & 7;
    R.mode = 0;
    if (kind < 2) {
        const size_t rb = SMP ? (size_t)(seq * 2 + kvh) * 512 : (size_t)32768 + (size_t)(seq * 2 + kvh) * 256;
        const bf16* ck = WSP(bf16, WS_CK) + (rb + ti * 64 + rr) * 64 + pc * 8;
        R.a = *(const v4u*)ck; R.c = *(const v4u*)(ck + (size_t)CMP_ROWS_J * 64);
    } else if (!SMP) {
        const int jb = (kind == 2) ? 0 : 2;
        const bf16* kp = WSP(bf16, WS_KVB) + ((((size_t)jb * PB + seq) * 2 + kvh) * PT + ti * 64 + rr) * 64 + pc * 8;
        R.a = *(const v4u*)kp; R.c = *(const v4u*)(kp + (size_t)PB * 2 * PT * 64);
    } else if (kind == 2) {
        if (ti < 128) {
            const int page = ((const int*)F.a->in[I_PT])[seq * NPG + (ti >> 1)], slot = (ti & 1) * 64 + rr;
            const float* kp = FIN(I_CACHE) + (((((size_t)l * NPHYS + page) * PAGE + slot) * 4 + 2) * 2 + kvh) * 64 + pc * 8;
            R.a = *(const v4u*)kp; R.b = *(const v4u*)(kp + 4); R.c = *(const v4u*)(kp + 128); R.d = *(const v4u*)(kp + 132); R.mode = 1;
        } else if (rr < ST) {
            const bf16* kp = WSP(bf16, WS_KVS) + ((((size_t)0 * SB + seq) * 2 + kvh) * ST + rr) * 64 + pc * 8;
            R.a = *(const v4u*)kp; R.c = *(const v4u*)(kp + (size_t)SB * 2 * ST * 64);
        } else R.mode = 2;
    } else {
        if (ti < 8) {
            const float* kp = FIN(I_CWIN) + (((((size_t)l * SB + seq) * WINB + ti * 64 + rr) * 2 + 0) * 2 + kvh) * 64 + pc * 8;
            R.a = *(const v4u*)kp; R.b = *(const v4u*)(kp + 4); R.c = *(const v4u*)(kp + 128); R.d = *(const v4u*)(kp + 132); R.mode = 1;
        } else if (rr < ST) {
            const bf16* kp = WSP(bf16, WS_KVS) + ((((size_t)2 * SB + seq) * 2 + kvh) * ST + rr) * 64 + pc * 8;
            R.a = *(const v4u*)kp; R.c = *(const v4u*)(kp + (size_t)SB * 2 * ST * 64);
        } else R.mode = 2;
    }
}
__device__ __forceinline__ void at_store(const Frame& F, int buf, const TileRegs& R) {
    const int rr = F.tid >> 3, pc = F.tid & 7; v4u k, v;
    if (R.mode == 0) { k = R.a; v = R.c; }
    else if (R.mode == 1) { k = pack8(__builtin_bit_cast(f32x4, R.a), __builtin_bit_cast(f32x4, R.b)); v = pack8(__builtin_bit_cast(f32x4, R.c), __builtin_bit_cast(f32x4, R.d)); }
    else { k = (v4u){0u, 0u, 0u, 0u}; v = k; }
    *(LAS v4u*)(F.lds + AT_K0 + buf * 64 * AT_RS + rr * AT_RS + pc * 16) = k;
    *(LAS v4u*)(F.lds + AT_V0 + buf * 64 * AT_RS + rr * AT_RS + pc * 16) = v;
}

template <bool SMP> __device__ __forceinline__ void attn_unit(Frame& F, int l, int unit) {
    const int tid = F.tid, lane = F.lane, w = F.wave;
    const int q = lane & 31, h_ = lane >> 5, blk = (lane >> 4) & 1, tl = q >> 2, hr = q & 3;
    int seq, kvh, qt;
    if (SMP) { seq = unit >> 1; kvh = unit & 1; qt = 128; } else { seq = unit >> 7; kvh = (unit >> 6) & 1; qt = unit & 63; }
    const int t0 = SMP ? PAST : qt * 64;
    const int tokl = SMP ? tl : 8 * w + tl, t = t0 + tokl;
    const size_t row = SMP ? (size_t)PM + seq * ST + tl : (size_t)seq * PT + t;
    const int head = kvh * 4 + hr;
    LAS float* PS = (LAS float*)(F.lds + AT_PS); LAS float* IMPw = (LAS float*)(F.lds + AT_IMP) + w * 192;
    LAS unsigned long long* MASKS = (LAS unsigned long long*)(F.lds + AT_MASK); LAS unsigned short* LIST = (LAS unsigned short*)(F.lds + AT_LIST); LAS int* NL = (LAS int*)(F.lds + AT_NL);
    constexpr int PSS = SMP ? 520 : 264;
    LAS float* PSw = SMP ? PS : PS + w * 8 * PSS;
    __syncthreads();
    bf16x8 qf[4];
    { const bf16* qp = WSP(bf16, WS_QN) + row * 512 + head * 64 + 8 * h_;
#pragma unroll
      for (int kk = 0; kk < 4; ++kk) qf[kk] = *(const bf16x8*)(qp + 16 * kk); }
    const float* ngp = WSP(float, WS_NG) + row * 24 + head * 3; const float g0 = ngp[0], g1 = ngp[1], g2 = ngp[2];
    if (!SMP) { for (int i = lane; i < 8 * PSS; i += 64) PSw[i] = 0.f; }
    const int ntc = SMP ? 8 : ((t0 + 32) >> 10) + 1;
    if (tid < 2 * ntc) LIST[tid] = (unsigned short)(((tid >= ntc ? 1u : 0u) << 14) | (unsigned)(tid >= ntc ? tid - ntc : tid));
    if (tid == 0) LIST[2 * ntc] = (unsigned short)AT_MARK;
    int nl = 2 * ntc + 1;
    TileRegs R;
    at_prefetch<SMP>(F, l, seq, kvh, (unsigned)0, R);
    at_store(F, 0, R);
    __syncthreads();
    float m = -INFINITY, lsum = 0.f, invden = 0.f;
    f32x16 O[2]; O[0] = (f32x16){}; O[1] = (f32x16){};
    LAS float* OAw = (LAS float*)(F.lds + AT_PS) + w * (SMP ? 2048 : 8 * PSS) + lane;
    unsigned long long mk0 = 0ull, mk1 = 0ull, wu = ~0ull;
    int cur_kind = -1, idx = 0;
#define AT_FINALIZE(kind) do { \
        if ((kind) == 0) { const float lt = lsum + __shfl_xor(lsum, 32); invden = lt > 0.f ? 1.0f / lt : 0.f; } \
        else if ((kind) == 1) { const float sc = g0 * invden; O[0] *= sc; O[1] *= sc; } \
        else if ((kind) == 2) { const float lt = lsum + __shfl_xor(lsum, 32); const float sc = (lt > 0.f ? 1.0f / lt : 0.f) * g1; \
            _Pragma("unroll") for (int r_ = 0; r_ < 16; ++r_) { OAw[r_ * 64] += O[0][r_] * sc; OAw[(16 + r_) * 64] += O[1][r_] * sc; } } } while (0)
    while (idx < nl) {
        const unsigned e = (unsigned)__builtin_amdgcn_readfirstlane((int)LIST[idx]);
        if (e == AT_MARK) {
            AT_FINALIZE(cur_kind); cur_kind = -1;
            LDS_WAIT(); asm volatile("" ::: "memory");
#pragma unroll 1
            for (int tk = 0; tk < 8; ++tk) {
                const LAS float* pr = PSw + tk * PSS;
                if (!SMP) {
                    const int s = lane; float imp = 0.f;
#pragma unroll
                    for (int n = 4 * s - 1; n <= 4 * s + 3; ++n) if (n >= 0) imp += pr[n];
                    const bool forced = (s == 0) || (s == qt) || (s == qt - 1), avail = s <= qt;
                    const float val = avail ? (forced ? 1e4f : imp) : -1e4f;
                    IMPw[s] = val; LDS_WAIT(); asm volatile("" ::: "memory");
                    int rank = 0;
#pragma unroll 8
                    for (int i = 0; i < 64; ++i) { const float v = IMPw[i]; rank += (v > val || (v == val && i < s)) ? 1 : 0; }
                    const unsigned long long mk = __ballot(rank < 16);
                    if (lane == 0) MASKS[(8 * w + tk) * 4] = mk;
                    LDS_WAIT(); asm volatile("" ::: "memory");
                } else {
                    const int sa = lane, sb = lane + 64; float ia = 0.f, ib = 0.f;
#pragma unroll
                    for (int n = 4 * sa - 1; n <= 4 * sa + 3; ++n) if (n >= 0) ia += pr[n];
#pragma unroll
                    for (int n = 4 * sb - 1; n <= 4 * sb + 3; ++n) ib += pr[n];
                    const bool fa = (sa == 0), fb = (sb == 127);
                    const float va = fa ? 1e4f : ia, vb = fb ? 1e4f : ib;
                    IMPw[sa] = va; IMPw[sb] = vb; LDS_WAIT(); asm volatile("" ::: "memory");
                    int ra = fa ? 0 : 1, rb = fb ? 0 : 1;
#pragma unroll 8
                    for (int i = 0; i < 128; ++i) { const float v = IMPw[i]; ra += (v > va || (v == va && i < sa)) ? 1 : 0; rb += (v > vb || (v == vb && i < sb)) ? 1 : 0; }
                    const unsigned long long ma = __ballot(ra < 16), mb = __ballot(rb < 16);
                    if (lane == 0) { MASKS[tk * 4] = ma; MASKS[tk * 4 + 1] = mb; MASKS[tk * 4 + 2] = 1ull; }
                    LDS_WAIT(); asm volatile("" ::: "memory");
                }
            }
            __syncthreads();
#pragma unroll
            for (int r_ = 0; r_ < 16; ++r_) { OAw[r_ * 64] = O[0][r_]; OAw[(16 + r_) * 64] = O[1][r_]; }
            if (tid == 0) {
                int n = idx + 1;
                if (!SMP) { unsigned long long U = 0ull; for (int i = 0; i < 64; ++i) U |= MASKS[i * 4];
                    for (int s = 0; s <= qt; ++s) if ((U >> s) & 1ull) LIST[n++] = (unsigned short)((2u << 14) | (unsigned)s);
                    for (int s = (qt > 8 ? qt - 8 : 0); s <= qt; ++s) LIST[n++] = (unsigned short)((3u << 14) | (unsigned)s);
                } else { unsigned long long U0 = 0ull, U1 = 0ull; for (int i = 0; i < 8; ++i) { U0 |= MASKS[i * 4]; U1 |= MASKS[i * 4 + 1]; }
                    for (int s = 0; s < 64; ++s) if ((U0 >> s) & 1ull) LIST[n++] = (unsigned short)((2u << 14) | (unsigned)s);
                    for (int s = 0; s < 64; ++s) if ((U1 >> s) & 1ull) LIST[n++] = (unsigned short)((2u << 14) | (unsigned)(64 + s));
                    LIST[n++] = (unsigned short)((2u << 14) | 128u);
                    for (int s = 0; s <= 8; ++s) LIST[n++] = (unsigned short)((3u << 14) | (unsigned)s); }
                NL[0] = n;
            }
            __syncthreads();
            nl = __builtin_amdgcn_readfirstlane(NL[0]);
            mk0 = MASKS[tokl * 4]; if (SMP) { mk1 = MASKS[tokl * 4 + 1]; }
            if (!SMP) { unsigned long long u = 0ull; for (int i = 0; i < 8; ++i) u |= MASKS[(8 * w + i) * 4]; wu = u; }
            if (idx + 1 < nl) { at_prefetch<SMP>(F, l, seq, kvh, (unsigned)LIST[idx + 1], R); at_store(F, (idx + 1) & 1, R); }
            __syncthreads();
            ++idx; continue;
        }
        const int kind = (int)(e >> 14), ti = (int)(e & 0x3fffu);
        if (kind != cur_kind) {
            if (cur_kind >= 0) AT_FINALIZE(cur_kind);
            if (kind != 1) m = -INFINITY;
            lsum = 0.f; O[0] = (f32x16){}; O[1] = (f32x16){}; cur_kind = kind;
        }
        const unsigned en = (idx + 1 < nl) ? (unsigned)__builtin_amdgcn_readfirstlane((int)LIST[idx + 1]) : AT_MARK;
        const bool have_next = (en != AT_MARK);
        if (have_next) at_prefetch<SMP>(F, l, seq, kvh, en, R);
        bool active = true;
        if (!SMP && kind == 2) active = ((wu >> ti) & 1ull) != 0ull;
        if (active) {
            const LAS unsigned char* Kb = F.lds + AT_K0 + (idx & 1) * 64 * AT_RS; const LAS unsigned char* Vb = F.lds + AT_V0 + (idx & 1) * 64 * AT_RS;
            int lo, hi; const int kb = 64 * ti;
            if (kind < 2) { lo = 0; hi = SMP ? 510 : ((t >= 31) ? ((t - 31) >> 4) : -1); }
            else if (kind == 2) { lo = 0; const unsigned long long mw = (ti < 64) ? mk0 : ((ti < 128) ? mk1 : 1ull); hi = ((mw >> (ti & 63)) & 1ull) ? t : -1; }
            else { if (SMP) { lo = tl; hi = WINB + tl; } else { lo = t - WINB; hi = t; } }
            f32x16 s0 = (f32x16){}, s1 = (f32x16){};
#pragma unroll
            for (int kk = 0; kk < 4; ++kk) {
                const bf16x8 k0 = *(const LAS bf16x8*)(Kb + q * AT_RS + (16 * kk + 8 * h_) * 2), k1 = *(const LAS bf16x8*)(Kb + (32 + q) * AT_RS + (16 * kk + 8 * h_) * 2);
                s0 = mfma32(k0, qf[kk], s0); s1 = mfma32(k1, qf[kk], s1);
            }
            float tmax = -INFINITY;
#pragma unroll
            for (int r = 0; r < 16; ++r) { const int key = kb + (r & 3) + 8 * (r >> 2) + 4 * h_;
                s0[r] = (key >= lo && key <= hi) ? s0[r] : -INFINITY; s1[r] = (key + 32 >= lo && key + 32 <= hi) ? s1[r] : -INFINITY;
                tmax = fmaxf(tmax, fmaxf(s0[r], s1[r])); }
            tmax = fmaxf(tmax, __shfl_xor(tmax, 32));
            const float m_new = fmaxf(m, tmax), m_use = (m_new == -INFINITY) ? 0.f : m_new;
            const float alpha = fexp2(m - m_use);
            float ps = 0.f;
#pragma unroll
            for (int r = 0; r < 16; ++r) { s0[r] = fexp2(s0[r] - m_use); s1[r] = fexp2(s1[r] - m_use); ps += s0[r] + s1[r]; }
            lsum = lsum * alpha + ps; m = m_new;
            if (kind != 0) {
                O[0] *= alpha; O[1] *= alpha;
#pragma unroll
                for (int kt2 = 0; kt2 < 2; ++kt2)
#pragma unroll
                    for (int s2 = 0; s2 < 2; ++s2) { const bf16x8 pf = cvt_frag(kt2 ? s1 : s0, s2); const int rA = 32 * kt2 + 16 * s2 + 4 * h_;
#pragma unroll
                        for (int dt = 0; dt < 2; ++dt) { const bf16x8 vf = tr_frag(Vb, AT_RS, rA, rA + 8, 32 * dt + 16 * blk, lane); O[dt] = mfma32(vf, pf, O[dt]); } }
            }
            if (kind == 1) {
#pragma unroll
                for (int r = 0; r < 16; ++r) { const int n = kb + (r & 3) + 8 * (r >> 2) + 4 * h_;
                    float a = s0[r] * invden, b = s1[r] * invden; a += __shfl_xor(a, 1); b += __shfl_xor(b, 1); a += __shfl_xor(a, 2); b += __shfl_xor(b, 2);
                    if (hr == 0) { PSw[tl * PSS + n] = a; PSw[tl * PSS + n + 32] = b; } }
            }
        }
        if (have_next) at_store(F, (idx + 1) & 1, R);
        __syncthreads();
        ++idx;
    }
#undef AT_FINALIZE
    {
        const float lt = lsum + __shfl_xor(lsum, 32); const float sc = (lt > 0.f ? 1.0f / lt : 0.f) * g2;
        if (!SMP || w == 0) {
            bf16* op = WSP(bf16, WS_OA) + row * 512 + head * 64;
#pragma unroll
            for (int dt = 0; dt < 2; ++dt)
#pragma unroll
                for (int r4 = 0; r4 < 4; ++r4) { float o_[4];
#pragma unroll
                    for (int x = 0; x < 4; ++x) o_[x] = OAw[(dt * 16 + 4 * r4 + x) * 64] + O[dt][4 * r4 + x] * sc;
                    v2u wv; wv.x = pk2(o_[0], o_[1]); wv.y = pk2(o_[2], o_[3]); *(v2u*)(op + 32 * dt + 8 * r4 + 4 * h_) = wv; }
        }
    }
}

constexpr int AS_RS = 144;
constexpr int AS_V = 0, AS_VW = 32 * AS_RS, AS_MRG = 0, AS_PS = 73728, AS_IMP = AS_PS + 16640, AS_MASK = AS_IMP + 6144;
static_assert(8 * 34 * 64 * 4 <= AS_PS && AS_MASK + 512 <= RING_BYTES, "sample attention LDS map");

struct ASrc { const float* kf; const float* vf; const bf16* kb; const bf16* vb; int rs; int nvalid; };

__device__ __forceinline__ void attn_sample_unit(Frame& F, int l, int unit) {
    const int lane = F.lane, w = F.wave, tid = F.tid;
    const int q = lane & 31, h_ = lane >> 5, blk = (lane >> 4) & 1, tl = q >> 2, hr = q & 3;
    const int seq = unit >> 1, kvh = unit & 1, head = kvh * 4 + hr;
    const size_t row = (size_t)PM + seq * ST + tl;
    LAS unsigned char* Vw = F.lds + AS_V + w * AS_VW;
    LAS float* MRG = (LAS float*)(F.lds + AS_MRG);
    LAS float* PS = (LAS float*)(F.lds + AS_PS);
    LAS float* IMPw = (LAS float*)(F.lds + AS_IMP) + w * 192;
    LAS unsigned long long* MASKS = (LAS unsigned long long*)(F.lds + AS_MASK);
    __syncthreads();
    bf16x8 qf[4];
    { const bf16* qp = WSP(bf16, WS_QN) + row * 512 + head * 64 + 8 * h_;
#pragma unroll
      for (int kk = 0; kk < 4; ++kk) qf[kk] = *(const bf16x8*)(qp + 16 * kk); }
    const float* ngp = WSP(float, WS_NG) + row * 24 + head * 3; const float g0 = ngp[0], g1 = ngp[1], g2 = ngp[2];
    const int* ptab = (const int*)F.a->in[I_PT] + seq * NPG;
    f32x16 OA0 = (f32x16){}, OA1 = (f32x16){};

#define AS_TILE(SRC, KB0, LO_, HI_, DO_PV, DO_PS, m, lsum, O0, O1, invden) do { \
        bf16x8 kfr[4]; \
        if ((SRC).kb) { const bf16* kp_ = (SRC).kb + (size_t)q * (SRC).rs + 8 * h_; _Pragma("unroll") for (int kk = 0; kk < 4; ++kk) kfr[kk] = *(const bf16x8*)(kp_ + 16 * kk); } \
        else { const float* kp_ = (SRC).kf + (size_t)q * (SRC).rs + 8 * h_; _Pragma("unroll") for (int kk = 0; kk < 4; ++kk) { const f32x4 a_ = *(const f32x4*)(kp_ + 16 * kk), b_ = *(const f32x4*)(kp_ + 16 * kk + 4); kfr[kk] = __builtin_bit_cast(bf16x8, pack8(a_, b_)); } } \
        if (DO_PV) { const int vr_ = lane >> 1, vh_ = lane & 1; v4u vv_[4]; \
            if (vr_ >= (SRC).nvalid) { _Pragma("unroll") for (int x = 0; x < 4; ++x) vv_[x] = (v4u){0u, 0u, 0u, 0u}; } \
            else if ((SRC).vb) { const bf16* vp_ = (SRC).vb + (size_t)vr_ * (SRC).rs + 32 * vh_; _Pragma("unroll") for (int x = 0; x < 4; ++x) vv_[x] = *(const v4u*)(vp_ + 8 * x); } \
            else { const float* vp_ = (SRC).vf + (size_t)vr_ * (SRC).rs + 32 * vh_; _Pragma("unroll") for (int x = 0; x < 4; ++x) vv_[x] = pack8(*(const f32x4*)(vp_ + 8 * x), *(const f32x4*)(vp_ + 8 * x + 4)); } \
            _Pragma("unroll") for (int x = 0; x < 4; ++x) *(LAS v4u*)(Vw + vr_ * AS_RS + vh_ * 64 + x * 16) = vv_[x]; } \
        f32x16 s_ = (f32x16){}; \
        _Pragma("unroll") for (int kk = 0; kk < 4; ++kk) s_ = mfma32(kfr[kk], qf[kk], s_); \
        float tmax_ = -INFINITY; \
        _Pragma("unroll") for (int r = 0; r < 16; ++r) { const int key_ = (KB0) + (r & 3) + 8 * (r >> 2) + 4 * h_; s_[r] = (key_ >= (LO_) && key_ <= (HI_)) ? s_[r] : -INFINITY; tmax_ = fmaxf(tmax_, s_[r]); } \
        tmax_ = fmaxf(tmax_, __shfl_xor(tmax_, 32)); \
        const float mn_ = fmaxf(m, tmax_), mu_ = (mn_ == -INFINITY) ? 0.f : mn_, al_ = fexp2(m - mu_); float ps_ = 0.f; \
        _Pragma("unroll") for (int r = 0; r < 16; ++r) { s_[r] = fexp2(s_[r] - mu_); ps_ += s_[r]; } \
        lsum = lsum * al_ + ps_; m = mn_; \
        if (DO_PV) { O0 *= al_; O1 *= al_; LDS_WAIT(); asm volatile("" ::: "memory"); \
            _Pragma("unroll") for (int s2 = 0; s2 < 2; ++s2) { const bf16x8 pf_ = cvt_frag(s_, s2); const int rA_ = 16 * s2 + 4 * h_; \
                O0 = mfma32(tr_frag(Vw, AS_RS, rA_, rA_ + 8, 16 * blk, lane), pf_, O0); O1 = mfma32(tr_frag(Vw, AS_RS, rA_, rA_ + 8, 32 + 16 * blk, lane), pf_, O1); } \
            LDS_WAIT(); asm volatile("" ::: "memory"); } \
        if (DO_PS) { _Pragma("unroll") for (int r = 0; r < 16; ++r) { const int n_ = (KB0) + (r & 3) + 8 * (r >> 2) + 4 * h_; float a_ = s_[r] * (invden); a_ += __shfl_xor(a_, 1); a_ += __shfl_xor(a_, 2); if (hr == 0) PS[tl * 520 + n_] = a_; } } \
    } while (0)
#define AS_PUBLISH(m, lsum, O0, O1) do { __syncthreads(); LAS float* mp_ = MRG + w * 34 * 64 + lane; mp_[0] = m; mp_[64] = lsum; \
        _Pragma("unroll") for (int r = 0; r < 16; ++r) { mp_[(2 + r) * 64] = O0[r]; mp_[(18 + r) * 64] = O1[r]; } __syncthreads(); } while (0)

    const bf16* CKk = WSP(bf16, WS_CK) + ((size_t)(seq * 2 + kvh) * 512) * 64; const bf16* CKv = CKk + (size_t)CMP_ROWS_J * 64;
    float mC = -INFINITY, lC = 0.f; f32x16 D0 = (f32x16){}, D1 = (f32x16){};
#pragma unroll 1
    for (int ti = w; ti < 16; ti += 8) { ASrc S{nullptr, nullptr, CKk + (size_t)ti * 32 * 64, CKv + (size_t)ti * 32 * 64, 64, 32}; AS_TILE(S, ti * 32, 0, 510, false, false, mC, lC, D0, D1, 0.f); }
    { __syncthreads(); MRG[w * 128 + lane] = mC; MRG[w * 128 + 64 + lane] = lC + __shfl_xor(lC, 32); __syncthreads(); }
    float mT = -INFINITY;
#pragma unroll
    for (int x = 0; x < 8; ++x) mT = fmaxf(mT, MRG[x * 128 + lane]);
    float lT = 0.f;
#pragma unroll
    for (int x = 0; x < 8; ++x) { const float mx_ = MRG[x * 128 + lane]; lT += (mx_ == -INFINITY) ? 0.f : MRG[x * 128 + 64 + lane] * fexp2(mx_ - mT); }
    const float invC = lT > 0.f ? 1.0f / lT : 0.f;
    __syncthreads();
    { float mB = mT, lB = 0.f;
#pragma unroll 1
      for (int ti = w; ti < 16; ti += 8) { ASrc S{nullptr, nullptr, CKk + (size_t)ti * 32 * 64, CKv + (size_t)ti * 32 * 64, 64, 32}; AS_TILE(S, ti * 32, 0, 510, true, true, mB, lB, D0, D1, invC); }
      AS_PUBLISH(mB, lB, D0, D1); }
    { const float sc = g0 * invC;
#pragma unroll 1
      for (int x = 0; x < 8; ++x) { const LAS float* mp = MRG + x * 34 * 64 + lane;
#pragma unroll
          for (int r = 0; r < 16; ++r) { OA0[r] += mp[(2 + r) * 64] * sc; OA1[r] += mp[(18 + r) * 64] * sc; } } }
    {
        const LAS float* pr = PS + w * 520; const int sa = lane, sb = lane + 64; float ia = 0.f, ib = 0.f;
#pragma unroll
        for (int n = 4 * sa - 1; n <= 4 * sa + 3; ++n) if (n >= 0) ia += pr[n];
#pragma unroll
        for (int n = 4 * sb - 1; n <= 4 * sb + 3; ++n) ib += pr[n];
        const bool fa = (sa == 0), fb = (sb == 127); const float va = fa ? 1e4f : ia, vb = fb ? 1e4f : ib;
        IMPw[sa] = va; IMPw[sb] = vb; LDS_WAIT(); asm volatile("" ::: "memory");
        int ra = fa ? 0 : 1, rb = fb ? 0 : 1;
#pragma unroll 8
        for (int i = 0; i < 128; ++i) { const float v = IMPw[i]; ra += (v > va || (v == va && i < sa)) ? 1 : 0; rb += (v > vb || (v == vb && i < sb)) ? 1 : 0; }
        const unsigned long long ma = __ballot(ra < 16), mb = __ballot(rb < 16);
        if (lane == 0) { MASKS[w * 4] = ma; MASKS[w * 4 + 1] = mb; }
    }
    __syncthreads();
    const unsigned long long mk0 = MASKS[tl * 4], mk1 = MASKS[tl * 4 + 1];
    unsigned long long U0 = 0ull, U1 = 0ull;
#pragma unroll
    for (int x = 0; x < 8; ++x) { U0 |= MASKS[x * 4]; U1 |= MASKS[x * 4 + 1]; }
    {
        float m = -INFINITY, ls = 0.f; D0 = (f32x16){}; D1 = (f32x16){};
        const int t = PAST + tl; int cnt = 0;
#pragma unroll 1
        for (int s = 0; s <= 128; ++s) {
            const bool in_u = (s < 64) ? ((U0 >> s) & 1ull) : ((s < 128) ? ((U1 >> (s - 64)) & 1ull) : true);
            if (!in_u) continue;
            const bool selb = (s < 64) ? ((mk0 >> s) & 1ull) : ((s < 128) ? ((mk1 >> (s - 64)) & 1ull) : true);
            const int nh = (s < 128) ? 2 : 1;
            for (int hf = 0; hf < nh; ++hf, ++cnt) {
                if ((cnt & 7) != w) continue;
                const int hi = selb ? t : -1;
                if (s < 128) { const int page = ptab[s >> 1], slot = (s & 1) * 64 + hf * 32;
                    const float* kp = FIN(I_CACHE) + (((((size_t)l * NPHYS + page) * PAGE + slot) * 4 + 2) * 2 + kvh) * 64;
                    ASrc S{kp, kp + 128, nullptr, nullptr, 512, 32}; AS_TILE(S, s * 64 + hf * 32, 0, hi, true, false, m, ls, D0, D1, 0.f); }
                else { const bf16* kp = WSP(bf16, WS_KVS) + ((((size_t)0 * SB + seq) * 2 + kvh) * ST) * 64;
                    ASrc S{nullptr, nullptr, kp, kp + (size_t)SB * 2 * ST * 64, 64, ST}; AS_TILE(S, PAST, 0, hi, true, false, m, ls, D0, D1, 0.f); }
            }
        }
        AS_PUBLISH(m, ls, D0, D1);
        float mt = -INFINITY;
#pragma unroll
        for (int x = 0; x < 8; ++x) mt = fmaxf(mt, MRG[x * 34 * 64 + lane]);
        float lt = 0.f; f32x16 T0 = (f32x16){}, T1 = (f32x16){};
#pragma unroll 1
        for (int x = 0; x < 8; ++x) { const LAS float* mp = MRG + x * 34 * 64 + lane; const float mx_ = mp[0]; const float f = (mx_ == -INFINITY) ? 0.f : fexp2(mx_ - mt); lt += mp[64] * f;
#pragma unroll
            for (int r = 0; r < 16; ++r) { T0[r] += mp[(2 + r) * 64] * f; T1[r] += mp[(18 + r) * 64] * f; } }
        lt += __shfl_xor(lt, 32); const float sc = (lt > 0.f ? 1.0f / lt : 0.f) * g1; OA0 += T0 * sc; OA1 += T1 * sc;
    }
    {
        float m = -INFINITY, ls = 0.f; D0 = (f32x16){}; D1 = (f32x16){};
#pragma unroll 1
        for (int ti = w; ti < 17; ti += 8) {
            if (ti < 16) { const float* kp = FIN(I_CWIN) + (((((size_t)l * SB + seq) * WINB + ti * 32) * 2 + 0) * 2 + kvh) * 64;
                ASrc S{kp, kp + 128, nullptr, nullptr, 256, 32}; AS_TILE(S, ti * 32, tl, WINB + tl, true, false, m, ls, D0, D1, 0.f); }
            else { const bf16* kp = WSP(bf16, WS_KVS) + ((((size_t)2 * SB + seq) * 2 + kvh) * ST) * 64;
                ASrc S{nullptr, nullptr, kp, kp + (size_t)SB * 2 * ST * 64, 64, ST}; AS_TILE(S, WINB, tl, WINB + tl, true, false, m, ls, D0, D1, 0.f); }
        }
        AS_PUBLISH(m, ls, D0, D1);
        float mt = -INFINITY;
#pragma unroll
        for (int x = 0; x < 8; ++x) mt = fmaxf(mt, MRG[x * 34 * 64 + lane]);
        float lt = 0.f; f32x16 T0 = (f32x16){}, T1 = (f32x16){};
#pragma unroll 1
        for (int x = 0; x < 8; ++x) { const LAS float* mp = MRG + x * 34 * 64 + lane; const float mx_ = mp[0]; const float f = (mx_ == -INFINITY) ? 0.f : fexp2(mx_ - mt); lt += mp[64] * f;
#pragma unroll
            for (int r = 0; r < 16; ++r) { T0[r] += mp[(2 + r) * 64] * f; T1[r] += mp[(18 + r) * 64] * f; } }
        lt += __shfl_xor(lt, 32); const float sc = (lt > 0.f ? 1.0f / lt : 0.f) * g2; OA0 += T0 * sc; OA1 += T1 * sc;
    }
#undef AS_TILE
#undef AS_PUBLISH
    if (w == 0) {
        bf16* op = WSP(bf16, WS_OA) + row * 512 + head * 64;
#pragma unroll
        for (int r4 = 0; r4 < 4; ++r4) { v2u a, b; a.x = pk2(OA0[4 * r4 + 0], OA0[4 * r4 + 1]); a.y = pk2(OA0[4 * r4 + 2], OA0[4 * r4 + 3]); b.x = pk2(OA1[4 * r4 + 0], OA1[4 * r4 + 1]); b.y = pk2(OA1[4 * r4 + 2], OA1[4 * r4 + 3]);
            *(v2u*)(op + 8 * r4 + 4 * h_) = a; *(v2u*)(op + 32 + 8 * r4 + 4 * h_) = b; }
    }
}

#ifdef DBG_CHECK
__device__ __forceinline__ unsigned dbg_rand(unsigned x) { x ^= x >> 16; x *= 0x7feb352du; x ^= x >> 15; x *= 0x846ca68bu; x ^= x >> 16; return x; }
__device__ __forceinline__ bool dbg_bad(float got, float exp_, float rtol, float atol) { return !(fabsf(got - exp_) <= rtol * fabsf(exp_) + atol); }
__device__ __forceinline__ float bfr(float x) { return __uint_as_float(pk2(x, 0.f) << 16); }
__device__ __forceinline__ int dbg_row(unsigned r) { const unsigned k = r % 20u; if (k == 0) return (int)(PM + (r >> 8) % SM); if (k == 1) return (int)(((r >> 8) % PB) * PT + ((r >> 12) % 8)); if (k == 2) return (int)(((r >> 8) % PB) * PT + PT - 1 - ((r >> 12) % 8)); return (int)((r >> 5) % PM); }
__device__ __forceinline__ float dbg_rs(const Frame& F, int row, int lane) { const float* xr = xrow_in(F, 0, row); float ss = 0.f; for (int d = lane; d < DM; d += 64) ss += xr[d] * xr[d]; return 1.0f / sqrtf(wave_sum(ss) * (1.0f / DM) + EPS); }
__device__ __forceinline__ float dbg_h(const Frame& F, int row, int d, float rs) { const float* mod = WSP(float, WS_MOD) + (size_t)row_bb(row) * 6144; return bfr(xrow_in(F, 0, row)[d] * rs * FIN(I_N1G)[d] * (1.0f + mod[1024 + d]) + mod[d]); }

__device__ __forceinline__ void dbg_check_phase(Frame& F) {
    const int gw = F.bid * NWAVES + F.wave, NGW = F.G * NWAVES, lane = F.lane;
    unsigned* CNT = (unsigned*)(F.ws + WS_CTL) + 3000;
    LAS float* L = (LAS float*)(F.lds + F.wave * 16384);
#define DBG_FLAG(ch, cond) do { if (__any(cond) && lane == 0) atomicAdd(CNT + (ch), 1u); } while (0)
    for (int s = gw; s < 1536; s += NGW) {
        const unsigned r = dbg_rand(1000u + s); const int row = dbg_row(r); const float rs = dbg_rs(F, row, lane); const int kind = s % 6;
        const bool isp = row < PM; const int b = isp ? (row >> 12) : ((row - PM) >> 3), t = isp ? (row & (PT - 1)) : ((row - PM) & 7);
#define DBG_U(col, dst) do { float a_ = 0.f; for (int d_ = lane; d_ < DM; d_ += 64) a_ += dbg_h(F, row, d_, rs) * bfr(FIN(I_WIN)[(size_t)d_ * D_IN + (col)]); dst = wave_sum(a_); } while (0)
        if (kind == 0) {
            const int c = (r >> 3) % 768, j = c >> 7, k = (c >> 6) & 1, dd = c & 63; float u; DBG_U(O_NKV + c, u); bool bad = false;
            if (j < 4) bad = dbg_bad(F.out[(isp ? OUT_ROWS_P + (size_t)row * 512 : OUT_ROWS_S + (size_t)(row - PM) * 512) + c], u, 0.01f, 0.01f);
            else if (isp) { if (t >= PT - WINB) bad = dbg_bad(F.out[OUT_WIN_P + ((size_t)b * WINB + (t - (PT - WINB))) * 256 + (c - 512)], u, 0.01f, 0.01f); }
            else bad = dbg_bad(F.out[OUT_WIN_S + ((size_t)b * WINB + (WINB - ST) + t) * 256 + (c - 512)], u, 0.01f, 0.01f);
            if (isp) { if (j < 2) bad = bad || dbg_bad(bf1(WSP(bf16, WS_ACMP)[((size_t)j * CMP_ROWS_J + 32768 + (b * 2 + k) * 256 + (t >> 4)) * 1024 + (t & 15) * 64 + dd]), u, 0.01f, 0.01f);
                       else bad = bad || dbg_bad(bf1(WSP(bf16, WS_KVB)[((((size_t)(j - 2) * PB + b) * 2 + k) * PT + t) * 64 + dd]), u, 0.01f, 0.01f); }
            else if (j >= 2) bad = bad || dbg_bad(bf1(WSP(bf16, WS_KVS)[((((size_t)(j - 2) * SB + b) * 2 + k) * ST + t) * 64 + dd]), u, 0.01f, 0.01f);
            DBG_FLAG(0, bad);
        } else if (kind == 1) {
            const int gi = (r >> 3) % 24, c5 = (r >> 8) % 512, cm = (r >> 8) % 3072; float u0, u1, u2, u3; DBG_U(O_NG + gi, u0); DBG_U(O_RX + c5, u1); DBG_U(O_RGATE + c5, u2); DBG_U(O_MG + cm, u3);
            bool bad = dbg_bad(WSP(float, WS_NG)[(size_t)row * 24 + gi], 1.0f / (1.0f + expf(-u0)), 0.01f, 0.005f);
            bad = bad || dbg_bad(WSP(float, WS_RX)[(size_t)row * 512 + c5], u1, 0.01f, 0.01f);
            bad = bad || dbg_bad(bf1(WSP(bf16, WS_GG)[(size_t)row * 512 + c5]), gelu_tanh(u2), 0.02f, 0.01f);
            bad = bad || dbg_bad(bf1(WSP(bf16, WS_MGS)[(size_t)row * 3072 + cm]), 1.0f / (1.0f + expf(-u3)), 0.01f, 0.005f);
            DBG_FLAG(1, bad);
        } else if (kind == 2) {
            const int head = (r >> 13) % 4, dim = (r >> 16) % 64, c5 = (r >> 3) % 512; float x1, x2, uv, ug, uq; DBG_U(O_RQ + head * 128 + dim, x1); DBG_U(O_RQ + head * 128 + 64 + dim, x2); DBG_U(O_RV + c5, uv); DBG_U(O_RG + c5, ug); DBG_U(O_NQ + c5, uq);
            const float pos = (float)(isp ? t : PAST + t); const float ang = pos * (float)pow(10000.0, -(double)dim / 64.0); float sn, cs; sincos_acc(ang, sn, cs);
            const bf16* RQ = WSP(bf16, WS_RQ);
            bool bad = dbg_bad(bf1(RQ[(size_t)row * 512 + head * 128 + dim]), x1 * cs - x2 * sn, 0.02f, 0.02f) || dbg_bad(bf1(RQ[(size_t)row * 512 + head * 128 + 64 + dim]), x1 * sn + x2 * cs, 0.02f, 0.02f);
            bad = bad || dbg_bad(bf1(RQ[(size_t)2 * MT * 512 + (size_t)row * 512 + c5]), uv, 0.01f, 0.01f) || dbg_bad(bf1(RQ[(size_t)3 * MT * 512 + (size_t)row * 512 + c5]), ug, 0.01f, 0.01f);
            bad = bad || dbg_bad(bf1(WSP(bf16, WS_QN)[(size_t)row * 512 + c5]), uq * QSCALE, 0.01f, 0.005f);
            DBG_FLAG(2, bad);
        }
#undef DBG_U
    }
    for (int s = gw; s < 128; s += NGW) {
        const unsigned r = dbg_rand(3000u + s); const int j = r & 1; const bool smp = ((r >> 1) & 3) != 0;
        const int grp = smp ? (int)((r >> 3) % 64) : (int)((r >> 3) % 8), nmax = smp ? 511 : 255; int n = (r >> 10) % nmax; if (((r >> 20) & 7) == 0) n = nmax - 1;
        const size_t rj = smp ? (size_t)grp * 512 + n : (size_t)32768 + grp * 256 + n;
        const bf16* A = WSP(bf16, WS_ACMP) + ((size_t)j * CMP_ROWS_J + rj) * 1024;
        const float* w1 = FIN(I_W1) + (size_t)j * 2048 * 128; const float* pe = FIN(I_PE) + j * 2048;
        for (int hh = 0; hh < 2; ++hh) { const int h = lane + 64 * hh; float a = FIN(I_B1)[j * 128 + h];
            for (int i = 0; i < 1024; ++i) a += (bf1(A[i]) + pe[i]) * w1[(size_t)i * 128 + h] + (bf1(A[1024 + i]) + pe[1024 + i]) * w1[(size_t)(1024 + i) * 128 + h];
            L[h] = gelu_tanh(a); }
        LDS_WAIT(); asm volatile("" ::: "memory");
        float o = 0.f; for (int h = 0; h < 128; ++h) o += L[h] * FIN(I_W2)[((size_t)j * 128 + h) * 64 + lane];
        const float got = bf1(WSP(bf16, WS_CK)[((size_t)j * CMP_ROWS_J + rj) * 64 + lane]);
        { const bool bd = dbg_bad(got, o, 0.05f, 0.03f); const unsigned long long mk = __ballot(bd); if (lane == 0 && mk) atomicAdd(CNT + 3, (unsigned)__popcll(mk)); }
        LDS_WAIT(); asm volatile("" ::: "memory");
    }
    for (int s = gw; s < 128; s += NGW) {
        const unsigned r = dbg_rand(3500u + s); const int j = r & 1; const bool smp = ((r >> 1) & 3) != 0;
        const int grp = smp ? (int)((r >> 3) % 64) : (int)((r >> 3) % 8), nmax = smp ? 511 : 255; const int n = (r >> 10) % nmax;
        const size_t rj = smp ? (size_t)grp * 512 + n : (size_t)32768 + grp * 256 + n, row = (size_t)j * CMP_ROWS_J + rj;
        const bf16* A = WSP(bf16, WS_ACMP) + row * 1024; const float* w1 = FIN(I_W1) + (size_t)j * 2048 * 128; const bf16* LH = WSP(bf16, WS_LH);
        unsigned nb = 0;
        for (int hh = 0; hh < 2; ++hh) { const int h = lane + 64 * hh; float lo = 0.f, hi = 0.f;
            for (int i = 0; i < 1024; ++i) { const float av = bf1(A[i]); lo += av * bfr(w1[(size_t)i * 128 + h]); hi += av * bfr(w1[(size_t)(1024 + i) * 128 + h]); }
            const bool bd = dbg_bad(bf1(LH[row * 256 + h]), lo, 0.02f, 0.02f) || dbg_bad(bf1(LH[row * 256 + 128 + h]), hi, 0.02f, 0.02f); nb += (unsigned)__popcll(__ballot(bd)); }
        if (lane == 0 && nb) atomicAdd(CNT + 9, nb);
        for (int hh = 0; hh < 2; ++hh) { const int h = lane + 64 * hh; L[h] = gelu_tanh(bf1(LH[row * 256 + h]) + bf1(LH[(row + 1) * 256 + 128 + h]) + WSP(float, WS_SMALLW + SW_CB)[j * 128 + h]); }
        LDS_WAIT(); asm volatile("" ::: "memory");
        float o = 0.f; for (int h = 0; h < 128; ++h) o += bfr(L[h]) * bfr(FIN(I_W2)[((size_t)j * 128 + h) * 64 + lane]);
        { const bool bd = dbg_bad(bf1(WSP(bf16, WS_CK)[row * 64 + lane]), o, 0.03f, 0.01f); const unsigned long long mk = __ballot(bd); if (lane == 0 && mk) atomicAdd(CNT + 11, (unsigned)__popcll(mk)); }
        LDS_WAIT(); asm volatile("" ::: "memory");
    }
    for (int s = gw; s < 64; s += NGW) {
        const unsigned r = dbg_rand(3700u + s); const int j = r & 1, half = (r >> 1) & 1, h = (r >> 2) % 128; const bf16* W1T = WSP(bf16, WS_SMALLW + SW_W1T) + ((size_t)j * 256 + half * 128 + h) * 1024;
        const float* w1 = FIN(I_W1) + ((size_t)j * 32 + half * 16) * 64 * 128 + h; unsigned nb = 0;
        for (int k = lane; k < 1024; k += 64) nb += (unsigned)__popcll(__ballot(dbg_bad(bf1(W1T[k]), w1[(size_t)k * 128], 0.01f, 0.0001f)));
        if (lane == 0 && nb) atomicAdd(CNT + 12, nb);
        const bool smp = ((r >> 9) & 3) != 0; const int grp = smp ? (int)((r >> 11) % 64) : (int)((r >> 11) % 8), n = (r >> 17) % (smp ? 511 : 255);
        const size_t row = (size_t)j * CMP_ROWS_J + (smp ? (size_t)grp * 512 + n : (size_t)32768 + grp * 256 + n); const bf16* A = WSP(bf16, WS_ACMP) + row * 1024;
        float a = 0.f; for (int k = lane; k < 1024; k += 64) a += bf1(A[k]) * bf1(W1T[k]); a = wave_sum(a);
        DBG_FLAG(13, dbg_bad(bf1(WSP(bf16, WS_LH)[row * 256 + half * 128 + h]), a, 0.02f, 0.02f));
    }
    for (int s = gw; s < 4; s += NGW) {
        const int j = s >> 1, h = (s & 1) * 64 + lane; const float* w1 = FIN(I_W1) + (size_t)j * 2048 * 128; const float* pe = FIN(I_PE) + j * 2048;
        float a = FIN(I_B1)[j * 128 + h]; for (int i = 0; i < 2048; ++i) a += pe[i] * w1[(size_t)i * 128 + h];
        const unsigned long long mk = __ballot(dbg_bad(WSP(float, WS_SMALLW + SW_CB)[j * 128 + h], a, 0.001f, 0.0005f)); if (lane == 0 && mk) atomicAdd(CNT + 10, (unsigned)__popcll(mk));
    }
    for (int s = gw; s < 96; s += NGW) {
        const unsigned r = dbg_rand(4000u + s); const bool smp = (s % 3) == 2;
        int seq, kvh = (r >> 4) & 1, t, tl = 0; size_t row;
        if (smp) { seq = (r >> 5) % SB; tl = (r >> 10) % ST; t = PAST + tl; row = (size_t)PM + seq * ST + tl; }
        else { seq = (r >> 5) % PB; const unsigned k = (r >> 8) % 8u; t = (k == 0) ? (int)((r >> 12) % 40) : (k == 1) ? PT - 1 - (int)((r >> 12) % 70) : (int)((r >> 12) % PT); row = (size_t)seq * PT + t; }
        const int N = smp ? 511 : 255, NS = smp ? 129 : 64, cur = t >> 6;
        LAS float* Q = L; LAS float* SC = L + 256; LAS float* PSUM = L + 256 + 2048; LAS float* OUT = L + 256 + 2048 + 512;
        for (int i = lane; i < 256; i += 64) Q[i] = bf1(WSP(bf16, WS_QN)[row * 512 + (kvh * 4 + (i >> 6)) * 64 + (i & 63)]);
        for (int i = lane; i < 768; i += 64) OUT[i] = 0.f;
        LDS_WAIT(); asm volatile("" ::: "memory");
        const bf16* CKk = WSP(bf16, WS_CK) + (smp ? (size_t)(seq * 2 + kvh) * 512 : (size_t)32768 + (seq * 2 + kvh) * 256) * 64; const bf16* CKv = CKk + (size_t)CMP_ROWS_J * 64;
        const int nvis = smp ? 511 : ((t >= 31) ? ((t - 31) >> 4) + 1 : 0);
        for (int i = lane; i < 512; i += 64) PSUM[i] = 0.f;
        for (int hr = 0; hr < 4; ++hr) {
            float mx = -INFINITY; for (int n = lane; n < nvis; n += 64) { float a = 0.f; for (int d = 0; d < 64; ++d) a += Q[hr * 64 + d] * bf1(CKk[(size_t)n * 64 + d]); SC[n] = a; mx = fmaxf(mx, a); }
            for (int o = 1; o < 64; o <<= 1) mx = fmaxf(mx, __shfl_xor(mx, o));
            float den = 0.f; for (int n = lane; n < nvis; n += 64) { const float e = exp2f(SC[n] - mx); SC[n] = e; den += e; } den = wave_sum(den);
            LDS_WAIT(); asm volatile("" ::: "memory");
            if (nvis > 0) { float o = 0.f; for (int n = 0; n < nvis; ++n) o += SC[n] * bf1(CKv[(size_t)n * 64 + lane]); OUT[hr * 64 + lane] = o / den;
                for (int n = lane; n < nvis; n += 64) PSUM[n] += SC[n] / den; }
            LDS_WAIT(); asm volatile("" ::: "memory");
        }
        LAS float* IMP = SC; LAS float* SELB = SC + 256;
        for (int sblk = lane; sblk < NS; sblk += 64) { float imp = 0.f; for (int n = 4 * sblk - 1; n <= 4 * sblk + 3; ++n) if (n >= 0 && n < N) imp += PSUM[n];
            const bool forced = sblk == 0 || sblk == cur || sblk == cur - 1, avail = sblk * 64 <= t; IMP[sblk] = avail ? (forced ? 1e4f : imp) : -1e4f; SELB[sblk] = 0.f; }
        LDS_WAIT(); asm volatile("" ::: "memory");
        for (int pick = 0; pick < 16 && pick < NS; ++pick) { float bv = -INFINITY; int bi = 1 << 30;
            for (int sblk = lane; sblk < NS; sblk += 64) { const float v = (SELB[sblk] != 0.f) ? -INFINITY : IMP[sblk]; if (v > bv || (v == bv && sblk < bi)) { bv = v; bi = sblk; } }
            for (int o = 1; o < 64; o <<= 1) { const float ov = __shfl_xor(bv, o); const int oi = __shfl_xor(bi, o); if (ov > bv || (ov == bv && oi < bi)) { bv = ov; bi = oi; } }
            if (lane == 0) SELB[bi] = 1.f; LDS_WAIT(); asm volatile("" ::: "memory"); }
        for (int br = 1; br < 3; ++br) for (int hr = 0; hr < 4; ++hr) {
            float mx = -INFINITY, den = 0.f, o = 0.f;
            const int plo = (br == 1) ? 0 : (t - WINB < 0 ? 0 : t - WINB), phi = t;
            for (int p = plo; p <= phi; ++p) {
                if (br == 1 && SELB[p >> 6] == 0.f) { p |= 63; continue; }
                const float* kf = nullptr; const bf16* kb = nullptr; const float* vf = nullptr; const bf16* vb = nullptr;
                const int jk = (br == 1) ? 2 : 4;
                if (!smp) { kb = WSP(bf16, WS_KVB) + ((((size_t)(jk - 2) * PB + seq) * 2 + kvh) * PT + p) * 64; vb = kb + (size_t)PB * 2 * PT * 64; }
                else if (p >= PAST) { kb = WSP(bf16, WS_KVS) + ((((size_t)(jk - 2) * SB + seq) * 2 + kvh) * ST + (p - PAST)) * 64; vb = kb + (size_t)SB * 2 * ST * 64; }
                else if (br == 1) { const int page = ((const int*)F.a->in[I_PT])[seq * NPG + (p >> 7)]; kf = FIN(I_CACHE) + ((((size_t)page * PAGE + (p & 127)) * 4 + 2) * 2 + kvh) * 64; vf = kf + 128; }
                else { kf = FIN(I_CWIN) + ((((size_t)seq * WINB + (p - (PAST - WINB))) * 2 + 0) * 2 + kvh) * 64; vf = kf + 128; }
                float a = 0.f; for (int d = 0; d < 64; ++d) a += Q[hr * 64 + d] * (kb ? bf1(kb[d]) : bfr(kf[d]));
                const float vv = vb ? bf1(vb[lane]) : bfr(vf[lane]);
                const float mn = fmaxf(mx, a), al = exp2f(mx - mn), e = exp2f(a - mn); den = den * al + e; o = o * al + e * vv; mx = mn;
            }
            OUT[(br * 4 + hr) * 64 + lane] = (den > 0.f) ? o / den : 0.f;
        }
        LDS_WAIT(); asm volatile("" ::: "memory");
        bool bad = false;
        for (int hr = 0; hr < 4; ++hr) { const float* ng = WSP(float, WS_NG) + row * 24 + (kvh * 4 + hr) * 3;
            const float e = ng[0] * OUT[(0 * 4 + hr) * 64 + lane] + ng[1] * OUT[(1 * 4 + hr) * 64 + lane] + ng[2] * OUT[(2 * 4 + hr) * 64 + lane];
            bad = bad || dbg_bad(bf1(WSP(bf16, WS_OA)[row * 512 + (kvh * 4 + hr) * 64 + lane]), e, 0.04f, 0.004f); }
        DBG_FLAG(smp ? 5 : 4, bad);
        LDS_WAIT(); asm volatile("" ::: "memory");
    }
    for (int s = gw; s < 96; s += NGW) {
        const unsigned r = dbg_rand(6000u + s); const bool smp = (s % 3) == 2; const int h = (r >> 3) & 3; const float lg = ret_log_g(h);
        const bf16* RQ = WSP(bf16, WS_RQ); const bf16* RK = RQ + (size_t)MT * 512; const bf16* RV = RQ + (size_t)2 * MT * 512; const bf16* RG = RQ + (size_t)3 * MT * 512;
        int seq, t; size_t row0; if (smp) { seq = (r >> 5) % SB; t = (r >> 10) % ST; row0 = (size_t)PM + seq * ST; } else { seq = (r >> 5) % PB; const unsigned k = (r >> 8) % 4u; t = (k == 0) ? (int)((r >> 12) % 300) : (int)((r >> 12) % PT); row0 = (size_t)seq * PT; }
        float o0 = 0.f, o1 = 0.f;
        for (int d = lane; d < 128; d += 64) L[d] = bf1(RQ[(row0 + t) * 512 + h * 128 + d]);
        LDS_WAIT(); asm volatile("" ::: "memory");
        for (int j = 0; j <= t; ++j) { float a = 0.f; for (int d = 0; d < 128; ++d) a += L[d] * bf1(RK[(row0 + j) * 512 + h * 128 + d]);
            a *= expf((float)(t - j) * lg); o0 += a * bf1(RV[(row0 + j) * 512 + h * 128 + lane]); o1 += a * bf1(RV[(row0 + j) * 512 + h * 128 + 64 + lane]); }
        if (smp) { const float* S0 = FIN(I_SRET) + (((size_t)0 * SB + seq) * 4 + h) * 16384; const float cr = expf((float)(t + 1) * lg);
            for (int d = 0; d < 128; ++d) { o0 += L[d] * S0[d * 128 + lane] * cr; o1 += L[d] * S0[d * 128 + 64 + lane] * cr; } }
        const float mean = wave_sum(o0 + o1) * (1.0f / 128.0f); const float var = wave_sum((o0 - mean) * (o0 - mean) + (o1 - mean) * (o1 - mean)) * (1.0f / 128.0f), rstd = 1.0f / sqrtf(var + EPS);
        const float* GN = FIN(I_GNG) + h * 128; const bf16* OR_ = WSP(bf16, WS_OA) + (size_t)MT * 512;
        const float g0 = bf1(RG[(row0 + t) * 512 + h * 128 + lane]), g1 = bf1(RG[(row0 + t) * 512 + h * 128 + 64 + lane]);
        const float e0 = (o0 - mean) * rstd * GN[lane] * (g0 / (1.0f + expf(-g0))), e1 = (o1 - mean) * rstd * GN[64 + lane] * (g1 / (1.0f + expf(-g1)));
        DBG_FLAG(6, dbg_bad(bf1(OR_[(row0 + t) * 512 + h * 128 + lane]), e0, 0.04f, 0.02f) || dbg_bad(bf1(OR_[(row0 + t) * 512 + h * 128 + 64 + lane]), e1, 0.04f, 0.02f));
        const int d = (r >> 20) % 128, T = smp ? ST : PT; float s0 = 0.f, s1 = 0.f;
        for (int j = 0; j < T; ++j) { const float kk = bf1(RK[(row0 + j) * 512 + h * 128 + d]) * expf((float)(T - 1 - j) * lg); s0 += kk * bf1(RV[(row0 + j) * 512 + h * 128 + lane]); s1 += kk * bf1(RV[(row0 + j) * 512 + h * 128 + 64 + lane]); }
        const float* SO;
        if (smp) { const float* S0 = FIN(I_SRET) + (((size_t)0 * SB + seq) * 4 + h) * 16384; const float g8 = expf(8.0f * lg); s0 += g8 * S0[d * 128 + lane]; s1 += g8 * S0[d * 128 + 64 + lane]; SO = F.out + OUT_RET_S + (((size_t)0 * SB + seq) * 4 + h) * 16384; }
        else SO = F.out + OUT_RET_P + (((size_t)0 * PB + seq) * 4 + h) * 16384;
        DBG_FLAG(7, dbg_bad(SO[d * 128 + lane], s0, 0.02f, 0.02f) || dbg_bad(SO[d * 128 + 64 + lane], s1, 0.02f, 0.02f));
        LDS_WAIT(); asm volatile("" ::: "memory");
    }
    for (int s = gw; s < 48; s += NGW) {
        const unsigned r = dbg_rand(8000u + s); const bool smp = (s % 3) == 2; const int blk = (r >> 3) & 7, c = blk * 64 + lane;
        int seq, T; size_t row0; if (smp) { seq = (r >> 6) % SB; T = ST; row0 = (size_t)PM + seq * ST; } else { seq = (r >> 6) % PB; T = 1 + (int)((r >> 10) % ((s & 1) ? 200 : PT)); row0 = (size_t)seq * PT; }
        const float* RX = WSP(float, WS_RX); const float* cw = FIN(I_RCW); const float cb = FIN(I_RCB)[c];
        float x3 = 0.f, x2 = 0.f, x1 = 0.f, h = 0.f;
        if (smp) { const float* cv = FIN(I_SCONV) + (size_t)seq * 3 * 512; x3 = cv[c]; x2 = cv[512 + c]; x1 = cv[1024 + c]; h = FIN(I_SH)[(size_t)seq * 512 + c]; }
        const float sp = log1pf(expf(-FIN(I_LAM)[c])); const float* wa = FIN(I_RWA) + (size_t)blk * 4096; const float* wx = FIN(I_RWX) + (size_t)blk * 4096;
        for (int t = 0; t < T; ++t) { const float x0 = RX[(row0 + t) * 512 + c]; const float xc = cb + cw[c] * x3 + cw[512 + c] * x2 + cw[1024 + c] * x1 + cw[1536 + c] * x0; x3 = x2; x2 = x1; x1 = x0;
            L[lane] = xc; LDS_WAIT(); asm volatile("" ::: "memory");
            float ra = FIN(I_RBA)[c], ri = FIN(I_RBX)[c]; for (int i = 0; i < 64; ++i) { ra += L[i] * wa[i * 64 + lane]; ri += L[i] * wx[i * 64 + lane]; }
            LDS_WAIT(); asm volatile("" ::: "memory");
            const float rr = 1.0f / (1.0f + expf(-ra)), ii = 1.0f / (1.0f + expf(-ri)), la = -8.0f * rr * sp, a = expf(la); h = a * h + sqrtf(-expm1f(2.0f * la)) * (ii * xc); }
        const size_t o = (row0 + T - 1) * 512 + c; const float e = h * bf1(WSP(bf16, WS_GG)[o]);
        DBG_FLAG(8, dbg_bad(bf1((WSP(bf16, WS_OA) + (size_t)2 * MT * 512)[o]), e, 0.04f, 0.01f));
    }
    for (int s = gw; s < 512; s += NGW) {
        const unsigned r = dbg_rand(9000u + s); const int row = dbg_row(r), col = (r >> 7) % DM;
        float e = 0.f;
        for (int br = 0; br < 3; ++br) { const bf16* O = WSP(bf16, WS_OA) + (size_t)br * MT * 512 + (size_t)row * 512; const float* W = FIN(br == 0 ? I_WBRA : (br == 1 ? I_WBRB : I_WBRC));
            float a = 0.f; for (int k = lane; k < 512; k += 64) a += bf1(O[k]) * bfr(W[(size_t)k * DM + col]); a = wave_sum(a); e += bf1(WSP(bf16, WS_MGS)[(size_t)row * 3072 + br * 1024 + col]) * a; }
        DBG_FLAG(20, dbg_bad(bf1(WSP(bf16, WS_MRG)[(size_t)row * DM + col]), e, 0.03f, 0.01f));
        const float* mod = WSP(float, WS_MOD) + (size_t)row_bb(row) * 6144;
        { float a = 0.f; for (int k = lane; k < DM; k += 64) a += bf1(WSP(bf16, WS_MRG)[(size_t)row * DM + k]) * bfr(FIN(I_WOUT)[(size_t)k * DM + col]); a = wave_sum(a);
          const float ex = xrow_in(F, 0, row)[col] + mod[2048 + col] * a; DBG_FLAG(21, dbg_bad(WSP(float, WS_X1)[(size_t)row * DM + col], ex, 0.005f, 0.005f)); }
        { const float* xr = WSP(float, WS_X1) + (size_t)row * DM; float ss = 0.f; for (int d = lane; d < DM; d += 64) ss += xr[d] * xr[d]; const float rs = 1.0f / sqrtf(wave_sum(ss) * (1.0f / DM) + EPS);
          const int c2 = (r >> 9) % NUP; float a = 0.f; for (int d = lane; d < DM; d += 64) a += bfr(xr[d] * rs * FIN(I_N2G)[d] * (1.0f + mod[4096 + d]) + mod[3072 + d]) * bfr(FIN(I_WUP)[(size_t)d * NUP + c2]); a = wave_sum(a);
          const float got = c2 < DFF ? bf1(WSP(bf16, WS_GP)[(size_t)row * DFF + c2]) : bf1((WSP(bf16, WS_GP) + (size_t)MT * DFF)[(size_t)row * DFF + c2 - DFF]); DBG_FLAG(22, dbg_bad(got, a, 0.02f, 0.01f)); }
        { const int c3 = (r >> 11) % DFF; const bf16* GP = WSP(bf16, WS_GP); const bf16* VAL = GP + (size_t)MT * DFF; const float* cw = FIN(I_FCW);
          const bool isp = row < PM; const int t = isp ? (row & (PT - 1)) : ((row - PM) & 7); float xm2, xm1;
          if (t >= 2) { xm2 = bf1(GP[(size_t)(row - 2) * DFF + c3]); xm1 = bf1(GP[(size_t)(row - 1) * DFF + c3]); }
          else if (isp) { xm2 = 0.f; xm1 = (t == 1) ? bf1(GP[(size_t)(row - 1) * DFF + c3]) : 0.f; }
          else { const float* st = FIN(I_SFFN) + ((size_t)((row - PM) >> 3) * 2) * DFF + c3; xm2 = (t == 0) ? st[0] : st[DFF]; xm1 = (t == 0) ? st[DFF] : bf1(GP[(size_t)(row - 1) * DFF + c3]); }
          const float y = FIN(I_FCB)[c3] + cw[c3] * xm2 + cw[DFF + c3] * xm1 + cw[2 * DFF + c3] * bf1(GP[(size_t)row * DFF + c3]); const float ex = (y / (1.0f + expf(-y))) * bf1(VAL[(size_t)row * DFF + c3]);
          DBG_FLAG(23, dbg_bad(bf1((GP + (size_t)2 * MT * DFF)[(size_t)row * DFF + c3]), ex, 0.02f, 0.005f)); }
        { const bf16* ACT = WSP(bf16, WS_GP) + (size_t)2 * MT * DFF + (size_t)row * DFF; float a = 0.f; for (int k = lane; k < DFF; k += 64) a += bf1(ACT[k]) * bfr(FIN(I_WDN)[(size_t)k * DM + col]); a = wave_sum(a);
          const float ex = WSP(float, WS_X1)[(size_t)row * DM + col] + mod[5120 + col] * a; DBG_FLAG(24, dbg_bad(WSP(float, WS_X2)[(size_t)row * DM + col], ex, 0.005f, 0.005f)); }
    }
#undef DBG_FLAG
}
__device__ __forceinline__ void dbg_report_phase(Frame& F) {
    const unsigned* CNT = (const unsigned*)(F.ws + WS_CTL) + 3000;
    const size_t ooff[14] = {OUT_Y, OUT_Y + (size_t)PM * DM, OUT_ROWS_P, OUT_ROWS_S, OUT_WIN_P, OUT_WIN_S, OUT_RET_P, OUT_RET_S, OUT_H_P, OUT_H_S, OUT_CV_P, OUT_CV_S, OUT_FC_P, OUT_FC_S};
    if (F.bid == 0 && F.tid < 14) { const int b = F.tid; const unsigned c = CNT[b]; const int cnt = 1 + (int)(c > 1000u ? 1000u : c);
        for (int i = 0; i < cnt; ++i) ((unsigned*)F.out)[ooff[b] + 7 + 2 * i] = 0xAAAAAAAAu; }
}
#endif

#ifndef DBG_SUB
#define DBG_SUB 0xFFFF
#endif
#ifndef DBG_MAXPH
#define DBG_MAXPH N_PHASES
#endif
#ifndef DBG_REPEAT
#define DBG_REPEAT 0
#endif
#ifndef DBG_MASK
#define DBG_MASK 0xFFFF
#endif
#define IN(k) (lo <= (k) && (k) < hi)
#ifdef DBG_TIME
#define SEAM(k) do { if ((k) + 1 < hi) { if (MK_N_LAUNCHES == 1) xcd_barrier(bar); } if (F.bid == 0 && F.tid == 0) ((unsigned long long*)(F.ws + WS_CTL))[2048 + (k) + 1] = __builtin_amdgcn_s_memrealtime(); } while (0)
#else
#define SEAM(k) do { if ((k) + 1 < hi) { if (MK_N_LAUNCHES == 1) xcd_barrier(bar); } } while (0)
#endif
template <int l> __device__ __forceinline__ void ph_win(Frame& F) { unsigned char* ws = F.ws;
    pg8::Gemm g{(const pg8::bf16_t*)(ws + WS_H), (const pg8::bf16_t*)(ws + WS_WIN) + (size_t)l * NIN * DM, MT, NIN, DM};
    pg8::StaticOrder S; S.init(MT, NIN, F.G, F.bid); EpiWin E{ws, F.out, l};
    pg8::gemm_phase<EpiWin, pg8::StaticOrder, true, true>(F.lds, g, S, E); }
template <int l> __device__ __forceinline__ void ph_mix1(Frame& F) { unsigned char* ws = F.ws;
    if (DBG_SUB & 1) { launder(F);
        pg8::Gemm g{(const pg8::bf16_t*)(ws + WS_ACMP) + (size_t)l * CMP_ROWS * 1024, (const pg8::bf16_t*)(ws + WS_SMALLW + SW_W1T) + (size_t)l * 512 * 1024, CMP_ROWS, 512, 1024};
        CmpOrder S{F.G, F.bid}; EpiLH E{(bf16*)(ws + WS_LH)};
        pg8::gemm_phase<EpiLH, CmpOrder, true, true>(F.lds, g, S, E); }
    if (DBG_SUB & 2) for (int u = F.bid; u < 512; u += F.G) { launder(F); ret_local_unit(F, u); }
    if (DBG_SUB & 4) for (int u = F.bid; u < 256; u += F.G) { launder(F); rglru_unit<0>(F, l, u); } }
template <int l> __device__ __forceinline__ void ph_mix2(Frame& F) { cmp2_phase(F, l); ret_scan_phase(F, l); rglru_carry_phase(F, l); }
#ifndef DBG_REPSUB
#define DBG_REPSUB 0
#endif
#define MIX3_ATT_S() for (int a = F.bid; a < 64; a += F.G) { launder(F); attn_sample_unit(F, l, a); }
#define MIX3_ATT_P() for (int a = (F.bid < 64 ? F.bid + F.G : F.bid); a < 576; a += F.G) { const int p = a - 64, qt = 63 - (p >> 3), bk = p & 7; launder(F); attn_unit<false>(F, l, bk * 64 + qt); }
#define MIX3_RET_O() for (int u = F.bid; u < 512; u += F.G) { launder(F); ret_out_unit(F, l, u); }
#define MIX3_RET_S() for (int u = F.bid; u < 128; u += F.G) { launder(F); ret_sample_unit(F, l, u); }
#define MIX3_RG1() for (int u = F.bid; u < 256; u += F.G) { launder(F); rglru_unit<1>(F, l, u); }
#define MIX3_RG2() for (int u = F.bid; u < 32; u += F.G) { launder(F); rglru_unit<2>(F, l, u); }
template <int l> __device__ __forceinline__ void ph_mix3(Frame& F) {
    MIX3_ATT_S(); if (DBG_REPSUB & 1) { MIX3_ATT_S(); }
    MIX3_ATT_P(); if (DBG_REPSUB & 2) { MIX3_ATT_P(); }
    MIX3_RET_O(); if (DBG_REPSUB & 4) { MIX3_RET_O(); }
    MIX3_RET_S(); if (DBG_REPSUB & 8) { MIX3_RET_S(); }
    MIX3_RG1(); if (DBG_REPSUB & 16) { MIX3_RG1(); }
    MIX3_RG2(); if (DBG_REPSUB & 32) { MIX3_RG2(); }
    __syncthreads(); }
template <int l> __device__ __forceinline__ void ph_br(Frame& F) { unsigned char* ws = F.ws;
    const pg8::bf16_t* wbr = (const pg8::bf16_t*)(ws + WS_WBR) + (size_t)l * 3 * 1024 * 512;
    pg8::StaticOrder S; S.init(MT, DM, F.G, F.bid);
    { pg8::Gemm g{(const pg8::bf16_t*)(ws + WS_OA), wbr, MT, DM, 512}; EpiBr<0> E{ws}; pg8::gemm_phase<EpiBr<0>, pg8::StaticOrder, true, true>(F.lds, g, S, E); }
    { launder(F); pg8::Gemm g{(const pg8::bf16_t*)(ws + WS_OA) + (size_t)MT * 512, wbr + (size_t)1024 * 512, MT, DM, 512}; EpiBr<1> E{ws}; pg8::gemm_phase<EpiBr<1>, pg8::StaticOrder, true, true>(F.lds, g, S, E); }
    { launder(F); pg8::Gemm g{(const pg8::bf16_t*)(ws + WS_OA) + (size_t)2 * MT * 512, wbr + (size_t)2 * 1024 * 512, MT, DM, 512}; EpiBr<2> E{ws}; pg8::gemm_phase<EpiBr<2>, pg8::StaticOrder, true, true>(F.lds, g, S, E); } }
template <int l> __device__ __forceinline__ void ph_out(Frame& F) { unsigned char* ws = F.ws;
    pg8::Gemm g{(const pg8::bf16_t*)(ws + WS_MRG), (const pg8::bf16_t*)(ws + WS_WOUT) + (size_t)l * DM * DM, MT, DM, DM};
    pg8::StaticOrder S; S.init(MT, DM, F.G, F.bid);
    EpiRes E{l == 0 ? FIN(I_XP) : (const float*)(ws + WS_X2), l == 0 ? FIN(I_XS) : nullptr, (float*)(ws + WS_X1), (const float*)(ws + WS_MOD) + (size_t)l * 36 * 6144, 2048};
    pg8::gemm_phase<EpiRes, pg8::StaticOrder, true, true>(F.lds, g, S, E); }
template <int l> __device__ __forceinline__ void ph_up(Frame& F) { unsigned char* ws = F.ws;
    pg8::Gemm g{(const pg8::bf16_t*)(ws + WS_H), (const pg8::bf16_t*)(ws + WS_WUP) + (size_t)l * NUP * DM, MT, NUP, DM};
    pg8::StaticOrder S; S.init(MT, NUP, F.G, F.bid); EpiUp E{ws, F.out, l};
    pg8::gemm_phase<EpiUp, pg8::StaticOrder, true, true>(F.lds, g, S, E); }
template <int l> __device__ __forceinline__ void ph_down(Frame& F) { unsigned char* ws = F.ws;
    pg8::Gemm g{(const pg8::bf16_t*)(ws + WS_GP) + (size_t)2 * MT * DFF, (const pg8::bf16_t*)(ws + WS_WDN) + (size_t)l * DM * DFF, MT, DM, DFF};
    pg8::StaticOrder S; S.init(MT, DM, F.G, F.bid);
    EpiRes E{(const float*)(ws + WS_X1), nullptr, (float*)(ws + WS_X2), (const float*)(ws + WS_MOD) + (size_t)l * 36 * 6144, 5120};
    pg8::gemm_phase<EpiRes, pg8::StaticOrder, true, true>(F.lds, g, S, E); }
#define RUNPH(bit, ph, CALL) do { if (((DBG_MASK >> (bit)) & 1) && IN(ph)) { launder(F); CALL; if ((DBG_REPEAT >> (bit)) & 1) { launder(F); CALL; } SEAM(ph); } } while (0)
template <int l> __device__ __forceinline__ void layer_phases(Frame& F, const XcdBarrier& bar, int lo, int hi) {
    constexpr int pb = PH_L0 + l * PH_PER_LAYER;
    RUNPH(1, pb + LP_N1, norm_phase(F, l, 0));
    RUNPH(2, pb + LP_WIN, ph_win<l>(F));
    RUNPH(3, pb + LP_MIX1, ph_mix1<l>(F));
    RUNPH(4, pb + LP_MIX2, ph_mix2<l>(F));
    RUNPH(5, pb + LP_MIX3, ph_mix3<l>(F));
    RUNPH(6, pb + LP_BR, ph_br<l>(F));
    RUNPH(7, pb + LP_OUT, ph_out<l>(F));
    RUNPH(8, pb + LP_N2, norm_phase(F, l, 1));
    RUNPH(9, pb + LP_UP, ph_up<l>(F));
    RUNPH(10, pb + LP_CONV, convact_phase(F, l));
    RUNPH(11, pb + LP_DOWN, ph_down<l>(F));
}
__global__ void __launch_bounds__(NTHR, 2) trunk_fwd(Args args) {
    extern __shared__ __attribute__((aligned(16))) unsigned char lds_raw[];
    Frame F;
    F.lds = (LAS unsigned char*)lds_raw;
    F.tid = threadIdx.x; F.lane = F.tid & 63; F.wave = __builtin_amdgcn_readfirstlane(F.tid >> 6);
    F.G = gridDim.x; F.bid = blockIdx.x; F.a = &args; F.ws = args.ws; F.out = args.out;
    volatile LAS unsigned* MISC = (volatile LAS unsigned*)(F.lds + MISC_OFF);
    for (int u = F.tid; u < 64; u += NTHR) MISC[u] = 0u;
    __syncthreads();
    unsigned* barw = (unsigned*)(F.ws + WS_CTL) + CW_BAR;
    XcdBarrier bar; bar.bar = barw; bar.x = 0; bar.st = nullptr;
    if (MK_N_LAUNCHES == 1) bar = xcd_barrier_post(barw, MISC + 8);
    const int lo = args.ph_lo, hi = args.ph_hi;
    unsigned char* ws = F.ws;

#ifdef DBG_TIME
    if (F.bid == 0 && F.tid == 0) ((unsigned long long*)(F.ws + WS_CTL))[2048] = __builtin_amdgcn_s_memrealtime();
#endif
    RUNPH(0, PH_P0, p0_prologue(F));

    layer_phases<0>(F, bar, lo, hi);
    layer_phases<1>(F, bar, lo, hi);
    if (((DBG_MASK >> 12) & 1) && IN(PH_FINAL)) { launder(F); final_phase(F); if ((DBG_REPEAT >> 12) & 1) { launder(F); final_phase(F); } }
#ifdef DBG_TIME
    {
        xcd_barrier(bar);
        if (F.bid == 0 && F.tid < 14) {
            const unsigned long long* ts = (const unsigned long long*)(F.ws + WS_CTL) + 2048; const unsigned long long tend = __builtin_amdgcn_s_memrealtime();
            const size_t ooff[14] = {OUT_Y, OUT_Y + (size_t)PM * DM, OUT_ROWS_P, OUT_ROWS_S, OUT_WIN_P, OUT_WIN_S, OUT_RET_P, OUT_RET_S, OUT_H_P, OUT_H_S, OUT_CV_P, OUT_CV_S, OUT_FC_P, OUT_FC_S};
            const int b = F.tid; unsigned long long d;
            if (b == 0) d = tend - ts[0]; else if (b == 1) d = ts[1] - ts[0]; else if (b == 13) d = tend - ts[PH_FINAL];
            else { const int ph = PH_L0 + DBG_TIME_LAYER * PH_PER_LAYER + (b - 2); d = ts[ph + 1] - ts[ph]; }
            int cnt = (int)(d / 100ull); if (cnt < 1) cnt = 1; if (cnt > 2000 && b != 0) cnt = 2000;
            for (int i = 0; i < cnt; ++i) ((unsigned*)F.out)[ooff[b] + 7 + 2 * i] = 0xAAAAAAAAu;
        }
    }
#endif
#ifdef DBG_CHECK
    if (lo == 100) { launder(F); dbg_check_phase(F); }
    if (lo == 101) { for (size_t i = (size_t)F.bid * NTHR + F.tid; i < OUT_END; i += (size_t)F.G * NTHR) F.out[i] = 0.f; }
    if (lo == 102) { launder(F); dbg_report_phase(F); }
#endif
}

extern "C" void kernel_launch(void* const* d_in, const int* in_sizes, int n_in, void* d_out, int out_size, void* d_ws, size_t ws_size, hipStream_t stream) {
    static int grid = 0;
    if (grid == 0) {
        if (n_in != 37 || (size_t)out_size != OUT_END || ws_size < WS_END) { fprintf(stderr, "kernel_launch: unexpected shapes: n_in %d out %d (want %zu) ws %zu (want %zu)\n", n_in, out_size, (size_t)OUT_END, ws_size, (size_t)WS_END); grid = -1; return; }
        int dev = 0, cus = 0, per_cu = 0;
        if (hipGetDevice(&dev) != hipSuccess || hipDeviceGetAttribute(&cus, hipDeviceAttributeMultiprocessorCount, dev) != hipSuccess) { grid = -1; return; }
        if (hipFuncSetAttribute((const void*)trunk_fwd, hipFuncAttributeMaxDynamicSharedMemorySize, LDS_BYTES) != hipSuccess) { fprintf(stderr, "kernel_launch: hipFuncSetAttribute failed\n"); grid = -1; return; }
        if (hipOccupancyMaxActiveBlocksPerMultiprocessor(&per_cu, (const void*)trunk_fwd, NTHR, LDS_BYTES) != hipSuccess || per_cu < 1) fprintf(stderr, "kernel_launch: occupancy query reports %d\n", per_cu);
        (void)hipGetLastError();
        grid = cus;
    }
    if (grid < 0) return;
    if (hipMemsetAsync((char*)d_ws + WS_CTL, 0, CTL_ZERO_BYTES, stream) != hipSuccess) return;
#ifdef DBG_POISON
    (void)hipMemsetAsync((char*)d_ws + CTL_ZERO_BYTES, 0xAA, WS_END - CTL_ZERO_BYTES, stream);
    (void)hipMemsetAsync(d_out, 0xAA, (size_t)OUT_END * 4, stream);
#endif
    Args a{};
    for (int i = 0; i < 37; ++i) a.in[i] = d_in[i];
    a.out = (float*)d_out; a.ws = (unsigned char*)d_ws;
#if MK_N_LAUNCHES == 1
    a.ph_lo = 0; a.ph_hi = N_PHASES;
    hipLaunchKernelGGL(trunk_fwd, dim3(grid), dim3(NTHR), LDS_BYTES, stream, a);
#else
    for (int p = 0; p < DBG_MAXPH; ++p) { a.ph_lo = p; a.ph_hi = p + 1; hipLaunchKernelGGL(trunk_fwd, dim3(grid), dim3(NTHR), LDS_BYTES, stream, a); }
#ifdef DBG_CHECK
    for (int p = 100; p < 103; ++p) { a.ph_lo = p; a.ph_hi = p + 1; hipLaunchKernelGGL(trunk_fwd, dim3(grid), dim3(NTHR), LDS_BYTES, stream, a); }
#endif
#endif
    (void)in_sizes;
}
```

```cpp
#include <hip/hip_runtime.h>
#include <cstdio>
#include <cstdint>

#ifndef MK_N_LAUNCHES
#define MK_N_LAUNCHES 1
#endif

constexpr int DM = 1024, PB = 4, PT = 4096, PM = PB * PT, SB = 32, ST = 8, SM = SB * ST, MT = PM + SM;
constexpr int DEPTH = 2, PAST = 8192, PAGE = 128, NPG = PAST / PAGE, NPHYS = 2560;
constexpr int D_IN = 7448, NIN = 7680, DFF = 2816, NUP = 2 * DFF;
constexpr int WINB = 512;
constexpr float EPS = 1e-6f;
constexpr float QSCALE = 0.125f * 1.4426950408889634f;

constexpr int O_NQ = 0, O_NKV = 512, O_NG = 1280, O_RQ = 1304, O_RK = 1816, O_RV = 2328, O_RG = 2840, O_RX = 3352, O_RGATE = 3864, O_MG = 4376;

constexpr size_t OUT_Y = 0;
constexpr size_t OUT_ROWS_P = OUT_Y + (size_t)MT * DM;
constexpr size_t OUT_ROWS_S = OUT_ROWS_P + (size_t)DEPTH * PM * 512;
constexpr size_t OUT_WIN_P = OUT_ROWS_S + (size_t)DEPTH * SM * 512;
constexpr size_t OUT_WIN_S = OUT_WIN_P + (size_t)DEPTH * PB * WINB * 256;
constexpr size_t OUT_RET_P = OUT_WIN_S + (size_t)DEPTH * SB * WINB * 256;
constexpr size_t OUT_RET_S = OUT_RET_P + (size_t)DEPTH * PB * 4 * 16384;
constexpr size_t OUT_H_P = OUT_RET_S + (size_t)DEPTH * SB * 4 * 16384;
constexpr size_t OUT_H_S = OUT_H_P + (size_t)DEPTH * PB * 512;
constexpr size_t OUT_CV_P = OUT_H_S + (size_t)DEPTH * SB * 512;
constexpr size_t OUT_CV_S = OUT_CV_P + (size_t)DEPTH * PB * 3 * 512;
constexpr size_t OUT_FC_P = OUT_CV_S + (size_t)DEPTH * SB * 3 * 512;
constexpr size_t OUT_FC_S = OUT_FC_P + (size_t)DEPTH * PB * 2 * DFF;
constexpr size_t OUT_END = OUT_FC_S + (size_t)DEPTH * SB * 2 * DFF;

constexpr size_t MiB = 1u << 20;
constexpr size_t WS_CTL = 0, CTL_ZERO_BYTES = 4 * MiB;
constexpr size_t WS_MOD = 1 * MiB;
constexpr size_t WS_ROT = 4 * MiB;
constexpr size_t WS_SMALLW = 8 * MiB;
constexpr size_t WS_WIN = 16 * MiB;
constexpr size_t WS_WBR = WS_WIN + (size_t)2 * NIN * DM * 2;
constexpr size_t WS_WOUT = WS_WBR + (size_t)2 * 3 * 1024 * 512 * 2;
constexpr size_t WS_WUP = WS_WOUT + (size_t)2 * 1024 * 1024 * 2;
constexpr size_t WS_WDN = WS_WUP + (size_t)2 * NUP * DM * 2;
constexpr size_t WS_WEND = WS_WDN + (size_t)2 * DM * DFF * 2;
constexpr size_t WS_H = 128 * MiB;
constexpr size_t WS_QN = WS_H + (size_t)MT * DM * 2;
constexpr size_t WS_KVB = WS_QN + (size_t)MT * 512 * 2;
constexpr size_t WS_KVS = WS_KVB + (size_t)4 * PB * 2 * PT * 64 * 2;
constexpr size_t WS_RQ = WS_KVS + (size_t)4 * SB * 2 * ST * 64 * 2;
constexpr size_t WS_RX = WS_RQ + (size_t)4 * MT * 512 * 2;
constexpr size_t WS_GG = WS_RX + (size_t)MT * 512 * 4;
constexpr size_t WS_MGS = WS_GG + (size_t)MT * 512 * 2;
constexpr size_t WS_NG = WS_MGS + (size_t)MT * 3072 * 2;
constexpr size_t WS_OA = WS_NG + (size_t)MT * 24 * 4;
constexpr size_t WS_MRG = WS_OA + (size_t)3 * MT * 512 * 2;
constexpr size_t WS_X1 = WS_MRG + (size_t)MT * DM * 2;
constexpr size_t WS_X2 = WS_X1 + (size_t)MT * DM * 4;
constexpr size_t WS_GP = WS_X2 + (size_t)MT * DM * 4;
constexpr size_t WS_ACMP = WS_GP + (size_t)3 * MT * DFF * 2;
constexpr int CMP_ROWS_J = 34816, CMP_ROWS = 2 * CMP_ROWS_J;
constexpr size_t WS_LH = WS_ACMP + (size_t)2 * CMP_ROWS * 1024 * 2 + 4096;
constexpr size_t WS_CK = WS_LH + (size_t)(CMP_ROWS + 16) * 256 * 2;
constexpr size_t WS_LT = WS_CK + (size_t)CMP_ROWS * 64 * 2;
constexpr size_t WS_SPT = WS_LT + (size_t)16 * 32 * 16384 * 4;
constexpr size_t WS_CAR = WS_SPT + (size_t)16 * 32 * 16384 * 2;
constexpr size_t WS_END = WS_CAR + (size_t)4 * 64 * 3 * 512 * 4 + MiB;
static_assert(WS_WEND <= WS_H, "weights fit below WS_H");

constexpr size_t SW_W1T = 0;
constexpr size_t SW_W2T = SW_W1T + (size_t)2 * 2 * 256 * 1024 * 2;
constexpr size_t SW_CB = SW_W2T + (size_t)2 * 2 * 64 * 128 * 2;
constexpr size_t SW_WAT = SW_CB + (size_t)2 * 2 * 128 * 4;
constexpr size_t SW_SP = SW_WAT + (size_t)2 * 2 * 8 * 64 * 64 * 2;
constexpr size_t SW_END = SW_SP + 2 * 512 * 4;
static_assert(SW_END <= 8 * MiB, "small weights fit");

constexpr int CW_TMO = 0;
constexpr int CW_BAR = 4096;

constexpr int PH_P0 = 0, PH_L0 = 1, PH_PER_LAYER = 11, PH_FINAL = PH_L0 + DEPTH * PH_PER_LAYER, N_PHASES = PH_FINAL + 1;
enum { LP_N1 = 0, LP_WIN, LP_MIX1, LP_MIX2, LP_MIX3, LP_BR, LP_OUT, LP_N2, LP_UP, LP_CONV, LP_DOWN };

constexpr int RING_BYTES = 131072;
constexpr int MISC_OFF = RING_BYTES;
constexpr int LDS_BYTES = RING_BYTES + 1024;
constexpr int NWAVES = 8, NTHR = 512;

#define GAS __attribute__((address_space(1)))
#define LAS __attribute__((address_space(3)))
typedef unsigned short bf16;
typedef unsigned v4u __attribute__((ext_vector_type(4)));
typedef unsigned v2u __attribute__((ext_vector_type(2)));
typedef float f32x16 __attribute__((ext_vector_type(16)));
typedef short s16x4 __attribute__((ext_vector_type(4)));
namespace pg8 {
#define PG8_LAS __attribute__((address_space(3)))
typedef unsigned short bf16_t;
typedef short bf16x8 __attribute__((ext_vector_type(8)));
typedef float f32x4 __attribute__((ext_vector_type(4)));
typedef unsigned u32x4 __attribute__((ext_vector_type(4)));
constexpr int BM = 256, BK = 64, HALF = 128, HTB = HALF * BK * 2  , STAGE_BYTES = 8 * HTB, NXCD = 8, WGM = 8;

__host__ __device__ __forceinline__ int lds_byte(int r, int c) { const int st = (r >> 4) * 2 + (c >> 5), rr = r & 15, cc = c & 31, ob = rr * 64 + cc * 2; return st * 1024 + (ob ^ (((ob >> 9) & 1) << 5)); }
__host__ __device__ __forceinline__ void stage_rc(int b, int& R, int& C) { const int st = b / 1024, sb = b % 1024, swz = sb ^ (((sb >> 9) & 1) << 5); R = (st >> 1) * 16 + swz / 64; C = (st & 1) * 32 + (swz % 64) / 2; }
__host__ __device__ __forceinline__ int perm32(int rho) { const int n = rho >> 4, i = rho & 15; return 8 * (i >> 2) + 4 * n + (i & 3); }

struct Unit { int pm, pn; };
struct Gemm { const bf16_t* A; const bf16_t* Bt; int M, N, K; };

struct StaticOrder {
    int nM, nN, nwg, G, c;
    __host__ __device__ void init(int M, int N, int G_, int c_) { nM = M / BM; nN = N / BM; nwg = nM * nN; G = G_; c = c_; }
    __host__ __device__ bool next(int i, Unit& u) const {
        const long L = (long)i * G + c; if (L >= nwg) return false;
        int wgid = (int)L; { const int q = nwg / NXCD, r = nwg % NXCD, xcd = wgid % NXCD, off = wgid / NXCD; wgid = (xcd < r ? xcd * (q + 1) : r * (q + 1) + (xcd - r) * q) + off; }
        const int nig = WGM * nN, gid = wgid / nig, fm = gid * WGM, gsz = (nM - fm) < WGM ? (nM - fm) : WGM;
        u.pm = fm + ((wgid % nig) % gsz); u.pn = (wgid % nig) / gsz; return true;
    }
    __device__ __forceinline__ void a_ready(const Unit&) const {}
    __device__ __forceinline__ void done(const Unit&) const {}
};
__device__ __forceinline__ unsigned cvt_pk_bf16(float lo, float hi) { unsigned r; asm volatile("v_cvt_pk_bf16_f32 %0, %1, %2" : "=v"(r) : "v"(lo), "v"(hi)); return r; }
typedef float f32x2 __attribute__((ext_vector_type(2)));
template <class Epi, class Sched, bool ALIGN_EPI = false, bool SP2 = false>
__device__ __forceinline__ void gemm_phase(PG8_LAS unsigned char* lds, const Gemm g, const Sched& S, const Epi& E) {
    const int tid = threadIdx.x, wid = __builtin_amdgcn_readfirstlane(tid >> 6), lane = tid & 63, wr = wid >> 2, wc = wid & 3, fr = lane & 15, fq = lane >> 4;
    const int K = g.K, nt = K / BK;
    unsigned voffA[2], voffB[2];
#pragma unroll
    for (int i = 0; i < 2; ++i) { int R, C; stage_rc(tid * 16 + i * 8192, R, C); const int Rb = Epi::PERM ? ((R & ~31) + perm32(R & 31)) : R;
        voffA[i] = (unsigned)(R * K + C) * 2u; voffB[i] = (unsigned)(Rb * K + C) * 2u; }
    const size_t kstep = (size_t)(BK * 2);
    const size_t hstep = (size_t)HALF * K * 2;
    const size_t tstep = 2 * hstep;
    const unsigned ldsw = (unsigned)wid * 1024u;
    const int aoff = lds_byte(wr * 64 + fr, fq * 8), boff = lds_byte(wc * 32 + fr, fq * 8);
#define PG8_SA(b, h) (((b) * 2 + (h)) * HTB)
#define PG8_SB(b, h) ((4 + (b) * 2 + (h)) * HTB)
#define PG8_STAGE(bufoff, gbase, voff) do { _Pragma("unroll") for (int _i = 0; _i < 2; ++_i) \
        __builtin_amdgcn_global_load_lds((const unsigned*)((const char*)(gbase) + (voff)[_i]), (PG8_LAS unsigned*)(lds + (bufoff) + ldsw + _i * 8192), 16, 0, 0); } while (0)
#define PG8_LDA(dst, b, h) do { _Pragma("unroll") for (int m = 0; m < 4; ++m) _Pragma("unroll") for (int k = 0; k < 2; ++k) dst[m][k] = *(const PG8_LAS bf16x8*)(lds + PG8_SA(b, h) + aoff + m * 2048 + k * 1024); } while (0)
#define PG8_LDB(dst, b, h) do { _Pragma("unroll") for (int n = 0; n < 2; ++n) _Pragma("unroll") for (int k = 0; k < 2; ++k) dst[n][k] = *(const PG8_LAS bf16x8*)(lds + PG8_SB(b, h) + boff + n * 2048 + k * 1024); } while (0)
#define PG8_MMA(ai, bj, At, Bt) do { __builtin_amdgcn_s_setprio(1); _Pragma("unroll") for (int m = 0; m < 4; ++m) _Pragma("unroll") for (int n = 0; n < 2; ++n) _Pragma("unroll") for (int k = 0; k < 2; ++k) \
        acc[ai][bj][m][n] = __builtin_amdgcn_mfma_f32_16x16x32_bf16(Bt[n][k], At[m][k], acc[ai][bj][m][n], 0, 0, 0); __builtin_amdgcn_s_setprio(0); } while (0)
#define PG8_WAIT_V(n) asm volatile("s_waitcnt vmcnt(" #n ")" ::: "memory")
#define PG8_WAIT_L(n) asm volatile("s_waitcnt lgkmcnt(" #n ")" ::: "memory")
#define PG8_BAR __builtin_amdgcn_s_barrier()
#define PG8_SCHED __builtin_amdgcn_sched_barrier(0)
    Unit cur, nxt; int ui = 0;
    if (!S.next(0, cur)) return;
    f32x4 acc[2][2][4][2];
#pragma unroll
    for (int a = 0; a < 2; ++a)
#pragma unroll
        for (int b = 0; b < 2; ++b)
#pragma unroll
            for (int m = 0; m < 4; ++m)
#pragma unroll
                for (int n = 0; n < 2; ++n) acc[a][b][m][n] = (f32x4){0.f, 0.f, 0.f, 0.f};
    bf16x8 At[4][2], B0[2][2], B1[2][2];
    const char* cA = (const char*)g.A + (size_t)cur.pm * tstep; const char* cB = (const char*)g.Bt + (size_t)cur.pn * tstep;
    S.a_ready(cur);
    if constexpr (SP2) {
        PG8_STAGE(PG8_SB(0, 0), cB, voffB); PG8_STAGE(PG8_SB(0, 1), cB + hstep, voffB); PG8_STAGE(PG8_SA(0, 0), cA, voffA); PG8_STAGE(PG8_SA(0, 1), cA + hstep, voffA);
        if (wr == 1) PG8_BAR;
        PG8_WAIT_V(2); PG8_BAR;
        PG8_STAGE(PG8_SB(1, 0), cB + kstep, voffB); PG8_STAGE(PG8_SA(1, 0), cA + kstep, voffA); PG8_STAGE(PG8_SB(1, 1), cB + hstep + kstep, voffB);
        PG8_WAIT_V(6); PG8_BAR;
    } else {
        PG8_STAGE(PG8_SB(0, 0), cB, voffB); PG8_STAGE(PG8_SA(0, 0), cA, voffA); PG8_STAGE(PG8_SB(0, 1), cB + hstep, voffB); PG8_STAGE(PG8_SA(0, 1), cA + hstep, voffA);
        if (wr == 1) PG8_BAR;
        PG8_WAIT_V(4); PG8_BAR;
        PG8_STAGE(PG8_SB(1, 0), cB + kstep, voffB); PG8_STAGE(PG8_SA(1, 0), cA + kstep, voffA); PG8_STAGE(PG8_SB(1, 1), cB + hstep + kstep, voffB);
        PG8_WAIT_V(6); PG8_BAR;
    }
    for (;;) {
        const bool has_next = S.next(ui + 1, nxt);
        const char* nA = has_next ? (const char*)g.A + (size_t)nxt.pm * tstep : cA; const char* nB = has_next ? (const char*)g.Bt + (size_t)nxt.pn * tstep : cB;
        for (int t = 0; t < nt; t += 2) {
            const bool last = (t == nt - 2);
            const char* a1 = cA + (size_t)(t + 1) * kstep;
            const char* a2 = last ? nA : cA + (size_t)(t + 2) * kstep; const char* b2 = last ? nB : cB + (size_t)(t + 2) * kstep;
            const char* a3 = a2 + kstep; const char* b3 = b2 + kstep;
            if (last && has_next) S.a_ready(nxt);
            if constexpr (SP2) {
            PG8_LDB(B0, 0, 0); PG8_LDB(B1, 0, 1); PG8_SCHED; PG8_LDA(At, 0, 0); PG8_STAGE(PG8_SA(1, 1), a1 + hstep, voffA);
            PG8_WAIT_V(8); PG8_WAIT_L(0); PG8_BAR; PG8_MMA(0, 0, At, B0); PG8_MMA(0, 1, At, B1); PG8_BAR; PG8_SCHED;
            PG8_LDA(At, 0, 1); PG8_STAGE(PG8_SB(0, 0), b2, voffB); PG8_STAGE(PG8_SB(0, 1), b2 + hstep, voffB); PG8_STAGE(PG8_SA(0, 0), a2, voffA);
            PG8_WAIT_V(8); PG8_WAIT_L(0); PG8_BAR; PG8_MMA(1, 0, At, B0); PG8_MMA(1, 1, At, B1); PG8_BAR; PG8_SCHED;
            PG8_LDB(B0, 1, 0); PG8_LDB(B1, 1, 1); PG8_SCHED; PG8_LDA(At, 1, 0); PG8_STAGE(PG8_SA(0, 1), a2 + hstep, voffA);
            PG8_WAIT_V(8); PG8_WAIT_L(0); PG8_BAR; PG8_MMA(0, 0, At, B0); PG8_MMA(0, 1, At, B1); PG8_BAR; PG8_SCHED;
            PG8_LDA(At, 1, 1); PG8_STAGE(PG8_SB(1, 0), b3, voffB); PG8_STAGE(PG8_SB(1, 1), b3 + hstep, voffB); PG8_STAGE(PG8_SA(1, 0), a3, voffA);
            PG8_WAIT_V(8); PG8_WAIT_L(0); PG8_BAR; PG8_MMA(1, 0, At, B0); PG8_MMA(1, 1, At, B1); PG8_BAR; PG8_SCHED;
            } else {
            PG8_LDB(B0, 0, 0); PG8_SCHED; PG8_LDA(At, 0, 0); PG8_STAGE(PG8_SA(1, 1), a1 + hstep, voffA);
            PG8_WAIT_L(8); PG8_BAR; PG8_WAIT_L(0); PG8_MMA(0, 0, At, B0); PG8_BAR; PG8_SCHED;
            PG8_LDB(B1, 0, 1); PG8_STAGE(PG8_SB(0, 0), b2, voffB);
            PG8_BAR; PG8_WAIT_L(0); PG8_MMA(0, 1, At, B1); PG8_BAR;
            PG8_LDA(At, 0, 1); PG8_STAGE(PG8_SA(0, 0), a2, voffA);
            PG8_BAR; PG8_WAIT_L(0); PG8_MMA(1, 0, At, B0); PG8_BAR; PG8_SCHED;
            PG8_STAGE(PG8_SB(0, 1), b2 + hstep, voffB);
            PG8_WAIT_V(6); PG8_BAR; PG8_MMA(1, 1, At, B1); PG8_BAR;
            PG8_LDB(B0, 1, 0); PG8_SCHED; PG8_LDA(At, 1, 0); PG8_STAGE(PG8_SA(0, 1), a2 + hstep, voffA);
            PG8_WAIT_L(8); PG8_BAR; PG8_WAIT_L(0); PG8_MMA(0, 0, At, B0); PG8_BAR; PG8_SCHED;
            PG8_LDB(B1, 1, 1); PG8_STAGE(PG8_SB(1, 0), b3, voffB);
            PG8_BAR; PG8_WAIT_L(0); PG8_MMA(0, 1, At, B1); PG8_BAR;
            PG8_LDA(At, 1, 1); PG8_STAGE(PG8_SA(1, 0), a3, voffA);
            PG8_BAR; PG8_WAIT_L(0); PG8_MMA(1, 0, At, B0); PG8_BAR; PG8_SCHED;
            PG8_STAGE(PG8_SB(1, 1), b3 + hstep, voffB);
            PG8_WAIT_V(6); PG8_BAR; PG8_MMA(1, 1, At, B1); PG8_BAR;
            }
        }
        if constexpr (ALIGN_EPI) { if (wr == 0) PG8_BAR; }
        if constexpr (!Epi::AFTER_DRAIN) { E(acc, cur, wr, wc, fr, fq); S.done(cur); }
        if (!has_next) break;
#pragma unroll
        for (int a = 0; a < 2; ++a)
#pragma unroll
            for (int b = 0; b < 2; ++b)
#pragma unroll
                for (int m = 0; m < 4; ++m)
#pragma unroll
                    for (int n = 0; n < 2; ++n) acc[a][b][m][n] = (f32x4){0.f, 0.f, 0.f, 0.f};
        cur = nxt; cA = nA; cB = nB; ++ui;
        if constexpr (ALIGN_EPI) { if (wr == 1) PG8_BAR; }
    }
    PG8_WAIT_V(0);
    if constexpr (!ALIGN_EPI) { if (wr == 0) PG8_BAR; }
    PG8_BAR;
    if constexpr (Epi::AFTER_DRAIN) { E.fused(acc, cur, wr, wc, fr, fq, lds, wid, lane); S.done(cur); }
#undef PG8_SA
#undef PG8_SB
#undef PG8_STAGE
#undef PG8_LDA
#undef PG8_LDB
#undef PG8_MMA
#undef PG8_WAIT_V
#undef PG8_WAIT_L
#undef PG8_BAR
#undef PG8_SCHED
}
}

using pg8::bf16x8; using pg8::f32x4; using pg8::u32x4;
#define LDS_WAIT() asm volatile("s_waitcnt lgkmcnt(0)" ::: "memory")
#define VM_WAIT() asm volatile("s_waitcnt vmcnt(0)" ::: "memory")
typedef float f32x2_t __attribute__((ext_vector_type(2))); typedef __bf16 bf16x2_t __attribute__((ext_vector_type(2)));
__device__ __forceinline__ unsigned pk2(float lo, float hi) { f32x2_t v = {lo, hi}; bf16x2_t b = __builtin_convertvector(v, bf16x2_t); return __builtin_bit_cast(unsigned, b); }
__device__ __forceinline__ float bf_lo(unsigned w) { return __uint_as_float(w << 16); }
__device__ __forceinline__ float bf_hi(unsigned w) { return __uint_as_float(w & 0xffff0000u); }
__device__ __forceinline__ float bf1(bf16 b) { return __uint_as_float(((unsigned)b) << 16); }
__device__ __forceinline__ float fexp2(float x) { return __builtin_amdgcn_exp2f(x); }
__device__ __forceinline__ float fexp(float x) { return __builtin_amdgcn_exp2f(x * 1.4426950408889634f); }
__device__ __forceinline__ float frcp(float x) { return __builtin_amdgcn_rcpf(x); }
__device__ __forceinline__ float sigmoidf_(float x) { return frcp(1.0f + fexp(-x)); }
__device__ __forceinline__ float siluf_(float x) { return x * sigmoidf_(x); }
__device__ __forceinline__ float gelu_tanh(float x) {
    const float u = 0.7978845608028654f * (x + 0.044715f * x * x * x);
    const float e = fexp(2.0f * u);
    const float t = 1.0f - 2.0f * frcp(e + 1.0f);
    return 0.5f * x * (1.0f + t);
}
__device__ __forceinline__ float wave_sum(float v) {
#pragma unroll
    for (int o = 1; o < 64; o <<= 1) v += __shfl_xor(v, o);
    return v;
}
__device__ __forceinline__ v4u pack8(const f32x4 a, const f32x4 b) { v4u w; w.x = pk2(a[0], a[1]); w.y = pk2(a[2], a[3]); w.z = pk2(b[0], b[1]); w.w = pk2(b[2], b[3]); return w; }
__device__ __forceinline__ void unpack8(const v4u w, f32x4& a, f32x4& b) { a = (f32x4){bf_lo(w.x), bf_hi(w.x), bf_lo(w.y), bf_hi(w.y)}; b = (f32x4){bf_lo(w.z), bf_hi(w.z), bf_lo(w.w), bf_hi(w.w)}; }

#define XB_TMO      128
#define XB_XCNT(j)  (256  + 64 * (j))
#define XB_XSUB(j)  (1280 + 64 * (j))
#define XB_XGEN(j)  (2304 + 64 * (j))
#define XB_TOP      3328
#define XB_TOPGEN   3392
#define XCD_BAR_WORDS 3456
#define XB_SPIN_CAP (1u << 18)

__device__ __forceinline__ unsigned xb_ld(unsigned* p)              { return __hip_atomic_load(p, __ATOMIC_RELAXED, __HIP_MEMORY_SCOPE_AGENT); }
__device__ __forceinline__ unsigned xb_add(unsigned* p, unsigned v) { return __hip_atomic_fetch_add(p, v, __ATOMIC_RELAXED, __HIP_MEMORY_SCOPE_AGENT); }
__device__ __forceinline__ unsigned xb_xcc_id() { return (unsigned)__builtin_amdgcn_s_getreg((3 << 11) | 20) & 0xFu; }
#define XB_SPIN(cond, bar) do { unsigned _sp = 0; while (cond) { __builtin_amdgcn_s_sleep(1); \
    if ((++_sp & 255u) == 0u) { if (xb_ld(&(bar)[XB_TMO])) break; if (_sp > XB_SPIN_CAP) { atomicAdd(&(bar)[XB_TMO], 1u); break; } } } } while (0)

struct XcdBarrier {
    unsigned* bar; unsigned x;
    volatile LAS unsigned* st;
};

__device__ __forceinline__ XcdBarrier xcd_barrier_post(unsigned* bar, volatile LAS unsigned* st) {
    XcdBarrier b; b.bar = bar; b.x = xb_xcc_id(); b.st = st;
    if (threadIdx.x == 0) (void)xb_add(&bar[XB_XCNT(b.x)], 1u);
    return b;
}
__device__ __forceinline__ void xcd_barrier_complete(unsigned* bar, unsigned x, unsigned& nloc, unsigned& nx) {
    const unsigned G = gridDim.x * gridDim.y * gridDim.z;
    unsigned sum, cnt, mine, sp = 0u;
    for (;;) {
        sum = 0u; cnt = 0u; mine = 0u;
#pragma unroll
        for (unsigned j = 0; j < 16; ++j) { const unsigned c = xb_ld(&bar[XB_XCNT(j)]); sum += c; cnt += (c > 0u) ? 1u : 0u; mine = (j == x) ? c : mine; }
        if (sum == G) break;
        __builtin_amdgcn_s_sleep(1);
        if ((++sp & 255u) == 0u) { if (xb_ld(&bar[XB_TMO])) break; if (sp > XB_SPIN_CAP) { atomicAdd(&bar[XB_TMO], 1u); break; } }
    }
    nloc = mine > 0u ? mine : 1u; nx = cnt > 0u ? cnt : 1u;
}

__device__ __forceinline__ void xcd_barrier(const XcdBarrier& b) {
    asm volatile("s_waitcnt vmcnt(0)" ::: "memory");
    __syncthreads();
    if (threadIdx.x == 0) {
        unsigned* bar = b.bar;
        __builtin_amdgcn_s_waitcnt(0);
        unsigned nloc = b.st[0], nx = b.st[1];
        if (nloc == 0u) { xcd_barrier_complete(bar, b.x, nloc, nx); b.st[0] = nloc; b.st[1] = nx; }
        const unsigned old = xb_add(&bar[XB_XSUB(b.x)], 1u);
        const unsigned gen = old / nloc;
        if (old + 1u == (gen + 1u) * nloc) {
            __builtin_amdgcn_fence(__ATOMIC_RELEASE, "agent");
            asm volatile("s_waitcnt vmcnt(0)" ::: "memory");
            const unsigned og = xb_add(&bar[XB_TOP], 1u);
            const unsigned tg = og / nx;
            if (og + 1u == (tg + 1u) * nx) xb_add(&bar[XB_TOPGEN], 1u);
            else XB_SPIN(xb_ld(&bar[XB_TOPGEN]) == tg, bar);
            __builtin_amdgcn_fence(__ATOMIC_ACQUIRE, "agent");
            xb_add(&bar[XB_XGEN(b.x)], 1u);
            asm volatile("s_waitcnt vmcnt(0)" ::: "memory");
        } else {
            XB_SPIN(xb_ld(&bar[XB_XGEN(b.x)]) == gen, bar);
            __builtin_amdgcn_fence(__ATOMIC_ACQUIRE, "agent");
            asm volatile("s_waitcnt vmcnt(0)" ::: "memory");
        }
    }
    __syncthreads();
}

struct Args { const void* in[37]; float* out; unsigned char* ws; int ph_lo, ph_hi; };
enum { I_XP = 0, I_XS, I_CACHE, I_CWIN, I_SRET, I_SH, I_SCONV, I_SFFN, I_PT, I_CP, I_CS, I_N1G, I_N2G, I_WADA, I_BADA, I_WIN, I_PE, I_W1, I_B1, I_W2,
       I_GNG, I_RCW, I_RCB, I_RWA, I_RBA, I_RWX, I_RBX, I_LAM, I_WBRA, I_WBRB, I_WBRC, I_WOUT, I_WUP, I_FCW, I_FCB, I_WDN, I_FNG };

struct Frame {
    LAS unsigned char* lds;
    int tid, lane, wave, G, bid;
    const Args* a;
    unsigned char* ws;
    float* out;
};
__device__ __forceinline__ void launder(Frame& F) { asm volatile("" : "+v"(F.tid), "+v"(F.lane)); int w_ = __builtin_amdgcn_readfirstlane(F.wave), b_ = __builtin_amdgcn_readfirstlane(F.bid), g_ = __builtin_amdgcn_readfirstlane(F.G); asm volatile("" : "+s"(w_), "+s"(b_), "+s"(g_)); F.wave = w_; F.bid = b_; F.G = g_; }
#define FIN(i) ((const float*)F.a->in[i])
#define WSP(T, off) ((T*)(F.ws + (off)))

__device__ __forceinline__ int row_bb(int row) { return row < PM ? (row >> 12) : 4 + ((row - PM) >> 3); }
__device__ __forceinline__ int row_pos(int row) { return row < PM ? (row & (PT - 1)) : PT + ((row - PM) & 7); }

__device__ __forceinline__ int win_cmap(int n) {
    if (n < 1280) return n;
    if (n < 2304) { const int c = n - 1280, isk = c >> 9, hc = c & 511, head = hc >> 7, s = hc & 127;
        const int g = s >> 3, w = s & 7, dim = (w < 4) ? (4 * g + w) : (64 + 4 * g + (w - 4)); return (isk ? O_RK : O_RQ) + head * 128 + dim; }
    if (n < 2816) return O_RV + (n - 2304);
    if (n < 3328) return O_RG + (n - 2816);
    if (n < 3840) return O_RX + (n - 3328);
    if (n < 4352) return O_RGATE + (n - 3840);
    if (n < 7424) return O_MG + (n - 4352);
    if (n < 7448) return O_NG + (n - 7424);
    return -1;
}

template <bool MAP> __device__ __forceinline__ void p0_tr_item(const float* W, int ldw, bf16* WT, int ldt, int k0, int n0, LAS float* scr, int lane) {
    const int nd = n0 + (lane & 31); const int sc = MAP ? win_cmap(nd) : nd;
#pragma unroll 8
    for (int i = 0; i < 32; ++i) { const int kk = 2 * i + (lane >> 5); scr[kk * 33 + (lane & 31)] = (sc >= 0) ? W[(size_t)(k0 + kk) * ldw + sc] : 0.f; }
    LDS_WAIT(); asm volatile("" ::: "memory");
    const int c = lane & 7;
#pragma unroll
    for (int j = 0; j < 4; ++j) { const int n = (lane >> 3) + 8 * j; const LAS float* s = scr + (8 * c) * 33 + n;
        v4u o; o.x = pk2(s[0 * 33], s[1 * 33]); o.y = pk2(s[2 * 33], s[3 * 33]); o.z = pk2(s[4 * 33], s[5 * 33]); o.w = pk2(s[6 * 33], s[7 * 33]);
        *(v4u*)(WT + (size_t)(n0 + n) * ldt + k0 + 8 * c) = o; }
    LDS_WAIT(); asm volatile("" ::: "memory");
}
__device__ __forceinline__ void sincos_acc(float ang, float& s, float& c) {
    const double a = (double)ang; const double kq = rint(a * 0.63661977236758134308); const double r = fma(-kq, 1.57079632679489661923, a);
    const double r2 = r * r;
    const double sp = r * (1.0 + r2 * (-1.6666666666666666e-1 + r2 * (8.3333333333333332e-3 + r2 * (-1.9841269841269841e-4 + r2 * (2.7557319223985893e-6 + r2 * (-2.5052108385441720e-8))))));
    const double cp = 1.0 + r2 * (-0.5 + r2 * (4.1666666666666664e-2 + r2 * (-1.3888888888888889e-3 + r2 * (2.4801587301587302e-5 + r2 * (-2.7557319223985888e-7 + r2 * 2.0876756987868099e-9)))));
    const int q = ((int)kq) & 3;
    const double ss = (q == 0) ? sp : (q == 1) ? cp : (q == 2) ? -sp : -cp;
    const double cc = (q == 0) ? cp : (q == 1) ? -sp : (q == 2) ? -cp : sp;
    s = (float)ss; c = (float)cc;
}

__device__ __forceinline__ void p0_prologue(Frame& F) {
    const int gw = F.bid * NWAVES + F.wave, NGW = F.G * NWAVES, lane = F.lane;
    LAS float* scr = (LAS float*)(F.lds + F.wave * 16384);
    {
        constexpr int I_IN = 16 * 240, I_BR = 8 * 32, I_OUT = 16 * 32, I_UP = 16 * 176, I_DN = 44 * 32, I_L = I_IN + 3 * I_BR + I_OUT + I_UP + I_DN;
        for (int it = gw; it < 2 * I_L; it += NGW) {
            const int l = it / I_L; int r = it % I_L;
            if (r < I_IN) { p0_tr_item<true>(FIN(I_WIN) + (size_t)l * DM * D_IN, D_IN, WSP(bf16, WS_WIN) + (size_t)l * NIN * DM, DM, 64 * (r / 240), 32 * (r % 240), scr, lane); continue; } r -= I_IN;
            if (r < 3 * I_BR) { const int w = r / I_BR, q = r % I_BR; const float* src = FIN(w == 0 ? I_WBRA : (w == 1 ? I_WBRB : I_WBRC)) + (size_t)l * 512 * 1024;
                p0_tr_item<false>(src, 1024, WSP(bf16, WS_WBR) + (size_t)(l * 3 + w) * 1024 * 512, 512, 64 * (q / 32), 32 * (q % 32), scr, lane); continue; } r -= 3 * I_BR;
            if (r < I_OUT) { p0_tr_item<false>(FIN(I_WOUT) + (size_t)l * 1024 * 1024, 1024, WSP(bf16, WS_WOUT) + (size_t)l * 1024 * 1024, 1024, 64 * (r / 32), 32 * (r % 32), scr, lane); continue; } r -= I_OUT;
            if (r < I_UP) { p0_tr_item<false>(FIN(I_WUP) + (size_t)l * DM * NUP, NUP, WSP(bf16, WS_WUP) + (size_t)l * NUP * DM, DM, 64 * (r / 176), 32 * (r % 176), scr, lane); continue; } r -= I_UP;
            p0_tr_item<false>(FIN(I_WDN) + (size_t)l * DFF * DM, DM, WSP(bf16, WS_WDN) + (size_t)l * DM * DFF, DFF, 64 * (r / 32), 32 * (r % 32), scr, lane);
        }
    }
    {
        constexpr int NI_W1 = 8 * 16 * 4, NI_W2 = 4 * 2 * 2, NI_RG = 32 * 2;
        for (int it = gw; it < NI_W1 + NI_W2 + NI_RG; it += NGW) {
            int r = it;
            if (r < NI_W1) { const int m = r / 64, q = r % 64, lk = m >> 1, half = m & 1;
                p0_tr_item<false>(FIN(I_W1) + ((size_t)lk * 32 + half * 16) * 64 * 128, 128, WSP(bf16, WS_SMALLW + SW_W1T) + ((size_t)lk * 256 + half * 128) * 1024, 1024, 64 * (q / 4), 32 * (q % 4), scr, lane); continue; } r -= NI_W1;
            if (r < NI_W2) { const int lk = r / 4, q = r % 4;
                p0_tr_item<false>(FIN(I_W2) + (size_t)lk * 128 * 64, 64, WSP(bf16, WS_SMALLW + SW_W2T) + (size_t)lk * 64 * 128, 128, 64 * (q / 2), 32 * (q % 2), scr, lane); continue; } r -= NI_W2;
            { const int m = r / 2, q = r % 2, l = m >> 4, which = (m >> 3) & 1, blk = m & 7;
                p0_tr_item<false>(FIN(which ? I_RWX : I_RWA) + ((size_t)l * 8 + blk) * 4096, 64, WSP(bf16, WS_SMALLW + SW_WAT) + (size_t)m * 4096, 64, 0, 32 * q, scr, lane); }
        }
    }
    for (int it = gw; it < 64; it += NGW) {
        const int lk = it >> 4, h0 = (it & 15) * 8; const float* pe = FIN(I_PE) + (size_t)lk * 2048; const float* w1 = FIN(I_W1) + (size_t)lk * 2048 * 128 + h0;
        f32x4 a0 = (f32x4){0.f, 0.f, 0.f, 0.f}, a1 = a0;
#pragma unroll 8
        for (int i = lane; i < 2048; i += 64) { const float p = pe[i]; a0 += *(const f32x4*)(w1 + (size_t)i * 128) * p; a1 += *(const f32x4*)(w1 + (size_t)i * 128 + 4) * p; }
#pragma unroll
        for (int x = 0; x < 4; ++x) { a0[x] = wave_sum(a0[x]); a1[x] = wave_sum(a1[x]); }
        if (lane == 0) { float* cb = WSP(float, WS_SMALLW + SW_CB) + lk * 128 + h0; const float* b1 = FIN(I_B1) + lk * 128 + h0;
#pragma unroll
            for (int x = 0; x < 4; ++x) { cb[x] = a0[x] + b1[x]; cb[4 + x] = a1[x] + b1[4 + x]; } }
    }
    for (int i = F.bid * NTHR + F.tid; i < 1024; i += F.G * NTHR) { const float lam = FIN(I_LAM)[i]; WSP(float, WS_SMALLW + SW_SP)[i] = log1pf(expf(-lam)); }
    for (int i = F.bid * NTHR + F.tid; i < 4104 * 64; i += F.G * NTHR) {
        const int pi = i >> 6, fi = i & 63; const float pos = (float)(pi < PT ? pi : PAST + (pi - PT));
        const float freq = (float)pow(10000.0, -(double)fi / 64.0); const float ang = pos * freq; float s, c; sincos_acc(ang, s, c);
        WSP(float, WS_ROT)[i] = c; WSP(float, WS_ROT)[4104 * 64 + i] = s;
    }
    {
        LAS float* SC = (LAS float*)(F.lds + 0);
        LAS float* RED = (LAS float*)(F.lds + 36864);
        for (int u = F.bid; u < 2 * 96; u += F.G) {
            const int l = u / 96, cg = u % 96; float acc[36];
#pragma unroll
            for (int b = 0; b < 36; ++b) acc[b] = 0.f;
#pragma unroll 1
            for (int kh = 0; kh < 4; ++kh) {
                __syncthreads();
                for (int i = F.tid; i < 256 * 36; i += NTHR) { const int d = i / 36, bb = i % 36; const float c = (bb < 4) ? FIN(I_CP)[bb * DM + kh * 256 + d] : FIN(I_CS)[(bb - 4) * DM + kh * 256 + d]; SC[i] = siluf_(c); }
                __syncthreads();
                const float* wp = FIN(I_WADA) + ((size_t)l * DM + kh * 256 + F.wave * 32) * 6144 + cg * 64 + lane;
#pragma unroll 1
                for (int d0 = 0; d0 < 32; d0 += 16) {
                    float wv[16];
#pragma unroll
                    for (int k = 0; k < 16; ++k) wv[k] = wp[(size_t)(d0 + k) * 6144];
#pragma unroll
                    for (int k = 0; k < 16; ++k) { const LAS f32x4* sc4 = (const LAS f32x4*)(SC + (F.wave * 32 + d0 + k) * 36);
#pragma unroll
                        for (int g = 0; g < 9; ++g) { const f32x4 s4 = sc4[g]; acc[4 * g + 0] += wv[k] * s4[0]; acc[4 * g + 1] += wv[k] * s4[1]; acc[4 * g + 2] += wv[k] * s4[2]; acc[4 * g + 3] += wv[k] * s4[3]; } }
                }
            }
#pragma unroll
            for (int b = 0; b < 36; ++b) RED[(F.wave * 36 + b) * 64 + lane] = acc[b];
            __syncthreads();
            for (int o = F.tid; o < 36 * 64; o += NTHR) { const int b = o >> 6, col = o & 63; float sm = FIN(I_BADA)[l * 6144 + cg * 64 + col];
#pragma unroll
                for (int w = 0; w < 8; ++w) sm += RED[(w * 36 + b) * 64 + col];
                WSP(float, WS_MOD)[((size_t)l * 36 + b) * 6144 + cg * 64 + col] = sm; }
        }
        __syncthreads();
    }
    for (int it = gw; it < 2 * SB * PAST / 8; it += NGW) {
        const int l = it / (SB * PAST / 8), r = it % (SB * PAST / 8), db = r / (PAST / 8), tt0 = (r % (PAST / 8)) * 8;
        const int page = ((const int*)F.a->in[I_PT])[db * NPG + (tt0 >> 7)];
        const float* src = FIN(I_CACHE) + (((size_t)l * NPHYS + page) * PAGE + (tt0 & 127)) * 512 + lane * 4;
        f32x4 v[8];
#pragma unroll
        for (int k = 0; k < 8; ++k) v[k] = __builtin_nontemporal_load((const f32x4*)(src + (size_t)k * 512));
        const int idx = lane * 4, j = idx >> 7, kk = (idx >> 6) & 1, d = idx & 63;
        bf16* dst = WSP(bf16, WS_ACMP) + ((size_t)(l * 2 + j) * CMP_ROWS_J) * 1024 + ((size_t)(db * 2 + kk) * PAST + tt0) * 64 + d;
#pragma unroll
        for (int k = 0; k < 8; ++k) { v2u o; o.x = pk2(v[k][0], v[k][1]); o.y = pk2(v[k][2], v[k][3]); *(v2u*)(dst + (size_t)k * 64) = o; }
    }
    for (size_t i = (size_t)F.bid * NTHR + F.tid; i < (size_t)2 * SB * 504 * 64; i += (size_t)F.G * NTHR) {
        const size_t seq = i / (504 * 64), r = i % (504 * 64);
        const f32x4 v = *(const f32x4*)(FIN(I_CWIN) + (seq * 512 + 8) * 256 + r * 4);
        *(f32x4*)(F.out + OUT_WIN_S + seq * 512 * 256 + r * 4) = v;
    }
}

__device__ __forceinline__ const float* xrow_in(const Frame& F, int l, int row) {
    if (l == 0) return row < PM ? FIN(I_XP) + (size_t)row * DM : FIN(I_XS) + (size_t)(row - PM) * DM;
    return WSP(float, WS_X2) + (size_t)row * DM;
}
__device__ __forceinline__ void norm_phase(Frame& F, int l, int which) {
    const int gw = F.bid * NWAVES + F.wave, NGW = F.G * NWAVES, lane = F.lane;
    const float* g = FIN(which ? I_N2G : I_N1G) + l * DM;
    for (int row = gw; row < MT; row += NGW) {
        const float* xr = which ? WSP(float, WS_X1) + (size_t)row * DM : xrow_in(F, l, row);
        const float* mod = WSP(float, WS_MOD) + ((size_t)l * 36 + row_bb(row)) * 6144 + (which ? 3072 : 0);
        f32x4 v[4]; float ss = 0.f;
#pragma unroll
        for (int j = 0; j < 4; ++j) { v[j] = *(const f32x4*)(xr + lane * 4 + 256 * j); ss += (v[j][0] * v[j][0] + v[j][1] * v[j][1]) + (v[j][2] * v[j][2] + v[j][3] * v[j][3]); }
        const float rs = 1.0f / sqrtf(wave_sum(ss) * (1.0f / DM) + EPS);
        bf16* o = WSP(bf16, WS_H) + (size_t)row * DM;
#pragma unroll
        for (int j = 0; j < 4; ++j) { const int c = lane * 4 + 256 * j; const f32x4 gg = *(const f32x4*)(g + c), sh = *(const f32x4*)(mod + c), sc = *(const f32x4*)(mod + 1024 + c);
            const f32x4 y = (v[j] * rs) * gg * (sc + 1.0f) + sh; v2u w; w.x = pk2(y[0], y[1]); w.y = pk2(y[2], y[3]); *(v2u*)(o + c) = w; }
    }
}
__device__ __forceinline__ void final_phase(Frame& F) {
    const int gw = F.bid * NWAVES + F.wave, NGW = F.G * NWAVES, lane = F.lane;
    const float* g = FIN(I_FNG);
    for (int row = gw; row < MT; row += NGW) {
        const float* xr = WSP(float, WS_X2) + (size_t)row * DM;
        f32x4 v[4]; float ss = 0.f;
#pragma unroll
        for (int j = 0; j < 4; ++j) { v[j] = *(const f32x4*)(xr + lane * 4 + 256 * j); ss += (v[j][0] * v[j][0] + v[j][1] * v[j][1]) + (v[j][2] * v[j][2] + v[j][3] * v[j][3]); }
        const float rs = 1.0f / sqrtf(wave_sum(ss) * (1.0f / DM) + EPS);
        float* o = F.out + OUT_Y + (size_t)row * DM;
#pragma unroll
        for (int j = 0; j < 4; ++j) { const int c = lane * 4 + 256 * j; *(f32x4*)(o + c) = (v[j] * rs) * *(const f32x4*)(g + c); }
    }
}

#define EPI_LOOP_BEGIN \
    _Pragma("unroll") for (int ai = 0; ai < 2; ++ai) _Pragma("unroll") for (int m = 0; m < 4; ++m) { const int row = u.pm * 256 + ai * 128 + wr * 64 + m * 16 + fr; \
    _Pragma("unroll") for (int bj = 0; bj < 2; ++bj) { const int ct = bj * 128 + wc * 32 + 8 * fq; const f32x4 v0 = acc[ai][bj][m][0], v1 = acc[ai][bj][m][1];
#define EPI_LOOP_END } }

struct EpiWin {
    static constexpr bool PERM = true, AFTER_DRAIN = false;
    unsigned char* ws; float* out; int l;
    __device__ __forceinline__ void operator()(const f32x4 (&acc)[2][2][4][2], const pg8::Unit& u, int wr, int wc, int fr0, int fq0) const {
        int fr = fr0, fq = fq0; asm volatile("" : "+v"(fr), "+v"(fq));
        const int pn = u.pn;
        if (pn < 2) {
            bf16* QN = (bf16*)(ws + WS_QN);
            EPI_LOOP_BEGIN *(v4u*)(QN + (size_t)row * 512 + pn * 256 + ct) = pack8(v0 * QSCALE, v1 * QSCALE); EPI_LOOP_END
        } else if (pn < 5) {
            EPI_LOOP_BEGIN
                const int c = (pn - 2) * 256 + ct, j = c >> 7, k = (c >> 6) & 1, d = c & 63;
                const bool isp = row < PM; const int b = isp ? (row >> 12) : ((row - PM) >> 3), t = isp ? (row & (PT - 1)) : ((row - PM) & 7);
                if (j < 4) { float* o = out + (isp ? OUT_ROWS_P + ((size_t)l * PM + row) * 512 : OUT_ROWS_S + ((size_t)l * SM + (row - PM)) * 512) + c; *(f32x4*)o = v0; *(f32x4*)(o + 4) = v1; }
                else if (isp) { if (t >= PT - WINB) { float* o = out + OUT_WIN_P + (((size_t)l * PB + b) * WINB + (t - (PT - WINB))) * 256 + (c - 512); *(f32x4*)o = v0; *(f32x4*)(o + 4) = v1; } }
                else { float* o = out + OUT_WIN_S + (((size_t)l * SB + b) * WINB + (WINB - ST) + t) * 256 + (c - 512); *(f32x4*)o = v0; *(f32x4*)(o + 4) = v1; }
                const v4u w = pack8(v0, v1);
                if (isp) {
                    if (j < 2) *(v4u*)((bf16*)(ws + WS_ACMP) + ((size_t)(l * 2 + j) * CMP_ROWS_J + 32768 + (b * 2 + k) * 256) * 1024 + (size_t)t * 64 + d) = w;
                    else *(v4u*)((bf16*)(ws + WS_KVB) + ((((size_t)(j - 2) * PB + b) * 2 + k) * PT + t) * 64 + d) = w;
                } else if (j >= 2) *(v4u*)((bf16*)(ws + WS_KVS) + ((((size_t)(j - 2) * SB + b) * 2 + k) * ST + t) * 64 + d) = w;
            EPI_LOOP_END
        } else if (pn < 9) {
            const float* ROTC = (const float*)(ws + WS_ROT); const float* ROTS = ROTC + 4104 * 64;
            EPI_LOOP_BEGIN
                const int c = (pn - 5) * 256 + ct, isk = c >> 9, hc = c & 511, head = hc >> 7, d0 = ((hc & 127) >> 3) * 4;
                const int pi = row_pos(row); const f32x4 cs = *(const f32x4*)(ROTC + pi * 64 + d0), sn = *(const f32x4*)(ROTS + pi * 64 + d0);
                const float sc = isk ? 0.08838834764831845f : 1.0f;
                const f32x4 o1 = (v0 * cs - v1 * sn) * sc, o2 = (v0 * sn + v1 * cs) * sc;
                bf16* o = (bf16*)(ws + WS_RQ) + (size_t)isk * MT * 512 + (size_t)row * 512 + head * 128 + d0;
                v2u w1; w1.x = pk2(o1[0], o1[1]); w1.y = pk2(o1[2], o1[3]); *(v2u*)o = w1;
                v2u w2; w2.x = pk2(o2[0], o2[1]); w2.y = pk2(o2[2], o2[3]); *(v2u*)(o + 64) = w2;
            EPI_LOOP_END
        } else if (pn < 13) {
            bf16* RV = (bf16*)(ws + WS_RQ) + (size_t)2 * MT * 512;
            EPI_LOOP_BEGIN const int c = (pn - 9) * 256 + ct; *(v4u*)(RV + (size_t)(c >> 9) * MT * 512 + (size_t)row * 512 + (c & 511)) = pack8(v0, v1); EPI_LOOP_END
        } else if (pn < 15) {
            float* RX = (float*)(ws + WS_RX);
            EPI_LOOP_BEGIN
                const int c = (pn - 13) * 256 + ct; float* o = RX + (size_t)row * 512 + c; *(f32x4*)o = v0; *(f32x4*)(o + 4) = v1;
                if (row < PM) { const int t = row & (PT - 1); if (t >= PT - 3) { float* q = out + OUT_CV_P + (((size_t)l * PB + (row >> 12)) * 3 + (t - (PT - 3))) * 512 + c; *(f32x4*)q = v0; *(f32x4*)(q + 4) = v1; } }
                else { const int i = (row - PM) & 7; if (i >= ST - 3) { float* q = out + OUT_CV_S + (((size_t)l * SB + ((row - PM) >> 3)) * 3 + (i - (ST - 3))) * 512 + c; *(f32x4*)q = v0; *(f32x4*)(q + 4) = v1; } }
            EPI_LOOP_END
        } else if (pn < 17) {
            bf16* GG = (bf16*)(ws + WS_GG);
            EPI_LOOP_BEGIN const int c = (pn - 15) * 256 + ct;
                f32x4 a, b;
#pragma unroll
                for (int i = 0; i < 4; ++i) { a[i] = gelu_tanh(v0[i]); b[i] = gelu_tanh(v1[i]); }
                *(v4u*)(GG + (size_t)row * 512 + c) = pack8(a, b); EPI_LOOP_END
        } else if (pn < 29) {
            bf16* MG = (bf16*)(ws + WS_MGS);
            EPI_LOOP_BEGIN const int c = (pn - 17) * 256 + ct;
                f32x4 a, b;
#pragma unroll
                for (int i = 0; i < 4; ++i) { a[i] = sigmoidf_(v0[i]); b[i] = sigmoidf_(v1[i]); }
                *(v4u*)(MG + (size_t)row * 3072 + c) = pack8(a, b); EPI_LOOP_END
        } else {
            float* NG = (float*)(ws + WS_NG);
            EPI_LOOP_BEGIN if (ct < 24) { f32x4 a, b;
#pragma unroll
                for (int i = 0; i < 4; ++i) { a[i] = sigmoidf_(v0[i]); b[i] = sigmoidf_(v1[i]); }
                float* o = NG + (size_t)row * 24 + ct; *(f32x4*)o = a; *(f32x4*)(o + 4) = b; } EPI_LOOP_END
        }
    }
};

struct EpiLH {
    static constexpr bool PERM = true, AFTER_DRAIN = false;
    bf16* LH;
    __device__ __forceinline__ void operator()(const f32x4 (&acc)[2][2][4][2], const pg8::Unit& u, int wr, int wc, int fr0, int fq0) const {
        int fr = fr0, fq = fq0; asm volatile("" : "+v"(fr), "+v"(fq));
        EPI_LOOP_BEGIN *(v4u*)(LH + (size_t)row * 256 + ct) = pack8(v0, v1); EPI_LOOP_END
    }
};
struct CmpOrder {
    int G, c;
    __device__ bool next(int i, pg8::Unit& u) const { const int L = i * G + c; if (L >= CMP_ROWS / 256) return false; u.pm = L; u.pn = L / (CMP_ROWS_J / 256); return true; }
    __device__ __forceinline__ void a_ready(const pg8::Unit&) const {}
    __device__ __forceinline__ void done(const pg8::Unit&) const {}
};

template <int BR> struct EpiBr {
    static constexpr bool PERM = true, AFTER_DRAIN = false;
    unsigned char* ws;
    __device__ __forceinline__ void operator()(const f32x4 (&acc)[2][2][4][2], const pg8::Unit& u, int wr, int wc, int fr0, int fq0) const {
        int fr = fr0, fq = fq0; asm volatile("" : "+v"(fr), "+v"(fq));
        const bf16* MG = (const bf16*)(ws + WS_MGS); bf16* MR = (bf16*)(ws + WS_MRG);
        EPI_LOOP_BEGIN
            const int col = u.pn * 256 + ct; f32x4 g0, g1; unpack8(*(const v4u*)(MG + (size_t)row * 3072 + BR * 1024 + col), g0, g1);
            f32x4 r0 = v0 * g0, r1 = v1 * g1; bf16* o = MR + (size_t)row * DM + col;
            if (BR > 0) { f32x4 p0, p1; unpack8(*(const v4u*)o, p0, p1); r0 += p0; r1 += p1; }
            *(v4u*)o = pack8(r0, r1);
        EPI_LOOP_END
    }
};

struct EpiRes {
    static constexpr bool PERM = true, AFTER_DRAIN = false;
    const float* xin_p; const float* xin_s; float* xout; const float* mod; int gofs;
    __device__ __forceinline__ void operator()(const f32x4 (&acc)[2][2][4][2], const pg8::Unit& u, int wr, int wc, int fr0, int fq0) const {
        int fr = fr0, fq = fq0; asm volatile("" : "+v"(fr), "+v"(fq));
        EPI_LOOP_BEGIN
            const int col = u.pn * 256 + ct; const float* xi = (xin_s && row >= PM) ? xin_s + (size_t)(row - PM) * DM + col : xin_p + (size_t)row * DM + col;
            const float* g = mod + (size_t)row_bb(row) * 6144 + gofs + col; float* o = xout + (size_t)row * DM + col;
            *(f32x4*)o = *(const f32x4*)xi + *(const f32x4*)g * v0; *(f32x4*)(o + 4) = *(const f32x4*)(xi + 4) + *(const f32x4*)(g + 4) * v1;
        EPI_LOOP_END
    }
};

struct EpiUp {
    static constexpr bool PERM = true, AFTER_DRAIN = false;
    unsigned char* ws; float* out; int l;
    __device__ __forceinline__ void operator()(const f32x4 (&acc)[2][2][4][2], const pg8::Unit& u, int wr, int wc, int fr0, int fq0) const {
        int fr = fr0, fq = fq0; asm volatile("" : "+v"(fr), "+v"(fq));
        bf16* GP = (bf16*)(ws + WS_GP); bf16* VAL = GP + (size_t)MT * DFF;
        if (u.pn < 11) {
            EPI_LOOP_BEGIN const int c = u.pn * 256 + ct; *(v4u*)(GP + (size_t)row * DFF + c) = pack8(v0, v1);
                if (row < PM) { const int t = row & (PT - 1); if (t >= PT - 2) { float* q = out + OUT_FC_P + (((size_t)l * PB + (row >> 12)) * 2 + (t - (PT - 2))) * DFF + c; *(f32x4*)q = v0; *(f32x4*)(q + 4) = v1; } }
                else { const int i = (row - PM) & 7; if (i >= ST - 2) { float* q = out + OUT_FC_S + (((size_t)l * SB + ((row - PM) >> 3)) * 2 + (i - (ST - 2))) * DFF + c; *(f32x4*)q = v0; *(f32x4*)(q + 4) = v1; } }
            EPI_LOOP_END
        } else {
            EPI_LOOP_BEGIN const int c = (u.pn - 11) * 256 + ct; *(v4u*)(VAL + (size_t)row * DFF + c) = pack8(v0, v1); EPI_LOOP_END
        }
    }
};

__device__ __forceinline__ f32x16 mfma32(bf16x8 a, bf16x8 b, f32x16 c) { return __builtin_amdgcn_mfma_f32_32x32x16_bf16(a, b, c, 0, 0, 0); }
__device__ __forceinline__ f32x4 mfma16(bf16x8 a, bf16x8 b, f32x4 c) { return __builtin_amdgcn_mfma_f32_16x16x32_bf16(a, b, c, 0, 0, 0); }
__device__ __forceinline__ float ret_log_g(int h) { return log1pf(-exp2f(-5.0f - (float)h)); }
__device__ __forceinline__ bf16x8 tr_frag(const LAS unsigned char* base, int rs_bytes, int rowA, int rowB, int colbase, int lane) {
    const int q = (lane & 15) >> 2, p = lane & 3;
    const LAS unsigned char* pa = base + (rowA + q) * rs_bytes + (colbase + 4 * p) * 2;
    const LAS unsigned char* pb = base + (rowB + q) * rs_bytes + (colbase + 4 * p) * 2;
    const s16x4 a = __builtin_bit_cast(s16x4, __builtin_amdgcn_ds_read_tr16_b64_v4i16((LAS s16x4*)pa));
    const s16x4 b = __builtin_bit_cast(s16x4, __builtin_amdgcn_ds_read_tr16_b64_v4i16((LAS s16x4*)pb));
    return (bf16x8){a[0], a[1], a[2], a[3], b[0], b[1], b[2], b[3]};
}
__device__ __forceinline__ bf16x8 cvt_frag(const f32x16& p, int s2) {
    u32x4 w; w.x = pk2(p[8 * s2 + 0], p[8 * s2 + 1]); w.y = pk2(p[8 * s2 + 2], p[8 * s2 + 3]); w.z = pk2(p[8 * s2 + 4], p[8 * s2 + 5]); w.w = pk2(p[8 * s2 + 6], p[8 * s2 + 7]);
    return __builtin_bit_cast(bf16x8, w);
}

__device__ __forceinline__ void cmp2_phase(Frame& F, int l) {
    const int gw = F.bid * NWAVES + F.wave, NGW = F.G * NWAVES, lane = F.lane, r = lane & 15, g = lane >> 4;
    const bf16* LH = WSP(bf16, WS_LH); bf16* CK = WSP(bf16, WS_CK);
    for (int wu = gw; wu < CMP_ROWS / 16; wu += NGW) {
        const int row0 = wu * 16, j = row0 / CMP_ROWS_J, rj = (row0 % CMP_ROWS_J) + r, row = row0 + r;
        const bool valid = (rj < 32768) ? ((rj & 511) < 511) : (((rj - 32768) & 255) < 255);
        const bf16* W2T = WSP(bf16, WS_SMALLW + SW_W2T) + (size_t)(l * 2 + j) * 64 * 128; const float* CB = WSP(float, WS_SMALLW + SW_CB) + (l * 2 + j) * 128;
        f32x4 acc[4];
#pragma unroll
        for (int ct = 0; ct < 4; ++ct) acc[ct] = (f32x4){0.f, 0.f, 0.f, 0.f};
#pragma unroll
        for (int ks = 0; ks < 4; ++ks) {
            const int h0 = 32 * ks + 8 * g; f32x4 a0, a1, b0, b1;
            unpack8(*(const v4u*)(LH + (size_t)row * 256 + h0), a0, a1); unpack8(*(const v4u*)(LH + (size_t)(row + 1) * 256 + 128 + h0), b0, b1);
            const f32x4 c0 = *(const f32x4*)(CB + h0), c1 = *(const f32x4*)(CB + h0 + 4);
            f32x4 x0 = a0 + b0 + c0, x1 = a1 + b1 + c1;
#pragma unroll
            for (int i = 0; i < 4; ++i) { x0[i] = gelu_tanh(x0[i]); x1[i] = gelu_tanh(x1[i]); }
            const bf16x8 hf = __builtin_bit_cast(bf16x8, pack8(x0, x1));
#pragma unroll
            for (int ct = 0; ct < 4; ++ct) { const bf16x8 wf = *(const bf16x8*)(W2T + (size_t)(16 * ct + r) * 128 + h0); acc[ct] = mfma16(wf, hf, acc[ct]); }
        }
#pragma unroll
        for (int ct = 0; ct < 4; ++ct) { const f32x4 v = valid ? acc[ct] : (f32x4){0.f, 0.f, 0.f, 0.f}; v2u w; w.x = pk2(v[0], v[1]); w.y = pk2(v[2], v[3]);
            *(v2u*)(CK + (size_t)row * 64 + 16 * ct + 4 * g) = w; }
    }
}

constexpr int CG_RS = 144, CG_BUF = 256 * CG_RS, CG_AW = 2 * CG_BUF;
__device__ __forceinline__ void cmp_gemm_unit(Frame& F, int l, int pm) {
    const int tid = F.tid, lane = F.lane, w = F.wave, q = lane & 31, h_ = lane >> 5;
    const int j = pm / 136, r = pm % 136; const bool smp = r < 128;
    const int grp = smp ? (r >> 1) : (r - 128), n0 = (smp ? (r & 1) * 256 : 0) + 32 * w;
    const float* rp[8]; const bf16* ab = nullptr;
    if (smp) { const int db = grp >> 1, k = grp & 1;
#pragma unroll
        for (int i = 0; i < 8; ++i) { const int tt0 = (n0 + 4 * i + (lane >> 4)) * 16; const int page = ((const int*)F.a->in[I_PT])[db * NPG + (tt0 >> 7)];
            rp[i] = FIN(I_CACHE) + (((((size_t)l * NPHYS + page) * PAGE + (tt0 & 127)) * 4 + j) * 2 + k) * 64 + (lane & 15) * 4; } }
    else { ab = WSP(bf16, WS_ACMP) + ((size_t)(l * 2 + j) * CMP_ROWS_J + 32768 + grp * 256 + n0 + q) * 1024 + 8 * h_;
#pragma unroll
        for (int i = 0; i < 8; ++i) rp[i] = nullptr; }
    const bf16* Bg = WSP(bf16, WS_SMALLW + SW_W1T) + (size_t)(l * 2 + j) * 256 * 1024;
    f32x16 acc[8];
#pragma unroll
    for (int ct = 0; ct < 8; ++ct) acc[ct] = (f32x16){};
    const bf16* bsrc = Bg + (size_t)(tid >> 1) * 1024 + (tid & 1) * 32; LAS unsigned char* bdst = F.lds + (tid >> 1) * CG_RS + (tid & 1) * 64;
    LAS unsigned char* Aw = F.lds + CG_AW + w * 32 * CG_RS;
    v4u bst[4]; f32x4 an[8]; v4u anb[4];
    __syncthreads();
#pragma unroll
    for (int x = 0; x < 4; ++x) bst[x] = *(const v4u*)(bsrc + 8 * x);
#pragma unroll
    for (int x = 0; x < 4; ++x) *(LAS v4u*)(bdst + x * 16) = bst[x];
    if (smp) {
#pragma unroll
        for (int i = 0; i < 8; ++i) an[i] = *(const f32x4*)(rp[i]); }
    else {
#pragma unroll
        for (int ks = 0; ks < 4; ++ks) anb[ks] = *(const v4u*)(ab + ks * 16); }
    __syncthreads();
#pragma unroll 1
    for (int kc = 0; kc < 16; ++kc) {
        bf16x8 ac[4];
        if (smp) {
#pragma unroll
            for (int i = 0; i < 8; ++i) { v2u o; o.x = pk2(an[i][0], an[i][1]); o.y = pk2(an[i][2], an[i][3]); *(LAS v2u*)(Aw + (4 * i + (lane >> 4)) * CG_RS + (lane & 15) * 8) = o; }
            LDS_WAIT(); asm volatile("" ::: "memory");
#pragma unroll
            for (int ks = 0; ks < 4; ++ks) ac[ks] = *(const LAS bf16x8*)(Aw + q * CG_RS + ks * 32 + 16 * h_);
        } else {
#pragma unroll
            for (int ks = 0; ks < 4; ++ks) ac[ks] = __builtin_bit_cast(bf16x8, anb[ks]); }
        if (kc + 1 < 16) {
#pragma unroll
            for (int x = 0; x < 4; ++x) bst[x] = *(const v4u*)(bsrc + (kc + 1) * 64 + 8 * x);
            if (smp) {
#pragma unroll
                for (int i = 0; i < 8; ++i) an[i] = *(const f32x4*)(rp[i] + (size_t)(kc + 1) * 512); }
            else {
#pragma unroll
                for (int ks = 0; ks < 4; ++ks) anb[ks] = *(const v4u*)(ab + (kc + 1) * 64 + ks * 16); }
        }
        const LAS unsigned char* bb = F.lds + (kc & 1) * CG_BUF + q * CG_RS + 16 * h_;
#pragma unroll
        for (int ks = 0; ks < 4; ++ks)
#pragma unroll
            for (int ct = 0; ct < 8; ++ct) { const bf16x8 bf = *(const LAS bf16x8*)(bb + ct * 32 * CG_RS + ks * 32); acc[ct] = mfma32(bf, ac[ks], acc[ct]); }
        if (kc + 1 < 16) {
#pragma unroll
            for (int x = 0; x < 4; ++x) *(LAS v4u*)(bdst + ((kc + 1) & 1) * CG_BUF + x * 16) = bst[x]; }
        __syncthreads();
    }
    bf16* LH = WSP(bf16, WS_LH) + ((size_t)pm * 256 + 32 * w + q) * 256;
#pragma unroll
    for (int ct = 0; ct < 8; ++ct)
#pragma unroll
        for (int r4 = 0; r4 < 4; ++r4) { v2u o; o.x = pk2(acc[ct][4 * r4 + 0], acc[ct][4 * r4 + 1]); o.y = pk2(acc[ct][4 * r4 + 2], acc[ct][4 * r4 + 3]); *(v2u*)(LH + ct * 32 + 8 * r4 + 4 * h_) = o; }
}

constexpr int RS_KV = 272;
__device__ __forceinline__ void ret_local_unit(Frame& F, int unit) {
    const int bh = unit >> 5, c = unit & 31, b = bh >> 2, h = bh & 3, lane = F.lane, w = F.wave;
    const float lg = ret_log_g(h);
    LAS unsigned char* KS = F.lds; LAS unsigned char* VS = F.lds + 128 * RS_KV;
    const bf16* RK = WSP(bf16, WS_RQ) + (size_t)MT * 512; const bf16* RV = WSP(bf16, WS_RQ) + (size_t)2 * MT * 512;
    __syncthreads();
#pragma unroll
    for (int i = 0; i < 4; ++i) { const int p = F.tid + NTHR * i, j = p >> 4, ch = p & 15; const size_t go = (size_t)(b * PT + 128 * c + j) * 512 + h * 128 + ch * 8;
        f32x4 k0, k1; unpack8(*(const v4u*)(RK + go), k0, k1); const float kw = fexp((float)(127 - j) * lg);
        *(LAS v4u*)(KS + j * RS_KV + ch * 16) = pack8(k0 * kw, k1 * kw);
        *(LAS v4u*)(VS + j * RS_KV + ch * 16) = *(const v4u*)(RV + go); }
    __syncthreads();
    const int et = w >> 1, dt0 = 2 * (w & 1), h_ = lane >> 5, blk = (lane >> 4) & 1;
    f32x16 acc[2]; acc[0] = (f32x16){}; acc[1] = (f32x16){};
#pragma unroll
    for (int ks = 0; ks < 8; ++ks) {
        const int rA = 16 * ks + 8 * h_;
        const bf16x8 af = tr_frag(VS, RS_KV, rA, rA + 4, 32 * et + 16 * blk, lane);
#pragma unroll
        for (int dd = 0; dd < 2; ++dd) { const bf16x8 bfr = tr_frag(KS, RS_KV, rA, rA + 4, 32 * (dt0 + dd) + 16 * blk, lane); acc[dd] = mfma32(af, bfr, acc[dd]); }
    }
    float* LT = WSP(float, WS_LT) + ((size_t)bh * 32 + c) * 16384;
#pragma unroll
    for (int dd = 0; dd < 2; ++dd)
#pragma unroll
        for (int r = 0; r < 16; ++r) { const int e = 32 * et + (r & 3) + 8 * (r >> 2) + 4 * h_; LT[e * 128 + 32 * (dt0 + dd) + (lane & 31)] = acc[dd][r]; }
}
__device__ __forceinline__ void ret_scan_phase(Frame& F, int l) {
    const float* LT = WSP(float, WS_LT); bf16* SPT = WSP(bf16, WS_SPT);
    for (int idx = F.bid * NTHR + F.tid; idx < 16 * 16384; idx += F.G * NTHR) {
        const int bh = idx >> 14, ed = idx & 16383, e = ed >> 7, d = ed & 127, h = bh & 3; const float g128 = fexp(128.0f * ret_log_g(h));
        float S = 0.f;
        for (int c = 0; c < 32; ++c) { const size_t o = ((size_t)bh * 32 + c) * 16384 + ed; SPT[o] = (bf16)(pk2(S, 0.f) & 0xffffu); S = S * g128 + LT[o]; }
        F.out[OUT_RET_P + ((size_t)l * 16 + bh) * 16384 + d * 128 + e] = S;
    }
}
__device__ __forceinline__ void ret_out_unit(Frame& F, int l, int unit) {
    const int bh = unit >> 5, c = unit & 31, b = bh >> 2, h = bh & 3, lane = F.lane, w = F.wave, tid = F.tid;
    const float lg = ret_log_g(h);
    LAS unsigned char* KS = F.lds; LAS unsigned char* VS = F.lds + 128 * RS_KV; LAS float* OT = (LAS float*)F.lds; LAS float* STAT = (LAS float*)(F.lds + 2 * 128 * RS_KV);
    const bf16* RQ = WSP(bf16, WS_RQ); const bf16* RK = RQ + (size_t)MT * 512; const bf16* RV = RQ + (size_t)2 * MT * 512; const bf16* RG = RQ + (size_t)3 * MT * 512;
    const size_t row0 = (size_t)b * PT + 128 * c;
    __syncthreads();
#pragma unroll
    for (int i = 0; i < 4; ++i) { const int p = tid + NTHR * i, j = p >> 4, ch = p & 15; const size_t go = (row0 + j) * 512 + h * 128 + ch * 8;
        *(LAS v4u*)(KS + j * RS_KV + ch * 16) = *(const v4u*)(RK + go); *(LAS v4u*)(VS + j * RS_KV + ch * 16) = *(const v4u*)(RV + go); }
    const int it = w & 3, eh = w >> 2, h_ = lane >> 5, blk = (lane >> 4) & 1, il = 32 * it + (lane & 31);
    bf16x8 qf[8];
#pragma unroll
    for (int ks = 0; ks < 8; ++ks) qf[ks] = *(const bf16x8*)(RQ + (row0 + il) * 512 + h * 128 + 16 * ks + 8 * h_);
    f32x16 acc[2]; acc[0] = (f32x16){}; acc[1] = (f32x16){};
    const bf16* SP = WSP(bf16, WS_SPT) + ((size_t)bh * 32 + c) * 16384;
#pragma unroll
    for (int ks = 0; ks < 8; ++ks)
#pragma unroll
        for (int e2 = 0; e2 < 2; ++e2) { const bf16x8 af = *(const bf16x8*)(SP + (size_t)(32 * (2 * eh + e2) + (lane & 31)) * 128 + 16 * ks + 8 * h_); acc[e2] = mfma32(af, qf[ks], acc[e2]); }
    { const float cr = fexp((float)(il + 1) * lg); acc[0] *= cr; acc[1] *= cr; }
    __syncthreads();
    for (int jt = 0; jt <= it; ++jt) {
        f32x16 s = (f32x16){};
#pragma unroll
        for (int ks = 0; ks < 8; ++ks) { const bf16x8 kf = *(const LAS bf16x8*)(KS + (32 * jt + (lane & 31)) * RS_KV + (16 * ks + 8 * h_) * 2); s = mfma32(kf, qf[ks], s); }
#pragma unroll
        for (int r = 0; r < 16; ++r) { const int j = 32 * jt + (r & 3) + 8 * (r >> 2) + 4 * h_; const int df = il - j; s[r] = (df >= 0) ? s[r] * fexp((float)df * lg) : 0.f; }
#pragma unroll
        for (int s2 = 0; s2 < 2; ++s2) { const bf16x8 pf = cvt_frag(s, s2); const int rA = 32 * jt + 16 * s2 + 4 * h_;
#pragma unroll
            for (int e2 = 0; e2 < 2; ++e2) { const bf16x8 vf = tr_frag(VS, RS_KV, rA, rA + 8, 32 * (2 * eh + e2) + 16 * blk, lane); acc[e2] = mfma32(vf, pf, acc[e2]); } }
    }
    float s1 = 0.f, s2 = 0.f;
#pragma unroll
    for (int e2 = 0; e2 < 2; ++e2)
#pragma unroll
        for (int r = 0; r < 16; ++r) { const float v = acc[e2][r]; s1 += v; s2 += v * v; }
    s1 += __shfl_xor(s1, 32); s2 += __shfl_xor(s2, 32);
    if (lane < 32) { STAT[(w * 32 + lane) * 2] = s1; STAT[(w * 32 + lane) * 2 + 1] = s2; }
    __syncthreads();
    { const int pw = w ^ 4; s1 += STAT[(pw * 32 + (lane & 31)) * 2]; s2 += STAT[(pw * 32 + (lane & 31)) * 2 + 1]; }
    const float mean = s1 * (1.0f / 128.0f), var = fmaxf(s2 * (1.0f / 128.0f) - mean * mean, 0.f), rstd = 1.0f / sqrtf(var + EPS);
#pragma unroll
    for (int e2 = 0; e2 < 2; ++e2)
#pragma unroll
        for (int r4 = 0; r4 < 4; ++r4) { const int e = 32 * (2 * eh + e2) + 8 * r4 + 4 * h_;
            f32x4 v; v[0] = (acc[e2][4 * r4 + 0] - mean) * rstd; v[1] = (acc[e2][4 * r4 + 1] - mean) * rstd; v[2] = (acc[e2][4 * r4 + 2] - mean) * rstd; v[3] = (acc[e2][4 * r4 + 3] - mean) * rstd;
            *(LAS f32x4*)(OT + il * 132 + e) = v; }
    __syncthreads();
    const float* GN = FIN(I_GNG) + l * 512 + h * 128; bf16* OR_ = WSP(bf16, WS_OA) + (size_t)MT * 512;
#pragma unroll
    for (int k = 0; k < 4; ++k) { const int q = tid + NTHR * k, i = q >> 4, ch = q & 15;
        const f32x4 o0 = *(const LAS f32x4*)(OT + i * 132 + 8 * ch), o1 = *(const LAS f32x4*)(OT + i * 132 + 8 * ch + 4);
        const f32x4 g0 = *(const f32x4*)(GN + 8 * ch), g1 = *(const f32x4*)(GN + 8 * ch + 4); f32x4 r0, r1; unpack8(*(const v4u*)(RG + (row0 + i) * 512 + h * 128 + 8 * ch), r0, r1);
        f32x4 y0, y1;
#pragma unroll
        for (int x = 0; x < 4; ++x) { y0[x] = o0[x] * g0[x] * siluf_(r0[x]); y1[x] = o1[x] * g1[x] * siluf_(r1[x]); }
        *(v4u*)(OR_ + (row0 + i) * 512 + h * 128 + 8 * ch) = pack8(y0, y1); }
}
__device__ __forceinline__ void ret_sample_unit(Frame& F, int l, int unit) {
    const int db = unit >> 2, h = unit & 3, tid = F.tid, e = tid & 127, dp = tid >> 7;
    const float lg = ret_log_g(h);
    LAS float* Q = (LAS float*)F.lds; LAS float* K = Q + 1024; LAS float* V = K + 1024; LAS float* GT = V + 1024; LAS float* CR = GT + 1024;
    LAS float* SC = CR + 4096; LAS float* RED = SC + 64;
    const bf16* RQ = WSP(bf16, WS_RQ); const size_t row0 = (size_t)PM + db * 8;
    __syncthreads();
    for (int i = tid; i < 4096; i += NTHR) { const int which = i >> 10, r = (i >> 7) & 7, d = i & 127; const float v = bf1(RQ[(size_t)which * MT * 512 + (row0 + r) * 512 + h * 128 + d]); Q[which * 1024 + r * 128 + d] = v; }
    __syncthreads();
    const float* S0 = FIN(I_SRET) + (((size_t)l * SB + db) * 4 + h) * 16384; float* SN = F.out + OUT_RET_S + (((size_t)l * SB + db) * 4 + h) * 16384;
    float kwv[8], cr[8];
#pragma unroll
    for (int j = 0; j < 8; ++j) { kwv[j] = V[j * 128 + e] * fexp((float)(7 - j) * lg); cr[j] = 0.f; }
    const float g8 = fexp(8.0f * lg);
    for (int d = dp * 32; d < dp * 32 + 32; ++d) {
        const float s0 = S0[d * 128 + e]; float sn = g8 * s0;
#pragma unroll
        for (int j = 0; j < 8; ++j) { cr[j] += Q[j * 128 + d] * s0; sn += K[j * 128 + d] * kwv[j]; }
        SN[d * 128 + e] = sn;
    }
#pragma unroll
    for (int i = 0; i < 8; ++i) CR[(dp * 8 + i) * 128 + e] = cr[i];
    if (tid < 64) { const int i = tid >> 3, j = tid & 7; float s = 0.f; if (j <= i) { for (int d = 0; d < 128; ++d) s += Q[i * 128 + d] * K[j * 128 + d]; s *= fexp((float)(i - j) * lg); } SC[tid] = s; }
    __syncthreads();
    float o[2];
#pragma unroll
    for (int ii = 0; ii < 2; ++ii) { const int i = 2 * dp + ii; float x = (CR[(0 * 8 + i) * 128 + e] + CR[(1 * 8 + i) * 128 + e] + CR[(2 * 8 + i) * 128 + e] + CR[(3 * 8 + i) * 128 + e]) * fexp((float)(i + 1) * lg);
        for (int j = 0; j <= i; ++j) x += SC[i * 8 + j] * V[j * 128 + e];
        o[ii] = x; }
#pragma unroll
    for (int ii = 0; ii < 2; ++ii) { const float a = wave_sum(o[ii]), q = wave_sum(o[ii] * o[ii]); if (F.lane == 0) { RED[(F.wave * 2 + ii) * 2] = a; RED[(F.wave * 2 + ii) * 2 + 1] = q; } }
    __syncthreads();
    const float* GN = FIN(I_GNG) + l * 512 + h * 128; bf16* OR_ = WSP(bf16, WS_OA) + (size_t)MT * 512;
#pragma unroll
    for (int ii = 0; ii < 2; ++ii) { const int i = 2 * dp + ii, w0 = 2 * dp; const float s1 = RED[(w0 * 2 + ii) * 2] + RED[((w0 + 1) * 2 + ii) * 2], s2 = RED[(w0 * 2 + ii) * 2 + 1] + RED[((w0 + 1) * 2 + ii) * 2 + 1];
        const float mean = s1 * (1.0f / 128.0f), var = fmaxf(s2 * (1.0f / 128.0f) - mean * mean, 0.f), rstd = 1.0f / sqrtf(var + EPS);
        const float y = (o[ii] - mean) * rstd * GN[e] * siluf_(GT[i * 128 + e]);
        OR_[(row0 + i) * 512 + h * 128 + e] = (bf16)(pk2(y, 0.f) & 0xffffu); }
}

template <int MODE> __device__ __forceinline__ void rglru_unit(Frame& F, int l, int unit) {
    const int tid = F.tid, c = tid, lane = F.lane, w = F.wave;
    LAS bf16* XC = (LAS bf16*)F.lds; LAS float* G = (LAS float*)(F.lds + 16384);
    const int seq = (MODE == 2) ? unit : (unit >> 6), tile = (MODE == 2) ? 0 : (unit & 63);
    const size_t row0 = (MODE == 2) ? (size_t)PM + seq * 8 : (size_t)seq * PT + tile * 64;
    const int ntok = (MODE == 2) ? 8 : 64, nsub = (MODE == 2) ? 1 : 4;
    const float* RX = WSP(float, WS_RX);
    const float w0 = FIN(I_RCW)[(l * 4 + 0) * 512 + c], w1 = FIN(I_RCW)[(l * 4 + 1) * 512 + c], w2 = FIN(I_RCW)[(l * 4 + 2) * 512 + c], w3 = FIN(I_RCW)[(l * 4 + 3) * 512 + c], cb = FIN(I_RCB)[l * 512 + c];
    const float ba = FIN(I_RBA)[l * 512 + c], bx = FIN(I_RBX)[l * 512 + c], sp = WSP(float, WS_SMALLW + SW_SP)[l * 512 + c];
    float x3, x2, x1;
    if (MODE == 2) { const float* cv = FIN(I_SCONV) + ((size_t)l * SB + seq) * 3 * 512; x3 = cv[c]; x2 = cv[512 + c]; x1 = cv[1024 + c]; }
    else if (tile == 0) { x3 = 0.f; x2 = 0.f; x1 = 0.f; }
    else { x3 = RX[(row0 - 3) * 512 + c]; x2 = RX[(row0 - 2) * 512 + c]; x1 = RX[(row0 - 1) * 512 + c]; }
    float h = (MODE == 0) ? 0.f : (MODE == 1) ? WSP(float, WS_CAR)[(size_t)4 * 64 * 2 * 512 + ((size_t)seq * 64 + tile) * 512 + c] : FIN(I_SH)[((size_t)l * SB + seq) * 512 + c];
    float aprod = 1.f;
    const int r16 = lane & 15, g4 = lane >> 4;
    bf16x8 wa[4][2], wx[4][2];
    { const bf16* WA = WSP(bf16, WS_SMALLW + SW_WAT) + ((size_t)(l * 2 + 0) * 8 + w) * 4096; const bf16* WX = WSP(bf16, WS_SMALLW + SW_WAT) + ((size_t)(l * 2 + 1) * 8 + w) * 4096;
#pragma unroll
      for (int ct = 0; ct < 4; ++ct)
#pragma unroll
          for (int ks = 0; ks < 2; ++ks) { wa[ct][ks] = *(const bf16x8*)(WA + (16 * ct + r16) * 64 + 32 * ks + 8 * g4); wx[ct][ks] = *(const bf16x8*)(WX + (16 * ct + r16) * 64 + 32 * ks + 8 * g4); } }
    const bf16* GG = WSP(bf16, WS_GG); bf16* OC = WSP(bf16, WS_OA) + (size_t)2 * MT * 512;
    __syncthreads();
    for (int s = 0; s < nsub; ++s) {
        float xc[16], gg[16];
#pragma unroll
        for (int tt = 0; tt < 16; ++tt) { const int t = s * 16 + tt; xc[tt] = (t < ntok) ? RX[(row0 + t) * 512 + c] : 0.f; gg[tt] = (MODE != 0 && t < ntok) ? bf1(GG[(row0 + t) * 512 + c]) : 0.f; }
#pragma unroll
        for (int tt = 0; tt < 16; ++tt) { const float x0 = xc[tt];
            xc[tt] = cb + w0 * x3 + w1 * x2 + w2 * x1 + w3 * x0; x3 = x2; x2 = x1; x1 = x0; XC[tt * 512 + c] = (bf16)(pk2(xc[tt], 0.f) & 0xffffu); }
        __syncthreads();
        {
            bf16x8 xf[2];
#pragma unroll
            for (int ks = 0; ks < 2; ++ks) xf[ks] = *(const LAS bf16x8*)(XC + r16 * 512 + w * 64 + 32 * ks + 8 * g4);
#pragma unroll
            for (int ct = 0; ct < 4; ++ct) { f32x4 da = (f32x4){0.f, 0.f, 0.f, 0.f}, dx = da;
#pragma unroll
                for (int ks = 0; ks < 2; ++ks) { da = mfma16(wa[ct][ks], xf[ks], da); dx = mfma16(wx[ct][ks], xf[ks], dx); }
                *(LAS f32x4*)(G + r16 * 512 + w * 64 + 16 * ct + 4 * g4) = da; *(LAS f32x4*)(G + 8192 + r16 * 512 + w * 64 + 16 * ct + 4 * g4) = dx; }
        }
        __syncthreads();
#pragma unroll
        for (int tt = 0; tt < 16; ++tt) { const int t = s * 16 + tt;
            if (t < ntok) {
                const float r = sigmoidf_(G[tt * 512 + c] + ba), ig = sigmoidf_(G[8192 + tt * 512 + c] + bx);
                const float la = -8.0f * r * sp, a = fexp(la), bt = sqrtf(fmaxf(1.0f - a * a, 0.f)) * (ig * xc[tt]);
                h = a * h + bt; aprod *= a;
                if (MODE != 0) { const size_t o = (row0 + t) * 512 + c; OC[o] = (bf16)(pk2(h * gg[tt], 0.f) & 0xffffu); }
            } }
    }
    if (MODE == 0) { float* CAR = WSP(float, WS_CAR) + ((size_t)seq * 64 + tile) * 1024; CAR[c] = aprod; CAR[512 + c] = h; }
    if (MODE == 2) F.out[OUT_H_S + ((size_t)l * SB + seq) * 512 + c] = h;
}
__device__ __forceinline__ void rglru_carry_phase(Frame& F, int l) {
    const float* CAR = WSP(float, WS_CAR); float* HIN = WSP(float, WS_CAR) + (size_t)4 * 64 * 2 * 512;
    for (int idx = F.bid * NTHR + F.tid; idx < PB * 512; idx += F.G * NTHR) {
        const int b = idx >> 9, c = idx & 511; float h = 0.f;
        for (int t = 0; t < 64; ++t) { HIN[((size_t)b * 64 + t) * 512 + c] = h; const float* cr = CAR + ((size_t)b * 64 + t) * 1024; h = cr[c] * h + cr[512 + c]; }
        F.out[OUT_H_P + ((size_t)l * PB + b) * 512 + c] = h;
    }
}

__device__ __forceinline__ void convact_phase(Frame& F, int l) {
    const bf16* GP = WSP(bf16, WS_GP); const bf16* VAL = GP + (size_t)MT * DFF; bf16* ACT = WSP(bf16, WS_GP) + (size_t)2 * MT * DFF;
    const float* CW = FIN(I_FCW) + (size_t)l * 3 * DFF; const float* CBI = FIN(I_FCB) + (size_t)l * DFF;
    constexpr int NRUN = PM / 16 + SB, NCG = DFF / 8;
    for (int it = F.bid * NTHR + F.tid; it < NRUN * NCG; it += F.G * NTHR) {
        const int run = it / NCG, cg = it % NCG, c = cg * 8;
        const bool isp = run < PM / 16; const size_t row0 = isp ? (size_t)run * 16 : (size_t)PM + (run - PM / 16) * 8; const int nt = isp ? 16 : 8;
        f32x4 p2a, p2b, p1a, p1b;
        if (isp) { if ((run & 255) == 0) { p2a = p2b = p1a = p1b = (f32x4){0.f, 0.f, 0.f, 0.f}; } else { unpack8(*(const v4u*)(GP + (row0 - 2) * DFF + c), p2a, p2b); unpack8(*(const v4u*)(GP + (row0 - 1) * DFF + c), p1a, p1b); } }
        else { const float* st = FIN(I_SFFN) + (((size_t)l * SB + (run - PM / 16)) * 2) * DFF + c; p2a = *(const f32x4*)st; p2b = *(const f32x4*)(st + 4); p1a = *(const f32x4*)(st + DFF); p1b = *(const f32x4*)(st + DFF + 4); }
        const f32x4 w0a = *(const f32x4*)(CW + c), w0b = *(const f32x4*)(CW + c + 4), w1a = *(const f32x4*)(CW + DFF + c), w1b = *(const f32x4*)(CW + DFF + c + 4), w2a = *(const f32x4*)(CW + 2 * DFF + c), w2b = *(const f32x4*)(CW + 2 * DFF + c + 4);
        const f32x4 ba = *(const f32x4*)(CBI + c), bb = *(const f32x4*)(CBI + c + 4);
        for (int t0 = 0; t0 < nt; t0 += 8) {
            v4u gx[8], vx[8];
#pragma unroll
            for (int k = 0; k < 8; ++k) { gx[k] = *(const v4u*)(GP + (row0 + t0 + k) * DFF + c); vx[k] = *(const v4u*)(VAL + (row0 + t0 + k) * DFF + c); }
#pragma unroll
            for (int k = 0; k < 8; ++k) {
                f32x4 xa, xb, va, vb; unpack8(gx[k], xa, xb); unpack8(vx[k], va, vb);
                f32x4 ya = ba + w0a * p2a + w1a * p1a + w2a * xa, yb = bb + w0b * p2b + w1b * p1b + w2b * xb;
#pragma unroll
                for (int i = 0; i < 4; ++i) { ya[i] = siluf_(ya[i]) * va[i]; yb[i] = siluf_(yb[i]) * vb[i]; }
                *(v4u*)(ACT + (row0 + t0 + k) * DFF + c) = pack8(ya, yb);
                p2a = p1a; p2b = p1b; p1a = xa; p1b = xb;
            }
        }
    }
}

constexpr int AT_RS = 144;
constexpr int AT_K0 = 0, AT_V0 = 2 * 64 * AT_RS, AT_PS = 4 * 64 * AT_RS, AT_IMP = AT_PS + 69632, AT_MASK = AT_IMP + 6144, AT_LIST = AT_MASK + 2048, AT_NL = AT_LIST + 1024;
constexpr unsigned AT_MARK = 0xFFFFu;
static_assert(AT_NL + 64 <= RING_BYTES, "attention LDS map");

struct TileRegs { v4u a, b, c, d; int mode; };

template <bool SMP> __device__ __forceinline__ void at_prefetch(const Frame& F, int l, int seq, int kvh, unsigned e, TileRegs& R) {
    const int kind = (int)(e >> 14), ti = (int)(e & 0x3fffu), rr = F.tid >> 3, pc = F.tid & 7;
    R.mode = 0;
    if (kind < 2) {
        const size_t rb = SMP ? (size_t)(seq * 2 + kvh) * 512 : (size_t)32768 + (size_t)(seq * 2 + kvh) * 256;
        const bf16* ck = WSP(bf16, WS_CK) + (rb + ti * 64 + rr) * 64 + pc * 8;
        R.a = *(const v4u*)ck; R.c = *(const v4u*)(ck + (size_t)CMP_ROWS_J * 64);
    } else if (!SMP) {
        const int jb = (kind == 2) ? 0 : 2;
        const bf16* kp = WSP(bf16, WS_KVB) + ((((size_t)jb * PB + seq) * 2 + kvh) * PT + ti * 64 + rr) * 64 + pc * 8;
        R.a = *(const v4u*)kp; R.c = *(const v4u*)(kp + (size_t)PB * 2 * PT * 64);
    } else if (kind == 2) {
        if (ti < 128) {
            const int page = ((const int*)F.a->in[I_PT])[seq * NPG + (ti >> 1)], slot = (ti & 1) * 64 + rr;
            const float* kp = FIN(I_CACHE) + (((((size_t)l * NPHYS + page) * PAGE + slot) * 4 + 2) * 2 + kvh) * 64 + pc * 8;
            R.a = *(const v4u*)kp; R.b = *(const v4u*)(kp + 4); R.c = *(const v4u*)(kp + 128); R.d = *(const v4u*)(kp + 132); R.mode = 1;
        } else if (rr < ST) {
            const bf16* kp = WSP(bf16, WS_KVS) + ((((size_t)0 * SB + seq) * 2 + kvh) * ST + rr) * 64 + pc * 8;
            R.a = *(const v4u*)kp; R.c = *(const v4u*)(kp + (size_t)SB * 2 * ST * 64);
        } else R.mode = 2;
    } else {
        if (ti < 8) {
            const float* kp = FIN(I_CWIN) + (((((size_t)l * SB + seq) * WINB + ti * 64 + rr) * 2 + 0) * 2 + kvh) * 64 + pc * 8;
            R.a = *(const v4u*)kp; R.b = *(const v4u*)(kp + 4); R.c = *(const v4u*)(kp + 128); R.d = *(const v4u*)(kp + 132); R.mode = 1;
        } else if (rr < ST) {
            const bf16* kp = WSP(bf16, WS_KVS) + ((((size_t)2 * SB + seq) * 2 + kvh) * ST + rr) * 64 + pc * 8;
            R.a = *(const v4u*)kp; R.c = *(const v4u*)(kp + (size_t)SB * 2 * ST * 64);
        } else R.mode = 2;
    }
}
__device__ __forceinline__ void at_store(const Frame& F, int buf, const TileRegs& R) {
    const int rr = F.tid >> 3, pc = F.tid & 7; v4u k, v;
    if (R.mode == 0) { k = R.a; v = R.c; }
    else if (R.mode == 1) { k = pack8(__builtin_bit_cast(f32x4, R.a), __builtin_bit_cast(f32x4, R.b)); v = pack8(__builtin_bit_cast(f32x4, R.c), __builtin_bit_cast(f32x4, R.d)); }
    else { k = (v4u){0u, 0u, 0u, 0u}; v = k; }
    *(LAS v4u*)(F.lds + AT_K0 + buf * 64 * AT_RS + rr * AT_RS + pc * 16) = k;
    *(LAS v4u*)(F.lds + AT_V0 + buf * 64 * AT_RS + rr * AT_RS + pc * 16) = v;
}

template <bool SMP> __device__ __forceinline__ void attn_unit(Frame& F, int l, int unit) {
    const int tid = F.tid, lane = F.lane, w = F.wave;
    const int q = lane & 31, h_ = lane >> 5, blk = (lane >> 4) & 1, tl = q >> 2, hr = q & 3;
    int seq, kvh, qt;
    if (SMP) { seq = unit >> 1; kvh = unit & 1; qt = 128; } else { seq = unit >> 7; kvh = (unit >> 6) & 1; qt = unit & 63; }
    const int t0 = SMP ? PAST : qt * 64;
    const int tokl = SMP ? tl : 8 * w + tl, t = t0 + tokl;
    const size_t row = SMP ? (size_t)PM + seq * ST + tl : (size_t)seq * PT + t;
    const int head = kvh * 4 + hr;
    LAS float* PS = (LAS float*)(F.lds + AT_PS); LAS float* IMPw = (LAS float*)(F.lds + AT_IMP) + w * 192;
    LAS unsigned long long* MASKS = (LAS unsigned long long*)(F.lds + AT_MASK); LAS unsigned short* LIST = (LAS unsigned short*)(F.lds + AT_LIST); LAS int* NL = (LAS int*)(F.lds + AT_NL);
    constexpr int PSS = SMP ? 520 : 264;
    LAS float* PSw = SMP ? PS : PS + w * 8 * PSS;
    __syncthreads();
    bf16x8 qf[4];
    { const bf16* qp = WSP(bf16, WS_QN) + row * 512 + head * 64 + 8 * h_;
#pragma unroll
      for (int kk = 0; kk < 4; ++kk) qf[kk] = *(const bf16x8*)(qp + 16 * kk); }
    const float* ngp = WSP(float, WS_NG) + row * 24 + head * 3; const float g0 = ngp[0], g1 = ngp[1], g2 = ngp[2];
    if (!SMP) { for (int i = lane; i < 8 * PSS; i += 64) PSw[i] = 0.f; }
    const int ntc = SMP ? 8 : ((t0 + 32) >> 10) + 1;
    if (tid < 2 * ntc) LIST[tid] = (unsigned short)(((tid >= ntc ? 1u : 0u) << 14) | (unsigned)(tid >= ntc ? tid - ntc : tid));
    if (tid == 0) LIST[2 * ntc] = (unsigned short)AT_MARK;
    int nl = 2 * ntc + 1;
    TileRegs R;
    at_prefetch<SMP>(F, l, seq, kvh, (unsigned)0, R);
    at_store(F, 0, R);
    __syncthreads();
    float m = -INFINITY, lsum = 0.f, invden = 0.f;
    f32x16 O[2]; O[0] = (f32x16){}; O[1] = (f32x16){};
    LAS float* OAw = (LAS float*)(F.lds + AT_PS) + w * (SMP ? 2048 : 8 * PSS) + lane;
    unsigned long long mk0 = 0ull, mk1 = 0ull, wu = ~0ull;
    int cur_kind = -1, idx = 0;
#define AT_FINALIZE(kind) do { \
        if ((kind) == 0) { const float lt = lsum + __shfl_xor(lsum, 32); invden = lt > 0.f ? 1.0f / lt : 0.f; } \
        else if ((kind) == 1) { const float sc = g0 * invden; O[0] *= sc; O[1] *= sc; } \
        else if ((kind) == 2) { const float lt = lsum + __shfl_xor(lsum, 32); const float sc = (lt > 0.f ? 1.0f / lt : 0.f) * g1; \
            _Pragma("unroll") for (int r_ = 0; r_ < 16; ++r_) { OAw[r_ * 64] += O[0][r_] * sc; OAw[(16 + r_) * 64] += O[1][r_] * sc; } } } while (0)
    while (idx < nl) {
        const unsigned e = (unsigned)__builtin_amdgcn_readfirstlane((int)LIST[idx]);
        if (e == AT_MARK) {
            AT_FINALIZE(cur_kind); cur_kind = -1;
            LDS_WAIT(); asm volatile("" ::: "memory");
#pragma unroll 1
            for (int tk = 0; tk < 8; ++tk) {
                const LAS float* pr = PSw + tk * PSS;
                if (!SMP) {
                    const int s = lane; float imp = 0.f;
#pragma unroll
                    for (int n = 4 * s - 1; n <= 4 * s + 3; ++n) if (n >= 0) imp += pr[n];
                    const bool forced = (s == 0) || (s == qt) || (s == qt - 1), avail = s <= qt;
                    const float val = avail ? (forced ? 1e4f : imp) : -1e4f;
                    IMPw[s] = val; LDS_WAIT(); asm volatile("" ::: "memory");
                    int rank = 0;
#pragma unroll 8
                    for (int i = 0; i < 64; ++i) { const float v = IMPw[i]; rank += (v > val || (v == val && i < s)) ? 1 : 0; }
                    const unsigned long long mk = __ballot(rank < 16);
                    if (lane == 0) MASKS[(8 * w + tk) * 4] = mk;
                    LDS_WAIT(); asm volatile("" ::: "memory");
                } else {
                    const int sa = lane, sb = lane + 64; float ia = 0.f, ib = 0.f;
#pragma unroll
                    for (int n = 4 * sa - 1; n <= 4 * sa + 3; ++n) if (n >= 0) ia += pr[n];
#pragma unroll
                    for (int n = 4 * sb - 1; n <= 4 * sb + 3; ++n) ib += pr[n];
                    const bool fa = (sa == 0), fb = (sb == 127);
                    const float va = fa ? 1e4f : ia, vb = fb ? 1e4f : ib;
                    IMPw[sa] = va; IMPw[sb] = vb; LDS_WAIT(); asm volatile("" ::: "memory");
                    int ra = fa ? 0 : 1, rb = fb ? 0 : 1;
#pragma unroll 8
                    for (int i = 0; i < 128; ++i) { const float v = IMPw[i]; ra += (v > va || (v == va && i < sa)) ? 1 : 0; rb += (v > vb || (v == vb && i < sb)) ? 1 : 0; }
                    const unsigned long long ma = __ballot(ra < 16), mb = __ballot(rb < 16);
                    if (lane == 0) { MASKS[tk * 4] = ma; MASKS[tk * 4 + 1] = mb; MASKS[tk * 4 + 2] = 1ull; }
                    LDS_WAIT(); asm volatile("" ::: "memory");
                }
            }
            __syncthreads();
#pragma unroll
            for (int r_ = 0; r_ < 16; ++r_) { OAw[r_ * 64] = O[0][r_]; OAw[(16 + r_) * 64] = O[1][r_]; }
            if (tid == 0) {
                int n = idx + 1;
                if (!SMP) { unsigned long long U = 0ull; for (int i = 0; i < 64; ++i) U |= MASKS[i * 4];
                    for (int s = 0; s <= qt; ++s) if ((U >> s) & 1ull) LIST[n++] = (unsigned short)((2u << 14) | (unsigned)s);
                    for (int s = (qt > 8 ? qt - 8 : 0); s <= qt; ++s) LIST[n++] = (unsigned short)((3u << 14) | (unsigned)s);
                } else { unsigned long long U0 = 0ull, U1 = 0ull; for (int i = 0; i < 8; ++i) { U0 |= MASKS[i * 4]; U1 |= MASKS[i * 4 + 1]; }
                    for (int s = 0; s < 64; ++s) if ((U0 >> s) & 1ull) LIST[n++] = (unsigned short)((2u << 14) | (unsigned)s);
                    for (int s = 0; s < 64; ++s) if ((U1 >> s) & 1ull) LIST[n++] = (unsigned short)((2u << 14) | (unsigned)(64 + s));
                    LIST[n++] = (unsigned short)((2u << 14) | 128u);
                    for (int s = 0; s <= 8; ++s) LIST[n++] = (unsigned short)((3u << 14) | (unsigned)s); }
                NL[0] = n;
            }
            __syncthreads();
            nl = __builtin_amdgcn_readfirstlane(NL[0]);
            mk0 = MASKS[tokl * 4]; if (SMP) { mk1 = MASKS[tokl * 4 + 1]; }
            if (!SMP) { unsigned long long u = 0ull; for (int i = 0; i < 8; ++i) u |= MASKS[(8 * w + i) * 4]; wu = u; }
            if (idx + 1 < nl) { at_prefetch<SMP>(F, l, seq, kvh, (unsigned)LIST[idx + 1], R); at_store(F, (idx + 1) & 1, R); }
            __syncthreads();
            ++idx; continue;
        }
        const int kind = (int)(e >> 14), ti = (int)(e & 0x3fffu);
        if (kind != cur_kind) {
            if (cur_kind >= 0) AT_FINALIZE(cur_kind);
            if (kind != 1) m = -INFINITY;
            lsum = 0.f; O[0] = (f32x16){}; O[1] = (f32x16){}; cur_kind = kind;
        }
        const unsigned en = (idx + 1 < nl) ? (unsigned)__builtin_amdgcn_readfirstlane((int)LIST[idx + 1]) : AT_MARK;
        const bool have_next = (en != AT_MARK);
        if (have_next) at_prefetch<SMP>(F, l, seq, kvh, en, R);
        bool active = true;
        if (!SMP && kind == 2) active = ((wu >> ti) & 1ull) != 0ull;
        if (active) {
            const LAS unsigned char* Kb = F.lds + AT_K0 + (idx & 1) * 64 * AT_RS; const LAS unsigned char* Vb = F.lds + AT_V0 + (idx & 1) * 64 * AT_RS;
            int lo, hi; const int kb = 64 * ti;
            if (kind < 2) { lo = 0; hi = SMP ? 510 : ((t >= 31) ? ((t - 31) >> 4) : -1); }
            else if (kind == 2) { lo = 0; const unsigned long long mw = (ti < 64) ? mk0 : ((ti < 128) ? mk1 : 1ull); hi = ((mw >> (ti & 63)) & 1ull) ? t : -1; }
            else { if (SMP) { lo = tl; hi = WINB + tl; } else { lo = t - WINB; hi = t; } }
            f32x16 s0 = (f32x16){}, s1 = (f32x16){};
#pragma unroll
            for (int kk = 0; kk < 4; ++kk) {
                const bf16x8 k0 = *(const LAS bf16x8*)(Kb + q * AT_RS + (16 * kk + 8 * h_) * 2), k1 = *(const LAS bf16x8*)(Kb + (32 + q) * AT_RS + (16 * kk + 8 * h_) * 2);
                s0 = mfma32(k0, qf[kk], s0); s1 = mfma32(k1, qf[kk], s1);
            }
            float tmax = -INFINITY;
#pragma unroll
            for (int r = 0; r < 16; ++r) { const int key = kb + (r & 3) + 8 * (r >> 2) + 4 * h_;
                s0[r] = (key >= lo && key <= hi) ? s0[r] : -INFINITY; s1[r] = (key + 32 >= lo && key + 32 <= hi) ? s1[r] : -INFINITY;
                tmax = fmaxf(tmax, fmaxf(s0[r], s1[r])); }
            tmax = fmaxf(tmax, __shfl_xor(tmax, 32));
            const float m_new = fmaxf(m, tmax), m_use = (m_new == -INFINITY) ? 0.f : m_new;
            const float alpha = fexp2(m - m_use);
            float ps = 0.f;
#pragma unroll
            for (int r = 0; r < 16; ++r) { s0[r] = fexp2(s0[r] - m_use); s1[r] = fexp2(s1[r] - m_use); ps += s0[r] + s1[r]; }
            lsum = lsum * alpha + ps; m = m_new;
            if (kind != 0) {
                O[0] *= alpha; O[1] *= alpha;
#pragma unroll
                for (int kt2 = 0; kt2 < 2; ++kt2)
#pragma unroll
                    for (int s2 = 0; s2 < 2; ++s2) { const bf16x8 pf = cvt_frag(kt2 ? s1 : s0, s2); const int rA = 32 * kt2 + 16 * s2 + 4 * h_;
#pragma unroll
                        for (int dt = 0; dt < 2; ++dt) { const bf16x8 vf = tr_frag(Vb, AT_RS, rA, rA + 8, 32 * dt + 16 * blk, lane); O[dt] = mfma32(vf, pf, O[dt]); } }
            }
            if (kind == 1) {
#pragma unroll
                for (int r = 0; r < 16; ++r) { const int n = kb + (r & 3) + 8 * (r >> 2) + 4 * h_;
                    float a = s0[r] * invden, b = s1[r] * invden; a += __shfl_xor(a, 1); b += __shfl_xor(b, 1); a += __shfl_xor(a, 2); b += __shfl_xor(b, 2);
                    if (hr == 0) { PSw[tl * PSS + n] = a; PSw[tl * PSS + n + 32] = b; } }
            }
        }
        if (have_next) at_store(F, (idx + 1) & 1, R);
        __syncthreads();
        ++idx;
    }
#undef AT_FINALIZE
    {
        const float lt = lsum + __shfl_xor(lsum, 32); const float sc = (lt > 0.f ? 1.0f / lt : 0.f) * g2;
        if (!SMP || w == 0) {
            bf16* op = WSP(bf16, WS_OA) + row * 512 + head * 64;
#pragma unroll
            for (int dt = 0; dt < 2; ++dt)
#pragma unroll
                for (int r4 = 0; r4 < 4; ++r4) { float o_[4];
#pragma unroll
                    for (int x = 0; x < 4; ++x) o_[x] = OAw[(dt * 16 + 4 * r4 + x) * 64] + O[dt][4 * r4 + x] * sc;
                    v2u wv; wv.x = pk2(o_[0], o_[1]); wv.y = pk2(o_[2], o_[3]); *(v2u*)(op + 32 * dt + 8 * r4 + 4 * h_) = wv; }
        }
    }
}

constexpr int AS_RS = 144;
constexpr int AS_V = 0, AS_VW = 32 * AS_RS, AS_MRG = 0, AS_PS = 73728, AS_IMP = AS_PS + 16640, AS_MASK = AS_IMP + 6144;
static_assert(8 * 34 * 64 * 4 <= AS_PS && AS_MASK + 512 <= RING_BYTES, "sample attention LDS map");

__device__ __forceinline__ float xhalf_max(float x) { auto t_ = __builtin_amdgcn_permlane32_swap(__float_as_uint(x), __float_as_uint(x), false, false); return fmaxf(__uint_as_float(t_[0]), __uint_as_float(t_[1])); }
__device__ __forceinline__ float xhalf_sum(float x) { auto t_ = __builtin_amdgcn_permlane32_swap(__float_as_uint(x), __float_as_uint(x), false, false); return __uint_as_float(t_[0]) + __uint_as_float(t_[1]); }
struct ASrc { const float* kf; const float* vf; const bf16* kb; const bf16* vb; int rs; int nvalid; };
#define AS_TILE(SRC, KB0, LO_, HI_, DO_PV, DO_PS, m, lsum, O0, O1, invden, PSS_) do { \
        bf16x8 kfr[4]; \
        if ((SRC).kb) { const bf16* kp_ = (SRC).kb + (size_t)q * (SRC).rs + 8 * h_; _Pragma("unroll") for (int kk = 0; kk < 4; ++kk) kfr[kk] = *(const bf16x8*)(kp_ + 16 * kk); } \
        else { const float* kp_ = (SRC).kf + (size_t)q * (SRC).rs + 8 * h_; _Pragma("unroll") for (int kk = 0; kk < 4; ++kk) { const f32x4 a_ = *(const f32x4*)(kp_ + 16 * kk), b_ = *(const f32x4*)(kp_ + 16 * kk + 4); kfr[kk] = __builtin_bit_cast(bf16x8, pack8(a_, b_)); } } \
        if (DO_PV) { const int vr_ = lane >> 1, vh_ = lane & 1; v4u vv_[4]; \
            if (vr_ >= (SRC).nvalid) { _Pragma("unroll") for (int x = 0; x < 4; ++x) vv_[x] = (v4u){0u, 0u, 0u, 0u}; } \
            else if ((SRC).vb) { const bf16* vp_ = (SRC).vb + (size_t)vr_ * (SRC).rs + 32 * vh_; _Pragma("unroll") for (int x = 0; x < 4; ++x) vv_[x] = *(const v4u*)(vp_ + 8 * x); } \
            else { const float* vp_ = (SRC).vf + (size_t)vr_ * (SRC).rs + 32 * vh_; _Pragma("unroll") for (int x = 0; x < 4; ++x) vv_[x] = pack8(*(const f32x4*)(vp_ + 8 * x), *(const f32x4*)(vp_ + 8 * x + 4)); } \
            _Pragma("unroll") for (int x = 0; x < 4; ++x) *(LAS v4u*)(Vw + vr_ * AS_RS + vh_ * 64 + x * 16) = vv_[x]; } \
        f32x16 s_ = (f32x16){}; \
        _Pragma("unroll") for (int kk = 0; kk < 4; ++kk) s_ = mfma32(kfr[kk], qf[kk], s_); \
        float tmax_ = -INFINITY; \
        _Pragma("unroll") for (int r = 0; r < 16; ++r) { const int key_ = (KB0) + (r & 3) + 8 * (r >> 2) + 4 * h_; s_[r] = (key_ >= (LO_) && key_ <= (HI_)) ? s_[r] : -INFINITY; tmax_ = fmaxf(tmax_, s_[r]); } \
        tmax_ = xhalf_max(tmax_); \
        const float mn_ = fmaxf(m, tmax_), mu_ = (mn_ == -INFINITY) ? 0.f : mn_, al_ = fexp2(m - mu_); float ps_ = 0.f; \
        _Pragma("unroll") for (int r = 0; r < 16; ++r) { s_[r] = fexp2(s_[r] - mu_); ps_ += s_[r]; } \
        lsum = lsum * al_ + ps_; m = mn_; \
        if (DO_PV) { O0 *= al_; O1 *= al_; LDS_WAIT(); asm volatile("" ::: "memory"); \
            _Pragma("unroll") for (int s2 = 0; s2 < 2; ++s2) { const bf16x8 pf_ = cvt_frag(s_, s2); const int rA_ = 16 * s2 + 4 * h_; \
                O0 = mfma32(tr_frag(Vw, AS_RS, rA_, rA_ + 8, 16 * blk, lane), pf_, O0); O1 = mfma32(tr_frag(Vw, AS_RS, rA_, rA_ + 8, 32 + 16 * blk, lane), pf_, O1); } \
            LDS_WAIT(); asm volatile("" ::: "memory"); } \
        if (DO_PS) { _Pragma("unroll") for (int r = 0; r < 16; ++r) { const int n_ = (KB0) + (r & 3) + 8 * (r >> 2) + 4 * h_; float a_ = s_[r] * (invden); a_ += __shfl_xor(a_, 1); a_ += __shfl_xor(a_, 2); if (hr == 0) PS[tl * (PSS_) + n_] = a_; } } \
    } while (0)

__device__ __forceinline__ void attn_sample_unit(Frame& F, int l, int unit) {
    const int lane = F.lane, w = F.wave, tid = F.tid;
    const int q = lane & 31, h_ = lane >> 5, blk = (lane >> 4) & 1, tl = q >> 2, hr = q & 3;
    const int seq = unit >> 1, kvh = unit & 1, head = kvh * 4 + hr;
    const size_t row = (size_t)PM + seq * ST + tl;
    LAS unsigned char* Vw = F.lds + AS_V + w * AS_VW;
    LAS float* MRG = (LAS float*)(F.lds + AS_MRG);
    LAS float* PS = (LAS float*)(F.lds + AS_PS);
    LAS float* IMPw = (LAS float*)(F.lds + AS_IMP) + w * 192;
    LAS unsigned long long* MASKS = (LAS unsigned long long*)(F.lds + AS_MASK);
    __syncthreads();
    bf16x8 qf[4];
    { const bf16* qp = WSP(bf16, WS_QN) + row * 512 + head * 64 + 8 * h_;
#pragma unroll
      for (int kk = 0; kk < 4; ++kk) qf[kk] = *(const bf16x8*)(qp + 16 * kk); }
    const float* ngp = WSP(float, WS_NG) + row * 24 + head * 3; const float g0 = ngp[0], g1 = ngp[1], g2 = ngp[2];
    const int* ptab = (const int*)F.a->in[I_PT] + seq * NPG;
    f32x16 OA0 = (f32x16){}, OA1 = (f32x16){};

#define AS_PUBLISH(m, lsum, O0, O1) do { __syncthreads(); LAS float* mp_ = MRG + w * 34 * 64 + lane; mp_[0] = m; mp_[64] = lsum; \
        _Pragma("unroll") for (int r = 0; r < 16; ++r) { mp_[(2 + r) * 64] = O0[r]; mp_[(18 + r) * 64] = O1[r]; } __syncthreads(); } while (0)

    const bf16* CKk = WSP(bf16, WS_CK) + ((size_t)(seq * 2 + kvh) * 512) * 64; const bf16* CKv = CKk + (size_t)CMP_ROWS_J * 64;
    float mC = -INFINITY, lC = 0.f; f32x16 D0 = (f32x16){}, D1 = (f32x16){};
#pragma unroll 1
    for (int ti = w; ti < 16; ti += 8) { ASrc S{nullptr, nullptr, CKk + (size_t)ti * 32 * 64, CKv + (size_t)ti * 32 * 64, 64, 32}; AS_TILE(S, ti * 32, 0, 510, false, false, mC, lC, D0, D1, 0.f, 520); }
    { __syncthreads(); MRG[w * 128 + lane] = mC; MRG[w * 128 + 64 + lane] = xhalf_sum(lC); __syncthreads(); }
    float mT = -INFINITY;
#pragma unroll
    for (int x = 0; x < 8; ++x) mT = fmaxf(mT, MRG[x * 128 + lane]);
    float lT = 0.f;
#pragma unroll
    for (int x = 0; x < 8; ++x) { const float mx_ = MRG[x * 128 + lane]; lT += (mx_ == -INFINITY) ? 0.f : MRG[x * 128 + 64 + lane] * fexp2(mx_ - mT); }
    const float invC = lT > 0.f ? 1.0f / lT : 0.f;
    __syncthreads();
    { float mB = mT, lB = 0.f;
#pragma unroll 1
      for (int ti = w; ti < 16; ti += 8) { ASrc S{nullptr, nullptr, CKk + (size_t)ti * 32 * 64, CKv + (size_t)ti * 32 * 64, 64, 32}; AS_TILE(S, ti * 32, 0, 510, true, true, mB, lB, D0, D1, invC, 520); }
      AS_PUBLISH(mB, lB, D0, D1); }
    { const float sc = g0 * invC;
#pragma unroll 1
      for (int x = 0; x < 8; ++x) { const LAS float* mp = MRG + x * 34 * 64 + lane;
#pragma unroll
          for (int r = 0; r < 16; ++r) { OA0[r] += mp[(2 + r) * 64] * sc; OA1[r] += mp[(18 + r) * 64] * sc; } } }
    {
        const LAS float* pr = PS + w * 520; const int sa = lane, sb = lane + 64; float ia = 0.f, ib = 0.f;
#pragma unroll
        for (int n = 4 * sa - 1; n <= 4 * sa + 3; ++n) if (n >= 0) ia += pr[n];
#pragma unroll
        for (int n = 4 * sb - 1; n <= 4 * sb + 3; ++n) ib += pr[n];
        const bool fa = (sa == 0), fb = (sb == 127); const float va = fa ? 1e4f : ia, vb = fb ? 1e4f : ib;
        IMPw[sa] = va; IMPw[sb] = vb; LDS_WAIT(); asm volatile("" ::: "memory");
        int ra = fa ? 0 : 1, rb = fb ? 0 : 1;
#pragma unroll 8
        for (int i = 0; i < 128; ++i) { const float v = IMPw[i]; ra += (v > va || (v == va && i < sa)) ? 1 : 0; rb += (v > vb || (v == vb && i < sb)) ? 1 : 0; }
        const unsigned long long ma = __ballot(ra < 16), mb = __ballot(rb < 16);
        if (lane == 0) { MASKS[w * 4] = ma; MASKS[w * 4 + 1] = mb; }
    }
    __syncthreads();
    const unsigned long long mk0 = MASKS[tl * 4], mk1 = MASKS[tl * 4 + 1];
    unsigned long long U0 = 0ull, U1 = 0ull;
#pragma unroll
    for (int x = 0; x < 8; ++x) { U0 |= MASKS[x * 4]; U1 |= MASKS[x * 4 + 1]; }
    {
        float m = -INFINITY, ls = 0.f; D0 = (f32x16){}; D1 = (f32x16){};
        const int t = PAST + tl; int cnt = 0;
#pragma unroll 1
        for (int s = 0; s <= 128; ++s) {
            const bool in_u = (s < 64) ? ((U0 >> s) & 1ull) : ((s < 128) ? ((U1 >> (s - 64)) & 1ull) : true);
            if (!in_u) continue;
            const bool selb = (s < 64) ? ((mk0 >> s) & 1ull) : ((s < 128) ? ((mk1 >> (s - 64)) & 1ull) : true);
            const int nh = (s < 128) ? 2 : 1;
            for (int hf = 0; hf < nh; ++hf, ++cnt) {
                if ((cnt & 7) != w) continue;
                const int hi = selb ? t : -1;
                if (s < 128) { const int page = ptab[s >> 1], slot = (s & 1) * 64 + hf * 32;
                    const float* kp = FIN(I_CACHE) + (((((size_t)l * NPHYS + page) * PAGE + slot) * 4 + 2) * 2 + kvh) * 64;
                    ASrc S{kp, kp + 128, nullptr, nullptr, 512, 32}; AS_TILE(S, s * 64 + hf * 32, 0, hi, true, false, m, ls, D0, D1, 0.f, 520); }
                else { const bf16* kp = WSP(bf16, WS_KVS) + ((((size_t)0 * SB + seq) * 2 + kvh) * ST) * 64;
                    ASrc S{nullptr, nullptr, kp, kp + (size_t)SB * 2 * ST * 64, 64, ST}; AS_TILE(S, PAST, 0, hi, true, false, m, ls, D0, D1, 0.f, 520); }
            }
        }
        AS_PUBLISH(m, ls, D0, D1);
        float mt = -INFINITY;
#pragma unroll
        for (int x = 0; x < 8; ++x) mt = fmaxf(mt, MRG[x * 34 * 64 + lane]);
        float lt = 0.f; f32x16 T0 = (f32x16){}, T1 = (f32x16){};
#pragma unroll 1
        for (int x = 0; x < 8; ++x) { const LAS float* mp = MRG + x * 34 * 64 + lane; const float mx_ = mp[0]; const float f = (mx_ == -INFINITY) ? 0.f : fexp2(mx_ - mt); lt += mp[64] * f;
#pragma unroll
            for (int r = 0; r < 16; ++r) { T0[r] += mp[(2 + r) * 64] * f; T1[r] += mp[(18 + r) * 64] * f; } }
        lt = xhalf_sum(lt); const float sc = (lt > 0.f ? 1.0f / lt : 0.f) * g1; OA0 += T0 * sc; OA1 += T1 * sc;
    }
    {
        float m = -INFINITY, ls = 0.f; D0 = (f32x16){}; D1 = (f32x16){};
#pragma unroll 1
        for (int ti = w; ti < 17; ti += 8) {
            if (ti < 16) { const float* kp = FIN(I_CWIN) + (((((size_t)l * SB + seq) * WINB + ti * 32) * 2 + 0) * 2 + kvh) * 64;
                ASrc S{kp, kp + 128, nullptr, nullptr, 256, 32}; AS_TILE(S, ti * 32, tl, WINB + tl, true, false, m, ls, D0, D1, 0.f, 520); }
            else { const bf16* kp = WSP(bf16, WS_KVS) + ((((size_t)2 * SB + seq) * 2 + kvh) * ST) * 64;
                ASrc S{nullptr, nullptr, kp, kp + (size_t)SB * 2 * ST * 64, 64, ST}; AS_TILE(S, WINB, tl, WINB + tl, true, false, m, ls, D0, D1, 0.f, 520); }
        }
        AS_PUBLISH(m, ls, D0, D1);
        float mt = -INFINITY;
#pragma unroll
        for (int x = 0; x < 8; ++x) mt = fmaxf(mt, MRG[x * 34 * 64 + lane]);
        float lt = 0.f; f32x16 T0 = (f32x16){}, T1 = (f32x16){};
#pragma unroll 1
        for (int x = 0; x < 8; ++x) { const LAS float* mp = MRG + x * 34 * 64 + lane; const float mx_ = mp[0]; const float f = (mx_ == -INFINITY) ? 0.f : fexp2(mx_ - mt); lt += mp[64] * f;
#pragma unroll
            for (int r = 0; r < 16; ++r) { T0[r] += mp[(2 + r) * 64] * f; T1[r] += mp[(18 + r) * 64] * f; } }
        lt = xhalf_sum(lt); const float sc = (lt > 0.f ? 1.0f / lt : 0.f) * g2; OA0 += T0 * sc; OA1 += T1 * sc;
    }
#undef AS_PUBLISH
    if (w == 0) {
        bf16* op = WSP(bf16, WS_OA) + row * 512 + head * 64;
#pragma unroll
        for (int r4 = 0; r4 < 4; ++r4) { v2u a, b; a.x = pk2(OA0[4 * r4 + 0], OA0[4 * r4 + 1]); a.y = pk2(OA0[4 * r4 + 2], OA0[4 * r4 + 3]); b.x = pk2(OA1[4 * r4 + 0], OA1[4 * r4 + 1]); b.y = pk2(OA1[4 * r4 + 2], OA1[4 * r4 + 3]);
            *(v2u*)(op + 8 * r4 + 4 * h_) = a; *(v2u*)(op + 32 + 8 * r4 + 4 * h_) = b; }
    }
}

constexpr int AP_WS = 14336, AP_V = 0, AP_PS = 4608, AP_IMP = AP_PS + 8 * 264 * 4, AP_MASK = AP_IMP + 256, AP_LIST = AP_MASK + 64;
static_assert(AP_LIST + 2 * 192 <= AP_WS && 8 * AP_WS <= RING_BYTES, "prompt attention LDS map");
__device__ __forceinline__ void attn_prompt_unit(Frame& F, int l, int unit) {
    const int lane = F.lane, w = F.wave;
    const int q = lane & 31, h_ = lane >> 5, blk = (lane >> 4) & 1, tl = q >> 2, hr = q & 3;
    const int seq = unit >> 7, kvh = (unit >> 6) & 1, qt = unit & 63, head = kvh * 4 + hr;
    const int t0w = qt * 64 + 8 * w, t = t0w + tl; const size_t row = (size_t)seq * PT + t;
    LAS unsigned char* Vw = F.lds + w * AP_WS + AP_V; LAS float* PS = (LAS float*)(F.lds + w * AP_WS + AP_PS); LAS float* IMPw = (LAS float*)(F.lds + w * AP_WS + AP_IMP);
    LAS unsigned long long* MASKS = (LAS unsigned long long*)(F.lds + w * AP_WS + AP_MASK); LAS unsigned short* LIST = (LAS unsigned short*)(F.lds + w * AP_WS + AP_LIST);
    __syncthreads();
    bf16x8 qf[4];
    { const bf16* qp = WSP(bf16, WS_QN) + row * 512 + head * 64 + 8 * h_;
#pragma unroll
      for (int kk = 0; kk < 4; ++kk) qf[kk] = *(const bf16x8*)(qp + 16 * kk); }
    const float* ngp = WSP(float, WS_NG) + row * 24 + head * 3; const float g0 = ngp[0], g1 = ngp[1], g2 = ngp[2];
    for (int i = lane; i < 8 * 264; i += 64) PS[i] = 0.f;
    const bf16* CKk = WSP(bf16, WS_CK) + ((size_t)32768 + (seq * 2 + kvh) * 256) * 64; const bf16* CKv = CKk + (size_t)CMP_ROWS_J * 64;
    const bf16* KS = WSP(bf16, WS_KVB) + ((((size_t)0 * PB + seq) * 2 + kvh) * PT) * 64; const bf16* VS = KS + (size_t)PB * 2 * PT * 64;
    const bf16* KW = KS + (size_t)2 * PB * 2 * PT * 64; const bf16* VW = KW + (size_t)PB * 2 * PT * 64;
    const int hiCmin = (t0w >= 31) ? ((t0w - 31) >> 4) : -1;
    const int hiC = (t >= 31) ? ((t - 31) >> 4) : -1; const int nmaxw = (t0w + 7 >= 31) ? ((t0w + 7 - 31) >> 4) : -1; const int ntc = (nmaxw >= 0) ? (nmaxw >> 5) + 1 : 0;
    f32x16 OA0 = (f32x16){}, OA1 = (f32x16){}, D0 = (f32x16){}, D1 = (f32x16){};
    float m = -INFINITY, lsum = 0.f, invC = 0.f; unsigned long long mk0 = 0ull;
    bf16x8 nk[4]; v4u nv[4];
#define AP_LOADT(e_) do { const int kd_ = (int)((e_) >> 12), ti_ = (int)((e_) & 0xfffu); const bf16* kb_ = (kd_ < 2 ? CKk : (kd_ == 2 ? KS : KW)) + (size_t)ti_ * 32 * 64; const bf16* vb_ = (kd_ < 2 ? CKv : (kd_ == 2 ? VS : VW)) + (size_t)ti_ * 32 * 64; \
        _Pragma("unroll") for (int kk = 0; kk < 4; ++kk) nk[kk] = *(const bf16x8*)(kb_ + (size_t)q * 64 + 8 * h_ + 16 * kk); \
        _Pragma("unroll") for (int x = 0; x < 4; ++x) nv[x] = *(const v4u*)(vb_ + (size_t)(lane >> 1) * 64 + 32 * (lane & 1) + 8 * x); } while (0)
#define AP_RUN(N_) do { const int n_ = (N_); if (n_ > 0) { const unsigned e0_ = (unsigned)__builtin_amdgcn_readfirstlane((int)LIST[0]); AP_LOADT(e0_); } \
      _Pragma("unroll 1") for (int i_ = 0; i_ < n_; ++i_) { \
        const unsigned e_ = (unsigned)__builtin_amdgcn_readfirstlane((int)LIST[i_]); const int kind = (int)(e_ >> 12), ti = (int)(e_ & 0xfffu); \
        bf16x8 ck[4]; _Pragma("unroll") for (int kk = 0; kk < 4; ++kk) ck[kk] = nk[kk]; \
        if (kind != 0) { _Pragma("unroll") for (int x = 0; x < 4; ++x) *(LAS v4u*)(Vw + (lane >> 1) * AS_RS + (lane & 1) * 64 + x * 16) = nv[x]; } \
        if (i_ + 1 < n_) { const unsigned en_ = (unsigned)__builtin_amdgcn_readfirstlane((int)LIST[i_ + 1]); AP_LOADT(en_); } \
        if (kind != cur_kind) { \
            if (cur_kind == 0) { const float lt_ = xhalf_sum(lsum); invC = lt_ > 0.f ? 1.0f / lt_ : 0.f; } \
            else if (cur_kind == 2) { const float lt_ = xhalf_sum(lsum); const float sc_ = (lt_ > 0.f ? 1.0f / lt_ : 0.f) * g1; OA0 += D0 * sc_; OA1 += D1 * sc_; } \
            if (kind != 1) m = -INFINITY; lsum = 0.f; D0 = (f32x16){}; D1 = (f32x16){}; cur_kind = kind; } \
        const int kb = ti * 32; int lo, hi; \
        if (kind < 2) { lo = 0; hi = hiC; } else if (kind == 2) { lo = 0; hi = ((mk0 >> (ti >> 1)) & 1ull) ? t : -1; } else { lo = t - WINB; hi = t; } \
        f32x16 s_ = (f32x16){}; \
        _Pragma("unroll") for (int kk = 0; kk < 4; ++kk) s_ = mfma32(ck[kk], qf[kk], s_); \
          \
        const bool interior = (kind < 2) ? (hiCmin >= 0 && kb + 31 <= hiCmin) : ((kind == 2) ? (kb + 31 <= t0w) : (kb >= t0w + 7 - WINB && kb + 31 <= t0w)); \
        float tmax_ = -INFINITY, mu_, mn_; \
        if (interior) { const bool on_ = hi >= 0; \
            _Pragma("unroll") for (int r = 0; r < 16; ++r) tmax_ = fmaxf(tmax_, s_[r]); \
            tmax_ = on_ ? tmax_ : -INFINITY; tmax_ = xhalf_max(tmax_); \
            mn_ = fmaxf(m, tmax_); mu_ = (mn_ == -INFINITY) ? 0.f : mn_; const float mr_ = on_ ? mu_ : INFINITY; \
            _Pragma("unroll") for (int r = 0; r < 16; ++r) s_[r] = fexp2(s_[r] - mr_); \
        } else { \
            _Pragma("unroll") for (int r = 0; r < 16; ++r) { const int key_ = kb + (r & 3) + 8 * (r >> 2) + 4 * h_; s_[r] = (key_ >= lo && key_ <= hi) ? s_[r] : -INFINITY; tmax_ = fmaxf(tmax_, s_[r]); } \
            tmax_ = xhalf_max(tmax_); \
            mn_ = fmaxf(m, tmax_); mu_ = (mn_ == -INFINITY) ? 0.f : mn_; \
            _Pragma("unroll") for (int r = 0; r < 16; ++r) s_[r] = fexp2(s_[r] - mu_); \
        } \
        const float al_ = fexp2(m - mu_); float ps_ = 0.f; \
        _Pragma("unroll") for (int r = 0; r < 16; ++r) ps_ += s_[r]; \
        lsum = lsum * al_ + ps_; m = mn_; \
        if (kind != 0) { if (__ballot(al_ != 1.0f) != 0ull) { D0 *= al_; D1 *= al_; } LDS_WAIT(); asm volatile("" ::: "memory"); \
            _Pragma("unroll") for (int s2 = 0; s2 < 2; ++s2) { const bf16x8 pf_ = cvt_frag(s_, s2); const int rA_ = 16 * s2 + 4 * h_; \
                D0 = mfma32(tr_frag(Vw, AS_RS, rA_, rA_ + 8, 16 * blk, lane), pf_, D0); D1 = mfma32(tr_frag(Vw, AS_RS, rA_, rA_ + 8, 32 + 16 * blk, lane), pf_, D1); } \
            LDS_WAIT(); asm volatile("" ::: "memory"); } \
        if (kind == 1) { _Pragma("unroll") for (int r = 0; r < 16; ++r) { const int n2_ = kb + (r & 3) + 8 * (r >> 2) + 4 * h_; float a_ = s_[r] * invC; a_ += __shfl_xor(a_, 1); a_ += __shfl_xor(a_, 2); if (hr == 0) PS[tl * 264 + n2_] = a_; } } \
      } } while (0)
    int cur_kind = -1;
    if (lane < 2 * ntc) LIST[lane] = (unsigned short)(((lane >= ntc ? 1u : 0u) << 12) | (unsigned)(lane >= ntc ? lane - ntc : lane));
    LDS_WAIT(); asm volatile("" ::: "memory");
    AP_RUN(2 * ntc);
    if (cur_kind == 1) { const float sc = g0 * invC; OA0 = D0 * sc; OA1 = D1 * sc; }
    LDS_WAIT(); asm volatile("" ::: "memory");
#pragma unroll 1
    for (int tk = 0; tk < 8; ++tk) {
        const LAS float* pr = PS + tk * 264; const int s = lane; float imp = 0.f;
#pragma unroll
        for (int n = 4 * s - 1; n <= 4 * s + 3; ++n) if (n >= 0) imp += pr[n];
        const bool forced = (s == 0) || (s == qt) || (s == qt - 1), avail = s <= qt; const float val = avail ? (forced ? 1e4f : imp) : -1e4f;
        IMPw[s] = val; LDS_WAIT(); asm volatile("" ::: "memory");
        int rank = 0;
#pragma unroll 8
        for (int i = 0; i < 64; ++i) { const float v = IMPw[i]; rank += (v > val || (v == val && i < s)) ? 1 : 0; }
        const unsigned long long mk = __ballot(rank < 16);
        if (lane == 0) MASKS[tk] = mk;
        LDS_WAIT(); asm volatile("" ::: "memory");
    }
    mk0 = MASKS[tl]; unsigned long long wu = 0ull;
#pragma unroll
    for (int i = 0; i < 8; ++i) wu |= MASKS[i];
    wu &= (qt >= 63) ? ~0ull : ((1ull << (qt + 1)) - 1ull);
    const int nsel = 2 * __popcll(wu); const int tiLo = (t0w > WINB) ? ((t0w - WINB) >> 5) : 0, tiHi = (t0w + 7) >> 5, nwin = tiHi - tiLo + 1;
    if ((wu >> lane) & 1ull) { const int pos = 2 * __popcll(wu & ((1ull << lane) - 1ull)); LIST[pos] = (unsigned short)((2u << 12) | (unsigned)(2 * lane)); LIST[pos + 1] = (unsigned short)((2u << 12) | (unsigned)(2 * lane + 1)); }
    if (lane < nwin) LIST[nsel + lane] = (unsigned short)((3u << 12) | (unsigned)(tiLo + lane));
    LDS_WAIT(); asm volatile("" ::: "memory");
#ifdef DBG_COUNT
    if (lane == 0) { unsigned* CNT = (unsigned*)(F.ws + WS_CTL) + 3000; atomicAdd(CNT + 0, (unsigned)nsel); atomicAdd(CNT + 1, (unsigned)nwin); atomicAdd(CNT + 2, (unsigned)(2 * ntc)); atomicAdd(CNT + 3, 1u); }
#endif
    cur_kind = -1;
    AP_RUN(nsel + nwin);
    { const float lt = xhalf_sum(lsum); const float sc = (lt > 0.f ? 1.0f / lt : 0.f) * g2; OA0 += D0 * sc; OA1 += D1 * sc; }
#undef AP_RUN
#undef AP_LOADT
    {
        bf16* op = WSP(bf16, WS_OA) + row * 512 + head * 64;
#pragma unroll
        for (int r4 = 0; r4 < 4; ++r4) { v2u a, b; a.x = pk2(OA0[4 * r4 + 0], OA0[4 * r4 + 1]); a.y = pk2(OA0[4 * r4 + 2], OA0[4 * r4 + 3]); b.x = pk2(OA1[4 * r4 + 0], OA1[4 * r4 + 1]); b.y = pk2(OA1[4 * r4 + 2], OA1[4 * r4 + 3]);
            *(v2u*)(op + 8 * r4 + 4 * h_) = a; *(v2u*)(op + 32 + 8 * r4 + 4 * h_) = b; }
    }
}
#undef AS_TILE

#ifdef DBG_CHECK
__device__ __forceinline__ unsigned dbg_rand(unsigned x) { x ^= x >> 16; x *= 0x7feb352du; x ^= x >> 15; x *= 0x846ca68bu; x ^= x >> 16; return x; }
__device__ __forceinline__ bool dbg_bad(float got, float exp_, float rtol, float atol) { return !(fabsf(got - exp_) <= rtol * fabsf(exp_) + atol); }
__device__ __forceinline__ float bfr(float x) { return __uint_as_float(pk2(x, 0.f) << 16); }
__device__ __forceinline__ int dbg_row(unsigned r) { const unsigned k = r % 20u; if (k == 0) return (int)(PM + (r >> 8) % SM); if (k == 1) return (int)(((r >> 8) % PB) * PT + ((r >> 12) % 8)); if (k == 2) return (int)(((r >> 8) % PB) * PT + PT - 1 - ((r >> 12) % 8)); return (int)((r >> 5) % PM); }
__device__ __forceinline__ float dbg_rs(const Frame& F, int row, int lane) { const float* xr = xrow_in(F, 0, row); float ss = 0.f; for (int d = lane; d < DM; d += 64) ss += xr[d] * xr[d]; return 1.0f / sqrtf(wave_sum(ss) * (1.0f / DM) + EPS); }
__device__ __forceinline__ float dbg_h(const Frame& F, int row, int d, float rs) { const float* mod = WSP(float, WS_MOD) + (size_t)row_bb(row) * 6144; return bfr(xrow_in(F, 0, row)[d] * rs * FIN(I_N1G)[d] * (1.0f + mod[1024 + d]) + mod[d]); }

__device__ __forceinline__ void dbg_check_phase(Frame& F) {
    const int gw = F.bid * NWAVES + F.wave, NGW = F.G * NWAVES, lane = F.lane;
    unsigned* CNT = (unsigned*)(F.ws + WS_CTL) + 3000;
    LAS float* L = (LAS float*)(F.lds + F.wave * 16384);
#define DBG_FLAG(ch, cond) do { if (__any(cond) && lane == 0) atomicAdd(CNT + (ch), 1u); } while (0)
    for (int s = gw; s < 1536; s += NGW) {
        const unsigned r = dbg_rand(1000u + s); const int row = dbg_row(r); const float rs = dbg_rs(F, row, lane); const int kind = s % 6;
        const bool isp = row < PM; const int b = isp ? (row >> 12) : ((row - PM) >> 3), t = isp ? (row & (PT - 1)) : ((row - PM) & 7);
#define DBG_U(col, dst) do { float a_ = 0.f; for (int d_ = lane; d_ < DM; d_ += 64) a_ += dbg_h(F, row, d_, rs) * bfr(FIN(I_WIN)[(size_t)d_ * D_IN + (col)]); dst = wave_sum(a_); } while (0)
        if (kind == 0) {
            const int c = (r >> 3) % 768, j = c >> 7, k = (c >> 6) & 1, dd = c & 63; float u; DBG_U(O_NKV + c, u); bool bad = false;
            if (j < 4) bad = dbg_bad(F.out[(isp ? OUT_ROWS_P + (size_t)row * 512 : OUT_ROWS_S + (size_t)(row - PM) * 512) + c], u, 0.01f, 0.01f);
            else if (isp) { if (t >= PT - WINB) bad = dbg_bad(F.out[OUT_WIN_P + ((size_t)b * WINB + (t - (PT - WINB))) * 256 + (c - 512)], u, 0.01f, 0.01f); }
            else bad = dbg_bad(F.out[OUT_WIN_S + ((size_t)b * WINB + (WINB - ST) + t) * 256 + (c - 512)], u, 0.01f, 0.01f);
            if (isp) { if (j < 2) bad = bad || dbg_bad(bf1(WSP(bf16, WS_ACMP)[((size_t)j * CMP_ROWS_J + 32768 + (b * 2 + k) * 256 + (t >> 4)) * 1024 + (t & 15) * 64 + dd]), u, 0.01f, 0.01f);
                       else bad = bad || dbg_bad(bf1(WSP(bf16, WS_KVB)[((((size_t)(j - 2) * PB + b) * 2 + k) * PT + t) * 64 + dd]), u, 0.01f, 0.01f); }
            else if (j >= 2) bad = bad || dbg_bad(bf1(WSP(bf16, WS_KVS)[((((size_t)(j - 2) * SB + b) * 2 + k) * ST + t) * 64 + dd]), u, 0.01f, 0.01f);
            DBG_FLAG(0, bad);
        } else if (kind == 1) {
            const int gi = (r >> 3) % 24, c5 = (r >> 8) % 512, cm = (r >> 8) % 3072; float u0, u1, u2, u3; DBG_U(O_NG + gi, u0); DBG_U(O_RX + c5, u1); DBG_U(O_RGATE + c5, u2); DBG_U(O_MG + cm, u3);
            bool bad = dbg_bad(WSP(float, WS_NG)[(size_t)row * 24 + gi], 1.0f / (1.0f + expf(-u0)), 0.01f, 0.005f);
            bad = bad || dbg_bad(WSP(float, WS_RX)[(size_t)row * 512 + c5], u1, 0.01f, 0.01f);
            bad = bad || dbg_bad(bf1(WSP(bf16, WS_GG)[(size_t)row * 512 + c5]), gelu_tanh(u2), 0.02f, 0.01f);
            bad = bad || dbg_bad(bf1(WSP(bf16, WS_MGS)[(size_t)row * 3072 + cm]), 1.0f / (1.0f + expf(-u3)), 0.01f, 0.005f);
            DBG_FLAG(1, bad);
        } else if (kind == 2) {
            const int head = (r >> 13) % 4, dim = (r >> 16) % 64, c5 = (r >> 3) % 512; float x1, x2, uv, ug, uq; DBG_U(O_RQ + head * 128 + dim, x1); DBG_U(O_RQ + head * 128 + 64 + dim, x2); DBG_U(O_RV + c5, uv); DBG_U(O_RG + c5, ug); DBG_U(O_NQ + c5, uq);
            const float pos = (float)(isp ? t : PAST + t); const float ang = pos * (float)pow(10000.0, -(double)dim / 64.0); float sn, cs; sincos_acc(ang, sn, cs);
            const bf16* RQ = WSP(bf16, WS_RQ);
            bool bad = dbg_bad(bf1(RQ[(size_t)row * 512 + head * 128 + dim]), x1 * cs - x2 * sn, 0.02f, 0.02f) || dbg_bad(bf1(RQ[(size_t)row * 512 + head * 128 + 64 + dim]), x1 * sn + x2 * cs, 0.02f, 0.02f);
            bad = bad || dbg_bad(bf1(RQ[(size_t)2 * MT * 512 + (size_t)row * 512 + c5]), uv, 0.01f, 0.01f) || dbg_bad(bf1(RQ[(size_t)3 * MT * 512 + (size_t)row * 512 + c5]), ug, 0.01f, 0.01f);
            bad = bad || dbg_bad(bf1(WSP(bf16, WS_QN)[(size_t)row * 512 + c5]), uq * QSCALE, 0.01f, 0.005f);
            DBG_FLAG(2, bad);
        }
#undef DBG_U
    }
    for (int s = gw; s < 128; s += NGW) {
        const unsigned r = dbg_rand(3000u + s); const int j = r & 1; const bool smp = ((r >> 1) & 3) != 0;
        const int grp = smp ? (int)((r >> 3) % 64) : (int)((r >> 3) % 8), nmax = smp ? 511 : 255; int n = (r >> 10) % nmax; if (((r >> 20) & 7) == 0) n = nmax - 1;
        const size_t rj = smp ? (size_t)grp * 512 + n : (size_t)32768 + grp * 256 + n;
        const bf16* A = WSP(bf16, WS_ACMP) + ((size_t)j * CMP_ROWS_J + rj) * 1024;
        const float* w1 = FIN(I_W1) + (size_t)j * 2048 * 128; const float* pe = FIN(I_PE) + j * 2048;
        for (int hh = 0; hh < 2; ++hh) { const int h = lane + 64 * hh; float a = FIN(I_B1)[j * 128 + h];
            for (int i = 0; i < 1024; ++i) a += (bf1(A[i]) + pe[i]) * w1[(size_t)i * 128 + h] + (bf1(A[1024 + i]) + pe[1024 + i]) * w1[(size_t)(1024 + i) * 128 + h];
            L[h] = gelu_tanh(a); }
        LDS_WAIT(); asm volatile("" ::: "memory");
        float o = 0.f; for (int h = 0; h < 128; ++h) o += L[h] * FIN(I_W2)[((size_t)j * 128 + h) * 64 + lane];
        const float got = bf1(WSP(bf16, WS_CK)[((size_t)j * CMP_ROWS_J + rj) * 64 + lane]);
        { const bool bd = dbg_bad(got, o, 0.05f, 0.03f); const unsigned long long mk = __ballot(bd); if (lane == 0 && mk) atomicAdd(CNT + 3, (unsigned)__popcll(mk)); }
        LDS_WAIT(); asm volatile("" ::: "memory");
    }
    for (int s = gw; s < 128; s += NGW) {
        const unsigned r = dbg_rand(3500u + s); const int j = r & 1; const bool smp = ((r >> 1) & 3) != 0;
        const int grp = smp ? (int)((r >> 3) % 64) : (int)((r >> 3) % 8), nmax = smp ? 511 : 255; const int n = (r >> 10) % nmax;
        const size_t rj = smp ? (size_t)grp * 512 + n : (size_t)32768 + grp * 256 + n, row = (size_t)j * CMP_ROWS_J + rj;
        const bf16* A = WSP(bf16, WS_ACMP) + row * 1024; const float* w1 = FIN(I_W1) + (size_t)j * 2048 * 128; const bf16* LH = WSP(bf16, WS_LH);
        unsigned nb = 0;
        for (int hh = 0; hh < 2; ++hh) { const int h = lane + 64 * hh; float lo = 0.f, hi = 0.f;
            for (int i = 0; i < 1024; ++i) { const float av = bf1(A[i]); lo += av * bfr(w1[(size_t)i * 128 + h]); hi += av * bfr(w1[(size_t)(1024 + i) * 128 + h]); }
            const bool bd = dbg_bad(bf1(LH[row * 256 + h]), lo, 0.02f, 0.02f) || dbg_bad(bf1(LH[row * 256 + 128 + h]), hi, 0.02f, 0.02f); nb += (unsigned)__popcll(__ballot(bd)); }
        if (lane == 0 && nb) atomicAdd(CNT + 9, nb);
        for (int hh = 0; hh < 2; ++hh) { const int h = lane + 64 * hh; L[h] = gelu_tanh(bf1(LH[row * 256 + h]) + bf1(LH[(row + 1) * 256 + 128 + h]) + WSP(float, WS_SMALLW + SW_CB)[j * 128 + h]); }
        LDS_WAIT(); asm volatile("" ::: "memory");
        float o = 0.f; for (int h = 0; h < 128; ++h) o += bfr(L[h]) * bfr(FIN(I_W2)[((size_t)j * 128 + h) * 64 + lane]);
        { const bool bd = dbg_bad(bf1(WSP(bf16, WS_CK)[row * 64 + lane]), o, 0.03f, 0.01f); const unsigned long long mk = __ballot(bd); if (lane == 0 && mk) atomicAdd(CNT + 11, (unsigned)__popcll(mk)); }
        LDS_WAIT(); asm volatile("" ::: "memory");
    }
    for (int s = gw; s < 64; s += NGW) {
        const unsigned r = dbg_rand(3700u + s); const int j = r & 1, half = (r >> 1) & 1, h = (r >> 2) % 128; const bf16* W1T = WSP(bf16, WS_SMALLW + SW_W1T) + ((size_t)j * 256 + half * 128 + h) * 1024;
        const float* w1 = FIN(I_W1) + ((size_t)j * 32 + half * 16) * 64 * 128 + h; unsigned nb = 0;
        for (int k = lane; k < 1024; k += 64) nb += (unsigned)__popcll(__ballot(dbg_bad(bf1(W1T[k]), w1[(size_t)k * 128], 0.01f, 0.0001f)));
        if (lane == 0 && nb) atomicAdd(CNT + 12, nb);
        const bool smp = ((r >> 9) & 3) != 0; const int grp = smp ? (int)((r >> 11) % 64) : (int)((r >> 11) % 8), n = (r >> 17) % (smp ? 511 : 255);
        const size_t row = (size_t)j * CMP_ROWS_J + (smp ? (size_t)grp * 512 + n : (size_t)32768 + grp * 256 + n); const bf16* A = WSP(bf16, WS_ACMP) + row * 1024;
        float a = 0.f; for (int k = lane; k < 1024; k += 64) a += bf1(A[k]) * bf1(W1T[k]); a = wave_sum(a);
        DBG_FLAG(13, dbg_bad(bf1(WSP(bf16, WS_LH)[row * 256 + half * 128 + h]), a, 0.02f, 0.02f));
    }
    for (int s = gw; s < 4; s += NGW) {
        const int j = s >> 1, h = (s & 1) * 64 + lane; const float* w1 = FIN(I_W1) + (size_t)j * 2048 * 128; const float* pe = FIN(I_PE) + j * 2048;
        float a = FIN(I_B1)[j * 128 + h]; for (int i = 0; i < 2048; ++i) a += pe[i] * w1[(size_t)i * 128 + h];
        const unsigned long long mk = __ballot(dbg_bad(WSP(float, WS_SMALLW + SW_CB)[j * 128 + h], a, 0.001f, 0.0005f)); if (lane == 0 && mk) atomicAdd(CNT + 10, (unsigned)__popcll(mk));
    }
    for (int s = gw; s < 96; s += NGW) {
        const unsigned r = dbg_rand(4000u + s); const bool smp = (s % 3) == 2;
        int seq, kvh = (r >> 4) & 1, t, tl = 0; size_t row;
        if (smp) { seq = (r >> 5) % SB; tl = (r >> 10) % ST; t = PAST + tl; row = (size_t)PM + seq * ST + tl; }
        else { seq = (r >> 5) % PB; const unsigned k = (r >> 8) % 8u; t = (k == 0) ? (int)((r >> 12) % 40) : (k == 1) ? PT - 1 - (int)((r >> 12) % 70) : (int)((r >> 12) % PT); row = (size_t)seq * PT + t; }
        const int N = smp ? 511 : 255, NS = smp ? 129 : 64, cur = t >> 6;
        LAS float* Q = L; LAS float* SC = L + 256; LAS float* PSUM = L + 256 + 2048; LAS float* OUT = L + 256 + 2048 + 512;
        for (int i = lane; i < 256; i += 64) Q[i] = bf1(WSP(bf16, WS_QN)[row * 512 + (kvh * 4 + (i >> 6)) * 64 + (i & 63)]);
        for (int i = lane; i < 768; i += 64) OUT[i] = 0.f;
        LDS_WAIT(); asm volatile("" ::: "memory");
        const bf16* CKk = WSP(bf16, WS_CK) + (smp ? (size_t)(seq * 2 + kvh) * 512 : (size_t)32768 + (seq * 2 + kvh) * 256) * 64; const bf16* CKv = CKk + (size_t)CMP_ROWS_J * 64;
        const int nvis = smp ? 511 : ((t >= 31) ? ((t - 31) >> 4) + 1 : 0);
        for (int i = lane; i < 512; i += 64) PSUM[i] = 0.f;
        for (int hr = 0; hr < 4; ++hr) {
            float mx = -INFINITY; for (int n = lane; n < nvis; n += 64) { float a = 0.f; for (int d = 0; d < 64; ++d) a += Q[hr * 64 + d] * bf1(CKk[(size_t)n * 64 + d]); SC[n] = a; mx = fmaxf(mx, a); }
            for (int o = 1; o < 64; o <<= 1) mx = fmaxf(mx, __shfl_xor(mx, o));
            float den = 0.f; for (int n = lane; n < nvis; n += 64) { const float e = exp2f(SC[n] - mx); SC[n] = e; den += e; } den = wave_sum(den);
            LDS_WAIT(); asm volatile("" ::: "memory");
            if (nvis > 0) { float o = 0.f; for (int n = 0; n < nvis; ++n) o += SC[n] * bf1(CKv[(size_t)n * 64 + lane]); OUT[hr * 64 + lane] = o / den;
                for (int n = lane; n < nvis; n += 64) PSUM[n] += SC[n] / den; }
            LDS_WAIT(); asm volatile("" ::: "memory");
        }
        LAS float* IMP = SC; LAS float* SELB = SC + 256;
        for (int sblk = lane; sblk < NS; sblk += 64) { float imp = 0.f; for (int n = 4 * sblk - 1; n <= 4 * sblk + 3; ++n) if (n >= 0 && n < N) imp += PSUM[n];
            const bool forced = sblk == 0 || sblk == cur || sblk == cur - 1, avail = sblk * 64 <= t; IMP[sblk] = avail ? (forced ? 1e4f : imp) : -1e4f; SELB[sblk] = 0.f; }
        LDS_WAIT(); asm volatile("" ::: "memory");
        for (int pick = 0; pick < 16 && pick < NS; ++pick) { float bv = -INFINITY; int bi = 1 << 30;
            for (int sblk = lane; sblk < NS; sblk += 64) { const float v = (SELB[sblk] != 0.f) ? -INFINITY : IMP[sblk]; if (v > bv || (v == bv && sblk < bi)) { bv = v; bi = sblk; } }
            for (int o = 1; o < 64; o <<= 1) { const float ov = __shfl_xor(bv, o); const int oi = __shfl_xor(bi, o); if (ov > bv || (ov == bv && oi < bi)) { bv = ov; bi = oi; } }
            if (lane == 0) SELB[bi] = 1.f; LDS_WAIT(); asm volatile("" ::: "memory"); }
        for (int br = 1; br < 3; ++br) for (int hr = 0; hr < 4; ++hr) {
            float mx = -INFINITY, den = 0.f, o = 0.f;
            const int plo = (br == 1) ? 0 : (t - WINB < 0 ? 0 : t - WINB), phi = t;
            for (int p = plo; p <= phi; ++p) {
                if (br == 1 && SELB[p >> 6] == 0.f) { p |= 63; continue; }
                const float* kf = nullptr; const bf16* kb = nullptr; const float* vf = nullptr; const bf16* vb = nullptr;
                const int jk = (br == 1) ? 2 : 4;
                if (!smp) { kb = WSP(bf16, WS_KVB) + ((((size_t)(jk - 2) * PB + seq) * 2 + kvh) * PT + p) * 64; vb = kb + (size_t)PB * 2 * PT * 64; }
                else if (p >= PAST) { kb = WSP(bf16, WS_KVS) + ((((size_t)(jk - 2) * SB + seq) * 2 + kvh) * ST + (p - PAST)) * 64; vb = kb + (size_t)SB * 2 * ST * 64; }
                else if (br == 1) { const int page = ((const int*)F.a->in[I_PT])[seq * NPG + (p >> 7)]; kf = FIN(I_CACHE) + ((((size_t)page * PAGE + (p & 127)) * 4 + 2) * 2 + kvh) * 64; vf = kf + 128; }
                else { kf = FIN(I_CWIN) + ((((size_t)seq * WINB + (p - (PAST - WINB))) * 2 + 0) * 2 + kvh) * 64; vf = kf + 128; }
                float a = 0.f; for (int d = 0; d < 64; ++d) a += Q[hr * 64 + d] * (kb ? bf1(kb[d]) : bfr(kf[d]));
                const float vv = vb ? bf1(vb[lane]) : bfr(vf[lane]);
                const float mn = fmaxf(mx, a), al = exp2f(mx - mn), e = exp2f(a - mn); den = den * al + e; o = o * al + e * vv; mx = mn;
            }
            OUT[(br * 4 + hr) * 64 + lane] = (den > 0.f) ? o / den : 0.f;
        }
        LDS_WAIT(); asm volatile("" ::: "memory");
        bool bad = false;
        for (int hr = 0; hr < 4; ++hr) { const float* ng = WSP(float, WS_NG) + row * 24 + (kvh * 4 + hr) * 3;
            const float e = ng[0] * OUT[(0 * 4 + hr) * 64 + lane] + ng[1] * OUT[(1 * 4 + hr) * 64 + lane] + ng[2] * OUT[(2 * 4 + hr) * 64 + lane];
            bad = bad || dbg_bad(bf1(WSP(bf16, WS_OA)[row * 512 + (kvh * 4 + hr) * 64 + lane]), e, 0.04f, 0.004f); }
        DBG_FLAG(smp ? 5 : 4, bad);
        LDS_WAIT(); asm volatile("" ::: "memory");
    }
    for (int s = gw; s < 96; s += NGW) {
        const unsigned r = dbg_rand(6000u + s); const bool smp = (s % 3) == 2; const int h = (r >> 3) & 3; const float lg = ret_log_g(h);
        const bf16* RQ = WSP(bf16, WS_RQ); const bf16* RK = RQ + (size_t)MT * 512; const bf16* RV = RQ + (size_t)2 * MT * 512; const bf16* RG = RQ + (size_t)3 * MT * 512;
        int seq, t; size_t row0; if (smp) { seq = (r >> 5) % SB; t = (r >> 10) % ST; row0 = (size_t)PM + seq * ST; } else { seq = (r >> 5) % PB; const unsigned k = (r >> 8) % 4u; t = (k == 0) ? (int)((r >> 12) % 300) : (int)((r >> 12) % PT); row0 = (size_t)seq * PT; }
        float o0 = 0.f, o1 = 0.f;
        for (int d = lane; d < 128; d += 64) L[d] = bf1(RQ[(row0 + t) * 512 + h * 128 + d]);
        LDS_WAIT(); asm volatile("" ::: "memory");
        for (int j = 0; j <= t; ++j) { float a = 0.f; for (int d = 0; d < 128; ++d) a += L[d] * bf1(RK[(row0 + j) * 512 + h * 128 + d]);
            a *= expf((float)(t - j) * lg); o0 += a * bf1(RV[(row0 + j) * 512 + h * 128 + lane]); o1 += a * bf1(RV[(row0 + j) * 512 + h * 128 + 64 + lane]); }
        if (smp) { const float* S0 = FIN(I_SRET) + (((size_t)0 * SB + seq) * 4 + h) * 16384; const float cr = expf((float)(t + 1) * lg);
            for (int d = 0; d < 128; ++d) { o0 += L[d] * S0[d * 128 + lane] * cr; o1 += L[d] * S0[d * 128 + 64 + lane] * cr; } }
        const float mean = wave_sum(o0 + o1) * (1.0f / 128.0f); const float var = wave_sum((o0 - mean) * (o0 - mean) + (o1 - mean) * (o1 - mean)) * (1.0f / 128.0f), rstd = 1.0f / sqrtf(var + EPS);
        const float* GN = FIN(I_GNG) + h * 128; const bf16* OR_ = WSP(bf16, WS_OA) + (size_t)MT * 512;
        const float g0 = bf1(RG[(row0 + t) * 512 + h * 128 + lane]), g1 = bf1(RG[(row0 + t) * 512 + h * 128 + 64 + lane]);
        const float e0 = (o0 - mean) * rstd * GN[lane] * (g0 / (1.0f + expf(-g0))), e1 = (o1 - mean) * rstd * GN[64 + lane] * (g1 / (1.0f + expf(-g1)));
        DBG_FLAG(6, dbg_bad(bf1(OR_[(row0 + t) * 512 + h * 128 + lane]), e0, 0.04f, 0.02f) || dbg_bad(bf1(OR_[(row0 + t) * 512 + h * 128 + 64 + lane]), e1, 0.04f, 0.02f));
        const int d = (r >> 20) % 128, T = smp ? ST : PT; float s0 = 0.f, s1 = 0.f;
        for (int j = 0; j < T; ++j) { const float kk = bf1(RK[(row0 + j) * 512 + h * 128 + d]) * expf((float)(T - 1 - j) * lg); s0 += kk * bf1(RV[(row0 + j) * 512 + h * 128 + lane]); s1 += kk * bf1(RV[(row0 + j) * 512 + h * 128 + 64 + lane]); }
        const float* SO;
        if (smp) { const float* S0 = FIN(I_SRET) + (((size_t)0 * SB + seq) * 4 + h) * 16384; const float g8 = expf(8.0f * lg); s0 += g8 * S0[d * 128 + lane]; s1 += g8 * S0[d * 128 + 64 + lane]; SO = F.out + OUT_RET_S + (((size_t)0 * SB + seq) * 4 + h) * 16384; }
        else SO = F.out + OUT_RET_P + (((size_t)0 * PB + seq) * 4 + h) * 16384;
        DBG_FLAG(7, dbg_bad(SO[d * 128 + lane], s0, 0.02f, 0.02f) || dbg_bad(SO[d * 128 + 64 + lane], s1, 0.02f, 0.02f));
        LDS_WAIT(); asm volatile("" ::: "memory");
    }
    for (int s = gw; s < 48; s += NGW) {
        const unsigned r = dbg_rand(8000u + s); const bool smp = (s % 3) == 2; const int blk = (r >> 3) & 7, c = blk * 64 + lane;
        int seq, T; size_t row0; if (smp) { seq = (r >> 6) % SB; T = ST; row0 = (size_t)PM + seq * ST; } else { seq = (r >> 6) % PB; T = 1 + (int)((r >> 10) % ((s & 1) ? 200 : PT)); row0 = (size_t)seq * PT; }
        const float* RX = WSP(float, WS_RX); const float* cw = FIN(I_RCW); const float cb = FIN(I_RCB)[c];
        float x3 = 0.f, x2 = 0.f, x1 = 0.f, h = 0.f;
        if (smp) { const float* cv = FIN(I_SCONV) + (size_t)seq * 3 * 512; x3 = cv[c]; x2 = cv[512 + c]; x1 = cv[1024 + c]; h = FIN(I_SH)[(size_t)seq * 512 + c]; }
        const float sp = log1pf(expf(-FIN(I_LAM)[c])); const float* wa = FIN(I_RWA) + (size_t)blk * 4096; const float* wx = FIN(I_RWX) + (size_t)blk * 4096;
        for (int t = 0; t < T; ++t) { const float x0 = RX[(row0 + t) * 512 + c]; const float xc = cb + cw[c] * x3 + cw[512 + c] * x2 + cw[1024 + c] * x1 + cw[1536 + c] * x0; x3 = x2; x2 = x1; x1 = x0;
            L[lane] = xc; LDS_WAIT(); asm volatile("" ::: "memory");
            float ra = FIN(I_RBA)[c], ri = FIN(I_RBX)[c]; for (int i = 0; i < 64; ++i) { ra += L[i] * wa[i * 64 + lane]; ri += L[i] * wx[i * 64 + lane]; }
            LDS_WAIT(); asm volatile("" ::: "memory");
            const float rr = 1.0f / (1.0f + expf(-ra)), ii = 1.0f / (1.0f + expf(-ri)), la = -8.0f * rr * sp, a = expf(la); h = a * h + sqrtf(-expm1f(2.0f * la)) * (ii * xc); }
        const size_t o = (row0 + T - 1) * 512 + c; const float e = h * bf1(WSP(bf16, WS_GG)[o]);
        DBG_FLAG(8, dbg_bad(bf1((WSP(bf16, WS_OA) + (size_t)2 * MT * 512)[o]), e, 0.04f, 0.01f));
    }
    for (int s = gw; s < 512; s += NGW) {
        const unsigned r = dbg_rand(9000u + s); const int row = dbg_row(r), col = (r >> 7) % DM;
        float e = 0.f;
        for (int br = 0; br < 3; ++br) { const bf16* O = WSP(bf16, WS_OA) + (size_t)br * MT * 512 + (size_t)row * 512; const float* W = FIN(br == 0 ? I_WBRA : (br == 1 ? I_WBRB : I_WBRC));
            float a = 0.f; for (int k = lane; k < 512; k += 64) a += bf1(O[k]) * bfr(W[(size_t)k * DM + col]); a = wave_sum(a); e += bf1(WSP(bf16, WS_MGS)[(size_t)row * 3072 + br * 1024 + col]) * a; }
        DBG_FLAG(20, dbg_bad(bf1(WSP(bf16, WS_MRG)[(size_t)row * DM + col]), e, 0.03f, 0.01f));
        const float* mod = WSP(float, WS_MOD) + (size_t)row_bb(row) * 6144;
        { float a = 0.f; for (int k = lane; k < DM; k += 64) a += bf1(WSP(bf16, WS_MRG)[(size_t)row * DM + k]) * bfr(FIN(I_WOUT)[(size_t)k * DM + col]); a = wave_sum(a);
          const float ex = xrow_in(F, 0, row)[col] + mod[2048 + col] * a; DBG_FLAG(21, dbg_bad(WSP(float, WS_X1)[(size_t)row * DM + col], ex, 0.005f, 0.005f)); }
        { const float* xr = WSP(float, WS_X1) + (size_t)row * DM; float ss = 0.f; for (int d = lane; d < DM; d += 64) ss += xr[d] * xr[d]; const float rs = 1.0f / sqrtf(wave_sum(ss) * (1.0f / DM) + EPS);
          const int c2 = (r >> 9) % NUP; float a = 0.f; for (int d = lane; d < DM; d += 64) a += bfr(xr[d] * rs * FIN(I_N2G)[d] * (1.0f + mod[4096 + d]) + mod[3072 + d]) * bfr(FIN(I_WUP)[(size_t)d * NUP + c2]); a = wave_sum(a);
          const float got = c2 < DFF ? bf1(WSP(bf16, WS_GP)[(size_t)row * DFF + c2]) : bf1((WSP(bf16, WS_GP) + (size_t)MT * DFF)[(size_t)row * DFF + c2 - DFF]); DBG_FLAG(22, dbg_bad(got, a, 0.02f, 0.01f)); }
        { const int c3 = (r >> 11) % DFF; const bf16* GP = WSP(bf16, WS_GP); const bf16* VAL = GP + (size_t)MT * DFF; const float* cw = FIN(I_FCW);
          const bool isp = row < PM; const int t = isp ? (row & (PT - 1)) : ((row - PM) & 7); float xm2, xm1;
          if (t >= 2) { xm2 = bf1(GP[(size_t)(row - 2) * DFF + c3]); xm1 = bf1(GP[(size_t)(row - 1) * DFF + c3]); }
          else if (isp) { xm2 = 0.f; xm1 = (t == 1) ? bf1(GP[(size_t)(row - 1) * DFF + c3]) : 0.f; }
          else { const float* st = FIN(I_SFFN) + ((size_t)((row - PM) >> 3) * 2) * DFF + c3; xm2 = (t == 0) ? st[0] : st[DFF]; xm1 = (t == 0) ? st[DFF] : bf1(GP[(size_t)(row - 1) * DFF + c3]); }
          const float y = FIN(I_FCB)[c3] + cw[c3] * xm2 + cw[DFF + c3] * xm1 + cw[2 * DFF + c3] * bf1(GP[(size_t)row * DFF + c3]); const float ex = (y / (1.0f + expf(-y))) * bf1(VAL[(size_t)row * DFF + c3]);
          DBG_FLAG(23, dbg_bad(bf1((GP + (size_t)2 * MT * DFF)[(size_t)row * DFF + c3]), ex, 0.02f, 0.005f)); }
        { const bf16* ACT = WSP(bf16, WS_GP) + (size_t)2 * MT * DFF + (size_t)row * DFF; float a = 0.f; for (int k = lane; k < DFF; k += 64) a += bf1(ACT[k]) * bfr(FIN(I_WDN)[(size_t)k * DM + col]); a = wave_sum(a);
          const float ex = WSP(float, WS_X1)[(size_t)row * DM + col] + mod[5120 + col] * a; DBG_FLAG(24, dbg_bad(WSP(float, WS_X2)[(size_t)row * DM + col], ex, 0.005f, 0.005f)); }
    }
#undef DBG_FLAG
}
__device__ __forceinline__ void dbg_report_phase(Frame& F) {
    const unsigned* CNT = (const unsigned*)(F.ws + WS_CTL) + 3000;
    const size_t ooff[14] = {OUT_Y, OUT_Y + (size_t)PM * DM, OUT_ROWS_P, OUT_ROWS_S, OUT_WIN_P, OUT_WIN_S, OUT_RET_P, OUT_RET_S, OUT_H_P, OUT_H_S, OUT_CV_P, OUT_CV_S, OUT_FC_P, OUT_FC_S};
    if (F.bid == 0 && F.tid < 14) { const int b = F.tid; const unsigned c = CNT[b]; const int cnt = 1 + (int)(c > 1000u ? 1000u : c);
        for (int i = 0; i < cnt; ++i) ((unsigned*)F.out)[ooff[b] + 7 + 2 * i] = 0xAAAAAAAAu; }
}
#endif

#ifndef DBG_SUB
#define DBG_SUB 0xFFFF
#endif
#ifndef DBG_MAXPH
#define DBG_MAXPH N_PHASES
#endif
#ifndef DBG_REPEAT
#define DBG_REPEAT 0
#endif
#ifndef DBG_MASK
#define DBG_MASK 0xFFFF
#endif
#define IN(k) (lo <= (k) && (k) < hi)
#ifdef DBG_TIME
#define SEAM(k) do { if ((k) + 1 < hi) { if (MK_N_LAUNCHES == 1) xcd_barrier(bar); } if (F.bid == 0 && F.tid == 0) ((unsigned long long*)(F.ws + WS_CTL))[2048 + (k) + 1] = __builtin_amdgcn_s_memrealtime(); } while (0)
#else
#define SEAM(k) do { if ((k) + 1 < hi) { if (MK_N_LAUNCHES == 1) xcd_barrier(bar); } } while (0)
#endif
template <int l> __device__ __forceinline__ void ph_win(Frame& F) { unsigned char* ws = F.ws;
    pg8::Gemm g{(const pg8::bf16_t*)(ws + WS_H), (const pg8::bf16_t*)(ws + WS_WIN) + (size_t)l * NIN * DM, MT, NIN, DM};
    pg8::StaticOrder S; S.init(MT, NIN, F.G, F.bid); EpiWin E{ws, F.out, l};
    pg8::gemm_phase<EpiWin, pg8::StaticOrder, true, true>(F.lds, g, S, E); }
template <int l> __device__ __forceinline__ void ph_mix1(Frame& F) { unsigned char* ws = F.ws;
    if (DBG_SUB & 1) { launder(F);
        pg8::Gemm g{(const pg8::bf16_t*)(ws + WS_ACMP) + (size_t)l * CMP_ROWS * 1024, (const pg8::bf16_t*)(ws + WS_SMALLW + SW_W1T) + (size_t)l * 512 * 1024, CMP_ROWS, 512, 1024};
        CmpOrder S{F.G, F.bid}; EpiLH E{(bf16*)(ws + WS_LH)};
        pg8::gemm_phase<EpiLH, CmpOrder, true, true>(F.lds, g, S, E); }
    if (DBG_SUB & 2) for (int u = F.bid; u < 512; u += F.G) { launder(F); ret_local_unit(F, u); }
    if (DBG_SUB & 4) for (int u = F.bid; u < 256; u += F.G) { launder(F); rglru_unit<0>(F, l, u); } }
template <int l> __device__ __forceinline__ void ph_mix2(Frame& F) { cmp2_phase(F, l); ret_scan_phase(F, l); rglru_carry_phase(F, l); }
constexpr int MQ_PA = 384, MQ_SA = MQ_PA + 64, MQ_PB = MQ_SA + 128, MQ_RG1 = MQ_PB + 256, MQ_RO = MQ_RG1 + 512, MQ_RS = MQ_RO + 128, MQ_RG2 = MQ_RS + 32;
template <int l> __device__ __forceinline__ void ph_mix3(Frame& F) {
    unsigned* ctr = (unsigned*)(F.ws + WS_CTL) + 3200 + l;
    volatile LAS int* QI = (volatile LAS int*)(F.lds + MISC_OFF + 128);
#pragma unroll 1
    for (;;) {
        __syncthreads();
        if (F.tid == 0) QI[0] = (int)__hip_atomic_fetch_add(ctr, 1u, __ATOMIC_RELAXED, __HIP_MEMORY_SCOPE_AGENT);
        __syncthreads();
        const int u = __builtin_amdgcn_readfirstlane(QI[0]);
        if (u >= MQ_RG2) break;
        launder(F);
        if (u < MQ_PA || (u >= MQ_SA && u < MQ_PB)) { const int v = (u < MQ_PA) ? u : u - MQ_SA + MQ_PA; attn_prompt_unit(F, l, (v & 7) * 64 + 63 - (v >> 3)); }
        else if (u < MQ_SA) { attn_sample_unit(F, l, u - MQ_PA); }
        else if (u < MQ_RG1) { rglru_unit<1>(F, l, u - MQ_PB); }
        else if (u < MQ_RO) { ret_out_unit(F, l, u - MQ_RG1); }
        else if (u < MQ_RS) { ret_sample_unit(F, l, u - MQ_RO); }
        else { rglru_unit<2>(F, l, u - MQ_RS); }
    }
    __syncthreads(); }
__device__ __forceinline__ void smp_stage_w(Frame& F, const bf16* Wt4, int K, int slot) {
    LAS bf16* WL = (LAS bf16*)(F.lds + slot * 24576);
    for (int i = F.tid; i < 4 * K / 8; i += NTHR) { const int r = i / (K / 8), c = i % (K / 8); *(LAS v4u*)(WL + r * (K + 8) + c * 8) = *(const v4u*)(Wt4 + (size_t)r * K + c * 8); }
}
__device__ __forceinline__ f32x16 smp_acc(Frame& F, const bf16* A, int K, int slot) {
    const int q = F.lane & 31, h_ = F.lane >> 5; const LAS bf16* WL = (const LAS bf16*)(F.lds + slot * 24576) + (q & 3) * (K + 8) + 8 * h_;
    const bf16* ap = A + (size_t)(F.wave * 32 + q) * K + 8 * h_; f32x16 acc = (f32x16){};
#pragma unroll 16
    for (int kk = 0; kk < K / 16; ++kk) acc = mfma32(*(const bf16x8*)(ap + 16 * kk), *(const LAS bf16x8*)(WL + 16 * kk), acc);
    return acc;
}
template <int l> __device__ __forceinline__ void ph_br(Frame& F) { unsigned char* ws = F.ws;
    const pg8::bf16_t* wbr = (const pg8::bf16_t*)(ws + WS_WBR) + (size_t)l * 3 * 1024 * 512;
    for (int cg = F.bid; cg < 256; cg += F.G) {
        __syncthreads();
#pragma unroll
        for (int br = 0; br < 3; ++br) smp_stage_w(F, wbr + (size_t)br * 1024 * 512 + (size_t)4 * cg * 512, 512, br);
        __syncthreads();
        const f32x16 a0 = smp_acc(F, (const bf16*)(ws + WS_OA) + (size_t)PM * 512, 512, 0), a1 = smp_acc(F, (const bf16*)(ws + WS_OA) + (size_t)(MT + PM) * 512, 512, 1), a2 = smp_acc(F, (const bf16*)(ws + WS_OA) + (size_t)(2 * MT + PM) * 512, 512, 2);
        const int q = F.lane & 31, h_ = F.lane >> 5;
        if (q < 4) { const bf16* MG = (const bf16*)(ws + WS_MGS); bf16* MR = (bf16*)(ws + WS_MRG); const int col = 4 * cg + q;
#pragma unroll
            for (int r = 0; r < 16; ++r) { const size_t row = (size_t)PM + F.wave * 32 + (r & 3) + 8 * (r >> 2) + 4 * h_; const bf16* g = MG + row * 3072 + col;
                MR[row * DM + col] = (bf16)(pk2(bf1(g[0]) * a0[r] + bf1(g[1024]) * a1[r] + bf1(g[2048]) * a2[r], 0.f) & 0xffffu); } }
    }
    __syncthreads();
    pg8::StaticOrder S; S.init(PM, DM, F.G, F.bid);
    { pg8::Gemm g{(const pg8::bf16_t*)(ws + WS_OA), wbr, PM, DM, 512}; EpiBr<0> E{ws}; pg8::gemm_phase<EpiBr<0>, pg8::StaticOrder, true, true>(F.lds, g, S, E); }
    { launder(F); pg8::Gemm g{(const pg8::bf16_t*)(ws + WS_OA) + (size_t)MT * 512, wbr + (size_t)1024 * 512, PM, DM, 512}; EpiBr<1> E{ws}; pg8::gemm_phase<EpiBr<1>, pg8::StaticOrder, true, true>(F.lds, g, S, E); }
    { launder(F); pg8::Gemm g{(const pg8::bf16_t*)(ws + WS_OA) + (size_t)2 * MT * 512, wbr + (size_t)2 * 1024 * 512, PM, DM, 512}; EpiBr<2> E{ws}; pg8::gemm_phase<EpiBr<2>, pg8::StaticOrder, true, true>(F.lds, g, S, E); } }
__device__ __forceinline__ void smp_res(Frame& F, const bf16* A, const bf16* Wt, int K, const float* xin  , float* xout  , const float* mod, int gofs) {
    for (int cg = F.bid; cg < 256; cg += F.G) {
        __syncthreads(); smp_stage_w(F, Wt + (size_t)4 * cg * K, K, 0); __syncthreads();
        const f32x16 a = smp_acc(F, A, K, 0); const int q = F.lane & 31, h_ = F.lane >> 5;
        if (q < 4) { const int col = 4 * cg + q;
#pragma unroll
            for (int r = 0; r < 16; ++r) { const int rr = F.wave * 32 + (r & 3) + 8 * (r >> 2) + 4 * h_; xout[(size_t)rr * DM + col] = xin[(size_t)rr * DM + col] + mod[(size_t)(4 + (rr >> 3)) * 6144 + gofs + col] * a[r]; } }
    }
    __syncthreads();
}
template <int l> __device__ __forceinline__ void ph_out(Frame& F) { unsigned char* ws = F.ws;
    const float* mod = (const float*)(ws + WS_MOD) + (size_t)l * 36 * 6144;
    smp_res(F, (const bf16*)(ws + WS_MRG) + (size_t)PM * DM, (const bf16*)(ws + WS_WOUT) + (size_t)l * DM * DM, DM, l == 0 ? FIN(I_XS) : (const float*)(ws + WS_X2) + (size_t)PM * DM, (float*)(ws + WS_X1) + (size_t)PM * DM, mod, 2048);
    pg8::Gemm g{(const pg8::bf16_t*)(ws + WS_MRG), (const pg8::bf16_t*)(ws + WS_WOUT) + (size_t)l * DM * DM, PM, DM, DM};
    pg8::StaticOrder S; S.init(PM, DM, F.G, F.bid);
    EpiRes E{l == 0 ? FIN(I_XP) : (const float*)(ws + WS_X2), nullptr, (float*)(ws + WS_X1), mod, 2048};
    pg8::gemm_phase<EpiRes, pg8::StaticOrder, true, true>(F.lds, g, S, E); }
template <int l> __device__ __forceinline__ void ph_down(Frame& F) { unsigned char* ws = F.ws;
    const float* mod = (const float*)(ws + WS_MOD) + (size_t)l * 36 * 6144;
    smp_res(F, (const bf16*)(ws + WS_GP) + (size_t)2 * MT * DFF + (size_t)PM * DFF, (const bf16*)(ws + WS_WDN) + (size_t)l * DM * DFF, DFF, (const float*)(ws + WS_X1) + (size_t)PM * DM, (float*)(ws + WS_X2) + (size_t)PM * DM, mod, 5120);
    pg8::Gemm g{(const pg8::bf16_t*)(ws + WS_GP) + (size_t)2 * MT * DFF, (const pg8::bf16_t*)(ws + WS_WDN) + (size_t)l * DM * DFF, PM, DM, DFF};
    pg8::StaticOrder S; S.init(PM, DM, F.G, F.bid);
    EpiRes E{(const float*)(ws + WS_X1), nullptr, (float*)(ws + WS_X2), mod, 5120};
    pg8::gemm_phase<EpiRes, pg8::StaticOrder, true, true>(F.lds, g, S, E); }
template <int l> __device__ __forceinline__ void ph_up(Frame& F) { unsigned char* ws = F.ws;
    pg8::Gemm g{(const pg8::bf16_t*)(ws + WS_H), (const pg8::bf16_t*)(ws + WS_WUP) + (size_t)l * NUP * DM, MT, NUP, DM};
    pg8::StaticOrder S; S.init(MT, NUP, F.G, F.bid); EpiUp E{ws, F.out, l};
    pg8::gemm_phase<EpiUp, pg8::StaticOrder, true, true>(F.lds, g, S, E); }
#define RUNPH(bit, ph, CALL) do { if (((DBG_MASK >> (bit)) & 1) && IN(ph)) { launder(F); CALL; if ((DBG_REPEAT >> (bit)) & 1) { launder(F); CALL; } SEAM(ph); } } while (0)
template <int l> __device__ __forceinline__ void layer_phases(Frame& F, const XcdBarrier& bar, int lo, int hi) {
    constexpr int pb = PH_L0 + l * PH_PER_LAYER;
    RUNPH(1, pb + LP_N1, norm_phase(F, l, 0));
    RUNPH(2, pb + LP_WIN, ph_win<l>(F));
    RUNPH(3, pb + LP_MIX1, ph_mix1<l>(F));
    RUNPH(4, pb + LP_MIX2, ph_mix2<l>(F));
    RUNPH(5, pb + LP_MIX3, ph_mix3<l>(F));
    RUNPH(6, pb + LP_BR, ph_br<l>(F));
    RUNPH(7, pb + LP_OUT, ph_out<l>(F));
    RUNPH(8, pb + LP_N2, norm_phase(F, l, 1));
    RUNPH(9, pb + LP_UP, ph_up<l>(F));
    RUNPH(10, pb + LP_CONV, convact_phase(F, l));
    RUNPH(11, pb + LP_DOWN, ph_down<l>(F));
}
__global__ void __launch_bounds__(NTHR, 2) trunk_fwd(Args args) {
    extern __shared__ __attribute__((aligned(16))) unsigned char lds_raw[];
    Frame F;
    F.lds = (LAS unsigned char*)lds_raw;
    F.tid = threadIdx.x; F.lane = F.tid & 63; F.wave = __builtin_amdgcn_readfirstlane(F.tid >> 6);
    F.G = gridDim.x; F.bid = blockIdx.x; F.a = &args; F.ws = args.ws; F.out = args.out;
    volatile LAS unsigned* MISC = (volatile LAS unsigned*)(F.lds + MISC_OFF);
    for (int u = F.tid; u < 64; u += NTHR) MISC[u] = 0u;
    __syncthreads();
    unsigned* barw = (unsigned*)(F.ws + WS_CTL) + CW_BAR;
    XcdBarrier bar; bar.bar = barw; bar.x = 0; bar.st = nullptr;
    if (MK_N_LAUNCHES == 1) bar = xcd_barrier_post(barw, MISC + 8);
    const int lo = args.ph_lo, hi = args.ph_hi;
    unsigned char* ws = F.ws;

#ifdef DBG_TIME
    if (F.bid == 0 && F.tid == 0) ((unsigned long long*)(F.ws + WS_CTL))[2048] = __builtin_amdgcn_s_memrealtime();
#endif
    RUNPH(0, PH_P0, p0_prologue(F));

    layer_phases<0>(F, bar, lo, hi);
    layer_phases<1>(F, bar, lo, hi);
    if (((DBG_MASK >> 12) & 1) && IN(PH_FINAL)) { launder(F); final_phase(F); if ((DBG_REPEAT >> 12) & 1) { launder(F); final_phase(F); } }
#ifdef DBG_TIME
    {
        xcd_barrier(bar);
        if (F.bid == 0 && F.tid < 14) {
            const unsigned long long* ts = (const unsigned long long*)(F.ws + WS_CTL) + 2048; const unsigned long long tend = __builtin_amdgcn_s_memrealtime();
            const size_t ooff[14] = {OUT_Y, OUT_Y + (size_t)PM * DM, OUT_ROWS_P, OUT_ROWS_S, OUT_WIN_P, OUT_WIN_S, OUT_RET_P, OUT_RET_S, OUT_H_P, OUT_H_S, OUT_CV_P, OUT_CV_S, OUT_FC_P, OUT_FC_S};
            const int b = F.tid; unsigned long long d;
            if (b == 0) d = tend - ts[0]; else if (b == 1) d = ts[1] - ts[0]; else if (b == 13) d = tend - ts[PH_FINAL];
            else { const int ph = PH_L0 + DBG_TIME_LAYER * PH_PER_LAYER + (b - 2); d = ts[ph + 1] - ts[ph]; }
            int cnt = (int)(d / 100ull); if (cnt < 1) cnt = 1; if (cnt > 2000 && b != 0) cnt = 2000;
            for (int i = 0; i < cnt; ++i) ((unsigned*)F.out)[ooff[b] + 7 + 2 * i] = 0xAAAAAAAAu;
        }
    }
#endif
#ifdef DBG_COUNT
    {
        xcd_barrier(bar);
        if (F.bid == 0 && F.tid < 3) { const unsigned* CNT = (const unsigned*)(F.ws + WS_CTL) + 3000; const size_t ooff[3] = {OUT_Y, OUT_Y + (size_t)PM * DM, OUT_ROWS_P};
            const int cnt = (int)((unsigned long long)CNT[F.tid] * 10ull / (CNT[3] ? CNT[3] : 1u)); for (int i = 0; i < cnt; ++i) ((unsigned*)F.out)[ooff[F.tid] + 7 + 2 * i] = 0xAAAAAAAAu; }
    }
#endif
#ifdef DBG_CHECK
    if (lo == 100) { launder(F); dbg_check_phase(F); }
    if (lo == 101) { for (size_t i = (size_t)F.bid * NTHR + F.tid; i < OUT_END; i += (size_t)F.G * NTHR) F.out[i] = 0.f; }
    if (lo == 102) { launder(F); dbg_report_phase(F); }
#endif
}

extern "C" void kernel_launch(void* const* d_in, const int* in_sizes, int n_in, void* d_out, int out_size, void* d_ws, size_t ws_size, hipStream_t stream) {
    static int grid = 0;
    if (grid == 0) {
        if (n_in != 37 || (size_t)out_size != OUT_END || ws_size < WS_END) { fprintf(stderr, "kernel_launch: unexpected shapes: n_in %d out %d (want %zu) ws %zu (want %zu)\n", n_in, out_size, (size_t)OUT_END, ws_size, (size_t)WS_END); grid = -1; return; }
        int dev = 0, cus = 0, per_cu = 0;
        if (hipGetDevice(&dev) != hipSuccess || hipDeviceGetAttribute(&cus, hipDeviceAttributeMultiprocessorCount, dev) != hipSuccess) { grid = -1; return; }
        if (hipFuncSetAttribute((const void*)trunk_fwd, hipFuncAttributeMaxDynamicSharedMemorySize, LDS_BYTES) != hipSuccess) { fprintf(stderr, "kernel_launch: hipFuncSetAttribute failed\n"); grid = -1; return; }
        if (hipOccupancyMaxActiveBlocksPerMultiprocessor(&per_cu, (const void*)trunk_fwd, NTHR, LDS_BYTES) != hipSuccess || per_cu < 1) fprintf(stderr, "kernel_launch: occupancy query reports %d\n", per_cu);
        (void)hipGetLastError();
        grid = cus;
    }
    if (grid < 0) return;
    if (hipMemsetAsync((char*)d_ws + WS_CTL, 0, CTL_ZERO_BYTES, stream) != hipSuccess) return;
#ifdef DBG_POISON
    (void)hipMemsetAsync((char*)d_ws + CTL_ZERO_BYTES, 0xAA, WS_END - CTL_ZERO_BYTES, stream);
    (void)hipMemsetAsync(d_out, 0xAA, (size_t)OUT_END * 4, stream);
#endif
    Args a{};
    for (int i = 0; i < 37; ++i) a.in[i] = d_in[i];
    a.out = (float*)d_out; a.ws = (unsigned char*)d_ws;
#if MK_N_LAUNCHES == 1
    a.ph_lo = 0; a.ph_hi = N_PHASES;
    hipLaunchKernelGGL(trunk_fwd, dim3(grid), dim3(NTHR), LDS_BYTES, stream, a);
#else
    for (int p = 0; p < DBG_MAXPH; ++p) { a.ph_lo = p; a.ph_hi = p + 1; hipLaunchKernelGGL(trunk_fwd, dim3(grid), dim3(NTHR), LDS_BYTES, stream, a); }
#ifdef DBG_CHECK
    for (int p = 100; p < 103; ++p) { a.ph_lo = p; a.ph_hi = p + 1; hipLaunchKernelGGL(trunk_fwd, dim3(grid), dim3(NTHR), LDS_BYTES, stream, a); }
#endif
#endif
    (void)in_sizes;
}
```

```cpp
#include <hip/hip_runtime.h>
#include <cstdio>
#include <cstdint>

#ifndef MK_N_LAUNCHES
#define MK_N_LAUNCHES 1
#endif

constexpr int DM = 1024, PB = 4, PT = 4096, PM = PB * PT, SB = 32, ST = 8, SM = SB * ST, MT = PM + SM;
constexpr int DEPTH = 2, PAST = 8192, PAGE = 128, NPG = PAST / PAGE, NPHYS = 2560;
constexpr int D_IN = 7448, NIN = 7680, DFF = 2816, NUP = 2 * DFF;
constexpr int WINB = 512;
constexpr float EPS = 1e-6f;
constexpr float QSCALE = 0.125f * 1.4426950408889634f;

constexpr int O_NQ = 0, O_NKV = 512, O_NG = 1280, O_RQ = 1304, O_RK = 1816, O_RV = 2328, O_RG = 2840, O_RX = 3352, O_RGATE = 3864, O_MG = 4376;

constexpr size_t OUT_Y = 0;
constexpr size_t OUT_ROWS_P = OUT_Y + (size_t)MT * DM;
constexpr size_t OUT_ROWS_S = OUT_ROWS_P + (size_t)DEPTH * PM * 512;
constexpr size_t OUT_WIN_P = OUT_ROWS_S + (size_t)DEPTH * SM * 512;
constexpr size_t OUT_WIN_S = OUT_WIN_P + (size_t)DEPTH * PB * WINB * 256;
constexpr size_t OUT_RET_P = OUT_WIN_S + (size_t)DEPTH * SB * WINB * 256;
constexpr size_t OUT_RET_S = OUT_RET_P + (size_t)DEPTH * PB * 4 * 16384;
constexpr size_t OUT_H_P = OUT_RET_S + (size_t)DEPTH * SB * 4 * 16384;
constexpr size_t OUT_H_S = OUT_H_P + (size_t)DEPTH * PB * 512;
constexpr size_t OUT_CV_P = OUT_H_S + (size_t)DEPTH * SB * 512;
constexpr size_t OUT_CV_S = OUT_CV_P + (size_t)DEPTH * PB * 3 * 512;
constexpr size_t OUT_FC_P = OUT_CV_S + (size_t)DEPTH * SB * 3 * 512;
constexpr size_t OUT_FC_S = OUT_FC_P + (size_t)DEPTH * PB * 2 * DFF;
constexpr size_t OUT_END = OUT_FC_S + (size_t)DEPTH * SB * 2 * DFF;

constexpr size_t MiB = 1u << 20;
constexpr size_t WS_CTL = 0, CTL_ZERO_BYTES = 4 * MiB;
constexpr size_t WS_MOD = 1 * MiB;
constexpr size_t WS_ROT = 4 * MiB;
constexpr size_t WS_SMALLW = 8 * MiB;
constexpr size_t WS_WIN = 16 * MiB;
constexpr size_t WS_WBR = WS_WIN + (size_t)2 * NIN * DM * 2;
constexpr size_t WS_WOUT = WS_WBR + (size_t)2 * 3 * 1024 * 512 * 2;
constexpr size_t WS_WUP = WS_WOUT + (size_t)2 * 1024 * 1024 * 2;
constexpr size_t WS_WDN = WS_WUP + (size_t)2 * NUP * DM * 2;
constexpr size_t WS_WEND = WS_WDN + (size_t)2 * DM * DFF * 2;
constexpr size_t WS_H = 128 * MiB;
constexpr size_t WS_QN = WS_H + (size_t)MT * DM * 2;
constexpr size_t WS_KVB = WS_QN + (size_t)MT * 512 * 2;
constexpr size_t WS_KVS = WS_KVB + (size_t)4 * PB * 2 * PT * 64 * 2;
constexpr size_t WS_RQ = WS_KVS + (size_t)4 * SB * 2 * ST * 64 * 2;
constexpr size_t WS_RX = WS_RQ + (size_t)4 * MT * 512 * 2;
constexpr size_t WS_GG = WS_RX + (size_t)MT * 512 * 4;
constexpr size_t WS_MGS = WS_GG + (size_t)MT * 512 * 2;
constexpr size_t WS_NG = WS_MGS + (size_t)MT * 3072 * 2;
constexpr size_t WS_OA = WS_NG + (size_t)MT * 24 * 4;
constexpr size_t WS_MRG = WS_OA + (size_t)3 * MT * 512 * 2;
constexpr size_t WS_X1 = WS_MRG + (size_t)MT * DM * 2;
constexpr size_t WS_X2 = WS_X1 + (size_t)MT * DM * 4;
constexpr size_t WS_GP = WS_X2 + (size_t)MT * DM * 4;
constexpr size_t WS_ACMP = WS_GP + (size_t)3 * MT * DFF * 2;
constexpr int CMP_ROWS_J = 34816, CMP_ROWS = 2 * CMP_ROWS_J;
constexpr size_t WS_LH = WS_ACMP + (size_t)2 * CMP_ROWS * 1024 * 2 + 4096;
constexpr size_t WS_CK = WS_LH + (size_t)(CMP_ROWS + 16) * 256 * 2;
constexpr size_t WS_LT = WS_CK + (size_t)CMP_ROWS * 64 * 2;
constexpr size_t WS_SPT = WS_LT + (size_t)16 * 32 * 16384 * 4;
constexpr size_t WS_CAR = WS_SPT + (size_t)16 * 32 * 16384 * 2;
constexpr size_t WS_END = WS_CAR + (size_t)4 * 64 * 3 * 512 * 4 + MiB;
static_assert(WS_WEND <= WS_H, "weights fit below WS_H");

constexpr size_t SW_W1T = 0;
constexpr size_t SW_W2T = SW_W1T + (size_t)2 * 2 * 256 * 1024 * 2;
constexpr size_t SW_CB = SW_W2T + (size_t)2 * 2 * 64 * 128 * 2;
constexpr size_t SW_WAT = SW_CB + (size_t)2 * 2 * 128 * 4;
constexpr size_t SW_SP = SW_WAT + (size_t)2 * 2 * 8 * 64 * 64 * 2;
constexpr size_t SW_END = SW_SP + 2 * 512 * 4;
static_assert(SW_END <= 8 * MiB, "small weights fit");

constexpr int CW_TMO = 0;
constexpr int CW_BAR = 4096;

constexpr int PH_P0 = 0, PH_L0 = 1, PH_PER_LAYER = 11, PH_FINAL = PH_L0 + DEPTH * PH_PER_LAYER, N_PHASES = PH_FINAL + 1;
enum { LP_N1 = 0, LP_WIN, LP_MIX1, LP_MIX2, LP_MIX3, LP_BR, LP_OUT, LP_N2, LP_UP, LP_CONV, LP_DOWN };

constexpr int RING_BYTES = 131072;
constexpr int MISC_OFF = RING_BYTES;
constexpr int LDS_BYTES = RING_BYTES + 1024;
constexpr int NWAVES = 8, NTHR = 512;

#define GAS __attribute__((address_space(1)))
#define LAS __attribute__((address_space(3)))
typedef unsigned short bf16;
typedef unsigned v4u __attribute__((ext_vector_type(4)));
typedef unsigned v2u __attribute__((ext_vector_type(2)));
typedef float f32x16 __attribute__((ext_vector_type(16)));
typedef short s16x4 __attribute__((ext_vector_type(4)));
namespace pg8 {
#define PG8_LAS __attribute__((address_space(3)))
typedef unsigned short bf16_t;
typedef short bf16x8 __attribute__((ext_vector_type(8)));
typedef float f32x4 __attribute__((ext_vector_type(4)));
typedef unsigned u32x4 __attribute__((ext_vector_type(4)));
constexpr int BM = 256, BK = 64, HALF = 128, HTB = HALF * BK * 2  , STAGE_BYTES = 8 * HTB, NXCD = 8, WGM = 8;

__host__ __device__ __forceinline__ int lds_byte(int r, int c) { const int st = (r >> 4) * 2 + (c >> 5), rr = r & 15, cc = c & 31, ob = rr * 64 + cc * 2; return st * 1024 + (ob ^ (((ob >> 9) & 1) << 5)); }
__host__ __device__ __forceinline__ void stage_rc(int b, int& R, int& C) { const int st = b / 1024, sb = b % 1024, swz = sb ^ (((sb >> 9) & 1) << 5); R = (st >> 1) * 16 + swz / 64; C = (st & 1) * 32 + (swz % 64) / 2; }
__host__ __device__ __forceinline__ int perm32(int rho) { const int n = rho >> 4, i = rho & 15; return 8 * (i >> 2) + 4 * n + (i & 3); }

struct Unit { int pm, pn; };
struct Gemm { const bf16_t* A; const bf16_t* Bt; int M, N, K; };

struct StaticOrder {
    int nM, nN, nwg, G, c;
    __host__ __device__ void init(int M, int N, int G_, int c_) { nM = M / BM; nN = N / BM; nwg = nM * nN; G = G_; c = c_; }
    __host__ __device__ bool next(int i, Unit& u) const {
        const long L = (long)i * G + c; if (L >= nwg) return false;
        int wgid = (int)L; { const int q = nwg / NXCD, r = nwg % NXCD, xcd = wgid % NXCD, off = wgid / NXCD; wgid = (xcd < r ? xcd * (q + 1) : r * (q + 1) + (xcd - r) * q) + off; }
        const int nig = WGM * nN, gid = wgid / nig, fm = gid * WGM, gsz = (nM - fm) < WGM ? (nM - fm) : WGM;
        u.pm = fm + ((wgid % nig) % gsz); u.pn = (wgid % nig) / gsz; return true;
    }
    __device__ __forceinline__ void a_ready(const Unit&) const {}
    __device__ __forceinline__ void done(const Unit&) const {}
};
__device__ __forceinline__ unsigned cvt_pk_bf16(float lo, float hi) { unsigned r; asm volatile("v_cvt_pk_bf16_f32 %0, %1, %2" : "=v"(r) : "v"(lo), "v"(hi)); return r; }
typedef float f32x2 __attribute__((ext_vector_type(2)));
template <class Epi, class Sched, bool ALIGN_EPI = false, bool SP2 = false>
__device__ __forceinline__ void gemm_phase(PG8_LAS unsigned char* lds, const Gemm g, const Sched& S, const Epi& E) {
    const int tid = threadIdx.x, wid = __builtin_amdgcn_readfirstlane(tid >> 6), lane = tid & 63, wr = wid >> 2, wc = wid & 3, fr = lane & 15, fq = lane >> 4;
    const int K = g.K, nt = K / BK;
    unsigned voffA[2], voffB[2];
#pragma unroll
    for (int i = 0; i < 2; ++i) { int R, C; stage_rc(tid * 16 + i * 8192, R, C); const int Rb = Epi::PERM ? ((R & ~31) + perm32(R & 31)) : R;
        voffA[i] = (unsigned)(R * K + C) * 2u; voffB[i] = (unsigned)(Rb * K + C) * 2u; }
    const size_t kstep = (size_t)(BK * 2);
    const size_t hstep = (size_t)HALF * K * 2;
    const size_t tstep = 2 * hstep;
    const unsigned ldsw = (unsigned)wid * 1024u;
    const int aoff = lds_byte(wr * 64 + fr, fq * 8), boff = lds_byte(wc * 32 + fr, fq * 8);
#define PG8_SA(b, h) (((b) * 2 + (h)) * HTB)
#define PG8_SB(b, h) ((4 + (b) * 2 + (h)) * HTB)
#define PG8_STAGE(bufoff, gbase, voff) do { _Pragma("unroll") for (int _i = 0; _i < 2; ++_i) \
        __builtin_amdgcn_global_load_lds((const unsigned*)((const char*)(gbase) + (voff)[_i]), (PG8_LAS unsigned*)(lds + (bufoff) + ldsw + _i * 8192), 16, 0, 0); } while (0)
#define PG8_LDA(dst, b, h) do { _Pragma("unroll") for (int m = 0; m < 4; ++m) _Pragma("unroll") for (int k = 0; k < 2; ++k) dst[m][k] = *(const PG8_LAS bf16x8*)(lds + PG8_SA(b, h) + aoff + m * 2048 + k * 1024); } while (0)
#define PG8_LDB(dst, b, h) do { _Pragma("unroll") for (int n = 0; n < 2; ++n) _Pragma("unroll") for (int k = 0; k < 2; ++k) dst[n][k] = *(const PG8_LAS bf16x8*)(lds + PG8_SB(b, h) + boff + n * 2048 + k * 1024); } while (0)
#define PG8_MMA(ai, bj, At, Bt) do { __builtin_amdgcn_s_setprio(1); _Pragma("unroll") for (int m = 0; m < 4; ++m) _Pragma("unroll") for (int n = 0; n < 2; ++n) _Pragma("unroll") for (int k = 0; k < 2; ++k) \
        acc[ai][bj][m][n] = __builtin_amdgcn_mfma_f32_16x16x32_bf16(Bt[n][k], At[m][k], acc[ai][bj][m][n], 0, 0, 0); __builtin_amdgcn_s_setprio(0); } while (0)
#define PG8_WAIT_V(n) asm volatile("s_waitcnt vmcnt(" #n ")" ::: "memory")
#define PG8_WAIT_L(n) asm volatile("s_waitcnt lgkmcnt(" #n ")" ::: "memory")
#define PG8_BAR __builtin_amdgcn_s_barrier()
#define PG8_SCHED __builtin_amdgcn_sched_barrier(0)
    Unit cur, nxt; int ui = 0;
    if (!S.next(0, cur)) return;
    f32x4 acc[2][2][4][2];
#pragma unroll
    for (int a = 0; a < 2; ++a)
#pragma unroll
        for (int b = 0; b < 2; ++b)
#pragma unroll
            for (int m = 0; m < 4; ++m)
#pragma unroll
                for (int n = 0; n < 2; ++n) acc[a][b][m][n] = (f32x4){0.f, 0.f, 0.f, 0.f};
    bf16x8 At[4][2], B0[2][2], B1[2][2];
    const char* cA = (const char*)g.A + (size_t)cur.pm * tstep; const char* cB = (const char*)g.Bt + (size_t)cur.pn * tstep;
    S.a_ready(cur);
    if constexpr (SP2) {
        PG8_STAGE(PG8_SB(0, 0), cB, voffB); PG8_STAGE(PG8_SB(0, 1), cB + hstep, voffB); PG8_STAGE(PG8_SA(0, 0), cA, voffA); PG8_STAGE(PG8_SA(0, 1), cA + hstep, voffA);
        if (wr == 1) PG8_BAR;
        PG8_WAIT_V(2); PG8_BAR;
        PG8_STAGE(PG8_SB(1, 0), cB + kstep, voffB); PG8_STAGE(PG8_SA(1, 0), cA + kstep, voffA); PG8_STAGE(PG8_SB(1, 1), cB + hstep + kstep, voffB);
        PG8_WAIT_V(6); PG8_BAR;
    } else {
        PG8_STAGE(PG8_SB(0, 0), cB, voffB); PG8_STAGE(PG8_SA(0, 0), cA, voffA); PG8_STAGE(PG8_SB(0, 1), cB + hstep, voffB); PG8_STAGE(PG8_SA(0, 1), cA + hstep, voffA);
        if (wr == 1) PG8_BAR;
        PG8_WAIT_V(4); PG8_BAR;
        PG8_STAGE(PG8_SB(1, 0), cB + kstep, voffB); PG8_STAGE(PG8_SA(1, 0), cA + kstep, voffA); PG8_STAGE(PG8_SB(1, 1), cB + hstep + kstep, voffB);
        PG8_WAIT_V(6); PG8_BAR;
    }
    for (;;) {
        const bool has_next = S.next(ui + 1, nxt);
        const char* nA = has_next ? (const char*)g.A + (size_t)nxt.pm * tstep : cA; const char* nB = has_next ? (const char*)g.Bt + (size_t)nxt.pn * tstep : cB;
        for (int t = 0; t < nt; t += 2) {
            const bool last = (t == nt - 2);
            const char* a1 = cA + (size_t)(t + 1) * kstep;
            const char* a2 = last ? nA : cA + (size_t)(t + 2) * kstep; const char* b2 = last ? nB : cB + (size_t)(t + 2) * kstep;
            const char* a3 = a2 + kstep; const char* b3 = b2 + kstep;
            if (last && has_next) S.a_ready(nxt);
            if constexpr (SP2) {
            PG8_LDB(B0, 0, 0); PG8_LDB(B1, 0, 1); PG8_SCHED; PG8_LDA(At, 0, 0); PG8_STAGE(PG8_SA(1, 1), a1 + hstep, voffA);
            PG8_WAIT_V(8); PG8_WAIT_L(0); PG8_BAR; PG8_MMA(0, 0, At, B0); PG8_MMA(0, 1, At, B1); PG8_BAR; PG8_SCHED;
            PG8_LDA(At, 0, 1); PG8_STAGE(PG8_SB(0, 0), b2, voffB); PG8_STAGE(PG8_SB(0, 1), b2 + hstep, voffB); PG8_STAGE(PG8_SA(0, 0), a2, voffA);
            PG8_WAIT_V(8); PG8_WAIT_L(0); PG8_BAR; PG8_MMA(1, 0, At, B0); PG8_MMA(1, 1, At, B1); PG8_BAR; PG8_SCHED;
            PG8_LDB(B0, 1, 0); PG8_LDB(B1, 1, 1); PG8_SCHED; PG8_LDA(At, 1, 0); PG8_STAGE(PG8_SA(0, 1), a2 + hstep, voffA);
            PG8_WAIT_V(8); PG8_WAIT_L(0); PG8_BAR; PG8_MMA(0, 0, At, B0); PG8_MMA(0, 1, At, B1); PG8_BAR; PG8_SCHED;
            PG8_LDA(At, 1, 1); PG8_STAGE(PG8_SB(1, 0), b3, voffB); PG8_STAGE(PG8_SB(1, 1), b3 + hstep, voffB); PG8_STAGE(PG8_SA(1, 0), a3, voffA);
            PG8_WAIT_V(8); PG8_WAIT_L(0); PG8_BAR; PG8_MMA(1, 0, At, B0); PG8_MMA(1, 1, At, B1); PG8_BAR; PG8_SCHED;
            } else {
            PG8_LDB(B0, 0, 0); PG8_SCHED; PG8_LDA(At, 0, 0); PG8_STAGE(PG8_SA(1, 1), a1 + hstep, voffA);
            PG8_WAIT_L(8); PG8_BAR; PG8_WAIT_L(0); PG8_MMA(0, 0, At, B0); PG8_BAR; PG8_SCHED;
            PG8_LDB(B1, 0, 1); PG8_STAGE(PG8_SB(0, 0), b2, voffB);
            PG8_BAR; PG8_WAIT_L(0); PG8_MMA(0, 1, At, B1); PG8_BAR;
            PG8_LDA(At, 0, 1); PG8_STAGE(PG8_SA(0, 0), a2, voffA);
            PG8_BAR; PG8_WAIT_L(0); PG8_MMA(1, 0, At, B0); PG8_BAR; PG8_SCHED;
            PG8_STAGE(PG8_SB(0, 1), b2 + hstep, voffB);
            PG8_WAIT_V(6); PG8_BAR; PG8_MMA(1, 1, At, B1); PG8_BAR;
            PG8_LDB(B0, 1, 0); PG8_SCHED; PG8_LDA(At, 1, 0); PG8_STAGE(PG8_SA(0, 1), a2 + hstep, voffA);
            PG8_WAIT_L(8); PG8_BAR; PG8_WAIT_L(0); PG8_MMA(0, 0, At, B0); PG8_BAR; PG8_SCHED;
            PG8_LDB(B1, 1, 1); PG8_STAGE(PG8_SB(1, 0), b3, voffB);
            PG8_BAR; PG8_WAIT_L(0); PG8_MMA(0, 1, At, B1); PG8_BAR;
            PG8_LDA(At, 1, 1); PG8_STAGE(PG8_SA(1, 0), a3, voffA);
            PG8_BAR; PG8_WAIT_L(0); PG8_MMA(1, 0, At, B0); PG8_BAR; PG8_SCHED;
            PG8_STAGE(PG8_SB(1, 1), b3 + hstep, voffB);
            PG8_WAIT_V(6); PG8_BAR; PG8_MMA(1, 1, At, B1); PG8_BAR;
            }
        }
        if constexpr (ALIGN_EPI) { if (wr == 0) PG8_BAR; }
        if constexpr (!Epi::AFTER_DRAIN) { E(acc, cur, wr, wc, fr, fq); S.done(cur); }
        if (!has_next) break;
#pragma unroll
        for (int a = 0; a < 2; ++a)
#pragma unroll
            for (int b = 0; b < 2; ++b)
#pragma unroll
                for (int m = 0; m < 4; ++m)
#pragma unroll
                    for (int n = 0; n < 2; ++n) acc[a][b][m][n] = (f32x4){0.f, 0.f, 0.f, 0.f};
        cur = nxt; cA = nA; cB = nB; ++ui;
        if constexpr (ALIGN_EPI) { if (wr == 1) PG8_BAR; }
    }
    PG8_WAIT_V(0);
    if constexpr (!ALIGN_EPI) { if (wr == 0) PG8_BAR; }
    PG8_BAR;
    if constexpr (Epi::AFTER_DRAIN) { E.fused(acc, cur, wr, wc, fr, fq, lds, wid, lane); S.done(cur); }
#undef PG8_SA
#undef PG8_SB
#undef PG8_STAGE
#undef PG8_LDA
#undef PG8_LDB
#undef PG8_MMA
#undef PG8_WAIT_V
#undef PG8_WAIT_L
#undef PG8_BAR
#undef PG8_SCHED
}
}

using pg8::bf16x8; using pg8::f32x4; using pg8::u32x4;
#define LDS_WAIT() asm volatile("s_waitcnt lgkmcnt(0)" ::: "memory")
#define VM_WAIT() asm volatile("s_waitcnt vmcnt(0)" ::: "memory")
typedef float f32x2_t __attribute__((ext_vector_type(2))); typedef __bf16 bf16x2_t __attribute__((ext_vector_type(2)));
__device__ __forceinline__ unsigned pk2(float lo, float hi) { f32x2_t v = {lo, hi}; bf16x2_t b = __builtin_convertvector(v, bf16x2_t); return __builtin_bit_cast(unsigned, b); }
__device__ __forceinline__ float bf_lo(unsigned w) { return __uint_as_float(w << 16); }
__device__ __forceinline__ float bf_hi(unsigned w) { return __uint_as_float(w & 0xffff0000u); }
__device__ __forceinline__ float bf1(bf16 b) { return __uint_as_float(((unsigned)b) << 16); }
__device__ __forceinline__ float fexp2(float x) { return __builtin_amdgcn_exp2f(x); }
__device__ __forceinline__ float fexp(float x) { return __builtin_amdgcn_exp2f(x * 1.4426950408889634f); }
__device__ __forceinline__ float frcp(float x) { return __builtin_amdgcn_rcpf(x); }
__device__ __forceinline__ float sigmoidf_(float x) { return frcp(1.0f + fexp(-x)); }
__device__ __forceinline__ float siluf_(float x) { return x * sigmoidf_(x); }
__device__ __forceinline__ float gelu_tanh(float x) {
    const float u = 0.7978845608028654f * (x + 0.044715f * x * x * x);
    const float e = fexp(2.0f * u);
    const float t = 1.0f - 2.0f * frcp(e + 1.0f);
    return 0.5f * x * (1.0f + t);
}
__device__ __forceinline__ float wave_sum(float v) {
#pragma unroll
    for (int o = 1; o < 64; o <<= 1) v += __shfl_xor(v, o);
    return v;
}
__device__ __forceinline__ v4u pack8(const f32x4 a, const f32x4 b) { v4u w; w.x = pk2(a[0], a[1]); w.y = pk2(a[2], a[3]); w.z = pk2(b[0], b[1]); w.w = pk2(b[2], b[3]); return w; }
__device__ __forceinline__ void unpack8(const v4u w, f32x4& a, f32x4& b) { a = (f32x4){bf_lo(w.x), bf_hi(w.x), bf_lo(w.y), bf_hi(w.y)}; b = (f32x4){bf_lo(w.z), bf_hi(w.z), bf_lo(w.w), bf_hi(w.w)}; }

#define XB_TMO      128
#define XB_XCNT(j)  (256  + 64 * (j))
#define XB_XSUB(j)  (1280 + 64 * (j))
#define XB_XGEN(j)  (2304 + 64 * (j))
#define XB_TOP      3328
#define XB_TOPGEN   3392
#define XCD_BAR_WORDS 3456
#define XB_SPIN_CAP (1u << 18)

__device__ __forceinline__ unsigned xb_ld(unsigned* p)              { return __hip_atomic_load(p, __ATOMIC_RELAXED, __HIP_MEMORY_SCOPE_AGENT); }
__device__ __forceinline__ unsigned xb_add(unsigned* p, unsigned v) { return __hip_atomic_fetch_add(p, v, __ATOMIC_RELAXED, __HIP_MEMORY_SCOPE_AGENT); }
__device__ __forceinline__ unsigned xb_xcc_id() { return (unsigned)__builtin_amdgcn_s_getreg((3 << 11) | 20) & 0xFu; }
#define XB_SPIN(cond, bar) do { unsigned _sp = 0; while (cond) { __builtin_amdgcn_s_sleep(1); \
    if ((++_sp & 255u) == 0u) { if (xb_ld(&(bar)[XB_TMO])) break; if (_sp > XB_SPIN_CAP) { atomicAdd(&(bar)[XB_TMO], 1u); break; } } } } while (0)

struct XcdBarrier {
    unsigned* bar; unsigned x;
    volatile LAS unsigned* st;
};

__device__ __forceinline__ XcdBarrier xcd_barrier_post(unsigned* bar, volatile LAS unsigned* st) {
    XcdBarrier b; b.bar = bar; b.x = xb_xcc_id(); b.st = st;
    if (threadIdx.x == 0) (void)xb_add(&bar[XB_XCNT(b.x)], 1u);
    return b;
}
__device__ __forceinline__ void xcd_barrier_complete(unsigned* bar, unsigned x, unsigned& nloc, unsigned& nx) {
    const unsigned G = gridDim.x * gridDim.y * gridDim.z;
    unsigned sum, cnt, mine, sp = 0u;
    for (;;) {
        sum = 0u; cnt = 0u; mine = 0u;
#pragma unroll
        for (unsigned j = 0; j < 16; ++j) { const unsigned c = xb_ld(&bar[XB_XCNT(j)]); sum += c; cnt += (c > 0u) ? 1u : 0u; mine = (j == x) ? c : mine; }
        if (sum == G) break;
        __builtin_amdgcn_s_sleep(1);
        if ((++sp & 255u) == 0u) { if (xb_ld(&bar[XB_TMO])) break; if (sp > XB_SPIN_CAP) { atomicAdd(&bar[XB_TMO], 1u); break; } }
    }
    nloc = mine > 0u ? mine : 1u; nx = cnt > 0u ? cnt : 1u;
}

__device__ __forceinline__ void xcd_barrier(const XcdBarrier& b) {
    asm volatile("s_waitcnt vmcnt(0)" ::: "memory");
    __syncthreads();
    if (threadIdx.x == 0) {
        unsigned* bar = b.bar;
        __builtin_amdgcn_s_waitcnt(0);
        unsigned nloc = b.st[0], nx = b.st[1];
        if (nloc == 0u) { xcd_barrier_complete(bar, b.x, nloc, nx); b.st[0] = nloc; b.st[1] = nx; }
        const unsigned old = xb_add(&bar[XB_XSUB(b.x)], 1u);
        const unsigned gen = old / nloc;
        if (old + 1u == (gen + 1u) * nloc) {
            __builtin_amdgcn_fence(__ATOMIC_RELEASE, "agent");
            asm volatile("s_waitcnt vmcnt(0)" ::: "memory");
            const unsigned og = xb_add(&bar[XB_TOP], 1u);
            const unsigned tg = og / nx;
            if (og + 1u == (tg + 1u) * nx) xb_add(&bar[XB_TOPGEN], 1u);
            else XB_SPIN(xb_ld(&bar[XB_TOPGEN]) == tg, bar);
            __builtin_amdgcn_fence(__ATOMIC_ACQUIRE, "agent");
            xb_add(&bar[XB_XGEN(b.x)], 1u);
            asm volatile("s_waitcnt vmcnt(0)" ::: "memory");
        } else {
            XB_SPIN(xb_ld(&bar[XB_XGEN(b.x)]) == gen, bar);
            __builtin_amdgcn_fence(__ATOMIC_ACQUIRE, "agent");
            asm volatile("s_waitcnt vmcnt(0)" ::: "memory");
        }
    }
    __syncthreads();
}

struct Args { const void* in[37]; float* out; unsigned char* ws; int ph_lo, ph_hi; };
enum { I_XP = 0, I_XS, I_CACHE, I_CWIN, I_SRET, I_SH, I_SCONV, I_SFFN, I_PT, I_CP, I_CS, I_N1G, I_N2G, I_WADA, I_BADA, I_WIN, I_PE, I_W1, I_B1, I_W2,
       I_GNG, I_RCW, I_RCB, I_RWA, I_RBA, I_RWX, I_RBX, I_LAM, I_WBRA, I_WBRB, I_WBRC, I_WOUT, I_WUP, I_FCW, I_FCB, I_WDN, I_FNG };

struct Frame {
    LAS unsigned char* lds;
    int tid, lane, wave, G, bid;
    const Args* a;
    unsigned char* ws;
    float* out;
};
__device__ __forceinline__ void launder(Frame& F) { asm volatile("" : "+v"(F.tid), "+v"(F.lane)); int w_ = __builtin_amdgcn_readfirstlane(F.wave), b_ = __builtin_amdgcn_readfirstlane(F.bid), g_ = __builtin_amdgcn_readfirstlane(F.G); asm volatile("" : "+s"(w_), "+s"(b_), "+s"(g_)); F.wave = w_; F.bid = b_; F.G = g_; }
#define FIN(i) ((const float*)F.a->in[i])
#define WSP(T, off) ((T*)(F.ws + (off)))

__device__ __forceinline__ int row_bb(int row) { return row < PM ? (row >> 12) : 4 + ((row - PM) >> 3); }
__device__ __forceinline__ int row_pos(int row) { return row < PM ? (row & (PT - 1)) : PT + ((row - PM) & 7); }

__device__ __forceinline__ int win_cmap(int n) {
    if (n < 1280) return n;
    if (n < 2304) { const int c = n - 1280, isk = c >> 9, hc = c & 511, head = hc >> 7, s = hc & 127;
        const int g = s >> 3, w = s & 7, dim = (w < 4) ? (4 * g + w) : (64 + 4 * g + (w - 4)); return (isk ? O_RK : O_RQ) + head * 128 + dim; }
    if (n < 2816) return O_RV + (n - 2304);
    if (n < 3328) return O_RG + (n - 2816);
    if (n < 3840) return O_RX + (n - 3328);
    if (n < 4352) return O_RGATE + (n - 3840);
    if (n < 7424) return O_MG + (n - 4352);
    if (n < 7448) return O_NG + (n - 7424);
    return -1;
}

template <bool MAP> __device__ __forceinline__ void p0_tr_item(const float* W, int ldw, bf16* WT, int ldt, int k0, int n0, LAS float* scr, int lane) {
    const int nd = n0 + (lane & 31); const int sc = MAP ? win_cmap(nd) : nd;
#pragma unroll 8
    for (int i = 0; i < 32; ++i) { const int kk = 2 * i + (lane >> 5); scr[kk * 33 + (lane & 31)] = (sc >= 0) ? W[(size_t)(k0 + kk) * ldw + sc] : 0.f; }
    LDS_WAIT(); asm volatile("" ::: "memory");
    const int c = lane & 7;
#pragma unroll
    for (int j = 0; j < 4; ++j) { const int n = (lane >> 3) + 8 * j; const LAS float* s = scr + (8 * c) * 33 + n;
        v4u o; o.x = pk2(s[0 * 33], s[1 * 33]); o.y = pk2(s[2 * 33], s[3 * 33]); o.z = pk2(s[4 * 33], s[5 * 33]); o.w = pk2(s[6 * 33], s[7 * 33]);
        *(v4u*)(WT + (size_t)(n0 + n) * ldt + k0 + 8 * c) = o; }
    LDS_WAIT(); asm volatile("" ::: "memory");
}
__device__ __forceinline__ void sincos_acc(float ang, float& s, float& c) {
    const double a = (double)ang; const double kq = rint(a * 0.63661977236758134308); const double r = fma(-kq, 1.57079632679489661923, a);
    const double r2 = r * r;
    const double sp = r * (1.0 + r2 * (-1.6666666666666666e-1 + r2 * (8.3333333333333332e-3 + r2 * (-1.9841269841269841e-4 + r2 * (2.7557319223985893e-6 + r2 * (-2.5052108385441720e-8))))));
    const double cp = 1.0 + r2 * (-0.5 + r2 * (4.1666666666666664e-2 + r2 * (-1.3888888888888889e-3 + r2 * (2.4801587301587302e-5 + r2 * (-2.7557319223985888e-7 + r2 * 2.0876756987868099e-9)))));
    const int q = ((int)kq) & 3;
    const double ss = (q == 0) ? sp : (q == 1) ? cp : (q == 2) ? -sp : -cp;
    const double cc = (q == 0) ? cp : (q == 1) ? -sp : (q == 2) ? -cp : sp;
    s = (float)ss; c = (float)cc;
}

__device__ __forceinline__ void p0_prologue(Frame& F) {
    const int gw = F.bid * NWAVES + F.wave, NGW = F.G * NWAVES, lane = F.lane;
    LAS float* scr = (LAS float*)(F.lds + F.wave * 16384);
    {
        constexpr int I_IN = 16 * 240, I_BR = 8 * 32, I_OUT = 16 * 32, I_UP = 16 * 176, I_DN = 44 * 32, I_L = I_IN + 3 * I_BR + I_OUT + I_UP + I_DN;
        for (int it = gw; it < 2 * I_L; it += NGW) {
            const int l = it / I_L; int r = it % I_L;
            if (r < I_IN) { p0_tr_item<true>(FIN(I_WIN) + (size_t)l * DM * D_IN, D_IN, WSP(bf16, WS_WIN) + (size_t)l * NIN * DM, DM, 64 * (r / 240), 32 * (r % 240), scr, lane); continue; } r -= I_IN;
            if (r < 3 * I_BR) { const int w = r / I_BR, q = r % I_BR; const float* src = FIN(w == 0 ? I_WBRA : (w == 1 ? I_WBRB : I_WBRC)) + (size_t)l * 512 * 1024;
                p0_tr_item<false>(src, 1024, WSP(bf16, WS_WBR) + (size_t)(l * 3 + w) * 1024 * 512, 512, 64 * (q / 32), 32 * (q % 32), scr, lane); continue; } r -= 3 * I_BR;
            if (r < I_OUT) { p0_tr_item<false>(FIN(I_WOUT) + (size_t)l * 1024 * 1024, 1024, WSP(bf16, WS_WOUT) + (size_t)l * 1024 * 1024, 1024, 64 * (r / 32), 32 * (r % 32), scr, lane); continue; } r -= I_OUT;
            if (r < I_UP) { p0_tr_item<false>(FIN(I_WUP) + (size_t)l * DM * NUP, NUP, WSP(bf16, WS_WUP) + (size_t)l * NUP * DM, DM, 64 * (r / 176), 32 * (r % 176), scr, lane); continue; } r -= I_UP;
            p0_tr_item<false>(FIN(I_WDN) + (size_t)l * DFF * DM, DM, WSP(bf16, WS_WDN) + (size_t)l * DM * DFF, DFF, 64 * (r / 32), 32 * (r % 32), scr, lane);
        }
    }
    {
        constexpr int NI_W1 = 8 * 16 * 4, NI_W2 = 4 * 2 * 2, NI_RG = 32 * 2;
        for (int it = gw; it < NI_W1 + NI_W2 + NI_RG; it += NGW) {
            int r = it;
            if (r < NI_W1) { const int m = r / 64, q = r % 64, lk = m >> 1, half = m & 1;
                p0_tr_item<false>(FIN(I_W1) + ((size_t)lk * 32 + half * 16) * 64 * 128, 128, WSP(bf16, WS_SMALLW + SW_W1T) + ((size_t)lk * 256 + half * 128) * 1024, 1024, 64 * (q / 4), 32 * (q % 4), scr, lane); continue; } r -= NI_W1;
            if (r < NI_W2) { const int lk = r / 4, q = r % 4;
                p0_tr_item<false>(FIN(I_W2) + (size_t)lk * 128 * 64, 64, WSP(bf16, WS_SMALLW + SW_W2T) + (size_t)lk * 64 * 128, 128, 64 * (q / 2), 32 * (q % 2), scr, lane); continue; } r -= NI_W2;
            { const int m = r / 2, q = r % 2, l = m >> 4, which = (m >> 3) & 1, blk = m & 7;
                p0_tr_item<false>(FIN(which ? I_RWX : I_RWA) + ((size_t)l * 8 + blk) * 4096, 64, WSP(bf16, WS_SMALLW + SW_WAT) + (size_t)m * 4096, 64, 0, 32 * q, scr, lane); }
        }
    }
    for (int it = gw; it < 64; it += NGW) {
        const int lk = it >> 4, h0 = (it & 15) * 8; const float* pe = FIN(I_PE) + (size_t)lk * 2048; const float* w1 = FIN(I_W1) + (size_t)lk * 2048 * 128 + h0;
        f32x4 a0 = (f32x4){0.f, 0.f, 0.f, 0.f}, a1 = a0;
#pragma unroll 8
        for (int i = lane; i < 2048; i += 64) { const float p = pe[i]; a0 += *(const f32x4*)(w1 + (size_t)i * 128) * p; a1 += *(const f32x4*)(w1 + (size_t)i * 128 + 4) * p; }
#pragma unroll
        for (int x = 0; x < 4; ++x) { a0[x] = wave_sum(a0[x]); a1[x] = wave_sum(a1[x]); }
        if (lane == 0) { float* cb = WSP(float, WS_SMALLW + SW_CB) + lk * 128 + h0; const float* b1 = FIN(I_B1) + lk * 128 + h0;
#pragma unroll
            for (int x = 0; x < 4; ++x) { cb[x] = a0[x] + b1[x]; cb[4 + x] = a1[x] + b1[4 + x]; } }
    }
    for (int i = F.bid * NTHR + F.tid; i < 1024; i += F.G * NTHR) { const float lam = FIN(I_LAM)[i]; WSP(float, WS_SMALLW + SW_SP)[i] = log1pf(expf(-lam)); }
    for (int i = F.bid * NTHR + F.tid; i < 4104 * 64; i += F.G * NTHR) {
        const int pi = i >> 6, fi = i & 63; const float pos = (float)(pi < PT ? pi : PAST + (pi - PT));
        const float freq = (float)pow(10000.0, -(double)fi / 64.0); const float ang = pos * freq; float s, c; sincos_acc(ang, s, c);
        WSP(float, WS_ROT)[i] = c; WSP(float, WS_ROT)[4104 * 64 + i] = s;
    }
    {
        LAS float* SC = (LAS float*)(F.lds + 0);
        LAS float* RED = (LAS float*)(F.lds + 36864);
        for (int u = F.bid; u < 2 * 96; u += F.G) {
            const int l = u / 96, cg = u % 96; float acc[36];
#pragma unroll
            for (int b = 0; b < 36; ++b) acc[b] = 0.f;
#pragma unroll 1
            for (int kh = 0; kh < 4; ++kh) {
                __syncthreads();
                for (int i = F.tid; i < 256 * 36; i += NTHR) { const int d = i / 36, bb = i % 36; const float c = (bb < 4) ? FIN(I_CP)[bb * DM + kh * 256 + d] : FIN(I_CS)[(bb - 4) * DM + kh * 256 + d]; SC[i] = siluf_(c); }
                __syncthreads();
                const float* wp = FIN(I_WADA) + ((size_t)l * DM + kh * 256 + F.wave * 32) * 6144 + cg * 64 + lane;
#pragma unroll 1
                for (int d0 = 0; d0 < 32; d0 += 16) {
                    float wv[16];
#pragma unroll
                    for (int k = 0; k < 16; ++k) wv[k] = wp[(size_t)(d0 + k) * 6144];
#pragma unroll
                    for (int k = 0; k < 16; ++k) { const LAS f32x4* sc4 = (const LAS f32x4*)(SC + (F.wave * 32 + d0 + k) * 36);
#pragma unroll
                        for (int g = 0; g < 9; ++g) { const f32x4 s4 = sc4[g]; acc[4 * g + 0] += wv[k] * s4[0]; acc[4 * g + 1] += wv[k] * s4[1]; acc[4 * g + 2] += wv[k] * s4[2]; acc[4 * g + 3] += wv[k] * s4[3]; } }
                }
            }
#pragma unroll
            for (int b = 0; b < 36; ++b) RED[(F.wave * 36 + b) * 64 + lane] = acc[b];
            __syncthreads();
            for (int o = F.tid; o < 36 * 64; o += NTHR) { const int b = o >> 6, col = o & 63; float sm = FIN(I_BADA)[l * 6144 + cg * 64 + col];
#pragma unroll
                for (int w = 0; w < 8; ++w) sm += RED[(w * 36 + b) * 64 + col];
                WSP(float, WS_MOD)[((size_t)l * 36 + b) * 6144 + cg * 64 + col] = sm; }
        }
        __syncthreads();
    }
    for (int it = gw; it < 2 * SB * PAST / 8; it += NGW) {
        const int l = it / (SB * PAST / 8), r = it % (SB * PAST / 8), db = r / (PAST / 8), tt0 = (r % (PAST / 8)) * 8;
        const int page = ((const int*)F.a->in[I_PT])[db * NPG + (tt0 >> 7)];
        const float* src = FIN(I_CACHE) + (((size_t)l * NPHYS + page) * PAGE + (tt0 & 127)) * 512 + lane * 4;
        f32x4 v[8];
#pragma unroll
        for (int k = 0; k < 8; ++k) v[k] = __builtin_nontemporal_load((const f32x4*)(src + (size_t)k * 512));
        const int idx = lane * 4, j = idx >> 7, kk = (idx >> 6) & 1, d = idx & 63;
        bf16* dst = WSP(bf16, WS_ACMP) + ((size_t)(l * 2 + j) * CMP_ROWS_J) * 1024 + ((size_t)(db * 2 + kk) * PAST + tt0) * 64 + d;
#pragma unroll
        for (int k = 0; k < 8; ++k) { v2u o; o.x = pk2(v[k][0], v[k][1]); o.y = pk2(v[k][2], v[k][3]); *(v2u*)(dst + (size_t)k * 64) = o; }
    }
    for (size_t i = (size_t)F.bid * NTHR + F.tid; i < (size_t)2 * SB * 504 * 64; i += (size_t)F.G * NTHR) {
        const size_t seq = i / (504 * 64), r = i % (504 * 64);
        const f32x4 v = *(const f32x4*)(FIN(I_CWIN) + (seq * 512 + 8) * 256 + r * 4);
        *(f32x4*)(F.out + OUT_WIN_S + seq * 512 * 256 + r * 4) = v;
    }
}

__device__ __forceinline__ const float* xrow_in(const Frame& F, int l, int row) {
    if (l == 0) return row < PM ? FIN(I_XP) + (size_t)row * DM : FIN(I_XS) + (size_t)(row - PM) * DM;
    return WSP(float, WS_X2) + (size_t)row * DM;
}
__device__ __forceinline__ void norm_phase(Frame& F, int l, int which) {
    const int gw = F.bid * NWAVES + F.wave, NGW = F.G * NWAVES, lane = F.lane;
    const float* g = FIN(which ? I_N2G : I_N1G) + l * DM;
    for (int row = gw; row < MT; row += NGW) {
        const float* xr = which ? WSP(float, WS_X1) + (size_t)row * DM : xrow_in(F, l, row);
        const float* mod = WSP(float, WS_MOD) + ((size_t)l * 36 + row_bb(row)) * 6144 + (which ? 3072 : 0);
        f32x4 v[4]; float ss = 0.f;
#pragma unroll
        for (int j = 0; j < 4; ++j) { v[j] = *(const f32x4*)(xr + lane * 4 + 256 * j); ss += (v[j][0] * v[j][0] + v[j][1] * v[j][1]) + (v[j][2] * v[j][2] + v[j][3] * v[j][3]); }
        const float rs = 1.0f / sqrtf(wave_sum(ss) * (1.0f / DM) + EPS);
        bf16* o = WSP(bf16, WS_H) + (size_t)row * DM;
#pragma unroll
        for (int j = 0; j < 4; ++j) { const int c = lane * 4 + 256 * j; const f32x4 gg = *(const f32x4*)(g + c), sh = *(const f32x4*)(mod + c), sc = *(const f32x4*)(mod + 1024 + c);
            const f32x4 y = (v[j] * rs) * gg * (sc + 1.0f) + sh; v2u w; w.x = pk2(y[0], y[1]); w.y = pk2(y[2], y[3]); *(v2u*)(o + c) = w; }
    }
}
__device__ __forceinline__ void final_phase(Frame& F) {
    const int gw = F.bid * NWAVES + F.wave, NGW = F.G * NWAVES, lane = F.lane;
    const float* g = FIN(I_FNG);
    for (int row = gw; row < MT; row += NGW) {
        const float* xr = WSP(float, WS_X2) + (size_t)row * DM;
        f32x4 v[4]; float ss = 0.f;
#pragma unroll
        for (int j = 0; j < 4; ++j) { v[j] = *(const f32x4*)(xr + lane * 4 + 256 * j); ss += (v[j][0] * v[j][0] + v[j][1] * v[j][1]) + (v[j][2] * v[j][2] + v[j][3] * v[j][3]); }
        const float rs = 1.0f / sqrtf(wave_sum(ss) * (1.0f / DM) + EPS);
        float* o = F.out + OUT_Y + (size_t)row * DM;
#pragma unroll
        for (int j = 0; j < 4; ++j) { const int c = lane * 4 + 256 * j; *(f32x4*)(o + c) = (v[j] * rs) * *(const f32x4*)(g + c); }
    }
}

#define EPI_LOOP_BEGIN \
    _Pragma("unroll") for (int ai = 0; ai < 2; ++ai) _Pragma("unroll") for (int m = 0; m < 4; ++m) { const int row = u.pm * 256 + ai * 128 + wr * 64 + m * 16 + fr; \
    _Pragma("unroll") for (int bj = 0; bj < 2; ++bj) { const int ct = bj * 128 + wc * 32 + 8 * fq; const f32x4 v0 = acc[ai][bj][m][0], v1 = acc[ai][bj][m][1];
#define EPI_LOOP_END } }

struct EpiWin {
    static constexpr bool PERM = true, AFTER_DRAIN = false;
    unsigned char* ws; float* out; int l;
    __device__ __forceinline__ void operator()(const f32x4 (&acc)[2][2][4][2], const pg8::Unit& u, int wr, int wc, int fr0, int fq0) const {
        int fr = fr0, fq = fq0; asm volatile("" : "+v"(fr), "+v"(fq));
        const int pn = u.pn;
        if (pn < 2) {
            bf16* QN = (bf16*)(ws + WS_QN);
            EPI_LOOP_BEGIN *(v4u*)(QN + (size_t)row * 512 + pn * 256 + ct) = pack8(v0 * QSCALE, v1 * QSCALE); EPI_LOOP_END
        } else if (pn < 5) {
            EPI_LOOP_BEGIN
                const int c = (pn - 2) * 256 + ct, j = c >> 7, k = (c >> 6) & 1, d = c & 63;
                const bool isp = row < PM; const int b = isp ? (row >> 12) : ((row - PM) >> 3), t = isp ? (row & (PT - 1)) : ((row - PM) & 7);
                if (j < 4) { float* o = out + (isp ? OUT_ROWS_P + ((size_t)l * PM + row) * 512 : OUT_ROWS_S + ((size_t)l * SM + (row - PM)) * 512) + c; *(f32x4*)o = v0; *(f32x4*)(o + 4) = v1; }
                else if (isp) { if (t >= PT - WINB) { float* o = out + OUT_WIN_P + (((size_t)l * PB + b) * WINB + (t - (PT - WINB))) * 256 + (c - 512); *(f32x4*)o = v0; *(f32x4*)(o + 4) = v1; } }
                else { float* o = out + OUT_WIN_S + (((size_t)l * SB + b) * WINB + (WINB - ST) + t) * 256 + (c - 512); *(f32x4*)o = v0; *(f32x4*)(o + 4) = v1; }
                const v4u w = pack8(v0, v1);
                if (isp) {
                    if (j < 2) *(v4u*)((bf16*)(ws + WS_ACMP) + ((size_t)(l * 2 + j) * CMP_ROWS_J + 32768 + (b * 2 + k) * 256) * 1024 + (size_t)t * 64 + d) = w;
                    else *(v4u*)((bf16*)(ws + WS_KVB) + ((((size_t)(j - 2) * PB + b) * 2 + k) * PT + t) * 64 + d) = w;
                } else if (j >= 2) *(v4u*)((bf16*)(ws + WS_KVS) + ((((size_t)(j - 2) * SB + b) * 2 + k) * ST + t) * 64 + d) = w;
            EPI_LOOP_END
        } else if (pn < 9) {
            const float* ROTC = (const float*)(ws + WS_ROT); const float* ROTS = ROTC + 4104 * 64;
            EPI_LOOP_BEGIN
                const int c = (pn - 5) * 256 + ct, isk = c >> 9, hc = c & 511, head = hc >> 7, d0 = ((hc & 127) >> 3) * 4;
                const int pi = row_pos(row); const f32x4 cs = *(const f32x4*)(ROTC + pi * 64 + d0), sn = *(const f32x4*)(ROTS + pi * 64 + d0);
                const float sc = isk ? 0.08838834764831845f : 1.0f;
                const f32x4 o1 = (v0 * cs - v1 * sn) * sc, o2 = (v0 * sn + v1 * cs) * sc;
                bf16* o = (bf16*)(ws + WS_RQ) + (size_t)isk * MT * 512 + (size_t)row * 512 + head * 128 + d0;
                v2u w1; w1.x = pk2(o1[0], o1[1]); w1.y = pk2(o1[2], o1[3]); *(v2u*)o = w1;
                v2u w2; w2.x = pk2(o2[0], o2[1]); w2.y = pk2(o2[2], o2[3]); *(v2u*)(o + 64) = w2;
            EPI_LOOP_END
        } else if (pn < 13) {
            bf16* RV = (bf16*)(ws + WS_RQ) + (size_t)2 * MT * 512;
            EPI_LOOP_BEGIN const int c = (pn - 9) * 256 + ct; *(v4u*)(RV + (size_t)(c >> 9) * MT * 512 + (size_t)row * 512 + (c & 511)) = pack8(v0, v1); EPI_LOOP_END
        } else if (pn < 15) {
            float* RX = (float*)(ws + WS_RX);
            EPI_LOOP_BEGIN
                const int c = (pn - 13) * 256 + ct; float* o = RX + (size_t)row * 512 + c; *(f32x4*)o = v0; *(f32x4*)(o + 4) = v1;
                if (row < PM) { const int t = row & (PT - 1); if (t >= PT - 3) { float* q = out + OUT_CV_P + (((size_t)l * PB + (row >> 12)) * 3 + (t - (PT - 3))) * 512 + c; *(f32x4*)q = v0; *(f32x4*)(q + 4) = v1; } }
                else { const int i = (row - PM) & 7; if (i >= ST - 3) { float* q = out + OUT_CV_S + (((size_t)l * SB + ((row - PM) >> 3)) * 3 + (i - (ST - 3))) * 512 + c; *(f32x4*)q = v0; *(f32x4*)(q + 4) = v1; } }
            EPI_LOOP_END
        } else if (pn < 17) {
            bf16* GG = (bf16*)(ws + WS_GG);
            EPI_LOOP_BEGIN const int c = (pn - 15) * 256 + ct;
                f32x4 a, b;
#pragma unroll
                for (int i = 0; i < 4; ++i) { a[i] = gelu_tanh(v0[i]); b[i] = gelu_tanh(v1[i]); }
                *(v4u*)(GG + (size_t)row * 512 + c) = pack8(a, b); EPI_LOOP_END
        } else if (pn < 29) {
            bf16* MG = (bf16*)(ws + WS_MGS);
            EPI_LOOP_BEGIN const int c = (pn - 17) * 256 + ct;
                f32x4 a, b;
#pragma unroll
                for (int i = 0; i < 4; ++i) { a[i] = sigmoidf_(v0[i]); b[i] = sigmoidf_(v1[i]); }
                *(v4u*)(MG + (size_t)row * 3072 + c) = pack8(a, b); EPI_LOOP_END
        } else {
            float* NG = (float*)(ws + WS_NG);
            EPI_LOOP_BEGIN if (ct < 24) { f32x4 a, b;
#pragma unroll
                for (int i = 0; i < 4; ++i) { a[i] = sigmoidf_(v0[i]); b[i] = sigmoidf_(v1[i]); }
                float* o = NG + (size_t)row * 24 + ct; *(f32x4*)o = a; *(f32x4*)(o + 4) = b; } EPI_LOOP_END
        }
    }
};

struct EpiLH {
    static constexpr bool PERM = true, AFTER_DRAIN = false;
    bf16* LH;
    __device__ __forceinline__ void operator()(const f32x4 (&acc)[2][2][4][2], const pg8::Unit& u, int wr, int wc, int fr0, int fq0) const {
        int fr = fr0, fq = fq0; asm volatile("" : "+v"(fr), "+v"(fq));
        EPI_LOOP_BEGIN *(v4u*)(LH + (size_t)row * 256 + ct) = pack8(v0, v1); EPI_LOOP_END
    }
};
struct CmpOrder {
    int G, c;
    __device__ bool next(int i, pg8::Unit& u) const { const int L = i * G + c; if (L >= CMP_ROWS / 256) return false; u.pm = L; u.pn = L / (CMP_ROWS_J / 256); return true; }
    __device__ __forceinline__ void a_ready(const pg8::Unit&) const {}
    __device__ __forceinline__ void done(const pg8::Unit&) const {}
};

template <int BR> struct EpiBr {
    static constexpr bool PERM = true, AFTER_DRAIN = false;
    unsigned char* ws;
    __device__ __forceinline__ void operator()(const f32x4 (&acc)[2][2][4][2], const pg8::Unit& u, int wr, int wc, int fr0, int fq0) const {
        int fr = fr0, fq = fq0; asm volatile("" : "+v"(fr), "+v"(fq));
        const bf16* MG = (const bf16*)(ws + WS_MGS); bf16* MR = (bf16*)(ws + WS_MRG);
        EPI_LOOP_BEGIN
            const int col = u.pn * 256 + ct; f32x4 g0, g1; unpack8(*(const v4u*)(MG + (size_t)row * 3072 + BR * 1024 + col), g0, g1);
            f32x4 r0 = v0 * g0, r1 = v1 * g1; bf16* o = MR + (size_t)row * DM + col;
            if (BR > 0) { f32x4 p0, p1; unpack8(*(const v4u*)o, p0, p1); r0 += p0; r1 += p1; }
            *(v4u*)o = pack8(r0, r1);
        EPI_LOOP_END
    }
};

struct BrOrder {
    pg8::StaticOrder S;
    __device__ bool next(int i, pg8::Unit& u) const { pg8::Unit t; if (!S.next(i / 3, t)) return false; const int br = i % 3; u.pm = br * (MT / 256) + t.pm; u.pn = br * 4 + t.pn; return true; }
    __device__ __forceinline__ void a_ready(const pg8::Unit&) const {}
    __device__ __forceinline__ void done(const pg8::Unit&) const {}
};
struct EpiBrAll {
    static constexpr bool PERM = true, AFTER_DRAIN = false;
    unsigned char* ws;
    __device__ __forceinline__ void operator()(const f32x4 (&acc)[2][2][4][2], const pg8::Unit& u0, int wr, int wc, int fr0, int fq0) const {
        int fr = fr0, fq = fq0; asm volatile("" : "+v"(fr), "+v"(fq));
        const int br = u0.pn >> 2; const pg8::Unit u{u0.pm - br * (MT / 256), u0.pn & 3};
        const bf16* MG = (const bf16*)(ws + WS_MGS) + br * 1024; bf16* MR = (bf16*)(ws + WS_MRG);
        if (br == 0) {
            EPI_LOOP_BEGIN const int col = u.pn * 256 + ct; f32x4 g0, g1; unpack8(*(const v4u*)(MG + (size_t)row * 3072 + col), g0, g1); *(v4u*)(MR + (size_t)row * DM + col) = pack8(v0 * g0, v1 * g1); EPI_LOOP_END
        } else {
            EPI_LOOP_BEGIN const int col = u.pn * 256 + ct; f32x4 g0, g1, p0, p1; unpack8(*(const v4u*)(MG + (size_t)row * 3072 + col), g0, g1); bf16* o = MR + (size_t)row * DM + col; unpack8(*(const v4u*)o, p0, p1);
                *(v4u*)o = pack8(v0 * g0 + p0, v1 * g1 + p1); EPI_LOOP_END
        }
    }
};

struct EpiRes {
    static constexpr bool PERM = true, AFTER_DRAIN = false;
    const float* xin_p; const float* xin_s; float* xout; const float* mod; int gofs;
    __device__ __forceinline__ void operator()(const f32x4 (&acc)[2][2][4][2], const pg8::Unit& u, int wr, int wc, int fr0, int fq0) const {
        int fr = fr0, fq = fq0; asm volatile("" : "+v"(fr), "+v"(fq));
        EPI_LOOP_BEGIN
            const int col = u.pn * 256 + ct; const float* xi = (xin_s && row >= PM) ? xin_s + (size_t)(row - PM) * DM + col : xin_p + (size_t)row * DM + col;
            const float* g = mod + (size_t)row_bb(row) * 6144 + gofs + col; float* o = xout + (size_t)row * DM + col;
            *(f32x4*)o = *(const f32x4*)xi + *(const f32x4*)g * v0; *(f32x4*)(o + 4) = *(const f32x4*)(xi + 4) + *(const f32x4*)(g + 4) * v1;
        EPI_LOOP_END
    }
};

struct EpiUp {
    static constexpr bool PERM = true, AFTER_DRAIN = false;
    unsigned char* ws; float* out; int l;
    __device__ __forceinline__ void operator()(const f32x4 (&acc)[2][2][4][2], const pg8::Unit& u, int wr, int wc, int fr0, int fq0) const {
        int fr = fr0, fq = fq0; asm volatile("" : "+v"(fr), "+v"(fq));
        bf16* GP = (bf16*)(ws + WS_GP); bf16* VAL = GP + (size_t)MT * DFF;
        if (u.pn < 11) {
            EPI_LOOP_BEGIN const int c = u.pn * 256 + ct; *(v4u*)(GP + (size_t)row * DFF + c) = pack8(v0, v1);
                if (row < PM) { const int t = row & (PT - 1); if (t >= PT - 2) { float* q = out + OUT_FC_P + (((size_t)l * PB + (row >> 12)) * 2 + (t - (PT - 2))) * DFF + c; *(f32x4*)q = v0; *(f32x4*)(q + 4) = v1; } }
                else { const int i = (row - PM) & 7; if (i >= ST - 2) { float* q = out + OUT_FC_S + (((size_t)l * SB + ((row - PM) >> 3)) * 2 + (i - (ST - 2))) * DFF + c; *(f32x4*)q = v0; *(f32x4*)(q + 4) = v1; } }
            EPI_LOOP_END
        } else {
            EPI_LOOP_BEGIN const int c = (u.pn - 11) * 256 + ct; *(v4u*)(VAL + (size_t)row * DFF + c) = pack8(v0, v1); EPI_LOOP_END
        }
    }
};

__device__ __forceinline__ f32x16 mfma32(bf16x8 a, bf16x8 b, f32x16 c) { return __builtin_amdgcn_mfma_f32_32x32x16_bf16(a, b, c, 0, 0, 0); }
__device__ __forceinline__ f32x4 mfma16(bf16x8 a, bf16x8 b, f32x4 c) { return __builtin_amdgcn_mfma_f32_16x16x32_bf16(a, b, c, 0, 0, 0); }
__device__ __forceinline__ float ret_log_g(int h) { return log1pf(-exp2f(-5.0f - (float)h)); }
__device__ __forceinline__ bf16x8 tr_frag(const LAS unsigned char* base, int rs_bytes, int rowA, int rowB, int colbase, int lane) {
    const int q = (lane & 15) >> 2, p = lane & 3;
    const LAS unsigned char* pa = base + (rowA + q) * rs_bytes + (colbase + 4 * p) * 2;
    const LAS unsigned char* pb = base + (rowB + q) * rs_bytes + (colbase + 4 * p) * 2;
    const s16x4 a = __builtin_bit_cast(s16x4, __builtin_amdgcn_ds_read_tr16_b64_v4i16((LAS s16x4*)pa));
    const s16x4 b = __builtin_bit_cast(s16x4, __builtin_amdgcn_ds_read_tr16_b64_v4i16((LAS s16x4*)pb));
    return (bf16x8){a[0], a[1], a[2], a[3], b[0], b[1], b[2], b[3]};
}
__device__ __forceinline__ bf16x8 cvt_frag(const f32x16& p, int s2) {
    u32x4 w; w.x = pk2(p[8 * s2 + 0], p[8 * s2 + 1]); w.y = pk2(p[8 * s2 + 2], p[8 * s2 + 3]); w.z = pk2(p[8 * s2 + 4], p[8 * s2 + 5]); w.w = pk2(p[8 * s2 + 6], p[8 * s2 + 7]);
    return __builtin_bit_cast(bf16x8, w);
}

__device__ __forceinline__ void cmp2_phase(Frame& F, int l) {
    const int gw = F.bid * NWAVES + F.wave, NGW = F.G * NWAVES, lane = F.lane, r = lane & 15, g = lane >> 4;
    const bf16* LH = WSP(bf16, WS_LH); bf16* CK = WSP(bf16, WS_CK);
    for (int wu = gw; wu < CMP_ROWS / 16; wu += NGW) {
        const int row0 = wu * 16, j = row0 / CMP_ROWS_J, rj = (row0 % CMP_ROWS_J) + r, row = row0 + r;
        const bool valid = (rj < 32768) ? ((rj & 511) < 511) : (((rj - 32768) & 255) < 255);
        const bf16* W2T = WSP(bf16, WS_SMALLW + SW_W2T) + (size_t)(l * 2 + j) * 64 * 128; const float* CB = WSP(float, WS_SMALLW + SW_CB) + (l * 2 + j) * 128;
        f32x4 acc[4];
#pragma unroll
        for (int ct = 0; ct < 4; ++ct) acc[ct] = (f32x4){0.f, 0.f, 0.f, 0.f};
#pragma unroll
        for (int ks = 0; ks < 4; ++ks) {
            const int h0 = 32 * ks + 8 * g; f32x4 a0, a1, b0, b1;
            unpack8(*(const v4u*)(LH + (size_t)row * 256 + h0), a0, a1); unpack8(*(const v4u*)(LH + (size_t)(row + 1) * 256 + 128 + h0), b0, b1);
            const f32x4 c0 = *(const f32x4*)(CB + h0), c1 = *(const f32x4*)(CB + h0 + 4);
            f32x4 x0 = a0 + b0 + c0, x1 = a1 + b1 + c1;
#pragma unroll
            for (int i = 0; i < 4; ++i) { x0[i] = gelu_tanh(x0[i]); x1[i] = gelu_tanh(x1[i]); }
            const bf16x8 hf = __builtin_bit_cast(bf16x8, pack8(x0, x1));
#pragma unroll
            for (int ct = 0; ct < 4; ++ct) { const bf16x8 wf = *(const bf16x8*)(W2T + (size_t)(16 * ct + r) * 128 + h0); acc[ct] = mfma16(wf, hf, acc[ct]); }
        }
#pragma unroll
        for (int ct = 0; ct < 4; ++ct) { const f32x4 v = valid ? acc[ct] : (f32x4){0.f, 0.f, 0.f, 0.f}; v2u w; w.x = pk2(v[0], v[1]); w.y = pk2(v[2], v[3]);
            *(v2u*)(CK + (size_t)row * 64 + 16 * ct + 4 * g) = w; }
    }
}

constexpr int CG_RS = 144, CG_BUF = 256 * CG_RS, CG_AW = 2 * CG_BUF;
__device__ __forceinline__ void cmp_gemm_unit(Frame& F, int l, int pm) {
    const int tid = F.tid, lane = F.lane, w = F.wave, q = lane & 31, h_ = lane >> 5;
    const int j = pm / 136, r = pm % 136; const bool smp = r < 128;
    const int grp = smp ? (r >> 1) : (r - 128), n0 = (smp ? (r & 1) * 256 : 0) + 32 * w;
    const float* rp[8]; const bf16* ab = nullptr;
    if (smp) { const int db = grp >> 1, k = grp & 1;
#pragma unroll
        for (int i = 0; i < 8; ++i) { const int tt0 = (n0 + 4 * i + (lane >> 4)) * 16; const int page = ((const int*)F.a->in[I_PT])[db * NPG + (tt0 >> 7)];
            rp[i] = FIN(I_CACHE) + (((((size_t)l * NPHYS + page) * PAGE + (tt0 & 127)) * 4 + j) * 2 + k) * 64 + (lane & 15) * 4; } }
    else { ab = WSP(bf16, WS_ACMP) + ((size_t)(l * 2 + j) * CMP_ROWS_J + 32768 + grp * 256 + n0 + q) * 1024 + 8 * h_;
#pragma unroll
        for (int i = 0; i < 8; ++i) rp[i] = nullptr; }
    const bf16* Bg = WSP(bf16, WS_SMALLW + SW_W1T) + (size_t)(l * 2 + j) * 256 * 1024;
    f32x16 acc[8];
#pragma unroll
    for (int ct = 0; ct < 8; ++ct) acc[ct] = (f32x16){};
    const bf16* bsrc = Bg + (size_t)(tid >> 1) * 1024 + (tid & 1) * 32; LAS unsigned char* bdst = F.lds + (tid >> 1) * CG_RS + (tid & 1) * 64;
    LAS unsigned char* Aw = F.lds + CG_AW + w * 32 * CG_RS;
    v4u bst[4]; f32x4 an[8]; v4u anb[4];
    __syncthreads();
#pragma unroll
    for (int x = 0; x < 4; ++x) bst[x] = *(const v4u*)(bsrc + 8 * x);
#pragma unroll
    for (int x = 0; x < 4; ++x) *(LAS v4u*)(bdst + x * 16) = bst[x];
    if (smp) {
#pragma unroll
        for (int i = 0; i < 8; ++i) an[i] = *(const f32x4*)(rp[i]); }
    else {
#pragma unroll
        for (int ks = 0; ks < 4; ++ks) anb[ks] = *(const v4u*)(ab + ks * 16); }
    __syncthreads();
#pragma unroll 1
    for (int kc = 0; kc < 16; ++kc) {
        bf16x8 ac[4];
        if (smp) {
#pragma unroll
            for (int i = 0; i < 8; ++i) { v2u o; o.x = pk2(an[i][0], an[i][1]); o.y = pk2(an[i][2], an[i][3]); *(LAS v2u*)(Aw + (4 * i + (lane >> 4)) * CG_RS + (lane & 15) * 8) = o; }
            LDS_WAIT(); asm volatile("" ::: "memory");
#pragma unroll
            for (int ks = 0; ks < 4; ++ks) ac[ks] = *(const LAS bf16x8*)(Aw + q * CG_RS + ks * 32 + 16 * h_);
        } else {
#pragma unroll
            for (int ks = 0; ks < 4; ++ks) ac[ks] = __builtin_bit_cast(bf16x8, anb[ks]); }
        if (kc + 1 < 16) {
#pragma unroll
            for (int x = 0; x < 4; ++x) bst[x] = *(const v4u*)(bsrc + (kc + 1) * 64 + 8 * x);
            if (smp) {
#pragma unroll
                for (int i = 0; i < 8; ++i) an[i] = *(const f32x4*)(rp[i] + (size_t)(kc + 1) * 512); }
            else {
#pragma unroll
                for (int ks = 0; ks < 4; ++ks) anb[ks] = *(const v4u*)(ab + (kc + 1) * 64 + ks * 16); }
        }
        const LAS unsigned char* bb = F.lds + (kc & 1) * CG_BUF + q * CG_RS + 16 * h_;
#pragma unroll
        for (int ks = 0; ks < 4; ++ks)
#pragma unroll
            for (int ct = 0; ct < 8; ++ct) { const bf16x8 bf = *(const LAS bf16x8*)(bb + ct * 32 * CG_RS + ks * 32); acc[ct] = mfma32(bf, ac[ks], acc[ct]); }
        if (kc + 1 < 16) {
#pragma unroll
            for (int x = 0; x < 4; ++x) *(LAS v4u*)(bdst + ((kc + 1) & 1) * CG_BUF + x * 16) = bst[x]; }
        __syncthreads();
    }
    bf16* LH = WSP(bf16, WS_LH) + ((size_t)pm * 256 + 32 * w + q) * 256;
#pragma unroll
    for (int ct = 0; ct < 8; ++ct)
#pragma unroll
        for (int r4 = 0; r4 < 4; ++r4) { v2u o; o.x = pk2(acc[ct][4 * r4 + 0], acc[ct][4 * r4 + 1]); o.y = pk2(acc[ct][4 * r4 + 2], acc[ct][4 * r4 + 3]); *(v2u*)(LH + ct * 32 + 8 * r4 + 4 * h_) = o; }
}

constexpr int RS_KV = 272;
__device__ __forceinline__ void ret_local_unit(Frame& F, int unit) {
    const int bh = unit >> 5, c = unit & 31, b = bh >> 2, h = bh & 3, lane = F.lane, w = F.wave;
    const float lg = ret_log_g(h);
    LAS unsigned char* KS = F.lds; LAS unsigned char* VS = F.lds + 128 * RS_KV;
    const bf16* RK = WSP(bf16, WS_RQ) + (size_t)MT * 512; const bf16* RV = WSP(bf16, WS_RQ) + (size_t)2 * MT * 512;
    __syncthreads();
#pragma unroll
    for (int i = 0; i < 4; ++i) { const int p = F.tid + NTHR * i, j = p >> 4, ch = p & 15; const size_t go = (size_t)(b * PT + 128 * c + j) * 512 + h * 128 + ch * 8;
        f32x4 k0, k1; unpack8(*(const v4u*)(RK + go), k0, k1); const float kw = fexp((float)(127 - j) * lg);
        *(LAS v4u*)(KS + j * RS_KV + ch * 16) = pack8(k0 * kw, k1 * kw);
        *(LAS v4u*)(VS + j * RS_KV + ch * 16) = *(const v4u*)(RV + go); }
    __syncthreads();
    const int et = w >> 1, dt0 = 2 * (w & 1), h_ = lane >> 5, blk = (lane >> 4) & 1;
    f32x16 acc[2]; acc[0] = (f32x16){}; acc[1] = (f32x16){};
#pragma unroll
    for (int ks = 0; ks < 8; ++ks) {
        const int rA = 16 * ks + 8 * h_;
        const bf16x8 af = tr_frag(VS, RS_KV, rA, rA + 4, 32 * et + 16 * blk, lane);
#pragma unroll
        for (int dd = 0; dd < 2; ++dd) { const bf16x8 bfr = tr_frag(KS, RS_KV, rA, rA + 4, 32 * (dt0 + dd) + 16 * blk, lane); acc[dd] = mfma32(af, bfr, acc[dd]); }
    }
    float* LT = WSP(float, WS_LT) + ((size_t)bh * 32 + c) * 16384;
#pragma unroll
    for (int dd = 0; dd < 2; ++dd)
#pragma unroll
        for (int r = 0; r < 16; ++r) { const int e = 32 * et + (r & 3) + 8 * (r >> 2) + 4 * h_; LT[e * 128 + 32 * (dt0 + dd) + (lane & 31)] = acc[dd][r]; }
}
__device__ __forceinline__ void ret_scan_phase(Frame& F, int l) {
    const float* LT = WSP(float, WS_LT); bf16* SPT = WSP(bf16, WS_SPT);
    for (int idx = F.bid * NTHR + F.tid; idx < 16 * 16384; idx += F.G * NTHR) {
        const int bh = idx >> 14, ed = idx & 16383, e = ed >> 7, d = ed & 127, h = bh & 3; const float g128 = fexp(128.0f * ret_log_g(h));
        float S = 0.f;
        for (int c = 0; c < 32; ++c) { const size_t o = ((size_t)bh * 32 + c) * 16384 + ed; SPT[o] = (bf16)(pk2(S, 0.f) & 0xffffu); S = S * g128 + LT[o]; }
        F.out[OUT_RET_P + ((size_t)l * 16 + bh) * 16384 + d * 128 + e] = S;
    }
}
__device__ __forceinline__ void ret_out_unit(Frame& F, int l, int unit) {
    const int bh = unit >> 5, c = unit & 31, b = bh >> 2, h = bh & 3, lane = F.lane, w = F.wave, tid = F.tid;
    const float lg = ret_log_g(h);
    LAS unsigned char* KS = F.lds; LAS unsigned char* VS = F.lds + 128 * RS_KV; LAS float* OT = (LAS float*)F.lds; LAS float* STAT = (LAS float*)(F.lds + 2 * 128 * RS_KV);
    const bf16* RQ = WSP(bf16, WS_RQ); const bf16* RK = RQ + (size_t)MT * 512; const bf16* RV = RQ + (size_t)2 * MT * 512; const bf16* RG = RQ + (size_t)3 * MT * 512;
    const size_t row0 = (size_t)b * PT + 128 * c;
    __syncthreads();
#pragma unroll
    for (int i = 0; i < 4; ++i) { const int p = tid + NTHR * i, j = p >> 4, ch = p & 15; const size_t go = (row0 + j) * 512 + h * 128 + ch * 8;
        *(LAS v4u*)(KS + j * RS_KV + ch * 16) = *(const v4u*)(RK + go); *(LAS v4u*)(VS + j * RS_KV + ch * 16) = *(const v4u*)(RV + go); }
    const int it = w & 3, eh = w >> 2, h_ = lane >> 5, blk = (lane >> 4) & 1, il = 32 * it + (lane & 31);
    bf16x8 qf[8];
#pragma unroll
    for (int ks = 0; ks < 8; ++ks) qf[ks] = *(const bf16x8*)(RQ + (row0 + il) * 512 + h * 128 + 16 * ks + 8 * h_);
    f32x16 acc[2]; acc[0] = (f32x16){}; acc[1] = (f32x16){};
    const bf16* SP = WSP(bf16, WS_SPT) + ((size_t)bh * 32 + c) * 16384;
#pragma unroll
    for (int ks = 0; ks < 8; ++ks)
#pragma unroll
        for (int e2 = 0; e2 < 2; ++e2) { const bf16x8 af = *(const bf16x8*)(SP + (size_t)(32 * (2 * eh + e2) + (lane & 31)) * 128 + 16 * ks + 8 * h_); acc[e2] = mfma32(af, qf[ks], acc[e2]); }
    { const float cr = fexp((float)(il + 1) * lg); acc[0] *= cr; acc[1] *= cr; }
    __syncthreads();
    for (int jt = 0; jt <= it; ++jt) {
        f32x16 s = (f32x16){};
#pragma unroll
        for (int ks = 0; ks < 8; ++ks) { const bf16x8 kf = *(const LAS bf16x8*)(KS + (32 * jt + (lane & 31)) * RS_KV + (16 * ks + 8 * h_) * 2); s = mfma32(kf, qf[ks], s); }
#pragma unroll
        for (int r = 0; r < 16; ++r) { const int j = 32 * jt + (r & 3) + 8 * (r >> 2) + 4 * h_; const int df = il - j; s[r] = (df >= 0) ? s[r] * fexp((float)df * lg) : 0.f; }
#pragma unroll
        for (int s2 = 0; s2 < 2; ++s2) { const bf16x8 pf = cvt_frag(s, s2); const int rA = 32 * jt + 16 * s2 + 4 * h_;
#pragma unroll
            for (int e2 = 0; e2 < 2; ++e2) { const bf16x8 vf = tr_frag(VS, RS_KV, rA, rA + 8, 32 * (2 * eh + e2) + 16 * blk, lane); acc[e2] = mfma32(vf, pf, acc[e2]); } }
    }
    float s1 = 0.f, s2 = 0.f;
#pragma unroll
    for (int e2 = 0; e2 < 2; ++e2)
#pragma unroll
        for (int r = 0; r < 16; ++r) { const float v = acc[e2][r]; s1 += v; s2 += v * v; }
    s1 += __shfl_xor(s1, 32); s2 += __shfl_xor(s2, 32);
    if (lane < 32) { STAT[(w * 32 + lane) * 2] = s1; STAT[(w * 32 + lane) * 2 + 1] = s2; }
    __syncthreads();
    { const int pw = w ^ 4; s1 += STAT[(pw * 32 + (lane & 31)) * 2]; s2 += STAT[(pw * 32 + (lane & 31)) * 2 + 1]; }
    const float mean = s1 * (1.0f / 128.0f), var = fmaxf(s2 * (1.0f / 128.0f) - mean * mean, 0.f), rstd = 1.0f / sqrtf(var + EPS);
#pragma unroll
    for (int e2 = 0; e2 < 2; ++e2)
#pragma unroll
        for (int r4 = 0; r4 < 4; ++r4) { const int e = 32 * (2 * eh + e2) + 8 * r4 + 4 * h_;
            f32x4 v; v[0] = (acc[e2][4 * r4 + 0] - mean) * rstd; v[1] = (acc[e2][4 * r4 + 1] - mean) * rstd; v[2] = (acc[e2][4 * r4 + 2] - mean) * rstd; v[3] = (acc[e2][4 * r4 + 3] - mean) * rstd;
            *(LAS f32x4*)(OT + il * 132 + e) = v; }
    __syncthreads();
    const float* GN = FIN(I_GNG) + l * 512 + h * 128; bf16* OR_ = WSP(bf16, WS_OA) + (size_t)MT * 512;
#pragma unroll
    for (int k = 0; k < 4; ++k) { const int q = tid + NTHR * k, i = q >> 4, ch = q & 15;
        const f32x4 o0 = *(const LAS f32x4*)(OT + i * 132 + 8 * ch), o1 = *(const LAS f32x4*)(OT + i * 132 + 8 * ch + 4);
        const f32x4 g0 = *(const f32x4*)(GN + 8 * ch), g1 = *(const f32x4*)(GN + 8 * ch + 4); f32x4 r0, r1; unpack8(*(const v4u*)(RG + (row0 + i) * 512 + h * 128 + 8 * ch), r0, r1);
        f32x4 y0, y1;
#pragma unroll
        for (int x = 0; x < 4; ++x) { y0[x] = o0[x] * g0[x] * siluf_(r0[x]); y1[x] = o1[x] * g1[x] * siluf_(r1[x]); }
        *(v4u*)(OR_ + (row0 + i) * 512 + h * 128 + 8 * ch) = pack8(y0, y1); }
}
__device__ __forceinline__ void ret_sample_unit(Frame& F, int l, int unit) {
    const int db = unit >> 2, h = unit & 3, tid = F.tid, e = tid & 127, dp = tid >> 7;
    const float lg = ret_log_g(h);
    LAS float* Q = (LAS float*)F.lds; LAS float* K = Q + 1024; LAS float* V = K + 1024; LAS float* GT = V + 1024; LAS float* CR = GT + 1024;
    LAS float* SC = CR + 4096; LAS float* RED = SC + 64;
    const bf16* RQ = WSP(bf16, WS_RQ); const size_t row0 = (size_t)PM + db * 8;
    __syncthreads();
    for (int i = tid; i < 4096; i += NTHR) { const int which = i >> 10, r = (i >> 7) & 7, d = i & 127; const float v = bf1(RQ[(size_t)which * MT * 512 + (row0 + r) * 512 + h * 128 + d]); Q[which * 1024 + r * 128 + d] = v; }
    __syncthreads();
    const float* S0 = FIN(I_SRET) + (((size_t)l * SB + db) * 4 + h) * 16384; float* SN = F.out + OUT_RET_S + (((size_t)l * SB + db) * 4 + h) * 16384;
    float kwv[8], cr[8];
#pragma unroll
    for (int j = 0; j < 8; ++j) { kwv[j] = V[j * 128 + e] * fexp((float)(7 - j) * lg); cr[j] = 0.f; }
    const float g8 = fexp(8.0f * lg);
    for (int d = dp * 32; d < dp * 32 + 32; ++d) {
        const float s0 = S0[d * 128 + e]; float sn = g8 * s0;
#pragma unroll
        for (int j = 0; j < 8; ++j) { cr[j] += Q[j * 128 + d] * s0; sn += K[j * 128 + d] * kwv[j]; }
        SN[d * 128 + e] = sn;
    }
#pragma unroll
    for (int i = 0; i < 8; ++i) CR[(dp * 8 + i) * 128 + e] = cr[i];
    if (tid < 64) { const int i = tid >> 3, j = tid & 7; float s = 0.f; if (j <= i) { for (int d = 0; d < 128; ++d) s += Q[i * 128 + d] * K[j * 128 + d]; s *= fexp((float)(i - j) * lg); } SC[tid] = s; }
    __syncthreads();
    float o[2];
#pragma unroll
    for (int ii = 0; ii < 2; ++ii) { const int i = 2 * dp + ii; float x = (CR[(0 * 8 + i) * 128 + e] + CR[(1 * 8 + i) * 128 + e] + CR[(2 * 8 + i) * 128 + e] + CR[(3 * 8 + i) * 128 + e]) * fexp((float)(i + 1) * lg);
        for (int j = 0; j <= i; ++j) x += SC[i * 8 + j] * V[j * 128 + e];
        o[ii] = x; }
#pragma unroll
    for (int ii = 0; ii < 2; ++ii) { const float a = wave_sum(o[ii]), q = wave_sum(o[ii] * o[ii]); if (F.lane == 0) { RED[(F.wave * 2 + ii) * 2] = a; RED[(F.wave * 2 + ii) * 2 + 1] = q; } }
    __syncthreads();
    const float* GN = FIN(I_GNG) + l * 512 + h * 128; bf16* OR_ = WSP(bf16, WS_OA) + (size_t)MT * 512;
#pragma unroll
    for (int ii = 0; ii < 2; ++ii) { const int i = 2 * dp + ii, w0 = 2 * dp; const float s1 = RED[(w0 * 2 + ii) * 2] + RED[((w0 + 1) * 2 + ii) * 2], s2 = RED[(w0 * 2 + ii) * 2 + 1] + RED[((w0 + 1) * 2 + ii) * 2 + 1];
        const float mean = s1 * (1.0f / 128.0f), var = fmaxf(s2 * (1.0f / 128.0f) - mean * mean, 0.f), rstd = 1.0f / sqrtf(var + EPS);
        const float y = (o[ii] - mean) * rstd * GN[e] * siluf_(GT[i * 128 + e]);
        OR_[(row0 + i) * 512 + h * 128 + e] = (bf16)(pk2(y, 0.f) & 0xffffu); }
}

template <int MODE> __device__ __forceinline__ void rglru_unit(Frame& F, int l, int unit) {
    const int tid = F.tid, c = tid, lane = F.lane, w = F.wave;
    LAS bf16* XC = (LAS bf16*)F.lds; LAS float* G = (LAS float*)(F.lds + 16384);
    const int seq = (MODE == 2) ? unit : (unit >> 6), tile = (MODE == 2) ? 0 : (unit & 63);
    const size_t row0 = (MODE == 2) ? (size_t)PM + seq * 8 : (size_t)seq * PT + tile * 64;
    const int ntok = (MODE == 2) ? 8 : 64, nsub = (MODE == 2) ? 1 : 4;
    const float* RX = WSP(float, WS_RX);
    const float w0 = FIN(I_RCW)[(l * 4 + 0) * 512 + c], w1 = FIN(I_RCW)[(l * 4 + 1) * 512 + c], w2 = FIN(I_RCW)[(l * 4 + 2) * 512 + c], w3 = FIN(I_RCW)[(l * 4 + 3) * 512 + c], cb = FIN(I_RCB)[l * 512 + c];
    const float ba = FIN(I_RBA)[l * 512 + c], bx = FIN(I_RBX)[l * 512 + c], sp = WSP(float, WS_SMALLW + SW_SP)[l * 512 + c];
    float x3, x2, x1;
    if (MODE == 2) { const float* cv = FIN(I_SCONV) + ((size_t)l * SB + seq) * 3 * 512; x3 = cv[c]; x2 = cv[512 + c]; x1 = cv[1024 + c]; }
    else if (tile == 0) { x3 = 0.f; x2 = 0.f; x1 = 0.f; }
    else { x3 = RX[(row0 - 3) * 512 + c]; x2 = RX[(row0 - 2) * 512 + c]; x1 = RX[(row0 - 1) * 512 + c]; }
    float h = (MODE == 0) ? 0.f : (MODE == 1) ? WSP(float, WS_CAR)[(size_t)4 * 64 * 2 * 512 + ((size_t)seq * 64 + tile) * 512 + c] : FIN(I_SH)[((size_t)l * SB + seq) * 512 + c];
    float aprod = 1.f;
    const int r16 = lane & 15, g4 = lane >> 4;
    bf16x8 wa[4][2], wx[4][2];
    { const bf16* WA = WSP(bf16, WS_SMALLW + SW_WAT) + ((size_t)(l * 2 + 0) * 8 + w) * 4096; const bf16* WX = WSP(bf16, WS_SMALLW + SW_WAT) + ((size_t)(l * 2 + 1) * 8 + w) * 4096;
#pragma unroll
      for (int ct = 0; ct < 4; ++ct)
#pragma unroll
          for (int ks = 0; ks < 2; ++ks) { wa[ct][ks] = *(const bf16x8*)(WA + (16 * ct + r16) * 64 + 32 * ks + 8 * g4); wx[ct][ks] = *(const bf16x8*)(WX + (16 * ct + r16) * 64 + 32 * ks + 8 * g4); } }
    const bf16* GG = WSP(bf16, WS_GG); bf16* OC = WSP(bf16, WS_OA) + (size_t)2 * MT * 512;
    __syncthreads();
    for (int s = 0; s < nsub; ++s) {
        float xc[16], gg[16];
#pragma unroll
        for (int tt = 0; tt < 16; ++tt) { const int t = s * 16 + tt; xc[tt] = (t < ntok) ? RX[(row0 + t) * 512 + c] : 0.f; gg[tt] = (MODE != 0 && t < ntok) ? bf1(GG[(row0 + t) * 512 + c]) : 0.f; }
#pragma unroll
        for (int tt = 0; tt < 16; ++tt) { const float x0 = xc[tt];
            xc[tt] = cb + w0 * x3 + w1 * x2 + w2 * x1 + w3 * x0; x3 = x2; x2 = x1; x1 = x0; XC[tt * 512 + c] = (bf16)(pk2(xc[tt], 0.f) & 0xffffu); }
        __syncthreads();
        {
            bf16x8 xf[2];
#pragma unroll
            for (int ks = 0; ks < 2; ++ks) xf[ks] = *(const LAS bf16x8*)(XC + r16 * 512 + w * 64 + 32 * ks + 8 * g4);
#pragma unroll
            for (int ct = 0; ct < 4; ++ct) { f32x4 da = (f32x4){0.f, 0.f, 0.f, 0.f}, dx = da;
#pragma unroll
                for (int ks = 0; ks < 2; ++ks) { da = mfma16(wa[ct][ks], xf[ks], da); dx = mfma16(wx[ct][ks], xf[ks], dx); }
                *(LAS f32x4*)(G + r16 * 512 + w * 64 + 16 * ct + 4 * g4) = da; *(LAS f32x4*)(G + 8192 + r16 * 512 + w * 64 + 16 * ct + 4 * g4) = dx; }
        }
        __syncthreads();
#pragma unroll
        for (int tt = 0; tt < 16; ++tt) { const int t = s * 16 + tt;
            if (t < ntok) {
                const float r = sigmoidf_(G[tt * 512 + c] + ba), ig = sigmoidf_(G[8192 + tt * 512 + c] + bx);
                const float la = -8.0f * r * sp, a = fexp(la), bt = sqrtf(fmaxf(1.0f - a * a, 0.f)) * (ig * xc[tt]);
                h = a * h + bt; aprod *= a;
                if (MODE != 0) { const size_t o = (row0 + t) * 512 + c; OC[o] = (bf16)(pk2(h * gg[tt], 0.f) & 0xffffu); }
            } }
    }
    if (MODE == 0) { float* CAR = WSP(float, WS_CAR) + ((size_t)seq * 64 + tile) * 1024; CAR[c] = aprod; CAR[512 + c] = h; }
    if (MODE == 2) F.out[OUT_H_S + ((size_t)l * SB + seq) * 512 + c] = h;
}
__device__ __forceinline__ void rglru_carry_phase(Frame& F, int l) {
    const float* CAR = WSP(float, WS_CAR); float* HIN = WSP(float, WS_CAR) + (size_t)4 * 64 * 2 * 512;
    for (int idx = F.bid * NTHR + F.tid; idx < PB * 512; idx += F.G * NTHR) {
        const int b = idx >> 9, c = idx & 511; float h = 0.f;
        for (int t = 0; t < 64; ++t) { HIN[((size_t)b * 64 + t) * 512 + c] = h; const float* cr = CAR + ((size_t)b * 64 + t) * 1024; h = cr[c] * h + cr[512 + c]; }
        F.out[OUT_H_P + ((size_t)l * PB + b) * 512 + c] = h;
    }
}

__device__ __forceinline__ void convact_phase(Frame& F, int l) {
    const bf16* GP = WSP(bf16, WS_GP); const bf16* VAL = GP + (size_t)MT * DFF; bf16* ACT = WSP(bf16, WS_GP) + (size_t)2 * MT * DFF;
    const float* CW = FIN(I_FCW) + (size_t)l * 3 * DFF; const float* CBI = FIN(I_FCB) + (size_t)l * DFF;
    constexpr int NRUN = PM / 16 + SB, NCG = DFF / 8;
    for (int it = F.bid * NTHR + F.tid; it < NRUN * NCG; it += F.G * NTHR) {
        const int run = it / NCG, cg = it % NCG, c = cg * 8;
        const bool isp = run < PM / 16; const size_t row0 = isp ? (size_t)run * 16 : (size_t)PM + (run - PM / 16) * 8; const int nt = isp ? 16 : 8;
        f32x4 p2a, p2b, p1a, p1b;
        if (isp) { if ((run & 255) == 0) { p2a = p2b = p1a = p1b = (f32x4){0.f, 0.f, 0.f, 0.f}; } else { unpack8(*(const v4u*)(GP + (row0 - 2) * DFF + c), p2a, p2b); unpack8(*(const v4u*)(GP + (row0 - 1) * DFF + c), p1a, p1b); } }
        else { const float* st = FIN(I_SFFN) + (((size_t)l * SB + (run - PM / 16)) * 2) * DFF + c; p2a = *(const f32x4*)st; p2b = *(const f32x4*)(st + 4); p1a = *(const f32x4*)(st + DFF); p1b = *(const f32x4*)(st + DFF + 4); }
        const f32x4 w0a = *(const f32x4*)(CW + c), w0b = *(const f32x4*)(CW + c + 4), w1a = *(const f32x4*)(CW + DFF + c), w1b = *(const f32x4*)(CW + DFF + c + 4), w2a = *(const f32x4*)(CW + 2 * DFF + c), w2b = *(const f32x4*)(CW + 2 * DFF + c + 4);
        const f32x4 ba = *(const f32x4*)(CBI + c), bb = *(const f32x4*)(CBI + c + 4);
        for (int t0 = 0; t0 < nt; t0 += 8) {
            v4u gx[8], vx[8];
#pragma unroll
            for (int k = 0; k < 8; ++k) { gx[k] = *(const v4u*)(GP + (row0 + t0 + k) * DFF + c); vx[k] = *(const v4u*)(VAL + (row0 + t0 + k) * DFF + c); }
#pragma unroll
            for (int k = 0; k < 8; ++k) {
                f32x4 xa, xb, va, vb; unpack8(gx[k], xa, xb); unpack8(vx[k], va, vb);
                f32x4 ya = ba + w0a * p2a + w1a * p1a + w2a * xa, yb = bb + w0b * p2b + w1b * p1b + w2b * xb;
#pragma unroll
                for (int i = 0; i < 4; ++i) { ya[i] = siluf_(ya[i]) * va[i]; yb[i] = siluf_(yb[i]) * vb[i]; }
                *(v4u*)(ACT + (row0 + t0 + k) * DFF + c) = pack8(ya, yb);
                p2a = p1a; p2b = p1b; p1a = xa; p1b = xb;
            }
        }
    }
}

constexpr int AT_RS = 144;
constexpr int AT_K0 = 0, AT_V0 = 2 * 64 * AT_RS, AT_PS = 4 * 64 * AT_RS, AT_IMP = AT_PS + 69632, AT_MASK = AT_IMP + 6144, AT_LIST = AT_MASK + 2048, AT_NL = AT_LIST + 1024;
constexpr unsigned AT_MARK = 0xFFFFu;
static_assert(AT_NL + 64 <= RING_BYTES, "attention LDS map");

struct TileRegs { v4u a, b, c, d; int mode; };

template <bool SMP> __device__ __forceinline__ void at_prefetch(const Frame& F, int l, int seq, int kvh, unsigned e, TileRegs& R) {
    const int kind = (int)(e >> 14), ti = (int)(e & 0x3fffu), rr = F.tid >> 3, pc = F.tid & 7;
    R.mode = 0;
    if (kind < 2) {
        const size_t rb = SMP ? (size_t)(seq * 2 + kvh) * 512 : (size_t)32768 + (size_t)(seq * 2 + kvh) * 256;
        const bf16* ck = WSP(bf16, WS_CK) + (rb + ti * 64 + rr) * 64 + pc * 8;
        R.a = *(const v4u*)ck; R.c = *(const v4u*)(ck + (size_t)CMP_ROWS_J * 64);
    } else if (!SMP) {
        const int jb = (kind == 2) ? 0 : 2;
        const bf16* kp = WSP(bf16, WS_KVB) + ((((size_t)jb * PB + seq) * 2 + kvh) * PT + ti * 64 + rr) * 64 + pc * 8;
        R.a = *(const v4u*)kp; R.c = *(const v4u*)(kp + (size_t)PB * 2 * PT * 64);
    } else if (kind == 2) {
        if (ti < 128) {
            const int page = ((const int*)F.a->in[I_PT])[seq * NPG + (ti >> 1)], slot = (ti & 1) * 64 + rr;
            const float* kp = FIN(I_CACHE) + (((((size_t)l * NPHYS + page) * PAGE + slot) * 4 + 2) * 2 + kvh) * 64 + pc * 8;
            R.a = *(const v4u*)kp; R.b = *(const v4u*)(kp + 4); R.c = *(const v4u*)(kp + 128); R.d = *(const v4u*)(kp + 132); R.mode = 1;
        } else if (rr < ST) {
            const bf16* kp = WSP(bf16, WS_KVS) + ((((size_t)0 * SB + seq) * 2 + kvh) * ST + rr) * 64 + pc * 8;
            R.a = *(const v4u*)kp; R.c = *(const v4u*)(kp + (size_t)SB * 2 * ST * 64);
        } else R.mode = 2;
    } else {
        if (ti < 8) {
            const float* kp = FIN(I_CWIN) + (((((size_t)l * SB + seq) * WINB + ti * 64 + rr) * 2 + 0) * 2 + kvh) * 64 + pc * 8;
            R.a = *(const v4u*)kp; R.b = *(const v4u*)(kp + 4); R.c = *(const v4u*)(kp + 128); R.d = *(const v4u*)(kp + 132); R.mode = 1;
        } else if (rr < ST) {
            const bf16* kp = WSP(bf16, WS_KVS) + ((((size_t)2 * SB + seq) * 2 + kvh) * ST + rr) * 64 + pc * 8;
            R.a = *(const v4u*)kp; R.c = *(const v4u*)(kp + (size_t)SB * 2 * ST * 64);
        } else R.mode = 2;
    }
}
__device__ __forceinline__ void at_store(const Frame& F, int buf, const TileRegs& R) {
    const int rr = F.tid >> 3, pc = F.tid & 7; v4u k, v;
    if (R.mode == 0) { k = R.a; v = R.c; }
    else if (R.mode == 1) { k = pack8(__builtin_bit_cast(f32x4, R.a), __builtin_bit_cast(f32x4, R.b)); v = pack8(__builtin_bit_cast(f32x4, R.c), __builtin_bit_cast(f32x4, R.d)); }
    else { k = (v4u){0u, 0u, 0u, 0u}; v = k; }
    *(LAS v4u*)(F.lds + AT_K0 + buf * 64 * AT_RS + rr * AT_RS + pc * 16) = k;
    *(LAS v4u*)(F.lds + AT_V0 + buf * 64 * AT_RS + rr * AT_RS + pc * 16) = v;
}

template <bool SMP> __device__ __forceinline__ void attn_unit(Frame& F, int l, int unit) {
    const int tid = F.tid, lane = F.lane, w = F.wave;
    const int q = lane & 31, h_ = lane >> 5, blk = (lane >> 4) & 1, tl = q >> 2, hr = q & 3;
    int seq, kvh, qt;
    if (SMP) { seq = unit >> 1; kvh = unit & 1; qt = 128; } else { seq = unit >> 7; kvh = (unit >> 6) & 1; qt = unit & 63; }
    const int t0 = SMP ? PAST : qt * 64;
    const int tokl = SMP ? tl : 8 * w + tl, t = t0 + tokl;
    const size_t row = SMP ? (size_t)PM + seq * ST + tl : (size_t)seq * PT + t;
    const int head = kvh * 4 + hr;
    LAS float* PS = (LAS float*)(F.lds + AT_PS); LAS float* IMPw = (LAS float*)(F.lds + AT_IMP) + w * 192;
    LAS unsigned long long* MASKS = (LAS unsigned long long*)(F.lds + AT_MASK); LAS unsigned short* LIST = (LAS unsigned short*)(F.lds + AT_LIST); LAS int* NL = (LAS int*)(F.lds + AT_NL);
    constexpr int PSS = SMP ? 520 : 264;
    LAS float* PSw = SMP ? PS : PS + w * 8 * PSS;
    __syncthreads();
    bf16x8 qf[4];
    { const bf16* qp = WSP(bf16, WS_QN) + row * 512 + head * 64 + 8 * h_;
#pragma unroll
      for (int kk = 0; kk < 4; ++kk) qf[kk] = *(const bf16x8*)(qp + 16 * kk); }
    const float* ngp = WSP(float, WS_NG) + row * 24 + head * 3; const float g0 = ngp[0], g1 = ngp[1], g2 = ngp[2];
    if (!SMP) { for (int i = lane; i < 8 * PSS; i += 64) PSw[i] = 0.f; }
    const int ntc = SMP ? 8 : ((t0 + 32) >> 10) + 1;
    if (tid < 2 * ntc) LIST[tid] = (unsigned short)(((tid >= ntc ? 1u : 0u) << 14) | (unsigned)(tid >= ntc ? tid - ntc : tid));
    if (tid == 0) LIST[2 * ntc] = (unsigned short)AT_MARK;
    int nl = 2 * ntc + 1;
    TileRegs R;
    at_prefetch<SMP>(F, l, seq, kvh, (unsigned)0, R);
    at_store(F, 0, R);
    __syncthreads();
    float m = -INFINITY, lsum = 0.f, invden = 0.f;
    f32x16 O[2]; O[0] = (f32x16){}; O[1] = (f32x16){};
    LAS float* OAw = (LAS float*)(F.lds + AT_PS) + w * (SMP ? 2048 : 8 * PSS) + lane;
    unsigned long long mk0 = 0ull, mk1 = 0ull, wu = ~0ull;
    int cur_kind = -1, idx = 0;
#define AT_FINALIZE(kind) do { \
        if ((kind) == 0) { const float lt = lsum + __shfl_xor(lsum, 32); invden = lt > 0.f ? 1.0f / lt : 0.f; } \
        else if ((kind) == 1) { const float sc = g0 * invden; O[0] *= sc; O[1] *= sc; } \
        else if ((kind) == 2) { const float lt = lsum + __shfl_xor(lsum, 32); const float sc = (lt > 0.f ? 1.0f / lt : 0.f) * g1; \
            _Pragma("unroll") for (int r_ = 0; r_ < 16; ++r_) { OAw[r_ * 64] += O[0][r_] * sc; OAw[(16 + r_) * 64] += O[1][r_] * sc; } } } while (0)
    while (idx < nl) {
        const unsigned e = (unsigned)__builtin_amdgcn_readfirstlane((int)LIST[idx]);
        if (e == AT_MARK) {
            AT_FINALIZE(cur_kind); cur_kind = -1;
            LDS_WAIT(); asm volatile("" ::: "memory");
#pragma unroll 1
            for (int tk = 0; tk < 8; ++tk) {
                const LAS float* pr = PSw + tk * PSS;
                if (!SMP) {
                    const int s = lane; float imp = 0.f;
#pragma unroll
                    for (int n = 4 * s - 1; n <= 4 * s + 3; ++n) if (n >= 0) imp += pr[n];
                    const bool forced = (s == 0) || (s == qt) || (s == qt - 1), avail = s <= qt;
                    const float val = avail ? (forced ? 1e4f : imp) : -1e4f;
                    IMPw[s] = val; LDS_WAIT(); asm volatile("" ::: "memory");
                    int rank = 0;
#pragma unroll 8
                    for (int i = 0; i < 64; ++i) { const float v = IMPw[i]; rank += (v > val || (v == val && i < s)) ? 1 : 0; }
                    const unsigned long long mk = __ballot(rank < 16);
                    if (lane == 0) MASKS[(8 * w + tk) * 4] = mk;
                    LDS_WAIT(); asm volatile("" ::: "memory");
                } else {
                    const int sa = lane, sb = lane + 64; float ia = 0.f, ib = 0.f;
#pragma unroll
                    for (int n = 4 * sa - 1; n <= 4 * sa + 3; ++n) if (n >= 0) ia += pr[n];
#pragma unroll
                    for (int n = 4 * sb - 1; n <= 4 * sb + 3; ++n) ib += pr[n];
                    const bool fa = (sa == 0), fb = (sb == 127);
                    const float va = fa ? 1e4f : ia, vb = fb ? 1e4f : ib;
                    IMPw[sa] = va; IMPw[sb] = vb; LDS_WAIT(); asm volatile("" ::: "memory");
                    int ra = fa ? 0 : 1, rb = fb ? 0 : 1;
#pragma unroll 8
                    for (int i = 0; i < 128; ++i) { const float v = IMPw[i]; ra += (v > va || (v == va && i < sa)) ? 1 : 0; rb += (v > vb || (v == vb && i < sb)) ? 1 : 0; }
                    const unsigned long long ma = __ballot(ra < 16), mb = __ballot(rb < 16);
                    if (lane == 0) { MASKS[tk * 4] = ma; MASKS[tk * 4 + 1] = mb; MASKS[tk * 4 + 2] = 1ull; }
                    LDS_WAIT(); asm volatile("" ::: "memory");
                }
            }
            __syncthreads();
#pragma unroll
            for (int r_ = 0; r_ < 16; ++r_) { OAw[r_ * 64] = O[0][r_]; OAw[(16 + r_) * 64] = O[1][r_]; }
            if (tid == 0) {
                int n = idx + 1;
                if (!SMP) { unsigned long long U = 0ull; for (int i = 0; i < 64; ++i) U |= MASKS[i * 4];
                    for (int s = 0; s <= qt; ++s) if ((U >> s) & 1ull) LIST[n++] = (unsigned short)((2u << 14) | (unsigned)s);
                    for (int s = (qt > 8 ? qt - 8 : 0); s <= qt; ++s) LIST[n++] = (unsigned short)((3u << 14) | (unsigned)s);
                } else { unsigned long long U0 = 0ull, U1 = 0ull; for (int i = 0; i < 8; ++i) { U0 |= MASKS[i * 4]; U1 |= MASKS[i * 4 + 1]; }
                    for (int s = 0; s < 64; ++s) if ((U0 >> s) & 1ull) LIST[n++] = (unsigned short)((2u << 14) | (unsigned)s);
                    for (int s = 0; s < 64; ++s) if ((U1 >> s) & 1ull) LIST[n++] = (unsigned short)((2u << 14) | (unsigned)(64 + s));
                    LIST[n++] = (unsigned short)((2u << 14) | 128u);
                    for (int s = 0; s <= 8; ++s) LIST[n++] = (unsigned short)((3u << 14) | (unsigned)s); }
                NL[0] = n;
            }
            __syncthreads();
            nl = __builtin_amdgcn_readfirstlane(NL[0]);
            mk0 = MASKS[tokl * 4]; if (SMP) { mk1 = MASKS[tokl * 4 + 1]; }
            if (!SMP) { unsigned long long u = 0ull; for (int i = 0; i < 8; ++i) u |= MASKS[(8 * w + i) * 4]; wu = u; }
            if (idx + 1 < nl) { at_prefetch<SMP>(F, l, seq, kvh, (unsigned)LIST[idx + 1], R); at_store(F, (idx + 1) & 1, R); }
            __syncthreads();
            ++idx; continue;
        }
        const int kind = (int)(e >> 14), ti = (int)(e & 0x3fffu);
        if (kind != cur_kind) {
            if (cur_kind >= 0) AT_FINALIZE(cur_kind);
            if (kind != 1) m = -INFINITY;
            lsum = 0.f; O[0] = (f32x16){}; O[1] = (f32x16){}; cur_kind = kind;
        }
        const unsigned en = (idx + 1 < nl) ? (unsigned)__builtin_amdgcn_readfirstlane((int)LIST[idx + 1]) : AT_MARK;
        const bool have_next = (en != AT_MARK);
        if (have_next) at_prefetch<SMP>(F, l, seq, kvh, en, R);
        bool active = true;
        if (!SMP && kind == 2) active = ((wu >> ti) & 1ull) != 0ull;
        if (active) {
            const LAS unsigned char* Kb = F.lds + AT_K0 + (idx & 1) * 64 * AT_RS; const LAS unsigned char* Vb = F.lds + AT_V0 + (idx & 1) * 64 * AT_RS;
            int lo, hi; const int kb = 64 * ti;
            if (kind < 2) { lo = 0; hi = SMP ? 510 : ((t >= 31) ? ((t - 31) >> 4) : -1); }
            else if (kind == 2) { lo = 0; const unsigned long long mw = (ti < 64) ? mk0 : ((ti < 128) ? mk1 : 1ull); hi = ((mw >> (ti & 63)) & 1ull) ? t : -1; }
            else { if (SMP) { lo = tl; hi = WINB + tl; } else { lo = t - WINB; hi = t; } }
            f32x16 s0 = (f32x16){}, s1 = (f32x16){};
#pragma unroll
            for (int kk = 0; kk < 4; ++kk) {
                const bf16x8 k0 = *(const LAS bf16x8*)(Kb + q * AT_RS + (16 * kk + 8 * h_) * 2), k1 = *(const LAS bf16x8*)(Kb + (32 + q) * AT_RS + (16 * kk + 8 * h_) * 2);
                s0 = mfma32(k0, qf[kk], s0); s1 = mfma32(k1, qf[kk], s1);
            }
            float tmax = -INFINITY;
#pragma unroll
            for (int r = 0; r < 16; ++r) { const int key = kb + (r & 3) + 8 * (r >> 2) + 4 * h_;
                s0[r] = (key >= lo && key <= hi) ? s0[r] : -INFINITY; s1[r] = (key + 32 >= lo && key + 32 <= hi) ? s1[r] : -INFINITY;
                tmax = fmaxf(tmax, fmaxf(s0[r], s1[r])); }
            tmax = fmaxf(tmax, __shfl_xor(tmax, 32));
            const float m_new = fmaxf(m, tmax), m_use = (m_new == -INFINITY) ? 0.f : m_new;
            const float alpha = fexp2(m - m_use);
            float ps = 0.f;
#pragma unroll
            for (int r = 0; r < 16; ++r) { s0[r] = fexp2(s0[r] - m_use); s1[r] = fexp2(s1[r] - m_use); ps += s0[r] + s1[r]; }
            lsum = lsum * alpha + ps; m = m_new;
            if (kind != 0) {
                O[0] *= alpha; O[1] *= alpha;
#pragma unroll
                for (int kt2 = 0; kt2 < 2; ++kt2)
#pragma unroll
                    for (int s2 = 0; s2 < 2; ++s2) { const bf16x8 pf = cvt_frag(kt2 ? s1 : s0, s2); const int rA = 32 * kt2 + 16 * s2 + 4 * h_;
#pragma unroll
                        for (int dt = 0; dt < 2; ++dt) { const bf16x8 vf = tr_frag(Vb, AT_RS, rA, rA + 8, 32 * dt + 16 * blk, lane); O[dt] = mfma32(vf, pf, O[dt]); } }
            }
            if (kind == 1) {
#pragma unroll
                for (int r = 0; r < 16; ++r) { const int n = kb + (r & 3) + 8 * (r >> 2) + 4 * h_;
                    float a = s0[r] * invden, b = s1[r] * invden; a += __shfl_xor(a, 1); b += __shfl_xor(b, 1); a += __shfl_xor(a, 2); b += __shfl_xor(b, 2);
                    if (hr == 0) { PSw[tl * PSS + n] = a; PSw[tl * PSS + n + 32] = b; } }
            }
        }
        if (have_next) at_store(F, (idx + 1) & 1, R);
        __syncthreads();
        ++idx;
    }
#undef AT_FINALIZE
    {
        const float lt = lsum + __shfl_xor(lsum, 32); const float sc = (lt > 0.f ? 1.0f / lt : 0.f) * g2;
        if (!SMP || w == 0) {
            bf16* op = WSP(bf16, WS_OA) + row * 512 + head * 64;
#pragma unroll
            for (int dt = 0; dt < 2; ++dt)
#pragma unroll
                for (int r4 = 0; r4 < 4; ++r4) { float o_[4];
#pragma unroll
                    for (int x = 0; x < 4; ++x) o_[x] = OAw[(dt * 16 + 4 * r4 + x) * 64] + O[dt][4 * r4 + x] * sc;
                    v2u wv; wv.x = pk2(o_[0], o_[1]); wv.y = pk2(o_[2], o_[3]); *(v2u*)(op + 32 * dt + 8 * r4 + 4 * h_) = wv; }
        }
    }
}

constexpr int AS_RS = 144;
constexpr int AS_V = 0, AS_VW = 32 * AS_RS, AS_MRG = 0, AS_PS = 73728, AS_IMP = AS_PS + 16640, AS_MASK = AS_IMP + 6144;
static_assert(8 * 34 * 64 * 4 <= AS_PS && AS_MASK + 512 <= RING_BYTES, "sample attention LDS map");

__device__ __forceinline__ float xhalf_max(float x) { auto t_ = __builtin_amdgcn_permlane32_swap(__float_as_uint(x), __float_as_uint(x), false, false); return fmaxf(__uint_as_float(t_[0]), __uint_as_float(t_[1])); }
__device__ __forceinline__ float xhalf_sum(float x) { auto t_ = __builtin_amdgcn_permlane32_swap(__float_as_uint(x), __float_as_uint(x), false, false); return __uint_as_float(t_[0]) + __uint_as_float(t_[1]); }
struct ASrc { const float* kf; const float* vf; const bf16* kb; const bf16* vb; int rs; int nvalid; };
#define AS_TILE(SRC, KB0, LO_, HI_, DO_PV, DO_PS, m, lsum, O0, O1, invden, PSS_) do { \
        bf16x8 kfr[4]; \
        if ((SRC).kb) { const bf16* kp_ = (SRC).kb + (size_t)q * (SRC).rs + 8 * h_; _Pragma("unroll") for (int kk = 0; kk < 4; ++kk) kfr[kk] = *(const bf16x8*)(kp_ + 16 * kk); } \
        else { const float* kp_ = (SRC).kf + (size_t)q * (SRC).rs + 8 * h_; _Pragma("unroll") for (int kk = 0; kk < 4; ++kk) { const f32x4 a_ = *(const f32x4*)(kp_ + 16 * kk), b_ = *(const f32x4*)(kp_ + 16 * kk + 4); kfr[kk] = __builtin_bit_cast(bf16x8, pack8(a_, b_)); } } \
        if (DO_PV) { const int vr_ = lane >> 1, vh_ = lane & 1; v4u vv_[4]; \
            if (vr_ >= (SRC).nvalid) { _Pragma("unroll") for (int x = 0; x < 4; ++x) vv_[x] = (v4u){0u, 0u, 0u, 0u}; } \
            else if ((SRC).vb) { const bf16* vp_ = (SRC).vb + (size_t)vr_ * (SRC).rs + 32 * vh_; _Pragma("unroll") for (int x = 0; x < 4; ++x) vv_[x] = *(const v4u*)(vp_ + 8 * x); } \
            else { const float* vp_ = (SRC).vf + (size_t)vr_ * (SRC).rs + 32 * vh_; _Pragma("unroll") for (int x = 0; x < 4; ++x) vv_[x] = pack8(*(const f32x4*)(vp_ + 8 * x), *(const f32x4*)(vp_ + 8 * x + 4)); } \
            _Pragma("unroll") for (int x = 0; x < 4; ++x) *(LAS v4u*)(Vw + vr_ * AS_RS + vh_ * 64 + x * 16) = vv_[x]; } \
        f32x16 s_ = (f32x16){}; \
        _Pragma("unroll") for (int kk = 0; kk < 4; ++kk) s_ = mfma32(kfr[kk], qf[kk], s_); \
        float tmax_ = -INFINITY; \
        _Pragma("unroll") for (int r = 0; r < 16; ++r) { const int key_ = (KB0) + (r & 3) + 8 * (r >> 2) + 4 * h_; s_[r] = (key_ >= (LO_) && key_ <= (HI_)) ? s_[r] : -INFINITY; tmax_ = fmaxf(tmax_, s_[r]); } \
        tmax_ = xhalf_max(tmax_); \
        const float mn_ = fmaxf(m, tmax_), mu_ = (mn_ == -INFINITY) ? 0.f : mn_, al_ = fexp2(m - mu_); float ps_ = 0.f; \
        _Pragma("unroll") for (int r = 0; r < 16; ++r) { s_[r] = fexp2(s_[r] - mu_); ps_ += s_[r]; } \
        lsum = lsum * al_ + ps_; m = mn_; \
        if (DO_PV) { O0 *= al_; O1 *= al_; LDS_WAIT(); asm volatile("" ::: "memory"); \
            _Pragma("unroll") for (int s2 = 0; s2 < 2; ++s2) { const bf16x8 pf_ = cvt_frag(s_, s2); const int rA_ = 16 * s2 + 4 * h_; \
                O0 = mfma32(tr_frag(Vw, AS_RS, rA_, rA_ + 8, 16 * blk, lane), pf_, O0); O1 = mfma32(tr_frag(Vw, AS_RS, rA_, rA_ + 8, 32 + 16 * blk, lane), pf_, O1); } \
            LDS_WAIT(); asm volatile("" ::: "memory"); } \
        if (DO_PS) { _Pragma("unroll") for (int r = 0; r < 16; ++r) { const int n_ = (KB0) + (r & 3) + 8 * (r >> 2) + 4 * h_; float a_ = s_[r] * (invden); a_ += __shfl_xor(a_, 1); a_ += __shfl_xor(a_, 2); if (hr == 0) PS[tl * (PSS_) + n_] = a_; } } \
    } while (0)

__device__ __forceinline__ void attn_sample_unit(Frame& F, int l, int unit) {
    const int lane = F.lane, w = F.wave, tid = F.tid;
    const int q = lane & 31, h_ = lane >> 5, blk = (lane >> 4) & 1, tl = q >> 2, hr = q & 3;
    const int seq = unit >> 1, kvh = unit & 1, head = kvh * 4 + hr;
    const size_t row = (size_t)PM + seq * ST + tl;
    LAS unsigned char* Vw = F.lds + AS_V + w * AS_VW;
    LAS float* MRG = (LAS float*)(F.lds + AS_MRG);
    LAS float* PS = (LAS float*)(F.lds + AS_PS);
    LAS float* IMPw = (LAS float*)(F.lds + AS_IMP) + w * 192;
    LAS unsigned long long* MASKS = (LAS unsigned long long*)(F.lds + AS_MASK);
    __syncthreads();
    bf16x8 qf[4];
    { const bf16* qp = WSP(bf16, WS_QN) + row * 512 + head * 64 + 8 * h_;
#pragma unroll
      for (int kk = 0; kk < 4; ++kk) qf[kk] = *(const bf16x8*)(qp + 16 * kk); }
    const float* ngp = WSP(float, WS_NG) + row * 24 + head * 3; const float g0 = ngp[0], g1 = ngp[1], g2 = ngp[2];
    const int* ptab = (const int*)F.a->in[I_PT] + seq * NPG;
    f32x16 OA0 = (f32x16){}, OA1 = (f32x16){};

#define AS_PUBLISH(m, lsum, O0, O1) do { __syncthreads(); LAS float* mp_ = MRG + w * 34 * 64 + lane; mp_[0] = m; mp_[64] = lsum; \
        _Pragma("unroll") for (int r = 0; r < 16; ++r) { mp_[(2 + r) * 64] = O0[r]; mp_[(18 + r) * 64] = O1[r]; } __syncthreads(); } while (0)

    const bf16* CKk = WSP(bf16, WS_CK) + ((size_t)(seq * 2 + kvh) * 512) * 64; const bf16* CKv = CKk + (size_t)CMP_ROWS_J * 64;
    float mC = -INFINITY, lC = 0.f; f32x16 D0 = (f32x16){}, D1 = (f32x16){};
#pragma unroll 1
    for (int ti = w; ti < 16; ti += 8) { ASrc S{nullptr, nullptr, CKk + (size_t)ti * 32 * 64, CKv + (size_t)ti * 32 * 64, 64, 32}; AS_TILE(S, ti * 32, 0, 510, false, false, mC, lC, D0, D1, 0.f, 520); }
    { __syncthreads(); MRG[w * 128 + lane] = mC; MRG[w * 128 + 64 + lane] = xhalf_sum(lC); __syncthreads(); }
    float mT = -INFINITY;
#pragma unroll
    for (int x = 0; x < 8; ++x) mT = fmaxf(mT, MRG[x * 128 + lane]);
    float lT = 0.f;
#pragma unroll
    for (int x = 0; x < 8; ++x) { const float mx_ = MRG[x * 128 + lane]; lT += (mx_ == -INFINITY) ? 0.f : MRG[x * 128 + 64 + lane] * fexp2(mx_ - mT); }
    const float invC = lT > 0.f ? 1.0f / lT : 0.f;
    __syncthreads();
    { float mB = mT, lB = 0.f;
#pragma unroll 1
      for (int ti = w; ti < 16; ti += 8) { ASrc S{nullptr, nullptr, CKk + (size_t)ti * 32 * 64, CKv + (size_t)ti * 32 * 64, 64, 32}; AS_TILE(S, ti * 32, 0, 510, true, true, mB, lB, D0, D1, invC, 520); }
      AS_PUBLISH(mB, lB, D0, D1); }
    { const float sc = g0 * invC;
#pragma unroll 1
      for (int x = 0; x < 8; ++x) { const LAS float* mp = MRG + x * 34 * 64 + lane;
#pragma unroll
          for (int r = 0; r < 16; ++r) { OA0[r] += mp[(2 + r) * 64] * sc; OA1[r] += mp[(18 + r) * 64] * sc; } } }
    {
        const LAS float* pr = PS + w * 520; const int sa = lane, sb = lane + 64; float ia = 0.f, ib = 0.f;
#pragma unroll
        for (int n = 4 * sa - 1; n <= 4 * sa + 3; ++n) if (n >= 0) ia += pr[n];
#pragma unroll
        for (int n = 4 * sb - 1; n <= 4 * sb + 3; ++n) ib += pr[n];
        const bool fa = (sa == 0), fb = (sb == 127); const float va = fa ? 1e4f : ia, vb = fb ? 1e4f : ib;
        IMPw[sa] = va; IMPw[sb] = vb; LDS_WAIT(); asm volatile("" ::: "memory");
        int ra = fa ? 0 : 1, rb = fb ? 0 : 1;
#pragma unroll 8
        for (int i = 0; i < 128; ++i) { const float v = IMPw[i]; ra += (v > va || (v == va && i < sa)) ? 1 : 0; rb += (v > vb || (v == vb && i < sb)) ? 1 : 0; }
        const unsigned long long ma = __ballot(ra < 16), mb = __ballot(rb < 16);
        if (lane == 0) { MASKS[w * 4] = ma; MASKS[w * 4 + 1] = mb; }
    }
    __syncthreads();
    const unsigned long long mk0 = MASKS[tl * 4], mk1 = MASKS[tl * 4 + 1];
    unsigned long long U0 = 0ull, U1 = 0ull;
#pragma unroll
    for (int x = 0; x < 8; ++x) { U0 |= MASKS[x * 4]; U1 |= MASKS[x * 4 + 1]; }
    {
        float m = -INFINITY, ls = 0.f; D0 = (f32x16){}; D1 = (f32x16){};
        const int t = PAST + tl; int cnt = 0;
#pragma unroll 1
        for (int s = 0; s <= 128; ++s) {
            const bool in_u = (s < 64) ? ((U0 >> s) & 1ull) : ((s < 128) ? ((U1 >> (s - 64)) & 1ull) : true);
            if (!in_u) continue;
            const bool selb = (s < 64) ? ((mk0 >> s) & 1ull) : ((s < 128) ? ((mk1 >> (s - 64)) & 1ull) : true);
            const int nh = (s < 128) ? 2 : 1;
            for (int hf = 0; hf < nh; ++hf, ++cnt) {
                if ((cnt & 7) != w) continue;
                const int hi = selb ? t : -1;
                if (s < 128) { const int page = ptab[s >> 1], slot = (s & 1) * 64 + hf * 32;
                    const float* kp = FIN(I_CACHE) + (((((size_t)l * NPHYS + page) * PAGE + slot) * 4 + 2) * 2 + kvh) * 64;
                    ASrc S{kp, kp + 128, nullptr, nullptr, 512, 32}; AS_TILE(S, s * 64 + hf * 32, 0, hi, true, false, m, ls, D0, D1, 0.f, 520); }
                else { const bf16* kp = WSP(bf16, WS_KVS) + ((((size_t)0 * SB + seq) * 2 + kvh) * ST) * 64;
                    ASrc S{nullptr, nullptr, kp, kp + (size_t)SB * 2 * ST * 64, 64, ST}; AS_TILE(S, PAST, 0, hi, true, false, m, ls, D0, D1, 0.f, 520); }
            }
        }
        AS_PUBLISH(m, ls, D0, D1);
        float mt = -INFINITY;
#pragma unroll
        for (int x = 0; x < 8; ++x) mt = fmaxf(mt, MRG[x * 34 * 64 + lane]);
        float lt = 0.f; f32x16 T0 = (f32x16){}, T1 = (f32x16){};
#pragma unroll 1
        for (int x = 0; x < 8; ++x) { const LAS float* mp = MRG + x * 34 * 64 + lane; const float mx_ = mp[0]; const float f = (mx_ == -INFINITY) ? 0.f : fexp2(mx_ - mt); lt += mp[64] * f;
#pragma unroll
            for (int r = 0; r < 16; ++r) { T0[r] += mp[(2 + r) * 64] * f; T1[r] += mp[(18 + r) * 64] * f; } }
        lt = xhalf_sum(lt); const float sc = (lt > 0.f ? 1.0f / lt : 0.f) * g1; OA0 += T0 * sc; OA1 += T1 * sc;
    }
    {
        float m = -INFINITY, ls = 0.f; D0 = (f32x16){}; D1 = (f32x16){};
#pragma unroll 1
        for (int ti = w; ti < 17; ti += 8) {
            if (ti < 16) { const float* kp = FIN(I_CWIN) + (((((size_t)l * SB + seq) * WINB + ti * 32) * 2 + 0) * 2 + kvh) * 64;
                ASrc S{kp, kp + 128, nullptr, nullptr, 256, 32}; AS_TILE(S, ti * 32, tl, WINB + tl, true, false, m, ls, D0, D1, 0.f, 520); }
            else { const bf16* kp = WSP(bf16, WS_KVS) + ((((size_t)2 * SB + seq) * 2 + kvh) * ST) * 64;
                ASrc S{nullptr, nullptr, kp, kp + (size_t)SB * 2 * ST * 64, 64, ST}; AS_TILE(S, WINB, tl, WINB + tl, true, false, m, ls, D0, D1, 0.f, 520); }
        }
        AS_PUBLISH(m, ls, D0, D1);
        float mt = -INFINITY;
#pragma unroll
        for (int x = 0; x < 8; ++x) mt = fmaxf(mt, MRG[x * 34 * 64 + lane]);
        float lt = 0.f; f32x16 T0 = (f32x16){}, T1 = (f32x16){};
#pragma unroll 1
        for (int x = 0; x < 8; ++x) { const LAS float* mp = MRG + x * 34 * 64 + lane; const float mx_ = mp[0]; const float f = (mx_ == -INFINITY) ? 0.f : fexp2(mx_ - mt); lt += mp[64] * f;
#pragma unroll
            for (int r = 0; r < 16; ++r) { T0[r] += mp[(2 + r) * 64] * f; T1[r] += mp[(18 + r) * 64] * f; } }
        lt = xhalf_sum(lt); const float sc = (lt > 0.f ? 1.0f / lt : 0.f) * g2; OA0 += T0 * sc; OA1 += T1 * sc;
    }
#undef AS_PUBLISH
    if (w == 0) {
        bf16* op = WSP(bf16, WS_OA) + row * 512 + head * 64;
#pragma unroll
        for (int r4 = 0; r4 < 4; ++r4) { v2u a, b; a.x = pk2(OA0[4 * r4 + 0], OA0[4 * r4 + 1]); a.y = pk2(OA0[4 * r4 + 2], OA0[4 * r4 + 3]); b.x = pk2(OA1[4 * r4 + 0], OA1[4 * r4 + 1]); b.y = pk2(OA1[4 * r4 + 2], OA1[4 * r4 + 3]);
            *(v2u*)(op + 8 * r4 + 4 * h_) = a; *(v2u*)(op + 32 + 8 * r4 + 4 * h_) = b; }
    }
}

constexpr int AP_WS = 14336, AP_V = 0, AP_PS = 4608, AP_IMP = AP_PS + 8 * 264 * 4, AP_MASK = AP_IMP + 256, AP_LIST = AP_MASK + 64;
static_assert(AP_LIST + 2 * 192 <= AP_WS && 8 * AP_WS <= RING_BYTES, "prompt attention LDS map");
__device__ __forceinline__ void attn_prompt_unit(Frame& F, int l, int unit) {
    const int lane = F.lane, w = F.wave;
    const int q = lane & 31, h_ = lane >> 5, blk = (lane >> 4) & 1, tl = q >> 2, hr = q & 3;
    const int seq = unit >> 7, kvh = (unit >> 6) & 1, qt = unit & 63, head = kvh * 4 + hr;
    const int t0w = qt * 64 + 8 * w, t = t0w + tl; const size_t row = (size_t)seq * PT + t;
    LAS unsigned char* Vw = F.lds + w * AP_WS + AP_V; LAS float* PS = (LAS float*)(F.lds + w * AP_WS + AP_PS); LAS float* IMPw = (LAS float*)(F.lds + w * AP_WS + AP_IMP);
    LAS unsigned long long* MASKS = (LAS unsigned long long*)(F.lds + w * AP_WS + AP_MASK); LAS unsigned short* LIST = (LAS unsigned short*)(F.lds + w * AP_WS + AP_LIST);
    __syncthreads();
    bf16x8 qf[4];
    { const bf16* qp = WSP(bf16, WS_QN) + row * 512 + head * 64 + 8 * h_;
#pragma unroll
      for (int kk = 0; kk < 4; ++kk) qf[kk] = *(const bf16x8*)(qp + 16 * kk); }
    const float* ngp = WSP(float, WS_NG) + row * 24 + head * 3; const float g0 = ngp[0], g1 = ngp[1], g2 = ngp[2];
    for (int i = lane; i < 8 * 264; i += 64) PS[i] = 0.f;
    const bf16* CKk = WSP(bf16, WS_CK) + ((size_t)32768 + (seq * 2 + kvh) * 256) * 64; const bf16* CKv = CKk + (size_t)CMP_ROWS_J * 64;
    const bf16* KS = WSP(bf16, WS_KVB) + ((((size_t)0 * PB + seq) * 2 + kvh) * PT) * 64; const bf16* VS = KS + (size_t)PB * 2 * PT * 64;
    const bf16* KW = KS + (size_t)2 * PB * 2 * PT * 64; const bf16* VW = KW + (size_t)PB * 2 * PT * 64;
    const int hiCmin = (t0w >= 31) ? ((t0w - 31) >> 4) : -1;
    const int hiC = (t >= 31) ? ((t - 31) >> 4) : -1; const int nmaxw = (t0w + 7 >= 31) ? ((t0w + 7 - 31) >> 4) : -1; const int ntc = (nmaxw >= 0) ? (nmaxw >> 5) + 1 : 0;
    f32x16 OA0 = (f32x16){}, OA1 = (f32x16){}, D0 = (f32x16){}, D1 = (f32x16){};
    float m = -INFINITY, lsum = 0.f, invC = 0.f; unsigned long long mk0 = 0ull;
    bf16x8 nk[4]; v4u nv[4];
#define AP_LOADT(e_) do { const int kd_ = (int)((e_) >> 12), ti_ = (int)((e_) & 0xfffu); const bf16* kb_ = (kd_ < 2 ? CKk : (kd_ == 2 ? KS : KW)) + (size_t)ti_ * 32 * 64; const bf16* vb_ = (kd_ < 2 ? CKv : (kd_ == 2 ? VS : VW)) + (size_t)ti_ * 32 * 64; \
        _Pragma("unroll") for (int kk = 0; kk < 4; ++kk) nk[kk] = *(const bf16x8*)(kb_ + (size_t)q * 64 + 8 * h_ + 16 * kk); \
        _Pragma("unroll") for (int x = 0; x < 4; ++x) nv[x] = *(const v4u*)(vb_ + (size_t)(lane >> 1) * 64 + 32 * (lane & 1) + 8 * x); } while (0)
#define AP_RUN(N_) do { const int n_ = (N_); if (n_ > 0) { const unsigned e0_ = (unsigned)__builtin_amdgcn_readfirstlane((int)LIST[0]); AP_LOADT(e0_); } \
      _Pragma("unroll 1") for (int i_ = 0; i_ < n_; ++i_) { \
        const unsigned e_ = (unsigned)__builtin_amdgcn_readfirstlane((int)LIST[i_]); const int kind = (int)(e_ >> 12), ti = (int)(e_ & 0xfffu); \
        bf16x8 ck[4]; _Pragma("unroll") for (int kk = 0; kk < 4; ++kk) ck[kk] = nk[kk]; \
        if (kind != 0) { _Pragma("unroll") for (int x = 0; x < 4; ++x) *(LAS v4u*)(Vw + (lane >> 1) * AS_RS + (lane & 1) * 64 + x * 16) = nv[x]; } \
        if (i_ + 1 < n_) { const unsigned en_ = (unsigned)__builtin_amdgcn_readfirstlane((int)LIST[i_ + 1]); AP_LOADT(en_); } \
        if (kind != cur_kind) { \
            if (cur_kind == 0) { const float lt_ = xhalf_sum(lsum); invC = lt_ > 0.f ? 1.0f / lt_ : 0.f; } \
            else if (cur_kind == 2) { const float lt_ = xhalf_sum(lsum); const float sc_ = (lt_ > 0.f ? 1.0f / lt_ : 0.f) * g1; OA0 += D0 * sc_; OA1 += D1 * sc_; } \
            if (kind != 1) m = -INFINITY; lsum = 0.f; D0 = (f32x16){}; D1 = (f32x16){}; cur_kind = kind; } \
        const int kb = ti * 32; int lo, hi; \
        if (kind < 2) { lo = 0; hi = hiC; } else if (kind == 2) { lo = 0; hi = ((mk0 >> (ti >> 1)) & 1ull) ? t : -1; } else { lo = t - WINB; hi = t; } \
        f32x16 s_ = (f32x16){}; \
        _Pragma("unroll") for (int kk = 0; kk < 4; ++kk) s_ = mfma32(ck[kk], qf[kk], s_); \
          \
        const bool interior = (kind < 2) ? (hiCmin >= 0 && kb + 31 <= hiCmin) : ((kind == 2) ? (kb + 31 <= t0w) : (kb >= t0w + 7 - WINB && kb + 31 <= t0w)); \
        float tmax_ = -INFINITY, mu_, mn_; \
        if (interior) { const bool on_ = hi >= 0; \
            _Pragma("unroll") for (int r = 0; r < 16; ++r) tmax_ = fmaxf(tmax_, s_[r]); \
            tmax_ = on_ ? tmax_ : -INFINITY; tmax_ = xhalf_max(tmax_); \
            mn_ = fmaxf(m, tmax_); mu_ = (mn_ == -INFINITY) ? 0.f : mn_; const float mr_ = on_ ? mu_ : INFINITY; \
            _Pragma("unroll") for (int r = 0; r < 16; ++r) s_[r] = fexp2(s_[r] - mr_); \
        } else { \
            _Pragma("unroll") for (int r = 0; r < 16; ++r) { const int key_ = kb + (r & 3) + 8 * (r >> 2) + 4 * h_; s_[r] = (key_ >= lo && key_ <= hi) ? s_[r] : -INFINITY; tmax_ = fmaxf(tmax_, s_[r]); } \
            tmax_ = xhalf_max(tmax_); \
            mn_ = fmaxf(m, tmax_); mu_ = (mn_ == -INFINITY) ? 0.f : mn_; \
            _Pragma("unroll") for (int r = 0; r < 16; ++r) s_[r] = fexp2(s_[r] - mu_); \
        } \
        const float al_ = fexp2(m - mu_); float ps_ = 0.f; \
        _Pragma("unroll") for (int r = 0; r < 16; ++r) ps_ += s_[r]; \
        lsum = lsum * al_ + ps_; m = mn_; \
        if (kind != 0) { if (__ballot(al_ != 1.0f) != 0ull) { D0 *= al_; D1 *= al_; } LDS_WAIT(); asm volatile("" ::: "memory"); \
            _Pragma("unroll") for (int s2 = 0; s2 < 2; ++s2) { const bf16x8 pf_ = cvt_frag(s_, s2); const int rA_ = 16 * s2 + 4 * h_; \
                D0 = mfma32(tr_frag(Vw, AS_RS, rA_, rA_ + 8, 16 * blk, lane), pf_, D0); D1 = mfma32(tr_frag(Vw, AS_RS, rA_, rA_ + 8, 32 + 16 * blk, lane), pf_, D1); } \
            LDS_WAIT(); asm volatile("" ::: "memory"); } \
        if (kind == 1) { _Pragma("unroll") for (int r = 0; r < 16; ++r) { const int n2_ = kb + (r & 3) + 8 * (r >> 2) + 4 * h_; float a_ = s_[r] * invC; a_ += __shfl_xor(a_, 1); a_ += __shfl_xor(a_, 2); if (hr == 0) PS[tl * 264 + n2_] = a_; } } \
      } } while (0)
    int cur_kind = -1;
    if (lane < 2 * ntc) LIST[lane] = (unsigned short)(((lane >= ntc ? 1u : 0u) << 12) | (unsigned)(lane >= ntc ? lane - ntc : lane));
    LDS_WAIT(); asm volatile("" ::: "memory");
    AP_RUN(2 * ntc);
    if (cur_kind == 1) { const float sc = g0 * invC; OA0 = D0 * sc; OA1 = D1 * sc; }
    LDS_WAIT(); asm volatile("" ::: "memory");
#pragma unroll 1
    for (int tk = 0; tk < 8; ++tk) {
        const LAS float* pr = PS + tk * 264; const int s = lane; float imp = 0.f;
#pragma unroll
        for (int n = 4 * s - 1; n <= 4 * s + 3; ++n) if (n >= 0) imp += pr[n];
        const bool forced = (s == 0) || (s == qt) || (s == qt - 1), avail = s <= qt; const float val = avail ? (forced ? 1e4f : imp) : -1e4f;
        IMPw[s] = val; LDS_WAIT(); asm volatile("" ::: "memory");
        int rank = 0;
#pragma unroll 8
        for (int i = 0; i < 64; ++i) { const float v = IMPw[i]; rank += (v > val || (v == val && i < s)) ? 1 : 0; }
        const unsigned long long mk = __ballot(rank < 16);
        if (lane == 0) MASKS[tk] = mk;
        LDS_WAIT(); asm volatile("" ::: "memory");
    }
    mk0 = MASKS[tl]; unsigned long long wu = 0ull;
#pragma unroll
    for (int i = 0; i < 8; ++i) wu |= MASKS[i];
    wu &= (qt >= 63) ? ~0ull : ((1ull << (qt + 1)) - 1ull);
    const int nsel = 2 * __popcll(wu); const int tiLo = (t0w > WINB) ? ((t0w - WINB) >> 5) : 0, tiHi = (t0w + 7) >> 5, nwin = tiHi - tiLo + 1;
    if ((wu >> lane) & 1ull) { const int pos = 2 * __popcll(wu & ((1ull << lane) - 1ull)); LIST[pos] = (unsigned short)((2u << 12) | (unsigned)(2 * lane)); LIST[pos + 1] = (unsigned short)((2u << 12) | (unsigned)(2 * lane + 1)); }
    if (lane < nwin) LIST[nsel + lane] = (unsigned short)((3u << 12) | (unsigned)(tiLo + lane));
    LDS_WAIT(); asm volatile("" ::: "memory");
#ifdef DBG_COUNT
    if (lane == 0) { unsigned* CNT = (unsigned*)(F.ws + WS_CTL) + 3000; atomicAdd(CNT + 0, (unsigned)nsel); atomicAdd(CNT + 1, (unsigned)nwin); atomicAdd(CNT + 2, (unsigned)(2 * ntc)); atomicAdd(CNT + 3, 1u); }
#endif
    cur_kind = -1;
    AP_RUN(nsel + nwin);
    { const float lt = xhalf_sum(lsum); const float sc = (lt > 0.f ? 1.0f / lt : 0.f) * g2; OA0 += D0 * sc; OA1 += D1 * sc; }
#undef AP_RUN
#undef AP_LOADT
    {
        bf16* op = WSP(bf16, WS_OA) + row * 512 + head * 64;
#pragma unroll
        for (int r4 = 0; r4 < 4; ++r4) { v2u a, b; a.x = pk2(OA0[4 * r4 + 0], OA0[4 * r4 + 1]); a.y = pk2(OA0[4 * r4 + 2], OA0[4 * r4 + 3]); b.x = pk2(OA1[4 * r4 + 0], OA1[4 * r4 + 1]); b.y = pk2(OA1[4 * r4 + 2], OA1[4 * r4 + 3]);
            *(v2u*)(op + 8 * r4 + 4 * h_) = a; *(v2u*)(op + 32 + 8 * r4 + 4 * h_) = b; }
    }
}
#undef AS_TILE

#ifdef DBG_CHECK
__device__ __forceinline__ unsigned dbg_rand(unsigned x) { x ^= x >> 16; x *= 0x7feb352du; x ^= x >> 15; x *= 0x846ca68bu; x ^= x >> 16; return x; }
__device__ __forceinline__ bool dbg_bad(float got, float exp_, float rtol, float atol) { return !(fabsf(got - exp_) <= rtol * fabsf(exp_) + atol); }
__device__ __forceinline__ float bfr(float x) { return __uint_as_float(pk2(x, 0.f) << 16); }
__device__ __forceinline__ int dbg_row(unsigned r) { const unsigned k = r % 20u; if (k == 0) return (int)(PM + (r >> 8) % SM); if (k == 1) return (int)(((r >> 8) % PB) * PT + ((r >> 12) % 8)); if (k == 2) return (int)(((r >> 8) % PB) * PT + PT - 1 - ((r >> 12) % 8)); return (int)((r >> 5) % PM); }
__device__ __forceinline__ float dbg_rs(const Frame& F, int row, int lane) { const float* xr = xrow_in(F, 0, row); float ss = 0.f; for (int d = lane; d < DM; d += 64) ss += xr[d] * xr[d]; return 1.0f / sqrtf(wave_sum(ss) * (1.0f / DM) + EPS); }
__device__ __forceinline__ float dbg_h(const Frame& F, int row, int d, float rs) { const float* mod = WSP(float, WS_MOD) + (size_t)row_bb(row) * 6144; return bfr(xrow_in(F, 0, row)[d] * rs * FIN(I_N1G)[d] * (1.0f + mod[1024 + d]) + mod[d]); }

__device__ __forceinline__ void dbg_check_phase(Frame& F) {
    const int gw = F.bid * NWAVES + F.wave, NGW = F.G * NWAVES, lane = F.lane;
    unsigned* CNT = (unsigned*)(F.ws + WS_CTL) + 3000;
    LAS float* L = (LAS float*)(F.lds + F.wave * 16384);
#define DBG_FLAG(ch, cond) do { if (__any(cond) && lane == 0) atomicAdd(CNT + (ch), 1u); } while (0)
    for (int s = gw; s < 1536; s += NGW) {
        const unsigned r = dbg_rand(1000u + s); const int row = dbg_row(r); const float rs = dbg_rs(F, row, lane); const int kind = s % 6;
        const bool isp = row < PM; const int b = isp ? (row >> 12) : ((row - PM) >> 3), t = isp ? (row & (PT - 1)) : ((row - PM) & 7);
#define DBG_U(col, dst) do { float a_ = 0.f; for (int d_ = lane; d_ < DM; d_ += 64) a_ += dbg_h(F, row, d_, rs) * bfr(FIN(I_WIN)[(size_t)d_ * D_IN + (col)]); dst = wave_sum(a_); } while (0)
        if (kind == 0) {
            const int c = (r >> 3) % 768, j = c >> 7, k = (c >> 6) & 1, dd = c & 63; float u; DBG_U(O_NKV + c, u); bool bad = false;
            if (j < 4) bad = dbg_bad(F.out[(isp ? OUT_ROWS_P + (size_t)row * 512 : OUT_ROWS_S + (size_t)(row - PM) * 512) + c], u, 0.01f, 0.01f);
            else if (isp) { if (t >= PT - WINB) bad = dbg_bad(F.out[OUT_WIN_P + ((size_t)b * WINB + (t - (PT - WINB))) * 256 + (c - 512)], u, 0.01f, 0.01f); }
            else bad = dbg_bad(F.out[OUT_WIN_S + ((size_t)b * WINB + (WINB - ST) + t) * 256 + (c - 512)], u, 0.01f, 0.01f);
            if (isp) { if (j < 2) bad = bad || dbg_bad(bf1(WSP(bf16, WS_ACMP)[((size_t)j * CMP_ROWS_J + 32768 + (b * 2 + k) * 256 + (t >> 4)) * 1024 + (t & 15) * 64 + dd]), u, 0.01f, 0.01f);
                       else bad = bad || dbg_bad(bf1(WSP(bf16, WS_KVB)[((((size_t)(j - 2) * PB + b) * 2 + k) * PT + t) * 64 + dd]), u, 0.01f, 0.01f); }
            else if (j >= 2) bad = bad || dbg_bad(bf1(WSP(bf16, WS_KVS)[((((size_t)(j - 2) * SB + b) * 2 + k) * ST + t) * 64 + dd]), u, 0.01f, 0.01f);
            DBG_FLAG(0, bad);
        } else if (kind == 1) {
            const int gi = (r >> 3) % 24, c5 = (r >> 8) % 512, cm = (r >> 8) % 3072; float u0, u1, u2, u3; DBG_U(O_NG + gi, u0); DBG_U(O_RX + c5, u1); DBG_U(O_RGATE + c5, u2); DBG_U(O_MG + cm, u3);
            bool bad = dbg_bad(WSP(float, WS_NG)[(size_t)row * 24 + gi], 1.0f / (1.0f + expf(-u0)), 0.01f, 0.005f);
            bad = bad || dbg_bad(WSP(float, WS_RX)[(size_t)row * 512 + c5], u1, 0.01f, 0.01f);
            bad = bad || dbg_bad(bf1(WSP(bf16, WS_GG)[(size_t)row * 512 + c5]), gelu_tanh(u2), 0.02f, 0.01f);
            bad = bad || dbg_bad(bf1(WSP(bf16, WS_MGS)[(size_t)row * 3072 + cm]), 1.0f / (1.0f + expf(-u3)), 0.01f, 0.005f);
            DBG_FLAG(1, bad);
        } else if (kind == 2) {
            const int head = (r >> 13) % 4, dim = (r >> 16) % 64, c5 = (r >> 3) % 512; float x1, x2, uv, ug, uq; DBG_U(O_RQ + head * 128 + dim, x1); DBG_U(O_RQ + head * 128 + 64 + dim, x2); DBG_U(O_RV + c5, uv); DBG_U(O_RG + c5, ug); DBG_U(O_NQ + c5, uq);
            const float pos = (float)(isp ? t : PAST + t); const float ang = pos * (float)pow(10000.0, -(double)dim / 64.0); float sn, cs; sincos_acc(ang, sn, cs);
            const bf16* RQ = WSP(bf16, WS_RQ);
            bool bad = dbg_bad(bf1(RQ[(size_t)row * 512 + head * 128 + dim]), x1 * cs - x2 * sn, 0.02f, 0.02f) || dbg_bad(bf1(RQ[(size_t)row * 512 + head * 128 + 64 + dim]), x1 * sn + x2 * cs, 0.02f, 0.02f);
            bad = bad || dbg_bad(bf1(RQ[(size_t)2 * MT * 512 + (size_t)row * 512 + c5]), uv, 0.01f, 0.01f) || dbg_bad(bf1(RQ[(size_t)3 * MT * 512 + (size_t)row * 512 + c5]), ug, 0.01f, 0.01f);
            bad = bad || dbg_bad(bf1(WSP(bf16, WS_QN)[(size_t)row * 512 + c5]), uq * QSCALE, 0.01f, 0.005f);
            DBG_FLAG(2, bad);
        }
#undef DBG_U
    }
    for (int s = gw; s < 128; s += NGW) {
        const unsigned r = dbg_rand(3000u + s); const int j = r & 1; const bool smp = ((r >> 1) & 3) != 0;
        const int grp = smp ? (int)((r >> 3) % 64) : (int)((r >> 3) % 8), nmax = smp ? 511 : 255; int n = (r >> 10) % nmax; if (((r >> 20) & 7) == 0) n = nmax - 1;
        const size_t rj = smp ? (size_t)grp * 512 + n : (size_t)32768 + grp * 256 + n;
        const bf16* A = WSP(bf16, WS_ACMP) + ((size_t)j * CMP_ROWS_J + rj) * 1024;
        const float* w1 = FIN(I_W1) + (size_t)j * 2048 * 128; const float* pe = FIN(I_PE) + j * 2048;
        for (int hh = 0; hh < 2; ++hh) { const int h = lane + 64 * hh; float a = FIN(I_B1)[j * 128 + h];
            for (int i = 0; i < 1024; ++i) a += (bf1(A[i]) + pe[i]) * w1[(size_t)i * 128 + h] + (bf1(A[1024 + i]) + pe[1024 + i]) * w1[(size_t)(1024 + i) * 128 + h];
            L[h] = gelu_tanh(a); }
        LDS_WAIT(); asm volatile("" ::: "memory");
        float o = 0.f; for (int h = 0; h < 128; ++h) o += L[h] * FIN(I_W2)[((size_t)j * 128 + h) * 64 + lane];
        const float got = bf1(WSP(bf16, WS_CK)[((size_t)j * CMP_ROWS_J + rj) * 64 + lane]);
        { const bool bd = dbg_bad(got, o, 0.05f, 0.03f); const unsigned long long mk = __ballot(bd); if (lane == 0 && mk) atomicAdd(CNT + 3, (unsigned)__popcll(mk)); }
        LDS_WAIT(); asm volatile("" ::: "memory");
    }
    for (int s = gw; s < 128; s += NGW) {
        const unsigned r = dbg_rand(3500u + s); const int j = r & 1; const bool smp = ((r >> 1) & 3) != 0;
        const int grp = smp ? (int)((r >> 3) % 64) : (int)((r >> 3) % 8), nmax = smp ? 511 : 255; const int n = (r >> 10) % nmax;
        const size_t rj = smp ? (size_t)grp * 512 + n : (size_t)32768 + grp * 256 + n, row = (size_t)j * CMP_ROWS_J + rj;
        const bf16* A = WSP(bf16, WS_ACMP) + row * 1024; const float* w1 = FIN(I_W1) + (size_t)j * 2048 * 128; const bf16* LH = WSP(bf16, WS_LH);
        unsigned nb = 0;
        for (int hh = 0; hh < 2; ++hh) { const int h = lane + 64 * hh; float lo = 0.f, hi = 0.f;
            for (int i = 0; i < 1024; ++i) { const float av = bf1(A[i]); lo += av * bfr(w1[(size_t)i * 128 + h]); hi += av * bfr(w1[(size_t)(1024 + i) * 128 + h]); }
            const bool bd = dbg_bad(bf1(LH[row * 256 + h]), lo, 0.02f, 0.02f) || dbg_bad(bf1(LH[row * 256 + 128 + h]), hi, 0.02f, 0.02f); nb += (unsigned)__popcll(__ballot(bd)); }
        if (lane == 0 && nb) atomicAdd(CNT + 9, nb);
        for (int hh = 0; hh < 2; ++hh) { const int h = lane + 64 * hh; L[h] = gelu_tanh(bf1(LH[row * 256 + h]) + bf1(LH[(row + 1) * 256 + 128 + h]) + WSP(float, WS_SMALLW + SW_CB)[j * 128 + h]); }
        LDS_WAIT(); asm volatile("" ::: "memory");
        float o = 0.f; for (int h = 0; h < 128; ++h) o += bfr(L[h]) * bfr(FIN(I_W2)[((size_t)j * 128 + h) * 64 + lane]);
        { const bool bd = dbg_bad(bf1(WSP(bf16, WS_CK)[row * 64 + lane]), o, 0.03f, 0.01f); const unsigned long long mk = __ballot(bd); if (lane == 0 && mk) atomicAdd(CNT + 11, (unsigned)__popcll(mk)); }
        LDS_WAIT(); asm volatile("" ::: "memory");
    }
    for (int s = gw; s < 64; s += NGW) {
        const unsigned r = dbg_rand(3700u + s); const int j = r & 1, half = (r >> 1) & 1, h = (r >> 2) % 128; const bf16* W1T = WSP(bf16, WS_SMALLW + SW_W1T) + ((size_t)j * 256 + half * 128 + h) * 1024;
        const float* w1 = FIN(I_W1) + ((size_t)j * 32 + half * 16) * 64 * 128 + h; unsigned nb = 0;
        for (int k = lane; k < 1024; k += 64) nb += (unsigned)__popcll(__ballot(dbg_bad(bf1(W1T[k]), w1[(size_t)k * 128], 0.01f, 0.0001f)));
        if (lane == 0 && nb) atomicAdd(CNT + 12, nb);
        const bool smp = ((r >> 9) & 3) != 0; const int grp = smp ? (int)((r >> 11) % 64) : (int)((r >> 11) % 8), n = (r >> 17) % (smp ? 511 : 255);
        const size_t row = (size_t)j * CMP_ROWS_J + (smp ? (size_t)grp * 512 + n : (size_t)32768 + grp * 256 + n); const bf16* A = WSP(bf16, WS_ACMP) + row * 1024;
        float a = 0.f; for (int k = lane; k < 1024; k += 64) a += bf1(A[k]) * bf1(W1T[k]); a = wave_sum(a);
        DBG_FLAG(13, dbg_bad(bf1(WSP(bf16, WS_LH)[row * 256 + half * 128 + h]), a, 0.02f, 0.02f));
    }
    for (int s = gw; s < 4; s += NGW) {
        const int j = s >> 1, h = (s & 1) * 64 + lane; const float* w1 = FIN(I_W1) + (size_t)j * 2048 * 128; const float* pe = FIN(I_PE) + j * 2048;
        float a = FIN(I_B1)[j * 128 + h]; for (int i = 0; i < 2048; ++i) a += pe[i] * w1[(size_t)i * 128 + h];
        const unsigned long long mk = __ballot(dbg_bad(WSP(float, WS_SMALLW + SW_CB)[j * 128 + h], a, 0.001f, 0.0005f)); if (lane == 0 && mk) atomicAdd(CNT + 10, (unsigned)__popcll(mk));
    }
    for (int s = gw; s < 96; s += NGW) {
        const unsigned r = dbg_rand(4000u + s); const bool smp = (s % 3) == 2;
        int seq, kvh = (r >> 4) & 1, t, tl = 0; size_t row;
        if (smp) { seq = (r >> 5) % SB; tl = (r >> 10) % ST; t = PAST + tl; row = (size_t)PM + seq * ST + tl; }
        else { seq = (r >> 5) % PB; const unsigned k = (r >> 8) % 8u; t = (k == 0) ? (int)((r >> 12) % 40) : (k == 1) ? PT - 1 - (int)((r >> 12) % 70) : (int)((r >> 12) % PT); row = (size_t)seq * PT + t; }
        const int N = smp ? 511 : 255, NS = smp ? 129 : 64, cur = t >> 6;
        LAS float* Q = L; LAS float* SC = L + 256; LAS float* PSUM = L + 256 + 2048; LAS float* OUT = L + 256 + 2048 + 512;
        for (int i = lane; i < 256; i += 64) Q[i] = bf1(WSP(bf16, WS_QN)[row * 512 + (kvh * 4 + (i >> 6)) * 64 + (i & 63)]);
        for (int i = lane; i < 768; i += 64) OUT[i] = 0.f;
        LDS_WAIT(); asm volatile("" ::: "memory");
        const bf16* CKk = WSP(bf16, WS_CK) + (smp ? (size_t)(seq * 2 + kvh) * 512 : (size_t)32768 + (seq * 2 + kvh) * 256) * 64; const bf16* CKv = CKk + (size_t)CMP_ROWS_J * 64;
        const int nvis = smp ? 511 : ((t >= 31) ? ((t - 31) >> 4) + 1 : 0);
        for (int i = lane; i < 512; i += 64) PSUM[i] = 0.f;
        for (int hr = 0; hr < 4; ++hr) {
            float mx = -INFINITY; for (int n = lane; n < nvis; n += 64) { float a = 0.f; for (int d = 0; d < 64; ++d) a += Q[hr * 64 + d] * bf1(CKk[(size_t)n * 64 + d]); SC[n] = a; mx = fmaxf(mx, a); }
            for (int o = 1; o < 64; o <<= 1) mx = fmaxf(mx, __shfl_xor(mx, o));
            float den = 0.f; for (int n = lane; n < nvis; n += 64) { const float e = exp2f(SC[n] - mx); SC[n] = e; den += e; } den = wave_sum(den);
            LDS_WAIT(); asm volatile("" ::: "memory");
            if (nvis > 0) { float o = 0.f; for (int n = 0; n < nvis; ++n) o += SC[n] * bf1(CKv[(size_t)n * 64 + lane]); OUT[hr * 64 + lane] = o / den;
                for (int n = lane; n < nvis; n += 64) PSUM[n] += SC[n] / den; }
            LDS_WAIT(); asm volatile("" ::: "memory");
        }
        LAS float* IMP = SC; LAS float* SELB = SC + 256;
        for (int sblk = lane; sblk < NS; sblk += 64) { float imp = 0.f; for (int n = 4 * sblk - 1; n <= 4 * sblk + 3; ++n) if (n >= 0 && n < N) imp += PSUM[n];
            const bool forced = sblk == 0 || sblk == cur || sblk == cur - 1, avail = sblk * 64 <= t; IMP[sblk] = avail ? (forced ? 1e4f : imp) : -1e4f; SELB[sblk] = 0.f; }
        LDS_WAIT(); asm volatile("" ::: "memory");
        for (int pick = 0; pick < 16 && pick < NS; ++pick) { float bv = -INFINITY; int bi = 1 << 30;
            for (int sblk = lane; sblk < NS; sblk += 64) { const float v = (SELB[sblk] != 0.f) ? -INFINITY : IMP[sblk]; if (v > bv || (v == bv && sblk < bi)) { bv = v; bi = sblk; } }
            for (int o = 1; o < 64; o <<= 1) { const float ov = __shfl_xor(bv, o); const int oi = __shfl_xor(bi, o); if (ov > bv || (ov == bv && oi < bi)) { bv = ov; bi = oi; } }
            if (lane == 0) SELB[bi] = 1.f; LDS_WAIT(); asm volatile("" ::: "memory"); }
        for (int br = 1; br < 3; ++br) for (int hr = 0; hr < 4; ++hr) {
            float mx = -INFINITY, den = 0.f, o = 0.f;
            const int plo = (br == 1) ? 0 : (t - WINB < 0 ? 0 : t - WINB), phi = t;
            for (int p = plo; p <= phi; ++p) {
                if (br == 1 && SELB[p >> 6] == 0.f) { p |= 63; continue; }
                const float* kf = nullptr; const bf16* kb = nullptr; const float* vf = nullptr; const bf16* vb = nullptr;
                const int jk = (br == 1) ? 2 : 4;
                if (!smp) { kb = WSP(bf16, WS_KVB) + ((((size_t)(jk - 2) * PB + seq) * 2 + kvh) * PT + p) * 64; vb = kb + (size_t)PB * 2 * PT * 64; }
                else if (p >= PAST) { kb = WSP(bf16, WS_KVS) + ((((size_t)(jk - 2) * SB + seq) * 2 + kvh) * ST + (p - PAST)) * 64; vb = kb + (size_t)SB * 2 * ST * 64; }
                else if (br == 1) { const int page = ((const int*)F.a->in[I_PT])[seq * NPG + (p >> 7)]; kf = FIN(I_CACHE) + ((((size_t)page * PAGE + (p & 127)) * 4 + 2) * 2 + kvh) * 64; vf = kf + 128; }
                else { kf = FIN(I_CWIN) + ((((size_t)seq * WINB + (p - (PAST - WINB))) * 2 + 0) * 2 + kvh) * 64; vf = kf + 128; }
                float a = 0.f; for (int d = 0; d < 64; ++d) a += Q[hr * 64 + d] * (kb ? bf1(kb[d]) : bfr(kf[d]));
                const float vv = vb ? bf1(vb[lane]) : bfr(vf[lane]);
                const float mn = fmaxf(mx, a), al = exp2f(mx - mn), e = exp2f(a - mn); den = den * al + e; o = o * al + e * vv; mx = mn;
            }
            OUT[(br * 4 + hr) * 64 + lane] = (den > 0.f) ? o / den : 0.f;
        }
        LDS_WAIT(); asm volatile("" ::: "memory");
        bool bad = false;
        for (int hr = 0; hr < 4; ++hr) { const float* ng = WSP(float, WS_NG) + row * 24 + (kvh * 4 + hr) * 3;
            const float e = ng[0] * OUT[(0 * 4 + hr) * 64 + lane] + ng[1] * OUT[(1 * 4 + hr) * 64 + lane] + ng[2] * OUT[(2 * 4 + hr) * 64 + lane];
            bad = bad || dbg_bad(bf1(WSP(bf16, WS_OA)[row * 512 + (kvh * 4 + hr) * 64 + lane]), e, 0.04f, 0.004f); }
        DBG_FLAG(smp ? 5 : 4, bad);
        LDS_WAIT(); asm volatile("" ::: "memory");
    }
    for (int s = gw; s < 96; s += NGW) {
        const unsigned r = dbg_rand(6000u + s); const bool smp = (s % 3) == 2; const int h = (r >> 3) & 3; const float lg = ret_log_g(h);
        const bf16* RQ = WSP(bf16, WS_RQ); const bf16* RK = RQ + (size_t)MT * 512; const bf16* RV = RQ + (size_t)2 * MT * 512; const bf16* RG = RQ + (size_t)3 * MT * 512;
        int seq, t; size_t row0; if (smp) { seq = (r >> 5) % SB; t = (r >> 10) % ST; row0 = (size_t)PM + seq * ST; } else { seq = (r >> 5) % PB; const unsigned k = (r >> 8) % 4u; t = (k == 0) ? (int)((r >> 12) % 300) : (int)((r >> 12) % PT); row0 = (size_t)seq * PT; }
        float o0 = 0.f, o1 = 0.f;
        for (int d = lane; d < 128; d += 64) L[d] = bf1(RQ[(row0 + t) * 512 + h * 128 + d]);
        LDS_WAIT(); asm volatile("" ::: "memory");
        for (int j = 0; j <= t; ++j) { float a = 0.f; for (int d = 0; d < 128; ++d) a += L[d] * bf1(RK[(row0 + j) * 512 + h * 128 + d]);
            a *= expf((float)(t - j) * lg); o0 += a * bf1(RV[(row0 + j) * 512 + h * 128 + lane]); o1 += a * bf1(RV[(row0 + j) * 512 + h * 128 + 64 + lane]); }
        if (smp) { const float* S0 = FIN(I_SRET) + (((size_t)0 * SB + seq) * 4 + h) * 16384; const float cr = expf((float)(t + 1) * lg);
            for (int d = 0; d < 128; ++d) { o0 += L[d] * S0[d * 128 + lane] * cr; o1 += L[d] * S0[d * 128 + 64 + lane] * cr; } }
        const float mean = wave_sum(o0 + o1) * (1.0f / 128.0f); const float var = wave_sum((o0 - mean) * (o0 - mean) + (o1 - mean) * (o1 - mean)) * (1.0f / 128.0f), rstd = 1.0f / sqrtf(var + EPS);
        const float* GN = FIN(I_GNG) + h * 128; const bf16* OR_ = WSP(bf16, WS_OA) + (size_t)MT * 512;
        const float g0 = bf1(RG[(row0 + t) * 512 + h * 128 + lane]), g1 = bf1(RG[(row0 + t) * 512 + h * 128 + 64 + lane]);
        const float e0 = (o0 - mean) * rstd * GN[lane] * (g0 / (1.0f + expf(-g0))), e1 = (o1 - mean) * rstd * GN[64 + lane] * (g1 / (1.0f + expf(-g1)));
        DBG_FLAG(6, dbg_bad(bf1(OR_[(row0 + t) * 512 + h * 128 + lane]), e0, 0.04f, 0.02f) || dbg_bad(bf1(OR_[(row0 + t) * 512 + h * 128 + 64 + lane]), e1, 0.04f, 0.02f));
        const int d = (r >> 20) % 128, T = smp ? ST : PT; float s0 = 0.f, s1 = 0.f;
        for (int j = 0; j < T; ++j) { const float kk = bf1(RK[(row0 + j) * 512 + h * 128 + d]) * expf((float)(T - 1 - j) * lg); s0 += kk * bf1(RV[(row0 + j) * 512 + h * 128 + lane]); s1 += kk * bf1(RV[(row0 + j) * 512 + h * 128 + 64 + lane]); }
        const float* SO;
        if (smp) { const float* S0 = FIN(I_SRET) + (((size_t)0 * SB + seq) * 4 + h) * 16384; const float g8 = expf(8.0f * lg); s0 += g8 * S0[d * 128 + lane]; s1 += g8 * S0[d * 128 + 64 + lane]; SO = F.out + OUT_RET_S + (((size_t)0 * SB + seq) * 4 + h) * 16384; }
        else SO = F.out + OUT_RET_P + (((size_t)0 * PB + seq) * 4 + h) * 16384;
        DBG_FLAG(7, dbg_bad(SO[d * 128 + lane], s0, 0.02f, 0.02f) || dbg_bad(SO[d * 128 + 64 + lane], s1, 0.02f, 0.02f));
        LDS_WAIT(); asm volatile("" ::: "memory");
    }
    for (int s = gw; s < 48; s += NGW) {
        const unsigned r = dbg_rand(8000u + s); const bool smp = (s % 3) == 2; const int blk = (r >> 3) & 7, c = blk * 64 + lane;
        int seq, T; size_t row0; if (smp) { seq = (r >> 6) % SB; T = ST; row0 = (size_t)PM + seq * ST; } else { seq = (r >> 6) % PB; T = 1 + (int)((r >> 10) % ((s & 1) ? 200 : PT)); row0 = (size_t)seq * PT; }
        const float* RX = WSP(float, WS_RX); const float* cw = FIN(I_RCW); const float cb = FIN(I_RCB)[c];
        float x3 = 0.f, x2 = 0.f, x1 = 0.f, h = 0.f;
        if (smp) { const float* cv = FIN(I_SCONV) + (size_t)seq * 3 * 512; x3 = cv[c]; x2 = cv[512 + c]; x1 = cv[1024 + c]; h = FIN(I_SH)[(size_t)seq * 512 + c]; }
        const float sp = log1pf(expf(-FIN(I_LAM)[c])); const float* wa = FIN(I_RWA) + (size_t)blk * 4096; const float* wx = FIN(I_RWX) + (size_t)blk * 4096;
        for (int t = 0; t < T; ++t) { const float x0 = RX[(row0 + t) * 512 + c]; const float xc = cb + cw[c] * x3 + cw[512 + c] * x2 + cw[1024 + c] * x1 + cw[1536 + c] * x0; x3 = x2; x2 = x1; x1 = x0;
            L[lane] = xc; LDS_WAIT(); asm volatile("" ::: "memory");
            float ra = FIN(I_RBA)[c], ri = FIN(I_RBX)[c]; for (int i = 0; i < 64; ++i) { ra += L[i] * wa[i * 64 + lane]; ri += L[i] * wx[i * 64 + lane]; }
            LDS_WAIT(); asm volatile("" ::: "memory");
            const float rr = 1.0f / (1.0f + expf(-ra)), ii = 1.0f / (1.0f + expf(-ri)), la = -8.0f * rr * sp, a = expf(la); h = a * h + sqrtf(-expm1f(2.0f * la)) * (ii * xc); }
        const size_t o = (row0 + T - 1) * 512 + c; const float e = h * bf1(WSP(bf16, WS_GG)[o]);
        DBG_FLAG(8, dbg_bad(bf1((WSP(bf16, WS_OA) + (size_t)2 * MT * 512)[o]), e, 0.04f, 0.01f));
    }
    for (int s = gw; s < 512; s += NGW) {
        const unsigned r = dbg_rand(9000u + s); const int row = dbg_row(r), col = (r >> 7) % DM;
        float e = 0.f;
        for (int br = 0; br < 3; ++br) { const bf16* O = WSP(bf16, WS_OA) + (size_t)br * MT * 512 + (size_t)row * 512; const float* W = FIN(br == 0 ? I_WBRA : (br == 1 ? I_WBRB : I_WBRC));
            float a = 0.f; for (int k = lane; k < 512; k += 64) a += bf1(O[k]) * bfr(W[(size_t)k * DM + col]); a = wave_sum(a); e += bf1(WSP(bf16, WS_MGS)[(size_t)row * 3072 + br * 1024 + col]) * a; }
        DBG_FLAG(20, dbg_bad(bf1(WSP(bf16, WS_MRG)[(size_t)row * DM + col]), e, 0.03f, 0.01f));
        const float* mod = WSP(float, WS_MOD) + (size_t)row_bb(row) * 6144;
        { float a = 0.f; for (int k = lane; k < DM; k += 64) a += bf1(WSP(bf16, WS_MRG)[(size_t)row * DM + k]) * bfr(FIN(I_WOUT)[(size_t)k * DM + col]); a = wave_sum(a);
          const float ex = xrow_in(F, 0, row)[col] + mod[2048 + col] * a; DBG_FLAG(21, dbg_bad(WSP(float, WS_X1)[(size_t)row * DM + col], ex, 0.005f, 0.005f)); }
        { const float* xr = WSP(float, WS_X1) + (size_t)row * DM; float ss = 0.f; for (int d = lane; d < DM; d += 64) ss += xr[d] * xr[d]; const float rs = 1.0f / sqrtf(wave_sum(ss) * (1.0f / DM) + EPS);
          const int c2 = (r >> 9) % NUP; float a = 0.f; for (int d = lane; d < DM; d += 64) a += bfr(xr[d] * rs * FIN(I_N2G)[d] * (1.0f + mod[4096 + d]) + mod[3072 + d]) * bfr(FIN(I_WUP)[(size_t)d * NUP + c2]); a = wave_sum(a);
          const float got = c2 < DFF ? bf1(WSP(bf16, WS_GP)[(size_t)row * DFF + c2]) : bf1((WSP(bf16, WS_GP) + (size_t)MT * DFF)[(size_t)row * DFF + c2 - DFF]); DBG_FLAG(22, dbg_bad(got, a, 0.02f, 0.01f)); }
        { const int c3 = (r >> 11) % DFF; const bf16* GP = WSP(bf16, WS_GP); const bf16* VAL = GP + (size_t)MT * DFF; const float* cw = FIN(I_FCW);
          const bool isp = row < PM; const int t = isp ? (row & (PT - 1)) : ((row - PM) & 7); float xm2, xm1;
          if (t >= 2) { xm2 = bf1(GP[(size_t)(row - 2) * DFF + c3]); xm1 = bf1(GP[(size_t)(row - 1) * DFF + c3]); }
          else if (isp) { xm2 = 0.f; xm1 = (t == 1) ? bf1(GP[(size_t)(row - 1) * DFF + c3]) : 0.f; }
          else { const float* st = FIN(I_SFFN) + ((size_t)((row - PM) >> 3) * 2) * DFF + c3; xm2 = (t == 0) ? st[0] : st[DFF]; xm1 = (t == 0) ? st[DFF] : bf1(GP[(size_t)(row - 1) * DFF + c3]); }
          const float y = FIN(I_FCB)[c3] + cw[c3] * xm2 + cw[DFF + c3] * xm1 + cw[2 * DFF + c3] * bf1(GP[(size_t)row * DFF + c3]); const float ex = (y / (1.0f + expf(-y))) * bf1(VAL[(size_t)row * DFF + c3]);
          DBG_FLAG(23, dbg_bad(bf1((GP + (size_t)2 * MT * DFF)[(size_t)row * DFF + c3]), ex, 0.02f, 0.005f)); }
        { const bf16* ACT = WSP(bf16, WS_GP) + (size_t)2 * MT * DFF + (size_t)row * DFF; float a = 0.f; for (int k = lane; k < DFF; k += 64) a += bf1(ACT[k]) * bfr(FIN(I_WDN)[(size_t)k * DM + col]); a = wave_sum(a);
          const float ex = WSP(float, WS_X1)[(size_t)row * DM + col] + mod[5120 + col] * a; DBG_FLAG(24, dbg_bad(WSP(float, WS_X2)[(size_t)row * DM + col], ex, 0.005f, 0.005f)); }
    }
#undef DBG_FLAG
}
__device__ __forceinline__ void dbg_report_phase(Frame& F) {
    const unsigned* CNT = (const unsigned*)(F.ws + WS_CTL) + 3000;
    const size_t ooff[14] = {OUT_Y, OUT_Y + (size_t)PM * DM, OUT_ROWS_P, OUT_ROWS_S, OUT_WIN_P, OUT_WIN_S, OUT_RET_P, OUT_RET_S, OUT_H_P, OUT_H_S, OUT_CV_P, OUT_CV_S, OUT_FC_P, OUT_FC_S};
    if (F.bid == 0 && F.tid < 14) { const int b = F.tid; const unsigned c = CNT[b]; const int cnt = 1 + (int)(c > 1000u ? 1000u : c);
        for (int i = 0; i < cnt; ++i) ((unsigned*)F.out)[ooff[b] + 7 + 2 * i] = 0xAAAAAAAAu; }
}
#endif

#ifndef DBG_SUB
#define DBG_SUB 0xFFFF
#endif
#ifndef DBG_MAXPH
#define DBG_MAXPH N_PHASES
#endif
#ifndef DBG_REPEAT
#define DBG_REPEAT 0
#endif
#ifndef DBG_MASK
#define DBG_MASK 0xFFFF
#endif
#define IN(k) (lo <= (k) && (k) < hi)
#ifdef DBG_TIME
#define SEAM(k) do { if ((k) + 1 < hi) { if (MK_N_LAUNCHES == 1) xcd_barrier(bar); } if (F.bid == 0 && F.tid == 0) ((unsigned long long*)(F.ws + WS_CTL))[2048 + (k) + 1] = __builtin_amdgcn_s_memrealtime(); } while (0)
#else
#define SEAM(k) do { if ((k) + 1 < hi) { if (MK_N_LAUNCHES == 1) xcd_barrier(bar); } } while (0)
#endif
template <int l> __device__ __forceinline__ void ph_win(Frame& F) { unsigned char* ws = F.ws;
    pg8::Gemm g{(const pg8::bf16_t*)(ws + WS_H), (const pg8::bf16_t*)(ws + WS_WIN) + (size_t)l * NIN * DM, MT, NIN, DM};
    pg8::StaticOrder S; S.init(MT, NIN, F.G, F.bid); EpiWin E{ws, F.out, l};
    pg8::gemm_phase<EpiWin, pg8::StaticOrder, true, true>(F.lds, g, S, E); }
template <int l> __device__ __forceinline__ void ph_mix1(Frame& F) { unsigned char* ws = F.ws;
    if (DBG_SUB & 1) { launder(F);
        pg8::Gemm g{(const pg8::bf16_t*)(ws + WS_ACMP) + (size_t)l * CMP_ROWS * 1024, (const pg8::bf16_t*)(ws + WS_SMALLW + SW_W1T) + (size_t)l * 512 * 1024, CMP_ROWS, 512, 1024};
        CmpOrder S{F.G, F.bid}; EpiLH E{(bf16*)(ws + WS_LH)};
        pg8::gemm_phase<EpiLH, CmpOrder, true, true>(F.lds, g, S, E); }
    {
        unsigned* ctr = (unsigned*)(F.ws + WS_CTL) + 3210 + l; volatile LAS int* QI = (volatile LAS int*)(F.lds + MISC_OFF + 128);
#pragma unroll 1
        for (;;) {
            __syncthreads();
            if (F.tid == 0) QI[0] = (int)__hip_atomic_fetch_add(ctr, 1u, __ATOMIC_RELAXED, __HIP_MEMORY_SCOPE_AGENT);
            __syncthreads();
            const int u = __builtin_amdgcn_readfirstlane(QI[0]);
            if (u >= 768) break;
            launder(F);
            if (u < 256) rglru_unit<0>(F, l, u); else ret_local_unit(F, u - 256);
        }
        __syncthreads();
    } }
template <int l> __device__ __forceinline__ void ph_mix2(Frame& F) { cmp2_phase(F, l); ret_scan_phase(F, l); rglru_carry_phase(F, l); }
constexpr int MQ_PA = 384, MQ_SA = MQ_PA + 64, MQ_PB = MQ_SA + 128, MQ_RG1 = MQ_PB + 256, MQ_RO = MQ_RG1 + 512, MQ_RS = MQ_RO + 128, MQ_RG2 = MQ_RS + 32;
template <int l> __device__ __forceinline__ void ph_mix3(Frame& F) {
    unsigned* ctr = (unsigned*)(F.ws + WS_CTL) + 3200 + l;
    volatile LAS int* QI = (volatile LAS int*)(F.lds + MISC_OFF + 128);
#pragma unroll 1
    for (;;) {
        __syncthreads();
        if (F.tid == 0) QI[0] = (int)__hip_atomic_fetch_add(ctr, 1u, __ATOMIC_RELAXED, __HIP_MEMORY_SCOPE_AGENT);
        __syncthreads();
        const int u = __builtin_amdgcn_readfirstlane(QI[0]);
        if (u >= MQ_RG2) break;
        launder(F);
        if (u < MQ_PA || (u >= MQ_SA && u < MQ_PB)) { const int v = (u < MQ_PA) ? u : u - MQ_SA + MQ_PA; attn_prompt_unit(F, l, (v & 7) * 64 + 63 - (v >> 3)); }
        else if (u < MQ_SA) { attn_sample_unit(F, l, u - MQ_PA); }
        else if (u < MQ_RG1) { rglru_unit<1>(F, l, u - MQ_PB); }
        else if (u < MQ_RO) { ret_out_unit(F, l, u - MQ_RG1); }
        else if (u < MQ_RS) { ret_sample_unit(F, l, u - MQ_RO); }
        else { rglru_unit<2>(F, l, u - MQ_RS); }
    }
    __syncthreads(); }
__device__ __forceinline__ f32x16 smp_tile_acc(Frame& F, const bf16* A, const bf16* Wt, int K, int tile) {
    const int q = F.lane & 31, h_ = F.lane >> 5, ks8 = K / 8, kb = F.wave * ks8;
    const bf16* ap = A + (size_t)((tile >> 5) * 32 + q) * K + kb + 8 * h_; const bf16* bp = Wt + (size_t)((tile & 31) * 32 + q) * K + kb + 8 * h_; f32x16 acc = (f32x16){};
#pragma unroll 11
    for (int kk = 0; kk < ks8 / 16; ++kk) acc = mfma32(*(const bf16x8*)(ap + 16 * kk), *(const bf16x8*)(bp + 16 * kk), acc);
    return acc;
}
__device__ __forceinline__ void smp_tile_put(Frame& F, const f32x16& acc, int slot) { LAS float* R = (LAS float*)(F.lds + slot * 32768) + F.wave * 1024 + F.lane;
#pragma unroll
    for (int r = 0; r < 16; ++r) R[r * 64] = acc[r]; }
__device__ __forceinline__ float smp_tile_get(Frame& F, int slot, int o) { const LAS float* R = (const LAS float*)(F.lds + slot * 32768) + o; float s = 0.f;
#pragma unroll
    for (int w = 0; w < 8; ++w) s += R[w * 1024];
    return s; }
template <int l> __device__ __forceinline__ void ph_br(Frame& F) { unsigned char* ws = F.ws;
    const pg8::bf16_t* wbr = (const pg8::bf16_t*)(ws + WS_WBR) + (size_t)l * 3 * 1024 * 512;
    for (int tile = F.bid; tile < 256; tile += F.G) {
        const f32x16 a0 = smp_tile_acc(F, (const bf16*)(ws + WS_OA) + (size_t)PM * 512, wbr, 512, tile), a1 = smp_tile_acc(F, (const bf16*)(ws + WS_OA) + (size_t)(MT + PM) * 512, wbr + (size_t)1024 * 512, 512, tile),
                     a2 = smp_tile_acc(F, (const bf16*)(ws + WS_OA) + (size_t)(2 * MT + PM) * 512, wbr + (size_t)2 * 1024 * 512, 512, tile);
        __syncthreads(); smp_tile_put(F, a0, 0); smp_tile_put(F, a1, 1); smp_tile_put(F, a2, 2); __syncthreads();
        const bf16* MG = (const bf16*)(ws + WS_MGS); bf16* MR = (bf16*)(ws + WS_MRG);
#pragma unroll
        for (int e = 0; e < 2; ++e) { const int o = F.tid * 2 + e, r = o >> 6, ln = o & 63; const size_t row = (size_t)PM + (tile >> 5) * 32 + (r & 3) + 8 * (r >> 2) + 4 * (ln >> 5); const int col = (tile & 31) * 32 + (ln & 31);
            const bf16* g = MG + row * 3072 + col; MR[row * DM + col] = (bf16)(pk2(bf1(g[0]) * smp_tile_get(F, 0, o) + bf1(g[1024]) * smp_tile_get(F, 1, o) + bf1(g[2048]) * smp_tile_get(F, 2, o), 0.f) & 0xffffu); }
    }
    __syncthreads();
    BrOrder S; S.S.init(PM, DM, F.G, F.bid);
    pg8::Gemm g{(const pg8::bf16_t*)(ws + WS_OA), wbr, 3 * MT, 3 * DM, 512}; EpiBrAll E{ws};
    pg8::gemm_phase<EpiBrAll, BrOrder, true, true>(F.lds, g, S, E); }
__device__ __forceinline__ void smp_res(Frame& F, const bf16* A, const bf16* Wt, int K, const float* xin  , float* xout  , const float* mod, int gofs) {
    for (int tile = F.bid; tile < 256; tile += F.G) {
        const f32x16 a = smp_tile_acc(F, A, Wt, K, tile);
        __syncthreads(); smp_tile_put(F, a, 0); __syncthreads();
#pragma unroll
        for (int e = 0; e < 2; ++e) { const int o = F.tid * 2 + e, r = o >> 6, ln = o & 63; const int rr = (tile >> 5) * 32 + (r & 3) + 8 * (r >> 2) + 4 * (ln >> 5), col = (tile & 31) * 32 + (ln & 31);
            xout[(size_t)rr * DM + col] = xin[(size_t)rr * DM + col] + mod[(size_t)(4 + (rr >> 3)) * 6144 + gofs + col] * smp_tile_get(F, 0, o); }
    }
    __syncthreads();
}
template <int l> __device__ __forceinline__ void ph_out(Frame& F) { unsigned char* ws = F.ws;
    const float* mod = (const float*)(ws + WS_MOD) + (size_t)l * 36 * 6144;
    smp_res(F, (const bf16*)(ws + WS_MRG) + (size_t)PM * DM, (const bf16*)(ws + WS_WOUT) + (size_t)l * DM * DM, DM, l == 0 ? FIN(I_XS) : (const float*)(ws + WS_X2) + (size_t)PM * DM, (float*)(ws + WS_X1) + (size_t)PM * DM, mod, 2048);
    pg8::Gemm g{(const pg8::bf16_t*)(ws + WS_MRG), (const pg8::bf16_t*)(ws + WS_WOUT) + (size_t)l * DM * DM, PM, DM, DM};
    pg8::StaticOrder S; S.init(PM, DM, F.G, F.bid);
    EpiRes E{l == 0 ? FIN(I_XP) : (const float*)(ws + WS_X2), nullptr, (float*)(ws + WS_X1), mod, 2048};
    pg8::gemm_phase<EpiRes, pg8::StaticOrder, true, true>(F.lds, g, S, E); }
template <int l> __device__ __forceinline__ void ph_down(Frame& F) { unsigned char* ws = F.ws;
    const float* mod = (const float*)(ws + WS_MOD) + (size_t)l * 36 * 6144;
    smp_res(F, (const bf16*)(ws + WS_GP) + (size_t)2 * MT * DFF + (size_t)PM * DFF, (const bf16*)(ws + WS_WDN) + (size_t)l * DM * DFF, DFF, (const float*)(ws + WS_X1) + (size_t)PM * DM, (float*)(ws + WS_X2) + (size_t)PM * DM, mod, 5120);
    pg8::Gemm g{(const pg8::bf16_t*)(ws + WS_GP) + (size_t)2 * MT * DFF, (const pg8::bf16_t*)(ws + WS_WDN) + (size_t)l * DM * DFF, PM, DM, DFF};
    pg8::StaticOrder S; S.init(PM, DM, F.G, F.bid);
    EpiRes E{(const float*)(ws + WS_X1), nullptr, (float*)(ws + WS_X2), mod, 5120};
    pg8::gemm_phase<EpiRes, pg8::StaticOrder, true, true>(F.lds, g, S, E); }
template <int l> __device__ __forceinline__ void ph_up(Frame& F) { unsigned char* ws = F.ws;
    pg8::Gemm g{(const pg8::bf16_t*)(ws + WS_H), (const pg8::bf16_t*)(ws + WS_WUP) + (size_t)l * NUP * DM, MT, NUP, DM};
    pg8::StaticOrder S; S.init(MT, NUP, F.G, F.bid); EpiUp E{ws, F.out, l};
    pg8::gemm_phase<EpiUp, pg8::StaticOrder, true, true>(F.lds, g, S, E); }
#define RUNPH(bit, ph, CALL) do { if (((DBG_MASK >> (bit)) & 1) && IN(ph)) { launder(F); CALL; if ((DBG_REPEAT >> (bit)) & 1) { launder(F); CALL; } SEAM(ph); } } while (0)
template <int l> __device__ __forceinline__ void layer_phases(Frame& F, const XcdBarrier& bar, int lo, int hi) {
    constexpr int pb = PH_L0 + l * PH_PER_LAYER;
    RUNPH(1, pb + LP_N1, norm_phase(F, l, 0));
    RUNPH(2, pb + LP_WIN, ph_win<l>(F));
    RUNPH(3, pb + LP_MIX1, ph_mix1<l>(F));
    RUNPH(4, pb + LP_MIX2, ph_mix2<l>(F));
    RUNPH(5, pb + LP_MIX3, ph_mix3<l>(F));
    RUNPH(6, pb + LP_BR, ph_br<l>(F));
    RUNPH(7, pb + LP_OUT, ph_out<l>(F));
    RUNPH(8, pb + LP_N2, norm_phase(F, l, 1));
    RUNPH(9, pb + LP_UP, ph_up<l>(F));
    RUNPH(10, pb + LP_CONV, convact_phase(F, l));
    RUNPH(11, pb + LP_DOWN, ph_down<l>(F));
}
__global__ void __launch_bounds__(NTHR, 2) trunk_fwd(Args args) {
    extern __shared__ __attribute__((aligned(16))) unsigned char lds_raw[];
    Frame F;
    F.lds = (LAS unsigned char*)lds_raw;
    F.tid = threadIdx.x; F.lane = F.tid & 63; F.wave = __builtin_amdgcn_readfirstlane(F.tid >> 6);
    F.G = gridDim.x; F.bid = blockIdx.x; F.a = &args; F.ws = args.ws; F.out = args.out;
    volatile LAS unsigned* MISC = (volatile LAS unsigned*)(F.lds + MISC_OFF);
    for (int u = F.tid; u < 64; u += NTHR) MISC[u] = 0u;
    __syncthreads();
    unsigned* barw = (unsigned*)(F.ws + WS_CTL) + CW_BAR;
    XcdBarrier bar; bar.bar = barw; bar.x = 0; bar.st = nullptr;
    if (MK_N_LAUNCHES == 1) bar = xcd_barrier_post(barw, MISC + 8);
    const int lo = args.ph_lo, hi = args.ph_hi;
    unsigned char* ws = F.ws;

#ifdef DBG_TIME
    if (F.bid == 0 && F.tid == 0) ((unsigned long long*)(F.ws + WS_CTL))[2048] = __builtin_amdgcn_s_memrealtime();
#endif
    RUNPH(0, PH_P0, p0_prologue(F));

    layer_phases<0>(F, bar, lo, hi);
    layer_phases<1>(F, bar, lo, hi);
    if (((DBG_MASK >> 12) & 1) && IN(PH_FINAL)) { launder(F); final_phase(F); if ((DBG_REPEAT >> 12) & 1) { launder(F); final_phase(F); } }
#ifdef DBG_TIME
    {
        xcd_barrier(bar);
        if (F.bid == 0 && F.tid < 14) {
            const unsigned long long* ts = (const unsigned long long*)(F.ws + WS_CTL) + 2048; const unsigned long long tend = __builtin_amdgcn_s_memrealtime();
            const size_t ooff[14] = {OUT_Y, OUT_Y + (size_t)PM * DM, OUT_ROWS_P, OUT_ROWS_S, OUT_WIN_P, OUT_WIN_S, OUT_RET_P, OUT_RET_S, OUT_H_P, OUT_H_S, OUT_CV_P, OUT_CV_S, OUT_FC_P, OUT_FC_S};
            const int b = F.tid; unsigned long long d;
            if (b == 0) d = tend - ts[0]; else if (b == 1) d = ts[1] - ts[0]; else if (b == 13) d = tend - ts[PH_FINAL];
            else { const int ph = PH_L0 + DBG_TIME_LAYER * PH_PER_LAYER + (b - 2); d = ts[ph + 1] - ts[ph]; }
            int cnt = (int)(d / 100ull); if (cnt < 1) cnt = 1; if (cnt > 2000 && b != 0) cnt = 2000;
            for (int i = 0; i < cnt; ++i) ((unsigned*)F.out)[ooff[b] + 7 + 2 * i] = 0xAAAAAAAAu;
        }
    }
#endif
#ifdef DBG_COUNT
    {
        xcd_barrier(bar);
        if (F.bid == 0 && F.tid < 3) { const unsigned* CNT = (const unsigned*)(F.ws + WS_CTL) + 3000; const size_t ooff[3] = {OUT_Y, OUT_Y + (size_t)PM * DM, OUT_ROWS_P};
            const int cnt = (int)((unsigned long long)CNT[F.tid] * 10ull / (CNT[3] ? CNT[3] : 1u)); for (int i = 0; i < cnt; ++i) ((unsigned*)F.out)[ooff[F.tid] + 7 + 2 * i] = 0xAAAAAAAAu; }
    }
#endif
#ifdef DBG_CHECK
    if (lo == 100) { launder(F); dbg_check_phase(F); }
    if (lo == 101) { for (size_t i = (size_t)F.bid * NTHR + F.tid; i < OUT_END; i += (size_t)F.G * NTHR) F.out[i] = 0.f; }
    if (lo == 102) { launder(F); dbg_report_phase(F); }
#endif
}

extern "C" void kernel_launch(void* const* d_in, const int* in_sizes, int n_in, void* d_out, int out_size, void* d_ws, size_t ws_size, hipStream_t stream) {
    static int grid = 0;
    if (grid == 0) {
        if (n_in != 37 || (size_t)out_size != OUT_END || ws_size < WS_END) { fprintf(stderr, "kernel_launch: unexpected shapes: n_in %d out %d (want %zu) ws %zu (want %zu)\n", n_in, out_size, (size_t)OUT_END, ws_size, (size_t)WS_END); grid = -1; return; }
        int dev = 0, cus = 0, per_cu = 0;
        if (hipGetDevice(&dev) != hipSuccess || hipDeviceGetAttribute(&cus, hipDeviceAttributeMultiprocessorCount, dev) != hipSuccess) { grid = -1; return; }
        if (hipFuncSetAttribute((const void*)trunk_fwd, hipFuncAttributeMaxDynamicSharedMemorySize, LDS_BYTES) != hipSuccess) { fprintf(stderr, "kernel_launch: hipFuncSetAttribute failed\n"); grid = -1; return; }
        if (hipOccupancyMaxActiveBlocksPerMultiprocessor(&per_cu, (const void*)trunk_fwd, NTHR, LDS_BYTES) != hipSuccess || per_cu < 1) fprintf(stderr, "kernel_launch: occupancy query reports %d\n", per_cu);
        (void)hipGetLastError();
        grid = cus;
    }
    if (grid < 0) return;
    if (hipMemsetAsync((char*)d_ws + WS_CTL, 0, CTL_ZERO_BYTES, stream) != hipSuccess) return;
#ifdef DBG_POISON
    (void)hipMemsetAsync((char*)d_ws + CTL_ZERO_BYTES, 0xAA, WS_END - CTL_ZERO_BYTES, stream);
    (void)hipMemsetAsync(d_out, 0xAA, (size_t)OUT_END * 4, stream);
#endif
    Args a{};
    for (int i = 0; i < 37; ++i) a.in[i] = d_in[i];
    a.out = (float*)d_out; a.ws = (unsigned char*)d_ws;
#if MK_N_LAUNCHES == 1
    a.ph_lo = 0; a.ph_hi = N_PHASES;
    hipLaunchKernelGGL(trunk_fwd, dim3(grid), dim3(NTHR), LDS_BYTES, stream, a);
#else
    for (int p = 0; p < DBG_MAXPH; ++p) { a.ph_lo = p; a.ph_hi = p + 1; hipLaunchKernelGGL(trunk_fwd, dim3(grid), dim3(NTHR), LDS_BYTES, stream, a); }
#ifdef DBG_CHECK
    for (int p = 100; p < 103; ++p) { a.ph_lo = p; a.ph_hi = p + 1; hipLaunchKernelGGL(trunk_fwd, dim3(grid), dim3(NTHR), LDS_BYTES, stream, a); }
#endif
#endif
    (void)in_sizes;
}
```

```cpp
#include <hip/hip_runtime.h>
#include <cstdio>
#include <cstdint>

#ifndef MK_N_LAUNCHES
#define MK_N_LAUNCHES 1
#endif

constexpr int DM = 1024, PB = 4, PT = 4096, PM = PB * PT, SB = 32, ST = 8, SM = SB * ST, MT = PM + SM;
constexpr int DEPTH = 2, PAST = 8192, PAGE = 128, NPG = PAST / PAGE, NPHYS = 2560;
constexpr int D_IN = 7448, NIN = 7680, DFF = 2816, NUP = 2 * DFF;
constexpr int WINB = 512;
constexpr float EPS = 1e-6f;
constexpr float QSCALE = 0.125f * 1.4426950408889634f;

constexpr int O_NQ = 0, O_NKV = 512, O_NG = 1280, O_RQ = 1304, O_RK = 1816, O_RV = 2328, O_RG = 2840, O_RX = 3352, O_RGATE = 3864, O_MG = 4376;

constexpr size_t OUT_Y = 0;
constexpr size_t OUT_ROWS_P = OUT_Y + (size_t)MT * DM;
constexpr size_t OUT_ROWS_S = OUT_ROWS_P + (size_t)DEPTH * PM * 512;
constexpr size_t OUT_WIN_P = OUT_ROWS_S + (size_t)DEPTH * SM * 512;
constexpr size_t OUT_WIN_S = OUT_WIN_P + (size_t)DEPTH * PB * WINB * 256;
constexpr size_t OUT_RET_P = OUT_WIN_S + (size_t)DEPTH * SB * WINB * 256;
constexpr size_t OUT_RET_S = OUT_RET_P + (size_t)DEPTH * PB * 4 * 16384;
constexpr size_t OUT_H_P = OUT_RET_S + (size_t)DEPTH * SB * 4 * 16384;
constexpr size_t OUT_H_S = OUT_H_P + (size_t)DEPTH * PB * 512;
constexpr size_t OUT_CV_P = OUT_H_S + (size_t)DEPTH * SB * 512;
constexpr size_t OUT_CV_S = OUT_CV_P + (size_t)DEPTH * PB * 3 * 512;
constexpr size_t OUT_FC_P = OUT_CV_S + (size_t)DEPTH * SB * 3 * 512;
constexpr size_t OUT_FC_S = OUT_FC_P + (size_t)DEPTH * PB * 2 * DFF;
constexpr size_t OUT_END = OUT_FC_S + (size_t)DEPTH * SB * 2 * DFF;

constexpr size_t MiB = 1u << 20;
constexpr size_t WS_CTL = 0, CTL_ZERO_BYTES = 4 * MiB;
constexpr size_t WS_MOD = 1 * MiB;
constexpr size_t WS_ROT = 4 * MiB;
constexpr size_t WS_SMALLW = 8 * MiB;
constexpr size_t WS_WIN = 16 * MiB;
constexpr size_t WS_WBR = WS_WIN + (size_t)2 * NIN * DM * 2;
constexpr size_t WS_WOUT = WS_WBR + (size_t)2 * 3 * 1024 * 512 * 2;
constexpr size_t WS_WUP = WS_WOUT + (size_t)2 * 1024 * 1024 * 2;
constexpr size_t WS_WDN = WS_WUP + (size_t)2 * NUP * DM * 2;
constexpr size_t WS_WEND = WS_WDN + (size_t)2 * DM * DFF * 2;
constexpr size_t WS_H = 128 * MiB;
constexpr size_t WS_QN = WS_H + (size_t)MT * DM * 2;
constexpr size_t WS_KVB = WS_QN + (size_t)MT * 512 * 2;
constexpr size_t WS_KVS = WS_KVB + (size_t)4 * PB * 2 * PT * 64 * 2;
constexpr size_t WS_RQ = WS_KVS + (size_t)4 * SB * 2 * ST * 64 * 2;
constexpr size_t WS_RX = WS_RQ + (size_t)4 * MT * 512 * 2;
constexpr size_t WS_GG = WS_RX + (size_t)MT * 512 * 4;
constexpr size_t WS_MGS = WS_GG + (size_t)MT * 512 * 2;
constexpr size_t WS_NG = WS_MGS + (size_t)MT * 3072 * 2;
constexpr size_t WS_OA = WS_NG + (size_t)MT * 24 * 4;
constexpr size_t WS_MRG = WS_OA + (size_t)3 * MT * 512 * 2;
constexpr size_t WS_X1 = WS_MRG + (size_t)MT * DM * 2;
constexpr size_t WS_X2 = WS_X1 + (size_t)MT * DM * 4;
constexpr size_t WS_GP = WS_X2 + (size_t)MT * DM * 4;
constexpr size_t WS_ACMP = WS_GP + (size_t)3 * MT * DFF * 2;
constexpr int CMP_ROWS_J = 34816, CMP_ROWS = 2 * CMP_ROWS_J;
constexpr size_t WS_LH = WS_ACMP + (size_t)2 * CMP_ROWS * 1024 * 2 + 4096;
constexpr size_t WS_CK = WS_LH + (size_t)(CMP_ROWS + 16) * 256 * 2;
constexpr size_t WS_LT = WS_CK + (size_t)CMP_ROWS * 64 * 2;
constexpr size_t WS_SPT = WS_LT + (size_t)16 * 32 * 16384 * 4;
constexpr size_t WS_CAR = WS_SPT + (size_t)16 * 32 * 16384 * 2;
constexpr size_t WS_OAG = WS_CAR + (size_t)4 * 64 * 3 * 512 * 4 + MiB;
constexpr size_t WS_END = WS_OAG + (size_t)2048 * 32 * 64 * 4 + MiB;
static_assert(WS_WEND <= WS_H, "weights fit below WS_H");

constexpr size_t SW_W1T = 0;
constexpr size_t SW_W2T = SW_W1T + (size_t)2 * 2 * 256 * 1024 * 2;
constexpr size_t SW_CB = SW_W2T + (size_t)2 * 2 * 64 * 128 * 2;
constexpr size_t SW_WAT = SW_CB + (size_t)2 * 2 * 128 * 4;
constexpr size_t SW_SP = SW_WAT + (size_t)2 * 2 * 8 * 64 * 64 * 2;
constexpr size_t SW_END = SW_SP + 2 * 512 * 4;
static_assert(SW_END <= 8 * MiB, "small weights fit");

constexpr int CW_TMO = 0;
constexpr int CW_BAR = 4096;

constexpr int PH_P0 = 0, PH_L0 = 1, PH_PER_LAYER = 11, PH_FINAL = PH_L0 + DEPTH * PH_PER_LAYER, N_PHASES = PH_FINAL + 1;
enum { LP_N1 = 0, LP_WIN, LP_MIX1, LP_MIX2, LP_MIX3, LP_BR, LP_OUT, LP_N2, LP_UP, LP_CONV, LP_DOWN };

constexpr int RING_BYTES = 131072;
constexpr int MISC_OFF = RING_BYTES;
constexpr int LDS_BYTES = RING_BYTES + 1024;
constexpr int NWAVES = 8, NTHR = 512;

#define GAS __attribute__((address_space(1)))
#define LAS __attribute__((address_space(3)))
typedef unsigned short bf16;
typedef unsigned v4u __attribute__((ext_vector_type(4)));
typedef unsigned v2u __attribute__((ext_vector_type(2)));
typedef float f32x16 __attribute__((ext_vector_type(16)));
typedef short s16x4 __attribute__((ext_vector_type(4)));
namespace pg8 {
#define PG8_LAS __attribute__((address_space(3)))
typedef unsigned short bf16_t;
typedef short bf16x8 __attribute__((ext_vector_type(8)));
typedef float f32x4 __attribute__((ext_vector_type(4)));
typedef unsigned u32x4 __attribute__((ext_vector_type(4)));
constexpr int BM = 256, BK = 64, HALF = 128, HTB = HALF * BK * 2  , STAGE_BYTES = 8 * HTB, NXCD = 8, WGM = 8;

__host__ __device__ __forceinline__ int lds_byte(int r, int c) { const int st = (r >> 4) * 2 + (c >> 5), rr = r & 15, cc = c & 31, ob = rr * 64 + cc * 2; return st * 1024 + (ob ^ (((ob >> 9) & 1) << 5)); }
__host__ __device__ __forceinline__ void stage_rc(int b, int& R, int& C) { const int st = b / 1024, sb = b % 1024, swz = sb ^ (((sb >> 9) & 1) << 5); R = (st >> 1) * 16 + swz / 64; C = (st & 1) * 32 + (swz % 64) / 2; }
__host__ __device__ __forceinline__ int perm32(int rho) { const int n = rho >> 4, i = rho & 15; return 8 * (i >> 2) + 4 * n + (i & 3); }

struct Unit { int pm, pn; };
struct Gemm { const bf16_t* A; const bf16_t* Bt; int M, N, K; };

struct StaticOrder {
    int nM, nN, nwg, G, c;
    __host__ __device__ void init(int M, int N, int G_, int c_) { nM = M / BM; nN = N / BM; nwg = nM * nN; G = G_; c = c_; }
    __host__ __device__ bool next(int i, Unit& u) const {
        const long L = (long)i * G + c; if (L >= nwg) return false;
        int wgid = (int)L; { const int q = nwg / NXCD, r = nwg % NXCD, xcd = wgid % NXCD, off = wgid / NXCD; wgid = (xcd < r ? xcd * (q + 1) : r * (q + 1) + (xcd - r) * q) + off; }
        const int nig = WGM * nN, gid = wgid / nig, fm = gid * WGM, gsz = (nM - fm) < WGM ? (nM - fm) : WGM;
        u.pm = fm + ((wgid % nig) % gsz); u.pn = (wgid % nig) / gsz; return true;
    }
    __device__ __forceinline__ void a_ready(const Unit&) const {}
    __device__ __forceinline__ void done(const Unit&) const {}
};
__device__ __forceinline__ unsigned cvt_pk_bf16(float lo, float hi) { unsigned r; asm volatile("v_cvt_pk_bf16_f32 %0, %1, %2" : "=v"(r) : "v"(lo), "v"(hi)); return r; }
typedef float f32x2 __attribute__((ext_vector_type(2)));
template <class Epi, class Sched, bool ALIGN_EPI = false, bool SP2 = false>
__device__ __forceinline__ void gemm_phase(PG8_LAS unsigned char* lds, const Gemm g, const Sched& S, const Epi& E) {
    const int tid = threadIdx.x, wid = __builtin_amdgcn_readfirstlane(tid >> 6), lane = tid & 63, wr = wid >> 2, wc = wid & 3, fr = lane & 15, fq = lane >> 4;
    const int K = g.K, nt = K / BK;
    unsigned voffA[2], voffB[2];
#pragma unroll
    for (int i = 0; i < 2; ++i) { int R, C; stage_rc(tid * 16 + i * 8192, R, C); const int Rb = Epi::PERM ? ((R & ~31) + perm32(R & 31)) : R;
        voffA[i] = (unsigned)(R * K + C) * 2u; voffB[i] = (unsigned)(Rb * K + C) * 2u; }
    const size_t kstep = (size_t)(BK * 2);
    const size_t hstep = (size_t)HALF * K * 2;
    const size_t tstep = 2 * hstep;
    const unsigned ldsw = (unsigned)wid * 1024u;
    const int aoff = lds_byte(wr * 64 + fr, fq * 8), boff = lds_byte(wc * 32 + fr, fq * 8);
#define PG8_SA(b, h) (((b) * 2 + (h)) * HTB)
#define PG8_SB(b, h) ((4 + (b) * 2 + (h)) * HTB)
#define PG8_STAGE(bufoff, gbase, voff) do { _Pragma("unroll") for (int _i = 0; _i < 2; ++_i) \
        __builtin_amdgcn_global_load_lds((const unsigned*)((const char*)(gbase) + (voff)[_i]), (PG8_LAS unsigned*)(lds + (bufoff) + ldsw + _i * 8192), 16, 0, 0); } while (0)
#define PG8_LDA(dst, b, h) do { _Pragma("unroll") for (int m = 0; m < 4; ++m) _Pragma("unroll") for (int k = 0; k < 2; ++k) dst[m][k] = *(const PG8_LAS bf16x8*)(lds + PG8_SA(b, h) + aoff + m * 2048 + k * 1024); } while (0)
#define PG8_LDB(dst, b, h) do { _Pragma("unroll") for (int n = 0; n < 2; ++n) _Pragma("unroll") for (int k = 0; k < 2; ++k) dst[n][k] = *(const PG8_LAS bf16x8*)(lds + PG8_SB(b, h) + boff + n * 2048 + k * 1024); } while (0)
#define PG8_MMA(ai, bj, At, Bt) do { __builtin_amdgcn_s_setprio(1); _Pragma("unroll") for (int m = 0; m < 4; ++m) _Pragma("unroll") for (int n = 0; n < 2; ++n) _Pragma("unroll") for (int k = 0; k < 2; ++k) \
        acc[ai][bj][m][n] = __builtin_amdgcn_mfma_f32_16x16x32_bf16(Bt[n][k], At[m][k], acc[ai][bj][m][n], 0, 0, 0); __builtin_amdgcn_s_setprio(0); } while (0)
#define PG8_WAIT_V(n) asm volatile("s_waitcnt vmcnt(" #n ")" ::: "memory")
#define PG8_WAIT_L(n) asm volatile("s_waitcnt lgkmcnt(" #n ")" ::: "memory")
#define PG8_BAR __builtin_amdgcn_s_barrier()
#define PG8_SCHED __builtin_amdgcn_sched_barrier(0)
    Unit cur, nxt; int ui = 0;
    if (!S.next(0, cur)) return;
    f32x4 acc[2][2][4][2];
#pragma unroll
    for (int a = 0; a < 2; ++a)
#pragma unroll
        for (int b = 0; b < 2; ++b)
#pragma unroll
            for (int m = 0; m < 4; ++m)
#pragma unroll
                for (int n = 0; n < 2; ++n) acc[a][b][m][n] = (f32x4){0.f, 0.f, 0.f, 0.f};
    bf16x8 At[4][2], B0[2][2], B1[2][2];
    const char* cA = (const char*)g.A + (size_t)cur.pm * tstep; const char* cB = (const char*)g.Bt + (size_t)cur.pn * tstep;
    S.a_ready(cur);
    if constexpr (SP2) {
        PG8_STAGE(PG8_SB(0, 0), cB, voffB); PG8_STAGE(PG8_SB(0, 1), cB + hstep, voffB); PG8_STAGE(PG8_SA(0, 0), cA, voffA); PG8_STAGE(PG8_SA(0, 1), cA + hstep, voffA);
        if (wr == 1) PG8_BAR;
        PG8_WAIT_V(2); PG8_BAR;
        PG8_STAGE(PG8_SB(1, 0), cB + kstep, voffB); PG8_STAGE(PG8_SA(1, 0), cA + kstep, voffA); PG8_STAGE(PG8_SB(1, 1), cB + hstep + kstep, voffB);
        PG8_WAIT_V(6); PG8_BAR;
    } else {
        PG8_STAGE(PG8_SB(0, 0), cB, voffB); PG8_STAGE(PG8_SA(0, 0), cA, voffA); PG8_STAGE(PG8_SB(0, 1), cB + hstep, voffB); PG8_STAGE(PG8_SA(0, 1), cA + hstep, voffA);
        if (wr == 1) PG8_BAR;
        PG8_WAIT_V(4); PG8_BAR;
        PG8_STAGE(PG8_SB(1, 0), cB + kstep, voffB); PG8_STAGE(PG8_SA(1, 0), cA + kstep, voffA); PG8_STAGE(PG8_SB(1, 1), cB + hstep + kstep, voffB);
        PG8_WAIT_V(6); PG8_BAR;
    }
    for (;;) {
        const bool has_next = S.next(ui + 1, nxt);
        const char* nA = has_next ? (const char*)g.A + (size_t)nxt.pm * tstep : cA; const char* nB = has_next ? (const char*)g.Bt + (size_t)nxt.pn * tstep : cB;
        for (int t = 0; t < nt; t += 2) {
            const bool last = (t == nt - 2);
            const char* a1 = cA + (size_t)(t + 1) * kstep;
            const char* a2 = last ? nA : cA + (size_t)(t + 2) * kstep; const char* b2 = last ? nB : cB + (size_t)(t + 2) * kstep;
            const char* a3 = a2 + kstep; const char* b3 = b2 + kstep;
            if (last && has_next) S.a_ready(nxt);
            if constexpr (SP2) {
            PG8_LDB(B0, 0, 0); PG8_LDB(B1, 0, 1); PG8_SCHED; PG8_LDA(At, 0, 0); PG8_STAGE(PG8_SA(1, 1), a1 + hstep, voffA);
            PG8_WAIT_V(8); PG8_WAIT_L(0); PG8_BAR; PG8_MMA(0, 0, At, B0); PG8_MMA(0, 1, At, B1); PG8_BAR; PG8_SCHED;
            PG8_LDA(At, 0, 1); PG8_STAGE(PG8_SB(0, 0), b2, voffB); PG8_STAGE(PG8_SB(0, 1), b2 + hstep, voffB); PG8_STAGE(PG8_SA(0, 0), a2, voffA);
            PG8_WAIT_V(8); PG8_WAIT_L(0); PG8_BAR; PG8_MMA(1, 0, At, B0); PG8_MMA(1, 1, At, B1); PG8_BAR; PG8_SCHED;
            PG8_LDB(B0, 1, 0); PG8_LDB(B1, 1, 1); PG8_SCHED; PG8_LDA(At, 1, 0); PG8_STAGE(PG8_SA(0, 1), a2 + hstep, voffA);
            PG8_WAIT_V(8); PG8_WAIT_L(0); PG8_BAR; PG8_MMA(0, 0, At, B0); PG8_MMA(0, 1, At, B1); PG8_BAR; PG8_SCHED;
            PG8_LDA(At, 1, 1); PG8_STAGE(PG8_SB(1, 0), b3, voffB); PG8_STAGE(PG8_SB(1, 1), b3 + hstep, voffB); PG8_STAGE(PG8_SA(1, 0), a3, voffA);
            PG8_WAIT_V(8); PG8_WAIT_L(0); PG8_BAR; PG8_MMA(1, 0, At, B0); PG8_MMA(1, 1, At, B1); PG8_BAR; PG8_SCHED;
            } else {
            PG8_LDB(B0, 0, 0); PG8_SCHED; PG8_LDA(At, 0, 0); PG8_STAGE(PG8_SA(1, 1), a1 + hstep, voffA);
            PG8_WAIT_L(8); PG8_BAR; PG8_WAIT_L(0); PG8_MMA(0, 0, At, B0); PG8_BAR; PG8_SCHED;
            PG8_LDB(B1, 0, 1); PG8_STAGE(PG8_SB(0, 0), b2, voffB);
            PG8_BAR; PG8_WAIT_L(0); PG8_MMA(0, 1, At, B1); PG8_BAR;
            PG8_LDA(At, 0, 1); PG8_STAGE(PG8_SA(0, 0), a2, voffA);
            PG8_BAR; PG8_WAIT_L(0); PG8_MMA(1, 0, At, B0); PG8_BAR; PG8_SCHED;
            PG8_STAGE(PG8_SB(0, 1), b2 + hstep, voffB);
            PG8_WAIT_V(6); PG8_BAR; PG8_MMA(1, 1, At, B1); PG8_BAR;
            PG8_LDB(B0, 1, 0); PG8_SCHED; PG8_LDA(At, 1, 0); PG8_STAGE(PG8_SA(0, 1), a2 + hstep, voffA);
            PG8_WAIT_L(8); PG8_BAR; PG8_WAIT_L(0); PG8_MMA(0, 0, At, B0); PG8_BAR; PG8_SCHED;
            PG8_LDB(B1, 1, 1); PG8_STAGE(PG8_SB(1, 0), b3, voffB);
            PG8_BAR; PG8_WAIT_L(0); PG8_MMA(0, 1, At, B1); PG8_BAR;
            PG8_LDA(At, 1, 1); PG8_STAGE(PG8_SA(1, 0), a3, voffA);
            PG8_BAR; PG8_WAIT_L(0); PG8_MMA(1, 0, At, B0); PG8_BAR; PG8_SCHED;
            PG8_STAGE(PG8_SB(1, 1), b3 + hstep, voffB);
            PG8_WAIT_V(6); PG8_BAR; PG8_MMA(1, 1, At, B1); PG8_BAR;
            }
        }
        if constexpr (ALIGN_EPI) { if (wr == 0) PG8_BAR; }
        if constexpr (!Epi::AFTER_DRAIN) { E(acc, cur, wr, wc, fr, fq); S.done(cur); }
        if (!has_next) break;
#pragma unroll
        for (int a = 0; a < 2; ++a)
#pragma unroll
            for (int b = 0; b < 2; ++b)
#pragma unroll
                for (int m = 0; m < 4; ++m)
#pragma unroll
                    for (int n = 0; n < 2; ++n) acc[a][b][m][n] = (f32x4){0.f, 0.f, 0.f, 0.f};
        cur = nxt; cA = nA; cB = nB; ++ui;
        if constexpr (ALIGN_EPI) { if (wr == 1) PG8_BAR; }
    }
    PG8_WAIT_V(0);
    if constexpr (!ALIGN_EPI) { if (wr == 0) PG8_BAR; }
    PG8_BAR;
    if constexpr (Epi::AFTER_DRAIN) { E.fused(acc, cur, wr, wc, fr, fq, lds, wid, lane); S.done(cur); }
#undef PG8_SA
#undef PG8_SB
#undef PG8_STAGE
#undef PG8_LDA
#undef PG8_LDB
#undef PG8_MMA
#undef PG8_WAIT_V
#undef PG8_WAIT_L
#undef PG8_BAR
#undef PG8_SCHED
}
}

using pg8::bf16x8; using pg8::f32x4; using pg8::u32x4;
#define LDS_WAIT() asm volatile("s_waitcnt lgkmcnt(0)" ::: "memory")
#define VM_WAIT() asm volatile("s_waitcnt vmcnt(0)" ::: "memory")
typedef float f32x2_t __attribute__((ext_vector_type(2))); typedef __bf16 bf16x2_t __attribute__((ext_vector_type(2)));
__device__ __forceinline__ unsigned pk2(float lo, float hi) { f32x2_t v = {lo, hi}; bf16x2_t b = __builtin_convertvector(v, bf16x2_t); return __builtin_bit_cast(unsigned, b); }
__device__ __forceinline__ float bf_lo(unsigned w) { return __uint_as_float(w << 16); }
__device__ __forceinline__ float bf_hi(unsigned w) { return __uint_as_float(w & 0xffff0000u); }
__device__ __forceinline__ float bf1(bf16 b) { return __uint_as_float(((unsigned)b) << 16); }
__device__ __forceinline__ float fexp2(float x) { return __builtin_amdgcn_exp2f(x); }
__device__ __forceinline__ float fexp(float x) { return __builtin_amdgcn_exp2f(x * 1.4426950408889634f); }
__device__ __forceinline__ float frcp(float x) { return __builtin_amdgcn_rcpf(x); }
__device__ __forceinline__ float sigmoidf_(float x) { return frcp(1.0f + fexp(-x)); }
__device__ __forceinline__ float siluf_(float x) { return x * sigmoidf_(x); }
__device__ __forceinline__ float gelu_tanh(float x) {
    const float u = 0.7978845608028654f * (x + 0.044715f * x * x * x);
    const float e = fexp(2.0f * u);
    const float t = 1.0f - 2.0f * frcp(e + 1.0f);
    return 0.5f * x * (1.0f + t);
}
__device__ __forceinline__ float wave_sum(float v) {
#pragma unroll
    for (int o = 1; o < 64; o <<= 1) v += __shfl_xor(v, o);
    return v;
}
__device__ __forceinline__ v4u pack8(const f32x4 a, const f32x4 b) { v4u w; w.x = pk2(a[0], a[1]); w.y = pk2(a[2], a[3]); w.z = pk2(b[0], b[1]); w.w = pk2(b[2], b[3]); return w; }
__device__ __forceinline__ void unpack8(const v4u w, f32x4& a, f32x4& b) { a = (f32x4){bf_lo(w.x), bf_hi(w.x), bf_lo(w.y), bf_hi(w.y)}; b = (f32x4){bf_lo(w.z), bf_hi(w.z), bf_lo(w.w), bf_hi(w.w)}; }

#define XB_TMO      128
#define XB_XCNT(j)  (256  + 64 * (j))
#define XB_XSUB(j)  (1280 + 64 * (j))
#define XB_XGEN(j)  (2304 + 64 * (j))
#define XB_TOP      3328
#define XB_TOPGEN   3392
#define XCD_BAR_WORDS 3456
#define XB_SPIN_CAP (1u << 18)

__device__ __forceinline__ unsigned xb_ld(unsigned* p)              { return __hip_atomic_load(p, __ATOMIC_RELAXED, __HIP_MEMORY_SCOPE_AGENT); }
__device__ __forceinline__ unsigned xb_add(unsigned* p, unsigned v) { return __hip_atomic_fetch_add(p, v, __ATOMIC_RELAXED, __HIP_MEMORY_SCOPE_AGENT); }
__device__ __forceinline__ unsigned xb_xcc_id() { return (unsigned)__builtin_amdgcn_s_getreg((3 << 11) | 20) & 0xFu; }
#define XB_SPIN(cond, bar) do { unsigned _sp = 0; while (cond) { __builtin_amdgcn_s_sleep(1); \
    if ((++_sp & 255u) == 0u) { if (xb_ld(&(bar)[XB_TMO])) break; if (_sp > XB_SPIN_CAP) { atomicAdd(&(bar)[XB_TMO], 1u); break; } } } } while (0)

struct XcdBarrier {
    unsigned* bar; unsigned x;
    volatile LAS unsigned* st;
};

__device__ __forceinline__ XcdBarrier xcd_barrier_post(unsigned* bar, volatile LAS unsigned* st) {
    XcdBarrier b; b.bar = bar; b.x = xb_xcc_id(); b.st = st;
    if (threadIdx.x == 0) (void)xb_add(&bar[XB_XCNT(b.x)], 1u);
    return b;
}
__device__ __forceinline__ void xcd_barrier_complete(unsigned* bar, unsigned x, unsigned& nloc, unsigned& nx) {
    const unsigned G = gridDim.x * gridDim.y * gridDim.z;
    unsigned sum, cnt, mine, sp = 0u;
    for (;;) {
        sum = 0u; cnt = 0u; mine = 0u;
#pragma unroll
        for (unsigned j = 0; j < 16; ++j) { const unsigned c = xb_ld(&bar[XB_XCNT(j)]); sum += c; cnt += (c > 0u) ? 1u : 0u; mine = (j == x) ? c : mine; }
        if (sum == G) break;
        __builtin_amdgcn_s_sleep(1);
        if ((++sp & 255u) == 0u) { if (xb_ld(&bar[XB_TMO])) break; if (sp > XB_SPIN_CAP) { atomicAdd(&bar[XB_TMO], 1u); break; } }
    }
    nloc = mine > 0u ? mine : 1u; nx = cnt > 0u ? cnt : 1u;
}

__device__ __forceinline__ void xcd_barrier(const XcdBarrier& b) {
    asm volatile("s_waitcnt vmcnt(0)" ::: "memory");
    __syncthreads();
    if (threadIdx.x == 0) {
        unsigned* bar = b.bar;
        __builtin_amdgcn_s_waitcnt(0);
        unsigned nloc = b.st[0], nx = b.st[1];
        if (nloc == 0u) { xcd_barrier_complete(bar, b.x, nloc, nx); b.st[0] = nloc; b.st[1] = nx; }
        const unsigned old = xb_add(&bar[XB_XSUB(b.x)], 1u);
        const unsigned gen = old / nloc;
        if (old + 1u == (gen + 1u) * nloc) {
            __builtin_amdgcn_fence(__ATOMIC_RELEASE, "agent");
            asm volatile("s_waitcnt vmcnt(0)" ::: "memory");
            const unsigned og = xb_add(&bar[XB_TOP], 1u);
            const unsigned tg = og / nx;
            if (og + 1u == (tg + 1u) * nx) xb_add(&bar[XB_TOPGEN], 1u);
            else XB_SPIN(xb_ld(&bar[XB_TOPGEN]) == tg, bar);
            __builtin_amdgcn_fence(__ATOMIC_ACQUIRE, "agent");
            xb_add(&bar[XB_XGEN(b.x)], 1u);
            asm volatile("s_waitcnt vmcnt(0)" ::: "memory");
        } else {
            XB_SPIN(xb_ld(&bar[XB_XGEN(b.x)]) == gen, bar);
            __builtin_amdgcn_fence(__ATOMIC_ACQUIRE, "agent");
            asm volatile("s_waitcnt vmcnt(0)" ::: "memory");
        }
    }
    __syncthreads();
}

struct Args { const void* in[37]; float* out; unsigned char* ws; int ph_lo, ph_hi; };
enum { I_XP = 0, I_XS, I_CACHE, I_CWIN, I_SRET, I_SH, I_SCONV, I_SFFN, I_PT, I_CP, I_CS, I_N1G, I_N2G, I_WADA, I_BADA, I_WIN, I_PE, I_W1, I_B1, I_W2,
       I_GNG, I_RCW, I_RCB, I_RWA, I_RBA, I_RWX, I_RBX, I_LAM, I_WBRA, I_WBRB, I_WBRC, I_WOUT, I_WUP, I_FCW, I_FCB, I_WDN, I_FNG };

struct Frame {
    LAS unsigned char* lds;
    int tid, lane, wave, G, bid;
    const Args* a;
    unsigned char* ws;
    float* out;
};
__device__ __forceinline__ void launder(Frame& F) { asm volatile("" : "+v"(F.tid), "+v"(F.lane)); int w_ = __builtin_amdgcn_readfirstlane(F.wave), b_ = __builtin_amdgcn_readfirstlane(F.bid), g_ = __builtin_amdgcn_readfirstlane(F.G); asm volatile("" : "+s"(w_), "+s"(b_), "+s"(g_)); F.wave = w_; F.bid = b_; F.G = g_; }
#define FIN(i) ((const float*)F.a->in[i])
#define WSP(T, off) ((T*)(F.ws + (off)))

__device__ __forceinline__ int row_bb(int row) { return row < PM ? (row >> 12) : 4 + ((row - PM) >> 3); }
__device__ __forceinline__ int row_pos(int row) { return row < PM ? (row & (PT - 1)) : PT + ((row - PM) & 7); }

__device__ __forceinline__ int win_cmap(int n) {
    if (n < 1280) return n;
    if (n < 2304) { const int c = n - 1280, isk = c >> 9, hc = c & 511, head = hc >> 7, s = hc & 127;
        const int g = s >> 3, w = s & 7, dim = (w < 4) ? (4 * g + w) : (64 + 4 * g + (w - 4)); return (isk ? O_RK : O_RQ) + head * 128 + dim; }
    if (n < 2816) return O_RV + (n - 2304);
    if (n < 3328) return O_RG + (n - 2816);
    if (n < 3840) return O_RX + (n - 3328);
    if (n < 4352) return O_RGATE + (n - 3840);
    if (n < 7424) return O_MG + (n - 4352);
    if (n < 7448) return O_NG + (n - 7424);
    return -1;
}

template <bool MAP> __device__ __forceinline__ void p0_tr_item(const float* W, int ldw, bf16* WT, int ldt, int k0, int n0, LAS float* scr, int lane) {
    const int nd = n0 + (lane & 31); const int sc = MAP ? win_cmap(nd) : nd;
#pragma unroll 8
    for (int i = 0; i < 32; ++i) { const int kk = 2 * i + (lane >> 5); scr[kk * 33 + (lane & 31)] = (sc >= 0) ? W[(size_t)(k0 + kk) * ldw + sc] : 0.f; }
    LDS_WAIT(); asm volatile("" ::: "memory");
    const int c = lane & 7;
#pragma unroll
    for (int j = 0; j < 4; ++j) { const int n = (lane >> 3) + 8 * j; const LAS float* s = scr + (8 * c) * 33 + n;
        v4u o; o.x = pk2(s[0 * 33], s[1 * 33]); o.y = pk2(s[2 * 33], s[3 * 33]); o.z = pk2(s[4 * 33], s[5 * 33]); o.w = pk2(s[6 * 33], s[7 * 33]);
        *(v4u*)(WT + (size_t)(n0 + n) * ldt + k0 + 8 * c) = o; }
    LDS_WAIT(); asm volatile("" ::: "memory");
}
__device__ __forceinline__ void sincos_acc(float ang, float& s, float& c) {
    const double a = (double)ang; const double kq = rint(a * 0.63661977236758134308); const double r = fma(-kq, 1.57079632679489661923, a);
    const double r2 = r * r;
    const double sp = r * (1.0 + r2 * (-1.6666666666666666e-1 + r2 * (8.3333333333333332e-3 + r2 * (-1.9841269841269841e-4 + r2 * (2.7557319223985893e-6 + r2 * (-2.5052108385441720e-8))))));
    const double cp = 1.0 + r2 * (-0.5 + r2 * (4.1666666666666664e-2 + r2 * (-1.3888888888888889e-3 + r2 * (2.4801587301587302e-5 + r2 * (-2.7557319223985888e-7 + r2 * 2.0876756987868099e-9)))));
    const int q = ((int)kq) & 3;
    const double ss = (q == 0) ? sp : (q == 1) ? cp : (q == 2) ? -sp : -cp;
    const double cc = (q == 0) ? cp : (q == 1) ? -sp : (q == 2) ? -cp : sp;
    s = (float)ss; c = (float)cc;
}

__device__ __forceinline__ void p0_prologue(Frame& F) {
    const int gw = F.bid * NWAVES + F.wave, NGW = F.G * NWAVES, lane = F.lane;
    LAS float* scr = (LAS float*)(F.lds + F.wave * 16384);
    {
        constexpr int I_IN = 16 * 240, I_BR = 8 * 32, I_OUT = 16 * 32, I_UP = 16 * 176, I_DN = 44 * 32, I_L = I_IN + 3 * I_BR + I_OUT + I_UP + I_DN;
        for (int it = gw; it < 2 * I_L; it += NGW) {
            const int l = it / I_L; int r = it % I_L;
            if (r < I_IN) { p0_tr_item<true>(FIN(I_WIN) + (size_t)l * DM * D_IN, D_IN, WSP(bf16, WS_WIN) + (size_t)l * NIN * DM, DM, 64 * (r / 240), 32 * (r % 240), scr, lane); continue; } r -= I_IN;
            if (r < 3 * I_BR) { const int w = r / I_BR, q = r % I_BR; const float* src = FIN(w == 0 ? I_WBRA : (w == 1 ? I_WBRB : I_WBRC)) + (size_t)l * 512 * 1024;
                p0_tr_item<false>(src, 1024, WSP(bf16, WS_WBR) + (size_t)(l * 3 + w) * 1024 * 512, 512, 64 * (q / 32), 32 * (q % 32), scr, lane); continue; } r -= 3 * I_BR;
            if (r < I_OUT) { p0_tr_item<false>(FIN(I_WOUT) + (size_t)l * 1024 * 1024, 1024, WSP(bf16, WS_WOUT) + (size_t)l * 1024 * 1024, 1024, 64 * (r / 32), 32 * (r % 32), scr, lane); continue; } r -= I_OUT;
            if (r < I_UP) { p0_tr_item<false>(FIN(I_WUP) + (size_t)l * DM * NUP, NUP, WSP(bf16, WS_WUP) + (size_t)l * NUP * DM, DM, 64 * (r / 176), 32 * (r % 176), scr, lane); continue; } r -= I_UP;
            p0_tr_item<false>(FIN(I_WDN) + (size_t)l * DFF * DM, DM, WSP(bf16, WS_WDN) + (size_t)l * DM * DFF, DFF, 64 * (r / 32), 32 * (r % 32), scr, lane);
        }
    }
    {
        constexpr int NI_W1 = 8 * 16 * 4, NI_W2 = 4 * 2 * 2, NI_RG = 32 * 2;
        for (int it = gw; it < NI_W1 + NI_W2 + NI_RG; it += NGW) {
            int r = it;
            if (r < NI_W1) { const int m = r / 64, q = r % 64, lk = m >> 1, half = m & 1;
                p0_tr_item<false>(FIN(I_W1) + ((size_t)lk * 32 + half * 16) * 64 * 128, 128, WSP(bf16, WS_SMALLW + SW_W1T) + ((size_t)lk * 256 + half * 128) * 1024, 1024, 64 * (q / 4), 32 * (q % 4), scr, lane); continue; } r -= NI_W1;
            if (r < NI_W2) { const int lk = r / 4, q = r % 4;
                p0_tr_item<false>(FIN(I_W2) + (size_t)lk * 128 * 64, 64, WSP(bf16, WS_SMALLW + SW_W2T) + (size_t)lk * 64 * 128, 128, 64 * (q / 2), 32 * (q % 2), scr, lane); continue; } r -= NI_W2;
            { const int m = r / 2, q = r % 2, l = m >> 4, which = (m >> 3) & 1, blk = m & 7;
                p0_tr_item<false>(FIN(which ? I_RWX : I_RWA) + ((size_t)l * 8 + blk) * 4096, 64, WSP(bf16, WS_SMALLW + SW_WAT) + (size_t)m * 4096, 64, 0, 32 * q, scr, lane); }
        }
    }
    for (int it = gw; it < 64; it += NGW) {
        const int lk = it >> 4, h0 = (it & 15) * 8; const float* pe = FIN(I_PE) + (size_t)lk * 2048; const float* w1 = FIN(I_W1) + (size_t)lk * 2048 * 128 + h0;
        f32x4 a0 = (f32x4){0.f, 0.f, 0.f, 0.f}, a1 = a0;
#pragma unroll 8
        for (int i = lane; i < 2048; i += 64) { const float p = pe[i]; a0 += *(const f32x4*)(w1 + (size_t)i * 128) * p; a1 += *(const f32x4*)(w1 + (size_t)i * 128 + 4) * p; }
#pragma unroll
        for (int x = 0; x < 4; ++x) { a0[x] = wave_sum(a0[x]); a1[x] = wave_sum(a1[x]); }
        if (lane == 0) { float* cb = WSP(float, WS_SMALLW + SW_CB) + lk * 128 + h0; const float* b1 = FIN(I_B1) + lk * 128 + h0;
#pragma unroll
            for (int x = 0; x < 4; ++x) { cb[x] = a0[x] + b1[x]; cb[4 + x] = a1[x] + b1[4 + x]; } }
    }
    for (int i = F.bid * NTHR + F.tid; i < 1024; i += F.G * NTHR) { const float lam = FIN(I_LAM)[i]; WSP(float, WS_SMALLW + SW_SP)[i] = log1pf(expf(-lam)); }
    for (int i = F.bid * NTHR + F.tid; i < 4104 * 64; i += F.G * NTHR) {
        const int pi = i >> 6, fi = i & 63; const float pos = (float)(pi < PT ? pi : PAST + (pi - PT));
        const float freq = (float)pow(10000.0, -(double)fi / 64.0); const float ang = pos * freq; float s, c; sincos_acc(ang, s, c);
        WSP(float, WS_ROT)[i] = c; WSP(float, WS_ROT)[4104 * 64 + i] = s;
    }
    {
        LAS float* SC = (LAS float*)(F.lds + 0);
        LAS float* RED = (LAS float*)(F.lds + 36864);
        for (int u = F.bid; u < 2 * 96; u += F.G) {
            const int l = u / 96, cg = u % 96; float acc[36];
#pragma unroll
            for (int b = 0; b < 36; ++b) acc[b] = 0.f;
#pragma unroll 1
            for (int kh = 0; kh < 4; ++kh) {
                __syncthreads();
                for (int i = F.tid; i < 256 * 36; i += NTHR) { const int d = i / 36, bb = i % 36; const float c = (bb < 4) ? FIN(I_CP)[bb * DM + kh * 256 + d] : FIN(I_CS)[(bb - 4) * DM + kh * 256 + d]; SC[i] = siluf_(c); }
                __syncthreads();
                const float* wp = FIN(I_WADA) + ((size_t)l * DM + kh * 256 + F.wave * 32) * 6144 + cg * 64 + lane;
#pragma unroll 1
                for (int d0 = 0; d0 < 32; d0 += 16) {
                    float wv[16];
#pragma unroll
                    for (int k = 0; k < 16; ++k) wv[k] = wp[(size_t)(d0 + k) * 6144];
#pragma unroll
                    for (int k = 0; k < 16; ++k) { const LAS f32x4* sc4 = (const LAS f32x4*)(SC + (F.wave * 32 + d0 + k) * 36);
#pragma unroll
                        for (int g = 0; g < 9; ++g) { const f32x4 s4 = sc4[g]; acc[4 * g + 0] += wv[k] * s4[0]; acc[4 * g + 1] += wv[k] * s4[1]; acc[4 * g + 2] += wv[k] * s4[2]; acc[4 * g + 3] += wv[k] * s4[3]; } }
                }
            }
#pragma unroll
            for (int b = 0; b < 36; ++b) RED[(F.wave * 36 + b) * 64 + lane] = acc[b];
            __syncthreads();
            for (int o = F.tid; o < 36 * 64; o += NTHR) { const int b = o >> 6, col = o & 63; float sm = FIN(I_BADA)[l * 6144 + cg * 64 + col];
#pragma unroll
                for (int w = 0; w < 8; ++w) sm += RED[(w * 36 + b) * 64 + col];
                WSP(float, WS_MOD)[((size_t)l * 36 + b) * 6144 + cg * 64 + col] = sm; }
        }
        __syncthreads();
    }
    for (int it = gw; it < 2 * SB * PAST / 8; it += NGW) {
        const int l = it / (SB * PAST / 8), r = it % (SB * PAST / 8), db = r / (PAST / 8), tt0 = (r % (PAST / 8)) * 8;
        const int page = ((const int*)F.a->in[I_PT])[db * NPG + (tt0 >> 7)];
        const float* src = FIN(I_CACHE) + (((size_t)l * NPHYS + page) * PAGE + (tt0 & 127)) * 512 + lane * 4;
        f32x4 v[8];
#pragma unroll
        for (int k = 0; k < 8; ++k) v[k] = __builtin_nontemporal_load((const f32x4*)(src + (size_t)k * 512));
        const int idx = lane * 4, j = idx >> 7, kk = (idx >> 6) & 1, d = idx & 63;
        bf16* dst = WSP(bf16, WS_ACMP) + ((size_t)(l * 2 + j) * CMP_ROWS_J) * 1024 + ((size_t)(db * 2 + kk) * PAST + tt0) * 64 + d;
#pragma unroll
        for (int k = 0; k < 8; ++k) { v2u o; o.x = pk2(v[k][0], v[k][1]); o.y = pk2(v[k][2], v[k][3]); *(v2u*)(dst + (size_t)k * 64) = o; }
    }
    for (size_t i = (size_t)F.bid * NTHR + F.tid; i < (size_t)2 * SB * 504 * 64; i += (size_t)F.G * NTHR) {
        const size_t seq = i / (504 * 64), r = i % (504 * 64);
        const f32x4 v = *(const f32x4*)(FIN(I_CWIN) + (seq * 512 + 8) * 256 + r * 4);
        *(f32x4*)(F.out + OUT_WIN_S + seq * 512 * 256 + r * 4) = v;
    }
}

__device__ __forceinline__ const float* xrow_in(const Frame& F, int l, int row) {
    if (l == 0) return row < PM ? FIN(I_XP) + (size_t)row * DM : FIN(I_XS) + (size_t)(row - PM) * DM;
    return WSP(float, WS_X2) + (size_t)row * DM;
}
__device__ __forceinline__ void norm_phase(Frame& F, int l, int which) {
    const int gw = F.bid * NWAVES + F.wave, NGW = F.G * NWAVES, lane = F.lane;
    const float* g = FIN(which ? I_N2G : I_N1G) + l * DM;
    for (int row0 = gw * 2; row0 < MT; row0 += NGW * 2) {
        f32x4 v[2][4]; float ss[2];
#pragma unroll
        for (int rr = 0; rr < 2; ++rr) { const float* xr = which ? WSP(float, WS_X1) + (size_t)(row0 + rr) * DM : xrow_in(F, l, row0 + rr);
#pragma unroll
            for (int j = 0; j < 4; ++j) v[rr][j] = *(const f32x4*)(xr + lane * 4 + 256 * j); }
#pragma unroll
        for (int rr = 0; rr < 2; ++rr) { float a = 0.f;
#pragma unroll
            for (int j = 0; j < 4; ++j) a += (v[rr][j][0] * v[rr][j][0] + v[rr][j][1] * v[rr][j][1]) + (v[rr][j][2] * v[rr][j][2] + v[rr][j][3] * v[rr][j][3]);
            ss[rr] = a; }
#pragma unroll
        for (int o = 1; o < 64; o <<= 1) { ss[0] += __shfl_xor(ss[0], o); ss[1] += __shfl_xor(ss[1], o); }
#pragma unroll
        for (int rr = 0; rr < 2; ++rr) { const int row = row0 + rr; const float rs = 1.0f / sqrtf(ss[rr] * (1.0f / DM) + EPS);
            const float* mod = WSP(float, WS_MOD) + ((size_t)l * 36 + row_bb(row)) * 6144 + (which ? 3072 : 0); bf16* o = WSP(bf16, WS_H) + (size_t)row * DM;
#pragma unroll
            for (int j = 0; j < 4; ++j) { const int c = lane * 4 + 256 * j; const f32x4 gg = *(const f32x4*)(g + c), sh = *(const f32x4*)(mod + c), sc = *(const f32x4*)(mod + 1024 + c);
                const f32x4 y = (v[rr][j] * rs) * gg * (sc + 1.0f) + sh; v2u w; w.x = pk2(y[0], y[1]); w.y = pk2(y[2], y[3]); *(v2u*)(o + c) = w; } }
    }
}
__device__ __forceinline__ void final_phase(Frame& F) {
    const int gw = F.bid * NWAVES + F.wave, NGW = F.G * NWAVES, lane = F.lane;
    const float* g = FIN(I_FNG);
    for (int row = gw; row < MT; row += NGW) {
        const float* xr = WSP(float, WS_X2) + (size_t)row * DM;
        f32x4 v[4]; float ss = 0.f;
#pragma unroll
        for (int j = 0; j < 4; ++j) { v[j] = *(const f32x4*)(xr + lane * 4 + 256 * j); ss += (v[j][0] * v[j][0] + v[j][1] * v[j][1]) + (v[j][2] * v[j][2] + v[j][3] * v[j][3]); }
        const float rs = 1.0f / sqrtf(wave_sum(ss) * (1.0f / DM) + EPS);
        float* o = F.out + OUT_Y + (size_t)row * DM;
#pragma unroll
        for (int j = 0; j < 4; ++j) { const int c = lane * 4 + 256 * j; *(f32x4*)(o + c) = (v[j] * rs) * *(const f32x4*)(g + c); }
    }
}

#define EPI_LOOP_BEGIN \
    _Pragma("unroll") for (int ai = 0; ai < 2; ++ai) _Pragma("unroll") for (int m = 0; m < 4; ++m) { const int row = u.pm * 256 + ai * 128 + wr * 64 + m * 16 + fr; \
    _Pragma("unroll") for (int bj = 0; bj < 2; ++bj) { const int ct = bj * 128 + wc * 32 + 8 * fq; const f32x4 v0 = acc[ai][bj][m][0], v1 = acc[ai][bj][m][1];
#define EPI_LOOP_END } }

struct EpiWin {
    static constexpr bool PERM = true, AFTER_DRAIN = false;
    unsigned char* ws; float* out; int l;
    __device__ __forceinline__ void operator()(const f32x4 (&acc)[2][2][4][2], const pg8::Unit& u, int wr, int wc, int fr0, int fq0) const {
        int fr = fr0, fq = fq0; asm volatile("" : "+v"(fr), "+v"(fq));
        const int pn = u.pn;
        if (pn < 2) {
            bf16* QN = (bf16*)(ws + WS_QN);
            EPI_LOOP_BEGIN *(v4u*)(QN + (size_t)row * 512 + pn * 256 + ct) = pack8(v0 * QSCALE, v1 * QSCALE); EPI_LOOP_END
        } else if (pn < 5) {
            EPI_LOOP_BEGIN
                const int c = (pn - 2) * 256 + ct, j = c >> 7, k = (c >> 6) & 1, d = c & 63;
                const bool isp = row < PM; const int b = isp ? (row >> 12) : ((row - PM) >> 3), t = isp ? (row & (PT - 1)) : ((row - PM) & 7);
                if (j < 4) { float* o = out + (isp ? OUT_ROWS_P + ((size_t)l * PM + row) * 512 : OUT_ROWS_S + ((size_t)l * SM + (row - PM)) * 512) + c; *(f32x4*)o = v0; *(f32x4*)(o + 4) = v1; }
                else if (isp) { if (t >= PT - WINB) { float* o = out + OUT_WIN_P + (((size_t)l * PB + b) * WINB + (t - (PT - WINB))) * 256 + (c - 512); *(f32x4*)o = v0; *(f32x4*)(o + 4) = v1; } }
                else { float* o = out + OUT_WIN_S + (((size_t)l * SB + b) * WINB + (WINB - ST) + t) * 256 + (c - 512); *(f32x4*)o = v0; *(f32x4*)(o + 4) = v1; }
                const v4u w = pack8(v0, v1);
                if (isp) {
                    if (j < 2) *(v4u*)((bf16*)(ws + WS_ACMP) + ((size_t)(l * 2 + j) * CMP_ROWS_J + 32768 + (b * 2 + k) * 256) * 1024 + (size_t)t * 64 + d) = w;
                    else *(v4u*)((bf16*)(ws + WS_KVB) + ((((size_t)(j - 2) * PB + b) * 2 + k) * PT + t) * 64 + d) = w;
                } else if (j >= 2) *(v4u*)((bf16*)(ws + WS_KVS) + ((((size_t)(j - 2) * SB + b) * 2 + k) * ST + t) * 64 + d) = w;
            EPI_LOOP_END
        } else if (pn < 9) {
            const float* ROTC = (const float*)(ws + WS_ROT); const float* ROTS = ROTC + 4104 * 64;
            EPI_LOOP_BEGIN
                const int c = (pn - 5) * 256 + ct, isk = c >> 9, hc = c & 511, head = hc >> 7, d0 = ((hc & 127) >> 3) * 4;
                const int pi = row_pos(row); const f32x4 cs = *(const f32x4*)(ROTC + pi * 64 + d0), sn = *(const f32x4*)(ROTS + pi * 64 + d0);
                const float sc = isk ? 0.08838834764831845f : 1.0f;
                const f32x4 o1 = (v0 * cs - v1 * sn) * sc, o2 = (v0 * sn + v1 * cs) * sc;
                bf16* o = (bf16*)(ws + WS_RQ) + (size_t)isk * MT * 512 + (size_t)row * 512 + head * 128 + d0;
                v2u w1; w1.x = pk2(o1[0], o1[1]); w1.y = pk2(o1[2], o1[3]); *(v2u*)o = w1;
                v2u w2; w2.x = pk2(o2[0], o2[1]); w2.y = pk2(o2[2], o2[3]); *(v2u*)(o + 64) = w2;
            EPI_LOOP_END
        } else if (pn < 13) {
            bf16* RV = (bf16*)(ws + WS_RQ) + (size_t)2 * MT * 512;
            EPI_LOOP_BEGIN const int c = (pn - 9) * 256 + ct; *(v4u*)(RV + (size_t)(c >> 9) * MT * 512 + (size_t)row * 512 + (c & 511)) = pack8(v0, v1); EPI_LOOP_END
        } else if (pn < 15) {
            float* RX = (float*)(ws + WS_RX);
            EPI_LOOP_BEGIN
                const int c = (pn - 13) * 256 + ct; float* o = RX + (size_t)row * 512 + c; *(f32x4*)o = v0; *(f32x4*)(o + 4) = v1;
                if (row < PM) { const int t = row & (PT - 1); if (t >= PT - 3) { float* q = out + OUT_CV_P + (((size_t)l * PB + (row >> 12)) * 3 + (t - (PT - 3))) * 512 + c; *(f32x4*)q = v0; *(f32x4*)(q + 4) = v1; } }
                else { const int i = (row - PM) & 7; if (i >= ST - 3) { float* q = out + OUT_CV_S + (((size_t)l * SB + ((row - PM) >> 3)) * 3 + (i - (ST - 3))) * 512 + c; *(f32x4*)q = v0; *(f32x4*)(q + 4) = v1; } }
            EPI_LOOP_END
        } else if (pn < 17) {
            bf16* GG = (bf16*)(ws + WS_GG);
            EPI_LOOP_BEGIN const int c = (pn - 15) * 256 + ct;
                f32x4 a, b;
#pragma unroll
                for (int i = 0; i < 4; ++i) { a[i] = gelu_tanh(v0[i]); b[i] = gelu_tanh(v1[i]); }
                *(v4u*)(GG + (size_t)row * 512 + c) = pack8(a, b); EPI_LOOP_END
        } else if (pn < 29) {
            bf16* MG = (bf16*)(ws + WS_MGS);
            EPI_LOOP_BEGIN const int c = (pn - 17) * 256 + ct;
                f32x4 a, b;
#pragma unroll
                for (int i = 0; i < 4; ++i) { a[i] = sigmoidf_(v0[i]); b[i] = sigmoidf_(v1[i]); }
                *(v4u*)(MG + (size_t)row * 3072 + c) = pack8(a, b); EPI_LOOP_END
        } else {
            float* NG = (float*)(ws + WS_NG);
            EPI_LOOP_BEGIN if (ct < 24) { f32x4 a, b;
#pragma unroll
                for (int i = 0; i < 4; ++i) { a[i] = sigmoidf_(v0[i]); b[i] = sigmoidf_(v1[i]); }
                float* o = NG + (size_t)row * 24 + ct; *(f32x4*)o = a; *(f32x4*)(o + 4) = b; } EPI_LOOP_END
        }
    }
};

struct EpiLH {
    static constexpr bool PERM = true, AFTER_DRAIN = false;
    bf16* LH;
    __device__ __forceinline__ void operator()(const f32x4 (&acc)[2][2][4][2], const pg8::Unit& u, int wr, int wc, int fr0, int fq0) const {
        int fr = fr0, fq = fq0; asm volatile("" : "+v"(fr), "+v"(fq));
        EPI_LOOP_BEGIN *(v4u*)(LH + (size_t)row * 256 + ct) = pack8(v0, v1); EPI_LOOP_END
    }
};
struct CmpOrder {
    int G, c;
    __device__ bool next(int i, pg8::Unit& u) const { const int L = i * G + c; if (L >= CMP_ROWS / 256) return false; u.pm = L; u.pn = L / (CMP_ROWS_J / 256); return true; }
    __device__ __forceinline__ void a_ready(const pg8::Unit&) const {}
    __device__ __forceinline__ void done(const pg8::Unit&) const {}
};

template <int BR> struct EpiBr {
    static constexpr bool PERM = true, AFTER_DRAIN = false;
    unsigned char* ws;
    __device__ __forceinline__ void operator()(const f32x4 (&acc)[2][2][4][2], const pg8::Unit& u, int wr, int wc, int fr0, int fq0) const {
        int fr = fr0, fq = fq0; asm volatile("" : "+v"(fr), "+v"(fq));
        const bf16* MG = (const bf16*)(ws + WS_MGS); bf16* MR = (bf16*)(ws + WS_MRG);
        EPI_LOOP_BEGIN
            const int col = u.pn * 256 + ct; f32x4 g0, g1; unpack8(*(const v4u*)(MG + (size_t)row * 3072 + BR * 1024 + col), g0, g1);
            f32x4 r0 = v0 * g0, r1 = v1 * g1; bf16* o = MR + (size_t)row * DM + col;
            if (BR > 0) { f32x4 p0, p1; unpack8(*(const v4u*)o, p0, p1); r0 += p0; r1 += p1; }
            *(v4u*)o = pack8(r0, r1);
        EPI_LOOP_END
    }
};

struct BrOrder {
    pg8::StaticOrder S;
    __device__ bool next(int i, pg8::Unit& u) const { pg8::Unit t; if (!S.next(i / 3, t)) return false; const int br = i % 3; u.pm = br * (MT / 256) + t.pm; u.pn = br * 4 + t.pn; return true; }
    __device__ __forceinline__ void a_ready(const pg8::Unit&) const {}
    __device__ __forceinline__ void done(const pg8::Unit&) const {}
};
struct EpiBrAll {
    static constexpr bool PERM = true, AFTER_DRAIN = false;
    unsigned char* ws;
    __device__ __forceinline__ void operator()(const f32x4 (&acc)[2][2][4][2], const pg8::Unit& u0, int wr, int wc, int fr0, int fq0) const {
        int fr = fr0, fq = fq0; asm volatile("" : "+v"(fr), "+v"(fq));
        const int br = u0.pn >> 2; const pg8::Unit u{u0.pm - br * (MT / 256), u0.pn & 3};
        const bf16* MG = (const bf16*)(ws + WS_MGS) + br * 1024; bf16* MR = (bf16*)(ws + WS_MRG);
        if (br == 0) {
            EPI_LOOP_BEGIN const int col = u.pn * 256 + ct; f32x4 g0, g1; unpack8(*(const v4u*)(MG + (size_t)row * 3072 + col), g0, g1); *(v4u*)(MR + (size_t)row * DM + col) = pack8(v0 * g0, v1 * g1); EPI_LOOP_END
        } else {
            EPI_LOOP_BEGIN const int col = u.pn * 256 + ct; f32x4 g0, g1, p0, p1; unpack8(*(const v4u*)(MG + (size_t)row * 3072 + col), g0, g1); bf16* o = MR + (size_t)row * DM + col; unpack8(*(const v4u*)o, p0, p1);
                *(v4u*)o = pack8(v0 * g0 + p0, v1 * g1 + p1); EPI_LOOP_END
        }
    }
};

struct EpiRes {
    static constexpr bool PERM = true, AFTER_DRAIN = false;
    const float* xin_p; const float* xin_s; float* xout; const float* mod; int gofs;
    __device__ __forceinline__ void operator()(const f32x4 (&acc)[2][2][4][2], const pg8::Unit& u, int wr, int wc, int fr0, int fq0) const {
        int fr = fr0, fq = fq0; asm volatile("" : "+v"(fr), "+v"(fq));
        EPI_LOOP_BEGIN
            const int col = u.pn * 256 + ct; const float* xi = (xin_s && row >= PM) ? xin_s + (size_t)(row - PM) * DM + col : xin_p + (size_t)row * DM + col;
            const float* g = mod + (size_t)row_bb(row) * 6144 + gofs + col; float* o = xout + (size_t)row * DM + col;
            *(f32x4*)o = *(const f32x4*)xi + *(const f32x4*)g * v0; *(f32x4*)(o + 4) = *(const f32x4*)(xi + 4) + *(const f32x4*)(g + 4) * v1;
        EPI_LOOP_END
    }
};

struct EpiUp {
    static constexpr bool PERM = true, AFTER_DRAIN = false;
    unsigned char* ws; float* out; int l;
    __device__ __forceinline__ void operator()(const f32x4 (&acc)[2][2][4][2], const pg8::Unit& u, int wr, int wc, int fr0, int fq0) const {
        int fr = fr0, fq = fq0; asm volatile("" : "+v"(fr), "+v"(fq));
        bf16* GP = (bf16*)(ws + WS_GP); bf16* VAL = GP + (size_t)MT * DFF;
        if (u.pn < 11) {
            EPI_LOOP_BEGIN const int c = u.pn * 256 + ct; *(v4u*)(GP + (size_t)row * DFF + c) = pack8(v0, v1);
                if (row < PM) { const int t = row & (PT - 1); if (t >= PT - 2) { float* q = out + OUT_FC_P + (((size_t)l * PB + (row >> 12)) * 2 + (t - (PT - 2))) * DFF + c; *(f32x4*)q = v0; *(f32x4*)(q + 4) = v1; } }
                else { const int i = (row - PM) & 7; if (i >= ST - 2) { float* q = out + OUT_FC_S + (((size_t)l * SB + ((row - PM) >> 3)) * 2 + (i - (ST - 2))) * DFF + c; *(f32x4*)q = v0; *(f32x4*)(q + 4) = v1; } }
            EPI_LOOP_END
        } else {
            EPI_LOOP_BEGIN const int c = (u.pn - 11) * 256 + ct; *(v4u*)(VAL + (size_t)row * DFF + c) = pack8(v0, v1); EPI_LOOP_END
        }
    }
};

__device__ __forceinline__ f32x16 mfma32(bf16x8 a, bf16x8 b, f32x16 c) { return __builtin_amdgcn_mfma_f32_32x32x16_bf16(a, b, c, 0, 0, 0); }
__device__ __forceinline__ f32x4 mfma16(bf16x8 a, bf16x8 b, f32x4 c) { return __builtin_amdgcn_mfma_f32_16x16x32_bf16(a, b, c, 0, 0, 0); }
__device__ __forceinline__ float ret_log_g(int h) { return log1pf(-exp2f(-5.0f - (float)h)); }
__device__ __forceinline__ bf16x8 tr_frag(const LAS unsigned char* base, int rs_bytes, int rowA, int rowB, int colbase, int lane) {
    const int q = (lane & 15) >> 2, p = lane & 3;
    const LAS unsigned char* pa = base + (rowA + q) * rs_bytes + (colbase + 4 * p) * 2;
    const LAS unsigned char* pb = base + (rowB + q) * rs_bytes + (colbase + 4 * p) * 2;
    const s16x4 a = __builtin_bit_cast(s16x4, __builtin_amdgcn_ds_read_tr16_b64_v4i16((LAS s16x4*)pa));
    const s16x4 b = __builtin_bit_cast(s16x4, __builtin_amdgcn_ds_read_tr16_b64_v4i16((LAS s16x4*)pb));
    return (bf16x8){a[0], a[1], a[2], a[3], b[0], b[1], b[2], b[3]};
}
__device__ __forceinline__ bf16x8 cvt_frag(const f32x16& p, int s2) {
    u32x4 w; w.x = pk2(p[8 * s2 + 0], p[8 * s2 + 1]); w.y = pk2(p[8 * s2 + 2], p[8 * s2 + 3]); w.z = pk2(p[8 * s2 + 4], p[8 * s2 + 5]); w.w = pk2(p[8 * s2 + 6], p[8 * s2 + 7]);
    return __builtin_bit_cast(bf16x8, w);
}

__device__ __forceinline__ void cmp2_phase(Frame& F, int l) {
    const int gw = F.bid * NWAVES + F.wave, NGW = F.G * NWAVES, lane = F.lane, r = lane & 15, g = lane >> 4;
    const bf16* LH = WSP(bf16, WS_LH); bf16* CK = WSP(bf16, WS_CK);
    for (int wu = gw; wu < CMP_ROWS / 16; wu += NGW) {
        const int row0 = wu * 16, j = row0 / CMP_ROWS_J, rj = (row0 % CMP_ROWS_J) + r, row = row0 + r;
        const bool valid = (rj < 32768) ? ((rj & 511) < 511) : (((rj - 32768) & 255) < 255);
        const bf16* W2T = WSP(bf16, WS_SMALLW + SW_W2T) + (size_t)(l * 2 + j) * 64 * 128; const float* CB = WSP(float, WS_SMALLW + SW_CB) + (l * 2 + j) * 128;
        f32x4 acc[4];
#pragma unroll
        for (int ct = 0; ct < 4; ++ct) acc[ct] = (f32x4){0.f, 0.f, 0.f, 0.f};
#pragma unroll
        for (int ks = 0; ks < 4; ++ks) {
            const int h0 = 32 * ks + 8 * g; f32x4 a0, a1, b0, b1;
            unpack8(*(const v4u*)(LH + (size_t)row * 256 + h0), a0, a1); unpack8(*(const v4u*)(LH + (size_t)(row + 1) * 256 + 128 + h0), b0, b1);
            const f32x4 c0 = *(const f32x4*)(CB + h0), c1 = *(const f32x4*)(CB + h0 + 4);
            f32x4 x0 = a0 + b0 + c0, x1 = a1 + b1 + c1;
#pragma unroll
            for (int i = 0; i < 4; ++i) { x0[i] = gelu_tanh(x0[i]); x1[i] = gelu_tanh(x1[i]); }
            const bf16x8 hf = __builtin_bit_cast(bf16x8, pack8(x0, x1));
#pragma unroll
            for (int ct = 0; ct < 4; ++ct) { const bf16x8 wf = *(const bf16x8*)(W2T + (size_t)(16 * ct + r) * 128 + h0); acc[ct] = mfma16(wf, hf, acc[ct]); }
        }
#pragma unroll
        for (int ct = 0; ct < 4; ++ct) { const f32x4 v = valid ? acc[ct] : (f32x4){0.f, 0.f, 0.f, 0.f}; v2u w; w.x = pk2(v[0], v[1]); w.y = pk2(v[2], v[3]);
            *(v2u*)(CK + (size_t)row * 64 + 16 * ct + 4 * g) = w; }
    }
}

constexpr int CG_RS = 144, CG_BUF = 256 * CG_RS, CG_AW = 2 * CG_BUF;
__device__ __forceinline__ void cmp_gemm_unit(Frame& F, int l, int pm) {
    const int tid = F.tid, lane = F.lane, w = F.wave, q = lane & 31, h_ = lane >> 5;
    const int j = pm / 136, r = pm % 136; const bool smp = r < 128;
    const int grp = smp ? (r >> 1) : (r - 128), n0 = (smp ? (r & 1) * 256 : 0) + 32 * w;
    const float* rp[8]; const bf16* ab = nullptr;
    if (smp) { const int db = grp >> 1, k = grp & 1;
#pragma unroll
        for (int i = 0; i < 8; ++i) { const int tt0 = (n0 + 4 * i + (lane >> 4)) * 16; const int page = ((const int*)F.a->in[I_PT])[db * NPG + (tt0 >> 7)];
            rp[i] = FIN(I_CACHE) + (((((size_t)l * NPHYS + page) * PAGE + (tt0 & 127)) * 4 + j) * 2 + k) * 64 + (lane & 15) * 4; } }
    else { ab = WSP(bf16, WS_ACMP) + ((size_t)(l * 2 + j) * CMP_ROWS_J + 32768 + grp * 256 + n0 + q) * 1024 + 8 * h_;
#pragma unroll
        for (int i = 0; i < 8; ++i) rp[i] = nullptr; }
    const bf16* Bg = WSP(bf16, WS_SMALLW + SW_W1T) + (size_t)(l * 2 + j) * 256 * 1024;
    f32x16 acc[8];
#pragma unroll
    for (int ct = 0; ct < 8; ++ct) acc[ct] = (f32x16){};
    const bf16* bsrc = Bg + (size_t)(tid >> 1) * 1024 + (tid & 1) * 32; LAS unsigned char* bdst = F.lds + (tid >> 1) * CG_RS + (tid & 1) * 64;
    LAS unsigned char* Aw = F.lds + CG_AW + w * 32 * CG_RS;
    v4u bst[4]; f32x4 an[8]; v4u anb[4];
    __syncthreads();
#pragma unroll
    for (int x = 0; x < 4; ++x) bst[x] = *(const v4u*)(bsrc + 8 * x);
#pragma unroll
    for (int x = 0; x < 4; ++x) *(LAS v4u*)(bdst + x * 16) = bst[x];
    if (smp) {
#pragma unroll
        for (int i = 0; i < 8; ++i) an[i] = *(const f32x4*)(rp[i]); }
    else {
#pragma unroll
        for (int ks = 0; ks < 4; ++ks) anb[ks] = *(const v4u*)(ab + ks * 16); }
    __syncthreads();
#pragma unroll 1
    for (int kc = 0; kc < 16; ++kc) {
        bf16x8 ac[4];
        if (smp) {
#pragma unroll
            for (int i = 0; i < 8; ++i) { v2u o; o.x = pk2(an[i][0], an[i][1]); o.y = pk2(an[i][2], an[i][3]); *(LAS v2u*)(Aw + (4 * i + (lane >> 4)) * CG_RS + (lane & 15) * 8) = o; }
            LDS_WAIT(); asm volatile("" ::: "memory");
#pragma unroll
            for (int ks = 0; ks < 4; ++ks) ac[ks] = *(const LAS bf16x8*)(Aw + q * CG_RS + ks * 32 + 16 * h_);
        } else {
#pragma unroll
            for (int ks = 0; ks < 4; ++ks) ac[ks] = __builtin_bit_cast(bf16x8, anb[ks]); }
        if (kc + 1 < 16) {
#pragma unroll
            for (int x = 0; x < 4; ++x) bst[x] = *(const v4u*)(bsrc + (kc + 1) * 64 + 8 * x);
            if (smp) {
#pragma unroll
                for (int i = 0; i < 8; ++i) an[i] = *(const f32x4*)(rp[i] + (size_t)(kc + 1) * 512); }
            else {
#pragma unroll
                for (int ks = 0; ks < 4; ++ks) anb[ks] = *(const v4u*)(ab + (kc + 1) * 64 + ks * 16); }
        }
        const LAS unsigned char* bb = F.lds + (kc & 1) * CG_BUF + q * CG_RS + 16 * h_;
#pragma unroll
        for (int ks = 0; ks < 4; ++ks)
#pragma unroll
            for (int ct = 0; ct < 8; ++ct) { const bf16x8 bf = *(const LAS bf16x8*)(bb + ct * 32 * CG_RS + ks * 32); acc[ct] = mfma32(bf, ac[ks], acc[ct]); }
        if (kc + 1 < 16) {
#pragma unroll
            for (int x = 0; x < 4; ++x) *(LAS v4u*)(bdst + ((kc + 1) & 1) * CG_BUF + x * 16) = bst[x]; }
        __syncthreads();
    }
    bf16* LH = WSP(bf16, WS_LH) + ((size_t)pm * 256 + 32 * w + q) * 256;
#pragma unroll
    for (int ct = 0; ct < 8; ++ct)
#pragma unroll
        for (int r4 = 0; r4 < 4; ++r4) { v2u o; o.x = pk2(acc[ct][4 * r4 + 0], acc[ct][4 * r4 + 1]); o.y = pk2(acc[ct][4 * r4 + 2], acc[ct][4 * r4 + 3]); *(v2u*)(LH + ct * 32 + 8 * r4 + 4 * h_) = o; }
}

constexpr int RS_KV = 272;
__device__ __forceinline__ void ret_local_unit(Frame& F, int unit) {
    const int bh = unit >> 5, c = unit & 31, b = bh >> 2, h = bh & 3, lane = F.lane, w = F.wave;
    const float lg = ret_log_g(h);
    LAS unsigned char* KS = F.lds; LAS unsigned char* VS = F.lds + 128 * RS_KV;
    const bf16* RK = WSP(bf16, WS_RQ) + (size_t)MT * 512; const bf16* RV = WSP(bf16, WS_RQ) + (size_t)2 * MT * 512;
    __syncthreads();
#pragma unroll
    for (int i = 0; i < 4; ++i) { const int p = F.tid + NTHR * i, j = p >> 4, ch = p & 15; const size_t go = (size_t)(b * PT + 128 * c + j) * 512 + h * 128 + ch * 8;
        f32x4 k0, k1; unpack8(*(const v4u*)(RK + go), k0, k1); const float kw = fexp((float)(127 - j) * lg);
        *(LAS v4u*)(KS + j * RS_KV + ch * 16) = pack8(k0 * kw, k1 * kw);
        *(LAS v4u*)(VS + j * RS_KV + ch * 16) = *(const v4u*)(RV + go); }
    __syncthreads();
    const int et = w >> 1, dt0 = 2 * (w & 1), h_ = lane >> 5, blk = (lane >> 4) & 1;
    f32x16 acc[2]; acc[0] = (f32x16){}; acc[1] = (f32x16){};
#pragma unroll
    for (int ks = 0; ks < 8; ++ks) {
        const int rA = 16 * ks + 8 * h_;
        const bf16x8 af = tr_frag(VS, RS_KV, rA, rA + 4, 32 * et + 16 * blk, lane);
#pragma unroll
        for (int dd = 0; dd < 2; ++dd) { const bf16x8 bfr = tr_frag(KS, RS_KV, rA, rA + 4, 32 * (dt0 + dd) + 16 * blk, lane); acc[dd] = mfma32(af, bfr, acc[dd]); }
    }
    float* LT = WSP(float, WS_LT) + ((size_t)bh * 32 + c) * 16384;
#pragma unroll
    for (int dd = 0; dd < 2; ++dd)
#pragma unroll
        for (int r = 0; r < 16; ++r) { const int e = 32 * et + (r & 3) + 8 * (r >> 2) + 4 * h_; LT[e * 128 + 32 * (dt0 + dd) + (lane & 31)] = acc[dd][r]; }
}
__device__ __forceinline__ void ret_scan_phase(Frame& F, int l) {
    const float* LT = WSP(float, WS_LT); bf16* SPT = WSP(bf16, WS_SPT);
    for (int idx = F.bid * NTHR + F.tid; idx < 16 * 16384; idx += F.G * NTHR) {
        const int bh = idx >> 14, ed = idx & 16383, e = ed >> 7, d = ed & 127, h = bh & 3; const float g128 = fexp(128.0f * ret_log_g(h));
        float S = 0.f;
        for (int c = 0; c < 32; ++c) { const size_t o = ((size_t)bh * 32 + c) * 16384 + ed; SPT[o] = (bf16)(pk2(S, 0.f) & 0xffffu); S = S * g128 + LT[o]; }
        F.out[OUT_RET_P + ((size_t)l * 16 + bh) * 16384 + d * 128 + e] = S;
    }
}
__device__ __forceinline__ void ret_out_unit(Frame& F, int l, int unit) {
    const int bh = unit >> 5, c = unit & 31, b = bh >> 2, h = bh & 3, lane = F.lane, w = F.wave, tid = F.tid;
    const float lg = ret_log_g(h);
    LAS unsigned char* KS = F.lds; LAS unsigned char* VS = F.lds + 128 * RS_KV; LAS float* OT = (LAS float*)F.lds; LAS float* STAT = (LAS float*)(F.lds + 2 * 128 * RS_KV);
    const bf16* RQ = WSP(bf16, WS_RQ); const bf16* RK = RQ + (size_t)MT * 512; const bf16* RV = RQ + (size_t)2 * MT * 512; const bf16* RG = RQ + (size_t)3 * MT * 512;
    const size_t row0 = (size_t)b * PT + 128 * c;
    __syncthreads();
#pragma unroll
    for (int i = 0; i < 4; ++i) { const int p = tid + NTHR * i, j = p >> 4, ch = p & 15; const size_t go = (row0 + j) * 512 + h * 128 + ch * 8;
        *(LAS v4u*)(KS + j * RS_KV + ch * 16) = *(const v4u*)(RK + go); *(LAS v4u*)(VS + j * RS_KV + ch * 16) = *(const v4u*)(RV + go); }
    const int it = w & 3, eh = w >> 2, h_ = lane >> 5, blk = (lane >> 4) & 1, il = 32 * it + (lane & 31);
    bf16x8 qf[8];
#pragma unroll
    for (int ks = 0; ks < 8; ++ks) qf[ks] = *(const bf16x8*)(RQ + (row0 + il) * 512 + h * 128 + 16 * ks + 8 * h_);
    f32x16 acc[2]; acc[0] = (f32x16){}; acc[1] = (f32x16){};
    const bf16* SP = WSP(bf16, WS_SPT) + ((size_t)bh * 32 + c) * 16384;
#pragma unroll
    for (int kb4 = 0; kb4 < 8; kb4 += 4) {
        bf16x8 af[4][2];
#pragma unroll
        for (int ks = 0; ks < 4; ++ks)
#pragma unroll
            for (int e2 = 0; e2 < 2; ++e2) af[ks][e2] = *(const bf16x8*)(SP + (size_t)(32 * (2 * eh + e2) + (lane & 31)) * 128 + 16 * (kb4 + ks) + 8 * h_);
#pragma unroll
        for (int ks = 0; ks < 4; ++ks)
#pragma unroll
            for (int e2 = 0; e2 < 2; ++e2) acc[e2] = mfma32(af[ks][e2], qf[kb4 + ks], acc[e2]);
    }
    { const float cr = fexp((float)(il + 1) * lg); acc[0] *= cr; acc[1] *= cr; }
    __syncthreads();
    for (int jt = 0; jt <= it; ++jt) {
        f32x16 s = (f32x16){};
#pragma unroll
        for (int ks = 0; ks < 8; ++ks) { const bf16x8 kf = *(const LAS bf16x8*)(KS + (32 * jt + (lane & 31)) * RS_KV + (16 * ks + 8 * h_) * 2); s = mfma32(kf, qf[ks], s); }
#pragma unroll
        for (int r = 0; r < 16; ++r) { const int j = 32 * jt + (r & 3) + 8 * (r >> 2) + 4 * h_; const int df = il - j; s[r] = (df >= 0) ? s[r] * fexp((float)df * lg) : 0.f; }
#pragma unroll
        for (int s2 = 0; s2 < 2; ++s2) { const bf16x8 pf = cvt_frag(s, s2); const int rA = 32 * jt + 16 * s2 + 4 * h_;
#pragma unroll
            for (int e2 = 0; e2 < 2; ++e2) { const bf16x8 vf = tr_frag(VS, RS_KV, rA, rA + 8, 32 * (2 * eh + e2) + 16 * blk, lane); acc[e2] = mfma32(vf, pf, acc[e2]); } }
    }
    float s1 = 0.f, s2 = 0.f;
#pragma unroll
    for (int e2 = 0; e2 < 2; ++e2)
#pragma unroll
        for (int r = 0; r < 16; ++r) { const float v = acc[e2][r]; s1 += v; s2 += v * v; }
    s1 += __shfl_xor(s1, 32); s2 += __shfl_xor(s2, 32);
    if (lane < 32) { STAT[(w * 32 + lane) * 2] = s1; STAT[(w * 32 + lane) * 2 + 1] = s2; }
    __syncthreads();
    { const int pw = w ^ 4; s1 += STAT[(pw * 32 + (lane & 31)) * 2]; s2 += STAT[(pw * 32 + (lane & 31)) * 2 + 1]; }
    const float mean = s1 * (1.0f / 128.0f), var = fmaxf(s2 * (1.0f / 128.0f) - mean * mean, 0.f), rstd = 1.0f / sqrtf(var + EPS);
#pragma unroll
    for (int e2 = 0; e2 < 2; ++e2)
#pragma unroll
        for (int r4 = 0; r4 < 4; ++r4) { const int e = 32 * (2 * eh + e2) + 8 * r4 + 4 * h_;
            f32x4 v; v[0] = (acc[e2][4 * r4 + 0] - mean) * rstd; v[1] = (acc[e2][4 * r4 + 1] - mean) * rstd; v[2] = (acc[e2][4 * r4 + 2] - mean) * rstd; v[3] = (acc[e2][4 * r4 + 3] - mean) * rstd;
            *(LAS f32x4*)(OT + il * 132 + e) = v; }
    __syncthreads();
    const float* GN = FIN(I_GNG) + l * 512 + h * 128; bf16* OR_ = WSP(bf16, WS_OA) + (size_t)MT * 512;
#pragma unroll
    for (int k = 0; k < 4; ++k) { const int q = tid + NTHR * k, i = q >> 4, ch = q & 15;
        const f32x4 o0 = *(const LAS f32x4*)(OT + i * 132 + 8 * ch), o1 = *(const LAS f32x4*)(OT + i * 132 + 8 * ch + 4);
        const f32x4 g0 = *(const f32x4*)(GN + 8 * ch), g1 = *(const f32x4*)(GN + 8 * ch + 4); f32x4 r0, r1; unpack8(*(const v4u*)(RG + (row0 + i) * 512 + h * 128 + 8 * ch), r0, r1);
        f32x4 y0, y1;
#pragma unroll
        for (int x = 0; x < 4; ++x) { y0[x] = o0[x] * g0[x] * siluf_(r0[x]); y1[x] = o1[x] * g1[x] * siluf_(r1[x]); }
        *(v4u*)(OR_ + (row0 + i) * 512 + h * 128 + 8 * ch) = pack8(y0, y1); }
}
__device__ __forceinline__ void ret_sample_unit(Frame& F, int l, int unit) {
    const int db = unit >> 2, h = unit & 3, tid = F.tid, e = tid & 127, dp = tid >> 7;
    const float lg = ret_log_g(h);
    LAS float* Q = (LAS float*)F.lds; LAS float* K = Q + 1024; LAS float* V = K + 1024; LAS float* GT = V + 1024; LAS float* CR = GT + 1024;
    LAS float* SC = CR + 4096; LAS float* RED = SC + 64;
    const bf16* RQ = WSP(bf16, WS_RQ); const size_t row0 = (size_t)PM + db * 8;
    __syncthreads();
    for (int i = tid; i < 4096; i += NTHR) { const int which = i >> 10, r = (i >> 7) & 7, d = i & 127; const float v = bf1(RQ[(size_t)which * MT * 512 + (row0 + r) * 512 + h * 128 + d]); Q[which * 1024 + r * 128 + d] = v; }
    __syncthreads();
    const float* S0 = FIN(I_SRET) + (((size_t)l * SB + db) * 4 + h) * 16384; float* SN = F.out + OUT_RET_S + (((size_t)l * SB + db) * 4 + h) * 16384;
    float kwv[8], cr[8];
#pragma unroll
    for (int j = 0; j < 8; ++j) { kwv[j] = V[j * 128 + e] * fexp((float)(7 - j) * lg); cr[j] = 0.f; }
    const float g8 = fexp(8.0f * lg);
    for (int d = dp * 32; d < dp * 32 + 32; ++d) {
        const float s0 = S0[d * 128 + e]; float sn = g8 * s0;
#pragma unroll
        for (int j = 0; j < 8; ++j) { cr[j] += Q[j * 128 + d] * s0; sn += K[j * 128 + d] * kwv[j]; }
        SN[d * 128 + e] = sn;
    }
#pragma unroll
    for (int i = 0; i < 8; ++i) CR[(dp * 8 + i) * 128 + e] = cr[i];
    if (tid < 64) { const int i = tid >> 3, j = tid & 7; float s = 0.f; if (j <= i) { for (int d = 0; d < 128; ++d) s += Q[i * 128 + d] * K[j * 128 + d]; s *= fexp((float)(i - j) * lg); } SC[tid] = s; }
    __syncthreads();
    float o[2];
#pragma unroll
    for (int ii = 0; ii < 2; ++ii) { const int i = 2 * dp + ii; float x = (CR[(0 * 8 + i) * 128 + e] + CR[(1 * 8 + i) * 128 + e] + CR[(2 * 8 + i) * 128 + e] + CR[(3 * 8 + i) * 128 + e]) * fexp((float)(i + 1) * lg);
        for (int j = 0; j <= i; ++j) x += SC[i * 8 + j] * V[j * 128 + e];
        o[ii] = x; }
#pragma unroll
    for (int ii = 0; ii < 2; ++ii) { const float a = wave_sum(o[ii]), q = wave_sum(o[ii] * o[ii]); if (F.lane == 0) { RED[(F.wave * 2 + ii) * 2] = a; RED[(F.wave * 2 + ii) * 2 + 1] = q; } }
    __syncthreads();
    const float* GN = FIN(I_GNG) + l * 512 + h * 128; bf16* OR_ = WSP(bf16, WS_OA) + (size_t)MT * 512;
#pragma unroll
    for (int ii = 0; ii < 2; ++ii) { const int i = 2 * dp + ii, w0 = 2 * dp; const float s1 = RED[(w0 * 2 + ii) * 2] + RED[((w0 + 1) * 2 + ii) * 2], s2 = RED[(w0 * 2 + ii) * 2 + 1] + RED[((w0 + 1) * 2 + ii) * 2 + 1];
        const float mean = s1 * (1.0f / 128.0f), var = fmaxf(s2 * (1.0f / 128.0f) - mean * mean, 0.f), rstd = 1.0f / sqrtf(var + EPS);
        const float y = (o[ii] - mean) * rstd * GN[e] * siluf_(GT[i * 128 + e]);
        OR_[(row0 + i) * 512 + h * 128 + e] = (bf16)(pk2(y, 0.f) & 0xffffu); }
}

template <int MODE> __device__ __forceinline__ void rglru_unit(Frame& F, int l, int unit) {
    const int tid = F.tid, c = tid, lane = F.lane, w = F.wave;
    LAS bf16* XC = (LAS bf16*)F.lds; LAS float* G = (LAS float*)(F.lds + 16384);
    const int seq = (MODE == 2) ? unit : (unit >> 6), tile = (MODE == 2) ? 0 : (unit & 63);
    const size_t row0 = (MODE == 2) ? (size_t)PM + seq * 8 : (size_t)seq * PT + tile * 64;
    const int ntok = (MODE == 2) ? 8 : 64, nsub = (MODE == 2) ? 1 : 4;
    const float* RX = WSP(float, WS_RX);
    const float w0 = FIN(I_RCW)[(l * 4 + 0) * 512 + c], w1 = FIN(I_RCW)[(l * 4 + 1) * 512 + c], w2 = FIN(I_RCW)[(l * 4 + 2) * 512 + c], w3 = FIN(I_RCW)[(l * 4 + 3) * 512 + c], cb = FIN(I_RCB)[l * 512 + c];
    const float ba = FIN(I_RBA)[l * 512 + c], bx = FIN(I_RBX)[l * 512 + c], sp = WSP(float, WS_SMALLW + SW_SP)[l * 512 + c];
    float x3, x2, x1;
    if (MODE == 2) { const float* cv = FIN(I_SCONV) + ((size_t)l * SB + seq) * 3 * 512; x3 = cv[c]; x2 = cv[512 + c]; x1 = cv[1024 + c]; }
    else if (tile == 0) { x3 = 0.f; x2 = 0.f; x1 = 0.f; }
    else { x3 = RX[(row0 - 3) * 512 + c]; x2 = RX[(row0 - 2) * 512 + c]; x1 = RX[(row0 - 1) * 512 + c]; }
    float h = (MODE == 0) ? 0.f : (MODE == 1) ? WSP(float, WS_CAR)[(size_t)4 * 64 * 2 * 512 + ((size_t)seq * 64 + tile) * 512 + c] : FIN(I_SH)[((size_t)l * SB + seq) * 512 + c];
    float aprod = 1.f;
    const int r16 = lane & 15, g4 = lane >> 4;
    bf16x8 wa[4][2], wx[4][2];
    { const bf16* WA = WSP(bf16, WS_SMALLW + SW_WAT) + ((size_t)(l * 2 + 0) * 8 + w) * 4096; const bf16* WX = WSP(bf16, WS_SMALLW + SW_WAT) + ((size_t)(l * 2 + 1) * 8 + w) * 4096;
#pragma unroll
      for (int ct = 0; ct < 4; ++ct)
#pragma unroll
          for (int ks = 0; ks < 2; ++ks) { wa[ct][ks] = *(const bf16x8*)(WA + (16 * ct + r16) * 64 + 32 * ks + 8 * g4); wx[ct][ks] = *(const bf16x8*)(WX + (16 * ct + r16) * 64 + 32 * ks + 8 * g4); } }
    const bf16* GG = WSP(bf16, WS_GG); bf16* OC = WSP(bf16, WS_OA) + (size_t)2 * MT * 512;
    __syncthreads();
    float xn[16]; bf16 gn[16];
#pragma unroll
    for (int tt = 0; tt < 16; ++tt) { xn[tt] = (tt < ntok) ? RX[(row0 + tt) * 512 + c] : 0.f; gn[tt] = (MODE != 0 && tt < ntok) ? GG[(row0 + tt) * 512 + c] : (bf16)0; }
    for (int s = 0; s < nsub; ++s) {
        float xc[16], gg[16];
#pragma unroll
        for (int tt = 0; tt < 16; ++tt) { xc[tt] = xn[tt]; gg[tt] = bf1(gn[tt]); }
        if (s + 1 < nsub) {
#pragma unroll
            for (int tt = 0; tt < 16; ++tt) { const int t = (s + 1) * 16 + tt; xn[tt] = RX[(row0 + t) * 512 + c]; gn[tt] = (MODE != 0) ? GG[(row0 + t) * 512 + c] : (bf16)0; } }
#pragma unroll
        for (int tt = 0; tt < 16; ++tt) { const float x0 = xc[tt];
            xc[tt] = cb + w0 * x3 + w1 * x2 + w2 * x1 + w3 * x0; x3 = x2; x2 = x1; x1 = x0; XC[tt * 512 + c] = (bf16)(pk2(xc[tt], 0.f) & 0xffffu); }
        LDS_WAIT(); asm volatile("" ::: "memory");
        {
            bf16x8 xf[2];
#pragma unroll
            for (int ks = 0; ks < 2; ++ks) xf[ks] = *(const LAS bf16x8*)(XC + r16 * 512 + w * 64 + 32 * ks + 8 * g4);
#pragma unroll
            for (int ct = 0; ct < 4; ++ct) { f32x4 da = (f32x4){0.f, 0.f, 0.f, 0.f}, dx = da;
#pragma unroll
                for (int ks = 0; ks < 2; ++ks) { da = mfma16(wa[ct][ks], xf[ks], da); dx = mfma16(wx[ct][ks], xf[ks], dx); }
                *(LAS f32x4*)(G + r16 * 512 + w * 64 + 16 * ct + 4 * g4) = da; *(LAS f32x4*)(G + 8192 + r16 * 512 + w * 64 + 16 * ct + 4 * g4) = dx; }
        }
        LDS_WAIT(); asm volatile("" ::: "memory");
#pragma unroll
        for (int tt = 0; tt < 16; ++tt) { const int t = s * 16 + tt;
            if (t < ntok) {
                const float r = sigmoidf_(G[tt * 512 + c] + ba), ig = sigmoidf_(G[8192 + tt * 512 + c] + bx);
                const float la = -8.0f * r * sp, a = fexp(la), bt = sqrtf(fmaxf(1.0f - a * a, 0.f)) * (ig * xc[tt]);
                h = a * h + bt; aprod *= a;
                if (MODE != 0) { const size_t o = (row0 + t) * 512 + c; OC[o] = (bf16)(pk2(h * gg[tt], 0.f) & 0xffffu); }
            } }
    }
    if (MODE == 0) { float* CAR = WSP(float, WS_CAR) + ((size_t)seq * 64 + tile) * 1024; CAR[c] = aprod; CAR[512 + c] = h; }
    if (MODE == 2) F.out[OUT_H_S + ((size_t)l * SB + seq) * 512 + c] = h;
}
__device__ __forceinline__ void rglru_carry_phase(Frame& F, int l) {
    const float* CAR = WSP(float, WS_CAR); float* HIN = WSP(float, WS_CAR) + (size_t)4 * 64 * 2 * 512;
    for (int idx = F.bid * NTHR + F.tid; idx < PB * 512; idx += F.G * NTHR) {
        const int b = idx >> 9, c = idx & 511; float h = 0.f;
        for (int t = 0; t < 64; ++t) { HIN[((size_t)b * 64 + t) * 512 + c] = h; const float* cr = CAR + ((size_t)b * 64 + t) * 1024; h = cr[c] * h + cr[512 + c]; }
        F.out[OUT_H_P + ((size_t)l * PB + b) * 512 + c] = h;
    }
}

__device__ __forceinline__ void convact_phase(Frame& F, int l) {
    const bf16* GP = WSP(bf16, WS_GP); const bf16* VAL = GP + (size_t)MT * DFF; bf16* ACT = WSP(bf16, WS_GP) + (size_t)2 * MT * DFF;
    const float* CW = FIN(I_FCW) + (size_t)l * 3 * DFF; const float* CBI = FIN(I_FCB) + (size_t)l * DFF;
    constexpr int NRUN = PM / 16 + SB, NCG = DFF / 8;
    for (int it = F.bid * NTHR + F.tid; it < NRUN * NCG; it += F.G * NTHR) {
        const int run = it / NCG, cg = it % NCG, c = cg * 8;
        const bool isp = run < PM / 16; const size_t row0 = isp ? (size_t)run * 16 : (size_t)PM + (run - PM / 16) * 8; const int nt = isp ? 16 : 8;
        f32x4 p2a, p2b, p1a, p1b;
        if (isp) { if ((run & 255) == 0) { p2a = p2b = p1a = p1b = (f32x4){0.f, 0.f, 0.f, 0.f}; } else { unpack8(*(const v4u*)(GP + (row0 - 2) * DFF + c), p2a, p2b); unpack8(*(const v4u*)(GP + (row0 - 1) * DFF + c), p1a, p1b); } }
        else { const float* st = FIN(I_SFFN) + (((size_t)l * SB + (run - PM / 16)) * 2) * DFF + c; p2a = *(const f32x4*)st; p2b = *(const f32x4*)(st + 4); p1a = *(const f32x4*)(st + DFF); p1b = *(const f32x4*)(st + DFF + 4); }
        const f32x4 w0a = *(const f32x4*)(CW + c), w0b = *(const f32x4*)(CW + c + 4), w1a = *(const f32x4*)(CW + DFF + c), w1b = *(const f32x4*)(CW + DFF + c + 4), w2a = *(const f32x4*)(CW + 2 * DFF + c), w2b = *(const f32x4*)(CW + 2 * DFF + c + 4);
        const f32x4 ba = *(const f32x4*)(CBI + c), bb = *(const f32x4*)(CBI + c + 4);
        for (int t0 = 0; t0 < nt; t0 += 8) {
            v4u gx[8], vx[8];
#pragma unroll
            for (int k = 0; k < 8; ++k) { gx[k] = *(const v4u*)(GP + (row0 + t0 + k) * DFF + c); vx[k] = *(const v4u*)(VAL + (row0 + t0 + k) * DFF + c); }
#pragma unroll
            for (int k = 0; k < 8; ++k) {
                f32x4 xa, xb, va, vb; unpack8(gx[k], xa, xb); unpack8(vx[k], va, vb);
                f32x4 ya = ba + w0a * p2a + w1a * p1a + w2a * xa, yb = bb + w0b * p2b + w1b * p1b + w2b * xb;
#pragma unroll
                for (int i = 0; i < 4; ++i) { ya[i] = siluf_(ya[i]) * va[i]; yb[i] = siluf_(yb[i]) * vb[i]; }
                *(v4u*)(ACT + (row0 + t0 + k) * DFF + c) = pack8(ya, yb);
                p2a = p1a; p2b = p1b; p1a = xa; p1b = xb;
            }
        }
    }
}

constexpr int AT_RS = 144;
constexpr int AT_K0 = 0, AT_V0 = 2 * 64 * AT_RS, AT_PS = 4 * 64 * AT_RS, AT_IMP = AT_PS + 69632, AT_MASK = AT_IMP + 6144, AT_LIST = AT_MASK + 2048, AT_NL = AT_LIST + 1024;
constexpr unsigned AT_MARK = 0xFFFFu;
static_assert(AT_NL + 64 <= RING_BYTES, "attention LDS map");

struct TileRegs { v4u a, b, c, d; int mode; };

template <bool SMP> __device__ __forceinline__ void at_prefetch(const Frame& F, int l, int seq, int kvh, unsigned e, TileRegs& R) {
    const int kind = (int)(e >> 14), ti = (int)(e & 0x3fffu), rr = F.tid >> 3, pc = F.tid & 7;
    R.mode = 0;
    if (kind < 2) {
        const size_t rb = SMP ? (size_t)(seq * 2 + kvh) * 512 : (size_t)32768 + (size_t)(seq * 2 + kvh) * 256;
        const bf16* ck = WSP(bf16, WS_CK) + (rb + ti * 64 + rr) * 64 + pc * 8;
        R.a = *(const v4u*)ck; R.c = *(const v4u*)(ck + (size_t)CMP_ROWS_J * 64);
    } else if (!SMP) {
        const int jb = (kind == 2) ? 0 : 2;
        const bf16* kp = WSP(bf16, WS_KVB) + ((((size_t)jb * PB + seq) * 2 + kvh) * PT + ti * 64 + rr) * 64 + pc * 8;
        R.a = *(const v4u*)kp; R.c = *(const v4u*)(kp + (size_t)PB * 2 * PT * 64);
    } else if (kind == 2) {
        if (ti < 128) {
            const int page = ((const int*)F.a->in[I_PT])[seq * NPG + (ti >> 1)], slot = (ti & 1) * 64 + rr;
            const float* kp = FIN(I_CACHE) + (((((size_t)l * NPHYS + page) * PAGE + slot) * 4 + 2) * 2 + kvh) * 64 + pc * 8;
            R.a = *(const v4u*)kp; R.b = *(const v4u*)(kp + 4); R.c = *(const v4u*)(kp + 128); R.d = *(const v4u*)(kp + 132); R.mode = 1;
        } else if (rr < ST) {
            const bf16* kp = WSP(bf16, WS_KVS) + ((((size_t)0 * SB + seq) * 2 + kvh) * ST + rr) * 64 + pc * 8;
            R.a = *(const v4u*)kp; R.c = *(const v4u*)(kp + (size_t)SB * 2 * ST * 64);
        } else R.mode = 2;
    } else {
        if (ti < 8) {
            const float* kp = FIN(I_CWIN) + (((((size_t)l * SB + seq) * WINB + ti * 64 + rr) * 2 + 0) * 2 + kvh) * 64 + pc * 8;
            R.a = *(const v4u*)kp; R.b = *(const v4u*)(kp + 4); R.c = *(const v4u*)(kp + 128); R.d = *(const v4u*)(kp + 132); R.mode = 1;
        } else if (rr < ST) {
            const bf16* kp = WSP(bf16, WS_KVS) + ((((size_t)2 * SB + seq) * 2 + kvh) * ST + rr) * 64 + pc * 8;
            R.a = *(const v4u*)kp; R.c = *(const v4u*)(kp + (size_t)SB * 2 * ST * 64);
        } else R.mode = 2;
    }
}
__device__ __forceinline__ void at_store(const Frame& F, int buf, const TileRegs& R) {
    const int rr = F.tid >> 3, pc = F.tid & 7; v4u k, v;
    if (R.mode == 0) { k = R.a; v = R.c; }
    else if (R.mode == 1) { k = pack8(__builtin_bit_cast(f32x4, R.a), __builtin_bit_cast(f32x4, R.b)); v = pack8(__builtin_bit_cast(f32x4, R.c), __builtin_bit_cast(f32x4, R.d)); }
    else { k = (v4u){0u, 0u, 0u, 0u}; v = k; }
    *(LAS v4u*)(F.lds + AT_K0 + buf * 64 * AT_RS + rr * AT_RS + pc * 16) = k;
    *(LAS v4u*)(F.lds + AT_V0 + buf * 64 * AT_RS + rr * AT_RS + pc * 16) = v;
}

template <bool SMP> __device__ __forceinline__ void attn_unit(Frame& F, int l, int unit) {
    const int tid = F.tid, lane = F.lane, w = F.wave;
    const int q = lane & 31, h_ = lane >> 5, blk = (lane >> 4) & 1, tl = q >> 2, hr = q & 3;
    int seq, kvh, qt;
    if (SMP) { seq = unit >> 1; kvh = unit & 1; qt = 128; } else { seq = unit >> 7; kvh = (unit >> 6) & 1; qt = unit & 63; }
    const int t0 = SMP ? PAST : qt * 64;
    const int tokl = SMP ? tl : 8 * w + tl, t = t0 + tokl;
    const size_t row = SMP ? (size_t)PM + seq * ST + tl : (size_t)seq * PT + t;
    const int head = kvh * 4 + hr;
    LAS float* PS = (LAS float*)(F.lds + AT_PS); LAS float* IMPw = (LAS float*)(F.lds + AT_IMP) + w * 192;
    LAS unsigned long long* MASKS = (LAS unsigned long long*)(F.lds + AT_MASK); LAS unsigned short* LIST = (LAS unsigned short*)(F.lds + AT_LIST); LAS int* NL = (LAS int*)(F.lds + AT_NL);
    constexpr int PSS = SMP ? 520 : 264;
    LAS float* PSw = SMP ? PS : PS + w * 8 * PSS;
    __syncthreads();
    bf16x8 qf[4];
    { const bf16* qp = WSP(bf16, WS_QN) + row * 512 + head * 64 + 8 * h_;
#pragma unroll
      for (int kk = 0; kk < 4; ++kk) qf[kk] = *(const bf16x8*)(qp + 16 * kk); }
    const float* ngp = WSP(float, WS_NG) + row * 24 + head * 3; const float g0 = ngp[0], g1 = ngp[1], g2 = ngp[2];
    if (!SMP) { for (int i = lane; i < 8 * PSS; i += 64) PSw[i] = 0.f; }
    const int ntc = SMP ? 8 : ((t0 + 32) >> 10) + 1;
    if (tid < 2 * ntc) LIST[tid] = (unsigned short)(((tid >= ntc ? 1u : 0u) << 14) | (unsigned)(tid >= ntc ? tid - ntc : tid));
    if (tid == 0) LIST[2 * ntc] = (unsigned short)AT_MARK;
    int nl = 2 * ntc + 1;
    TileRegs R;
    at_prefetch<SMP>(F, l, seq, kvh, (unsigned)0, R);
    at_store(F, 0, R);
    __syncthreads();
    float m = -INFINITY, lsum = 0.f, invden = 0.f;
    f32x16 O[2]; O[0] = (f32x16){}; O[1] = (f32x16){};
    LAS float* OAw = (LAS float*)(F.lds + AT_PS) + w * (SMP ? 2048 : 8 * PSS) + lane;
    unsigned long long mk0 = 0ull, mk1 = 0ull, wu = ~0ull;
    int cur_kind = -1, idx = 0;
#define AT_FINALIZE(kind) do { \
        if ((kind) == 0) { const float lt = lsum + __shfl_xor(lsum, 32); invden = lt > 0.f ? 1.0f / lt : 0.f; } \
        else if ((kind) == 1) { const float sc = g0 * invden; O[0] *= sc; O[1] *= sc; } \
        else if ((kind) == 2) { const float lt = lsum + __shfl_xor(lsum, 32); const float sc = (lt > 0.f ? 1.0f / lt : 0.f) * g1; \
            _Pragma("unroll") for (int r_ = 0; r_ < 16; ++r_) { OAw[r_ * 64] += O[0][r_] * sc; OAw[(16 + r_) * 64] += O[1][r_] * sc; } } } while (0)
    while (idx < nl) {
        const unsigned e = (unsigned)__builtin_amdgcn_readfirstlane((int)LIST[idx]);
        if (e == AT_MARK) {
            AT_FINALIZE(cur_kind); cur_kind = -1;
            LDS_WAIT(); asm volatile("" ::: "memory");
#pragma unroll 1
            for (int tk = 0; tk < 8; ++tk) {
                const LAS float* pr = PSw + tk * PSS;
                if (!SMP) {
                    const int s = lane; float imp = 0.f;
#pragma unroll
                    for (int n = 4 * s - 1; n <= 4 * s + 3; ++n) if (n >= 0) imp += pr[n];
                    const bool forced = (s == 0) || (s == qt) || (s == qt - 1), avail = s <= qt;
                    const float val = avail ? (forced ? 1e4f : imp) : -1e4f;
                    IMPw[s] = val; LDS_WAIT(); asm volatile("" ::: "memory");
                    int rank = 0;
#pragma unroll 8
                    for (int i = 0; i < 64; ++i) { const float v = IMPw[i]; rank += (v > val || (v == val && i < s)) ? 1 : 0; }
                    const unsigned long long mk = __ballot(rank < 16);
                    if (lane == 0) MASKS[(8 * w + tk) * 4] = mk;
                    LDS_WAIT(); asm volatile("" ::: "memory");
                } else {
                    const int sa = lane, sb = lane + 64; float ia = 0.f, ib = 0.f;
#pragma unroll
                    for (int n = 4 * sa - 1; n <= 4 * sa + 3; ++n) if (n >= 0) ia += pr[n];
#pragma unroll
                    for (int n = 4 * sb - 1; n <= 4 * sb + 3; ++n) ib += pr[n];
                    const bool fa = (sa == 0), fb = (sb == 127);
                    const float va = fa ? 1e4f : ia, vb = fb ? 1e4f : ib;
                    IMPw[sa] = va; IMPw[sb] = vb; LDS_WAIT(); asm volatile("" ::: "memory");
                    int ra = fa ? 0 : 1, rb = fb ? 0 : 1;
#pragma unroll 8
                    for (int i = 0; i < 128; ++i) { const float v = IMPw[i]; ra += (v > va || (v == va && i < sa)) ? 1 : 0; rb += (v > vb || (v == vb && i < sb)) ? 1 : 0; }
                    const unsigned long long ma = __ballot(ra < 16), mb = __ballot(rb < 16);
                    if (lane == 0) { MASKS[tk * 4] = ma; MASKS[tk * 4 + 1] = mb; MASKS[tk * 4 + 2] = 1ull; }
                    LDS_WAIT(); asm volatile("" ::: "memory");
                }
            }
            __syncthreads();
#pragma unroll
            for (int r_ = 0; r_ < 16; ++r_) { OAw[r_ * 64] = O[0][r_]; OAw[(16 + r_) * 64] = O[1][r_]; }
            if (tid == 0) {
                int n = idx + 1;
                if (!SMP) { unsigned long long U = 0ull; for (int i = 0; i < 64; ++i) U |= MASKS[i * 4];
                    for (int s = 0; s <= qt; ++s) if ((U >> s) & 1ull) LIST[n++] = (unsigned short)((2u << 14) | (unsigned)s);
                    for (int s = (qt > 8 ? qt - 8 : 0); s <= qt; ++s) LIST[n++] = (unsigned short)((3u << 14) | (unsigned)s);
                } else { unsigned long long U0 = 0ull, U1 = 0ull; for (int i = 0; i < 8; ++i) { U0 |= MASKS[i * 4]; U1 |= MASKS[i * 4 + 1]; }
                    for (int s = 0; s < 64; ++s) if ((U0 >> s) & 1ull) LIST[n++] = (unsigned short)((2u << 14) | (unsigned)s);
                    for (int s = 0; s < 64; ++s) if ((U1 >> s) & 1ull) LIST[n++] = (unsigned short)((2u << 14) | (unsigned)(64 + s));
                    LIST[n++] = (unsigned short)((2u << 14) | 128u);
                    for (int s = 0; s <= 8; ++s) LIST[n++] = (unsigned short)((3u << 14) | (unsigned)s); }
                NL[0] = n;
            }
            __syncthreads();
            nl = __builtin_amdgcn_readfirstlane(NL[0]);
            mk0 = MASKS[tokl * 4]; if (SMP) { mk1 = MASKS[tokl * 4 + 1]; }
            if (!SMP) { unsigned long long u = 0ull; for (int i = 0; i < 8; ++i) u |= MASKS[(8 * w + i) * 4]; wu = u; }
            if (idx + 1 < nl) { at_prefetch<SMP>(F, l, seq, kvh, (unsigned)LIST[idx + 1], R); at_store(F, (idx + 1) & 1, R); }
            __syncthreads();
            ++idx; continue;
        }
        const int kind = (int)(e >> 14), ti = (int)(e & 0x3fffu);
        if (kind != cur_kind) {
            if (cur_kind >= 0) AT_FINALIZE(cur_kind);
            if (kind != 1) m = -INFINITY;
            lsum = 0.f; O[0] = (f32x16){}; O[1] = (f32x16){}; cur_kind = kind;
        }
        const unsigned en = (idx + 1 < nl) ? (unsigned)__builtin_amdgcn_readfirstlane((int)LIST[idx + 1]) : AT_MARK;
        const bool have_next = (en != AT_MARK);
        if (have_next) at_prefetch<SMP>(F, l, seq, kvh, en, R);
        bool active = true;
        if (!SMP && kind == 2) active = ((wu >> ti) & 1ull) != 0ull;
        if (active) {
            const LAS unsigned char* Kb = F.lds + AT_K0 + (idx & 1) * 64 * AT_RS; const LAS unsigned char* Vb = F.lds + AT_V0 + (idx & 1) * 64 * AT_RS;
            int lo, hi; const int kb = 64 * ti;
            if (kind < 2) { lo = 0; hi = SMP ? 510 : ((t >= 31) ? ((t - 31) >> 4) : -1); }
            else if (kind == 2) { lo = 0; const unsigned long long mw = (ti < 64) ? mk0 : ((ti < 128) ? mk1 : 1ull); hi = ((mw >> (ti & 63)) & 1ull) ? t : -1; }
            else { if (SMP) { lo = tl; hi = WINB + tl; } else { lo = t - WINB; hi = t; } }
            f32x16 s0 = (f32x16){}, s1 = (f32x16){};
#pragma unroll
            for (int kk = 0; kk < 4; ++kk) {
                const bf16x8 k0 = *(const LAS bf16x8*)(Kb + q * AT_RS + (16 * kk + 8 * h_) * 2), k1 = *(const LAS bf16x8*)(Kb + (32 + q) * AT_RS + (16 * kk + 8 * h_) * 2);
                s0 = mfma32(k0, qf[kk], s0); s1 = mfma32(k1, qf[kk], s1);
            }
            float tmax = -INFINITY;
#pragma unroll
            for (int r = 0; r < 16; ++r) { const int key = kb + (r & 3) + 8 * (r >> 2) + 4 * h_;
                s0[r] = (key >= lo && key <= hi) ? s0[r] : -INFINITY; s1[r] = (key + 32 >= lo && key + 32 <= hi) ? s1[r] : -INFINITY;
                tmax = fmaxf(tmax, fmaxf(s0[r], s1[r])); }
            tmax = fmaxf(tmax, __shfl_xor(tmax, 32));
            const float m_new = fmaxf(m, tmax), m_use = (m_new == -INFINITY) ? 0.f : m_new;
            const float alpha = fexp2(m - m_use);
            float ps = 0.f;
#pragma unroll
            for (int r = 0; r < 16; ++r) { s0[r] = fexp2(s0[r] - m_use); s1[r] = fexp2(s1[r] - m_use); ps += s0[r] + s1[r]; }
            lsum = lsum * alpha + ps; m = m_new;
            if (kind != 0) {
                O[0] *= alpha; O[1] *= alpha;
#pragma unroll
                for (int kt2 = 0; kt2 < 2; ++kt2)
#pragma unroll
                    for (int s2 = 0; s2 < 2; ++s2) { const bf16x8 pf = cvt_frag(kt2 ? s1 : s0, s2); const int rA = 32 * kt2 + 16 * s2 + 4 * h_;
#pragma unroll
                        for (int dt = 0; dt < 2; ++dt) { const bf16x8 vf = tr_frag(Vb, AT_RS, rA, rA + 8, 32 * dt + 16 * blk, lane); O[dt] = mfma32(vf, pf, O[dt]); } }
            }
            if (kind == 1) {
#pragma unroll
                for (int r = 0; r < 16; ++r) { const int n = kb + (r & 3) + 8 * (r >> 2) + 4 * h_;
                    float a = s0[r] * invden, b = s1[r] * invden; a += __shfl_xor(a, 1); b += __shfl_xor(b, 1); a += __shfl_xor(a, 2); b += __shfl_xor(b, 2);
                    if (hr == 0) { PSw[tl * PSS + n] = a; PSw[tl * PSS + n + 32] = b; } }
            }
        }
        if (have_next) at_store(F, (idx + 1) & 1, R);
        __syncthreads();
        ++idx;
    }
#undef AT_FINALIZE
    {
        const float lt = lsum + __shfl_xor(lsum, 32); const float sc = (lt > 0.f ? 1.0f / lt : 0.f) * g2;
        if (!SMP || w == 0) {
            bf16* op = WSP(bf16, WS_OA) + row * 512 + head * 64;
#pragma unroll
            for (int dt = 0; dt < 2; ++dt)
#pragma unroll
                for (int r4 = 0; r4 < 4; ++r4) { float o_[4];
#pragma unroll
                    for (int x = 0; x < 4; ++x) o_[x] = OAw[(dt * 16 + 4 * r4 + x) * 64] + O[dt][4 * r4 + x] * sc;
                    v2u wv; wv.x = pk2(o_[0], o_[1]); wv.y = pk2(o_[2], o_[3]); *(v2u*)(op + 32 * dt + 8 * r4 + 4 * h_) = wv; }
        }
    }
}

constexpr int AS_RS = 144;
constexpr int AS_V = 0, AS_VW = 32 * AS_RS, AS_MRG = 0, AS_PS = 73728, AS_IMP = AS_PS + 16640, AS_MASK = AS_IMP + 6144;
static_assert(8 * 34 * 64 * 4 <= AS_PS && AS_MASK + 512 <= RING_BYTES, "sample attention LDS map");

__device__ __forceinline__ float xhalf_max(float x) { auto t_ = __builtin_amdgcn_permlane32_swap(__float_as_uint(x), __float_as_uint(x), false, false); return fmaxf(__uint_as_float(t_[0]), __uint_as_float(t_[1])); }
__device__ __forceinline__ float xhalf_sum(float x) { auto t_ = __builtin_amdgcn_permlane32_swap(__float_as_uint(x), __float_as_uint(x), false, false); return __uint_as_float(t_[0]) + __uint_as_float(t_[1]); }
struct ASrc { const float* kf; const float* vf; const bf16* kb; const bf16* vb; int rs; int nvalid; };
#define AS_TILE(SRC, KB0, LO_, HI_, DO_PV, DO_PS, m, lsum, O0, O1, invden, PSS_) do { \
        bf16x8 kfr[4]; \
        if ((SRC).kb) { const bf16* kp_ = (SRC).kb + (size_t)q * (SRC).rs + 8 * h_; _Pragma("unroll") for (int kk = 0; kk < 4; ++kk) kfr[kk] = *(const bf16x8*)(kp_ + 16 * kk); } \
        else { const float* kp_ = (SRC).kf + (size_t)q * (SRC).rs + 8 * h_; _Pragma("unroll") for (int kk = 0; kk < 4; ++kk) { const f32x4 a_ = *(const f32x4*)(kp_ + 16 * kk), b_ = *(const f32x4*)(kp_ + 16 * kk + 4); kfr[kk] = __builtin_bit_cast(bf16x8, pack8(a_, b_)); } } \
        if (DO_PV) { const int vr_ = lane >> 1, vh_ = lane & 1; v4u vv_[4]; \
            if (vr_ >= (SRC).nvalid) { _Pragma("unroll") for (int x = 0; x < 4; ++x) vv_[x] = (v4u){0u, 0u, 0u, 0u}; } \
            else if ((SRC).vb) { const bf16* vp_ = (SRC).vb + (size_t)vr_ * (SRC).rs + 32 * vh_; _Pragma("unroll") for (int x = 0; x < 4; ++x) vv_[x] = *(const v4u*)(vp_ + 8 * x); } \
            else { const float* vp_ = (SRC).vf + (size_t)vr_ * (SRC).rs + 32 * vh_; _Pragma("unroll") for (int x = 0; x < 4; ++x) vv_[x] = pack8(*(const f32x4*)(vp_ + 8 * x), *(const f32x4*)(vp_ + 8 * x + 4)); } \
            _Pragma("unroll") for (int x = 0; x < 4; ++x) *(LAS v4u*)(Vw + vr_ * AS_RS + vh_ * 64 + x * 16) = vv_[x]; } \
        f32x16 s_ = (f32x16){}; \
        _Pragma("unroll") for (int kk = 0; kk < 4; ++kk) s_ = mfma32(kfr[kk], qf[kk], s_); \
        float tmax_ = -INFINITY; \
        _Pragma("unroll") for (int r = 0; r < 16; ++r) { const int key_ = (KB0) + (r & 3) + 8 * (r >> 2) + 4 * h_; s_[r] = (key_ >= (LO_) && key_ <= (HI_)) ? s_[r] : -INFINITY; tmax_ = fmaxf(tmax_, s_[r]); } \
        tmax_ = xhalf_max(tmax_); \
        const float mn_ = fmaxf(m, tmax_), mu_ = (mn_ == -INFINITY) ? 0.f : mn_, al_ = fexp2(m - mu_); float ps_ = 0.f; \
        _Pragma("unroll") for (int r = 0; r < 16; ++r) { s_[r] = fexp2(s_[r] - mu_); ps_ += s_[r]; } \
        lsum = lsum * al_ + ps_; m = mn_; \
        if (DO_PV) { O0 *= al_; O1 *= al_; LDS_WAIT(); asm volatile("" ::: "memory"); \
            _Pragma("unroll") for (int s2 = 0; s2 < 2; ++s2) { const bf16x8 pf_ = cvt_frag(s_, s2); const int rA_ = 16 * s2 + 4 * h_; \
                O0 = mfma32(tr_frag(Vw, AS_RS, rA_, rA_ + 8, 16 * blk, lane), pf_, O0); O1 = mfma32(tr_frag(Vw, AS_RS, rA_, rA_ + 8, 32 + 16 * blk, lane), pf_, O1); } \
            LDS_WAIT(); asm volatile("" ::: "memory"); } \
        if (DO_PS) { _Pragma("unroll") for (int r = 0; r < 16; ++r) { const int n_ = (KB0) + (r & 3) + 8 * (r >> 2) + 4 * h_; float a_ = s_[r] * (invden); a_ += __shfl_xor(a_, 1); a_ += __shfl_xor(a_, 2); if (hr == 0) PS[tl * (PSS_) + n_] = a_; } } \
    } while (0)

__device__ __forceinline__ void attn_sample_unit(Frame& F, int l, int unit) {
    const int lane = F.lane, w = F.wave, tid = F.tid;
    const int q = lane & 31, h_ = lane >> 5, blk = (lane >> 4) & 1, tl = q >> 2, hr = q & 3;
    const int seq = unit >> 1, kvh = unit & 1, head = kvh * 4 + hr;
    const size_t row = (size_t)PM + seq * ST + tl;
    LAS unsigned char* Vw = F.lds + AS_V + w * AS_VW;
    LAS float* MRG = (LAS float*)(F.lds + AS_MRG);
    LAS float* PS = (LAS float*)(F.lds + AS_PS);
    LAS float* IMPw = (LAS float*)(F.lds + AS_IMP) + w * 192;
    LAS unsigned long long* MASKS = (LAS unsigned long long*)(F.lds + AS_MASK);
    __syncthreads();
    bf16x8 qf[4];
    { const bf16* qp = WSP(bf16, WS_QN) + row * 512 + head * 64 + 8 * h_;
#pragma unroll
      for (int kk = 0; kk < 4; ++kk) qf[kk] = *(const bf16x8*)(qp + 16 * kk); }
    const float* ngp = WSP(float, WS_NG) + row * 24 + head * 3; const float g0 = ngp[0], g1 = ngp[1], g2 = ngp[2];
    const int* ptab = (const int*)F.a->in[I_PT] + seq * NPG;
    f32x16 OA0 = (f32x16){}, OA1 = (f32x16){};

#define AS_PUBLISH(m, lsum, O0, O1) do { __syncthreads(); LAS float* mp_ = MRG + w * 34 * 64 + lane; mp_[0] = m; mp_[64] = lsum; \
        _Pragma("unroll") for (int r = 0; r < 16; ++r) { mp_[(2 + r) * 64] = O0[r]; mp_[(18 + r) * 64] = O1[r]; } __syncthreads(); } while (0)

    const bf16* CKk = WSP(bf16, WS_CK) + ((size_t)(seq * 2 + kvh) * 512) * 64; const bf16* CKv = CKk + (size_t)CMP_ROWS_J * 64;
    float mC = -INFINITY, lC = 0.f; f32x16 D0 = (f32x16){}, D1 = (f32x16){};
#pragma unroll 1
    for (int ti = w; ti < 16; ti += 8) { ASrc S{nullptr, nullptr, CKk + (size_t)ti * 32 * 64, CKv + (size_t)ti * 32 * 64, 64, 32}; AS_TILE(S, ti * 32, 0, 510, false, false, mC, lC, D0, D1, 0.f, 520); }
    { __syncthreads(); MRG[w * 128 + lane] = mC; MRG[w * 128 + 64 + lane] = xhalf_sum(lC); __syncthreads(); }
    float mT = -INFINITY;
#pragma unroll
    for (int x = 0; x < 8; ++x) mT = fmaxf(mT, MRG[x * 128 + lane]);
    float lT = 0.f;
#pragma unroll
    for (int x = 0; x < 8; ++x) { const float mx_ = MRG[x * 128 + lane]; lT += (mx_ == -INFINITY) ? 0.f : MRG[x * 128 + 64 + lane] * fexp2(mx_ - mT); }
    const float invC = lT > 0.f ? 1.0f / lT : 0.f;
    __syncthreads();
    { float mB = mT, lB = 0.f;
#pragma unroll 1
      for (int ti = w; ti < 16; ti += 8) { ASrc S{nullptr, nullptr, CKk + (size_t)ti * 32 * 64, CKv + (size_t)ti * 32 * 64, 64, 32}; AS_TILE(S, ti * 32, 0, 510, true, true, mB, lB, D0, D1, invC, 520); }
      AS_PUBLISH(mB, lB, D0, D1); }
    { const float sc = g0 * invC;
#pragma unroll 1
      for (int x = 0; x < 8; ++x) { const LAS float* mp = MRG + x * 34 * 64 + lane;
#pragma unroll
          for (int r = 0; r < 16; ++r) { OA0[r] += mp[(2 + r) * 64] * sc; OA1[r] += mp[(18 + r) * 64] * sc; } } }
    {
        const LAS float* pr = PS + w * 520; const int sa = lane, sb = lane + 64; float ia = 0.f, ib = 0.f;
#pragma unroll
        for (int n = 4 * sa - 1; n <= 4 * sa + 3; ++n) if (n >= 0) ia += pr[n];
#pragma unroll
        for (int n = 4 * sb - 1; n <= 4 * sb + 3; ++n) ib += pr[n];
        const bool fa = (sa == 0), fb = (sb == 127); const float va = fa ? 1e4f : ia, vb = fb ? 1e4f : ib;
        IMPw[sa] = va; IMPw[sb] = vb; LDS_WAIT(); asm volatile("" ::: "memory");
        int ra = fa ? 0 : 1, rb = fb ? 0 : 1;
#pragma unroll 8
        for (int i = 0; i < 128; ++i) { const float v = IMPw[i]; ra += (v > va || (v == va && i < sa)) ? 1 : 0; rb += (v > vb || (v == vb && i < sb)) ? 1 : 0; }
        const unsigned long long ma = __ballot(ra < 16), mb = __ballot(rb < 16);
        if (lane == 0) { MASKS[w * 4] = ma; MASKS[w * 4 + 1] = mb; }
    }
    __syncthreads();
    const unsigned long long mk0 = MASKS[tl * 4], mk1 = MASKS[tl * 4 + 1];
    unsigned long long U0 = 0ull, U1 = 0ull;
#pragma unroll
    for (int x = 0; x < 8; ++x) { U0 |= MASKS[x * 4]; U1 |= MASKS[x * 4 + 1]; }
    {
        float m = -INFINITY, ls = 0.f; D0 = (f32x16){}; D1 = (f32x16){};
        const int t = PAST + tl; int cnt = 0;
#pragma unroll 1
        for (int s = 0; s <= 128; ++s) {
            const bool in_u = (s < 64) ? ((U0 >> s) & 1ull) : ((s < 128) ? ((U1 >> (s - 64)) & 1ull) : true);
            if (!in_u) continue;
            const bool selb = (s < 64) ? ((mk0 >> s) & 1ull) : ((s < 128) ? ((mk1 >> (s - 64)) & 1ull) : true);
            const int nh = (s < 128) ? 2 : 1;
            for (int hf = 0; hf < nh; ++hf, ++cnt) {
                if ((cnt & 7) != w) continue;
                const int hi = selb ? t : -1;
                if (s < 128) { const int page = ptab[s >> 1], slot = (s & 1) * 64 + hf * 32;
                    const float* kp = FIN(I_CACHE) + (((((size_t)l * NPHYS + page) * PAGE + slot) * 4 + 2) * 2 + kvh) * 64;
                    ASrc S{kp, kp + 128, nullptr, nullptr, 512, 32}; AS_TILE(S, s * 64 + hf * 32, 0, hi, true, false, m, ls, D0, D1, 0.f, 520); }
                else { const bf16* kp = WSP(bf16, WS_KVS) + ((((size_t)0 * SB + seq) * 2 + kvh) * ST) * 64;
                    ASrc S{nullptr, nullptr, kp, kp + (size_t)SB * 2 * ST * 64, 64, ST}; AS_TILE(S, PAST, 0, hi, true, false, m, ls, D0, D1, 0.f, 520); }
            }
        }
        AS_PUBLISH(m, ls, D0, D1);
        float mt = -INFINITY;
#pragma unroll
        for (int x = 0; x < 8; ++x) mt = fmaxf(mt, MRG[x * 34 * 64 + lane]);
        float lt = 0.f; f32x16 T0 = (f32x16){}, T1 = (f32x16){};
#pragma unroll 1
        for (int x = 0; x < 8; ++x) { const LAS float* mp = MRG + x * 34 * 64 + lane; const float mx_ = mp[0]; const float f = (mx_ == -INFINITY) ? 0.f : fexp2(mx_ - mt); lt += mp[64] * f;
#pragma unroll
            for (int r = 0; r < 16; ++r) { T0[r] += mp[(2 + r) * 64] * f; T1[r] += mp[(18 + r) * 64] * f; } }
        lt = xhalf_sum(lt); const float sc = (lt > 0.f ? 1.0f / lt : 0.f) * g1; OA0 += T0 * sc; OA1 += T1 * sc;
    }
    {
        float m = -INFINITY, ls = 0.f; D0 = (f32x16){}; D1 = (f32x16){};
#pragma unroll 1
        for (int ti = w; ti < 17; ti += 8) {
            if (ti < 16) { const float* kp = FIN(I_CWIN) + (((((size_t)l * SB + seq) * WINB + ti * 32) * 2 + 0) * 2 + kvh) * 64;
                ASrc S{kp, kp + 128, nullptr, nullptr, 256, 32}; AS_TILE(S, ti * 32, tl, WINB + tl, true, false, m, ls, D0, D1, 0.f, 520); }
            else { const bf16* kp = WSP(bf16, WS_KVS) + ((((size_t)2 * SB + seq) * 2 + kvh) * ST) * 64;
                ASrc S{nullptr, nullptr, kp, kp + (size_t)SB * 2 * ST * 64, 64, ST}; AS_TILE(S, WINB, tl, WINB + tl, true, false, m, ls, D0, D1, 0.f, 520); }
        }
        AS_PUBLISH(m, ls, D0, D1);
        float mt = -INFINITY;
#pragma unroll
        for (int x = 0; x < 8; ++x) mt = fmaxf(mt, MRG[x * 34 * 64 + lane]);
        float lt = 0.f; f32x16 T0 = (f32x16){}, T1 = (f32x16){};
#pragma unroll 1
        for (int x = 0; x < 8; ++x) { const LAS float* mp = MRG + x * 34 * 64 + lane; const float mx_ = mp[0]; const float f = (mx_ == -INFINITY) ? 0.f : fexp2(mx_ - mt); lt += mp[64] * f;
#pragma unroll
            for (int r = 0; r < 16; ++r) { T0[r] += mp[(2 + r) * 64] * f; T1[r] += mp[(18 + r) * 64] * f; } }
        lt = xhalf_sum(lt); const float sc = (lt > 0.f ? 1.0f / lt : 0.f) * g2; OA0 += T0 * sc; OA1 += T1 * sc;
    }
#undef AS_PUBLISH
    if (w == 0) {
        bf16* op = WSP(bf16, WS_OA) + row * 512 + head * 64;
#pragma unroll
        for (int r4 = 0; r4 < 4; ++r4) { v2u a, b; a.x = pk2(OA0[4 * r4 + 0], OA0[4 * r4 + 1]); a.y = pk2(OA0[4 * r4 + 2], OA0[4 * r4 + 3]); b.x = pk2(OA1[4 * r4 + 0], OA1[4 * r4 + 1]); b.y = pk2(OA1[4 * r4 + 2], OA1[4 * r4 + 3]);
            *(v2u*)(op + 8 * r4 + 4 * h_) = a; *(v2u*)(op + 32 + 8 * r4 + 4 * h_) = b; }
    }
}

#ifndef DBG_DUP
#define DBG_DUP 0
#endif
#if DBG_DUP == 1
#define AP_DUP_QK(NK) { f32x16 d_ = (f32x16){}; _Pragma("unroll") for (int kk = 0; kk < 4; ++kk) d_ = mfma32(NK[kk], qf[(kk + 1) & 3], d_); _Pragma("unroll") for (int r = 0; r < 16; ++r) s_[r] += zf * d_[r]; }
#else
#define AP_DUP_QK(NK)
#endif
#if DBG_DUP == 2
#define AP_DUP_EXP() { float acc_ = 0.f; _Pragma("unroll") for (int r = 0; r < 16; ++r) acc_ += fexp2(s_[r] * 0.5f - 3.0f); lsum += zf * acc_; }
#else
#define AP_DUP_EXP()
#endif
#if DBG_DUP == 3
#define AP_DUP_PV() { f32x16 e0_ = (f32x16){}, e1_ = (f32x16){}; _Pragma("unroll") for (int s2 = 0; s2 < 2; ++s2) { const bf16x8 pf_ = cvt_frag(s_, 1 - s2); const int rA_ = 16 * s2 + 4 * h_; \
        e0_ = mfma32(tr_frag(Vw, AS_RS, rA_ + 8, rA_, 16 * blk, lane), pf_, e0_); e1_ = mfma32(tr_frag(Vw, AS_RS, rA_ + 8, rA_, 32 + 16 * blk, lane), pf_, e1_); } D0 += e0_ * zf; D1 += e1_ * zf; }
#else
#define AP_DUP_PV()
#endif
constexpr int AP_WS = 14336, AP_V = 0, AP_PS = 4608, AP_IMP = AP_PS + 8 * 264 * 4, AP_MASK = AP_IMP + 256, AP_LIST = AP_MASK + 64;
static_assert(AP_LIST + 2 * 192 <= AP_WS && 8 * AP_WS <= RING_BYTES, "prompt attention LDS map");
__device__ __forceinline__ void attn_prompt_unit(Frame& F, int l, int unit) {
    const int lane = F.lane, w = F.wave;
    const int q = lane & 31, h_ = lane >> 5, blk = (lane >> 4) & 1, tl = q >> 2, hr = q & 3;
    const int seq = unit >> 7, kvh = (unit >> 6) & 1, qt = unit & 63, head = kvh * 4 + hr;
    const int t0w = qt * 64 + 8 * w, t = t0w + tl; const size_t row = (size_t)seq * PT + t;
    LAS unsigned char* Vw = F.lds + w * AP_WS + AP_V; LAS float* PS = (LAS float*)(F.lds + w * AP_WS + AP_PS); LAS float* IMPw = (LAS float*)(F.lds + w * AP_WS + AP_IMP);
    LAS unsigned long long* MASKS = (LAS unsigned long long*)(F.lds + w * AP_WS + AP_MASK); LAS unsigned short* LIST = (LAS unsigned short*)(F.lds + w * AP_WS + AP_LIST);
    __syncthreads();
    bf16x8 qf[4];
    { const bf16* qp = WSP(bf16, WS_QN) + row * 512 + head * 64 + 8 * h_;
#pragma unroll
      for (int kk = 0; kk < 4; ++kk) qf[kk] = *(const bf16x8*)(qp + 16 * kk); }
    const float* ngp = WSP(float, WS_NG) + row * 24 + head * 3; const float g0 = ngp[0], g1 = ngp[1], g2 = ngp[2];
    for (int i = lane; i < 8 * 264; i += 64) PS[i] = 0.f;
    const bf16* CKk = WSP(bf16, WS_CK) + ((size_t)32768 + (seq * 2 + kvh) * 256) * 64; const bf16* CKv = CKk + (size_t)CMP_ROWS_J * 64;
    const bf16* KS = WSP(bf16, WS_KVB) + ((((size_t)0 * PB + seq) * 2 + kvh) * PT) * 64; const bf16* VS = KS + (size_t)PB * 2 * PT * 64;
    const bf16* KW = KS + (size_t)2 * PB * 2 * PT * 64; const bf16* VW = KW + (size_t)PB * 2 * PT * 64;
    const int hiCmin = (t0w >= 31) ? ((t0w - 31) >> 4) : -1;
    const int hiC = (t >= 31) ? ((t - 31) >> 4) : -1; const int nmaxw = (t0w + 7 >= 31) ? ((t0w + 7 - 31) >> 4) : -1; const int ntc = (nmaxw >= 0) ? (nmaxw >> 5) + 1 : 0;
    f32x16 D0 = (f32x16){}, D1 = (f32x16){};
    LAS float* OAG = PS + lane;
    float m = -INFINITY, lsum = 0.f, invC = 0.f; unsigned long long mk0 = 0ull;
    const float zf = (F.G == 12345) ? 1.0f : 0.0f;
    bf16x8 nk0[4], nk1[4]; v4u nv0[4], nv1[4];
#define AP_LOADT(e_, NK, NV) do { const int kd_ = (int)((e_) >> 12), ti_ = (int)((e_) & 0xfffu); const bf16* kb_ = (kd_ < 2 ? CKk : (kd_ == 2 ? KS : KW)) + (size_t)ti_ * 32 * 64; const bf16* vb_ = (kd_ < 2 ? CKv : (kd_ == 2 ? VS : VW)) + (size_t)ti_ * 32 * 64; \
        _Pragma("unroll") for (int kk = 0; kk < 4; ++kk) NK[kk] = *(const bf16x8*)(kb_ + (size_t)q * 64 + 8 * h_ + 16 * kk); \
        _Pragma("unroll") for (int x = 0; x < 4; ++x) NV[x] = *(const v4u*)(vb_ + (size_t)(lane >> 1) * 64 + 32 * (lane & 1) + 8 * x); } while (0)
#define AP_STEP(i_, n_, NK, NV) do { \
        const unsigned e_ = (unsigned)__builtin_amdgcn_readfirstlane((int)LIST[i_]); const int kind = (int)(e_ >> 12), ti = (int)(e_ & 0xfffu); \
        if (kind != 0) { _Pragma("unroll") for (int x = 0; x < 4; ++x) *(LAS v4u*)(Vw + (lane >> 1) * AS_RS + (lane & 1) * 64 + x * 16) = NV[x]; } \
        f32x16 s_ = (f32x16){}; \
        _Pragma("unroll") for (int kk = 0; kk < 4; ++kk) s_ = mfma32(NK[kk], qf[kk], s_); \
        AP_DUP_QK(NK) \
        if ((i_) + 2 < (n_)) { const unsigned en_ = (unsigned)__builtin_amdgcn_readfirstlane((int)LIST[(i_) + 2]); AP_LOADT(en_, NK, NV); } \
        if (kind != cur_kind) { \
            if (cur_kind == 0) { const float lt_ = xhalf_sum(lsum); invC = lt_ > 0.f ? 1.0f / lt_ : 0.f; } \
            else if (cur_kind == 2) { const float lt_ = xhalf_sum(lsum); const float sc_ = (lt_ > 0.f ? 1.0f / lt_ : 0.f) * g1; \
                _Pragma("unroll") for (int r = 0; r < 16; ++r) { OAG[r * 64] += D0[r] * sc_; OAG[(16 + r) * 64] += D1[r] * sc_; } } \
            if (kind != 1) m = -INFINITY; lsum = 0.f; D0 = (f32x16){}; D1 = (f32x16){}; cur_kind = kind; } \
        const int kb = ti * 32; int lo, hi; \
        if (kind < 2) { lo = 0; hi = hiC; } else if (kind == 2) { lo = 0; hi = ((mk0 >> (ti >> 1)) & 1ull) ? t : -1; } else { lo = t - WINB; hi = t; } \
          \
        const bool interior = (kind < 2) ? (hiCmin >= 0 && kb + 31 <= hiCmin) : ((kind == 2) ? (kb + 31 <= t0w) : (kb >= t0w + 7 - WINB && kb + 31 <= t0w)); \
        float tmax_ = -INFINITY, mu_, mn_; \
        if (interior) { const bool on_ = hi >= 0; \
            _Pragma("unroll") for (int r = 0; r < 16; ++r) tmax_ = fmaxf(tmax_, s_[r]); \
            tmax_ = on_ ? tmax_ : -INFINITY; tmax_ = xhalf_max(tmax_); \
            mn_ = fmaxf(m, tmax_); mu_ = (mn_ == -INFINITY) ? 0.f : mn_; const float mr_ = on_ ? mu_ : INFINITY; \
            _Pragma("unroll") for (int r = 0; r < 16; ++r) s_[r] = fexp2(s_[r] - mr_); \
        } else { \
            _Pragma("unroll") for (int r = 0; r < 16; ++r) { const int key_ = kb + (r & 3) + 8 * (r >> 2) + 4 * h_; s_[r] = (key_ >= lo && key_ <= hi) ? s_[r] : -INFINITY; tmax_ = fmaxf(tmax_, s_[r]); } \
            tmax_ = xhalf_max(tmax_); \
            mn_ = fmaxf(m, tmax_); mu_ = (mn_ == -INFINITY) ? 0.f : mn_; \
            _Pragma("unroll") for (int r = 0; r < 16; ++r) s_[r] = fexp2(s_[r] - mu_); \
        } \
        AP_DUP_EXP() \
        const float al_ = fexp2(m - mu_); float ps_ = 0.f; \
        _Pragma("unroll") for (int r = 0; r < 16; ++r) ps_ += s_[r]; \
        lsum = lsum * al_ + ps_; m = mn_; \
        if (kind != 0) { if (__ballot(al_ != 1.0f) != 0ull) { D0 *= al_; D1 *= al_; } asm volatile("" ::: "memory");   \
            _Pragma("unroll") for (int s2 = 0; s2 < 2; ++s2) { const bf16x8 pf_ = cvt_frag(s_, s2); const int rA_ = 16 * s2 + 4 * h_; \
                D0 = mfma32(tr_frag(Vw, AS_RS, rA_, rA_ + 8, 16 * blk, lane), pf_, D0); D1 = mfma32(tr_frag(Vw, AS_RS, rA_, rA_ + 8, 32 + 16 * blk, lane), pf_, D1); } \
            AP_DUP_PV() \
            asm volatile("" ::: "memory"); } \
        if (kind == 1) { _Pragma("unroll") for (int r = 0; r < 16; ++r) { const int n2_ = kb + (r & 3) + 8 * (r >> 2) + 4 * h_; float a_ = s_[r] * invC; a_ += __shfl_xor(a_, 1); a_ += __shfl_xor(a_, 2); if (hr == 0) PS[tl * 264 + n2_] = a_; } } \
    } while (0)
#define AP_RUN(N_) do { const int n_ = (N_); \
      if (n_ > 0) { const unsigned e0_ = (unsigned)__builtin_amdgcn_readfirstlane((int)LIST[0]); AP_LOADT(e0_, nk0, nv0); } \
      if (n_ > 1) { const unsigned e1_ = (unsigned)__builtin_amdgcn_readfirstlane((int)LIST[1]); AP_LOADT(e1_, nk1, nv1); } \
      _Pragma("unroll 1") for (int i_ = 0; i_ < n_; i_ += 2) { AP_STEP(i_, n_, nk0, nv0); if (i_ + 1 < n_) AP_STEP(i_ + 1, n_, nk1, nv1); } } while (0)
    int cur_kind = -1;
    if (lane < 2 * ntc) LIST[lane] = (unsigned short)(((lane >= ntc ? 1u : 0u) << 12) | (unsigned)(lane >= ntc ? lane - ntc : lane));
    LDS_WAIT(); asm volatile("" ::: "memory");
    AP_RUN(2 * ntc);
    { const float sc = (cur_kind == 1) ? g0 * invC : 0.f; D0 *= sc; D1 *= sc; }
    LDS_WAIT(); asm volatile("" ::: "memory");
#pragma unroll 1
    for (int tk = 0; tk < 8; ++tk) {
        const LAS float* pr = PS + tk * 264; const int s = lane; float imp = 0.f;
#pragma unroll
        for (int n = 4 * s - 1; n <= 4 * s + 3; ++n) if (n >= 0) imp += pr[n];
        const bool forced = (s == 0) || (s == qt) || (s == qt - 1), avail = s <= qt; const float val = avail ? (forced ? 1e4f : imp) : -1e4f;
        IMPw[s] = val; LDS_WAIT(); asm volatile("" ::: "memory");
        int rank = 0;
#pragma unroll 8
        for (int i = 0; i < 64; ++i) { const float v = IMPw[i]; rank += (v > val || (v == val && i < s)) ? 1 : 0; }
        const unsigned long long mk = __ballot(rank < 16);
        if (lane == 0) MASKS[tk] = mk;
        LDS_WAIT(); asm volatile("" ::: "memory");
    }
#pragma unroll
    for (int r = 0; r < 16; ++r) { OAG[r * 64] = D0[r]; OAG[(16 + r) * 64] = D1[r]; }
    mk0 = MASKS[tl]; unsigned long long wu = 0ull;
#pragma unroll
    for (int i = 0; i < 8; ++i) wu |= MASKS[i];
    wu &= (qt >= 63) ? ~0ull : ((1ull << (qt + 1)) - 1ull);
    const int nsel = 2 * __popcll(wu); const int tiLo = (t0w > WINB) ? ((t0w - WINB) >> 5) : 0, tiHi = (t0w + 7) >> 5, nwin = tiHi - tiLo + 1;
    if ((wu >> lane) & 1ull) { const int pos = 2 * __popcll(wu & ((1ull << lane) - 1ull)); LIST[pos] = (unsigned short)((2u << 12) | (unsigned)(2 * lane)); LIST[pos + 1] = (unsigned short)((2u << 12) | (unsigned)(2 * lane + 1)); }
    if (lane < nwin) LIST[nsel + lane] = (unsigned short)((3u << 12) | (unsigned)(tiLo + lane));
    LDS_WAIT(); asm volatile("" ::: "memory");
#ifdef DBG_COUNT
    if (lane == 0) { unsigned* CNT = (unsigned*)(F.ws + WS_CTL) + 3000; atomicAdd(CNT + 0, (unsigned)nsel); atomicAdd(CNT + 1, (unsigned)nwin); atomicAdd(CNT + 2, (unsigned)(2 * ntc)); atomicAdd(CNT + 3, 1u); }
#endif
    cur_kind = -1;
    AP_RUN(nsel + nwin);
    const float ltw = xhalf_sum(lsum); const float scw = (ltw > 0.f ? 1.0f / ltw : 0.f) * g2;
#undef AP_RUN
#undef AP_STEP
#undef AP_LOADT
    {
        bf16* op = WSP(bf16, WS_OA) + row * 512 + head * 64;
#pragma unroll
        for (int r4 = 0; r4 < 4; ++r4) { float a_[4], b_[4];
#pragma unroll
            for (int x = 0; x < 4; ++x) { a_[x] = OAG[(4 * r4 + x) * 64] + D0[4 * r4 + x] * scw; b_[x] = OAG[(16 + 4 * r4 + x) * 64] + D1[4 * r4 + x] * scw; }
            v2u a, b; a.x = pk2(a_[0], a_[1]); a.y = pk2(a_[2], a_[3]); b.x = pk2(b_[0], b_[1]); b.y = pk2(b_[2], b_[3]);
            *(v2u*)(op + 8 * r4 + 4 * h_) = a; *(v2u*)(op + 32 + 8 * r4 + 4 * h_) = b; }
    }
}
#undef AS_TILE

#ifdef DBG_CHECK
__device__ __forceinline__ unsigned dbg_rand(unsigned x) { x ^= x >> 16; x *= 0x7feb352du; x ^= x >> 15; x *= 0x846ca68bu; x ^= x >> 16; return x; }
__device__ __forceinline__ bool dbg_bad(float got, float exp_, float rtol, float atol) { return !(fabsf(got - exp_) <= rtol * fabsf(exp_) + atol); }
__device__ __forceinline__ float bfr(float x) { return __uint_as_float(pk2(x, 0.f) << 16); }
__device__ __forceinline__ int dbg_row(unsigned r) { const unsigned k = r % 20u; if (k == 0) return (int)(PM + (r >> 8) % SM); if (k == 1) return (int)(((r >> 8) % PB) * PT + ((r >> 12) % 8)); if (k == 2) return (int)(((r >> 8) % PB) * PT + PT - 1 - ((r >> 12) % 8)); return (int)((r >> 5) % PM); }
__device__ __forceinline__ float dbg_rs(const Frame& F, int row, int lane) { const float* xr = xrow_in(F, 0, row); float ss = 0.f; for (int d = lane; d < DM; d += 64) ss += xr[d] * xr[d]; return 1.0f / sqrtf(wave_sum(ss) * (1.0f / DM) + EPS); }
__device__ __forceinline__ float dbg_h(const Frame& F, int row, int d, float rs) { const float* mod = WSP(float, WS_MOD) + (size_t)row_bb(row) * 6144; return bfr(xrow_in(F, 0, row)[d] * rs * FIN(I_N1G)[d] * (1.0f + mod[1024 + d]) + mod[d]); }

__device__ __forceinline__ void dbg_check_phase(Frame& F) {
    const int gw = F.bid * NWAVES + F.wave, NGW = F.G * NWAVES, lane = F.lane;
    unsigned* CNT = (unsigned*)(F.ws + WS_CTL) + 3000;
    LAS float* L = (LAS float*)(F.lds + F.wave * 16384);
#define DBG_FLAG(ch, cond) do { if (__any(cond) && lane == 0) atomicAdd(CNT + (ch), 1u); } while (0)
    for (int s = gw; s < 1536; s += NGW) {
        const unsigned r = dbg_rand(1000u + s); const int row = dbg_row(r); const float rs = dbg_rs(F, row, lane); const int kind = s % 6;
        const bool isp = row < PM; const int b = isp ? (row >> 12) : ((row - PM) >> 3), t = isp ? (row & (PT - 1)) : ((row - PM) & 7);
#define DBG_U(col, dst) do { float a_ = 0.f; for (int d_ = lane; d_ < DM; d_ += 64) a_ += dbg_h(F, row, d_, rs) * bfr(FIN(I_WIN)[(size_t)d_ * D_IN + (col)]); dst = wave_sum(a_); } while (0)
        if (kind == 0) {
            const int c = (r >> 3) % 768, j = c >> 7, k = (c >> 6) & 1, dd = c & 63; float u; DBG_U(O_NKV + c, u); bool bad = false;
            if (j < 4) bad = dbg_bad(F.out[(isp ? OUT_ROWS_P + (size_t)row * 512 : OUT_ROWS_S + (size_t)(row - PM) * 512) + c], u, 0.01f, 0.01f);
            else if (isp) { if (t >= PT - WINB) bad = dbg_bad(F.out[OUT_WIN_P + ((size_t)b * WINB + (t - (PT - WINB))) * 256 + (c - 512)], u, 0.01f, 0.01f); }
            else bad = dbg_bad(F.out[OUT_WIN_S + ((size_t)b * WINB + (WINB - ST) + t) * 256 + (c - 512)], u, 0.01f, 0.01f);
            if (isp) { if (j < 2) bad = bad || dbg_bad(bf1(WSP(bf16, WS_ACMP)[((size_t)j * CMP_ROWS_J + 32768 + (b * 2 + k) * 256 + (t >> 4)) * 1024 + (t & 15) * 64 + dd]), u, 0.01f, 0.01f);
                       else bad = bad || dbg_bad(bf1(WSP(bf16, WS_KVB)[((((size_t)(j - 2) * PB + b) * 2 + k) * PT + t) * 64 + dd]), u, 0.01f, 0.01f); }
            else if (j >= 2) bad = bad || dbg_bad(bf1(WSP(bf16, WS_KVS)[((((size_t)(j - 2) * SB + b) * 2 + k) * ST + t) * 64 + dd]), u, 0.01f, 0.01f);
            DBG_FLAG(0, bad);
        } else if (kind == 1) {
            const int gi = (r >> 3) % 24, c5 = (r >> 8) % 512, cm = (r >> 8) % 3072; float u0, u1, u2, u3; DBG_U(O_NG + gi, u0); DBG_U(O_RX + c5, u1); DBG_U(O_RGATE + c5, u2); DBG_U(O_MG + cm, u3);
            bool bad = dbg_bad(WSP(float, WS_NG)[(size_t)row * 24 + gi], 1.0f / (1.0f + expf(-u0)), 0.01f, 0.005f);
            bad = bad || dbg_bad(WSP(float, WS_RX)[(size_t)row * 512 + c5], u1, 0.01f, 0.01f);
            bad = bad || dbg_bad(bf1(WSP(bf16, WS_GG)[(size_t)row * 512 + c5]), gelu_tanh(u2), 0.02f, 0.01f);
            bad = bad || dbg_bad(bf1(WSP(bf16, WS_MGS)[(size_t)row * 3072 + cm]), 1.0f / (1.0f + expf(-u3)), 0.01f, 0.005f);
            DBG_FLAG(1, bad);
        } else if (kind == 2) {
            const int head = (r >> 13) % 4, dim = (r >> 16) % 64, c5 = (r >> 3) % 512; float x1, x2, uv, ug, uq; DBG_U(O_RQ + head * 128 + dim, x1); DBG_U(O_RQ + head * 128 + 64 + dim, x2); DBG_U(O_RV + c5, uv); DBG_U(O_RG + c5, ug); DBG_U(O_NQ + c5, uq);
            const float pos = (float)(isp ? t : PAST + t); const float ang = pos * (float)pow(10000.0, -(double)dim / 64.0); float sn, cs; sincos_acc(ang, sn, cs);
            const bf16* RQ = WSP(bf16, WS_RQ);
            bool bad = dbg_bad(bf1(RQ[(size_t)row * 512 + head * 128 + dim]), x1 * cs - x2 * sn, 0.02f, 0.02f) || dbg_bad(bf1(RQ[(size_t)row * 512 + head * 128 + 64 + dim]), x1 * sn + x2 * cs, 0.02f, 0.02f);
            bad = bad || dbg_bad(bf1(RQ[(size_t)2 * MT * 512 + (size_t)row * 512 + c5]), uv, 0.01f, 0.01f) || dbg_bad(bf1(RQ[(size_t)3 * MT * 512 + (size_t)row * 512 + c5]), ug, 0.01f, 0.01f);
            bad = bad || dbg_bad(bf1(WSP(bf16, WS_QN)[(size_t)row * 512 + c5]), uq * QSCALE, 0.01f, 0.005f);
            DBG_FLAG(2, bad);
        }
#undef DBG_U
    }
    for (int s = gw; s < 128; s += NGW) {
        const unsigned r = dbg_rand(3000u + s); const int j = r & 1; const bool smp = ((r >> 1) & 3) != 0;
        const int grp = smp ? (int)((r >> 3) % 64) : (int)((r >> 3) % 8), nmax = smp ? 511 : 255; int n = (r >> 10) % nmax; if (((r >> 20) & 7) == 0) n = nmax - 1;
        const size_t rj = smp ? (size_t)grp * 512 + n : (size_t)32768 + grp * 256 + n;
        const bf16* A = WSP(bf16, WS_ACMP) + ((size_t)j * CMP_ROWS_J + rj) * 1024;
        const float* w1 = FIN(I_W1) + (size_t)j * 2048 * 128; const float* pe = FIN(I_PE) + j * 2048;
        for (int hh = 0; hh < 2; ++hh) { const int h = lane + 64 * hh; float a = FIN(I_B1)[j * 128 + h];
            for (int i = 0; i < 1024; ++i) a += (bf1(A[i]) + pe[i]) * w1[(size_t)i * 128 + h] + (bf1(A[1024 + i]) + pe[1024 + i]) * w1[(size_t)(1024 + i) * 128 + h];
            L[h] = gelu_tanh(a); }
        LDS_WAIT(); asm volatile("" ::: "memory");
        float o = 0.f; for (int h = 0; h < 128; ++h) o += L[h] * FIN(I_W2)[((size_t)j * 128 + h) * 64 + lane];
        const float got = bf1(WSP(bf16, WS_CK)[((size_t)j * CMP_ROWS_J + rj) * 64 + lane]);
        { const bool bd = dbg_bad(got, o, 0.05f, 0.03f); const unsigned long long mk = __ballot(bd); if (lane == 0 && mk) atomicAdd(CNT + 3, (unsigned)__popcll(mk)); }
        LDS_WAIT(); asm volatile("" ::: "memory");
    }
    for (int s = gw; s < 128; s += NGW) {
        const unsigned r = dbg_rand(3500u + s); const int j = r & 1; const bool smp = ((r >> 1) & 3) != 0;
        const int grp = smp ? (int)((r >> 3) % 64) : (int)((r >> 3) % 8), nmax = smp ? 511 : 255; const int n = (r >> 10) % nmax;
        const size_t rj = smp ? (size_t)grp * 512 + n : (size_t)32768 + grp * 256 + n, row = (size_t)j * CMP_ROWS_J + rj;
        const bf16* A = WSP(bf16, WS_ACMP) + row * 1024; const float* w1 = FIN(I_W1) + (size_t)j * 2048 * 128; const bf16* LH = WSP(bf16, WS_LH);
        unsigned nb = 0;
        for (int hh = 0; hh < 2; ++hh) { const int h = lane + 64 * hh; float lo = 0.f, hi = 0.f;
            for (int i = 0; i < 1024; ++i) { const float av = bf1(A[i]); lo += av * bfr(w1[(size_t)i * 128 + h]); hi += av * bfr(w1[(size_t)(1024 + i) * 128 + h]); }
            const bool bd = dbg_bad(bf1(LH[row * 256 + h]), lo, 0.02f, 0.02f) || dbg_bad(bf1(LH[row * 256 + 128 + h]), hi, 0.02f, 0.02f); nb += (unsigned)__popcll(__ballot(bd)); }
        if (lane == 0 && nb) atomicAdd(CNT + 9, nb);
        for (int hh = 0; hh < 2; ++hh) { const int h = lane + 64 * hh; L[h] = gelu_tanh(bf1(LH[row * 256 + h]) + bf1(LH[(row + 1) * 256 + 128 + h]) + WSP(float, WS_SMALLW + SW_CB)[j * 128 + h]); }
        LDS_WAIT(); asm volatile("" ::: "memory");
        float o = 0.f; for (int h = 0; h < 128; ++h) o += bfr(L[h]) * bfr(FIN(I_W2)[((size_t)j * 128 + h) * 64 + lane]);
        { const bool bd = dbg_bad(bf1(WSP(bf16, WS_CK)[row * 64 + lane]), o, 0.03f, 0.01f); const unsigned long long mk = __ballot(bd); if (lane == 0 && mk) atomicAdd(CNT + 11, (unsigned)__popcll(mk)); }
        LDS_WAIT(); asm volatile("" ::: "memory");
    }
    for (int s = gw; s < 64; s += NGW) {
        const unsigned r = dbg_rand(3700u + s); const int j = r & 1, half = (r >> 1) & 1, h = (r >> 2) % 128; const bf16* W1T = WSP(bf16, WS_SMALLW + SW_W1T) + ((size_t)j * 256 + half * 128 + h) * 1024;
        const float* w1 = FIN(I_W1) + ((size_t)j * 32 + half * 16) * 64 * 128 + h; unsigned nb = 0;
        for (int k = lane; k < 1024; k += 64) nb += (unsigned)__popcll(__ballot(dbg_bad(bf1(W1T[k]), w1[(size_t)k * 128], 0.01f, 0.0001f)));
        if (lane == 0 && nb) atomicAdd(CNT + 12, nb);
        const bool smp = ((r >> 9) & 3) != 0; const int grp = smp ? (int)((r >> 11) % 64) : (int)((r >> 11) % 8), n = (r >> 17) % (smp ? 511 : 255);
        const size_t row = (size_t)j * CMP_ROWS_J + (smp ? (size_t)grp * 512 + n : (size_t)32768 + grp * 256 + n); const bf16* A = WSP(bf16, WS_ACMP) + row * 1024;
        float a = 0.f; for (int k = lane; k < 1024; k += 64) a += bf1(A[k]) * bf1(W1T[k]); a = wave_sum(a);
        DBG_FLAG(13, dbg_bad(bf1(WSP(bf16, WS_LH)[row * 256 + half * 128 + h]), a, 0.02f, 0.02f));
    }
    for (int s = gw; s < 4; s += NGW) {
        const int j = s >> 1, h = (s & 1) * 64 + lane; const float* w1 = FIN(I_W1) + (size_t)j * 2048 * 128; const float* pe = FIN(I_PE) + j * 2048;
        float a = FIN(I_B1)[j * 128 + h]; for (int i = 0; i < 2048; ++i) a += pe[i] * w1[(size_t)i * 128 + h];
        const unsigned long long mk = __ballot(dbg_bad(WSP(float, WS_SMALLW + SW_CB)[j * 128 + h], a, 0.001f, 0.0005f)); if (lane == 0 && mk) atomicAdd(CNT + 10, (unsigned)__popcll(mk));
    }
    for (int s = gw; s < 96; s += NGW) {
        const unsigned r = dbg_rand(4000u + s); const bool smp = (s % 3) == 2;
        int seq, kvh = (r >> 4) & 1, t, tl = 0; size_t row;
        if (smp) { seq = (r >> 5) % SB; tl = (r >> 10) % ST; t = PAST + tl; row = (size_t)PM + seq * ST + tl; }
        else { seq = (r >> 5) % PB; const unsigned k = (r >> 8) % 8u; t = (k == 0) ? (int)((r >> 12) % 40) : (k == 1) ? PT - 1 - (int)((r >> 12) % 70) : (int)((r >> 12) % PT); row = (size_t)seq * PT + t; }
        const int N = smp ? 511 : 255, NS = smp ? 129 : 64, cur = t >> 6;
        LAS float* Q = L; LAS float* SC = L + 256; LAS float* PSUM = L + 256 + 2048; LAS float* OUT = L + 256 + 2048 + 512;
        for (int i = lane; i < 256; i += 64) Q[i] = bf1(WSP(bf16, WS_QN)[row * 512 + (kvh * 4 + (i >> 6)) * 64 + (i & 63)]);
        for (int i = lane; i < 768; i += 64) OUT[i] = 0.f;
        LDS_WAIT(); asm volatile("" ::: "memory");
        const bf16* CKk = WSP(bf16, WS_CK) + (smp ? (size_t)(seq * 2 + kvh) * 512 : (size_t)32768 + (seq * 2 + kvh) * 256) * 64; const bf16* CKv = CKk + (size_t)CMP_ROWS_J * 64;
        const int nvis = smp ? 511 : ((t >= 31) ? ((t - 31) >> 4) + 1 : 0);
        for (int i = lane; i < 512; i += 64) PSUM[i] = 0.f;
        for (int hr = 0; hr < 4; ++hr) {
            float mx = -INFINITY; for (int n = lane; n < nvis; n += 64) { float a = 0.f; for (int d = 0; d < 64; ++d) a += Q[hr * 64 + d] * bf1(CKk[(size_t)n * 64 + d]); SC[n] = a; mx = fmaxf(mx, a); }
            for (int o = 1; o < 64; o <<= 1) mx = fmaxf(mx, __shfl_xor(mx, o));
            float den = 0.f; for (int n = lane; n < nvis; n += 64) { const float e = exp2f(SC[n] - mx); SC[n] = e; den += e; } den = wave_sum(den);
            LDS_WAIT(); asm volatile("" ::: "memory");
            if (nvis > 0) { float o = 0.f; for (int n = 0; n < nvis; ++n) o += SC[n] * bf1(CKv[(size_t)n * 64 + lane]); OUT[hr * 64 + lane] = o / den;
                for (int n = lane; n < nvis; n += 64) PSUM[n] += SC[n] / den; }
            LDS_WAIT(); asm volatile("" ::: "memory");
        }
        LAS float* IMP = SC; LAS float* SELB = SC + 256;
        for (int sblk = lane; sblk < NS; sblk += 64) { float imp = 0.f; for (int n = 4 * sblk - 1; n <= 4 * sblk + 3; ++n) if (n >= 0 && n < N) imp += PSUM[n];
            const bool forced = sblk == 0 || sblk == cur || sblk == cur - 1, avail = sblk * 64 <= t; IMP[sblk] = avail ? (forced ? 1e4f : imp) : -1e4f; SELB[sblk] = 0.f; }
        LDS_WAIT(); asm volatile("" ::: "memory");
        for (int pick = 0; pick < 16 && pick < NS; ++pick) { float bv = -INFINITY; int bi = 1 << 30;
            for (int sblk = lane; sblk < NS; sblk += 64) { const float v = (SELB[sblk] != 0.f) ? -INFINITY : IMP[sblk]; if (v > bv || (v == bv && sblk < bi)) { bv = v; bi = sblk; } }
            for (int o = 1; o < 64; o <<= 1) { const float ov = __shfl_xor(bv, o); const int oi = __shfl_xor(bi, o); if (ov > bv || (ov == bv && oi < bi)) { bv = ov; bi = oi; } }
            if (lane == 0) SELB[bi] = 1.f; LDS_WAIT(); asm volatile("" ::: "memory"); }
        for (int br = 1; br < 3; ++br) for (int hr = 0; hr < 4; ++hr) {
            float mx = -INFINITY, den = 0.f, o = 0.f;
            const int plo = (br == 1) ? 0 : (t - WINB < 0 ? 0 : t - WINB), phi = t;
            for (int p = plo; p <= phi; ++p) {
                if (br == 1 && SELB[p >> 6] == 0.f) { p |= 63; continue; }
                const float* kf = nullptr; const bf16* kb = nullptr; const float* vf = nullptr; const bf16* vb = nullptr;
                const int jk = (br == 1) ? 2 : 4;
                if (!smp) { kb = WSP(bf16, WS_KVB) + ((((size_t)(jk - 2) * PB + seq) * 2 + kvh) * PT + p) * 64; vb = kb + (size_t)PB * 2 * PT * 64; }
                else if (p >= PAST) { kb = WSP(bf16, WS_KVS) + ((((size_t)(jk - 2) * SB + seq) * 2 + kvh) * ST + (p - PAST)) * 64; vb = kb + (size_t)SB * 2 * ST * 64; }
                else if (br == 1) { const int page = ((const int*)F.a->in[I_PT])[seq * NPG + (p >> 7)]; kf = FIN(I_CACHE) + ((((size_t)page * PAGE + (p & 127)) * 4 + 2) * 2 + kvh) * 64; vf = kf + 128; }
                else { kf = FIN(I_CWIN) + ((((size_t)seq * WINB + (p - (PAST - WINB))) * 2 + 0) * 2 + kvh) * 64; vf = kf + 128; }
                float a = 0.f; for (int d = 0; d < 64; ++d) a += Q[hr * 64 + d] * (kb ? bf1(kb[d]) : bfr(kf[d]));
                const float vv = vb ? bf1(vb[lane]) : bfr(vf[lane]);
                const float mn = fmaxf(mx, a), al = exp2f(mx - mn), e = exp2f(a - mn); den = den * al + e; o = o * al + e * vv; mx = mn;
            }
            OUT[(br * 4 + hr) * 64 + lane] = (den > 0.f) ? o / den : 0.f;
        }
        LDS_WAIT(); asm volatile("" ::: "memory");
        bool bad = false;
        for (int hr = 0; hr < 4; ++hr) { const float* ng = WSP(float, WS_NG) + row * 24 + (kvh * 4 + hr) * 3;
            const float e = ng[0] * OUT[(0 * 4 + hr) * 64 + lane] + ng[1] * OUT[(1 * 4 + hr) * 64 + lane] + ng[2] * OUT[(2 * 4 + hr) * 64 + lane];
            bad = bad || dbg_bad(bf1(WSP(bf16, WS_OA)[row * 512 + (kvh * 4 + hr) * 64 + lane]), e, 0.04f, 0.004f); }
        DBG_FLAG(smp ? 5 : 4, bad);
        LDS_WAIT(); asm volatile("" ::: "memory");
    }
    for (int s = gw; s < 96; s += NGW) {
        const unsigned r = dbg_rand(6000u + s); const bool smp = (s % 3) == 2; const int h = (r >> 3) & 3; const float lg = ret_log_g(h);
        const bf16* RQ = WSP(bf16, WS_RQ); const bf16* RK = RQ + (size_t)MT * 512; const bf16* RV = RQ + (size_t)2 * MT * 512; const bf16* RG = RQ + (size_t)3 * MT * 512;
        int seq, t; size_t row0; if (smp) { seq = (r >> 5) % SB; t = (r >> 10) % ST; row0 = (size_t)PM + seq * ST; } else { seq = (r >> 5) % PB; const unsigned k = (r >> 8) % 4u; t = (k == 0) ? (int)((r >> 12) % 300) : (int)((r >> 12) % PT); row0 = (size_t)seq * PT; }
        float o0 = 0.f, o1 = 0.f;
        for (int d = lane; d < 128; d += 64) L[d] = bf1(RQ[(row0 + t) * 512 + h * 128 + d]);
        LDS_WAIT(); asm volatile("" ::: "memory");
        for (int j = 0; j <= t; ++j) { float a = 0.f; for (int d = 0; d < 128; ++d) a += L[d] * bf1(RK[(row0 + j) * 512 + h * 128 + d]);
            a *= expf((float)(t - j) * lg); o0 += a * bf1(RV[(row0 + j) * 512 + h * 128 + lane]); o1 += a * bf1(RV[(row0 + j) * 512 + h * 128 + 64 + lane]); }
        if (smp) { const float* S0 = FIN(I_SRET) + (((size_t)0 * SB + seq) * 4 + h) * 16384; const float cr = expf((float)(t + 1) * lg);
            for (int d = 0; d < 128; ++d) { o0 += L[d] * S0[d * 128 + lane] * cr; o1 += L[d] * S0[d * 128 + 64 + lane] * cr; } }
        const float mean = wave_sum(o0 + o1) * (1.0f / 128.0f); const float var = wave_sum((o0 - mean) * (o0 - mean) + (o1 - mean) * (o1 - mean)) * (1.0f / 128.0f), rstd = 1.0f / sqrtf(var + EPS);
        const float* GN = FIN(I_GNG) + h * 128; const bf16* OR_ = WSP(bf16, WS_OA) + (size_t)MT * 512;
        const float g0 = bf1(RG[(row0 + t) * 512 + h * 128 + lane]), g1 = bf1(RG[(row0 + t) * 512 + h * 128 + 64 + lane]);
        const float e0 = (o0 - mean) * rstd * GN[lane] * (g0 / (1.0f + expf(-g0))), e1 = (o1 - mean) * rstd * GN[64 + lane] * (g1 / (1.0f + expf(-g1)));
        DBG_FLAG(6, dbg_bad(bf1(OR_[(row0 + t) * 512 + h * 128 + lane]), e0, 0.04f, 0.02f) || dbg_bad(bf1(OR_[(row0 + t) * 512 + h * 128 + 64 + lane]), e1, 0.04f, 0.02f));
        const int d = (r >> 20) % 128, T = smp ? ST : PT; float s0 = 0.f, s1 = 0.f;
        for (int j = 0; j < T; ++j) { const float kk = bf1(RK[(row0 + j) * 512 + h * 128 + d]) * expf((float)(T - 1 - j) * lg); s0 += kk * bf1(RV[(row0 + j) * 512 + h * 128 + lane]); s1 += kk * bf1(RV[(row0 + j) * 512 + h * 128 + 64 + lane]); }
        const float* SO;
        if (smp) { const float* S0 = FIN(I_SRET) + (((size_t)0 * SB + seq) * 4 + h) * 16384; const float g8 = expf(8.0f * lg); s0 += g8 * S0[d * 128 + lane]; s1 += g8 * S0[d * 128 + 64 + lane]; SO = F.out + OUT_RET_S + (((size_t)0 * SB + seq) * 4 + h) * 16384; }
        else SO = F.out + OUT_RET_P + (((size_t)0 * PB + seq) * 4 + h) * 16384;
        DBG_FLAG(7, dbg_bad(SO[d * 128 + lane], s0, 0.02f, 0.02f) || dbg_bad(SO[d * 128 + 64 + lane], s1, 0.02f, 0.02f));
        LDS_WAIT(); asm volatile("" ::: "memory");
    }
    for (int s = gw; s < 48; s += NGW) {
        const unsigned r = dbg_rand(8000u + s); const bool smp = (s % 3) == 2; const int blk = (r >> 3) & 7, c = blk * 64 + lane;
        int seq, T; size_t row0; if (smp) { seq = (r >> 6) % SB; T = ST; row0 = (size_t)PM + seq * ST; } else { seq = (r >> 6) % PB; T = 1 + (int)((r >> 10) % ((s & 1) ? 200 : PT)); row0 = (size_t)seq * PT; }
        const float* RX = WSP(float, WS_RX); const float* cw = FIN(I_RCW); const float cb = FIN(I_RCB)[c];
        float x3 = 0.f, x2 = 0.f, x1 = 0.f, h = 0.f;
        if (smp) { const float* cv = FIN(I_SCONV) + (size_t)seq * 3 * 512; x3 = cv[c]; x2 = cv[512 + c]; x1 = cv[1024 + c]; h = FIN(I_SH)[(size_t)seq * 512 + c]; }
        const float sp = log1pf(expf(-FIN(I_LAM)[c])); const float* wa = FIN(I_RWA) + (size_t)blk * 4096; const float* wx = FIN(I_RWX) + (size_t)blk * 4096;
        for (int t = 0; t < T; ++t) { const float x0 = RX[(row0 + t) * 512 + c]; const float xc = cb + cw[c] * x3 + cw[512 + c] * x2 + cw[1024 + c] * x1 + cw[1536 + c] * x0; x3 = x2; x2 = x1; x1 = x0;
            L[lane] = xc; LDS_WAIT(); asm volatile("" ::: "memory");
            float ra = FIN(I_RBA)[c], ri = FIN(I_RBX)[c]; for (int i = 0; i < 64; ++i) { ra += L[i] * wa[i * 64 + lane]; ri += L[i] * wx[i * 64 + lane]; }
            LDS_WAIT(); asm volatile("" ::: "memory");
            const float rr = 1.0f / (1.0f + expf(-ra)), ii = 1.0f / (1.0f + expf(-ri)), la = -8.0f * rr * sp, a = expf(la); h = a * h + sqrtf(-expm1f(2.0f * la)) * (ii * xc); }
        const size_t o = (row0 + T - 1) * 512 + c; const float e = h * bf1(WSP(bf16, WS_GG)[o]);
        DBG_FLAG(8, dbg_bad(bf1((WSP(bf16, WS_OA) + (size_t)2 * MT * 512)[o]), e, 0.04f, 0.01f));
    }
    for (int s = gw; s < 512; s += NGW) {
        const unsigned r = dbg_rand(9000u + s); const int row = dbg_row(r), col = (r >> 7) % DM;
        float e = 0.f;
        for (int br = 0; br < 3; ++br) { const bf16* O = WSP(bf16, WS_OA) + (size_t)br * MT * 512 + (size_t)row * 512; const float* W = FIN(br == 0 ? I_WBRA : (br == 1 ? I_WBRB : I_WBRC));
            float a = 0.f; for (int k = lane; k < 512; k += 64) a += bf1(O[k]) * bfr(W[(size_t)k * DM + col]); a = wave_sum(a); e += bf1(WSP(bf16, WS_MGS)[(size_t)row * 3072 + br * 1024 + col]) * a; }
        DBG_FLAG(20, dbg_bad(bf1(WSP(bf16, WS_MRG)[(size_t)row * DM + col]), e, 0.03f, 0.01f));
        const float* mod = WSP(float, WS_MOD) + (size_t)row_bb(row) * 6144;
        { float a = 0.f; for (int k = lane; k < DM; k += 64) a += bf1(WSP(bf16, WS_MRG)[(size_t)row * DM + k]) * bfr(FIN(I_WOUT)[(size_t)k * DM + col]); a = wave_sum(a);
          const float ex = xrow_in(F, 0, row)[col] + mod[2048 + col] * a; DBG_FLAG(21, dbg_bad(WSP(float, WS_X1)[(size_t)row * DM + col], ex, 0.005f, 0.005f)); }
        { const float* xr = WSP(float, WS_X1) + (size_t)row * DM; float ss = 0.f; for (int d = lane; d < DM; d += 64) ss += xr[d] * xr[d]; const float rs = 1.0f / sqrtf(wave_sum(ss) * (1.0f / DM) + EPS);
          const int c2 = (r >> 9) % NUP; float a = 0.f; for (int d = lane; d < DM; d += 64) a += bfr(xr[d] * rs * FIN(I_N2G)[d] * (1.0f + mod[4096 + d]) + mod[3072 + d]) * bfr(FIN(I_WUP)[(size_t)d * NUP + c2]); a = wave_sum(a);
          const float got = c2 < DFF ? bf1(WSP(bf16, WS_GP)[(size_t)row * DFF + c2]) : bf1((WSP(bf16, WS_GP) + (size_t)MT * DFF)[(size_t)row * DFF + c2 - DFF]); DBG_FLAG(22, dbg_bad(got, a, 0.02f, 0.01f)); }
        { const int c3 = (r >> 11) % DFF; const bf16* GP = WSP(bf16, WS_GP); const bf16* VAL = GP + (size_t)MT * DFF; const float* cw = FIN(I_FCW);
          const bool isp = row < PM; const int t = isp ? (row & (PT - 1)) : ((row - PM) & 7); float xm2, xm1;
          if (t >= 2) { xm2 = bf1(GP[(size_t)(row - 2) * DFF + c3]); xm1 = bf1(GP[(size_t)(row - 1) * DFF + c3]); }
          else if (isp) { xm2 = 0.f; xm1 = (t == 1) ? bf1(GP[(size_t)(row - 1) * DFF + c3]) : 0.f; }
          else { const float* st = FIN(I_SFFN) + ((size_t)((row - PM) >> 3) * 2) * DFF + c3; xm2 = (t == 0) ? st[0] : st[DFF]; xm1 = (t == 0) ? st[DFF] : bf1(GP[(size_t)(row - 1) * DFF + c3]); }
          const float y = FIN(I_FCB)[c3] + cw[c3] * xm2 + cw[DFF + c3] * xm1 + cw[2 * DFF + c3] * bf1(GP[(size_t)row * DFF + c3]); const float ex = (y / (1.0f + expf(-y))) * bf1(VAL[(size_t)row * DFF + c3]);
          DBG_FLAG(23, dbg_bad(bf1((GP + (size_t)2 * MT * DFF)[(size_t)row * DFF + c3]), ex, 0.02f, 0.005f)); }
        { const bf16* ACT = WSP(bf16, WS_GP) + (size_t)2 * MT * DFF + (size_t)row * DFF; float a = 0.f; for (int k = lane; k < DFF; k += 64) a += bf1(ACT[k]) * bfr(FIN(I_WDN)[(size_t)k * DM + col]); a = wave_sum(a);
          const float ex = WSP(float, WS_X1)[(size_t)row * DM + col] + mod[5120 + col] * a; DBG_FLAG(24, dbg_bad(WSP(float, WS_X2)[(size_t)row * DM + col], ex, 0.005f, 0.005f)); }
    }
#undef DBG_FLAG
}
__device__ __forceinline__ void dbg_report_phase(Frame& F) {
    const unsigned* CNT = (const unsigned*)(F.ws + WS_CTL) + 3000;
    const size_t ooff[14] = {OUT_Y, OUT_Y + (size_t)PM * DM, OUT_ROWS_P, OUT_ROWS_S, OUT_WIN_P, OUT_WIN_S, OUT_RET_P, OUT_RET_S, OUT_H_P, OUT_H_S, OUT_CV_P, OUT_CV_S, OUT_FC_P, OUT_FC_S};
    if (F.bid == 0 && F.tid < 14) { const int b = F.tid; const unsigned c = CNT[b]; const int cnt = 1 + (int)(c > 1000u ? 1000u : c);
        for (int i = 0; i < cnt; ++i) ((unsigned*)F.out)[ooff[b] + 7 + 2 * i] = 0xAAAAAAAAu; }
}
#endif

#ifndef DBG_SUB
#define DBG_SUB 0xFFFF
#endif
#ifndef DBG_MAXPH
#define DBG_MAXPH N_PHASES
#endif
#ifndef DBG_REPEAT
#define DBG_REPEAT 0
#endif
#ifndef DBG_MASK
#define DBG_MASK 0xFFFF
#endif
#define IN(k) (lo <= (k) && (k) < hi)
#ifdef DBG_TIME
#define SEAM(k) do { if ((k) + 1 < hi) { if (MK_N_LAUNCHES == 1) xcd_barrier(bar); } if (F.bid == 0 && F.tid == 0) ((unsigned long long*)(F.ws + WS_CTL))[2048 + (k) + 1] = __builtin_amdgcn_s_memrealtime(); } while (0)
#else
#define SEAM(k) do { if ((k) + 1 < hi) { if (MK_N_LAUNCHES == 1) xcd_barrier(bar); } } while (0)
#endif
template <int l> __device__ __forceinline__ void ph_win(Frame& F) { unsigned char* ws = F.ws;
    pg8::Gemm g{(const pg8::bf16_t*)(ws + WS_H), (const pg8::bf16_t*)(ws + WS_WIN) + (size_t)l * NIN * DM, MT, NIN, DM};
    pg8::StaticOrder S; S.init(MT, NIN, F.G, F.bid); EpiWin E{ws, F.out, l};
    pg8::gemm_phase<EpiWin, pg8::StaticOrder, true, true>(F.lds, g, S, E); }
template <int l> __device__ __forceinline__ void ph_mix1(Frame& F) { unsigned char* ws = F.ws;
    if (DBG_SUB & 1) { launder(F);
        pg8::Gemm g{(const pg8::bf16_t*)(ws + WS_ACMP) + (size_t)l * CMP_ROWS * 1024, (const pg8::bf16_t*)(ws + WS_SMALLW + SW_W1T) + (size_t)l * 512 * 1024, CMP_ROWS, 512, 1024};
        CmpOrder S{F.G, F.bid}; EpiLH E{(bf16*)(ws + WS_LH)};
        pg8::gemm_phase<EpiLH, CmpOrder, true, true>(F.lds, g, S, E); }
    {
        unsigned* ctr = (unsigned*)(F.ws + WS_CTL) + 3210 + l; volatile LAS int* QI = (volatile LAS int*)(F.lds + MISC_OFF + 128);
#pragma unroll 1
        for (;;) {
            __syncthreads();
            if (F.tid == 0) QI[0] = (int)__hip_atomic_fetch_add(ctr, 1u, __ATOMIC_RELAXED, __HIP_MEMORY_SCOPE_AGENT);
            __syncthreads();
            const int u = __builtin_amdgcn_readfirstlane(QI[0]);
            if (u >= 768) break;
            launder(F);
            if (u < 256) rglru_unit<0>(F, l, u); else ret_local_unit(F, u - 256);
        }
        __syncthreads();
    } }
template <int l> __device__ __forceinline__ void ph_mix2(Frame& F) { cmp2_phase(F, l); ret_scan_phase(F, l); rglru_carry_phase(F, l); }
#ifndef DBG_REPQ
#define DBG_REPQ 0
#endif
constexpr int MQ_SA = 64, MQ_PA = MQ_SA + 512, MQ_RG1 = MQ_PA + 256, MQ_RO = MQ_RG1 + 512, MQ_RS = MQ_RO + 128, MQ_RG2 = MQ_RS + 32;
template <int l> __device__ __forceinline__ void ph_mix3(Frame& F) {
    unsigned* ctr = (unsigned*)(F.ws + WS_CTL) + 3200 + l;
    volatile LAS int* QI = (volatile LAS int*)(F.lds + MISC_OFF + 128);
#pragma unroll 1
    for (;;) {
        __syncthreads();
        if (F.tid == 0) QI[0] = (int)__hip_atomic_fetch_add(ctr, 1u, __ATOMIC_RELAXED, __HIP_MEMORY_SCOPE_AGENT);
        __syncthreads();
        const int u = __builtin_amdgcn_readfirstlane(QI[0]);
        if (u >= MQ_RG2) break;
        launder(F);
        if (u < MQ_SA) { attn_sample_unit(F, l, u); if (DBG_REPQ & 2) { launder(F); attn_sample_unit(F, l, u); } }
        else if (u < MQ_PA) { const int v = u - MQ_SA; attn_prompt_unit(F, l, (v & 7) * 64 + 63 - (v >> 3)); if (DBG_REPQ & 1) { launder(F); attn_prompt_unit(F, l, (v & 7) * 64 + 63 - (v >> 3)); } }
        else if (u < MQ_RG1) { rglru_unit<1>(F, l, u - MQ_PA); }
        else if (u < MQ_RO) { ret_out_unit(F, l, u - MQ_RG1); }
        else if (u < MQ_RS) { ret_sample_unit(F, l, u - MQ_RO); }
        else { rglru_unit<2>(F, l, u - MQ_RS); }
    }
    __syncthreads(); }
__device__ __forceinline__ f32x16 smp_tile_acc(Frame& F, const bf16* A, const bf16* Wt, int K, int tile) {
    const int q = F.lane & 31, h_ = F.lane >> 5, ks8 = K / 8, kb = F.wave * ks8;
    const bf16* ap = A + (size_t)((tile >> 5) * 32 + q) * K + kb + 8 * h_; const bf16* bp = Wt + (size_t)((tile & 31) * 32 + q) * K + kb + 8 * h_; f32x16 acc = (f32x16){};
#pragma unroll 11
    for (int kk = 0; kk < ks8 / 16; ++kk) acc = mfma32(*(const bf16x8*)(ap + 16 * kk), *(const bf16x8*)(bp + 16 * kk), acc);
    return acc;
}
__device__ __forceinline__ void smp_tile_put(Frame& F, const f32x16& acc, int slot) { LAS float* R = (LAS float*)(F.lds + slot * 32768) + F.wave * 1024 + F.lane;
#pragma unroll
    for (int r = 0; r < 16; ++r) R[r * 64] = acc[r]; }
__device__ __forceinline__ float smp_tile_get(Frame& F, int slot, int o) { const LAS float* R = (const LAS float*)(F.lds + slot * 32768) + o; float s = 0.f;
#pragma unroll
    for (int w = 0; w < 8; ++w) s += R[w * 1024];
    return s; }
template <int l> __device__ __forceinline__ void ph_br(Frame& F) { unsigned char* ws = F.ws;
    const pg8::bf16_t* wbr = (const pg8::bf16_t*)(ws + WS_WBR) + (size_t)l * 3 * 1024 * 512;
    for (int tile = F.bid; tile < 256; tile += F.G) {
        const f32x16 a0 = smp_tile_acc(F, (const bf16*)(ws + WS_OA) + (size_t)PM * 512, wbr, 512, tile), a1 = smp_tile_acc(F, (const bf16*)(ws + WS_OA) + (size_t)(MT + PM) * 512, wbr + (size_t)1024 * 512, 512, tile),
                     a2 = smp_tile_acc(F, (const bf16*)(ws + WS_OA) + (size_t)(2 * MT + PM) * 512, wbr + (size_t)2 * 1024 * 512, 512, tile);
        __syncthreads(); smp_tile_put(F, a0, 0); smp_tile_put(F, a1, 1); smp_tile_put(F, a2, 2); __syncthreads();
        const bf16* MG = (const bf16*)(ws + WS_MGS); bf16* MR = (bf16*)(ws + WS_MRG);
#pragma unroll
        for (int e = 0; e < 2; ++e) { const int o = F.tid * 2 + e, r = o >> 6, ln = o & 63; const size_t row = (size_t)PM + (tile >> 5) * 32 + (r & 3) + 8 * (r >> 2) + 4 * (ln >> 5); const int col = (tile & 31) * 32 + (ln & 31);
            const bf16* g = MG + row * 3072 + col; MR[row * DM + col] = (bf16)(pk2(bf1(g[0]) * smp_tile_get(F, 0, o) + bf1(g[1024]) * smp_tile_get(F, 1, o) + bf1(g[2048]) * smp_tile_get(F, 2, o), 0.f) & 0xffffu); }
    }
    __syncthreads();
    BrOrder S; S.S.init(PM, DM, F.G, F.bid);
    pg8::Gemm g{(const pg8::bf16_t*)(ws + WS_OA), wbr, 3 * MT, 3 * DM, 512}; EpiBrAll E{ws};
    pg8::gemm_phase<EpiBrAll, BrOrder, true, true>(F.lds, g, S, E); }
__device__ __forceinline__ void smp_res(Frame& F, const bf16* A, const bf16* Wt, int K, const float* xin  , float* xout  , const float* mod, int gofs) {
    for (int tile = F.bid; tile < 256; tile += F.G) {
        const f32x16 a = smp_tile_acc(F, A, Wt, K, tile);
        __syncthreads(); smp_tile_put(F, a, 0); __syncthreads();
#pragma unroll
        for (int e = 0; e < 2; ++e) { const int o = F.tid * 2 + e, r = o >> 6, ln = o & 63; const int rr = (tile >> 5) * 32 + (r & 3) + 8 * (r >> 2) + 4 * (ln >> 5), col = (tile & 31) * 32 + (ln & 31);
            xout[(size_t)rr * DM + col] = xin[(size_t)rr * DM + col] + mod[(size_t)(4 + (rr >> 3)) * 6144 + gofs + col] * smp_tile_get(F, 0, o); }
    }
    __syncthreads();
}
template <int l> __device__ __forceinline__ void ph_out(Frame& F) { unsigned char* ws = F.ws;
    const float* mod = (const float*)(ws + WS_MOD) + (size_t)l * 36 * 6144;
    smp_res(F, (const bf16*)(ws + WS_MRG) + (size_t)PM * DM, (const bf16*)(ws + WS_WOUT) + (size_t)l * DM * DM, DM, l == 0 ? FIN(I_XS) : (const float*)(ws + WS_X2) + (size_t)PM * DM, (float*)(ws + WS_X1) + (size_t)PM * DM, mod, 2048);
    pg8::Gemm g{(const pg8::bf16_t*)(ws + WS_MRG), (const pg8::bf16_t*)(ws + WS_WOUT) + (size_t)l * DM * DM, PM, DM, DM};
    pg8::StaticOrder S; S.init(PM, DM, F.G, F.bid);
    EpiRes E{l == 0 ? FIN(I_XP) : (const float*)(ws + WS_X2), nullptr, (float*)(ws + WS_X1), mod, 2048};
    pg8::gemm_phase<EpiRes, pg8::StaticOrder, true, true>(F.lds, g, S, E); }
template <int l> __device__ __forceinline__ void ph_down(Frame& F) { unsigned char* ws = F.ws;
    const float* mod = (const float*)(ws + WS_MOD) + (size_t)l * 36 * 6144;
    smp_res(F, (const bf16*)(ws + WS_GP) + (size_t)2 * MT * DFF + (size_t)PM * DFF, (const bf16*)(ws + WS_WDN) + (size_t)l * DM * DFF, DFF, (const float*)(ws + WS_X1) + (size_t)PM * DM, (float*)(ws + WS_X2) + (size_t)PM * DM, mod, 5120);
    pg8::Gemm g{(const pg8::bf16_t*)(ws + WS_GP) + (size_t)2 * MT * DFF, (const pg8::bf16_t*)(ws + WS_WDN) + (size_t)l * DM * DFF, PM, DM, DFF};
    pg8::StaticOrder S; S.init(PM, DM, F.G, F.bid);
    EpiRes E{(const float*)(ws + WS_X1), nullptr, (float*)(ws + WS_X2), mod, 5120};
    pg8::gemm_phase<EpiRes, pg8::StaticOrder, true, true>(F.lds, g, S, E); }
template <int l> __device__ __forceinline__ void ph_up(Frame& F) { unsigned char* ws = F.ws;
    pg8::Gemm g{(const pg8::bf16_t*)(ws + WS_H), (const pg8::bf16_t*)(ws + WS_WUP) + (size_t)l * NUP * DM, MT, NUP, DM};
    pg8::StaticOrder S; S.init(MT, NUP, F.G, F.bid); EpiUp E{ws, F.out, l};
    pg8::gemm_phase<EpiUp, pg8::StaticOrder, true, true>(F.lds, g, S, E); }
#define RUNPH(bit, ph, CALL) do { if (((DBG_MASK >> (bit)) & 1) && IN(ph)) { launder(F); CALL; if ((DBG_REPEAT >> (bit)) & 1) { launder(F); CALL; } SEAM(ph); } } while (0)
template <int l> __device__ __forceinline__ void layer_phases(Frame& F, const XcdBarrier& bar, int lo, int hi) {
    constexpr int pb = PH_L0 + l * PH_PER_LAYER;
    RUNPH(1, pb + LP_N1, norm_phase(F, l, 0));
    RUNPH(2, pb + LP_WIN, ph_win<l>(F));
    RUNPH(3, pb + LP_MIX1, ph_mix1<l>(F));
    RUNPH(4, pb + LP_MIX2, ph_mix2<l>(F));
    RUNPH(5, pb + LP_MIX3, ph_mix3<l>(F));
    RUNPH(6, pb + LP_BR, ph_br<l>(F));
    RUNPH(7, pb + LP_OUT, ph_out<l>(F));
    RUNPH(8, pb + LP_N2, norm_phase(F, l, 1));
    RUNPH(9, pb + LP_UP, ph_up<l>(F));
    RUNPH(10, pb + LP_CONV, convact_phase(F, l));
    RUNPH(11, pb + LP_DOWN, ph_down<l>(F));
}
__global__ void __launch_bounds__(NTHR, 2) trunk_fwd(Args args) {
    extern __shared__ __attribute__((aligned(16))) unsigned char lds_raw[];
    Frame F;
    F.lds = (LAS unsigned char*)lds_raw;
    F.tid = threadIdx.x; F.lane = F.tid & 63; F.wave = __builtin_amdgcn_readfirstlane(F.tid >> 6);
    F.G = gridDim.x; F.bid = blockIdx.x; F.a = &args; F.ws = args.ws; F.out = args.out;
    volatile LAS unsigned* MISC = (volatile LAS unsigned*)(F.lds + MISC_OFF);
    for (int u = F.tid; u < 64; u += NTHR) MISC[u] = 0u;
    __syncthreads();
    unsigned* barw = (unsigned*)(F.ws + WS_CTL) + CW_BAR;
    XcdBarrier bar; bar.bar = barw; bar.x = 0; bar.st = nullptr;
    if (MK_N_LAUNCHES == 1) bar = xcd_barrier_post(barw, MISC + 8);
    const int lo = args.ph_lo, hi = args.ph_hi;
    unsigned char* ws = F.ws;

#ifdef DBG_TIME
    if (F.bid == 0 && F.tid == 0) ((unsigned long long*)(F.ws + WS_CTL))[2048] = __builtin_amdgcn_s_memrealtime();
#endif
    RUNPH(0, PH_P0, p0_prologue(F));

    layer_phases<0>(F, bar, lo, hi);
    layer_phases<1>(F, bar, lo, hi);
    if (((DBG_MASK >> 12) & 1) && IN(PH_FINAL)) { launder(F); final_phase(F); if ((DBG_REPEAT >> 12) & 1) { launder(F); final_phase(F); } }
#ifdef DBG_TIME
    {
        xcd_barrier(bar);
        if (F.bid == 0 && F.tid < 14) {
            const unsigned long long* ts = (const unsigned long long*)(F.ws + WS_CTL) + 2048; const unsigned long long tend = __builtin_amdgcn_s_memrealtime();
            const size_t ooff[14] = {OUT_Y, OUT_Y + (size_t)PM * DM, OUT_ROWS_P, OUT_ROWS_S, OUT_WIN_P, OUT_WIN_S, OUT_RET_P, OUT_RET_S, OUT_H_P, OUT_H_S, OUT_CV_P, OUT_CV_S, OUT_FC_P, OUT_FC_S};
            const int b = F.tid; unsigned long long d;
            if (b == 0) d = tend - ts[0]; else if (b == 1) d = ts[1] - ts[0]; else if (b == 13) d = tend - ts[PH_FINAL];
            else { const int ph = PH_L0 + DBG_TIME_LAYER * PH_PER_LAYER + (b - 2); d = ts[ph + 1] - ts[ph]; }
            int cnt = (int)(d / 100ull); if (cnt < 1) cnt = 1; if (cnt > 2000 && b != 0) cnt = 2000;
            for (int i = 0; i < cnt; ++i) ((unsigned*)F.out)[ooff[b] + 7 + 2 * i] = 0xAAAAAAAAu;
        }
    }
#endif
#ifdef DBG_COUNT
    {
        xcd_barrier(bar);
        if (F.bid == 0 && F.tid < 3) { const unsigned* CNT = (const unsigned*)(F.ws + WS_CTL) + 3000; const size_t ooff[3] = {OUT_Y, OUT_Y + (size_t)PM * DM, OUT_ROWS_P};
            const int cnt = (int)((unsigned long long)CNT[F.tid] * 10ull / (CNT[3] ? CNT[3] : 1u)); for (int i = 0; i < cnt; ++i) ((unsigned*)F.out)[ooff[F.tid] + 7 + 2 * i] = 0xAAAAAAAAu; }
    }
#endif
#ifdef DBG_CHECK
    if (lo == 100) { launder(F); dbg_check_phase(F); }
    if (lo == 101) { for (size_t i = (size_t)F.bid * NTHR + F.tid; i < OUT_END; i += (size_t)F.G * NTHR) F.out[i] = 0.f; }
    if (lo == 102) { launder(F); dbg_report_phase(F); }
#endif
}

extern "C" void kernel_launch(void* const* d_in, const int* in_sizes, int n_in, void* d_out, int out_size, void* d_ws, size_t ws_size, hipStream_t stream) {
    static int grid = 0;
    if (grid == 0) {
        if (n_in != 37 || (size_t)out_size != OUT_END || ws_size < WS_END) { fprintf(stderr, "kernel_launch: unexpected shapes: n_in %d out %d (want %zu) ws %zu (want %zu)\n", n_in, out_size, (size_t)OUT_END, ws_size, (size_t)WS_END); grid = -1; return; }
        int dev = 0, cus = 0, per_cu = 0;
        if (hipGetDevice(&dev) != hipSuccess || hipDeviceGetAttribute(&cus, hipDeviceAttributeMultiprocessorCount, dev) != hipSuccess) { grid = -1; return; }
        if (hipFuncSetAttribute((const void*)trunk_fwd, hipFuncAttributeMaxDynamicSharedMemorySize, LDS_BYTES) != hipSuccess) { fprintf(stderr, "kernel_launch: hipFuncSetAttribute failed\n"); grid = -1; return; }
        if (hipOccupancyMaxActiveBlocksPerMultiprocessor(&per_cu, (const void*)trunk_fwd, NTHR, LDS_BYTES) != hipSuccess || per_cu < 1) fprintf(stderr, "kernel_launch: occupancy query reports %d\n", per_cu);
        (void)hipGetLastError();
        grid = cus;
    }
    if (grid < 0) return;
    if (hipMemsetAsync((char*)d_ws + WS_CTL, 0, CTL_ZERO_BYTES, stream) != hipSuccess) return;
#ifdef DBG_POISON
    (void)hipMemsetAsync((char*)d_ws + CTL_ZERO_BYTES, 0xAA, WS_END - CTL_ZERO_BYTES, stream);
    (void)hipMemsetAsync(d_out, 0xAA, (size_t)OUT_END * 4, stream);
#endif
    Args a{};
    for (int i = 0; i < 37; ++i) a.in[i] = d_in[i];
    a.out = (float*)d_out; a.ws = (unsigned char*)d_ws;
#if MK_N_LAUNCHES == 1
    a.ph_lo = 0; a.ph_hi = N_PHASES;
    hipLaunchKernelGGL(trunk_fwd, dim3(grid), dim3(NTHR), LDS_BYTES, stream, a);
#else
    for (int p = 0; p < DBG_MAXPH; ++p) { a.ph_lo = p; a.ph_hi = p + 1; hipLaunchKernelGGL(trunk_fwd, dim3(grid), dim3(NTHR), LDS_BYTES, stream, a); }
#ifdef DBG_CHECK
    for (int p = 100; p < 103; ++p) { a.ph_lo = p; a.ph_hi = p + 1; hipLaunchKernelGGL(trunk_fwd, dim3(grid), dim3(NTHR), LDS_BYTES, stream, a); }
#endif
#endif
    (void)in_sizes;
}
```

```cpp
#include <hip/hip_runtime.h>
#include <cstdio>
#include <cstdint>

#ifndef MK_N_LAUNCHES
#define MK_N_LAUNCHES 1
#endif

constexpr int DM = 1024, PB = 4, PT = 4096, PM = PB * PT, SB = 32, ST = 8, SM = SB * ST, MT = PM + SM;
constexpr int DEPTH = 2, PAST = 8192, PAGE = 128, NPG = PAST / PAGE, NPHYS = 2560;
constexpr int D_IN = 7448, NIN = 7680, DFF = 2816, NUP = 2 * DFF;
constexpr int WINB = 512;
constexpr float EPS = 1e-6f;
constexpr float QSCALE = 0.125f * 1.4426950408889634f;

constexpr int O_NQ = 0, O_NKV = 512, O_NG = 1280, O_RQ = 1304, O_RK = 1816, O_RV = 2328, O_RG = 2840, O_RX = 3352, O_RGATE = 3864, O_MG = 4376;

constexpr size_t OUT_Y = 0;
constexpr size_t OUT_ROWS_P = OUT_Y + (size_t)MT * DM;
constexpr size_t OUT_ROWS_S = OUT_ROWS_P + (size_t)DEPTH * PM * 512;
constexpr size_t OUT_WIN_P = OUT_ROWS_S + (size_t)DEPTH * SM * 512;
constexpr size_t OUT_WIN_S = OUT_WIN_P + (size_t)DEPTH * PB * WINB * 256;
constexpr size_t OUT_RET_P = OUT_WIN_S + (size_t)DEPTH * SB * WINB * 256;
constexpr size_t OUT_RET_S = OUT_RET_P + (size_t)DEPTH * PB * 4 * 16384;
constexpr size_t OUT_H_P = OUT_RET_S + (size_t)DEPTH * SB * 4 * 16384;
constexpr size_t OUT_H_S = OUT_H_P + (size_t)DEPTH * PB * 512;
constexpr size_t OUT_CV_P = OUT_H_S + (size_t)DEPTH * SB * 512;
constexpr size_t OUT_CV_S = OUT_CV_P + (size_t)DEPTH * PB * 3 * 512;
constexpr size_t OUT_FC_P = OUT_CV_S + (size_t)DEPTH * SB * 3 * 512;
constexpr size_t OUT_FC_S = OUT_FC_P + (size_t)DEPTH * PB * 2 * DFF;
constexpr size_t OUT_END = OUT_FC_S + (size_t)DEPTH * SB * 2 * DFF;

constexpr size_t MiB = 1u << 20;
constexpr size_t WS_CTL = 0, CTL_ZERO_BYTES = 4 * MiB;
constexpr size_t WS_MOD = 1 * MiB;
constexpr size_t WS_ROT = 4 * MiB;
constexpr size_t WS_SMALLW = 8 * MiB;
constexpr size_t WS_WIN = 16 * MiB;
constexpr size_t WS_WBR = WS_WIN + (size_t)2 * NIN * DM * 2;
constexpr size_t WS_WOUT = WS_WBR + (size_t)2 * 3 * 1024 * 512 * 2;
constexpr size_t WS_WUP = WS_WOUT + (size_t)2 * 1024 * 1024 * 2;
constexpr size_t WS_WDN = WS_WUP + (size_t)2 * NUP * DM * 2;
constexpr size_t WS_WEND = WS_WDN + (size_t)2 * DM * DFF * 2;
constexpr size_t WS_H = 128 * MiB;
constexpr size_t WS_QN = WS_H + (size_t)MT * DM * 2;
constexpr size_t WS_KVB = WS_QN + (size_t)MT * 512 * 2;
constexpr size_t WS_KVS = WS_KVB + (size_t)4 * PB * 2 * PT * 64 * 2;
constexpr size_t WS_RQ = WS_KVS + (size_t)4 * SB * 2 * ST * 64 * 2;
constexpr size_t WS_RX = WS_RQ + (size_t)4 * MT * 512 * 2;
constexpr size_t WS_GG = WS_RX + (size_t)MT * 512 * 4;
constexpr size_t WS_MGS = WS_GG + (size_t)MT * 512 * 2;
constexpr size_t WS_NG = WS_MGS + (size_t)MT * 3072 * 2;
constexpr size_t WS_OA = WS_NG + (size_t)MT * 24 * 4;
constexpr size_t WS_MRG = WS_OA + (size_t)3 * MT * 512 * 2;
constexpr size_t WS_X1 = WS_MRG + (size_t)MT * DM * 2;
constexpr size_t WS_X2 = WS_X1 + (size_t)MT * DM * 4;
constexpr size_t WS_GP = WS_X2 + (size_t)MT * DM * 4;
constexpr size_t WS_ACMP = WS_GP + (size_t)3 * MT * DFF * 2;
constexpr int CMP_ROWS_J = 34816, CMP_ROWS = 2 * CMP_ROWS_J;
constexpr size_t WS_LH = WS_ACMP + (size_t)2 * CMP_ROWS * 1024 * 2 + 4096;
constexpr size_t WS_CK = WS_LH + (size_t)(CMP_ROWS + 16) * 256 * 2;
constexpr size_t WS_LT = WS_CK + (size_t)CMP_ROWS * 64 * 2;
constexpr size_t WS_SPT = WS_LT + (size_t)16 * 32 * 16384 * 4;
constexpr size_t WS_CAR = WS_SPT + (size_t)16 * 32 * 16384 * 2;
constexpr size_t WS_OAG = WS_CAR + (size_t)4 * 64 * 3 * 512 * 4 + MiB;
constexpr size_t WS_END = WS_OAG + (size_t)2048 * 32 * 64 * 4 + MiB;
static_assert(WS_WEND <= WS_H, "weights fit below WS_H");

constexpr size_t SW_W1T = 0;
constexpr size_t SW_W2T = SW_W1T + (size_t)2 * 2 * 256 * 1024 * 2;
constexpr size_t SW_CB = SW_W2T + (size_t)2 * 2 * 64 * 128 * 2;
constexpr size_t SW_WAT = SW_CB + (size_t)2 * 2 * 128 * 4;
constexpr size_t SW_SP = SW_WAT + (size_t)2 * 2 * 8 * 64 * 64 * 2;
constexpr size_t SW_END = SW_SP + 2 * 512 * 4;
static_assert(SW_END <= 8 * MiB, "small weights fit");

constexpr int CW_TMO = 0;
constexpr int CW_BAR = 4096;

constexpr int PH_P0 = 0, PH_L0 = 1, PH_PER_LAYER = 11, PH_FINAL = PH_L0 + DEPTH * PH_PER_LAYER, N_PHASES = PH_FINAL + 1;
enum { LP_N1 = 0, LP_WIN, LP_MIX1, LP_MIX2, LP_MIX3, LP_BR, LP_OUT, LP_N2, LP_UP, LP_CONV, LP_DOWN };

constexpr int RING_BYTES = 131072;
constexpr int MISC_OFF = RING_BYTES;
constexpr int LDS_BYTES = RING_BYTES + 1024;
constexpr int NWAVES = 8, NTHR = 512;

#define GAS __attribute__((address_space(1)))
#define LAS __attribute__((address_space(3)))
typedef unsigned short bf16;
typedef unsigned v4u __attribute__((ext_vector_type(4)));
typedef unsigned v2u __attribute__((ext_vector_type(2)));
typedef float f32x16 __attribute__((ext_vector_type(16)));
typedef short s16x4 __attribute__((ext_vector_type(4)));
namespace pg8 {
#define PG8_LAS __attribute__((address_space(3)))
typedef unsigned short bf16_t;
typedef short bf16x8 __attribute__((ext_vector_type(8)));
typedef float f32x4 __attribute__((ext_vector_type(4)));
typedef unsigned u32x4 __attribute__((ext_vector_type(4)));
constexpr int BM = 256, BK = 64, HALF = 128, HTB = HALF * BK * 2  , STAGE_BYTES = 8 * HTB, NXCD = 8, WGM = 8;

__host__ __device__ __forceinline__ int lds_byte(int r, int c) { const int st = (r >> 4) * 2 + (c >> 5), rr = r & 15, cc = c & 31, ob = rr * 64 + cc * 2; return st * 1024 + (ob ^ (((ob >> 9) & 1) << 5)); }
__host__ __device__ __forceinline__ void stage_rc(int b, int& R, int& C) { const int st = b / 1024, sb = b % 1024, swz = sb ^ (((sb >> 9) & 1) << 5); R = (st >> 1) * 16 + swz / 64; C = (st & 1) * 32 + (swz % 64) / 2; }
__host__ __device__ __forceinline__ int perm32(int rho) { const int n = rho >> 4, i = rho & 15; return 8 * (i >> 2) + 4 * n + (i & 3); }

struct Unit { int pm, pn; };
struct Gemm { const bf16_t* A; const bf16_t* Bt; int M, N, K; };

struct StaticOrder {
    int nM, nN, nwg, G, c;
    __host__ __device__ void init(int M, int N, int G_, int c_) { nM = M / BM; nN = N / BM; nwg = nM * nN; G = G_; c = c_; }
    __host__ __device__ bool next(int i, Unit& u) const {
        const long L = (long)i * G + c; if (L >= nwg) return false;
        int wgid = (int)L; { const int q = nwg / NXCD, r = nwg % NXCD, xcd = wgid % NXCD, off = wgid / NXCD; wgid = (xcd < r ? xcd * (q + 1) : r * (q + 1) + (xcd - r) * q) + off; }
        const int nig = WGM * nN, gid = wgid / nig, fm = gid * WGM, gsz = (nM - fm) < WGM ? (nM - fm) : WGM;
        u.pm = fm + ((wgid % nig) % gsz); u.pn = (wgid % nig) / gsz; return true;
    }
    __device__ __forceinline__ void a_ready(const Unit&) const {}
    __device__ __forceinline__ void done(const Unit&) const {}
};
__device__ __forceinline__ unsigned cvt_pk_bf16(float lo, float hi) { unsigned r; asm volatile("v_cvt_pk_bf16_f32 %0, %1, %2" : "=v"(r) : "v"(lo), "v"(hi)); return r; }
typedef float f32x2 __attribute__((ext_vector_type(2)));
template <class Epi, class Sched, bool ALIGN_EPI = false, bool SP2 = false>
__device__ __forceinline__ void gemm_phase(PG8_LAS unsigned char* lds, const Gemm g, const Sched& S, const Epi& E) {
    const int tid = threadIdx.x, wid = __builtin_amdgcn_readfirstlane(tid >> 6), lane = tid & 63, wr = wid >> 2, wc = wid & 3, fr = lane & 15, fq = lane >> 4;
    const int K = g.K, nt = K / BK;
    unsigned voffA[2], voffB[2];
#pragma unroll
    for (int i = 0; i < 2; ++i) { int R, C; stage_rc(tid * 16 + i * 8192, R, C); const int Rb = Epi::PERM ? ((R & ~31) + perm32(R & 31)) : R;
        voffA[i] = (unsigned)(R * K + C) * 2u; voffB[i] = (unsigned)(Rb * K + C) * 2u; }
    const size_t kstep = (size_t)(BK * 2);
    const size_t hstep = (size_t)HALF * K * 2;
    const size_t tstep = 2 * hstep;
    const unsigned ldsw = (unsigned)wid * 1024u;
    const int aoff = lds_byte(wr * 64 + fr, fq * 8), boff = lds_byte(wc * 32 + fr, fq * 8);
#define PG8_SA(b, h) (((b) * 2 + (h)) * HTB)
#define PG8_SB(b, h) ((4 + (b) * 2 + (h)) * HTB)
#define PG8_STAGE(bufoff, gbase, voff) do { _Pragma("unroll") for (int _i = 0; _i < 2; ++_i) \
        __builtin_amdgcn_global_load_lds((const unsigned*)((const char*)(gbase) + (voff)[_i]), (PG8_LAS unsigned*)(lds + (bufoff) + ldsw + _i * 8192), 16, 0, 0); } while (0)
#define PG8_LDA(dst, b, h) do { _Pragma("unroll") for (int m = 0; m < 4; ++m) _Pragma("unroll") for (int k = 0; k < 2; ++k) dst[m][k] = *(const PG8_LAS bf16x8*)(lds + PG8_SA(b, h) + aoff + m * 2048 + k * 1024); } while (0)
#define PG8_LDB(dst, b, h) do { _Pragma("unroll") for (int n = 0; n < 2; ++n) _Pragma("unroll") for (int k = 0; k < 2; ++k) dst[n][k] = *(const PG8_LAS bf16x8*)(lds + PG8_SB(b, h) + boff + n * 2048 + k * 1024); } while (0)
#define PG8_MMA(ai, bj, At, Bt) do { __builtin_amdgcn_s_setprio(1); _Pragma("unroll") for (int m = 0; m < 4; ++m) _Pragma("unroll") for (int n = 0; n < 2; ++n) _Pragma("unroll") for (int k = 0; k < 2; ++k) \
        acc[ai][bj][m][n] = __builtin_amdgcn_mfma_f32_16x16x32_bf16(Bt[n][k], At[m][k], acc[ai][bj][m][n], 0, 0, 0); __builtin_amdgcn_s_setprio(0); } while (0)
#define PG8_WAIT_V(n) asm volatile("s_waitcnt vmcnt(" #n ")" ::: "memory")
#define PG8_WAIT_L(n) asm volatile("s_waitcnt lgkmcnt(" #n ")" ::: "memory")
#define PG8_BAR __builtin_amdgcn_s_barrier()
#define PG8_SCHED __builtin_amdgcn_sched_barrier(0)
    Unit cur, nxt; int ui = 0;
    if (!S.next(0, cur)) return;
    f32x4 acc[2][2][4][2];
#pragma unroll
    for (int a = 0; a < 2; ++a)
#pragma unroll
        for (int b = 0; b < 2; ++b)
#pragma unroll
            for (int m = 0; m < 4; ++m)
#pragma unroll
                for (int n = 0; n < 2; ++n) acc[a][b][m][n] = (f32x4){0.f, 0.f, 0.f, 0.f};
    bf16x8 At[4][2], B0[2][2], B1[2][2];
    const char* cA = (const char*)g.A + (size_t)cur.pm * tstep; const char* cB = (const char*)g.Bt + (size_t)cur.pn * tstep;
    S.a_ready(cur);
    if constexpr (SP2) {
        PG8_STAGE(PG8_SB(0, 0), cB, voffB); PG8_STAGE(PG8_SB(0, 1), cB + hstep, voffB); PG8_STAGE(PG8_SA(0, 0), cA, voffA); PG8_STAGE(PG8_SA(0, 1), cA + hstep, voffA);
        if (wr == 1) PG8_BAR;
        PG8_WAIT_V(2); PG8_BAR;
        PG8_STAGE(PG8_SB(1, 0), cB + kstep, voffB); PG8_STAGE(PG8_SA(1, 0), cA + kstep, voffA); PG8_STAGE(PG8_SB(1, 1), cB + hstep + kstep, voffB);
        PG8_WAIT_V(6); PG8_BAR;
    } else {
        PG8_STAGE(PG8_SB(0, 0), cB, voffB); PG8_STAGE(PG8_SA(0, 0), cA, voffA); PG8_STAGE(PG8_SB(0, 1), cB + hstep, voffB); PG8_STAGE(PG8_SA(0, 1), cA + hstep, voffA);
        if (wr == 1) PG8_BAR;
        PG8_WAIT_V(4); PG8_BAR;
        PG8_STAGE(PG8_SB(1, 0), cB + kstep, voffB); PG8_STAGE(PG8_SA(1, 0), cA + kstep, voffA); PG8_STAGE(PG8_SB(1, 1), cB + hstep + kstep, voffB);
        PG8_WAIT_V(6); PG8_BAR;
    }
    for (;;) {
        const bool has_next = S.next(ui + 1, nxt);
        const char* nA = has_next ? (const char*)g.A + (size_t)nxt.pm * tstep : cA; const char* nB = has_next ? (const char*)g.Bt + (size_t)nxt.pn * tstep : cB;
        for (int t = 0; t < nt; t += 2) {
            const bool last = (t == nt - 2);
            const char* a1 = cA + (size_t)(t + 1) * kstep;
            const char* a2 = last ? nA : cA + (size_t)(t + 2) * kstep; const char* b2 = last ? nB : cB + (size_t)(t + 2) * kstep;
            const char* a3 = a2 + kstep; const char* b3 = b2 + kstep;
            if (last && has_next) S.a_ready(nxt);
            if constexpr (SP2) {
            PG8_LDB(B0, 0, 0); PG8_LDB(B1, 0, 1); PG8_SCHED; PG8_LDA(At, 0, 0); PG8_STAGE(PG8_SA(1, 1), a1 + hstep, voffA);
            PG8_WAIT_V(8); PG8_WAIT_L(0); PG8_BAR; PG8_MMA(0, 0, At, B0); PG8_MMA(0, 1, At, B1); PG8_BAR; PG8_SCHED;
            PG8_LDA(At, 0, 1); PG8_STAGE(PG8_SB(0, 0), b2, voffB); PG8_STAGE(PG8_SB(0, 1), b2 + hstep, voffB); PG8_STAGE(PG8_SA(0, 0), a2, voffA);
            PG8_WAIT_V(8); PG8_WAIT_L(0); PG8_BAR; PG8_MMA(1, 0, At, B0); PG8_MMA(1, 1, At, B1); PG8_BAR; PG8_SCHED;
            PG8_LDB(B0, 1, 0); PG8_LDB(B1, 1, 1); PG8_SCHED; PG8_LDA(At, 1, 0); PG8_STAGE(PG8_SA(0, 1), a2 + hstep, voffA);
            PG8_WAIT_V(8); PG8_WAIT_L(0); PG8_BAR; PG8_MMA(0, 0, At, B0); PG8_MMA(0, 1, At, B1); PG8_BAR; PG8_SCHED;
            PG8_LDA(At, 1, 1); PG8_STAGE(PG8_SB(1, 0), b3, voffB); PG8_STAGE(PG8_SB(1, 1), b3 + hstep, voffB); PG8_STAGE(PG8_SA(1, 0), a3, voffA);
            PG8_WAIT_V(8); PG8_WAIT_L(0); PG8_BAR; PG8_MMA(1, 0, At, B0); PG8_MMA(1, 1, At, B1); PG8_BAR; PG8_SCHED;
            } else {
            PG8_LDB(B0, 0, 0); PG8_SCHED; PG8_LDA(At, 0, 0); PG8_STAGE(PG8_SA(1, 1), a1 + hstep, voffA);
            PG8_WAIT_L(8); PG8_BAR; PG8_WAIT_L(0); PG8_MMA(0, 0, At, B0); PG8_BAR; PG8_SCHED;
            PG8_LDB(B1, 0, 1); PG8_STAGE(PG8_SB(0, 0), b2, voffB);
            PG8_BAR; PG8_WAIT_L(0); PG8_MMA(0, 1, At, B1); PG8_BAR;
            PG8_LDA(At, 0, 1); PG8_STAGE(PG8_SA(0, 0), a2, voffA);
            PG8_BAR; PG8_WAIT_L(0); PG8_MMA(1, 0, At, B0); PG8_BAR; PG8_SCHED;
            PG8_STAGE(PG8_SB(0, 1), b2 + hstep, voffB);
            PG8_WAIT_V(6); PG8_BAR; PG8_MMA(1, 1, At, B1); PG8_BAR;
            PG8_LDB(B0, 1, 0); PG8_SCHED; PG8_LDA(At, 1, 0); PG8_STAGE(PG8_SA(0, 1), a2 + hstep, voffA);
            PG8_WAIT_L(8); PG8_BAR; PG8_WAIT_L(0); PG8_MMA(0, 0, At, B0); PG8_BAR; PG8_SCHED;
            PG8_LDB(B1, 1, 1); PG8_STAGE(PG8_SB(1, 0), b3, voffB);
            PG8_BAR; PG8_WAIT_L(0); PG8_MMA(0, 1, At, B1); PG8_BAR;
            PG8_LDA(At, 1, 1); PG8_STAGE(PG8_SA(1, 0), a3, voffA);
            PG8_BAR; PG8_WAIT_L(0); PG8_MMA(1, 0, At, B0); PG8_BAR; PG8_SCHED;
            PG8_STAGE(PG8_SB(1, 1), b3 + hstep, voffB);
            PG8_WAIT_V(6); PG8_BAR; PG8_MMA(1, 1, At, B1); PG8_BAR;
            }
        }
        if constexpr (ALIGN_EPI) { if (wr == 0) PG8_BAR; }
        if constexpr (!Epi::AFTER_DRAIN) { E(acc, cur, wr, wc, fr, fq); S.done(cur); }
        if (!has_next) break;
#pragma unroll
        for (int a = 0; a < 2; ++a)
#pragma unroll
            for (int b = 0; b < 2; ++b)
#pragma unroll
                for (int m = 0; m < 4; ++m)
#pragma unroll
                    for (int n = 0; n < 2; ++n) acc[a][b][m][n] = (f32x4){0.f, 0.f, 0.f, 0.f};
        cur = nxt; cA = nA; cB = nB; ++ui;
        if constexpr (ALIGN_EPI) { if (wr == 1) PG8_BAR; }
    }
    PG8_WAIT_V(0);
    if constexpr (!ALIGN_EPI) { if (wr == 0) PG8_BAR; }
    PG8_BAR;
    if constexpr (Epi::AFTER_DRAIN) { E.fused(acc, cur, wr, wc, fr, fq, lds, wid, lane); S.done(cur); }
#undef PG8_SA
#undef PG8_SB
#undef PG8_STAGE
#undef PG8_LDA
#undef PG8_LDB
#undef PG8_MMA
#undef PG8_WAIT_V
#undef PG8_WAIT_L
#undef PG8_BAR
#undef PG8_SCHED
}
}

using pg8::bf16x8; using pg8::f32x4; using pg8::u32x4;
#define LDS_WAIT() asm volatile("s_waitcnt lgkmcnt(0)" ::: "memory")
#define VM_WAIT() asm volatile("s_waitcnt vmcnt(0)" ::: "memory")
typedef float f32x2_t __attribute__((ext_vector_type(2))); typedef __bf16 bf16x2_t __attribute__((ext_vector_type(2)));
__device__ __forceinline__ unsigned pk2(float lo, float hi) { f32x2_t v = {lo, hi}; bf16x2_t b = __builtin_convertvector(v, bf16x2_t); return __builtin_bit_cast(unsigned, b); }
__device__ __forceinline__ float bf_lo(unsigned w) { return __uint_as_float(w << 16); }
__device__ __forceinline__ float bf_hi(unsigned w) { return __uint_as_float(w & 0xffff0000u); }
__device__ __forceinline__ float bf1(bf16 b) { return __uint_as_float(((unsigned)b) << 16); }
__device__ __forceinline__ float fexp2(float x) { return __builtin_amdgcn_exp2f(x); }
__device__ __forceinline__ float fexp(float x) { return __builtin_amdgcn_exp2f(x * 1.4426950408889634f); }
__device__ __forceinline__ float frcp(float x) { return __builtin_amdgcn_rcpf(x); }
__device__ __forceinline__ float sigmoidf_(float x) { return frcp(1.0f + fexp(-x)); }
__device__ __forceinline__ float siluf_(float x) { return x * sigmoidf_(x); }
__device__ __forceinline__ float gelu_tanh(float x) {
    const float u = 0.7978845608028654f * (x + 0.044715f * x * x * x);
    const float e = fexp(2.0f * u);
    const float t = 1.0f - 2.0f * frcp(e + 1.0f);
    return 0.5f * x * (1.0f + t);
}
__device__ __forceinline__ float wave_sum(float v) {
#pragma unroll
    for (int o = 1; o < 64; o <<= 1) v += __shfl_xor(v, o);
    return v;
}
__device__ __forceinline__ v4u pack8(const f32x4 a, const f32x4 b) { v4u w; w.x = pk2(a[0], a[1]); w.y = pk2(a[2], a[3]); w.z = pk2(b[0], b[1]); w.w = pk2(b[2], b[3]); return w; }
__device__ __forceinline__ void unpack8(const v4u w, f32x4& a, f32x4& b) { a = (f32x4){bf_lo(w.x), bf_hi(w.x), bf_lo(w.y), bf_hi(w.y)}; b = (f32x4){bf_lo(w.z), bf_hi(w.z), bf_lo(w.w), bf_hi(w.w)}; }

#define XB_TMO      128
#define XB_XCNT(j)  (256  + 64 * (j))
#define XB_XSUB(j)  (1280 + 64 * (j))
#define XB_XGEN(j)  (2304 + 64 * (j))
#define XB_TOP      3328
#define XB_TOPGEN   3392
#define XCD_BAR_WORDS 3456
#define XB_SPIN_CAP (1u << 18)

__device__ __forceinline__ unsigned xb_ld(unsigned* p)              { return __hip_atomic_load(p, __ATOMIC_RELAXED, __HIP_MEMORY_SCOPE_AGENT); }
__device__ __forceinline__ unsigned xb_add(unsigned* p, unsigned v) { return __hip_atomic_fetch_add(p, v, __ATOMIC_RELAXED, __HIP_MEMORY_SCOPE_AGENT); }
__device__ __forceinline__ unsigned xb_xcc_id() { return (unsigned)__builtin_amdgcn_s_getreg((3 << 11) | 20) & 0xFu; }
#define XB_SPIN(cond, bar) do { unsigned _sp = 0; while (cond) { __builtin_amdgcn_s_sleep(1); \
    if ((++_sp & 255u) == 0u) { if (xb_ld(&(bar)[XB_TMO])) break; if (_sp > XB_SPIN_CAP) { atomicAdd(&(bar)[XB_TMO], 1u); break; } } } } while (0)

struct XcdBarrier {
    unsigned* bar; unsigned x;
    volatile LAS unsigned* st;
};

__device__ __forceinline__ XcdBarrier xcd_barrier_post(unsigned* bar, volatile LAS unsigned* st) {
    XcdBarrier b; b.bar = bar; b.x = xb_xcc_id(); b.st = st;
    if (threadIdx.x == 0) (void)xb_add(&bar[XB_XCNT(b.x)], 1u);
    return b;
}
__device__ __forceinline__ void xcd_barrier_complete(unsigned* bar, unsigned x, unsigned& nloc, unsigned& nx) {
    const unsigned G = gridDim.x * gridDim.y * gridDim.z;
    unsigned sum, cnt, mine, sp = 0u;
    for (;;) {
        sum = 0u; cnt = 0u; mine = 0u;
#pragma unroll
        for (unsigned j = 0; j < 16; ++j) { const unsigned c = xb_ld(&bar[XB_XCNT(j)]); sum += c; cnt += (c > 0u) ? 1u : 0u; mine = (j == x) ? c : mine; }
        if (sum == G) break;
        __builtin_amdgcn_s_sleep(1);
        if ((++sp & 255u) == 0u) { if (xb_ld(&bar[XB_TMO])) break; if (sp > XB_SPIN_CAP) { atomicAdd(&bar[XB_TMO], 1u); break; } }
    }
    nloc = mine > 0u ? mine : 1u; nx = cnt > 0u ? cnt : 1u;
}

__device__ __forceinline__ void xcd_barrier(const XcdBarrier& b) {
    asm volatile("s_waitcnt vmcnt(0)" ::: "memory");
    __syncthreads();
    if (threadIdx.x == 0) {
        unsigned* bar = b.bar;
        __builtin_amdgcn_s_waitcnt(0);
        unsigned nloc = b.st[0], nx = b.st[1];
        if (nloc == 0u) { xcd_barrier_complete(bar, b.x, nloc, nx); b.st[0] = nloc; b.st[1] = nx; }
        const unsigned old = xb_add(&bar[XB_XSUB(b.x)], 1u);
        const unsigned gen = old / nloc;
        if (old + 1u == (gen + 1u) * nloc) {
            __builtin_amdgcn_fence(__ATOMIC_RELEASE, "agent");
            asm volatile("s_waitcnt vmcnt(0)" ::: "memory");
            const unsigned og = xb_add(&bar[XB_TOP], 1u);
            const unsigned tg = og / nx;
            if (og + 1u == (tg + 1u) * nx) xb_add(&bar[XB_TOPGEN], 1u);
            else XB_SPIN(xb_ld(&bar[XB_TOPGEN]) == tg, bar);
            __builtin_amdgcn_fence(__ATOMIC_ACQUIRE, "agent");
            xb_add(&bar[XB_XGEN(b.x)], 1u);
            asm volatile("s_waitcnt vmcnt(0)" ::: "memory");
        } else {
            XB_SPIN(xb_ld(&bar[XB_XGEN(b.x)]) == gen, bar);
            __builtin_amdgcn_fence(__ATOMIC_ACQUIRE, "agent");
            asm volatile("s_waitcnt vmcnt(0)" ::: "memory");
        }
    }
    __syncthreads();
}

struct Args { const void* in[37]; float* out; unsigned char* ws; int ph_lo, ph_hi; };
enum { I_XP = 0, I_XS, I_CACHE, I_CWIN, I_SRET, I_SH, I_SCONV, I_SFFN, I_PT, I_CP, I_CS, I_N1G, I_N2G, I_WADA, I_BADA, I_WIN, I_PE, I_W1, I_B1, I_W2,
       I_GNG, I_RCW, I_RCB, I_RWA, I_RBA, I_RWX, I_RBX, I_LAM, I_WBRA, I_WBRB, I_WBRC, I_WOUT, I_WUP, I_FCW, I_FCB, I_WDN, I_FNG };

struct Frame {
    LAS unsigned char* lds;
    int tid, lane, wave, G, bid;
    const Args* a;
    unsigned char* ws;
    float* out;
};
__device__ __forceinline__ void launder(Frame& F) { asm volatile("" : "+v"(F.tid), "+v"(F.lane)); int w_ = __builtin_amdgcn_readfirstlane(F.wave), b_ = __builtin_amdgcn_readfirstlane(F.bid), g_ = __builtin_amdgcn_readfirstlane(F.G); asm volatile("" : "+s"(w_), "+s"(b_), "+s"(g_)); F.wave = w_; F.bid = b_; F.G = g_; }
#define FIN(i) ((const float*)F.a->in[i])
#define WSP(T, off) ((T*)(F.ws + (off)))

__device__ __forceinline__ int row_bb(int row) { return row < PM ? (row >> 12) : 4 + ((row - PM) >> 3); }
__device__ __forceinline__ int row_pos(int row) { return row < PM ? (row & (PT - 1)) : PT + ((row - PM) & 7); }

__device__ __forceinline__ int win_cmap(int n) {
    if (n < 1280) return n;
    if (n < 2304) { const int c = n - 1280, isk = c >> 9, hc = c & 511, head = hc >> 7, s = hc & 127;
        const int g = s >> 3, w = s & 7, dim = (w < 4) ? (4 * g + w) : (64 + 4 * g + (w - 4)); return (isk ? O_RK : O_RQ) + head * 128 + dim; }
    if (n < 2816) return O_RV + (n - 2304);
    if (n < 3328) return O_RG + (n - 2816);
    if (n < 3840) return O_RX + (n - 3328);
    if (n < 4352) return O_RGATE + (n - 3840);
    if (n < 7424) return O_MG + (n - 4352);
    if (n < 7448) return O_NG + (n - 7424);
    return -1;
}

template <bool MAP> __device__ __forceinline__ void p0_tr_item(const float* W, int ldw, bf16* WT, int ldt, int k0, int n0, LAS float* scr, int lane) {
    const int nd = n0 + (lane & 31); const int sc = MAP ? win_cmap(nd) : nd;
#pragma unroll 8
    for (int i = 0; i < 32; ++i) { const int kk = 2 * i + (lane >> 5); scr[kk * 33 + (lane & 31)] = (sc >= 0) ? W[(size_t)(k0 + kk) * ldw + sc] : 0.f; }
    LDS_WAIT(); asm volatile("" ::: "memory");
    const int c = lane & 7;
#pragma unroll
    for (int j = 0; j < 4; ++j) { const int n = (lane >> 3) + 8 * j; const LAS float* s = scr + (8 * c) * 33 + n;
        v4u o; o.x = pk2(s[0 * 33], s[1 * 33]); o.y = pk2(s[2 * 33], s[3 * 33]); o.z = pk2(s[4 * 33], s[5 * 33]); o.w = pk2(s[6 * 33], s[7 * 33]);
        *(v4u*)(WT + (size_t)(n0 + n) * ldt + k0 + 8 * c) = o; }
    LDS_WAIT(); asm volatile("" ::: "memory");
}
__device__ __forceinline__ void sincos_acc(float ang, float& s, float& c) {
    const double a = (double)ang; const double kq = rint(a * 0.63661977236758134308); const double r = fma(-kq, 1.57079632679489661923, a);
    const double r2 = r * r;
    const double sp = r * (1.0 + r2 * (-1.6666666666666666e-1 + r2 * (8.3333333333333332e-3 + r2 * (-1.9841269841269841e-4 + r2 * (2.7557319223985893e-6 + r2 * (-2.5052108385441720e-8))))));
    const double cp = 1.0 + r2 * (-0.5 + r2 * (4.1666666666666664e-2 + r2 * (-1.3888888888888889e-3 + r2 * (2.4801587301587302e-5 + r2 * (-2.7557319223985888e-7 + r2 * 2.0876756987868099e-9)))));
    const int q = ((int)kq) & 3;
    const double ss = (q == 0) ? sp : (q == 1) ? cp : (q == 2) ? -sp : -cp;
    const double cc = (q == 0) ? cp : (q == 1) ? -sp : (q == 2) ? -cp : sp;
    s = (float)ss; c = (float)cc;
}

__device__ __forceinline__ void p0_prologue(Frame& F) {
    const int gw = F.bid * NWAVES + F.wave, NGW = F.G * NWAVES, lane = F.lane;
    LAS float* scr = (LAS float*)(F.lds + F.wave * 16384);
    {
        constexpr int I_IN = 16 * 240, I_BR = 8 * 32, I_OUT = 16 * 32, I_UP = 16 * 176, I_DN = 44 * 32, I_L = I_IN + 3 * I_BR + I_OUT + I_UP + I_DN;
        for (int it = gw; it < 2 * I_L; it += NGW) {
            const int l = it / I_L; int r = it % I_L;
            if (r < I_IN) { p0_tr_item<true>(FIN(I_WIN) + (size_t)l * DM * D_IN, D_IN, WSP(bf16, WS_WIN) + (size_t)l * NIN * DM, DM, 64 * (r / 240), 32 * (r % 240), scr, lane); continue; } r -= I_IN;
            if (r < 3 * I_BR) { const int w = r / I_BR, q = r % I_BR; const float* src = FIN(w == 0 ? I_WBRA : (w == 1 ? I_WBRB : I_WBRC)) + (size_t)l * 512 * 1024;
                p0_tr_item<false>(src, 1024, WSP(bf16, WS_WBR) + (size_t)(l * 3 + w) * 1024 * 512, 512, 64 * (q / 32), 32 * (q % 32), scr, lane); continue; } r -= 3 * I_BR;
            if (r < I_OUT) { p0_tr_item<false>(FIN(I_WOUT) + (size_t)l * 1024 * 1024, 1024, WSP(bf16, WS_WOUT) + (size_t)l * 1024 * 1024, 1024, 64 * (r / 32), 32 * (r % 32), scr, lane); continue; } r -= I_OUT;
            if (r < I_UP) { p0_tr_item<false>(FIN(I_WUP) + (size_t)l * DM * NUP, NUP, WSP(bf16, WS_WUP) + (size_t)l * NUP * DM, DM, 64 * (r / 176), 32 * (r % 176), scr, lane); continue; } r -= I_UP;
            p0_tr_item<false>(FIN(I_WDN) + (size_t)l * DFF * DM, DM, WSP(bf16, WS_WDN) + (size_t)l * DM * DFF, DFF, 64 * (r / 32), 32 * (r % 32), scr, lane);
        }
    }
    {
        constexpr int NI_W1 = 8 * 16 * 4, NI_W2 = 4 * 2 * 2, NI_RG = 32 * 2;
        for (int it = gw; it < NI_W1 + NI_W2 + NI_RG; it += NGW) {
            int r = it;
            if (r < NI_W1) { const int m = r / 64, q = r % 64, lk = m >> 1, half = m & 1;
                p0_tr_item<false>(FIN(I_W1) + ((size_t)lk * 32 + half * 16) * 64 * 128, 128, WSP(bf16, WS_SMALLW + SW_W1T) + ((size_t)lk * 256 + half * 128) * 1024, 1024, 64 * (q / 4), 32 * (q % 4), scr, lane); continue; } r -= NI_W1;
            if (r < NI_W2) { const int lk = r / 4, q = r % 4;
                p0_tr_item<false>(FIN(I_W2) + (size_t)lk * 128 * 64, 64, WSP(bf16, WS_SMALLW + SW_W2T) + (size_t)lk * 64 * 128, 128, 64 * (q / 2), 32 * (q % 2), scr, lane); continue; } r -= NI_W2;
            { const int m = r / 2, q = r % 2, l = m >> 4, which = (m >> 3) & 1, blk = m & 7;
                p0_tr_item<false>(FIN(which ? I_RWX : I_RWA) + ((size_t)l * 8 + blk) * 4096, 64, WSP(bf16, WS_SMALLW + SW_WAT) + (size_t)m * 4096, 64, 0, 32 * q, scr, lane); }
        }
    }
    for (int it = gw; it < 64; it += NGW) {
        const int lk = it >> 4, h0 = (it & 15) * 8; const float* pe = FIN(I_PE) + (size_t)lk * 2048; const float* w1 = FIN(I_W1) + (size_t)lk * 2048 * 128 + h0;
        f32x4 a0 = (f32x4){0.f, 0.f, 0.f, 0.f}, a1 = a0;
#pragma unroll 8
        for (int i = lane; i < 2048; i += 64) { const float p = pe[i]; a0 += *(const f32x4*)(w1 + (size_t)i * 128) * p; a1 += *(const f32x4*)(w1 + (size_t)i * 128 + 4) * p; }
#pragma unroll
        for (int x = 0; x < 4; ++x) { a0[x] = wave_sum(a0[x]); a1[x] = wave_sum(a1[x]); }
        if (lane == 0) { float* cb = WSP(float, WS_SMALLW + SW_CB) + lk * 128 + h0; const float* b1 = FIN(I_B1) + lk * 128 + h0;
#pragma unroll
            for (int x = 0; x < 4; ++x) { cb[x] = a0[x] + b1[x]; cb[4 + x] = a1[x] + b1[4 + x]; } }
    }
    for (int i = F.bid * NTHR + F.tid; i < 1024; i += F.G * NTHR) { const float lam = FIN(I_LAM)[i]; WSP(float, WS_SMALLW + SW_SP)[i] = log1pf(expf(-lam)); }
    for (int i = F.bid * NTHR + F.tid; i < 4104 * 64; i += F.G * NTHR) {
        const int pi = i >> 6, fi = i & 63; const float pos = (float)(pi < PT ? pi : PAST + (pi - PT));
        const float freq = (float)pow(10000.0, -(double)fi / 64.0); const float ang = pos * freq; float s, c; sincos_acc(ang, s, c);
        WSP(float, WS_ROT)[i] = c; WSP(float, WS_ROT)[4104 * 64 + i] = s;
    }
    {
        LAS float* SC = (LAS float*)(F.lds + 0);
        LAS float* RED = (LAS float*)(F.lds + 36864);
        for (int u = F.bid; u < 2 * 96; u += F.G) {
            const int l = u / 96, cg = u % 96; float acc[36];
#pragma unroll
            for (int b = 0; b < 36; ++b) acc[b] = 0.f;
#pragma unroll 1
            for (int kh = 0; kh < 4; ++kh) {
                __syncthreads();
                for (int i = F.tid; i < 256 * 36; i += NTHR) { const int d = i / 36, bb = i % 36; const float c = (bb < 4) ? FIN(I_CP)[bb * DM + kh * 256 + d] : FIN(I_CS)[(bb - 4) * DM + kh * 256 + d]; SC[i] = siluf_(c); }
                __syncthreads();
                const float* wp = FIN(I_WADA) + ((size_t)l * DM + kh * 256 + F.wave * 32) * 6144 + cg * 64 + lane;
#pragma unroll 1
                for (int d0 = 0; d0 < 32; d0 += 16) {
                    float wv[16];
#pragma unroll
                    for (int k = 0; k < 16; ++k) wv[k] = wp[(size_t)(d0 + k) * 6144];
#pragma unroll
                    for (int k = 0; k < 16; ++k) { const LAS f32x4* sc4 = (const LAS f32x4*)(SC + (F.wave * 32 + d0 + k) * 36);
#pragma unroll
                        for (int g = 0; g < 9; ++g) { const f32x4 s4 = sc4[g]; acc[4 * g + 0] += wv[k] * s4[0]; acc[4 * g + 1] += wv[k] * s4[1]; acc[4 * g + 2] += wv[k] * s4[2]; acc[4 * g + 3] += wv[k] * s4[3]; } }
                }
            }
#pragma unroll
            for (int b = 0; b < 36; ++b) RED[(F.wave * 36 + b) * 64 + lane] = acc[b];
            __syncthreads();
            for (int o = F.tid; o < 36 * 64; o += NTHR) { const int b = o >> 6, col = o & 63; float sm = FIN(I_BADA)[l * 6144 + cg * 64 + col];
#pragma unroll
                for (int w = 0; w < 8; ++w) sm += RED[(w * 36 + b) * 64 + col];
                WSP(float, WS_MOD)[((size_t)l * 36 + b) * 6144 + cg * 64 + col] = sm; }
        }
        __syncthreads();
    }
    for (int it = gw; it < 2 * SB * PAST / 8; it += NGW) {
        const int l = it / (SB * PAST / 8), r = it % (SB * PAST / 8), db = r / (PAST / 8), tt0 = (r % (PAST / 8)) * 8;
        const int page = ((const int*)F.a->in[I_PT])[db * NPG + (tt0 >> 7)];
        const float* src = FIN(I_CACHE) + (((size_t)l * NPHYS + page) * PAGE + (tt0 & 127)) * 512 + lane * 4;
        f32x4 v[8];
#pragma unroll
        for (int k = 0; k < 8; ++k) v[k] = __builtin_nontemporal_load((const f32x4*)(src + (size_t)k * 512));
        const int idx = lane * 4, j = idx >> 7, kk = (idx >> 6) & 1, d = idx & 63;
        bf16* dst = WSP(bf16, WS_ACMP) + ((size_t)(l * 2 + j) * CMP_ROWS_J) * 1024 + ((size_t)(db * 2 + kk) * PAST + tt0) * 64 + d;
#pragma unroll
        for (int k = 0; k < 8; ++k) { v2u o; o.x = pk2(v[k][0], v[k][1]); o.y = pk2(v[k][2], v[k][3]); *(v2u*)(dst + (size_t)k * 64) = o; }
    }
    for (size_t i = (size_t)F.bid * NTHR + F.tid; i < (size_t)2 * SB * 504 * 64; i += (size_t)F.G * NTHR) {
        const size_t seq = i / (504 * 64), r = i % (504 * 64);
        const f32x4 v = *(const f32x4*)(FIN(I_CWIN) + (seq * 512 + 8) * 256 + r * 4);
        *(f32x4*)(F.out + OUT_WIN_S + seq * 512 * 256 + r * 4) = v;
    }
}

__device__ __forceinline__ const float* xrow_in(const Frame& F, int l, int row) {
    if (l == 0) return row < PM ? FIN(I_XP) + (size_t)row * DM : FIN(I_XS) + (size_t)(row - PM) * DM;
    return WSP(float, WS_X2) + (size_t)row * DM;
}
__device__ __forceinline__ void norm_phase(Frame& F, int l, int which) {
    const int gw = F.bid * NWAVES + F.wave, NGW = F.G * NWAVES, lane = F.lane;
    const float* g = FIN(which ? I_N2G : I_N1G) + l * DM;
    for (int row0 = gw * 2; row0 < MT; row0 += NGW * 2) {
        f32x4 v[2][4]; float ss[2];
#pragma unroll
        for (int rr = 0; rr < 2; ++rr) { const float* xr = which ? WSP(float, WS_X1) + (size_t)(row0 + rr) * DM : xrow_in(F, l, row0 + rr);
#pragma unroll
            for (int j = 0; j < 4; ++j) v[rr][j] = *(const f32x4*)(xr + lane * 4 + 256 * j); }
#pragma unroll
        for (int rr = 0; rr < 2; ++rr) { float a = 0.f;
#pragma unroll
            for (int j = 0; j < 4; ++j) a += (v[rr][j][0] * v[rr][j][0] + v[rr][j][1] * v[rr][j][1]) + (v[rr][j][2] * v[rr][j][2] + v[rr][j][3] * v[rr][j][3]);
            ss[rr] = a; }
#pragma unroll
        for (int o = 1; o < 64; o <<= 1) { ss[0] += __shfl_xor(ss[0], o); ss[1] += __shfl_xor(ss[1], o); }
#pragma unroll
        for (int rr = 0; rr < 2; ++rr) { const int row = row0 + rr; const float rs = 1.0f / sqrtf(ss[rr] * (1.0f / DM) + EPS);
            const float* mod = WSP(float, WS_MOD) + ((size_t)l * 36 + row_bb(row)) * 6144 + (which ? 3072 : 0); bf16* o = WSP(bf16, WS_H) + (size_t)row * DM;
#pragma unroll
            for (int j = 0; j < 4; ++j) { const int c = lane * 4 + 256 * j; const f32x4 gg = *(const f32x4*)(g + c), sh = *(const f32x4*)(mod + c), sc = *(const f32x4*)(mod + 1024 + c);
                const f32x4 y = (v[rr][j] * rs) * gg * (sc + 1.0f) + sh; v2u w; w.x = pk2(y[0], y[1]); w.y = pk2(y[2], y[3]); *(v2u*)(o + c) = w; } }
    }
}
__device__ __forceinline__ void final_phase(Frame& F) {
    const int gw = F.bid * NWAVES + F.wave, NGW = F.G * NWAVES, lane = F.lane;
    const float* g = FIN(I_FNG);
    for (int row = gw; row < MT; row += NGW) {
        const float* xr = WSP(float, WS_X2) + (size_t)row * DM;
        f32x4 v[4]; float ss = 0.f;
#pragma unroll
        for (int j = 0; j < 4; ++j) { v[j] = *(const f32x4*)(xr + lane * 4 + 256 * j); ss += (v[j][0] * v[j][0] + v[j][1] * v[j][1]) + (v[j][2] * v[j][2] + v[j][3] * v[j][3]); }
        const float rs = 1.0f / sqrtf(wave_sum(ss) * (1.0f / DM) + EPS);
        float* o = F.out + OUT_Y + (size_t)row * DM;
#pragma unroll
        for (int j = 0; j < 4; ++j) { const int c = lane * 4 + 256 * j; *(f32x4*)(o + c) = (v[j] * rs) * *(const f32x4*)(g + c); }
    }
}

#define EPI_LOOP_BEGIN \
    _Pragma("unroll") for (int ai = 0; ai < 2; ++ai) _Pragma("unroll") for (int m = 0; m < 4; ++m) { const int row = u.pm * 256 + ai * 128 + wr * 64 + m * 16 + fr; \
    _Pragma("unroll") for (int bj = 0; bj < 2; ++bj) { const int ct = bj * 128 + wc * 32 + 8 * fq; const f32x4 v0 = acc[ai][bj][m][0], v1 = acc[ai][bj][m][1];
#define EPI_LOOP_END } }

struct EpiWin {
    static constexpr bool PERM = true, AFTER_DRAIN = false;
    unsigned char* ws; float* out; int l;
    __device__ __forceinline__ void operator()(const f32x4 (&acc)[2][2][4][2], const pg8::Unit& u, int wr, int wc, int fr0, int fq0) const {
        int fr = fr0, fq = fq0; asm volatile("" : "+v"(fr), "+v"(fq));
        const int pn = u.pn;
        if (pn < 2) {
            bf16* QN = (bf16*)(ws + WS_QN);
            EPI_LOOP_BEGIN *(v4u*)(QN + (size_t)row * 512 + pn * 256 + ct) = pack8(v0 * QSCALE, v1 * QSCALE); EPI_LOOP_END
        } else if (pn < 5) {
            EPI_LOOP_BEGIN
                const int c = (pn - 2) * 256 + ct, j = c >> 7, k = (c >> 6) & 1, d = c & 63;
                const bool isp = row < PM; const int b = isp ? (row >> 12) : ((row - PM) >> 3), t = isp ? (row & (PT - 1)) : ((row - PM) & 7);
                if (j < 4) { float* o = out + (isp ? OUT_ROWS_P + ((size_t)l * PM + row) * 512 : OUT_ROWS_S + ((size_t)l * SM + (row - PM)) * 512) + c; *(f32x4*)o = v0; *(f32x4*)(o + 4) = v1; }
                else if (isp) { if (t >= PT - WINB) { float* o = out + OUT_WIN_P + (((size_t)l * PB + b) * WINB + (t - (PT - WINB))) * 256 + (c - 512); *(f32x4*)o = v0; *(f32x4*)(o + 4) = v1; } }
                else { float* o = out + OUT_WIN_S + (((size_t)l * SB + b) * WINB + (WINB - ST) + t) * 256 + (c - 512); *(f32x4*)o = v0; *(f32x4*)(o + 4) = v1; }
                const v4u w = pack8(v0, v1);
                if (isp) {
                    if (j < 2) *(v4u*)((bf16*)(ws + WS_ACMP) + ((size_t)(l * 2 + j) * CMP_ROWS_J + 32768 + (b * 2 + k) * 256) * 1024 + (size_t)t * 64 + d) = w;
                    else if (j & 1) *(v4u*)((bf16*)(ws + WS_KVB) + ((((size_t)(j - 2) * PB + b) * 2 + k) * PT + t) * 64 + d) = w;
                    else *(v4u*)((bf16*)(ws + WS_KVB) + (((size_t)(j - 2) * PB + b) * 2 + k) * PT * 64 + (size_t)(t >> 5) * 2048 + ((d >> 3) * 32 + (t & 31)) * 8) = w;
                } else if (j >= 2) *(v4u*)((bf16*)(ws + WS_KVS) + ((((size_t)(j - 2) * SB + b) * 2 + k) * ST + t) * 64 + d) = w;
            EPI_LOOP_END
        } else if (pn < 9) {
            const float* ROTC = (const float*)(ws + WS_ROT); const float* ROTS = ROTC + 4104 * 64;
            EPI_LOOP_BEGIN
                const int c = (pn - 5) * 256 + ct, isk = c >> 9, hc = c & 511, head = hc >> 7, d0 = ((hc & 127) >> 3) * 4;
                const int pi = row_pos(row); const f32x4 cs = *(const f32x4*)(ROTC + pi * 64 + d0), sn = *(const f32x4*)(ROTS + pi * 64 + d0);
                const float sc = isk ? 0.08838834764831845f : 1.0f;
                const f32x4 o1 = (v0 * cs - v1 * sn) * sc, o2 = (v0 * sn + v1 * cs) * sc;
                bf16* o = (bf16*)(ws + WS_RQ) + (size_t)isk * MT * 512 + (size_t)row * 512 + head * 128 + d0;
                v2u w1; w1.x = pk2(o1[0], o1[1]); w1.y = pk2(o1[2], o1[3]); *(v2u*)o = w1;
                v2u w2; w2.x = pk2(o2[0], o2[1]); w2.y = pk2(o2[2], o2[3]); *(v2u*)(o + 64) = w2;
            EPI_LOOP_END
        } else if (pn < 13) {
            bf16* RV = (bf16*)(ws + WS_RQ) + (size_t)2 * MT * 512;
            EPI_LOOP_BEGIN const int c = (pn - 9) * 256 + ct; *(v4u*)(RV + (size_t)(c >> 9) * MT * 512 + (size_t)row * 512 + (c & 511)) = pack8(v0, v1); EPI_LOOP_END
        } else if (pn < 15) {
            float* RX = (float*)(ws + WS_RX);
            EPI_LOOP_BEGIN
                const int c = (pn - 13) * 256 + ct; float* o = RX + (size_t)row * 512 + c; *(f32x4*)o = v0; *(f32x4*)(o + 4) = v1;
                if (row < PM) { const int t = row & (PT - 1); if (t >= PT - 3) { float* q = out + OUT_CV_P + (((size_t)l * PB + (row >> 12)) * 3 + (t - (PT - 3))) * 512 + c; *(f32x4*)q = v0; *(f32x4*)(q + 4) = v1; } }
                else { const int i = (row - PM) & 7; if (i >= ST - 3) { float* q = out + OUT_CV_S + (((size_t)l * SB + ((row - PM) >> 3)) * 3 + (i - (ST - 3))) * 512 + c; *(f32x4*)q = v0; *(f32x4*)(q + 4) = v1; } }
            EPI_LOOP_END
        } else if (pn < 17) {
            bf16* GG = (bf16*)(ws + WS_GG);
            EPI_LOOP_BEGIN const int c = (pn - 15) * 256 + ct;
                f32x4 a, b;
#pragma unroll
                for (int i = 0; i < 4; ++i) { a[i] = gelu_tanh(v0[i]); b[i] = gelu_tanh(v1[i]); }
                *(v4u*)(GG + (size_t)row * 512 + c) = pack8(a, b); EPI_LOOP_END
        } else if (pn < 29) {
            bf16* MG = (bf16*)(ws + WS_MGS);
            EPI_LOOP_BEGIN const int c = (pn - 17) * 256 + ct;
                f32x4 a, b;
#pragma unroll
                for (int i = 0; i < 4; ++i) { a[i] = sigmoidf_(v0[i]); b[i] = sigmoidf_(v1[i]); }
                *(v4u*)(MG + (size_t)row * 3072 + c) = pack8(a, b); EPI_LOOP_END
        } else {
            float* NG = (float*)(ws + WS_NG);
            EPI_LOOP_BEGIN if (ct < 24) { f32x4 a, b;
#pragma unroll
                for (int i = 0; i < 4; ++i) { a[i] = sigmoidf_(v0[i]); b[i] = sigmoidf_(v1[i]); }
                float* o = NG + (size_t)row * 24 + ct; *(f32x4*)o = a; *(f32x4*)(o + 4) = b; } EPI_LOOP_END
        }
    }
};

struct EpiLH {
    static constexpr bool PERM = true, AFTER_DRAIN = false;
    bf16* LH;
    __device__ __forceinline__ void operator()(const f32x4 (&acc)[2][2][4][2], const pg8::Unit& u, int wr, int wc, int fr0, int fq0) const {
        int fr = fr0, fq = fq0; asm volatile("" : "+v"(fr), "+v"(fq));
        EPI_LOOP_BEGIN *(v4u*)(LH + (size_t)row * 256 + ct) = pack8(v0, v1); EPI_LOOP_END
    }
};
struct CmpOrder {
    int G, c;
    __device__ bool next(int i, pg8::Unit& u) const { const int L = i * G + c; if (L >= CMP_ROWS / 256) return false; u.pm = L; u.pn = L / (CMP_ROWS_J / 256); return true; }
    __device__ __forceinline__ void a_ready(const pg8::Unit&) const {}
    __device__ __forceinline__ void done(const pg8::Unit&) const {}
};

template <int BR> struct EpiBr {
    static constexpr bool PERM = true, AFTER_DRAIN = false;
    unsigned char* ws;
    __device__ __forceinline__ void operator()(const f32x4 (&acc)[2][2][4][2], const pg8::Unit& u, int wr, int wc, int fr0, int fq0) const {
        int fr = fr0, fq = fq0; asm volatile("" : "+v"(fr), "+v"(fq));
        const bf16* MG = (const bf16*)(ws + WS_MGS); bf16* MR = (bf16*)(ws + WS_MRG);
        EPI_LOOP_BEGIN
            const int col = u.pn * 256 + ct; f32x4 g0, g1; unpack8(*(const v4u*)(MG + (size_t)row * 3072 + BR * 1024 + col), g0, g1);
            f32x4 r0 = v0 * g0, r1 = v1 * g1; bf16* o = MR + (size_t)row * DM + col;
            if (BR > 0) { f32x4 p0, p1; unpack8(*(const v4u*)o, p0, p1); r0 += p0; r1 += p1; }
            *(v4u*)o = pack8(r0, r1);
        EPI_LOOP_END
    }
};

struct BrOrder {
    pg8::StaticOrder S;
    __device__ bool next(int i, pg8::Unit& u) const { pg8::Unit t; if (!S.next(i / 3, t)) return false; const int br = i % 3; u.pm = br * (MT / 256) + t.pm; u.pn = br * 4 + t.pn; return true; }
    __device__ __forceinline__ void a_ready(const pg8::Unit&) const {}
    __device__ __forceinline__ void done(const pg8::Unit&) const {}
};
struct EpiBrAll {
    static constexpr bool PERM = true, AFTER_DRAIN = false;
    unsigned char* ws;
    __device__ __forceinline__ void operator()(const f32x4 (&acc)[2][2][4][2], const pg8::Unit& u0, int wr, int wc, int fr0, int fq0) const {
        int fr = fr0, fq = fq0; asm volatile("" : "+v"(fr), "+v"(fq));
        const int br = u0.pn >> 2; const pg8::Unit u{u0.pm - br * (MT / 256), u0.pn & 3};
        const bf16* MG = (const bf16*)(ws + WS_MGS) + br * 1024; bf16* MR = (bf16*)(ws + WS_MRG);
        if (br == 0) {
            EPI_LOOP_BEGIN const int col = u.pn * 256 + ct; f32x4 g0, g1; unpack8(*(const v4u*)(MG + (size_t)row * 3072 + col), g0, g1); *(v4u*)(MR + (size_t)row * DM + col) = pack8(v0 * g0, v1 * g1); EPI_LOOP_END
        } else {
            EPI_LOOP_BEGIN const int col = u.pn * 256 + ct; f32x4 g0, g1, p0, p1; unpack8(*(const v4u*)(MG + (size_t)row * 3072 + col), g0, g1); bf16* o = MR + (size_t)row * DM + col; unpack8(*(const v4u*)o, p0, p1);
                *(v4u*)o = pack8(v0 * g0 + p0, v1 * g1 + p1); EPI_LOOP_END
        }
    }
};

struct EpiRes {
    static constexpr bool PERM = true, AFTER_DRAIN = false;
    const float* xin_p; const float* xin_s; float* xout; const float* mod; int gofs;
    __device__ __forceinline__ void operator()(const f32x4 (&acc)[2][2][4][2], const pg8::Unit& u, int wr, int wc, int fr0, int fq0) const {
        int fr = fr0, fq = fq0; asm volatile("" : "+v"(fr), "+v"(fq));
        EPI_LOOP_BEGIN
            const int col = u.pn * 256 + ct; const float* xi = (xin_s && row >= PM) ? xin_s + (size_t)(row - PM) * DM + col : xin_p + (size_t)row * DM + col;
            const float* g = mod + (size_t)row_bb(row) * 6144 + gofs + col; float* o = xout + (size_t)row * DM + col;
            *(f32x4*)o = *(const f32x4*)xi + *(const f32x4*)g * v0; *(f32x4*)(o + 4) = *(const f32x4*)(xi + 4) + *(const f32x4*)(g + 4) * v1;
        EPI_LOOP_END
    }
};

struct EpiUp {
    static constexpr bool PERM = true, AFTER_DRAIN = false;
    unsigned char* ws; float* out; int l;
    __device__ __forceinline__ void operator()(const f32x4 (&acc)[2][2][4][2], const pg8::Unit& u, int wr, int wc, int fr0, int fq0) const {
        int fr = fr0, fq = fq0; asm volatile("" : "+v"(fr), "+v"(fq));
        bf16* GP = (bf16*)(ws + WS_GP); bf16* VAL = GP + (size_t)MT * DFF;
        if (u.pn < 11) {
            EPI_LOOP_BEGIN const int c = u.pn * 256 + ct; *(v4u*)(GP + (size_t)row * DFF + c) = pack8(v0, v1);
                if (row < PM) { const int t = row & (PT - 1); if (t >= PT - 2) { float* q = out + OUT_FC_P + (((size_t)l * PB + (row >> 12)) * 2 + (t - (PT - 2))) * DFF + c; *(f32x4*)q = v0; *(f32x4*)(q + 4) = v1; } }
                else { const int i = (row - PM) & 7; if (i >= ST - 2) { float* q = out + OUT_FC_S + (((size_t)l * SB + ((row - PM) >> 3)) * 2 + (i - (ST - 2))) * DFF + c; *(f32x4*)q = v0; *(f32x4*)(q + 4) = v1; } }
            EPI_LOOP_END
        } else {
            EPI_LOOP_BEGIN const int c = (u.pn - 11) * 256 + ct; *(v4u*)(VAL + (size_t)row * DFF + c) = pack8(v0, v1); EPI_LOOP_END
        }
    }
};

__device__ __forceinline__ f32x16 mfma32(bf16x8 a, bf16x8 b, f32x16 c) { return __builtin_amdgcn_mfma_f32_32x32x16_bf16(a, b, c, 0, 0, 0); }
__device__ __forceinline__ f32x4 mfma16(bf16x8 a, bf16x8 b, f32x4 c) { return __builtin_amdgcn_mfma_f32_16x16x32_bf16(a, b, c, 0, 0, 0); }
__device__ __forceinline__ float ret_log_g(int h) { return log1pf(-exp2f(-5.0f - (float)h)); }
__device__ __forceinline__ bf16x8 tr_frag(const LAS unsigned char* base, int rs_bytes, int rowA, int rowB, int colbase, int lane) {
    const int q = (lane & 15) >> 2, p = lane & 3;
    const LAS unsigned char* pa = base + (rowA + q) * rs_bytes + (colbase + 4 * p) * 2;
    const LAS unsigned char* pb = base + (rowB + q) * rs_bytes + (colbase + 4 * p) * 2;
    const s16x4 a = __builtin_bit_cast(s16x4, __builtin_amdgcn_ds_read_tr16_b64_v4i16((LAS s16x4*)pa));
    const s16x4 b = __builtin_bit_cast(s16x4, __builtin_amdgcn_ds_read_tr16_b64_v4i16((LAS s16x4*)pb));
    return (bf16x8){a[0], a[1], a[2], a[3], b[0], b[1], b[2], b[3]};
}
__device__ __forceinline__ bf16x8 cvt_frag(const f32x16& p, int s2) {
    u32x4 w; w.x = pk2(p[8 * s2 + 0], p[8 * s2 + 1]); w.y = pk2(p[8 * s2 + 2], p[8 * s2 + 3]); w.z = pk2(p[8 * s2 + 4], p[8 * s2 + 5]); w.w = pk2(p[8 * s2 + 6], p[8 * s2 + 7]);
    return __builtin_bit_cast(bf16x8, w);
}

__device__ __forceinline__ void cmp2_phase(Frame& F, int l) {
    const int gw = F.bid * NWAVES + F.wave, NGW = F.G * NWAVES, lane = F.lane, r = lane & 15, g = lane >> 4;
    const bf16* LH = WSP(bf16, WS_LH); bf16* CK = WSP(bf16, WS_CK);
    for (int wu = gw; wu < CMP_ROWS / 16; wu += NGW) {
        const int row0 = wu * 16, j = row0 / CMP_ROWS_J, rj = (row0 % CMP_ROWS_J) + r, row = row0 + r;
        const bool valid = (rj < 32768) ? ((rj & 511) < 511) : (((rj - 32768) & 255) < 255);
        const bf16* W2T = WSP(bf16, WS_SMALLW + SW_W2T) + (size_t)(l * 2 + j) * 64 * 128; const float* CB = WSP(float, WS_SMALLW + SW_CB) + (l * 2 + j) * 128;
        f32x4 acc[4];
#pragma unroll
        for (int ct = 0; ct < 4; ++ct) acc[ct] = (f32x4){0.f, 0.f, 0.f, 0.f};
#pragma unroll
        for (int ks = 0; ks < 4; ++ks) {
            const int h0 = 32 * ks + 8 * g; f32x4 a0, a1, b0, b1;
            unpack8(*(const v4u*)(LH + (size_t)row * 256 + h0), a0, a1); unpack8(*(const v4u*)(LH + (size_t)(row + 1) * 256 + 128 + h0), b0, b1);
            const f32x4 c0 = *(const f32x4*)(CB + h0), c1 = *(const f32x4*)(CB + h0 + 4);
            f32x4 x0 = a0 + b0 + c0, x1 = a1 + b1 + c1;
#pragma unroll
            for (int i = 0; i < 4; ++i) { x0[i] = gelu_tanh(x0[i]); x1[i] = gelu_tanh(x1[i]); }
            const bf16x8 hf = __builtin_bit_cast(bf16x8, pack8(x0, x1));
#pragma unroll
            for (int ct = 0; ct < 4; ++ct) { const bf16x8 wf = *(const bf16x8*)(W2T + (size_t)(16 * ct + r) * 128 + h0); acc[ct] = mfma16(wf, hf, acc[ct]); }
        }
#pragma unroll
        for (int ct = 0; ct < 4; ++ct) { const f32x4 v = valid ? acc[ct] : (f32x4){0.f, 0.f, 0.f, 0.f}; v2u w; w.x = pk2(v[0], v[1]); w.y = pk2(v[2], v[3]);
            *(v2u*)(CK + (size_t)row * 64 + 16 * ct + 4 * g) = w; }
    }
}

constexpr int CG_RS = 144, CG_BUF = 256 * CG_RS, CG_AW = 2 * CG_BUF;
__device__ __forceinline__ void cmp_gemm_unit(Frame& F, int l, int pm) {
    const int tid = F.tid, lane = F.lane, w = F.wave, q = lane & 31, h_ = lane >> 5;
    const int j = pm / 136, r = pm % 136; const bool smp = r < 128;
    const int grp = smp ? (r >> 1) : (r - 128), n0 = (smp ? (r & 1) * 256 : 0) + 32 * w;
    const float* rp[8]; const bf16* ab = nullptr;
    if (smp) { const int db = grp >> 1, k = grp & 1;
#pragma unroll
        for (int i = 0; i < 8; ++i) { const int tt0 = (n0 + 4 * i + (lane >> 4)) * 16; const int page = ((const int*)F.a->in[I_PT])[db * NPG + (tt0 >> 7)];
            rp[i] = FIN(I_CACHE) + (((((size_t)l * NPHYS + page) * PAGE + (tt0 & 127)) * 4 + j) * 2 + k) * 64 + (lane & 15) * 4; } }
    else { ab = WSP(bf16, WS_ACMP) + ((size_t)(l * 2 + j) * CMP_ROWS_J + 32768 + grp * 256 + n0 + q) * 1024 + 8 * h_;
#pragma unroll
        for (int i = 0; i < 8; ++i) rp[i] = nullptr; }
    const bf16* Bg = WSP(bf16, WS_SMALLW + SW_W1T) + (size_t)(l * 2 + j) * 256 * 1024;
    f32x16 acc[8];
#pragma unroll
    for (int ct = 0; ct < 8; ++ct) acc[ct] = (f32x16){};
    const bf16* bsrc = Bg + (size_t)(tid >> 1) * 1024 + (tid & 1) * 32; LAS unsigned char* bdst = F.lds + (tid >> 1) * CG_RS + (tid & 1) * 64;
    LAS unsigned char* Aw = F.lds + CG_AW + w * 32 * CG_RS;
    v4u bst[4]; f32x4 an[8]; v4u anb[4];
    __syncthreads();
#pragma unroll
    for (int x = 0; x < 4; ++x) bst[x] = *(const v4u*)(bsrc + 8 * x);
#pragma unroll
    for (int x = 0; x < 4; ++x) *(LAS v4u*)(bdst + x * 16) = bst[x];
    if (smp) {
#pragma unroll
        for (int i = 0; i < 8; ++i) an[i] = *(const f32x4*)(rp[i]); }
    else {
#pragma unroll
        for (int ks = 0; ks < 4; ++ks) anb[ks] = *(const v4u*)(ab + ks * 16); }
    __syncthreads();
#pragma unroll 1
    for (int kc = 0; kc < 16; ++kc) {
        bf16x8 ac[4];
        if (smp) {
#pragma unroll
            for (int i = 0; i < 8; ++i) { v2u o; o.x = pk2(an[i][0], an[i][1]); o.y = pk2(an[i][2], an[i][3]); *(LAS v2u*)(Aw + (4 * i + (lane >> 4)) * CG_RS + (lane & 15) * 8) = o; }
            LDS_WAIT(); asm volatile("" ::: "memory");
#pragma unroll
            for (int ks = 0; ks < 4; ++ks) ac[ks] = *(const LAS bf16x8*)(Aw + q * CG_RS + ks * 32 + 16 * h_);
        } else {
#pragma unroll
            for (int ks = 0; ks < 4; ++ks) ac[ks] = __builtin_bit_cast(bf16x8, anb[ks]); }
        if (kc + 1 < 16) {
#pragma unroll
            for (int x = 0; x < 4; ++x) bst[x] = *(const v4u*)(bsrc + (kc + 1) * 64 + 8 * x);
            if (smp) {
#pragma unroll
                for (int i = 0; i < 8; ++i) an[i] = *(const f32x4*)(rp[i] + (size_t)(kc + 1) * 512); }
            else {
#pragma unroll
                for (int ks = 0; ks < 4; ++ks) anb[ks] = *(const v4u*)(ab + (kc + 1) * 64 + ks * 16); }
        }
        const LAS unsigned char* bb = F.lds + (kc & 1) * CG_BUF + q * CG_RS + 16 * h_;
#pragma unroll
        for (int ks = 0; ks < 4; ++ks)
#pragma unroll
            for (int ct = 0; ct < 8; ++ct) { const bf16x8 bf = *(const LAS bf16x8*)(bb + ct * 32 * CG_RS + ks * 32); acc[ct] = mfma32(bf, ac[ks], acc[ct]); }
        if (kc + 1 < 16) {
#pragma unroll
            for (int x = 0; x < 4; ++x) *(LAS v4u*)(bdst + ((kc + 1) & 1) * CG_BUF + x * 16) = bst[x]; }
        __syncthreads();
    }
    bf16* LH = WSP(bf16, WS_LH) + ((size_t)pm * 256 + 32 * w + q) * 256;
#pragma unroll
    for (int ct = 0; ct < 8; ++ct)
#pragma unroll
        for (int r4 = 0; r4 < 4; ++r4) { v2u o; o.x = pk2(acc[ct][4 * r4 + 0], acc[ct][4 * r4 + 1]); o.y = pk2(acc[ct][4 * r4 + 2], acc[ct][4 * r4 + 3]); *(v2u*)(LH + ct * 32 + 8 * r4 + 4 * h_) = o; }
}

constexpr int RS_KV = 272;
__device__ __forceinline__ void ret_local_unit(Frame& F, int unit) {
    const int bh = unit >> 5, c = unit & 31, b = bh >> 2, h = bh & 3, lane = F.lane, w = F.wave;
    const float lg = ret_log_g(h);
    LAS unsigned char* KS = F.lds; LAS unsigned char* VS = F.lds + 128 * RS_KV;
    const bf16* RK = WSP(bf16, WS_RQ) + (size_t)MT * 512; const bf16* RV = WSP(bf16, WS_RQ) + (size_t)2 * MT * 512;
    __syncthreads();
#pragma unroll
    for (int i = 0; i < 4; ++i) { const int p = F.tid + NTHR * i, j = p >> 4, ch = p & 15; const size_t go = (size_t)(b * PT + 128 * c + j) * 512 + h * 128 + ch * 8;
        f32x4 k0, k1; unpack8(*(const v4u*)(RK + go), k0, k1); const float kw = fexp((float)(127 - j) * lg);
        *(LAS v4u*)(KS + j * RS_KV + ch * 16) = pack8(k0 * kw, k1 * kw);
        *(LAS v4u*)(VS + j * RS_KV + ch * 16) = *(const v4u*)(RV + go); }
    __syncthreads();
    const int et = w >> 1, dt0 = 2 * (w & 1), h_ = lane >> 5, blk = (lane >> 4) & 1;
    f32x16 acc[2]; acc[0] = (f32x16){}; acc[1] = (f32x16){};
#pragma unroll
    for (int ks = 0; ks < 8; ++ks) {
        const int rA = 16 * ks + 8 * h_;
        const bf16x8 af = tr_frag(VS, RS_KV, rA, rA + 4, 32 * et + 16 * blk, lane);
#pragma unroll
        for (int dd = 0; dd < 2; ++dd) { const bf16x8 bfr = tr_frag(KS, RS_KV, rA, rA + 4, 32 * (dt0 + dd) + 16 * blk, lane); acc[dd] = mfma32(af, bfr, acc[dd]); }
    }
    float* LT = WSP(float, WS_LT) + ((size_t)bh * 32 + c) * 16384;
#pragma unroll
    for (int dd = 0; dd < 2; ++dd)
#pragma unroll
        for (int r = 0; r < 16; ++r) { const int e = 32 * et + (r & 3) + 8 * (r >> 2) + 4 * h_; LT[e * 128 + 32 * (dt0 + dd) + (lane & 31)] = acc[dd][r]; }
}
__device__ __forceinline__ void ret_scan_phase(Frame& F, int l) {
    const float* LT = WSP(float, WS_LT); bf16* SPT = WSP(bf16, WS_SPT);
    for (int idx = F.bid * NTHR + F.tid; idx < 16 * 16384; idx += F.G * NTHR) {
        const int bh = idx >> 14, ed = idx & 16383, e = ed >> 7, d = ed & 127, h = bh & 3; const float g128 = fexp(128.0f * ret_log_g(h));
        float S = 0.f;
        for (int c = 0; c < 32; ++c) { const size_t o = ((size_t)bh * 32 + c) * 16384 + ed; SPT[o] = (bf16)(pk2(S, 0.f) & 0xffffu); S = S * g128 + LT[o]; }
        F.out[OUT_RET_P + ((size_t)l * 16 + bh) * 16384 + d * 128 + e] = S;
    }
}
__device__ __forceinline__ void ret_out_unit(Frame& F, int l, int unit) {
    const int bh = unit >> 5, c = unit & 31, b = bh >> 2, h = bh & 3, lane = F.lane, w = F.wave, tid = F.tid;
    const float lg = ret_log_g(h);
    LAS unsigned char* KS = F.lds; LAS unsigned char* VS = F.lds + 128 * RS_KV; LAS float* OT = (LAS float*)F.lds; LAS float* STAT = (LAS float*)(F.lds + 2 * 128 * RS_KV);
    const bf16* RQ = WSP(bf16, WS_RQ); const bf16* RK = RQ + (size_t)MT * 512; const bf16* RV = RQ + (size_t)2 * MT * 512; const bf16* RG = RQ + (size_t)3 * MT * 512;
    const size_t row0 = (size_t)b * PT + 128 * c;
    __syncthreads();
#pragma unroll
    for (int i = 0; i < 4; ++i) { const int p = tid + NTHR * i, j = p >> 4, ch = p & 15; const size_t go = (row0 + j) * 512 + h * 128 + ch * 8;
        *(LAS v4u*)(KS + j * RS_KV + ch * 16) = *(const v4u*)(RK + go); *(LAS v4u*)(VS + j * RS_KV + ch * 16) = *(const v4u*)(RV + go); }
    const int it = w & 3, eh = w >> 2, h_ = lane >> 5, blk = (lane >> 4) & 1, il = 32 * it + (lane & 31);
    bf16x8 qf[8];
#pragma unroll
    for (int ks = 0; ks < 8; ++ks) qf[ks] = *(const bf16x8*)(RQ + (row0 + il) * 512 + h * 128 + 16 * ks + 8 * h_);
    f32x16 acc[2]; acc[0] = (f32x16){}; acc[1] = (f32x16){};
    const bf16* SP = WSP(bf16, WS_SPT) + ((size_t)bh * 32 + c) * 16384;
#pragma unroll
    for (int kb4 = 0; kb4 < 8; kb4 += 4) {
        bf16x8 af[4][2];
#pragma unroll
        for (int ks = 0; ks < 4; ++ks)
#pragma unroll
            for (int e2 = 0; e2 < 2; ++e2) af[ks][e2] = *(const bf16x8*)(SP + (size_t)(32 * (2 * eh + e2) + (lane & 31)) * 128 + 16 * (kb4 + ks) + 8 * h_);
#pragma unroll
        for (int ks = 0; ks < 4; ++ks)
#pragma unroll
            for (int e2 = 0; e2 < 2; ++e2) acc[e2] = mfma32(af[ks][e2], qf[kb4 + ks], acc[e2]);
    }
    { const float cr = fexp((float)(il + 1) * lg); acc[0] *= cr; acc[1] *= cr; }
    __syncthreads();
    for (int jt = 0; jt <= it; ++jt) {
        f32x16 s = (f32x16){};
#pragma unroll
        for (int ks = 0; ks < 8; ++ks) { const bf16x8 kf = *(const LAS bf16x8*)(KS + (32 * jt + (lane & 31)) * RS_KV + (16 * ks + 8 * h_) * 2); s = mfma32(kf, qf[ks], s); }
#pragma unroll
        for (int r = 0; r < 16; ++r) { const int j = 32 * jt + (r & 3) + 8 * (r >> 2) + 4 * h_; const int df = il - j; s[r] = (df >= 0) ? s[r] * fexp((float)df * lg) : 0.f; }
#pragma unroll
        for (int s2 = 0; s2 < 2; ++s2) { const bf16x8 pf = cvt_frag(s, s2); const int rA = 32 * jt + 16 * s2 + 4 * h_;
#pragma unroll
            for (int e2 = 0; e2 < 2; ++e2) { const bf16x8 vf = tr_frag(VS, RS_KV, rA, rA + 8, 32 * (2 * eh + e2) + 16 * blk, lane); acc[e2] = mfma32(vf, pf, acc[e2]); } }
    }
    float s1 = 0.f, s2 = 0.f;
#pragma unroll
    for (int e2 = 0; e2 < 2; ++e2)
#pragma unroll
        for (int r = 0; r < 16; ++r) { const float v = acc[e2][r]; s1 += v; s2 += v * v; }
    s1 += __shfl_xor(s1, 32); s2 += __shfl_xor(s2, 32);
    if (lane < 32) { STAT[(w * 32 + lane) * 2] = s1; STAT[(w * 32 + lane) * 2 + 1] = s2; }
    __syncthreads();
    { const int pw = w ^ 4; s1 += STAT[(pw * 32 + (lane & 31)) * 2]; s2 += STAT[(pw * 32 + (lane & 31)) * 2 + 1]; }
    const float mean = s1 * (1.0f / 128.0f), var = fmaxf(s2 * (1.0f / 128.0f) - mean * mean, 0.f), rstd = 1.0f / sqrtf(var + EPS);
#pragma unroll
    for (int e2 = 0; e2 < 2; ++e2)
#pragma unroll
        for (int r4 = 0; r4 < 4; ++r4) { const int e = 32 * (2 * eh + e2) + 8 * r4 + 4 * h_;
            f32x4 v; v[0] = (acc[e2][4 * r4 + 0] - mean) * rstd; v[1] = (acc[e2][4 * r4 + 1] - mean) * rstd; v[2] = (acc[e2][4 * r4 + 2] - mean) * rstd; v[3] = (acc[e2][4 * r4 + 3] - mean) * rstd;
            *(LAS f32x4*)(OT + il * 132 + e) = v; }
    __syncthreads();
    const float* GN = FIN(I_GNG) + l * 512 + h * 128; bf16* OR_ = WSP(bf16, WS_OA) + (size_t)MT * 512;
#pragma unroll
    for (int k = 0; k < 4; ++k) { const int q = tid + NTHR * k, i = q >> 4, ch = q & 15;
        const f32x4 o0 = *(const LAS f32x4*)(OT + i * 132 + 8 * ch), o1 = *(const LAS f32x4*)(OT + i * 132 + 8 * ch + 4);
        const f32x4 g0 = *(const f32x4*)(GN + 8 * ch), g1 = *(const f32x4*)(GN + 8 * ch + 4); f32x4 r0, r1; unpack8(*(const v4u*)(RG + (row0 + i) * 512 + h * 128 + 8 * ch), r0, r1);
        f32x4 y0, y1;
#pragma unroll
        for (int x = 0; x < 4; ++x) { y0[x] = o0[x] * g0[x] * siluf_(r0[x]); y1[x] = o1[x] * g1[x] * siluf_(r1[x]); }
        *(v4u*)(OR_ + (row0 + i) * 512 + h * 128 + 8 * ch) = pack8(y0, y1); }
}
__device__ __forceinline__ void ret_sample_unit(Frame& F, int l, int unit) {
    const int db = unit >> 2, h = unit & 3, tid = F.tid, e = tid & 127, dp = tid >> 7;
    const float lg = ret_log_g(h);
    LAS float* Q = (LAS float*)F.lds; LAS float* K = Q + 1024; LAS float* V = K + 1024; LAS float* GT = V + 1024; LAS float* CR = GT + 1024;
    LAS float* SC = CR + 4096; LAS float* RED = SC + 64;
    const bf16* RQ = WSP(bf16, WS_RQ); const size_t row0 = (size_t)PM + db * 8;
    __syncthreads();
    for (int i = tid; i < 4096; i += NTHR) { const int which = i >> 10, r = (i >> 7) & 7, d = i & 127; const float v = bf1(RQ[(size_t)which * MT * 512 + (row0 + r) * 512 + h * 128 + d]); Q[which * 1024 + r * 128 + d] = v; }
    __syncthreads();
    const float* S0 = FIN(I_SRET) + (((size_t)l * SB + db) * 4 + h) * 16384; float* SN = F.out + OUT_RET_S + (((size_t)l * SB + db) * 4 + h) * 16384;
    float kwv[8], cr[8];
#pragma unroll
    for (int j = 0; j < 8; ++j) { kwv[j] = V[j * 128 + e] * fexp((float)(7 - j) * lg); cr[j] = 0.f; }
    const float g8 = fexp(8.0f * lg);
    for (int d = dp * 32; d < dp * 32 + 32; ++d) {
        const float s0 = S0[d * 128 + e]; float sn = g8 * s0;
#pragma unroll
        for (int j = 0; j < 8; ++j) { cr[j] += Q[j * 128 + d] * s0; sn += K[j * 128 + d] * kwv[j]; }
        SN[d * 128 + e] = sn;
    }
#pragma unroll
    for (int i = 0; i < 8; ++i) CR[(dp * 8 + i) * 128 + e] = cr[i];
    if (tid < 64) { const int i = tid >> 3, j = tid & 7; float s = 0.f; if (j <= i) { for (int d = 0; d < 128; ++d) s += Q[i * 128 + d] * K[j * 128 + d]; s *= fexp((float)(i - j) * lg); } SC[tid] = s; }
    __syncthreads();
    float o[2];
#pragma unroll
    for (int ii = 0; ii < 2; ++ii) { const int i = 2 * dp + ii; float x = (CR[(0 * 8 + i) * 128 + e] + CR[(1 * 8 + i) * 128 + e] + CR[(2 * 8 + i) * 128 + e] + CR[(3 * 8 + i) * 128 + e]) * fexp((float)(i + 1) * lg);
        for (int j = 0; j <= i; ++j) x += SC[i * 8 + j] * V[j * 128 + e];
        o[ii] = x; }
#pragma unroll
    for (int ii = 0; ii < 2; ++ii) { const float a = wave_sum(o[ii]), q = wave_sum(o[ii] * o[ii]); if (F.lane == 0) { RED[(F.wave * 2 + ii) * 2] = a; RED[(F.wave * 2 + ii) * 2 + 1] = q; } }
    __syncthreads();
    const float* GN = FIN(I_GNG) + l * 512 + h * 128; bf16* OR_ = WSP(bf16, WS_OA) + (size_t)MT * 512;
#pragma unroll
    for (int ii = 0; ii < 2; ++ii) { const int i = 2 * dp + ii, w0 = 2 * dp; const float s1 = RED[(w0 * 2 + ii) * 2] + RED[((w0 + 1) * 2 + ii) * 2], s2 = RED[(w0 * 2 + ii) * 2 + 1] + RED[((w0 + 1) * 2 + ii) * 2 + 1];
        const float mean = s1 * (1.0f / 128.0f), var = fmaxf(s2 * (1.0f / 128.0f) - mean * mean, 0.f), rstd = 1.0f / sqrtf(var + EPS);
        const float y = (o[ii] - mean) * rstd * GN[e] * siluf_(GT[i * 128 + e]);
        OR_[(row0 + i) * 512 + h * 128 + e] = (bf16)(pk2(y, 0.f) & 0xffffu); }
}

template <int MODE> __device__ __forceinline__ void rglru_unit(Frame& F, int l, int unit) {
    const int tid = F.tid, c = tid, lane = F.lane, w = F.wave;
    LAS bf16* XC = (LAS bf16*)F.lds; LAS float* G = (LAS float*)(F.lds + 16384);
    const int seq = (MODE == 2) ? unit : (unit >> 6), tile = (MODE == 2) ? 0 : (unit & 63);
    const size_t row0 = (MODE == 2) ? (size_t)PM + seq * 8 : (size_t)seq * PT + tile * 64;
    const int ntok = (MODE == 2) ? 8 : 64, nsub = (MODE == 2) ? 1 : 4;
    const float* RX = WSP(float, WS_RX);
    const float w0 = FIN(I_RCW)[(l * 4 + 0) * 512 + c], w1 = FIN(I_RCW)[(l * 4 + 1) * 512 + c], w2 = FIN(I_RCW)[(l * 4 + 2) * 512 + c], w3 = FIN(I_RCW)[(l * 4 + 3) * 512 + c], cb = FIN(I_RCB)[l * 512 + c];
    const float ba = FIN(I_RBA)[l * 512 + c], bx = FIN(I_RBX)[l * 512 + c], sp = WSP(float, WS_SMALLW + SW_SP)[l * 512 + c];
    float x3, x2, x1;
    if (MODE == 2) { const float* cv = FIN(I_SCONV) + ((size_t)l * SB + seq) * 3 * 512; x3 = cv[c]; x2 = cv[512 + c]; x1 = cv[1024 + c]; }
    else if (tile == 0) { x3 = 0.f; x2 = 0.f; x1 = 0.f; }
    else { x3 = RX[(row0 - 3) * 512 + c]; x2 = RX[(row0 - 2) * 512 + c]; x1 = RX[(row0 - 1) * 512 + c]; }
    float h = (MODE == 0) ? 0.f : (MODE == 1) ? WSP(float, WS_CAR)[(size_t)4 * 64 * 2 * 512 + ((size_t)seq * 64 + tile) * 512 + c] : FIN(I_SH)[((size_t)l * SB + seq) * 512 + c];
    float aprod = 1.f;
    const int r16 = lane & 15, g4 = lane >> 4;
    bf16x8 wa[4][2], wx[4][2];
    { const bf16* WA = WSP(bf16, WS_SMALLW + SW_WAT) + ((size_t)(l * 2 + 0) * 8 + w) * 4096; const bf16* WX = WSP(bf16, WS_SMALLW + SW_WAT) + ((size_t)(l * 2 + 1) * 8 + w) * 4096;
#pragma unroll
      for (int ct = 0; ct < 4; ++ct)
#pragma unroll
          for (int ks = 0; ks < 2; ++ks) { wa[ct][ks] = *(const bf16x8*)(WA + (16 * ct + r16) * 64 + 32 * ks + 8 * g4); wx[ct][ks] = *(const bf16x8*)(WX + (16 * ct + r16) * 64 + 32 * ks + 8 * g4); } }
    const bf16* GG = WSP(bf16, WS_GG); bf16* OC = WSP(bf16, WS_OA) + (size_t)2 * MT * 512;
    __syncthreads();
    float xn[16]; bf16 gn[16];
#pragma unroll
    for (int tt = 0; tt < 16; ++tt) { xn[tt] = (tt < ntok) ? RX[(row0 + tt) * 512 + c] : 0.f; gn[tt] = (MODE != 0 && tt < ntok) ? GG[(row0 + tt) * 512 + c] : (bf16)0; }
    for (int s = 0; s < nsub; ++s) {
        float xc[16], gg[16];
#pragma unroll
        for (int tt = 0; tt < 16; ++tt) { xc[tt] = xn[tt]; gg[tt] = bf1(gn[tt]); }
        if (s + 1 < nsub) {
#pragma unroll
            for (int tt = 0; tt < 16; ++tt) { const int t = (s + 1) * 16 + tt; xn[tt] = RX[(row0 + t) * 512 + c]; gn[tt] = (MODE != 0) ? GG[(row0 + t) * 512 + c] : (bf16)0; } }
#pragma unroll
        for (int tt = 0; tt < 16; ++tt) { const float x0 = xc[tt];
            xc[tt] = cb + w0 * x3 + w1 * x2 + w2 * x1 + w3 * x0; x3 = x2; x2 = x1; x1 = x0; XC[tt * 512 + c] = (bf16)(pk2(xc[tt], 0.f) & 0xffffu); }
        LDS_WAIT(); asm volatile("" ::: "memory");
        {
            bf16x8 xf[2];
#pragma unroll
            for (int ks = 0; ks < 2; ++ks) xf[ks] = *(const LAS bf16x8*)(XC + r16 * 512 + w * 64 + 32 * ks + 8 * g4);
#pragma unroll
            for (int ct = 0; ct < 4; ++ct) { f32x4 da = (f32x4){0.f, 0.f, 0.f, 0.f}, dx = da;
#pragma unroll
                for (int ks = 0; ks < 2; ++ks) { da = mfma16(wa[ct][ks], xf[ks], da); dx = mfma16(wx[ct][ks], xf[ks], dx); }
                *(LAS f32x4*)(G + r16 * 512 + w * 64 + 16 * ct + 4 * g4) = da; *(LAS f32x4*)(G + 8192 + r16 * 512 + w * 64 + 16 * ct + 4 * g4) = dx; }
        }
        LDS_WAIT(); asm volatile("" ::: "memory");
#pragma unroll
        for (int tt = 0; tt < 16; ++tt) { const int t = s * 16 + tt;
            if (t < ntok) {
                const float r = sigmoidf_(G[tt * 512 + c] + ba), ig = sigmoidf_(G[8192 + tt * 512 + c] + bx);
                const float la = -8.0f * r * sp, a = fexp(la), bt = sqrtf(fmaxf(1.0f - a * a, 0.f)) * (ig * xc[tt]);
                h = a * h + bt; aprod *= a;
                if (MODE != 0) { const size_t o = (row0 + t) * 512 + c; OC[o] = (bf16)(pk2(h * gg[tt], 0.f) & 0xffffu); }
            } }
    }
    if (MODE == 0) { float* CAR = WSP(float, WS_CAR) + ((size_t)seq * 64 + tile) * 1024; CAR[c] = aprod; CAR[512 + c] = h; }
    if (MODE == 2) F.out[OUT_H_S + ((size_t)l * SB + seq) * 512 + c] = h;
}
__device__ __forceinline__ void rglru_carry_phase(Frame& F, int l) {
    const float* CAR = WSP(float, WS_CAR); float* HIN = WSP(float, WS_CAR) + (size_t)4 * 64 * 2 * 512;
    for (int idx = F.bid * NTHR + F.tid; idx < PB * 512; idx += F.G * NTHR) {
        const int b = idx >> 9, c = idx & 511; float h = 0.f;
        for (int t = 0; t < 64; ++t) { HIN[((size_t)b * 64 + t) * 512 + c] = h; const float* cr = CAR + ((size_t)b * 64 + t) * 1024; h = cr[c] * h + cr[512 + c]; }
        F.out[OUT_H_P + ((size_t)l * PB + b) * 512 + c] = h;
    }
}

__device__ __forceinline__ void convact_phase(Frame& F, int l) {
    const bf16* GP = WSP(bf16, WS_GP); const bf16* VAL = GP + (size_t)MT * DFF; bf16* ACT = WSP(bf16, WS_GP) + (size_t)2 * MT * DFF;
    const float* CW = FIN(I_FCW) + (size_t)l * 3 * DFF; const float* CBI = FIN(I_FCB) + (size_t)l * DFF;
    constexpr int NRUN = PM / 16 + SB, NCG = DFF / 8;
    for (int it = F.bid * NTHR + F.tid; it < NRUN * NCG; it += F.G * NTHR) {
        const int run = it / NCG, cg = it % NCG, c = cg * 8;
        const bool isp = run < PM / 16; const size_t row0 = isp ? (size_t)run * 16 : (size_t)PM + (run - PM / 16) * 8; const int nt = isp ? 16 : 8;
        f32x4 p2a, p2b, p1a, p1b;
        if (isp) { if ((run & 255) == 0) { p2a = p2b = p1a = p1b = (f32x4){0.f, 0.f, 0.f, 0.f}; } else { unpack8(*(const v4u*)(GP + (row0 - 2) * DFF + c), p2a, p2b); unpack8(*(const v4u*)(GP + (row0 - 1) * DFF + c), p1a, p1b); } }
        else { const float* st = FIN(I_SFFN) + (((size_t)l * SB + (run - PM / 16)) * 2) * DFF + c; p2a = *(const f32x4*)st; p2b = *(const f32x4*)(st + 4); p1a = *(const f32x4*)(st + DFF); p1b = *(const f32x4*)(st + DFF + 4); }
        const f32x4 w0a = *(const f32x4*)(CW + c), w0b = *(const f32x4*)(CW + c + 4), w1a = *(const f32x4*)(CW + DFF + c), w1b = *(const f32x4*)(CW + DFF + c + 4), w2a = *(const f32x4*)(CW + 2 * DFF + c), w2b = *(const f32x4*)(CW + 2 * DFF + c + 4);
        const f32x4 ba = *(const f32x4*)(CBI + c), bb = *(const f32x4*)(CBI + c + 4);
        for (int t0 = 0; t0 < nt; t0 += 8) {
            v4u gx[8], vx[8];
#pragma unroll
            for (int k = 0; k < 8; ++k) { gx[k] = *(const v4u*)(GP + (row0 + t0 + k) * DFF + c); vx[k] = *(const v4u*)(VAL + (row0 + t0 + k) * DFF + c); }
#pragma unroll
            for (int k = 0; k < 8; ++k) {
                f32x4 xa, xb, va, vb; unpack8(gx[k], xa, xb); unpack8(vx[k], va, vb);
                f32x4 ya = ba + w0a * p2a + w1a * p1a + w2a * xa, yb = bb + w0b * p2b + w1b * p1b + w2b * xb;
#pragma unroll
                for (int i = 0; i < 4; ++i) { ya[i] = siluf_(ya[i]) * va[i]; yb[i] = siluf_(yb[i]) * vb[i]; }
                *(v4u*)(ACT + (row0 + t0 + k) * DFF + c) = pack8(ya, yb);
                p2a = p1a; p2b = p1b; p1a = xa; p1b = xb;
            }
        }
    }
}

constexpr int AT_RS = 144;
constexpr int AT_K0 = 0, AT_V0 = 2 * 64 * AT_RS, AT_PS = 4 * 64 * AT_RS, AT_IMP = AT_PS + 69632, AT_MASK = AT_IMP + 6144, AT_LIST = AT_MASK + 2048, AT_NL = AT_LIST + 1024;
constexpr unsigned AT_MARK = 0xFFFFu;
static_assert(AT_NL + 64 <= RING_BYTES, "attention LDS map");

struct TileRegs { v4u a, b, c, d; int mode; };

template <bool SMP> __device__ __forceinline__ void at_prefetch(const Frame& F, int l, int seq, int kvh, unsigned e, TileRegs& R) {
    const int kind = (int)(e >> 14), ti = (int)(e & 0x3fffu), rr = F.tid >> 3, pc = F.tid & 7;
    R.mode = 0;
    if (kind < 2) {
        const size_t rb = SMP ? (size_t)(seq * 2 + kvh) * 512 : (size_t)32768 + (size_t)(seq * 2 + kvh) * 256;
        const bf16* ck = WSP(bf16, WS_CK) + (rb + ti * 64 + rr) * 64 + pc * 8;
        R.a = *(const v4u*)ck; R.c = *(const v4u*)(ck + (size_t)CMP_ROWS_J * 64);
    } else if (!SMP) {
        const int jb = (kind == 2) ? 0 : 2;
        const bf16* kp = WSP(bf16, WS_KVB) + ((((size_t)jb * PB + seq) * 2 + kvh) * PT + ti * 64 + rr) * 64 + pc * 8;
        R.a = *(const v4u*)kp; R.c = *(const v4u*)(kp + (size_t)PB * 2 * PT * 64);
    } else if (kind == 2) {
        if (ti < 128) {
            const int page = ((const int*)F.a->in[I_PT])[seq * NPG + (ti >> 1)], slot = (ti & 1) * 64 + rr;
            const float* kp = FIN(I_CACHE) + (((((size_t)l * NPHYS + page) * PAGE + slot) * 4 + 2) * 2 + kvh) * 64 + pc * 8;
            R.a = *(const v4u*)kp; R.b = *(const v4u*)(kp + 4); R.c = *(const v4u*)(kp + 128); R.d = *(const v4u*)(kp + 132); R.mode = 1;
        } else if (rr < ST) {
            const bf16* kp = WSP(bf16, WS_KVS) + ((((size_t)0 * SB + seq) * 2 + kvh) * ST + rr) * 64 + pc * 8;
            R.a = *(const v4u*)kp; R.c = *(const v4u*)(kp + (size_t)SB * 2 * ST * 64);
        } else R.mode = 2;
    } else {
        if (ti < 8) {
            const float* kp = FIN(I_CWIN) + (((((size_t)l * SB + seq) * WINB + ti * 64 + rr) * 2 + 0) * 2 + kvh) * 64 + pc * 8;
            R.a = *(const v4u*)kp; R.b = *(const v4u*)(kp + 4); R.c = *(const v4u*)(kp + 128); R.d = *(const v4u*)(kp + 132); R.mode = 1;
        } else if (rr < ST) {
            const bf16* kp = WSP(bf16, WS_KVS) + ((((size_t)2 * SB + seq) * 2 + kvh) * ST + rr) * 64 + pc * 8;
            R.a = *(const v4u*)kp; R.c = *(const v4u*)(kp + (size_t)SB * 2 * ST * 64);
        } else R.mode = 2;
    }
}
__device__ __forceinline__ void at_store(const Frame& F, int buf, const TileRegs& R) {
    const int rr = F.tid >> 3, pc = F.tid & 7; v4u k, v;
    if (R.mode == 0) { k = R.a; v = R.c; }
    else if (R.mode == 1) { k = pack8(__builtin_bit_cast(f32x4, R.a), __builtin_bit_cast(f32x4, R.b)); v = pack8(__builtin_bit_cast(f32x4, R.c), __builtin_bit_cast(f32x4, R.d)); }
    else { k = (v4u){0u, 0u, 0u, 0u}; v = k; }
    *(LAS v4u*)(F.lds + AT_K0 + buf * 64 * AT_RS + rr * AT_RS + pc * 16) = k;
    *(LAS v4u*)(F.lds + AT_V0 + buf * 64 * AT_RS + rr * AT_RS + pc * 16) = v;
}

template <bool SMP> __device__ __forceinline__ void attn_unit(Frame& F, int l, int unit) {
    const int tid = F.tid, lane = F.lane, w = F.wave;
    const int q = lane & 31, h_ = lane >> 5, blk = (lane >> 4) & 1, tl = q >> 2, hr = q & 3;
    int seq, kvh, qt;
    if (SMP) { seq = unit >> 1; kvh = unit & 1; qt = 128; } else { seq = unit >> 7; kvh = (unit >> 6) & 1; qt = unit & 63; }
    const int t0 = SMP ? PAST : qt * 64;
    const int tokl = SMP ? tl : 8 * w + tl, t = t0 + tokl;
    const size_t row = SMP ? (size_t)PM + seq * ST + tl : (size_t)seq * PT + t;
    const int head = kvh * 4 + hr;
    LAS float* PS = (LAS float*)(F.lds + AT_PS); LAS float* IMPw = (LAS float*)(F.lds + AT_IMP) + w * 192;
    LAS unsigned long long* MASKS = (LAS unsigned long long*)(F.lds + AT_MASK); LAS unsigned short* LIST = (LAS unsigned short*)(F.lds + AT_LIST); LAS int* NL = (LAS int*)(F.lds + AT_NL);
    constexpr int PSS = SMP ? 520 : 264;
    LAS float* PSw = SMP ? PS : PS + w * 8 * PSS;
    __syncthreads();
    bf16x8 qf[4];
    { const bf16* qp = WSP(bf16, WS_QN) + row * 512 + head * 64 + 8 * h_;
#pragma unroll
      for (int kk = 0; kk < 4; ++kk) qf[kk] = *(const bf16x8*)(qp + 16 * kk); }
    const float* ngp = WSP(float, WS_NG) + row * 24 + head * 3; const float g0 = ngp[0], g1 = ngp[1], g2 = ngp[2];
    if (!SMP) { for (int i = lane; i < 8 * PSS; i += 64) PSw[i] = 0.f; }
    const int ntc = SMP ? 8 : ((t0 + 32) >> 10) + 1;
    if (tid < 2 * ntc) LIST[tid] = (unsigned short)(((tid >= ntc ? 1u : 0u) << 14) | (unsigned)(tid >= ntc ? tid - ntc : tid));
    if (tid == 0) LIST[2 * ntc] = (unsigned short)AT_MARK;
    int nl = 2 * ntc + 1;
    TileRegs R;
    at_prefetch<SMP>(F, l, seq, kvh, (unsigned)0, R);
    at_store(F, 0, R);
    __syncthreads();
    float m = -INFINITY, lsum = 0.f, invden = 0.f;
    f32x16 O[2]; O[0] = (f32x16){}; O[1] = (f32x16){};
    LAS float* OAw = (LAS float*)(F.lds + AT_PS) + w * (SMP ? 2048 : 8 * PSS) + lane;
    unsigned long long mk0 = 0ull, mk1 = 0ull, wu = ~0ull;
    int cur_kind = -1, idx = 0;
#define AT_FINALIZE(kind) do { \
        if ((kind) == 0) { const float lt = lsum + __shfl_xor(lsum, 32); invden = lt > 0.f ? 1.0f / lt : 0.f; } \
        else if ((kind) == 1) { const float sc = g0 * invden; O[0] *= sc; O[1] *= sc; } \
        else if ((kind) == 2) { const float lt = lsum + __shfl_xor(lsum, 32); const float sc = (lt > 0.f ? 1.0f / lt : 0.f) * g1; \
            _Pragma("unroll") for (int r_ = 0; r_ < 16; ++r_) { OAw[r_ * 64] += O[0][r_] * sc; OAw[(16 + r_) * 64] += O[1][r_] * sc; } } } while (0)
    while (idx < nl) {
        const unsigned e = (unsigned)__builtin_amdgcn_readfirstlane((int)LIST[idx]);
        if (e == AT_MARK) {
            AT_FINALIZE(cur_kind); cur_kind = -1;
            LDS_WAIT(); asm volatile("" ::: "memory");
#pragma unroll 1
            for (int tk = 0; tk < 8; ++tk) {
                const LAS float* pr = PSw + tk * PSS;
                if (!SMP) {
                    const int s = lane; float imp = 0.f;
#pragma unroll
                    for (int n = 4 * s - 1; n <= 4 * s + 3; ++n) if (n >= 0) imp += pr[n];
                    const bool forced = (s == 0) || (s == qt) || (s == qt - 1), avail = s <= qt;
                    const float val = avail ? (forced ? 1e4f : imp) : -1e4f;
                    IMPw[s] = val; LDS_WAIT(); asm volatile("" ::: "memory");
                    int rank = 0;
#pragma unroll 8
                    for (int i = 0; i < 64; ++i) { const float v = IMPw[i]; rank += (v > val || (v == val && i < s)) ? 1 : 0; }
                    const unsigned long long mk = __ballot(rank < 16);
                    if (lane == 0) MASKS[(8 * w + tk) * 4] = mk;
                    LDS_WAIT(); asm volatile("" ::: "memory");
                } else {
                    const int sa = lane, sb = lane + 64; float ia = 0.f, ib = 0.f;
#pragma unroll
                    for (int n = 4 * sa - 1; n <= 4 * sa + 3; ++n) if (n >= 0) ia += pr[n];
#pragma unroll
                    for (int n = 4 * sb - 1; n <= 4 * sb + 3; ++n) ib += pr[n];
                    const bool fa = (sa == 0), fb = (sb == 127);
                    const float va = fa ? 1e4f : ia, vb = fb ? 1e4f : ib;
                    IMPw[sa] = va; IMPw[sb] = vb; LDS_WAIT(); asm volatile("" ::: "memory");
                    int ra = fa ? 0 : 1, rb = fb ? 0 : 1;
#pragma unroll 8
                    for (int i = 0; i < 128; ++i) { const float v = IMPw[i]; ra += (v > va || (v == va && i < sa)) ? 1 : 0; rb += (v > vb || (v == vb && i < sb)) ? 1 : 0; }
                    const unsigned long long ma = __ballot(ra < 16), mb = __ballot(rb < 16);
                    if (lane == 0) { MASKS[tk * 4] = ma; MASKS[tk * 4 + 1] = mb; MASKS[tk * 4 + 2] = 1ull; }
                    LDS_WAIT(); asm volatile("" ::: "memory");
                }
            }
            __syncthreads();
#pragma unroll
            for (int r_ = 0; r_ < 16; ++r_) { OAw[r_ * 64] = O[0][r_]; OAw[(16 + r_) * 64] = O[1][r_]; }
            if (tid == 0) {
                int n = idx + 1;
                if (!SMP) { unsigned long long U = 0ull; for (int i = 0; i < 64; ++i) U |= MASKS[i * 4];
                    for (int s = 0; s <= qt; ++s) if ((U >> s) & 1ull) LIST[n++] = (unsigned short)((2u << 14) | (unsigned)s);
                    for (int s = (qt > 8 ? qt - 8 : 0); s <= qt; ++s) LIST[n++] = (unsigned short)((3u << 14) | (unsigned)s);
                } else { unsigned long long U0 = 0ull, U1 = 0ull; for (int i = 0; i < 8; ++i) { U0 |= MASKS[i * 4]; U1 |= MASKS[i * 4 + 1]; }
                    for (int s = 0; s < 64; ++s) if ((U0 >> s) & 1ull) LIST[n++] = (unsigned short)((2u << 14) | (unsigned)s);
                    for (int s = 0; s < 64; ++s) if ((U1 >> s) & 1ull) LIST[n++] = (unsigned short)((2u << 14) | (unsigned)(64 + s));
                    LIST[n++] = (unsigned short)((2u << 14) | 128u);
                    for (int s = 0; s <= 8; ++s) LIST[n++] = (unsigned short)((3u << 14) | (unsigned)s); }
                NL[0] = n;
            }
            __syncthreads();
            nl = __builtin_amdgcn_readfirstlane(NL[0]);
            mk0 = MASKS[tokl * 4]; if (SMP) { mk1 = MASKS[tokl * 4 + 1]; }
            if (!SMP) { unsigned long long u = 0ull; for (int i = 0; i < 8; ++i) u |= MASKS[(8 * w + i) * 4]; wu = u; }
            if (idx + 1 < nl) { at_prefetch<SMP>(F, l, seq, kvh, (unsigned)LIST[idx + 1], R); at_store(F, (idx + 1) & 1, R); }
            __syncthreads();
            ++idx; continue;
        }
        const int kind = (int)(e >> 14), ti = (int)(e & 0x3fffu);
        if (kind != cur_kind) {
            if (cur_kind >= 0) AT_FINALIZE(cur_kind);
            if (kind != 1) m = -INFINITY;
            lsum = 0.f; O[0] = (f32x16){}; O[1] = (f32x16){}; cur_kind = kind;
        }
        const unsigned en = (idx + 1 < nl) ? (unsigned)__builtin_amdgcn_readfirstlane((int)LIST[idx + 1]) : AT_MARK;
        const bool have_next = (en != AT_MARK);
        if (have_next) at_prefetch<SMP>(F, l, seq, kvh, en, R);
        bool active = true;
        if (!SMP && kind == 2) active = ((wu >> ti) & 1ull) != 0ull;
        if (active) {
            const LAS unsigned char* Kb = F.lds + AT_K0 + (idx & 1) * 64 * AT_RS; const LAS unsigned char* Vb = F.lds + AT_V0 + (idx & 1) * 64 * AT_RS;
            int lo, hi; const int kb = 64 * ti;
            if (kind < 2) { lo = 0; hi = SMP ? 510 : ((t >= 31) ? ((t - 31) >> 4) : -1); }
            else if (kind == 2) { lo = 0; const unsigned long long mw = (ti < 64) ? mk0 : ((ti < 128) ? mk1 : 1ull); hi = ((mw >> (ti & 63)) & 1ull) ? t : -1; }
            else { if (SMP) { lo = tl; hi = WINB + tl; } else { lo = t - WINB; hi = t; } }
            f32x16 s0 = (f32x16){}, s1 = (f32x16){};
#pragma unroll
            for (int kk = 0; kk < 4; ++kk) {
                const bf16x8 k0 = *(const LAS bf16x8*)(Kb + q * AT_RS + (16 * kk + 8 * h_) * 2), k1 = *(const LAS bf16x8*)(Kb + (32 + q) * AT_RS + (16 * kk + 8 * h_) * 2);
                s0 = mfma32(k0, qf[kk], s0); s1 = mfma32(k1, qf[kk], s1);
            }
            float tmax = -INFINITY;
#pragma unroll
            for (int r = 0; r < 16; ++r) { const int key = kb + (r & 3) + 8 * (r >> 2) + 4 * h_;
                s0[r] = (key >= lo && key <= hi) ? s0[r] : -INFINITY; s1[r] = (key + 32 >= lo && key + 32 <= hi) ? s1[r] : -INFINITY;
                tmax = fmaxf(tmax, fmaxf(s0[r], s1[r])); }
            tmax = fmaxf(tmax, __shfl_xor(tmax, 32));
            const float m_new = fmaxf(m, tmax), m_use = (m_new == -INFINITY) ? 0.f : m_new;
            const float alpha = fexp2(m - m_use);
            float ps = 0.f;
#pragma unroll
            for (int r = 0; r < 16; ++r) { s0[r] = fexp2(s0[r] - m_use); s1[r] = fexp2(s1[r] - m_use); ps += s0[r] + s1[r]; }
            lsum = lsum * alpha + ps; m = m_new;
            if (kind != 0) {
                O[0] *= alpha; O[1] *= alpha;
#pragma unroll
                for (int kt2 = 0; kt2 < 2; ++kt2)
#pragma unroll
                    for (int s2 = 0; s2 < 2; ++s2) { const bf16x8 pf = cvt_frag(kt2 ? s1 : s0, s2); const int rA = 32 * kt2 + 16 * s2 + 4 * h_;
#pragma unroll
                        for (int dt = 0; dt < 2; ++dt) { const bf16x8 vf = tr_frag(Vb, AT_RS, rA, rA + 8, 32 * dt + 16 * blk, lane); O[dt] = mfma32(vf, pf, O[dt]); } }
            }
            if (kind == 1) {
#pragma unroll
                for (int r = 0; r < 16; ++r) { const int n = kb + (r & 3) + 8 * (r >> 2) + 4 * h_;
                    float a = s0[r] * invden, b = s1[r] * invden; a += __shfl_xor(a, 1); b += __shfl_xor(b, 1); a += __shfl_xor(a, 2); b += __shfl_xor(b, 2);
                    if (hr == 0) { PSw[tl * PSS + n] = a; PSw[tl * PSS + n + 32] = b; } }
            }
        }
        if (have_next) at_store(F, (idx + 1) & 1, R);
        __syncthreads();
        ++idx;
    }
#undef AT_FINALIZE
    {
        const float lt = lsum + __shfl_xor(lsum, 32); const float sc = (lt > 0.f ? 1.0f / lt : 0.f) * g2;
        if (!SMP || w == 0) {
            bf16* op = WSP(bf16, WS_OA) + row * 512 + head * 64;
#pragma unroll
            for (int dt = 0; dt < 2; ++dt)
#pragma unroll
                for (int r4 = 0; r4 < 4; ++r4) { float o_[4];
#pragma unroll
                    for (int x = 0; x < 4; ++x) o_[x] = OAw[(dt * 16 + 4 * r4 + x) * 64] + O[dt][4 * r4 + x] * sc;
                    v2u wv; wv.x = pk2(o_[0], o_[1]); wv.y = pk2(o_[2], o_[3]); *(v2u*)(op + 32 * dt + 8 * r4 + 4 * h_) = wv; }
        }
    }
}

constexpr int AS_RS = 144;
constexpr int AS_V = 0, AS_VW = 32 * AS_RS, AS_MRG = 0, AS_PS = 73728, AS_IMP = AS_PS + 16640, AS_MASK = AS_IMP + 6144;
static_assert(8 * 34 * 64 * 4 <= AS_PS && AS_MASK + 512 <= RING_BYTES, "sample attention LDS map");

__device__ __forceinline__ float xhalf_max(float x) { auto t_ = __builtin_amdgcn_permlane32_swap(__float_as_uint(x), __float_as_uint(x), false, false); return fmaxf(__uint_as_float(t_[0]), __uint_as_float(t_[1])); }
__device__ __forceinline__ float xhalf_sum(float x) { auto t_ = __builtin_amdgcn_permlane32_swap(__float_as_uint(x), __float_as_uint(x), false, false); return __uint_as_float(t_[0]) + __uint_as_float(t_[1]); }
struct ASrc { const float* kf; const float* vf; const bf16* kb; const bf16* vb; int rs; int nvalid; };
#define AS_TILE(SRC, KB0, LO_, HI_, DO_PV, DO_PS, m, lsum, O0, O1, invden, PSS_) do { \
        bf16x8 kfr[4]; \
        if ((SRC).kb) { const bf16* kp_ = (SRC).kb + (size_t)q * (SRC).rs + 8 * h_; _Pragma("unroll") for (int kk = 0; kk < 4; ++kk) kfr[kk] = *(const bf16x8*)(kp_ + 16 * kk); } \
        else { const float* kp_ = (SRC).kf + (size_t)q * (SRC).rs + 8 * h_; _Pragma("unroll") for (int kk = 0; kk < 4; ++kk) { const f32x4 a_ = *(const f32x4*)(kp_ + 16 * kk), b_ = *(const f32x4*)(kp_ + 16 * kk + 4); kfr[kk] = __builtin_bit_cast(bf16x8, pack8(a_, b_)); } } \
        if (DO_PV) { const int vr_ = lane >> 1, vh_ = lane & 1; v4u vv_[4]; \
            if (vr_ >= (SRC).nvalid) { _Pragma("unroll") for (int x = 0; x < 4; ++x) vv_[x] = (v4u){0u, 0u, 0u, 0u}; } \
            else if ((SRC).vb) { const bf16* vp_ = (SRC).vb + (size_t)vr_ * (SRC).rs + 32 * vh_; _Pragma("unroll") for (int x = 0; x < 4; ++x) vv_[x] = *(const v4u*)(vp_ + 8 * x); } \
            else { const float* vp_ = (SRC).vf + (size_t)vr_ * (SRC).rs + 32 * vh_; _Pragma("unroll") for (int x = 0; x < 4; ++x) vv_[x] = pack8(*(const f32x4*)(vp_ + 8 * x), *(const f32x4*)(vp_ + 8 * x + 4)); } \
            _Pragma("unroll") for (int x = 0; x < 4; ++x) *(LAS v4u*)(Vw + vr_ * AS_RS + vh_ * 64 + x * 16) = vv_[x]; } \
        f32x16 s_ = (f32x16){}; \
        _Pragma("unroll") for (int kk = 0; kk < 4; ++kk) s_ = mfma32(kfr[kk], qf[kk], s_); \
        float tmax_ = -INFINITY; \
        _Pragma("unroll") for (int r = 0; r < 16; ++r) { const int key_ = (KB0) + (r & 3) + 8 * (r >> 2) + 4 * h_; s_[r] = (key_ >= (LO_) && key_ <= (HI_)) ? s_[r] : -INFINITY; tmax_ = fmaxf(tmax_, s_[r]); } \
        tmax_ = xhalf_max(tmax_); \
        const float mn_ = fmaxf(m, tmax_), mu_ = (mn_ == -INFINITY) ? 0.f : mn_, al_ = fexp2(m - mu_); float ps_ = 0.f; \
        _Pragma("unroll") for (int r = 0; r < 16; ++r) { s_[r] = fexp2(s_[r] - mu_); ps_ += s_[r]; } \
        lsum = lsum * al_ + ps_; m = mn_; \
        if (DO_PV) { O0 *= al_; O1 *= al_; LDS_WAIT(); asm volatile("" ::: "memory"); \
            _Pragma("unroll") for (int s2 = 0; s2 < 2; ++s2) { const bf16x8 pf_ = cvt_frag(s_, s2); const int rA_ = 16 * s2 + 4 * h_; \
                O0 = mfma32(tr_frag(Vw, AS_RS, rA_, rA_ + 8, 16 * blk, lane), pf_, O0); O1 = mfma32(tr_frag(Vw, AS_RS, rA_, rA_ + 8, 32 + 16 * blk, lane), pf_, O1); } \
            LDS_WAIT(); asm volatile("" ::: "memory"); } \
        if (DO_PS) { _Pragma("unroll") for (int r = 0; r < 16; ++r) { const int n_ = (KB0) + (r & 3) + 8 * (r >> 2) + 4 * h_; float a_ = s_[r] * (invden); a_ += __shfl_xor(a_, 1); a_ += __shfl_xor(a_, 2); if (hr == 0) PS[tl * (PSS_) + n_] = a_; } } \
    } while (0)

__device__ __forceinline__ void attn_sample_unit(Frame& F, int l, int unit) {
    const int lane = F.lane, w = F.wave, tid = F.tid;
    const int q = lane & 31, h_ = lane >> 5, blk = (lane >> 4) & 1, tl = q >> 2, hr = q & 3;
    const int seq = unit >> 1, kvh = unit & 1, head = kvh * 4 + hr;
    const size_t row = (size_t)PM + seq * ST + tl;
    LAS unsigned char* Vw = F.lds + AS_V + w * AS_VW;
    LAS float* MRG = (LAS float*)(F.lds + AS_MRG);
    LAS float* PS = (LAS float*)(F.lds + AS_PS);
    LAS float* IMPw = (LAS float*)(F.lds + AS_IMP) + w * 192;
    LAS unsigned long long* MASKS = (LAS unsigned long long*)(F.lds + AS_MASK);
    __syncthreads();
    bf16x8 qf[4];
    { const bf16* qp = WSP(bf16, WS_QN) + row * 512 + head * 64 + 8 * h_;
#pragma unroll
      for (int kk = 0; kk < 4; ++kk) qf[kk] = *(const bf16x8*)(qp + 16 * kk); }
    const float* ngp = WSP(float, WS_NG) + row * 24 + head * 3; const float g0 = ngp[0], g1 = ngp[1], g2 = ngp[2];
    const int* ptab = (const int*)F.a->in[I_PT] + seq * NPG;
    f32x16 OA0 = (f32x16){}, OA1 = (f32x16){};

#define AS_PUBLISH(m, lsum, O0, O1) do { __syncthreads(); LAS float* mp_ = MRG + w * 34 * 64 + lane; mp_[0] = m; mp_[64] = lsum; \
        _Pragma("unroll") for (int r = 0; r < 16; ++r) { mp_[(2 + r) * 64] = O0[r]; mp_[(18 + r) * 64] = O1[r]; } __syncthreads(); } while (0)

    const bf16* CKk = WSP(bf16, WS_CK) + ((size_t)(seq * 2 + kvh) * 512) * 64; const bf16* CKv = CKk + (size_t)CMP_ROWS_J * 64;
    float mC = -INFINITY, lC = 0.f; f32x16 D0 = (f32x16){}, D1 = (f32x16){};
#pragma unroll 1
    for (int ti = w; ti < 16; ti += 8) { ASrc S{nullptr, nullptr, CKk + (size_t)ti * 32 * 64, CKv + (size_t)ti * 32 * 64, 64, 32}; AS_TILE(S, ti * 32, 0, 510, false, false, mC, lC, D0, D1, 0.f, 520); }
    { __syncthreads(); MRG[w * 128 + lane] = mC; MRG[w * 128 + 64 + lane] = xhalf_sum(lC); __syncthreads(); }
    float mT = -INFINITY;
#pragma unroll
    for (int x = 0; x < 8; ++x) mT = fmaxf(mT, MRG[x * 128 + lane]);
    float lT = 0.f;
#pragma unroll
    for (int x = 0; x < 8; ++x) { const float mx_ = MRG[x * 128 + lane]; lT += (mx_ == -INFINITY) ? 0.f : MRG[x * 128 + 64 + lane] * fexp2(mx_ - mT); }
    const float invC = lT > 0.f ? 1.0f / lT : 0.f;
    __syncthreads();
    { float mB = mT, lB = 0.f;
#pragma unroll 1
      for (int ti = w; ti < 16; ti += 8) { ASrc S{nullptr, nullptr, CKk + (size_t)ti * 32 * 64, CKv + (size_t)ti * 32 * 64, 64, 32}; AS_TILE(S, ti * 32, 0, 510, true, true, mB, lB, D0, D1, invC, 520); }
      AS_PUBLISH(mB, lB, D0, D1); }
    { const float sc = g0 * invC;
#pragma unroll 1
      for (int x = 0; x < 8; ++x) { const LAS float* mp = MRG + x * 34 * 64 + lane;
#pragma unroll
          for (int r = 0; r < 16; ++r) { OA0[r] += mp[(2 + r) * 64] * sc; OA1[r] += mp[(18 + r) * 64] * sc; } } }
    {
        const LAS float* pr = PS + w * 520; const int sa = lane, sb = lane + 64; float ia = 0.f, ib = 0.f;
#pragma unroll
        for (int n = 4 * sa - 1; n <= 4 * sa + 3; ++n) if (n >= 0) ia += pr[n];
#pragma unroll
        for (int n = 4 * sb - 1; n <= 4 * sb + 3; ++n) ib += pr[n];
        const bool fa = (sa == 0), fb = (sb == 127); const float va = fa ? 1e4f : ia, vb = fb ? 1e4f : ib;
        IMPw[sa] = va; IMPw[sb] = vb; LDS_WAIT(); asm volatile("" ::: "memory");
        int ra = fa ? 0 : 1, rb = fb ? 0 : 1;
#pragma unroll 8
        for (int i = 0; i < 128; ++i) { const float v = IMPw[i]; ra += (v > va || (v == va && i < sa)) ? 1 : 0; rb += (v > vb || (v == vb && i < sb)) ? 1 : 0; }
        const unsigned long long ma = __ballot(ra < 16), mb = __ballot(rb < 16);
        if (lane == 0) { MASKS[w * 4] = ma; MASKS[w * 4 + 1] = mb; }
    }
    __syncthreads();
    const unsigned long long mk0 = MASKS[tl * 4], mk1 = MASKS[tl * 4 + 1];
    unsigned long long U0 = 0ull, U1 = 0ull;
#pragma unroll
    for (int x = 0; x < 8; ++x) { U0 |= MASKS[x * 4]; U1 |= MASKS[x * 4 + 1]; }
    {
        float m = -INFINITY, ls = 0.f; D0 = (f32x16){}; D1 = (f32x16){};
        const int t = PAST + tl; int cnt = 0;
#pragma unroll 1
        for (int s = 0; s <= 128; ++s) {
            const bool in_u = (s < 64) ? ((U0 >> s) & 1ull) : ((s < 128) ? ((U1 >> (s - 64)) & 1ull) : true);
            if (!in_u) continue;
            const bool selb = (s < 64) ? ((mk0 >> s) & 1ull) : ((s < 128) ? ((mk1 >> (s - 64)) & 1ull) : true);
            const int nh = (s < 128) ? 2 : 1;
            for (int hf = 0; hf < nh; ++hf, ++cnt) {
                if ((cnt & 7) != w) continue;
                const int hi = selb ? t : -1;
                if (s < 128) { const int page = ptab[s >> 1], slot = (s & 1) * 64 + hf * 32;
                    const float* kp = FIN(I_CACHE) + (((((size_t)l * NPHYS + page) * PAGE + slot) * 4 + 2) * 2 + kvh) * 64;
                    ASrc S{kp, kp + 128, nullptr, nullptr, 512, 32}; AS_TILE(S, s * 64 + hf * 32, 0, hi, true, false, m, ls, D0, D1, 0.f, 520); }
                else { const bf16* kp = WSP(bf16, WS_KVS) + ((((size_t)0 * SB + seq) * 2 + kvh) * ST) * 64;
                    ASrc S{nullptr, nullptr, kp, kp + (size_t)SB * 2 * ST * 64, 64, ST}; AS_TILE(S, PAST, 0, hi, true, false, m, ls, D0, D1, 0.f, 520); }
            }
        }
        AS_PUBLISH(m, ls, D0, D1);
        float mt = -INFINITY;
#pragma unroll
        for (int x = 0; x < 8; ++x) mt = fmaxf(mt, MRG[x * 34 * 64 + lane]);
        float lt = 0.f; f32x16 T0 = (f32x16){}, T1 = (f32x16){};
#pragma unroll 1
        for (int x = 0; x < 8; ++x) { const LAS float* mp = MRG + x * 34 * 64 + lane; const float mx_ = mp[0]; const float f = (mx_ == -INFINITY) ? 0.f : fexp2(mx_ - mt); lt += mp[64] * f;
#pragma unroll
            for (int r = 0; r < 16; ++r) { T0[r] += mp[(2 + r) * 64] * f; T1[r] += mp[(18 + r) * 64] * f; } }
        lt = xhalf_sum(lt); const float sc = (lt > 0.f ? 1.0f / lt : 0.f) * g1; OA0 += T0 * sc; OA1 += T1 * sc;
    }
    {
        float m = -INFINITY, ls = 0.f; D0 = (f32x16){}; D1 = (f32x16){};
#pragma unroll 1
        for (int ti = w; ti < 17; ti += 8) {
            if (ti < 16) { const float* kp = FIN(I_CWIN) + (((((size_t)l * SB + seq) * WINB + ti * 32) * 2 + 0) * 2 + kvh) * 64;
                ASrc S{kp, kp + 128, nullptr, nullptr, 256, 32}; AS_TILE(S, ti * 32, tl, WINB + tl, true, false, m, ls, D0, D1, 0.f, 520); }
            else { const bf16* kp = WSP(bf16, WS_KVS) + ((((size_t)2 * SB + seq) * 2 + kvh) * ST) * 64;
                ASrc S{nullptr, nullptr, kp, kp + (size_t)SB * 2 * ST * 64, 64, ST}; AS_TILE(S, WINB, tl, WINB + tl, true, false, m, ls, D0, D1, 0.f, 520); }
        }
        AS_PUBLISH(m, ls, D0, D1);
        float mt = -INFINITY;
#pragma unroll
        for (int x = 0; x < 8; ++x) mt = fmaxf(mt, MRG[x * 34 * 64 + lane]);
        float lt = 0.f; f32x16 T0 = (f32x16){}, T1 = (f32x16){};
#pragma unroll 1
        for (int x = 0; x < 8; ++x) { const LAS float* mp = MRG + x * 34 * 64 + lane; const float mx_ = mp[0]; const float f = (mx_ == -INFINITY) ? 0.f : fexp2(mx_ - mt); lt += mp[64] * f;
#pragma unroll
            for (int r = 0; r < 16; ++r) { T0[r] += mp[(2 + r) * 64] * f; T1[r] += mp[(18 + r) * 64] * f; } }
        lt = xhalf_sum(lt); const float sc = (lt > 0.f ? 1.0f / lt : 0.f) * g2; OA0 += T0 * sc; OA1 += T1 * sc;
    }
#undef AS_PUBLISH
    if (w == 0) {
        bf16* op = WSP(bf16, WS_OA) + row * 512 + head * 64;
#pragma unroll
        for (int r4 = 0; r4 < 4; ++r4) { v2u a, b; a.x = pk2(OA0[4 * r4 + 0], OA0[4 * r4 + 1]); a.y = pk2(OA0[4 * r4 + 2], OA0[4 * r4 + 3]); b.x = pk2(OA1[4 * r4 + 0], OA1[4 * r4 + 1]); b.y = pk2(OA1[4 * r4 + 2], OA1[4 * r4 + 3]);
            *(v2u*)(op + 8 * r4 + 4 * h_) = a; *(v2u*)(op + 32 + 8 * r4 + 4 * h_) = b; }
    }
}

#ifndef DBG_DUP
#define DBG_DUP 0
#endif
#if DBG_DUP == 1
#define AP_DUP_QK(NK) { f32x16 d_ = (f32x16){}; _Pragma("unroll") for (int kk = 0; kk < 4; ++kk) d_ = mfma32(NK[kk], qf[(kk + 1) & 3], d_); _Pragma("unroll") for (int r = 0; r < 16; ++r) s_[r] += zf * d_[r]; }
#else
#define AP_DUP_QK(NK)
#endif
#if DBG_DUP == 2
#define AP_DUP_EXP() { float acc_ = 0.f; _Pragma("unroll") for (int r = 0; r < 16; ++r) acc_ += fexp2(s_[r] * 0.5f - 3.0f); lsum += zf * acc_; }
#else
#define AP_DUP_EXP()
#endif
#if DBG_DUP == 3
#define AP_DUP_PV() { f32x16 e0_ = (f32x16){}, e1_ = (f32x16){}; _Pragma("unroll") for (int s2 = 0; s2 < 2; ++s2) { const bf16x8 pf_ = cvt_frag(s_, 1 - s2); const int rA_ = 16 * s2 + 4 * h_; \
        e0_ = mfma32(tr_frag(Vw, AS_RS, rA_ + 8, rA_, 16 * blk, lane), pf_, e0_); e1_ = mfma32(tr_frag(Vw, AS_RS, rA_ + 8, rA_, 32 + 16 * blk, lane), pf_, e1_); } D0 += e0_ * zf; D1 += e1_ * zf; }
#else
#define AP_DUP_PV()
#endif
constexpr int AP_WS = 14336, AP_V = 0, AP_PS = 4608, AP_IMP = AP_PS + 8 * 264 * 4, AP_MASK = AP_IMP + 256, AP_LIST = AP_MASK + 64;
static_assert(AP_LIST + 2 * 192 <= AP_WS && 8 * AP_WS <= RING_BYTES, "prompt attention LDS map");
__device__ __forceinline__ void attn_prompt_unit(Frame& F, int l, int unit) {
    const int lane = F.lane, w = F.wave;
    const int q = lane & 31, h_ = lane >> 5, blk = (lane >> 4) & 1, tl = q >> 2, hr = q & 3;
    const int seq = unit >> 7, kvh = (unit >> 6) & 1, qt = unit & 63, head = kvh * 4 + hr;
    const int t0w = qt * 64 + 8 * w, t = t0w + tl; const size_t row = (size_t)seq * PT + t;
    LAS unsigned char* Vw = F.lds + w * AP_WS + AP_V; LAS float* PS = (LAS float*)(F.lds + w * AP_WS + AP_PS); LAS float* IMPw = (LAS float*)(F.lds + w * AP_WS + AP_IMP);
    LAS unsigned long long* MASKS = (LAS unsigned long long*)(F.lds + w * AP_WS + AP_MASK); LAS unsigned short* LIST = (LAS unsigned short*)(F.lds + w * AP_WS + AP_LIST);
    __syncthreads();
    bf16x8 qf[4];
    { const bf16* qp = WSP(bf16, WS_QN) + row * 512 + head * 64 + 8 * h_;
#pragma unroll
      for (int kk = 0; kk < 4; ++kk) qf[kk] = *(const bf16x8*)(qp + 16 * kk); }
    const float* ngp = WSP(float, WS_NG) + row * 24 + head * 3; const float g0 = ngp[0], g1 = ngp[1], g2 = ngp[2];
    for (int i = lane; i < 8 * 264; i += 64) PS[i] = 0.f;
    const bf16* CKk = WSP(bf16, WS_CK) + ((size_t)32768 + (seq * 2 + kvh) * 256) * 64; const bf16* CKv = CKk + (size_t)CMP_ROWS_J * 64;
    const bf16* KS = WSP(bf16, WS_KVB) + ((((size_t)0 * PB + seq) * 2 + kvh) * PT) * 64; const bf16* VS = KS + (size_t)PB * 2 * PT * 64;
    const bf16* KW = KS + (size_t)2 * PB * 2 * PT * 64; const bf16* VW = KW + (size_t)PB * 2 * PT * 64;
    const int hiCmin = (t0w >= 31) ? ((t0w - 31) >> 4) : -1;
    const int hiC = (t >= 31) ? ((t - 31) >> 4) : -1; const int nmaxw = (t0w + 7 >= 31) ? ((t0w + 7 - 31) >> 4) : -1; const int ntc = (nmaxw >= 0) ? (nmaxw >> 5) + 1 : 0;
    f32x16 D0 = (f32x16){}, D1 = (f32x16){};
    LAS float* OAG = PS + lane;
    float m = -INFINITY, lsum = 0.f, invC = 0.f; unsigned long long mk0 = 0ull;
    const float zf = (F.G == 12345) ? 1.0f : 0.0f;
    bf16x8 nk0[4], nk1[4]; v4u nv0[4], nv1[4];
#define AP_LOADT(e_, NK, NV) do { const int kd_ = (int)((e_) >> 12), ti_ = (int)((e_) & 0xfffu); const bf16* kb_ = (kd_ < 2 ? CKk : (kd_ == 2 ? KS : KW)) + (size_t)ti_ * 32 * 64; const bf16* vb_ = (kd_ < 2 ? CKv : (kd_ == 2 ? VS : VW)) + (size_t)ti_ * 32 * 64; \
        const int ko_ = kd_ < 2 ? q * 64 + 8 * h_ : lane * 8, ks_ = kd_ < 2 ? 16 : 512;     \
        _Pragma("unroll") for (int kk = 0; kk < 4; ++kk) NK[kk] = *(const bf16x8*)(kb_ + ko_ + ks_ * kk); \
        _Pragma("unroll") for (int x = 0; x < 4; ++x) NV[x] = *(const v4u*)(vb_ + 512 * x + lane * 8); } while (0)
#define AP_STEP(i_, n_, NK, NV, EC) do { \
        const unsigned e_ = EC; const int kind = (int)(e_ >> 12), ti = (int)(e_ & 0xfffu); \
        if (kind != 0) { _Pragma("unroll") for (int x = 0; x < 4; ++x) *(LAS v4u*)(Vw + (8 * x + (lane >> 3)) * AS_RS + (lane & 7) * 16) = NV[x]; } \
        f32x16 s_ = (f32x16){}; \
        _Pragma("unroll") for (int kk = 0; kk < 4; ++kk) s_ = mfma32(NK[kk], qf[kk], s_); \
        AP_DUP_QK(NK) \
        if ((i_) + 2 < (n_)) { const unsigned en_ = (unsigned)__builtin_amdgcn_readfirstlane((int)LIST[(i_) + 2]); EC = en_; AP_LOADT(en_, NK, NV); } \
        if (kind != cur_kind) { \
            if (cur_kind == 0) { const float lt_ = xhalf_sum(lsum); invC = lt_ > 0.f ? 1.0f / lt_ : 0.f; } \
            else if (cur_kind == 2) { const float lt_ = xhalf_sum(lsum); const float sc_ = (lt_ > 0.f ? 1.0f / lt_ : 0.f) * g1; \
                _Pragma("unroll") for (int r = 0; r < 16; ++r) { OAG[r * 64] += D0[r] * sc_; OAG[(16 + r) * 64] += D1[r] * sc_; } } \
            if (kind != 1) m = -INFINITY; lsum = 0.f; D0 = (f32x16){}; D1 = (f32x16){}; cur_kind = kind; } \
        const int kb = ti * 32; int lo, hi; \
        if (kind < 2) { lo = 0; hi = hiC; } else if (kind == 2) { lo = 0; hi = ((mk0 >> (ti >> 1)) & 1ull) ? t : -1; } else { lo = t - WINB; hi = t; } \
          \
        const bool interior = (kind < 2) ? (hiCmin >= 0 && kb + 31 <= hiCmin) : ((kind == 2) ? (kb + 31 <= t0w) : (kb >= t0w + 7 - WINB && kb + 31 <= t0w)); \
        float tmax_ = -INFINITY, mu_, mn_; \
        if (interior) { const bool on_ = hi >= 0; \
            _Pragma("unroll") for (int r = 0; r < 16; ++r) tmax_ = fmaxf(tmax_, s_[r]); \
            tmax_ = on_ ? tmax_ : -INFINITY; tmax_ = xhalf_max(tmax_); \
            mn_ = fmaxf(m, tmax_); mu_ = (mn_ == -INFINITY) ? 0.f : mn_; const float mr_ = on_ ? mu_ : INFINITY; \
            _Pragma("unroll") for (int r = 0; r < 16; ++r) s_[r] = fexp2(s_[r] - mr_); \
        } else { \
            _Pragma("unroll") for (int r = 0; r < 16; ++r) { const int key_ = kb + (r & 3) + 8 * (r >> 2) + 4 * h_; s_[r] = (key_ >= lo && key_ <= hi) ? s_[r] : -INFINITY; tmax_ = fmaxf(tmax_, s_[r]); } \
            tmax_ = xhalf_max(tmax_); \
            mn_ = fmaxf(m, tmax_); mu_ = (mn_ == -INFINITY) ? 0.f : mn_; \
            _Pragma("unroll") for (int r = 0; r < 16; ++r) s_[r] = fexp2(s_[r] - mu_); \
        } \
        AP_DUP_EXP() \
        const float al_ = fexp2(m - mu_); float ps_ = 0.f; \
        _Pragma("unroll") for (int r = 0; r < 16; ++r) ps_ += s_[r]; \
        lsum = lsum * al_ + ps_; m = mn_; \
        if (kind != 0) { if (__ballot(al_ != 1.0f) != 0ull) { D0 *= al_; D1 *= al_; } asm volatile("" ::: "memory");   \
            { const bf16x8 va0_ = tr_frag(Vw, AS_RS, 4 * h_, 4 * h_ + 8, 16 * blk, lane), va1_ = tr_frag(Vw, AS_RS, 4 * h_, 4 * h_ + 8, 32 + 16 * blk, lane), \
                           vb0_ = tr_frag(Vw, AS_RS, 16 + 4 * h_, 24 + 4 * h_, 16 * blk, lane), vb1_ = tr_frag(Vw, AS_RS, 16 + 4 * h_, 24 + 4 * h_, 32 + 16 * blk, lane);   \
              const bf16x8 pf0_ = cvt_frag(s_, 0), pf1_ = cvt_frag(s_, 1); \
              D0 = mfma32(va0_, pf0_, D0); D1 = mfma32(va1_, pf0_, D1); D0 = mfma32(vb0_, pf1_, D0); D1 = mfma32(vb1_, pf1_, D1); } \
            AP_DUP_PV() \
            asm volatile("" ::: "memory"); } \
        if (kind == 1) { _Pragma("unroll") for (int r = 0; r < 16; ++r) { const int n2_ = kb + (r & 3) + 8 * (r >> 2) + 4 * h_; float a_ = s_[r] * invC; a_ += __shfl_xor(a_, 1); a_ += __shfl_xor(a_, 2); if (hr == 0) PS[tl * 264 + n2_] = a_; } } \
    } while (0)
#define AP_RUN(N_) do { const int n_ = (N_); unsigned ec0_ = 0u, ec1_ = 0u;                  \
      if (n_ > 0) { ec0_ = (unsigned)__builtin_amdgcn_readfirstlane((int)LIST[0]); AP_LOADT(ec0_, nk0, nv0); } \
      if (n_ > 1) { ec1_ = (unsigned)__builtin_amdgcn_readfirstlane((int)LIST[1]); AP_LOADT(ec1_, nk1, nv1); } \
      _Pragma("unroll 1") for (int i_ = 0; i_ < n_; i_ += 2) { AP_STEP(i_, n_, nk0, nv0, ec0_); if (i_ + 1 < n_) AP_STEP(i_ + 1, n_, nk1, nv1, ec1_); } } while (0)
    int cur_kind = -1;
    if (lane < 2 * ntc) LIST[lane] = (unsigned short)(((lane >= ntc ? 1u : 0u) << 12) | (unsigned)(lane >= ntc ? lane - ntc : lane));
    LDS_WAIT(); asm volatile("" ::: "memory");
    AP_RUN(2 * ntc);
    { const float sc = (cur_kind == 1) ? g0 * invC : 0.f; D0 *= sc; D1 *= sc; }
    LDS_WAIT(); asm volatile("" ::: "memory");
#pragma unroll 1
    for (int tk = 0; tk < 8; ++tk) {
        const LAS float* pr = PS + tk * 264; const int s = lane; float imp = 0.f;
#pragma unroll
        for (int n = 4 * s - 1; n <= 4 * s + 3; ++n) if (n >= 0) imp += pr[n];
        const bool forced = (s == 0) || (s == qt) || (s == qt - 1), avail = s <= qt; const float val = avail ? (forced ? 1e4f : imp) : -1e4f;
        IMPw[s] = val; LDS_WAIT(); asm volatile("" ::: "memory");
        int rank = 0;
#pragma unroll 8
        for (int i = 0; i < 64; ++i) { const float v = IMPw[i]; rank += (v > val || (v == val && i < s)) ? 1 : 0; }
        const unsigned long long mk = __ballot(rank < 16);
        if (lane == 0) MASKS[tk] = mk;
        LDS_WAIT(); asm volatile("" ::: "memory");
    }
#pragma unroll
    for (int r = 0; r < 16; ++r) { OAG[r * 64] = D0[r]; OAG[(16 + r) * 64] = D1[r]; }
    mk0 = MASKS[tl]; unsigned long long wu = 0ull;
#pragma unroll
    for (int i = 0; i < 8; ++i) wu |= MASKS[i];
    wu &= (qt >= 63) ? ~0ull : ((1ull << (qt + 1)) - 1ull);
    const int nsel = 2 * __popcll(wu); const int tiLo = (t0w > WINB) ? ((t0w - WINB) >> 5) : 0, tiHi = (t0w + 7) >> 5, nwin = tiHi - tiLo + 1;
    if ((wu >> lane) & 1ull) { const int pos = 2 * __popcll(wu & ((1ull << lane) - 1ull)); LIST[pos] = (unsigned short)((2u << 12) | (unsigned)(2 * lane)); LIST[pos + 1] = (unsigned short)((2u << 12) | (unsigned)(2 * lane + 1)); }
    if (lane < nwin) LIST[nsel + lane] = (unsigned short)((3u << 12) | (unsigned)(tiLo + lane));
    LDS_WAIT(); asm volatile("" ::: "memory");
#ifdef DBG_COUNT
    if (lane == 0) { unsigned* CNT = (unsigned*)(F.ws + WS_CTL) + 3000; atomicAdd(CNT + 0, (unsigned)nsel); atomicAdd(CNT + 1, (unsigned)nwin); atomicAdd(CNT + 2, (unsigned)(2 * ntc)); atomicAdd(CNT + 3, 1u); }
#endif
    cur_kind = -1;
    AP_RUN(nsel + nwin);
    const float ltw = xhalf_sum(lsum); const float scw = (ltw > 0.f ? 1.0f / ltw : 0.f) * g2;
#undef AP_RUN
#undef AP_STEP
#undef AP_LOADT
    {
        bf16* op = WSP(bf16, WS_OA) + row * 512 + head * 64;
#pragma unroll
        for (int r4 = 0; r4 < 4; ++r4) { float a_[4], b_[4];
#pragma unroll
            for (int x = 0; x < 4; ++x) { a_[x] = OAG[(4 * r4 + x) * 64] + D0[4 * r4 + x] * scw; b_[x] = OAG[(16 + 4 * r4 + x) * 64] + D1[4 * r4 + x] * scw; }
            v2u a, b; a.x = pk2(a_[0], a_[1]); a.y = pk2(a_[2], a_[3]); b.x = pk2(b_[0], b_[1]); b.y = pk2(b_[2], b_[3]);
            *(v2u*)(op + 8 * r4 + 4 * h_) = a; *(v2u*)(op + 32 + 8 * r4 + 4 * h_) = b; }
    }
}
#undef AS_TILE

#ifdef DBG_CHECK
__device__ __forceinline__ unsigned dbg_rand(unsigned x) { x ^= x >> 16; x *= 0x7feb352du; x ^= x >> 15; x *= 0x846ca68bu; x ^= x >> 16; return x; }
__device__ __forceinline__ bool dbg_bad(float got, float exp_, float rtol, float atol) { return !(fabsf(got - exp_) <= rtol * fabsf(exp_) + atol); }
__device__ __forceinline__ float bfr(float x) { return __uint_as_float(pk2(x, 0.f) << 16); }
__device__ __forceinline__ int dbg_row(unsigned r) { const unsigned k = r % 20u; if (k == 0) return (int)(PM + (r >> 8) % SM); if (k == 1) return (int)(((r >> 8) % PB) * PT + ((r >> 12) % 8)); if (k == 2) return (int)(((r >> 8) % PB) * PT + PT - 1 - ((r >> 12) % 8)); return (int)((r >> 5) % PM); }
__device__ __forceinline__ float dbg_rs(const Frame& F, int row, int lane) { const float* xr = xrow_in(F, 0, row); float ss = 0.f; for (int d = lane; d < DM; d += 64) ss += xr[d] * xr[d]; return 1.0f / sqrtf(wave_sum(ss) * (1.0f / DM) + EPS); }
__device__ __forceinline__ float dbg_h(const Frame& F, int row, int d, float rs) { const float* mod = WSP(float, WS_MOD) + (size_t)row_bb(row) * 6144; return bfr(xrow_in(F, 0, row)[d] * rs * FIN(I_N1G)[d] * (1.0f + mod[1024 + d]) + mod[d]); }

__device__ __forceinline__ void dbg_check_phase(Frame& F) {
    const int gw = F.bid * NWAVES + F.wave, NGW = F.G * NWAVES, lane = F.lane;
    unsigned* CNT = (unsigned*)(F.ws + WS_CTL) + 3000;
    LAS float* L = (LAS float*)(F.lds + F.wave * 16384);
#define DBG_FLAG(ch, cond) do { if (__any(cond) && lane == 0) atomicAdd(CNT + (ch), 1u); } while (0)
    for (int s = gw; s < 1536; s += NGW) {
        const unsigned r = dbg_rand(1000u + s); const int row = dbg_row(r); const float rs = dbg_rs(F, row, lane); const int kind = s % 6;
        const bool isp = row < PM; const int b = isp ? (row >> 12) : ((row - PM) >> 3), t = isp ? (row & (PT - 1)) : ((row - PM) & 7);
#define DBG_U(col, dst) do { float a_ = 0.f; for (int d_ = lane; d_ < DM; d_ += 64) a_ += dbg_h(F, row, d_, rs) * bfr(FIN(I_WIN)[(size_t)d_ * D_IN + (col)]); dst = wave_sum(a_); } while (0)
        if (kind == 0) {
            const int c = (r >> 3) % 768, j = c >> 7, k = (c >> 6) & 1, dd = c & 63; float u; DBG_U(O_NKV + c, u); bool bad = false;
            if (j < 4) bad = dbg_bad(F.out[(isp ? OUT_ROWS_P + (size_t)row * 512 : OUT_ROWS_S + (size_t)(row - PM) * 512) + c], u, 0.01f, 0.01f);
            else if (isp) { if (t >= PT - WINB) bad = dbg_bad(F.out[OUT_WIN_P + ((size_t)b * WINB + (t - (PT - WINB))) * 256 + (c - 512)], u, 0.01f, 0.01f); }
            else bad = dbg_bad(F.out[OUT_WIN_S + ((size_t)b * WINB + (WINB - ST) + t) * 256 + (c - 512)], u, 0.01f, 0.01f);
            if (isp) { if (j < 2) bad = bad || dbg_bad(bf1(WSP(bf16, WS_ACMP)[((size_t)j * CMP_ROWS_J + 32768 + (b * 2 + k) * 256 + (t >> 4)) * 1024 + (t & 15) * 64 + dd]), u, 0.01f, 0.01f);
                       else bad = bad || dbg_bad(bf1(WSP(bf16, WS_KVB)[((((size_t)(j - 2) * PB + b) * 2 + k) * PT + t) * 64 + dd]), u, 0.01f, 0.01f); }
            else if (j >= 2) bad = bad || dbg_bad(bf1(WSP(bf16, WS_KVS)[((((size_t)(j - 2) * SB + b) * 2 + k) * ST + t) * 64 + dd]), u, 0.01f, 0.01f);
            DBG_FLAG(0, bad);
        } else if (kind == 1) {
            const int gi = (r >> 3) % 24, c5 = (r >> 8) % 512, cm = (r >> 8) % 3072; float u0, u1, u2, u3; DBG_U(O_NG + gi, u0); DBG_U(O_RX + c5, u1); DBG_U(O_RGATE + c5, u2); DBG_U(O_MG + cm, u3);
            bool bad = dbg_bad(WSP(float, WS_NG)[(size_t)row * 24 + gi], 1.0f / (1.0f + expf(-u0)), 0.01f, 0.005f);
            bad = bad || dbg_bad(WSP(float, WS_RX)[(size_t)row * 512 + c5], u1, 0.01f, 0.01f);
            bad = bad || dbg_bad(bf1(WSP(bf16, WS_GG)[(size_t)row * 512 + c5]), gelu_tanh(u2), 0.02f, 0.01f);
            bad = bad || dbg_bad(bf1(WSP(bf16, WS_MGS)[(size_t)row * 3072 + cm]), 1.0f / (1.0f + expf(-u3)), 0.01f, 0.005f);
            DBG_FLAG(1, bad);
        } else if (kind == 2) {
            const int head = (r >> 13) % 4, dim = (r >> 16) % 64, c5 = (r >> 3) % 512; float x1, x2, uv, ug, uq; DBG_U(O_RQ + head * 128 + dim, x1); DBG_U(O_RQ + head * 128 + 64 + dim, x2); DBG_U(O_RV + c5, uv); DBG_U(O_RG + c5, ug); DBG_U(O_NQ + c5, uq);
            const float pos = (float)(isp ? t : PAST + t); const float ang = pos * (float)pow(10000.0, -(double)dim / 64.0); float sn, cs; sincos_acc(ang, sn, cs);
            const bf16* RQ = WSP(bf16, WS_RQ);
            bool bad = dbg_bad(bf1(RQ[(size_t)row * 512 + head * 128 + dim]), x1 * cs - x2 * sn, 0.02f, 0.02f) || dbg_bad(bf1(RQ[(size_t)row * 512 + head * 128 + 64 + dim]), x1 * sn + x2 * cs, 0.02f, 0.02f);
            bad = bad || dbg_bad(bf1(RQ[(size_t)2 * MT * 512 + (size_t)row * 512 + c5]), uv, 0.01f, 0.01f) || dbg_bad(bf1(RQ[(size_t)3 * MT * 512 + (size_t)row * 512 + c5]), ug, 0.01f, 0.01f);
            bad = bad || dbg_bad(bf1(WSP(bf16, WS_QN)[(size_t)row * 512 + c5]), uq * QSCALE, 0.01f, 0.005f);
            DBG_FLAG(2, bad);
        }
#undef DBG_U
    }
    for (int s = gw; s < 128; s += NGW) {
        const unsigned r = dbg_rand(3000u + s); const int j = r & 1; const bool smp = ((r >> 1) & 3) != 0;
        const int grp = smp ? (int)((r >> 3) % 64) : (int)((r >> 3) % 8), nmax = smp ? 511 : 255; int n = (r >> 10) % nmax; if (((r >> 20) & 7) == 0) n = nmax - 1;
        const size_t rj = smp ? (size_t)grp * 512 + n : (size_t)32768 + grp * 256 + n;
        const bf16* A = WSP(bf16, WS_ACMP) + ((size_t)j * CMP_ROWS_J + rj) * 1024;
        const float* w1 = FIN(I_W1) + (size_t)j * 2048 * 128; const float* pe = FIN(I_PE) + j * 2048;
        for (int hh = 0; hh < 2; ++hh) { const int h = lane + 64 * hh; float a = FIN(I_B1)[j * 128 + h];
            for (int i = 0; i < 1024; ++i) a += (bf1(A[i]) + pe[i]) * w1[(size_t)i * 128 + h] + (bf1(A[1024 + i]) + pe[1024 + i]) * w1[(size_t)(1024 + i) * 128 + h];
            L[h] = gelu_tanh(a); }
        LDS_WAIT(); asm volatile("" ::: "memory");
        float o = 0.f; for (int h = 0; h < 128; ++h) o += L[h] * FIN(I_W2)[((size_t)j * 128 + h) * 64 + lane];
        const float got = bf1(WSP(bf16, WS_CK)[((size_t)j * CMP_ROWS_J + rj) * 64 + lane]);
        { const bool bd = dbg_bad(got, o, 0.05f, 0.03f); const unsigned long long mk = __ballot(bd); if (lane == 0 && mk) atomicAdd(CNT + 3, (unsigned)__popcll(mk)); }
        LDS_WAIT(); asm volatile("" ::: "memory");
    }
    for (int s = gw; s < 128; s += NGW) {
        const unsigned r = dbg_rand(3500u + s); const int j = r & 1; const bool smp = ((r >> 1) & 3) != 0;
        const int grp = smp ? (int)((r >> 3) % 64) : (int)((r >> 3) % 8), nmax = smp ? 511 : 255; const int n = (r >> 10) % nmax;
        const size_t rj = smp ? (size_t)grp * 512 + n : (size_t)32768 + grp * 256 + n, row = (size_t)j * CMP_ROWS_J + rj;
        const bf16* A = WSP(bf16, WS_ACMP) + row * 1024; const float* w1 = FIN(I_W1) + (size_t)j * 2048 * 128; const bf16* LH = WSP(bf16, WS_LH);
        unsigned nb = 0;
        for (int hh = 0; hh < 2; ++hh) { const int h = lane + 64 * hh; float lo = 0.f, hi = 0.f;
            for (int i = 0; i < 1024; ++i) { const float av = bf1(A[i]); lo += av * bfr(w1[(size_t)i * 128 + h]); hi += av * bfr(w1[(size_t)(1024 + i) * 128 + h]); }
            const bool bd = dbg_bad(bf1(LH[row * 256 + h]), lo, 0.02f, 0.02f) || dbg_bad(bf1(LH[row * 256 + 128 + h]), hi, 0.02f, 0.02f); nb += (unsigned)__popcll(__ballot(bd)); }
        if (lane == 0 && nb) atomicAdd(CNT + 9, nb);
        for (int hh = 0; hh < 2; ++hh) { const int h = lane + 64 * hh; L[h] = gelu_tanh(bf1(LH[row * 256 + h]) + bf1(LH[(row + 1) * 256 + 128 + h]) + WSP(float, WS_SMALLW + SW_CB)[j * 128 + h]); }
        LDS_WAIT(); asm volatile("" ::: "memory");
        float o = 0.f; for (int h = 0; h < 128; ++h) o += bfr(L[h]) * bfr(FIN(I_W2)[((size_t)j * 128 + h) * 64 + lane]);
        { const bool bd = dbg_bad(bf1(WSP(bf16, WS_CK)[row * 64 + lane]), o, 0.03f, 0.01f); const unsigned long long mk = __ballot(bd); if (lane == 0 && mk) atomicAdd(CNT + 11, (unsigned)__popcll(mk)); }
        LDS_WAIT(); asm volatile("" ::: "memory");
    }
    for (int s = gw; s < 64; s += NGW) {
        const unsigned r = dbg_rand(3700u + s); const int j = r & 1, half = (r >> 1) & 1, h = (r >> 2) % 128; const bf16* W1T = WSP(bf16, WS_SMALLW + SW_W1T) + ((size_t)j * 256 + half * 128 + h) * 1024;
        const float* w1 = FIN(I_W1) + ((size_t)j * 32 + half * 16) * 64 * 128 + h; unsigned nb = 0;
        for (int k = lane; k < 1024; k += 64) nb += (unsigned)__popcll(__ballot(dbg_bad(bf1(W1T[k]), w1[(size_t)k * 128], 0.01f, 0.0001f)));
        if (lane == 0 && nb) atomicAdd(CNT + 12, nb);
        const bool smp = ((r >> 9) & 3) != 0; const int grp = smp ? (int)((r >> 11) % 64) : (int)((r >> 11) % 8), n = (r >> 17) % (smp ? 511 : 255);
        const size_t row = (size_t)j * CMP_ROWS_J + (smp ? (size_t)grp * 512 + n : (size_t)32768 + grp * 256 + n); const bf16* A = WSP(bf16, WS_ACMP) + row * 1024;
        float a = 0.f; for (int k = lane; k < 1024; k += 64) a += bf1(A[k]) * bf1(W1T[k]); a = wave_sum(a);
        DBG_FLAG(13, dbg_bad(bf1(WSP(bf16, WS_LH)[row * 256 + half * 128 + h]), a, 0.02f, 0.02f));
    }
    for (int s = gw; s < 4; s += NGW) {
        const int j = s >> 1, h = (s & 1) * 64 + lane; const float* w1 = FIN(I_W1) + (size_t)j * 2048 * 128; const float* pe = FIN(I_PE) + j * 2048;
        float a = FIN(I_B1)[j * 128 + h]; for (int i = 0; i < 2048; ++i) a += pe[i] * w1[(size_t)i * 128 + h];
        const unsigned long long mk = __ballot(dbg_bad(WSP(float, WS_SMALLW + SW_CB)[j * 128 + h], a, 0.001f, 0.0005f)); if (lane == 0 && mk) atomicAdd(CNT + 10, (unsigned)__popcll(mk));
    }
    for (int s = gw; s < 96; s += NGW) {
        const unsigned r = dbg_rand(4000u + s); const bool smp = (s % 3) == 2;
        int seq, kvh = (r >> 4) & 1, t, tl = 0; size_t row;
        if (smp) { seq = (r >> 5) % SB; tl = (r >> 10) % ST; t = PAST + tl; row = (size_t)PM + seq * ST + tl; }
        else { seq = (r >> 5) % PB; const unsigned k = (r >> 8) % 8u; t = (k == 0) ? (int)((r >> 12) % 40) : (k == 1) ? PT - 1 - (int)((r >> 12) % 70) : (int)((r >> 12) % PT); row = (size_t)seq * PT + t; }
        const int N = smp ? 511 : 255, NS = smp ? 129 : 64, cur = t >> 6;
        LAS float* Q = L; LAS float* SC = L + 256; LAS float* PSUM = L + 256 + 2048; LAS float* OUT = L + 256 + 2048 + 512;
        for (int i = lane; i < 256; i += 64) Q[i] = bf1(WSP(bf16, WS_QN)[row * 512 + (kvh * 4 + (i >> 6)) * 64 + (i & 63)]);
        for (int i = lane; i < 768; i += 64) OUT[i] = 0.f;
        LDS_WAIT(); asm volatile("" ::: "memory");
        const bf16* CKk = WSP(bf16, WS_CK) + (smp ? (size_t)(seq * 2 + kvh) * 512 : (size_t)32768 + (seq * 2 + kvh) * 256) * 64; const bf16* CKv = CKk + (size_t)CMP_ROWS_J * 64;
        const int nvis = smp ? 511 : ((t >= 31) ? ((t - 31) >> 4) + 1 : 0);
        for (int i = lane; i < 512; i += 64) PSUM[i] = 0.f;
        for (int hr = 0; hr < 4; ++hr) {
            float mx = -INFINITY; for (int n = lane; n < nvis; n += 64) { float a = 0.f; for (int d = 0; d < 64; ++d) a += Q[hr * 64 + d] * bf1(CKk[(size_t)n * 64 + d]); SC[n] = a; mx = fmaxf(mx, a); }
            for (int o = 1; o < 64; o <<= 1) mx = fmaxf(mx, __shfl_xor(mx, o));
            float den = 0.f; for (int n = lane; n < nvis; n += 64) { const float e = exp2f(SC[n] - mx); SC[n] = e; den += e; } den = wave_sum(den);
            LDS_WAIT(); asm volatile("" ::: "memory");
            if (nvis > 0) { float o = 0.f; for (int n = 0; n < nvis; ++n) o += SC[n] * bf1(CKv[(size_t)n * 64 + lane]); OUT[hr * 64 + lane] = o / den;
                for (int n = lane; n < nvis; n += 64) PSUM[n] += SC[n] / den; }
            LDS_WAIT(); asm volatile("" ::: "memory");
        }
        LAS float* IMP = SC; LAS float* SELB = SC + 256;
        for (int sblk = lane; sblk < NS; sblk += 64) { float imp = 0.f; for (int n = 4 * sblk - 1; n <= 4 * sblk + 3; ++n) if (n >= 0 && n < N) imp += PSUM[n];
            const bool forced = sblk == 0 || sblk == cur || sblk == cur - 1, avail = sblk * 64 <= t; IMP[sblk] = avail ? (forced ? 1e4f : imp) : -1e4f; SELB[sblk] = 0.f; }
        LDS_WAIT(); asm volatile("" ::: "memory");
        for (int pick = 0; pick < 16 && pick < NS; ++pick) { float bv = -INFINITY; int bi = 1 << 30;
            for (int sblk = lane; sblk < NS; sblk += 64) { const float v = (SELB[sblk] != 0.f) ? -INFINITY : IMP[sblk]; if (v > bv || (v == bv && sblk < bi)) { bv = v; bi = sblk; } }
            for (int o = 1; o < 64; o <<= 1) { const float ov = __shfl_xor(bv, o); const int oi = __shfl_xor(bi, o); if (ov > bv || (ov == bv && oi < bi)) { bv = ov; bi = oi; } }
            if (lane == 0) SELB[bi] = 1.f; LDS_WAIT(); asm volatile("" ::: "memory"); }
        for (int br = 1; br < 3; ++br) for (int hr = 0; hr < 4; ++hr) {
            float mx = -INFINITY, den = 0.f, o = 0.f;
            const int plo = (br == 1) ? 0 : (t - WINB < 0 ? 0 : t - WINB), phi = t;
            for (int p = plo; p <= phi; ++p) {
                if (br == 1 && SELB[p >> 6] == 0.f) { p |= 63; continue; }
                const float* kf = nullptr; const bf16* kb = nullptr; const float* vf = nullptr; const bf16* vb = nullptr;
                const int jk = (br == 1) ? 2 : 4;
                if (!smp) { kb = WSP(bf16, WS_KVB) + ((((size_t)(jk - 2) * PB + seq) * 2 + kvh) * PT + p) * 64; vb = kb + (size_t)PB * 2 * PT * 64; }
                else if (p >= PAST) { kb = WSP(bf16, WS_KVS) + ((((size_t)(jk - 2) * SB + seq) * 2 + kvh) * ST + (p - PAST)) * 64; vb = kb + (size_t)SB * 2 * ST * 64; }
                else if (br == 1) { const int page = ((const int*)F.a->in[I_PT])[seq * NPG + (p >> 7)]; kf = FIN(I_CACHE) + ((((size_t)page * PAGE + (p & 127)) * 4 + 2) * 2 + kvh) * 64; vf = kf + 128; }
                else { kf = FIN(I_CWIN) + ((((size_t)seq * WINB + (p - (PAST - WINB))) * 2 + 0) * 2 + kvh) * 64; vf = kf + 128; }
                float a = 0.f; for (int d = 0; d < 64; ++d) a += Q[hr * 64 + d] * (kb ? bf1(kb[d]) : bfr(kf[d]));
                const float vv = vb ? bf1(vb[lane]) : bfr(vf[lane]);
                const float mn = fmaxf(mx, a), al = exp2f(mx - mn), e = exp2f(a - mn); den = den * al + e; o = o * al + e * vv; mx = mn;
            }
            OUT[(br * 4 + hr) * 64 + lane] = (den > 0.f) ? o / den : 0.f;
        }
        LDS_WAIT(); asm volatile("" ::: "memory");
        bool bad = false;
        for (int hr = 0; hr < 4; ++hr) { const float* ng = WSP(float, WS_NG) + row * 24 + (kvh * 4 + hr) * 3;
            const float e = ng[0] * OUT[(0 * 4 + hr) * 64 + lane] + ng[1] * OUT[(1 * 4 + hr) * 64 + lane] + ng[2] * OUT[(2 * 4 + hr) * 64 + lane];
            bad = bad || dbg_bad(bf1(WSP(bf16, WS_OA)[row * 512 + (kvh * 4 + hr) * 64 + lane]), e, 0.04f, 0.004f); }
        DBG_FLAG(smp ? 5 : 4, bad);
        LDS_WAIT(); asm volatile("" ::: "memory");
    }
    for (int s = gw; s < 96; s += NGW) {
        const unsigned r = dbg_rand(6000u + s); const bool smp = (s % 3) == 2; const int h = (r >> 3) & 3; const float lg = ret_log_g(h);
        const bf16* RQ = WSP(bf16, WS_RQ); const bf16* RK = RQ + (size_t)MT * 512; const bf16* RV = RQ + (size_t)2 * MT * 512; const bf16* RG = RQ + (size_t)3 * MT * 512;
        int seq, t; size_t row0; if (smp) { seq = (r >> 5) % SB; t = (r >> 10) % ST; row0 = (size_t)PM + seq * ST; } else { seq = (r >> 5) % PB; const unsigned k = (r >> 8) % 4u; t = (k == 0) ? (int)((r >> 12) % 300) : (int)((r >> 12) % PT); row0 = (size_t)seq * PT; }
        float o0 = 0.f, o1 = 0.f;
        for (int d = lane; d < 128; d += 64) L[d] = bf1(RQ[(row0 + t) * 512 + h * 128 + d]);
        LDS_WAIT(); asm volatile("" ::: "memory");
        for (int j = 0; j <= t; ++j) { float a = 0.f; for (int d = 0; d < 128; ++d) a += L[d] * bf1(RK[(row0 + j) * 512 + h * 128 + d]);
            a *= expf((float)(t - j) * lg); o0 += a * bf1(RV[(row0 + j) * 512 + h * 128 + lane]); o1 += a * bf1(RV[(row0 + j) * 512 + h * 128 + 64 + lane]); }
        if (smp) { const float* S0 = FIN(I_SRET) + (((size_t)0 * SB + seq) * 4 + h) * 16384; const float cr = expf((float)(t + 1) * lg);
            for (int d = 0; d < 128; ++d) { o0 += L[d] * S0[d * 128 + lane] * cr; o1 += L[d] * S0[d * 128 + 64 + lane] * cr; } }
        const float mean = wave_sum(o0 + o1) * (1.0f / 128.0f); const float var = wave_sum((o0 - mean) * (o0 - mean) + (o1 - mean) * (o1 - mean)) * (1.0f / 128.0f), rstd = 1.0f / sqrtf(var + EPS);
        const float* GN = FIN(I_GNG) + h * 128; const bf16* OR_ = WSP(bf16, WS_OA) + (size_t)MT * 512;
        const float g0 = bf1(RG[(row0 + t) * 512 + h * 128 + lane]), g1 = bf1(RG[(row0 + t) * 512 + h * 128 + 64 + lane]);
        const float e0 = (o0 - mean) * rstd * GN[lane] * (g0 / (1.0f + expf(-g0))), e1 = (o1 - mean) * rstd * GN[64 + lane] * (g1 / (1.0f + expf(-g1)));
        DBG_FLAG(6, dbg_bad(bf1(OR_[(row0 + t) * 512 + h * 128 + lane]), e0, 0.04f, 0.02f) || dbg_bad(bf1(OR_[(row0 + t) * 512 + h * 128 + 64 + lane]), e1, 0.04f, 0.02f));
        const int d = (r >> 20) % 128, T = smp ? ST : PT; float s0 = 0.f, s1 = 0.f;
        for (int j = 0; j < T; ++j) { const float kk = bf1(RK[(row0 + j) * 512 + h * 128 + d]) * expf((float)(T - 1 - j) * lg); s0 += kk * bf1(RV[(row0 + j) * 512 + h * 128 + lane]); s1 += kk * bf1(RV[(row0 + j) * 512 + h * 128 + 64 + lane]); }
        const float* SO;
        if (smp) { const float* S0 = FIN(I_SRET) + (((size_t)0 * SB + seq) * 4 + h) * 16384; const float g8 = expf(8.0f * lg); s0 += g8 * S0[d * 128 + lane]; s1 += g8 * S0[d * 128 + 64 + lane]; SO = F.out + OUT_RET_S + (((size_t)0 * SB + seq) * 4 + h) * 16384; }
        else SO = F.out + OUT_RET_P + (((size_t)0 * PB + seq) * 4 + h) * 16384;
        DBG_FLAG(7, dbg_bad(SO[d * 128 + lane], s0, 0.02f, 0.02f) || dbg_bad(SO[d * 128 + 64 + lane], s1, 0.02f, 0.02f));
        LDS_WAIT(); asm volatile("" ::: "memory");
    }
    for (int s = gw; s < 48; s += NGW) {
        const unsigned r = dbg_rand(8000u + s); const bool smp = (s % 3) == 2; const int blk = (r >> 3) & 7, c = blk * 64 + lane;
        int seq, T; size_t row0; if (smp) { seq = (r >> 6) % SB; T = ST; row0 = (size_t)PM + seq * ST; } else { seq = (r >> 6) % PB; T = 1 + (int)((r >> 10) % ((s & 1) ? 200 : PT)); row0 = (size_t)seq * PT; }
        const float* RX = WSP(float, WS_RX); const float* cw = FIN(I_RCW); const float cb = FIN(I_RCB)[c];
        float x3 = 0.f, x2 = 0.f, x1 = 0.f, h = 0.f;
        if (smp) { const float* cv = FIN(I_SCONV) + (size_t)seq * 3 * 512; x3 = cv[c]; x2 = cv[512 + c]; x1 = cv[1024 + c]; h = FIN(I_SH)[(size_t)seq * 512 + c]; }
        const float sp = log1pf(expf(-FIN(I_LAM)[c])); const float* wa = FIN(I_RWA) + (size_t)blk * 4096; const float* wx = FIN(I_RWX) + (size_t)blk * 4096;
        for (int t = 0; t < T; ++t) { const float x0 = RX[(row0 + t) * 512 + c]; const float xc = cb + cw[c] * x3 + cw[512 + c] * x2 + cw[1024 + c] * x1 + cw[1536 + c] * x0; x3 = x2; x2 = x1; x1 = x0;
            L[lane] = xc; LDS_WAIT(); asm volatile("" ::: "memory");
            float ra = FIN(I_RBA)[c], ri = FIN(I_RBX)[c]; for (int i = 0; i < 64; ++i) { ra += L[i] * wa[i * 64 + lane]; ri += L[i] * wx[i * 64 + lane]; }
            LDS_WAIT(); asm volatile("" ::: "memory");
            const float rr = 1.0f / (1.0f + expf(-ra)), ii = 1.0f / (1.0f + expf(-ri)), la = -8.0f * rr * sp, a = expf(la); h = a * h + sqrtf(-expm1f(2.0f * la)) * (ii * xc); }
        const size_t o = (row0 + T - 1) * 512 + c; const float e = h * bf1(WSP(bf16, WS_GG)[o]);
        DBG_FLAG(8, dbg_bad(bf1((WSP(bf16, WS_OA) + (size_t)2 * MT * 512)[o]), e, 0.04f, 0.01f));
    }
    for (int s = gw; s < 512; s += NGW) {
        const unsigned r = dbg_rand(9000u + s); const int row = dbg_row(r), col = (r >> 7) % DM;
        float e = 0.f;
        for (int br = 0; br < 3; ++br) { const bf16* O = WSP(bf16, WS_OA) + (size_t)br * MT * 512 + (size_t)row * 512; const float* W = FIN(br == 0 ? I_WBRA : (br == 1 ? I_WBRB : I_WBRC));
            float a = 0.f; for (int k = lane; k < 512; k += 64) a += bf1(O[k]) * bfr(W[(size_t)k * DM + col]); a = wave_sum(a); e += bf1(WSP(bf16, WS_MGS)[(size_t)row * 3072 + br * 1024 + col]) * a; }
        DBG_FLAG(20, dbg_bad(bf1(WSP(bf16, WS_MRG)[(size_t)row * DM + col]), e, 0.03f, 0.01f));
        const float* mod = WSP(float, WS_MOD) + (size_t)row_bb(row) * 6144;
        { float a = 0.f; for (int k = lane; k < DM; k += 64) a += bf1(WSP(bf16, WS_MRG)[(size_t)row * DM + k]) * bfr(FIN(I_WOUT)[(size_t)k * DM + col]); a = wave_sum(a);
          const float ex = xrow_in(F, 0, row)[col] + mod[2048 + col] * a; DBG_FLAG(21, dbg_bad(WSP(float, WS_X1)[(size_t)row * DM + col], ex, 0.005f, 0.005f)); }
        { const float* xr = WSP(float, WS_X1) + (size_t)row * DM; float ss = 0.f; for (int d = lane; d < DM; d += 64) ss += xr[d] * xr[d]; const float rs = 1.0f / sqrtf(wave_sum(ss) * (1.0f / DM) + EPS);
          const int c2 = (r >> 9) % NUP; float a = 0.f; for (int d = lane; d < DM; d += 64) a += bfr(xr[d] * rs * FIN(I_N2G)[d] * (1.0f + mod[4096 + d]) + mod[3072 + d]) * bfr(FIN(I_WUP)[(size_t)d * NUP + c2]); a = wave_sum(a);
          const float got = c2 < DFF ? bf1(WSP(bf16, WS_GP)[(size_t)row * DFF + c2]) : bf1((WSP(bf16, WS_GP) + (size_t)MT * DFF)[(size_t)row * DFF + c2 - DFF]); DBG_FLAG(22, dbg_bad(got, a, 0.02f, 0.01f)); }
        { const int c3 = (r >> 11) % DFF; const bf16* GP = WSP(bf16, WS_GP); const bf16* VAL = GP + (size_t)MT * DFF; const float* cw = FIN(I_FCW);
          const bool isp = row < PM; const int t = isp ? (row & (PT - 1)) : ((row - PM) & 7); float xm2, xm1;
          if (t >= 2) { xm2 = bf1(GP[(size_t)(row - 2) * DFF + c3]); xm1 = bf1(GP[(size_t)(row - 1) * DFF + c3]); }
          else if (isp) { xm2 = 0.f; xm1 = (t == 1) ? bf1(GP[(size_t)(row - 1) * DFF + c3]) : 0.f; }
          else { const float* st = FIN(I_SFFN) + ((size_t)((row - PM) >> 3) * 2) * DFF + c3; xm2 = (t == 0) ? st[0] : st[DFF]; xm1 = (t == 0) ? st[DFF] : bf1(GP[(size_t)(row - 1) * DFF + c3]); }
          const float y = FIN(I_FCB)[c3] + cw[c3] * xm2 + cw[DFF + c3] * xm1 + cw[2 * DFF + c3] * bf1(GP[(size_t)row * DFF + c3]); const float ex = (y / (1.0f + expf(-y))) * bf1(VAL[(size_t)row * DFF + c3]);
          DBG_FLAG(23, dbg_bad(bf1((GP + (size_t)2 * MT * DFF)[(size_t)row * DFF + c3]), ex, 0.02f, 0.005f)); }
        { const bf16* ACT = WSP(bf16, WS_GP) + (size_t)2 * MT * DFF + (size_t)row * DFF; float a = 0.f; for (int k = lane; k < DFF; k += 64) a += bf1(ACT[k]) * bfr(FIN(I_WDN)[(size_t)k * DM + col]); a = wave_sum(a);
          const float ex = WSP(float, WS_X1)[(size_t)row * DM + col] + mod[5120 + col] * a; DBG_FLAG(24, dbg_bad(WSP(float, WS_X2)[(size_t)row * DM + col], ex, 0.005f, 0.005f)); }
    }
#undef DBG_FLAG
}
__device__ __forceinline__ void dbg_report_phase(Frame& F) {
    const unsigned* CNT = (const unsigned*)(F.ws + WS_CTL) + 3000;
    const size_t ooff[14] = {OUT_Y, OUT_Y + (size_t)PM * DM, OUT_ROWS_P, OUT_ROWS_S, OUT_WIN_P, OUT_WIN_S, OUT_RET_P, OUT_RET_S, OUT_H_P, OUT_H_S, OUT_CV_P, OUT_CV_S, OUT_FC_P, OUT_FC_S};
    if (F.bid == 0 && F.tid < 14) { const int b = F.tid; const unsigned c = CNT[b]; const int cnt = 1 + (int)(c > 1000u ? 1000u : c);
        for (int i = 0; i < cnt; ++i) ((unsigned*)F.out)[ooff[b] + 7 + 2 * i] = 0xAAAAAAAAu; }
}
#endif

#ifndef DBG_SUB
#define DBG_SUB 0xFFFF
#endif
#ifndef DBG_MAXPH
#define DBG_MAXPH N_PHASES
#endif
#ifndef DBG_REPEAT
#define DBG_REPEAT 0
#endif
#ifndef DBG_MASK
#define DBG_MASK 0xFFFF
#endif
#define IN(k) (lo <= (k) && (k) < hi)
#ifdef DBG_TIME
#define SEAM(k) do { if ((k) + 1 < hi) { if (MK_N_LAUNCHES == 1) xcd_barrier(bar); } if (F.bid == 0 && F.tid == 0) ((unsigned long long*)(F.ws + WS_CTL))[2048 + (k) + 1] = __builtin_amdgcn_s_memrealtime(); } while (0)
#else
#define SEAM(k) do { if ((k) + 1 < hi) { if (MK_N_LAUNCHES == 1) xcd_barrier(bar); } } while (0)
#endif
template <int l> __device__ __forceinline__ void ph_win(Frame& F) { unsigned char* ws = F.ws;
    pg8::Gemm g{(const pg8::bf16_t*)(ws + WS_H), (const pg8::bf16_t*)(ws + WS_WIN) + (size_t)l * NIN * DM, MT, NIN, DM};
    pg8::StaticOrder S; S.init(MT, NIN, F.G, F.bid); EpiWin E{ws, F.out, l};
    pg8::gemm_phase<EpiWin, pg8::StaticOrder, true, true>(F.lds, g, S, E); }
template <int l> __device__ __forceinline__ void ph_mix1(Frame& F) { unsigned char* ws = F.ws;
    if (DBG_SUB & 1) { launder(F);
        pg8::Gemm g{(const pg8::bf16_t*)(ws + WS_ACMP) + (size_t)l * CMP_ROWS * 1024, (const pg8::bf16_t*)(ws + WS_SMALLW + SW_W1T) + (size_t)l * 512 * 1024, CMP_ROWS, 512, 1024};
        CmpOrder S{F.G, F.bid}; EpiLH E{(bf16*)(ws + WS_LH)};
        pg8::gemm_phase<EpiLH, CmpOrder, true, true>(F.lds, g, S, E); }
    {
        unsigned* ctr = (unsigned*)(F.ws + WS_CTL) + 3210 + l; volatile LAS int* QI = (volatile LAS int*)(F.lds + MISC_OFF + 128);
#pragma unroll 1
        for (;;) {
            __syncthreads();
            if (F.tid == 0) QI[0] = (int)__hip_atomic_fetch_add(ctr, 1u, __ATOMIC_RELAXED, __HIP_MEMORY_SCOPE_AGENT);
            __syncthreads();
            const int u = __builtin_amdgcn_readfirstlane(QI[0]);
            if (u >= 768) break;
            launder(F);
            if (u < 256) rglru_unit<0>(F, l, u); else ret_local_unit(F, u - 256);
        }
        __syncthreads();
    } }
template <int l> __device__ __forceinline__ void ph_mix2(Frame& F) { cmp2_phase(F, l); ret_scan_phase(F, l); rglru_carry_phase(F, l); }
#ifndef DBG_REPQ
#define DBG_REPQ 0
#endif
constexpr int MQ_SA = 64, MQ_PA = MQ_SA + 512, MQ_RG1 = MQ_PA + 256, MQ_RO = MQ_RG1 + 512, MQ_RS = MQ_RO + 128, MQ_RG2 = MQ_RS + 32;
template <int l> __device__ __forceinline__ void ph_mix3(Frame& F) {
    unsigned* ctr = (unsigned*)(F.ws + WS_CTL) + 3200 + l;
    volatile LAS int* QI = (volatile LAS int*)(F.lds + MISC_OFF + 128);
#pragma unroll 1
    for (;;) {
        __syncthreads();
        if (F.tid == 0) QI[0] = (int)__hip_atomic_fetch_add(ctr, 1u, __ATOMIC_RELAXED, __HIP_MEMORY_SCOPE_AGENT);
        __syncthreads();
        const int u = __builtin_amdgcn_readfirstlane(QI[0]);
        if (u >= MQ_RG2) break;
        launder(F);
        if (u < MQ_SA) { attn_sample_unit(F, l, u); if (DBG_REPQ & 2) { launder(F); attn_sample_unit(F, l, u); } }
        else if (u < MQ_PA) { const int v = u - MQ_SA; attn_prompt_unit(F, l, (v & 7) * 64 + 63 - (v >> 3)); if (DBG_REPQ & 1) { launder(F); attn_prompt_unit(F, l, (v & 7) * 64 + 63 - (v >> 3)); } }
        else if (u < MQ_RG1) { rglru_unit<1>(F, l, u - MQ_PA); }
        else if (u < MQ_RO) { ret_out_unit(F, l, u - MQ_RG1); }
        else if (u < MQ_RS) { ret_sample_unit(F, l, u - MQ_RO); }
        else { rglru_unit<2>(F, l, u - MQ_RS); }
    }
    __syncthreads(); }
__device__ __forceinline__ f32x16 smp_tile_acc(Frame& F, const bf16* A, const bf16* Wt, int K, int tile) {
    const int q = F.lane & 31, h_ = F.lane >> 5, ks8 = K / 8, kb = F.wave * ks8;
    const bf16* ap = A + (size_t)((tile >> 5) * 32 + q) * K + kb + 8 * h_; const bf16* bp = Wt + (size_t)((tile & 31) * 32 + q) * K + kb + 8 * h_; f32x16 acc = (f32x16){};
#pragma unroll 11
    for (int kk = 0; kk < ks8 / 16; ++kk) acc = mfma32(*(const bf16x8*)(ap + 16 * kk), *(const bf16x8*)(bp + 16 * kk), acc);
    return acc;
}
__device__ __forceinline__ void smp_tile_put(Frame& F, const f32x16& acc, int slot) { LAS float* R = (LAS float*)(F.lds + slot * 32768) + F.wave * 1024 + F.lane;
#pragma unroll
    for (int r = 0; r < 16; ++r) R[r * 64] = acc[r]; }
__device__ __forceinline__ float smp_tile_get(Frame& F, int slot, int o) { const LAS float* R = (const LAS float*)(F.lds + slot * 32768) + o; float s = 0.f;
#pragma unroll
    for (int w = 0; w < 8; ++w) s += R[w * 1024];
    return s; }
template <int l> __device__ __forceinline__ void ph_br(Frame& F) { unsigned char* ws = F.ws;
    const pg8::bf16_t* wbr = (const pg8::bf16_t*)(ws + WS_WBR) + (size_t)l * 3 * 1024 * 512;
    for (int tile = F.bid; tile < 256; tile += F.G) {
        const f32x16 a0 = smp_tile_acc(F, (const bf16*)(ws + WS_OA) + (size_t)PM * 512, wbr, 512, tile), a1 = smp_tile_acc(F, (const bf16*)(ws + WS_OA) + (size_t)(MT + PM) * 512, wbr + (size_t)1024 * 512, 512, tile),
                     a2 = smp_tile_acc(F, (const bf16*)(ws + WS_OA) + (size_t)(2 * MT + PM) * 512, wbr + (size_t)2 * 1024 * 512, 512, tile);
        __syncthreads(); smp_tile_put(F, a0, 0); smp_tile_put(F, a1, 1); smp_tile_put(F, a2, 2); __syncthreads();
        const bf16* MG = (const bf16*)(ws + WS_MGS); bf16* MR = (bf16*)(ws + WS_MRG);
#pragma unroll
        for (int e = 0; e < 2; ++e) { const int o = F.tid * 2 + e, r = o >> 6, ln = o & 63; const size_t row = (size_t)PM + (tile >> 5) * 32 + (r & 3) + 8 * (r >> 2) + 4 * (ln >> 5); const int col = (tile & 31) * 32 + (ln & 31);
            const bf16* g = MG + row * 3072 + col; MR[row * DM + col] = (bf16)(pk2(bf1(g[0]) * smp_tile_get(F, 0, o) + bf1(g[1024]) * smp_tile_get(F, 1, o) + bf1(g[2048]) * smp_tile_get(F, 2, o), 0.f) & 0xffffu); }
    }
    __syncthreads();
    BrOrder S; S.S.init(PM, DM, F.G, F.bid);
    pg8::Gemm g{(const pg8::bf16_t*)(ws + WS_OA), wbr, 3 * MT, 3 * DM, 512}; EpiBrAll E{ws};
    pg8::gemm_phase<EpiBrAll, BrOrder, true, true>(F.lds, g, S, E); }
__device__ __forceinline__ void smp_res(Frame& F, const bf16* A, const bf16* Wt, int K, const float* xin  , float* xout  , const float* mod, int gofs) {
    for (int tile = F.bid; tile < 256; tile += F.G) {
        const f32x16 a = smp_tile_acc(F, A, Wt, K, tile);
        __syncthreads(); smp_tile_put(F, a, 0); __syncthreads();
#pragma unroll
        for (int e = 0; e < 2; ++e) { const int o = F.tid * 2 + e, r = o >> 6, ln = o & 63; const int rr = (tile >> 5) * 32 + (r & 3) + 8 * (r >> 2) + 4 * (ln >> 5), col = (tile & 31) * 32 + (ln & 31);
            xout[(size_t)rr * DM + col] = xin[(size_t)rr * DM + col] + mod[(size_t)(4 + (rr >> 3)) * 6144 + gofs + col] * smp_tile_get(F, 0, o); }
    }
    __syncthreads();
}
template <int l> __device__ __forceinline__ void ph_out(Frame& F) { unsigned char* ws = F.ws;
    const float* mod = (const float*)(ws + WS_MOD) + (size_t)l * 36 * 6144;
    smp_res(F, (const bf16*)(ws + WS_MRG) + (size_t)PM * DM, (const bf16*)(ws + WS_WOUT) + (size_t)l * DM * DM, DM, l == 0 ? FIN(I_XS) : (const float*)(ws + WS_X2) + (size_t)PM * DM, (float*)(ws + WS_X1) + (size_t)PM * DM, mod, 2048);
    pg8::Gemm g{(const pg8::bf16_t*)(ws + WS_MRG), (const pg8::bf16_t*)(ws + WS_WOUT) + (size_t)l * DM * DM, PM, DM, DM};
    pg8::StaticOrder S; S.init(PM, DM, F.G, F.bid);
    EpiRes E{l == 0 ? FIN(I_XP) : (const float*)(ws + WS_X2), nullptr, (float*)(ws + WS_X1), mod, 2048};
    pg8::gemm_phase<EpiRes, pg8::StaticOrder, true, true>(F.lds, g, S, E); }
template <int l> __device__ __forceinline__ void ph_down(Frame& F) { unsigned char* ws = F.ws;
    const float* mod = (const float*)(ws + WS_MOD) + (size_t)l * 36 * 6144;
    smp_res(F, (const bf16*)(ws + WS_GP) + (size_t)2 * MT * DFF + (size_t)PM * DFF, (const bf16*)(ws + WS_WDN) + (size_t)l * DM * DFF, DFF, (const float*)(ws + WS_X1) + (size_t)PM * DM, (float*)(ws + WS_X2) + (size_t)PM * DM, mod, 5120);
    pg8::Gemm g{(const pg8::bf16_t*)(ws + WS_GP) + (size_t)2 * MT * DFF, (const pg8::bf16_t*)(ws + WS_WDN) + (size_t)l * DM * DFF, PM, DM, DFF};
    pg8::StaticOrder S; S.init(PM, DM, F.G, F.bid);
    EpiRes E{(const float*)(ws + WS_X1), nullptr, (float*)(ws + WS_X2), mod, 5120};
    pg8::gemm_phase<EpiRes, pg8::StaticOrder, true, true>(F.lds, g, S, E); }
template <int l> __device__ __forceinline__ void ph_up(Frame& F) { unsigned char* ws = F.ws;
    pg8::Gemm g{(const pg8::bf16_t*)(ws + WS_H), (const pg8::bf16_t*)(ws + WS_WUP) + (size_t)l * NUP * DM, MT, NUP, DM};
    pg8::StaticOrder S; S.init(MT, NUP, F.G, F.bid); EpiUp E{ws, F.out, l};
    pg8::gemm_phase<EpiUp, pg8::StaticOrder, true, true>(F.lds, g, S, E); }
#define RUNPH(bit, ph, CALL) do { if (((DBG_MASK >> (bit)) & 1) && IN(ph)) { launder(F); CALL; if ((DBG_REPEAT >> (bit)) & 1) { launder(F); CALL; } SEAM(ph); } } while (0)
template <int l> __device__ __forceinline__ void layer_phases(Frame& F, const XcdBarrier& bar, int lo, int hi) {
    constexpr int pb = PH_L0 + l * PH_PER_LAYER;
    RUNPH(1, pb + LP_N1, norm_phase(F, l, 0));
    RUNPH(2, pb + LP_WIN, ph_win<l>(F));
    RUNPH(3, pb + LP_MIX1, ph_mix1<l>(F));
    RUNPH(4, pb + LP_MIX2, ph_mix2<l>(F));
    RUNPH(5, pb + LP_MIX3, ph_mix3<l>(F));
    RUNPH(6, pb + LP_BR, ph_br<l>(F));
    RUNPH(7, pb + LP_OUT, ph_out<l>(F));
    RUNPH(8, pb + LP_N2, norm_phase(F, l, 1));
    RUNPH(9, pb + LP_UP, ph_up<l>(F));
    RUNPH(10, pb + LP_CONV, convact_phase(F, l));
    RUNPH(11, pb + LP_DOWN, ph_down<l>(F));
}
__global__ void __launch_bounds__(NTHR, 2) trunk_fwd(Args args) {
    extern __shared__ __attribute__((aligned(16))) unsigned char lds_raw[];
    Frame F;
    F.lds = (LAS unsigned char*)lds_raw;
    F.tid = threadIdx.x; F.lane = F.tid & 63; F.wave = __builtin_amdgcn_readfirstlane(F.tid >> 6);
    F.G = gridDim.x; F.bid = blockIdx.x; F.a = &args; F.ws = args.ws; F.out = args.out;
    volatile LAS unsigned* MISC = (volatile LAS unsigned*)(F.lds + MISC_OFF);
    for (int u = F.tid; u < 64; u += NTHR) MISC[u] = 0u;
    __syncthreads();
    unsigned* barw = (unsigned*)(F.ws + WS_CTL) + CW_BAR;
    XcdBarrier bar; bar.bar = barw; bar.x = 0; bar.st = nullptr;
    if (MK_N_LAUNCHES == 1) bar = xcd_barrier_post(barw, MISC + 8);
    const int lo = args.ph_lo, hi = args.ph_hi;
    unsigned char* ws = F.ws;

#ifdef DBG_TIME
    if (F.bid == 0 && F.tid == 0) ((unsigned long long*)(F.ws + WS_CTL))[2048] = __builtin_amdgcn_s_memrealtime();
#endif
    RUNPH(0, PH_P0, p0_prologue(F));

    layer_phases<0>(F, bar, lo, hi);
    layer_phases<1>(F, bar, lo, hi);
    if (((DBG_MASK >> 12) & 1) && IN(PH_FINAL)) { launder(F); final_phase(F); if ((DBG_REPEAT >> 12) & 1) { launder(F); final_phase(F); } }
#ifdef DBG_TIME
    {
        xcd_barrier(bar);
        if (F.bid == 0 && F.tid < 14) {
            const unsigned long long* ts = (const unsigned long long*)(F.ws + WS_CTL) + 2048; const unsigned long long tend = __builtin_amdgcn_s_memrealtime();
            const size_t ooff[14] = {OUT_Y, OUT_Y + (size_t)PM * DM, OUT_ROWS_P, OUT_ROWS_S, OUT_WIN_P, OUT_WIN_S, OUT_RET_P, OUT_RET_S, OUT_H_P, OUT_H_S, OUT_CV_P, OUT_CV_S, OUT_FC_P, OUT_FC_S};
            const int b = F.tid; unsigned long long d;
            if (b == 0) d = tend - ts[0]; else if (b == 1) d = ts[1] - ts[0]; else if (b == 13) d = tend - ts[PH_FINAL];
            else { const int ph = PH_L0 + DBG_TIME_LAYER * PH_PER_LAYER + (b - 2); d = ts[ph + 1] - ts[ph]; }
            int cnt = (int)(d / 100ull); if (cnt < 1) cnt = 1; if (cnt > 2000 && b != 0) cnt = 2000;
            for (int i = 0; i < cnt; ++i) ((unsigned*)F.out)[ooff[b] + 7 + 2 * i] = 0xAAAAAAAAu;
        }
    }
#endif
#ifdef DBG_COUNT
    {
        xcd_barrier(bar);
        if (F.bid == 0 && F.tid < 3) { const unsigned* CNT = (const unsigned*)(F.ws + WS_CTL) + 3000; const size_t ooff[3] = {OUT_Y, OUT_Y + (size_t)PM * DM, OUT_ROWS_P};
            const int cnt = (int)((unsigned long long)CNT[F.tid] * 10ull / (CNT[3] ? CNT[3] : 1u)); for (int i = 0; i < cnt; ++i) ((unsigned*)F.out)[ooff[F.tid] + 7 + 2 * i] = 0xAAAAAAAAu; }
    }
#endif
#ifdef DBG_CHECK
    if (lo == 100) { launder(F); dbg_check_phase(F); }
    if (lo == 101) { for (size_t i = (size_t)F.bid * NTHR + F.tid; i < OUT_END; i += (size_t)F.G * NTHR) F.out[i] = 0.f; }
    if (lo == 102) { launder(F); dbg_report_phase(F); }
#endif
}

extern "C" void kernel_launch(void* const* d_in, const int* in_sizes, int n_in, void* d_out, int out_size, void* d_ws, size_t ws_size, hipStream_t stream) {
    static int grid = 0;
    if (grid == 0) {
        if (n_in != 37 || (size_t)out_size != OUT_END || ws_size < WS_END) { fprintf(stderr, "kernel_launch: unexpected shapes: n_in %d out %d (want %zu) ws %zu (want %zu)\n", n_in, out_size, (size_t)OUT_END, ws_size, (size_t)WS_END); grid = -1; return; }
        int dev = 0, cus = 0, per_cu = 0;
        if (hipGetDevice(&dev) != hipSuccess || hipDeviceGetAttribute(&cus, hipDeviceAttributeMultiprocessorCount, dev) != hipSuccess) { grid = -1; return; }
        if (hipFuncSetAttribute((const void*)trunk_fwd, hipFuncAttributeMaxDynamicSharedMemorySize, LDS_BYTES) != hipSuccess) { fprintf(stderr, "kernel_launch: hipFuncSetAttribute failed\n"); grid = -1; return; }
        if (hipOccupancyMaxActiveBlocksPerMultiprocessor(&per_cu, (const void*)trunk_fwd, NTHR, LDS_BYTES) != hipSuccess || per_cu < 1) fprintf(stderr, "kernel_launch: occupancy query reports %d\n", per_cu);
        (void)hipGetLastError();
        grid = cus;
    }
    if (grid < 0) return;
    if (hipMemsetAsync((char*)d_ws + WS_CTL, 0, CTL_ZERO_BYTES, stream) != hipSuccess) return;
#ifdef DBG_POISON
    (void)hipMemsetAsync((char*)d_ws + CTL_ZERO_BYTES, 0xAA, WS_END - CTL_ZERO_BYTES, stream);
    (void)hipMemsetAsync(d_out, 0xAA, (size_t)OUT_END * 4, stream);
#endif
    Args a{};
    for (int i = 0; i < 37; ++i) a.in[i] = d_in[i];
    a.out = (float*)d_out; a.ws = (unsigned char*)d_ws;
#if MK_N_LAUNCHES == 1
    a.ph_lo = 0; a.ph_hi = N_PHASES;
    hipLaunchKernelGGL(trunk_fwd, dim3(grid), dim3(NTHR), LDS_BYTES, stream, a);
#else
    for (int p = 0; p < DBG_MAXPH; ++p) { a.ph_lo = p; a.ph_hi = p + 1; hipLaunchKernelGGL(trunk_fwd, dim3(grid), dim3(NTHR), LDS_BYTES, stream, a); }
#ifdef DBG_CHECK
    for (int p = 100; p < 103; ++p) { a.ph_lo = p; a.ph_hi = p + 1; hipLaunchKernelGGL(trunk_fwd, dim3(grid), dim3(NTHR), LDS_BYTES, stream, a); }
#endif
#endif
    (void)in_sizes;
}
```

```cpp
#include <hip/hip_runtime.h>
#include <cstdio>
#include <cstdint>

#ifndef MK_N_LAUNCHES
#define MK_N_LAUNCHES 1
#endif

constexpr int DM = 1024, PB = 4, PT = 4096, PM = PB * PT, SB = 32, ST = 8, SM = SB * ST, MT = PM + SM;
constexpr int DEPTH = 2, PAST = 8192, PAGE = 128, NPG = PAST / PAGE, NPHYS = 2560;
constexpr int D_IN = 7448, NIN = 7680, DFF = 2816, NUP = 2 * DFF;
constexpr int WINB = 512;
constexpr float EPS = 1e-6f;
constexpr float QSCALE = 0.125f * 1.4426950408889634f;

constexpr int O_NQ = 0, O_NKV = 512, O_NG = 1280, O_RQ = 1304, O_RK = 1816, O_RV = 2328, O_RG = 2840, O_RX = 3352, O_RGATE = 3864, O_MG = 4376;

constexpr size_t OUT_Y = 0;
constexpr size_t OUT_ROWS_P = OUT_Y + (size_t)MT * DM;
constexpr size_t OUT_ROWS_S = OUT_ROWS_P + (size_t)DEPTH * PM * 512;
constexpr size_t OUT_WIN_P = OUT_ROWS_S + (size_t)DEPTH * SM * 512;
constexpr size_t OUT_WIN_S = OUT_WIN_P + (size_t)DEPTH * PB * WINB * 256;
constexpr size_t OUT_RET_P = OUT_WIN_S + (size_t)DEPTH * SB * WINB * 256;
constexpr size_t OUT_RET_S = OUT_RET_P + (size_t)DEPTH * PB * 4 * 16384;
constexpr size_t OUT_H_P = OUT_RET_S + (size_t)DEPTH * SB * 4 * 16384;
constexpr size_t OUT_H_S = OUT_H_P + (size_t)DEPTH * PB * 512;
constexpr size_t OUT_CV_P = OUT_H_S + (size_t)DEPTH * SB * 512;
constexpr size_t OUT_CV_S = OUT_CV_P + (size_t)DEPTH * PB * 3 * 512;
constexpr size_t OUT_FC_P = OUT_CV_S + (size_t)DEPTH * SB * 3 * 512;
constexpr size_t OUT_FC_S = OUT_FC_P + (size_t)DEPTH * PB * 2 * DFF;
constexpr size_t OUT_END = OUT_FC_S + (size_t)DEPTH * SB * 2 * DFF;

constexpr size_t MiB = 1u << 20;
constexpr size_t WS_CTL = 0, CTL_ZERO_BYTES = 4 * MiB;
constexpr size_t WS_MOD = 1 * MiB;
constexpr size_t WS_ROT = 4 * MiB;
constexpr size_t WS_SMALLW = 8 * MiB;
constexpr size_t WS_WIN = 16 * MiB;
constexpr size_t WS_WBR = WS_WIN + (size_t)2 * NIN * DM * 2;
constexpr size_t WS_WOUT = WS_WBR + (size_t)2 * 3 * 1024 * 512 * 2;
constexpr size_t WS_WUP = WS_WOUT + (size_t)2 * 1024 * 1024 * 2;
constexpr size_t WS_WDN = WS_WUP + (size_t)2 * NUP * DM * 2;
constexpr size_t WS_WEND = WS_WDN + (size_t)2 * DM * DFF * 2;
constexpr size_t WS_H = 128 * MiB;
constexpr size_t WS_QN = WS_H + (size_t)MT * DM * 2;
constexpr size_t WS_KVB = WS_QN + (size_t)MT * 512 * 2;
constexpr size_t WS_KVS = WS_KVB + (size_t)4 * PB * 2 * PT * 64 * 2;
constexpr size_t WS_RQ = WS_KVS + (size_t)4 * SB * 2 * ST * 64 * 2;
constexpr size_t WS_RX = WS_RQ + (size_t)4 * MT * 512 * 2;
constexpr size_t WS_GG = WS_RX + (size_t)MT * 512 * 4;
constexpr size_t WS_MGS = WS_GG + (size_t)MT * 512 * 2;
constexpr size_t WS_NG = WS_MGS + (size_t)MT * 3072 * 2;
constexpr size_t WS_OA = WS_NG + (size_t)MT * 24 * 4;
constexpr size_t WS_MRG = WS_OA + (size_t)3 * MT * 512 * 2;
constexpr size_t WS_X1 = WS_MRG + (size_t)MT * DM * 2;
constexpr size_t WS_X2 = WS_X1 + (size_t)MT * DM * 4;
constexpr size_t WS_GP = WS_X2 + (size_t)MT * DM * 4;
constexpr size_t WS_ACMP = WS_GP + (size_t)3 * MT * DFF * 2;
constexpr int CMP_ROWS_J = 34816, CMP_ROWS = 2 * CMP_ROWS_J;
constexpr size_t WS_LH = WS_ACMP + (size_t)2 * CMP_ROWS * 1024 * 2 + 4096;
constexpr size_t WS_CK = WS_LH + (size_t)(CMP_ROWS + 16) * 256 * 2;
constexpr size_t WS_LT = WS_CK + (size_t)CMP_ROWS * 64 * 2;
constexpr size_t WS_SPT = WS_LT + (size_t)16 * 32 * 16384 * 4;
constexpr size_t WS_CAR = WS_SPT + (size_t)16 * 32 * 16384 * 2;
constexpr size_t WS_OAG = WS_CAR + (size_t)4 * 64 * 3 * 512 * 4 + MiB;
constexpr size_t WS_END = WS_OAG + (size_t)2048 * 32 * 64 * 4 + MiB;
static_assert(WS_WEND <= WS_H, "weights fit below WS_H");

constexpr size_t SW_W1T = 0;
constexpr size_t SW_W2T = SW_W1T + (size_t)2 * 2 * 256 * 1024 * 2;
constexpr size_t SW_CB = SW_W2T + (size_t)2 * 2 * 64 * 128 * 2;
constexpr size_t SW_WAT = SW_CB + (size_t)2 * 2 * 128 * 4;
constexpr size_t SW_SP = SW_WAT + (size_t)2 * 2 * 8 * 64 * 64 * 2;
constexpr size_t SW_END = SW_SP + 2 * 512 * 4;
static_assert(SW_END <= 8 * MiB, "small weights fit");

constexpr int CW_TMO = 0;
constexpr int CW_BAR = 4096;

constexpr int PH_P0 = 0, PH_L0 = 1, PH_PER_LAYER = 11, PH_FINAL = PH_L0 + DEPTH * PH_PER_LAYER, N_PHASES = PH_FINAL + 1;
enum { LP_N1 = 0, LP_WIN, LP_MIX1, LP_MIX2, LP_MIX3, LP_BR, LP_OUT, LP_N2, LP_UP, LP_CONV, LP_DOWN };

constexpr int RING_BYTES = 131072;
constexpr int MISC_OFF = RING_BYTES;
constexpr int LDS_BYTES = RING_BYTES + 1024;
constexpr int NWAVES = 8, NTHR = 512;

#define GAS __attribute__((address_space(1)))
#define LAS __attribute__((address_space(3)))
typedef unsigned short bf16;
typedef unsigned v4u __attribute__((ext_vector_type(4)));
typedef unsigned v2u __attribute__((ext_vector_type(2)));
typedef float f32x16 __attribute__((ext_vector_type(16)));
typedef short s16x4 __attribute__((ext_vector_type(4)));
namespace pg8 {
#define PG8_LAS __attribute__((address_space(3)))
typedef unsigned short bf16_t;
typedef short bf16x8 __attribute__((ext_vector_type(8)));
typedef float f32x4 __attribute__((ext_vector_type(4)));
typedef unsigned u32x4 __attribute__((ext_vector_type(4)));
constexpr int BM = 256, BK = 64, HALF = 128, HTB = HALF * BK * 2  , STAGE_BYTES = 8 * HTB, NXCD = 8, WGM = 8;

__host__ __device__ __forceinline__ int lds_byte(int r, int c) { const int st = (r >> 4) * 2 + (c >> 5), rr = r & 15, cc = c & 31, ob = rr * 64 + cc * 2; return st * 1024 + (ob ^ (((ob >> 9) & 1) << 5)); }
__host__ __device__ __forceinline__ void stage_rc(int b, int& R, int& C) { const int st = b / 1024, sb = b % 1024, swz = sb ^ (((sb >> 9) & 1) << 5); R = (st >> 1) * 16 + swz / 64; C = (st & 1) * 32 + (swz % 64) / 2; }
__host__ __device__ __forceinline__ int perm32(int rho) { const int n = rho >> 4, i = rho & 15; return 8 * (i >> 2) + 4 * n + (i & 3); }

struct Unit { int pm, pn; };
struct Gemm { const bf16_t* A; const bf16_t* Bt; int M, N, K; };

struct StaticOrder {
    int nM, nN, nwg, G, c;
    __host__ __device__ void init(int M, int N, int G_, int c_) { nM = M / BM; nN = N / BM; nwg = nM * nN; G = G_; c = c_; }
    __host__ __device__ bool next(int i, Unit& u) const {
        const long L = (long)i * G + c; if (L >= nwg) return false;
        int wgid = (int)L; { const int q = nwg / NXCD, r = nwg % NXCD, xcd = wgid % NXCD, off = wgid / NXCD; wgid = (xcd < r ? xcd * (q + 1) : r * (q + 1) + (xcd - r) * q) + off; }
        const int nig = WGM * nN, gid = wgid / nig, fm = gid * WGM, gsz = (nM - fm) < WGM ? (nM - fm) : WGM;
        u.pm = fm + ((wgid % nig) % gsz); u.pn = (wgid % nig) / gsz; return true;
    }
    __device__ __forceinline__ void a_ready(const Unit&) const {}
    __device__ __forceinline__ void done(const Unit&) const {}
};
__device__ __forceinline__ unsigned cvt_pk_bf16(float lo, float hi) { unsigned r; asm volatile("v_cvt_pk_bf16_f32 %0, %1, %2" : "=v"(r) : "v"(lo), "v"(hi)); return r; }
typedef float f32x2 __attribute__((ext_vector_type(2)));
template <class Epi, class Sched, bool ALIGN_EPI = false, bool SP2 = false>
__device__ __forceinline__ void gemm_phase(PG8_LAS unsigned char* lds, const Gemm g, const Sched& S, const Epi& E) {
    const int tid = threadIdx.x, wid = __builtin_amdgcn_readfirstlane(tid >> 6), lane = tid & 63, wr = wid >> 2, wc = wid & 3, fr = lane & 15, fq = lane >> 4;
    const int K = g.K, nt = K / BK;
    unsigned voffA[2], voffB[2];
#pragma unroll
    for (int i = 0; i < 2; ++i) { int R, C; stage_rc(tid * 16 + i * 8192, R, C); const int Rb = Epi::PERM ? ((R & ~31) + perm32(R & 31)) : R;
        voffA[i] = (unsigned)(R * K + C) * 2u; voffB[i] = (unsigned)(Rb * K + C) * 2u; }
    const size_t kstep = (size_t)(BK * 2);
    const size_t hstep = (size_t)HALF * K * 2;
    const size_t tstep = 2 * hstep;
    const unsigned ldsw = (unsigned)wid * 1024u;
    const int aoff = lds_byte(wr * 64 + fr, fq * 8), boff = lds_byte(wc * 32 + fr, fq * 8);
#define PG8_SA(b, h) (((b) * 2 + (h)) * HTB)
#define PG8_SB(b, h) ((4 + (b) * 2 + (h)) * HTB)
#define PG8_STAGE(bufoff, gbase, voff) do { _Pragma("unroll") for (int _i = 0; _i < 2; ++_i) \
        __builtin_amdgcn_global_load_lds((const unsigned*)((const char*)(gbase) + (voff)[_i]), (PG8_LAS unsigned*)(lds + (bufoff) + ldsw + _i * 8192), 16, 0, 0); } while (0)
#define PG8_LDA(dst, b, h) do { _Pragma("unroll") for (int m = 0; m < 4; ++m) _Pragma("unroll") for (int k = 0; k < 2; ++k) dst[m][k] = *(const PG8_LAS bf16x8*)(lds + PG8_SA(b, h) + aoff + m * 2048 + k * 1024); } while (0)
#define PG8_LDB(dst, b, h) do { _Pragma("unroll") for (int n = 0; n < 2; ++n) _Pragma("unroll") for (int k = 0; k < 2; ++k) dst[n][k] = *(const PG8_LAS bf16x8*)(lds + PG8_SB(b, h) + boff + n * 2048 + k * 1024); } while (0)
#define PG8_MMA(ai, bj, At, Bt) do { __builtin_amdgcn_s_setprio(1); _Pragma("unroll") for (int m = 0; m < 4; ++m) _Pragma("unroll") for (int n = 0; n < 2; ++n) _Pragma("unroll") for (int k = 0; k < 2; ++k) \
        acc[ai][bj][m][n] = __builtin_amdgcn_mfma_f32_16x16x32_bf16(Bt[n][k], At[m][k], acc[ai][bj][m][n], 0, 0, 0); __builtin_amdgcn_s_setprio(0); } while (0)
#define PG8_WAIT_V(n) asm volatile("s_waitcnt vmcnt(" #n ")" ::: "memory")
#define PG8_WAIT_L(n) asm volatile("s_waitcnt lgkmcnt(" #n ")" ::: "memory")
#define PG8_BAR __builtin_amdgcn_s_barrier()
#define PG8_SCHED __builtin_amdgcn_sched_barrier(0)
    Unit cur, nxt; int ui = 0;
    if (!S.next(0, cur)) return;
    f32x4 acc[2][2][4][2];
#pragma unroll
    for (int a = 0; a < 2; ++a)
#pragma unroll
        for (int b = 0; b < 2; ++b)
#pragma unroll
            for (int m = 0; m < 4; ++m)
#pragma unroll
                for (int n = 0; n < 2; ++n) acc[a][b][m][n] = (f32x4){0.f, 0.f, 0.f, 0.f};
    bf16x8 At[4][2], B0[2][2], B1[2][2];
    const char* cA = (const char*)g.A + (size_t)cur.pm * tstep; const char* cB = (const char*)g.Bt + (size_t)cur.pn * tstep;
    S.a_ready(cur);
    if constexpr (SP2) {
        PG8_STAGE(PG8_SB(0, 0), cB, voffB); PG8_STAGE(PG8_SB(0, 1), cB + hstep, voffB); PG8_STAGE(PG8_SA(0, 0), cA, voffA); PG8_STAGE(PG8_SA(0, 1), cA + hstep, voffA);
        if (wr == 1) PG8_BAR;
        PG8_WAIT_V(2); PG8_BAR;
        PG8_STAGE(PG8_SB(1, 0), cB + kstep, voffB); PG8_STAGE(PG8_SA(1, 0), cA + kstep, voffA); PG8_STAGE(PG8_SB(1, 1), cB + hstep + kstep, voffB);
        PG8_WAIT_V(6); PG8_BAR;
    } else {
        PG8_STAGE(PG8_SB(0, 0), cB, voffB); PG8_STAGE(PG8_SA(0, 0), cA, voffA); PG8_STAGE(PG8_SB(0, 1), cB + hstep, voffB); PG8_STAGE(PG8_SA(0, 1), cA + hstep, voffA);
        if (wr == 1) PG8_BAR;
        PG8_WAIT_V(4); PG8_BAR;
        PG8_STAGE(PG8_SB(1, 0), cB + kstep, voffB); PG8_STAGE(PG8_SA(1, 0), cA + kstep, voffA); PG8_STAGE(PG8_SB(1, 1), cB + hstep + kstep, voffB);
        PG8_WAIT_V(6); PG8_BAR;
    }
    for (;;) {
        const bool has_next = S.next(ui + 1, nxt);
        const char* nA = has_next ? (const char*)g.A + (size_t)nxt.pm * tstep : cA; const char* nB = has_next ? (const char*)g.Bt + (size_t)nxt.pn * tstep : cB;
        for (int t = 0; t < nt; t += 2) {
            const bool last = (t == nt - 2);
            const char* a1 = cA + (size_t)(t + 1) * kstep;
            const char* a2 = last ? nA : cA + (size_t)(t + 2) * kstep; const char* b2 = last ? nB : cB + (size_t)(t + 2) * kstep;
            const char* a3 = a2 + kstep; const char* b3 = b2 + kstep;
            if (last && has_next) S.a_ready(nxt);
            if constexpr (SP2) {
            PG8_LDB(B0, 0, 0); PG8_LDB(B1, 0, 1); PG8_SCHED; PG8_LDA(At, 0, 0); PG8_STAGE(PG8_SA(1, 1), a1 + hstep, voffA);
            PG8_WAIT_V(8); PG8_WAIT_L(0); PG8_BAR; PG8_MMA(0, 0, At, B0); PG8_MMA(0, 1, At, B1); PG8_BAR; PG8_SCHED;
            PG8_LDA(At, 0, 1); PG8_STAGE(PG8_SB(0, 0), b2, voffB); PG8_STAGE(PG8_SB(0, 1), b2 + hstep, voffB); PG8_STAGE(PG8_SA(0, 0), a2, voffA);
            PG8_WAIT_V(8); PG8_WAIT_L(0); PG8_BAR; PG8_MMA(1, 0, At, B0); PG8_MMA(1, 1, At, B1); PG8_BAR; PG8_SCHED;
            PG8_LDB(B0, 1, 0); PG8_LDB(B1, 1, 1); PG8_SCHED; PG8_LDA(At, 1, 0); PG8_STAGE(PG8_SA(0, 1), a2 + hstep, voffA);
            PG8_WAIT_V(8); PG8_WAIT_L(0); PG8_BAR; PG8_MMA(0, 0, At, B0); PG8_MMA(0, 1, At, B1); PG8_BAR; PG8_SCHED;
            PG8_LDA(At, 1, 1); PG8_STAGE(PG8_SB(1, 0), b3, voffB); PG8_STAGE(PG8_SB(1, 1), b3 + hstep, voffB); PG8_STAGE(PG8_SA(1, 0), a3, voffA);
            PG8_WAIT_V(8); PG8_WAIT_L(0); PG8_BAR; PG8_MMA(1, 0, At, B0); PG8_MMA(1, 1, At, B1); PG8_BAR; PG8_SCHED;
            } else {
            PG8_LDB(B0, 0, 0); PG8_SCHED; PG8_LDA(At, 0, 0); PG8_STAGE(PG8_SA(1, 1), a1 + hstep, voffA);
            PG8_WAIT_L(8); PG8_BAR; PG8_WAIT_L(0); PG8_MMA(0, 0, At, B0); PG8_BAR; PG8_SCHED;
            PG8_LDB(B1, 0, 1); PG8_STAGE(PG8_SB(0, 0), b2, voffB);
            PG8_BAR; PG8_WAIT_L(0); PG8_MMA(0, 1, At, B1); PG8_BAR;
            PG8_LDA(At, 0, 1); PG8_STAGE(PG8_SA(0, 0), a2, voffA);
            PG8_BAR; PG8_WAIT_L(0); PG8_MMA(1, 0, At, B0); PG8_BAR; PG8_SCHED;
            PG8_STAGE(PG8_SB(0, 1), b2 + hstep, voffB);
            PG8_WAIT_V(6); PG8_BAR; PG8_MMA(1, 1, At, B1); PG8_BAR;
            PG8_LDB(B0, 1, 0); PG8_SCHED; PG8_LDA(At, 1, 0); PG8_STAGE(PG8_SA(0, 1), a2 + hstep, voffA);
            PG8_WAIT_L(8); PG8_BAR; PG8_WAIT_L(0); PG8_MMA(0, 0, At, B0); PG8_BAR; PG8_SCHED;
            PG8_LDB(B1, 1, 1); PG8_STAGE(PG8_SB(1, 0), b3, voffB);
            PG8_BAR; PG8_WAIT_L(0); PG8_MMA(0, 1, At, B1); PG8_BAR;
            PG8_LDA(At, 1, 1); PG8_STAGE(PG8_SA(1, 0), a3, voffA);
            PG8_BAR; PG8_WAIT_L(0); PG8_MMA(1, 0, At, B0); PG8_BAR; PG8_SCHED;
            PG8_STAGE(PG8_SB(1, 1), b3 + hstep, voffB);
            PG8_WAIT_V(6); PG8_BAR; PG8_MMA(1, 1, At, B1); PG8_BAR;
            }
        }
        if constexpr (ALIGN_EPI) { if (wr == 0) PG8_BAR; }
        if constexpr (!Epi::AFTER_DRAIN) { E(acc, cur, wr, wc, fr, fq); S.done(cur); }
        if (!has_next) break;
#pragma unroll
        for (int a = 0; a < 2; ++a)
#pragma unroll
            for (int b = 0; b < 2; ++b)
#pragma unroll
                for (int m = 0; m < 4; ++m)
#pragma unroll
                    for (int n = 0; n < 2; ++n) acc[a][b][m][n] = (f32x4){0.f, 0.f, 0.f, 0.f};
        cur = nxt; cA = nA; cB = nB; ++ui;
        if constexpr (ALIGN_EPI) { if (wr == 1) PG8_BAR; }
    }
    PG8_WAIT_V(0);
    if constexpr (!ALIGN_EPI) { if (wr == 0) PG8_BAR; }
    PG8_BAR;
    if constexpr (Epi::AFTER_DRAIN) { E.fused(acc, cur, wr, wc, fr, fq, lds, wid, lane); S.done(cur); }
#undef PG8_SA
#undef PG8_SB
#undef PG8_STAGE
#undef PG8_LDA
#undef PG8_LDB
#undef PG8_MMA
#undef PG8_WAIT_V
#undef PG8_WAIT_L
#undef PG8_BAR
#undef PG8_SCHED
}
}

using pg8::bf16x8; using pg8::f32x4; using pg8::u32x4;
#define LDS_WAIT() asm volatile("s_waitcnt lgkmcnt(0)" ::: "memory")
#define VM_WAIT() asm volatile("s_waitcnt vmcnt(0)" ::: "memory")
typedef float f32x2_t __attribute__((ext_vector_type(2))); typedef __bf16 bf16x2_t __attribute__((ext_vector_type(2)));
__device__ __forceinline__ unsigned pk2(float lo, float hi) { f32x2_t v = {lo, hi}; bf16x2_t b = __builtin_convertvector(v, bf16x2_t); return __builtin_bit_cast(unsigned, b); }
__device__ __forceinline__ float bf_lo(unsigned w) { return __uint_as_float(w << 16); }
__device__ __forceinline__ float bf_hi(unsigned w) { return __uint_as_float(w & 0xffff0000u); }
__device__ __forceinline__ float bf1(bf16 b) { return __uint_as_float(((unsigned)b) << 16); }
__device__ __forceinline__ float fexp2(float x) { return __builtin_amdgcn_exp2f(x); }
__device__ __forceinline__ float fexp(float x) { return __builtin_amdgcn_exp2f(x * 1.4426950408889634f); }
__device__ __forceinline__ float frcp(float x) { return __builtin_amdgcn_rcpf(x); }
__device__ __forceinline__ float sigmoidf_(float x) { return frcp(1.0f + fexp(-x)); }
__device__ __forceinline__ float siluf_(float x) { return x * sigmoidf_(x); }
__device__ __forceinline__ float gelu_tanh(float x) {
    const float u = 0.7978845608028654f * (x + 0.044715f * x * x * x);
    const float e = fexp(2.0f * u);
    const float t = 1.0f - 2.0f * frcp(e + 1.0f);
    return 0.5f * x * (1.0f + t);
}
__device__ __forceinline__ float wave_sum(float v) {
#pragma unroll
    for (int o = 1; o < 64; o <<= 1) v += __shfl_xor(v, o);
    return v;
}
__device__ __forceinline__ v4u pack8(const f32x4 a, const f32x4 b) { v4u w; w.x = pk2(a[0], a[1]); w.y = pk2(a[2], a[3]); w.z = pk2(b[0], b[1]); w.w = pk2(b[2], b[3]); return w; }
__device__ __forceinline__ void unpack8(const v4u w, f32x4& a, f32x4& b) { a = (f32x4){bf_lo(w.x), bf_hi(w.x), bf_lo(w.y), bf_hi(w.y)}; b = (f32x4){bf_lo(w.z), bf_hi(w.z), bf_lo(w.w), bf_hi(w.w)}; }

#define XB_TMO      128
#define XB_XCNT(j)  (256  + 64 * (j))
#define XB_XSUB(j)  (1280 + 64 * (j))
#define XB_XGEN(j)  (2304 + 64 * (j))
#define XB_TOP      3328
#define XB_TOPGEN   3392
#define XCD_BAR_WORDS 3456
#define XB_SPIN_CAP (1u << 18)

__device__ __forceinline__ unsigned xb_ld(unsigned* p)              { return __hip_atomic_load(p, __ATOMIC_RELAXED, __HIP_MEMORY_SCOPE_AGENT); }
__device__ __forceinline__ unsigned xb_add(unsigned* p, unsigned v) { return __hip_atomic_fetch_add(p, v, __ATOMIC_RELAXED, __HIP_MEMORY_SCOPE_AGENT); }
__device__ __forceinline__ unsigned xb_xcc_id() { return (unsigned)__builtin_amdgcn_s_getreg((3 << 11) | 20) & 0xFu; }
#define XB_SPIN(cond, bar) do { unsigned _sp = 0; while (cond) { __builtin_amdgcn_s_sleep(1); \
    if ((++_sp & 255u) == 0u) { if (xb_ld(&(bar)[XB_TMO])) break; if (_sp > XB_SPIN_CAP) { atomicAdd(&(bar)[XB_TMO], 1u); break; } } } } while (0)

struct XcdBarrier {
    unsigned* bar; unsigned x;
    volatile LAS unsigned* st;
};

__device__ __forceinline__ XcdBarrier xcd_barrier_post(unsigned* bar, volatile LAS unsigned* st) {
    XcdBarrier b; b.bar = bar; b.x = xb_xcc_id(); b.st = st;
    if (threadIdx.x == 0) (void)xb_add(&bar[XB_XCNT(b.x)], 1u);
    return b;
}
__device__ __forceinline__ void xcd_barrier_complete(unsigned* bar, unsigned x, unsigned& nloc, unsigned& nx) {
    const unsigned G = gridDim.x * gridDim.y * gridDim.z;
    unsigned sum, cnt, mine, sp = 0u;
    for (;;) {
        sum = 0u; cnt = 0u; mine = 0u;
#pragma unroll
        for (unsigned j = 0; j < 16; ++j) { const unsigned c = xb_ld(&bar[XB_XCNT(j)]); sum += c; cnt += (c > 0u) ? 1u : 0u; mine = (j == x) ? c : mine; }
        if (sum == G) break;
        __builtin_amdgcn_s_sleep(1);
        if ((++sp & 255u) == 0u) { if (xb_ld(&bar[XB_TMO])) break; if (sp > XB_SPIN_CAP) { atomicAdd(&bar[XB_TMO], 1u); break; } }
    }
    nloc = mine > 0u ? mine : 1u; nx = cnt > 0u ? cnt : 1u;
}

__device__ __forceinline__ void xcd_barrier(const XcdBarrier& b) {
    asm volatile("s_waitcnt vmcnt(0)" ::: "memory");
    __syncthreads();
    if (threadIdx.x == 0) {
        unsigned* bar = b.bar;
        __builtin_amdgcn_s_waitcnt(0);
        unsigned nloc = b.st[0], nx = b.st[1];
        if (nloc == 0u) { xcd_barrier_complete(bar, b.x, nloc, nx); b.st[0] = nloc; b.st[1] = nx; }
        const unsigned old = xb_add(&bar[XB_XSUB(b.x)], 1u);
        const unsigned gen = old / nloc;
        if (old + 1u == (gen + 1u) * nloc) {
            __builtin_amdgcn_fence(__ATOMIC_RELEASE, "agent");
            asm volatile("s_waitcnt vmcnt(0)" ::: "memory");
            const unsigned og = xb_add(&bar[XB_TOP], 1u);
            const unsigned tg = og / nx;
            if (og + 1u == (tg + 1u) * nx) xb_add(&bar[XB_TOPGEN], 1u);
            else XB_SPIN(xb_ld(&bar[XB_TOPGEN]) == tg, bar);
            __builtin_amdgcn_fence(__ATOMIC_ACQUIRE, "agent");
            xb_add(&bar[XB_XGEN(b.x)], 1u);
            asm volatile("s_waitcnt vmcnt(0)" ::: "memory");
        } else {
            XB_SPIN(xb_ld(&bar[XB_XGEN(b.x)]) == gen, bar);
            __builtin_amdgcn_fence(__ATOMIC_ACQUIRE, "agent");
            asm volatile("s_waitcnt vmcnt(0)" ::: "memory");
        }
    }
    __syncthreads();
}

struct Args { const void* in[37]; float* out; unsigned char* ws; int ph_lo, ph_hi; };
enum { I_XP = 0, I_XS, I_CACHE, I_CWIN, I_SRET, I_SH, I_SCONV, I_SFFN, I_PT, I_CP, I_CS, I_N1G, I_N2G, I_WADA, I_BADA, I_WIN, I_PE, I_W1, I_B1, I_W2,
       I_GNG, I_RCW, I_RCB, I_RWA, I_RBA, I_RWX, I_RBX, I_LAM, I_WBRA, I_WBRB, I_WBRC, I_WOUT, I_WUP, I_FCW, I_FCB, I_WDN, I_FNG };

struct Frame {
    LAS unsigned char* lds;
    int tid, lane, wave, G, bid;
    const Args* a;
    unsigned char* ws;
    float* out;
};
__device__ __forceinline__ void launder(Frame& F) { asm volatile("" : "+v"(F.tid), "+v"(F.lane)); int w_ = __builtin_amdgcn_readfirstlane(F.wave), b_ = __builtin_amdgcn_readfirstlane(F.bid), g_ = __builtin_amdgcn_readfirstlane(F.G); asm volatile("" : "+s"(w_), "+s"(b_), "+s"(g_)); F.wave = w_; F.bid = b_; F.G = g_; }
#define FIN(i) ((const float*)F.a->in[i])
#define WSP(T, off) ((T*)(F.ws + (off)))

__device__ __forceinline__ int row_bb(int row) { return row < PM ? (row >> 12) : 4 + ((row - PM) >> 3); }
__device__ __forceinline__ int row_pos(int row) { return row < PM ? (row & (PT - 1)) : PT + ((row - PM) & 7); }

__device__ __forceinline__ int win_cmap(int n) {
    if (n < 1280) return n;
    if (n < 2304) { const int c = n - 1280, isk = c >> 9, hc = c & 511, head = hc >> 7, s = hc & 127;
        const int g = s >> 3, w = s & 7, dim = (w < 4) ? (4 * g + w) : (64 + 4 * g + (w - 4)); return (isk ? O_RK : O_RQ) + head * 128 + dim; }
    if (n < 2816) return O_RV + (n - 2304);
    if (n < 3328) return O_RG + (n - 2816);
    if (n < 3840) return O_RX + (n - 3328);
    if (n < 4352) return O_RGATE + (n - 3840);
    if (n < 7424) return O_MG + (n - 4352);
    if (n < 7448) return O_NG + (n - 7424);
    return -1;
}

template <bool MAP> __device__ __forceinline__ void p0_tr_item(const float* W, int ldw, bf16* WT, int ldt, int k0, int n0, LAS float* scr, int lane) {
    const int nd = n0 + (lane & 31); const int sc = MAP ? win_cmap(nd) : nd;
    float tv[32];
#pragma unroll
    for (int i = 0; i < 32; ++i) { const int kk = 2 * i + (lane >> 5); tv[i] = (sc >= 0) ? W[(size_t)(k0 + kk) * ldw + sc] : 0.f; }
#pragma unroll
    for (int i = 0; i < 32; ++i) { const int kk = 2 * i + (lane >> 5); scr[kk * 33 + (lane & 31)] = tv[i]; }
    LDS_WAIT(); asm volatile("" ::: "memory");
    const int c = lane & 7;
#pragma unroll
    for (int j = 0; j < 4; ++j) { const int n = (lane >> 3) + 8 * j; const LAS float* s = scr + (8 * c) * 33 + n;
        v4u o; o.x = pk2(s[0 * 33], s[1 * 33]); o.y = pk2(s[2 * 33], s[3 * 33]); o.z = pk2(s[4 * 33], s[5 * 33]); o.w = pk2(s[6 * 33], s[7 * 33]);
        *(v4u*)(WT + (size_t)(n0 + n) * ldt + k0 + 8 * c) = o; }
    LDS_WAIT(); asm volatile("" ::: "memory");
}
__device__ __forceinline__ void sincos_acc(float ang, float& s, float& c) {
    const double a = (double)ang; const double kq = rint(a * 0.63661977236758134308); const double r = fma(-kq, 1.57079632679489661923, a);
    const double r2 = r * r;
    const double sp = r * (1.0 + r2 * (-1.6666666666666666e-1 + r2 * (8.3333333333333332e-3 + r2 * (-1.9841269841269841e-4 + r2 * (2.7557319223985893e-6 + r2 * (-2.5052108385441720e-8))))));
    const double cp = 1.0 + r2 * (-0.5 + r2 * (4.1666666666666664e-2 + r2 * (-1.3888888888888889e-3 + r2 * (2.4801587301587302e-5 + r2 * (-2.7557319223985888e-7 + r2 * 2.0876756987868099e-9)))));
    const int q = ((int)kq) & 3;
    const double ss = (q == 0) ? sp : (q == 1) ? cp : (q == 2) ? -sp : -cp;
    const double cc = (q == 0) ? cp : (q == 1) ? -sp : (q == 2) ? -cp : sp;
    s = (float)ss; c = (float)cc;
}

__device__ __forceinline__ void p0_prologue(Frame& F) {
    const int gw = F.bid * NWAVES + F.wave, NGW = F.G * NWAVES, lane = F.lane;
    LAS float* scr = (LAS float*)(F.lds + F.wave * 16384);
    {
        constexpr int I_IN = 16 * 240, I_BR = 8 * 32, I_OUT = 16 * 32, I_UP = 16 * 176, I_DN = 44 * 32, I_L = I_IN + 3 * I_BR + I_OUT + I_UP + I_DN;
        for (int it = gw; it < 2 * I_L; it += NGW) {
            const int l = it / I_L; int r = it % I_L;
            if (r < I_IN) { p0_tr_item<true>(FIN(I_WIN) + (size_t)l * DM * D_IN, D_IN, WSP(bf16, WS_WIN) + (size_t)l * NIN * DM, DM, 64 * (r / 240), 32 * (r % 240), scr, lane); continue; } r -= I_IN;
            if (r < 3 * I_BR) { const int w = r / I_BR, q = r % I_BR; const float* src = FIN(w == 0 ? I_WBRA : (w == 1 ? I_WBRB : I_WBRC)) + (size_t)l * 512 * 1024;
                p0_tr_item<false>(src, 1024, WSP(bf16, WS_WBR) + (size_t)(l * 3 + w) * 1024 * 512, 512, 64 * (q / 32), 32 * (q % 32), scr, lane); continue; } r -= 3 * I_BR;
            if (r < I_OUT) { p0_tr_item<false>(FIN(I_WOUT) + (size_t)l * 1024 * 1024, 1024, WSP(bf16, WS_WOUT) + (size_t)l * 1024 * 1024, 1024, 64 * (r / 32), 32 * (r % 32), scr, lane); continue; } r -= I_OUT;
            if (r < I_UP) { p0_tr_item<false>(FIN(I_WUP) + (size_t)l * DM * NUP, NUP, WSP(bf16, WS_WUP) + (size_t)l * NUP * DM, DM, 64 * (r / 176), 32 * (r % 176), scr, lane); continue; } r -= I_UP;
            p0_tr_item<false>(FIN(I_WDN) + (size_t)l * DFF * DM, DM, WSP(bf16, WS_WDN) + (size_t)l * DM * DFF, DFF, 64 * (r / 32), 32 * (r % 32), scr, lane);
        }
    }
    {
        constexpr int NI_W1 = 8 * 16 * 4, NI_W2 = 4 * 2 * 2, NI_RG = 32 * 2;
        for (int it = gw; it < NI_W1 + NI_W2 + NI_RG; it += NGW) {
            int r = it;
            if (r < NI_W1) { const int m = r / 64, q = r % 64, lk = m >> 1, half = m & 1;
                p0_tr_item<false>(FIN(I_W1) + ((size_t)lk * 32 + half * 16) * 64 * 128, 128, WSP(bf16, WS_SMALLW + SW_W1T) + ((size_t)lk * 256 + half * 128) * 1024, 1024, 64 * (q / 4), 32 * (q % 4), scr, lane); continue; } r -= NI_W1;
            if (r < NI_W2) { const int lk = r / 4, q = r % 4;
                p0_tr_item<false>(FIN(I_W2) + (size_t)lk * 128 * 64, 64, WSP(bf16, WS_SMALLW + SW_W2T) + (size_t)lk * 64 * 128, 128, 64 * (q / 2), 32 * (q % 2), scr, lane); continue; } r -= NI_W2;
            { const int m = r / 2, q = r % 2, l = m >> 4, which = (m >> 3) & 1, blk = m & 7;
                p0_tr_item<false>(FIN(which ? I_RWX : I_RWA) + ((size_t)l * 8 + blk) * 4096, 64, WSP(bf16, WS_SMALLW + SW_WAT) + (size_t)m * 4096, 64, 0, 32 * q, scr, lane); }
        }
    }
    for (int it = gw; it < 64; it += NGW) {
        const int lk = it >> 4, h0 = (it & 15) * 8; const float* pe = FIN(I_PE) + (size_t)lk * 2048; const float* w1 = FIN(I_W1) + (size_t)lk * 2048 * 128 + h0;
        f32x4 a0 = (f32x4){0.f, 0.f, 0.f, 0.f}, a1 = a0;
#pragma unroll 8
        for (int i = lane; i < 2048; i += 64) { const float p = pe[i]; a0 += *(const f32x4*)(w1 + (size_t)i * 128) * p; a1 += *(const f32x4*)(w1 + (size_t)i * 128 + 4) * p; }
#pragma unroll
        for (int x = 0; x < 4; ++x) { a0[x] = wave_sum(a0[x]); a1[x] = wave_sum(a1[x]); }
        if (lane == 0) { float* cb = WSP(float, WS_SMALLW + SW_CB) + lk * 128 + h0; const float* b1 = FIN(I_B1) + lk * 128 + h0;
#pragma unroll
            for (int x = 0; x < 4; ++x) { cb[x] = a0[x] + b1[x]; cb[4 + x] = a1[x] + b1[4 + x]; } }
    }
    for (int i = F.bid * NTHR + F.tid; i < 1024; i += F.G * NTHR) { const float lam = FIN(I_LAM)[i]; WSP(float, WS_SMALLW + SW_SP)[i] = log1pf(expf(-lam)); }
    for (int i = F.bid * NTHR + F.tid; i < 4104 * 64; i += F.G * NTHR) {
        const int pi = i >> 6, fi = i & 63; const float pos = (float)(pi < PT ? pi : PAST + (pi - PT));
        const float freq = (float)pow(10000.0, -(double)fi / 64.0); const float ang = pos * freq; float s, c; sincos_acc(ang, s, c);
        WSP(float, WS_ROT)[i] = c; WSP(float, WS_ROT)[4104 * 64 + i] = s;
    }
    {
        LAS float* SC = (LAS float*)(F.lds + 0);
        LAS float* RED = (LAS float*)(F.lds + 36864);
        for (int u = F.bid; u < 2 * 96; u += F.G) {
            const int l = u / 96, cg = u % 96; float acc[36];
#pragma unroll
            for (int b = 0; b < 36; ++b) acc[b] = 0.f;
#pragma unroll 1
            for (int kh = 0; kh < 4; ++kh) {
                __syncthreads();
                for (int i = F.tid; i < 256 * 36; i += NTHR) { const int d = i / 36, bb = i % 36; const float c = (bb < 4) ? FIN(I_CP)[bb * DM + kh * 256 + d] : FIN(I_CS)[(bb - 4) * DM + kh * 256 + d]; SC[i] = siluf_(c); }
                __syncthreads();
                const float* wp = FIN(I_WADA) + ((size_t)l * DM + kh * 256 + F.wave * 32) * 6144 + cg * 64 + lane;
#pragma unroll 1
                for (int d0 = 0; d0 < 32; d0 += 16) {
                    float wv[16];
#pragma unroll
                    for (int k = 0; k < 16; ++k) wv[k] = wp[(size_t)(d0 + k) * 6144];
#pragma unroll
                    for (int k = 0; k < 16; ++k) { const LAS f32x4* sc4 = (const LAS f32x4*)(SC + (F.wave * 32 + d0 + k) * 36);
#pragma unroll
                        for (int g = 0; g < 9; ++g) { const f32x4 s4 = sc4[g]; acc[4 * g + 0] += wv[k] * s4[0]; acc[4 * g + 1] += wv[k] * s4[1]; acc[4 * g + 2] += wv[k] * s4[2]; acc[4 * g + 3] += wv[k] * s4[3]; } }
                }
            }
#pragma unroll
            for (int b = 0; b < 36; ++b) RED[(F.wave * 36 + b) * 64 + lane] = acc[b];
            __syncthreads();
            for (int o = F.tid; o < 36 * 64; o += NTHR) { const int b = o >> 6, col = o & 63; float sm = FIN(I_BADA)[l * 6144 + cg * 64 + col];
#pragma unroll
                for (int w = 0; w < 8; ++w) sm += RED[(w * 36 + b) * 64 + col];
                WSP(float, WS_MOD)[((size_t)l * 36 + b) * 6144 + cg * 64 + col] = sm; }
        }
        __syncthreads();
    }
    for (int it = gw; it < 2 * SB * PAST / 8; it += NGW) {
        const int l = it / (SB * PAST / 8), r = it % (SB * PAST / 8), db = r / (PAST / 8), tt0 = (r % (PAST / 8)) * 8;
        const int page = ((const int*)F.a->in[I_PT])[db * NPG + (tt0 >> 7)];
        const float* src = FIN(I_CACHE) + (((size_t)l * NPHYS + page) * PAGE + (tt0 & 127)) * 512 + lane * 4;
        f32x4 v[8];
#pragma unroll
        for (int k = 0; k < 8; ++k) v[k] = __builtin_nontemporal_load((const f32x4*)(src + (size_t)k * 512));
        const int idx = lane * 4, j = idx >> 7, kk = (idx >> 6) & 1, d = idx & 63;
        bf16* dst = WSP(bf16, WS_ACMP) + ((size_t)(l * 2 + j) * CMP_ROWS_J) * 1024 + ((size_t)(db * 2 + kk) * PAST + tt0) * 64 + d;
#pragma unroll
        for (int k = 0; k < 8; ++k) { v2u o; o.x = pk2(v[k][0], v[k][1]); o.y = pk2(v[k][2], v[k][3]); *(v2u*)(dst + (size_t)k * 64) = o; }
    }
    for (size_t i = (size_t)F.bid * NTHR + F.tid; i < (size_t)2 * SB * 504 * 64; i += (size_t)F.G * NTHR) {
        const size_t seq = i / (504 * 64), r = i % (504 * 64);
        const f32x4 v = *(const f32x4*)(FIN(I_CWIN) + (seq * 512 + 8) * 256 + r * 4);
        *(f32x4*)(F.out + OUT_WIN_S + seq * 512 * 256 + r * 4) = v;
    }
}

__device__ __forceinline__ const float* xrow_in(const Frame& F, int l, int row) {
    if (l == 0) return row < PM ? FIN(I_XP) + (size_t)row * DM : FIN(I_XS) + (size_t)(row - PM) * DM;
    return WSP(float, WS_X2) + (size_t)row * DM;
}
__device__ __forceinline__ void norm_phase(Frame& F, int l, int which) {
    const int gw = F.bid * NWAVES + F.wave, NGW = F.G * NWAVES, lane = F.lane;
    const float* g = FIN(which ? I_N2G : I_N1G) + l * DM;
    for (int row0 = gw * 2; row0 < MT; row0 += NGW * 2) {
        f32x4 v[2][4]; float ss[2];
#pragma unroll
        for (int rr = 0; rr < 2; ++rr) { const float* xr = which ? WSP(float, WS_X1) + (size_t)(row0 + rr) * DM : xrow_in(F, l, row0 + rr);
#pragma unroll
            for (int j = 0; j < 4; ++j) v[rr][j] = *(const f32x4*)(xr + lane * 4 + 256 * j); }
#pragma unroll
        for (int rr = 0; rr < 2; ++rr) { float a = 0.f;
#pragma unroll
            for (int j = 0; j < 4; ++j) a += (v[rr][j][0] * v[rr][j][0] + v[rr][j][1] * v[rr][j][1]) + (v[rr][j][2] * v[rr][j][2] + v[rr][j][3] * v[rr][j][3]);
            ss[rr] = a; }
#pragma unroll
        for (int o = 1; o < 64; o <<= 1) { ss[0] += __shfl_xor(ss[0], o); ss[1] += __shfl_xor(ss[1], o); }
#pragma unroll
        for (int rr = 0; rr < 2; ++rr) { const int row = row0 + rr; const float rs = 1.0f / sqrtf(ss[rr] * (1.0f / DM) + EPS);
            const float* mod = WSP(float, WS_MOD) + ((size_t)l * 36 + row_bb(row)) * 6144 + (which ? 3072 : 0); bf16* o = WSP(bf16, WS_H) + (size_t)row * DM;
#pragma unroll
            for (int j = 0; j < 4; ++j) { const int c = lane * 4 + 256 * j; const f32x4 gg = *(const f32x4*)(g + c), sh = *(const f32x4*)(mod + c), sc = *(const f32x4*)(mod + 1024 + c);
                const f32x4 y = (v[rr][j] * rs) * gg * (sc + 1.0f) + sh; v2u w; w.x = pk2(y[0], y[1]); w.y = pk2(y[2], y[3]); *(v2u*)(o + c) = w; } }
    }
}
__device__ __forceinline__ void final_phase(Frame& F) {
    const int gw = F.bid * NWAVES + F.wave, NGW = F.G * NWAVES, lane = F.lane;
    const float* g = FIN(I_FNG);
    for (int row = gw; row < MT; row += NGW) {
        const float* xr = WSP(float, WS_X2) + (size_t)row * DM;
        f32x4 v[4]; float ss = 0.f;
#pragma unroll
        for (int j = 0; j < 4; ++j) { v[j] = *(const f32x4*)(xr + lane * 4 + 256 * j); ss += (v[j][0] * v[j][0] + v[j][1] * v[j][1]) + (v[j][2] * v[j][2] + v[j][3] * v[j][3]); }
        const float rs = 1.0f / sqrtf(wave_sum(ss) * (1.0f / DM) + EPS);
        float* o = F.out + OUT_Y + (size_t)row * DM;
#pragma unroll
        for (int j = 0; j < 4; ++j) { const int c = lane * 4 + 256 * j; *(f32x4*)(o + c) = (v[j] * rs) * *(const f32x4*)(g + c); }
    }
}

#define EPI_LOOP_BEGIN \
    _Pragma("unroll") for (int ai = 0; ai < 2; ++ai) _Pragma("unroll") for (int m = 0; m < 4; ++m) { const int row = u.pm * 256 + ai * 128 + wr * 64 + m * 16 + fr; \
    _Pragma("unroll") for (int bj = 0; bj < 2; ++bj) { const int ct = bj * 128 + wc * 32 + 8 * fq; const f32x4 v0 = acc[ai][bj][m][0], v1 = acc[ai][bj][m][1];
#define EPI_LOOP_END } }

struct EpiWin {
    static constexpr bool PERM = true, AFTER_DRAIN = false;
    unsigned char* ws; float* out; int l;
    __device__ __forceinline__ void operator()(const f32x4 (&acc)[2][2][4][2], const pg8::Unit& u, int wr, int wc, int fr0, int fq0) const {
        int fr = fr0, fq = fq0; asm volatile("" : "+v"(fr), "+v"(fq));
        const int pn = u.pn;
        if (pn < 2) {
            bf16* QN = (bf16*)(ws + WS_QN);
            EPI_LOOP_BEGIN *(v4u*)(QN + (size_t)row * 512 + pn * 256 + ct) = pack8(v0 * QSCALE, v1 * QSCALE); EPI_LOOP_END
        } else if (pn < 5) {
            EPI_LOOP_BEGIN
                const int c = (pn - 2) * 256 + ct, j = c >> 7, k = (c >> 6) & 1, d = c & 63;
                const bool isp = row < PM; const int b = isp ? (row >> 12) : ((row - PM) >> 3), t = isp ? (row & (PT - 1)) : ((row - PM) & 7);
                if (j < 4) { float* o = out + (isp ? OUT_ROWS_P + ((size_t)l * PM + row) * 512 : OUT_ROWS_S + ((size_t)l * SM + (row - PM)) * 512) + c; *(f32x4*)o = v0; *(f32x4*)(o + 4) = v1; }
                else if (isp) { if (t >= PT - WINB) { float* o = out + OUT_WIN_P + (((size_t)l * PB + b) * WINB + (t - (PT - WINB))) * 256 + (c - 512); *(f32x4*)o = v0; *(f32x4*)(o + 4) = v1; } }
                else { float* o = out + OUT_WIN_S + (((size_t)l * SB + b) * WINB + (WINB - ST) + t) * 256 + (c - 512); *(f32x4*)o = v0; *(f32x4*)(o + 4) = v1; }
                const v4u w = pack8(v0, v1);
                if (isp) {
                    if (j < 2) *(v4u*)((bf16*)(ws + WS_ACMP) + ((size_t)(l * 2 + j) * CMP_ROWS_J + 32768 + (b * 2 + k) * 256) * 1024 + (size_t)t * 64 + d) = w;
                    else if (j & 1) {
                        const int tq = t & 31, s2 = tq >> 4, hh = (tq >> 2) & 1, ii = (tq & 3) + 4 * ((tq >> 3) & 1);
                        bf16* vt = (bf16*)(ws + WS_KVB) + (((size_t)(j - 2) * PB + b) * 2 + k) * PT * 64 + (size_t)(t >> 5) * 2048 + ((((d >> 5) * 2 + s2) * 2 + hh) * 32 + (d & 31)) * 8 + ii;
                        vt[0] = (bf16)(w.x & 0xffffu); vt[8] = (bf16)(w.x >> 16); vt[16] = (bf16)(w.y & 0xffffu); vt[24] = (bf16)(w.y >> 16);
                        vt[32] = (bf16)(w.z & 0xffffu); vt[40] = (bf16)(w.z >> 16); vt[48] = (bf16)(w.w & 0xffffu); vt[56] = (bf16)(w.w >> 16); }
                    else *(v4u*)((bf16*)(ws + WS_KVB) + (((size_t)(j - 2) * PB + b) * 2 + k) * PT * 64 + (size_t)(t >> 5) * 2048 + ((d >> 3) * 32 + (t & 31)) * 8) = w;
                } else if (j >= 2) *(v4u*)((bf16*)(ws + WS_KVS) + ((((size_t)(j - 2) * SB + b) * 2 + k) * ST + t) * 64 + d) = w;
            EPI_LOOP_END
        } else if (pn < 9) {
            const float* ROTC = (const float*)(ws + WS_ROT); const float* ROTS = ROTC + 4104 * 64;
            EPI_LOOP_BEGIN
                const int c = (pn - 5) * 256 + ct, isk = c >> 9, hc = c & 511, head = hc >> 7, d0 = ((hc & 127) >> 3) * 4;
                const int pi = row_pos(row); const f32x4 cs = *(const f32x4*)(ROTC + pi * 64 + d0), sn = *(const f32x4*)(ROTS + pi * 64 + d0);
                const float sc = isk ? 0.08838834764831845f : 1.0f;
                const f32x4 o1 = (v0 * cs - v1 * sn) * sc, o2 = (v0 * sn + v1 * cs) * sc;
                bf16* o = (bf16*)(ws + WS_RQ) + (size_t)isk * MT * 512 + (size_t)row * 512 + head * 128 + d0;
                v2u w1; w1.x = pk2(o1[0], o1[1]); w1.y = pk2(o1[2], o1[3]); *(v2u*)o = w1;
                v2u w2; w2.x = pk2(o2[0], o2[1]); w2.y = pk2(o2[2], o2[3]); *(v2u*)(o + 64) = w2;
            EPI_LOOP_END
        } else if (pn < 13) {
            bf16* RV = (bf16*)(ws + WS_RQ) + (size_t)2 * MT * 512;
            EPI_LOOP_BEGIN const int c = (pn - 9) * 256 + ct; *(v4u*)(RV + (size_t)(c >> 9) * MT * 512 + (size_t)row * 512 + (c & 511)) = pack8(v0, v1); EPI_LOOP_END
        } else if (pn < 15) {
            float* RX = (float*)(ws + WS_RX);
            EPI_LOOP_BEGIN
                const int c = (pn - 13) * 256 + ct; float* o = RX + (size_t)row * 512 + c; *(f32x4*)o = v0; *(f32x4*)(o + 4) = v1;
                if (row < PM) { const int t = row & (PT - 1); if (t >= PT - 3) { float* q = out + OUT_CV_P + (((size_t)l * PB + (row >> 12)) * 3 + (t - (PT - 3))) * 512 + c; *(f32x4*)q = v0; *(f32x4*)(q + 4) = v1; } }
                else { const int i = (row - PM) & 7; if (i >= ST - 3) { float* q = out + OUT_CV_S + (((size_t)l * SB + ((row - PM) >> 3)) * 3 + (i - (ST - 3))) * 512 + c; *(f32x4*)q = v0; *(f32x4*)(q + 4) = v1; } }
            EPI_LOOP_END
        } else if (pn < 17) {
            bf16* GG = (bf16*)(ws + WS_GG);
            EPI_LOOP_BEGIN const int c = (pn - 15) * 256 + ct;
                f32x4 a, b;
#pragma unroll
                for (int i = 0; i < 4; ++i) { a[i] = gelu_tanh(v0[i]); b[i] = gelu_tanh(v1[i]); }
                *(v4u*)(GG + (size_t)row * 512 + c) = pack8(a, b); EPI_LOOP_END
        } else if (pn < 29) {
            bf16* MG = (bf16*)(ws + WS_MGS);
            EPI_LOOP_BEGIN const int c = (pn - 17) * 256 + ct;
                f32x4 a, b;
#pragma unroll
                for (int i = 0; i < 4; ++i) { a[i] = sigmoidf_(v0[i]); b[i] = sigmoidf_(v1[i]); }
                *(v4u*)(MG + (size_t)row * 3072 + c) = pack8(a, b); EPI_LOOP_END
        } else {
            float* NG = (float*)(ws + WS_NG);
            EPI_LOOP_BEGIN if (ct < 24) { f32x4 a, b;
#pragma unroll
                for (int i = 0; i < 4; ++i) { a[i] = sigmoidf_(v0[i]); b[i] = sigmoidf_(v1[i]); }
                float* o = NG + (size_t)row * 24 + ct; *(f32x4*)o = a; *(f32x4*)(o + 4) = b; } EPI_LOOP_END
        }
    }
};

struct EpiLH {
    static constexpr bool PERM = true, AFTER_DRAIN = false;
    bf16* LH;
    __device__ __forceinline__ void operator()(const f32x4 (&acc)[2][2][4][2], const pg8::Unit& u, int wr, int wc, int fr0, int fq0) const {
        int fr = fr0, fq = fq0; asm volatile("" : "+v"(fr), "+v"(fq));
        EPI_LOOP_BEGIN *(v4u*)(LH + (size_t)row * 256 + ct) = pack8(v0, v1); EPI_LOOP_END
    }
};
struct CmpOrder {
    int G, c;
    __device__ bool next(int i, pg8::Unit& u) const { const int L = i * G + c; if (L >= CMP_ROWS / 256) return false; u.pm = L; u.pn = L / (CMP_ROWS_J / 256); return true; }
    __device__ __forceinline__ void a_ready(const pg8::Unit&) const {}
    __device__ __forceinline__ void done(const pg8::Unit&) const {}
};

template <int BR> struct EpiBr {
    static constexpr bool PERM = true, AFTER_DRAIN = false;
    unsigned char* ws;
    __device__ __forceinline__ void operator()(const f32x4 (&acc)[2][2][4][2], const pg8::Unit& u, int wr, int wc, int fr0, int fq0) const {
        int fr = fr0, fq = fq0; asm volatile("" : "+v"(fr), "+v"(fq));
        const bf16* MG = (const bf16*)(ws + WS_MGS); bf16* MR = (bf16*)(ws + WS_MRG);
        EPI_LOOP_BEGIN
            const int col = u.pn * 256 + ct; f32x4 g0, g1; unpack8(*(const v4u*)(MG + (size_t)row * 3072 + BR * 1024 + col), g0, g1);
            f32x4 r0 = v0 * g0, r1 = v1 * g1; bf16* o = MR + (size_t)row * DM + col;
            if (BR > 0) { f32x4 p0, p1; unpack8(*(const v4u*)o, p0, p1); r0 += p0; r1 += p1; }
            *(v4u*)o = pack8(r0, r1);
        EPI_LOOP_END
    }
};

struct BrOrder {
    pg8::StaticOrder S;
    __device__ bool next(int i, pg8::Unit& u) const { pg8::Unit t; if (!S.next(i / 3, t)) return false; const int br = i % 3; u.pm = br * (MT / 256) + t.pm; u.pn = br * 4 + t.pn; return true; }
    __device__ __forceinline__ void a_ready(const pg8::Unit&) const {}
    __device__ __forceinline__ void done(const pg8::Unit&) const {}
};
struct EpiBrAll {
    static constexpr bool PERM = true, AFTER_DRAIN = false;
    unsigned char* ws;
    __device__ __forceinline__ void operator()(const f32x4 (&acc)[2][2][4][2], const pg8::Unit& u0, int wr, int wc, int fr0, int fq0) const {
        int fr = fr0, fq = fq0; asm volatile("" : "+v"(fr), "+v"(fq));
        const int br = u0.pn >> 2; const pg8::Unit u{u0.pm - br * (MT / 256), u0.pn & 3};
        const bf16* MG = (const bf16*)(ws + WS_MGS) + br * 1024; bf16* MR = (bf16*)(ws + WS_MRG);
        if (br == 0) {
            EPI_LOOP_BEGIN const int col = u.pn * 256 + ct; f32x4 g0, g1; unpack8(*(const v4u*)(MG + (size_t)row * 3072 + col), g0, g1); *(v4u*)(MR + (size_t)row * DM + col) = pack8(v0 * g0, v1 * g1); EPI_LOOP_END
        } else {
            EPI_LOOP_BEGIN const int col = u.pn * 256 + ct; f32x4 g0, g1, p0, p1; unpack8(*(const v4u*)(MG + (size_t)row * 3072 + col), g0, g1); bf16* o = MR + (size_t)row * DM + col; unpack8(*(const v4u*)o, p0, p1);
                *(v4u*)o = pack8(v0 * g0 + p0, v1 * g1 + p1); EPI_LOOP_END
        }
    }
};

struct EpiRes {
    static constexpr bool PERM = true, AFTER_DRAIN = false;
    const float* xin_p; const float* xin_s; float* xout; const float* mod; int gofs;
    __device__ __forceinline__ void operator()(const f32x4 (&acc)[2][2][4][2], const pg8::Unit& u, int wr, int wc, int fr0, int fq0) const {
        int fr = fr0, fq = fq0; asm volatile("" : "+v"(fr), "+v"(fq));
        EPI_LOOP_BEGIN
            const int col = u.pn * 256 + ct; const float* xi = (xin_s && row >= PM) ? xin_s + (size_t)(row - PM) * DM + col : xin_p + (size_t)row * DM + col;
            const float* g = mod + (size_t)row_bb(row) * 6144 + gofs + col; float* o = xout + (size_t)row * DM + col;
            *(f32x4*)o = *(const f32x4*)xi + *(const f32x4*)g * v0; *(f32x4*)(o + 4) = *(const f32x4*)(xi + 4) + *(const f32x4*)(g + 4) * v1;
        EPI_LOOP_END
    }
};

struct EpiUp {
    static constexpr bool PERM = true, AFTER_DRAIN = false;
    unsigned char* ws; float* out; int l;
    __device__ __forceinline__ void operator()(const f32x4 (&acc)[2][2][4][2], const pg8::Unit& u, int wr, int wc, int fr0, int fq0) const {
        int fr = fr0, fq = fq0; asm volatile("" : "+v"(fr), "+v"(fq));
        bf16* GP = (bf16*)(ws + WS_GP); bf16* VAL = GP + (size_t)MT * DFF;
        if (u.pn < 11) {
            EPI_LOOP_BEGIN const int c = u.pn * 256 + ct; *(v4u*)(GP + (size_t)row * DFF + c) = pack8(v0, v1);
                if (row < PM) { const int t = row & (PT - 1); if (t >= PT - 2) { float* q = out + OUT_FC_P + (((size_t)l * PB + (row >> 12)) * 2 + (t - (PT - 2))) * DFF + c; *(f32x4*)q = v0; *(f32x4*)(q + 4) = v1; } }
                else { const int i = (row - PM) & 7; if (i >= ST - 2) { float* q = out + OUT_FC_S + (((size_t)l * SB + ((row - PM) >> 3)) * 2 + (i - (ST - 2))) * DFF + c; *(f32x4*)q = v0; *(f32x4*)(q + 4) = v1; } }
            EPI_LOOP_END
        } else {
            EPI_LOOP_BEGIN const int c = (u.pn - 11) * 256 + ct; *(v4u*)(VAL + (size_t)row * DFF + c) = pack8(v0, v1); EPI_LOOP_END
        }
    }
};

__device__ __forceinline__ f32x16 mfma32(bf16x8 a, bf16x8 b, f32x16 c) { return __builtin_amdgcn_mfma_f32_32x32x16_bf16(a, b, c, 0, 0, 0); }
__device__ __forceinline__ f32x4 mfma16(bf16x8 a, bf16x8 b, f32x4 c) { return __builtin_amdgcn_mfma_f32_16x16x32_bf16(a, b, c, 0, 0, 0); }
__device__ __forceinline__ float ret_log_g(int h) { return log1pf(-exp2f(-5.0f - (float)h)); }
__device__ __forceinline__ bf16x8 tr_frag(const LAS unsigned char* base, int rs_bytes, int rowA, int rowB, int colbase, int lane) {
    const int q = (lane & 15) >> 2, p = lane & 3;
    const LAS unsigned char* pa = base + (rowA + q) * rs_bytes + (colbase + 4 * p) * 2;
    const LAS unsigned char* pb = base + (rowB + q) * rs_bytes + (colbase + 4 * p) * 2;
    const s16x4 a = __builtin_bit_cast(s16x4, __builtin_amdgcn_ds_read_tr16_b64_v4i16((LAS s16x4*)pa));
    const s16x4 b = __builtin_bit_cast(s16x4, __builtin_amdgcn_ds_read_tr16_b64_v4i16((LAS s16x4*)pb));
    return (bf16x8){a[0], a[1], a[2], a[3], b[0], b[1], b[2], b[3]};
}
__device__ __forceinline__ bf16x8 cvt_frag(const f32x16& p, int s2) {
    u32x4 w; w.x = pk2(p[8 * s2 + 0], p[8 * s2 + 1]); w.y = pk2(p[8 * s2 + 2], p[8 * s2 + 3]); w.z = pk2(p[8 * s2 + 4], p[8 * s2 + 5]); w.w = pk2(p[8 * s2 + 6], p[8 * s2 + 7]);
    return __builtin_bit_cast(bf16x8, w);
}

__device__ __forceinline__ void cmp2_phase(Frame& F, int l) {
    const int gw = F.bid * NWAVES + F.wave, NGW = F.G * NWAVES, lane = F.lane, r = lane & 15, g = lane >> 4;
    const bf16* LH = WSP(bf16, WS_LH); bf16* CK = WSP(bf16, WS_CK);
    for (int wu = gw; wu < CMP_ROWS / 16; wu += NGW) {
        const int row0 = wu * 16, j = row0 / CMP_ROWS_J, rj = (row0 % CMP_ROWS_J) + r, row = row0 + r;
        const bool valid = (rj < 32768) ? ((rj & 511) < 511) : (((rj - 32768) & 255) < 255);
        const bf16* W2T = WSP(bf16, WS_SMALLW + SW_W2T) + (size_t)(l * 2 + j) * 64 * 128; const float* CB = WSP(float, WS_SMALLW + SW_CB) + (l * 2 + j) * 128;
        f32x4 acc[4];
#pragma unroll
        for (int ct = 0; ct < 4; ++ct) acc[ct] = (f32x4){0.f, 0.f, 0.f, 0.f};
#pragma unroll
        for (int ks = 0; ks < 4; ++ks) {
            const int h0 = 32 * ks + 8 * g; f32x4 a0, a1, b0, b1;
            unpack8(*(const v4u*)(LH + (size_t)row * 256 + h0), a0, a1); unpack8(*(const v4u*)(LH + (size_t)(row + 1) * 256 + 128 + h0), b0, b1);
            const f32x4 c0 = *(const f32x4*)(CB + h0), c1 = *(const f32x4*)(CB + h0 + 4);
            f32x4 x0 = a0 + b0 + c0, x1 = a1 + b1 + c1;
#pragma unroll
            for (int i = 0; i < 4; ++i) { x0[i] = gelu_tanh(x0[i]); x1[i] = gelu_tanh(x1[i]); }
            const bf16x8 hf = __builtin_bit_cast(bf16x8, pack8(x0, x1));
#pragma unroll
            for (int ct = 0; ct < 4; ++ct) { const bf16x8 wf = *(const bf16x8*)(W2T + (size_t)(16 * ct + r) * 128 + h0); acc[ct] = mfma16(wf, hf, acc[ct]); }
        }
#pragma unroll
        for (int ct = 0; ct < 4; ++ct) { const f32x4 v = valid ? acc[ct] : (f32x4){0.f, 0.f, 0.f, 0.f}; v2u w; w.x = pk2(v[0], v[1]); w.y = pk2(v[2], v[3]);
            *(v2u*)(CK + (size_t)row * 64 + 16 * ct + 4 * g) = w; }
    }
}

constexpr int CG_RS = 144, CG_BUF = 256 * CG_RS, CG_AW = 2 * CG_BUF;
__device__ __forceinline__ void cmp_gemm_unit(Frame& F, int l, int pm) {
    const int tid = F.tid, lane = F.lane, w = F.wave, q = lane & 31, h_ = lane >> 5;
    const int j = pm / 136, r = pm % 136; const bool smp = r < 128;
    const int grp = smp ? (r >> 1) : (r - 128), n0 = (smp ? (r & 1) * 256 : 0) + 32 * w;
    const float* rp[8]; const bf16* ab = nullptr;
    if (smp) { const int db = grp >> 1, k = grp & 1;
#pragma unroll
        for (int i = 0; i < 8; ++i) { const int tt0 = (n0 + 4 * i + (lane >> 4)) * 16; const int page = ((const int*)F.a->in[I_PT])[db * NPG + (tt0 >> 7)];
            rp[i] = FIN(I_CACHE) + (((((size_t)l * NPHYS + page) * PAGE + (tt0 & 127)) * 4 + j) * 2 + k) * 64 + (lane & 15) * 4; } }
    else { ab = WSP(bf16, WS_ACMP) + ((size_t)(l * 2 + j) * CMP_ROWS_J + 32768 + grp * 256 + n0 + q) * 1024 + 8 * h_;
#pragma unroll
        for (int i = 0; i < 8; ++i) rp[i] = nullptr; }
    const bf16* Bg = WSP(bf16, WS_SMALLW + SW_W1T) + (size_t)(l * 2 + j) * 256 * 1024;
    f32x16 acc[8];
#pragma unroll
    for (int ct = 0; ct < 8; ++ct) acc[ct] = (f32x16){};
    const bf16* bsrc = Bg + (size_t)(tid >> 1) * 1024 + (tid & 1) * 32; LAS unsigned char* bdst = F.lds + (tid >> 1) * CG_RS + (tid & 1) * 64;
    LAS unsigned char* Aw = F.lds + CG_AW + w * 32 * CG_RS;
    v4u bst[4]; f32x4 an[8]; v4u anb[4];
    __syncthreads();
#pragma unroll
    for (int x = 0; x < 4; ++x) bst[x] = *(const v4u*)(bsrc + 8 * x);
#pragma unroll
    for (int x = 0; x < 4; ++x) *(LAS v4u*)(bdst + x * 16) = bst[x];
    if (smp) {
#pragma unroll
        for (int i = 0; i < 8; ++i) an[i] = *(const f32x4*)(rp[i]); }
    else {
#pragma unroll
        for (int ks = 0; ks < 4; ++ks) anb[ks] = *(const v4u*)(ab + ks * 16); }
    __syncthreads();
#pragma unroll 1
    for (int kc = 0; kc < 16; ++kc) {
        bf16x8 ac[4];
        if (smp) {
#pragma unroll
            for (int i = 0; i < 8; ++i) { v2u o; o.x = pk2(an[i][0], an[i][1]); o.y = pk2(an[i][2], an[i][3]); *(LAS v2u*)(Aw + (4 * i + (lane >> 4)) * CG_RS + (lane & 15) * 8) = o; }
            LDS_WAIT(); asm volatile("" ::: "memory");
#pragma unroll
            for (int ks = 0; ks < 4; ++ks) ac[ks] = *(const LAS bf16x8*)(Aw + q * CG_RS + ks * 32 + 16 * h_);
        } else {
#pragma unroll
            for (int ks = 0; ks < 4; ++ks) ac[ks] = __builtin_bit_cast(bf16x8, anb[ks]); }
        if (kc + 1 < 16) {
#pragma unroll
            for (int x = 0; x < 4; ++x) bst[x] = *(const v4u*)(bsrc + (kc + 1) * 64 + 8 * x);
            if (smp) {
#pragma unroll
                for (int i = 0; i < 8; ++i) an[i] = *(const f32x4*)(rp[i] + (size_t)(kc + 1) * 512); }
            else {
#pragma unroll
                for (int ks = 0; ks < 4; ++ks) anb[ks] = *(const v4u*)(ab + (kc + 1) * 64 + ks * 16); }
        }
        const LAS unsigned char* bb = F.lds + (kc & 1) * CG_BUF + q * CG_RS + 16 * h_;
#pragma unroll
        for (int ks = 0; ks < 4; ++ks)
#pragma unroll
            for (int ct = 0; ct < 8; ++ct) { const bf16x8 bf = *(const LAS bf16x8*)(bb + ct * 32 * CG_RS + ks * 32); acc[ct] = mfma32(bf, ac[ks], acc[ct]); }
        if (kc + 1 < 16) {
#pragma unroll
            for (int x = 0; x < 4; ++x) *(LAS v4u*)(bdst + ((kc + 1) & 1) * CG_BUF + x * 16) = bst[x]; }
        __syncthreads();
    }
    bf16* LH = WSP(bf16, WS_LH) + ((size_t)pm * 256 + 32 * w + q) * 256;
#pragma unroll
    for (int ct = 0; ct < 8; ++ct)
#pragma unroll
        for (int r4 = 0; r4 < 4; ++r4) { v2u o; o.x = pk2(acc[ct][4 * r4 + 0], acc[ct][4 * r4 + 1]); o.y = pk2(acc[ct][4 * r4 + 2], acc[ct][4 * r4 + 3]); *(v2u*)(LH + ct * 32 + 8 * r4 + 4 * h_) = o; }
}

constexpr int RS_KV = 272;
__device__ __forceinline__ void ret_local_unit(Frame& F, int unit) {
    const int bh = unit >> 5, c = unit & 31, b = bh >> 2, h = bh & 3, lane = F.lane, w = F.wave;
    const float lg = ret_log_g(h);
    LAS unsigned char* KS = F.lds; LAS unsigned char* VS = F.lds + 128 * RS_KV;
    const bf16* RK = WSP(bf16, WS_RQ) + (size_t)MT * 512; const bf16* RV = WSP(bf16, WS_RQ) + (size_t)2 * MT * 512;
    __syncthreads();
#pragma unroll
    for (int i = 0; i < 4; ++i) { const int p = F.tid + NTHR * i, j = p >> 4, ch = p & 15; const size_t go = (size_t)(b * PT + 128 * c + j) * 512 + h * 128 + ch * 8;
        f32x4 k0, k1; unpack8(*(const v4u*)(RK + go), k0, k1); const float kw = fexp((float)(127 - j) * lg);
        *(LAS v4u*)(KS + j * RS_KV + ch * 16) = pack8(k0 * kw, k1 * kw);
        *(LAS v4u*)(VS + j * RS_KV + ch * 16) = *(const v4u*)(RV + go); }
    __syncthreads();
    const int et = w >> 1, dt0 = 2 * (w & 1), h_ = lane >> 5, blk = (lane >> 4) & 1;
    f32x16 acc[2]; acc[0] = (f32x16){}; acc[1] = (f32x16){};
#pragma unroll
    for (int ks = 0; ks < 8; ++ks) {
        const int rA = 16 * ks + 8 * h_;
        const bf16x8 af = tr_frag(VS, RS_KV, rA, rA + 4, 32 * et + 16 * blk, lane);
#pragma unroll
        for (int dd = 0; dd < 2; ++dd) { const bf16x8 bfr = tr_frag(KS, RS_KV, rA, rA + 4, 32 * (dt0 + dd) + 16 * blk, lane); acc[dd] = mfma32(af, bfr, acc[dd]); }
    }
    float* LT = WSP(float, WS_LT) + ((size_t)bh * 32 + c) * 16384;
#pragma unroll
    for (int dd = 0; dd < 2; ++dd)
#pragma unroll
        for (int r = 0; r < 16; ++r) { const int e = 32 * et + (r & 3) + 8 * (r >> 2) + 4 * h_; LT[e * 128 + 32 * (dt0 + dd) + (lane & 31)] = acc[dd][r]; }
}
__device__ __forceinline__ void ret_scan_phase(Frame& F, int l) {
    const float* LT = WSP(float, WS_LT); bf16* SPT = WSP(bf16, WS_SPT);
    for (int idx = F.bid * NTHR + F.tid; idx < 16 * 16384; idx += F.G * NTHR) {
        const int bh = idx >> 14, ed = idx & 16383, e = ed >> 7, d = ed & 127, h = bh & 3; const float g128 = fexp(128.0f * ret_log_g(h));
        float S = 0.f;
        for (int c = 0; c < 32; ++c) { const size_t o = ((size_t)bh * 32 + c) * 16384 + ed; SPT[o] = (bf16)(pk2(S, 0.f) & 0xffffu); S = S * g128 + LT[o]; }
        F.out[OUT_RET_P + ((size_t)l * 16 + bh) * 16384 + d * 128 + e] = S;
    }
}
__device__ __forceinline__ void ret_out_unit(Frame& F, int l, int unit) {
    const int bh = unit >> 5, c = unit & 31, b = bh >> 2, h = bh & 3, lane = F.lane, w = F.wave, tid = F.tid;
    const float lg = ret_log_g(h);
    LAS unsigned char* KS = F.lds; LAS unsigned char* VS = F.lds + 128 * RS_KV; LAS float* OT = (LAS float*)F.lds; LAS float* STAT = (LAS float*)(F.lds + 2 * 128 * RS_KV);
    const bf16* RQ = WSP(bf16, WS_RQ); const bf16* RK = RQ + (size_t)MT * 512; const bf16* RV = RQ + (size_t)2 * MT * 512; const bf16* RG = RQ + (size_t)3 * MT * 512;
    const size_t row0 = (size_t)b * PT + 128 * c;
    __syncthreads();
#pragma unroll
    for (int i = 0; i < 4; ++i) { const int p = tid + NTHR * i, j = p >> 4, ch = p & 15; const size_t go = (row0 + j) * 512 + h * 128 + ch * 8;
        *(LAS v4u*)(KS + j * RS_KV + ch * 16) = *(const v4u*)(RK + go); *(LAS v4u*)(VS + j * RS_KV + ch * 16) = *(const v4u*)(RV + go); }
    const int it = w & 3, eh = w >> 2, h_ = lane >> 5, blk = (lane >> 4) & 1, il = 32 * it + (lane & 31);
    bf16x8 qf[8];
#pragma unroll
    for (int ks = 0; ks < 8; ++ks) qf[ks] = *(const bf16x8*)(RQ + (row0 + il) * 512 + h * 128 + 16 * ks + 8 * h_);
    f32x16 acc[2]; acc[0] = (f32x16){}; acc[1] = (f32x16){};
    const bf16* SP = WSP(bf16, WS_SPT) + ((size_t)bh * 32 + c) * 16384;
#pragma unroll
    for (int kb4 = 0; kb4 < 8; kb4 += 4) {
        bf16x8 af[4][2];
#pragma unroll
        for (int ks = 0; ks < 4; ++ks)
#pragma unroll
            for (int e2 = 0; e2 < 2; ++e2) af[ks][e2] = *(const bf16x8*)(SP + (size_t)(32 * (2 * eh + e2) + (lane & 31)) * 128 + 16 * (kb4 + ks) + 8 * h_);
#pragma unroll
        for (int ks = 0; ks < 4; ++ks)
#pragma unroll
            for (int e2 = 0; e2 < 2; ++e2) acc[e2] = mfma32(af[ks][e2], qf[kb4 + ks], acc[e2]);
    }
    { const float cr = fexp((float)(il + 1) * lg); acc[0] *= cr; acc[1] *= cr; }
    __syncthreads();
    for (int jt = 0; jt <= it; ++jt) {
        f32x16 s = (f32x16){};
#pragma unroll
        for (int ks = 0; ks < 8; ++ks) { const bf16x8 kf = *(const LAS bf16x8*)(KS + (32 * jt + (lane & 31)) * RS_KV + (16 * ks + 8 * h_) * 2); s = mfma32(kf, qf[ks], s); }
#pragma unroll
        for (int r = 0; r < 16; ++r) { const int j = 32 * jt + (r & 3) + 8 * (r >> 2) + 4 * h_; const int df = il - j; s[r] = (df >= 0) ? s[r] * fexp((float)df * lg) : 0.f; }
#pragma unroll
        for (int s2 = 0; s2 < 2; ++s2) { const bf16x8 pf = cvt_frag(s, s2); const int rA = 32 * jt + 16 * s2 + 4 * h_;
#pragma unroll
            for (int e2 = 0; e2 < 2; ++e2) { const bf16x8 vf = tr_frag(VS, RS_KV, rA, rA + 8, 32 * (2 * eh + e2) + 16 * blk, lane); acc[e2] = mfma32(vf, pf, acc[e2]); } }
    }
    float s1 = 0.f, s2 = 0.f;
#pragma unroll
    for (int e2 = 0; e2 < 2; ++e2)
#pragma unroll
        for (int r = 0; r < 16; ++r) { const float v = acc[e2][r]; s1 += v; s2 += v * v; }
    s1 += __shfl_xor(s1, 32); s2 += __shfl_xor(s2, 32);
    if (lane < 32) { STAT[(w * 32 + lane) * 2] = s1; STAT[(w * 32 + lane) * 2 + 1] = s2; }
    __syncthreads();
    { const int pw = w ^ 4; s1 += STAT[(pw * 32 + (lane & 31)) * 2]; s2 += STAT[(pw * 32 + (lane & 31)) * 2 + 1]; }
    const float mean = s1 * (1.0f / 128.0f), var = fmaxf(s2 * (1.0f / 128.0f) - mean * mean, 0.f), rstd = 1.0f / sqrtf(var + EPS);
#pragma unroll
    for (int e2 = 0; e2 < 2; ++e2)
#pragma unroll
        for (int r4 = 0; r4 < 4; ++r4) { const int e = 32 * (2 * eh + e2) + 8 * r4 + 4 * h_;
            f32x4 v; v[0] = (acc[e2][4 * r4 + 0] - mean) * rstd; v[1] = (acc[e2][4 * r4 + 1] - mean) * rstd; v[2] = (acc[e2][4 * r4 + 2] - mean) * rstd; v[3] = (acc[e2][4 * r4 + 3] - mean) * rstd;
            *(LAS f32x4*)(OT + il * 132 + e) = v; }
    __syncthreads();
    const float* GN = FIN(I_GNG) + l * 512 + h * 128; bf16* OR_ = WSP(bf16, WS_OA) + (size_t)MT * 512;
#pragma unroll
    for (int k = 0; k < 4; ++k) { const int q = tid + NTHR * k, i = q >> 4, ch = q & 15;
        const f32x4 o0 = *(const LAS f32x4*)(OT + i * 132 + 8 * ch), o1 = *(const LAS f32x4*)(OT + i * 132 + 8 * ch + 4);
        const f32x4 g0 = *(const f32x4*)(GN + 8 * ch), g1 = *(const f32x4*)(GN + 8 * ch + 4); f32x4 r0, r1; unpack8(*(const v4u*)(RG + (row0 + i) * 512 + h * 128 + 8 * ch), r0, r1);
        f32x4 y0, y1;
#pragma unroll
        for (int x = 0; x < 4; ++x) { y0[x] = o0[x] * g0[x] * siluf_(r0[x]); y1[x] = o1[x] * g1[x] * siluf_(r1[x]); }
        *(v4u*)(OR_ + (row0 + i) * 512 + h * 128 + 8 * ch) = pack8(y0, y1); }
}
__device__ __forceinline__ void ret_sample_unit(Frame& F, int l, int unit) {
    const int db = unit >> 2, h = unit & 3, tid = F.tid, e = tid & 127, dp = tid >> 7;
    const float lg = ret_log_g(h);
    LAS float* Q = (LAS float*)F.lds; LAS float* K = Q + 1024; LAS float* V = K + 1024; LAS float* GT = V + 1024; LAS float* CR = GT + 1024;
    LAS float* SC = CR + 4096; LAS float* RED = SC + 64;
    const bf16* RQ = WSP(bf16, WS_RQ); const size_t row0 = (size_t)PM + db * 8;
    __syncthreads();
    for (int i = tid; i < 4096; i += NTHR) { const int which = i >> 10, r = (i >> 7) & 7, d = i & 127; const float v = bf1(RQ[(size_t)which * MT * 512 + (row0 + r) * 512 + h * 128 + d]); Q[which * 1024 + r * 128 + d] = v; }
    __syncthreads();
    const float* S0 = FIN(I_SRET) + (((size_t)l * SB + db) * 4 + h) * 16384; float* SN = F.out + OUT_RET_S + (((size_t)l * SB + db) * 4 + h) * 16384;
    float kwv[8], cr[8];
#pragma unroll
    for (int j = 0; j < 8; ++j) { kwv[j] = V[j * 128 + e] * fexp((float)(7 - j) * lg); cr[j] = 0.f; }
    const float g8 = fexp(8.0f * lg);
    for (int d = dp * 32; d < dp * 32 + 32; ++d) {
        const float s0 = S0[d * 128 + e]; float sn = g8 * s0;
#pragma unroll
        for (int j = 0; j < 8; ++j) { cr[j] += Q[j * 128 + d] * s0; sn += K[j * 128 + d] * kwv[j]; }
        SN[d * 128 + e] = sn;
    }
#pragma unroll
    for (int i = 0; i < 8; ++i) CR[(dp * 8 + i) * 128 + e] = cr[i];
    if (tid < 64) { const int i = tid >> 3, j = tid & 7; float s = 0.f; if (j <= i) { for (int d = 0; d < 128; ++d) s += Q[i * 128 + d] * K[j * 128 + d]; s *= fexp((float)(i - j) * lg); } SC[tid] = s; }
    __syncthreads();
    float o[2];
#pragma unroll
    for (int ii = 0; ii < 2; ++ii) { const int i = 2 * dp + ii; float x = (CR[(0 * 8 + i) * 128 + e] + CR[(1 * 8 + i) * 128 + e] + CR[(2 * 8 + i) * 128 + e] + CR[(3 * 8 + i) * 128 + e]) * fexp((float)(i + 1) * lg);
        for (int j = 0; j <= i; ++j) x += SC[i * 8 + j] * V[j * 128 + e];
        o[ii] = x; }
#pragma unroll
    for (int ii = 0; ii < 2; ++ii) { const float a = wave_sum(o[ii]), q = wave_sum(o[ii] * o[ii]); if (F.lane == 0) { RED[(F.wave * 2 + ii) * 2] = a; RED[(F.wave * 2 + ii) * 2 + 1] = q; } }
    __syncthreads();
    const float* GN = FIN(I_GNG) + l * 512 + h * 128; bf16* OR_ = WSP(bf16, WS_OA) + (size_t)MT * 512;
#pragma unroll
    for (int ii = 0; ii < 2; ++ii) { const int i = 2 * dp + ii, w0 = 2 * dp; const float s1 = RED[(w0 * 2 + ii) * 2] + RED[((w0 + 1) * 2 + ii) * 2], s2 = RED[(w0 * 2 + ii) * 2 + 1] + RED[((w0 + 1) * 2 + ii) * 2 + 1];
        const float mean = s1 * (1.0f / 128.0f), var = fmaxf(s2 * (1.0f / 128.0f) - mean * mean, 0.f), rstd = 1.0f / sqrtf(var + EPS);
        const float y = (o[ii] - mean) * rstd * GN[e] * siluf_(GT[i * 128 + e]);
        OR_[(row0 + i) * 512 + h * 128 + e] = (bf16)(pk2(y, 0.f) & 0xffffu); }
}

template <int MODE> __device__ __forceinline__ void rglru_unit(Frame& F, int l, int unit) {
    const int tid = F.tid, c = tid, lane = F.lane, w = F.wave;
    LAS bf16* XC = (LAS bf16*)F.lds; LAS float* G = (LAS float*)(F.lds + 16384);
    const int seq = (MODE == 2) ? unit : (unit >> 6), tile = (MODE == 2) ? 0 : (unit & 63);
    const size_t row0 = (MODE == 2) ? (size_t)PM + seq * 8 : (size_t)seq * PT + tile * 64;
    const int ntok = (MODE == 2) ? 8 : 64, nsub = (MODE == 2) ? 1 : 4;
    const float* RX = WSP(float, WS_RX);
    const float w0 = FIN(I_RCW)[(l * 4 + 0) * 512 + c], w1 = FIN(I_RCW)[(l * 4 + 1) * 512 + c], w2 = FIN(I_RCW)[(l * 4 + 2) * 512 + c], w3 = FIN(I_RCW)[(l * 4 + 3) * 512 + c], cb = FIN(I_RCB)[l * 512 + c];
    const float ba = FIN(I_RBA)[l * 512 + c], bx = FIN(I_RBX)[l * 512 + c], sp = WSP(float, WS_SMALLW + SW_SP)[l * 512 + c];
    float x3, x2, x1;
    if (MODE == 2) { const float* cv = FIN(I_SCONV) + ((size_t)l * SB + seq) * 3 * 512; x3 = cv[c]; x2 = cv[512 + c]; x1 = cv[1024 + c]; }
    else if (tile == 0) { x3 = 0.f; x2 = 0.f; x1 = 0.f; }
    else { x3 = RX[(row0 - 3) * 512 + c]; x2 = RX[(row0 - 2) * 512 + c]; x1 = RX[(row0 - 1) * 512 + c]; }
    float h = (MODE == 0) ? 0.f : (MODE == 1) ? WSP(float, WS_CAR)[(size_t)4 * 64 * 2 * 512 + ((size_t)seq * 64 + tile) * 512 + c] : FIN(I_SH)[((size_t)l * SB + seq) * 512 + c];
    float aprod = 1.f;
    const int r16 = lane & 15, g4 = lane >> 4;
    bf16x8 wa[4][2], wx[4][2];
    { const bf16* WA = WSP(bf16, WS_SMALLW + SW_WAT) + ((size_t)(l * 2 + 0) * 8 + w) * 4096; const bf16* WX = WSP(bf16, WS_SMALLW + SW_WAT) + ((size_t)(l * 2 + 1) * 8 + w) * 4096;
#pragma unroll
      for (int ct = 0; ct < 4; ++ct)
#pragma unroll
          for (int ks = 0; ks < 2; ++ks) { wa[ct][ks] = *(const bf16x8*)(WA + (16 * ct + r16) * 64 + 32 * ks + 8 * g4); wx[ct][ks] = *(const bf16x8*)(WX + (16 * ct + r16) * 64 + 32 * ks + 8 * g4); } }
    const bf16* GG = WSP(bf16, WS_GG); bf16* OC = WSP(bf16, WS_OA) + (size_t)2 * MT * 512;
    __syncthreads();
    float xn[16]; bf16 gn[16];
#pragma unroll
    for (int tt = 0; tt < 16; ++tt) { xn[tt] = (tt < ntok) ? RX[(row0 + tt) * 512 + c] : 0.f; gn[tt] = (MODE != 0 && tt < ntok) ? GG[(row0 + tt) * 512 + c] : (bf16)0; }
    for (int s = 0; s < nsub; ++s) {
        float xc[16], gg[16];
#pragma unroll
        for (int tt = 0; tt < 16; ++tt) { xc[tt] = xn[tt]; gg[tt] = bf1(gn[tt]); }
        if (s + 1 < nsub) {
#pragma unroll
            for (int tt = 0; tt < 16; ++tt) { const int t = (s + 1) * 16 + tt; xn[tt] = RX[(row0 + t) * 512 + c]; gn[tt] = (MODE != 0) ? GG[(row0 + t) * 512 + c] : (bf16)0; } }
#pragma unroll
        for (int tt = 0; tt < 16; ++tt) { const float x0 = xc[tt];
            xc[tt] = cb + w0 * x3 + w1 * x2 + w2 * x1 + w3 * x0; x3 = x2; x2 = x1; x1 = x0; XC[tt * 512 + c] = (bf16)(pk2(xc[tt], 0.f) & 0xffffu); }
        LDS_WAIT(); asm volatile("" ::: "memory");
        {
            bf16x8 xf[2];
#pragma unroll
            for (int ks = 0; ks < 2; ++ks) xf[ks] = *(const LAS bf16x8*)(XC + r16 * 512 + w * 64 + 32 * ks + 8 * g4);
#pragma unroll
            for (int ct = 0; ct < 4; ++ct) { f32x4 da = (f32x4){0.f, 0.f, 0.f, 0.f}, dx = da;
#pragma unroll
                for (int ks = 0; ks < 2; ++ks) { da = mfma16(wa[ct][ks], xf[ks], da); dx = mfma16(wx[ct][ks], xf[ks], dx); }
                *(LAS f32x4*)(G + r16 * 512 + w * 64 + 16 * ct + 4 * g4) = da; *(LAS f32x4*)(G + 8192 + r16 * 512 + w * 64 + 16 * ct + 4 * g4) = dx; }
        }
        LDS_WAIT(); asm volatile("" ::: "memory");
#pragma unroll
        for (int tt = 0; tt < 16; ++tt) { const int t = s * 16 + tt;
            if (t < ntok) {
                const float r = sigmoidf_(G[tt * 512 + c] + ba), ig = sigmoidf_(G[8192 + tt * 512 + c] + bx);
                const float la = -8.0f * r * sp, a = fexp(la), bt = sqrtf(fmaxf(1.0f - a * a, 0.f)) * (ig * xc[tt]);
                h = a * h + bt; aprod *= a;
                if (MODE != 0) { const size_t o = (row0 + t) * 512 + c; OC[o] = (bf16)(pk2(h * gg[tt], 0.f) & 0xffffu); }
            } }
    }
    if (MODE == 0) { float* CAR = WSP(float, WS_CAR) + ((size_t)seq * 64 + tile) * 1024; CAR[c] = aprod; CAR[512 + c] = h; }
    if (MODE == 2) F.out[OUT_H_S + ((size_t)l * SB + seq) * 512 + c] = h;
}
__device__ __forceinline__ void rglru_carry_phase(Frame& F, int l) {
    const float* CAR = WSP(float, WS_CAR); float* HIN = WSP(float, WS_CAR) + (size_t)4 * 64 * 2 * 512;
    for (int idx = F.bid * NTHR + F.tid; idx < PB * 512; idx += F.G * NTHR) {
        const int b = idx >> 9, c = idx & 511; float h = 0.f;
        for (int t = 0; t < 64; ++t) { HIN[((size_t)b * 64 + t) * 512 + c] = h; const float* cr = CAR + ((size_t)b * 64 + t) * 1024; h = cr[c] * h + cr[512 + c]; }
        F.out[OUT_H_P + ((size_t)l * PB + b) * 512 + c] = h;
    }
}

__device__ __forceinline__ void convact_phase(Frame& F, int l) {
    const bf16* GP = WSP(bf16, WS_GP); const bf16* VAL = GP + (size_t)MT * DFF; bf16* ACT = WSP(bf16, WS_GP) + (size_t)2 * MT * DFF;
    const float* CW = FIN(I_FCW) + (size_t)l * 3 * DFF; const float* CBI = FIN(I_FCB) + (size_t)l * DFF;
    constexpr int NRUN = PM / 16 + SB, NCG = DFF / 8;
    for (int it = F.bid * NTHR + F.tid; it < NRUN * NCG; it += F.G * NTHR) {
        const int run = it / NCG, cg = it % NCG, c = cg * 8;
        const bool isp = run < PM / 16; const size_t row0 = isp ? (size_t)run * 16 : (size_t)PM + (run - PM / 16) * 8; const int nt = isp ? 16 : 8;
        f32x4 p2a, p2b, p1a, p1b;
        if (isp) { if ((run & 255) == 0) { p2a = p2b = p1a = p1b = (f32x4){0.f, 0.f, 0.f, 0.f}; } else { unpack8(*(const v4u*)(GP + (row0 - 2) * DFF + c), p2a, p2b); unpack8(*(const v4u*)(GP + (row0 - 1) * DFF + c), p1a, p1b); } }
        else { const float* st = FIN(I_SFFN) + (((size_t)l * SB + (run - PM / 16)) * 2) * DFF + c; p2a = *(const f32x4*)st; p2b = *(const f32x4*)(st + 4); p1a = *(const f32x4*)(st + DFF); p1b = *(const f32x4*)(st + DFF + 4); }
        const f32x4 w0a = *(const f32x4*)(CW + c), w0b = *(const f32x4*)(CW + c + 4), w1a = *(const f32x4*)(CW + DFF + c), w1b = *(const f32x4*)(CW + DFF + c + 4), w2a = *(const f32x4*)(CW + 2 * DFF + c), w2b = *(const f32x4*)(CW + 2 * DFF + c + 4);
        const f32x4 ba = *(const f32x4*)(CBI + c), bb = *(const f32x4*)(CBI + c + 4);
        for (int t0 = 0; t0 < nt; t0 += 8) {
            v4u gx[8], vx[8];
#pragma unroll
            for (int k = 0; k < 8; ++k) { gx[k] = *(const v4u*)(GP + (row0 + t0 + k) * DFF + c); vx[k] = *(const v4u*)(VAL + (row0 + t0 + k) * DFF + c); }
#pragma unroll
            for (int k = 0; k < 8; ++k) {
                f32x4 xa, xb, va, vb; unpack8(gx[k], xa, xb); unpack8(vx[k], va, vb);
                f32x4 ya = ba + w0a * p2a + w1a * p1a + w2a * xa, yb = bb + w0b * p2b + w1b * p1b + w2b * xb;
#pragma unroll
                for (int i = 0; i < 4; ++i) { ya[i] = siluf_(ya[i]) * va[i]; yb[i] = siluf_(yb[i]) * vb[i]; }
                *(v4u*)(ACT + (row0 + t0 + k) * DFF + c) = pack8(ya, yb);
                p2a = p1a; p2b = p1b; p1a = xa; p1b = xb;
            }
        }
    }
}

constexpr int AT_RS = 144;
constexpr int AT_K0 = 0, AT_V0 = 2 * 64 * AT_RS, AT_PS = 4 * 64 * AT_RS, AT_IMP = AT_PS + 69632, AT_MASK = AT_IMP + 6144, AT_LIST = AT_MASK + 2048, AT_NL = AT_LIST + 1024;
constexpr unsigned AT_MARK = 0xFFFFu;
static_assert(AT_NL + 64 <= RING_BYTES, "attention LDS map");

struct TileRegs { v4u a, b, c, d; int mode; };

template <bool SMP> __device__ __forceinline__ void at_prefetch(const Frame& F, int l, int seq, int kvh, unsigned e, TileRegs& R) {
    const int kind = (int)(e >> 14), ti = (int)(e & 0x3fffu), rr = F.tid >> 3, pc = F.tid & 7;
    R.mode = 0;
    if (kind < 2) {
        const size_t rb = SMP ? (size_t)(seq * 2 + kvh) * 512 : (size_t)32768 + (size_t)(seq * 2 + kvh) * 256;
        const bf16* ck = WSP(bf16, WS_CK) + (rb + ti * 64 + rr) * 64 + pc * 8;
        R.a = *(const v4u*)ck; R.c = *(const v4u*)(ck + (size_t)CMP_ROWS_J * 64);
    } else if (!SMP) {
        const int jb = (kind == 2) ? 0 : 2;
        const bf16* kp = WSP(bf16, WS_KVB) + ((((size_t)jb * PB + seq) * 2 + kvh) * PT + ti * 64 + rr) * 64 + pc * 8;
        R.a = *(const v4u*)kp; R.c = *(const v4u*)(kp + (size_t)PB * 2 * PT * 64);
    } else if (kind == 2) {
        if (ti < 128) {
            const int page = ((const int*)F.a->in[I_PT])[seq * NPG + (ti >> 1)], slot = (ti & 1) * 64 + rr;
            const float* kp = FIN(I_CACHE) + (((((size_t)l * NPHYS + page) * PAGE + slot) * 4 + 2) * 2 + kvh) * 64 + pc * 8;
            R.a = *(const v4u*)kp; R.b = *(const v4u*)(kp + 4); R.c = *(const v4u*)(kp + 128); R.d = *(const v4u*)(kp + 132); R.mode = 1;
        } else if (rr < ST) {
            const bf16* kp = WSP(bf16, WS_KVS) + ((((size_t)0 * SB + seq) * 2 + kvh) * ST + rr) * 64 + pc * 8;
            R.a = *(const v4u*)kp; R.c = *(const v4u*)(kp + (size_t)SB * 2 * ST * 64);
        } else R.mode = 2;
    } else {
        if (ti < 8) {
            const float* kp = FIN(I_CWIN) + (((((size_t)l * SB + seq) * WINB + ti * 64 + rr) * 2 + 0) * 2 + kvh) * 64 + pc * 8;
            R.a = *(const v4u*)kp; R.b = *(const v4u*)(kp + 4); R.c = *(const v4u*)(kp + 128); R.d = *(const v4u*)(kp + 132); R.mode = 1;
        } else if (rr < ST) {
            const bf16* kp = WSP(bf16, WS_KVS) + ((((size_t)2 * SB + seq) * 2 + kvh) * ST + rr) * 64 + pc * 8;
            R.a = *(const v4u*)kp; R.c = *(const v4u*)(kp + (size_t)SB * 2 * ST * 64);
        } else R.mode = 2;
    }
}
__device__ __forceinline__ void at_store(const Frame& F, int buf, const TileRegs& R) {
    const int rr = F.tid >> 3, pc = F.tid & 7; v4u k, v;
    if (R.mode == 0) { k = R.a; v = R.c; }
    else if (R.mode == 1) { k = pack8(__builtin_bit_cast(f32x4, R.a), __builtin_bit_cast(f32x4, R.b)); v = pack8(__builtin_bit_cast(f32x4, R.c), __builtin_bit_cast(f32x4, R.d)); }
    else { k = (v4u){0u, 0u, 0u, 0u}; v = k; }
    *(LAS v4u*)(F.lds + AT_K0 + buf * 64 * AT_RS + rr * AT_RS + pc * 16) = k;
    *(LAS v4u*)(F.lds + AT_V0 + buf * 64 * AT_RS + rr * AT_RS + pc * 16) = v;
}

template <bool SMP> __device__ __forceinline__ void attn_unit(Frame& F, int l, int unit) {
    const int tid = F.tid, lane = F.lane, w = F.wave;
    const int q = lane & 31, h_ = lane >> 5, blk = (lane >> 4) & 1, tl = q >> 2, hr = q & 3;
    int seq, kvh, qt;
    if (SMP) { seq = unit >> 1; kvh = unit & 1; qt = 128; } else { seq = unit >> 7; kvh = (unit >> 6) & 1; qt = unit & 63; }
    const int t0 = SMP ? PAST : qt * 64;
    const int tokl = SMP ? tl : 8 * w + tl, t = t0 + tokl;
    const size_t row = SMP ? (size_t)PM + seq * ST + tl : (size_t)seq * PT + t;
    const int head = kvh * 4 + hr;
    LAS float* PS = (LAS float*)(F.lds + AT_PS); LAS float* IMPw = (LAS float*)(F.lds + AT_IMP) + w * 192;
    LAS unsigned long long* MASKS = (LAS unsigned long long*)(F.lds + AT_MASK); LAS unsigned short* LIST = (LAS unsigned short*)(F.lds + AT_LIST); LAS int* NL = (LAS int*)(F.lds + AT_NL);
    constexpr int PSS = SMP ? 520 : 264;
    LAS float* PSw = SMP ? PS : PS + w * 8 * PSS;
    __syncthreads();
    bf16x8 qf[4];
    { const bf16* qp = WSP(bf16, WS_QN) + row * 512 + head * 64 + 8 * h_;
#pragma unroll
      for (int kk = 0; kk < 4; ++kk) qf[kk] = *(const bf16x8*)(qp + 16 * kk); }
    const float* ngp = WSP(float, WS_NG) + row * 24 + head * 3; const float g0 = ngp[0], g1 = ngp[1], g2 = ngp[2];
    if (!SMP) { for (int i = lane; i < 8 * PSS; i += 64) PSw[i] = 0.f; }
    const int ntc = SMP ? 8 : ((t0 + 32) >> 10) + 1;
    if (tid < 2 * ntc) LIST[tid] = (unsigned short)(((tid >= ntc ? 1u : 0u) << 14) | (unsigned)(tid >= ntc ? tid - ntc : tid));
    if (tid == 0) LIST[2 * ntc] = (unsigned short)AT_MARK;
    int nl = 2 * ntc + 1;
    TileRegs R;
    at_prefetch<SMP>(F, l, seq, kvh, (unsigned)0, R);
    at_store(F, 0, R);
    __syncthreads();
    float m = -INFINITY, lsum = 0.f, invden = 0.f;
    f32x16 O[2]; O[0] = (f32x16){}; O[1] = (f32x16){};
    LAS float* OAw = (LAS float*)(F.lds + AT_PS) + w * (SMP ? 2048 : 8 * PSS) + lane;
    unsigned long long mk0 = 0ull, mk1 = 0ull, wu = ~0ull;
    int cur_kind = -1, idx = 0;
#define AT_FINALIZE(kind) do { \
        if ((kind) == 0) { const float lt = lsum + __shfl_xor(lsum, 32); invden = lt > 0.f ? 1.0f / lt : 0.f; } \
        else if ((kind) == 1) { const float sc = g0 * invden; O[0] *= sc; O[1] *= sc; } \
        else if ((kind) == 2) { const float lt = lsum + __shfl_xor(lsum, 32); const float sc = (lt > 0.f ? 1.0f / lt : 0.f) * g1; \
            _Pragma("unroll") for (int r_ = 0; r_ < 16; ++r_) { OAw[r_ * 64] += O[0][r_] * sc; OAw[(16 + r_) * 64] += O[1][r_] * sc; } } } while (0)
    while (idx < nl) {
        const unsigned e = (unsigned)__builtin_amdgcn_readfirstlane((int)LIST[idx]);
        if (e == AT_MARK) {
            AT_FINALIZE(cur_kind); cur_kind = -1;
            LDS_WAIT(); asm volatile("" ::: "memory");
#pragma unroll 1
            for (int tk = 0; tk < 8; ++tk) {
                const LAS float* pr = PSw + tk * PSS;
                if (!SMP) {
                    const int s = lane; float imp = 0.f;
#pragma unroll
                    for (int n = 4 * s - 1; n <= 4 * s + 3; ++n) if (n >= 0) imp += pr[n];
                    const bool forced = (s == 0) || (s == qt) || (s == qt - 1), avail = s <= qt;
                    const float val = avail ? (forced ? 1e4f : imp) : -1e4f;
                    IMPw[s] = val; LDS_WAIT(); asm volatile("" ::: "memory");
                    int rank = 0;
#pragma unroll 8
                    for (int i = 0; i < 64; ++i) { const float v = IMPw[i]; rank += (v > val || (v == val && i < s)) ? 1 : 0; }
                    const unsigned long long mk = __ballot(rank < 16);
                    if (lane == 0) MASKS[(8 * w + tk) * 4] = mk;
                    LDS_WAIT(); asm volatile("" ::: "memory");
                } else {
                    const int sa = lane, sb = lane + 64; float ia = 0.f, ib = 0.f;
#pragma unroll
                    for (int n = 4 * sa - 1; n <= 4 * sa + 3; ++n) if (n >= 0) ia += pr[n];
#pragma unroll
                    for (int n = 4 * sb - 1; n <= 4 * sb + 3; ++n) ib += pr[n];
                    const bool fa = (sa == 0), fb = (sb == 127);
                    const float va = fa ? 1e4f : ia, vb = fb ? 1e4f : ib;
                    IMPw[sa] = va; IMPw[sb] = vb; LDS_WAIT(); asm volatile("" ::: "memory");
                    int ra = fa ? 0 : 1, rb = fb ? 0 : 1;
#pragma unroll 8
                    for (int i = 0; i < 128; ++i) { const float v = IMPw[i]; ra += (v > va || (v == va && i < sa)) ? 1 : 0; rb += (v > vb || (v == vb && i < sb)) ? 1 : 0; }
                    const unsigned long long ma = __ballot(ra < 16), mb = __ballot(rb < 16);
                    if (lane == 0) { MASKS[tk * 4] = ma; MASKS[tk * 4 + 1] = mb; MASKS[tk * 4 + 2] = 1ull; }
                    LDS_WAIT(); asm volatile("" ::: "memory");
                }
            }
            __syncthreads();
#pragma unroll
            for (int r_ = 0; r_ < 16; ++r_) { OAw[r_ * 64] = O[0][r_]; OAw[(16 + r_) * 64] = O[1][r_]; }
            if (tid == 0) {
                int n = idx + 1;
                if (!SMP) { unsigned long long U = 0ull; for (int i = 0; i < 64; ++i) U |= MASKS[i * 4];
                    for (int s = 0; s <= qt; ++s) if ((U >> s) & 1ull) LIST[n++] = (unsigned short)((2u << 14) | (unsigned)s);
                    for (int s = (qt > 8 ? qt - 8 : 0); s <= qt; ++s) LIST[n++] = (unsigned short)((3u << 14) | (unsigned)s);
                } else { unsigned long long U0 = 0ull, U1 = 0ull; for (int i = 0; i < 8; ++i) { U0 |= MASKS[i * 4]; U1 |= MASKS[i * 4 + 1]; }
                    for (int s = 0; s < 64; ++s) if ((U0 >> s) & 1ull) LIST[n++] = (unsigned short)((2u << 14) | (unsigned)s);
                    for (int s = 0; s < 64; ++s) if ((U1 >> s) & 1ull) LIST[n++] = (unsigned short)((2u << 14) | (unsigned)(64 + s));
                    LIST[n++] = (unsigned short)((2u << 14) | 128u);
                    for (int s = 0; s <= 8; ++s) LIST[n++] = (unsigned short)((3u << 14) | (unsigned)s); }
                NL[0] = n;
            }
            __syncthreads();
            nl = __builtin_amdgcn_readfirstlane(NL[0]);
            mk0 = MASKS[tokl * 4]; if (SMP) { mk1 = MASKS[tokl * 4 + 1]; }
            if (!SMP) { unsigned long long u = 0ull; for (int i = 0; i < 8; ++i) u |= MASKS[(8 * w + i) * 4]; wu = u; }
            if (idx + 1 < nl) { at_prefetch<SMP>(F, l, seq, kvh, (unsigned)LIST[idx + 1], R); at_store(F, (idx + 1) & 1, R); }
            __syncthreads();
            ++idx; continue;
        }
        const int kind = (int)(e >> 14), ti = (int)(e & 0x3fffu);
        if (kind != cur_kind) {
            if (cur_kind >= 0) AT_FINALIZE(cur_kind);
            if (kind != 1) m = -INFINITY;
            lsum = 0.f; O[0] = (f32x16){}; O[1] = (f32x16){}; cur_kind = kind;
        }
        const unsigned en = (idx + 1 < nl) ? (unsigned)__builtin_amdgcn_readfirstlane((int)LIST[idx + 1]) : AT_MARK;
        const bool have_next = (en != AT_MARK);
        if (have_next) at_prefetch<SMP>(F, l, seq, kvh, en, R);
        bool active = true;
        if (!SMP && kind == 2) active = ((wu >> ti) & 1ull) != 0ull;
        if (active) {
            const LAS unsigned char* Kb = F.lds + AT_K0 + (idx & 1) * 64 * AT_RS; const LAS unsigned char* Vb = F.lds + AT_V0 + (idx & 1) * 64 * AT_RS;
            int lo, hi; const int kb = 64 * ti;
            if (kind < 2) { lo = 0; hi = SMP ? 510 : ((t >= 31) ? ((t - 31) >> 4) : -1); }
            else if (kind == 2) { lo = 0; const unsigned long long mw = (ti < 64) ? mk0 : ((ti < 128) ? mk1 : 1ull); hi = ((mw >> (ti & 63)) & 1ull) ? t : -1; }
            else { if (SMP) { lo = tl; hi = WINB + tl; } else { lo = t - WINB; hi = t; } }
            f32x16 s0 = (f32x16){}, s1 = (f32x16){};
#pragma unroll
            for (int kk = 0; kk < 4; ++kk) {
                const bf16x8 k0 = *(const LAS bf16x8*)(Kb + q * AT_RS + (16 * kk + 8 * h_) * 2), k1 = *(const LAS bf16x8*)(Kb + (32 + q) * AT_RS + (16 * kk + 8 * h_) * 2);
                s0 = mfma32(k0, qf[kk], s0); s1 = mfma32(k1, qf[kk], s1);
            }
            float tmax = -INFINITY;
#pragma unroll
            for (int r = 0; r < 16; ++r) { const int key = kb + (r & 3) + 8 * (r >> 2) + 4 * h_;
                s0[r] = (key >= lo && key <= hi) ? s0[r] : -INFINITY; s1[r] = (key + 32 >= lo && key + 32 <= hi) ? s1[r] : -INFINITY;
                tmax = fmaxf(tmax, fmaxf(s0[r], s1[r])); }
            tmax = fmaxf(tmax, __shfl_xor(tmax, 32));
            const float m_new = fmaxf(m, tmax), m_use = (m_new == -INFINITY) ? 0.f : m_new;
            const float alpha = fexp2(m - m_use);
            float ps = 0.f;
#pragma unroll
            for (int r = 0; r < 16; ++r) { s0[r] = fexp2(s0[r] - m_use); s1[r] = fexp2(s1[r] - m_use); ps += s0[r] + s1[r]; }
            lsum = lsum * alpha + ps; m = m_new;
            if (kind != 0) {
                O[0] *= alpha; O[1] *= alpha;
#pragma unroll
                for (int kt2 = 0; kt2 < 2; ++kt2)
#pragma unroll
                    for (int s2 = 0; s2 < 2; ++s2) { const bf16x8 pf = cvt_frag(kt2 ? s1 : s0, s2); const int rA = 32 * kt2 + 16 * s2 + 4 * h_;
#pragma unroll
                        for (int dt = 0; dt < 2; ++dt) { const bf16x8 vf = tr_frag(Vb, AT_RS, rA, rA + 8, 32 * dt + 16 * blk, lane); O[dt] = mfma32(vf, pf, O[dt]); } }
            }
            if (kind == 1) {
#pragma unroll
                for (int r = 0; r < 16; ++r) { const int n = kb + (r & 3) + 8 * (r >> 2) + 4 * h_;
                    float a = s0[r] * invden, b = s1[r] * invden; a += __shfl_xor(a, 1); b += __shfl_xor(b, 1); a += __shfl_xor(a, 2); b += __shfl_xor(b, 2);
                    if (hr == 0) { PSw[tl * PSS + n] = a; PSw[tl * PSS + n + 32] = b; } }
            }
        }
        if (have_next) at_store(F, (idx + 1) & 1, R);
        __syncthreads();
        ++idx;
    }
#undef AT_FINALIZE
    {
        const float lt = lsum + __shfl_xor(lsum, 32); const float sc = (lt > 0.f ? 1.0f / lt : 0.f) * g2;
        if (!SMP || w == 0) {
            bf16* op = WSP(bf16, WS_OA) + row * 512 + head * 64;
#pragma unroll
            for (int dt = 0; dt < 2; ++dt)
#pragma unroll
                for (int r4 = 0; r4 < 4; ++r4) { float o_[4];
#pragma unroll
                    for (int x = 0; x < 4; ++x) o_[x] = OAw[(dt * 16 + 4 * r4 + x) * 64] + O[dt][4 * r4 + x] * sc;
                    v2u wv; wv.x = pk2(o_[0], o_[1]); wv.y = pk2(o_[2], o_[3]); *(v2u*)(op + 32 * dt + 8 * r4 + 4 * h_) = wv; }
        }
    }
}

constexpr int AS_RS = 144;
constexpr int AS_V = 0, AS_VW = 32 * AS_RS, AS_MRG = 0, AS_PS = 73728, AS_IMP = AS_PS + 16640, AS_MASK = AS_IMP + 6144;
static_assert(8 * 34 * 64 * 4 <= AS_PS && AS_MASK + 512 <= RING_BYTES, "sample attention LDS map");

__device__ __forceinline__ float xhalf_max(float x) { auto t_ = __builtin_amdgcn_permlane32_swap(__float_as_uint(x), __float_as_uint(x), false, false); return fmaxf(__uint_as_float(t_[0]), __uint_as_float(t_[1])); }
__device__ __forceinline__ float xhalf_sum(float x) { auto t_ = __builtin_amdgcn_permlane32_swap(__float_as_uint(x), __float_as_uint(x), false, false); return __uint_as_float(t_[0]) + __uint_as_float(t_[1]); }
struct ASrc { const float* kf; const float* vf; const bf16* kb; const bf16* vb; int rs; int nvalid; };
#define AS_TILE(SRC, KB0, LO_, HI_, DO_PV, DO_PS, m, lsum, O0, O1, invden, PSS_) do { \
        bf16x8 kfr[4]; \
        if ((SRC).kb) { const bf16* kp_ = (SRC).kb + (size_t)q * (SRC).rs + 8 * h_; _Pragma("unroll") for (int kk = 0; kk < 4; ++kk) kfr[kk] = *(const bf16x8*)(kp_ + 16 * kk); } \
        else { const float* kp_ = (SRC).kf + (size_t)q * (SRC).rs + 8 * h_; _Pragma("unroll") for (int kk = 0; kk < 4; ++kk) { const f32x4 a_ = *(const f32x4*)(kp_ + 16 * kk), b_ = *(const f32x4*)(kp_ + 16 * kk + 4); kfr[kk] = __builtin_bit_cast(bf16x8, pack8(a_, b_)); } } \
        if (DO_PV) { const int vr_ = lane >> 1, vh_ = lane & 1; v4u vv_[4]; \
            if (vr_ >= (SRC).nvalid) { _Pragma("unroll") for (int x = 0; x < 4; ++x) vv_[x] = (v4u){0u, 0u, 0u, 0u}; } \
            else if ((SRC).vb) { const bf16* vp_ = (SRC).vb + (size_t)vr_ * (SRC).rs + 32 * vh_; _Pragma("unroll") for (int x = 0; x < 4; ++x) vv_[x] = *(const v4u*)(vp_ + 8 * x); } \
            else { const float* vp_ = (SRC).vf + (size_t)vr_ * (SRC).rs + 32 * vh_; _Pragma("unroll") for (int x = 0; x < 4; ++x) vv_[x] = pack8(*(const f32x4*)(vp_ + 8 * x), *(const f32x4*)(vp_ + 8 * x + 4)); } \
            _Pragma("unroll") for (int x = 0; x < 4; ++x) *(LAS v4u*)(Vw + vr_ * AS_RS + vh_ * 64 + x * 16) = vv_[x]; } \
        f32x16 s_ = (f32x16){}; \
        _Pragma("unroll") for (int kk = 0; kk < 4; ++kk) s_ = mfma32(kfr[kk], qf[kk], s_); \
        float tmax_ = -INFINITY; \
        _Pragma("unroll") for (int r = 0; r < 16; ++r) { const int key_ = (KB0) + (r & 3) + 8 * (r >> 2) + 4 * h_; s_[r] = (key_ >= (LO_) && key_ <= (HI_)) ? s_[r] : -INFINITY; tmax_ = fmaxf(tmax_, s_[r]); } \
        tmax_ = xhalf_max(tmax_); \
        const float mn_ = fmaxf(m, tmax_), mu_ = (mn_ == -INFINITY) ? 0.f : mn_, al_ = fexp2(m - mu_); float ps_ = 0.f; \
        _Pragma("unroll") for (int r = 0; r < 16; ++r) { s_[r] = fexp2(s_[r] - mu_); ps_ += s_[r]; } \
        lsum = lsum * al_ + ps_; m = mn_; \
        if (DO_PV) { O0 *= al_; O1 *= al_; LDS_WAIT(); asm volatile("" ::: "memory"); \
            _Pragma("unroll") for (int s2 = 0; s2 < 2; ++s2) { const bf16x8 pf_ = cvt_frag(s_, s2); const int rA_ = 16 * s2 + 4 * h_; \
                O0 = mfma32(tr_frag(Vw, AS_RS, rA_, rA_ + 8, 16 * blk, lane), pf_, O0); O1 = mfma32(tr_frag(Vw, AS_RS, rA_, rA_ + 8, 32 + 16 * blk, lane), pf_, O1); } \
            LDS_WAIT(); asm volatile("" ::: "memory"); } \
        if (DO_PS) { _Pragma("unroll") for (int r = 0; r < 16; ++r) { const int n_ = (KB0) + (r & 3) + 8 * (r >> 2) + 4 * h_; float a_ = s_[r] * (invden); a_ += __shfl_xor(a_, 1); a_ += __shfl_xor(a_, 2); if (hr == 0) PS[tl * (PSS_) + n_] = a_; } } \
    } while (0)

__device__ __forceinline__ void attn_sample_unit(Frame& F, int l, int unit) {
    const int lane = F.lane, w = F.wave, tid = F.tid;
    const int q = lane & 31, h_ = lane >> 5, blk = (lane >> 4) & 1, tl = q >> 2, hr = q & 3;
    const int seq = unit >> 1, kvh = unit & 1, head = kvh * 4 + hr;
    const size_t row = (size_t)PM + seq * ST + tl;
    LAS unsigned char* Vw = F.lds + AS_V + w * AS_VW;
    LAS float* MRG = (LAS float*)(F.lds + AS_MRG);
    LAS float* PS = (LAS float*)(F.lds + AS_PS);
    LAS float* IMPw = (LAS float*)(F.lds + AS_IMP) + w * 192;
    LAS unsigned long long* MASKS = (LAS unsigned long long*)(F.lds + AS_MASK);
    __syncthreads();
    bf16x8 qf[4];
    { const bf16* qp = WSP(bf16, WS_QN) + row * 512 + head * 64 + 8 * h_;
#pragma unroll
      for (int kk = 0; kk < 4; ++kk) qf[kk] = *(const bf16x8*)(qp + 16 * kk); }
    const float* ngp = WSP(float, WS_NG) + row * 24 + head * 3; const float g0 = ngp[0], g1 = ngp[1], g2 = ngp[2];
    const int* ptab = (const int*)F.a->in[I_PT] + seq * NPG;
    f32x16 OA0 = (f32x16){}, OA1 = (f32x16){};

#define AS_PUBLISH(m, lsum, O0, O1) do { __syncthreads(); LAS float* mp_ = MRG + w * 34 * 64 + lane; mp_[0] = m; mp_[64] = lsum; \
        _Pragma("unroll") for (int r = 0; r < 16; ++r) { mp_[(2 + r) * 64] = O0[r]; mp_[(18 + r) * 64] = O1[r]; } __syncthreads(); } while (0)

    const bf16* CKk = WSP(bf16, WS_CK) + ((size_t)(seq * 2 + kvh) * 512) * 64; const bf16* CKv = CKk + (size_t)CMP_ROWS_J * 64;
    float mC = -INFINITY, lC = 0.f; f32x16 D0 = (f32x16){}, D1 = (f32x16){};
#pragma unroll 1
    for (int ti = w; ti < 16; ti += 8) { ASrc S{nullptr, nullptr, CKk + (size_t)ti * 32 * 64, CKv + (size_t)ti * 32 * 64, 64, 32}; AS_TILE(S, ti * 32, 0, 510, false, false, mC, lC, D0, D1, 0.f, 520); }
    { __syncthreads(); MRG[w * 128 + lane] = mC; MRG[w * 128 + 64 + lane] = xhalf_sum(lC); __syncthreads(); }
    float mT = -INFINITY;
#pragma unroll
    for (int x = 0; x < 8; ++x) mT = fmaxf(mT, MRG[x * 128 + lane]);
    float lT = 0.f;
#pragma unroll
    for (int x = 0; x < 8; ++x) { const float mx_ = MRG[x * 128 + lane]; lT += (mx_ == -INFINITY) ? 0.f : MRG[x * 128 + 64 + lane] * fexp2(mx_ - mT); }
    const float invC = lT > 0.f ? 1.0f / lT : 0.f;
    __syncthreads();
    { float mB = mT, lB = 0.f;
#pragma unroll 1
      for (int ti = w; ti < 16; ti += 8) { ASrc S{nullptr, nullptr, CKk + (size_t)ti * 32 * 64, CKv + (size_t)ti * 32 * 64, 64, 32}; AS_TILE(S, ti * 32, 0, 510, true, true, mB, lB, D0, D1, invC, 520); }
      AS_PUBLISH(mB, lB, D0, D1); }
    { const float sc = g0 * invC;
#pragma unroll 1
      for (int x = 0; x < 8; ++x) { const LAS float* mp = MRG + x * 34 * 64 + lane;
#pragma unroll
          for (int r = 0; r < 16; ++r) { OA0[r] += mp[(2 + r) * 64] * sc; OA1[r] += mp[(18 + r) * 64] * sc; } } }
    {
        const LAS float* pr = PS + w * 520; const int sa = lane, sb = lane + 64; float ia = 0.f, ib = 0.f;
#pragma unroll
        for (int n = 4 * sa - 1; n <= 4 * sa + 3; ++n) if (n >= 0) ia += pr[n];
#pragma unroll
        for (int n = 4 * sb - 1; n <= 4 * sb + 3; ++n) ib += pr[n];
        const bool fa = (sa == 0), fb = (sb == 127); const float va = fa ? 1e4f : ia, vb = fb ? 1e4f : ib;
        IMPw[sa] = va; IMPw[sb] = vb; LDS_WAIT(); asm volatile("" ::: "memory");
        int ra = fa ? 0 : 1, rb = fb ? 0 : 1;
#pragma unroll 8
        for (int i = 0; i < 128; ++i) { const float v = IMPw[i]; ra += (v > va || (v == va && i < sa)) ? 1 : 0; rb += (v > vb || (v == vb && i < sb)) ? 1 : 0; }
        const unsigned long long ma = __ballot(ra < 16), mb = __ballot(rb < 16);
        if (lane == 0) { MASKS[w * 4] = ma; MASKS[w * 4 + 1] = mb; }
    }
    __syncthreads();
    const unsigned long long mk0 = MASKS[tl * 4], mk1 = MASKS[tl * 4 + 1];
    unsigned long long U0 = 0ull, U1 = 0ull;
#pragma unroll
    for (int x = 0; x < 8; ++x) { U0 |= MASKS[x * 4]; U1 |= MASKS[x * 4 + 1]; }
    {
        float m = -INFINITY, ls = 0.f; D0 = (f32x16){}; D1 = (f32x16){};
        const int t = PAST + tl; int cnt = 0;
#pragma unroll 1
        for (int s = 0; s <= 128; ++s) {
            const bool in_u = (s < 64) ? ((U0 >> s) & 1ull) : ((s < 128) ? ((U1 >> (s - 64)) & 1ull) : true);
            if (!in_u) continue;
            const bool selb = (s < 64) ? ((mk0 >> s) & 1ull) : ((s < 128) ? ((mk1 >> (s - 64)) & 1ull) : true);
            const int nh = (s < 128) ? 2 : 1;
            for (int hf = 0; hf < nh; ++hf, ++cnt) {
                if ((cnt & 7) != w) continue;
                const int hi = selb ? t : -1;
                if (s < 128) { const int page = ptab[s >> 1], slot = (s & 1) * 64 + hf * 32;
                    const float* kp = FIN(I_CACHE) + (((((size_t)l * NPHYS + page) * PAGE + slot) * 4 + 2) * 2 + kvh) * 64;
                    ASrc S{kp, kp + 128, nullptr, nullptr, 512, 32}; AS_TILE(S, s * 64 + hf * 32, 0, hi, true, false, m, ls, D0, D1, 0.f, 520); }
                else { const bf16* kp = WSP(bf16, WS_KVS) + ((((size_t)0 * SB + seq) * 2 + kvh) * ST) * 64;
                    ASrc S{nullptr, nullptr, kp, kp + (size_t)SB * 2 * ST * 64, 64, ST}; AS_TILE(S, PAST, 0, hi, true, false, m, ls, D0, D1, 0.f, 520); }
            }
        }
        AS_PUBLISH(m, ls, D0, D1);
        float mt = -INFINITY;
#pragma unroll
        for (int x = 0; x < 8; ++x) mt = fmaxf(mt, MRG[x * 34 * 64 + lane]);
        float lt = 0.f; f32x16 T0 = (f32x16){}, T1 = (f32x16){};
#pragma unroll 1
        for (int x = 0; x < 8; ++x) { const LAS float* mp = MRG + x * 34 * 64 + lane; const float mx_ = mp[0]; const float f = (mx_ == -INFINITY) ? 0.f : fexp2(mx_ - mt); lt += mp[64] * f;
#pragma unroll
            for (int r = 0; r < 16; ++r) { T0[r] += mp[(2 + r) * 64] * f; T1[r] += mp[(18 + r) * 64] * f; } }
        lt = xhalf_sum(lt); const float sc = (lt > 0.f ? 1.0f / lt : 0.f) * g1; OA0 += T0 * sc; OA1 += T1 * sc;
    }
    {
        float m = -INFINITY, ls = 0.f; D0 = (f32x16){}; D1 = (f32x16){};
#pragma unroll 1
        for (int ti = w; ti < 17; ti += 8) {
            if (ti < 16) { const float* kp = FIN(I_CWIN) + (((((size_t)l * SB + seq) * WINB + ti * 32) * 2 + 0) * 2 + kvh) * 64;
                ASrc S{kp, kp + 128, nullptr, nullptr, 256, 32}; AS_TILE(S, ti * 32, tl, WINB + tl, true, false, m, ls, D0, D1, 0.f, 520); }
            else { const bf16* kp = WSP(bf16, WS_KVS) + ((((size_t)2 * SB + seq) * 2 + kvh) * ST) * 64;
                ASrc S{nullptr, nullptr, kp, kp + (size_t)SB * 2 * ST * 64, 64, ST}; AS_TILE(S, WINB, tl, WINB + tl, true, false, m, ls, D0, D1, 0.f, 520); }
        }
        AS_PUBLISH(m, ls, D0, D1);
        float mt = -INFINITY;
#pragma unroll
        for (int x = 0; x < 8; ++x) mt = fmaxf(mt, MRG[x * 34 * 64 + lane]);
        float lt = 0.f; f32x16 T0 = (f32x16){}, T1 = (f32x16){};
#pragma unroll 1
        for (int x = 0; x < 8; ++x) { const LAS float* mp = MRG + x * 34 * 64 + lane; const float mx_ = mp[0]; const float f = (mx_ == -INFINITY) ? 0.f : fexp2(mx_ - mt); lt += mp[64] * f;
#pragma unroll
            for (int r = 0; r < 16; ++r) { T0[r] += mp[(2 + r) * 64] * f; T1[r] += mp[(18 + r) * 64] * f; } }
        lt = xhalf_sum(lt); const float sc = (lt > 0.f ? 1.0f / lt : 0.f) * g2; OA0 += T0 * sc; OA1 += T1 * sc;
    }
#undef AS_PUBLISH
    if (w == 0) {
        bf16* op = WSP(bf16, WS_OA) + row * 512 + head * 64;
#pragma unroll
        for (int r4 = 0; r4 < 4; ++r4) { v2u a, b; a.x = pk2(OA0[4 * r4 + 0], OA0[4 * r4 + 1]); a.y = pk2(OA0[4 * r4 + 2], OA0[4 * r4 + 3]); b.x = pk2(OA1[4 * r4 + 0], OA1[4 * r4 + 1]); b.y = pk2(OA1[4 * r4 + 2], OA1[4 * r4 + 3]);
            *(v2u*)(op + 8 * r4 + 4 * h_) = a; *(v2u*)(op + 32 + 8 * r4 + 4 * h_) = b; }
    }
}

#ifndef DBG_DUP
#define DBG_DUP 0
#endif
#if DBG_DUP == 1
#define AP_DUP_QK(NK) { f32x16 d_ = (f32x16){}; _Pragma("unroll") for (int kk = 0; kk < 4; ++kk) d_ = mfma32(NK[kk], qf[(kk + 1) & 3], d_); _Pragma("unroll") for (int r = 0; r < 16; ++r) s_[r] += zf * d_[r]; }
#else
#define AP_DUP_QK(NK)
#endif
#if DBG_DUP == 2
#define AP_DUP_EXP() { float acc_ = 0.f; _Pragma("unroll") for (int r = 0; r < 16; ++r) acc_ += fexp2(s_[r] * 0.5f - 3.0f); lsum += zf * acc_; }
#else
#define AP_DUP_EXP()
#endif
#if DBG_DUP == 3
#define AP_DUP_PV() { f32x16 e0_ = (f32x16){}, e1_ = (f32x16){}; _Pragma("unroll") for (int s2 = 0; s2 < 2; ++s2) { const bf16x8 pf_ = cvt_frag(s_, 1 - s2); const int rA_ = 16 * s2 + 4 * h_; \
        e0_ = mfma32(tr_frag(Vw, AS_RS, rA_ + 8, rA_, 16 * blk, lane), pf_, e0_); e1_ = mfma32(tr_frag(Vw, AS_RS, rA_ + 8, rA_, 32 + 16 * blk, lane), pf_, e1_); } D0 += e0_ * zf; D1 += e1_ * zf; }
#else
#define AP_DUP_PV()
#endif
constexpr int AP_WS = 14336, AP_V = 0, AP_PS = 4608, AP_IMP = AP_PS + 8 * 264 * 4, AP_MASK = AP_IMP + 256, AP_LIST = AP_MASK + 64;
static_assert(AP_LIST + 2 * 192 <= AP_WS && 8 * AP_WS <= RING_BYTES, "prompt attention LDS map");
__device__ __forceinline__ void attn_prompt_unit(Frame& F, int l, int unit) {
    const int lane = F.lane, w = F.wave;
    const int q = lane & 31, h_ = lane >> 5, blk = (lane >> 4) & 1, tl = q >> 2, hr = q & 3;
    const int seq = unit >> 7, kvh = (unit >> 6) & 1, qt = unit & 63, head = kvh * 4 + hr;
    const int t0w = qt * 64 + 8 * w, t = t0w + tl; const size_t row = (size_t)seq * PT + t;
    LAS unsigned char* Vw = F.lds + w * AP_WS + AP_V; LAS float* PS = (LAS float*)(F.lds + w * AP_WS + AP_PS); LAS float* IMPw = (LAS float*)(F.lds + w * AP_WS + AP_IMP);
    LAS unsigned long long* MASKS = (LAS unsigned long long*)(F.lds + w * AP_WS + AP_MASK); LAS unsigned short* LIST = (LAS unsigned short*)(F.lds + w * AP_WS + AP_LIST);
    __syncthreads();
    bf16x8 qf[4];
    { const bf16* qp = WSP(bf16, WS_QN) + row * 512 + head * 64 + 8 * h_;
#pragma unroll
      for (int kk = 0; kk < 4; ++kk) qf[kk] = *(const bf16x8*)(qp + 16 * kk); }
    const float* ngp = WSP(float, WS_NG) + row * 24 + head * 3; const float g0 = ngp[0], g1 = ngp[1], g2 = ngp[2];
    for (int i = lane; i < 8 * 264; i += 64) PS[i] = 0.f;
    const bf16* CKk = WSP(bf16, WS_CK) + ((size_t)32768 + (seq * 2 + kvh) * 256) * 64; const bf16* CKv = CKk + (size_t)CMP_ROWS_J * 64;
    const bf16* KS = WSP(bf16, WS_KVB) + ((((size_t)0 * PB + seq) * 2 + kvh) * PT) * 64; const bf16* VS = KS + (size_t)PB * 2 * PT * 64;
    const bf16* KW = KS + (size_t)2 * PB * 2 * PT * 64; const bf16* VW = KW + (size_t)PB * 2 * PT * 64;
    const int hiCmin = (t0w >= 31) ? ((t0w - 31) >> 4) : -1;
    const int hiC = (t >= 31) ? ((t - 31) >> 4) : -1; const int nmaxw = (t0w + 7 >= 31) ? ((t0w + 7 - 31) >> 4) : -1; const int ntc = (nmaxw >= 0) ? (nmaxw >> 5) + 1 : 0;
    f32x16 D0 = (f32x16){}, D1 = (f32x16){};
    LAS float* OAG = PS + lane;
    float m = -INFINITY, lsum = 0.f, invC = 0.f; unsigned long long mk0 = 0ull;
    const float zf = (F.G == 12345) ? 1.0f : 0.0f;
    bf16x8 nk0[4]; v4u nv0[4], nv1[4];
#define AP_LOADK(e_, NK) do { const int kd_ = (int)((e_) >> 12), ti_ = (int)((e_) & 0xfffu); const bf16* kb_ = (kd_ < 2 ? CKk : (kd_ == 2 ? KS : KW)) + (size_t)ti_ * 32 * 64; \
        const int ko_ = kd_ < 2 ? q * 64 + 8 * h_ : lane * 8, ks_ = kd_ < 2 ? 16 : 512;     \
        _Pragma("unroll") for (int kk = 0; kk < 4; ++kk) NK[kk] = *(const bf16x8*)(kb_ + ko_ + ks_ * kk); } while (0)
#define AP_LOADV(e_, NV) do { const int kd_ = (int)((e_) >> 12), ti_ = (int)((e_) & 0xfffu); const bf16* vb_ = (kd_ < 2 ? CKv : (kd_ == 2 ? VS : VW)) + (size_t)ti_ * 32 * 64; \
        _Pragma("unroll") for (int x = 0; x < 4; ++x) NV[x] = *(const v4u*)(vb_ + 512 * x + lane * 8); } while (0)
#define AP_LOADT(e_, NK, NV) do { AP_LOADK(e_, NK); AP_LOADV(e_, NV); } while (0)
#define AP_STEP(i_, n_, NK, NV, NVN, EC, ECN) do { \
        const unsigned e_ = EC; const int kind = (int)(e_ >> 12), ti = (int)(e_ & 0xfffu); \
        if (kind == 1) { _Pragma("unroll") for (int x = 0; x < 4; ++x) *(LAS v4u*)(Vw + (8 * x + (lane >> 3)) * AS_RS + (lane & 7) * 16) = NV[x]; }     \
        f32x16 s_ = (f32x16){}; \
        _Pragma("unroll") for (int kk = 0; kk < 4; ++kk) s_ = mfma32(NK[kk], qf[kk], s_); \
        AP_DUP_QK(NK) \
          \
        if ((i_) + 1 < (n_)) { AP_LOADK(ECN, NK); AP_LOADV(ECN, NVN); if ((i_) + 2 < (n_)) EC = (unsigned)__builtin_amdgcn_readfirstlane((int)LIST[(i_) + 2]); } \
        if (kind != cur_kind) { \
            if (cur_kind == 0) { const float lt_ = xhalf_sum(lsum); invC = lt_ > 0.f ? 1.0f / lt_ : 0.f; } \
            else if (cur_kind == 2) { const float lt_ = xhalf_sum(lsum); const float sc_ = (lt_ > 0.f ? 1.0f / lt_ : 0.f) * g1; \
                _Pragma("unroll") for (int r = 0; r < 16; ++r) { OAG[r * 64] += D0[r] * sc_; OAG[(16 + r) * 64] += D1[r] * sc_; } } \
            if (kind != 1) m = -INFINITY; lsum = 0.f; D0 = (f32x16){}; D1 = (f32x16){}; cur_kind = kind; } \
        const int kb = ti * 32; int lo, hi; \
        if (kind < 2) { lo = 0; hi = hiC; } else if (kind == 2) { lo = 0; hi = ((mk0 >> (ti >> 1)) & 1ull) ? t : -1; } else { lo = t - WINB; hi = t; } \
          \
        const bool interior = (kind < 2) ? (hiCmin >= 0 && kb + 31 <= hiCmin) : ((kind == 2) ? (kb + 31 <= t0w) : (kb >= t0w + 7 - WINB && kb + 31 <= t0w)); \
        float tmax_ = -INFINITY, mu_, mn_; \
        if (interior) { const bool on_ = hi >= 0; \
            _Pragma("unroll") for (int r = 0; r < 16; ++r) tmax_ = fmaxf(tmax_, s_[r]); \
            tmax_ = on_ ? tmax_ : -INFINITY; tmax_ = xhalf_max(tmax_); \
            mn_ = fmaxf(m, tmax_); mu_ = (mn_ == -INFINITY) ? 0.f : mn_; const float mr_ = on_ ? mu_ : INFINITY; \
            _Pragma("unroll") for (int r = 0; r < 16; ++r) s_[r] = fexp2(s_[r] - mr_); \
        } else { \
            _Pragma("unroll") for (int r = 0; r < 16; ++r) { const int key_ = kb + (r & 3) + 8 * (r >> 2) + 4 * h_; s_[r] = (key_ >= lo && key_ <= hi) ? s_[r] : -INFINITY; tmax_ = fmaxf(tmax_, s_[r]); } \
            tmax_ = xhalf_max(tmax_); \
            mn_ = fmaxf(m, tmax_); mu_ = (mn_ == -INFINITY) ? 0.f : mn_; \
            _Pragma("unroll") for (int r = 0; r < 16; ++r) s_[r] = fexp2(s_[r] - mu_); \
        } \
        AP_DUP_EXP() \
        const float al_ = fexp2(m - mu_); float ps_ = 0.f; \
        _Pragma("unroll") for (int r = 0; r < 16; ++r) ps_ += s_[r]; \
        lsum = lsum * al_ + ps_; m = mn_; \
        if (kind >= 2) { if (__ballot(al_ != 1.0f) != 0ull) { D0 *= al_; D1 *= al_; } \
            const bf16x8 pf0_ = cvt_frag(s_, 0), pf1_ = cvt_frag(s_, 1); \
            D0 = mfma32(__builtin_bit_cast(bf16x8, NV[0]), pf0_, D0); D1 = mfma32(__builtin_bit_cast(bf16x8, NV[2]), pf0_, D1); D0 = mfma32(__builtin_bit_cast(bf16x8, NV[1]), pf1_, D0); D1 = mfma32(__builtin_bit_cast(bf16x8, NV[3]), pf1_, D1); \
        } else if (kind == 1) { if (__ballot(al_ != 1.0f) != 0ull) { D0 *= al_; D1 *= al_; } asm volatile("" ::: "memory");   \
            { const bf16x8 va0_ = tr_frag(Vw, AS_RS, 4 * h_, 4 * h_ + 8, 16 * blk, lane), va1_ = tr_frag(Vw, AS_RS, 4 * h_, 4 * h_ + 8, 32 + 16 * blk, lane), \
                           vb0_ = tr_frag(Vw, AS_RS, 16 + 4 * h_, 24 + 4 * h_, 16 * blk, lane), vb1_ = tr_frag(Vw, AS_RS, 16 + 4 * h_, 24 + 4 * h_, 32 + 16 * blk, lane);   \
              const bf16x8 pf0_ = cvt_frag(s_, 0), pf1_ = cvt_frag(s_, 1); \
              D0 = mfma32(va0_, pf0_, D0); D1 = mfma32(va1_, pf0_, D1); D0 = mfma32(vb0_, pf1_, D0); D1 = mfma32(vb1_, pf1_, D1); } \
            AP_DUP_PV() \
            asm volatile("" ::: "memory"); } \
        if (kind == 1) { _Pragma("unroll") for (int r = 0; r < 16; ++r) { const int n2_ = kb + (r & 3) + 8 * (r >> 2) + 4 * h_; float a_ = s_[r] * invC; a_ += __shfl_xor(a_, 1); a_ += __shfl_xor(a_, 2); if (hr == 0) PS[tl * 264 + n2_] = a_; } } \
    } while (0)
#define AP_RUN(N_) do { const int n_ = (N_); unsigned ec0_ = 0u, ec1_ = 0u;                  \
      if (n_ > 0) { ec0_ = (unsigned)__builtin_amdgcn_readfirstlane((int)LIST[0]); AP_LOADK(ec0_, nk0); AP_LOADV(ec0_, nv0); } \
      if (n_ > 1) { ec1_ = (unsigned)__builtin_amdgcn_readfirstlane((int)LIST[1]); } \
      _Pragma("unroll 1") for (int i_ = 0; i_ < n_; i_ += 2) { AP_STEP(i_, n_, nk0, nv0, nv1, ec0_, ec1_); if (i_ + 1 < n_) AP_STEP(i_ + 1, n_, nk0, nv1, nv0, ec1_, ec0_); } } while (0)
    int cur_kind = -1;
    if (lane < 2 * ntc) LIST[lane] = (unsigned short)(((lane >= ntc ? 1u : 0u) << 12) | (unsigned)(lane >= ntc ? lane - ntc : lane));
    LDS_WAIT(); asm volatile("" ::: "memory");
    AP_RUN(2 * ntc);
    { const float sc = (cur_kind == 1) ? g0 * invC : 0.f; D0 *= sc; D1 *= sc; }
    LDS_WAIT(); asm volatile("" ::: "memory");
#pragma unroll 1
    for (int tk = 0; tk < 8; ++tk) {
        const LAS float* pr = PS + tk * 264; const int s = lane; float imp = 0.f;
#pragma unroll
        for (int n = 4 * s - 1; n <= 4 * s + 3; ++n) if (n >= 0) imp += pr[n];
        const bool forced = (s == 0) || (s == qt) || (s == qt - 1), avail = s <= qt; const float val = avail ? (forced ? 1e4f : imp) : -1e4f;
        IMPw[s] = val; LDS_WAIT(); asm volatile("" ::: "memory");
        int rank = 0;
#pragma unroll 8
        for (int i = 0; i < 64; ++i) { const float v = IMPw[i]; rank += (v > val || (v == val && i < s)) ? 1 : 0; }
        const unsigned long long mk = __ballot(rank < 16);
        if (lane == 0) MASKS[tk] = mk;
        LDS_WAIT(); asm volatile("" ::: "memory");
    }
#pragma unroll
    for (int r = 0; r < 16; ++r) { OAG[r * 64] = D0[r]; OAG[(16 + r) * 64] = D1[r]; }
    mk0 = MASKS[tl]; unsigned long long wu = 0ull;
#pragma unroll
    for (int i = 0; i < 8; ++i) wu |= MASKS[i];
    wu &= (qt >= 63) ? ~0ull : ((1ull << (qt + 1)) - 1ull);
    const int nsel = 2 * __popcll(wu); const int tiLo = (t0w > WINB) ? ((t0w - WINB) >> 5) : 0, tiHi = (t0w + 7) >> 5, nwin = tiHi - tiLo + 1;
    if ((wu >> lane) & 1ull) { const int pos = 2 * __popcll(wu & ((1ull << lane) - 1ull)); LIST[pos] = (unsigned short)((2u << 12) | (unsigned)(2 * lane)); LIST[pos + 1] = (unsigned short)((2u << 12) | (unsigned)(2 * lane + 1)); }
    if (lane < nwin) LIST[nsel + lane] = (unsigned short)((3u << 12) | (unsigned)(tiLo + lane));
    LDS_WAIT(); asm volatile("" ::: "memory");
#ifdef DBG_COUNT
    if (lane == 0) { unsigned* CNT = (unsigned*)(F.ws + WS_CTL) + 3000; atomicAdd(CNT + 0, (unsigned)nsel); atomicAdd(CNT + 1, (unsigned)nwin); atomicAdd(CNT + 2, (unsigned)(2 * ntc)); atomicAdd(CNT + 3, 1u); }
#endif
    cur_kind = -1;
    AP_RUN(nsel + nwin);
    const float ltw = xhalf_sum(lsum); const float scw = (ltw > 0.f ? 1.0f / ltw : 0.f) * g2;
#undef AP_RUN
#undef AP_STEP
#undef AP_LOADT
#undef AP_LOADK
#undef AP_LOADV
    {
        bf16* op = WSP(bf16, WS_OA) + row * 512 + head * 64;
#pragma unroll
        for (int r4 = 0; r4 < 4; ++r4) { float a_[4], b_[4];
#pragma unroll
            for (int x = 0; x < 4; ++x) { a_[x] = OAG[(4 * r4 + x) * 64] + D0[4 * r4 + x] * scw; b_[x] = OAG[(16 + 4 * r4 + x) * 64] + D1[4 * r4 + x] * scw; }
            v2u a, b; a.x = pk2(a_[0], a_[1]); a.y = pk2(a_[2], a_[3]); b.x = pk2(b_[0], b_[1]); b.y = pk2(b_[2], b_[3]);
            *(v2u*)(op + 8 * r4 + 4 * h_) = a; *(v2u*)(op + 32 + 8 * r4 + 4 * h_) = b; }
    }
}
#undef AS_TILE

#ifdef DBG_CHECK
__device__ __forceinline__ unsigned dbg_rand(unsigned x) { x ^= x >> 16; x *= 0x7feb352du; x ^= x >> 15; x *= 0x846ca68bu; x ^= x >> 16; return x; }
__device__ __forceinline__ bool dbg_bad(float got, float exp_, float rtol, float atol) { return !(fabsf(got - exp_) <= rtol * fabsf(exp_) + atol); }
__device__ __forceinline__ float bfr(float x) { return __uint_as_float(pk2(x, 0.f) << 16); }
__device__ __forceinline__ int dbg_row(unsigned r) { const unsigned k = r % 20u; if (k == 0) return (int)(PM + (r >> 8) % SM); if (k == 1) return (int)(((r >> 8) % PB) * PT + ((r >> 12) % 8)); if (k == 2) return (int)(((r >> 8) % PB) * PT + PT - 1 - ((r >> 12) % 8)); return (int)((r >> 5) % PM); }
__device__ __forceinline__ float dbg_rs(const Frame& F, int row, int lane) { const float* xr = xrow_in(F, 0, row); float ss = 0.f; for (int d = lane; d < DM; d += 64) ss += xr[d] * xr[d]; return 1.0f / sqrtf(wave_sum(ss) * (1.0f / DM) + EPS); }
__device__ __forceinline__ float dbg_h(const Frame& F, int row, int d, float rs) { const float* mod = WSP(float, WS_MOD) + (size_t)row_bb(row) * 6144; return bfr(xrow_in(F, 0, row)[d] * rs * FIN(I_N1G)[d] * (1.0f + mod[1024 + d]) + mod[d]); }

__device__ __forceinline__ void dbg_check_phase(Frame& F) {
    const int gw = F.bid * NWAVES + F.wave, NGW = F.G * NWAVES, lane = F.lane;
    unsigned* CNT = (unsigned*)(F.ws + WS_CTL) + 3000;
    LAS float* L = (LAS float*)(F.lds + F.wave * 16384);
#define DBG_FLAG(ch, cond) do { if (__any(cond) && lane == 0) atomicAdd(CNT + (ch), 1u); } while (0)
    for (int s = gw; s < 1536; s += NGW) {
        const unsigned r = dbg_rand(1000u + s); const int row = dbg_row(r); const float rs = dbg_rs(F, row, lane); const int kind = s % 6;
        const bool isp = row < PM; const int b = isp ? (row >> 12) : ((row - PM) >> 3), t = isp ? (row & (PT - 1)) : ((row - PM) & 7);
#define DBG_U(col, dst) do { float a_ = 0.f; for (int d_ = lane; d_ < DM; d_ += 64) a_ += dbg_h(F, row, d_, rs) * bfr(FIN(I_WIN)[(size_t)d_ * D_IN + (col)]); dst = wave_sum(a_); } while (0)
        if (kind == 0) {
            const int c = (r >> 3) % 768, j = c >> 7, k = (c >> 6) & 1, dd = c & 63; float u; DBG_U(O_NKV + c, u); bool bad = false;
            if (j < 4) bad = dbg_bad(F.out[(isp ? OUT_ROWS_P + (size_t)row * 512 : OUT_ROWS_S + (size_t)(row - PM) * 512) + c], u, 0.01f, 0.01f);
            else if (isp) { if (t >= PT - WINB) bad = dbg_bad(F.out[OUT_WIN_P + ((size_t)b * WINB + (t - (PT - WINB))) * 256 + (c - 512)], u, 0.01f, 0.01f); }
            else bad = dbg_bad(F.out[OUT_WIN_S + ((size_t)b * WINB + (WINB - ST) + t) * 256 + (c - 512)], u, 0.01f, 0.01f);
            if (isp) { if (j < 2) bad = bad || dbg_bad(bf1(WSP(bf16, WS_ACMP)[((size_t)j * CMP_ROWS_J + 32768 + (b * 2 + k) * 256 + (t >> 4)) * 1024 + (t & 15) * 64 + dd]), u, 0.01f, 0.01f);
                       else bad = bad || dbg_bad(bf1(WSP(bf16, WS_KVB)[((((size_t)(j - 2) * PB + b) * 2 + k) * PT + t) * 64 + dd]), u, 0.01f, 0.01f); }
            else if (j >= 2) bad = bad || dbg_bad(bf1(WSP(bf16, WS_KVS)[((((size_t)(j - 2) * SB + b) * 2 + k) * ST + t) * 64 + dd]), u, 0.01f, 0.01f);
            DBG_FLAG(0, bad);
        } else if (kind == 1) {
            const int gi = (r >> 3) % 24, c5 = (r >> 8) % 512, cm = (r >> 8) % 3072; float u0, u1, u2, u3; DBG_U(O_NG + gi, u0); DBG_U(O_RX + c5, u1); DBG_U(O_RGATE + c5, u2); DBG_U(O_MG + cm, u3);
            bool bad = dbg_bad(WSP(float, WS_NG)[(size_t)row * 24 + gi], 1.0f / (1.0f + expf(-u0)), 0.01f, 0.005f);
            bad = bad || dbg_bad(WSP(float, WS_RX)[(size_t)row * 512 + c5], u1, 0.01f, 0.01f);
            bad = bad || dbg_bad(bf1(WSP(bf16, WS_GG)[(size_t)row * 512 + c5]), gelu_tanh(u2), 0.02f, 0.01f);
            bad = bad || dbg_bad(bf1(WSP(bf16, WS_MGS)[(size_t)row * 3072 + cm]), 1.0f / (1.0f + expf(-u3)), 0.01f, 0.005f);
            DBG_FLAG(1, bad);
        } else if (kind == 2) {
            const int head = (r >> 13) % 4, dim = (r >> 16) % 64, c5 = (r >> 3) % 512; float x1, x2, uv, ug, uq; DBG_U(O_RQ + head * 128 + dim, x1); DBG_U(O_RQ + head * 128 + 64 + dim, x2); DBG_U(O_RV + c5, uv); DBG_U(O_RG + c5, ug); DBG_U(O_NQ + c5, uq);
            const float pos = (float)(isp ? t : PAST + t); const float ang = pos * (float)pow(10000.0, -(double)dim / 64.0); float sn, cs; sincos_acc(ang, sn, cs);
            const bf16* RQ = WSP(bf16, WS_RQ);
            bool bad = dbg_bad(bf1(RQ[(size_t)row * 512 + head * 128 + dim]), x1 * cs - x2 * sn, 0.02f, 0.02f) || dbg_bad(bf1(RQ[(size_t)row * 512 + head * 128 + 64 + dim]), x1 * sn + x2 * cs, 0.02f, 0.02f);
            bad = bad || dbg_bad(bf1(RQ[(size_t)2 * MT * 512 + (size_t)row * 512 + c5]), uv, 0.01f, 0.01f) || dbg_bad(bf1(RQ[(size_t)3 * MT * 512 + (size_t)row * 512 + c5]), ug, 0.01f, 0.01f);
            bad = bad || dbg_bad(bf1(WSP(bf16, WS_QN)[(size_t)row * 512 + c5]), uq * QSCALE, 0.01f, 0.005f);
            DBG_FLAG(2, bad);
        }
#undef DBG_U
    }
    for (int s = gw; s < 128; s += NGW) {
        const unsigned r = dbg_rand(3000u + s); const int j = r & 1; const bool smp = ((r >> 1) & 3) != 0;
        const int grp = smp ? (int)((r >> 3) % 64) : (int)((r >> 3) % 8), nmax = smp ? 511 : 255; int n = (r >> 10) % nmax; if (((r >> 20) & 7) == 0) n = nmax - 1;
        const size_t rj = smp ? (size_t)grp * 512 + n : (size_t)32768 + grp * 256 + n;
        const bf16* A = WSP(bf16, WS_ACMP) + ((size_t)j * CMP_ROWS_J + rj) * 1024;
        const float* w1 = FIN(I_W1) + (size_t)j * 2048 * 128; const float* pe = FIN(I_PE) + j * 2048;
        for (int hh = 0; hh < 2; ++hh) { const int h = lane + 64 * hh; float a = FIN(I_B1)[j * 128 + h];
            for (int i = 0; i < 1024; ++i) a += (bf1(A[i]) + pe[i]) * w1[(size_t)i * 128 + h] + (bf1(A[1024 + i]) + pe[1024 + i]) * w1[(size_t)(1024 + i) * 128 + h];
            L[h] = gelu_tanh(a); }
        LDS_WAIT(); asm volatile("" ::: "memory");
        float o = 0.f; for (int h = 0; h < 128; ++h) o += L[h] * FIN(I_W2)[((size_t)j * 128 + h) * 64 + lane];
        const float got = bf1(WSP(bf16, WS_CK)[((size_t)j * CMP_ROWS_J + rj) * 64 + lane]);
        { const bool bd = dbg_bad(got, o, 0.05f, 0.03f); const unsigned long long mk = __ballot(bd); if (lane == 0 && mk) atomicAdd(CNT + 3, (unsigned)__popcll(mk)); }
        LDS_WAIT(); asm volatile("" ::: "memory");
    }
    for (int s = gw; s < 128; s += NGW) {
        const unsigned r = dbg_rand(3500u + s); const int j = r & 1; const bool smp = ((r >> 1) & 3) != 0;
        const int grp = smp ? (int)((r >> 3) % 64) : (int)((r >> 3) % 8), nmax = smp ? 511 : 255; const int n = (r >> 10) % nmax;
        const size_t rj = smp ? (size_t)grp * 512 + n : (size_t)32768 + grp * 256 + n, row = (size_t)j * CMP_ROWS_J + rj;
        const bf16* A = WSP(bf16, WS_ACMP) + row * 1024; const float* w1 = FIN(I_W1) + (size_t)j * 2048 * 128; const bf16* LH = WSP(bf16, WS_LH);
        unsigned nb = 0;
        for (int hh = 0; hh < 2; ++hh) { const int h = lane + 64 * hh; float lo = 0.f, hi = 0.f;
            for (int i = 0; i < 1024; ++i) { const float av = bf1(A[i]); lo += av * bfr(w1[(size_t)i * 128 + h]); hi += av * bfr(w1[(size_t)(1024 + i) * 128 + h]); }
            const bool bd = dbg_bad(bf1(LH[row * 256 + h]), lo, 0.02f, 0.02f) || dbg_bad(bf1(LH[row * 256 + 128 + h]), hi, 0.02f, 0.02f); nb += (unsigned)__popcll(__ballot(bd)); }
        if (lane == 0 && nb) atomicAdd(CNT + 9, nb);
        for (int hh = 0; hh < 2; ++hh) { const int h = lane + 64 * hh; L[h] = gelu_tanh(bf1(LH[row * 256 + h]) + bf1(LH[(row + 1) * 256 + 128 + h]) + WSP(float, WS_SMALLW + SW_CB)[j * 128 + h]); }
        LDS_WAIT(); asm volatile("" ::: "memory");
        float o = 0.f; for (int h = 0; h < 128; ++h) o += bfr(L[h]) * bfr(FIN(I_W2)[((size_t)j * 128 + h) * 64 + lane]);
        { const bool bd = dbg_bad(bf1(WSP(bf16, WS_CK)[row * 64 + lane]), o, 0.03f, 0.01f); const unsigned long long mk = __ballot(bd); if (lane == 0 && mk) atomicAdd(CNT + 11, (unsigned)__popcll(mk)); }
        LDS_WAIT(); asm volatile("" ::: "memory");
    }
    for (int s = gw; s < 64; s += NGW) {
        const unsigned r = dbg_rand(3700u + s); const int j = r & 1, half = (r >> 1) & 1, h = (r >> 2) % 128; const bf16* W1T = WSP(bf16, WS_SMALLW + SW_W1T) + ((size_t)j * 256 + half * 128 + h) * 1024;
        const float* w1 = FIN(I_W1) + ((size_t)j * 32 + half * 16) * 64 * 128 + h; unsigned nb = 0;
        for (int k = lane; k < 1024; k += 64) nb += (unsigned)__popcll(__ballot(dbg_bad(bf1(W1T[k]), w1[(size_t)k * 128], 0.01f, 0.0001f)));
        if (lane == 0 && nb) atomicAdd(CNT + 12, nb);
        const bool smp = ((r >> 9) & 3) != 0; const int grp = smp ? (int)((r >> 11) % 64) : (int)((r >> 11) % 8), n = (r >> 17) % (smp ? 511 : 255);
        const size_t row = (size_t)j * CMP_ROWS_J + (smp ? (size_t)grp * 512 + n : (size_t)32768 + grp * 256 + n); const bf16* A = WSP(bf16, WS_ACMP) + row * 1024;
        float a = 0.f; for (int k = lane; k < 1024; k += 64) a += bf1(A[k]) * bf1(W1T[k]); a = wave_sum(a);
        DBG_FLAG(13, dbg_bad(bf1(WSP(bf16, WS_LH)[row * 256 + half * 128 + h]), a, 0.02f, 0.02f));
    }
    for (int s = gw; s < 4; s += NGW) {
        const int j = s >> 1, h = (s & 1) * 64 + lane; const float* w1 = FIN(I_W1) + (size_t)j * 2048 * 128; const float* pe = FIN(I_PE) + j * 2048;
        float a = FIN(I_B1)[j * 128 + h]; for (int i = 0; i < 2048; ++i) a += pe[i] * w1[(size_t)i * 128 + h];
        const unsigned long long mk = __ballot(dbg_bad(WSP(float, WS_SMALLW + SW_CB)[j * 128 + h], a, 0.001f, 0.0005f)); if (lane == 0 && mk) atomicAdd(CNT + 10, (unsigned)__popcll(mk));
    }
    for (int s = gw; s < 96; s += NGW) {
        const unsigned r = dbg_rand(4000u + s); const bool smp = (s % 3) == 2;
        int seq, kvh = (r >> 4) & 1, t, tl = 0; size_t row;
        if (smp) { seq = (r >> 5) % SB; tl = (r >> 10) % ST; t = PAST + tl; row = (size_t)PM + seq * ST + tl; }
        else { seq = (r >> 5) % PB; const unsigned k = (r >> 8) % 8u; t = (k == 0) ? (int)((r >> 12) % 40) : (k == 1) ? PT - 1 - (int)((r >> 12) % 70) : (int)((r >> 12) % PT); row = (size_t)seq * PT + t; }
        const int N = smp ? 511 : 255, NS = smp ? 129 : 64, cur = t >> 6;
        LAS float* Q = L; LAS float* SC = L + 256; LAS float* PSUM = L + 256 + 2048; LAS float* OUT = L + 256 + 2048 + 512;
        for (int i = lane; i < 256; i += 64) Q[i] = bf1(WSP(bf16, WS_QN)[row * 512 + (kvh * 4 + (i >> 6)) * 64 + (i & 63)]);
        for (int i = lane; i < 768; i += 64) OUT[i] = 0.f;
        LDS_WAIT(); asm volatile("" ::: "memory");
        const bf16* CKk = WSP(bf16, WS_CK) + (smp ? (size_t)(seq * 2 + kvh) * 512 : (size_t)32768 + (seq * 2 + kvh) * 256) * 64; const bf16* CKv = CKk + (size_t)CMP_ROWS_J * 64;
        const int nvis = smp ? 511 : ((t >= 31) ? ((t - 31) >> 4) + 1 : 0);
        for (int i = lane; i < 512; i += 64) PSUM[i] = 0.f;
        for (int hr = 0; hr < 4; ++hr) {
            float mx = -INFINITY; for (int n = lane; n < nvis; n += 64) { float a = 0.f; for (int d = 0; d < 64; ++d) a += Q[hr * 64 + d] * bf1(CKk[(size_t)n * 64 + d]); SC[n] = a; mx = fmaxf(mx, a); }
            for (int o = 1; o < 64; o <<= 1) mx = fmaxf(mx, __shfl_xor(mx, o));
            float den = 0.f; for (int n = lane; n < nvis; n += 64) { const float e = exp2f(SC[n] - mx); SC[n] = e; den += e; } den = wave_sum(den);
            LDS_WAIT(); asm volatile("" ::: "memory");
            if (nvis > 0) { float o = 0.f; for (int n = 0; n < nvis; ++n) o += SC[n] * bf1(CKv[(size_t)n * 64 + lane]); OUT[hr * 64 + lane] = o / den;
                for (int n = lane; n < nvis; n += 64) PSUM[n] += SC[n] / den; }
            LDS_WAIT(); asm volatile("" ::: "memory");
        }
        LAS float* IMP = SC; LAS float* SELB = SC + 256;
        for (int sblk = lane; sblk < NS; sblk += 64) { float imp = 0.f; for (int n = 4 * sblk - 1; n <= 4 * sblk + 3; ++n) if (n >= 0 && n < N) imp += PSUM[n];
            const bool forced = sblk == 0 || sblk == cur || sblk == cur - 1, avail = sblk * 64 <= t; IMP[sblk] = avail ? (forced ? 1e4f : imp) : -1e4f; SELB[sblk] = 0.f; }
        LDS_WAIT(); asm volatile("" ::: "memory");
        for (int pick = 0; pick < 16 && pick < NS; ++pick) { float bv = -INFINITY; int bi = 1 << 30;
            for (int sblk = lane; sblk < NS; sblk += 64) { const float v = (SELB[sblk] != 0.f) ? -INFINITY : IMP[sblk]; if (v > bv || (v == bv && sblk < bi)) { bv = v; bi = sblk; } }
            for (int o = 1; o < 64; o <<= 1) { const float ov = __shfl_xor(bv, o); const int oi = __shfl_xor(bi, o); if (ov > bv || (ov == bv && oi < bi)) { bv = ov; bi = oi; } }
            if (lane == 0) SELB[bi] = 1.f; LDS_WAIT(); asm volatile("" ::: "memory"); }
        for (int br = 1; br < 3; ++br) for (int hr = 0; hr < 4; ++hr) {
            float mx = -INFINITY, den = 0.f, o = 0.f;
            const int plo = (br == 1) ? 0 : (t - WINB < 0 ? 0 : t - WINB), phi = t;
            for (int p = plo; p <= phi; ++p) {
                if (br == 1 && SELB[p >> 6] == 0.f) { p |= 63; continue; }
                const float* kf = nullptr; const bf16* kb = nullptr; const float* vf = nullptr; const bf16* vb = nullptr;
                const int jk = (br == 1) ? 2 : 4;
                if (!smp) { kb = WSP(bf16, WS_KVB) + ((((size_t)(jk - 2) * PB + seq) * 2 + kvh) * PT + p) * 64; vb = kb + (size_t)PB * 2 * PT * 64; }
                else if (p >= PAST) { kb = WSP(bf16, WS_KVS) + ((((size_t)(jk - 2) * SB + seq) * 2 + kvh) * ST + (p - PAST)) * 64; vb = kb + (size_t)SB * 2 * ST * 64; }
                else if (br == 1) { const int page = ((const int*)F.a->in[I_PT])[seq * NPG + (p >> 7)]; kf = FIN(I_CACHE) + ((((size_t)page * PAGE + (p & 127)) * 4 + 2) * 2 + kvh) * 64; vf = kf + 128; }
                else { kf = FIN(I_CWIN) + ((((size_t)seq * WINB + (p - (PAST - WINB))) * 2 + 0) * 2 + kvh) * 64; vf = kf + 128; }
                float a = 0.f; for (int d = 0; d < 64; ++d) a += Q[hr * 64 + d] * (kb ? bf1(kb[d]) : bfr(kf[d]));
                const float vv = vb ? bf1(vb[lane]) : bfr(vf[lane]);
                const float mn = fmaxf(mx, a), al = exp2f(mx - mn), e = exp2f(a - mn); den = den * al + e; o = o * al + e * vv; mx = mn;
            }
            OUT[(br * 4 + hr) * 64 + lane] = (den > 0.f) ? o / den : 0.f;
        }
        LDS_WAIT(); asm volatile("" ::: "memory");
        bool bad = false;
        for (int hr = 0; hr < 4; ++hr) { const float* ng = WSP(float, WS_NG) + row * 24 + (kvh * 4 + hr) * 3;
            const float e = ng[0] * OUT[(0 * 4 + hr) * 64 + lane] + ng[1] * OUT[(1 * 4 + hr) * 64 + lane] + ng[2] * OUT[(2 * 4 + hr) * 64 + lane];
            bad = bad || dbg_bad(bf1(WSP(bf16, WS_OA)[row * 512 + (kvh * 4 + hr) * 64 + lane]), e, 0.04f, 0.004f); }
        DBG_FLAG(smp ? 5 : 4, bad);
        LDS_WAIT(); asm volatile("" ::: "memory");
    }
    for (int s = gw; s < 96; s += NGW) {
        const unsigned r = dbg_rand(6000u + s); const bool smp = (s % 3) == 2; const int h = (r >> 3) & 3; const float lg = ret_log_g(h);
        const bf16* RQ = WSP(bf16, WS_RQ); const bf16* RK = RQ + (size_t)MT * 512; const bf16* RV = RQ + (size_t)2 * MT * 512; const bf16* RG = RQ + (size_t)3 * MT * 512;
        int seq, t; size_t row0; if (smp) { seq = (r >> 5) % SB; t = (r >> 10) % ST; row0 = (size_t)PM + seq * ST; } else { seq = (r >> 5) % PB; const unsigned k = (r >> 8) % 4u; t = (k == 0) ? (int)((r >> 12) % 300) : (int)((r >> 12) % PT); row0 = (size_t)seq * PT; }
        float o0 = 0.f, o1 = 0.f;
        for (int d = lane; d < 128; d += 64) L[d] = bf1(RQ[(row0 + t) * 512 + h * 128 + d]);
        LDS_WAIT(); asm volatile("" ::: "memory");
        for (int j = 0; j <= t; ++j) { float a = 0.f; for (int d = 0; d < 128; ++d) a += L[d] * bf1(RK[(row0 + j) * 512 + h * 128 + d]);
            a *= expf((float)(t - j) * lg); o0 += a * bf1(RV[(row0 + j) * 512 + h * 128 + lane]); o1 += a * bf1(RV[(row0 + j) * 512 + h * 128 + 64 + lane]); }
        if (smp) { const float* S0 = FIN(I_SRET) + (((size_t)0 * SB + seq) * 4 + h) * 16384; const float cr = expf((float)(t + 1) * lg);
            for (int d = 0; d < 128; ++d) { o0 += L[d] * S0[d * 128 + lane] * cr; o1 += L[d] * S0[d * 128 + 64 + lane] * cr; } }
        const float mean = wave_sum(o0 + o1) * (1.0f / 128.0f); const float var = wave_sum((o0 - mean) * (o0 - mean) + (o1 - mean) * (o1 - mean)) * (1.0f / 128.0f), rstd = 1.0f / sqrtf(var + EPS);
        const float* GN = FIN(I_GNG) + h * 128; const bf16* OR_ = WSP(bf16, WS_OA) + (size_t)MT * 512;
        const float g0 = bf1(RG[(row0 + t) * 512 + h * 128 + lane]), g1 = bf1(RG[(row0 + t) * 512 + h * 128 + 64 + lane]);
        const float e0 = (o0 - mean) * rstd * GN[lane] * (g0 / (1.0f + expf(-g0))), e1 = (o1 - mean) * rstd * GN[64 + lane] * (g1 / (1.0f + expf(-g1)));
        DBG_FLAG(6, dbg_bad(bf1(OR_[(row0 + t) * 512 + h * 128 + lane]), e0, 0.04f, 0.02f) || dbg_bad(bf1(OR_[(row0 + t) * 512 + h * 128 + 64 + lane]), e1, 0.04f, 0.02f));
        const int d = (r >> 20) % 128, T = smp ? ST : PT; float s0 = 0.f, s1 = 0.f;
        for (int j = 0; j < T; ++j) { const float kk = bf1(RK[(row0 + j) * 512 + h * 128 + d]) * expf((float)(T - 1 - j) * lg); s0 += kk * bf1(RV[(row0 + j) * 512 + h * 128 + lane]); s1 += kk * bf1(RV[(row0 + j) * 512 + h * 128 + 64 + lane]); }
        const float* SO;
        if (smp) { const float* S0 = FIN(I_SRET) + (((size_t)0 * SB + seq) * 4 + h) * 16384; const float g8 = expf(8.0f * lg); s0 += g8 * S0[d * 128 + lane]; s1 += g8 * S0[d * 128 + 64 + lane]; SO = F.out + OUT_RET_S + (((size_t)0 * SB + seq) * 4 + h) * 16384; }
        else SO = F.out + OUT_RET_P + (((size_t)0 * PB + seq) * 4 + h) * 16384;
        DBG_FLAG(7, dbg_bad(SO[d * 128 + lane], s0, 0.02f, 0.02f) || dbg_bad(SO[d * 128 + 64 + lane], s1, 0.02f, 0.02f));
        LDS_WAIT(); asm volatile("" ::: "memory");
    }
    for (int s = gw; s < 48; s += NGW) {
        const unsigned r = dbg_rand(8000u + s); const bool smp = (s % 3) == 2; const int blk = (r >> 3) & 7, c = blk * 64 + lane;
        int seq, T; size_t row0; if (smp) { seq = (r >> 6) % SB; T = ST; row0 = (size_t)PM + seq * ST; } else { seq = (r >> 6) % PB; T = 1 + (int)((r >> 10) % ((s & 1) ? 200 : PT)); row0 = (size_t)seq * PT; }
        const float* RX = WSP(float, WS_RX); const float* cw = FIN(I_RCW); const float cb = FIN(I_RCB)[c];
        float x3 = 0.f, x2 = 0.f, x1 = 0.f, h = 0.f;
        if (smp) { const float* cv = FIN(I_SCONV) + (size_t)seq * 3 * 512; x3 = cv[c]; x2 = cv[512 + c]; x1 = cv[1024 + c]; h = FIN(I_SH)[(size_t)seq * 512 + c]; }
        const float sp = log1pf(expf(-FIN(I_LAM)[c])); const float* wa = FIN(I_RWA) + (size_t)blk * 4096; const float* wx = FIN(I_RWX) + (size_t)blk * 4096;
        for (int t = 0; t < T; ++t) { const float x0 = RX[(row0 + t) * 512 + c]; const float xc = cb + cw[c] * x3 + cw[512 + c] * x2 + cw[1024 + c] * x1 + cw[1536 + c] * x0; x3 = x2; x2 = x1; x1 = x0;
            L[lane] = xc; LDS_WAIT(); asm volatile("" ::: "memory");
            float ra = FIN(I_RBA)[c], ri = FIN(I_RBX)[c]; for (int i = 0; i < 64; ++i) { ra += L[i] * wa[i * 64 + lane]; ri += L[i] * wx[i * 64 + lane]; }
            LDS_WAIT(); asm volatile("" ::: "memory");
            const float rr = 1.0f / (1.0f + expf(-ra)), ii = 1.0f / (1.0f + expf(-ri)), la = -8.0f * rr * sp, a = expf(la); h = a * h + sqrtf(-expm1f(2.0f * la)) * (ii * xc); }
        const size_t o = (row0 + T - 1) * 512 + c; const float e = h * bf1(WSP(bf16, WS_GG)[o]);
        DBG_FLAG(8, dbg_bad(bf1((WSP(bf16, WS_OA) + (size_t)2 * MT * 512)[o]), e, 0.04f, 0.01f));
    }
    for (int s = gw; s < 512; s += NGW) {
        const unsigned r = dbg_rand(9000u + s); const int row = dbg_row(r), col = (r >> 7) % DM;
        float e = 0.f;
        for (int br = 0; br < 3; ++br) { const bf16* O = WSP(bf16, WS_OA) + (size_t)br * MT * 512 + (size_t)row * 512; const float* W = FIN(br == 0 ? I_WBRA : (br == 1 ? I_WBRB : I_WBRC));
            float a = 0.f; for (int k = lane; k < 512; k += 64) a += bf1(O[k]) * bfr(W[(size_t)k * DM + col]); a = wave_sum(a); e += bf1(WSP(bf16, WS_MGS)[(size_t)row * 3072 + br * 1024 + col]) * a; }
        DBG_FLAG(20, dbg_bad(bf1(WSP(bf16, WS_MRG)[(size_t)row * DM + col]), e, 0.03f, 0.01f));
        const float* mod = WSP(float, WS_MOD) + (size_t)row_bb(row) * 6144;
        { float a = 0.f; for (int k = lane; k < DM; k += 64) a += bf1(WSP(bf16, WS_MRG)[(size_t)row * DM + k]) * bfr(FIN(I_WOUT)[(size_t)k * DM + col]); a = wave_sum(a);
          const float ex = xrow_in(F, 0, row)[col] + mod[2048 + col] * a; DBG_FLAG(21, dbg_bad(WSP(float, WS_X1)[(size_t)row * DM + col], ex, 0.005f, 0.005f)); }
        { const float* xr = WSP(float, WS_X1) + (size_t)row * DM; float ss = 0.f; for (int d = lane; d < DM; d += 64) ss += xr[d] * xr[d]; const float rs = 1.0f / sqrtf(wave_sum(ss) * (1.0f / DM) + EPS);
          const int c2 = (r >> 9) % NUP; float a = 0.f; for (int d = lane; d < DM; d += 64) a += bfr(xr[d] * rs * FIN(I_N2G)[d] * (1.0f + mod[4096 + d]) + mod[3072 + d]) * bfr(FIN(I_WUP)[(size_t)d * NUP + c2]); a = wave_sum(a);
          const float got = c2 < DFF ? bf1(WSP(bf16, WS_GP)[(size_t)row * DFF + c2]) : bf1((WSP(bf16, WS_GP) + (size_t)MT * DFF)[(size_t)row * DFF + c2 - DFF]); DBG_FLAG(22, dbg_bad(got, a, 0.02f, 0.01f)); }
        { const int c3 = (r >> 11) % DFF; const bf16* GP = WSP(bf16, WS_GP); const bf16* VAL = GP + (size_t)MT * DFF; const float* cw = FIN(I_FCW);
          const bool isp = row < PM; const int t = isp ? (row & (PT - 1)) : ((row - PM) & 7); float xm2, xm1;
          if (t >= 2) { xm2 = bf1(GP[(size_t)(row - 2) * DFF + c3]); xm1 = bf1(GP[(size_t)(row - 1) * DFF + c3]); }
          else if (isp) { xm2 = 0.f; xm1 = (t == 1) ? bf1(GP[(size_t)(row - 1) * DFF + c3]) : 0.f; }
          else { const float* st = FIN(I_SFFN) + ((size_t)((row - PM) >> 3) * 2) * DFF + c3; xm2 = (t == 0) ? st[0] : st[DFF]; xm1 = (t == 0) ? st[DFF] : bf1(GP[(size_t)(row - 1) * DFF + c3]); }
          const float y = FIN(I_FCB)[c3] + cw[c3] * xm2 + cw[DFF + c3] * xm1 + cw[2 * DFF + c3] * bf1(GP[(size_t)row * DFF + c3]); const float ex = (y / (1.0f + expf(-y))) * bf1(VAL[(size_t)row * DFF + c3]);
          DBG_FLAG(23, dbg_bad(bf1((GP + (size_t)2 * MT * DFF)[(size_t)row * DFF + c3]), ex, 0.02f, 0.005f)); }
        { const bf16* ACT = WSP(bf16, WS_GP) + (size_t)2 * MT * DFF + (size_t)row * DFF; float a = 0.f; for (int k = lane; k < DFF; k += 64) a += bf1(ACT[k]) * bfr(FIN(I_WDN)[(size_t)k * DM + col]); a = wave_sum(a);
          const float ex = WSP(float, WS_X1)[(size_t)row * DM + col] + mod[5120 + col] * a; DBG_FLAG(24, dbg_bad(WSP(float, WS_X2)[(size_t)row * DM + col], ex, 0.005f, 0.005f)); }
    }
#undef DBG_FLAG
}
__device__ __forceinline__ void dbg_report_phase(Frame& F) {
    const unsigned* CNT = (const unsigned*)(F.ws + WS_CTL) + 3000;
    const size_t ooff[14] = {OUT_Y, OUT_Y + (size_t)PM * DM, OUT_ROWS_P, OUT_ROWS_S, OUT_WIN_P, OUT_WIN_S, OUT_RET_P, OUT_RET_S, OUT_H_P, OUT_H_S, OUT_CV_P, OUT_CV_S, OUT_FC_P, OUT_FC_S};
    if (F.bid == 0 && F.tid < 14) { const int b = F.tid; const unsigned c = CNT[b]; const int cnt = 1 + (int)(c > 1000u ? 1000u : c);
        for (int i = 0; i < cnt; ++i) ((unsigned*)F.out)[ooff[b] + 7 + 2 * i] = 0xAAAAAAAAu; }
}
#endif

#ifndef DBG_SUB
#define DBG_SUB 0xFFFF
#endif
#ifndef DBG_MAXPH
#define DBG_MAXPH N_PHASES
#endif
#ifndef DBG_REPEAT
#define DBG_REPEAT 0
#endif
#ifndef DBG_MASK
#define DBG_MASK 0xFFFF
#endif
#define IN(k) (lo <= (k) && (k) < hi)
#ifdef DBG_TIME
#define SEAM(k) do { if ((k) + 1 < hi) { if (MK_N_LAUNCHES == 1) xcd_barrier(bar); } if (F.bid == 0 && F.tid == 0) ((unsigned long long*)(F.ws + WS_CTL))[2048 + (k) + 1] = __builtin_amdgcn_s_memrealtime(); } while (0)
#else
#define SEAM(k) do { if ((k) + 1 < hi) { if (MK_N_LAUNCHES == 1) xcd_barrier(bar); } } while (0)
#endif
template <int l> __device__ __forceinline__ void ph_win(Frame& F) { unsigned char* ws = F.ws;
    pg8::Gemm g{(const pg8::bf16_t*)(ws + WS_H), (const pg8::bf16_t*)(ws + WS_WIN) + (size_t)l * NIN * DM, MT, NIN, DM};
    pg8::StaticOrder S; S.init(MT, NIN, F.G, F.bid); EpiWin E{ws, F.out, l};
    pg8::gemm_phase<EpiWin, pg8::StaticOrder, true, true>(F.lds, g, S, E); }
template <int l> __device__ __forceinline__ void ph_mix1(Frame& F) { unsigned char* ws = F.ws;
    if (DBG_SUB & 1) { launder(F);
        pg8::Gemm g{(const pg8::bf16_t*)(ws + WS_ACMP) + (size_t)l * CMP_ROWS * 1024, (const pg8::bf16_t*)(ws + WS_SMALLW + SW_W1T) + (size_t)l * 512 * 1024, CMP_ROWS, 512, 1024};
        CmpOrder S{F.G, F.bid}; EpiLH E{(bf16*)(ws + WS_LH)};
        pg8::gemm_phase<EpiLH, CmpOrder, true, true>(F.lds, g, S, E); }
    {
        unsigned* ctr = (unsigned*)(F.ws + WS_CTL) + 3210 + l; volatile LAS int* QI = (volatile LAS int*)(F.lds + MISC_OFF + 128);
#pragma unroll 1
        for (;;) {
            __syncthreads();
            if (F.tid == 0) QI[0] = (int)__hip_atomic_fetch_add(ctr, 1u, __ATOMIC_RELAXED, __HIP_MEMORY_SCOPE_AGENT);
            __syncthreads();
            const int u = __builtin_amdgcn_readfirstlane(QI[0]);
            if (u >= 768) break;
            launder(F);
            if (u < 256) rglru_unit<0>(F, l, u); else ret_local_unit(F, u - 256);
        }
        __syncthreads();
    } }
template <int l> __device__ __forceinline__ void ph_mix2(Frame& F) { cmp2_phase(F, l); ret_scan_phase(F, l); rglru_carry_phase(F, l); }
#ifndef DBG_REPQ
#define DBG_REPQ 0
#endif
constexpr int MQ_SA = 64, MQ_PA = MQ_SA + 512, MQ_RG1 = MQ_PA + 256, MQ_RO = MQ_RG1 + 512, MQ_RS = MQ_RO + 128, MQ_RG2 = MQ_RS + 32;
template <int l> __device__ __forceinline__ void ph_mix3(Frame& F) {
    unsigned* ctr = (unsigned*)(F.ws + WS_CTL) + 3200 + l;
    volatile LAS int* QI = (volatile LAS int*)(F.lds + MISC_OFF + 128);
#pragma unroll 1
    for (;;) {
        __syncthreads();
        if (F.tid == 0) QI[0] = (int)__hip_atomic_fetch_add(ctr, 1u, __ATOMIC_RELAXED, __HIP_MEMORY_SCOPE_AGENT);
        __syncthreads();
        const int u = __builtin_amdgcn_readfirstlane(QI[0]);
        if (u >= MQ_RG2) break;
        launder(F);
        if (u < MQ_SA) { attn_sample_unit(F, l, u); if (DBG_REPQ & 2) { launder(F); attn_sample_unit(F, l, u); } }
        else if (u < MQ_PA) { const int v = u - MQ_SA; attn_prompt_unit(F, l, (v & 7) * 64 + 63 - (v >> 3)); if (DBG_REPQ & 1) { launder(F); attn_prompt_unit(F, l, (v & 7) * 64 + 63 - (v >> 3)); } }
        else if (u < MQ_RG1) { rglru_unit<1>(F, l, u - MQ_PA); }
        else if (u < MQ_RO) { ret_out_unit(F, l, u - MQ_RG1); }
        else if (u < MQ_RS) { ret_sample_unit(F, l, u - MQ_RO); }
        else { rglru_unit<2>(F, l, u - MQ_RS); }
    }
    __syncthreads(); }
__device__ __forceinline__ f32x16 smp_tile_acc(Frame& F, const bf16* A, const bf16* Wt, int K, int tile) {
    const int q = F.lane & 31, h_ = F.lane >> 5, ks8 = K / 8, kb = F.wave * ks8;
    const bf16* ap = A + (size_t)((tile >> 5) * 32 + q) * K + kb + 8 * h_; const bf16* bp = Wt + (size_t)((tile & 31) * 32 + q) * K + kb + 8 * h_; f32x16 acc = (f32x16){};
#pragma unroll 11
    for (int kk = 0; kk < ks8 / 16; ++kk) acc = mfma32(*(const bf16x8*)(ap + 16 * kk), *(const bf16x8*)(bp + 16 * kk), acc);
    return acc;
}
__device__ __forceinline__ void smp_tile_put(Frame& F, const f32x16& acc, int slot) { LAS float* R = (LAS float*)(F.lds + slot * 32768) + F.wave * 1024 + F.lane;
#pragma unroll
    for (int r = 0; r < 16; ++r) R[r * 64] = acc[r]; }
__device__ __forceinline__ float smp_tile_get(Frame& F, int slot, int o) { const LAS float* R = (const LAS float*)(F.lds + slot * 32768) + o; float s = 0.f;
#pragma unroll
    for (int w = 0; w < 8; ++w) s += R[w * 1024];
    return s; }
template <int l> __device__ __forceinline__ void ph_br(Frame& F) { unsigned char* ws = F.ws;
    const pg8::bf16_t* wbr = (const pg8::bf16_t*)(ws + WS_WBR) + (size_t)l * 3 * 1024 * 512;
    for (int tile = F.bid; tile < 256; tile += F.G) {
        const f32x16 a0 = smp_tile_acc(F, (const bf16*)(ws + WS_OA) + (size_t)PM * 512, wbr, 512, tile), a1 = smp_tile_acc(F, (const bf16*)(ws + WS_OA) + (size_t)(MT + PM) * 512, wbr + (size_t)1024 * 512, 512, tile),
                     a2 = smp_tile_acc(F, (const bf16*)(ws + WS_OA) + (size_t)(2 * MT + PM) * 512, wbr + (size_t)2 * 1024 * 512, 512, tile);
        __syncthreads(); smp_tile_put(F, a0, 0); smp_tile_put(F, a1, 1); smp_tile_put(F, a2, 2); __syncthreads();
        const bf16* MG = (const bf16*)(ws + WS_MGS); bf16* MR = (bf16*)(ws + WS_MRG);
#pragma unroll
        for (int e = 0; e < 2; ++e) { const int o = F.tid * 2 + e, r = o >> 6, ln = o & 63; const size_t row = (size_t)PM + (tile >> 5) * 32 + (r & 3) + 8 * (r >> 2) + 4 * (ln >> 5); const int col = (tile & 31) * 32 + (ln & 31);
            const bf16* g = MG + row * 3072 + col; MR[row * DM + col] = (bf16)(pk2(bf1(g[0]) * smp_tile_get(F, 0, o) + bf1(g[1024]) * smp_tile_get(F, 1, o) + bf1(g[2048]) * smp_tile_get(F, 2, o), 0.f) & 0xffffu); }
    }
    __syncthreads();
    BrOrder S; S.S.init(PM, DM, F.G, F.bid);
    pg8::Gemm g{(const pg8::bf16_t*)(ws + WS_OA), wbr, 3 * MT, 3 * DM, 512}; EpiBrAll E{ws};
    pg8::gemm_phase<EpiBrAll, BrOrder, true, true>(F.lds, g, S, E); }
__device__ __forceinline__ void smp_res(Frame& F, const bf16* A, const bf16* Wt, int K, const float* xin  , float* xout  , const float* mod, int gofs) {
    for (int tile = F.bid; tile < 256; tile += F.G) {
        const f32x16 a = smp_tile_acc(F, A, Wt, K, tile);
        __syncthreads(); smp_tile_put(F, a, 0); __syncthreads();
#pragma unroll
        for (int e = 0; e < 2; ++e) { const int o = F.tid * 2 + e, r = o >> 6, ln = o & 63; const int rr = (tile >> 5) * 32 + (r & 3) + 8 * (r >> 2) + 4 * (ln >> 5), col = (tile & 31) * 32 + (ln & 31);
            xout[(size_t)rr * DM + col] = xin[(size_t)rr * DM + col] + mod[(size_t)(4 + (rr >> 3)) * 6144 + gofs + col] * smp_tile_get(F, 0, o); }
    }
    __syncthreads();
}
template <int l> __device__ __forceinline__ void ph_out(Frame& F) { unsigned char* ws = F.ws;
    const float* mod = (const float*)(ws + WS_MOD) + (size_t)l * 36 * 6144;
    smp_res(F, (const bf16*)(ws + WS_MRG) + (size_t)PM * DM, (const bf16*)(ws + WS_WOUT) + (size_t)l * DM * DM, DM, l == 0 ? FIN(I_XS) : (const float*)(ws + WS_X2) + (size_t)PM * DM, (float*)(ws + WS_X1) + (size_t)PM * DM, mod, 2048);
    pg8::Gemm g{(const pg8::bf16_t*)(ws + WS_MRG), (const pg8::bf16_t*)(ws + WS_WOUT) + (size_t)l * DM * DM, PM, DM, DM};
    pg8::StaticOrder S; S.init(PM, DM, F.G, F.bid);
    EpiRes E{l == 0 ? FIN(I_XP) : (const float*)(ws + WS_X2), nullptr, (float*)(ws + WS_X1), mod, 2048};
    pg8::gemm_phase<EpiRes, pg8::StaticOrder, true, true>(F.lds, g, S, E); }
template <int l> __device__ __forceinline__ void ph_down(Frame& F) { unsigned char* ws = F.ws;
    const float* mod = (const float*)(ws + WS_MOD) + (size_t)l * 36 * 6144;
    smp_res(F, (const bf16*)(ws + WS_GP) + (size_t)2 * MT * DFF + (size_t)PM * DFF, (const bf16*)(ws + WS_WDN) + (size_t)l * DM * DFF, DFF, (const float*)(ws + WS_X1) + (size_t)PM * DM, (float*)(ws + WS_X2) + (size_t)PM * DM, mod, 5120);
    pg8::Gemm g{(const pg8::bf16_t*)(ws + WS_GP) + (size_t)2 * MT * DFF, (const pg8::bf16_t*)(ws + WS_WDN) + (size_t)l * DM * DFF, PM, DM, DFF};
    pg8::StaticOrder S; S.init(PM, DM, F.G, F.bid);
    EpiRes E{(const float*)(ws + WS_X1), nullptr, (float*)(ws + WS_X2), mod, 5120};
    pg8::gemm_phase<EpiRes, pg8::StaticOrder, true, true>(F.lds, g, S, E); }
template <int l> __device__ __forceinline__ void ph_up(Frame& F) { unsigned char* ws = F.ws;
    pg8::Gemm g{(const pg8::bf16_t*)(ws + WS_H), (const pg8::bf16_t*)(ws + WS_WUP) + (size_t)l * NUP * DM, MT, NUP, DM};
    pg8::StaticOrder S; S.init(MT, NUP, F.G, F.bid); EpiUp E{ws, F.out, l};
    pg8::gemm_phase<EpiUp, pg8::StaticOrder, true, true>(F.lds, g, S, E); }
#define RUNPH(bit, ph, CALL) do { if (((DBG_MASK >> (bit)) & 1) && IN(ph)) { launder(F); CALL; if ((DBG_REPEAT >> (bit)) & 1) { launder(F); CALL; } SEAM(ph); } } while (0)
template <int l> __device__ __forceinline__ void layer_phases(Frame& F, const XcdBarrier& bar, int lo, int hi) {
    constexpr int pb = PH_L0 + l * PH_PER_LAYER;
    RUNPH(1, pb + LP_N1, norm_phase(F, l, 0));
    RUNPH(2, pb + LP_WIN, ph_win<l>(F));
    RUNPH(3, pb + LP_MIX1, ph_mix1<l>(F));
    RUNPH(4, pb + LP_MIX2, ph_mix2<l>(F));
    RUNPH(5, pb + LP_MIX3, ph_mix3<l>(F));
    RUNPH(6, pb + LP_BR, ph_br<l>(F));
    RUNPH(7, pb + LP_OUT, ph_out<l>(F));
    RUNPH(8, pb + LP_N2, norm_phase(F, l, 1));
    RUNPH(9, pb + LP_UP, ph_up<l>(F));
    RUNPH(10, pb + LP_CONV, convact_phase(F, l));
    RUNPH(11, pb + LP_DOWN, ph_down<l>(F));
}
__global__ void __launch_bounds__(NTHR, 2) trunk_fwd(Args args) {
    extern __shared__ __attribute__((aligned(16))) unsigned char lds_raw[];
    Frame F;
    F.lds = (LAS unsigned char*)lds_raw;
    F.tid = threadIdx.x; F.lane = F.tid & 63; F.wave = __builtin_amdgcn_readfirstlane(F.tid >> 6);
    F.G = gridDim.x; F.bid = blockIdx.x; F.a = &args; F.ws = args.ws; F.out = args.out;
    volatile LAS unsigned* MISC = (volatile LAS unsigned*)(F.lds + MISC_OFF);
    for (int u = F.tid; u < 64; u += NTHR) MISC[u] = 0u;
    __syncthreads();
    unsigned* barw = (unsigned*)(F.ws + WS_CTL) + CW_BAR;
    XcdBarrier bar; bar.bar = barw; bar.x = 0; bar.st = nullptr;
    if (MK_N_LAUNCHES == 1) bar = xcd_barrier_post(barw, MISC + 8);
    const int lo = args.ph_lo, hi = args.ph_hi;
    unsigned char* ws = F.ws;

#ifdef DBG_TIME
    if (F.bid == 0 && F.tid == 0) ((unsigned long long*)(F.ws + WS_CTL))[2048] = __builtin_amdgcn_s_memrealtime();
#endif
    RUNPH(0, PH_P0, p0_prologue(F));

    layer_phases<0>(F, bar, lo, hi);
    layer_phases<1>(F, bar, lo, hi);
    if (((DBG_MASK >> 12) & 1) && IN(PH_FINAL)) { launder(F); final_phase(F); if ((DBG_REPEAT >> 12) & 1) { launder(F); final_phase(F); } }
#ifdef DBG_TIME
    {
        xcd_barrier(bar);
        if (F.bid == 0 && F.tid < 14) {
            const unsigned long long* ts = (const unsigned long long*)(F.ws + WS_CTL) + 2048; const unsigned long long tend = __builtin_amdgcn_s_memrealtime();
            const size_t ooff[14] = {OUT_Y, OUT_Y + (size_t)PM * DM, OUT_ROWS_P, OUT_ROWS_S, OUT_WIN_P, OUT_WIN_S, OUT_RET_P, OUT_RET_S, OUT_H_P, OUT_H_S, OUT_CV_P, OUT_CV_S, OUT_FC_P, OUT_FC_S};
            const int b = F.tid; unsigned long long d;
            if (b == 0) d = tend - ts[0]; else if (b == 1) d = ts[1] - ts[0]; else if (b == 13) d = tend - ts[PH_FINAL];
            else { const int ph = PH_L0 + DBG_TIME_LAYER * PH_PER_LAYER + (b - 2); d = ts[ph + 1] - ts[ph]; }
            int cnt = (int)(d / 100ull); if (cnt < 1) cnt = 1; if (cnt > 2000 && b != 0) cnt = 2000;
            for (int i = 0; i < cnt; ++i) ((unsigned*)F.out)[ooff[b] + 7 + 2 * i] = 0xAAAAAAAAu;
        }
    }
#endif
#ifdef DBG_COUNT
    {
        xcd_barrier(bar);
        if (F.bid == 0 && F.tid < 3) { const unsigned* CNT = (const unsigned*)(F.ws + WS_CTL) + 3000; const size_t ooff[3] = {OUT_Y, OUT_Y + (size_t)PM * DM, OUT_ROWS_P};
            const int cnt = (int)((unsigned long long)CNT[F.tid] * 10ull / (CNT[3] ? CNT[3] : 1u)); for (int i = 0; i < cnt; ++i) ((unsigned*)F.out)[ooff[F.tid] + 7 + 2 * i] = 0xAAAAAAAAu; }
    }
#endif
#ifdef DBG_CHECK
    if (lo == 100) { launder(F); dbg_check_phase(F); }
    if (lo == 101) { for (size_t i = (size_t)F.bid * NTHR + F.tid; i < OUT_END; i += (size_t)F.G * NTHR) F.out[i] = 0.f; }
    if (lo == 102) { launder(F); dbg_report_phase(F); }
#endif
}

extern "C" void kernel_launch(void* const* d_in, const int* in_sizes, int n_in, void* d_out, int out_size, void* d_ws, size_t ws_size, hipStream_t stream) {
    static int grid = 0;
    if (grid == 0) {
        if (n_in != 37 || (size_t)out_size != OUT_END || ws_size < WS_END) { fprintf(stderr, "kernel_launch: unexpected shapes: n_in %d out %d (want %zu) ws %zu (want %zu)\n", n_in, out_size, (size_t)OUT_END, ws_size, (size_t)WS_END); grid = -1; return; }
        int dev = 0, cus = 0, per_cu = 0;
        if (hipGetDevice(&dev) != hipSuccess || hipDeviceGetAttribute(&cus, hipDeviceAttributeMultiprocessorCount, dev) != hipSuccess) { grid = -1; return; }
        if (hipFuncSetAttribute((const void*)trunk_fwd, hipFuncAttributeMaxDynamicSharedMemorySize, LDS_BYTES) != hipSuccess) { fprintf(stderr, "kernel_launch: hipFuncSetAttribute failed\n"); grid = -1; return; }
        if (hipOccupancyMaxActiveBlocksPerMultiprocessor(&per_cu, (const void*)trunk_fwd, NTHR, LDS_BYTES) != hipSuccess || per_cu < 1) fprintf(stderr, "kernel_launch: occupancy query reports %d\n", per_cu);
        (void)hipGetLastError();
        grid = cus;
    }
    if (grid < 0) return;
    if (hipMemsetAsync((char*)d_ws + WS_CTL, 0, CTL_ZERO_BYTES, stream) != hipSuccess) return;
#ifdef DBG_POISON
    (void)hipMemsetAsync((char*)d_ws + CTL_ZERO_BYTES, 0xAA, WS_END - CTL_ZERO_BYTES, stream);
    (void)hipMemsetAsync(d_out, 0xAA, (size_t)OUT_END * 4, stream);
#endif
    Args a{};
    for (int i = 0; i < 37; ++i) a.in[i] = d_in[i];
    a.out = (float*)d_out; a.ws = (unsigned char*)d_ws;
#if MK_N_LAUNCHES == 1
    a.ph_lo = 0; a.ph_hi = N_PHASES;
    hipLaunchKernelGGL(trunk_fwd, dim3(grid), dim3(NTHR), LDS_BYTES, stream, a);
#else
    for (int p = 0; p < DBG_MAXPH; ++p) { a.ph_lo = p; a.ph_hi = p + 1; hipLaunchKernelGGL(trunk_fwd, dim3(grid), dim3(NTHR), LDS_BYTES, stream, a); }
#ifdef DBG_CHECK
    for (int p = 100; p < 103; ++p) { a.ph_lo = p; a.ph_hi = p + 1; hipLaunchKernelGGL(trunk_fwd, dim3(grid), dim3(NTHR), LDS_BYTES, stream, a); }
#endif
#endif
    (void)in_sizes;
}
```

```cpp
#include <hip/hip_runtime.h>
#include <cstdio>
#include <cstdint>

#ifndef MK_N_LAUNCHES
#define MK_N_LAUNCHES 1
#endif

constexpr int DM = 1024, PB = 4, PT = 4096, PM = PB * PT, SB = 32, ST = 8, SM = SB * ST, MT = PM + SM;
constexpr int DEPTH = 2, PAST = 8192, PAGE = 128, NPG = PAST / PAGE, NPHYS = 2560;
constexpr int D_IN = 7448, NIN = 7680, DFF = 2816, NUP = 2 * DFF;
constexpr int WINB = 512;
constexpr float EPS = 1e-6f;
constexpr float QSCALE = 0.125f * 1.4426950408889634f;

constexpr int O_NQ = 0, O_NKV = 512, O_NG = 1280, O_RQ = 1304, O_RK = 1816, O_RV = 2328, O_RG = 2840, O_RX = 3352, O_RGATE = 3864, O_MG = 4376;

constexpr size_t OUT_Y = 0;
constexpr size_t OUT_ROWS_P = OUT_Y + (size_t)MT * DM;
constexpr size_t OUT_ROWS_S = OUT_ROWS_P + (size_t)DEPTH * PM * 512;
constexpr size_t OUT_WIN_P = OUT_ROWS_S + (size_t)DEPTH * SM * 512;
constexpr size_t OUT_WIN_S = OUT_WIN_P + (size_t)DEPTH * PB * WINB * 256;
constexpr size_t OUT_RET_P = OUT_WIN_S + (size_t)DEPTH * SB * WINB * 256;
constexpr size_t OUT_RET_S = OUT_RET_P + (size_t)DEPTH * PB * 4 * 16384;
constexpr size_t OUT_H_P = OUT_RET_S + (size_t)DEPTH * SB * 4 * 16384;
constexpr size_t OUT_H_S = OUT_H_P + (size_t)DEPTH * PB * 512;
constexpr size_t OUT_CV_P = OUT_H_S + (size_t)DEPTH * SB * 512;
constexpr size_t OUT_CV_S = OUT_CV_P + (size_t)DEPTH * PB * 3 * 512;
constexpr size_t OUT_FC_P = OUT_CV_S + (size_t)DEPTH * SB * 3 * 512;
constexpr size_t OUT_FC_S = OUT_FC_P + (size_t)DEPTH * PB * 2 * DFF;
constexpr size_t OUT_END = OUT_FC_S + (size_t)DEPTH * SB * 2 * DFF;

constexpr size_t MiB = 1u << 20;
constexpr size_t WS_CTL = 0, CTL_ZERO_BYTES = 4 * MiB;
constexpr size_t WS_MOD = 1 * MiB;
constexpr size_t WS_ROT = 4 * MiB;
constexpr size_t WS_SMALLW = 8 * MiB;
constexpr size_t WS_WIN = 16 * MiB;
constexpr size_t WS_WBR = WS_WIN + (size_t)2 * NIN * DM * 2;
constexpr size_t WS_WOUT = WS_WBR + (size_t)2 * 3 * 1024 * 512 * 2;
constexpr size_t WS_WUP = WS_WOUT + (size_t)2 * 1024 * 1024 * 2;
constexpr size_t WS_WDN = WS_WUP + (size_t)2 * NUP * DM * 2;
constexpr size_t WS_WEND = WS_WDN + (size_t)2 * DM * DFF * 2;
constexpr size_t WS_H = 128 * MiB;
constexpr size_t WS_QN = WS_H + (size_t)MT * DM * 2;
constexpr size_t WS_KVB = WS_QN + (size_t)MT * 512 * 2;
constexpr size_t WS_KVS = WS_KVB + (size_t)4 * PB * 2 * PT * 64 * 2;
constexpr size_t WS_RQ = WS_KVS + (size_t)4 * SB * 2 * ST * 64 * 2;
constexpr size_t WS_RX = WS_RQ + (size_t)4 * MT * 512 * 2;
constexpr size_t WS_GG = WS_RX + (size_t)MT * 512 * 4;
constexpr size_t WS_MGS = WS_GG + (size_t)MT * 512 * 2;
constexpr size_t WS_NG = WS_MGS + (size_t)MT * 3072 * 2;
constexpr size_t WS_OA = WS_NG + (size_t)MT * 24 * 4;
constexpr size_t WS_MRG = WS_OA + (size_t)3 * MT * 512 * 2;
constexpr size_t WS_X1 = WS_MRG + (size_t)MT * DM * 2;
constexpr size_t WS_X2 = WS_X1 + (size_t)MT * DM * 4;
constexpr size_t WS_GP = WS_X2 + (size_t)MT * DM * 4;
constexpr size_t WS_ACMP = WS_GP + (size_t)3 * MT * DFF * 2;
constexpr int CMP_ROWS_J = 34816, CMP_ROWS = 2 * CMP_ROWS_J;
constexpr size_t WS_LH = WS_ACMP + (size_t)2 * CMP_ROWS * 1024 * 2 + 4096;
constexpr size_t WS_CK = WS_LH + (size_t)(CMP_ROWS + 16) * 256 * 2;
constexpr size_t WS_LT = WS_CK + (size_t)CMP_ROWS * 64 * 2;
constexpr size_t WS_SPT = WS_LT + (size_t)16 * 32 * 16384 * 4;
constexpr size_t WS_CAR = WS_SPT + (size_t)16 * 32 * 16384 * 2;
constexpr size_t WS_OAG = WS_CAR + (size_t)4 * 64 * 3 * 512 * 4 + MiB;
constexpr size_t WS_END = WS_OAG + (size_t)2048 * 32 * 64 * 4 + MiB;
static_assert(WS_WEND <= WS_H, "weights fit below WS_H");

constexpr size_t SW_W1T = 0;
constexpr size_t SW_W2T = SW_W1T + (size_t)2 * 2 * 256 * 1024 * 2;
constexpr size_t SW_CB = SW_W2T + (size_t)2 * 2 * 64 * 128 * 2;
constexpr size_t SW_WAT = SW_CB + (size_t)2 * 2 * 128 * 4;
constexpr size_t SW_SP = SW_WAT + (size_t)2 * 2 * 8 * 64 * 64 * 2;
constexpr size_t SW_END = SW_SP + 2 * 512 * 4;
static_assert(SW_END <= 8 * MiB, "small weights fit");

constexpr int CW_TMO = 0;
constexpr int CW_BAR = 4096;

constexpr int PH_P0 = 0, PH_L0 = 1, PH_PER_LAYER = 11, PH_FINAL = PH_L0 + DEPTH * PH_PER_LAYER, N_PHASES = PH_FINAL + 1;
enum { LP_N1 = 0, LP_WIN, LP_MIX1, LP_MIX2, LP_MIX3, LP_BR, LP_OUT, LP_N2, LP_UP, LP_CONV, LP_DOWN };

constexpr int RING_BYTES = 131072;
constexpr int MISC_OFF = RING_BYTES;
constexpr int LDS_BYTES = RING_BYTES + 1024;
constexpr int NWAVES = 8, NTHR = 512;

#define GAS __attribute__((address_space(1)))
#define LAS __attribute__((address_space(3)))
typedef unsigned short bf16;
typedef unsigned v4u __attribute__((ext_vector_type(4)));
typedef unsigned v2u __attribute__((ext_vector_type(2)));
typedef float f32x16 __attribute__((ext_vector_type(16)));
typedef short s16x4 __attribute__((ext_vector_type(4)));
namespace pg8 {
#define PG8_LAS __attribute__((address_space(3)))
typedef unsigned short bf16_t;
typedef short bf16x8 __attribute__((ext_vector_type(8)));
typedef float f32x4 __attribute__((ext_vector_type(4)));
typedef unsigned u32x4 __attribute__((ext_vector_type(4)));
constexpr int BM = 256, BK = 64, HALF = 128, HTB = HALF * BK * 2  , STAGE_BYTES = 8 * HTB, NXCD = 8, WGM = 8;

__host__ __device__ __forceinline__ int lds_byte(int r, int c) { const int st = (r >> 4) * 2 + (c >> 5), rr = r & 15, cc = c & 31, ob = rr * 64 + cc * 2; return st * 1024 + (ob ^ (((ob >> 9) & 1) << 5)); }
__host__ __device__ __forceinline__ void stage_rc(int b, int& R, int& C) { const int st = b / 1024, sb = b % 1024, swz = sb ^ (((sb >> 9) & 1) << 5); R = (st >> 1) * 16 + swz / 64; C = (st & 1) * 32 + (swz % 64) / 2; }
__host__ __device__ __forceinline__ int perm32(int rho) { const int n = rho >> 4, i = rho & 15; return 8 * (i >> 2) + 4 * n + (i & 3); }

struct Unit { int pm, pn; };
struct Gemm { const bf16_t* A; const bf16_t* Bt; int M, N, K; };

struct StaticOrder {
    int nM, nN, nwg, G, c;
    __host__ __device__ void init(int M, int N, int G_, int c_) { nM = M / BM; nN = N / BM; nwg = nM * nN; G = G_; c = c_; }
    __host__ __device__ bool next(int i, Unit& u) const {
        const long L = (long)i * G + c; if (L >= nwg) return false;
        int wgid = (int)L; { const int q = nwg / NXCD, r = nwg % NXCD, xcd = wgid % NXCD, off = wgid / NXCD; wgid = (xcd < r ? xcd * (q + 1) : r * (q + 1) + (xcd - r) * q) + off; }
        const int nig = WGM * nN, gid = wgid / nig, fm = gid * WGM, gsz = (nM - fm) < WGM ? (nM - fm) : WGM;
        u.pm = fm + ((wgid % nig) % gsz); u.pn = (wgid % nig) / gsz; return true;
    }
    __device__ __forceinline__ void a_ready(const Unit&) const {}
    __device__ __forceinline__ void done(const Unit&) const {}
};
__device__ __forceinline__ unsigned cvt_pk_bf16(float lo, float hi) { unsigned r; asm volatile("v_cvt_pk_bf16_f32 %0, %1, %2" : "=v"(r) : "v"(lo), "v"(hi)); return r; }
typedef float f32x2 __attribute__((ext_vector_type(2)));
template <class Epi, class Sched, bool ALIGN_EPI = false, bool SP2 = false>
__device__ __forceinline__ void gemm_phase(PG8_LAS unsigned char* lds, const Gemm g, const Sched& S, const Epi& E) {
    const int tid = threadIdx.x, wid = __builtin_amdgcn_readfirstlane(tid >> 6), lane = tid & 63, wr = wid >> 2, wc = wid & 3, fr = lane & 15, fq = lane >> 4;
    const int K = g.K, nt = K / BK;
    unsigned voffA[2], voffB[2];
#pragma unroll
    for (int i = 0; i < 2; ++i) { int R, C; stage_rc(tid * 16 + i * 8192, R, C); const int Rb = Epi::PERM ? ((R & ~31) + perm32(R & 31)) : R;
        voffA[i] = (unsigned)(R * K + C) * 2u; voffB[i] = (unsigned)(Rb * K + C) * 2u; }
    const size_t kstep = (size_t)(BK * 2);
    const size_t hstep = (size_t)HALF * K * 2;
    const size_t tstep = 2 * hstep;
    const unsigned ldsw = (unsigned)wid * 1024u;
    const int aoff = lds_byte(wr * 64 + fr, fq * 8), boff = lds_byte(wc * 32 + fr, fq * 8);
#define PG8_SA(b, h) (((b) * 2 + (h)) * HTB)
#define PG8_SB(b, h) ((4 + (b) * 2 + (h)) * HTB)
#define PG8_STAGE(bufoff, gbase, voff) do { _Pragma("unroll") for (int _i = 0; _i < 2; ++_i) \
        __builtin_amdgcn_global_load_lds((const unsigned*)((const char*)(gbase) + (voff)[_i]), (PG8_LAS unsigned*)(lds + (bufoff) + ldsw + _i * 8192), 16, 0, 0); } while (0)
#define PG8_LDA(dst, b, h) do { _Pragma("unroll") for (int m = 0; m < 4; ++m) _Pragma("unroll") for (int k = 0; k < 2; ++k) dst[m][k] = *(const PG8_LAS bf16x8*)(lds + PG8_SA(b, h) + aoff + m * 2048 + k * 1024); } while (0)
#define PG8_LDB(dst, b, h) do { _Pragma("unroll") for (int n = 0; n < 2; ++n) _Pragma("unroll") for (int k = 0; k < 2; ++k) dst[n][k] = *(const PG8_LAS bf16x8*)(lds + PG8_SB(b, h) + boff + n * 2048 + k * 1024); } while (0)
#define PG8_MMA(ai, bj, At, Bt) do { __builtin_amdgcn_s_setprio(1); _Pragma("unroll") for (int m = 0; m < 4; ++m) _Pragma("unroll") for (int n = 0; n < 2; ++n) _Pragma("unroll") for (int k = 0; k < 2; ++k) \
        acc[ai][bj][m][n] = __builtin_amdgcn_mfma_f32_16x16x32_bf16(Bt[n][k], At[m][k], acc[ai][bj][m][n], 0, 0, 0); __builtin_amdgcn_s_setprio(0); } while (0)
#define PG8_WAIT_V(n) asm volatile("s_waitcnt vmcnt(" #n ")" ::: "memory")
#define PG8_WAIT_L(n) asm volatile("s_waitcnt lgkmcnt(" #n ")" ::: "memory")
#define PG8_BAR __builtin_amdgcn_s_barrier()
#define PG8_SCHED __builtin_amdgcn_sched_barrier(0)
    Unit cur, nxt; int ui = 0;
    if (!S.next(0, cur)) return;
    f32x4 acc[2][2][4][2];
#pragma unroll
    for (int a = 0; a < 2; ++a)
#pragma unroll
        for (int b = 0; b < 2; ++b)
#pragma unroll
            for (int m = 0; m < 4; ++m)
#pragma unroll
                for (int n = 0; n < 2; ++n) acc[a][b][m][n] = (f32x4){0.f, 0.f, 0.f, 0.f};
    bf16x8 At[4][2], B0[2][2], B1[2][2];
    const char* cA = (const char*)g.A + (size_t)cur.pm * tstep; const char* cB = (const char*)g.Bt + (size_t)cur.pn * tstep;
    S.a_ready(cur);
    if constexpr (SP2) {
        PG8_STAGE(PG8_SB(0, 0), cB, voffB); PG8_STAGE(PG8_SB(0, 1), cB + hstep, voffB); PG8_STAGE(PG8_SA(0, 0), cA, voffA); PG8_STAGE(PG8_SA(0, 1), cA + hstep, voffA);
        if (wr == 1) PG8_BAR;
        PG8_WAIT_V(2); PG8_BAR;
        PG8_STAGE(PG8_SB(1, 0), cB + kstep, voffB); PG8_STAGE(PG8_SA(1, 0), cA + kstep, voffA); PG8_STAGE(PG8_SB(1, 1), cB + hstep + kstep, voffB);
        PG8_WAIT_V(6); PG8_BAR;
    } else {
        PG8_STAGE(PG8_SB(0, 0), cB, voffB); PG8_STAGE(PG8_SA(0, 0), cA, voffA); PG8_STAGE(PG8_SB(0, 1), cB + hstep, voffB); PG8_STAGE(PG8_SA(0, 1), cA + hstep, voffA);
        if (wr == 1) PG8_BAR;
        PG8_WAIT_V(4); PG8_BAR;
        PG8_STAGE(PG8_SB(1, 0), cB + kstep, voffB); PG8_STAGE(PG8_SA(1, 0), cA + kstep, voffA); PG8_STAGE(PG8_SB(1, 1), cB + hstep + kstep, voffB);
        PG8_WAIT_V(6); PG8_BAR;
    }
    for (;;) {
        const bool has_next = S.next(ui + 1, nxt);
        const char* nA = has_next ? (const char*)g.A + (size_t)nxt.pm * tstep : cA; const char* nB = has_next ? (const char*)g.Bt + (size_t)nxt.pn * tstep : cB;
        for (int t = 0; t < nt; t += 2) {
            const bool last = (t == nt - 2);
            const char* a1 = cA + (size_t)(t + 1) * kstep;
            const char* a2 = last ? nA : cA + (size_t)(t + 2) * kstep; const char* b2 = last ? nB : cB + (size_t)(t + 2) * kstep;
            const char* a3 = a2 + kstep; const char* b3 = b2 + kstep;
            if (last && has_next) S.a_ready(nxt);
            if constexpr (SP2) {
            PG8_LDB(B0, 0, 0); PG8_LDB(B1, 0, 1); PG8_SCHED; PG8_LDA(At, 0, 0); PG8_STAGE(PG8_SA(1, 1), a1 + hstep, voffA);
            PG8_WAIT_V(8); PG8_WAIT_L(0); PG8_BAR; PG8_MMA(0, 0, At, B0); PG8_MMA(0, 1, At, B1); PG8_BAR; PG8_SCHED;
            PG8_LDA(At, 0, 1); PG8_STAGE(PG8_SB(0, 0), b2, voffB); PG8_STAGE(PG8_SB(0, 1), b2 + hstep, voffB); PG8_STAGE(PG8_SA(0, 0), a2, voffA);
            PG8_WAIT_V(8); PG8_WAIT_L(0); PG8_BAR; PG8_MMA(1, 0, At, B0); PG8_MMA(1, 1, At, B1); PG8_BAR; PG8_SCHED;
            PG8_LDB(B0, 1, 0); PG8_LDB(B1, 1, 1); PG8_SCHED; PG8_LDA(At, 1, 0); PG8_STAGE(PG8_SA(0, 1), a2 + hstep, voffA);
            PG8_WAIT_V(8); PG8_WAIT_L(0); PG8_BAR; PG8_MMA(0, 0, At, B0); PG8_MMA(0, 1, At, B1); PG8_BAR; PG8_SCHED;
            PG8_LDA(At, 1, 1); PG8_STAGE(PG8_SB(1, 0), b3, voffB); PG8_STAGE(PG8_SB(1, 1), b3 + hstep, voffB); PG8_STAGE(PG8_SA(1, 0), a3, voffA);
            PG8_WAIT_V(8); PG8_WAIT_L(0); PG8_BAR; PG8_MMA(1, 0, At, B0); PG8_MMA(1, 1, At, B1); PG8_BAR; PG8_SCHED;
            } else {
            PG8_LDB(B0, 0, 0); PG8_SCHED; PG8_LDA(At, 0, 0); PG8_STAGE(PG8_SA(1, 1), a1 + hstep, voffA);
            PG8_WAIT_L(8); PG8_BAR; PG8_WAIT_L(0); PG8_MMA(0, 0, At, B0); PG8_BAR; PG8_SCHED;
            PG8_LDB(B1, 0, 1); PG8_STAGE(PG8_SB(0, 0), b2, voffB);
            PG8_BAR; PG8_WAIT_L(0); PG8_MMA(0, 1, At, B1); PG8_BAR;
            PG8_LDA(At, 0, 1); PG8_STAGE(PG8_SA(0, 0), a2, voffA);
            PG8_BAR; PG8_WAIT_L(0); PG8_MMA(1, 0, At, B0); PG8_BAR; PG8_SCHED;
            PG8_STAGE(PG8_SB(0, 1), b2 + hstep, voffB);
            PG8_WAIT_V(6); PG8_BAR; PG8_MMA(1, 1, At, B1); PG8_BAR;
            PG8_LDB(B0, 1, 0); PG8_SCHED; PG8_LDA(At, 1, 0); PG8_STAGE(PG8_SA(0, 1), a2 + hstep, voffA);
            PG8_WAIT_L(8); PG8_BAR; PG8_WAIT_L(0); PG8_MMA(0, 0, At, B0); PG8_BAR; PG8_SCHED;
            PG8_LDB(B1, 1, 1); PG8_STAGE(PG8_SB(1, 0), b3, voffB);
            PG8_BAR; PG8_WAIT_L(0); PG8_MMA(0, 1, At, B1); PG8_BAR;
            PG8_LDA(At, 1, 1); PG8_STAGE(PG8_SA(1, 0), a3, voffA);
            PG8_BAR; PG8_WAIT_L(0); PG8_MMA(1, 0, At, B0); PG8_BAR; PG8_SCHED;
            PG8_STAGE(PG8_SB(1, 1), b3 + hstep, voffB);
            PG8_WAIT_V(6); PG8_BAR; PG8_MMA(1, 1, At, B1); PG8_BAR;
            }
        }
        if constexpr (ALIGN_EPI) { if (wr == 0) PG8_BAR; }
        if constexpr (!Epi::AFTER_DRAIN) { E(acc, cur, wr, wc, fr, fq); S.done(cur); }
        if (!has_next) break;
#pragma unroll
        for (int a = 0; a < 2; ++a)
#pragma unroll
            for (int b = 0; b < 2; ++b)
#pragma unroll
                for (int m = 0; m < 4; ++m)
#pragma unroll
                    for (int n = 0; n < 2; ++n) acc[a][b][m][n] = (f32x4){0.f, 0.f, 0.f, 0.f};
        cur = nxt; cA = nA; cB = nB; ++ui;
        if constexpr (ALIGN_EPI) { if (wr == 1) PG8_BAR; }
    }
    PG8_WAIT_V(0);
    if constexpr (!ALIGN_EPI) { if (wr == 0) PG8_BAR; }
    PG8_BAR;
    if constexpr (Epi::AFTER_DRAIN) { E.fused(acc, cur, wr, wc, fr, fq, lds, wid, lane); S.done(cur); }
#undef PG8_SA
#undef PG8_SB
#undef PG8_STAGE
#undef PG8_LDA
#undef PG8_LDB
#undef PG8_MMA
#undef PG8_WAIT_V
#undef PG8_WAIT_L
#undef PG8_BAR
#undef PG8_SCHED
}
}

using pg8::bf16x8; using pg8::f32x4; using pg8::u32x4;
#define LDS_WAIT() asm volatile("s_waitcnt lgkmcnt(0)" ::: "memory")
#define VM_WAIT() asm volatile("s_waitcnt vmcnt(0)" ::: "memory")
typedef float f32x2_t __attribute__((ext_vector_type(2))); typedef __bf16 bf16x2_t __attribute__((ext_vector_type(2)));
__device__ __forceinline__ unsigned pk2(float lo, float hi) { f32x2_t v = {lo, hi}; bf16x2_t b = __builtin_convertvector(v, bf16x2_t); return __builtin_bit_cast(unsigned, b); }
__device__ __forceinline__ float bf_lo(unsigned w) { return __uint_as_float(w << 16); }
__device__ __forceinline__ float bf_hi(unsigned w) { return __uint_as_float(w & 0xffff0000u); }
__device__ __forceinline__ float bf1(bf16 b) { return __uint_as_float(((unsigned)b) << 16); }
__device__ __forceinline__ float fexp2(float x) { return __builtin_amdgcn_exp2f(x); }
__device__ __forceinline__ float fexp(float x) { return __builtin_amdgcn_exp2f(x * 1.4426950408889634f); }
__device__ __forceinline__ float frcp(float x) { return __builtin_amdgcn_rcpf(x); }
__device__ __forceinline__ float sigmoidf_(float x) { return frcp(1.0f + fexp(-x)); }
__device__ __forceinline__ float siluf_(float x) { return x * sigmoidf_(x); }
__device__ __forceinline__ float gelu_tanh(float x) {
    const float u = 0.7978845608028654f * (x + 0.044715f * x * x * x);
    const float e = fexp(2.0f * u);
    const float t = 1.0f - 2.0f * frcp(e + 1.0f);
    return 0.5f * x * (1.0f + t);
}
__device__ __forceinline__ float wave_sum(float v) {
#pragma unroll
    for (int o = 1; o < 64; o <<= 1) v += __shfl_xor(v, o);
    return v;
}
__device__ __forceinline__ v4u pack8(const f32x4 a, const f32x4 b) { v4u w; w.x = pk2(a[0], a[1]); w.y = pk2(a[2], a[3]); w.z = pk2(b[0], b[1]); w.w = pk2(b[2], b[3]); return w; }
__device__ __forceinline__ void unpack8(const v4u w, f32x4& a, f32x4& b) { a = (f32x4){bf_lo(w.x), bf_hi(w.x), bf_lo(w.y), bf_hi(w.y)}; b = (f32x4){bf_lo(w.z), bf_hi(w.z), bf_lo(w.w), bf_hi(w.w)}; }

#define XB_TMO      128
#define XB_XCNT(j)  (256  + 64 * (j))
#define XB_XSUB(j)  (1280 + 64 * (j))
#define XB_XGEN(j)  (2304 + 64 * (j))
#define XB_TOP      3328
#define XB_TOPGEN   3392
#define XCD_BAR_WORDS 3456
#define XB_SPIN_CAP (1u << 18)

__device__ __forceinline__ unsigned xb_ld(unsigned* p)              { return __hip_atomic_load(p, __ATOMIC_RELAXED, __HIP_MEMORY_SCOPE_AGENT); }
__device__ __forceinline__ unsigned xb_add(unsigned* p, unsigned v) { return __hip_atomic_fetch_add(p, v, __ATOMIC_RELAXED, __HIP_MEMORY_SCOPE_AGENT); }
__device__ __forceinline__ unsigned xb_xcc_id() { return (unsigned)__builtin_amdgcn_s_getreg((3 << 11) | 20) & 0xFu; }
#define XB_SPIN(cond, bar) do { unsigned _sp = 0; while (cond) { __builtin_amdgcn_s_sleep(1); \
    if ((++_sp & 255u) == 0u) { if (xb_ld(&(bar)[XB_TMO])) break; if (_sp > XB_SPIN_CAP) { atomicAdd(&(bar)[XB_TMO], 1u); break; } } } } while (0)

struct XcdBarrier {
    unsigned* bar; unsigned x;
    volatile LAS unsigned* st;
};

__device__ __forceinline__ XcdBarrier xcd_barrier_post(unsigned* bar, volatile LAS unsigned* st) {
    XcdBarrier b; b.bar = bar; b.x = xb_xcc_id(); b.st = st;
    if (threadIdx.x == 0) (void)xb_add(&bar[XB_XCNT(b.x)], 1u);
    return b;
}
__device__ __forceinline__ void xcd_barrier_complete(unsigned* bar, unsigned x, unsigned& nloc, unsigned& nx) {
    const unsigned G = gridDim.x * gridDim.y * gridDim.z;
    unsigned sum, cnt, mine, sp = 0u;
    for (;;) {
        sum = 0u; cnt = 0u; mine = 0u;
#pragma unroll
        for (unsigned j = 0; j < 16; ++j) { const unsigned c = xb_ld(&bar[XB_XCNT(j)]); sum += c; cnt += (c > 0u) ? 1u : 0u; mine = (j == x) ? c : mine; }
        if (sum == G) break;
        __builtin_amdgcn_s_sleep(1);
        if ((++sp & 255u) == 0u) { if (xb_ld(&bar[XB_TMO])) break; if (sp > XB_SPIN_CAP) { atomicAdd(&bar[XB_TMO], 1u); break; } }
    }
    nloc = mine > 0u ? mine : 1u; nx = cnt > 0u ? cnt : 1u;
}

__device__ __forceinline__ void xcd_barrier(const XcdBarrier& b) {
    asm volatile("s_waitcnt vmcnt(0)" ::: "memory");
    __syncthreads();
    if (threadIdx.x == 0) {
        unsigned* bar = b.bar;
        __builtin_amdgcn_s_waitcnt(0);
        unsigned nloc = b.st[0], nx = b.st[1];
        if (nloc == 0u) { xcd_barrier_complete(bar, b.x, nloc, nx); b.st[0] = nloc; b.st[1] = nx; }
        const unsigned old = xb_add(&bar[XB_XSUB(b.x)], 1u);
        const unsigned gen = old / nloc;
        if (old + 1u == (gen + 1u) * nloc) {
            __builtin_amdgcn_fence(__ATOMIC_RELEASE, "agent");
            asm volatile("s_waitcnt vmcnt(0)" ::: "memory");
            const unsigned og = xb_add(&bar[XB_TOP], 1u);
            const unsigned tg = og / nx;
            if (og + 1u == (tg + 1u) * nx) xb_add(&bar[XB_TOPGEN], 1u);
            else XB_SPIN(xb_ld(&bar[XB_TOPGEN]) == tg, bar);
            __builtin_amdgcn_fence(__ATOMIC_ACQUIRE, "agent");
            xb_add(&bar[XB_XGEN(b.x)], 1u);
            asm volatile("s_waitcnt vmcnt(0)" ::: "memory");
        } else {
            XB_SPIN(xb_ld(&bar[XB_XGEN(b.x)]) == gen, bar);
            __builtin_amdgcn_fence(__ATOMIC_ACQUIRE, "agent");
            asm volatile("s_waitcnt vmcnt(0)" ::: "memory");
        }
    }
    __syncthreads();
}

struct Args { const void* in[37]; float* out; unsigned char* ws; int ph_lo, ph_hi; };
enum { I_XP = 0, I_XS, I_CACHE, I_CWIN, I_SRET, I_SH, I_SCONV, I_SFFN, I_PT, I_CP, I_CS, I_N1G, I_N2G, I_WADA, I_BADA, I_WIN, I_PE, I_W1, I_B1, I_W2,
       I_GNG, I_RCW, I_RCB, I_RWA, I_RBA, I_RWX, I_RBX, I_LAM, I_WBRA, I_WBRB, I_WBRC, I_WOUT, I_WUP, I_FCW, I_FCB, I_WDN, I_FNG };

struct Frame {
    LAS unsigned char* lds;
    int tid, lane, wave, G, bid;
    const Args* a;
    unsigned char* ws;
    float* out;
};
__device__ __forceinline__ void launder(Frame& F) { asm volatile("" : "+v"(F.tid), "+v"(F.lane)); int w_ = __builtin_amdgcn_readfirstlane(F.wave), b_ = __builtin_amdgcn_readfirstlane(F.bid), g_ = __builtin_amdgcn_readfirstlane(F.G); asm volatile("" : "+s"(w_), "+s"(b_), "+s"(g_)); F.wave = w_; F.bid = b_; F.G = g_; }
#define FIN(i) ((const float*)F.a->in[i])
#define WSP(T, off) ((T*)(F.ws + (off)))

__device__ __forceinline__ int row_bb(int row) { return row < PM ? (row >> 12) : 4 + ((row - PM) >> 3); }
__device__ __forceinline__ int row_pos(int row) { return row < PM ? (row & (PT - 1)) : PT + ((row - PM) & 7); }

__device__ __forceinline__ int win_cmap(int n) {
    if (n < 1280) return n;
    if (n < 2304) { const int c = n - 1280, isk = c >> 9, hc = c & 511, head = hc >> 7, s = hc & 127;
        const int g = s >> 3, w = s & 7, dim = (w < 4) ? (4 * g + w) : (64 + 4 * g + (w - 4)); return (isk ? O_RK : O_RQ) + head * 128 + dim; }
    if (n < 2816) return O_RV + (n - 2304);
    if (n < 3328) return O_RG + (n - 2816);
    if (n < 3840) return O_RX + (n - 3328);
    if (n < 4352) return O_RGATE + (n - 3840);
    if (n < 7424) return O_MG + (n - 4352);
    if (n < 7448) return O_NG + (n - 7424);
    return -1;
}

template <bool MAP> __device__ __forceinline__ void p0_tr_item(const float* W, int ldw, bf16* WT, int ldt, int k0, int n0, LAS float* scr, int lane) {
    const int nd = n0 + (lane & 31); const int sc = MAP ? win_cmap(nd) : nd;
    float tv[32];
#pragma unroll
    for (int i = 0; i < 32; ++i) { const int kk = 2 * i + (lane >> 5); tv[i] = (sc >= 0) ? W[(size_t)(k0 + kk) * ldw + sc] : 0.f; }
#pragma unroll
    for (int i = 0; i < 32; ++i) { const int kk = 2 * i + (lane >> 5); scr[kk * 33 + (lane & 31)] = tv[i]; }
    LDS_WAIT(); asm volatile("" ::: "memory");
    const int c = lane & 7;
#pragma unroll
    for (int j = 0; j < 4; ++j) { const int n = (lane >> 3) + 8 * j; const LAS float* s = scr + (8 * c) * 33 + n;
        v4u o; o.x = pk2(s[0 * 33], s[1 * 33]); o.y = pk2(s[2 * 33], s[3 * 33]); o.z = pk2(s[4 * 33], s[5 * 33]); o.w = pk2(s[6 * 33], s[7 * 33]);
        *(v4u*)(WT + (size_t)(n0 + n) * ldt + k0 + 8 * c) = o; }
    LDS_WAIT(); asm volatile("" ::: "memory");
}
__device__ __forceinline__ void sincos_acc(float ang, float& s, float& c) {
    const double a = (double)ang; const double kq = rint(a * 0.63661977236758134308); const double r = fma(-kq, 1.57079632679489661923, a);
    const double r2 = r * r;
    const double sp = r * (1.0 + r2 * (-1.6666666666666666e-1 + r2 * (8.3333333333333332e-3 + r2 * (-1.9841269841269841e-4 + r2 * (2.7557319223985893e-6 + r2 * (-2.5052108385441720e-8))))));
    const double cp = 1.0 + r2 * (-0.5 + r2 * (4.1666666666666664e-2 + r2 * (-1.3888888888888889e-3 + r2 * (2.4801587301587302e-5 + r2 * (-2.7557319223985888e-7 + r2 * 2.0876756987868099e-9)))));
    const int q = ((int)kq) & 3;
    const double ss = (q == 0) ? sp : (q == 1) ? cp : (q == 2) ? -sp : -cp;
    const double cc = (q == 0) ? cp : (q == 1) ? -sp : (q == 2) ? -cp : sp;
    s = (float)ss; c = (float)cc;
}

__device__ __forceinline__ void p0_prologue(Frame& F) {
    const int gw = F.bid * NWAVES + F.wave, NGW = F.G * NWAVES, lane = F.lane;
    LAS float* scr = (LAS float*)(F.lds + F.wave * 16384);
    {
        constexpr int I_IN = 16 * 240, I_BR = 8 * 32, I_OUT = 16 * 32, I_UP = 16 * 176, I_DN = 44 * 32, I_L = I_IN + 3 * I_BR + I_OUT + I_UP + I_DN;
        for (int it = gw; it < 2 * I_L; it += NGW) {
            const int l = it / I_L; int r = it % I_L;
            if (r < I_IN) { p0_tr_item<true>(FIN(I_WIN) + (size_t)l * DM * D_IN, D_IN, WSP(bf16, WS_WIN) + (size_t)l * NIN * DM, DM, 64 * (r / 240), 32 * (r % 240), scr, lane); continue; } r -= I_IN;
            if (r < 3 * I_BR) { const int w = r / I_BR, q = r % I_BR; const float* src = FIN(w == 0 ? I_WBRA : (w == 1 ? I_WBRB : I_WBRC)) + (size_t)l * 512 * 1024;
                p0_tr_item<false>(src, 1024, WSP(bf16, WS_WBR) + (size_t)(l * 3 + w) * 1024 * 512, 512, 64 * (q / 32), 32 * (q % 32), scr, lane); continue; } r -= 3 * I_BR;
            if (r < I_OUT) { p0_tr_item<false>(FIN(I_WOUT) + (size_t)l * 1024 * 1024, 1024, WSP(bf16, WS_WOUT) + (size_t)l * 1024 * 1024, 1024, 64 * (r / 32), 32 * (r % 32), scr, lane); continue; } r -= I_OUT;
            if (r < I_UP) { p0_tr_item<false>(FIN(I_WUP) + (size_t)l * DM * NUP, NUP, WSP(bf16, WS_WUP) + (size_t)l * NUP * DM, DM, 64 * (r / 176), 32 * (r % 176), scr, lane); continue; } r -= I_UP;
            p0_tr_item<false>(FIN(I_WDN) + (size_t)l * DFF * DM, DM, WSP(bf16, WS_WDN) + (size_t)l * DM * DFF, DFF, 64 * (r / 32), 32 * (r % 32), scr, lane);
        }
    }
    {
        constexpr int NI_W1 = 8 * 16 * 4, NI_W2 = 4 * 2 * 2, NI_RG = 32 * 2;
        for (int it = gw; it < NI_W1 + NI_W2 + NI_RG; it += NGW) {
            int r = it;
            if (r < NI_W1) { const int m = r / 64, q = r % 64, lk = m >> 1, half = m & 1;
                p0_tr_item<false>(FIN(I_W1) + ((size_t)lk * 32 + half * 16) * 64 * 128, 128, WSP(bf16, WS_SMALLW + SW_W1T) + ((size_t)lk * 256 + half * 128) * 1024, 1024, 64 * (q / 4), 32 * (q % 4), scr, lane); continue; } r -= NI_W1;
            if (r < NI_W2) { const int lk = r / 4, q = r % 4;
                p0_tr_item<false>(FIN(I_W2) + (size_t)lk * 128 * 64, 64, WSP(bf16, WS_SMALLW + SW_W2T) + (size_t)lk * 64 * 128, 128, 64 * (q / 2), 32 * (q % 2), scr, lane); continue; } r -= NI_W2;
            { const int m = r / 2, q = r % 2, l = m >> 4, which = (m >> 3) & 1, blk = m & 7;
                p0_tr_item<false>(FIN(which ? I_RWX : I_RWA) + ((size_t)l * 8 + blk) * 4096, 64, WSP(bf16, WS_SMALLW + SW_WAT) + (size_t)m * 4096, 64, 0, 32 * q, scr, lane); }
        }
    }
    for (int it = gw; it < 64; it += NGW) {
        const int lk = it >> 4, h0 = (it & 15) * 8; const float* pe = FIN(I_PE) + (size_t)lk * 2048; const float* w1 = FIN(I_W1) + (size_t)lk * 2048 * 128 + h0;
        f32x4 a0 = (f32x4){0.f, 0.f, 0.f, 0.f}, a1 = a0;
#pragma unroll 8
        for (int i = lane; i < 2048; i += 64) { const float p = pe[i]; a0 += *(const f32x4*)(w1 + (size_t)i * 128) * p; a1 += *(const f32x4*)(w1 + (size_t)i * 128 + 4) * p; }
#pragma unroll
        for (int x = 0; x < 4; ++x) { a0[x] = wave_sum(a0[x]); a1[x] = wave_sum(a1[x]); }
        if (lane == 0) { float* cb = WSP(float, WS_SMALLW + SW_CB) + lk * 128 + h0; const float* b1 = FIN(I_B1) + lk * 128 + h0;
#pragma unroll
            for (int x = 0; x < 4; ++x) { cb[x] = a0[x] + b1[x]; cb[4 + x] = a1[x] + b1[4 + x]; } }
    }
    for (int i = F.bid * NTHR + F.tid; i < 1024; i += F.G * NTHR) { const float lam = FIN(I_LAM)[i]; WSP(float, WS_SMALLW + SW_SP)[i] = log1pf(expf(-lam)); }
    for (int i = F.bid * NTHR + F.tid; i < 4104 * 64; i += F.G * NTHR) {
        const int pi = i >> 6, fi = i & 63; const float pos = (float)(pi < PT ? pi : PAST + (pi - PT));
        const float freq = (float)pow(10000.0, -(double)fi / 64.0); const float ang = pos * freq; float s, c; sincos_acc(ang, s, c);
        WSP(float, WS_ROT)[i] = c; WSP(float, WS_ROT)[4104 * 64 + i] = s;
    }
    {
        LAS float* SC = (LAS float*)(F.lds + 0);
        LAS float* RED = (LAS float*)(F.lds + 36864);
        for (int u = F.bid; u < 2 * 96; u += F.G) {
            const int l = u / 96, cg = u % 96; float acc[36];
#pragma unroll
            for (int b = 0; b < 36; ++b) acc[b] = 0.f;
#pragma unroll 1
            for (int kh = 0; kh < 4; ++kh) {
                __syncthreads();
                for (int i = F.tid; i < 256 * 36; i += NTHR) { const int d = i / 36, bb = i % 36; const float c = (bb < 4) ? FIN(I_CP)[bb * DM + kh * 256 + d] : FIN(I_CS)[(bb - 4) * DM + kh * 256 + d]; SC[i] = siluf_(c); }
                __syncthreads();
                const float* wp = FIN(I_WADA) + ((size_t)l * DM + kh * 256 + F.wave * 32) * 6144 + cg * 64 + lane;
#pragma unroll 1
                for (int d0 = 0; d0 < 32; d0 += 16) {
                    float wv[16];
#pragma unroll
                    for (int k = 0; k < 16; ++k) wv[k] = wp[(size_t)(d0 + k) * 6144];
#pragma unroll
                    for (int k = 0; k < 16; ++k) { const LAS f32x4* sc4 = (const LAS f32x4*)(SC + (F.wave * 32 + d0 + k) * 36);
#pragma unroll
                        for (int g = 0; g < 9; ++g) { const f32x4 s4 = sc4[g]; acc[4 * g + 0] += wv[k] * s4[0]; acc[4 * g + 1] += wv[k] * s4[1]; acc[4 * g + 2] += wv[k] * s4[2]; acc[4 * g + 3] += wv[k] * s4[3]; } }
                }
            }
#pragma unroll
            for (int b = 0; b < 36; ++b) RED[(F.wave * 36 + b) * 64 + lane] = acc[b];
            __syncthreads();
            for (int o = F.tid; o < 36 * 64; o += NTHR) { const int b = o >> 6, col = o & 63; float sm = FIN(I_BADA)[l * 6144 + cg * 64 + col];
#pragma unroll
                for (int w = 0; w < 8; ++w) sm += RED[(w * 36 + b) * 64 + col];
                WSP(float, WS_MOD)[((size_t)l * 36 + b) * 6144 + cg * 64 + col] = sm; }
        }
        __syncthreads();
    }
    for (int it = gw; it < 2 * SB * PAST / 8; it += NGW) {
        const int l = it / (SB * PAST / 8), r = it % (SB * PAST / 8), db = r / (PAST / 8), tt0 = (r % (PAST / 8)) * 8;
        const int page = ((const int*)F.a->in[I_PT])[db * NPG + (tt0 >> 7)];
        const float* src = FIN(I_CACHE) + (((size_t)l * NPHYS + page) * PAGE + (tt0 & 127)) * 512 + lane * 4;
        f32x4 v[8];
#pragma unroll
        for (int k = 0; k < 8; ++k) v[k] = __builtin_nontemporal_load((const f32x4*)(src + (size_t)k * 512));
        const int idx = lane * 4, j = idx >> 7, kk = (idx >> 6) & 1, d = idx & 63;
        bf16* dst = WSP(bf16, WS_ACMP) + ((size_t)(l * 2 + j) * CMP_ROWS_J) * 1024 + ((size_t)(db * 2 + kk) * PAST + tt0) * 64 + d;
#pragma unroll
        for (int k = 0; k < 8; ++k) { v2u o; o.x = pk2(v[k][0], v[k][1]); o.y = pk2(v[k][2], v[k][3]); *(v2u*)(dst + (size_t)k * 64) = o; }
    }
    for (size_t i = (size_t)F.bid * NTHR + F.tid; i < (size_t)2 * SB * 504 * 64; i += (size_t)F.G * NTHR) {
        const size_t seq = i / (504 * 64), r = i % (504 * 64);
        const f32x4 v = *(const f32x4*)(FIN(I_CWIN) + (seq * 512 + 8) * 256 + r * 4);
        *(f32x4*)(F.out + OUT_WIN_S + seq * 512 * 256 + r * 4) = v;
    }
}

__device__ __forceinline__ f32x4 ld4_bf(const bf16* p) { const v2u w = *(const v2u*)p; return (f32x4){bf_lo(w.x), bf_hi(w.x), bf_lo(w.y), bf_hi(w.y)}; }
__device__ __forceinline__ void norm_phase(Frame& F, int l, int which) {
    const int gw = F.bid * NWAVES + F.wave, NGW = F.G * NWAVES, lane = F.lane;
    const float* g = FIN(which ? I_N2G : I_N1G) + l * DM;
    for (int row0 = gw * 2; row0 < MT; row0 += NGW * 2) {
        f32x4 v[2][4]; float ss[2];
#pragma unroll
        for (int rr = 0; rr < 2; ++rr) { const int row = row0 + rr;
            if (which == 0 && l == 0) { const float* xr = row < PM ? FIN(I_XP) + (size_t)row * DM : FIN(I_XS) + (size_t)(row - PM) * DM;
#pragma unroll
                for (int j = 0; j < 4; ++j) v[rr][j] = *(const f32x4*)(xr + lane * 4 + 256 * j); }
            else { const bf16* xr = WSP(bf16, which ? WS_X1 : WS_X2) + (size_t)row * DM;
#pragma unroll
                for (int j = 0; j < 4; ++j) v[rr][j] = ld4_bf(xr + lane * 4 + 256 * j); } }
#pragma unroll
        for (int rr = 0; rr < 2; ++rr) { float a = 0.f;
#pragma unroll
            for (int j = 0; j < 4; ++j) a += (v[rr][j][0] * v[rr][j][0] + v[rr][j][1] * v[rr][j][1]) + (v[rr][j][2] * v[rr][j][2] + v[rr][j][3] * v[rr][j][3]);
            ss[rr] = a; }
#pragma unroll
        for (int o = 1; o < 64; o <<= 1) { ss[0] += __shfl_xor(ss[0], o); ss[1] += __shfl_xor(ss[1], o); }
#pragma unroll
        for (int rr = 0; rr < 2; ++rr) { const int row = row0 + rr; const float rs = 1.0f / sqrtf(ss[rr] * (1.0f / DM) + EPS);
            const float* mod = WSP(float, WS_MOD) + ((size_t)l * 36 + row_bb(row)) * 6144 + (which ? 3072 : 0); bf16* o = WSP(bf16, WS_H) + (size_t)row * DM;
#pragma unroll
            for (int j = 0; j < 4; ++j) { const int c = lane * 4 + 256 * j; const f32x4 gg = *(const f32x4*)(g + c), sh = *(const f32x4*)(mod + c), sc = *(const f32x4*)(mod + 1024 + c);
                const f32x4 y = (v[rr][j] * rs) * gg * (sc + 1.0f) + sh; v2u w; w.x = pk2(y[0], y[1]); w.y = pk2(y[2], y[3]); *(v2u*)(o + c) = w; } }
    }
}
__device__ __forceinline__ void final_phase(Frame& F) {
    const int gw = F.bid * NWAVES + F.wave, NGW = F.G * NWAVES, lane = F.lane;
    const float* g = FIN(I_FNG);
    for (int row = gw; row < MT; row += NGW) {
        const bf16* xr = WSP(bf16, WS_X2) + (size_t)row * DM;
        f32x4 v[4]; float ss = 0.f;
#pragma unroll
        for (int j = 0; j < 4; ++j) { v[j] = ld4_bf(xr + lane * 4 + 256 * j); ss += (v[j][0] * v[j][0] + v[j][1] * v[j][1]) + (v[j][2] * v[j][2] + v[j][3] * v[j][3]); }
        const float rs = 1.0f / sqrtf(wave_sum(ss) * (1.0f / DM) + EPS);
        float* o = F.out + OUT_Y + (size_t)row * DM;
#pragma unroll
        for (int j = 0; j < 4; ++j) { const int c = lane * 4 + 256 * j; *(f32x4*)(o + c) = (v[j] * rs) * *(const f32x4*)(g + c); }
    }
}

#define EPI_LOOP_BEGIN \
    _Pragma("unroll") for (int ai = 0; ai < 2; ++ai) _Pragma("unroll") for (int m = 0; m < 4; ++m) { const int row = u.pm * 256 + ai * 128 + wr * 64 + m * 16 + fr; \
    _Pragma("unroll") for (int bj = 0; bj < 2; ++bj) { const int ct = bj * 128 + wc * 32 + 8 * fq; const f32x4 v0 = acc[ai][bj][m][0], v1 = acc[ai][bj][m][1];
#define EPI_LOOP_END } }

struct EpiWin {
    static constexpr bool PERM = true, AFTER_DRAIN = false;
    unsigned char* ws; float* out; int l;
    __device__ __forceinline__ void operator()(const f32x4 (&acc)[2][2][4][2], const pg8::Unit& u, int wr, int wc, int fr0, int fq0) const {
        int fr = fr0, fq = fq0; asm volatile("" : "+v"(fr), "+v"(fq));
        const int pn = u.pn;
        if (pn < 2) {
            bf16* QN = (bf16*)(ws + WS_QN);
            EPI_LOOP_BEGIN *(v4u*)(QN + (size_t)row * 512 + pn * 256 + ct) = pack8(v0 * QSCALE, v1 * QSCALE); EPI_LOOP_END
        } else if (pn < 5) {
            EPI_LOOP_BEGIN
                const int c = (pn - 2) * 256 + ct, j = c >> 7, k = (c >> 6) & 1, d = c & 63;
                const bool isp = row < PM; const int b = isp ? (row >> 12) : ((row - PM) >> 3), t = isp ? (row & (PT - 1)) : ((row - PM) & 7);
                if (j < 4) { float* o = out + (isp ? OUT_ROWS_P + ((size_t)l * PM + row) * 512 : OUT_ROWS_S + ((size_t)l * SM + (row - PM)) * 512) + c; *(f32x4*)o = v0; *(f32x4*)(o + 4) = v1; }
                else if (isp) { if (t >= PT - WINB) { float* o = out + OUT_WIN_P + (((size_t)l * PB + b) * WINB + (t - (PT - WINB))) * 256 + (c - 512); *(f32x4*)o = v0; *(f32x4*)(o + 4) = v1; } }
                else { float* o = out + OUT_WIN_S + (((size_t)l * SB + b) * WINB + (WINB - ST) + t) * 256 + (c - 512); *(f32x4*)o = v0; *(f32x4*)(o + 4) = v1; }
                const v4u w = pack8(v0, v1);
                if (isp) {
                    if (j < 2) *(v4u*)((bf16*)(ws + WS_ACMP) + ((size_t)(l * 2 + j) * CMP_ROWS_J + 32768 + (b * 2 + k) * 256) * 1024 + (size_t)t * 64 + d) = w;
                    else if (j & 1) {
                        const int tq = t & 31, s2 = tq >> 4, hh = (tq >> 2) & 1, ii = (tq & 3) + 4 * ((tq >> 3) & 1);
                        bf16* vt = (bf16*)(ws + WS_KVB) + (((size_t)(j - 2) * PB + b) * 2 + k) * PT * 64 + (size_t)(t >> 5) * 2048 + ((((d >> 5) * 2 + s2) * 2 + hh) * 32 + (d & 31)) * 8 + ii;
                        vt[0] = (bf16)(w.x & 0xffffu); vt[8] = (bf16)(w.x >> 16); vt[16] = (bf16)(w.y & 0xffffu); vt[24] = (bf16)(w.y >> 16);
                        vt[32] = (bf16)(w.z & 0xffffu); vt[40] = (bf16)(w.z >> 16); vt[48] = (bf16)(w.w & 0xffffu); vt[56] = (bf16)(w.w >> 16); }
                    else *(v4u*)((bf16*)(ws + WS_KVB) + (((size_t)(j - 2) * PB + b) * 2 + k) * PT * 64 + (size_t)(t >> 5) * 2048 + ((d >> 3) * 32 + (t & 31)) * 8) = w;
                } else if (j >= 2) *(v4u*)((bf16*)(ws + WS_KVS) + ((((size_t)(j - 2) * SB + b) * 2 + k) * ST + t) * 64 + d) = w;
            EPI_LOOP_END
        } else if (pn < 9) {
            const float* ROTC = (const float*)(ws + WS_ROT); const float* ROTS = ROTC + 4104 * 64;
            EPI_LOOP_BEGIN
                const int c = (pn - 5) * 256 + ct, isk = c >> 9, hc = c & 511, head = hc >> 7, d0 = ((hc & 127) >> 3) * 4;
                const int pi = row_pos(row); const f32x4 cs = *(const f32x4*)(ROTC + pi * 64 + d0), sn = *(const f32x4*)(ROTS + pi * 64 + d0);
                const float sc = isk ? 0.08838834764831845f : 1.0f;
                const f32x4 o1 = (v0 * cs - v1 * sn) * sc, o2 = (v0 * sn + v1 * cs) * sc;
                bf16* o = (bf16*)(ws + WS_RQ) + (size_t)isk * MT * 512 + (size_t)row * 512 + head * 128 + d0;
                v2u w1; w1.x = pk2(o1[0], o1[1]); w1.y = pk2(o1[2], o1[3]); *(v2u*)o = w1;
                v2u w2; w2.x = pk2(o2[0], o2[1]); w2.y = pk2(o2[2], o2[3]); *(v2u*)(o + 64) = w2;
            EPI_LOOP_END
        } else if (pn < 13) {
            bf16* RV = (bf16*)(ws + WS_RQ) + (size_t)2 * MT * 512;
            EPI_LOOP_BEGIN const int c = (pn - 9) * 256 + ct; *(v4u*)(RV + (size_t)(c >> 9) * MT * 512 + (size_t)row * 512 + (c & 511)) = pack8(v0, v1); EPI_LOOP_END
        } else if (pn < 15) {
            float* RX = (float*)(ws + WS_RX);
            EPI_LOOP_BEGIN
                const int c = (pn - 13) * 256 + ct; float* o = RX + (size_t)row * 512 + c; *(f32x4*)o = v0; *(f32x4*)(o + 4) = v1;
                if (row < PM) { const int t = row & (PT - 1); if (t >= PT - 3) { float* q = out + OUT_CV_P + (((size_t)l * PB + (row >> 12)) * 3 + (t - (PT - 3))) * 512 + c; *(f32x4*)q = v0; *(f32x4*)(q + 4) = v1; } }
                else { const int i = (row - PM) & 7; if (i >= ST - 3) { float* q = out + OUT_CV_S + (((size_t)l * SB + ((row - PM) >> 3)) * 3 + (i - (ST - 3))) * 512 + c; *(f32x4*)q = v0; *(f32x4*)(q + 4) = v1; } }
            EPI_LOOP_END
        } else if (pn < 17) {
            bf16* GG = (bf16*)(ws + WS_GG);
            EPI_LOOP_BEGIN const int c = (pn - 15) * 256 + ct;
                f32x4 a, b;
#pragma unroll
                for (int i = 0; i < 4; ++i) { a[i] = gelu_tanh(v0[i]); b[i] = gelu_tanh(v1[i]); }
                *(v4u*)(GG + (size_t)row * 512 + c) = pack8(a, b); EPI_LOOP_END
        } else if (pn < 29) {
            bf16* MG = (bf16*)(ws + WS_MGS);
            EPI_LOOP_BEGIN const int c = (pn - 17) * 256 + ct;
                f32x4 a, b;
#pragma unroll
                for (int i = 0; i < 4; ++i) { a[i] = sigmoidf_(v0[i]); b[i] = sigmoidf_(v1[i]); }
                *(v4u*)(MG + (size_t)row * 3072 + c) = pack8(a, b); EPI_LOOP_END
        } else {
            float* NG = (float*)(ws + WS_NG);
            EPI_LOOP_BEGIN if (ct < 24) { f32x4 a, b;
#pragma unroll
                for (int i = 0; i < 4; ++i) { a[i] = sigmoidf_(v0[i]); b[i] = sigmoidf_(v1[i]); }
                float* o = NG + (size_t)row * 24 + ct; *(f32x4*)o = a; *(f32x4*)(o + 4) = b; } EPI_LOOP_END
        }
    }
};

struct EpiLH {
    static constexpr bool PERM = true, AFTER_DRAIN = false;
    bf16* LH;
    __device__ __forceinline__ void operator()(const f32x4 (&acc)[2][2][4][2], const pg8::Unit& u, int wr, int wc, int fr0, int fq0) const {
        int fr = fr0, fq = fq0; asm volatile("" : "+v"(fr), "+v"(fq));
        EPI_LOOP_BEGIN *(v4u*)(LH + (size_t)row * 256 + ct) = pack8(v0, v1); EPI_LOOP_END
    }
};
struct CmpOrder {
    int G, c;
    __device__ bool next(int i, pg8::Unit& u) const { const int L = i * G + c; if (L >= CMP_ROWS / 256) return false; u.pm = L; u.pn = L / (CMP_ROWS_J / 256); return true; }
    __device__ __forceinline__ void a_ready(const pg8::Unit&) const {}
    __device__ __forceinline__ void done(const pg8::Unit&) const {}
};

template <int BR> struct EpiBr {
    static constexpr bool PERM = true, AFTER_DRAIN = false;
    unsigned char* ws;
    __device__ __forceinline__ void operator()(const f32x4 (&acc)[2][2][4][2], const pg8::Unit& u, int wr, int wc, int fr0, int fq0) const {
        int fr = fr0, fq = fq0; asm volatile("" : "+v"(fr), "+v"(fq));
        const bf16* MG = (const bf16*)(ws + WS_MGS); bf16* MR = (bf16*)(ws + WS_MRG);
        EPI_LOOP_BEGIN
            const int col = u.pn * 256 + ct; f32x4 g0, g1; unpack8(*(const v4u*)(MG + (size_t)row * 3072 + BR * 1024 + col), g0, g1);
            f32x4 r0 = v0 * g0, r1 = v1 * g1; bf16* o = MR + (size_t)row * DM + col;
            if (BR > 0) { f32x4 p0, p1; unpack8(*(const v4u*)o, p0, p1); r0 += p0; r1 += p1; }
            *(v4u*)o = pack8(r0, r1);
        EPI_LOOP_END
    }
};

struct BrOrder {
    pg8::StaticOrder S;
    __device__ bool next(int i, pg8::Unit& u) const { pg8::Unit t; if (!S.next(i / 3, t)) return false; const int br = i % 3; u.pm = br * (MT / 256) + t.pm; u.pn = br * 4 + t.pn; return true; }
    __device__ __forceinline__ void a_ready(const pg8::Unit&) const {}
    __device__ __forceinline__ void done(const pg8::Unit&) const {}
};
struct EpiBrAll {
    static constexpr bool PERM = true, AFTER_DRAIN = false;
    unsigned char* ws;
    __device__ __forceinline__ void operator()(const f32x4 (&acc)[2][2][4][2], const pg8::Unit& u0, int wr, int wc, int fr0, int fq0) const {
        int fr = fr0, fq = fq0; asm volatile("" : "+v"(fr), "+v"(fq));
        const int br = u0.pn >> 2; const pg8::Unit u{u0.pm - br * (MT / 256), u0.pn & 3};
        const bf16* MG = (const bf16*)(ws + WS_MGS) + br * 1024; bf16* MR = (bf16*)(ws + WS_MRG);
        if (br == 0) {
            EPI_LOOP_BEGIN const int col = u.pn * 256 + ct; f32x4 g0, g1; unpack8(*(const v4u*)(MG + (size_t)row * 3072 + col), g0, g1); *(v4u*)(MR + (size_t)row * DM + col) = pack8(v0 * g0, v1 * g1); EPI_LOOP_END
        } else {
            EPI_LOOP_BEGIN const int col = u.pn * 256 + ct; f32x4 g0, g1, p0, p1; unpack8(*(const v4u*)(MG + (size_t)row * 3072 + col), g0, g1); bf16* o = MR + (size_t)row * DM + col; unpack8(*(const v4u*)o, p0, p1);
                *(v4u*)o = pack8(v0 * g0 + p0, v1 * g1 + p1); EPI_LOOP_END
        }
    }
};

template <bool INF32> struct EpiRes {
    static constexpr bool PERM = true, AFTER_DRAIN = false;
    const void* xin_p; bf16* xout; const float* mod; int gofs;
    __device__ __forceinline__ void operator()(const f32x4 (&acc)[2][2][4][2], const pg8::Unit& u, int wr, int wc, int fr0, int fq0) const {
        int fr = fr0, fq = fq0; asm volatile("" : "+v"(fr), "+v"(fq));
        EPI_LOOP_BEGIN
            const int col = u.pn * 256 + ct; f32x4 x0, x1;
            if (INF32) { const float* xi = (const float*)xin_p + (size_t)row * DM + col; x0 = *(const f32x4*)xi; x1 = *(const f32x4*)(xi + 4); }
            else unpack8(*(const v4u*)((const bf16*)xin_p + (size_t)row * DM + col), x0, x1);
            const float* g = mod + (size_t)row_bb(row) * 6144 + gofs + col;
            *(v4u*)(xout + (size_t)row * DM + col) = pack8(x0 + *(const f32x4*)g * v0, x1 + *(const f32x4*)(g + 4) * v1);
        EPI_LOOP_END
    }
};

struct EpiUp {
    static constexpr bool PERM = true, AFTER_DRAIN = false;
    unsigned char* ws; float* out; int l;
    __device__ __forceinline__ void operator()(const f32x4 (&acc)[2][2][4][2], const pg8::Unit& u, int wr, int wc, int fr0, int fq0) const {
        int fr = fr0, fq = fq0; asm volatile("" : "+v"(fr), "+v"(fq));
        bf16* GP = (bf16*)(ws + WS_GP); bf16* VAL = GP + (size_t)MT * DFF;
        if (u.pn < 11) {
            EPI_LOOP_BEGIN const int c = u.pn * 256 + ct; *(v4u*)(GP + (size_t)row * DFF + c) = pack8(v0, v1);
                if (row < PM) { const int t = row & (PT - 1); if (t >= PT - 2) { float* q = out + OUT_FC_P + (((size_t)l * PB + (row >> 12)) * 2 + (t - (PT - 2))) * DFF + c; *(f32x4*)q = v0; *(f32x4*)(q + 4) = v1; } }
                else { const int i = (row - PM) & 7; if (i >= ST - 2) { float* q = out + OUT_FC_S + (((size_t)l * SB + ((row - PM) >> 3)) * 2 + (i - (ST - 2))) * DFF + c; *(f32x4*)q = v0; *(f32x4*)(q + 4) = v1; } }
            EPI_LOOP_END
        } else {
            EPI_LOOP_BEGIN const int c = (u.pn - 11) * 256 + ct; *(v4u*)(VAL + (size_t)row * DFF + c) = pack8(v0, v1); EPI_LOOP_END
        }
    }
};

__device__ __forceinline__ f32x16 mfma32(bf16x8 a, bf16x8 b, f32x16 c) { return __builtin_amdgcn_mfma_f32_32x32x16_bf16(a, b, c, 0, 0, 0); }
__device__ __forceinline__ f32x4 mfma16(bf16x8 a, bf16x8 b, f32x4 c) { return __builtin_amdgcn_mfma_f32_16x16x32_bf16(a, b, c, 0, 0, 0); }
__device__ __forceinline__ float ret_log_g(int h) { return log1pf(-exp2f(-5.0f - (float)h)); }
__device__ __forceinline__ bf16x8 tr_frag(const LAS unsigned char* base, int rs_bytes, int rowA, int rowB, int colbase, int lane) {
    const int q = (lane & 15) >> 2, p = lane & 3;
    const LAS unsigned char* pa = base + (rowA + q) * rs_bytes + (colbase + 4 * p) * 2;
    const LAS unsigned char* pb = base + (rowB + q) * rs_bytes + (colbase + 4 * p) * 2;
    const s16x4 a = __builtin_bit_cast(s16x4, __builtin_amdgcn_ds_read_tr16_b64_v4i16((LAS s16x4*)pa));
    const s16x4 b = __builtin_bit_cast(s16x4, __builtin_amdgcn_ds_read_tr16_b64_v4i16((LAS s16x4*)pb));
    return (bf16x8){a[0], a[1], a[2], a[3], b[0], b[1], b[2], b[3]};
}
__device__ __forceinline__ bf16x8 cvt_frag(const f32x16& p, int s2) {
    u32x4 w; w.x = pk2(p[8 * s2 + 0], p[8 * s2 + 1]); w.y = pk2(p[8 * s2 + 2], p[8 * s2 + 3]); w.z = pk2(p[8 * s2 + 4], p[8 * s2 + 5]); w.w = pk2(p[8 * s2 + 6], p[8 * s2 + 7]);
    return __builtin_bit_cast(bf16x8, w);
}

__device__ __forceinline__ void cmp2_phase(Frame& F, int l) {
    const int gw = F.bid * NWAVES + F.wave, NGW = F.G * NWAVES, lane = F.lane, r = lane & 15, g = lane >> 4;
    const bf16* LH = WSP(bf16, WS_LH); bf16* CK = WSP(bf16, WS_CK);
    for (int wu = gw; wu < CMP_ROWS / 16; wu += NGW) {
        const int row0 = wu * 16, j = row0 / CMP_ROWS_J, rj = (row0 % CMP_ROWS_J) + r, row = row0 + r;
        const bool valid = (rj < 32768) ? ((rj & 511) < 511) : (((rj - 32768) & 255) < 255);
        const bf16* W2T = WSP(bf16, WS_SMALLW + SW_W2T) + (size_t)(l * 2 + j) * 64 * 128; const float* CB = WSP(float, WS_SMALLW + SW_CB) + (l * 2 + j) * 128;
        f32x4 acc[4];
#pragma unroll
        for (int ct = 0; ct < 4; ++ct) acc[ct] = (f32x4){0.f, 0.f, 0.f, 0.f};
#pragma unroll
        for (int ks = 0; ks < 4; ++ks) {
            const int h0 = 32 * ks + 8 * g; f32x4 a0, a1, b0, b1;
            unpack8(*(const v4u*)(LH + (size_t)row * 256 + h0), a0, a1); unpack8(*(const v4u*)(LH + (size_t)(row + 1) * 256 + 128 + h0), b0, b1);
            const f32x4 c0 = *(const f32x4*)(CB + h0), c1 = *(const f32x4*)(CB + h0 + 4);
            f32x4 x0 = a0 + b0 + c0, x1 = a1 + b1 + c1;
#pragma unroll
            for (int i = 0; i < 4; ++i) { x0[i] = gelu_tanh(x0[i]); x1[i] = gelu_tanh(x1[i]); }
            const bf16x8 hf = __builtin_bit_cast(bf16x8, pack8(x0, x1));
#pragma unroll
            for (int ct = 0; ct < 4; ++ct) { const bf16x8 wf = *(const bf16x8*)(W2T + (size_t)(16 * ct + r) * 128 + h0); acc[ct] = mfma16(wf, hf, acc[ct]); }
        }
#pragma unroll
        for (int ct = 0; ct < 4; ++ct) { const f32x4 v = valid ? acc[ct] : (f32x4){0.f, 0.f, 0.f, 0.f}; v2u w; w.x = pk2(v[0], v[1]); w.y = pk2(v[2], v[3]);
            *(v2u*)(CK + (size_t)row * 64 + 16 * ct + 4 * g) = w; }
    }
}

constexpr int CG_RS = 144, CG_BUF = 256 * CG_RS, CG_AW = 2 * CG_BUF;
__device__ __forceinline__ void cmp_gemm_unit(Frame& F, int l, int pm) {
    const int tid = F.tid, lane = F.lane, w = F.wave, q = lane & 31, h_ = lane >> 5;
    const int j = pm / 136, r = pm % 136; const bool smp = r < 128;
    const int grp = smp ? (r >> 1) : (r - 128), n0 = (smp ? (r & 1) * 256 : 0) + 32 * w;
    const float* rp[8]; const bf16* ab = nullptr;
    if (smp) { const int db = grp >> 1, k = grp & 1;
#pragma unroll
        for (int i = 0; i < 8; ++i) { const int tt0 = (n0 + 4 * i + (lane >> 4)) * 16; const int page = ((const int*)F.a->in[I_PT])[db * NPG + (tt0 >> 7)];
            rp[i] = FIN(I_CACHE) + (((((size_t)l * NPHYS + page) * PAGE + (tt0 & 127)) * 4 + j) * 2 + k) * 64 + (lane & 15) * 4; } }
    else { ab = WSP(bf16, WS_ACMP) + ((size_t)(l * 2 + j) * CMP_ROWS_J + 32768 + grp * 256 + n0 + q) * 1024 + 8 * h_;
#pragma unroll
        for (int i = 0; i < 8; ++i) rp[i] = nullptr; }
    const bf16* Bg = WSP(bf16, WS_SMALLW + SW_W1T) + (size_t)(l * 2 + j) * 256 * 1024;
    f32x16 acc[8];
#pragma unroll
    for (int ct = 0; ct < 8; ++ct) acc[ct] = (f32x16){};
    const bf16* bsrc = Bg + (size_t)(tid >> 1) * 1024 + (tid & 1) * 32; LAS unsigned char* bdst = F.lds + (tid >> 1) * CG_RS + (tid & 1) * 64;
    LAS unsigned char* Aw = F.lds + CG_AW + w * 32 * CG_RS;
    v4u bst[4]; f32x4 an[8]; v4u anb[4];
    __syncthreads();
#pragma unroll
    for (int x = 0; x < 4; ++x) bst[x] = *(const v4u*)(bsrc + 8 * x);
#pragma unroll
    for (int x = 0; x < 4; ++x) *(LAS v4u*)(bdst + x * 16) = bst[x];
    if (smp) {
#pragma unroll
        for (int i = 0; i < 8; ++i) an[i] = *(const f32x4*)(rp[i]); }
    else {
#pragma unroll
        for (int ks = 0; ks < 4; ++ks) anb[ks] = *(const v4u*)(ab + ks * 16); }
    __syncthreads();
#pragma unroll 1
    for (int kc = 0; kc < 16; ++kc) {
        bf16x8 ac[4];
        if (smp) {
#pragma unroll
            for (int i = 0; i < 8; ++i) { v2u o; o.x = pk2(an[i][0], an[i][1]); o.y = pk2(an[i][2], an[i][3]); *(LAS v2u*)(Aw + (4 * i + (lane >> 4)) * CG_RS + (lane & 15) * 8) = o; }
            LDS_WAIT(); asm volatile("" ::: "memory");
#pragma unroll
            for (int ks = 0; ks < 4; ++ks) ac[ks] = *(const LAS bf16x8*)(Aw + q * CG_RS + ks * 32 + 16 * h_);
        } else {
#pragma unroll
            for (int ks = 0; ks < 4; ++ks) ac[ks] = __builtin_bit_cast(bf16x8, anb[ks]); }
        if (kc + 1 < 16) {
#pragma unroll
            for (int x = 0; x < 4; ++x) bst[x] = *(const v4u*)(bsrc + (kc + 1) * 64 + 8 * x);
            if (smp) {
#pragma unroll
                for (int i = 0; i < 8; ++i) an[i] = *(const f32x4*)(rp[i] + (size_t)(kc + 1) * 512); }
            else {
#pragma unroll
                for (int ks = 0; ks < 4; ++ks) anb[ks] = *(const v4u*)(ab + (kc + 1) * 64 + ks * 16); }
        }
        const LAS unsigned char* bb = F.lds + (kc & 1) * CG_BUF + q * CG_RS + 16 * h_;
#pragma unroll
        for (int ks = 0; ks < 4; ++ks)
#pragma unroll
            for (int ct = 0; ct < 8; ++ct) { const bf16x8 bf = *(const LAS bf16x8*)(bb + ct * 32 * CG_RS + ks * 32); acc[ct] = mfma32(bf, ac[ks], acc[ct]); }
        if (kc + 1 < 16) {
#pragma unroll
            for (int x = 0; x < 4; ++x) *(LAS v4u*)(bdst + ((kc + 1) & 1) * CG_BUF + x * 16) = bst[x]; }
        __syncthreads();
    }
    bf16* LH = WSP(bf16, WS_LH) + ((size_t)pm * 256 + 32 * w + q) * 256;
#pragma unroll
    for (int ct = 0; ct < 8; ++ct)
#pragma unroll
        for (int r4 = 0; r4 < 4; ++r4) { v2u o; o.x = pk2(acc[ct][4 * r4 + 0], acc[ct][4 * r4 + 1]); o.y = pk2(acc[ct][4 * r4 + 2], acc[ct][4 * r4 + 3]); *(v2u*)(LH + ct * 32 + 8 * r4 + 4 * h_) = o; }
}

constexpr int RS_KV = 272;
__device__ __forceinline__ void ret_local_unit(Frame& F, int unit) {
    const int bh = unit >> 5, c = unit & 31, b = bh >> 2, h = bh & 3, lane = F.lane, w = F.wave;
    const float lg = ret_log_g(h);
    LAS unsigned char* KS = F.lds; LAS unsigned char* VS = F.lds + 128 * RS_KV;
    const bf16* RK = WSP(bf16, WS_RQ) + (size_t)MT * 512; const bf16* RV = WSP(bf16, WS_RQ) + (size_t)2 * MT * 512;
    __syncthreads();
#pragma unroll
    for (int i = 0; i < 4; ++i) { const int p = F.tid + NTHR * i, j = p >> 4, ch = p & 15; const size_t go = (size_t)(b * PT + 128 * c + j) * 512 + h * 128 + ch * 8;
        f32x4 k0, k1; unpack8(*(const v4u*)(RK + go), k0, k1); const float kw = fexp((float)(127 - j) * lg);
        *(LAS v4u*)(KS + j * RS_KV + ch * 16) = pack8(k0 * kw, k1 * kw);
        *(LAS v4u*)(VS + j * RS_KV + ch * 16) = *(const v4u*)(RV + go); }
    __syncthreads();
    const int et = w >> 1, dt0 = 2 * (w & 1), h_ = lane >> 5, blk = (lane >> 4) & 1;
    f32x16 acc[2]; acc[0] = (f32x16){}; acc[1] = (f32x16){};
#pragma unroll
    for (int ks = 0; ks < 8; ++ks) {
        const int rA = 16 * ks + 8 * h_;
        const bf16x8 af = tr_frag(VS, RS_KV, rA, rA + 4, 32 * et + 16 * blk, lane);
#pragma unroll
        for (int dd = 0; dd < 2; ++dd) { const bf16x8 bfr = tr_frag(KS, RS_KV, rA, rA + 4, 32 * (dt0 + dd) + 16 * blk, lane); acc[dd] = mfma32(af, bfr, acc[dd]); }
    }
    float* LT = WSP(float, WS_LT) + ((size_t)bh * 32 + c) * 16384;
#pragma unroll
    for (int dd = 0; dd < 2; ++dd)
#pragma unroll
        for (int r = 0; r < 16; ++r) { const int e = 32 * et + (r & 3) + 8 * (r >> 2) + 4 * h_; LT[e * 128 + 32 * (dt0 + dd) + (lane & 31)] = acc[dd][r]; }
}
__device__ __forceinline__ void ret_scan_phase(Frame& F, int l) {
    const float* LT = WSP(float, WS_LT); bf16* SPT = WSP(bf16, WS_SPT);
    for (int idx = F.bid * NTHR + F.tid; idx < 16 * 16384; idx += F.G * NTHR) {
        const int bh = idx >> 14, ed = idx & 16383, e = ed >> 7, d = ed & 127, h = bh & 3; const float g128 = fexp(128.0f * ret_log_g(h));
        float S = 0.f;
        for (int c = 0; c < 32; ++c) { const size_t o = ((size_t)bh * 32 + c) * 16384 + ed; SPT[o] = (bf16)(pk2(S, 0.f) & 0xffffu); S = S * g128 + LT[o]; }
        F.out[OUT_RET_P + ((size_t)l * 16 + bh) * 16384 + d * 128 + e] = S;
    }
}
__device__ __forceinline__ void ret_out_unit(Frame& F, int l, int unit) {
    const int bh = unit >> 5, c = unit & 31, b = bh >> 2, h = bh & 3, lane = F.lane, w = F.wave, tid = F.tid;
    const float lg = ret_log_g(h);
    LAS unsigned char* KS = F.lds; LAS unsigned char* VS = F.lds + 128 * RS_KV; LAS float* OT = (LAS float*)F.lds; LAS float* STAT = (LAS float*)(F.lds + 2 * 128 * RS_KV);
    const bf16* RQ = WSP(bf16, WS_RQ); const bf16* RK = RQ + (size_t)MT * 512; const bf16* RV = RQ + (size_t)2 * MT * 512; const bf16* RG = RQ + (size_t)3 * MT * 512;
    const size_t row0 = (size_t)b * PT + 128 * c;
    __syncthreads();
#pragma unroll
    for (int i = 0; i < 4; ++i) { const int p = tid + NTHR * i, j = p >> 4, ch = p & 15; const size_t go = (row0 + j) * 512 + h * 128 + ch * 8;
        *(LAS v4u*)(KS + j * RS_KV + ch * 16) = *(const v4u*)(RK + go); *(LAS v4u*)(VS + j * RS_KV + ch * 16) = *(const v4u*)(RV + go); }
    const int it = w & 3, eh = w >> 2, h_ = lane >> 5, blk = (lane >> 4) & 1, il = 32 * it + (lane & 31);
    bf16x8 qf[8];
#pragma unroll
    for (int ks = 0; ks < 8; ++ks) qf[ks] = *(const bf16x8*)(RQ + (row0 + il) * 512 + h * 128 + 16 * ks + 8 * h_);
    f32x16 acc[2]; acc[0] = (f32x16){}; acc[1] = (f32x16){};
    const bf16* SP = WSP(bf16, WS_SPT) + ((size_t)bh * 32 + c) * 16384;
#pragma unroll
    for (int kb4 = 0; kb4 < 8; kb4 += 4) {
        bf16x8 af[4][2];
#pragma unroll
        for (int ks = 0; ks < 4; ++ks)
#pragma unroll
            for (int e2 = 0; e2 < 2; ++e2) af[ks][e2] = *(const bf16x8*)(SP + (size_t)(32 * (2 * eh + e2) + (lane & 31)) * 128 + 16 * (kb4 + ks) + 8 * h_);
#pragma unroll
        for (int ks = 0; ks < 4; ++ks)
#pragma unroll
            for (int e2 = 0; e2 < 2; ++e2) acc[e2] = mfma32(af[ks][e2], qf[kb4 + ks], acc[e2]);
    }
    { const float cr = fexp((float)(il + 1) * lg); acc[0] *= cr; acc[1] *= cr; }
    __syncthreads();
    for (int jt = 0; jt <= it; ++jt) {
        f32x16 s = (f32x16){};
#pragma unroll
        for (int ks = 0; ks < 8; ++ks) { const bf16x8 kf = *(const LAS bf16x8*)(KS + (32 * jt + (lane & 31)) * RS_KV + (16 * ks + 8 * h_) * 2); s = mfma32(kf, qf[ks], s); }
#pragma unroll
        for (int r = 0; r < 16; ++r) { const int j = 32 * jt + (r & 3) + 8 * (r >> 2) + 4 * h_; const int df = il - j; s[r] = (df >= 0) ? s[r] * fexp((float)df * lg) : 0.f; }
#pragma unroll
        for (int s2 = 0; s2 < 2; ++s2) { const bf16x8 pf = cvt_frag(s, s2); const int rA = 32 * jt + 16 * s2 + 4 * h_;
#pragma unroll
            for (int e2 = 0; e2 < 2; ++e2) { const bf16x8 vf = tr_frag(VS, RS_KV, rA, rA + 8, 32 * (2 * eh + e2) + 16 * blk, lane); acc[e2] = mfma32(vf, pf, acc[e2]); } }
    }
    float s1 = 0.f, s2 = 0.f;
#pragma unroll
    for (int e2 = 0; e2 < 2; ++e2)
#pragma unroll
        for (int r = 0; r < 16; ++r) { const float v = acc[e2][r]; s1 += v; s2 += v * v; }
    s1 += __shfl_xor(s1, 32); s2 += __shfl_xor(s2, 32);
    if (lane < 32) { STAT[(w * 32 + lane) * 2] = s1; STAT[(w * 32 + lane) * 2 + 1] = s2; }
    __syncthreads();
    { const int pw = w ^ 4; s1 += STAT[(pw * 32 + (lane & 31)) * 2]; s2 += STAT[(pw * 32 + (lane & 31)) * 2 + 1]; }
    const float mean = s1 * (1.0f / 128.0f), var = fmaxf(s2 * (1.0f / 128.0f) - mean * mean, 0.f), rstd = 1.0f / sqrtf(var + EPS);
#pragma unroll
    for (int e2 = 0; e2 < 2; ++e2)
#pragma unroll
        for (int r4 = 0; r4 < 4; ++r4) { const int e = 32 * (2 * eh + e2) + 8 * r4 + 4 * h_;
            f32x4 v; v[0] = (acc[e2][4 * r4 + 0] - mean) * rstd; v[1] = (acc[e2][4 * r4 + 1] - mean) * rstd; v[2] = (acc[e2][4 * r4 + 2] - mean) * rstd; v[3] = (acc[e2][4 * r4 + 3] - mean) * rstd;
            *(LAS f32x4*)(OT + il * 132 + e) = v; }
    __syncthreads();
    const float* GN = FIN(I_GNG) + l * 512 + h * 128; bf16* OR_ = WSP(bf16, WS_OA) + (size_t)MT * 512;
#pragma unroll
    for (int k = 0; k < 4; ++k) { const int q = tid + NTHR * k, i = q >> 4, ch = q & 15;
        const f32x4 o0 = *(const LAS f32x4*)(OT + i * 132 + 8 * ch), o1 = *(const LAS f32x4*)(OT + i * 132 + 8 * ch + 4);
        const f32x4 g0 = *(const f32x4*)(GN + 8 * ch), g1 = *(const f32x4*)(GN + 8 * ch + 4); f32x4 r0, r1; unpack8(*(const v4u*)(RG + (row0 + i) * 512 + h * 128 + 8 * ch), r0, r1);
        f32x4 y0, y1;
#pragma unroll
        for (int x = 0; x < 4; ++x) { y0[x] = o0[x] * g0[x] * siluf_(r0[x]); y1[x] = o1[x] * g1[x] * siluf_(r1[x]); }
        *(v4u*)(OR_ + (row0 + i) * 512 + h * 128 + 8 * ch) = pack8(y0, y1); }
}
__device__ __forceinline__ void ret_sample_unit(Frame& F, int l, int unit) {
    const int db = unit >> 2, h = unit & 3, tid = F.tid, e = tid & 127, dp = tid >> 7;
    const float lg = ret_log_g(h);
    LAS float* Q = (LAS float*)F.lds; LAS float* K = Q + 1024; LAS float* V = K + 1024; LAS float* GT = V + 1024; LAS float* CR = GT + 1024;
    LAS float* SC = CR + 4096; LAS float* RED = SC + 64;
    const bf16* RQ = WSP(bf16, WS_RQ); const size_t row0 = (size_t)PM + db * 8;
    __syncthreads();
    for (int i = tid; i < 4096; i += NTHR) { const int which = i >> 10, r = (i >> 7) & 7, d = i & 127; const float v = bf1(RQ[(size_t)which * MT * 512 + (row0 + r) * 512 + h * 128 + d]); Q[which * 1024 + r * 128 + d] = v; }
    __syncthreads();
    const float* S0 = FIN(I_SRET) + (((size_t)l * SB + db) * 4 + h) * 16384; float* SN = F.out + OUT_RET_S + (((size_t)l * SB + db) * 4 + h) * 16384;
    float kwv[8], cr[8];
#pragma unroll
    for (int j = 0; j < 8; ++j) { kwv[j] = V[j * 128 + e] * fexp((float)(7 - j) * lg); cr[j] = 0.f; }
    const float g8 = fexp(8.0f * lg);
    for (int d = dp * 32; d < dp * 32 + 32; ++d) {
        const float s0 = S0[d * 128 + e]; float sn = g8 * s0;
#pragma unroll
        for (int j = 0; j < 8; ++j) { cr[j] += Q[j * 128 + d] * s0; sn += K[j * 128 + d] * kwv[j]; }
        SN[d * 128 + e] = sn;
    }
#pragma unroll
    for (int i = 0; i < 8; ++i) CR[(dp * 8 + i) * 128 + e] = cr[i];
    if (tid < 64) { const int i = tid >> 3, j = tid & 7; float s = 0.f; if (j <= i) { for (int d = 0; d < 128; ++d) s += Q[i * 128 + d] * K[j * 128 + d]; s *= fexp((float)(i - j) * lg); } SC[tid] = s; }
    __syncthreads();
    float o[2];
#pragma unroll
    for (int ii = 0; ii < 2; ++ii) { const int i = 2 * dp + ii; float x = (CR[(0 * 8 + i) * 128 + e] + CR[(1 * 8 + i) * 128 + e] + CR[(2 * 8 + i) * 128 + e] + CR[(3 * 8 + i) * 128 + e]) * fexp((float)(i + 1) * lg);
        for (int j = 0; j <= i; ++j) x += SC[i * 8 + j] * V[j * 128 + e];
        o[ii] = x; }
#pragma unroll
    for (int ii = 0; ii < 2; ++ii) { const float a = wave_sum(o[ii]), q = wave_sum(o[ii] * o[ii]); if (F.lane == 0) { RED[(F.wave * 2 + ii) * 2] = a; RED[(F.wave * 2 + ii) * 2 + 1] = q; } }
    __syncthreads();
    const float* GN = FIN(I_GNG) + l * 512 + h * 128; bf16* OR_ = WSP(bf16, WS_OA) + (size_t)MT * 512;
#pragma unroll
    for (int ii = 0; ii < 2; ++ii) { const int i = 2 * dp + ii, w0 = 2 * dp; const float s1 = RED[(w0 * 2 + ii) * 2] + RED[((w0 + 1) * 2 + ii) * 2], s2 = RED[(w0 * 2 + ii) * 2 + 1] + RED[((w0 + 1) * 2 + ii) * 2 + 1];
        const float mean = s1 * (1.0f / 128.0f), var = fmaxf(s2 * (1.0f / 128.0f) - mean * mean, 0.f), rstd = 1.0f / sqrtf(var + EPS);
        const float y = (o[ii] - mean) * rstd * GN[e] * siluf_(GT[i * 128 + e]);
        OR_[(row0 + i) * 512 + h * 128 + e] = (bf16)(pk2(y, 0.f) & 0xffffu); }
}

template <int MODE> __device__ __forceinline__ void rglru_unit(Frame& F, int l, int unit) {
    const int tid = F.tid, c = tid, lane = F.lane, w = F.wave;
    LAS bf16* XC = (LAS bf16*)F.lds; LAS float* G = (LAS float*)(F.lds + 16384);
    const int seq = (MODE == 2) ? unit : (unit >> 6), tile = (MODE == 2) ? 0 : (unit & 63);
    const size_t row0 = (MODE == 2) ? (size_t)PM + seq * 8 : (size_t)seq * PT + tile * 64;
    const int ntok = (MODE == 2) ? 8 : 64, nsub = (MODE == 2) ? 1 : 4;
    const float* RX = WSP(float, WS_RX);
    const float w0 = FIN(I_RCW)[(l * 4 + 0) * 512 + c], w1 = FIN(I_RCW)[(l * 4 + 1) * 512 + c], w2 = FIN(I_RCW)[(l * 4 + 2) * 512 + c], w3 = FIN(I_RCW)[(l * 4 + 3) * 512 + c], cb = FIN(I_RCB)[l * 512 + c];
    const float ba = FIN(I_RBA)[l * 512 + c], bx = FIN(I_RBX)[l * 512 + c], sp = WSP(float, WS_SMALLW + SW_SP)[l * 512 + c];
    float x3, x2, x1;
    if (MODE == 2) { const float* cv = FIN(I_SCONV) + ((size_t)l * SB + seq) * 3 * 512; x3 = cv[c]; x2 = cv[512 + c]; x1 = cv[1024 + c]; }
    else if (tile == 0) { x3 = 0.f; x2 = 0.f; x1 = 0.f; }
    else { x3 = RX[(row0 - 3) * 512 + c]; x2 = RX[(row0 - 2) * 512 + c]; x1 = RX[(row0 - 1) * 512 + c]; }
    float h = (MODE == 0) ? 0.f : (MODE == 1) ? WSP(float, WS_CAR)[(size_t)4 * 64 * 2 * 512 + ((size_t)seq * 64 + tile) * 512 + c] : FIN(I_SH)[((size_t)l * SB + seq) * 512 + c];
    float aprod = 1.f;
    const int r16 = lane & 15, g4 = lane >> 4;
    bf16x8 wa[4][2], wx[4][2];
    { const bf16* WA = WSP(bf16, WS_SMALLW + SW_WAT) + ((size_t)(l * 2 + 0) * 8 + w) * 4096; const bf16* WX = WSP(bf16, WS_SMALLW + SW_WAT) + ((size_t)(l * 2 + 1) * 8 + w) * 4096;
#pragma unroll
      for (int ct = 0; ct < 4; ++ct)
#pragma unroll
          for (int ks = 0; ks < 2; ++ks) { wa[ct][ks] = *(const bf16x8*)(WA + (16 * ct + r16) * 64 + 32 * ks + 8 * g4); wx[ct][ks] = *(const bf16x8*)(WX + (16 * ct + r16) * 64 + 32 * ks + 8 * g4); } }
    const bf16* GG = WSP(bf16, WS_GG); bf16* OC = WSP(bf16, WS_OA) + (size_t)2 * MT * 512;
    __syncthreads();
    float xn[16]; bf16 gn[16];
#pragma unroll
    for (int tt = 0; tt < 16; ++tt) { xn[tt] = (tt < ntok) ? RX[(row0 + tt) * 512 + c] : 0.f; gn[tt] = (MODE != 0 && tt < ntok) ? GG[(row0 + tt) * 512 + c] : (bf16)0; }
    for (int s = 0; s < nsub; ++s) {
        float xc[16], gg[16];
#pragma unroll
        for (int tt = 0; tt < 16; ++tt) { xc[tt] = xn[tt]; gg[tt] = bf1(gn[tt]); }
        if (s + 1 < nsub) {
#pragma unroll
            for (int tt = 0; tt < 16; ++tt) { const int t = (s + 1) * 16 + tt; xn[tt] = RX[(row0 + t) * 512 + c]; gn[tt] = (MODE != 0) ? GG[(row0 + t) * 512 + c] : (bf16)0; } }
#pragma unroll
        for (int tt = 0; tt < 16; ++tt) { const float x0 = xc[tt];
            xc[tt] = cb + w0 * x3 + w1 * x2 + w2 * x1 + w3 * x0; x3 = x2; x2 = x1; x1 = x0; XC[tt * 512 + c] = (bf16)(pk2(xc[tt], 0.f) & 0xffffu); }
        LDS_WAIT(); asm volatile("" ::: "memory");
        {
            bf16x8 xf[2];
#pragma unroll
            for (int ks = 0; ks < 2; ++ks) xf[ks] = *(const LAS bf16x8*)(XC + r16 * 512 + w * 64 + 32 * ks + 8 * g4);
#pragma unroll
            for (int ct = 0; ct < 4; ++ct) { f32x4 da = (f32x4){0.f, 0.f, 0.f, 0.f}, dx = da;
#pragma unroll
                for (int ks = 0; ks < 2; ++ks) { da = mfma16(wa[ct][ks], xf[ks], da); dx = mfma16(wx[ct][ks], xf[ks], dx); }
                *(LAS f32x4*)(G + r16 * 512 + w * 64 + 16 * ct + 4 * g4) = da; *(LAS f32x4*)(G + 8192 + r16 * 512 + w * 64 + 16 * ct + 4 * g4) = dx; }
        }
        LDS_WAIT(); asm volatile("" ::: "memory");
#pragma unroll
        for (int tt = 0; tt < 16; ++tt) { const int t = s * 16 + tt;
            if (t < ntok) {
                const float r = sigmoidf_(G[tt * 512 + c] + ba), ig = sigmoidf_(G[8192 + tt * 512 + c] + bx);
                const float la = -8.0f * r * sp, a = fexp(la), bt = sqrtf(fmaxf(1.0f - a * a, 0.f)) * (ig * xc[tt]);
                h = a * h + bt; aprod *= a;
                if (MODE != 0) { const size_t o = (row0 + t) * 512 + c; OC[o] = (bf16)(pk2(h * gg[tt], 0.f) & 0xffffu); }
            } }
    }
    if (MODE == 0) { float* CAR = WSP(float, WS_CAR) + ((size_t)seq * 64 + tile) * 1024; CAR[c] = aprod; CAR[512 + c] = h; }
    if (MODE == 2) F.out[OUT_H_S + ((size_t)l * SB + seq) * 512 + c] = h;
}
__device__ __forceinline__ void rglru_carry_phase(Frame& F, int l) {
    const float* CAR = WSP(float, WS_CAR); float* HIN = WSP(float, WS_CAR) + (size_t)4 * 64 * 2 * 512;
    for (int idx = F.bid * NTHR + F.tid; idx < PB * 512; idx += F.G * NTHR) {
        const int b = idx >> 9, c = idx & 511; float h = 0.f;
        for (int t = 0; t < 64; ++t) { HIN[((size_t)b * 64 + t) * 512 + c] = h; const float* cr = CAR + ((size_t)b * 64 + t) * 1024; h = cr[c] * h + cr[512 + c]; }
        F.out[OUT_H_P + ((size_t)l * PB + b) * 512 + c] = h;
    }
}

__device__ __forceinline__ void convact_phase(Frame& F, int l) {
    const bf16* GP = WSP(bf16, WS_GP); const bf16* VAL = GP + (size_t)MT * DFF; bf16* ACT = WSP(bf16, WS_GP) + (size_t)2 * MT * DFF;
    const float* CW = FIN(I_FCW) + (size_t)l * 3 * DFF; const float* CBI = FIN(I_FCB) + (size_t)l * DFF;
    constexpr int NRUN = PM / 16 + SB, NCG = DFF / 8;
    for (int it = F.bid * NTHR + F.tid; it < NRUN * NCG; it += F.G * NTHR) {
        const int run = it / NCG, cg = it % NCG, c = cg * 8;
        const bool isp = run < PM / 16; const size_t row0 = isp ? (size_t)run * 16 : (size_t)PM + (run - PM / 16) * 8; const int nt = isp ? 16 : 8;
        f32x4 p2a, p2b, p1a, p1b;
        if (isp) { if ((run & 255) == 0) { p2a = p2b = p1a = p1b = (f32x4){0.f, 0.f, 0.f, 0.f}; } else { unpack8(*(const v4u*)(GP + (row0 - 2) * DFF + c), p2a, p2b); unpack8(*(const v4u*)(GP + (row0 - 1) * DFF + c), p1a, p1b); } }
        else { const float* st = FIN(I_SFFN) + (((size_t)l * SB + (run - PM / 16)) * 2) * DFF + c; p2a = *(const f32x4*)st; p2b = *(const f32x4*)(st + 4); p1a = *(const f32x4*)(st + DFF); p1b = *(const f32x4*)(st + DFF + 4); }
        const f32x4 w0a = *(const f32x4*)(CW + c), w0b = *(const f32x4*)(CW + c + 4), w1a = *(const f32x4*)(CW + DFF + c), w1b = *(const f32x4*)(CW + DFF + c + 4), w2a = *(const f32x4*)(CW + 2 * DFF + c), w2b = *(const f32x4*)(CW + 2 * DFF + c + 4);
        const f32x4 ba = *(const f32x4*)(CBI + c), bb = *(const f32x4*)(CBI + c + 4);
        for (int t0 = 0; t0 < nt; t0 += 8) {
            v4u gx[8], vx[8];
#pragma unroll
            for (int k = 0; k < 8; ++k) { gx[k] = *(const v4u*)(GP + (row0 + t0 + k) * DFF + c); vx[k] = *(const v4u*)(VAL + (row0 + t0 + k) * DFF + c); }
#pragma unroll
            for (int k = 0; k < 8; ++k) {
                f32x4 xa, xb, va, vb; unpack8(gx[k], xa, xb); unpack8(vx[k], va, vb);
                f32x4 ya = ba + w0a * p2a + w1a * p1a + w2a * xa, yb = bb + w0b * p2b + w1b * p1b + w2b * xb;
#pragma unroll
                for (int i = 0; i < 4; ++i) { ya[i] = siluf_(ya[i]) * va[i]; yb[i] = siluf_(yb[i]) * vb[i]; }
                *(v4u*)(ACT + (row0 + t0 + k) * DFF + c) = pack8(ya, yb);
                p2a = p1a; p2b = p1b; p1a = xa; p1b = xb;
            }
        }
    }
}

constexpr int AT_RS = 144;
constexpr int AT_K0 = 0, AT_V0 = 2 * 64 * AT_RS, AT_PS = 4 * 64 * AT_RS, AT_IMP = AT_PS + 69632, AT_MASK = AT_IMP + 6144, AT_LIST = AT_MASK + 2048, AT_NL = AT_LIST + 1024;
constexpr unsigned AT_MARK = 0xFFFFu;
static_assert(AT_NL + 64 <= RING_BYTES, "attention LDS map");

struct TileRegs { v4u a, b, c, d; int mode; };

template <bool SMP> __device__ __forceinline__ void at_prefetch(const Frame& F, int l, int seq, int kvh, unsigned e, TileRegs& R) {
    const int kind = (int)(e >> 14), ti = (int)(e & 0x3fffu), rr = F.tid >> 3, pc = F.tid & 7;
    R.mode = 0;
    if (kind < 2) {
        const size_t rb = SMP ? (size_t)(seq * 2 + kvh) * 512 : (size_t)32768 + (size_t)(seq * 2 + kvh) * 256;
        const bf16* ck = WSP(bf16, WS_CK) + (rb + ti * 64 + rr) * 64 + pc * 8;
        R.a = *(const v4u*)ck; R.c = *(const v4u*)(ck + (size_t)CMP_ROWS_J * 64);
    } else if (!SMP) {
        const int jb = (kind == 2) ? 0 : 2;
        const bf16* kp = WSP(bf16, WS_KVB) + ((((size_t)jb * PB + seq) * 2 + kvh) * PT + ti * 64 + rr) * 64 + pc * 8;
        R.a = *(const v4u*)kp; R.c = *(const v4u*)(kp + (size_t)PB * 2 * PT * 64);
    } else if (kind == 2) {
        if (ti < 128) {
            const int page = ((const int*)F.a->in[I_PT])[seq * NPG + (ti >> 1)], slot = (ti & 1) * 64 + rr;
            const float* kp = FIN(I_CACHE) + (((((size_t)l * NPHYS + page) * PAGE + slot) * 4 + 2) * 2 + kvh) * 64 + pc * 8;
            R.a = *(const v4u*)kp; R.b = *(const v4u*)(kp + 4); R.c = *(const v4u*)(kp + 128); R.d = *(const v4u*)(kp + 132); R.mode = 1;
        } else if (rr < ST) {
            const bf16* kp = WSP(bf16, WS_KVS) + ((((size_t)0 * SB + seq) * 2 + kvh) * ST + rr) * 64 + pc * 8;
            R.a = *(const v4u*)kp; R.c = *(const v4u*)(kp + (size_t)SB * 2 * ST * 64);
        } else R.mode = 2;
    } else {
        if (ti < 8) {
            const float* kp = FIN(I_CWIN) + (((((size_t)l * SB + seq) * WINB + ti * 64 + rr) * 2 + 0) * 2 + kvh) * 64 + pc * 8;
            R.a = *(const v4u*)kp; R.b = *(const v4u*)(kp + 4); R.c = *(const v4u*)(kp + 128); R.d = *(const v4u*)(kp + 132); R.mode = 1;
        } else if (rr < ST) {
            const bf16* kp = WSP(bf16, WS_KVS) + ((((size_t)2 * SB + seq) * 2 + kvh) * ST + rr) * 64 + pc * 8;
            R.a = *(const v4u*)kp; R.c = *(const v4u*)(kp + (size_t)SB * 2 * ST * 64);
        } else R.mode = 2;
    }
}
__device__ __forceinline__ void at_store(const Frame& F, int buf, const TileRegs& R) {
    const int rr = F.tid >> 3, pc = F.tid & 7; v4u k, v;
    if (R.mode == 0) { k = R.a; v = R.c; }
    else if (R.mode == 1) { k = pack8(__builtin_bit_cast(f32x4, R.a), __builtin_bit_cast(f32x4, R.b)); v = pack8(__builtin_bit_cast(f32x4, R.c), __builtin_bit_cast(f32x4, R.d)); }
    else { k = (v4u){0u, 0u, 0u, 0u}; v = k; }
    *(LAS v4u*)(F.lds + AT_K0 + buf * 64 * AT_RS + rr * AT_RS + pc * 16) = k;
    *(LAS v4u*)(F.lds + AT_V0 + buf * 64 * AT_RS + rr * AT_RS + pc * 16) = v;
}

template <bool SMP> __device__ __forceinline__ void attn_unit(Frame& F, int l, int unit) {
    const int tid = F.tid, lane = F.lane, w = F.wave;
    const int q = lane & 31, h_ = lane >> 5, blk = (lane >> 4) & 1, tl = q >> 2, hr = q & 3;
    int seq, kvh, qt;
    if (SMP) { seq = unit >> 1; kvh = unit & 1; qt = 128; } else { seq = unit >> 7; kvh = (unit >> 6) & 1; qt = unit & 63; }
    const int t0 = SMP ? PAST : qt * 64;
    const int tokl = SMP ? tl : 8 * w + tl, t = t0 + tokl;
    const size_t row = SMP ? (size_t)PM + seq * ST + tl : (size_t)seq * PT + t;
    const int head = kvh * 4 + hr;
    LAS float* PS = (LAS float*)(F.lds + AT_PS); LAS float* IMPw = (LAS float*)(F.lds + AT_IMP) + w * 192;
    LAS unsigned long long* MASKS = (LAS unsigned long long*)(F.lds + AT_MASK); LAS unsigned short* LIST = (LAS unsigned short*)(F.lds + AT_LIST); LAS int* NL = (LAS int*)(F.lds + AT_NL);
    constexpr int PSS = SMP ? 520 : 264;
    LAS float* PSw = SMP ? PS : PS + w * 8 * PSS;
    __syncthreads();
    bf16x8 qf[4];
    { const bf16* qp = WSP(bf16, WS_QN) + row * 512 + head * 64 + 8 * h_;
#pragma unroll
      for (int kk = 0; kk < 4; ++kk) qf[kk] = *(const bf16x8*)(qp + 16 * kk); }
    const float* ngp = WSP(float, WS_NG) + row * 24 + head * 3; const float g0 = ngp[0], g1 = ngp[1], g2 = ngp[2];
    if (!SMP) { for (int i = lane; i < 8 * PSS; i += 64) PSw[i] = 0.f; }
    const int ntc = SMP ? 8 : ((t0 + 32) >> 10) + 1;
    if (tid < 2 * ntc) LIST[tid] = (unsigned short)(((tid >= ntc ? 1u : 0u) << 14) | (unsigned)(tid >= ntc ? tid - ntc : tid));
    if (tid == 0) LIST[2 * ntc] = (unsigned short)AT_MARK;
    int nl = 2 * ntc + 1;
    TileRegs R;
    at_prefetch<SMP>(F, l, seq, kvh, (unsigned)0, R);
    at_store(F, 0, R);
    __syncthreads();
    float m = -INFINITY, lsum = 0.f, invden = 0.f;
    f32x16 O[2]; O[0] = (f32x16){}; O[1] = (f32x16){};
    LAS float* OAw = (LAS float*)(F.lds + AT_PS) + w * (SMP ? 2048 : 8 * PSS) + lane;
    unsigned long long mk0 = 0ull, mk1 = 0ull, wu = ~0ull;
    int cur_kind = -1, idx = 0;
#define AT_FINALIZE(kind) do { \
        if ((kind) == 0) { const float lt = lsum + __shfl_xor(lsum, 32); invden = lt > 0.f ? 1.0f / lt : 0.f; } \
        else if ((kind) == 1) { const float sc = g0 * invden; O[0] *= sc; O[1] *= sc; } \
        else if ((kind) == 2) { const float lt = lsum + __shfl_xor(lsum, 32); const float sc = (lt > 0.f ? 1.0f / lt : 0.f) * g1; \
            _Pragma("unroll") for (int r_ = 0; r_ < 16; ++r_) { OAw[r_ * 64] += O[0][r_] * sc; OAw[(16 + r_) * 64] += O[1][r_] * sc; } } } while (0)
    while (idx < nl) {
        const unsigned e = (unsigned)__builtin_amdgcn_readfirstlane((int)LIST[idx]);
        if (e == AT_MARK) {
            AT_FINALIZE(cur_kind); cur_kind = -1;
            LDS_WAIT(); asm volatile("" ::: "memory");
#pragma unroll 1
            for (int tk = 0; tk < 8; ++tk) {
                const LAS float* pr = PSw + tk * PSS;
                if (!SMP) {
                    const int s = lane; float imp = 0.f;
#pragma unroll
                    for (int n = 4 * s - 1; n <= 4 * s + 3; ++n) if (n >= 0) imp += pr[n];
                    const bool forced = (s == 0) || (s == qt) || (s == qt - 1), avail = s <= qt;
                    const float val = avail ? (forced ? 1e4f : imp) : -1e4f;
                    IMPw[s] = val; LDS_WAIT(); asm volatile("" ::: "memory");
                    int rank = 0;
#pragma unroll 8
                    for (int i = 0; i < 64; ++i) { const float v = IMPw[i]; rank += (v > val || (v == val && i < s)) ? 1 : 0; }
                    const unsigned long long mk = __ballot(rank < 16);
                    if (lane == 0) MASKS[(8 * w + tk) * 4] = mk;
                    LDS_WAIT(); asm volatile("" ::: "memory");
                } else {
                    const int sa = lane, sb = lane + 64; float ia = 0.f, ib = 0.f;
#pragma unroll
                    for (int n = 4 * sa - 1; n <= 4 * sa + 3; ++n) if (n >= 0) ia += pr[n];
#pragma unroll
                    for (int n = 4 * sb - 1; n <= 4 * sb + 3; ++n) ib += pr[n];
                    const bool fa = (sa == 0), fb = (sb == 127);
                    const float va = fa ? 1e4f : ia, vb = fb ? 1e4f : ib;
                    IMPw[sa] = va; IMPw[sb] = vb; LDS_WAIT(); asm volatile("" ::: "memory");
                    int ra = fa ? 0 : 1, rb = fb ? 0 : 1;
#pragma unroll 8
                    for (int i = 0; i < 128; ++i) { const float v = IMPw[i]; ra += (v > va || (v == va && i < sa)) ? 1 : 0; rb += (v > vb || (v == vb && i < sb)) ? 1 : 0; }
                    const unsigned long long ma = __ballot(ra < 16), mb = __ballot(rb < 16);
                    if (lane == 0) { MASKS[tk * 4] = ma; MASKS[tk * 4 + 1] = mb; MASKS[tk * 4 + 2] = 1ull; }
                    LDS_WAIT(); asm volatile("" ::: "memory");
                }
            }
            __syncthreads();
#pragma unroll
            for (int r_ = 0; r_ < 16; ++r_) { OAw[r_ * 64] = O[0][r_]; OAw[(16 + r_) * 64] = O[1][r_]; }
            if (tid == 0) {
                int n = idx + 1;
                if (!SMP) { unsigned long long U = 0ull; for (int i = 0; i < 64; ++i) U |= MASKS[i * 4];
                    for (int s = 0; s <= qt; ++s) if ((U >> s) & 1ull) LIST[n++] = (unsigned short)((2u << 14) | (unsigned)s);
                    for (int s = (qt > 8 ? qt - 8 : 0); s <= qt; ++s) LIST[n++] = (unsigned short)((3u << 14) | (unsigned)s);
                } else { unsigned long long U0 = 0ull, U1 = 0ull; for (int i = 0; i < 8; ++i) { U0 |= MASKS[i * 4]; U1 |= MASKS[i * 4 + 1]; }
                    for (int s = 0; s < 64; ++s) if ((U0 >> s) & 1ull) LIST[n++] = (unsigned short)((2u << 14) | (unsigned)s);
                    for (int s = 0; s < 64; ++s) if ((U1 >> s) & 1ull) LIST[n++] = (unsigned short)((2u << 14) | (unsigned)(64 + s));
                    LIST[n++] = (unsigned short)((2u << 14) | 128u);
                    for (int s = 0; s <= 8; ++s) LIST[n++] = (unsigned short)((3u << 14) | (unsigned)s); }
                NL[0] = n;
            }
            __syncthreads();
            nl = __builtin_amdgcn_readfirstlane(NL[0]);
            mk0 = MASKS[tokl * 4]; if (SMP) { mk1 = MASKS[tokl * 4 + 1]; }
            if (!SMP) { unsigned long long u = 0ull; for (int i = 0; i < 8; ++i) u |= MASKS[(8 * w + i) * 4]; wu = u; }
            if (idx + 1 < nl) { at_prefetch<SMP>(F, l, seq, kvh, (unsigned)LIST[idx + 1], R); at_store(F, (idx + 1) & 1, R); }
            __syncthreads();
            ++idx; continue;
        }
        const int kind = (int)(e >> 14), ti = (int)(e & 0x3fffu);
        if (kind != cur_kind) {
            if (cur_kind >= 0) AT_FINALIZE(cur_kind);
            if (kind != 1) m = -INFINITY;
            lsum = 0.f; O[0] = (f32x16){}; O[1] = (f32x16){}; cur_kind = kind;
        }
        const unsigned en = (idx + 1 < nl) ? (unsigned)__builtin_amdgcn_readfirstlane((int)LIST[idx + 1]) : AT_MARK;
        const bool have_next = (en != AT_MARK);
        if (have_next) at_prefetch<SMP>(F, l, seq, kvh, en, R);
        bool active = true;
        if (!SMP && kind == 2) active = ((wu >> ti) & 1ull) != 0ull;
        if (active) {
            const LAS unsigned char* Kb = F.lds + AT_K0 + (idx & 1) * 64 * AT_RS; const LAS unsigned char* Vb = F.lds + AT_V0 + (idx & 1) * 64 * AT_RS;
            int lo, hi; const int kb = 64 * ti;
            if (kind < 2) { lo = 0; hi = SMP ? 510 : ((t >= 31) ? ((t - 31) >> 4) : -1); }
            else if (kind == 2) { lo = 0; const unsigned long long mw = (ti < 64) ? mk0 : ((ti < 128) ? mk1 : 1ull); hi = ((mw >> (ti & 63)) & 1ull) ? t : -1; }
            else { if (SMP) { lo = tl; hi = WINB + tl; } else { lo = t - WINB; hi = t; } }
            f32x16 s0 = (f32x16){}, s1 = (f32x16){};
#pragma unroll
            for (int kk = 0; kk < 4; ++kk) {
                const bf16x8 k0 = *(const LAS bf16x8*)(Kb + q * AT_RS + (16 * kk + 8 * h_) * 2), k1 = *(const LAS bf16x8*)(Kb + (32 + q) * AT_RS + (16 * kk + 8 * h_) * 2);
                s0 = mfma32(k0, qf[kk], s0); s1 = mfma32(k1, qf[kk], s1);
            }
            float tmax = -INFINITY;
#pragma unroll
            for (int r = 0; r < 16; ++r) { const int key = kb + (r & 3) + 8 * (r >> 2) + 4 * h_;
                s0[r] = (key >= lo && key <= hi) ? s0[r] : -INFINITY; s1[r] = (key + 32 >= lo && key + 32 <= hi) ? s1[r] : -INFINITY;
                tmax = fmaxf(tmax, fmaxf(s0[r], s1[r])); }
            tmax = fmaxf(tmax, __shfl_xor(tmax, 32));
            const float m_new = fmaxf(m, tmax), m_use = (m_new == -INFINITY) ? 0.f : m_new;
            const float alpha = fexp2(m - m_use);
            float ps = 0.f;
#pragma unroll
            for (int r = 0; r < 16; ++r) { s0[r] = fexp2(s0[r] - m_use); s1[r] = fexp2(s1[r] - m_use); ps += s0[r] + s1[r]; }
            lsum = lsum * alpha + ps; m = m_new;
            if (kind != 0) {
                O[0] *= alpha; O[1] *= alpha;
#pragma unroll
                for (int kt2 = 0; kt2 < 2; ++kt2)
#pragma unroll
                    for (int s2 = 0; s2 < 2; ++s2) { const bf16x8 pf = cvt_frag(kt2 ? s1 : s0, s2); const int rA = 32 * kt2 + 16 * s2 + 4 * h_;
#pragma unroll
                        for (int dt = 0; dt < 2; ++dt) { const bf16x8 vf = tr_frag(Vb, AT_RS, rA, rA + 8, 32 * dt + 16 * blk, lane); O[dt] = mfma32(vf, pf, O[dt]); } }
            }
            if (kind == 1) {
#pragma unroll
                for (int r = 0; r < 16; ++r) { const int n = kb + (r & 3) + 8 * (r >> 2) + 4 * h_;
                    float a = s0[r] * invden, b = s1[r] * invden; a += __shfl_xor(a, 1); b += __shfl_xor(b, 1); a += __shfl_xor(a, 2); b += __shfl_xor(b, 2);
                    if (hr == 0) { PSw[tl * PSS + n] = a; PSw[tl * PSS + n + 32] = b; } }
            }
        }
        if (have_next) at_store(F, (idx + 1) & 1, R);
        __syncthreads();
        ++idx;
    }
#undef AT_FINALIZE
    {
        const float lt = lsum + __shfl_xor(lsum, 32); const float sc = (lt > 0.f ? 1.0f / lt : 0.f) * g2;
        if (!SMP || w == 0) {
            bf16* op = WSP(bf16, WS_OA) + row * 512 + head * 64;
#pragma unroll
            for (int dt = 0; dt < 2; ++dt)
#pragma unroll
                for (int r4 = 0; r4 < 4; ++r4) { float o_[4];
#pragma unroll
                    for (int x = 0; x < 4; ++x) o_[x] = OAw[(dt * 16 + 4 * r4 + x) * 64] + O[dt][4 * r4 + x] * sc;
                    v2u wv; wv.x = pk2(o_[0], o_[1]); wv.y = pk2(o_[2], o_[3]); *(v2u*)(op + 32 * dt + 8 * r4 + 4 * h_) = wv; }
        }
    }
}

constexpr int AS_RS = 144;
constexpr int AS_V = 0, AS_VW = 32 * AS_RS, AS_MRG = 0, AS_PS = 73728, AS_IMP = AS_PS + 16640, AS_MASK = AS_IMP + 6144;
static_assert(8 * 34 * 64 * 4 <= AS_PS && AS_MASK + 512 <= RING_BYTES, "sample attention LDS map");

__device__ __forceinline__ float xhalf_max(float x) { auto t_ = __builtin_amdgcn_permlane32_swap(__float_as_uint(x), __float_as_uint(x), false, false); return fmaxf(__uint_as_float(t_[0]), __uint_as_float(t_[1])); }
__device__ __forceinline__ float xhalf_sum(float x) { auto t_ = __builtin_amdgcn_permlane32_swap(__float_as_uint(x), __float_as_uint(x), false, false); return __uint_as_float(t_[0]) + __uint_as_float(t_[1]); }
struct ASrc { const float* kf; const float* vf; const bf16* kb; const bf16* vb; int rs; int nvalid; };
#define AS_TILE(SRC, KB0, LO_, HI_, DO_PV, DO_PS, m, lsum, O0, O1, invden, PSS_) do { \
        bf16x8 kfr[4]; \
        if ((SRC).kb) { const bf16* kp_ = (SRC).kb + (size_t)q * (SRC).rs + 8 * h_; _Pragma("unroll") for (int kk = 0; kk < 4; ++kk) kfr[kk] = *(const bf16x8*)(kp_ + 16 * kk); } \
        else { const float* kp_ = (SRC).kf + (size_t)q * (SRC).rs + 8 * h_; _Pragma("unroll") for (int kk = 0; kk < 4; ++kk) { const f32x4 a_ = *(const f32x4*)(kp_ + 16 * kk), b_ = *(const f32x4*)(kp_ + 16 * kk + 4); kfr[kk] = __builtin_bit_cast(bf16x8, pack8(a_, b_)); } } \
        if (DO_PV) { const int vr_ = lane >> 1, vh_ = lane & 1; v4u vv_[4]; \
            if (vr_ >= (SRC).nvalid) { _Pragma("unroll") for (int x = 0; x < 4; ++x) vv_[x] = (v4u){0u, 0u, 0u, 0u}; } \
            else if ((SRC).vb) { const bf16* vp_ = (SRC).vb + (size_t)vr_ * (SRC).rs + 32 * vh_; _Pragma("unroll") for (int x = 0; x < 4; ++x) vv_[x] = *(const v4u*)(vp_ + 8 * x); } \
            else { const float* vp_ = (SRC).vf + (size_t)vr_ * (SRC).rs + 32 * vh_; _Pragma("unroll") for (int x = 0; x < 4; ++x) vv_[x] = pack8(*(const f32x4*)(vp_ + 8 * x), *(const f32x4*)(vp_ + 8 * x + 4)); } \
            _Pragma("unroll") for (int x = 0; x < 4; ++x) *(LAS v4u*)(Vw + vr_ * AS_RS + vh_ * 64 + x * 16) = vv_[x]; } \
        f32x16 s_ = (f32x16){}; \
        _Pragma("unroll") for (int kk = 0; kk < 4; ++kk) s_ = mfma32(kfr[kk], qf[kk], s_); \
        float tmax_ = -INFINITY; \
        _Pragma("unroll") for (int r = 0; r < 16; ++r) { const int key_ = (KB0) + (r & 3) + 8 * (r >> 2) + 4 * h_; s_[r] = (key_ >= (LO_) && key_ <= (HI_)) ? s_[r] : -INFINITY; tmax_ = fmaxf(tmax_, s_[r]); } \
        tmax_ = xhalf_max(tmax_); \
        const float mn_ = fmaxf(m, tmax_), mu_ = (mn_ == -INFINITY) ? 0.f : mn_, al_ = fexp2(m - mu_); float ps_ = 0.f; \
        _Pragma("unroll") for (int r = 0; r < 16; ++r) { s_[r] = fexp2(s_[r] - mu_); ps_ += s_[r]; } \
        lsum = lsum * al_ + ps_; m = mn_; \
        if (DO_PV) { O0 *= al_; O1 *= al_; LDS_WAIT(); asm volatile("" ::: "memory"); \
            _Pragma("unroll") for (int s2 = 0; s2 < 2; ++s2) { const bf16x8 pf_ = cvt_frag(s_, s2); const int rA_ = 16 * s2 + 4 * h_; \
                O0 = mfma32(tr_frag(Vw, AS_RS, rA_, rA_ + 8, 16 * blk, lane), pf_, O0); O1 = mfma32(tr_frag(Vw, AS_RS, rA_, rA_ + 8, 32 + 16 * blk, lane), pf_, O1); } \
            LDS_WAIT(); asm volatile("" ::: "memory"); } \
        if (DO_PS) { _Pragma("unroll") for (int r = 0; r < 16; ++r) { const int n_ = (KB0) + (r & 3) + 8 * (r >> 2) + 4 * h_; float a_ = s_[r] * (invden); a_ += __shfl_xor(a_, 1); a_ += __shfl_xor(a_, 2); if (hr == 0) PS[tl * (PSS_) + n_] = a_; } } \
    } while (0)

__device__ __forceinline__ void attn_sample_unit(Frame& F, int l, int unit) {
    const int lane = F.lane, w = F.wave, tid = F.tid;
    const int q = lane & 31, h_ = lane >> 5, blk = (lane >> 4) & 1, tl = q >> 2, hr = q & 3;
    const int seq = unit >> 1, kvh = unit & 1, head = kvh * 4 + hr;
    const size_t row = (size_t)PM + seq * ST + tl;
    LAS unsigned char* Vw = F.lds + AS_V + w * AS_VW;
    LAS float* MRG = (LAS float*)(F.lds + AS_MRG);
    LAS float* PS = (LAS float*)(F.lds + AS_PS);
    LAS float* IMPw = (LAS float*)(F.lds + AS_IMP) + w * 192;
    LAS unsigned long long* MASKS = (LAS unsigned long long*)(F.lds + AS_MASK);
    __syncthreads();
    bf16x8 qf[4];
    { const bf16* qp = WSP(bf16, WS_QN) + row * 512 + head * 64 + 8 * h_;
#pragma unroll
      for (int kk = 0; kk < 4; ++kk) qf[kk] = *(const bf16x8*)(qp + 16 * kk); }
    const float* ngp = WSP(float, WS_NG) + row * 24 + head * 3; const float g0 = ngp[0], g1 = ngp[1], g2 = ngp[2];
    const int* ptab = (const int*)F.a->in[I_PT] + seq * NPG;
    f32x16 OA0 = (f32x16){}, OA1 = (f32x16){};

#define AS_PUBLISH(m, lsum, O0, O1) do { __syncthreads(); LAS float* mp_ = MRG + w * 34 * 64 + lane; mp_[0] = m; mp_[64] = lsum; \
        _Pragma("unroll") for (int r = 0; r < 16; ++r) { mp_[(2 + r) * 64] = O0[r]; mp_[(18 + r) * 64] = O1[r]; } __syncthreads(); } while (0)

    const bf16* CKk = WSP(bf16, WS_CK) + ((size_t)(seq * 2 + kvh) * 512) * 64; const bf16* CKv = CKk + (size_t)CMP_ROWS_J * 64;
    float mC = -INFINITY, lC = 0.f; f32x16 D0 = (f32x16){}, D1 = (f32x16){};
#pragma unroll 1
    for (int ti = w; ti < 16; ti += 8) { ASrc S{nullptr, nullptr, CKk + (size_t)ti * 32 * 64, CKv + (size_t)ti * 32 * 64, 64, 32}; AS_TILE(S, ti * 32, 0, 510, false, false, mC, lC, D0, D1, 0.f, 520); }
    { __syncthreads(); MRG[w * 128 + lane] = mC; MRG[w * 128 + 64 + lane] = xhalf_sum(lC); __syncthreads(); }
    float mT = -INFINITY;
#pragma unroll
    for (int x = 0; x < 8; ++x) mT = fmaxf(mT, MRG[x * 128 + lane]);
    float lT = 0.f;
#pragma unroll
    for (int x = 0; x < 8; ++x) { const float mx_ = MRG[x * 128 + lane]; lT += (mx_ == -INFINITY) ? 0.f : MRG[x * 128 + 64 + lane] * fexp2(mx_ - mT); }
    const float invC = lT > 0.f ? 1.0f / lT : 0.f;
    __syncthreads();
    { float mB = mT, lB = 0.f;
#pragma unroll 1
      for (int ti = w; ti < 16; ti += 8) { ASrc S{nullptr, nullptr, CKk + (size_t)ti * 32 * 64, CKv + (size_t)ti * 32 * 64, 64, 32}; AS_TILE(S, ti * 32, 0, 510, true, true, mB, lB, D0, D1, invC, 520); }
      AS_PUBLISH(mB, lB, D0, D1); }
    { const float sc = g0 * invC;
#pragma unroll 1
      for (int x = 0; x < 8; ++x) { const LAS float* mp = MRG + x * 34 * 64 + lane;
#pragma unroll
          for (int r = 0; r < 16; ++r) { OA0[r] += mp[(2 + r) * 64] * sc; OA1[r] += mp[(18 + r) * 64] * sc; } } }
    {
        const LAS float* pr = PS + w * 520; const int sa = lane, sb = lane + 64; float ia = 0.f, ib = 0.f;
#pragma unroll
        for (int n = 4 * sa - 1; n <= 4 * sa + 3; ++n) if (n >= 0) ia += pr[n];
#pragma unroll
        for (int n = 4 * sb - 1; n <= 4 * sb + 3; ++n) ib += pr[n];
        const bool fa = (sa == 0), fb = (sb == 127); const float va = fa ? 1e4f : ia, vb = fb ? 1e4f : ib;
        IMPw[sa] = va; IMPw[sb] = vb; LDS_WAIT(); asm volatile("" ::: "memory");
        int ra = fa ? 0 : 1, rb = fb ? 0 : 1;
#pragma unroll 8
        for (int i = 0; i < 128; ++i) { const float v = IMPw[i]; ra += (v > va || (v == va && i < sa)) ? 1 : 0; rb += (v > vb || (v == vb && i < sb)) ? 1 : 0; }
        const unsigned long long ma = __ballot(ra < 16), mb = __ballot(rb < 16);
        if (lane == 0) { MASKS[w * 4] = ma; MASKS[w * 4 + 1] = mb; }
    }
    __syncthreads();
    const unsigned long long mk0 = MASKS[tl * 4], mk1 = MASKS[tl * 4 + 1];
    unsigned long long U0 = 0ull, U1 = 0ull;
#pragma unroll
    for (int x = 0; x < 8; ++x) { U0 |= MASKS[x * 4]; U1 |= MASKS[x * 4 + 1]; }
    {
        float m = -INFINITY, ls = 0.f; D0 = (f32x16){}; D1 = (f32x16){};
        const int t = PAST + tl; int cnt = 0;
#pragma unroll 1
        for (int s = 0; s <= 128; ++s) {
            const bool in_u = (s < 64) ? ((U0 >> s) & 1ull) : ((s < 128) ? ((U1 >> (s - 64)) & 1ull) : true);
            if (!in_u) continue;
            const bool selb = (s < 64) ? ((mk0 >> s) & 1ull) : ((s < 128) ? ((mk1 >> (s - 64)) & 1ull) : true);
            const int nh = (s < 128) ? 2 : 1;
            for (int hf = 0; hf < nh; ++hf, ++cnt) {
                if ((cnt & 7) != w) continue;
                const int hi = selb ? t : -1;
                if (s < 128) { const int page = ptab[s >> 1], slot = (s & 1) * 64 + hf * 32;
                    const float* kp = FIN(I_CACHE) + (((((size_t)l * NPHYS + page) * PAGE + slot) * 4 + 2) * 2 + kvh) * 64;
                    ASrc S{kp, kp + 128, nullptr, nullptr, 512, 32}; AS_TILE(S, s * 64 + hf * 32, 0, hi, true, false, m, ls, D0, D1, 0.f, 520); }
                else { const bf16* kp = WSP(bf16, WS_KVS) + ((((size_t)0 * SB + seq) * 2 + kvh) * ST) * 64;
                    ASrc S{nullptr, nullptr, kp, kp + (size_t)SB * 2 * ST * 64, 64, ST}; AS_TILE(S, PAST, 0, hi, true, false, m, ls, D0, D1, 0.f, 520); }
            }
        }
        AS_PUBLISH(m, ls, D0, D1);
        float mt = -INFINITY;
#pragma unroll
        for (int x = 0; x < 8; ++x) mt = fmaxf(mt, MRG[x * 34 * 64 + lane]);
        float lt = 0.f; f32x16 T0 = (f32x16){}, T1 = (f32x16){};
#pragma unroll 1
        for (int x = 0; x < 8; ++x) { const LAS float* mp = MRG + x * 34 * 64 + lane; const float mx_ = mp[0]; const float f = (mx_ == -INFINITY) ? 0.f : fexp2(mx_ - mt); lt += mp[64] * f;
#pragma unroll
            for (int r = 0; r < 16; ++r) { T0[r] += mp[(2 + r) * 64] * f; T1[r] += mp[(18 + r) * 64] * f; } }
        lt = xhalf_sum(lt); const float sc = (lt > 0.f ? 1.0f / lt : 0.f) * g1; OA0 += T0 * sc; OA1 += T1 * sc;
    }
    {
        float m = -INFINITY, ls = 0.f; D0 = (f32x16){}; D1 = (f32x16){};
#pragma unroll 1
        for (int ti = w; ti < 17; ti += 8) {
            if (ti < 16) { const float* kp = FIN(I_CWIN) + (((((size_t)l * SB + seq) * WINB + ti * 32) * 2 + 0) * 2 + kvh) * 64;
                ASrc S{kp, kp + 128, nullptr, nullptr, 256, 32}; AS_TILE(S, ti * 32, tl, WINB + tl, true, false, m, ls, D0, D1, 0.f, 520); }
            else { const bf16* kp = WSP(bf16, WS_KVS) + ((((size_t)2 * SB + seq) * 2 + kvh) * ST) * 64;
                ASrc S{nullptr, nullptr, kp, kp + (size_t)SB * 2 * ST * 64, 64, ST}; AS_TILE(S, WINB, tl, WINB + tl, true, false, m, ls, D0, D1, 0.f, 520); }
        }
        AS_PUBLISH(m, ls, D0, D1);
        float mt = -INFINITY;
#pragma unroll
        for (int x = 0; x < 8; ++x) mt = fmaxf(mt, MRG[x * 34 * 64 + lane]);
        float lt = 0.f; f32x16 T0 = (f32x16){}, T1 = (f32x16){};
#pragma unroll 1
        for (int x = 0; x < 8; ++x) { const LAS float* mp = MRG + x * 34 * 64 + lane; const float mx_ = mp[0]; const float f = (mx_ == -INFINITY) ? 0.f : fexp2(mx_ - mt); lt += mp[64] * f;
#pragma unroll
            for (int r = 0; r < 16; ++r) { T0[r] += mp[(2 + r) * 64] * f; T1[r] += mp[(18 + r) * 64] * f; } }
        lt = xhalf_sum(lt); const float sc = (lt > 0.f ? 1.0f / lt : 0.f) * g2; OA0 += T0 * sc; OA1 += T1 * sc;
    }
#undef AS_PUBLISH
    if (w == 0) {
        bf16* op = WSP(bf16, WS_OA) + row * 512 + head * 64;
#pragma unroll
        for (int r4 = 0; r4 < 4; ++r4) { v2u a, b; a.x = pk2(OA0[4 * r4 + 0], OA0[4 * r4 + 1]); a.y = pk2(OA0[4 * r4 + 2], OA0[4 * r4 + 3]); b.x = pk2(OA1[4 * r4 + 0], OA1[4 * r4 + 1]); b.y = pk2(OA1[4 * r4 + 2], OA1[4 * r4 + 3]);
            *(v2u*)(op + 8 * r4 + 4 * h_) = a; *(v2u*)(op + 32 + 8 * r4 + 4 * h_) = b; }
    }
}

#ifndef DBG_DUP
#define DBG_DUP 0
#endif
#if DBG_DUP == 1
#define AP_DUP_QK(NK) { f32x16 d_ = (f32x16){}; _Pragma("unroll") for (int kk = 0; kk < 4; ++kk) d_ = mfma32(NK[kk], qf[(kk + 1) & 3], d_); _Pragma("unroll") for (int r = 0; r < 16; ++r) s_[r] += zf * d_[r]; }
#else
#define AP_DUP_QK(NK)
#endif
#if DBG_DUP == 2
#define AP_DUP_EXP() { float acc_ = 0.f; _Pragma("unroll") for (int r = 0; r < 16; ++r) acc_ += fexp2(s_[r] * 0.5f - 3.0f); lsum += zf * acc_; }
#else
#define AP_DUP_EXP()
#endif
#if DBG_DUP == 3
#define AP_DUP_PV() { f32x16 e0_ = (f32x16){}, e1_ = (f32x16){}; _Pragma("unroll") for (int s2 = 0; s2 < 2; ++s2) { const bf16x8 pf_ = cvt_frag(s_, 1 - s2); const int rA_ = 16 * s2 + 4 * h_; \
        e0_ = mfma32(tr_frag(Vw, AS_RS, rA_ + 8, rA_, 16 * blk, lane), pf_, e0_); e1_ = mfma32(tr_frag(Vw, AS_RS, rA_ + 8, rA_, 32 + 16 * blk, lane), pf_, e1_); } D0 += e0_ * zf; D1 += e1_ * zf; }
#else
#define AP_DUP_PV()
#endif
constexpr int AP_WS = 14336, AP_V = 0, AP_PS = 4608, AP_IMP = AP_PS + 8 * 264 * 4, AP_MASK = AP_IMP + 256, AP_LIST = AP_MASK + 64;
static_assert(AP_LIST + 2 * 192 <= AP_WS && 8 * AP_WS <= RING_BYTES, "prompt attention LDS map");
__device__ __forceinline__ void attn_prompt_unit(Frame& F, int l, int unit) {
    const int lane = F.lane, w = F.wave;
    const int q = lane & 31, h_ = lane >> 5, blk = (lane >> 4) & 1, tl = q >> 2, hr = q & 3;
    const int seq = unit >> 7, kvh = (unit >> 6) & 1, qt = unit & 63, head = kvh * 4 + hr;
    const int t0w = qt * 64 + 8 * w, t = t0w + tl; const size_t row = (size_t)seq * PT + t;
    LAS unsigned char* Vw = F.lds + w * AP_WS + AP_V; LAS float* PS = (LAS float*)(F.lds + w * AP_WS + AP_PS); LAS float* IMPw = (LAS float*)(F.lds + w * AP_WS + AP_IMP);
    LAS unsigned long long* MASKS = (LAS unsigned long long*)(F.lds + w * AP_WS + AP_MASK); LAS unsigned short* LIST = (LAS unsigned short*)(F.lds + w * AP_WS + AP_LIST);
    __syncthreads();
    bf16x8 qf[4];
    { const bf16* qp = WSP(bf16, WS_QN) + row * 512 + head * 64 + 8 * h_;
#pragma unroll
      for (int kk = 0; kk < 4; ++kk) qf[kk] = *(const bf16x8*)(qp + 16 * kk); }
    const float* ngp = WSP(float, WS_NG) + row * 24 + head * 3; const float g0 = ngp[0], g1 = ngp[1], g2 = ngp[2];
    for (int i = lane; i < 8 * 264; i += 64) PS[i] = 0.f;
    const bf16* CKk = WSP(bf16, WS_CK) + ((size_t)32768 + (seq * 2 + kvh) * 256) * 64; const bf16* CKv = CKk + (size_t)CMP_ROWS_J * 64;
    const bf16* KS = WSP(bf16, WS_KVB) + ((((size_t)0 * PB + seq) * 2 + kvh) * PT) * 64; const bf16* VS = KS + (size_t)PB * 2 * PT * 64;
    const bf16* KW = KS + (size_t)2 * PB * 2 * PT * 64; const bf16* VW = KW + (size_t)PB * 2 * PT * 64;
    const int hiCmin = (t0w >= 31) ? ((t0w - 31) >> 4) : -1;
    const int hiC = (t >= 31) ? ((t - 31) >> 4) : -1; const int nmaxw = (t0w + 7 >= 31) ? ((t0w + 7 - 31) >> 4) : -1; const int ntc = (nmaxw >= 0) ? (nmaxw >> 5) + 1 : 0;
    f32x16 D0 = (f32x16){}, D1 = (f32x16){};
    LAS float* OAG = PS + lane;
    float m = -INFINITY, lsum = 0.f, invC = 0.f; unsigned long long mk0 = 0ull;
    const float zf = (F.G == 12345) ? 1.0f : 0.0f;
    bf16x8 nk0[4]; v4u nv0[4], nv1[4];
#define AP_LOADK(e_, NK) do { const int kd_ = (int)((e_) >> 12), ti_ = (int)((e_) & 0xfffu); const bf16* kb_ = (kd_ < 2 ? CKk : (kd_ == 2 ? KS : KW)) + (size_t)ti_ * 32 * 64; \
        const int ko_ = kd_ < 2 ? q * 64 + 8 * h_ : lane * 8, ks_ = kd_ < 2 ? 16 : 512;     \
        _Pragma("unroll") for (int kk = 0; kk < 4; ++kk) NK[kk] = *(const bf16x8*)(kb_ + ko_ + ks_ * kk); } while (0)
#define AP_LOADV(e_, NV) do { const int kd_ = (int)((e_) >> 12), ti_ = (int)((e_) & 0xfffu); const bf16* vb_ = (kd_ < 2 ? CKv : (kd_ == 2 ? VS : VW)) + (size_t)ti_ * 32 * 64; \
        _Pragma("unroll") for (int x = 0; x < 4; ++x) NV[x] = *(const v4u*)(vb_ + 512 * x + lane * 8); } while (0)
#define AP_LOADT(e_, NK, NV) do { AP_LOADK(e_, NK); AP_LOADV(e_, NV); } while (0)
#define AP_STEP(i_, n_, NK, NV, NVN, EC, ECN) do { \
        const unsigned e_ = EC; const int kind = (int)(e_ >> 12), ti = (int)(e_ & 0xfffu); \
        if (kind == 1) { _Pragma("unroll") for (int x = 0; x < 4; ++x) *(LAS v4u*)(Vw + (8 * x + (lane >> 3)) * AS_RS + (lane & 7) * 16) = NV[x]; }     \
        f32x16 s_ = (f32x16){}; \
        _Pragma("unroll") for (int kk = 0; kk < 4; ++kk) s_ = mfma32(NK[kk], qf[kk], s_); \
        AP_DUP_QK(NK) \
          \
        if ((i_) + 1 < (n_)) { AP_LOADK(ECN, NK); AP_LOADV(ECN, NVN); if ((i_) + 2 < (n_)) EC = (unsigned)__builtin_amdgcn_readfirstlane((int)LIST[(i_) + 2]); } \
        if (kind != cur_kind) { \
            if (cur_kind == 0) { const float lt_ = xhalf_sum(lsum); invC = lt_ > 0.f ? 1.0f / lt_ : 0.f; } \
            else if (cur_kind == 2) { const float lt_ = xhalf_sum(lsum); const float sc_ = (lt_ > 0.f ? 1.0f / lt_ : 0.f) * g1; \
                _Pragma("unroll") for (int r = 0; r < 16; ++r) { OAG[r * 64] += D0[r] * sc_; OAG[(16 + r) * 64] += D1[r] * sc_; } } \
            if (kind != 1) m = -INFINITY; lsum = 0.f; D0 = (f32x16){}; D1 = (f32x16){}; cur_kind = kind; } \
        const int kb = ti * 32; int lo, hi; \
        if (kind < 2) { lo = 0; hi = hiC; } else if (kind == 2) { lo = 0; hi = ((mk0 >> (ti >> 1)) & 1ull) ? t : -1; } else { lo = t - WINB; hi = t; } \
          \
        const bool interior = (kind < 2) ? (hiCmin >= 0 && kb + 31 <= hiCmin) : ((kind == 2) ? (kb + 31 <= t0w) : (kb >= t0w + 7 - WINB && kb + 31 <= t0w)); \
        float tmax_ = -INFINITY, mu_, mn_; \
        if (interior) { const bool on_ = hi >= 0; \
            _Pragma("unroll") for (int r = 0; r < 16; ++r) tmax_ = fmaxf(tmax_, s_[r]); \
            tmax_ = on_ ? tmax_ : -INFINITY; tmax_ = xhalf_max(tmax_); \
            mn_ = fmaxf(m, tmax_); mu_ = (mn_ == -INFINITY) ? 0.f : mn_; const float mr_ = on_ ? mu_ : INFINITY; \
            _Pragma("unroll") for (int r = 0; r < 16; ++r) s_[r] = fexp2(s_[r] - mr_); \
        } else { \
            _Pragma("unroll") for (int r = 0; r < 16; ++r) { const int key_ = kb + (r & 3) + 8 * (r >> 2) + 4 * h_; s_[r] = (key_ >= lo && key_ <= hi) ? s_[r] : -INFINITY; tmax_ = fmaxf(tmax_, s_[r]); } \
            tmax_ = xhalf_max(tmax_); \
            mn_ = fmaxf(m, tmax_); mu_ = (mn_ == -INFINITY) ? 0.f : mn_; \
            _Pragma("unroll") for (int r = 0; r < 16; ++r) s_[r] = fexp2(s_[r] - mu_); \
        } \
        AP_DUP_EXP() \
        const float al_ = fexp2(m - mu_); float ps_ = 0.f; \
        _Pragma("unroll") for (int r = 0; r < 16; ++r) ps_ += s_[r]; \
        lsum = lsum * al_ + ps_; m = mn_; \
        if (kind >= 2) { if (__ballot(al_ != 1.0f) != 0ull) { D0 *= al_; D1 *= al_; } \
            const bf16x8 pf0_ = cvt_frag(s_, 0), pf1_ = cvt_frag(s_, 1); \
            D0 = mfma32(__builtin_bit_cast(bf16x8, NV[0]), pf0_, D0); D1 = mfma32(__builtin_bit_cast(bf16x8, NV[2]), pf0_, D1); D0 = mfma32(__builtin_bit_cast(bf16x8, NV[1]), pf1_, D0); D1 = mfma32(__builtin_bit_cast(bf16x8, NV[3]), pf1_, D1); \
        } else if (kind == 1) { if (__ballot(al_ != 1.0f) != 0ull) { D0 *= al_; D1 *= al_; } asm volatile("" ::: "memory");   \
            { const bf16x8 va0_ = tr_frag(Vw, AS_RS, 4 * h_, 4 * h_ + 8, 16 * blk, lane), va1_ = tr_frag(Vw, AS_RS, 4 * h_, 4 * h_ + 8, 32 + 16 * blk, lane), \
                           vb0_ = tr_frag(Vw, AS_RS, 16 + 4 * h_, 24 + 4 * h_, 16 * blk, lane), vb1_ = tr_frag(Vw, AS_RS, 16 + 4 * h_, 24 + 4 * h_, 32 + 16 * blk, lane);   \
              const bf16x8 pf0_ = cvt_frag(s_, 0), pf1_ = cvt_frag(s_, 1); \
              D0 = mfma32(va0_, pf0_, D0); D1 = mfma32(va1_, pf0_, D1); D0 = mfma32(vb0_, pf1_, D0); D1 = mfma32(vb1_, pf1_, D1); } \
            AP_DUP_PV() \
            asm volatile("" ::: "memory"); } \
        if (kind == 1) { _Pragma("unroll") for (int r = 0; r < 16; ++r) { const int n2_ = kb + (r & 3) + 8 * (r >> 2) + 4 * h_; float a_ = s_[r] * invC; a_ += __shfl_xor(a_, 1); a_ += __shfl_xor(a_, 2); if (hr == 0) PS[tl * 264 + n2_] = a_; } } \
    } while (0)
#define AP_RUN(N_) do { const int n_ = (N_); unsigned ec0_ = 0u, ec1_ = 0u;                  \
      if (n_ > 0) { ec0_ = (unsigned)__builtin_amdgcn_readfirstlane((int)LIST[0]); AP_LOADK(ec0_, nk0); AP_LOADV(ec0_, nv0); } \
      if (n_ > 1) { ec1_ = (unsigned)__builtin_amdgcn_readfirstlane((int)LIST[1]); } \
      _Pragma("unroll 1") for (int i_ = 0; i_ < n_; i_ += 2) { AP_STEP(i_, n_, nk0, nv0, nv1, ec0_, ec1_); if (i_ + 1 < n_) AP_STEP(i_ + 1, n_, nk0, nv1, nv0, ec1_, ec0_); } } while (0)
    int cur_kind = -1;
    if (lane < 2 * ntc) LIST[lane] = (unsigned short)(((lane >= ntc ? 1u : 0u) << 12) | (unsigned)(lane >= ntc ? lane - ntc : lane));
    LDS_WAIT(); asm volatile("" ::: "memory");
    AP_RUN(2 * ntc);
    { const float sc = (cur_kind == 1) ? g0 * invC : 0.f; D0 *= sc; D1 *= sc; }
    LDS_WAIT(); asm volatile("" ::: "memory");
#pragma unroll 1
    for (int tk = 0; tk < 8; ++tk) {
        const LAS float* pr = PS + tk * 264; const int s = lane; float imp = 0.f;
#pragma unroll
        for (int n = 4 * s - 1; n <= 4 * s + 3; ++n) if (n >= 0) imp += pr[n];
        const bool forced = (s == 0) || (s == qt) || (s == qt - 1), avail = s <= qt; const float val = avail ? (forced ? 1e4f : imp) : -1e4f;
        IMPw[s] = val; LDS_WAIT(); asm volatile("" ::: "memory");
        int rank = 0;
#pragma unroll 8
        for (int i = 0; i < 64; ++i) { const float v = IMPw[i]; rank += (v > val || (v == val && i < s)) ? 1 : 0; }
        const unsigned long long mk = __ballot(rank < 16);
        if (lane == 0) MASKS[tk] = mk;
        LDS_WAIT(); asm volatile("" ::: "memory");
    }
#pragma unroll
    for (int r = 0; r < 16; ++r) { OAG[r * 64] = D0[r]; OAG[(16 + r) * 64] = D1[r]; }
    mk0 = MASKS[tl]; unsigned long long wu = 0ull;
#pragma unroll
    for (int i = 0; i < 8; ++i) wu |= MASKS[i];
    wu &= (qt >= 63) ? ~0ull : ((1ull << (qt + 1)) - 1ull);
    const int nsel = 2 * __popcll(wu); const int tiLo = (t0w > WINB) ? ((t0w - WINB) >> 5) : 0, tiHi = (t0w + 7) >> 5, nwin = tiHi - tiLo + 1;
    if ((wu >> lane) & 1ull) { const int pos = 2 * __popcll(wu & ((1ull << lane) - 1ull)); LIST[pos] = (unsigned short)((2u << 12) | (unsigned)(2 * lane)); LIST[pos + 1] = (unsigned short)((2u << 12) | (unsigned)(2 * lane + 1)); }
    if (lane < nwin) LIST[nsel + lane] = (unsigned short)((3u << 12) | (unsigned)(tiLo + lane));
    LDS_WAIT(); asm volatile("" ::: "memory");
#ifdef DBG_COUNT
    if (lane == 0) { unsigned* CNT = (unsigned*)(F.ws + WS_CTL) + 3000; atomicAdd(CNT + 0, (unsigned)nsel); atomicAdd(CNT + 1, (unsigned)nwin); atomicAdd(CNT + 2, (unsigned)(2 * ntc)); atomicAdd(CNT + 3, 1u); }
#endif
    cur_kind = -1;
    AP_RUN(nsel + nwin);
    const float ltw = xhalf_sum(lsum); const float scw = (ltw > 0.f ? 1.0f / ltw : 0.f) * g2;
#undef AP_RUN
#undef AP_STEP
#undef AP_LOADT
#undef AP_LOADK
#undef AP_LOADV
    {
        bf16* op = WSP(bf16, WS_OA) + row * 512 + head * 64;
#pragma unroll
        for (int r4 = 0; r4 < 4; ++r4) { float a_[4], b_[4];
#pragma unroll
            for (int x = 0; x < 4; ++x) { a_[x] = OAG[(4 * r4 + x) * 64] + D0[4 * r4 + x] * scw; b_[x] = OAG[(16 + 4 * r4 + x) * 64] + D1[4 * r4 + x] * scw; }
            v2u a, b; a.x = pk2(a_[0], a_[1]); a.y = pk2(a_[2], a_[3]); b.x = pk2(b_[0], b_[1]); b.y = pk2(b_[2], b_[3]);
            *(v2u*)(op + 8 * r4 + 4 * h_) = a; *(v2u*)(op + 32 + 8 * r4 + 4 * h_) = b; }
    }
}
#undef AS_TILE

#ifdef DBG_CHECK
__device__ __forceinline__ unsigned dbg_rand(unsigned x) { x ^= x >> 16; x *= 0x7feb352du; x ^= x >> 15; x *= 0x846ca68bu; x ^= x >> 16; return x; }
__device__ __forceinline__ bool dbg_bad(float got, float exp_, float rtol, float atol) { return !(fabsf(got - exp_) <= rtol * fabsf(exp_) + atol); }
__device__ __forceinline__ float bfr(float x) { return __uint_as_float(pk2(x, 0.f) << 16); }
__device__ __forceinline__ int dbg_row(unsigned r) { const unsigned k = r % 20u; if (k == 0) return (int)(PM + (r >> 8) % SM); if (k == 1) return (int)(((r >> 8) % PB) * PT + ((r >> 12) % 8)); if (k == 2) return (int)(((r >> 8) % PB) * PT + PT - 1 - ((r >> 12) % 8)); return (int)((r >> 5) % PM); }
__device__ __forceinline__ float dbg_rs(const Frame& F, int row, int lane) { const float* xr = xrow_in(F, 0, row); float ss = 0.f; for (int d = lane; d < DM; d += 64) ss += xr[d] * xr[d]; return 1.0f / sqrtf(wave_sum(ss) * (1.0f / DM) + EPS); }
__device__ __forceinline__ float dbg_h(const Frame& F, int row, int d, float rs) { const float* mod = WSP(float, WS_MOD) + (size_t)row_bb(row) * 6144; return bfr(xrow_in(F, 0, row)[d] * rs * FIN(I_N1G)[d] * (1.0f + mod[1024 + d]) + mod[d]); }

__device__ __forceinline__ void dbg_check_phase(Frame& F) {
    const int gw = F.bid * NWAVES + F.wave, NGW = F.G * NWAVES, lane = F.lane;
    unsigned* CNT = (unsigned*)(F.ws + WS_CTL) + 3000;
    LAS float* L = (LAS float*)(F.lds + F.wave * 16384);
#define DBG_FLAG(ch, cond) do { if (__any(cond) && lane == 0) atomicAdd(CNT + (ch), 1u); } while (0)
    for (int s = gw; s < 1536; s += NGW) {
        const unsigned r = dbg_rand(1000u + s); const int row = dbg_row(r); const float rs = dbg_rs(F, row, lane); const int kind = s % 6;
        const bool isp = row < PM; const int b = isp ? (row >> 12) : ((row - PM) >> 3), t = isp ? (row & (PT - 1)) : ((row - PM) & 7);
#define DBG_U(col, dst) do { float a_ = 0.f; for (int d_ = lane; d_ < DM; d_ += 64) a_ += dbg_h(F, row, d_, rs) * bfr(FIN(I_WIN)[(size_t)d_ * D_IN + (col)]); dst = wave_sum(a_); } while (0)
        if (kind == 0) {
            const int c = (r >> 3) % 768, j = c >> 7, k = (c >> 6) & 1, dd = c & 63; float u; DBG_U(O_NKV + c, u); bool bad = false;
            if (j < 4) bad = dbg_bad(F.out[(isp ? OUT_ROWS_P + (size_t)row * 512 : OUT_ROWS_S + (size_t)(row - PM) * 512) + c], u, 0.01f, 0.01f);
            else if (isp) { if (t >= PT - WINB) bad = dbg_bad(F.out[OUT_WIN_P + ((size_t)b * WINB + (t - (PT - WINB))) * 256 + (c - 512)], u, 0.01f, 0.01f); }
            else bad = dbg_bad(F.out[OUT_WIN_S + ((size_t)b * WINB + (WINB - ST) + t) * 256 + (c - 512)], u, 0.01f, 0.01f);
            if (isp) { if (j < 2) bad = bad || dbg_bad(bf1(WSP(bf16, WS_ACMP)[((size_t)j * CMP_ROWS_J + 32768 + (b * 2 + k) * 256 + (t >> 4)) * 1024 + (t & 15) * 64 + dd]), u, 0.01f, 0.01f);
                       else bad = bad || dbg_bad(bf1(WSP(bf16, WS_KVB)[((((size_t)(j - 2) * PB + b) * 2 + k) * PT + t) * 64 + dd]), u, 0.01f, 0.01f); }
            else if (j >= 2) bad = bad || dbg_bad(bf1(WSP(bf16, WS_KVS)[((((size_t)(j - 2) * SB + b) * 2 + k) * ST + t) * 64 + dd]), u, 0.01f, 0.01f);
            DBG_FLAG(0, bad);
        } else if (kind == 1) {
            const int gi = (r >> 3) % 24, c5 = (r >> 8) % 512, cm = (r >> 8) % 3072; float u0, u1, u2, u3; DBG_U(O_NG + gi, u0); DBG_U(O_RX + c5, u1); DBG_U(O_RGATE + c5, u2); DBG_U(O_MG + cm, u3);
            bool bad = dbg_bad(WSP(float, WS_NG)[(size_t)row * 24 + gi], 1.0f / (1.0f + expf(-u0)), 0.01f, 0.005f);
            bad = bad || dbg_bad(WSP(float, WS_RX)[(size_t)row * 512 + c5], u1, 0.01f, 0.01f);
            bad = bad || dbg_bad(bf1(WSP(bf16, WS_GG)[(size_t)row * 512 + c5]), gelu_tanh(u2), 0.02f, 0.01f);
            bad = bad || dbg_bad(bf1(WSP(bf16, WS_MGS)[(size_t)row * 3072 + cm]), 1.0f / (1.0f + expf(-u3)), 0.01f, 0.005f);
            DBG_FLAG(1, bad);
        } else if (kind == 2) {
            const int head = (r >> 13) % 4, dim = (r >> 16) % 64, c5 = (r >> 3) % 512; float x1, x2, uv, ug, uq; DBG_U(O_RQ + head * 128 + dim, x1); DBG_U(O_RQ + head * 128 + 64 + dim, x2); DBG_U(O_RV + c5, uv); DBG_U(O_RG + c5, ug); DBG_U(O_NQ + c5, uq);
            const float pos = (float)(isp ? t : PAST + t); const float ang = pos * (float)pow(10000.0, -(double)dim / 64.0); float sn, cs; sincos_acc(ang, sn, cs);
            const bf16* RQ = WSP(bf16, WS_RQ);
            bool bad = dbg_bad(bf1(RQ[(size_t)row * 512 + head * 128 + dim]), x1 * cs - x2 * sn, 0.02f, 0.02f) || dbg_bad(bf1(RQ[(size_t)row * 512 + head * 128 + 64 + dim]), x1 * sn + x2 * cs, 0.02f, 0.02f);
            bad = bad || dbg_bad(bf1(RQ[(size_t)2 * MT * 512 + (size_t)row * 512 + c5]), uv, 0.01f, 0.01f) || dbg_bad(bf1(RQ[(size_t)3 * MT * 512 + (size_t)row * 512 + c5]), ug, 0.01f, 0.01f);
            bad = bad || dbg_bad(bf1(WSP(bf16, WS_QN)[(size_t)row * 512 + c5]), uq * QSCALE, 0.01f, 0.005f);
            DBG_FLAG(2, bad);
        }
#undef DBG_U
    }
    for (int s = gw; s < 128; s += NGW) {
        const unsigned r = dbg_rand(3000u + s); const int j = r & 1; const bool smp = ((r >> 1) & 3) != 0;
        const int grp = smp ? (int)((r >> 3) % 64) : (int)((r >> 3) % 8), nmax = smp ? 511 : 255; int n = (r >> 10) % nmax; if (((r >> 20) & 7) == 0) n = nmax - 1;
        const size_t rj = smp ? (size_t)grp * 512 + n : (size_t)32768 + grp * 256 + n;
        const bf16* A = WSP(bf16, WS_ACMP) + ((size_t)j * CMP_ROWS_J + rj) * 1024;
        const float* w1 = FIN(I_W1) + (size_t)j * 2048 * 128; const float* pe = FIN(I_PE) + j * 2048;
        for (int hh = 0; hh < 2; ++hh) { const int h = lane + 64 * hh; float a = FIN(I_B1)[j * 128 + h];
            for (int i = 0; i < 1024; ++i) a += (bf1(A[i]) + pe[i]) * w1[(size_t)i * 128 + h] + (bf1(A[1024 + i]) + pe[1024 + i]) * w1[(size_t)(1024 + i) * 128 + h];
            L[h] = gelu_tanh(a); }
        LDS_WAIT(); asm volatile("" ::: "memory");
        float o = 0.f; for (int h = 0; h < 128; ++h) o += L[h] * FIN(I_W2)[((size_t)j * 128 + h) * 64 + lane];
        const float got = bf1(WSP(bf16, WS_CK)[((size_t)j * CMP_ROWS_J + rj) * 64 + lane]);
        { const bool bd = dbg_bad(got, o, 0.05f, 0.03f); const unsigned long long mk = __ballot(bd); if (lane == 0 && mk) atomicAdd(CNT + 3, (unsigned)__popcll(mk)); }
        LDS_WAIT(); asm volatile("" ::: "memory");
    }
    for (int s = gw; s < 128; s += NGW) {
        const unsigned r = dbg_rand(3500u + s); const int j = r & 1; const bool smp = ((r >> 1) & 3) != 0;
        const int grp = smp ? (int)((r >> 3) % 64) : (int)((r >> 3) % 8), nmax = smp ? 511 : 255; const int n = (r >> 10) % nmax;
        const size_t rj = smp ? (size_t)grp * 512 + n : (size_t)32768 + grp * 256 + n, row = (size_t)j * CMP_ROWS_J + rj;
        const bf16* A = WSP(bf16, WS_ACMP) + row * 1024; const float* w1 = FIN(I_W1) + (size_t)j * 2048 * 128; const bf16* LH = WSP(bf16, WS_LH);
        unsigned nb = 0;
        for (int hh = 0; hh < 2; ++hh) { const int h = lane + 64 * hh; float lo = 0.f, hi = 0.f;
            for (int i = 0; i < 1024; ++i) { const float av = bf1(A[i]); lo += av * bfr(w1[(size_t)i * 128 + h]); hi += av * bfr(w1[(size_t)(1024 + i) * 128 + h]); }
            const bool bd = dbg_bad(bf1(LH[row * 256 + h]), lo, 0.02f, 0.02f) || dbg_bad(bf1(LH[row * 256 + 128 + h]), hi, 0.02f, 0.02f); nb += (unsigned)__popcll(__ballot(bd)); }
        if (lane == 0 && nb) atomicAdd(CNT + 9, nb);
        for (int hh = 0; hh < 2; ++hh) { const int h = lane + 64 * hh; L[h] = gelu_tanh(bf1(LH[row * 256 + h]) + bf1(LH[(row + 1) * 256 + 128 + h]) + WSP(float, WS_SMALLW + SW_CB)[j * 128 + h]); }
        LDS_WAIT(); asm volatile("" ::: "memory");
        float o = 0.f; for (int h = 0; h < 128; ++h) o += bfr(L[h]) * bfr(FIN(I_W2)[((size_t)j * 128 + h) * 64 + lane]);
        { const bool bd = dbg_bad(bf1(WSP(bf16, WS_CK)[row * 64 + lane]), o, 0.03f, 0.01f); const unsigned long long mk = __ballot(bd); if (lane == 0 && mk) atomicAdd(CNT + 11, (unsigned)__popcll(mk)); }
        LDS_WAIT(); asm volatile("" ::: "memory");
    }
    for (int s = gw; s < 64; s += NGW) {
        const unsigned r = dbg_rand(3700u + s); const int j = r & 1, half = (r >> 1) & 1, h = (r >> 2) % 128; const bf16* W1T = WSP(bf16, WS_SMALLW + SW_W1T) + ((size_t)j * 256 + half * 128 + h) * 1024;
        const float* w1 = FIN(I_W1) + ((size_t)j * 32 + half * 16) * 64 * 128 + h; unsigned nb = 0;
        for (int k = lane; k < 1024; k += 64) nb += (unsigned)__popcll(__ballot(dbg_bad(bf1(W1T[k]), w1[(size_t)k * 128], 0.01f, 0.0001f)));
        if (lane == 0 && nb) atomicAdd(CNT + 12, nb);
        const bool smp = ((r >> 9) & 3) != 0; const int grp = smp ? (int)((r >> 11) % 64) : (int)((r >> 11) % 8), n = (r >> 17) % (smp ? 511 : 255);
        const size_t row = (size_t)j * CMP_ROWS_J + (smp ? (size_t)grp * 512 + n : (size_t)32768 + grp * 256 + n); const bf16* A = WSP(bf16, WS_ACMP) + row * 1024;
        float a = 0.f; for (int k = lane; k < 1024; k += 64) a += bf1(A[k]) * bf1(W1T[k]); a = wave_sum(a);
        DBG_FLAG(13, dbg_bad(bf1(WSP(bf16, WS_LH)[row * 256 + half * 128 + h]), a, 0.02f, 0.02f));
    }
    for (int s = gw; s < 4; s += NGW) {
        const int j = s >> 1, h = (s & 1) * 64 + lane; const float* w1 = FIN(I_W1) + (size_t)j * 2048 * 128; const float* pe = FIN(I_PE) + j * 2048;
        float a = FIN(I_B1)[j * 128 + h]; for (int i = 0; i < 2048; ++i) a += pe[i] * w1[(size_t)i * 128 + h];
        const unsigned long long mk = __ballot(dbg_bad(WSP(float, WS_SMALLW + SW_CB)[j * 128 + h], a, 0.001f, 0.0005f)); if (lane == 0 && mk) atomicAdd(CNT + 10, (unsigned)__popcll(mk));
    }
    for (int s = gw; s < 96; s += NGW) {
        const unsigned r = dbg_rand(4000u + s); const bool smp = (s % 3) == 2;
        int seq, kvh = (r >> 4) & 1, t, tl = 0; size_t row;
        if (smp) { seq = (r >> 5) % SB; tl = (r >> 10) % ST; t = PAST + tl; row = (size_t)PM + seq * ST + tl; }
        else { seq = (r >> 5) % PB; const unsigned k = (r >> 8) % 8u; t = (k == 0) ? (int)((r >> 12) % 40) : (k == 1) ? PT - 1 - (int)((r >> 12) % 70) : (int)((r >> 12) % PT); row = (size_t)seq * PT + t; }
        const int N = smp ? 511 : 255, NS = smp ? 129 : 64, cur = t >> 6;
        LAS float* Q = L; LAS float* SC = L + 256; LAS float* PSUM = L + 256 + 2048; LAS float* OUT = L + 256 + 2048 + 512;
        for (int i = lane; i < 256; i += 64) Q[i] = bf1(WSP(bf16, WS_QN)[row * 512 + (kvh * 4 + (i >> 6)) * 64 + (i & 63)]);
        for (int i = lane; i < 768; i += 64) OUT[i] = 0.f;
        LDS_WAIT(); asm volatile("" ::: "memory");
        const bf16* CKk = WSP(bf16, WS_CK) + (smp ? (size_t)(seq * 2 + kvh) * 512 : (size_t)32768 + (seq * 2 + kvh) * 256) * 64; const bf16* CKv = CKk + (size_t)CMP_ROWS_J * 64;
        const int nvis = smp ? 511 : ((t >= 31) ? ((t - 31) >> 4) + 1 : 0);
        for (int i = lane; i < 512; i += 64) PSUM[i] = 0.f;
        for (int hr = 0; hr < 4; ++hr) {
            float mx = -INFINITY; for (int n = lane; n < nvis; n += 64) { float a = 0.f; for (int d = 0; d < 64; ++d) a += Q[hr * 64 + d] * bf1(CKk[(size_t)n * 64 + d]); SC[n] = a; mx = fmaxf(mx, a); }
            for (int o = 1; o < 64; o <<= 1) mx = fmaxf(mx, __shfl_xor(mx, o));
            float den = 0.f; for (int n = lane; n < nvis; n += 64) { const float e = exp2f(SC[n] - mx); SC[n] = e; den += e; } den = wave_sum(den);
            LDS_WAIT(); asm volatile("" ::: "memory");
            if (nvis > 0) { float o = 0.f; for (int n = 0; n < nvis; ++n) o += SC[n] * bf1(CKv[(size_t)n * 64 + lane]); OUT[hr * 64 + lane] = o / den;
                for (int n = lane; n < nvis; n += 64) PSUM[n] += SC[n] / den; }
            LDS_WAIT(); asm volatile("" ::: "memory");
        }
        LAS float* IMP = SC; LAS float* SELB = SC + 256;
        for (int sblk = lane; sblk < NS; sblk += 64) { float imp = 0.f; for (int n = 4 * sblk - 1; n <= 4 * sblk + 3; ++n) if (n >= 0 && n < N) imp += PSUM[n];
            const bool forced = sblk == 0 || sblk == cur || sblk == cur - 1, avail = sblk * 64 <= t; IMP[sblk] = avail ? (forced ? 1e4f : imp) : -1e4f; SELB[sblk] = 0.f; }
        LDS_WAIT(); asm volatile("" ::: "memory");
        for (int pick = 0; pick < 16 && pick < NS; ++pick) { float bv = -INFINITY; int bi = 1 << 30;
            for (int sblk = lane; sblk < NS; sblk += 64) { const float v = (SELB[sblk] != 0.f) ? -INFINITY : IMP[sblk]; if (v > bv || (v == bv && sblk < bi)) { bv = v; bi = sblk; } }
            for (int o = 1; o < 64; o <<= 1) { const float ov = __shfl_xor(bv, o); const int oi = __shfl_xor(bi, o); if (ov > bv || (ov == bv && oi < bi)) { bv = ov; bi = oi; } }
            if (lane == 0) SELB[bi] = 1.f; LDS_WAIT(); asm volatile("" ::: "memory"); }
        for (int br = 1; br < 3; ++br) for (int hr = 0; hr < 4; ++hr) {
            float mx = -INFINITY, den = 0.f, o = 0.f;
            const int plo = (br == 1) ? 0 : (t - WINB < 0 ? 0 : t - WINB), phi = t;
            for (int p = plo; p <= phi; ++p) {
                if (br == 1 && SELB[p >> 6] == 0.f) { p |= 63; continue; }
                const float* kf = nullptr; const bf16* kb = nullptr; const float* vf = nullptr; const bf16* vb = nullptr;
                const int jk = (br == 1) ? 2 : 4;
                if (!smp) { kb = WSP(bf16, WS_KVB) + ((((size_t)(jk - 2) * PB + seq) * 2 + kvh) * PT + p) * 64; vb = kb + (size_t)PB * 2 * PT * 64; }
                else if (p >= PAST) { kb = WSP(bf16, WS_KVS) + ((((size_t)(jk - 2) * SB + seq) * 2 + kvh) * ST + (p - PAST)) * 64; vb = kb + (size_t)SB * 2 * ST * 64; }
                else if (br == 1) { const int page = ((const int*)F.a->in[I_PT])[seq * NPG + (p >> 7)]; kf = FIN(I_CACHE) + ((((size_t)page * PAGE + (p & 127)) * 4 + 2) * 2 + kvh) * 64; vf = kf + 128; }
                else { kf = FIN(I_CWIN) + ((((size_t)seq * WINB + (p - (PAST - WINB))) * 2 + 0) * 2 + kvh) * 64; vf = kf + 128; }
                float a = 0.f; for (int d = 0; d < 64; ++d) a += Q[hr * 64 + d] * (kb ? bf1(kb[d]) : bfr(kf[d]));
                const float vv = vb ? bf1(vb[lane]) : bfr(vf[lane]);
                const float mn = fmaxf(mx, a), al = exp2f(mx - mn), e = exp2f(a - mn); den = den * al + e; o = o * al + e * vv; mx = mn;
            }
            OUT[(br * 4 + hr) * 64 + lane] = (den > 0.f) ? o / den : 0.f;
        }
        LDS_WAIT(); asm volatile("" ::: "memory");
        bool bad = false;
        for (int hr = 0; hr < 4; ++hr) { const float* ng = WSP(float, WS_NG) + row * 24 + (kvh * 4 + hr) * 3;
            const float e = ng[0] * OUT[(0 * 4 + hr) * 64 + lane] + ng[1] * OUT[(1 * 4 + hr) * 64 + lane] + ng[2] * OUT[(2 * 4 + hr) * 64 + lane];
            bad = bad || dbg_bad(bf1(WSP(bf16, WS_OA)[row * 512 + (kvh * 4 + hr) * 64 + lane]), e, 0.04f, 0.004f); }
        DBG_FLAG(smp ? 5 : 4, bad);
        LDS_WAIT(); asm volatile("" ::: "memory");
    }
    for (int s = gw; s < 96; s += NGW) {
        const unsigned r = dbg_rand(6000u + s); const bool smp = (s % 3) == 2; const int h = (r >> 3) & 3; const float lg = ret_log_g(h);
        const bf16* RQ = WSP(bf16, WS_RQ); const bf16* RK = RQ + (size_t)MT * 512; const bf16* RV = RQ + (size_t)2 * MT * 512; const bf16* RG = RQ + (size_t)3 * MT * 512;
        int seq, t; size_t row0; if (smp) { seq = (r >> 5) % SB; t = (r >> 10) % ST; row0 = (size_t)PM + seq * ST; } else { seq = (r >> 5) % PB; const unsigned k = (r >> 8) % 4u; t = (k == 0) ? (int)((r >> 12) % 300) : (int)((r >> 12) % PT); row0 = (size_t)seq * PT; }
        float o0 = 0.f, o1 = 0.f;
        for (int d = lane; d < 128; d += 64) L[d] = bf1(RQ[(row0 + t) * 512 + h * 128 + d]);
        LDS_WAIT(); asm volatile("" ::: "memory");
        for (int j = 0; j <= t; ++j) { float a = 0.f; for (int d = 0; d < 128; ++d) a += L[d] * bf1(RK[(row0 + j) * 512 + h * 128 + d]);
            a *= expf((float)(t - j) * lg); o0 += a * bf1(RV[(row0 + j) * 512 + h * 128 + lane]); o1 += a * bf1(RV[(row0 + j) * 512 + h * 128 + 64 + lane]); }
        if (smp) { const float* S0 = FIN(I_SRET) + (((size_t)0 * SB + seq) * 4 + h) * 16384; const float cr = expf((float)(t + 1) * lg);
            for (int d = 0; d < 128; ++d) { o0 += L[d] * S0[d * 128 + lane] * cr; o1 += L[d] * S0[d * 128 + 64 + lane] * cr; } }
        const float mean = wave_sum(o0 + o1) * (1.0f / 128.0f); const float var = wave_sum((o0 - mean) * (o0 - mean) + (o1 - mean) * (o1 - mean)) * (1.0f / 128.0f), rstd = 1.0f / sqrtf(var + EPS);
        const float* GN = FIN(I_GNG) + h * 128; const bf16* OR_ = WSP(bf16, WS_OA) + (size_t)MT * 512;
        const float g0 = bf1(RG[(row0 + t) * 512 + h * 128 + lane]), g1 = bf1(RG[(row0 + t) * 512 + h * 128 + 64 + lane]);
        const float e0 = (o0 - mean) * rstd * GN[lane] * (g0 / (1.0f + expf(-g0))), e1 = (o1 - mean) * rstd * GN[64 + lane] * (g1 / (1.0f + expf(-g1)));
        DBG_FLAG(6, dbg_bad(bf1(OR_[(row0 + t) * 512 + h * 128 + lane]), e0, 0.04f, 0.02f) || dbg_bad(bf1(OR_[(row0 + t) * 512 + h * 128 + 64 + lane]), e1, 0.04f, 0.02f));
        const int d = (r >> 20) % 128, T = smp ? ST : PT; float s0 = 0.f, s1 = 0.f;
        for (int j = 0; j < T; ++j) { const float kk = bf1(RK[(row0 + j) * 512 + h * 128 + d]) * expf((float)(T - 1 - j) * lg); s0 += kk * bf1(RV[(row0 + j) * 512 + h * 128 + lane]); s1 += kk * bf1(RV[(row0 + j) * 512 + h * 128 + 64 + lane]); }
        const float* SO;
        if (smp) { const float* S0 = FIN(I_SRET) + (((size_t)0 * SB + seq) * 4 + h) * 16384; const float g8 = expf(8.0f * lg); s0 += g8 * S0[d * 128 + lane]; s1 += g8 * S0[d * 128 + 64 + lane]; SO = F.out + OUT_RET_S + (((size_t)0 * SB + seq) * 4 + h) * 16384; }
        else SO = F.out + OUT_RET_P + (((size_t)0 * PB + seq) * 4 + h) * 16384;
        DBG_FLAG(7, dbg_bad(SO[d * 128 + lane], s0, 0.02f, 0.02f) || dbg_bad(SO[d * 128 + 64 + lane], s1, 0.02f, 0.02f));
        LDS_WAIT(); asm volatile("" ::: "memory");
    }
    for (int s = gw; s < 48; s += NGW) {
        const unsigned r = dbg_rand(8000u + s); const bool smp = (s % 3) == 2; const int blk = (r >> 3) & 7, c = blk * 64 + lane;
        int seq, T; size_t row0; if (smp) { seq = (r >> 6) % SB; T = ST; row0 = (size_t)PM + seq * ST; } else { seq = (r >> 6) % PB; T = 1 + (int)((r >> 10) % ((s & 1) ? 200 : PT)); row0 = (size_t)seq * PT; }
        const float* RX = WSP(float, WS_RX); const float* cw = FIN(I_RCW); const float cb = FIN(I_RCB)[c];
        float x3 = 0.f, x2 = 0.f, x1 = 0.f, h = 0.f;
        if (smp) { const float* cv = FIN(I_SCONV) + (size_t)seq * 3 * 512; x3 = cv[c]; x2 = cv[512 + c]; x1 = cv[1024 + c]; h = FIN(I_SH)[(size_t)seq * 512 + c]; }
        const float sp = log1pf(expf(-FIN(I_LAM)[c])); const float* wa = FIN(I_RWA) + (size_t)blk * 4096; const float* wx = FIN(I_RWX) + (size_t)blk * 4096;
        for (int t = 0; t < T; ++t) { const float x0 = RX[(row0 + t) * 512 + c]; const float xc = cb + cw[c] * x3 + cw[512 + c] * x2 + cw[1024 + c] * x1 + cw[1536 + c] * x0; x3 = x2; x2 = x1; x1 = x0;
            L[lane] = xc; LDS_WAIT(); asm volatile("" ::: "memory");
            float ra = FIN(I_RBA)[c], ri = FIN(I_RBX)[c]; for (int i = 0; i < 64; ++i) { ra += L[i] * wa[i * 64 + lane]; ri += L[i] * wx[i * 64 + lane]; }
            LDS_WAIT(); asm volatile("" ::: "memory");
            const float rr = 1.0f / (1.0f + expf(-ra)), ii = 1.0f / (1.0f + expf(-ri)), la = -8.0f * rr * sp, a = expf(la); h = a * h + sqrtf(-expm1f(2.0f * la)) * (ii * xc); }
        const size_t o = (row0 + T - 1) * 512 + c; const float e = h * bf1(WSP(bf16, WS_GG)[o]);
        DBG_FLAG(8, dbg_bad(bf1((WSP(bf16, WS_OA) + (size_t)2 * MT * 512)[o]), e, 0.04f, 0.01f));
    }
    for (int s = gw; s < 512; s += NGW) {
        const unsigned r = dbg_rand(9000u + s); const int row = dbg_row(r), col = (r >> 7) % DM;
        float e = 0.f;
        for (int br = 0; br < 3; ++br) { const bf16* O = WSP(bf16, WS_OA) + (size_t)br * MT * 512 + (size_t)row * 512; const float* W = FIN(br == 0 ? I_WBRA : (br == 1 ? I_WBRB : I_WBRC));
            float a = 0.f; for (int k = lane; k < 512; k += 64) a += bf1(O[k]) * bfr(W[(size_t)k * DM + col]); a = wave_sum(a); e += bf1(WSP(bf16, WS_MGS)[(size_t)row * 3072 + br * 1024 + col]) * a; }
        DBG_FLAG(20, dbg_bad(bf1(WSP(bf16, WS_MRG)[(size_t)row * DM + col]), e, 0.03f, 0.01f));
        const float* mod = WSP(float, WS_MOD) + (size_t)row_bb(row) * 6144;
        { float a = 0.f; for (int k = lane; k < DM; k += 64) a += bf1(WSP(bf16, WS_MRG)[(size_t)row * DM + k]) * bfr(FIN(I_WOUT)[(size_t)k * DM + col]); a = wave_sum(a);
          const float ex = xrow_in(F, 0, row)[col] + mod[2048 + col] * a; DBG_FLAG(21, dbg_bad(WSP(float, WS_X1)[(size_t)row * DM + col], ex, 0.005f, 0.005f)); }
        { const float* xr = WSP(float, WS_X1) + (size_t)row * DM; float ss = 0.f; for (int d = lane; d < DM; d += 64) ss += xr[d] * xr[d]; const float rs = 1.0f / sqrtf(wave_sum(ss) * (1.0f / DM) + EPS);
          const int c2 = (r >> 9) % NUP; float a = 0.f; for (int d = lane; d < DM; d += 64) a += bfr(xr[d] * rs * FIN(I_N2G)[d] * (1.0f + mod[4096 + d]) + mod[3072 + d]) * bfr(FIN(I_WUP)[(size_t)d * NUP + c2]); a = wave_sum(a);
          const float got = c2 < DFF ? bf1(WSP(bf16, WS_GP)[(size_t)row * DFF + c2]) : bf1((WSP(bf16, WS_GP) + (size_t)MT * DFF)[(size_t)row * DFF + c2 - DFF]); DBG_FLAG(22, dbg_bad(got, a, 0.02f, 0.01f)); }
        { const int c3 = (r >> 11) % DFF; const bf16* GP = WSP(bf16, WS_GP); const bf16* VAL = GP + (size_t)MT * DFF; const float* cw = FIN(I_FCW);
          const bool isp = row < PM; const int t = isp ? (row & (PT - 1)) : ((row - PM) & 7); float xm2, xm1;
          if (t >= 2) { xm2 = bf1(GP[(size_t)(row - 2) * DFF + c3]); xm1 = bf1(GP[(size_t)(row - 1) * DFF + c3]); }
          else if (isp) { xm2 = 0.f; xm1 = (t == 1) ? bf1(GP[(size_t)(row - 1) * DFF + c3]) : 0.f; }
          else { const float* st = FIN(I_SFFN) + ((size_t)((row - PM) >> 3) * 2) * DFF + c3; xm2 = (t == 0) ? st[0] : st[DFF]; xm1 = (t == 0) ? st[DFF] : bf1(GP[(size_t)(row - 1) * DFF + c3]); }
          const float y = FIN(I_FCB)[c3] + cw[c3] * xm2 + cw[DFF + c3] * xm1 + cw[2 * DFF + c3] * bf1(GP[(size_t)row * DFF + c3]); const float ex = (y / (1.0f + expf(-y))) * bf1(VAL[(size_t)row * DFF + c3]);
          DBG_FLAG(23, dbg_bad(bf1((GP + (size_t)2 * MT * DFF)[(size_t)row * DFF + c3]), ex, 0.02f, 0.005f)); }
        { const bf16* ACT = WSP(bf16, WS_GP) + (size_t)2 * MT * DFF + (size_t)row * DFF; float a = 0.f; for (int k = lane; k < DFF; k += 64) a += bf1(ACT[k]) * bfr(FIN(I_WDN)[(size_t)k * DM + col]); a = wave_sum(a);
          const float ex = WSP(float, WS_X1)[(size_t)row * DM + col] + mod[5120 + col] * a; DBG_FLAG(24, dbg_bad(WSP(float, WS_X2)[(size_t)row * DM + col], ex, 0.005f, 0.005f)); }
    }
#undef DBG_FLAG
}
__device__ __forceinline__ void dbg_report_phase(Frame& F) {
    const unsigned* CNT = (const unsigned*)(F.ws + WS_CTL) + 3000;
    const size_t ooff[14] = {OUT_Y, OUT_Y + (size_t)PM * DM, OUT_ROWS_P, OUT_ROWS_S, OUT_WIN_P, OUT_WIN_S, OUT_RET_P, OUT_RET_S, OUT_H_P, OUT_H_S, OUT_CV_P, OUT_CV_S, OUT_FC_P, OUT_FC_S};
    if (F.bid == 0 && F.tid < 14) { const int b = F.tid; const unsigned c = CNT[b]; const int cnt = 1 + (int)(c > 1000u ? 1000u : c);
        for (int i = 0; i < cnt; ++i) ((unsigned*)F.out)[ooff[b] + 7 + 2 * i] = 0xAAAAAAAAu; }
}
#endif

#ifndef DBG_SUB
#define DBG_SUB 0xFFFF
#endif
#ifndef DBG_MAXPH
#define DBG_MAXPH N_PHASES
#endif
#ifndef DBG_REPEAT
#define DBG_REPEAT 0
#endif
#ifndef DBG_MASK
#define DBG_MASK 0xFFFF
#endif
#define IN(k) (lo <= (k) && (k) < hi)
#ifdef DBG_TIME
#define SEAM(k) do { if ((k) + 1 < hi) { if (MK_N_LAUNCHES == 1) xcd_barrier(bar); } if (F.bid == 0 && F.tid == 0) ((unsigned long long*)(F.ws + WS_CTL))[2048 + (k) + 1] = __builtin_amdgcn_s_memrealtime(); } while (0)
#else
#define SEAM(k) do { if ((k) + 1 < hi) { if (MK_N_LAUNCHES == 1) xcd_barrier(bar); } } while (0)
#endif
template <int l> __device__ __forceinline__ void ph_win(Frame& F) { unsigned char* ws = F.ws;
    pg8::Gemm g{(const pg8::bf16_t*)(ws + WS_H), (const pg8::bf16_t*)(ws + WS_WIN) + (size_t)l * NIN * DM, MT, NIN, DM};
    pg8::StaticOrder S; S.init(MT, NIN, F.G, F.bid); EpiWin E{ws, F.out, l};
    pg8::gemm_phase<EpiWin, pg8::StaticOrder, true, true>(F.lds, g, S, E); }
template <int l> __device__ __forceinline__ void ph_mix1(Frame& F) { unsigned char* ws = F.ws;
    if (DBG_SUB & 1) { launder(F);
        pg8::Gemm g{(const pg8::bf16_t*)(ws + WS_ACMP) + (size_t)l * CMP_ROWS * 1024, (const pg8::bf16_t*)(ws + WS_SMALLW + SW_W1T) + (size_t)l * 512 * 1024, CMP_ROWS, 512, 1024};
        CmpOrder S{F.G, F.bid}; EpiLH E{(bf16*)(ws + WS_LH)};
        pg8::gemm_phase<EpiLH, CmpOrder, true, true>(F.lds, g, S, E); }
    {
        unsigned* ctr = (unsigned*)(F.ws + WS_CTL) + 3210 + l; volatile LAS int* QI = (volatile LAS int*)(F.lds + MISC_OFF + 128);
#pragma unroll 1
        for (;;) {
            __syncthreads();
            if (F.tid == 0) QI[0] = (int)__hip_atomic_fetch_add(ctr, 1u, __ATOMIC_RELAXED, __HIP_MEMORY_SCOPE_AGENT);
            __syncthreads();
            const int u = __builtin_amdgcn_readfirstlane(QI[0]);
            if (u >= 768) break;
            launder(F);
            if (u < 256) rglru_unit<0>(F, l, u); else ret_local_unit(F, u - 256);
        }
        __syncthreads();
    } }
template <int l> __device__ __forceinline__ void ph_mix2(Frame& F) { cmp2_phase(F, l); ret_scan_phase(F, l); rglru_carry_phase(F, l); }
#ifndef DBG_REPQ
#define DBG_REPQ 0
#endif
constexpr int MQ_SA = 64, MQ_PA = MQ_SA + 512, MQ_RG1 = MQ_PA + 256, MQ_RO = MQ_RG1 + 512, MQ_RS = MQ_RO + 128, MQ_RG2 = MQ_RS + 32;
template <int l> __device__ __forceinline__ void ph_mix3(Frame& F) {
    unsigned* ctr = (unsigned*)(F.ws + WS_CTL) + 3200 + l;
    volatile LAS int* QI = (volatile LAS int*)(F.lds + MISC_OFF + 128);
#pragma unroll 1
    for (;;) {
        __syncthreads();
        if (F.tid == 0) QI[0] = (int)__hip_atomic_fetch_add(ctr, 1u, __ATOMIC_RELAXED, __HIP_MEMORY_SCOPE_AGENT);
        __syncthreads();
        const int u = __builtin_amdgcn_readfirstlane(QI[0]);
        if (u >= MQ_RG2) break;
        launder(F);
        if (u < MQ_SA) { attn_sample_unit(F, l, u); if (DBG_REPQ & 2) { launder(F); attn_sample_unit(F, l, u); } }
        else if (u < MQ_PA) { const int v = u - MQ_SA; attn_prompt_unit(F, l, (v & 7) * 64 + 63 - (v >> 3)); if (DBG_REPQ & 1) { launder(F); attn_prompt_unit(F, l, (v & 7) * 64 + 63 - (v >> 3)); } }
        else if (u < MQ_RG1) { rglru_unit<1>(F, l, u - MQ_PA); }
        else if (u < MQ_RO) { ret_out_unit(F, l, u - MQ_RG1); }
        else if (u < MQ_RS) { ret_sample_unit(F, l, u - MQ_RO); }
        else { rglru_unit<2>(F, l, u - MQ_RS); }
    }
    __syncthreads(); }
__device__ __forceinline__ f32x16 smp_tile_acc(Frame& F, const bf16* A, const bf16* Wt, int K, int tile) {
    const int q = F.lane & 31, h_ = F.lane >> 5, ks8 = K / 8, kb = F.wave * ks8;
    const bf16* ap = A + (size_t)((tile >> 5) * 32 + q) * K + kb + 8 * h_; const bf16* bp = Wt + (size_t)((tile & 31) * 32 + q) * K + kb + 8 * h_; f32x16 acc = (f32x16){};
#pragma unroll 11
    for (int kk = 0; kk < ks8 / 16; ++kk) acc = mfma32(*(const bf16x8*)(ap + 16 * kk), *(const bf16x8*)(bp + 16 * kk), acc);
    return acc;
}
__device__ __forceinline__ void smp_tile_put(Frame& F, const f32x16& acc, int slot) { LAS float* R = (LAS float*)(F.lds + slot * 32768) + F.wave * 1024 + F.lane;
#pragma unroll
    for (int r = 0; r < 16; ++r) R[r * 64] = acc[r]; }
__device__ __forceinline__ float smp_tile_get(Frame& F, int slot, int o) { const LAS float* R = (const LAS float*)(F.lds + slot * 32768) + o; float s = 0.f;
#pragma unroll
    for (int w = 0; w < 8; ++w) s += R[w * 1024];
    return s; }
template <int l> __device__ __forceinline__ void ph_br(Frame& F) { unsigned char* ws = F.ws;
    const pg8::bf16_t* wbr = (const pg8::bf16_t*)(ws + WS_WBR) + (size_t)l * 3 * 1024 * 512;
    for (int tile = F.bid; tile < 256; tile += F.G) {
        const f32x16 a0 = smp_tile_acc(F, (const bf16*)(ws + WS_OA) + (size_t)PM * 512, wbr, 512, tile), a1 = smp_tile_acc(F, (const bf16*)(ws + WS_OA) + (size_t)(MT + PM) * 512, wbr + (size_t)1024 * 512, 512, tile),
                     a2 = smp_tile_acc(F, (const bf16*)(ws + WS_OA) + (size_t)(2 * MT + PM) * 512, wbr + (size_t)2 * 1024 * 512, 512, tile);
        __syncthreads(); smp_tile_put(F, a0, 0); smp_tile_put(F, a1, 1); smp_tile_put(F, a2, 2); __syncthreads();
        const bf16* MG = (const bf16*)(ws + WS_MGS); bf16* MR = (bf16*)(ws + WS_MRG);
#pragma unroll
        for (int e = 0; e < 2; ++e) { const int o = F.tid * 2 + e, r = o >> 6, ln = o & 63; const size_t row = (size_t)PM + (tile >> 5) * 32 + (r & 3) + 8 * (r >> 2) + 4 * (ln >> 5); const int col = (tile & 31) * 32 + (ln & 31);
            const bf16* g = MG + row * 3072 + col; MR[row * DM + col] = (bf16)(pk2(bf1(g[0]) * smp_tile_get(F, 0, o) + bf1(g[1024]) * smp_tile_get(F, 1, o) + bf1(g[2048]) * smp_tile_get(F, 2, o), 0.f) & 0xffffu); }
    }
    __syncthreads();
    BrOrder S; S.S.init(PM, DM, F.G, F.bid);
    pg8::Gemm g{(const pg8::bf16_t*)(ws + WS_OA), wbr, 3 * MT, 3 * DM, 512}; EpiBrAll E{ws};
    pg8::gemm_phase<EpiBrAll, BrOrder, true, true>(F.lds, g, S, E); }
template <bool INF32> __device__ __forceinline__ void smp_res(Frame& F, const bf16* A, const bf16* Wt, int K, const void* xin  , bf16* xout  , const float* mod, int gofs) {
    for (int tile = F.bid; tile < 256; tile += F.G) {
        const f32x16 a = smp_tile_acc(F, A, Wt, K, tile);
        __syncthreads(); smp_tile_put(F, a, 0); __syncthreads();
#pragma unroll
        for (int e = 0; e < 2; ++e) { const int o = F.tid * 2 + e, r = o >> 6, ln = o & 63; const int rr = (tile >> 5) * 32 + (r & 3) + 8 * (r >> 2) + 4 * (ln >> 5), col = (tile & 31) * 32 + (ln & 31);
            const float xi = INF32 ? ((const float*)xin)[(size_t)rr * DM + col] : bf1(((const bf16*)xin)[(size_t)rr * DM + col]);
            xout[(size_t)rr * DM + col] = (bf16)(pk2(xi + mod[(size_t)(4 + (rr >> 3)) * 6144 + gofs + col] * smp_tile_get(F, 0, o), 0.f) & 0xffffu); }
    }
    __syncthreads();
}
template <int l> __device__ __forceinline__ void ph_out(Frame& F) { unsigned char* ws = F.ws;
    const float* mod = (const float*)(ws + WS_MOD) + (size_t)l * 36 * 6144;
    smp_res<l == 0>(F, (const bf16*)(ws + WS_MRG) + (size_t)PM * DM, (const bf16*)(ws + WS_WOUT) + (size_t)l * DM * DM, DM, l == 0 ? (const void*)FIN(I_XS) : (const void*)((const bf16*)(ws + WS_X2) + (size_t)PM * DM), (bf16*)(ws + WS_X1) + (size_t)PM * DM, mod, 2048);
    pg8::Gemm g{(const pg8::bf16_t*)(ws + WS_MRG), (const pg8::bf16_t*)(ws + WS_WOUT) + (size_t)l * DM * DM, PM, DM, DM};
    pg8::StaticOrder S; S.init(PM, DM, F.G, F.bid);
    EpiRes<l == 0> E{l == 0 ? (const void*)FIN(I_XP) : (const void*)(ws + WS_X2), (bf16*)(ws + WS_X1), mod, 2048};
    pg8::gemm_phase<EpiRes<l == 0>, pg8::StaticOrder, true, true>(F.lds, g, S, E); }
template <int l> __device__ __forceinline__ void ph_down(Frame& F) { unsigned char* ws = F.ws;
    const float* mod = (const float*)(ws + WS_MOD) + (size_t)l * 36 * 6144;
    smp_res<false>(F, (const bf16*)(ws + WS_GP) + (size_t)2 * MT * DFF + (size_t)PM * DFF, (const bf16*)(ws + WS_WDN) + (size_t)l * DM * DFF, DFF, (const void*)((const bf16*)(ws + WS_X1) + (size_t)PM * DM), (bf16*)(ws + WS_X2) + (size_t)PM * DM, mod, 5120);
    pg8::Gemm g{(const pg8::bf16_t*)(ws + WS_GP) + (size_t)2 * MT * DFF, (const pg8::bf16_t*)(ws + WS_WDN) + (size_t)l * DM * DFF, PM, DM, DFF};
    pg8::StaticOrder S; S.init(PM, DM, F.G, F.bid);
    EpiRes<false> E{(const void*)(ws + WS_X1), (bf16*)(ws + WS_X2), mod, 5120};
    pg8::gemm_phase<EpiRes<false>, pg8::StaticOrder, true, true>(F.lds, g, S, E); }
template <int l> __device__ __forceinline__ void ph_up(Frame& F) { unsigned char* ws = F.ws;
    pg8::Gemm g{(const pg8::bf16_t*)(ws + WS_H), (const pg8::bf16_t*)(ws + WS_WUP) + (size_t)l * NUP * DM, MT, NUP, DM};
    pg8::StaticOrder S; S.init(MT, NUP, F.G, F.bid); EpiUp E{ws, F.out, l};
    pg8::gemm_phase<EpiUp, pg8::StaticOrder, true, true>(F.lds, g, S, E); }
#define RUNPH(bit, ph, CALL) do { if (((DBG_MASK >> (bit)) & 1) && IN(ph)) { launder(F); CALL; if ((DBG_REPEAT >> (bit)) & 1) { launder(F); CALL; } SEAM(ph); } } while (0)
template <int l> __device__ __forceinline__ void layer_phases(Frame& F, const XcdBarrier& bar, int lo, int hi) {
    constexpr int pb = PH_L0 + l * PH_PER_LAYER;
    RUNPH(1, pb + LP_N1, norm_phase(F, l, 0));
    RUNPH(2, pb + LP_WIN, ph_win<l>(F));
    RUNPH(3, pb + LP_MIX1, ph_mix1<l>(F));
    RUNPH(4, pb + LP_MIX2, ph_mix2<l>(F));
    RUNPH(5, pb + LP_MIX3, ph_mix3<l>(F));
    RUNPH(6, pb + LP_BR, ph_br<l>(F));
    RUNPH(7, pb + LP_OUT, ph_out<l>(F));
    RUNPH(8, pb + LP_N2, norm_phase(F, l, 1));
    RUNPH(9, pb + LP_UP, ph_up<l>(F));
    RUNPH(10, pb + LP_CONV, convact_phase(F, l));
    RUNPH(11, pb + LP_DOWN, ph_down<l>(F));
}
__global__ void __launch_bounds__(NTHR, 2) trunk_fwd(Args args) {
    extern __shared__ __attribute__((aligned(16))) unsigned char lds_raw[];
    Frame F;
    F.lds = (LAS unsigned char*)lds_raw;
    F.tid = threadIdx.x; F.lane = F.tid & 63; F.wave = __builtin_amdgcn_readfirstlane(F.tid >> 6);
    F.G = gridDim.x; F.bid = blockIdx.x; F.a = &args; F.ws = args.ws; F.out = args.out;
    volatile LAS unsigned* MISC = (volatile LAS unsigned*)(F.lds + MISC_OFF);
    for (int u = F.tid; u < 64; u += NTHR) MISC[u] = 0u;
    __syncthreads();
    unsigned* barw = (unsigned*)(F.ws + WS_CTL) + CW_BAR;
    XcdBarrier bar; bar.bar = barw; bar.x = 0; bar.st = nullptr;
    if (MK_N_LAUNCHES == 1) bar = xcd_barrier_post(barw, MISC + 8);
    const int lo = args.ph_lo, hi = args.ph_hi;
    unsigned char* ws = F.ws;

#ifdef DBG_TIME
    if (F.bid == 0 && F.tid == 0) ((unsigned long long*)(F.ws + WS_CTL))[2048] = __builtin_amdgcn_s_memrealtime();
#endif
    RUNPH(0, PH_P0, p0_prologue(F));

    layer_phases<0>(F, bar, lo, hi);
    layer_phases<1>(F, bar, lo, hi);
    if (((DBG_MASK >> 12) & 1) && IN(PH_FINAL)) { launder(F); final_phase(F); if ((DBG_REPEAT >> 12) & 1) { launder(F); final_phase(F); } }
#ifdef DBG_TIME
    {
        xcd_barrier(bar);
        if (F.bid == 0 && F.tid < 14) {
            const unsigned long long* ts = (const unsigned long long*)(F.ws + WS_CTL) + 2048; const unsigned long long tend = __builtin_amdgcn_s_memrealtime();
            const size_t ooff[14] = {OUT_Y, OUT_Y + (size_t)PM * DM, OUT_ROWS_P, OUT_ROWS_S, OUT_WIN_P, OUT_WIN_S, OUT_RET_P, OUT_RET_S, OUT_H_P, OUT_H_S, OUT_CV_P, OUT_CV_S, OUT_FC_P, OUT_FC_S};
            const int b = F.tid; unsigned long long d;
            if (b == 0) d = tend - ts[0]; else if (b == 1) d = ts[1] - ts[0]; else if (b == 13) d = tend - ts[PH_FINAL];
            else { const int ph = PH_L0 + DBG_TIME_LAYER * PH_PER_LAYER + (b - 2); d = ts[ph + 1] - ts[ph]; }
            int cnt = (int)(d / 100ull); if (cnt < 1) cnt = 1; if (cnt > 2000 && b != 0) cnt = 2000;
            for (int i = 0; i < cnt; ++i) ((unsigned*)F.out)[ooff[b] + 7 + 2 * i] = 0xAAAAAAAAu;
        }
    }
#endif
#ifdef DBG_COUNT
    {
        xcd_barrier(bar);
        if (F.bid == 0 && F.tid < 3) { const unsigned* CNT = (const unsigned*)(F.ws + WS_CTL) + 3000; const size_t ooff[3] = {OUT_Y, OUT_Y + (size_t)PM * DM, OUT_ROWS_P};
            const int cnt = (int)((unsigned long long)CNT[F.tid] * 10ull / (CNT[3] ? CNT[3] : 1u)); for (int i = 0; i < cnt; ++i) ((unsigned*)F.out)[ooff[F.tid] + 7 + 2 * i] = 0xAAAAAAAAu; }
    }
#endif
#ifdef DBG_CHECK
    if (lo == 100) { launder(F); dbg_check_phase(F); }
    if (lo == 101) { for (size_t i = (size_t)F.bid * NTHR + F.tid; i < OUT_END; i += (size_t)F.G * NTHR) F.out[i] = 0.f; }
    if (lo == 102) { launder(F); dbg_report_phase(F); }
#endif
}

extern "C" void kernel_launch(void* const* d_in, const int* in_sizes, int n_in, void* d_out, int out_size, void* d_ws, size_t ws_size, hipStream_t stream) {
    static int grid = 0;
    if (grid == 0) {
        if (n_in != 37 || (size_t)out_size != OUT_END || ws_size < WS_END) { fprintf(stderr, "kernel_launch: unexpected shapes: n_in %d out %d (want %zu) ws %zu (want %zu)\n", n_in, out_size, (size_t)OUT_END, ws_size, (size_t)WS_END); grid = -1; return; }
        int dev = 0, cus = 0, per_cu = 0;
        if (hipGetDevice(&dev) != hipSuccess || hipDeviceGetAttribute(&cus, hipDeviceAttributeMultiprocessorCount, dev) != hipSuccess) { grid = -1; return; }
        if (hipFuncSetAttribute((const void*)trunk_fwd, hipFuncAttributeMaxDynamicSharedMemorySize, LDS_BYTES) != hipSuccess) { fprintf(stderr, "kernel_launch: hipFuncSetAttribute failed\n"); grid = -1; return; }
        if (hipOccupancyMaxActiveBlocksPerMultiprocessor(&per_cu, (const void*)trunk_fwd, NTHR, LDS_BYTES) != hipSuccess || per_cu < 1) fprintf(stderr, "kernel_launch: occupancy query reports %d\n", per_cu);
        (void)hipGetLastError();
        grid = cus;
    }
    if (grid < 0) return;
    if (hipMemsetAsync((char*)d_ws + WS_CTL, 0, CTL_ZERO_BYTES, stream) != hipSuccess) return;
#ifdef DBG_POISON
    (void)hipMemsetAsync((char*)d_ws + CTL_ZERO_BYTES, 0xAA, WS_END - CTL_ZERO_BYTES, stream);
    (void)hipMemsetAsync(d_out, 0xAA, (size_t)OUT_END * 4, stream);
#endif
    Args a{};
    for (int i = 0; i < 37; ++i) a.in[i] = d_in[i];
    a.out = (float*)d_out; a.ws = (unsigned char*)d_ws;
#if MK_N_LAUNCHES == 1
    a.ph_lo = 0; a.ph_hi = N_PHASES;
    hipLaunchKernelGGL(trunk_fwd, dim3(grid), dim3(NTHR), LDS_BYTES, stream, a);
#else
    for (int p = 0; p < DBG_MAXPH; ++p) { a.ph_lo = p; a.ph_hi = p + 1; hipLaunchKernelGGL(trunk_fwd, dim3(grid), dim3(NTHR), LDS_BYTES, stream, a); }
#ifdef DBG_CHECK
    for (int p = 100; p < 103; ++p) { a.ph_lo = p; a.ph_hi = p + 1; hipLaunchKernelGGL(trunk_fwd, dim3(grid), dim3(NTHR), LDS_BYTES, stream, a); }
#endif
#endif
    (void)in_sizes;
}
```

```cpp
#include <hip/hip_runtime.h>
#include <cstdio>
#include <cstdint>

#ifndef MK_N_LAUNCHES
#define MK_N_LAUNCHES 1
#endif

constexpr int DM = 1024, PB = 4, PT = 4096, PM = PB * PT, SB = 32, ST = 8, SM = SB * ST, MT = PM + SM;
constexpr int DEPTH = 2, PAST = 8192, PAGE = 128, NPG = PAST / PAGE, NPHYS = 2560;
constexpr int D_IN = 7448, NIN = 7680, DFF = 2816, NUP = 2 * DFF;
constexpr int WINB = 512;
constexpr float EPS = 1e-6f;
constexpr float QSCALE = 0.125f * 1.4426950408889634f;

constexpr int O_NQ = 0, O_NKV = 512, O_NG = 1280, O_RQ = 1304, O_RK = 1816, O_RV = 2328, O_RG = 2840, O_RX = 3352, O_RGATE = 3864, O_MG = 4376;

constexpr size_t OUT_Y = 0;
constexpr size_t OUT_ROWS_P = OUT_Y + (size_t)MT * DM;
constexpr size_t OUT_ROWS_S = OUT_ROWS_P + (size_t)DEPTH * PM * 512;
constexpr size_t OUT_WIN_P = OUT_ROWS_S + (size_t)DEPTH * SM * 512;
constexpr size_t OUT_WIN_S = OUT_WIN_P + (size_t)DEPTH * PB * WINB * 256;
constexpr size_t OUT_RET_P = OUT_WIN_S + (size_t)DEPTH * SB * WINB * 256;
constexpr size_t OUT_RET_S = OUT_RET_P + (size_t)DEPTH * PB * 4 * 16384;
constexpr size_t OUT_H_P = OUT_RET_S + (size_t)DEPTH * SB * 4 * 16384;
constexpr size_t OUT_H_S = OUT_H_P + (size_t)DEPTH * PB * 512;
constexpr size_t OUT_CV_P = OUT_H_S + (size_t)DEPTH * SB * 512;
constexpr size_t OUT_CV_S = OUT_CV_P + (size_t)DEPTH * PB * 3 * 512;
constexpr size_t OUT_FC_P = OUT_CV_S + (size_t)DEPTH * SB * 3 * 512;
constexpr size_t OUT_FC_S = OUT_FC_P + (size_t)DEPTH * PB * 2 * DFF;
constexpr size_t OUT_END = OUT_FC_S + (size_t)DEPTH * SB * 2 * DFF;

constexpr size_t MiB = 1u << 20;
constexpr size_t WS_CTL = 0, CTL_ZERO_BYTES = 4 * MiB;
constexpr size_t WS_MOD = 1 * MiB;
constexpr size_t WS_ROT = 4 * MiB;
constexpr size_t WS_SMALLW = 8 * MiB;
constexpr size_t WS_WIN = 16 * MiB;
constexpr size_t WS_WBR = WS_WIN + (size_t)2 * NIN * DM * 2;
constexpr size_t WS_WOUT = WS_WBR + (size_t)2 * 3 * 1024 * 512 * 2;
constexpr size_t WS_WUP = WS_WOUT + (size_t)2 * 1024 * 1024 * 2;
constexpr size_t WS_WDN = WS_WUP + (size_t)2 * NUP * DM * 2;
constexpr size_t WS_WEND = WS_WDN + (size_t)2 * DM * DFF * 2;
constexpr size_t WS_H = 128 * MiB;
constexpr size_t WS_QN = WS_H + (size_t)MT * DM * 2;
constexpr size_t WS_KVB = WS_QN + (size_t)MT * 512 * 2;
constexpr size_t WS_KVS = WS_KVB + (size_t)4 * PB * 2 * PT * 64 * 2;
constexpr size_t WS_RQ = WS_KVS + (size_t)4 * SB * 2 * ST * 64 * 2;
constexpr size_t WS_RX = WS_RQ + (size_t)4 * MT * 512 * 2;
constexpr size_t WS_GG = WS_RX + (size_t)MT * 512 * 4;
constexpr size_t WS_MGS = WS_GG + (size_t)MT * 512 * 2;
constexpr size_t WS_NG = WS_MGS + (size_t)MT * 3072 * 2;
constexpr size_t WS_OA = WS_NG + (size_t)MT * 24 * 4;
constexpr size_t WS_MRG = WS_OA + (size_t)3 * MT * 512 * 2;
constexpr size_t WS_X1 = WS_MRG + (size_t)MT * DM * 2;
constexpr size_t WS_X2 = WS_X1 + (size_t)MT * DM * 4;
constexpr size_t WS_GP = WS_X2 + (size_t)MT * DM * 4;
constexpr size_t WS_ACMP = WS_GP + (size_t)3 * MT * DFF * 2;
constexpr int CMP_ROWS_J = 34816, CMP_ROWS = 2 * CMP_ROWS_J;
constexpr size_t WS_LH = WS_ACMP + (size_t)2 * CMP_ROWS * 1024 * 2 + 4096;
constexpr size_t WS_CK = WS_LH + (size_t)(CMP_ROWS + 16) * 256 * 2;
constexpr size_t WS_LT = WS_CK + (size_t)CMP_ROWS * 64 * 2;
constexpr size_t WS_SPT = WS_LT + (size_t)16 * 32 * 16384 * 4;
constexpr size_t WS_CAR = WS_SPT + (size_t)16 * 32 * 16384 * 2;
constexpr size_t WS_OAG = WS_CAR + (size_t)4 * 64 * 3 * 512 * 4 + MiB;
constexpr size_t WS_END = WS_OAG + (size_t)2048 * 32 * 64 * 4 + MiB;
static_assert(WS_WEND <= WS_H, "weights fit below WS_H");

constexpr size_t SW_W1T = 0;
constexpr size_t SW_W2T = SW_W1T + (size_t)2 * 2 * 256 * 1024 * 2;
constexpr size_t SW_CB = SW_W2T + (size_t)2 * 2 * 64 * 128 * 2;
constexpr size_t SW_WAT = SW_CB + (size_t)2 * 2 * 128 * 4;
constexpr size_t SW_SP = SW_WAT + (size_t)2 * 2 * 8 * 64 * 64 * 2;
constexpr size_t SW_END = SW_SP + 2 * 512 * 4;
static_assert(SW_END <= 8 * MiB, "small weights fit");

constexpr int CW_TMO = 0;
constexpr int CW_BAR = 4096;

constexpr int PH_P0 = 0, PH_L0 = 1, PH_PER_LAYER = 11, PH_FINAL = PH_L0 + DEPTH * PH_PER_LAYER, N_PHASES = PH_FINAL + 1;
enum { LP_N1 = 0, LP_WIN, LP_MIX1, LP_MIX2, LP_MIX3, LP_BR, LP_OUT, LP_N2, LP_UP, LP_CONV, LP_DOWN };

constexpr int RING_BYTES = 131072;
constexpr int MISC_OFF = RING_BYTES;
constexpr int LDS_BYTES = RING_BYTES + 1024;
constexpr int NWAVES = 8, NTHR = 512;

#define GAS __attribute__((address_space(1)))
#define LAS __attribute__((address_space(3)))
typedef unsigned short bf16;
typedef unsigned v4u __attribute__((ext_vector_type(4)));
typedef unsigned v2u __attribute__((ext_vector_type(2)));
typedef float f32x16 __attribute__((ext_vector_type(16)));
typedef short s16x4 __attribute__((ext_vector_type(4)));
namespace pg8 {
#define PG8_LAS __attribute__((address_space(3)))
typedef unsigned short bf16_t;
typedef short bf16x8 __attribute__((ext_vector_type(8)));
typedef float f32x4 __attribute__((ext_vector_type(4)));
typedef unsigned u32x4 __attribute__((ext_vector_type(4)));
constexpr int BM = 256, BK = 64, HALF = 128, HTB = HALF * BK * 2  , STAGE_BYTES = 8 * HTB, NXCD = 8, WGM = 8;

__host__ __device__ __forceinline__ int lds_byte(int r, int c) { const int st = (r >> 4) * 2 + (c >> 5), rr = r & 15, cc = c & 31, ob = rr * 64 + cc * 2; return st * 1024 + (ob ^ (((ob >> 9) & 1) << 5)); }
__host__ __device__ __forceinline__ void stage_rc(int b, int& R, int& C) { const int st = b / 1024, sb = b % 1024, swz = sb ^ (((sb >> 9) & 1) << 5); R = (st >> 1) * 16 + swz / 64; C = (st & 1) * 32 + (swz % 64) / 2; }
__host__ __device__ __forceinline__ int perm32(int rho) { const int n = rho >> 4, i = rho & 15; return 8 * (i >> 2) + 4 * n + (i & 3); }

struct Unit { int pm, pn; };
struct Gemm { const bf16_t* A; const bf16_t* Bt; int M, N, K; };

struct StaticOrder {
    int nM, nN, nwg, G, c;
    __host__ __device__ void init(int M, int N, int G_, int c_) { nM = M / BM; nN = N / BM; nwg = nM * nN; G = G_; c = c_; }
    __host__ __device__ bool next(int i, Unit& u) const {
        const long L = (long)i * G + c; if (L >= nwg) return false;
        int wgid = (int)L; { const int q = nwg / NXCD, r = nwg % NXCD, xcd = wgid % NXCD, off = wgid / NXCD; wgid = (xcd < r ? xcd * (q + 1) : r * (q + 1) + (xcd - r) * q) + off; }
        const int nig = WGM * nN, gid = wgid / nig, fm = gid * WGM, gsz = (nM - fm) < WGM ? (nM - fm) : WGM;
        u.pm = fm + ((wgid % nig) % gsz); u.pn = (wgid % nig) / gsz; return true;
    }
    __device__ __forceinline__ void a_ready(const Unit&) const {}
    __device__ __forceinline__ void done(const Unit&) const {}
};
__device__ __forceinline__ unsigned cvt_pk_bf16(float lo, float hi) { unsigned r; asm volatile("v_cvt_pk_bf16_f32 %0, %1, %2" : "=v"(r) : "v"(lo), "v"(hi)); return r; }
typedef float f32x2 __attribute__((ext_vector_type(2)));
template <class Epi, class Sched, bool ALIGN_EPI = false, bool SP2 = false>
__device__ __forceinline__ void gemm_phase(PG8_LAS unsigned char* lds, const Gemm g, const Sched& S, const Epi& E) {
    const int tid = threadIdx.x, wid = __builtin_amdgcn_readfirstlane(tid >> 6), lane = tid & 63, wr = wid >> 2, wc = wid & 3, fr = lane & 15, fq = lane >> 4;
    const int K = g.K, nt = K / BK;
    unsigned voffA[2], voffB[2];
#pragma unroll
    for (int i = 0; i < 2; ++i) { int R, C; stage_rc(tid * 16 + i * 8192, R, C); const int Rb = Epi::PERM ? ((R & ~31) + perm32(R & 31)) : R;
        voffA[i] = (unsigned)(R * K + C) * 2u; voffB[i] = (unsigned)(Rb * K + C) * 2u; }
    const size_t kstep = (size_t)(BK * 2);
    const size_t hstep = (size_t)HALF * K * 2;
    const size_t tstep = 2 * hstep;
    const unsigned ldsw = (unsigned)wid * 1024u;
    const int aoff = lds_byte(wr * 64 + fr, fq * 8), boff = lds_byte(wc * 32 + fr, fq * 8);
#define PG8_SA(b, h) (((b) * 2 + (h)) * HTB)
#define PG8_SB(b, h) ((4 + (b) * 2 + (h)) * HTB)
#define PG8_STAGE(bufoff, gbase, voff) do { _Pragma("unroll") for (int _i = 0; _i < 2; ++_i) \
        __builtin_amdgcn_global_load_lds((const unsigned*)((const char*)(gbase) + (voff)[_i]), (PG8_LAS unsigned*)(lds + (bufoff) + ldsw + _i * 8192), 16, 0, 0); } while (0)
#define PG8_LDA(dst, b, h) do { _Pragma("unroll") for (int m = 0; m < 4; ++m) _Pragma("unroll") for (int k = 0; k < 2; ++k) dst[m][k] = *(const PG8_LAS bf16x8*)(lds + PG8_SA(b, h) + aoff + m * 2048 + k * 1024); } while (0)
#define PG8_LDB(dst, b, h) do { _Pragma("unroll") for (int n = 0; n < 2; ++n) _Pragma("unroll") for (int k = 0; k < 2; ++k) dst[n][k] = *(const PG8_LAS bf16x8*)(lds + PG8_SB(b, h) + boff + n * 2048 + k * 1024); } while (0)
#define PG8_MMA(ai, bj, At, Bt) do { __builtin_amdgcn_s_setprio(1); _Pragma("unroll") for (int m = 0; m < 4; ++m) _Pragma("unroll") for (int n = 0; n < 2; ++n) _Pragma("unroll") for (int k = 0; k < 2; ++k) \
        acc[ai][bj][m][n] = __builtin_amdgcn_mfma_f32_16x16x32_bf16(Bt[n][k], At[m][k], acc[ai][bj][m][n], 0, 0, 0); __builtin_amdgcn_s_setprio(0); } while (0)
#define PG8_WAIT_V(n) asm volatile("s_waitcnt vmcnt(" #n ")" ::: "memory")
#define PG8_WAIT_L(n) asm volatile("s_waitcnt lgkmcnt(" #n ")" ::: "memory")
#define PG8_BAR __builtin_amdgcn_s_barrier()
#define PG8_SCHED __builtin_amdgcn_sched_barrier(0)
    Unit cur, nxt; int ui = 0;
    if (!S.next(0, cur)) return;
    f32x4 acc[2][2][4][2];
#pragma unroll
    for (int a = 0; a < 2; ++a)
#pragma unroll
        for (int b = 0; b < 2; ++b)
#pragma unroll
            for (int m = 0; m < 4; ++m)
#pragma unroll
                for (int n = 0; n < 2; ++n) acc[a][b][m][n] = (f32x4){0.f, 0.f, 0.f, 0.f};
    bf16x8 At[4][2], B0[2][2], B1[2][2];
    const char* cA = (const char*)g.A + (size_t)cur.pm * tstep; const char* cB = (const char*)g.Bt + (size_t)cur.pn * tstep;
    S.a_ready(cur);
    if constexpr (SP2) {
        PG8_STAGE(PG8_SB(0, 0), cB, voffB); PG8_STAGE(PG8_SB(0, 1), cB + hstep, voffB); PG8_STAGE(PG8_SA(0, 0), cA, voffA); PG8_STAGE(PG8_SA(0, 1), cA + hstep, voffA);
        if (wr == 1) PG8_BAR;
        PG8_WAIT_V(2); PG8_BAR;
        PG8_STAGE(PG8_SB(1, 0), cB + kstep, voffB); PG8_STAGE(PG8_SA(1, 0), cA + kstep, voffA); PG8_STAGE(PG8_SB(1, 1), cB + hstep + kstep, voffB);
        PG8_WAIT_V(6); PG8_BAR;
    } else {
        PG8_STAGE(PG8_SB(0, 0), cB, voffB); PG8_STAGE(PG8_SA(0, 0), cA, voffA); PG8_STAGE(PG8_SB(0, 1), cB + hstep, voffB); PG8_STAGE(PG8_SA(0, 1), cA + hstep, voffA);
        if (wr == 1) PG8_BAR;
        PG8_WAIT_V(4); PG8_BAR;
        PG8_STAGE(PG8_SB(1, 0), cB + kstep, voffB); PG8_STAGE(PG8_SA(1, 0), cA + kstep, voffA); PG8_STAGE(PG8_SB(1, 1), cB + hstep + kstep, voffB);
        PG8_WAIT_V(6); PG8_BAR;
    }
    for (;;) {
        const bool has_next = S.next(ui + 1, nxt);
        const char* nA = has_next ? (const char*)g.A + (size_t)nxt.pm * tstep : cA; const char* nB = has_next ? (const char*)g.Bt + (size_t)nxt.pn * tstep : cB;
        for (int t = 0; t < nt; t += 2) {
            const bool last = (t == nt - 2);
            const char* a1 = cA + (size_t)(t + 1) * kstep;
            const char* a2 = last ? nA : cA + (size_t)(t + 2) * kstep; const char* b2 = last ? nB : cB + (size_t)(t + 2) * kstep;
            const char* a3 = a2 + kstep; const char* b3 = b2 + kstep;
            if (last && has_next) S.a_ready(nxt);
            if constexpr (SP2) {
            PG8_LDB(B0, 0, 0); PG8_LDB(B1, 0, 1); PG8_SCHED; PG8_LDA(At, 0, 0); PG8_STAGE(PG8_SA(1, 1), a1 + hstep, voffA);
            PG8_WAIT_V(8); PG8_WAIT_L(0); PG8_BAR; PG8_MMA(0, 0, At, B0); PG8_MMA(0, 1, At, B1); PG8_BAR; PG8_SCHED;
            PG8_LDA(At, 0, 1); PG8_STAGE(PG8_SB(0, 0), b2, voffB); PG8_STAGE(PG8_SB(0, 1), b2 + hstep, voffB); PG8_STAGE(PG8_SA(0, 0), a2, voffA);
            PG8_WAIT_V(8); PG8_WAIT_L(0); PG8_BAR; PG8_MMA(1, 0, At, B0); PG8_MMA(1, 1, At, B1); PG8_BAR; PG8_SCHED;
            PG8_LDB(B0, 1, 0); PG8_LDB(B1, 1, 1); PG8_SCHED; PG8_LDA(At, 1, 0); PG8_STAGE(PG8_SA(0, 1), a2 + hstep, voffA);
            PG8_WAIT_V(8); PG8_WAIT_L(0); PG8_BAR; PG8_MMA(0, 0, At, B0); PG8_MMA(0, 1, At, B1); PG8_BAR; PG8_SCHED;
            PG8_LDA(At, 1, 1); PG8_STAGE(PG8_SB(1, 0), b3, voffB); PG8_STAGE(PG8_SB(1, 1), b3 + hstep, voffB); PG8_STAGE(PG8_SA(1, 0), a3, voffA);
            PG8_WAIT_V(8); PG8_WAIT_L(0); PG8_BAR; PG8_MMA(1, 0, At, B0); PG8_MMA(1, 1, At, B1); PG8_BAR; PG8_SCHED;
            } else {
            PG8_LDB(B0, 0, 0); PG8_SCHED; PG8_LDA(At, 0, 0); PG8_STAGE(PG8_SA(1, 1), a1 + hstep, voffA);
            PG8_WAIT_L(8); PG8_BAR; PG8_WAIT_L(0); PG8_MMA(0, 0, At, B0); PG8_BAR; PG8_SCHED;
            PG8_LDB(B1, 0, 1); PG8_STAGE(PG8_SB(0, 0), b2, voffB);
            PG8_BAR; PG8_WAIT_L(0); PG8_MMA(0, 1, At, B1); PG8_BAR;
            PG8_LDA(At, 0, 1); PG8_STAGE(PG8_SA(0, 0), a2, voffA);
            PG8_BAR; PG8_WAIT_L(0); PG8_MMA(1, 0, At, B0); PG8_BAR; PG8_SCHED;
            PG8_STAGE(PG8_SB(0, 1), b2 + hstep, voffB);
            PG8_WAIT_V(6); PG8_BAR; PG8_MMA(1, 1, At, B1); PG8_BAR;
            PG8_LDB(B0, 1, 0); PG8_SCHED; PG8_LDA(At, 1, 0); PG8_STAGE(PG8_SA(0, 1), a2 + hstep, voffA);
            PG8_WAIT_L(8); PG8_BAR; PG8_WAIT_L(0); PG8_MMA(0, 0, At, B0); PG8_BAR; PG8_SCHED;
            PG8_LDB(B1, 1, 1); PG8_STAGE(PG8_SB(1, 0), b3, voffB);
            PG8_BAR; PG8_WAIT_L(0); PG8_MMA(0, 1, At, B1); PG8_BAR;
            PG8_LDA(At, 1, 1); PG8_STAGE(PG8_SA(1, 0), a3, voffA);
            PG8_BAR; PG8_WAIT_L(0); PG8_MMA(1, 0, At, B0); PG8_BAR; PG8_SCHED;
            PG8_STAGE(PG8_SB(1, 1), b3 + hstep, voffB);
            PG8_WAIT_V(6); PG8_BAR; PG8_MMA(1, 1, At, B1); PG8_BAR;
            }
        }
        if constexpr (ALIGN_EPI) { if (wr == 0) PG8_BAR; }
        if constexpr (!Epi::AFTER_DRAIN) { E(acc, cur, wr, wc, fr, fq); S.done(cur); }
        if (!has_next) break;
#pragma unroll
        for (int a = 0; a < 2; ++a)
#pragma unroll
            for (int b = 0; b < 2; ++b)
#pragma unroll
                for (int m = 0; m < 4; ++m)
#pragma unroll
                    for (int n = 0; n < 2; ++n) acc[a][b][m][n] = (f32x4){0.f, 0.f, 0.f, 0.f};
        cur = nxt; cA = nA; cB = nB; ++ui;
        if constexpr (ALIGN_EPI) { if (wr == 1) PG8_BAR; }
    }
    PG8_WAIT_V(0);
    if constexpr (!ALIGN_EPI) { if (wr == 0) PG8_BAR; }
    PG8_BAR;
    if constexpr (Epi::AFTER_DRAIN) { E.fused(acc, cur, wr, wc, fr, fq, lds, wid, lane); S.done(cur); }
#undef PG8_SA
#undef PG8_SB
#undef PG8_STAGE
#undef PG8_LDA
#undef PG8_LDB
#undef PG8_MMA
#undef PG8_WAIT_V
#undef PG8_WAIT_L
#undef PG8_BAR
#undef PG8_SCHED
}
}

using pg8::bf16x8; using pg8::f32x4; using pg8::u32x4;
#define LDS_WAIT() asm volatile("s_waitcnt lgkmcnt(0)" ::: "memory")
#define VM_WAIT() asm volatile("s_waitcnt vmcnt(0)" ::: "memory")
typedef float f32x2_t __attribute__((ext_vector_type(2))); typedef __bf16 bf16x2_t __attribute__((ext_vector_type(2)));
__device__ __forceinline__ unsigned pk2(float lo, float hi) { f32x2_t v = {lo, hi}; bf16x2_t b = __builtin_convertvector(v, bf16x2_t); return __builtin_bit_cast(unsigned, b); }
__device__ __forceinline__ float bf_lo(unsigned w) { return __uint_as_float(w << 16); }
__device__ __forceinline__ float bf_hi(unsigned w) { return __uint_as_float(w & 0xffff0000u); }
__device__ __forceinline__ float bf1(bf16 b) { return __uint_as_float(((unsigned)b) << 16); }
__device__ __forceinline__ float fexp2(float x) { return __builtin_amdgcn_exp2f(x); }
__device__ __forceinline__ float fexp(float x) { return __builtin_amdgcn_exp2f(x * 1.4426950408889634f); }
__device__ __forceinline__ float frcp(float x) { return __builtin_amdgcn_rcpf(x); }
__device__ __forceinline__ float sigmoidf_(float x) { return frcp(1.0f + fexp(-x)); }
__device__ __forceinline__ float siluf_(float x) { return x * sigmoidf_(x); }
__device__ __forceinline__ float gelu_tanh(float x) {
    const float u = 0.7978845608028654f * (x + 0.044715f * x * x * x);
    const float e = fexp(2.0f * u);
    const float t = 1.0f - 2.0f * frcp(e + 1.0f);
    return 0.5f * x * (1.0f + t);
}
__device__ __forceinline__ float wave_sum(float v) {
#pragma unroll
    for (int o = 1; o < 64; o <<= 1) v += __shfl_xor(v, o);
    return v;
}
__device__ __forceinline__ v4u pack8(const f32x4 a, const f32x4 b) { v4u w; w.x = pk2(a[0], a[1]); w.y = pk2(a[2], a[3]); w.z = pk2(b[0], b[1]); w.w = pk2(b[2], b[3]); return w; }
__device__ __forceinline__ void unpack8(const v4u w, f32x4& a, f32x4& b) { a = (f32x4){bf_lo(w.x), bf_hi(w.x), bf_lo(w.y), bf_hi(w.y)}; b = (f32x4){bf_lo(w.z), bf_hi(w.z), bf_lo(w.w), bf_hi(w.w)}; }

#define XB_TMO      128
#define XB_XCNT(j)  (256  + 64 * (j))
#define XB_XSUB(j)  (1280 + 64 * (j))
#define XB_XGEN(j)  (2304 + 64 * (j))
#define XB_TOP      3328
#define XB_TOPGEN   3392
#define XCD_BAR_WORDS 3456
#define XB_SPIN_CAP (1u << 18)

__device__ __forceinline__ unsigned xb_ld(unsigned* p)              { return __hip_atomic_load(p, __ATOMIC_RELAXED, __HIP_MEMORY_SCOPE_AGENT); }
__device__ __forceinline__ unsigned xb_add(unsigned* p, unsigned v) { return __hip_atomic_fetch_add(p, v, __ATOMIC_RELAXED, __HIP_MEMORY_SCOPE_AGENT); }
__device__ __forceinline__ unsigned xb_xcc_id() { return (unsigned)__builtin_amdgcn_s_getreg((3 << 11) | 20) & 0xFu; }
#define XB_SPIN(cond, bar) do { unsigned _sp = 0; while (cond) { __builtin_amdgcn_s_sleep(1); \
    if ((++_sp & 255u) == 0u) { if (xb_ld(&(bar)[XB_TMO])) break; if (_sp > XB_SPIN_CAP) { atomicAdd(&(bar)[XB_TMO], 1u); break; } } } } while (0)

struct XcdBarrier {
    unsigned* bar; unsigned x;
    volatile LAS unsigned* st;
};

__device__ __forceinline__ XcdBarrier xcd_barrier_post(unsigned* bar, volatile LAS unsigned* st) {
    XcdBarrier b; b.bar = bar; b.x = xb_xcc_id(); b.st = st;
    if (threadIdx.x == 0) (void)xb_add(&bar[XB_XCNT(b.x)], 1u);
    return b;
}
__device__ __forceinline__ void xcd_barrier_complete(unsigned* bar, unsigned x, unsigned& nloc, unsigned& nx) {
    const unsigned G = gridDim.x * gridDim.y * gridDim.z;
    unsigned sum, cnt, mine, sp = 0u;
    for (;;) {
        sum = 0u; cnt = 0u; mine = 0u;
#pragma unroll
        for (unsigned j = 0; j < 16; ++j) { const unsigned c = xb_ld(&bar[XB_XCNT(j)]); sum += c; cnt += (c > 0u) ? 1u : 0u; mine = (j == x) ? c : mine; }
        if (sum == G) break;
        __builtin_amdgcn_s_sleep(1);
        if ((++sp & 255u) == 0u) { if (xb_ld(&bar[XB_TMO])) break; if (sp > XB_SPIN_CAP) { atomicAdd(&bar[XB_TMO], 1u); break; } }
    }
    nloc = mine > 0u ? mine : 1u; nx = cnt > 0u ? cnt : 1u;
}

__device__ __forceinline__ void xcd_barrier(const XcdBarrier& b) {
    asm volatile("s_waitcnt vmcnt(0)" ::: "memory");
    __syncthreads();
    if (threadIdx.x == 0) {
        unsigned* bar = b.bar;
        __builtin_amdgcn_s_waitcnt(0);
        unsigned nloc = b.st[0], nx = b.st[1];
        if (nloc == 0u) { xcd_barrier_complete(bar, b.x, nloc, nx); b.st[0] = nloc; b.st[1] = nx; }
        const unsigned old = xb_add(&bar[XB_XSUB(b.x)], 1u);
        const unsigned gen = old / nloc;
        if (old + 1u == (gen + 1u) * nloc) {
            __builtin_amdgcn_fence(__ATOMIC_RELEASE, "agent");
            asm volatile("s_waitcnt vmcnt(0)" ::: "memory");
            const unsigned og = xb_add(&bar[XB_TOP], 1u);
            const unsigned tg = og / nx;
            if (og + 1u == (tg + 1u) * nx) xb_add(&bar[XB_TOPGEN], 1u);
            else XB_SPIN(xb_ld(&bar[XB_TOPGEN]) == tg, bar);
            __builtin_amdgcn_fence(__ATOMIC_ACQUIRE, "agent");
            xb_add(&bar[XB_XGEN(b.x)], 1u);
            asm volatile("s_waitcnt vmcnt(0)" ::: "memory");
        } else {
            XB_SPIN(xb_ld(&bar[XB_XGEN(b.x)]) == gen, bar);
            __builtin_amdgcn_fence(__ATOMIC_ACQUIRE, "agent");
            asm volatile("s_waitcnt vmcnt(0)" ::: "memory");
        }
    }
    __syncthreads();
}

struct Args { const void* in[37]; float* out; unsigned char* ws; int ph_lo, ph_hi; };
enum { I_XP = 0, I_XS, I_CACHE, I_CWIN, I_SRET, I_SH, I_SCONV, I_SFFN, I_PT, I_CP, I_CS, I_N1G, I_N2G, I_WADA, I_BADA, I_WIN, I_PE, I_W1, I_B1, I_W2,
       I_GNG, I_RCW, I_RCB, I_RWA, I_RBA, I_RWX, I_RBX, I_LAM, I_WBRA, I_WBRB, I_WBRC, I_WOUT, I_WUP, I_FCW, I_FCB, I_WDN, I_FNG };

struct Frame {
    LAS unsigned char* lds;
    int tid, lane, wave, G, bid;
    const Args* a;
    unsigned char* ws;
    float* out;
};
__device__ __forceinline__ void launder(Frame& F) { asm volatile("" : "+v"(F.tid), "+v"(F.lane)); int w_ = __builtin_amdgcn_readfirstlane(F.wave), b_ = __builtin_amdgcn_readfirstlane(F.bid), g_ = __builtin_amdgcn_readfirstlane(F.G); asm volatile("" : "+s"(w_), "+s"(b_), "+s"(g_)); F.wave = w_; F.bid = b_; F.G = g_; }
#define FIN(i) ((const float*)F.a->in[i])
#define WSP(T, off) ((T*)(F.ws + (off)))

__device__ __forceinline__ int row_bb(int row) { return row < PM ? (row >> 12) : 4 + ((row - PM) >> 3); }
__device__ __forceinline__ int row_pos(int row) { return row < PM ? (row & (PT - 1)) : PT + ((row - PM) & 7); }

__device__ __forceinline__ int win_cmap(int n) {
    if (n < 1280) return n;
    if (n < 2304) { const int c = n - 1280, isk = c >> 9, hc = c & 511, head = hc >> 7, s = hc & 127;
        const int g = s >> 3, w = s & 7, dim = (w < 4) ? (4 * g + w) : (64 + 4 * g + (w - 4)); return (isk ? O_RK : O_RQ) + head * 128 + dim; }
    if (n < 2816) return O_RV + (n - 2304);
    if (n < 3328) return O_RG + (n - 2816);
    if (n < 3840) return O_RX + (n - 3328);
    if (n < 4352) return O_RGATE + (n - 3840);
    if (n < 7424) return O_MG + (n - 4352);
    if (n < 7448) return O_NG + (n - 7424);
    return -1;
}

template <bool MAP> __device__ __forceinline__ void p0_tr_item(const float* W, int ldw, bf16* WT, int ldt, int k0, int n0, LAS float* scr, int lane) {
    const int nd = n0 + (lane & 31); const int sc = MAP ? win_cmap(nd) : nd;
    float tv[32];
#pragma unroll
    for (int i = 0; i < 32; ++i) { const int kk = 2 * i + (lane >> 5); tv[i] = (sc >= 0) ? W[(size_t)(k0 + kk) * ldw + sc] : 0.f; }
#pragma unroll
    for (int i = 0; i < 32; ++i) { const int kk = 2 * i + (lane >> 5); scr[kk * 33 + (lane & 31)] = tv[i]; }
    LDS_WAIT(); asm volatile("" ::: "memory");
    const int c = lane & 7;
#pragma unroll
    for (int j = 0; j < 4; ++j) { const int n = (lane >> 3) + 8 * j; const LAS float* s = scr + (8 * c) * 33 + n;
        v4u o; o.x = pk2(s[0 * 33], s[1 * 33]); o.y = pk2(s[2 * 33], s[3 * 33]); o.z = pk2(s[4 * 33], s[5 * 33]); o.w = pk2(s[6 * 33], s[7 * 33]);
        *(v4u*)(WT + (size_t)(n0 + n) * ldt + k0 + 8 * c) = o; }
    LDS_WAIT(); asm volatile("" ::: "memory");
}
__device__ __forceinline__ void sincos_acc(float ang, float& s, float& c) {
    const double a = (double)ang; const double kq = rint(a * 0.63661977236758134308); const double r = fma(-kq, 1.57079632679489661923, a);
    const double r2 = r * r;
    const double sp = r * (1.0 + r2 * (-1.6666666666666666e-1 + r2 * (8.3333333333333332e-3 + r2 * (-1.9841269841269841e-4 + r2 * (2.7557319223985893e-6 + r2 * (-2.5052108385441720e-8))))));
    const double cp = 1.0 + r2 * (-0.5 + r2 * (4.1666666666666664e-2 + r2 * (-1.3888888888888889e-3 + r2 * (2.4801587301587302e-5 + r2 * (-2.7557319223985888e-7 + r2 * 2.0876756987868099e-9)))));
    const int q = ((int)kq) & 3;
    const double ss = (q == 0) ? sp : (q == 1) ? cp : (q == 2) ? -sp : -cp;
    const double cc = (q == 0) ? cp : (q == 1) ? -sp : (q == 2) ? -cp : sp;
    s = (float)ss; c = (float)cc;
}

__device__ __forceinline__ void p0_prologue(Frame& F) {
    const int gw = F.bid * NWAVES + F.wave, NGW = F.G * NWAVES, lane = F.lane;
    LAS float* scr = (LAS float*)(F.lds + F.wave * 16384);
    {
        constexpr int I_IN = 16 * 240, I_BR = 8 * 32, I_OUT = 16 * 32, I_UP = 16 * 176, I_DN = 44 * 32, I_L = I_IN + 3 * I_BR + I_OUT + I_UP + I_DN;
        for (int it = gw; it < 2 * I_L; it += NGW) {
            const int l = it / I_L; int r = it % I_L;
            if (r < I_IN) { p0_tr_item<true>(FIN(I_WIN) + (size_t)l * DM * D_IN, D_IN, WSP(bf16, WS_WIN) + (size_t)l * NIN * DM, DM, 64 * (r / 240), 32 * (r % 240), scr, lane); continue; } r -= I_IN;
            if (r < 3 * I_BR) { const int w = r / I_BR, q = r % I_BR; const float* src = FIN(w == 0 ? I_WBRA : (w == 1 ? I_WBRB : I_WBRC)) + (size_t)l * 512 * 1024;
                p0_tr_item<false>(src, 1024, WSP(bf16, WS_WBR) + (size_t)(l * 3 + w) * 1024 * 512, 512, 64 * (q / 32), 32 * (q % 32), scr, lane); continue; } r -= 3 * I_BR;
            if (r < I_OUT) { p0_tr_item<false>(FIN(I_WOUT) + (size_t)l * 1024 * 1024, 1024, WSP(bf16, WS_WOUT) + (size_t)l * 1024 * 1024, 1024, 64 * (r / 32), 32 * (r % 32), scr, lane); continue; } r -= I_OUT;
            if (r < I_UP) { p0_tr_item<false>(FIN(I_WUP) + (size_t)l * DM * NUP, NUP, WSP(bf16, WS_WUP) + (size_t)l * NUP * DM, DM, 64 * (r / 176), 32 * (r % 176), scr, lane); continue; } r -= I_UP;
            p0_tr_item<false>(FIN(I_WDN) + (size_t)l * DFF * DM, DM, WSP(bf16, WS_WDN) + (size_t)l * DM * DFF, DFF, 64 * (r / 32), 32 * (r % 32), scr, lane);
        }
    }
    {
        constexpr int NI_W1 = 8 * 16 * 4, NI_W2 = 4 * 2 * 2, NI_RG = 32 * 2;
        for (int it = gw; it < NI_W1 + NI_W2 + NI_RG; it += NGW) {
            int r = it;
            if (r < NI_W1) { const int m = r / 64, q = r % 64, lk = m >> 1, half = m & 1;
                p0_tr_item<false>(FIN(I_W1) + ((size_t)lk * 32 + half * 16) * 64 * 128, 128, WSP(bf16, WS_SMALLW + SW_W1T) + ((size_t)lk * 256 + half * 128) * 1024, 1024, 64 * (q / 4), 32 * (q % 4), scr, lane); continue; } r -= NI_W1;
            if (r < NI_W2) { const int lk = r / 4, q = r % 4;
                p0_tr_item<false>(FIN(I_W2) + (size_t)lk * 128 * 64, 64, WSP(bf16, WS_SMALLW + SW_W2T) + (size_t)lk * 64 * 128, 128, 64 * (q / 2), 32 * (q % 2), scr, lane); continue; } r -= NI_W2;
            { const int m = r / 2, q = r % 2, l = m >> 4, which = (m >> 3) & 1, blk = m & 7;
                p0_tr_item<false>(FIN(which ? I_RWX : I_RWA) + ((size_t)l * 8 + blk) * 4096, 64, WSP(bf16, WS_SMALLW + SW_WAT) + (size_t)m * 4096, 64, 0, 32 * q, scr, lane); }
        }
    }
    for (int it = gw; it < 64; it += NGW) {
        const int lk = it >> 4, h0 = (it & 15) * 8; const float* pe = FIN(I_PE) + (size_t)lk * 2048; const float* w1 = FIN(I_W1) + (size_t)lk * 2048 * 128 + h0;
        f32x4 a0 = (f32x4){0.f, 0.f, 0.f, 0.f}, a1 = a0;
#pragma unroll 8
        for (int i = lane; i < 2048; i += 64) { const float p = pe[i]; a0 += *(const f32x4*)(w1 + (size_t)i * 128) * p; a1 += *(const f32x4*)(w1 + (size_t)i * 128 + 4) * p; }
#pragma unroll
        for (int x = 0; x < 4; ++x) { a0[x] = wave_sum(a0[x]); a1[x] = wave_sum(a1[x]); }
        if (lane == 0) { float* cb = WSP(float, WS_SMALLW + SW_CB) + lk * 128 + h0; const float* b1 = FIN(I_B1) + lk * 128 + h0;
#pragma unroll
            for (int x = 0; x < 4; ++x) { cb[x] = a0[x] + b1[x]; cb[4 + x] = a1[x] + b1[4 + x]; } }
    }
    for (int i = F.bid * NTHR + F.tid; i < 1024; i += F.G * NTHR) { const float lam = FIN(I_LAM)[i]; WSP(float, WS_SMALLW + SW_SP)[i] = log1pf(expf(-lam)); }
    for (int i = F.bid * NTHR + F.tid; i < 4104 * 64; i += F.G * NTHR) {
        const int pi = i >> 6, fi = i & 63; const float pos = (float)(pi < PT ? pi : PAST + (pi - PT));
        const float freq = (float)pow(10000.0, -(double)fi / 64.0); const float ang = pos * freq; float s, c; sincos_acc(ang, s, c);
        WSP(float, WS_ROT)[i] = c; WSP(float, WS_ROT)[4104 * 64 + i] = s;
    }
    {
        LAS float* SC = (LAS float*)(F.lds + 0);
        LAS float* RED = (LAS float*)(F.lds + 36864);
        for (int u = F.bid; u < 2 * 96; u += F.G) {
            const int l = u / 96, cg = u % 96; float acc[36];
#pragma unroll
            for (int b = 0; b < 36; ++b) acc[b] = 0.f;
#pragma unroll 1
            for (int kh = 0; kh < 4; ++kh) {
                __syncthreads();
                for (int i = F.tid; i < 256 * 36; i += NTHR) { const int d = i / 36, bb = i % 36; const float c = (bb < 4) ? FIN(I_CP)[bb * DM + kh * 256 + d] : FIN(I_CS)[(bb - 4) * DM + kh * 256 + d]; SC[i] = siluf_(c); }
                __syncthreads();
                const float* wp = FIN(I_WADA) + ((size_t)l * DM + kh * 256 + F.wave * 32) * 6144 + cg * 64 + lane;
#pragma unroll 1
                for (int d0 = 0; d0 < 32; d0 += 16) {
                    float wv[16];
#pragma unroll
                    for (int k = 0; k < 16; ++k) wv[k] = wp[(size_t)(d0 + k) * 6144];
#pragma unroll
                    for (int k = 0; k < 16; ++k) { const LAS f32x4* sc4 = (const LAS f32x4*)(SC + (F.wave * 32 + d0 + k) * 36);
#pragma unroll
                        for (int g = 0; g < 9; ++g) { const f32x4 s4 = sc4[g]; acc[4 * g + 0] += wv[k] * s4[0]; acc[4 * g + 1] += wv[k] * s4[1]; acc[4 * g + 2] += wv[k] * s4[2]; acc[4 * g + 3] += wv[k] * s4[3]; } }
                }
            }
#pragma unroll
            for (int b = 0; b < 36; ++b) RED[(F.wave * 36 + b) * 64 + lane] = acc[b];
            __syncthreads();
            for (int o = F.tid; o < 36 * 64; o += NTHR) { const int b = o >> 6, col = o & 63; float sm = FIN(I_BADA)[l * 6144 + cg * 64 + col];
#pragma unroll
                for (int w = 0; w < 8; ++w) sm += RED[(w * 36 + b) * 64 + col];
                WSP(float, WS_MOD)[((size_t)l * 36 + b) * 6144 + cg * 64 + col] = sm; }
        }
        __syncthreads();
    }
    for (size_t i = (size_t)F.bid * NTHR + F.tid; i < (size_t)2 * SB * 504 * 64; i += (size_t)F.G * NTHR) {
        const size_t seq = i / (504 * 64), r = i % (504 * 64);
        const f32x4 v = *(const f32x4*)(FIN(I_CWIN) + (seq * 512 + 8) * 256 + r * 4);
        *(f32x4*)(F.out + OUT_WIN_S + seq * 512 * 256 + r * 4) = v;
    }
}

__device__ __forceinline__ f32x4 ld4_bf(const bf16* p) { const v2u w = *(const v2u*)p; return (f32x4){bf_lo(w.x), bf_hi(w.x), bf_lo(w.y), bf_hi(w.y)}; }
__device__ __forceinline__ void norm_phase(Frame& F, int l, int which) {
    const int gw = F.bid * NWAVES + F.wave, NGW = F.G * NWAVES, lane = F.lane;
    const float* g = FIN(which ? I_N2G : I_N1G) + l * DM;
    for (int row0 = gw * 2; row0 < MT; row0 += NGW * 2) {
        f32x4 v[2][4]; float ss[2];
#pragma unroll
        for (int rr = 0; rr < 2; ++rr) { const int row = row0 + rr;
            if (which == 0 && l == 0) { const float* xr = row < PM ? FIN(I_XP) + (size_t)row * DM : FIN(I_XS) + (size_t)(row - PM) * DM;
#pragma unroll
                for (int j = 0; j < 4; ++j) v[rr][j] = *(const f32x4*)(xr + lane * 4 + 256 * j); }
            else { const bf16* xr = WSP(bf16, which ? WS_X1 : WS_X2) + (size_t)row * DM;
#pragma unroll
                for (int j = 0; j < 4; ++j) v[rr][j] = ld4_bf(xr + lane * 4 + 256 * j); } }
#pragma unroll
        for (int rr = 0; rr < 2; ++rr) { float a = 0.f;
#pragma unroll
            for (int j = 0; j < 4; ++j) a += (v[rr][j][0] * v[rr][j][0] + v[rr][j][1] * v[rr][j][1]) + (v[rr][j][2] * v[rr][j][2] + v[rr][j][3] * v[rr][j][3]);
            ss[rr] = a; }
#pragma unroll
        for (int o = 1; o < 64; o <<= 1) { ss[0] += __shfl_xor(ss[0], o); ss[1] += __shfl_xor(ss[1], o); }
#pragma unroll
        for (int rr = 0; rr < 2; ++rr) { const int row = row0 + rr; const float rs = 1.0f / sqrtf(ss[rr] * (1.0f / DM) + EPS);
            const float* mod = WSP(float, WS_MOD) + ((size_t)l * 36 + row_bb(row)) * 6144 + (which ? 3072 : 0); bf16* o = WSP(bf16, WS_H) + (size_t)row * DM;
#pragma unroll
            for (int j = 0; j < 4; ++j) { const int c = lane * 4 + 256 * j; const f32x4 gg = *(const f32x4*)(g + c), sh = *(const f32x4*)(mod + c), sc = *(const f32x4*)(mod + 1024 + c);
                const f32x4 y = (v[rr][j] * rs) * gg * (sc + 1.0f) + sh; v2u w; w.x = pk2(y[0], y[1]); w.y = pk2(y[2], y[3]); *(v2u*)(o + c) = w; } }
    }
}
__device__ __forceinline__ void final_phase(Frame& F) {
    const int gw = F.bid * NWAVES + F.wave, NGW = F.G * NWAVES, lane = F.lane;
    const float* g = FIN(I_FNG);
    for (int row = gw; row < MT; row += NGW) {
        const bf16* xr = WSP(bf16, WS_X2) + (size_t)row * DM;
        f32x4 v[4]; float ss = 0.f;
#pragma unroll
        for (int j = 0; j < 4; ++j) { v[j] = ld4_bf(xr + lane * 4 + 256 * j); ss += (v[j][0] * v[j][0] + v[j][1] * v[j][1]) + (v[j][2] * v[j][2] + v[j][3] * v[j][3]); }
        const float rs = 1.0f / sqrtf(wave_sum(ss) * (1.0f / DM) + EPS);
        float* o = F.out + OUT_Y + (size_t)row * DM;
#pragma unroll
        for (int j = 0; j < 4; ++j) { const int c = lane * 4 + 256 * j; *(f32x4*)(o + c) = (v[j] * rs) * *(const f32x4*)(g + c); }
    }
}

#define EPI_LOOP_BEGIN \
    _Pragma("unroll") for (int ai = 0; ai < 2; ++ai) _Pragma("unroll") for (int m = 0; m < 4; ++m) { const int row = u.pm * 256 + ai * 128 + wr * 64 + m * 16 + fr; \
    _Pragma("unroll") for (int bj = 0; bj < 2; ++bj) { const int ct = bj * 128 + wc * 32 + 8 * fq; const f32x4 v0 = acc[ai][bj][m][0], v1 = acc[ai][bj][m][1];
#define EPI_LOOP_END } }

struct EpiWin {
    static constexpr bool PERM = true, AFTER_DRAIN = false;
    unsigned char* ws; float* out; int l;
    __device__ __forceinline__ void operator()(const f32x4 (&acc)[2][2][4][2], const pg8::Unit& u, int wr, int wc, int fr0, int fq0) const {
        int fr = fr0, fq = fq0; asm volatile("" : "+v"(fr), "+v"(fq));
        const int pn = u.pn;
        if (pn < 2) {
            bf16* QN = (bf16*)(ws + WS_QN);
            EPI_LOOP_BEGIN *(v4u*)(QN + (size_t)row * 512 + pn * 256 + ct) = pack8(v0 * QSCALE, v1 * QSCALE); EPI_LOOP_END
        } else if (pn < 5) {
            EPI_LOOP_BEGIN
                const int c = (pn - 2) * 256 + ct, j = c >> 7, k = (c >> 6) & 1, d = c & 63;
                const bool isp = row < PM; const int b = isp ? (row >> 12) : ((row - PM) >> 3), t = isp ? (row & (PT - 1)) : ((row - PM) & 7);
                if (j < 4) { float* o = out + (isp ? OUT_ROWS_P + ((size_t)l * PM + row) * 512 : OUT_ROWS_S + ((size_t)l * SM + (row - PM)) * 512) + c; *(f32x4*)o = v0; *(f32x4*)(o + 4) = v1; }
                else if (isp) { if (t >= PT - WINB) { float* o = out + OUT_WIN_P + (((size_t)l * PB + b) * WINB + (t - (PT - WINB))) * 256 + (c - 512); *(f32x4*)o = v0; *(f32x4*)(o + 4) = v1; } }
                else { float* o = out + OUT_WIN_S + (((size_t)l * SB + b) * WINB + (WINB - ST) + t) * 256 + (c - 512); *(f32x4*)o = v0; *(f32x4*)(o + 4) = v1; }
                const v4u w = pack8(v0, v1);
                if (isp) {
                    if (j < 2) *(v4u*)((bf16*)(ws + WS_ACMP) + ((size_t)(l * 2 + j) * CMP_ROWS_J + 32768 + (b * 2 + k) * 256) * 1024 + (size_t)t * 64 + d) = w;
                    else if (j & 1) {
                        const int tq = t & 31, s2 = tq >> 4, hh = (tq >> 2) & 1, ii = (tq & 3) + 4 * ((tq >> 3) & 1);
                        bf16* vt = (bf16*)(ws + WS_KVB) + (((size_t)(j - 2) * PB + b) * 2 + k) * PT * 64 + (size_t)(t >> 5) * 2048 + ((((d >> 5) * 2 + s2) * 2 + hh) * 32 + (d & 31)) * 8 + ii;
                        vt[0] = (bf16)(w.x & 0xffffu); vt[8] = (bf16)(w.x >> 16); vt[16] = (bf16)(w.y & 0xffffu); vt[24] = (bf16)(w.y >> 16);
                        vt[32] = (bf16)(w.z & 0xffffu); vt[40] = (bf16)(w.z >> 16); vt[48] = (bf16)(w.w & 0xffffu); vt[56] = (bf16)(w.w >> 16); }
                    else *(v4u*)((bf16*)(ws + WS_KVB) + (((size_t)(j - 2) * PB + b) * 2 + k) * PT * 64 + (size_t)(t >> 5) * 2048 + ((d >> 3) * 32 + (t & 31)) * 8) = w;
                } else if (j >= 2) *(v4u*)((bf16*)(ws + WS_KVS) + ((((size_t)(j - 2) * SB + b) * 2 + k) * ST + t) * 64 + d) = w;
            EPI_LOOP_END
        } else if (pn < 9) {
            const float* ROTC = (const float*)(ws + WS_ROT); const float* ROTS = ROTC + 4104 * 64;
#pragma unroll
            for (int ai = 0; ai < 2; ++ai) {
                f32x4 cs[4][2], sn[4][2];
#pragma unroll
                for (int m = 0; m < 4; ++m) { const int row = u.pm * 256 + ai * 128 + wr * 64 + m * 16 + fr; const int pi = row_pos(row);
#pragma unroll
                    for (int bj = 0; bj < 2; ++bj) { const int ct = bj * 128 + wc * 32 + 8 * fq; const int c = (pn - 5) * 256 + ct, d0 = (((c & 511) & 127) >> 3) * 4; cs[m][bj] = *(const f32x4*)(ROTC + pi * 64 + d0); sn[m][bj] = *(const f32x4*)(ROTS + pi * 64 + d0); } }
#pragma unroll
                for (int m = 0; m < 4; ++m) { const int row = u.pm * 256 + ai * 128 + wr * 64 + m * 16 + fr;
#pragma unroll
                    for (int bj = 0; bj < 2; ++bj) { const int ct = bj * 128 + wc * 32 + 8 * fq; const f32x4 v0 = acc[ai][bj][m][0], v1 = acc[ai][bj][m][1];
                        const int c = (pn - 5) * 256 + ct, isk = c >> 9, hc = c & 511, head = hc >> 7, d0 = ((hc & 127) >> 3) * 4;
                        const float sc = isk ? 0.08838834764831845f : 1.0f;
                        const f32x4 o1 = (v0 * cs[m][bj] - v1 * sn[m][bj]) * sc, o2 = (v0 * sn[m][bj] + v1 * cs[m][bj]) * sc;
                        bf16* o = (bf16*)(ws + WS_RQ) + (size_t)isk * MT * 512 + (size_t)row * 512 + head * 128 + d0;
                        v2u w1; w1.x = pk2(o1[0], o1[1]); w1.y = pk2(o1[2], o1[3]); *(v2u*)o = w1;
                        v2u w2; w2.x = pk2(o2[0], o2[1]); w2.y = pk2(o2[2], o2[3]); *(v2u*)(o + 64) = w2; } }
            }
        } else if (pn < 13) {
            bf16* RV = (bf16*)(ws + WS_RQ) + (size_t)2 * MT * 512;
            EPI_LOOP_BEGIN const int c = (pn - 9) * 256 + ct; *(v4u*)(RV + (size_t)(c >> 9) * MT * 512 + (size_t)row * 512 + (c & 511)) = pack8(v0, v1); EPI_LOOP_END
        } else if (pn < 15) {
            float* RX = (float*)(ws + WS_RX);
            EPI_LOOP_BEGIN
                const int c = (pn - 13) * 256 + ct; float* o = RX + (size_t)row * 512 + c; *(f32x4*)o = v0; *(f32x4*)(o + 4) = v1;
                if (row < PM) { const int t = row & (PT - 1); if (t >= PT - 3) { float* q = out + OUT_CV_P + (((size_t)l * PB + (row >> 12)) * 3 + (t - (PT - 3))) * 512 + c; *(f32x4*)q = v0; *(f32x4*)(q + 4) = v1; } }
                else { const int i = (row - PM) & 7; if (i >= ST - 3) { float* q = out + OUT_CV_S + (((size_t)l * SB + ((row - PM) >> 3)) * 3 + (i - (ST - 3))) * 512 + c; *(f32x4*)q = v0; *(f32x4*)(q + 4) = v1; } }
            EPI_LOOP_END
        } else if (pn < 17) {
            bf16* GG = (bf16*)(ws + WS_GG);
            EPI_LOOP_BEGIN const int c = (pn - 15) * 256 + ct;
                f32x4 a, b;
#pragma unroll
                for (int i = 0; i < 4; ++i) { a[i] = gelu_tanh(v0[i]); b[i] = gelu_tanh(v1[i]); }
                *(v4u*)(GG + (size_t)row * 512 + c) = pack8(a, b); EPI_LOOP_END
        } else if (pn < 29) {
            bf16* MG = (bf16*)(ws + WS_MGS);
            EPI_LOOP_BEGIN const int c = (pn - 17) * 256 + ct;
                f32x4 a, b;
#pragma unroll
                for (int i = 0; i < 4; ++i) { a[i] = sigmoidf_(v0[i]); b[i] = sigmoidf_(v1[i]); }
                *(v4u*)(MG + (size_t)row * 3072 + c) = pack8(a, b); EPI_LOOP_END
        } else {
            float* NG = (float*)(ws + WS_NG);
            EPI_LOOP_BEGIN if (ct < 24) { f32x4 a, b;
#pragma unroll
                for (int i = 0; i < 4; ++i) { a[i] = sigmoidf_(v0[i]); b[i] = sigmoidf_(v1[i]); }
                float* o = NG + (size_t)row * 24 + ct; *(f32x4*)o = a; *(f32x4*)(o + 4) = b; } EPI_LOOP_END
        }
    }
};

struct EpiLH {
    static constexpr bool PERM = true, AFTER_DRAIN = false;
    bf16* LH;
    __device__ __forceinline__ void operator()(const f32x4 (&acc)[2][2][4][2], const pg8::Unit& u, int wr, int wc, int fr0, int fq0) const {
        int fr = fr0, fq = fq0; asm volatile("" : "+v"(fr), "+v"(fq));
        EPI_LOOP_BEGIN *(v4u*)(LH + (size_t)row * 256 + ct) = pack8(v0, v1); EPI_LOOP_END
    }
};
struct CmpOrder {
    int G, c;
    __device__ bool next(int i, pg8::Unit& u) const { const int L = i * G + c; if (L >= CMP_ROWS / 256) return false; u.pm = L; u.pn = L / (CMP_ROWS_J / 256); return true; }
    __device__ __forceinline__ void a_ready(const pg8::Unit&) const {}
    __device__ __forceinline__ void done(const pg8::Unit&) const {}
};

template <int BR> struct EpiBr {
    static constexpr bool PERM = true, AFTER_DRAIN = false;
    unsigned char* ws;
    __device__ __forceinline__ void operator()(const f32x4 (&acc)[2][2][4][2], const pg8::Unit& u, int wr, int wc, int fr0, int fq0) const {
        int fr = fr0, fq = fq0; asm volatile("" : "+v"(fr), "+v"(fq));
        const bf16* MG = (const bf16*)(ws + WS_MGS); bf16* MR = (bf16*)(ws + WS_MRG);
        EPI_LOOP_BEGIN
            const int col = u.pn * 256 + ct; f32x4 g0, g1; unpack8(*(const v4u*)(MG + (size_t)row * 3072 + BR * 1024 + col), g0, g1);
            f32x4 r0 = v0 * g0, r1 = v1 * g1; bf16* o = MR + (size_t)row * DM + col;
            if (BR > 0) { f32x4 p0, p1; unpack8(*(const v4u*)o, p0, p1); r0 += p0; r1 += p1; }
            *(v4u*)o = pack8(r0, r1);
        EPI_LOOP_END
    }
};

struct BrOrder {
    pg8::StaticOrder S;
    __device__ bool next(int i, pg8::Unit& u) const { pg8::Unit t; if (!S.next(i / 3, t)) return false; const int br = i % 3; u.pm = br * (MT / 256) + t.pm; u.pn = br * 4 + t.pn; return true; }
    __device__ __forceinline__ void a_ready(const pg8::Unit&) const {}
    __device__ __forceinline__ void done(const pg8::Unit&) const {}
};
struct EpiBrAll {
    static constexpr bool PERM = true, AFTER_DRAIN = false;
    unsigned char* ws;
    __device__ __forceinline__ void operator()(const f32x4 (&acc)[2][2][4][2], const pg8::Unit& u0, int wr, int wc, int fr0, int fq0) const {
        int fr = fr0, fq = fq0; asm volatile("" : "+v"(fr), "+v"(fq));
        const int br = u0.pn >> 2; const pg8::Unit u{u0.pm - br * (MT / 256), u0.pn & 3};
        const bf16* MG = (const bf16*)(ws + WS_MGS) + br * 1024; bf16* MR = (bf16*)(ws + WS_MRG);
#pragma unroll
        for (int ai = 0; ai < 2; ++ai) {
            v4u gw[4][2], pw[4][2];
#pragma unroll
            for (int m = 0; m < 4; ++m) { const int row = u.pm * 256 + ai * 128 + wr * 64 + m * 16 + fr;
#pragma unroll
                for (int bj = 0; bj < 2; ++bj) { const int col = u.pn * 256 + bj * 128 + wc * 32 + 8 * fq; gw[m][bj] = *(const v4u*)(MG + (size_t)row * 3072 + col); if (br != 0) pw[m][bj] = *(const v4u*)(MR + (size_t)row * DM + col); } }
#pragma unroll
            for (int m = 0; m < 4; ++m) { const int row = u.pm * 256 + ai * 128 + wr * 64 + m * 16 + fr;
#pragma unroll
                for (int bj = 0; bj < 2; ++bj) { const int col = u.pn * 256 + bj * 128 + wc * 32 + 8 * fq; const f32x4 v0 = acc[ai][bj][m][0], v1 = acc[ai][bj][m][1];
                    f32x4 g0, g1; unpack8(gw[m][bj], g0, g1); f32x4 r0 = v0 * g0, r1 = v1 * g1;
                    if (br != 0) { f32x4 p0, p1; unpack8(pw[m][bj], p0, p1); r0 += p0; r1 += p1; }
                    *(v4u*)(MR + (size_t)row * DM + col) = pack8(r0, r1); } }
        }
    }
};

template <bool INF32> struct EpiRes {
    static constexpr bool PERM = true, AFTER_DRAIN = false;
    const void* xin_p; bf16* xout; const float* mod; int gofs;
    __device__ __forceinline__ void operator()(const f32x4 (&acc)[2][2][4][2], const pg8::Unit& u, int wr, int wc, int fr0, int fq0) const {
        int fr = fr0, fq = fq0; asm volatile("" : "+v"(fr), "+v"(fq));
#pragma unroll
        for (int ai = 0; ai < 2; ++ai) {
            const float* gp = mod + (size_t)row_bb(u.pm * 256 + ai * 128) * 6144 + gofs + u.pn * 256 + wc * 32 + 8 * fq;
            f32x4 g[2][2];
#pragma unroll
            for (int bj = 0; bj < 2; ++bj) { g[bj][0] = *(const f32x4*)(gp + 128 * bj); g[bj][1] = *(const f32x4*)(gp + 128 * bj + 4); }
            if (INF32) {
#pragma unroll
                for (int mh = 0; mh < 2; ++mh) {
                    f32x4 xv[2][2][2];
#pragma unroll
                    for (int m2 = 0; m2 < 2; ++m2) { const int row = u.pm * 256 + ai * 128 + wr * 64 + (2 * mh + m2) * 16 + fr;
#pragma unroll
                        for (int bj = 0; bj < 2; ++bj) { const float* xi = (const float*)xin_p + (size_t)row * DM + u.pn * 256 + bj * 128 + wc * 32 + 8 * fq; xv[m2][bj][0] = *(const f32x4*)xi; xv[m2][bj][1] = *(const f32x4*)(xi + 4); } }
#pragma unroll
                    for (int m2 = 0; m2 < 2; ++m2) { const int m = 2 * mh + m2; const int row = u.pm * 256 + ai * 128 + wr * 64 + m * 16 + fr;
#pragma unroll
                        for (int bj = 0; bj < 2; ++bj) { const int col = u.pn * 256 + bj * 128 + wc * 32 + 8 * fq;
                            *(v4u*)(xout + (size_t)row * DM + col) = pack8(xv[m2][bj][0] + g[bj][0] * acc[ai][bj][m][0], xv[m2][bj][1] + g[bj][1] * acc[ai][bj][m][1]); } }
                }
            } else {
                v4u xw[4][2];
#pragma unroll
                for (int m = 0; m < 4; ++m) { const int row = u.pm * 256 + ai * 128 + wr * 64 + m * 16 + fr;
#pragma unroll
                    for (int bj = 0; bj < 2; ++bj) xw[m][bj] = *(const v4u*)((const bf16*)xin_p + (size_t)row * DM + u.pn * 256 + bj * 128 + wc * 32 + 8 * fq); }
#pragma unroll
                for (int m = 0; m < 4; ++m) { const int row = u.pm * 256 + ai * 128 + wr * 64 + m * 16 + fr;
#pragma unroll
                    for (int bj = 0; bj < 2; ++bj) { const int col = u.pn * 256 + bj * 128 + wc * 32 + 8 * fq; f32x4 x0, x1; unpack8(xw[m][bj], x0, x1);
                        *(v4u*)(xout + (size_t)row * DM + col) = pack8(x0 + g[bj][0] * acc[ai][bj][m][0], x1 + g[bj][1] * acc[ai][bj][m][1]); } }
            }
        }
    }
};

struct EpiUp {
    static constexpr bool PERM = true, AFTER_DRAIN = false;
    unsigned char* ws; float* out; int l;
    __device__ __forceinline__ void operator()(const f32x4 (&acc)[2][2][4][2], const pg8::Unit& u, int wr, int wc, int fr0, int fq0) const {
        int fr = fr0, fq = fq0; asm volatile("" : "+v"(fr), "+v"(fq));
        bf16* GP = (bf16*)(ws + WS_GP); bf16* VAL = GP + (size_t)MT * DFF;
        if (u.pn < 11) {
            EPI_LOOP_BEGIN const int c = u.pn * 256 + ct; *(v4u*)(GP + (size_t)row * DFF + c) = pack8(v0, v1);
                if (row < PM) { const int t = row & (PT - 1); if (t >= PT - 2) { float* q = out + OUT_FC_P + (((size_t)l * PB + (row >> 12)) * 2 + (t - (PT - 2))) * DFF + c; *(f32x4*)q = v0; *(f32x4*)(q + 4) = v1; } }
                else { const int i = (row - PM) & 7; if (i >= ST - 2) { float* q = out + OUT_FC_S + (((size_t)l * SB + ((row - PM) >> 3)) * 2 + (i - (ST - 2))) * DFF + c; *(f32x4*)q = v0; *(f32x4*)(q + 4) = v1; } }
            EPI_LOOP_END
        } else {
            EPI_LOOP_BEGIN const int c = (u.pn - 11) * 256 + ct; *(v4u*)(VAL + (size_t)row * DFF + c) = pack8(v0, v1); EPI_LOOP_END
        }
    }
};

__device__ __forceinline__ f32x16 mfma32(bf16x8 a, bf16x8 b, f32x16 c) { return __builtin_amdgcn_mfma_f32_32x32x16_bf16(a, b, c, 0, 0, 0); }
__device__ __forceinline__ f32x4 mfma16(bf16x8 a, bf16x8 b, f32x4 c) { return __builtin_amdgcn_mfma_f32_16x16x32_bf16(a, b, c, 0, 0, 0); }
__device__ __forceinline__ float ret_log_g(int h) { return log1pf(-exp2f(-5.0f - (float)h)); }
__device__ __forceinline__ bf16x8 tr_frag(const LAS unsigned char* base, int rs_bytes, int rowA, int rowB, int colbase, int lane) {
    const int q = (lane & 15) >> 2, p = lane & 3;
    const LAS unsigned char* pa = base + (rowA + q) * rs_bytes + (colbase + 4 * p) * 2;
    const LAS unsigned char* pb = base + (rowB + q) * rs_bytes + (colbase + 4 * p) * 2;
    const s16x4 a = __builtin_bit_cast(s16x4, __builtin_amdgcn_ds_read_tr16_b64_v4i16((LAS s16x4*)pa));
    const s16x4 b = __builtin_bit_cast(s16x4, __builtin_amdgcn_ds_read_tr16_b64_v4i16((LAS s16x4*)pb));
    return (bf16x8){a[0], a[1], a[2], a[3], b[0], b[1], b[2], b[3]};
}
__device__ __forceinline__ bf16x8 cvt_frag(const f32x16& p, int s2) {
    u32x4 w; w.x = pk2(p[8 * s2 + 0], p[8 * s2 + 1]); w.y = pk2(p[8 * s2 + 2], p[8 * s2 + 3]); w.z = pk2(p[8 * s2 + 4], p[8 * s2 + 5]); w.w = pk2(p[8 * s2 + 6], p[8 * s2 + 7]);
    return __builtin_bit_cast(bf16x8, w);
}

__device__ __forceinline__ void cmp2_phase(Frame& F, int l) {
    const int gw = F.bid * NWAVES + F.wave, NGW = F.G * NWAVES, lane = F.lane, r = lane & 15, g = lane >> 4;
    const bf16* LH = WSP(bf16, WS_LH); bf16* CK = WSP(bf16, WS_CK);
    for (int wu = gw; wu < CMP_ROWS / 16; wu += NGW) {
        const int row0 = wu * 16, j = row0 / CMP_ROWS_J, rj = (row0 % CMP_ROWS_J) + r, row = row0 + r;
        const bool valid = (rj < 32768) ? ((rj & 511) < 511) : (((rj - 32768) & 255) < 255);
        const bf16* W2T = WSP(bf16, WS_SMALLW + SW_W2T) + (size_t)(l * 2 + j) * 64 * 128; const float* CB = WSP(float, WS_SMALLW + SW_CB) + (l * 2 + j) * 128;
        f32x4 acc[4];
#pragma unroll
        for (int ct = 0; ct < 4; ++ct) acc[ct] = (f32x4){0.f, 0.f, 0.f, 0.f};
#pragma unroll
        for (int ks = 0; ks < 4; ++ks) {
            const int h0 = 32 * ks + 8 * g; f32x4 a0, a1, b0, b1;
            unpack8(*(const v4u*)(LH + (size_t)row * 256 + h0), a0, a1); unpack8(*(const v4u*)(LH + (size_t)(row + 1) * 256 + 128 + h0), b0, b1);
            const f32x4 c0 = *(const f32x4*)(CB + h0), c1 = *(const f32x4*)(CB + h0 + 4);
            f32x4 x0 = a0 + b0 + c0, x1 = a1 + b1 + c1;
#pragma unroll
            for (int i = 0; i < 4; ++i) { x0[i] = gelu_tanh(x0[i]); x1[i] = gelu_tanh(x1[i]); }
            const bf16x8 hf = __builtin_bit_cast(bf16x8, pack8(x0, x1));
#pragma unroll
            for (int ct = 0; ct < 4; ++ct) { const bf16x8 wf = *(const bf16x8*)(W2T + (size_t)(16 * ct + r) * 128 + h0); acc[ct] = mfma16(wf, hf, acc[ct]); }
        }
#pragma unroll
        for (int ct = 0; ct < 4; ++ct) { const f32x4 v = valid ? acc[ct] : (f32x4){0.f, 0.f, 0.f, 0.f}; v2u w; w.x = pk2(v[0], v[1]); w.y = pk2(v[2], v[3]);
            *(v2u*)(CK + (size_t)row * 64 + 16 * ct + 4 * g) = w; }
    }
}

constexpr int CG_RS = 144, CG_BUF = 256 * CG_RS, CG_AW = 2 * CG_BUF, CG_AT = 32 * CG_RS;
static_assert(CG_AW + 2 * 4 * CG_AT <= RING_BYTES, "compress GEMM LDS map");
template <bool smp> __device__ __forceinline__ void cmp_gemm_unit(Frame& F, int l, int j, int grp, int n00) {
    const int tid = F.tid, lane = F.lane, w = F.wave, q = lane & 31, h_ = lane >> 5, rg = w >> 1, ch = w & 1;
    const float* rp[4]; const bf16* ab = nullptr;
    if (smp) { const int db = grp >> 1, k = grp & 1;
#pragma unroll
        for (int i = 0; i < 4; ++i) { const int tt0 = (n00 + 32 * rg + 16 * ch + 4 * i + (lane >> 4)) * 16; const int page = ((const int*)F.a->in[I_PT])[db * NPG + (tt0 >> 7)];
            rp[i] = FIN(I_CACHE) + (((((size_t)l * NPHYS + page) * PAGE + (tt0 & 127)) * 4 + j) * 2 + k) * 64 + (lane & 15) * 4; } }
    else {
        ab = WSP(bf16, WS_ACMP) + ((size_t)(l * 2 + j) * CMP_ROWS_J + 32768 + grp * 256 + n00 + 32 * rg + 16 * ch + (lane >> 3)) * 1024 + (lane & 7) * 8;
#pragma unroll
        for (int i = 0; i < 4; ++i) rp[i] = nullptr; }
    const bf16* Bg = WSP(bf16, WS_SMALLW + SW_W1T) + (size_t)(l * 2 + j) * 256 * 1024;
    f32x16 acc[4];
#pragma unroll
    for (int ct = 0; ct < 4; ++ct) acc[ct] = (f32x16){};
    const bf16* bsrc = Bg + (size_t)(tid >> 1) * 1024 + (tid & 1) * 32; LAS unsigned char* bdst = F.lds + (tid >> 1) * CG_RS + (tid & 1) * 64;
    v4u bst[2][4]; f32x4 an[4][4]; v4u anb[4][2];
    __syncthreads();
#pragma unroll
    for (int x = 0; x < 4; ++x) bst[0][x] = *(const v4u*)(bsrc + 8 * x);
#pragma unroll
    for (int x = 0; x < 4; ++x) bst[1][x] = *(const v4u*)(bsrc + 64 + 8 * x);
#pragma unroll
    for (int d = 0; d < 4; ++d) {
        if (smp) {
#pragma unroll
            for (int i = 0; i < 4; ++i) an[d][i] = __builtin_nontemporal_load((const f32x4*)(rp[i] + (size_t)d * 512)); }
        else {
#pragma unroll
            for (int i = 0; i < 2; ++i) anb[d][i] = *(const v4u*)(ab + (size_t)(8 * i) * 1024 + d * 64); } }
#pragma unroll
    for (int x = 0; x < 4; ++x) *(LAS v4u*)(bdst + x * 16) = bst[0][x];
#define CG_CHUNK(d, LAST_) { const int kc = kc4 + (d); \
            LAS unsigned char* At = F.lds + CG_AW + (((d) & 1) * 4 + rg) * CG_AT; \
            if (!(LAST_) || (d) < 2) {                                   \
                _Pragma("unroll") for (int x = 0; x < 4; ++x) bst[(d) & 1][x] = *(const v4u*)(bsrc + (kc + 2) * 64 + 8 * x); } \
            if (smp) { \
                _Pragma("unroll") for (int i = 0; i < 4; ++i) { v2u o; o.x = pk2(an[d][i][0], an[d][i][1]); o.y = pk2(an[d][i][2], an[d][i][3]); *(LAS v2u*)(At + (16 * ch + 4 * i + (lane >> 4)) * CG_RS + (lane & 15) * 8) = o; } \
                if (!(LAST_)) { _Pragma("unroll") for (int i = 0; i < 4; ++i) an[d][i] = __builtin_nontemporal_load((const f32x4*)(rp[i] + (size_t)(kc + 4) * 512)); } \
            } else { \
                _Pragma("unroll") for (int i = 0; i < 2; ++i) *(LAS v4u*)(At + (16 * ch + 8 * i + (lane >> 3)) * CG_RS + (lane & 7) * 16) = anb[d][i]; \
                if (!(LAST_)) { _Pragma("unroll") for (int i = 0; i < 2; ++i) anb[d][i] = *(const v4u*)(ab + (size_t)(8 * i) * 1024 + (kc + 4) * 64); } \
            } \
            __syncthreads();                                           \
            bf16x8 ac[4]; \
            _Pragma("unroll") for (int ks = 0; ks < 4; ++ks) ac[ks] = *(const LAS bf16x8*)(At + q * CG_RS + ks * 32 + 16 * h_); \
            const LAS unsigned char* bb = F.lds + ((d) & 1) * CG_BUF + (128 * ch + q) * CG_RS + 16 * h_; \
            _Pragma("unroll") for (int ks = 0; ks < 4; ++ks) \
                _Pragma("unroll") for (int ct = 0; ct < 4; ++ct) { const bf16x8 bf = *(const LAS bf16x8*)(bb + ct * 32 * CG_RS + ks * 32); acc[ct] = mfma32(bf, ac[ks], acc[ct]); } \
            if (!(LAST_) || (d) < 3) { _Pragma("unroll") for (int x = 0; x < 4; ++x) *(LAS v4u*)(bdst + (((d) + 1) & 1) * CG_BUF + x * 16) = bst[((d) + 1) & 1][x]; } }
    int kc4 = 0;
#pragma unroll 1
    for (; kc4 < 12; kc4 += 4) { CG_CHUNK(0, false) CG_CHUNK(1, false) CG_CHUNK(2, false) CG_CHUNK(3, false) }
    { CG_CHUNK(0, true) CG_CHUNK(1, true) CG_CHUNK(2, true) CG_CHUNK(3, true) }
#undef CG_CHUNK
    bf16* LH = WSP(bf16, WS_LH) + ((size_t)j * CMP_ROWS_J + (smp ? grp * 512 : 32768 + grp * 256) + n00 + 32 * rg + q) * 256 + 128 * ch;
#pragma unroll
    for (int ct = 0; ct < 4; ++ct)
#pragma unroll
        for (int r4 = 0; r4 < 4; ++r4) { v2u o; o.x = pk2(acc[ct][4 * r4 + 0], acc[ct][4 * r4 + 1]); o.y = pk2(acc[ct][4 * r4 + 2], acc[ct][4 * r4 + 3]); *(v2u*)(LH + ct * 32 + 8 * r4 + 4 * h_) = o; }
}

constexpr int RS_KV = 272;
__device__ __forceinline__ void ret_local_unit(Frame& F, int unit) {
    const int bh = unit >> 5, c = unit & 31, b = bh >> 2, h = bh & 3, lane = F.lane, w = F.wave;
    const float lg = ret_log_g(h);
    LAS unsigned char* KS = F.lds; LAS unsigned char* VS = F.lds + 128 * RS_KV;
    const bf16* RK = WSP(bf16, WS_RQ) + (size_t)MT * 512; const bf16* RV = WSP(bf16, WS_RQ) + (size_t)2 * MT * 512;
    __syncthreads();
#pragma unroll
    for (int i = 0; i < 4; ++i) { const int p = F.tid + NTHR * i, j = p >> 4, ch = p & 15; const size_t go = (size_t)(b * PT + 128 * c + j) * 512 + h * 128 + ch * 8;
        f32x4 k0, k1; unpack8(*(const v4u*)(RK + go), k0, k1); const float kw = fexp((float)(127 - j) * lg);
        *(LAS v4u*)(KS + j * RS_KV + ch * 16) = pack8(k0 * kw, k1 * kw);
        *(LAS v4u*)(VS + j * RS_KV + ch * 16) = *(const v4u*)(RV + go); }
    __syncthreads();
    const int et = w >> 1, dt0 = 2 * (w & 1), h_ = lane >> 5, blk = (lane >> 4) & 1;
    f32x16 acc[2]; acc[0] = (f32x16){}; acc[1] = (f32x16){};
#pragma unroll
    for (int ks = 0; ks < 8; ++ks) {
        const int rA = 16 * ks + 8 * h_;
        const bf16x8 af = tr_frag(VS, RS_KV, rA, rA + 4, 32 * et + 16 * blk, lane);
#pragma unroll
        for (int dd = 0; dd < 2; ++dd) { const bf16x8 bfr = tr_frag(KS, RS_KV, rA, rA + 4, 32 * (dt0 + dd) + 16 * blk, lane); acc[dd] = mfma32(af, bfr, acc[dd]); }
    }
    float* LT = WSP(float, WS_LT) + ((size_t)bh * 32 + c) * 16384;
#pragma unroll
    for (int dd = 0; dd < 2; ++dd)
#pragma unroll
        for (int r = 0; r < 16; ++r) { const int e = 32 * et + (r & 3) + 8 * (r >> 2) + 4 * h_; LT[e * 128 + 32 * (dt0 + dd) + (lane & 31)] = acc[dd][r]; }
}
__device__ __forceinline__ void ret_scan_phase(Frame& F, int l) {
    const float* LT = WSP(float, WS_LT); bf16* SPT = WSP(bf16, WS_SPT);
    for (int idx = F.bid * NTHR + F.tid; idx < 16 * 16384; idx += F.G * NTHR) {
        const int bh = idx >> 14, ed = idx & 16383, e = ed >> 7, d = ed & 127, h = bh & 3; const float g128 = fexp(128.0f * ret_log_g(h));
        float S = 0.f;
        for (int c = 0; c < 32; ++c) { const size_t o = ((size_t)bh * 32 + c) * 16384 + ed; SPT[o] = (bf16)(pk2(S, 0.f) & 0xffffu); S = S * g128 + LT[o]; }
        F.out[OUT_RET_P + ((size_t)l * 16 + bh) * 16384 + d * 128 + e] = S;
    }
}
__device__ __forceinline__ void ret_out_unit(Frame& F, int l, int unit) {
    const int bh = unit >> 5, c = unit & 31, b = bh >> 2, h = bh & 3, lane = F.lane, w = F.wave, tid = F.tid;
    const float lg = ret_log_g(h);
    LAS unsigned char* KS = F.lds; LAS unsigned char* VS = F.lds + 128 * RS_KV; LAS float* OT = (LAS float*)F.lds; LAS float* STAT = (LAS float*)(F.lds + 2 * 128 * RS_KV);
    const bf16* RQ = WSP(bf16, WS_RQ); const bf16* RK = RQ + (size_t)MT * 512; const bf16* RV = RQ + (size_t)2 * MT * 512; const bf16* RG = RQ + (size_t)3 * MT * 512;
    const size_t row0 = (size_t)b * PT + 128 * c;
    __syncthreads();
#pragma unroll
    for (int i = 0; i < 4; ++i) { const int p = tid + NTHR * i, j = p >> 4, ch = p & 15; const size_t go = (row0 + j) * 512 + h * 128 + ch * 8;
        *(LAS v4u*)(KS + j * RS_KV + ch * 16) = *(const v4u*)(RK + go); *(LAS v4u*)(VS + j * RS_KV + ch * 16) = *(const v4u*)(RV + go); }
    const int it = w & 3, eh = w >> 2, h_ = lane >> 5, blk = (lane >> 4) & 1, il = 32 * it + (lane & 31);
    bf16x8 qf[8];
#pragma unroll
    for (int ks = 0; ks < 8; ++ks) qf[ks] = *(const bf16x8*)(RQ + (row0 + il) * 512 + h * 128 + 16 * ks + 8 * h_);
    f32x16 acc[2]; acc[0] = (f32x16){}; acc[1] = (f32x16){};
    const bf16* SP = WSP(bf16, WS_SPT) + ((size_t)bh * 32 + c) * 16384;
#pragma unroll
    for (int kb4 = 0; kb4 < 8; kb4 += 4) {
        bf16x8 af[4][2];
#pragma unroll
        for (int ks = 0; ks < 4; ++ks)
#pragma unroll
            for (int e2 = 0; e2 < 2; ++e2) af[ks][e2] = *(const bf16x8*)(SP + (size_t)(32 * (2 * eh + e2) + (lane & 31)) * 128 + 16 * (kb4 + ks) + 8 * h_);
#pragma unroll
        for (int ks = 0; ks < 4; ++ks)
#pragma unroll
            for (int e2 = 0; e2 < 2; ++e2) acc[e2] = mfma32(af[ks][e2], qf[kb4 + ks], acc[e2]);
    }
    { const float cr = fexp((float)(il + 1) * lg); acc[0] *= cr; acc[1] *= cr; }
    __syncthreads();
    for (int jt = 0; jt <= it; ++jt) {
        f32x16 s = (f32x16){};
#pragma unroll
        for (int ks = 0; ks < 8; ++ks) { const bf16x8 kf = *(const LAS bf16x8*)(KS + (32 * jt + (lane & 31)) * RS_KV + (16 * ks + 8 * h_) * 2); s = mfma32(kf, qf[ks], s); }
#pragma unroll
        for (int r = 0; r < 16; ++r) { const int j = 32 * jt + (r & 3) + 8 * (r >> 2) + 4 * h_; const int df = il - j; s[r] = (df >= 0) ? s[r] * fexp((float)df * lg) : 0.f; }
#pragma unroll
        for (int s2 = 0; s2 < 2; ++s2) { const bf16x8 pf = cvt_frag(s, s2); const int rA = 32 * jt + 16 * s2 + 4 * h_;
#pragma unroll
            for (int e2 = 0; e2 < 2; ++e2) { const bf16x8 vf = tr_frag(VS, RS_KV, rA, rA + 8, 32 * (2 * eh + e2) + 16 * blk, lane); acc[e2] = mfma32(vf, pf, acc[e2]); } }
    }
    float s1 = 0.f, s2 = 0.f;
#pragma unroll
    for (int e2 = 0; e2 < 2; ++e2)
#pragma unroll
        for (int r = 0; r < 16; ++r) { const float v = acc[e2][r]; s1 += v; s2 += v * v; }
    s1 += __shfl_xor(s1, 32); s2 += __shfl_xor(s2, 32);
    if (lane < 32) { STAT[(w * 32 + lane) * 2] = s1; STAT[(w * 32 + lane) * 2 + 1] = s2; }
    __syncthreads();
    { const int pw = w ^ 4; s1 += STAT[(pw * 32 + (lane & 31)) * 2]; s2 += STAT[(pw * 32 + (lane & 31)) * 2 + 1]; }
    const float mean = s1 * (1.0f / 128.0f), var = fmaxf(s2 * (1.0f / 128.0f) - mean * mean, 0.f), rstd = 1.0f / sqrtf(var + EPS);
#pragma unroll
    for (int e2 = 0; e2 < 2; ++e2)
#pragma unroll
        for (int r4 = 0; r4 < 4; ++r4) { const int e = 32 * (2 * eh + e2) + 8 * r4 + 4 * h_;
            f32x4 v; v[0] = (acc[e2][4 * r4 + 0] - mean) * rstd; v[1] = (acc[e2][4 * r4 + 1] - mean) * rstd; v[2] = (acc[e2][4 * r4 + 2] - mean) * rstd; v[3] = (acc[e2][4 * r4 + 3] - mean) * rstd;
            *(LAS f32x4*)(OT + il * 132 + e) = v; }
    __syncthreads();
    const float* GN = FIN(I_GNG) + l * 512 + h * 128; bf16* OR_ = WSP(bf16, WS_OA) + (size_t)MT * 512;
#pragma unroll
    for (int k = 0; k < 4; ++k) { const int q = tid + NTHR * k, i = q >> 4, ch = q & 15;
        const f32x4 o0 = *(const LAS f32x4*)(OT + i * 132 + 8 * ch), o1 = *(const LAS f32x4*)(OT + i * 132 + 8 * ch + 4);
        const f32x4 g0 = *(const f32x4*)(GN + 8 * ch), g1 = *(const f32x4*)(GN + 8 * ch + 4); f32x4 r0, r1; unpack8(*(const v4u*)(RG + (row0 + i) * 512 + h * 128 + 8 * ch), r0, r1);
        f32x4 y0, y1;
#pragma unroll
        for (int x = 0; x < 4; ++x) { y0[x] = o0[x] * g0[x] * siluf_(r0[x]); y1[x] = o1[x] * g1[x] * siluf_(r1[x]); }
        *(v4u*)(OR_ + (row0 + i) * 512 + h * 128 + 8 * ch) = pack8(y0, y1); }
}
__device__ __forceinline__ void ret_sample_unit(Frame& F, int l, int unit) {
    const int db = unit >> 2, h = unit & 3, tid = F.tid, e = tid & 127, dp = tid >> 7;
    const float lg = ret_log_g(h);
    LAS float* Q = (LAS float*)F.lds; LAS float* K = Q + 1024; LAS float* V = K + 1024; LAS float* GT = V + 1024; LAS float* CR = GT + 1024;
    LAS float* SC = CR + 4096; LAS float* RED = SC + 64;
    const bf16* RQ = WSP(bf16, WS_RQ); const size_t row0 = (size_t)PM + db * 8;
    __syncthreads();
    for (int i = tid; i < 4096; i += NTHR) { const int which = i >> 10, r = (i >> 7) & 7, d = i & 127; const float v = bf1(RQ[(size_t)which * MT * 512 + (row0 + r) * 512 + h * 128 + d]); Q[which * 1024 + r * 128 + d] = v; }
    __syncthreads();
    const float* S0 = FIN(I_SRET) + (((size_t)l * SB + db) * 4 + h) * 16384; float* SN = F.out + OUT_RET_S + (((size_t)l * SB + db) * 4 + h) * 16384;
    float kwv[8], cr[8];
#pragma unroll
    for (int j = 0; j < 8; ++j) { kwv[j] = V[j * 128 + e] * fexp((float)(7 - j) * lg); cr[j] = 0.f; }
    const float g8 = fexp(8.0f * lg);
    for (int d = dp * 32; d < dp * 32 + 32; ++d) {
        const float s0 = S0[d * 128 + e]; float sn = g8 * s0;
#pragma unroll
        for (int j = 0; j < 8; ++j) { cr[j] += Q[j * 128 + d] * s0; sn += K[j * 128 + d] * kwv[j]; }
        SN[d * 128 + e] = sn;
    }
#pragma unroll
    for (int i = 0; i < 8; ++i) CR[(dp * 8 + i) * 128 + e] = cr[i];
    if (tid < 64) { const int i = tid >> 3, j = tid & 7; float s = 0.f; if (j <= i) { for (int d = 0; d < 128; ++d) s += Q[i * 128 + d] * K[j * 128 + d]; s *= fexp((float)(i - j) * lg); } SC[tid] = s; }
    __syncthreads();
    float o[2];
#pragma unroll
    for (int ii = 0; ii < 2; ++ii) { const int i = 2 * dp + ii; float x = (CR[(0 * 8 + i) * 128 + e] + CR[(1 * 8 + i) * 128 + e] + CR[(2 * 8 + i) * 128 + e] + CR[(3 * 8 + i) * 128 + e]) * fexp((float)(i + 1) * lg);
        for (int j = 0; j <= i; ++j) x += SC[i * 8 + j] * V[j * 128 + e];
        o[ii] = x; }
#pragma unroll
    for (int ii = 0; ii < 2; ++ii) { const float a = wave_sum(o[ii]), q = wave_sum(o[ii] * o[ii]); if (F.lane == 0) { RED[(F.wave * 2 + ii) * 2] = a; RED[(F.wave * 2 + ii) * 2 + 1] = q; } }
    __syncthreads();
    const float* GN = FIN(I_GNG) + l * 512 + h * 128; bf16* OR_ = WSP(bf16, WS_OA) + (size_t)MT * 512;
#pragma unroll
    for (int ii = 0; ii < 2; ++ii) { const int i = 2 * dp + ii, w0 = 2 * dp; const float s1 = RED[(w0 * 2 + ii) * 2] + RED[((w0 + 1) * 2 + ii) * 2], s2 = RED[(w0 * 2 + ii) * 2 + 1] + RED[((w0 + 1) * 2 + ii) * 2 + 1];
        const float mean = s1 * (1.0f / 128.0f), var = fmaxf(s2 * (1.0f / 128.0f) - mean * mean, 0.f), rstd = 1.0f / sqrtf(var + EPS);
        const float y = (o[ii] - mean) * rstd * GN[e] * siluf_(GT[i * 128 + e]);
        OR_[(row0 + i) * 512 + h * 128 + e] = (bf16)(pk2(y, 0.f) & 0xffffu); }
}

template <int MODE> __device__ __forceinline__ void rglru_unit(Frame& F, int l, int unit) {
    const int tid = F.tid, c = tid, lane = F.lane, w = F.wave;
    LAS bf16* XC = (LAS bf16*)F.lds; LAS float* G = (LAS float*)(F.lds + 16384);
    const int seq = (MODE == 2) ? unit : (unit >> 6), tile = (MODE == 2) ? 0 : (unit & 63);
    const size_t row0 = (MODE == 2) ? (size_t)PM + seq * 8 : (size_t)seq * PT + tile * 64;
    const int ntok = (MODE == 2) ? 8 : 64, nsub = (MODE == 2) ? 1 : 4;
    const float* RX = WSP(float, WS_RX);
    const float w0 = FIN(I_RCW)[(l * 4 + 0) * 512 + c], w1 = FIN(I_RCW)[(l * 4 + 1) * 512 + c], w2 = FIN(I_RCW)[(l * 4 + 2) * 512 + c], w3 = FIN(I_RCW)[(l * 4 + 3) * 512 + c], cb = FIN(I_RCB)[l * 512 + c];
    const float ba = FIN(I_RBA)[l * 512 + c], bx = FIN(I_RBX)[l * 512 + c], sp = WSP(float, WS_SMALLW + SW_SP)[l * 512 + c];
    float x3, x2, x1;
    if (MODE == 2) { const float* cv = FIN(I_SCONV) + ((size_t)l * SB + seq) * 3 * 512; x3 = cv[c]; x2 = cv[512 + c]; x1 = cv[1024 + c]; }
    else if (tile == 0) { x3 = 0.f; x2 = 0.f; x1 = 0.f; }
    else { x3 = RX[(row0 - 3) * 512 + c]; x2 = RX[(row0 - 2) * 512 + c]; x1 = RX[(row0 - 1) * 512 + c]; }
    float h = (MODE == 0) ? 0.f : (MODE == 1) ? WSP(float, WS_CAR)[(size_t)4 * 64 * 2 * 512 + ((size_t)seq * 64 + tile) * 512 + c] : FIN(I_SH)[((size_t)l * SB + seq) * 512 + c];
    float aprod = 1.f;
    const int r16 = lane & 15, g4 = lane >> 4;
    bf16x8 wa[4][2], wx[4][2];
    { const bf16* WA = WSP(bf16, WS_SMALLW + SW_WAT) + ((size_t)(l * 2 + 0) * 8 + w) * 4096; const bf16* WX = WSP(bf16, WS_SMALLW + SW_WAT) + ((size_t)(l * 2 + 1) * 8 + w) * 4096;
#pragma unroll
      for (int ct = 0; ct < 4; ++ct)
#pragma unroll
          for (int ks = 0; ks < 2; ++ks) { wa[ct][ks] = *(const bf16x8*)(WA + (16 * ct + r16) * 64 + 32 * ks + 8 * g4); wx[ct][ks] = *(const bf16x8*)(WX + (16 * ct + r16) * 64 + 32 * ks + 8 * g4); } }
    const bf16* GG = WSP(bf16, WS_GG); bf16* OC = WSP(bf16, WS_OA) + (size_t)2 * MT * 512;
    __syncthreads();
    float xn[16]; bf16 gn[16];
#pragma unroll
    for (int tt = 0; tt < 16; ++tt) { xn[tt] = (tt < ntok) ? RX[(row0 + tt) * 512 + c] : 0.f; gn[tt] = (MODE != 0 && tt < ntok) ? GG[(row0 + tt) * 512 + c] : (bf16)0; }
    for (int s = 0; s < nsub; ++s) {
        float xc[16], gg[16];
#pragma unroll
        for (int tt = 0; tt < 16; ++tt) { xc[tt] = xn[tt]; gg[tt] = bf1(gn[tt]); }
        if (s + 1 < nsub) {
#pragma unroll
            for (int tt = 0; tt < 16; ++tt) { const int t = (s + 1) * 16 + tt; xn[tt] = RX[(row0 + t) * 512 + c]; gn[tt] = (MODE != 0) ? GG[(row0 + t) * 512 + c] : (bf16)0; } }
#pragma unroll
        for (int tt = 0; tt < 16; ++tt) { const float x0 = xc[tt];
            xc[tt] = cb + w0 * x3 + w1 * x2 + w2 * x1 + w3 * x0; x3 = x2; x2 = x1; x1 = x0; XC[tt * 512 + c] = (bf16)(pk2(xc[tt], 0.f) & 0xffffu); }
        LDS_WAIT(); asm volatile("" ::: "memory");
        {
            bf16x8 xf[2];
#pragma unroll
            for (int ks = 0; ks < 2; ++ks) xf[ks] = *(const LAS bf16x8*)(XC + r16 * 512 + w * 64 + 32 * ks + 8 * g4);
#pragma unroll
            for (int ct = 0; ct < 4; ++ct) { f32x4 da = (f32x4){0.f, 0.f, 0.f, 0.f}, dx = da;
#pragma unroll
                for (int ks = 0; ks < 2; ++ks) { da = mfma16(wa[ct][ks], xf[ks], da); dx = mfma16(wx[ct][ks], xf[ks], dx); }
                *(LAS f32x4*)(G + r16 * 512 + w * 64 + 16 * ct + 4 * g4) = da; *(LAS f32x4*)(G + 8192 + r16 * 512 + w * 64 + 16 * ct + 4 * g4) = dx; }
        }
        LDS_WAIT(); asm volatile("" ::: "memory");
#pragma unroll
        for (int tt = 0; tt < 16; ++tt) { const int t = s * 16 + tt;
            if (t < ntok) {
                const float r = sigmoidf_(G[tt * 512 + c] + ba), ig = sigmoidf_(G[8192 + tt * 512 + c] + bx);
                const float la = -8.0f * r * sp, a = fexp(la), bt = sqrtf(fmaxf(1.0f - a * a, 0.f)) * (ig * xc[tt]);
                h = a * h + bt; aprod *= a;
                if (MODE != 0) { const size_t o = (row0 + t) * 512 + c; OC[o] = (bf16)(pk2(h * gg[tt], 0.f) & 0xffffu); }
            } }
    }
    if (MODE == 0) { float* CAR = WSP(float, WS_CAR) + ((size_t)seq * 64 + tile) * 1024; CAR[c] = aprod; CAR[512 + c] = h; }
    if (MODE == 2) F.out[OUT_H_S + ((size_t)l * SB + seq) * 512 + c] = h;
}
__device__ __forceinline__ void rglru_carry_phase(Frame& F, int l) {
    const float* CAR = WSP(float, WS_CAR); float* HIN = WSP(float, WS_CAR) + (size_t)4 * 64 * 2 * 512;
    for (int idx = F.bid * NTHR + F.tid; idx < PB * 512; idx += F.G * NTHR) {
        const int b = idx >> 9, c = idx & 511; float h = 0.f;
        for (int t = 0; t < 64; ++t) { HIN[((size_t)b * 64 + t) * 512 + c] = h; const float* cr = CAR + ((size_t)b * 64 + t) * 1024; h = cr[c] * h + cr[512 + c]; }
        F.out[OUT_H_P + ((size_t)l * PB + b) * 512 + c] = h;
    }
}

__device__ __forceinline__ void convact_phase(Frame& F, int l) {
    const bf16* GP = WSP(bf16, WS_GP); const bf16* VAL = GP + (size_t)MT * DFF; bf16* ACT = WSP(bf16, WS_GP) + (size_t)2 * MT * DFF;
    const float* CW = FIN(I_FCW) + (size_t)l * 3 * DFF; const float* CBI = FIN(I_FCB) + (size_t)l * DFF;
    constexpr int NRUN = PM / 16 + SB, NCG = DFF / 8;
    for (int it = F.bid * NTHR + F.tid; it < NRUN * NCG; it += F.G * NTHR) {
        const int run = it / NCG, cg = it % NCG, c = cg * 8;
        const bool isp = run < PM / 16; const size_t row0 = isp ? (size_t)run * 16 : (size_t)PM + (run - PM / 16) * 8; const int nt = isp ? 16 : 8;
        f32x4 p2a, p2b, p1a, p1b;
        if (isp) { if ((run & 255) == 0) { p2a = p2b = p1a = p1b = (f32x4){0.f, 0.f, 0.f, 0.f}; } else { unpack8(*(const v4u*)(GP + (row0 - 2) * DFF + c), p2a, p2b); unpack8(*(const v4u*)(GP + (row0 - 1) * DFF + c), p1a, p1b); } }
        else { const float* st = FIN(I_SFFN) + (((size_t)l * SB + (run - PM / 16)) * 2) * DFF + c; p2a = *(const f32x4*)st; p2b = *(const f32x4*)(st + 4); p1a = *(const f32x4*)(st + DFF); p1b = *(const f32x4*)(st + DFF + 4); }
        const f32x4 w0a = *(const f32x4*)(CW + c), w0b = *(const f32x4*)(CW + c + 4), w1a = *(const f32x4*)(CW + DFF + c), w1b = *(const f32x4*)(CW + DFF + c + 4), w2a = *(const f32x4*)(CW + 2 * DFF + c), w2b = *(const f32x4*)(CW + 2 * DFF + c + 4);
        const f32x4 ba = *(const f32x4*)(CBI + c), bb = *(const f32x4*)(CBI + c + 4);
        for (int t0 = 0; t0 < nt; t0 += 8) {
            v4u gx[8], vx[8];
#pragma unroll
            for (int k = 0; k < 8; ++k) { gx[k] = *(const v4u*)(GP + (row0 + t0 + k) * DFF + c); vx[k] = *(const v4u*)(VAL + (row0 + t0 + k) * DFF + c); }
#pragma unroll
            for (int k = 0; k < 8; ++k) {
                f32x4 xa, xb, va, vb; unpack8(gx[k], xa, xb); unpack8(vx[k], va, vb);
                f32x4 ya = ba + w0a * p2a + w1a * p1a + w2a * xa, yb = bb + w0b * p2b + w1b * p1b + w2b * xb;
#pragma unroll
                for (int i = 0; i < 4; ++i) { ya[i] = siluf_(ya[i]) * va[i]; yb[i] = siluf_(yb[i]) * vb[i]; }
                *(v4u*)(ACT + (row0 + t0 + k) * DFF + c) = pack8(ya, yb);
                p2a = p1a; p2b = p1b; p1a = xa; p1b = xb;
            }
        }
    }
}

constexpr int AT_RS = 144;
constexpr int AT_K0 = 0, AT_V0 = 2 * 64 * AT_RS, AT_PS = 4 * 64 * AT_RS, AT_IMP = AT_PS + 69632, AT_MASK = AT_IMP + 6144, AT_LIST = AT_MASK + 2048, AT_NL = AT_LIST + 1024;
constexpr unsigned AT_MARK = 0xFFFFu;
static_assert(AT_NL + 64 <= RING_BYTES, "attention LDS map");

struct TileRegs { v4u a, b, c, d; int mode; };

template <bool SMP> __device__ __forceinline__ void at_prefetch(const Frame& F, int l, int seq, int kvh, unsigned e, TileRegs& R) {
    const int kind = (int)(e >> 14), ti = (int)(e & 0x3fffu), rr = F.tid >> 3, pc = F.tid & 7;
    R.mode = 0;
    if (kind < 2) {
        const size_t rb = SMP ? (size_t)(seq * 2 + kvh) * 512 : (size_t)32768 + (size_t)(seq * 2 + kvh) * 256;
        const bf16* ck = WSP(bf16, WS_CK) + (rb + ti * 64 + rr) * 64 + pc * 8;
        R.a = *(const v4u*)ck; R.c = *(const v4u*)(ck + (size_t)CMP_ROWS_J * 64);
    } else if (!SMP) {
        const int jb = (kind == 2) ? 0 : 2;
        const bf16* kp = WSP(bf16, WS_KVB) + ((((size_t)jb * PB + seq) * 2 + kvh) * PT + ti * 64 + rr) * 64 + pc * 8;
        R.a = *(const v4u*)kp; R.c = *(const v4u*)(kp + (size_t)PB * 2 * PT * 64);
    } else if (kind == 2) {
        if (ti < 128) {
            const int page = ((const int*)F.a->in[I_PT])[seq * NPG + (ti >> 1)], slot = (ti & 1) * 64 + rr;
            const float* kp = FIN(I_CACHE) + (((((size_t)l * NPHYS + page) * PAGE + slot) * 4 + 2) * 2 + kvh) * 64 + pc * 8;
            R.a = *(const v4u*)kp; R.b = *(const v4u*)(kp + 4); R.c = *(const v4u*)(kp + 128); R.d = *(const v4u*)(kp + 132); R.mode = 1;
        } else if (rr < ST) {
            const bf16* kp = WSP(bf16, WS_KVS) + ((((size_t)0 * SB + seq) * 2 + kvh) * ST + rr) * 64 + pc * 8;
            R.a = *(const v4u*)kp; R.c = *(const v4u*)(kp + (size_t)SB * 2 * ST * 64);
        } else R.mode = 2;
    } else {
        if (ti < 8) {
            const float* kp = FIN(I_CWIN) + (((((size_t)l * SB + seq) * WINB + ti * 64 + rr) * 2 + 0) * 2 + kvh) * 64 + pc * 8;
            R.a = *(const v4u*)kp; R.b = *(const v4u*)(kp + 4); R.c = *(const v4u*)(kp + 128); R.d = *(const v4u*)(kp + 132); R.mode = 1;
        } else if (rr < ST) {
            const bf16* kp = WSP(bf16, WS_KVS) + ((((size_t)2 * SB + seq) * 2 + kvh) * ST + rr) * 64 + pc * 8;
            R.a = *(const v4u*)kp; R.c = *(const v4u*)(kp + (size_t)SB * 2 * ST * 64);
        } else R.mode = 2;
    }
}
__device__ __forceinline__ void at_store(const Frame& F, int buf, const TileRegs& R) {
    const int rr = F.tid >> 3, pc = F.tid & 7; v4u k, v;
    if (R.mode == 0) { k = R.a; v = R.c; }
    else if (R.mode == 1) { k = pack8(__builtin_bit_cast(f32x4, R.a), __builtin_bit_cast(f32x4, R.b)); v = pack8(__builtin_bit_cast(f32x4, R.c), __builtin_bit_cast(f32x4, R.d)); }
    else { k = (v4u){0u, 0u, 0u, 0u}; v = k; }
    *(LAS v4u*)(F.lds + AT_K0 + buf * 64 * AT_RS + rr * AT_RS + pc * 16) = k;
    *(LAS v4u*)(F.lds + AT_V0 + buf * 64 * AT_RS + rr * AT_RS + pc * 16) = v;
}

template <bool SMP> __device__ __forceinline__ void attn_unit(Frame& F, int l, int unit) {
    const int tid = F.tid, lane = F.lane, w = F.wave;
    const int q = lane & 31, h_ = lane >> 5, blk = (lane >> 4) & 1, tl = q >> 2, hr = q & 3;
    int seq, kvh, qt;
    if (SMP) { seq = unit >> 1; kvh = unit & 1; qt = 128; } else { seq = unit >> 7; kvh = (unit >> 6) & 1; qt = unit & 63; }
    const int t0 = SMP ? PAST : qt * 64;
    const int tokl = SMP ? tl : 8 * w + tl, t = t0 + tokl;
    const size_t row = SMP ? (size_t)PM + seq * ST + tl : (size_t)seq * PT + t;
    const int head = kvh * 4 + hr;
    LAS float* PS = (LAS float*)(F.lds + AT_PS); LAS float* IMPw = (LAS float*)(F.lds + AT_IMP) + w * 192;
    LAS unsigned long long* MASKS = (LAS unsigned long long*)(F.lds + AT_MASK); LAS unsigned short* LIST = (LAS unsigned short*)(F.lds + AT_LIST); LAS int* NL = (LAS int*)(F.lds + AT_NL);
    constexpr int PSS = SMP ? 520 : 264;
    LAS float* PSw = SMP ? PS : PS + w * 8 * PSS;
    __syncthreads();
    bf16x8 qf[4];
    { const bf16* qp = WSP(bf16, WS_QN) + row * 512 + head * 64 + 8 * h_;
#pragma unroll
      for (int kk = 0; kk < 4; ++kk) qf[kk] = *(const bf16x8*)(qp + 16 * kk); }
    const float* ngp = WSP(float, WS_NG) + row * 24 + head * 3; const float g0 = ngp[0], g1 = ngp[1], g2 = ngp[2];
    if (!SMP) { for (int i = lane; i < 8 * PSS; i += 64) PSw[i] = 0.f; }
    const int ntc = SMP ? 8 : ((t0 + 32) >> 10) + 1;
    if (tid < 2 * ntc) LIST[tid] = (unsigned short)(((tid >= ntc ? 1u : 0u) << 14) | (unsigned)(tid >= ntc ? tid - ntc : tid));
    if (tid == 0) LIST[2 * ntc] = (unsigned short)AT_MARK;
    int nl = 2 * ntc + 1;
    TileRegs R;
    at_prefetch<SMP>(F, l, seq, kvh, (unsigned)0, R);
    at_store(F, 0, R);
    __syncthreads();
    float m = -INFINITY, lsum = 0.f, invden = 0.f;
    f32x16 O[2]; O[0] = (f32x16){}; O[1] = (f32x16){};
    LAS float* OAw = (LAS float*)(F.lds + AT_PS) + w * (SMP ? 2048 : 8 * PSS) + lane;
    unsigned long long mk0 = 0ull, mk1 = 0ull, wu = ~0ull;
    int cur_kind = -1, idx = 0;
#define AT_FINALIZE(kind) do { \
        if ((kind) == 0) { const float lt = lsum + __shfl_xor(lsum, 32); invden = lt > 0.f ? 1.0f / lt : 0.f; } \
        else if ((kind) == 1) { const float sc = g0 * invden; O[0] *= sc; O[1] *= sc; } \
        else if ((kind) == 2) { const float lt = lsum + __shfl_xor(lsum, 32); const float sc = (lt > 0.f ? 1.0f / lt : 0.f) * g1; \
            _Pragma("unroll") for (int r_ = 0; r_ < 16; ++r_) { OAw[r_ * 64] += O[0][r_] * sc; OAw[(16 + r_) * 64] += O[1][r_] * sc; } } } while (0)
    while (idx < nl) {
        const unsigned e = (unsigned)__builtin_amdgcn_readfirstlane((int)LIST[idx]);
        if (e == AT_MARK) {
            AT_FINALIZE(cur_kind); cur_kind = -1;
            LDS_WAIT(); asm volatile("" ::: "memory");
#pragma unroll 1
            for (int tk = 0; tk < 8; ++tk) {
                const LAS float* pr = PSw + tk * PSS;
                if (!SMP) {
                    const int s = lane; float imp = 0.f;
#pragma unroll
                    for (int n = 4 * s - 1; n <= 4 * s + 3; ++n) if (n >= 0) imp += pr[n];
                    const bool forced = (s == 0) || (s == qt) || (s == qt - 1), avail = s <= qt;
                    const float val = avail ? (forced ? 1e4f : imp) : -1e4f;
                    IMPw[s] = val; LDS_WAIT(); asm volatile("" ::: "memory");
                    int rank = 0;
#pragma unroll 8
                    for (int i = 0; i < 64; ++i) { const float v = IMPw[i]; rank += (v > val || (v == val && i < s)) ? 1 : 0; }
                    const unsigned long long mk = __ballot(rank < 16);
                    if (lane == 0) MASKS[(8 * w + tk) * 4] = mk;
                    LDS_WAIT(); asm volatile("" ::: "memory");
                } else {
                    const int sa = lane, sb = lane + 64; float ia = 0.f, ib = 0.f;
#pragma unroll
                    for (int n = 4 * sa - 1; n <= 4 * sa + 3; ++n) if (n >= 0) ia += pr[n];
#pragma unroll
                    for (int n = 4 * sb - 1; n <= 4 * sb + 3; ++n) ib += pr[n];
                    const bool fa = (sa == 0), fb = (sb == 127);
                    const float va = fa ? 1e4f : ia, vb = fb ? 1e4f : ib;
                    IMPw[sa] = va; IMPw[sb] = vb; LDS_WAIT(); asm volatile("" ::: "memory");
                    int ra = fa ? 0 : 1, rb = fb ? 0 : 1;
#pragma unroll 8
                    for (int i = 0; i < 128; ++i) { const float v = IMPw[i]; ra += (v > va || (v == va && i < sa)) ? 1 : 0; rb += (v > vb || (v == vb && i < sb)) ? 1 : 0; }
                    const unsigned long long ma = __ballot(ra < 16), mb = __ballot(rb < 16);
                    if (lane == 0) { MASKS[tk * 4] = ma; MASKS[tk * 4 + 1] = mb; MASKS[tk * 4 + 2] = 1ull; }
                    LDS_WAIT(); asm volatile("" ::: "memory");
                }
            }
            __syncthreads();
#pragma unroll
            for (int r_ = 0; r_ < 16; ++r_) { OAw[r_ * 64] = O[0][r_]; OAw[(16 + r_) * 64] = O[1][r_]; }
            if (tid == 0) {
                int n = idx + 1;
                if (!SMP) { unsigned long long U = 0ull; for (int i = 0; i < 64; ++i) U |= MASKS[i * 4];
                    for (int s = 0; s <= qt; ++s) if ((U >> s) & 1ull) LIST[n++] = (unsigned short)((2u << 14) | (unsigned)s);
                    for (int s = (qt > 8 ? qt - 8 : 0); s <= qt; ++s) LIST[n++] = (unsigned short)((3u << 14) | (unsigned)s);
                } else { unsigned long long U0 = 0ull, U1 = 0ull; for (int i = 0; i < 8; ++i) { U0 |= MASKS[i * 4]; U1 |= MASKS[i * 4 + 1]; }
                    for (int s = 0; s < 64; ++s) if ((U0 >> s) & 1ull) LIST[n++] = (unsigned short)((2u << 14) | (unsigned)s);
                    for (int s = 0; s < 64; ++s) if ((U1 >> s) & 1ull) LIST[n++] = (unsigned short)((2u << 14) | (unsigned)(64 + s));
                    LIST[n++] = (unsigned short)((2u << 14) | 128u);
                    for (int s = 0; s <= 8; ++s) LIST[n++] = (unsigned short)((3u << 14) | (unsigned)s); }
                NL[0] = n;
            }
            __syncthreads();
            nl = __builtin_amdgcn_readfirstlane(NL[0]);
            mk0 = MASKS[tokl * 4]; if (SMP) { mk1 = MASKS[tokl * 4 + 1]; }
            if (!SMP) { unsigned long long u = 0ull; for (int i = 0; i < 8; ++i) u |= MASKS[(8 * w + i) * 4]; wu = u; }
            if (idx + 1 < nl) { at_prefetch<SMP>(F, l, seq, kvh, (unsigned)LIST[idx + 1], R); at_store(F, (idx + 1) & 1, R); }
            __syncthreads();
            ++idx; continue;
        }
        const int kind = (int)(e >> 14), ti = (int)(e & 0x3fffu);
        if (kind != cur_kind) {
            if (cur_kind >= 0) AT_FINALIZE(cur_kind);
            if (kind != 1) m = -INFINITY;
            lsum = 0.f; O[0] = (f32x16){}; O[1] = (f32x16){}; cur_kind = kind;
        }
        const unsigned en = (idx + 1 < nl) ? (unsigned)__builtin_amdgcn_readfirstlane((int)LIST[idx + 1]) : AT_MARK;
        const bool have_next = (en != AT_MARK);
        if (have_next) at_prefetch<SMP>(F, l, seq, kvh, en, R);
        bool active = true;
        if (!SMP && kind == 2) active = ((wu >> ti) & 1ull) != 0ull;
        if (active) {
            const LAS unsigned char* Kb = F.lds + AT_K0 + (idx & 1) * 64 * AT_RS; const LAS unsigned char* Vb = F.lds + AT_V0 + (idx & 1) * 64 * AT_RS;
            int lo, hi; const int kb = 64 * ti;
            if (kind < 2) { lo = 0; hi = SMP ? 510 : ((t >= 31) ? ((t - 31) >> 4) : -1); }
            else if (kind == 2) { lo = 0; const unsigned long long mw = (ti < 64) ? mk0 : ((ti < 128) ? mk1 : 1ull); hi = ((mw >> (ti & 63)) & 1ull) ? t : -1; }
            else { if (SMP) { lo = tl; hi = WINB + tl; } else { lo = t - WINB; hi = t; } }
            f32x16 s0 = (f32x16){}, s1 = (f32x16){};
#pragma unroll
            for (int kk = 0; kk < 4; ++kk) {
                const bf16x8 k0 = *(const LAS bf16x8*)(Kb + q * AT_RS + (16 * kk + 8 * h_) * 2), k1 = *(const LAS bf16x8*)(Kb + (32 + q) * AT_RS + (16 * kk + 8 * h_) * 2);
                s0 = mfma32(k0, qf[kk], s0); s1 = mfma32(k1, qf[kk], s1);
            }
            float tmax = -INFINITY;
#pragma unroll
            for (int r = 0; r < 16; ++r) { const int key = kb + (r & 3) + 8 * (r >> 2) + 4 * h_;
                s0[r] = (key >= lo && key <= hi) ? s0[r] : -INFINITY; s1[r] = (key + 32 >= lo && key + 32 <= hi) ? s1[r] : -INFINITY;
                tmax = fmaxf(tmax, fmaxf(s0[r], s1[r])); }
            tmax = fmaxf(tmax, __shfl_xor(tmax, 32));
            const float m_new = fmaxf(m, tmax), m_use = (m_new == -INFINITY) ? 0.f : m_new;
            const float alpha = fexp2(m - m_use);
            float ps = 0.f;
#pragma unroll
            for (int r = 0; r < 16; ++r) { s0[r] = fexp2(s0[r] - m_use); s1[r] = fexp2(s1[r] - m_use); ps += s0[r] + s1[r]; }
            lsum = lsum * alpha + ps; m = m_new;
            if (kind != 0) {
                O[0] *= alpha; O[1] *= alpha;
#pragma unroll
                for (int kt2 = 0; kt2 < 2; ++kt2)
#pragma unroll
                    for (int s2 = 0; s2 < 2; ++s2) { const bf16x8 pf = cvt_frag(kt2 ? s1 : s0, s2); const int rA = 32 * kt2 + 16 * s2 + 4 * h_;
#pragma unroll
                        for (int dt = 0; dt < 2; ++dt) { const bf16x8 vf = tr_frag(Vb, AT_RS, rA, rA + 8, 32 * dt + 16 * blk, lane); O[dt] = mfma32(vf, pf, O[dt]); } }
            }
            if (kind == 1) {
#pragma unroll
                for (int r = 0; r < 16; ++r) { const int n = kb + (r & 3) + 8 * (r >> 2) + 4 * h_;
                    float a = s0[r] * invden, b = s1[r] * invden; a += __shfl_xor(a, 1); b += __shfl_xor(b, 1); a += __shfl_xor(a, 2); b += __shfl_xor(b, 2);
                    if (hr == 0) { PSw[tl * PSS + n] = a; PSw[tl * PSS + n + 32] = b; } }
            }
        }
        if (have_next) at_store(F, (idx + 1) & 1, R);
        __syncthreads();
        ++idx;
    }
#undef AT_FINALIZE
    {
        const float lt = lsum + __shfl_xor(lsum, 32); const float sc = (lt > 0.f ? 1.0f / lt : 0.f) * g2;
        if (!SMP || w == 0) {
            bf16* op = WSP(bf16, WS_OA) + row * 512 + head * 64;
#pragma unroll
            for (int dt = 0; dt < 2; ++dt)
#pragma unroll
                for (int r4 = 0; r4 < 4; ++r4) { float o_[4];
#pragma unroll
                    for (int x = 0; x < 4; ++x) o_[x] = OAw[(dt * 16 + 4 * r4 + x) * 64] + O[dt][4 * r4 + x] * sc;
                    v2u wv; wv.x = pk2(o_[0], o_[1]); wv.y = pk2(o_[2], o_[3]); *(v2u*)(op + 32 * dt + 8 * r4 + 4 * h_) = wv; }
        }
    }
}

constexpr int AS_RS = 144;
constexpr int AS_V = 0, AS_VW = 32 * AS_RS, AS_MRG = 0, AS_PS = 73728, AS_IMP = AS_PS + 16640, AS_MASK = AS_IMP + 6144;
static_assert(8 * 34 * 64 * 4 <= AS_PS && AS_MASK + 512 <= RING_BYTES, "sample attention LDS map");

__device__ __forceinline__ float xhalf_max(float x) { auto t_ = __builtin_amdgcn_permlane32_swap(__float_as_uint(x), __float_as_uint(x), false, false); return fmaxf(__uint_as_float(t_[0]), __uint_as_float(t_[1])); }
__device__ __forceinline__ float xhalf_sum(float x) { auto t_ = __builtin_amdgcn_permlane32_swap(__float_as_uint(x), __float_as_uint(x), false, false); return __uint_as_float(t_[0]) + __uint_as_float(t_[1]); }
struct ASrc { const float* kf; const float* vf; const bf16* kb; const bf16* vb; int rs; int nvalid; };
#define AS_TILE(SRC, KB0, LO_, HI_, DO_PV, DO_PS, m, lsum, O0, O1, invden, PSS_) do { \
        bf16x8 kfr[4]; \
        if ((SRC).kb) { const bf16* kp_ = (SRC).kb + (size_t)q * (SRC).rs + 8 * h_; _Pragma("unroll") for (int kk = 0; kk < 4; ++kk) kfr[kk] = *(const bf16x8*)(kp_ + 16 * kk); } \
        else { const float* kp_ = (SRC).kf + (size_t)q * (SRC).rs + 8 * h_; _Pragma("unroll") for (int kk = 0; kk < 4; ++kk) { const f32x4 a_ = *(const f32x4*)(kp_ + 16 * kk), b_ = *(const f32x4*)(kp_ + 16 * kk + 4); kfr[kk] = __builtin_bit_cast(bf16x8, pack8(a_, b_)); } } \
        if (DO_PV) { const int vr_ = lane >> 1, vh_ = lane & 1; v4u vv_[4]; \
            if (vr_ >= (SRC).nvalid) { _Pragma("unroll") for (int x = 0; x < 4; ++x) vv_[x] = (v4u){0u, 0u, 0u, 0u}; } \
            else if ((SRC).vb) { const bf16* vp_ = (SRC).vb + (size_t)vr_ * (SRC).rs + 32 * vh_; _Pragma("unroll") for (int x = 0; x < 4; ++x) vv_[x] = *(const v4u*)(vp_ + 8 * x); } \
            else { const float* vp_ = (SRC).vf + (size_t)vr_ * (SRC).rs + 32 * vh_; _Pragma("unroll") for (int x = 0; x < 4; ++x) vv_[x] = pack8(*(const f32x4*)(vp_ + 8 * x), *(const f32x4*)(vp_ + 8 * x + 4)); } \
            _Pragma("unroll") for (int x = 0; x < 4; ++x) *(LAS v4u*)(Vw + vr_ * AS_RS + vh_ * 64 + x * 16) = vv_[x]; } \
        f32x16 s_ = (f32x16){}; \
        _Pragma("unroll") for (int kk = 0; kk < 4; ++kk) s_ = mfma32(kfr[kk], qf[kk], s_); \
        float tmax_ = -INFINITY; \
        _Pragma("unroll") for (int r = 0; r < 16; ++r) { const int key_ = (KB0) + (r & 3) + 8 * (r >> 2) + 4 * h_; s_[r] = (key_ >= (LO_) && key_ <= (HI_)) ? s_[r] : -INFINITY; tmax_ = fmaxf(tmax_, s_[r]); } \
        tmax_ = xhalf_max(tmax_); \
        const float mn_ = fmaxf(m, tmax_), mu_ = (mn_ == -INFINITY) ? 0.f : mn_, al_ = fexp2(m - mu_); float ps_ = 0.f; \
        _Pragma("unroll") for (int r = 0; r < 16; ++r) { s_[r] = fexp2(s_[r] - mu_); ps_ += s_[r]; } \
        lsum = lsum * al_ + ps_; m = mn_; \
        if (DO_PV) { O0 *= al_; O1 *= al_; LDS_WAIT(); asm volatile("" ::: "memory"); \
            _Pragma("unroll") for (int s2 = 0; s2 < 2; ++s2) { const bf16x8 pf_ = cvt_frag(s_, s2); const int rA_ = 16 * s2 + 4 * h_; \
                O0 = mfma32(tr_frag(Vw, AS_RS, rA_, rA_ + 8, 16 * blk, lane), pf_, O0); O1 = mfma32(tr_frag(Vw, AS_RS, rA_, rA_ + 8, 32 + 16 * blk, lane), pf_, O1); } \
            LDS_WAIT(); asm volatile("" ::: "memory"); } \
        if (DO_PS) { _Pragma("unroll") for (int r = 0; r < 16; ++r) { const int n_ = (KB0) + (r & 3) + 8 * (r >> 2) + 4 * h_; float a_ = s_[r] * (invden); a_ += __shfl_xor(a_, 1); a_ += __shfl_xor(a_, 2); if (hr == 0) PS[tl * (PSS_) + n_] = a_; } } \
    } while (0)

__device__ __forceinline__ void attn_sample_unit(Frame& F, int l, int unit) {
    const int lane = F.lane, w = F.wave, tid = F.tid;
    const int q = lane & 31, h_ = lane >> 5, blk = (lane >> 4) & 1, tl = q >> 2, hr = q & 3;
    const int seq = unit >> 1, kvh = unit & 1, head = kvh * 4 + hr;
    const size_t row = (size_t)PM + seq * ST + tl;
    LAS unsigned char* Vw = F.lds + AS_V + w * AS_VW;
    LAS float* MRG = (LAS float*)(F.lds + AS_MRG);
    LAS float* PS = (LAS float*)(F.lds + AS_PS);
    LAS float* IMPw = (LAS float*)(F.lds + AS_IMP) + w * 192;
    LAS unsigned long long* MASKS = (LAS unsigned long long*)(F.lds + AS_MASK);
    __syncthreads();
    bf16x8 qf[4];
    { const bf16* qp = WSP(bf16, WS_QN) + row * 512 + head * 64 + 8 * h_;
#pragma unroll
      for (int kk = 0; kk < 4; ++kk) qf[kk] = *(const bf16x8*)(qp + 16 * kk); }
    const float* ngp = WSP(float, WS_NG) + row * 24 + head * 3; const float g0 = ngp[0], g1 = ngp[1], g2 = ngp[2];
    const int* ptab = (const int*)F.a->in[I_PT] + seq * NPG;
    f32x16 OA0 = (f32x16){}, OA1 = (f32x16){};

#define AS_PUBLISH(m, lsum, O0, O1) do { __syncthreads(); LAS float* mp_ = MRG + w * 34 * 64 + lane; mp_[0] = m; mp_[64] = lsum; \
        _Pragma("unroll") for (int r = 0; r < 16; ++r) { mp_[(2 + r) * 64] = O0[r]; mp_[(18 + r) * 64] = O1[r]; } __syncthreads(); } while (0)

    const bf16* CKk = WSP(bf16, WS_CK) + ((size_t)(seq * 2 + kvh) * 512) * 64; const bf16* CKv = CKk + (size_t)CMP_ROWS_J * 64;
    float mC = -INFINITY, lC = 0.f; f32x16 D0 = (f32x16){}, D1 = (f32x16){};
#pragma unroll 1
    for (int ti = w; ti < 16; ti += 8) { ASrc S{nullptr, nullptr, CKk + (size_t)ti * 32 * 64, CKv + (size_t)ti * 32 * 64, 64, 32}; AS_TILE(S, ti * 32, 0, 510, false, false, mC, lC, D0, D1, 0.f, 520); }
    { __syncthreads(); MRG[w * 128 + lane] = mC; MRG[w * 128 + 64 + lane] = xhalf_sum(lC); __syncthreads(); }
    float mT = -INFINITY;
#pragma unroll
    for (int x = 0; x < 8; ++x) mT = fmaxf(mT, MRG[x * 128 + lane]);
    float lT = 0.f;
#pragma unroll
    for (int x = 0; x < 8; ++x) { const float mx_ = MRG[x * 128 + lane]; lT += (mx_ == -INFINITY) ? 0.f : MRG[x * 128 + 64 + lane] * fexp2(mx_ - mT); }
    const float invC = lT > 0.f ? 1.0f / lT : 0.f;
    __syncthreads();
    { float mB = mT, lB = 0.f;
#pragma unroll 1
      for (int ti = w; ti < 16; ti += 8) { ASrc S{nullptr, nullptr, CKk + (size_t)ti * 32 * 64, CKv + (size_t)ti * 32 * 64, 64, 32}; AS_TILE(S, ti * 32, 0, 510, true, true, mB, lB, D0, D1, invC, 520); }
      AS_PUBLISH(mB, lB, D0, D1); }
    { const float sc = g0 * invC;
#pragma unroll 1
      for (int x = 0; x < 8; ++x) { const LAS float* mp = MRG + x * 34 * 64 + lane;
#pragma unroll
          for (int r = 0; r < 16; ++r) { OA0[r] += mp[(2 + r) * 64] * sc; OA1[r] += mp[(18 + r) * 64] * sc; } } }
    {
        const LAS float* pr = PS + w * 520; const int sa = lane, sb = lane + 64; float ia = 0.f, ib = 0.f;
#pragma unroll
        for (int n = 4 * sa - 1; n <= 4 * sa + 3; ++n) if (n >= 0) ia += pr[n];
#pragma unroll
        for (int n = 4 * sb - 1; n <= 4 * sb + 3; ++n) ib += pr[n];
        const bool fa = (sa == 0), fb = (sb == 127); const float va = fa ? 1e4f : ia, vb = fb ? 1e4f : ib;
        IMPw[sa] = va; IMPw[sb] = vb; LDS_WAIT(); asm volatile("" ::: "memory");
        int ra = fa ? 0 : 1, rb = fb ? 0 : 1;
#pragma unroll 8
        for (int i = 0; i < 128; ++i) { const float v = IMPw[i]; ra += (v > va || (v == va && i < sa)) ? 1 : 0; rb += (v > vb || (v == vb && i < sb)) ? 1 : 0; }
        const unsigned long long ma = __ballot(ra < 16), mb = __ballot(rb < 16);
        if (lane == 0) { MASKS[w * 4] = ma; MASKS[w * 4 + 1] = mb; }
    }
    __syncthreads();
    const unsigned long long mk0 = MASKS[tl * 4], mk1 = MASKS[tl * 4 + 1];
    unsigned long long U0 = 0ull, U1 = 0ull;
#pragma unroll
    for (int x = 0; x < 8; ++x) { U0 |= MASKS[x * 4]; U1 |= MASKS[x * 4 + 1]; }
    {
        float m = -INFINITY, ls = 0.f; D0 = (f32x16){}; D1 = (f32x16){};
        const int t = PAST + tl; int cnt = 0;
#pragma unroll 1
        for (int s = 0; s <= 128; ++s) {
            const bool in_u = (s < 64) ? ((U0 >> s) & 1ull) : ((s < 128) ? ((U1 >> (s - 64)) & 1ull) : true);
            if (!in_u) continue;
            const bool selb = (s < 64) ? ((mk0 >> s) & 1ull) : ((s < 128) ? ((mk1 >> (s - 64)) & 1ull) : true);
            const int nh = (s < 128) ? 2 : 1;
            for (int hf = 0; hf < nh; ++hf, ++cnt) {
                if ((cnt & 7) != w) continue;
                const int hi = selb ? t : -1;
                if (s < 128) { const int page = ptab[s >> 1], slot = (s & 1) * 64 + hf * 32;
                    const float* kp = FIN(I_CACHE) + (((((size_t)l * NPHYS + page) * PAGE + slot) * 4 + 2) * 2 + kvh) * 64;
                    ASrc S{kp, kp + 128, nullptr, nullptr, 512, 32}; AS_TILE(S, s * 64 + hf * 32, 0, hi, true, false, m, ls, D0, D1, 0.f, 520); }
                else { const bf16* kp = WSP(bf16, WS_KVS) + ((((size_t)0 * SB + seq) * 2 + kvh) * ST) * 64;
                    ASrc S{nullptr, nullptr, kp, kp + (size_t)SB * 2 * ST * 64, 64, ST}; AS_TILE(S, PAST, 0, hi, true, false, m, ls, D0, D1, 0.f, 520); }
            }
        }
        AS_PUBLISH(m, ls, D0, D1);
        float mt = -INFINITY;
#pragma unroll
        for (int x = 0; x < 8; ++x) mt = fmaxf(mt, MRG[x * 34 * 64 + lane]);
        float lt = 0.f; f32x16 T0 = (f32x16){}, T1 = (f32x16){};
#pragma unroll 1
        for (int x = 0; x < 8; ++x) { const LAS float* mp = MRG + x * 34 * 64 + lane; const float mx_ = mp[0]; const float f = (mx_ == -INFINITY) ? 0.f : fexp2(mx_ - mt); lt += mp[64] * f;
#pragma unroll
            for (int r = 0; r < 16; ++r) { T0[r] += mp[(2 + r) * 64] * f; T1[r] += mp[(18 + r) * 64] * f; } }
        lt = xhalf_sum(lt); const float sc = (lt > 0.f ? 1.0f / lt : 0.f) * g1; OA0 += T0 * sc; OA1 += T1 * sc;
    }
    {
        float m = -INFINITY, ls = 0.f; D0 = (f32x16){}; D1 = (f32x16){};
#pragma unroll 1
        for (int ti = w; ti < 17; ti += 8) {
            if (ti < 16) { const float* kp = FIN(I_CWIN) + (((((size_t)l * SB + seq) * WINB + ti * 32) * 2 + 0) * 2 + kvh) * 64;
                ASrc S{kp, kp + 128, nullptr, nullptr, 256, 32}; AS_TILE(S, ti * 32, tl, WINB + tl, true, false, m, ls, D0, D1, 0.f, 520); }
            else { const bf16* kp = WSP(bf16, WS_KVS) + ((((size_t)2 * SB + seq) * 2 + kvh) * ST) * 64;
                ASrc S{nullptr, nullptr, kp, kp + (size_t)SB * 2 * ST * 64, 64, ST}; AS_TILE(S, WINB, tl, WINB + tl, true, false, m, ls, D0, D1, 0.f, 520); }
        }
        AS_PUBLISH(m, ls, D0, D1);
        float mt = -INFINITY;
#pragma unroll
        for (int x = 0; x < 8; ++x) mt = fmaxf(mt, MRG[x * 34 * 64 + lane]);
        float lt = 0.f; f32x16 T0 = (f32x16){}, T1 = (f32x16){};
#pragma unroll 1
        for (int x = 0; x < 8; ++x) { const LAS float* mp = MRG + x * 34 * 64 + lane; const float mx_ = mp[0]; const float f = (mx_ == -INFINITY) ? 0.f : fexp2(mx_ - mt); lt += mp[64] * f;
#pragma unroll
            for (int r = 0; r < 16; ++r) { T0[r] += mp[(2 + r) * 64] * f; T1[r] += mp[(18 + r) * 64] * f; } }
        lt = xhalf_sum(lt); const float sc = (lt > 0.f ? 1.0f / lt : 0.f) * g2; OA0 += T0 * sc; OA1 += T1 * sc;
    }
#undef AS_PUBLISH
    if (w == 0) {
        bf16* op = WSP(bf16, WS_OA) + row * 512 + head * 64;
#pragma unroll
        for (int r4 = 0; r4 < 4; ++r4) { v2u a, b; a.x = pk2(OA0[4 * r4 + 0], OA0[4 * r4 + 1]); a.y = pk2(OA0[4 * r4 + 2], OA0[4 * r4 + 3]); b.x = pk2(OA1[4 * r4 + 0], OA1[4 * r4 + 1]); b.y = pk2(OA1[4 * r4 + 2], OA1[4 * r4 + 3]);
            *(v2u*)(op + 8 * r4 + 4 * h_) = a; *(v2u*)(op + 32 + 8 * r4 + 4 * h_) = b; }
    }
}

#ifndef DBG_DUP
#define DBG_DUP 0
#endif
#if DBG_DUP == 1
#define AP_DUP_QK(NK) { f32x16 d_ = (f32x16){}; _Pragma("unroll") for (int kk = 0; kk < 4; ++kk) d_ = mfma32(NK[kk], qf[(kk + 1) & 3], d_); _Pragma("unroll") for (int r = 0; r < 16; ++r) s_[r] += zf * d_[r]; }
#else
#define AP_DUP_QK(NK)
#endif
#if DBG_DUP == 2
#define AP_DUP_EXP() { float acc_ = 0.f; _Pragma("unroll") for (int r = 0; r < 16; ++r) acc_ += fexp2(s_[r] * 0.5f - 3.0f); lsum += zf * acc_; }
#else
#define AP_DUP_EXP()
#endif
#if DBG_DUP == 3
#define AP_DUP_PV() { f32x16 e0_ = (f32x16){}, e1_ = (f32x16){}; _Pragma("unroll") for (int s2 = 0; s2 < 2; ++s2) { const bf16x8 pf_ = cvt_frag(s_, 1 - s2); const int rA_ = 16 * s2 + 4 * h_; \
        e0_ = mfma32(tr_frag(Vw, AS_RS, rA_ + 8, rA_, 16 * blk, lane), pf_, e0_); e1_ = mfma32(tr_frag(Vw, AS_RS, rA_ + 8, rA_, 32 + 16 * blk, lane), pf_, e1_); } D0 += e0_ * zf; D1 += e1_ * zf; }
#else
#define AP_DUP_PV()
#endif
constexpr int AP_WS = 14336, AP_V = 0, AP_PS = 4608, AP_IMP = AP_PS + 8 * 264 * 4, AP_MASK = AP_IMP + 256, AP_LIST = AP_MASK + 64;
static_assert(AP_LIST + 2 * 192 <= AP_WS && 8 * AP_WS <= RING_BYTES, "prompt attention LDS map");
__device__ __forceinline__ void attn_prompt_unit(Frame& F, int l, int unit) {
    const int lane = F.lane, w = F.wave;
    const int q = lane & 31, h_ = lane >> 5, blk = (lane >> 4) & 1, tl = q >> 2, hr = q & 3;
    const int seq = unit >> 7, kvh = (unit >> 6) & 1, qt = unit & 63, head = kvh * 4 + hr;
    const int t0w = qt * 64 + 8 * w, t = t0w + tl; const size_t row = (size_t)seq * PT + t;
    LAS unsigned char* Vw = F.lds + w * AP_WS + AP_V; LAS float* PS = (LAS float*)(F.lds + w * AP_WS + AP_PS); LAS float* IMPw = (LAS float*)(F.lds + w * AP_WS + AP_IMP);
    LAS unsigned long long* MASKS = (LAS unsigned long long*)(F.lds + w * AP_WS + AP_MASK); LAS unsigned short* LIST = (LAS unsigned short*)(F.lds + w * AP_WS + AP_LIST);
    __syncthreads();
    bf16x8 qf[4];
    { const bf16* qp = WSP(bf16, WS_QN) + row * 512 + head * 64 + 8 * h_;
#pragma unroll
      for (int kk = 0; kk < 4; ++kk) qf[kk] = *(const bf16x8*)(qp + 16 * kk); }
    const float* ngp = WSP(float, WS_NG) + row * 24 + head * 3; const float g0 = ngp[0], g1 = ngp[1], g2 = ngp[2];
    for (int i = lane; i < 8 * 264; i += 64) PS[i] = 0.f;
    const bf16* CKk = WSP(bf16, WS_CK) + ((size_t)32768 + (seq * 2 + kvh) * 256) * 64; const bf16* CKv = CKk + (size_t)CMP_ROWS_J * 64;
    const bf16* KS = WSP(bf16, WS_KVB) + ((((size_t)0 * PB + seq) * 2 + kvh) * PT) * 64; const bf16* VS = KS + (size_t)PB * 2 * PT * 64;
    const bf16* KW = KS + (size_t)2 * PB * 2 * PT * 64; const bf16* VW = KW + (size_t)PB * 2 * PT * 64;
    const int hiCmin = (t0w >= 31) ? ((t0w - 31) >> 4) : -1;
    const int hiC = (t >= 31) ? ((t - 31) >> 4) : -1; const int nmaxw = (t0w + 7 >= 31) ? ((t0w + 7 - 31) >> 4) : -1; const int ntc = (nmaxw >= 0) ? (nmaxw >> 5) + 1 : 0;
    f32x16 D0 = (f32x16){}, D1 = (f32x16){};
    LAS float* OAG = PS + lane;
    float m = -INFINITY, lsum = 0.f, invC = 0.f; unsigned long long mk0 = 0ull;
    const float zf = (F.G == 12345) ? 1.0f : 0.0f;
    bf16x8 nk0[4]; v4u nv0[4], nv1[4];
#define AP_LOADK(e_, NK) do { const int kd_ = (int)((e_) >> 12), ti_ = (int)((e_) & 0xfffu); const bf16* kb_ = (kd_ < 2 ? CKk : (kd_ == 2 ? KS : KW)) + (size_t)ti_ * 32 * 64; \
        const int ko_ = kd_ < 2 ? q * 64 + 8 * h_ : lane * 8, ks_ = kd_ < 2 ? 16 : 512;     \
        _Pragma("unroll") for (int kk = 0; kk < 4; ++kk) NK[kk] = *(const bf16x8*)(kb_ + ko_ + ks_ * kk); } while (0)
#define AP_LOADV(e_, NV) do { const int kd_ = (int)((e_) >> 12), ti_ = (int)((e_) & 0xfffu); const bf16* vb_ = (kd_ < 2 ? CKv : (kd_ == 2 ? VS : VW)) + (size_t)ti_ * 32 * 64; \
        _Pragma("unroll") for (int x = 0; x < 4; ++x) NV[x] = *(const v4u*)(vb_ + 512 * x + lane * 8); } while (0)
#define AP_LOADT(e_, NK, NV) do { AP_LOADK(e_, NK); AP_LOADV(e_, NV); } while (0)
#define AP_STEP(i_, n_, NK, NV, NVN, EC, ECN) do { \
        const unsigned e_ = EC; const int kind = (int)(e_ >> 12), ti = (int)(e_ & 0xfffu); \
        if (kind == 1) { _Pragma("unroll") for (int x = 0; x < 4; ++x) *(LAS v4u*)(Vw + (8 * x + (lane >> 3)) * AS_RS + (lane & 7) * 16) = NV[x]; }     \
        f32x16 s_ = (f32x16){}; \
        _Pragma("unroll") for (int kk = 0; kk < 4; ++kk) s_ = mfma32(NK[kk], qf[kk], s_); \
        AP_DUP_QK(NK) \
          \
        if ((i_) + 1 < (n_)) { AP_LOADK(ECN, NK); AP_LOADV(ECN, NVN); if ((i_) + 2 < (n_)) EC = (unsigned)__builtin_amdgcn_readfirstlane((int)LIST[(i_) + 2]); } \
        if (kind != cur_kind) { \
            if (cur_kind == 0) { const float lt_ = xhalf_sum(lsum); invC = lt_ > 0.f ? 1.0f / lt_ : 0.f; } \
            else if (cur_kind == 2) { const float lt_ = xhalf_sum(lsum); const float sc_ = (lt_ > 0.f ? 1.0f / lt_ : 0.f) * g1; \
                _Pragma("unroll") for (int r = 0; r < 16; ++r) { OAG[r * 64] += D0[r] * sc_; OAG[(16 + r) * 64] += D1[r] * sc_; } } \
            if (kind != 1) m = -INFINITY; lsum = 0.f; D0 = (f32x16){}; D1 = (f32x16){}; cur_kind = kind; } \
        const int kb = ti * 32; int lo, hi; \
        if (kind < 2) { lo = 0; hi = hiC; } else if (kind == 2) { lo = 0; hi = ((mk0 >> (ti >> 1)) & 1ull) ? t : -1; } else { lo = t - WINB; hi = t; } \
          \
        const bool interior = (kind < 2) ? (hiCmin >= 0 && kb + 31 <= hiCmin) : ((kind == 2) ? (kb + 31 <= t0w) : (kb >= t0w + 7 - WINB && kb + 31 <= t0w)); \
        float tmax_ = -INFINITY, mu_, mn_; \
        if (interior) { const bool on_ = hi >= 0; \
            _Pragma("unroll") for (int r = 0; r < 16; ++r) tmax_ = fmaxf(tmax_, s_[r]); \
            tmax_ = on_ ? tmax_ : -INFINITY; tmax_ = xhalf_max(tmax_); \
            mn_ = fmaxf(m, tmax_); mu_ = (mn_ == -INFINITY) ? 0.f : mn_; const float mr_ = on_ ? mu_ : INFINITY; \
            _Pragma("unroll") for (int r = 0; r < 16; ++r) s_[r] = fexp2(s_[r] - mr_); \
        } else { \
            _Pragma("unroll") for (int r = 0; r < 16; ++r) { const int key_ = kb + (r & 3) + 8 * (r >> 2) + 4 * h_; s_[r] = (key_ >= lo && key_ <= hi) ? s_[r] : -INFINITY; tmax_ = fmaxf(tmax_, s_[r]); } \
            tmax_ = xhalf_max(tmax_); \
            mn_ = fmaxf(m, tmax_); mu_ = (mn_ == -INFINITY) ? 0.f : mn_; \
            _Pragma("unroll") for (int r = 0; r < 16; ++r) s_[r] = fexp2(s_[r] - mu_); \
        } \
        AP_DUP_EXP() \
        const float al_ = fexp2(m - mu_); float ps_ = 0.f; \
        _Pragma("unroll") for (int r = 0; r < 16; ++r) ps_ += s_[r]; \
        lsum = lsum * al_ + ps_; m = mn_; \
        if (kind >= 2) { if (__ballot(al_ != 1.0f) != 0ull) { D0 *= al_; D1 *= al_; } \
            const bf16x8 pf0_ = cvt_frag(s_, 0), pf1_ = cvt_frag(s_, 1); \
            D0 = mfma32(__builtin_bit_cast(bf16x8, NV[0]), pf0_, D0); D1 = mfma32(__builtin_bit_cast(bf16x8, NV[2]), pf0_, D1); D0 = mfma32(__builtin_bit_cast(bf16x8, NV[1]), pf1_, D0); D1 = mfma32(__builtin_bit_cast(bf16x8, NV[3]), pf1_, D1); \
        } else if (kind == 1) { if (__ballot(al_ != 1.0f) != 0ull) { D0 *= al_; D1 *= al_; } asm volatile("" ::: "memory");   \
            { const bf16x8 va0_ = tr_frag(Vw, AS_RS, 4 * h_, 4 * h_ + 8, 16 * blk, lane), va1_ = tr_frag(Vw, AS_RS, 4 * h_, 4 * h_ + 8, 32 + 16 * blk, lane), \
                           vb0_ = tr_frag(Vw, AS_RS, 16 + 4 * h_, 24 + 4 * h_, 16 * blk, lane), vb1_ = tr_frag(Vw, AS_RS, 16 + 4 * h_, 24 + 4 * h_, 32 + 16 * blk, lane);   \
              const bf16x8 pf0_ = cvt_frag(s_, 0), pf1_ = cvt_frag(s_, 1); \
              D0 = mfma32(va0_, pf0_, D0); D1 = mfma32(va1_, pf0_, D1); D0 = mfma32(vb0_, pf1_, D0); D1 = mfma32(vb1_, pf1_, D1); } \
            AP_DUP_PV() \
            asm volatile("" ::: "memory"); } \
        if (kind == 1) { _Pragma("unroll") for (int r = 0; r < 16; ++r) { const int n2_ = kb + (r & 3) + 8 * (r >> 2) + 4 * h_; float a_ = s_[r] * invC; a_ += __shfl_xor(a_, 1); a_ += __shfl_xor(a_, 2); if (hr == 0) PS[tl * 264 + n2_] = a_; } } \
    } while (0)
#define AP_RUN(N_) do { const int n_ = (N_); unsigned ec0_ = 0u, ec1_ = 0u;                  \
      if (n_ > 0) { ec0_ = (unsigned)__builtin_amdgcn_readfirstlane((int)LIST[0]); AP_LOADK(ec0_, nk0); AP_LOADV(ec0_, nv0); } \
      if (n_ > 1) { ec1_ = (unsigned)__builtin_amdgcn_readfirstlane((int)LIST[1]); } \
      _Pragma("unroll 1") for (int i_ = 0; i_ < n_; i_ += 2) { AP_STEP(i_, n_, nk0, nv0, nv1, ec0_, ec1_); if (i_ + 1 < n_) AP_STEP(i_ + 1, n_, nk0, nv1, nv0, ec1_, ec0_); } } while (0)
    int cur_kind = -1;
    if (lane < 2 * ntc) LIST[lane] = (unsigned short)(((lane >= ntc ? 1u : 0u) << 12) | (unsigned)(lane >= ntc ? lane - ntc : lane));
    LDS_WAIT(); asm volatile("" ::: "memory");
    AP_RUN(2 * ntc);
    { const float sc = (cur_kind == 1) ? g0 * invC : 0.f; D0 *= sc; D1 *= sc; }
    LDS_WAIT(); asm volatile("" ::: "memory");
#pragma unroll 1
    for (int tk = 0; tk < 8; ++tk) {
        const LAS float* pr = PS + tk * 264; const int s = lane; float imp = 0.f;
#pragma unroll
        for (int n = 4 * s - 1; n <= 4 * s + 3; ++n) if (n >= 0) imp += pr[n];
        const bool forced = (s == 0) || (s == qt) || (s == qt - 1), avail = s <= qt; const float val = avail ? (forced ? 1e4f : imp) : -1e4f;
        IMPw[s] = val; LDS_WAIT(); asm volatile("" ::: "memory");
        int rank = 0;
#pragma unroll 8
        for (int i = 0; i < 64; ++i) { const float v = IMPw[i]; rank += (v > val || (v == val && i < s)) ? 1 : 0; }
        const unsigned long long mk = __ballot(rank < 16);
        if (lane == 0) MASKS[tk] = mk;
        LDS_WAIT(); asm volatile("" ::: "memory");
    }
#pragma unroll
    for (int r = 0; r < 16; ++r) { OAG[r * 64] = D0[r]; OAG[(16 + r) * 64] = D1[r]; }
    mk0 = MASKS[tl]; unsigned long long wu = 0ull;
#pragma unroll
    for (int i = 0; i < 8; ++i) wu |= MASKS[i];
    wu &= (qt >= 63) ? ~0ull : ((1ull << (qt + 1)) - 1ull);
    const int nsel = 2 * __popcll(wu); const int tiLo = (t0w > WINB) ? ((t0w - WINB) >> 5) : 0, tiHi = (t0w + 7) >> 5, nwin = tiHi - tiLo + 1;
    if ((wu >> lane) & 1ull) { const int pos = 2 * __popcll(wu & ((1ull << lane) - 1ull)); LIST[pos] = (unsigned short)((2u << 12) | (unsigned)(2 * lane)); LIST[pos + 1] = (unsigned short)((2u << 12) | (unsigned)(2 * lane + 1)); }
    if (lane < nwin) LIST[nsel + lane] = (unsigned short)((3u << 12) | (unsigned)(tiLo + lane));
    LDS_WAIT(); asm volatile("" ::: "memory");
#ifdef DBG_COUNT
    if (lane == 0) { unsigned* CNT = (unsigned*)(F.ws + WS_CTL) + 3000; atomicAdd(CNT + 0, (unsigned)nsel); atomicAdd(CNT + 1, (unsigned)nwin); atomicAdd(CNT + 2, (unsigned)(2 * ntc)); atomicAdd(CNT + 3, 1u); }
#endif
    cur_kind = -1;
    AP_RUN(nsel + nwin);
    const float ltw = xhalf_sum(lsum); const float scw = (ltw > 0.f ? 1.0f / ltw : 0.f) * g2;
#undef AP_RUN
#undef AP_STEP
#undef AP_LOADT
#undef AP_LOADK
#undef AP_LOADV
    {
        bf16* op = WSP(bf16, WS_OA) + row * 512 + head * 64;
#pragma unroll
        for (int r4 = 0; r4 < 4; ++r4) { float a_[4], b_[4];
#pragma unroll
            for (int x = 0; x < 4; ++x) { a_[x] = OAG[(4 * r4 + x) * 64] + D0[4 * r4 + x] * scw; b_[x] = OAG[(16 + 4 * r4 + x) * 64] + D1[4 * r4 + x] * scw; }
            v2u a, b; a.x = pk2(a_[0], a_[1]); a.y = pk2(a_[2], a_[3]); b.x = pk2(b_[0], b_[1]); b.y = pk2(b_[2], b_[3]);
            *(v2u*)(op + 8 * r4 + 4 * h_) = a; *(v2u*)(op + 32 + 8 * r4 + 4 * h_) = b; }
    }
}
#undef AS_TILE

#ifdef DBG_CHECK
__device__ __forceinline__ unsigned dbg_rand(unsigned x) { x ^= x >> 16; x *= 0x7feb352du; x ^= x >> 15; x *= 0x846ca68bu; x ^= x >> 16; return x; }
__device__ __forceinline__ bool dbg_bad(float got, float exp_, float rtol, float atol) { return !(fabsf(got - exp_) <= rtol * fabsf(exp_) + atol); }
__device__ __forceinline__ float bfr(float x) { return __uint_as_float(pk2(x, 0.f) << 16); }
__device__ __forceinline__ int dbg_row(unsigned r) { const unsigned k = r % 20u; if (k == 0) return (int)(PM + (r >> 8) % SM); if (k == 1) return (int)(((r >> 8) % PB) * PT + ((r >> 12) % 8)); if (k == 2) return (int)(((r >> 8) % PB) * PT + PT - 1 - ((r >> 12) % 8)); return (int)((r >> 5) % PM); }
__device__ __forceinline__ float dbg_rs(const Frame& F, int row, int lane) { const float* xr = xrow_in(F, 0, row); float ss = 0.f; for (int d = lane; d < DM; d += 64) ss += xr[d] * xr[d]; return 1.0f / sqrtf(wave_sum(ss) * (1.0f / DM) + EPS); }
__device__ __forceinline__ float dbg_h(const Frame& F, int row, int d, float rs) { const float* mod = WSP(float, WS_MOD) + (size_t)row_bb(row) * 6144; return bfr(xrow_in(F, 0, row)[d] * rs * FIN(I_N1G)[d] * (1.0f + mod[1024 + d]) + mod[d]); }

__device__ __forceinline__ void dbg_check_phase(Frame& F) {
    const int gw = F.bid * NWAVES + F.wave, NGW = F.G * NWAVES, lane = F.lane;
    unsigned* CNT = (unsigned*)(F.ws + WS_CTL) + 3000;
    LAS float* L = (LAS float*)(F.lds + F.wave * 16384);
#define DBG_FLAG(ch, cond) do { if (__any(cond) && lane == 0) atomicAdd(CNT + (ch), 1u); } while (0)
    for (int s = gw; s < 1536; s += NGW) {
        const unsigned r = dbg_rand(1000u + s); const int row = dbg_row(r); const float rs = dbg_rs(F, row, lane); const int kind = s % 6;
        const bool isp = row < PM; const int b = isp ? (row >> 12) : ((row - PM) >> 3), t = isp ? (row & (PT - 1)) : ((row - PM) & 7);
#define DBG_U(col, dst) do { float a_ = 0.f; for (int d_ = lane; d_ < DM; d_ += 64) a_ += dbg_h(F, row, d_, rs) * bfr(FIN(I_WIN)[(size_t)d_ * D_IN + (col)]); dst = wave_sum(a_); } while (0)
        if (kind == 0) {
            const int c = (r >> 3) % 768, j = c >> 7, k = (c >> 6) & 1, dd = c & 63; float u; DBG_U(O_NKV + c, u); bool bad = false;
            if (j < 4) bad = dbg_bad(F.out[(isp ? OUT_ROWS_P + (size_t)row * 512 : OUT_ROWS_S + (size_t)(row - PM) * 512) + c], u, 0.01f, 0.01f);
            else if (isp) { if (t >= PT - WINB) bad = dbg_bad(F.out[OUT_WIN_P + ((size_t)b * WINB + (t - (PT - WINB))) * 256 + (c - 512)], u, 0.01f, 0.01f); }
            else bad = dbg_bad(F.out[OUT_WIN_S + ((size_t)b * WINB + (WINB - ST) + t) * 256 + (c - 512)], u, 0.01f, 0.01f);
            if (isp) { if (j < 2) bad = bad || dbg_bad(bf1(WSP(bf16, WS_ACMP)[((size_t)j * CMP_ROWS_J + 32768 + (b * 2 + k) * 256 + (t >> 4)) * 1024 + (t & 15) * 64 + dd]), u, 0.01f, 0.01f);
                       else bad = bad || dbg_bad(bf1(WSP(bf16, WS_KVB)[((((size_t)(j - 2) * PB + b) * 2 + k) * PT + t) * 64 + dd]), u, 0.01f, 0.01f); }
            else if (j >= 2) bad = bad || dbg_bad(bf1(WSP(bf16, WS_KVS)[((((size_t)(j - 2) * SB + b) * 2 + k) * ST + t) * 64 + dd]), u, 0.01f, 0.01f);
            DBG_FLAG(0, bad);
        } else if (kind == 1) {
            const int gi = (r >> 3) % 24, c5 = (r >> 8) % 512, cm = (r >> 8) % 3072; float u0, u1, u2, u3; DBG_U(O_NG + gi, u0); DBG_U(O_RX + c5, u1); DBG_U(O_RGATE + c5, u2); DBG_U(O_MG + cm, u3);
            bool bad = dbg_bad(WSP(float, WS_NG)[(size_t)row * 24 + gi], 1.0f / (1.0f + expf(-u0)), 0.01f, 0.005f);
            bad = bad || dbg_bad(WSP(float, WS_RX)[(size_t)row * 512 + c5], u1, 0.01f, 0.01f);
            bad = bad || dbg_bad(bf1(WSP(bf16, WS_GG)[(size_t)row * 512 + c5]), gelu_tanh(u2), 0.02f, 0.01f);
            bad = bad || dbg_bad(bf1(WSP(bf16, WS_MGS)[(size_t)row * 3072 + cm]), 1.0f / (1.0f + expf(-u3)), 0.01f, 0.005f);
            DBG_FLAG(1, bad);
        } else if (kind == 2) {
            const int head = (r >> 13) % 4, dim = (r >> 16) % 64, c5 = (r >> 3) % 512; float x1, x2, uv, ug, uq; DBG_U(O_RQ + head * 128 + dim, x1); DBG_U(O_RQ + head * 128 + 64 + dim, x2); DBG_U(O_RV + c5, uv); DBG_U(O_RG + c5, ug); DBG_U(O_NQ + c5, uq);
            const float pos = (float)(isp ? t : PAST + t); const float ang = pos * (float)pow(10000.0, -(double)dim / 64.0); float sn, cs; sincos_acc(ang, sn, cs);
            const bf16* RQ = WSP(bf16, WS_RQ);
            bool bad = dbg_bad(bf1(RQ[(size_t)row * 512 + head * 128 + dim]), x1 * cs - x2 * sn, 0.02f, 0.02f) || dbg_bad(bf1(RQ[(size_t)row * 512 + head * 128 + 64 + dim]), x1 * sn + x2 * cs, 0.02f, 0.02f);
            bad = bad || dbg_bad(bf1(RQ[(size_t)2 * MT * 512 + (size_t)row * 512 + c5]), uv, 0.01f, 0.01f) || dbg_bad(bf1(RQ[(size_t)3 * MT * 512 + (size_t)row * 512 + c5]), ug, 0.01f, 0.01f);
            bad = bad || dbg_bad(bf1(WSP(bf16, WS_QN)[(size_t)row * 512 + c5]), uq * QSCALE, 0.01f, 0.005f);
            DBG_FLAG(2, bad);
        }
#undef DBG_U
    }
    for (int s = gw; s < 128; s += NGW) {
        const unsigned r = dbg_rand(3000u + s); const int j = r & 1; const bool smp = ((r >> 1) & 3) != 0;
        const int grp = smp ? (int)((r >> 3) % 64) : (int)((r >> 3) % 8), nmax = smp ? 511 : 255; int n = (r >> 10) % nmax; if (((r >> 20) & 7) == 0) n = nmax - 1;
        const size_t rj = smp ? (size_t)grp * 512 + n : (size_t)32768 + grp * 256 + n;
        const bf16* A = WSP(bf16, WS_ACMP) + ((size_t)j * CMP_ROWS_J + rj) * 1024;
        const float* w1 = FIN(I_W1) + (size_t)j * 2048 * 128; const float* pe = FIN(I_PE) + j * 2048;
        for (int hh = 0; hh < 2; ++hh) { const int h = lane + 64 * hh; float a = FIN(I_B1)[j * 128 + h];
            for (int i = 0; i < 1024; ++i) a += (bf1(A[i]) + pe[i]) * w1[(size_t)i * 128 + h] + (bf1(A[1024 + i]) + pe[1024 + i]) * w1[(size_t)(1024 + i) * 128 + h];
            L[h] = gelu_tanh(a); }
        LDS_WAIT(); asm volatile("" ::: "memory");
        float o = 0.f; for (int h = 0; h < 128; ++h) o += L[h] * FIN(I_W2)[((size_t)j * 128 + h) * 64 + lane];
        const float got = bf1(WSP(bf16, WS_CK)[((size_t)j * CMP_ROWS_J + rj) * 64 + lane]);
        { const bool bd = dbg_bad(got, o, 0.05f, 0.03f); const unsigned long long mk = __ballot(bd); if (lane == 0 && mk) atomicAdd(CNT + 3, (unsigned)__popcll(mk)); }
        LDS_WAIT(); asm volatile("" ::: "memory");
    }
    for (int s = gw; s < 128; s += NGW) {
        const unsigned r = dbg_rand(3500u + s); const int j = r & 1; const bool smp = ((r >> 1) & 3) != 0;
        const int grp = smp ? (int)((r >> 3) % 64) : (int)((r >> 3) % 8), nmax = smp ? 511 : 255; const int n = (r >> 10) % nmax;
        const size_t rj = smp ? (size_t)grp * 512 + n : (size_t)32768 + grp * 256 + n, row = (size_t)j * CMP_ROWS_J + rj;
        const bf16* A = WSP(bf16, WS_ACMP) + row * 1024; const float* w1 = FIN(I_W1) + (size_t)j * 2048 * 128; const bf16* LH = WSP(bf16, WS_LH);
        unsigned nb = 0;
        for (int hh = 0; hh < 2; ++hh) { const int h = lane + 64 * hh; float lo = 0.f, hi = 0.f;
            for (int i = 0; i < 1024; ++i) { const float av = bf1(A[i]); lo += av * bfr(w1[(size_t)i * 128 + h]); hi += av * bfr(w1[(size_t)(1024 + i) * 128 + h]); }
            const bool bd = dbg_bad(bf1(LH[row * 256 + h]), lo, 0.02f, 0.02f) || dbg_bad(bf1(LH[row * 256 + 128 + h]), hi, 0.02f, 0.02f); nb += (unsigned)__popcll(__ballot(bd)); }
        if (lane == 0 && nb) atomicAdd(CNT + 9, nb);
        for (int hh = 0; hh < 2; ++hh) { const int h = lane + 64 * hh; L[h] = gelu_tanh(bf1(LH[row * 256 + h]) + bf1(LH[(row + 1) * 256 + 128 + h]) + WSP(float, WS_SMALLW + SW_CB)[j * 128 + h]); }
        LDS_WAIT(); asm volatile("" ::: "memory");
        float o = 0.f; for (int h = 0; h < 128; ++h) o += bfr(L[h]) * bfr(FIN(I_W2)[((size_t)j * 128 + h) * 64 + lane]);
        { const bool bd = dbg_bad(bf1(WSP(bf16, WS_CK)[row * 64 + lane]), o, 0.03f, 0.01f); const unsigned long long mk = __ballot(bd); if (lane == 0 && mk) atomicAdd(CNT + 11, (unsigned)__popcll(mk)); }
        LDS_WAIT(); asm volatile("" ::: "memory");
    }
    for (int s = gw; s < 64; s += NGW) {
        const unsigned r = dbg_rand(3700u + s); const int j = r & 1, half = (r >> 1) & 1, h = (r >> 2) % 128; const bf16* W1T = WSP(bf16, WS_SMALLW + SW_W1T) + ((size_t)j * 256 + half * 128 + h) * 1024;
        const float* w1 = FIN(I_W1) + ((size_t)j * 32 + half * 16) * 64 * 128 + h; unsigned nb = 0;
        for (int k = lane; k < 1024; k += 64) nb += (unsigned)__popcll(__ballot(dbg_bad(bf1(W1T[k]), w1[(size_t)k * 128], 0.01f, 0.0001f)));
        if (lane == 0 && nb) atomicAdd(CNT + 12, nb);
        const bool smp = ((r >> 9) & 3) != 0; const int grp = smp ? (int)((r >> 11) % 64) : (int)((r >> 11) % 8), n = (r >> 17) % (smp ? 511 : 255);
        const size_t row = (size_t)j * CMP_ROWS_J + (smp ? (size_t)grp * 512 + n : (size_t)32768 + grp * 256 + n); const bf16* A = WSP(bf16, WS_ACMP) + row * 1024;
        float a = 0.f; for (int k = lane; k < 1024; k += 64) a += bf1(A[k]) * bf1(W1T[k]); a = wave_sum(a);
        DBG_FLAG(13, dbg_bad(bf1(WSP(bf16, WS_LH)[row * 256 + half * 128 + h]), a, 0.02f, 0.02f));
    }
    for (int s = gw; s < 4; s += NGW) {
        const int j = s >> 1, h = (s & 1) * 64 + lane; const float* w1 = FIN(I_W1) + (size_t)j * 2048 * 128; const float* pe = FIN(I_PE) + j * 2048;
        float a = FIN(I_B1)[j * 128 + h]; for (int i = 0; i < 2048; ++i) a += pe[i] * w1[(size_t)i * 128 + h];
        const unsigned long long mk = __ballot(dbg_bad(WSP(float, WS_SMALLW + SW_CB)[j * 128 + h], a, 0.001f, 0.0005f)); if (lane == 0 && mk) atomicAdd(CNT + 10, (unsigned)__popcll(mk));
    }
    for (int s = gw; s < 96; s += NGW) {
        const unsigned r = dbg_rand(4000u + s); const bool smp = (s % 3) == 2;
        int seq, kvh = (r >> 4) & 1, t, tl = 0; size_t row;
        if (smp) { seq = (r >> 5) % SB; tl = (r >> 10) % ST; t = PAST + tl; row = (size_t)PM + seq * ST + tl; }
        else { seq = (r >> 5) % PB; const unsigned k = (r >> 8) % 8u; t = (k == 0) ? (int)((r >> 12) % 40) : (k == 1) ? PT - 1 - (int)((r >> 12) % 70) : (int)((r >> 12) % PT); row = (size_t)seq * PT + t; }
        const int N = smp ? 511 : 255, NS = smp ? 129 : 64, cur = t >> 6;
        LAS float* Q = L; LAS float* SC = L + 256; LAS float* PSUM = L + 256 + 2048; LAS float* OUT = L + 256 + 2048 + 512;
        for (int i = lane; i < 256; i += 64) Q[i] = bf1(WSP(bf16, WS_QN)[row * 512 + (kvh * 4 + (i >> 6)) * 64 + (i & 63)]);
        for (int i = lane; i < 768; i += 64) OUT[i] = 0.f;
        LDS_WAIT(); asm volatile("" ::: "memory");
        const bf16* CKk = WSP(bf16, WS_CK) + (smp ? (size_t)(seq * 2 + kvh) * 512 : (size_t)32768 + (seq * 2 + kvh) * 256) * 64; const bf16* CKv = CKk + (size_t)CMP_ROWS_J * 64;
        const int nvis = smp ? 511 : ((t >= 31) ? ((t - 31) >> 4) + 1 : 0);
        for (int i = lane; i < 512; i += 64) PSUM[i] = 0.f;
        for (int hr = 0; hr < 4; ++hr) {
            float mx = -INFINITY; for (int n = lane; n < nvis; n += 64) { float a = 0.f; for (int d = 0; d < 64; ++d) a += Q[hr * 64 + d] * bf1(CKk[(size_t)n * 64 + d]); SC[n] = a; mx = fmaxf(mx, a); }
            for (int o = 1; o < 64; o <<= 1) mx = fmaxf(mx, __shfl_xor(mx, o));
            float den = 0.f; for (int n = lane; n < nvis; n += 64) { const float e = exp2f(SC[n] - mx); SC[n] = e; den += e; } den = wave_sum(den);
            LDS_WAIT(); asm volatile("" ::: "memory");
            if (nvis > 0) { float o = 0.f; for (int n = 0; n < nvis; ++n) o += SC[n] * bf1(CKv[(size_t)n * 64 + lane]); OUT[hr * 64 + lane] = o / den;
                for (int n = lane; n < nvis; n += 64) PSUM[n] += SC[n] / den; }
            LDS_WAIT(); asm volatile("" ::: "memory");
        }
        LAS float* IMP = SC; LAS float* SELB = SC + 256;
        for (int sblk = lane; sblk < NS; sblk += 64) { float imp = 0.f; for (int n = 4 * sblk - 1; n <= 4 * sblk + 3; ++n) if (n >= 0 && n < N) imp += PSUM[n];
            const bool forced = sblk == 0 || sblk == cur || sblk == cur - 1, avail = sblk * 64 <= t; IMP[sblk] = avail ? (forced ? 1e4f : imp) : -1e4f; SELB[sblk] = 0.f; }
        LDS_WAIT(); asm volatile("" ::: "memory");
        for (int pick = 0; pick < 16 && pick < NS; ++pick) { float bv = -INFINITY; int bi = 1 << 30;
            for (int sblk = lane; sblk < NS; sblk += 64) { const float v = (SELB[sblk] != 0.f) ? -INFINITY : IMP[sblk]; if (v > bv || (v == bv && sblk < bi)) { bv = v; bi = sblk; } }
            for (int o = 1; o < 64; o <<= 1) { const float ov = __shfl_xor(bv, o); const int oi = __shfl_xor(bi, o); if (ov > bv || (ov == bv && oi < bi)) { bv = ov; bi = oi; } }
            if (lane == 0) SELB[bi] = 1.f; LDS_WAIT(); asm volatile("" ::: "memory"); }
        for (int br = 1; br < 3; ++br) for (int hr = 0; hr < 4; ++hr) {
            float mx = -INFINITY, den = 0.f, o = 0.f;
            const int plo = (br == 1) ? 0 : (t - WINB < 0 ? 0 : t - WINB), phi = t;
            for (int p = plo; p <= phi; ++p) {
                if (br == 1 && SELB[p >> 6] == 0.f) { p |= 63; continue; }
                const float* kf = nullptr; const bf16* kb = nullptr; const float* vf = nullptr; const bf16* vb = nullptr;
                const int jk = (br == 1) ? 2 : 4;
                if (!smp) { kb = WSP(bf16, WS_KVB) + ((((size_t)(jk - 2) * PB + seq) * 2 + kvh) * PT + p) * 64; vb = kb + (size_t)PB * 2 * PT * 64; }
                else if (p >= PAST) { kb = WSP(bf16, WS_KVS) + ((((size_t)(jk - 2) * SB + seq) * 2 + kvh) * ST + (p - PAST)) * 64; vb = kb + (size_t)SB * 2 * ST * 64; }
                else if (br == 1) { const int page = ((const int*)F.a->in[I_PT])[seq * NPG + (p >> 7)]; kf = FIN(I_CACHE) + ((((size_t)page * PAGE + (p & 127)) * 4 + 2) * 2 + kvh) * 64; vf = kf + 128; }
                else { kf = FIN(I_CWIN) + ((((size_t)seq * WINB + (p - (PAST - WINB))) * 2 + 0) * 2 + kvh) * 64; vf = kf + 128; }
                float a = 0.f; for (int d = 0; d < 64; ++d) a += Q[hr * 64 + d] * (kb ? bf1(kb[d]) : bfr(kf[d]));
                const float vv = vb ? bf1(vb[lane]) : bfr(vf[lane]);
                const float mn = fmaxf(mx, a), al = exp2f(mx - mn), e = exp2f(a - mn); den = den * al + e; o = o * al + e * vv; mx = mn;
            }
            OUT[(br * 4 + hr) * 64 + lane] = (den > 0.f) ? o / den : 0.f;
        }
        LDS_WAIT(); asm volatile("" ::: "memory");
        bool bad = false;
        for (int hr = 0; hr < 4; ++hr) { const float* ng = WSP(float, WS_NG) + row * 24 + (kvh * 4 + hr) * 3;
            const float e = ng[0] * OUT[(0 * 4 + hr) * 64 + lane] + ng[1] * OUT[(1 * 4 + hr) * 64 + lane] + ng[2] * OUT[(2 * 4 + hr) * 64 + lane];
            bad = bad || dbg_bad(bf1(WSP(bf16, WS_OA)[row * 512 + (kvh * 4 + hr) * 64 + lane]), e, 0.04f, 0.004f); }
        DBG_FLAG(smp ? 5 : 4, bad);
        LDS_WAIT(); asm volatile("" ::: "memory");
    }
    for (int s = gw; s < 96; s += NGW) {
        const unsigned r = dbg_rand(6000u + s); const bool smp = (s % 3) == 2; const int h = (r >> 3) & 3; const float lg = ret_log_g(h);
        const bf16* RQ = WSP(bf16, WS_RQ); const bf16* RK = RQ + (size_t)MT * 512; const bf16* RV = RQ + (size_t)2 * MT * 512; const bf16* RG = RQ + (size_t)3 * MT * 512;
        int seq, t; size_t row0; if (smp) { seq = (r >> 5) % SB; t = (r >> 10) % ST; row0 = (size_t)PM + seq * ST; } else { seq = (r >> 5) % PB; const unsigned k = (r >> 8) % 4u; t = (k == 0) ? (int)((r >> 12) % 300) : (int)((r >> 12) % PT); row0 = (size_t)seq * PT; }
        float o0 = 0.f, o1 = 0.f;
        for (int d = lane; d < 128; d += 64) L[d] = bf1(RQ[(row0 + t) * 512 + h * 128 + d]);
        LDS_WAIT(); asm volatile("" ::: "memory");
        for (int j = 0; j <= t; ++j) { float a = 0.f; for (int d = 0; d < 128; ++d) a += L[d] * bf1(RK[(row0 + j) * 512 + h * 128 + d]);
            a *= expf((float)(t - j) * lg); o0 += a * bf1(RV[(row0 + j) * 512 + h * 128 + lane]); o1 += a * bf1(RV[(row0 + j) * 512 + h * 128 + 64 + lane]); }
        if (smp) { const float* S0 = FIN(I_SRET) + (((size_t)0 * SB + seq) * 4 + h) * 16384; const float cr = expf((float)(t + 1) * lg);
            for (int d = 0; d < 128; ++d) { o0 += L[d] * S0[d * 128 + lane] * cr; o1 += L[d] * S0[d * 128 + 64 + lane] * cr; } }
        const float mean = wave_sum(o0 + o1) * (1.0f / 128.0f); const float var = wave_sum((o0 - mean) * (o0 - mean) + (o1 - mean) * (o1 - mean)) * (1.0f / 128.0f), rstd = 1.0f / sqrtf(var + EPS);
        const float* GN = FIN(I_GNG) + h * 128; const bf16* OR_ = WSP(bf16, WS_OA) + (size_t)MT * 512;
        const float g0 = bf1(RG[(row0 + t) * 512 + h * 128 + lane]), g1 = bf1(RG[(row0 + t) * 512 + h * 128 + 64 + lane]);
        const float e0 = (o0 - mean) * rstd * GN[lane] * (g0 / (1.0f + expf(-g0))), e1 = (o1 - mean) * rstd * GN[64 + lane] * (g1 / (1.0f + expf(-g1)));
        DBG_FLAG(6, dbg_bad(bf1(OR_[(row0 + t) * 512 + h * 128 + lane]), e0, 0.04f, 0.02f) || dbg_bad(bf1(OR_[(row0 + t) * 512 + h * 128 + 64 + lane]), e1, 0.04f, 0.02f));
        const int d = (r >> 20) % 128, T = smp ? ST : PT; float s0 = 0.f, s1 = 0.f;
        for (int j = 0; j < T; ++j) { const float kk = bf1(RK[(row0 + j) * 512 + h * 128 + d]) * expf((float)(T - 1 - j) * lg); s0 += kk * bf1(RV[(row0 + j) * 512 + h * 128 + lane]); s1 += kk * bf1(RV[(row0 + j) * 512 + h * 128 + 64 + lane]); }
        const float* SO;
        if (smp) { const float* S0 = FIN(I_SRET) + (((size_t)0 * SB + seq) * 4 + h) * 16384; const float g8 = expf(8.0f * lg); s0 += g8 * S0[d * 128 + lane]; s1 += g8 * S0[d * 128 + 64 + lane]; SO = F.out + OUT_RET_S + (((size_t)0 * SB + seq) * 4 + h) * 16384; }
        else SO = F.out + OUT_RET_P + (((size_t)0 * PB + seq) * 4 + h) * 16384;
        DBG_FLAG(7, dbg_bad(SO[d * 128 + lane], s0, 0.02f, 0.02f) || dbg_bad(SO[d * 128 + 64 + lane], s1, 0.02f, 0.02f));
        LDS_WAIT(); asm volatile("" ::: "memory");
    }
    for (int s = gw; s < 48; s += NGW) {
        const unsigned r = dbg_rand(8000u + s); const bool smp = (s % 3) == 2; const int blk = (r >> 3) & 7, c = blk * 64 + lane;
        int seq, T; size_t row0; if (smp) { seq = (r >> 6) % SB; T = ST; row0 = (size_t)PM + seq * ST; } else { seq = (r >> 6) % PB; T = 1 + (int)((r >> 10) % ((s & 1) ? 200 : PT)); row0 = (size_t)seq * PT; }
        const float* RX = WSP(float, WS_RX); const float* cw = FIN(I_RCW); const float cb = FIN(I_RCB)[c];
        float x3 = 0.f, x2 = 0.f, x1 = 0.f, h = 0.f;
        if (smp) { const float* cv = FIN(I_SCONV) + (size_t)seq * 3 * 512; x3 = cv[c]; x2 = cv[512 + c]; x1 = cv[1024 + c]; h = FIN(I_SH)[(size_t)seq * 512 + c]; }
        const float sp = log1pf(expf(-FIN(I_LAM)[c])); const float* wa = FIN(I_RWA) + (size_t)blk * 4096; const float* wx = FIN(I_RWX) + (size_t)blk * 4096;
        for (int t = 0; t < T; ++t) { const float x0 = RX[(row0 + t) * 512 + c]; const float xc = cb + cw[c] * x3 + cw[512 + c] * x2 + cw[1024 + c] * x1 + cw[1536 + c] * x0; x3 = x2; x2 = x1; x1 = x0;
            L[lane] = xc; LDS_WAIT(); asm volatile("" ::: "memory");
            float ra = FIN(I_RBA)[c], ri = FIN(I_RBX)[c]; for (int i = 0; i < 64; ++i) { ra += L[i] * wa[i * 64 + lane]; ri += L[i] * wx[i * 64 + lane]; }
            LDS_WAIT(); asm volatile("" ::: "memory");
            const float rr = 1.0f / (1.0f + expf(-ra)), ii = 1.0f / (1.0f + expf(-ri)), la = -8.0f * rr * sp, a = expf(la); h = a * h + sqrtf(-expm1f(2.0f * la)) * (ii * xc); }
        const size_t o = (row0 + T - 1) * 512 + c; const float e = h * bf1(WSP(bf16, WS_GG)[o]);
        DBG_FLAG(8, dbg_bad(bf1((WSP(bf16, WS_OA) + (size_t)2 * MT * 512)[o]), e, 0.04f, 0.01f));
    }
    for (int s = gw; s < 512; s += NGW) {
        const unsigned r = dbg_rand(9000u + s); const int row = dbg_row(r), col = (r >> 7) % DM;
        float e = 0.f;
        for (int br = 0; br < 3; ++br) { const bf16* O = WSP(bf16, WS_OA) + (size_t)br * MT * 512 + (size_t)row * 512; const float* W = FIN(br == 0 ? I_WBRA : (br == 1 ? I_WBRB : I_WBRC));
            float a = 0.f; for (int k = lane; k < 512; k += 64) a += bf1(O[k]) * bfr(W[(size_t)k * DM + col]); a = wave_sum(a); e += bf1(WSP(bf16, WS_MGS)[(size_t)row * 3072 + br * 1024 + col]) * a; }
        DBG_FLAG(20, dbg_bad(bf1(WSP(bf16, WS_MRG)[(size_t)row * DM + col]), e, 0.03f, 0.01f));
        const float* mod = WSP(float, WS_MOD) + (size_t)row_bb(row) * 6144;
        { float a = 0.f; for (int k = lane; k < DM; k += 64) a += bf1(WSP(bf16, WS_MRG)[(size_t)row * DM + k]) * bfr(FIN(I_WOUT)[(size_t)k * DM + col]); a = wave_sum(a);
          const float ex = xrow_in(F, 0, row)[col] + mod[2048 + col] * a; DBG_FLAG(21, dbg_bad(WSP(float, WS_X1)[(size_t)row * DM + col], ex, 0.005f, 0.005f)); }
        { const float* xr = WSP(float, WS_X1) + (size_t)row * DM; float ss = 0.f; for (int d = lane; d < DM; d += 64) ss += xr[d] * xr[d]; const float rs = 1.0f / sqrtf(wave_sum(ss) * (1.0f / DM) + EPS);
          const int c2 = (r >> 9) % NUP; float a = 0.f; for (int d = lane; d < DM; d += 64) a += bfr(xr[d] * rs * FIN(I_N2G)[d] * (1.0f + mod[4096 + d]) + mod[3072 + d]) * bfr(FIN(I_WUP)[(size_t)d * NUP + c2]); a = wave_sum(a);
          const float got = c2 < DFF ? bf1(WSP(bf16, WS_GP)[(size_t)row * DFF + c2]) : bf1((WSP(bf16, WS_GP) + (size_t)MT * DFF)[(size_t)row * DFF + c2 - DFF]); DBG_FLAG(22, dbg_bad(got, a, 0.02f, 0.01f)); }
        { const int c3 = (r >> 11) % DFF; const bf16* GP = WSP(bf16, WS_GP); const bf16* VAL = GP + (size_t)MT * DFF; const float* cw = FIN(I_FCW);
          const bool isp = row < PM; const int t = isp ? (row & (PT - 1)) : ((row - PM) & 7); float xm2, xm1;
          if (t >= 2) { xm2 = bf1(GP[(size_t)(row - 2) * DFF + c3]); xm1 = bf1(GP[(size_t)(row - 1) * DFF + c3]); }
          else if (isp) { xm2 = 0.f; xm1 = (t == 1) ? bf1(GP[(size_t)(row - 1) * DFF + c3]) : 0.f; }
          else { const float* st = FIN(I_SFFN) + ((size_t)((row - PM) >> 3) * 2) * DFF + c3; xm2 = (t == 0) ? st[0] : st[DFF]; xm1 = (t == 0) ? st[DFF] : bf1(GP[(size_t)(row - 1) * DFF + c3]); }
          const float y = FIN(I_FCB)[c3] + cw[c3] * xm2 + cw[DFF + c3] * xm1 + cw[2 * DFF + c3] * bf1(GP[(size_t)row * DFF + c3]); const float ex = (y / (1.0f + expf(-y))) * bf1(VAL[(size_t)row * DFF + c3]);
          DBG_FLAG(23, dbg_bad(bf1((GP + (size_t)2 * MT * DFF)[(size_t)row * DFF + c3]), ex, 0.02f, 0.005f)); }
        { const bf16* ACT = WSP(bf16, WS_GP) + (size_t)2 * MT * DFF + (size_t)row * DFF; float a = 0.f; for (int k = lane; k < DFF; k += 64) a += bf1(ACT[k]) * bfr(FIN(I_WDN)[(size_t)k * DM + col]); a = wave_sum(a);
          const float ex = WSP(float, WS_X1)[(size_t)row * DM + col] + mod[5120 + col] * a; DBG_FLAG(24, dbg_bad(WSP(float, WS_X2)[(size_t)row * DM + col], ex, 0.005f, 0.005f)); }
    }
#undef DBG_FLAG
}
__device__ __forceinline__ void dbg_report_phase(Frame& F) {
    const unsigned* CNT = (const unsigned*)(F.ws + WS_CTL) + 3000;
    const size_t ooff[14] = {OUT_Y, OUT_Y + (size_t)PM * DM, OUT_ROWS_P, OUT_ROWS_S, OUT_WIN_P, OUT_WIN_S, OUT_RET_P, OUT_RET_S, OUT_H_P, OUT_H_S, OUT_CV_P, OUT_CV_S, OUT_FC_P, OUT_FC_S};
    if (F.bid == 0 && F.tid < 14) { const int b = F.tid; const unsigned c = CNT[b]; const int cnt = 1 + (int)(c > 1000u ? 1000u : c);
        for (int i = 0; i < cnt; ++i) ((unsigned*)F.out)[ooff[b] + 7 + 2 * i] = 0xAAAAAAAAu; }
}
#endif

#ifndef DBG_SUB
#define DBG_SUB 0xFFFF
#endif
#ifndef DBG_MAXPH
#define DBG_MAXPH N_PHASES
#endif
#ifndef DBG_REPEAT
#define DBG_REPEAT 0
#endif
#ifndef DBG_MASK
#define DBG_MASK 0xFFFF
#endif
#define IN(k) (lo <= (k) && (k) < hi)
#ifdef DBG_TIME
#define SEAM(k) do { if ((k) + 1 < hi) { if (MK_N_LAUNCHES == 1) xcd_barrier(bar); } if (F.bid == 0 && F.tid == 0) ((unsigned long long*)(F.ws + WS_CTL))[2048 + (k) + 1] = __builtin_amdgcn_s_memrealtime(); } while (0)
#else
#define SEAM(k) do { if ((k) + 1 < hi) { if (MK_N_LAUNCHES == 1) xcd_barrier(bar); } } while (0)
#endif
template <int l> __device__ __forceinline__ void ph_win(Frame& F) { unsigned char* ws = F.ws;
    pg8::Gemm g{(const pg8::bf16_t*)(ws + WS_H), (const pg8::bf16_t*)(ws + WS_WIN) + (size_t)l * NIN * DM, MT, NIN, DM};
    pg8::StaticOrder S; S.init(MT, NIN, F.G, F.bid); EpiWin E{ws, F.out, l};
    pg8::gemm_phase<EpiWin, pg8::StaticOrder, true, true>(F.lds, g, S, E); }
template <int l> __device__ __forceinline__ void ph_mix1(Frame& F) {
    for (int x = F.bid; x < 512; x += F.G) { launder(F); cmp_gemm_unit<true>(F, l, x >> 8, (x & 255) >> 2, (x & 3) * 128); }
    {
        unsigned* ctr = (unsigned*)(F.ws + WS_CTL) + 3210 + l; volatile LAS int* QI = (volatile LAS int*)(F.lds + MISC_OFF + 128);
#pragma unroll 1
        for (;;) {
            __syncthreads();
            if (F.tid == 0) QI[0] = (int)__hip_atomic_fetch_add(ctr, 1u, __ATOMIC_RELAXED, __HIP_MEMORY_SCOPE_AGENT);
            __syncthreads();
            const int u = __builtin_amdgcn_readfirstlane(QI[0]);
            if (u >= 32 + 768) break;
            launder(F);
            if (u < 32) cmp_gemm_unit<false>(F, l, u >> 4, (u >> 1) & 7, (u & 1) * 128); else if (u < 32 + 256) rglru_unit<0>(F, l, u - 32); else ret_local_unit(F, u - 32 - 256);
        }
        __syncthreads();
    } }
template <int l> __device__ __forceinline__ void ph_mix2(Frame& F) { cmp2_phase(F, l); ret_scan_phase(F, l); rglru_carry_phase(F, l); }
#ifndef DBG_REPQ
#define DBG_REPQ 0
#endif
constexpr int MQ_SA = 64, MQ_PA = MQ_SA + 512, MQ_RG1 = MQ_PA + 256, MQ_RO = MQ_RG1 + 512, MQ_RS = MQ_RO + 128, MQ_RG2 = MQ_RS + 32;
template <int l> __device__ __forceinline__ void ph_mix3(Frame& F) {
    unsigned* ctr = (unsigned*)(F.ws + WS_CTL) + 3200 + l;
    volatile LAS int* QI = (volatile LAS int*)(F.lds + MISC_OFF + 128);
#pragma unroll 1
    for (;;) {
        __syncthreads();
        if (F.tid == 0) QI[0] = (int)__hip_atomic_fetch_add(ctr, 1u, __ATOMIC_RELAXED, __HIP_MEMORY_SCOPE_AGENT);
        __syncthreads();
        const int u = __builtin_amdgcn_readfirstlane(QI[0]);
        if (u >= MQ_RG2) break;
        launder(F);
        if (u < MQ_SA) { attn_sample_unit(F, l, u); if (DBG_REPQ & 2) { launder(F); attn_sample_unit(F, l, u); } }
        else if (u < MQ_PA) { const int v = u - MQ_SA; attn_prompt_unit(F, l, (v & 7) * 64 + 63 - (v >> 3)); if (DBG_REPQ & 1) { launder(F); attn_prompt_unit(F, l, (v & 7) * 64 + 63 - (v >> 3)); } }
        else if (u < MQ_RG1) { rglru_unit<1>(F, l, u - MQ_PA); }
        else if (u < MQ_RO) { ret_out_unit(F, l, u - MQ_RG1); }
        else if (u < MQ_RS) { ret_sample_unit(F, l, u - MQ_RO); }
        else { rglru_unit<2>(F, l, u - MQ_RS); }
    }
    __syncthreads(); }
__device__ __forceinline__ f32x16 smp_tile_acc(Frame& F, const bf16* A, const bf16* Wt, int K, int tile) {
    const int q = F.lane & 31, h_ = F.lane >> 5, ks8 = K / 8, kb = F.wave * ks8;
    const bf16* ap = A + (size_t)((tile >> 5) * 32 + q) * K + kb + 8 * h_; const bf16* bp = Wt + (size_t)((tile & 31) * 32 + q) * K + kb + 8 * h_; f32x16 acc = (f32x16){};
#pragma unroll 11
    for (int kk = 0; kk < ks8 / 16; ++kk) acc = mfma32(*(const bf16x8*)(ap + 16 * kk), *(const bf16x8*)(bp + 16 * kk), acc);
    return acc;
}
__device__ __forceinline__ void smp_tile_put(Frame& F, const f32x16& acc, int slot) { LAS float* R = (LAS float*)(F.lds + slot * 32768) + F.wave * 1024 + F.lane;
#pragma unroll
    for (int r = 0; r < 16; ++r) R[r * 64] = acc[r]; }
__device__ __forceinline__ float smp_tile_get(Frame& F, int slot, int o) { const LAS float* R = (const LAS float*)(F.lds + slot * 32768) + o; float s = 0.f;
#pragma unroll
    for (int w = 0; w < 8; ++w) s += R[w * 1024];
    return s; }
template <int l> __device__ __forceinline__ void ph_br(Frame& F) { unsigned char* ws = F.ws;
    const pg8::bf16_t* wbr = (const pg8::bf16_t*)(ws + WS_WBR) + (size_t)l * 3 * 1024 * 512;
    for (int tile = F.bid; tile < 256; tile += F.G) {
        const f32x16 a0 = smp_tile_acc(F, (const bf16*)(ws + WS_OA) + (size_t)PM * 512, wbr, 512, tile), a1 = smp_tile_acc(F, (const bf16*)(ws + WS_OA) + (size_t)(MT + PM) * 512, wbr + (size_t)1024 * 512, 512, tile),
                     a2 = smp_tile_acc(F, (const bf16*)(ws + WS_OA) + (size_t)(2 * MT + PM) * 512, wbr + (size_t)2 * 1024 * 512, 512, tile);
        __syncthreads(); smp_tile_put(F, a0, 0); smp_tile_put(F, a1, 1); smp_tile_put(F, a2, 2); __syncthreads();
        const bf16* MG = (const bf16*)(ws + WS_MGS); bf16* MR = (bf16*)(ws + WS_MRG);
#pragma unroll
        for (int e = 0; e < 2; ++e) { const int o = F.tid * 2 + e, r = o >> 6, ln = o & 63; const size_t row = (size_t)PM + (tile >> 5) * 32 + (r & 3) + 8 * (r >> 2) + 4 * (ln >> 5); const int col = (tile & 31) * 32 + (ln & 31);
            const bf16* g = MG + row * 3072 + col; MR[row * DM + col] = (bf16)(pk2(bf1(g[0]) * smp_tile_get(F, 0, o) + bf1(g[1024]) * smp_tile_get(F, 1, o) + bf1(g[2048]) * smp_tile_get(F, 2, o), 0.f) & 0xffffu); }
    }
    __syncthreads();
    BrOrder S; S.S.init(PM, DM, F.G, F.bid);
    pg8::Gemm g{(const pg8::bf16_t*)(ws + WS_OA), wbr, 3 * MT, 3 * DM, 512}; EpiBrAll E{ws};
    pg8::gemm_phase<EpiBrAll, BrOrder, true, true>(F.lds, g, S, E); }
template <bool INF32> __device__ __forceinline__ void smp_res(Frame& F, const bf16* A, const bf16* Wt, int K, const void* xin  , bf16* xout  , const float* mod, int gofs) {
    for (int tile = F.bid; tile < 256; tile += F.G) {
        const f32x16 a = smp_tile_acc(F, A, Wt, K, tile);
        __syncthreads(); smp_tile_put(F, a, 0); __syncthreads();
#pragma unroll
        for (int e = 0; e < 2; ++e) { const int o = F.tid * 2 + e, r = o >> 6, ln = o & 63; const int rr = (tile >> 5) * 32 + (r & 3) + 8 * (r >> 2) + 4 * (ln >> 5), col = (tile & 31) * 32 + (ln & 31);
            const float xi = INF32 ? ((const float*)xin)[(size_t)rr * DM + col] : bf1(((const bf16*)xin)[(size_t)rr * DM + col]);
            xout[(size_t)rr * DM + col] = (bf16)(pk2(xi + mod[(size_t)(4 + (rr >> 3)) * 6144 + gofs + col] * smp_tile_get(F, 0, o), 0.f) & 0xffffu); }
    }
    __syncthreads();
}
template <int l> __device__ __forceinline__ void ph_out(Frame& F) { unsigned char* ws = F.ws;
    const float* mod = (const float*)(ws + WS_MOD) + (size_t)l * 36 * 6144;
    smp_res<l == 0>(F, (const bf16*)(ws + WS_MRG) + (size_t)PM * DM, (const bf16*)(ws + WS_WOUT) + (size_t)l * DM * DM, DM, l == 0 ? (const void*)FIN(I_XS) : (const void*)((const bf16*)(ws + WS_X2) + (size_t)PM * DM), (bf16*)(ws + WS_X1) + (size_t)PM * DM, mod, 2048);
    pg8::Gemm g{(const pg8::bf16_t*)(ws + WS_MRG), (const pg8::bf16_t*)(ws + WS_WOUT) + (size_t)l * DM * DM, PM, DM, DM};
    pg8::StaticOrder S; S.init(PM, DM, F.G, F.bid);
    EpiRes<l == 0> E{l == 0 ? (const void*)FIN(I_XP) : (const void*)(ws + WS_X2), (bf16*)(ws + WS_X1), mod, 2048};
    pg8::gemm_phase<EpiRes<l == 0>, pg8::StaticOrder, true, true>(F.lds, g, S, E); }
template <int l> __device__ __forceinline__ void ph_down(Frame& F) { unsigned char* ws = F.ws;
    const float* mod = (const float*)(ws + WS_MOD) + (size_t)l * 36 * 6144;
    smp_res<false>(F, (const bf16*)(ws + WS_GP) + (size_t)2 * MT * DFF + (size_t)PM * DFF, (const bf16*)(ws + WS_WDN) + (size_t)l * DM * DFF, DFF, (const void*)((const bf16*)(ws + WS_X1) + (size_t)PM * DM), (bf16*)(ws + WS_X2) + (size_t)PM * DM, mod, 5120);
    pg8::Gemm g{(const pg8::bf16_t*)(ws + WS_GP) + (size_t)2 * MT * DFF, (const pg8::bf16_t*)(ws + WS_WDN) + (size_t)l * DM * DFF, PM, DM, DFF};
    pg8::StaticOrder S; S.init(PM, DM, F.G, F.bid);
    EpiRes<false> E{(const void*)(ws + WS_X1), (bf16*)(ws + WS_X2), mod, 5120};
    pg8::gemm_phase<EpiRes<false>, pg8::StaticOrder, true, true>(F.lds, g, S, E); }
template <int l> __device__ __forceinline__ void ph_up(Frame& F) { unsigned char* ws = F.ws;
    pg8::Gemm g{(const pg8::bf16_t*)(ws + WS_H), (const pg8::bf16_t*)(ws + WS_WUP) + (size_t)l * NUP * DM, MT, NUP, DM};
    pg8::StaticOrder S; S.init(MT, NUP, F.G, F.bid); EpiUp E{ws, F.out, l};
    pg8::gemm_phase<EpiUp, pg8::StaticOrder, true, true>(F.lds, g, S, E); }
#define RUNPH(bit, ph, CALL) do { if (((DBG_MASK >> (bit)) & 1) && IN(ph)) { launder(F); CALL; if ((DBG_REPEAT >> (bit)) & 1) { launder(F); CALL; } SEAM(ph); } } while (0)
template <int l> __device__ __forceinline__ void layer_phases(Frame& F, const XcdBarrier& bar, int lo, int hi) {
    constexpr int pb = PH_L0 + l * PH_PER_LAYER;
    RUNPH(1, pb + LP_N1, norm_phase(F, l, 0));
    RUNPH(2, pb + LP_WIN, ph_win<l>(F));
    RUNPH(3, pb + LP_MIX1, ph_mix1<l>(F));
    RUNPH(4, pb + LP_MIX2, ph_mix2<l>(F));
    RUNPH(5, pb + LP_MIX3, ph_mix3<l>(F));
    RUNPH(6, pb + LP_BR, ph_br<l>(F));
    RUNPH(7, pb + LP_OUT, ph_out<l>(F));
    RUNPH(8, pb + LP_N2, norm_phase(F, l, 1));
    RUNPH(9, pb + LP_UP, ph_up<l>(F));
    RUNPH(10, pb + LP_CONV, convact_phase(F, l));
    RUNPH(11, pb + LP_DOWN, ph_down<l>(F));
}
__global__ void __launch_bounds__(NTHR, 2) trunk_fwd(Args args) {
    extern __shared__ __attribute__((aligned(16))) unsigned char lds_raw[];
    Frame F;
    F.lds = (LAS unsigned char*)lds_raw;
    F.tid = threadIdx.x; F.lane = F.tid & 63; F.wave = __builtin_amdgcn_readfirstlane(F.tid >> 6);
    F.G = gridDim.x; F.bid = blockIdx.x; F.a = &args; F.ws = args.ws; F.out = args.out;
    volatile LAS unsigned* MISC = (volatile LAS unsigned*)(F.lds + MISC_OFF);
    for (int u = F.tid; u < 64; u += NTHR) MISC[u] = 0u;
    __syncthreads();
    unsigned* barw = (unsigned*)(F.ws + WS_CTL) + CW_BAR;
    XcdBarrier bar; bar.bar = barw; bar.x = 0; bar.st = nullptr;
    if (MK_N_LAUNCHES == 1) bar = xcd_barrier_post(barw, MISC + 8);
    const int lo = args.ph_lo, hi = args.ph_hi;
    unsigned char* ws = F.ws;

#ifdef DBG_TIME
    if (F.bid == 0 && F.tid == 0) ((unsigned long long*)(F.ws + WS_CTL))[2048] = __builtin_amdgcn_s_memrealtime();
#endif
    RUNPH(0, PH_P0, p0_prologue(F));

    layer_phases<0>(F, bar, lo, hi);
    layer_phases<1>(F, bar, lo, hi);
    if (((DBG_MASK >> 12) & 1) && IN(PH_FINAL)) { launder(F); final_phase(F); if ((DBG_REPEAT >> 12) & 1) { launder(F); final_phase(F); } }
#ifdef DBG_TIME
    {
        xcd_barrier(bar);
        if (F.bid == 0 && F.tid < 14) {
            const unsigned long long* ts = (const unsigned long long*)(F.ws + WS_CTL) + 2048; const unsigned long long tend = __builtin_amdgcn_s_memrealtime();
            const size_t ooff[14] = {OUT_Y, OUT_Y + (size_t)PM * DM, OUT_ROWS_P, OUT_ROWS_S, OUT_WIN_P, OUT_WIN_S, OUT_RET_P, OUT_RET_S, OUT_H_P, OUT_H_S, OUT_CV_P, OUT_CV_S, OUT_FC_P, OUT_FC_S};
            const int b = F.tid; unsigned long long d;
            if (b == 0) d = tend - ts[0]; else if (b == 1) d = ts[1] - ts[0]; else if (b == 13) d = tend - ts[PH_FINAL];
            else { const int ph = PH_L0 + DBG_TIME_LAYER * PH_PER_LAYER + (b - 2); d = ts[ph + 1] - ts[ph]; }
            int cnt = (int)(d / 100ull); if (cnt < 1) cnt = 1; if (cnt > 2000 && b != 0) cnt = 2000;
            for (int i = 0; i < cnt; ++i) ((unsigned*)F.out)[ooff[b] + 7 + 2 * i] = 0xAAAAAAAAu;
        }
    }
#endif
#ifdef DBG_COUNT
    {
        xcd_barrier(bar);
        if (F.bid == 0 && F.tid < 3) { const unsigned* CNT = (const unsigned*)(F.ws + WS_CTL) + 3000; const size_t ooff[3] = {OUT_Y, OUT_Y + (size_t)PM * DM, OUT_ROWS_P};
            const int cnt = (int)((unsigned long long)CNT[F.tid] * 10ull / (CNT[3] ? CNT[3] : 1u)); for (int i = 0; i < cnt; ++i) ((unsigned*)F.out)[ooff[F.tid] + 7 + 2 * i] = 0xAAAAAAAAu; }
    }
#endif
#ifdef DBG_CHECK
    if (lo == 100) { launder(F); dbg_check_phase(F); }
    if (lo == 101) { for (size_t i = (size_t)F.bid * NTHR + F.tid; i < OUT_END; i += (size_t)F.G * NTHR) F.out[i] = 0.f; }
    if (lo == 102) { launder(F); dbg_report_phase(F); }
#endif
}

extern "C" void kernel_launch(void* const* d_in, const int* in_sizes, int n_in, void* d_out, int out_size, void* d_ws, size_t ws_size, hipStream_t stream) {
    static int grid = 0;
    if (grid == 0) {
        if (n_in != 37 || (size_t)out_size != OUT_END || ws_size < WS_END) { fprintf(stderr, "kernel_launch: unexpected shapes: n_in %d out %d (want %zu) ws %zu (want %zu)\n", n_in, out_size, (size_t)OUT_END, ws_size, (size_t)WS_END); grid = -1; return; }
        int dev = 0, cus = 0, per_cu = 0;
        if (hipGetDevice(&dev) != hipSuccess || hipDeviceGetAttribute(&cus, hipDeviceAttributeMultiprocessorCount, dev) != hipSuccess) { grid = -1; return; }
        if (hipFuncSetAttribute((const void*)trunk_fwd, hipFuncAttributeMaxDynamicSharedMemorySize, LDS_BYTES) != hipSuccess) { fprintf(stderr, "kernel_launch: hipFuncSetAttribute failed\n"); grid = -1; return; }
        if (hipOccupancyMaxActiveBlocksPerMultiprocessor(&per_cu, (const void*)trunk_fwd, NTHR, LDS_BYTES) != hipSuccess || per_cu < 1) fprintf(stderr, "kernel_launch: occupancy query reports %d\n", per_cu);
        (void)hipGetLastError();
        grid = cus;
    }
    if (grid < 0) return;
    if (hipMemsetAsync((char*)d_ws + WS_CTL, 0, CTL_ZERO_BYTES, stream) != hipSuccess) return;
#ifdef DBG_POISON
    (void)hipMemsetAsync((char*)d_ws + CTL_ZERO_BYTES, 0xAA, WS_END - CTL_ZERO_BYTES, stream);
    (void)hipMemsetAsync(d_out, 0xAA, (size_t)OUT_END * 4, stream);
#endif
    Args a{};
    for (int i = 0; i < 37; ++i) a.in[i] = d_in[i];
    a.out = (float*)d_out; a.ws = (unsigned char*)d_ws;
#if MK_N_LAUNCHES == 1
    a.ph_lo = 0; a.ph_hi = N_PHASES;
    hipLaunchKernelGGL(trunk_fwd, dim3(grid), dim3(NTHR), LDS_BYTES, stream, a);
#else
    for (int p = 0; p < DBG_MAXPH; ++p) { a.ph_lo = p; a.ph_hi = p + 1; hipLaunchKernelGGL(trunk_fwd, dim3(grid), dim3(NTHR), LDS_BYTES, stream, a); }
#ifdef DBG_CHECK
    for (int p = 100; p < 103; ++p) { a.ph_lo = p; a.ph_hi = p + 1; hipLaunchKernelGGL(trunk_fwd, dim3(grid), dim3(NTHR), LDS_BYTES, stream, a); }
#endif
#endif
    (void)in_sizes;
}
```

```cpp
#include <hip/hip_runtime.h>
#include <cstdio>
#include <cstdint>

#ifndef MK_N_LAUNCHES
#define MK_N_LAUNCHES 1
#endif

constexpr int DM = 1024, PB = 4, PT = 4096, PM = PB * PT, SB = 32, ST = 8, SM = SB * ST, MT = PM + SM;
constexpr int DEPTH = 2, PAST = 8192, PAGE = 128, NPG = PAST / PAGE, NPHYS = 2560;
constexpr int D_IN = 7448, NIN = 7680, DFF = 2816, NUP = 2 * DFF;
constexpr int WINB = 512;
constexpr float EPS = 1e-6f;
constexpr float QSCALE = 0.125f * 1.4426950408889634f;

constexpr int O_NQ = 0, O_NKV = 512, O_NG = 1280, O_RQ = 1304, O_RK = 1816, O_RV = 2328, O_RG = 2840, O_RX = 3352, O_RGATE = 3864, O_MG = 4376;

constexpr size_t OUT_Y = 0;
constexpr size_t OUT_ROWS_P = OUT_Y + (size_t)MT * DM;
constexpr size_t OUT_ROWS_S = OUT_ROWS_P + (size_t)DEPTH * PM * 512;
constexpr size_t OUT_WIN_P = OUT_ROWS_S + (size_t)DEPTH * SM * 512;
constexpr size_t OUT_WIN_S = OUT_WIN_P + (size_t)DEPTH * PB * WINB * 256;
constexpr size_t OUT_RET_P = OUT_WIN_S + (size_t)DEPTH * SB * WINB * 256;
constexpr size_t OUT_RET_S = OUT_RET_P + (size_t)DEPTH * PB * 4 * 16384;
constexpr size_t OUT_H_P = OUT_RET_S + (size_t)DEPTH * SB * 4 * 16384;
constexpr size_t OUT_H_S = OUT_H_P + (size_t)DEPTH * PB * 512;
constexpr size_t OUT_CV_P = OUT_H_S + (size_t)DEPTH * SB * 512;
constexpr size_t OUT_CV_S = OUT_CV_P + (size_t)DEPTH * PB * 3 * 512;
constexpr size_t OUT_FC_P = OUT_CV_S + (size_t)DEPTH * SB * 3 * 512;
constexpr size_t OUT_FC_S = OUT_FC_P + (size_t)DEPTH * PB * 2 * DFF;
constexpr size_t OUT_END = OUT_FC_S + (size_t)DEPTH * SB * 2 * DFF;

constexpr size_t MiB = 1u << 20;
constexpr size_t WS_CTL = 0, CTL_ZERO_BYTES = 4 * MiB;
constexpr size_t WS_MOD = 1 * MiB;
constexpr size_t WS_ROT = 4 * MiB;
constexpr size_t WS_SMALLW = 8 * MiB;
constexpr size_t WS_WIN = 16 * MiB;
constexpr size_t WS_WBR = WS_WIN + (size_t)2 * NIN * DM * 2;
constexpr size_t WS_WOUT = WS_WBR + (size_t)2 * 3 * 1024 * 512 * 2;
constexpr size_t WS_WUP = WS_WOUT + (size_t)2 * 1024 * 1024 * 2;
constexpr size_t WS_WDN = WS_WUP + (size_t)2 * NUP * DM * 2;
constexpr size_t WS_WEND = WS_WDN + (size_t)2 * DM * DFF * 2;
constexpr size_t WS_H = 128 * MiB;
constexpr size_t WS_QN = WS_H + (size_t)MT * DM * 2;
constexpr size_t WS_KVB = WS_QN + (size_t)MT * 512 * 2;
constexpr size_t WS_KVS = WS_KVB + (size_t)4 * PB * 2 * PT * 64 * 2;
constexpr size_t WS_RQ = WS_KVS + (size_t)4 * SB * 2 * ST * 64 * 2;
constexpr size_t WS_RX = WS_RQ + (size_t)4 * MT * 512 * 2;
constexpr size_t WS_GG = WS_RX + (size_t)MT * 512 * 4;
constexpr size_t WS_MGS = WS_GG + (size_t)MT * 512 * 2;
constexpr size_t WS_NG = WS_MGS + (size_t)MT * 3072 * 2;
constexpr size_t WS_OA = WS_NG + (size_t)MT * 24 * 4;
constexpr size_t WS_MRG = WS_OA + (size_t)3 * MT * 512 * 2;
constexpr size_t WS_X1 = WS_MRG + (size_t)MT * DM * 2;
constexpr size_t WS_X2 = WS_X1 + (size_t)MT * DM * 4;
constexpr size_t WS_GP = WS_X2 + (size_t)MT * DM * 4;
constexpr size_t WS_ACMP = WS_GP + (size_t)3 * MT * DFF * 2;
constexpr int CMP_ROWS_J = 34816, CMP_ROWS = 2 * CMP_ROWS_J;
constexpr size_t WS_LH = WS_ACMP + (size_t)2 * CMP_ROWS * 1024 * 2 + 4096;
constexpr size_t WS_CK = WS_LH + (size_t)(CMP_ROWS + 16) * 256 * 2;
constexpr size_t WS_LT = WS_CK + (size_t)CMP_ROWS * 64 * 2;
constexpr size_t WS_SPT = WS_LT + (size_t)16 * 32 * 16384 * 4;
constexpr size_t WS_CAR = WS_SPT + (size_t)16 * 32 * 16384 * 2;
constexpr size_t WS_OAG = WS_CAR + (size_t)4 * 64 * 3 * 512 * 4 + MiB;
constexpr size_t WS_END = WS_OAG + (size_t)2048 * 32 * 64 * 4 + MiB;
static_assert(WS_WEND <= WS_H, "weights fit below WS_H");

constexpr size_t SW_W1T = 0;
constexpr size_t SW_W2T = SW_W1T + (size_t)2 * 2 * 256 * 1024 * 2;
constexpr size_t SW_CB = SW_W2T + (size_t)2 * 2 * 64 * 128 * 2;
constexpr size_t SW_WAT = SW_CB + (size_t)2 * 2 * 128 * 4;
constexpr size_t SW_SP = SW_WAT + (size_t)2 * 2 * 8 * 64 * 64 * 2;
constexpr size_t SW_END = SW_SP + 2 * 512 * 4;
static_assert(SW_END <= 8 * MiB, "small weights fit");

constexpr int CW_TMO = 0;
constexpr int CW_BAR = 4096;

constexpr int PH_P0 = 0, PH_L0 = 1, PH_PER_LAYER = 11, PH_FINAL = PH_L0 + DEPTH * PH_PER_LAYER, N_PHASES = PH_FINAL + 1;
enum { LP_N1 = 0, LP_WIN, LP_MIX1, LP_MIX2, LP_MIX3, LP_BR, LP_OUT, LP_N2, LP_UP, LP_CONV, LP_DOWN };

constexpr int RING_BYTES = 131072;
constexpr int MISC_OFF = RING_BYTES;
constexpr int LDS_BYTES = RING_BYTES + 1024;
constexpr int NWAVES = 8, NTHR = 512;

#define GAS __attribute__((address_space(1)))
#define LAS __attribute__((address_space(3)))
typedef unsigned short bf16;
typedef unsigned v4u __attribute__((ext_vector_type(4)));
typedef unsigned v2u __attribute__((ext_vector_type(2)));
typedef float f32x16 __attribute__((ext_vector_type(16)));
typedef short s16x4 __attribute__((ext_vector_type(4)));
namespace pg8 {
#define PG8_LAS __attribute__((address_space(3)))
typedef unsigned short bf16_t;
typedef short bf16x8 __attribute__((ext_vector_type(8)));
typedef float f32x4 __attribute__((ext_vector_type(4)));
typedef unsigned u32x4 __attribute__((ext_vector_type(4)));
constexpr int BM = 256, BK = 64, HALF = 128, HTB = HALF * BK * 2  , STAGE_BYTES = 8 * HTB, NXCD = 8, WGM = 8;

__host__ __device__ __forceinline__ int lds_byte(int r, int c) { const int st = (r >> 4) * 2 + (c >> 5), rr = r & 15, cc = c & 31, ob = rr * 64 + cc * 2; return st * 1024 + (ob ^ (((ob >> 9) & 1) << 5)); }
__host__ __device__ __forceinline__ void stage_rc(int b, int& R, int& C) { const int st = b / 1024, sb = b % 1024, swz = sb ^ (((sb >> 9) & 1) << 5); R = (st >> 1) * 16 + swz / 64; C = (st & 1) * 32 + (swz % 64) / 2; }
__host__ __device__ __forceinline__ int perm32(int rho) { const int n = rho >> 4, i = rho & 15; return 8 * (i >> 2) + 4 * n + (i & 3); }

struct Unit { int pm, pn; };
struct Gemm { const bf16_t* A; const bf16_t* Bt; int M, N, K; };

struct StaticOrder {
    int nM, nN, nwg, G, c;
    __host__ __device__ void init(int M, int N, int G_, int c_) { nM = M / BM; nN = N / BM; nwg = nM * nN; G = G_; c = c_; }
    __host__ __device__ bool next(int i, Unit& u) const {
        const long L = (long)i * G + c; if (L >= nwg) return false;
        int wgid = (int)L; { const int q = nwg / NXCD, r = nwg % NXCD, xcd = wgid % NXCD, off = wgid / NXCD; wgid = (xcd < r ? xcd * (q + 1) : r * (q + 1) + (xcd - r) * q) + off; }
        const int nig = WGM * nN, gid = wgid / nig, fm = gid * WGM, gsz = (nM - fm) < WGM ? (nM - fm) : WGM;
        u.pm = fm + ((wgid % nig) % gsz); u.pn = (wgid % nig) / gsz; return true;
    }
    __device__ __forceinline__ void a_ready(const Unit&) const {}
    __device__ __forceinline__ void done(const Unit&) const {}
};
__device__ __forceinline__ unsigned cvt_pk_bf16(float lo, float hi) { unsigned r; asm volatile("v_cvt_pk_bf16_f32 %0, %1, %2" : "=v"(r) : "v"(lo), "v"(hi)); return r; }
typedef float f32x2 __attribute__((ext_vector_type(2)));
template <class Epi, class Sched, bool ALIGN_EPI = false, bool SP2 = false>
__device__ __forceinline__ void gemm_phase(PG8_LAS unsigned char* lds, const Gemm g, const Sched& S, const Epi& E) {
    const int tid = threadIdx.x, wid = __builtin_amdgcn_readfirstlane(tid >> 6), lane = tid & 63, wr = wid >> 2, wc = wid & 3, fr = lane & 15, fq = lane >> 4;
    const int K = g.K, nt = K / BK;
    unsigned voffA[2], voffB[2];
#pragma unroll
    for (int i = 0; i < 2; ++i) { int R, C; stage_rc(tid * 16 + i * 8192, R, C); const int Rb = Epi::PERM ? ((R & ~31) + perm32(R & 31)) : R;
        voffA[i] = (unsigned)(R * K + C) * 2u; voffB[i] = (unsigned)(Rb * K + C) * 2u; }
    const size_t kstep = (size_t)(BK * 2);
    const size_t hstep = (size_t)HALF * K * 2;
    const size_t tstep = 2 * hstep;
    const unsigned ldsw = (unsigned)wid * 1024u;
    const int aoff = lds_byte(wr * 64 + fr, fq * 8), boff = lds_byte(wc * 32 + fr, fq * 8);
#define PG8_SA(b, h) (((b) * 2 + (h)) * HTB)
#define PG8_SB(b, h) ((4 + (b) * 2 + (h)) * HTB)
#define PG8_STAGE(bufoff, gbase, voff) do { _Pragma("unroll") for (int _i = 0; _i < 2; ++_i) \
        __builtin_amdgcn_global_load_lds((const unsigned*)((const char*)(gbase) + (voff)[_i]), (PG8_LAS unsigned*)(lds + (bufoff) + ldsw + _i * 8192), 16, 0, 0); } while (0)
#define PG8_LDA(dst, b, h) do { _Pragma("unroll") for (int m = 0; m < 4; ++m) _Pragma("unroll") for (int k = 0; k < 2; ++k) dst[m][k] = *(const PG8_LAS bf16x8*)(lds + PG8_SA(b, h) + aoff + m * 2048 + k * 1024); } while (0)
#define PG8_LDB(dst, b, h) do { _Pragma("unroll") for (int n = 0; n < 2; ++n) _Pragma("unroll") for (int k = 0; k < 2; ++k) dst[n][k] = *(const PG8_LAS bf16x8*)(lds + PG8_SB(b, h) + boff + n * 2048 + k * 1024); } while (0)
#define PG8_MMA(ai, bj, At, Bt) do { __builtin_amdgcn_s_setprio(1); _Pragma("unroll") for (int m = 0; m < 4; ++m) _Pragma("unroll") for (int n = 0; n < 2; ++n) _Pragma("unroll") for (int k = 0; k < 2; ++k) \
        acc[ai][bj][m][n] = __builtin_amdgcn_mfma_f32_16x16x32_bf16(Bt[n][k], At[m][k], acc[ai][bj][m][n], 0, 0, 0); __builtin_amdgcn_s_setprio(0); } while (0)
#define PG8_WAIT_V(n) asm volatile("s_waitcnt vmcnt(" #n ")" ::: "memory")
#define PG8_WAIT_L(n) asm volatile("s_waitcnt lgkmcnt(" #n ")" ::: "memory")
#define PG8_BAR __builtin_amdgcn_s_barrier()
#define PG8_SCHED __builtin_amdgcn_sched_barrier(0)
    Unit cur, nxt; int ui = 0;
    if (!S.next(0, cur)) return;
    f32x4 acc[2][2][4][2];
#pragma unroll
    for (int a = 0; a < 2; ++a)
#pragma unroll
        for (int b = 0; b < 2; ++b)
#pragma unroll
            for (int m = 0; m < 4; ++m)
#pragma unroll
                for (int n = 0; n < 2; ++n) acc[a][b][m][n] = (f32x4){0.f, 0.f, 0.f, 0.f};
    bf16x8 At[4][2], B0[2][2], B1[2][2];
    const char* cA = (const char*)g.A + (size_t)cur.pm * tstep; const char* cB = (const char*)g.Bt + (size_t)cur.pn * tstep;
    S.a_ready(cur);
    if constexpr (SP2) {
        PG8_STAGE(PG8_SB(0, 0), cB, voffB); PG8_STAGE(PG8_SB(0, 1), cB + hstep, voffB); PG8_STAGE(PG8_SA(0, 0), cA, voffA); PG8_STAGE(PG8_SA(0, 1), cA + hstep, voffA);
        if (wr == 1) PG8_BAR;
        PG8_WAIT_V(2); PG8_BAR;
        PG8_STAGE(PG8_SB(1, 0), cB + kstep, voffB); PG8_STAGE(PG8_SA(1, 0), cA + kstep, voffA); PG8_STAGE(PG8_SB(1, 1), cB + hstep + kstep, voffB);
        PG8_WAIT_V(6); PG8_BAR;
    } else {
        PG8_STAGE(PG8_SB(0, 0), cB, voffB); PG8_STAGE(PG8_SA(0, 0), cA, voffA); PG8_STAGE(PG8_SB(0, 1), cB + hstep, voffB); PG8_STAGE(PG8_SA(0, 1), cA + hstep, voffA);
        if (wr == 1) PG8_BAR;
        PG8_WAIT_V(4); PG8_BAR;
        PG8_STAGE(PG8_SB(1, 0), cB + kstep, voffB); PG8_STAGE(PG8_SA(1, 0), cA + kstep, voffA); PG8_STAGE(PG8_SB(1, 1), cB + hstep + kstep, voffB);
        PG8_WAIT_V(6); PG8_BAR;
    }
    for (;;) {
        const bool has_next = S.next(ui + 1, nxt);
        const char* nA = has_next ? (const char*)g.A + (size_t)nxt.pm * tstep : cA; const char* nB = has_next ? (const char*)g.Bt + (size_t)nxt.pn * tstep : cB;
        for (int t = 0; t < nt; t += 2) {
            const bool last = (t == nt - 2);
            const char* a1 = cA + (size_t)(t + 1) * kstep;
            const char* a2 = last ? nA : cA + (size_t)(t + 2) * kstep; const char* b2 = last ? nB : cB + (size_t)(t + 2) * kstep;
            const char* a3 = a2 + kstep; const char* b3 = b2 + kstep;
            if (last && has_next) S.a_ready(nxt);
            if constexpr (SP2) {
            PG8_LDB(B0, 0, 0); PG8_LDB(B1, 0, 1); PG8_SCHED; PG8_LDA(At, 0, 0); PG8_STAGE(PG8_SA(1, 1), a1 + hstep, voffA);
            PG8_WAIT_V(8); PG8_WAIT_L(0); PG8_BAR; PG8_MMA(0, 0, At, B0); PG8_MMA(0, 1, At, B1); PG8_BAR; PG8_SCHED;
            PG8_LDA(At, 0, 1); PG8_STAGE(PG8_SB(0, 0), b2, voffB); PG8_STAGE(PG8_SB(0, 1), b2 + hstep, voffB); PG8_STAGE(PG8_SA(0, 0), a2, voffA);
            PG8_WAIT_V(8); PG8_WAIT_L(0); PG8_BAR; PG8_MMA(1, 0, At, B0); PG8_MMA(1, 1, At, B1); PG8_BAR; PG8_SCHED;
            PG8_LDB(B0, 1, 0); PG8_LDB(B1, 1, 1); PG8_SCHED; PG8_LDA(At, 1, 0); PG8_STAGE(PG8_SA(0, 1), a2 + hstep, voffA);
            PG8_WAIT_V(8); PG8_WAIT_L(0); PG8_BAR; PG8_MMA(0, 0, At, B0); PG8_MMA(0, 1, At, B1); PG8_BAR; PG8_SCHED;
            PG8_LDA(At, 1, 1); PG8_STAGE(PG8_SB(1, 0), b3, voffB); PG8_STAGE(PG8_SB(1, 1), b3 + hstep, voffB); PG8_STAGE(PG8_SA(1, 0), a3, voffA);
            PG8_WAIT_V(8); PG8_WAIT_L(0); PG8_BAR; PG8_MMA(1, 0, At, B0); PG8_MMA(1, 1, At, B1); PG8_BAR; PG8_SCHED;
            } else {
            PG8_LDB(B0, 0, 0); PG8_SCHED; PG8_LDA(At, 0, 0); PG8_STAGE(PG8_SA(1, 1), a1 + hstep, voffA);
            PG8_WAIT_L(8); PG8_BAR; PG8_WAIT_L(0); PG8_MMA(0, 0, At, B0); PG8_BAR; PG8_SCHED;
            PG8_LDB(B1, 0, 1); PG8_STAGE(PG8_SB(0, 0), b2, voffB);
            PG8_BAR; PG8_WAIT_L(0); PG8_MMA(0, 1, At, B1); PG8_BAR;
            PG8_LDA(At, 0, 1); PG8_STAGE(PG8_SA(0, 0), a2, voffA);
            PG8_BAR; PG8_WAIT_L(0); PG8_MMA(1, 0, At, B0); PG8_BAR; PG8_SCHED;
            PG8_STAGE(PG8_SB(0, 1), b2 + hstep, voffB);
            PG8_WAIT_V(6); PG8_BAR; PG8_MMA(1, 1, At, B1); PG8_BAR;
            PG8_LDB(B0, 1, 0); PG8_SCHED; PG8_LDA(At, 1, 0); PG8_STAGE(PG8_SA(0, 1), a2 + hstep, voffA);
            PG8_WAIT_L(8); PG8_BAR; PG8_WAIT_L(0); PG8_MMA(0, 0, At, B0); PG8_BAR; PG8_SCHED;
            PG8_LDB(B1, 1, 1); PG8_STAGE(PG8_SB(1, 0), b3, voffB);
            PG8_BAR; PG8_WAIT_L(0); PG8_MMA(0, 1, At, B1); PG8_BAR;
            PG8_LDA(At, 1, 1); PG8_STAGE(PG8_SA(1, 0), a3, voffA);
            PG8_BAR; PG8_WAIT_L(0); PG8_MMA(1, 0, At, B0); PG8_BAR; PG8_SCHED;
            PG8_STAGE(PG8_SB(1, 1), b3 + hstep, voffB);
            PG8_WAIT_V(6); PG8_BAR; PG8_MMA(1, 1, At, B1); PG8_BAR;
            }
        }
        if constexpr (ALIGN_EPI) { if (wr == 0) PG8_BAR; }
        if constexpr (!Epi::AFTER_DRAIN) { E(acc, cur, wr, wc, fr, fq); S.done(cur); }
        if (!has_next) break;
#pragma unroll
        for (int a = 0; a < 2; ++a)
#pragma unroll
            for (int b = 0; b < 2; ++b)
#pragma unroll
                for (int m = 0; m < 4; ++m)
#pragma unroll
                    for (int n = 0; n < 2; ++n) acc[a][b][m][n] = (f32x4){0.f, 0.f, 0.f, 0.f};
        cur = nxt; cA = nA; cB = nB; ++ui;
        if constexpr (ALIGN_EPI) { if (wr == 1) PG8_BAR; }
    }
    PG8_WAIT_V(0);
    if constexpr (!ALIGN_EPI) { if (wr == 0) PG8_BAR; }
    PG8_BAR;
    if constexpr (Epi::AFTER_DRAIN) { E.fused(acc, cur, wr, wc, fr, fq, lds, wid, lane); S.done(cur); }
#undef PG8_SA
#undef PG8_SB
#undef PG8_STAGE
#undef PG8_LDA
#undef PG8_LDB
#undef PG8_MMA
#undef PG8_WAIT_V
#undef PG8_WAIT_L
#undef PG8_BAR
#undef PG8_SCHED
}
}

using pg8::bf16x8; using pg8::f32x4; using pg8::u32x4;
#define LDS_WAIT() asm volatile("s_waitcnt lgkmcnt(0)" ::: "memory")
#define VM_WAIT() asm volatile("s_waitcnt vmcnt(0)" ::: "memory")
typedef float f32x2_t __attribute__((ext_vector_type(2))); typedef __bf16 bf16x2_t __attribute__((ext_vector_type(2)));
__device__ __forceinline__ unsigned pk2(float lo, float hi) { f32x2_t v = {lo, hi}; bf16x2_t b = __builtin_convertvector(v, bf16x2_t); return __builtin_bit_cast(unsigned, b); }
__device__ __forceinline__ float bf_lo(unsigned w) { return __uint_as_float(w << 16); }
__device__ __forceinline__ float bf_hi(unsigned w) { return __uint_as_float(w & 0xffff0000u); }
__device__ __forceinline__ float bf1(bf16 b) { return __uint_as_float(((unsigned)b) << 16); }
__device__ __forceinline__ float fexp2(float x) { return __builtin_amdgcn_exp2f(x); }
__device__ __forceinline__ float fexp(float x) { return __builtin_amdgcn_exp2f(x * 1.4426950408889634f); }
__device__ __forceinline__ float frcp(float x) { return __builtin_amdgcn_rcpf(x); }
__device__ __forceinline__ float sigmoidf_(float x) { return frcp(1.0f + fexp(-x)); }
__device__ __forceinline__ float siluf_(float x) { return x * sigmoidf_(x); }
__device__ __forceinline__ float gelu_tanh(float x) {
    const float u = 0.7978845608028654f * (x + 0.044715f * x * x * x);
    const float e = fexp(2.0f * u);
    const float t = 1.0f - 2.0f * frcp(e + 1.0f);
    return 0.5f * x * (1.0f + t);
}
__device__ __forceinline__ float wave_sum(float v) {
#pragma unroll
    for (int o = 1; o < 64; o <<= 1) v += __shfl_xor(v, o);
    return v;
}
__device__ __forceinline__ v4u pack8(const f32x4 a, const f32x4 b) { v4u w; w.x = pk2(a[0], a[1]); w.y = pk2(a[2], a[3]); w.z = pk2(b[0], b[1]); w.w = pk2(b[2], b[3]); return w; }
__device__ __forceinline__ void unpack8(const v4u w, f32x4& a, f32x4& b) { a = (f32x4){bf_lo(w.x), bf_hi(w.x), bf_lo(w.y), bf_hi(w.y)}; b = (f32x4){bf_lo(w.z), bf_hi(w.z), bf_lo(w.w), bf_hi(w.w)}; }

#define XB_TMO      128
#define XB_XCNT(j)  (256  + 64 * (j))
#define XB_XSUB(j)  (1280 + 64 * (j))
#define XB_XGEN(j)  (2304 + 64 * (j))
#define XB_TOP      3328
#define XB_TOPGEN   3392
#define XCD_BAR_WORDS 3456
#define XB_SPIN_CAP (1u << 18)

__device__ __forceinline__ unsigned xb_ld(unsigned* p)              { return __hip_atomic_load(p, __ATOMIC_RELAXED, __HIP_MEMORY_SCOPE_AGENT); }
__device__ __forceinline__ unsigned xb_add(unsigned* p, unsigned v) { return __hip_atomic_fetch_add(p, v, __ATOMIC_RELAXED, __HIP_MEMORY_SCOPE_AGENT); }
__device__ __forceinline__ unsigned xb_xcc_id() { return (unsigned)__builtin_amdgcn_s_getreg((3 << 11) | 20) & 0xFu; }
#define XB_SPIN(cond, bar) do { unsigned _sp = 0; while (cond) { __builtin_amdgcn_s_sleep(1); \
    if ((++_sp & 255u) == 0u) { if (xb_ld(&(bar)[XB_TMO])) break; if (_sp > XB_SPIN_CAP) { atomicAdd(&(bar)[XB_TMO], 1u); break; } } } } while (0)

struct XcdBarrier {
    unsigned* bar; unsigned x;
    volatile LAS unsigned* st;
};

__device__ __forceinline__ XcdBarrier xcd_barrier_post(unsigned* bar, volatile LAS unsigned* st) {
    XcdBarrier b; b.bar = bar; b.x = xb_xcc_id(); b.st = st;
    if (threadIdx.x == 0) (void)xb_add(&bar[XB_XCNT(b.x)], 1u);
    return b;
}
__device__ __forceinline__ void xcd_barrier_complete(unsigned* bar, unsigned x, unsigned& nloc, unsigned& nx) {
    const unsigned G = gridDim.x * gridDim.y * gridDim.z;
    unsigned sum, cnt, mine, sp = 0u;
    for (;;) {
        sum = 0u; cnt = 0u; mine = 0u;
#pragma unroll
        for (unsigned j = 0; j < 16; ++j) { const unsigned c = xb_ld(&bar[XB_XCNT(j)]); sum += c; cnt += (c > 0u) ? 1u : 0u; mine = (j == x) ? c : mine; }
        if (sum == G) break;
        __builtin_amdgcn_s_sleep(1);
        if ((++sp & 255u) == 0u) { if (xb_ld(&bar[XB_TMO])) break; if (sp > XB_SPIN_CAP) { atomicAdd(&bar[XB_TMO], 1u); break; } }
    }
    nloc = mine > 0u ? mine : 1u; nx = cnt > 0u ? cnt : 1u;
}

__device__ __forceinline__ void xcd_barrier(const XcdBarrier& b) {
    asm volatile("s_waitcnt vmcnt(0)" ::: "memory");
    __syncthreads();
    if (threadIdx.x == 0) {
        unsigned* bar = b.bar;
        __builtin_amdgcn_s_waitcnt(0);
        unsigned nloc = b.st[0], nx = b.st[1];
        if (nloc == 0u) { xcd_barrier_complete(bar, b.x, nloc, nx); b.st[0] = nloc; b.st[1] = nx; }
        const unsigned old = xb_add(&bar[XB_XSUB(b.x)], 1u);
        const unsigned gen = old / nloc;
        if (old + 1u == (gen + 1u) * nloc) {
            __builtin_amdgcn_fence(__ATOMIC_RELEASE, "agent");
            asm volatile("s_waitcnt vmcnt(0)" ::: "memory");
            const unsigned og = xb_add(&bar[XB_TOP], 1u);
            const unsigned tg = og / nx;
            if (og + 1u == (tg + 1u) * nx) xb_add(&bar[XB_TOPGEN], 1u);
            else XB_SPIN(xb_ld(&bar[XB_TOPGEN]) == tg, bar);
            __builtin_amdgcn_fence(__ATOMIC_ACQUIRE, "agent");
            xb_add(&bar[XB_XGEN(b.x)], 1u);
            asm volatile("s_waitcnt vmcnt(0)" ::: "memory");
        } else {
            XB_SPIN(xb_ld(&bar[XB_XGEN(b.x)]) == gen, bar);
            __builtin_amdgcn_fence(__ATOMIC_ACQUIRE, "agent");
            asm volatile("s_waitcnt vmcnt(0)" ::: "memory");
        }
    }
    __syncthreads();
}

struct Args { const void* in[37]; float* out; unsigned char* ws; int ph_lo, ph_hi; };
enum { I_XP = 0, I_XS, I_CACHE, I_CWIN, I_SRET, I_SH, I_SCONV, I_SFFN, I_PT, I_CP, I_CS, I_N1G, I_N2G, I_WADA, I_BADA, I_WIN, I_PE, I_W1, I_B1, I_W2,
       I_GNG, I_RCW, I_RCB, I_RWA, I_RBA, I_RWX, I_RBX, I_LAM, I_WBRA, I_WBRB, I_WBRC, I_WOUT, I_WUP, I_FCW, I_FCB, I_WDN, I_FNG };

struct Frame {
    LAS unsigned char* lds;
    int tid, lane, wave, G, bid;
    const Args* a;
    unsigned char* ws;
    float* out;
};
__device__ __forceinline__ void launder(Frame& F) { asm volatile("" : "+v"(F.tid), "+v"(F.lane)); int w_ = __builtin_amdgcn_readfirstlane(F.wave), b_ = __builtin_amdgcn_readfirstlane(F.bid), g_ = __builtin_amdgcn_readfirstlane(F.G); asm volatile("" : "+s"(w_), "+s"(b_), "+s"(g_)); F.wave = w_; F.bid = b_; F.G = g_; }
#define FIN(i) ((const float*)F.a->in[i])
#define WSP(T, off) ((T*)(F.ws + (off)))

__device__ __forceinline__ int row_bb(int row) { return row < PM ? (row >> 12) : 4 + ((row - PM) >> 3); }
__device__ __forceinline__ int row_pos(int row) { return row < PM ? (row & (PT - 1)) : PT + ((row - PM) & 7); }

__device__ __forceinline__ int win_cmap(int n) {
    if (n < 1280) return n;
    if (n < 2304) { const int c = n - 1280, isk = c >> 9, hc = c & 511, head = hc >> 7, s = hc & 127;
        const int g = s >> 3, w = s & 7, dim = (w < 4) ? (4 * g + w) : (64 + 4 * g + (w - 4)); return (isk ? O_RK : O_RQ) + head * 128 + dim; }
    if (n < 2816) return O_RV + (n - 2304);
    if (n < 3328) return O_RG + (n - 2816);
    if (n < 3840) return O_RX + (n - 3328);
    if (n < 4352) return O_RGATE + (n - 3840);
    if (n < 7424) return O_MG + (n - 4352);
    if (n < 7448) return O_NG + (n - 7424);
    return -1;
}

struct TrItem { const float* W; bf16* WT; int ldw, ldt, k0, n0; bool map; };
__device__ __forceinline__ void p0_tr_load(const TrItem& I, float (&tv)[32], int lane) {
    const int nd = I.n0 + (lane & 31); const int sc = I.map ? win_cmap(nd) : nd;
#pragma unroll
    for (int i = 0; i < 32; ++i) { const int kk = 2 * i + (lane >> 5); tv[i] = (sc >= 0) ? I.W[(size_t)(I.k0 + kk) * I.ldw + sc] : 0.f; }
}
__device__ __forceinline__ void p0_tr_finish(const TrItem& I, const float (&tv)[32], LAS float* scr, int lane) {
#pragma unroll
    for (int i = 0; i < 32; ++i) { const int kk = 2 * i + (lane >> 5); scr[kk * 33 + (lane & 31)] = tv[i]; }
    LDS_WAIT(); asm volatile("" ::: "memory");
    const int c = lane & 7;
#pragma unroll
    for (int j = 0; j < 4; ++j) { const int n = (lane >> 3) + 8 * j; const LAS float* s = scr + (8 * c) * 33 + n;
        v4u o; o.x = pk2(s[0 * 33], s[1 * 33]); o.y = pk2(s[2 * 33], s[3 * 33]); o.z = pk2(s[4 * 33], s[5 * 33]); o.w = pk2(s[6 * 33], s[7 * 33]);
        *(v4u*)(I.WT + (size_t)(I.n0 + n) * I.ldt + I.k0 + 8 * c) = o; }
    LDS_WAIT(); asm volatile("" ::: "memory");
}
template <bool MAP> __device__ __forceinline__ void p0_tr_item(const float* W, int ldw, bf16* WT, int ldt, int k0, int n0, LAS float* scr, int lane) {
    TrItem I{W, WT, ldw, ldt, k0, n0, MAP}; float tv[32]; p0_tr_load(I, tv, lane); p0_tr_finish(I, tv, scr, lane);
}
__device__ __forceinline__ void sincos_acc(float ang, float& s, float& c) {
    const double a = (double)ang; const double kq = rint(a * 0.63661977236758134308); const double r = fma(-kq, 1.57079632679489661923, a);
    const double r2 = r * r;
    const double sp = r * (1.0 + r2 * (-1.6666666666666666e-1 + r2 * (8.3333333333333332e-3 + r2 * (-1.9841269841269841e-4 + r2 * (2.7557319223985893e-6 + r2 * (-2.5052108385441720e-8))))));
    const double cp = 1.0 + r2 * (-0.5 + r2 * (4.1666666666666664e-2 + r2 * (-1.3888888888888889e-3 + r2 * (2.4801587301587302e-5 + r2 * (-2.7557319223985888e-7 + r2 * 2.0876756987868099e-9)))));
    const int q = ((int)kq) & 3;
    const double ss = (q == 0) ? sp : (q == 1) ? cp : (q == 2) ? -sp : -cp;
    const double cc = (q == 0) ? cp : (q == 1) ? -sp : (q == 2) ? -cp : sp;
    s = (float)ss; c = (float)cc;
}

__device__ __forceinline__ void p0_prologue(Frame& F) {
    const int gw = F.bid * NWAVES + F.wave, NGW = F.G * NWAVES, lane = F.lane;
    LAS float* scr = (LAS float*)(F.lds + F.wave * 16384);
    {
        constexpr int I_IN = 16 * 240, I_BR = 8 * 32, I_OUT = 16 * 32, I_UP = 16 * 176, I_DN = 44 * 32, I_L = I_IN + 3 * I_BR + I_OUT + I_UP + I_DN;
        for (int it = gw; it < 2 * I_L; it += NGW) {
            const int l = it / I_L; int r = it % I_L;
            if (r < I_IN) { p0_tr_item<true>(FIN(I_WIN) + (size_t)l * DM * D_IN, D_IN, WSP(bf16, WS_WIN) + (size_t)l * NIN * DM, DM, 64 * (r / 240), 32 * (r % 240), scr, lane); continue; } r -= I_IN;
            if (r < 3 * I_BR) { const int w = r / I_BR, q = r % I_BR; const float* src = FIN(w == 0 ? I_WBRA : (w == 1 ? I_WBRB : I_WBRC)) + (size_t)l * 512 * 1024;
                p0_tr_item<false>(src, 1024, WSP(bf16, WS_WBR) + (size_t)(l * 3 + w) * 1024 * 512, 512, 64 * (q / 32), 32 * (q % 32), scr, lane); continue; } r -= 3 * I_BR;
            if (r < I_OUT) { p0_tr_item<false>(FIN(I_WOUT) + (size_t)l * 1024 * 1024, 1024, WSP(bf16, WS_WOUT) + (size_t)l * 1024 * 1024, 1024, 64 * (r / 32), 32 * (r % 32), scr, lane); continue; } r -= I_OUT;
            if (r < I_UP) { p0_tr_item<false>(FIN(I_WUP) + (size_t)l * DM * NUP, NUP, WSP(bf16, WS_WUP) + (size_t)l * NUP * DM, DM, 64 * (r / 176), 32 * (r % 176), scr, lane); continue; } r -= I_UP;
            p0_tr_item<false>(FIN(I_WDN) + (size_t)l * DFF * DM, DM, WSP(bf16, WS_WDN) + (size_t)l * DM * DFF, DFF, 64 * (r / 32), 32 * (r % 32), scr, lane);
        }
    }
    {
        constexpr int NI_W1 = 8 * 16 * 4, NI_W2 = 4 * 2 * 2, NI_RG = 32 * 2;
        for (int it = gw; it < NI_W1 + NI_W2 + NI_RG; it += NGW) {
            int r = it;
            if (r < NI_W1) { const int m = r / 64, q = r % 64, lk = m >> 1, half = m & 1;
                p0_tr_item<false>(FIN(I_W1) + ((size_t)lk * 32 + half * 16) * 64 * 128, 128, WSP(bf16, WS_SMALLW + SW_W1T) + ((size_t)lk * 256 + half * 128) * 1024, 1024, 64 * (q / 4), 32 * (q % 4), scr, lane); continue; } r -= NI_W1;
            if (r < NI_W2) { const int lk = r / 4, q = r % 4;
                p0_tr_item<false>(FIN(I_W2) + (size_t)lk * 128 * 64, 64, WSP(bf16, WS_SMALLW + SW_W2T) + (size_t)lk * 64 * 128, 128, 64 * (q / 2), 32 * (q % 2), scr, lane); continue; } r -= NI_W2;
            { const int m = r / 2, q = r % 2, l = m >> 4, which = (m >> 3) & 1, blk = m & 7;
                p0_tr_item<false>(FIN(which ? I_RWX : I_RWA) + ((size_t)l * 8 + blk) * 4096, 64, WSP(bf16, WS_SMALLW + SW_WAT) + (size_t)m * 4096, 64, 0, 32 * q, scr, lane); }
        }
    }
    for (int it = gw; it < 64; it += NGW) {
        const int lk = it >> 4, h0 = (it & 15) * 8; const float* pe = FIN(I_PE) + (size_t)lk * 2048; const float* w1 = FIN(I_W1) + (size_t)lk * 2048 * 128 + h0;
        f32x4 a0 = (f32x4){0.f, 0.f, 0.f, 0.f}, a1 = a0;
#pragma unroll 8
        for (int i = lane; i < 2048; i += 64) { const float p = pe[i]; a0 += *(const f32x4*)(w1 + (size_t)i * 128) * p; a1 += *(const f32x4*)(w1 + (size_t)i * 128 + 4) * p; }
#pragma unroll
        for (int x = 0; x < 4; ++x) { a0[x] = wave_sum(a0[x]); a1[x] = wave_sum(a1[x]); }
        if (lane == 0) { float* cb = WSP(float, WS_SMALLW + SW_CB) + lk * 128 + h0; const float* b1 = FIN(I_B1) + lk * 128 + h0;
#pragma unroll
            for (int x = 0; x < 4; ++x) { cb[x] = a0[x] + b1[x]; cb[4 + x] = a1[x] + b1[4 + x]; } }
    }
    for (int i = F.bid * NTHR + F.tid; i < 1024; i += F.G * NTHR) { const float lam = FIN(I_LAM)[i]; WSP(float, WS_SMALLW + SW_SP)[i] = log1pf(expf(-lam)); }
    for (int i = F.bid * NTHR + F.tid; i < 4104 * 64; i += F.G * NTHR) {
        const int pi = i >> 6, fi = i & 63; const float pos = (float)(pi < PT ? pi : PAST + (pi - PT));
        const float freq = (float)pow(10000.0, -(double)fi / 64.0); const float ang = pos * freq; float s, c; sincos_acc(ang, s, c);
        WSP(float, WS_ROT)[i] = c; WSP(float, WS_ROT)[4104 * 64 + i] = s;
    }
    {
        LAS float* SC = (LAS float*)(F.lds + 0);
        LAS float* RED = (LAS float*)(F.lds + 36864);
        for (int u = F.bid; u < 2 * 96; u += F.G) {
            const int l = u / 96, cg = u % 96; float acc[36];
#pragma unroll
            for (int b = 0; b < 36; ++b) acc[b] = 0.f;
#pragma unroll 1
            for (int kh = 0; kh < 4; ++kh) {
                __syncthreads();
                {   float cv[18];
                    const float* cpp = FIN(I_CP); const float* csp = FIN(I_CS);
#pragma unroll
                    for (int it = 0; it < 18; ++it) { const int i = F.tid + NTHR * it, bb = i >> 8, d = i & 255;
                        cv[it] = (bb < 4) ? cpp[bb * DM + kh * 256 + d] : csp[(bb - 4) * DM + kh * 256 + d]; }
#pragma unroll
                    for (int it = 0; it < 18; ++it) { const int i = F.tid + NTHR * it, bb = i >> 8, d = i & 255; SC[d * 36 + bb] = siluf_(cv[it]); }
                }
                __syncthreads();
                const float* wp = FIN(I_WADA) + ((size_t)l * DM + kh * 256 + F.wave * 32) * 6144 + cg * 64 + lane;
                {
                    float wv[32];
#pragma unroll
                    for (int k = 0; k < 32; ++k) wv[k] = wp[(size_t)k * 6144];
                    const LAS f32x4* scb = (const LAS f32x4*)(SC + (F.wave * 32) * 36);
                    f32x4 sa[9], sb[9];
#pragma unroll
                    for (int g = 0; g < 9; ++g) sa[g] = scb[g];
#pragma unroll
                    for (int k = 0; k < 32; k += 2) {
#pragma unroll
                        for (int g = 0; g < 9; ++g) sb[g] = scb[(k + 1) * 9 + g];
#pragma unroll
                        for (int g = 0; g < 9; ++g) { acc[4 * g + 0] += wv[k] * sa[g][0]; acc[4 * g + 1] += wv[k] * sa[g][1]; acc[4 * g + 2] += wv[k] * sa[g][2]; acc[4 * g + 3] += wv[k] * sa[g][3]; }
                        if (k + 2 < 32) {
#pragma unroll
                            for (int g = 0; g < 9; ++g) sa[g] = scb[(k + 2) * 9 + g]; }
#pragma unroll
                        for (int g = 0; g < 9; ++g) { acc[4 * g + 0] += wv[k + 1] * sb[g][0]; acc[4 * g + 1] += wv[k + 1] * sb[g][1]; acc[4 * g + 2] += wv[k + 1] * sb[g][2]; acc[4 * g + 3] += wv[k + 1] * sb[g][3]; }
                    }
                }
            }
#pragma unroll
            for (int b = 0; b < 36; ++b) RED[(F.wave * 36 + b) * 64 + lane] = acc[b];
            __syncthreads();
            for (int o = F.tid; o < 36 * 64; o += NTHR) { const int b = o >> 6, col = o & 63; float sm = FIN(I_BADA)[l * 6144 + cg * 64 + col];
#pragma unroll
                for (int w = 0; w < 8; ++w) sm += RED[(w * 36 + b) * 64 + col];
                WSP(float, WS_MOD)[((size_t)l * 36 + b) * 6144 + cg * 64 + col] = sm; }
        }
        __syncthreads();
    }
    {   constexpr size_t NV4 = (size_t)2 * SB * 504 * 64; const size_t stride = (size_t)F.G * NTHR;
        for (size_t i0 = (size_t)F.bid * NTHR + F.tid; i0 < NV4; i0 += 8 * stride) {
            f32x4 v[8];
#pragma unroll
            for (int k = 0; k < 8; ++k) { const size_t i = i0 + k * stride; if (i < NV4) { const size_t seq = i / (504 * 64), r = i % (504 * 64); v[k] = __builtin_nontemporal_load((const f32x4*)(FIN(I_CWIN) + (seq * 512 + 8) * 256 + r * 4)); } }
#pragma unroll
            for (int k = 0; k < 8; ++k) { const size_t i = i0 + k * stride; if (i < NV4) { const size_t seq = i / (504 * 64), r = i % (504 * 64); *(f32x4*)(F.out + OUT_WIN_S + seq * 512 * 256 + r * 4) = v[k]; } }
        }
    }
}

__device__ __forceinline__ f32x4 ld4_bf(const bf16* p) { const v2u w = *(const v2u*)p; return (f32x4){bf_lo(w.x), bf_hi(w.x), bf_lo(w.y), bf_hi(w.y)}; }
__device__ __forceinline__ void norm_phase(Frame& F, int l, int which) {
    const int gw = F.bid * NWAVES + F.wave, NGW = F.G * NWAVES, lane = F.lane;
    const float* g = FIN(which ? I_N2G : I_N1G) + l * DM;
    constexpr int NR = 4;
    for (int row0 = gw * NR; row0 < MT; row0 += NGW * NR) {
        f32x4 v[NR][4]; float ss[NR];
#pragma unroll
        for (int rr = 0; rr < NR; ++rr) { const int row = row0 + rr;
            if (which == 0 && l == 0) { const float* xr = row < PM ? FIN(I_XP) + (size_t)row * DM : FIN(I_XS) + (size_t)(row - PM) * DM;
#pragma unroll
                for (int j = 0; j < 4; ++j) v[rr][j] = *(const f32x4*)(xr + lane * 4 + 256 * j); }
            else { const bf16* xr = WSP(bf16, which ? WS_X1 : WS_X2) + (size_t)row * DM;
#pragma unroll
                for (int j = 0; j < 4; ++j) v[rr][j] = ld4_bf(xr + lane * 4 + 256 * j); } }
#pragma unroll
        for (int rr = 0; rr < NR; ++rr) { float a = 0.f;
#pragma unroll
            for (int j = 0; j < 4; ++j) a += (v[rr][j][0] * v[rr][j][0] + v[rr][j][1] * v[rr][j][1]) + (v[rr][j][2] * v[rr][j][2] + v[rr][j][3] * v[rr][j][3]);
            ss[rr] = a; }
#pragma unroll
        for (int o = 1; o < 64; o <<= 1) {
#pragma unroll
            for (int rr = 0; rr < NR; ++rr) ss[rr] += __shfl_xor(ss[rr], o); }
#pragma unroll
        for (int rr = 0; rr < NR; ++rr) { const int row = row0 + rr; const float rs = 1.0f / sqrtf(ss[rr] * (1.0f / DM) + EPS);
            const float* mod = WSP(float, WS_MOD) + ((size_t)l * 36 + row_bb(row)) * 6144 + (which ? 3072 : 0); bf16* o = WSP(bf16, WS_H) + (size_t)row * DM;
#pragma unroll
            for (int j = 0; j < 4; ++j) { const int c = lane * 4 + 256 * j; const f32x4 gg = *(const f32x4*)(g + c), sh = *(const f32x4*)(mod + c), sc = *(const f32x4*)(mod + 1024 + c);
                const f32x4 y = (v[rr][j] * rs) * gg * (sc + 1.0f) + sh; v2u w; w.x = pk2(y[0], y[1]); w.y = pk2(y[2], y[3]); *(v2u*)(o + c) = w; } }
    }
}
__device__ __forceinline__ void final_phase(Frame& F) {
    const int gw = F.bid * NWAVES + F.wave, NGW = F.G * NWAVES, lane = F.lane;
    const float* g = FIN(I_FNG);
    for (int row0 = gw * 4; row0 < MT; row0 += NGW * 4) {
        f32x4 v[4][4]; float ss[4];
#pragma unroll
        for (int rr = 0; rr < 4; ++rr) { const bf16* xr = WSP(bf16, WS_X2) + (size_t)(row0 + rr) * DM; float a = 0.f;
#pragma unroll
            for (int j = 0; j < 4; ++j) { v[rr][j] = ld4_bf(xr + lane * 4 + 256 * j); a += (v[rr][j][0] * v[rr][j][0] + v[rr][j][1] * v[rr][j][1]) + (v[rr][j][2] * v[rr][j][2] + v[rr][j][3] * v[rr][j][3]); }
            ss[rr] = a; }
#pragma unroll
        for (int rr = 0; rr < 4; ++rr) { const float rs = 1.0f / sqrtf(wave_sum(ss[rr]) * (1.0f / DM) + EPS);
            float* o = F.out + OUT_Y + (size_t)(row0 + rr) * DM;
#pragma unroll
            for (int j = 0; j < 4; ++j) { const int c = lane * 4 + 256 * j; *(f32x4*)(o + c) = (v[rr][j] * rs) * *(const f32x4*)(g + c); } }
    }
}

#define EPI_LOOP_BEGIN \
    _Pragma("unroll") for (int ai = 0; ai < 2; ++ai) _Pragma("unroll") for (int m = 0; m < 4; ++m) { const int row = u.pm * 256 + ai * 128 + wr * 64 + m * 16 + fr; \
    _Pragma("unroll") for (int bj = 0; bj < 2; ++bj) { const int ct = bj * 128 + wc * 32 + 8 * fq; const f32x4 v0 = acc[ai][bj][m][0], v1 = acc[ai][bj][m][1];
#define EPI_LOOP_END } }

struct EpiWin {
    static constexpr bool PERM = true, AFTER_DRAIN = false;
    unsigned char* ws; float* out; int l;
    __device__ __forceinline__ void operator()(const f32x4 (&acc)[2][2][4][2], const pg8::Unit& u, int wr, int wc, int fr0, int fq0) const {
        int fr = fr0, fq = fq0; asm volatile("" : "+v"(fr), "+v"(fq));
        const int pn = u.pn;
        if (pn < 2) {
            bf16* QN = (bf16*)(ws + WS_QN);
            EPI_LOOP_BEGIN *(v4u*)(QN + (size_t)row * 512 + pn * 256 + ct) = pack8(v0 * QSCALE, v1 * QSCALE); EPI_LOOP_END
        } else if (pn < 5) {
            EPI_LOOP_BEGIN
                const int c = (pn - 2) * 256 + ct, j = c >> 7, k = (c >> 6) & 1, d = c & 63;
                const bool isp = row < PM; const int b = isp ? (row >> 12) : ((row - PM) >> 3), t = isp ? (row & (PT - 1)) : ((row - PM) & 7);
                if (j < 4) { float* o = out + (isp ? OUT_ROWS_P + ((size_t)l * PM + row) * 512 : OUT_ROWS_S + ((size_t)l * SM + (row - PM)) * 512) + c; *(f32x4*)o = v0; *(f32x4*)(o + 4) = v1; }
                else if (isp) { if (t >= PT - WINB) { float* o = out + OUT_WIN_P + (((size_t)l * PB + b) * WINB + (t - (PT - WINB))) * 256 + (c - 512); *(f32x4*)o = v0; *(f32x4*)(o + 4) = v1; } }
                else { float* o = out + OUT_WIN_S + (((size_t)l * SB + b) * WINB + (WINB - ST) + t) * 256 + (c - 512); *(f32x4*)o = v0; *(f32x4*)(o + 4) = v1; }
                const v4u w = pack8(v0, v1);
                if (isp) {
                    if (j < 2) *(v4u*)((bf16*)(ws + WS_ACMP) + ((size_t)(l * 2 + j) * CMP_ROWS_J + 32768 + (b * 2 + k) * 256) * 1024 + (size_t)t * 64 + d) = w;
                    else if (j & 1) {
                        const int tq = t & 31, s2 = tq >> 4, hh = (tq >> 2) & 1, ii = (tq & 3) + 4 * ((tq >> 3) & 1);
                        bf16* vt = (bf16*)(ws + WS_KVB) + (((size_t)(j - 2) * PB + b) * 2 + k) * PT * 64 + (size_t)(t >> 5) * 2048 + ((((d >> 5) * 2 + s2) * 2 + hh) * 32 + (d & 31)) * 8 + ii;
                        vt[0] = (bf16)(w.x & 0xffffu); vt[8] = (bf16)(w.x >> 16); vt[16] = (bf16)(w.y & 0xffffu); vt[24] = (bf16)(w.y >> 16);
                        vt[32] = (bf16)(w.z & 0xffffu); vt[40] = (bf16)(w.z >> 16); vt[48] = (bf16)(w.w & 0xffffu); vt[56] = (bf16)(w.w >> 16); }
                    else *(v4u*)((bf16*)(ws + WS_KVB) + (((size_t)(j - 2) * PB + b) * 2 + k) * PT * 64 + (size_t)(t >> 5) * 2048 + ((d >> 3) * 32 + (t & 31)) * 8) = w;
                } else if (j >= 2) *(v4u*)((bf16*)(ws + WS_KVS) + ((((size_t)(j - 2) * SB + b) * 2 + k) * ST + t) * 64 + d) = w;
            EPI_LOOP_END
        } else if (pn < 9) {
            const float* ROTC = (const float*)(ws + WS_ROT); const float* ROTS = ROTC + 4104 * 64;
#pragma unroll
            for (int ai = 0; ai < 2; ++ai) {
                f32x4 cs[4][2], sn[4][2];
#pragma unroll
                for (int m = 0; m < 4; ++m) { const int row = u.pm * 256 + ai * 128 + wr * 64 + m * 16 + fr; const int pi = row_pos(row);
#pragma unroll
                    for (int bj = 0; bj < 2; ++bj) { const int ct = bj * 128 + wc * 32 + 8 * fq; const int c = (pn - 5) * 256 + ct, d0 = (((c & 511) & 127) >> 3) * 4; cs[m][bj] = *(const f32x4*)(ROTC + pi * 64 + d0); sn[m][bj] = *(const f32x4*)(ROTS + pi * 64 + d0); } }
#pragma unroll
                for (int m = 0; m < 4; ++m) { const int row = u.pm * 256 + ai * 128 + wr * 64 + m * 16 + fr;
#pragma unroll
                    for (int bj = 0; bj < 2; ++bj) { const int ct = bj * 128 + wc * 32 + 8 * fq; const f32x4 v0 = acc[ai][bj][m][0], v1 = acc[ai][bj][m][1];
                        const int c = (pn - 5) * 256 + ct, isk = c >> 9, hc = c & 511, head = hc >> 7, d0 = ((hc & 127) >> 3) * 4;
                        const float sc = isk ? 0.08838834764831845f : 1.0f;
                        const f32x4 o1 = (v0 * cs[m][bj] - v1 * sn[m][bj]) * sc, o2 = (v0 * sn[m][bj] + v1 * cs[m][bj]) * sc;
                        bf16* o = (bf16*)(ws + WS_RQ) + (size_t)isk * MT * 512 + (size_t)row * 512 + head * 128 + d0;
                        v2u w1; w1.x = pk2(o1[0], o1[1]); w1.y = pk2(o1[2], o1[3]); *(v2u*)o = w1;
                        v2u w2; w2.x = pk2(o2[0], o2[1]); w2.y = pk2(o2[2], o2[3]); *(v2u*)(o + 64) = w2; } }
            }
        } else if (pn < 13) {
            bf16* RV = (bf16*)(ws + WS_RQ) + (size_t)2 * MT * 512;
            EPI_LOOP_BEGIN const int c = (pn - 9) * 256 + ct; *(v4u*)(RV + (size_t)(c >> 9) * MT * 512 + (size_t)row * 512 + (c & 511)) = pack8(v0, v1); EPI_LOOP_END
        } else if (pn < 15) {
            float* RX = (float*)(ws + WS_RX);
            EPI_LOOP_BEGIN
                const int c = (pn - 13) * 256 + ct; float* o = RX + (size_t)row * 512 + c; *(f32x4*)o = v0; *(f32x4*)(o + 4) = v1;
                if (row < PM) { const int t = row & (PT - 1); if (t >= PT - 3) { float* q = out + OUT_CV_P + (((size_t)l * PB + (row >> 12)) * 3 + (t - (PT - 3))) * 512 + c; *(f32x4*)q = v0; *(f32x4*)(q + 4) = v1; } }
                else { const int i = (row - PM) & 7; if (i >= ST - 3) { float* q = out + OUT_CV_S + (((size_t)l * SB + ((row - PM) >> 3)) * 3 + (i - (ST - 3))) * 512 + c; *(f32x4*)q = v0; *(f32x4*)(q + 4) = v1; } }
            EPI_LOOP_END
        } else if (pn < 17) {
            bf16* GG = (bf16*)(ws + WS_GG);
            EPI_LOOP_BEGIN const int c = (pn - 15) * 256 + ct;
                f32x4 a, b;
#pragma unroll
                for (int i = 0; i < 4; ++i) { a[i] = gelu_tanh(v0[i]); b[i] = gelu_tanh(v1[i]); }
                *(v4u*)(GG + (size_t)row * 512 + c) = pack8(a, b); EPI_LOOP_END
        } else if (pn < 29) {
            bf16* MG = (bf16*)(ws + WS_MGS);
            EPI_LOOP_BEGIN const int c = (pn - 17) * 256 + ct;
                f32x4 a, b;
#pragma unroll
                for (int i = 0; i < 4; ++i) { a[i] = sigmoidf_(v0[i]); b[i] = sigmoidf_(v1[i]); }
                *(v4u*)(MG + (size_t)row * 3072 + c) = pack8(a, b); EPI_LOOP_END
        } else {
            float* NG = (float*)(ws + WS_NG);
            EPI_LOOP_BEGIN if (ct < 24) { f32x4 a, b;
#pragma unroll
                for (int i = 0; i < 4; ++i) { a[i] = sigmoidf_(v0[i]); b[i] = sigmoidf_(v1[i]); }
                float* o = NG + (size_t)row * 24 + ct; *(f32x4*)o = a; *(f32x4*)(o + 4) = b; } EPI_LOOP_END
        }
    }
};

struct EpiLH {
    static constexpr bool PERM = true, AFTER_DRAIN = false;
    bf16* LH;
    __device__ __forceinline__ void operator()(const f32x4 (&acc)[2][2][4][2], const pg8::Unit& u, int wr, int wc, int fr0, int fq0) const {
        int fr = fr0, fq = fq0; asm volatile("" : "+v"(fr), "+v"(fq));
        EPI_LOOP_BEGIN *(v4u*)(LH + (size_t)row * 256 + ct) = pack8(v0, v1); EPI_LOOP_END
    }
};
struct CmpOrder {
    int G, c;
    __device__ bool next(int i, pg8::Unit& u) const { const int L = i * G + c; if (L >= CMP_ROWS / 256) return false; u.pm = L; u.pn = L / (CMP_ROWS_J / 256); return true; }
    __device__ __forceinline__ void a_ready(const pg8::Unit&) const {}
    __device__ __forceinline__ void done(const pg8::Unit&) const {}
};

template <int BR> struct EpiBr {
    static constexpr bool PERM = true, AFTER_DRAIN = false;
    unsigned char* ws;
    __device__ __forceinline__ void operator()(const f32x4 (&acc)[2][2][4][2], const pg8::Unit& u, int wr, int wc, int fr0, int fq0) const {
        int fr = fr0, fq = fq0; asm volatile("" : "+v"(fr), "+v"(fq));
        const bf16* MG = (const bf16*)(ws + WS_MGS); bf16* MR = (bf16*)(ws + WS_MRG);
        EPI_LOOP_BEGIN
            const int col = u.pn * 256 + ct; f32x4 g0, g1; unpack8(*(const v4u*)(MG + (size_t)row * 3072 + BR * 1024 + col), g0, g1);
            f32x4 r0 = v0 * g0, r1 = v1 * g1; bf16* o = MR + (size_t)row * DM + col;
            if (BR > 0) { f32x4 p0, p1; unpack8(*(const v4u*)o, p0, p1); r0 += p0; r1 += p1; }
            *(v4u*)o = pack8(r0, r1);
        EPI_LOOP_END
    }
};

struct BrOrder {
    pg8::StaticOrder S;
    __device__ bool next(int i, pg8::Unit& u) const { pg8::Unit t; if (!S.next(i / 3, t)) return false; const int br = i % 3; u.pm = br * (MT / 256) + t.pm; u.pn = br * 4 + t.pn; return true; }
    __device__ __forceinline__ void a_ready(const pg8::Unit&) const {}
    __device__ __forceinline__ void done(const pg8::Unit&) const {}
};
struct EpiBrAll {
    static constexpr bool PERM = true, AFTER_DRAIN = false;
    unsigned char* ws;
    __device__ __forceinline__ void operator()(const f32x4 (&acc)[2][2][4][2], const pg8::Unit& u0, int wr, int wc, int fr0, int fq0) const {
        int fr = fr0, fq = fq0; asm volatile("" : "+v"(fr), "+v"(fq));
        const int br = u0.pn >> 2; const pg8::Unit u{u0.pm - br * (MT / 256), u0.pn & 3};
        const bf16* MG = (const bf16*)(ws + WS_MGS) + br * 1024; bf16* MR = (bf16*)(ws + WS_MRG);
#pragma unroll
        for (int ai = 0; ai < 2; ++ai) {
            v4u gw[4][2], pw[4][2];
#pragma unroll
            for (int m = 0; m < 4; ++m) { const int row = u.pm * 256 + ai * 128 + wr * 64 + m * 16 + fr;
#pragma unroll
                for (int bj = 0; bj < 2; ++bj) { const int col = u.pn * 256 + bj * 128 + wc * 32 + 8 * fq; gw[m][bj] = *(const v4u*)(MG + (size_t)row * 3072 + col); if (br != 0) pw[m][bj] = *(const v4u*)(MR + (size_t)row * DM + col); } }
#pragma unroll
            for (int m = 0; m < 4; ++m) { const int row = u.pm * 256 + ai * 128 + wr * 64 + m * 16 + fr;
#pragma unroll
                for (int bj = 0; bj < 2; ++bj) { const int col = u.pn * 256 + bj * 128 + wc * 32 + 8 * fq; const f32x4 v0 = acc[ai][bj][m][0], v1 = acc[ai][bj][m][1];
                    f32x4 g0, g1; unpack8(gw[m][bj], g0, g1); f32x4 r0 = v0 * g0, r1 = v1 * g1;
                    if (br != 0) { f32x4 p0, p1; unpack8(pw[m][bj], p0, p1); r0 += p0; r1 += p1; }
                    *(v4u*)(MR + (size_t)row * DM + col) = pack8(r0, r1); } }
        }
    }
};

template <bool INF32> struct EpiRes {
    static constexpr bool PERM = true, AFTER_DRAIN = false;
    const void* xin_p; bf16* xout; const float* mod; int gofs;
    __device__ __forceinline__ void operator()(const f32x4 (&acc)[2][2][4][2], const pg8::Unit& u, int wr, int wc, int fr0, int fq0) const {
        int fr = fr0, fq = fq0; asm volatile("" : "+v"(fr), "+v"(fq));
#pragma unroll
        for (int ai = 0; ai < 2; ++ai) {
            const float* gp = mod + (size_t)row_bb(u.pm * 256 + ai * 128) * 6144 + gofs + u.pn * 256 + wc * 32 + 8 * fq;
            f32x4 g[2][2];
#pragma unroll
            for (int bj = 0; bj < 2; ++bj) { g[bj][0] = *(const f32x4*)(gp + 128 * bj); g[bj][1] = *(const f32x4*)(gp + 128 * bj + 4); }
            if (INF32) {
#pragma unroll
                for (int mh = 0; mh < 2; ++mh) {
                    f32x4 xv[2][2][2];
#pragma unroll
                    for (int m2 = 0; m2 < 2; ++m2) { const int row = u.pm * 256 + ai * 128 + wr * 64 + (2 * mh + m2) * 16 + fr;
#pragma unroll
                        for (int bj = 0; bj < 2; ++bj) { const float* xi = (const float*)xin_p + (size_t)row * DM + u.pn * 256 + bj * 128 + wc * 32 + 8 * fq; xv[m2][bj][0] = *(const f32x4*)xi; xv[m2][bj][1] = *(const f32x4*)(xi + 4); } }
#pragma unroll
                    for (int m2 = 0; m2 < 2; ++m2) { const int m = 2 * mh + m2; const int row = u.pm * 256 + ai * 128 + wr * 64 + m * 16 + fr;
#pragma unroll
                        for (int bj = 0; bj < 2; ++bj) { const int col = u.pn * 256 + bj * 128 + wc * 32 + 8 * fq;
                            *(v4u*)(xout + (size_t)row * DM + col) = pack8(xv[m2][bj][0] + g[bj][0] * acc[ai][bj][m][0], xv[m2][bj][1] + g[bj][1] * acc[ai][bj][m][1]); } }
                }
            } else {
                v4u xw[4][2];
#pragma unroll
                for (int m = 0; m < 4; ++m) { const int row = u.pm * 256 + ai * 128 + wr * 64 + m * 16 + fr;
#pragma unroll
                    for (int bj = 0; bj < 2; ++bj) xw[m][bj] = *(const v4u*)((const bf16*)xin_p + (size_t)row * DM + u.pn * 256 + bj * 128 + wc * 32 + 8 * fq); }
#pragma unroll
                for (int m = 0; m < 4; ++m) { const int row = u.pm * 256 + ai * 128 + wr * 64 + m * 16 + fr;
#pragma unroll
                    for (int bj = 0; bj < 2; ++bj) { const int col = u.pn * 256 + bj * 128 + wc * 32 + 8 * fq; f32x4 x0, x1; unpack8(xw[m][bj], x0, x1);
                        *(v4u*)(xout + (size_t)row * DM + col) = pack8(x0 + g[bj][0] * acc[ai][bj][m][0], x1 + g[bj][1] * acc[ai][bj][m][1]); } }
            }
        }
    }
};

struct EpiUp {
    static constexpr bool PERM = true, AFTER_DRAIN = false;
    unsigned char* ws; float* out; int l;
    __device__ __forceinline__ void operator()(const f32x4 (&acc)[2][2][4][2], const pg8::Unit& u, int wr, int wc, int fr0, int fq0) const {
        int fr = fr0, fq = fq0; asm volatile("" : "+v"(fr), "+v"(fq));
        bf16* GP = (bf16*)(ws + WS_GP); bf16* VAL = GP + (size_t)MT * DFF;
        if (u.pn < 11) {
            EPI_LOOP_BEGIN const int c = u.pn * 256 + ct; *(v4u*)(GP + (size_t)row * DFF + c) = pack8(v0, v1);
                if (row < PM) { const int t = row & (PT - 1); if (t >= PT - 2) { float* q = out + OUT_FC_P + (((size_t)l * PB + (row >> 12)) * 2 + (t - (PT - 2))) * DFF + c; *(f32x4*)q = v0; *(f32x4*)(q + 4) = v1; } }
                else { const int i = (row - PM) & 7; if (i >= ST - 2) { float* q = out + OUT_FC_S + (((size_t)l * SB + ((row - PM) >> 3)) * 2 + (i - (ST - 2))) * DFF + c; *(f32x4*)q = v0; *(f32x4*)(q + 4) = v1; } }
            EPI_LOOP_END
        } else {
            EPI_LOOP_BEGIN const int c = (u.pn - 11) * 256 + ct; *(v4u*)(VAL + (size_t)row * DFF + c) = pack8(v0, v1); EPI_LOOP_END
        }
    }
};

__device__ __forceinline__ f32x16 mfma32(bf16x8 a, bf16x8 b, f32x16 c) { return __builtin_amdgcn_mfma_f32_32x32x16_bf16(a, b, c, 0, 0, 0); }
__device__ __forceinline__ f32x4 mfma16(bf16x8 a, bf16x8 b, f32x4 c) { return __builtin_amdgcn_mfma_f32_16x16x32_bf16(a, b, c, 0, 0, 0); }
__device__ __forceinline__ float ret_log_g(int h) { return log1pf(-exp2f(-5.0f - (float)h)); }
__device__ __forceinline__ bf16x8 tr_frag(const LAS unsigned char* base, int rs_bytes, int rowA, int rowB, int colbase, int lane) {
    const int q = (lane & 15) >> 2, p = lane & 3;
    const LAS unsigned char* pa = base + (rowA + q) * rs_bytes + (colbase + 4 * p) * 2;
    const LAS unsigned char* pb = base + (rowB + q) * rs_bytes + (colbase + 4 * p) * 2;
    const s16x4 a = __builtin_bit_cast(s16x4, __builtin_amdgcn_ds_read_tr16_b64_v4i16((LAS s16x4*)pa));
    const s16x4 b = __builtin_bit_cast(s16x4, __builtin_amdgcn_ds_read_tr16_b64_v4i16((LAS s16x4*)pb));
    return (bf16x8){a[0], a[1], a[2], a[3], b[0], b[1], b[2], b[3]};
}
__device__ __forceinline__ bf16x8 cvt_frag(const f32x16& p, int s2) {
    u32x4 w; w.x = pk2(p[8 * s2 + 0], p[8 * s2 + 1]); w.y = pk2(p[8 * s2 + 2], p[8 * s2 + 3]); w.z = pk2(p[8 * s2 + 4], p[8 * s2 + 5]); w.w = pk2(p[8 * s2 + 6], p[8 * s2 + 7]);
    return __builtin_bit_cast(bf16x8, w);
}

__device__ __forceinline__ void cmp2_phase(Frame& F, int l) {
    const int gw = F.bid * NWAVES + F.wave, NGW = F.G * NWAVES, lane = F.lane, r = lane & 15, g = lane >> 4;
    const bf16* LH = WSP(bf16, WS_LH); bf16* CK = WSP(bf16, WS_CK);
    for (int wu = gw; wu < CMP_ROWS / 16; wu += NGW) {
        const int row0 = wu * 16, j = row0 / CMP_ROWS_J, rj = (row0 % CMP_ROWS_J) + r, row = row0 + r;
        const bool valid = (rj < 32768) ? ((rj & 511) < 511) : (((rj - 32768) & 255) < 255);
        const bf16* W2T = WSP(bf16, WS_SMALLW + SW_W2T) + (size_t)(l * 2 + j) * 64 * 128; const float* CB = WSP(float, WS_SMALLW + SW_CB) + (l * 2 + j) * 128;
        f32x4 acc[4];
#pragma unroll
        for (int ct = 0; ct < 4; ++ct) acc[ct] = (f32x4){0.f, 0.f, 0.f, 0.f};
#pragma unroll
        for (int ks = 0; ks < 4; ++ks) {
            const int h0 = 32 * ks + 8 * g; f32x4 a0, a1, b0, b1;
            unpack8(*(const v4u*)(LH + (size_t)row * 256 + h0), a0, a1); unpack8(*(const v4u*)(LH + (size_t)(row + 1) * 256 + 128 + h0), b0, b1);
            const f32x4 c0 = *(const f32x4*)(CB + h0), c1 = *(const f32x4*)(CB + h0 + 4);
            f32x4 x0 = a0 + b0 + c0, x1 = a1 + b1 + c1;
#pragma unroll
            for (int i = 0; i < 4; ++i) { x0[i] = gelu_tanh(x0[i]); x1[i] = gelu_tanh(x1[i]); }
            const bf16x8 hf = __builtin_bit_cast(bf16x8, pack8(x0, x1));
#pragma unroll
            for (int ct = 0; ct < 4; ++ct) { const bf16x8 wf = *(const bf16x8*)(W2T + (size_t)(16 * ct + r) * 128 + h0); acc[ct] = mfma16(wf, hf, acc[ct]); }
        }
#pragma unroll
        for (int ct = 0; ct < 4; ++ct) { const f32x4 v = valid ? acc[ct] : (f32x4){0.f, 0.f, 0.f, 0.f}; v2u w; w.x = pk2(v[0], v[1]); w.y = pk2(v[2], v[3]);
            *(v2u*)(CK + (size_t)row * 64 + 16 * ct + 4 * g) = w; }
    }
}

constexpr int CG_RS = 144, CG_BUF = 256 * CG_RS, CG_AW = 2 * CG_BUF, CG_AT = 32 * CG_RS;
static_assert(CG_AW + 2 * 4 * CG_AT <= RING_BYTES, "compress GEMM LDS map");
template <bool smp> __device__ __forceinline__ void cmp_gemm_unit(Frame& F, int l, int j, int grp, int n00) {
    const int tid = F.tid, lane = F.lane, w = F.wave, q = lane & 31, h_ = lane >> 5, rg = w >> 1, ch = w & 1;
    const float* rp[4]; const bf16* ab = nullptr;
    if (smp) { const int db = grp >> 1, k = grp & 1;
#pragma unroll
        for (int i = 0; i < 4; ++i) { const int tt0 = (n00 + 32 * rg + 16 * ch + 4 * i + (lane >> 4)) * 16; const int page = ((const int*)F.a->in[I_PT])[db * NPG + (tt0 >> 7)];
            rp[i] = FIN(I_CACHE) + (((((size_t)l * NPHYS + page) * PAGE + (tt0 & 127)) * 4 + j) * 2 + k) * 64 + (lane & 15) * 4; } }
    else {
        ab = WSP(bf16, WS_ACMP) + ((size_t)(l * 2 + j) * CMP_ROWS_J + 32768 + grp * 256 + n00 + 32 * rg + 16 * ch + (lane >> 3)) * 1024 + (lane & 7) * 8;
#pragma unroll
        for (int i = 0; i < 4; ++i) rp[i] = nullptr; }
    const bf16* Bg = WSP(bf16, WS_SMALLW + SW_W1T) + (size_t)(l * 2 + j) * 256 * 1024;
    f32x16 acc[4];
#pragma unroll
    for (int ct = 0; ct < 4; ++ct) acc[ct] = (f32x16){};
    const bf16* bsrc = Bg + (size_t)(tid >> 1) * 1024 + (tid & 1) * 32; LAS unsigned char* bdst = F.lds + (tid >> 1) * CG_RS + (tid & 1) * 64;
    v4u bst[2][4]; f32x4 an[4][4]; v4u anb[4][2];
    __syncthreads();
#pragma unroll
    for (int x = 0; x < 4; ++x) bst[0][x] = *(const v4u*)(bsrc + 8 * x);
#pragma unroll
    for (int x = 0; x < 4; ++x) bst[1][x] = *(const v4u*)(bsrc + 64 + 8 * x);
#pragma unroll
    for (int d = 0; d < 4; ++d) {
        if (smp) {
#pragma unroll
            for (int i = 0; i < 4; ++i) an[d][i] = __builtin_nontemporal_load((const f32x4*)(rp[i] + (size_t)d * 512)); }
        else {
#pragma unroll
            for (int i = 0; i < 2; ++i) anb[d][i] = *(const v4u*)(ab + (size_t)(8 * i) * 1024 + d * 64); } }
#pragma unroll
    for (int x = 0; x < 4; ++x) *(LAS v4u*)(bdst + x * 16) = bst[0][x];
#define CG_CHUNK(d, LAST_) { const int kc = kc4 + (d); \
            LAS unsigned char* At = F.lds + CG_AW + (((d) & 1) * 4 + rg) * CG_AT; \
            if (!(LAST_) || (d) < 2) {                                   \
                _Pragma("unroll") for (int x = 0; x < 4; ++x) bst[(d) & 1][x] = *(const v4u*)(bsrc + (kc + 2) * 64 + 8 * x); } \
            if (smp) { \
                _Pragma("unroll") for (int i = 0; i < 4; ++i) { v2u o; o.x = pk2(an[d][i][0], an[d][i][1]); o.y = pk2(an[d][i][2], an[d][i][3]); *(LAS v2u*)(At + (16 * ch + 4 * i + (lane >> 4)) * CG_RS + (lane & 15) * 8) = o; } \
                if (!(LAST_)) { _Pragma("unroll") for (int i = 0; i < 4; ++i) an[d][i] = __builtin_nontemporal_load((const f32x4*)(rp[i] + (size_t)(kc + 4) * 512)); } \
            } else { \
                _Pragma("unroll") for (int i = 0; i < 2; ++i) *(LAS v4u*)(At + (16 * ch + 8 * i + (lane >> 3)) * CG_RS + (lane & 7) * 16) = anb[d][i]; \
                if (!(LAST_)) { _Pragma("unroll") for (int i = 0; i < 2; ++i) anb[d][i] = *(const v4u*)(ab + (size_t)(8 * i) * 1024 + (kc + 4) * 64); } \
            } \
            __syncthreads();                                           \
            bf16x8 ac[4]; \
            _Pragma("unroll") for (int ks = 0; ks < 4; ++ks) ac[ks] = *(const LAS bf16x8*)(At + q * CG_RS + ks * 32 + 16 * h_); \
            const LAS unsigned char* bb = F.lds + ((d) & 1) * CG_BUF + (128 * ch + q) * CG_RS + 16 * h_; \
            _Pragma("unroll") for (int ks = 0; ks < 4; ++ks) \
                _Pragma("unroll") for (int ct = 0; ct < 4; ++ct) { const bf16x8 bf = *(const LAS bf16x8*)(bb + ct * 32 * CG_RS + ks * 32); acc[ct] = mfma32(bf, ac[ks], acc[ct]); } \
            if (!(LAST_) || (d) < 3) { _Pragma("unroll") for (int x = 0; x < 4; ++x) *(LAS v4u*)(bdst + (((d) + 1) & 1) * CG_BUF + x * 16) = bst[((d) + 1) & 1][x]; } }
    int kc4 = 0;
#pragma unroll 1
    for (; kc4 < 12; kc4 += 4) { CG_CHUNK(0, false) CG_CHUNK(1, false) CG_CHUNK(2, false) CG_CHUNK(3, false) }
    { CG_CHUNK(0, true) CG_CHUNK(1, true) CG_CHUNK(2, true) CG_CHUNK(3, true) }
#undef CG_CHUNK
    bf16* LH = WSP(bf16, WS_LH) + ((size_t)j * CMP_ROWS_J + (smp ? grp * 512 : 32768 + grp * 256) + n00 + 32 * rg + q) * 256 + 128 * ch;
#pragma unroll
    for (int ct = 0; ct < 4; ++ct)
#pragma unroll
        for (int r4 = 0; r4 < 4; ++r4) { v2u o; o.x = pk2(acc[ct][4 * r4 + 0], acc[ct][4 * r4 + 1]); o.y = pk2(acc[ct][4 * r4 + 2], acc[ct][4 * r4 + 3]); *(v2u*)(LH + ct * 32 + 8 * r4 + 4 * h_) = o; }
}

constexpr int RS_KV = 272;
__device__ __forceinline__ void ret_local_unit(Frame& F, int unit) {
    const int bh = unit >> 5, c = unit & 31, b = bh >> 2, h = bh & 3, lane = F.lane, w = F.wave;
    const float lg = ret_log_g(h);
    LAS unsigned char* KS = F.lds; LAS unsigned char* VS = F.lds + 128 * RS_KV;
    const bf16* RK = WSP(bf16, WS_RQ) + (size_t)MT * 512; const bf16* RV = WSP(bf16, WS_RQ) + (size_t)2 * MT * 512;
    __syncthreads();
#pragma unroll
    for (int i = 0; i < 4; ++i) { const int p = F.tid + NTHR * i, j = p >> 4, ch = p & 15; const size_t go = (size_t)(b * PT + 128 * c + j) * 512 + h * 128 + ch * 8;
        f32x4 k0, k1; unpack8(*(const v4u*)(RK + go), k0, k1); const float kw = fexp((float)(127 - j) * lg);
        *(LAS v4u*)(KS + j * RS_KV + ch * 16) = pack8(k0 * kw, k1 * kw);
        *(LAS v4u*)(VS + j * RS_KV + ch * 16) = *(const v4u*)(RV + go); }
    __syncthreads();
    const int et = w >> 1, dt0 = 2 * (w & 1), h_ = lane >> 5, blk = (lane >> 4) & 1;
    f32x16 acc[2]; acc[0] = (f32x16){}; acc[1] = (f32x16){};
#pragma unroll
    for (int ks = 0; ks < 8; ++ks) {
        const int rA = 16 * ks + 8 * h_;
        const bf16x8 af = tr_frag(VS, RS_KV, rA, rA + 4, 32 * et + 16 * blk, lane);
#pragma unroll
        for (int dd = 0; dd < 2; ++dd) { const bf16x8 bfr = tr_frag(KS, RS_KV, rA, rA + 4, 32 * (dt0 + dd) + 16 * blk, lane); acc[dd] = mfma32(af, bfr, acc[dd]); }
    }
    bf16* LT = WSP(bf16, WS_LT) + ((size_t)bh * 32 + c) * 16384;
#pragma unroll
    for (int dd = 0; dd < 2; ++dd)
#pragma unroll
        for (int r = 0; r < 16; ++r) { const int e = 32 * et + (r & 3) + 8 * (r >> 2) + 4 * h_; LT[e * 128 + 32 * (dt0 + dd) + (lane & 31)] = (bf16)(pk2(acc[dd][r], 0.f) & 0xffffu); }
}
__device__ __forceinline__ void ret_scan_phase(Frame& F, int l) {
    const bf16* LT = WSP(bf16, WS_LT); bf16* SPT = WSP(bf16, WS_SPT);
    for (int idx = F.bid * NTHR + F.tid; idx < 16 * 16384; idx += F.G * NTHR) {
        const int bh = idx >> 14, ed = idx & 16383, e = ed >> 7, d = ed & 127, h = bh & 3; const float g128 = fexp(128.0f * ret_log_g(h));
        float S = 0.f;
        for (int c = 0; c < 32; ++c) { const size_t o = ((size_t)bh * 32 + c) * 16384 + ed; SPT[o] = (bf16)(pk2(S, 0.f) & 0xffffu); S = S * g128 + bf1(LT[o]); }
        F.out[OUT_RET_P + ((size_t)l * 16 + bh) * 16384 + d * 128 + e] = S;
    }
}
__device__ __forceinline__ void ret_out_unit(Frame& F, int l, int unit) {
    const int bh = unit >> 5, c = unit & 31, b = bh >> 2, h = bh & 3, lane = F.lane, w = F.wave, tid = F.tid;
    const float lg = ret_log_g(h);
    LAS unsigned char* KS = F.lds; LAS unsigned char* VS = F.lds + 128 * RS_KV; LAS float* OT = (LAS float*)F.lds; LAS float* STAT = (LAS float*)(F.lds + 2 * 128 * RS_KV);
    const bf16* RQ = WSP(bf16, WS_RQ); const bf16* RK = RQ + (size_t)MT * 512; const bf16* RV = RQ + (size_t)2 * MT * 512; const bf16* RG = RQ + (size_t)3 * MT * 512;
    const size_t row0 = (size_t)b * PT + 128 * c;
    __syncthreads();
#pragma unroll
    for (int i = 0; i < 4; ++i) { const int p = tid + NTHR * i, j = p >> 4, ch = p & 15; const size_t go = (row0 + j) * 512 + h * 128 + ch * 8;
        *(LAS v4u*)(KS + j * RS_KV + ch * 16) = *(const v4u*)(RK + go); *(LAS v4u*)(VS + j * RS_KV + ch * 16) = *(const v4u*)(RV + go); }
    const int it = w & 3, eh = w >> 2, h_ = lane >> 5, blk = (lane >> 4) & 1, il = 32 * it + (lane & 31);
    bf16x8 qf[8];
#pragma unroll
    for (int ks = 0; ks < 8; ++ks) qf[ks] = *(const bf16x8*)(RQ + (row0 + il) * 512 + h * 128 + 16 * ks + 8 * h_);
    f32x16 acc[2]; acc[0] = (f32x16){}; acc[1] = (f32x16){};
    const bf16* SP = WSP(bf16, WS_SPT) + ((size_t)bh * 32 + c) * 16384;
#pragma unroll
    for (int kb4 = 0; kb4 < 8; kb4 += 4) {
        bf16x8 af[4][2];
#pragma unroll
        for (int ks = 0; ks < 4; ++ks)
#pragma unroll
            for (int e2 = 0; e2 < 2; ++e2) af[ks][e2] = *(const bf16x8*)(SP + (size_t)(32 * (2 * eh + e2) + (lane & 31)) * 128 + 16 * (kb4 + ks) + 8 * h_);
#pragma unroll
        for (int ks = 0; ks < 4; ++ks)
#pragma unroll
            for (int e2 = 0; e2 < 2; ++e2) acc[e2] = mfma32(af[ks][e2], qf[kb4 + ks], acc[e2]);
    }
    { const float cr = fexp((float)(il + 1) * lg); acc[0] *= cr; acc[1] *= cr; }
    __syncthreads();
    for (int jt = 0; jt <= it; ++jt) {
        f32x16 s = (f32x16){};
#pragma unroll
        for (int ks = 0; ks < 8; ++ks) { const bf16x8 kf = *(const LAS bf16x8*)(KS + (32 * jt + (lane & 31)) * RS_KV + (16 * ks + 8 * h_) * 2); s = mfma32(kf, qf[ks], s); }
#pragma unroll
        for (int r = 0; r < 16; ++r) { const int j = 32 * jt + (r & 3) + 8 * (r >> 2) + 4 * h_; const int df = il - j; s[r] = (df >= 0) ? s[r] * fexp((float)df * lg) : 0.f; }
#pragma unroll
        for (int s2 = 0; s2 < 2; ++s2) { const bf16x8 pf = cvt_frag(s, s2); const int rA = 32 * jt + 16 * s2 + 4 * h_;
#pragma unroll
            for (int e2 = 0; e2 < 2; ++e2) { const bf16x8 vf = tr_frag(VS, RS_KV, rA, rA + 8, 32 * (2 * eh + e2) + 16 * blk, lane); acc[e2] = mfma32(vf, pf, acc[e2]); } }
    }
    float s1 = 0.f, s2 = 0.f;
#pragma unroll
    for (int e2 = 0; e2 < 2; ++e2)
#pragma unroll
        for (int r = 0; r < 16; ++r) { const float v = acc[e2][r]; s1 += v; s2 += v * v; }
    s1 += __shfl_xor(s1, 32); s2 += __shfl_xor(s2, 32);
    if (lane < 32) { STAT[(w * 32 + lane) * 2] = s1; STAT[(w * 32 + lane) * 2 + 1] = s2; }
    __syncthreads();
    { const int pw = w ^ 4; s1 += STAT[(pw * 32 + (lane & 31)) * 2]; s2 += STAT[(pw * 32 + (lane & 31)) * 2 + 1]; }
    const float mean = s1 * (1.0f / 128.0f), var = fmaxf(s2 * (1.0f / 128.0f) - mean * mean, 0.f), rstd = 1.0f / sqrtf(var + EPS);
#pragma unroll
    for (int e2 = 0; e2 < 2; ++e2)
#pragma unroll
        for (int r4 = 0; r4 < 4; ++r4) { const int e = 32 * (2 * eh + e2) + 8 * r4 + 4 * h_;
            f32x4 v; v[0] = (acc[e2][4 * r4 + 0] - mean) * rstd; v[1] = (acc[e2][4 * r4 + 1] - mean) * rstd; v[2] = (acc[e2][4 * r4 + 2] - mean) * rstd; v[3] = (acc[e2][4 * r4 + 3] - mean) * rstd;
            *(LAS f32x4*)(OT + il * 132 + e) = v; }
    __syncthreads();
    const float* GN = FIN(I_GNG) + l * 512 + h * 128; bf16* OR_ = WSP(bf16, WS_OA) + (size_t)MT * 512;
#pragma unroll
    for (int k = 0; k < 4; ++k) { const int q = tid + NTHR * k, i = q >> 4, ch = q & 15;
        const f32x4 o0 = *(const LAS f32x4*)(OT + i * 132 + 8 * ch), o1 = *(const LAS f32x4*)(OT + i * 132 + 8 * ch + 4);
        const f32x4 g0 = *(const f32x4*)(GN + 8 * ch), g1 = *(const f32x4*)(GN + 8 * ch + 4); f32x4 r0, r1; unpack8(*(const v4u*)(RG + (row0 + i) * 512 + h * 128 + 8 * ch), r0, r1);
        f32x4 y0, y1;
#pragma unroll
        for (int x = 0; x < 4; ++x) { y0[x] = o0[x] * g0[x] * siluf_(r0[x]); y1[x] = o1[x] * g1[x] * siluf_(r1[x]); }
        *(v4u*)(OR_ + (row0 + i) * 512 + h * 128 + 8 * ch) = pack8(y0, y1); }
}
__device__ __forceinline__ void ret_sample_unit(Frame& F, int l, int unit) {
    const int db = unit >> 2, h = unit & 3, tid = F.tid, e = tid & 127, dp = tid >> 7;
    const float lg = ret_log_g(h);
    LAS float* Q = (LAS float*)F.lds; LAS float* K = Q + 1024; LAS float* V = K + 1024; LAS float* GT = V + 1024; LAS float* CR = GT + 1024;
    LAS float* SC = CR + 4096; LAS float* RED = SC + 64;
    const bf16* RQ = WSP(bf16, WS_RQ); const size_t row0 = (size_t)PM + db * 8;
    __syncthreads();
    for (int i = tid; i < 4096; i += NTHR) { const int which = i >> 10, r = (i >> 7) & 7, d = i & 127; const float v = bf1(RQ[(size_t)which * MT * 512 + (row0 + r) * 512 + h * 128 + d]); Q[which * 1024 + r * 128 + d] = v; }
    __syncthreads();
    const float* S0 = FIN(I_SRET) + (((size_t)l * SB + db) * 4 + h) * 16384; float* SN = F.out + OUT_RET_S + (((size_t)l * SB + db) * 4 + h) * 16384;
    float kwv[8], cr[8];
#pragma unroll
    for (int j = 0; j < 8; ++j) { kwv[j] = V[j * 128 + e] * fexp((float)(7 - j) * lg); cr[j] = 0.f; }
    const float g8 = fexp(8.0f * lg);
    {   float s0v[32];
#pragma unroll
        for (int dd = 0; dd < 32; ++dd) s0v[dd] = S0[(dp * 32 + dd) * 128 + e];
#pragma unroll
        for (int dd = 0; dd < 32; ++dd) { const int d = dp * 32 + dd; const float s0 = s0v[dd]; float sn = g8 * s0;
#pragma unroll
            for (int j = 0; j < 8; ++j) { cr[j] += Q[j * 128 + d] * s0; sn += K[j * 128 + d] * kwv[j]; }
            SN[d * 128 + e] = sn; }
    }
#pragma unroll
    for (int i = 0; i < 8; ++i) CR[(dp * 8 + i) * 128 + e] = cr[i];
    if (tid < 64) { const int i = tid >> 3, j = tid & 7; float s = 0.f; if (j <= i) { for (int d = 0; d < 128; ++d) s += Q[i * 128 + d] * K[j * 128 + d]; s *= fexp((float)(i - j) * lg); } SC[tid] = s; }
    __syncthreads();
    float o[2];
#pragma unroll
    for (int ii = 0; ii < 2; ++ii) { const int i = 2 * dp + ii; float x = (CR[(0 * 8 + i) * 128 + e] + CR[(1 * 8 + i) * 128 + e] + CR[(2 * 8 + i) * 128 + e] + CR[(3 * 8 + i) * 128 + e]) * fexp((float)(i + 1) * lg);
        for (int j = 0; j <= i; ++j) x += SC[i * 8 + j] * V[j * 128 + e];
        o[ii] = x; }
#pragma unroll
    for (int ii = 0; ii < 2; ++ii) { const float a = wave_sum(o[ii]), q = wave_sum(o[ii] * o[ii]); if (F.lane == 0) { RED[(F.wave * 2 + ii) * 2] = a; RED[(F.wave * 2 + ii) * 2 + 1] = q; } }
    __syncthreads();
    const float* GN = FIN(I_GNG) + l * 512 + h * 128; bf16* OR_ = WSP(bf16, WS_OA) + (size_t)MT * 512;
#pragma unroll
    for (int ii = 0; ii < 2; ++ii) { const int i = 2 * dp + ii, w0 = 2 * dp; const float s1 = RED[(w0 * 2 + ii) * 2] + RED[((w0 + 1) * 2 + ii) * 2], s2 = RED[(w0 * 2 + ii) * 2 + 1] + RED[((w0 + 1) * 2 + ii) * 2 + 1];
        const float mean = s1 * (1.0f / 128.0f), var = fmaxf(s2 * (1.0f / 128.0f) - mean * mean, 0.f), rstd = 1.0f / sqrtf(var + EPS);
        const float y = (o[ii] - mean) * rstd * GN[e] * siluf_(GT[i * 128 + e]);
        OR_[(row0 + i) * 512 + h * 128 + e] = (bf16)(pk2(y, 0.f) & 0xffffu); }
}

template <int MODE> __device__ __forceinline__ void rglru_unit(Frame& F, int l, int unit) {
    const int tid = F.tid, c = tid, lane = F.lane, w = F.wave;
    LAS bf16* XC = (LAS bf16*)F.lds; LAS float* G = (LAS float*)(F.lds + 16384);
    const int seq = (MODE == 2) ? unit : (unit >> 6), tile = (MODE == 2) ? 0 : (unit & 63);
    const size_t row0 = (MODE == 2) ? (size_t)PM + seq * 8 : (size_t)seq * PT + tile * 64;
    const int ntok = (MODE == 2) ? 8 : 64, nsub = (MODE == 2) ? 1 : 4;
    const float* RX = WSP(float, WS_RX);
    const float w0 = FIN(I_RCW)[(l * 4 + 0) * 512 + c], w1 = FIN(I_RCW)[(l * 4 + 1) * 512 + c], w2 = FIN(I_RCW)[(l * 4 + 2) * 512 + c], w3 = FIN(I_RCW)[(l * 4 + 3) * 512 + c], cb = FIN(I_RCB)[l * 512 + c];
    const float ba = FIN(I_RBA)[l * 512 + c], bx = FIN(I_RBX)[l * 512 + c], sp = WSP(float, WS_SMALLW + SW_SP)[l * 512 + c];
    float x3, x2, x1;
    if (MODE == 2) { const float* cv = FIN(I_SCONV) + ((size_t)l * SB + seq) * 3 * 512; x3 = cv[c]; x2 = cv[512 + c]; x1 = cv[1024 + c]; }
    else if (tile == 0) { x3 = 0.f; x2 = 0.f; x1 = 0.f; }
    else { x3 = RX[(row0 - 3) * 512 + c]; x2 = RX[(row0 - 2) * 512 + c]; x1 = RX[(row0 - 1) * 512 + c]; }
    float h = (MODE == 0) ? 0.f : (MODE == 1) ? WSP(float, WS_CAR)[(size_t)4 * 64 * 2 * 512 + ((size_t)seq * 64 + tile) * 512 + c] : FIN(I_SH)[((size_t)l * SB + seq) * 512 + c];
    float aprod = 1.f;
    const int r16 = lane & 15, g4 = lane >> 4;
    bf16x8 wa[4][2], wx[4][2];
    { const bf16* WA = WSP(bf16, WS_SMALLW + SW_WAT) + ((size_t)(l * 2 + 0) * 8 + w) * 4096; const bf16* WX = WSP(bf16, WS_SMALLW + SW_WAT) + ((size_t)(l * 2 + 1) * 8 + w) * 4096;
#pragma unroll
      for (int ct = 0; ct < 4; ++ct)
#pragma unroll
          for (int ks = 0; ks < 2; ++ks) { wa[ct][ks] = *(const bf16x8*)(WA + (16 * ct + r16) * 64 + 32 * ks + 8 * g4); wx[ct][ks] = *(const bf16x8*)(WX + (16 * ct + r16) * 64 + 32 * ks + 8 * g4); } }
    const bf16* GG = WSP(bf16, WS_GG); bf16* OC = WSP(bf16, WS_OA) + (size_t)2 * MT * 512;
    __syncthreads();
    float xn[16]; bf16 gn[16];
#pragma unroll
    for (int tt = 0; tt < 16; ++tt) { xn[tt] = (tt < ntok) ? RX[(row0 + tt) * 512 + c] : 0.f; gn[tt] = (MODE != 0 && tt < ntok) ? GG[(row0 + tt) * 512 + c] : (bf16)0; }
    for (int s = 0; s < nsub; ++s) {
        float xc[16], gg[16];
#pragma unroll
        for (int tt = 0; tt < 16; ++tt) { xc[tt] = xn[tt]; gg[tt] = bf1(gn[tt]); }
        if (s + 1 < nsub) {
#pragma unroll
            for (int tt = 0; tt < 16; ++tt) { const int t = (s + 1) * 16 + tt; xn[tt] = RX[(row0 + t) * 512 + c]; gn[tt] = (MODE != 0) ? GG[(row0 + t) * 512 + c] : (bf16)0; } }
#pragma unroll
        for (int tt = 0; tt < 16; ++tt) { const float x0 = xc[tt];
            xc[tt] = cb + w0 * x3 + w1 * x2 + w2 * x1 + w3 * x0; x3 = x2; x2 = x1; x1 = x0; XC[tt * 512 + c] = (bf16)(pk2(xc[tt], 0.f) & 0xffffu); }
        LDS_WAIT(); asm volatile("" ::: "memory");
        {
            bf16x8 xf[2];
#pragma unroll
            for (int ks = 0; ks < 2; ++ks) xf[ks] = *(const LAS bf16x8*)(XC + r16 * 512 + w * 64 + 32 * ks + 8 * g4);
#pragma unroll
            for (int ct = 0; ct < 4; ++ct) { f32x4 da = (f32x4){0.f, 0.f, 0.f, 0.f}, dx = da;
#pragma unroll
                for (int ks = 0; ks < 2; ++ks) { da = mfma16(wa[ct][ks], xf[ks], da); dx = mfma16(wx[ct][ks], xf[ks], dx); }
                *(LAS f32x4*)(G + r16 * 512 + w * 64 + 16 * ct + 4 * g4) = da; *(LAS f32x4*)(G + 8192 + r16 * 512 + w * 64 + 16 * ct + 4 * g4) = dx; }
        }
        LDS_WAIT(); asm volatile("" ::: "memory");
#pragma unroll
        for (int tt = 0; tt < 16; ++tt) { const int t = s * 16 + tt;
            if (t < ntok) {
                const float r = sigmoidf_(G[tt * 512 + c] + ba), ig = sigmoidf_(G[8192 + tt * 512 + c] + bx);
                const float la = -8.0f * r * sp, a = fexp(la), bt = sqrtf(fmaxf(1.0f - a * a, 0.f)) * (ig * xc[tt]);
                h = a * h + bt; aprod *= a;
                if (MODE != 0) { const size_t o = (row0 + t) * 512 + c; OC[o] = (bf16)(pk2(h * gg[tt], 0.f) & 0xffffu); }
            } }
    }
    if (MODE == 0) { float* CAR = WSP(float, WS_CAR) + ((size_t)seq * 64 + tile) * 1024; CAR[c] = aprod; CAR[512 + c] = h; }
    if (MODE == 2) F.out[OUT_H_S + ((size_t)l * SB + seq) * 512 + c] = h;
}
__device__ __forceinline__ void rglru_carry_phase(Frame& F, int l) {
    const float* CAR = WSP(float, WS_CAR); float* HIN = WSP(float, WS_CAR) + (size_t)4 * 64 * 2 * 512;
    for (int idx = F.bid * NTHR + F.tid; idx < PB * 512; idx += F.G * NTHR) {
        const int b = idx >> 9, c = idx & 511; float h = 0.f;
#pragma unroll 1
        for (int t0 = 0; t0 < 64; t0 += 32) {
            float ca[32], cb[32];
#pragma unroll
            for (int t = 0; t < 32; ++t) { const float* cr = CAR + ((size_t)b * 64 + t0 + t) * 1024; ca[t] = cr[c]; cb[t] = cr[512 + c]; }
#pragma unroll
            for (int t = 0; t < 32; ++t) { HIN[((size_t)b * 64 + t0 + t) * 512 + c] = h; h = ca[t] * h + cb[t]; }
        }
        F.out[OUT_H_P + ((size_t)l * PB + b) * 512 + c] = h;
    }
}

__device__ __forceinline__ void convact_phase(Frame& F, int l) {
    const bf16* GP = WSP(bf16, WS_GP); const bf16* VAL = GP + (size_t)MT * DFF; bf16* ACT = WSP(bf16, WS_GP) + (size_t)2 * MT * DFF;
    const float* CW = FIN(I_FCW) + (size_t)l * 3 * DFF; const float* CBI = FIN(I_FCB) + (size_t)l * DFF;
    constexpr int NRUN = PM / 16 + SB, NCG = DFF / 8;
    for (int it = F.bid * NTHR + F.tid; it < NRUN * NCG; it += F.G * NTHR) {
        const int run = it / NCG, cg = it % NCG, c = cg * 8;
        const bool isp = run < PM / 16; const size_t row0 = isp ? (size_t)run * 16 : (size_t)PM + (run - PM / 16) * 8; const int nt = isp ? 16 : 8;
        f32x4 p2a, p2b, p1a, p1b;
        if (isp) { if ((run & 255) == 0) { p2a = p2b = p1a = p1b = (f32x4){0.f, 0.f, 0.f, 0.f}; } else { unpack8(*(const v4u*)(GP + (row0 - 2) * DFF + c), p2a, p2b); unpack8(*(const v4u*)(GP + (row0 - 1) * DFF + c), p1a, p1b); } }
        else { const float* st = FIN(I_SFFN) + (((size_t)l * SB + (run - PM / 16)) * 2) * DFF + c; p2a = *(const f32x4*)st; p2b = *(const f32x4*)(st + 4); p1a = *(const f32x4*)(st + DFF); p1b = *(const f32x4*)(st + DFF + 4); }
        const f32x4 w0a = *(const f32x4*)(CW + c), w0b = *(const f32x4*)(CW + c + 4), w1a = *(const f32x4*)(CW + DFF + c), w1b = *(const f32x4*)(CW + DFF + c + 4), w2a = *(const f32x4*)(CW + 2 * DFF + c), w2b = *(const f32x4*)(CW + 2 * DFF + c + 4);
        const f32x4 ba = *(const f32x4*)(CBI + c), bb = *(const f32x4*)(CBI + c + 4);
        for (int t0 = 0; t0 < nt; t0 += 8) {
            v4u gx[8], vx[8];
#pragma unroll
            for (int k = 0; k < 8; ++k) { gx[k] = *(const v4u*)(GP + (row0 + t0 + k) * DFF + c); vx[k] = *(const v4u*)(VAL + (row0 + t0 + k) * DFF + c); }
#pragma unroll
            for (int k = 0; k < 8; ++k) {
                f32x4 xa, xb, va, vb; unpack8(gx[k], xa, xb); unpack8(vx[k], va, vb);
                f32x4 ya = ba + w0a * p2a + w1a * p1a + w2a * xa, yb = bb + w0b * p2b + w1b * p1b + w2b * xb;
#pragma unroll
                for (int i = 0; i < 4; ++i) { ya[i] = siluf_(ya[i]) * va[i]; yb[i] = siluf_(yb[i]) * vb[i]; }
                *(v4u*)(ACT + (row0 + t0 + k) * DFF + c) = pack8(ya, yb);
                p2a = p1a; p2b = p1b; p1a = xa; p1b = xb;
            }
        }
    }
}

constexpr int AT_RS = 144;
constexpr int AT_K0 = 0, AT_V0 = 2 * 64 * AT_RS, AT_PS = 4 * 64 * AT_RS, AT_IMP = AT_PS + 69632, AT_MASK = AT_IMP + 6144, AT_LIST = AT_MASK + 2048, AT_NL = AT_LIST + 1024;
constexpr unsigned AT_MARK = 0xFFFFu;
static_assert(AT_NL + 64 <= RING_BYTES, "attention LDS map");

struct TileRegs { v4u a, b, c, d; int mode; };

template <bool SMP> __device__ __forceinline__ void at_prefetch(const Frame& F, int l, int seq, int kvh, unsigned e, TileRegs& R) {
    const int kind = (int)(e >> 14), ti = (int)(e & 0x3fffu), rr = F.tid >> 3, pc = F.tid & 7;
    R.mode = 0;
    if (kind < 2) {
        const size_t rb = SMP ? (size_t)(seq * 2 + kvh) * 512 : (size_t)32768 + (size_t)(seq * 2 + kvh) * 256;
        const bf16* ck = WSP(bf16, WS_CK) + (rb + ti * 64 + rr) * 64 + pc * 8;
        R.a = *(const v4u*)ck; R.c = *(const v4u*)(ck + (size_t)CMP_ROWS_J * 64);
    } else if (!SMP) {
        const int jb = (kind == 2) ? 0 : 2;
        const bf16* kp = WSP(bf16, WS_KVB) + ((((size_t)jb * PB + seq) * 2 + kvh) * PT + ti * 64 + rr) * 64 + pc * 8;
        R.a = *(const v4u*)kp; R.c = *(const v4u*)(kp + (size_t)PB * 2 * PT * 64);
    } else if (kind == 2) {
        if (ti < 128) {
            const int page = ((const int*)F.a->in[I_PT])[seq * NPG + (ti >> 1)], slot = (ti & 1) * 64 + rr;
            const float* kp = FIN(I_CACHE) + (((((size_t)l * NPHYS + page) * PAGE + slot) * 4 + 2) * 2 + kvh) * 64 + pc * 8;
            R.a = *(const v4u*)kp; R.b = *(const v4u*)(kp + 4); R.c = *(const v4u*)(kp + 128); R.d = *(const v4u*)(kp + 132); R.mode = 1;
        } else if (rr < ST) {
            const bf16* kp = WSP(bf16, WS_KVS) + ((((size_t)0 * SB + seq) * 2 + kvh) * ST + rr) * 64 + pc * 8;
            R.a = *(const v4u*)kp; R.c = *(const v4u*)(kp + (size_t)SB * 2 * ST * 64);
        } else R.mode = 2;
    } else {
        if (ti < 8) {
            const float* kp = FIN(I_CWIN) + (((((size_t)l * SB + seq) * WINB + ti * 64 + rr) * 2 + 0) * 2 + kvh) * 64 + pc * 8;
            R.a = *(const v4u*)kp; R.b = *(const v4u*)(kp + 4); R.c = *(const v4u*)(kp + 128); R.d = *(const v4u*)(kp + 132); R.mode = 1;
        } else if (rr < ST) {
            const bf16* kp = WSP(bf16, WS_KVS) + ((((size_t)2 * SB + seq) * 2 + kvh) * ST + rr) * 64 + pc * 8;
            R.a = *(const v4u*)kp; R.c = *(const v4u*)(kp + (size_t)SB * 2 * ST * 64);
        } else R.mode = 2;
    }
}
__device__ __forceinline__ void at_store(const Frame& F, int buf, const TileRegs& R) {
    const int rr = F.tid >> 3, pc = F.tid & 7; v4u k, v;
    if (R.mode == 0) { k = R.a; v = R.c; }
    else if (R.mode == 1) { k = pack8(__builtin_bit_cast(f32x4, R.a), __builtin_bit_cast(f32x4, R.b)); v = pack8(__builtin_bit_cast(f32x4, R.c), __builtin_bit_cast(f32x4, R.d)); }
    else { k = (v4u){0u, 0u, 0u, 0u}; v = k; }
    *(LAS v4u*)(F.lds + AT_K0 + buf * 64 * AT_RS + rr * AT_RS + pc * 16) = k;
    *(LAS v4u*)(F.lds + AT_V0 + buf * 64 * AT_RS + rr * AT_RS + pc * 16) = v;
}

template <bool SMP> __device__ __forceinline__ void attn_unit(Frame& F, int l, int unit) {
    const int tid = F.tid, lane = F.lane, w = F.wave;
    const int q = lane & 31, h_ = lane >> 5, blk = (lane >> 4) & 1, tl = q >> 2, hr = q & 3;
    int seq, kvh, qt;
    if (SMP) { seq = unit >> 1; kvh = unit & 1; qt = 128; } else { seq = unit >> 7; kvh = (unit >> 6) & 1; qt = unit & 63; }
    const int t0 = SMP ? PAST : qt * 64;
    const int tokl = SMP ? tl : 8 * w + tl, t = t0 + tokl;
    const size_t row = SMP ? (size_t)PM + seq * ST + tl : (size_t)seq * PT + t;
    const int head = kvh * 4 + hr;
    LAS float* PS = (LAS float*)(F.lds + AT_PS); LAS float* IMPw = (LAS float*)(F.lds + AT_IMP) + w * 192;
    LAS unsigned long long* MASKS = (LAS unsigned long long*)(F.lds + AT_MASK); LAS unsigned short* LIST = (LAS unsigned short*)(F.lds + AT_LIST); LAS int* NL = (LAS int*)(F.lds + AT_NL);
    constexpr int PSS = SMP ? 520 : 264;
    LAS float* PSw = SMP ? PS : PS + w * 8 * PSS;
    __syncthreads();
    bf16x8 qf[4];
    { const bf16* qp = WSP(bf16, WS_QN) + row * 512 + head * 64 + 8 * h_;
#pragma unroll
      for (int kk = 0; kk < 4; ++kk) qf[kk] = *(const bf16x8*)(qp + 16 * kk); }
    const float* ngp = WSP(float, WS_NG) + row * 24 + head * 3; const float g0 = ngp[0], g1 = ngp[1], g2 = ngp[2];
    if (!SMP) { for (int i = lane; i < 8 * PSS; i += 64) PSw[i] = 0.f; }
    const int ntc = SMP ? 8 : ((t0 + 32) >> 10) + 1;
    if (tid < 2 * ntc) LIST[tid] = (unsigned short)(((tid >= ntc ? 1u : 0u) << 14) | (unsigned)(tid >= ntc ? tid - ntc : tid));
    if (tid == 0) LIST[2 * ntc] = (unsigned short)AT_MARK;
    int nl = 2 * ntc + 1;
    TileRegs R;
    at_prefetch<SMP>(F, l, seq, kvh, (unsigned)0, R);
    at_store(F, 0, R);
    __syncthreads();
    float m = -INFINITY, lsum = 0.f, invden = 0.f;
    f32x16 O[2]; O[0] = (f32x16){}; O[1] = (f32x16){};
    LAS float* OAw = (LAS float*)(F.lds + AT_PS) + w * (SMP ? 2048 : 8 * PSS) + lane;
    unsigned long long mk0 = 0ull, mk1 = 0ull, wu = ~0ull;
    int cur_kind = -1, idx = 0;
#define AT_FINALIZE(kind) do { \
        if ((kind) == 0) { const float lt = lsum + __shfl_xor(lsum, 32); invden = lt > 0.f ? 1.0f / lt : 0.f; } \
        else if ((kind) == 1) { const float sc = g0 * invden; O[0] *= sc; O[1] *= sc; } \
        else if ((kind) == 2) { const float lt = lsum + __shfl_xor(lsum, 32); const float sc = (lt > 0.f ? 1.0f / lt : 0.f) * g1; \
            _Pragma("unroll") for (int r_ = 0; r_ < 16; ++r_) { OAw[r_ * 64] += O[0][r_] * sc; OAw[(16 + r_) * 64] += O[1][r_] * sc; } } } while (0)
    while (idx < nl) {
        const unsigned e = (unsigned)__builtin_amdgcn_readfirstlane((int)LIST[idx]);
        if (e == AT_MARK) {
            AT_FINALIZE(cur_kind); cur_kind = -1;
            LDS_WAIT(); asm volatile("" ::: "memory");
#pragma unroll 1
            for (int tk = 0; tk < 8; ++tk) {
                const LAS float* pr = PSw + tk * PSS;
                if (!SMP) {
                    const int s = lane; float imp = 0.f;
#pragma unroll
                    for (int n = 4 * s - 1; n <= 4 * s + 3; ++n) if (n >= 0) imp += pr[n];
                    const bool forced = (s == 0) || (s == qt) || (s == qt - 1), avail = s <= qt;
                    const float val = avail ? (forced ? 1e4f : imp) : -1e4f;
                    IMPw[s] = val; LDS_WAIT(); asm volatile("" ::: "memory");
                    int rank = 0;
#pragma unroll 8
                    for (int i = 0; i < 64; ++i) { const float v = IMPw[i]; rank += (v > val || (v == val && i < s)) ? 1 : 0; }
                    const unsigned long long mk = __ballot(rank < 16);
                    if (lane == 0) MASKS[(8 * w + tk) * 4] = mk;
                    LDS_WAIT(); asm volatile("" ::: "memory");
                } else {
                    const int sa = lane, sb = lane + 64; float ia = 0.f, ib = 0.f;
#pragma unroll
                    for (int n = 4 * sa - 1; n <= 4 * sa + 3; ++n) if (n >= 0) ia += pr[n];
#pragma unroll
                    for (int n = 4 * sb - 1; n <= 4 * sb + 3; ++n) ib += pr[n];
                    const bool fa = (sa == 0), fb = (sb == 127);
                    const float va = fa ? 1e4f : ia, vb = fb ? 1e4f : ib;
                    IMPw[sa] = va; IMPw[sb] = vb; LDS_WAIT(); asm volatile("" ::: "memory");
                    int ra = fa ? 0 : 1, rb = fb ? 0 : 1;
#pragma unroll 8
                    for (int i = 0; i < 128; ++i) { const float v = IMPw[i]; ra += (v > va || (v == va && i < sa)) ? 1 : 0; rb += (v > vb || (v == vb && i < sb)) ? 1 : 0; }
                    const unsigned long long ma = __ballot(ra < 16), mb = __ballot(rb < 16);
                    if (lane == 0) { MASKS[tk * 4] = ma; MASKS[tk * 4 + 1] = mb; MASKS[tk * 4 + 2] = 1ull; }
                    LDS_WAIT(); asm volatile("" ::: "memory");
                }
            }
            __syncthreads();
#pragma unroll
            for (int r_ = 0; r_ < 16; ++r_) { OAw[r_ * 64] = O[0][r_]; OAw[(16 + r_) * 64] = O[1][r_]; }
            if (tid == 0) {
                int n = idx + 1;
                if (!SMP) { unsigned long long U = 0ull; for (int i = 0; i < 64; ++i) U |= MASKS[i * 4];
                    for (int s = 0; s <= qt; ++s) if ((U >> s) & 1ull) LIST[n++] = (unsigned short)((2u << 14) | (unsigned)s);
                    for (int s = (qt > 8 ? qt - 8 : 0); s <= qt; ++s) LIST[n++] = (unsigned short)((3u << 14) | (unsigned)s);
                } else { unsigned long long U0 = 0ull, U1 = 0ull; for (int i = 0; i < 8; ++i) { U0 |= MASKS[i * 4]; U1 |= MASKS[i * 4 + 1]; }
                    for (int s = 0; s < 64; ++s) if ((U0 >> s) & 1ull) LIST[n++] = (unsigned short)((2u << 14) | (unsigned)s);
                    for (int s = 0; s < 64; ++s) if ((U1 >> s) & 1ull) LIST[n++] = (unsigned short)((2u << 14) | (unsigned)(64 + s));
                    LIST[n++] = (unsigned short)((2u << 14) | 128u);
                    for (int s = 0; s <= 8; ++s) LIST[n++] = (unsigned short)((3u << 14) | (unsigned)s); }
                NL[0] = n;
            }
            __syncthreads();
            nl = __builtin_amdgcn_readfirstlane(NL[0]);
            mk0 = MASKS[tokl * 4]; if (SMP) { mk1 = MASKS[tokl * 4 + 1]; }
            if (!SMP) { unsigned long long u = 0ull; for (int i = 0; i < 8; ++i) u |= MASKS[(8 * w + i) * 4]; wu = u; }
            if (idx + 1 < nl) { at_prefetch<SMP>(F, l, seq, kvh, (unsigned)LIST[idx + 1], R); at_store(F, (idx + 1) & 1, R); }
            __syncthreads();
            ++idx; continue;
        }
        const int kind = (int)(e >> 14), ti = (int)(e & 0x3fffu);
        if (kind != cur_kind) {
            if (cur_kind >= 0) AT_FINALIZE(cur_kind);
            if (kind != 1) m = -INFINITY;
            lsum = 0.f; O[0] = (f32x16){}; O[1] = (f32x16){}; cur_kind = kind;
        }
        const unsigned en = (idx + 1 < nl) ? (unsigned)__builtin_amdgcn_readfirstlane((int)LIST[idx + 1]) : AT_MARK;
        const bool have_next = (en != AT_MARK);
        if (have_next) at_prefetch<SMP>(F, l, seq, kvh, en, R);
        bool active = true;
        if (!SMP && kind == 2) active = ((wu >> ti) & 1ull) != 0ull;
        if (active) {
            const LAS unsigned char* Kb = F.lds + AT_K0 + (idx & 1) * 64 * AT_RS; const LAS unsigned char* Vb = F.lds + AT_V0 + (idx & 1) * 64 * AT_RS;
            int lo, hi; const int kb = 64 * ti;
            if (kind < 2) { lo = 0; hi = SMP ? 510 : ((t >= 31) ? ((t - 31) >> 4) : -1); }
            else if (kind == 2) { lo = 0; const unsigned long long mw = (ti < 64) ? mk0 : ((ti < 128) ? mk1 : 1ull); hi = ((mw >> (ti & 63)) & 1ull) ? t : -1; }
            else { if (SMP) { lo = tl; hi = WINB + tl; } else { lo = t - WINB; hi = t; } }
            f32x16 s0 = (f32x16){}, s1 = (f32x16){};
#pragma unroll
            for (int kk = 0; kk < 4; ++kk) {
                const bf16x8 k0 = *(const LAS bf16x8*)(Kb + q * AT_RS + (16 * kk + 8 * h_) * 2), k1 = *(const LAS bf16x8*)(Kb + (32 + q) * AT_RS + (16 * kk + 8 * h_) * 2);
                s0 = mfma32(k0, qf[kk], s0); s1 = mfma32(k1, qf[kk], s1);
            }
            float tmax = -INFINITY;
#pragma unroll
            for (int r = 0; r < 16; ++r) { const int key = kb + (r & 3) + 8 * (r >> 2) + 4 * h_;
                s0[r] = (key >= lo && key <= hi) ? s0[r] : -INFINITY; s1[r] = (key + 32 >= lo && key + 32 <= hi) ? s1[r] : -INFINITY;
                tmax = fmaxf(tmax, fmaxf(s0[r], s1[r])); }
            tmax = fmaxf(tmax, __shfl_xor(tmax, 32));
            const float m_new = fmaxf(m, tmax), m_use = (m_new == -INFINITY) ? 0.f : m_new;
            const float alpha = fexp2(m - m_use);
            float ps = 0.f;
#pragma unroll
            for (int r = 0; r < 16; ++r) { s0[r] = fexp2(s0[r] - m_use); s1[r] = fexp2(s1[r] - m_use); ps += s0[r] + s1[r]; }
            lsum = lsum * alpha + ps; m = m_new;
            if (kind != 0) {
                O[0] *= alpha; O[1] *= alpha;
#pragma unroll
                for (int kt2 = 0; kt2 < 2; ++kt2)
#pragma unroll
                    for (int s2 = 0; s2 < 2; ++s2) { const bf16x8 pf = cvt_frag(kt2 ? s1 : s0, s2); const int rA = 32 * kt2 + 16 * s2 + 4 * h_;
#pragma unroll
                        for (int dt = 0; dt < 2; ++dt) { const bf16x8 vf = tr_frag(Vb, AT_RS, rA, rA + 8, 32 * dt + 16 * blk, lane); O[dt] = mfma32(vf, pf, O[dt]); } }
            }
            if (kind == 1) {
#pragma unroll
                for (int r = 0; r < 16; ++r) { const int n = kb + (r & 3) + 8 * (r >> 2) + 4 * h_;
                    float a = s0[r] * invden, b = s1[r] * invden; a += __shfl_xor(a, 1); b += __shfl_xor(b, 1); a += __shfl_xor(a, 2); b += __shfl_xor(b, 2);
                    if (hr == 0) { PSw[tl * PSS + n] = a; PSw[tl * PSS + n + 32] = b; } }
            }
        }
        if (have_next) at_store(F, (idx + 1) & 1, R);
        __syncthreads();
        ++idx;
    }
#undef AT_FINALIZE
    {
        const float lt = lsum + __shfl_xor(lsum, 32); const float sc = (lt > 0.f ? 1.0f / lt : 0.f) * g2;
        if (!SMP || w == 0) {
            bf16* op = WSP(bf16, WS_OA) + row * 512 + head * 64;
#pragma unroll
            for (int dt = 0; dt < 2; ++dt)
#pragma unroll
                for (int r4 = 0; r4 < 4; ++r4) { float o_[4];
#pragma unroll
                    for (int x = 0; x < 4; ++x) o_[x] = OAw[(dt * 16 + 4 * r4 + x) * 64] + O[dt][4 * r4 + x] * sc;
                    v2u wv; wv.x = pk2(o_[0], o_[1]); wv.y = pk2(o_[2], o_[3]); *(v2u*)(op + 32 * dt + 8 * r4 + 4 * h_) = wv; }
        }
    }
}

constexpr int AS_RS = 144;
constexpr int AS_V = 0, AS_VW = 32 * AS_RS, AS_MRG = 0, AS_PS = 73728, AS_IMP = AS_PS + 16640, AS_MASK = AS_IMP + 6144;
static_assert(8 * 34 * 64 * 4 <= AS_PS && AS_MASK + 512 <= RING_BYTES, "sample attention LDS map");

__device__ __forceinline__ float xhalf_max(float x) { auto t_ = __builtin_amdgcn_permlane32_swap(__float_as_uint(x), __float_as_uint(x), false, false); return fmaxf(__uint_as_float(t_[0]), __uint_as_float(t_[1])); }
__device__ __forceinline__ float xhalf_sum(float x) { auto t_ = __builtin_amdgcn_permlane32_swap(__float_as_uint(x), __float_as_uint(x), false, false); return __uint_as_float(t_[0]) + __uint_as_float(t_[1]); }
struct ASrc { const float* kf; const float* vf; const bf16* kb; const bf16* vb; int rs; int nvalid; };
#define AS_TILE(SRC, KB0, LO_, HI_, DO_PV, DO_PS, m, lsum, O0, O1, invden, PSS_) do { \
        bf16x8 kfr[4]; \
        if ((SRC).kb) { const bf16* kp_ = (SRC).kb + (size_t)q * (SRC).rs + 8 * h_; _Pragma("unroll") for (int kk = 0; kk < 4; ++kk) kfr[kk] = *(const bf16x8*)(kp_ + 16 * kk); } \
        else { const float* kp_ = (SRC).kf + (size_t)q * (SRC).rs + 8 * h_; _Pragma("unroll") for (int kk = 0; kk < 4; ++kk) { const f32x4 a_ = *(const f32x4*)(kp_ + 16 * kk), b_ = *(const f32x4*)(kp_ + 16 * kk + 4); kfr[kk] = __builtin_bit_cast(bf16x8, pack8(a_, b_)); } } \
        if (DO_PV) { const int vr_ = lane >> 1, vh_ = lane & 1; v4u vv_[4]; \
            if (vr_ >= (SRC).nvalid) { _Pragma("unroll") for (int x = 0; x < 4; ++x) vv_[x] = (v4u){0u, 0u, 0u, 0u}; } \
            else if ((SRC).vb) { const bf16* vp_ = (SRC).vb + (size_t)vr_ * (SRC).rs + 32 * vh_; _Pragma("unroll") for (int x = 0; x < 4; ++x) vv_[x] = *(const v4u*)(vp_ + 8 * x); } \
            else { const float* vp_ = (SRC).vf + (size_t)vr_ * (SRC).rs + 32 * vh_; _Pragma("unroll") for (int x = 0; x < 4; ++x) vv_[x] = pack8(*(const f32x4*)(vp_ + 8 * x), *(const f32x4*)(vp_ + 8 * x + 4)); } \
            _Pragma("unroll") for (int x = 0; x < 4; ++x) *(LAS v4u*)(Vw + vr_ * AS_RS + vh_ * 64 + x * 16) = vv_[x]; } \
        f32x16 s_ = (f32x16){}; \
        _Pragma("unroll") for (int kk = 0; kk < 4; ++kk) s_ = mfma32(kfr[kk], qf[kk], s_); \
        float tmax_ = -INFINITY; \
        _Pragma("unroll") for (int r = 0; r < 16; ++r) { const int key_ = (KB0) + (r & 3) + 8 * (r >> 2) + 4 * h_; s_[r] = (key_ >= (LO_) && key_ <= (HI_)) ? s_[r] : -INFINITY; tmax_ = fmaxf(tmax_, s_[r]); } \
        tmax_ = xhalf_max(tmax_); \
        const float mn_ = fmaxf(m, tmax_), mu_ = (mn_ == -INFINITY) ? 0.f : mn_, al_ = fexp2(m - mu_); float ps_ = 0.f; \
        _Pragma("unroll") for (int r = 0; r < 16; ++r) { s_[r] = fexp2(s_[r] - mu_); ps_ += s_[r]; } \
        lsum = lsum * al_ + ps_; m = mn_; \
        if (DO_PV) { O0 *= al_; O1 *= al_; LDS_WAIT(); asm volatile("" ::: "memory"); \
            _Pragma("unroll") for (int s2 = 0; s2 < 2; ++s2) { const bf16x8 pf_ = cvt_frag(s_, s2); const int rA_ = 16 * s2 + 4 * h_; \
                O0 = mfma32(tr_frag(Vw, AS_RS, rA_, rA_ + 8, 16 * blk, lane), pf_, O0); O1 = mfma32(tr_frag(Vw, AS_RS, rA_, rA_ + 8, 32 + 16 * blk, lane), pf_, O1); } \
            LDS_WAIT(); asm volatile("" ::: "memory"); } \
        if (DO_PS) { _Pragma("unroll") for (int r = 0; r < 16; ++r) { const int n_ = (KB0) + (r & 3) + 8 * (r >> 2) + 4 * h_; float a_ = s_[r] * (invden); a_ += __shfl_xor(a_, 1); a_ += __shfl_xor(a_, 2); if (hr == 0) PS[tl * (PSS_) + n_] = a_; } } \
    } while (0)

__device__ __forceinline__ void attn_sample_unit(Frame& F, int l, int unit) {
    const int lane = F.lane, w = F.wave, tid = F.tid;
    const int q = lane & 31, h_ = lane >> 5, blk = (lane >> 4) & 1, tl = q >> 2, hr = q & 3;
    const int seq = unit >> 1, kvh = unit & 1, head = kvh * 4 + hr;
    const size_t row = (size_t)PM + seq * ST + tl;
    LAS unsigned char* Vw = F.lds + AS_V + w * AS_VW;
    LAS float* MRG = (LAS float*)(F.lds + AS_MRG);
    LAS float* PS = (LAS float*)(F.lds + AS_PS);
    LAS float* IMPw = (LAS float*)(F.lds + AS_IMP) + w * 192;
    LAS unsigned long long* MASKS = (LAS unsigned long long*)(F.lds + AS_MASK);
    __syncthreads();
    bf16x8 qf[4];
    { const bf16* qp = WSP(bf16, WS_QN) + row * 512 + head * 64 + 8 * h_;
#pragma unroll
      for (int kk = 0; kk < 4; ++kk) qf[kk] = *(const bf16x8*)(qp + 16 * kk); }
    const float* ngp = WSP(float, WS_NG) + row * 24 + head * 3; const float g0 = ngp[0], g1 = ngp[1], g2 = ngp[2];
    const int* ptab = (const int*)F.a->in[I_PT] + seq * NPG;
    f32x16 OA0 = (f32x16){}, OA1 = (f32x16){};

#define AS_PUBLISH(m, lsum, O0, O1) do { __syncthreads(); LAS float* mp_ = MRG + w * 34 * 64 + lane; mp_[0] = m; mp_[64] = lsum; \
        _Pragma("unroll") for (int r = 0; r < 16; ++r) { mp_[(2 + r) * 64] = O0[r]; mp_[(18 + r) * 64] = O1[r]; } __syncthreads(); } while (0)

    const bf16* CKk = WSP(bf16, WS_CK) + ((size_t)(seq * 2 + kvh) * 512) * 64; const bf16* CKv = CKk + (size_t)CMP_ROWS_J * 64;
    float mC = -INFINITY, lC = 0.f; f32x16 D0 = (f32x16){}, D1 = (f32x16){};
#pragma unroll 1
    for (int ti = w; ti < 16; ti += 8) { ASrc S{nullptr, nullptr, CKk + (size_t)ti * 32 * 64, CKv + (size_t)ti * 32 * 64, 64, 32}; AS_TILE(S, ti * 32, 0, 510, false, false, mC, lC, D0, D1, 0.f, 520); }
    { __syncthreads(); MRG[w * 128 + lane] = mC; MRG[w * 128 + 64 + lane] = xhalf_sum(lC); __syncthreads(); }
    float mT = -INFINITY;
#pragma unroll
    for (int x = 0; x < 8; ++x) mT = fmaxf(mT, MRG[x * 128 + lane]);
    float lT = 0.f;
#pragma unroll
    for (int x = 0; x < 8; ++x) { const float mx_ = MRG[x * 128 + lane]; lT += (mx_ == -INFINITY) ? 0.f : MRG[x * 128 + 64 + lane] * fexp2(mx_ - mT); }
    const float invC = lT > 0.f ? 1.0f / lT : 0.f;
    __syncthreads();
    { float mB = mT, lB = 0.f;
#pragma unroll 1
      for (int ti = w; ti < 16; ti += 8) { ASrc S{nullptr, nullptr, CKk + (size_t)ti * 32 * 64, CKv + (size_t)ti * 32 * 64, 64, 32}; AS_TILE(S, ti * 32, 0, 510, true, true, mB, lB, D0, D1, invC, 520); }
      AS_PUBLISH(mB, lB, D0, D1); }
    { const float sc = g0 * invC;
#pragma unroll 1
      for (int x = 0; x < 8; ++x) { const LAS float* mp = MRG + x * 34 * 64 + lane;
#pragma unroll
          for (int r = 0; r < 16; ++r) { OA0[r] += mp[(2 + r) * 64] * sc; OA1[r] += mp[(18 + r) * 64] * sc; } } }
    {
        const LAS float* pr = PS + w * 520; const int sa = lane, sb = lane + 64; float ia = 0.f, ib = 0.f;
#pragma unroll
        for (int n = 4 * sa - 1; n <= 4 * sa + 3; ++n) if (n >= 0) ia += pr[n];
#pragma unroll
        for (int n = 4 * sb - 1; n <= 4 * sb + 3; ++n) ib += pr[n];
        const bool fa = (sa == 0), fb = (sb == 127); const float va = fa ? 1e4f : ia, vb = fb ? 1e4f : ib;
        IMPw[sa] = va; IMPw[sb] = vb; LDS_WAIT(); asm volatile("" ::: "memory");
        int ra = fa ? 0 : 1, rb = fb ? 0 : 1;
#pragma unroll 8
        for (int i = 0; i < 128; ++i) { const float v = IMPw[i]; ra += (v > va || (v == va && i < sa)) ? 1 : 0; rb += (v > vb || (v == vb && i < sb)) ? 1 : 0; }
        const unsigned long long ma = __ballot(ra < 16), mb = __ballot(rb < 16);
        if (lane == 0) { MASKS[w * 4] = ma; MASKS[w * 4 + 1] = mb; }
    }
    __syncthreads();
    const unsigned long long mk0 = MASKS[tl * 4], mk1 = MASKS[tl * 4 + 1];
    unsigned long long U0 = 0ull, U1 = 0ull;
#pragma unroll
    for (int x = 0; x < 8; ++x) { U0 |= MASKS[x * 4]; U1 |= MASKS[x * 4 + 1]; }
    {
        float m = -INFINITY, ls = 0.f; D0 = (f32x16){}; D1 = (f32x16){};
        const int t = PAST + tl; int cnt = 0;
#pragma unroll 1
        for (int s = 0; s <= 128; ++s) {
            const bool in_u = (s < 64) ? ((U0 >> s) & 1ull) : ((s < 128) ? ((U1 >> (s - 64)) & 1ull) : true);
            if (!in_u) continue;
            const bool selb = (s < 64) ? ((mk0 >> s) & 1ull) : ((s < 128) ? ((mk1 >> (s - 64)) & 1ull) : true);
            const int nh = (s < 128) ? 2 : 1;
            for (int hf = 0; hf < nh; ++hf, ++cnt) {
                if ((cnt & 7) != w) continue;
                const int hi = selb ? t : -1;
                if (s < 128) { const int page = ptab[s >> 1], slot = (s & 1) * 64 + hf * 32;
                    const float* kp = FIN(I_CACHE) + (((((size_t)l * NPHYS + page) * PAGE + slot) * 4 + 2) * 2 + kvh) * 64;
                    ASrc S{kp, kp + 128, nullptr, nullptr, 512, 32}; AS_TILE(S, s * 64 + hf * 32, 0, hi, true, false, m, ls, D0, D1, 0.f, 520); }
                else { const bf16* kp = WSP(bf16, WS_KVS) + ((((size_t)0 * SB + seq) * 2 + kvh) * ST) * 64;
                    ASrc S{nullptr, nullptr, kp, kp + (size_t)SB * 2 * ST * 64, 64, ST}; AS_TILE(S, PAST, 0, hi, true, false, m, ls, D0, D1, 0.f, 520); }
            }
        }
        AS_PUBLISH(m, ls, D0, D1);
        float mt = -INFINITY;
#pragma unroll
        for (int x = 0; x < 8; ++x) mt = fmaxf(mt, MRG[x * 34 * 64 + lane]);
        float lt = 0.f; f32x16 T0 = (f32x16){}, T1 = (f32x16){};
#pragma unroll 1
        for (int x = 0; x < 8; ++x) { const LAS float* mp = MRG + x * 34 * 64 + lane; const float mx_ = mp[0]; const float f = (mx_ == -INFINITY) ? 0.f : fexp2(mx_ - mt); lt += mp[64] * f;
#pragma unroll
            for (int r = 0; r < 16; ++r) { T0[r] += mp[(2 + r) * 64] * f; T1[r] += mp[(18 + r) * 64] * f; } }
        lt = xhalf_sum(lt); const float sc = (lt > 0.f ? 1.0f / lt : 0.f) * g1; OA0 += T0 * sc; OA1 += T1 * sc;
    }
    {
        float m = -INFINITY, ls = 0.f; D0 = (f32x16){}; D1 = (f32x16){};
#pragma unroll 1
        for (int ti = w; ti < 17; ti += 8) {
            if (ti < 16) { const float* kp = FIN(I_CWIN) + (((((size_t)l * SB + seq) * WINB + ti * 32) * 2 + 0) * 2 + kvh) * 64;
                ASrc S{kp, kp + 128, nullptr, nullptr, 256, 32}; AS_TILE(S, ti * 32, tl, WINB + tl, true, false, m, ls, D0, D1, 0.f, 520); }
            else { const bf16* kp = WSP(bf16, WS_KVS) + ((((size_t)2 * SB + seq) * 2 + kvh) * ST) * 64;
                ASrc S{nullptr, nullptr, kp, kp + (size_t)SB * 2 * ST * 64, 64, ST}; AS_TILE(S, WINB, tl, WINB + tl, true, false, m, ls, D0, D1, 0.f, 520); }
        }
        AS_PUBLISH(m, ls, D0, D1);
        float mt = -INFINITY;
#pragma unroll
        for (int x = 0; x < 8; ++x) mt = fmaxf(mt, MRG[x * 34 * 64 + lane]);
        float lt = 0.f; f32x16 T0 = (f32x16){}, T1 = (f32x16){};
#pragma unroll 1
        for (int x = 0; x < 8; ++x) { const LAS float* mp = MRG + x * 34 * 64 + lane; const float mx_ = mp[0]; const float f = (mx_ == -INFINITY) ? 0.f : fexp2(mx_ - mt); lt += mp[64] * f;
#pragma unroll
            for (int r = 0; r < 16; ++r) { T0[r] += mp[(2 + r) * 64] * f; T1[r] += mp[(18 + r) * 64] * f; } }
        lt = xhalf_sum(lt); const float sc = (lt > 0.f ? 1.0f / lt : 0.f) * g2; OA0 += T0 * sc; OA1 += T1 * sc;
    }
#undef AS_PUBLISH
    if (w == 0) {
        bf16* op = WSP(bf16, WS_OA) + row * 512 + head * 64;
#pragma unroll
        for (int r4 = 0; r4 < 4; ++r4) { v2u a, b; a.x = pk2(OA0[4 * r4 + 0], OA0[4 * r4 + 1]); a.y = pk2(OA0[4 * r4 + 2], OA0[4 * r4 + 3]); b.x = pk2(OA1[4 * r4 + 0], OA1[4 * r4 + 1]); b.y = pk2(OA1[4 * r4 + 2], OA1[4 * r4 + 3]);
            *(v2u*)(op + 8 * r4 + 4 * h_) = a; *(v2u*)(op + 32 + 8 * r4 + 4 * h_) = b; }
    }
}

#ifndef DBG_DUP
#define DBG_DUP 0
#endif
#if DBG_DUP == 1
#define AP_DUP_QK(NK) { f32x16 d_ = (f32x16){}; _Pragma("unroll") for (int kk = 0; kk < 4; ++kk) d_ = mfma32(NK[kk], qf[(kk + 1) & 3], d_); _Pragma("unroll") for (int r = 0; r < 16; ++r) s_[r] += zf * d_[r]; }
#else
#define AP_DUP_QK(NK)
#endif
#if DBG_DUP == 2
#define AP_DUP_EXP() { float acc_ = 0.f; _Pragma("unroll") for (int r = 0; r < 16; ++r) acc_ += fexp2(s_[r] * 0.5f - 3.0f); lsum += zf * acc_; }
#else
#define AP_DUP_EXP()
#endif
#if DBG_DUP == 3
#define AP_DUP_PV() { f32x16 e0_ = (f32x16){}, e1_ = (f32x16){}; _Pragma("unroll") for (int s2 = 0; s2 < 2; ++s2) { const bf16x8 pf_ = cvt_frag(s_, 1 - s2); const int rA_ = 16 * s2 + 4 * h_; \
        e0_ = mfma32(tr_frag(Vw, AS_RS, rA_ + 8, rA_, 16 * blk, lane), pf_, e0_); e1_ = mfma32(tr_frag(Vw, AS_RS, rA_ + 8, rA_, 32 + 16 * blk, lane), pf_, e1_); } D0 += e0_ * zf; D1 += e1_ * zf; }
#else
#define AP_DUP_PV()
#endif
constexpr int AP_WS = 14336, AP_V = 0, AP_PS = 4608, AP_IMP = AP_PS + 8 * 264 * 4, AP_MASK = AP_IMP + 256, AP_LIST = AP_MASK + 64;
static_assert(AP_LIST + 2 * 192 <= AP_WS && 8 * AP_WS <= RING_BYTES, "prompt attention LDS map");
__device__ __forceinline__ void attn_prompt_unit(Frame& F, int l, int unit) {
    const int lane = F.lane, w = F.wave;
    const int q = lane & 31, h_ = lane >> 5, blk = (lane >> 4) & 1, tl = q >> 2, hr = q & 3;
    const int seq = unit >> 7, kvh = (unit >> 6) & 1, qt = unit & 63, head = kvh * 4 + hr;
    const int t0w = qt * 64 + 8 * w, t = t0w + tl; const size_t row = (size_t)seq * PT + t;
    LAS unsigned char* Vw = F.lds + w * AP_WS + AP_V; LAS float* PS = (LAS float*)(F.lds + w * AP_WS + AP_PS); LAS float* IMPw = (LAS float*)(F.lds + w * AP_WS + AP_IMP);
    LAS unsigned long long* MASKS = (LAS unsigned long long*)(F.lds + w * AP_WS + AP_MASK); LAS unsigned short* LIST = (LAS unsigned short*)(F.lds + w * AP_WS + AP_LIST);
    __syncthreads();
    bf16x8 qf[4];
    { const bf16* qp = WSP(bf16, WS_QN) + row * 512 + head * 64 + 8 * h_;
#pragma unroll
      for (int kk = 0; kk < 4; ++kk) qf[kk] = *(const bf16x8*)(qp + 16 * kk); }
    const float* ngp = WSP(float, WS_NG) + row * 24 + head * 3; const float g0 = ngp[0], g1 = ngp[1], g2 = ngp[2];
    for (int i = lane; i < 8 * 264; i += 64) PS[i] = 0.f;
    const bf16* CKk = WSP(bf16, WS_CK) + ((size_t)32768 + (seq * 2 + kvh) * 256) * 64; const bf16* CKv = CKk + (size_t)CMP_ROWS_J * 64;
    const bf16* KS = WSP(bf16, WS_KVB) + ((((size_t)0 * PB + seq) * 2 + kvh) * PT) * 64; const bf16* VS = KS + (size_t)PB * 2 * PT * 64;
    const bf16* KW = KS + (size_t)2 * PB * 2 * PT * 64; const bf16* VW = KW + (size_t)PB * 2 * PT * 64;
    const int hiCmin = (t0w >= 31) ? ((t0w - 31) >> 4) : -1;
    const int hiC = (t >= 31) ? ((t - 31) >> 4) : -1; const int nmaxw = (t0w + 7 >= 31) ? ((t0w + 7 - 31) >> 4) : -1; const int ntc = (nmaxw >= 0) ? (nmaxw >> 5) + 1 : 0;
    f32x16 D0 = (f32x16){}, D1 = (f32x16){};
    LAS float* OAG = PS + lane;
    float m = -INFINITY, lsum = 0.f, invC = 0.f; unsigned long long mk0 = 0ull;
    const float zf = (F.G == 12345) ? 1.0f : 0.0f;
    bf16x8 nk0[4]; v4u nv0[4], nv1[4];
#define AP_LOADK(e_, NK) do { const int kd_ = (int)((e_) >> 12), ti_ = (int)((e_) & 0xfffu); const bf16* kb_ = (kd_ < 2 ? CKk : (kd_ == 2 ? KS : KW)) + (size_t)ti_ * 32 * 64; \
        const int ko_ = kd_ < 2 ? q * 64 + 8 * h_ : lane * 8, ks_ = kd_ < 2 ? 16 : 512;     \
        _Pragma("unroll") for (int kk = 0; kk < 4; ++kk) NK[kk] = *(const bf16x8*)(kb_ + ko_ + ks_ * kk); } while (0)
#define AP_LOADV(e_, NV) do { const int kd_ = (int)((e_) >> 12), ti_ = (int)((e_) & 0xfffu); const bf16* vb_ = (kd_ < 2 ? CKv : (kd_ == 2 ? VS : VW)) + (size_t)ti_ * 32 * 64; \
        _Pragma("unroll") for (int x = 0; x < 4; ++x) NV[x] = *(const v4u*)(vb_ + 512 * x + lane * 8); } while (0)
#define AP_LOADT(e_, NK, NV) do { AP_LOADK(e_, NK); AP_LOADV(e_, NV); } while (0)
#define AP_STEP(i_, n_, NK, NV, NVN, EC, ECN) do { \
        const unsigned e_ = EC; const int kind = (int)(e_ >> 12), ti = (int)(e_ & 0xfffu); \
        if (kind == 1) { _Pragma("unroll") for (int x = 0; x < 4; ++x) *(LAS v4u*)(Vw + (8 * x + (lane >> 3)) * AS_RS + (lane & 7) * 16) = NV[x]; }     \
        f32x16 s_ = (f32x16){}; \
        _Pragma("unroll") for (int kk = 0; kk < 4; ++kk) s_ = mfma32(NK[kk], qf[kk], s_); \
        AP_DUP_QK(NK) \
          \
        if ((i_) + 1 < (n_)) { AP_LOADK(ECN, NK); AP_LOADV(ECN, NVN); if ((i_) + 2 < (n_)) EC = (unsigned)__builtin_amdgcn_readfirstlane((int)LIST[(i_) + 2]); } \
        if (kind != cur_kind) { \
            if (cur_kind == 0) { const float lt_ = xhalf_sum(lsum); invC = lt_ > 0.f ? 1.0f / lt_ : 0.f; } \
            else if (cur_kind == 2) { const float lt_ = xhalf_sum(lsum); const float sc_ = (lt_ > 0.f ? 1.0f / lt_ : 0.f) * g1; \
                _Pragma("unroll") for (int r = 0; r < 16; ++r) { OAG[r * 64] += D0[r] * sc_; OAG[(16 + r) * 64] += D1[r] * sc_; } } \
            if (kind != 1) m = -INFINITY; lsum = 0.f; D0 = (f32x16){}; D1 = (f32x16){}; cur_kind = kind; } \
        const int kb = ti * 32; int lo, hi; \
        if (kind < 2) { lo = 0; hi = hiC; } else if (kind == 2) { lo = 0; hi = ((mk0 >> (ti >> 1)) & 1ull) ? t : -1; } else { lo = t - WINB; hi = t; } \
          \
        const bool interior = (kind < 2) ? (hiCmin >= 0 && kb + 31 <= hiCmin) : ((kind == 2) ? (kb + 31 <= t0w) : (kb >= t0w + 7 - WINB && kb + 31 <= t0w)); \
        float tmax_ = -INFINITY, mu_, mn_; \
        if (interior) { const bool on_ = hi >= 0; \
            _Pragma("unroll") for (int r = 0; r < 16; ++r) tmax_ = fmaxf(tmax_, s_[r]); \
            tmax_ = on_ ? tmax_ : -INFINITY; tmax_ = xhalf_max(tmax_); \
            mn_ = fmaxf(m, tmax_); mu_ = (mn_ == -INFINITY) ? 0.f : mn_; const float mr_ = on_ ? mu_ : INFINITY; \
            _Pragma("unroll") for (int r = 0; r < 16; ++r) s_[r] = fexp2(s_[r] - mr_); \
        } else { \
            _Pragma("unroll") for (int r = 0; r < 16; ++r) { const int key_ = kb + (r & 3) + 8 * (r >> 2) + 4 * h_; s_[r] = (key_ >= lo && key_ <= hi) ? s_[r] : -INFINITY; tmax_ = fmaxf(tmax_, s_[r]); } \
            tmax_ = xhalf_max(tmax_); \
            mn_ = fmaxf(m, tmax_); mu_ = (mn_ == -INFINITY) ? 0.f : mn_; \
            _Pragma("unroll") for (int r = 0; r < 16; ++r) s_[r] = fexp2(s_[r] - mu_); \
        } \
        AP_DUP_EXP() \
        const float al_ = fexp2(m - mu_); float ps_ = 0.f; \
        _Pragma("unroll") for (int r = 0; r < 16; ++r) ps_ += s_[r]; \
        lsum = lsum * al_ + ps_; m = mn_; \
        if (kind >= 2) { if (__ballot(al_ != 1.0f) != 0ull) { D0 *= al_; D1 *= al_; } \
            const bf16x8 pf0_ = cvt_frag(s_, 0), pf1_ = cvt_frag(s_, 1); \
            D0 = mfma32(__builtin_bit_cast(bf16x8, NV[0]), pf0_, D0); D1 = mfma32(__builtin_bit_cast(bf16x8, NV[2]), pf0_, D1); D0 = mfma32(__builtin_bit_cast(bf16x8, NV[1]), pf1_, D0); D1 = mfma32(__builtin_bit_cast(bf16x8, NV[3]), pf1_, D1); \
        } else if (kind == 1) { if (__ballot(al_ != 1.0f) != 0ull) { D0 *= al_; D1 *= al_; } asm volatile("" ::: "memory");   \
            { const bf16x8 va0_ = tr_frag(Vw, AS_RS, 4 * h_, 4 * h_ + 8, 16 * blk, lane), va1_ = tr_frag(Vw, AS_RS, 4 * h_, 4 * h_ + 8, 32 + 16 * blk, lane), \
                           vb0_ = tr_frag(Vw, AS_RS, 16 + 4 * h_, 24 + 4 * h_, 16 * blk, lane), vb1_ = tr_frag(Vw, AS_RS, 16 + 4 * h_, 24 + 4 * h_, 32 + 16 * blk, lane);   \
              const bf16x8 pf0_ = cvt_frag(s_, 0), pf1_ = cvt_frag(s_, 1); \
              D0 = mfma32(va0_, pf0_, D0); D1 = mfma32(va1_, pf0_, D1); D0 = mfma32(vb0_, pf1_, D0); D1 = mfma32(vb1_, pf1_, D1); } \
            AP_DUP_PV() \
            asm volatile("" ::: "memory"); } \
        if (kind == 1) { _Pragma("unroll") for (int r = 0; r < 16; ++r) { const int n2_ = kb + (r & 3) + 8 * (r >> 2) + 4 * h_; float a_ = s_[r] * invC; a_ += __shfl_xor(a_, 1); a_ += __shfl_xor(a_, 2); if (hr == 0) PS[tl * 264 + n2_] = a_; } } \
    } while (0)
#define AP_RUN(N_) do { const int n_ = (N_); unsigned ec0_ = 0u, ec1_ = 0u;                  \
      if (n_ > 0) { ec0_ = (unsigned)__builtin_amdgcn_readfirstlane((int)LIST[0]); AP_LOADK(ec0_, nk0); AP_LOADV(ec0_, nv0); } \
      if (n_ > 1) { ec1_ = (unsigned)__builtin_amdgcn_readfirstlane((int)LIST[1]); } \
      _Pragma("unroll 1") for (int i_ = 0; i_ < n_; i_ += 2) { AP_STEP(i_, n_, nk0, nv0, nv1, ec0_, ec1_); if (i_ + 1 < n_) AP_STEP(i_ + 1, n_, nk0, nv1, nv0, ec1_, ec0_); } } while (0)
    int cur_kind = -1;
    if (lane < 2 * ntc) LIST[lane] = (unsigned short)(((lane >= ntc ? 1u : 0u) << 12) | (unsigned)(lane >= ntc ? lane - ntc : lane));
    LDS_WAIT(); asm volatile("" ::: "memory");
    AP_RUN(2 * ntc);
    { const float sc = (cur_kind == 1) ? g0 * invC : 0.f; D0 *= sc; D1 *= sc; }
    LDS_WAIT(); asm volatile("" ::: "memory");
#pragma unroll 1
    for (int tk = 0; tk < 8; ++tk) {
        const LAS float* pr = PS + tk * 264; const int s = lane; float imp = 0.f;
#pragma unroll
        for (int n = 4 * s - 1; n <= 4 * s + 3; ++n) if (n >= 0) imp += pr[n];
        const bool forced = (s == 0) || (s == qt) || (s == qt - 1), avail = s <= qt;
        const unsigned key = avail ? (forced ? 0x7fffffffu : (imp > 0.f ? __float_as_uint(imp) + 1u : 1u)) : 0u;
        unsigned thr = 0u;
#pragma unroll
        for (int bit = 30; bit >= 0; --bit) { const unsigned cand = thr | (1u << bit); const int cnt = __popcll(__ballot(key >= cand)); thr = (cnt >= 16) ? cand : thr; }
        const unsigned long long gt = __ballot(key > thr), eq = __ballot(key == thr); const int need = 16 - __popcll(gt);
        const int below = __builtin_amdgcn_mbcnt_hi((unsigned)(eq >> 32), __builtin_amdgcn_mbcnt_lo((unsigned)eq, 0u));
        const unsigned long long mk = gt | __ballot(key == thr && below < need);
        if (lane == 0) MASKS[tk] = mk;
        LDS_WAIT(); asm volatile("" ::: "memory");
    }
#pragma unroll
    for (int r = 0; r < 16; ++r) { OAG[r * 64] = D0[r]; OAG[(16 + r) * 64] = D1[r]; }
    mk0 = MASKS[tl]; unsigned long long wu = 0ull;
#pragma unroll
    for (int i = 0; i < 8; ++i) wu |= MASKS[i];
    wu &= (qt >= 63) ? ~0ull : ((1ull << (qt + 1)) - 1ull);
    const int nsel = 2 * __popcll(wu); const int tiLo = (t0w > WINB) ? ((t0w - WINB) >> 5) : 0, tiHi = (t0w + 7) >> 5, nwin = tiHi - tiLo + 1;
    if ((wu >> lane) & 1ull) { const int pos = 2 * __popcll(wu & ((1ull << lane) - 1ull)); LIST[pos] = (unsigned short)((2u << 12) | (unsigned)(2 * lane)); LIST[pos + 1] = (unsigned short)((2u << 12) | (unsigned)(2 * lane + 1)); }
    if (lane < nwin) LIST[nsel + lane] = (unsigned short)((3u << 12) | (unsigned)(tiLo + lane));
    LDS_WAIT(); asm volatile("" ::: "memory");
#ifdef DBG_COUNT
    if (lane == 0) { unsigned* CNT = (unsigned*)(F.ws + WS_CTL) + 3000; atomicAdd(CNT + 0, (unsigned)nsel); atomicAdd(CNT + 1, (unsigned)nwin); atomicAdd(CNT + 2, (unsigned)(2 * ntc)); atomicAdd(CNT + 3, 1u); }
#endif
    cur_kind = -1;
    AP_RUN(nsel + nwin);
    const float ltw = xhalf_sum(lsum); const float scw = (ltw > 0.f ? 1.0f / ltw : 0.f) * g2;
#undef AP_RUN
#undef AP_STEP
#undef AP_LOADT
#undef AP_LOADK
#undef AP_LOADV
    {
        bf16* op = WSP(bf16, WS_OA) + row * 512 + head * 64;
#pragma unroll
        for (int r4 = 0; r4 < 4; ++r4) { float a_[4], b_[4];
#pragma unroll
            for (int x = 0; x < 4; ++x) { a_[x] = OAG[(4 * r4 + x) * 64] + D0[4 * r4 + x] * scw; b_[x] = OAG[(16 + 4 * r4 + x) * 64] + D1[4 * r4 + x] * scw; }
            v2u a, b; a.x = pk2(a_[0], a_[1]); a.y = pk2(a_[2], a_[3]); b.x = pk2(b_[0], b_[1]); b.y = pk2(b_[2], b_[3]);
            *(v2u*)(op + 8 * r4 + 4 * h_) = a; *(v2u*)(op + 32 + 8 * r4 + 4 * h_) = b; }
    }
}
#undef AS_TILE

#ifdef DBG_CHECK
__device__ __forceinline__ unsigned dbg_rand(unsigned x) { x ^= x >> 16; x *= 0x7feb352du; x ^= x >> 15; x *= 0x846ca68bu; x ^= x >> 16; return x; }
__device__ __forceinline__ bool dbg_bad(float got, float exp_, float rtol, float atol) { return !(fabsf(got - exp_) <= rtol * fabsf(exp_) + atol); }
__device__ __forceinline__ float bfr(float x) { return __uint_as_float(pk2(x, 0.f) << 16); }
__device__ __forceinline__ int dbg_row(unsigned r) { const unsigned k = r % 20u; if (k == 0) return (int)(PM + (r >> 8) % SM); if (k == 1) return (int)(((r >> 8) % PB) * PT + ((r >> 12) % 8)); if (k == 2) return (int)(((r >> 8) % PB) * PT + PT - 1 - ((r >> 12) % 8)); return (int)((r >> 5) % PM); }
__device__ __forceinline__ float dbg_rs(const Frame& F, int row, int lane) { const float* xr = xrow_in(F, 0, row); float ss = 0.f; for (int d = lane; d < DM; d += 64) ss += xr[d] * xr[d]; return 1.0f / sqrtf(wave_sum(ss) * (1.0f / DM) + EPS); }
__device__ __forceinline__ float dbg_h(const Frame& F, int row, int d, float rs) { const float* mod = WSP(float, WS_MOD) + (size_t)row_bb(row) * 6144; return bfr(xrow_in(F, 0, row)[d] * rs * FIN(I_N1G)[d] * (1.0f + mod[1024 + d]) + mod[d]); }

__device__ __forceinline__ void dbg_check_phase(Frame& F) {
    const int gw = F.bid * NWAVES + F.wave, NGW = F.G * NWAVES, lane = F.lane;
    unsigned* CNT = (unsigned*)(F.ws + WS_CTL) + 3000;
    LAS float* L = (LAS float*)(F.lds + F.wave * 16384);
#define DBG_FLAG(ch, cond) do { if (__any(cond) && lane == 0) atomicAdd(CNT + (ch), 1u); } while (0)
    for (int s = gw; s < 1536; s += NGW) {
        const unsigned r = dbg_rand(1000u + s); const int row = dbg_row(r); const float rs = dbg_rs(F, row, lane); const int kind = s % 6;
        const bool isp = row < PM; const int b = isp ? (row >> 12) : ((row - PM) >> 3), t = isp ? (row & (PT - 1)) : ((row - PM) & 7);
#define DBG_U(col, dst) do { float a_ = 0.f; for (int d_ = lane; d_ < DM; d_ += 64) a_ += dbg_h(F, row, d_, rs) * bfr(FIN(I_WIN)[(size_t)d_ * D_IN + (col)]); dst = wave_sum(a_); } while (0)
        if (kind == 0) {
            const int c = (r >> 3) % 768, j = c >> 7, k = (c >> 6) & 1, dd = c & 63; float u; DBG_U(O_NKV + c, u); bool bad = false;
            if (j < 4) bad = dbg_bad(F.out[(isp ? OUT_ROWS_P + (size_t)row * 512 : OUT_ROWS_S + (size_t)(row - PM) * 512) + c], u, 0.01f, 0.01f);
            else if (isp) { if (t >= PT - WINB) bad = dbg_bad(F.out[OUT_WIN_P + ((size_t)b * WINB + (t - (PT - WINB))) * 256 + (c - 512)], u, 0.01f, 0.01f); }
            else bad = dbg_bad(F.out[OUT_WIN_S + ((size_t)b * WINB + (WINB - ST) + t) * 256 + (c - 512)], u, 0.01f, 0.01f);
            if (isp) { if (j < 2) bad = bad || dbg_bad(bf1(WSP(bf16, WS_ACMP)[((size_t)j * CMP_ROWS_J + 32768 + (b * 2 + k) * 256 + (t >> 4)) * 1024 + (t & 15) * 64 + dd]), u, 0.01f, 0.01f);
                       else bad = bad || dbg_bad(bf1(WSP(bf16, WS_KVB)[((((size_t)(j - 2) * PB + b) * 2 + k) * PT + t) * 64 + dd]), u, 0.01f, 0.01f); }
            else if (j >= 2) bad = bad || dbg_bad(bf1(WSP(bf16, WS_KVS)[((((size_t)(j - 2) * SB + b) * 2 + k) * ST + t) * 64 + dd]), u, 0.01f, 0.01f);
            DBG_FLAG(0, bad);
        } else if (kind == 1) {
            const int gi = (r >> 3) % 24, c5 = (r >> 8) % 512, cm = (r >> 8) % 3072; float u0, u1, u2, u3; DBG_U(O_NG + gi, u0); DBG_U(O_RX + c5, u1); DBG_U(O_RGATE + c5, u2); DBG_U(O_MG + cm, u3);
            bool bad = dbg_bad(WSP(float, WS_NG)[(size_t)row * 24 + gi], 1.0f / (1.0f + expf(-u0)), 0.01f, 0.005f);
            bad = bad || dbg_bad(WSP(float, WS_RX)[(size_t)row * 512 + c5], u1, 0.01f, 0.01f);
            bad = bad || dbg_bad(bf1(WSP(bf16, WS_GG)[(size_t)row * 512 + c5]), gelu_tanh(u2), 0.02f, 0.01f);
            bad = bad || dbg_bad(bf1(WSP(bf16, WS_MGS)[(size_t)row * 3072 + cm]), 1.0f / (1.0f + expf(-u3)), 0.01f, 0.005f);
            DBG_FLAG(1, bad);
        } else if (kind == 2) {
            const int head = (r >> 13) % 4, dim = (r >> 16) % 64, c5 = (r >> 3) % 512; float x1, x2, uv, ug, uq; DBG_U(O_RQ + head * 128 + dim, x1); DBG_U(O_RQ + head * 128 + 64 + dim, x2); DBG_U(O_RV + c5, uv); DBG_U(O_RG + c5, ug); DBG_U(O_NQ + c5, uq);
            const float pos = (float)(isp ? t : PAST + t); const float ang = pos * (float)pow(10000.0, -(double)dim / 64.0); float sn, cs; sincos_acc(ang, sn, cs);
            const bf16* RQ = WSP(bf16, WS_RQ);
            bool bad = dbg_bad(bf1(RQ[(size_t)row * 512 + head * 128 + dim]), x1 * cs - x2 * sn, 0.02f, 0.02f) || dbg_bad(bf1(RQ[(size_t)row * 512 + head * 128 + 64 + dim]), x1 * sn + x2 * cs, 0.02f, 0.02f);
            bad = bad || dbg_bad(bf1(RQ[(size_t)2 * MT * 512 + (size_t)row * 512 + c5]), uv, 0.01f, 0.01f) || dbg_bad(bf1(RQ[(size_t)3 * MT * 512 + (size_t)row * 512 + c5]), ug, 0.01f, 0.01f);
            bad = bad || dbg_bad(bf1(WSP(bf16, WS_QN)[(size_t)row * 512 + c5]), uq * QSCALE, 0.01f, 0.005f);
            DBG_FLAG(2, bad);
        }
#undef DBG_U
    }
    for (int s = gw; s < 128; s += NGW) {
        const unsigned r = dbg_rand(3000u + s); const int j = r & 1; const bool smp = ((r >> 1) & 3) != 0;
        const int grp = smp ? (int)((r >> 3) % 64) : (int)((r >> 3) % 8), nmax = smp ? 511 : 255; int n = (r >> 10) % nmax; if (((r >> 20) & 7) == 0) n = nmax - 1;
        const size_t rj = smp ? (size_t)grp * 512 + n : (size_t)32768 + grp * 256 + n;
        const bf16* A = WSP(bf16, WS_ACMP) + ((size_t)j * CMP_ROWS_J + rj) * 1024;
        const float* w1 = FIN(I_W1) + (size_t)j * 2048 * 128; const float* pe = FIN(I_PE) + j * 2048;
        for (int hh = 0; hh < 2; ++hh) { const int h = lane + 64 * hh; float a = FIN(I_B1)[j * 128 + h];
            for (int i = 0; i < 1024; ++i) a += (bf1(A[i]) + pe[i]) * w1[(size_t)i * 128 + h] + (bf1(A[1024 + i]) + pe[1024 + i]) * w1[(size_t)(1024 + i) * 128 + h];
            L[h] = gelu_tanh(a); }
        LDS_WAIT(); asm volatile("" ::: "memory");
        float o = 0.f; for (int h = 0; h < 128; ++h) o += L[h] * FIN(I_W2)[((size_t)j * 128 + h) * 64 + lane];
        const float got = bf1(WSP(bf16, WS_CK)[((size_t)j * CMP_ROWS_J + rj) * 64 + lane]);
        { const bool bd = dbg_bad(got, o, 0.05f, 0.03f); const unsigned long long mk = __ballot(bd); if (lane == 0 && mk) atomicAdd(CNT + 3, (unsigned)__popcll(mk)); }
        LDS_WAIT(); asm volatile("" ::: "memory");
    }
    for (int s = gw; s < 128; s += NGW) {
        const unsigned r = dbg_rand(3500u + s); const int j = r & 1; const bool smp = ((r >> 1) & 3) != 0;
        const int grp = smp ? (int)((r >> 3) % 64) : (int)((r >> 3) % 8), nmax = smp ? 511 : 255; const int n = (r >> 10) % nmax;
        const size_t rj = smp ? (size_t)grp * 512 + n : (size_t)32768 + grp * 256 + n, row = (size_t)j * CMP_ROWS_J + rj;
        const bf16* A = WSP(bf16, WS_ACMP) + row * 1024; const float* w1 = FIN(I_W1) + (size_t)j * 2048 * 128; const bf16* LH = WSP(bf16, WS_LH);
        unsigned nb = 0;
        for (int hh = 0; hh < 2; ++hh) { const int h = lane + 64 * hh; float lo = 0.f, hi = 0.f;
            for (int i = 0; i < 1024; ++i) { const float av = bf1(A[i]); lo += av * bfr(w1[(size_t)i * 128 + h]); hi += av * bfr(w1[(size_t)(1024 + i) * 128 + h]); }
            const bool bd = dbg_bad(bf1(LH[row * 256 + h]), lo, 0.02f, 0.02f) || dbg_bad(bf1(LH[row * 256 + 128 + h]), hi, 0.02f, 0.02f); nb += (unsigned)__popcll(__ballot(bd)); }
        if (lane == 0 && nb) atomicAdd(CNT + 9, nb);
        for (int hh = 0; hh < 2; ++hh) { const int h = lane + 64 * hh; L[h] = gelu_tanh(bf1(LH[row * 256 + h]) + bf1(LH[(row + 1) * 256 + 128 + h]) + WSP(float, WS_SMALLW + SW_CB)[j * 128 + h]); }
        LDS_WAIT(); asm volatile("" ::: "memory");
        float o = 0.f; for (int h = 0; h < 128; ++h) o += bfr(L[h]) * bfr(FIN(I_W2)[((size_t)j * 128 + h) * 64 + lane]);
        { const bool bd = dbg_bad(bf1(WSP(bf16, WS_CK)[row * 64 + lane]), o, 0.03f, 0.01f); const unsigned long long mk = __ballot(bd); if (lane == 0 && mk) atomicAdd(CNT + 11, (unsigned)__popcll(mk)); }
        LDS_WAIT(); asm volatile("" ::: "memory");
    }
    for (int s = gw; s < 64; s += NGW) {
        const unsigned r = dbg_rand(3700u + s); const int j = r & 1, half = (r >> 1) & 1, h = (r >> 2) % 128; const bf16* W1T = WSP(bf16, WS_SMALLW + SW_W1T) + ((size_t)j * 256 + half * 128 + h) * 1024;
        const float* w1 = FIN(I_W1) + ((size_t)j * 32 + half * 16) * 64 * 128 + h; unsigned nb = 0;
        for (int k = lane; k < 1024; k += 64) nb += (unsigned)__popcll(__ballot(dbg_bad(bf1(W1T[k]), w1[(size_t)k * 128], 0.01f, 0.0001f)));
        if (lane == 0 && nb) atomicAdd(CNT + 12, nb);
        const bool smp = ((r >> 9) & 3) != 0; const int grp = smp ? (int)((r >> 11) % 64) : (int)((r >> 11) % 8), n = (r >> 17) % (smp ? 511 : 255);
        const size_t row = (size_t)j * CMP_ROWS_J + (smp ? (size_t)grp * 512 + n : (size_t)32768 + grp * 256 + n); const bf16* A = WSP(bf16, WS_ACMP) + row * 1024;
        float a = 0.f; for (int k = lane; k < 1024; k += 64) a += bf1(A[k]) * bf1(W1T[k]); a = wave_sum(a);
        DBG_FLAG(13, dbg_bad(bf1(WSP(bf16, WS_LH)[row * 256 + half * 128 + h]), a, 0.02f, 0.02f));
    }
    for (int s = gw; s < 4; s += NGW) {
        const int j = s >> 1, h = (s & 1) * 64 + lane; const float* w1 = FIN(I_W1) + (size_t)j * 2048 * 128; const float* pe = FIN(I_PE) + j * 2048;
        float a = FIN(I_B1)[j * 128 + h]; for (int i = 0; i < 2048; ++i) a += pe[i] * w1[(size_t)i * 128 + h];
        const unsigned long long mk = __ballot(dbg_bad(WSP(float, WS_SMALLW + SW_CB)[j * 128 + h], a, 0.001f, 0.0005f)); if (lane == 0 && mk) atomicAdd(CNT + 10, (unsigned)__popcll(mk));
    }
    for (int s = gw; s < 96; s += NGW) {
        const unsigned r = dbg_rand(4000u + s); const bool smp = (s % 3) == 2;
        int seq, kvh = (r >> 4) & 1, t, tl = 0; size_t row;
        if (smp) { seq = (r >> 5) % SB; tl = (r >> 10) % ST; t = PAST + tl; row = (size_t)PM + seq * ST + tl; }
        else { seq = (r >> 5) % PB; const unsigned k = (r >> 8) % 8u; t = (k == 0) ? (int)((r >> 12) % 40) : (k == 1) ? PT - 1 - (int)((r >> 12) % 70) : (int)((r >> 12) % PT); row = (size_t)seq * PT + t; }
        const int N = smp ? 511 : 255, NS = smp ? 129 : 64, cur = t >> 6;
        LAS float* Q = L; LAS float* SC = L + 256; LAS float* PSUM = L + 256 + 2048; LAS float* OUT = L + 256 + 2048 + 512;
        for (int i = lane; i < 256; i += 64) Q[i] = bf1(WSP(bf16, WS_QN)[row * 512 + (kvh * 4 + (i >> 6)) * 64 + (i & 63)]);
        for (int i = lane; i < 768; i += 64) OUT[i] = 0.f;
        LDS_WAIT(); asm volatile("" ::: "memory");
        const bf16* CKk = WSP(bf16, WS_CK) + (smp ? (size_t)(seq * 2 + kvh) * 512 : (size_t)32768 + (seq * 2 + kvh) * 256) * 64; const bf16* CKv = CKk + (size_t)CMP_ROWS_J * 64;
        const int nvis = smp ? 511 : ((t >= 31) ? ((t - 31) >> 4) + 1 : 0);
        for (int i = lane; i < 512; i += 64) PSUM[i] = 0.f;
        for (int hr = 0; hr < 4; ++hr) {
            float mx = -INFINITY; for (int n = lane; n < nvis; n += 64) { float a = 0.f; for (int d = 0; d < 64; ++d) a += Q[hr * 64 + d] * bf1(CKk[(size_t)n * 64 + d]); SC[n] = a; mx = fmaxf(mx, a); }
            for (int o = 1; o < 64; o <<= 1) mx = fmaxf(mx, __shfl_xor(mx, o));
            float den = 0.f; for (int n = lane; n < nvis; n += 64) { const float e = exp2f(SC[n] - mx); SC[n] = e; den += e; } den = wave_sum(den);
            LDS_WAIT(); asm volatile("" ::: "memory");
            if (nvis > 0) { float o = 0.f; for (int n = 0; n < nvis; ++n) o += SC[n] * bf1(CKv[(size_t)n * 64 + lane]); OUT[hr * 64 + lane] = o / den;
                for (int n = lane; n < nvis; n += 64) PSUM[n] += SC[n] / den; }
            LDS_WAIT(); asm volatile("" ::: "memory");
        }
        LAS float* IMP = SC; LAS float* SELB = SC + 256;
        for (int sblk = lane; sblk < NS; sblk += 64) { float imp = 0.f; for (int n = 4 * sblk - 1; n <= 4 * sblk + 3; ++n) if (n >= 0 && n < N) imp += PSUM[n];
            const bool forced = sblk == 0 || sblk == cur || sblk == cur - 1, avail = sblk * 64 <= t; IMP[sblk] = avail ? (forced ? 1e4f : imp) : -1e4f; SELB[sblk] = 0.f; }
        LDS_WAIT(); asm volatile("" ::: "memory");
        for (int pick = 0; pick < 16 && pick < NS; ++pick) { float bv = -INFINITY; int bi = 1 << 30;
            for (int sblk = lane; sblk < NS; sblk += 64) { const float v = (SELB[sblk] != 0.f) ? -INFINITY : IMP[sblk]; if (v > bv || (v == bv && sblk < bi)) { bv = v; bi = sblk; } }
            for (int o = 1; o < 64; o <<= 1) { const float ov = __shfl_xor(bv, o); const int oi = __shfl_xor(bi, o); if (ov > bv || (ov == bv && oi < bi)) { bv = ov; bi = oi; } }
            if (lane == 0) SELB[bi] = 1.f; LDS_WAIT(); asm volatile("" ::: "memory"); }
        for (int br = 1; br < 3; ++br) for (int hr = 0; hr < 4; ++hr) {
            float mx = -INFINITY, den = 0.f, o = 0.f;
            const int plo = (br == 1) ? 0 : (t - WINB < 0 ? 0 : t - WINB), phi = t;
            for (int p = plo; p <= phi; ++p) {
                if (br == 1 && SELB[p >> 6] == 0.f) { p |= 63; continue; }
                const float* kf = nullptr; const bf16* kb = nullptr; const float* vf = nullptr; const bf16* vb = nullptr;
                const int jk = (br == 1) ? 2 : 4;
                if (!smp) { kb = WSP(bf16, WS_KVB) + ((((size_t)(jk - 2) * PB + seq) * 2 + kvh) * PT + p) * 64; vb = kb + (size_t)PB * 2 * PT * 64; }
                else if (p >= PAST) { kb = WSP(bf16, WS_KVS) + ((((size_t)(jk - 2) * SB + seq) * 2 + kvh) * ST + (p - PAST)) * 64; vb = kb + (size_t)SB * 2 * ST * 64; }
                else if (br == 1) { const int page = ((const int*)F.a->in[I_PT])[seq * NPG + (p >> 7)]; kf = FIN(I_CACHE) + ((((size_t)page * PAGE + (p & 127)) * 4 + 2) * 2 + kvh) * 64; vf = kf + 128; }
                else { kf = FIN(I_CWIN) + ((((size_t)seq * WINB + (p - (PAST - WINB))) * 2 + 0) * 2 + kvh) * 64; vf = kf + 128; }
                float a = 0.f; for (int d = 0; d < 64; ++d) a += Q[hr * 64 + d] * (kb ? bf1(kb[d]) : bfr(kf[d]));
                const float vv = vb ? bf1(vb[lane]) : bfr(vf[lane]);
                const float mn = fmaxf(mx, a), al = exp2f(mx - mn), e = exp2f(a - mn); den = den * al + e; o = o * al + e * vv; mx = mn;
            }
            OUT[(br * 4 + hr) * 64 + lane] = (den > 0.f) ? o / den : 0.f;
        }
        LDS_WAIT(); asm volatile("" ::: "memory");
        bool bad = false;
        for (int hr = 0; hr < 4; ++hr) { const float* ng = WSP(float, WS_NG) + row * 24 + (kvh * 4 + hr) * 3;
            const float e = ng[0] * OUT[(0 * 4 + hr) * 64 + lane] + ng[1] * OUT[(1 * 4 + hr) * 64 + lane] + ng[2] * OUT[(2 * 4 + hr) * 64 + lane];
            bad = bad || dbg_bad(bf1(WSP(bf16, WS_OA)[row * 512 + (kvh * 4 + hr) * 64 + lane]), e, 0.04f, 0.004f); }
        DBG_FLAG(smp ? 5 : 4, bad);
        LDS_WAIT(); asm volatile("" ::: "memory");
    }
    for (int s = gw; s < 96; s += NGW) {
        const unsigned r = dbg_rand(6000u + s); const bool smp = (s % 3) == 2; const int h = (r >> 3) & 3; const float lg = ret_log_g(h);
        const bf16* RQ = WSP(bf16, WS_RQ); const bf16* RK = RQ + (size_t)MT * 512; const bf16* RV = RQ + (size_t)2 * MT * 512; const bf16* RG = RQ + (size_t)3 * MT * 512;
        int seq, t; size_t row0; if (smp) { seq = (r >> 5) % SB; t = (r >> 10) % ST; row0 = (size_t)PM + seq * ST; } else { seq = (r >> 5) % PB; const unsigned k = (r >> 8) % 4u; t = (k == 0) ? (int)((r >> 12) % 300) : (int)((r >> 12) % PT); row0 = (size_t)seq * PT; }
        float o0 = 0.f, o1 = 0.f;
        for (int d = lane; d < 128; d += 64) L[d] = bf1(RQ[(row0 + t) * 512 + h * 128 + d]);
        LDS_WAIT(); asm volatile("" ::: "memory");
        for (int j = 0; j <= t; ++j) { float a = 0.f; for (int d = 0; d < 128; ++d) a += L[d] * bf1(RK[(row0 + j) * 512 + h * 128 + d]);
            a *= expf((float)(t - j) * lg); o0 += a * bf1(RV[(row0 + j) * 512 + h * 128 + lane]); o1 += a * bf1(RV[(row0 + j) * 512 + h * 128 + 64 + lane]); }
        if (smp) { const float* S0 = FIN(I_SRET) + (((size_t)0 * SB + seq) * 4 + h) * 16384; const float cr = expf((float)(t + 1) * lg);
            for (int d = 0; d < 128; ++d) { o0 += L[d] * S0[d * 128 + lane] * cr; o1 += L[d] * S0[d * 128 + 64 + lane] * cr; } }
        const float mean = wave_sum(o0 + o1) * (1.0f / 128.0f); const float var = wave_sum((o0 - mean) * (o0 - mean) + (o1 - mean) * (o1 - mean)) * (1.0f / 128.0f), rstd = 1.0f / sqrtf(var + EPS);
        const float* GN = FIN(I_GNG) + h * 128; const bf16* OR_ = WSP(bf16, WS_OA) + (size_t)MT * 512;
        const float g0 = bf1(RG[(row0 + t) * 512 + h * 128 + lane]), g1 = bf1(RG[(row0 + t) * 512 + h * 128 + 64 + lane]);
        const float e0 = (o0 - mean) * rstd * GN[lane] * (g0 / (1.0f + expf(-g0))), e1 = (o1 - mean) * rstd * GN[64 + lane] * (g1 / (1.0f + expf(-g1)));
        DBG_FLAG(6, dbg_bad(bf1(OR_[(row0 + t) * 512 + h * 128 + lane]), e0, 0.04f, 0.02f) || dbg_bad(bf1(OR_[(row0 + t) * 512 + h * 128 + 64 + lane]), e1, 0.04f, 0.02f));
        const int d = (r >> 20) % 128, T = smp ? ST : PT; float s0 = 0.f, s1 = 0.f;
        for (int j = 0; j < T; ++j) { const float kk = bf1(RK[(row0 + j) * 512 + h * 128 + d]) * expf((float)(T - 1 - j) * lg); s0 += kk * bf1(RV[(row0 + j) * 512 + h * 128 + lane]); s1 += kk * bf1(RV[(row0 + j) * 512 + h * 128 + 64 + lane]); }
        const float* SO;
        if (smp) { const float* S0 = FIN(I_SRET) + (((size_t)0 * SB + seq) * 4 + h) * 16384; const float g8 = expf(8.0f * lg); s0 += g8 * S0[d * 128 + lane]; s1 += g8 * S0[d * 128 + 64 + lane]; SO = F.out + OUT_RET_S + (((size_t)0 * SB + seq) * 4 + h) * 16384; }
        else SO = F.out + OUT_RET_P + (((size_t)0 * PB + seq) * 4 + h) * 16384;
        DBG_FLAG(7, dbg_bad(SO[d * 128 + lane], s0, 0.02f, 0.02f) || dbg_bad(SO[d * 128 + 64 + lane], s1, 0.02f, 0.02f));
        LDS_WAIT(); asm volatile("" ::: "memory");
    }
    for (int s = gw; s < 48; s += NGW) {
        const unsigned r = dbg_rand(8000u + s); const bool smp = (s % 3) == 2; const int blk = (r >> 3) & 7, c = blk * 64 + lane;
        int seq, T; size_t row0; if (smp) { seq = (r >> 6) % SB; T = ST; row0 = (size_t)PM + seq * ST; } else { seq = (r >> 6) % PB; T = 1 + (int)((r >> 10) % ((s & 1) ? 200 : PT)); row0 = (size_t)seq * PT; }
        const float* RX = WSP(float, WS_RX); const float* cw = FIN(I_RCW); const float cb = FIN(I_RCB)[c];
        float x3 = 0.f, x2 = 0.f, x1 = 0.f, h = 0.f;
        if (smp) { const float* cv = FIN(I_SCONV) + (size_t)seq * 3 * 512; x3 = cv[c]; x2 = cv[512 + c]; x1 = cv[1024 + c]; h = FIN(I_SH)[(size_t)seq * 512 + c]; }
        const float sp = log1pf(expf(-FIN(I_LAM)[c])); const float* wa = FIN(I_RWA) + (size_t)blk * 4096; const float* wx = FIN(I_RWX) + (size_t)blk * 4096;
        for (int t = 0; t < T; ++t) { const float x0 = RX[(row0 + t) * 512 + c]; const float xc = cb + cw[c] * x3 + cw[512 + c] * x2 + cw[1024 + c] * x1 + cw[1536 + c] * x0; x3 = x2; x2 = x1; x1 = x0;
            L[lane] = xc; LDS_WAIT(); asm volatile("" ::: "memory");
            float ra = FIN(I_RBA)[c], ri = FIN(I_RBX)[c]; for (int i = 0; i < 64; ++i) { ra += L[i] * wa[i * 64 + lane]; ri += L[i] * wx[i * 64 + lane]; }
            LDS_WAIT(); asm volatile("" ::: "memory");
            const float rr = 1.0f / (1.0f + expf(-ra)), ii = 1.0f / (1.0f + expf(-ri)), la = -8.0f * rr * sp, a = expf(la); h = a * h + sqrtf(-expm1f(2.0f * la)) * (ii * xc); }
        const size_t o = (row0 + T - 1) * 512 + c; const float e = h * bf1(WSP(bf16, WS_GG)[o]);
        DBG_FLAG(8, dbg_bad(bf1((WSP(bf16, WS_OA) + (size_t)2 * MT * 512)[o]), e, 0.04f, 0.01f));
    }
    for (int s = gw; s < 512; s += NGW) {
        const unsigned r = dbg_rand(9000u + s); const int row = dbg_row(r), col = (r >> 7) % DM;
        float e = 0.f;
        for (int br = 0; br < 3; ++br) { const bf16* O = WSP(bf16, WS_OA) + (size_t)br * MT * 512 + (size_t)row * 512; const float* W = FIN(br == 0 ? I_WBRA : (br == 1 ? I_WBRB : I_WBRC));
            float a = 0.f; for (int k = lane; k < 512; k += 64) a += bf1(O[k]) * bfr(W[(size_t)k * DM + col]); a = wave_sum(a); e += bf1(WSP(bf16, WS_MGS)[(size_t)row * 3072 + br * 1024 + col]) * a; }
        DBG_FLAG(20, dbg_bad(bf1(WSP(bf16, WS_MRG)[(size_t)row * DM + col]), e, 0.03f, 0.01f));
        const float* mod = WSP(float, WS_MOD) + (size_t)row_bb(row) * 6144;
        { float a = 0.f; for (int k = lane; k < DM; k += 64) a += bf1(WSP(bf16, WS_MRG)[(size_t)row * DM + k]) * bfr(FIN(I_WOUT)[(size_t)k * DM + col]); a = wave_sum(a);
          const float ex = xrow_in(F, 0, row)[col] + mod[2048 + col] * a; DBG_FLAG(21, dbg_bad(WSP(float, WS_X1)[(size_t)row * DM + col], ex, 0.005f, 0.005f)); }
        { const float* xr = WSP(float, WS_X1) + (size_t)row * DM; float ss = 0.f; for (int d = lane; d < DM; d += 64) ss += xr[d] * xr[d]; const float rs = 1.0f / sqrtf(wave_sum(ss) * (1.0f / DM) + EPS);
          const int c2 = (r >> 9) % NUP; float a = 0.f; for (int d = lane; d < DM; d += 64) a += bfr(xr[d] * rs * FIN(I_N2G)[d] * (1.0f + mod[4096 + d]) + mod[3072 + d]) * bfr(FIN(I_WUP)[(size_t)d * NUP + c2]); a = wave_sum(a);
          const float got = c2 < DFF ? bf1(WSP(bf16, WS_GP)[(size_t)row * DFF + c2]) : bf1((WSP(bf16, WS_GP) + (size_t)MT * DFF)[(size_t)row * DFF + c2 - DFF]); DBG_FLAG(22, dbg_bad(got, a, 0.02f, 0.01f)); }
        { const int c3 = (r >> 11) % DFF; const bf16* GP = WSP(bf16, WS_GP); const bf16* VAL = GP + (size_t)MT * DFF; const float* cw = FIN(I_FCW);
          const bool isp = row < PM; const int t = isp ? (row & (PT - 1)) : ((row - PM) & 7); float xm2, xm1;
          if (t >= 2) { xm2 = bf1(GP[(size_t)(row - 2) * DFF + c3]); xm1 = bf1(GP[(size_t)(row - 1) * DFF + c3]); }
          else if (isp) { xm2 = 0.f; xm1 = (t == 1) ? bf1(GP[(size_t)(row - 1) * DFF + c3]) : 0.f; }
          else { const float* st = FIN(I_SFFN) + ((size_t)((row - PM) >> 3) * 2) * DFF + c3; xm2 = (t == 0) ? st[0] : st[DFF]; xm1 = (t == 0) ? st[DFF] : bf1(GP[(size_t)(row - 1) * DFF + c3]); }
          const float y = FIN(I_FCB)[c3] + cw[c3] * xm2 + cw[DFF + c3] * xm1 + cw[2 * DFF + c3] * bf1(GP[(size_t)row * DFF + c3]); const float ex = (y / (1.0f + expf(-y))) * bf1(VAL[(size_t)row * DFF + c3]);
          DBG_FLAG(23, dbg_bad(bf1((GP + (size_t)2 * MT * DFF)[(size_t)row * DFF + c3]), ex, 0.02f, 0.005f)); }
        { const bf16* ACT = WSP(bf16, WS_GP) + (size_t)2 * MT * DFF + (size_t)row * DFF; float a = 0.f; for (int k = lane; k < DFF; k += 64) a += bf1(ACT[k]) * bfr(FIN(I_WDN)[(size_t)k * DM + col]); a = wave_sum(a);
          const float ex = WSP(float, WS_X1)[(size_t)row * DM + col] + mod[5120 + col] * a; DBG_FLAG(24, dbg_bad(WSP(float, WS_X2)[(size_t)row * DM + col], ex, 0.005f, 0.005f)); }
    }
#undef DBG_FLAG
}
__device__ __forceinline__ void dbg_report_phase(Frame& F) {
    const unsigned* CNT = (const unsigned*)(F.ws + WS_CTL) + 3000;
    const size_t ooff[14] = {OUT_Y, OUT_Y + (size_t)PM * DM, OUT_ROWS_P, OUT_ROWS_S, OUT_WIN_P, OUT_WIN_S, OUT_RET_P, OUT_RET_S, OUT_H_P, OUT_H_S, OUT_CV_P, OUT_CV_S, OUT_FC_P, OUT_FC_S};
    if (F.bid == 0 && F.tid < 14) { const int b = F.tid; const unsigned c = CNT[b]; const int cnt = 1 + (int)(c > 1000u ? 1000u : c);
        for (int i = 0; i < cnt; ++i) ((unsigned*)F.out)[ooff[b] + 7 + 2 * i] = 0xAAAAAAAAu; }
}
#endif

#ifndef DBG_SUB
#define DBG_SUB 0xFFFF
#endif
#ifndef DBG_MAXPH
#define DBG_MAXPH N_PHASES
#endif
#ifndef DBG_REPEAT
#define DBG_REPEAT 0
#endif
#ifndef DBG_MASK
#define DBG_MASK 0xFFFF
#endif
#define IN(k) (lo <= (k) && (k) < hi)
#ifdef DBG_TIME
#define SEAM(k) do { if ((k) + 1 < hi) { if (MK_N_LAUNCHES == 1) xcd_barrier(bar); } if (F.bid == 0 && F.tid == 0) ((unsigned long long*)(F.ws + WS_CTL))[2048 + (k) + 1] = __builtin_amdgcn_s_memrealtime(); } while (0)
#else
#define SEAM(k) do { if ((k) + 1 < hi) { if (MK_N_LAUNCHES == 1) xcd_barrier(bar); } } while (0)
#endif
template <int l> __device__ __forceinline__ void ph_win(Frame& F) { unsigned char* ws = F.ws;
    pg8::Gemm g{(const pg8::bf16_t*)(ws + WS_H), (const pg8::bf16_t*)(ws + WS_WIN) + (size_t)l * NIN * DM, MT, NIN, DM};
    pg8::StaticOrder S; S.init(MT, NIN, F.G, F.bid); EpiWin E{ws, F.out, l};
    pg8::gemm_phase<EpiWin, pg8::StaticOrder, true, true>(F.lds, g, S, E); }
template <int l> __device__ __forceinline__ void ph_mix1(Frame& F) {
    for (int x = F.bid; x < 512; x += F.G) { launder(F); cmp_gemm_unit<true>(F, l, x >> 8, (x & 255) >> 2, (x & 3) * 128); }
    {
        unsigned* ctr = (unsigned*)(F.ws + WS_CTL) + 3210 + l; volatile LAS int* QI = (volatile LAS int*)(F.lds + MISC_OFF + 128);
#pragma unroll 1
        for (;;) {
            __syncthreads();
            if (F.tid == 0) QI[0] = (int)__hip_atomic_fetch_add(ctr, 1u, __ATOMIC_RELAXED, __HIP_MEMORY_SCOPE_AGENT);
            __syncthreads();
            const int u = __builtin_amdgcn_readfirstlane(QI[0]);
            if (u >= 32 + 768) break;
            launder(F);
            if (u < 32) cmp_gemm_unit<false>(F, l, u >> 4, (u >> 1) & 7, (u & 1) * 128); else if (u < 32 + 256) rglru_unit<0>(F, l, u - 32); else ret_local_unit(F, u - 32 - 256);
        }
        __syncthreads();
    } }
template <int l> __device__ __forceinline__ void ph_mix2(Frame& F) { cmp2_phase(F, l); ret_scan_phase(F, l); rglru_carry_phase(F, l); }
#ifndef DBG_REPQ
#define DBG_REPQ 0
#endif
constexpr int MQ_SA = 64, MQ_PA = MQ_SA + 512, MQ_RG1 = MQ_PA + 256, MQ_RO = MQ_RG1 + 512, MQ_RS = MQ_RO + 128, MQ_RG2 = MQ_RS + 32;
template <int l> __device__ __forceinline__ void ph_mix3(Frame& F) {
    unsigned* ctr = (unsigned*)(F.ws + WS_CTL) + 3200 + l;
    volatile LAS int* QI = (volatile LAS int*)(F.lds + MISC_OFF + 128);
#pragma unroll 1
    for (;;) {
        __syncthreads();
        if (F.tid == 0) QI[0] = (int)__hip_atomic_fetch_add(ctr, 1u, __ATOMIC_RELAXED, __HIP_MEMORY_SCOPE_AGENT);
        __syncthreads();
        const int u = __builtin_amdgcn_readfirstlane(QI[0]);
        if (u >= MQ_RG2) break;
        launder(F);
        if (u < MQ_SA) { attn_sample_unit(F, l, u); if (DBG_REPQ & 2) { launder(F); attn_sample_unit(F, l, u); } }
        else if (u < MQ_PA) { const int v = u - MQ_SA; attn_prompt_unit(F, l, (v & 7) * 64 + 63 - (v >> 3)); if (DBG_REPQ & 1) { launder(F); attn_prompt_unit(F, l, (v & 7) * 64 + 63 - (v >> 3)); } }
        else if (u < MQ_RG1) { rglru_unit<1>(F, l, u - MQ_PA); }
        else if (u < MQ_RO) { ret_out_unit(F, l, u - MQ_RG1); }
        else if (u < MQ_RS) { ret_sample_unit(F, l, u - MQ_RO); }
        else { rglru_unit<2>(F, l, u - MQ_RS); }
    }
    __syncthreads(); }
__device__ __forceinline__ f32x16 smp_tile_acc(Frame& F, const bf16* A, const bf16* Wt, int K, int tile) {
    const int q = F.lane & 31, h_ = F.lane >> 5, ks8 = K / 8, kb = F.wave * ks8;
    const bf16* ap = A + (size_t)((tile >> 5) * 32 + q) * K + kb + 8 * h_; const bf16* bp = Wt + (size_t)((tile & 31) * 32 + q) * K + kb + 8 * h_; f32x16 acc = (f32x16){};
#pragma unroll 11
    for (int kk = 0; kk < ks8 / 16; ++kk) acc = mfma32(*(const bf16x8*)(ap + 16 * kk), *(const bf16x8*)(bp + 16 * kk), acc);
    return acc;
}
__device__ __forceinline__ void smp_tile_put(Frame& F, const f32x16& acc, int slot) { LAS float* R = (LAS float*)(F.lds + slot * 32768) + F.wave * 1024 + F.lane;
#pragma unroll
    for (int r = 0; r < 16; ++r) R[r * 64] = acc[r]; }
__device__ __forceinline__ float smp_tile_get(Frame& F, int slot, int o) { const LAS float* R = (const LAS float*)(F.lds + slot * 32768) + o; float s = 0.f;
#pragma unroll
    for (int w = 0; w < 8; ++w) s += R[w * 1024];
    return s; }
template <int l> __device__ __forceinline__ void ph_br(Frame& F) { unsigned char* ws = F.ws;
    const pg8::bf16_t* wbr = (const pg8::bf16_t*)(ws + WS_WBR) + (size_t)l * 3 * 1024 * 512;
    for (int tile = F.bid; tile < 256; tile += F.G) {
        const f32x16 a0 = smp_tile_acc(F, (const bf16*)(ws + WS_OA) + (size_t)PM * 512, wbr, 512, tile), a1 = smp_tile_acc(F, (const bf16*)(ws + WS_OA) + (size_t)(MT + PM) * 512, wbr + (size_t)1024 * 512, 512, tile),
                     a2 = smp_tile_acc(F, (const bf16*)(ws + WS_OA) + (size_t)(2 * MT + PM) * 512, wbr + (size_t)2 * 1024 * 512, 512, tile);
        __syncthreads(); smp_tile_put(F, a0, 0); smp_tile_put(F, a1, 1); smp_tile_put(F, a2, 2); __syncthreads();
        const bf16* MG = (const bf16*)(ws + WS_MGS); bf16* MR = (bf16*)(ws + WS_MRG);
#pragma unroll
        for (int e = 0; e < 2; ++e) { const int o = F.tid * 2 + e, r = o >> 6, ln = o & 63; const size_t row = (size_t)PM + (tile >> 5) * 32 + (r & 3) + 8 * (r >> 2) + 4 * (ln >> 5); const int col = (tile & 31) * 32 + (ln & 31);
            const bf16* g = MG + row * 3072 + col; MR[row * DM + col] = (bf16)(pk2(bf1(g[0]) * smp_tile_get(F, 0, o) + bf1(g[1024]) * smp_tile_get(F, 1, o) + bf1(g[2048]) * smp_tile_get(F, 2, o), 0.f) & 0xffffu); }
    }
    __syncthreads();
    BrOrder S; S.S.init(PM, DM, F.G, F.bid);
    pg8::Gemm g{(const pg8::bf16_t*)(ws + WS_OA), wbr, 3 * MT, 3 * DM, 512}; EpiBrAll E{ws};
    pg8::gemm_phase<EpiBrAll, BrOrder, true, true>(F.lds, g, S, E); }
template <bool INF32> __device__ __forceinline__ void smp_res(Frame& F, const bf16* A, const bf16* Wt, int K, const void* xin  , bf16* xout  , const float* mod, int gofs) {
    for (int tile = F.bid; tile < 256; tile += F.G) {
        const f32x16 a = smp_tile_acc(F, A, Wt, K, tile);
        __syncthreads(); smp_tile_put(F, a, 0); __syncthreads();
#pragma unroll
        for (int e = 0; e < 2; ++e) { const int o = F.tid * 2 + e, r = o >> 6, ln = o & 63; const int rr = (tile >> 5) * 32 + (r & 3) + 8 * (r >> 2) + 4 * (ln >> 5), col = (tile & 31) * 32 + (ln & 31);
            const float xi = INF32 ? ((const float*)xin)[(size_t)rr * DM + col] : bf1(((const bf16*)xin)[(size_t)rr * DM + col]);
            xout[(size_t)rr * DM + col] = (bf16)(pk2(xi + mod[(size_t)(4 + (rr >> 3)) * 6144 + gofs + col] * smp_tile_get(F, 0, o), 0.f) & 0xffffu); }
    }
    __syncthreads();
}
template <int l> __device__ __forceinline__ void ph_out(Frame& F) { unsigned char* ws = F.ws;
    const float* mod = (const float*)(ws + WS_MOD) + (size_t)l * 36 * 6144;
    smp_res<l == 0>(F, (const bf16*)(ws + WS_MRG) + (size_t)PM * DM, (const bf16*)(ws + WS_WOUT) + (size_t)l * DM * DM, DM, l == 0 ? (const void*)FIN(I_XS) : (const void*)((const bf16*)(ws + WS_X2) + (size_t)PM * DM), (bf16*)(ws + WS_X1) + (size_t)PM * DM, mod, 2048);
    pg8::Gemm g{(const pg8::bf16_t*)(ws + WS_MRG), (const pg8::bf16_t*)(ws + WS_WOUT) + (size_t)l * DM * DM, PM, DM, DM};
    pg8::StaticOrder S; S.init(PM, DM, F.G, F.bid);
    EpiRes<l == 0> E{l == 0 ? (const void*)FIN(I_XP) : (const void*)(ws + WS_X2), (bf16*)(ws + WS_X1), mod, 2048};
    pg8::gemm_phase<EpiRes<l == 0>, pg8::StaticOrder, true, true>(F.lds, g, S, E); }
template <int l> __device__ __forceinline__ void ph_down(Frame& F) { unsigned char* ws = F.ws;
    const float* mod = (const float*)(ws + WS_MOD) + (size_t)l * 36 * 6144;
    smp_res<false>(F, (const bf16*)(ws + WS_GP) + (size_t)2 * MT * DFF + (size_t)PM * DFF, (const bf16*)(ws + WS_WDN) + (size_t)l * DM * DFF, DFF, (const void*)((const bf16*)(ws + WS_X1) + (size_t)PM * DM), (bf16*)(ws + WS_X2) + (size_t)PM * DM, mod, 5120);
    pg8::Gemm g{(const pg8::bf16_t*)(ws + WS_GP) + (size_t)2 * MT * DFF, (const pg8::bf16_t*)(ws + WS_WDN) + (size_t)l * DM * DFF, PM, DM, DFF};
    pg8::StaticOrder S; S.init(PM, DM, F.G, F.bid);
    EpiRes<false> E{(const void*)(ws + WS_X1), (bf16*)(ws + WS_X2), mod, 5120};
    pg8::gemm_phase<EpiRes<false>, pg8::StaticOrder, true, true>(F.lds, g, S, E); }
template <int l> __device__ __forceinline__ void ph_up(Frame& F) { unsigned char* ws = F.ws;
    pg8::Gemm g{(const pg8::bf16_t*)(ws + WS_H), (const pg8::bf16_t*)(ws + WS_WUP) + (size_t)l * NUP * DM, MT, NUP, DM};
    pg8::StaticOrder S; S.init(MT, NUP, F.G, F.bid); EpiUp E{ws, F.out, l};
    pg8::gemm_phase<EpiUp, pg8::StaticOrder, true, true>(F.lds, g, S, E); }
#ifdef DBG_AMP_BIT
#define AMP_T0(bit) unsigned long long amp_t0_ = 0ull; if ((bit) == DBG_AMP_BIT) amp_t0_ = __builtin_amdgcn_s_memrealtime();
#define AMP_T1(bit) if ((bit) == DBG_AMP_BIT && F.tid == 0) { volatile LAS unsigned* AM = (volatile LAS unsigned*)(F.lds + MISC_OFF + 192); AM[0] += (unsigned)(__builtin_amdgcn_s_memrealtime() - amp_t0_); }
#else
#define AMP_T0(bit)
#define AMP_T1(bit)
#endif
#define RUNPH(bit, ph, CALL) do { if (((DBG_MASK >> (bit)) & 1) && IN(ph)) { AMP_T0(bit) launder(F); CALL; if ((DBG_REPEAT >> (bit)) & 1) { launder(F); CALL; } SEAM(ph); AMP_T1(bit) } } while (0)
template <int l> __device__ __forceinline__ void layer_phases(Frame& F, const XcdBarrier& bar, int lo, int hi) {
    constexpr int pb = PH_L0 + l * PH_PER_LAYER;
    RUNPH(1, pb + LP_N1, norm_phase(F, l, 0));
    RUNPH(2, pb + LP_WIN, ph_win<l>(F));
    RUNPH(3, pb + LP_MIX1, ph_mix1<l>(F));
    RUNPH(4, pb + LP_MIX2, ph_mix2<l>(F));
    RUNPH(5, pb + LP_MIX3, ph_mix3<l>(F));
    RUNPH(6, pb + LP_BR, ph_br<l>(F));
    RUNPH(7, pb + LP_OUT, ph_out<l>(F));
    RUNPH(8, pb + LP_N2, norm_phase(F, l, 1));
    RUNPH(9, pb + LP_UP, ph_up<l>(F));
    RUNPH(10, pb + LP_CONV, convact_phase(F, l));
    RUNPH(11, pb + LP_DOWN, ph_down<l>(F));
}
__global__ void __launch_bounds__(NTHR, 2) trunk_fwd(Args args) {
    extern __shared__ __attribute__((aligned(16))) unsigned char lds_raw[];
    Frame F;
    F.lds = (LAS unsigned char*)lds_raw;
    F.tid = threadIdx.x; F.lane = F.tid & 63; F.wave = __builtin_amdgcn_readfirstlane(F.tid >> 6);
    F.G = gridDim.x; F.bid = blockIdx.x; F.a = &args; F.ws = args.ws; F.out = args.out;
    volatile LAS unsigned* MISC = (volatile LAS unsigned*)(F.lds + MISC_OFF);
    for (int u = F.tid; u < 64; u += NTHR) MISC[u] = 0u;
    __syncthreads();
    unsigned* barw = (unsigned*)(F.ws + WS_CTL) + CW_BAR;
    XcdBarrier bar; bar.bar = barw; bar.x = 0; bar.st = nullptr;
    if (MK_N_LAUNCHES == 1) bar = xcd_barrier_post(barw, MISC + 8);
    const int lo = args.ph_lo, hi = args.ph_hi;
    unsigned char* ws = F.ws;

#ifdef DBG_TIME
    if (F.bid == 0 && F.tid == 0) ((unsigned long long*)(F.ws + WS_CTL))[2048] = __builtin_amdgcn_s_memrealtime();
#endif
    RUNPH(0, PH_P0, p0_prologue(F));

    layer_phases<0>(F, bar, lo, hi);
    layer_phases<1>(F, bar, lo, hi);
    if (((DBG_MASK >> 12) & 1) && IN(PH_FINAL)) { launder(F); final_phase(F); if ((DBG_REPEAT >> 12) & 1) { launder(F); final_phase(F); } }
#ifdef DBG_AMP_BIT
    if (F.tid == 0) { volatile LAS unsigned* AM = (volatile LAS unsigned*)(F.lds + MISC_OFF + 192); const unsigned long long tot = (unsigned long long)AM[0] * DBG_AMP, ts = __builtin_amdgcn_s_memrealtime();
        while (__builtin_amdgcn_s_memrealtime() - ts < tot) __builtin_amdgcn_s_sleep(8); }
    __syncthreads();
#endif
#ifdef DBG_TIME
    {
        xcd_barrier(bar);
        if (F.bid == 0 && F.tid < 14) {
            const unsigned long long* ts = (const unsigned long long*)(F.ws + WS_CTL) + 2048; const unsigned long long tend = __builtin_amdgcn_s_memrealtime();
            const size_t ooff[14] = {OUT_Y, OUT_Y + (size_t)PM * DM, OUT_ROWS_P, OUT_ROWS_S, OUT_WIN_P, OUT_WIN_S, OUT_RET_P, OUT_RET_S, OUT_H_P, OUT_H_S, OUT_CV_P, OUT_CV_S, OUT_FC_P, OUT_FC_S};
            const int b = F.tid; unsigned long long d;
            if (b == 0) d = tend - ts[0]; else if (b == 1) d = ts[1] - ts[0]; else if (b == 13) d = tend - ts[PH_FINAL];
            else { const int ph = PH_L0 + DBG_TIME_LAYER * PH_PER_LAYER + (b - 2); d = ts[ph + 1] - ts[ph]; }
            int cnt = (int)(d / 100ull); if (cnt < 1) cnt = 1; if (cnt > 2000 && b != 0) cnt = 2000;
            for (int i = 0; i < cnt; ++i) ((unsigned*)F.out)[ooff[b] + 7 + 2 * i] = 0xAAAAAAAAu;
        }
    }
#endif
#ifdef DBG_COUNT
    {
        xcd_barrier(bar);
        if (F.bid == 0 && F.tid < 3) { const unsigned* CNT = (const unsigned*)(F.ws + WS_CTL) + 3000; const size_t ooff[3] = {OUT_Y, OUT_Y + (size_t)PM * DM, OUT_ROWS_P};
            const int cnt = (int)((unsigned long long)CNT[F.tid] * 10ull / (CNT[3] ? CNT[3] : 1u)); for (int i = 0; i < cnt; ++i) ((unsigned*)F.out)[ooff[F.tid] + 7 + 2 * i] = 0xAAAAAAAAu; }
    }
#endif
#ifdef DBG_CHECK
    if (lo == 100) { launder(F); dbg_check_phase(F); }
    if (lo == 101) { for (size_t i = (size_t)F.bid * NTHR + F.tid; i < OUT_END; i += (size_t)F.G * NTHR) F.out[i] = 0.f; }
    if (lo == 102) { launder(F); dbg_report_phase(F); }
#endif
}

extern "C" void kernel_launch(void* const* d_in, const int* in_sizes, int n_in, void* d_out, int out_size, void* d_ws, size_t ws_size, hipStream_t stream) {
    static int grid = 0;
    if (grid == 0) {
        if (n_in != 37 || (size_t)out_size != OUT_END || ws_size < WS_END) { fprintf(stderr, "kernel_launch: unexpected shapes: n_in %d out %d (want %zu) ws %zu (want %zu)\n", n_in, out_size, (size_t)OUT_END, ws_size, (size_t)WS_END); grid = -1; return; }
        int dev = 0, cus = 0, per_cu = 0;
        if (hipGetDevice(&dev) != hipSuccess || hipDeviceGetAttribute(&cus, hipDeviceAttributeMultiprocessorCount, dev) != hipSuccess) { grid = -1; return; }
        if (hipFuncSetAttribute((const void*)trunk_fwd, hipFuncAttributeMaxDynamicSharedMemorySize, LDS_BYTES) != hipSuccess) { fprintf(stderr, "kernel_launch: hipFuncSetAttribute failed\n"); grid = -1; return; }
        if (hipOccupancyMaxActiveBlocksPerMultiprocessor(&per_cu, (const void*)trunk_fwd, NTHR, LDS_BYTES) != hipSuccess || per_cu < 1) fprintf(stderr, "kernel_launch: occupancy query reports %d\n", per_cu);
        (void)hipGetLastError();
        grid = cus;
    }
    if (grid < 0) return;
    if (hipMemsetAsync((char*)d_ws + WS_CTL, 0, CTL_ZERO_BYTES, stream) != hipSuccess) return;
#ifdef DBG_POISON
    (void)hipMemsetAsync((char*)d_ws + CTL_ZERO_BYTES, 0xAA, WS_END - CTL_ZERO_BYTES, stream);
    (void)hipMemsetAsync(d_out, 0xAA, (size_t)OUT_END * 4, stream);
#endif
    Args a{};
    for (int i = 0; i < 37; ++i) a.in[i] = d_in[i];
    a.out = (float*)d_out; a.ws = (unsigned char*)d_ws;
#if MK_N_LAUNCHES == 1
    a.ph_lo = 0; a.ph_hi = N_PHASES;
    hipLaunchKernelGGL(trunk_fwd, dim3(grid), dim3(NTHR), LDS_BYTES, stream, a);
#else
    for (int p = 0; p < DBG_MAXPH; ++p) { a.ph_lo = p; a.ph_hi = p + 1; hipLaunchKernelGGL(trunk_fwd, dim3(grid), dim3(NTHR), LDS_BYTES, stream, a); }
#ifdef DBG_CHECK
    for (int p = 100; p < 103; ++p) { a.ph_lo = p; a.ph_hi = p + 1; hipLaunchKernelGGL(trunk_fwd, dim3(grid), dim3(NTHR), LDS_BYTES, stream, a); }
#endif
#endif
    (void)in_sizes;
}
```

```cpp
#include <hip/hip_runtime.h>
#include <cstdio>
#include <cstdint>

#ifndef MK_N_LAUNCHES
#define MK_N_LAUNCHES 1
#endif

constexpr int DM = 1024, PB = 4, PT = 4096, PM = PB * PT, SB = 32, ST = 8, SM = SB * ST, MT = PM + SM;
constexpr int DEPTH = 2, PAST = 8192, PAGE = 128, NPG = PAST / PAGE, NPHYS = 2560;
constexpr int D_IN = 7448, NIN = 7680, DFF = 2816, NUP = 2 * DFF;
constexpr int WINB = 512;
constexpr float EPS = 1e-6f;
constexpr float QSCALE = 0.125f * 1.4426950408889634f;

constexpr int O_NQ = 0, O_NKV = 512, O_NG = 1280, O_RQ = 1304, O_RK = 1816, O_RV = 2328, O_RG = 2840, O_RX = 3352, O_RGATE = 3864, O_MG = 4376;

constexpr size_t OUT_Y = 0;
constexpr size_t OUT_ROWS_P = OUT_Y + (size_t)MT * DM;
constexpr size_t OUT_ROWS_S = OUT_ROWS_P + (size_t)DEPTH * PM * 512;
constexpr size_t OUT_WIN_P = OUT_ROWS_S + (size_t)DEPTH * SM * 512;
constexpr size_t OUT_WIN_S = OUT_WIN_P + (size_t)DEPTH * PB * WINB * 256;
constexpr size_t OUT_RET_P = OUT_WIN_S + (size_t)DEPTH * SB * WINB * 256;
constexpr size_t OUT_RET_S = OUT_RET_P + (size_t)DEPTH * PB * 4 * 16384;
constexpr size_t OUT_H_P = OUT_RET_S + (size_t)DEPTH * SB * 4 * 16384;
constexpr size_t OUT_H_S = OUT_H_P + (size_t)DEPTH * PB * 512;
constexpr size_t OUT_CV_P = OUT_H_S + (size_t)DEPTH * SB * 512;
constexpr size_t OUT_CV_S = OUT_CV_P + (size_t)DEPTH * PB * 3 * 512;
constexpr size_t OUT_FC_P = OUT_CV_S + (size_t)DEPTH * SB * 3 * 512;
constexpr size_t OUT_FC_S = OUT_FC_P + (size_t)DEPTH * PB * 2 * DFF;
constexpr size_t OUT_END = OUT_FC_S + (size_t)DEPTH * SB * 2 * DFF;

constexpr size_t MiB = 1u << 20;
constexpr size_t WS_CTL = 0, CTL_ZERO_BYTES = 4 * MiB;
constexpr size_t WS_MOD = 1 * MiB;
constexpr size_t WS_ROT = 4 * MiB;
constexpr size_t WS_SMALLW = 8 * MiB;
constexpr size_t WS_WIN = 16 * MiB;
constexpr size_t WS_WBR = WS_WIN + (size_t)2 * NIN * DM * 2;
constexpr size_t WS_WOUT = WS_WBR + (size_t)2 * 3 * 1024 * 512 * 2;
constexpr size_t WS_WUP = WS_WOUT + (size_t)2 * 1024 * 1024 * 2;
constexpr size_t WS_WDN = WS_WUP + (size_t)2 * NUP * DM * 2;
constexpr size_t WS_WEND = WS_WDN + (size_t)2 * DM * DFF * 2;
constexpr size_t WS_H = 128 * MiB;
constexpr size_t WS_QN = WS_H + (size_t)MT * DM * 2;
constexpr size_t WS_KVB = WS_QN + (size_t)MT * 512 * 2;
constexpr size_t WS_KVS = WS_KVB + (size_t)4 * PB * 2 * PT * 64 * 2;
constexpr size_t WS_RQ = WS_KVS + (size_t)4 * SB * 2 * ST * 64 * 2;
constexpr size_t WS_RX = WS_RQ + (size_t)4 * MT * 512 * 2;
constexpr size_t WS_GG = WS_RX + (size_t)MT * 512 * 4;
constexpr size_t WS_MGS = WS_GG + (size_t)MT * 512 * 2;
constexpr size_t WS_NG = WS_MGS + (size_t)MT * 3072 * 2;
constexpr size_t WS_OA = WS_NG + (size_t)MT * 24 * 4;
constexpr size_t WS_MRG = WS_OA + (size_t)3 * MT * 512 * 2;
constexpr size_t WS_X1 = WS_MRG + (size_t)MT * DM * 2;
constexpr size_t WS_X2 = WS_X1 + (size_t)MT * DM * 4;
constexpr size_t WS_GP = WS_X2 + (size_t)MT * DM * 4;
constexpr size_t WS_ACMP = WS_GP + (size_t)3 * MT * DFF * 2;
constexpr int CMP_ROWS_J = 34816, CMP_ROWS = 2 * CMP_ROWS_J;
constexpr size_t WS_LH = WS_ACMP + (size_t)2 * CMP_ROWS * 1024 * 2 + 4096;
constexpr size_t WS_CK = WS_LH + (size_t)(CMP_ROWS + 16) * 256 * 2;
constexpr size_t WS_LT = WS_CK + (size_t)CMP_ROWS * 64 * 2;
constexpr size_t WS_SPT = WS_LT + (size_t)16 * 32 * 16384 * 4;
constexpr size_t WS_CAR = WS_SPT + (size_t)16 * 32 * 16384 * 2;
constexpr size_t WS_OAG = WS_CAR + (size_t)4 * 64 * 3 * 512 * 4 + MiB;
constexpr size_t WS_END = WS_OAG + (size_t)2048 * 32 * 64 * 4 + MiB;
static_assert(WS_WEND <= WS_H, "weights fit below WS_H");

constexpr size_t SW_W1T = 0;
constexpr size_t SW_W2T = SW_W1T + (size_t)2 * 2 * 256 * 1024 * 2;
constexpr size_t SW_CB = SW_W2T + (size_t)2 * 2 * 64 * 128 * 2;
constexpr size_t SW_WAT = SW_CB + (size_t)2 * 2 * 128 * 4;
constexpr size_t SW_SP = SW_WAT + (size_t)2 * 2 * 8 * 64 * 64 * 2;
constexpr size_t SW_END = SW_SP + 2 * 512 * 4;
static_assert(SW_END <= 8 * MiB, "small weights fit");

constexpr int CW_TMO = 0;
constexpr int CW_BAR = 4096;

constexpr int PH_P0 = 0, PH_L0 = 1, PH_PER_LAYER = 11, PH_FINAL = PH_L0 + DEPTH * PH_PER_LAYER, N_PHASES = PH_FINAL + 1;
enum { LP_N1 = 0, LP_WIN, LP_MIX1, LP_MIX2, LP_MIX3, LP_BR, LP_OUT, LP_N2, LP_UP, LP_CONV, LP_DOWN };

constexpr int RING_BYTES = 131072;
constexpr int MISC_OFF = RING_BYTES;
constexpr int LDS_BYTES = RING_BYTES + 1024;
constexpr int NWAVES = 8, NTHR = 512;

#define GAS __attribute__((address_space(1)))
#define LAS __attribute__((address_space(3)))
typedef unsigned short bf16;
typedef unsigned v4u __attribute__((ext_vector_type(4)));
typedef unsigned v2u __attribute__((ext_vector_type(2)));
typedef float f32x16 __attribute__((ext_vector_type(16)));
typedef short s16x4 __attribute__((ext_vector_type(4)));
namespace pg8 {
#define PG8_LAS __attribute__((address_space(3)))
typedef unsigned short bf16_t;
typedef short bf16x8 __attribute__((ext_vector_type(8)));
typedef float f32x4 __attribute__((ext_vector_type(4)));
typedef unsigned u32x4 __attribute__((ext_vector_type(4)));
constexpr int BM = 256, BK = 64, HALF = 128, HTB = HALF * BK * 2  , STAGE_BYTES = 8 * HTB, NXCD = 8, WGM = 8;

__host__ __device__ __forceinline__ int lds_byte(int r, int c) { const int st = (r >> 4) * 2 + (c >> 5), rr = r & 15, cc = c & 31, ob = rr * 64 + cc * 2; return st * 1024 + (ob ^ (((ob >> 9) & 1) << 5)); }
__host__ __device__ __forceinline__ void stage_rc(int b, int& R, int& C) { const int st = b / 1024, sb = b % 1024, swz = sb ^ (((sb >> 9) & 1) << 5); R = (st >> 1) * 16 + swz / 64; C = (st & 1) * 32 + (swz % 64) / 2; }
__host__ __device__ __forceinline__ int perm32(int rho) { const int n = rho >> 4, i = rho & 15; return 8 * (i >> 2) + 4 * n + (i & 3); }

struct Unit { int pm, pn; };
struct Gemm { const bf16_t* A; const bf16_t* Bt; int M, N, K; };

struct StaticOrder {
    int nM, nN, nwg, G, c;
    __host__ __device__ void init(int M, int N, int G_, int c_) { nM = M / BM; nN = N / BM; nwg = nM * nN; G = G_; c = c_; }
    __host__ __device__ bool next(int i, Unit& u) const {
        const long L = (long)i * G + c; if (L >= nwg) return false;
        int wgid = (int)L; { const int q = nwg / NXCD, r = nwg % NXCD, xcd = wgid % NXCD, off = wgid / NXCD; wgid = (xcd < r ? xcd * (q + 1) : r * (q + 1) + (xcd - r) * q) + off; }
        const int nig = WGM * nN, gid = wgid / nig, fm = gid * WGM, gsz = (nM - fm) < WGM ? (nM - fm) : WGM;
        u.pm = fm + ((wgid % nig) % gsz); u.pn = (wgid % nig) / gsz; return true;
    }
    __device__ __forceinline__ void a_ready(const Unit&) const {}
    __device__ __forceinline__ void done(const Unit&) const {}
};
__device__ __forceinline__ unsigned cvt_pk_bf16(float lo, float hi) { unsigned r; asm volatile("v_cvt_pk_bf16_f32 %0, %1, %2" : "=v"(r) : "v"(lo), "v"(hi)); return r; }
typedef float f32x2 __attribute__((ext_vector_type(2)));
template <class Epi, class Sched, bool ALIGN_EPI = false, bool SP2 = false>
__device__ __forceinline__ void gemm_phase(PG8_LAS unsigned char* lds, const Gemm g, const Sched& S, const Epi& E) {
    const int tid = threadIdx.x, wid = __builtin_amdgcn_readfirstlane(tid >> 6), lane = tid & 63, wr = wid >> 2, wc = wid & 3, fr = lane & 15, fq = lane >> 4;
    const int K = g.K, nt = K / BK;
    unsigned voffA[2], voffB[2];
#pragma unroll
    for (int i = 0; i < 2; ++i) { int R, C; stage_rc(tid * 16 + i * 8192, R, C); const int Rb = Epi::PERM ? ((R & ~31) + perm32(R & 31)) : R;
        voffA[i] = (unsigned)(R * K + C) * 2u; voffB[i] = (unsigned)(Rb * K + C) * 2u; }
    const size_t kstep = (size_t)(BK * 2);
    const size_t hstep = (size_t)HALF * K * 2;
    const size_t tstep = 2 * hstep;
    const unsigned ldsw = (unsigned)wid * 1024u;
    const int aoff = lds_byte(wr * 64 + fr, fq * 8), boff = lds_byte(wc * 32 + fr, fq * 8);
#define PG8_SA(b, h) (((b) * 2 + (h)) * HTB)
#define PG8_SB(b, h) ((4 + (b) * 2 + (h)) * HTB)
#define PG8_STAGE(bufoff, gbase, voff) do { _Pragma("unroll") for (int _i = 0; _i < 2; ++_i) \
        __builtin_amdgcn_global_load_lds((const unsigned*)((const char*)(gbase) + (voff)[_i]), (PG8_LAS unsigned*)(lds + (bufoff) + ldsw + _i * 8192), 16, 0, 0); } while (0)
#define PG8_LDA(dst, b, h) do { _Pragma("unroll") for (int m = 0; m < 4; ++m) _Pragma("unroll") for (int k = 0; k < 2; ++k) dst[m][k] = *(const PG8_LAS bf16x8*)(lds + PG8_SA(b, h) + aoff + m * 2048 + k * 1024); } while (0)
#define PG8_LDB(dst, b, h) do { _Pragma("unroll") for (int n = 0; n < 2; ++n) _Pragma("unroll") for (int k = 0; k < 2; ++k) dst[n][k] = *(const PG8_LAS bf16x8*)(lds + PG8_SB(b, h) + boff + n * 2048 + k * 1024); } while (0)
#define PG8_MMA(ai, bj, At, Bt) do { __builtin_amdgcn_s_setprio(1); _Pragma("unroll") for (int m = 0; m < 4; ++m) _Pragma("unroll") for (int n = 0; n < 2; ++n) _Pragma("unroll") for (int k = 0; k < 2; ++k) \
        acc[ai][bj][m][n] = __builtin_amdgcn_mfma_f32_16x16x32_bf16(Bt[n][k], At[m][k], acc[ai][bj][m][n], 0, 0, 0); __builtin_amdgcn_s_setprio(0); } while (0)
#define PG8_WAIT_V(n) asm volatile("s_waitcnt vmcnt(" #n ")" ::: "memory")
#define PG8_WAIT_L(n) asm volatile("s_waitcnt lgkmcnt(" #n ")" ::: "memory")
#define PG8_BAR __builtin_amdgcn_s_barrier()
#define PG8_SCHED __builtin_amdgcn_sched_barrier(0)
    Unit cur, nxt; int ui = 0;
    if (!S.next(0, cur)) return;
    f32x4 acc[2][2][4][2];
#pragma unroll
    for (int a = 0; a < 2; ++a)
#pragma unroll
        for (int b = 0; b < 2; ++b)
#pragma unroll
            for (int m = 0; m < 4; ++m)
#pragma unroll
                for (int n = 0; n < 2; ++n) acc[a][b][m][n] = (f32x4){0.f, 0.f, 0.f, 0.f};
    bf16x8 At[4][2], B0[2][2], B1[2][2];
    const char* cA = (const char*)g.A + (size_t)cur.pm * tstep; const char* cB = (const char*)g.Bt + (size_t)cur.pn * tstep;
    S.a_ready(cur);
    if constexpr (SP2) {
        PG8_STAGE(PG8_SB(0, 0), cB, voffB); PG8_STAGE(PG8_SB(0, 1), cB + hstep, voffB); PG8_STAGE(PG8_SA(0, 0), cA, voffA); PG8_STAGE(PG8_SA(0, 1), cA + hstep, voffA);
        if (wr == 1) PG8_BAR;
        PG8_WAIT_V(2); PG8_BAR;
        PG8_STAGE(PG8_SB(1, 0), cB + kstep, voffB); PG8_STAGE(PG8_SA(1, 0), cA + kstep, voffA); PG8_STAGE(PG8_SB(1, 1), cB + hstep + kstep, voffB);
        PG8_WAIT_V(6); PG8_BAR;
    } else {
        PG8_STAGE(PG8_SB(0, 0), cB, voffB); PG8_STAGE(PG8_SA(0, 0), cA, voffA); PG8_STAGE(PG8_SB(0, 1), cB + hstep, voffB); PG8_STAGE(PG8_SA(0, 1), cA + hstep, voffA);
        if (wr == 1) PG8_BAR;
        PG8_WAIT_V(4); PG8_BAR;
        PG8_STAGE(PG8_SB(1, 0), cB + kstep, voffB); PG8_STAGE(PG8_SA(1, 0), cA + kstep, voffA); PG8_STAGE(PG8_SB(1, 1), cB + hstep + kstep, voffB);
        PG8_WAIT_V(6); PG8_BAR;
    }
    for (;;) {
        const bool has_next = S.next(ui + 1, nxt);
        const char* nA = has_next ? (const char*)g.A + (size_t)nxt.pm * tstep : cA; const char* nB = has_next ? (const char*)g.Bt + (size_t)nxt.pn * tstep : cB;
        for (int t = 0; t < nt; t += 2) {
            const bool last = (t == nt - 2);
            const char* a1 = cA + (size_t)(t + 1) * kstep;
            const char* a2 = last ? nA : cA + (size_t)(t + 2) * kstep; const char* b2 = last ? nB : cB + (size_t)(t + 2) * kstep;
            const char* a3 = a2 + kstep; const char* b3 = b2 + kstep;
            if (last && has_next) S.a_ready(nxt);
            if constexpr (SP2) {
            PG8_LDB(B0, 0, 0); PG8_LDB(B1, 0, 1); PG8_SCHED; PG8_LDA(At, 0, 0); PG8_STAGE(PG8_SA(1, 1), a1 + hstep, voffA);
            PG8_WAIT_V(8); PG8_WAIT_L(0); PG8_BAR; PG8_MMA(0, 0, At, B0); PG8_MMA(0, 1, At, B1); PG8_BAR; PG8_SCHED;
            PG8_LDA(At, 0, 1); PG8_STAGE(PG8_SB(0, 0), b2, voffB); PG8_STAGE(PG8_SB(0, 1), b2 + hstep, voffB); PG8_STAGE(PG8_SA(0, 0), a2, voffA);
            PG8_WAIT_V(8); PG8_WAIT_L(0); PG8_BAR; PG8_MMA(1, 0, At, B0); PG8_MMA(1, 1, At, B1); PG8_BAR; PG8_SCHED;
            PG8_LDB(B0, 1, 0); PG8_LDB(B1, 1, 1); PG8_SCHED; PG8_LDA(At, 1, 0); PG8_STAGE(PG8_SA(0, 1), a2 + hstep, voffA);
            PG8_WAIT_V(8); PG8_WAIT_L(0); PG8_BAR; PG8_MMA(0, 0, At, B0); PG8_MMA(0, 1, At, B1); PG8_BAR; PG8_SCHED;
            PG8_LDA(At, 1, 1); PG8_STAGE(PG8_SB(1, 0), b3, voffB); PG8_STAGE(PG8_SB(1, 1), b3 + hstep, voffB); PG8_STAGE(PG8_SA(1, 0), a3, voffA);
            PG8_WAIT_V(8); PG8_WAIT_L(0); PG8_BAR; PG8_MMA(1, 0, At, B0); PG8_MMA(1, 1, At, B1); PG8_BAR; PG8_SCHED;
            } else {
            PG8_LDB(B0, 0, 0); PG8_SCHED; PG8_LDA(At, 0, 0); PG8_STAGE(PG8_SA(1, 1), a1 + hstep, voffA);
            PG8_WAIT_L(8); PG8_BAR; PG8_WAIT_L(0); PG8_MMA(0, 0, At, B0); PG8_BAR; PG8_SCHED;
            PG8_LDB(B1, 0, 1); PG8_STAGE(PG8_SB(0, 0), b2, voffB);
            PG8_BAR; PG8_WAIT_L(0); PG8_MMA(0, 1, At, B1); PG8_BAR;
            PG8_LDA(At, 0, 1); PG8_STAGE(PG8_SA(0, 0), a2, voffA);
            PG8_BAR; PG8_WAIT_L(0); PG8_MMA(1, 0, At, B0); PG8_BAR; PG8_SCHED;
            PG8_STAGE(PG8_SB(0, 1), b2 + hstep, voffB);
            PG8_WAIT_V(6); PG8_BAR; PG8_MMA(1, 1, At, B1); PG8_BAR;
            PG8_LDB(B0, 1, 0); PG8_SCHED; PG8_LDA(At, 1, 0); PG8_STAGE(PG8_SA(0, 1), a2 + hstep, voffA);
            PG8_WAIT_L(8); PG8_BAR; PG8_WAIT_L(0); PG8_MMA(0, 0, At, B0); PG8_BAR; PG8_SCHED;
            PG8_LDB(B1, 1, 1); PG8_STAGE(PG8_SB(1, 0), b3, voffB);
            PG8_BAR; PG8_WAIT_L(0); PG8_MMA(0, 1, At, B1); PG8_BAR;
            PG8_LDA(At, 1, 1); PG8_STAGE(PG8_SA(1, 0), a3, voffA);
            PG8_BAR; PG8_WAIT_L(0); PG8_MMA(1, 0, At, B0); PG8_BAR; PG8_SCHED;
            PG8_STAGE(PG8_SB(1, 1), b3 + hstep, voffB);
            PG8_WAIT_V(6); PG8_BAR; PG8_MMA(1, 1, At, B1); PG8_BAR;
            }
        }
        if constexpr (ALIGN_EPI) { if (wr == 0) PG8_BAR; }
        if constexpr (!Epi::AFTER_DRAIN) { E(acc, cur, wr, wc, fr, fq); S.done(cur); }
        if (!has_next) break;
#pragma unroll
        for (int a = 0; a < 2; ++a)
#pragma unroll
            for (int b = 0; b < 2; ++b)
#pragma unroll
                for (int m = 0; m < 4; ++m)
#pragma unroll
                    for (int n = 0; n < 2; ++n) acc[a][b][m][n] = (f32x4){0.f, 0.f, 0.f, 0.f};
        cur = nxt; cA = nA; cB = nB; ++ui;
        if constexpr (ALIGN_EPI) { if (wr == 1) PG8_BAR; }
    }
    PG8_WAIT_V(0);
    if constexpr (!ALIGN_EPI) { if (wr == 0) PG8_BAR; }
    PG8_BAR;
    if constexpr (Epi::AFTER_DRAIN) { E.fused(acc, cur, wr, wc, fr, fq, lds, wid, lane); S.done(cur); }
#undef PG8_SA
#undef PG8_SB
#undef PG8_STAGE
#undef PG8_LDA
#undef PG8_LDB
#undef PG8_MMA
#undef PG8_WAIT_V
#undef PG8_WAIT_L
#undef PG8_BAR
#undef PG8_SCHED
}
}

using pg8::bf16x8; using pg8::f32x4; using pg8::u32x4;
#define LDS_WAIT() asm volatile("s_waitcnt lgkmcnt(0)" ::: "memory")
#define VM_WAIT() asm volatile("s_waitcnt vmcnt(0)" ::: "memory")
typedef float f32x2_t __attribute__((ext_vector_type(2))); typedef __bf16 bf16x2_t __attribute__((ext_vector_type(2)));
__device__ __forceinline__ unsigned pk2(float lo, float hi) { f32x2_t v = {lo, hi}; bf16x2_t b = __builtin_convertvector(v, bf16x2_t); return __builtin_bit_cast(unsigned, b); }
__device__ __forceinline__ float bf_lo(unsigned w) { return __uint_as_float(w << 16); }
__device__ __forceinline__ float bf_hi(unsigned w) { return __uint_as_float(w & 0xffff0000u); }
__device__ __forceinline__ float bf1(bf16 b) { return __uint_as_float(((unsigned)b) << 16); }
__device__ __forceinline__ float fexp2(float x) { return __builtin_amdgcn_exp2f(x); }
__device__ __forceinline__ float fexp(float x) { return __builtin_amdgcn_exp2f(x * 1.4426950408889634f); }
__device__ __forceinline__ float frcp(float x) { return __builtin_amdgcn_rcpf(x); }
__device__ __forceinline__ float sigmoidf_(float x) { return frcp(1.0f + fexp(-x)); }
__device__ __forceinline__ float siluf_(float x) { return x * sigmoidf_(x); }
__device__ __forceinline__ float gelu_tanh(float x) {
    const float u = 0.7978845608028654f * (x + 0.044715f * x * x * x);
    const float e = fexp(2.0f * u);
    const float t = 1.0f - 2.0f * frcp(e + 1.0f);
    return 0.5f * x * (1.0f + t);
}
__device__ __forceinline__ float wave_sum(float v) {
#pragma unroll
    for (int o = 1; o < 64; o <<= 1) v += __shfl_xor(v, o);
    return v;
}
__device__ __forceinline__ v4u pack8(const f32x4 a, const f32x4 b) { v4u w; w.x = pk2(a[0], a[1]); w.y = pk2(a[2], a[3]); w.z = pk2(b[0], b[1]); w.w = pk2(b[2], b[3]); return w; }
__device__ __forceinline__ void unpack8(const v4u w, f32x4& a, f32x4& b) { a = (f32x4){bf_lo(w.x), bf_hi(w.x), bf_lo(w.y), bf_hi(w.y)}; b = (f32x4){bf_lo(w.z), bf_hi(w.z), bf_lo(w.w), bf_hi(w.w)}; }

#define XB_TMO      128
#define XB_XCNT(j)  (256  + 64 * (j))
#define XB_XSUB(j)  (1280 + 64 * (j))
#define XB_XGEN(j)  (2304 + 64 * (j))
#define XB_TOP      3328
#define XB_TOPGEN   3392
#define XCD_BAR_WORDS 3456
#define XB_SPIN_CAP (1u << 18)

__device__ __forceinline__ unsigned xb_ld(unsigned* p)              { return __hip_atomic_load(p, __ATOMIC_RELAXED, __HIP_MEMORY_SCOPE_AGENT); }
__device__ __forceinline__ unsigned xb_add(unsigned* p, unsigned v) { return __hip_atomic_fetch_add(p, v, __ATOMIC_RELAXED, __HIP_MEMORY_SCOPE_AGENT); }
__device__ __forceinline__ unsigned xb_xcc_id() { return (unsigned)__builtin_amdgcn_s_getreg((3 << 11) | 20) & 0xFu; }
#define XB_SPIN(cond, bar) do { unsigned _sp = 0; while (cond) { __builtin_amdgcn_s_sleep(1); \
    if ((++_sp & 255u) == 0u) { if (xb_ld(&(bar)[XB_TMO])) break; if (_sp > XB_SPIN_CAP) { atomicAdd(&(bar)[XB_TMO], 1u); break; } } } } while (0)

struct XcdBarrier {
    unsigned* bar; unsigned x;
    volatile LAS unsigned* st;
};

__device__ __forceinline__ XcdBarrier xcd_barrier_post(unsigned* bar, volatile LAS unsigned* st) {
    XcdBarrier b; b.bar = bar; b.x = xb_xcc_id(); b.st = st;
    if (threadIdx.x == 0) (void)xb_add(&bar[XB_XCNT(b.x)], 1u);
    return b;
}
__device__ __forceinline__ void xcd_barrier_complete(unsigned* bar, unsigned x, unsigned& nloc, unsigned& nx) {
    const unsigned G = gridDim.x * gridDim.y * gridDim.z;
    unsigned sum, cnt, mine, sp = 0u;
    for (;;) {
        sum = 0u; cnt = 0u; mine = 0u;
#pragma unroll
        for (unsigned j = 0; j < 16; ++j) { const unsigned c = xb_ld(&bar[XB_XCNT(j)]); sum += c; cnt += (c > 0u) ? 1u : 0u; mine = (j == x) ? c : mine; }
        if (sum == G) break;
        __builtin_amdgcn_s_sleep(1);
        if ((++sp & 255u) == 0u) { if (xb_ld(&bar[XB_TMO])) break; if (sp > XB_SPIN_CAP) { atomicAdd(&bar[XB_TMO], 1u); break; } }
    }
    nloc = mine > 0u ? mine : 1u; nx = cnt > 0u ? cnt : 1u;
}

__device__ __forceinline__ void xcd_barrier(const XcdBarrier& b) {
    asm volatile("s_waitcnt vmcnt(0)" ::: "memory");
    __syncthreads();
    if (threadIdx.x == 0) {
        unsigned* bar = b.bar;
        __builtin_amdgcn_s_waitcnt(0);
        unsigned nloc = b.st[0], nx = b.st[1];
        if (nloc == 0u) { xcd_barrier_complete(bar, b.x, nloc, nx); b.st[0] = nloc; b.st[1] = nx; }
        const unsigned old = xb_add(&bar[XB_XSUB(b.x)], 1u);
        const unsigned gen = old / nloc;
        if (old + 1u == (gen + 1u) * nloc) {
            __builtin_amdgcn_fence(__ATOMIC_RELEASE, "agent");
            asm volatile("s_waitcnt vmcnt(0)" ::: "memory");
            const unsigned og = xb_add(&bar[XB_TOP], 1u);
            const unsigned tg = og / nx;
            if (og + 1u == (tg + 1u) * nx) xb_add(&bar[XB_TOPGEN], 1u);
            else XB_SPIN(xb_ld(&bar[XB_TOPGEN]) == tg, bar);
            __builtin_amdgcn_fence(__ATOMIC_ACQUIRE, "agent");
            xb_add(&bar[XB_XGEN(b.x)], 1u);
            asm volatile("s_waitcnt vmcnt(0)" ::: "memory");
        } else {
            XB_SPIN(xb_ld(&bar[XB_XGEN(b.x)]) == gen, bar);
            __builtin_amdgcn_fence(__ATOMIC_ACQUIRE, "agent");
            asm volatile("s_waitcnt vmcnt(0)" ::: "memory");
        }
    }
    __syncthreads();
}

struct Args { const void* in[37]; float* out; unsigned char* ws; int ph_lo, ph_hi; };
enum { I_XP = 0, I_XS, I_CACHE, I_CWIN, I_SRET, I_SH, I_SCONV, I_SFFN, I_PT, I_CP, I_CS, I_N1G, I_N2G, I_WADA, I_BADA, I_WIN, I_PE, I_W1, I_B1, I_W2,
       I_GNG, I_RCW, I_RCB, I_RWA, I_RBA, I_RWX, I_RBX, I_LAM, I_WBRA, I_WBRB, I_WBRC, I_WOUT, I_WUP, I_FCW, I_FCB, I_WDN, I_FNG };

struct Frame {
    LAS unsigned char* lds;
    int tid, lane, wave, G, bid;
    const Args* a;
    unsigned char* ws;
    float* out;
};
__device__ __forceinline__ void launder(Frame& F) { asm volatile("" : "+v"(F.tid), "+v"(F.lane)); int w_ = __builtin_amdgcn_readfirstlane(F.wave), b_ = __builtin_amdgcn_readfirstlane(F.bid), g_ = __builtin_amdgcn_readfirstlane(F.G); asm volatile("" : "+s"(w_), "+s"(b_), "+s"(g_)); F.wave = w_; F.bid = b_; F.G = g_; }
#define FIN(i) ((const float*)F.a->in[i])
#define WSP(T, off) ((T*)(F.ws + (off)))

__device__ __forceinline__ int row_bb(int row) { return row < PM ? (row >> 12) : 4 + ((row - PM) >> 3); }
__device__ __forceinline__ int row_pos(int row) { return row < PM ? (row & (PT - 1)) : PT + ((row - PM) & 7); }

__device__ __forceinline__ int win_cmap(int n) {
    if (n < 1280) return n;
    if (n < 2304) { const int c = n - 1280, isk = c >> 9, hc = c & 511, head = hc >> 7, s = hc & 127;
        const int g = s >> 3, w = s & 7, dim = (w < 4) ? (4 * g + w) : (64 + 4 * g + (w - 4)); return (isk ? O_RK : O_RQ) + head * 128 + dim; }
    if (n < 2816) return O_RV + (n - 2304);
    if (n < 3328) return O_RG + (n - 2816);
    if (n < 3840) return O_RX + (n - 3328);
    if (n < 4352) return O_RGATE + (n - 3840);
    if (n < 7424) return O_MG + (n - 4352);
    if (n < 7448) return O_NG + (n - 7424);
    return -1;
}

struct TrItem { const float* W; bf16* WT; int ldw, ldt, k0, n0; bool map; };
__device__ __forceinline__ void p0_tr_load(const TrItem& I, float (&tv)[32], int lane) {
    const int nd = I.n0 + (lane & 31); const int sc = I.map ? win_cmap(nd) : nd;
#pragma unroll
    for (int i = 0; i < 32; ++i) { const int kk = 2 * i + (lane >> 5); tv[i] = (sc >= 0) ? I.W[(size_t)(I.k0 + kk) * I.ldw + sc] : 0.f; }
}
__device__ __forceinline__ void p0_tr_finish(const TrItem& I, const float (&tv)[32], LAS float* scr, int lane) {
#pragma unroll
    for (int i = 0; i < 32; ++i) { const int kk = 2 * i + (lane >> 5); scr[kk * 33 + (lane & 31)] = tv[i]; }
    LDS_WAIT(); asm volatile("" ::: "memory");
    const int c = lane & 7;
#pragma unroll
    for (int j = 0; j < 4; ++j) { const int n = (lane >> 3) + 8 * j; const LAS float* s = scr + (8 * c) * 33 + n;
        v4u o; o.x = pk2(s[0 * 33], s[1 * 33]); o.y = pk2(s[2 * 33], s[3 * 33]); o.z = pk2(s[4 * 33], s[5 * 33]); o.w = pk2(s[6 * 33], s[7 * 33]);
        *(v4u*)(I.WT + (size_t)(I.n0 + n) * I.ldt + I.k0 + 8 * c) = o; }
    LDS_WAIT(); asm volatile("" ::: "memory");
}
template <bool MAP> __device__ __forceinline__ void p0_tr_item(const float* W, int ldw, bf16* WT, int ldt, int k0, int n0, LAS float* scr, int lane) {
    TrItem I{W, WT, ldw, ldt, k0, n0, MAP}; float tv[32]; p0_tr_load(I, tv, lane); p0_tr_finish(I, tv, scr, lane);
}
template <bool MAP> __device__ __forceinline__ void p0_tr_item2(const float* W, int ldw, bf16* WT, int ldt, int k0, int n0, LAS float* scr, int lane) {
    TrItem I0{W, WT, ldw, ldt, k0, n0, MAP}, I1{W, WT, ldw, ldt, k0, n0 + 32, MAP}; float t0[32], t1[32];
    p0_tr_load(I0, t0, lane); p0_tr_load(I1, t1, lane); p0_tr_finish(I0, t0, scr, lane); p0_tr_finish(I1, t1, scr, lane);
}
__device__ __forceinline__ void sincos_acc(float ang, float& s, float& c) {
    const double a = (double)ang; const double kq = rint(a * 0.63661977236758134308); const double r = fma(-kq, 1.57079632679489661923, a);
    const double r2 = r * r;
    const double sp = r * (1.0 + r2 * (-1.6666666666666666e-1 + r2 * (8.3333333333333332e-3 + r2 * (-1.9841269841269841e-4 + r2 * (2.7557319223985893e-6 + r2 * (-2.5052108385441720e-8))))));
    const double cp = 1.0 + r2 * (-0.5 + r2 * (4.1666666666666664e-2 + r2 * (-1.3888888888888889e-3 + r2 * (2.4801587301587302e-5 + r2 * (-2.7557319223985888e-7 + r2 * 2.0876756987868099e-9)))));
    const int q = ((int)kq) & 3;
    const double ss = (q == 0) ? sp : (q == 1) ? cp : (q == 2) ? -sp : -cp;
    const double cc = (q == 0) ? cp : (q == 1) ? -sp : (q == 2) ? -cp : sp;
    s = (float)ss; c = (float)cc;
}

__device__ __forceinline__ void p0_prologue(Frame& F) {
    const int gw = F.bid * NWAVES + F.wave, NGW = F.G * NWAVES, lane = F.lane;
    LAS float* scr = (LAS float*)(F.lds + F.wave * 16384);
    {
        constexpr int I_IN = 16 * 240, I_BR = 8 * 32, I_OUT = 16 * 32, I_UP = 16 * 176, I_DN = 44 * 32, I_L = I_IN + 3 * I_BR + I_OUT + I_UP + I_DN;
        for (int it = gw; it < 2 * I_L; it += NGW) {
            const int l = it / I_L; int r = it % I_L;
            if (r < I_IN) { p0_tr_item<true>(FIN(I_WIN) + (size_t)l * DM * D_IN, D_IN, WSP(bf16, WS_WIN) + (size_t)l * NIN * DM, DM, 64 * (r / 240), 32 * (r % 240), scr, lane); continue; } r -= I_IN;
            if (r < 3 * I_BR) { const int w = r / I_BR, q = r % I_BR; const float* src = FIN(w == 0 ? I_WBRA : (w == 1 ? I_WBRB : I_WBRC)) + (size_t)l * 512 * 1024;
                p0_tr_item<false>(src, 1024, WSP(bf16, WS_WBR) + (size_t)(l * 3 + w) * 1024 * 512, 512, 64 * (q / 32), 32 * (q % 32), scr, lane); continue; } r -= 3 * I_BR;
            if (r < I_OUT) { p0_tr_item<false>(FIN(I_WOUT) + (size_t)l * 1024 * 1024, 1024, WSP(bf16, WS_WOUT) + (size_t)l * 1024 * 1024, 1024, 64 * (r / 32), 32 * (r % 32), scr, lane); continue; } r -= I_OUT;
            if (r < I_UP) { p0_tr_item<false>(FIN(I_WUP) + (size_t)l * DM * NUP, NUP, WSP(bf16, WS_WUP) + (size_t)l * NUP * DM, DM, 64 * (r / 176), 32 * (r % 176), scr, lane); continue; } r -= I_UP;
            p0_tr_item<false>(FIN(I_WDN) + (size_t)l * DFF * DM, DM, WSP(bf16, WS_WDN) + (size_t)l * DM * DFF, DFF, 64 * (r / 32), 32 * (r % 32), scr, lane);
        }
    }
    {
        constexpr int NI_W1 = 8 * 16 * 4, NI_W2 = 4 * 2 * 2, NI_RG = 32 * 2;
        for (int it = gw; it < NI_W1 + NI_W2 + NI_RG; it += NGW) {
            int r = it;
            if (r < NI_W1) { const int m = r / 64, q = r % 64, lk = m >> 1, half = m & 1;
                p0_tr_item<false>(FIN(I_W1) + ((size_t)lk * 32 + half * 16) * 64 * 128, 128, WSP(bf16, WS_SMALLW + SW_W1T) + ((size_t)lk * 256 + half * 128) * 1024, 1024, 64 * (q / 4), 32 * (q % 4), scr, lane); continue; } r -= NI_W1;
            if (r < NI_W2) { const int lk = r / 4, q = r % 4;
                p0_tr_item<false>(FIN(I_W2) + (size_t)lk * 128 * 64, 64, WSP(bf16, WS_SMALLW + SW_W2T) + (size_t)lk * 64 * 128, 128, 64 * (q / 2), 32 * (q % 2), scr, lane); continue; } r -= NI_W2;
            { const int m = r / 2, q = r % 2, l = m >> 4, which = (m >> 3) & 1, blk = m & 7;
                p0_tr_item<false>(FIN(which ? I_RWX : I_RWA) + ((size_t)l * 8 + blk) * 4096, 64, WSP(bf16, WS_SMALLW + SW_WAT) + (size_t)m * 4096, 64, 0, 32 * q, scr, lane); }
        }
    }
    for (int it = gw; it < 64; it += NGW) {
        const int lk = it >> 4, h0 = (it & 15) * 8; const float* pe = FIN(I_PE) + (size_t)lk * 2048; const float* w1 = FIN(I_W1) + (size_t)lk * 2048 * 128 + h0;
        f32x4 a0 = (f32x4){0.f, 0.f, 0.f, 0.f}, a1 = a0;
#pragma unroll 8
        for (int i = lane; i < 2048; i += 64) { const float p = pe[i]; a0 += *(const f32x4*)(w1 + (size_t)i * 128) * p; a1 += *(const f32x4*)(w1 + (size_t)i * 128 + 4) * p; }
#pragma unroll
        for (int x = 0; x < 4; ++x) { a0[x] = wave_sum(a0[x]); a1[x] = wave_sum(a1[x]); }
        if (lane == 0) { float* cb = WSP(float, WS_SMALLW + SW_CB) + lk * 128 + h0; const float* b1 = FIN(I_B1) + lk * 128 + h0;
#pragma unroll
            for (int x = 0; x < 4; ++x) { cb[x] = a0[x] + b1[x]; cb[4 + x] = a1[x] + b1[4 + x]; } }
    }
    for (int i = F.bid * NTHR + F.tid; i < 1024; i += F.G * NTHR) { const float lam = FIN(I_LAM)[i]; WSP(float, WS_SMALLW + SW_SP)[i] = log1pf(expf(-lam)); }
    for (int i = F.bid * NTHR + F.tid; i < 4104 * 64; i += F.G * NTHR) {
        const int pi = i >> 6, fi = i & 63; const float pos = (float)(pi < PT ? pi : PAST + (pi - PT));
        const float freq = (float)pow(10000.0, -(double)fi / 64.0); const float ang = pos * freq; float s, c; sincos_acc(ang, s, c);
        WSP(float, WS_ROT)[i] = c; WSP(float, WS_ROT)[4104 * 64 + i] = s;
    }
    {
        LAS float* SC = (LAS float*)(F.lds + 0);
        LAS float* RED = (LAS float*)(F.lds + 36864);
        for (int u = F.bid; u < 2 * 96; u += F.G) {
            const int l = u / 96, cg = u % 96; float acc[36];
#pragma unroll
            for (int b = 0; b < 36; ++b) acc[b] = 0.f;
#pragma unroll 1
            for (int kh = 0; kh < 4; ++kh) {
                __syncthreads();
                {   float cv[18];
                    const float* cpp = FIN(I_CP); const float* csp = FIN(I_CS);
#pragma unroll
                    for (int it = 0; it < 18; ++it) { const int i = F.tid + NTHR * it, bb = i >> 8, d = i & 255;
                        cv[it] = (bb < 4) ? cpp[bb * DM + kh * 256 + d] : csp[(bb - 4) * DM + kh * 256 + d]; }
#pragma unroll
                    for (int it = 0; it < 18; ++it) { const int i = F.tid + NTHR * it, bb = i >> 8, d = i & 255; SC[d * 36 + bb] = siluf_(cv[it]); }
                }
                __syncthreads();
                const float* wp = FIN(I_WADA) + ((size_t)l * DM + kh * 256 + F.wave * 32) * 6144 + cg * 64 + lane;
                {
                    float wv[32];
#pragma unroll
                    for (int k = 0; k < 32; ++k) wv[k] = wp[(size_t)k * 6144];
                    const LAS f32x4* scb = (const LAS f32x4*)(SC + (F.wave * 32) * 36);
                    f32x4 sa[9], sb[9];
#pragma unroll
                    for (int g = 0; g < 9; ++g) sa[g] = scb[g];
#pragma unroll
                    for (int k = 0; k < 32; k += 2) {
#pragma unroll
                        for (int g = 0; g < 9; ++g) sb[g] = scb[(k + 1) * 9 + g];
#pragma unroll
                        for (int g = 0; g < 9; ++g) { acc[4 * g + 0] += wv[k] * sa[g][0]; acc[4 * g + 1] += wv[k] * sa[g][1]; acc[4 * g + 2] += wv[k] * sa[g][2]; acc[4 * g + 3] += wv[k] * sa[g][3]; }
                        if (k + 2 < 32) {
#pragma unroll
                            for (int g = 0; g < 9; ++g) sa[g] = scb[(k + 2) * 9 + g]; }
#pragma unroll
                        for (int g = 0; g < 9; ++g) { acc[4 * g + 0] += wv[k + 1] * sb[g][0]; acc[4 * g + 1] += wv[k + 1] * sb[g][1]; acc[4 * g + 2] += wv[k + 1] * sb[g][2]; acc[4 * g + 3] += wv[k + 1] * sb[g][3]; }
                    }
                }
            }
#pragma unroll
            for (int b = 0; b < 36; ++b) RED[(F.wave * 36 + b) * 64 + lane] = acc[b];
            __syncthreads();
            for (int o = F.tid; o < 36 * 64; o += NTHR) { const int b = o >> 6, col = o & 63; float sm = FIN(I_BADA)[l * 6144 + cg * 64 + col];
#pragma unroll
                for (int w = 0; w < 8; ++w) sm += RED[(w * 36 + b) * 64 + col];
                WSP(float, WS_MOD)[((size_t)l * 36 + b) * 6144 + cg * 64 + col] = sm; }
        }
        __syncthreads();
    }
    {   constexpr size_t NV4 = (size_t)2 * SB * 504 * 64; const size_t stride = (size_t)F.G * NTHR;
        for (size_t i0 = (size_t)F.bid * NTHR + F.tid; i0 < NV4; i0 += 8 * stride) {
            f32x4 v[8];
#pragma unroll
            for (int k = 0; k < 8; ++k) { const size_t i = i0 + k * stride; if (i < NV4) { const size_t seq = i / (504 * 64), r = i % (504 * 64); v[k] = __builtin_nontemporal_load((const f32x4*)(FIN(I_CWIN) + (seq * 512 + 8) * 256 + r * 4)); } }
#pragma unroll
            for (int k = 0; k < 8; ++k) { const size_t i = i0 + k * stride; if (i < NV4) { const size_t seq = i / (504 * 64), r = i % (504 * 64); *(f32x4*)(F.out + OUT_WIN_S + seq * 512 * 256 + r * 4) = v[k]; } }
        }
    }
}

__device__ __forceinline__ f32x4 ld4_bf(const bf16* p) { const v2u w = *(const v2u*)p; return (f32x4){bf_lo(w.x), bf_hi(w.x), bf_lo(w.y), bf_hi(w.y)}; }
__device__ __forceinline__ void norm_phase(Frame& F, int l, int which) {
    const int gw = F.bid * NWAVES + F.wave, NGW = F.G * NWAVES, lane = F.lane;
    const float* g = FIN(which ? I_N2G : I_N1G) + l * DM;
    constexpr int NR = 4;
    for (int row0 = gw * NR; row0 < MT; row0 += NGW * NR) {
        f32x4 v[NR][4]; float ss[NR];
#pragma unroll
        for (int rr = 0; rr < NR; ++rr) { const int row = row0 + rr;
            if (which == 0 && l == 0) { const float* xr = row < PM ? FIN(I_XP) + (size_t)row * DM : FIN(I_XS) + (size_t)(row - PM) * DM;
#pragma unroll
                for (int j = 0; j < 4; ++j) v[rr][j] = *(const f32x4*)(xr + lane * 4 + 256 * j); }
            else { const bf16* xr = WSP(bf16, which ? WS_X1 : WS_X2) + (size_t)row * DM;
#pragma unroll
                for (int j = 0; j < 4; ++j) v[rr][j] = ld4_bf(xr + lane * 4 + 256 * j); } }
#pragma unroll
        for (int rr = 0; rr < NR; ++rr) { float a = 0.f;
#pragma unroll
            for (int j = 0; j < 4; ++j) a += (v[rr][j][0] * v[rr][j][0] + v[rr][j][1] * v[rr][j][1]) + (v[rr][j][2] * v[rr][j][2] + v[rr][j][3] * v[rr][j][3]);
            ss[rr] = a; }
#pragma unroll
        for (int o = 1; o < 64; o <<= 1) {
#pragma unroll
            for (int rr = 0; rr < NR; ++rr) ss[rr] += __shfl_xor(ss[rr], o); }
#pragma unroll
        for (int rr = 0; rr < NR; ++rr) { const int row = row0 + rr; const float rs = 1.0f / sqrtf(ss[rr] * (1.0f / DM) + EPS);
            const float* mod = WSP(float, WS_MOD) + ((size_t)l * 36 + row_bb(row)) * 6144 + (which ? 3072 : 0); bf16* o = WSP(bf16, WS_H) + (size_t)row * DM;
#pragma unroll
            for (int j = 0; j < 4; ++j) { const int c = lane * 4 + 256 * j; const f32x4 gg = *(const f32x4*)(g + c), sh = *(const f32x4*)(mod + c), sc = *(const f32x4*)(mod + 1024 + c);
                const f32x4 y = (v[rr][j] * rs) * gg * (sc + 1.0f) + sh; v2u w; w.x = pk2(y[0], y[1]); w.y = pk2(y[2], y[3]); *(v2u*)(o + c) = w; } }
    }
}
__device__ __forceinline__ void final_phase(Frame& F) {
    const int gw = F.bid * NWAVES + F.wave, NGW = F.G * NWAVES, lane = F.lane;
    const float* g = FIN(I_FNG);
    for (int row0 = gw * 4; row0 < MT; row0 += NGW * 4) {
        f32x4 v[4][4]; float ss[4];
#pragma unroll
        for (int rr = 0; rr < 4; ++rr) { const bf16* xr = WSP(bf16, WS_X2) + (size_t)(row0 + rr) * DM; float a = 0.f;
#pragma unroll
            for (int j = 0; j < 4; ++j) { v[rr][j] = ld4_bf(xr + lane * 4 + 256 * j); a += (v[rr][j][0] * v[rr][j][0] + v[rr][j][1] * v[rr][j][1]) + (v[rr][j][2] * v[rr][j][2] + v[rr][j][3] * v[rr][j][3]); }
            ss[rr] = a; }
#pragma unroll
        for (int rr = 0; rr < 4; ++rr) { const float rs = 1.0f / sqrtf(wave_sum(ss[rr]) * (1.0f / DM) + EPS);
            float* o = F.out + OUT_Y + (size_t)(row0 + rr) * DM;
#pragma unroll
            for (int j = 0; j < 4; ++j) { const int c = lane * 4 + 256 * j; *(f32x4*)(o + c) = (v[rr][j] * rs) * *(const f32x4*)(g + c); } }
    }
}

#define EPI_LOOP_BEGIN \
    _Pragma("unroll") for (int ai = 0; ai < 2; ++ai) _Pragma("unroll") for (int m = 0; m < 4; ++m) { const int row = u.pm * 256 + ai * 128 + wr * 64 + m * 16 + fr; \
    _Pragma("unroll") for (int bj = 0; bj < 2; ++bj) { const int ct = bj * 128 + wc * 32 + 8 * fq; const f32x4 v0 = acc[ai][bj][m][0], v1 = acc[ai][bj][m][1];
#define EPI_LOOP_END } }

struct EpiWin {
    static constexpr bool PERM = true, AFTER_DRAIN = false;
    unsigned char* ws; float* out; int l;
    __device__ __forceinline__ void operator()(const f32x4 (&acc)[2][2][4][2], const pg8::Unit& u, int wr, int wc, int fr0, int fq0) const {
        int fr = fr0, fq = fq0; asm volatile("" : "+v"(fr), "+v"(fq));
        const int pn = u.pn;
        if (pn < 2) {
            bf16* QN = (bf16*)(ws + WS_QN);
            EPI_LOOP_BEGIN *(v4u*)(QN + (size_t)row * 512 + pn * 256 + ct) = pack8(v0 * QSCALE, v1 * QSCALE); EPI_LOOP_END
        } else if (pn < 5) {
            EPI_LOOP_BEGIN
                const int c = (pn - 2) * 256 + ct, j = c >> 7, k = (c >> 6) & 1, d = c & 63;
                const bool isp = row < PM; const int b = isp ? (row >> 12) : ((row - PM) >> 3), t = isp ? (row & (PT - 1)) : ((row - PM) & 7);
                if (j < 4) { float* o = out + (isp ? OUT_ROWS_P + ((size_t)l * PM + row) * 512 : OUT_ROWS_S + ((size_t)l * SM + (row - PM)) * 512) + c; *(f32x4*)o = v0; *(f32x4*)(o + 4) = v1; }
                else if (isp) { if (t >= PT - WINB) { float* o = out + OUT_WIN_P + (((size_t)l * PB + b) * WINB + (t - (PT - WINB))) * 256 + (c - 512); *(f32x4*)o = v0; *(f32x4*)(o + 4) = v1; } }
                else { float* o = out + OUT_WIN_S + (((size_t)l * SB + b) * WINB + (WINB - ST) + t) * 256 + (c - 512); *(f32x4*)o = v0; *(f32x4*)(o + 4) = v1; }
                const v4u w = pack8(v0, v1);
                if (isp) {
                    if (j < 2) *(v4u*)((bf16*)(ws + WS_ACMP) + ((size_t)(l * 2 + j) * CMP_ROWS_J + 32768 + (b * 2 + k) * 256) * 1024 + (size_t)t * 64 + d) = w;
                    else if (j & 1) {
                        const int tq = t & 31, s2 = tq >> 4, hh = (tq >> 2) & 1, ii = (tq & 3) + 4 * ((tq >> 3) & 1);
                        bf16* vt = (bf16*)(ws + WS_KVB) + (((size_t)(j - 2) * PB + b) * 2 + k) * PT * 64 + (size_t)(t >> 5) * 2048 + ((((d >> 5) * 2 + s2) * 2 + hh) * 32 + (d & 31)) * 8 + ii;
                        vt[0] = (bf16)(w.x & 0xffffu); vt[8] = (bf16)(w.x >> 16); vt[16] = (bf16)(w.y & 0xffffu); vt[24] = (bf16)(w.y >> 16);
                        vt[32] = (bf16)(w.z & 0xffffu); vt[40] = (bf16)(w.z >> 16); vt[48] = (bf16)(w.w & 0xffffu); vt[56] = (bf16)(w.w >> 16); }
                    else *(v4u*)((bf16*)(ws + WS_KVB) + (((size_t)(j - 2) * PB + b) * 2 + k) * PT * 64 + (size_t)(t >> 5) * 2048 + ((d >> 3) * 32 + (t & 31)) * 8) = w;
                } else if (j >= 2) *(v4u*)((bf16*)(ws + WS_KVS) + ((((size_t)(j - 2) * SB + b) * 2 + k) * ST + t) * 64 + d) = w;
            EPI_LOOP_END
        } else if (pn < 9) {
            const float* ROTC = (const float*)(ws + WS_ROT); const float* ROTS = ROTC + 4104 * 64;
#pragma unroll
            for (int ai = 0; ai < 2; ++ai) {
                f32x4 cs[4][2], sn[4][2];
#pragma unroll
                for (int m = 0; m < 4; ++m) { const int row = u.pm * 256 + ai * 128 + wr * 64 + m * 16 + fr; const int pi = row_pos(row);
#pragma unroll
                    for (int bj = 0; bj < 2; ++bj) { const int ct = bj * 128 + wc * 32 + 8 * fq; const int c = (pn - 5) * 256 + ct, d0 = (((c & 511) & 127) >> 3) * 4; cs[m][bj] = *(const f32x4*)(ROTC + pi * 64 + d0); sn[m][bj] = *(const f32x4*)(ROTS + pi * 64 + d0); } }
#pragma unroll
                for (int m = 0; m < 4; ++m) { const int row = u.pm * 256 + ai * 128 + wr * 64 + m * 16 + fr;
#pragma unroll
                    for (int bj = 0; bj < 2; ++bj) { const int ct = bj * 128 + wc * 32 + 8 * fq; const f32x4 v0 = acc[ai][bj][m][0], v1 = acc[ai][bj][m][1];
                        const int c = (pn - 5) * 256 + ct, isk = c >> 9, hc = c & 511, head = hc >> 7, d0 = ((hc & 127) >> 3) * 4;
                        const float sc = isk ? 0.08838834764831845f : 1.0f;
                        const f32x4 o1 = (v0 * cs[m][bj] - v1 * sn[m][bj]) * sc, o2 = (v0 * sn[m][bj] + v1 * cs[m][bj]) * sc;
                        bf16* o = (bf16*)(ws + WS_RQ) + (size_t)isk * MT * 512 + (size_t)row * 512 + head * 128 + d0;
                        v2u w1; w1.x = pk2(o1[0], o1[1]); w1.y = pk2(o1[2], o1[3]); *(v2u*)o = w1;
                        v2u w2; w2.x = pk2(o2[0], o2[1]); w2.y = pk2(o2[2], o2[3]); *(v2u*)(o + 64) = w2; } }
            }
        } else if (pn < 13) {
            bf16* RV = (bf16*)(ws + WS_RQ) + (size_t)2 * MT * 512;
            EPI_LOOP_BEGIN const int c = (pn - 9) * 256 + ct; *(v4u*)(RV + (size_t)(c >> 9) * MT * 512 + (size_t)row * 512 + (c & 511)) = pack8(v0, v1); EPI_LOOP_END
        } else if (pn < 15) {
            float* RX = (float*)(ws + WS_RX);
            EPI_LOOP_BEGIN
                const int c = (pn - 13) * 256 + ct; float* o = RX + (size_t)row * 512 + c; *(f32x4*)o = v0; *(f32x4*)(o + 4) = v1;
                if (row < PM) { const int t = row & (PT - 1); if (t >= PT - 3) { float* q = out + OUT_CV_P + (((size_t)l * PB + (row >> 12)) * 3 + (t - (PT - 3))) * 512 + c; *(f32x4*)q = v0; *(f32x4*)(q + 4) = v1; } }
                else { const int i = (row - PM) & 7; if (i >= ST - 3) { float* q = out + OUT_CV_S + (((size_t)l * SB + ((row - PM) >> 3)) * 3 + (i - (ST - 3))) * 512 + c; *(f32x4*)q = v0; *(f32x4*)(q + 4) = v1; } }
            EPI_LOOP_END
        } else if (pn < 17) {
            bf16* GG = (bf16*)(ws + WS_GG);
            EPI_LOOP_BEGIN const int c = (pn - 15) * 256 + ct;
                f32x4 a, b;
#pragma unroll
                for (int i = 0; i < 4; ++i) { a[i] = gelu_tanh(v0[i]); b[i] = gelu_tanh(v1[i]); }
                *(v4u*)(GG + (size_t)row * 512 + c) = pack8(a, b); EPI_LOOP_END
        } else if (pn < 29) {
            bf16* MG = (bf16*)(ws + WS_MGS);
            EPI_LOOP_BEGIN const int c = (pn - 17) * 256 + ct;
                f32x4 a, b;
#pragma unroll
                for (int i = 0; i < 4; ++i) { a[i] = sigmoidf_(v0[i]); b[i] = sigmoidf_(v1[i]); }
                *(v4u*)(MG + (size_t)row * 3072 + c) = pack8(a, b); EPI_LOOP_END
        } else {
            float* NG = (float*)(ws + WS_NG);
            EPI_LOOP_BEGIN if (ct < 24) { f32x4 a, b;
#pragma unroll
                for (int i = 0; i < 4; ++i) { a[i] = sigmoidf_(v0[i]); b[i] = sigmoidf_(v1[i]); }
                float* o = NG + (size_t)row * 24 + ct; *(f32x4*)o = a; *(f32x4*)(o + 4) = b; } EPI_LOOP_END
        }
    }
};

struct EpiLH {
    static constexpr bool PERM = true, AFTER_DRAIN = false;
    bf16* LH;
    __device__ __forceinline__ void operator()(const f32x4 (&acc)[2][2][4][2], const pg8::Unit& u, int wr, int wc, int fr0, int fq0) const {
        int fr = fr0, fq = fq0; asm volatile("" : "+v"(fr), "+v"(fq));
        EPI_LOOP_BEGIN *(v4u*)(LH + (size_t)row * 256 + ct) = pack8(v0, v1); EPI_LOOP_END
    }
};
struct CmpOrder {
    int G, c;
    __device__ bool next(int i, pg8::Unit& u) const { const int L = i * G + c; if (L >= CMP_ROWS / 256) return false; u.pm = L; u.pn = L / (CMP_ROWS_J / 256); return true; }
    __device__ __forceinline__ void a_ready(const pg8::Unit&) const {}
    __device__ __forceinline__ void done(const pg8::Unit&) const {}
};

template <int BR> struct EpiBr {
    static constexpr bool PERM = true, AFTER_DRAIN = false;
    unsigned char* ws;
    __device__ __forceinline__ void operator()(const f32x4 (&acc)[2][2][4][2], const pg8::Unit& u, int wr, int wc, int fr0, int fq0) const {
        int fr = fr0, fq = fq0; asm volatile("" : "+v"(fr), "+v"(fq));
        const bf16* MG = (const bf16*)(ws + WS_MGS); bf16* MR = (bf16*)(ws + WS_MRG);
        EPI_LOOP_BEGIN
            const int col = u.pn * 256 + ct; f32x4 g0, g1; unpack8(*(const v4u*)(MG + (size_t)row * 3072 + BR * 1024 + col), g0, g1);
            f32x4 r0 = v0 * g0, r1 = v1 * g1; bf16* o = MR + (size_t)row * DM + col;
            if (BR > 0) { f32x4 p0, p1; unpack8(*(const v4u*)o, p0, p1); r0 += p0; r1 += p1; }
            *(v4u*)o = pack8(r0, r1);
        EPI_LOOP_END
    }
};

struct BrOrder {
    pg8::StaticOrder S;
    __device__ bool next(int i, pg8::Unit& u) const { pg8::Unit t; if (!S.next(i / 3, t)) return false; const int br = i % 3; u.pm = br * (MT / 256) + t.pm; u.pn = br * 4 + t.pn; return true; }
    __device__ __forceinline__ void a_ready(const pg8::Unit&) const {}
    __device__ __forceinline__ void done(const pg8::Unit&) const {}
};
struct EpiBrAll {
    static constexpr bool PERM = true, AFTER_DRAIN = false;
    unsigned char* ws;
    __device__ __forceinline__ void operator()(const f32x4 (&acc)[2][2][4][2], const pg8::Unit& u0, int wr, int wc, int fr0, int fq0) const {
        int fr = fr0, fq = fq0; asm volatile("" : "+v"(fr), "+v"(fq));
        const int br = u0.pn >> 2; const pg8::Unit u{u0.pm - br * (MT / 256), u0.pn & 3};
        const bf16* MG = (const bf16*)(ws + WS_MGS) + br * 1024; bf16* MR = (bf16*)(ws + WS_MRG);
#pragma unroll
        for (int ai = 0; ai < 2; ++ai) {
            v4u gw[4][2], pw[4][2];
#pragma unroll
            for (int m = 0; m < 4; ++m) { const int row = u.pm * 256 + ai * 128 + wr * 64 + m * 16 + fr;
#pragma unroll
                for (int bj = 0; bj < 2; ++bj) { const int col = u.pn * 256 + bj * 128 + wc * 32 + 8 * fq; gw[m][bj] = *(const v4u*)(MG + (size_t)row * 3072 + col); if (br != 0) pw[m][bj] = *(const v4u*)(MR + (size_t)row * DM + col); } }
#pragma unroll
            for (int m = 0; m < 4; ++m) { const int row = u.pm * 256 + ai * 128 + wr * 64 + m * 16 + fr;
#pragma unroll
                for (int bj = 0; bj < 2; ++bj) { const int col = u.pn * 256 + bj * 128 + wc * 32 + 8 * fq; const f32x4 v0 = acc[ai][bj][m][0], v1 = acc[ai][bj][m][1];
                    f32x4 g0, g1; unpack8(gw[m][bj], g0, g1); f32x4 r0 = v0 * g0, r1 = v1 * g1;
                    if (br != 0) { f32x4 p0, p1; unpack8(pw[m][bj], p0, p1); r0 += p0; r1 += p1; }
                    *(v4u*)(MR + (size_t)row * DM + col) = pack8(r0, r1); } }
        }
    }
};

template <bool INF32> struct EpiRes {
    static constexpr bool PERM = true, AFTER_DRAIN = false;
    const void* xin_p; bf16* xout; const float* mod; int gofs;
    __device__ __forceinline__ void operator()(const f32x4 (&acc)[2][2][4][2], const pg8::Unit& u, int wr, int wc, int fr0, int fq0) const {
        int fr = fr0, fq = fq0; asm volatile("" : "+v"(fr), "+v"(fq));
#pragma unroll
        for (int ai = 0; ai < 2; ++ai) {
            const float* gp = mod + (size_t)row_bb(u.pm * 256 + ai * 128) * 6144 + gofs + u.pn * 256 + wc * 32 + 8 * fq;
            f32x4 g[2][2];
#pragma unroll
            for (int bj = 0; bj < 2; ++bj) { g[bj][0] = *(const f32x4*)(gp + 128 * bj); g[bj][1] = *(const f32x4*)(gp + 128 * bj + 4); }
            if (INF32) {
#pragma unroll
                for (int mh = 0; mh < 2; ++mh) {
                    f32x4 xv[2][2][2];
#pragma unroll
                    for (int m2 = 0; m2 < 2; ++m2) { const int row = u.pm * 256 + ai * 128 + wr * 64 + (2 * mh + m2) * 16 + fr;
#pragma unroll
                        for (int bj = 0; bj < 2; ++bj) { const float* xi = (const float*)xin_p + (size_t)row * DM + u.pn * 256 + bj * 128 + wc * 32 + 8 * fq; xv[m2][bj][0] = *(const f32x4*)xi; xv[m2][bj][1] = *(const f32x4*)(xi + 4); } }
#pragma unroll
                    for (int m2 = 0; m2 < 2; ++m2) { const int m = 2 * mh + m2; const int row = u.pm * 256 + ai * 128 + wr * 64 + m * 16 + fr;
#pragma unroll
                        for (int bj = 0; bj < 2; ++bj) { const int col = u.pn * 256 + bj * 128 + wc * 32 + 8 * fq;
                            *(v4u*)(xout + (size_t)row * DM + col) = pack8(xv[m2][bj][0] + g[bj][0] * acc[ai][bj][m][0], xv[m2][bj][1] + g[bj][1] * acc[ai][bj][m][1]); } }
                }
            } else {
                v4u xw[4][2];
#pragma unroll
                for (int m = 0; m < 4; ++m) { const int row = u.pm * 256 + ai * 128 + wr * 64 + m * 16 + fr;
#pragma unroll
                    for (int bj = 0; bj < 2; ++bj) xw[m][bj] = *(const v4u*)((const bf16*)xin_p + (size_t)row * DM + u.pn * 256 + bj * 128 + wc * 32 + 8 * fq); }
#pragma unroll
                for (int m = 0; m < 4; ++m) { const int row = u.pm * 256 + ai * 128 + wr * 64 + m * 16 + fr;
#pragma unroll
                    for (int bj = 0; bj < 2; ++bj) { const int col = u.pn * 256 + bj * 128 + wc * 32 + 8 * fq; f32x4 x0, x1; unpack8(xw[m][bj], x0, x1);
                        *(v4u*)(xout + (size_t)row * DM + col) = pack8(x0 + g[bj][0] * acc[ai][bj][m][0], x1 + g[bj][1] * acc[ai][bj][m][1]); } }
            }
        }
    }
};

struct UpOrder {
    pg8::StaticOrder S;
    __device__ bool next(int i, pg8::Unit& u) const { pg8::Unit t; if (!S.next(i >> 1, t)) return false; u.pm = t.pm; u.pn = t.pn + 11 * (i & 1); return true; }
    __device__ __forceinline__ void a_ready(const pg8::Unit&) const {}
    __device__ __forceinline__ void done(const pg8::Unit&) const {}
};
struct EpiUp {
    static constexpr bool PERM = true, AFTER_DRAIN = false;
    unsigned char* ws; float* out; int l; const float* cw; const float* cbi;
    __device__ __forceinline__ void operator()(const f32x4 (&acc)[2][2][4][2], const pg8::Unit& u, int wr, int wc, int fr0, int fq0) const {
        int fr = fr0, fq = fq0; asm volatile("" : "+v"(fr), "+v"(fq));
        bf16* GP = (bf16*)(ws + WS_GP); bf16* VAL = GP + (size_t)MT * DFF; bf16* ACT = GP + (size_t)2 * MT * DFF;
        if (u.pn < 11) {
            EPI_LOOP_BEGIN const int c = u.pn * 256 + ct; *(v4u*)(GP + (size_t)row * DFF + c) = pack8(v0, v1);
                if (row < PM) { const int t = row & (PT - 1); if (t >= PT - 2) { float* q = out + OUT_FC_P + (((size_t)l * PB + (row >> 12)) * 2 + (t - (PT - 2))) * DFF + c; *(f32x4*)q = v0; *(f32x4*)(q + 4) = v1; } }
                else { const int i = (row - PM) & 7; if (i >= ST - 2) { float* q = out + OUT_FC_S + (((size_t)l * SB + ((row - PM) >> 3)) * 2 + (i - (ST - 2))) * DFF + c; *(f32x4*)q = v0; *(f32x4*)(q + 4) = v1; } }
            EPI_LOOP_END
        } else if (u.pm * 256 >= PM) {
            EPI_LOOP_BEGIN const int c = (u.pn - 11) * 256 + ct; *(v4u*)(VAL + (size_t)row * DFF + c) = pack8(v0, v1); EPI_LOOP_END
        } else {
#pragma unroll
            for (int bj = 0; bj < 2; ++bj) { const int c = (u.pn - 11) * 256 + bj * 128 + wc * 32 + 8 * fq;
                const f32x4 w0a = *(const f32x4*)(cw + c), w0b = *(const f32x4*)(cw + c + 4), w1a = *(const f32x4*)(cw + DFF + c), w1b = *(const f32x4*)(cw + DFF + c + 4);
                const f32x4 w2a = *(const f32x4*)(cw + 2 * DFF + c), w2b = *(const f32x4*)(cw + 2 * DFF + c + 4), ba = *(const f32x4*)(cbi + c), bb = *(const f32x4*)(cbi + c + 4);
#pragma unroll
                for (int ai = 0; ai < 2; ++ai)
#pragma unroll
                  for (int mh = 0; mh < 2; ++mh) {
                    v4u g0[2], g1[2], g2[2];
#pragma unroll
                    for (int m2 = 0; m2 < 2; ++m2) { const int row = u.pm * 256 + ai * 128 + wr * 64 + (2 * mh + m2) * 16 + fr; const int t = row & (PT - 1); const bf16* gp = GP + (size_t)row * DFF + c;
                        g0[m2] = *(const v4u*)gp;
                        g1[m2] = (t >= 1) ? *(const v4u*)(gp - DFF) : (v4u){0u, 0u, 0u, 0u};
                        g2[m2] = (t >= 2) ? *(const v4u*)(gp - 2 * DFF) : (v4u){0u, 0u, 0u, 0u}; }
#pragma unroll
                    for (int m2 = 0; m2 < 2; ++m2) { const int m = 2 * mh + m2; const int row = u.pm * 256 + ai * 128 + wr * 64 + m * 16 + fr; const int t = row & (PT - 1);
                        const f32x4 v0 = acc[ai][bj][m][0], v1 = acc[ai][bj][m][1];
                        if ((t & 255) < 2 && t >= 2) { *(v4u*)(VAL + (size_t)row * DFF + c) = pack8(v0, v1); }
                        else { f32x4 xa, xb, pa, pb, qa, qb; unpack8(g0[m2], xa, xb); unpack8(g1[m2], pa, pb); unpack8(g2[m2], qa, qb);
                            f32x4 ya = ba + w0a * qa + w1a * pa + w2a * xa, yb = bb + w0b * qb + w1b * pb + w2b * xb;
#pragma unroll
                            for (int i = 0; i < 4; ++i) { ya[i] = siluf_(ya[i]) * v0[i]; yb[i] = siluf_(yb[i]) * v1[i]; }
                            *(v4u*)(ACT + (size_t)row * DFF + c) = pack8(ya, yb); } }
                  }
            }
        }
    }
};

__device__ __forceinline__ f32x16 mfma32(bf16x8 a, bf16x8 b, f32x16 c) { return __builtin_amdgcn_mfma_f32_32x32x16_bf16(a, b, c, 0, 0, 0); }
__device__ __forceinline__ f32x4 mfma16(bf16x8 a, bf16x8 b, f32x4 c) { return __builtin_amdgcn_mfma_f32_16x16x32_bf16(a, b, c, 0, 0, 0); }
__device__ __forceinline__ float ret_log_g(int h) { return log1pf(-exp2f(-5.0f - (float)h)); }
__device__ __forceinline__ bf16x8 tr_frag(const LAS unsigned char* base, int rs_bytes, int rowA, int rowB, int colbase, int lane) {
    const int q = (lane & 15) >> 2, p = lane & 3;
    const LAS unsigned char* pa = base + (rowA + q) * rs_bytes + (colbase + 4 * p) * 2;
    const LAS unsigned char* pb = base + (rowB + q) * rs_bytes + (colbase + 4 * p) * 2;
    const s16x4 a = __builtin_bit_cast(s16x4, __builtin_amdgcn_ds_read_tr16_b64_v4i16((LAS s16x4*)pa));
    const s16x4 b = __builtin_bit_cast(s16x4, __builtin_amdgcn_ds_read_tr16_b64_v4i16((LAS s16x4*)pb));
    return (bf16x8){a[0], a[1], a[2], a[3], b[0], b[1], b[2], b[3]};
}
__device__ __forceinline__ bf16x8 cvt_frag(const f32x16& p, int s2) {
    u32x4 w; w.x = pk2(p[8 * s2 + 0], p[8 * s2 + 1]); w.y = pk2(p[8 * s2 + 2], p[8 * s2 + 3]); w.z = pk2(p[8 * s2 + 4], p[8 * s2 + 5]); w.w = pk2(p[8 * s2 + 6], p[8 * s2 + 7]);
    return __builtin_bit_cast(bf16x8, w);
}

__device__ __forceinline__ void cmp2_phase(Frame& F, int l) {
    const int gw = F.bid * NWAVES + F.wave, NGW = F.G * NWAVES, lane = F.lane, r = lane & 15, g = lane >> 4;
    const bf16* LH = WSP(bf16, WS_LH); bf16* CK = WSP(bf16, WS_CK);
    for (int wu = gw; wu < CMP_ROWS / 16; wu += NGW) {
        const int row0 = wu * 16, j = row0 / CMP_ROWS_J, rj = (row0 % CMP_ROWS_J) + r, row = row0 + r;
        const bool valid = (rj < 32768) ? ((rj & 511) < 511) : (((rj - 32768) & 255) < 255);
        const bf16* W2T = WSP(bf16, WS_SMALLW + SW_W2T) + (size_t)(l * 2 + j) * 64 * 128; const float* CB = WSP(float, WS_SMALLW + SW_CB) + (l * 2 + j) * 128;
        f32x4 acc[4];
#pragma unroll
        for (int ct = 0; ct < 4; ++ct) acc[ct] = (f32x4){0.f, 0.f, 0.f, 0.f};
#pragma unroll
        for (int ks = 0; ks < 4; ++ks) {
            const int h0 = 32 * ks + 8 * g; f32x4 a0, a1, b0, b1;
            unpack8(*(const v4u*)(LH + (size_t)row * 256 + h0), a0, a1); unpack8(*(const v4u*)(LH + (size_t)(row + 1) * 256 + 128 + h0), b0, b1);
            const f32x4 c0 = *(const f32x4*)(CB + h0), c1 = *(const f32x4*)(CB + h0 + 4);
            f32x4 x0 = a0 + b0 + c0, x1 = a1 + b1 + c1;
#pragma unroll
            for (int i = 0; i < 4; ++i) { x0[i] = gelu_tanh(x0[i]); x1[i] = gelu_tanh(x1[i]); }
            const bf16x8 hf = __builtin_bit_cast(bf16x8, pack8(x0, x1));
#pragma unroll
            for (int ct = 0; ct < 4; ++ct) { const bf16x8 wf = *(const bf16x8*)(W2T + (size_t)(16 * ct + r) * 128 + h0); acc[ct] = mfma16(wf, hf, acc[ct]); }
        }
#pragma unroll
        for (int ct = 0; ct < 4; ++ct) { const f32x4 v = valid ? acc[ct] : (f32x4){0.f, 0.f, 0.f, 0.f}; v2u w; w.x = pk2(v[0], v[1]); w.y = pk2(v[2], v[3]);
            *(v2u*)(CK + (size_t)row * 64 + 16 * ct + 4 * g) = w; }
    }
}

constexpr int CG_RS = 144, CG_BUF = 256 * CG_RS, CG_AW = 2 * CG_BUF, CG_AT = 32 * CG_RS;
static_assert(CG_AW + 2 * 4 * CG_AT <= RING_BYTES, "compress GEMM LDS map");
template <bool smp> __device__ __forceinline__ void cmp_gemm_unit(Frame& F, int l, int j, int grp, int n00) {
    const int tid = F.tid, lane = F.lane, w = F.wave, q = lane & 31, h_ = lane >> 5, rg = w >> 1, ch = w & 1;
    const float* rp[4]; const bf16* ab = nullptr;
    if (smp) { const int db = grp >> 1, k = grp & 1;
#pragma unroll
        for (int i = 0; i < 4; ++i) { const int tt0 = (n00 + 32 * rg + 16 * ch + 4 * i + (lane >> 4)) * 16; const int page = ((const int*)F.a->in[I_PT])[db * NPG + (tt0 >> 7)];
            rp[i] = FIN(I_CACHE) + (((((size_t)l * NPHYS + page) * PAGE + (tt0 & 127)) * 4 + j) * 2 + k) * 64 + (lane & 15) * 4; } }
    else {
        ab = WSP(bf16, WS_ACMP) + ((size_t)(l * 2 + j) * CMP_ROWS_J + 32768 + grp * 256 + n00 + 32 * rg + 16 * ch + (lane >> 3)) * 1024 + (lane & 7) * 8;
#pragma unroll
        for (int i = 0; i < 4; ++i) rp[i] = nullptr; }
    const bf16* Bg = WSP(bf16, WS_SMALLW + SW_W1T) + (size_t)(l * 2 + j) * 256 * 1024;
    f32x16 acc[4];
#pragma unroll
    for (int ct = 0; ct < 4; ++ct) acc[ct] = (f32x16){};
    const bf16* bsrc = Bg + (size_t)(tid >> 1) * 1024 + (tid & 1) * 32; LAS unsigned char* bdst = F.lds + (tid >> 1) * CG_RS + (tid & 1) * 64;
    v4u bst[2][4]; f32x4 an[4][4]; v4u anb[4][2];
    __syncthreads();
#pragma unroll
    for (int x = 0; x < 4; ++x) bst[0][x] = *(const v4u*)(bsrc + 8 * x);
#pragma unroll
    for (int x = 0; x < 4; ++x) bst[1][x] = *(const v4u*)(bsrc + 64 + 8 * x);
#pragma unroll
    for (int d = 0; d < 4; ++d) {
        if (smp) {
#pragma unroll
            for (int i = 0; i < 4; ++i) an[d][i] = __builtin_nontemporal_load((const f32x4*)(rp[i] + (size_t)d * 512)); }
        else {
#pragma unroll
            for (int i = 0; i < 2; ++i) anb[d][i] = *(const v4u*)(ab + (size_t)(8 * i) * 1024 + d * 64); } }
#pragma unroll
    for (int x = 0; x < 4; ++x) *(LAS v4u*)(bdst + x * 16) = bst[0][x];
#define CG_CHUNK(d, LAST_) { const int kc = kc4 + (d); \
            LAS unsigned char* At = F.lds + CG_AW + (((d) & 1) * 4 + rg) * CG_AT; \
            if (!(LAST_) || (d) < 2) {                                   \
                _Pragma("unroll") for (int x = 0; x < 4; ++x) bst[(d) & 1][x] = *(const v4u*)(bsrc + (kc + 2) * 64 + 8 * x); } \
            if (smp) { \
                _Pragma("unroll") for (int i = 0; i < 4; ++i) { v2u o; o.x = pk2(an[d][i][0], an[d][i][1]); o.y = pk2(an[d][i][2], an[d][i][3]); *(LAS v2u*)(At + (16 * ch + 4 * i + (lane >> 4)) * CG_RS + (lane & 15) * 8) = o; } \
                if (!(LAST_)) { _Pragma("unroll") for (int i = 0; i < 4; ++i) an[d][i] = __builtin_nontemporal_load((const f32x4*)(rp[i] + (size_t)(kc + 4) * 512)); } \
            } else { \
                _Pragma("unroll") for (int i = 0; i < 2; ++i) *(LAS v4u*)(At + (16 * ch + 8 * i + (lane >> 3)) * CG_RS + (lane & 7) * 16) = anb[d][i]; \
                if (!(LAST_)) { _Pragma("unroll") for (int i = 0; i < 2; ++i) anb[d][i] = *(const v4u*)(ab + (size_t)(8 * i) * 1024 + (kc + 4) * 64); } \
            } \
            __syncthreads();                                           \
            bf16x8 ac[4]; \
            _Pragma("unroll") for (int ks = 0; ks < 4; ++ks) ac[ks] = *(const LAS bf16x8*)(At + q * CG_RS + ks * 32 + 16 * h_); \
            const LAS unsigned char* bb = F.lds + ((d) & 1) * CG_BUF + (128 * ch + q) * CG_RS + 16 * h_; \
            _Pragma("unroll") for (int ks = 0; ks < 4; ++ks) \
                _Pragma("unroll") for (int ct = 0; ct < 4; ++ct) { const bf16x8 bf = *(const LAS bf16x8*)(bb + ct * 32 * CG_RS + ks * 32); acc[ct] = mfma32(bf, ac[ks], acc[ct]); } \
            if (!(LAST_) || (d) < 3) { _Pragma("unroll") for (int x = 0; x < 4; ++x) *(LAS v4u*)(bdst + (((d) + 1) & 1) * CG_BUF + x * 16) = bst[((d) + 1) & 1][x]; } }
    int kc4 = 0;
#pragma unroll 1
    for (; kc4 < 12; kc4 += 4) { CG_CHUNK(0, false) CG_CHUNK(1, false) CG_CHUNK(2, false) CG_CHUNK(3, false) }
    { CG_CHUNK(0, true) CG_CHUNK(1, true) CG_CHUNK(2, true) CG_CHUNK(3, true) }
#undef CG_CHUNK
    bf16* LH = WSP(bf16, WS_LH) + ((size_t)j * CMP_ROWS_J + (smp ? grp * 512 : 32768 + grp * 256) + n00 + 32 * rg + q) * 256 + 128 * ch;
#pragma unroll
    for (int ct = 0; ct < 4; ++ct)
#pragma unroll
        for (int r4 = 0; r4 < 4; ++r4) { v2u o; o.x = pk2(acc[ct][4 * r4 + 0], acc[ct][4 * r4 + 1]); o.y = pk2(acc[ct][4 * r4 + 2], acc[ct][4 * r4 + 3]); *(v2u*)(LH + ct * 32 + 8 * r4 + 4 * h_) = o; }
}

constexpr int RS_KV = 272;
__device__ __forceinline__ void ret_local_unit(Frame& F, int unit) {
    const int bh = unit >> 5, c = unit & 31, b = bh >> 2, h = bh & 3, lane = F.lane, w = F.wave;
    const float lg = ret_log_g(h);
    LAS unsigned char* KS = F.lds; LAS unsigned char* VS = F.lds + 128 * RS_KV;
    const bf16* RK = WSP(bf16, WS_RQ) + (size_t)MT * 512; const bf16* RV = WSP(bf16, WS_RQ) + (size_t)2 * MT * 512;
    __syncthreads();
#pragma unroll
    for (int i = 0; i < 4; ++i) { const int p = F.tid + NTHR * i, j = p >> 4, ch = p & 15; const size_t go = (size_t)(b * PT + 128 * c + j) * 512 + h * 128 + ch * 8;
        f32x4 k0, k1; unpack8(*(const v4u*)(RK + go), k0, k1); const float kw = fexp((float)(127 - j) * lg);
        *(LAS v4u*)(KS + j * RS_KV + ch * 16) = pack8(k0 * kw, k1 * kw);
        *(LAS v4u*)(VS + j * RS_KV + ch * 16) = *(const v4u*)(RV + go); }
    __syncthreads();
    const int et = w >> 1, dt0 = 2 * (w & 1), h_ = lane >> 5, blk = (lane >> 4) & 1;
    f32x16 acc[2]; acc[0] = (f32x16){}; acc[1] = (f32x16){};
#pragma unroll
    for (int ks = 0; ks < 8; ++ks) {
        const int rA = 16 * ks + 8 * h_;
        const bf16x8 af = tr_frag(VS, RS_KV, rA, rA + 4, 32 * et + 16 * blk, lane);
#pragma unroll
        for (int dd = 0; dd < 2; ++dd) { const bf16x8 bfr = tr_frag(KS, RS_KV, rA, rA + 4, 32 * (dt0 + dd) + 16 * blk, lane); acc[dd] = mfma32(af, bfr, acc[dd]); }
    }
    bf16* LT = WSP(bf16, WS_LT) + ((size_t)bh * 32 + c) * 16384;
#pragma unroll
    for (int dd = 0; dd < 2; ++dd)
#pragma unroll
        for (int r = 0; r < 16; ++r) { const int e = 32 * et + (r & 3) + 8 * (r >> 2) + 4 * h_; LT[e * 128 + 32 * (dt0 + dd) + (lane & 31)] = (bf16)(pk2(acc[dd][r], 0.f) & 0xffffu); }
}
__device__ __forceinline__ void ret_scan_phase(Frame& F, int l) {
    const bf16* LT = WSP(bf16, WS_LT); bf16* SPT = WSP(bf16, WS_SPT);
    for (int idx = F.bid * NTHR + F.tid; idx < 16 * 16384; idx += F.G * NTHR) {
        const int bh = idx >> 14, ed = idx & 16383, e = ed >> 7, d = ed & 127, h = bh & 3; const float g128 = fexp(128.0f * ret_log_g(h));
        float S = 0.f;
        for (int c = 0; c < 32; ++c) { const size_t o = ((size_t)bh * 32 + c) * 16384 + ed; SPT[o] = (bf16)(pk2(S, 0.f) & 0xffffu); S = S * g128 + bf1(LT[o]); }
        F.out[OUT_RET_P + ((size_t)l * 16 + bh) * 16384 + d * 128 + e] = S;
    }
}
__device__ __forceinline__ void ret_out_unit(Frame& F, int l, int unit) {
    const int bh = unit >> 5, c = unit & 31, b = bh >> 2, h = bh & 3, lane = F.lane, w = F.wave, tid = F.tid;
    const float lg = ret_log_g(h);
    LAS unsigned char* KS = F.lds; LAS unsigned char* VS = F.lds + 128 * RS_KV; LAS float* OT = (LAS float*)F.lds; LAS float* STAT = (LAS float*)(F.lds + 2 * 128 * RS_KV);
    const bf16* RQ = WSP(bf16, WS_RQ); const bf16* RK = RQ + (size_t)MT * 512; const bf16* RV = RQ + (size_t)2 * MT * 512; const bf16* RG = RQ + (size_t)3 * MT * 512;
    const size_t row0 = (size_t)b * PT + 128 * c;
    __syncthreads();
#pragma unroll
    for (int i = 0; i < 4; ++i) { const int p = tid + NTHR * i, j = p >> 4, ch = p & 15; const size_t go = (row0 + j) * 512 + h * 128 + ch * 8;
        *(LAS v4u*)(KS + j * RS_KV + ch * 16) = *(const v4u*)(RK + go); *(LAS v4u*)(VS + j * RS_KV + ch * 16) = *(const v4u*)(RV + go); }
    const int it = w & 3, eh = w >> 2, h_ = lane >> 5, blk = (lane >> 4) & 1, il = 32 * it + (lane & 31);
    bf16x8 qf[8];
#pragma unroll
    for (int ks = 0; ks < 8; ++ks) qf[ks] = *(const bf16x8*)(RQ + (row0 + il) * 512 + h * 128 + 16 * ks + 8 * h_);
    f32x16 acc[2]; acc[0] = (f32x16){}; acc[1] = (f32x16){};
    const bf16* SP = WSP(bf16, WS_SPT) + ((size_t)bh * 32 + c) * 16384;
#pragma unroll
    for (int kb4 = 0; kb4 < 8; kb4 += 4) {
        bf16x8 af[4][2];
#pragma unroll
        for (int ks = 0; ks < 4; ++ks)
#pragma unroll
            for (int e2 = 0; e2 < 2; ++e2) af[ks][e2] = *(const bf16x8*)(SP + (size_t)(32 * (2 * eh + e2) + (lane & 31)) * 128 + 16 * (kb4 + ks) + 8 * h_);
#pragma unroll
        for (int ks = 0; ks < 4; ++ks)
#pragma unroll
            for (int e2 = 0; e2 < 2; ++e2) acc[e2] = mfma32(af[ks][e2], qf[kb4 + ks], acc[e2]);
    }
    { const float cr = fexp((float)(il + 1) * lg); acc[0] *= cr; acc[1] *= cr; }
    __syncthreads();
    for (int jt = 0; jt <= it; ++jt) {
        f32x16 s = (f32x16){};
#pragma unroll
        for (int ks = 0; ks < 8; ++ks) { const bf16x8 kf = *(const LAS bf16x8*)(KS + (32 * jt + (lane & 31)) * RS_KV + (16 * ks + 8 * h_) * 2); s = mfma32(kf, qf[ks], s); }
#pragma unroll
        for (int r = 0; r < 16; ++r) { const int j = 32 * jt + (r & 3) + 8 * (r >> 2) + 4 * h_; const int df = il - j; s[r] = (df >= 0) ? s[r] * fexp((float)df * lg) : 0.f; }
#pragma unroll
        for (int s2 = 0; s2 < 2; ++s2) { const bf16x8 pf = cvt_frag(s, s2); const int rA = 32 * jt + 16 * s2 + 4 * h_;
#pragma unroll
            for (int e2 = 0; e2 < 2; ++e2) { const bf16x8 vf = tr_frag(VS, RS_KV, rA, rA + 8, 32 * (2 * eh + e2) + 16 * blk, lane); acc[e2] = mfma32(vf, pf, acc[e2]); } }
    }
    float s1 = 0.f, s2 = 0.f;
#pragma unroll
    for (int e2 = 0; e2 < 2; ++e2)
#pragma unroll
        for (int r = 0; r < 16; ++r) { const float v = acc[e2][r]; s1 += v; s2 += v * v; }
    s1 += __shfl_xor(s1, 32); s2 += __shfl_xor(s2, 32);
    if (lane < 32) { STAT[(w * 32 + lane) * 2] = s1; STAT[(w * 32 + lane) * 2 + 1] = s2; }
    __syncthreads();
    { const int pw = w ^ 4; s1 += STAT[(pw * 32 + (lane & 31)) * 2]; s2 += STAT[(pw * 32 + (lane & 31)) * 2 + 1]; }
    const float mean = s1 * (1.0f / 128.0f), var = fmaxf(s2 * (1.0f / 128.0f) - mean * mean, 0.f), rstd = 1.0f / sqrtf(var + EPS);
#pragma unroll
    for (int e2 = 0; e2 < 2; ++e2)
#pragma unroll
        for (int r4 = 0; r4 < 4; ++r4) { const int e = 32 * (2 * eh + e2) + 8 * r4 + 4 * h_;
            f32x4 v; v[0] = (acc[e2][4 * r4 + 0] - mean) * rstd; v[1] = (acc[e2][4 * r4 + 1] - mean) * rstd; v[2] = (acc[e2][4 * r4 + 2] - mean) * rstd; v[3] = (acc[e2][4 * r4 + 3] - mean) * rstd;
            *(LAS f32x4*)(OT + il * 132 + e) = v; }
    __syncthreads();
    const float* GN = FIN(I_GNG) + l * 512 + h * 128; bf16* OR_ = WSP(bf16, WS_OA) + (size_t)MT * 512;
#pragma unroll
    for (int k = 0; k < 4; ++k) { const int q = tid + NTHR * k, i = q >> 4, ch = q & 15;
        const f32x4 o0 = *(const LAS f32x4*)(OT + i * 132 + 8 * ch), o1 = *(const LAS f32x4*)(OT + i * 132 + 8 * ch + 4);
        const f32x4 g0 = *(const f32x4*)(GN + 8 * ch), g1 = *(const f32x4*)(GN + 8 * ch + 4); f32x4 r0, r1; unpack8(*(const v4u*)(RG + (row0 + i) * 512 + h * 128 + 8 * ch), r0, r1);
        f32x4 y0, y1;
#pragma unroll
        for (int x = 0; x < 4; ++x) { y0[x] = o0[x] * g0[x] * siluf_(r0[x]); y1[x] = o1[x] * g1[x] * siluf_(r1[x]); }
        *(v4u*)(OR_ + (row0 + i) * 512 + h * 128 + 8 * ch) = pack8(y0, y1); }
}
__device__ __forceinline__ void ret_sample_unit(Frame& F, int l, int unit) {
    const int db = unit >> 2, h = unit & 3, tid = F.tid, e = tid & 127, dp = tid >> 7;
    const float lg = ret_log_g(h);
    LAS float* Q = (LAS float*)F.lds; LAS float* K = Q + 1024; LAS float* V = K + 1024; LAS float* GT = V + 1024; LAS float* CR = GT + 1024;
    LAS float* SC = CR + 4096; LAS float* RED = SC + 64;
    const bf16* RQ = WSP(bf16, WS_RQ); const size_t row0 = (size_t)PM + db * 8;
    __syncthreads();
    for (int i = tid; i < 4096; i += NTHR) { const int which = i >> 10, r = (i >> 7) & 7, d = i & 127; const float v = bf1(RQ[(size_t)which * MT * 512 + (row0 + r) * 512 + h * 128 + d]); Q[which * 1024 + r * 128 + d] = v; }
    __syncthreads();
    const float* S0 = FIN(I_SRET) + (((size_t)l * SB + db) * 4 + h) * 16384; float* SN = F.out + OUT_RET_S + (((size_t)l * SB + db) * 4 + h) * 16384;
    float kwv[8], cr[8];
#pragma unroll
    for (int j = 0; j < 8; ++j) { kwv[j] = V[j * 128 + e] * fexp((float)(7 - j) * lg); cr[j] = 0.f; }
    const float g8 = fexp(8.0f * lg);
    {   float s0v[32];
#pragma unroll
        for (int dd = 0; dd < 32; ++dd) s0v[dd] = S0[(dp * 32 + dd) * 128 + e];
#pragma unroll
        for (int dd = 0; dd < 32; ++dd) { const int d = dp * 32 + dd; const float s0 = s0v[dd]; float sn = g8 * s0;
#pragma unroll
            for (int j = 0; j < 8; ++j) { cr[j] += Q[j * 128 + d] * s0; sn += K[j * 128 + d] * kwv[j]; }
            SN[d * 128 + e] = sn; }
    }
#pragma unroll
    for (int i = 0; i < 8; ++i) CR[(dp * 8 + i) * 128 + e] = cr[i];
    if (tid < 64) { const int i = tid >> 3, j = tid & 7; float s = 0.f; if (j <= i) { for (int d = 0; d < 128; ++d) s += Q[i * 128 + d] * K[j * 128 + d]; s *= fexp((float)(i - j) * lg); } SC[tid] = s; }
    __syncthreads();
    float o[2];
#pragma unroll
    for (int ii = 0; ii < 2; ++ii) { const int i = 2 * dp + ii; float x = (CR[(0 * 8 + i) * 128 + e] + CR[(1 * 8 + i) * 128 + e] + CR[(2 * 8 + i) * 128 + e] + CR[(3 * 8 + i) * 128 + e]) * fexp((float)(i + 1) * lg);
        for (int j = 0; j <= i; ++j) x += SC[i * 8 + j] * V[j * 128 + e];
        o[ii] = x; }
#pragma unroll
    for (int ii = 0; ii < 2; ++ii) { const float a = wave_sum(o[ii]), q = wave_sum(o[ii] * o[ii]); if (F.lane == 0) { RED[(F.wave * 2 + ii) * 2] = a; RED[(F.wave * 2 + ii) * 2 + 1] = q; } }
    __syncthreads();
    const float* GN = FIN(I_GNG) + l * 512 + h * 128; bf16* OR_ = WSP(bf16, WS_OA) + (size_t)MT * 512;
#pragma unroll
    for (int ii = 0; ii < 2; ++ii) { const int i = 2 * dp + ii, w0 = 2 * dp; const float s1 = RED[(w0 * 2 + ii) * 2] + RED[((w0 + 1) * 2 + ii) * 2], s2 = RED[(w0 * 2 + ii) * 2 + 1] + RED[((w0 + 1) * 2 + ii) * 2 + 1];
        const float mean = s1 * (1.0f / 128.0f), var = fmaxf(s2 * (1.0f / 128.0f) - mean * mean, 0.f), rstd = 1.0f / sqrtf(var + EPS);
        const float y = (o[ii] - mean) * rstd * GN[e] * siluf_(GT[i * 128 + e]);
        OR_[(row0 + i) * 512 + h * 128 + e] = (bf16)(pk2(y, 0.f) & 0xffffu); }
}

template <int MODE> __device__ __forceinline__ void rglru_unit(Frame& F, int l, int unit) {
    const int tid = F.tid, c = tid, lane = F.lane, w = F.wave;
    LAS bf16* XC = (LAS bf16*)F.lds; LAS float* G = (LAS float*)(F.lds + 16384);
    const int seq = (MODE == 2) ? unit : (unit >> 6), tile = (MODE == 2) ? 0 : (unit & 63);
    const size_t row0 = (MODE == 2) ? (size_t)PM + seq * 8 : (size_t)seq * PT + tile * 64;
    const int ntok = (MODE == 2) ? 8 : 64, nsub = (MODE == 2) ? 1 : 4;
    const float* RX = WSP(float, WS_RX);
    const float w0 = FIN(I_RCW)[(l * 4 + 0) * 512 + c], w1 = FIN(I_RCW)[(l * 4 + 1) * 512 + c], w2 = FIN(I_RCW)[(l * 4 + 2) * 512 + c], w3 = FIN(I_RCW)[(l * 4 + 3) * 512 + c], cb = FIN(I_RCB)[l * 512 + c];
    const float ba = FIN(I_RBA)[l * 512 + c], bx = FIN(I_RBX)[l * 512 + c], sp = WSP(float, WS_SMALLW + SW_SP)[l * 512 + c];
    float x3, x2, x1;
    if (MODE == 2) { const float* cv = FIN(I_SCONV) + ((size_t)l * SB + seq) * 3 * 512; x3 = cv[c]; x2 = cv[512 + c]; x1 = cv[1024 + c]; }
    else if (tile == 0) { x3 = 0.f; x2 = 0.f; x1 = 0.f; }
    else { x3 = RX[(row0 - 3) * 512 + c]; x2 = RX[(row0 - 2) * 512 + c]; x1 = RX[(row0 - 1) * 512 + c]; }
    float h = (MODE == 0) ? 0.f : (MODE == 1) ? WSP(float, WS_CAR)[(size_t)4 * 64 * 2 * 512 + ((size_t)seq * 64 + tile) * 512 + c] : FIN(I_SH)[((size_t)l * SB + seq) * 512 + c];
    float aprod = 1.f;
    const int r16 = lane & 15, g4 = lane >> 4;
    bf16x8 wa[4][2], wx[4][2];
    { const bf16* WA = WSP(bf16, WS_SMALLW + SW_WAT) + ((size_t)(l * 2 + 0) * 8 + w) * 4096; const bf16* WX = WSP(bf16, WS_SMALLW + SW_WAT) + ((size_t)(l * 2 + 1) * 8 + w) * 4096;
#pragma unroll
      for (int ct = 0; ct < 4; ++ct)
#pragma unroll
          for (int ks = 0; ks < 2; ++ks) { wa[ct][ks] = *(const bf16x8*)(WA + (16 * ct + r16) * 64 + 32 * ks + 8 * g4); wx[ct][ks] = *(const bf16x8*)(WX + (16 * ct + r16) * 64 + 32 * ks + 8 * g4); } }
    const bf16* GG = WSP(bf16, WS_GG); bf16* OC = WSP(bf16, WS_OA) + (size_t)2 * MT * 512;
    __syncthreads();
    float xn[16]; bf16 gn[16];
#pragma unroll
    for (int tt = 0; tt < 16; ++tt) { xn[tt] = (tt < ntok) ? RX[(row0 + tt) * 512 + c] : 0.f; gn[tt] = (MODE != 0 && tt < ntok) ? GG[(row0 + tt) * 512 + c] : (bf16)0; }
    for (int s = 0; s < nsub; ++s) {
        float xc[16], gg[16];
#pragma unroll
        for (int tt = 0; tt < 16; ++tt) { xc[tt] = xn[tt]; gg[tt] = bf1(gn[tt]); }
        if (s + 1 < nsub) {
#pragma unroll
            for (int tt = 0; tt < 16; ++tt) { const int t = (s + 1) * 16 + tt; xn[tt] = RX[(row0 + t) * 512 + c]; gn[tt] = (MODE != 0) ? GG[(row0 + t) * 512 + c] : (bf16)0; } }
#pragma unroll
        for (int tt = 0; tt < 16; ++tt) { const float x0 = xc[tt];
            xc[tt] = cb + w0 * x3 + w1 * x2 + w2 * x1 + w3 * x0; x3 = x2; x2 = x1; x1 = x0; XC[tt * 512 + c] = (bf16)(pk2(xc[tt], 0.f) & 0xffffu); }
        LDS_WAIT(); asm volatile("" ::: "memory");
        {
            bf16x8 xf[2];
#pragma unroll
            for (int ks = 0; ks < 2; ++ks) xf[ks] = *(const LAS bf16x8*)(XC + r16 * 512 + w * 64 + 32 * ks + 8 * g4);
#pragma unroll
            for (int ct = 0; ct < 4; ++ct) { f32x4 da = (f32x4){0.f, 0.f, 0.f, 0.f}, dx = da;
#pragma unroll
                for (int ks = 0; ks < 2; ++ks) { da = mfma16(wa[ct][ks], xf[ks], da); dx = mfma16(wx[ct][ks], xf[ks], dx); }
                *(LAS f32x4*)(G + r16 * 512 + w * 64 + 16 * ct + 4 * g4) = da; *(LAS f32x4*)(G + 8192 + r16 * 512 + w * 64 + 16 * ct + 4 * g4) = dx; }
        }
        LDS_WAIT(); asm volatile("" ::: "memory");
#pragma unroll
        for (int tt = 0; tt < 16; ++tt) { const int t = s * 16 + tt;
            if (t < ntok) {
                const float r = sigmoidf_(G[tt * 512 + c] + ba), ig = sigmoidf_(G[8192 + tt * 512 + c] + bx);
                const float la = -8.0f * r * sp, a = fexp(la), bt = sqrtf(fmaxf(1.0f - a * a, 0.f)) * (ig * xc[tt]);
                h = a * h + bt; aprod *= a;
                if (MODE != 0) { const size_t o = (row0 + t) * 512 + c; OC[o] = (bf16)(pk2(h * gg[tt], 0.f) & 0xffffu); }
            } }
    }
    if (MODE == 0) { float* CAR = WSP(float, WS_CAR) + ((size_t)seq * 64 + tile) * 1024; CAR[c] = aprod; CAR[512 + c] = h; }
    if (MODE == 2) F.out[OUT_H_S + ((size_t)l * SB + seq) * 512 + c] = h;
}
__device__ __forceinline__ void rglru_carry_phase(Frame& F, int l) {
    const float* CAR = WSP(float, WS_CAR); float* HIN = WSP(float, WS_CAR) + (size_t)4 * 64 * 2 * 512;
    for (int idx = F.bid * NTHR + F.tid; idx < PB * 512; idx += F.G * NTHR) {
        const int b = idx >> 9, c = idx & 511; float h = 0.f;
#pragma unroll 1
        for (int t0 = 0; t0 < 64; t0 += 32) {
            float ca[32], cb[32];
#pragma unroll
            for (int t = 0; t < 32; ++t) { const float* cr = CAR + ((size_t)b * 64 + t0 + t) * 1024; ca[t] = cr[c]; cb[t] = cr[512 + c]; }
#pragma unroll
            for (int t = 0; t < 32; ++t) { HIN[((size_t)b * 64 + t0 + t) * 512 + c] = h; h = ca[t] * h + cb[t]; }
        }
        F.out[OUT_H_P + ((size_t)l * PB + b) * 512 + c] = h;
    }
}

__device__ __forceinline__ void convact_phase(Frame& F, int l) {
    const bf16* GP = WSP(bf16, WS_GP); const bf16* VAL = GP + (size_t)MT * DFF; bf16* ACT = WSP(bf16, WS_GP) + (size_t)2 * MT * DFF;
    const float* CW = FIN(I_FCW) + (size_t)l * 3 * DFF; const float* CBI = FIN(I_FCB) + (size_t)l * DFF;
    constexpr int NPR = PB * 15, NRUN = NPR + SB, NCG = DFF / 8;
    for (int it = F.bid * NTHR + F.tid; it < NRUN * NCG; it += F.G * NTHR) {
        const int run = it / NCG, cg = it % NCG, c = cg * 8;
        const bool isp = run < NPR; const size_t row0 = isp ? (size_t)(run / 15) * PT + 256 * (run % 15 + 1) : (size_t)PM + (run - NPR) * 8; const int nt = isp ? 2 : 8;
        f32x4 p2a, p2b, p1a, p1b;
        if (isp) { unpack8(*(const v4u*)(GP + (row0 - 2) * DFF + c), p2a, p2b); unpack8(*(const v4u*)(GP + (row0 - 1) * DFF + c), p1a, p1b); }
        else { const float* st = FIN(I_SFFN) + (((size_t)l * SB + (run - NPR)) * 2) * DFF + c; p2a = *(const f32x4*)st; p2b = *(const f32x4*)(st + 4); p1a = *(const f32x4*)(st + DFF); p1b = *(const f32x4*)(st + DFF + 4); }
        const f32x4 w0a = *(const f32x4*)(CW + c), w0b = *(const f32x4*)(CW + c + 4), w1a = *(const f32x4*)(CW + DFF + c), w1b = *(const f32x4*)(CW + DFF + c + 4), w2a = *(const f32x4*)(CW + 2 * DFF + c), w2b = *(const f32x4*)(CW + 2 * DFF + c + 4);
        const f32x4 ba = *(const f32x4*)(CBI + c), bb = *(const f32x4*)(CBI + c + 4);
        v4u gx[8], vx[8];
#pragma unroll
        for (int k = 0; k < 8; ++k) if (k < nt) { gx[k] = *(const v4u*)(GP + (row0 + k) * DFF + c); vx[k] = *(const v4u*)(VAL + (row0 + k) * DFF + c); }
#pragma unroll
        for (int k = 0; k < 8; ++k) if (k < nt) {
            f32x4 xa, xb, va, vb; unpack8(gx[k], xa, xb); unpack8(vx[k], va, vb);
            f32x4 ya = ba + w0a * p2a + w1a * p1a + w2a * xa, yb = bb + w0b * p2b + w1b * p1b + w2b * xb;
#pragma unroll
            for (int i = 0; i < 4; ++i) { ya[i] = siluf_(ya[i]) * va[i]; yb[i] = siluf_(yb[i]) * vb[i]; }
            *(v4u*)(ACT + (row0 + k) * DFF + c) = pack8(ya, yb);
            p2a = p1a; p2b = p1b; p1a = xa; p1b = xb;
        }
    }
}

constexpr int AT_RS = 144;
constexpr int AT_K0 = 0, AT_V0 = 2 * 64 * AT_RS, AT_PS = 4 * 64 * AT_RS, AT_IMP = AT_PS + 69632, AT_MASK = AT_IMP + 6144, AT_LIST = AT_MASK + 2048, AT_NL = AT_LIST + 1024;
constexpr unsigned AT_MARK = 0xFFFFu;
static_assert(AT_NL + 64 <= RING_BYTES, "attention LDS map");

struct TileRegs { v4u a, b, c, d; int mode; };

template <bool SMP> __device__ __forceinline__ void at_prefetch(const Frame& F, int l, int seq, int kvh, unsigned e, TileRegs& R) {
    const int kind = (int)(e >> 14), ti = (int)(e & 0x3fffu), rr = F.tid >> 3, pc = F.tid & 7;
    R.mode = 0;
    if (kind < 2) {
        const size_t rb = SMP ? (size_t)(seq * 2 + kvh) * 512 : (size_t)32768 + (size_t)(seq * 2 + kvh) * 256;
        const bf16* ck = WSP(bf16, WS_CK) + (rb + ti * 64 + rr) * 64 + pc * 8;
        R.a = *(const v4u*)ck; R.c = *(const v4u*)(ck + (size_t)CMP_ROWS_J * 64);
    } else if (!SMP) {
        const int jb = (kind == 2) ? 0 : 2;
        const bf16* kp = WSP(bf16, WS_KVB) + ((((size_t)jb * PB + seq) * 2 + kvh) * PT + ti * 64 + rr) * 64 + pc * 8;
        R.a = *(const v4u*)kp; R.c = *(const v4u*)(kp + (size_t)PB * 2 * PT * 64);
    } else if (kind == 2) {
        if (ti < 128) {
            const int page = ((const int*)F.a->in[I_PT])[seq * NPG + (ti >> 1)], slot = (ti & 1) * 64 + rr;
            const float* kp = FIN(I_CACHE) + (((((size_t)l * NPHYS + page) * PAGE + slot) * 4 + 2) * 2 + kvh) * 64 + pc * 8;
            R.a = *(const v4u*)kp; R.b = *(const v4u*)(kp + 4); R.c = *(const v4u*)(kp + 128); R.d = *(const v4u*)(kp + 132); R.mode = 1;
        } else if (rr < ST) {
            const bf16* kp = WSP(bf16, WS_KVS) + ((((size_t)0 * SB + seq) * 2 + kvh) * ST + rr) * 64 + pc * 8;
            R.a = *(const v4u*)kp; R.c = *(const v4u*)(kp + (size_t)SB * 2 * ST * 64);
        } else R.mode = 2;
    } else {
        if (ti < 8) {
            const float* kp = FIN(I_CWIN) + (((((size_t)l * SB + seq) * WINB + ti * 64 + rr) * 2 + 0) * 2 + kvh) * 64 + pc * 8;
            R.a = *(const v4u*)kp; R.b = *(const v4u*)(kp + 4); R.c = *(const v4u*)(kp + 128); R.d = *(const v4u*)(kp + 132); R.mode = 1;
        } else if (rr < ST) {
            const bf16* kp = WSP(bf16, WS_KVS) + ((((size_t)2 * SB + seq) * 2 + kvh) * ST + rr) * 64 + pc * 8;
            R.a = *(const v4u*)kp; R.c = *(const v4u*)(kp + (size_t)SB * 2 * ST * 64);
        } else R.mode = 2;
    }
}
__device__ __forceinline__ void at_store(const Frame& F, int buf, const TileRegs& R) {
    const int rr = F.tid >> 3, pc = F.tid & 7; v4u k, v;
    if (R.mode == 0) { k = R.a; v = R.c; }
    else if (R.mode == 1) { k = pack8(__builtin_bit_cast(f32x4, R.a), __builtin_bit_cast(f32x4, R.b)); v = pack8(__builtin_bit_cast(f32x4, R.c), __builtin_bit_cast(f32x4, R.d)); }
    else { k = (v4u){0u, 0u, 0u, 0u}; v = k; }
    *(LAS v4u*)(F.lds + AT_K0 + buf * 64 * AT_RS + rr * AT_RS + pc * 16) = k;
    *(LAS v4u*)(F.lds + AT_V0 + buf * 64 * AT_RS + rr * AT_RS + pc * 16) = v;
}

template <bool SMP> __device__ __forceinline__ void attn_unit(Frame& F, int l, int unit) {
    const int tid = F.tid, lane = F.lane, w = F.wave;
    const int q = lane & 31, h_ = lane >> 5, blk = (lane >> 4) & 1, tl = q >> 2, hr = q & 3;
    int seq, kvh, qt;
    if (SMP) { seq = unit >> 1; kvh = unit & 1; qt = 128; } else { seq = unit >> 7; kvh = (unit >> 6) & 1; qt = unit & 63; }
    const int t0 = SMP ? PAST : qt * 64;
    const int tokl = SMP ? tl : 8 * w + tl, t = t0 + tokl;
    const size_t row = SMP ? (size_t)PM + seq * ST + tl : (size_t)seq * PT + t;
    const int head = kvh * 4 + hr;
    LAS float* PS = (LAS float*)(F.lds + AT_PS); LAS float* IMPw = (LAS float*)(F.lds + AT_IMP) + w * 192;
    LAS unsigned long long* MASKS = (LAS unsigned long long*)(F.lds + AT_MASK); LAS unsigned short* LIST = (LAS unsigned short*)(F.lds + AT_LIST); LAS int* NL = (LAS int*)(F.lds + AT_NL);
    constexpr int PSS = SMP ? 520 : 264;
    LAS float* PSw = SMP ? PS : PS + w * 8 * PSS;
    __syncthreads();
    bf16x8 qf[4];
    { const bf16* qp = WSP(bf16, WS_QN) + row * 512 + head * 64 + 8 * h_;
#pragma unroll
      for (int kk = 0; kk < 4; ++kk) qf[kk] = *(const bf16x8*)(qp + 16 * kk); }
    const float* ngp = WSP(float, WS_NG) + row * 24 + head * 3; const float g0 = ngp[0], g1 = ngp[1], g2 = ngp[2];
    if (!SMP) { for (int i = lane; i < 8 * PSS; i += 64) PSw[i] = 0.f; }
    const int ntc = SMP ? 8 : ((t0 + 32) >> 10) + 1;
    if (tid < 2 * ntc) LIST[tid] = (unsigned short)(((tid >= ntc ? 1u : 0u) << 14) | (unsigned)(tid >= ntc ? tid - ntc : tid));
    if (tid == 0) LIST[2 * ntc] = (unsigned short)AT_MARK;
    int nl = 2 * ntc + 1;
    TileRegs R;
    at_prefetch<SMP>(F, l, seq, kvh, (unsigned)0, R);
    at_store(F, 0, R);
    __syncthreads();
    float m = -INFINITY, lsum = 0.f, invden = 0.f;
    f32x16 O[2]; O[0] = (f32x16){}; O[1] = (f32x16){};
    LAS float* OAw = (LAS float*)(F.lds + AT_PS) + w * (SMP ? 2048 : 8 * PSS) + lane;
    unsigned long long mk0 = 0ull, mk1 = 0ull, wu = ~0ull;
    int cur_kind = -1, idx = 0;
#define AT_FINALIZE(kind) do { \
        if ((kind) == 0) { const float lt = lsum + __shfl_xor(lsum, 32); invden = lt > 0.f ? 1.0f / lt : 0.f; } \
        else if ((kind) == 1) { const float sc = g0 * invden; O[0] *= sc; O[1] *= sc; } \
        else if ((kind) == 2) { const float lt = lsum + __shfl_xor(lsum, 32); const float sc = (lt > 0.f ? 1.0f / lt : 0.f) * g1; \
            _Pragma("unroll") for (int r_ = 0; r_ < 16; ++r_) { OAw[r_ * 64] += O[0][r_] * sc; OAw[(16 + r_) * 64] += O[1][r_] * sc; } } } while (0)
    while (idx < nl) {
        const unsigned e = (unsigned)__builtin_amdgcn_readfirstlane((int)LIST[idx]);
        if (e == AT_MARK) {
            AT_FINALIZE(cur_kind); cur_kind = -1;
            LDS_WAIT(); asm volatile("" ::: "memory");
#pragma unroll 1
            for (int tk = 0; tk < 8; ++tk) {
                const LAS float* pr = PSw + tk * PSS;
                if (!SMP) {
                    const int s = lane; float imp = 0.f;
#pragma unroll
                    for (int n = 4 * s - 1; n <= 4 * s + 3; ++n) if (n >= 0) imp += pr[n];
                    const bool forced = (s == 0) || (s == qt) || (s == qt - 1), avail = s <= qt;
                    const float val = avail ? (forced ? 1e4f : imp) : -1e4f;
                    IMPw[s] = val; LDS_WAIT(); asm volatile("" ::: "memory");
                    int rank = 0;
#pragma unroll 8
                    for (int i = 0; i < 64; ++i) { const float v = IMPw[i]; rank += (v > val || (v == val && i < s)) ? 1 : 0; }
                    const unsigned long long mk = __ballot(rank < 16);
                    if (lane == 0) MASKS[(8 * w + tk) * 4] = mk;
                    LDS_WAIT(); asm volatile("" ::: "memory");
                } else {
                    const int sa = lane, sb = lane + 64; float ia = 0.f, ib = 0.f;
#pragma unroll
                    for (int n = 4 * sa - 1; n <= 4 * sa + 3; ++n) if (n >= 0) ia += pr[n];
#pragma unroll
                    for (int n = 4 * sb - 1; n <= 4 * sb + 3; ++n) ib += pr[n];
                    const bool fa = (sa == 0), fb = (sb == 127);
                    const float va = fa ? 1e4f : ia, vb = fb ? 1e4f : ib;
                    IMPw[sa] = va; IMPw[sb] = vb; LDS_WAIT(); asm volatile("" ::: "memory");
                    int ra = fa ? 0 : 1, rb = fb ? 0 : 1;
#pragma unroll 8
                    for (int i = 0; i < 128; ++i) { const float v = IMPw[i]; ra += (v > va || (v == va && i < sa)) ? 1 : 0; rb += (v > vb || (v == vb && i < sb)) ? 1 : 0; }
                    const unsigned long long ma = __ballot(ra < 16), mb = __ballot(rb < 16);
                    if (lane == 0) { MASKS[tk * 4] = ma; MASKS[tk * 4 + 1] = mb; MASKS[tk * 4 + 2] = 1ull; }
                    LDS_WAIT(); asm volatile("" ::: "memory");
                }
            }
            __syncthreads();
#pragma unroll
            for (int r_ = 0; r_ < 16; ++r_) { OAw[r_ * 64] = O[0][r_]; OAw[(16 + r_) * 64] = O[1][r_]; }
            if (tid == 0) {
                int n = idx + 1;
                if (!SMP) { unsigned long long U = 0ull; for (int i = 0; i < 64; ++i) U |= MASKS[i * 4];
                    for (int s = 0; s <= qt; ++s) if ((U >> s) & 1ull) LIST[n++] = (unsigned short)((2u << 14) | (unsigned)s);
                    for (int s = (qt > 8 ? qt - 8 : 0); s <= qt; ++s) LIST[n++] = (unsigned short)((3u << 14) | (unsigned)s);
                } else { unsigned long long U0 = 0ull, U1 = 0ull; for (int i = 0; i < 8; ++i) { U0 |= MASKS[i * 4]; U1 |= MASKS[i * 4 + 1]; }
                    for (int s = 0; s < 64; ++s) if ((U0 >> s) & 1ull) LIST[n++] = (unsigned short)((2u << 14) | (unsigned)s);
                    for (int s = 0; s < 64; ++s) if ((U1 >> s) & 1ull) LIST[n++] = (unsigned short)((2u << 14) | (unsigned)(64 + s));
                    LIST[n++] = (unsigned short)((2u << 14) | 128u);
                    for (int s = 0; s <= 8; ++s) LIST[n++] = (unsigned short)((3u << 14) | (unsigned)s); }
                NL[0] = n;
            }
            __syncthreads();
            nl = __builtin_amdgcn_readfirstlane(NL[0]);
            mk0 = MASKS[tokl * 4]; if (SMP) { mk1 = MASKS[tokl * 4 + 1]; }
            if (!SMP) { unsigned long long u = 0ull; for (int i = 0; i < 8; ++i) u |= MASKS[(8 * w + i) * 4]; wu = u; }
            if (idx + 1 < nl) { at_prefetch<SMP>(F, l, seq, kvh, (unsigned)LIST[idx + 1], R); at_store(F, (idx + 1) & 1, R); }
            __syncthreads();
            ++idx; continue;
        }
        const int kind = (int)(e >> 14), ti = (int)(e & 0x3fffu);
        if (kind != cur_kind) {
            if (cur_kind >= 0) AT_FINALIZE(cur_kind);
            if (kind != 1) m = -INFINITY;
            lsum = 0.f; O[0] = (f32x16){}; O[1] = (f32x16){}; cur_kind = kind;
        }
        const unsigned en = (idx + 1 < nl) ? (unsigned)__builtin_amdgcn_readfirstlane((int)LIST[idx + 1]) : AT_MARK;
        const bool have_next = (en != AT_MARK);
        if (have_next) at_prefetch<SMP>(F, l, seq, kvh, en, R);
        bool active = true;
        if (!SMP && kind == 2) active = ((wu >> ti) & 1ull) != 0ull;
        if (active) {
            const LAS unsigned char* Kb = F.lds + AT_K0 + (idx & 1) * 64 * AT_RS; const LAS unsigned char* Vb = F.lds + AT_V0 + (idx & 1) * 64 * AT_RS;
            int lo, hi; const int kb = 64 * ti;
            if (kind < 2) { lo = 0; hi = SMP ? 510 : ((t >= 31) ? ((t - 31) >> 4) : -1); }
            else if (kind == 2) { lo = 0; const unsigned long long mw = (ti < 64) ? mk0 : ((ti < 128) ? mk1 : 1ull); hi = ((mw >> (ti & 63)) & 1ull) ? t : -1; }
            else { if (SMP) { lo = tl; hi = WINB + tl; } else { lo = t - WINB; hi = t; } }
            f32x16 s0 = (f32x16){}, s1 = (f32x16){};
#pragma unroll
            for (int kk = 0; kk < 4; ++kk) {
                const bf16x8 k0 = *(const LAS bf16x8*)(Kb + q * AT_RS + (16 * kk + 8 * h_) * 2), k1 = *(const LAS bf16x8*)(Kb + (32 + q) * AT_RS + (16 * kk + 8 * h_) * 2);
                s0 = mfma32(k0, qf[kk], s0); s1 = mfma32(k1, qf[kk], s1);
            }
            float tmax = -INFINITY;
#pragma unroll
            for (int r = 0; r < 16; ++r) { const int key = kb + (r & 3) + 8 * (r >> 2) + 4 * h_;
                s0[r] = (key >= lo && key <= hi) ? s0[r] : -INFINITY; s1[r] = (key + 32 >= lo && key + 32 <= hi) ? s1[r] : -INFINITY;
                tmax = fmaxf(tmax, fmaxf(s0[r], s1[r])); }
            tmax = fmaxf(tmax, __shfl_xor(tmax, 32));
            const float m_new = fmaxf(m, tmax), m_use = (m_new == -INFINITY) ? 0.f : m_new;
            const float alpha = fexp2(m - m_use);
            float ps = 0.f;
#pragma unroll
            for (int r = 0; r < 16; ++r) { s0[r] = fexp2(s0[r] - m_use); s1[r] = fexp2(s1[r] - m_use); ps += s0[r] + s1[r]; }
            lsum = lsum * alpha + ps; m = m_new;
            if (kind != 0) {
                O[0] *= alpha; O[1] *= alpha;
#pragma unroll
                for (int kt2 = 0; kt2 < 2; ++kt2)
#pragma unroll
                    for (int s2 = 0; s2 < 2; ++s2) { const bf16x8 pf = cvt_frag(kt2 ? s1 : s0, s2); const int rA = 32 * kt2 + 16 * s2 + 4 * h_;
#pragma unroll
                        for (int dt = 0; dt < 2; ++dt) { const bf16x8 vf = tr_frag(Vb, AT_RS, rA, rA + 8, 32 * dt + 16 * blk, lane); O[dt] = mfma32(vf, pf, O[dt]); } }
            }
            if (kind == 1) {
#pragma unroll
                for (int r = 0; r < 16; ++r) { const int n = kb + (r & 3) + 8 * (r >> 2) + 4 * h_;
                    float a = s0[r] * invden, b = s1[r] * invden; a += __shfl_xor(a, 1); b += __shfl_xor(b, 1); a += __shfl_xor(a, 2); b += __shfl_xor(b, 2);
                    if (hr == 0) { PSw[tl * PSS + n] = a; PSw[tl * PSS + n + 32] = b; } }
            }
        }
        if (have_next) at_store(F, (idx + 1) & 1, R);
        __syncthreads();
        ++idx;
    }
#undef AT_FINALIZE
    {
        const float lt = lsum + __shfl_xor(lsum, 32); const float sc = (lt > 0.f ? 1.0f / lt : 0.f) * g2;
        if (!SMP || w == 0) {
            bf16* op = WSP(bf16, WS_OA) + row * 512 + head * 64;
#pragma unroll
            for (int dt = 0; dt < 2; ++dt)
#pragma unroll
                for (int r4 = 0; r4 < 4; ++r4) { float o_[4];
#pragma unroll
                    for (int x = 0; x < 4; ++x) o_[x] = OAw[(dt * 16 + 4 * r4 + x) * 64] + O[dt][4 * r4 + x] * sc;
                    v2u wv; wv.x = pk2(o_[0], o_[1]); wv.y = pk2(o_[2], o_[3]); *(v2u*)(op + 32 * dt + 8 * r4 + 4 * h_) = wv; }
        }
    }
}

constexpr int AS_RS = 144;
constexpr int AS_V = 0, AS_VW = 32 * AS_RS, AS_MRG = 0, AS_PS = 73728, AS_IMP = AS_PS + 16640, AS_MASK = AS_IMP + 6144;
static_assert(8 * 34 * 64 * 4 <= AS_PS && AS_MASK + 512 <= RING_BYTES, "sample attention LDS map");

__device__ __forceinline__ float xhalf_max(float x) { auto t_ = __builtin_amdgcn_permlane32_swap(__float_as_uint(x), __float_as_uint(x), false, false); return fmaxf(__uint_as_float(t_[0]), __uint_as_float(t_[1])); }
__device__ __forceinline__ float xhalf_sum(float x) { auto t_ = __builtin_amdgcn_permlane32_swap(__float_as_uint(x), __float_as_uint(x), false, false); return __uint_as_float(t_[0]) + __uint_as_float(t_[1]); }
struct ASrc { const float* kf; const float* vf; const bf16* kb; const bf16* vb; int rs; int nvalid; };
#define AS_TILE(SRC, KB0, LO_, HI_, DO_PV, DO_PS, m, lsum, O0, O1, invden, PSS_) do { \
        bf16x8 kfr[4]; \
        if ((SRC).kb) { const bf16* kp_ = (SRC).kb + (size_t)q * (SRC).rs + 8 * h_; _Pragma("unroll") for (int kk = 0; kk < 4; ++kk) kfr[kk] = *(const bf16x8*)(kp_ + 16 * kk); } \
        else { const float* kp_ = (SRC).kf + (size_t)q * (SRC).rs + 8 * h_; _Pragma("unroll") for (int kk = 0; kk < 4; ++kk) { const f32x4 a_ = *(const f32x4*)(kp_ + 16 * kk), b_ = *(const f32x4*)(kp_ + 16 * kk + 4); kfr[kk] = __builtin_bit_cast(bf16x8, pack8(a_, b_)); } } \
        if (DO_PV) { const int vr_ = lane >> 1, vh_ = lane & 1; v4u vv_[4]; \
            if (vr_ >= (SRC).nvalid) { _Pragma("unroll") for (int x = 0; x < 4; ++x) vv_[x] = (v4u){0u, 0u, 0u, 0u}; } \
            else if ((SRC).vb) { const bf16* vp_ = (SRC).vb + (size_t)vr_ * (SRC).rs + 32 * vh_; _Pragma("unroll") for (int x = 0; x < 4; ++x) vv_[x] = *(const v4u*)(vp_ + 8 * x); } \
            else { const float* vp_ = (SRC).vf + (size_t)vr_ * (SRC).rs + 32 * vh_; _Pragma("unroll") for (int x = 0; x < 4; ++x) vv_[x] = pack8(*(const f32x4*)(vp_ + 8 * x), *(const f32x4*)(vp_ + 8 * x + 4)); } \
            _Pragma("unroll") for (int x = 0; x < 4; ++x) *(LAS v4u*)(Vw + vr_ * AS_RS + vh_ * 64 + x * 16) = vv_[x]; } \
        f32x16 s_ = (f32x16){}; \
        _Pragma("unroll") for (int kk = 0; kk < 4; ++kk) s_ = mfma32(kfr[kk], qf[kk], s_); \
        float tmax_ = -INFINITY; \
        _Pragma("unroll") for (int r = 0; r < 16; ++r) { const int key_ = (KB0) + (r & 3) + 8 * (r >> 2) + 4 * h_; s_[r] = (key_ >= (LO_) && key_ <= (HI_)) ? s_[r] : -INFINITY; tmax_ = fmaxf(tmax_, s_[r]); } \
        tmax_ = xhalf_max(tmax_); \
        const float mn_ = fmaxf(m, tmax_), mu_ = (mn_ == -INFINITY) ? 0.f : mn_, al_ = fexp2(m - mu_); float ps_ = 0.f; \
        _Pragma("unroll") for (int r = 0; r < 16; ++r) { s_[r] = fexp2(s_[r] - mu_); ps_ += s_[r]; } \
        lsum = lsum * al_ + ps_; m = mn_; \
        if (DO_PV) { O0 *= al_; O1 *= al_; LDS_WAIT(); asm volatile("" ::: "memory"); \
            _Pragma("unroll") for (int s2 = 0; s2 < 2; ++s2) { const bf16x8 pf_ = cvt_frag(s_, s2); const int rA_ = 16 * s2 + 4 * h_; \
                O0 = mfma32(tr_frag(Vw, AS_RS, rA_, rA_ + 8, 16 * blk, lane), pf_, O0); O1 = mfma32(tr_frag(Vw, AS_RS, rA_, rA_ + 8, 32 + 16 * blk, lane), pf_, O1); } \
            LDS_WAIT(); asm volatile("" ::: "memory"); } \
        if (DO_PS) { _Pragma("unroll") for (int r = 0; r < 16; ++r) { const int n_ = (KB0) + (r & 3) + 8 * (r >> 2) + 4 * h_; float a_ = s_[r] * (invden); a_ += __shfl_xor(a_, 1); a_ += __shfl_xor(a_, 2); if (hr == 0) PS[tl * (PSS_) + n_] = a_; } } \
    } while (0)

__device__ __forceinline__ void attn_sample_unit(Frame& F, int l, int unit) {
    const int lane = F.lane, w = F.wave, tid = F.tid;
    const int q = lane & 31, h_ = lane >> 5, blk = (lane >> 4) & 1, tl = q >> 2, hr = q & 3;
    const int seq = unit >> 1, kvh = unit & 1, head = kvh * 4 + hr;
    const size_t row = (size_t)PM + seq * ST + tl;
    LAS unsigned char* Vw = F.lds + AS_V + w * AS_VW;
    LAS float* MRG = (LAS float*)(F.lds + AS_MRG);
    LAS float* PS = (LAS float*)(F.lds + AS_PS);
    LAS float* IMPw = (LAS float*)(F.lds + AS_IMP) + w * 192;
    LAS unsigned long long* MASKS = (LAS unsigned long long*)(F.lds + AS_MASK);
    __syncthreads();
    bf16x8 qf[4];
    { const bf16* qp = WSP(bf16, WS_QN) + row * 512 + head * 64 + 8 * h_;
#pragma unroll
      for (int kk = 0; kk < 4; ++kk) qf[kk] = *(const bf16x8*)(qp + 16 * kk); }
    const float* ngp = WSP(float, WS_NG) + row * 24 + head * 3; const float g0 = ngp[0], g1 = ngp[1], g2 = ngp[2];
    const int* ptab = (const int*)F.a->in[I_PT] + seq * NPG;
    f32x16 OA0 = (f32x16){}, OA1 = (f32x16){};

#define AS_PUBLISH(m, lsum, O0, O1) do { __syncthreads(); LAS float* mp_ = MRG + w * 34 * 64 + lane; mp_[0] = m; mp_[64] = lsum; \
        _Pragma("unroll") for (int r = 0; r < 16; ++r) { mp_[(2 + r) * 64] = O0[r]; mp_[(18 + r) * 64] = O1[r]; } __syncthreads(); } while (0)

    const bf16* CKk = WSP(bf16, WS_CK) + ((size_t)(seq * 2 + kvh) * 512) * 64; const bf16* CKv = CKk + (size_t)CMP_ROWS_J * 64;
    float mC = -INFINITY, lC = 0.f; f32x16 D0 = (f32x16){}, D1 = (f32x16){};
#pragma unroll 1
    for (int ti = w; ti < 16; ti += 8) { ASrc S{nullptr, nullptr, CKk + (size_t)ti * 32 * 64, CKv + (size_t)ti * 32 * 64, 64, 32}; AS_TILE(S, ti * 32, 0, 510, false, false, mC, lC, D0, D1, 0.f, 520); }
    { __syncthreads(); MRG[w * 128 + lane] = mC; MRG[w * 128 + 64 + lane] = xhalf_sum(lC); __syncthreads(); }
    float mT = -INFINITY;
#pragma unroll
    for (int x = 0; x < 8; ++x) mT = fmaxf(mT, MRG[x * 128 + lane]);
    float lT = 0.f;
#pragma unroll
    for (int x = 0; x < 8; ++x) { const float mx_ = MRG[x * 128 + lane]; lT += (mx_ == -INFINITY) ? 0.f : MRG[x * 128 + 64 + lane] * fexp2(mx_ - mT); }
    const float invC = lT > 0.f ? 1.0f / lT : 0.f;
    __syncthreads();
    { float mB = mT, lB = 0.f;
#pragma unroll 1
      for (int ti = w; ti < 16; ti += 8) { ASrc S{nullptr, nullptr, CKk + (size_t)ti * 32 * 64, CKv + (size_t)ti * 32 * 64, 64, 32}; AS_TILE(S, ti * 32, 0, 510, true, true, mB, lB, D0, D1, invC, 520); }
      AS_PUBLISH(mB, lB, D0, D1); }
    { const float sc = g0 * invC;
#pragma unroll 1
      for (int x = 0; x < 8; ++x) { const LAS float* mp = MRG + x * 34 * 64 + lane;
#pragma unroll
          for (int r = 0; r < 16; ++r) { OA0[r] += mp[(2 + r) * 64] * sc; OA1[r] += mp[(18 + r) * 64] * sc; } } }
    {
        const LAS float* pr = PS + w * 520; const int sa = lane, sb = lane + 64; float ia = 0.f, ib = 0.f;
#pragma unroll
        for (int n = 4 * sa - 1; n <= 4 * sa + 3; ++n) if (n >= 0) ia += pr[n];
#pragma unroll
        for (int n = 4 * sb - 1; n <= 4 * sb + 3; ++n) ib += pr[n];
        const bool fa = (sa == 0), fb = (sb == 127); const float va = fa ? 1e4f : ia, vb = fb ? 1e4f : ib;
        IMPw[sa] = va; IMPw[sb] = vb; LDS_WAIT(); asm volatile("" ::: "memory");
        int ra = fa ? 0 : 1, rb = fb ? 0 : 1;
#pragma unroll 8
        for (int i = 0; i < 128; ++i) { const float v = IMPw[i]; ra += (v > va || (v == va && i < sa)) ? 1 : 0; rb += (v > vb || (v == vb && i < sb)) ? 1 : 0; }
        const unsigned long long ma = __ballot(ra < 16), mb = __ballot(rb < 16);
        if (lane == 0) { MASKS[w * 4] = ma; MASKS[w * 4 + 1] = mb; }
    }
    __syncthreads();
    const unsigned long long mk0 = MASKS[tl * 4], mk1 = MASKS[tl * 4 + 1];
    unsigned long long U0 = 0ull, U1 = 0ull;
#pragma unroll
    for (int x = 0; x < 8; ++x) { U0 |= MASKS[x * 4]; U1 |= MASKS[x * 4 + 1]; }
    {
        float m = -INFINITY, ls = 0.f; D0 = (f32x16){}; D1 = (f32x16){};
        const int t = PAST + tl; int cnt = 0;
#pragma unroll 1
        for (int s = 0; s <= 128; ++s) {
            const bool in_u = (s < 64) ? ((U0 >> s) & 1ull) : ((s < 128) ? ((U1 >> (s - 64)) & 1ull) : true);
            if (!in_u) continue;
            const bool selb = (s < 64) ? ((mk0 >> s) & 1ull) : ((s < 128) ? ((mk1 >> (s - 64)) & 1ull) : true);
            const int nh = (s < 128) ? 2 : 1;
            for (int hf = 0; hf < nh; ++hf, ++cnt) {
                if ((cnt & 7) != w) continue;
                const int hi = selb ? t : -1;
                if (s < 128) { const int page = ptab[s >> 1], slot = (s & 1) * 64 + hf * 32;
                    const float* kp = FIN(I_CACHE) + (((((size_t)l * NPHYS + page) * PAGE + slot) * 4 + 2) * 2 + kvh) * 64;
                    ASrc S{kp, kp + 128, nullptr, nullptr, 512, 32}; AS_TILE(S, s * 64 + hf * 32, 0, hi, true, false, m, ls, D0, D1, 0.f, 520); }
                else { const bf16* kp = WSP(bf16, WS_KVS) + ((((size_t)0 * SB + seq) * 2 + kvh) * ST) * 64;
                    ASrc S{nullptr, nullptr, kp, kp + (size_t)SB * 2 * ST * 64, 64, ST}; AS_TILE(S, PAST, 0, hi, true, false, m, ls, D0, D1, 0.f, 520); }
            }
        }
        AS_PUBLISH(m, ls, D0, D1);
        float mt = -INFINITY;
#pragma unroll
        for (int x = 0; x < 8; ++x) mt = fmaxf(mt, MRG[x * 34 * 64 + lane]);
        float lt = 0.f; f32x16 T0 = (f32x16){}, T1 = (f32x16){};
#pragma unroll 1
        for (int x = 0; x < 8; ++x) { const LAS float* mp = MRG + x * 34 * 64 + lane; const float mx_ = mp[0]; const float f = (mx_ == -INFINITY) ? 0.f : fexp2(mx_ - mt); lt += mp[64] * f;
#pragma unroll
            for (int r = 0; r < 16; ++r) { T0[r] += mp[(2 + r) * 64] * f; T1[r] += mp[(18 + r) * 64] * f; } }
        lt = xhalf_sum(lt); const float sc = (lt > 0.f ? 1.0f / lt : 0.f) * g1; OA0 += T0 * sc; OA1 += T1 * sc;
    }
    {
        float m = -INFINITY, ls = 0.f; D0 = (f32x16){}; D1 = (f32x16){};
#pragma unroll 1
        for (int ti = w; ti < 17; ti += 8) {
            if (ti < 16) { const float* kp = FIN(I_CWIN) + (((((size_t)l * SB + seq) * WINB + ti * 32) * 2 + 0) * 2 + kvh) * 64;
                ASrc S{kp, kp + 128, nullptr, nullptr, 256, 32}; AS_TILE(S, ti * 32, tl, WINB + tl, true, false, m, ls, D0, D1, 0.f, 520); }
            else { const bf16* kp = WSP(bf16, WS_KVS) + ((((size_t)2 * SB + seq) * 2 + kvh) * ST) * 64;
                ASrc S{nullptr, nullptr, kp, kp + (size_t)SB * 2 * ST * 64, 64, ST}; AS_TILE(S, WINB, tl, WINB + tl, true, false, m, ls, D0, D1, 0.f, 520); }
        }
        AS_PUBLISH(m, ls, D0, D1);
        float mt = -INFINITY;
#pragma unroll
        for (int x = 0; x < 8; ++x) mt = fmaxf(mt, MRG[x * 34 * 64 + lane]);
        float lt = 0.f; f32x16 T0 = (f32x16){}, T1 = (f32x16){};
#pragma unroll 1
        for (int x = 0; x < 8; ++x) { const LAS float* mp = MRG + x * 34 * 64 + lane; const float mx_ = mp[0]; const float f = (mx_ == -INFINITY) ? 0.f : fexp2(mx_ - mt); lt += mp[64] * f;
#pragma unroll
            for (int r = 0; r < 16; ++r) { T0[r] += mp[(2 + r) * 64] * f; T1[r] += mp[(18 + r) * 64] * f; } }
        lt = xhalf_sum(lt); const float sc = (lt > 0.f ? 1.0f / lt : 0.f) * g2; OA0 += T0 * sc; OA1 += T1 * sc;
    }
#undef AS_PUBLISH
    if (w == 0) {
        bf16* op = WSP(bf16, WS_OA) + row * 512 + head * 64;
#pragma unroll
        for (int r4 = 0; r4 < 4; ++r4) { v2u a, b; a.x = pk2(OA0[4 * r4 + 0], OA0[4 * r4 + 1]); a.y = pk2(OA0[4 * r4 + 2], OA0[4 * r4 + 3]); b.x = pk2(OA1[4 * r4 + 0], OA1[4 * r4 + 1]); b.y = pk2(OA1[4 * r4 + 2], OA1[4 * r4 + 3]);
            *(v2u*)(op + 8 * r4 + 4 * h_) = a; *(v2u*)(op + 32 + 8 * r4 + 4 * h_) = b; }
    }
}

#ifndef DBG_DUP
#define DBG_DUP 0
#endif
#if DBG_DUP == 1
#define AP_DUP_QK(NK) { f32x16 d_ = (f32x16){}; _Pragma("unroll") for (int kk = 0; kk < 4; ++kk) d_ = mfma32(NK[kk], qf[(kk + 1) & 3], d_); _Pragma("unroll") for (int r = 0; r < 16; ++r) s_[r] += zf * d_[r]; }
#else
#define AP_DUP_QK(NK)
#endif
#if DBG_DUP == 2
#define AP_DUP_EXP() { float acc_ = 0.f; _Pragma("unroll") for (int r = 0; r < 16; ++r) acc_ += fexp2(s_[r] * 0.5f - 3.0f); lsum += zf * acc_; }
#else
#define AP_DUP_EXP()
#endif
#if DBG_DUP == 3
#define AP_DUP_PV() { f32x16 e0_ = (f32x16){}, e1_ = (f32x16){}; _Pragma("unroll") for (int s2 = 0; s2 < 2; ++s2) { const bf16x8 pf_ = cvt_frag(s_, 1 - s2); const int rA_ = 16 * s2 + 4 * h_; \
        e0_ = mfma32(tr_frag(Vw, AS_RS, rA_ + 8, rA_, 16 * blk, lane), pf_, e0_); e1_ = mfma32(tr_frag(Vw, AS_RS, rA_ + 8, rA_, 32 + 16 * blk, lane), pf_, e1_); } D0 += e0_ * zf; D1 += e1_ * zf; }
#else
#define AP_DUP_PV()
#endif
constexpr int AP_WS = 14336, AP_V = 0, AP_PS = 4608, AP_IMP = AP_PS + 8 * 264 * 4, AP_MASK = AP_IMP + 256, AP_LIST = AP_MASK + 64;
static_assert(AP_LIST + 2 * 192 <= AP_WS && 8 * AP_WS <= RING_BYTES, "prompt attention LDS map");
__device__ __forceinline__ void attn_prompt_unit(Frame& F, int l, int unit) {
    const int lane = F.lane, w = F.wave;
    const int q = lane & 31, h_ = lane >> 5, blk = (lane >> 4) & 1, tl = q >> 2, hr = q & 3;
    const int seq = unit >> 7, kvh = (unit >> 6) & 1, qt = unit & 63, head = kvh * 4 + hr;
    const int t0w = qt * 64 + 8 * w, t = t0w + tl; const size_t row = (size_t)seq * PT + t;
    LAS unsigned char* Vw = F.lds + w * AP_WS + AP_V; LAS float* PS = (LAS float*)(F.lds + w * AP_WS + AP_PS); LAS float* IMPw = (LAS float*)(F.lds + w * AP_WS + AP_IMP);
    LAS unsigned long long* MASKS = (LAS unsigned long long*)(F.lds + w * AP_WS + AP_MASK); LAS unsigned short* LIST = (LAS unsigned short*)(F.lds + w * AP_WS + AP_LIST);
    __syncthreads();
    bf16x8 qf[4];
    { const bf16* qp = WSP(bf16, WS_QN) + row * 512 + head * 64 + 8 * h_;
#pragma unroll
      for (int kk = 0; kk < 4; ++kk) qf[kk] = *(const bf16x8*)(qp + 16 * kk); }
    const float* ngp = WSP(float, WS_NG) + row * 24 + head * 3; const float g0 = ngp[0], g1 = ngp[1], g2 = ngp[2];
    for (int i = lane; i < 8 * 264; i += 64) PS[i] = 0.f;
    const bf16* CKk = WSP(bf16, WS_CK) + ((size_t)32768 + (seq * 2 + kvh) * 256) * 64; const bf16* CKv = CKk + (size_t)CMP_ROWS_J * 64;
    const bf16* KS = WSP(bf16, WS_KVB) + ((((size_t)0 * PB + seq) * 2 + kvh) * PT) * 64; const bf16* VS = KS + (size_t)PB * 2 * PT * 64;
    const bf16* KW = KS + (size_t)2 * PB * 2 * PT * 64; const bf16* VW = KW + (size_t)PB * 2 * PT * 64;
    const int hiCmin = (t0w >= 31) ? ((t0w - 31) >> 4) : -1;
    const int hiC = (t >= 31) ? ((t - 31) >> 4) : -1; const int nmaxw = (t0w + 7 >= 31) ? ((t0w + 7 - 31) >> 4) : -1; const int ntc = (nmaxw >= 0) ? (nmaxw >> 5) + 1 : 0;
    f32x16 D0 = (f32x16){}, D1 = (f32x16){};
    LAS float* OAG = PS + lane;
    float m = -INFINITY, lsum = 0.f, invC = 0.f; unsigned long long mk0 = 0ull;
    const float zf = (F.G == 12345) ? 1.0f : 0.0f;
    bf16x8 nk0[4]; v4u nv0[4], nv1[4];
#define AP_LOADK(e_, NK) do { const int kd_ = (int)((e_) >> 12), ti_ = (int)((e_) & 0xfffu); const bf16* kb_ = (kd_ < 2 ? CKk : (kd_ == 2 ? KS : KW)) + (size_t)ti_ * 32 * 64; \
        const int ko_ = kd_ < 2 ? q * 64 + 8 * h_ : lane * 8, ks_ = kd_ < 2 ? 16 : 512;     \
        _Pragma("unroll") for (int kk = 0; kk < 4; ++kk) NK[kk] = *(const bf16x8*)(kb_ + ko_ + ks_ * kk); } while (0)
#define AP_LOADV(e_, NV) do { const int kd_ = (int)((e_) >> 12), ti_ = (int)((e_) & 0xfffu); const bf16* vb_ = (kd_ < 2 ? CKv : (kd_ == 2 ? VS : VW)) + (size_t)ti_ * 32 * 64; \
        _Pragma("unroll") for (int x = 0; x < 4; ++x) NV[x] = *(const v4u*)(vb_ + 512 * x + lane * 8); } while (0)
#define AP_LOADT(e_, NK, NV) do { AP_LOADK(e_, NK); AP_LOADV(e_, NV); } while (0)
#define AP_STEP(i_, n_, NK, NV, NVN, EC, ECN) do { \
        const unsigned e_ = EC; const int kind = (int)(e_ >> 12), ti = (int)(e_ & 0xfffu); \
        if (kind == 1) { _Pragma("unroll") for (int x = 0; x < 4; ++x) *(LAS v4u*)(Vw + (8 * x + (lane >> 3)) * AS_RS + (lane & 7) * 16) = NV[x]; }     \
        f32x16 s_ = (f32x16){}; \
        _Pragma("unroll") for (int kk = 0; kk < 4; ++kk) s_ = mfma32(NK[kk], qf[kk], s_); \
        AP_DUP_QK(NK) \
          \
        if ((i_) + 1 < (n_)) { AP_LOADK(ECN, NK); AP_LOADV(ECN, NVN); if ((i_) + 2 < (n_)) EC = (unsigned)__builtin_amdgcn_readfirstlane((int)LIST[(i_) + 2]); } \
        if (kind != cur_kind) { \
            if (cur_kind == 0) { const float lt_ = xhalf_sum(lsum); invC = lt_ > 0.f ? 1.0f / lt_ : 0.f; } \
            else if (cur_kind == 2) { const float lt_ = xhalf_sum(lsum); const float sc_ = (lt_ > 0.f ? 1.0f / lt_ : 0.f) * g1; \
                _Pragma("unroll") for (int r = 0; r < 16; ++r) { OAG[r * 64] += D0[r] * sc_; OAG[(16 + r) * 64] += D1[r] * sc_; } } \
            if (kind != 1) m = -INFINITY; lsum = 0.f; D0 = (f32x16){}; D1 = (f32x16){}; cur_kind = kind; } \
        const int kb = ti * 32; int lo, hi; \
        if (kind < 2) { lo = 0; hi = hiC; } else if (kind == 2) { lo = 0; hi = ((mk0 >> (ti >> 1)) & 1ull) ? t : -1; } else { lo = t - WINB; hi = t; } \
          \
        const bool interior = (kind < 2) ? (hiCmin >= 0 && kb + 31 <= hiCmin) : ((kind == 2) ? (kb + 31 <= t0w) : (kb >= t0w + 7 - WINB && kb + 31 <= t0w)); \
        float tmax_ = -INFINITY, mu_, mn_; \
        if (interior) { const bool on_ = hi >= 0; \
            _Pragma("unroll") for (int r = 0; r < 16; ++r) tmax_ = fmaxf(tmax_, s_[r]); \
            tmax_ = on_ ? tmax_ : -INFINITY; tmax_ = xhalf_max(tmax_); \
            mn_ = fmaxf(m, tmax_); mu_ = (mn_ == -INFINITY) ? 0.f : mn_; const float mr_ = on_ ? mu_ : INFINITY; \
            _Pragma("unroll") for (int r = 0; r < 16; ++r) s_[r] = fexp2(s_[r] - mr_); \
        } else { \
            _Pragma("unroll") for (int r = 0; r < 16; ++r) { const int key_ = kb + (r & 3) + 8 * (r >> 2) + 4 * h_; s_[r] = (key_ >= lo && key_ <= hi) ? s_[r] : -INFINITY; tmax_ = fmaxf(tmax_, s_[r]); } \
            tmax_ = xhalf_max(tmax_); \
            mn_ = fmaxf(m, tmax_); mu_ = (mn_ == -INFINITY) ? 0.f : mn_; \
            _Pragma("unroll") for (int r = 0; r < 16; ++r) s_[r] = fexp2(s_[r] - mu_); \
        } \
        AP_DUP_EXP() \
        const float al_ = fexp2(m - mu_); float ps_ = 0.f; \
        _Pragma("unroll") for (int r = 0; r < 16; ++r) ps_ += s_[r]; \
        lsum = lsum * al_ + ps_; m = mn_; \
        if (kind >= 2) { if (__ballot(al_ != 1.0f) != 0ull) { D0 *= al_; D1 *= al_; } \
            const bf16x8 pf0_ = cvt_frag(s_, 0), pf1_ = cvt_frag(s_, 1); \
            D0 = mfma32(__builtin_bit_cast(bf16x8, NV[0]), pf0_, D0); D1 = mfma32(__builtin_bit_cast(bf16x8, NV[2]), pf0_, D1); D0 = mfma32(__builtin_bit_cast(bf16x8, NV[1]), pf1_, D0); D1 = mfma32(__builtin_bit_cast(bf16x8, NV[3]), pf1_, D1); \
        } else if (kind == 1) { if (__ballot(al_ != 1.0f) != 0ull) { D0 *= al_; D1 *= al_; } asm volatile("" ::: "memory");   \
            { const bf16x8 va0_ = tr_frag(Vw, AS_RS, 4 * h_, 4 * h_ + 8, 16 * blk, lane), va1_ = tr_frag(Vw, AS_RS, 4 * h_, 4 * h_ + 8, 32 + 16 * blk, lane), \
                           vb0_ = tr_frag(Vw, AS_RS, 16 + 4 * h_, 24 + 4 * h_, 16 * blk, lane), vb1_ = tr_frag(Vw, AS_RS, 16 + 4 * h_, 24 + 4 * h_, 32 + 16 * blk, lane);   \
              const bf16x8 pf0_ = cvt_frag(s_, 0), pf1_ = cvt_frag(s_, 1); \
              D0 = mfma32(va0_, pf0_, D0); D1 = mfma32(va1_, pf0_, D1); D0 = mfma32(vb0_, pf1_, D0); D1 = mfma32(vb1_, pf1_, D1); } \
            AP_DUP_PV() \
            asm volatile("" ::: "memory"); } \
        if (kind == 1) { _Pragma("unroll") for (int r = 0; r < 16; ++r) { const int n2_ = kb + (r & 3) + 8 * (r >> 2) + 4 * h_; float a_ = s_[r] * invC; a_ += __shfl_xor(a_, 1); a_ += __shfl_xor(a_, 2); if (hr == 0) PS[tl * 264 + n2_] = a_; } } \
    } while (0)
#define AP_RUN(N_) do { const int n_ = (N_); unsigned ec0_ = 0u, ec1_ = 0u;                  \
      if (n_ > 0) { ec0_ = (unsigned)__builtin_amdgcn_readfirstlane((int)LIST[0]); AP_LOADK(ec0_, nk0); AP_LOADV(ec0_, nv0); } \
      if (n_ > 1) { ec1_ = (unsigned)__builtin_amdgcn_readfirstlane((int)LIST[1]); } \
      _Pragma("unroll 1") for (int i_ = 0; i_ < n_; i_ += 2) { AP_STEP(i_, n_, nk0, nv0, nv1, ec0_, ec1_); if (i_ + 1 < n_) AP_STEP(i_ + 1, n_, nk0, nv1, nv0, ec1_, ec0_); } } while (0)
    int cur_kind = -1;
    if (lane < 2 * ntc) LIST[lane] = (unsigned short)(((lane >= ntc ? 1u : 0u) << 12) | (unsigned)(lane >= ntc ? lane - ntc : lane));
    LDS_WAIT(); asm volatile("" ::: "memory");
    AP_RUN(2 * ntc);
    { const float sc = (cur_kind == 1) ? g0 * invC : 0.f; D0 *= sc; D1 *= sc; }
    LDS_WAIT(); asm volatile("" ::: "memory");
#pragma unroll 1
    for (int tk = 0; tk < 8; ++tk) {
        const LAS float* pr = PS + tk * 264; const int s = lane; float imp = 0.f;
#pragma unroll
        for (int n = 4 * s - 1; n <= 4 * s + 3; ++n) if (n >= 0) imp += pr[n];
        const bool forced = (s == 0) || (s == qt) || (s == qt - 1), avail = s <= qt;
        const unsigned key = avail ? (forced ? 0x7fffffffu : (imp > 0.f ? __float_as_uint(imp) + 1u : 1u)) : 0u;
        unsigned thr = 0u;
#pragma unroll
        for (int bit = 30; bit >= 0; --bit) { const unsigned cand = thr | (1u << bit); const int cnt = __popcll(__ballot(key >= cand)); thr = (cnt >= 16) ? cand : thr; }
        const unsigned long long gt = __ballot(key > thr), eq = __ballot(key == thr); const int need = 16 - __popcll(gt);
        const int below = __builtin_amdgcn_mbcnt_hi((unsigned)(eq >> 32), __builtin_amdgcn_mbcnt_lo((unsigned)eq, 0u));
        const unsigned long long mk = gt | __ballot(key == thr && below < need);
        if (lane == 0) MASKS[tk] = mk;
        LDS_WAIT(); asm volatile("" ::: "memory");
    }
#pragma unroll
    for (int r = 0; r < 16; ++r) { OAG[r * 64] = D0[r]; OAG[(16 + r) * 64] = D1[r]; }
    mk0 = MASKS[tl]; unsigned long long wu = 0ull;
#pragma unroll
    for (int i = 0; i < 8; ++i) wu |= MASKS[i];
    wu &= (qt >= 63) ? ~0ull : ((1ull << (qt + 1)) - 1ull);
    const int nsel = 2 * __popcll(wu); const int tiLo = (t0w > WINB) ? ((t0w - WINB) >> 5) : 0, tiHi = (t0w + 7) >> 5, nwin = tiHi - tiLo + 1;
    if ((wu >> lane) & 1ull) { const int pos = 2 * __popcll(wu & ((1ull << lane) - 1ull)); LIST[pos] = (unsigned short)((2u << 12) | (unsigned)(2 * lane)); LIST[pos + 1] = (unsigned short)((2u << 12) | (unsigned)(2 * lane + 1)); }
    if (lane < nwin) LIST[nsel + lane] = (unsigned short)((3u << 12) | (unsigned)(tiLo + lane));
    LDS_WAIT(); asm volatile("" ::: "memory");
#ifdef DBG_COUNT
    if (lane == 0) { unsigned* CNT = (unsigned*)(F.ws + WS_CTL) + 3000; atomicAdd(CNT + 0, (unsigned)nsel); atomicAdd(CNT + 1, (unsigned)nwin); atomicAdd(CNT + 2, (unsigned)(2 * ntc)); atomicAdd(CNT + 3, 1u); }
#endif
    cur_kind = -1;
    AP_RUN(nsel + nwin);
    const float ltw = xhalf_sum(lsum); const float scw = (ltw > 0.f ? 1.0f / ltw : 0.f) * g2;
#undef AP_RUN
#undef AP_STEP
#undef AP_LOADT
#undef AP_LOADK
#undef AP_LOADV
    {
        bf16* op = WSP(bf16, WS_OA) + row * 512 + head * 64;
#pragma unroll
        for (int r4 = 0; r4 < 4; ++r4) { float a_[4], b_[4];
#pragma unroll
            for (int x = 0; x < 4; ++x) { a_[x] = OAG[(4 * r4 + x) * 64] + D0[4 * r4 + x] * scw; b_[x] = OAG[(16 + 4 * r4 + x) * 64] + D1[4 * r4 + x] * scw; }
            v2u a, b; a.x = pk2(a_[0], a_[1]); a.y = pk2(a_[2], a_[3]); b.x = pk2(b_[0], b_[1]); b.y = pk2(b_[2], b_[3]);
            *(v2u*)(op + 8 * r4 + 4 * h_) = a; *(v2u*)(op + 32 + 8 * r4 + 4 * h_) = b; }
    }
}
#undef AS_TILE

#ifdef DBG_CHECK
__device__ __forceinline__ unsigned dbg_rand(unsigned x) { x ^= x >> 16; x *= 0x7feb352du; x ^= x >> 15; x *= 0x846ca68bu; x ^= x >> 16; return x; }
__device__ __forceinline__ bool dbg_bad(float got, float exp_, float rtol, float atol) { return !(fabsf(got - exp_) <= rtol * fabsf(exp_) + atol); }
__device__ __forceinline__ float bfr(float x) { return __uint_as_float(pk2(x, 0.f) << 16); }
__device__ __forceinline__ int dbg_row(unsigned r) { const unsigned k = r % 20u; if (k == 0) return (int)(PM + (r >> 8) % SM); if (k == 1) return (int)(((r >> 8) % PB) * PT + ((r >> 12) % 8)); if (k == 2) return (int)(((r >> 8) % PB) * PT + PT - 1 - ((r >> 12) % 8)); return (int)((r >> 5) % PM); }
__device__ __forceinline__ float dbg_rs(const Frame& F, int row, int lane) { const float* xr = xrow_in(F, 0, row); float ss = 0.f; for (int d = lane; d < DM; d += 64) ss += xr[d] * xr[d]; return 1.0f / sqrtf(wave_sum(ss) * (1.0f / DM) + EPS); }
__device__ __forceinline__ float dbg_h(const Frame& F, int row, int d, float rs) { const float* mod = WSP(float, WS_MOD) + (size_t)row_bb(row) * 6144; return bfr(xrow_in(F, 0, row)[d] * rs * FIN(I_N1G)[d] * (1.0f + mod[1024 + d]) + mod[d]); }

__device__ __forceinline__ void dbg_check_phase(Frame& F) {
    const int gw = F.bid * NWAVES + F.wave, NGW = F.G * NWAVES, lane = F.lane;
    unsigned* CNT = (unsigned*)(F.ws + WS_CTL) + 3000;
    LAS float* L = (LAS float*)(F.lds + F.wave * 16384);
#define DBG_FLAG(ch, cond) do { if (__any(cond) && lane == 0) atomicAdd(CNT + (ch), 1u); } while (0)
    for (int s = gw; s < 1536; s += NGW) {
        const unsigned r = dbg_rand(1000u + s); const int row = dbg_row(r); const float rs = dbg_rs(F, row, lane); const int kind = s % 6;
        const bool isp = row < PM; const int b = isp ? (row >> 12) : ((row - PM) >> 3), t = isp ? (row & (PT - 1)) : ((row - PM) & 7);
#define DBG_U(col, dst) do { float a_ = 0.f; for (int d_ = lane; d_ < DM; d_ += 64) a_ += dbg_h(F, row, d_, rs) * bfr(FIN(I_WIN)[(size_t)d_ * D_IN + (col)]); dst = wave_sum(a_); } while (0)
        if (kind == 0) {
            const int c = (r >> 3) % 768, j = c >> 7, k = (c >> 6) & 1, dd = c & 63; float u; DBG_U(O_NKV + c, u); bool bad = false;
            if (j < 4) bad = dbg_bad(F.out[(isp ? OUT_ROWS_P + (size_t)row * 512 : OUT_ROWS_S + (size_t)(row - PM) * 512) + c], u, 0.01f, 0.01f);
            else if (isp) { if (t >= PT - WINB) bad = dbg_bad(F.out[OUT_WIN_P + ((size_t)b * WINB + (t - (PT - WINB))) * 256 + (c - 512)], u, 0.01f, 0.01f); }
            else bad = dbg_bad(F.out[OUT_WIN_S + ((size_t)b * WINB + (WINB - ST) + t) * 256 + (c - 512)], u, 0.01f, 0.01f);
            if (isp) { if (j < 2) bad = bad || dbg_bad(bf1(WSP(bf16, WS_ACMP)[((size_t)j * CMP_ROWS_J + 32768 + (b * 2 + k) * 256 + (t >> 4)) * 1024 + (t & 15) * 64 + dd]), u, 0.01f, 0.01f);
                       else bad = bad || dbg_bad(bf1(WSP(bf16, WS_KVB)[((((size_t)(j - 2) * PB + b) * 2 + k) * PT + t) * 64 + dd]), u, 0.01f, 0.01f); }
            else if (j >= 2) bad = bad || dbg_bad(bf1(WSP(bf16, WS_KVS)[((((size_t)(j - 2) * SB + b) * 2 + k) * ST + t) * 64 + dd]), u, 0.01f, 0.01f);
            DBG_FLAG(0, bad);
        } else if (kind == 1) {
            const int gi = (r >> 3) % 24, c5 = (r >> 8) % 512, cm = (r >> 8) % 3072; float u0, u1, u2, u3; DBG_U(O_NG + gi, u0); DBG_U(O_RX + c5, u1); DBG_U(O_RGATE + c5, u2); DBG_U(O_MG + cm, u3);
            bool bad = dbg_bad(WSP(float, WS_NG)[(size_t)row * 24 + gi], 1.0f / (1.0f + expf(-u0)), 0.01f, 0.005f);
            bad = bad || dbg_bad(WSP(float, WS_RX)[(size_t)row * 512 + c5], u1, 0.01f, 0.01f);
            bad = bad || dbg_bad(bf1(WSP(bf16, WS_GG)[(size_t)row * 512 + c5]), gelu_tanh(u2), 0.02f, 0.01f);
            bad = bad || dbg_bad(bf1(WSP(bf16, WS_MGS)[(size_t)row * 3072 + cm]), 1.0f / (1.0f + expf(-u3)), 0.01f, 0.005f);
            DBG_FLAG(1, bad);
        } else if (kind == 2) {
            const int head = (r >> 13) % 4, dim = (r >> 16) % 64, c5 = (r >> 3) % 512; float x1, x2, uv, ug, uq; DBG_U(O_RQ + head * 128 + dim, x1); DBG_U(O_RQ + head * 128 + 64 + dim, x2); DBG_U(O_RV + c5, uv); DBG_U(O_RG + c5, ug); DBG_U(O_NQ + c5, uq);
            const float pos = (float)(isp ? t : PAST + t); const float ang = pos * (float)pow(10000.0, -(double)dim / 64.0); float sn, cs; sincos_acc(ang, sn, cs);
            const bf16* RQ = WSP(bf16, WS_RQ);
            bool bad = dbg_bad(bf1(RQ[(size_t)row * 512 + head * 128 + dim]), x1 * cs - x2 * sn, 0.02f, 0.02f) || dbg_bad(bf1(RQ[(size_t)row * 512 + head * 128 + 64 + dim]), x1 * sn + x2 * cs, 0.02f, 0.02f);
            bad = bad || dbg_bad(bf1(RQ[(size_t)2 * MT * 512 + (size_t)row * 512 + c5]), uv, 0.01f, 0.01f) || dbg_bad(bf1(RQ[(size_t)3 * MT * 512 + (size_t)row * 512 + c5]), ug, 0.01f, 0.01f);
            bad = bad || dbg_bad(bf1(WSP(bf16, WS_QN)[(size_t)row * 512 + c5]), uq * QSCALE, 0.01f, 0.005f);
            DBG_FLAG(2, bad);
        }
#undef DBG_U
    }
    for (int s = gw; s < 128; s += NGW) {
        const unsigned r = dbg_rand(3000u + s); const int j = r & 1; const bool smp = ((r >> 1) & 3) != 0;
        const int grp = smp ? (int)((r >> 3) % 64) : (int)((r >> 3) % 8), nmax = smp ? 511 : 255; int n = (r >> 10) % nmax; if (((r >> 20) & 7) == 0) n = nmax - 1;
        const size_t rj = smp ? (size_t)grp * 512 + n : (size_t)32768 + grp * 256 + n;
        const bf16* A = WSP(bf16, WS_ACMP) + ((size_t)j * CMP_ROWS_J + rj) * 1024;
        const float* w1 = FIN(I_W1) + (size_t)j * 2048 * 128; const float* pe = FIN(I_PE) + j * 2048;
        for (int hh = 0; hh < 2; ++hh) { const int h = lane + 64 * hh; float a = FIN(I_B1)[j * 128 + h];
            for (int i = 0; i < 1024; ++i) a += (bf1(A[i]) + pe[i]) * w1[(size_t)i * 128 + h] + (bf1(A[1024 + i]) + pe[1024 + i]) * w1[(size_t)(1024 + i) * 128 + h];
            L[h] = gelu_tanh(a); }
        LDS_WAIT(); asm volatile("" ::: "memory");
        float o = 0.f; for (int h = 0; h < 128; ++h) o += L[h] * FIN(I_W2)[((size_t)j * 128 + h) * 64 + lane];
        const float got = bf1(WSP(bf16, WS_CK)[((size_t)j * CMP_ROWS_J + rj) * 64 + lane]);
        { const bool bd = dbg_bad(got, o, 0.05f, 0.03f); const unsigned long long mk = __ballot(bd); if (lane == 0 && mk) atomicAdd(CNT + 3, (unsigned)__popcll(mk)); }
        LDS_WAIT(); asm volatile("" ::: "memory");
    }
    for (int s = gw; s < 128; s += NGW) {
        const unsigned r = dbg_rand(3500u + s); const int j = r & 1; const bool smp = ((r >> 1) & 3) != 0;
        const int grp = smp ? (int)((r >> 3) % 64) : (int)((r >> 3) % 8), nmax = smp ? 511 : 255; const int n = (r >> 10) % nmax;
        const size_t rj = smp ? (size_t)grp * 512 + n : (size_t)32768 + grp * 256 + n, row = (size_t)j * CMP_ROWS_J + rj;
        const bf16* A = WSP(bf16, WS_ACMP) + row * 1024; const float* w1 = FIN(I_W1) + (size_t)j * 2048 * 128; const bf16* LH = WSP(bf16, WS_LH);
        unsigned nb = 0;
        for (int hh = 0; hh < 2; ++hh) { const int h = lane + 64 * hh; float lo = 0.f, hi = 0.f;
            for (int i = 0; i < 1024; ++i) { const float av = bf1(A[i]); lo += av * bfr(w1[(size_t)i * 128 + h]); hi += av * bfr(w1[(size_t)(1024 + i) * 128 + h]); }
            const bool bd = dbg_bad(bf1(LH[row * 256 + h]), lo, 0.02f, 0.02f) || dbg_bad(bf1(LH[row * 256 + 128 + h]), hi, 0.02f, 0.02f); nb += (unsigned)__popcll(__ballot(bd)); }
        if (lane == 0 && nb) atomicAdd(CNT + 9, nb);
        for (int hh = 0; hh < 2; ++hh) { const int h = lane + 64 * hh; L[h] = gelu_tanh(bf1(LH[row * 256 + h]) + bf1(LH[(row + 1) * 256 + 128 + h]) + WSP(float, WS_SMALLW + SW_CB)[j * 128 + h]); }
        LDS_WAIT(); asm volatile("" ::: "memory");
        float o = 0.f; for (int h = 0; h < 128; ++h) o += bfr(L[h]) * bfr(FIN(I_W2)[((size_t)j * 128 + h) * 64 + lane]);
        { const bool bd = dbg_bad(bf1(WSP(bf16, WS_CK)[row * 64 + lane]), o, 0.03f, 0.01f); const unsigned long long mk = __ballot(bd); if (lane == 0 && mk) atomicAdd(CNT + 11, (unsigned)__popcll(mk)); }
        LDS_WAIT(); asm volatile("" ::: "memory");
    }
    for (int s = gw; s < 64; s += NGW) {
        const unsigned r = dbg_rand(3700u + s); const int j = r & 1, half = (r >> 1) & 1, h = (r >> 2) % 128; const bf16* W1T = WSP(bf16, WS_SMALLW + SW_W1T) + ((size_t)j * 256 + half * 128 + h) * 1024;
        const float* w1 = FIN(I_W1) + ((size_t)j * 32 + half * 16) * 64 * 128 + h; unsigned nb = 0;
        for (int k = lane; k < 1024; k += 64) nb += (unsigned)__popcll(__ballot(dbg_bad(bf1(W1T[k]), w1[(size_t)k * 128], 0.01f, 0.0001f)));
        if (lane == 0 && nb) atomicAdd(CNT + 12, nb);
        const bool smp = ((r >> 9) & 3) != 0; const int grp = smp ? (int)((r >> 11) % 64) : (int)((r >> 11) % 8), n = (r >> 17) % (smp ? 511 : 255);
        const size_t row = (size_t)j * CMP_ROWS_J + (smp ? (size_t)grp * 512 + n : (size_t)32768 + grp * 256 + n); const bf16* A = WSP(bf16, WS_ACMP) + row * 1024;
        float a = 0.f; for (int k = lane; k < 1024; k += 64) a += bf1(A[k]) * bf1(W1T[k]); a = wave_sum(a);
        DBG_FLAG(13, dbg_bad(bf1(WSP(bf16, WS_LH)[row * 256 + half * 128 + h]), a, 0.02f, 0.02f));
    }
    for (int s = gw; s < 4; s += NGW) {
        const int j = s >> 1, h = (s & 1) * 64 + lane; const float* w1 = FIN(I_W1) + (size_t)j * 2048 * 128; const float* pe = FIN(I_PE) + j * 2048;
        float a = FIN(I_B1)[j * 128 + h]; for (int i = 0; i < 2048; ++i) a += pe[i] * w1[(size_t)i * 128 + h];
        const unsigned long long mk = __ballot(dbg_bad(WSP(float, WS_SMALLW + SW_CB)[j * 128 + h], a, 0.001f, 0.0005f)); if (lane == 0 && mk) atomicAdd(CNT + 10, (unsigned)__popcll(mk));
    }
    for (int s = gw; s < 96; s += NGW) {
        const unsigned r = dbg_rand(4000u + s); const bool smp = (s % 3) == 2;
        int seq, kvh = (r >> 4) & 1, t, tl = 0; size_t row;
        if (smp) { seq = (r >> 5) % SB; tl = (r >> 10) % ST; t = PAST + tl; row = (size_t)PM + seq * ST + tl; }
        else { seq = (r >> 5) % PB; const unsigned k = (r >> 8) % 8u; t = (k == 0) ? (int)((r >> 12) % 40) : (k == 1) ? PT - 1 - (int)((r >> 12) % 70) : (int)((r >> 12) % PT); row = (size_t)seq * PT + t; }
        const int N = smp ? 511 : 255, NS = smp ? 129 : 64, cur = t >> 6;
        LAS float* Q = L; LAS float* SC = L + 256; LAS float* PSUM = L + 256 + 2048; LAS float* OUT = L + 256 + 2048 + 512;
        for (int i = lane; i < 256; i += 64) Q[i] = bf1(WSP(bf16, WS_QN)[row * 512 + (kvh * 4 + (i >> 6)) * 64 + (i & 63)]);
        for (int i = lane; i < 768; i += 64) OUT[i] = 0.f;
        LDS_WAIT(); asm volatile("" ::: "memory");
        const bf16* CKk = WSP(bf16, WS_CK) + (smp ? (size_t)(seq * 2 + kvh) * 512 : (size_t)32768 + (seq * 2 + kvh) * 256) * 64; const bf16* CKv = CKk + (size_t)CMP_ROWS_J * 64;
        const int nvis = smp ? 511 : ((t >= 31) ? ((t - 31) >> 4) + 1 : 0);
        for (int i = lane; i < 512; i += 64) PSUM[i] = 0.f;
        for (int hr = 0; hr < 4; ++hr) {
            float mx = -INFINITY; for (int n = lane; n < nvis; n += 64) { float a = 0.f; for (int d = 0; d < 64; ++d) a += Q[hr * 64 + d] * bf1(CKk[(size_t)n * 64 + d]); SC[n] = a; mx = fmaxf(mx, a); }
            for (int o = 1; o < 64; o <<= 1) mx = fmaxf(mx, __shfl_xor(mx, o));
            float den = 0.f; for (int n = lane; n < nvis; n += 64) { const float e = exp2f(SC[n] - mx); SC[n] = e; den += e; } den = wave_sum(den);
            LDS_WAIT(); asm volatile("" ::: "memory");
            if (nvis > 0) { float o = 0.f; for (int n = 0; n < nvis; ++n) o += SC[n] * bf1(CKv[(size_t)n * 64 + lane]); OUT[hr * 64 + lane] = o / den;
                for (int n = lane; n < nvis; n += 64) PSUM[n] += SC[n] / den; }
            LDS_WAIT(); asm volatile("" ::: "memory");
        }
        LAS float* IMP = SC; LAS float* SELB = SC + 256;
        for (int sblk = lane; sblk < NS; sblk += 64) { float imp = 0.f; for (int n = 4 * sblk - 1; n <= 4 * sblk + 3; ++n) if (n >= 0 && n < N) imp += PSUM[n];
            const bool forced = sblk == 0 || sblk == cur || sblk == cur - 1, avail = sblk * 64 <= t; IMP[sblk] = avail ? (forced ? 1e4f : imp) : -1e4f; SELB[sblk] = 0.f; }
        LDS_WAIT(); asm volatile("" ::: "memory");
        for (int pick = 0; pick < 16 && pick < NS; ++pick) { float bv = -INFINITY; int bi = 1 << 30;
            for (int sblk = lane; sblk < NS; sblk += 64) { const float v = (SELB[sblk] != 0.f) ? -INFINITY : IMP[sblk]; if (v > bv || (v == bv && sblk < bi)) { bv = v; bi = sblk; } }
            for (int o = 1; o < 64; o <<= 1) { const float ov = __shfl_xor(bv, o); const int oi = __shfl_xor(bi, o); if (ov > bv || (ov == bv && oi < bi)) { bv = ov; bi = oi; } }
            if (lane == 0) SELB[bi] = 1.f; LDS_WAIT(); asm volatile("" ::: "memory"); }
        for (int br = 1; br < 3; ++br) for (int hr = 0; hr < 4; ++hr) {
            float mx = -INFINITY, den = 0.f, o = 0.f;
            const int plo = (br == 1) ? 0 : (t - WINB < 0 ? 0 : t - WINB), phi = t;
            for (int p = plo; p <= phi; ++p) {
                if (br == 1 && SELB[p >> 6] == 0.f) { p |= 63; continue; }
                const float* kf = nullptr; const bf16* kb = nullptr; const float* vf = nullptr; const bf16* vb = nullptr;
                const int jk = (br == 1) ? 2 : 4;
                if (!smp) { kb = WSP(bf16, WS_KVB) + ((((size_t)(jk - 2) * PB + seq) * 2 + kvh) * PT + p) * 64; vb = kb + (size_t)PB * 2 * PT * 64; }
                else if (p >= PAST) { kb = WSP(bf16, WS_KVS) + ((((size_t)(jk - 2) * SB + seq) * 2 + kvh) * ST + (p - PAST)) * 64; vb = kb + (size_t)SB * 2 * ST * 64; }
                else if (br == 1) { const int page = ((const int*)F.a->in[I_PT])[seq * NPG + (p >> 7)]; kf = FIN(I_CACHE) + ((((size_t)page * PAGE + (p & 127)) * 4 + 2) * 2 + kvh) * 64; vf = kf + 128; }
                else { kf = FIN(I_CWIN) + ((((size_t)seq * WINB + (p - (PAST - WINB))) * 2 + 0) * 2 + kvh) * 64; vf = kf + 128; }
                float a = 0.f; for (int d = 0; d < 64; ++d) a += Q[hr * 64 + d] * (kb ? bf1(kb[d]) : bfr(kf[d]));
                const float vv = vb ? bf1(vb[lane]) : bfr(vf[lane]);
                const float mn = fmaxf(mx, a), al = exp2f(mx - mn), e = exp2f(a - mn); den = den * al + e; o = o * al + e * vv; mx = mn;
            }
            OUT[(br * 4 + hr) * 64 + lane] = (den > 0.f) ? o / den : 0.f;
        }
        LDS_WAIT(); asm volatile("" ::: "memory");
        bool bad = false;
        for (int hr = 0; hr < 4; ++hr) { const float* ng = WSP(float, WS_NG) + row * 24 + (kvh * 4 + hr) * 3;
            const float e = ng[0] * OUT[(0 * 4 + hr) * 64 + lane] + ng[1] * OUT[(1 * 4 + hr) * 64 + lane] + ng[2] * OUT[(2 * 4 + hr) * 64 + lane];
            bad = bad || dbg_bad(bf1(WSP(bf16, WS_OA)[row * 512 + (kvh * 4 + hr) * 64 + lane]), e, 0.04f, 0.004f); }
        DBG_FLAG(smp ? 5 : 4, bad);
        LDS_WAIT(); asm volatile("" ::: "memory");
    }
    for (int s = gw; s < 96; s += NGW) {
        const unsigned r = dbg_rand(6000u + s); const bool smp = (s % 3) == 2; const int h = (r >> 3) & 3; const float lg = ret_log_g(h);
        const bf16* RQ = WSP(bf16, WS_RQ); const bf16* RK = RQ + (size_t)MT * 512; const bf16* RV = RQ + (size_t)2 * MT * 512; const bf16* RG = RQ + (size_t)3 * MT * 512;
        int seq, t; size_t row0; if (smp) { seq = (r >> 5) % SB; t = (r >> 10) % ST; row0 = (size_t)PM + seq * ST; } else { seq = (r >> 5) % PB; const unsigned k = (r >> 8) % 4u; t = (k == 0) ? (int)((r >> 12) % 300) : (int)((r >> 12) % PT); row0 = (size_t)seq * PT; }
        float o0 = 0.f, o1 = 0.f;
        for (int d = lane; d < 128; d += 64) L[d] = bf1(RQ[(row0 + t) * 512 + h * 128 + d]);
        LDS_WAIT(); asm volatile("" ::: "memory");
        for (int j = 0; j <= t; ++j) { float a = 0.f; for (int d = 0; d < 128; ++d) a += L[d] * bf1(RK[(row0 + j) * 512 + h * 128 + d]);
            a *= expf((float)(t - j) * lg); o0 += a * bf1(RV[(row0 + j) * 512 + h * 128 + lane]); o1 += a * bf1(RV[(row0 + j) * 512 + h * 128 + 64 + lane]); }
        if (smp) { const float* S0 = FIN(I_SRET) + (((size_t)0 * SB + seq) * 4 + h) * 16384; const float cr = expf((float)(t + 1) * lg);
            for (int d = 0; d < 128; ++d) { o0 += L[d] * S0[d * 128 + lane] * cr; o1 += L[d] * S0[d * 128 + 64 + lane] * cr; } }
        const float mean = wave_sum(o0 + o1) * (1.0f / 128.0f); const float var = wave_sum((o0 - mean) * (o0 - mean) + (o1 - mean) * (o1 - mean)) * (1.0f / 128.0f), rstd = 1.0f / sqrtf(var + EPS);
        const float* GN = FIN(I_GNG) + h * 128; const bf16* OR_ = WSP(bf16, WS_OA) + (size_t)MT * 512;
        const float g0 = bf1(RG[(row0 + t) * 512 + h * 128 + lane]), g1 = bf1(RG[(row0 + t) * 512 + h * 128 + 64 + lane]);
        const float e0 = (o0 - mean) * rstd * GN[lane] * (g0 / (1.0f + expf(-g0))), e1 = (o1 - mean) * rstd * GN[64 + lane] * (g1 / (1.0f + expf(-g1)));
        DBG_FLAG(6, dbg_bad(bf1(OR_[(row0 + t) * 512 + h * 128 + lane]), e0, 0.04f, 0.02f) || dbg_bad(bf1(OR_[(row0 + t) * 512 + h * 128 + 64 + lane]), e1, 0.04f, 0.02f));
        const int d = (r >> 20) % 128, T = smp ? ST : PT; float s0 = 0.f, s1 = 0.f;
        for (int j = 0; j < T; ++j) { const float kk = bf1(RK[(row0 + j) * 512 + h * 128 + d]) * expf((float)(T - 1 - j) * lg); s0 += kk * bf1(RV[(row0 + j) * 512 + h * 128 + lane]); s1 += kk * bf1(RV[(row0 + j) * 512 + h * 128 + 64 + lane]); }
        const float* SO;
        if (smp) { const float* S0 = FIN(I_SRET) + (((size_t)0 * SB + seq) * 4 + h) * 16384; const float g8 = expf(8.0f * lg); s0 += g8 * S0[d * 128 + lane]; s1 += g8 * S0[d * 128 + 64 + lane]; SO = F.out + OUT_RET_S + (((size_t)0 * SB + seq) * 4 + h) * 16384; }
        else SO = F.out + OUT_RET_P + (((size_t)0 * PB + seq) * 4 + h) * 16384;
        DBG_FLAG(7, dbg_bad(SO[d * 128 + lane], s0, 0.02f, 0.02f) || dbg_bad(SO[d * 128 + 64 + lane], s1, 0.02f, 0.02f));
        LDS_WAIT(); asm volatile("" ::: "memory");
    }
    for (int s = gw; s < 48; s += NGW) {
        const unsigned r = dbg_rand(8000u + s); const bool smp = (s % 3) == 2; const int blk = (r >> 3) & 7, c = blk * 64 + lane;
        int seq, T; size_t row0; if (smp) { seq = (r >> 6) % SB; T = ST; row0 = (size_t)PM + seq * ST; } else { seq = (r >> 6) % PB; T = 1 + (int)((r >> 10) % ((s & 1) ? 200 : PT)); row0 = (size_t)seq * PT; }
        const float* RX = WSP(float, WS_RX); const float* cw = FIN(I_RCW); const float cb = FIN(I_RCB)[c];
        float x3 = 0.f, x2 = 0.f, x1 = 0.f, h = 0.f;
        if (smp) { const float* cv = FIN(I_SCONV) + (size_t)seq * 3 * 512; x3 = cv[c]; x2 = cv[512 + c]; x1 = cv[1024 + c]; h = FIN(I_SH)[(size_t)seq * 512 + c]; }
        const float sp = log1pf(expf(-FIN(I_LAM)[c])); const float* wa = FIN(I_RWA) + (size_t)blk * 4096; const float* wx = FIN(I_RWX) + (size_t)blk * 4096;
        for (int t = 0; t < T; ++t) { const float x0 = RX[(row0 + t) * 512 + c]; const float xc = cb + cw[c] * x3 + cw[512 + c] * x2 + cw[1024 + c] * x1 + cw[1536 + c] * x0; x3 = x2; x2 = x1; x1 = x0;
            L[lane] = xc; LDS_WAIT(); asm volatile("" ::: "memory");
            float ra = FIN(I_RBA)[c], ri = FIN(I_RBX)[c]; for (int i = 0; i < 64; ++i) { ra += L[i] * wa[i * 64 + lane]; ri += L[i] * wx[i * 64 + lane]; }
            LDS_WAIT(); asm volatile("" ::: "memory");
            const float rr = 1.0f / (1.0f + expf(-ra)), ii = 1.0f / (1.0f + expf(-ri)), la = -8.0f * rr * sp, a = expf(la); h = a * h + sqrtf(-expm1f(2.0f * la)) * (ii * xc); }
        const size_t o = (row0 + T - 1) * 512 + c; const float e = h * bf1(WSP(bf16, WS_GG)[o]);
        DBG_FLAG(8, dbg_bad(bf1((WSP(bf16, WS_OA) + (size_t)2 * MT * 512)[o]), e, 0.04f, 0.01f));
    }
    for (int s = gw; s < 512; s += NGW) {
        const unsigned r = dbg_rand(9000u + s); const int row = dbg_row(r), col = (r >> 7) % DM;
        float e = 0.f;
        for (int br = 0; br < 3; ++br) { const bf16* O = WSP(bf16, WS_OA) + (size_t)br * MT * 512 + (size_t)row * 512; const float* W = FIN(br == 0 ? I_WBRA : (br == 1 ? I_WBRB : I_WBRC));
            float a = 0.f; for (int k = lane; k < 512; k += 64) a += bf1(O[k]) * bfr(W[(size_t)k * DM + col]); a = wave_sum(a); e += bf1(WSP(bf16, WS_MGS)[(size_t)row * 3072 + br * 1024 + col]) * a; }
        DBG_FLAG(20, dbg_bad(bf1(WSP(bf16, WS_MRG)[(size_t)row * DM + col]), e, 0.03f, 0.01f));
        const float* mod = WSP(float, WS_MOD) + (size_t)row_bb(row) * 6144;
        { float a = 0.f; for (int k = lane; k < DM; k += 64) a += bf1(WSP(bf16, WS_MRG)[(size_t)row * DM + k]) * bfr(FIN(I_WOUT)[(size_t)k * DM + col]); a = wave_sum(a);
          const float ex = xrow_in(F, 0, row)[col] + mod[2048 + col] * a; DBG_FLAG(21, dbg_bad(WSP(float, WS_X1)[(size_t)row * DM + col], ex, 0.005f, 0.005f)); }
        { const float* xr = WSP(float, WS_X1) + (size_t)row * DM; float ss = 0.f; for (int d = lane; d < DM; d += 64) ss += xr[d] * xr[d]; const float rs = 1.0f / sqrtf(wave_sum(ss) * (1.0f / DM) + EPS);
          const int c2 = (r >> 9) % NUP; float a = 0.f; for (int d = lane; d < DM; d += 64) a += bfr(xr[d] * rs * FIN(I_N2G)[d] * (1.0f + mod[4096 + d]) + mod[3072 + d]) * bfr(FIN(I_WUP)[(size_t)d * NUP + c2]); a = wave_sum(a);
          const float got = c2 < DFF ? bf1(WSP(bf16, WS_GP)[(size_t)row * DFF + c2]) : bf1((WSP(bf16, WS_GP) + (size_t)MT * DFF)[(size_t)row * DFF + c2 - DFF]); DBG_FLAG(22, dbg_bad(got, a, 0.02f, 0.01f)); }
        { const int c3 = (r >> 11) % DFF; const bf16* GP = WSP(bf16, WS_GP); const bf16* VAL = GP + (size_t)MT * DFF; const float* cw = FIN(I_FCW);
          const bool isp = row < PM; const int t = isp ? (row & (PT - 1)) : ((row - PM) & 7); float xm2, xm1;
          if (t >= 2) { xm2 = bf1(GP[(size_t)(row - 2) * DFF + c3]); xm1 = bf1(GP[(size_t)(row - 1) * DFF + c3]); }
          else if (isp) { xm2 = 0.f; xm1 = (t == 1) ? bf1(GP[(size_t)(row - 1) * DFF + c3]) : 0.f; }
          else { const float* st = FIN(I_SFFN) + ((size_t)((row - PM) >> 3) * 2) * DFF + c3; xm2 = (t == 0) ? st[0] : st[DFF]; xm1 = (t == 0) ? st[DFF] : bf1(GP[(size_t)(row - 1) * DFF + c3]); }
          const float y = FIN(I_FCB)[c3] + cw[c3] * xm2 + cw[DFF + c3] * xm1 + cw[2 * DFF + c3] * bf1(GP[(size_t)row * DFF + c3]); const float ex = (y / (1.0f + expf(-y))) * bf1(VAL[(size_t)row * DFF + c3]);
          DBG_FLAG(23, dbg_bad(bf1((GP + (size_t)2 * MT * DFF)[(size_t)row * DFF + c3]), ex, 0.02f, 0.005f)); }
        { const bf16* ACT = WSP(bf16, WS_GP) + (size_t)2 * MT * DFF + (size_t)row * DFF; float a = 0.f; for (int k = lane; k < DFF; k += 64) a += bf1(ACT[k]) * bfr(FIN(I_WDN)[(size_t)k * DM + col]); a = wave_sum(a);
          const float ex = WSP(float, WS_X1)[(size_t)row * DM + col] + mod[5120 + col] * a; DBG_FLAG(24, dbg_bad(WSP(float, WS_X2)[(size_t)row * DM + col], ex, 0.005f, 0.005f)); }
    }
#undef DBG_FLAG
}
__device__ __forceinline__ void dbg_report_phase(Frame& F) {
    const unsigned* CNT = (const unsigned*)(F.ws + WS_CTL) + 3000;
    const size_t ooff[14] = {OUT_Y, OUT_Y + (size_t)PM * DM, OUT_ROWS_P, OUT_ROWS_S, OUT_WIN_P, OUT_WIN_S, OUT_RET_P, OUT_RET_S, OUT_H_P, OUT_H_S, OUT_CV_P, OUT_CV_S, OUT_FC_P, OUT_FC_S};
    if (F.bid == 0 && F.tid < 14) { const int b = F.tid; const unsigned c = CNT[b]; const int cnt = 1 + (int)(c > 1000u ? 1000u : c);
        for (int i = 0; i < cnt; ++i) ((unsigned*)F.out)[ooff[b] + 7 + 2 * i] = 0xAAAAAAAAu; }
}
#endif

#ifndef DBG_SUB
#define DBG_SUB 0xFFFF
#endif
#ifndef DBG_MAXPH
#define DBG_MAXPH N_PHASES
#endif
#ifndef DBG_REPEAT
#define DBG_REPEAT 0
#endif
#ifndef DBG_MASK
#define DBG_MASK 0xFFFF
#endif
#define IN(k) (lo <= (k) && (k) < hi)
#ifdef DBG_TIME
#define SEAM(k) do { if ((k) + 1 < hi) { if (MK_N_LAUNCHES == 1) xcd_barrier(bar); } if (F.bid == 0 && F.tid == 0) ((unsigned long long*)(F.ws + WS_CTL))[2048 + (k) + 1] = __builtin_amdgcn_s_memrealtime(); } while (0)
#else
#define SEAM(k) do { if ((k) + 1 < hi) { if (MK_N_LAUNCHES == 1) xcd_barrier(bar); } } while (0)
#endif
template <int l> __device__ __forceinline__ void ph_win(Frame& F) { unsigned char* ws = F.ws;
    pg8::Gemm g{(const pg8::bf16_t*)(ws + WS_H), (const pg8::bf16_t*)(ws + WS_WIN) + (size_t)l * NIN * DM, MT, NIN, DM};
    pg8::StaticOrder S; S.init(MT, NIN, F.G, F.bid); EpiWin E{ws, F.out, l};
    pg8::gemm_phase<EpiWin, pg8::StaticOrder, true, true>(F.lds, g, S, E); }
template <int l> __device__ __forceinline__ void ph_mix1(Frame& F) {
    for (int x = F.bid; x < 512; x += F.G) { launder(F); cmp_gemm_unit<true>(F, l, x >> 8, (x & 255) >> 2, (x & 3) * 128); }
    {
        unsigned* ctr = (unsigned*)(F.ws + WS_CTL) + 3210 + l; volatile LAS int* QI = (volatile LAS int*)(F.lds + MISC_OFF + 128);
#pragma unroll 1
        for (;;) {
            __syncthreads();
            if (F.tid == 0) QI[0] = (int)__hip_atomic_fetch_add(ctr, 1u, __ATOMIC_RELAXED, __HIP_MEMORY_SCOPE_AGENT);
            __syncthreads();
            const int u = __builtin_amdgcn_readfirstlane(QI[0]);
            if (u >= 32 + 768) break;
            launder(F);
            if (u < 32) cmp_gemm_unit<false>(F, l, u >> 4, (u >> 1) & 7, (u & 1) * 128); else if (u < 32 + 256) rglru_unit<0>(F, l, u - 32); else ret_local_unit(F, u - 32 - 256);
        }
        __syncthreads();
    } }
template <int l> __device__ __forceinline__ void ph_mix2(Frame& F) { cmp2_phase(F, l); ret_scan_phase(F, l); rglru_carry_phase(F, l); }
#ifndef DBG_REPQ
#define DBG_REPQ 0
#endif
constexpr int MQ_SA = 64, MQ_PA = MQ_SA + 512, MQ_RG1 = MQ_PA + 256, MQ_RO = MQ_RG1 + 512, MQ_RS = MQ_RO + 128, MQ_RG2 = MQ_RS + 32;
template <int l> __device__ __forceinline__ void ph_mix3(Frame& F) {
    unsigned* ctr = (unsigned*)(F.ws + WS_CTL) + 3200 + l;
    volatile LAS int* QI = (volatile LAS int*)(F.lds + MISC_OFF + 128);
#pragma unroll 1
    for (;;) {
        __syncthreads();
        if (F.tid == 0) QI[0] = (int)__hip_atomic_fetch_add(ctr, 1u, __ATOMIC_RELAXED, __HIP_MEMORY_SCOPE_AGENT);
        __syncthreads();
        const int u = __builtin_amdgcn_readfirstlane(QI[0]);
        if (u >= MQ_RG2) break;
        launder(F);
        if (u < MQ_SA) { attn_sample_unit(F, l, u); if (DBG_REPQ & 2) { launder(F); attn_sample_unit(F, l, u); } }
        else if (u < MQ_PA) { const int v = u - MQ_SA; attn_prompt_unit(F, l, (v & 7) * 64 + 63 - (v >> 3)); if (DBG_REPQ & 1) { launder(F); attn_prompt_unit(F, l, (v & 7) * 64 + 63 - (v >> 3)); } }
        else if (u < MQ_RG1) { rglru_unit<1>(F, l, u - MQ_PA); }
        else if (u < MQ_RO) { ret_out_unit(F, l, u - MQ_RG1); }
        else if (u < MQ_RS) { ret_sample_unit(F, l, u - MQ_RO); }
        else { rglru_unit<2>(F, l, u - MQ_RS); }
    }
    __syncthreads(); }
__device__ __forceinline__ f32x16 smp_tile_acc(Frame& F, const bf16* A, const bf16* Wt, int K, int tile) {
    const int q = F.lane & 31, h_ = F.lane >> 5, ks8 = K / 8, kb = F.wave * ks8;
    const bf16* ap = A + (size_t)((tile >> 5) * 32 + q) * K + kb + 8 * h_; const bf16* bp = Wt + (size_t)((tile & 31) * 32 + q) * K + kb + 8 * h_; f32x16 acc = (f32x16){};
#pragma unroll 11
    for (int kk = 0; kk < ks8 / 16; ++kk) acc = mfma32(*(const bf16x8*)(ap + 16 * kk), *(const bf16x8*)(bp + 16 * kk), acc);
    return acc;
}
__device__ __forceinline__ void smp_tile_put(Frame& F, const f32x16& acc, int slot) { LAS float* R = (LAS float*)(F.lds + slot * 32768) + F.wave * 1024 + F.lane;
#pragma unroll
    for (int r = 0; r < 16; ++r) R[r * 64] = acc[r]; }
__device__ __forceinline__ float smp_tile_get(Frame& F, int slot, int o) { const LAS float* R = (const LAS float*)(F.lds + slot * 32768) + o; float s = 0.f;
#pragma unroll
    for (int w = 0; w < 8; ++w) s += R[w * 1024];
    return s; }
template <int l> __device__ __forceinline__ void ph_br(Frame& F) { unsigned char* ws = F.ws;
    const pg8::bf16_t* wbr = (const pg8::bf16_t*)(ws + WS_WBR) + (size_t)l * 3 * 1024 * 512;
    for (int tile = F.bid; tile < 256; tile += F.G) {
        const f32x16 a0 = smp_tile_acc(F, (const bf16*)(ws + WS_OA) + (size_t)PM * 512, wbr, 512, tile), a1 = smp_tile_acc(F, (const bf16*)(ws + WS_OA) + (size_t)(MT + PM) * 512, wbr + (size_t)1024 * 512, 512, tile),
                     a2 = smp_tile_acc(F, (const bf16*)(ws + WS_OA) + (size_t)(2 * MT + PM) * 512, wbr + (size_t)2 * 1024 * 512, 512, tile);
        __syncthreads(); smp_tile_put(F, a0, 0); smp_tile_put(F, a1, 1); smp_tile_put(F, a2, 2); __syncthreads();
        const bf16* MG = (const bf16*)(ws + WS_MGS); bf16* MR = (bf16*)(ws + WS_MRG);
#pragma unroll
        for (int e = 0; e < 2; ++e) { const int o = F.tid * 2 + e, r = o >> 6, ln = o & 63; const size_t row = (size_t)PM + (tile >> 5) * 32 + (r & 3) + 8 * (r >> 2) + 4 * (ln >> 5); const int col = (tile & 31) * 32 + (ln & 31);
            const bf16* g = MG + row * 3072 + col; MR[row * DM + col] = (bf16)(pk2(bf1(g[0]) * smp_tile_get(F, 0, o) + bf1(g[1024]) * smp_tile_get(F, 1, o) + bf1(g[2048]) * smp_tile_get(F, 2, o), 0.f) & 0xffffu); }
    }
    __syncthreads();
    BrOrder S; S.S.init(PM, DM, F.G, F.bid);
    pg8::Gemm g{(const pg8::bf16_t*)(ws + WS_OA), wbr, 3 * MT, 3 * DM, 512}; EpiBrAll E{ws};
    pg8::gemm_phase<EpiBrAll, BrOrder, true, true>(F.lds, g, S, E); }
template <bool INF32> __device__ __forceinline__ void smp_res(Frame& F, const bf16* A, const bf16* Wt, int K, const void* xin  , bf16* xout  , const float* mod, int gofs) {
    for (int tile = F.bid; tile < 256; tile += F.G) {
        const f32x16 a = smp_tile_acc(F, A, Wt, K, tile);
        __syncthreads(); smp_tile_put(F, a, 0); __syncthreads();
#pragma unroll
        for (int e = 0; e < 2; ++e) { const int o = F.tid * 2 + e, r = o >> 6, ln = o & 63; const int rr = (tile >> 5) * 32 + (r & 3) + 8 * (r >> 2) + 4 * (ln >> 5), col = (tile & 31) * 32 + (ln & 31);
            const float xi = INF32 ? ((const float*)xin)[(size_t)rr * DM + col] : bf1(((const bf16*)xin)[(size_t)rr * DM + col]);
            xout[(size_t)rr * DM + col] = (bf16)(pk2(xi + mod[(size_t)(4 + (rr >> 3)) * 6144 + gofs + col] * smp_tile_get(F, 0, o), 0.f) & 0xffffu); }
    }
    __syncthreads();
}
template <int l> __device__ __forceinline__ void ph_out(Frame& F) { unsigned char* ws = F.ws;
    const float* mod = (const float*)(ws + WS_MOD) + (size_t)l * 36 * 6144;
    smp_res<l == 0>(F, (const bf16*)(ws + WS_MRG) + (size_t)PM * DM, (const bf16*)(ws + WS_WOUT) + (size_t)l * DM * DM, DM, l == 0 ? (const void*)FIN(I_XS) : (const void*)((const bf16*)(ws + WS_X2) + (size_t)PM * DM), (bf16*)(ws + WS_X1) + (size_t)PM * DM, mod, 2048);
    pg8::Gemm g{(const pg8::bf16_t*)(ws + WS_MRG), (const pg8::bf16_t*)(ws + WS_WOUT) + (size_t)l * DM * DM, PM, DM, DM};
    pg8::StaticOrder S; S.init(PM, DM, F.G, F.bid);
    EpiRes<l == 0> E{l == 0 ? (const void*)FIN(I_XP) : (const void*)(ws + WS_X2), (bf16*)(ws + WS_X1), mod, 2048};
    pg8::gemm_phase<EpiRes<l == 0>, pg8::StaticOrder, true, true>(F.lds, g, S, E); }
template <int l> __device__ __forceinline__ void ph_down(Frame& F) { unsigned char* ws = F.ws;
    const float* mod = (const float*)(ws + WS_MOD) + (size_t)l * 36 * 6144;
    smp_res<false>(F, (const bf16*)(ws + WS_GP) + (size_t)2 * MT * DFF + (size_t)PM * DFF, (const bf16*)(ws + WS_WDN) + (size_t)l * DM * DFF, DFF, (const void*)((const bf16*)(ws + WS_X1) + (size_t)PM * DM), (bf16*)(ws + WS_X2) + (size_t)PM * DM, mod, 5120);
    pg8::Gemm g{(const pg8::bf16_t*)(ws + WS_GP) + (size_t)2 * MT * DFF, (const pg8::bf16_t*)(ws + WS_WDN) + (size_t)l * DM * DFF, PM, DM, DFF};
    pg8::StaticOrder S; S.init(PM, DM, F.G, F.bid);
    EpiRes<false> E{(const void*)(ws + WS_X1), (bf16*)(ws + WS_X2), mod, 5120};
    pg8::gemm_phase<EpiRes<false>, pg8::StaticOrder, true, true>(F.lds, g, S, E); }
template <int l> __device__ __forceinline__ void ph_up(Frame& F) { unsigned char* ws = F.ws;
    pg8::Gemm g{(const pg8::bf16_t*)(ws + WS_H), (const pg8::bf16_t*)(ws + WS_WUP) + (size_t)l * NUP * DM, MT, NUP, DM};
    UpOrder S; S.S.init(MT, DFF, F.G, F.bid); EpiUp E{ws, F.out, l, FIN(I_FCW) + (size_t)l * 3 * DFF, FIN(I_FCB) + (size_t)l * DFF};
    pg8::gemm_phase<EpiUp, UpOrder, true, true>(F.lds, g, S, E); }
#ifdef DBG_AMP_BIT
#define AMP_T0(bit) unsigned long long amp_t0_ = 0ull; if ((bit) == DBG_AMP_BIT) amp_t0_ = __builtin_amdgcn_s_memrealtime();
#define AMP_T1(bit) if ((bit) == DBG_AMP_BIT && F.tid == 0) { volatile LAS unsigned* AM = (volatile LAS unsigned*)(F.lds + MISC_OFF + 192); AM[0] += (unsigned)(__builtin_amdgcn_s_memrealtime() - amp_t0_); }
#else
#define AMP_T0(bit)
#define AMP_T1(bit)
#endif
#define RUNPH(bit, ph, CALL) do { if (((DBG_MASK >> (bit)) & 1) && IN(ph)) { AMP_T0(bit) launder(F); CALL; if ((DBG_REPEAT >> (bit)) & 1) { launder(F); CALL; } SEAM(ph); AMP_T1(bit) } } while (0)
template <int l> __device__ __forceinline__ void layer_phases(Frame& F, const XcdBarrier& bar, int lo, int hi) {
    constexpr int pb = PH_L0 + l * PH_PER_LAYER;
    RUNPH(1, pb + LP_N1, norm_phase(F, l, 0));
    RUNPH(2, pb + LP_WIN, ph_win<l>(F));
    RUNPH(3, pb + LP_MIX1, ph_mix1<l>(F));
    RUNPH(4, pb + LP_MIX2, ph_mix2<l>(F));
    RUNPH(5, pb + LP_MIX3, ph_mix3<l>(F));
    RUNPH(6, pb + LP_BR, ph_br<l>(F));
    RUNPH(7, pb + LP_OUT, ph_out<l>(F));
    RUNPH(8, pb + LP_N2, norm_phase(F, l, 1));
    RUNPH(9, pb + LP_UP, ph_up<l>(F));
    RUNPH(10, pb + LP_CONV, convact_phase(F, l));
    RUNPH(11, pb + LP_DOWN, ph_down<l>(F));
}
__global__ void __launch_bounds__(NTHR, 2) trunk_fwd(Args args) {
    extern __shared__ __attribute__((aligned(16))) unsigned char lds_raw[];
    Frame F;
    F.lds = (LAS unsigned char*)lds_raw;
    F.tid = threadIdx.x; F.lane = F.tid & 63; F.wave = __builtin_amdgcn_readfirstlane(F.tid >> 6);
    F.G = gridDim.x; F.bid = blockIdx.x; F.a = &args; F.ws = args.ws; F.out = args.out;
    volatile LAS unsigned* MISC = (volatile LAS unsigned*)(F.lds + MISC_OFF);
    for (int u = F.tid; u < 64; u += NTHR) MISC[u] = 0u;
    __syncthreads();
    unsigned* barw = (unsigned*)(F.ws + WS_CTL) + CW_BAR;
    XcdBarrier bar; bar.bar = barw; bar.x = 0; bar.st = nullptr;
    if (MK_N_LAUNCHES == 1) bar = xcd_barrier_post(barw, MISC + 8);
    const int lo = args.ph_lo, hi = args.ph_hi;
    unsigned char* ws = F.ws;

#ifdef DBG_TIME
    if (F.bid == 0 && F.tid == 0) ((unsigned long long*)(F.ws + WS_CTL))[2048] = __builtin_amdgcn_s_memrealtime();
#endif
    RUNPH(0, PH_P0, p0_prologue(F));

    layer_phases<0>(F, bar, lo, hi);
    layer_phases<1>(F, bar, lo, hi);
    if (((DBG_MASK >> 12) & 1) && IN(PH_FINAL)) { launder(F); final_phase(F); if ((DBG_REPEAT >> 12) & 1) { launder(F); final_phase(F); } }
#ifdef DBG_AMP_BIT
    if (F.tid == 0) { volatile LAS unsigned* AM = (volatile LAS unsigned*)(F.lds + MISC_OFF + 192); const unsigned long long tot = (unsigned long long)AM[0] * DBG_AMP, ts = __builtin_amdgcn_s_memrealtime();
        while (__builtin_amdgcn_s_memrealtime() - ts < tot) __builtin_amdgcn_s_sleep(8); }
    __syncthreads();
#endif
#ifdef DBG_TIME
    {
        xcd_barrier(bar);
        if (F.bid == 0 && F.tid < 14) {
            const unsigned long long* ts = (const unsigned long long*)(F.ws + WS_CTL) + 2048; const unsigned long long tend = __builtin_amdgcn_s_memrealtime();
            const size_t ooff[14] = {OUT_Y, OUT_Y + (size_t)PM * DM, OUT_ROWS_P, OUT_ROWS_S, OUT_WIN_P, OUT_WIN_S, OUT_RET_P, OUT_RET_S, OUT_H_P, OUT_H_S, OUT_CV_P, OUT_CV_S, OUT_FC_P, OUT_FC_S};
            const int b = F.tid; unsigned long long d;
            if (b == 0) d = tend - ts[0]; else if (b == 1) d = ts[1] - ts[0]; else if (b == 13) d = tend - ts[PH_FINAL];
            else { const int ph = PH_L0 + DBG_TIME_LAYER * PH_PER_LAYER + (b - 2); d = ts[ph + 1] - ts[ph]; }
            int cnt = (int)(d / 100ull); if (cnt < 1) cnt = 1; if (cnt > 2000 && b != 0) cnt = 2000;
            for (int i = 0; i < cnt; ++i) ((unsigned*)F.out)[ooff[b] + 7 + 2 * i] = 0xAAAAAAAAu;
        }
    }
#endif
#ifdef DBG_COUNT
    {
        xcd_barrier(bar);
        if (F.bid == 0 && F.tid < 3) { const unsigned* CNT = (const unsigned*)(F.ws + WS_CTL) + 3000; const size_t ooff[3] = {OUT_Y, OUT_Y + (size_t)PM * DM, OUT_ROWS_P};
            const int cnt = (int)((unsigned long long)CNT[F.tid] * 10ull / (CNT[3] ? CNT[3] : 1u)); for (int i = 0; i < cnt; ++i) ((unsigned*)F.out)[ooff[F.tid] + 7 + 2 * i] = 0xAAAAAAAAu; }
    }
#endif
#ifdef DBG_CHECK
    if (lo == 100) { launder(F); dbg_check_phase(F); }
    if (lo == 101) { for (size_t i = (size_t)F.bid * NTHR + F.tid; i < OUT_END; i += (size_t)F.G * NTHR) F.out[i] = 0.f; }
    if (lo == 102) { launder(F); dbg_report_phase(F); }
#endif
}

extern "C" void kernel_launch(void* const* d_in, const int* in_sizes, int n_in, void* d_out, int out_size, void* d_ws, size_t ws_size, hipStream_t stream) {
    static int grid = 0;
    if (grid == 0) {
        if (n_in != 37 || (size_t)out_size != OUT_END || ws_size < WS_END) { fprintf(stderr, "kernel_launch: unexpected shapes: n_in %d out %d (want %zu) ws %zu (want %zu)\n", n_in, out_size, (size_t)OUT_END, ws_size, (size_t)WS_END); grid = -1; return; }
        int dev = 0, cus = 0, per_cu = 0;
        if (hipGetDevice(&dev) != hipSuccess || hipDeviceGetAttribute(&cus, hipDeviceAttributeMultiprocessorCount, dev) != hipSuccess) { grid = -1; return; }
        if (hipFuncSetAttribute((const void*)trunk_fwd, hipFuncAttributeMaxDynamicSharedMemorySize, LDS_BYTES) != hipSuccess) { fprintf(stderr, "kernel_launch: hipFuncSetAttribute failed\n"); grid = -1; return; }
        if (hipOccupancyMaxActiveBlocksPerMultiprocessor(&per_cu, (const void*)trunk_fwd, NTHR, LDS_BYTES) != hipSuccess || per_cu < 1) fprintf(stderr, "kernel_launch: occupancy query reports %d\n", per_cu);
        (void)hipGetLastError();
        grid = cus;
    }
    if (grid < 0) return;
    if (hipMemsetAsync((char*)d_ws + WS_CTL, 0, CTL_ZERO_BYTES, stream) != hipSuccess) return;
#ifdef DBG_POISON
    (void)hipMemsetAsync((char*)d_ws + CTL_ZERO_BYTES, 0xAA, WS_END - CTL_ZERO_BYTES, stream);
    (void)hipMemsetAsync(d_out, 0xAA, (size_t)OUT_END * 4, stream);
#endif
    Args a{};
    for (int i = 0; i < 37; ++i) a.in[i] = d_in[i];
    a.out = (float*)d_out; a.ws = (unsigned char*)d_ws;
#if MK_N_LAUNCHES == 1
    a.ph_lo = 0; a.ph_hi = N_PHASES;
    hipLaunchKernelGGL(trunk_fwd, dim3(grid), dim3(NTHR), LDS_BYTES, stream, a);
#else
    for (int p = 0; p < DBG_MAXPH; ++p) { a.ph_lo = p; a.ph_hi = p + 1; hipLaunchKernelGGL(trunk_fwd, dim3(grid), dim3(NTHR), LDS_BYTES, stream, a); }
#ifdef DBG_CHECK
    for (int p = 100; p < 103; ++p) { a.ph_lo = p; a.ph_hi = p + 1; hipLaunchKernelGGL(trunk_fwd, dim3(grid), dim3(NTHR), LDS_BYTES, stream, a); }
#endif
#endif
    (void)in_sizes;
}
```

```cpp
#include <hip/hip_runtime.h>
#include <cstdio>
#include <cstdint>

#ifndef MK_N_LAUNCHES
#define MK_N_LAUNCHES 1
#endif

constexpr int DM = 1024, PB = 4, PT = 4096, PM = PB * PT, SB = 32, ST = 8, SM = SB * ST, MT = PM + SM;
constexpr int DEPTH = 2, PAST = 8192, PAGE = 128, NPG = PAST / PAGE, NPHYS = 2560;
constexpr int D_IN = 7448, NIN = 7680, DFF = 2816, NUP = 2 * DFF;
constexpr int WINB = 512;
constexpr float EPS = 1e-6f;
constexpr float QSCALE = 0.125f * 1.4426950408889634f;

constexpr int O_NQ = 0, O_NKV = 512, O_NG = 1280, O_RQ = 1304, O_RK = 1816, O_RV = 2328, O_RG = 2840, O_RX = 3352, O_RGATE = 3864, O_MG = 4376;

constexpr size_t OUT_Y = 0;
constexpr size_t OUT_ROWS_P = OUT_Y + (size_t)MT * DM;
constexpr size_t OUT_ROWS_S = OUT_ROWS_P + (size_t)DEPTH * PM * 512;
constexpr size_t OUT_WIN_P = OUT_ROWS_S + (size_t)DEPTH * SM * 512;
constexpr size_t OUT_WIN_S = OUT_WIN_P + (size_t)DEPTH * PB * WINB * 256;
constexpr size_t OUT_RET_P = OUT_WIN_S + (size_t)DEPTH * SB * WINB * 256;
constexpr size_t OUT_RET_S = OUT_RET_P + (size_t)DEPTH * PB * 4 * 16384;
constexpr size_t OUT_H_P = OUT_RET_S + (size_t)DEPTH * SB * 4 * 16384;
constexpr size_t OUT_H_S = OUT_H_P + (size_t)DEPTH * PB * 512;
constexpr size_t OUT_CV_P = OUT_H_S + (size_t)DEPTH * SB * 512;
constexpr size_t OUT_CV_S = OUT_CV_P + (size_t)DEPTH * PB * 3 * 512;
constexpr size_t OUT_FC_P = OUT_CV_S + (size_t)DEPTH * SB * 3 * 512;
constexpr size_t OUT_FC_S = OUT_FC_P + (size_t)DEPTH * PB * 2 * DFF;
constexpr size_t OUT_END = OUT_FC_S + (size_t)DEPTH * SB * 2 * DFF;

constexpr size_t MiB = 1u << 20;
constexpr size_t WS_CTL = 0, CTL_ZERO_BYTES = 4 * MiB;
constexpr size_t WS_MOD = 1 * MiB;
constexpr size_t WS_ROT = 4 * MiB;
constexpr size_t WS_SMALLW = 8 * MiB;
constexpr size_t WS_WIN = 16 * MiB;
constexpr size_t WS_WBR = WS_WIN + (size_t)2 * NIN * DM * 2;
constexpr size_t WS_WOUT = WS_WBR + (size_t)2 * 3 * 1024 * 512 * 2;
constexpr size_t WS_WUP = WS_WOUT + (size_t)2 * 1024 * 1024 * 2;
constexpr size_t WS_WDN = WS_WUP + (size_t)2 * NUP * DM * 2;
constexpr size_t WS_WEND = WS_WDN + (size_t)2 * DM * DFF * 2;
constexpr size_t WS_H = 128 * MiB;
constexpr size_t WS_QN = WS_H + (size_t)MT * DM * 2;
constexpr size_t WS_KVB = WS_QN + (size_t)MT * 512 * 2;
constexpr size_t WS_KVS = WS_KVB + (size_t)4 * PB * 2 * PT * 64 * 2;
constexpr size_t WS_RQ = WS_KVS + (size_t)4 * SB * 2 * ST * 64 * 2;
constexpr size_t WS_RX = WS_RQ + (size_t)4 * MT * 512 * 2;
constexpr size_t WS_GG = WS_RX + (size_t)MT * 512 * 4;
constexpr size_t WS_MGS = WS_GG + (size_t)MT * 512 * 2;
constexpr size_t WS_NG = WS_MGS + (size_t)MT * 3072 * 2;
constexpr size_t WS_OA = WS_NG + (size_t)MT * 24 * 4;
constexpr size_t WS_MRG = WS_OA + (size_t)3 * MT * 512 * 2;
constexpr size_t WS_X1 = WS_MRG + (size_t)MT * DM * 2;
constexpr size_t WS_X2 = WS_X1 + (size_t)MT * DM * 4;
constexpr size_t WS_GP = WS_X2 + (size_t)MT * DM * 4;
constexpr size_t WS_ACMP = WS_GP + (size_t)3 * MT * DFF * 2;
constexpr int CMP_ROWS_J = 34816, CMP_ROWS = 2 * CMP_ROWS_J;
constexpr size_t WS_LH = WS_ACMP + (size_t)2 * CMP_ROWS * 1024 * 2 + 4096;
constexpr size_t WS_CK = WS_LH + (size_t)(CMP_ROWS + 16) * 256 * 2;
constexpr size_t WS_LT = WS_CK + (size_t)CMP_ROWS * 64 * 2;
constexpr size_t WS_SPT = WS_LT + (size_t)16 * 32 * 16384 * 4;
constexpr size_t WS_CAR = WS_SPT + (size_t)16 * 32 * 16384 * 2;
constexpr size_t WS_OAG = WS_CAR + (size_t)4 * 64 * 3 * 512 * 4 + MiB;
constexpr size_t WS_END = WS_OAG + (size_t)2048 * 32 * 64 * 4 + MiB;
static_assert(WS_WEND <= WS_H, "weights fit below WS_H");

constexpr size_t SW_W1T = 0;
constexpr size_t SW_W2T = SW_W1T + (size_t)2 * 2 * 256 * 1024 * 2;
constexpr size_t SW_CB = SW_W2T + (size_t)2 * 2 * 64 * 128 * 2;
constexpr size_t SW_WAT = SW_CB + (size_t)2 * 2 * 128 * 4;
constexpr size_t SW_SP = SW_WAT + (size_t)2 * 2 * 8 * 64 * 64 * 2;
constexpr size_t SW_END = SW_SP + 2 * 512 * 4;
static_assert(SW_END <= 8 * MiB, "small weights fit");

constexpr int CW_TMO = 0;
constexpr int CW_BAR = 4096;

constexpr int PH_P0 = 0, PH_L0 = 1, PH_PER_LAYER = 11, PH_FINAL = PH_L0 + DEPTH * PH_PER_LAYER, N_PHASES = PH_FINAL + 1;
enum { LP_N1 = 0, LP_WIN, LP_MIX1, LP_MIX2, LP_MIX3, LP_BR, LP_OUT, LP_N2, LP_UP, LP_CONV, LP_DOWN };

constexpr int RING_BYTES = 131072;
constexpr int MISC_OFF = RING_BYTES;
constexpr int LDS_BYTES = RING_BYTES + 1024;
constexpr int NWAVES = 8, NTHR = 512;

#define GAS __attribute__((address_space(1)))
#define LAS __attribute__((address_space(3)))
typedef unsigned short bf16;
typedef unsigned v4u __attribute__((ext_vector_type(4)));
typedef unsigned v2u __attribute__((ext_vector_type(2)));
typedef float f32x16 __attribute__((ext_vector_type(16)));
typedef short s16x4 __attribute__((ext_vector_type(4)));
namespace pg8 {
#define PG8_LAS __attribute__((address_space(3)))
typedef unsigned short bf16_t;
typedef short bf16x8 __attribute__((ext_vector_type(8)));
typedef float f32x4 __attribute__((ext_vector_type(4)));
typedef unsigned u32x4 __attribute__((ext_vector_type(4)));
constexpr int BM = 256, BK = 64, HALF = 128, HTB = HALF * BK * 2  , STAGE_BYTES = 8 * HTB, NXCD = 8, WGM = 8;

__host__ __device__ __forceinline__ int lds_byte(int r, int c) { const int st = (r >> 4) * 2 + (c >> 5), rr = r & 15, cc = c & 31, ob = rr * 64 + cc * 2; return st * 1024 + (ob ^ (((ob >> 9) & 1) << 5)); }
__host__ __device__ __forceinline__ void stage_rc(int b, int& R, int& C) { const int st = b / 1024, sb = b % 1024, swz = sb ^ (((sb >> 9) & 1) << 5); R = (st >> 1) * 16 + swz / 64; C = (st & 1) * 32 + (swz % 64) / 2; }
__host__ __device__ __forceinline__ int perm32(int rho) { const int n = rho >> 4, i = rho & 15; return 8 * (i >> 2) + 4 * n + (i & 3); }

struct Unit { int pm, pn; };
struct Gemm { const bf16_t* A; const bf16_t* Bt; int M, N, K; };

struct StaticOrder {
    int nM, nN, nwg, G, c;
    __host__ __device__ void init(int M, int N, int G_, int c_) { nM = M / BM; nN = N / BM; nwg = nM * nN; G = G_; c = c_; }
    __host__ __device__ bool next(int i, Unit& u) const {
        const long L = (long)i * G + c; if (L >= nwg) return false;
        int wgid = (int)L; { const int q = nwg / NXCD, r = nwg % NXCD, xcd = wgid % NXCD, off = wgid / NXCD; wgid = (xcd < r ? xcd * (q + 1) : r * (q + 1) + (xcd - r) * q) + off; }
        const int nig = WGM * nN, gid = wgid / nig, fm = gid * WGM, gsz = (nM - fm) < WGM ? (nM - fm) : WGM;
        u.pm = fm + ((wgid % nig) % gsz); u.pn = (wgid % nig) / gsz; return true;
    }
    __device__ __forceinline__ void a_ready(const Unit&) const {}
    __device__ __forceinline__ void done(const Unit&) const {}
};
__device__ __forceinline__ unsigned cvt_pk_bf16(float lo, float hi) { unsigned r; asm volatile("v_cvt_pk_bf16_f32 %0, %1, %2" : "=v"(r) : "v"(lo), "v"(hi)); return r; }
typedef float f32x2 __attribute__((ext_vector_type(2)));
template <class Epi, class Sched, bool ALIGN_EPI = false, bool SP2 = false>
__device__ __forceinline__ void gemm_phase(PG8_LAS unsigned char* lds, const Gemm g, const Sched& S, const Epi& E) {
    const int tid = threadIdx.x, wid = __builtin_amdgcn_readfirstlane(tid >> 6), lane = tid & 63, wr = wid >> 2, wc = wid & 3, fr = lane & 15, fq = lane >> 4;
    const int K = g.K, nt = K / BK;
    unsigned voffA[2], voffB[2];
#pragma unroll
    for (int i = 0; i < 2; ++i) { int R, C; stage_rc(tid * 16 + i * 8192, R, C); const int Rb = Epi::PERM ? ((R & ~31) + perm32(R & 31)) : R;
        voffA[i] = (unsigned)(R * K + C) * 2u; voffB[i] = (unsigned)(Rb * K + C) * 2u; }
    const size_t kstep = (size_t)(BK * 2);
    const size_t hstep = (size_t)HALF * K * 2;
    const size_t tstep = 2 * hstep;
    const unsigned ldsw = (unsigned)wid * 1024u;
    const int aoff = lds_byte(wr * 64 + fr, fq * 8), boff = lds_byte(wc * 32 + fr, fq * 8);
#define PG8_SA(b, h) (((b) * 2 + (h)) * HTB)
#define PG8_SB(b, h) ((4 + (b) * 2 + (h)) * HTB)
#define PG8_STAGE(bufoff, gbase, voff) do { _Pragma("unroll") for (int _i = 0; _i < 2; ++_i) \
        __builtin_amdgcn_global_load_lds((const unsigned*)((const char*)(gbase) + (voff)[_i]), (PG8_LAS unsigned*)(lds + (bufoff) + ldsw + _i * 8192), 16, 0, 0); } while (0)
#define PG8_LDA(dst, b, h) do { _Pragma("unroll") for (int m = 0; m < 4; ++m) _Pragma("unroll") for (int k = 0; k < 2; ++k) dst[m][k] = *(const PG8_LAS bf16x8*)(lds + PG8_SA(b, h) + aoff + m * 2048 + k * 1024); } while (0)
#define PG8_LDB(dst, b, h) do { _Pragma("unroll") for (int n = 0; n < 2; ++n) _Pragma("unroll") for (int k = 0; k < 2; ++k) dst[n][k] = *(const PG8_LAS bf16x8*)(lds + PG8_SB(b, h) + boff + n * 2048 + k * 1024); } while (0)
#define PG8_MMA(ai, bj, At, Bt) do { __builtin_amdgcn_s_setprio(1); _Pragma("unroll") for (int m = 0; m < 4; ++m) _Pragma("unroll") for (int n = 0; n < 2; ++n) _Pragma("unroll") for (int k = 0; k < 2; ++k) \
        acc[ai][bj][m][n] = __builtin_amdgcn_mfma_f32_16x16x32_bf16(Bt[n][k], At[m][k], acc[ai][bj][m][n], 0, 0, 0); __builtin_amdgcn_s_setprio(0); } while (0)
#define PG8_WAIT_V(n) asm volatile("s_waitcnt vmcnt(" #n ")" ::: "memory")
#define PG8_WAIT_L(n) asm volatile("s_waitcnt lgkmcnt(" #n ")" ::: "memory")
#define PG8_BAR __builtin_amdgcn_s_barrier()
#define PG8_SCHED __builtin_amdgcn_sched_barrier(0)
    Unit cur, nxt; int ui = 0;
    if (!S.next(0, cur)) return;
    f32x4 acc[2][2][4][2];
#pragma unroll
    for (int a = 0; a < 2; ++a)
#pragma unroll
        for (int b = 0; b < 2; ++b)
#pragma unroll
            for (int m = 0; m < 4; ++m)
#pragma unroll
                for (int n = 0; n < 2; ++n) acc[a][b][m][n] = (f32x4){0.f, 0.f, 0.f, 0.f};
    bf16x8 At[4][2], B0[2][2], B1[2][2];
    const char* cA = (const char*)g.A + (size_t)cur.pm * tstep; const char* cB = (const char*)g.Bt + (size_t)cur.pn * tstep;
    S.a_ready(cur);
    if constexpr (SP2) {
        PG8_STAGE(PG8_SB(0, 0), cB, voffB); PG8_STAGE(PG8_SB(0, 1), cB + hstep, voffB); PG8_STAGE(PG8_SA(0, 0), cA, voffA); PG8_STAGE(PG8_SA(0, 1), cA + hstep, voffA);
        if (wr == 1) PG8_BAR;
        PG8_WAIT_V(2); PG8_BAR;
        PG8_STAGE(PG8_SB(1, 0), cB + kstep, voffB); PG8_STAGE(PG8_SA(1, 0), cA + kstep, voffA); PG8_STAGE(PG8_SB(1, 1), cB + hstep + kstep, voffB);
        PG8_WAIT_V(6); PG8_BAR;
    } else {
        PG8_STAGE(PG8_SB(0, 0), cB, voffB); PG8_STAGE(PG8_SA(0, 0), cA, voffA); PG8_STAGE(PG8_SB(0, 1), cB + hstep, voffB); PG8_STAGE(PG8_SA(0, 1), cA + hstep, voffA);
        if (wr == 1) PG8_BAR;
        PG8_WAIT_V(4); PG8_BAR;
        PG8_STAGE(PG8_SB(1, 0), cB + kstep, voffB); PG8_STAGE(PG8_SA(1, 0), cA + kstep, voffA); PG8_STAGE(PG8_SB(1, 1), cB + hstep + kstep, voffB);
        PG8_WAIT_V(6); PG8_BAR;
    }
    for (;;) {
        const bool has_next = S.next(ui + 1, nxt);
        const char* nA = has_next ? (const char*)g.A + (size_t)nxt.pm * tstep : cA; const char* nB = has_next ? (const char*)g.Bt + (size_t)nxt.pn * tstep : cB;
        for (int t = 0; t < nt; t += 2) {
            const bool last = (t == nt - 2);
            const char* a1 = cA + (size_t)(t + 1) * kstep;
            const char* a2 = last ? nA : cA + (size_t)(t + 2) * kstep; const char* b2 = last ? nB : cB + (size_t)(t + 2) * kstep;
            const char* a3 = a2 + kstep; const char* b3 = b2 + kstep;
            if (last && has_next) S.a_ready(nxt);
            if constexpr (SP2) {
            PG8_LDB(B0, 0, 0); PG8_LDB(B1, 0, 1); PG8_SCHED; PG8_LDA(At, 0, 0); PG8_STAGE(PG8_SA(1, 1), a1 + hstep, voffA);
            PG8_WAIT_V(8); PG8_WAIT_L(0); PG8_BAR; PG8_MMA(0, 0, At, B0); PG8_MMA(0, 1, At, B1); PG8_BAR; PG8_SCHED;
            PG8_LDA(At, 0, 1); PG8_STAGE(PG8_SB(0, 0), b2, voffB); PG8_STAGE(PG8_SB(0, 1), b2 + hstep, voffB); PG8_STAGE(PG8_SA(0, 0), a2, voffA);
            PG8_WAIT_V(8); PG8_WAIT_L(0); PG8_BAR; PG8_MMA(1, 0, At, B0); PG8_MMA(1, 1, At, B1); PG8_BAR; PG8_SCHED;
            PG8_LDB(B0, 1, 0); PG8_LDB(B1, 1, 1); PG8_SCHED; PG8_LDA(At, 1, 0); PG8_STAGE(PG8_SA(0, 1), a2 + hstep, voffA);
            PG8_WAIT_V(8); PG8_WAIT_L(0); PG8_BAR; PG8_MMA(0, 0, At, B0); PG8_MMA(0, 1, At, B1); PG8_BAR; PG8_SCHED;
            PG8_LDA(At, 1, 1); PG8_STAGE(PG8_SB(1, 0), b3, voffB); PG8_STAGE(PG8_SB(1, 1), b3 + hstep, voffB); PG8_STAGE(PG8_SA(1, 0), a3, voffA);
            PG8_WAIT_V(8); PG8_WAIT_L(0); PG8_BAR; PG8_MMA(1, 0, At, B0); PG8_MMA(1, 1, At, B1); PG8_BAR; PG8_SCHED;
            } else {
            PG8_LDB(B0, 0, 0); PG8_SCHED; PG8_LDA(At, 0, 0); PG8_STAGE(PG8_SA(1, 1), a1 + hstep, voffA);
            PG8_WAIT_L(8); PG8_BAR; PG8_WAIT_L(0); PG8_MMA(0, 0, At, B0); PG8_BAR; PG8_SCHED;
            PG8_LDB(B1, 0, 1); PG8_STAGE(PG8_SB(0, 0), b2, voffB);
            PG8_BAR; PG8_WAIT_L(0); PG8_MMA(0, 1, At, B1); PG8_BAR;
            PG8_LDA(At, 0, 1); PG8_STAGE(PG8_SA(0, 0), a2, voffA);
            PG8_BAR; PG8_WAIT_L(0); PG8_MMA(1, 0, At, B0); PG8_BAR; PG8_SCHED;
            PG8_STAGE(PG8_SB(0, 1), b2 + hstep, voffB);
            PG8_WAIT_V(6); PG8_BAR; PG8_MMA(1, 1, At, B1); PG8_BAR;
            PG8_LDB(B0, 1, 0); PG8_SCHED; PG8_LDA(At, 1, 0); PG8_STAGE(PG8_SA(0, 1), a2 + hstep, voffA);
            PG8_WAIT_L(8); PG8_BAR; PG8_WAIT_L(0); PG8_MMA(0, 0, At, B0); PG8_BAR; PG8_SCHED;
            PG8_LDB(B1, 1, 1); PG8_STAGE(PG8_SB(1, 0), b3, voffB);
            PG8_BAR; PG8_WAIT_L(0); PG8_MMA(0, 1, At, B1); PG8_BAR;
            PG8_LDA(At, 1, 1); PG8_STAGE(PG8_SA(1, 0), a3, voffA);
            PG8_BAR; PG8_WAIT_L(0); PG8_MMA(1, 0, At, B0); PG8_BAR; PG8_SCHED;
            PG8_STAGE(PG8_SB(1, 1), b3 + hstep, voffB);
            PG8_WAIT_V(6); PG8_BAR; PG8_MMA(1, 1, At, B1); PG8_BAR;
            }
        }
        if constexpr (ALIGN_EPI) { if (wr == 0) PG8_BAR; }
        if constexpr (!Epi::AFTER_DRAIN) { E(acc, cur, wr, wc, fr, fq); S.done(cur); }
        if (!has_next) break;
#pragma unroll
        for (int a = 0; a < 2; ++a)
#pragma unroll
            for (int b = 0; b < 2; ++b)
#pragma unroll
                for (int m = 0; m < 4; ++m)
#pragma unroll
                    for (int n = 0; n < 2; ++n) acc[a][b][m][n] = (f32x4){0.f, 0.f, 0.f, 0.f};
        cur = nxt; cA = nA; cB = nB; ++ui;
        if constexpr (ALIGN_EPI) { if (wr == 1) PG8_BAR; }
    }
    PG8_WAIT_V(0);
    if constexpr (!ALIGN_EPI) { if (wr == 0) PG8_BAR; }
    PG8_BAR;
    if constexpr (Epi::AFTER_DRAIN) { E.fused(acc, cur, wr, wc, fr, fq, lds, wid, lane); S.done(cur); }
#undef PG8_SA
#undef PG8_SB
#undef PG8_STAGE
#undef PG8_LDA
#undef PG8_LDB
#undef PG8_MMA
#undef PG8_WAIT_V
#undef PG8_WAIT_L
#undef PG8_BAR
#undef PG8_SCHED
}
}

using pg8::bf16x8; using pg8::f32x4; using pg8::u32x4;
#define LDS_WAIT() asm volatile("s_waitcnt lgkmcnt(0)" ::: "memory")
#define VM_WAIT() asm volatile("s_waitcnt vmcnt(0)" ::: "memory")
typedef float f32x2_t __attribute__((ext_vector_type(2))); typedef __bf16 bf16x2_t __attribute__((ext_vector_type(2)));
__device__ __forceinline__ unsigned pk2(float lo, float hi) { f32x2_t v = {lo, hi}; bf16x2_t b = __builtin_convertvector(v, bf16x2_t); return __builtin_bit_cast(unsigned, b); }
__device__ __forceinline__ float bf_lo(unsigned w) { return __uint_as_float(w << 16); }
__device__ __forceinline__ float bf_hi(unsigned w) { return __uint_as_float(w & 0xffff0000u); }
__device__ __forceinline__ float bf1(bf16 b) { return __uint_as_float(((unsigned)b) << 16); }
__device__ __forceinline__ float fexp2(float x) { return __builtin_amdgcn_exp2f(x); }
__device__ __forceinline__ float fexp(float x) { return __builtin_amdgcn_exp2f(x * 1.4426950408889634f); }
__device__ __forceinline__ float frcp(float x) { return __builtin_amdgcn_rcpf(x); }
__device__ __forceinline__ float sigmoidf_(float x) { return frcp(1.0f + fexp(-x)); }
__device__ __forceinline__ float siluf_(float x) { return x * sigmoidf_(x); }
__device__ __forceinline__ float gelu_tanh(float x) {
    const float u = 0.7978845608028654f * (x + 0.044715f * x * x * x);
    const float e = fexp(2.0f * u);
    const float t = 1.0f - 2.0f * frcp(e + 1.0f);
    return 0.5f * x * (1.0f + t);
}
__device__ __forceinline__ float wave_sum(float v) {
#pragma unroll
    for (int o = 1; o < 64; o <<= 1) v += __shfl_xor(v, o);
    return v;
}
__device__ __forceinline__ v4u pack8(const f32x4 a, const f32x4 b) { v4u w; w.x = pk2(a[0], a[1]); w.y = pk2(a[2], a[3]); w.z = pk2(b[0], b[1]); w.w = pk2(b[2], b[3]); return w; }
__device__ __forceinline__ void unpack8(const v4u w, f32x4& a, f32x4& b) { a = (f32x4){bf_lo(w.x), bf_hi(w.x), bf_lo(w.y), bf_hi(w.y)}; b = (f32x4){bf_lo(w.z), bf_hi(w.z), bf_lo(w.w), bf_hi(w.w)}; }

#define XB_TMO      128
#define XB_XCNT(j)  (256  + 64 * (j))
#define XB_XSUB(j)  (1280 + 64 * (j))
#define XB_XGEN(j)  (2304 + 64 * (j))
#define XB_TOP      3328
#define XB_TOPGEN   3392
#define XCD_BAR_WORDS 3456
#define XB_SPIN_CAP (1u << 18)

__device__ __forceinline__ unsigned xb_ld(unsigned* p)              { return __hip_atomic_load(p, __ATOMIC_RELAXED, __HIP_MEMORY_SCOPE_AGENT); }
__device__ __forceinline__ unsigned xb_add(unsigned* p, unsigned v) { return __hip_atomic_fetch_add(p, v, __ATOMIC_RELAXED, __HIP_MEMORY_SCOPE_AGENT); }
__device__ __forceinline__ unsigned xb_xcc_id() { return (unsigned)__builtin_amdgcn_s_getreg((3 << 11) | 20) & 0xFu; }
#define XB_SPIN(cond, bar) do { unsigned _sp = 0; while (cond) { __builtin_amdgcn_s_sleep(1); \
    if ((++_sp & 255u) == 0u) { if (xb_ld(&(bar)[XB_TMO])) break; if (_sp > XB_SPIN_CAP) { atomicAdd(&(bar)[XB_TMO], 1u); break; } } } } while (0)

struct XcdBarrier {
    unsigned* bar; unsigned x;
    volatile LAS unsigned* st;
};

__device__ __forceinline__ XcdBarrier xcd_barrier_post(unsigned* bar, volatile LAS unsigned* st) {
    XcdBarrier b; b.bar = bar; b.x = xb_xcc_id(); b.st = st;
    if (threadIdx.x == 0) (void)xb_add(&bar[XB_XCNT(b.x)], 1u);
    return b;
}
__device__ __forceinline__ void xcd_barrier_complete(unsigned* bar, unsigned x, unsigned& nloc, unsigned& nx) {
    const unsigned G = gridDim.x * gridDim.y * gridDim.z;
    unsigned sum, cnt, mine, sp = 0u;
    for (;;) {
        sum = 0u; cnt = 0u; mine = 0u;
#pragma unroll
        for (unsigned j = 0; j < 16; ++j) { const unsigned c = xb_ld(&bar[XB_XCNT(j)]); sum += c; cnt += (c > 0u) ? 1u : 0u; mine = (j == x) ? c : mine; }
        if (sum == G) break;
        __builtin_amdgcn_s_sleep(1);
        if ((++sp & 255u) == 0u) { if (xb_ld(&bar[XB_TMO])) break; if (sp > XB_SPIN_CAP) { atomicAdd(&bar[XB_TMO], 1u); break; } }
    }
    nloc = mine > 0u ? mine : 1u; nx = cnt > 0u ? cnt : 1u;
}

__device__ __forceinline__ void xcd_barrier(const XcdBarrier& b) {
    asm volatile("s_waitcnt vmcnt(0)" ::: "memory");
    __syncthreads();
    if (threadIdx.x == 0) {
        unsigned* bar = b.bar;
        __builtin_amdgcn_s_waitcnt(0);
        unsigned nloc = b.st[0], nx = b.st[1];
        if (nloc == 0u) { xcd_barrier_complete(bar, b.x, nloc, nx); b.st[0] = nloc; b.st[1] = nx; }
        const unsigned old = xb_add(&bar[XB_XSUB(b.x)], 1u);
        const unsigned gen = old / nloc;
        if (old + 1u == (gen + 1u) * nloc) {
            __builtin_amdgcn_fence(__ATOMIC_RELEASE, "agent");
            asm volatile("s_waitcnt vmcnt(0)" ::: "memory");
            const unsigned og = xb_add(&bar[XB_TOP], 1u);
            const unsigned tg = og / nx;
            if (og + 1u == (tg + 1u) * nx) xb_add(&bar[XB_TOPGEN], 1u);
            else XB_SPIN(xb_ld(&bar[XB_TOPGEN]) == tg, bar);
            __builtin_amdgcn_fence(__ATOMIC_ACQUIRE, "agent");
            xb_add(&bar[XB_XGEN(b.x)], 1u);
            asm volatile("s_waitcnt vmcnt(0)" ::: "memory");
        } else {
            XB_SPIN(xb_ld(&bar[XB_XGEN(b.x)]) == gen, bar);
            __builtin_amdgcn_fence(__ATOMIC_ACQUIRE, "agent");
            asm volatile("s_waitcnt vmcnt(0)" ::: "memory");
        }
    }
    __syncthreads();
}

struct Args { const void* in[37]; float* out; unsigned char* ws; int ph_lo, ph_hi; };
enum { I_XP = 0, I_XS, I_CACHE, I_CWIN, I_SRET, I_SH, I_SCONV, I_SFFN, I_PT, I_CP, I_CS, I_N1G, I_N2G, I_WADA, I_BADA, I_WIN, I_PE, I_W1, I_B1, I_W2,
       I_GNG, I_RCW, I_RCB, I_RWA, I_RBA, I_RWX, I_RBX, I_LAM, I_WBRA, I_WBRB, I_WBRC, I_WOUT, I_WUP, I_FCW, I_FCB, I_WDN, I_FNG };

struct Frame {
    LAS unsigned char* lds;
    int tid, lane, wave, G, bid;
    const Args* a;
    unsigned char* ws;
    float* out;
};
__device__ __forceinline__ void launder(Frame& F) { asm volatile("" : "+v"(F.tid), "+v"(F.lane)); int w_ = __builtin_amdgcn_readfirstlane(F.wave), b_ = __builtin_amdgcn_readfirstlane(F.bid), g_ = __builtin_amdgcn_readfirstlane(F.G); asm volatile("" : "+s"(w_), "+s"(b_), "+s"(g_)); F.wave = w_; F.bid = b_; F.G = g_; }
#define FIN(i) ((const float*)F.a->in[i])
#define WSP(T, off) ((T*)(F.ws + (off)))

__device__ __forceinline__ int row_bb(int row) { return row < PM ? (row >> 12) : 4 + ((row - PM) >> 3); }
__device__ __forceinline__ int row_pos(int row) { return row < PM ? (row & (PT - 1)) : PT + ((row - PM) & 7); }

__device__ __forceinline__ int win_cmap(int n) {
    if (n < 1280) return n;
    if (n < 2304) { const int c = n - 1280, isk = c >> 9, hc = c & 511, head = hc >> 7, s = hc & 127;
        const int g = s >> 3, w = s & 7, dim = (w < 4) ? (4 * g + w) : (64 + 4 * g + (w - 4)); return (isk ? O_RK : O_RQ) + head * 128 + dim; }
    if (n < 2816) return O_RV + (n - 2304);
    if (n < 3328) return O_RG + (n - 2816);
    if (n < 3840) return O_RX + (n - 3328);
    if (n < 4352) return O_RGATE + (n - 3840);
    if (n < 7424) return O_MG + (n - 4352);
    if (n < 7448) return O_NG + (n - 7424);
    return -1;
}

struct TrItem { const float* W; bf16* WT; int ldw, ldt, k0, n0; bool map; };
__device__ __forceinline__ void p0_tr_load(const TrItem& I, float (&tv)[32], int lane) {
    const int nd = I.n0 + (lane & 31); const int sc = I.map ? win_cmap(nd) : nd;
#pragma unroll
    for (int i = 0; i < 32; ++i) { const int kk = 2 * i + (lane >> 5); tv[i] = (sc >= 0) ? I.W[(size_t)(I.k0 + kk) * I.ldw + sc] : 0.f; }
}
__device__ __forceinline__ void p0_tr_finish(const TrItem& I, const float (&tv)[32], LAS float* scr, int lane) {
#pragma unroll
    for (int i = 0; i < 32; ++i) { const int kk = 2 * i + (lane >> 5); scr[kk * 33 + (lane & 31)] = tv[i]; }
    LDS_WAIT(); asm volatile("" ::: "memory");
    const int c = lane & 7;
#pragma unroll
    for (int j = 0; j < 4; ++j) { const int n = (lane >> 3) + 8 * j; const LAS float* s = scr + (8 * c) * 33 + n;
        v4u o; o.x = pk2(s[0 * 33], s[1 * 33]); o.y = pk2(s[2 * 33], s[3 * 33]); o.z = pk2(s[4 * 33], s[5 * 33]); o.w = pk2(s[6 * 33], s[7 * 33]);
        *(v4u*)(I.WT + (size_t)(I.n0 + n) * I.ldt + I.k0 + 8 * c) = o; }
    LDS_WAIT(); asm volatile("" ::: "memory");
}
template <bool MAP> __device__ __forceinline__ void p0_tr_item(const float* W, int ldw, bf16* WT, int ldt, int k0, int n0, LAS float* scr, int lane) {
    TrItem I{W, WT, ldw, ldt, k0, n0, MAP}; float tv[32]; p0_tr_load(I, tv, lane); p0_tr_finish(I, tv, scr, lane);
}
template <bool MAP> __device__ __forceinline__ void p0_tr_item2(const float* W, int ldw, bf16* WT, int ldt, int k0, int n0, LAS float* scr, int lane) {
    TrItem I0{W, WT, ldw, ldt, k0, n0, MAP}, I1{W, WT, ldw, ldt, k0, n0 + 32, MAP}; float t0[32], t1[32];
    p0_tr_load(I0, t0, lane); p0_tr_load(I1, t1, lane); p0_tr_finish(I0, t0, scr, lane); p0_tr_finish(I1, t1, scr, lane);
}
__device__ __forceinline__ void sincos_acc(float ang, float& s, float& c) {
    const double a = (double)ang; const double kq = rint(a * 0.63661977236758134308); const double r = fma(-kq, 1.57079632679489661923, a);
    const double r2 = r * r;
    const double sp = r * (1.0 + r2 * (-1.6666666666666666e-1 + r2 * (8.3333333333333332e-3 + r2 * (-1.9841269841269841e-4 + r2 * (2.7557319223985893e-6 + r2 * (-2.5052108385441720e-8))))));
    const double cp = 1.0 + r2 * (-0.5 + r2 * (4.1666666666666664e-2 + r2 * (-1.3888888888888889e-3 + r2 * (2.4801587301587302e-5 + r2 * (-2.7557319223985888e-7 + r2 * 2.0876756987868099e-9)))));
    const int q = ((int)kq) & 3;
    const double ss = (q == 0) ? sp : (q == 1) ? cp : (q == 2) ? -sp : -cp;
    const double cc = (q == 0) ? cp : (q == 1) ? -sp : (q == 2) ? -cp : sp;
    s = (float)ss; c = (float)cc;
}

__device__ __forceinline__ void p0_prologue(Frame& F) {
    const int gw = F.bid * NWAVES + F.wave, NGW = F.G * NWAVES, lane = F.lane;
    LAS float* scr = (LAS float*)(F.lds + F.wave * 16384);
    {
        constexpr int I_IN = 16 * 240, I_BR = 8 * 32, I_OUT = 16 * 32, I_UP = 16 * 176, I_DN = 44 * 32, I_L = I_IN + 3 * I_BR + I_OUT + I_UP + I_DN;
        for (int it = gw; it < 2 * I_L; it += NGW) {
            const int l = it / I_L; int r = it % I_L;
            if (r < I_IN) { p0_tr_item<true>(FIN(I_WIN) + (size_t)l * DM * D_IN, D_IN, WSP(bf16, WS_WIN) + (size_t)l * NIN * DM, DM, 64 * (r / 240), 32 * (r % 240), scr, lane); continue; } r -= I_IN;
            if (r < 3 * I_BR) { const int w = r / I_BR, q = r % I_BR; const float* src = FIN(w == 0 ? I_WBRA : (w == 1 ? I_WBRB : I_WBRC)) + (size_t)l * 512 * 1024;
                p0_tr_item<false>(src, 1024, WSP(bf16, WS_WBR) + (size_t)(l * 3 + w) * 1024 * 512, 512, 64 * (q / 32), 32 * (q % 32), scr, lane); continue; } r -= 3 * I_BR;
            if (r < I_OUT) { p0_tr_item<false>(FIN(I_WOUT) + (size_t)l * 1024 * 1024, 1024, WSP(bf16, WS_WOUT) + (size_t)l * 1024 * 1024, 1024, 64 * (r / 32), 32 * (r % 32), scr, lane); continue; } r -= I_OUT;
            if (r < I_UP) { p0_tr_item<false>(FIN(I_WUP) + (size_t)l * DM * NUP, NUP, WSP(bf16, WS_WUP) + (size_t)l * NUP * DM, DM, 64 * (r / 176), 32 * (r % 176), scr, lane); continue; } r -= I_UP;
            p0_tr_item<false>(FIN(I_WDN) + (size_t)l * DFF * DM, DM, WSP(bf16, WS_WDN) + (size_t)l * DM * DFF, DFF, 64 * (r / 32), 32 * (r % 32), scr, lane);
        }
    }
    {
        constexpr int NI_W1 = 8 * 16 * 4, NI_W2 = 4 * 2 * 2, NI_RG = 32 * 2;
        for (int it = gw; it < NI_W1 + NI_W2 + NI_RG; it += NGW) {
            int r = it;
            if (r < NI_W1) { const int m = r / 64, q = r % 64, lk = m >> 1, half = m & 1;
                p0_tr_item<false>(FIN(I_W1) + ((size_t)lk * 32 + half * 16) * 64 * 128, 128, WSP(bf16, WS_SMALLW + SW_W1T) + ((size_t)lk * 256 + half * 128) * 1024, 1024, 64 * (q / 4), 32 * (q % 4), scr, lane); continue; } r -= NI_W1;
            if (r < NI_W2) { const int lk = r / 4, q = r % 4;
                p0_tr_item<false>(FIN(I_W2) + (size_t)lk * 128 * 64, 64, WSP(bf16, WS_SMALLW + SW_W2T) + (size_t)lk * 64 * 128, 128, 64 * (q / 2), 32 * (q % 2), scr, lane); continue; } r -= NI_W2;
            { const int m = r / 2, q = r % 2, l = m >> 4, which = (m >> 3) & 1, blk = m & 7;
                p0_tr_item<false>(FIN(which ? I_RWX : I_RWA) + ((size_t)l * 8 + blk) * 4096, 64, WSP(bf16, WS_SMALLW + SW_WAT) + (size_t)m * 4096, 64, 0, 32 * q, scr, lane); }
        }
    }
    for (int it = gw; it < 64; it += NGW) {
        const int lk = it >> 4, h0 = (it & 15) * 8; const float* pe = FIN(I_PE) + (size_t)lk * 2048; const float* w1 = FIN(I_W1) + (size_t)lk * 2048 * 128 + h0;
        f32x4 a0 = (f32x4){0.f, 0.f, 0.f, 0.f}, a1 = a0;
#pragma unroll 8
        for (int i = lane; i < 2048; i += 64) { const float p = pe[i]; a0 += *(const f32x4*)(w1 + (size_t)i * 128) * p; a1 += *(const f32x4*)(w1 + (size_t)i * 128 + 4) * p; }
#pragma unroll
        for (int x = 0; x < 4; ++x) { a0[x] = wave_sum(a0[x]); a1[x] = wave_sum(a1[x]); }
        if (lane == 0) { float* cb = WSP(float, WS_SMALLW + SW_CB) + lk * 128 + h0; const float* b1 = FIN(I_B1) + lk * 128 + h0;
#pragma unroll
            for (int x = 0; x < 4; ++x) { cb[x] = a0[x] + b1[x]; cb[4 + x] = a1[x] + b1[4 + x]; } }
    }
    for (int i = F.bid * NTHR + F.tid; i < 1024; i += F.G * NTHR) { const float lam = FIN(I_LAM)[i]; WSP(float, WS_SMALLW + SW_SP)[i] = log1pf(expf(-lam)); }
    for (int i = F.bid * NTHR + F.tid; i < 4104 * 64; i += F.G * NTHR) {
        const int pi = i >> 6, fi = i & 63; const float pos = (float)(pi < PT ? pi : PAST + (pi - PT));
        const float freq = (float)pow(10000.0, -(double)fi / 64.0); const float ang = pos * freq; float s, c; sincos_acc(ang, s, c);
        WSP(float, WS_ROT)[i] = c; WSP(float, WS_ROT)[4104 * 64 + i] = s;
    }
    {
        LAS float* SC = (LAS float*)(F.lds + 0);
        LAS float* RED = (LAS float*)(F.lds + 36864);
        for (int u = F.bid; u < 2 * 96; u += F.G) {
            const int l = u / 96, cg = u % 96; float acc[36];
#pragma unroll
            for (int b = 0; b < 36; ++b) acc[b] = 0.f;
#pragma unroll 1
            for (int kh = 0; kh < 4; ++kh) {
                __syncthreads();
                {   float cv[18];
                    const float* cpp = FIN(I_CP); const float* csp = FIN(I_CS);
#pragma unroll
                    for (int it = 0; it < 18; ++it) { const int i = F.tid + NTHR * it, bb = i >> 8, d = i & 255;
                        cv[it] = (bb < 4) ? cpp[bb * DM + kh * 256 + d] : csp[(bb - 4) * DM + kh * 256 + d]; }
#pragma unroll
                    for (int it = 0; it < 18; ++it) { const int i = F.tid + NTHR * it, bb = i >> 8, d = i & 255; SC[d * 36 + bb] = siluf_(cv[it]); }
                }
                __syncthreads();
                const float* wp = FIN(I_WADA) + ((size_t)l * DM + kh * 256 + F.wave * 32) * 6144 + cg * 64 + lane;
                {
                    float wv[32];
#pragma unroll
                    for (int k = 0; k < 32; ++k) wv[k] = wp[(size_t)k * 6144];
                    const LAS f32x4* scb = (const LAS f32x4*)(SC + (F.wave * 32) * 36);
                    f32x4 sa[9], sb[9];
#pragma unroll
                    for (int g = 0; g < 9; ++g) sa[g] = scb[g];
#pragma unroll
                    for (int k = 0; k < 32; k += 2) {
#pragma unroll
                        for (int g = 0; g < 9; ++g) sb[g] = scb[(k + 1) * 9 + g];
#pragma unroll
                        for (int g = 0; g < 9; ++g) { acc[4 * g + 0] += wv[k] * sa[g][0]; acc[4 * g + 1] += wv[k] * sa[g][1]; acc[4 * g + 2] += wv[k] * sa[g][2]; acc[4 * g + 3] += wv[k] * sa[g][3]; }
                        if (k + 2 < 32) {
#pragma unroll
                            for (int g = 0; g < 9; ++g) sa[g] = scb[(k + 2) * 9 + g]; }
#pragma unroll
                        for (int g = 0; g < 9; ++g) { acc[4 * g + 0] += wv[k + 1] * sb[g][0]; acc[4 * g + 1] += wv[k + 1] * sb[g][1]; acc[4 * g + 2] += wv[k + 1] * sb[g][2]; acc[4 * g + 3] += wv[k + 1] * sb[g][3]; }
                    }
                }
            }
#pragma unroll
            for (int b = 0; b < 36; ++b) RED[(F.wave * 36 + b) * 64 + lane] = acc[b];
            __syncthreads();
            for (int o = F.tid; o < 36 * 64; o += NTHR) { const int b = o >> 6, col = o & 63; float sm = FIN(I_BADA)[l * 6144 + cg * 64 + col];
#pragma unroll
                for (int w = 0; w < 8; ++w) sm += RED[(w * 36 + b) * 64 + col];
                WSP(float, WS_MOD)[((size_t)l * 36 + b) * 6144 + cg * 64 + col] = sm; }
        }
        __syncthreads();
    }
    {   constexpr size_t NV4 = (size_t)2 * SB * 504 * 64; const size_t stride = (size_t)F.G * NTHR;
        for (size_t i0 = (size_t)F.bid * NTHR + F.tid; i0 < NV4; i0 += 8 * stride) {
            f32x4 v[8];
#pragma unroll
            for (int k = 0; k < 8; ++k) { const size_t i = i0 + k * stride; if (i < NV4) { const size_t seq = i / (504 * 64), r = i % (504 * 64); v[k] = __builtin_nontemporal_load((const f32x4*)(FIN(I_CWIN) + (seq * 512 + 8) * 256 + r * 4)); } }
#pragma unroll
            for (int k = 0; k < 8; ++k) { const size_t i = i0 + k * stride; if (i < NV4) { const size_t seq = i / (504 * 64), r = i % (504 * 64); *(f32x4*)(F.out + OUT_WIN_S + seq * 512 * 256 + r * 4) = v[k]; } }
        }
    }
}

__device__ __forceinline__ f32x4 ld4_bf(const bf16* p) { const v2u w = *(const v2u*)p; return (f32x4){bf_lo(w.x), bf_hi(w.x), bf_lo(w.y), bf_hi(w.y)}; }
__device__ __forceinline__ void norm_phase(Frame& F, int l, int which) {
    const int gw = F.bid * NWAVES + F.wave, NGW = F.G * NWAVES, lane = F.lane;
    const float* g = FIN(which ? I_N2G : I_N1G) + l * DM;
    constexpr int NR = 4;
    for (int row0 = gw * NR; row0 < MT; row0 += NGW * NR) {
        f32x4 v[NR][4]; float ss[NR];
#pragma unroll
        for (int rr = 0; rr < NR; ++rr) { const int row = row0 + rr;
            if (which == 0 && l == 0) { const float* xr = row < PM ? FIN(I_XP) + (size_t)row * DM : FIN(I_XS) + (size_t)(row - PM) * DM;
#pragma unroll
                for (int j = 0; j < 4; ++j) v[rr][j] = *(const f32x4*)(xr + lane * 4 + 256 * j); }
            else { const bf16* xr = WSP(bf16, which ? WS_X1 : WS_X2) + (size_t)row * DM;
#pragma unroll
                for (int j = 0; j < 4; ++j) v[rr][j] = ld4_bf(xr + lane * 4 + 256 * j); } }
#pragma unroll
        for (int rr = 0; rr < NR; ++rr) { float a = 0.f;
#pragma unroll
            for (int j = 0; j < 4; ++j) a += (v[rr][j][0] * v[rr][j][0] + v[rr][j][1] * v[rr][j][1]) + (v[rr][j][2] * v[rr][j][2] + v[rr][j][3] * v[rr][j][3]);
            ss[rr] = a; }
#pragma unroll
        for (int o = 1; o < 64; o <<= 1) {
#pragma unroll
            for (int rr = 0; rr < NR; ++rr) ss[rr] += __shfl_xor(ss[rr], o); }
#pragma unroll
        for (int rr = 0; rr < NR; ++rr) { const int row = row0 + rr; const float rs = 1.0f / sqrtf(ss[rr] * (1.0f / DM) + EPS);
            const float* mod = WSP(float, WS_MOD) + ((size_t)l * 36 + row_bb(row)) * 6144 + (which ? 3072 : 0); bf16* o = WSP(bf16, WS_H) + (size_t)row * DM;
#pragma unroll
            for (int j = 0; j < 4; ++j) { const int c = lane * 4 + 256 * j; const f32x4 gg = *(const f32x4*)(g + c), sh = *(const f32x4*)(mod + c), sc = *(const f32x4*)(mod + 1024 + c);
                const f32x4 y = (v[rr][j] * rs) * gg * (sc + 1.0f) + sh; v2u w; w.x = pk2(y[0], y[1]); w.y = pk2(y[2], y[3]); *(v2u*)(o + c) = w; } }
    }
}
__device__ __forceinline__ void final_phase(Frame& F) {
    const int gw = F.bid * NWAVES + F.wave, NGW = F.G * NWAVES, lane = F.lane;
    const float* g = FIN(I_FNG);
    for (int row0 = gw * 4; row0 < MT; row0 += NGW * 4) {
        f32x4 v[4][4]; float ss[4];
#pragma unroll
        for (int rr = 0; rr < 4; ++rr) { const bf16* xr = WSP(bf16, WS_X2) + (size_t)(row0 + rr) * DM; float a = 0.f;
#pragma unroll
            for (int j = 0; j < 4; ++j) { v[rr][j] = ld4_bf(xr + lane * 4 + 256 * j); a += (v[rr][j][0] * v[rr][j][0] + v[rr][j][1] * v[rr][j][1]) + (v[rr][j][2] * v[rr][j][2] + v[rr][j][3] * v[rr][j][3]); }
            ss[rr] = a; }
#pragma unroll
        for (int rr = 0; rr < 4; ++rr) { const float rs = 1.0f / sqrtf(wave_sum(ss[rr]) * (1.0f / DM) + EPS);
            float* o = F.out + OUT_Y + (size_t)(row0 + rr) * DM;
#pragma unroll
            for (int j = 0; j < 4; ++j) { const int c = lane * 4 + 256 * j; *(f32x4*)(o + c) = (v[rr][j] * rs) * *(const f32x4*)(g + c); } }
    }
}

#define EPI_LOOP_BEGIN \
    _Pragma("unroll") for (int ai = 0; ai < 2; ++ai) _Pragma("unroll") for (int m = 0; m < 4; ++m) { const int row = u.pm * 256 + ai * 128 + wr * 64 + m * 16 + fr; \
    _Pragma("unroll") for (int bj = 0; bj < 2; ++bj) { const int ct = bj * 128 + wc * 32 + 8 * fq; const f32x4 v0 = acc[ai][bj][m][0], v1 = acc[ai][bj][m][1];
#define EPI_LOOP_END } }

struct EpiWin {
    static constexpr bool PERM = true, AFTER_DRAIN = false;
    unsigned char* ws; float* out; int l;
    __device__ __forceinline__ void operator()(const f32x4 (&acc)[2][2][4][2], const pg8::Unit& u, int wr, int wc, int fr0, int fq0) const {
        int fr = fr0, fq = fq0; asm volatile("" : "+v"(fr), "+v"(fq));
        const int pn = u.pn;
        if (pn < 2) {
            bf16* QN = (bf16*)(ws + WS_QN);
            EPI_LOOP_BEGIN *(v4u*)(QN + (size_t)row * 512 + pn * 256 + ct) = pack8(v0 * QSCALE, v1 * QSCALE); EPI_LOOP_END
        } else if (pn < 5) {
            EPI_LOOP_BEGIN
                const int c = (pn - 2) * 256 + ct, j = c >> 7, k = (c >> 6) & 1, d = c & 63;
                const bool isp = row < PM; const int b = isp ? (row >> 12) : ((row - PM) >> 3), t = isp ? (row & (PT - 1)) : ((row - PM) & 7);
                if (j < 4) { float* o = out + (isp ? OUT_ROWS_P + ((size_t)l * PM + row) * 512 : OUT_ROWS_S + ((size_t)l * SM + (row - PM)) * 512) + c; *(f32x4*)o = v0; *(f32x4*)(o + 4) = v1; }
                else if (isp) { if (t >= PT - WINB) { float* o = out + OUT_WIN_P + (((size_t)l * PB + b) * WINB + (t - (PT - WINB))) * 256 + (c - 512); *(f32x4*)o = v0; *(f32x4*)(o + 4) = v1; } }
                else { float* o = out + OUT_WIN_S + (((size_t)l * SB + b) * WINB + (WINB - ST) + t) * 256 + (c - 512); *(f32x4*)o = v0; *(f32x4*)(o + 4) = v1; }
                const v4u w = pack8(v0, v1);
                if (isp) {
                    if (j < 2) *(v4u*)((bf16*)(ws + WS_ACMP) + ((size_t)(l * 2 + j) * CMP_ROWS_J + 32768 + (b * 2 + k) * 256) * 1024 + (size_t)t * 64 + d) = w;
                    else if (j & 1) {
                        const int tq = t & 31, s2 = tq >> 4, hh = (tq >> 2) & 1, ii = (tq & 3) + 4 * ((tq >> 3) & 1);
                        bf16* vt = (bf16*)(ws + WS_KVB) + (((size_t)(j - 2) * PB + b) * 2 + k) * PT * 64 + (size_t)(t >> 5) * 2048 + ((((d >> 5) * 2 + s2) * 2 + hh) * 32 + (d & 31)) * 8 + ii;
                        vt[0] = (bf16)(w.x & 0xffffu); vt[8] = (bf16)(w.x >> 16); vt[16] = (bf16)(w.y & 0xffffu); vt[24] = (bf16)(w.y >> 16);
                        vt[32] = (bf16)(w.z & 0xffffu); vt[40] = (bf16)(w.z >> 16); vt[48] = (bf16)(w.w & 0xffffu); vt[56] = (bf16)(w.w >> 16); }
                    else *(v4u*)((bf16*)(ws + WS_KVB) + (((size_t)(j - 2) * PB + b) * 2 + k) * PT * 64 + (size_t)(t >> 5) * 2048 + ((d >> 3) * 32 + (t & 31)) * 8) = w;
                } else if (j >= 2) *(v4u*)((bf16*)(ws + WS_KVS) + ((((size_t)(j - 2) * SB + b) * 2 + k) * ST + t) * 64 + d) = w;
            EPI_LOOP_END
        } else if (pn < 9) {
            const float* ROTC = (const float*)(ws + WS_ROT); const float* ROTS = ROTC + 4104 * 64;
#pragma unroll
            for (int ai = 0; ai < 2; ++ai) {
                f32x4 cs[4][2], sn[4][2];
#pragma unroll
                for (int m = 0; m < 4; ++m) { const int row = u.pm * 256 + ai * 128 + wr * 64 + m * 16 + fr; const int pi = row_pos(row);
#pragma unroll
                    for (int bj = 0; bj < 2; ++bj) { const int ct = bj * 128 + wc * 32 + 8 * fq; const int c = (pn - 5) * 256 + ct, d0 = (((c & 511) & 127) >> 3) * 4; cs[m][bj] = *(const f32x4*)(ROTC + pi * 64 + d0); sn[m][bj] = *(const f32x4*)(ROTS + pi * 64 + d0); } }
#pragma unroll
                for (int m = 0; m < 4; ++m) { const int row = u.pm * 256 + ai * 128 + wr * 64 + m * 16 + fr;
#pragma unroll
                    for (int bj = 0; bj < 2; ++bj) { const int ct = bj * 128 + wc * 32 + 8 * fq; const f32x4 v0 = acc[ai][bj][m][0], v1 = acc[ai][bj][m][1];
                        const int c = (pn - 5) * 256 + ct, isk = c >> 9, hc = c & 511, head = hc >> 7, d0 = ((hc & 127) >> 3) * 4;
                        const float sc = isk ? 0.08838834764831845f : 1.0f;
                        const f32x4 o1 = (v0 * cs[m][bj] - v1 * sn[m][bj]) * sc, o2 = (v0 * sn[m][bj] + v1 * cs[m][bj]) * sc;
                        bf16* o = (bf16*)(ws + WS_RQ) + (size_t)isk * MT * 512 + (size_t)row * 512 + head * 128 + d0;
                        v2u w1; w1.x = pk2(o1[0], o1[1]); w1.y = pk2(o1[2], o1[3]); *(v2u*)o = w1;
                        v2u w2; w2.x = pk2(o2[0], o2[1]); w2.y = pk2(o2[2], o2[3]); *(v2u*)(o + 64) = w2; } }
            }
        } else if (pn < 13) {
            bf16* RV = (bf16*)(ws + WS_RQ) + (size_t)2 * MT * 512;
            EPI_LOOP_BEGIN const int c = (pn - 9) * 256 + ct; *(v4u*)(RV + (size_t)(c >> 9) * MT * 512 + (size_t)row * 512 + (c & 511)) = pack8(v0, v1); EPI_LOOP_END
        } else if (pn < 15) {
            float* RX = (float*)(ws + WS_RX);
            EPI_LOOP_BEGIN
                const int c = (pn - 13) * 256 + ct; float* o = RX + (size_t)row * 512 + c; *(f32x4*)o = v0; *(f32x4*)(o + 4) = v1;
                if (row < PM) { const int t = row & (PT - 1); if (t >= PT - 3) { float* q = out + OUT_CV_P + (((size_t)l * PB + (row >> 12)) * 3 + (t - (PT - 3))) * 512 + c; *(f32x4*)q = v0; *(f32x4*)(q + 4) = v1; } }
                else { const int i = (row - PM) & 7; if (i >= ST - 3) { float* q = out + OUT_CV_S + (((size_t)l * SB + ((row - PM) >> 3)) * 3 + (i - (ST - 3))) * 512 + c; *(f32x4*)q = v0; *(f32x4*)(q + 4) = v1; } }
            EPI_LOOP_END
        } else if (pn < 17) {
            bf16* GG = (bf16*)(ws + WS_GG);
            EPI_LOOP_BEGIN const int c = (pn - 15) * 256 + ct;
                f32x4 a, b;
#pragma unroll
                for (int i = 0; i < 4; ++i) { a[i] = gelu_tanh(v0[i]); b[i] = gelu_tanh(v1[i]); }
                *(v4u*)(GG + (size_t)row * 512 + c) = pack8(a, b); EPI_LOOP_END
        } else if (pn < 29) {
            bf16* MG = (bf16*)(ws + WS_MGS);
            EPI_LOOP_BEGIN const int c = (pn - 17) * 256 + ct;
                f32x4 a, b;
#pragma unroll
                for (int i = 0; i < 4; ++i) { a[i] = sigmoidf_(v0[i]); b[i] = sigmoidf_(v1[i]); }
                *(v4u*)(MG + (size_t)row * 3072 + c) = pack8(a, b); EPI_LOOP_END
        } else {
            float* NG = (float*)(ws + WS_NG);
            EPI_LOOP_BEGIN if (ct < 24) { f32x4 a, b;
#pragma unroll
                for (int i = 0; i < 4; ++i) { a[i] = sigmoidf_(v0[i]); b[i] = sigmoidf_(v1[i]); }
                float* o = NG + (size_t)row * 24 + ct; *(f32x4*)o = a; *(f32x4*)(o + 4) = b; } EPI_LOOP_END
        }
    }
};

struct EpiLH {
    static constexpr bool PERM = true, AFTER_DRAIN = false;
    bf16* LH;
    __device__ __forceinline__ void operator()(const f32x4 (&acc)[2][2][4][2], const pg8::Unit& u, int wr, int wc, int fr0, int fq0) const {
        int fr = fr0, fq = fq0; asm volatile("" : "+v"(fr), "+v"(fq));
        EPI_LOOP_BEGIN *(v4u*)(LH + (size_t)row * 256 + ct) = pack8(v0, v1); EPI_LOOP_END
    }
};
struct CmpOrder {
    int G, c;
    __device__ bool next(int i, pg8::Unit& u) const { const int L = i * G + c; if (L >= CMP_ROWS / 256) return false; u.pm = L; u.pn = L / (CMP_ROWS_J / 256); return true; }
    __device__ __forceinline__ void a_ready(const pg8::Unit&) const {}
    __device__ __forceinline__ void done(const pg8::Unit&) const {}
};

template <int BR> struct EpiBr {
    static constexpr bool PERM = true, AFTER_DRAIN = false;
    unsigned char* ws;
    __device__ __forceinline__ void operator()(const f32x4 (&acc)[2][2][4][2], const pg8::Unit& u, int wr, int wc, int fr0, int fq0) const {
        int fr = fr0, fq = fq0; asm volatile("" : "+v"(fr), "+v"(fq));
        const bf16* MG = (const bf16*)(ws + WS_MGS); bf16* MR = (bf16*)(ws + WS_MRG);
        EPI_LOOP_BEGIN
            const int col = u.pn * 256 + ct; f32x4 g0, g1; unpack8(*(const v4u*)(MG + (size_t)row * 3072 + BR * 1024 + col), g0, g1);
            f32x4 r0 = v0 * g0, r1 = v1 * g1; bf16* o = MR + (size_t)row * DM + col;
            if (BR > 0) { f32x4 p0, p1; unpack8(*(const v4u*)o, p0, p1); r0 += p0; r1 += p1; }
            *(v4u*)o = pack8(r0, r1);
        EPI_LOOP_END
    }
};

struct BrOrder {
    pg8::StaticOrder S;
    __device__ bool next(int i, pg8::Unit& u) const { pg8::Unit t; if (!S.next(i / 3, t)) return false; const int br = i % 3; u.pm = br * (MT / 256) + t.pm; u.pn = br * 4 + t.pn; return true; }
    __device__ __forceinline__ void a_ready(const pg8::Unit&) const {}
    __device__ __forceinline__ void done(const pg8::Unit&) const {}
};
struct EpiBrAll {
    static constexpr bool PERM = true, AFTER_DRAIN = false;
    unsigned char* ws;
    __device__ __forceinline__ void operator()(const f32x4 (&acc)[2][2][4][2], const pg8::Unit& u0, int wr, int wc, int fr0, int fq0) const {
        int fr = fr0, fq = fq0; asm volatile("" : "+v"(fr), "+v"(fq));
        const int br = u0.pn >> 2; const pg8::Unit u{u0.pm - br * (MT / 256), u0.pn & 3};
        const bf16* MG = (const bf16*)(ws + WS_MGS) + br * 1024; bf16* MR = (bf16*)(ws + WS_MRG);
#pragma unroll
        for (int ai = 0; ai < 2; ++ai) {
            v4u gw[4][2], pw[4][2];
#pragma unroll
            for (int m = 0; m < 4; ++m) { const int row = u.pm * 256 + ai * 128 + wr * 64 + m * 16 + fr;
#pragma unroll
                for (int bj = 0; bj < 2; ++bj) { const int col = u.pn * 256 + bj * 128 + wc * 32 + 8 * fq; gw[m][bj] = *(const v4u*)(MG + (size_t)row * 3072 + col); if (br != 0) pw[m][bj] = *(const v4u*)(MR + (size_t)row * DM + col); } }
#pragma unroll
            for (int m = 0; m < 4; ++m) { const int row = u.pm * 256 + ai * 128 + wr * 64 + m * 16 + fr;
#pragma unroll
                for (int bj = 0; bj < 2; ++bj) { const int col = u.pn * 256 + bj * 128 + wc * 32 + 8 * fq; const f32x4 v0 = acc[ai][bj][m][0], v1 = acc[ai][bj][m][1];
                    f32x4 g0, g1; unpack8(gw[m][bj], g0, g1); f32x4 r0 = v0 * g0, r1 = v1 * g1;
                    if (br != 0) { f32x4 p0, p1; unpack8(pw[m][bj], p0, p1); r0 += p0; r1 += p1; }
                    *(v4u*)(MR + (size_t)row * DM + col) = pack8(r0, r1); } }
        }
    }
};

template <bool INF32> struct EpiRes {
    static constexpr bool PERM = true, AFTER_DRAIN = false;
    const void* xin_p; bf16* xout; const float* mod; int gofs;
    __device__ __forceinline__ void operator()(const f32x4 (&acc)[2][2][4][2], const pg8::Unit& u, int wr, int wc, int fr0, int fq0) const {
        int fr = fr0, fq = fq0; asm volatile("" : "+v"(fr), "+v"(fq));
#pragma unroll
        for (int ai = 0; ai < 2; ++ai) {
            const float* gp = mod + (size_t)row_bb(u.pm * 256 + ai * 128) * 6144 + gofs + u.pn * 256 + wc * 32 + 8 * fq;
            f32x4 g[2][2];
#pragma unroll
            for (int bj = 0; bj < 2; ++bj) { g[bj][0] = *(const f32x4*)(gp + 128 * bj); g[bj][1] = *(const f32x4*)(gp + 128 * bj + 4); }
            if (INF32) {
#pragma unroll
                for (int mh = 0; mh < 2; ++mh) {
                    f32x4 xv[2][2][2];
#pragma unroll
                    for (int m2 = 0; m2 < 2; ++m2) { const int row = u.pm * 256 + ai * 128 + wr * 64 + (2 * mh + m2) * 16 + fr;
#pragma unroll
                        for (int bj = 0; bj < 2; ++bj) { const float* xi = (const float*)xin_p + (size_t)row * DM + u.pn * 256 + bj * 128 + wc * 32 + 8 * fq; xv[m2][bj][0] = *(const f32x4*)xi; xv[m2][bj][1] = *(const f32x4*)(xi + 4); } }
#pragma unroll
                    for (int m2 = 0; m2 < 2; ++m2) { const int m = 2 * mh + m2; const int row = u.pm * 256 + ai * 128 + wr * 64 + m * 16 + fr;
#pragma unroll
                        for (int bj = 0; bj < 2; ++bj) { const int col = u.pn * 256 + bj * 128 + wc * 32 + 8 * fq;
                            *(v4u*)(xout + (size_t)row * DM + col) = pack8(xv[m2][bj][0] + g[bj][0] * acc[ai][bj][m][0], xv[m2][bj][1] + g[bj][1] * acc[ai][bj][m][1]); } }
                }
            } else {
                v4u xw[4][2];
#pragma unroll
                for (int m = 0; m < 4; ++m) { const int row = u.pm * 256 + ai * 128 + wr * 64 + m * 16 + fr;
#pragma unroll
                    for (int bj = 0; bj < 2; ++bj) xw[m][bj] = *(const v4u*)((const bf16*)xin_p + (size_t)row * DM + u.pn * 256 + bj * 128 + wc * 32 + 8 * fq); }
#pragma unroll
                for (int m = 0; m < 4; ++m) { const int row = u.pm * 256 + ai * 128 + wr * 64 + m * 16 + fr;
#pragma unroll
                    for (int bj = 0; bj < 2; ++bj) { const int col = u.pn * 256 + bj * 128 + wc * 32 + 8 * fq; f32x4 x0, x1; unpack8(xw[m][bj], x0, x1);
                        *(v4u*)(xout + (size_t)row * DM + col) = pack8(x0 + g[bj][0] * acc[ai][bj][m][0], x1 + g[bj][1] * acc[ai][bj][m][1]); } }
            }
        }
    }
};

struct UpOrder {
    pg8::StaticOrder S;
    __device__ bool next(int i, pg8::Unit& u) const { pg8::Unit t; if (!S.next(i >> 1, t)) return false; u.pm = t.pm; u.pn = t.pn + 11 * (i & 1); return true; }
    __device__ __forceinline__ void a_ready(const pg8::Unit&) const {}
    __device__ __forceinline__ void done(const pg8::Unit&) const {}
};
struct EpiUp {
    static constexpr bool PERM = true, AFTER_DRAIN = false;
    unsigned char* ws; float* out; int l; const float* cw; const float* cbi;
    __device__ __forceinline__ void operator()(const f32x4 (&acc)[2][2][4][2], const pg8::Unit& u, int wr, int wc, int fr0, int fq0) const {
        int fr = fr0, fq = fq0; asm volatile("" : "+v"(fr), "+v"(fq));
        bf16* GP = (bf16*)(ws + WS_GP); bf16* VAL = GP + (size_t)MT * DFF; bf16* ACT = GP + (size_t)2 * MT * DFF;
        if (u.pn < 11) {
            EPI_LOOP_BEGIN const int c = u.pn * 256 + ct; *(v4u*)(GP + (size_t)row * DFF + c) = pack8(v0, v1);
                if (row < PM) { const int t = row & (PT - 1); if (t >= PT - 2) { float* q = out + OUT_FC_P + (((size_t)l * PB + (row >> 12)) * 2 + (t - (PT - 2))) * DFF + c; *(f32x4*)q = v0; *(f32x4*)(q + 4) = v1; } }
                else { const int i = (row - PM) & 7; if (i >= ST - 2) { float* q = out + OUT_FC_S + (((size_t)l * SB + ((row - PM) >> 3)) * 2 + (i - (ST - 2))) * DFF + c; *(f32x4*)q = v0; *(f32x4*)(q + 4) = v1; } }
            EPI_LOOP_END
        } else if (u.pm * 256 >= PM) {
            EPI_LOOP_BEGIN const int c = (u.pn - 11) * 256 + ct; *(v4u*)(VAL + (size_t)row * DFF + c) = pack8(v0, v1); EPI_LOOP_END
        } else {
#pragma unroll
            for (int bj = 0; bj < 2; ++bj) { const int c = (u.pn - 11) * 256 + bj * 128 + wc * 32 + 8 * fq;
                const f32x4 w0a = *(const f32x4*)(cw + c), w0b = *(const f32x4*)(cw + c + 4), w1a = *(const f32x4*)(cw + DFF + c), w1b = *(const f32x4*)(cw + DFF + c + 4);
                const f32x4 w2a = *(const f32x4*)(cw + 2 * DFF + c), w2b = *(const f32x4*)(cw + 2 * DFF + c + 4), ba = *(const f32x4*)(cbi + c), bb = *(const f32x4*)(cbi + c + 4);
#pragma unroll
                for (int ai = 0; ai < 2; ++ai)
#pragma unroll
                  for (int mh = 0; mh < 2; ++mh) {
                    v4u g0[2], g1[2], g2[2];
#pragma unroll
                    for (int m2 = 0; m2 < 2; ++m2) { const int row = u.pm * 256 + ai * 128 + wr * 64 + (2 * mh + m2) * 16 + fr; const int t = row & (PT - 1); const bf16* gp = GP + (size_t)row * DFF + c;
                        g0[m2] = *(const v4u*)gp;
                        g1[m2] = (t >= 1) ? *(const v4u*)(gp - DFF) : (v4u){0u, 0u, 0u, 0u};
                        g2[m2] = (t >= 2) ? *(const v4u*)(gp - 2 * DFF) : (v4u){0u, 0u, 0u, 0u}; }
#pragma unroll
                    for (int m2 = 0; m2 < 2; ++m2) { const int m = 2 * mh + m2; const int row = u.pm * 256 + ai * 128 + wr * 64 + m * 16 + fr; const int t = row & (PT - 1);
                        const f32x4 v0 = acc[ai][bj][m][0], v1 = acc[ai][bj][m][1];
                        if ((t & 255) < 2 && t >= 2) { *(v4u*)(VAL + (size_t)row * DFF + c) = pack8(v0, v1); }
                        else { f32x4 xa, xb, pa, pb, qa, qb; unpack8(g0[m2], xa, xb); unpack8(g1[m2], pa, pb); unpack8(g2[m2], qa, qb);
                            f32x4 ya = ba + w0a * qa + w1a * pa + w2a * xa, yb = bb + w0b * qb + w1b * pb + w2b * xb;
#pragma unroll
                            for (int i = 0; i < 4; ++i) { ya[i] = siluf_(ya[i]) * v0[i]; yb[i] = siluf_(yb[i]) * v1[i]; }
                            *(v4u*)(ACT + (size_t)row * DFF + c) = pack8(ya, yb); } }
                  }
            }
        }
    }
};

__device__ __forceinline__ f32x16 mfma32(bf16x8 a, bf16x8 b, f32x16 c) { return __builtin_amdgcn_mfma_f32_32x32x16_bf16(a, b, c, 0, 0, 0); }
__device__ __forceinline__ f32x4 mfma16(bf16x8 a, bf16x8 b, f32x4 c) { return __builtin_amdgcn_mfma_f32_16x16x32_bf16(a, b, c, 0, 0, 0); }
__device__ __forceinline__ float ret_log_g(int h) { return log1pf(-exp2f(-5.0f - (float)h)); }
__device__ __forceinline__ bf16x8 tr_frag(const LAS unsigned char* base, int rs_bytes, int rowA, int rowB, int colbase, int lane) {
    const int q = (lane & 15) >> 2, p = lane & 3;
    const LAS unsigned char* pa = base + (rowA + q) * rs_bytes + (colbase + 4 * p) * 2;
    const LAS unsigned char* pb = base + (rowB + q) * rs_bytes + (colbase + 4 * p) * 2;
    const s16x4 a = __builtin_bit_cast(s16x4, __builtin_amdgcn_ds_read_tr16_b64_v4i16((LAS s16x4*)pa));
    const s16x4 b = __builtin_bit_cast(s16x4, __builtin_amdgcn_ds_read_tr16_b64_v4i16((LAS s16x4*)pb));
    return (bf16x8){a[0], a[1], a[2], a[3], b[0], b[1], b[2], b[3]};
}
__device__ __forceinline__ bf16x8 cvt_frag(const f32x16& p, int s2) {
    u32x4 w; w.x = pk2(p[8 * s2 + 0], p[8 * s2 + 1]); w.y = pk2(p[8 * s2 + 2], p[8 * s2 + 3]); w.z = pk2(p[8 * s2 + 4], p[8 * s2 + 5]); w.w = pk2(p[8 * s2 + 6], p[8 * s2 + 7]);
    return __builtin_bit_cast(bf16x8, w);
}

__device__ __forceinline__ void cmp2_phase(Frame& F, int l) {
    const int gw = F.bid * NWAVES + F.wave, NGW = F.G * NWAVES, lane = F.lane, r = lane & 15, g = lane >> 4;
    const bf16* LH = WSP(bf16, WS_LH); bf16* CK = WSP(bf16, WS_CK);
    const int j = gw & 1, gwj = gw >> 1, NGJ = NGW >> 1;
    const bf16* W2T = WSP(bf16, WS_SMALLW + SW_W2T) + (size_t)(l * 2 + j) * 64 * 128; const float* CB = WSP(float, WS_SMALLW + SW_CB) + (l * 2 + j) * 128;
    bf16x8 wf[4][4];
#pragma unroll
    for (int ks = 0; ks < 4; ++ks)
#pragma unroll
        for (int ct = 0; ct < 4; ++ct) wf[ks][ct] = *(const bf16x8*)(W2T + (size_t)(16 * ct + r) * 128 + 32 * ks + 8 * g);
    for (int wu = gwj; wu < CMP_ROWS_J / 16; wu += NGJ) {
        const int rj0 = wu * 16, rj = rj0 + r; const size_t row = (size_t)j * CMP_ROWS_J + rj;
        const bool valid = (rj < 32768) ? ((rj & 511) < 511) : (((rj - 32768) & 255) < 255);
        v4u la[4], lb[4];
#pragma unroll
        for (int ks = 0; ks < 4; ++ks) { const int h0 = 32 * ks + 8 * g; la[ks] = *(const v4u*)(LH + row * 256 + h0); lb[ks] = *(const v4u*)(LH + (row + 1) * 256 + 128 + h0); }
        f32x4 acc[4];
#pragma unroll
        for (int ct = 0; ct < 4; ++ct) acc[ct] = (f32x4){0.f, 0.f, 0.f, 0.f};
#pragma unroll
        for (int ks = 0; ks < 4; ++ks) {
            const int h0 = 32 * ks + 8 * g; f32x4 a0, a1, b0, b1;
            unpack8(la[ks], a0, a1); unpack8(lb[ks], b0, b1);
            const f32x4 c0 = *(const f32x4*)(CB + h0), c1 = *(const f32x4*)(CB + h0 + 4);
            f32x4 x0 = a0 + b0 + c0, x1 = a1 + b1 + c1;
#pragma unroll
            for (int i = 0; i < 4; ++i) { x0[i] = gelu_tanh(x0[i]); x1[i] = gelu_tanh(x1[i]); }
            const bf16x8 hf = __builtin_bit_cast(bf16x8, pack8(x0, x1));
#pragma unroll
            for (int ct = 0; ct < 4; ++ct) acc[ct] = mfma16(wf[ks][ct], hf, acc[ct]);
        }
#pragma unroll
        for (int ct = 0; ct < 4; ++ct) { const f32x4 v = valid ? acc[ct] : (f32x4){0.f, 0.f, 0.f, 0.f}; v2u w; w.x = pk2(v[0], v[1]); w.y = pk2(v[2], v[3]);
            *(v2u*)(CK + row * 64 + 16 * ct + 4 * g) = w; }
    }
}

constexpr int CG_RS = 144, CG_BUF = 256 * CG_RS, CG_AW = 2 * CG_BUF, CG_AT = 32 * CG_RS;
static_assert(CG_AW + 2 * 4 * CG_AT <= RING_BYTES, "compress GEMM LDS map");
template <bool smp> __device__ __forceinline__ void cmp_gemm_unit(Frame& F, int l, int j, int grp, int n00) {
    const int tid = F.tid, lane = F.lane, w = F.wave, q = lane & 31, h_ = lane >> 5, rg = w >> 1, ch = w & 1;
    const float* rp[4]; const bf16* ab = nullptr;
    if (smp) { const int db = grp >> 1, k = grp & 1;
#pragma unroll
        for (int i = 0; i < 4; ++i) { const int tt0 = (n00 + 32 * rg + 16 * ch + 4 * i + (lane >> 4)) * 16; const int page = ((const int*)F.a->in[I_PT])[db * NPG + (tt0 >> 7)];
            rp[i] = FIN(I_CACHE) + (((((size_t)l * NPHYS + page) * PAGE + (tt0 & 127)) * 4 + j) * 2 + k) * 64 + (lane & 15) * 4; } }
    else {
        ab = WSP(bf16, WS_ACMP) + ((size_t)(l * 2 + j) * CMP_ROWS_J + 32768 + grp * 256 + n00 + 32 * rg + 16 * ch + (lane >> 3)) * 1024 + (lane & 7) * 8;
#pragma unroll
        for (int i = 0; i < 4; ++i) rp[i] = nullptr; }
    const bf16* Bg = WSP(bf16, WS_SMALLW + SW_W1T) + (size_t)(l * 2 + j) * 256 * 1024;
    f32x16 acc[4];
#pragma unroll
    for (int ct = 0; ct < 4; ++ct) acc[ct] = (f32x16){};
    const bf16* bsrc = Bg + (size_t)(tid >> 1) * 1024 + (tid & 1) * 32; LAS unsigned char* bdst = F.lds + (tid >> 1) * CG_RS + (tid & 1) * 64;
    v4u bst[2][4]; f32x4 an[4][4]; v4u anb[4][2];
    __syncthreads();
#pragma unroll
    for (int x = 0; x < 4; ++x) bst[0][x] = *(const v4u*)(bsrc + 8 * x);
#pragma unroll
    for (int x = 0; x < 4; ++x) bst[1][x] = *(const v4u*)(bsrc + 64 + 8 * x);
#pragma unroll
    for (int d = 0; d < 4; ++d) {
        if (smp) {
#pragma unroll
            for (int i = 0; i < 4; ++i) an[d][i] = __builtin_nontemporal_load((const f32x4*)(rp[i] + (size_t)d * 512)); }
        else {
#pragma unroll
            for (int i = 0; i < 2; ++i) anb[d][i] = *(const v4u*)(ab + (size_t)(8 * i) * 1024 + d * 64); } }
#pragma unroll
    for (int x = 0; x < 4; ++x) *(LAS v4u*)(bdst + x * 16) = bst[0][x];
#define CG_CHUNK(d, LAST_) { const int kc = kc4 + (d); \
            LAS unsigned char* At = F.lds + CG_AW + (((d) & 1) * 4 + rg) * CG_AT; \
            if (!(LAST_) || (d) < 2) {                                   \
                _Pragma("unroll") for (int x = 0; x < 4; ++x) bst[(d) & 1][x] = *(const v4u*)(bsrc + (kc + 2) * 64 + 8 * x); } \
            if (smp) { \
                _Pragma("unroll") for (int i = 0; i < 4; ++i) { v2u o; o.x = pk2(an[d][i][0], an[d][i][1]); o.y = pk2(an[d][i][2], an[d][i][3]); *(LAS v2u*)(At + (16 * ch + 4 * i + (lane >> 4)) * CG_RS + (lane & 15) * 8) = o; } \
                if (!(LAST_)) { _Pragma("unroll") for (int i = 0; i < 4; ++i) an[d][i] = __builtin_nontemporal_load((const f32x4*)(rp[i] + (size_t)(kc + 4) * 512)); } \
            } else { \
                _Pragma("unroll") for (int i = 0; i < 2; ++i) *(LAS v4u*)(At + (16 * ch + 8 * i + (lane >> 3)) * CG_RS + (lane & 7) * 16) = anb[d][i]; \
                if (!(LAST_)) { _Pragma("unroll") for (int i = 0; i < 2; ++i) anb[d][i] = *(const v4u*)(ab + (size_t)(8 * i) * 1024 + (kc + 4) * 64); } \
            } \
            __syncthreads();                                           \
            bf16x8 ac[4]; \
            _Pragma("unroll") for (int ks = 0; ks < 4; ++ks) ac[ks] = *(const LAS bf16x8*)(At + q * CG_RS + ks * 32 + 16 * h_); \
            const LAS unsigned char* bb = F.lds + ((d) & 1) * CG_BUF + (128 * ch + q) * CG_RS + 16 * h_; \
            _Pragma("unroll") for (int ks = 0; ks < 4; ++ks) \
                _Pragma("unroll") for (int ct = 0; ct < 4; ++ct) { const bf16x8 bf = *(const LAS bf16x8*)(bb + ct * 32 * CG_RS + ks * 32); acc[ct] = mfma32(bf, ac[ks], acc[ct]); } \
            if (!(LAST_) || (d) < 3) { _Pragma("unroll") for (int x = 0; x < 4; ++x) *(LAS v4u*)(bdst + (((d) + 1) & 1) * CG_BUF + x * 16) = bst[((d) + 1) & 1][x]; } }
    int kc4 = 0;
#pragma unroll 1
    for (; kc4 < 12; kc4 += 4) { CG_CHUNK(0, false) CG_CHUNK(1, false) CG_CHUNK(2, false) CG_CHUNK(3, false) }
    { CG_CHUNK(0, true) CG_CHUNK(1, true) CG_CHUNK(2, true) CG_CHUNK(3, true) }
#undef CG_CHUNK
    bf16* LH = WSP(bf16, WS_LH) + ((size_t)j * CMP_ROWS_J + (smp ? grp * 512 : 32768 + grp * 256) + n00 + 32 * rg + q) * 256 + 128 * ch;
#pragma unroll
    for (int ct = 0; ct < 4; ++ct)
#pragma unroll
        for (int r4 = 0; r4 < 4; ++r4) { v2u o; o.x = pk2(acc[ct][4 * r4 + 0], acc[ct][4 * r4 + 1]); o.y = pk2(acc[ct][4 * r4 + 2], acc[ct][4 * r4 + 3]); *(v2u*)(LH + ct * 32 + 8 * r4 + 4 * h_) = o; }
}

constexpr int RS_KV = 272;
__device__ __forceinline__ void ret_local_unit(Frame& F, int unit) {
    const int bh = unit >> 5, c = unit & 31, b = bh >> 2, h = bh & 3, lane = F.lane, w = F.wave;
    const float lg = ret_log_g(h);
    LAS unsigned char* KS = F.lds; LAS unsigned char* VS = F.lds + 128 * RS_KV;
    const bf16* RK = WSP(bf16, WS_RQ) + (size_t)MT * 512; const bf16* RV = WSP(bf16, WS_RQ) + (size_t)2 * MT * 512;
    __syncthreads();
#pragma unroll
    for (int i = 0; i < 4; ++i) { const int p = F.tid + NTHR * i, j = p >> 4, ch = p & 15; const size_t go = (size_t)(b * PT + 128 * c + j) * 512 + h * 128 + ch * 8;
        f32x4 k0, k1; unpack8(*(const v4u*)(RK + go), k0, k1); const float kw = fexp((float)(127 - j) * lg);
        *(LAS v4u*)(KS + j * RS_KV + ch * 16) = pack8(k0 * kw, k1 * kw);
        *(LAS v4u*)(VS + j * RS_KV + ch * 16) = *(const v4u*)(RV + go); }
    __syncthreads();
    const int et = w >> 1, dt0 = 2 * (w & 1), h_ = lane >> 5, blk = (lane >> 4) & 1;
    f32x16 acc[2]; acc[0] = (f32x16){}; acc[1] = (f32x16){};
#pragma unroll
    for (int ks = 0; ks < 8; ++ks) {
        const int rA = 16 * ks + 8 * h_;
        const bf16x8 af = tr_frag(VS, RS_KV, rA, rA + 4, 32 * et + 16 * blk, lane);
#pragma unroll
        for (int dd = 0; dd < 2; ++dd) { const bf16x8 bfr = tr_frag(KS, RS_KV, rA, rA + 4, 32 * (dt0 + dd) + 16 * blk, lane); acc[dd] = mfma32(af, bfr, acc[dd]); }
    }
    bf16* LT = WSP(bf16, WS_LT) + ((size_t)bh * 32 + c) * 16384;
#pragma unroll
    for (int dd = 0; dd < 2; ++dd)
#pragma unroll
        for (int r = 0; r < 16; ++r) { const int e = 32 * et + (r & 3) + 8 * (r >> 2) + 4 * h_; LT[e * 128 + 32 * (dt0 + dd) + (lane & 31)] = (bf16)(pk2(acc[dd][r], 0.f) & 0xffffu); }
}
__device__ __forceinline__ void ret_scan_phase(Frame& F, int l) {
    const bf16* LT = WSP(bf16, WS_LT); bf16* SPT = WSP(bf16, WS_SPT);
    for (int idx = F.bid * NTHR + F.tid; idx < 16 * 16384; idx += F.G * NTHR) {
        const int bh = idx >> 14, ed = idx & 16383, e = ed >> 7, d = ed & 127, h = bh & 3; const float g128 = fexp(128.0f * ret_log_g(h));
        float S = 0.f;
        for (int c = 0; c < 32; ++c) { const size_t o = ((size_t)bh * 32 + c) * 16384 + ed; SPT[o] = (bf16)(pk2(S, 0.f) & 0xffffu); S = S * g128 + bf1(LT[o]); }
        F.out[OUT_RET_P + ((size_t)l * 16 + bh) * 16384 + d * 128 + e] = S;
    }
}
__device__ __forceinline__ void ret_out_unit(Frame& F, int l, int unit) {
    const int bh = unit >> 5, c = unit & 31, b = bh >> 2, h = bh & 3, lane = F.lane, w = F.wave, tid = F.tid;
    const float lg = ret_log_g(h);
    LAS unsigned char* KS = F.lds; LAS unsigned char* VS = F.lds + 128 * RS_KV; LAS float* OT = (LAS float*)F.lds; LAS float* STAT = (LAS float*)(F.lds + 2 * 128 * RS_KV);
    const bf16* RQ = WSP(bf16, WS_RQ); const bf16* RK = RQ + (size_t)MT * 512; const bf16* RV = RQ + (size_t)2 * MT * 512; const bf16* RG = RQ + (size_t)3 * MT * 512;
    const size_t row0 = (size_t)b * PT + 128 * c;
    __syncthreads();
#pragma unroll
    for (int i = 0; i < 4; ++i) { const int p = tid + NTHR * i, j = p >> 4, ch = p & 15; const size_t go = (row0 + j) * 512 + h * 128 + ch * 8;
        *(LAS v4u*)(KS + j * RS_KV + ch * 16) = *(const v4u*)(RK + go); *(LAS v4u*)(VS + j * RS_KV + ch * 16) = *(const v4u*)(RV + go); }
    const int it = w & 3, eh = w >> 2, h_ = lane >> 5, blk = (lane >> 4) & 1, il = 32 * it + (lane & 31);
    bf16x8 qf[8];
#pragma unroll
    for (int ks = 0; ks < 8; ++ks) qf[ks] = *(const bf16x8*)(RQ + (row0 + il) * 512 + h * 128 + 16 * ks + 8 * h_);
    f32x16 acc[2]; acc[0] = (f32x16){}; acc[1] = (f32x16){};
    const bf16* SP = WSP(bf16, WS_SPT) + ((size_t)bh * 32 + c) * 16384;
#pragma unroll
    for (int kb4 = 0; kb4 < 8; kb4 += 4) {
        bf16x8 af[4][2];
#pragma unroll
        for (int ks = 0; ks < 4; ++ks)
#pragma unroll
            for (int e2 = 0; e2 < 2; ++e2) af[ks][e2] = *(const bf16x8*)(SP + (size_t)(32 * (2 * eh + e2) + (lane & 31)) * 128 + 16 * (kb4 + ks) + 8 * h_);
#pragma unroll
        for (int ks = 0; ks < 4; ++ks)
#pragma unroll
            for (int e2 = 0; e2 < 2; ++e2) acc[e2] = mfma32(af[ks][e2], qf[kb4 + ks], acc[e2]);
    }
    { const float cr = fexp((float)(il + 1) * lg); acc[0] *= cr; acc[1] *= cr; }
    __syncthreads();
    for (int jt = 0; jt <= it; ++jt) {
        f32x16 s = (f32x16){};
#pragma unroll
        for (int ks = 0; ks < 8; ++ks) { const bf16x8 kf = *(const LAS bf16x8*)(KS + (32 * jt + (lane & 31)) * RS_KV + (16 * ks + 8 * h_) * 2); s = mfma32(kf, qf[ks], s); }
#pragma unroll
        for (int r = 0; r < 16; ++r) { const int j = 32 * jt + (r & 3) + 8 * (r >> 2) + 4 * h_; const int df = il - j; s[r] = (df >= 0) ? s[r] * fexp((float)df * lg) : 0.f; }
#pragma unroll
        for (int s2 = 0; s2 < 2; ++s2) { const bf16x8 pf = cvt_frag(s, s2); const int rA = 32 * jt + 16 * s2 + 4 * h_;
#pragma unroll
            for (int e2 = 0; e2 < 2; ++e2) { const bf16x8 vf = tr_frag(VS, RS_KV, rA, rA + 8, 32 * (2 * eh + e2) + 16 * blk, lane); acc[e2] = mfma32(vf, pf, acc[e2]); } }
    }
    float s1 = 0.f, s2 = 0.f;
#pragma unroll
    for (int e2 = 0; e2 < 2; ++e2)
#pragma unroll
        for (int r = 0; r < 16; ++r) { const float v = acc[e2][r]; s1 += v; s2 += v * v; }
    s1 += __shfl_xor(s1, 32); s2 += __shfl_xor(s2, 32);
    if (lane < 32) { STAT[(w * 32 + lane) * 2] = s1; STAT[(w * 32 + lane) * 2 + 1] = s2; }
    __syncthreads();
    { const int pw = w ^ 4; s1 += STAT[(pw * 32 + (lane & 31)) * 2]; s2 += STAT[(pw * 32 + (lane & 31)) * 2 + 1]; }
    const float mean = s1 * (1.0f / 128.0f), var = fmaxf(s2 * (1.0f / 128.0f) - mean * mean, 0.f), rstd = 1.0f / sqrtf(var + EPS);
#pragma unroll
    for (int e2 = 0; e2 < 2; ++e2)
#pragma unroll
        for (int r4 = 0; r4 < 4; ++r4) { const int e = 32 * (2 * eh + e2) + 8 * r4 + 4 * h_;
            f32x4 v; v[0] = (acc[e2][4 * r4 + 0] - mean) * rstd; v[1] = (acc[e2][4 * r4 + 1] - mean) * rstd; v[2] = (acc[e2][4 * r4 + 2] - mean) * rstd; v[3] = (acc[e2][4 * r4 + 3] - mean) * rstd;
            *(LAS f32x4*)(OT + il * 132 + e) = v; }
    __syncthreads();
    const float* GN = FIN(I_GNG) + l * 512 + h * 128; bf16* OR_ = WSP(bf16, WS_OA) + (size_t)MT * 512;
#pragma unroll
    for (int k = 0; k < 4; ++k) { const int q = tid + NTHR * k, i = q >> 4, ch = q & 15;
        const f32x4 o0 = *(const LAS f32x4*)(OT + i * 132 + 8 * ch), o1 = *(const LAS f32x4*)(OT + i * 132 + 8 * ch + 4);
        const f32x4 g0 = *(const f32x4*)(GN + 8 * ch), g1 = *(const f32x4*)(GN + 8 * ch + 4); f32x4 r0, r1; unpack8(*(const v4u*)(RG + (row0 + i) * 512 + h * 128 + 8 * ch), r0, r1);
        f32x4 y0, y1;
#pragma unroll
        for (int x = 0; x < 4; ++x) { y0[x] = o0[x] * g0[x] * siluf_(r0[x]); y1[x] = o1[x] * g1[x] * siluf_(r1[x]); }
        *(v4u*)(OR_ + (row0 + i) * 512 + h * 128 + 8 * ch) = pack8(y0, y1); }
}
__device__ __forceinline__ void ret_sample_unit(Frame& F, int l, int unit) {
    const int db = unit >> 2, h = unit & 3, tid = F.tid, e = tid & 127, dp = tid >> 7;
    const float lg = ret_log_g(h);
    LAS float* Q = (LAS float*)F.lds; LAS float* K = Q + 1024; LAS float* V = K + 1024; LAS float* GT = V + 1024; LAS float* CR = GT + 1024;
    LAS float* SC = CR + 4096; LAS float* RED = SC + 64;
    const bf16* RQ = WSP(bf16, WS_RQ); const size_t row0 = (size_t)PM + db * 8;
    __syncthreads();
    for (int i = tid; i < 4096; i += NTHR) { const int which = i >> 10, r = (i >> 7) & 7, d = i & 127; const float v = bf1(RQ[(size_t)which * MT * 512 + (row0 + r) * 512 + h * 128 + d]); Q[which * 1024 + r * 128 + d] = v; }
    __syncthreads();
    const float* S0 = FIN(I_SRET) + (((size_t)l * SB + db) * 4 + h) * 16384; float* SN = F.out + OUT_RET_S + (((size_t)l * SB + db) * 4 + h) * 16384;
    float kwv[8], cr[8];
#pragma unroll
    for (int j = 0; j < 8; ++j) { kwv[j] = V[j * 128 + e] * fexp((float)(7 - j) * lg); cr[j] = 0.f; }
    const float g8 = fexp(8.0f * lg);
    {   float s0v[32];
#pragma unroll
        for (int dd = 0; dd < 32; ++dd) s0v[dd] = S0[(dp * 32 + dd) * 128 + e];
#pragma unroll
        for (int dd = 0; dd < 32; ++dd) { const int d = dp * 32 + dd; const float s0 = s0v[dd]; float sn = g8 * s0;
#pragma unroll
            for (int j = 0; j < 8; ++j) { cr[j] += Q[j * 128 + d] * s0; sn += K[j * 128 + d] * kwv[j]; }
            SN[d * 128 + e] = sn; }
    }
#pragma unroll
    for (int i = 0; i < 8; ++i) CR[(dp * 8 + i) * 128 + e] = cr[i];
    if (tid < 64) { const int i = tid >> 3, j = tid & 7; float s = 0.f; if (j <= i) { for (int d = 0; d < 128; ++d) s += Q[i * 128 + d] * K[j * 128 + d]; s *= fexp((float)(i - j) * lg); } SC[tid] = s; }
    __syncthreads();
    float o[2];
#pragma unroll
    for (int ii = 0; ii < 2; ++ii) { const int i = 2 * dp + ii; float x = (CR[(0 * 8 + i) * 128 + e] + CR[(1 * 8 + i) * 128 + e] + CR[(2 * 8 + i) * 128 + e] + CR[(3 * 8 + i) * 128 + e]) * fexp((float)(i + 1) * lg);
        for (int j = 0; j <= i; ++j) x += SC[i * 8 + j] * V[j * 128 + e];
        o[ii] = x; }
#pragma unroll
    for (int ii = 0; ii < 2; ++ii) { const float a = wave_sum(o[ii]), q = wave_sum(o[ii] * o[ii]); if (F.lane == 0) { RED[(F.wave * 2 + ii) * 2] = a; RED[(F.wave * 2 + ii) * 2 + 1] = q; } }
    __syncthreads();
    const float* GN = FIN(I_GNG) + l * 512 + h * 128; bf16* OR_ = WSP(bf16, WS_OA) + (size_t)MT * 512;
#pragma unroll
    for (int ii = 0; ii < 2; ++ii) { const int i = 2 * dp + ii, w0 = 2 * dp; const float s1 = RED[(w0 * 2 + ii) * 2] + RED[((w0 + 1) * 2 + ii) * 2], s2 = RED[(w0 * 2 + ii) * 2 + 1] + RED[((w0 + 1) * 2 + ii) * 2 + 1];
        const float mean = s1 * (1.0f / 128.0f), var = fmaxf(s2 * (1.0f / 128.0f) - mean * mean, 0.f), rstd = 1.0f / sqrtf(var + EPS);
        const float y = (o[ii] - mean) * rstd * GN[e] * siluf_(GT[i * 128 + e]);
        OR_[(row0 + i) * 512 + h * 128 + e] = (bf16)(pk2(y, 0.f) & 0xffffu); }
}

template <int MODE> __device__ __forceinline__ void rglru_unit(Frame& F, int l, int unit) {
    const int tid = F.tid, c = tid, lane = F.lane, w = F.wave;
    LAS bf16* XC = (LAS bf16*)F.lds; LAS float* G = (LAS float*)(F.lds + 16384);
    const int seq = (MODE == 2) ? unit : (unit >> 6), tile = (MODE == 2) ? 0 : (unit & 63);
    const size_t row0 = (MODE == 2) ? (size_t)PM + seq * 8 : (size_t)seq * PT + tile * 64;
    const int ntok = (MODE == 2) ? 8 : 64, nsub = (MODE == 2) ? 1 : 4;
    const float* RX = WSP(float, WS_RX);
    const float w0 = FIN(I_RCW)[(l * 4 + 0) * 512 + c], w1 = FIN(I_RCW)[(l * 4 + 1) * 512 + c], w2 = FIN(I_RCW)[(l * 4 + 2) * 512 + c], w3 = FIN(I_RCW)[(l * 4 + 3) * 512 + c], cb = FIN(I_RCB)[l * 512 + c];
    const float ba = FIN(I_RBA)[l * 512 + c], bx = FIN(I_RBX)[l * 512 + c], sp = WSP(float, WS_SMALLW + SW_SP)[l * 512 + c];
    float x3, x2, x1;
    if (MODE == 2) { const float* cv = FIN(I_SCONV) + ((size_t)l * SB + seq) * 3 * 512; x3 = cv[c]; x2 = cv[512 + c]; x1 = cv[1024 + c]; }
    else if (tile == 0) { x3 = 0.f; x2 = 0.f; x1 = 0.f; }
    else { x3 = RX[(row0 - 3) * 512 + c]; x2 = RX[(row0 - 2) * 512 + c]; x1 = RX[(row0 - 1) * 512 + c]; }
    float h = (MODE == 0) ? 0.f : (MODE == 1) ? WSP(float, WS_CAR)[(size_t)4 * 64 * 2 * 512 + ((size_t)seq * 64 + tile) * 512 + c] : FIN(I_SH)[((size_t)l * SB + seq) * 512 + c];
    float aprod = 1.f;
    const int r16 = lane & 15, g4 = lane >> 4;
    bf16x8 wa[4][2], wx[4][2];
    { const bf16* WA = WSP(bf16, WS_SMALLW + SW_WAT) + ((size_t)(l * 2 + 0) * 8 + w) * 4096; const bf16* WX = WSP(bf16, WS_SMALLW + SW_WAT) + ((size_t)(l * 2 + 1) * 8 + w) * 4096;
#pragma unroll
      for (int ct = 0; ct < 4; ++ct)
#pragma unroll
          for (int ks = 0; ks < 2; ++ks) { wa[ct][ks] = *(const bf16x8*)(WA + (16 * ct + r16) * 64 + 32 * ks + 8 * g4); wx[ct][ks] = *(const bf16x8*)(WX + (16 * ct + r16) * 64 + 32 * ks + 8 * g4); } }
    const bf16* GG = WSP(bf16, WS_GG); bf16* OC = WSP(bf16, WS_OA) + (size_t)2 * MT * 512;
    __syncthreads();
    float xn[16]; bf16 gn[16];
#pragma unroll
    for (int tt = 0; tt < 16; ++tt) { xn[tt] = (tt < ntok) ? RX[(row0 + tt) * 512 + c] : 0.f; gn[tt] = (MODE != 0 && tt < ntok) ? GG[(row0 + tt) * 512 + c] : (bf16)0; }
    for (int s = 0; s < nsub; ++s) {
        float xc[16], gg[16];
#pragma unroll
        for (int tt = 0; tt < 16; ++tt) { xc[tt] = xn[tt]; gg[tt] = bf1(gn[tt]); }
        if (s + 1 < nsub) {
#pragma unroll
            for (int tt = 0; tt < 16; ++tt) { const int t = (s + 1) * 16 + tt; xn[tt] = RX[(row0 + t) * 512 + c]; gn[tt] = (MODE != 0) ? GG[(row0 + t) * 512 + c] : (bf16)0; } }
#pragma unroll
        for (int tt = 0; tt < 16; ++tt) { const float x0 = xc[tt];
            xc[tt] = cb + w0 * x3 + w1 * x2 + w2 * x1 + w3 * x0; x3 = x2; x2 = x1; x1 = x0; XC[tt * 512 + c] = (bf16)(pk2(xc[tt], 0.f) & 0xffffu); }
        LDS_WAIT(); asm volatile("" ::: "memory");
        {
            bf16x8 xf[2];
#pragma unroll
            for (int ks = 0; ks < 2; ++ks) xf[ks] = *(const LAS bf16x8*)(XC + r16 * 512 + w * 64 + 32 * ks + 8 * g4);
#pragma unroll
            for (int ct = 0; ct < 4; ++ct) { f32x4 da = (f32x4){0.f, 0.f, 0.f, 0.f}, dx = da;
#pragma unroll
                for (int ks = 0; ks < 2; ++ks) { da = mfma16(wa[ct][ks], xf[ks], da); dx = mfma16(wx[ct][ks], xf[ks], dx); }
                *(LAS f32x4*)(G + r16 * 512 + w * 64 + 16 * ct + 4 * g4) = da; *(LAS f32x4*)(G + 8192 + r16 * 512 + w * 64 + 16 * ct + 4 * g4) = dx; }
        }
        LDS_WAIT(); asm volatile("" ::: "memory");
#pragma unroll
        for (int tt = 0; tt < 16; ++tt) { const int t = s * 16 + tt;
            if (t < ntok) {
                const float r = sigmoidf_(G[tt * 512 + c] + ba), ig = sigmoidf_(G[8192 + tt * 512 + c] + bx);
                const float la = -8.0f * r * sp, a = fexp(la), bt = sqrtf(fmaxf(1.0f - a * a, 0.f)) * (ig * xc[tt]);
                h = a * h + bt; aprod *= a;
                if (MODE != 0) { const size_t o = (row0 + t) * 512 + c; OC[o] = (bf16)(pk2(h * gg[tt], 0.f) & 0xffffu); }
            } }
    }
    if (MODE == 0) { float* CAR = WSP(float, WS_CAR) + ((size_t)seq * 64 + tile) * 1024; CAR[c] = aprod; CAR[512 + c] = h; }
    if (MODE == 2) F.out[OUT_H_S + ((size_t)l * SB + seq) * 512 + c] = h;
}
__device__ __forceinline__ void rglru_carry_phase(Frame& F, int l) {
    const float* CAR = WSP(float, WS_CAR); float* HIN = WSP(float, WS_CAR) + (size_t)4 * 64 * 2 * 512;
    for (int idx = F.bid * NTHR + F.tid; idx < PB * 512; idx += F.G * NTHR) {
        const int b = idx >> 9, c = idx & 511; float h = 0.f;
#pragma unroll 1
        for (int t0 = 0; t0 < 64; t0 += 32) {
            float ca[32], cb[32];
#pragma unroll
            for (int t = 0; t < 32; ++t) { const float* cr = CAR + ((size_t)b * 64 + t0 + t) * 1024; ca[t] = cr[c]; cb[t] = cr[512 + c]; }
#pragma unroll
            for (int t = 0; t < 32; ++t) { HIN[((size_t)b * 64 + t0 + t) * 512 + c] = h; h = ca[t] * h + cb[t]; }
        }
        F.out[OUT_H_P + ((size_t)l * PB + b) * 512 + c] = h;
    }
}

__device__ __forceinline__ void convact_phase(Frame& F, int l) {
    const bf16* GP = WSP(bf16, WS_GP); const bf16* VAL = GP + (size_t)MT * DFF; bf16* ACT = WSP(bf16, WS_GP) + (size_t)2 * MT * DFF;
    const float* CW = FIN(I_FCW) + (size_t)l * 3 * DFF; const float* CBI = FIN(I_FCB) + (size_t)l * DFF;
    constexpr int NPR = PB * 15, NRUN = NPR + SB, NCG = DFF / 8;
    for (int it = F.bid * NTHR + F.tid; it < NRUN * NCG; it += F.G * NTHR) {
        const int run = it / NCG, cg = it % NCG, c = cg * 8;
        const bool isp = run < NPR; const size_t row0 = isp ? (size_t)(run / 15) * PT + 256 * (run % 15 + 1) : (size_t)PM + (run - NPR) * 8; const int nt = isp ? 2 : 8;
        f32x4 p2a, p2b, p1a, p1b;
        if (isp) { unpack8(*(const v4u*)(GP + (row0 - 2) * DFF + c), p2a, p2b); unpack8(*(const v4u*)(GP + (row0 - 1) * DFF + c), p1a, p1b); }
        else { const float* st = FIN(I_SFFN) + (((size_t)l * SB + (run - NPR)) * 2) * DFF + c; p2a = *(const f32x4*)st; p2b = *(const f32x4*)(st + 4); p1a = *(const f32x4*)(st + DFF); p1b = *(const f32x4*)(st + DFF + 4); }
        const f32x4 w0a = *(const f32x4*)(CW + c), w0b = *(const f32x4*)(CW + c + 4), w1a = *(const f32x4*)(CW + DFF + c), w1b = *(const f32x4*)(CW + DFF + c + 4), w2a = *(const f32x4*)(CW + 2 * DFF + c), w2b = *(const f32x4*)(CW + 2 * DFF + c + 4);
        const f32x4 ba = *(const f32x4*)(CBI + c), bb = *(const f32x4*)(CBI + c + 4);
        v4u gx[8], vx[8];
#pragma unroll
        for (int k = 0; k < 8; ++k) if (k < nt) { gx[k] = *(const v4u*)(GP + (row0 + k) * DFF + c); vx[k] = *(const v4u*)(VAL + (row0 + k) * DFF + c); }
#pragma unroll
        for (int k = 0; k < 8; ++k) if (k < nt) {
            f32x4 xa, xb, va, vb; unpack8(gx[k], xa, xb); unpack8(vx[k], va, vb);
            f32x4 ya = ba + w0a * p2a + w1a * p1a + w2a * xa, yb = bb + w0b * p2b + w1b * p1b + w2b * xb;
#pragma unroll
            for (int i = 0; i < 4; ++i) { ya[i] = siluf_(ya[i]) * va[i]; yb[i] = siluf_(yb[i]) * vb[i]; }
            *(v4u*)(ACT + (row0 + k) * DFF + c) = pack8(ya, yb);
            p2a = p1a; p2b = p1b; p1a = xa; p1b = xb;
        }
    }
}

constexpr int AT_RS = 144;
constexpr int AT_K0 = 0, AT_V0 = 2 * 64 * AT_RS, AT_PS = 4 * 64 * AT_RS, AT_IMP = AT_PS + 69632, AT_MASK = AT_IMP + 6144, AT_LIST = AT_MASK + 2048, AT_NL = AT_LIST + 1024;
constexpr unsigned AT_MARK = 0xFFFFu;
static_assert(AT_NL + 64 <= RING_BYTES, "attention LDS map");

struct TileRegs { v4u a, b, c, d; int mode; };

template <bool SMP> __device__ __forceinline__ void at_prefetch(const Frame& F, int l, int seq, int kvh, unsigned e, TileRegs& R) {
    const int kind = (int)(e >> 14), ti = (int)(e & 0x3fffu), rr = F.tid >> 3, pc = F.tid & 7;
    R.mode = 0;
    if (kind < 2) {
        const size_t rb = SMP ? (size_t)(seq * 2 + kvh) * 512 : (size_t)32768 + (size_t)(seq * 2 + kvh) * 256;
        const bf16* ck = WSP(bf16, WS_CK) + (rb + ti * 64 + rr) * 64 + pc * 8;
        R.a = *(const v4u*)ck; R.c = *(const v4u*)(ck + (size_t)CMP_ROWS_J * 64);
    } else if (!SMP) {
        const int jb = (kind == 2) ? 0 : 2;
        const bf16* kp = WSP(bf16, WS_KVB) + ((((size_t)jb * PB + seq) * 2 + kvh) * PT + ti * 64 + rr) * 64 + pc * 8;
        R.a = *(const v4u*)kp; R.c = *(const v4u*)(kp + (size_t)PB * 2 * PT * 64);
    } else if (kind == 2) {
        if (ti < 128) {
            const int page = ((const int*)F.a->in[I_PT])[seq * NPG + (ti >> 1)], slot = (ti & 1) * 64 + rr;
            const float* kp = FIN(I_CACHE) + (((((size_t)l * NPHYS + page) * PAGE + slot) * 4 + 2) * 2 + kvh) * 64 + pc * 8;
            R.a = *(const v4u*)kp; R.b = *(const v4u*)(kp + 4); R.c = *(const v4u*)(kp + 128); R.d = *(const v4u*)(kp + 132); R.mode = 1;
        } else if (rr < ST) {
            const bf16* kp = WSP(bf16, WS_KVS) + ((((size_t)0 * SB + seq) * 2 + kvh) * ST + rr) * 64 + pc * 8;
            R.a = *(const v4u*)kp; R.c = *(const v4u*)(kp + (size_t)SB * 2 * ST * 64);
        } else R.mode = 2;
    } else {
        if (ti < 8) {
            const float* kp = FIN(I_CWIN) + (((((size_t)l * SB + seq) * WINB + ti * 64 + rr) * 2 + 0) * 2 + kvh) * 64 + pc * 8;
            R.a = *(const v4u*)kp; R.b = *(const v4u*)(kp + 4); R.c = *(const v4u*)(kp + 128); R.d = *(const v4u*)(kp + 132); R.mode = 1;
        } else if (rr < ST) {
            const bf16* kp = WSP(bf16, WS_KVS) + ((((size_t)2 * SB + seq) * 2 + kvh) * ST + rr) * 64 + pc * 8;
            R.a = *(const v4u*)kp; R.c = *(const v4u*)(kp + (size_t)SB * 2 * ST * 64);
        } else R.mode = 2;
    }
}
__device__ __forceinline__ void at_store(const Frame& F, int buf, const TileRegs& R) {
    const int rr = F.tid >> 3, pc = F.tid & 7; v4u k, v;
    if (R.mode == 0) { k = R.a; v = R.c; }
    else if (R.mode == 1) { k = pack8(__builtin_bit_cast(f32x4, R.a), __builtin_bit_cast(f32x4, R.b)); v = pack8(__builtin_bit_cast(f32x4, R.c), __builtin_bit_cast(f32x4, R.d)); }
    else { k = (v4u){0u, 0u, 0u, 0u}; v = k; }
    *(LAS v4u*)(F.lds + AT_K0 + buf * 64 * AT_RS + rr * AT_RS + pc * 16) = k;
    *(LAS v4u*)(F.lds + AT_V0 + buf * 64 * AT_RS + rr * AT_RS + pc * 16) = v;
}

template <bool SMP> __device__ __forceinline__ void attn_unit(Frame& F, int l, int unit) {
    const int tid = F.tid, lane = F.lane, w = F.wave;
    const int q = lane & 31, h_ = lane >> 5, blk = (lane >> 4) & 1, tl = q >> 2, hr = q & 3;
    int seq, kvh, qt;
    if (SMP) { seq = unit >> 1; kvh = unit & 1; qt = 128; } else { seq = unit >> 7; kvh = (unit >> 6) & 1; qt = unit & 63; }
    const int t0 = SMP ? PAST : qt * 64;
    const int tokl = SMP ? tl : 8 * w + tl, t = t0 + tokl;
    const size_t row = SMP ? (size_t)PM + seq * ST + tl : (size_t)seq * PT + t;
    const int head = kvh * 4 + hr;
    LAS float* PS = (LAS float*)(F.lds + AT_PS); LAS float* IMPw = (LAS float*)(F.lds + AT_IMP) + w * 192;
    LAS unsigned long long* MASKS = (LAS unsigned long long*)(F.lds + AT_MASK); LAS unsigned short* LIST = (LAS unsigned short*)(F.lds + AT_LIST); LAS int* NL = (LAS int*)(F.lds + AT_NL);
    constexpr int PSS = SMP ? 520 : 264;
    LAS float* PSw = SMP ? PS : PS + w * 8 * PSS;
    __syncthreads();
    bf16x8 qf[4];
    { const bf16* qp = WSP(bf16, WS_QN) + row * 512 + head * 64 + 8 * h_;
#pragma unroll
      for (int kk = 0; kk < 4; ++kk) qf[kk] = *(const bf16x8*)(qp + 16 * kk); }
    const float* ngp = WSP(float, WS_NG) + row * 24 + head * 3; const float g0 = ngp[0], g1 = ngp[1], g2 = ngp[2];
    if (!SMP) { for (int i = lane; i < 8 * PSS; i += 64) PSw[i] = 0.f; }
    const int ntc = SMP ? 8 : ((t0 + 32) >> 10) + 1;
    if (tid < 2 * ntc) LIST[tid] = (unsigned short)(((tid >= ntc ? 1u : 0u) << 14) | (unsigned)(tid >= ntc ? tid - ntc : tid));
    if (tid == 0) LIST[2 * ntc] = (unsigned short)AT_MARK;
    int nl = 2 * ntc + 1;
    TileRegs R;
    at_prefetch<SMP>(F, l, seq, kvh, (unsigned)0, R);
    at_store(F, 0, R);
    __syncthreads();
    float m = -INFINITY, lsum = 0.f, invden = 0.f;
    f32x16 O[2]; O[0] = (f32x16){}; O[1] = (f32x16){};
    LAS float* OAw = (LAS float*)(F.lds + AT_PS) + w * (SMP ? 2048 : 8 * PSS) + lane;
    unsigned long long mk0 = 0ull, mk1 = 0ull, wu = ~0ull;
    int cur_kind = -1, idx = 0;
#define AT_FINALIZE(kind) do { \
        if ((kind) == 0) { const float lt = lsum + __shfl_xor(lsum, 32); invden = lt > 0.f ? 1.0f / lt : 0.f; } \
        else if ((kind) == 1) { const float sc = g0 * invden; O[0] *= sc; O[1] *= sc; } \
        else if ((kind) == 2) { const float lt = lsum + __shfl_xor(lsum, 32); const float sc = (lt > 0.f ? 1.0f / lt : 0.f) * g1; \
            _Pragma("unroll") for (int r_ = 0; r_ < 16; ++r_) { OAw[r_ * 64] += O[0][r_] * sc; OAw[(16 + r_) * 64] += O[1][r_] * sc; } } } while (0)
    while (idx < nl) {
        const unsigned e = (unsigned)__builtin_amdgcn_readfirstlane((int)LIST[idx]);
        if (e == AT_MARK) {
            AT_FINALIZE(cur_kind); cur_kind = -1;
            LDS_WAIT(); asm volatile("" ::: "memory");
#pragma unroll 1
            for (int tk = 0; tk < 8; ++tk) {
                const LAS float* pr = PSw + tk * PSS;
                if (!SMP) {
                    const int s = lane; float imp = 0.f;
#pragma unroll
                    for (int n = 4 * s - 1; n <= 4 * s + 3; ++n) if (n >= 0) imp += pr[n];
                    const bool forced = (s == 0) || (s == qt) || (s == qt - 1), avail = s <= qt;
                    const float val = avail ? (forced ? 1e4f : imp) : -1e4f;
                    IMPw[s] = val; LDS_WAIT(); asm volatile("" ::: "memory");
                    int rank = 0;
#pragma unroll 8
                    for (int i = 0; i < 64; ++i) { const float v = IMPw[i]; rank += (v > val || (v == val && i < s)) ? 1 : 0; }
                    const unsigned long long mk = __ballot(rank < 16);
                    if (lane == 0) MASKS[(8 * w + tk) * 4] = mk;
                    LDS_WAIT(); asm volatile("" ::: "memory");
                } else {
                    const int sa = lane, sb = lane + 64; float ia = 0.f, ib = 0.f;
#pragma unroll
                    for (int n = 4 * sa - 1; n <= 4 * sa + 3; ++n) if (n >= 0) ia += pr[n];
#pragma unroll
                    for (int n = 4 * sb - 1; n <= 4 * sb + 3; ++n) ib += pr[n];
                    const bool fa = (sa == 0), fb = (sb == 127);
                    const float va = fa ? 1e4f : ia, vb = fb ? 1e4f : ib;
                    IMPw[sa] = va; IMPw[sb] = vb; LDS_WAIT(); asm volatile("" ::: "memory");
                    int ra = fa ? 0 : 1, rb = fb ? 0 : 1;
#pragma unroll 8
                    for (int i = 0; i < 128; ++i) { const float v = IMPw[i]; ra += (v > va || (v == va && i < sa)) ? 1 : 0; rb += (v > vb || (v == vb && i < sb)) ? 1 : 0; }
                    const unsigned long long ma = __ballot(ra < 16), mb = __ballot(rb < 16);
                    if (lane == 0) { MASKS[tk * 4] = ma; MASKS[tk * 4 + 1] = mb; MASKS[tk * 4 + 2] = 1ull; }
                    LDS_WAIT(); asm volatile("" ::: "memory");
                }
            }
            __syncthreads();
#pragma unroll
            for (int r_ = 0; r_ < 16; ++r_) { OAw[r_ * 64] = O[0][r_]; OAw[(16 + r_) * 64] = O[1][r_]; }
            if (tid == 0) {
                int n = idx + 1;
                if (!SMP) { unsigned long long U = 0ull; for (int i = 0; i < 64; ++i) U |= MASKS[i * 4];
                    for (int s = 0; s <= qt; ++s) if ((U >> s) & 1ull) LIST[n++] = (unsigned short)((2u << 14) | (unsigned)s);
                    for (int s = (qt > 8 ? qt - 8 : 0); s <= qt; ++s) LIST[n++] = (unsigned short)((3u << 14) | (unsigned)s);
                } else { unsigned long long U0 = 0ull, U1 = 0ull; for (int i = 0; i < 8; ++i) { U0 |= MASKS[i * 4]; U1 |= MASKS[i * 4 + 1]; }
                    for (int s = 0; s < 64; ++s) if ((U0 >> s) & 1ull) LIST[n++] = (unsigned short)((2u << 14) | (unsigned)s);
                    for (int s = 0; s < 64; ++s) if ((U1 >> s) & 1ull) LIST[n++] = (unsigned short)((2u << 14) | (unsigned)(64 + s));
                    LIST[n++] = (unsigned short)((2u << 14) | 128u);
                    for (int s = 0; s <= 8; ++s) LIST[n++] = (unsigned short)((3u << 14) | (unsigned)s); }
                NL[0] = n;
            }
            __syncthreads();
            nl = __builtin_amdgcn_readfirstlane(NL[0]);
            mk0 = MASKS[tokl * 4]; if (SMP) { mk1 = MASKS[tokl * 4 + 1]; }
            if (!SMP) { unsigned long long u = 0ull; for (int i = 0; i < 8; ++i) u |= MASKS[(8 * w + i) * 4]; wu = u; }
            if (idx + 1 < nl) { at_prefetch<SMP>(F, l, seq, kvh, (unsigned)LIST[idx + 1], R); at_store(F, (idx + 1) & 1, R); }
            __syncthreads();
            ++idx; continue;
        }
        const int kind = (int)(e >> 14), ti = (int)(e & 0x3fffu);
        if (kind != cur_kind) {
            if (cur_kind >= 0) AT_FINALIZE(cur_kind);
            if (kind != 1) m = -INFINITY;
            lsum = 0.f; O[0] = (f32x16){}; O[1] = (f32x16){}; cur_kind = kind;
        }
        const unsigned en = (idx + 1 < nl) ? (unsigned)__builtin_amdgcn_readfirstlane((int)LIST[idx + 1]) : AT_MARK;
        const bool have_next = (en != AT_MARK);
        if (have_next) at_prefetch<SMP>(F, l, seq, kvh, en, R);
        bool active = true;
        if (!SMP && kind == 2) active = ((wu >> ti) & 1ull) != 0ull;
        if (active) {
            const LAS unsigned char* Kb = F.lds + AT_K0 + (idx & 1) * 64 * AT_RS; const LAS unsigned char* Vb = F.lds + AT_V0 + (idx & 1) * 64 * AT_RS;
            int lo, hi; const int kb = 64 * ti;
            if (kind < 2) { lo = 0; hi = SMP ? 510 : ((t >= 31) ? ((t - 31) >> 4) : -1); }
            else if (kind == 2) { lo = 0; const unsigned long long mw = (ti < 64) ? mk0 : ((ti < 128) ? mk1 : 1ull); hi = ((mw >> (ti & 63)) & 1ull) ? t : -1; }
            else { if (SMP) { lo = tl; hi = WINB + tl; } else { lo = t - WINB; hi = t; } }
            f32x16 s0 = (f32x16){}, s1 = (f32x16){};
#pragma unroll
            for (int kk = 0; kk < 4; ++kk) {
                const bf16x8 k0 = *(const LAS bf16x8*)(Kb + q * AT_RS + (16 * kk + 8 * h_) * 2), k1 = *(const LAS bf16x8*)(Kb + (32 + q) * AT_RS + (16 * kk + 8 * h_) * 2);
                s0 = mfma32(k0, qf[kk], s0); s1 = mfma32(k1, qf[kk], s1);
            }
            float tmax = -INFINITY;
#pragma unroll
            for (int r = 0; r < 16; ++r) { const int key = kb + (r & 3) + 8 * (r >> 2) + 4 * h_;
                s0[r] = (key >= lo && key <= hi) ? s0[r] : -INFINITY; s1[r] = (key + 32 >= lo && key + 32 <= hi) ? s1[r] : -INFINITY;
                tmax = fmaxf(tmax, fmaxf(s0[r], s1[r])); }
            tmax = fmaxf(tmax, __shfl_xor(tmax, 32));
            const float m_new = fmaxf(m, tmax), m_use = (m_new == -INFINITY) ? 0.f : m_new;
            const float alpha = fexp2(m - m_use);
            float ps = 0.f;
#pragma unroll
            for (int r = 0; r < 16; ++r) { s0[r] = fexp2(s0[r] - m_use); s1[r] = fexp2(s1[r] - m_use); ps += s0[r] + s1[r]; }
            lsum = lsum * alpha + ps; m = m_new;
            if (kind != 0) {
                O[0] *= alpha; O[1] *= alpha;
#pragma unroll
                for (int kt2 = 0; kt2 < 2; ++kt2)
#pragma unroll
                    for (int s2 = 0; s2 < 2; ++s2) { const bf16x8 pf = cvt_frag(kt2 ? s1 : s0, s2); const int rA = 32 * kt2 + 16 * s2 + 4 * h_;
#pragma unroll
                        for (int dt = 0; dt < 2; ++dt) { const bf16x8 vf = tr_frag(Vb, AT_RS, rA, rA + 8, 32 * dt + 16 * blk, lane); O[dt] = mfma32(vf, pf, O[dt]); } }
            }
            if (kind == 1) {
#pragma unroll
                for (int r = 0; r < 16; ++r) { const int n = kb + (r & 3) + 8 * (r >> 2) + 4 * h_;
                    float a = s0[r] * invden, b = s1[r] * invden; a += __shfl_xor(a, 1); b += __shfl_xor(b, 1); a += __shfl_xor(a, 2); b += __shfl_xor(b, 2);
                    if (hr == 0) { PSw[tl * PSS + n] = a; PSw[tl * PSS + n + 32] = b; } }
            }
        }
        if (have_next) at_store(F, (idx + 1) & 1, R);
        __syncthreads();
        ++idx;
    }
#undef AT_FINALIZE
    {
        const float lt = lsum + __shfl_xor(lsum, 32); const float sc = (lt > 0.f ? 1.0f / lt : 0.f) * g2;
        if (!SMP || w == 0) {
            bf16* op = WSP(bf16, WS_OA) + row * 512 + head * 64;
#pragma unroll
            for (int dt = 0; dt < 2; ++dt)
#pragma unroll
                for (int r4 = 0; r4 < 4; ++r4) { float o_[4];
#pragma unroll
                    for (int x = 0; x < 4; ++x) o_[x] = OAw[(dt * 16 + 4 * r4 + x) * 64] + O[dt][4 * r4 + x] * sc;
                    v2u wv; wv.x = pk2(o_[0], o_[1]); wv.y = pk2(o_[2], o_[3]); *(v2u*)(op + 32 * dt + 8 * r4 + 4 * h_) = wv; }
        }
    }
}

constexpr int AS_RS = 144;
constexpr int AS_V = 0, AS_VW = 32 * AS_RS, AS_MRG = 0, AS_PS = 73728, AS_IMP = AS_PS + 16640, AS_MASK = AS_IMP + 6144, AS_OA = AS_MASK + 512;
static_assert(8 * 34 * 64 * 4 <= AS_PS && AS_OA + 32 * 64 * 4 <= RING_BYTES, "sample attention LDS map");

__device__ __forceinline__ float xhalf_max(float x) { auto t_ = __builtin_amdgcn_permlane32_swap(__float_as_uint(x), __float_as_uint(x), false, false); return fmaxf(__uint_as_float(t_[0]), __uint_as_float(t_[1])); }
__device__ __forceinline__ float xhalf_sum(float x) { auto t_ = __builtin_amdgcn_permlane32_swap(__float_as_uint(x), __float_as_uint(x), false, false); return __uint_as_float(t_[0]) + __uint_as_float(t_[1]); }
struct ASrc { const float* kf; const float* vf; const bf16* kb; const bf16* vb; int rs; int nvalid; };
#define AS_TILE(SRC, KB0, LO_, HI_, DO_PV, DO_PS, m, lsum, O0, O1, invden, PSS_) do { \
        bf16x8 kfr[4]; f32x4 vx_[8]; \
        if ((SRC).kb) { const bf16* kp_ = (SRC).kb + (size_t)q * (SRC).rs + 8 * h_; _Pragma("unroll") for (int kk = 0; kk < 4; ++kk) kfr[kk] = *(const bf16x8*)(kp_ + 16 * kk); } \
        else {   \
            f32x4 kx_[8]; _Pragma("unroll") for (int x = 0; x < 8; ++x) kx_[x] = *(const f32x4*)((SRC).kf + (size_t)(4 * x + (lane >> 4)) * (SRC).rs + (lane & 15) * 4); \
            _Pragma("unroll") for (int x = 0; x < 8; ++x) { v2u o_; o_.x = pk2(kx_[x][0], kx_[x][1]); o_.y = pk2(kx_[x][2], kx_[x][3]); *(LAS v2u*)(Vw + (4 * x + (lane >> 4)) * AS_RS + (lane & 15) * 8) = o_; } \
            LDS_WAIT(); asm volatile("" ::: "memory"); \
            _Pragma("unroll") for (int kk = 0; kk < 4; ++kk) kfr[kk] = *(const LAS bf16x8*)(Vw + q * AS_RS + (16 * kk + 8 * h_) * 2); \
            LDS_WAIT(); asm volatile("" ::: "memory"); \
            if (DO_PV) { _Pragma("unroll") for (int x = 0; x < 8; ++x) vx_[x] = *(const f32x4*)((SRC).vf + (size_t)(4 * x + (lane >> 4)) * (SRC).rs + (lane & 15) * 4); } }     \
        if (DO_PV) { const int vr_ = lane >> 1, vh_ = lane & 1; v4u vv_[4]; \
            if (vr_ >= (SRC).nvalid) { _Pragma("unroll") for (int x = 0; x < 4; ++x) vv_[x] = (v4u){0u, 0u, 0u, 0u}; } \
            else if ((SRC).vb) { const bf16* vp_ = (SRC).vb + (size_t)vr_ * (SRC).rs + 32 * vh_; _Pragma("unroll") for (int x = 0; x < 4; ++x) vv_[x] = *(const v4u*)(vp_ + 8 * x); } \
            if ((SRC).vb || vr_ >= (SRC).nvalid) { _Pragma("unroll") for (int x = 0; x < 4; ++x) *(LAS v4u*)(Vw + vr_ * AS_RS + vh_ * 64 + x * 16) = vv_[x]; } } \
        f32x16 s_ = (f32x16){}; \
        _Pragma("unroll") for (int kk = 0; kk < 4; ++kk) s_ = mfma32(kfr[kk], qf[kk], s_); \
        float tmax_ = -INFINITY; \
        _Pragma("unroll") for (int r = 0; r < 16; ++r) { const int key_ = (KB0) + (r & 3) + 8 * (r >> 2) + 4 * h_; s_[r] = (key_ >= (LO_) && key_ <= (HI_)) ? s_[r] : -INFINITY; tmax_ = fmaxf(tmax_, s_[r]); } \
        tmax_ = xhalf_max(tmax_); \
        const float mn_ = fmaxf(m, tmax_), mu_ = (mn_ == -INFINITY) ? 0.f : mn_, al_ = fexp2(m - mu_); float ps_ = 0.f; \
        _Pragma("unroll") for (int r = 0; r < 16; ++r) { s_[r] = fexp2(s_[r] - mu_); ps_ += s_[r]; } \
        lsum = lsum * al_ + ps_; m = mn_; \
        if (DO_PV) { O0 *= al_; O1 *= al_; \
            if (!(SRC).vb) { _Pragma("unroll") for (int x = 0; x < 8; ++x) { v2u o_; o_.x = pk2(vx_[x][0], vx_[x][1]); o_.y = pk2(vx_[x][2], vx_[x][3]); *(LAS v2u*)(Vw + (4 * x + (lane >> 4)) * AS_RS + (lane & 15) * 8) = o_; } } \
            LDS_WAIT(); asm volatile("" ::: "memory"); \
            _Pragma("unroll") for (int s2 = 0; s2 < 2; ++s2) { const bf16x8 pf_ = cvt_frag(s_, s2); const int rA_ = 16 * s2 + 4 * h_; \
                O0 = mfma32(tr_frag(Vw, AS_RS, rA_, rA_ + 8, 16 * blk, lane), pf_, O0); O1 = mfma32(tr_frag(Vw, AS_RS, rA_, rA_ + 8, 32 + 16 * blk, lane), pf_, O1); } \
            LDS_WAIT(); asm volatile("" ::: "memory"); } \
        if (DO_PS) { _Pragma("unroll") for (int r = 0; r < 16; ++r) { const int n_ = (KB0) + (r & 3) + 8 * (r >> 2) + 4 * h_; float a_ = s_[r] * (invden); a_ += __shfl_xor(a_, 1); a_ += __shfl_xor(a_, 2); if (hr == 0) PS[tl * (PSS_) + n_] = a_; } } \
    } while (0)

__device__ __forceinline__ void attn_sample_unit(Frame& F, int l, int unit) {
    const int lane = F.lane, w = F.wave, tid = F.tid;
    const int q = lane & 31, h_ = lane >> 5, blk = (lane >> 4) & 1, tl = q >> 2, hr = q & 3;
    const int seq = unit >> 1, kvh = unit & 1, head = kvh * 4 + hr;
    const size_t row = (size_t)PM + seq * ST + tl;
    LAS unsigned char* Vw = F.lds + AS_V + w * AS_VW;
    LAS float* MRG = (LAS float*)(F.lds + AS_MRG);
    LAS float* PS = (LAS float*)(F.lds + AS_PS);
    LAS float* IMPw = (LAS float*)(F.lds + AS_IMP) + w * 192;
    LAS unsigned long long* MASKS = (LAS unsigned long long*)(F.lds + AS_MASK);
    __syncthreads();
    bf16x8 qf[4];
    { const bf16* qp = WSP(bf16, WS_QN) + row * 512 + head * 64 + 8 * h_;
#pragma unroll
      for (int kk = 0; kk < 4; ++kk) qf[kk] = *(const bf16x8*)(qp + 16 * kk); }
    const float* ngp = WSP(float, WS_NG) + row * 24 + head * 3; const float g0 = ngp[0], g1 = ngp[1], g2 = ngp[2];
    const int* ptab = (const int*)F.a->in[I_PT] + seq * NPG;
    LAS float* OAL = (LAS float*)(F.lds + AS_OA) + lane;

#define AS_PUBLISH(m, lsum, O0, O1) do { __syncthreads(); LAS float* mp_ = MRG + w * 34 * 64 + lane; mp_[0] = m; mp_[64] = lsum; \
        _Pragma("unroll") for (int r = 0; r < 16; ++r) { mp_[(2 + r) * 64] = O0[r]; mp_[(18 + r) * 64] = O1[r]; } __syncthreads(); } while (0)

    const bf16* CKk = WSP(bf16, WS_CK) + ((size_t)(seq * 2 + kvh) * 512) * 64; const bf16* CKv = CKk + (size_t)CMP_ROWS_J * 64;
    float mC = -INFINITY, lC = 0.f; f32x16 D0 = (f32x16){}, D1 = (f32x16){};
#pragma unroll 1
    for (int ti = w; ti < 16; ti += 8) { ASrc S{nullptr, nullptr, CKk + (size_t)ti * 32 * 64, CKv + (size_t)ti * 32 * 64, 64, 32}; AS_TILE(S, ti * 32, 0, 510, false, false, mC, lC, D0, D1, 0.f, 520); }
    { __syncthreads(); MRG[w * 128 + lane] = mC; MRG[w * 128 + 64 + lane] = xhalf_sum(lC); __syncthreads(); }
    float mT = -INFINITY;
#pragma unroll
    for (int x = 0; x < 8; ++x) mT = fmaxf(mT, MRG[x * 128 + lane]);
    float lT = 0.f;
#pragma unroll
    for (int x = 0; x < 8; ++x) { const float mx_ = MRG[x * 128 + lane]; lT += (mx_ == -INFINITY) ? 0.f : MRG[x * 128 + 64 + lane] * fexp2(mx_ - mT); }
    const float invC = lT > 0.f ? 1.0f / lT : 0.f;
    __syncthreads();
    { float mB = mT, lB = 0.f;
#pragma unroll 1
      for (int ti = w; ti < 16; ti += 8) { ASrc S{nullptr, nullptr, CKk + (size_t)ti * 32 * 64, CKv + (size_t)ti * 32 * 64, 64, 32}; AS_TILE(S, ti * 32, 0, 510, true, true, mB, lB, D0, D1, invC, 520); }
      AS_PUBLISH(mB, lB, D0, D1); }
    if (w == 0) { const float sc = g0 * invC; f32x16 T0 = (f32x16){}, T1 = (f32x16){};
#pragma unroll 1
      for (int x = 0; x < 8; ++x) { const LAS float* mp = MRG + x * 34 * 64 + lane;
#pragma unroll
          for (int r = 0; r < 16; ++r) { T0[r] += mp[(2 + r) * 64] * sc; T1[r] += mp[(18 + r) * 64] * sc; } }
#pragma unroll
      for (int r = 0; r < 16; ++r) { OAL[r * 64] = T0[r]; OAL[(16 + r) * 64] = T1[r]; } }
    {
        const LAS float* pr = PS + w * 520; const int sa = lane, sb = lane + 64; float ia = 0.f, ib = 0.f;
#pragma unroll
        for (int n = 4 * sa - 1; n <= 4 * sa + 3; ++n) if (n >= 0) ia += pr[n];
#pragma unroll
        for (int n = 4 * sb - 1; n <= 4 * sb + 3; ++n) ib += pr[n];
        const bool fa = (sa == 0), fb = (sb == 127); const float va = fa ? 1e4f : ia, vb = fb ? 1e4f : ib;
        IMPw[sa] = va; IMPw[sb] = vb; LDS_WAIT(); asm volatile("" ::: "memory");
        int ra = fa ? 0 : 1, rb = fb ? 0 : 1;
#pragma unroll 8
        for (int i = 0; i < 128; ++i) { const float v = IMPw[i]; ra += (v > va || (v == va && i < sa)) ? 1 : 0; rb += (v > vb || (v == vb && i < sb)) ? 1 : 0; }
        const unsigned long long ma = __ballot(ra < 16), mb = __ballot(rb < 16);
        if (lane == 0) { MASKS[w * 4] = ma; MASKS[w * 4 + 1] = mb; }
    }
    __syncthreads();
    const unsigned long long mk0 = MASKS[tl * 4], mk1 = MASKS[tl * 4 + 1];
    unsigned long long U0 = 0ull, U1 = 0ull;
#pragma unroll
    for (int x = 0; x < 8; ++x) { U0 |= MASKS[x * 4]; U1 |= MASKS[x * 4 + 1]; }
    {
        float m = -INFINITY, ls = 0.f; D0 = (f32x16){}; D1 = (f32x16){};
        const int t = PAST + tl; int cnt = 0;
#pragma unroll 1
        for (int s = 0; s <= 128; ++s) {
            const bool in_u = (s < 64) ? ((U0 >> s) & 1ull) : ((s < 128) ? ((U1 >> (s - 64)) & 1ull) : true);
            if (!in_u) continue;
            const bool selb = (s < 64) ? ((mk0 >> s) & 1ull) : ((s < 128) ? ((mk1 >> (s - 64)) & 1ull) : true);
            const int nh = (s < 128) ? 2 : 1;
            for (int hf = 0; hf < nh; ++hf, ++cnt) {
                if ((cnt & 7) != w) continue;
                const int hi = selb ? t : -1;
                if (s < 128) { const int page = ptab[s >> 1], slot = (s & 1) * 64 + hf * 32;
                    const float* kp = FIN(I_CACHE) + (((((size_t)l * NPHYS + page) * PAGE + slot) * 4 + 2) * 2 + kvh) * 64;
                    ASrc S{kp, kp + 128, nullptr, nullptr, 512, 32}; AS_TILE(S, s * 64 + hf * 32, 0, hi, true, false, m, ls, D0, D1, 0.f, 520); }
                else { const bf16* kp = WSP(bf16, WS_KVS) + ((((size_t)0 * SB + seq) * 2 + kvh) * ST) * 64;
                    ASrc S{nullptr, nullptr, kp, kp + (size_t)SB * 2 * ST * 64, 64, ST}; AS_TILE(S, PAST, 0, hi, true, false, m, ls, D0, D1, 0.f, 520); }
            }
        }
        AS_PUBLISH(m, ls, D0, D1);
        float mt = -INFINITY;
#pragma unroll
        for (int x = 0; x < 8; ++x) mt = fmaxf(mt, MRG[x * 34 * 64 + lane]);
        float lt = 0.f; f32x16 T0 = (f32x16){}, T1 = (f32x16){};
#pragma unroll 1
        for (int x = 0; x < 8; ++x) { const LAS float* mp = MRG + x * 34 * 64 + lane; const float mx_ = mp[0]; const float f = (mx_ == -INFINITY) ? 0.f : fexp2(mx_ - mt); lt += mp[64] * f;
#pragma unroll
            for (int r = 0; r < 16; ++r) { T0[r] += mp[(2 + r) * 64] * f; T1[r] += mp[(18 + r) * 64] * f; } }
        lt = xhalf_sum(lt); const float sc = (lt > 0.f ? 1.0f / lt : 0.f) * g1;
        if (w == 0) {
#pragma unroll
            for (int r = 0; r < 16; ++r) { OAL[r * 64] += T0[r] * sc; OAL[(16 + r) * 64] += T1[r] * sc; } }
    }
    {
        float m = -INFINITY, ls = 0.f; D0 = (f32x16){}; D1 = (f32x16){};
#pragma unroll 1
        for (int ti = w; ti < 17; ti += 8) {
            if (ti < 16) { const float* kp = FIN(I_CWIN) + (((((size_t)l * SB + seq) * WINB + ti * 32) * 2 + 0) * 2 + kvh) * 64;
                ASrc S{kp, kp + 128, nullptr, nullptr, 256, 32}; AS_TILE(S, ti * 32, tl, WINB + tl, true, false, m, ls, D0, D1, 0.f, 520); }
            else { const bf16* kp = WSP(bf16, WS_KVS) + ((((size_t)2 * SB + seq) * 2 + kvh) * ST) * 64;
                ASrc S{nullptr, nullptr, kp, kp + (size_t)SB * 2 * ST * 64, 64, ST}; AS_TILE(S, WINB, tl, WINB + tl, true, false, m, ls, D0, D1, 0.f, 520); }
        }
        AS_PUBLISH(m, ls, D0, D1);
        float mt = -INFINITY;
#pragma unroll
        for (int x = 0; x < 8; ++x) mt = fmaxf(mt, MRG[x * 34 * 64 + lane]);
        float lt = 0.f; f32x16 T0 = (f32x16){}, T1 = (f32x16){};
#pragma unroll 1
        for (int x = 0; x < 8; ++x) { const LAS float* mp = MRG + x * 34 * 64 + lane; const float mx_ = mp[0]; const float f = (mx_ == -INFINITY) ? 0.f : fexp2(mx_ - mt); lt += mp[64] * f;
#pragma unroll
            for (int r = 0; r < 16; ++r) { T0[r] += mp[(2 + r) * 64] * f; T1[r] += mp[(18 + r) * 64] * f; } }
        lt = xhalf_sum(lt); const float sc = (lt > 0.f ? 1.0f / lt : 0.f) * g2;
        if (w == 0) {
#pragma unroll
            for (int r = 0; r < 16; ++r) { OAL[r * 64] += T0[r] * sc; OAL[(16 + r) * 64] += T1[r] * sc; } }
    }
#undef AS_PUBLISH
    if (w == 0) {
        bf16* op = WSP(bf16, WS_OA) + row * 512 + head * 64;
#pragma unroll
        for (int r4 = 0; r4 < 4; ++r4) { float a_[4], b_[4];
#pragma unroll
            for (int x = 0; x < 4; ++x) { a_[x] = OAL[(4 * r4 + x) * 64]; b_[x] = OAL[(16 + 4 * r4 + x) * 64]; }
            v2u a, b; a.x = pk2(a_[0], a_[1]); a.y = pk2(a_[2], a_[3]); b.x = pk2(b_[0], b_[1]); b.y = pk2(b_[2], b_[3]);
            *(v2u*)(op + 8 * r4 + 4 * h_) = a; *(v2u*)(op + 32 + 8 * r4 + 4 * h_) = b; }
    }
}

#ifndef DBG_DUP
#define DBG_DUP 0
#endif
#if DBG_DUP == 1
#define AP_DUP_QK(NK) { f32x16 d_ = (f32x16){}; _Pragma("unroll") for (int kk = 0; kk < 4; ++kk) d_ = mfma32(NK[kk], qf[(kk + 1) & 3], d_); _Pragma("unroll") for (int r = 0; r < 16; ++r) s_[r] += zf * d_[r]; }
#else
#define AP_DUP_QK(NK)
#endif
#if DBG_DUP == 2
#define AP_DUP_EXP() { float acc_ = 0.f; _Pragma("unroll") for (int r = 0; r < 16; ++r) acc_ += fexp2(s_[r] * 0.5f - 3.0f); lsum += zf * acc_; }
#else
#define AP_DUP_EXP()
#endif
#if DBG_DUP == 3
#define AP_DUP_PV() { f32x16 e0_ = (f32x16){}, e1_ = (f32x16){}; _Pragma("unroll") for (int s2 = 0; s2 < 2; ++s2) { const bf16x8 pf_ = cvt_frag(s_, 1 - s2); const int rA_ = 16 * s2 + 4 * h_; \
        e0_ = mfma32(tr_frag(Vw, AS_RS, rA_ + 8, rA_, 16 * blk, lane), pf_, e0_); e1_ = mfma32(tr_frag(Vw, AS_RS, rA_ + 8, rA_, 32 + 16 * blk, lane), pf_, e1_); } D0 += e0_ * zf; D1 += e1_ * zf; }
#else
#define AP_DUP_PV()
#endif
constexpr int AP_WS = 14336, AP_V = 0, AP_PS = 4608, AP_IMP = AP_PS + 8 * 264 * 4, AP_MASK = AP_IMP + 256, AP_LIST = AP_MASK + 64;
static_assert(AP_LIST + 2 * 192 <= AP_WS && 8 * AP_WS <= RING_BYTES, "prompt attention LDS map");
__device__ __forceinline__ void attn_prompt_unit(Frame& F, int l, int unit) {
    const int lane = F.lane, w = F.wave;
    const int q = lane & 31, h_ = lane >> 5, blk = (lane >> 4) & 1, tl = q >> 2, hr = q & 3;
    const int seq = unit >> 7, kvh = (unit >> 6) & 1, qt = unit & 63, head = kvh * 4 + hr;
    const int t0w = qt * 64 + 8 * w, t = t0w + tl; const size_t row = (size_t)seq * PT + t;
    LAS unsigned char* Vw = F.lds + w * AP_WS + AP_V; LAS float* PS = (LAS float*)(F.lds + w * AP_WS + AP_PS); LAS float* IMPw = (LAS float*)(F.lds + w * AP_WS + AP_IMP);
    LAS unsigned long long* MASKS = (LAS unsigned long long*)(F.lds + w * AP_WS + AP_MASK); LAS unsigned short* LIST = (LAS unsigned short*)(F.lds + w * AP_WS + AP_LIST);
    __syncthreads();
    bf16x8 qf[4];
    { const bf16* qp = WSP(bf16, WS_QN) + row * 512 + head * 64 + 8 * h_;
#pragma unroll
      for (int kk = 0; kk < 4; ++kk) qf[kk] = *(const bf16x8*)(qp + 16 * kk); }
    const float* ngp = WSP(float, WS_NG) + row * 24 + head * 3; const float g0 = ngp[0], g1 = ngp[1], g2 = ngp[2];
    for (int i = lane; i < 8 * 264; i += 64) PS[i] = 0.f;
    const bf16* CKk = WSP(bf16, WS_CK) + ((size_t)32768 + (seq * 2 + kvh) * 256) * 64; const bf16* CKv = CKk + (size_t)CMP_ROWS_J * 64;
    const bf16* KS = WSP(bf16, WS_KVB) + ((((size_t)0 * PB + seq) * 2 + kvh) * PT) * 64; const bf16* VS = KS + (size_t)PB * 2 * PT * 64;
    const bf16* KW = KS + (size_t)2 * PB * 2 * PT * 64; const bf16* VW = KW + (size_t)PB * 2 * PT * 64;
    const int hiCmin = (t0w >= 31) ? ((t0w - 31) >> 4) : -1;
    const int hiC = (t >= 31) ? ((t - 31) >> 4) : -1; const int nmaxw = (t0w + 7 >= 31) ? ((t0w + 7 - 31) >> 4) : -1; const int ntc = (nmaxw >= 0) ? (nmaxw >> 5) + 1 : 0;
    f32x16 D0 = (f32x16){}, D1 = (f32x16){};
    LAS float* OAG = PS + lane;
    float m = -INFINITY, lsum = 0.f, invC = 0.f; unsigned long long mk0 = 0ull;
    const float zf = (F.G == 12345) ? 1.0f : 0.0f;
    bf16x8 nk0[4]; v4u nv0[4], nv1[4];
#define AP_LOADK(e_, NK) do { const int kd_ = (int)((e_) >> 12), ti_ = (int)((e_) & 0xfffu); const bf16* kb_ = (kd_ < 2 ? CKk : (kd_ == 2 ? KS : KW)) + (size_t)ti_ * 32 * 64; \
        const int ko_ = kd_ < 2 ? q * 64 + 8 * h_ : lane * 8, ks_ = kd_ < 2 ? 16 : 512;     \
        _Pragma("unroll") for (int kk = 0; kk < 4; ++kk) NK[kk] = *(const bf16x8*)(kb_ + ko_ + ks_ * kk); } while (0)
#define AP_LOADV(e_, NV) do { const int kd_ = (int)((e_) >> 12), ti_ = (int)((e_) & 0xfffu); const bf16* vb_ = (kd_ < 2 ? CKv : (kd_ == 2 ? VS : VW)) + (size_t)ti_ * 32 * 64; \
        _Pragma("unroll") for (int x = 0; x < 4; ++x) NV[x] = *(const v4u*)(vb_ + 512 * x + lane * 8); } while (0)
#define AP_LOADT(e_, NK, NV) do { AP_LOADK(e_, NK); AP_LOADV(e_, NV); } while (0)
#define AP_STEP(i_, n_, NK, NV, NVN, EC, ECN) do { \
        const unsigned e_ = EC; const int kind = (int)(e_ >> 12), ti = (int)(e_ & 0xfffu); \
        if (kind == 1) { _Pragma("unroll") for (int x = 0; x < 4; ++x) *(LAS v4u*)(Vw + (8 * x + (lane >> 3)) * AS_RS + (lane & 7) * 16) = NV[x]; }     \
        f32x16 s_ = (f32x16){}; \
        _Pragma("unroll") for (int kk = 0; kk < 4; ++kk) s_ = mfma32(NK[kk], qf[kk], s_); \
        AP_DUP_QK(NK) \
          \
        if ((i_) + 1 < (n_)) { AP_LOADK(ECN, NK); AP_LOADV(ECN, NVN); if ((i_) + 2 < (n_)) EC = (unsigned)__builtin_amdgcn_readfirstlane((int)LIST[(i_) + 2]); } \
        if (kind != cur_kind) { \
            if (cur_kind == 0) { const float lt_ = xhalf_sum(lsum); invC = lt_ > 0.f ? 1.0f / lt_ : 0.f; } \
            else if (cur_kind == 2) { const float lt_ = xhalf_sum(lsum); const float sc_ = (lt_ > 0.f ? 1.0f / lt_ : 0.f) * g1; \
                _Pragma("unroll") for (int r = 0; r < 16; ++r) { OAG[r * 64] += D0[r] * sc_; OAG[(16 + r) * 64] += D1[r] * sc_; } } \
            if (kind != 1) m = -INFINITY; lsum = 0.f; D0 = (f32x16){}; D1 = (f32x16){}; cur_kind = kind; } \
        const int kb = ti * 32; int lo, hi; \
        if (kind < 2) { lo = 0; hi = hiC; } else if (kind == 2) { lo = 0; hi = ((mk0 >> (ti >> 1)) & 1ull) ? t : -1; } else { lo = t - WINB; hi = t; } \
          \
        const bool interior = (kind < 2) ? (hiCmin >= 0 && kb + 31 <= hiCmin) : ((kind == 2) ? (kb + 31 <= t0w) : (kb >= t0w + 7 - WINB && kb + 31 <= t0w)); \
        float tmax_ = -INFINITY, mu_, mn_; \
        if (interior) { const bool on_ = hi >= 0; \
            _Pragma("unroll") for (int r = 0; r < 16; ++r) tmax_ = fmaxf(tmax_, s_[r]); \
            tmax_ = on_ ? tmax_ : -INFINITY; tmax_ = xhalf_max(tmax_); \
            mn_ = fmaxf(m, tmax_); mu_ = (mn_ == -INFINITY) ? 0.f : mn_; const float mr_ = on_ ? mu_ : INFINITY; \
            _Pragma("unroll") for (int r = 0; r < 16; ++r) s_[r] = fexp2(s_[r] - mr_); \
        } else { \
            _Pragma("unroll") for (int r = 0; r < 16; ++r) { const int key_ = kb + (r & 3) + 8 * (r >> 2) + 4 * h_; s_[r] = (key_ >= lo && key_ <= hi) ? s_[r] : -INFINITY; tmax_ = fmaxf(tmax_, s_[r]); } \
            tmax_ = xhalf_max(tmax_); \
            mn_ = fmaxf(m, tmax_); mu_ = (mn_ == -INFINITY) ? 0.f : mn_; \
            _Pragma("unroll") for (int r = 0; r < 16; ++r) s_[r] = fexp2(s_[r] - mu_); \
        } \
        AP_DUP_EXP() \
        const float al_ = fexp2(m - mu_); float ps_ = 0.f; \
        _Pragma("unroll") for (int r = 0; r < 16; ++r) ps_ += s_[r]; \
        lsum = lsum * al_ + ps_; m = mn_; \
        if (kind >= 2) { if (__ballot(al_ != 1.0f) != 0ull) { D0 *= al_; D1 *= al_; } \
            const bf16x8 pf0_ = cvt_frag(s_, 0), pf1_ = cvt_frag(s_, 1); \
            D0 = mfma32(__builtin_bit_cast(bf16x8, NV[0]), pf0_, D0); D1 = mfma32(__builtin_bit_cast(bf16x8, NV[2]), pf0_, D1); D0 = mfma32(__builtin_bit_cast(bf16x8, NV[1]), pf1_, D0); D1 = mfma32(__builtin_bit_cast(bf16x8, NV[3]), pf1_, D1); \
        } else if (kind == 1) { if (__ballot(al_ != 1.0f) != 0ull) { D0 *= al_; D1 *= al_; } asm volatile("" ::: "memory");   \
            { const bf16x8 va0_ = tr_frag(Vw, AS_RS, 4 * h_, 4 * h_ + 8, 16 * blk, lane), va1_ = tr_frag(Vw, AS_RS, 4 * h_, 4 * h_ + 8, 32 + 16 * blk, lane), \
                           vb0_ = tr_frag(Vw, AS_RS, 16 + 4 * h_, 24 + 4 * h_, 16 * blk, lane), vb1_ = tr_frag(Vw, AS_RS, 16 + 4 * h_, 24 + 4 * h_, 32 + 16 * blk, lane);   \
              const bf16x8 pf0_ = cvt_frag(s_, 0), pf1_ = cvt_frag(s_, 1); \
              D0 = mfma32(va0_, pf0_, D0); D1 = mfma32(va1_, pf0_, D1); D0 = mfma32(vb0_, pf1_, D0); D1 = mfma32(vb1_, pf1_, D1); } \
            AP_DUP_PV() \
            asm volatile("" ::: "memory"); } \
        if (kind == 1) { _Pragma("unroll") for (int r = 0; r < 16; ++r) { const int n2_ = kb + (r & 3) + 8 * (r >> 2) + 4 * h_; float a_ = s_[r] * invC; a_ += __shfl_xor(a_, 1); a_ += __shfl_xor(a_, 2); if (hr == 0) PS[tl * 264 + n2_] = a_; } } \
    } while (0)
#define AP_RUN(N_) do { const int n_ = (N_); unsigned ec0_ = 0u, ec1_ = 0u;                  \
      if (n_ > 0) { ec0_ = (unsigned)__builtin_amdgcn_readfirstlane((int)LIST[0]); AP_LOADK(ec0_, nk0); AP_LOADV(ec0_, nv0); } \
      if (n_ > 1) { ec1_ = (unsigned)__builtin_amdgcn_readfirstlane((int)LIST[1]); } \
      _Pragma("unroll 1") for (int i_ = 0; i_ < n_; i_ += 2) { AP_STEP(i_, n_, nk0, nv0, nv1, ec0_, ec1_); if (i_ + 1 < n_) AP_STEP(i_ + 1, n_, nk0, nv1, nv0, ec1_, ec0_); } } while (0)
    int cur_kind = -1;
    if (lane < 2 * ntc) LIST[lane] = (unsigned short)(((lane >= ntc ? 1u : 0u) << 12) | (unsigned)(lane >= ntc ? lane - ntc : lane));
    LDS_WAIT(); asm volatile("" ::: "memory");
    AP_RUN(2 * ntc);
    { const float sc = (cur_kind == 1) ? g0 * invC : 0.f; D0 *= sc; D1 *= sc; }
    LDS_WAIT(); asm volatile("" ::: "memory");
#pragma unroll 1
    for (int tk = 0; tk < 8; ++tk) {
        const LAS float* pr = PS + tk * 264; const int s = lane; float imp = 0.f;
#pragma unroll
        for (int n = 4 * s - 1; n <= 4 * s + 3; ++n) if (n >= 0) imp += pr[n];
        const bool forced = (s == 0) || (s == qt) || (s == qt - 1), avail = s <= qt;
        const unsigned key = avail ? (forced ? 0x7fffffffu : (imp > 0.f ? __float_as_uint(imp) + 1u : 1u)) : 0u;
        unsigned thr = 0u;
#pragma unroll
        for (int bit = 30; bit >= 0; --bit) { const unsigned cand = thr | (1u << bit); const int cnt = __popcll(__ballot(key >= cand)); thr = (cnt >= 16) ? cand : thr; }
        const unsigned long long gt = __ballot(key > thr), eq = __ballot(key == thr); const int need = 16 - __popcll(gt);
        const int below = __builtin_amdgcn_mbcnt_hi((unsigned)(eq >> 32), __builtin_amdgcn_mbcnt_lo((unsigned)eq, 0u));
        const unsigned long long mk = gt | __ballot(key == thr && below < need);
        if (lane == 0) MASKS[tk] = mk;
        LDS_WAIT(); asm volatile("" ::: "memory");
    }
#pragma unroll
    for (int r = 0; r < 16; ++r) { OAG[r * 64] = D0[r]; OAG[(16 + r) * 64] = D1[r]; }
    mk0 = MASKS[tl]; unsigned long long wu = 0ull;
#pragma unroll
    for (int i = 0; i < 8; ++i) wu |= MASKS[i];
    wu &= (qt >= 63) ? ~0ull : ((1ull << (qt + 1)) - 1ull);
    const int nsel = 2 * __popcll(wu); const int tiLo = (t0w > WINB) ? ((t0w - WINB) >> 5) : 0, tiHi = (t0w + 7) >> 5, nwin = tiHi - tiLo + 1;
    if ((wu >> lane) & 1ull) { const int pos = 2 * __popcll(wu & ((1ull << lane) - 1ull)); LIST[pos] = (unsigned short)((2u << 12) | (unsigned)(2 * lane)); LIST[pos + 1] = (unsigned short)((2u << 12) | (unsigned)(2 * lane + 1)); }
    if (lane < nwin) LIST[nsel + lane] = (unsigned short)((3u << 12) | (unsigned)(tiLo + lane));
    LDS_WAIT(); asm volatile("" ::: "memory");
#ifdef DBG_COUNT
    if (lane == 0) { unsigned* CNT = (unsigned*)(F.ws + WS_CTL) + 3000; atomicAdd(CNT + 0, (unsigned)nsel); atomicAdd(CNT + 1, (unsigned)nwin); atomicAdd(CNT + 2, (unsigned)(2 * ntc)); atomicAdd(CNT + 3, 1u); }
#endif
    cur_kind = -1;
    AP_RUN(nsel + nwin);
    const float ltw = xhalf_sum(lsum); const float scw = (ltw > 0.f ? 1.0f / ltw : 0.f) * g2;
#undef AP_RUN
#undef AP_STEP
#undef AP_LOADT
#undef AP_LOADK
#undef AP_LOADV
    {
        bf16* op = WSP(bf16, WS_OA) + row * 512 + head * 64;
#pragma unroll
        for (int r4 = 0; r4 < 4; ++r4) { float a_[4], b_[4];
#pragma unroll
            for (int x = 0; x < 4; ++x) { a_[x] = OAG[(4 * r4 + x) * 64] + D0[4 * r4 + x] * scw; b_[x] = OAG[(16 + 4 * r4 + x) * 64] + D1[4 * r4 + x] * scw; }
            v2u a, b; a.x = pk2(a_[0], a_[1]); a.y = pk2(a_[2], a_[3]); b.x = pk2(b_[0], b_[1]); b.y = pk2(b_[2], b_[3]);
            *(v2u*)(op + 8 * r4 + 4 * h_) = a; *(v2u*)(op + 32 + 8 * r4 + 4 * h_) = b; }
    }
}
#undef AS_TILE

#ifdef DBG_CHECK
__device__ __forceinline__ unsigned dbg_rand(unsigned x) { x ^= x >> 16; x *= 0x7feb352du; x ^= x >> 15; x *= 0x846ca68bu; x ^= x >> 16; return x; }
__device__ __forceinline__ bool dbg_bad(float got, float exp_, float rtol, float atol) { return !(fabsf(got - exp_) <= rtol * fabsf(exp_) + atol); }
__device__ __forceinline__ float bfr(float x) { return __uint_as_float(pk2(x, 0.f) << 16); }
__device__ __forceinline__ int dbg_row(unsigned r) { const unsigned k = r % 20u; if (k == 0) return (int)(PM + (r >> 8) % SM); if (k == 1) return (int)(((r >> 8) % PB) * PT + ((r >> 12) % 8)); if (k == 2) return (int)(((r >> 8) % PB) * PT + PT - 1 - ((r >> 12) % 8)); return (int)((r >> 5) % PM); }
__device__ __forceinline__ float dbg_rs(const Frame& F, int row, int lane) { const float* xr = xrow_in(F, 0, row); float ss = 0.f; for (int d = lane; d < DM; d += 64) ss += xr[d] * xr[d]; return 1.0f / sqrtf(wave_sum(ss) * (1.0f / DM) + EPS); }
__device__ __forceinline__ float dbg_h(const Frame& F, int row, int d, float rs) { const float* mod = WSP(float, WS_MOD) + (size_t)row_bb(row) * 6144; return bfr(xrow_in(F, 0, row)[d] * rs * FIN(I_N1G)[d] * (1.0f + mod[1024 + d]) + mod[d]); }

__device__ __forceinline__ void dbg_check_phase(Frame& F) {
    const int gw = F.bid * NWAVES + F.wave, NGW = F.G * NWAVES, lane = F.lane;
    unsigned* CNT = (unsigned*)(F.ws + WS_CTL) + 3000;
    LAS float* L = (LAS float*)(F.lds + F.wave * 16384);
#define DBG_FLAG(ch, cond) do { if (__any(cond) && lane == 0) atomicAdd(CNT + (ch), 1u); } while (0)
    for (int s = gw; s < 1536; s += NGW) {
        const unsigned r = dbg_rand(1000u + s); const int row = dbg_row(r); const float rs = dbg_rs(F, row, lane); const int kind = s % 6;
        const bool isp = row < PM; const int b = isp ? (row >> 12) : ((row - PM) >> 3), t = isp ? (row & (PT - 1)) : ((row - PM) & 7);
#define DBG_U(col, dst) do { float a_ = 0.f; for (int d_ = lane; d_ < DM; d_ += 64) a_ += dbg_h(F, row, d_, rs) * bfr(FIN(I_WIN)[(size_t)d_ * D_IN + (col)]); dst = wave_sum(a_); } while (0)
        if (kind == 0) {
            const int c = (r >> 3) % 768, j = c >> 7, k = (c >> 6) & 1, dd = c & 63; float u; DBG_U(O_NKV + c, u); bool bad = false;
            if (j < 4) bad = dbg_bad(F.out[(isp ? OUT_ROWS_P + (size_t)row * 512 : OUT_ROWS_S + (size_t)(row - PM) * 512) + c], u, 0.01f, 0.01f);
            else if (isp) { if (t >= PT - WINB) bad = dbg_bad(F.out[OUT_WIN_P + ((size_t)b * WINB + (t - (PT - WINB))) * 256 + (c - 512)], u, 0.01f, 0.01f); }
            else bad = dbg_bad(F.out[OUT_WIN_S + ((size_t)b * WINB + (WINB - ST) + t) * 256 + (c - 512)], u, 0.01f, 0.01f);
            if (isp) { if (j < 2) bad = bad || dbg_bad(bf1(WSP(bf16, WS_ACMP)[((size_t)j * CMP_ROWS_J + 32768 + (b * 2 + k) * 256 + (t >> 4)) * 1024 + (t & 15) * 64 + dd]), u, 0.01f, 0.01f);
                       else bad = bad || dbg_bad(bf1(WSP(bf16, WS_KVB)[((((size_t)(j - 2) * PB + b) * 2 + k) * PT + t) * 64 + dd]), u, 0.01f, 0.01f); }
            else if (j >= 2) bad = bad || dbg_bad(bf1(WSP(bf16, WS_KVS)[((((size_t)(j - 2) * SB + b) * 2 + k) * ST + t) * 64 + dd]), u, 0.01f, 0.01f);
            DBG_FLAG(0, bad);
        } else if (kind == 1) {
            const int gi = (r >> 3) % 24, c5 = (r >> 8) % 512, cm = (r >> 8) % 3072; float u0, u1, u2, u3; DBG_U(O_NG + gi, u0); DBG_U(O_RX + c5, u1); DBG_U(O_RGATE + c5, u2); DBG_U(O_MG + cm, u3);
            bool bad = dbg_bad(WSP(float, WS_NG)[(size_t)row * 24 + gi], 1.0f / (1.0f + expf(-u0)), 0.01f, 0.005f);
            bad = bad || dbg_bad(WSP(float, WS_RX)[(size_t)row * 512 + c5], u1, 0.01f, 0.01f);
            bad = bad || dbg_bad(bf1(WSP(bf16, WS_GG)[(size_t)row * 512 + c5]), gelu_tanh(u2), 0.02f, 0.01f);
            bad = bad || dbg_bad(bf1(WSP(bf16, WS_MGS)[(size_t)row * 3072 + cm]), 1.0f / (1.0f + expf(-u3)), 0.01f, 0.005f);
            DBG_FLAG(1, bad);
        } else if (kind == 2) {
            const int head = (r >> 13) % 4, dim = (r >> 16) % 64, c5 = (r >> 3) % 512; float x1, x2, uv, ug, uq; DBG_U(O_RQ + head * 128 + dim, x1); DBG_U(O_RQ + head * 128 + 64 + dim, x2); DBG_U(O_RV + c5, uv); DBG_U(O_RG + c5, ug); DBG_U(O_NQ + c5, uq);
            const float pos = (float)(isp ? t : PAST + t); const float ang = pos * (float)pow(10000.0, -(double)dim / 64.0); float sn, cs; sincos_acc(ang, sn, cs);
            const bf16* RQ = WSP(bf16, WS_RQ);
            bool bad = dbg_bad(bf1(RQ[(size_t)row * 512 + head * 128 + dim]), x1 * cs - x2 * sn, 0.02f, 0.02f) || dbg_bad(bf1(RQ[(size_t)row * 512 + head * 128 + 64 + dim]), x1 * sn + x2 * cs, 0.02f, 0.02f);
            bad = bad || dbg_bad(bf1(RQ[(size_t)2 * MT * 512 + (size_t)row * 512 + c5]), uv, 0.01f, 0.01f) || dbg_bad(bf1(RQ[(size_t)3 * MT * 512 + (size_t)row * 512 + c5]), ug, 0.01f, 0.01f);
            bad = bad || dbg_bad(bf1(WSP(bf16, WS_QN)[(size_t)row * 512 + c5]), uq * QSCALE, 0.01f, 0.005f);
            DBG_FLAG(2, bad);
        }
#undef DBG_U
    }
    for (int s = gw; s < 128; s += NGW) {
        const unsigned r = dbg_rand(3000u + s); const int j = r & 1; const bool smp = ((r >> 1) & 3) != 0;
        const int grp = smp ? (int)((r >> 3) % 64) : (int)((r >> 3) % 8), nmax = smp ? 511 : 255; int n = (r >> 10) % nmax; if (((r >> 20) & 7) == 0) n = nmax - 1;
        const size_t rj = smp ? (size_t)grp * 512 + n : (size_t)32768 + grp * 256 + n;
        const bf16* A = WSP(bf16, WS_ACMP) + ((size_t)j * CMP_ROWS_J + rj) * 1024;
        const float* w1 = FIN(I_W1) + (size_t)j * 2048 * 128; const float* pe = FIN(I_PE) + j * 2048;
        for (int hh = 0; hh < 2; ++hh) { const int h = lane + 64 * hh; float a = FIN(I_B1)[j * 128 + h];
            for (int i = 0; i < 1024; ++i) a += (bf1(A[i]) + pe[i]) * w1[(size_t)i * 128 + h] + (bf1(A[1024 + i]) + pe[1024 + i]) * w1[(size_t)(1024 + i) * 128 + h];
            L[h] = gelu_tanh(a); }
        LDS_WAIT(); asm volatile("" ::: "memory");
        float o = 0.f; for (int h = 0; h < 128; ++h) o += L[h] * FIN(I_W2)[((size_t)j * 128 + h) * 64 + lane];
        const float got = bf1(WSP(bf16, WS_CK)[((size_t)j * CMP_ROWS_J + rj) * 64 + lane]);
        { const bool bd = dbg_bad(got, o, 0.05f, 0.03f); const unsigned long long mk = __ballot(bd); if (lane == 0 && mk) atomicAdd(CNT + 3, (unsigned)__popcll(mk)); }
        LDS_WAIT(); asm volatile("" ::: "memory");
    }
    for (int s = gw; s < 128; s += NGW) {
        const unsigned r = dbg_rand(3500u + s); const int j = r & 1; const bool smp = ((r >> 1) & 3) != 0;
        const int grp = smp ? (int)((r >> 3) % 64) : (int)((r >> 3) % 8), nmax = smp ? 511 : 255; const int n = (r >> 10) % nmax;
        const size_t rj = smp ? (size_t)grp * 512 + n : (size_t)32768 + grp * 256 + n, row = (size_t)j * CMP_ROWS_J + rj;
        const bf16* A = WSP(bf16, WS_ACMP) + row * 1024; const float* w1 = FIN(I_W1) + (size_t)j * 2048 * 128; const bf16* LH = WSP(bf16, WS_LH);
        unsigned nb = 0;
        for (int hh = 0; hh < 2; ++hh) { const int h = lane + 64 * hh; float lo = 0.f, hi = 0.f;
            for (int i = 0; i < 1024; ++i) { const float av = bf1(A[i]); lo += av * bfr(w1[(size_t)i * 128 + h]); hi += av * bfr(w1[(size_t)(1024 + i) * 128 + h]); }
            const bool bd = dbg_bad(bf1(LH[row * 256 + h]), lo, 0.02f, 0.02f) || dbg_bad(bf1(LH[row * 256 + 128 + h]), hi, 0.02f, 0.02f); nb += (unsigned)__popcll(__ballot(bd)); }
        if (lane == 0 && nb) atomicAdd(CNT + 9, nb);
        for (int hh = 0; hh < 2; ++hh) { const int h = lane + 64 * hh; L[h] = gelu_tanh(bf1(LH[row * 256 + h]) + bf1(LH[(row + 1) * 256 + 128 + h]) + WSP(float, WS_SMALLW + SW_CB)[j * 128 + h]); }
        LDS_WAIT(); asm volatile("" ::: "memory");
        float o = 0.f; for (int h = 0; h < 128; ++h) o += bfr(L[h]) * bfr(FIN(I_W2)[((size_t)j * 128 + h) * 64 + lane]);
        { const bool bd = dbg_bad(bf1(WSP(bf16, WS_CK)[row * 64 + lane]), o, 0.03f, 0.01f); const unsigned long long mk = __ballot(bd); if (lane == 0 && mk) atomicAdd(CNT + 11, (unsigned)__popcll(mk)); }
        LDS_WAIT(); asm volatile("" ::: "memory");
    }
    for (int s = gw; s < 64; s += NGW) {
        const unsigned r = dbg_rand(3700u + s); const int j = r & 1, half = (r >> 1) & 1, h = (r >> 2) % 128; const bf16* W1T = WSP(bf16, WS_SMALLW + SW_W1T) + ((size_t)j * 256 + half * 128 + h) * 1024;
        const float* w1 = FIN(I_W1) + ((size_t)j * 32 + half * 16) * 64 * 128 + h; unsigned nb = 0;
        for (int k = lane; k < 1024; k += 64) nb += (unsigned)__popcll(__ballot(dbg_bad(bf1(W1T[k]), w1[(size_t)k * 128], 0.01f, 0.0001f)));
        if (lane == 0 && nb) atomicAdd(CNT + 12, nb);
        const bool smp = ((r >> 9) & 3) != 0; const int grp = smp ? (int)((r >> 11) % 64) : (int)((r >> 11) % 8), n = (r >> 17) % (smp ? 511 : 255);
        const size_t row = (size_t)j * CMP_ROWS_J + (smp ? (size_t)grp * 512 + n : (size_t)32768 + grp * 256 + n); const bf16* A = WSP(bf16, WS_ACMP) + row * 1024;
        float a = 0.f; for (int k = lane; k < 1024; k += 64) a += bf1(A[k]) * bf1(W1T[k]); a = wave_sum(a);
        DBG_FLAG(13, dbg_bad(bf1(WSP(bf16, WS_LH)[row * 256 + half * 128 + h]), a, 0.02f, 0.02f));
    }
    for (int s = gw; s < 4; s += NGW) {
        const int j = s >> 1, h = (s & 1) * 64 + lane; const float* w1 = FIN(I_W1) + (size_t)j * 2048 * 128; const float* pe = FIN(I_PE) + j * 2048;
        float a = FIN(I_B1)[j * 128 + h]; for (int i = 0; i < 2048; ++i) a += pe[i] * w1[(size_t)i * 128 + h];
        const unsigned long long mk = __ballot(dbg_bad(WSP(float, WS_SMALLW + SW_CB)[j * 128 + h], a, 0.001f, 0.0005f)); if (lane == 0 && mk) atomicAdd(CNT + 10, (unsigned)__popcll(mk));
    }
    for (int s = gw; s < 96; s += NGW) {
        const unsigned r = dbg_rand(4000u + s); const bool smp = (s % 3) == 2;
        int seq, kvh = (r >> 4) & 1, t, tl = 0; size_t row;
        if (smp) { seq = (r >> 5) % SB; tl = (r >> 10) % ST; t = PAST + tl; row = (size_t)PM + seq * ST + tl; }
        else { seq = (r >> 5) % PB; const unsigned k = (r >> 8) % 8u; t = (k == 0) ? (int)((r >> 12) % 40) : (k == 1) ? PT - 1 - (int)((r >> 12) % 70) : (int)((r >> 12) % PT); row = (size_t)seq * PT + t; }
        const int N = smp ? 511 : 255, NS = smp ? 129 : 64, cur = t >> 6;
        LAS float* Q = L; LAS float* SC = L + 256; LAS float* PSUM = L + 256 + 2048; LAS float* OUT = L + 256 + 2048 + 512;
        for (int i = lane; i < 256; i += 64) Q[i] = bf1(WSP(bf16, WS_QN)[row * 512 + (kvh * 4 + (i >> 6)) * 64 + (i & 63)]);
        for (int i = lane; i < 768; i += 64) OUT[i] = 0.f;
        LDS_WAIT(); asm volatile("" ::: "memory");
        const bf16* CKk = WSP(bf16, WS_CK) + (smp ? (size_t)(seq * 2 + kvh) * 512 : (size_t)32768 + (seq * 2 + kvh) * 256) * 64; const bf16* CKv = CKk + (size_t)CMP_ROWS_J * 64;
        const int nvis = smp ? 511 : ((t >= 31) ? ((t - 31) >> 4) + 1 : 0);
        for (int i = lane; i < 512; i += 64) PSUM[i] = 0.f;
        for (int hr = 0; hr < 4; ++hr) {
            float mx = -INFINITY; for (int n = lane; n < nvis; n += 64) { float a = 0.f; for (int d = 0; d < 64; ++d) a += Q[hr * 64 + d] * bf1(CKk[(size_t)n * 64 + d]); SC[n] = a; mx = fmaxf(mx, a); }
            for (int o = 1; o < 64; o <<= 1) mx = fmaxf(mx, __shfl_xor(mx, o));
            float den = 0.f; for (int n = lane; n < nvis; n += 64) { const float e = exp2f(SC[n] - mx); SC[n] = e; den += e; } den = wave_sum(den);
            LDS_WAIT(); asm volatile("" ::: "memory");
            if (nvis > 0) { float o = 0.f; for (int n = 0; n < nvis; ++n) o += SC[n] * bf1(CKv[(size_t)n * 64 + lane]); OUT[hr * 64 + lane] = o / den;
                for (int n = lane; n < nvis; n += 64) PSUM[n] += SC[n] / den; }
            LDS_WAIT(); asm volatile("" ::: "memory");
        }
        LAS float* IMP = SC; LAS float* SELB = SC + 256;
        for (int sblk = lane; sblk < NS; sblk += 64) { float imp = 0.f; for (int n = 4 * sblk - 1; n <= 4 * sblk + 3; ++n) if (n >= 0 && n < N) imp += PSUM[n];
            const bool forced = sblk == 0 || sblk == cur || sblk == cur - 1, avail = sblk * 64 <= t; IMP[sblk] = avail ? (forced ? 1e4f : imp) : -1e4f; SELB[sblk] = 0.f; }
        LDS_WAIT(); asm volatile("" ::: "memory");
        for (int pick = 0; pick < 16 && pick < NS; ++pick) { float bv = -INFINITY; int bi = 1 << 30;
            for (int sblk = lane; sblk < NS; sblk += 64) { const float v = (SELB[sblk] != 0.f) ? -INFINITY : IMP[sblk]; if (v > bv || (v == bv && sblk < bi)) { bv = v; bi = sblk; } }
            for (int o = 1; o < 64; o <<= 1) { const float ov = __shfl_xor(bv, o); const int oi = __shfl_xor(bi, o); if (ov > bv || (ov == bv && oi < bi)) { bv = ov; bi = oi; } }
            if (lane == 0) SELB[bi] = 1.f; LDS_WAIT(); asm volatile("" ::: "memory"); }
        for (int br = 1; br < 3; ++br) for (int hr = 0; hr < 4; ++hr) {
            float mx = -INFINITY, den = 0.f, o = 0.f;
            const int plo = (br == 1) ? 0 : (t - WINB < 0 ? 0 : t - WINB), phi = t;
            for (int p = plo; p <= phi; ++p) {
                if (br == 1 && SELB[p >> 6] == 0.f) { p |= 63; continue; }
                const float* kf = nullptr; const bf16* kb = nullptr; const float* vf = nullptr; const bf16* vb = nullptr;
                const int jk = (br == 1) ? 2 : 4;
                if (!smp) { kb = WSP(bf16, WS_KVB) + ((((size_t)(jk - 2) * PB + seq) * 2 + kvh) * PT + p) * 64; vb = kb + (size_t)PB * 2 * PT * 64; }
                else if (p >= PAST) { kb = WSP(bf16, WS_KVS) + ((((size_t)(jk - 2) * SB + seq) * 2 + kvh) * ST + (p - PAST)) * 64; vb = kb + (size_t)SB * 2 * ST * 64; }
                else if (br == 1) { const int page = ((const int*)F.a->in[I_PT])[seq * NPG + (p >> 7)]; kf = FIN(I_CACHE) + ((((size_t)page * PAGE + (p & 127)) * 4 + 2) * 2 + kvh) * 64; vf = kf + 128; }
                else { kf = FIN(I_CWIN) + ((((size_t)seq * WINB + (p - (PAST - WINB))) * 2 + 0) * 2 + kvh) * 64; vf = kf + 128; }
                float a = 0.f; for (int d = 0; d < 64; ++d) a += Q[hr * 64 + d] * (kb ? bf1(kb[d]) : bfr(kf[d]));
                const float vv = vb ? bf1(vb[lane]) : bfr(vf[lane]);
                const float mn = fmaxf(mx, a), al = exp2f(mx - mn), e = exp2f(a - mn); den = den * al + e; o = o * al + e * vv; mx = mn;
            }
            OUT[(br * 4 + hr) * 64 + lane] = (den > 0.f) ? o / den : 0.f;
        }
        LDS_WAIT(); asm volatile("" ::: "memory");
        bool bad = false;
        for (int hr = 0; hr < 4; ++hr) { const float* ng = WSP(float, WS_NG) + row * 24 + (kvh * 4 + hr) * 3;
            const float e = ng[0] * OUT[(0 * 4 + hr) * 64 + lane] + ng[1] * OUT[(1 * 4 + hr) * 64 + lane] + ng[2] * OUT[(2 * 4 + hr) * 64 + lane];
            bad = bad || dbg_bad(bf1(WSP(bf16, WS_OA)[row * 512 + (kvh * 4 + hr) * 64 + lane]), e, 0.04f, 0.004f); }
        DBG_FLAG(smp ? 5 : 4, bad);
        LDS_WAIT(); asm volatile("" ::: "memory");
    }
    for (int s = gw; s < 96; s += NGW) {
        const unsigned r = dbg_rand(6000u + s); const bool smp = (s % 3) == 2; const int h = (r >> 3) & 3; const float lg = ret_log_g(h);
        const bf16* RQ = WSP(bf16, WS_RQ); const bf16* RK = RQ + (size_t)MT * 512; const bf16* RV = RQ + (size_t)2 * MT * 512; const bf16* RG = RQ + (size_t)3 * MT * 512;
        int seq, t; size_t row0; if (smp) { seq = (r >> 5) % SB; t = (r >> 10) % ST; row0 = (size_t)PM + seq * ST; } else { seq = (r >> 5) % PB; const unsigned k = (r >> 8) % 4u; t = (k == 0) ? (int)((r >> 12) % 300) : (int)((r >> 12) % PT); row0 = (size_t)seq * PT; }
        float o0 = 0.f, o1 = 0.f;
        for (int d = lane; d < 128; d += 64) L[d] = bf1(RQ[(row0 + t) * 512 + h * 128 + d]);
        LDS_WAIT(); asm volatile("" ::: "memory");
        for (int j = 0; j <= t; ++j) { float a = 0.f; for (int d = 0; d < 128; ++d) a += L[d] * bf1(RK[(row0 + j) * 512 + h * 128 + d]);
            a *= expf((float)(t - j) * lg); o0 += a * bf1(RV[(row0 + j) * 512 + h * 128 + lane]); o1 += a * bf1(RV[(row0 + j) * 512 + h * 128 + 64 + lane]); }
        if (smp) { const float* S0 = FIN(I_SRET) + (((size_t)0 * SB + seq) * 4 + h) * 16384; const float cr = expf((float)(t + 1) * lg);
            for (int d = 0; d < 128; ++d) { o0 += L[d] * S0[d * 128 + lane] * cr; o1 += L[d] * S0[d * 128 + 64 + lane] * cr; } }
        const float mean = wave_sum(o0 + o1) * (1.0f / 128.0f); const float var = wave_sum((o0 - mean) * (o0 - mean) + (o1 - mean) * (o1 - mean)) * (1.0f / 128.0f), rstd = 1.0f / sqrtf(var + EPS);
        const float* GN = FIN(I_GNG) + h * 128; const bf16* OR_ = WSP(bf16, WS_OA) + (size_t)MT * 512;
        const float g0 = bf1(RG[(row0 + t) * 512 + h * 128 + lane]), g1 = bf1(RG[(row0 + t) * 512 + h * 128 + 64 + lane]);
        const float e0 = (o0 - mean) * rstd * GN[lane] * (g0 / (1.0f + expf(-g0))), e1 = (o1 - mean) * rstd * GN[64 + lane] * (g1 / (1.0f + expf(-g1)));
        DBG_FLAG(6, dbg_bad(bf1(OR_[(row0 + t) * 512 + h * 128 + lane]), e0, 0.04f, 0.02f) || dbg_bad(bf1(OR_[(row0 + t) * 512 + h * 128 + 64 + lane]), e1, 0.04f, 0.02f));
        const int d = (r >> 20) % 128, T = smp ? ST : PT; float s0 = 0.f, s1 = 0.f;
        for (int j = 0; j < T; ++j) { const float kk = bf1(RK[(row0 + j) * 512 + h * 128 + d]) * expf((float)(T - 1 - j) * lg); s0 += kk * bf1(RV[(row0 + j) * 512 + h * 128 + lane]); s1 += kk * bf1(RV[(row0 + j) * 512 + h * 128 + 64 + lane]); }
        const float* SO;
        if (smp) { const float* S0 = FIN(I_SRET) + (((size_t)0 * SB + seq) * 4 + h) * 16384; const float g8 = expf(8.0f * lg); s0 += g8 * S0[d * 128 + lane]; s1 += g8 * S0[d * 128 + 64 + lane]; SO = F.out + OUT_RET_S + (((size_t)0 * SB + seq) * 4 + h) * 16384; }
        else SO = F.out + OUT_RET_P + (((size_t)0 * PB + seq) * 4 + h) * 16384;
        DBG_FLAG(7, dbg_bad(SO[d * 128 + lane], s0, 0.02f, 0.02f) || dbg_bad(SO[d * 128 + 64 + lane], s1, 0.02f, 0.02f));
        LDS_WAIT(); asm volatile("" ::: "memory");
    }
    for (int s = gw; s < 48; s += NGW) {
        const unsigned r = dbg_rand(8000u + s); const bool smp = (s % 3) == 2; const int blk = (r >> 3) & 7, c = blk * 64 + lane;
        int seq, T; size_t row0; if (smp) { seq = (r >> 6) % SB; T = ST; row0 = (size_t)PM + seq * ST; } else { seq = (r >> 6) % PB; T = 1 + (int)((r >> 10) % ((s & 1) ? 200 : PT)); row0 = (size_t)seq * PT; }
        const float* RX = WSP(float, WS_RX); const float* cw = FIN(I_RCW); const float cb = FIN(I_RCB)[c];
        float x3 = 0.f, x2 = 0.f, x1 = 0.f, h = 0.f;
        if (smp) { const float* cv = FIN(I_SCONV) + (size_t)seq * 3 * 512; x3 = cv[c]; x2 = cv[512 + c]; x1 = cv[1024 + c]; h = FIN(I_SH)[(size_t)seq * 512 + c]; }
        const float sp = log1pf(expf(-FIN(I_LAM)[c])); const float* wa = FIN(I_RWA) + (size_t)blk * 4096; const float* wx = FIN(I_RWX) + (size_t)blk * 4096;
        for (int t = 0; t < T; ++t) { const float x0 = RX[(row0 + t) * 512 + c]; const float xc = cb + cw[c] * x3 + cw[512 + c] * x2 + cw[1024 + c] * x1 + cw[1536 + c] * x0; x3 = x2; x2 = x1; x1 = x0;
            L[lane] = xc; LDS_WAIT(); asm volatile("" ::: "memory");
            float ra = FIN(I_RBA)[c], ri = FIN(I_RBX)[c]; for (int i = 0; i < 64; ++i) { ra += L[i] * wa[i * 64 + lane]; ri += L[i] * wx[i * 64 + lane]; }
            LDS_WAIT(); asm volatile("" ::: "memory");
            const float rr = 1.0f / (1.0f + expf(-ra)), ii = 1.0f / (1.0f + expf(-ri)), la = -8.0f * rr * sp, a = expf(la); h = a * h + sqrtf(-expm1f(2.0f * la)) * (ii * xc); }
        const size_t o = (row0 + T - 1) * 512 + c; const float e = h * bf1(WSP(bf16, WS_GG)[o]);
        DBG_FLAG(8, dbg_bad(bf1((WSP(bf16, WS_OA) + (size_t)2 * MT * 512)[o]), e, 0.04f, 0.01f));
    }
    for (int s = gw; s < 512; s += NGW) {
        const unsigned r = dbg_rand(9000u + s); const int row = dbg_row(r), col = (r >> 7) % DM;
        float e = 0.f;
        for (int br = 0; br < 3; ++br) { const bf16* O = WSP(bf16, WS_OA) + (size_t)br * MT * 512 + (size_t)row * 512; const float* W = FIN(br == 0 ? I_WBRA : (br == 1 ? I_WBRB : I_WBRC));
            float a = 0.f; for (int k = lane; k < 512; k += 64) a += bf1(O[k]) * bfr(W[(size_t)k * DM + col]); a = wave_sum(a); e += bf1(WSP(bf16, WS_MGS)[(size_t)row * 3072 + br * 1024 + col]) * a; }
        DBG_FLAG(20, dbg_bad(bf1(WSP(bf16, WS_MRG)[(size_t)row * DM + col]), e, 0.03f, 0.01f));
        const float* mod = WSP(float, WS_MOD) + (size_t)row_bb(row) * 6144;
        { float a = 0.f; for (int k = lane; k < DM; k += 64) a += bf1(WSP(bf16, WS_MRG)[(size_t)row * DM + k]) * bfr(FIN(I_WOUT)[(size_t)k * DM + col]); a = wave_sum(a);
          const float ex = xrow_in(F, 0, row)[col] + mod[2048 + col] * a; DBG_FLAG(21, dbg_bad(WSP(float, WS_X1)[(size_t)row * DM + col], ex, 0.005f, 0.005f)); }
        { const float* xr = WSP(float, WS_X1) + (size_t)row * DM; float ss = 0.f; for (int d = lane; d < DM; d += 64) ss += xr[d] * xr[d]; const float rs = 1.0f / sqrtf(wave_sum(ss) * (1.0f / DM) + EPS);
          const int c2 = (r >> 9) % NUP; float a = 0.f; for (int d = lane; d < DM; d += 64) a += bfr(xr[d] * rs * FIN(I_N2G)[d] * (1.0f + mod[4096 + d]) + mod[3072 + d]) * bfr(FIN(I_WUP)[(size_t)d * NUP + c2]); a = wave_sum(a);
          const float got = c2 < DFF ? bf1(WSP(bf16, WS_GP)[(size_t)row * DFF + c2]) : bf1((WSP(bf16, WS_GP) + (size_t)MT * DFF)[(size_t)row * DFF + c2 - DFF]); DBG_FLAG(22, dbg_bad(got, a, 0.02f, 0.01f)); }
        { const int c3 = (r >> 11) % DFF; const bf16* GP = WSP(bf16, WS_GP); const bf16* VAL = GP + (size_t)MT * DFF; const float* cw = FIN(I_FCW);
          const bool isp = row < PM; const int t = isp ? (row & (PT - 1)) : ((row - PM) & 7); float xm2, xm1;
          if (t >= 2) { xm2 = bf1(GP[(size_t)(row - 2) * DFF + c3]); xm1 = bf1(GP[(size_t)(row - 1) * DFF + c3]); }
          else if (isp) { xm2 = 0.f; xm1 = (t == 1) ? bf1(GP[(size_t)(row - 1) * DFF + c3]) : 0.f; }
          else { const float* st = FIN(I_SFFN) + ((size_t)((row - PM) >> 3) * 2) * DFF + c3; xm2 = (t == 0) ? st[0] : st[DFF]; xm1 = (t == 0) ? st[DFF] : bf1(GP[(size_t)(row - 1) * DFF + c3]); }
          const float y = FIN(I_FCB)[c3] + cw[c3] * xm2 + cw[DFF + c3] * xm1 + cw[2 * DFF + c3] * bf1(GP[(size_t)row * DFF + c3]); const float ex = (y / (1.0f + expf(-y))) * bf1(VAL[(size_t)row * DFF + c3]);
          DBG_FLAG(23, dbg_bad(bf1((GP + (size_t)2 * MT * DFF)[(size_t)row * DFF + c3]), ex, 0.02f, 0.005f)); }
        { const bf16* ACT = WSP(bf16, WS_GP) + (size_t)2 * MT * DFF + (size_t)row * DFF; float a = 0.f; for (int k = lane; k < DFF; k += 64) a += bf1(ACT[k]) * bfr(FIN(I_WDN)[(size_t)k * DM + col]); a = wave_sum(a);
          const float ex = WSP(float, WS_X1)[(size_t)row * DM + col] + mod[5120 + col] * a; DBG_FLAG(24, dbg_bad(WSP(float, WS_X2)[(size_t)row * DM + col], ex, 0.005f, 0.005f)); }
    }
#undef DBG_FLAG
}
__device__ __forceinline__ void dbg_report_phase(Frame& F) {
    const unsigned* CNT = (const unsigned*)(F.ws + WS_CTL) + 3000;
    const size_t ooff[14] = {OUT_Y, OUT_Y + (size_t)PM * DM, OUT_ROWS_P, OUT_ROWS_S, OUT_WIN_P, OUT_WIN_S, OUT_RET_P, OUT_RET_S, OUT_H_P, OUT_H_S, OUT_CV_P, OUT_CV_S, OUT_FC_P, OUT_FC_S};
    if (F.bid == 0 && F.tid < 14) { const int b = F.tid; const unsigned c = CNT[b]; const int cnt = 1 + (int)(c > 1000u ? 1000u : c);
        for (int i = 0; i < cnt; ++i) ((unsigned*)F.out)[ooff[b] + 7 + 2 * i] = 0xAAAAAAAAu; }
}
#endif

#ifndef DBG_SUB
#define DBG_SUB 0xFFFF
#endif
#ifndef DBG_MAXPH
#define DBG_MAXPH N_PHASES
#endif
#ifndef DBG_REPEAT
#define DBG_REPEAT 0
#endif
#ifndef DBG_MASK
#define DBG_MASK 0xFFFF
#endif
#define IN(k) (lo <= (k) && (k) < hi)
#ifdef DBG_TIME
#define SEAM(k) do { if ((k) + 1 < hi) { if (MK_N_LAUNCHES == 1) xcd_barrier(bar); } if (F.bid == 0 && F.tid == 0) ((unsigned long long*)(F.ws + WS_CTL))[2048 + (k) + 1] = __builtin_amdgcn_s_memrealtime(); } while (0)
#else
#define SEAM(k) do { if ((k) + 1 < hi) { if (MK_N_LAUNCHES == 1) xcd_barrier(bar); } } while (0)
#endif
template <int l> __device__ __forceinline__ void ph_win(Frame& F) { unsigned char* ws = F.ws;
    pg8::Gemm g{(const pg8::bf16_t*)(ws + WS_H), (const pg8::bf16_t*)(ws + WS_WIN) + (size_t)l * NIN * DM, MT, NIN, DM};
    pg8::StaticOrder S; S.init(MT, NIN, F.G, F.bid); EpiWin E{ws, F.out, l};
    pg8::gemm_phase<EpiWin, pg8::StaticOrder, true, true>(F.lds, g, S, E); }
template <int l> __device__ __forceinline__ void ph_mix1(Frame& F) {
    for (int x = F.bid; x < 512; x += F.G) { launder(F); cmp_gemm_unit<true>(F, l, x >> 8, (x & 255) >> 2, (x & 3) * 128); }
    {
        unsigned* ctr = (unsigned*)(F.ws + WS_CTL) + 3210 + l; volatile LAS int* QI = (volatile LAS int*)(F.lds + MISC_OFF + 128);
#pragma unroll 1
        for (;;) {
            __syncthreads();
            if (F.tid == 0) QI[0] = (int)__hip_atomic_fetch_add(ctr, 1u, __ATOMIC_RELAXED, __HIP_MEMORY_SCOPE_AGENT);
            __syncthreads();
            const int u = __builtin_amdgcn_readfirstlane(QI[0]);
            if (u >= 32 + 768) break;
            launder(F);
            if (u < 32) cmp_gemm_unit<false>(F, l, u >> 4, (u >> 1) & 7, (u & 1) * 128); else if (u < 32 + 256) rglru_unit<0>(F, l, u - 32); else ret_local_unit(F, u - 32 - 256);
        }
        __syncthreads();
    } }
template <int l> __device__ __forceinline__ void ph_mix2(Frame& F) { cmp2_phase(F, l); ret_scan_phase(F, l); rglru_carry_phase(F, l); }
#ifndef DBG_REPQ
#define DBG_REPQ 0
#endif
constexpr int MQ_SA = 64, MQ_PA = MQ_SA + 512, MQ_RG1 = MQ_PA + 256, MQ_RO = MQ_RG1 + 512, MQ_RS = MQ_RO + 128, MQ_RG2 = MQ_RS + 32;
template <int l> __device__ __forceinline__ void ph_mix3(Frame& F) {
    unsigned* ctr = (unsigned*)(F.ws + WS_CTL) + 3200 + l;
    volatile LAS int* QI = (volatile LAS int*)(F.lds + MISC_OFF + 128);
#pragma unroll 1
    for (;;) {
        __syncthreads();
        if (F.tid == 0) QI[0] = (int)__hip_atomic_fetch_add(ctr, 1u, __ATOMIC_RELAXED, __HIP_MEMORY_SCOPE_AGENT);
        __syncthreads();
        const int u = __builtin_amdgcn_readfirstlane(QI[0]);
        if (u >= MQ_RG2) break;
        launder(F);
        if (u < MQ_SA) { attn_sample_unit(F, l, u); if (DBG_REPQ & 2) { launder(F); attn_sample_unit(F, l, u); } }
        else if (u < MQ_PA) { const int v = u - MQ_SA; attn_prompt_unit(F, l, (v & 7) * 64 + 63 - (v >> 3)); if (DBG_REPQ & 1) { launder(F); attn_prompt_unit(F, l, (v & 7) * 64 + 63 - (v >> 3)); } }
        else if (u < MQ_RG1) { rglru_unit<1>(F, l, u - MQ_PA); }
        else if (u < MQ_RO) { ret_out_unit(F, l, u - MQ_RG1); }
        else if (u < MQ_RS) { ret_sample_unit(F, l, u - MQ_RO); }
        else { rglru_unit<2>(F, l, u - MQ_RS); }
    }
    __syncthreads(); }
__device__ __forceinline__ f32x16 smp_tile_acc(Frame& F, const bf16* A, const bf16* Wt, int K, int tile) {
    const int q = F.lane & 31, h_ = F.lane >> 5, ks8 = K / 8, kb = F.wave * ks8;
    const bf16* ap = A + (size_t)((tile >> 5) * 32 + q) * K + kb + 8 * h_; const bf16* bp = Wt + (size_t)((tile & 31) * 32 + q) * K + kb + 8 * h_; f32x16 acc = (f32x16){};
#pragma unroll 11
    for (int kk = 0; kk < ks8 / 16; ++kk) acc = mfma32(*(const bf16x8*)(ap + 16 * kk), *(const bf16x8*)(bp + 16 * kk), acc);
    return acc;
}
__device__ __forceinline__ void smp_tile_put(Frame& F, const f32x16& acc, int slot) { LAS float* R = (LAS float*)(F.lds + slot * 32768) + F.wave * 1024 + F.lane;
#pragma unroll
    for (int r = 0; r < 16; ++r) R[r * 64] = acc[r]; }
__device__ __forceinline__ float smp_tile_get(Frame& F, int slot, int o) { const LAS float* R = (const LAS float*)(F.lds + slot * 32768) + o; float s = 0.f;
#pragma unroll
    for (int w = 0; w < 8; ++w) s += R[w * 1024];
    return s; }
template <int l> __device__ __forceinline__ void ph_br(Frame& F) { unsigned char* ws = F.ws;
    const pg8::bf16_t* wbr = (const pg8::bf16_t*)(ws + WS_WBR) + (size_t)l * 3 * 1024 * 512;
    for (int tile = F.bid; tile < 256; tile += F.G) {
        const f32x16 a0 = smp_tile_acc(F, (const bf16*)(ws + WS_OA) + (size_t)PM * 512, wbr, 512, tile), a1 = smp_tile_acc(F, (const bf16*)(ws + WS_OA) + (size_t)(MT + PM) * 512, wbr + (size_t)1024 * 512, 512, tile),
                     a2 = smp_tile_acc(F, (const bf16*)(ws + WS_OA) + (size_t)(2 * MT + PM) * 512, wbr + (size_t)2 * 1024 * 512, 512, tile);
        __syncthreads(); smp_tile_put(F, a0, 0); smp_tile_put(F, a1, 1); smp_tile_put(F, a2, 2); __syncthreads();
        const bf16* MG = (const bf16*)(ws + WS_MGS); bf16* MR = (bf16*)(ws + WS_MRG);
#pragma unroll
        for (int e = 0; e < 2; ++e) { const int o = F.tid * 2 + e, r = o >> 6, ln = o & 63; const size_t row = (size_t)PM + (tile >> 5) * 32 + (r & 3) + 8 * (r >> 2) + 4 * (ln >> 5); const int col = (tile & 31) * 32 + (ln & 31);
            const bf16* g = MG + row * 3072 + col; MR[row * DM + col] = (bf16)(pk2(bf1(g[0]) * smp_tile_get(F, 0, o) + bf1(g[1024]) * smp_tile_get(F, 1, o) + bf1(g[2048]) * smp_tile_get(F, 2, o), 0.f) & 0xffffu); }
    }
    __syncthreads();
    BrOrder S; S.S.init(PM, DM, F.G, F.bid);
    pg8::Gemm g{(const pg8::bf16_t*)(ws + WS_OA), wbr, 3 * MT, 3 * DM, 512}; EpiBrAll E{ws};
    pg8::gemm_phase<EpiBrAll, BrOrder, true, true>(F.lds, g, S, E); }
template <bool INF32> __device__ __forceinline__ void smp_res(Frame& F, const bf16* A, const bf16* Wt, int K, const void* xin  , bf16* xout  , const float* mod, int gofs) {
    for (int tile = F.bid; tile < 256; tile += F.G) {
        const f32x16 a = smp_tile_acc(F, A, Wt, K, tile);
        __syncthreads(); smp_tile_put(F, a, 0); __syncthreads();
#pragma unroll
        for (int e = 0; e < 2; ++e) { const int o = F.tid * 2 + e, r = o >> 6, ln = o & 63; const int rr = (tile >> 5) * 32 + (r & 3) + 8 * (r >> 2) + 4 * (ln >> 5), col = (tile & 31) * 32 + (ln & 31);
            const float xi = INF32 ? ((const float*)xin)[(size_t)rr * DM + col] : bf1(((const bf16*)xin)[(size_t)rr * DM + col]);
            xout[(size_t)rr * DM + col] = (bf16)(pk2(xi + mod[(size_t)(4 + (rr >> 3)) * 6144 + gofs + col] * smp_tile_get(F, 0, o), 0.f) & 0xffffu); }
    }
    __syncthreads();
}
template <int l> __device__ __forceinline__ void ph_out(Frame& F) { unsigned char* ws = F.ws;
    const float* mod = (const float*)(ws + WS_MOD) + (size_t)l * 36 * 6144;
    smp_res<l == 0>(F, (const bf16*)(ws + WS_MRG) + (size_t)PM * DM, (const bf16*)(ws + WS_WOUT) + (size_t)l * DM * DM, DM, l == 0 ? (const void*)FIN(I_XS) : (const void*)((const bf16*)(ws + WS_X2) + (size_t)PM * DM), (bf16*)(ws + WS_X1) + (size_t)PM * DM, mod, 2048);
    pg8::Gemm g{(const pg8::bf16_t*)(ws + WS_MRG), (const pg8::bf16_t*)(ws + WS_WOUT) + (size_t)l * DM * DM, PM, DM, DM};
    pg8::StaticOrder S; S.init(PM, DM, F.G, F.bid);
    EpiRes<l == 0> E{l == 0 ? (const void*)FIN(I_XP) : (const void*)(ws + WS_X2), (bf16*)(ws + WS_X1), mod, 2048};
    pg8::gemm_phase<EpiRes<l == 0>, pg8::StaticOrder, true, true>(F.lds, g, S, E); }
template <int l> __device__ __forceinline__ void ph_down(Frame& F) { unsigned char* ws = F.ws;
    const float* mod = (const float*)(ws + WS_MOD) + (size_t)l * 36 * 6144;
    smp_res<false>(F, (const bf16*)(ws + WS_GP) + (size_t)2 * MT * DFF + (size_t)PM * DFF, (const bf16*)(ws + WS_WDN) + (size_t)l * DM * DFF, DFF, (const void*)((const bf16*)(ws + WS_X1) + (size_t)PM * DM), (bf16*)(ws + WS_X2) + (size_t)PM * DM, mod, 5120);
    pg8::Gemm g{(const pg8::bf16_t*)(ws + WS_GP) + (size_t)2 * MT * DFF, (const pg8::bf16_t*)(ws + WS_WDN) + (size_t)l * DM * DFF, PM, DM, DFF};
    pg8::StaticOrder S; S.init(PM, DM, F.G, F.bid);
    EpiRes<false> E{(const void*)(ws + WS_X1), (bf16*)(ws + WS_X2), mod, 5120};
    pg8::gemm_phase<EpiRes<false>, pg8::StaticOrder, true, true>(F.lds, g, S, E); }
template <int l> __device__ __forceinline__ void ph_up(Frame& F) { unsigned char* ws = F.ws;
    pg8::Gemm g{(const pg8::bf16_t*)(ws + WS_H), (const pg8::bf16_t*)(ws + WS_WUP) + (size_t)l * NUP * DM, MT, NUP, DM};
    UpOrder S; S.S.init(MT, DFF, F.G, F.bid); EpiUp E{ws, F.out, l, FIN(I_FCW) + (size_t)l * 3 * DFF, FIN(I_FCB) + (size_t)l * DFF};
    pg8::gemm_phase<EpiUp, UpOrder, true, true>(F.lds, g, S, E); }
#ifdef DBG_AMP_BIT
#define AMP_T0(bit) unsigned long long amp_t0_ = 0ull; if ((bit) == DBG_AMP_BIT) amp_t0_ = __builtin_amdgcn_s_memrealtime();
#define AMP_T1(bit) if ((bit) == DBG_AMP_BIT && F.tid == 0) { volatile LAS unsigned* AM = (volatile LAS unsigned*)(F.lds + MISC_OFF + 192); AM[0] += (unsigned)(__builtin_amdgcn_s_memrealtime() - amp_t0_); }
#else
#define AMP_T0(bit)
#define AMP_T1(bit)
#endif
#define RUNPH(bit, ph, CALL) do { if (((DBG_MASK >> (bit)) & 1) && IN(ph)) { AMP_T0(bit) launder(F); CALL; if ((DBG_REPEAT >> (bit)) & 1) { launder(F); CALL; } SEAM(ph); AMP_T1(bit) } } while (0)
template <int l> __device__ __forceinline__ void layer_phases(Frame& F, const XcdBarrier& bar, int lo, int hi) {
    constexpr int pb = PH_L0 + l * PH_PER_LAYER;
    RUNPH(1, pb + LP_N1, norm_phase(F, l, 0));
    RUNPH(2, pb + LP_WIN, ph_win<l>(F));
    RUNPH(3, pb + LP_MIX1, ph_mix1<l>(F));
    RUNPH(4, pb + LP_MIX2, ph_mix2<l>(F));
    RUNPH(5, pb + LP_MIX3, ph_mix3<l>(F));
    RUNPH(6, pb + LP_BR, ph_br<l>(F));
    RUNPH(7, pb + LP_OUT, ph_out<l>(F));
    RUNPH(8, pb + LP_N2, norm_phase(F, l, 1));
    RUNPH(9, pb + LP_UP, ph_up<l>(F));
    RUNPH(10, pb + LP_CONV, convact_phase(F, l));
    RUNPH(11, pb + LP_DOWN, ph_down<l>(F));
}
__global__ void __launch_bounds__(NTHR, 2) trunk_fwd(Args args) {
    extern __shared__ __attribute__((aligned(16))) unsigned char lds_raw[];
    Frame F;
    F.lds = (LAS unsigned char*)lds_raw;
    F.tid = threadIdx.x; F.lane = F.tid & 63; F.wave = __builtin_amdgcn_readfirstlane(F.tid >> 6);
    F.G = gridDim.x; F.bid = blockIdx.x; F.a = &args; F.ws = args.ws; F.out = args.out;
    volatile LAS unsigned* MISC = (volatile LAS unsigned*)(F.lds + MISC_OFF);
    for (int u = F.tid; u < 64; u += NTHR) MISC[u] = 0u;
    __syncthreads();
    unsigned* barw = (unsigned*)(F.ws + WS_CTL) + CW_BAR;
    XcdBarrier bar; bar.bar = barw; bar.x = 0; bar.st = nullptr;
    if (MK_N_LAUNCHES == 1) bar = xcd_barrier_post(barw, MISC + 8);
    const int lo = args.ph_lo, hi = args.ph_hi;
    unsigned char* ws = F.ws;

#ifdef DBG_TIME
    if (F.bid == 0 && F.tid == 0) ((unsigned long long*)(F.ws + WS_CTL))[2048] = __builtin_amdgcn_s_memrealtime();
#endif
    RUNPH(0, PH_P0, p0_prologue(F));

    layer_phases<0>(F, bar, lo, hi);
    layer_phases<1>(F, bar, lo, hi);
    if (((DBG_MASK >> 12) & 1) && IN(PH_FINAL)) { launder(F); final_phase(F); if ((DBG_REPEAT >> 12) & 1) { launder(F); final_phase(F); } }
#ifdef DBG_AMP_BIT
    if (F.tid == 0) { volatile LAS unsigned* AM = (volatile LAS unsigned*)(F.lds + MISC_OFF + 192); const unsigned long long tot = (unsigned long long)AM[0] * DBG_AMP, ts = __builtin_amdgcn_s_memrealtime();
        while (__builtin_amdgcn_s_memrealtime() - ts < tot) __builtin_amdgcn_s_sleep(8); }
    __syncthreads();
#endif
#ifdef DBG_TIME
    {
        xcd_barrier(bar);
        if (F.bid == 0 && F.tid < 14) {
            const unsigned long long* ts = (const unsigned long long*)(F.ws + WS_CTL) + 2048; const unsigned long long tend = __builtin_amdgcn_s_memrealtime();
            const size_t ooff[14] = {OUT_Y, OUT_Y + (size_t)PM * DM, OUT_ROWS_P, OUT_ROWS_S, OUT_WIN_P, OUT_WIN_S, OUT_RET_P, OUT_RET_S, OUT_H_P, OUT_H_S, OUT_CV_P, OUT_CV_S, OUT_FC_P, OUT_FC_S};
            const int b = F.tid; unsigned long long d;
            if (b == 0) d = tend - ts[0]; else if (b == 1) d = ts[1] - ts[0]; else if (b == 13) d = tend - ts[PH_FINAL];
            else { const int ph = PH_L0 + DBG_TIME_LAYER * PH_PER_LAYER + (b - 2); d = ts[ph + 1] - ts[ph]; }
            int cnt = (int)(d / 100ull); if (cnt < 1) cnt = 1; if (cnt > 2000 && b != 0) cnt = 2000;
            for (int i = 0; i < cnt; ++i) ((unsigned*)F.out)[ooff[b] + 7 + 2 * i] = 0xAAAAAAAAu;
        }
    }
#endif
#ifdef DBG_COUNT
    {
        xcd_barrier(bar);
        if (F.bid == 0 && F.tid < 3) { const unsigned* CNT = (const unsigned*)(F.ws + WS_CTL) + 3000; const size_t ooff[3] = {OUT_Y, OUT_Y + (size_t)PM * DM, OUT_ROWS_P};
            const int cnt = (int)((unsigned long long)CNT[F.tid] * 10ull / (CNT[3] ? CNT[3] : 1u)); for (int i = 0; i < cnt; ++i) ((unsigned*)F.out)[ooff[F.tid] + 7 + 2 * i] = 0xAAAAAAAAu; }
    }
#endif
#ifdef DBG_CHECK
    if (lo == 100) { launder(F); dbg_check_phase(F); }
    if (lo == 101) { for (size_t i = (size_t)F.bid * NTHR + F.tid; i < OUT_END; i += (size_t)F.G * NTHR) F.out[i] = 0.f; }
    if (lo == 102) { launder(F); dbg_report_phase(F); }
#endif
}

extern "C" void kernel_launch(void* const* d_in, const int* in_sizes, int n_in, void* d_out, int out_size, void* d_ws, size_t ws_size, hipStream_t stream) {
    static int grid = 0;
    if (grid == 0) {
        if (n_in != 37 || (size_t)out_size != OUT_END || ws_size < WS_END) { fprintf(stderr, "kernel_launch: unexpected shapes: n_in %d out %d (want %zu) ws %zu (want %zu)\n", n_in, out_size, (size_t)OUT_END, ws_size, (size_t)WS_END); grid = -1; return; }
        int dev = 0, cus = 0, per_cu = 0;
        if (hipGetDevice(&dev) != hipSuccess || hipDeviceGetAttribute(&cus, hipDeviceAttributeMultiprocessorCount, dev) != hipSuccess) { grid = -1; return; }
        if (hipFuncSetAttribute((const void*)trunk_fwd, hipFuncAttributeMaxDynamicSharedMemorySize, LDS_BYTES) != hipSuccess) { fprintf(stderr, "kernel_launch: hipFuncSetAttribute failed\n"); grid = -1; return; }
        if (hipOccupancyMaxActiveBlocksPerMultiprocessor(&per_cu, (const void*)trunk_fwd, NTHR, LDS_BYTES) != hipSuccess || per_cu < 1) fprintf(stderr, "kernel_launch: occupancy query reports %d\n", per_cu);
        (void)hipGetLastError();
        grid = cus;
    }
    if (grid < 0) return;
    if (hipMemsetAsync((char*)d_ws + WS_CTL, 0, CTL_ZERO_BYTES, stream) != hipSuccess) return;
#ifdef DBG_POISON
    (void)hipMemsetAsync((char*)d_ws + CTL_ZERO_BYTES, 0xAA, WS_END - CTL_ZERO_BYTES, stream);
    (void)hipMemsetAsync(d_out, 0xAA, (size_t)OUT_END * 4, stream);
#endif
    Args a{};
    for (int i = 0; i < 37; ++i) a.in[i] = d_in[i];
    a.out = (float*)d_out; a.ws = (unsigned char*)d_ws;
#if MK_N_LAUNCHES == 1
    a.ph_lo = 0; a.ph_hi = N_PHASES;
    hipLaunchKernelGGL(trunk_fwd, dim3(grid), dim3(NTHR), LDS_BYTES, stream, a);
#else
    for (int p = 0; p < DBG_MAXPH; ++p) { a.ph_lo = p; a.ph_hi = p + 1; hipLaunchKernelGGL(trunk_fwd, dim3(grid), dim3(NTHR), LDS_BYTES, stream, a); }
#ifdef DBG_CHECK
    for (int p = 100; p < 103; ++p) { a.ph_lo = p; a.ph_hi = p + 1; hipLaunchKernelGGL(trunk_fwd, dim3(grid), dim3(NTHR), LDS_BYTES, stream, a); }
#endif
#endif
    (void)in_sizes;
}
```

```cpp
#include <hip/hip_runtime.h>
#include <cstdio>
#include <cstdint>

#ifndef MK_N_LAUNCHES
#define MK_N_LAUNCHES 1
#endif

constexpr int DM = 1024, PB = 4, PT = 4096, PM = PB * PT, SB = 32, ST = 8, SM = SB * ST, MT = PM + SM;
constexpr int DEPTH = 2, PAST = 8192, PAGE = 128, NPG = PAST / PAGE, NPHYS = 2560;
constexpr int D_IN = 7448, NIN = 7680, DFF = 2816, NUP = 2 * DFF;
constexpr int WINB = 512;
constexpr float EPS = 1e-6f;
constexpr float QSCALE = 0.125f * 1.4426950408889634f;

constexpr int O_NQ = 0, O_NKV = 512, O_NG = 1280, O_RQ = 1304, O_RK = 1816, O_RV = 2328, O_RG = 2840, O_RX = 3352, O_RGATE = 3864, O_MG = 4376;

constexpr size_t OUT_Y = 0;
constexpr size_t OUT_ROWS_P = OUT_Y + (size_t)MT * DM;
constexpr size_t OUT_ROWS_S = OUT_ROWS_P + (size_t)DEPTH * PM * 512;
constexpr size_t OUT_WIN_P = OUT_ROWS_S + (size_t)DEPTH * SM * 512;
constexpr size_t OUT_WIN_S = OUT_WIN_P + (size_t)DEPTH * PB * WINB * 256;
constexpr size_t OUT_RET_P = OUT_WIN_S + (size_t)DEPTH * SB * WINB * 256;
constexpr size_t OUT_RET_S = OUT_RET_P + (size_t)DEPTH * PB * 4 * 16384;
constexpr size_t OUT_H_P = OUT_RET_S + (size_t)DEPTH * SB * 4 * 16384;
constexpr size_t OUT_H_S = OUT_H_P + (size_t)DEPTH * PB * 512;
constexpr size_t OUT_CV_P = OUT_H_S + (size_t)DEPTH * SB * 512;
constexpr size_t OUT_CV_S = OUT_CV_P + (size_t)DEPTH * PB * 3 * 512;
constexpr size_t OUT_FC_P = OUT_CV_S + (size_t)DEPTH * SB * 3 * 512;
constexpr size_t OUT_FC_S = OUT_FC_P + (size_t)DEPTH * PB * 2 * DFF;
constexpr size_t OUT_END = OUT_FC_S + (size_t)DEPTH * SB * 2 * DFF;

constexpr size_t MiB = 1u << 20;
constexpr size_t WS_CTL = 0, CTL_ZERO_BYTES = 4 * MiB;
constexpr size_t WS_MOD = 1 * MiB;
constexpr size_t WS_ROT = 4 * MiB;
constexpr size_t WS_SMALLW = 8 * MiB;
constexpr size_t WS_SFB = 12 * MiB;
constexpr size_t WS_WIN = 16 * MiB;
constexpr size_t WS_WBR = WS_WIN + (size_t)2 * NIN * DM * 2;
constexpr size_t WS_WOUT = WS_WBR + (size_t)2 * 3 * 1024 * 512 * 2;
constexpr size_t WS_WUP = WS_WOUT + (size_t)2 * 1024 * 1024 * 2;
constexpr size_t WS_WDN = WS_WUP + (size_t)2 * NUP * DM * 2;
constexpr size_t WS_WEND = WS_WDN + (size_t)2 * DM * DFF * 2;
constexpr size_t WS_H = 128 * MiB;
constexpr size_t WS_QN = WS_H + (size_t)MT * DM * 2;
constexpr size_t WS_KVB = WS_QN + (size_t)MT * 512 * 2;
constexpr size_t WS_KVS = WS_KVB + (size_t)4 * PB * 2 * PT * 64 * 2;
constexpr size_t WS_RQ = WS_KVS + (size_t)4 * SB * 2 * ST * 64 * 2;
constexpr size_t WS_RX = WS_RQ + (size_t)4 * MT * 512 * 2;
constexpr size_t WS_GG = WS_RX + (size_t)MT * 512 * 4;
constexpr size_t WS_MGS = WS_GG + (size_t)MT * 512 * 2;
constexpr size_t WS_NG = WS_MGS + (size_t)MT * 3072 * 2;
constexpr size_t WS_OA = WS_NG + (size_t)MT * 24 * 4;
constexpr size_t WS_MRG = WS_OA + (size_t)3 * MT * 512 * 2;
constexpr size_t WS_X1 = WS_MRG + (size_t)MT * DM * 2;
constexpr size_t WS_X2 = WS_X1 + (size_t)MT * DM * 4;
constexpr size_t WS_GP = WS_X2 + (size_t)MT * DM * 4;
constexpr size_t WS_ACMP = WS_GP + (size_t)3 * MT * DFF * 2;
constexpr int CMP_ROWS_J = 34816, CMP_ROWS = 2 * CMP_ROWS_J;
constexpr size_t WS_LH = WS_ACMP + (size_t)2 * CMP_ROWS * 1024 * 2 + 4096;
constexpr size_t WS_CK = WS_LH + (size_t)(CMP_ROWS + 16) * 256 * 2;
constexpr size_t WS_LT = WS_CK + (size_t)CMP_ROWS * 64 * 2;
constexpr size_t WS_SPT = WS_LT + (size_t)16 * 32 * 16384 * 4;
constexpr size_t WS_CAR = WS_SPT + (size_t)16 * 32 * 16384 * 2;
constexpr size_t WS_OAG = WS_CAR + (size_t)4 * 64 * 3 * 512 * 4 + MiB;
constexpr size_t WS_END = WS_OAG + (size_t)2048 * 32 * 64 * 4 + MiB;
static_assert(WS_WEND <= WS_H, "weights fit below WS_H");

constexpr size_t SW_W1T = 0;
constexpr size_t SW_W2T = SW_W1T + (size_t)2 * 2 * 256 * 1024 * 2;
constexpr size_t SW_CB = SW_W2T + (size_t)2 * 2 * 64 * 128 * 2;
constexpr size_t SW_WAT = SW_CB + (size_t)2 * 2 * 128 * 4;
constexpr size_t SW_SP = SW_WAT + (size_t)2 * 2 * 8 * 64 * 64 * 2;
constexpr size_t SW_END = SW_SP + 2 * 512 * 4;
static_assert(SW_END <= 8 * MiB, "small weights fit");

constexpr int CW_TMO = 0;
constexpr int CW_BAR = 4096;

constexpr int PH_P0 = 0, PH_L0 = 1, PH_PER_LAYER = 11, PH_FINAL = PH_L0 + DEPTH * PH_PER_LAYER, N_PHASES = PH_FINAL + 1;
enum { LP_N1 = 0, LP_WIN, LP_MIX1, LP_MIX2, LP_MIX3, LP_BR, LP_OUT, LP_N2, LP_UP, LP_CONV, LP_DOWN };

constexpr int RING_BYTES = 131072;
constexpr int MISC_OFF = RING_BYTES;
constexpr int LDS_BYTES = RING_BYTES + 1024;
constexpr int NWAVES = 8, NTHR = 512;

#define GAS __attribute__((address_space(1)))
#define LAS __attribute__((address_space(3)))
typedef unsigned short bf16;
typedef unsigned v4u __attribute__((ext_vector_type(4)));
typedef unsigned v2u __attribute__((ext_vector_type(2)));
typedef float f32x16 __attribute__((ext_vector_type(16)));
typedef short s16x4 __attribute__((ext_vector_type(4)));
namespace pg8 {
#define PG8_LAS __attribute__((address_space(3)))
typedef unsigned short bf16_t;
typedef short bf16x8 __attribute__((ext_vector_type(8)));
typedef float f32x4 __attribute__((ext_vector_type(4)));
typedef unsigned u32x4 __attribute__((ext_vector_type(4)));
constexpr int BM = 256, BK = 64, HALF = 128, HTB = HALF * BK * 2  , STAGE_BYTES = 8 * HTB, NXCD = 8, WGM = 8;

__host__ __device__ __forceinline__ int lds_byte(int r, int c) { const int st = (r >> 4) * 2 + (c >> 5), rr = r & 15, cc = c & 31, ob = rr * 64 + cc * 2; return st * 1024 + (ob ^ (((ob >> 9) & 1) << 5)); }
__host__ __device__ __forceinline__ void stage_rc(int b, int& R, int& C) { const int st = b / 1024, sb = b % 1024, swz = sb ^ (((sb >> 9) & 1) << 5); R = (st >> 1) * 16 + swz / 64; C = (st & 1) * 32 + (swz % 64) / 2; }
__host__ __device__ __forceinline__ int perm32(int rho) { const int n = rho >> 4, i = rho & 15; return 8 * (i >> 2) + 4 * n + (i & 3); }

struct Unit { int pm, pn; };
struct Gemm { const bf16_t* A; const bf16_t* Bt; int M, N, K; };

struct StaticOrder {
    int nM, nN, nwg, G, c;
    __host__ __device__ void init(int M, int N, int G_, int c_) { nM = M / BM; nN = N / BM; nwg = nM * nN; G = G_; c = c_; }
    __host__ __device__ bool next(int i, Unit& u) const {
        const long L = (long)i * G + c; if (L >= nwg) return false;
        int wgid = (int)L; { const int q = nwg / NXCD, r = nwg % NXCD, xcd = wgid % NXCD, off = wgid / NXCD; wgid = (xcd < r ? xcd * (q + 1) : r * (q + 1) + (xcd - r) * q) + off; }
        const int nig = WGM * nN, gid = wgid / nig, fm = gid * WGM, gsz = (nM - fm) < WGM ? (nM - fm) : WGM;
        u.pm = fm + ((wgid % nig) % gsz); u.pn = (wgid % nig) / gsz; return true;
    }
    __device__ __forceinline__ void a_ready(const Unit&) const {}
    __device__ __forceinline__ void done(const Unit&) const {}
};
__device__ __forceinline__ unsigned cvt_pk_bf16(float lo, float hi) { unsigned r; asm volatile("v_cvt_pk_bf16_f32 %0, %1, %2" : "=v"(r) : "v"(lo), "v"(hi)); return r; }
typedef float f32x2 __attribute__((ext_vector_type(2)));
template <class Epi, class Sched, bool ALIGN_EPI = false, bool SP2 = false>
__device__ __forceinline__ void gemm_phase(PG8_LAS unsigned char* lds, const Gemm g, const Sched& S, const Epi& E) {
    const int tid = threadIdx.x, wid = __builtin_amdgcn_readfirstlane(tid >> 6), lane = tid & 63, wr = wid >> 2, wc = wid & 3, fr = lane & 15, fq = lane >> 4;
    const int K = g.K, nt = K / BK;
    unsigned voffA[2], voffB[2];
#pragma unroll
    for (int i = 0; i < 2; ++i) { int R, C; stage_rc(tid * 16 + i * 8192, R, C); const int Rb = Epi::PERM ? ((R & ~31) + perm32(R & 31)) : R;
        voffA[i] = (unsigned)(R * K + C) * 2u; voffB[i] = (unsigned)(Rb * K + C) * 2u; }
    const size_t kstep = (size_t)(BK * 2);
    const size_t hstep = (size_t)HALF * K * 2;
    const size_t tstep = 2 * hstep;
    const unsigned ldsw = (unsigned)wid * 1024u;
    const int aoff = lds_byte(wr * 64 + fr, fq * 8), boff = lds_byte(wc * 32 + fr, fq * 8);
#define PG8_SA(b, h) (((b) * 2 + (h)) * HTB)
#define PG8_SB(b, h) ((4 + (b) * 2 + (h)) * HTB)
#define PG8_STAGE(bufoff, gbase, voff) do { _Pragma("unroll") for (int _i = 0; _i < 2; ++_i) \
        __builtin_amdgcn_global_load_lds((const unsigned*)((const char*)(gbase) + (voff)[_i]), (PG8_LAS unsigned*)(lds + (bufoff) + ldsw + _i * 8192), 16, 0, 0); } while (0)
#define PG8_LDA(dst, b, h) do { _Pragma("unroll") for (int m = 0; m < 4; ++m) _Pragma("unroll") for (int k = 0; k < 2; ++k) dst[m][k] = *(const PG8_LAS bf16x8*)(lds + PG8_SA(b, h) + aoff + m * 2048 + k * 1024); } while (0)
#define PG8_LDB(dst, b, h) do { _Pragma("unroll") for (int n = 0; n < 2; ++n) _Pragma("unroll") for (int k = 0; k < 2; ++k) dst[n][k] = *(const PG8_LAS bf16x8*)(lds + PG8_SB(b, h) + boff + n * 2048 + k * 1024); } while (0)
#define PG8_MMA(ai, bj, At, Bt) do { __builtin_amdgcn_s_setprio(1); _Pragma("unroll") for (int m = 0; m < 4; ++m) _Pragma("unroll") for (int n = 0; n < 2; ++n) _Pragma("unroll") for (int k = 0; k < 2; ++k) \
        acc[ai][bj][m][n] = __builtin_amdgcn_mfma_f32_16x16x32_bf16(Bt[n][k], At[m][k], acc[ai][bj][m][n], 0, 0, 0); __builtin_amdgcn_s_setprio(0); } while (0)
#define PG8_WAIT_V(n) asm volatile("s_waitcnt vmcnt(" #n ")" ::: "memory")
#define PG8_WAIT_L(n) asm volatile("s_waitcnt lgkmcnt(" #n ")" ::: "memory")
#define PG8_BAR __builtin_amdgcn_s_barrier()
#define PG8_SCHED __builtin_amdgcn_sched_barrier(0)
    Unit cur, nxt; int ui = 0;
    if (!S.next(0, cur)) return;
    f32x4 acc[2][2][4][2];
#pragma unroll
    for (int a = 0; a < 2; ++a)
#pragma unroll
        for (int b = 0; b < 2; ++b)
#pragma unroll
            for (int m = 0; m < 4; ++m)
#pragma unroll
                for (int n = 0; n < 2; ++n) acc[a][b][m][n] = (f32x4){0.f, 0.f, 0.f, 0.f};
    bf16x8 At[4][2], B0[2][2], B1[2][2];
    const char* cA = (const char*)g.A + (size_t)cur.pm * tstep; const char* cB = (const char*)g.Bt + (size_t)cur.pn * tstep;
    S.a_ready(cur);
    if constexpr (SP2) {
        PG8_STAGE(PG8_SB(0, 0), cB, voffB); PG8_STAGE(PG8_SB(0, 1), cB + hstep, voffB); PG8_STAGE(PG8_SA(0, 0), cA, voffA); PG8_STAGE(PG8_SA(0, 1), cA + hstep, voffA);
        if (wr == 1) PG8_BAR;
        PG8_WAIT_V(2); PG8_BAR;
        PG8_STAGE(PG8_SB(1, 0), cB + kstep, voffB); PG8_STAGE(PG8_SA(1, 0), cA + kstep, voffA); PG8_STAGE(PG8_SB(1, 1), cB + hstep + kstep, voffB);
        PG8_WAIT_V(6); PG8_BAR;
    } else {
        PG8_STAGE(PG8_SB(0, 0), cB, voffB); PG8_STAGE(PG8_SA(0, 0), cA, voffA); PG8_STAGE(PG8_SB(0, 1), cB + hstep, voffB); PG8_STAGE(PG8_SA(0, 1), cA + hstep, voffA);
        if (wr == 1) PG8_BAR;
        PG8_WAIT_V(4); PG8_BAR;
        PG8_STAGE(PG8_SB(1, 0), cB + kstep, voffB); PG8_STAGE(PG8_SA(1, 0), cA + kstep, voffA); PG8_STAGE(PG8_SB(1, 1), cB + hstep + kstep, voffB);
        PG8_WAIT_V(6); PG8_BAR;
    }
    for (;;) {
        const bool has_next = S.next(ui + 1, nxt);
        const char* nA = has_next ? (const char*)g.A + (size_t)nxt.pm * tstep : cA; const char* nB = has_next ? (const char*)g.Bt + (size_t)nxt.pn * tstep : cB;
        for (int t = 0; t < nt; t += 2) {
            const bool last = (t == nt - 2);
            const char* a1 = cA + (size_t)(t + 1) * kstep;
            const char* a2 = last ? nA : cA + (size_t)(t + 2) * kstep; const char* b2 = last ? nB : cB + (size_t)(t + 2) * kstep;
            const char* a3 = a2 + kstep; const char* b3 = b2 + kstep;
            if (last && has_next) S.a_ready(nxt);
            if constexpr (SP2) {
            PG8_LDB(B0, 0, 0); PG8_LDB(B1, 0, 1); PG8_SCHED; PG8_LDA(At, 0, 0); PG8_STAGE(PG8_SA(1, 1), a1 + hstep, voffA);
            PG8_WAIT_V(8); PG8_WAIT_L(0); PG8_BAR; PG8_MMA(0, 0, At, B0); PG8_MMA(0, 1, At, B1); PG8_BAR; PG8_SCHED;
            PG8_LDA(At, 0, 1); PG8_STAGE(PG8_SB(0, 0), b2, voffB); PG8_STAGE(PG8_SB(0, 1), b2 + hstep, voffB); PG8_STAGE(PG8_SA(0, 0), a2, voffA);
            PG8_WAIT_V(8); PG8_WAIT_L(0); PG8_BAR; PG8_MMA(1, 0, At, B0); PG8_MMA(1, 1, At, B1); PG8_BAR; PG8_SCHED;
            PG8_LDB(B0, 1, 0); PG8_LDB(B1, 1, 1); PG8_SCHED; PG8_LDA(At, 1, 0); PG8_STAGE(PG8_SA(0, 1), a2 + hstep, voffA);
            PG8_WAIT_V(8); PG8_WAIT_L(0); PG8_BAR; PG8_MMA(0, 0, At, B0); PG8_MMA(0, 1, At, B1); PG8_BAR; PG8_SCHED;
            PG8_LDA(At, 1, 1); PG8_STAGE(PG8_SB(1, 0), b3, voffB); PG8_STAGE(PG8_SB(1, 1), b3 + hstep, voffB); PG8_STAGE(PG8_SA(1, 0), a3, voffA);
            PG8_WAIT_V(8); PG8_WAIT_L(0); PG8_BAR; PG8_MMA(1, 0, At, B0); PG8_MMA(1, 1, At, B1); PG8_BAR; PG8_SCHED;
            } else {
            PG8_LDB(B0, 0, 0); PG8_SCHED; PG8_LDA(At, 0, 0); PG8_STAGE(PG8_SA(1, 1), a1 + hstep, voffA);
            PG8_WAIT_L(8); PG8_BAR; PG8_WAIT_L(0); PG8_MMA(0, 0, At, B0); PG8_BAR; PG8_SCHED;
            PG8_LDB(B1, 0, 1); PG8_STAGE(PG8_SB(0, 0), b2, voffB);
            PG8_BAR; PG8_WAIT_L(0); PG8_MMA(0, 1, At, B1); PG8_BAR;
            PG8_LDA(At, 0, 1); PG8_STAGE(PG8_SA(0, 0), a2, voffA);
            PG8_BAR; PG8_WAIT_L(0); PG8_MMA(1, 0, At, B0); PG8_BAR; PG8_SCHED;
            PG8_STAGE(PG8_SB(0, 1), b2 + hstep, voffB);
            PG8_WAIT_V(6); PG8_BAR; PG8_MMA(1, 1, At, B1); PG8_BAR;
            PG8_LDB(B0, 1, 0); PG8_SCHED; PG8_LDA(At, 1, 0); PG8_STAGE(PG8_SA(0, 1), a2 + hstep, voffA);
            PG8_WAIT_L(8); PG8_BAR; PG8_WAIT_L(0); PG8_MMA(0, 0, At, B0); PG8_BAR; PG8_SCHED;
            PG8_LDB(B1, 1, 1); PG8_STAGE(PG8_SB(1, 0), b3, voffB);
            PG8_BAR; PG8_WAIT_L(0); PG8_MMA(0, 1, At, B1); PG8_BAR;
            PG8_LDA(At, 1, 1); PG8_STAGE(PG8_SA(1, 0), a3, voffA);
            PG8_BAR; PG8_WAIT_L(0); PG8_MMA(1, 0, At, B0); PG8_BAR; PG8_SCHED;
            PG8_STAGE(PG8_SB(1, 1), b3 + hstep, voffB);
            PG8_WAIT_V(6); PG8_BAR; PG8_MMA(1, 1, At, B1); PG8_BAR;
            }
        }
        if constexpr (ALIGN_EPI) { if (wr == 0) PG8_BAR; }
        if constexpr (!Epi::AFTER_DRAIN) { E(acc, cur, wr, wc, fr, fq); S.done(cur); }
        if (!has_next) break;
#pragma unroll
        for (int a = 0; a < 2; ++a)
#pragma unroll
            for (int b = 0; b < 2; ++b)
#pragma unroll
                for (int m = 0; m < 4; ++m)
#pragma unroll
                    for (int n = 0; n < 2; ++n) acc[a][b][m][n] = (f32x4){0.f, 0.f, 0.f, 0.f};
        cur = nxt; cA = nA; cB = nB; ++ui;
        if constexpr (ALIGN_EPI) { if (wr == 1) PG8_BAR; }
    }
    PG8_WAIT_V(0);
    if constexpr (!ALIGN_EPI) { if (wr == 0) PG8_BAR; }
    PG8_BAR;
    if constexpr (Epi::AFTER_DRAIN) { E.fused(acc, cur, wr, wc, fr, fq, lds, wid, lane); S.done(cur); }
#undef PG8_SA
#undef PG8_SB
#undef PG8_STAGE
#undef PG8_LDA
#undef PG8_LDB
#undef PG8_MMA
#undef PG8_WAIT_V
#undef PG8_WAIT_L
#undef PG8_BAR
#undef PG8_SCHED
}
}

using pg8::bf16x8; using pg8::f32x4; using pg8::u32x4;
#define LDS_WAIT() asm volatile("s_waitcnt lgkmcnt(0)" ::: "memory")
#define VM_WAIT() asm volatile("s_waitcnt vmcnt(0)" ::: "memory")
typedef float f32x2_t __attribute__((ext_vector_type(2))); typedef __bf16 bf16x2_t __attribute__((ext_vector_type(2)));
__device__ __forceinline__ unsigned pk2(float lo, float hi) { f32x2_t v = {lo, hi}; bf16x2_t b = __builtin_convertvector(v, bf16x2_t); return __builtin_bit_cast(unsigned, b); }
__device__ __forceinline__ float bf_lo(unsigned w) { return __uint_as_float(w << 16); }
__device__ __forceinline__ float bf_hi(unsigned w) { return __uint_as_float(w & 0xffff0000u); }
__device__ __forceinline__ float bf1(bf16 b) { return __uint_as_float(((unsigned)b) << 16); }
__device__ __forceinline__ float fexp2(float x) { return __builtin_amdgcn_exp2f(x); }
__device__ __forceinline__ float fexp(float x) { return __builtin_amdgcn_exp2f(x * 1.4426950408889634f); }
__device__ __forceinline__ float frcp(float x) { return __builtin_amdgcn_rcpf(x); }
__device__ __forceinline__ float sigmoidf_(float x) { return frcp(1.0f + fexp(-x)); }
__device__ __forceinline__ float siluf_(float x) { return x * sigmoidf_(x); }
__device__ __forceinline__ float gelu_tanh(float x) {
    const float u = 0.7978845608028654f * (x + 0.044715f * x * x * x);
    const float e = fexp(2.0f * u);
    const float t = 1.0f - 2.0f * frcp(e + 1.0f);
    return 0.5f * x * (1.0f + t);
}
__device__ __forceinline__ float wave_sum(float v) {
#pragma unroll
    for (int o = 1; o < 64; o <<= 1) v += __shfl_xor(v, o);
    return v;
}
__device__ __forceinline__ v4u pack8(const f32x4 a, const f32x4 b) { v4u w; w.x = pk2(a[0], a[1]); w.y = pk2(a[2], a[3]); w.z = pk2(b[0], b[1]); w.w = pk2(b[2], b[3]); return w; }
__device__ __forceinline__ void unpack8(const v4u w, f32x4& a, f32x4& b) { a = (f32x4){bf_lo(w.x), bf_hi(w.x), bf_lo(w.y), bf_hi(w.y)}; b = (f32x4){bf_lo(w.z), bf_hi(w.z), bf_lo(w.w), bf_hi(w.w)}; }

#define XB_TMO      128
#define XB_XCNT(j)  (256  + 64 * (j))
#define XB_XSUB(j)  (1280 + 64 * (j))
#define XB_XGEN(j)  (2304 + 64 * (j))
#define XB_TOP      3328
#define XB_TOPGEN   3392
#define XCD_BAR_WORDS 3456
#define XB_SPIN_CAP (1u << 18)

__device__ __forceinline__ unsigned xb_ld(unsigned* p)              { return __hip_atomic_load(p, __ATOMIC_RELAXED, __HIP_MEMORY_SCOPE_AGENT); }
__device__ __forceinline__ unsigned xb_add(unsigned* p, unsigned v) { return __hip_atomic_fetch_add(p, v, __ATOMIC_RELAXED, __HIP_MEMORY_SCOPE_AGENT); }
__device__ __forceinline__ unsigned xb_xcc_id() { return (unsigned)__builtin_amdgcn_s_getreg((3 << 11) | 20) & 0xFu; }
#define XB_SPIN(cond, bar) do { unsigned _sp = 0; while (cond) { __builtin_amdgcn_s_sleep(1); \
    if ((++_sp & 255u) == 0u) { if (xb_ld(&(bar)[XB_TMO])) break; if (_sp > XB_SPIN_CAP) { atomicAdd(&(bar)[XB_TMO], 1u); break; } } } } while (0)

struct XcdBarrier {
    unsigned* bar; unsigned x;
    volatile LAS unsigned* st;
};

__device__ __forceinline__ XcdBarrier xcd_barrier_post(unsigned* bar, volatile LAS unsigned* st) {
    XcdBarrier b; b.bar = bar; b.x = xb_xcc_id(); b.st = st;
    if (threadIdx.x == 0) (void)xb_add(&bar[XB_XCNT(b.x)], 1u);
    return b;
}
__device__ __forceinline__ void xcd_barrier_complete(unsigned* bar, unsigned x, unsigned& nloc, unsigned& nx) {
    const unsigned G = gridDim.x * gridDim.y * gridDim.z;
    unsigned sum, cnt, mine, sp = 0u;
    for (;;) {
        sum = 0u; cnt = 0u; mine = 0u;
#pragma unroll
        for (unsigned j = 0; j < 16; ++j) { const unsigned c = xb_ld(&bar[XB_XCNT(j)]); sum += c; cnt += (c > 0u) ? 1u : 0u; mine = (j == x) ? c : mine; }
        if (sum == G) break;
        __builtin_amdgcn_s_sleep(1);
        if ((++sp & 255u) == 0u) { if (xb_ld(&bar[XB_TMO])) break; if (sp > XB_SPIN_CAP) { atomicAdd(&bar[XB_TMO], 1u); break; } }
    }
    nloc = mine > 0u ? mine : 1u; nx = cnt > 0u ? cnt : 1u;
}

__device__ __forceinline__ void xcd_barrier(const XcdBarrier& b) {
    asm volatile("s_waitcnt vmcnt(0)" ::: "memory");
    __syncthreads();
    if (threadIdx.x == 0) {
        unsigned* bar = b.bar;
        __builtin_amdgcn_s_waitcnt(0);
        unsigned nloc = b.st[0], nx = b.st[1];
        if (nloc == 0u) { xcd_barrier_complete(bar, b.x, nloc, nx); b.st[0] = nloc; b.st[1] = nx; }
        const unsigned old = xb_add(&bar[XB_XSUB(b.x)], 1u);
        const unsigned gen = old / nloc;
        if (old + 1u == (gen + 1u) * nloc) {
            __builtin_amdgcn_fence(__ATOMIC_RELEASE, "agent");
            asm volatile("s_waitcnt vmcnt(0)" ::: "memory");
            const unsigned og = xb_add(&bar[XB_TOP], 1u);
            const unsigned tg = og / nx;
            if (og + 1u == (tg + 1u) * nx) xb_add(&bar[XB_TOPGEN], 1u);
            else XB_SPIN(xb_ld(&bar[XB_TOPGEN]) == tg, bar);
            __builtin_amdgcn_fence(__ATOMIC_ACQUIRE, "agent");
            xb_add(&bar[XB_XGEN(b.x)], 1u);
            asm volatile("s_waitcnt vmcnt(0)" ::: "memory");
        } else {
            XB_SPIN(xb_ld(&bar[XB_XGEN(b.x)]) == gen, bar);
            __builtin_amdgcn_fence(__ATOMIC_ACQUIRE, "agent");
            asm volatile("s_waitcnt vmcnt(0)" ::: "memory");
        }
    }
    __syncthreads();
}

struct Args { const void* in[37]; float* out; unsigned char* ws; int ph_lo, ph_hi; };
enum { I_XP = 0, I_XS, I_CACHE, I_CWIN, I_SRET, I_SH, I_SCONV, I_SFFN, I_PT, I_CP, I_CS, I_N1G, I_N2G, I_WADA, I_BADA, I_WIN, I_PE, I_W1, I_B1, I_W2,
       I_GNG, I_RCW, I_RCB, I_RWA, I_RBA, I_RWX, I_RBX, I_LAM, I_WBRA, I_WBRB, I_WBRC, I_WOUT, I_WUP, I_FCW, I_FCB, I_WDN, I_FNG };

struct Frame {
    LAS unsigned char* lds;
    int tid, lane, wave, G, bid;
    const Args* a;
    unsigned char* ws;
    float* out;
};
__device__ __forceinline__ void launder(Frame& F) { asm volatile("" : "+v"(F.tid), "+v"(F.lane)); int w_ = __builtin_amdgcn_readfirstlane(F.wave), b_ = __builtin_amdgcn_readfirstlane(F.bid), g_ = __builtin_amdgcn_readfirstlane(F.G); asm volatile("" : "+s"(w_), "+s"(b_), "+s"(g_)); F.wave = w_; F.bid = b_; F.G = g_; }
#define FIN(i) ((const float*)F.a->in[i])
#define WSP(T, off) ((T*)(F.ws + (off)))

__device__ __forceinline__ int row_bb(int row) { return row < PM ? (row >> 12) : 4 + ((row - PM) >> 3); }
__device__ __forceinline__ int row_pos(int row) { return row < PM ? (row & (PT - 1)) : PT + ((row - PM) & 7); }

__device__ __forceinline__ int win_cmap(int n) {
    if (n < 1280) return n;
    if (n < 2304) { const int c = n - 1280, isk = c >> 9, hc = c & 511, head = hc >> 7, s = hc & 127;
        const int g = s >> 3, w = s & 7, dim = (w < 4) ? (4 * g + w) : (64 + 4 * g + (w - 4)); return (isk ? O_RK : O_RQ) + head * 128 + dim; }
    if (n < 2816) return O_RV + (n - 2304);
    if (n < 3328) return O_RG + (n - 2816);
    if (n < 3840) return O_RX + (n - 3328);
    if (n < 4352) return O_RGATE + (n - 3840);
    if (n < 7424) return O_MG + (n - 4352);
    if (n < 7448) return O_NG + (n - 7424);
    return -1;
}

struct TrItem { const float* W; bf16* WT; int ldw, ldt, k0, n0; bool map; };
__device__ __forceinline__ void p0_tr_load(const TrItem& I, float (&tv)[32], int lane) {
    const int nd = I.n0 + (lane & 31); const int sc = I.map ? win_cmap(nd) : nd;
#pragma unroll
    for (int i = 0; i < 32; ++i) { const int kk = 2 * i + (lane >> 5); tv[i] = (sc >= 0) ? I.W[(size_t)(I.k0 + kk) * I.ldw + sc] : 0.f; }
}
__device__ __forceinline__ void p0_tr_finish(const TrItem& I, const float (&tv)[32], LAS float* scr, int lane) {
#pragma unroll
    for (int i = 0; i < 32; ++i) { const int kk = 2 * i + (lane >> 5); scr[kk * 33 + (lane & 31)] = tv[i]; }
    LDS_WAIT(); asm volatile("" ::: "memory");
    const int c = lane & 7;
#pragma unroll
    for (int j = 0; j < 4; ++j) { const int n = (lane >> 3) + 8 * j; const LAS float* s = scr + (8 * c) * 33 + n;
        v4u o; o.x = pk2(s[0 * 33], s[1 * 33]); o.y = pk2(s[2 * 33], s[3 * 33]); o.z = pk2(s[4 * 33], s[5 * 33]); o.w = pk2(s[6 * 33], s[7 * 33]);
        *(v4u*)(I.WT + (size_t)(I.n0 + n) * I.ldt + I.k0 + 8 * c) = o; }
    LDS_WAIT(); asm volatile("" ::: "memory");
}
template <bool MAP> __device__ __forceinline__ void p0_tr_item(const float* W, int ldw, bf16* WT, int ldt, int k0, int n0, LAS float* scr, int lane) {
    TrItem I{W, WT, ldw, ldt, k0, n0, MAP}; float tv[32]; p0_tr_load(I, tv, lane); p0_tr_finish(I, tv, scr, lane);
}
template <bool MAP> __device__ __forceinline__ void p0_tr_item2(const float* W, int ldw, bf16* WT, int ldt, int k0, int n0, LAS float* scr, int lane) {
    TrItem I0{W, WT, ldw, ldt, k0, n0, MAP}, I1{W, WT, ldw, ldt, k0, n0 + 32, MAP}; float t0[32], t1[32];
    p0_tr_load(I0, t0, lane); p0_tr_load(I1, t1, lane); p0_tr_finish(I0, t0, scr, lane); p0_tr_finish(I1, t1, scr, lane);
}
__device__ __forceinline__ void sincos_acc(float ang, float& s, float& c) {
    const double a = (double)ang; const double kq = rint(a * 0.63661977236758134308); const double r = fma(-kq, 1.57079632679489661923, a);
    const double r2 = r * r;
    const double sp = r * (1.0 + r2 * (-1.6666666666666666e-1 + r2 * (8.3333333333333332e-3 + r2 * (-1.9841269841269841e-4 + r2 * (2.7557319223985893e-6 + r2 * (-2.5052108385441720e-8))))));
    const double cp = 1.0 + r2 * (-0.5 + r2 * (4.1666666666666664e-2 + r2 * (-1.3888888888888889e-3 + r2 * (2.4801587301587302e-5 + r2 * (-2.7557319223985888e-7 + r2 * 2.0876756987868099e-9)))));
    const int q = ((int)kq) & 3;
    const double ss = (q == 0) ? sp : (q == 1) ? cp : (q == 2) ? -sp : -cp;
    const double cc = (q == 0) ? cp : (q == 1) ? -sp : (q == 2) ? -cp : sp;
    s = (float)ss; c = (float)cc;
}

__device__ __forceinline__ void p0_prologue(Frame& F) {
    const int gw = F.bid * NWAVES + F.wave, NGW = F.G * NWAVES, lane = F.lane;
    LAS float* scr = (LAS float*)(F.lds + F.wave * 16384);
    {
        constexpr int I_IN = 16 * 240, I_BR = 8 * 32, I_OUT = 16 * 32, I_UP = 16 * 176, I_DN = 44 * 32, I_L = I_IN + 3 * I_BR + I_OUT + I_UP + I_DN;
        for (int it = gw; it < 2 * I_L; it += NGW) {
            const int l = it / I_L; int r = it % I_L;
            if (r < I_IN) { p0_tr_item<true>(FIN(I_WIN) + (size_t)l * DM * D_IN, D_IN, WSP(bf16, WS_WIN) + (size_t)l * NIN * DM, DM, 64 * (r / 240), 32 * (r % 240), scr, lane); continue; } r -= I_IN;
            if (r < 3 * I_BR) { const int w = r / I_BR, q = r % I_BR; const float* src = FIN(w == 0 ? I_WBRA : (w == 1 ? I_WBRB : I_WBRC)) + (size_t)l * 512 * 1024;
                p0_tr_item<false>(src, 1024, WSP(bf16, WS_WBR) + (size_t)(l * 3 + w) * 1024 * 512, 512, 64 * (q / 32), 32 * (q % 32), scr, lane); continue; } r -= 3 * I_BR;
            if (r < I_OUT) { p0_tr_item<false>(FIN(I_WOUT) + (size_t)l * 1024 * 1024, 1024, WSP(bf16, WS_WOUT) + (size_t)l * 1024 * 1024, 1024, 64 * (r / 32), 32 * (r % 32), scr, lane); continue; } r -= I_OUT;
            if (r < I_UP) { p0_tr_item<false>(FIN(I_WUP) + (size_t)l * DM * NUP, NUP, WSP(bf16, WS_WUP) + (size_t)l * NUP * DM, DM, 64 * (r / 176), 32 * (r % 176), scr, lane); continue; } r -= I_UP;
            p0_tr_item<false>(FIN(I_WDN) + (size_t)l * DFF * DM, DM, WSP(bf16, WS_WDN) + (size_t)l * DM * DFF, DFF, 64 * (r / 32), 32 * (r % 32), scr, lane);
        }
    }
    {
        constexpr int NI_W1 = 8 * 16 * 4, NI_W2 = 4 * 2 * 2, NI_RG = 32 * 2;
        for (int it = gw; it < NI_W1 + NI_W2 + NI_RG; it += NGW) {
            int r = it;
            if (r < NI_W1) { const int m = r / 64, q = r % 64, lk = m >> 1, half = m & 1;
                p0_tr_item<false>(FIN(I_W1) + ((size_t)lk * 32 + half * 16) * 64 * 128, 128, WSP(bf16, WS_SMALLW + SW_W1T) + ((size_t)lk * 256 + half * 128) * 1024, 1024, 64 * (q / 4), 32 * (q % 4), scr, lane); continue; } r -= NI_W1;
            if (r < NI_W2) { const int lk = r / 4, q = r % 4;
                p0_tr_item<false>(FIN(I_W2) + (size_t)lk * 128 * 64, 64, WSP(bf16, WS_SMALLW + SW_W2T) + (size_t)lk * 64 * 128, 128, 64 * (q / 2), 32 * (q % 2), scr, lane); continue; } r -= NI_W2;
            { const int m = r / 2, q = r % 2, l = m >> 4, which = (m >> 3) & 1, blk = m & 7;
                p0_tr_item<false>(FIN(which ? I_RWX : I_RWA) + ((size_t)l * 8 + blk) * 4096, 64, WSP(bf16, WS_SMALLW + SW_WAT) + (size_t)m * 4096, 64, 0, 32 * q, scr, lane); }
        }
    }
    for (int it = gw; it < 64; it += NGW) {
        const int lk = it >> 4, h0 = (it & 15) * 8; const float* pe = FIN(I_PE) + (size_t)lk * 2048; const float* w1 = FIN(I_W1) + (size_t)lk * 2048 * 128 + h0;
        f32x4 a0 = (f32x4){0.f, 0.f, 0.f, 0.f}, a1 = a0;
#pragma unroll 8
        for (int i = lane; i < 2048; i += 64) { const float p = pe[i]; a0 += *(const f32x4*)(w1 + (size_t)i * 128) * p; a1 += *(const f32x4*)(w1 + (size_t)i * 128 + 4) * p; }
#pragma unroll
        for (int x = 0; x < 4; ++x) { a0[x] = wave_sum(a0[x]); a1[x] = wave_sum(a1[x]); }
        if (lane == 0) { float* cb = WSP(float, WS_SMALLW + SW_CB) + lk * 128 + h0; const float* b1 = FIN(I_B1) + lk * 128 + h0;
#pragma unroll
            for (int x = 0; x < 4; ++x) { cb[x] = a0[x] + b1[x]; cb[4 + x] = a1[x] + b1[4 + x]; } }
    }
    for (int i = F.bid * NTHR + F.tid; i < 1024; i += F.G * NTHR) { const float lam = FIN(I_LAM)[i]; WSP(float, WS_SMALLW + SW_SP)[i] = log1pf(expf(-lam)); }
    for (int i = F.bid * NTHR + F.tid; i < 2 * SB * 2 * DFF; i += F.G * NTHR) WSP(bf16, WS_SFB)[i] = (bf16)(pk2(FIN(I_SFFN)[i], 0.f) & 0xffffu);
    for (int i = F.bid * NTHR + F.tid; i < 4104 * 64; i += F.G * NTHR) {
        const int pi = i >> 6, fi = i & 63; const float pos = (float)(pi < PT ? pi : PAST + (pi - PT));
        const float freq = (float)pow(10000.0, -(double)fi / 64.0); const float ang = pos * freq; float s, c; sincos_acc(ang, s, c);
        WSP(float, WS_ROT)[i] = c; WSP(float, WS_ROT)[4104 * 64 + i] = s;
    }
    {
        LAS float* SC = (LAS float*)(F.lds + 0);
        LAS float* RED = (LAS float*)(F.lds + 36864);
        for (int u = F.bid; u < 2 * 96; u += F.G) {
            const int l = u / 96, cg = u % 96; float acc[36];
#pragma unroll
            for (int b = 0; b < 36; ++b) acc[b] = 0.f;
#pragma unroll 1
            for (int kh = 0; kh < 4; ++kh) {
                __syncthreads();
                {   float cv[18];
                    const float* cpp = FIN(I_CP); const float* csp = FIN(I_CS);
#pragma unroll
                    for (int it = 0; it < 18; ++it) { const int i = F.tid + NTHR * it, bb = i >> 8, d = i & 255;
                        cv[it] = (bb < 4) ? cpp[bb * DM + kh * 256 + d] : csp[(bb - 4) * DM + kh * 256 + d]; }
#pragma unroll
                    for (int it = 0; it < 18; ++it) { const int i = F.tid + NTHR * it, bb = i >> 8, d = i & 255; SC[d * 36 + bb] = siluf_(cv[it]); }
                }
                __syncthreads();
                const float* wp = FIN(I_WADA) + ((size_t)l * DM + kh * 256 + F.wave * 32) * 6144 + cg * 64 + lane;
                {
                    float wv[32];
#pragma unroll
                    for (int k = 0; k < 32; ++k) wv[k] = wp[(size_t)k * 6144];
                    const LAS f32x4* scb = (const LAS f32x4*)(SC + (F.wave * 32) * 36);
                    f32x4 sa[9], sb[9];
#pragma unroll
                    for (int g = 0; g < 9; ++g) sa[g] = scb[g];
#pragma unroll
                    for (int k = 0; k < 32; k += 2) {
#pragma unroll
                        for (int g = 0; g < 9; ++g) sb[g] = scb[(k + 1) * 9 + g];
#pragma unroll
                        for (int g = 0; g < 9; ++g) { acc[4 * g + 0] += wv[k] * sa[g][0]; acc[4 * g + 1] += wv[k] * sa[g][1]; acc[4 * g + 2] += wv[k] * sa[g][2]; acc[4 * g + 3] += wv[k] * sa[g][3]; }
                        if (k + 2 < 32) {
#pragma unroll
                            for (int g = 0; g < 9; ++g) sa[g] = scb[(k + 2) * 9 + g]; }
#pragma unroll
                        for (int g = 0; g < 9; ++g) { acc[4 * g + 0] += wv[k + 1] * sb[g][0]; acc[4 * g + 1] += wv[k + 1] * sb[g][1]; acc[4 * g + 2] += wv[k + 1] * sb[g][2]; acc[4 * g + 3] += wv[k + 1] * sb[g][3]; }
                    }
                }
            }
#pragma unroll
            for (int b = 0; b < 36; ++b) RED[(F.wave * 36 + b) * 64 + lane] = acc[b];
            __syncthreads();
            for (int o = F.tid; o < 36 * 64; o += NTHR) { const int b = o >> 6, col = o & 63; float sm = FIN(I_BADA)[l * 6144 + cg * 64 + col];
#pragma unroll
                for (int w = 0; w < 8; ++w) sm += RED[(w * 36 + b) * 64 + col];
                WSP(float, WS_MOD)[((size_t)l * 36 + b) * 6144 + cg * 64 + col] = sm; }
        }
        __syncthreads();
    }
    {   constexpr size_t NV4 = (size_t)2 * SB * 504 * 64; const size_t stride = (size_t)F.G * NTHR;
        for (size_t i0 = (size_t)F.bid * NTHR + F.tid; i0 < NV4; i0 += 8 * stride) {
            f32x4 v[8];
#pragma unroll
            for (int k = 0; k < 8; ++k) { const size_t i = i0 + k * stride; if (i < NV4) { const size_t seq = i / (504 * 64), r = i % (504 * 64); v[k] = __builtin_nontemporal_load((const f32x4*)(FIN(I_CWIN) + (seq * 512 + 8) * 256 + r * 4)); } }
#pragma unroll
            for (int k = 0; k < 8; ++k) { const size_t i = i0 + k * stride; if (i < NV4) { const size_t seq = i / (504 * 64), r = i % (504 * 64); *(f32x4*)(F.out + OUT_WIN_S + seq * 512 * 256 + r * 4) = v[k]; } }
        }
    }
}

__device__ __forceinline__ f32x4 ld4_bf(const bf16* p) { const v2u w = *(const v2u*)p; return (f32x4){bf_lo(w.x), bf_hi(w.x), bf_lo(w.y), bf_hi(w.y)}; }
__device__ __forceinline__ void norm_phase(Frame& F, int l, int which) {
    const int gw = F.bid * NWAVES + F.wave, NGW = F.G * NWAVES, lane = F.lane;
    const float* g = FIN(which ? I_N2G : I_N1G) + l * DM;
    constexpr int NR = 4;
    for (int row0 = gw * NR; row0 < MT; row0 += NGW * NR) {
        f32x4 v[NR][4]; float ss[NR];
#pragma unroll
        for (int rr = 0; rr < NR; ++rr) { const int row = row0 + rr;
            if (which == 0 && l == 0) { const float* xr = row < PM ? FIN(I_XP) + (size_t)row * DM : FIN(I_XS) + (size_t)(row - PM) * DM;
#pragma unroll
                for (int j = 0; j < 4; ++j) v[rr][j] = *(const f32x4*)(xr + lane * 4 + 256 * j); }
            else { const bf16* xr = WSP(bf16, which ? WS_X1 : WS_X2) + (size_t)row * DM;
#pragma unroll
                for (int j = 0; j < 4; ++j) v[rr][j] = ld4_bf(xr + lane * 4 + 256 * j); } }
#pragma unroll
        for (int rr = 0; rr < NR; ++rr) { float a = 0.f;
#pragma unroll
            for (int j = 0; j < 4; ++j) a += (v[rr][j][0] * v[rr][j][0] + v[rr][j][1] * v[rr][j][1]) + (v[rr][j][2] * v[rr][j][2] + v[rr][j][3] * v[rr][j][3]);
            ss[rr] = a; }
#pragma unroll
        for (int o = 1; o < 64; o <<= 1) {
#pragma unroll
            for (int rr = 0; rr < NR; ++rr) ss[rr] += __shfl_xor(ss[rr], o); }
#pragma unroll
        for (int rr = 0; rr < NR; ++rr) { const int row = row0 + rr; const float rs = 1.0f / sqrtf(ss[rr] * (1.0f / DM) + EPS);
            const float* mod = WSP(float, WS_MOD) + ((size_t)l * 36 + row_bb(row)) * 6144 + (which ? 3072 : 0); bf16* o = WSP(bf16, WS_H) + (size_t)row * DM;
#pragma unroll
            for (int j = 0; j < 4; ++j) { const int c = lane * 4 + 256 * j; const f32x4 gg = *(const f32x4*)(g + c), sh = *(const f32x4*)(mod + c), sc = *(const f32x4*)(mod + 1024 + c);
                const f32x4 y = (v[rr][j] * rs) * gg * (sc + 1.0f) + sh; v2u w; w.x = pk2(y[0], y[1]); w.y = pk2(y[2], y[3]); *(v2u*)(o + c) = w; } }
    }
}
__device__ __forceinline__ void final_phase(Frame& F) {
    const int gw = F.bid * NWAVES + F.wave, NGW = F.G * NWAVES, lane = F.lane;
    const float* g = FIN(I_FNG);
    for (int row0 = gw * 4; row0 < MT; row0 += NGW * 4) {
        f32x4 v[4][4]; float ss[4];
#pragma unroll
        for (int rr = 0; rr < 4; ++rr) { const bf16* xr = WSP(bf16, WS_X2) + (size_t)(row0 + rr) * DM; float a = 0.f;
#pragma unroll
            for (int j = 0; j < 4; ++j) { v[rr][j] = ld4_bf(xr + lane * 4 + 256 * j); a += (v[rr][j][0] * v[rr][j][0] + v[rr][j][1] * v[rr][j][1]) + (v[rr][j][2] * v[rr][j][2] + v[rr][j][3] * v[rr][j][3]); }
            ss[rr] = a; }
#pragma unroll
        for (int rr = 0; rr < 4; ++rr) { const float rs = 1.0f / sqrtf(wave_sum(ss[rr]) * (1.0f / DM) + EPS);
            float* o = F.out + OUT_Y + (size_t)(row0 + rr) * DM;
#pragma unroll
            for (int j = 0; j < 4; ++j) { const int c = lane * 4 + 256 * j; *(f32x4*)(o + c) = (v[rr][j] * rs) * *(const f32x4*)(g + c); } }
    }
}

#define EPI_LOOP_BEGIN \
    _Pragma("unroll") for (int ai = 0; ai < 2; ++ai) _Pragma("unroll") for (int m = 0; m < 4; ++m) { const int row = u.pm * 256 + ai * 128 + wr * 64 + m * 16 + fr; \
    _Pragma("unroll") for (int bj = 0; bj < 2; ++bj) { const int ct = bj * 128 + wc * 32 + 8 * fq; const f32x4 v0 = acc[ai][bj][m][0], v1 = acc[ai][bj][m][1];
#define EPI_LOOP_END } }

struct EpiWin {
    static constexpr bool PERM = true, AFTER_DRAIN = false;
    unsigned char* ws; float* out; int l;
    __device__ __forceinline__ void operator()(const f32x4 (&acc)[2][2][4][2], const pg8::Unit& u, int wr, int wc, int fr0, int fq0) const {
        int fr = fr0, fq = fq0; asm volatile("" : "+v"(fr), "+v"(fq));
        const int pn = u.pn;
        if (pn < 2) {
            bf16* QN = (bf16*)(ws + WS_QN);
            EPI_LOOP_BEGIN *(v4u*)(QN + (size_t)row * 512 + pn * 256 + ct) = pack8(v0 * QSCALE, v1 * QSCALE); EPI_LOOP_END
        } else if (pn < 5) {
            EPI_LOOP_BEGIN
                const int c = (pn - 2) * 256 + ct, j = c >> 7, k = (c >> 6) & 1, d = c & 63;
                const bool isp = row < PM; const int b = isp ? (row >> 12) : ((row - PM) >> 3), t = isp ? (row & (PT - 1)) : ((row - PM) & 7);
                if (j < 4) { float* o = out + (isp ? OUT_ROWS_P + ((size_t)l * PM + row) * 512 : OUT_ROWS_S + ((size_t)l * SM + (row - PM)) * 512) + c; *(f32x4*)o = v0; *(f32x4*)(o + 4) = v1; }
                else if (isp) { if (t >= PT - WINB) { float* o = out + OUT_WIN_P + (((size_t)l * PB + b) * WINB + (t - (PT - WINB))) * 256 + (c - 512); *(f32x4*)o = v0; *(f32x4*)(o + 4) = v1; } }
                else { float* o = out + OUT_WIN_S + (((size_t)l * SB + b) * WINB + (WINB - ST) + t) * 256 + (c - 512); *(f32x4*)o = v0; *(f32x4*)(o + 4) = v1; }
                const v4u w = pack8(v0, v1);
                if (isp) {
                    if (j < 2) *(v4u*)((bf16*)(ws + WS_ACMP) + ((size_t)(l * 2 + j) * CMP_ROWS_J + 32768 + (b * 2 + k) * 256) * 1024 + (size_t)t * 64 + d) = w;
                    else if (j & 1) {
                        const int tq = t & 31, s2 = tq >> 4, hh = (tq >> 2) & 1, ii = (tq & 3) + 4 * ((tq >> 3) & 1);
                        bf16* vt = (bf16*)(ws + WS_KVB) + (((size_t)(j - 2) * PB + b) * 2 + k) * PT * 64 + (size_t)(t >> 5) * 2048 + ((((d >> 5) * 2 + s2) * 2 + hh) * 32 + (d & 31)) * 8 + ii;
                        vt[0] = (bf16)(w.x & 0xffffu); vt[8] = (bf16)(w.x >> 16); vt[16] = (bf16)(w.y & 0xffffu); vt[24] = (bf16)(w.y >> 16);
                        vt[32] = (bf16)(w.z & 0xffffu); vt[40] = (bf16)(w.z >> 16); vt[48] = (bf16)(w.w & 0xffffu); vt[56] = (bf16)(w.w >> 16); }
                    else *(v4u*)((bf16*)(ws + WS_KVB) + (((size_t)(j - 2) * PB + b) * 2 + k) * PT * 64 + (size_t)(t >> 5) * 2048 + ((d >> 3) * 32 + (t & 31)) * 8) = w;
                } else if (j >= 2) *(v4u*)((bf16*)(ws + WS_KVS) + ((((size_t)(j - 2) * SB + b) * 2 + k) * ST + t) * 64 + d) = w;
            EPI_LOOP_END
        } else if (pn < 9) {
            const float* ROTC = (const float*)(ws + WS_ROT); const float* ROTS = ROTC + 4104 * 64;
#pragma unroll
            for (int ai = 0; ai < 2; ++ai) {
                f32x4 cs[4][2], sn[4][2];
#pragma unroll
                for (int m = 0; m < 4; ++m) { const int row = u.pm * 256 + ai * 128 + wr * 64 + m * 16 + fr; const int pi = row_pos(row);
#pragma unroll
                    for (int bj = 0; bj < 2; ++bj) { const int ct = bj * 128 + wc * 32 + 8 * fq; const int c = (pn - 5) * 256 + ct, d0 = (((c & 511) & 127) >> 3) * 4; cs[m][bj] = *(const f32x4*)(ROTC + pi * 64 + d0); sn[m][bj] = *(const f32x4*)(ROTS + pi * 64 + d0); } }
#pragma unroll
                for (int m = 0; m < 4; ++m) { const int row = u.pm * 256 + ai * 128 + wr * 64 + m * 16 + fr;
#pragma unroll
                    for (int bj = 0; bj < 2; ++bj) { const int ct = bj * 128 + wc * 32 + 8 * fq; const f32x4 v0 = acc[ai][bj][m][0], v1 = acc[ai][bj][m][1];
                        const int c = (pn - 5) * 256 + ct, isk = c >> 9, hc = c & 511, head = hc >> 7, d0 = ((hc & 127) >> 3) * 4;
                        const float sc = isk ? 0.08838834764831845f : 1.0f;
                        const f32x4 o1 = (v0 * cs[m][bj] - v1 * sn[m][bj]) * sc, o2 = (v0 * sn[m][bj] + v1 * cs[m][bj]) * sc;
                        bf16* o = (bf16*)(ws + WS_RQ) + (size_t)isk * MT * 512 + (size_t)row * 512 + head * 128 + d0;
                        v2u w1; w1.x = pk2(o1[0], o1[1]); w1.y = pk2(o1[2], o1[3]); *(v2u*)o = w1;
                        v2u w2; w2.x = pk2(o2[0], o2[1]); w2.y = pk2(o2[2], o2[3]); *(v2u*)(o + 64) = w2; } }
            }
        } else if (pn < 13) {
            bf16* RV = (bf16*)(ws + WS_RQ) + (size_t)2 * MT * 512;
            EPI_LOOP_BEGIN const int c = (pn - 9) * 256 + ct; *(v4u*)(RV + (size_t)(c >> 9) * MT * 512 + (size_t)row * 512 + (c & 511)) = pack8(v0, v1); EPI_LOOP_END
        } else if (pn < 15) {
            float* RX = (float*)(ws + WS_RX);
            EPI_LOOP_BEGIN
                const int c = (pn - 13) * 256 + ct; float* o = RX + (size_t)row * 512 + c; *(f32x4*)o = v0; *(f32x4*)(o + 4) = v1;
                if (row < PM) { const int t = row & (PT - 1); if (t >= PT - 3) { float* q = out + OUT_CV_P + (((size_t)l * PB + (row >> 12)) * 3 + (t - (PT - 3))) * 512 + c; *(f32x4*)q = v0; *(f32x4*)(q + 4) = v1; } }
                else { const int i = (row - PM) & 7; if (i >= ST - 3) { float* q = out + OUT_CV_S + (((size_t)l * SB + ((row - PM) >> 3)) * 3 + (i - (ST - 3))) * 512 + c; *(f32x4*)q = v0; *(f32x4*)(q + 4) = v1; } }
            EPI_LOOP_END
        } else if (pn < 17) {
            bf16* GG = (bf16*)(ws + WS_GG);
            EPI_LOOP_BEGIN const int c = (pn - 15) * 256 + ct;
                f32x4 a, b;
#pragma unroll
                for (int i = 0; i < 4; ++i) { a[i] = gelu_tanh(v0[i]); b[i] = gelu_tanh(v1[i]); }
                *(v4u*)(GG + (size_t)row * 512 + c) = pack8(a, b); EPI_LOOP_END
        } else if (pn < 29) {
            bf16* MG = (bf16*)(ws + WS_MGS);
            EPI_LOOP_BEGIN const int c = (pn - 17) * 256 + ct;
                f32x4 a, b;
#pragma unroll
                for (int i = 0; i < 4; ++i) { a[i] = sigmoidf_(v0[i]); b[i] = sigmoidf_(v1[i]); }
                *(v4u*)(MG + (size_t)row * 3072 + c) = pack8(a, b); EPI_LOOP_END
        } else {
            float* NG = (float*)(ws + WS_NG);
            EPI_LOOP_BEGIN if (ct < 24) { f32x4 a, b;
#pragma unroll
                for (int i = 0; i < 4; ++i) { a[i] = sigmoidf_(v0[i]); b[i] = sigmoidf_(v1[i]); }
                float* o = NG + (size_t)row * 24 + ct; *(f32x4*)o = a; *(f32x4*)(o + 4) = b; } EPI_LOOP_END
        }
    }
};

struct EpiLH {
    static constexpr bool PERM = true, AFTER_DRAIN = false;
    bf16* LH;
    __device__ __forceinline__ void operator()(const f32x4 (&acc)[2][2][4][2], const pg8::Unit& u, int wr, int wc, int fr0, int fq0) const {
        int fr = fr0, fq = fq0; asm volatile("" : "+v"(fr), "+v"(fq));
        EPI_LOOP_BEGIN *(v4u*)(LH + (size_t)row * 256 + ct) = pack8(v0, v1); EPI_LOOP_END
    }
};
struct CmpOrder {
    int G, c;
    __device__ bool next(int i, pg8::Unit& u) const { const int L = i * G + c; if (L >= CMP_ROWS / 256) return false; u.pm = L; u.pn = L / (CMP_ROWS_J / 256); return true; }
    __device__ __forceinline__ void a_ready(const pg8::Unit&) const {}
    __device__ __forceinline__ void done(const pg8::Unit&) const {}
};

template <int BR> struct EpiBr {
    static constexpr bool PERM = true, AFTER_DRAIN = false;
    unsigned char* ws;
    __device__ __forceinline__ void operator()(const f32x4 (&acc)[2][2][4][2], const pg8::Unit& u, int wr, int wc, int fr0, int fq0) const {
        int fr = fr0, fq = fq0; asm volatile("" : "+v"(fr), "+v"(fq));
        const bf16* MG = (const bf16*)(ws + WS_MGS); bf16* MR = (bf16*)(ws + WS_MRG);
        EPI_LOOP_BEGIN
            const int col = u.pn * 256 + ct; f32x4 g0, g1; unpack8(*(const v4u*)(MG + (size_t)row * 3072 + BR * 1024 + col), g0, g1);
            f32x4 r0 = v0 * g0, r1 = v1 * g1; bf16* o = MR + (size_t)row * DM + col;
            if (BR > 0) { f32x4 p0, p1; unpack8(*(const v4u*)o, p0, p1); r0 += p0; r1 += p1; }
            *(v4u*)o = pack8(r0, r1);
        EPI_LOOP_END
    }
};

struct BrOrder {
    pg8::StaticOrder S;
    __device__ bool next(int i, pg8::Unit& u) const { pg8::Unit t; if (!S.next(i / 3, t)) return false; const int br = i % 3; u.pm = br * (MT / 256) + t.pm; u.pn = br * 4 + t.pn; return true; }
    __device__ __forceinline__ void a_ready(const pg8::Unit&) const {}
    __device__ __forceinline__ void done(const pg8::Unit&) const {}
};
struct EpiBrAll {
    static constexpr bool PERM = true, AFTER_DRAIN = false;
    unsigned char* ws;
    __device__ __forceinline__ void operator()(const f32x4 (&acc)[2][2][4][2], const pg8::Unit& u0, int wr, int wc, int fr0, int fq0) const {
        int fr = fr0, fq = fq0; asm volatile("" : "+v"(fr), "+v"(fq));
        const int br = u0.pn >> 2; const pg8::Unit u{u0.pm - br * (MT / 256), u0.pn & 3};
        const bf16* MG = (const bf16*)(ws + WS_MGS) + br * 1024; bf16* MR = (bf16*)(ws + WS_MRG);
#pragma unroll
        for (int ai = 0; ai < 2; ++ai) {
            v4u gw[4][2], pw[4][2];
#pragma unroll
            for (int m = 0; m < 4; ++m) { const int row = u.pm * 256 + ai * 128 + wr * 64 + m * 16 + fr;
#pragma unroll
                for (int bj = 0; bj < 2; ++bj) { const int col = u.pn * 256 + bj * 128 + wc * 32 + 8 * fq; gw[m][bj] = *(const v4u*)(MG + (size_t)row * 3072 + col); if (br != 0) pw[m][bj] = *(const v4u*)(MR + (size_t)row * DM + col); } }
#pragma unroll
            for (int m = 0; m < 4; ++m) { const int row = u.pm * 256 + ai * 128 + wr * 64 + m * 16 + fr;
#pragma unroll
                for (int bj = 0; bj < 2; ++bj) { const int col = u.pn * 256 + bj * 128 + wc * 32 + 8 * fq; const f32x4 v0 = acc[ai][bj][m][0], v1 = acc[ai][bj][m][1];
                    f32x4 g0, g1; unpack8(gw[m][bj], g0, g1); f32x4 r0 = v0 * g0, r1 = v1 * g1;
                    if (br != 0) { f32x4 p0, p1; unpack8(pw[m][bj], p0, p1); r0 += p0; r1 += p1; }
                    *(v4u*)(MR + (size_t)row * DM + col) = pack8(r0, r1); } }
        }
    }
};

template <bool INF32> struct EpiRes {
    static constexpr bool PERM = true, AFTER_DRAIN = false;
    const void* xin_p; bf16* xout; const float* mod; int gofs;
    __device__ __forceinline__ void operator()(const f32x4 (&acc)[2][2][4][2], const pg8::Unit& u, int wr, int wc, int fr0, int fq0) const {
        int fr = fr0, fq = fq0; asm volatile("" : "+v"(fr), "+v"(fq));
#pragma unroll
        for (int ai = 0; ai < 2; ++ai) {
            const float* gp = mod + (size_t)row_bb(u.pm * 256 + ai * 128) * 6144 + gofs + u.pn * 256 + wc * 32 + 8 * fq;
            f32x4 g[2][2];
#pragma unroll
            for (int bj = 0; bj < 2; ++bj) { g[bj][0] = *(const f32x4*)(gp + 128 * bj); g[bj][1] = *(const f32x4*)(gp + 128 * bj + 4); }
            if (INF32) {
#pragma unroll
                for (int mh = 0; mh < 2; ++mh) {
                    f32x4 xv[2][2][2];
#pragma unroll
                    for (int m2 = 0; m2 < 2; ++m2) { const int row = u.pm * 256 + ai * 128 + wr * 64 + (2 * mh + m2) * 16 + fr;
#pragma unroll
                        for (int bj = 0; bj < 2; ++bj) { const float* xi = (const float*)xin_p + (size_t)row * DM + u.pn * 256 + bj * 128 + wc * 32 + 8 * fq; xv[m2][bj][0] = *(const f32x4*)xi; xv[m2][bj][1] = *(const f32x4*)(xi + 4); } }
#pragma unroll
                    for (int m2 = 0; m2 < 2; ++m2) { const int m = 2 * mh + m2; const int row = u.pm * 256 + ai * 128 + wr * 64 + m * 16 + fr;
#pragma unroll
                        for (int bj = 0; bj < 2; ++bj) { const int col = u.pn * 256 + bj * 128 + wc * 32 + 8 * fq;
                            *(v4u*)(xout + (size_t)row * DM + col) = pack8(xv[m2][bj][0] + g[bj][0] * acc[ai][bj][m][0], xv[m2][bj][1] + g[bj][1] * acc[ai][bj][m][1]); } }
                }
            } else {
                v4u xw[4][2];
#pragma unroll
                for (int m = 0; m < 4; ++m) { const int row = u.pm * 256 + ai * 128 + wr * 64 + m * 16 + fr;
#pragma unroll
                    for (int bj = 0; bj < 2; ++bj) xw[m][bj] = *(const v4u*)((const bf16*)xin_p + (size_t)row * DM + u.pn * 256 + bj * 128 + wc * 32 + 8 * fq); }
#pragma unroll
                for (int m = 0; m < 4; ++m) { const int row = u.pm * 256 + ai * 128 + wr * 64 + m * 16 + fr;
#pragma unroll
                    for (int bj = 0; bj < 2; ++bj) { const int col = u.pn * 256 + bj * 128 + wc * 32 + 8 * fq; f32x4 x0, x1; unpack8(xw[m][bj], x0, x1);
                        *(v4u*)(xout + (size_t)row * DM + col) = pack8(x0 + g[bj][0] * acc[ai][bj][m][0], x1 + g[bj][1] * acc[ai][bj][m][1]); } }
            }
        }
    }
};

struct UpOrder {
    pg8::StaticOrder S;
    __device__ bool next(int i, pg8::Unit& u) const { pg8::Unit t; if (!S.next(i >> 1, t)) return false; u.pm = t.pm; u.pn = t.pn + 11 * (i & 1); return true; }
    __device__ __forceinline__ void a_ready(const pg8::Unit&) const {}
    __device__ __forceinline__ void done(const pg8::Unit&) const {}
};
struct EpiUp {
    static constexpr bool PERM = true, AFTER_DRAIN = false;
    unsigned char* ws; float* out; int l; const float* cw; const float* cbi; const bf16* sfb;
    __device__ __forceinline__ void operator()(const f32x4 (&acc)[2][2][4][2], const pg8::Unit& u, int wr, int wc, int fr0, int fq0) const {
        int fr = fr0, fq = fq0; asm volatile("" : "+v"(fr), "+v"(fq));
        bf16* GP = (bf16*)(ws + WS_GP); bf16* VAL = GP + (size_t)MT * DFF; bf16* ACT = GP + (size_t)2 * MT * DFF;
        if (u.pn < 11) {
            EPI_LOOP_BEGIN const int c = u.pn * 256 + ct; *(v4u*)(GP + (size_t)row * DFF + c) = pack8(v0, v1);
                if (row < PM) { const int t = row & (PT - 1); if (t >= PT - 2) { float* q = out + OUT_FC_P + (((size_t)l * PB + (row >> 12)) * 2 + (t - (PT - 2))) * DFF + c; *(f32x4*)q = v0; *(f32x4*)(q + 4) = v1; } }
                else { const int i = (row - PM) & 7; if (i >= ST - 2) { float* q = out + OUT_FC_S + (((size_t)l * SB + ((row - PM) >> 3)) * 2 + (i - (ST - 2))) * DFF + c; *(f32x4*)q = v0; *(f32x4*)(q + 4) = v1; } }
            EPI_LOOP_END
        } else if (u.pm * 256 >= PM) {
#pragma unroll
            for (int bj = 0; bj < 2; ++bj) { const int c = (u.pn - 11) * 256 + bj * 128 + wc * 32 + 8 * fq;
                const f32x4 w0a = *(const f32x4*)(cw + c), w0b = *(const f32x4*)(cw + c + 4), w1a = *(const f32x4*)(cw + DFF + c), w1b = *(const f32x4*)(cw + DFF + c + 4);
                const f32x4 w2a = *(const f32x4*)(cw + 2 * DFF + c), w2b = *(const f32x4*)(cw + 2 * DFF + c + 4), ba = *(const f32x4*)(cbi + c), bb = *(const f32x4*)(cbi + c + 4);
#pragma unroll
                for (int ai = 0; ai < 2; ++ai)
#pragma unroll
                  for (int mh = 0; mh < 2; ++mh) {
                    v4u g0[2], g1[2], g2[2];
#pragma unroll
                    for (int m2 = 0; m2 < 2; ++m2) { const int row = u.pm * 256 + ai * 128 + wr * 64 + (2 * mh + m2) * 16 + fr; const bf16* gp = GP + (size_t)row * DFF + c;
                        const bf16* sb = sfb + (size_t)((row - PM) >> 3) * 2 * DFF + c; const int i = (row - PM) & 7;
                        const bf16* q1 = (i < 1) ? sb + DFF : gp - DFF; const bf16* q2 = (i < 2) ? (i == 1 ? sb + DFF : sb) : gp - 2 * DFF;
                        g0[m2] = *(const v4u*)gp; g1[m2] = *(const v4u*)q1; g2[m2] = *(const v4u*)q2; }
#pragma unroll
                    for (int m2 = 0; m2 < 2; ++m2) { const int m = 2 * mh + m2; const int row = u.pm * 256 + ai * 128 + wr * 64 + m * 16 + fr; const int t = row & (PT - 1);
                        const f32x4 v0 = acc[ai][bj][m][0], v1 = acc[ai][bj][m][1];
                        if (false) { *(v4u*)(VAL + (size_t)row * DFF + c) = pack8(v0, v1); }
                        else { f32x4 xa, xb, pa, pb, qa, qb; unpack8(g0[m2], xa, xb); unpack8(g1[m2], pa, pb); unpack8(g2[m2], qa, qb);
                            f32x4 ya = ba + w0a * qa + w1a * pa + w2a * xa, yb = bb + w0b * qb + w1b * pb + w2b * xb;
#pragma unroll
                            for (int i = 0; i < 4; ++i) { ya[i] = siluf_(ya[i]) * v0[i]; yb[i] = siluf_(yb[i]) * v1[i]; }
                            *(v4u*)(ACT + (size_t)row * DFF + c) = pack8(ya, yb); } }
                  }
            }
                } else {
#pragma unroll
            for (int bj = 0; bj < 2; ++bj) { const int c = (u.pn - 11) * 256 + bj * 128 + wc * 32 + 8 * fq;
                const f32x4 w0a = *(const f32x4*)(cw + c), w0b = *(const f32x4*)(cw + c + 4), w1a = *(const f32x4*)(cw + DFF + c), w1b = *(const f32x4*)(cw + DFF + c + 4);
                const f32x4 w2a = *(const f32x4*)(cw + 2 * DFF + c), w2b = *(const f32x4*)(cw + 2 * DFF + c + 4), ba = *(const f32x4*)(cbi + c), bb = *(const f32x4*)(cbi + c + 4);
#pragma unroll
                for (int ai = 0; ai < 2; ++ai)
#pragma unroll
                  for (int mh = 0; mh < 2; ++mh) {
                    v4u g0[2], g1[2], g2[2];
#pragma unroll
                    for (int m2 = 0; m2 < 2; ++m2) { const int row = u.pm * 256 + ai * 128 + wr * 64 + (2 * mh + m2) * 16 + fr; const bf16* gp = GP + (size_t)row * DFF + c;
                        const int t = row & (PT - 1);
                        g0[m2] = *(const v4u*)gp;
                        g1[m2] = (t >= 1) ? *(const v4u*)(gp - DFF) : (v4u){0u, 0u, 0u, 0u};
                        g2[m2] = (t >= 2) ? *(const v4u*)(gp - 2 * DFF) : (v4u){0u, 0u, 0u, 0u}; }
#pragma unroll
                    for (int m2 = 0; m2 < 2; ++m2) { const int m = 2 * mh + m2; const int row = u.pm * 256 + ai * 128 + wr * 64 + m * 16 + fr; const int t = row & (PT - 1);
                        const f32x4 v0 = acc[ai][bj][m][0], v1 = acc[ai][bj][m][1];
                        if ((t & 255) < 2 && t >= 2) { *(v4u*)(VAL + (size_t)row * DFF + c) = pack8(v0, v1); }
                        else { f32x4 xa, xb, pa, pb, qa, qb; unpack8(g0[m2], xa, xb); unpack8(g1[m2], pa, pb); unpack8(g2[m2], qa, qb);
                            f32x4 ya = ba + w0a * qa + w1a * pa + w2a * xa, yb = bb + w0b * qb + w1b * pb + w2b * xb;
#pragma unroll
                            for (int i = 0; i < 4; ++i) { ya[i] = siluf_(ya[i]) * v0[i]; yb[i] = siluf_(yb[i]) * v1[i]; }
                            *(v4u*)(ACT + (size_t)row * DFF + c) = pack8(ya, yb); } }
                  }
            }
        }
    }
};

__device__ __forceinline__ f32x16 mfma32(bf16x8 a, bf16x8 b, f32x16 c) { return __builtin_amdgcn_mfma_f32_32x32x16_bf16(a, b, c, 0, 0, 0); }
__device__ __forceinline__ f32x4 mfma16(bf16x8 a, bf16x8 b, f32x4 c) { return __builtin_amdgcn_mfma_f32_16x16x32_bf16(a, b, c, 0, 0, 0); }
__device__ __forceinline__ float ret_log_g(int h) { return log1pf(-exp2f(-5.0f - (float)h)); }
__device__ __forceinline__ bf16x8 tr_frag(const LAS unsigned char* base, int rs_bytes, int rowA, int rowB, int colbase, int lane) {
    const int q = (lane & 15) >> 2, p = lane & 3;
    const LAS unsigned char* pa = base + (rowA + q) * rs_bytes + (colbase + 4 * p) * 2;
    const LAS unsigned char* pb = base + (rowB + q) * rs_bytes + (colbase + 4 * p) * 2;
    const s16x4 a = __builtin_bit_cast(s16x4, __builtin_amdgcn_ds_read_tr16_b64_v4i16((LAS s16x4*)pa));
    const s16x4 b = __builtin_bit_cast(s16x4, __builtin_amdgcn_ds_read_tr16_b64_v4i16((LAS s16x4*)pb));
    return (bf16x8){a[0], a[1], a[2], a[3], b[0], b[1], b[2], b[3]};
}
__device__ __forceinline__ bf16x8 cvt_frag(const f32x16& p, int s2) {
    u32x4 w; w.x = pk2(p[8 * s2 + 0], p[8 * s2 + 1]); w.y = pk2(p[8 * s2 + 2], p[8 * s2 + 3]); w.z = pk2(p[8 * s2 + 4], p[8 * s2 + 5]); w.w = pk2(p[8 * s2 + 6], p[8 * s2 + 7]);
    return __builtin_bit_cast(bf16x8, w);
}

__device__ __forceinline__ void cmp2_phase(Frame& F, int l) {
    const int gw = F.bid * NWAVES + F.wave, NGW = F.G * NWAVES, lane = F.lane, r = lane & 15, g = lane >> 4;
    const bf16* LH = WSP(bf16, WS_LH); bf16* CK = WSP(bf16, WS_CK);
    const int j = gw & 1, gwj = gw >> 1, NGJ = NGW >> 1;
    const bf16* W2T = WSP(bf16, WS_SMALLW + SW_W2T) + (size_t)(l * 2 + j) * 64 * 128; const float* CB = WSP(float, WS_SMALLW + SW_CB) + (l * 2 + j) * 128;
    bf16x8 wf[4][4];
#pragma unroll
    for (int ks = 0; ks < 4; ++ks)
#pragma unroll
        for (int ct = 0; ct < 4; ++ct) wf[ks][ct] = *(const bf16x8*)(W2T + (size_t)(16 * ct + r) * 128 + 32 * ks + 8 * g);
    for (int wu = gwj; wu < CMP_ROWS_J / 16; wu += NGJ) {
        const int rj0 = wu * 16, rj = rj0 + r; const size_t row = (size_t)j * CMP_ROWS_J + rj;
        const bool valid = (rj < 32768) ? ((rj & 511) < 511) : (((rj - 32768) & 255) < 255);
        v4u la[4], lb[4];
#pragma unroll
        for (int ks = 0; ks < 4; ++ks) { const int h0 = 32 * ks + 8 * g; la[ks] = *(const v4u*)(LH + row * 256 + h0); lb[ks] = *(const v4u*)(LH + (row + 1) * 256 + 128 + h0); }
        f32x4 acc[4];
#pragma unroll
        for (int ct = 0; ct < 4; ++ct) acc[ct] = (f32x4){0.f, 0.f, 0.f, 0.f};
#pragma unroll
        for (int ks = 0; ks < 4; ++ks) {
            const int h0 = 32 * ks + 8 * g; f32x4 a0, a1, b0, b1;
            unpack8(la[ks], a0, a1); unpack8(lb[ks], b0, b1);
            const f32x4 c0 = *(const f32x4*)(CB + h0), c1 = *(const f32x4*)(CB + h0 + 4);
            f32x4 x0 = a0 + b0 + c0, x1 = a1 + b1 + c1;
#pragma unroll
            for (int i = 0; i < 4; ++i) { x0[i] = gelu_tanh(x0[i]); x1[i] = gelu_tanh(x1[i]); }
            const bf16x8 hf = __builtin_bit_cast(bf16x8, pack8(x0, x1));
#pragma unroll
            for (int ct = 0; ct < 4; ++ct) acc[ct] = mfma16(wf[ks][ct], hf, acc[ct]);
        }
#pragma unroll
        for (int ct = 0; ct < 4; ++ct) { const f32x4 v = valid ? acc[ct] : (f32x4){0.f, 0.f, 0.f, 0.f}; v2u w; w.x = pk2(v[0], v[1]); w.y = pk2(v[2], v[3]);
            *(v2u*)(CK + row * 64 + 16 * ct + 4 * g) = w; }
    }
}

constexpr int CG_RS = 144, CG_BUF = 256 * CG_RS, CG_AW = 2 * CG_BUF, CG_AT = 32 * CG_RS;
static_assert(CG_AW + 2 * 4 * CG_AT <= RING_BYTES, "compress GEMM LDS map");
template <bool smp> __device__ __forceinline__ void cmp_gemm_unit(Frame& F, int l, int j, int grp, int n00) {
    const int tid = F.tid, lane = F.lane, w = F.wave, q = lane & 31, h_ = lane >> 5, rg = w >> 1, ch = w & 1;
    const float* rp[4]; const bf16* ab = nullptr;
    if (smp) { const int db = grp >> 1, k = grp & 1;
#pragma unroll
        for (int i = 0; i < 4; ++i) { const int tt0 = (n00 + 32 * rg + 16 * ch + 4 * i + (lane >> 4)) * 16; const int page = ((const int*)F.a->in[I_PT])[db * NPG + (tt0 >> 7)];
            rp[i] = FIN(I_CACHE) + (((((size_t)l * NPHYS + page) * PAGE + (tt0 & 127)) * 4 + j) * 2 + k) * 64 + (lane & 15) * 4; } }
    else {
        ab = WSP(bf16, WS_ACMP) + ((size_t)(l * 2 + j) * CMP_ROWS_J + 32768 + grp * 256 + n00 + 32 * rg + 16 * ch + (lane >> 3)) * 1024 + (lane & 7) * 8;
#pragma unroll
        for (int i = 0; i < 4; ++i) rp[i] = nullptr; }
    const bf16* Bg = WSP(bf16, WS_SMALLW + SW_W1T) + (size_t)(l * 2 + j) * 256 * 1024;
    f32x16 acc[4];
#pragma unroll
    for (int ct = 0; ct < 4; ++ct) acc[ct] = (f32x16){};
    const bf16* bsrc = Bg + (size_t)(tid >> 1) * 1024 + (tid & 1) * 32; LAS unsigned char* bdst = F.lds + (tid >> 1) * CG_RS + (tid & 1) * 64;
    v4u bst[2][4]; f32x4 an[4][4]; v4u anb[4][2];
    __syncthreads();
#pragma unroll
    for (int x = 0; x < 4; ++x) bst[0][x] = *(const v4u*)(bsrc + 8 * x);
#pragma unroll
    for (int x = 0; x < 4; ++x) bst[1][x] = *(const v4u*)(bsrc + 64 + 8 * x);
#pragma unroll
    for (int d = 0; d < 4; ++d) {
        if (smp) {
#pragma unroll
            for (int i = 0; i < 4; ++i) an[d][i] = __builtin_nontemporal_load((const f32x4*)(rp[i] + (size_t)d * 512)); }
        else {
#pragma unroll
            for (int i = 0; i < 2; ++i) anb[d][i] = *(const v4u*)(ab + (size_t)(8 * i) * 1024 + d * 64); } }
#pragma unroll
    for (int x = 0; x < 4; ++x) *(LAS v4u*)(bdst + x * 16) = bst[0][x];
#define CG_CHUNK(d, LAST_) { const int kc = kc4 + (d); \
            LAS unsigned char* At = F.lds + CG_AW + (((d) & 1) * 4 + rg) * CG_AT; \
            if (!(LAST_) || (d) < 2) {                                   \
                _Pragma("unroll") for (int x = 0; x < 4; ++x) bst[(d) & 1][x] = *(const v4u*)(bsrc + (kc + 2) * 64 + 8 * x); } \
            if (smp) { \
                _Pragma("unroll") for (int i = 0; i < 4; ++i) { v2u o; o.x = pk2(an[d][i][0], an[d][i][1]); o.y = pk2(an[d][i][2], an[d][i][3]); *(LAS v2u*)(At + (16 * ch + 4 * i + (lane >> 4)) * CG_RS + (lane & 15) * 8) = o; } \
                if (!(LAST_)) { _Pragma("unroll") for (int i = 0; i < 4; ++i) an[d][i] = __builtin_nontemporal_load((const f32x4*)(rp[i] + (size_t)(kc + 4) * 512)); } \
            } else { \
                _Pragma("unroll") for (int i = 0; i < 2; ++i) *(LAS v4u*)(At + (16 * ch + 8 * i + (lane >> 3)) * CG_RS + (lane & 7) * 16) = anb[d][i]; \
                if (!(LAST_)) { _Pragma("unroll") for (int i = 0; i < 2; ++i) anb[d][i] = *(const v4u*)(ab + (size_t)(8 * i) * 1024 + (kc + 4) * 64); } \
            } \
            __syncthreads();                                           \
            bf16x8 ac[4]; \
            _Pragma("unroll") for (int ks = 0; ks < 4; ++ks) ac[ks] = *(const LAS bf16x8*)(At + q * CG_RS + ks * 32 + 16 * h_); \
            const LAS unsigned char* bb = F.lds + ((d) & 1) * CG_BUF + (128 * ch + q) * CG_RS + 16 * h_; \
            _Pragma("unroll") for (int ks = 0; ks < 4; ++ks) \
                _Pragma("unroll") for (int ct = 0; ct < 4; ++ct) { const bf16x8 bf = *(const LAS bf16x8*)(bb + ct * 32 * CG_RS + ks * 32); acc[ct] = mfma32(bf, ac[ks], acc[ct]); } \
            if (!(LAST_) || (d) < 3) { _Pragma("unroll") for (int x = 0; x < 4; ++x) *(LAS v4u*)(bdst + (((d) + 1) & 1) * CG_BUF + x * 16) = bst[((d) + 1) & 1][x]; } }
    int kc4 = 0;
#pragma unroll 1
    for (; kc4 < 12; kc4 += 4) { CG_CHUNK(0, false) CG_CHUNK(1, false) CG_CHUNK(2, false) CG_CHUNK(3, false) }
    { CG_CHUNK(0, true) CG_CHUNK(1, true) CG_CHUNK(2, true) CG_CHUNK(3, true) }
#undef CG_CHUNK
    bf16* LH = WSP(bf16, WS_LH) + ((size_t)j * CMP_ROWS_J + (smp ? grp * 512 : 32768 + grp * 256) + n00 + 32 * rg + q) * 256 + 128 * ch;
#pragma unroll
    for (int ct = 0; ct < 4; ++ct)
#pragma unroll
        for (int r4 = 0; r4 < 4; ++r4) { v2u o; o.x = pk2(acc[ct][4 * r4 + 0], acc[ct][4 * r4 + 1]); o.y = pk2(acc[ct][4 * r4 + 2], acc[ct][4 * r4 + 3]); *(v2u*)(LH + ct * 32 + 8 * r4 + 4 * h_) = o; }
}

constexpr int RS_KV = 272;
__device__ __forceinline__ void ret_local_unit(Frame& F, int unit) {
    const int bh = unit >> 5, c = unit & 31, b = bh >> 2, h = bh & 3, lane = F.lane, w = F.wave;
    const float lg = ret_log_g(h);
    LAS unsigned char* KS = F.lds; LAS unsigned char* VS = F.lds + 128 * RS_KV;
    const bf16* RK = WSP(bf16, WS_RQ) + (size_t)MT * 512; const bf16* RV = WSP(bf16, WS_RQ) + (size_t)2 * MT * 512;
    __syncthreads();
#pragma unroll
    for (int i = 0; i < 4; ++i) { const int p = F.tid + NTHR * i, j = p >> 4, ch = p & 15; const size_t go = (size_t)(b * PT + 128 * c + j) * 512 + h * 128 + ch * 8;
        f32x4 k0, k1; unpack8(*(const v4u*)(RK + go), k0, k1); const float kw = fexp((float)(127 - j) * lg);
        *(LAS v4u*)(KS + j * RS_KV + ch * 16) = pack8(k0 * kw, k1 * kw);
        *(LAS v4u*)(VS + j * RS_KV + ch * 16) = *(const v4u*)(RV + go); }
    __syncthreads();
    const int et = w >> 1, dt0 = 2 * (w & 1), h_ = lane >> 5, blk = (lane >> 4) & 1;
    f32x16 acc[2]; acc[0] = (f32x16){}; acc[1] = (f32x16){};
#pragma unroll
    for (int ks = 0; ks < 8; ++ks) {
        const int rA = 16 * ks + 8 * h_;
        const bf16x8 af = tr_frag(VS, RS_KV, rA, rA + 4, 32 * et + 16 * blk, lane);
#pragma unroll
        for (int dd = 0; dd < 2; ++dd) { const bf16x8 bfr = tr_frag(KS, RS_KV, rA, rA + 4, 32 * (dt0 + dd) + 16 * blk, lane); acc[dd] = mfma32(af, bfr, acc[dd]); }
    }
    bf16* LT = WSP(bf16, WS_LT) + ((size_t)bh * 32 + c) * 16384;
#pragma unroll
    for (int dd = 0; dd < 2; ++dd)
#pragma unroll
        for (int r = 0; r < 16; ++r) { const int e = 32 * et + (r & 3) + 8 * (r >> 2) + 4 * h_; LT[e * 128 + 32 * (dt0 + dd) + (lane & 31)] = (bf16)(pk2(acc[dd][r], 0.f) & 0xffffu); }
}
__device__ __forceinline__ void ret_scan_phase(Frame& F, int l) {
    const bf16* LT = WSP(bf16, WS_LT); bf16* SPT = WSP(bf16, WS_SPT);
    for (int idx = F.bid * NTHR + F.tid; idx < 16 * 16384; idx += F.G * NTHR) {
        const int bh = idx >> 14, ed = idx & 16383, e = ed >> 7, d = ed & 127, h = bh & 3; const float g128 = fexp(128.0f * ret_log_g(h));
        float S = 0.f;
        for (int c = 0; c < 32; ++c) { const size_t o = ((size_t)bh * 32 + c) * 16384 + ed; SPT[o] = (bf16)(pk2(S, 0.f) & 0xffffu); S = S * g128 + bf1(LT[o]); }
        F.out[OUT_RET_P + ((size_t)l * 16 + bh) * 16384 + d * 128 + e] = S;
    }
}
__device__ __forceinline__ void ret_out_unit(Frame& F, int l, int unit) {
    const int bh = unit >> 5, c = unit & 31, b = bh >> 2, h = bh & 3, lane = F.lane, w = F.wave, tid = F.tid;
    const float lg = ret_log_g(h);
    LAS unsigned char* KS = F.lds; LAS unsigned char* VS = F.lds + 128 * RS_KV; LAS float* OT = (LAS float*)F.lds; LAS float* STAT = (LAS float*)(F.lds + 2 * 128 * RS_KV);
    const bf16* RQ = WSP(bf16, WS_RQ); const bf16* RK = RQ + (size_t)MT * 512; const bf16* RV = RQ + (size_t)2 * MT * 512; const bf16* RG = RQ + (size_t)3 * MT * 512;
    const size_t row0 = (size_t)b * PT + 128 * c;
    __syncthreads();
#pragma unroll
    for (int i = 0; i < 4; ++i) { const int p = tid + NTHR * i, j = p >> 4, ch = p & 15; const size_t go = (row0 + j) * 512 + h * 128 + ch * 8;
        *(LAS v4u*)(KS + j * RS_KV + ch * 16) = *(const v4u*)(RK + go); *(LAS v4u*)(VS + j * RS_KV + ch * 16) = *(const v4u*)(RV + go); }
    const int it = w & 3, eh = w >> 2, h_ = lane >> 5, blk = (lane >> 4) & 1, il = 32 * it + (lane & 31);
    bf16x8 qf[8];
#pragma unroll
    for (int ks = 0; ks < 8; ++ks) qf[ks] = *(const bf16x8*)(RQ + (row0 + il) * 512 + h * 128 + 16 * ks + 8 * h_);
    f32x16 acc[2]; acc[0] = (f32x16){}; acc[1] = (f32x16){};
    const bf16* SP = WSP(bf16, WS_SPT) + ((size_t)bh * 32 + c) * 16384;
#pragma unroll
    for (int kb4 = 0; kb4 < 8; kb4 += 4) {
        bf16x8 af[4][2];
#pragma unroll
        for (int ks = 0; ks < 4; ++ks)
#pragma unroll
            for (int e2 = 0; e2 < 2; ++e2) af[ks][e2] = *(const bf16x8*)(SP + (size_t)(32 * (2 * eh + e2) + (lane & 31)) * 128 + 16 * (kb4 + ks) + 8 * h_);
#pragma unroll
        for (int ks = 0; ks < 4; ++ks)
#pragma unroll
            for (int e2 = 0; e2 < 2; ++e2) acc[e2] = mfma32(af[ks][e2], qf[kb4 + ks], acc[e2]);
    }
    { const float cr = fexp((float)(il + 1) * lg); acc[0] *= cr; acc[1] *= cr; }
    __syncthreads();
    for (int jt = 0; jt <= it; ++jt) {
        f32x16 s = (f32x16){};
#pragma unroll
        for (int ks = 0; ks < 8; ++ks) { const bf16x8 kf = *(const LAS bf16x8*)(KS + (32 * jt + (lane & 31)) * RS_KV + (16 * ks + 8 * h_) * 2); s = mfma32(kf, qf[ks], s); }
#pragma unroll
        for (int r = 0; r < 16; ++r) { const int j = 32 * jt + (r & 3) + 8 * (r >> 2) + 4 * h_; const int df = il - j; s[r] = (df >= 0) ? s[r] * fexp((float)df * lg) : 0.f; }
#pragma unroll
        for (int s2 = 0; s2 < 2; ++s2) { const bf16x8 pf = cvt_frag(s, s2); const int rA = 32 * jt + 16 * s2 + 4 * h_;
#pragma unroll
            for (int e2 = 0; e2 < 2; ++e2) { const bf16x8 vf = tr_frag(VS, RS_KV, rA, rA + 8, 32 * (2 * eh + e2) + 16 * blk, lane); acc[e2] = mfma32(vf, pf, acc[e2]); } }
    }
    float s1 = 0.f, s2 = 0.f;
#pragma unroll
    for (int e2 = 0; e2 < 2; ++e2)
#pragma unroll
        for (int r = 0; r < 16; ++r) { const float v = acc[e2][r]; s1 += v; s2 += v * v; }
    s1 += __shfl_xor(s1, 32); s2 += __shfl_xor(s2, 32);
    if (lane < 32) { STAT[(w * 32 + lane) * 2] = s1; STAT[(w * 32 + lane) * 2 + 1] = s2; }
    __syncthreads();
    { const int pw = w ^ 4; s1 += STAT[(pw * 32 + (lane & 31)) * 2]; s2 += STAT[(pw * 32 + (lane & 31)) * 2 + 1]; }
    const float mean = s1 * (1.0f / 128.0f), var = fmaxf(s2 * (1.0f / 128.0f) - mean * mean, 0.f), rstd = 1.0f / sqrtf(var + EPS);
#pragma unroll
    for (int e2 = 0; e2 < 2; ++e2)
#pragma unroll
        for (int r4 = 0; r4 < 4; ++r4) { const int e = 32 * (2 * eh + e2) + 8 * r4 + 4 * h_;
            f32x4 v; v[0] = (acc[e2][4 * r4 + 0] - mean) * rstd; v[1] = (acc[e2][4 * r4 + 1] - mean) * rstd; v[2] = (acc[e2][4 * r4 + 2] - mean) * rstd; v[3] = (acc[e2][4 * r4 + 3] - mean) * rstd;
            *(LAS f32x4*)(OT + il * 132 + e) = v; }
    __syncthreads();
    const float* GN = FIN(I_GNG) + l * 512 + h * 128; bf16* OR_ = WSP(bf16, WS_OA) + (size_t)MT * 512;
#pragma unroll
    for (int k = 0; k < 4; ++k) { const int q = tid + NTHR * k, i = q >> 4, ch = q & 15;
        const f32x4 o0 = *(const LAS f32x4*)(OT + i * 132 + 8 * ch), o1 = *(const LAS f32x4*)(OT + i * 132 + 8 * ch + 4);
        const f32x4 g0 = *(const f32x4*)(GN + 8 * ch), g1 = *(const f32x4*)(GN + 8 * ch + 4); f32x4 r0, r1; unpack8(*(const v4u*)(RG + (row0 + i) * 512 + h * 128 + 8 * ch), r0, r1);
        f32x4 y0, y1;
#pragma unroll
        for (int x = 0; x < 4; ++x) { y0[x] = o0[x] * g0[x] * siluf_(r0[x]); y1[x] = o1[x] * g1[x] * siluf_(r1[x]); }
        *(v4u*)(OR_ + (row0 + i) * 512 + h * 128 + 8 * ch) = pack8(y0, y1); }
}
__device__ __forceinline__ void ret_sample_unit(Frame& F, int l, int unit) {
    const int db = unit >> 2, h = unit & 3, tid = F.tid, e = tid & 127, dp = tid >> 7;
    const float lg = ret_log_g(h);
    LAS float* Q = (LAS float*)F.lds; LAS float* K = Q + 1024; LAS float* V = K + 1024; LAS float* GT = V + 1024; LAS float* CR = GT + 1024;
    LAS float* SC = CR + 4096; LAS float* RED = SC + 64;
    const bf16* RQ = WSP(bf16, WS_RQ); const size_t row0 = (size_t)PM + db * 8;
    __syncthreads();
    for (int i = tid; i < 4096; i += NTHR) { const int which = i >> 10, r = (i >> 7) & 7, d = i & 127; const float v = bf1(RQ[(size_t)which * MT * 512 + (row0 + r) * 512 + h * 128 + d]); Q[which * 1024 + r * 128 + d] = v; }
    __syncthreads();
    const float* S0 = FIN(I_SRET) + (((size_t)l * SB + db) * 4 + h) * 16384; float* SN = F.out + OUT_RET_S + (((size_t)l * SB + db) * 4 + h) * 16384;
    float kwv[8], cr[8];
#pragma unroll
    for (int j = 0; j < 8; ++j) { kwv[j] = V[j * 128 + e] * fexp((float)(7 - j) * lg); cr[j] = 0.f; }
    const float g8 = fexp(8.0f * lg);
    {   float s0v[32];
#pragma unroll
        for (int dd = 0; dd < 32; ++dd) s0v[dd] = S0[(dp * 32 + dd) * 128 + e];
#pragma unroll
        for (int dd = 0; dd < 32; ++dd) { const int d = dp * 32 + dd; const float s0 = s0v[dd]; float sn = g8 * s0;
#pragma unroll
            for (int j = 0; j < 8; ++j) { cr[j] += Q[j * 128 + d] * s0; sn += K[j * 128 + d] * kwv[j]; }
            SN[d * 128 + e] = sn; }
    }
#pragma unroll
    for (int i = 0; i < 8; ++i) CR[(dp * 8 + i) * 128 + e] = cr[i];
    if (tid < 64) { const int i = tid >> 3, j = tid & 7; float s = 0.f; if (j <= i) { for (int d = 0; d < 128; ++d) s += Q[i * 128 + d] * K[j * 128 + d]; s *= fexp((float)(i - j) * lg); } SC[tid] = s; }
    __syncthreads();
    float o[2];
#pragma unroll
    for (int ii = 0; ii < 2; ++ii) { const int i = 2 * dp + ii; float x = (CR[(0 * 8 + i) * 128 + e] + CR[(1 * 8 + i) * 128 + e] + CR[(2 * 8 + i) * 128 + e] + CR[(3 * 8 + i) * 128 + e]) * fexp((float)(i + 1) * lg);
        for (int j = 0; j <= i; ++j) x += SC[i * 8 + j] * V[j * 128 + e];
        o[ii] = x; }
#pragma unroll
    for (int ii = 0; ii < 2; ++ii) { const float a = wave_sum(o[ii]), q = wave_sum(o[ii] * o[ii]); if (F.lane == 0) { RED[(F.wave * 2 + ii) * 2] = a; RED[(F.wave * 2 + ii) * 2 + 1] = q; } }
    __syncthreads();
    const float* GN = FIN(I_GNG) + l * 512 + h * 128; bf16* OR_ = WSP(bf16, WS_OA) + (size_t)MT * 512;
#pragma unroll
    for (int ii = 0; ii < 2; ++ii) { const int i = 2 * dp + ii, w0 = 2 * dp; const float s1 = RED[(w0 * 2 + ii) * 2] + RED[((w0 + 1) * 2 + ii) * 2], s2 = RED[(w0 * 2 + ii) * 2 + 1] + RED[((w0 + 1) * 2 + ii) * 2 + 1];
        const float mean = s1 * (1.0f / 128.0f), var = fmaxf(s2 * (1.0f / 128.0f) - mean * mean, 0.f), rstd = 1.0f / sqrtf(var + EPS);
        const float y = (o[ii] - mean) * rstd * GN[e] * siluf_(GT[i * 128 + e]);
        OR_[(row0 + i) * 512 + h * 128 + e] = (bf16)(pk2(y, 0.f) & 0xffffu); }
}

template <int MODE> __device__ __forceinline__ void rglru_unit(Frame& F, int l, int unit) {
    const int tid = F.tid, c = tid, lane = F.lane, w = F.wave;
    LAS bf16* XC = (LAS bf16*)F.lds; LAS float* G = (LAS float*)(F.lds + 16384);
    const int seq = (MODE == 2) ? unit : (unit >> 6), tile = (MODE == 2) ? 0 : (unit & 63);
    const size_t row0 = (MODE == 2) ? (size_t)PM + seq * 8 : (size_t)seq * PT + tile * 64;
    const int ntok = (MODE == 2) ? 8 : 64, nsub = (MODE == 2) ? 1 : 4;
    const float* RX = WSP(float, WS_RX);
    const float w0 = FIN(I_RCW)[(l * 4 + 0) * 512 + c], w1 = FIN(I_RCW)[(l * 4 + 1) * 512 + c], w2 = FIN(I_RCW)[(l * 4 + 2) * 512 + c], w3 = FIN(I_RCW)[(l * 4 + 3) * 512 + c], cb = FIN(I_RCB)[l * 512 + c];
    const float ba = FIN(I_RBA)[l * 512 + c], bx = FIN(I_RBX)[l * 512 + c], sp = WSP(float, WS_SMALLW + SW_SP)[l * 512 + c];
    float x3, x2, x1;
    if (MODE == 2) { const float* cv = FIN(I_SCONV) + ((size_t)l * SB + seq) * 3 * 512; x3 = cv[c]; x2 = cv[512 + c]; x1 = cv[1024 + c]; }
    else if (tile == 0) { x3 = 0.f; x2 = 0.f; x1 = 0.f; }
    else { x3 = RX[(row0 - 3) * 512 + c]; x2 = RX[(row0 - 2) * 512 + c]; x1 = RX[(row0 - 1) * 512 + c]; }
    float h = (MODE == 0) ? 0.f : (MODE == 1) ? WSP(float, WS_CAR)[(size_t)4 * 64 * 2 * 512 + ((size_t)seq * 64 + tile) * 512 + c] : FIN(I_SH)[((size_t)l * SB + seq) * 512 + c];
    float aprod = 1.f;
    const int r16 = lane & 15, g4 = lane >> 4;
    bf16x8 wa[4][2], wx[4][2];
    { const bf16* WA = WSP(bf16, WS_SMALLW + SW_WAT) + ((size_t)(l * 2 + 0) * 8 + w) * 4096; const bf16* WX = WSP(bf16, WS_SMALLW + SW_WAT) + ((size_t)(l * 2 + 1) * 8 + w) * 4096;
#pragma unroll
      for (int ct = 0; ct < 4; ++ct)
#pragma unroll
          for (int ks = 0; ks < 2; ++ks) { wa[ct][ks] = *(const bf16x8*)(WA + (16 * ct + r16) * 64 + 32 * ks + 8 * g4); wx[ct][ks] = *(const bf16x8*)(WX + (16 * ct + r16) * 64 + 32 * ks + 8 * g4); } }
    const bf16* GG = WSP(bf16, WS_GG); bf16* OC = WSP(bf16, WS_OA) + (size_t)2 * MT * 512;
    __syncthreads();
    float xn[16]; bf16 gn[16];
#pragma unroll
    for (int tt = 0; tt < 16; ++tt) { xn[tt] = (tt < ntok) ? RX[(row0 + tt) * 512 + c] : 0.f; gn[tt] = (MODE != 0 && tt < ntok) ? GG[(row0 + tt) * 512 + c] : (bf16)0; }
    for (int s = 0; s < nsub; ++s) {
        float xc[16], gg[16];
#pragma unroll
        for (int tt = 0; tt < 16; ++tt) { xc[tt] = xn[tt]; gg[tt] = bf1(gn[tt]); }
        if (s + 1 < nsub) {
#pragma unroll
            for (int tt = 0; tt < 16; ++tt) { const int t = (s + 1) * 16 + tt; xn[tt] = RX[(row0 + t) * 512 + c]; gn[tt] = (MODE != 0) ? GG[(row0 + t) * 512 + c] : (bf16)0; } }
#pragma unroll
        for (int tt = 0; tt < 16; ++tt) { const float x0 = xc[tt];
            xc[tt] = cb + w0 * x3 + w1 * x2 + w2 * x1 + w3 * x0; x3 = x2; x2 = x1; x1 = x0; XC[tt * 512 + c] = (bf16)(pk2(xc[tt], 0.f) & 0xffffu); }
        LDS_WAIT(); asm volatile("" ::: "memory");
        {
            bf16x8 xf[2];
#pragma unroll
            for (int ks = 0; ks < 2; ++ks) xf[ks] = *(const LAS bf16x8*)(XC + r16 * 512 + w * 64 + 32 * ks + 8 * g4);
#pragma unroll
            for (int ct = 0; ct < 4; ++ct) { f32x4 da = (f32x4){0.f, 0.f, 0.f, 0.f}, dx = da;
#pragma unroll
                for (int ks = 0; ks < 2; ++ks) { da = mfma16(wa[ct][ks], xf[ks], da); dx = mfma16(wx[ct][ks], xf[ks], dx); }
                *(LAS f32x4*)(G + r16 * 512 + w * 64 + 16 * ct + 4 * g4) = da; *(LAS f32x4*)(G + 8192 + r16 * 512 + w * 64 + 16 * ct + 4 * g4) = dx; }
        }
        LDS_WAIT(); asm volatile("" ::: "memory");
#pragma unroll
        for (int tt = 0; tt < 16; ++tt) { const int t = s * 16 + tt;
            if (t < ntok) {
                const float r = sigmoidf_(G[tt * 512 + c] + ba), ig = sigmoidf_(G[8192 + tt * 512 + c] + bx);
                const float la = -8.0f * r * sp, a = fexp(la), bt = sqrtf(fmaxf(1.0f - a * a, 0.f)) * (ig * xc[tt]);
                h = a * h + bt; aprod *= a;
                if (MODE != 0) { const size_t o = (row0 + t) * 512 + c; OC[o] = (bf16)(pk2(h * gg[tt], 0.f) & 0xffffu); }
            } }
    }
    if (MODE == 0) { float* CAR = WSP(float, WS_CAR) + ((size_t)seq * 64 + tile) * 1024; CAR[c] = aprod; CAR[512 + c] = h; }
    if (MODE == 2) F.out[OUT_H_S + ((size_t)l * SB + seq) * 512 + c] = h;
}
__device__ __forceinline__ void rglru_carry_phase(Frame& F, int l) {
    const float* CAR = WSP(float, WS_CAR); float* HIN = WSP(float, WS_CAR) + (size_t)4 * 64 * 2 * 512;
    for (int idx = F.bid * NTHR + F.tid; idx < PB * 512; idx += F.G * NTHR) {
        const int b = idx >> 9, c = idx & 511; float h = 0.f;
#pragma unroll 1
        for (int t0 = 0; t0 < 64; t0 += 32) {
            float ca[32], cb[32];
#pragma unroll
            for (int t = 0; t < 32; ++t) { const float* cr = CAR + ((size_t)b * 64 + t0 + t) * 1024; ca[t] = cr[c]; cb[t] = cr[512 + c]; }
#pragma unroll
            for (int t = 0; t < 32; ++t) { HIN[((size_t)b * 64 + t0 + t) * 512 + c] = h; h = ca[t] * h + cb[t]; }
        }
        F.out[OUT_H_P + ((size_t)l * PB + b) * 512 + c] = h;
    }
}

__device__ __forceinline__ void convact_rows(Frame& F, int l, size_t row0, int nrows, bool smp) {
    const bf16* GP = WSP(bf16, WS_GP); const bf16* VAL = GP + (size_t)MT * DFF; bf16* ACT = WSP(bf16, WS_GP) + (size_t)2 * MT * DFF;
    const float* CW = FIN(I_FCW) + (size_t)l * 3 * DFF; const float* CBI = FIN(I_FCB) + (size_t)l * DFF;
    constexpr int NCG = DFF / 8;
    for (int it = F.tid; it < nrows * NCG; it += NTHR) {
        const int rr = it / NCG, c = (it % NCG) * 8; const size_t row = row0 + rr;
        f32x4 xa, xb, p1a, p1b, p2a, p2b, va, vb;
        const v4u gx = *(const v4u*)(GP + row * DFF + c), vx = *(const v4u*)(VAL + row * DFF + c);
        if (!smp) { v4u g1 = *(const v4u*)(GP + (row - 1) * DFF + c), g2 = *(const v4u*)(GP + (row - 2) * DFF + c); unpack8(g1, p1a, p1b); unpack8(g2, p2a, p2b); }
        else { const int sr = (int)(row - PM), seq = sr >> 3, i = sr & 7; const float* st = FIN(I_SFFN) + (((size_t)l * SB + seq) * 2) * DFF + c;
            if (i >= 1) unpack8(*(const v4u*)(GP + (row - 1) * DFF + c), p1a, p1b); else { p1a = *(const f32x4*)(st + DFF); p1b = *(const f32x4*)(st + DFF + 4); }
            if (i >= 2) unpack8(*(const v4u*)(GP + (row - 2) * DFF + c), p2a, p2b); else { const float* s2 = st + (i == 1 ? DFF : 0); p2a = *(const f32x4*)s2; p2b = *(const f32x4*)(s2 + 4); } }
        unpack8(gx, xa, xb); unpack8(vx, va, vb);
        const f32x4 w0a = *(const f32x4*)(CW + c), w0b = *(const f32x4*)(CW + c + 4), w1a = *(const f32x4*)(CW + DFF + c), w1b = *(const f32x4*)(CW + DFF + c + 4), w2a = *(const f32x4*)(CW + 2 * DFF + c), w2b = *(const f32x4*)(CW + 2 * DFF + c + 4);
        f32x4 ya = *(const f32x4*)(CBI + c) + w0a * p2a + w1a * p1a + w2a * xa, yb = *(const f32x4*)(CBI + c + 4) + w0b * p2b + w1b * p1b + w2b * xb;
#pragma unroll
        for (int k = 0; k < 4; ++k) { ya[k] = siluf_(ya[k]) * va[k]; yb[k] = siluf_(yb[k]) * vb[k]; }
        *(v4u*)(ACT + row * DFF + c) = pack8(ya, yb);
    }
}

constexpr int AT_RS = 144;
constexpr int AT_K0 = 0, AT_V0 = 2 * 64 * AT_RS, AT_PS = 4 * 64 * AT_RS, AT_IMP = AT_PS + 69632, AT_MASK = AT_IMP + 6144, AT_LIST = AT_MASK + 2048, AT_NL = AT_LIST + 1024;
constexpr unsigned AT_MARK = 0xFFFFu;
static_assert(AT_NL + 64 <= RING_BYTES, "attention LDS map");

struct TileRegs { v4u a, b, c, d; int mode; };

template <bool SMP> __device__ __forceinline__ void at_prefetch(const Frame& F, int l, int seq, int kvh, unsigned e, TileRegs& R) {
    const int kind = (int)(e >> 14), ti = (int)(e & 0x3fffu), rr = F.tid >> 3, pc = F.tid & 7;
    R.mode = 0;
    if (kind < 2) {
        const size_t rb = SMP ? (size_t)(seq * 2 + kvh) * 512 : (size_t)32768 + (size_t)(seq * 2 + kvh) * 256;
        const bf16* ck = WSP(bf16, WS_CK) + (rb + ti * 64 + rr) * 64 + pc * 8;
        R.a = *(const v4u*)ck; R.c = *(const v4u*)(ck + (size_t)CMP_ROWS_J * 64);
    } else if (!SMP) {
        const int jb = (kind == 2) ? 0 : 2;
        const bf16* kp = WSP(bf16, WS_KVB) + ((((size_t)jb * PB + seq) * 2 + kvh) * PT + ti * 64 + rr) * 64 + pc * 8;
        R.a = *(const v4u*)kp; R.c = *(const v4u*)(kp + (size_t)PB * 2 * PT * 64);
    } else if (kind == 2) {
        if (ti < 128) {
            const int page = ((const int*)F.a->in[I_PT])[seq * NPG + (ti >> 1)], slot = (ti & 1) * 64 + rr;
            const float* kp = FIN(I_CACHE) + (((((size_t)l * NPHYS + page) * PAGE + slot) * 4 + 2) * 2 + kvh) * 64 + pc * 8;
            R.a = *(const v4u*)kp; R.b = *(const v4u*)(kp + 4); R.c = *(const v4u*)(kp + 128); R.d = *(const v4u*)(kp + 132); R.mode = 1;
        } else if (rr < ST) {
            const bf16* kp = WSP(bf16, WS_KVS) + ((((size_t)0 * SB + seq) * 2 + kvh) * ST + rr) * 64 + pc * 8;
            R.a = *(const v4u*)kp; R.c = *(const v4u*)(kp + (size_t)SB * 2 * ST * 64);
        } else R.mode = 2;
    } else {
        if (ti < 8) {
            const float* kp = FIN(I_CWIN) + (((((size_t)l * SB + seq) * WINB + ti * 64 + rr) * 2 + 0) * 2 + kvh) * 64 + pc * 8;
            R.a = *(const v4u*)kp; R.b = *(const v4u*)(kp + 4); R.c = *(const v4u*)(kp + 128); R.d = *(const v4u*)(kp + 132); R.mode = 1;
        } else if (rr < ST) {
            const bf16* kp = WSP(bf16, WS_KVS) + ((((size_t)2 * SB + seq) * 2 + kvh) * ST + rr) * 64 + pc * 8;
            R.a = *(const v4u*)kp; R.c = *(const v4u*)(kp + (size_t)SB * 2 * ST * 64);
        } else R.mode = 2;
    }
}
__device__ __forceinline__ void at_store(const Frame& F, int buf, const TileRegs& R) {
    const int rr = F.tid >> 3, pc = F.tid & 7; v4u k, v;
    if (R.mode == 0) { k = R.a; v = R.c; }
    else if (R.mode == 1) { k = pack8(__builtin_bit_cast(f32x4, R.a), __builtin_bit_cast(f32x4, R.b)); v = pack8(__builtin_bit_cast(f32x4, R.c), __builtin_bit_cast(f32x4, R.d)); }
    else { k = (v4u){0u, 0u, 0u, 0u}; v = k; }
    *(LAS v4u*)(F.lds + AT_K0 + buf * 64 * AT_RS + rr * AT_RS + pc * 16) = k;
    *(LAS v4u*)(F.lds + AT_V0 + buf * 64 * AT_RS + rr * AT_RS + pc * 16) = v;
}

template <bool SMP> __device__ __forceinline__ void attn_unit(Frame& F, int l, int unit) {
    const int tid = F.tid, lane = F.lane, w = F.wave;
    const int q = lane & 31, h_ = lane >> 5, blk = (lane >> 4) & 1, tl = q >> 2, hr = q & 3;
    int seq, kvh, qt;
    if (SMP) { seq = unit >> 1; kvh = unit & 1; qt = 128; } else { seq = unit >> 7; kvh = (unit >> 6) & 1; qt = unit & 63; }
    const int t0 = SMP ? PAST : qt * 64;
    const int tokl = SMP ? tl : 8 * w + tl, t = t0 + tokl;
    const size_t row = SMP ? (size_t)PM + seq * ST + tl : (size_t)seq * PT + t;
    const int head = kvh * 4 + hr;
    LAS float* PS = (LAS float*)(F.lds + AT_PS); LAS float* IMPw = (LAS float*)(F.lds + AT_IMP) + w * 192;
    LAS unsigned long long* MASKS = (LAS unsigned long long*)(F.lds + AT_MASK); LAS unsigned short* LIST = (LAS unsigned short*)(F.lds + AT_LIST); LAS int* NL = (LAS int*)(F.lds + AT_NL);
    constexpr int PSS = SMP ? 520 : 264;
    LAS float* PSw = SMP ? PS : PS + w * 8 * PSS;
    __syncthreads();
    bf16x8 qf[4];
    { const bf16* qp = WSP(bf16, WS_QN) + row * 512 + head * 64 + 8 * h_;
#pragma unroll
      for (int kk = 0; kk < 4; ++kk) qf[kk] = *(const bf16x8*)(qp + 16 * kk); }
    const float* ngp = WSP(float, WS_NG) + row * 24 + head * 3; const float g0 = ngp[0], g1 = ngp[1], g2 = ngp[2];
    if (!SMP) { for (int i = lane; i < 8 * PSS; i += 64) PSw[i] = 0.f; }
    const int ntc = SMP ? 8 : ((t0 + 32) >> 10) + 1;
    if (tid < 2 * ntc) LIST[tid] = (unsigned short)(((tid >= ntc ? 1u : 0u) << 14) | (unsigned)(tid >= ntc ? tid - ntc : tid));
    if (tid == 0) LIST[2 * ntc] = (unsigned short)AT_MARK;
    int nl = 2 * ntc + 1;
    TileRegs R;
    at_prefetch<SMP>(F, l, seq, kvh, (unsigned)0, R);
    at_store(F, 0, R);
    __syncthreads();
    float m = -INFINITY, lsum = 0.f, invden = 0.f;
    f32x16 O[2]; O[0] = (f32x16){}; O[1] = (f32x16){};
    LAS float* OAw = (LAS float*)(F.lds + AT_PS) + w * (SMP ? 2048 : 8 * PSS) + lane;
    unsigned long long mk0 = 0ull, mk1 = 0ull, wu = ~0ull;
    int cur_kind = -1, idx = 0;
#define AT_FINALIZE(kind) do { \
        if ((kind) == 0) { const float lt = lsum + __shfl_xor(lsum, 32); invden = lt > 0.f ? 1.0f / lt : 0.f; } \
        else if ((kind) == 1) { const float sc = g0 * invden; O[0] *= sc; O[1] *= sc; } \
        else if ((kind) == 2) { const float lt = lsum + __shfl_xor(lsum, 32); const float sc = (lt > 0.f ? 1.0f / lt : 0.f) * g1; \
            _Pragma("unroll") for (int r_ = 0; r_ < 16; ++r_) { OAw[r_ * 64] += O[0][r_] * sc; OAw[(16 + r_) * 64] += O[1][r_] * sc; } } } while (0)
    while (idx < nl) {
        const unsigned e = (unsigned)__builtin_amdgcn_readfirstlane((int)LIST[idx]);
        if (e == AT_MARK) {
            AT_FINALIZE(cur_kind); cur_kind = -1;
            LDS_WAIT(); asm volatile("" ::: "memory");
#pragma unroll 1
            for (int tk = 0; tk < 8; ++tk) {
                const LAS float* pr = PSw + tk * PSS;
                if (!SMP) {
                    const int s = lane; float imp = 0.f;
#pragma unroll
                    for (int n = 4 * s - 1; n <= 4 * s + 3; ++n) if (n >= 0) imp += pr[n];
                    const bool forced = (s == 0) || (s == qt) || (s == qt - 1), avail = s <= qt;
                    const float val = avail ? (forced ? 1e4f : imp) : -1e4f;
                    IMPw[s] = val; LDS_WAIT(); asm volatile("" ::: "memory");
                    int rank = 0;
#pragma unroll 8
                    for (int i = 0; i < 64; ++i) { const float v = IMPw[i]; rank += (v > val || (v == val && i < s)) ? 1 : 0; }
                    const unsigned long long mk = __ballot(rank < 16);
                    if (lane == 0) MASKS[(8 * w + tk) * 4] = mk;
                    LDS_WAIT(); asm volatile("" ::: "memory");
                } else {
                    const int sa = lane, sb = lane + 64; float ia = 0.f, ib = 0.f;
#pragma unroll
                    for (int n = 4 * sa - 1; n <= 4 * sa + 3; ++n) if (n >= 0) ia += pr[n];
#pragma unroll
                    for (int n = 4 * sb - 1; n <= 4 * sb + 3; ++n) ib += pr[n];
                    const bool fa = (sa == 0), fb = (sb == 127);
                    const float va = fa ? 1e4f : ia, vb = fb ? 1e4f : ib;
                    IMPw[sa] = va; IMPw[sb] = vb; LDS_WAIT(); asm volatile("" ::: "memory");
                    int ra = fa ? 0 : 1, rb = fb ? 0 : 1;
#pragma unroll 8
                    for (int i = 0; i < 128; ++i) { const float v = IMPw[i]; ra += (v > va || (v == va && i < sa)) ? 1 : 0; rb += (v > vb || (v == vb && i < sb)) ? 1 : 0; }
                    const unsigned long long ma = __ballot(ra < 16), mb = __ballot(rb < 16);
                    if (lane == 0) { MASKS[tk * 4] = ma; MASKS[tk * 4 + 1] = mb; MASKS[tk * 4 + 2] = 1ull; }
                    LDS_WAIT(); asm volatile("" ::: "memory");
                }
            }
            __syncthreads();
#pragma unroll
            for (int r_ = 0; r_ < 16; ++r_) { OAw[r_ * 64] = O[0][r_]; OAw[(16 + r_) * 64] = O[1][r_]; }
            if (tid == 0) {
                int n = idx + 1;
                if (!SMP) { unsigned long long U = 0ull; for (int i = 0; i < 64; ++i) U |= MASKS[i * 4];
                    for (int s = 0; s <= qt; ++s) if ((U >> s) & 1ull) LIST[n++] = (unsigned short)((2u << 14) | (unsigned)s);
                    for (int s = (qt > 8 ? qt - 8 : 0); s <= qt; ++s) LIST[n++] = (unsigned short)((3u << 14) | (unsigned)s);
                } else { unsigned long long U0 = 0ull, U1 = 0ull; for (int i = 0; i < 8; ++i) { U0 |= MASKS[i * 4]; U1 |= MASKS[i * 4 + 1]; }
                    for (int s = 0; s < 64; ++s) if ((U0 >> s) & 1ull) LIST[n++] = (unsigned short)((2u << 14) | (unsigned)s);
                    for (int s = 0; s < 64; ++s) if ((U1 >> s) & 1ull) LIST[n++] = (unsigned short)((2u << 14) | (unsigned)(64 + s));
                    LIST[n++] = (unsigned short)((2u << 14) | 128u);
                    for (int s = 0; s <= 8; ++s) LIST[n++] = (unsigned short)((3u << 14) | (unsigned)s); }
                NL[0] = n;
            }
            __syncthreads();
            nl = __builtin_amdgcn_readfirstlane(NL[0]);
            mk0 = MASKS[tokl * 4]; if (SMP) { mk1 = MASKS[tokl * 4 + 1]; }
            if (!SMP) { unsigned long long u = 0ull; for (int i = 0; i < 8; ++i) u |= MASKS[(8 * w + i) * 4]; wu = u; }
            if (idx + 1 < nl) { at_prefetch<SMP>(F, l, seq, kvh, (unsigned)LIST[idx + 1], R); at_store(F, (idx + 1) & 1, R); }
            __syncthreads();
            ++idx; continue;
        }
        const int kind = (int)(e >> 14), ti = (int)(e & 0x3fffu);
        if (kind != cur_kind) {
            if (cur_kind >= 0) AT_FINALIZE(cur_kind);
            if (kind != 1) m = -INFINITY;
            lsum = 0.f; O[0] = (f32x16){}; O[1] = (f32x16){}; cur_kind = kind;
        }
        const unsigned en = (idx + 1 < nl) ? (unsigned)__builtin_amdgcn_readfirstlane((int)LIST[idx + 1]) : AT_MARK;
        const bool have_next = (en != AT_MARK);
        if (have_next) at_prefetch<SMP>(F, l, seq, kvh, en, R);
        bool active = true;
        if (!SMP && kind == 2) active = ((wu >> ti) & 1ull) != 0ull;
        if (active) {
            const LAS unsigned char* Kb = F.lds + AT_K0 + (idx & 1) * 64 * AT_RS; const LAS unsigned char* Vb = F.lds + AT_V0 + (idx & 1) * 64 * AT_RS;
            int lo, hi; const int kb = 64 * ti;
            if (kind < 2) { lo = 0; hi = SMP ? 510 : ((t >= 31) ? ((t - 31) >> 4) : -1); }
            else if (kind == 2) { lo = 0; const unsigned long long mw = (ti < 64) ? mk0 : ((ti < 128) ? mk1 : 1ull); hi = ((mw >> (ti & 63)) & 1ull) ? t : -1; }
            else { if (SMP) { lo = tl; hi = WINB + tl; } else { lo = t - WINB; hi = t; } }
            f32x16 s0 = (f32x16){}, s1 = (f32x16){};
#pragma unroll
            for (int kk = 0; kk < 4; ++kk) {
                const bf16x8 k0 = *(const LAS bf16x8*)(Kb + q * AT_RS + (16 * kk + 8 * h_) * 2), k1 = *(const LAS bf16x8*)(Kb + (32 + q) * AT_RS + (16 * kk + 8 * h_) * 2);
                s0 = mfma32(k0, qf[kk], s0); s1 = mfma32(k1, qf[kk], s1);
            }
            float tmax = -INFINITY;
#pragma unroll
            for (int r = 0; r < 16; ++r) { const int key = kb + (r & 3) + 8 * (r >> 2) + 4 * h_;
                s0[r] = (key >= lo && key <= hi) ? s0[r] : -INFINITY; s1[r] = (key + 32 >= lo && key + 32 <= hi) ? s1[r] : -INFINITY;
                tmax = fmaxf(tmax, fmaxf(s0[r], s1[r])); }
            tmax = fmaxf(tmax, __shfl_xor(tmax, 32));
            const float m_new = fmaxf(m, tmax), m_use = (m_new == -INFINITY) ? 0.f : m_new;
            const float alpha = fexp2(m - m_use);
            float ps = 0.f;
#pragma unroll
            for (int r = 0; r < 16; ++r) { s0[r] = fexp2(s0[r] - m_use); s1[r] = fexp2(s1[r] - m_use); ps += s0[r] + s1[r]; }
            lsum = lsum * alpha + ps; m = m_new;
            if (kind != 0) {
                O[0] *= alpha; O[1] *= alpha;
#pragma unroll
                for (int kt2 = 0; kt2 < 2; ++kt2)
#pragma unroll
                    for (int s2 = 0; s2 < 2; ++s2) { const bf16x8 pf = cvt_frag(kt2 ? s1 : s0, s2); const int rA = 32 * kt2 + 16 * s2 + 4 * h_;
#pragma unroll
                        for (int dt = 0; dt < 2; ++dt) { const bf16x8 vf = tr_frag(Vb, AT_RS, rA, rA + 8, 32 * dt + 16 * blk, lane); O[dt] = mfma32(vf, pf, O[dt]); } }
            }
            if (kind == 1) {
#pragma unroll
                for (int r = 0; r < 16; ++r) { const int n = kb + (r & 3) + 8 * (r >> 2) + 4 * h_;
                    float a = s0[r] * invden, b = s1[r] * invden; a += __shfl_xor(a, 1); b += __shfl_xor(b, 1); a += __shfl_xor(a, 2); b += __shfl_xor(b, 2);
                    if (hr == 0) { PSw[tl * PSS + n] = a; PSw[tl * PSS + n + 32] = b; } }
            }
        }
        if (have_next) at_store(F, (idx + 1) & 1, R);
        __syncthreads();
        ++idx;
    }
#undef AT_FINALIZE
    {
        const float lt = lsum + __shfl_xor(lsum, 32); const float sc = (lt > 0.f ? 1.0f / lt : 0.f) * g2;
        if (!SMP || w == 0) {
            bf16* op = WSP(bf16, WS_OA) + row * 512 + head * 64;
#pragma unroll
            for (int dt = 0; dt < 2; ++dt)
#pragma unroll
                for (int r4 = 0; r4 < 4; ++r4) { float o_[4];
#pragma unroll
                    for (int x = 0; x < 4; ++x) o_[x] = OAw[(dt * 16 + 4 * r4 + x) * 64] + O[dt][4 * r4 + x] * sc;
                    v2u wv; wv.x = pk2(o_[0], o_[1]); wv.y = pk2(o_[2], o_[3]); *(v2u*)(op + 32 * dt + 8 * r4 + 4 * h_) = wv; }
        }
    }
}

constexpr int AS_RS = 144;
constexpr int AS_V = 0, AS_VW = 32 * AS_RS, AS_MRG = 0, AS_PS = 73728, AS_IMP = AS_PS + 16640, AS_MASK = AS_IMP + 6144, AS_OA = AS_MASK + 512;
static_assert(8 * 34 * 64 * 4 <= AS_PS && AS_OA + 32 * 64 * 4 <= RING_BYTES, "sample attention LDS map");

__device__ __forceinline__ float xhalf_max(float x) { auto t_ = __builtin_amdgcn_permlane32_swap(__float_as_uint(x), __float_as_uint(x), false, false); return fmaxf(__uint_as_float(t_[0]), __uint_as_float(t_[1])); }
__device__ __forceinline__ float xhalf_sum(float x) { auto t_ = __builtin_amdgcn_permlane32_swap(__float_as_uint(x), __float_as_uint(x), false, false); return __uint_as_float(t_[0]) + __uint_as_float(t_[1]); }
struct ASrc { const float* kf; const float* vf; const bf16* kb; const bf16* vb; int rs; int nvalid; };
#define AS_TILE(SRC, KB0, LO_, HI_, DO_PV, DO_PS, m, lsum, O0, O1, invden, PSS_) do { \
        bf16x8 kfr[4]; f32x4 vx_[8]; \
        if ((SRC).kb) { const bf16* kp_ = (SRC).kb + (size_t)q * (SRC).rs + 8 * h_; _Pragma("unroll") for (int kk = 0; kk < 4; ++kk) kfr[kk] = *(const bf16x8*)(kp_ + 16 * kk); } \
        else {   \
            f32x4 kx_[8]; _Pragma("unroll") for (int x = 0; x < 8; ++x) kx_[x] = *(const f32x4*)((SRC).kf + (size_t)(4 * x + (lane >> 4)) * (SRC).rs + (lane & 15) * 4); \
            _Pragma("unroll") for (int x = 0; x < 8; ++x) { v2u o_; o_.x = pk2(kx_[x][0], kx_[x][1]); o_.y = pk2(kx_[x][2], kx_[x][3]); *(LAS v2u*)(Vw + (4 * x + (lane >> 4)) * AS_RS + (lane & 15) * 8) = o_; } \
            LDS_WAIT(); asm volatile("" ::: "memory"); \
            _Pragma("unroll") for (int kk = 0; kk < 4; ++kk) kfr[kk] = *(const LAS bf16x8*)(Vw + q * AS_RS + (16 * kk + 8 * h_) * 2); \
            LDS_WAIT(); asm volatile("" ::: "memory"); \
            if (DO_PV) { _Pragma("unroll") for (int x = 0; x < 8; ++x) vx_[x] = *(const f32x4*)((SRC).vf + (size_t)(4 * x + (lane >> 4)) * (SRC).rs + (lane & 15) * 4); } }     \
        if (DO_PV) { const int vr_ = lane >> 1, vh_ = lane & 1; v4u vv_[4]; \
            if (vr_ >= (SRC).nvalid) { _Pragma("unroll") for (int x = 0; x < 4; ++x) vv_[x] = (v4u){0u, 0u, 0u, 0u}; } \
            else if ((SRC).vb) { const bf16* vp_ = (SRC).vb + (size_t)vr_ * (SRC).rs + 32 * vh_; _Pragma("unroll") for (int x = 0; x < 4; ++x) vv_[x] = *(const v4u*)(vp_ + 8 * x); } \
            if ((SRC).vb || vr_ >= (SRC).nvalid) { _Pragma("unroll") for (int x = 0; x < 4; ++x) *(LAS v4u*)(Vw + vr_ * AS_RS + vh_ * 64 + x * 16) = vv_[x]; } } \
        f32x16 s_ = (f32x16){}; \
        _Pragma("unroll") for (int kk = 0; kk < 4; ++kk) s_ = mfma32(kfr[kk], qf[kk], s_); \
        float tmax_ = -INFINITY; \
        _Pragma("unroll") for (int r = 0; r < 16; ++r) { const int key_ = (KB0) + (r & 3) + 8 * (r >> 2) + 4 * h_; s_[r] = (key_ >= (LO_) && key_ <= (HI_)) ? s_[r] : -INFINITY; tmax_ = fmaxf(tmax_, s_[r]); } \
        tmax_ = xhalf_max(tmax_); \
        const float mn_ = fmaxf(m, tmax_), mu_ = (mn_ == -INFINITY) ? 0.f : mn_, al_ = fexp2(m - mu_); float ps_ = 0.f; \
        _Pragma("unroll") for (int r = 0; r < 16; ++r) { s_[r] = fexp2(s_[r] - mu_); ps_ += s_[r]; } \
        lsum = lsum * al_ + ps_; m = mn_; \
        if (DO_PV) { O0 *= al_; O1 *= al_; \
            if (!(SRC).vb) { _Pragma("unroll") for (int x = 0; x < 8; ++x) { v2u o_; o_.x = pk2(vx_[x][0], vx_[x][1]); o_.y = pk2(vx_[x][2], vx_[x][3]); *(LAS v2u*)(Vw + (4 * x + (lane >> 4)) * AS_RS + (lane & 15) * 8) = o_; } } \
            LDS_WAIT(); asm volatile("" ::: "memory"); \
            _Pragma("unroll") for (int s2 = 0; s2 < 2; ++s2) { const bf16x8 pf_ = cvt_frag(s_, s2); const int rA_ = 16 * s2 + 4 * h_; \
                O0 = mfma32(tr_frag(Vw, AS_RS, rA_, rA_ + 8, 16 * blk, lane), pf_, O0); O1 = mfma32(tr_frag(Vw, AS_RS, rA_, rA_ + 8, 32 + 16 * blk, lane), pf_, O1); } \
            LDS_WAIT(); asm volatile("" ::: "memory"); } \
        if (DO_PS) { _Pragma("unroll") for (int r = 0; r < 16; ++r) { const int n_ = (KB0) + (r & 3) + 8 * (r >> 2) + 4 * h_; float a_ = s_[r] * (invden); a_ += __shfl_xor(a_, 1); a_ += __shfl_xor(a_, 2); if (hr == 0) PS[tl * (PSS_) + n_] = a_; } } \
    } while (0)

__device__ __forceinline__ void attn_sample_unit(Frame& F, int l, int unit) {
    const int lane = F.lane, w = F.wave, tid = F.tid;
    const int q = lane & 31, h_ = lane >> 5, blk = (lane >> 4) & 1, tl = q >> 2, hr = q & 3;
    const int seq = unit >> 1, kvh = unit & 1, head = kvh * 4 + hr;
    const size_t row = (size_t)PM + seq * ST + tl;
    LAS unsigned char* Vw = F.lds + AS_V + w * AS_VW;
    LAS float* MRG = (LAS float*)(F.lds + AS_MRG);
    LAS float* PS = (LAS float*)(F.lds + AS_PS);
    LAS float* IMPw = (LAS float*)(F.lds + AS_IMP) + w * 192;
    LAS unsigned long long* MASKS = (LAS unsigned long long*)(F.lds + AS_MASK);
    __syncthreads();
    bf16x8 qf[4];
    { const bf16* qp = WSP(bf16, WS_QN) + row * 512 + head * 64 + 8 * h_;
#pragma unroll
      for (int kk = 0; kk < 4; ++kk) qf[kk] = *(const bf16x8*)(qp + 16 * kk); }
    const float* ngp = WSP(float, WS_NG) + row * 24 + head * 3; const float g0 = ngp[0], g1 = ngp[1], g2 = ngp[2];
    const int* ptab = (const int*)F.a->in[I_PT] + seq * NPG;
    LAS float* OAL = (LAS float*)(F.lds + AS_OA) + lane;

#define AS_PUBLISH(m, lsum, O0, O1) do { __syncthreads(); LAS float* mp_ = MRG + w * 34 * 64 + lane; mp_[0] = m; mp_[64] = lsum; \
        _Pragma("unroll") for (int r = 0; r < 16; ++r) { mp_[(2 + r) * 64] = O0[r]; mp_[(18 + r) * 64] = O1[r]; } __syncthreads(); } while (0)

    const bf16* CKk = WSP(bf16, WS_CK) + ((size_t)(seq * 2 + kvh) * 512) * 64; const bf16* CKv = CKk + (size_t)CMP_ROWS_J * 64;
    float mC = -INFINITY, lC = 0.f; f32x16 D0 = (f32x16){}, D1 = (f32x16){};
#pragma unroll 1
    for (int ti = w; ti < 16; ti += 8) { ASrc S{nullptr, nullptr, CKk + (size_t)ti * 32 * 64, CKv + (size_t)ti * 32 * 64, 64, 32}; AS_TILE(S, ti * 32, 0, 510, false, false, mC, lC, D0, D1, 0.f, 520); }
    { __syncthreads(); MRG[w * 128 + lane] = mC; MRG[w * 128 + 64 + lane] = xhalf_sum(lC); __syncthreads(); }
    float mT = -INFINITY;
#pragma unroll
    for (int x = 0; x < 8; ++x) mT = fmaxf(mT, MRG[x * 128 + lane]);
    float lT = 0.f;
#pragma unroll
    for (int x = 0; x < 8; ++x) { const float mx_ = MRG[x * 128 + lane]; lT += (mx_ == -INFINITY) ? 0.f : MRG[x * 128 + 64 + lane] * fexp2(mx_ - mT); }
    const float invC = lT > 0.f ? 1.0f / lT : 0.f;
    __syncthreads();
    { float mB = mT, lB = 0.f;
#pragma unroll 1
      for (int ti = w; ti < 16; ti += 8) { ASrc S{nullptr, nullptr, CKk + (size_t)ti * 32 * 64, CKv + (size_t)ti * 32 * 64, 64, 32}; AS_TILE(S, ti * 32, 0, 510, true, true, mB, lB, D0, D1, invC, 520); }
      AS_PUBLISH(mB, lB, D0, D1); }
    if (w == 0) { const float sc = g0 * invC; f32x16 T0 = (f32x16){}, T1 = (f32x16){};
#pragma unroll 1
      for (int x = 0; x < 8; ++x) { const LAS float* mp = MRG + x * 34 * 64 + lane;
#pragma unroll
          for (int r = 0; r < 16; ++r) { T0[r] += mp[(2 + r) * 64] * sc; T1[r] += mp[(18 + r) * 64] * sc; } }
#pragma unroll
      for (int r = 0; r < 16; ++r) { OAL[r * 64] = T0[r]; OAL[(16 + r) * 64] = T1[r]; } }
    {
        const LAS float* pr = PS + w * 520; const int sa = lane, sb = lane + 64; float ia = 0.f, ib = 0.f;
#pragma unroll
        for (int n = 4 * sa - 1; n <= 4 * sa + 3; ++n) if (n >= 0) ia += pr[n];
#pragma unroll
        for (int n = 4 * sb - 1; n <= 4 * sb + 3; ++n) ib += pr[n];
        const bool fa = (sa == 0), fb = (sb == 127); const float va = fa ? 1e4f : ia, vb = fb ? 1e4f : ib;
        IMPw[sa] = va; IMPw[sb] = vb; LDS_WAIT(); asm volatile("" ::: "memory");
        int ra = fa ? 0 : 1, rb = fb ? 0 : 1;
#pragma unroll 8
        for (int i = 0; i < 128; ++i) { const float v = IMPw[i]; ra += (v > va || (v == va && i < sa)) ? 1 : 0; rb += (v > vb || (v == vb && i < sb)) ? 1 : 0; }
        const unsigned long long ma = __ballot(ra < 16), mb = __ballot(rb < 16);
        if (lane == 0) { MASKS[w * 4] = ma; MASKS[w * 4 + 1] = mb; }
    }
    __syncthreads();
    const unsigned long long mk0 = MASKS[tl * 4], mk1 = MASKS[tl * 4 + 1];
    unsigned long long U0 = 0ull, U1 = 0ull;
#pragma unroll
    for (int x = 0; x < 8; ++x) { U0 |= MASKS[x * 4]; U1 |= MASKS[x * 4 + 1]; }
    {
        float m = -INFINITY, ls = 0.f; D0 = (f32x16){}; D1 = (f32x16){};
        const int t = PAST + tl; int cnt = 0;
#pragma unroll 1
        for (int s = 0; s <= 128; ++s) {
            const bool in_u = (s < 64) ? ((U0 >> s) & 1ull) : ((s < 128) ? ((U1 >> (s - 64)) & 1ull) : true);
            if (!in_u) continue;
            const bool selb = (s < 64) ? ((mk0 >> s) & 1ull) : ((s < 128) ? ((mk1 >> (s - 64)) & 1ull) : true);
            const int nh = (s < 128) ? 2 : 1;
            for (int hf = 0; hf < nh; ++hf, ++cnt) {
                if ((cnt & 7) != w) continue;
                const int hi = selb ? t : -1;
                if (s < 128) { const int page = ptab[s >> 1], slot = (s & 1) * 64 + hf * 32;
                    const float* kp = FIN(I_CACHE) + (((((size_t)l * NPHYS + page) * PAGE + slot) * 4 + 2) * 2 + kvh) * 64;
                    ASrc S{kp, kp + 128, nullptr, nullptr, 512, 32}; AS_TILE(S, s * 64 + hf * 32, 0, hi, true, false, m, ls, D0, D1, 0.f, 520); }
                else { const bf16* kp = WSP(bf16, WS_KVS) + ((((size_t)0 * SB + seq) * 2 + kvh) * ST) * 64;
                    ASrc S{nullptr, nullptr, kp, kp + (size_t)SB * 2 * ST * 64, 64, ST}; AS_TILE(S, PAST, 0, hi, true, false, m, ls, D0, D1, 0.f, 520); }
            }
        }
        AS_PUBLISH(m, ls, D0, D1);
        float mt = -INFINITY;
#pragma unroll
        for (int x = 0; x < 8; ++x) mt = fmaxf(mt, MRG[x * 34 * 64 + lane]);
        float lt = 0.f; f32x16 T0 = (f32x16){}, T1 = (f32x16){};
#pragma unroll 1
        for (int x = 0; x < 8; ++x) { const LAS float* mp = MRG + x * 34 * 64 + lane; const float mx_ = mp[0]; const float f = (mx_ == -INFINITY) ? 0.f : fexp2(mx_ - mt); lt += mp[64] * f;
#pragma unroll
            for (int r = 0; r < 16; ++r) { T0[r] += mp[(2 + r) * 64] * f; T1[r] += mp[(18 + r) * 64] * f; } }
        lt = xhalf_sum(lt); const float sc = (lt > 0.f ? 1.0f / lt : 0.f) * g1;
        if (w == 0) {
#pragma unroll
            for (int r = 0; r < 16; ++r) { OAL[r * 64] += T0[r] * sc; OAL[(16 + r) * 64] += T1[r] * sc; } }
    }
    {
        float m = -INFINITY, ls = 0.f; D0 = (f32x16){}; D1 = (f32x16){};
#pragma unroll 1
        for (int ti = w; ti < 17; ti += 8) {
            if (ti < 16) { const float* kp = FIN(I_CWIN) + (((((size_t)l * SB + seq) * WINB + ti * 32) * 2 + 0) * 2 + kvh) * 64;
                ASrc S{kp, kp + 128, nullptr, nullptr, 256, 32}; AS_TILE(S, ti * 32, tl, WINB + tl, true, false, m, ls, D0, D1, 0.f, 520); }
            else { const bf16* kp = WSP(bf16, WS_KVS) + ((((size_t)2 * SB + seq) * 2 + kvh) * ST) * 64;
                ASrc S{nullptr, nullptr, kp, kp + (size_t)SB * 2 * ST * 64, 64, ST}; AS_TILE(S, WINB, tl, WINB + tl, true, false, m, ls, D0, D1, 0.f, 520); }
        }
        AS_PUBLISH(m, ls, D0, D1);
        float mt = -INFINITY;
#pragma unroll
        for (int x = 0; x < 8; ++x) mt = fmaxf(mt, MRG[x * 34 * 64 + lane]);
        float lt = 0.f; f32x16 T0 = (f32x16){}, T1 = (f32x16){};
#pragma unroll 1
        for (int x = 0; x < 8; ++x) { const LAS float* mp = MRG + x * 34 * 64 + lane; const float mx_ = mp[0]; const float f = (mx_ == -INFINITY) ? 0.f : fexp2(mx_ - mt); lt += mp[64] * f;
#pragma unroll
            for (int r = 0; r < 16; ++r) { T0[r] += mp[(2 + r) * 64] * f; T1[r] += mp[(18 + r) * 64] * f; } }
        lt = xhalf_sum(lt); const float sc = (lt > 0.f ? 1.0f / lt : 0.f) * g2;
        if (w == 0) {
#pragma unroll
            for (int r = 0; r < 16; ++r) { OAL[r * 64] += T0[r] * sc; OAL[(16 + r) * 64] += T1[r] * sc; } }
    }
#undef AS_PUBLISH
    if (w == 0) {
        bf16* op = WSP(bf16, WS_OA) + row * 512 + head * 64;
#pragma unroll
        for (int r4 = 0; r4 < 4; ++r4) { float a_[4], b_[4];
#pragma unroll
            for (int x = 0; x < 4; ++x) { a_[x] = OAL[(4 * r4 + x) * 64]; b_[x] = OAL[(16 + 4 * r4 + x) * 64]; }
            v2u a, b; a.x = pk2(a_[0], a_[1]); a.y = pk2(a_[2], a_[3]); b.x = pk2(b_[0], b_[1]); b.y = pk2(b_[2], b_[3]);
            *(v2u*)(op + 8 * r4 + 4 * h_) = a; *(v2u*)(op + 32 + 8 * r4 + 4 * h_) = b; }
    }
}

#ifndef DBG_DUP
#define DBG_DUP 0
#endif
#if DBG_DUP == 1
#define AP_DUP_QK(NK) { f32x16 d_ = (f32x16){}; _Pragma("unroll") for (int kk = 0; kk < 4; ++kk) d_ = mfma32(NK[kk], qf[(kk + 1) & 3], d_); _Pragma("unroll") for (int r = 0; r < 16; ++r) s_[r] += zf * d_[r]; }
#else
#define AP_DUP_QK(NK)
#endif
#if DBG_DUP == 2
#define AP_DUP_EXP() { float acc_ = 0.f; _Pragma("unroll") for (int r = 0; r < 16; ++r) acc_ += fexp2(s_[r] * 0.5f - 3.0f); lsum += zf * acc_; }
#else
#define AP_DUP_EXP()
#endif
#if DBG_DUP == 3
#define AP_DUP_PV() { f32x16 e0_ = (f32x16){}, e1_ = (f32x16){}; _Pragma("unroll") for (int s2 = 0; s2 < 2; ++s2) { const bf16x8 pf_ = cvt_frag(s_, 1 - s2); const int rA_ = 16 * s2 + 4 * h_; \
        e0_ = mfma32(tr_frag(Vw, AS_RS, rA_ + 8, rA_, 16 * blk, lane), pf_, e0_); e1_ = mfma32(tr_frag(Vw, AS_RS, rA_ + 8, rA_, 32 + 16 * blk, lane), pf_, e1_); } D0 += e0_ * zf; D1 += e1_ * zf; }
#else
#define AP_DUP_PV()
#endif
constexpr int AP_WS = 14336, AP_V = 0, AP_PS = 4608, AP_IMP = AP_PS + 8 * 264 * 4, AP_MASK = AP_IMP + 256, AP_LIST = AP_MASK + 64;
static_assert(AP_LIST + 2 * 192 <= AP_WS && 8 * AP_WS <= RING_BYTES, "prompt attention LDS map");
__device__ __forceinline__ void attn_prompt_unit(Frame& F, int l, int unit) {
    const int lane = F.lane, w = F.wave;
    const int q = lane & 31, h_ = lane >> 5, blk = (lane >> 4) & 1, tl = q >> 2, hr = q & 3;
    const int seq = unit >> 7, kvh = (unit >> 6) & 1, qt = unit & 63, head = kvh * 4 + hr;
    const int t0w = qt * 64 + 8 * w, t = t0w + tl; const size_t row = (size_t)seq * PT + t;
    LAS unsigned char* Vw = F.lds + w * AP_WS + AP_V; LAS float* PS = (LAS float*)(F.lds + w * AP_WS + AP_PS); LAS float* IMPw = (LAS float*)(F.lds + w * AP_WS + AP_IMP);
    LAS unsigned long long* MASKS = (LAS unsigned long long*)(F.lds + w * AP_WS + AP_MASK); LAS unsigned short* LIST = (LAS unsigned short*)(F.lds + w * AP_WS + AP_LIST);
    __syncthreads();
    bf16x8 qf[4];
    { const bf16* qp = WSP(bf16, WS_QN) + row * 512 + head * 64 + 8 * h_;
#pragma unroll
      for (int kk = 0; kk < 4; ++kk) qf[kk] = *(const bf16x8*)(qp + 16 * kk); }
    const float* ngp = WSP(float, WS_NG) + row * 24 + head * 3; const float g0 = ngp[0], g1 = ngp[1], g2 = ngp[2];
    for (int i = lane; i < 8 * 264; i += 64) PS[i] = 0.f;
    const bf16* CKk = WSP(bf16, WS_CK) + ((size_t)32768 + (seq * 2 + kvh) * 256) * 64; const bf16* CKv = CKk + (size_t)CMP_ROWS_J * 64;
    const bf16* KS = WSP(bf16, WS_KVB) + ((((size_t)0 * PB + seq) * 2 + kvh) * PT) * 64; const bf16* VS = KS + (size_t)PB * 2 * PT * 64;
    const bf16* KW = KS + (size_t)2 * PB * 2 * PT * 64; const bf16* VW = KW + (size_t)PB * 2 * PT * 64;
    const int hiCmin = (t0w >= 31) ? ((t0w - 31) >> 4) : -1;
    const int hiC = (t >= 31) ? ((t - 31) >> 4) : -1; const int nmaxw = (t0w + 7 >= 31) ? ((t0w + 7 - 31) >> 4) : -1; const int ntc = (nmaxw >= 0) ? (nmaxw >> 5) + 1 : 0;
    f32x16 D0 = (f32x16){}, D1 = (f32x16){};
    LAS float* OAG = PS + lane;
    float m = -INFINITY, lsum = 0.f, invC = 0.f; unsigned long long mk0 = 0ull;
    const float zf = (F.G == 12345) ? 1.0f : 0.0f;
    bf16x8 nk0[4]; v4u nv0[4], nv1[4];
#define AP_LOADK(e_, NK) do { const int kd_ = (int)((e_) >> 12), ti_ = (int)((e_) & 0xfffu); const bf16* kb_ = (kd_ < 2 ? CKk : (kd_ == 2 ? KS : KW)) + (size_t)ti_ * 32 * 64; \
        const int ko_ = kd_ < 2 ? q * 64 + 8 * h_ : lane * 8, ks_ = kd_ < 2 ? 16 : 512;     \
        _Pragma("unroll") for (int kk = 0; kk < 4; ++kk) NK[kk] = *(const bf16x8*)(kb_ + ko_ + ks_ * kk); } while (0)
#define AP_LOADV(e_, NV) do { const int kd_ = (int)((e_) >> 12), ti_ = (int)((e_) & 0xfffu); const bf16* vb_ = (kd_ < 2 ? CKv : (kd_ == 2 ? VS : VW)) + (size_t)ti_ * 32 * 64; \
        _Pragma("unroll") for (int x = 0; x < 4; ++x) NV[x] = *(const v4u*)(vb_ + 512 * x + lane * 8); } while (0)
#define AP_LOADT(e_, NK, NV) do { AP_LOADK(e_, NK); AP_LOADV(e_, NV); } while (0)
#define AP_STEP(i_, n_, NK, NV, NVN, EC, ECN) do { \
        const unsigned e_ = EC; const int kind = (int)(e_ >> 12), ti = (int)(e_ & 0xfffu); \
        if (kind == 1) { _Pragma("unroll") for (int x = 0; x < 4; ++x) *(LAS v4u*)(Vw + (8 * x + (lane >> 3)) * AS_RS + (lane & 7) * 16) = NV[x]; }     \
        f32x16 s_ = (f32x16){}; \
        _Pragma("unroll") for (int kk = 0; kk < 4; ++kk) s_ = mfma32(NK[kk], qf[kk], s_); \
        AP_DUP_QK(NK) \
          \
        if ((i_) + 1 < (n_)) { AP_LOADK(ECN, NK); AP_LOADV(ECN, NVN); if ((i_) + 2 < (n_)) EC = (unsigned)__builtin_amdgcn_readfirstlane((int)LIST[(i_) + 2]); } \
        if (kind != cur_kind) { \
            if (cur_kind == 0) { const float lt_ = xhalf_sum(lsum); invC = lt_ > 0.f ? 1.0f / lt_ : 0.f; } \
            else if (cur_kind == 2) { const float lt_ = xhalf_sum(lsum); const float sc_ = (lt_ > 0.f ? 1.0f / lt_ : 0.f) * g1; \
                _Pragma("unroll") for (int r = 0; r < 16; ++r) { OAG[r * 64] += D0[r] * sc_; OAG[(16 + r) * 64] += D1[r] * sc_; } } \
            if (kind != 1) m = -INFINITY; lsum = 0.f; D0 = (f32x16){}; D1 = (f32x16){}; cur_kind = kind; } \
        const int kb = ti * 32; int lo, hi; \
        if (kind < 2) { lo = 0; hi = hiC; } else if (kind == 2) { lo = 0; hi = ((mk0 >> (ti >> 1)) & 1ull) ? t : -1; } else { lo = t - WINB; hi = t; } \
          \
        const bool interior = (kind < 2) ? (hiCmin >= 0 && kb + 31 <= hiCmin) : ((kind == 2) ? (kb + 31 <= t0w) : (kb >= t0w + 7 - WINB && kb + 31 <= t0w)); \
        float tmax_ = -INFINITY, mu_, mn_; \
        if (interior) { const bool on_ = hi >= 0; \
            _Pragma("unroll") for (int r = 0; r < 16; ++r) tmax_ = fmaxf(tmax_, s_[r]); \
            tmax_ = on_ ? tmax_ : -INFINITY; tmax_ = xhalf_max(tmax_); \
            mn_ = fmaxf(m, tmax_); mu_ = (mn_ == -INFINITY) ? 0.f : mn_; const float mr_ = on_ ? mu_ : INFINITY; \
            _Pragma("unroll") for (int r = 0; r < 16; ++r) s_[r] = fexp2(s_[r] - mr_); \
        } else { \
            _Pragma("unroll") for (int r = 0; r < 16; ++r) { const int key_ = kb + (r & 3) + 8 * (r >> 2) + 4 * h_; s_[r] = (key_ >= lo && key_ <= hi) ? s_[r] : -INFINITY; tmax_ = fmaxf(tmax_, s_[r]); } \
            tmax_ = xhalf_max(tmax_); \
            mn_ = fmaxf(m, tmax_); mu_ = (mn_ == -INFINITY) ? 0.f : mn_; \
            _Pragma("unroll") for (int r = 0; r < 16; ++r) s_[r] = fexp2(s_[r] - mu_); \
        } \
        AP_DUP_EXP() \
        const float al_ = fexp2(m - mu_); float ps_ = 0.f; \
        _Pragma("unroll") for (int r = 0; r < 16; ++r) ps_ += s_[r]; \
        lsum = lsum * al_ + ps_; m = mn_; \
        if (kind >= 2) { if (__ballot(al_ != 1.0f) != 0ull) { D0 *= al_; D1 *= al_; } \
            const bf16x8 pf0_ = cvt_frag(s_, 0), pf1_ = cvt_frag(s_, 1); \
            D0 = mfma32(__builtin_bit_cast(bf16x8, NV[0]), pf0_, D0); D1 = mfma32(__builtin_bit_cast(bf16x8, NV[2]), pf0_, D1); D0 = mfma32(__builtin_bit_cast(bf16x8, NV[1]), pf1_, D0); D1 = mfma32(__builtin_bit_cast(bf16x8, NV[3]), pf1_, D1); \
        } else if (kind == 1) { if (__ballot(al_ != 1.0f) != 0ull) { D0 *= al_; D1 *= al_; } asm volatile("" ::: "memory");   \
            { const bf16x8 va0_ = tr_frag(Vw, AS_RS, 4 * h_, 4 * h_ + 8, 16 * blk, lane), va1_ = tr_frag(Vw, AS_RS, 4 * h_, 4 * h_ + 8, 32 + 16 * blk, lane), \
                           vb0_ = tr_frag(Vw, AS_RS, 16 + 4 * h_, 24 + 4 * h_, 16 * blk, lane), vb1_ = tr_frag(Vw, AS_RS, 16 + 4 * h_, 24 + 4 * h_, 32 + 16 * blk, lane);   \
              const bf16x8 pf0_ = cvt_frag(s_, 0), pf1_ = cvt_frag(s_, 1); \
              D0 = mfma32(va0_, pf0_, D0); D1 = mfma32(va1_, pf0_, D1); D0 = mfma32(vb0_, pf1_, D0); D1 = mfma32(vb1_, pf1_, D1); } \
            AP_DUP_PV() \
            asm volatile("" ::: "memory"); } \
        if (kind == 1) { _Pragma("unroll") for (int r = 0; r < 16; ++r) { const int n2_ = kb + (r & 3) + 8 * (r >> 2) + 4 * h_; float a_ = s_[r] * invC; a_ += __shfl_xor(a_, 1); a_ += __shfl_xor(a_, 2); if (hr == 0) PS[tl * 264 + n2_] = a_; } } \
    } while (0)
#define AP_RUN(N_) do { const int n_ = (N_); unsigned ec0_ = 0u, ec1_ = 0u;                  \
      if (n_ > 0) { ec0_ = (unsigned)__builtin_amdgcn_readfirstlane((int)LIST[0]); AP_LOADK(ec0_, nk0); AP_LOADV(ec0_, nv0); } \
      if (n_ > 1) { ec1_ = (unsigned)__builtin_amdgcn_readfirstlane((int)LIST[1]); } \
      _Pragma("unroll 1") for (int i_ = 0; i_ < n_; i_ += 2) { AP_STEP(i_, n_, nk0, nv0, nv1, ec0_, ec1_); if (i_ + 1 < n_) AP_STEP(i_ + 1, n_, nk0, nv1, nv0, ec1_, ec0_); } } while (0)
    int cur_kind = -1;
    if (lane < 2 * ntc) LIST[lane] = (unsigned short)(((lane >= ntc ? 1u : 0u) << 12) | (unsigned)(lane >= ntc ? lane - ntc : lane));
    LDS_WAIT(); asm volatile("" ::: "memory");
    AP_RUN(2 * ntc);
    { const float sc = (cur_kind == 1) ? g0 * invC : 0.f; D0 *= sc; D1 *= sc; }
    LDS_WAIT(); asm volatile("" ::: "memory");
#pragma unroll 1
    for (int tk = 0; tk < 8; ++tk) {
        const LAS float* pr = PS + tk * 264; const int s = lane; float imp = 0.f;
#pragma unroll
        for (int n = 4 * s - 1; n <= 4 * s + 3; ++n) if (n >= 0) imp += pr[n];
        const bool forced = (s == 0) || (s == qt) || (s == qt - 1), avail = s <= qt;
        const unsigned key = avail ? (forced ? 0x7fffffffu : (imp > 0.f ? __float_as_uint(imp) + 1u : 1u)) : 0u;
        unsigned thr = 0u;
#pragma unroll
        for (int bit = 30; bit >= 0; --bit) { const unsigned cand = thr | (1u << bit); const int cnt = __popcll(__ballot(key >= cand)); thr = (cnt >= 16) ? cand : thr; }
        const unsigned long long gt = __ballot(key > thr), eq = __ballot(key == thr); const int need = 16 - __popcll(gt);
        const int below = __builtin_amdgcn_mbcnt_hi((unsigned)(eq >> 32), __builtin_amdgcn_mbcnt_lo((unsigned)eq, 0u));
        const unsigned long long mk = gt | __ballot(key == thr && below < need);
        if (lane == 0) MASKS[tk] = mk;
        LDS_WAIT(); asm volatile("" ::: "memory");
    }
#pragma unroll
    for (int r = 0; r < 16; ++r) { OAG[r * 64] = D0[r]; OAG[(16 + r) * 64] = D1[r]; }
    mk0 = MASKS[tl]; unsigned long long wu = 0ull;
#pragma unroll
    for (int i = 0; i < 8; ++i) wu |= MASKS[i];
    wu &= (qt >= 63) ? ~0ull : ((1ull << (qt + 1)) - 1ull);
    const int nsel = 2 * __popcll(wu); const int tiLo = (t0w > WINB) ? ((t0w - WINB) >> 5) : 0, tiHi = (t0w + 7) >> 5, nwin = tiHi - tiLo + 1;
    if ((wu >> lane) & 1ull) { const int pos = 2 * __popcll(wu & ((1ull << lane) - 1ull)); LIST[pos] = (unsigned short)((2u << 12) | (unsigned)(2 * lane)); LIST[pos + 1] = (unsigned short)((2u << 12) | (unsigned)(2 * lane + 1)); }
    if (lane < nwin) LIST[nsel + lane] = (unsigned short)((3u << 12) | (unsigned)(tiLo + lane));
    LDS_WAIT(); asm volatile("" ::: "memory");
#ifdef DBG_COUNT
    if (lane == 0) { unsigned* CNT = (unsigned*)(F.ws + WS_CTL) + 3000; atomicAdd(CNT + 0, (unsigned)nsel); atomicAdd(CNT + 1, (unsigned)nwin); atomicAdd(CNT + 2, (unsigned)(2 * ntc)); atomicAdd(CNT + 3, 1u); }
#endif
    cur_kind = -1;
    AP_RUN(nsel + nwin);
    const float ltw = xhalf_sum(lsum); const float scw = (ltw > 0.f ? 1.0f / ltw : 0.f) * g2;
#undef AP_RUN
#undef AP_STEP
#undef AP_LOADT
#undef AP_LOADK
#undef AP_LOADV
    {
        bf16* op = WSP(bf16, WS_OA) + row * 512 + head * 64;
#pragma unroll
        for (int r4 = 0; r4 < 4; ++r4) { float a_[4], b_[4];
#pragma unroll
            for (int x = 0; x < 4; ++x) { a_[x] = OAG[(4 * r4 + x) * 64] + D0[4 * r4 + x] * scw; b_[x] = OAG[(16 + 4 * r4 + x) * 64] + D1[4 * r4 + x] * scw; }
            v2u a, b; a.x = pk2(a_[0], a_[1]); a.y = pk2(a_[2], a_[3]); b.x = pk2(b_[0], b_[1]); b.y = pk2(b_[2], b_[3]);
            *(v2u*)(op + 8 * r4 + 4 * h_) = a; *(v2u*)(op + 32 + 8 * r4 + 4 * h_) = b; }
    }
}
#undef AS_TILE

#ifdef DBG_CHECK
__device__ __forceinline__ unsigned dbg_rand(unsigned x) { x ^= x >> 16; x *= 0x7feb352du; x ^= x >> 15; x *= 0x846ca68bu; x ^= x >> 16; return x; }
__device__ __forceinline__ bool dbg_bad(float got, float exp_, float rtol, float atol) { return !(fabsf(got - exp_) <= rtol * fabsf(exp_) + atol); }
__device__ __forceinline__ float bfr(float x) { return __uint_as_float(pk2(x, 0.f) << 16); }
__device__ __forceinline__ int dbg_row(unsigned r) { const unsigned k = r % 20u; if (k == 0) return (int)(PM + (r >> 8) % SM); if (k == 1) return (int)(((r >> 8) % PB) * PT + ((r >> 12) % 8)); if (k == 2) return (int)(((r >> 8) % PB) * PT + PT - 1 - ((r >> 12) % 8)); return (int)((r >> 5) % PM); }
__device__ __forceinline__ float dbg_rs(const Frame& F, int row, int lane) { const float* xr = xrow_in(F, 0, row); float ss = 0.f; for (int d = lane; d < DM; d += 64) ss += xr[d] * xr[d]; return 1.0f / sqrtf(wave_sum(ss) * (1.0f / DM) + EPS); }
__device__ __forceinline__ float dbg_h(const Frame& F, int row, int d, float rs) { const float* mod = WSP(float, WS_MOD) + (size_t)row_bb(row) * 6144; return bfr(xrow_in(F, 0, row)[d] * rs * FIN(I_N1G)[d] * (1.0f + mod[1024 + d]) + mod[d]); }

__device__ __forceinline__ void dbg_check_phase(Frame& F) {
    const int gw = F.bid * NWAVES + F.wave, NGW = F.G * NWAVES, lane = F.lane;
    unsigned* CNT = (unsigned*)(F.ws + WS_CTL) + 3000;
    LAS float* L = (LAS float*)(F.lds + F.wave * 16384);
#define DBG_FLAG(ch, cond) do { if (__any(cond) && lane == 0) atomicAdd(CNT + (ch), 1u); } while (0)
    for (int s = gw; s < 1536; s += NGW) {
        const unsigned r = dbg_rand(1000u + s); const int row = dbg_row(r); const float rs = dbg_rs(F, row, lane); const int kind = s % 6;
        const bool isp = row < PM; const int b = isp ? (row >> 12) : ((row - PM) >> 3), t = isp ? (row & (PT - 1)) : ((row - PM) & 7);
#define DBG_U(col, dst) do { float a_ = 0.f; for (int d_ = lane; d_ < DM; d_ += 64) a_ += dbg_h(F, row, d_, rs) * bfr(FIN(I_WIN)[(size_t)d_ * D_IN + (col)]); dst = wave_sum(a_); } while (0)
        if (kind == 0) {
            const int c = (r >> 3) % 768, j = c >> 7, k = (c >> 6) & 1, dd = c & 63; float u; DBG_U(O_NKV + c, u); bool bad = false;
            if (j < 4) bad = dbg_bad(F.out[(isp ? OUT_ROWS_P + (size_t)row * 512 : OUT_ROWS_S + (size_t)(row - PM) * 512) + c], u, 0.01f, 0.01f);
            else if (isp) { if (t >= PT - WINB) bad = dbg_bad(F.out[OUT_WIN_P + ((size_t)b * WINB + (t - (PT - WINB))) * 256 + (c - 512)], u, 0.01f, 0.01f); }
            else bad = dbg_bad(F.out[OUT_WIN_S + ((size_t)b * WINB + (WINB - ST) + t) * 256 + (c - 512)], u, 0.01f, 0.01f);
            if (isp) { if (j < 2) bad = bad || dbg_bad(bf1(WSP(bf16, WS_ACMP)[((size_t)j * CMP_ROWS_J + 32768 + (b * 2 + k) * 256 + (t >> 4)) * 1024 + (t & 15) * 64 + dd]), u, 0.01f, 0.01f);
                       else bad = bad || dbg_bad(bf1(WSP(bf16, WS_KVB)[((((size_t)(j - 2) * PB + b) * 2 + k) * PT + t) * 64 + dd]), u, 0.01f, 0.01f); }
            else if (j >= 2) bad = bad || dbg_bad(bf1(WSP(bf16, WS_KVS)[((((size_t)(j - 2) * SB + b) * 2 + k) * ST + t) * 64 + dd]), u, 0.01f, 0.01f);
            DBG_FLAG(0, bad);
        } else if (kind == 1) {
            const int gi = (r >> 3) % 24, c5 = (r >> 8) % 512, cm = (r >> 8) % 3072; float u0, u1, u2, u3; DBG_U(O_NG + gi, u0); DBG_U(O_RX + c5, u1); DBG_U(O_RGATE + c5, u2); DBG_U(O_MG + cm, u3);
            bool bad = dbg_bad(WSP(float, WS_NG)[(size_t)row * 24 + gi], 1.0f / (1.0f + expf(-u0)), 0.01f, 0.005f);
            bad = bad || dbg_bad(WSP(float, WS_RX)[(size_t)row * 512 + c5], u1, 0.01f, 0.01f);
            bad = bad || dbg_bad(bf1(WSP(bf16, WS_GG)[(size_t)row * 512 + c5]), gelu_tanh(u2), 0.02f, 0.01f);
            bad = bad || dbg_bad(bf1(WSP(bf16, WS_MGS)[(size_t)row * 3072 + cm]), 1.0f / (1.0f + expf(-u3)), 0.01f, 0.005f);
            DBG_FLAG(1, bad);
        } else if (kind == 2) {
            const int head = (r >> 13) % 4, dim = (r >> 16) % 64, c5 = (r >> 3) % 512; float x1, x2, uv, ug, uq; DBG_U(O_RQ + head * 128 + dim, x1); DBG_U(O_RQ + head * 128 + 64 + dim, x2); DBG_U(O_RV + c5, uv); DBG_U(O_RG + c5, ug); DBG_U(O_NQ + c5, uq);
            const float pos = (float)(isp ? t : PAST + t); const float ang = pos * (float)pow(10000.0, -(double)dim / 64.0); float sn, cs; sincos_acc(ang, sn, cs);
            const bf16* RQ = WSP(bf16, WS_RQ);
            bool bad = dbg_bad(bf1(RQ[(size_t)row * 512 + head * 128 + dim]), x1 * cs - x2 * sn, 0.02f, 0.02f) || dbg_bad(bf1(RQ[(size_t)row * 512 + head * 128 + 64 + dim]), x1 * sn + x2 * cs, 0.02f, 0.02f);
            bad = bad || dbg_bad(bf1(RQ[(size_t)2 * MT * 512 + (size_t)row * 512 + c5]), uv, 0.01f, 0.01f) || dbg_bad(bf1(RQ[(size_t)3 * MT * 512 + (size_t)row * 512 + c5]), ug, 0.01f, 0.01f);
            bad = bad || dbg_bad(bf1(WSP(bf16, WS_QN)[(size_t)row * 512 + c5]), uq * QSCALE, 0.01f, 0.005f);
            DBG_FLAG(2, bad);
        }
#undef DBG_U
    }
    for (int s = gw; s < 128; s += NGW) {
        const unsigned r = dbg_rand(3000u + s); const int j = r & 1; const bool smp = ((r >> 1) & 3) != 0;
        const int grp = smp ? (int)((r >> 3) % 64) : (int)((r >> 3) % 8), nmax = smp ? 511 : 255; int n = (r >> 10) % nmax; if (((r >> 20) & 7) == 0) n = nmax - 1;
        const size_t rj = smp ? (size_t)grp * 512 + n : (size_t)32768 + grp * 256 + n;
        const bf16* A = WSP(bf16, WS_ACMP) + ((size_t)j * CMP_ROWS_J + rj) * 1024;
        const float* w1 = FIN(I_W1) + (size_t)j * 2048 * 128; const float* pe = FIN(I_PE) + j * 2048;
        for (int hh = 0; hh < 2; ++hh) { const int h = lane + 64 * hh; float a = FIN(I_B1)[j * 128 + h];
            for (int i = 0; i < 1024; ++i) a += (bf1(A[i]) + pe[i]) * w1[(size_t)i * 128 + h] + (bf1(A[1024 + i]) + pe[1024 + i]) * w1[(size_t)(1024 + i) * 128 + h];
            L[h] = gelu_tanh(a); }
        LDS_WAIT(); asm volatile("" ::: "memory");
        float o = 0.f; for (int h = 0; h < 128; ++h) o += L[h] * FIN(I_W2)[((size_t)j * 128 + h) * 64 + lane];
        const float got = bf1(WSP(bf16, WS_CK)[((size_t)j * CMP_ROWS_J + rj) * 64 + lane]);
        { const bool bd = dbg_bad(got, o, 0.05f, 0.03f); const unsigned long long mk = __ballot(bd); if (lane == 0 && mk) atomicAdd(CNT + 3, (unsigned)__popcll(mk)); }
        LDS_WAIT(); asm volatile("" ::: "memory");
    }
    for (int s = gw; s < 128; s += NGW) {
        const unsigned r = dbg_rand(3500u + s); const int j = r & 1; const bool smp = ((r >> 1) & 3) != 0;
        const int grp = smp ? (int)((r >> 3) % 64) : (int)((r >> 3) % 8), nmax = smp ? 511 : 255; const int n = (r >> 10) % nmax;
        const size_t rj = smp ? (size_t)grp * 512 + n : (size_t)32768 + grp * 256 + n, row = (size_t)j * CMP_ROWS_J + rj;
        const bf16* A = WSP(bf16, WS_ACMP) + row * 1024; const float* w1 = FIN(I_W1) + (size_t)j * 2048 * 128; const bf16* LH = WSP(bf16, WS_LH);
        unsigned nb = 0;
        for (int hh = 0; hh < 2; ++hh) { const int h = lane + 64 * hh; float lo = 0.f, hi = 0.f;
            for (int i = 0; i < 1024; ++i) { const float av = bf1(A[i]); lo += av * bfr(w1[(size_t)i * 128 + h]); hi += av * bfr(w1[(size_t)(1024 + i) * 128 + h]); }
            const bool bd = dbg_bad(bf1(LH[row * 256 + h]), lo, 0.02f, 0.02f) || dbg_bad(bf1(LH[row * 256 + 128 + h]), hi, 0.02f, 0.02f); nb += (unsigned)__popcll(__ballot(bd)); }
        if (lane == 0 && nb) atomicAdd(CNT + 9, nb);
        for (int hh = 0; hh < 2; ++hh) { const int h = lane + 64 * hh; L[h] = gelu_tanh(bf1(LH[row * 256 + h]) + bf1(LH[(row + 1) * 256 + 128 + h]) + WSP(float, WS_SMALLW + SW_CB)[j * 128 + h]); }
        LDS_WAIT(); asm volatile("" ::: "memory");
        float o = 0.f; for (int h = 0; h < 128; ++h) o += bfr(L[h]) * bfr(FIN(I_W2)[((size_t)j * 128 + h) * 64 + lane]);
        { const bool bd = dbg_bad(bf1(WSP(bf16, WS_CK)[row * 64 + lane]), o, 0.03f, 0.01f); const unsigned long long mk = __ballot(bd); if (lane == 0 && mk) atomicAdd(CNT + 11, (unsigned)__popcll(mk)); }
        LDS_WAIT(); asm volatile("" ::: "memory");
    }
    for (int s = gw; s < 64; s += NGW) {
        const unsigned r = dbg_rand(3700u + s); const int j = r & 1, half = (r >> 1) & 1, h = (r >> 2) % 128; const bf16* W1T = WSP(bf16, WS_SMALLW + SW_W1T) + ((size_t)j * 256 + half * 128 + h) * 1024;
        const float* w1 = FIN(I_W1) + ((size_t)j * 32 + half * 16) * 64 * 128 + h; unsigned nb = 0;
        for (int k = lane; k < 1024; k += 64) nb += (unsigned)__popcll(__ballot(dbg_bad(bf1(W1T[k]), w1[(size_t)k * 128], 0.01f, 0.0001f)));
        if (lane == 0 && nb) atomicAdd(CNT + 12, nb);
        const bool smp = ((r >> 9) & 3) != 0; const int grp = smp ? (int)((r >> 11) % 64) : (int)((r >> 11) % 8), n = (r >> 17) % (smp ? 511 : 255);
        const size_t row = (size_t)j * CMP_ROWS_J + (smp ? (size_t)grp * 512 + n : (size_t)32768 + grp * 256 + n); const bf16* A = WSP(bf16, WS_ACMP) + row * 1024;
        float a = 0.f; for (int k = lane; k < 1024; k += 64) a += bf1(A[k]) * bf1(W1T[k]); a = wave_sum(a);
        DBG_FLAG(13, dbg_bad(bf1(WSP(bf16, WS_LH)[row * 256 + half * 128 + h]), a, 0.02f, 0.02f));
    }
    for (int s = gw; s < 4; s += NGW) {
        const int j = s >> 1, h = (s & 1) * 64 + lane; const float* w1 = FIN(I_W1) + (size_t)j * 2048 * 128; const float* pe = FIN(I_PE) + j * 2048;
        float a = FIN(I_B1)[j * 128 + h]; for (int i = 0; i < 2048; ++i) a += pe[i] * w1[(size_t)i * 128 + h];
        const unsigned long long mk = __ballot(dbg_bad(WSP(float, WS_SMALLW + SW_CB)[j * 128 + h], a, 0.001f, 0.0005f)); if (lane == 0 && mk) atomicAdd(CNT + 10, (unsigned)__popcll(mk));
    }
    for (int s = gw; s < 96; s += NGW) {
        const unsigned r = dbg_rand(4000u + s); const bool smp = (s % 3) == 2;
        int seq, kvh = (r >> 4) & 1, t, tl = 0; size_t row;
        if (smp) { seq = (r >> 5) % SB; tl = (r >> 10) % ST; t = PAST + tl; row = (size_t)PM + seq * ST + tl; }
        else { seq = (r >> 5) % PB; const unsigned k = (r >> 8) % 8u; t = (k == 0) ? (int)((r >> 12) % 40) : (k == 1) ? PT - 1 - (int)((r >> 12) % 70) : (int)((r >> 12) % PT); row = (size_t)seq * PT + t; }
        const int N = smp ? 511 : 255, NS = smp ? 129 : 64, cur = t >> 6;
        LAS float* Q = L; LAS float* SC = L + 256; LAS float* PSUM = L + 256 + 2048; LAS float* OUT = L + 256 + 2048 + 512;
        for (int i = lane; i < 256; i += 64) Q[i] = bf1(WSP(bf16, WS_QN)[row * 512 + (kvh * 4 + (i >> 6)) * 64 + (i & 63)]);
        for (int i = lane; i < 768; i += 64) OUT[i] = 0.f;
        LDS_WAIT(); asm volatile("" ::: "memory");
        const bf16* CKk = WSP(bf16, WS_CK) + (smp ? (size_t)(seq * 2 + kvh) * 512 : (size_t)32768 + (seq * 2 + kvh) * 256) * 64; const bf16* CKv = CKk + (size_t)CMP_ROWS_J * 64;
        const int nvis = smp ? 511 : ((t >= 31) ? ((t - 31) >> 4) + 1 : 0);
        for (int i = lane; i < 512; i += 64) PSUM[i] = 0.f;
        for (int hr = 0; hr < 4; ++hr) {
            float mx = -INFINITY; for (int n = lane; n < nvis; n += 64) { float a = 0.f; for (int d = 0; d < 64; ++d) a += Q[hr * 64 + d] * bf1(CKk[(size_t)n * 64 + d]); SC[n] = a; mx = fmaxf(mx, a); }
            for (int o = 1; o < 64; o <<= 1) mx = fmaxf(mx, __shfl_xor(mx, o));
            float den = 0.f; for (int n = lane; n < nvis; n += 64) { const float e = exp2f(SC[n] - mx); SC[n] = e; den += e; } den = wave_sum(den);
            LDS_WAIT(); asm volatile("" ::: "memory");
            if (nvis > 0) { float o = 0.f; for (int n = 0; n < nvis; ++n) o += SC[n] * bf1(CKv[(size_t)n * 64 + lane]); OUT[hr * 64 + lane] = o / den;
                for (int n = lane; n < nvis; n += 64) PSUM[n] += SC[n] / den; }
            LDS_WAIT(); asm volatile("" ::: "memory");
        }
        LAS float* IMP = SC; LAS float* SELB = SC + 256;
        for (int sblk = lane; sblk < NS; sblk += 64) { float imp = 0.f; for (int n = 4 * sblk - 1; n <= 4 * sblk + 3; ++n) if (n >= 0 && n < N) imp += PSUM[n];
            const bool forced = sblk == 0 || sblk == cur || sblk == cur - 1, avail = sblk * 64 <= t; IMP[sblk] = avail ? (forced ? 1e4f : imp) : -1e4f; SELB[sblk] = 0.f; }
        LDS_WAIT(); asm volatile("" ::: "memory");
        for (int pick = 0; pick < 16 && pick < NS; ++pick) { float bv = -INFINITY; int bi = 1 << 30;
            for (int sblk = lane; sblk < NS; sblk += 64) { const float v = (SELB[sblk] != 0.f) ? -INFINITY : IMP[sblk]; if (v > bv || (v == bv && sblk < bi)) { bv = v; bi = sblk; } }
            for (int o = 1; o < 64; o <<= 1) { const float ov = __shfl_xor(bv, o); const int oi = __shfl_xor(bi, o); if (ov > bv || (ov == bv && oi < bi)) { bv = ov; bi = oi; } }
            if (lane == 0) SELB[bi] = 1.f; LDS_WAIT(); asm volatile("" ::: "memory"); }
        for (int br = 1; br < 3; ++br) for (int hr = 0; hr < 4; ++hr) {
            float mx = -INFINITY, den = 0.f, o = 0.f;
            const int plo = (br == 1) ? 0 : (t - WINB < 0 ? 0 : t - WINB), phi = t;
            for (int p = plo; p <= phi; ++p) {
                if (br == 1 && SELB[p >> 6] == 0.f) { p |= 63; continue; }
                const float* kf = nullptr; const bf16* kb = nullptr; const float* vf = nullptr; const bf16* vb = nullptr;
                const int jk = (br == 1) ? 2 : 4;
                if (!smp) { kb = WSP(bf16, WS_KVB) + ((((size_t)(jk - 2) * PB + seq) * 2 + kvh) * PT + p) * 64; vb = kb + (size_t)PB * 2 * PT * 64; }
                else if (p >= PAST) { kb = WSP(bf16, WS_KVS) + ((((size_t)(jk - 2) * SB + seq) * 2 + kvh) * ST + (p - PAST)) * 64; vb = kb + (size_t)SB * 2 * ST * 64; }
                else if (br == 1) { const int page = ((const int*)F.a->in[I_PT])[seq * NPG + (p >> 7)]; kf = FIN(I_CACHE) + ((((size_t)page * PAGE + (p & 127)) * 4 + 2) * 2 + kvh) * 64; vf = kf + 128; }
                else { kf = FIN(I_CWIN) + ((((size_t)seq * WINB + (p - (PAST - WINB))) * 2 + 0) * 2 + kvh) * 64; vf = kf + 128; }
                float a = 0.f; for (int d = 0; d < 64; ++d) a += Q[hr * 64 + d] * (kb ? bf1(kb[d]) : bfr(kf[d]));
                const float vv = vb ? bf1(vb[lane]) : bfr(vf[lane]);
                const float mn = fmaxf(mx, a), al = exp2f(mx - mn), e = exp2f(a - mn); den = den * al + e; o = o * al + e * vv; mx = mn;
            }
            OUT[(br * 4 + hr) * 64 + lane] = (den > 0.f) ? o / den : 0.f;
        }
        LDS_WAIT(); asm volatile("" ::: "memory");
        bool bad = false;
        for (int hr = 0; hr < 4; ++hr) { const float* ng = WSP(float, WS_NG) + row * 24 + (kvh * 4 + hr) * 3;
            const float e = ng[0] * OUT[(0 * 4 + hr) * 64 + lane] + ng[1] * OUT[(1 * 4 + hr) * 64 + lane] + ng[2] * OUT[(2 * 4 + hr) * 64 + lane];
            bad = bad || dbg_bad(bf1(WSP(bf16, WS_OA)[row * 512 + (kvh * 4 + hr) * 64 + lane]), e, 0.04f, 0.004f); }
        DBG_FLAG(smp ? 5 : 4, bad);
        LDS_WAIT(); asm volatile("" ::: "memory");
    }
    for (int s = gw; s < 96; s += NGW) {
        const unsigned r = dbg_rand(6000u + s); const bool smp = (s % 3) == 2; const int h = (r >> 3) & 3; const float lg = ret_log_g(h);
        const bf16* RQ = WSP(bf16, WS_RQ); const bf16* RK = RQ + (size_t)MT * 512; const bf16* RV = RQ + (size_t)2 * MT * 512; const bf16* RG = RQ + (size_t)3 * MT * 512;
        int seq, t; size_t row0; if (smp) { seq = (r >> 5) % SB; t = (r >> 10) % ST; row0 = (size_t)PM + seq * ST; } else { seq = (r >> 5) % PB; const unsigned k = (r >> 8) % 4u; t = (k == 0) ? (int)((r >> 12) % 300) : (int)((r >> 12) % PT); row0 = (size_t)seq * PT; }
        float o0 = 0.f, o1 = 0.f;
        for (int d = lane; d < 128; d += 64) L[d] = bf1(RQ[(row0 + t) * 512 + h * 128 + d]);
        LDS_WAIT(); asm volatile("" ::: "memory");
        for (int j = 0; j <= t; ++j) { float a = 0.f; for (int d = 0; d < 128; ++d) a += L[d] * bf1(RK[(row0 + j) * 512 + h * 128 + d]);
            a *= expf((float)(t - j) * lg); o0 += a * bf1(RV[(row0 + j) * 512 + h * 128 + lane]); o1 += a * bf1(RV[(row0 + j) * 512 + h * 128 + 64 + lane]); }
        if (smp) { const float* S0 = FIN(I_SRET) + (((size_t)0 * SB + seq) * 4 + h) * 16384; const float cr = expf((float)(t + 1) * lg);
            for (int d = 0; d < 128; ++d) { o0 += L[d] * S0[d * 128 + lane] * cr; o1 += L[d] * S0[d * 128 + 64 + lane] * cr; } }
        const float mean = wave_sum(o0 + o1) * (1.0f / 128.0f); const float var = wave_sum((o0 - mean) * (o0 - mean) + (o1 - mean) * (o1 - mean)) * (1.0f / 128.0f), rstd = 1.0f / sqrtf(var + EPS);
        const float* GN = FIN(I_GNG) + h * 128; const bf16* OR_ = WSP(bf16, WS_OA) + (size_t)MT * 512;
        const float g0 = bf1(RG[(row0 + t) * 512 + h * 128 + lane]), g1 = bf1(RG[(row0 + t) * 512 + h * 128 + 64 + lane]);
        const float e0 = (o0 - mean) * rstd * GN[lane] * (g0 / (1.0f + expf(-g0))), e1 = (o1 - mean) * rstd * GN[64 + lane] * (g1 / (1.0f + expf(-g1)));
        DBG_FLAG(6, dbg_bad(bf1(OR_[(row0 + t) * 512 + h * 128 + lane]), e0, 0.04f, 0.02f) || dbg_bad(bf1(OR_[(row0 + t) * 512 + h * 128 + 64 + lane]), e1, 0.04f, 0.02f));
        const int d = (r >> 20) % 128, T = smp ? ST : PT; float s0 = 0.f, s1 = 0.f;
        for (int j = 0; j < T; ++j) { const float kk = bf1(RK[(row0 + j) * 512 + h * 128 + d]) * expf((float)(T - 1 - j) * lg); s0 += kk * bf1(RV[(row0 + j) * 512 + h * 128 + lane]); s1 += kk * bf1(RV[(row0 + j) * 512 + h * 128 + 64 + lane]); }
        const float* SO;
        if (smp) { const float* S0 = FIN(I_SRET) + (((size_t)0 * SB + seq) * 4 + h) * 16384; const float g8 = expf(8.0f * lg); s0 += g8 * S0[d * 128 + lane]; s1 += g8 * S0[d * 128 + 64 + lane]; SO = F.out + OUT_RET_S + (((size_t)0 * SB + seq) * 4 + h) * 16384; }
        else SO = F.out + OUT_RET_P + (((size_t)0 * PB + seq) * 4 + h) * 16384;
        DBG_FLAG(7, dbg_bad(SO[d * 128 + lane], s0, 0.02f, 0.02f) || dbg_bad(SO[d * 128 + 64 + lane], s1, 0.02f, 0.02f));
        LDS_WAIT(); asm volatile("" ::: "memory");
    }
    for (int s = gw; s < 48; s += NGW) {
        const unsigned r = dbg_rand(8000u + s); const bool smp = (s % 3) == 2; const int blk = (r >> 3) & 7, c = blk * 64 + lane;
        int seq, T; size_t row0; if (smp) { seq = (r >> 6) % SB; T = ST; row0 = (size_t)PM + seq * ST; } else { seq = (r >> 6) % PB; T = 1 + (int)((r >> 10) % ((s & 1) ? 200 : PT)); row0 = (size_t)seq * PT; }
        const float* RX = WSP(float, WS_RX); const float* cw = FIN(I_RCW); const float cb = FIN(I_RCB)[c];
        float x3 = 0.f, x2 = 0.f, x1 = 0.f, h = 0.f;
        if (smp) { const float* cv = FIN(I_SCONV) + (size_t)seq * 3 * 512; x3 = cv[c]; x2 = cv[512 + c]; x1 = cv[1024 + c]; h = FIN(I_SH)[(size_t)seq * 512 + c]; }
        const float sp = log1pf(expf(-FIN(I_LAM)[c])); const float* wa = FIN(I_RWA) + (size_t)blk * 4096; const float* wx = FIN(I_RWX) + (size_t)blk * 4096;
        for (int t = 0; t < T; ++t) { const float x0 = RX[(row0 + t) * 512 + c]; const float xc = cb + cw[c] * x3 + cw[512 + c] * x2 + cw[1024 + c] * x1 + cw[1536 + c] * x0; x3 = x2; x2 = x1; x1 = x0;
            L[lane] = xc; LDS_WAIT(); asm volatile("" ::: "memory");
            float ra = FIN(I_RBA)[c], ri = FIN(I_RBX)[c]; for (int i = 0; i < 64; ++i) { ra += L[i] * wa[i * 64 + lane]; ri += L[i] * wx[i * 64 + lane]; }
            LDS_WAIT(); asm volatile("" ::: "memory");
            const float rr = 1.0f / (1.0f + expf(-ra)), ii = 1.0f / (1.0f + expf(-ri)), la = -8.0f * rr * sp, a = expf(la); h = a * h + sqrtf(-expm1f(2.0f * la)) * (ii * xc); }
        const size_t o = (row0 + T - 1) * 512 + c; const float e = h * bf1(WSP(bf16, WS_GG)[o]);
        DBG_FLAG(8, dbg_bad(bf1((WSP(bf16, WS_OA) + (size_t)2 * MT * 512)[o]), e, 0.04f, 0.01f));
    }
    for (int s = gw; s < 512; s += NGW) {
        const unsigned r = dbg_rand(9000u + s); const int row = dbg_row(r), col = (r >> 7) % DM;
        float e = 0.f;
        for (int br = 0; br < 3; ++br) { const bf16* O = WSP(bf16, WS_OA) + (size_t)br * MT * 512 + (size_t)row * 512; const float* W = FIN(br == 0 ? I_WBRA : (br == 1 ? I_WBRB : I_WBRC));
            float a = 0.f; for (int k = lane; k < 512; k += 64) a += bf1(O[k]) * bfr(W[(size_t)k * DM + col]); a = wave_sum(a); e += bf1(WSP(bf16, WS_MGS)[(size_t)row * 3072 + br * 1024 + col]) * a; }
        DBG_FLAG(20, dbg_bad(bf1(WSP(bf16, WS_MRG)[(size_t)row * DM + col]), e, 0.03f, 0.01f));
        const float* mod = WSP(float, WS_MOD) + (size_t)row_bb(row) * 6144;
        { float a = 0.f; for (int k = lane; k < DM; k += 64) a += bf1(WSP(bf16, WS_MRG)[(size_t)row * DM + k]) * bfr(FIN(I_WOUT)[(size_t)k * DM + col]); a = wave_sum(a);
          const float ex = xrow_in(F, 0, row)[col] + mod[2048 + col] * a; DBG_FLAG(21, dbg_bad(WSP(float, WS_X1)[(size_t)row * DM + col], ex, 0.005f, 0.005f)); }
        { const float* xr = WSP(float, WS_X1) + (size_t)row * DM; float ss = 0.f; for (int d = lane; d < DM; d += 64) ss += xr[d] * xr[d]; const float rs = 1.0f / sqrtf(wave_sum(ss) * (1.0f / DM) + EPS);
          const int c2 = (r >> 9) % NUP; float a = 0.f; for (int d = lane; d < DM; d += 64) a += bfr(xr[d] * rs * FIN(I_N2G)[d] * (1.0f + mod[4096 + d]) + mod[3072 + d]) * bfr(FIN(I_WUP)[(size_t)d * NUP + c2]); a = wave_sum(a);
          const float got = c2 < DFF ? bf1(WSP(bf16, WS_GP)[(size_t)row * DFF + c2]) : bf1((WSP(bf16, WS_GP) + (size_t)MT * DFF)[(size_t)row * DFF + c2 - DFF]); DBG_FLAG(22, dbg_bad(got, a, 0.02f, 0.01f)); }
        { const int c3 = (r >> 11) % DFF; const bf16* GP = WSP(bf16, WS_GP); const bf16* VAL = GP + (size_t)MT * DFF; const float* cw = FIN(I_FCW);
          const bool isp = row < PM; const int t = isp ? (row & (PT - 1)) : ((row - PM) & 7); float xm2, xm1;
          if (t >= 2) { xm2 = bf1(GP[(size_t)(row - 2) * DFF + c3]); xm1 = bf1(GP[(size_t)(row - 1) * DFF + c3]); }
          else if (isp) { xm2 = 0.f; xm1 = (t == 1) ? bf1(GP[(size_t)(row - 1) * DFF + c3]) : 0.f; }
          else { const float* st = FIN(I_SFFN) + ((size_t)((row - PM) >> 3) * 2) * DFF + c3; xm2 = (t == 0) ? st[0] : st[DFF]; xm1 = (t == 0) ? st[DFF] : bf1(GP[(size_t)(row - 1) * DFF + c3]); }
          const float y = FIN(I_FCB)[c3] + cw[c3] * xm2 + cw[DFF + c3] * xm1 + cw[2 * DFF + c3] * bf1(GP[(size_t)row * DFF + c3]); const float ex = (y / (1.0f + expf(-y))) * bf1(VAL[(size_t)row * DFF + c3]);
          DBG_FLAG(23, dbg_bad(bf1((GP + (size_t)2 * MT * DFF)[(size_t)row * DFF + c3]), ex, 0.02f, 0.005f)); }
        { const bf16* ACT = WSP(bf16, WS_GP) + (size_t)2 * MT * DFF + (size_t)row * DFF; float a = 0.f; for (int k = lane; k < DFF; k += 64) a += bf1(ACT[k]) * bfr(FIN(I_WDN)[(size_t)k * DM + col]); a = wave_sum(a);
          const float ex = WSP(float, WS_X1)[(size_t)row * DM + col] + mod[5120 + col] * a; DBG_FLAG(24, dbg_bad(WSP(float, WS_X2)[(size_t)row * DM + col], ex, 0.005f, 0.005f)); }
    }
#undef DBG_FLAG
}
__device__ __forceinline__ void dbg_report_phase(Frame& F) {
    const unsigned* CNT = (const unsigned*)(F.ws + WS_CTL) + 3000;
    const size_t ooff[14] = {OUT_Y, OUT_Y + (size_t)PM * DM, OUT_ROWS_P, OUT_ROWS_S, OUT_WIN_P, OUT_WIN_S, OUT_RET_P, OUT_RET_S, OUT_H_P, OUT_H_S, OUT_CV_P, OUT_CV_S, OUT_FC_P, OUT_FC_S};
    if (F.bid == 0 && F.tid < 14) { const int b = F.tid; const unsigned c = CNT[b]; const int cnt = 1 + (int)(c > 1000u ? 1000u : c);
        for (int i = 0; i < cnt; ++i) ((unsigned*)F.out)[ooff[b] + 7 + 2 * i] = 0xAAAAAAAAu; }
}
#endif

#ifndef DBG_SUB
#define DBG_SUB 0xFFFF
#endif
#ifndef DBG_MAXPH
#define DBG_MAXPH N_PHASES
#endif
#ifndef DBG_REPEAT
#define DBG_REPEAT 0
#endif
#ifndef DBG_MASK
#define DBG_MASK 0xFFFF
#endif
#define IN(k) (lo <= (k) && (k) < hi)
#ifdef DBG_TIME
#define SEAM(k) do { if ((k) + 1 < hi) { if (MK_N_LAUNCHES == 1) xcd_barrier(bar); } if (F.bid == 0 && F.tid == 0) ((unsigned long long*)(F.ws + WS_CTL))[2048 + (k) + 1] = __builtin_amdgcn_s_memrealtime(); } while (0)
#else
#define SEAM(k) do { if ((k) + 1 < hi) { if (MK_N_LAUNCHES == 1) xcd_barrier(bar); } } while (0)
#endif
template <int l> __device__ __forceinline__ void ph_win(Frame& F) { unsigned char* ws = F.ws;
    pg8::Gemm g{(const pg8::bf16_t*)(ws + WS_H), (const pg8::bf16_t*)(ws + WS_WIN) + (size_t)l * NIN * DM, MT, NIN, DM};
    pg8::StaticOrder S; S.init(MT, NIN, F.G, F.bid); EpiWin E{ws, F.out, l};
    pg8::gemm_phase<EpiWin, pg8::StaticOrder, true, true>(F.lds, g, S, E); }
template <int l> __device__ __forceinline__ void ph_mix1(Frame& F) {
    for (int x = F.bid; x < 512; x += F.G) { launder(F); cmp_gemm_unit<true>(F, l, x >> 8, (x & 255) >> 2, (x & 3) * 128); }
    {
        unsigned* ctr = (unsigned*)(F.ws + WS_CTL) + 3210 + l; volatile LAS int* QI = (volatile LAS int*)(F.lds + MISC_OFF + 128);
#pragma unroll 1
        for (;;) {
            __syncthreads();
            if (F.tid == 0) QI[0] = (int)__hip_atomic_fetch_add(ctr, 1u, __ATOMIC_RELAXED, __HIP_MEMORY_SCOPE_AGENT);
            __syncthreads();
            const int u = __builtin_amdgcn_readfirstlane(QI[0]);
            if (u >= 32 + 768) break;
            launder(F);
            if (u < 32) cmp_gemm_unit<false>(F, l, u >> 4, (u >> 1) & 7, (u & 1) * 128); else if (u < 32 + 256) rglru_unit<0>(F, l, u - 32); else ret_local_unit(F, u - 32 - 256);
        }
        __syncthreads();
    } }
template <int l> __device__ __forceinline__ void ph_mix2(Frame& F) { cmp2_phase(F, l); ret_scan_phase(F, l); rglru_carry_phase(F, l); }
#ifndef DBG_REPQ
#define DBG_REPQ 0
#endif
constexpr int MQ_SA = 64, MQ_PA = MQ_SA + 512, MQ_RG1 = MQ_PA + 256, MQ_RO = MQ_RG1 + 512, MQ_RS = MQ_RO + 128, MQ_RG2 = MQ_RS + 32;
template <int l> __device__ __forceinline__ void ph_mix3(Frame& F) {
    unsigned* ctr = (unsigned*)(F.ws + WS_CTL) + 3200 + l;
    volatile LAS int* QI = (volatile LAS int*)(F.lds + MISC_OFF + 128);
#pragma unroll 1
    for (;;) {
        __syncthreads();
        if (F.tid == 0) QI[0] = (int)__hip_atomic_fetch_add(ctr, 1u, __ATOMIC_RELAXED, __HIP_MEMORY_SCOPE_AGENT);
        __syncthreads();
        const int u = __builtin_amdgcn_readfirstlane(QI[0]);
        if (u >= MQ_RG2) break;
        launder(F);
        if (u < MQ_SA) { attn_sample_unit(F, l, u); if (DBG_REPQ & 2) { launder(F); attn_sample_unit(F, l, u); } }
        else if (u < MQ_PA) { const int v = u - MQ_SA; attn_prompt_unit(F, l, (v & 7) * 64 + 63 - (v >> 3)); if (DBG_REPQ & 1) { launder(F); attn_prompt_unit(F, l, (v & 7) * 64 + 63 - (v >> 3)); } }
        else if (u < MQ_RG1) { rglru_unit<1>(F, l, u - MQ_PA); }
        else if (u < MQ_RO) { ret_out_unit(F, l, u - MQ_RG1); }
        else if (u < MQ_RS) { ret_sample_unit(F, l, u - MQ_RO); }
        else { rglru_unit<2>(F, l, u - MQ_RS); }
    }
    __syncthreads(); }
__device__ __forceinline__ f32x16 smp_tile_acc(Frame& F, const bf16* A, const bf16* Wt, int K, int tile) {
    const int q = F.lane & 31, h_ = F.lane >> 5, ks8 = K / 8, kb = F.wave * ks8;
    const bf16* ap = A + (size_t)((tile >> 5) * 32 + q) * K + kb + 8 * h_; const bf16* bp = Wt + (size_t)((tile & 31) * 32 + q) * K + kb + 8 * h_; f32x16 acc = (f32x16){};
#pragma unroll 11
    for (int kk = 0; kk < ks8 / 16; ++kk) acc = mfma32(*(const bf16x8*)(ap + 16 * kk), *(const bf16x8*)(bp + 16 * kk), acc);
    return acc;
}
__device__ __forceinline__ void smp_tile_put(Frame& F, const f32x16& acc, int slot) { LAS float* R = (LAS float*)(F.lds + slot * 32768) + F.wave * 1024 + F.lane;
#pragma unroll
    for (int r = 0; r < 16; ++r) R[r * 64] = acc[r]; }
__device__ __forceinline__ float smp_tile_get(Frame& F, int slot, int o) { const LAS float* R = (const LAS float*)(F.lds + slot * 32768) + o; float s = 0.f;
#pragma unroll
    for (int w = 0; w < 8; ++w) s += R[w * 1024];
    return s; }
template <int l> __device__ __forceinline__ void ph_br(Frame& F) { unsigned char* ws = F.ws;
    const pg8::bf16_t* wbr = (const pg8::bf16_t*)(ws + WS_WBR) + (size_t)l * 3 * 1024 * 512;
    for (int tile = F.bid; tile < 256; tile += F.G) {
        const f32x16 a0 = smp_tile_acc(F, (const bf16*)(ws + WS_OA) + (size_t)PM * 512, wbr, 512, tile), a1 = smp_tile_acc(F, (const bf16*)(ws + WS_OA) + (size_t)(MT + PM) * 512, wbr + (size_t)1024 * 512, 512, tile),
                     a2 = smp_tile_acc(F, (const bf16*)(ws + WS_OA) + (size_t)(2 * MT + PM) * 512, wbr + (size_t)2 * 1024 * 512, 512, tile);
        __syncthreads(); smp_tile_put(F, a0, 0); smp_tile_put(F, a1, 1); smp_tile_put(F, a2, 2); __syncthreads();
        const bf16* MG = (const bf16*)(ws + WS_MGS); bf16* MR = (bf16*)(ws + WS_MRG);
#pragma unroll
        for (int e = 0; e < 2; ++e) { const int o = F.tid * 2 + e, r = o >> 6, ln = o & 63; const size_t row = (size_t)PM + (tile >> 5) * 32 + (r & 3) + 8 * (r >> 2) + 4 * (ln >> 5); const int col = (tile & 31) * 32 + (ln & 31);
            const bf16* g = MG + row * 3072 + col; MR[row * DM + col] = (bf16)(pk2(bf1(g[0]) * smp_tile_get(F, 0, o) + bf1(g[1024]) * smp_tile_get(F, 1, o) + bf1(g[2048]) * smp_tile_get(F, 2, o), 0.f) & 0xffffu); }
    }
    __syncthreads();
    BrOrder S; S.S.init(PM, DM, F.G, F.bid);
    pg8::Gemm g{(const pg8::bf16_t*)(ws + WS_OA), wbr, 3 * MT, 3 * DM, 512}; EpiBrAll E{ws};
    pg8::gemm_phase<EpiBrAll, BrOrder, true, true>(F.lds, g, S, E); }
template <bool INF32> __device__ __forceinline__ void smp_res(Frame& F, const bf16* A, const bf16* Wt, int K, const void* xin  , bf16* xout  , const float* mod, int gofs) {
    for (int tile = F.bid; tile < 256; tile += F.G) {
        const f32x16 a = smp_tile_acc(F, A, Wt, K, tile);
        __syncthreads(); smp_tile_put(F, a, 0); __syncthreads();
#pragma unroll
        for (int e = 0; e < 2; ++e) { const int o = F.tid * 2 + e, r = o >> 6, ln = o & 63; const int rr = (tile >> 5) * 32 + (r & 3) + 8 * (r >> 2) + 4 * (ln >> 5), col = (tile & 31) * 32 + (ln & 31);
            const float xi = INF32 ? ((const float*)xin)[(size_t)rr * DM + col] : bf1(((const bf16*)xin)[(size_t)rr * DM + col]);
            xout[(size_t)rr * DM + col] = (bf16)(pk2(xi + mod[(size_t)(4 + (rr >> 3)) * 6144 + gofs + col] * smp_tile_get(F, 0, o), 0.f) & 0xffffu); }
    }
    __syncthreads();
}
template <int l> __device__ __forceinline__ void ph_out(Frame& F) { unsigned char* ws = F.ws;
    const float* mod = (const float*)(ws + WS_MOD) + (size_t)l * 36 * 6144;
    smp_res<l == 0>(F, (const bf16*)(ws + WS_MRG) + (size_t)PM * DM, (const bf16*)(ws + WS_WOUT) + (size_t)l * DM * DM, DM, l == 0 ? (const void*)FIN(I_XS) : (const void*)((const bf16*)(ws + WS_X2) + (size_t)PM * DM), (bf16*)(ws + WS_X1) + (size_t)PM * DM, mod, 2048);
    pg8::Gemm g{(const pg8::bf16_t*)(ws + WS_MRG), (const pg8::bf16_t*)(ws + WS_WOUT) + (size_t)l * DM * DM, PM, DM, DM};
    pg8::StaticOrder S; S.init(PM, DM, F.G, F.bid);
    EpiRes<l == 0> E{l == 0 ? (const void*)FIN(I_XP) : (const void*)(ws + WS_X2), (bf16*)(ws + WS_X1), mod, 2048};
    pg8::gemm_phase<EpiRes<l == 0>, pg8::StaticOrder, true, true>(F.lds, g, S, E); }
template <int l> __device__ __forceinline__ void ph_down(Frame& F) { unsigned char* ws = F.ws;
    const float* mod = (const float*)(ws + WS_MOD) + (size_t)l * 36 * 6144;
    {
        pg8::StaticOrder S0; S0.init(PM, DM, F.G, F.bid); pg8::Unit u0;
        for (int i = 0; S0.next(i, u0); ++i) if ((u0.pm & 15) != 0) convact_rows(F, l, (size_t)u0.pm * 256, 2, false);
        asm volatile("s_waitcnt vmcnt(0)" ::: "memory"); __syncthreads();
    }
    smp_res<false>(F, (const bf16*)(ws + WS_GP) + (size_t)2 * MT * DFF + (size_t)PM * DFF, (const bf16*)(ws + WS_WDN) + (size_t)l * DM * DFF, DFF, (const void*)((const bf16*)(ws + WS_X1) + (size_t)PM * DM), (bf16*)(ws + WS_X2) + (size_t)PM * DM, mod, 5120);
    pg8::Gemm g{(const pg8::bf16_t*)(ws + WS_GP) + (size_t)2 * MT * DFF, (const pg8::bf16_t*)(ws + WS_WDN) + (size_t)l * DM * DFF, PM, DM, DFF};
    pg8::StaticOrder S; S.init(PM, DM, F.G, F.bid);
    EpiRes<false> E{(const void*)(ws + WS_X1), (bf16*)(ws + WS_X2), mod, 5120};
    pg8::gemm_phase<EpiRes<false>, pg8::StaticOrder, true, true>(F.lds, g, S, E); }
template <int l> __device__ __forceinline__ void ph_up(Frame& F) { unsigned char* ws = F.ws;
    pg8::Gemm g{(const pg8::bf16_t*)(ws + WS_H), (const pg8::bf16_t*)(ws + WS_WUP) + (size_t)l * NUP * DM, MT, NUP, DM};
    UpOrder S; S.S.init(MT, DFF, F.G, F.bid); EpiUp E{ws, F.out, l, FIN(I_FCW) + (size_t)l * 3 * DFF, FIN(I_FCB) + (size_t)l * DFF, (const bf16*)(ws + WS_SFB) + (size_t)l * SB * 2 * DFF};
    pg8::gemm_phase<EpiUp, UpOrder, true, true>(F.lds, g, S, E); }
#ifdef DBG_AMP_BIT
#define AMP_T0(bit) unsigned long long amp_t0_ = 0ull; if ((bit) == DBG_AMP_BIT) amp_t0_ = __builtin_amdgcn_s_memrealtime();
#define AMP_T1(bit) if ((bit) == DBG_AMP_BIT && F.tid == 0) { volatile LAS unsigned* AM = (volatile LAS unsigned*)(F.lds + MISC_OFF + 192); AM[0] += (unsigned)(__builtin_amdgcn_s_memrealtime() - amp_t0_); }
#else
#define AMP_T0(bit)
#define AMP_T1(bit)
#endif
#define RUNPH(bit, ph, CALL) do { if (((DBG_MASK >> (bit)) & 1) && IN(ph)) { AMP_T0(bit) launder(F); CALL; if ((DBG_REPEAT >> (bit)) & 1) { launder(F); CALL; } SEAM(ph); AMP_T1(bit) } } while (0)
template <int l> __device__ __forceinline__ void layer_phases(Frame& F, const XcdBarrier& bar, int lo, int hi) {
    constexpr int pb = PH_L0 + l * PH_PER_LAYER;
    RUNPH(1, pb + LP_N1, norm_phase(F, l, 0));
    RUNPH(2, pb + LP_WIN, ph_win<l>(F));
    RUNPH(3, pb + LP_MIX1, ph_mix1<l>(F));
    RUNPH(4, pb + LP_MIX2, ph_mix2<l>(F));
    RUNPH(5, pb + LP_MIX3, ph_mix3<l>(F));
    RUNPH(6, pb + LP_BR, ph_br<l>(F));
    RUNPH(7, pb + LP_OUT, ph_out<l>(F));
    RUNPH(8, pb + LP_N2, norm_phase(F, l, 1));
    RUNPH(9, pb + LP_UP, ph_up<l>(F));
    RUNPH(11, pb + LP_DOWN, ph_down<l>(F));
}
__global__ void __launch_bounds__(NTHR, 2) trunk_fwd(Args args) {
    extern __shared__ __attribute__((aligned(16))) unsigned char lds_raw[];
    Frame F;
    F.lds = (LAS unsigned char*)lds_raw;
    F.tid = threadIdx.x; F.lane = F.tid & 63; F.wave = __builtin_amdgcn_readfirstlane(F.tid >> 6);
    F.G = gridDim.x; F.bid = blockIdx.x; F.a = &args; F.ws = args.ws; F.out = args.out;
    volatile LAS unsigned* MISC = (volatile LAS unsigned*)(F.lds + MISC_OFF);
    for (int u = F.tid; u < 64; u += NTHR) MISC[u] = 0u;
    __syncthreads();
    unsigned* barw = (unsigned*)(F.ws + WS_CTL) + CW_BAR;
    XcdBarrier bar; bar.bar = barw; bar.x = 0; bar.st = nullptr;
    if (MK_N_LAUNCHES == 1) bar = xcd_barrier_post(barw, MISC + 8);
    const int lo = args.ph_lo, hi = args.ph_hi;
    unsigned char* ws = F.ws;

#ifdef DBG_TIME
    if (F.bid == 0 && F.tid == 0) ((unsigned long long*)(F.ws + WS_CTL))[2048] = __builtin_amdgcn_s_memrealtime();
#endif
    RUNPH(0, PH_P0, p0_prologue(F));

    layer_phases<0>(F, bar, lo, hi);
    layer_phases<1>(F, bar, lo, hi);
    if (((DBG_MASK >> 12) & 1) && IN(PH_FINAL)) { launder(F); final_phase(F); if ((DBG_REPEAT >> 12) & 1) { launder(F); final_phase(F); } }
#ifdef DBG_AMP_BIT
    if (F.tid == 0) { volatile LAS unsigned* AM = (volatile LAS unsigned*)(F.lds + MISC_OFF + 192); const unsigned long long tot = (unsigned long long)AM[0] * DBG_AMP, ts = __builtin_amdgcn_s_memrealtime();
        while (__builtin_amdgcn_s_memrealtime() - ts < tot) __builtin_amdgcn_s_sleep(8); }
    __syncthreads();
#endif
#ifdef DBG_TIME
    {
        xcd_barrier(bar);
        if (F.bid == 0 && F.tid < 14) {
            const unsigned long long* ts = (const unsigned long long*)(F.ws + WS_CTL) + 2048; const unsigned long long tend = __builtin_amdgcn_s_memrealtime();
            const size_t ooff[14] = {OUT_Y, OUT_Y + (size_t)PM * DM, OUT_ROWS_P, OUT_ROWS_S, OUT_WIN_P, OUT_WIN_S, OUT_RET_P, OUT_RET_S, OUT_H_P, OUT_H_S, OUT_CV_P, OUT_CV_S, OUT_FC_P, OUT_FC_S};
            const int b = F.tid; unsigned long long d;
            if (b == 0) d = tend - ts[0]; else if (b == 1) d = ts[1] - ts[0]; else if (b == 13) d = tend - ts[PH_FINAL];
            else { const int ph = PH_L0 + DBG_TIME_LAYER * PH_PER_LAYER + (b - 2); d = ts[ph + 1] - ts[ph]; }
            int cnt = (int)(d / 100ull); if (cnt < 1) cnt = 1; if (cnt > 2000 && b != 0) cnt = 2000;
            for (int i = 0; i < cnt; ++i) ((unsigned*)F.out)[ooff[b] + 7 + 2 * i] = 0xAAAAAAAAu;
        }
    }
#endif
#ifdef DBG_COUNT
    {
        xcd_barrier(bar);
        if (F.bid == 0 && F.tid < 3) { const unsigned* CNT = (const unsigned*)(F.ws + WS_CTL) + 3000; const size_t ooff[3] = {OUT_Y, OUT_Y + (size_t)PM * DM, OUT_ROWS_P};
            const int cnt = (int)((unsigned long long)CNT[F.tid] * 10ull / (CNT[3] ? CNT[3] : 1u)); for (int i = 0; i < cnt; ++i) ((unsigned*)F.out)[ooff[F.tid] + 7 + 2 * i] = 0xAAAAAAAAu; }
    }
#endif
#ifdef DBG_CHECK
    if (lo == 100) { launder(F); dbg_check_phase(F); }
    if (lo == 101) { for (size_t i = (size_t)F.bid * NTHR + F.tid; i < OUT_END; i += (size_t)F.G * NTHR) F.out[i] = 0.f; }
    if (lo == 102) { launder(F); dbg_report_phase(F); }
#endif
}

extern "C" void kernel_launch(void* const* d_in, const int* in_sizes, int n_in, void* d_out, int out_size, void* d_ws, size_t ws_size, hipStream_t stream) {
    static int grid = 0;
    if (grid == 0) {
        if (n_in != 37 || (size_t)out_size != OUT_END || ws_size < WS_END) { fprintf(stderr, "kernel_launch: unexpected shapes: n_in %d out %d (want %zu) ws %zu (want %zu)\n", n_in, out_size, (size_t)OUT_END, ws_size, (size_t)WS_END); grid = -1; return; }
        int dev = 0, cus = 0, per_cu = 0;
        if (hipGetDevice(&dev) != hipSuccess || hipDeviceGetAttribute(&cus, hipDeviceAttributeMultiprocessorCount, dev) != hipSuccess) { grid = -1; return; }
        if (hipFuncSetAttribute((const void*)trunk_fwd, hipFuncAttributeMaxDynamicSharedMemorySize, LDS_BYTES) != hipSuccess) { fprintf(stderr, "kernel_launch: hipFuncSetAttribute failed\n"); grid = -1; return; }
        if (hipOccupancyMaxActiveBlocksPerMultiprocessor(&per_cu, (const void*)trunk_fwd, NTHR, LDS_BYTES) != hipSuccess || per_cu < 1) fprintf(stderr, "kernel_launch: occupancy query reports %d\n", per_cu);
        (void)hipGetLastError();
        grid = cus;
    }
    if (grid < 0) return;
    if (hipMemsetAsync((char*)d_ws + WS_CTL, 0, CTL_ZERO_BYTES, stream) != hipSuccess) return;
#ifdef DBG_POISON
    (void)hipMemsetAsync((char*)d_ws + CTL_ZERO_BYTES, 0xAA, WS_END - CTL_ZERO_BYTES, stream);
    (void)hipMemsetAsync(d_out, 0xAA, (size_t)OUT_END * 4, stream);
#endif
    Args a{};
    for (int i = 0; i < 37; ++i) a.in[i] = d_in[i];
    a.out = (float*)d_out; a.ws = (unsigned char*)d_ws;
#if MK_N_LAUNCHES == 1
    a.ph_lo = 0; a.ph_hi = N_PHASES;
    hipLaunchKernelGGL(trunk_fwd, dim3(grid), dim3(NTHR), LDS_BYTES, stream, a);
#else
    for (int p = 0; p < DBG_MAXPH; ++p) { a.ph_lo = p; a.ph_hi = p + 1; hipLaunchKernelGGL(trunk_fwd, dim3(grid), dim3(NTHR), LDS_BYTES, stream, a); }
#ifdef DBG_CHECK
    for (int p = 100; p < 103; ++p) { a.ph_lo = p; a.ph_hi = p + 1; hipLaunchKernelGGL(trunk_fwd, dim3(grid), dim3(NTHR), LDS_BYTES, stream, a); }
#endif
#endif
    (void)in_sizes;
}
```

```cpp
#include <hip/hip_runtime.h>
#include <cstdio>
#include <cstdint>

#ifndef MK_N_LAUNCHES
#define MK_N_LAUNCHES 1
#endif

constexpr int DM = 1024, PB = 4, PT = 4096, PM = PB * PT, SB = 32, ST = 8, SM = SB * ST, MT = PM + SM;
constexpr int DEPTH = 2, PAST = 8192, PAGE = 128, NPG = PAST / PAGE, NPHYS = 2560;
constexpr int D_IN = 7448, NIN = 7680, DFF = 2816, NUP = 2 * DFF;
constexpr int WINB = 512;
constexpr float EPS = 1e-6f;
constexpr float QSCALE = 0.125f * 1.4426950408889634f;

constexpr int O_NQ = 0, O_NKV = 512, O_NG = 1280, O_RQ = 1304, O_RK = 1816, O_RV = 2328, O_RG = 2840, O_RX = 3352, O_RGATE = 3864, O_MG = 4376;

constexpr size_t OUT_Y = 0;
constexpr size_t OUT_ROWS_P = OUT_Y + (size_t)MT * DM;
constexpr size_t OUT_ROWS_S = OUT_ROWS_P + (size_t)DEPTH * PM * 512;
constexpr size_t OUT_WIN_P = OUT_ROWS_S + (size_t)DEPTH * SM * 512;
constexpr size_t OUT_WIN_S = OUT_WIN_P + (size_t)DEPTH * PB * WINB * 256;
constexpr size_t OUT_RET_P = OUT_WIN_S + (size_t)DEPTH * SB * WINB * 256;
constexpr size_t OUT_RET_S = OUT_RET_P + (size_t)DEPTH * PB * 4 * 16384;
constexpr size_t OUT_H_P = OUT_RET_S + (size_t)DEPTH * SB * 4 * 16384;
constexpr size_t OUT_H_S = OUT_H_P + (size_t)DEPTH * PB * 512;
constexpr size_t OUT_CV_P = OUT_H_S + (size_t)DEPTH * SB * 512;
constexpr size_t OUT_CV_S = OUT_CV_P + (size_t)DEPTH * PB * 3 * 512;
constexpr size_t OUT_FC_P = OUT_CV_S + (size_t)DEPTH * SB * 3 * 512;
constexpr size_t OUT_FC_S = OUT_FC_P + (size_t)DEPTH * PB * 2 * DFF;
constexpr size_t OUT_END = OUT_FC_S + (size_t)DEPTH * SB * 2 * DFF;

constexpr size_t MiB = 1u << 20;
constexpr size_t WS_CTL = 0, CTL_ZERO_BYTES = 4 * MiB;
constexpr size_t WS_MOD = 1 * MiB;
constexpr size_t WS_ROT = 4 * MiB;
constexpr size_t WS_SMALLW = 8 * MiB;
constexpr size_t WS_SFB = 12 * MiB;
constexpr size_t WS_WIN = 16 * MiB;
constexpr size_t WS_WBR = WS_WIN + (size_t)2 * NIN * DM * 2;
constexpr size_t WS_WOUT = WS_WBR + (size_t)2 * 3 * 1024 * 512 * 2;
constexpr size_t WS_WUP = WS_WOUT + (size_t)2 * 1024 * 1024 * 2;
constexpr size_t WS_WDN = WS_WUP + (size_t)2 * NUP * DM * 2;
constexpr size_t WS_WEND = WS_WDN + (size_t)2 * DM * DFF * 2;
constexpr size_t WS_H = 128 * MiB;
constexpr size_t WS_QN = WS_H + (size_t)MT * DM * 2;
constexpr size_t WS_KVB = WS_QN + (size_t)MT * 512 * 2;
constexpr size_t WS_KVS = WS_KVB + (size_t)4 * PB * 2 * PT * 64 * 2;
constexpr size_t WS_RQ = WS_KVS + (size_t)4 * SB * 2 * ST * 64 * 2;
constexpr size_t WS_RX = WS_RQ + (size_t)4 * MT * 512 * 2;
constexpr size_t WS_GG = WS_RX + (size_t)MT * 512 * 4;
constexpr size_t WS_MGS = WS_GG + (size_t)MT * 512 * 2;
constexpr size_t WS_NG = WS_MGS + (size_t)MT * 3072 * 2;
constexpr size_t WS_OA = WS_NG + (size_t)MT * 24 * 4;
constexpr size_t WS_MRG = WS_OA + (size_t)3 * MT * 512 * 2;
constexpr size_t WS_X1 = WS_MRG + (size_t)MT * DM * 2;
constexpr size_t WS_X2 = WS_X1 + (size_t)MT * DM * 4;
constexpr size_t WS_GP = WS_X2 + (size_t)MT * DM * 4;
constexpr size_t WS_ACMP = WS_GP + (size_t)3 * MT * DFF * 2;
constexpr int CMP_ROWS_J = 34816, CMP_ROWS = 2 * CMP_ROWS_J;
constexpr size_t WS_LH = WS_ACMP + (size_t)2 * CMP_ROWS * 1024 * 2 + 4096;
constexpr size_t WS_CK = WS_LH + (size_t)(CMP_ROWS + 16) * 256 * 2;
constexpr size_t WS_LT = WS_CK + (size_t)CMP_ROWS * 64 * 2;
constexpr size_t WS_SPT = WS_LT + (size_t)16 * 32 * 16384 * 4;
constexpr size_t WS_CAR = WS_SPT + (size_t)16 * 32 * 16384 * 2;
constexpr size_t WS_OAG = WS_CAR + (size_t)4 * 64 * 3 * 512 * 4 + MiB;
constexpr size_t WS_END = WS_OAG + (size_t)2048 * 32 * 64 * 4 + MiB;
static_assert(WS_WEND <= WS_H, "weights fit below WS_H");

constexpr size_t SW_W1T = 0;
constexpr size_t SW_W2T = SW_W1T + (size_t)2 * 2 * 256 * 1024 * 2;
constexpr size_t SW_CB = SW_W2T + (size_t)2 * 2 * 64 * 128 * 2;
constexpr size_t SW_WAT = SW_CB + (size_t)2 * 2 * 128 * 4;
constexpr size_t SW_SP = SW_WAT + (size_t)2 * 2 * 8 * 64 * 64 * 2;
constexpr size_t SW_END = SW_SP + 2 * 512 * 4;
static_assert(SW_END <= 8 * MiB, "small weights fit");

constexpr int CW_TMO = 0;
constexpr int CW_BAR = 4096;

constexpr int PH_P0 = 0, PH_L0 = 1, PH_PER_LAYER = 11, PH_FINAL = PH_L0 + DEPTH * PH_PER_LAYER, N_PHASES = PH_FINAL + 1;
enum { LP_N1 = 0, LP_WIN, LP_MIX1, LP_MIX2, LP_MIX3, LP_BR, LP_OUT, LP_N2, LP_UP, LP_CONV, LP_DOWN };

constexpr int RING_BYTES = 131072;
constexpr int MISC_OFF = RING_BYTES;
constexpr int LDS_BYTES = RING_BYTES + 1024;
constexpr int NWAVES = 8, NTHR = 512;

#define GAS __attribute__((address_space(1)))
#define LAS __attribute__((address_space(3)))
typedef unsigned short bf16;
typedef unsigned v4u __attribute__((ext_vector_type(4)));
typedef unsigned v2u __attribute__((ext_vector_type(2)));
typedef float f32x16 __attribute__((ext_vector_type(16)));
typedef short s16x4 __attribute__((ext_vector_type(4)));
namespace pg8 {
#define PG8_LAS __attribute__((address_space(3)))
typedef unsigned short bf16_t;
typedef short bf16x8 __attribute__((ext_vector_type(8)));
typedef float f32x4 __attribute__((ext_vector_type(4)));
typedef unsigned u32x4 __attribute__((ext_vector_type(4)));
constexpr int BM = 256, BK = 64, HALF = 128, HTB = HALF * BK * 2  , STAGE_BYTES = 8 * HTB, NXCD = 8, WGM = 8;

__host__ __device__ __forceinline__ int lds_byte(int r, int c) { const int st = (r >> 4) * 2 + (c >> 5), rr = r & 15, cc = c & 31, ob = rr * 64 + cc * 2; return st * 1024 + (ob ^ (((ob >> 9) & 1) << 5)); }
__host__ __device__ __forceinline__ void stage_rc(int b, int& R, int& C) { const int st = b / 1024, sb = b % 1024, swz = sb ^ (((sb >> 9) & 1) << 5); R = (st >> 1) * 16 + swz / 64; C = (st & 1) * 32 + (swz % 64) / 2; }
__host__ __device__ __forceinline__ int perm32(int rho) { const int n = rho >> 4, i = rho & 15; return 8 * (i >> 2) + 4 * n + (i & 3); }

struct Unit { int pm, pn; };
struct Gemm { const bf16_t* A; const bf16_t* Bt; int M, N, K; };

struct StaticOrder {
    int nM, nN, nwg, G, c;
    __host__ __device__ void init(int M, int N, int G_, int c_) { nM = M / BM; nN = N / BM; nwg = nM * nN; G = G_; c = c_; }
    __host__ __device__ bool next(int i, Unit& u) const {
        const long L = (long)i * G + c; if (L >= nwg) return false;
        int wgid = (int)L; { const int q = nwg / NXCD, r = nwg % NXCD, xcd = wgid % NXCD, off = wgid / NXCD; wgid = (xcd < r ? xcd * (q + 1) : r * (q + 1) + (xcd - r) * q) + off; }
        const int nig = WGM * nN, gid = wgid / nig, fm = gid * WGM, gsz = (nM - fm) < WGM ? (nM - fm) : WGM;
        u.pm = fm + ((wgid % nig) % gsz); u.pn = (wgid % nig) / gsz; return true;
    }
    __device__ __forceinline__ void a_ready(const Unit&) const {}
    __device__ __forceinline__ void done(const Unit&) const {}
};
__device__ __forceinline__ unsigned cvt_pk_bf16(float lo, float hi) { unsigned r; asm volatile("v_cvt_pk_bf16_f32 %0, %1, %2" : "=v"(r) : "v"(lo), "v"(hi)); return r; }
typedef float f32x2 __attribute__((ext_vector_type(2)));
template <class Epi, class Sched, bool ALIGN_EPI = false, bool SP2 = false>
__device__ __forceinline__ void gemm_phase(PG8_LAS unsigned char* lds, const Gemm g, const Sched& S, const Epi& E) {
    const int tid = threadIdx.x, wid = __builtin_amdgcn_readfirstlane(tid >> 6), lane = tid & 63, wr = wid >> 2, wc = wid & 3, fr = lane & 15, fq = lane >> 4;
    const int K = g.K, nt = K / BK;
    unsigned voffA[2], voffB[2];
#pragma unroll
    for (int i = 0; i < 2; ++i) { int R, C; stage_rc(tid * 16 + i * 8192, R, C); const int Rb = Epi::PERM ? ((R & ~31) + perm32(R & 31)) : R;
        voffA[i] = (unsigned)(R * K + C) * 2u; voffB[i] = (unsigned)(Rb * K + C) * 2u; }
    const size_t kstep = (size_t)(BK * 2);
    const size_t hstep = (size_t)HALF * K * 2;
    const size_t tstep = 2 * hstep;
    const unsigned ldsw = (unsigned)wid * 1024u;
    const int aoff = lds_byte(wr * 64 + fr, fq * 8), boff = lds_byte(wc * 32 + fr, fq * 8);
#define PG8_SA(b, h) (((b) * 2 + (h)) * HTB)
#define PG8_SB(b, h) ((4 + (b) * 2 + (h)) * HTB)
#define PG8_STAGE(bufoff, gbase, voff) do { _Pragma("unroll") for (int _i = 0; _i < 2; ++_i) \
        __builtin_amdgcn_global_load_lds((const unsigned*)((const char*)(gbase) + (voff)[_i]), (PG8_LAS unsigned*)(lds + (bufoff) + ldsw + _i * 8192), 16, 0, 0); } while (0)
#define PG8_LDA(dst, b, h) do { _Pragma("unroll") for (int m = 0; m < 4; ++m) _Pragma("unroll") for (int k = 0; k < 2; ++k) dst[m][k] = *(const PG8_LAS bf16x8*)(lds + PG8_SA(b, h) + aoff + m * 2048 + k * 1024); } while (0)
#define PG8_LDB(dst, b, h) do { _Pragma("unroll") for (int n = 0; n < 2; ++n) _Pragma("unroll") for (int k = 0; k < 2; ++k) dst[n][k] = *(const PG8_LAS bf16x8*)(lds + PG8_SB(b, h) + boff + n * 2048 + k * 1024); } while (0)
#define PG8_MMA(ai, bj, At, Bt) do { __builtin_amdgcn_s_setprio(1); _Pragma("unroll") for (int m = 0; m < 4; ++m) _Pragma("unroll") for (int n = 0; n < 2; ++n) _Pragma("unroll") for (int k = 0; k < 2; ++k) \
        acc[ai][bj][m][n] = __builtin_amdgcn_mfma_f32_16x16x32_bf16(Bt[n][k], At[m][k], acc[ai][bj][m][n], 0, 0, 0); __builtin_amdgcn_s_setprio(0); } while (0)
#define PG8_WAIT_V(n) asm volatile("s_waitcnt vmcnt(" #n ")" ::: "memory")
#define PG8_WAIT_L(n) asm volatile("s_waitcnt lgkmcnt(" #n ")" ::: "memory")
#define PG8_BAR __builtin_amdgcn_s_barrier()
#define PG8_SCHED __builtin_amdgcn_sched_barrier(0)
    Unit cur, nxt; int ui = 0;
    if (!S.next(0, cur)) return;
    f32x4 acc[2][2][4][2];
#pragma unroll
    for (int a = 0; a < 2; ++a)
#pragma unroll
        for (int b = 0; b < 2; ++b)
#pragma unroll
            for (int m = 0; m < 4; ++m)
#pragma unroll
                for (int n = 0; n < 2; ++n) acc[a][b][m][n] = (f32x4){0.f, 0.f, 0.f, 0.f};
    bf16x8 At[4][2], B0[2][2], B1[2][2];
    const char* cA = (const char*)g.A + (size_t)cur.pm * tstep; const char* cB = (const char*)g.Bt + (size_t)cur.pn * tstep;
    S.a_ready(cur);
    if constexpr (SP2) {
        PG8_STAGE(PG8_SB(0, 0), cB, voffB); PG8_STAGE(PG8_SB(0, 1), cB + hstep, voffB); PG8_STAGE(PG8_SA(0, 0), cA, voffA); PG8_STAGE(PG8_SA(0, 1), cA + hstep, voffA);
        if (wr == 1) PG8_BAR;
        PG8_WAIT_V(2); PG8_BAR;
        PG8_STAGE(PG8_SB(1, 0), cB + kstep, voffB); PG8_STAGE(PG8_SA(1, 0), cA + kstep, voffA); PG8_STAGE(PG8_SB(1, 1), cB + hstep + kstep, voffB);
        PG8_WAIT_V(6); PG8_BAR;
    } else {
        PG8_STAGE(PG8_SB(0, 0), cB, voffB); PG8_STAGE(PG8_SA(0, 0), cA, voffA); PG8_STAGE(PG8_SB(0, 1), cB + hstep, voffB); PG8_STAGE(PG8_SA(0, 1), cA + hstep, voffA);
        if (wr == 1) PG8_BAR;
        PG8_WAIT_V(4); PG8_BAR;
        PG8_STAGE(PG8_SB(1, 0), cB + kstep, voffB); PG8_STAGE(PG8_SA(1, 0), cA + kstep, voffA); PG8_STAGE(PG8_SB(1, 1), cB + hstep + kstep, voffB);
        PG8_WAIT_V(6); PG8_BAR;
    }
    for (;;) {
        const bool has_next = S.next(ui + 1, nxt);
        const char* nA = has_next ? (const char*)g.A + (size_t)nxt.pm * tstep : cA; const char* nB = has_next ? (const char*)g.Bt + (size_t)nxt.pn * tstep : cB;
        for (int t = 0; t < nt; t += 2) {
            const bool last = (t == nt - 2);
            const char* a1 = cA + (size_t)(t + 1) * kstep;
            const char* a2 = last ? nA : cA + (size_t)(t + 2) * kstep; const char* b2 = last ? nB : cB + (size_t)(t + 2) * kstep;
            const char* a3 = a2 + kstep; const char* b3 = b2 + kstep;
            if (last && has_next) S.a_ready(nxt);
            if constexpr (SP2) {
            PG8_LDB(B0, 0, 0); PG8_LDB(B1, 0, 1); PG8_SCHED; PG8_LDA(At, 0, 0); PG8_STAGE(PG8_SA(1, 1), a1 + hstep, voffA);
            PG8_WAIT_V(8); PG8_WAIT_L(0); PG8_BAR; PG8_MMA(0, 0, At, B0); PG8_MMA(0, 1, At, B1); PG8_BAR; PG8_SCHED;
            PG8_LDA(At, 0, 1); PG8_STAGE(PG8_SB(0, 0), b2, voffB); PG8_STAGE(PG8_SB(0, 1), b2 + hstep, voffB); PG8_STAGE(PG8_SA(0, 0), a2, voffA);
            PG8_WAIT_V(8); PG8_WAIT_L(0); PG8_BAR; PG8_MMA(1, 0, At, B0); PG8_MMA(1, 1, At, B1); PG8_BAR; PG8_SCHED;
            PG8_LDB(B0, 1, 0); PG8_LDB(B1, 1, 1); PG8_SCHED; PG8_LDA(At, 1, 0); PG8_STAGE(PG8_SA(0, 1), a2 + hstep, voffA);
            PG8_WAIT_V(8); PG8_WAIT_L(0); PG8_BAR; PG8_MMA(0, 0, At, B0); PG8_MMA(0, 1, At, B1); PG8_BAR; PG8_SCHED;
            PG8_LDA(At, 1, 1); PG8_STAGE(PG8_SB(1, 0), b3, voffB); PG8_STAGE(PG8_SB(1, 1), b3 + hstep, voffB); PG8_STAGE(PG8_SA(1, 0), a3, voffA);
            PG8_WAIT_V(8); PG8_WAIT_L(0); PG8_BAR; PG8_MMA(1, 0, At, B0); PG8_MMA(1, 1, At, B1); PG8_BAR; PG8_SCHED;
            } else {
            PG8_LDB(B0, 0, 0); PG8_SCHED; PG8_LDA(At, 0, 0); PG8_STAGE(PG8_SA(1, 1), a1 + hstep, voffA);
            PG8_WAIT_L(8); PG8_BAR; PG8_WAIT_L(0); PG8_MMA(0, 0, At, B0); PG8_BAR; PG8_SCHED;
            PG8_LDB(B1, 0, 1); PG8_STAGE(PG8_SB(0, 0), b2, voffB);
            PG8_BAR; PG8_WAIT_L(0); PG8_MMA(0, 1, At, B1); PG8_BAR;
            PG8_LDA(At, 0, 1); PG8_STAGE(PG8_SA(0, 0), a2, voffA);
            PG8_BAR; PG8_WAIT_L(0); PG8_MMA(1, 0, At, B0); PG8_BAR; PG8_SCHED;
            PG8_STAGE(PG8_SB(0, 1), b2 + hstep, voffB);
            PG8_WAIT_V(6); PG8_BAR; PG8_MMA(1, 1, At, B1); PG8_BAR;
            PG8_LDB(B0, 1, 0); PG8_SCHED; PG8_LDA(At, 1, 0); PG8_STAGE(PG8_SA(0, 1), a2 + hstep, voffA);
            PG8_WAIT_L(8); PG8_BAR; PG8_WAIT_L(0); PG8_MMA(0, 0, At, B0); PG8_BAR; PG8_SCHED;
            PG8_LDB(B1, 1, 1); PG8_STAGE(PG8_SB(1, 0), b3, voffB);
            PG8_BAR; PG8_WAIT_L(0); PG8_MMA(0, 1, At, B1); PG8_BAR;
            PG8_LDA(At, 1, 1); PG8_STAGE(PG8_SA(1, 0), a3, voffA);
            PG8_BAR; PG8_WAIT_L(0); PG8_MMA(1, 0, At, B0); PG8_BAR; PG8_SCHED;
            PG8_STAGE(PG8_SB(1, 1), b3 + hstep, voffB);
            PG8_WAIT_V(6); PG8_BAR; PG8_MMA(1, 1, At, B1); PG8_BAR;
            }
        }
        if constexpr (ALIGN_EPI) { if (wr == 0) PG8_BAR; }
        if constexpr (!Epi::AFTER_DRAIN) { E(acc, cur, wr, wc, fr, fq); S.done(cur); }
        if (!has_next) break;
#pragma unroll
        for (int a = 0; a < 2; ++a)
#pragma unroll
            for (int b = 0; b < 2; ++b)
#pragma unroll
                for (int m = 0; m < 4; ++m)
#pragma unroll
                    for (int n = 0; n < 2; ++n) acc[a][b][m][n] = (f32x4){0.f, 0.f, 0.f, 0.f};
        cur = nxt; cA = nA; cB = nB; ++ui;
        if constexpr (ALIGN_EPI) { if (wr == 1) PG8_BAR; }
    }
    PG8_WAIT_V(0);
    if constexpr (!ALIGN_EPI) { if (wr == 0) PG8_BAR; }
    PG8_BAR;
    if constexpr (Epi::AFTER_DRAIN) { E.fused(acc, cur, wr, wc, fr, fq, lds, wid, lane); S.done(cur); }
#undef PG8_SA
#undef PG8_SB
#undef PG8_STAGE
#undef PG8_LDA
#undef PG8_LDB
#undef PG8_MMA
#undef PG8_WAIT_V
#undef PG8_WAIT_L
#undef PG8_BAR
#undef PG8_SCHED
}
}

using pg8::bf16x8; using pg8::f32x4; using pg8::u32x4;
#define LDS_WAIT() asm volatile("s_waitcnt lgkmcnt(0)" ::: "memory")
#define VM_WAIT() asm volatile("s_waitcnt vmcnt(0)" ::: "memory")
typedef float f32x2_t __attribute__((ext_vector_type(2))); typedef __bf16 bf16x2_t __attribute__((ext_vector_type(2)));
__device__ __forceinline__ unsigned pk2(float lo, float hi) { f32x2_t v = {lo, hi}; bf16x2_t b = __builtin_convertvector(v, bf16x2_t); return __builtin_bit_cast(unsigned, b); }
__device__ __forceinline__ float bf_lo(unsigned w) { return __uint_as_float(w << 16); }
__device__ __forceinline__ float bf_hi(unsigned w) { return __uint_as_float(w & 0xffff0000u); }
__device__ __forceinline__ float bf1(bf16 b) { return __uint_as_float(((unsigned)b) << 16); }
__device__ __forceinline__ float fexp2(float x) { return __builtin_amdgcn_exp2f(x); }
__device__ __forceinline__ float fexp(float x) { return __builtin_amdgcn_exp2f(x * 1.4426950408889634f); }
__device__ __forceinline__ float frcp(float x) { return __builtin_amdgcn_rcpf(x); }
__device__ __forceinline__ float sigmoidf_(float x) { return frcp(1.0f + fexp(-x)); }
__device__ __forceinline__ float siluf_(float x) { return x * sigmoidf_(x); }
__device__ __forceinline__ float gelu_tanh(float x) {
    const float u = 0.7978845608028654f * (x + 0.044715f * x * x * x);
    const float e = fexp(2.0f * u);
    const float t = 1.0f - 2.0f * frcp(e + 1.0f);
    return 0.5f * x * (1.0f + t);
}
__device__ __forceinline__ float wave_sum(float v) {
#pragma unroll
    for (int o = 1; o < 64; o <<= 1) v += __shfl_xor(v, o);
    return v;
}
__device__ __forceinline__ v4u pack8(const f32x4 a, const f32x4 b) { v4u w; w.x = pk2(a[0], a[1]); w.y = pk2(a[2], a[3]); w.z = pk2(b[0], b[1]); w.w = pk2(b[2], b[3]); return w; }
__device__ __forceinline__ void unpack8(const v4u w, f32x4& a, f32x4& b) { a = (f32x4){bf_lo(w.x), bf_hi(w.x), bf_lo(w.y), bf_hi(w.y)}; b = (f32x4){bf_lo(w.z), bf_hi(w.z), bf_lo(w.w), bf_hi(w.w)}; }

#define XB_TMO      128
#define XB_XCNT(j)  (256  + 64 * (j))
#define XB_XSUB(j)  (1280 + 64 * (j))
#define XB_XGEN(j)  (2304 + 64 * (j))
#define XB_TOP      3328
#define XB_TOPGEN   3392
#define XCD_BAR_WORDS 3456
#define XB_SPIN_CAP (1u << 18)

__device__ __forceinline__ unsigned xb_ld(unsigned* p)              { return __hip_atomic_load(p, __ATOMIC_RELAXED, __HIP_MEMORY_SCOPE_AGENT); }
__device__ __forceinline__ unsigned xb_add(unsigned* p, unsigned v) { return __hip_atomic_fetch_add(p, v, __ATOMIC_RELAXED, __HIP_MEMORY_SCOPE_AGENT); }
__device__ __forceinline__ unsigned xb_xcc_id() { return (unsigned)__builtin_amdgcn_s_getreg((3 << 11) | 20) & 0xFu; }
#define XB_SPIN(cond, bar) do { unsigned _sp = 0; while (cond) { __builtin_amdgcn_s_sleep(1); \
    if ((++_sp & 255u) == 0u) { if (xb_ld(&(bar)[XB_TMO])) break; if (_sp > XB_SPIN_CAP) { atomicAdd(&(bar)[XB_TMO], 1u); break; } } } } while (0)

struct XcdBarrier {
    unsigned* bar; unsigned x;
    volatile LAS unsigned* st;
};

__device__ __forceinline__ XcdBarrier xcd_barrier_post(unsigned* bar, volatile LAS unsigned* st) {
    XcdBarrier b; b.bar = bar; b.x = xb_xcc_id(); b.st = st;
    if (threadIdx.x == 0) (void)xb_add(&bar[XB_XCNT(b.x)], 1u);
    return b;
}
__device__ __forceinline__ void xcd_barrier_complete(unsigned* bar, unsigned x, unsigned& nloc, unsigned& nx) {
    const unsigned G = gridDim.x * gridDim.y * gridDim.z;
    unsigned sum, cnt, mine, sp = 0u;
    for (;;) {
        sum = 0u; cnt = 0u; mine = 0u;
#pragma unroll
        for (unsigned j = 0; j < 16; ++j) { const unsigned c = xb_ld(&bar[XB_XCNT(j)]); sum += c; cnt += (c > 0u) ? 1u : 0u; mine = (j == x) ? c : mine; }
        if (sum == G) break;
        __builtin_amdgcn_s_sleep(1);
        if ((++sp & 255u) == 0u) { if (xb_ld(&bar[XB_TMO])) break; if (sp > XB_SPIN_CAP) { atomicAdd(&bar[XB_TMO], 1u); break; } }
    }
    nloc = mine > 0u ? mine : 1u; nx = cnt > 0u ? cnt : 1u;
}

__device__ __forceinline__ void xcd_barrier(const XcdBarrier& b) {
    asm volatile("s_waitcnt vmcnt(0)" ::: "memory");
    __syncthreads();
    if (threadIdx.x == 0) {
        unsigned* bar = b.bar;
        __builtin_amdgcn_s_waitcnt(0);
        unsigned nloc = b.st[0], nx = b.st[1];
        if (nloc == 0u) { xcd_barrier_complete(bar, b.x, nloc, nx); b.st[0] = nloc; b.st[1] = nx; }
        const unsigned old = xb_add(&bar[XB_XSUB(b.x)], 1u);
        const unsigned gen = old / nloc;
        if (old + 1u == (gen + 1u) * nloc) {
            __builtin_amdgcn_fence(__ATOMIC_RELEASE, "agent");
            asm volatile("s_waitcnt vmcnt(0)" ::: "memory");
            const unsigned og = xb_add(&bar[XB_TOP], 1u);
            const unsigned tg = og / nx;
            if (og + 1u == (tg + 1u) * nx) xb_add(&bar[XB_TOPGEN], 1u);
            else XB_SPIN(xb_ld(&bar[XB_TOPGEN]) == tg, bar);
            __builtin_amdgcn_fence(__ATOMIC_ACQUIRE, "agent");
            xb_add(&bar[XB_XGEN(b.x)], 1u);
            asm volatile("s_waitcnt vmcnt(0)" ::: "memory");
        } else {
            XB_SPIN(xb_ld(&bar[XB_XGEN(b.x)]) == gen, bar);
            __builtin_amdgcn_fence(__ATOMIC_ACQUIRE, "agent");
            asm volatile("s_waitcnt vmcnt(0)" ::: "memory");
        }
    }
    __syncthreads();
}

struct Args { const void* in[37]; float* out; unsigned char* ws; int ph_lo, ph_hi; };
enum { I_XP = 0, I_XS, I_CACHE, I_CWIN, I_SRET, I_SH, I_SCONV, I_SFFN, I_PT, I_CP, I_CS, I_N1G, I_N2G, I_WADA, I_BADA, I_WIN, I_PE, I_W1, I_B1, I_W2,
       I_GNG, I_RCW, I_RCB, I_RWA, I_RBA, I_RWX, I_RBX, I_LAM, I_WBRA, I_WBRB, I_WBRC, I_WOUT, I_WUP, I_FCW, I_FCB, I_WDN, I_FNG };

struct Frame {
    LAS unsigned char* lds;
    int tid, lane, wave, G, bid;
    const Args* a;
    unsigned char* ws;
    float* out;
};
__device__ __forceinline__ void launder(Frame& F) { asm volatile("" : "+v"(F.tid), "+v"(F.lane)); int w_ = __builtin_amdgcn_readfirstlane(F.wave), b_ = __builtin_amdgcn_readfirstlane(F.bid), g_ = __builtin_amdgcn_readfirstlane(F.G); asm volatile("" : "+s"(w_), "+s"(b_), "+s"(g_)); F.wave = w_; F.bid = b_; F.G = g_; }
#define FIN(i) ((const float*)F.a->in[i])
#define WSP(T, off) ((T*)(F.ws + (off)))

__device__ __forceinline__ int row_bb(int row) { return row < PM ? (row >> 12) : 4 + ((row - PM) >> 3); }
__device__ __forceinline__ int row_pos(int row) { return row < PM ? (row & (PT - 1)) : PT + ((row - PM) & 7); }

__device__ __forceinline__ int win_cmap(int n) {
    if (n < 1280) return n;
    if (n < 2304) { const int c = n - 1280, isk = c >> 9, hc = c & 511, head = hc >> 7, s = hc & 127;
        const int g = s >> 3, w = s & 7, dim = (w < 4) ? (4 * g + w) : (64 + 4 * g + (w - 4)); return (isk ? O_RK : O_RQ) + head * 128 + dim; }
    if (n < 2816) return O_RV + (n - 2304);
    if (n < 3328) return O_RG + (n - 2816);
    if (n < 3840) return O_RX + (n - 3328);
    if (n < 4352) return O_RGATE + (n - 3840);
    if (n < 7424) return O_MG + (n - 4352);
    if (n < 7448) return O_NG + (n - 7424);
    return -1;
}

struct TrItem { const float* W; bf16* WT; int ldw, ldt, k0, n0; bool map; };
__device__ __forceinline__ void p0_tr_load(const TrItem& I, float (&tv)[32], int lane) {
    const int nd = I.n0 + (lane & 31); const int sc = I.map ? win_cmap(nd) : nd;
#pragma unroll
    for (int i = 0; i < 32; ++i) { const int kk = 2 * i + (lane >> 5); tv[i] = (sc >= 0) ? I.W[(size_t)(I.k0 + kk) * I.ldw + sc] : 0.f; }
}
__device__ __forceinline__ void p0_tr_finish(const TrItem& I, const float (&tv)[32], LAS float* scr, int lane) {
#pragma unroll
    for (int i = 0; i < 32; ++i) { const int kk = 2 * i + (lane >> 5); scr[kk * 33 + (lane & 31)] = tv[i]; }
    LDS_WAIT(); asm volatile("" ::: "memory");
    const int c = lane & 7;
#pragma unroll
    for (int j = 0; j < 4; ++j) { const int n = (lane >> 3) + 8 * j; const LAS float* s = scr + (8 * c) * 33 + n;
        v4u o; o.x = pk2(s[0 * 33], s[1 * 33]); o.y = pk2(s[2 * 33], s[3 * 33]); o.z = pk2(s[4 * 33], s[5 * 33]); o.w = pk2(s[6 * 33], s[7 * 33]);
        *(v4u*)(I.WT + (size_t)(I.n0 + n) * I.ldt + I.k0 + 8 * c) = o; }
    LDS_WAIT(); asm volatile("" ::: "memory");
}
template <bool MAP> __device__ __forceinline__ void p0_tr_item(const float* W, int ldw, bf16* WT, int ldt, int k0, int n0, LAS float* scr, int lane) {
    TrItem I{W, WT, ldw, ldt, k0, n0, MAP}; float tv[32]; p0_tr_load(I, tv, lane); p0_tr_finish(I, tv, scr, lane);
}
template <bool MAP> __device__ __forceinline__ void p0_tr_item2(const float* W, int ldw, bf16* WT, int ldt, int k0, int n0, LAS float* scr, int lane) {
    TrItem I0{W, WT, ldw, ldt, k0, n0, MAP}, I1{W, WT, ldw, ldt, k0, n0 + 32, MAP}; float t0[32], t1[32];
    p0_tr_load(I0, t0, lane); p0_tr_load(I1, t1, lane); p0_tr_finish(I0, t0, scr, lane); p0_tr_finish(I1, t1, scr, lane);
}
__device__ __forceinline__ void sincos_acc(float ang, float& s, float& c) {
    const double a = (double)ang; const double kq = rint(a * 0.63661977236758134308); const double r = fma(-kq, 1.57079632679489661923, a);
    const double r2 = r * r;
    const double sp = r * (1.0 + r2 * (-1.6666666666666666e-1 + r2 * (8.3333333333333332e-3 + r2 * (-1.9841269841269841e-4 + r2 * (2.7557319223985893e-6 + r2 * (-2.5052108385441720e-8))))));
    const double cp = 1.0 + r2 * (-0.5 + r2 * (4.1666666666666664e-2 + r2 * (-1.3888888888888889e-3 + r2 * (2.4801587301587302e-5 + r2 * (-2.7557319223985888e-7 + r2 * 2.0876756987868099e-9)))));
    const int q = ((int)kq) & 3;
    const double ss = (q == 0) ? sp : (q == 1) ? cp : (q == 2) ? -sp : -cp;
    const double cc = (q == 0) ? cp : (q == 1) ? -sp : (q == 2) ? -cp : sp;
    s = (float)ss; c = (float)cc;
}

__device__ __forceinline__ void p0_prologue(Frame& F) {
    const int gw = F.bid * NWAVES + F.wave, NGW = F.G * NWAVES, lane = F.lane;
    LAS float* scr = (LAS float*)(F.lds + F.wave * 16384);
    {
        constexpr int I_IN = 16 * 240, I_BR = 8 * 32, I_OUT = 16 * 32, I_UP = 16 * 176, I_DN = 44 * 32, I_L = I_IN + 3 * I_BR + I_OUT + I_UP + I_DN;
        for (int it = gw; it < 2 * I_L; it += NGW) {
            const int l = it / I_L; int r = it % I_L;
            if (r < I_IN) { p0_tr_item<true>(FIN(I_WIN) + (size_t)l * DM * D_IN, D_IN, WSP(bf16, WS_WIN) + (size_t)l * NIN * DM, DM, 64 * (r / 240), 32 * (r % 240), scr, lane); continue; } r -= I_IN;
            if (r < 3 * I_BR) { const int w = r / I_BR, q = r % I_BR; const float* src = FIN(w == 0 ? I_WBRA : (w == 1 ? I_WBRB : I_WBRC)) + (size_t)l * 512 * 1024;
                p0_tr_item<false>(src, 1024, WSP(bf16, WS_WBR) + (size_t)(l * 3 + w) * 1024 * 512, 512, 64 * (q / 32), 32 * (q % 32), scr, lane); continue; } r -= 3 * I_BR;
            if (r < I_OUT) { p0_tr_item<false>(FIN(I_WOUT) + (size_t)l * 1024 * 1024, 1024, WSP(bf16, WS_WOUT) + (size_t)l * 1024 * 1024, 1024, 64 * (r / 32), 32 * (r % 32), scr, lane); continue; } r -= I_OUT;
            if (r < I_UP) { p0_tr_item<false>(FIN(I_WUP) + (size_t)l * DM * NUP, NUP, WSP(bf16, WS_WUP) + (size_t)l * NUP * DM, DM, 64 * (r / 176), 32 * (r % 176), scr, lane); continue; } r -= I_UP;
            p0_tr_item<false>(FIN(I_WDN) + (size_t)l * DFF * DM, DM, WSP(bf16, WS_WDN) + (size_t)l * DM * DFF, DFF, 64 * (r / 32), 32 * (r % 32), scr, lane);
        }
    }
    {
        constexpr int NI_W1 = 8 * 16 * 4, NI_W2 = 4 * 2 * 2, NI_RG = 32 * 2;
        for (int it = gw; it < NI_W1 + NI_W2 + NI_RG; it += NGW) {
            int r = it;
            if (r < NI_W1) { const int m = r / 64, q = r % 64, lk = m >> 1, half = m & 1;
                p0_tr_item<false>(FIN(I_W1) + ((size_t)lk * 32 + half * 16) * 64 * 128, 128, WSP(bf16, WS_SMALLW + SW_W1T) + ((size_t)lk * 256 + half * 128) * 1024, 1024, 64 * (q / 4), 32 * (q % 4), scr, lane); continue; } r -= NI_W1;
            if (r < NI_W2) { const int lk = r / 4, q = r % 4;
                p0_tr_item<false>(FIN(I_W2) + (size_t)lk * 128 * 64, 64, WSP(bf16, WS_SMALLW + SW_W2T) + (size_t)lk * 64 * 128, 128, 64 * (q / 2), 32 * (q % 2), scr, lane); continue; } r -= NI_W2;
            { const int m = r / 2, q = r % 2, l = m >> 4, which = (m >> 3) & 1, blk = m & 7;
                p0_tr_item<false>(FIN(which ? I_RWX : I_RWA) + ((size_t)l * 8 + blk) * 4096, 64, WSP(bf16, WS_SMALLW + SW_WAT) + (size_t)m * 4096, 64, 0, 32 * q, scr, lane); }
        }
    }
    for (int it = gw; it < 64; it += NGW) {
        const int lk = it >> 4, h0 = (it & 15) * 8; const float* pe = FIN(I_PE) + (size_t)lk * 2048; const float* w1 = FIN(I_W1) + (size_t)lk * 2048 * 128 + h0;
        f32x4 a0 = (f32x4){0.f, 0.f, 0.f, 0.f}, a1 = a0;
#pragma unroll 8
        for (int i = lane; i < 2048; i += 64) { const float p = pe[i]; a0 += *(const f32x4*)(w1 + (size_t)i * 128) * p; a1 += *(const f32x4*)(w1 + (size_t)i * 128 + 4) * p; }
#pragma unroll
        for (int x = 0; x < 4; ++x) { a0[x] = wave_sum(a0[x]); a1[x] = wave_sum(a1[x]); }
        if (lane == 0) { float* cb = WSP(float, WS_SMALLW + SW_CB) + lk * 128 + h0; const float* b1 = FIN(I_B1) + lk * 128 + h0;
#pragma unroll
            for (int x = 0; x < 4; ++x) { cb[x] = a0[x] + b1[x]; cb[4 + x] = a1[x] + b1[4 + x]; } }
    }
    for (int i = F.bid * NTHR + F.tid; i < 1024; i += F.G * NTHR) { const float lam = FIN(I_LAM)[i]; WSP(float, WS_SMALLW + SW_SP)[i] = log1pf(expf(-lam)); }
    for (int i = F.bid * NTHR + F.tid; i < 2 * SB * 2 * DFF; i += F.G * NTHR) WSP(bf16, WS_SFB)[i] = (bf16)(pk2(FIN(I_SFFN)[i], 0.f) & 0xffffu);
    for (int i = F.bid * NTHR + F.tid; i < 4104 * 64; i += F.G * NTHR) {
        const int pi = i >> 6, fi = i & 63; const float pos = (float)(pi < PT ? pi : PAST + (pi - PT));
        const float freq = (float)pow(10000.0, -(double)fi / 64.0); const float ang = pos * freq; float s, c; sincos_acc(ang, s, c);
        WSP(float, WS_ROT)[i] = c; WSP(float, WS_ROT)[4104 * 64 + i] = s;
    }
    {
        LAS float* SC = (LAS float*)(F.lds + 0);
        LAS float* RED = (LAS float*)(F.lds + 36864);
        for (int u = F.bid; u < 2 * 96; u += F.G) {
            const int l = u / 96, cg = u % 96; float acc[36];
#pragma unroll
            for (int b = 0; b < 36; ++b) acc[b] = 0.f;
#pragma unroll 1
            for (int kh = 0; kh < 4; ++kh) {
                __syncthreads();
                {   float cv[18];
                    const float* cpp = FIN(I_CP); const float* csp = FIN(I_CS);
#pragma unroll
                    for (int it = 0; it < 18; ++it) { const int i = F.tid + NTHR * it, bb = i >> 8, d = i & 255;
                        cv[it] = (bb < 4) ? cpp[bb * DM + kh * 256 + d] : csp[(bb - 4) * DM + kh * 256 + d]; }
#pragma unroll
                    for (int it = 0; it < 18; ++it) { const int i = F.tid + NTHR * it, bb = i >> 8, d = i & 255; SC[d * 36 + bb] = siluf_(cv[it]); }
                }
                __syncthreads();
                const float* wp = FIN(I_WADA) + ((size_t)l * DM + kh * 256 + F.wave * 32) * 6144 + cg * 64 + lane;
                {
                    float wv[32];
#pragma unroll
                    for (int k = 0; k < 32; ++k) wv[k] = wp[(size_t)k * 6144];
                    const LAS f32x4* scb = (const LAS f32x4*)(SC + (F.wave * 32) * 36);
                    f32x4 sa[9], sb[9];
#pragma unroll
                    for (int g = 0; g < 9; ++g) sa[g] = scb[g];
#pragma unroll
                    for (int k = 0; k < 32; k += 2) {
#pragma unroll
                        for (int g = 0; g < 9; ++g) sb[g] = scb[(k + 1) * 9 + g];
#pragma unroll
                        for (int g = 0; g < 9; ++g) { acc[4 * g + 0] += wv[k] * sa[g][0]; acc[4 * g + 1] += wv[k] * sa[g][1]; acc[4 * g + 2] += wv[k] * sa[g][2]; acc[4 * g + 3] += wv[k] * sa[g][3]; }
                        if (k + 2 < 32) {
#pragma unroll
                            for (int g = 0; g < 9; ++g) sa[g] = scb[(k + 2) * 9 + g]; }
#pragma unroll
                        for (int g = 0; g < 9; ++g) { acc[4 * g + 0] += wv[k + 1] * sb[g][0]; acc[4 * g + 1] += wv[k + 1] * sb[g][1]; acc[4 * g + 2] += wv[k + 1] * sb[g][2]; acc[4 * g + 3] += wv[k + 1] * sb[g][3]; }
                    }
                }
            }
#pragma unroll
            for (int b = 0; b < 36; ++b) RED[(F.wave * 36 + b) * 64 + lane] = acc[b];
            __syncthreads();
            for (int o = F.tid; o < 36 * 64; o += NTHR) { const int b = o >> 6, col = o & 63; float sm = FIN(I_BADA)[l * 6144 + cg * 64 + col];
#pragma unroll
                for (int w = 0; w < 8; ++w) sm += RED[(w * 36 + b) * 64 + col];
                WSP(float, WS_MOD)[((size_t)l * 36 + b) * 6144 + cg * 64 + col] = sm; }
        }
        __syncthreads();
    }
    {   constexpr size_t NV4 = (size_t)2 * SB * 504 * 64; const size_t stride = (size_t)F.G * NTHR;
        for (size_t i0 = (size_t)F.bid * NTHR + F.tid; i0 < NV4; i0 += 8 * stride) {
            f32x4 v[8];
#pragma unroll
            for (int k = 0; k < 8; ++k) { const size_t i = i0 + k * stride; if (i < NV4) { const size_t seq = i / (504 * 64), r = i % (504 * 64); v[k] = __builtin_nontemporal_load((const f32x4*)(FIN(I_CWIN) + (seq * 512 + 8) * 256 + r * 4)); } }
#pragma unroll
            for (int k = 0; k < 8; ++k) { const size_t i = i0 + k * stride; if (i < NV4) { const size_t seq = i / (504 * 64), r = i % (504 * 64); *(f32x4*)(F.out + OUT_WIN_S + seq * 512 * 256 + r * 4) = v[k]; } }
        }
    }
}

__device__ __forceinline__ f32x4 ld4_bf(const bf16* p) { const v2u w = *(const v2u*)p; return (f32x4){bf_lo(w.x), bf_hi(w.x), bf_lo(w.y), bf_hi(w.y)}; }
__device__ __forceinline__ void norm_phase(Frame& F, int l, int which) {
    const int gw = F.bid * NWAVES + F.wave, NGW = F.G * NWAVES, lane = F.lane;
    const float* g = FIN(which ? I_N2G : I_N1G) + l * DM;
    constexpr int NR = 4;
    for (int row0 = gw * NR; row0 < MT; row0 += NGW * NR) {
        f32x4 v[NR][4]; float ss[NR];
#pragma unroll
        for (int rr = 0; rr < NR; ++rr) { const int row = row0 + rr;
            if (which == 0 && l == 0) { const float* xr = row < PM ? FIN(I_XP) + (size_t)row * DM : FIN(I_XS) + (size_t)(row - PM) * DM;
#pragma unroll
                for (int j = 0; j < 4; ++j) v[rr][j] = *(const f32x4*)(xr + lane * 4 + 256 * j); }
            else { const bf16* xr = WSP(bf16, which ? WS_X1 : WS_X2) + (size_t)row * DM;
#pragma unroll
                for (int j = 0; j < 4; ++j) v[rr][j] = ld4_bf(xr + lane * 4 + 256 * j); } }
#pragma unroll
        for (int rr = 0; rr < NR; ++rr) { float a = 0.f;
#pragma unroll
            for (int j = 0; j < 4; ++j) a += (v[rr][j][0] * v[rr][j][0] + v[rr][j][1] * v[rr][j][1]) + (v[rr][j][2] * v[rr][j][2] + v[rr][j][3] * v[rr][j][3]);
            ss[rr] = a; }
#pragma unroll
        for (int o = 1; o < 64; o <<= 1) {
#pragma unroll
            for (int rr = 0; rr < NR; ++rr) ss[rr] += __shfl_xor(ss[rr], o); }
#pragma unroll
        for (int rr = 0; rr < NR; ++rr) { const int row = row0 + rr; const float rs = 1.0f / sqrtf(ss[rr] * (1.0f / DM) + EPS);
            const float* mod = WSP(float, WS_MOD) + ((size_t)l * 36 + row_bb(row)) * 6144 + (which ? 3072 : 0); bf16* o = WSP(bf16, WS_H) + (size_t)row * DM;
#pragma unroll
            for (int j = 0; j < 4; ++j) { const int c = lane * 4 + 256 * j; const f32x4 gg = *(const f32x4*)(g + c), sh = *(const f32x4*)(mod + c), sc = *(const f32x4*)(mod + 1024 + c);
                const f32x4 y = (v[rr][j] * rs) * gg * (sc + 1.0f) + sh; v2u w; w.x = pk2(y[0], y[1]); w.y = pk2(y[2], y[3]); *(v2u*)(o + c) = w; } }
    }
}
__device__ __forceinline__ void final_phase(Frame& F) {
    const int gw = F.bid * NWAVES + F.wave, NGW = F.G * NWAVES, lane = F.lane;
    const float* g = FIN(I_FNG);
    for (int row0 = gw * 4; row0 < MT; row0 += NGW * 4) {
        f32x4 v[4][4]; float ss[4];
#pragma unroll
        for (int rr = 0; rr < 4; ++rr) { const bf16* xr = WSP(bf16, WS_X2) + (size_t)(row0 + rr) * DM; float a = 0.f;
#pragma unroll
            for (int j = 0; j < 4; ++j) { v[rr][j] = ld4_bf(xr + lane * 4 + 256 * j); a += (v[rr][j][0] * v[rr][j][0] + v[rr][j][1] * v[rr][j][1]) + (v[rr][j][2] * v[rr][j][2] + v[rr][j][3] * v[rr][j][3]); }
            ss[rr] = a; }
#pragma unroll
        for (int rr = 0; rr < 4; ++rr) { const float rs = 1.0f / sqrtf(wave_sum(ss[rr]) * (1.0f / DM) + EPS);
            float* o = F.out + OUT_Y + (size_t)(row0 + rr) * DM;
#pragma unroll
            for (int j = 0; j < 4; ++j) { const int c = lane * 4 + 256 * j; *(f32x4*)(o + c) = (v[rr][j] * rs) * *(const f32x4*)(g + c); } }
    }
}

#define EPI_LOOP_BEGIN \
    _Pragma("unroll") for (int ai = 0; ai < 2; ++ai) _Pragma("unroll") for (int m = 0; m < 4; ++m) { const int row = u.pm * 256 + ai * 128 + wr * 64 + m * 16 + fr; \
    _Pragma("unroll") for (int bj = 0; bj < 2; ++bj) { const int ct = bj * 128 + wc * 32 + 8 * fq; const f32x4 v0 = acc[ai][bj][m][0], v1 = acc[ai][bj][m][1];
#define EPI_LOOP_END } }

struct EpiWin {
    static constexpr bool PERM = true, AFTER_DRAIN = false;
    unsigned char* ws; float* out; int l;
    __device__ __forceinline__ void operator()(const f32x4 (&acc)[2][2][4][2], const pg8::Unit& u, int wr, int wc, int fr0, int fq0) const {
        int fr = fr0, fq = fq0; asm volatile("" : "+v"(fr), "+v"(fq));
        const int pn = u.pn;
        if (pn < 2) {
            bf16* QN = (bf16*)(ws + WS_QN);
            EPI_LOOP_BEGIN *(v4u*)(QN + (size_t)row * 512 + pn * 256 + ct) = pack8(v0 * QSCALE, v1 * QSCALE); EPI_LOOP_END
        } else if (pn < 5) {
            EPI_LOOP_BEGIN
                const int c = (pn - 2) * 256 + ct, j = c >> 7, k = (c >> 6) & 1, d = c & 63;
                const bool isp = row < PM; const int b = isp ? (row >> 12) : ((row - PM) >> 3), t = isp ? (row & (PT - 1)) : ((row - PM) & 7);
                if (j < 4) { float* o = out + (isp ? OUT_ROWS_P + ((size_t)l * PM + row) * 512 : OUT_ROWS_S + ((size_t)l * SM + (row - PM)) * 512) + c; *(f32x4*)o = v0; *(f32x4*)(o + 4) = v1; }
                else if (isp) { if (t >= PT - WINB) { float* o = out + OUT_WIN_P + (((size_t)l * PB + b) * WINB + (t - (PT - WINB))) * 256 + (c - 512); *(f32x4*)o = v0; *(f32x4*)(o + 4) = v1; } }
                else { float* o = out + OUT_WIN_S + (((size_t)l * SB + b) * WINB + (WINB - ST) + t) * 256 + (c - 512); *(f32x4*)o = v0; *(f32x4*)(o + 4) = v1; }
                const v4u w = pack8(v0, v1);
                if (isp) {
                    if (j < 2) *(v4u*)((bf16*)(ws + WS_ACMP) + ((size_t)(l * 2 + j) * CMP_ROWS_J + 32768 + (b * 2 + k) * 256) * 1024 + (size_t)t * 64 + d) = w;
                    else if (j & 1) {
                        const int tq = t & 31, s2 = tq >> 4, hh = (tq >> 2) & 1, ii = (tq & 3) + 4 * ((tq >> 3) & 1);
                        bf16* vt = (bf16*)(ws + WS_KVB) + (((size_t)(j - 2) * PB + b) * 2 + k) * PT * 64 + (size_t)(t >> 5) * 2048 + ((((d >> 5) * 2 + s2) * 2 + hh) * 32 + (d & 31)) * 8 + ii;
                        vt[0] = (bf16)(w.x & 0xffffu); vt[8] = (bf16)(w.x >> 16); vt[16] = (bf16)(w.y & 0xffffu); vt[24] = (bf16)(w.y >> 16);
                        vt[32] = (bf16)(w.z & 0xffffu); vt[40] = (bf16)(w.z >> 16); vt[48] = (bf16)(w.w & 0xffffu); vt[56] = (bf16)(w.w >> 16); }
                    else *(v4u*)((bf16*)(ws + WS_KVB) + (((size_t)(j - 2) * PB + b) * 2 + k) * PT * 64 + (size_t)(t >> 5) * 2048 + ((d >> 3) * 32 + (t & 31)) * 8) = w;
                } else if (j >= 2) *(v4u*)((bf16*)(ws + WS_KVS) + ((((size_t)(j - 2) * SB + b) * 2 + k) * ST + t) * 64 + d) = w;
            EPI_LOOP_END
        } else if (pn < 9) {
            const float* ROTC = (const float*)(ws + WS_ROT); const float* ROTS = ROTC + 4104 * 64;
#pragma unroll
            for (int ai = 0; ai < 2; ++ai) {
                f32x4 cs[4][2], sn[4][2];
#pragma unroll
                for (int m = 0; m < 4; ++m) { const int row = u.pm * 256 + ai * 128 + wr * 64 + m * 16 + fr; const int pi = row_pos(row);
#pragma unroll
                    for (int bj = 0; bj < 2; ++bj) { const int ct = bj * 128 + wc * 32 + 8 * fq; const int c = (pn - 5) * 256 + ct, d0 = (((c & 511) & 127) >> 3) * 4; cs[m][bj] = *(const f32x4*)(ROTC + pi * 64 + d0); sn[m][bj] = *(const f32x4*)(ROTS + pi * 64 + d0); } }
#pragma unroll
                for (int m = 0; m < 4; ++m) { const int row = u.pm * 256 + ai * 128 + wr * 64 + m * 16 + fr;
#pragma unroll
                    for (int bj = 0; bj < 2; ++bj) { const int ct = bj * 128 + wc * 32 + 8 * fq; const f32x4 v0 = acc[ai][bj][m][0], v1 = acc[ai][bj][m][1];
                        const int c = (pn - 5) * 256 + ct, isk = c >> 9, hc = c & 511, head = hc >> 7, d0 = ((hc & 127) >> 3) * 4;
                        const float sc = isk ? 0.08838834764831845f : 1.0f;
                        const f32x4 o1 = (v0 * cs[m][bj] - v1 * sn[m][bj]) * sc, o2 = (v0 * sn[m][bj] + v1 * cs[m][bj]) * sc;
                        bf16* o = (bf16*)(ws + WS_RQ) + (size_t)isk * MT * 512 + (size_t)row * 512 + head * 128 + d0;
                        v2u w1; w1.x = pk2(o1[0], o1[1]); w1.y = pk2(o1[2], o1[3]); *(v2u*)o = w1;
                        v2u w2; w2.x = pk2(o2[0], o2[1]); w2.y = pk2(o2[2], o2[3]); *(v2u*)(o + 64) = w2; } }
            }
        } else if (pn < 13) {
            bf16* RV = (bf16*)(ws + WS_RQ) + (size_t)2 * MT * 512;
            EPI_LOOP_BEGIN const int c = (pn - 9) * 256 + ct; *(v4u*)(RV + (size_t)(c >> 9) * MT * 512 + (size_t)row * 512 + (c & 511)) = pack8(v0, v1); EPI_LOOP_END
        } else if (pn < 15) {
            float* RX = (float*)(ws + WS_RX);
            EPI_LOOP_BEGIN
                const int c = (pn - 13) * 256 + ct; float* o = RX + (size_t)row * 512 + c; *(f32x4*)o = v0; *(f32x4*)(o + 4) = v1;
                if (row < PM) { const int t = row & (PT - 1); if (t >= PT - 3) { float* q = out + OUT_CV_P + (((size_t)l * PB + (row >> 12)) * 3 + (t - (PT - 3))) * 512 + c; *(f32x4*)q = v0; *(f32x4*)(q + 4) = v1; } }
                else { const int i = (row - PM) & 7; if (i >= ST - 3) { float* q = out + OUT_CV_S + (((size_t)l * SB + ((row - PM) >> 3)) * 3 + (i - (ST - 3))) * 512 + c; *(f32x4*)q = v0; *(f32x4*)(q + 4) = v1; } }
            EPI_LOOP_END
        } else if (pn < 17) {
            bf16* GG = (bf16*)(ws + WS_GG);
            EPI_LOOP_BEGIN const int c = (pn - 15) * 256 + ct;
                f32x4 a, b;
#pragma unroll
                for (int i = 0; i < 4; ++i) { a[i] = gelu_tanh(v0[i]); b[i] = gelu_tanh(v1[i]); }
                *(v4u*)(GG + (size_t)row * 512 + c) = pack8(a, b); EPI_LOOP_END
        } else if (pn < 29) {
            bf16* MG = (bf16*)(ws + WS_MGS);
            EPI_LOOP_BEGIN const int c = (pn - 17) * 256 + ct;
                f32x4 a, b;
#pragma unroll
                for (int i = 0; i < 4; ++i) { a[i] = sigmoidf_(v0[i]); b[i] = sigmoidf_(v1[i]); }
                *(v4u*)(MG + (size_t)row * 3072 + c) = pack8(a, b); EPI_LOOP_END
        } else {
            float* NG = (float*)(ws + WS_NG);
            EPI_LOOP_BEGIN if (ct < 24) { f32x4 a, b;
#pragma unroll
                for (int i = 0; i < 4; ++i) { a[i] = sigmoidf_(v0[i]); b[i] = sigmoidf_(v1[i]); }
                float* o = NG + (size_t)row * 24 + ct; *(f32x4*)o = a; *(f32x4*)(o + 4) = b; } EPI_LOOP_END
        }
    }
};

struct EpiLH {
    static constexpr bool PERM = true, AFTER_DRAIN = false;
    bf16* LH;
    __device__ __forceinline__ void operator()(const f32x4 (&acc)[2][2][4][2], const pg8::Unit& u, int wr, int wc, int fr0, int fq0) const {
        int fr = fr0, fq = fq0; asm volatile("" : "+v"(fr), "+v"(fq));
        EPI_LOOP_BEGIN *(v4u*)(LH + (size_t)row * 256 + ct) = pack8(v0, v1); EPI_LOOP_END
    }
};
struct CmpOrder {
    int G, c;
    __device__ bool next(int i, pg8::Unit& u) const { const int L = i * G + c; if (L >= CMP_ROWS / 256) return false; u.pm = L; u.pn = L / (CMP_ROWS_J / 256); return true; }
    __device__ __forceinline__ void a_ready(const pg8::Unit&) const {}
    __device__ __forceinline__ void done(const pg8::Unit&) const {}
};

template <int BR> struct EpiBr {
    static constexpr bool PERM = true, AFTER_DRAIN = false;
    unsigned char* ws;
    __device__ __forceinline__ void operator()(const f32x4 (&acc)[2][2][4][2], const pg8::Unit& u, int wr, int wc, int fr0, int fq0) const {
        int fr = fr0, fq = fq0; asm volatile("" : "+v"(fr), "+v"(fq));
        const bf16* MG = (const bf16*)(ws + WS_MGS); bf16* MR = (bf16*)(ws + WS_MRG);
        EPI_LOOP_BEGIN
            const int col = u.pn * 256 + ct; f32x4 g0, g1; unpack8(*(const v4u*)(MG + (size_t)row * 3072 + BR * 1024 + col), g0, g1);
            f32x4 r0 = v0 * g0, r1 = v1 * g1; bf16* o = MR + (size_t)row * DM + col;
            if (BR > 0) { f32x4 p0, p1; unpack8(*(const v4u*)o, p0, p1); r0 += p0; r1 += p1; }
            *(v4u*)o = pack8(r0, r1);
        EPI_LOOP_END
    }
};

struct BrOrder {
    pg8::StaticOrder S;
    __device__ bool next(int i, pg8::Unit& u) const { pg8::Unit t; if (!S.next(i / 3, t)) return false; const int br = i % 3; u.pm = br * (MT / 256) + t.pm; u.pn = br * 4 + t.pn; return true; }
    __device__ __forceinline__ void a_ready(const pg8::Unit&) const {}
    __device__ __forceinline__ void done(const pg8::Unit&) const {}
};
struct EpiBrAll {
    static constexpr bool PERM = true, AFTER_DRAIN = false;
    unsigned char* ws;
    __device__ __forceinline__ void operator()(const f32x4 (&acc)[2][2][4][2], const pg8::Unit& u0, int wr, int wc, int fr0, int fq0) const {
        int fr = fr0, fq = fq0; asm volatile("" : "+v"(fr), "+v"(fq));
        const int br = u0.pn >> 2; const pg8::Unit u{u0.pm - br * (MT / 256), u0.pn & 3};
        const bf16* MG = (const bf16*)(ws + WS_MGS) + br * 1024; bf16* MR = (bf16*)(ws + WS_MRG);
#pragma unroll
        for (int ai = 0; ai < 2; ++ai) {
            v4u gw[4][2], pw[4][2];
#pragma unroll
            for (int m = 0; m < 4; ++m) { const int row = u.pm * 256 + ai * 128 + wr * 64 + m * 16 + fr;
#pragma unroll
                for (int bj = 0; bj < 2; ++bj) { const int col = u.pn * 256 + bj * 128 + wc * 32 + 8 * fq; gw[m][bj] = *(const v4u*)(MG + (size_t)row * 3072 + col); if (br != 0) pw[m][bj] = *(const v4u*)(MR + (size_t)row * DM + col); } }
#pragma unroll
            for (int m = 0; m < 4; ++m) { const int row = u.pm * 256 + ai * 128 + wr * 64 + m * 16 + fr;
#pragma unroll
                for (int bj = 0; bj < 2; ++bj) { const int col = u.pn * 256 + bj * 128 + wc * 32 + 8 * fq; const f32x4 v0 = acc[ai][bj][m][0], v1 = acc[ai][bj][m][1];
                    f32x4 g0, g1; unpack8(gw[m][bj], g0, g1); f32x4 r0 = v0 * g0, r1 = v1 * g1;
                    if (br != 0) { f32x4 p0, p1; unpack8(pw[m][bj], p0, p1); r0 += p0; r1 += p1; }
                    *(v4u*)(MR + (size_t)row * DM + col) = pack8(r0, r1); } }
        }
    }
};

template <bool INF32> struct EpiRes {
    static constexpr bool PERM = true, AFTER_DRAIN = false;
    const void* xin_p; bf16* xout; const float* mod; int gofs;
    __device__ __forceinline__ void operator()(const f32x4 (&acc)[2][2][4][2], const pg8::Unit& u, int wr, int wc, int fr0, int fq0) const {
        int fr = fr0, fq = fq0; asm volatile("" : "+v"(fr), "+v"(fq));
#pragma unroll
        for (int ai = 0; ai < 2; ++ai) {
            const float* gp = mod + (size_t)row_bb(u.pm * 256 + ai * 128) * 6144 + gofs + u.pn * 256 + wc * 32 + 8 * fq;
            f32x4 g[2][2];
#pragma unroll
            for (int bj = 0; bj < 2; ++bj) { g[bj][0] = *(const f32x4*)(gp + 128 * bj); g[bj][1] = *(const f32x4*)(gp + 128 * bj + 4); }
            if (INF32) {
#pragma unroll
                for (int mh = 0; mh < 2; ++mh) {
                    f32x4 xv[2][2][2];
#pragma unroll
                    for (int m2 = 0; m2 < 2; ++m2) { const int row = u.pm * 256 + ai * 128 + wr * 64 + (2 * mh + m2) * 16 + fr;
#pragma unroll
                        for (int bj = 0; bj < 2; ++bj) { const float* xi = (const float*)xin_p + (size_t)row * DM + u.pn * 256 + bj * 128 + wc * 32 + 8 * fq; xv[m2][bj][0] = *(const f32x4*)xi; xv[m2][bj][1] = *(const f32x4*)(xi + 4); } }
#pragma unroll
                    for (int m2 = 0; m2 < 2; ++m2) { const int m = 2 * mh + m2; const int row = u.pm * 256 + ai * 128 + wr * 64 + m * 16 + fr;
#pragma unroll
                        for (int bj = 0; bj < 2; ++bj) { const int col = u.pn * 256 + bj * 128 + wc * 32 + 8 * fq;
                            *(v4u*)(xout + (size_t)row * DM + col) = pack8(xv[m2][bj][0] + g[bj][0] * acc[ai][bj][m][0], xv[m2][bj][1] + g[bj][1] * acc[ai][bj][m][1]); } }
                }
            } else {
                v4u xw[4][2];
#pragma unroll
                for (int m = 0; m < 4; ++m) { const int row = u.pm * 256 + ai * 128 + wr * 64 + m * 16 + fr;
#pragma unroll
                    for (int bj = 0; bj < 2; ++bj) xw[m][bj] = *(const v4u*)((const bf16*)xin_p + (size_t)row * DM + u.pn * 256 + bj * 128 + wc * 32 + 8 * fq); }
#pragma unroll
                for (int m = 0; m < 4; ++m) { const int row = u.pm * 256 + ai * 128 + wr * 64 + m * 16 + fr;
#pragma unroll
                    for (int bj = 0; bj < 2; ++bj) { const int col = u.pn * 256 + bj * 128 + wc * 32 + 8 * fq; f32x4 x0, x1; unpack8(xw[m][bj], x0, x1);
                        *(v4u*)(xout + (size_t)row * DM + col) = pack8(x0 + g[bj][0] * acc[ai][bj][m][0], x1 + g[bj][1] * acc[ai][bj][m][1]); } }
            }
        }
    }
};

template <int CTRL> __device__ __forceinline__ v4u dpp4(const v4u old, const v4u src) {
    v4u r; r.x = (unsigned)__builtin_amdgcn_update_dpp((int)old.x, (int)src.x, CTRL, 0xf, 0xf, false); r.y = (unsigned)__builtin_amdgcn_update_dpp((int)old.y, (int)src.y, CTRL, 0xf, 0xf, false);
    r.z = (unsigned)__builtin_amdgcn_update_dpp((int)old.z, (int)src.z, CTRL, 0xf, 0xf, false); r.w = (unsigned)__builtin_amdgcn_update_dpp((int)old.w, (int)src.w, CTRL, 0xf, 0xf, false); return r; }
struct UpOrder {
    pg8::StaticOrder S;
    __device__ bool next(int i, pg8::Unit& u) const { pg8::Unit t; if (!S.next(i >> 1, t)) return false; u.pm = t.pm; u.pn = t.pn + 11 * (i & 1); return true; }
    __device__ __forceinline__ void a_ready(const pg8::Unit&) const {}
    __device__ __forceinline__ void done(const pg8::Unit&) const {}
};
struct EpiUp {
    static constexpr bool PERM = true, AFTER_DRAIN = false;
    unsigned char* ws; float* out; int l; const float* cw; const float* cbi; const bf16* sfb;
    __device__ __forceinline__ void operator()(const f32x4 (&acc)[2][2][4][2], const pg8::Unit& u, int wr, int wc, int fr0, int fq0) const {
        int fr = fr0, fq = fq0; asm volatile("" : "+v"(fr), "+v"(fq));
        bf16* GP = (bf16*)(ws + WS_GP); bf16* VAL = GP + (size_t)MT * DFF; bf16* ACT = GP + (size_t)2 * MT * DFF;
        if (u.pn < 11) {
            EPI_LOOP_BEGIN const int c = u.pn * 256 + ct; *(v4u*)(GP + (size_t)row * DFF + c) = pack8(v0, v1);
                if (row < PM) { const int t = row & (PT - 1); if (t >= PT - 2) { float* q = out + OUT_FC_P + (((size_t)l * PB + (row >> 12)) * 2 + (t - (PT - 2))) * DFF + c; *(f32x4*)q = v0; *(f32x4*)(q + 4) = v1; } }
                else { const int i = (row - PM) & 7; if (i >= ST - 2) { float* q = out + OUT_FC_S + (((size_t)l * SB + ((row - PM) >> 3)) * 2 + (i - (ST - 2))) * DFF + c; *(f32x4*)q = v0; *(f32x4*)(q + 4) = v1; } }
            EPI_LOOP_END
        } else if (u.pm * 256 >= PM) {
#pragma unroll
            for (int bj = 0; bj < 2; ++bj) { const int c = (u.pn - 11) * 256 + bj * 128 + wc * 32 + 8 * fq;
                const f32x4 w0a = *(const f32x4*)(cw + c), w0b = *(const f32x4*)(cw + c + 4), w1a = *(const f32x4*)(cw + DFF + c), w1b = *(const f32x4*)(cw + DFF + c + 4);
                const f32x4 w2a = *(const f32x4*)(cw + 2 * DFF + c), w2b = *(const f32x4*)(cw + 2 * DFF + c + 4), ba = *(const f32x4*)(cbi + c), bb = *(const f32x4*)(cbi + c + 4);
#pragma unroll
                for (int ai = 0; ai < 2; ++ai)
#pragma unroll
                  for (int mh = 0; mh < 2; ++mh) {
                    v4u g0[2], g1[2], g2[2];
#pragma unroll
                    for (int m2 = 0; m2 < 2; ++m2) { const int row = u.pm * 256 + ai * 128 + wr * 64 + (2 * mh + m2) * 16 + fr; const bf16* gp = GP + (size_t)row * DFF + c;
                        const bf16* sb = sfb + (size_t)((row - PM) >> 3) * 2 * DFF + c; const int i = (row - PM) & 7;
                        const bf16* q1 = (i < 1) ? sb + DFF : gp - DFF; const bf16* q2 = (i < 2) ? (i == 1 ? sb + DFF : sb) : gp - 2 * DFF;
                        g0[m2] = *(const v4u*)gp; g1[m2] = *(const v4u*)q1; g2[m2] = *(const v4u*)q2; }
#pragma unroll
                    for (int m2 = 0; m2 < 2; ++m2) { const int m = 2 * mh + m2; const int row = u.pm * 256 + ai * 128 + wr * 64 + m * 16 + fr; const int t = row & (PT - 1);
                        const f32x4 v0 = acc[ai][bj][m][0], v1 = acc[ai][bj][m][1];
                        if (false) { *(v4u*)(VAL + (size_t)row * DFF + c) = pack8(v0, v1); }
                        else { f32x4 xa, xb, pa, pb, qa, qb; unpack8(g0[m2], xa, xb); unpack8(g1[m2], pa, pb); unpack8(g2[m2], qa, qb);
                            f32x4 ya = ba + w0a * qa + w1a * pa + w2a * xa, yb = bb + w0b * qb + w1b * pb + w2b * xb;
#pragma unroll
                            for (int i = 0; i < 4; ++i) { ya[i] = siluf_(ya[i]) * v0[i]; yb[i] = siluf_(yb[i]) * v1[i]; }
                            *(v4u*)(ACT + (size_t)row * DFF + c) = pack8(ya, yb); } }
                  }
            }
                } else {
#pragma unroll
            for (int bj = 0; bj < 2; ++bj) { const int c = (u.pn - 11) * 256 + bj * 128 + wc * 32 + 8 * fq;
                const f32x4 w0a = *(const f32x4*)(cw + c), w0b = *(const f32x4*)(cw + c + 4), w1a = *(const f32x4*)(cw + DFF + c), w1b = *(const f32x4*)(cw + DFF + c + 4);
                const f32x4 w2a = *(const f32x4*)(cw + 2 * DFF + c), w2b = *(const f32x4*)(cw + 2 * DFF + c + 4), ba = *(const f32x4*)(cbi + c), bb = *(const f32x4*)(cbi + c + 4);
#pragma unroll
                for (int ai = 0; ai < 2; ++ai) {
                    v4u g[4], gm;
                    const int rowb = u.pm * 256 + ai * 128 + wr * 64 + fr;
#pragma unroll
                    for (int m = 0; m < 4; ++m) g[m] = *(const v4u*)(GP + (size_t)(rowb + m * 16) * DFF + c);
                    gm = (fr >= 14 && ((rowb - fr) & (PT - 1)) != 0) ? *(const v4u*)(GP + (size_t)(rowb - 16) * DFF + c) : (v4u){0u, 0u, 0u, 0u};
#pragma unroll
                    for (int m = 0; m < 4; ++m) { const int row = rowb + m * 16; const int t = row & (PT - 1);
                        const v4u pv = (m == 0) ? gm : g[m - 1];
                        const v4u t1 = dpp4<0x111>(dpp4<0x121>(pv, pv), g[m]), t2 = dpp4<0x112>(dpp4<0x122>(pv, pv), g[m]);
                        const f32x4 v0 = acc[ai][bj][m][0], v1 = acc[ai][bj][m][1];
                        if ((t & 255) < 2 && t >= 2) { *(v4u*)(VAL + (size_t)row * DFF + c) = pack8(v0, v1); }
                        else { f32x4 xa, xb, pa, pb, qa, qb; unpack8(g[m], xa, xb); unpack8(t1, pa, pb); unpack8(t2, qa, qb);
                            f32x4 ya = ba + w0a * qa + w1a * pa + w2a * xa, yb = bb + w0b * qb + w1b * pb + w2b * xb;
#pragma unroll
                            for (int i = 0; i < 4; ++i) { ya[i] = siluf_(ya[i]) * v0[i]; yb[i] = siluf_(yb[i]) * v1[i]; }
                            *(v4u*)(ACT + (size_t)row * DFF + c) = pack8(ya, yb); } }
                }
            }
        }
    }
};

__device__ __forceinline__ f32x16 mfma32(bf16x8 a, bf16x8 b, f32x16 c) { return __builtin_amdgcn_mfma_f32_32x32x16_bf16(a, b, c, 0, 0, 0); }
__device__ __forceinline__ f32x4 mfma16(bf16x8 a, bf16x8 b, f32x4 c) { return __builtin_amdgcn_mfma_f32_16x16x32_bf16(a, b, c, 0, 0, 0); }
__device__ __forceinline__ float ret_log_g(int h) { return log1pf(-exp2f(-5.0f - (float)h)); }
__device__ __forceinline__ bf16x8 tr_frag(const LAS unsigned char* base, int rs_bytes, int rowA, int rowB, int colbase, int lane) {
    const int q = (lane & 15) >> 2, p = lane & 3;
    const LAS unsigned char* pa = base + (rowA + q) * rs_bytes + (colbase + 4 * p) * 2;
    const LAS unsigned char* pb = base + (rowB + q) * rs_bytes + (colbase + 4 * p) * 2;
    const s16x4 a = __builtin_bit_cast(s16x4, __builtin_amdgcn_ds_read_tr16_b64_v4i16((LAS s16x4*)pa));
    const s16x4 b = __builtin_bit_cast(s16x4, __builtin_amdgcn_ds_read_tr16_b64_v4i16((LAS s16x4*)pb));
    return (bf16x8){a[0], a[1], a[2], a[3], b[0], b[1], b[2], b[3]};
}
__device__ __forceinline__ bf16x8 cvt_frag(const f32x16& p, int s2) {
    u32x4 w; w.x = pk2(p[8 * s2 + 0], p[8 * s2 + 1]); w.y = pk2(p[8 * s2 + 2], p[8 * s2 + 3]); w.z = pk2(p[8 * s2 + 4], p[8 * s2 + 5]); w.w = pk2(p[8 * s2 + 6], p[8 * s2 + 7]);
    return __builtin_bit_cast(bf16x8, w);
}

__device__ __forceinline__ void cmp2_phase(Frame& F, int l) {
    const int gw = F.bid * NWAVES + F.wave, NGW = F.G * NWAVES, lane = F.lane, r = lane & 15, g = lane >> 4;
    const bf16* LH = WSP(bf16, WS_LH); bf16* CK = WSP(bf16, WS_CK);
    const int j = gw & 1, gwj = gw >> 1, NGJ = NGW >> 1;
    const bf16* W2T = WSP(bf16, WS_SMALLW + SW_W2T) + (size_t)(l * 2 + j) * 64 * 128; const float* CB = WSP(float, WS_SMALLW + SW_CB) + (l * 2 + j) * 128;
    bf16x8 wf[4][4];
#pragma unroll
    for (int ks = 0; ks < 4; ++ks)
#pragma unroll
        for (int ct = 0; ct < 4; ++ct) wf[ks][ct] = *(const bf16x8*)(W2T + (size_t)(16 * ct + r) * 128 + 32 * ks + 8 * g);
    for (int wu = gwj; wu < CMP_ROWS_J / 16; wu += NGJ) {
        const int rj0 = wu * 16, rj = rj0 + r; const size_t row = (size_t)j * CMP_ROWS_J + rj;
        const bool valid = (rj < 32768) ? ((rj & 511) < 511) : (((rj - 32768) & 255) < 255);
        v4u la[4], lb[4];
#pragma unroll
        for (int ks = 0; ks < 4; ++ks) { const int h0 = 32 * ks + 8 * g; la[ks] = *(const v4u*)(LH + row * 256 + h0); lb[ks] = *(const v4u*)(LH + (row + 1) * 256 + 128 + h0); }
        f32x4 acc[4];
#pragma unroll
        for (int ct = 0; ct < 4; ++ct) acc[ct] = (f32x4){0.f, 0.f, 0.f, 0.f};
#pragma unroll
        for (int ks = 0; ks < 4; ++ks) {
            const int h0 = 32 * ks + 8 * g; f32x4 a0, a1, b0, b1;
            unpack8(la[ks], a0, a1); unpack8(lb[ks], b0, b1);
            const f32x4 c0 = *(const f32x4*)(CB + h0), c1 = *(const f32x4*)(CB + h0 + 4);
            f32x4 x0 = a0 + b0 + c0, x1 = a1 + b1 + c1;
#pragma unroll
            for (int i = 0; i < 4; ++i) { x0[i] = gelu_tanh(x0[i]); x1[i] = gelu_tanh(x1[i]); }
            const bf16x8 hf = __builtin_bit_cast(bf16x8, pack8(x0, x1));
#pragma unroll
            for (int ct = 0; ct < 4; ++ct) acc[ct] = mfma16(wf[ks][ct], hf, acc[ct]);
        }
#pragma unroll
        for (int ct = 0; ct < 4; ++ct) { const f32x4 v = valid ? acc[ct] : (f32x4){0.f, 0.f, 0.f, 0.f}; v2u w; w.x = pk2(v[0], v[1]); w.y = pk2(v[2], v[3]);
            *(v2u*)(CK + row * 64 + 16 * ct + 4 * g) = w; }
    }
}

constexpr int CG_RS = 144, CG_BUF = 256 * CG_RS, CG_AW = 2 * CG_BUF, CG_AT = 32 * CG_RS;
static_assert(CG_AW + 2 * 4 * CG_AT <= RING_BYTES, "compress GEMM LDS map");
template <bool smp> __device__ __forceinline__ void cmp_gemm_unit(Frame& F, int l, int j, int grp, int n00) {
    const int tid = F.tid, lane = F.lane, w = F.wave, q = lane & 31, h_ = lane >> 5, rg = w >> 1, ch = w & 1;
    const float* rp[4]; const bf16* ab = nullptr;
    if (smp) { const int db = grp >> 1, k = grp & 1;
#pragma unroll
        for (int i = 0; i < 4; ++i) { const int tt0 = (n00 + 32 * rg + 16 * ch + 4 * i + (lane >> 4)) * 16; const int page = ((const int*)F.a->in[I_PT])[db * NPG + (tt0 >> 7)];
            rp[i] = FIN(I_CACHE) + (((((size_t)l * NPHYS + page) * PAGE + (tt0 & 127)) * 4 + j) * 2 + k) * 64 + (lane & 15) * 4; } }
    else {
        ab = WSP(bf16, WS_ACMP) + ((size_t)(l * 2 + j) * CMP_ROWS_J + 32768 + grp * 256 + n00 + 32 * rg + 16 * ch + (lane >> 3)) * 1024 + (lane & 7) * 8;
#pragma unroll
        for (int i = 0; i < 4; ++i) rp[i] = nullptr; }
    const bf16* Bg = WSP(bf16, WS_SMALLW + SW_W1T) + (size_t)(l * 2 + j) * 256 * 1024;
    f32x16 acc[4];
#pragma unroll
    for (int ct = 0; ct < 4; ++ct) acc[ct] = (f32x16){};
    const bf16* bsrc = Bg + (size_t)(tid >> 1) * 1024 + (tid & 1) * 32; LAS unsigned char* bdst = F.lds + (tid >> 1) * CG_RS + (tid & 1) * 64;
    v4u bst[2][4]; f32x4 an[4][4]; v4u anb[4][2];
    __syncthreads();
#pragma unroll
    for (int x = 0; x < 4; ++x) bst[0][x] = *(const v4u*)(bsrc + 8 * x);
#pragma unroll
    for (int x = 0; x < 4; ++x) bst[1][x] = *(const v4u*)(bsrc + 64 + 8 * x);
#pragma unroll
    for (int d = 0; d < 4; ++d) {
        if (smp) {
#pragma unroll
            for (int i = 0; i < 4; ++i) an[d][i] = __builtin_nontemporal_load((const f32x4*)(rp[i] + (size_t)d * 512)); }
        else {
#pragma unroll
            for (int i = 0; i < 2; ++i) anb[d][i] = *(const v4u*)(ab + (size_t)(8 * i) * 1024 + d * 64); } }
#pragma unroll
    for (int x = 0; x < 4; ++x) *(LAS v4u*)(bdst + x * 16) = bst[0][x];
#define CG_CHUNK(d, LAST_) { const int kc = kc4 + (d); \
            LAS unsigned char* At = F.lds + CG_AW + (((d) & 1) * 4 + rg) * CG_AT; \
            if (!(LAST_) || (d) < 2) {                                   \
                _Pragma("unroll") for (int x = 0; x < 4; ++x) bst[(d) & 1][x] = *(const v4u*)(bsrc + (kc + 2) * 64 + 8 * x); } \
            if (smp) { \
                _Pragma("unroll") for (int i = 0; i < 4; ++i) { v2u o; o.x = pk2(an[d][i][0], an[d][i][1]); o.y = pk2(an[d][i][2], an[d][i][3]); *(LAS v2u*)(At + (16 * ch + 4 * i + (lane >> 4)) * CG_RS + (lane & 15) * 8) = o; } \
                if (!(LAST_)) { _Pragma("unroll") for (int i = 0; i < 4; ++i) an[d][i] = __builtin_nontemporal_load((const f32x4*)(rp[i] + (size_t)(kc + 4) * 512)); } \
            } else { \
                _Pragma("unroll") for (int i = 0; i < 2; ++i) *(LAS v4u*)(At + (16 * ch + 8 * i + (lane >> 3)) * CG_RS + (lane & 7) * 16) = anb[d][i]; \
                if (!(LAST_)) { _Pragma("unroll") for (int i = 0; i < 2; ++i) anb[d][i] = *(const v4u*)(ab + (size_t)(8 * i) * 1024 + (kc + 4) * 64); } \
            } \
            __syncthreads();                                           \
            bf16x8 ac[4]; \
            _Pragma("unroll") for (int ks = 0; ks < 4; ++ks) ac[ks] = *(const LAS bf16x8*)(At + q * CG_RS + ks * 32 + 16 * h_); \
            const LAS unsigned char* bb = F.lds + ((d) & 1) * CG_BUF + (128 * ch + q) * CG_RS + 16 * h_; \
            _Pragma("unroll") for (int ks = 0; ks < 4; ++ks) \
                _Pragma("unroll") for (int ct = 0; ct < 4; ++ct) { const bf16x8 bf = *(const LAS bf16x8*)(bb + ct * 32 * CG_RS + ks * 32); acc[ct] = mfma32(bf, ac[ks], acc[ct]); } \
            if (!(LAST_) || (d) < 3) { _Pragma("unroll") for (int x = 0; x < 4; ++x) *(LAS v4u*)(bdst + (((d) + 1) & 1) * CG_BUF + x * 16) = bst[((d) + 1) & 1][x]; } }
    int kc4 = 0;
#pragma unroll 1
    for (; kc4 < 12; kc4 += 4) { CG_CHUNK(0, false) CG_CHUNK(1, false) CG_CHUNK(2, false) CG_CHUNK(3, false) }
    { CG_CHUNK(0, true) CG_CHUNK(1, true) CG_CHUNK(2, true) CG_CHUNK(3, true) }
#undef CG_CHUNK
    bf16* LH = WSP(bf16, WS_LH) + ((size_t)j * CMP_ROWS_J + (smp ? grp * 512 : 32768 + grp * 256) + n00 + 32 * rg + q) * 256 + 128 * ch;
#pragma unroll
    for (int ct = 0; ct < 4; ++ct)
#pragma unroll
        for (int r4 = 0; r4 < 4; ++r4) { v2u o; o.x = pk2(acc[ct][4 * r4 + 0], acc[ct][4 * r4 + 1]); o.y = pk2(acc[ct][4 * r4 + 2], acc[ct][4 * r4 + 3]); *(v2u*)(LH + ct * 32 + 8 * r4 + 4 * h_) = o; }
}

constexpr int RS_KV = 272;
__device__ __forceinline__ void ret_local_unit(Frame& F, int unit) {
    const int bh = unit >> 5, c = unit & 31, b = bh >> 2, h = bh & 3, lane = F.lane, w = F.wave;
    const float lg = ret_log_g(h);
    LAS unsigned char* KS = F.lds; LAS unsigned char* VS = F.lds + 128 * RS_KV;
    const bf16* RK = WSP(bf16, WS_RQ) + (size_t)MT * 512; const bf16* RV = WSP(bf16, WS_RQ) + (size_t)2 * MT * 512;
    __syncthreads();
#pragma unroll
    for (int i = 0; i < 4; ++i) { const int p = F.tid + NTHR * i, j = p >> 4, ch = p & 15; const size_t go = (size_t)(b * PT + 128 * c + j) * 512 + h * 128 + ch * 8;
        f32x4 k0, k1; unpack8(*(const v4u*)(RK + go), k0, k1); const float kw = fexp((float)(127 - j) * lg);
        *(LAS v4u*)(KS + j * RS_KV + ch * 16) = pack8(k0 * kw, k1 * kw);
        *(LAS v4u*)(VS + j * RS_KV + ch * 16) = *(const v4u*)(RV + go); }
    __syncthreads();
    const int et = w >> 1, dt0 = 2 * (w & 1), h_ = lane >> 5, blk = (lane >> 4) & 1;
    f32x16 acc[2]; acc[0] = (f32x16){}; acc[1] = (f32x16){};
#pragma unroll
    for (int ks = 0; ks < 8; ++ks) {
        const int rA = 16 * ks + 8 * h_;
        const bf16x8 af = tr_frag(VS, RS_KV, rA, rA + 4, 32 * et + 16 * blk, lane);
#pragma unroll
        for (int dd = 0; dd < 2; ++dd) { const bf16x8 bfr = tr_frag(KS, RS_KV, rA, rA + 4, 32 * (dt0 + dd) + 16 * blk, lane); acc[dd] = mfma32(af, bfr, acc[dd]); }
    }
    bf16* LT = WSP(bf16, WS_LT) + ((size_t)bh * 32 + c) * 16384;
#pragma unroll
    for (int dd = 0; dd < 2; ++dd)
#pragma unroll
        for (int r = 0; r < 16; ++r) { const int e = 32 * et + (r & 3) + 8 * (r >> 2) + 4 * h_; LT[e * 128 + 32 * (dt0 + dd) + (lane & 31)] = (bf16)(pk2(acc[dd][r], 0.f) & 0xffffu); }
}
__device__ __forceinline__ void ret_scan_phase(Frame& F, int l) {
    const bf16* LT = WSP(bf16, WS_LT); bf16* SPT = WSP(bf16, WS_SPT);
    for (int idx = F.bid * NTHR + F.tid; idx < 16 * 16384; idx += F.G * NTHR) {
        const int bh = idx >> 14, ed = idx & 16383, e = ed >> 7, d = ed & 127, h = bh & 3; const float g128 = fexp(128.0f * ret_log_g(h));
        float S = 0.f;
        for (int c = 0; c < 32; ++c) { const size_t o = ((size_t)bh * 32 + c) * 16384 + ed; SPT[o] = (bf16)(pk2(S, 0.f) & 0xffffu); S = S * g128 + bf1(LT[o]); }
        F.out[OUT_RET_P + ((size_t)l * 16 + bh) * 16384 + d * 128 + e] = S;
    }
}
__device__ __forceinline__ void ret_out_unit(Frame& F, int l, int unit) {
    const int bh = unit >> 5, c = unit & 31, b = bh >> 2, h = bh & 3, lane = F.lane, w = F.wave, tid = F.tid;
    const float lg = ret_log_g(h);
    LAS unsigned char* KS = F.lds; LAS unsigned char* VS = F.lds + 128 * RS_KV; LAS float* OT = (LAS float*)F.lds; LAS float* STAT = (LAS float*)(F.lds + 2 * 128 * RS_KV);
    const bf16* RQ = WSP(bf16, WS_RQ); const bf16* RK = RQ + (size_t)MT * 512; const bf16* RV = RQ + (size_t)2 * MT * 512; const bf16* RG = RQ + (size_t)3 * MT * 512;
    const size_t row0 = (size_t)b * PT + 128 * c;
    __syncthreads();
#pragma unroll
    for (int i = 0; i < 4; ++i) { const int p = tid + NTHR * i, j = p >> 4, ch = p & 15; const size_t go = (row0 + j) * 512 + h * 128 + ch * 8;
        *(LAS v4u*)(KS + j * RS_KV + ch * 16) = *(const v4u*)(RK + go); *(LAS v4u*)(VS + j * RS_KV + ch * 16) = *(const v4u*)(RV + go); }
    const int it = w & 3, eh = w >> 2, h_ = lane >> 5, blk = (lane >> 4) & 1, il = 32 * it + (lane & 31);
    bf16x8 qf[8];
#pragma unroll
    for (int ks = 0; ks < 8; ++ks) qf[ks] = *(const bf16x8*)(RQ + (row0 + il) * 512 + h * 128 + 16 * ks + 8 * h_);
    f32x16 acc[2]; acc[0] = (f32x16){}; acc[1] = (f32x16){};
    const bf16* SP = WSP(bf16, WS_SPT) + ((size_t)bh * 32 + c) * 16384;
#pragma unroll
    for (int kb4 = 0; kb4 < 8; kb4 += 4) {
        bf16x8 af[4][2];
#pragma unroll
        for (int ks = 0; ks < 4; ++ks)
#pragma unroll
            for (int e2 = 0; e2 < 2; ++e2) af[ks][e2] = *(const bf16x8*)(SP + (size_t)(32 * (2 * eh + e2) + (lane & 31)) * 128 + 16 * (kb4 + ks) + 8 * h_);
#pragma unroll
        for (int ks = 0; ks < 4; ++ks)
#pragma unroll
            for (int e2 = 0; e2 < 2; ++e2) acc[e2] = mfma32(af[ks][e2], qf[kb4 + ks], acc[e2]);
    }
    { const float cr = fexp((float)(il + 1) * lg); acc[0] *= cr; acc[1] *= cr; }
    __syncthreads();
    for (int jt = 0; jt <= it; ++jt) {
        f32x16 s = (f32x16){};
#pragma unroll
        for (int ks = 0; ks < 8; ++ks) { const bf16x8 kf = *(const LAS bf16x8*)(KS + (32 * jt + (lane & 31)) * RS_KV + (16 * ks + 8 * h_) * 2); s = mfma32(kf, qf[ks], s); }
#pragma unroll
        for (int r = 0; r < 16; ++r) { const int j = 32 * jt + (r & 3) + 8 * (r >> 2) + 4 * h_; const int df = il - j; s[r] = (df >= 0) ? s[r] * fexp((float)df * lg) : 0.f; }
#pragma unroll
        for (int s2 = 0; s2 < 2; ++s2) { const bf16x8 pf = cvt_frag(s, s2); const int rA = 32 * jt + 16 * s2 + 4 * h_;
#pragma unroll
            for (int e2 = 0; e2 < 2; ++e2) { const bf16x8 vf = tr_frag(VS, RS_KV, rA, rA + 8, 32 * (2 * eh + e2) + 16 * blk, lane); acc[e2] = mfma32(vf, pf, acc[e2]); } }
    }
    float s1 = 0.f, s2 = 0.f;
#pragma unroll
    for (int e2 = 0; e2 < 2; ++e2)
#pragma unroll
        for (int r = 0; r < 16; ++r) { const float v = acc[e2][r]; s1 += v; s2 += v * v; }
    s1 += __shfl_xor(s1, 32); s2 += __shfl_xor(s2, 32);
    if (lane < 32) { STAT[(w * 32 + lane) * 2] = s1; STAT[(w * 32 + lane) * 2 + 1] = s2; }
    __syncthreads();
    { const int pw = w ^ 4; s1 += STAT[(pw * 32 + (lane & 31)) * 2]; s2 += STAT[(pw * 32 + (lane & 31)) * 2 + 1]; }
    const float mean = s1 * (1.0f / 128.0f), var = fmaxf(s2 * (1.0f / 128.0f) - mean * mean, 0.f), rstd = 1.0f / sqrtf(var + EPS);
#pragma unroll
    for (int e2 = 0; e2 < 2; ++e2)
#pragma unroll
        for (int r4 = 0; r4 < 4; ++r4) { const int e = 32 * (2 * eh + e2) + 8 * r4 + 4 * h_;
            f32x4 v; v[0] = (acc[e2][4 * r4 + 0] - mean) * rstd; v[1] = (acc[e2][4 * r4 + 1] - mean) * rstd; v[2] = (acc[e2][4 * r4 + 2] - mean) * rstd; v[3] = (acc[e2][4 * r4 + 3] - mean) * rstd;
            *(LAS f32x4*)(OT + il * 132 + e) = v; }
    __syncthreads();
    const float* GN = FIN(I_GNG) + l * 512 + h * 128; bf16* OR_ = WSP(bf16, WS_OA) + (size_t)MT * 512;
#pragma unroll
    for (int k = 0; k < 4; ++k) { const int q = tid + NTHR * k, i = q >> 4, ch = q & 15;
        const f32x4 o0 = *(const LAS f32x4*)(OT + i * 132 + 8 * ch), o1 = *(const LAS f32x4*)(OT + i * 132 + 8 * ch + 4);
        const f32x4 g0 = *(const f32x4*)(GN + 8 * ch), g1 = *(const f32x4*)(GN + 8 * ch + 4); f32x4 r0, r1; unpack8(*(const v4u*)(RG + (row0 + i) * 512 + h * 128 + 8 * ch), r0, r1);
        f32x4 y0, y1;
#pragma unroll
        for (int x = 0; x < 4; ++x) { y0[x] = o0[x] * g0[x] * siluf_(r0[x]); y1[x] = o1[x] * g1[x] * siluf_(r1[x]); }
        *(v4u*)(OR_ + (row0 + i) * 512 + h * 128 + 8 * ch) = pack8(y0, y1); }
}
__device__ __forceinline__ void ret_sample_unit(Frame& F, int l, int unit) {
    const int db = unit >> 2, h = unit & 3, tid = F.tid, e = tid & 127, dp = tid >> 7;
    const float lg = ret_log_g(h);
    LAS float* Q = (LAS float*)F.lds; LAS float* K = Q + 1024; LAS float* V = K + 1024; LAS float* GT = V + 1024; LAS float* CR = GT + 1024;
    LAS float* SC = CR + 4096; LAS float* RED = SC + 64;
    const bf16* RQ = WSP(bf16, WS_RQ); const size_t row0 = (size_t)PM + db * 8;
    __syncthreads();
    for (int i = tid; i < 4096; i += NTHR) { const int which = i >> 10, r = (i >> 7) & 7, d = i & 127; const float v = bf1(RQ[(size_t)which * MT * 512 + (row0 + r) * 512 + h * 128 + d]); Q[which * 1024 + r * 128 + d] = v; }
    __syncthreads();
    const float* S0 = FIN(I_SRET) + (((size_t)l * SB + db) * 4 + h) * 16384; float* SN = F.out + OUT_RET_S + (((size_t)l * SB + db) * 4 + h) * 16384;
    float kwv[8], cr[8];
#pragma unroll
    for (int j = 0; j < 8; ++j) { kwv[j] = V[j * 128 + e] * fexp((float)(7 - j) * lg); cr[j] = 0.f; }
    const float g8 = fexp(8.0f * lg);
    {   float s0v[32];
#pragma unroll
        for (int dd = 0; dd < 32; ++dd) s0v[dd] = S0[(dp * 32 + dd) * 128 + e];
#pragma unroll
        for (int dd = 0; dd < 32; ++dd) { const int d = dp * 32 + dd; const float s0 = s0v[dd]; float sn = g8 * s0;
#pragma unroll
            for (int j = 0; j < 8; ++j) { cr[j] += Q[j * 128 + d] * s0; sn += K[j * 128 + d] * kwv[j]; }
            SN[d * 128 + e] = sn; }
    }
#pragma unroll
    for (int i = 0; i < 8; ++i) CR[(dp * 8 + i) * 128 + e] = cr[i];
    if (tid < 64) { const int i = tid >> 3, j = tid & 7; float s = 0.f; if (j <= i) { for (int d = 0; d < 128; ++d) s += Q[i * 128 + d] * K[j * 128 + d]; s *= fexp((float)(i - j) * lg); } SC[tid] = s; }
    __syncthreads();
    float o[2];
#pragma unroll
    for (int ii = 0; ii < 2; ++ii) { const int i = 2 * dp + ii; float x = (CR[(0 * 8 + i) * 128 + e] + CR[(1 * 8 + i) * 128 + e] + CR[(2 * 8 + i) * 128 + e] + CR[(3 * 8 + i) * 128 + e]) * fexp((float)(i + 1) * lg);
        for (int j = 0; j <= i; ++j) x += SC[i * 8 + j] * V[j * 128 + e];
        o[ii] = x; }
#pragma unroll
    for (int ii = 0; ii < 2; ++ii) { const float a = wave_sum(o[ii]), q = wave_sum(o[ii] * o[ii]); if (F.lane == 0) { RED[(F.wave * 2 + ii) * 2] = a; RED[(F.wave * 2 + ii) * 2 + 1] = q; } }
    __syncthreads();
    const float* GN = FIN(I_GNG) + l * 512 + h * 128; bf16* OR_ = WSP(bf16, WS_OA) + (size_t)MT * 512;
#pragma unroll
    for (int ii = 0; ii < 2; ++ii) { const int i = 2 * dp + ii, w0 = 2 * dp; const float s1 = RED[(w0 * 2 + ii) * 2] + RED[((w0 + 1) * 2 + ii) * 2], s2 = RED[(w0 * 2 + ii) * 2 + 1] + RED[((w0 + 1) * 2 + ii) * 2 + 1];
        const float mean = s1 * (1.0f / 128.0f), var = fmaxf(s2 * (1.0f / 128.0f) - mean * mean, 0.f), rstd = 1.0f / sqrtf(var + EPS);
        const float y = (o[ii] - mean) * rstd * GN[e] * siluf_(GT[i * 128 + e]);
        OR_[(row0 + i) * 512 + h * 128 + e] = (bf16)(pk2(y, 0.f) & 0xffffu); }
}

template <int MODE> __device__ __forceinline__ void rglru_unit(Frame& F, int l, int unit) {
    const int tid = F.tid, c = tid, lane = F.lane, w = F.wave;
    LAS bf16* XC = (LAS bf16*)F.lds; LAS float* G = (LAS float*)(F.lds + 16384);
    const int seq = (MODE == 2) ? unit : (unit >> 6), tile = (MODE == 2) ? 0 : (unit & 63);
    const size_t row0 = (MODE == 2) ? (size_t)PM + seq * 8 : (size_t)seq * PT + tile * 64;
    const int ntok = (MODE == 2) ? 8 : 64, nsub = (MODE == 2) ? 1 : 4;
    const float* RX = WSP(float, WS_RX);
    const float w0 = FIN(I_RCW)[(l * 4 + 0) * 512 + c], w1 = FIN(I_RCW)[(l * 4 + 1) * 512 + c], w2 = FIN(I_RCW)[(l * 4 + 2) * 512 + c], w3 = FIN(I_RCW)[(l * 4 + 3) * 512 + c], cb = FIN(I_RCB)[l * 512 + c];
    const float ba = FIN(I_RBA)[l * 512 + c], bx = FIN(I_RBX)[l * 512 + c], sp = WSP(float, WS_SMALLW + SW_SP)[l * 512 + c];
    float x3, x2, x1;
    if (MODE == 2) { const float* cv = FIN(I_SCONV) + ((size_t)l * SB + seq) * 3 * 512; x3 = cv[c]; x2 = cv[512 + c]; x1 = cv[1024 + c]; }
    else if (tile == 0) { x3 = 0.f; x2 = 0.f; x1 = 0.f; }
    else { x3 = RX[(row0 - 3) * 512 + c]; x2 = RX[(row0 - 2) * 512 + c]; x1 = RX[(row0 - 1) * 512 + c]; }
    float h = (MODE == 0) ? 0.f : (MODE == 1) ? WSP(float, WS_CAR)[(size_t)4 * 64 * 2 * 512 + ((size_t)seq * 64 + tile) * 512 + c] : FIN(I_SH)[((size_t)l * SB + seq) * 512 + c];
    float aprod = 1.f;
    const int r16 = lane & 15, g4 = lane >> 4;
    bf16x8 wa[4][2], wx[4][2];
    { const bf16* WA = WSP(bf16, WS_SMALLW + SW_WAT) + ((size_t)(l * 2 + 0) * 8 + w) * 4096; const bf16* WX = WSP(bf16, WS_SMALLW + SW_WAT) + ((size_t)(l * 2 + 1) * 8 + w) * 4096;
#pragma unroll
      for (int ct = 0; ct < 4; ++ct)
#pragma unroll
          for (int ks = 0; ks < 2; ++ks) { wa[ct][ks] = *(const bf16x8*)(WA + (16 * ct + r16) * 64 + 32 * ks + 8 * g4); wx[ct][ks] = *(const bf16x8*)(WX + (16 * ct + r16) * 64 + 32 * ks + 8 * g4); } }
    const bf16* GG = WSP(bf16, WS_GG); bf16* OC = WSP(bf16, WS_OA) + (size_t)2 * MT * 512;
    __syncthreads();
    float xn[16]; bf16 gn[16];
#pragma unroll
    for (int tt = 0; tt < 16; ++tt) { xn[tt] = (tt < ntok) ? RX[(row0 + tt) * 512 + c] : 0.f; gn[tt] = (MODE != 0 && tt < ntok) ? GG[(row0 + tt) * 512 + c] : (bf16)0; }
    for (int s = 0; s < nsub; ++s) {
        float xc[16], gg[16];
#pragma unroll
        for (int tt = 0; tt < 16; ++tt) { xc[tt] = xn[tt]; gg[tt] = bf1(gn[tt]); }
        if (s + 1 < nsub) {
#pragma unroll
            for (int tt = 0; tt < 16; ++tt) { const int t = (s + 1) * 16 + tt; xn[tt] = RX[(row0 + t) * 512 + c]; gn[tt] = (MODE != 0) ? GG[(row0 + t) * 512 + c] : (bf16)0; } }
#pragma unroll
        for (int tt = 0; tt < 16; ++tt) { const float x0 = xc[tt];
            xc[tt] = cb + w0 * x3 + w1 * x2 + w2 * x1 + w3 * x0; x3 = x2; x2 = x1; x1 = x0; XC[tt * 512 + c] = (bf16)(pk2(xc[tt], 0.f) & 0xffffu); }
        LDS_WAIT(); asm volatile("" ::: "memory");
        {
            bf16x8 xf[2];
#pragma unroll
            for (int ks = 0; ks < 2; ++ks) xf[ks] = *(const LAS bf16x8*)(XC + r16 * 512 + w * 64 + 32 * ks + 8 * g4);
#pragma unroll
            for (int ct = 0; ct < 4; ++ct) { f32x4 da = (f32x4){0.f, 0.f, 0.f, 0.f}, dx = da;
#pragma unroll
                for (int ks = 0; ks < 2; ++ks) { da = mfma16(wa[ct][ks], xf[ks], da); dx = mfma16(wx[ct][ks], xf[ks], dx); }
                *(LAS f32x4*)(G + r16 * 512 + w * 64 + 16 * ct + 4 * g4) = da; *(LAS f32x4*)(G + 8192 + r16 * 512 + w * 64 + 16 * ct + 4 * g4) = dx; }
        }
        LDS_WAIT(); asm volatile("" ::: "memory");
#pragma unroll
        for (int tt = 0; tt < 16; ++tt) { const int t = s * 16 + tt;
            if (t < ntok) {
                const float r = sigmoidf_(G[tt * 512 + c] + ba), ig = sigmoidf_(G[8192 + tt * 512 + c] + bx);
                const float la = -8.0f * r * sp, a = fexp(la), bt = sqrtf(fmaxf(1.0f - a * a, 0.f)) * (ig * xc[tt]);
                h = a * h + bt; aprod *= a;
                if (MODE != 0) { const size_t o = (row0 + t) * 512 + c; OC[o] = (bf16)(pk2(h * gg[tt], 0.f) & 0xffffu); }
            } }
    }
    if (MODE == 0) { float* CAR = WSP(float, WS_CAR) + ((size_t)seq * 64 + tile) * 1024; CAR[c] = aprod; CAR[512 + c] = h; }
    if (MODE == 2) F.out[OUT_H_S + ((size_t)l * SB + seq) * 512 + c] = h;
}
__device__ __forceinline__ void rglru_carry_phase(Frame& F, int l) {
    const float* CAR = WSP(float, WS_CAR); float* HIN = WSP(float, WS_CAR) + (size_t)4 * 64 * 2 * 512;
    for (int idx = F.bid * NTHR + F.tid; idx < PB * 512; idx += F.G * NTHR) {
        const int b = idx >> 9, c = idx & 511; float h = 0.f;
#pragma unroll 1
        for (int t0 = 0; t0 < 64; t0 += 32) {
            float ca[32], cb[32];
#pragma unroll
            for (int t = 0; t < 32; ++t) { const float* cr = CAR + ((size_t)b * 64 + t0 + t) * 1024; ca[t] = cr[c]; cb[t] = cr[512 + c]; }
#pragma unroll
            for (int t = 0; t < 32; ++t) { HIN[((size_t)b * 64 + t0 + t) * 512 + c] = h; h = ca[t] * h + cb[t]; }
        }
        F.out[OUT_H_P + ((size_t)l * PB + b) * 512 + c] = h;
    }
}

__device__ __forceinline__ void convact_rows(Frame& F, int l, size_t row0, int nrows, bool smp) {
    const bf16* GP = WSP(bf16, WS_GP); const bf16* VAL = GP + (size_t)MT * DFF; bf16* ACT = WSP(bf16, WS_GP) + (size_t)2 * MT * DFF;
    const float* CW = FIN(I_FCW) + (size_t)l * 3 * DFF; const float* CBI = FIN(I_FCB) + (size_t)l * DFF;
    constexpr int NCG = DFF / 8;
    for (int it = F.tid; it < nrows * NCG; it += NTHR) {
        const int rr = it / NCG, c = (it % NCG) * 8; const size_t row = row0 + rr;
        f32x4 xa, xb, p1a, p1b, p2a, p2b, va, vb;
        const v4u gx = *(const v4u*)(GP + row * DFF + c), vx = *(const v4u*)(VAL + row * DFF + c);
        if (!smp) { v4u g1 = *(const v4u*)(GP + (row - 1) * DFF + c), g2 = *(const v4u*)(GP + (row - 2) * DFF + c); unpack8(g1, p1a, p1b); unpack8(g2, p2a, p2b); }
        else { const int sr = (int)(row - PM), seq = sr >> 3, i = sr & 7; const float* st = FIN(I_SFFN) + (((size_t)l * SB + seq) * 2) * DFF + c;
            if (i >= 1) unpack8(*(const v4u*)(GP + (row - 1) * DFF + c), p1a, p1b); else { p1a = *(const f32x4*)(st + DFF); p1b = *(const f32x4*)(st + DFF + 4); }
            if (i >= 2) unpack8(*(const v4u*)(GP + (row - 2) * DFF + c), p2a, p2b); else { const float* s2 = st + (i == 1 ? DFF : 0); p2a = *(const f32x4*)s2; p2b = *(const f32x4*)(s2 + 4); } }
        unpack8(gx, xa, xb); unpack8(vx, va, vb);
        const f32x4 w0a = *(const f32x4*)(CW + c), w0b = *(const f32x4*)(CW + c + 4), w1a = *(const f32x4*)(CW + DFF + c), w1b = *(const f32x4*)(CW + DFF + c + 4), w2a = *(const f32x4*)(CW + 2 * DFF + c), w2b = *(const f32x4*)(CW + 2 * DFF + c + 4);
        f32x4 ya = *(const f32x4*)(CBI + c) + w0a * p2a + w1a * p1a + w2a * xa, yb = *(const f32x4*)(CBI + c + 4) + w0b * p2b + w1b * p1b + w2b * xb;
#pragma unroll
        for (int k = 0; k < 4; ++k) { ya[k] = siluf_(ya[k]) * va[k]; yb[k] = siluf_(yb[k]) * vb[k]; }
        *(v4u*)(ACT + row * DFF + c) = pack8(ya, yb);
    }
}

constexpr int AT_RS = 144;
constexpr int AT_K0 = 0, AT_V0 = 2 * 64 * AT_RS, AT_PS = 4 * 64 * AT_RS, AT_IMP = AT_PS + 69632, AT_MASK = AT_IMP + 6144, AT_LIST = AT_MASK + 2048, AT_NL = AT_LIST + 1024;
constexpr unsigned AT_MARK = 0xFFFFu;
static_assert(AT_NL + 64 <= RING_BYTES, "attention LDS map");

struct TileRegs { v4u a, b, c, d; int mode; };

template <bool SMP> __device__ __forceinline__ void at_prefetch(const Frame& F, int l, int seq, int kvh, unsigned e, TileRegs& R) {
    const int kind = (int)(e >> 14), ti = (int)(e & 0x3fffu), rr = F.tid >> 3, pc = F.tid & 7;
    R.mode = 0;
    if (kind < 2) {
        const size_t rb = SMP ? (size_t)(seq * 2 + kvh) * 512 : (size_t)32768 + (size_t)(seq * 2 + kvh) * 256;
        const bf16* ck = WSP(bf16, WS_CK) + (rb + ti * 64 + rr) * 64 + pc * 8;
        R.a = *(const v4u*)ck; R.c = *(const v4u*)(ck + (size_t)CMP_ROWS_J * 64);
    } else if (!SMP) {
        const int jb = (kind == 2) ? 0 : 2;
        const bf16* kp = WSP(bf16, WS_KVB) + ((((size_t)jb * PB + seq) * 2 + kvh) * PT + ti * 64 + rr) * 64 + pc * 8;
        R.a = *(const v4u*)kp; R.c = *(const v4u*)(kp + (size_t)PB * 2 * PT * 64);
    } else if (kind == 2) {
        if (ti < 128) {
            const int page = ((const int*)F.a->in[I_PT])[seq * NPG + (ti >> 1)], slot = (ti & 1) * 64 + rr;
            const float* kp = FIN(I_CACHE) + (((((size_t)l * NPHYS + page) * PAGE + slot) * 4 + 2) * 2 + kvh) * 64 + pc * 8;
            R.a = *(const v4u*)kp; R.b = *(const v4u*)(kp + 4); R.c = *(const v4u*)(kp + 128); R.d = *(const v4u*)(kp + 132); R.mode = 1;
        } else if (rr < ST) {
            const bf16* kp = WSP(bf16, WS_KVS) + ((((size_t)0 * SB + seq) * 2 + kvh) * ST + rr) * 64 + pc * 8;
            R.a = *(const v4u*)kp; R.c = *(const v4u*)(kp + (size_t)SB * 2 * ST * 64);
        } else R.mode = 2;
    } else {
        if (ti < 8) {
            const float* kp = FIN(I_CWIN) + (((((size_t)l * SB + seq) * WINB + ti * 64 + rr) * 2 + 0) * 2 + kvh) * 64 + pc * 8;
            R.a = *(const v4u*)kp; R.b = *(const v4u*)(kp + 4); R.c = *(const v4u*)(kp + 128); R.d = *(const v4u*)(kp + 132); R.mode = 1;
        } else if (rr < ST) {
            const bf16* kp = WSP(bf16, WS_KVS) + ((((size_t)2 * SB + seq) * 2 + kvh) * ST + rr) * 64 + pc * 8;
            R.a = *(const v4u*)kp; R.c = *(const v4u*)(kp + (size_t)SB * 2 * ST * 64);
        } else R.mode = 2;
    }
}
__device__ __forceinline__ void at_store(const Frame& F, int buf, const TileRegs& R) {
    const int rr = F.tid >> 3, pc = F.tid & 7; v4u k, v;
    if (R.mode == 0) { k = R.a; v = R.c; }
    else if (R.mode == 1) { k = pack8(__builtin_bit_cast(f32x4, R.a), __builtin_bit_cast(f32x4, R.b)); v = pack8(__builtin_bit_cast(f32x4, R.c), __builtin_bit_cast(f32x4, R.d)); }
    else { k = (v4u){0u, 0u, 0u, 0u}; v = k; }
    *(LAS v4u*)(F.lds + AT_K0 + buf * 64 * AT_RS + rr * AT_RS + pc * 16) = k;
    *(LAS v4u*)(F.lds + AT_V0 + buf * 64 * AT_RS + rr * AT_RS + pc * 16) = v;
}

template <bool SMP> __device__ __forceinline__ void attn_unit(Frame& F, int l, int unit) {
    const int tid = F.tid, lane = F.lane, w = F.wave;
    const int q = lane & 31, h_ = lane >> 5, blk = (lane >> 4) & 1, tl = q >> 2, hr = q & 3;
    int seq, kvh, qt;
    if (SMP) { seq = unit >> 1; kvh = unit & 1; qt = 128; } else { seq = unit >> 7; kvh = (unit >> 6) & 1; qt = unit & 63; }
    const int t0 = SMP ? PAST : qt * 64;
    const int tokl = SMP ? tl : 8 * w + tl, t = t0 + tokl;
    const size_t row = SMP ? (size_t)PM + seq * ST + tl : (size_t)seq * PT + t;
    const int head = kvh * 4 + hr;
    LAS float* PS = (LAS float*)(F.lds + AT_PS); LAS float* IMPw = (LAS float*)(F.lds + AT_IMP) + w * 192;
    LAS unsigned long long* MASKS = (LAS unsigned long long*)(F.lds + AT_MASK); LAS unsigned short* LIST = (LAS unsigned short*)(F.lds + AT_LIST); LAS int* NL = (LAS int*)(F.lds + AT_NL);
    constexpr int PSS = SMP ? 520 : 264;
    LAS float* PSw = SMP ? PS : PS + w * 8 * PSS;
    __syncthreads();
    bf16x8 qf[4];
    { const bf16* qp = WSP(bf16, WS_QN) + row * 512 + head * 64 + 8 * h_;
#pragma unroll
      for (int kk = 0; kk < 4; ++kk) qf[kk] = *(const bf16x8*)(qp + 16 * kk); }
    const float* ngp = WSP(float, WS_NG) + row * 24 + head * 3; const float g0 = ngp[0], g1 = ngp[1], g2 = ngp[2];
    if (!SMP) { for (int i = lane; i < 8 * PSS; i += 64) PSw[i] = 0.f; }
    const int ntc = SMP ? 8 : ((t0 + 32) >> 10) + 1;
    if (tid < 2 * ntc) LIST[tid] = (unsigned short)(((tid >= ntc ? 1u : 0u) << 14) | (unsigned)(tid >= ntc ? tid - ntc : tid));
    if (tid == 0) LIST[2 * ntc] = (unsigned short)AT_MARK;
    int nl = 2 * ntc + 1;
    TileRegs R;
    at_prefetch<SMP>(F, l, seq, kvh, (unsigned)0, R);
    at_store(F, 0, R);
    __syncthreads();
    float m = -INFINITY, lsum = 0.f, invden = 0.f;
    f32x16 O[2]; O[0] = (f32x16){}; O[1] = (f32x16){};
    LAS float* OAw = (LAS float*)(F.lds + AT_PS) + w * (SMP ? 2048 : 8 * PSS) + lane;
    unsigned long long mk0 = 0ull, mk1 = 0ull, wu = ~0ull;
    int cur_kind = -1, idx = 0;
#define AT_FINALIZE(kind) do { \
        if ((kind) == 0) { const float lt = lsum + __shfl_xor(lsum, 32); invden = lt > 0.f ? 1.0f / lt : 0.f; } \
        else if ((kind) == 1) { const float sc = g0 * invden; O[0] *= sc; O[1] *= sc; } \
        else if ((kind) == 2) { const float lt = lsum + __shfl_xor(lsum, 32); const float sc = (lt > 0.f ? 1.0f / lt : 0.f) * g1; \
            _Pragma("unroll") for (int r_ = 0; r_ < 16; ++r_) { OAw[r_ * 64] += O[0][r_] * sc; OAw[(16 + r_) * 64] += O[1][r_] * sc; } } } while (0)
    while (idx < nl) {
        const unsigned e = (unsigned)__builtin_amdgcn_readfirstlane((int)LIST[idx]);
        if (e == AT_MARK) {
            AT_FINALIZE(cur_kind); cur_kind = -1;
            LDS_WAIT(); asm volatile("" ::: "memory");
#pragma unroll 1
            for (int tk = 0; tk < 8; ++tk) {
                const LAS float* pr = PSw + tk * PSS;
                if (!SMP) {
                    const int s = lane; float imp = 0.f;
#pragma unroll
                    for (int n = 4 * s - 1; n <= 4 * s + 3; ++n) if (n >= 0) imp += pr[n];
                    const bool forced = (s == 0) || (s == qt) || (s == qt - 1), avail = s <= qt;
                    const float val = avail ? (forced ? 1e4f : imp) : -1e4f;
                    IMPw[s] = val; LDS_WAIT(); asm volatile("" ::: "memory");
                    int rank = 0;
#pragma unroll 8
                    for (int i = 0; i < 64; ++i) { const float v = IMPw[i]; rank += (v > val || (v == val && i < s)) ? 1 : 0; }
                    const unsigned long long mk = __ballot(rank < 16);
                    if (lane == 0) MASKS[(8 * w + tk) * 4] = mk;
                    LDS_WAIT(); asm volatile("" ::: "memory");
                } else {
                    const int sa = lane, sb = lane + 64; float ia = 0.f, ib = 0.f;
#pragma unroll
                    for (int n = 4 * sa - 1; n <= 4 * sa + 3; ++n) if (n >= 0) ia += pr[n];
#pragma unroll
                    for (int n = 4 * sb - 1; n <= 4 * sb + 3; ++n) ib += pr[n];
                    const bool fa = (sa == 0), fb = (sb == 127);
                    const float va = fa ? 1e4f : ia, vb = fb ? 1e4f : ib;
                    IMPw[sa] = va; IMPw[sb] = vb; LDS_WAIT(); asm volatile("" ::: "memory");
                    int ra = fa ? 0 : 1, rb = fb ? 0 : 1;
#pragma unroll 8
                    for (int i = 0; i < 128; ++i) { const float v = IMPw[i]; ra += (v > va || (v == va && i < sa)) ? 1 : 0; rb += (v > vb || (v == vb && i < sb)) ? 1 : 0; }
                    const unsigned long long ma = __ballot(ra < 16), mb = __ballot(rb < 16);
                    if (lane == 0) { MASKS[tk * 4] = ma; MASKS[tk * 4 + 1] = mb; MASKS[tk * 4 + 2] = 1ull; }
                    LDS_WAIT(); asm volatile("" ::: "memory");
                }
            }
            __syncthreads();
#pragma unroll
            for (int r_ = 0; r_ < 16; ++r_) { OAw[r_ * 64] = O[0][r_]; OAw[(16 + r_) * 64] = O[1][r_]; }
            if (tid == 0) {
                int n = idx + 1;
                if (!SMP) { unsigned long long U = 0ull; for (int i = 0; i < 64; ++i) U |= MASKS[i * 4];
                    for (int s = 0; s <= qt; ++s) if ((U >> s) & 1ull) LIST[n++] = (unsigned short)((2u << 14) | (unsigned)s);
                    for (int s = (qt > 8 ? qt - 8 : 0); s <= qt; ++s) LIST[n++] = (unsigned short)((3u << 14) | (unsigned)s);
                } else { unsigned long long U0 = 0ull, U1 = 0ull; for (int i = 0; i < 8; ++i) { U0 |= MASKS[i * 4]; U1 |= MASKS[i * 4 + 1]; }
                    for (int s = 0; s < 64; ++s) if ((U0 >> s) & 1ull) LIST[n++] = (unsigned short)((2u << 14) | (unsigned)s);
                    for (int s = 0; s < 64; ++s) if ((U1 >> s) & 1ull) LIST[n++] = (unsigned short)((2u << 14) | (unsigned)(64 + s));
                    LIST[n++] = (unsigned short)((2u << 14) | 128u);
                    for (int s = 0; s <= 8; ++s) LIST[n++] = (unsigned short)((3u << 14) | (unsigned)s); }
                NL[0] = n;
            }
            __syncthreads();
            nl = __builtin_amdgcn_readfirstlane(NL[0]);
            mk0 = MASKS[tokl * 4]; if (SMP) { mk1 = MASKS[tokl * 4 + 1]; }
            if (!SMP) { unsigned long long u = 0ull; for (int i = 0; i < 8; ++i) u |= MASKS[(8 * w + i) * 4]; wu = u; }
            if (idx + 1 < nl) { at_prefetch<SMP>(F, l, seq, kvh, (unsigned)LIST[idx + 1], R); at_store(F, (idx + 1) & 1, R); }
            __syncthreads();
            ++idx; continue;
        }
        const int kind = (int)(e >> 14), ti = (int)(e & 0x3fffu);
        if (kind != cur_kind) {
            if (cur_kind >= 0) AT_FINALIZE(cur_kind);
            if (kind != 1) m = -INFINITY;
            lsum = 0.f; O[0] = (f32x16){}; O[1] = (f32x16){}; cur_kind = kind;
        }
        const unsigned en = (idx + 1 < nl) ? (unsigned)__builtin_amdgcn_readfirstlane((int)LIST[idx + 1]) : AT_MARK;
        const bool have_next = (en != AT_MARK);
        if (have_next) at_prefetch<SMP>(F, l, seq, kvh, en, R);
        bool active = true;
        if (!SMP && kind == 2) active = ((wu >> ti) & 1ull) != 0ull;
        if (active) {
            const LAS unsigned char* Kb = F.lds + AT_K0 + (idx & 1) * 64 * AT_RS; const LAS unsigned char* Vb = F.lds + AT_V0 + (idx & 1) * 64 * AT_RS;
            int lo, hi; const int kb = 64 * ti;
            if (kind < 2) { lo = 0; hi = SMP ? 510 : ((t >= 31) ? ((t - 31) >> 4) : -1); }
            else if (kind == 2) { lo = 0; const unsigned long long mw = (ti < 64) ? mk0 : ((ti < 128) ? mk1 : 1ull); hi = ((mw >> (ti & 63)) & 1ull) ? t : -1; }
            else { if (SMP) { lo = tl; hi = WINB + tl; } else { lo = t - WINB; hi = t; } }
            f32x16 s0 = (f32x16){}, s1 = (f32x16){};
#pragma unroll
            for (int kk = 0; kk < 4; ++kk) {
                const bf16x8 k0 = *(const LAS bf16x8*)(Kb + q * AT_RS + (16 * kk + 8 * h_) * 2), k1 = *(const LAS bf16x8*)(Kb + (32 + q) * AT_RS + (16 * kk + 8 * h_) * 2);
                s0 = mfma32(k0, qf[kk], s0); s1 = mfma32(k1, qf[kk], s1);
            }
            float tmax = -INFINITY;
#pragma unroll
            for (int r = 0; r < 16; ++r) { const int key = kb + (r & 3) + 8 * (r >> 2) + 4 * h_;
                s0[r] = (key >= lo && key <= hi) ? s0[r] : -INFINITY; s1[r] = (key + 32 >= lo && key + 32 <= hi) ? s1[r] : -INFINITY;
                tmax = fmaxf(tmax, fmaxf(s0[r], s1[r])); }
            tmax = fmaxf(tmax, __shfl_xor(tmax, 32));
            const float m_new = fmaxf(m, tmax), m_use = (m_new == -INFINITY) ? 0.f : m_new;
            const float alpha = fexp2(m - m_use);
            float ps = 0.f;
#pragma unroll
            for (int r = 0; r < 16; ++r) { s0[r] = fexp2(s0[r] - m_use); s1[r] = fexp2(s1[r] - m_use); ps += s0[r] + s1[r]; }
            lsum = lsum * alpha + ps; m = m_new;
            if (kind != 0) {
                O[0] *= alpha; O[1] *= alpha;
#pragma unroll
                for (int kt2 = 0; kt2 < 2; ++kt2)
#pragma unroll
                    for (int s2 = 0; s2 < 2; ++s2) { const bf16x8 pf = cvt_frag(kt2 ? s1 : s0, s2); const int rA = 32 * kt2 + 16 * s2 + 4 * h_;
#pragma unroll
                        for (int dt = 0; dt < 2; ++dt) { const bf16x8 vf = tr_frag(Vb, AT_RS, rA, rA + 8, 32 * dt + 16 * blk, lane); O[dt] = mfma32(vf, pf, O[dt]); } }
            }
            if (kind == 1) {
#pragma unroll
                for (int r = 0; r < 16; ++r) { const int n = kb + (r & 3) + 8 * (r >> 2) + 4 * h_;
                    float a = s0[r] * invden, b = s1[r] * invden; a += __shfl_xor(a, 1); b += __shfl_xor(b, 1); a += __shfl_xor(a, 2); b += __shfl_xor(b, 2);
                    if (hr == 0) { PSw[tl * PSS + n] = a; PSw[tl * PSS + n + 32] = b; } }
            }
        }
        if (have_next) at_store(F, (idx + 1) & 1, R);
        __syncthreads();
        ++idx;
    }
#undef AT_FINALIZE
    {
        const float lt = lsum + __shfl_xor(lsum, 32); const float sc = (lt > 0.f ? 1.0f / lt : 0.f) * g2;
        if (!SMP || w == 0) {
            bf16* op = WSP(bf16, WS_OA) + row * 512 + head * 64;
#pragma unroll
            for (int dt = 0; dt < 2; ++dt)
#pragma unroll
                for (int r4 = 0; r4 < 4; ++r4) { float o_[4];
#pragma unroll
                    for (int x = 0; x < 4; ++x) o_[x] = OAw[(dt * 16 + 4 * r4 + x) * 64] + O[dt][4 * r4 + x] * sc;
                    v2u wv; wv.x = pk2(o_[0], o_[1]); wv.y = pk2(o_[2], o_[3]); *(v2u*)(op + 32 * dt + 8 * r4 + 4 * h_) = wv; }
        }
    }
}

constexpr int AS_RS = 144;
constexpr int AS_V = 0, AS_VW = 32 * AS_RS, AS_MRG = 0, AS_PS = 73728, AS_IMP = AS_PS + 16640, AS_MASK = AS_IMP + 6144, AS_OA = AS_MASK + 512;
static_assert(8 * 34 * 64 * 4 <= AS_PS && AS_OA + 32 * 64 * 4 <= RING_BYTES, "sample attention LDS map");

__device__ __forceinline__ float xhalf_max(float x) { auto t_ = __builtin_amdgcn_permlane32_swap(__float_as_uint(x), __float_as_uint(x), false, false); return fmaxf(__uint_as_float(t_[0]), __uint_as_float(t_[1])); }
__device__ __forceinline__ float xhalf_sum(float x) { auto t_ = __builtin_amdgcn_permlane32_swap(__float_as_uint(x), __float_as_uint(x), false, false); return __uint_as_float(t_[0]) + __uint_as_float(t_[1]); }
struct ASrc { const float* kf; const float* vf; const bf16* kb; const bf16* vb; int rs; int nvalid; };
#define AS_TILE(SRC, KB0, LO_, HI_, DO_PV, DO_PS, m, lsum, O0, O1, invden, PSS_) do { \
        bf16x8 kfr[4]; f32x4 vx_[8]; \
        if ((SRC).kb) { const bf16* kp_ = (SRC).kb + (size_t)q * (SRC).rs + 8 * h_; _Pragma("unroll") for (int kk = 0; kk < 4; ++kk) kfr[kk] = *(const bf16x8*)(kp_ + 16 * kk); } \
        else {   \
            f32x4 kx_[8]; _Pragma("unroll") for (int x = 0; x < 8; ++x) kx_[x] = *(const f32x4*)((SRC).kf + (size_t)(4 * x + (lane >> 4)) * (SRC).rs + (lane & 15) * 4); \
            _Pragma("unroll") for (int x = 0; x < 8; ++x) { v2u o_; o_.x = pk2(kx_[x][0], kx_[x][1]); o_.y = pk2(kx_[x][2], kx_[x][3]); *(LAS v2u*)(Vw + (4 * x + (lane >> 4)) * AS_RS + (lane & 15) * 8) = o_; } \
            LDS_WAIT(); asm volatile("" ::: "memory"); \
            _Pragma("unroll") for (int kk = 0; kk < 4; ++kk) kfr[kk] = *(const LAS bf16x8*)(Vw + q * AS_RS + (16 * kk + 8 * h_) * 2); \
            LDS_WAIT(); asm volatile("" ::: "memory"); \
            if (DO_PV) { _Pragma("unroll") for (int x = 0; x < 8; ++x) vx_[x] = *(const f32x4*)((SRC).vf + (size_t)(4 * x + (lane >> 4)) * (SRC).rs + (lane & 15) * 4); } }     \
        if (DO_PV) { const int vr_ = lane >> 1, vh_ = lane & 1; v4u vv_[4]; \
            if (vr_ >= (SRC).nvalid) { _Pragma("unroll") for (int x = 0; x < 4; ++x) vv_[x] = (v4u){0u, 0u, 0u, 0u}; } \
            else if ((SRC).vb) { const bf16* vp_ = (SRC).vb + (size_t)vr_ * (SRC).rs + 32 * vh_; _Pragma("unroll") for (int x = 0; x < 4; ++x) vv_[x] = *(const v4u*)(vp_ + 8 * x); } \
            if ((SRC).vb || vr_ >= (SRC).nvalid) { _Pragma("unroll") for (int x = 0; x < 4; ++x) *(LAS v4u*)(Vw + vr_ * AS_RS + vh_ * 64 + x * 16) = vv_[x]; } } \
        f32x16 s_ = (f32x16){}; \
        _Pragma("unroll") for (int kk = 0; kk < 4; ++kk) s_ = mfma32(kfr[kk], qf[kk], s_); \
        float tmax_ = -INFINITY; \
        _Pragma("unroll") for (int r = 0; r < 16; ++r) { const int key_ = (KB0) + (r & 3) + 8 * (r >> 2) + 4 * h_; s_[r] = (key_ >= (LO_) && key_ <= (HI_)) ? s_[r] : -INFINITY; tmax_ = fmaxf(tmax_, s_[r]); } \
        tmax_ = xhalf_max(tmax_); \
        const float mn_ = fmaxf(m, tmax_), mu_ = (mn_ == -INFINITY) ? 0.f : mn_, al_ = fexp2(m - mu_); float ps_ = 0.f; \
        _Pragma("unroll") for (int r = 0; r < 16; ++r) { s_[r] = fexp2(s_[r] - mu_); ps_ += s_[r]; } \
        lsum = lsum * al_ + ps_; m = mn_; \
        if (DO_PV) { O0 *= al_; O1 *= al_; \
            if (!(SRC).vb) { _Pragma("unroll") for (int x = 0; x < 8; ++x) { v2u o_; o_.x = pk2(vx_[x][0], vx_[x][1]); o_.y = pk2(vx_[x][2], vx_[x][3]); *(LAS v2u*)(Vw + (4 * x + (lane >> 4)) * AS_RS + (lane & 15) * 8) = o_; } } \
            LDS_WAIT(); asm volatile("" ::: "memory"); \
            _Pragma("unroll") for (int s2 = 0; s2 < 2; ++s2) { const bf16x8 pf_ = cvt_frag(s_, s2); const int rA_ = 16 * s2 + 4 * h_; \
                O0 = mfma32(tr_frag(Vw, AS_RS, rA_, rA_ + 8, 16 * blk, lane), pf_, O0); O1 = mfma32(tr_frag(Vw, AS_RS, rA_, rA_ + 8, 32 + 16 * blk, lane), pf_, O1); } \
            LDS_WAIT(); asm volatile("" ::: "memory"); } \
        if (DO_PS) { _Pragma("unroll") for (int r = 0; r < 16; ++r) { const int n_ = (KB0) + (r & 3) + 8 * (r >> 2) + 4 * h_; float a_ = s_[r] * (invden); a_ += __shfl_xor(a_, 1); a_ += __shfl_xor(a_, 2); if (hr == 0) PS[tl * (PSS_) + n_] = a_; } } \
    } while (0)

__device__ __forceinline__ void attn_sample_unit(Frame& F, int l, int unit) {
    const int lane = F.lane, w = F.wave, tid = F.tid;
    const int q = lane & 31, h_ = lane >> 5, blk = (lane >> 4) & 1, tl = q >> 2, hr = q & 3;
    const int seq = unit >> 1, kvh = unit & 1, head = kvh * 4 + hr;
    const size_t row = (size_t)PM + seq * ST + tl;
    LAS unsigned char* Vw = F.lds + AS_V + w * AS_VW;
    LAS float* MRG = (LAS float*)(F.lds + AS_MRG);
    LAS float* PS = (LAS float*)(F.lds + AS_PS);
    LAS float* IMPw = (LAS float*)(F.lds + AS_IMP) + w * 192;
    LAS unsigned long long* MASKS = (LAS unsigned long long*)(F.lds + AS_MASK);
    __syncthreads();
    bf16x8 qf[4];
    { const bf16* qp = WSP(bf16, WS_QN) + row * 512 + head * 64 + 8 * h_;
#pragma unroll
      for (int kk = 0; kk < 4; ++kk) qf[kk] = *(const bf16x8*)(qp + 16 * kk); }
    const float* ngp = WSP(float, WS_NG) + row * 24 + head * 3; const float g0 = ngp[0], g1 = ngp[1], g2 = ngp[2];
    const int* ptab = (const int*)F.a->in[I_PT] + seq * NPG;
    LAS float* OAL = (LAS float*)(F.lds + AS_OA) + lane;

#define AS_PUBLISH(m, lsum, O0, O1) do { __syncthreads(); LAS float* mp_ = MRG + w * 34 * 64 + lane; mp_[0] = m; mp_[64] = lsum; \
        _Pragma("unroll") for (int r = 0; r < 16; ++r) { mp_[(2 + r) * 64] = O0[r]; mp_[(18 + r) * 64] = O1[r]; } __syncthreads(); } while (0)

    const bf16* CKk = WSP(bf16, WS_CK) + ((size_t)(seq * 2 + kvh) * 512) * 64; const bf16* CKv = CKk + (size_t)CMP_ROWS_J * 64;
    float mC = -INFINITY, lC = 0.f; f32x16 D0 = (f32x16){}, D1 = (f32x16){};
#pragma unroll 1
    for (int ti = w; ti < 16; ti += 8) { ASrc S{nullptr, nullptr, CKk + (size_t)ti * 32 * 64, CKv + (size_t)ti * 32 * 64, 64, 32}; AS_TILE(S, ti * 32, 0, 510, false, false, mC, lC, D0, D1, 0.f, 520); }
    { __syncthreads(); MRG[w * 128 + lane] = mC; MRG[w * 128 + 64 + lane] = xhalf_sum(lC); __syncthreads(); }
    float mT = -INFINITY;
#pragma unroll
    for (int x = 0; x < 8; ++x) mT = fmaxf(mT, MRG[x * 128 + lane]);
    float lT = 0.f;
#pragma unroll
    for (int x = 0; x < 8; ++x) { const float mx_ = MRG[x * 128 + lane]; lT += (mx_ == -INFINITY) ? 0.f : MRG[x * 128 + 64 + lane] * fexp2(mx_ - mT); }
    const float invC = lT > 0.f ? 1.0f / lT : 0.f;
    __syncthreads();
    { float mB = mT, lB = 0.f;
#pragma unroll 1
      for (int ti = w; ti < 16; ti += 8) { ASrc S{nullptr, nullptr, CKk + (size_t)ti * 32 * 64, CKv + (size_t)ti * 32 * 64, 64, 32}; AS_TILE(S, ti * 32, 0, 510, true, true, mB, lB, D0, D1, invC, 520); }
      AS_PUBLISH(mB, lB, D0, D1); }
    if (w == 0) { const float sc = g0 * invC; f32x16 T0 = (f32x16){}, T1 = (f32x16){};
#pragma unroll 1
      for (int x = 0; x < 8; ++x) { const LAS float* mp = MRG + x * 34 * 64 + lane;
#pragma unroll
          for (int r = 0; r < 16; ++r) { T0[r] += mp[(2 + r) * 64] * sc; T1[r] += mp[(18 + r) * 64] * sc; } }
#pragma unroll
      for (int r = 0; r < 16; ++r) { OAL[r * 64] = T0[r]; OAL[(16 + r) * 64] = T1[r]; } }
    {
        const LAS float* pr = PS + w * 520; const int sa = lane, sb = lane + 64; float ia = 0.f, ib = 0.f;
#pragma unroll
        for (int n = 4 * sa - 1; n <= 4 * sa + 3; ++n) if (n >= 0) ia += pr[n];
#pragma unroll
        for (int n = 4 * sb - 1; n <= 4 * sb + 3; ++n) ib += pr[n];
        const bool fa = (sa == 0), fb = (sb == 127); const float va = fa ? 1e4f : ia, vb = fb ? 1e4f : ib;
        IMPw[sa] = va; IMPw[sb] = vb; LDS_WAIT(); asm volatile("" ::: "memory");
        int ra = fa ? 0 : 1, rb = fb ? 0 : 1;
#pragma unroll 8
        for (int i = 0; i < 128; ++i) { const float v = IMPw[i]; ra += (v > va || (v == va && i < sa)) ? 1 : 0; rb += (v > vb || (v == vb && i < sb)) ? 1 : 0; }
        const unsigned long long ma = __ballot(ra < 16), mb = __ballot(rb < 16);
        if (lane == 0) { MASKS[w * 4] = ma; MASKS[w * 4 + 1] = mb; }
    }
    __syncthreads();
    const unsigned long long mk0 = MASKS[tl * 4], mk1 = MASKS[tl * 4 + 1];
    unsigned long long U0 = 0ull, U1 = 0ull;
#pragma unroll
    for (int x = 0; x < 8; ++x) { U0 |= MASKS[x * 4]; U1 |= MASKS[x * 4 + 1]; }
    {
        float m = -INFINITY, ls = 0.f; D0 = (f32x16){}; D1 = (f32x16){};
        const int t = PAST + tl; int cnt = 0;
#pragma unroll 1
        for (int s = 0; s <= 128; ++s) {
            const bool in_u = (s < 64) ? ((U0 >> s) & 1ull) : ((s < 128) ? ((U1 >> (s - 64)) & 1ull) : true);
            if (!in_u) continue;
            const bool selb = (s < 64) ? ((mk0 >> s) & 1ull) : ((s < 128) ? ((mk1 >> (s - 64)) & 1ull) : true);
            const int nh = (s < 128) ? 2 : 1;
            for (int hf = 0; hf < nh; ++hf, ++cnt) {
                if ((cnt & 7) != w) continue;
                const int hi = selb ? t : -1;
                if (s < 128) { const int page = ptab[s >> 1], slot = (s & 1) * 64 + hf * 32;
                    const float* kp = FIN(I_CACHE) + (((((size_t)l * NPHYS + page) * PAGE + slot) * 4 + 2) * 2 + kvh) * 64;
                    ASrc S{kp, kp + 128, nullptr, nullptr, 512, 32}; AS_TILE(S, s * 64 + hf * 32, 0, hi, true, false, m, ls, D0, D1, 0.f, 520); }
                else { const bf16* kp = WSP(bf16, WS_KVS) + ((((size_t)0 * SB + seq) * 2 + kvh) * ST) * 64;
                    ASrc S{nullptr, nullptr, kp, kp + (size_t)SB * 2 * ST * 64, 64, ST}; AS_TILE(S, PAST, 0, hi, true, false, m, ls, D0, D1, 0.f, 520); }
            }
        }
        AS_PUBLISH(m, ls, D0, D1);
        float mt = -INFINITY;
#pragma unroll
        for (int x = 0; x < 8; ++x) mt = fmaxf(mt, MRG[x * 34 * 64 + lane]);
        float lt = 0.f; f32x16 T0 = (f32x16){}, T1 = (f32x16){};
#pragma unroll 1
        for (int x = 0; x < 8; ++x) { const LAS float* mp = MRG + x * 34 * 64 + lane; const float mx_ = mp[0]; const float f = (mx_ == -INFINITY) ? 0.f : fexp2(mx_ - mt); lt += mp[64] * f;
#pragma unroll
            for (int r = 0; r < 16; ++r) { T0[r] += mp[(2 + r) * 64] * f; T1[r] += mp[(18 + r) * 64] * f; } }
        lt = xhalf_sum(lt); const float sc = (lt > 0.f ? 1.0f / lt : 0.f) * g1;
        if (w == 0) {
#pragma unroll
            for (int r = 0; r < 16; ++r) { OAL[r * 64] += T0[r] * sc; OAL[(16 + r) * 64] += T1[r] * sc; } }
    }
    {
        float m = -INFINITY, ls = 0.f; D0 = (f32x16){}; D1 = (f32x16){};
#pragma unroll 1
        for (int ti = w; ti < 17; ti += 8) {
            if (ti < 16) { const float* kp = FIN(I_CWIN) + (((((size_t)l * SB + seq) * WINB + ti * 32) * 2 + 0) * 2 + kvh) * 64;
                ASrc S{kp, kp + 128, nullptr, nullptr, 256, 32}; AS_TILE(S, ti * 32, tl, WINB + tl, true, false, m, ls, D0, D1, 0.f, 520); }
            else { const bf16* kp = WSP(bf16, WS_KVS) + ((((size_t)2 * SB + seq) * 2 + kvh) * ST) * 64;
                ASrc S{nullptr, nullptr, kp, kp + (size_t)SB * 2 * ST * 64, 64, ST}; AS_TILE(S, WINB, tl, WINB + tl, true, false, m, ls, D0, D1, 0.f, 520); }
        }
        AS_PUBLISH(m, ls, D0, D1);
        float mt = -INFINITY;
#pragma unroll
        for (int x = 0; x < 8; ++x) mt = fmaxf(mt, MRG[x * 34 * 64 + lane]);
        float lt = 0.f; f32x16 T0 = (f32x16){}, T1 = (f32x16){};
#pragma unroll 1
        for (int x = 0; x < 8; ++x) { const LAS float* mp = MRG + x * 34 * 64 + lane; const float mx_ = mp[0]; const float f = (mx_ == -INFINITY) ? 0.f : fexp2(mx_ - mt); lt += mp[64] * f;
#pragma unroll
            for (int r = 0; r < 16; ++r) { T0[r] += mp[(2 + r) * 64] * f; T1[r] += mp[(18 + r) * 64] * f; } }
        lt = xhalf_sum(lt); const float sc = (lt > 0.f ? 1.0f / lt : 0.f) * g2;
        if (w == 0) {
#pragma unroll
            for (int r = 0; r < 16; ++r) { OAL[r * 64] += T0[r] * sc; OAL[(16 + r) * 64] += T1[r] * sc; } }
    }
#undef AS_PUBLISH
    if (w == 0) {
        bf16* op = WSP(bf16, WS_OA) + row * 512 + head * 64;
#pragma unroll
        for (int r4 = 0; r4 < 4; ++r4) { float a_[4], b_[4];
#pragma unroll
            for (int x = 0; x < 4; ++x) { a_[x] = OAL[(4 * r4 + x) * 64]; b_[x] = OAL[(16 + 4 * r4 + x) * 64]; }
            v2u a, b; a.x = pk2(a_[0], a_[1]); a.y = pk2(a_[2], a_[3]); b.x = pk2(b_[0], b_[1]); b.y = pk2(b_[2], b_[3]);
            *(v2u*)(op + 8 * r4 + 4 * h_) = a; *(v2u*)(op + 32 + 8 * r4 + 4 * h_) = b; }
    }
}

#ifndef DBG_DUP
#define DBG_DUP 0
#endif
#if DBG_DUP == 1
#define AP_DUP_QK(NK) { f32x16 d_ = (f32x16){}; _Pragma("unroll") for (int kk = 0; kk < 4; ++kk) d_ = mfma32(NK[kk], qf[(kk + 1) & 3], d_); _Pragma("unroll") for (int r = 0; r < 16; ++r) s_[r] += zf * d_[r]; }
#else
#define AP_DUP_QK(NK)
#endif
#if DBG_DUP == 2
#define AP_DUP_EXP() { float acc_ = 0.f; _Pragma("unroll") for (int r = 0; r < 16; ++r) acc_ += fexp2(s_[r] * 0.5f - 3.0f); lsum += zf * acc_; }
#else
#define AP_DUP_EXP()
#endif
#if DBG_DUP == 3
#define AP_DUP_PV() { f32x16 e0_ = (f32x16){}, e1_ = (f32x16){}; _Pragma("unroll") for (int s2 = 0; s2 < 2; ++s2) { const bf16x8 pf_ = cvt_frag(s_, 1 - s2); const int rA_ = 16 * s2 + 4 * h_; \
        e0_ = mfma32(tr_frag(Vw, AS_RS, rA_ + 8, rA_, 16 * blk, lane), pf_, e0_); e1_ = mfma32(tr_frag(Vw, AS_RS, rA_ + 8, rA_, 32 + 16 * blk, lane), pf_, e1_); } D0 += e0_ * zf; D1 += e1_ * zf; }
#else
#define AP_DUP_PV()
#endif
constexpr int AP_WS = 14336, AP_V = 0, AP_PS = 4608, AP_IMP = AP_PS + 8 * 264 * 4, AP_MASK = AP_IMP + 256, AP_LIST = AP_MASK + 64;
static_assert(AP_LIST + 2 * 192 <= AP_WS && 8 * AP_WS <= RING_BYTES, "prompt attention LDS map");
__device__ __forceinline__ void attn_prompt_unit(Frame& F, int l, int unit) {
    const int lane = F.lane, w = F.wave;
    const int q = lane & 31, h_ = lane >> 5, blk = (lane >> 4) & 1, tl = q >> 2, hr = q & 3;
    const int seq = unit >> 7, kvh = (unit >> 6) & 1, qt = unit & 63, head = kvh * 4 + hr;
    const int t0w = qt * 64 + 8 * w, t = t0w + tl; const size_t row = (size_t)seq * PT + t;
    LAS unsigned char* Vw = F.lds + w * AP_WS + AP_V; LAS float* PS = (LAS float*)(F.lds + w * AP_WS + AP_PS); LAS float* IMPw = (LAS float*)(F.lds + w * AP_WS + AP_IMP);
    LAS unsigned long long* MASKS = (LAS unsigned long long*)(F.lds + w * AP_WS + AP_MASK); LAS unsigned short* LIST = (LAS unsigned short*)(F.lds + w * AP_WS + AP_LIST);
    __syncthreads();
    bf16x8 qf[4];
    { const bf16* qp = WSP(bf16, WS_QN) + row * 512 + head * 64 + 8 * h_;
#pragma unroll
      for (int kk = 0; kk < 4; ++kk) qf[kk] = *(const bf16x8*)(qp + 16 * kk); }
    const float* ngp = WSP(float, WS_NG) + row * 24 + head * 3; const float g0 = ngp[0], g1 = ngp[1], g2 = ngp[2];
    for (int i = lane; i < 8 * 264; i += 64) PS[i] = 0.f;
    const bf16* CKk = WSP(bf16, WS_CK) + ((size_t)32768 + (seq * 2 + kvh) * 256) * 64; const bf16* CKv = CKk + (size_t)CMP_ROWS_J * 64;
    const bf16* KS = WSP(bf16, WS_KVB) + ((((size_t)0 * PB + seq) * 2 + kvh) * PT) * 64; const bf16* VS = KS + (size_t)PB * 2 * PT * 64;
    const bf16* KW = KS + (size_t)2 * PB * 2 * PT * 64; const bf16* VW = KW + (size_t)PB * 2 * PT * 64;
    const int hiCmin = (t0w >= 31) ? ((t0w - 31) >> 4) : -1;
    const int hiC = (t >= 31) ? ((t - 31) >> 4) : -1; const int nmaxw = (t0w + 7 >= 31) ? ((t0w + 7 - 31) >> 4) : -1; const int ntc = (nmaxw >= 0) ? (nmaxw >> 5) + 1 : 0;
    f32x16 D0 = (f32x16){}, D1 = (f32x16){};
    LAS float* OAG = PS + lane;
    float m = -INFINITY, lsum = 0.f, invC = 0.f; unsigned long long mk0 = 0ull;
    const float zf = (F.G == 12345) ? 1.0f : 0.0f;
    bf16x8 nk0[4]; v4u nv0[4], nv1[4];
#define AP_LOADK(e_, NK) do { const int kd_ = (int)((e_) >> 12), ti_ = (int)((e_) & 0xfffu); const bf16* kb_ = (kd_ < 2 ? CKk : (kd_ == 2 ? KS : KW)) + (size_t)ti_ * 32 * 64; \
        const int ko_ = kd_ < 2 ? q * 64 + 8 * h_ : lane * 8, ks_ = kd_ < 2 ? 16 : 512;     \
        _Pragma("unroll") for (int kk = 0; kk < 4; ++kk) NK[kk] = *(const bf16x8*)(kb_ + ko_ + ks_ * kk); } while (0)
#define AP_LOADV(e_, NV) do { const int kd_ = (int)((e_) >> 12), ti_ = (int)((e_) & 0xfffu); const bf16* vb_ = (kd_ < 2 ? CKv : (kd_ == 2 ? VS : VW)) + (size_t)ti_ * 32 * 64; \
        _Pragma("unroll") for (int x = 0; x < 4; ++x) NV[x] = *(const v4u*)(vb_ + 512 * x + lane * 8); } while (0)
#define AP_LOADT(e_, NK, NV) do { AP_LOADK(e_, NK); AP_LOADV(e_, NV); } while (0)
#define AP_STEP(i_, n_, NK, NV, NVN, EC, ECN) do { \
        const unsigned e_ = EC; const int kind = (int)(e_ >> 12), ti = (int)(e_ & 0xfffu); \
        if (kind == 1) { _Pragma("unroll") for (int x = 0; x < 4; ++x) *(LAS v4u*)(Vw + (8 * x + (lane >> 3)) * AS_RS + (lane & 7) * 16) = NV[x]; }     \
        f32x16 s_ = (f32x16){}; \
        _Pragma("unroll") for (int kk = 0; kk < 4; ++kk) s_ = mfma32(NK[kk], qf[kk], s_); \
        AP_DUP_QK(NK) \
          \
        if ((i_) + 1 < (n_)) { AP_LOADK(ECN, NK); AP_LOADV(ECN, NVN); if ((i_) + 2 < (n_)) EC = (unsigned)__builtin_amdgcn_readfirstlane((int)LIST[(i_) + 2]); } \
        if (kind != cur_kind) { \
            if (cur_kind == 0) { const float lt_ = xhalf_sum(lsum); invC = lt_ > 0.f ? 1.0f / lt_ : 0.f; } \
            else if (cur_kind == 2) { const float lt_ = xhalf_sum(lsum); const float sc_ = (lt_ > 0.f ? 1.0f / lt_ : 0.f) * g1; \
                _Pragma("unroll") for (int r = 0; r < 16; ++r) { OAG[r * 64] += D0[r] * sc_; OAG[(16 + r) * 64] += D1[r] * sc_; } } \
            if (kind != 1) m = -INFINITY; lsum = 0.f; D0 = (f32x16){}; D1 = (f32x16){}; cur_kind = kind; } \
        const int kb = ti * 32; int lo, hi; \
        if (kind < 2) { lo = 0; hi = hiC; } else if (kind == 2) { lo = 0; hi = ((mk0 >> (ti >> 1)) & 1ull) ? t : -1; } else { lo = t - WINB; hi = t; } \
          \
        const bool interior = (kind < 2) ? (hiCmin >= 0 && kb + 31 <= hiCmin) : ((kind == 2) ? (kb + 31 <= t0w) : (kb >= t0w + 7 - WINB && kb + 31 <= t0w)); \
        float tmax_ = -INFINITY, mu_, mn_; \
        if (interior) { const bool on_ = hi >= 0; \
            _Pragma("unroll") for (int r = 0; r < 16; ++r) tmax_ = fmaxf(tmax_, s_[r]); \
            tmax_ = on_ ? tmax_ : -INFINITY; tmax_ = xhalf_max(tmax_); \
            mn_ = fmaxf(m, tmax_); mu_ = (mn_ == -INFINITY) ? 0.f : mn_; const float mr_ = on_ ? mu_ : INFINITY; \
            _Pragma("unroll") for (int r = 0; r < 16; ++r) s_[r] = fexp2(s_[r] - mr_); \
        } else { \
            _Pragma("unroll") for (int r = 0; r < 16; ++r) { const int key_ = kb + (r & 3) + 8 * (r >> 2) + 4 * h_; s_[r] = (key_ >= lo && key_ <= hi) ? s_[r] : -INFINITY; tmax_ = fmaxf(tmax_, s_[r]); } \
            tmax_ = xhalf_max(tmax_); \
            mn_ = fmaxf(m, tmax_); mu_ = (mn_ == -INFINITY) ? 0.f : mn_; \
            _Pragma("unroll") for (int r = 0; r < 16; ++r) s_[r] = fexp2(s_[r] - mu_); \
        } \
        AP_DUP_EXP() \
        const float al_ = fexp2(m - mu_); float ps_ = 0.f; \
        _Pragma("unroll") for (int r = 0; r < 16; ++r) ps_ += s_[r]; \
        lsum = lsum * al_ + ps_; m = mn_; \
        if (kind >= 2) { if (__ballot(al_ != 1.0f) != 0ull) { D0 *= al_; D1 *= al_; } \
            const bf16x8 pf0_ = cvt_frag(s_, 0), pf1_ = cvt_frag(s_, 1); \
            D0 = mfma32(__builtin_bit_cast(bf16x8, NV[0]), pf0_, D0); D1 = mfma32(__builtin_bit_cast(bf16x8, NV[2]), pf0_, D1); D0 = mfma32(__builtin_bit_cast(bf16x8, NV[1]), pf1_, D0); D1 = mfma32(__builtin_bit_cast(bf16x8, NV[3]), pf1_, D1); \
        } else if (kind == 1) { if (__ballot(al_ != 1.0f) != 0ull) { D0 *= al_; D1 *= al_; } asm volatile("" ::: "memory");   \
            { const bf16x8 va0_ = tr_frag(Vw, AS_RS, 4 * h_, 4 * h_ + 8, 16 * blk, lane), va1_ = tr_frag(Vw, AS_RS, 4 * h_, 4 * h_ + 8, 32 + 16 * blk, lane), \
                           vb0_ = tr_frag(Vw, AS_RS, 16 + 4 * h_, 24 + 4 * h_, 16 * blk, lane), vb1_ = tr_frag(Vw, AS_RS, 16 + 4 * h_, 24 + 4 * h_, 32 + 16 * blk, lane);   \
              const bf16x8 pf0_ = cvt_frag(s_, 0), pf1_ = cvt_frag(s_, 1); \
              D0 = mfma32(va0_, pf0_, D0); D1 = mfma32(va1_, pf0_, D1); D0 = mfma32(vb0_, pf1_, D0); D1 = mfma32(vb1_, pf1_, D1); } \
            AP_DUP_PV() \
            asm volatile("" ::: "memory"); } \
        if (kind == 1) { _Pragma("unroll") for (int r = 0; r < 16; ++r) { const int n2_ = kb + (r & 3) + 8 * (r >> 2) + 4 * h_; float a_ = s_[r] * invC; a_ += __shfl_xor(a_, 1); a_ += __shfl_xor(a_, 2); if (hr == 0) PS[tl * 264 + n2_] = a_; } } \
    } while (0)
#define AP_RUN(N_) do { const int n_ = (N_); unsigned ec0_ = 0u, ec1_ = 0u;                  \
      if (n_ > 0) { ec0_ = (unsigned)__builtin_amdgcn_readfirstlane((int)LIST[0]); AP_LOADK(ec0_, nk0); AP_LOADV(ec0_, nv0); } \
      if (n_ > 1) { ec1_ = (unsigned)__builtin_amdgcn_readfirstlane((int)LIST[1]); } \
      _Pragma("unroll 1") for (int i_ = 0; i_ < n_; i_ += 2) { AP_STEP(i_, n_, nk0, nv0, nv1, ec0_, ec1_); if (i_ + 1 < n_) AP_STEP(i_ + 1, n_, nk0, nv1, nv0, ec1_, ec0_); } } while (0)
    int cur_kind = -1;
    if (lane < 2 * ntc) LIST[lane] = (unsigned short)(((lane >= ntc ? 1u : 0u) << 12) | (unsigned)(lane >= ntc ? lane - ntc : lane));
    LDS_WAIT(); asm volatile("" ::: "memory");
    AP_RUN(2 * ntc);
    { const float sc = (cur_kind == 1) ? g0 * invC : 0.f; D0 *= sc; D1 *= sc; }
    LDS_WAIT(); asm volatile("" ::: "memory");
#pragma unroll 1
    for (int tk = 0; tk < 8; ++tk) {
        const LAS float* pr = PS + tk * 264; const int s = lane; float imp = 0.f;
#pragma unroll
        for (int n = 4 * s - 1; n <= 4 * s + 3; ++n) if (n >= 0) imp += pr[n];
        const bool forced = (s == 0) || (s == qt) || (s == qt - 1), avail = s <= qt;
        const unsigned key = avail ? (forced ? 0x7fffffffu : (imp > 0.f ? __float_as_uint(imp) + 1u : 1u)) : 0u;
        unsigned thr = 0u;
#pragma unroll
        for (int bit = 30; bit >= 0; --bit) { const unsigned cand = thr | (1u << bit); const int cnt = __popcll(__ballot(key >= cand)); thr = (cnt >= 16) ? cand : thr; }
        const unsigned long long gt = __ballot(key > thr), eq = __ballot(key == thr); const int need = 16 - __popcll(gt);
        const int below = __builtin_amdgcn_mbcnt_hi((unsigned)(eq >> 32), __builtin_amdgcn_mbcnt_lo((unsigned)eq, 0u));
        const unsigned long long mk = gt | __ballot(key == thr && below < need);
        if (lane == 0) MASKS[tk] = mk;
        LDS_WAIT(); asm volatile("" ::: "memory");
    }
#pragma unroll
    for (int r = 0; r < 16; ++r) { OAG[r * 64] = D0[r]; OAG[(16 + r) * 64] = D1[r]; }
    mk0 = MASKS[tl]; unsigned long long wu = 0ull;
#pragma unroll
    for (int i = 0; i < 8; ++i) wu |= MASKS[i];
    wu &= (qt >= 63) ? ~0ull : ((1ull << (qt + 1)) - 1ull);
    const int nsel = 2 * __popcll(wu); const int tiLo = (t0w > WINB) ? ((t0w - WINB) >> 5) : 0, tiHi = (t0w + 7) >> 5, nwin = tiHi - tiLo + 1;
    if ((wu >> lane) & 1ull) { const int pos = 2 * __popcll(wu & ((1ull << lane) - 1ull)); LIST[pos] = (unsigned short)((2u << 12) | (unsigned)(2 * lane)); LIST[pos + 1] = (unsigned short)((2u << 12) | (unsigned)(2 * lane + 1)); }
    if (lane < nwin) LIST[nsel + lane] = (unsigned short)((3u << 12) | (unsigned)(tiLo + lane));
    LDS_WAIT(); asm volatile("" ::: "memory");
#ifdef DBG_COUNT
    if (lane == 0) { unsigned* CNT = (unsigned*)(F.ws + WS_CTL) + 3000; atomicAdd(CNT + 0, (unsigned)nsel); atomicAdd(CNT + 1, (unsigned)nwin); atomicAdd(CNT + 2, (unsigned)(2 * ntc)); atomicAdd(CNT + 3, 1u); }
#endif
    cur_kind = -1;
    AP_RUN(nsel + nwin);
    const float ltw = xhalf_sum(lsum); const float scw = (ltw > 0.f ? 1.0f / ltw : 0.f) * g2;
#undef AP_RUN
#undef AP_STEP
#undef AP_LOADT
#undef AP_LOADK
#undef AP_LOADV
    {
        bf16* op = WSP(bf16, WS_OA) + row * 512 + head * 64;
#pragma unroll
        for (int r4 = 0; r4 < 4; ++r4) { float a_[4], b_[4];
#pragma unroll
            for (int x = 0; x < 4; ++x) { a_[x] = OAG[(4 * r4 + x) * 64] + D0[4 * r4 + x] * scw; b_[x] = OAG[(16 + 4 * r4 + x) * 64] + D1[4 * r4 + x] * scw; }
            v2u a, b; a.x = pk2(a_[0], a_[1]); a.y = pk2(a_[2], a_[3]); b.x = pk2(b_[0], b_[1]); b.y = pk2(b_[2], b_[3]);
            *(v2u*)(op + 8 * r4 + 4 * h_) = a; *(v2u*)(op + 32 + 8 * r4 + 4 * h_) = b; }
    }
}
#undef AS_TILE

#ifdef DBG_CHECK
__device__ __forceinline__ unsigned dbg_rand(unsigned x) { x ^= x >> 16; x *= 0x7feb352du; x ^= x >> 15; x *= 0x846ca68bu; x ^= x >> 16; return x; }
__device__ __forceinline__ bool dbg_bad(float got, float exp_, float rtol, float atol) { return !(fabsf(got - exp_) <= rtol * fabsf(exp_) + atol); }
__device__ __forceinline__ float bfr(float x) { return __uint_as_float(pk2(x, 0.f) << 16); }
__device__ __forceinline__ int dbg_row(unsigned r) { const unsigned k = r % 20u; if (k == 0) return (int)(PM + (r >> 8) % SM); if (k == 1) return (int)(((r >> 8) % PB) * PT + ((r >> 12) % 8)); if (k == 2) return (int)(((r >> 8) % PB) * PT + PT - 1 - ((r >> 12) % 8)); return (int)((r >> 5) % PM); }
__device__ __forceinline__ float dbg_rs(const Frame& F, int row, int lane) { const float* xr = xrow_in(F, 0, row); float ss = 0.f; for (int d = lane; d < DM; d += 64) ss += xr[d] * xr[d]; return 1.0f / sqrtf(wave_sum(ss) * (1.0f / DM) + EPS); }
__device__ __forceinline__ float dbg_h(const Frame& F, int row, int d, float rs) { const float* mod = WSP(float, WS_MOD) + (size_t)row_bb(row) * 6144; return bfr(xrow_in(F, 0, row)[d] * rs * FIN(I_N1G)[d] * (1.0f + mod[1024 + d]) + mod[d]); }

__device__ __forceinline__ void dbg_check_phase(Frame& F) {
    const int gw = F.bid * NWAVES + F.wave, NGW = F.G * NWAVES, lane = F.lane;
    unsigned* CNT = (unsigned*)(F.ws + WS_CTL) + 3000;
    LAS float* L = (LAS float*)(F.lds + F.wave * 16384);
#define DBG_FLAG(ch, cond) do { if (__any(cond) && lane == 0) atomicAdd(CNT + (ch), 1u); } while (0)
    for (int s = gw; s < 1536; s += NGW) {
        const unsigned r = dbg_rand(1000u + s); const int row = dbg_row(r); const float rs = dbg_rs(F, row, lane); const int kind = s % 6;
        const bool isp = row < PM; const int b = isp ? (row >> 12) : ((row - PM) >> 3), t = isp ? (row & (PT - 1)) : ((row - PM) & 7);
#define DBG_U(col, dst) do { float a_ = 0.f; for (int d_ = lane; d_ < DM; d_ += 64) a_ += dbg_h(F, row, d_, rs) * bfr(FIN(I_WIN)[(size_t)d_ * D_IN + (col)]); dst = wave_sum(a_); } while (0)
        if (kind == 0) {
            const int c = (r >> 3) % 768, j = c >> 7, k = (c >> 6) & 1, dd = c & 63; float u; DBG_U(O_NKV + c, u); bool bad = false;
            if (j < 4) bad = dbg_bad(F.out[(isp ? OUT_ROWS_P + (size_t)row * 512 : OUT_ROWS_S + (size_t)(row - PM) * 512) + c], u, 0.01f, 0.01f);
            else if (isp) { if (t >= PT - WINB) bad = dbg_bad(F.out[OUT_WIN_P + ((size_t)b * WINB + (t - (PT - WINB))) * 256 + (c - 512)], u, 0.01f, 0.01f); }
            else bad = dbg_bad(F.out[OUT_WIN_S + ((size_t)b * WINB + (WINB - ST) + t) * 256 + (c - 512)], u, 0.01f, 0.01f);
            if (isp) { if (j < 2) bad = bad || dbg_bad(bf1(WSP(bf16, WS_ACMP)[((size_t)j * CMP_ROWS_J + 32768 + (b * 2 + k) * 256 + (t >> 4)) * 1024 + (t & 15) * 64 + dd]), u, 0.01f, 0.01f);
                       else bad = bad || dbg_bad(bf1(WSP(bf16, WS_KVB)[((((size_t)(j - 2) * PB + b) * 2 + k) * PT + t) * 64 + dd]), u, 0.01f, 0.01f); }
            else if (j >= 2) bad = bad || dbg_bad(bf1(WSP(bf16, WS_KVS)[((((size_t)(j - 2) * SB + b) * 2 + k) * ST + t) * 64 + dd]), u, 0.01f, 0.01f);
            DBG_FLAG(0, bad);
        } else if (kind == 1) {
            const int gi = (r >> 3) % 24, c5 = (r >> 8) % 512, cm = (r >> 8) % 3072; float u0, u1, u2, u3; DBG_U(O_NG + gi, u0); DBG_U(O_RX + c5, u1); DBG_U(O_RGATE + c5, u2); DBG_U(O_MG + cm, u3);
            bool bad = dbg_bad(WSP(float, WS_NG)[(size_t)row * 24 + gi], 1.0f / (1.0f + expf(-u0)), 0.01f, 0.005f);
            bad = bad || dbg_bad(WSP(float, WS_RX)[(size_t)row * 512 + c5], u1, 0.01f, 0.01f);
            bad = bad || dbg_bad(bf1(WSP(bf16, WS_GG)[(size_t)row * 512 + c5]), gelu_tanh(u2), 0.02f, 0.01f);
            bad = bad || dbg_bad(bf1(WSP(bf16, WS_MGS)[(size_t)row * 3072 + cm]), 1.0f / (1.0f + expf(-u3)), 0.01f, 0.005f);
            DBG_FLAG(1, bad);
        } else if (kind == 2) {
            const int head = (r >> 13) % 4, dim = (r >> 16) % 64, c5 = (r >> 3) % 512; float x1, x2, uv, ug, uq; DBG_U(O_RQ + head * 128 + dim, x1); DBG_U(O_RQ + head * 128 + 64 + dim, x2); DBG_U(O_RV + c5, uv); DBG_U(O_RG + c5, ug); DBG_U(O_NQ + c5, uq);
            const float pos = (float)(isp ? t : PAST + t); const float ang = pos * (float)pow(10000.0, -(double)dim / 64.0); float sn, cs; sincos_acc(ang, sn, cs);
            const bf16* RQ = WSP(bf16, WS_RQ);
            bool bad = dbg_bad(bf1(RQ[(size_t)row * 512 + head * 128 + dim]), x1 * cs - x2 * sn, 0.02f, 0.02f) || dbg_bad(bf1(RQ[(size_t)row * 512 + head * 128 + 64 + dim]), x1 * sn + x2 * cs, 0.02f, 0.02f);
            bad = bad || dbg_bad(bf1(RQ[(size_t)2 * MT * 512 + (size_t)row * 512 + c5]), uv, 0.01f, 0.01f) || dbg_bad(bf1(RQ[(size_t)3 * MT * 512 + (size_t)row * 512 + c5]), ug, 0.01f, 0.01f);
            bad = bad || dbg_bad(bf1(WSP(bf16, WS_QN)[(size_t)row * 512 + c5]), uq * QSCALE, 0.01f, 0.005f);
            DBG_FLAG(2, bad);
        }
#undef DBG_U
    }
    for (int s = gw; s < 128; s += NGW) {
        const unsigned r = dbg_rand(3000u + s); const int j = r & 1; const bool smp = ((r >> 1) & 3) != 0;
        const int grp = smp ? (int)((r >> 3) % 64) : (int)((r >> 3) % 8), nmax = smp ? 511 : 255; int n = (r >> 10) % nmax; if (((r >> 20) & 7) == 0) n = nmax - 1;
        const size_t rj = smp ? (size_t)grp * 512 + n : (size_t)32768 + grp * 256 + n;
        const bf16* A = WSP(bf16, WS_ACMP) + ((size_t)j * CMP_ROWS_J + rj) * 1024;
        const float* w1 = FIN(I_W1) + (size_t)j * 2048 * 128; const float* pe = FIN(I_PE) + j * 2048;
        for (int hh = 0; hh < 2; ++hh) { const int h = lane + 64 * hh; float a = FIN(I_B1)[j * 128 + h];
            for (int i = 0; i < 1024; ++i) a += (bf1(A[i]) + pe[i]) * w1[(size_t)i * 128 + h] + (bf1(A[1024 + i]) + pe[1024 + i]) * w1[(size_t)(1024 + i) * 128 + h];
            L[h] = gelu_tanh(a); }
        LDS_WAIT(); asm volatile("" ::: "memory");
        float o = 0.f; for (int h = 0; h < 128; ++h) o += L[h] * FIN(I_W2)[((size_t)j * 128 + h) * 64 + lane];
        const float got = bf1(WSP(bf16, WS_CK)[((size_t)j * CMP_ROWS_J + rj) * 64 + lane]);
        { const bool bd = dbg_bad(got, o, 0.05f, 0.03f); const unsigned long long mk = __ballot(bd); if (lane == 0 && mk) atomicAdd(CNT + 3, (unsigned)__popcll(mk)); }
        LDS_WAIT(); asm volatile("" ::: "memory");
    }
    for (int s = gw; s < 128; s += NGW) {
        const unsigned r = dbg_rand(3500u + s); const int j = r & 1; const bool smp = ((r >> 1) & 3) != 0;
        const int grp = smp ? (int)((r >> 3) % 64) : (int)((r >> 3) % 8), nmax = smp ? 511 : 255; const int n = (r >> 10) % nmax;
        const size_t rj = smp ? (size_t)grp * 512 + n : (size_t)32768 + grp * 256 + n, row = (size_t)j * CMP_ROWS_J + rj;
        const bf16* A = WSP(bf16, WS_ACMP) + row * 1024; const float* w1 = FIN(I_W1) + (size_t)j * 2048 * 128; const bf16* LH = WSP(bf16, WS_LH);
        unsigned nb = 0;
        for (int hh = 0; hh < 2; ++hh) { const int h = lane + 64 * hh; float lo = 0.f, hi = 0.f;
            for (int i = 0; i < 1024; ++i) { const float av = bf1(A[i]); lo += av * bfr(w1[(size_t)i * 128 + h]); hi += av * bfr(w1[(size_t)(1024 + i) * 128 + h]); }
            const bool bd = dbg_bad(bf1(LH[row * 256 + h]), lo, 0.02f, 0.02f) || dbg_bad(bf1(LH[row * 256 + 128 + h]), hi, 0.02f, 0.02f); nb += (unsigned)__popcll(__ballot(bd)); }
        if (lane == 0 && nb) atomicAdd(CNT + 9, nb);
        for (int hh = 0; hh < 2; ++hh) { const int h = lane + 64 * hh; L[h] = gelu_tanh(bf1(LH[row * 256 + h]) + bf1(LH[(row + 1) * 256 + 128 + h]) + WSP(float, WS_SMALLW + SW_CB)[j * 128 + h]); }
        LDS_WAIT(); asm volatile("" ::: "memory");
        float o = 0.f; for (int h = 0; h < 128; ++h) o += bfr(L[h]) * bfr(FIN(I_W2)[((size_t)j * 128 + h) * 64 + lane]);
        { const bool bd = dbg_bad(bf1(WSP(bf16, WS_CK)[row * 64 + lane]), o, 0.03f, 0.01f); const unsigned long long mk = __ballot(bd); if (lane == 0 && mk) atomicAdd(CNT + 11, (unsigned)__popcll(mk)); }
        LDS_WAIT(); asm volatile("" ::: "memory");
    }
    for (int s = gw; s < 64; s += NGW) {
        const unsigned r = dbg_rand(3700u + s); const int j = r & 1, half = (r >> 1) & 1, h = (r >> 2) % 128; const bf16* W1T = WSP(bf16, WS_SMALLW + SW_W1T) + ((size_t)j * 256 + half * 128 + h) * 1024;
        const float* w1 = FIN(I_W1) + ((size_t)j * 32 + half * 16) * 64 * 128 + h; unsigned nb = 0;
        for (int k = lane; k < 1024; k += 64) nb += (unsigned)__popcll(__ballot(dbg_bad(bf1(W1T[k]), w1[(size_t)k * 128], 0.01f, 0.0001f)));
        if (lane == 0 && nb) atomicAdd(CNT + 12, nb);
        const bool smp = ((r >> 9) & 3) != 0; const int grp = smp ? (int)((r >> 11) % 64) : (int)((r >> 11) % 8), n = (r >> 17) % (smp ? 511 : 255);
        const size_t row = (size_t)j * CMP_ROWS_J + (smp ? (size_t)grp * 512 + n : (size_t)32768 + grp * 256 + n); const bf16* A = WSP(bf16, WS_ACMP) + row * 1024;
        float a = 0.f; for (int k = lane; k < 1024; k += 64) a += bf1(A[k]) * bf1(W1T[k]); a = wave_sum(a);
        DBG_FLAG(13, dbg_bad(bf1(WSP(bf16, WS_LH)[row * 256 + half * 128 + h]), a, 0.02f, 0.02f));
    }
    for (int s = gw; s < 4; s += NGW) {
        const int j = s >> 1, h = (s & 1) * 64 + lane; const float* w1 = FIN(I_W1) + (size_t)j * 2048 * 128; const float* pe = FIN(I_PE) + j * 2048;
        float a = FIN(I_B1)[j * 128 + h]; for (int i = 0; i < 2048; ++i) a += pe[i] * w1[(size_t)i * 128 + h];
        const unsigned long long mk = __ballot(dbg_bad(WSP(float, WS_SMALLW + SW_CB)[j * 128 + h], a, 0.001f, 0.0005f)); if (lane == 0 && mk) atomicAdd(CNT + 10, (unsigned)__popcll(mk));
    }
    for (int s = gw; s < 96; s += NGW) {
        const unsigned r = dbg_rand(4000u + s); const bool smp = (s % 3) == 2;
        int seq, kvh = (r >> 4) & 1, t, tl = 0; size_t row;
        if (smp) { seq = (r >> 5) % SB; tl = (r >> 10) % ST; t = PAST + tl; row = (size_t)PM + seq * ST + tl; }
        else { seq = (r >> 5) % PB; const unsigned k = (r >> 8) % 8u; t = (k == 0) ? (int)((r >> 12) % 40) : (k == 1) ? PT - 1 - (int)((r >> 12) % 70) : (int)((r >> 12) % PT); row = (size_t)seq * PT + t; }
        const int N = smp ? 511 : 255, NS = smp ? 129 : 64, cur = t >> 6;
        LAS float* Q = L; LAS float* SC = L + 256; LAS float* PSUM = L + 256 + 2048; LAS float* OUT = L + 256 + 2048 + 512;
        for (int i = lane; i < 256; i += 64) Q[i] = bf1(WSP(bf16, WS_QN)[row * 512 + (kvh * 4 + (i >> 6)) * 64 + (i & 63)]);
        for (int i = lane; i < 768; i += 64) OUT[i] = 0.f;
        LDS_WAIT(); asm volatile("" ::: "memory");
        const bf16* CKk = WSP(bf16, WS_CK) + (smp ? (size_t)(seq * 2 + kvh) * 512 : (size_t)32768 + (seq * 2 + kvh) * 256) * 64; const bf16* CKv = CKk + (size_t)CMP_ROWS_J * 64;
        const int nvis = smp ? 511 : ((t >= 31) ? ((t - 31) >> 4) + 1 : 0);
        for (int i = lane; i < 512; i += 64) PSUM[i] = 0.f;
        for (int hr = 0; hr < 4; ++hr) {
            float mx = -INFINITY; for (int n = lane; n < nvis; n += 64) { float a = 0.f; for (int d = 0; d < 64; ++d) a += Q[hr * 64 + d] * bf1(CKk[(size_t)n * 64 + d]); SC[n] = a; mx = fmaxf(mx, a); }
            for (int o = 1; o < 64; o <<= 1) mx = fmaxf(mx, __shfl_xor(mx, o));
            float den = 0.f; for (int n = lane; n < nvis; n += 64) { const float e = exp2f(SC[n] - mx); SC[n] = e; den += e; } den = wave_sum(den);
            LDS_WAIT(); asm volatile("" ::: "memory");
            if (nvis > 0) { float o = 0.f; for (int n = 0; n < nvis; ++n) o += SC[n] * bf1(CKv[(size_t)n * 64 + lane]); OUT[hr * 64 + lane] = o / den;
                for (int n = lane; n < nvis; n += 64) PSUM[n] += SC[n] / den; }
            LDS_WAIT(); asm volatile("" ::: "memory");
        }
        LAS float* IMP = SC; LAS float* SELB = SC + 256;
        for (int sblk = lane; sblk < NS; sblk += 64) { float imp = 0.f; for (int n = 4 * sblk - 1; n <= 4 * sblk + 3; ++n) if (n >= 0 && n < N) imp += PSUM[n];
            const bool forced = sblk == 0 || sblk == cur || sblk == cur - 1, avail = sblk * 64 <= t; IMP[sblk] = avail ? (forced ? 1e4f : imp) : -1e4f; SELB[sblk] = 0.f; }
        LDS_WAIT(); asm volatile("" ::: "memory");
        for (int pick = 0; pick < 16 && pick < NS; ++pick) { float bv = -INFINITY; int bi = 1 << 30;
            for (int sblk = lane; sblk < NS; sblk += 64) { const float v = (SELB[sblk] != 0.f) ? -INFINITY : IMP[sblk]; if (v > bv || (v == bv && sblk < bi)) { bv = v; bi = sblk; } }
            for (int o = 1; o < 64; o <<= 1) { const float ov = __shfl_xor(bv, o); const int oi = __shfl_xor(bi, o); if (ov > bv || (ov == bv && oi < bi)) { bv = ov; bi = oi; } }
            if (lane == 0) SELB[bi] = 1.f; LDS_WAIT(); asm volatile("" ::: "memory"); }
        for (int br = 1; br < 3; ++br) for (int hr = 0; hr < 4; ++hr) {
            float mx = -INFINITY, den = 0.f, o = 0.f;
            const int plo = (br == 1) ? 0 : (t - WINB < 0 ? 0 : t - WINB), phi = t;
            for (int p = plo; p <= phi; ++p) {
                if (br == 1 && SELB[p >> 6] == 0.f) { p |= 63; continue; }
                const float* kf = nullptr; const bf16* kb = nullptr; const float* vf = nullptr; const bf16* vb = nullptr;
                const int jk = (br == 1) ? 2 : 4;
                if (!smp) { kb = WSP(bf16, WS_KVB) + ((((size_t)(jk - 2) * PB + seq) * 2 + kvh) * PT + p) * 64; vb = kb + (size_t)PB * 2 * PT * 64; }
                else if (p >= PAST) { kb = WSP(bf16, WS_KVS) + ((((size_t)(jk - 2) * SB + seq) * 2 + kvh) * ST + (p - PAST)) * 64; vb = kb + (size_t)SB * 2 * ST * 64; }
                else if (br == 1) { const int page = ((const int*)F.a->in[I_PT])[seq * NPG + (p >> 7)]; kf = FIN(I_CACHE) + ((((size_t)page * PAGE + (p & 127)) * 4 + 2) * 2 + kvh) * 64; vf = kf + 128; }
                else { kf = FIN(I_CWIN) + ((((size_t)seq * WINB + (p - (PAST - WINB))) * 2 + 0) * 2 + kvh) * 64; vf = kf + 128; }
                float a = 0.f; for (int d = 0; d < 64; ++d) a += Q[hr * 64 + d] * (kb ? bf1(kb[d]) : bfr(kf[d]));
                const float vv = vb ? bf1(vb[lane]) : bfr(vf[lane]);
                const float mn = fmaxf(mx, a), al = exp2f(mx - mn), e = exp2f(a - mn); den = den * al + e; o = o * al + e * vv; mx = mn;
            }
            OUT[(br * 4 + hr) * 64 + lane] = (den > 0.f) ? o / den : 0.f;
        }
        LDS_WAIT(); asm volatile("" ::: "memory");
        bool bad = false;
        for (int hr = 0; hr < 4; ++hr) { const float* ng = WSP(float, WS_NG) + row * 24 + (kvh * 4 + hr) * 3;
            const float e = ng[0] * OUT[(0 * 4 + hr) * 64 + lane] + ng[1] * OUT[(1 * 4 + hr) * 64 + lane] + ng[2] * OUT[(2 * 4 + hr) * 64 + lane];
            bad = bad || dbg_bad(bf1(WSP(bf16, WS_OA)[row * 512 + (kvh * 4 + hr) * 64 + lane]), e, 0.04f, 0.004f); }
        DBG_FLAG(smp ? 5 : 4, bad);
        LDS_WAIT(); asm volatile("" ::: "memory");
    }
    for (int s = gw; s < 96; s += NGW) {
        const unsigned r = dbg_rand(6000u + s); const bool smp = (s % 3) == 2; const int h = (r >> 3) & 3; const float lg = ret_log_g(h);
        const bf16* RQ = WSP(bf16, WS_RQ); const bf16* RK = RQ + (size_t)MT * 512; const bf16* RV = RQ + (size_t)2 * MT * 512; const bf16* RG = RQ + (size_t)3 * MT * 512;
        int seq, t; size_t row0; if (smp) { seq = (r >> 5) % SB; t = (r >> 10) % ST; row0 = (size_t)PM + seq * ST; } else { seq = (r >> 5) % PB; const unsigned k = (r >> 8) % 4u; t = (k == 0) ? (int)((r >> 12) % 300) : (int)((r >> 12) % PT); row0 = (size_t)seq * PT; }
        float o0 = 0.f, o1 = 0.f;
        for (int d = lane; d < 128; d += 64) L[d] = bf1(RQ[(row0 + t) * 512 + h * 128 + d]);
        LDS_WAIT(); asm volatile("" ::: "memory");
        for (int j = 0; j <= t; ++j) { float a = 0.f; for (int d = 0; d < 128; ++d) a += L[d] * bf1(RK[(row0 + j) * 512 + h * 128 + d]);
            a *= expf((float)(t - j) * lg); o0 += a * bf1(RV[(row0 + j) * 512 + h * 128 + lane]); o1 += a * bf1(RV[(row0 + j) * 512 + h * 128 + 64 + lane]); }
        if (smp) { const float* S0 = FIN(I_SRET) + (((size_t)0 * SB + seq) * 4 + h) * 16384; const float cr = expf((float)(t + 1) * lg);
            for (int d = 0; d < 128; ++d) { o0 += L[d] * S0[d * 128 + lane] * cr; o1 += L[d] * S0[d * 128 + 64 + lane] * cr; } }
        const float mean = wave_sum(o0 + o1) * (1.0f / 128.0f); const float var = wave_sum((o0 - mean) * (o0 - mean) + (o1 - mean) * (o1 - mean)) * (1.0f / 128.0f), rstd = 1.0f / sqrtf(var + EPS);
        const float* GN = FIN(I_GNG) + h * 128; const bf16* OR_ = WSP(bf16, WS_OA) + (size_t)MT * 512;
        const float g0 = bf1(RG[(row0 + t) * 512 + h * 128 + lane]), g1 = bf1(RG[(row0 + t) * 512 + h * 128 + 64 + lane]);
        const float e0 = (o0 - mean) * rstd * GN[lane] * (g0 / (1.0f + expf(-g0))), e1 = (o1 - mean) * rstd * GN[64 + lane] * (g1 / (1.0f + expf(-g1)));
        DBG_FLAG(6, dbg_bad(bf1(OR_[(row0 + t) * 512 + h * 128 + lane]), e0, 0.04f, 0.02f) || dbg_bad(bf1(OR_[(row0 + t) * 512 + h * 128 + 64 + lane]), e1, 0.04f, 0.02f));
        const int d = (r >> 20) % 128, T = smp ? ST : PT; float s0 = 0.f, s1 = 0.f;
        for (int j = 0; j < T; ++j) { const float kk = bf1(RK[(row0 + j) * 512 + h * 128 + d]) * expf((float)(T - 1 - j) * lg); s0 += kk * bf1(RV[(row0 + j) * 512 + h * 128 + lane]); s1 += kk * bf1(RV[(row0 + j) * 512 + h * 128 + 64 + lane]); }
        const float* SO;
        if (smp) { const float* S0 = FIN(I_SRET) + (((size_t)0 * SB + seq) * 4 + h) * 16384; const float g8 = expf(8.0f * lg); s0 += g8 * S0[d * 128 + lane]; s1 += g8 * S0[d * 128 + 64 + lane]; SO = F.out + OUT_RET_S + (((size_t)0 * SB + seq) * 4 + h) * 16384; }
        else SO = F.out + OUT_RET_P + (((size_t)0 * PB + seq) * 4 + h) * 16384;
        DBG_FLAG(7, dbg_bad(SO[d * 128 + lane], s0, 0.02f, 0.02f) || dbg_bad(SO[d * 128 + 64 + lane], s1, 0.02f, 0.02f));
        LDS_WAIT(); asm volatile("" ::: "memory");
    }
    for (int s = gw; s < 48; s += NGW) {
        const unsigned r = dbg_rand(8000u + s); const bool smp = (s % 3) == 2; const int blk = (r >> 3) & 7, c = blk * 64 + lane;
        int seq, T; size_t row0; if (smp) { seq = (r >> 6) % SB; T = ST; row0 = (size_t)PM + seq * ST; } else { seq = (r >> 6) % PB; T = 1 + (int)((r >> 10) % ((s & 1) ? 200 : PT)); row0 = (size_t)seq * PT; }
        const float* RX = WSP(float, WS_RX); const float* cw = FIN(I_RCW); const float cb = FIN(I_RCB)[c];
        float x3 = 0.f, x2 = 0.f, x1 = 0.f, h = 0.f;
        if (smp) { const float* cv = FIN(I_SCONV) + (size_t)seq * 3 * 512; x3 = cv[c]; x2 = cv[512 + c]; x1 = cv[1024 + c]; h = FIN(I_SH)[(size_t)seq * 512 + c]; }
        const float sp = log1pf(expf(-FIN(I_LAM)[c])); const float* wa = FIN(I_RWA) + (size_t)blk * 4096; const float* wx = FIN(I_RWX) + (size_t)blk * 4096;
        for (int t = 0; t < T; ++t) { const float x0 = RX[(row0 + t) * 512 + c]; const float xc = cb + cw[c] * x3 + cw[512 + c] * x2 + cw[1024 + c] * x1 + cw[1536 + c] * x0; x3 = x2; x2 = x1; x1 = x0;
            L[lane] = xc; LDS_WAIT(); asm volatile("" ::: "memory");
            float ra = FIN(I_RBA)[c], ri = FIN(I_RBX)[c]; for (int i = 0; i < 64; ++i) { ra += L[i] * wa[i * 64 + lane]; ri += L[i] * wx[i * 64 + lane]; }
            LDS_WAIT(); asm volatile("" ::: "memory");
            const float rr = 1.0f / (1.0f + expf(-ra)), ii = 1.0f / (1.0f + expf(-ri)), la = -8.0f * rr * sp, a = expf(la); h = a * h + sqrtf(-expm1f(2.0f * la)) * (ii * xc); }
        const size_t o = (row0 + T - 1) * 512 + c; const float e = h * bf1(WSP(bf16, WS_GG)[o]);
        DBG_FLAG(8, dbg_bad(bf1((WSP(bf16, WS_OA) + (size_t)2 * MT * 512)[o]), e, 0.04f, 0.01f));
    }
    for (int s = gw; s < 512; s += NGW) {
        const unsigned r = dbg_rand(9000u + s); const int row = dbg_row(r), col = (r >> 7) % DM;
        float e = 0.f;
        for (int br = 0; br < 3; ++br) { const bf16* O = WSP(bf16, WS_OA) + (size_t)br * MT * 512 + (size_t)row * 512; const float* W = FIN(br == 0 ? I_WBRA : (br == 1 ? I_WBRB : I_WBRC));
            float a = 0.f; for (int k = lane; k < 512; k += 64) a += bf1(O[k]) * bfr(W[(size_t)k * DM + col]); a = wave_sum(a); e += bf1(WSP(bf16, WS_MGS)[(size_t)row * 3072 + br * 1024 + col]) * a; }
        DBG_FLAG(20, dbg_bad(bf1(WSP(bf16, WS_MRG)[(size_t)row * DM + col]), e, 0.03f, 0.01f));
        const float* mod = WSP(float, WS_MOD) + (size_t)row_bb(row) * 6144;
        { float a = 0.f; for (int k = lane; k < DM; k += 64) a += bf1(WSP(bf16, WS_MRG)[(size_t)row * DM + k]) * bfr(FIN(I_WOUT)[(size_t)k * DM + col]); a = wave_sum(a);
          const float ex = xrow_in(F, 0, row)[col] + mod[2048 + col] * a; DBG_FLAG(21, dbg_bad(WSP(float, WS_X1)[(size_t)row * DM + col], ex, 0.005f, 0.005f)); }
        { const float* xr = WSP(float, WS_X1) + (size_t)row * DM; float ss = 0.f; for (int d = lane; d < DM; d += 64) ss += xr[d] * xr[d]; const float rs = 1.0f / sqrtf(wave_sum(ss) * (1.0f / DM) + EPS);
          const int c2 = (r >> 9) % NUP; float a = 0.f; for (int d = lane; d < DM; d += 64) a += bfr(xr[d] * rs * FIN(I_N2G)[d] * (1.0f + mod[4096 + d]) + mod[3072 + d]) * bfr(FIN(I_WUP)[(size_t)d * NUP + c2]); a = wave_sum(a);
          const float got = c2 < DFF ? bf1(WSP(bf16, WS_GP)[(size_t)row * DFF + c2]) : bf1((WSP(bf16, WS_GP) + (size_t)MT * DFF)[(size_t)row * DFF + c2 - DFF]); DBG_FLAG(22, dbg_bad(got, a, 0.02f, 0.01f)); }
        { const int c3 = (r >> 11) % DFF; const bf16* GP = WSP(bf16, WS_GP); const bf16* VAL = GP + (size_t)MT * DFF; const float* cw = FIN(I_FCW);
          const bool isp = row < PM; const int t = isp ? (row & (PT - 1)) : ((row - PM) & 7); float xm2, xm1;
          if (t >= 2) { xm2 = bf1(GP[(size_t)(row - 2) * DFF + c3]); xm1 = bf1(GP[(size_t)(row - 1) * DFF + c3]); }
          else if (isp) { xm2 = 0.f; xm1 = (t == 1) ? bf1(GP[(size_t)(row - 1) * DFF + c3]) : 0.f; }
          else { const float* st = FIN(I_SFFN) + ((size_t)((row - PM) >> 3) * 2) * DFF + c3; xm2 = (t == 0) ? st[0] : st[DFF]; xm1 = (t == 0) ? st[DFF] : bf1(GP[(size_t)(row - 1) * DFF + c3]); }
          const float y = FIN(I_FCB)[c3] + cw[c3] * xm2 + cw[DFF + c3] * xm1 + cw[2 * DFF + c3] * bf1(GP[(size_t)row * DFF + c3]); const float ex = (y / (1.0f + expf(-y))) * bf1(VAL[(size_t)row * DFF + c3]);
          DBG_FLAG(23, dbg_bad(bf1((GP + (size_t)2 * MT * DFF)[(size_t)row * DFF + c3]), ex, 0.02f, 0.005f)); }
        { const bf16* ACT = WSP(bf16, WS_GP) + (size_t)2 * MT * DFF + (size_t)row * DFF; float a = 0.f; for (int k = lane; k < DFF; k += 64) a += bf1(ACT[k]) * bfr(FIN(I_WDN)[(size_t)k * DM + col]); a = wave_sum(a);
          const float ex = WSP(float, WS_X1)[(size_t)row * DM + col] + mod[5120 + col] * a; DBG_FLAG(24, dbg_bad(WSP(float, WS_X2)[(size_t)row * DM + col], ex, 0.005f, 0.005f)); }
    }
#undef DBG_FLAG
}
__device__ __forceinline__ void dbg_report_phase(Frame& F) {
    const unsigned* CNT = (const unsigned*)(F.ws + WS_CTL) + 3000;
    const size_t ooff[14] = {OUT_Y, OUT_Y + (size_t)PM * DM, OUT_ROWS_P, OUT_ROWS_S, OUT_WIN_P, OUT_WIN_S, OUT_RET_P, OUT_RET_S, OUT_H_P, OUT_H_S, OUT_CV_P, OUT_CV_S, OUT_FC_P, OUT_FC_S};
    if (F.bid == 0 && F.tid < 14) { const int b = F.tid; const unsigned c = CNT[b]; const int cnt = 1 + (int)(c > 1000u ? 1000u : c);
        for (int i = 0; i < cnt; ++i) ((unsigned*)F.out)[ooff[b] + 7 + 2 * i] = 0xAAAAAAAAu; }
}
#endif

#ifndef DBG_SUB
#define DBG_SUB 0xFFFF
#endif
#ifndef DBG_MAXPH
#define DBG_MAXPH N_PHASES
#endif
#ifndef DBG_REPEAT
#define DBG_REPEAT 0
#endif
#ifndef DBG_MASK
#define DBG_MASK 0xFFFF
#endif
#define IN(k) (lo <= (k) && (k) < hi)
#ifdef DBG_TIME
#define SEAM(k) do { if ((k) + 1 < hi) { if (MK_N_LAUNCHES == 1) xcd_barrier(bar); } if (F.bid == 0 && F.tid == 0) ((unsigned long long*)(F.ws + WS_CTL))[2048 + (k) + 1] = __builtin_amdgcn_s_memrealtime(); } while (0)
#else
#define SEAM(k) do { if ((k) + 1 < hi) { if (MK_N_LAUNCHES == 1) xcd_barrier(bar); } } while (0)
#endif
template <int l> __device__ __forceinline__ void ph_win(Frame& F) { unsigned char* ws = F.ws;
    pg8::Gemm g{(const pg8::bf16_t*)(ws + WS_H), (const pg8::bf16_t*)(ws + WS_WIN) + (size_t)l * NIN * DM, MT, NIN, DM};
    pg8::StaticOrder S; S.init(MT, NIN, F.G, F.bid); EpiWin E{ws, F.out, l};
    pg8::gemm_phase<EpiWin, pg8::StaticOrder, true, true>(F.lds, g, S, E); }
template <int l> __device__ __forceinline__ void ph_mix1(Frame& F) {
    for (int x = F.bid; x < 512; x += F.G) { launder(F); cmp_gemm_unit<true>(F, l, x >> 8, (x & 255) >> 2, (x & 3) * 128); }
    {
        unsigned* ctr = (unsigned*)(F.ws + WS_CTL) + 3210 + l; volatile LAS int* QI = (volatile LAS int*)(F.lds + MISC_OFF + 128);
#pragma unroll 1
        for (;;) {
            __syncthreads();
            if (F.tid == 0) QI[0] = (int)__hip_atomic_fetch_add(ctr, 1u, __ATOMIC_RELAXED, __HIP_MEMORY_SCOPE_AGENT);
            __syncthreads();
            const int u = __builtin_amdgcn_readfirstlane(QI[0]);
            if (u >= 32 + 768) break;
            launder(F);
            if (u < 32) cmp_gemm_unit<false>(F, l, u >> 4, (u >> 1) & 7, (u & 1) * 128); else if (u < 32 + 256) rglru_unit<0>(F, l, u - 32); else ret_local_unit(F, u - 32 - 256);
        }
        __syncthreads();
    } }
template <int l> __device__ __forceinline__ void ph_mix2(Frame& F) { cmp2_phase(F, l); ret_scan_phase(F, l); rglru_carry_phase(F, l); }
#ifndef DBG_REPQ
#define DBG_REPQ 0
#endif
constexpr int MQ_SA = 64, MQ_PA = MQ_SA + 512, MQ_RG1 = MQ_PA + 256, MQ_RO = MQ_RG1 + 512, MQ_RS = MQ_RO + 128, MQ_RG2 = MQ_RS + 32;
template <int l> __device__ __forceinline__ void ph_mix3(Frame& F) {
    unsigned* ctr = (unsigned*)(F.ws + WS_CTL) + 3200 + l;
    volatile LAS int* QI = (volatile LAS int*)(F.lds + MISC_OFF + 128);
#pragma unroll 1
    for (;;) {
        __syncthreads();
        if (F.tid == 0) QI[0] = (int)__hip_atomic_fetch_add(ctr, 1u, __ATOMIC_RELAXED, __HIP_MEMORY_SCOPE_AGENT);
        __syncthreads();
        const int u = __builtin_amdgcn_readfirstlane(QI[0]);
        if (u >= MQ_RG2) break;
        launder(F);
        if (u < MQ_SA) { attn_sample_unit(F, l, u); if (DBG_REPQ & 2) { launder(F); attn_sample_unit(F, l, u); } }
        else if (u < MQ_PA) { const int v = u - MQ_SA; attn_prompt_unit(F, l, (v & 7) * 64 + 63 - (v >> 3)); if (DBG_REPQ & 1) { launder(F); attn_prompt_unit(F, l, (v & 7) * 64 + 63 - (v >> 3)); } }
        else if (u < MQ_RG1) { rglru_unit<1>(F, l, u - MQ_PA); }
        else if (u < MQ_RO) { ret_out_unit(F, l, u - MQ_RG1); }
        else if (u < MQ_RS) { ret_sample_unit(F, l, u - MQ_RO); }
        else { rglru_unit<2>(F, l, u - MQ_RS); }
    }
    __syncthreads(); }
__device__ __forceinline__ f32x16 smp_tile_acc(Frame& F, const bf16* A, const bf16* Wt, int K, int tile) {
    const int q = F.lane & 31, h_ = F.lane >> 5, ks8 = K / 8, kb = F.wave * ks8;
    const bf16* ap = A + (size_t)((tile >> 5) * 32 + q) * K + kb + 8 * h_; const bf16* bp = Wt + (size_t)((tile & 31) * 32 + q) * K + kb + 8 * h_; f32x16 acc = (f32x16){};
#pragma unroll 11
    for (int kk = 0; kk < ks8 / 16; ++kk) acc = mfma32(*(const bf16x8*)(ap + 16 * kk), *(const bf16x8*)(bp + 16 * kk), acc);
    return acc;
}
__device__ __forceinline__ void smp_tile_put(Frame& F, const f32x16& acc, int slot) { LAS float* R = (LAS float*)(F.lds + slot * 32768) + F.wave * 1024 + F.lane;
#pragma unroll
    for (int r = 0; r < 16; ++r) R[r * 64] = acc[r]; }
__device__ __forceinline__ float smp_tile_get(Frame& F, int slot, int o) { const LAS float* R = (const LAS float*)(F.lds + slot * 32768) + o; float s = 0.f;
#pragma unroll
    for (int w = 0; w < 8; ++w) s += R[w * 1024];
    return s; }
template <int l> __device__ __forceinline__ void ph_br(Frame& F) { unsigned char* ws = F.ws;
    const pg8::bf16_t* wbr = (const pg8::bf16_t*)(ws + WS_WBR) + (size_t)l * 3 * 1024 * 512;
    for (int tile = F.bid; tile < 256; tile += F.G) {
        const f32x16 a0 = smp_tile_acc(F, (const bf16*)(ws + WS_OA) + (size_t)PM * 512, wbr, 512, tile), a1 = smp_tile_acc(F, (const bf16*)(ws + WS_OA) + (size_t)(MT + PM) * 512, wbr + (size_t)1024 * 512, 512, tile),
                     a2 = smp_tile_acc(F, (const bf16*)(ws + WS_OA) + (size_t)(2 * MT + PM) * 512, wbr + (size_t)2 * 1024 * 512, 512, tile);
        __syncthreads(); smp_tile_put(F, a0, 0); smp_tile_put(F, a1, 1); smp_tile_put(F, a2, 2); __syncthreads();
        const bf16* MG = (const bf16*)(ws + WS_MGS); bf16* MR = (bf16*)(ws + WS_MRG);
#pragma unroll
        for (int e = 0; e < 2; ++e) { const int o = F.tid * 2 + e, r = o >> 6, ln = o & 63; const size_t row = (size_t)PM + (tile >> 5) * 32 + (r & 3) + 8 * (r >> 2) + 4 * (ln >> 5); const int col = (tile & 31) * 32 + (ln & 31);
            const bf16* g = MG + row * 3072 + col; MR[row * DM + col] = (bf16)(pk2(bf1(g[0]) * smp_tile_get(F, 0, o) + bf1(g[1024]) * smp_tile_get(F, 1, o) + bf1(g[2048]) * smp_tile_get(F, 2, o), 0.f) & 0xffffu); }
    }
    __syncthreads();
    BrOrder S; S.S.init(PM, DM, F.G, F.bid);
    pg8::Gemm g{(const pg8::bf16_t*)(ws + WS_OA), wbr, 3 * MT, 3 * DM, 512}; EpiBrAll E{ws};
    pg8::gemm_phase<EpiBrAll, BrOrder, true, true>(F.lds, g, S, E); }
template <bool INF32> __device__ __forceinline__ void smp_res(Frame& F, const bf16* A, const bf16* Wt, int K, const void* xin  , bf16* xout  , const float* mod, int gofs) {
    for (int tile = F.bid; tile < 256; tile += F.G) {
        const f32x16 a = smp_tile_acc(F, A, Wt, K, tile);
        __syncthreads(); smp_tile_put(F, a, 0); __syncthreads();
#pragma unroll
        for (int e = 0; e < 2; ++e) { const int o = F.tid * 2 + e, r = o >> 6, ln = o & 63; const int rr = (tile >> 5) * 32 + (r & 3) + 8 * (r >> 2) + 4 * (ln >> 5), col = (tile & 31) * 32 + (ln & 31);
            const float xi = INF32 ? ((const float*)xin)[(size_t)rr * DM + col] : bf1(((const bf16*)xin)[(size_t)rr * DM + col]);
            xout[(size_t)rr * DM + col] = (bf16)(pk2(xi + mod[(size_t)(4 + (rr >> 3)) * 6144 + gofs + col] * smp_tile_get(F, 0, o), 0.f) & 0xffffu); }
    }
    __syncthreads();
}
template <int l> __device__ __forceinline__ void ph_out(Frame& F) { unsigned char* ws = F.ws;
    const float* mod = (const float*)(ws + WS_MOD) + (size_t)l * 36 * 6144;
    smp_res<l == 0>(F, (const bf16*)(ws + WS_MRG) + (size_t)PM * DM, (const bf16*)(ws + WS_WOUT) + (size_t)l * DM * DM, DM, l == 0 ? (const void*)FIN(I_XS) : (const void*)((const bf16*)(ws + WS_X2) + (size_t)PM * DM), (bf16*)(ws + WS_X1) + (size_t)PM * DM, mod, 2048);
    pg8::Gemm g{(const pg8::bf16_t*)(ws + WS_MRG), (const pg8::bf16_t*)(ws + WS_WOUT) + (size_t)l * DM * DM, PM, DM, DM};
    pg8::StaticOrder S; S.init(PM, DM, F.G, F.bid);
    EpiRes<l == 0> E{l == 0 ? (const void*)FIN(I_XP) : (const void*)(ws + WS_X2), (bf16*)(ws + WS_X1), mod, 2048};
    pg8::gemm_phase<EpiRes<l == 0>, pg8::StaticOrder, true, true>(F.lds, g, S, E); }
template <int l> __device__ __forceinline__ void ph_down(Frame& F) { unsigned char* ws = F.ws;
    const float* mod = (const float*)(ws + WS_MOD) + (size_t)l * 36 * 6144;
    {
        pg8::StaticOrder S0; S0.init(PM, DM, F.G, F.bid); pg8::Unit u0;
        for (int i = 0; S0.next(i, u0); ++i) if ((u0.pm & 15) != 0) convact_rows(F, l, (size_t)u0.pm * 256, 2, false);
        asm volatile("s_waitcnt vmcnt(0)" ::: "memory"); __syncthreads();
    }
    smp_res<false>(F, (const bf16*)(ws + WS_GP) + (size_t)2 * MT * DFF + (size_t)PM * DFF, (const bf16*)(ws + WS_WDN) + (size_t)l * DM * DFF, DFF, (const void*)((const bf16*)(ws + WS_X1) + (size_t)PM * DM), (bf16*)(ws + WS_X2) + (size_t)PM * DM, mod, 5120);
    pg8::Gemm g{(const pg8::bf16_t*)(ws + WS_GP) + (size_t)2 * MT * DFF, (const pg8::bf16_t*)(ws + WS_WDN) + (size_t)l * DM * DFF, PM, DM, DFF};
    pg8::StaticOrder S; S.init(PM, DM, F.G, F.bid);
    EpiRes<false> E{(const void*)(ws + WS_X1), (bf16*)(ws + WS_X2), mod, 5120};
    pg8::gemm_phase<EpiRes<false>, pg8::StaticOrder, true, true>(F.lds, g, S, E); }
template <int l> __device__ __forceinline__ void ph_up(Frame& F) { unsigned char* ws = F.ws;
    pg8::Gemm g{(const pg8::bf16_t*)(ws + WS_H), (const pg8::bf16_t*)(ws + WS_WUP) + (size_t)l * NUP * DM, MT, NUP, DM};
    UpOrder S; S.S.init(MT, DFF, F.G, F.bid); EpiUp E{ws, F.out, l, FIN(I_FCW) + (size_t)l * 3 * DFF, FIN(I_FCB) + (size_t)l * DFF, (const bf16*)(ws + WS_SFB) + (size_t)l * SB * 2 * DFF};
    pg8::gemm_phase<EpiUp, UpOrder, true, true>(F.lds, g, S, E); }
#ifdef DBG_AMP_BIT
#define AMP_T0(bit) unsigned long long amp_t0_ = 0ull; if ((bit) == DBG_AMP_BIT) amp_t0_ = __builtin_amdgcn_s_memrealtime();
#define AMP_T1(bit) if ((bit) == DBG_AMP_BIT && F.tid == 0) { volatile LAS unsigned* AM = (volatile LAS unsigned*)(F.lds + MISC_OFF + 192); AM[0] += (unsigned)(__builtin_amdgcn_s_memrealtime() - amp_t0_); }
#else
#define AMP_T0(bit)
#define AMP_T1(bit)
#endif
#define RUNPH(bit, ph, CALL) do { if (((DBG_MASK >> (bit)) & 1) && IN(ph)) { AMP_T0(bit) launder(F); CALL; if ((DBG_REPEAT >> (bit)) & 1) { launder(F); CALL; } SEAM(ph); AMP_T1(bit) } } while (0)
template <int l> __device__ __forceinline__ void layer_phases(Frame& F, const XcdBarrier& bar, int lo, int hi) {
    constexpr int pb = PH_L0 + l * PH_PER_LAYER;
    RUNPH(1, pb + LP_N1, norm_phase(F, l, 0));
    RUNPH(2, pb + LP_WIN, ph_win<l>(F));
    RUNPH(3, pb + LP_MIX1, ph_mix1<l>(F));
    RUNPH(4, pb + LP_MIX2, ph_mix2<l>(F));
    RUNPH(5, pb + LP_MIX3, ph_mix3<l>(F));
    RUNPH(6, pb + LP_BR, ph_br<l>(F));
    RUNPH(7, pb + LP_OUT, ph_out<l>(F));
    RUNPH(8, pb + LP_N2, norm_phase(F, l, 1));
    RUNPH(9, pb + LP_UP, ph_up<l>(F));
    RUNPH(11, pb + LP_DOWN, ph_down<l>(F));
}
__global__ void __launch_bounds__(NTHR, 2) trunk_fwd(Args args) {
    extern __shared__ __attribute__((aligned(16))) unsigned char lds_raw[];
    Frame F;
    F.lds = (LAS unsigned char*)lds_raw;
    F.tid = threadIdx.x; F.lane = F.tid & 63; F.wave = __builtin_amdgcn_readfirstlane(F.tid >> 6);
    F.G = gridDim.x; F.bid = blockIdx.x; F.a = &args; F.ws = args.ws; F.out = args.out;
    volatile LAS unsigned* MISC = (volatile LAS unsigned*)(F.lds + MISC_OFF);
    for (int u = F.tid; u < 64; u += NTHR) MISC[u] = 0u;
    __syncthreads();
    unsigned* barw = (unsigned*)(F.ws + WS_CTL) + CW_BAR;
    XcdBarrier bar; bar.bar = barw; bar.x = 0; bar.st = nullptr;
    if (MK_N_LAUNCHES == 1) bar = xcd_barrier_post(barw, MISC + 8);
    const int lo = args.ph_lo, hi = args.ph_hi;
    unsigned char* ws = F.ws;

#ifdef DBG_TIME
    if (F.bid == 0 && F.tid == 0) ((unsigned long long*)(F.ws + WS_CTL))[2048] = __builtin_amdgcn_s_memrealtime();
#endif
    RUNPH(0, PH_P0, p0_prologue(F));

    layer_phases<0>(F, bar, lo, hi);
    layer_phases<1>(F, bar, lo, hi);
    if (((DBG_MASK >> 12) & 1) && IN(PH_FINAL)) { launder(F); final_phase(F); if ((DBG_REPEAT >> 12) & 1) { launder(F); final_phase(F); } }
#ifdef DBG_AMP_BIT
    if (F.tid == 0) { volatile LAS unsigned* AM = (volatile LAS unsigned*)(F.lds + MISC_OFF + 192); const unsigned long long tot = (unsigned long long)AM[0] * DBG_AMP, ts = __builtin_amdgcn_s_memrealtime();
        while (__builtin_amdgcn_s_memrealtime() - ts < tot) __builtin_amdgcn_s_sleep(8); }
    __syncthreads();
#endif
#ifdef DBG_TIME
    {
        xcd_barrier(bar);
        if (F.bid == 0 && F.tid < 14) {
            const unsigned long long* ts = (const unsigned long long*)(F.ws + WS_CTL) + 2048; const unsigned long long tend = __builtin_amdgcn_s_memrealtime();
            const size_t ooff[14] = {OUT_Y, OUT_Y + (size_t)PM * DM, OUT_ROWS_P, OUT_ROWS_S, OUT_WIN_P, OUT_WIN_S, OUT_RET_P, OUT_RET_S, OUT_H_P, OUT_H_S, OUT_CV_P, OUT_CV_S, OUT_FC_P, OUT_FC_S};
            const int b = F.tid; unsigned long long d;
            if (b == 0) d = tend - ts[0]; else if (b == 1) d = ts[1] - ts[0]; else if (b == 13) d = tend - ts[PH_FINAL];
            else { const int ph = PH_L0 + DBG_TIME_LAYER * PH_PER_LAYER + (b - 2); d = ts[ph + 1] - ts[ph]; }
            int cnt = (int)(d / 100ull); if (cnt < 1) cnt = 1; if (cnt > 2000 && b != 0) cnt = 2000;
            for (int i = 0; i < cnt; ++i) ((unsigned*)F.out)[ooff[b] + 7 + 2 * i] = 0xAAAAAAAAu;
        }
    }
#endif
#ifdef DBG_COUNT
    {
        xcd_barrier(bar);
        if (F.bid == 0 && F.tid < 3) { const unsigned* CNT = (const unsigned*)(F.ws + WS_CTL) + 3000; const size_t ooff[3] = {OUT_Y, OUT_Y + (size_t)PM * DM, OUT_ROWS_P};
            const int cnt = (int)((unsigned long long)CNT[F.tid] * 10ull / (CNT[3] ? CNT[3] : 1u)); for (int i = 0; i < cnt; ++i) ((unsigned*)F.out)[ooff[F.tid] + 7 + 2 * i] = 0xAAAAAAAAu; }
    }
#endif
#ifdef DBG_CHECK
    if (lo == 100) { launder(F); dbg_check_phase(F); }
    if (lo == 101) { for (size_t i = (size_t)F.bid * NTHR + F.tid; i < OUT_END; i += (size_t)F.G * NTHR) F.out[i] = 0.f; }
    if (lo == 102) { launder(F); dbg_report_phase(F); }
#endif
}

extern "C" void kernel_launch(void* const* d_in, const int* in_sizes, int n_in, void* d_out, int out_size, void* d_ws, size_t ws_size, hipStream_t stream) {
    static int grid = 0;
    if (grid == 0) {
        if (n_in != 37 || (size_t)out_size != OUT_END || ws_size < WS_END) { fprintf(stderr, "kernel_launch: unexpected shapes: n_in %d out %d (want %zu) ws %zu (want %zu)\n", n_in, out_size, (size_t)OUT_END, ws_size, (size_t)WS_END); grid = -1; return; }
        int dev = 0, cus = 0, per_cu = 0;
        if (hipGetDevice(&dev) != hipSuccess || hipDeviceGetAttribute(&cus, hipDeviceAttributeMultiprocessorCount, dev) != hipSuccess) { grid = -1; return; }
        if (hipFuncSetAttribute((const void*)trunk_fwd, hipFuncAttributeMaxDynamicSharedMemorySize, LDS_BYTES) != hipSuccess) { fprintf(stderr, "kernel_launch: hipFuncSetAttribute failed\n"); grid = -1; return; }
        if (hipOccupancyMaxActiveBlocksPerMultiprocessor(&per_cu, (const void*)trunk_fwd, NTHR, LDS_BYTES) != hipSuccess || per_cu < 1) fprintf(stderr, "kernel_launch: occupancy query reports %d\n", per_cu);
        (void)hipGetLastError();
        grid = cus;
    }
    if (grid < 0) return;
    if (hipMemsetAsync((char*)d_ws + WS_CTL, 0, CTL_ZERO_BYTES, stream) != hipSuccess) return;
#ifdef DBG_POISON
    (void)hipMemsetAsync((char*)d_ws + CTL_ZERO_BYTES, 0xAA, WS_END - CTL_ZERO_BYTES, stream);
    (void)hipMemsetAsync(d_out, 0xAA, (size_t)OUT_END * 4, stream);
#endif
    Args a{};
    for (int i = 0; i < 37; ++i) a.in[i] = d_in[i];
    a.out = (float*)d_out; a.ws = (unsigned char*)d_ws;
#if MK_N_LAUNCHES == 1
    a.ph_lo = 0; a.ph_hi = N_PHASES;
    hipLaunchKernelGGL(trunk_fwd, dim3(grid), dim3(NTHR), LDS_BYTES, stream, a);
#else
    for (int p = 0; p < DBG_MAXPH; ++p) { a.ph_lo = p; a.ph_hi = p + 1; hipLaunchKernelGGL(trunk_fwd, dim3(grid), dim3(NTHR), LDS_BYTES, stream, a); }
#ifdef DBG_CHECK
    for (int p = 100; p < 103; ++p) { a.ph_lo = p; a.ph_hi = p + 1; hipLaunchKernelGGL(trunk_fwd, dim3(grid), dim3(NTHR), LDS_BYTES, stream, a); }
#endif
#endif
    (void)in_sizes;
}
```

```cpp
#include <hip/hip_runtime.h>
#include <cstdio>
#include <cstdint>

#ifndef MK_N_LAUNCHES
#define MK_N_LAUNCHES 1
#endif

constexpr int DM = 1024, PB = 4, PT = 4096, PM = PB * PT, SB = 32, ST = 8, SM = SB * ST, MT = PM + SM;
constexpr int DEPTH = 2, PAST = 8192, PAGE = 128, NPG = PAST / PAGE, NPHYS = 2560;
constexpr int D_IN = 7448, NIN = 7680, DFF = 2816, NUP = 2 * DFF;
constexpr int WINB = 512;
constexpr float EPS = 1e-6f;
constexpr float QSCALE = 0.125f * 1.4426950408889634f;

constexpr int O_NQ = 0, O_NKV = 512, O_NG = 1280, O_RQ = 1304, O_RK = 1816, O_RV = 2328, O_RG = 2840, O_RX = 3352, O_RGATE = 3864, O_MG = 4376;

constexpr size_t OUT_Y = 0;
constexpr size_t OUT_ROWS_P = OUT_Y + (size_t)MT * DM;
constexpr size_t OUT_ROWS_S = OUT_ROWS_P + (size_t)DEPTH * PM * 512;
constexpr size_t OUT_WIN_P = OUT_ROWS_S + (size_t)DEPTH * SM * 512;
constexpr size_t OUT_WIN_S = OUT_WIN_P + (size_t)DEPTH * PB * WINB * 256;
constexpr size_t OUT_RET_P = OUT_WIN_S + (size_t)DEPTH * SB * WINB * 256;
constexpr size_t OUT_RET_S = OUT_RET_P + (size_t)DEPTH * PB * 4 * 16384;
constexpr size_t OUT_H_P = OUT_RET_S + (size_t)DEPTH * SB * 4 * 16384;
constexpr size_t OUT_H_S = OUT_H_P + (size_t)DEPTH * PB * 512;
constexpr size_t OUT_CV_P = OUT_H_S + (size_t)DEPTH * SB * 512;
constexpr size_t OUT_CV_S = OUT_CV_P + (size_t)DEPTH * PB * 3 * 512;
constexpr size_t OUT_FC_P = OUT_CV_S + (size_t)DEPTH * SB * 3 * 512;
constexpr size_t OUT_FC_S = OUT_FC_P + (size_t)DEPTH * PB * 2 * DFF;
constexpr size_t OUT_END = OUT_FC_S + (size_t)DEPTH * SB * 2 * DFF;

constexpr size_t MiB = 1u << 20;
constexpr size_t WS_CTL = 0, CTL_ZERO_BYTES = 4 * MiB;
constexpr size_t WS_MOD = 1 * MiB;
constexpr size_t WS_ROT = 4 * MiB;
constexpr size_t WS_SMALLW = 8 * MiB;
constexpr size_t WS_SFB = 12 * MiB;
constexpr size_t WS_WIN = 16 * MiB;
constexpr size_t WS_WBR = WS_WIN + (size_t)2 * NIN * DM * 2;
constexpr size_t WS_WOUT = WS_WBR + (size_t)2 * 3 * 1024 * 512 * 2;
constexpr size_t WS_WUP = WS_WOUT + (size_t)2 * 1024 * 1024 * 2;
constexpr size_t WS_WDN = WS_WUP + (size_t)2 * NUP * DM * 2;
constexpr size_t WS_WEND = WS_WDN + (size_t)2 * DM * DFF * 2;
constexpr size_t WS_H = 128 * MiB;
constexpr size_t WS_QN = WS_H + (size_t)MT * DM * 2;
constexpr size_t WS_KVB = WS_QN + (size_t)MT * 512 * 2;
constexpr size_t WS_KVS = WS_KVB + (size_t)4 * PB * 2 * PT * 64 * 2;
constexpr size_t WS_RQ = WS_KVS + (size_t)4 * SB * 2 * ST * 64 * 2;
constexpr size_t WS_RX = WS_RQ + (size_t)4 * MT * 512 * 2;
constexpr size_t WS_GG = WS_RX + (size_t)MT * 512 * 4;
constexpr size_t WS_MGS = WS_GG + (size_t)MT * 512 * 2;
constexpr size_t WS_NG = WS_MGS + (size_t)MT * 3072 * 2;
constexpr size_t WS_OA = WS_NG + (size_t)MT * 24 * 4;
constexpr size_t WS_MRG = WS_OA + (size_t)3 * MT * 512 * 2;
constexpr size_t WS_X1 = WS_MRG + (size_t)MT * DM * 2;
constexpr size_t WS_X2 = WS_X1 + (size_t)MT * DM * 4;
constexpr size_t WS_GP = WS_X2 + (size_t)MT * DM * 4;
constexpr size_t WS_ACMP = WS_GP + (size_t)3 * MT * DFF * 2;
constexpr int CMP_ROWS_J = 34816, CMP_ROWS = 2 * CMP_ROWS_J;
constexpr size_t WS_LH = WS_ACMP + (size_t)2 * CMP_ROWS * 1024 * 2 + 4096;
constexpr size_t WS_CK = WS_LH + (size_t)(CMP_ROWS + 16) * 256 * 2;
constexpr size_t WS_LT = WS_CK + (size_t)CMP_ROWS * 64 * 2;
constexpr size_t WS_SPT = WS_LT + (size_t)16 * 32 * 16384 * 4;
constexpr size_t WS_CAR = WS_SPT + (size_t)16 * 32 * 16384 * 2;
constexpr size_t WS_OAG = WS_CAR + (size_t)4 * 64 * 3 * 512 * 4 + MiB;
constexpr size_t WS_END = WS_OAG + (size_t)2048 * 32 * 64 * 4 + MiB;
static_assert(WS_WEND <= WS_H, "weights fit below WS_H");

constexpr size_t SW_W1T = 0;
constexpr size_t SW_W2T = SW_W1T + (size_t)2 * 2 * 256 * 1024 * 2;
constexpr size_t SW_CB = SW_W2T + (size_t)2 * 2 * 64 * 128 * 2;
constexpr size_t SW_WAT = SW_CB + (size_t)2 * 2 * 128 * 4;
constexpr size_t SW_SP = SW_WAT + (size_t)2 * 2 * 8 * 64 * 64 * 2;
constexpr size_t SW_END = SW_SP + 2 * 512 * 4;
static_assert(SW_END <= 8 * MiB, "small weights fit");

constexpr int CW_TMO = 0;
constexpr int CW_BAR = 4096;

constexpr int PH_P0 = 0, PH_L0 = 1, PH_PER_LAYER = 11, PH_FINAL = PH_L0 + DEPTH * PH_PER_LAYER, N_PHASES = PH_FINAL + 1;
enum { LP_N1 = 0, LP_WIN, LP_MIX1, LP_MIX2, LP_MIX3, LP_BR, LP_OUT, LP_N2, LP_UP, LP_CONV, LP_DOWN };

constexpr int RING_BYTES = 131072;
constexpr int MISC_OFF = RING_BYTES;
constexpr int LDS_BYTES = RING_BYTES + 1024;
constexpr int NWAVES = 8, NTHR = 512;

#define GAS __attribute__((address_space(1)))
#define LAS __attribute__((address_space(3)))
typedef unsigned short bf16;
typedef unsigned v4u __attribute__((ext_vector_type(4)));
typedef unsigned v2u __attribute__((ext_vector_type(2)));
typedef float f32x16 __attribute__((ext_vector_type(16)));
typedef short s16x4 __attribute__((ext_vector_type(4)));
namespace pg8 {
#define PG8_LAS __attribute__((address_space(3)))
typedef unsigned short bf16_t;
typedef short bf16x8 __attribute__((ext_vector_type(8)));
typedef float f32x4 __attribute__((ext_vector_type(4)));
typedef unsigned u32x4 __attribute__((ext_vector_type(4)));
constexpr int BM = 256, BK = 64, HALF = 128, HTB = HALF * BK * 2  , STAGE_BYTES = 8 * HTB, NXCD = 8, WGM = 8;

__host__ __device__ __forceinline__ int lds_byte(int r, int c) { const int st = (r >> 4) * 2 + (c >> 5), rr = r & 15, cc = c & 31, ob = rr * 64 + cc * 2; return st * 1024 + (ob ^ (((ob >> 9) & 1) << 5)); }
__host__ __device__ __forceinline__ void stage_rc(int b, int& R, int& C) { const int st = b / 1024, sb = b % 1024, swz = sb ^ (((sb >> 9) & 1) << 5); R = (st >> 1) * 16 + swz / 64; C = (st & 1) * 32 + (swz % 64) / 2; }
__host__ __device__ __forceinline__ int perm32(int rho) { const int n = rho >> 4, i = rho & 15; return 8 * (i >> 2) + 4 * n + (i & 3); }

struct Unit { int pm, pn; };
struct Gemm { const bf16_t* A; const bf16_t* Bt; int M, N, K; };

struct StaticOrder {
    int nM, nN, nwg, G, c;
    __host__ __device__ void init(int M, int N, int G_, int c_) { nM = M / BM; nN = N / BM; nwg = nM * nN; G = G_; c = c_; }
    __host__ __device__ bool next(int i, Unit& u) const {
        const long L = (long)i * G + c; if (L >= nwg) return false;
        int wgid = (int)L; { const int q = nwg / NXCD, r = nwg % NXCD, xcd = wgid % NXCD, off = wgid / NXCD; wgid = (xcd < r ? xcd * (q + 1) : r * (q + 1) + (xcd - r) * q) + off; }
        const int nig = WGM * nN, gid = wgid / nig, fm = gid * WGM, gsz = (nM - fm) < WGM ? (nM - fm) : WGM;
        u.pm = fm + ((wgid % nig) % gsz); u.pn = (wgid % nig) / gsz; return true;
    }
    __device__ __forceinline__ void a_ready(const Unit&) const {}
    __device__ __forceinline__ void done(const Unit&) const {}
};
__device__ __forceinline__ unsigned cvt_pk_bf16(float lo, float hi) { unsigned r; asm volatile("v_cvt_pk_bf16_f32 %0, %1, %2" : "=v"(r) : "v"(lo), "v"(hi)); return r; }
typedef float f32x2 __attribute__((ext_vector_type(2)));
template <class Epi, class Sched, bool ALIGN_EPI = false, bool SP2 = false>
__device__ __forceinline__ void gemm_phase(PG8_LAS unsigned char* lds, const Gemm g, const Sched& S, const Epi& E) {
    const int tid = threadIdx.x, wid = __builtin_amdgcn_readfirstlane(tid >> 6), lane = tid & 63, wr = wid >> 2, wc = wid & 3, fr = lane & 15, fq = lane >> 4;
    const int K = g.K, nt = K / BK;
    unsigned voffA[2], voffB[2];
#pragma unroll
    for (int i = 0; i < 2; ++i) { int R, C; stage_rc(tid * 16 + i * 8192, R, C); const int Rb = Epi::PERM ? ((R & ~31) + perm32(R & 31)) : R;
        voffA[i] = (unsigned)(R * K + C) * 2u; voffB[i] = (unsigned)(Rb * K + C) * 2u; }
    const size_t kstep = (size_t)(BK * 2);
    const size_t hstep = (size_t)HALF * K * 2;
    const size_t tstep = 2 * hstep;
    const unsigned ldsw = (unsigned)wid * 1024u;
    const int aoff = lds_byte(wr * 64 + fr, fq * 8), boff = lds_byte(wc * 32 + fr, fq * 8);
#define PG8_SA(b, h) (((b) * 2 + (h)) * HTB)
#define PG8_SB(b, h) ((4 + (b) * 2 + (h)) * HTB)
#define PG8_STAGE(bufoff, gbase, voff) do { _Pragma("unroll") for (int _i = 0; _i < 2; ++_i) \
        __builtin_amdgcn_global_load_lds((const unsigned*)((const char*)(gbase) + (voff)[_i]), (PG8_LAS unsigned*)(lds + (bufoff) + ldsw + _i * 8192), 16, 0, 0); } while (0)
#define PG8_LDA(dst, b, h) do { _Pragma("unroll") for (int m = 0; m < 4; ++m) _Pragma("unroll") for (int k = 0; k < 2; ++k) dst[m][k] = *(const PG8_LAS bf16x8*)(lds + PG8_SA(b, h) + aoff + m * 2048 + k * 1024); } while (0)
#define PG8_LDB(dst, b, h) do { _Pragma("unroll") for (int n = 0; n < 2; ++n) _Pragma("unroll") for (int k = 0; k < 2; ++k) dst[n][k] = *(const PG8_LAS bf16x8*)(lds + PG8_SB(b, h) + boff + n * 2048 + k * 1024); } while (0)
#define PG8_MMA(ai, bj, At, Bt) do { __builtin_amdgcn_s_setprio(1); _Pragma("unroll") for (int m = 0; m < 4; ++m) _Pragma("unroll") for (int n = 0; n < 2; ++n) _Pragma("unroll") for (int k = 0; k < 2; ++k) \
        acc[ai][bj][m][n] = __builtin_amdgcn_mfma_f32_16x16x32_bf16(Bt[n][k], At[m][k], acc[ai][bj][m][n], 0, 0, 0); __builtin_amdgcn_s_setprio(0); } while (0)
#define PG8_WAIT_V(n) asm volatile("s_waitcnt vmcnt(" #n ")" ::: "memory")
#define PG8_WAIT_L(n) asm volatile("s_waitcnt lgkmcnt(" #n ")" ::: "memory")
#define PG8_BAR __builtin_amdgcn_s_barrier()
#define PG8_SCHED __builtin_amdgcn_sched_barrier(0)
    Unit cur, nxt; int ui = 0;
    if (!S.next(0, cur)) return;
    f32x4 acc[2][2][4][2];
#pragma unroll
    for (int a = 0; a < 2; ++a)
#pragma unroll
        for (int b = 0; b < 2; ++b)
#pragma unroll
            for (int m = 0; m < 4; ++m)
#pragma unroll
                for (int n = 0; n < 2; ++n) acc[a][b][m][n] = (f32x4){0.f, 0.f, 0.f, 0.f};
    bf16x8 At[4][2], B0[2][2], B1[2][2];
    const char* cA = (const char*)g.A + (size_t)cur.pm * tstep; const char* cB = (const char*)g.Bt + (size_t)cur.pn * tstep;
    S.a_ready(cur);
    if constexpr (SP2) {
        PG8_STAGE(PG8_SB(0, 0), cB, voffB); PG8_STAGE(PG8_SB(0, 1), cB + hstep, voffB); PG8_STAGE(PG8_SA(0, 0), cA, voffA); PG8_STAGE(PG8_SA(0, 1), cA + hstep, voffA);
        if (wr == 1) PG8_BAR;
        PG8_WAIT_V(2); PG8_BAR;
        PG8_STAGE(PG8_SB(1, 0), cB + kstep, voffB); PG8_STAGE(PG8_SA(1, 0), cA + kstep, voffA); PG8_STAGE(PG8_SB(1, 1), cB + hstep + kstep, voffB);
        PG8_WAIT_V(6); PG8_BAR;
    } else {
        PG8_STAGE(PG8_SB(0, 0), cB, voffB); PG8_STAGE(PG8_SA(0, 0), cA, voffA); PG8_STAGE(PG8_SB(0, 1), cB + hstep, voffB); PG8_STAGE(PG8_SA(0, 1), cA + hstep, voffA);
        if (wr == 1) PG8_BAR;
        PG8_WAIT_V(4); PG8_BAR;
        PG8_STAGE(PG8_SB(1, 0), cB + kstep, voffB); PG8_STAGE(PG8_SA(1, 0), cA + kstep, voffA); PG8_STAGE(PG8_SB(1, 1), cB + hstep + kstep, voffB);
        PG8_WAIT_V(6); PG8_BAR;
    }
    for (;;) {
        const bool has_next = S.next(ui + 1, nxt);
        const char* nA = has_next ? (const char*)g.A + (size_t)nxt.pm * tstep : cA; const char* nB = has_next ? (const char*)g.Bt + (size_t)nxt.pn * tstep : cB;
        for (int t = 0; t < nt; t += 2) {
            const bool last = (t == nt - 2);
            const char* a1 = cA + (size_t)(t + 1) * kstep;
            const char* a2 = last ? nA : cA + (size_t)(t + 2) * kstep; const char* b2 = last ? nB : cB + (size_t)(t + 2) * kstep;
            const char* a3 = a2 + kstep; const char* b3 = b2 + kstep;
            if (last && has_next) S.a_ready(nxt);
            if constexpr (SP2) {
            PG8_LDB(B0, 0, 0); PG8_LDB(B1, 0, 1); PG8_SCHED; PG8_LDA(At, 0, 0); PG8_STAGE(PG8_SA(1, 1), a1 + hstep, voffA);
            PG8_WAIT_V(8); PG8_WAIT_L(0); PG8_BAR; PG8_MMA(0, 0, At, B0); PG8_MMA(0, 1, At, B1); PG8_BAR; PG8_SCHED;
            PG8_LDA(At, 0, 1); PG8_STAGE(PG8_SB(0, 0), b2, voffB); PG8_STAGE(PG8_SB(0, 1), b2 + hstep, voffB); PG8_STAGE(PG8_SA(0, 0), a2, voffA);
            PG8_WAIT_V(8); PG8_WAIT_L(0); PG8_BAR; PG8_MMA(1, 0, At, B0); PG8_MMA(1, 1, At, B1); PG8_BAR; PG8_SCHED;
            PG8_LDB(B0, 1, 0); PG8_LDB(B1, 1, 1); PG8_SCHED; PG8_LDA(At, 1, 0); PG8_STAGE(PG8_SA(0, 1), a2 + hstep, voffA);
            PG8_WAIT_V(8); PG8_WAIT_L(0); PG8_BAR; PG8_MMA(0, 0, At, B0); PG8_MMA(0, 1, At, B1); PG8_BAR; PG8_SCHED;
            PG8_LDA(At, 1, 1); PG8_STAGE(PG8_SB(1, 0), b3, voffB); PG8_STAGE(PG8_SB(1, 1), b3 + hstep, voffB); PG8_STAGE(PG8_SA(1, 0), a3, voffA);
            PG8_WAIT_V(8); PG8_WAIT_L(0); PG8_BAR; PG8_MMA(1, 0, At, B0); PG8_MMA(1, 1, At, B1); PG8_BAR; PG8_SCHED;
            } else {
            PG8_LDB(B0, 0, 0); PG8_SCHED; PG8_LDA(At, 0, 0); PG8_STAGE(PG8_SA(1, 1), a1 + hstep, voffA);
            PG8_WAIT_L(8); PG8_BAR; PG8_WAIT_L(0); PG8_MMA(0, 0, At, B0); PG8_BAR; PG8_SCHED;
            PG8_LDB(B1, 0, 1); PG8_STAGE(PG8_SB(0, 0), b2, voffB);
            PG8_BAR; PG8_WAIT_L(0); PG8_MMA(0, 1, At, B1); PG8_BAR;
            PG8_LDA(At, 0, 1); PG8_STAGE(PG8_SA(0, 0), a2, voffA);
            PG8_BAR; PG8_WAIT_L(0); PG8_MMA(1, 0, At, B0); PG8_BAR; PG8_SCHED;
            PG8_STAGE(PG8_SB(0, 1), b2 + hstep, voffB);
            PG8_WAIT_V(6); PG8_BAR; PG8_MMA(1, 1, At, B1); PG8_BAR;
            PG8_LDB(B0, 1, 0); PG8_SCHED; PG8_LDA(At, 1, 0); PG8_STAGE(PG8_SA(0, 1), a2 + hstep, voffA);
            PG8_WAIT_L(8); PG8_BAR; PG8_WAIT_L(0); PG8_MMA(0, 0, At, B0); PG8_BAR; PG8_SCHED;
            PG8_LDB(B1, 1, 1); PG8_STAGE(PG8_SB(1, 0), b3, voffB);
            PG8_BAR; PG8_WAIT_L(0); PG8_MMA(0, 1, At, B1); PG8_BAR;
            PG8_LDA(At, 1, 1); PG8_STAGE(PG8_SA(1, 0), a3, voffA);
            PG8_BAR; PG8_WAIT_L(0); PG8_MMA(1, 0, At, B0); PG8_BAR; PG8_SCHED;
            PG8_STAGE(PG8_SB(1, 1), b3 + hstep, voffB);
            PG8_WAIT_V(6); PG8_BAR; PG8_MMA(1, 1, At, B1); PG8_BAR;
            }
        }
        if constexpr (ALIGN_EPI) { if (wr == 0) PG8_BAR; }
        if constexpr (!Epi::AFTER_DRAIN) { E(acc, cur, wr, wc, fr, fq); S.done(cur); }
        if (!has_next) break;
#pragma unroll
        for (int a = 0; a < 2; ++a)
#pragma unroll
            for (int b = 0; b < 2; ++b)
#pragma unroll
                for (int m = 0; m < 4; ++m)
#pragma unroll
                    for (int n = 0; n < 2; ++n) acc[a][b][m][n] = (f32x4){0.f, 0.f, 0.f, 0.f};
        cur = nxt; cA = nA; cB = nB; ++ui;
        if constexpr (ALIGN_EPI) { if (wr == 1) PG8_BAR; }
    }
    PG8_WAIT_V(0);
    if constexpr (!ALIGN_EPI) { if (wr == 0) PG8_BAR; }
    PG8_BAR;
    if constexpr (Epi::AFTER_DRAIN) { E.fused(acc, cur, wr, wc, fr, fq, lds, wid, lane); S.done(cur); }
#undef PG8_SA
#undef PG8_SB
#undef PG8_STAGE
#undef PG8_LDA
#undef PG8_LDB
#undef PG8_MMA
#undef PG8_WAIT_V
#undef PG8_WAIT_L
#undef PG8_BAR
#undef PG8_SCHED
}
}

using pg8::bf16x8; using pg8::f32x4; using pg8::u32x4;
#define LDS_WAIT() asm volatile("s_waitcnt lgkmcnt(0)" ::: "memory")
#define VM_WAIT() asm volatile("s_waitcnt vmcnt(0)" ::: "memory")
typedef float f32x2_t __attribute__((ext_vector_type(2))); typedef __bf16 bf16x2_t __attribute__((ext_vector_type(2)));
__device__ __forceinline__ unsigned pk2(float lo, float hi) { f32x2_t v = {lo, hi}; bf16x2_t b = __builtin_convertvector(v, bf16x2_t); return __builtin_bit_cast(unsigned, b); }
__device__ __forceinline__ float bf_lo(unsigned w) { return __uint_as_float(w << 16); }
__device__ __forceinline__ float bf_hi(unsigned w) { return __uint_as_float(w & 0xffff0000u); }
__device__ __forceinline__ float bf1(bf16 b) { return __uint_as_float(((unsigned)b) << 16); }
__device__ __forceinline__ float fexp2(float x) { return __builtin_amdgcn_exp2f(x); }
__device__ __forceinline__ float fexp(float x) { return __builtin_amdgcn_exp2f(x * 1.4426950408889634f); }
__device__ __forceinline__ float frcp(float x) { return __builtin_amdgcn_rcpf(x); }
__device__ __forceinline__ float sigmoidf_(float x) { return frcp(1.0f + fexp(-x)); }
__device__ __forceinline__ float siluf_(float x) { return x * sigmoidf_(x); }
__device__ __forceinline__ float gelu_tanh(float x) {
    const float u = 0.7978845608028654f * (x + 0.044715f * x * x * x);
    const float e = fexp(2.0f * u);
    const float t = 1.0f - 2.0f * frcp(e + 1.0f);
    return 0.5f * x * (1.0f + t);
}
__device__ __forceinline__ float wave_sum(float v) {
#pragma unroll
    for (int o = 1; o < 64; o <<= 1) v += __shfl_xor(v, o);
    return v;
}
__device__ __forceinline__ v4u pack8(const f32x4 a, const f32x4 b) { v4u w; w.x = pk2(a[0], a[1]); w.y = pk2(a[2], a[3]); w.z = pk2(b[0], b[1]); w.w = pk2(b[2], b[3]); return w; }
__device__ __forceinline__ void unpack8(const v4u w, f32x4& a, f32x4& b) { a = (f32x4){bf_lo(w.x), bf_hi(w.x), bf_lo(w.y), bf_hi(w.y)}; b = (f32x4){bf_lo(w.z), bf_hi(w.z), bf_lo(w.w), bf_hi(w.w)}; }

#define XB_TMO      128
#define XB_XCNT(j)  (256  + 64 * (j))
#define XB_XSUB(j)  (1280 + 64 * (j))
#define XB_XGEN(j)  (2304 + 64 * (j))
#define XB_TOP      3328
#define XB_TOPGEN   3392
#define XCD_BAR_WORDS 3456
#define XB_SPIN_CAP (1u << 18)

__device__ __forceinline__ unsigned xb_ld(unsigned* p)              { return __hip_atomic_load(p, __ATOMIC_RELAXED, __HIP_MEMORY_SCOPE_AGENT); }
__device__ __forceinline__ unsigned xb_add(unsigned* p, unsigned v) { return __hip_atomic_fetch_add(p, v, __ATOMIC_RELAXED, __HIP_MEMORY_SCOPE_AGENT); }
__device__ __forceinline__ unsigned xb_xcc_id() { return (unsigned)__builtin_amdgcn_s_getreg((3 << 11) | 20) & 0xFu; }
#define XB_SPIN(cond, bar) do { unsigned _sp = 0; while (cond) { __builtin_amdgcn_s_sleep(1); \
    if ((++_sp & 255u) == 0u) { if (xb_ld(&(bar)[XB_TMO])) break; if (_sp > XB_SPIN_CAP) { atomicAdd(&(bar)[XB_TMO], 1u); break; } } } } while (0)

struct XcdBarrier {
    unsigned* bar; unsigned x;
    volatile LAS unsigned* st;
};

__device__ __forceinline__ XcdBarrier xcd_barrier_post(unsigned* bar, volatile LAS unsigned* st) {
    XcdBarrier b; b.bar = bar; b.x = xb_xcc_id(); b.st = st;
    if (threadIdx.x == 0) (void)xb_add(&bar[XB_XCNT(b.x)], 1u);
    return b;
}
__device__ __forceinline__ void xcd_barrier_complete(unsigned* bar, unsigned x, unsigned& nloc, unsigned& nx) {
    const unsigned G = gridDim.x * gridDim.y * gridDim.z;
    unsigned sum, cnt, mine, sp = 0u;
    for (;;) {
        sum = 0u; cnt = 0u; mine = 0u;
#pragma unroll
        for (unsigned j = 0; j < 16; ++j) { const unsigned c = xb_ld(&bar[XB_XCNT(j)]); sum += c; cnt += (c > 0u) ? 1u : 0u; mine = (j == x) ? c : mine; }
        if (sum == G) break;
        __builtin_amdgcn_s_sleep(1);
        if ((++sp & 255u) == 0u) { if (xb_ld(&bar[XB_TMO])) break; if (sp > XB_SPIN_CAP) { atomicAdd(&bar[XB_TMO], 1u); break; } }
    }
    nloc = mine > 0u ? mine : 1u; nx = cnt > 0u ? cnt : 1u;
}

__device__ __forceinline__ void xcd_barrier(const XcdBarrier& b) {
    asm volatile("s_waitcnt vmcnt(0)" ::: "memory");
    __syncthreads();
    if (threadIdx.x == 0) {
        unsigned* bar = b.bar;
        __builtin_amdgcn_s_waitcnt(0);
        unsigned nloc = b.st[0], nx = b.st[1];
        if (nloc == 0u) { xcd_barrier_complete(bar, b.x, nloc, nx); b.st[0] = nloc; b.st[1] = nx; }
        const unsigned old = xb_add(&bar[XB_XSUB(b.x)], 1u);
        const unsigned gen = old / nloc;
        if (old + 1u == (gen + 1u) * nloc) {
            __builtin_amdgcn_fence(__ATOMIC_RELEASE, "agent");
            asm volatile("s_waitcnt vmcnt(0)" ::: "memory");
            const unsigned og = xb_add(&bar[XB_TOP], 1u);
            const unsigned tg = og / nx;
            if (og + 1u == (tg + 1u) * nx) xb_add(&bar[XB_TOPGEN], 1u);
            else XB_SPIN(xb_ld(&bar[XB_TOPGEN]) == tg, bar);
            __builtin_amdgcn_fence(__ATOMIC_ACQUIRE, "agent");
            xb_add(&bar[XB_XGEN(b.x)], 1u);
            asm volatile("s_waitcnt vmcnt(0)" ::: "memory");
        } else {
            XB_SPIN(xb_ld(&bar[XB_XGEN(b.x)]) == gen, bar);
            __builtin_amdgcn_fence(__ATOMIC_ACQUIRE, "agent");
            asm volatile("s_waitcnt vmcnt(0)" ::: "memory");
        }
    }
    __syncthreads();
}

struct Args { const void* in[37]; float* out; unsigned char* ws; int ph_lo, ph_hi; };
enum { I_XP = 0, I_XS, I_CACHE, I_CWIN, I_SRET, I_SH, I_SCONV, I_SFFN, I_PT, I_CP, I_CS, I_N1G, I_N2G, I_WADA, I_BADA, I_WIN, I_PE, I_W1, I_B1, I_W2,
       I_GNG, I_RCW, I_RCB, I_RWA, I_RBA, I_RWX, I_RBX, I_LAM, I_WBRA, I_WBRB, I_WBRC, I_WOUT, I_WUP, I_FCW, I_FCB, I_WDN, I_FNG };

struct Frame {
    LAS unsigned char* lds;
    int tid, lane, wave, G, bid;
    const Args* a;
    unsigned char* ws;
    float* out;
};
__device__ __forceinline__ void launder(Frame& F) { asm volatile("" : "+v"(F.tid), "+v"(F.lane)); int w_ = __builtin_amdgcn_readfirstlane(F.wave), b_ = __builtin_amdgcn_readfirstlane(F.bid), g_ = __builtin_amdgcn_readfirstlane(F.G); asm volatile("" : "+s"(w_), "+s"(b_), "+s"(g_)); F.wave = w_; F.bid = b_; F.G = g_; }
#define FIN(i) ((const float*)F.a->in[i])
#define WSP(T, off) ((T*)(F.ws + (off)))

__device__ __forceinline__ int row_bb(int row) { return row < PM ? (row >> 12) : 4 + ((row - PM) >> 3); }
__device__ __forceinline__ int row_pos(int row) { return row < PM ? (row & (PT - 1)) : PT + ((row - PM) & 7); }

__device__ __forceinline__ int win_cmap(int n) {
    if (n < 1280) return n;
    if (n < 2304) { const int c = n - 1280, isk = c >> 9, hc = c & 511, head = hc >> 7, s = hc & 127;
        const int g = s >> 3, w = s & 7, dim = (w < 4) ? (4 * g + w) : (64 + 4 * g + (w - 4)); return (isk ? O_RK : O_RQ) + head * 128 + dim; }
    if (n < 2816) return O_RV + (n - 2304);
    if (n < 3328) return O_RG + (n - 2816);
    if (n < 3840) return O_RX + (n - 3328);
    if (n < 4352) return O_RGATE + (n - 3840);
    if (n < 7424) return O_MG + (n - 4352);
    if (n < 7448) return O_NG + (n - 7424);
    return -1;
}

struct TrItem { const float* W; bf16* WT; int ldw, ldt, k0, n0; bool map; };
__device__ __forceinline__ void p0_tr_load(const TrItem& I, float (&tv)[32], int lane) {
    const int nd = I.n0 + (lane & 31); const int sc = I.map ? win_cmap(nd) : nd;
#pragma unroll
    for (int i = 0; i < 32; ++i) { const int kk = 2 * i + (lane >> 5); tv[i] = (sc >= 0) ? I.W[(size_t)(I.k0 + kk) * I.ldw + sc] : 0.f; }
}
__device__ __forceinline__ void p0_tr_finish(const TrItem& I, const float (&tv)[32], LAS float* scr, int lane) {
#pragma unroll
    for (int i = 0; i < 32; ++i) { const int kk = 2 * i + (lane >> 5); scr[kk * 33 + (lane & 31)] = tv[i]; }
    LDS_WAIT(); asm volatile("" ::: "memory");
    const int c = lane & 7;
#pragma unroll
    for (int j = 0; j < 4; ++j) { const int n = (lane >> 3) + 8 * j; const LAS float* s = scr + (8 * c) * 33 + n;
        v4u o; o.x = pk2(s[0 * 33], s[1 * 33]); o.y = pk2(s[2 * 33], s[3 * 33]); o.z = pk2(s[4 * 33], s[5 * 33]); o.w = pk2(s[6 * 33], s[7 * 33]);
        *(v4u*)(I.WT + (size_t)(I.n0 + n) * I.ldt + I.k0 + 8 * c) = o; }
    LDS_WAIT(); asm volatile("" ::: "memory");
}
template <bool MAP> __device__ __forceinline__ void p0_tr_item(const float* W, int ldw, bf16* WT, int ldt, int k0, int n0, LAS float* scr, int lane) {
    TrItem I{W, WT, ldw, ldt, k0, n0, MAP}; float tv[32]; p0_tr_load(I, tv, lane); p0_tr_finish(I, tv, scr, lane);
}
template <bool MAP> __device__ __forceinline__ void p0_tr_item2(const float* W, int ldw, bf16* WT, int ldt, int k0, int n0, LAS float* scr, int lane) {
    TrItem I0{W, WT, ldw, ldt, k0, n0, MAP}, I1{W, WT, ldw, ldt, k0, n0 + 32, MAP}; float t0[32], t1[32];
    p0_tr_load(I0, t0, lane); p0_tr_load(I1, t1, lane); p0_tr_finish(I0, t0, scr, lane); p0_tr_finish(I1, t1, scr, lane);
}
__device__ __forceinline__ void sincos_acc(float ang, float& s, float& c) {
    const double a = (double)ang; const double kq = rint(a * 0.63661977236758134308); const double r = fma(-kq, 1.57079632679489661923, a);
    const double r2 = r * r;
    const double sp = r * (1.0 + r2 * (-1.6666666666666666e-1 + r2 * (8.3333333333333332e-3 + r2 * (-1.9841269841269841e-4 + r2 * (2.7557319223985893e-6 + r2 * (-2.5052108385441720e-8))))));
    const double cp = 1.0 + r2 * (-0.5 + r2 * (4.1666666666666664e-2 + r2 * (-1.3888888888888889e-3 + r2 * (2.4801587301587302e-5 + r2 * (-2.7557319223985888e-7 + r2 * 2.0876756987868099e-9)))));
    const int q = ((int)kq) & 3;
    const double ss = (q == 0) ? sp : (q == 1) ? cp : (q == 2) ? -sp : -cp;
    const double cc = (q == 0) ? cp : (q == 1) ? -sp : (q == 2) ? -cp : sp;
    s = (float)ss; c = (float)cc;
}

__device__ __forceinline__ void p0_prologue(Frame& F) {
    const int gw = F.bid * NWAVES + F.wave, NGW = F.G * NWAVES, lane = F.lane;
    LAS float* scr = (LAS float*)(F.lds + F.wave * 16384);
    {
        constexpr int I_IN = 16 * 240, I_BR = 8 * 32, I_OUT = 16 * 32, I_UP = 16 * 176, I_DN = 44 * 32, I_L = I_IN + 3 * I_BR + I_OUT + I_UP + I_DN;
        for (int it = gw; it < 2 * I_L; it += NGW) {
            const int l = it / I_L; int r = it % I_L;
            if (r < I_IN) { p0_tr_item<true>(FIN(I_WIN) + (size_t)l * DM * D_IN, D_IN, WSP(bf16, WS_WIN) + (size_t)l * NIN * DM, DM, 64 * (r / 240), 32 * (r % 240), scr, lane); continue; } r -= I_IN;
            if (r < 3 * I_BR) { const int w = r / I_BR, q = r % I_BR; const float* src = FIN(w == 0 ? I_WBRA : (w == 1 ? I_WBRB : I_WBRC)) + (size_t)l * 512 * 1024;
                p0_tr_item<false>(src, 1024, WSP(bf16, WS_WBR) + (size_t)(l * 3 + w) * 1024 * 512, 512, 64 * (q / 32), 32 * (q % 32), scr, lane); continue; } r -= 3 * I_BR;
            if (r < I_OUT) { p0_tr_item<false>(FIN(I_WOUT) + (size_t)l * 1024 * 1024, 1024, WSP(bf16, WS_WOUT) + (size_t)l * 1024 * 1024, 1024, 64 * (r / 32), 32 * (r % 32), scr, lane); continue; } r -= I_OUT;
            if (r < I_UP) { p0_tr_item<false>(FIN(I_WUP) + (size_t)l * DM * NUP, NUP, WSP(bf16, WS_WUP) + (size_t)l * NUP * DM, DM, 64 * (r / 176), 32 * (r % 176), scr, lane); continue; } r -= I_UP;
            p0_tr_item<false>(FIN(I_WDN) + (size_t)l * DFF * DM, DM, WSP(bf16, WS_WDN) + (size_t)l * DM * DFF, DFF, 64 * (r / 32), 32 * (r % 32), scr, lane);
        }
    }
    {
        constexpr int NI_W1 = 8 * 16 * 4, NI_W2 = 4 * 2 * 2, NI_RG = 32 * 2;
        for (int it = gw; it < NI_W1 + NI_W2 + NI_RG; it += NGW) {
            int r = it;
            if (r < NI_W1) { const int m = r / 64, q = r % 64, lk = m >> 1, half = m & 1;
                p0_tr_item<false>(FIN(I_W1) + ((size_t)lk * 32 + half * 16) * 64 * 128, 128, WSP(bf16, WS_SMALLW + SW_W1T) + ((size_t)lk * 256 + half * 128) * 1024, 1024, 64 * (q / 4), 32 * (q % 4), scr, lane); continue; } r -= NI_W1;
            if (r < NI_W2) { const int lk = r / 4, q = r % 4;
                p0_tr_item<false>(FIN(I_W2) + (size_t)lk * 128 * 64, 64, WSP(bf16, WS_SMALLW + SW_W2T) + (size_t)lk * 64 * 128, 128, 64 * (q / 2), 32 * (q % 2), scr, lane); continue; } r -= NI_W2;
            { const int m = r / 2, q = r % 2, l = m >> 4, which = (m >> 3) & 1, blk = m & 7;
                p0_tr_item<false>(FIN(which ? I_RWX : I_RWA) + ((size_t)l * 8 + blk) * 4096, 64, WSP(bf16, WS_SMALLW + SW_WAT) + (size_t)m * 4096, 64, 0, 32 * q, scr, lane); }
        }
    }
    for (int it = gw; it < 64; it += NGW) {
        const int lk = it >> 4, h0 = (it & 15) * 8; const float* pe = FIN(I_PE) + (size_t)lk * 2048; const float* w1 = FIN(I_W1) + (size_t)lk * 2048 * 128 + h0;
        f32x4 a0 = (f32x4){0.f, 0.f, 0.f, 0.f}, a1 = a0;
#pragma unroll 8
        for (int i = lane; i < 2048; i += 64) { const float p = pe[i]; a0 += *(const f32x4*)(w1 + (size_t)i * 128) * p; a1 += *(const f32x4*)(w1 + (size_t)i * 128 + 4) * p; }
#pragma unroll
        for (int x = 0; x < 4; ++x) { a0[x] = wave_sum(a0[x]); a1[x] = wave_sum(a1[x]); }
        if (lane == 0) { float* cb = WSP(float, WS_SMALLW + SW_CB) + lk * 128 + h0; const float* b1 = FIN(I_B1) + lk * 128 + h0;
#pragma unroll
            for (int x = 0; x < 4; ++x) { cb[x] = a0[x] + b1[x]; cb[4 + x] = a1[x] + b1[4 + x]; } }
    }
    for (int i = F.bid * NTHR + F.tid; i < 1024; i += F.G * NTHR) { const float lam = FIN(I_LAM)[i]; WSP(float, WS_SMALLW + SW_SP)[i] = log1pf(expf(-lam)); }
    for (int i = F.bid * NTHR + F.tid; i < 2 * SB * 2 * DFF; i += F.G * NTHR) WSP(bf16, WS_SFB)[i] = (bf16)(pk2(FIN(I_SFFN)[i], 0.f) & 0xffffu);
    for (int i = F.bid * NTHR + F.tid; i < 4104 * 64; i += F.G * NTHR) {
        const int pi = i >> 6, fi = i & 63; const float pos = (float)(pi < PT ? pi : PAST + (pi - PT));
        const float freq = (float)pow(10000.0, -(double)fi / 64.0); const float ang = pos * freq; float s, c; sincos_acc(ang, s, c);
        WSP(float, WS_ROT)[i] = c; WSP(float, WS_ROT)[4104 * 64 + i] = s;
    }
    {
        LAS float* SC = (LAS float*)(F.lds + 0);
        LAS float* RED = (LAS float*)(F.lds + 36864);
        for (int u = F.bid; u < 2 * 96; u += F.G) {
            const int l = u / 96, cg = u % 96; float acc[36];
#pragma unroll
            for (int b = 0; b < 36; ++b) acc[b] = 0.f;
#pragma unroll 1
            for (int kq = 0; kq < 4; ++kq) { const int kh = (kq + u) & 3;
                __syncthreads();
                {   float cv[18];
                    const float* cpp = FIN(I_CP); const float* csp = FIN(I_CS);
#pragma unroll
                    for (int it = 0; it < 18; ++it) { const int i = F.tid + NTHR * it, bb = i >> 8, d = i & 255;
                        cv[it] = (bb < 4) ? cpp[bb * DM + kh * 256 + d] : csp[(bb - 4) * DM + kh * 256 + d]; }
#pragma unroll
                    for (int it = 0; it < 18; ++it) { const int i = F.tid + NTHR * it, bb = i >> 8, d = i & 255; SC[d * 36 + bb] = siluf_(cv[it]); }
                }
                __syncthreads();
                const float* wp = FIN(I_WADA) + ((size_t)l * DM + kh * 256 + F.wave * 32) * 6144 + cg * 64 + lane;
                {
                    float wv[32];
#pragma unroll
                    for (int k = 0; k < 32; ++k) wv[k] = wp[(size_t)k * 6144];
                    const LAS f32x4* scb = (const LAS f32x4*)(SC + (F.wave * 32) * 36);
                    f32x4 sa[9], sb[9];
#pragma unroll
                    for (int g = 0; g < 9; ++g) sa[g] = scb[g];
#pragma unroll
                    for (int k = 0; k < 32; k += 2) {
#pragma unroll
                        for (int g = 0; g < 9; ++g) sb[g] = scb[(k + 1) * 9 + g];
#pragma unroll
                        for (int g = 0; g < 9; ++g) { acc[4 * g + 0] += wv[k] * sa[g][0]; acc[4 * g + 1] += wv[k] * sa[g][1]; acc[4 * g + 2] += wv[k] * sa[g][2]; acc[4 * g + 3] += wv[k] * sa[g][3]; }
                        if (k + 2 < 32) {
#pragma unroll
                            for (int g = 0; g < 9; ++g) sa[g] = scb[(k + 2) * 9 + g]; }
#pragma unroll
                        for (int g = 0; g < 9; ++g) { acc[4 * g + 0] += wv[k + 1] * sb[g][0]; acc[4 * g + 1] += wv[k + 1] * sb[g][1]; acc[4 * g + 2] += wv[k + 1] * sb[g][2]; acc[4 * g + 3] += wv[k + 1] * sb[g][3]; }
                    }
                }
            }
#pragma unroll
            for (int b = 0; b < 36; ++b) RED[(F.wave * 36 + b) * 64 + lane] = acc[b];
            __syncthreads();
            for (int o = F.tid; o < 36 * 64; o += NTHR) { const int b = o >> 6, col = o & 63; float sm = FIN(I_BADA)[l * 6144 + cg * 64 + col];
#pragma unroll
                for (int w = 0; w < 8; ++w) sm += RED[(w * 36 + b) * 64 + col];
                WSP(float, WS_MOD)[((size_t)l * 36 + b) * 6144 + cg * 64 + col] = sm; }
        }
        __syncthreads();
    }
    {   constexpr size_t NV4 = (size_t)2 * SB * 504 * 64; const size_t stride = (size_t)F.G * NTHR;
        for (size_t i0 = (size_t)F.bid * NTHR + F.tid; i0 < NV4; i0 += 8 * stride) {
            f32x4 v[8];
#pragma unroll
            for (int k = 0; k < 8; ++k) { const size_t i = i0 + k * stride; if (i < NV4) { const size_t seq = i / (504 * 64), r = i % (504 * 64); v[k] = __builtin_nontemporal_load((const f32x4*)(FIN(I_CWIN) + (seq * 512 + 8) * 256 + r * 4)); } }
#pragma unroll
            for (int k = 0; k < 8; ++k) { const size_t i = i0 + k * stride; if (i < NV4) { const size_t seq = i / (504 * 64), r = i % (504 * 64); *(f32x4*)(F.out + OUT_WIN_S + seq * 512 * 256 + r * 4) = v[k]; } }
        }
    }
}

__device__ __forceinline__ f32x4 ld4_bf(const bf16* p) { const v2u w = *(const v2u*)p; return (f32x4){bf_lo(w.x), bf_hi(w.x), bf_lo(w.y), bf_hi(w.y)}; }
__device__ __forceinline__ void norm_phase(Frame& F, int l, int which) {
    const int gw = F.bid * NWAVES + F.wave, NGW = F.G * NWAVES, lane = F.lane;
    const float* g = FIN(which ? I_N2G : I_N1G) + l * DM;
    constexpr int NR = 4;
    for (int row0 = gw * NR; row0 < MT; row0 += NGW * NR) {
        f32x4 v[NR][4]; float ss[NR];
#pragma unroll
        for (int rr = 0; rr < NR; ++rr) { const int row = row0 + rr;
            if (which == 0 && l == 0) { const float* xr = row < PM ? FIN(I_XP) + (size_t)row * DM : FIN(I_XS) + (size_t)(row - PM) * DM;
#pragma unroll
                for (int j = 0; j < 4; ++j) v[rr][j] = *(const f32x4*)(xr + lane * 4 + 256 * j); }
            else { const bf16* xr = WSP(bf16, which ? WS_X1 : WS_X2) + (size_t)row * DM;
#pragma unroll
                for (int j = 0; j < 4; ++j) v[rr][j] = ld4_bf(xr + lane * 4 + 256 * j); } }
#pragma unroll
        for (int rr = 0; rr < NR; ++rr) { float a = 0.f;
#pragma unroll
            for (int j = 0; j < 4; ++j) a += (v[rr][j][0] * v[rr][j][0] + v[rr][j][1] * v[rr][j][1]) + (v[rr][j][2] * v[rr][j][2] + v[rr][j][3] * v[rr][j][3]);
            ss[rr] = a; }
#pragma unroll
        for (int o = 1; o < 64; o <<= 1) {
#pragma unroll
            for (int rr = 0; rr < NR; ++rr) ss[rr] += __shfl_xor(ss[rr], o); }
#pragma unroll
        for (int rr = 0; rr < NR; ++rr) { const int row = row0 + rr; const float rs = 1.0f / sqrtf(ss[rr] * (1.0f / DM) + EPS);
            const float* mod = WSP(float, WS_MOD) + ((size_t)l * 36 + row_bb(row)) * 6144 + (which ? 3072 : 0); bf16* o = WSP(bf16, WS_H) + (size_t)row * DM;
#pragma unroll
            for (int j = 0; j < 4; ++j) { const int c = lane * 4 + 256 * j; const f32x4 gg = *(const f32x4*)(g + c), sh = *(const f32x4*)(mod + c), sc = *(const f32x4*)(mod + 1024 + c);
                const f32x4 y = (v[rr][j] * rs) * gg * (sc + 1.0f) + sh; v2u w; w.x = pk2(y[0], y[1]); w.y = pk2(y[2], y[3]); *(v2u*)(o + c) = w; } }
    }
}
__device__ __forceinline__ void final_phase(Frame& F) {
    const int gw = F.bid * NWAVES + F.wave, NGW = F.G * NWAVES, lane = F.lane;
    const float* g = FIN(I_FNG);
    for (int row0 = gw * 4; row0 < MT; row0 += NGW * 4) {
        f32x4 v[4][4]; float ss[4];
#pragma unroll
        for (int rr = 0; rr < 4; ++rr) { const bf16* xr = WSP(bf16, WS_X2) + (size_t)(row0 + rr) * DM; float a = 0.f;
#pragma unroll
            for (int j = 0; j < 4; ++j) { v[rr][j] = ld4_bf(xr + lane * 4 + 256 * j); a += (v[rr][j][0] * v[rr][j][0] + v[rr][j][1] * v[rr][j][1]) + (v[rr][j][2] * v[rr][j][2] + v[rr][j][3] * v[rr][j][3]); }
            ss[rr] = a; }
#pragma unroll
        for (int rr = 0; rr < 4; ++rr) { const float rs = 1.0f / sqrtf(wave_sum(ss[rr]) * (1.0f / DM) + EPS);
            float* o = F.out + OUT_Y + (size_t)(row0 + rr) * DM;
#pragma unroll
            for (int j = 0; j < 4; ++j) { const int c = lane * 4 + 256 * j; *(f32x4*)(o + c) = (v[rr][j] * rs) * *(const f32x4*)(g + c); } }
    }
}

#define EPI_LOOP_BEGIN \
    _Pragma("unroll") for (int ai = 0; ai < 2; ++ai) _Pragma("unroll") for (int m = 0; m < 4; ++m) { const int row = u.pm * 256 + ai * 128 + wr * 64 + m * 16 + fr; \
    _Pragma("unroll") for (int bj = 0; bj < 2; ++bj) { const int ct = bj * 128 + wc * 32 + 8 * fq; const f32x4 v0 = acc[ai][bj][m][0], v1 = acc[ai][bj][m][1];
#define EPI_LOOP_END } }

struct EpiWin {
    static constexpr bool PERM = true, AFTER_DRAIN = false;
    unsigned char* ws; float* out; int l;
    __device__ __forceinline__ void operator()(const f32x4 (&acc)[2][2][4][2], const pg8::Unit& u, int wr, int wc, int fr0, int fq0) const {
        int fr = fr0, fq = fq0; asm volatile("" : "+v"(fr), "+v"(fq));
        const int pn = u.pn;
        if (pn < 2) {
            bf16* QN = (bf16*)(ws + WS_QN);
            EPI_LOOP_BEGIN *(v4u*)(QN + (size_t)row * 512 + pn * 256 + ct) = pack8(v0 * QSCALE, v1 * QSCALE); EPI_LOOP_END
        } else if (pn < 5) {
            EPI_LOOP_BEGIN
                const int c = (pn - 2) * 256 + ct, j = c >> 7, k = (c >> 6) & 1, d = c & 63;
                const bool isp = row < PM; const int b = isp ? (row >> 12) : ((row - PM) >> 3), t = isp ? (row & (PT - 1)) : ((row - PM) & 7);
                if (j < 4) { float* o = out + (isp ? OUT_ROWS_P + ((size_t)l * PM + row) * 512 : OUT_ROWS_S + ((size_t)l * SM + (row - PM)) * 512) + c; *(f32x4*)o = v0; *(f32x4*)(o + 4) = v1; }
                else if (isp) { if (t >= PT - WINB) { float* o = out + OUT_WIN_P + (((size_t)l * PB + b) * WINB + (t - (PT - WINB))) * 256 + (c - 512); *(f32x4*)o = v0; *(f32x4*)(o + 4) = v1; } }
                else { float* o = out + OUT_WIN_S + (((size_t)l * SB + b) * WINB + (WINB - ST) + t) * 256 + (c - 512); *(f32x4*)o = v0; *(f32x4*)(o + 4) = v1; }
                const v4u w = pack8(v0, v1);
                if (isp) {
                    if (j < 2) *(v4u*)((bf16*)(ws + WS_ACMP) + ((size_t)(l * 2 + j) * CMP_ROWS_J + 32768 + (b * 2 + k) * 256) * 1024 + (size_t)t * 64 + d) = w;
                    else if (j & 1) {
                        const int tq = t & 31, s2 = tq >> 4, hh = (tq >> 2) & 1, ii = (tq & 3) + 4 * ((tq >> 3) & 1);
                        bf16* vt = (bf16*)(ws + WS_KVB) + (((size_t)(j - 2) * PB + b) * 2 + k) * PT * 64 + (size_t)(t >> 5) * 2048 + ((((d >> 5) * 2 + s2) * 2 + hh) * 32 + (d & 31)) * 8 + ii;
                        vt[0] = (bf16)(w.x & 0xffffu); vt[8] = (bf16)(w.x >> 16); vt[16] = (bf16)(w.y & 0xffffu); vt[24] = (bf16)(w.y >> 16);
                        vt[32] = (bf16)(w.z & 0xffffu); vt[40] = (bf16)(w.z >> 16); vt[48] = (bf16)(w.w & 0xffffu); vt[56] = (bf16)(w.w >> 16); }
                    else *(v4u*)((bf16*)(ws + WS_KVB) + (((size_t)(j - 2) * PB + b) * 2 + k) * PT * 64 + (size_t)(t >> 5) * 2048 + ((d >> 3) * 32 + (t & 31)) * 8) = w;
                } else if (j >= 2) *(v4u*)((bf16*)(ws + WS_KVS) + ((((size_t)(j - 2) * SB + b) * 2 + k) * ST + t) * 64 + d) = w;
            EPI_LOOP_END
        } else if (pn < 9) {
            const float* ROTC = (const float*)(ws + WS_ROT); const float* ROTS = ROTC + 4104 * 64;
#pragma unroll
            for (int ai = 0; ai < 2; ++ai) {
                f32x4 cs[4][2], sn[4][2];
#pragma unroll
                for (int m = 0; m < 4; ++m) { const int row = u.pm * 256 + ai * 128 + wr * 64 + m * 16 + fr; const int pi = row_pos(row);
#pragma unroll
                    for (int bj = 0; bj < 2; ++bj) { const int ct = bj * 128 + wc * 32 + 8 * fq; const int c = (pn - 5) * 256 + ct, d0 = (((c & 511) & 127) >> 3) * 4; cs[m][bj] = *(const f32x4*)(ROTC + pi * 64 + d0); sn[m][bj] = *(const f32x4*)(ROTS + pi * 64 + d0); } }
#pragma unroll
                for (int m = 0; m < 4; ++m) { const int row = u.pm * 256 + ai * 128 + wr * 64 + m * 16 + fr;
#pragma unroll
                    for (int bj = 0; bj < 2; ++bj) { const int ct = bj * 128 + wc * 32 + 8 * fq; const f32x4 v0 = acc[ai][bj][m][0], v1 = acc[ai][bj][m][1];
                        const int c = (pn - 5) * 256 + ct, isk = c >> 9, hc = c & 511, head = hc >> 7, d0 = ((hc & 127) >> 3) * 4;
                        const float sc = isk ? 0.08838834764831845f : 1.0f;
                        const f32x4 o1 = (v0 * cs[m][bj] - v1 * sn[m][bj]) * sc, o2 = (v0 * sn[m][bj] + v1 * cs[m][bj]) * sc;
                        bf16* o = (bf16*)(ws + WS_RQ) + (size_t)isk * MT * 512 + (size_t)row * 512 + head * 128 + d0;
                        v2u w1; w1.x = pk2(o1[0], o1[1]); w1.y = pk2(o1[2], o1[3]); *(v2u*)o = w1;
                        v2u w2; w2.x = pk2(o2[0], o2[1]); w2.y = pk2(o2[2], o2[3]); *(v2u*)(o + 64) = w2; } }
            }
        } else if (pn < 13) {
            bf16* RV = (bf16*)(ws + WS_RQ) + (size_t)2 * MT * 512;
            EPI_LOOP_BEGIN const int c = (pn - 9) * 256 + ct; *(v4u*)(RV + (size_t)(c >> 9) * MT * 512 + (size_t)row * 512 + (c & 511)) = pack8(v0, v1); EPI_LOOP_END
        } else if (pn < 15) {
            float* RX = (float*)(ws + WS_RX);
            EPI_LOOP_BEGIN
                const int c = (pn - 13) * 256 + ct; float* o = RX + (size_t)row * 512 + c; *(f32x4*)o = v0; *(f32x4*)(o + 4) = v1;
                if (row < PM) { const int t = row & (PT - 1); if (t >= PT - 3) { float* q = out + OUT_CV_P + (((size_t)l * PB + (row >> 12)) * 3 + (t - (PT - 3))) * 512 + c; *(f32x4*)q = v0; *(f32x4*)(q + 4) = v1; } }
                else { const int i = (row - PM) & 7; if (i >= ST - 3) { float* q = out + OUT_CV_S + (((size_t)l * SB + ((row - PM) >> 3)) * 3 + (i - (ST - 3))) * 512 + c; *(f32x4*)q = v0; *(f32x4*)(q + 4) = v1; } }
            EPI_LOOP_END
        } else if (pn < 17) {
            bf16* GG = (bf16*)(ws + WS_GG);
            EPI_LOOP_BEGIN const int c = (pn - 15) * 256 + ct;
                f32x4 a, b;
#pragma unroll
                for (int i = 0; i < 4; ++i) { a[i] = gelu_tanh(v0[i]); b[i] = gelu_tanh(v1[i]); }
                *(v4u*)(GG + (size_t)row * 512 + c) = pack8(a, b); EPI_LOOP_END
        } else if (pn < 29) {
            bf16* MG = (bf16*)(ws + WS_MGS);
            EPI_LOOP_BEGIN const int c = (pn - 17) * 256 + ct;
                f32x4 a, b;
#pragma unroll
                for (int i = 0; i < 4; ++i) { a[i] = sigmoidf_(v0[i]); b[i] = sigmoidf_(v1[i]); }
                *(v4u*)(MG + (size_t)row * 3072 + c) = pack8(a, b); EPI_LOOP_END
        } else {
            float* NG = (float*)(ws + WS_NG);
            EPI_LOOP_BEGIN if (ct < 24) { f32x4 a, b;
#pragma unroll
                for (int i = 0; i < 4; ++i) { a[i] = sigmoidf_(v0[i]); b[i] = sigmoidf_(v1[i]); }
                float* o = NG + (size_t)row * 24 + ct; *(f32x4*)o = a; *(f32x4*)(o + 4) = b; } EPI_LOOP_END
        }
    }
};

struct EpiLH {
    static constexpr bool PERM = true, AFTER_DRAIN = false;
    bf16* LH;
    __device__ __forceinline__ void operator()(const f32x4 (&acc)[2][2][4][2], const pg8::Unit& u, int wr, int wc, int fr0, int fq0) const {
        int fr = fr0, fq = fq0; asm volatile("" : "+v"(fr), "+v"(fq));
        EPI_LOOP_BEGIN *(v4u*)(LH + (size_t)row * 256 + ct) = pack8(v0, v1); EPI_LOOP_END
    }
};
struct CmpOrder {
    int G, c;
    __device__ bool next(int i, pg8::Unit& u) const { const int L = i * G + c; if (L >= CMP_ROWS / 256) return false; u.pm = L; u.pn = L / (CMP_ROWS_J / 256); return true; }
    __device__ __forceinline__ void a_ready(const pg8::Unit&) const {}
    __device__ __forceinline__ void done(const pg8::Unit&) const {}
};

template <int BR> struct EpiBr {
    static constexpr bool PERM = true, AFTER_DRAIN = false;
    unsigned char* ws;
    __device__ __forceinline__ void operator()(const f32x4 (&acc)[2][2][4][2], const pg8::Unit& u, int wr, int wc, int fr0, int fq0) const {
        int fr = fr0, fq = fq0; asm volatile("" : "+v"(fr), "+v"(fq));
        const bf16* MG = (const bf16*)(ws + WS_MGS); bf16* MR = (bf16*)(ws + WS_MRG);
        EPI_LOOP_BEGIN
            const int col = u.pn * 256 + ct; f32x4 g0, g1; unpack8(*(const v4u*)(MG + (size_t)row * 3072 + BR * 1024 + col), g0, g1);
            f32x4 r0 = v0 * g0, r1 = v1 * g1; bf16* o = MR + (size_t)row * DM + col;
            if (BR > 0) { f32x4 p0, p1; unpack8(*(const v4u*)o, p0, p1); r0 += p0; r1 += p1; }
            *(v4u*)o = pack8(r0, r1);
        EPI_LOOP_END
    }
};

struct BrOrder {
    pg8::StaticOrder S;
    __device__ bool next(int i, pg8::Unit& u) const { pg8::Unit t; if (!S.next(i / 3, t)) return false; const int br = i % 3; u.pm = br * (MT / 256) + t.pm; u.pn = br * 4 + t.pn; return true; }
    __device__ __forceinline__ void a_ready(const pg8::Unit&) const {}
    __device__ __forceinline__ void done(const pg8::Unit&) const {}
};
struct EpiBrAll {
    static constexpr bool PERM = true, AFTER_DRAIN = false;
    unsigned char* ws;
    __device__ __forceinline__ void operator()(const f32x4 (&acc)[2][2][4][2], const pg8::Unit& u0, int wr, int wc, int fr0, int fq0) const {
        int fr = fr0, fq = fq0; asm volatile("" : "+v"(fr), "+v"(fq));
        const int br = u0.pn >> 2; const pg8::Unit u{u0.pm - br * (MT / 256), u0.pn & 3};
        const bf16* MG = (const bf16*)(ws + WS_MGS) + br * 1024; bf16* MR = (bf16*)(ws + WS_MRG);
#pragma unroll
        for (int ai = 0; ai < 2; ++ai) {
            v4u gw[4][2], pw[4][2];
#pragma unroll
            for (int m = 0; m < 4; ++m) { const int row = u.pm * 256 + ai * 128 + wr * 64 + m * 16 + fr;
#pragma unroll
                for (int bj = 0; bj < 2; ++bj) { const int col = u.pn * 256 + bj * 128 + wc * 32 + 8 * fq; gw[m][bj] = *(const v4u*)(MG + (size_t)row * 3072 + col); if (br != 0) pw[m][bj] = *(const v4u*)(MR + (size_t)row * DM + col); } }
#pragma unroll
            for (int m = 0; m < 4; ++m) { const int row = u.pm * 256 + ai * 128 + wr * 64 + m * 16 + fr;
#pragma unroll
                for (int bj = 0; bj < 2; ++bj) { const int col = u.pn * 256 + bj * 128 + wc * 32 + 8 * fq; const f32x4 v0 = acc[ai][bj][m][0], v1 = acc[ai][bj][m][1];
                    f32x4 g0, g1; unpack8(gw[m][bj], g0, g1); f32x4 r0 = v0 * g0, r1 = v1 * g1;
                    if (br != 0) { f32x4 p0, p1; unpack8(pw[m][bj], p0, p1); r0 += p0; r1 += p1; }
                    *(v4u*)(MR + (size_t)row * DM + col) = pack8(r0, r1); } }
        }
    }
};

template <bool INF32> struct EpiRes {
    static constexpr bool PERM = true, AFTER_DRAIN = false;
    const void* xin_p; bf16* xout; const float* mod; int gofs;
    __device__ __forceinline__ void operator()(const f32x4 (&acc)[2][2][4][2], const pg8::Unit& u, int wr, int wc, int fr0, int fq0) const {
        int fr = fr0, fq = fq0; asm volatile("" : "+v"(fr), "+v"(fq));
#pragma unroll
        for (int ai = 0; ai < 2; ++ai) {
            const float* gp = mod + (size_t)row_bb(u.pm * 256 + ai * 128) * 6144 + gofs + u.pn * 256 + wc * 32 + 8 * fq;
            f32x4 g[2][2];
#pragma unroll
            for (int bj = 0; bj < 2; ++bj) { g[bj][0] = *(const f32x4*)(gp + 128 * bj); g[bj][1] = *(const f32x4*)(gp + 128 * bj + 4); }
            if (INF32) {
#pragma unroll
                for (int mh = 0; mh < 2; ++mh) {
                    f32x4 xv[2][2][2];
#pragma unroll
                    for (int m2 = 0; m2 < 2; ++m2) { const int row = u.pm * 256 + ai * 128 + wr * 64 + (2 * mh + m2) * 16 + fr;
#pragma unroll
                        for (int bj = 0; bj < 2; ++bj) { const float* xi = (const float*)xin_p + (size_t)row * DM + u.pn * 256 + bj * 128 + wc * 32 + 8 * fq; xv[m2][bj][0] = *(const f32x4*)xi; xv[m2][bj][1] = *(const f32x4*)(xi + 4); } }
#pragma unroll
                    for (int m2 = 0; m2 < 2; ++m2) { const int m = 2 * mh + m2; const int row = u.pm * 256 + ai * 128 + wr * 64 + m * 16 + fr;
#pragma unroll
                        for (int bj = 0; bj < 2; ++bj) { const int col = u.pn * 256 + bj * 128 + wc * 32 + 8 * fq;
                            *(v4u*)(xout + (size_t)row * DM + col) = pack8(xv[m2][bj][0] + g[bj][0] * acc[ai][bj][m][0], xv[m2][bj][1] + g[bj][1] * acc[ai][bj][m][1]); } }
                }
            } else {
                v4u xw[4][2];
#pragma unroll
                for (int m = 0; m < 4; ++m) { const int row = u.pm * 256 + ai * 128 + wr * 64 + m * 16 + fr;
#pragma unroll
                    for (int bj = 0; bj < 2; ++bj) xw[m][bj] = *(const v4u*)((const bf16*)xin_p + (size_t)row * DM + u.pn * 256 + bj * 128 + wc * 32 + 8 * fq); }
#pragma unroll
                for (int m = 0; m < 4; ++m) { const int row = u.pm * 256 + ai * 128 + wr * 64 + m * 16 + fr;
#pragma unroll
                    for (int bj = 0; bj < 2; ++bj) { const int col = u.pn * 256 + bj * 128 + wc * 32 + 8 * fq; f32x4 x0, x1; unpack8(xw[m][bj], x0, x1);
                        *(v4u*)(xout + (size_t)row * DM + col) = pack8(x0 + g[bj][0] * acc[ai][bj][m][0], x1 + g[bj][1] * acc[ai][bj][m][1]); } }
            }
        }
    }
};

template <int CTRL> __device__ __forceinline__ v4u dpp4(const v4u old, const v4u src) {
    v4u r; r.x = (unsigned)__builtin_amdgcn_update_dpp((int)old.x, (int)src.x, CTRL, 0xf, 0xf, false); r.y = (unsigned)__builtin_amdgcn_update_dpp((int)old.y, (int)src.y, CTRL, 0xf, 0xf, false);
    r.z = (unsigned)__builtin_amdgcn_update_dpp((int)old.z, (int)src.z, CTRL, 0xf, 0xf, false); r.w = (unsigned)__builtin_amdgcn_update_dpp((int)old.w, (int)src.w, CTRL, 0xf, 0xf, false); return r; }
struct UpOrder {
    pg8::StaticOrder S;
    __device__ bool next(int i, pg8::Unit& u) const { pg8::Unit t; if (!S.next(i >> 1, t)) return false; u.pm = t.pm; u.pn = t.pn + 11 * (i & 1); return true; }
    __device__ __forceinline__ void a_ready(const pg8::Unit&) const {}
    __device__ __forceinline__ void done(const pg8::Unit&) const {}
};
struct EpiUp {
    static constexpr bool PERM = true, AFTER_DRAIN = false;
    unsigned char* ws; float* out; int l; const float* cw; const float* cbi; const bf16* sfb;
    __device__ __forceinline__ void operator()(const f32x4 (&acc)[2][2][4][2], const pg8::Unit& u, int wr, int wc, int fr0, int fq0) const {
        int fr = fr0, fq = fq0; asm volatile("" : "+v"(fr), "+v"(fq));
        bf16* GP = (bf16*)(ws + WS_GP); bf16* VAL = GP + (size_t)MT * DFF; bf16* ACT = GP + (size_t)2 * MT * DFF;
        if (u.pn < 11) {
            EPI_LOOP_BEGIN const int c = u.pn * 256 + ct; *(v4u*)(GP + (size_t)row * DFF + c) = pack8(v0, v1);
                if (row < PM) { const int t = row & (PT - 1); if (t >= PT - 2) { float* q = out + OUT_FC_P + (((size_t)l * PB + (row >> 12)) * 2 + (t - (PT - 2))) * DFF + c; *(f32x4*)q = v0; *(f32x4*)(q + 4) = v1; } }
                else { const int i = (row - PM) & 7; if (i >= ST - 2) { float* q = out + OUT_FC_S + (((size_t)l * SB + ((row - PM) >> 3)) * 2 + (i - (ST - 2))) * DFF + c; *(f32x4*)q = v0; *(f32x4*)(q + 4) = v1; } }
            EPI_LOOP_END
        } else if (u.pm * 256 >= PM) {
#pragma unroll
            for (int bj = 0; bj < 2; ++bj) { const int c = (u.pn - 11) * 256 + bj * 128 + wc * 32 + 8 * fq;
                const f32x4 w0a = *(const f32x4*)(cw + c), w0b = *(const f32x4*)(cw + c + 4), w1a = *(const f32x4*)(cw + DFF + c), w1b = *(const f32x4*)(cw + DFF + c + 4);
                const f32x4 w2a = *(const f32x4*)(cw + 2 * DFF + c), w2b = *(const f32x4*)(cw + 2 * DFF + c + 4), ba = *(const f32x4*)(cbi + c), bb = *(const f32x4*)(cbi + c + 4);
#pragma unroll
                for (int ai = 0; ai < 2; ++ai)
#pragma unroll
                  for (int mh = 0; mh < 2; ++mh) {
                    v4u g0[2], g1[2], g2[2];
#pragma unroll
                    for (int m2 = 0; m2 < 2; ++m2) { const int row = u.pm * 256 + ai * 128 + wr * 64 + (2 * mh + m2) * 16 + fr; const bf16* gp = GP + (size_t)row * DFF + c;
                        const bf16* sb = sfb + (size_t)((row - PM) >> 3) * 2 * DFF + c; const int i = (row - PM) & 7;
                        const bf16* q1 = (i < 1) ? sb + DFF : gp - DFF; const bf16* q2 = (i < 2) ? (i == 1 ? sb + DFF : sb) : gp - 2 * DFF;
                        g0[m2] = *(const v4u*)gp; g1[m2] = *(const v4u*)q1; g2[m2] = *(const v4u*)q2; }
#pragma unroll
                    for (int m2 = 0; m2 < 2; ++m2) { const int m = 2 * mh + m2; const int row = u.pm * 256 + ai * 128 + wr * 64 + m * 16 + fr; const int t = row & (PT - 1);
                        const f32x4 v0 = acc[ai][bj][m][0], v1 = acc[ai][bj][m][1];
                        if (false) { *(v4u*)(VAL + (size_t)row * DFF + c) = pack8(v0, v1); }
                        else { f32x4 xa, xb, pa, pb, qa, qb; unpack8(g0[m2], xa, xb); unpack8(g1[m2], pa, pb); unpack8(g2[m2], qa, qb);
                            f32x4 ya = ba + w0a * qa + w1a * pa + w2a * xa, yb = bb + w0b * qb + w1b * pb + w2b * xb;
#pragma unroll
                            for (int i = 0; i < 4; ++i) { ya[i] = siluf_(ya[i]) * v0[i]; yb[i] = siluf_(yb[i]) * v1[i]; }
                            *(v4u*)(ACT + (size_t)row * DFF + c) = pack8(ya, yb); } }
                  }
            }
                } else {
#pragma unroll
            for (int bj = 0; bj < 2; ++bj) { const int c = (u.pn - 11) * 256 + bj * 128 + wc * 32 + 8 * fq;
                const f32x4 w0a = *(const f32x4*)(cw + c), w0b = *(const f32x4*)(cw + c + 4), w1a = *(const f32x4*)(cw + DFF + c), w1b = *(const f32x4*)(cw + DFF + c + 4);
                const f32x4 w2a = *(const f32x4*)(cw + 2 * DFF + c), w2b = *(const f32x4*)(cw + 2 * DFF + c + 4), ba = *(const f32x4*)(cbi + c), bb = *(const f32x4*)(cbi + c + 4);
#pragma unroll
                for (int ai = 0; ai < 2; ++ai) {
                    v4u g[4], gm;
                    const int rowb = u.pm * 256 + ai * 128 + wr * 64 + fr;
#pragma unroll
                    for (int m = 0; m < 4; ++m) g[m] = *(const v4u*)(GP + (size_t)(rowb + m * 16) * DFF + c);
                    gm = (fr >= 14 && ((rowb - fr) & (PT - 1)) != 0) ? *(const v4u*)(GP + (size_t)(rowb - 16) * DFF + c) : (v4u){0u, 0u, 0u, 0u};
#pragma unroll
                    for (int m = 0; m < 4; ++m) { const int row = rowb + m * 16; const int t = row & (PT - 1);
                        const v4u pv = (m == 0) ? gm : g[m - 1];
                        const v4u t1 = dpp4<0x111>(dpp4<0x121>(pv, pv), g[m]), t2 = dpp4<0x112>(dpp4<0x122>(pv, pv), g[m]);
                        const f32x4 v0 = acc[ai][bj][m][0], v1 = acc[ai][bj][m][1];
                        if ((t & 255) < 2 && t >= 2) { *(v4u*)(VAL + (size_t)row * DFF + c) = pack8(v0, v1); }
                        else { f32x4 xa, xb, pa, pb, qa, qb; unpack8(g[m], xa, xb); unpack8(t1, pa, pb); unpack8(t2, qa, qb);
                            f32x4 ya = ba + w0a * qa + w1a * pa + w2a * xa, yb = bb + w0b * qb + w1b * pb + w2b * xb;
#pragma unroll
                            for (int i = 0; i < 4; ++i) { ya[i] = siluf_(ya[i]) * v0[i]; yb[i] = siluf_(yb[i]) * v1[i]; }
                            *(v4u*)(ACT + (size_t)row * DFF + c) = pack8(ya, yb); } }
                }
            }
        }
    }
};

__device__ __forceinline__ f32x16 mfma32(bf16x8 a, bf16x8 b, f32x16 c) { return __builtin_amdgcn_mfma_f32_32x32x16_bf16(a, b, c, 0, 0, 0); }
__device__ __forceinline__ f32x4 mfma16(bf16x8 a, bf16x8 b, f32x4 c) { return __builtin_amdgcn_mfma_f32_16x16x32_bf16(a, b, c, 0, 0, 0); }
__device__ __forceinline__ float ret_log_g(int h) { return log1pf(-exp2f(-5.0f - (float)h)); }
__device__ __forceinline__ bf16x8 tr_frag(const LAS unsigned char* base, int rs_bytes, int rowA, int rowB, int colbase, int lane) {
    const int q = (lane & 15) >> 2, p = lane & 3;
    const LAS unsigned char* pa = base + (rowA + q) * rs_bytes + (colbase + 4 * p) * 2;
    const LAS unsigned char* pb = base + (rowB + q) * rs_bytes + (colbase + 4 * p) * 2;
    const s16x4 a = __builtin_bit_cast(s16x4, __builtin_amdgcn_ds_read_tr16_b64_v4i16((LAS s16x4*)pa));
    const s16x4 b = __builtin_bit_cast(s16x4, __builtin_amdgcn_ds_read_tr16_b64_v4i16((LAS s16x4*)pb));
    return (bf16x8){a[0], a[1], a[2], a[3], b[0], b[1], b[2], b[3]};
}
__device__ __forceinline__ bf16x8 cvt_frag(const f32x16& p, int s2) {
    u32x4 w; w.x = pk2(p[8 * s2 + 0], p[8 * s2 + 1]); w.y = pk2(p[8 * s2 + 2], p[8 * s2 + 3]); w.z = pk2(p[8 * s2 + 4], p[8 * s2 + 5]); w.w = pk2(p[8 * s2 + 6], p[8 * s2 + 7]);
    return __builtin_bit_cast(bf16x8, w);
}

__device__ __forceinline__ void cmp2_phase(Frame& F, int l) {
    const int gw = F.bid * NWAVES + F.wave, NGW = F.G * NWAVES, lane = F.lane, r = lane & 15, g = lane >> 4;
    const bf16* LH = WSP(bf16, WS_LH); bf16* CK = WSP(bf16, WS_CK);
    const int j = gw & 1, gwj = gw >> 1, NGJ = NGW >> 1;
    const bf16* W2T = WSP(bf16, WS_SMALLW + SW_W2T) + (size_t)(l * 2 + j) * 64 * 128; const float* CB = WSP(float, WS_SMALLW + SW_CB) + (l * 2 + j) * 128;
    bf16x8 wf[4][4];
#pragma unroll
    for (int ks = 0; ks < 4; ++ks)
#pragma unroll
        for (int ct = 0; ct < 4; ++ct) wf[ks][ct] = *(const bf16x8*)(W2T + (size_t)(16 * ct + r) * 128 + 32 * ks + 8 * g);
    for (int wu = gwj; wu < CMP_ROWS_J / 16; wu += NGJ) {
        const int rj0 = wu * 16, rj = rj0 + r; const size_t row = (size_t)j * CMP_ROWS_J + rj;
        const bool valid = (rj < 32768) ? ((rj & 511) < 511) : (((rj - 32768) & 255) < 255);
        v4u la[4], lb[4];
#pragma unroll
        for (int ks = 0; ks < 4; ++ks) { const int h0 = 32 * ks + 8 * g; la[ks] = *(const v4u*)(LH + row * 256 + h0); lb[ks] = *(const v4u*)(LH + (row + 1) * 256 + 128 + h0); }
        f32x4 acc[4];
#pragma unroll
        for (int ct = 0; ct < 4; ++ct) acc[ct] = (f32x4){0.f, 0.f, 0.f, 0.f};
#pragma unroll
        for (int ks = 0; ks < 4; ++ks) {
            const int h0 = 32 * ks + 8 * g; f32x4 a0, a1, b0, b1;
            unpack8(la[ks], a0, a1); unpack8(lb[ks], b0, b1);
            const f32x4 c0 = *(const f32x4*)(CB + h0), c1 = *(const f32x4*)(CB + h0 + 4);
            f32x4 x0 = a0 + b0 + c0, x1 = a1 + b1 + c1;
#pragma unroll
            for (int i = 0; i < 4; ++i) { x0[i] = gelu_tanh(x0[i]); x1[i] = gelu_tanh(x1[i]); }
            const bf16x8 hf = __builtin_bit_cast(bf16x8, pack8(x0, x1));
#pragma unroll
            for (int ct = 0; ct < 4; ++ct) acc[ct] = mfma16(wf[ks][ct], hf, acc[ct]);
        }
#pragma unroll
        for (int ct = 0; ct < 4; ++ct) { const f32x4 v = valid ? acc[ct] : (f32x4){0.f, 0.f, 0.f, 0.f}; v2u w; w.x = pk2(v[0], v[1]); w.y = pk2(v[2], v[3]);
            *(v2u*)(CK + row * 64 + 16 * ct + 4 * g) = w; }
    }
}

constexpr int CG_RS = 144, CG_BUF = 256 * CG_RS, CG_AW = 2 * CG_BUF, CG_AT = 32 * CG_RS;
static_assert(CG_AW + 2 * 4 * CG_AT <= RING_BYTES, "compress GEMM LDS map");
template <bool smp> __device__ __forceinline__ void cmp_gemm_unit(Frame& F, int l, int j, int grp, int n00) {
    const int tid = F.tid, lane = F.lane, w = F.wave, q = lane & 31, h_ = lane >> 5, rg = w >> 1, ch = w & 1;
    const float* rp[4]; const bf16* ab = nullptr;
    if (smp) { const int db = grp >> 1, k = grp & 1;
#pragma unroll
        for (int i = 0; i < 4; ++i) { const int tt0 = (n00 + 32 * rg + 16 * ch + 4 * i + (lane >> 4)) * 16; const int page = ((const int*)F.a->in[I_PT])[db * NPG + (tt0 >> 7)];
            rp[i] = FIN(I_CACHE) + (((((size_t)l * NPHYS + page) * PAGE + (tt0 & 127)) * 4 + j) * 2 + k) * 64 + (lane & 15) * 4; } }
    else {
        ab = WSP(bf16, WS_ACMP) + ((size_t)(l * 2 + j) * CMP_ROWS_J + 32768 + grp * 256 + n00 + 32 * rg + 16 * ch + (lane >> 3)) * 1024 + (lane & 7) * 8;
#pragma unroll
        for (int i = 0; i < 4; ++i) rp[i] = nullptr; }
    const bf16* Bg = WSP(bf16, WS_SMALLW + SW_W1T) + (size_t)(l * 2 + j) * 256 * 1024;
    f32x16 acc[4];
#pragma unroll
    for (int ct = 0; ct < 4; ++ct) acc[ct] = (f32x16){};
    const bf16* bsrc = Bg + (size_t)(tid >> 1) * 1024 + (tid & 1) * 32; LAS unsigned char* bdst = F.lds + (tid >> 1) * CG_RS + (tid & 1) * 64;
    v4u bst[2][4]; f32x4 an[4][4]; v4u anb[4][2];
    __syncthreads();
#pragma unroll
    for (int x = 0; x < 4; ++x) bst[0][x] = *(const v4u*)(bsrc + 8 * x);
#pragma unroll
    for (int x = 0; x < 4; ++x) bst[1][x] = *(const v4u*)(bsrc + 64 + 8 * x);
#pragma unroll
    for (int d = 0; d < 4; ++d) {
        if (smp) {
#pragma unroll
            for (int i = 0; i < 4; ++i) an[d][i] = __builtin_nontemporal_load((const f32x4*)(rp[i] + (size_t)d * 512)); }
        else {
#pragma unroll
            for (int i = 0; i < 2; ++i) anb[d][i] = *(const v4u*)(ab + (size_t)(8 * i) * 1024 + d * 64); } }
#pragma unroll
    for (int x = 0; x < 4; ++x) *(LAS v4u*)(bdst + x * 16) = bst[0][x];
#define CG_CHUNK(d, LAST_) { const int kc = kc4 + (d); \
            LAS unsigned char* At = F.lds + CG_AW + (((d) & 1) * 4 + rg) * CG_AT; \
            if (!(LAST_) || (d) < 2) {                                   \
                _Pragma("unroll") for (int x = 0; x < 4; ++x) bst[(d) & 1][x] = *(const v4u*)(bsrc + (kc + 2) * 64 + 8 * x); } \
            if (smp) { \
                _Pragma("unroll") for (int i = 0; i < 4; ++i) { v2u o; o.x = pk2(an[d][i][0], an[d][i][1]); o.y = pk2(an[d][i][2], an[d][i][3]); *(LAS v2u*)(At + (16 * ch + 4 * i + (lane >> 4)) * CG_RS + (lane & 15) * 8) = o; } \
                if (!(LAST_)) { _Pragma("unroll") for (int i = 0; i < 4; ++i) an[d][i] = __builtin_nontemporal_load((const f32x4*)(rp[i] + (size_t)(kc + 4) * 512)); } \
            } else { \
                _Pragma("unroll") for (int i = 0; i < 2; ++i) *(LAS v4u*)(At + (16 * ch + 8 * i + (lane >> 3)) * CG_RS + (lane & 7) * 16) = anb[d][i]; \
                if (!(LAST_)) { _Pragma("unroll") for (int i = 0; i < 2; ++i) anb[d][i] = *(const v4u*)(ab + (size_t)(8 * i) * 1024 + (kc + 4) * 64); } \
            } \
            __syncthreads();                                           \
            bf16x8 ac[4]; \
            _Pragma("unroll") for (int ks = 0; ks < 4; ++ks) ac[ks] = *(const LAS bf16x8*)(At + q * CG_RS + ks * 32 + 16 * h_); \
            const LAS unsigned char* bb = F.lds + ((d) & 1) * CG_BUF + (128 * ch + q) * CG_RS + 16 * h_; \
            _Pragma("unroll") for (int ks = 0; ks < 4; ++ks) \
                _Pragma("unroll") for (int ct = 0; ct < 4; ++ct) { const bf16x8 bf = *(const LAS bf16x8*)(bb + ct * 32 * CG_RS + ks * 32); acc[ct] = mfma32(bf, ac[ks], acc[ct]); } \
            if (!(LAST_) || (d) < 3) { _Pragma("unroll") for (int x = 0; x < 4; ++x) *(LAS v4u*)(bdst + (((d) + 1) & 1) * CG_BUF + x * 16) = bst[((d) + 1) & 1][x]; } }
    int kc4 = 0;
#pragma unroll 1
    for (; kc4 < 12; kc4 += 4) { CG_CHUNK(0, false) CG_CHUNK(1, false) CG_CHUNK(2, false) CG_CHUNK(3, false) }
    { CG_CHUNK(0, true) CG_CHUNK(1, true) CG_CHUNK(2, true) CG_CHUNK(3, true) }
#undef CG_CHUNK
    bf16* LH = WSP(bf16, WS_LH) + ((size_t)j * CMP_ROWS_J + (smp ? grp * 512 : 32768 + grp * 256) + n00 + 32 * rg + q) * 256 + 128 * ch;
#pragma unroll
    for (int ct = 0; ct < 4; ++ct)
#pragma unroll
        for (int r4 = 0; r4 < 4; ++r4) { v2u o; o.x = pk2(acc[ct][4 * r4 + 0], acc[ct][4 * r4 + 1]); o.y = pk2(acc[ct][4 * r4 + 2], acc[ct][4 * r4 + 3]); *(v2u*)(LH + ct * 32 + 8 * r4 + 4 * h_) = o; }
}

constexpr int RS_KV = 272;
__device__ __forceinline__ void ret_local_unit(Frame& F, int unit) {
    const int bh = unit >> 5, c = unit & 31, b = bh >> 2, h = bh & 3, lane = F.lane, w = F.wave;
    const float lg = ret_log_g(h);
    LAS unsigned char* KS = F.lds; LAS unsigned char* VS = F.lds + 128 * RS_KV;
    const bf16* RK = WSP(bf16, WS_RQ) + (size_t)MT * 512; const bf16* RV = WSP(bf16, WS_RQ) + (size_t)2 * MT * 512;
    __syncthreads();
#pragma unroll
    for (int i = 0; i < 4; ++i) { const int p = F.tid + NTHR * i, j = p >> 4, ch = p & 15; const size_t go = (size_t)(b * PT + 128 * c + j) * 512 + h * 128 + ch * 8;
        f32x4 k0, k1; unpack8(*(const v4u*)(RK + go), k0, k1); const float kw = fexp((float)(127 - j) * lg);
        *(LAS v4u*)(KS + j * RS_KV + ch * 16) = pack8(k0 * kw, k1 * kw);
        *(LAS v4u*)(VS + j * RS_KV + ch * 16) = *(const v4u*)(RV + go); }
    __syncthreads();
    const int et = w >> 1, dt0 = 2 * (w & 1), h_ = lane >> 5, blk = (lane >> 4) & 1;
    f32x16 acc[2]; acc[0] = (f32x16){}; acc[1] = (f32x16){};
#pragma unroll
    for (int ks = 0; ks < 8; ++ks) {
        const int rA = 16 * ks + 8 * h_;
        const bf16x8 af = tr_frag(VS, RS_KV, rA, rA + 4, 32 * et + 16 * blk, lane);
#pragma unroll
        for (int dd = 0; dd < 2; ++dd) { const bf16x8 bfr = tr_frag(KS, RS_KV, rA, rA + 4, 32 * (dt0 + dd) + 16 * blk, lane); acc[dd] = mfma32(af, bfr, acc[dd]); }
    }
    bf16* LT = WSP(bf16, WS_LT) + ((size_t)bh * 32 + c) * 16384;
#pragma unroll
    for (int dd = 0; dd < 2; ++dd)
#pragma unroll
        for (int r = 0; r < 16; ++r) { const int e = 32 * et + (r & 3) + 8 * (r >> 2) + 4 * h_; LT[e * 128 + 32 * (dt0 + dd) + (lane & 31)] = (bf16)(pk2(acc[dd][r], 0.f) & 0xffffu); }
}
__device__ __forceinline__ void ret_scan_phase(Frame& F, int l) {
    const bf16* LT = WSP(bf16, WS_LT); bf16* SPT = WSP(bf16, WS_SPT);
    for (int idx = F.bid * NTHR + F.tid; idx < 16 * 16384; idx += F.G * NTHR) {
        const int bh = idx >> 14, ed = idx & 16383, e = ed >> 7, d = ed & 127, h = bh & 3; const float g128 = fexp(128.0f * ret_log_g(h));
        float S = 0.f;
        for (int c = 0; c < 32; ++c) { const size_t o = ((size_t)bh * 32 + c) * 16384 + ed; SPT[o] = (bf16)(pk2(S, 0.f) & 0xffffu); S = S * g128 + bf1(LT[o]); }
        F.out[OUT_RET_P + ((size_t)l * 16 + bh) * 16384 + d * 128 + e] = S;
    }
}
__device__ __forceinline__ void ret_out_unit(Frame& F, int l, int unit) {
    const int bh = unit >> 5, c = unit & 31, b = bh >> 2, h = bh & 3, lane = F.lane, w = F.wave, tid = F.tid;
    const float lg = ret_log_g(h);
    LAS unsigned char* KS = F.lds; LAS unsigned char* VS = F.lds + 128 * RS_KV; LAS float* OT = (LAS float*)F.lds; LAS float* STAT = (LAS float*)(F.lds + 2 * 128 * RS_KV);
    const bf16* RQ = WSP(bf16, WS_RQ); const bf16* RK = RQ + (size_t)MT * 512; const bf16* RV = RQ + (size_t)2 * MT * 512; const bf16* RG = RQ + (size_t)3 * MT * 512;
    const size_t row0 = (size_t)b * PT + 128 * c;
    __syncthreads();
#pragma unroll
    for (int i = 0; i < 4; ++i) { const int p = tid + NTHR * i, j = p >> 4, ch = p & 15; const size_t go = (row0 + j) * 512 + h * 128 + ch * 8;
        *(LAS v4u*)(KS + j * RS_KV + ch * 16) = *(const v4u*)(RK + go); *(LAS v4u*)(VS + j * RS_KV + ch * 16) = *(const v4u*)(RV + go); }
    const int it = w & 3, eh = w >> 2, h_ = lane >> 5, blk = (lane >> 4) & 1, il = 32 * it + (lane & 31);
    bf16x8 qf[8];
#pragma unroll
    for (int ks = 0; ks < 8; ++ks) qf[ks] = *(const bf16x8*)(RQ + (row0 + il) * 512 + h * 128 + 16 * ks + 8 * h_);
    f32x16 acc[2]; acc[0] = (f32x16){}; acc[1] = (f32x16){};
    const bf16* SP = WSP(bf16, WS_SPT) + ((size_t)bh * 32 + c) * 16384;
#pragma unroll
    for (int kb4 = 0; kb4 < 8; kb4 += 4) {
        bf16x8 af[4][2];
#pragma unroll
        for (int ks = 0; ks < 4; ++ks)
#pragma unroll
            for (int e2 = 0; e2 < 2; ++e2) af[ks][e2] = *(const bf16x8*)(SP + (size_t)(32 * (2 * eh + e2) + (lane & 31)) * 128 + 16 * (kb4 + ks) + 8 * h_);
#pragma unroll
        for (int ks = 0; ks < 4; ++ks)
#pragma unroll
            for (int e2 = 0; e2 < 2; ++e2) acc[e2] = mfma32(af[ks][e2], qf[kb4 + ks], acc[e2]);
    }
    { const float cr = fexp((float)(il + 1) * lg); acc[0] *= cr; acc[1] *= cr; }
    __syncthreads();
    for (int jt = 0; jt <= it; ++jt) {
        f32x16 s = (f32x16){};
#pragma unroll
        for (int ks = 0; ks < 8; ++ks) { const bf16x8 kf = *(const LAS bf16x8*)(KS + (32 * jt + (lane & 31)) * RS_KV + (16 * ks + 8 * h_) * 2); s = mfma32(kf, qf[ks], s); }
#pragma unroll
        for (int r = 0; r < 16; ++r) { const int j = 32 * jt + (r & 3) + 8 * (r >> 2) + 4 * h_; const int df = il - j; s[r] = (df >= 0) ? s[r] * fexp((float)df * lg) : 0.f; }
#pragma unroll
        for (int s2 = 0; s2 < 2; ++s2) { const bf16x8 pf = cvt_frag(s, s2); const int rA = 32 * jt + 16 * s2 + 4 * h_;
#pragma unroll
            for (int e2 = 0; e2 < 2; ++e2) { const bf16x8 vf = tr_frag(VS, RS_KV, rA, rA + 8, 32 * (2 * eh + e2) + 16 * blk, lane); acc[e2] = mfma32(vf, pf, acc[e2]); } }
    }
    float s1 = 0.f, s2 = 0.f;
#pragma unroll
    for (int e2 = 0; e2 < 2; ++e2)
#pragma unroll
        for (int r = 0; r < 16; ++r) { const float v = acc[e2][r]; s1 += v; s2 += v * v; }
    s1 += __shfl_xor(s1, 32); s2 += __shfl_xor(s2, 32);
    if (lane < 32) { STAT[(w * 32 + lane) * 2] = s1; STAT[(w * 32 + lane) * 2 + 1] = s2; }
    __syncthreads();
    { const int pw = w ^ 4; s1 += STAT[(pw * 32 + (lane & 31)) * 2]; s2 += STAT[(pw * 32 + (lane & 31)) * 2 + 1]; }
    const float mean = s1 * (1.0f / 128.0f), var = fmaxf(s2 * (1.0f / 128.0f) - mean * mean, 0.f), rstd = 1.0f / sqrtf(var + EPS);
#pragma unroll
    for (int e2 = 0; e2 < 2; ++e2)
#pragma unroll
        for (int r4 = 0; r4 < 4; ++r4) { const int e = 32 * (2 * eh + e2) + 8 * r4 + 4 * h_;
            f32x4 v; v[0] = (acc[e2][4 * r4 + 0] - mean) * rstd; v[1] = (acc[e2][4 * r4 + 1] - mean) * rstd; v[2] = (acc[e2][4 * r4 + 2] - mean) * rstd; v[3] = (acc[e2][4 * r4 + 3] - mean) * rstd;
            *(LAS f32x4*)(OT + il * 132 + e) = v; }
    __syncthreads();
    const float* GN = FIN(I_GNG) + l * 512 + h * 128; bf16* OR_ = WSP(bf16, WS_OA) + (size_t)MT * 512;
#pragma unroll
    for (int k = 0; k < 4; ++k) { const int q = tid + NTHR * k, i = q >> 4, ch = q & 15;
        const f32x4 o0 = *(const LAS f32x4*)(OT + i * 132 + 8 * ch), o1 = *(const LAS f32x4*)(OT + i * 132 + 8 * ch + 4);
        const f32x4 g0 = *(const f32x4*)(GN + 8 * ch), g1 = *(const f32x4*)(GN + 8 * ch + 4); f32x4 r0, r1; unpack8(*(const v4u*)(RG + (row0 + i) * 512 + h * 128 + 8 * ch), r0, r1);
        f32x4 y0, y1;
#pragma unroll
        for (int x = 0; x < 4; ++x) { y0[x] = o0[x] * g0[x] * siluf_(r0[x]); y1[x] = o1[x] * g1[x] * siluf_(r1[x]); }
        *(v4u*)(OR_ + (row0 + i) * 512 + h * 128 + 8 * ch) = pack8(y0, y1); }
}
__device__ __forceinline__ void ret_sample_unit(Frame& F, int l, int unit) {
    const int db = unit >> 2, h = unit & 3, tid = F.tid, e = tid & 127, dp = tid >> 7;
    const float lg = ret_log_g(h);
    LAS float* Q = (LAS float*)F.lds; LAS float* K = Q + 1024; LAS float* V = K + 1024; LAS float* GT = V + 1024; LAS float* CR = GT + 1024;
    LAS float* SC = CR + 4096; LAS float* RED = SC + 64;
    const bf16* RQ = WSP(bf16, WS_RQ); const size_t row0 = (size_t)PM + db * 8;
    __syncthreads();
    for (int i = tid; i < 4096; i += NTHR) { const int which = i >> 10, r = (i >> 7) & 7, d = i & 127; const float v = bf1(RQ[(size_t)which * MT * 512 + (row0 + r) * 512 + h * 128 + d]); Q[which * 1024 + r * 128 + d] = v; }
    __syncthreads();
    const float* S0 = FIN(I_SRET) + (((size_t)l * SB + db) * 4 + h) * 16384; float* SN = F.out + OUT_RET_S + (((size_t)l * SB + db) * 4 + h) * 16384;
    float kwv[8], cr[8];
#pragma unroll
    for (int j = 0; j < 8; ++j) { kwv[j] = V[j * 128 + e] * fexp((float)(7 - j) * lg); cr[j] = 0.f; }
    const float g8 = fexp(8.0f * lg);
    {   float s0v[32];
#pragma unroll
        for (int dd = 0; dd < 32; ++dd) s0v[dd] = S0[(dp * 32 + dd) * 128 + e];
#pragma unroll
        for (int dd = 0; dd < 32; ++dd) { const int d = dp * 32 + dd; const float s0 = s0v[dd]; float sn = g8 * s0;
#pragma unroll
            for (int j = 0; j < 8; ++j) { cr[j] += Q[j * 128 + d] * s0; sn += K[j * 128 + d] * kwv[j]; }
            SN[d * 128 + e] = sn; }
    }
#pragma unroll
    for (int i = 0; i < 8; ++i) CR[(dp * 8 + i) * 128 + e] = cr[i];
    if (tid < 64) { const int i = tid >> 3, j = tid & 7; float s = 0.f; if (j <= i) { for (int d = 0; d < 128; ++d) s += Q[i * 128 + d] * K[j * 128 + d]; s *= fexp((float)(i - j) * lg); } SC[tid] = s; }
    __syncthreads();
    float o[2];
#pragma unroll
    for (int ii = 0; ii < 2; ++ii) { const int i = 2 * dp + ii; float x = (CR[(0 * 8 + i) * 128 + e] + CR[(1 * 8 + i) * 128 + e] + CR[(2 * 8 + i) * 128 + e] + CR[(3 * 8 + i) * 128 + e]) * fexp((float)(i + 1) * lg);
        for (int j = 0; j <= i; ++j) x += SC[i * 8 + j] * V[j * 128 + e];
        o[ii] = x; }
#pragma unroll
    for (int ii = 0; ii < 2; ++ii) { const float a = wave_sum(o[ii]), q = wave_sum(o[ii] * o[ii]); if (F.lane == 0) { RED[(F.wave * 2 + ii) * 2] = a; RED[(F.wave * 2 + ii) * 2 + 1] = q; } }
    __syncthreads();
    const float* GN = FIN(I_GNG) + l * 512 + h * 128; bf16* OR_ = WSP(bf16, WS_OA) + (size_t)MT * 512;
#pragma unroll
    for (int ii = 0; ii < 2; ++ii) { const int i = 2 * dp + ii, w0 = 2 * dp; const float s1 = RED[(w0 * 2 + ii) * 2] + RED[((w0 + 1) * 2 + ii) * 2], s2 = RED[(w0 * 2 + ii) * 2 + 1] + RED[((w0 + 1) * 2 + ii) * 2 + 1];
        const float mean = s1 * (1.0f / 128.0f), var = fmaxf(s2 * (1.0f / 128.0f) - mean * mean, 0.f), rstd = 1.0f / sqrtf(var + EPS);
        const float y = (o[ii] - mean) * rstd * GN[e] * siluf_(GT[i * 128 + e]);
        OR_[(row0 + i) * 512 + h * 128 + e] = (bf16)(pk2(y, 0.f) & 0xffffu); }
}

template <int MODE> __device__ __forceinline__ void rglru_unit(Frame& F, int l, int unit) {
    const int tid = F.tid, c = tid, lane = F.lane, w = F.wave;
    LAS bf16* XC = (LAS bf16*)F.lds; LAS float* G = (LAS float*)(F.lds + 16384);
    const int seq = (MODE == 2) ? unit : (unit >> 6), tile = (MODE == 2) ? 0 : (unit & 63);
    const size_t row0 = (MODE == 2) ? (size_t)PM + seq * 8 : (size_t)seq * PT + tile * 64;
    const int ntok = (MODE == 2) ? 8 : 64, nsub = (MODE == 2) ? 1 : 4;
    const float* RX = WSP(float, WS_RX);
    const float w0 = FIN(I_RCW)[(l * 4 + 0) * 512 + c], w1 = FIN(I_RCW)[(l * 4 + 1) * 512 + c], w2 = FIN(I_RCW)[(l * 4 + 2) * 512 + c], w3 = FIN(I_RCW)[(l * 4 + 3) * 512 + c], cb = FIN(I_RCB)[l * 512 + c];
    const float ba = FIN(I_RBA)[l * 512 + c], bx = FIN(I_RBX)[l * 512 + c], sp = WSP(float, WS_SMALLW + SW_SP)[l * 512 + c];
    float x3, x2, x1;
    if (MODE == 2) { const float* cv = FIN(I_SCONV) + ((size_t)l * SB + seq) * 3 * 512; x3 = cv[c]; x2 = cv[512 + c]; x1 = cv[1024 + c]; }
    else if (tile == 0) { x3 = 0.f; x2 = 0.f; x1 = 0.f; }
    else { x3 = RX[(row0 - 3) * 512 + c]; x2 = RX[(row0 - 2) * 512 + c]; x1 = RX[(row0 - 1) * 512 + c]; }
    float h = (MODE == 0) ? 0.f : (MODE == 1) ? WSP(float, WS_CAR)[(size_t)4 * 64 * 2 * 512 + ((size_t)seq * 64 + tile) * 512 + c] : FIN(I_SH)[((size_t)l * SB + seq) * 512 + c];
    float aprod = 1.f;
    const int r16 = lane & 15, g4 = lane >> 4;
    bf16x8 wa[4][2], wx[4][2];
    { const bf16* WA = WSP(bf16, WS_SMALLW + SW_WAT) + ((size_t)(l * 2 + 0) * 8 + w) * 4096; const bf16* WX = WSP(bf16, WS_SMALLW + SW_WAT) + ((size_t)(l * 2 + 1) * 8 + w) * 4096;
#pragma unroll
      for (int ct = 0; ct < 4; ++ct)
#pragma unroll
          for (int ks = 0; ks < 2; ++ks) { wa[ct][ks] = *(const bf16x8*)(WA + (16 * ct + r16) * 64 + 32 * ks + 8 * g4); wx[ct][ks] = *(const bf16x8*)(WX + (16 * ct + r16) * 64 + 32 * ks + 8 * g4); } }
    const bf16* GG = WSP(bf16, WS_GG); bf16* OC = WSP(bf16, WS_OA) + (size_t)2 * MT * 512;
    __syncthreads();
    float xn[16]; bf16 gn[16];
#pragma unroll
    for (int tt = 0; tt < 16; ++tt) { xn[tt] = (tt < ntok) ? RX[(row0 + tt) * 512 + c] : 0.f; gn[tt] = (MODE != 0 && tt < ntok) ? GG[(row0 + tt) * 512 + c] : (bf16)0; }
    for (int s = 0; s < nsub; ++s) {
        float xc[16], gg[16];
#pragma unroll
        for (int tt = 0; tt < 16; ++tt) { xc[tt] = xn[tt]; gg[tt] = bf1(gn[tt]); }
        if (s + 1 < nsub) {
#pragma unroll
            for (int tt = 0; tt < 16; ++tt) { const int t = (s + 1) * 16 + tt; xn[tt] = RX[(row0 + t) * 512 + c]; gn[tt] = (MODE != 0) ? GG[(row0 + t) * 512 + c] : (bf16)0; } }
#pragma unroll
        for (int tt = 0; tt < 16; ++tt) { const float x0 = xc[tt];
            xc[tt] = cb + w0 * x3 + w1 * x2 + w2 * x1 + w3 * x0; x3 = x2; x2 = x1; x1 = x0; XC[tt * 512 + c] = (bf16)(pk2(xc[tt], 0.f) & 0xffffu); }
        LDS_WAIT(); asm volatile("" ::: "memory");
        {
            bf16x8 xf[2];
#pragma unroll
            for (int ks = 0; ks < 2; ++ks) xf[ks] = *(const LAS bf16x8*)(XC + r16 * 512 + w * 64 + 32 * ks + 8 * g4);
#pragma unroll
            for (int ct = 0; ct < 4; ++ct) { f32x4 da = (f32x4){0.f, 0.f, 0.f, 0.f}, dx = da;
#pragma unroll
                for (int ks = 0; ks < 2; ++ks) { da = mfma16(wa[ct][ks], xf[ks], da); dx = mfma16(wx[ct][ks], xf[ks], dx); }
                *(LAS f32x4*)(G + r16 * 512 + w * 64 + 16 * ct + 4 * g4) = da; *(LAS f32x4*)(G + 8192 + r16 * 512 + w * 64 + 16 * ct + 4 * g4) = dx; }
        }
        LDS_WAIT(); asm volatile("" ::: "memory");
#pragma unroll
        for (int tt = 0; tt < 16; ++tt) { const int t = s * 16 + tt;
            if (t < ntok) {
                const float r = sigmoidf_(G[tt * 512 + c] + ba), ig = sigmoidf_(G[8192 + tt * 512 + c] + bx);
                const float la = -8.0f * r * sp, a = fexp(la), bt = sqrtf(fmaxf(1.0f - a * a, 0.f)) * (ig * xc[tt]);
                h = a * h + bt; aprod *= a;
                if (MODE != 0) { const size_t o = (row0 + t) * 512 + c; OC[o] = (bf16)(pk2(h * gg[tt], 0.f) & 0xffffu); }
            } }
    }
    if (MODE == 0) { float* CAR = WSP(float, WS_CAR) + ((size_t)seq * 64 + tile) * 1024; CAR[c] = aprod; CAR[512 + c] = h; }
    if (MODE == 2) F.out[OUT_H_S + ((size_t)l * SB + seq) * 512 + c] = h;
}
__device__ __forceinline__ void rglru_carry_phase(Frame& F, int l) {
    const float* CAR = WSP(float, WS_CAR); float* HIN = WSP(float, WS_CAR) + (size_t)4 * 64 * 2 * 512;
    for (int idx = F.bid * NTHR + F.tid; idx < PB * 512; idx += F.G * NTHR) {
        const int b = idx >> 9, c = idx & 511; float h = 0.f;
#pragma unroll 1
        for (int t0 = 0; t0 < 64; t0 += 32) {
            float ca[32], cb[32];
#pragma unroll
            for (int t = 0; t < 32; ++t) { const float* cr = CAR + ((size_t)b * 64 + t0 + t) * 1024; ca[t] = cr[c]; cb[t] = cr[512 + c]; }
#pragma unroll
            for (int t = 0; t < 32; ++t) { HIN[((size_t)b * 64 + t0 + t) * 512 + c] = h; h = ca[t] * h + cb[t]; }
        }
        F.out[OUT_H_P + ((size_t)l * PB + b) * 512 + c] = h;
    }
}

__device__ __forceinline__ void convact_rows(Frame& F, int l, size_t row0, int nrows, bool smp) {
    const bf16* GP = WSP(bf16, WS_GP); const bf16* VAL = GP + (size_t)MT * DFF; bf16* ACT = WSP(bf16, WS_GP) + (size_t)2 * MT * DFF;
    const float* CW = FIN(I_FCW) + (size_t)l * 3 * DFF; const float* CBI = FIN(I_FCB) + (size_t)l * DFF;
    constexpr int NCG = DFF / 8;
    for (int it = F.tid; it < nrows * NCG; it += NTHR) {
        const int rr = it / NCG, c = (it % NCG) * 8; const size_t row = row0 + rr;
        f32x4 xa, xb, p1a, p1b, p2a, p2b, va, vb;
        const v4u gx = *(const v4u*)(GP + row * DFF + c), vx = *(const v4u*)(VAL + row * DFF + c);
        if (!smp) { v4u g1 = *(const v4u*)(GP + (row - 1) * DFF + c), g2 = *(const v4u*)(GP + (row - 2) * DFF + c); unpack8(g1, p1a, p1b); unpack8(g2, p2a, p2b); }
        else { const int sr = (int)(row - PM), seq = sr >> 3, i = sr & 7; const float* st = FIN(I_SFFN) + (((size_t)l * SB + seq) * 2) * DFF + c;
            if (i >= 1) unpack8(*(const v4u*)(GP + (row - 1) * DFF + c), p1a, p1b); else { p1a = *(const f32x4*)(st + DFF); p1b = *(const f32x4*)(st + DFF + 4); }
            if (i >= 2) unpack8(*(const v4u*)(GP + (row - 2) * DFF + c), p2a, p2b); else { const float* s2 = st + (i == 1 ? DFF : 0); p2a = *(const f32x4*)s2; p2b = *(const f32x4*)(s2 + 4); } }
        unpack8(gx, xa, xb); unpack8(vx, va, vb);
        const f32x4 w0a = *(const f32x4*)(CW + c), w0b = *(const f32x4*)(CW + c + 4), w1a = *(const f32x4*)(CW + DFF + c), w1b = *(const f32x4*)(CW + DFF + c + 4), w2a = *(const f32x4*)(CW + 2 * DFF + c), w2b = *(const f32x4*)(CW + 2 * DFF + c + 4);
        f32x4 ya = *(const f32x4*)(CBI + c) + w0a * p2a + w1a * p1a + w2a * xa, yb = *(const f32x4*)(CBI + c + 4) + w0b * p2b + w1b * p1b + w2b * xb;
#pragma unroll
        for (int k = 0; k < 4; ++k) { ya[k] = siluf_(ya[k]) * va[k]; yb[k] = siluf_(yb[k]) * vb[k]; }
        *(v4u*)(ACT + row * DFF + c) = pack8(ya, yb);
    }
}

constexpr int AT_RS = 144;
constexpr int AT_K0 = 0, AT_V0 = 2 * 64 * AT_RS, AT_PS = 4 * 64 * AT_RS, AT_IMP = AT_PS + 69632, AT_MASK = AT_IMP + 6144, AT_LIST = AT_MASK + 2048, AT_NL = AT_LIST + 1024;
constexpr unsigned AT_MARK = 0xFFFFu;
static_assert(AT_NL + 64 <= RING_BYTES, "attention LDS map");

struct TileRegs { v4u a, b, c, d; int mode; };

template <bool SMP> __device__ __forceinline__ void at_prefetch(const Frame& F, int l, int seq, int kvh, unsigned e, TileRegs& R) {
    const int kind = (int)(e >> 14), ti = (int)(e & 0x3fffu), rr = F.tid >> 3, pc = F.tid & 7;
    R.mode = 0;
    if (kind < 2) {
        const size_t rb = SMP ? (size_t)(seq * 2 + kvh) * 512 : (size_t)32768 + (size_t)(seq * 2 + kvh) * 256;
        const bf16* ck = WSP(bf16, WS_CK) + (rb + ti * 64 + rr) * 64 + pc * 8;
        R.a = *(const v4u*)ck; R.c = *(const v4u*)(ck + (size_t)CMP_ROWS_J * 64);
    } else if (!SMP) {
        const int jb = (kind == 2) ? 0 : 2;
        const bf16* kp = WSP(bf16, WS_KVB) + ((((size_t)jb * PB + seq) * 2 + kvh) * PT + ti * 64 + rr) * 64 + pc * 8;
        R.a = *(const v4u*)kp; R.c = *(const v4u*)(kp + (size_t)PB * 2 * PT * 64);
    } else if (kind == 2) {
        if (ti < 128) {
            const int page = ((const int*)F.a->in[I_PT])[seq * NPG + (ti >> 1)], slot = (ti & 1) * 64 + rr;
            const float* kp = FIN(I_CACHE) + (((((size_t)l * NPHYS + page) * PAGE + slot) * 4 + 2) * 2 + kvh) * 64 + pc * 8;
            R.a = *(const v4u*)kp; R.b = *(const v4u*)(kp + 4); R.c = *(const v4u*)(kp + 128); R.d = *(const v4u*)(kp + 132); R.mode = 1;
        } else if (rr < ST) {
            const bf16* kp = WSP(bf16, WS_KVS) + ((((size_t)0 * SB + seq) * 2 + kvh) * ST + rr) * 64 + pc * 8;
            R.a = *(const v4u*)kp; R.c = *(const v4u*)(kp + (size_t)SB * 2 * ST * 64);
        } else R.mode = 2;
    } else {
        if (ti < 8) {
            const float* kp = FIN(I_CWIN) + (((((size_t)l * SB + seq) * WINB + ti * 64 + rr) * 2 + 0) * 2 + kvh) * 64 + pc * 8;
            R.a = *(const v4u*)kp; R.b = *(const v4u*)(kp + 4); R.c = *(const v4u*)(kp + 128); R.d = *(const v4u*)(kp + 132); R.mode = 1;
        } else if (rr < ST) {
            const bf16* kp = WSP(bf16, WS_KVS) + ((((size_t)2 * SB + seq) * 2 + kvh) * ST + rr) * 64 + pc * 8;
            R.a = *(const v4u*)kp; R.c = *(const v4u*)(kp + (size_t)SB * 2 * ST * 64);
        } else R.mode = 2;
    }
}
__device__ __forceinline__ void at_store(const Frame& F, int buf, const TileRegs& R) {
    const int rr = F.tid >> 3, pc = F.tid & 7; v4u k, v;
    if (R.mode == 0) { k = R.a; v = R.c; }
    else if (R.mode == 1) { k = pack8(__builtin_bit_cast(f32x4, R.a), __builtin_bit_cast(f32x4, R.b)); v = pack8(__builtin_bit_cast(f32x4, R.c), __builtin_bit_cast(f32x4, R.d)); }
    else { k = (v4u){0u, 0u, 0u, 0u}; v = k; }
    *(LAS v4u*)(F.lds + AT_K0 + buf * 64 * AT_RS + rr * AT_RS + pc * 16) = k;
    *(LAS v4u*)(F.lds + AT_V0 + buf * 64 * AT_RS + rr * AT_RS + pc * 16) = v;
}

template <bool SMP> __device__ __forceinline__ void attn_unit(Frame& F, int l, int unit) {
    const int tid = F.tid, lane = F.lane, w = F.wave;
    const int q = lane & 31, h_ = lane >> 5, blk = (lane >> 4) & 1, tl = q >> 2, hr = q & 3;
    int seq, kvh, qt;
    if (SMP) { seq = unit >> 1; kvh = unit & 1; qt = 128; } else { seq = unit >> 7; kvh = (unit >> 6) & 1; qt = unit & 63; }
    const int t0 = SMP ? PAST : qt * 64;
    const int tokl = SMP ? tl : 8 * w + tl, t = t0 + tokl;
    const size_t row = SMP ? (size_t)PM + seq * ST + tl : (size_t)seq * PT + t;
    const int head = kvh * 4 + hr;
    LAS float* PS = (LAS float*)(F.lds + AT_PS); LAS float* IMPw = (LAS float*)(F.lds + AT_IMP) + w * 192;
    LAS unsigned long long* MASKS = (LAS unsigned long long*)(F.lds + AT_MASK); LAS unsigned short* LIST = (LAS unsigned short*)(F.lds + AT_LIST); LAS int* NL = (LAS int*)(F.lds + AT_NL);
    constexpr int PSS = SMP ? 520 : 264;
    LAS float* PSw = SMP ? PS : PS + w * 8 * PSS;
    __syncthreads();
    bf16x8 qf[4];
    { const bf16* qp = WSP(bf16, WS_QN) + row * 512 + head * 64 + 8 * h_;
#pragma unroll
      for (int kk = 0; kk < 4; ++kk) qf[kk] = *(const bf16x8*)(qp + 16 * kk); }
    const float* ngp = WSP(float, WS_NG) + row * 24 + head * 3; const float g0 = ngp[0], g1 = ngp[1], g2 = ngp[2];
    if (!SMP) { for (int i = lane; i < 8 * PSS; i += 64) PSw[i] = 0.f; }
    const int ntc = SMP ? 8 : ((t0 + 32) >> 10) + 1;
    if (tid < 2 * ntc) LIST[tid] = (unsigned short)(((tid >= ntc ? 1u : 0u) << 14) | (unsigned)(tid >= ntc ? tid - ntc : tid));
    if (tid == 0) LIST[2 * ntc] = (unsigned short)AT_MARK;
    int nl = 2 * ntc + 1;
    TileRegs R;
    at_prefetch<SMP>(F, l, seq, kvh, (unsigned)0, R);
    at_store(F, 0, R);
    __syncthreads();
    float m = -INFINITY, lsum = 0.f, invden = 0.f;
    f32x16 O[2]; O[0] = (f32x16){}; O[1] = (f32x16){};
    LAS float* OAw = (LAS float*)(F.lds + AT_PS) + w * (SMP ? 2048 : 8 * PSS) + lane;
    unsigned long long mk0 = 0ull, mk1 = 0ull, wu = ~0ull;
    int cur_kind = -1, idx = 0;
#define AT_FINALIZE(kind) do { \
        if ((kind) == 0) { const float lt = lsum + __shfl_xor(lsum, 32); invden = lt > 0.f ? 1.0f / lt : 0.f; } \
        else if ((kind) == 1) { const float sc = g0 * invden; O[0] *= sc; O[1] *= sc; } \
        else if ((kind) == 2) { const float lt = lsum + __shfl_xor(lsum, 32); const float sc = (lt > 0.f ? 1.0f / lt : 0.f) * g1; \
            _Pragma("unroll") for (int r_ = 0; r_ < 16; ++r_) { OAw[r_ * 64] += O[0][r_] * sc; OAw[(16 + r_) * 64] += O[1][r_] * sc; } } } while (0)
    while (idx < nl) {
        const unsigned e = (unsigned)__builtin_amdgcn_readfirstlane((int)LIST[idx]);
        if (e == AT_MARK) {
            AT_FINALIZE(cur_kind); cur_kind = -1;
            LDS_WAIT(); asm volatile("" ::: "memory");
#pragma unroll 1
            for (int tk = 0; tk < 8; ++tk) {
                const LAS float* pr = PSw + tk * PSS;
                if (!SMP) {
                    const int s = lane; float imp = 0.f;
#pragma unroll
                    for (int n = 4 * s - 1; n <= 4 * s + 3; ++n) if (n >= 0) imp += pr[n];
                    const bool forced = (s == 0) || (s == qt) || (s == qt - 1), avail = s <= qt;
                    const float val = avail ? (forced ? 1e4f : imp) : -1e4f;
                    IMPw[s] = val; LDS_WAIT(); asm volatile("" ::: "memory");
                    int rank = 0;
#pragma unroll 8
                    for (int i = 0; i < 64; ++i) { const float v = IMPw[i]; rank += (v > val || (v == val && i < s)) ? 1 : 0; }
                    const unsigned long long mk = __ballot(rank < 16);
                    if (lane == 0) MASKS[(8 * w + tk) * 4] = mk;
                    LDS_WAIT(); asm volatile("" ::: "memory");
                } else {
                    const int sa = lane, sb = lane + 64; float ia = 0.f, ib = 0.f;
#pragma unroll
                    for (int n = 4 * sa - 1; n <= 4 * sa + 3; ++n) if (n >= 0) ia += pr[n];
#pragma unroll
                    for (int n = 4 * sb - 1; n <= 4 * sb + 3; ++n) ib += pr[n];
                    const bool fa = (sa == 0), fb = (sb == 127);
                    const float va = fa ? 1e4f : ia, vb = fb ? 1e4f : ib;
                    IMPw[sa] = va; IMPw[sb] = vb; LDS_WAIT(); asm volatile("" ::: "memory");
                    int ra = fa ? 0 : 1, rb = fb ? 0 : 1;
#pragma unroll 8
                    for (int i = 0; i < 128; ++i) { const float v = IMPw[i]; ra += (v > va || (v == va && i < sa)) ? 1 : 0; rb += (v > vb || (v == vb && i < sb)) ? 1 : 0; }
                    const unsigned long long ma = __ballot(ra < 16), mb = __ballot(rb < 16);
                    if (lane == 0) { MASKS[tk * 4] = ma; MASKS[tk * 4 + 1] = mb; MASKS[tk * 4 + 2] = 1ull; }
                    LDS_WAIT(); asm volatile("" ::: "memory");
                }
            }
            __syncthreads();
#pragma unroll
            for (int r_ = 0; r_ < 16; ++r_) { OAw[r_ * 64] = O[0][r_]; OAw[(16 + r_) * 64] = O[1][r_]; }
            if (tid == 0) {
                int n = idx + 1;
                if (!SMP) { unsigned long long U = 0ull; for (int i = 0; i < 64; ++i) U |= MASKS[i * 4];
                    for (int s = 0; s <= qt; ++s) if ((U >> s) & 1ull) LIST[n++] = (unsigned short)((2u << 14) | (unsigned)s);
                    for (int s = (qt > 8 ? qt - 8 : 0); s <= qt; ++s) LIST[n++] = (unsigned short)((3u << 14) | (unsigned)s);
                } else { unsigned long long U0 = 0ull, U1 = 0ull; for (int i = 0; i < 8; ++i) { U0 |= MASKS[i * 4]; U1 |= MASKS[i * 4 + 1]; }
                    for (int s = 0; s < 64; ++s) if ((U0 >> s) & 1ull) LIST[n++] = (unsigned short)((2u << 14) | (unsigned)s);
                    for (int s = 0; s < 64; ++s) if ((U1 >> s) & 1ull) LIST[n++] = (unsigned short)((2u << 14) | (unsigned)(64 + s));
                    LIST[n++] = (unsigned short)((2u << 14) | 128u);
                    for (int s = 0; s <= 8; ++s) LIST[n++] = (unsigned short)((3u << 14) | (unsigned)s); }
                NL[0] = n;
            }
            __syncthreads();
            nl = __builtin_amdgcn_readfirstlane(NL[0]);
            mk0 = MASKS[tokl * 4]; if (SMP) { mk1 = MASKS[tokl * 4 + 1]; }
            if (!SMP) { unsigned long long u = 0ull; for (int i = 0; i < 8; ++i) u |= MASKS[(8 * w + i) * 4]; wu = u; }
            if (idx + 1 < nl) { at_prefetch<SMP>(F, l, seq, kvh, (unsigned)LIST[idx + 1], R); at_store(F, (idx + 1) & 1, R); }
            __syncthreads();
            ++idx; continue;
        }
        const int kind = (int)(e >> 14), ti = (int)(e & 0x3fffu);
        if (kind != cur_kind) {
            if (cur_kind >= 0) AT_FINALIZE(cur_kind);
            if (kind != 1) m = -INFINITY;
            lsum = 0.f; O[0] = (f32x16){}; O[1] = (f32x16){}; cur_kind = kind;
        }
        const unsigned en = (idx + 1 < nl) ? (unsigned)__builtin_amdgcn_readfirstlane((int)LIST[idx + 1]) : AT_MARK;
        const bool have_next = (en != AT_MARK);
        if (have_next) at_prefetch<SMP>(F, l, seq, kvh, en, R);
        bool active = true;
        if (!SMP && kind == 2) active = ((wu >> ti) & 1ull) != 0ull;
        if (active) {
            const LAS unsigned char* Kb = F.lds + AT_K0 + (idx & 1) * 64 * AT_RS; const LAS unsigned char* Vb = F.lds + AT_V0 + (idx & 1) * 64 * AT_RS;
            int lo, hi; const int kb = 64 * ti;
            if (kind < 2) { lo = 0; hi = SMP ? 510 : ((t >= 31) ? ((t - 31) >> 4) : -1); }
            else if (kind == 2) { lo = 0; const unsigned long long mw = (ti < 64) ? mk0 : ((ti < 128) ? mk1 : 1ull); hi = ((mw >> (ti & 63)) & 1ull) ? t : -1; }
            else { if (SMP) { lo = tl; hi = WINB + tl; } else { lo = t - WINB; hi = t; } }
            f32x16 s0 = (f32x16){}, s1 = (f32x16){};
#pragma unroll
            for (int kk = 0; kk < 4; ++kk) {
                const bf16x8 k0 = *(const LAS bf16x8*)(Kb + q * AT_RS + (16 * kk + 8 * h_) * 2), k1 = *(const LAS bf16x8*)(Kb + (32 + q) * AT_RS + (16 * kk + 8 * h_) * 2);
                s0 = mfma32(k0, qf[kk], s0); s1 = mfma32(k1, qf[kk], s1);
            }
            float tmax = -INFINITY;
#pragma unroll
            for (int r = 0; r < 16; ++r) { const int key = kb + (r & 3) + 8 * (r >> 2) + 4 * h_;
                s0[r] = (key >= lo && key <= hi) ? s0[r] : -INFINITY; s1[r] = (key + 32 >= lo && key + 32 <= hi) ? s1[r] : -INFINITY;
                tmax = fmaxf(tmax, fmaxf(s0[r], s1[r])); }
            tmax = fmaxf(tmax, __shfl_xor(tmax, 32));
            const float m_new = fmaxf(m, tmax), m_use = (m_new == -INFINITY) ? 0.f : m_new;
            const float alpha = fexp2(m - m_use);
            float ps = 0.f;
#pragma unroll
            for (int r = 0; r < 16; ++r) { s0[r] = fexp2(s0[r] - m_use); s1[r] = fexp2(s1[r] - m_use); ps += s0[r] + s1[r]; }
            lsum = lsum * alpha + ps; m = m_new;
            if (kind != 0) {
                O[0] *= alpha; O[1] *= alpha;
#pragma unroll
                for (int kt2 = 0; kt2 < 2; ++kt2)
#pragma unroll
                    for (int s2 = 0; s2 < 2; ++s2) { const bf16x8 pf = cvt_frag(kt2 ? s1 : s0, s2); const int rA = 32 * kt2 + 16 * s2 + 4 * h_;
#pragma unroll
                        for (int dt = 0; dt < 2; ++dt) { const bf16x8 vf = tr_frag(Vb, AT_RS, rA, rA + 8, 32 * dt + 16 * blk, lane); O[dt] = mfma32(vf, pf, O[dt]); } }
            }
            if (kind == 1) {
#pragma unroll
                for (int r = 0; r < 16; ++r) { const int n = kb + (r & 3) + 8 * (r >> 2) + 4 * h_;
                    float a = s0[r] * invden, b = s1[r] * invden; a += __shfl_xor(a, 1); b += __shfl_xor(b, 1); a += __shfl_xor(a, 2); b += __shfl_xor(b, 2);
                    if (hr == 0) { PSw[tl * PSS + n] = a; PSw[tl * PSS + n + 32] = b; } }
            }
        }
        if (have_next) at_store(F, (idx + 1) & 1, R);
        __syncthreads();
        ++idx;
    }
#undef AT_FINALIZE
    {
        const float lt = lsum + __shfl_xor(lsum, 32); const float sc = (lt > 0.f ? 1.0f / lt : 0.f) * g2;
        if (!SMP || w == 0) {
            bf16* op = WSP(bf16, WS_OA) + row * 512 + head * 64;
#pragma unroll
            for (int dt = 0; dt < 2; ++dt)
#pragma unroll
                for (int r4 = 0; r4 < 4; ++r4) { float o_[4];
#pragma unroll
                    for (int x = 0; x < 4; ++x) o_[x] = OAw[(dt * 16 + 4 * r4 + x) * 64] + O[dt][4 * r4 + x] * sc;
                    v2u wv; wv.x = pk2(o_[0], o_[1]); wv.y = pk2(o_[2], o_[3]); *(v2u*)(op + 32 * dt + 8 * r4 + 4 * h_) = wv; }
        }
    }
}

constexpr int AS_RS = 144;
constexpr int AS_V = 0, AS_VW = 32 * AS_RS, AS_MRG = 0, AS_PS = 73728, AS_IMP = AS_PS + 16640, AS_MASK = AS_IMP + 6144, AS_OA = AS_MASK + 512;
static_assert(8 * 34 * 64 * 4 <= AS_PS && AS_OA + 32 * 64 * 4 <= RING_BYTES, "sample attention LDS map");

__device__ __forceinline__ float xhalf_max(float x) { auto t_ = __builtin_amdgcn_permlane32_swap(__float_as_uint(x), __float_as_uint(x), false, false); return fmaxf(__uint_as_float(t_[0]), __uint_as_float(t_[1])); }
__device__ __forceinline__ float xhalf_sum(float x) { auto t_ = __builtin_amdgcn_permlane32_swap(__float_as_uint(x), __float_as_uint(x), false, false); return __uint_as_float(t_[0]) + __uint_as_float(t_[1]); }
struct ASrc { const float* kf; const float* vf; const bf16* kb; const bf16* vb; int rs; int nvalid; };
#define AS_TILE(SRC, KB0, LO_, HI_, DO_PV, DO_PS, m, lsum, O0, O1, invden, PSS_) do { \
        bf16x8 kfr[4]; f32x4 vx_[8]; \
        if ((SRC).kb) { const bf16* kp_ = (SRC).kb + (size_t)q * (SRC).rs + 8 * h_; _Pragma("unroll") for (int kk = 0; kk < 4; ++kk) kfr[kk] = *(const bf16x8*)(kp_ + 16 * kk); } \
        else {   \
            f32x4 kx_[8]; _Pragma("unroll") for (int x = 0; x < 8; ++x) kx_[x] = *(const f32x4*)((SRC).kf + (size_t)(4 * x + (lane >> 4)) * (SRC).rs + (lane & 15) * 4); \
            _Pragma("unroll") for (int x = 0; x < 8; ++x) { v2u o_; o_.x = pk2(kx_[x][0], kx_[x][1]); o_.y = pk2(kx_[x][2], kx_[x][3]); *(LAS v2u*)(Vw + (4 * x + (lane >> 4)) * AS_RS + (lane & 15) * 8) = o_; } \
            LDS_WAIT(); asm volatile("" ::: "memory"); \
            _Pragma("unroll") for (int kk = 0; kk < 4; ++kk) kfr[kk] = *(const LAS bf16x8*)(Vw + q * AS_RS + (16 * kk + 8 * h_) * 2); \
            LDS_WAIT(); asm volatile("" ::: "memory"); \
            if (DO_PV) { _Pragma("unroll") for (int x = 0; x < 8; ++x) vx_[x] = *(const f32x4*)((SRC).vf + (size_t)(4 * x + (lane >> 4)) * (SRC).rs + (lane & 15) * 4); } }     \
        if (DO_PV) { const int vr_ = lane >> 1, vh_ = lane & 1; v4u vv_[4]; \
            if (vr_ >= (SRC).nvalid) { _Pragma("unroll") for (int x = 0; x < 4; ++x) vv_[x] = (v4u){0u, 0u, 0u, 0u}; } \
            else if ((SRC).vb) { const bf16* vp_ = (SRC).vb + (size_t)vr_ * (SRC).rs + 32 * vh_; _Pragma("unroll") for (int x = 0; x < 4; ++x) vv_[x] = *(const v4u*)(vp_ + 8 * x); } \
            if ((SRC).vb || vr_ >= (SRC).nvalid) { _Pragma("unroll") for (int x = 0; x < 4; ++x) *(LAS v4u*)(Vw + vr_ * AS_RS + vh_ * 64 + x * 16) = vv_[x]; } } \
        f32x16 s_ = (f32x16){}; \
        _Pragma("unroll") for (int kk = 0; kk < 4; ++kk) s_ = mfma32(kfr[kk], qf[kk], s_); \
        float tmax_ = -INFINITY; \
        _Pragma("unroll") for (int r = 0; r < 16; ++r) { const int key_ = (KB0) + (r & 3) + 8 * (r >> 2) + 4 * h_; s_[r] = (key_ >= (LO_) && key_ <= (HI_)) ? s_[r] : -INFINITY; tmax_ = fmaxf(tmax_, s_[r]); } \
        tmax_ = xhalf_max(tmax_); \
        const float mn_ = fmaxf(m, tmax_), mu_ = (mn_ == -INFINITY) ? 0.f : mn_, al_ = fexp2(m - mu_); float ps_ = 0.f; \
        _Pragma("unroll") for (int r = 0; r < 16; ++r) { s_[r] = fexp2(s_[r] - mu_); ps_ += s_[r]; } \
        lsum = lsum * al_ + ps_; m = mn_; \
        if (DO_PV) { O0 *= al_; O1 *= al_; \
            if (!(SRC).vb) { _Pragma("unroll") for (int x = 0; x < 8; ++x) { v2u o_; o_.x = pk2(vx_[x][0], vx_[x][1]); o_.y = pk2(vx_[x][2], vx_[x][3]); *(LAS v2u*)(Vw + (4 * x + (lane >> 4)) * AS_RS + (lane & 15) * 8) = o_; } } \
            LDS_WAIT(); asm volatile("" ::: "memory"); \
            _Pragma("unroll") for (int s2 = 0; s2 < 2; ++s2) { const bf16x8 pf_ = cvt_frag(s_, s2); const int rA_ = 16 * s2 + 4 * h_; \
                O0 = mfma32(tr_frag(Vw, AS_RS, rA_, rA_ + 8, 16 * blk, lane), pf_, O0); O1 = mfma32(tr_frag(Vw, AS_RS, rA_, rA_ + 8, 32 + 16 * blk, lane), pf_, O1); } \
            LDS_WAIT(); asm volatile("" ::: "memory"); } \
        if (DO_PS) { _Pragma("unroll") for (int r = 0; r < 16; ++r) { const int n_ = (KB0) + (r & 3) + 8 * (r >> 2) + 4 * h_; float a_ = s_[r] * (invden); a_ += __shfl_xor(a_, 1); a_ += __shfl_xor(a_, 2); if (hr == 0) PS[tl * (PSS_) + n_] = a_; } } \
    } while (0)

__device__ __forceinline__ void attn_sample_unit(Frame& F, int l, int unit) {
    const int lane = F.lane, w = F.wave, tid = F.tid;
    const int q = lane & 31, h_ = lane >> 5, blk = (lane >> 4) & 1, tl = q >> 2, hr = q & 3;
    const int seq = unit >> 1, kvh = unit & 1, head = kvh * 4 + hr;
    const size_t row = (size_t)PM + seq * ST + tl;
    LAS unsigned char* Vw = F.lds + AS_V + w * AS_VW;
    LAS float* MRG = (LAS float*)(F.lds + AS_MRG);
    LAS float* PS = (LAS float*)(F.lds + AS_PS);
    LAS float* IMPw = (LAS float*)(F.lds + AS_IMP) + w * 192;
    LAS unsigned long long* MASKS = (LAS unsigned long long*)(F.lds + AS_MASK);
    __syncthreads();
    bf16x8 qf[4];
    { const bf16* qp = WSP(bf16, WS_QN) + row * 512 + head * 64 + 8 * h_;
#pragma unroll
      for (int kk = 0; kk < 4; ++kk) qf[kk] = *(const bf16x8*)(qp + 16 * kk); }
    const float* ngp = WSP(float, WS_NG) + row * 24 + head * 3; const float g0 = ngp[0], g1 = ngp[1], g2 = ngp[2];
    const int* ptab = (const int*)F.a->in[I_PT] + seq * NPG;
    LAS float* OAL = (LAS float*)(F.lds + AS_OA) + lane;

#define AS_PUBLISH(m, lsum, O0, O1) do { __syncthreads(); LAS float* mp_ = MRG + w * 34 * 64 + lane; mp_[0] = m; mp_[64] = lsum; \
        _Pragma("unroll") for (int r = 0; r < 16; ++r) { mp_[(2 + r) * 64] = O0[r]; mp_[(18 + r) * 64] = O1[r]; } __syncthreads(); } while (0)

    const bf16* CKk = WSP(bf16, WS_CK) + ((size_t)(seq * 2 + kvh) * 512) * 64; const bf16* CKv = CKk + (size_t)CMP_ROWS_J * 64;
    float mC = -INFINITY, lC = 0.f; f32x16 D0 = (f32x16){}, D1 = (f32x16){};
#pragma unroll 1
    for (int ti = w; ti < 16; ti += 8) { ASrc S{nullptr, nullptr, CKk + (size_t)ti * 32 * 64, CKv + (size_t)ti * 32 * 64, 64, 32}; AS_TILE(S, ti * 32, 0, 510, false, false, mC, lC, D0, D1, 0.f, 520); }
    { __syncthreads(); MRG[w * 128 + lane] = mC; MRG[w * 128 + 64 + lane] = xhalf_sum(lC); __syncthreads(); }
    float mT = -INFINITY;
#pragma unroll
    for (int x = 0; x < 8; ++x) mT = fmaxf(mT, MRG[x * 128 + lane]);
    float lT = 0.f;
#pragma unroll
    for (int x = 0; x < 8; ++x) { const float mx_ = MRG[x * 128 + lane]; lT += (mx_ == -INFINITY) ? 0.f : MRG[x * 128 + 64 + lane] * fexp2(mx_ - mT); }
    const float invC = lT > 0.f ? 1.0f / lT : 0.f;
    __syncthreads();
    { float mB = mT, lB = 0.f;
#pragma unroll 1
      for (int ti = w; ti < 16; ti += 8) { ASrc S{nullptr, nullptr, CKk + (size_t)ti * 32 * 64, CKv + (size_t)ti * 32 * 64, 64, 32}; AS_TILE(S, ti * 32, 0, 510, true, true, mB, lB, D0, D1, invC, 520); }
      AS_PUBLISH(mB, lB, D0, D1); }
    if (w == 0) { const float sc = g0 * invC; f32x16 T0 = (f32x16){}, T1 = (f32x16){};
#pragma unroll 1
      for (int x = 0; x < 8; ++x) { const LAS float* mp = MRG + x * 34 * 64 + lane;
#pragma unroll
          for (int r = 0; r < 16; ++r) { T0[r] += mp[(2 + r) * 64] * sc; T1[r] += mp[(18 + r) * 64] * sc; } }
#pragma unroll
      for (int r = 0; r < 16; ++r) { OAL[r * 64] = T0[r]; OAL[(16 + r) * 64] = T1[r]; } }
    {
        const LAS float* pr = PS + w * 520; const int sa = lane, sb = lane + 64; float ia = 0.f, ib = 0.f;
#pragma unroll
        for (int n = 4 * sa - 1; n <= 4 * sa + 3; ++n) if (n >= 0) ia += pr[n];
#pragma unroll
        for (int n = 4 * sb - 1; n <= 4 * sb + 3; ++n) ib += pr[n];
        const bool fa = (sa == 0), fb = (sb == 127); const float va = fa ? 1e4f : ia, vb = fb ? 1e4f : ib;
        IMPw[sa] = va; IMPw[sb] = vb; LDS_WAIT(); asm volatile("" ::: "memory");
        int ra = fa ? 0 : 1, rb = fb ? 0 : 1;
#pragma unroll 8
        for (int i = 0; i < 128; ++i) { const float v = IMPw[i]; ra += (v > va || (v == va && i < sa)) ? 1 : 0; rb += (v > vb || (v == vb && i < sb)) ? 1 : 0; }
        const unsigned long long ma = __ballot(ra < 16), mb = __ballot(rb < 16);
        if (lane == 0) { MASKS[w * 4] = ma; MASKS[w * 4 + 1] = mb; }
    }
    __syncthreads();
    const unsigned long long mk0 = MASKS[tl * 4], mk1 = MASKS[tl * 4 + 1];
    unsigned long long U0 = 0ull, U1 = 0ull;
#pragma unroll
    for (int x = 0; x < 8; ++x) { U0 |= MASKS[x * 4]; U1 |= MASKS[x * 4 + 1]; }
    {
        float m = -INFINITY, ls = 0.f; D0 = (f32x16){}; D1 = (f32x16){};
        const int t = PAST + tl; int cnt = 0;
#pragma unroll 1
        for (int s = 0; s <= 128; ++s) {
            const bool in_u = (s < 64) ? ((U0 >> s) & 1ull) : ((s < 128) ? ((U1 >> (s - 64)) & 1ull) : true);
            if (!in_u) continue;
            const bool selb = (s < 64) ? ((mk0 >> s) & 1ull) : ((s < 128) ? ((mk1 >> (s - 64)) & 1ull) : true);
            const int nh = (s < 128) ? 2 : 1;
            for (int hf = 0; hf < nh; ++hf, ++cnt) {
                if ((cnt & 7) != w) continue;
                const int hi = selb ? t : -1;
                if (s < 128) { const int page = ptab[s >> 1], slot = (s & 1) * 64 + hf * 32;
                    const float* kp = FIN(I_CACHE) + (((((size_t)l * NPHYS + page) * PAGE + slot) * 4 + 2) * 2 + kvh) * 64;
                    ASrc S{kp, kp + 128, nullptr, nullptr, 512, 32}; AS_TILE(S, s * 64 + hf * 32, 0, hi, true, false, m, ls, D0, D1, 0.f, 520); }
                else { const bf16* kp = WSP(bf16, WS_KVS) + ((((size_t)0 * SB + seq) * 2 + kvh) * ST) * 64;
                    ASrc S{nullptr, nullptr, kp, kp + (size_t)SB * 2 * ST * 64, 64, ST}; AS_TILE(S, PAST, 0, hi, true, false, m, ls, D0, D1, 0.f, 520); }
            }
        }
        AS_PUBLISH(m, ls, D0, D1);
        float mt = -INFINITY;
#pragma unroll
        for (int x = 0; x < 8; ++x) mt = fmaxf(mt, MRG[x * 34 * 64 + lane]);
        float lt = 0.f; f32x16 T0 = (f32x16){}, T1 = (f32x16){};
#pragma unroll 1
        for (int x = 0; x < 8; ++x) { const LAS float* mp = MRG + x * 34 * 64 + lane; const float mx_ = mp[0]; const float f = (mx_ == -INFINITY) ? 0.f : fexp2(mx_ - mt); lt += mp[64] * f;
#pragma unroll
            for (int r = 0; r < 16; ++r) { T0[r] += mp[(2 + r) * 64] * f; T1[r] += mp[(18 + r) * 64] * f; } }
        lt = xhalf_sum(lt); const float sc = (lt > 0.f ? 1.0f / lt : 0.f) * g1;
        if (w == 0) {
#pragma unroll
            for (int r = 0; r < 16; ++r) { OAL[r * 64] += T0[r] * sc; OAL[(16 + r) * 64] += T1[r] * sc; } }
    }
    {
        float m = -INFINITY, ls = 0.f; D0 = (f32x16){}; D1 = (f32x16){};
#pragma unroll 1
        for (int ti = w; ti < 17; ti += 8) {
            if (ti < 16) { const float* kp = FIN(I_CWIN) + (((((size_t)l * SB + seq) * WINB + ti * 32) * 2 + 0) * 2 + kvh) * 64;
                ASrc S{kp, kp + 128, nullptr, nullptr, 256, 32}; AS_TILE(S, ti * 32, tl, WINB + tl, true, false, m, ls, D0, D1, 0.f, 520); }
            else { const bf16* kp = WSP(bf16, WS_KVS) + ((((size_t)2 * SB + seq) * 2 + kvh) * ST) * 64;
                ASrc S{nullptr, nullptr, kp, kp + (size_t)SB * 2 * ST * 64, 64, ST}; AS_TILE(S, WINB, tl, WINB + tl, true, false, m, ls, D0, D1, 0.f, 520); }
        }
        AS_PUBLISH(m, ls, D0, D1);
        float mt = -INFINITY;
#pragma unroll
        for (int x = 0; x < 8; ++x) mt = fmaxf(mt, MRG[x * 34 * 64 + lane]);
        float lt = 0.f; f32x16 T0 = (f32x16){}, T1 = (f32x16){};
#pragma unroll 1
        for (int x = 0; x < 8; ++x) { const LAS float* mp = MRG + x * 34 * 64 + lane; const float mx_ = mp[0]; const float f = (mx_ == -INFINITY) ? 0.f : fexp2(mx_ - mt); lt += mp[64] * f;
#pragma unroll
            for (int r = 0; r < 16; ++r) { T0[r] += mp[(2 + r) * 64] * f; T1[r] += mp[(18 + r) * 64] * f; } }
        lt = xhalf_sum(lt); const float sc = (lt > 0.f ? 1.0f / lt : 0.f) * g2;
        if (w == 0) {
#pragma unroll
            for (int r = 0; r < 16; ++r) { OAL[r * 64] += T0[r] * sc; OAL[(16 + r) * 64] += T1[r] * sc; } }
    }
#undef AS_PUBLISH
    if (w == 0) {
        bf16* op = WSP(bf16, WS_OA) + row * 512 + head * 64;
#pragma unroll
        for (int r4 = 0; r4 < 4; ++r4) { float a_[4], b_[4];
#pragma unroll
            for (int x = 0; x < 4; ++x) { a_[x] = OAL[(4 * r4 + x) * 64]; b_[x] = OAL[(16 + 4 * r4 + x) * 64]; }
            v2u a, b; a.x = pk2(a_[0], a_[1]); a.y = pk2(a_[2], a_[3]); b.x = pk2(b_[0], b_[1]); b.y = pk2(b_[2], b_[3]);
            *(v2u*)(op + 8 * r4 + 4 * h_) = a; *(v2u*)(op + 32 + 8 * r4 + 4 * h_) = b; }
    }
}

#ifndef DBG_DUP
#define DBG_DUP 0
#endif
#if DBG_DUP == 1
#define AP_DUP_QK(NK) { f32x16 d_ = (f32x16){}; _Pragma("unroll") for (int kk = 0; kk < 4; ++kk) d_ = mfma32(NK[kk], qf[(kk + 1) & 3], d_); _Pragma("unroll") for (int r = 0; r < 16; ++r) s_[r] += zf * d_[r]; }
#else
#define AP_DUP_QK(NK)
#endif
#if DBG_DUP == 2
#define AP_DUP_EXP() { float acc_ = 0.f; _Pragma("unroll") for (int r = 0; r < 16; ++r) acc_ += fexp2(s_[r] * 0.5f - 3.0f); lsum += zf * acc_; }
#else
#define AP_DUP_EXP()
#endif
#if DBG_DUP == 3
#define AP_DUP_PV() { f32x16 e0_ = (f32x16){}, e1_ = (f32x16){}; _Pragma("unroll") for (int s2 = 0; s2 < 2; ++s2) { const bf16x8 pf_ = cvt_frag(s_, 1 - s2); const int rA_ = 16 * s2 + 4 * h_; \
        e0_ = mfma32(tr_frag(Vw, AS_RS, rA_ + 8, rA_, 16 * blk, lane), pf_, e0_); e1_ = mfma32(tr_frag(Vw, AS_RS, rA_ + 8, rA_, 32 + 16 * blk, lane), pf_, e1_); } D0 += e0_ * zf; D1 += e1_ * zf; }
#else
#define AP_DUP_PV()
#endif
constexpr int AP_WS = 14336, AP_V = 0, AP_PS = 4608, AP_IMP = AP_PS + 8 * 264 * 4, AP_MASK = AP_IMP + 256, AP_LIST = AP_MASK + 64;
static_assert(AP_LIST + 2 * 192 <= AP_WS && 8 * AP_WS <= RING_BYTES, "prompt attention LDS map");
__device__ __forceinline__ void attn_prompt_unit(Frame& F, int l, int unit) {
    const int lane = F.lane, w = F.wave;
    const int q = lane & 31, h_ = lane >> 5, blk = (lane >> 4) & 1, tl = q >> 2, hr = q & 3;
    const int seq = unit >> 7, kvh = (unit >> 6) & 1, qt = unit & 63, head = kvh * 4 + hr;
    const int t0w = qt * 64 + 8 * w, t = t0w + tl; const size_t row = (size_t)seq * PT + t;
    LAS unsigned char* Vw = F.lds + w * AP_WS + AP_V; LAS float* PS = (LAS float*)(F.lds + w * AP_WS + AP_PS); LAS float* IMPw = (LAS float*)(F.lds + w * AP_WS + AP_IMP);
    LAS unsigned long long* MASKS = (LAS unsigned long long*)(F.lds + w * AP_WS + AP_MASK); LAS unsigned short* LIST = (LAS unsigned short*)(F.lds + w * AP_WS + AP_LIST);
    __syncthreads();
    bf16x8 qf[4];
    { const bf16* qp = WSP(bf16, WS_QN) + row * 512 + head * 64 + 8 * h_;
#pragma unroll
      for (int kk = 0; kk < 4; ++kk) qf[kk] = *(const bf16x8*)(qp + 16 * kk); }
    const float* ngp = WSP(float, WS_NG) + row * 24 + head * 3; const float g0 = ngp[0], g1 = ngp[1], g2 = ngp[2];
    for (int i = lane; i < 8 * 264; i += 64) PS[i] = 0.f;
    const bf16* CKk = WSP(bf16, WS_CK) + ((size_t)32768 + (seq * 2 + kvh) * 256) * 64; const bf16* CKv = CKk + (size_t)CMP_ROWS_J * 64;
    const bf16* KS = WSP(bf16, WS_KVB) + ((((size_t)0 * PB + seq) * 2 + kvh) * PT) * 64; const bf16* VS = KS + (size_t)PB * 2 * PT * 64;
    const bf16* KW = KS + (size_t)2 * PB * 2 * PT * 64; const bf16* VW = KW + (size_t)PB * 2 * PT * 64;
    const int hiCmin = (t0w >= 31) ? ((t0w - 31) >> 4) : -1;
    const int hiC = (t >= 31) ? ((t - 31) >> 4) : -1; const int nmaxw = (t0w + 7 >= 31) ? ((t0w + 7 - 31) >> 4) : -1; const int ntc = (nmaxw >= 0) ? (nmaxw >> 5) + 1 : 0;
    f32x16 D0 = (f32x16){}, D1 = (f32x16){};
    LAS float* OAG = PS + lane;
    float m = -INFINITY, lsum = 0.f, invC = 0.f; unsigned long long mk0 = 0ull;
    const float zf = (F.G == 12345) ? 1.0f : 0.0f;
    bf16x8 nk0[4]; v4u nv0[4], nv1[4];
#define AP_LOADK(e_, NK) do { const int kd_ = (int)((e_) >> 12), ti_ = (int)((e_) & 0xfffu); const bf16* kb_ = (kd_ < 2 ? CKk : (kd_ == 2 ? KS : KW)) + (size_t)ti_ * 32 * 64; \
        const int ko_ = kd_ < 2 ? q * 64 + 8 * h_ : lane * 8, ks_ = kd_ < 2 ? 16 : 512;     \
        _Pragma("unroll") for (int kk = 0; kk < 4; ++kk) NK[kk] = *(const bf16x8*)(kb_ + ko_ + ks_ * kk); } while (0)
#define AP_LOADV(e_, NV) do { const int kd_ = (int)((e_) >> 12), ti_ = (int)((e_) & 0xfffu); const bf16* vb_ = (kd_ < 2 ? CKv : (kd_ == 2 ? VS : VW)) + (size_t)ti_ * 32 * 64; \
        _Pragma("unroll") for (int x = 0; x < 4; ++x) NV[x] = *(const v4u*)(vb_ + 512 * x + lane * 8); } while (0)
#define AP_LOADT(e_, NK, NV) do { AP_LOADK(e_, NK); AP_LOADV(e_, NV); } while (0)
#define AP_STEP(i_, n_, NK, NV, NVN, EC, ECN) do { \
        const unsigned e_ = EC; const int kind = (int)(e_ >> 12), ti = (int)(e_ & 0xfffu); \
        if (kind == 1) { _Pragma("unroll") for (int x = 0; x < 4; ++x) *(LAS v4u*)(Vw + (8 * x + (lane >> 3)) * AS_RS + (lane & 7) * 16) = NV[x]; }     \
        f32x16 s_ = (f32x16){}; \
        _Pragma("unroll") for (int kk = 0; kk < 4; ++kk) s_ = mfma32(NK[kk], qf[kk], s_); \
        AP_DUP_QK(NK) \
          \
        if ((i_) + 1 < (n_)) { AP_LOADK(ECN, NK); AP_LOADV(ECN, NVN); if ((i_) + 2 < (n_)) EC = (unsigned)__builtin_amdgcn_readfirstlane((int)LIST[(i_) + 2]); } \
        if (kind != cur_kind) { \
            if (cur_kind == 0) { const float lt_ = xhalf_sum(lsum); invC = lt_ > 0.f ? 1.0f / lt_ : 0.f; } \
            else if (cur_kind == 2) { const float lt_ = xhalf_sum(lsum); const float sc_ = (lt_ > 0.f ? 1.0f / lt_ : 0.f) * g1; \
                _Pragma("unroll") for (int r = 0; r < 16; ++r) { OAG[r * 64] += D0[r] * sc_; OAG[(16 + r) * 64] += D1[r] * sc_; } } \
            if (kind != 1) m = -INFINITY; lsum = 0.f; D0 = (f32x16){}; D1 = (f32x16){}; cur_kind = kind; } \
        const int kb = ti * 32; int lo, hi; \
        if (kind < 2) { lo = 0; hi = hiC; } else if (kind == 2) { lo = 0; hi = ((mk0 >> (ti >> 1)) & 1ull) ? t : -1; } else { lo = t - WINB; hi = t; } \
          \
        const bool interior = (kind < 2) ? (hiCmin >= 0 && kb + 31 <= hiCmin) : ((kind == 2) ? (kb + 31 <= t0w) : (kb >= t0w + 7 - WINB && kb + 31 <= t0w)); \
        float tmax_ = -INFINITY, mu_, mn_; \
        if (interior) { const bool on_ = hi >= 0; \
            _Pragma("unroll") for (int r = 0; r < 16; ++r) tmax_ = fmaxf(tmax_, s_[r]); \
            tmax_ = on_ ? tmax_ : -INFINITY; tmax_ = xhalf_max(tmax_); \
            mn_ = fmaxf(m, tmax_); mu_ = (mn_ == -INFINITY) ? 0.f : mn_; const float mr_ = on_ ? mu_ : INFINITY; \
            _Pragma("unroll") for (int r = 0; r < 16; ++r) s_[r] = fexp2(s_[r] - mr_); \
        } else { \
            _Pragma("unroll") for (int r = 0; r < 16; ++r) { const int key_ = kb + (r & 3) + 8 * (r >> 2) + 4 * h_; s_[r] = (key_ >= lo && key_ <= hi) ? s_[r] : -INFINITY; tmax_ = fmaxf(tmax_, s_[r]); } \
            tmax_ = xhalf_max(tmax_); \
            mn_ = fmaxf(m, tmax_); mu_ = (mn_ == -INFINITY) ? 0.f : mn_; \
            _Pragma("unroll") for (int r = 0; r < 16; ++r) s_[r] = fexp2(s_[r] - mu_); \
        } \
        AP_DUP_EXP() \
        const float al_ = fexp2(m - mu_); float ps_ = 0.f; \
        _Pragma("unroll") for (int r = 0; r < 16; ++r) ps_ += s_[r]; \
        lsum = lsum * al_ + ps_; m = mn_; \
        if (kind >= 2) { if (__ballot(al_ != 1.0f) != 0ull) { D0 *= al_; D1 *= al_; } \
            const bf16x8 pf0_ = cvt_frag(s_, 0), pf1_ = cvt_frag(s_, 1); \
            D0 = mfma32(__builtin_bit_cast(bf16x8, NV[0]), pf0_, D0); D1 = mfma32(__builtin_bit_cast(bf16x8, NV[2]), pf0_, D1); D0 = mfma32(__builtin_bit_cast(bf16x8, NV[1]), pf1_, D0); D1 = mfma32(__builtin_bit_cast(bf16x8, NV[3]), pf1_, D1); \
        } else if (kind == 1) { if (__ballot(al_ != 1.0f) != 0ull) { D0 *= al_; D1 *= al_; } asm volatile("" ::: "memory");   \
            { const bf16x8 va0_ = tr_frag(Vw, AS_RS, 4 * h_, 4 * h_ + 8, 16 * blk, lane), va1_ = tr_frag(Vw, AS_RS, 4 * h_, 4 * h_ + 8, 32 + 16 * blk, lane), \
                           vb0_ = tr_frag(Vw, AS_RS, 16 + 4 * h_, 24 + 4 * h_, 16 * blk, lane), vb1_ = tr_frag(Vw, AS_RS, 16 + 4 * h_, 24 + 4 * h_, 32 + 16 * blk, lane);   \
              const bf16x8 pf0_ = cvt_frag(s_, 0), pf1_ = cvt_frag(s_, 1); \
              D0 = mfma32(va0_, pf0_, D0); D1 = mfma32(va1_, pf0_, D1); D0 = mfma32(vb0_, pf1_, D0); D1 = mfma32(vb1_, pf1_, D1); } \
            AP_DUP_PV() \
            asm volatile("" ::: "memory"); } \
        if (kind == 1) { _Pragma("unroll") for (int r = 0; r < 16; ++r) { const int n2_ = kb + (r & 3) + 8 * (r >> 2) + 4 * h_; float a_ = s_[r] * invC; a_ += __shfl_xor(a_, 1); a_ += __shfl_xor(a_, 2); if (hr == 0) PS[tl * 264 + n2_] = a_; } } \
    } while (0)
#define AP_RUN(N_) do { const int n_ = (N_); unsigned ec0_ = 0u, ec1_ = 0u;                  \
      if (n_ > 0) { ec0_ = (unsigned)__builtin_amdgcn_readfirstlane((int)LIST[0]); AP_LOADK(ec0_, nk0); AP_LOADV(ec0_, nv0); } \
      if (n_ > 1) { ec1_ = (unsigned)__builtin_amdgcn_readfirstlane((int)LIST[1]); } \
      _Pragma("unroll 1") for (int i_ = 0; i_ < n_; i_ += 2) { AP_STEP(i_, n_, nk0, nv0, nv1, ec0_, ec1_); if (i_ + 1 < n_) AP_STEP(i_ + 1, n_, nk0, nv1, nv0, ec1_, ec0_); } } while (0)
    int cur_kind = -1;
    if (lane < 2 * ntc) LIST[lane] = (unsigned short)(((lane >= ntc ? 1u : 0u) << 12) | (unsigned)(lane >= ntc ? lane - ntc : lane));
    LDS_WAIT(); asm volatile("" ::: "memory");
    AP_RUN(2 * ntc);
    { const float sc = (cur_kind == 1) ? g0 * invC : 0.f; D0 *= sc; D1 *= sc; }
    LDS_WAIT(); asm volatile("" ::: "memory");
#pragma unroll 1
    for (int tk = 0; tk < 8; ++tk) {
        const LAS float* pr = PS + tk * 264; const int s = lane; float imp = 0.f;
#pragma unroll
        for (int n = 4 * s - 1; n <= 4 * s + 3; ++n) if (n >= 0) imp += pr[n];
        const bool forced = (s == 0) || (s == qt) || (s == qt - 1), avail = s <= qt;
        const unsigned key = avail ? (forced ? 0x7fffffffu : (imp > 0.f ? __float_as_uint(imp) + 1u : 1u)) : 0u;
        unsigned thr = 0u;
#pragma unroll
        for (int bit = 30; bit >= 0; --bit) { const unsigned cand = thr | (1u << bit); const int cnt = __popcll(__ballot(key >= cand)); thr = (cnt >= 16) ? cand : thr; }
        const unsigned long long gt = __ballot(key > thr), eq = __ballot(key == thr); const int need = 16 - __popcll(gt);
        const int below = __builtin_amdgcn_mbcnt_hi((unsigned)(eq >> 32), __builtin_amdgcn_mbcnt_lo((unsigned)eq, 0u));
        const unsigned long long mk = gt | __ballot(key == thr && below < need);
        if (lane == 0) MASKS[tk] = mk;
        LDS_WAIT(); asm volatile("" ::: "memory");
    }
#pragma unroll
    for (int r = 0; r < 16; ++r) { OAG[r * 64] = D0[r]; OAG[(16 + r) * 64] = D1[r]; }
    mk0 = MASKS[tl]; unsigned long long wu = 0ull;
#pragma unroll
    for (int i = 0; i < 8; ++i) wu |= MASKS[i];
    wu &= (qt >= 63) ? ~0ull : ((1ull << (qt + 1)) - 1ull);
    const int nsel = 2 * __popcll(wu); const int tiLo = (t0w > WINB) ? ((t0w - WINB) >> 5) : 0, tiHi = (t0w + 7) >> 5, nwin = tiHi - tiLo + 1;
    if ((wu >> lane) & 1ull) { const int pos = 2 * __popcll(wu & ((1ull << lane) - 1ull)); LIST[pos] = (unsigned short)((2u << 12) | (unsigned)(2 * lane)); LIST[pos + 1] = (unsigned short)((2u << 12) | (unsigned)(2 * lane + 1)); }
    if (lane < nwin) LIST[nsel + lane] = (unsigned short)((3u << 12) | (unsigned)(tiLo + lane));
    LDS_WAIT(); asm volatile("" ::: "memory");
#ifdef DBG_COUNT
    if (lane == 0) { unsigned* CNT = (unsigned*)(F.ws + WS_CTL) + 3000; atomicAdd(CNT + 0, (unsigned)nsel); atomicAdd(CNT + 1, (unsigned)nwin); atomicAdd(CNT + 2, (unsigned)(2 * ntc)); atomicAdd(CNT + 3, 1u); }
#endif
    cur_kind = -1;
    AP_RUN(nsel + nwin);
    const float ltw = xhalf_sum(lsum); const float scw = (ltw > 0.f ? 1.0f / ltw : 0.f) * g2;
#undef AP_RUN
#undef AP_STEP
#undef AP_LOADT
#undef AP_LOADK
#undef AP_LOADV
    {
        bf16* op = WSP(bf16, WS_OA) + row * 512 + head * 64;
#pragma unroll
        for (int r4 = 0; r4 < 4; ++r4) { float a_[4], b_[4];
#pragma unroll
            for (int x = 0; x < 4; ++x) { a_[x] = OAG[(4 * r4 + x) * 64] + D0[4 * r4 + x] * scw; b_[x] = OAG[(16 + 4 * r4 + x) * 64] + D1[4 * r4 + x] * scw; }
            v2u a, b; a.x = pk2(a_[0], a_[1]); a.y = pk2(a_[2], a_[3]); b.x = pk2(b_[0], b_[1]); b.y = pk2(b_[2], b_[3]);
            *(v2u*)(op + 8 * r4 + 4 * h_) = a; *(v2u*)(op + 32 + 8 * r4 + 4 * h_) = b; }
    }
}
#undef AS_TILE

#ifdef DBG_CHECK
__device__ __forceinline__ unsigned dbg_rand(unsigned x) { x ^= x >> 16; x *= 0x7feb352du; x ^= x >> 15; x *= 0x846ca68bu; x ^= x >> 16; return x; }
__device__ __forceinline__ bool dbg_bad(float got, float exp_, float rtol, float atol) { return !(fabsf(got - exp_) <= rtol * fabsf(exp_) + atol); }
__device__ __forceinline__ float bfr(float x) { return __uint_as_float(pk2(x, 0.f) << 16); }
__device__ __forceinline__ int dbg_row(unsigned r) { const unsigned k = r % 20u; if (k == 0) return (int)(PM + (r >> 8) % SM); if (k == 1) return (int)(((r >> 8) % PB) * PT + ((r >> 12) % 8)); if (k == 2) return (int)(((r >> 8) % PB) * PT + PT - 1 - ((r >> 12) % 8)); return (int)((r >> 5) % PM); }
__device__ __forceinline__ float dbg_rs(const Frame& F, int row, int lane) { const float* xr = xrow_in(F, 0, row); float ss = 0.f; for (int d = lane; d < DM; d += 64) ss += xr[d] * xr[d]; return 1.0f / sqrtf(wave_sum(ss) * (1.0f / DM) + EPS); }
__device__ __forceinline__ float dbg_h(const Frame& F, int row, int d, float rs) { const float* mod = WSP(float, WS_MOD) + (size_t)row_bb(row) * 6144; return bfr(xrow_in(F, 0, row)[d] * rs * FIN(I_N1G)[d] * (1.0f + mod[1024 + d]) + mod[d]); }

__device__ __forceinline__ void dbg_check_phase(Frame& F) {
    const int gw = F.bid * NWAVES + F.wave, NGW = F.G * NWAVES, lane = F.lane;
    unsigned* CNT = (unsigned*)(F.ws + WS_CTL) + 3000;
    LAS float* L = (LAS float*)(F.lds + F.wave * 16384);
#define DBG_FLAG(ch, cond) do { if (__any(cond) && lane == 0) atomicAdd(CNT + (ch), 1u); } while (0)
    for (int s = gw; s < 1536; s += NGW) {
        const unsigned r = dbg_rand(1000u + s); const int row = dbg_row(r); const float rs = dbg_rs(F, row, lane); const int kind = s % 6;
        const bool isp = row < PM; const int b = isp ? (row >> 12) : ((row - PM) >> 3), t = isp ? (row & (PT - 1)) : ((row - PM) & 7);
#define DBG_U(col, dst) do { float a_ = 0.f; for (int d_ = lane; d_ < DM; d_ += 64) a_ += dbg_h(F, row, d_, rs) * bfr(FIN(I_WIN)[(size_t)d_ * D_IN + (col)]); dst = wave_sum(a_); } while (0)
        if (kind == 0) {
            const int c = (r >> 3) % 768, j = c >> 7, k = (c >> 6) & 1, dd = c & 63; float u; DBG_U(O_NKV + c, u); bool bad = false;
            if (j < 4) bad = dbg_bad(F.out[(isp ? OUT_ROWS_P + (size_t)row * 512 : OUT_ROWS_S + (size_t)(row - PM) * 512) + c], u, 0.01f, 0.01f);
            else if (isp) { if (t >= PT - WINB) bad = dbg_bad(F.out[OUT_WIN_P + ((size_t)b * WINB + (t - (PT - WINB))) * 256 + (c - 512)], u, 0.01f, 0.01f); }
            else bad = dbg_bad(F.out[OUT_WIN_S + ((size_t)b * WINB + (WINB - ST) + t) * 256 + (c - 512)], u, 0.01f, 0.01f);
            if (isp) { if (j < 2) bad = bad || dbg_bad(bf1(WSP(bf16, WS_ACMP)[((size_t)j * CMP_ROWS_J + 32768 + (b * 2 + k) * 256 + (t >> 4)) * 1024 + (t & 15) * 64 + dd]), u, 0.01f, 0.01f);
                       else bad = bad || dbg_bad(bf1(WSP(bf16, WS_KVB)[((((size_t)(j - 2) * PB + b) * 2 + k) * PT + t) * 64 + dd]), u, 0.01f, 0.01f); }
            else if (j >= 2) bad = bad || dbg_bad(bf1(WSP(bf16, WS_KVS)[((((size_t)(j - 2) * SB + b) * 2 + k) * ST + t) * 64 + dd]), u, 0.01f, 0.01f);
            DBG_FLAG(0, bad);
        } else if (kind == 1) {
            const int gi = (r >> 3) % 24, c5 = (r >> 8) % 512, cm = (r >> 8) % 3072; float u0, u1, u2, u3; DBG_U(O_NG + gi, u0); DBG_U(O_RX + c5, u1); DBG_U(O_RGATE + c5, u2); DBG_U(O_MG + cm, u3);
            bool bad = dbg_bad(WSP(float, WS_NG)[(size_t)row * 24 + gi], 1.0f / (1.0f + expf(-u0)), 0.01f, 0.005f);
            bad = bad || dbg_bad(WSP(float, WS_RX)[(size_t)row * 512 + c5], u1, 0.01f, 0.01f);
            bad = bad || dbg_bad(bf1(WSP(bf16, WS_GG)[(size_t)row * 512 + c5]), gelu_tanh(u2), 0.02f, 0.01f);
            bad = bad || dbg_bad(bf1(WSP(bf16, WS_MGS)[(size_t)row * 3072 + cm]), 1.0f / (1.0f + expf(-u3)), 0.01f, 0.005f);
            DBG_FLAG(1, bad);
        } else if (kind == 2) {
            const int head = (r >> 13) % 4, dim = (r >> 16) % 64, c5 = (r >> 3) % 512; float x1, x2, uv, ug, uq; DBG_U(O_RQ + head * 128 + dim, x1); DBG_U(O_RQ + head * 128 + 64 + dim, x2); DBG_U(O_RV + c5, uv); DBG_U(O_RG + c5, ug); DBG_U(O_NQ + c5, uq);
            const float pos = (float)(isp ? t : PAST + t); const float ang = pos * (float)pow(10000.0, -(double)dim / 64.0); float sn, cs; sincos_acc(ang, sn, cs);
            const bf16* RQ = WSP(bf16, WS_RQ);
            bool bad = dbg_bad(bf1(RQ[(size_t)row * 512 + head * 128 + dim]), x1 * cs - x2 * sn, 0.02f, 0.02f) || dbg_bad(bf1(RQ[(size_t)row * 512 + head * 128 + 64 + dim]), x1 * sn + x2 * cs, 0.02f, 0.02f);
            bad = bad || dbg_bad(bf1(RQ[(size_t)2 * MT * 512 + (size_t)row * 512 + c5]), uv, 0.01f, 0.01f) || dbg_bad(bf1(RQ[(size_t)3 * MT * 512 + (size_t)row * 512 + c5]), ug, 0.01f, 0.01f);
            bad = bad || dbg_bad(bf1(WSP(bf16, WS_QN)[(size_t)row * 512 + c5]), uq * QSCALE, 0.01f, 0.005f);
            DBG_FLAG(2, bad);
        }
#undef DBG_U
    }
    for (int s = gw; s < 128; s += NGW) {
        const unsigned r = dbg_rand(3000u + s); const int j = r & 1; const bool smp = ((r >> 1) & 3) != 0;
        const int grp = smp ? (int)((r >> 3) % 64) : (int)((r >> 3) % 8), nmax = smp ? 511 : 255; int n = (r >> 10) % nmax; if (((r >> 20) & 7) == 0) n = nmax - 1;
        const size_t rj = smp ? (size_t)grp * 512 + n : (size_t)32768 + grp * 256 + n;
        const bf16* A = WSP(bf16, WS_ACMP) + ((size_t)j * CMP_ROWS_J + rj) * 1024;
        const float* w1 = FIN(I_W1) + (size_t)j * 2048 * 128; const float* pe = FIN(I_PE) + j * 2048;
        for (int hh = 0; hh < 2; ++hh) { const int h = lane + 64 * hh; float a = FIN(I_B1)[j * 128 + h];
            for (int i = 0; i < 1024; ++i) a += (bf1(A[i]) + pe[i]) * w1[(size_t)i * 128 + h] + (bf1(A[1024 + i]) + pe[1024 + i]) * w1[(size_t)(1024 + i) * 128 + h];
            L[h] = gelu_tanh(a); }
        LDS_WAIT(); asm volatile("" ::: "memory");
        float o = 0.f; for (int h = 0; h < 128; ++h) o += L[h] * FIN(I_W2)[((size_t)j * 128 + h) * 64 + lane];
        const float got = bf1(WSP(bf16, WS_CK)[((size_t)j * CMP_ROWS_J + rj) * 64 + lane]);
        { const bool bd = dbg_bad(got, o, 0.05f, 0.03f); const unsigned long long mk = __ballot(bd); if (lane == 0 && mk) atomicAdd(CNT + 3, (unsigned)__popcll(mk)); }
        LDS_WAIT(); asm volatile("" ::: "memory");
    }
    for (int s = gw; s < 128; s += NGW) {
        const unsigned r = dbg_rand(3500u + s); const int j = r & 1; const bool smp = ((r >> 1) & 3) != 0;
        const int grp = smp ? (int)((r >> 3) % 64) : (int)((r >> 3) % 8), nmax = smp ? 511 : 255; const int n = (r >> 10) % nmax;
        const size_t rj = smp ? (size_t)grp * 512 + n : (size_t)32768 + grp * 256 + n, row = (size_t)j * CMP_ROWS_J + rj;
        const bf16* A = WSP(bf16, WS_ACMP) + row * 1024; const float* w1 = FIN(I_W1) + (size_t)j * 2048 * 128; const bf16* LH = WSP(bf16, WS_LH);
        unsigned nb = 0;
        for (int hh = 0; hh < 2; ++hh) { const int h = lane + 64 * hh; float lo = 0.f, hi = 0.f;
            for (int i = 0; i < 1024; ++i) { const float av = bf1(A[i]); lo += av * bfr(w1[(size_t)i * 128 + h]); hi += av * bfr(w1[(size_t)(1024 + i) * 128 + h]); }
            const bool bd = dbg_bad(bf1(LH[row * 256 + h]), lo, 0.02f, 0.02f) || dbg_bad(bf1(LH[row * 256 + 128 + h]), hi, 0.02f, 0.02f); nb += (unsigned)__popcll(__ballot(bd)); }
        if (lane == 0 && nb) atomicAdd(CNT + 9, nb);
        for (int hh = 0; hh < 2; ++hh) { const int h = lane + 64 * hh; L[h] = gelu_tanh(bf1(LH[row * 256 + h]) + bf1(LH[(row + 1) * 256 + 128 + h]) + WSP(float, WS_SMALLW + SW_CB)[j * 128 + h]); }
        LDS_WAIT(); asm volatile("" ::: "memory");
        float o = 0.f; for (int h = 0; h < 128; ++h) o += bfr(L[h]) * bfr(FIN(I_W2)[((size_t)j * 128 + h) * 64 + lane]);
        { const bool bd = dbg_bad(bf1(WSP(bf16, WS_CK)[row * 64 + lane]), o, 0.03f, 0.01f); const unsigned long long mk = __ballot(bd); if (lane == 0 && mk) atomicAdd(CNT + 11, (unsigned)__popcll(mk)); }
        LDS_WAIT(); asm volatile("" ::: "memory");
    }
    for (int s = gw; s < 64; s += NGW) {
        const unsigned r = dbg_rand(3700u + s); const int j = r & 1, half = (r >> 1) & 1, h = (r >> 2) % 128; const bf16* W1T = WSP(bf16, WS_SMALLW + SW_W1T) + ((size_t)j * 256 + half * 128 + h) * 1024;
        const float* w1 = FIN(I_W1) + ((size_t)j * 32 + half * 16) * 64 * 128 + h; unsigned nb = 0;
        for (int k = lane; k < 1024; k += 64) nb += (unsigned)__popcll(__ballot(dbg_bad(bf1(W1T[k]), w1[(size_t)k * 128], 0.01f, 0.0001f)));
        if (lane == 0 && nb) atomicAdd(CNT + 12, nb);
        const bool smp = ((r >> 9) & 3) != 0; const int grp = smp ? (int)((r >> 11) % 64) : (int)((r >> 11) % 8), n = (r >> 17) % (smp ? 511 : 255);
        const size_t row = (size_t)j * CMP_ROWS_J + (smp ? (size_t)grp * 512 + n : (size_t)32768 + grp * 256 + n); const bf16* A = WSP(bf16, WS_ACMP) + row * 1024;
        float a = 0.f; for (int k = lane; k < 1024; k += 64) a += bf1(A[k]) * bf1(W1T[k]); a = wave_sum(a);
        DBG_FLAG(13, dbg_bad(bf1(WSP(bf16, WS_LH)[row * 256 + half * 128 + h]), a, 0.02f, 0.02f));
    }
    for (int s = gw; s < 4; s += NGW) {
        const int j = s >> 1, h = (s & 1) * 64 + lane; const float* w1 = FIN(I_W1) + (size_t)j * 2048 * 128; const float* pe = FIN(I_PE) + j * 2048;
        float a = FIN(I_B1)[j * 128 + h]; for (int i = 0; i < 2048; ++i) a += pe[i] * w1[(size_t)i * 128 + h];
        const unsigned long long mk = __ballot(dbg_bad(WSP(float, WS_SMALLW + SW_CB)[j * 128 + h], a, 0.001f, 0.0005f)); if (lane == 0 && mk) atomicAdd(CNT + 10, (unsigned)__popcll(mk));
    }
    for (int s = gw; s < 96; s += NGW) {
        const unsigned r = dbg_rand(4000u + s); const bool smp = (s % 3) == 2;
        int seq, kvh = (r >> 4) & 1, t, tl = 0; size_t row;
        if (smp) { seq = (r >> 5) % SB; tl = (r >> 10) % ST; t = PAST + tl; row = (size_t)PM + seq * ST + tl; }
        else { seq = (r >> 5) % PB; const unsigned k = (r >> 8) % 8u; t = (k == 0) ? (int)((r >> 12) % 40) : (k == 1) ? PT - 1 - (int)((r >> 12) % 70) : (int)((r >> 12) % PT); row = (size_t)seq * PT + t; }
        const int N = smp ? 511 : 255, NS = smp ? 129 : 64, cur = t >> 6;
        LAS float* Q = L; LAS float* SC = L + 256; LAS float* PSUM = L + 256 + 2048; LAS float* OUT = L + 256 + 2048 + 512;
        for (int i = lane; i < 256; i += 64) Q[i] = bf1(WSP(bf16, WS_QN)[row * 512 + (kvh * 4 + (i >> 6)) * 64 + (i & 63)]);
        for (int i = lane; i < 768; i += 64) OUT[i] = 0.f;
        LDS_WAIT(); asm volatile("" ::: "memory");
        const bf16* CKk = WSP(bf16, WS_CK) + (smp ? (size_t)(seq * 2 + kvh) * 512 : (size_t)32768 + (seq * 2 + kvh) * 256) * 64; const bf16* CKv = CKk + (size_t)CMP_ROWS_J * 64;
        const int nvis = smp ? 511 : ((t >= 31) ? ((t - 31) >> 4) + 1 : 0);
        for (int i = lane; i < 512; i += 64) PSUM[i] = 0.f;
        for (int hr = 0; hr < 4; ++hr) {
            float mx = -INFINITY; for (int n = lane; n < nvis; n += 64) { float a = 0.f; for (int d = 0; d < 64; ++d) a += Q[hr * 64 + d] * bf1(CKk[(size_t)n * 64 + d]); SC[n] = a; mx = fmaxf(mx, a); }
            for (int o = 1; o < 64; o <<= 1) mx = fmaxf(mx, __shfl_xor(mx, o));
            float den = 0.f; for (int n = lane; n < nvis; n += 64) { const float e = exp2f(SC[n] - mx); SC[n] = e; den += e; } den = wave_sum(den);
            LDS_WAIT(); asm volatile("" ::: "memory");
            if (nvis > 0) { float o = 0.f; for (int n = 0; n < nvis; ++n) o += SC[n] * bf1(CKv[(size_t)n * 64 + lane]); OUT[hr * 64 + lane] = o / den;
                for (int n = lane; n < nvis; n += 64) PSUM[n] += SC[n] / den; }
            LDS_WAIT(); asm volatile("" ::: "memory");
        }
        LAS float* IMP = SC; LAS float* SELB = SC + 256;
        for (int sblk = lane; sblk < NS; sblk += 64) { float imp = 0.f; for (int n = 4 * sblk - 1; n <= 4 * sblk + 3; ++n) if (n >= 0 && n < N) imp += PSUM[n];
            const bool forced = sblk == 0 || sblk == cur || sblk == cur - 1, avail = sblk * 64 <= t; IMP[sblk] = avail ? (forced ? 1e4f : imp) : -1e4f; SELB[sblk] = 0.f; }
        LDS_WAIT(); asm volatile("" ::: "memory");
        for (int pick = 0; pick < 16 && pick < NS; ++pick) { float bv = -INFINITY; int bi = 1 << 30;
            for (int sblk = lane; sblk < NS; sblk += 64) { const float v = (SELB[sblk] != 0.f) ? -INFINITY : IMP[sblk]; if (v > bv || (v == bv && sblk < bi)) { bv = v; bi = sblk; } }
            for (int o = 1; o < 64; o <<= 1) { const float ov = __shfl_xor(bv, o); const int oi = __shfl_xor(bi, o); if (ov > bv || (ov == bv && oi < bi)) { bv = ov; bi = oi; } }
            if (lane == 0) SELB[bi] = 1.f; LDS_WAIT(); asm volatile("" ::: "memory"); }
        for (int br = 1; br < 3; ++br) for (int hr = 0; hr < 4; ++hr) {
            float mx = -INFINITY, den = 0.f, o = 0.f;
            const int plo = (br == 1) ? 0 : (t - WINB < 0 ? 0 : t - WINB), phi = t;
            for (int p = plo; p <= phi; ++p) {
                if (br == 1 && SELB[p >> 6] == 0.f) { p |= 63; continue; }
                const float* kf = nullptr; const bf16* kb = nullptr; const float* vf = nullptr; const bf16* vb = nullptr;
                const int jk = (br == 1) ? 2 : 4;
                if (!smp) { kb = WSP(bf16, WS_KVB) + ((((size_t)(jk - 2) * PB + seq) * 2 + kvh) * PT + p) * 64; vb = kb + (size_t)PB * 2 * PT * 64; }
                else if (p >= PAST) { kb = WSP(bf16, WS_KVS) + ((((size_t)(jk - 2) * SB + seq) * 2 + kvh) * ST + (p - PAST)) * 64; vb = kb + (size_t)SB * 2 * ST * 64; }
                else if (br == 1) { const int page = ((const int*)F.a->in[I_PT])[seq * NPG + (p >> 7)]; kf = FIN(I_CACHE) + ((((size_t)page * PAGE + (p & 127)) * 4 + 2) * 2 + kvh) * 64; vf = kf + 128; }
                else { kf = FIN(I_CWIN) + ((((size_t)seq * WINB + (p - (PAST - WINB))) * 2 + 0) * 2 + kvh) * 64; vf = kf + 128; }
                float a = 0.f; for (int d = 0; d < 64; ++d) a += Q[hr * 64 + d] * (kb ? bf1(kb[d]) : bfr(kf[d]));
                const float vv = vb ? bf1(vb[lane]) : bfr(vf[lane]);
                const float mn = fmaxf(mx, a), al = exp2f(mx - mn), e = exp2f(a - mn); den = den * al + e; o = o * al + e * vv; mx = mn;
            }
            OUT[(br * 4 + hr) * 64 + lane] = (den > 0.f) ? o / den : 0.f;
        }
        LDS_WAIT(); asm volatile("" ::: "memory");
        bool bad = false;
        for (int hr = 0; hr < 4; ++hr) { const float* ng = WSP(float, WS_NG) + row * 24 + (kvh * 4 + hr) * 3;
            const float e = ng[0] * OUT[(0 * 4 + hr) * 64 + lane] + ng[1] * OUT[(1 * 4 + hr) * 64 + lane] + ng[2] * OUT[(2 * 4 + hr) * 64 + lane];
            bad = bad || dbg_bad(bf1(WSP(bf16, WS_OA)[row * 512 + (kvh * 4 + hr) * 64 + lane]), e, 0.04f, 0.004f); }
        DBG_FLAG(smp ? 5 : 4, bad);
        LDS_WAIT(); asm volatile("" ::: "memory");
    }
    for (int s = gw; s < 96; s += NGW) {
        const unsigned r = dbg_rand(6000u + s); const bool smp = (s % 3) == 2; const int h = (r >> 3) & 3; const float lg = ret_log_g(h);
        const bf16* RQ = WSP(bf16, WS_RQ); const bf16* RK = RQ + (size_t)MT * 512; const bf16* RV = RQ + (size_t)2 * MT * 512; const bf16* RG = RQ + (size_t)3 * MT * 512;
        int seq, t; size_t row0; if (smp) { seq = (r >> 5) % SB; t = (r >> 10) % ST; row0 = (size_t)PM + seq * ST; } else { seq = (r >> 5) % PB; const unsigned k = (r >> 8) % 4u; t = (k == 0) ? (int)((r >> 12) % 300) : (int)((r >> 12) % PT); row0 = (size_t)seq * PT; }
        float o0 = 0.f, o1 = 0.f;
        for (int d = lane; d < 128; d += 64) L[d] = bf1(RQ[(row0 + t) * 512 + h * 128 + d]);
        LDS_WAIT(); asm volatile("" ::: "memory");
        for (int j = 0; j <= t; ++j) { float a = 0.f; for (int d = 0; d < 128; ++d) a += L[d] * bf1(RK[(row0 + j) * 512 + h * 128 + d]);
            a *= expf((float)(t - j) * lg); o0 += a * bf1(RV[(row0 + j) * 512 + h * 128 + lane]); o1 += a * bf1(RV[(row0 + j) * 512 + h * 128 + 64 + lane]); }
        if (smp) { const float* S0 = FIN(I_SRET) + (((size_t)0 * SB + seq) * 4 + h) * 16384; const float cr = expf((float)(t + 1) * lg);
            for (int d = 0; d < 128; ++d) { o0 += L[d] * S0[d * 128 + lane] * cr; o1 += L[d] * S0[d * 128 + 64 + lane] * cr; } }
        const float mean = wave_sum(o0 + o1) * (1.0f / 128.0f); const float var = wave_sum((o0 - mean) * (o0 - mean) + (o1 - mean) * (o1 - mean)) * (1.0f / 128.0f), rstd = 1.0f / sqrtf(var + EPS);
        const float* GN = FIN(I_GNG) + h * 128; const bf16* OR_ = WSP(bf16, WS_OA) + (size_t)MT * 512;
        const float g0 = bf1(RG[(row0 + t) * 512 + h * 128 + lane]), g1 = bf1(RG[(row0 + t) * 512 + h * 128 + 64 + lane]);
        const float e0 = (o0 - mean) * rstd * GN[lane] * (g0 / (1.0f + expf(-g0))), e1 = (o1 - mean) * rstd * GN[64 + lane] * (g1 / (1.0f + expf(-g1)));
        DBG_FLAG(6, dbg_bad(bf1(OR_[(row0 + t) * 512 + h * 128 + lane]), e0, 0.04f, 0.02f) || dbg_bad(bf1(OR_[(row0 + t) * 512 + h * 128 + 64 + lane]), e1, 0.04f, 0.02f));
        const int d = (r >> 20) % 128, T = smp ? ST : PT; float s0 = 0.f, s1 = 0.f;
        for (int j = 0; j < T; ++j) { const float kk = bf1(RK[(row0 + j) * 512 + h * 128 + d]) * expf((float)(T - 1 - j) * lg); s0 += kk * bf1(RV[(row0 + j) * 512 + h * 128 + lane]); s1 += kk * bf1(RV[(row0 + j) * 512 + h * 128 + 64 + lane]); }
        const float* SO;
        if (smp) { const float* S0 = FIN(I_SRET) + (((size_t)0 * SB + seq) * 4 + h) * 16384; const float g8 = expf(8.0f * lg); s0 += g8 * S0[d * 128 + lane]; s1 += g8 * S0[d * 128 + 64 + lane]; SO = F.out + OUT_RET_S + (((size_t)0 * SB + seq) * 4 + h) * 16384; }
        else SO = F.out + OUT_RET_P + (((size_t)0 * PB + seq) * 4 + h) * 16384;
        DBG_FLAG(7, dbg_bad(SO[d * 128 + lane], s0, 0.02f, 0.02f) || dbg_bad(SO[d * 128 + 64 + lane], s1, 0.02f, 0.02f));
        LDS_WAIT(); asm volatile("" ::: "memory");
    }
    for (int s = gw; s < 48; s += NGW) {
        const unsigned r = dbg_rand(8000u + s); const bool smp = (s % 3) == 2; const int blk = (r >> 3) & 7, c = blk * 64 + lane;
        int seq, T; size_t row0; if (smp) { seq = (r >> 6) % SB; T = ST; row0 = (size_t)PM + seq * ST; } else { seq = (r >> 6) % PB; T = 1 + (int)((r >> 10) % ((s & 1) ? 200 : PT)); row0 = (size_t)seq * PT; }
        const float* RX = WSP(float, WS_RX); const float* cw = FIN(I_RCW); const float cb = FIN(I_RCB)[c];
        float x3 = 0.f, x2 = 0.f, x1 = 0.f, h = 0.f;
        if (smp) { const float* cv = FIN(I_SCONV) + (size_t)seq * 3 * 512; x3 = cv[c]; x2 = cv[512 + c]; x1 = cv[1024 + c]; h = FIN(I_SH)[(size_t)seq * 512 + c]; }
        const float sp = log1pf(expf(-FIN(I_LAM)[c])); const float* wa = FIN(I_RWA) + (size_t)blk * 4096; const float* wx = FIN(I_RWX) + (size_t)blk * 4096;
        for (int t = 0; t < T; ++t) { const float x0 = RX[(row0 + t) * 512 + c]; const float xc = cb + cw[c] * x3 + cw[512 + c] * x2 + cw[1024 + c] * x1 + cw[1536 + c] * x0; x3 = x2; x2 = x1; x1 = x0;
            L[lane] = xc; LDS_WAIT(); asm volatile("" ::: "memory");
            float ra = FIN(I_RBA)[c], ri = FIN(I_RBX)[c]; for (int i = 0; i < 64; ++i) { ra += L[i] * wa[i * 64 + lane]; ri += L[i] * wx[i * 64 + lane]; }
            LDS_WAIT(); asm volatile("" ::: "memory");
            const float rr = 1.0f / (1.0f + expf(-ra)), ii = 1.0f / (1.0f + expf(-ri)), la = -8.0f * rr * sp, a = expf(la); h = a * h + sqrtf(-expm1f(2.0f * la)) * (ii * xc); }
        const size_t o = (row0 + T - 1) * 512 + c; const float e = h * bf1(WSP(bf16, WS_GG)[o]);
        DBG_FLAG(8, dbg_bad(bf1((WSP(bf16, WS_OA) + (size_t)2 * MT * 512)[o]), e, 0.04f, 0.01f));
    }
    for (int s = gw; s < 512; s += NGW) {
        const unsigned r = dbg_rand(9000u + s); const int row = dbg_row(r), col = (r >> 7) % DM;
        float e = 0.f;
        for (int br = 0; br < 3; ++br) { const bf16* O = WSP(bf16, WS_OA) + (size_t)br * MT * 512 + (size_t)row * 512; const float* W = FIN(br == 0 ? I_WBRA : (br == 1 ? I_WBRB : I_WBRC));
            float a = 0.f; for (int k = lane; k < 512; k += 64) a += bf1(O[k]) * bfr(W[(size_t)k * DM + col]); a = wave_sum(a); e += bf1(WSP(bf16, WS_MGS)[(size_t)row * 3072 + br * 1024 + col]) * a; }
        DBG_FLAG(20, dbg_bad(bf1(WSP(bf16, WS_MRG)[(size_t)row * DM + col]), e, 0.03f, 0.01f));
        const float* mod = WSP(float, WS_MOD) + (size_t)row_bb(row) * 6144;
        { float a = 0.f; for (int k = lane; k < DM; k += 64) a += bf1(WSP(bf16, WS_MRG)[(size_t)row * DM + k]) * bfr(FIN(I_WOUT)[(size_t)k * DM + col]); a = wave_sum(a);
          const float ex = xrow_in(F, 0, row)[col] + mod[2048 + col] * a; DBG_FLAG(21, dbg_bad(WSP(float, WS_X1)[(size_t)row * DM + col], ex, 0.005f, 0.005f)); }
        { const float* xr = WSP(float, WS_X1) + (size_t)row * DM; float ss = 0.f; for (int d = lane; d < DM; d += 64) ss += xr[d] * xr[d]; const float rs = 1.0f / sqrtf(wave_sum(ss) * (1.0f / DM) + EPS);
          const int c2 = (r >> 9) % NUP; float a = 0.f; for (int d = lane; d < DM; d += 64) a += bfr(xr[d] * rs * FIN(I_N2G)[d] * (1.0f + mod[4096 + d]) + mod[3072 + d]) * bfr(FIN(I_WUP)[(size_t)d * NUP + c2]); a = wave_sum(a);
          const float got = c2 < DFF ? bf1(WSP(bf16, WS_GP)[(size_t)row * DFF + c2]) : bf1((WSP(bf16, WS_GP) + (size_t)MT * DFF)[(size_t)row * DFF + c2 - DFF]); DBG_FLAG(22, dbg_bad(got, a, 0.02f, 0.01f)); }
        { const int c3 = (r >> 11) % DFF; const bf16* GP = WSP(bf16, WS_GP); const bf16* VAL = GP + (size_t)MT * DFF; const float* cw = FIN(I_FCW);
          const bool isp = row < PM; const int t = isp ? (row & (PT - 1)) : ((row - PM) & 7); float xm2, xm1;
          if (t >= 2) { xm2 = bf1(GP[(size_t)(row - 2) * DFF + c3]); xm1 = bf1(GP[(size_t)(row - 1) * DFF + c3]); }
          else if (isp) { xm2 = 0.f; xm1 = (t == 1) ? bf1(GP[(size_t)(row - 1) * DFF + c3]) : 0.f; }
          else { const float* st = FIN(I_SFFN) + ((size_t)((row - PM) >> 3) * 2) * DFF + c3; xm2 = (t == 0) ? st[0] : st[DFF]; xm1 = (t == 0) ? st[DFF] : bf1(GP[(size_t)(row - 1) * DFF + c3]); }
          const float y = FIN(I_FCB)[c3] + cw[c3] * xm2 + cw[DFF + c3] * xm1 + cw[2 * DFF + c3] * bf1(GP[(size_t)row * DFF + c3]); const float ex = (y / (1.0f + expf(-y))) * bf1(VAL[(size_t)row * DFF + c3]);
          DBG_FLAG(23, dbg_bad(bf1((GP + (size_t)2 * MT * DFF)[(size_t)row * DFF + c3]), ex, 0.02f, 0.005f)); }
        { const bf16* ACT = WSP(bf16, WS_GP) + (size_t)2 * MT * DFF + (size_t)row * DFF; float a = 0.f; for (int k = lane; k < DFF; k += 64) a += bf1(ACT[k]) * bfr(FIN(I_WDN)[(size_t)k * DM + col]); a = wave_sum(a);
          const float ex = WSP(float, WS_X1)[(size_t)row * DM + col] + mod[5120 + col] * a; DBG_FLAG(24, dbg_bad(WSP(float, WS_X2)[(size_t)row * DM + col], ex, 0.005f, 0.005f)); }
    }
#undef DBG_FLAG
}
__device__ __forceinline__ void dbg_report_phase(Frame& F) {
    const unsigned* CNT = (const unsigned*)(F.ws + WS_CTL) + 3000;
    const size_t ooff[14] = {OUT_Y, OUT_Y + (size_t)PM * DM, OUT_ROWS_P, OUT_ROWS_S, OUT_WIN_P, OUT_WIN_S, OUT_RET_P, OUT_RET_S, OUT_H_P, OUT_H_S, OUT_CV_P, OUT_CV_S, OUT_FC_P, OUT_FC_S};
    if (F.bid == 0 && F.tid < 14) { const int b = F.tid; const unsigned c = CNT[b]; const int cnt = 1 + (int)(c > 1000u ? 1000u : c);
        for (int i = 0; i < cnt; ++i) ((unsigned*)F.out)[ooff[b] + 7 + 2 * i] = 0xAAAAAAAAu; }
}
#endif

#ifndef DBG_SUB
#define DBG_SUB 0xFFFF
#endif
#ifndef DBG_MAXPH
#define DBG_MAXPH N_PHASES
#endif
#ifndef DBG_REPEAT
#define DBG_REPEAT 0
#endif
#ifndef DBG_MASK
#define DBG_MASK 0xFFFF
#endif
#define IN(k) (lo <= (k) && (k) < hi)
#ifdef DBG_TIME
#define SEAM(k) do { if ((k) + 1 < hi) { if (MK_N_LAUNCHES == 1) xcd_barrier(bar); } if (F.bid == 0 && F.tid == 0) ((unsigned long long*)(F.ws + WS_CTL))[2048 + (k) + 1] = __builtin_amdgcn_s_memrealtime(); } while (0)
#else
#define SEAM(k) do { if ((k) + 1 < hi) { if (MK_N_LAUNCHES == 1) xcd_barrier(bar); } } while (0)
#endif
template <int l> __device__ __forceinline__ void ph_win(Frame& F) { unsigned char* ws = F.ws;
    pg8::Gemm g{(const pg8::bf16_t*)(ws + WS_H), (const pg8::bf16_t*)(ws + WS_WIN) + (size_t)l * NIN * DM, MT, NIN, DM};
    pg8::StaticOrder S; S.init(MT, NIN, F.G, F.bid); EpiWin E{ws, F.out, l};
    pg8::gemm_phase<EpiWin, pg8::StaticOrder, true, true>(F.lds, g, S, E); }
template <int l> __device__ __forceinline__ void ph_mix1(Frame& F) {
    for (int x = F.bid; x < 512; x += F.G) { launder(F); cmp_gemm_unit<true>(F, l, x >> 8, (x & 255) >> 2, (x & 3) * 128); }
    {
        unsigned* ctr = (unsigned*)(F.ws + WS_CTL) + 3210 + l; volatile LAS int* QI = (volatile LAS int*)(F.lds + MISC_OFF + 128);
#pragma unroll 1
        for (;;) {
            __syncthreads();
            if (F.tid == 0) QI[0] = (int)__hip_atomic_fetch_add(ctr, 1u, __ATOMIC_RELAXED, __HIP_MEMORY_SCOPE_AGENT);
            __syncthreads();
            const int u = __builtin_amdgcn_readfirstlane(QI[0]);
            if (u >= 32 + 768) break;
            launder(F);
            if (u < 32) cmp_gemm_unit<false>(F, l, u >> 4, (u >> 1) & 7, (u & 1) * 128); else if (u < 32 + 256) rglru_unit<0>(F, l, u - 32); else ret_local_unit(F, u - 32 - 256);
        }
        __syncthreads();
    } }
template <int l> __device__ __forceinline__ void ph_mix2(Frame& F) { cmp2_phase(F, l); ret_scan_phase(F, l); rglru_carry_phase(F, l); }
#ifndef DBG_REPQ
#define DBG_REPQ 0
#endif
constexpr int MQ_SA = 64, MQ_PA = MQ_SA + 512, MQ_RG1 = MQ_PA + 256, MQ_RO = MQ_RG1 + 512, MQ_RS = MQ_RO + 128, MQ_RG2 = MQ_RS + 32;
template <int l> __device__ __forceinline__ void ph_mix3(Frame& F) {
    unsigned* ctr = (unsigned*)(F.ws + WS_CTL) + 3200 + l;
    volatile LAS int* QI = (volatile LAS int*)(F.lds + MISC_OFF + 128);
#pragma unroll 1
    for (;;) {
        __syncthreads();
        if (F.tid == 0) QI[0] = (int)__hip_atomic_fetch_add(ctr, 1u, __ATOMIC_RELAXED, __HIP_MEMORY_SCOPE_AGENT);
        __syncthreads();
        const int u = __builtin_amdgcn_readfirstlane(QI[0]);
        if (u >= MQ_RG2) break;
        launder(F);
        if (u < MQ_SA) { attn_sample_unit(F, l, u); if (DBG_REPQ & 2) { launder(F); attn_sample_unit(F, l, u); } }
        else if (u < MQ_PA) { const int v = u - MQ_SA; attn_prompt_unit(F, l, (v & 7) * 64 + 63 - (v >> 3)); if (DBG_REPQ & 1) { launder(F); attn_prompt_unit(F, l, (v & 7) * 64 + 63 - (v >> 3)); } }
        else if (u < MQ_RG1) { rglru_unit<1>(F, l, u - MQ_PA); }
        else if (u < MQ_RO) { ret_out_unit(F, l, u - MQ_RG1); }
        else if (u < MQ_RS) { ret_sample_unit(F, l, u - MQ_RO); }
        else { rglru_unit<2>(F, l, u - MQ_RS); }
    }
    __syncthreads(); }
__device__ __forceinline__ f32x16 smp_tile_acc(Frame& F, const bf16* A, const bf16* Wt, int K, int tile) {
    const int q = F.lane & 31, h_ = F.lane >> 5, ks8 = K / 8, kb = F.wave * ks8;
    const bf16* ap = A + (size_t)((tile >> 5) * 32 + q) * K + kb + 8 * h_; const bf16* bp = Wt + (size_t)((tile & 31) * 32 + q) * K + kb + 8 * h_; f32x16 acc = (f32x16){};
#pragma unroll 11
    for (int kk = 0; kk < ks8 / 16; ++kk) acc = mfma32(*(const bf16x8*)(ap + 16 * kk), *(const bf16x8*)(bp + 16 * kk), acc);
    return acc;
}
__device__ __forceinline__ void smp_tile_put(Frame& F, const f32x16& acc, int slot) { LAS float* R = (LAS float*)(F.lds + slot * 32768) + F.wave * 1024 + F.lane;
#pragma unroll
    for (int r = 0; r < 16; ++r) R[r * 64] = acc[r]; }
__device__ __forceinline__ float smp_tile_get(Frame& F, int slot, int o) { const LAS float* R = (const LAS float*)(F.lds + slot * 32768) + o; float s = 0.f;
#pragma unroll
    for (int w = 0; w < 8; ++w) s += R[w * 1024];
    return s; }
template <int l> __device__ __forceinline__ void ph_br(Frame& F) { unsigned char* ws = F.ws;
    const pg8::bf16_t* wbr = (const pg8::bf16_t*)(ws + WS_WBR) + (size_t)l * 3 * 1024 * 512;
    for (int tile = F.bid; tile < 256; tile += F.G) {
        const f32x16 a0 = smp_tile_acc(F, (const bf16*)(ws + WS_OA) + (size_t)PM * 512, wbr, 512, tile), a1 = smp_tile_acc(F, (const bf16*)(ws + WS_OA) + (size_t)(MT + PM) * 512, wbr + (size_t)1024 * 512, 512, tile),
                     a2 = smp_tile_acc(F, (const bf16*)(ws + WS_OA) + (size_t)(2 * MT + PM) * 512, wbr + (size_t)2 * 1024 * 512, 512, tile);
        __syncthreads(); smp_tile_put(F, a0, 0); smp_tile_put(F, a1, 1); smp_tile_put(F, a2, 2); __syncthreads();
        const bf16* MG = (const bf16*)(ws + WS_MGS); bf16* MR = (bf16*)(ws + WS_MRG);
#pragma unroll
        for (int e = 0; e < 2; ++e) { const int o = F.tid * 2 + e, r = o >> 6, ln = o & 63; const size_t row = (size_t)PM + (tile >> 5) * 32 + (r & 3) + 8 * (r >> 2) + 4 * (ln >> 5); const int col = (tile & 31) * 32 + (ln & 31);
            const bf16* g = MG + row * 3072 + col; MR[row * DM + col] = (bf16)(pk2(bf1(g[0]) * smp_tile_get(F, 0, o) + bf1(g[1024]) * smp_tile_get(F, 1, o) + bf1(g[2048]) * smp_tile_get(F, 2, o), 0.f) & 0xffffu); }
    }
    __syncthreads();
    BrOrder S; S.S.init(PM, DM, F.G, F.bid);
    pg8::Gemm g{(const pg8::bf16_t*)(ws + WS_OA), wbr, 3 * MT, 3 * DM, 512}; EpiBrAll E{ws};
    pg8::gemm_phase<EpiBrAll, BrOrder, true, true>(F.lds, g, S, E); }
template <bool INF32> __device__ __forceinline__ void smp_res(Frame& F, const bf16* A, const bf16* Wt, int K, const void* xin  , bf16* xout  , const float* mod, int gofs) {
    for (int tile = F.bid; tile < 256; tile += F.G) {
        const f32x16 a = smp_tile_acc(F, A, Wt, K, tile);
        __syncthreads(); smp_tile_put(F, a, 0); __syncthreads();
#pragma unroll
        for (int e = 0; e < 2; ++e) { const int o = F.tid * 2 + e, r = o >> 6, ln = o & 63; const int rr = (tile >> 5) * 32 + (r & 3) + 8 * (r >> 2) + 4 * (ln >> 5), col = (tile & 31) * 32 + (ln & 31);
            const float xi = INF32 ? ((const float*)xin)[(size_t)rr * DM + col] : bf1(((const bf16*)xin)[(size_t)rr * DM + col]);
            xout[(size_t)rr * DM + col] = (bf16)(pk2(xi + mod[(size_t)(4 + (rr >> 3)) * 6144 + gofs + col] * smp_tile_get(F, 0, o), 0.f) & 0xffffu); }
    }
    __syncthreads();
}
template <int l> __device__ __forceinline__ void ph_out(Frame& F) { unsigned char* ws = F.ws;
    const float* mod = (const float*)(ws + WS_MOD) + (size_t)l * 36 * 6144;
    smp_res<l == 0>(F, (const bf16*)(ws + WS_MRG) + (size_t)PM * DM, (const bf16*)(ws + WS_WOUT) + (size_t)l * DM * DM, DM, l == 0 ? (const void*)FIN(I_XS) : (const void*)((const bf16*)(ws + WS_X2) + (size_t)PM * DM), (bf16*)(ws + WS_X1) + (size_t)PM * DM, mod, 2048);
    pg8::Gemm g{(const pg8::bf16_t*)(ws + WS_MRG), (const pg8::bf16_t*)(ws + WS_WOUT) + (size_t)l * DM * DM, PM, DM, DM};
    pg8::StaticOrder S; S.init(PM, DM, F.G, F.bid);
    EpiRes<l == 0> E{l == 0 ? (const void*)FIN(I_XP) : (const void*)(ws + WS_X2), (bf16*)(ws + WS_X1), mod, 2048};
    pg8::gemm_phase<EpiRes<l == 0>, pg8::StaticOrder, true, true>(F.lds, g, S, E); }
template <int l> __device__ __forceinline__ void ph_down(Frame& F) { unsigned char* ws = F.ws;
    const float* mod = (const float*)(ws + WS_MOD) + (size_t)l * 36 * 6144;
    {
        pg8::StaticOrder S0; S0.init(PM, DM, F.G, F.bid); pg8::Unit u0;
        for (int i = 0; S0.next(i, u0); ++i) if ((u0.pm & 15) != 0) convact_rows(F, l, (size_t)u0.pm * 256, 2, false);
        asm volatile("s_waitcnt vmcnt(0)" ::: "memory"); __syncthreads();
    }
    smp_res<false>(F, (const bf16*)(ws + WS_GP) + (size_t)2 * MT * DFF + (size_t)PM * DFF, (const bf16*)(ws + WS_WDN) + (size_t)l * DM * DFF, DFF, (const void*)((const bf16*)(ws + WS_X1) + (size_t)PM * DM), (bf16*)(ws + WS_X2) + (size_t)PM * DM, mod, 5120);
    pg8::Gemm g{(const pg8::bf16_t*)(ws + WS_GP) + (size_t)2 * MT * DFF, (const pg8::bf16_t*)(ws + WS_WDN) + (size_t)l * DM * DFF, PM, DM, DFF};
    pg8::StaticOrder S; S.init(PM, DM, F.G, F.bid);
    EpiRes<false> E{(const void*)(ws + WS_X1), (bf16*)(ws + WS_X2), mod, 5120};
    pg8::gemm_phase<EpiRes<false>, pg8::StaticOrder, true, true>(F.lds, g, S, E); }
template <int l> __device__ __forceinline__ void ph_up(Frame& F) { unsigned char* ws = F.ws;
    pg8::Gemm g{(const pg8::bf16_t*)(ws + WS_H), (const pg8::bf16_t*)(ws + WS_WUP) + (size_t)l * NUP * DM, MT, NUP, DM};
    UpOrder S; S.S.init(MT, DFF, F.G, F.bid); EpiUp E{ws, F.out, l, FIN(I_FCW) + (size_t)l * 3 * DFF, FIN(I_FCB) + (size_t)l * DFF, (const bf16*)(ws + WS_SFB) + (size_t)l * SB * 2 * DFF};
    pg8::gemm_phase<EpiUp, UpOrder, true, true>(F.lds, g, S, E); }
#ifdef DBG_AMP_BIT
#define AMP_T0(bit) unsigned long long amp_t0_ = 0ull; if ((bit) == DBG_AMP_BIT) amp_t0_ = __builtin_amdgcn_s_memrealtime();
#define AMP_T1(bit) if ((bit) == DBG_AMP_BIT && F.tid == 0) { volatile LAS unsigned* AM = (volatile LAS unsigned*)(F.lds + MISC_OFF + 192); AM[0] += (unsigned)(__builtin_amdgcn_s_memrealtime() - amp_t0_); }
#else
#define AMP_T0(bit)
#define AMP_T1(bit)
#endif
#define RUNPH(bit, ph, CALL) do { if (((DBG_MASK >> (bit)) & 1) && IN(ph)) { AMP_T0(bit) launder(F); CALL; if ((DBG_REPEAT >> (bit)) & 1) { launder(F); CALL; } SEAM(ph); AMP_T1(bit) } } while (0)
template <int l> __device__ __forceinline__ void layer_phases(Frame& F, const XcdBarrier& bar, int lo, int hi) {
    constexpr int pb = PH_L0 + l * PH_PER_LAYER;
    RUNPH(1, pb + LP_N1, norm_phase(F, l, 0));
    RUNPH(2, pb + LP_WIN, ph_win<l>(F));
    RUNPH(3, pb + LP_MIX1, ph_mix1<l>(F));
    RUNPH(4, pb + LP_MIX2, ph_mix2<l>(F));
    RUNPH(5, pb + LP_MIX3, ph_mix3<l>(F));
    RUNPH(6, pb + LP_BR, ph_br<l>(F));
    RUNPH(7, pb + LP_OUT, ph_out<l>(F));
    RUNPH(8, pb + LP_N2, norm_phase(F, l, 1));
    RUNPH(9, pb + LP_UP, ph_up<l>(F));
    RUNPH(11, pb + LP_DOWN, ph_down<l>(F));
}
__global__ void __launch_bounds__(NTHR, 2) trunk_fwd(Args args) {
    extern __shared__ __attribute__((aligned(16))) unsigned char lds_raw[];
    Frame F;
    F.lds = (LAS unsigned char*)lds_raw;
    F.tid = threadIdx.x; F.lane = F.tid & 63; F.wave = __builtin_amdgcn_readfirstlane(F.tid >> 6);
    F.G = gridDim.x; F.bid = blockIdx.x; F.a = &args; F.ws = args.ws; F.out = args.out;
    volatile LAS unsigned* MISC = (volatile LAS unsigned*)(F.lds + MISC_OFF);
    for (int u = F.tid; u < 64; u += NTHR) MISC[u] = 0u;
    __syncthreads();
    unsigned* barw = (unsigned*)(F.ws + WS_CTL) + CW_BAR;
    XcdBarrier bar; bar.bar = barw; bar.x = 0; bar.st = nullptr;
    if (MK_N_LAUNCHES == 1) bar = xcd_barrier_post(barw, MISC + 8);
    const int lo = args.ph_lo, hi = args.ph_hi;
    unsigned char* ws = F.ws;

#ifdef DBG_TIME
    if (F.bid == 0 && F.tid == 0) ((unsigned long long*)(F.ws + WS_CTL))[2048] = __builtin_amdgcn_s_memrealtime();
#endif
    RUNPH(0, PH_P0, p0_prologue(F));

    layer_phases<0>(F, bar, lo, hi);
    layer_phases<1>(F, bar, lo, hi);
    if (((DBG_MASK >> 12) & 1) && IN(PH_FINAL)) { launder(F); final_phase(F); if ((DBG_REPEAT >> 12) & 1) { launder(F); final_phase(F); } }
#ifdef DBG_AMP_BIT
    if (F.tid == 0) { volatile LAS unsigned* AM = (volatile LAS unsigned*)(F.lds + MISC_OFF + 192); const unsigned long long tot = (unsigned long long)AM[0] * DBG_AMP, ts = __builtin_amdgcn_s_memrealtime();
        while (__builtin_amdgcn_s_memrealtime() - ts < tot) __builtin_amdgcn_s_sleep(8); }
    __syncthreads();
#endif
#ifdef DBG_TIME
    {
        xcd_barrier(bar);
        if (F.bid == 0 && F.tid < 14) {
            const unsigned long long* ts = (const unsigned long long*)(F.ws + WS_CTL) + 2048; const unsigned long long tend = __builtin_amdgcn_s_memrealtime();
            const size_t ooff[14] = {OUT_Y, OUT_Y + (size_t)PM * DM, OUT_ROWS_P, OUT_ROWS_S, OUT_WIN_P, OUT_WIN_S, OUT_RET_P, OUT_RET_S, OUT_H_P, OUT_H_S, OUT_CV_P, OUT_CV_S, OUT_FC_P, OUT_FC_S};
            const int b = F.tid; unsigned long long d;
            if (b == 0) d = tend - ts[0]; else if (b == 1) d = ts[1] - ts[0]; else if (b == 13) d = tend - ts[PH_FINAL];
            else { const int ph = PH_L0 + DBG_TIME_LAYER * PH_PER_LAYER + (b - 2); d = ts[ph + 1] - ts[ph]; }
            int cnt = (int)(d / 100ull); if (cnt < 1) cnt = 1; if (cnt > 2000 && b != 0) cnt = 2000;
            for (int i = 0; i < cnt; ++i) ((unsigned*)F.out)[ooff[b] + 7 + 2 * i] = 0xAAAAAAAAu;
        }
    }
#endif
#ifdef DBG_COUNT
    {
        xcd_barrier(bar);
        if (F.bid == 0 && F.tid < 3) { const unsigned* CNT = (const unsigned*)(F.ws + WS_CTL) + 3000; const size_t ooff[3] = {OUT_Y, OUT_Y + (size_t)PM * DM, OUT_ROWS_P};
            const int cnt = (int)((unsigned long long)CNT[F.tid] * 10ull / (CNT[3] ? CNT[3] : 1u)); for (int i = 0; i < cnt; ++i) ((unsigned*)F.out)[ooff[F.tid] + 7 + 2 * i] = 0xAAAAAAAAu; }
    }
#endif
#ifdef DBG_CHECK
    if (lo == 100) { launder(F); dbg_check_phase(F); }
    if (lo == 101) { for (size_t i = (size_t)F.bid * NTHR + F.tid; i < OUT_END; i += (size_t)F.G * NTHR) F.out[i] = 0.f; }
    if (lo == 102) { launder(F); dbg_report_phase(F); }
#endif
}

extern "C" void kernel_launch(void* const* d_in, const int* in_sizes, int n_in, void* d_out, int out_size, void* d_ws, size_t ws_size, hipStream_t stream) {
    static int grid = 0;
    if (grid == 0) {
        if (n_in != 37 || (size_t)out_size != OUT_END || ws_size < WS_END) { fprintf(stderr, "kernel_launch: unexpected shapes: n_in %d out %d (want %zu) ws %zu (want %zu)\n", n_in, out_size, (size_t)OUT_END, ws_size, (size_t)WS_END); grid = -1; return; }
        int dev = 0, cus = 0, per_cu = 0;
        if (hipGetDevice(&dev) != hipSuccess || hipDeviceGetAttribute(&cus, hipDeviceAttributeMultiprocessorCount, dev) != hipSuccess) { grid = -1; return; }
        if (hipFuncSetAttribute((const void*)trunk_fwd, hipFuncAttributeMaxDynamicSharedMemorySize, LDS_BYTES) != hipSuccess) { fprintf(stderr, "kernel_launch: hipFuncSetAttribute failed\n"); grid = -1; return; }
        if (hipOccupancyMaxActiveBlocksPerMultiprocessor(&per_cu, (const void*)trunk_fwd, NTHR, LDS_BYTES) != hipSuccess || per_cu < 1) fprintf(stderr, "kernel_launch: occupancy query reports %d\n", per_cu);
        (void)hipGetLastError();
        grid = cus;
    }
    if (grid < 0) return;
    if (hipMemsetAsync((char*)d_ws + WS_CTL, 0, CTL_ZERO_BYTES, stream) != hipSuccess) return;
#ifdef DBG_POISON
    (void)hipMemsetAsync((char*)d_ws + CTL_ZERO_BYTES, 0xAA, WS_END - CTL_ZERO_BYTES, stream);
    (void)hipMemsetAsync(d_out, 0xAA, (size_t)OUT_END * 4, stream);
#endif
    Args a{};
    for (int i = 0; i < 37; ++i) a.in[i] = d_in[i];
    a.out = (float*)d_out; a.ws = (unsigned char*)d_ws;
#if MK_N_LAUNCHES == 1
    a.ph_lo = 0; a.ph_hi = N_PHASES;
    hipLaunchKernelGGL(trunk_fwd, dim3(grid), dim3(NTHR), LDS_BYTES, stream, a);
#else
    for (int p = 0; p < DBG_MAXPH; ++p) { a.ph_lo = p; a.ph_hi = p + 1; hipLaunchKernelGGL(trunk_fwd, dim3(grid), dim3(NTHR), LDS_BYTES, stream, a); }
#ifdef DBG_CHECK
    for (int p = 100; p < 103; ++p) { a.ph_lo = p; a.ph_hi = p + 1; hipLaunchKernelGGL(trunk_fwd, dim3(grid), dim3(NTHR), LDS_BYTES, stream, a); }
#endif
#endif
    (void)in_sizes;
}
```

```cpp
#include <hip/hip_runtime.h>
#include <cstdio>
#include <cstdint>

#ifndef MK_N_LAUNCHES
#define MK_N_LAUNCHES 1
#endif

constexpr int DM = 1024, PB = 4, PT = 4096, PM = PB * PT, SB = 32, ST = 8, SM = SB * ST, MT = PM + SM;
constexpr int DEPTH = 2, PAST = 8192, PAGE = 128, NPG = PAST / PAGE, NPHYS = 2560;
constexpr int D_IN = 7448, NIN = 7680, DFF = 2816, NUP = 2 * DFF;
constexpr int WINB = 512;
constexpr float EPS = 1e-6f;
constexpr float QSCALE = 0.125f * 1.4426950408889634f;

constexpr int O_NQ = 0, O_NKV = 512, O_NG = 1280, O_RQ = 1304, O_RK = 1816, O_RV = 2328, O_RG = 2840, O_RX = 3352, O_RGATE = 3864, O_MG = 4376;

constexpr size_t OUT_Y = 0;
constexpr size_t OUT_ROWS_P = OUT_Y + (size_t)MT * DM;
constexpr size_t OUT_ROWS_S = OUT_ROWS_P + (size_t)DEPTH * PM * 512;
constexpr size_t OUT_WIN_P = OUT_ROWS_S + (size_t)DEPTH * SM * 512;
constexpr size_t OUT_WIN_S = OUT_WIN_P + (size_t)DEPTH * PB * WINB * 256;
constexpr size_t OUT_RET_P = OUT_WIN_S + (size_t)DEPTH * SB * WINB * 256;
constexpr size_t OUT_RET_S = OUT_RET_P + (size_t)DEPTH * PB * 4 * 16384;
constexpr size_t OUT_H_P = OUT_RET_S + (size_t)DEPTH * SB * 4 * 16384;
constexpr size_t OUT_H_S = OUT_H_P + (size_t)DEPTH * PB * 512;
constexpr size_t OUT_CV_P = OUT_H_S + (size_t)DEPTH * SB * 512;
constexpr size_t OUT_CV_S = OUT_CV_P + (size_t)DEPTH * PB * 3 * 512;
constexpr size_t OUT_FC_P = OUT_CV_S + (size_t)DEPTH * SB * 3 * 512;
constexpr size_t OUT_FC_S = OUT_FC_P + (size_t)DEPTH * PB * 2 * DFF;
constexpr size_t OUT_END = OUT_FC_S + (size_t)DEPTH * SB * 2 * DFF;

constexpr size_t MiB = 1u << 20;
constexpr size_t WS_CTL = 0, CTL_ZERO_BYTES = 4 * MiB;
constexpr size_t WS_MOD = 1 * MiB;
constexpr size_t WS_ROT = 4 * MiB;
constexpr size_t WS_SMALLW = 8 * MiB;
constexpr size_t WS_SFB = 12 * MiB;
constexpr size_t WS_WIN = 16 * MiB;
constexpr size_t WS_WBR = WS_WIN + (size_t)2 * NIN * DM * 2;
constexpr size_t WS_WOUT = WS_WBR + (size_t)2 * 3 * 1024 * 512 * 2;
constexpr size_t WS_WUP = WS_WOUT + (size_t)2 * 1024 * 1024 * 2;
constexpr size_t WS_WDN = WS_WUP + (size_t)2 * NUP * DM * 2;
constexpr size_t WS_WEND = WS_WDN + (size_t)2 * DM * DFF * 2;
constexpr size_t WS_H = 128 * MiB;
constexpr size_t WS_QN = WS_H + (size_t)MT * DM * 2;
constexpr size_t WS_KVB = WS_QN + (size_t)MT * 512 * 2;
constexpr size_t WS_KVS = WS_KVB + (size_t)4 * PB * 2 * PT * 64 * 2;
constexpr size_t WS_RQ = WS_KVS + (size_t)4 * SB * 2 * ST * 64 * 2;
constexpr size_t WS_RX = WS_RQ + (size_t)4 * MT * 512 * 2;
constexpr size_t WS_GG = WS_RX + (size_t)MT * 512 * 4;
constexpr size_t WS_MGS = WS_GG + (size_t)MT * 512 * 2;
constexpr size_t WS_NG = WS_MGS + (size_t)MT * 3072 * 2;
constexpr size_t WS_OA = WS_NG + (size_t)MT * 24 * 4;
constexpr size_t WS_MRG = WS_OA + (size_t)3 * MT * 512 * 2;
constexpr size_t WS_X1 = WS_MRG + (size_t)MT * DM * 2;
constexpr size_t WS_X2 = WS_X1 + (size_t)MT * DM * 4;
constexpr size_t WS_GP = WS_X2 + (size_t)MT * DM * 4;
constexpr size_t WS_ACMP = WS_GP + (size_t)3 * MT * DFF * 2;
constexpr int CMP_ROWS_J = 34816, CMP_ROWS = 2 * CMP_ROWS_J;
constexpr size_t WS_LH = WS_ACMP + (size_t)2 * CMP_ROWS * 1024 * 2 + 4096;
constexpr size_t WS_CK = WS_LH + (size_t)(CMP_ROWS + 16) * 256 * 2;
constexpr size_t WS_LT = WS_CK + (size_t)CMP_ROWS * 64 * 2;
constexpr size_t WS_SPT = WS_LT + (size_t)16 * 32 * 16384 * 4;
constexpr size_t WS_CAR = WS_SPT + (size_t)16 * 32 * 16384 * 2;
constexpr size_t WS_OAG = WS_CAR + (size_t)4 * 64 * 3 * 512 * 4 + MiB;
constexpr size_t WS_END = WS_OAG + (size_t)2048 * 32 * 64 * 4 + MiB;
static_assert(WS_WEND <= WS_H, "weights fit below WS_H");

constexpr size_t SW_W1T = 0;
constexpr size_t SW_W2T = SW_W1T + (size_t)2 * 2 * 256 * 1024 * 2;
constexpr size_t SW_CB = SW_W2T + (size_t)2 * 2 * 64 * 128 * 2;
constexpr size_t SW_WAT = SW_CB + (size_t)2 * 2 * 128 * 4;
constexpr size_t SW_SP = SW_WAT + (size_t)2 * 2 * 8 * 64 * 64 * 2;
constexpr size_t SW_END = SW_SP + 2 * 512 * 4;
static_assert(SW_END <= 8 * MiB, "small weights fit");

constexpr int CW_TMO = 0;
constexpr int CW_BAR = 4096;

constexpr int PH_P0 = 0, PH_L0 = 1, PH_PER_LAYER = 11, PH_FINAL = PH_L0 + DEPTH * PH_PER_LAYER, N_PHASES = PH_FINAL + 1;
enum { LP_N1 = 0, LP_WIN, LP_MIX1, LP_MIX2, LP_MIX3, LP_BR, LP_OUT, LP_N2, LP_UP, LP_CONV, LP_DOWN };

constexpr int RING_BYTES = 131072;
constexpr int MISC_OFF = RING_BYTES;
constexpr int LDS_BYTES = RING_BYTES + 1024;
constexpr int NWAVES = 8, NTHR = 512;

#define GAS __attribute__((address_space(1)))
#define LAS __attribute__((address_space(3)))
typedef unsigned short bf16;
typedef unsigned v4u __attribute__((ext_vector_type(4)));
typedef unsigned v2u __attribute__((ext_vector_type(2)));
typedef float f32x16 __attribute__((ext_vector_type(16)));
typedef short s16x4 __attribute__((ext_vector_type(4)));
namespace pg8 {
#define PG8_LAS __attribute__((address_space(3)))
typedef unsigned short bf16_t;
typedef short bf16x8 __attribute__((ext_vector_type(8)));
typedef float f32x4 __attribute__((ext_vector_type(4)));
typedef unsigned u32x4 __attribute__((ext_vector_type(4)));
constexpr int BM = 256, BK = 64, HALF = 128, HTB = HALF * BK * 2  , STAGE_BYTES = 8 * HTB, NXCD = 8, WGM = 8;

__host__ __device__ __forceinline__ int lds_byte(int r, int c) { const int st = (r >> 4) * 2 + (c >> 5), rr = r & 15, cc = c & 31, ob = rr * 64 + cc * 2; return st * 1024 + (ob ^ (((ob >> 9) & 1) << 5)); }
__host__ __device__ __forceinline__ void stage_rc(int b, int& R, int& C) { const int st = b / 1024, sb = b % 1024, swz = sb ^ (((sb >> 9) & 1) << 5); R = (st >> 1) * 16 + swz / 64; C = (st & 1) * 32 + (swz % 64) / 2; }
__host__ __device__ __forceinline__ int perm32(int rho) { const int n = rho >> 4, i = rho & 15; return 8 * (i >> 2) + 4 * n + (i & 3); }

struct Unit { int pm, pn; };
struct Gemm { const bf16_t* A; const bf16_t* Bt; int M, N, K; };

struct StaticOrder {
    int nM, nN, nwg, G, c;
    __host__ __device__ void init(int M, int N, int G_, int c_) { nM = M / BM; nN = N / BM; nwg = nM * nN; G = G_; c = c_; }
    __host__ __device__ bool next(int i, Unit& u) const {
        const long L = (long)i * G + c; if (L >= nwg) return false;
        int wgid = (int)L; { const int q = nwg / NXCD, r = nwg % NXCD, xcd = wgid % NXCD, off = wgid / NXCD; wgid = (xcd < r ? xcd * (q + 1) : r * (q + 1) + (xcd - r) * q) + off; }
        const int nig = WGM * nN, gid = wgid / nig, fm = gid * WGM, gsz = (nM - fm) < WGM ? (nM - fm) : WGM;
        u.pm = fm + ((wgid % nig) % gsz); u.pn = (wgid % nig) / gsz; return true;
    }
    __device__ __forceinline__ void a_ready(const Unit&) const {}
    __device__ __forceinline__ void done(const Unit&) const {}
};
__device__ __forceinline__ unsigned cvt_pk_bf16(float lo, float hi) { unsigned r; asm volatile("v_cvt_pk_bf16_f32 %0, %1, %2" : "=v"(r) : "v"(lo), "v"(hi)); return r; }
typedef float f32x2 __attribute__((ext_vector_type(2)));
template <class Epi, class Sched, bool ALIGN_EPI = false, bool SP2 = false>
__device__ __forceinline__ void gemm_phase(PG8_LAS unsigned char* lds, const Gemm g, const Sched& S, const Epi& E) {
    const int tid = threadIdx.x, wid = __builtin_amdgcn_readfirstlane(tid >> 6), lane = tid & 63, wr = wid >> 2, wc = wid & 3, fr = lane & 15, fq = lane >> 4;
    const int K = g.K, nt = K / BK;
    unsigned voffA[2], voffB[2];
#pragma unroll
    for (int i = 0; i < 2; ++i) { int R, C; stage_rc(tid * 16 + i * 8192, R, C); const int Rb = Epi::PERM ? ((R & ~31) + perm32(R & 31)) : R;
        voffA[i] = (unsigned)(R * K + C) * 2u; voffB[i] = (unsigned)(Rb * K + C) * 2u; }
    const size_t kstep = (size_t)(BK * 2);
    const size_t hstep = (size_t)HALF * K * 2;
    const size_t tstep = 2 * hstep;
    const unsigned ldsw = (unsigned)wid * 1024u;
    const int aoff = lds_byte(wr * 64 + fr, fq * 8), boff = lds_byte(wc * 32 + fr, fq * 8);
#define PG8_SA(b, h) (((b) * 2 + (h)) * HTB)
#define PG8_SB(b, h) ((4 + (b) * 2 + (h)) * HTB)
#define PG8_STAGE(bufoff, gbase, voff) do { _Pragma("unroll") for (int _i = 0; _i < 2; ++_i) \
        __builtin_amdgcn_global_load_lds((const unsigned*)((const char*)(gbase) + (voff)[_i]), (PG8_LAS unsigned*)(lds + (bufoff) + ldsw + _i * 8192), 16, 0, 0); } while (0)
#define PG8_LDA(dst, b, h) do { _Pragma("unroll") for (int m = 0; m < 4; ++m) _Pragma("unroll") for (int k = 0; k < 2; ++k) dst[m][k] = *(const PG8_LAS bf16x8*)(lds + PG8_SA(b, h) + aoff + m * 2048 + k * 1024); } while (0)
#define PG8_LDB(dst, b, h) do { _Pragma("unroll") for (int n = 0; n < 2; ++n) _Pragma("unroll") for (int k = 0; k < 2; ++k) dst[n][k] = *(const PG8_LAS bf16x8*)(lds + PG8_SB(b, h) + boff + n * 2048 + k * 1024); } while (0)
#define PG8_MMA(ai, bj, At, Bt) do { __builtin_amdgcn_s_setprio(1); _Pragma("unroll") for (int m = 0; m < 4; ++m) _Pragma("unroll") for (int n = 0; n < 2; ++n) _Pragma("unroll") for (int k = 0; k < 2; ++k) \
        acc[ai][bj][m][n] = __builtin_amdgcn_mfma_f32_16x16x32_bf16(Bt[n][k], At[m][k], acc[ai][bj][m][n], 0, 0, 0); __builtin_amdgcn_s_setprio(0); } while (0)
#define PG8_WAIT_V(n) asm volatile("s_waitcnt vmcnt(" #n ")" ::: "memory")
#define PG8_WAIT_L(n) asm volatile("s_waitcnt lgkmcnt(" #n ")" ::: "memory")
#define PG8_BAR __builtin_amdgcn_s_barrier()
#define PG8_SCHED __builtin_amdgcn_sched_barrier(0)
    Unit cur, nxt; int ui = 0;
    if (!S.next(0, cur)) return;
    f32x4 acc[2][2][4][2];
#pragma unroll
    for (int a = 0; a < 2; ++a)
#pragma unroll
        for (int b = 0; b < 2; ++b)
#pragma unroll
            for (int m = 0; m < 4; ++m)
#pragma unroll
                for (int n = 0; n < 2; ++n) acc[a][b][m][n] = (f32x4){0.f, 0.f, 0.f, 0.f};
    bf16x8 At[4][2], B0[2][2], B1[2][2];
    const char* cA = (const char*)g.A + (size_t)cur.pm * tstep; const char* cB = (const char*)g.Bt + (size_t)cur.pn * tstep;
    S.a_ready(cur);
    if constexpr (SP2) {
        PG8_STAGE(PG8_SB(0, 0), cB, voffB); PG8_STAGE(PG8_SB(0, 1), cB + hstep, voffB); PG8_STAGE(PG8_SA(0, 0), cA, voffA); PG8_STAGE(PG8_SA(0, 1), cA + hstep, voffA);
        if (wr == 1) PG8_BAR;
        PG8_WAIT_V(2); PG8_BAR;
        PG8_STAGE(PG8_SB(1, 0), cB + kstep, voffB); PG8_STAGE(PG8_SA(1, 0), cA + kstep, voffA); PG8_STAGE(PG8_SB(1, 1), cB + hstep + kstep, voffB);
        PG8_WAIT_V(6); PG8_BAR;
    } else {
        PG8_STAGE(PG8_SB(0, 0), cB, voffB); PG8_STAGE(PG8_SA(0, 0), cA, voffA); PG8_STAGE(PG8_SB(0, 1), cB + hstep, voffB); PG8_STAGE(PG8_SA(0, 1), cA + hstep, voffA);
        if (wr == 1) PG8_BAR;
        PG8_WAIT_V(4); PG8_BAR;
        PG8_STAGE(PG8_SB(1, 0), cB + kstep, voffB); PG8_STAGE(PG8_SA(1, 0), cA + kstep, voffA); PG8_STAGE(PG8_SB(1, 1), cB + hstep + kstep, voffB);
        PG8_WAIT_V(6); PG8_BAR;
    }
    for (;;) {
        const bool has_next = S.next(ui + 1, nxt);
        const char* nA = has_next ? (const char*)g.A + (size_t)nxt.pm * tstep : cA; const char* nB = has_next ? (const char*)g.Bt + (size_t)nxt.pn * tstep : cB;
        for (int t = 0; t < nt; t += 2) {
            const bool last = (t == nt - 2);
            const char* a1 = cA + (size_t)(t + 1) * kstep;
            const char* a2 = last ? nA : cA + (size_t)(t + 2) * kstep; const char* b2 = last ? nB : cB + (size_t)(t + 2) * kstep;
            const char* a3 = a2 + kstep; const char* b3 = b2 + kstep;
            if (last && has_next) S.a_ready(nxt);
            if constexpr (SP2) {
            PG8_LDB(B0, 0, 0); PG8_LDB(B1, 0, 1); PG8_SCHED; PG8_LDA(At, 0, 0); PG8_STAGE(PG8_SA(1, 1), a1 + hstep, voffA);
            PG8_WAIT_V(8); PG8_WAIT_L(0); PG8_BAR; PG8_MMA(0, 0, At, B0); PG8_MMA(0, 1, At, B1); PG8_BAR; PG8_SCHED;
            PG8_LDA(At, 0, 1); PG8_STAGE(PG8_SB(0, 0), b2, voffB); PG8_STAGE(PG8_SB(0, 1), b2 + hstep, voffB); PG8_STAGE(PG8_SA(0, 0), a2, voffA);
            PG8_WAIT_V(8); PG8_WAIT_L(0); PG8_BAR; PG8_MMA(1, 0, At, B0); PG8_MMA(1, 1, At, B1); PG8_BAR; PG8_SCHED;
            PG8_LDB(B0, 1, 0); PG8_LDB(B1, 1, 1); PG8_SCHED; PG8_LDA(At, 1, 0); PG8_STAGE(PG8_SA(0, 1), a2 + hstep, voffA);
            PG8_WAIT_V(8); PG8_WAIT_L(0); PG8_BAR; PG8_MMA(0, 0, At, B0); PG8_MMA(0, 1, At, B1); PG8_BAR; PG8_SCHED;
            PG8_LDA(At, 1, 1); PG8_STAGE(PG8_SB(1, 0), b3, voffB); PG8_STAGE(PG8_SB(1, 1), b3 + hstep, voffB); PG8_STAGE(PG8_SA(1, 0), a3, voffA);
            PG8_WAIT_V(8); PG8_WAIT_L(0); PG8_BAR; PG8_MMA(1, 0, At, B0); PG8_MMA(1, 1, At, B1); PG8_BAR; PG8_SCHED;
            } else {
            PG8_LDB(B0, 0, 0); PG8_SCHED; PG8_LDA(At, 0, 0); PG8_STAGE(PG8_SA(1, 1), a1 + hstep, voffA);
            PG8_WAIT_L(8); PG8_BAR; PG8_WAIT_L(0); PG8_MMA(0, 0, At, B0); PG8_BAR; PG8_SCHED;
            PG8_LDB(B1, 0, 1); PG8_STAGE(PG8_SB(0, 0), b2, voffB);
            PG8_BAR; PG8_WAIT_L(0); PG8_MMA(0, 1, At, B1); PG8_BAR;
            PG8_LDA(At, 0, 1); PG8_STAGE(PG8_SA(0, 0), a2, voffA);
            PG8_BAR; PG8_WAIT_L(0); PG8_MMA(1, 0, At, B0); PG8_BAR; PG8_SCHED;
            PG8_STAGE(PG8_SB(0, 1), b2 + hstep, voffB);
            PG8_WAIT_V(6); PG8_BAR; PG8_MMA(1, 1, At, B1); PG8_BAR;
            PG8_LDB(B0, 1, 0); PG8_SCHED; PG8_LDA(At, 1, 0); PG8_STAGE(PG8_SA(0, 1), a2 + hstep, voffA);
            PG8_WAIT_L(8); PG8_BAR; PG8_WAIT_L(0); PG8_MMA(0, 0, At, B0); PG8_BAR; PG8_SCHED;
            PG8_LDB(B1, 1, 1); PG8_STAGE(PG8_SB(1, 0), b3, voffB);
            PG8_BAR; PG8_WAIT_L(0); PG8_MMA(0, 1, At, B1); PG8_BAR;
            PG8_LDA(At, 1, 1); PG8_STAGE(PG8_SA(1, 0), a3, voffA);
            PG8_BAR; PG8_WAIT_L(0); PG8_MMA(1, 0, At, B0); PG8_BAR; PG8_SCHED;
            PG8_STAGE(PG8_SB(1, 1), b3 + hstep, voffB);
            PG8_WAIT_V(6); PG8_BAR; PG8_MMA(1, 1, At, B1); PG8_BAR;
            }
        }
        if constexpr (ALIGN_EPI) { if (wr == 0) PG8_BAR; }
        if constexpr (!Epi::AFTER_DRAIN) { E(acc, cur, wr, wc, fr, fq); S.done(cur); }
        if (!has_next) break;
#pragma unroll
        for (int a = 0; a < 2; ++a)
#pragma unroll
            for (int b = 0; b < 2; ++b)
#pragma unroll
                for (int m = 0; m < 4; ++m)
#pragma unroll
                    for (int n = 0; n < 2; ++n) acc[a][b][m][n] = (f32x4){0.f, 0.f, 0.f, 0.f};
        cur = nxt; cA = nA; cB = nB; ++ui;
        if constexpr (ALIGN_EPI) { if (wr == 1) PG8_BAR; }
    }
    PG8_WAIT_V(0);
    if constexpr (!ALIGN_EPI) { if (wr == 0) PG8_BAR; }
    PG8_BAR;
    if constexpr (Epi::AFTER_DRAIN) { E.fused(acc, cur, wr, wc, fr, fq, lds, wid, lane); S.done(cur); }
#undef PG8_SA
#undef PG8_SB
#undef PG8_STAGE
#undef PG8_LDA
#undef PG8_LDB
#undef PG8_MMA
#undef PG8_WAIT_V
#undef PG8_WAIT_L
#undef PG8_BAR
#undef PG8_SCHED
}
}

using pg8::bf16x8; using pg8::f32x4; using pg8::u32x4;
#define LDS_WAIT() asm volatile("s_waitcnt lgkmcnt(0)" ::: "memory")
#define VM_WAIT() asm volatile("s_waitcnt vmcnt(0)" ::: "memory")
typedef float f32x2_t __attribute__((ext_vector_type(2))); typedef __bf16 bf16x2_t __attribute__((ext_vector_type(2)));
__device__ __forceinline__ unsigned pk2(float lo, float hi) { f32x2_t v = {lo, hi}; bf16x2_t b = __builtin_convertvector(v, bf16x2_t); return __builtin_bit_cast(unsigned, b); }
__device__ __forceinline__ float bf_lo(unsigned w) { return __uint_as_float(w << 16); }
__device__ __forceinline__ float bf_hi(unsigned w) { return __uint_as_float(w & 0xffff0000u); }
__device__ __forceinline__ float bf1(bf16 b) { return __uint_as_float(((unsigned)b) << 16); }
__device__ __forceinline__ float fexp2(float x) { return __builtin_amdgcn_exp2f(x); }
__device__ __forceinline__ float fexp(float x) { return __builtin_amdgcn_exp2f(x * 1.4426950408889634f); }
__device__ __forceinline__ float frcp(float x) { return __builtin_amdgcn_rcpf(x); }
__device__ __forceinline__ float sigmoidf_(float x) { return frcp(1.0f + fexp(-x)); }
__device__ __forceinline__ float siluf_(float x) { return x * sigmoidf_(x); }
__device__ __forceinline__ float gelu_tanh(float x) {
    const float u = 0.7978845608028654f * (x + 0.044715f * x * x * x);
    const float e = fexp(2.0f * u);
    const float t = 1.0f - 2.0f * frcp(e + 1.0f);
    return 0.5f * x * (1.0f + t);
}
__device__ __forceinline__ float wave_sum(float v) {
#pragma unroll
    for (int o = 1; o < 64; o <<= 1) v += __shfl_xor(v, o);
    return v;
}
__device__ __forceinline__ v4u pack8(const f32x4 a, const f32x4 b) { v4u w; w.x = pk2(a[0], a[1]); w.y = pk2(a[2], a[3]); w.z = pk2(b[0], b[1]); w.w = pk2(b[2], b[3]); return w; }
__device__ __forceinline__ void unpack8(const v4u w, f32x4& a, f32x4& b) { a = (f32x4){bf_lo(w.x), bf_hi(w.x), bf_lo(w.y), bf_hi(w.y)}; b = (f32x4){bf_lo(w.z), bf_hi(w.z), bf_lo(w.w), bf_hi(w.w)}; }

#define XB_TMO      128
#define XB_XCNT(j)  (256  + 64 * (j))
#define XB_XSUB(j)  (1280 + 64 * (j))
#define XB_XGEN(j)  (2304 + 64 * (j))
#define XB_TOP      3328
#define XB_TOPGEN   3392
#define XCD_BAR_WORDS 3456
#define XB_SPIN_CAP (1u << 18)

__device__ __forceinline__ unsigned xb_ld(unsigned* p)              { return __hip_atomic_load(p, __ATOMIC_RELAXED, __HIP_MEMORY_SCOPE_AGENT); }
__device__ __forceinline__ unsigned xb_add(unsigned* p, unsigned v) { return __hip_atomic_fetch_add(p, v, __ATOMIC_RELAXED, __HIP_MEMORY_SCOPE_AGENT); }
__device__ __forceinline__ unsigned xb_xcc_id() { return (unsigned)__builtin_amdgcn_s_getreg((3 << 11) | 20) & 0xFu; }
#define XB_SPIN(cond, bar) do { unsigned _sp = 0; while (cond) { __builtin_amdgcn_s_sleep(1); \
    if ((++_sp & 255u) == 0u) { if (xb_ld(&(bar)[XB_TMO])) break; if (_sp > XB_SPIN_CAP) { atomicAdd(&(bar)[XB_TMO], 1u); break; } } } } while (0)

struct XcdBarrier {
    unsigned* bar; unsigned x;
    volatile LAS unsigned* st;
};

__device__ __forceinline__ XcdBarrier xcd_barrier_post(unsigned* bar, volatile LAS unsigned* st) {
    XcdBarrier b; b.bar = bar; b.x = xb_xcc_id(); b.st = st;
    if (threadIdx.x == 0) (void)xb_add(&bar[XB_XCNT(b.x)], 1u);
    return b;
}
__device__ __forceinline__ void xcd_barrier_complete(unsigned* bar, unsigned x, unsigned& nloc, unsigned& nx) {
    const unsigned G = gridDim.x * gridDim.y * gridDim.z;
    unsigned sum, cnt, mine, sp = 0u;
    for (;;) {
        sum = 0u; cnt = 0u; mine = 0u;
#pragma unroll
        for (unsigned j = 0; j < 16; ++j) { const unsigned c = xb_ld(&bar[XB_XCNT(j)]); sum += c; cnt += (c > 0u) ? 1u : 0u; mine = (j == x) ? c : mine; }
        if (sum == G) break;
        __builtin_amdgcn_s_sleep(1);
        if ((++sp & 255u) == 0u) { if (xb_ld(&bar[XB_TMO])) break; if (sp > XB_SPIN_CAP) { atomicAdd(&bar[XB_TMO], 1u); break; } }
    }
    nloc = mine > 0u ? mine : 1u; nx = cnt > 0u ? cnt : 1u;
}

__device__ __forceinline__ void xcd_barrier(const XcdBarrier& b) {
    asm volatile("s_waitcnt vmcnt(0)" ::: "memory");
    __syncthreads();
    if (threadIdx.x == 0) {
        unsigned* bar = b.bar;
        __builtin_amdgcn_s_waitcnt(0);
        unsigned nloc = b.st[0], nx = b.st[1];
        if (nloc == 0u) { xcd_barrier_complete(bar, b.x, nloc, nx); b.st[0] = nloc; b.st[1] = nx; }
        const unsigned old = xb_add(&bar[XB_XSUB(b.x)], 1u);
        const unsigned gen = old / nloc;
        if (old + 1u == (gen + 1u) * nloc) {
            __builtin_amdgcn_fence(__ATOMIC_RELEASE, "agent");
            asm volatile("s_waitcnt vmcnt(0)" ::: "memory");
            const unsigned og = xb_add(&bar[XB_TOP], 1u);
            const unsigned tg = og / nx;
            if (og + 1u == (tg + 1u) * nx) xb_add(&bar[XB_TOPGEN], 1u);
            else XB_SPIN(xb_ld(&bar[XB_TOPGEN]) == tg, bar);
            __builtin_amdgcn_fence(__ATOMIC_ACQUIRE, "agent");
            xb_add(&bar[XB_XGEN(b.x)], 1u);
            asm volatile("s_waitcnt vmcnt(0)" ::: "memory");
        } else {
            XB_SPIN(xb_ld(&bar[XB_XGEN(b.x)]) == gen, bar);
            __builtin_amdgcn_fence(__ATOMIC_ACQUIRE, "agent");
            asm volatile("s_waitcnt vmcnt(0)" ::: "memory");
        }
    }
    __syncthreads();
}

struct Args { const void* in[37]; float* out; unsigned char* ws; int ph_lo, ph_hi; };
enum { I_XP = 0, I_XS, I_CACHE, I_CWIN, I_SRET, I_SH, I_SCONV, I_SFFN, I_PT, I_CP, I_CS, I_N1G, I_N2G, I_WADA, I_BADA, I_WIN, I_PE, I_W1, I_B1, I_W2,
       I_GNG, I_RCW, I_RCB, I_RWA, I_RBA, I_RWX, I_RBX, I_LAM, I_WBRA, I_WBRB, I_WBRC, I_WOUT, I_WUP, I_FCW, I_FCB, I_WDN, I_FNG };

struct Frame {
    LAS unsigned char* lds;
    int tid, lane, wave, G, bid;
    const Args* a;
    unsigned char* ws;
    float* out;
};
__device__ __forceinline__ void launder(Frame& F) { asm volatile("" : "+v"(F.tid), "+v"(F.lane)); int w_ = __builtin_amdgcn_readfirstlane(F.wave), b_ = __builtin_amdgcn_readfirstlane(F.bid), g_ = __builtin_amdgcn_readfirstlane(F.G); asm volatile("" : "+s"(w_), "+s"(b_), "+s"(g_)); F.wave = w_; F.bid = b_; F.G = g_; }
#define FIN(i) ((const float*)F.a->in[i])
#define WSP(T, off) ((T*)(F.ws + (off)))

__device__ __forceinline__ int row_bb(int row) { return row < PM ? (row >> 12) : 4 + ((row - PM) >> 3); }
__device__ __forceinline__ int row_pos(int row) { return row < PM ? (row & (PT - 1)) : PT + ((row - PM) & 7); }

__device__ __forceinline__ int win_cmap(int n) {
    if (n < 1280) return n;
    if (n < 2304) { const int c = n - 1280, isk = c >> 9, hc = c & 511, head = hc >> 7, s = hc & 127;
        const int g = s >> 3, w = s & 7, dim = (w < 4) ? (4 * g + w) : (64 + 4 * g + (w - 4)); return (isk ? O_RK : O_RQ) + head * 128 + dim; }
    if (n < 2816) return O_RV + (n - 2304);
    if (n < 3328) return O_RG + (n - 2816);
    if (n < 3840) return O_RX + (n - 3328);
    if (n < 4352) return O_RGATE + (n - 3840);
    if (n < 7424) return O_MG + (n - 4352);
    if (n < 7448) return O_NG + (n - 7424);
    return -1;
}

struct TrItem { const float* W; bf16* WT; int ldw, ldt, k0, n0; bool map; };
__device__ __forceinline__ void p0_tr_load(const TrItem& I, float (&tv)[32], int lane) {
    const int nd = I.n0 + (lane & 31); const int sc = I.map ? win_cmap(nd) : nd;
#pragma unroll
    for (int i = 0; i < 32; ++i) { const int kk = 2 * i + (lane >> 5); tv[i] = (sc >= 0) ? I.W[(size_t)(I.k0 + kk) * I.ldw + sc] : 0.f; }
}
__device__ __forceinline__ void p0_tr_finish(const TrItem& I, const float (&tv)[32], LAS float* scr, int lane) {
#pragma unroll
    for (int i = 0; i < 32; ++i) { const int kk = 2 * i + (lane >> 5); scr[kk * 33 + (lane & 31)] = tv[i]; }
    LDS_WAIT(); asm volatile("" ::: "memory");
    const int c = lane & 7;
#pragma unroll
    for (int j = 0; j < 4; ++j) { const int n = (lane >> 3) + 8 * j; const LAS float* s = scr + (8 * c) * 33 + n;
        v4u o; o.x = pk2(s[0 * 33], s[1 * 33]); o.y = pk2(s[2 * 33], s[3 * 33]); o.z = pk2(s[4 * 33], s[5 * 33]); o.w = pk2(s[6 * 33], s[7 * 33]);
        *(v4u*)(I.WT + (size_t)(I.n0 + n) * I.ldt + I.k0 + 8 * c) = o; }
    LDS_WAIT(); asm volatile("" ::: "memory");
}
template <bool MAP> __device__ __forceinline__ void p0_tr_item(const float* W, int ldw, bf16* WT, int ldt, int k0, int n0, LAS float* scr, int lane) {
    TrItem I{W, WT, ldw, ldt, k0, n0, MAP}; float tv[32]; p0_tr_load(I, tv, lane); p0_tr_finish(I, tv, scr, lane);
}
template <bool MAP> __device__ __forceinline__ void p0_tr_item2(const float* W, int ldw, bf16* WT, int ldt, int k0, int n0, LAS float* scr, int lane) {
    TrItem I0{W, WT, ldw, ldt, k0, n0, MAP}, I1{W, WT, ldw, ldt, k0, n0 + 32, MAP}; float t0[32], t1[32];
    p0_tr_load(I0, t0, lane); p0_tr_load(I1, t1, lane); p0_tr_finish(I0, t0, scr, lane); p0_tr_finish(I1, t1, scr, lane);
}
__device__ __forceinline__ void sincos_acc(float ang, float& s, float& c) {
    const double a = (double)ang; const double kq = rint(a * 0.63661977236758134308); const double r = fma(-kq, 1.57079632679489661923, a);
    const double r2 = r * r;
    const double sp = r * (1.0 + r2 * (-1.6666666666666666e-1 + r2 * (8.3333333333333332e-3 + r2 * (-1.9841269841269841e-4 + r2 * (2.7557319223985893e-6 + r2 * (-2.5052108385441720e-8))))));
    const double cp = 1.0 + r2 * (-0.5 + r2 * (4.1666666666666664e-2 + r2 * (-1.3888888888888889e-3 + r2 * (2.4801587301587302e-5 + r2 * (-2.7557319223985888e-7 + r2 * 2.0876756987868099e-9)))));
    const int q = ((int)kq) & 3;
    const double ss = (q == 0) ? sp : (q == 1) ? cp : (q == 2) ? -sp : -cp;
    const double cc = (q == 0) ? cp : (q == 1) ? -sp : (q == 2) ? -cp : sp;
    s = (float)ss; c = (float)cc;
}

__device__ __forceinline__ void p0_prologue(Frame& F) {
    const int gw = F.bid * NWAVES + F.wave, NGW = F.G * NWAVES, lane = F.lane;
    LAS float* scr = (LAS float*)(F.lds + F.wave * 16384);
    {
        constexpr int I_IN = 16 * 240, I_BR = 8 * 32, I_OUT = 16 * 32, I_UP = 16 * 176, I_DN = 44 * 32, I_L = I_IN + 3 * I_BR + I_OUT + I_UP + I_DN;
        for (int it = gw; it < 2 * I_L; it += NGW) {
            const int l = it / I_L; int r = it % I_L;
            if (r < I_IN) { p0_tr_item<true>(FIN(I_WIN) + (size_t)l * DM * D_IN, D_IN, WSP(bf16, WS_WIN) + (size_t)l * NIN * DM, DM, 64 * (r / 240), 32 * (r % 240), scr, lane); continue; } r -= I_IN;
            if (r < 3 * I_BR) { const int w = r / I_BR, q = r % I_BR; const float* src = FIN(w == 0 ? I_WBRA : (w == 1 ? I_WBRB : I_WBRC)) + (size_t)l * 512 * 1024;
                p0_tr_item<false>(src, 1024, WSP(bf16, WS_WBR) + (size_t)(l * 3 + w) * 1024 * 512, 512, 64 * (q / 32), 32 * (q % 32), scr, lane); continue; } r -= 3 * I_BR;
            if (r < I_OUT) { p0_tr_item<false>(FIN(I_WOUT) + (size_t)l * 1024 * 1024, 1024, WSP(bf16, WS_WOUT) + (size_t)l * 1024 * 1024, 1024, 64 * (r / 32), 32 * (r % 32), scr, lane); continue; } r -= I_OUT;
            if (r < I_UP) { p0_tr_item<false>(FIN(I_WUP) + (size_t)l * DM * NUP, NUP, WSP(bf16, WS_WUP) + (size_t)l * NUP * DM, DM, 64 * (r / 176), 32 * (r % 176), scr, lane); continue; } r -= I_UP;
            p0_tr_item<false>(FIN(I_WDN) + (size_t)l * DFF * DM, DM, WSP(bf16, WS_WDN) + (size_t)l * DM * DFF, DFF, 64 * (r / 32), 32 * (r % 32), scr, lane);
        }
    }
    {
        constexpr int NI_W1 = 8 * 16 * 4, NI_W2 = 4 * 2 * 2, NI_RG = 32 * 2;
        for (int it = gw; it < NI_W1 + NI_W2 + NI_RG; it += NGW) {
            int r = it;
            if (r < NI_W1) { const int m = r / 64, q = r % 64, lk = m >> 1, half = m & 1;
                p0_tr_item<false>(FIN(I_W1) + ((size_t)lk * 32 + half * 16) * 64 * 128, 128, WSP(bf16, WS_SMALLW + SW_W1T) + ((size_t)lk * 256 + half * 128) * 1024, 1024, 64 * (q / 4), 32 * (q % 4), scr, lane); continue; } r -= NI_W1;
            if (r < NI_W2) { const int lk = r / 4, q = r % 4;
                p0_tr_item<false>(FIN(I_W2) + (size_t)lk * 128 * 64, 64, WSP(bf16, WS_SMALLW + SW_W2T) + (size_t)lk * 64 * 128, 128, 64 * (q / 2), 32 * (q % 2), scr, lane); continue; } r -= NI_W2;
            { const int m = r / 2, q = r % 2, l = m >> 4, which = (m >> 3) & 1, blk = m & 7;
                p0_tr_item<false>(FIN(which ? I_RWX : I_RWA) + ((size_t)l * 8 + blk) * 4096, 64, WSP(bf16, WS_SMALLW + SW_WAT) + (size_t)m * 4096, 64, 0, 32 * q, scr, lane); }
        }
    }
    for (int it = gw; it < 64; it += NGW) {
        const int lk = it >> 4, h0 = (it & 15) * 8; const float* pe = FIN(I_PE) + (size_t)lk * 2048; const float* w1 = FIN(I_W1) + (size_t)lk * 2048 * 128 + h0;
        f32x4 a0 = (f32x4){0.f, 0.f, 0.f, 0.f}, a1 = a0;
#pragma unroll 8
        for (int i = lane; i < 2048; i += 64) { const float p = pe[i]; a0 += *(const f32x4*)(w1 + (size_t)i * 128) * p; a1 += *(const f32x4*)(w1 + (size_t)i * 128 + 4) * p; }
#pragma unroll
        for (int x = 0; x < 4; ++x) { a0[x] = wave_sum(a0[x]); a1[x] = wave_sum(a1[x]); }
        if (lane == 0) { float* cb = WSP(float, WS_SMALLW + SW_CB) + lk * 128 + h0; const float* b1 = FIN(I_B1) + lk * 128 + h0;
#pragma unroll
            for (int x = 0; x < 4; ++x) { cb[x] = a0[x] + b1[x]; cb[4 + x] = a1[x] + b1[4 + x]; } }
    }
    for (int i = F.bid * NTHR + F.tid; i < 1024; i += F.G * NTHR) { const float lam = FIN(I_LAM)[i]; WSP(float, WS_SMALLW + SW_SP)[i] = log1pf(expf(-lam)); }
    for (int i = F.bid * NTHR + F.tid; i < 2 * SB * 2 * DFF; i += F.G * NTHR) WSP(bf16, WS_SFB)[i] = (bf16)(pk2(FIN(I_SFFN)[i], 0.f) & 0xffffu);
    for (int i = F.bid * NTHR + F.tid; i < 4104 * 64; i += F.G * NTHR) {
        const int pi = i >> 6, fi = i & 63; const float pos = (float)(pi < PT ? pi : PAST + (pi - PT));
        const float freq = (float)pow(10000.0, -(double)fi / 64.0); const float ang = pos * freq; float s, c; sincos_acc(ang, s, c);
        WSP(float, WS_ROT)[i] = c; WSP(float, WS_ROT)[4104 * 64 + i] = s;
    }
    {
        LAS float* SC = (LAS float*)(F.lds + 0);
        LAS float* RED = (LAS float*)(F.lds + 36864);
        for (int u = F.bid; u < 2 * 96; u += F.G) {
            const int l = u / 96, cg = u % 96; float acc[36];
#pragma unroll
            for (int b = 0; b < 36; ++b) acc[b] = 0.f;
#pragma unroll 1
            for (int kq = 0; kq < 4; ++kq) { const int kh = (kq + u) & 3;
                __syncthreads();
                {   float cv[18];
                    const float* cpp = FIN(I_CP); const float* csp = FIN(I_CS);
#pragma unroll
                    for (int it = 0; it < 18; ++it) { const int i = F.tid + NTHR * it, bb = i >> 8, d = i & 255;
                        cv[it] = (bb < 4) ? cpp[bb * DM + kh * 256 + d] : csp[(bb - 4) * DM + kh * 256 + d]; }
#pragma unroll
                    for (int it = 0; it < 18; ++it) { const int i = F.tid + NTHR * it, bb = i >> 8, d = i & 255; SC[d * 36 + bb] = siluf_(cv[it]); }
                }
                __syncthreads();
                const float* wp = FIN(I_WADA) + ((size_t)l * DM + kh * 256 + F.wave * 32) * 6144 + cg * 64 + lane;
                {
                    float wv[32];
#pragma unroll
                    for (int k = 0; k < 32; ++k) wv[k] = wp[(size_t)k * 6144];
                    const LAS f32x4* scb = (const LAS f32x4*)(SC + (F.wave * 32) * 36);
                    f32x4 sa[9], sb[9];
#pragma unroll
                    for (int g = 0; g < 9; ++g) sa[g] = scb[g];
#pragma unroll
                    for (int k = 0; k < 32; k += 2) {
#pragma unroll
                        for (int g = 0; g < 9; ++g) sb[g] = scb[(k + 1) * 9 + g];
#pragma unroll
                        for (int g = 0; g < 9; ++g) { acc[4 * g + 0] += wv[k] * sa[g][0]; acc[4 * g + 1] += wv[k] * sa[g][1]; acc[4 * g + 2] += wv[k] * sa[g][2]; acc[4 * g + 3] += wv[k] * sa[g][3]; }
                        if (k + 2 < 32) {
#pragma unroll
                            for (int g = 0; g < 9; ++g) sa[g] = scb[(k + 2) * 9 + g]; }
#pragma unroll
                        for (int g = 0; g < 9; ++g) { acc[4 * g + 0] += wv[k + 1] * sb[g][0]; acc[4 * g + 1] += wv[k + 1] * sb[g][1]; acc[4 * g + 2] += wv[k + 1] * sb[g][2]; acc[4 * g + 3] += wv[k + 1] * sb[g][3]; }
                    }
                }
            }
#pragma unroll
            for (int b = 0; b < 36; ++b) RED[(F.wave * 36 + b) * 64 + lane] = acc[b];
            __syncthreads();
            for (int o = F.tid; o < 36 * 64; o += NTHR) { const int b = o >> 6, col = o & 63; float sm = FIN(I_BADA)[l * 6144 + cg * 64 + col];
#pragma unroll
                for (int w = 0; w < 8; ++w) sm += RED[(w * 36 + b) * 64 + col];
                WSP(float, WS_MOD)[((size_t)l * 36 + b) * 6144 + cg * 64 + col] = sm; }
        }
        __syncthreads();
    }
    {   constexpr size_t NV4 = (size_t)2 * SB * 504 * 64; const size_t stride = (size_t)F.G * NTHR;
        for (size_t i0 = (size_t)F.bid * NTHR + F.tid; i0 < NV4; i0 += 8 * stride) {
            f32x4 v[8];
#pragma unroll
            for (int k = 0; k < 8; ++k) { const size_t i = i0 + k * stride; if (i < NV4) { const size_t seq = i / (504 * 64), r = i % (504 * 64); v[k] = __builtin_nontemporal_load((const f32x4*)(FIN(I_CWIN) + (seq * 512 + 8) * 256 + r * 4)); } }
#pragma unroll
            for (int k = 0; k < 8; ++k) { const size_t i = i0 + k * stride; if (i < NV4) { const size_t seq = i / (504 * 64), r = i % (504 * 64); *(f32x4*)(F.out + OUT_WIN_S + seq * 512 * 256 + r * 4) = v[k]; } }
        }
    }
}

__device__ __forceinline__ f32x4 ld4_bf(const bf16* p) { const v2u w = *(const v2u*)p; return (f32x4){bf_lo(w.x), bf_hi(w.x), bf_lo(w.y), bf_hi(w.y)}; }
__device__ __forceinline__ void norm_phase(Frame& F, int l, int which) {
    const int gw = F.bid * NWAVES + F.wave, NGW = F.G * NWAVES, lane = F.lane;
    const float* g = FIN(which ? I_N2G : I_N1G) + l * DM;
    constexpr int NR = 4;
    for (int row0 = gw * NR; row0 < MT; row0 += NGW * NR) {
        f32x4 v[NR][4]; float ss[NR];
#pragma unroll
        for (int rr = 0; rr < NR; ++rr) { const int row = row0 + rr;
            if (which == 0 && l == 0) { const float* xr = row < PM ? FIN(I_XP) + (size_t)row * DM : FIN(I_XS) + (size_t)(row - PM) * DM;
#pragma unroll
                for (int j = 0; j < 4; ++j) v[rr][j] = *(const f32x4*)(xr + lane * 4 + 256 * j); }
            else { const bf16* xr = WSP(bf16, which ? WS_X1 : WS_X2) + (size_t)row * DM;
#pragma unroll
                for (int j = 0; j < 4; ++j) v[rr][j] = ld4_bf(xr + lane * 4 + 256 * j); } }
#pragma unroll
        for (int rr = 0; rr < NR; ++rr) { float a = 0.f;
#pragma unroll
            for (int j = 0; j < 4; ++j) a += (v[rr][j][0] * v[rr][j][0] + v[rr][j][1] * v[rr][j][1]) + (v[rr][j][2] * v[rr][j][2] + v[rr][j][3] * v[rr][j][3]);
            ss[rr] = a; }
#pragma unroll
        for (int o = 1; o < 64; o <<= 1) {
#pragma unroll
            for (int rr = 0; rr < NR; ++rr) ss[rr] += __shfl_xor(ss[rr], o); }
#pragma unroll
        for (int rr = 0; rr < NR; ++rr) { const int row = row0 + rr; const float rs = 1.0f / sqrtf(ss[rr] * (1.0f / DM) + EPS);
            const float* mod = WSP(float, WS_MOD) + ((size_t)l * 36 + row_bb(row)) * 6144 + (which ? 3072 : 0); bf16* o = WSP(bf16, WS_H) + (size_t)row * DM;
#pragma unroll
            for (int j = 0; j < 4; ++j) { const int c = lane * 4 + 256 * j; const f32x4 gg = *(const f32x4*)(g + c), sh = *(const f32x4*)(mod + c), sc = *(const f32x4*)(mod + 1024 + c);
                const f32x4 y = (v[rr][j] * rs) * gg * (sc + 1.0f) + sh; v2u w; w.x = pk2(y[0], y[1]); w.y = pk2(y[2], y[3]); *(v2u*)(o + c) = w; } }
    }
}
__device__ __forceinline__ void final_phase(Frame& F) {
    const int gw = F.bid * NWAVES + F.wave, NGW = F.G * NWAVES, lane = F.lane;
    const float* g = FIN(I_FNG);
    for (int row0 = gw * 4; row0 < MT; row0 += NGW * 4) {
        f32x4 v[4][4]; float ss[4];
#pragma unroll
        for (int rr = 0; rr < 4; ++rr) { const bf16* xr = WSP(bf16, WS_X2) + (size_t)(row0 + rr) * DM; float a = 0.f;
#pragma unroll
            for (int j = 0; j < 4; ++j) { v[rr][j] = ld4_bf(xr + lane * 4 + 256 * j); a += (v[rr][j][0] * v[rr][j][0] + v[rr][j][1] * v[rr][j][1]) + (v[rr][j][2] * v[rr][j][2] + v[rr][j][3] * v[rr][j][3]); }
            ss[rr] = a; }
#pragma unroll
        for (int rr = 0; rr < 4; ++rr) { const float rs = 1.0f / sqrtf(wave_sum(ss[rr]) * (1.0f / DM) + EPS);
            float* o = F.out + OUT_Y + (size_t)(row0 + rr) * DM;
#pragma unroll
            for (int j = 0; j < 4; ++j) { const int c = lane * 4 + 256 * j; *(f32x4*)(o + c) = (v[rr][j] * rs) * *(const f32x4*)(g + c); } }
    }
}

#define EPI_LOOP_BEGIN \
    _Pragma("unroll") for (int ai = 0; ai < 2; ++ai) _Pragma("unroll") for (int m = 0; m < 4; ++m) { const int row = u.pm * 256 + ai * 128 + wr * 64 + m * 16 + fr; \
    _Pragma("unroll") for (int bj = 0; bj < 2; ++bj) { const int ct = bj * 128 + wc * 32 + 8 * fq; const f32x4 v0 = acc[ai][bj][m][0], v1 = acc[ai][bj][m][1];
#define EPI_LOOP_END } }

struct EpiWin {
    static constexpr bool PERM = true, AFTER_DRAIN = false;
    unsigned char* ws; float* out; int l;
    __device__ __forceinline__ void operator()(const f32x4 (&acc)[2][2][4][2], const pg8::Unit& u, int wr, int wc, int fr0, int fq0) const {
        int fr = fr0, fq = fq0; asm volatile("" : "+v"(fr), "+v"(fq));
        const int pn = u.pn;
        if (pn < 2) {
            bf16* QN = (bf16*)(ws + WS_QN);
            EPI_LOOP_BEGIN *(v4u*)(QN + (size_t)row * 512 + pn * 256 + ct) = pack8(v0 * QSCALE, v1 * QSCALE); EPI_LOOP_END
        } else if (pn < 5) {
            EPI_LOOP_BEGIN
                const int c = (pn - 2) * 256 + ct, j = c >> 7, k = (c >> 6) & 1, d = c & 63;
                const bool isp = row < PM; const int b = isp ? (row >> 12) : ((row - PM) >> 3), t = isp ? (row & (PT - 1)) : ((row - PM) & 7);
                if (j < 4) { float* o = out + (isp ? OUT_ROWS_P + ((size_t)l * PM + row) * 512 : OUT_ROWS_S + ((size_t)l * SM + (row - PM)) * 512) + c; *(f32x4*)o = v0; *(f32x4*)(o + 4) = v1; }
                else if (isp) { if (t >= PT - WINB) { float* o = out + OUT_WIN_P + (((size_t)l * PB + b) * WINB + (t - (PT - WINB))) * 256 + (c - 512); *(f32x4*)o = v0; *(f32x4*)(o + 4) = v1; } }
                else { float* o = out + OUT_WIN_S + (((size_t)l * SB + b) * WINB + (WINB - ST) + t) * 256 + (c - 512); *(f32x4*)o = v0; *(f32x4*)(o + 4) = v1; }
                const v4u w = pack8(v0, v1);
                if (isp) {
                    if (j < 2) *(v4u*)((bf16*)(ws + WS_ACMP) + ((size_t)(l * 2 + j) * CMP_ROWS_J + 32768 + (b * 2 + k) * 256) * 1024 + (size_t)t * 64 + d) = w;
                    else if (j & 1) {
                        const int tq = t & 31, s2 = tq >> 4, hh = (tq >> 2) & 1, ii = (tq & 3) + 4 * ((tq >> 3) & 1);
                        bf16* vt = (bf16*)(ws + WS_KVB) + (((size_t)(j - 2) * PB + b) * 2 + k) * PT * 64 + (size_t)(t >> 5) * 2048 + ((((d >> 5) * 2 + s2) * 2 + hh) * 32 + (d & 31)) * 8 + ii;
                        vt[0] = (bf16)(w.x & 0xffffu); vt[8] = (bf16)(w.x >> 16); vt[16] = (bf16)(w.y & 0xffffu); vt[24] = (bf16)(w.y >> 16);
                        vt[32] = (bf16)(w.z & 0xffffu); vt[40] = (bf16)(w.z >> 16); vt[48] = (bf16)(w.w & 0xffffu); vt[56] = (bf16)(w.w >> 16); }
                    else *(v4u*)((bf16*)(ws + WS_KVB) + (((size_t)(j - 2) * PB + b) * 2 + k) * PT * 64 + (size_t)(t >> 5) * 2048 + ((d >> 3) * 32 + (t & 31)) * 8) = w;
                } else if (j >= 2) *(v4u*)((bf16*)(ws + WS_KVS) + ((((size_t)(j - 2) * SB + b) * 2 + k) * ST + t) * 64 + d) = w;
            EPI_LOOP_END
        } else if (pn < 9) {
            const float* ROTC = (const float*)(ws + WS_ROT); const float* ROTS = ROTC + 4104 * 64;
#pragma unroll
            for (int ai = 0; ai < 2; ++ai) {
                f32x4 cs[4][2], sn[4][2];
#pragma unroll
                for (int m = 0; m < 4; ++m) { const int row = u.pm * 256 + ai * 128 + wr * 64 + m * 16 + fr; const int pi = row_pos(row);
#pragma unroll
                    for (int bj = 0; bj < 2; ++bj) { const int ct = bj * 128 + wc * 32 + 8 * fq; const int c = (pn - 5) * 256 + ct, d0 = (((c & 511) & 127) >> 3) * 4; cs[m][bj] = *(const f32x4*)(ROTC + pi * 64 + d0); sn[m][bj] = *(const f32x4*)(ROTS + pi * 64 + d0); } }
#pragma unroll
                for (int m = 0; m < 4; ++m) { const int row = u.pm * 256 + ai * 128 + wr * 64 + m * 16 + fr;
#pragma unroll
                    for (int bj = 0; bj < 2; ++bj) { const int ct = bj * 128 + wc * 32 + 8 * fq; const f32x4 v0 = acc[ai][bj][m][0], v1 = acc[ai][bj][m][1];
                        const int c = (pn - 5) * 256 + ct, isk = c >> 9, hc = c & 511, head = hc >> 7, d0 = ((hc & 127) >> 3) * 4;
                        const float sc = isk ? 0.08838834764831845f : 1.0f;
                        const f32x4 o1 = (v0 * cs[m][bj] - v1 * sn[m][bj]) * sc, o2 = (v0 * sn[m][bj] + v1 * cs[m][bj]) * sc;
                        bf16* o = (bf16*)(ws + WS_RQ) + (size_t)isk * MT * 512 + (size_t)row * 512 + head * 128 + d0;
                        v2u w1; w1.x = pk2(o1[0], o1[1]); w1.y = pk2(o1[2], o1[3]); *(v2u*)o = w1;
                        v2u w2; w2.x = pk2(o2[0], o2[1]); w2.y = pk2(o2[2], o2[3]); *(v2u*)(o + 64) = w2; } }
            }
        } else if (pn < 13) {
            bf16* RV = (bf16*)(ws + WS_RQ) + (size_t)2 * MT * 512;
            EPI_LOOP_BEGIN const int c = (pn - 9) * 256 + ct; *(v4u*)(RV + (size_t)(c >> 9) * MT * 512 + (size_t)row * 512 + (c & 511)) = pack8(v0, v1); EPI_LOOP_END
        } else if (pn < 15) {
            float* RX = (float*)(ws + WS_RX);
            EPI_LOOP_BEGIN
                const int c = (pn - 13) * 256 + ct; float* o = RX + (size_t)row * 512 + c; *(f32x4*)o = v0; *(f32x4*)(o + 4) = v1;
                if (row < PM) { const int t = row & (PT - 1); if (t >= PT - 3) { float* q = out + OUT_CV_P + (((size_t)l * PB + (row >> 12)) * 3 + (t - (PT - 3))) * 512 + c; *(f32x4*)q = v0; *(f32x4*)(q + 4) = v1; } }
                else { const int i = (row - PM) & 7; if (i >= ST - 3) { float* q = out + OUT_CV_S + (((size_t)l * SB + ((row - PM) >> 3)) * 3 + (i - (ST - 3))) * 512 + c; *(f32x4*)q = v0; *(f32x4*)(q + 4) = v1; } }
            EPI_LOOP_END
        } else if (pn < 17) {
            bf16* GG = (bf16*)(ws + WS_GG);
            EPI_LOOP_BEGIN const int c = (pn - 15) * 256 + ct;
                f32x4 a, b;
#pragma unroll
                for (int i = 0; i < 4; ++i) { a[i] = gelu_tanh(v0[i]); b[i] = gelu_tanh(v1[i]); }
                *(v4u*)(GG + (size_t)row * 512 + c) = pack8(a, b); EPI_LOOP_END
        } else if (pn < 29) {
            bf16* MG = (bf16*)(ws + WS_MGS);
            EPI_LOOP_BEGIN const int c = (pn - 17) * 256 + ct;
                f32x4 a, b;
#pragma unroll
                for (int i = 0; i < 4; ++i) { a[i] = sigmoidf_(v0[i]); b[i] = sigmoidf_(v1[i]); }
                *(v4u*)(MG + (size_t)row * 3072 + c) = pack8(a, b); EPI_LOOP_END
        } else {
            float* NG = (float*)(ws + WS_NG);
            EPI_LOOP_BEGIN if (ct < 24) { f32x4 a, b;
#pragma unroll
                for (int i = 0; i < 4; ++i) { a[i] = sigmoidf_(v0[i]); b[i] = sigmoidf_(v1[i]); }
                float* o = NG + (size_t)row * 24 + ct; *(f32x4*)o = a; *(f32x4*)(o + 4) = b; } EPI_LOOP_END
        }
    }
};

struct EpiLH {
    static constexpr bool PERM = true, AFTER_DRAIN = false;
    bf16* LH;
    __device__ __forceinline__ void operator()(const f32x4 (&acc)[2][2][4][2], const pg8::Unit& u, int wr, int wc, int fr0, int fq0) const {
        int fr = fr0, fq = fq0; asm volatile("" : "+v"(fr), "+v"(fq));
        EPI_LOOP_BEGIN *(v4u*)(LH + (size_t)row * 256 + ct) = pack8(v0, v1); EPI_LOOP_END
    }
};
struct CmpOrder {
    int G, c;
    __device__ bool next(int i, pg8::Unit& u) const { const int L = i * G + c; if (L >= CMP_ROWS / 256) return false; u.pm = L; u.pn = L / (CMP_ROWS_J / 256); return true; }
    __device__ __forceinline__ void a_ready(const pg8::Unit&) const {}
    __device__ __forceinline__ void done(const pg8::Unit&) const {}
};

template <int BR> struct EpiBr {
    static constexpr bool PERM = true, AFTER_DRAIN = false;
    unsigned char* ws;
    __device__ __forceinline__ void operator()(const f32x4 (&acc)[2][2][4][2], const pg8::Unit& u, int wr, int wc, int fr0, int fq0) const {
        int fr = fr0, fq = fq0; asm volatile("" : "+v"(fr), "+v"(fq));
        const bf16* MG = (const bf16*)(ws + WS_MGS); bf16* MR = (bf16*)(ws + WS_MRG);
        EPI_LOOP_BEGIN
            const int col = u.pn * 256 + ct; f32x4 g0, g1; unpack8(*(const v4u*)(MG + (size_t)row * 3072 + BR * 1024 + col), g0, g1);
            f32x4 r0 = v0 * g0, r1 = v1 * g1; bf16* o = MR + (size_t)row * DM + col;
            if (BR > 0) { f32x4 p0, p1; unpack8(*(const v4u*)o, p0, p1); r0 += p0; r1 += p1; }
            *(v4u*)o = pack8(r0, r1);
        EPI_LOOP_END
    }
};

struct BrOrder {
    pg8::StaticOrder S;
    __device__ bool next(int i, pg8::Unit& u) const { pg8::Unit t; if (!S.next(i / 3, t)) return false; const int br = i % 3; u.pm = br * (MT / 256) + t.pm; u.pn = br * 4 + t.pn; return true; }
    __device__ __forceinline__ void a_ready(const pg8::Unit&) const {}
    __device__ __forceinline__ void done(const pg8::Unit&) const {}
};
struct EpiBrAll {
    static constexpr bool PERM = true, AFTER_DRAIN = false;
    unsigned char* ws;
    __device__ __forceinline__ void operator()(const f32x4 (&acc)[2][2][4][2], const pg8::Unit& u0, int wr, int wc, int fr0, int fq0) const {
        int fr = fr0, fq = fq0; asm volatile("" : "+v"(fr), "+v"(fq));
        const int br = u0.pn >> 2; const pg8::Unit u{u0.pm - br * (MT / 256), u0.pn & 3};
        const bf16* MG = (const bf16*)(ws + WS_MGS) + br * 1024; bf16* MR = (bf16*)(ws + WS_MRG);
#pragma unroll
        for (int ai = 0; ai < 2; ++ai) {
            v4u gw[4][2], pw[4][2];
#pragma unroll
            for (int m = 0; m < 4; ++m) { const int row = u.pm * 256 + ai * 128 + wr * 64 + m * 16 + fr;
#pragma unroll
                for (int bj = 0; bj < 2; ++bj) { const int col = u.pn * 256 + bj * 128 + wc * 32 + 8 * fq; gw[m][bj] = *(const v4u*)(MG + (size_t)row * 3072 + col); if (br != 0) pw[m][bj] = *(const v4u*)(MR + (size_t)row * DM + col); } }
#pragma unroll
            for (int m = 0; m < 4; ++m) { const int row = u.pm * 256 + ai * 128 + wr * 64 + m * 16 + fr;
#pragma unroll
                for (int bj = 0; bj < 2; ++bj) { const int col = u.pn * 256 + bj * 128 + wc * 32 + 8 * fq; const f32x4 v0 = acc[ai][bj][m][0], v1 = acc[ai][bj][m][1];
                    f32x4 g0, g1; unpack8(gw[m][bj], g0, g1); f32x4 r0 = v0 * g0, r1 = v1 * g1;
                    if (br != 0) { f32x4 p0, p1; unpack8(pw[m][bj], p0, p1); r0 += p0; r1 += p1; }
                    *(v4u*)(MR + (size_t)row * DM + col) = pack8(r0, r1); } }
        }
    }
};

template <bool INF32> struct EpiRes {
    static constexpr bool PERM = true, AFTER_DRAIN = false;
    const void* xin_p; bf16* xout; const float* mod; int gofs;
    __device__ __forceinline__ void operator()(const f32x4 (&acc)[2][2][4][2], const pg8::Unit& u, int wr, int wc, int fr0, int fq0) const {
        int fr = fr0, fq = fq0; asm volatile("" : "+v"(fr), "+v"(fq));
#pragma unroll
        for (int ai = 0; ai < 2; ++ai) {
            const float* gp = mod + (size_t)row_bb(u.pm * 256 + ai * 128) * 6144 + gofs + u.pn * 256 + wc * 32 + 8 * fq;
            f32x4 g[2][2];
#pragma unroll
            for (int bj = 0; bj < 2; ++bj) { g[bj][0] = *(const f32x4*)(gp + 128 * bj); g[bj][1] = *(const f32x4*)(gp + 128 * bj + 4); }
            if (INF32) {
#pragma unroll
                for (int mh = 0; mh < 2; ++mh) {
                    f32x4 xv[2][2][2];
#pragma unroll
                    for (int m2 = 0; m2 < 2; ++m2) { const int row = u.pm * 256 + ai * 128 + wr * 64 + (2 * mh + m2) * 16 + fr;
#pragma unroll
                        for (int bj = 0; bj < 2; ++bj) { const float* xi = (const float*)xin_p + (size_t)row * DM + u.pn * 256 + bj * 128 + wc * 32 + 8 * fq; xv[m2][bj][0] = *(const f32x4*)xi; xv[m2][bj][1] = *(const f32x4*)(xi + 4); } }
#pragma unroll
                    for (int m2 = 0; m2 < 2; ++m2) { const int m = 2 * mh + m2; const int row = u.pm * 256 + ai * 128 + wr * 64 + m * 16 + fr;
#pragma unroll
                        for (int bj = 0; bj < 2; ++bj) { const int col = u.pn * 256 + bj * 128 + wc * 32 + 8 * fq;
                            *(v4u*)(xout + (size_t)row * DM + col) = pack8(xv[m2][bj][0] + g[bj][0] * acc[ai][bj][m][0], xv[m2][bj][1] + g[bj][1] * acc[ai][bj][m][1]); } }
                }
            } else {
                v4u xw[4][2];
#pragma unroll
                for (int m = 0; m < 4; ++m) { const int row = u.pm * 256 + ai * 128 + wr * 64 + m * 16 + fr;
#pragma unroll
                    for (int bj = 0; bj < 2; ++bj) xw[m][bj] = *(const v4u*)((const bf16*)xin_p + (size_t)row * DM + u.pn * 256 + bj * 128 + wc * 32 + 8 * fq); }
#pragma unroll
                for (int m = 0; m < 4; ++m) { const int row = u.pm * 256 + ai * 128 + wr * 64 + m * 16 + fr;
#pragma unroll
                    for (int bj = 0; bj < 2; ++bj) { const int col = u.pn * 256 + bj * 128 + wc * 32 + 8 * fq; f32x4 x0, x1; unpack8(xw[m][bj], x0, x1);
                        *(v4u*)(xout + (size_t)row * DM + col) = pack8(x0 + g[bj][0] * acc[ai][bj][m][0], x1 + g[bj][1] * acc[ai][bj][m][1]); } }
            }
        }
    }
};

template <int CTRL> __device__ __forceinline__ v4u dpp4(const v4u old, const v4u src) {
    v4u r; r.x = (unsigned)__builtin_amdgcn_update_dpp((int)old.x, (int)src.x, CTRL, 0xf, 0xf, false); r.y = (unsigned)__builtin_amdgcn_update_dpp((int)old.y, (int)src.y, CTRL, 0xf, 0xf, false);
    r.z = (unsigned)__builtin_amdgcn_update_dpp((int)old.z, (int)src.z, CTRL, 0xf, 0xf, false); r.w = (unsigned)__builtin_amdgcn_update_dpp((int)old.w, (int)src.w, CTRL, 0xf, 0xf, false); return r; }
struct UpOrder {
    pg8::StaticOrder S;
    __device__ bool next(int i, pg8::Unit& u) const { pg8::Unit t; if (!S.next(i >> 1, t)) return false; u.pm = t.pm; u.pn = t.pn + 11 * (i & 1); return true; }
    __device__ __forceinline__ void a_ready(const pg8::Unit&) const {}
    __device__ __forceinline__ void done(const pg8::Unit&) const {}
};
struct EpiUp {
    static constexpr bool PERM = true, AFTER_DRAIN = false;
    unsigned char* ws; float* out; int l; const float* cw; const float* cbi; const bf16* sfb;
    __device__ __forceinline__ void operator()(const f32x4 (&acc)[2][2][4][2], const pg8::Unit& u, int wr, int wc, int fr0, int fq0) const {
        int fr = fr0, fq = fq0; asm volatile("" : "+v"(fr), "+v"(fq));
        bf16* GP = (bf16*)(ws + WS_GP); bf16* VAL = GP + (size_t)MT * DFF; bf16* ACT = GP + (size_t)2 * MT * DFF;
        if (u.pn < 11) {
            EPI_LOOP_BEGIN const int c = u.pn * 256 + ct; *(v4u*)(GP + (size_t)row * DFF + c) = pack8(v0, v1);
                if (row < PM) { const int t = row & (PT - 1); if (t >= PT - 2) { float* q = out + OUT_FC_P + (((size_t)l * PB + (row >> 12)) * 2 + (t - (PT - 2))) * DFF + c; *(f32x4*)q = v0; *(f32x4*)(q + 4) = v1; } }
                else { const int i = (row - PM) & 7; if (i >= ST - 2) { float* q = out + OUT_FC_S + (((size_t)l * SB + ((row - PM) >> 3)) * 2 + (i - (ST - 2))) * DFF + c; *(f32x4*)q = v0; *(f32x4*)(q + 4) = v1; } }
            EPI_LOOP_END
        } else if (u.pm * 256 >= PM) {
#pragma unroll
            for (int bj = 0; bj < 2; ++bj) { const int c = (u.pn - 11) * 256 + bj * 128 + wc * 32 + 8 * fq;
                const f32x4 w0a = *(const f32x4*)(cw + c), w0b = *(const f32x4*)(cw + c + 4), w1a = *(const f32x4*)(cw + DFF + c), w1b = *(const f32x4*)(cw + DFF + c + 4);
                const f32x4 w2a = *(const f32x4*)(cw + 2 * DFF + c), w2b = *(const f32x4*)(cw + 2 * DFF + c + 4), ba = *(const f32x4*)(cbi + c), bb = *(const f32x4*)(cbi + c + 4);
#pragma unroll
                for (int ai = 0; ai < 2; ++ai)
#pragma unroll
                  for (int mh = 0; mh < 2; ++mh) {
                    v4u g0[2], g1[2], g2[2];
#pragma unroll
                    for (int m2 = 0; m2 < 2; ++m2) { const int row = u.pm * 256 + ai * 128 + wr * 64 + (2 * mh + m2) * 16 + fr; const bf16* gp = GP + (size_t)row * DFF + c;
                        const bf16* sb = sfb + (size_t)((row - PM) >> 3) * 2 * DFF + c; const int i = (row - PM) & 7;
                        const bf16* q1 = (i < 1) ? sb + DFF : gp - DFF; const bf16* q2 = (i < 2) ? (i == 1 ? sb + DFF : sb) : gp - 2 * DFF;
                        g0[m2] = *(const v4u*)gp; g1[m2] = *(const v4u*)q1; g2[m2] = *(const v4u*)q2; }
#pragma unroll
                    for (int m2 = 0; m2 < 2; ++m2) { const int m = 2 * mh + m2; const int row = u.pm * 256 + ai * 128 + wr * 64 + m * 16 + fr; const int t = row & (PT - 1);
                        const f32x4 v0 = acc[ai][bj][m][0], v1 = acc[ai][bj][m][1];
                        if (false) { *(v4u*)(VAL + (size_t)row * DFF + c) = pack8(v0, v1); }
                        else { f32x4 xa, xb, pa, pb, qa, qb; unpack8(g0[m2], xa, xb); unpack8(g1[m2], pa, pb); unpack8(g2[m2], qa, qb);
                            f32x4 ya = ba + w0a * qa + w1a * pa + w2a * xa, yb = bb + w0b * qb + w1b * pb + w2b * xb;
#pragma unroll
                            for (int i = 0; i < 4; ++i) { ya[i] = siluf_(ya[i]) * v0[i]; yb[i] = siluf_(yb[i]) * v1[i]; }
                            *(v4u*)(ACT + (size_t)row * DFF + c) = pack8(ya, yb); } }
                  }
            }
                } else {
#pragma unroll
            for (int bj = 0; bj < 2; ++bj) { const int c = (u.pn - 11) * 256 + bj * 128 + wc * 32 + 8 * fq;
                const f32x4 w0a = *(const f32x4*)(cw + c), w0b = *(const f32x4*)(cw + c + 4), w1a = *(const f32x4*)(cw + DFF + c), w1b = *(const f32x4*)(cw + DFF + c + 4);
                const f32x4 w2a = *(const f32x4*)(cw + 2 * DFF + c), w2b = *(const f32x4*)(cw + 2 * DFF + c + 4), ba = *(const f32x4*)(cbi + c), bb = *(const f32x4*)(cbi + c + 4);
#pragma unroll
                for (int ai = 0; ai < 2; ++ai) {
                    v4u g[4], gm;
                    const int rowb = u.pm * 256 + ai * 128 + wr * 64 + fr;
#pragma unroll
                    for (int m = 0; m < 4; ++m) g[m] = *(const v4u*)(GP + (size_t)(rowb + m * 16) * DFF + c);
                    gm = (fr >= 14 && ((rowb - fr) & (PT - 1)) != 0) ? *(const v4u*)(GP + (size_t)(rowb - 16) * DFF + c) : (v4u){0u, 0u, 0u, 0u};
#pragma unroll
                    for (int m = 0; m < 4; ++m) { const int row = rowb + m * 16; const int t = row & (PT - 1);
                        const v4u pv = (m == 0) ? gm : g[m - 1];
                        const v4u t1 = dpp4<0x111>(dpp4<0x121>(pv, pv), g[m]), t2 = dpp4<0x112>(dpp4<0x122>(pv, pv), g[m]);
                        const f32x4 v0 = acc[ai][bj][m][0], v1 = acc[ai][bj][m][1];
                        if ((t & 255) < 2 && t >= 2) { *(v4u*)(VAL + (size_t)row * DFF + c) = pack8(v0, v1); }
                        else { f32x4 xa, xb, pa, pb, qa, qb; unpack8(g[m], xa, xb); unpack8(t1, pa, pb); unpack8(t2, qa, qb);
                            f32x4 ya = ba + w0a * qa + w1a * pa + w2a * xa, yb = bb + w0b * qb + w1b * pb + w2b * xb;
#pragma unroll
                            for (int i = 0; i < 4; ++i) { ya[i] = siluf_(ya[i]) * v0[i]; yb[i] = siluf_(yb[i]) * v1[i]; }
                            *(v4u*)(ACT + (size_t)row * DFF + c) = pack8(ya, yb); } }
                }
            }
        }
    }
};

__device__ __forceinline__ f32x16 mfma32(bf16x8 a, bf16x8 b, f32x16 c) { return __builtin_amdgcn_mfma_f32_32x32x16_bf16(a, b, c, 0, 0, 0); }
__device__ __forceinline__ f32x4 mfma16(bf16x8 a, bf16x8 b, f32x4 c) { return __builtin_amdgcn_mfma_f32_16x16x32_bf16(a, b, c, 0, 0, 0); }
__device__ __forceinline__ float ret_log_g(int h) { return log1pf(-exp2f(-5.0f - (float)h)); }
__device__ __forceinline__ bf16x8 tr_frag(const LAS unsigned char* base, int rs_bytes, int rowA, int rowB, int colbase, int lane) {
    const int q = (lane & 15) >> 2, p = lane & 3;
    const LAS unsigned char* pa = base + (rowA + q) * rs_bytes + (colbase + 4 * p) * 2;
    const LAS unsigned char* pb = base + (rowB + q) * rs_bytes + (colbase + 4 * p) * 2;
    const s16x4 a = __builtin_bit_cast(s16x4, __builtin_amdgcn_ds_read_tr16_b64_v4i16((LAS s16x4*)pa));
    const s16x4 b = __builtin_bit_cast(s16x4, __builtin_amdgcn_ds_read_tr16_b64_v4i16((LAS s16x4*)pb));
    return (bf16x8){a[0], a[1], a[2], a[3], b[0], b[1], b[2], b[3]};
}
__device__ __forceinline__ bf16x8 cvt_frag(const f32x16& p, int s2) {
    u32x4 w; w.x = pk2(p[8 * s2 + 0], p[8 * s2 + 1]); w.y = pk2(p[8 * s2 + 2], p[8 * s2 + 3]); w.z = pk2(p[8 * s2 + 4], p[8 * s2 + 5]); w.w = pk2(p[8 * s2 + 6], p[8 * s2 + 7]);
    return __builtin_bit_cast(bf16x8, w);
}

__device__ __forceinline__ void cmp2_phase(Frame& F, int l) {
    const int gw = F.bid * NWAVES + F.wave, NGW = F.G * NWAVES, lane = F.lane, r = lane & 15, g = lane >> 4;
    const bf16* LH = WSP(bf16, WS_LH); bf16* CK = WSP(bf16, WS_CK);
    const int j = gw & 1, gwj = gw >> 1, NGJ = NGW >> 1;
    const bf16* W2T = WSP(bf16, WS_SMALLW + SW_W2T) + (size_t)(l * 2 + j) * 64 * 128; const float* CB = WSP(float, WS_SMALLW + SW_CB) + (l * 2 + j) * 128;
    bf16x8 wf[4][4];
#pragma unroll
    for (int ks = 0; ks < 4; ++ks)
#pragma unroll
        for (int ct = 0; ct < 4; ++ct) wf[ks][ct] = *(const bf16x8*)(W2T + (size_t)(16 * ct + r) * 128 + 32 * ks + 8 * g);
    for (int wu = gwj; wu < CMP_ROWS_J / 16; wu += NGJ) {
        const int rj0 = wu * 16, rj = rj0 + r; const size_t row = (size_t)j * CMP_ROWS_J + rj;
        const bool valid = (rj < 32768) ? ((rj & 511) < 511) : (((rj - 32768) & 255) < 255);
        v4u la[4], lb[4];
#pragma unroll
        for (int ks = 0; ks < 4; ++ks) { const int h0 = 32 * ks + 8 * g; la[ks] = *(const v4u*)(LH + row * 256 + h0); lb[ks] = *(const v4u*)(LH + (row + 1) * 256 + 128 + h0); }
        f32x4 acc[4];
#pragma unroll
        for (int ct = 0; ct < 4; ++ct) acc[ct] = (f32x4){0.f, 0.f, 0.f, 0.f};
#pragma unroll
        for (int ks = 0; ks < 4; ++ks) {
            const int h0 = 32 * ks + 8 * g; f32x4 a0, a1, b0, b1;
            unpack8(la[ks], a0, a1); unpack8(lb[ks], b0, b1);
            const f32x4 c0 = *(const f32x4*)(CB + h0), c1 = *(const f32x4*)(CB + h0 + 4);
            f32x4 x0 = a0 + b0 + c0, x1 = a1 + b1 + c1;
#pragma unroll
            for (int i = 0; i < 4; ++i) { x0[i] = gelu_tanh(x0[i]); x1[i] = gelu_tanh(x1[i]); }
            const bf16x8 hf = __builtin_bit_cast(bf16x8, pack8(x0, x1));
#pragma unroll
            for (int ct = 0; ct < 4; ++ct) acc[ct] = mfma16(wf[ks][ct], hf, acc[ct]);
        }
#pragma unroll
        for (int ct = 0; ct < 4; ++ct) { const f32x4 v = valid ? acc[ct] : (f32x4){0.f, 0.f, 0.f, 0.f}; v2u w; w.x = pk2(v[0], v[1]); w.y = pk2(v[2], v[3]);
            *(v2u*)(CK + row * 64 + 16 * ct + 4 * g) = w; }
    }
}

constexpr int CG_RS = 144, CG_BUF = 256 * CG_RS, CG_AW = 2 * CG_BUF, CG_AT = 32 * CG_RS;
static_assert(CG_AW + 2 * 4 * CG_AT <= RING_BYTES, "compress GEMM LDS map");
template <bool smp> __device__ __forceinline__ void cmp_gemm_unit(Frame& F, int l, int j, int grp, int n00) {
    const int tid = F.tid, lane = F.lane, w = F.wave, q = lane & 31, h_ = lane >> 5, rg = w >> 1, ch = w & 1;
    const float* rp[4]; const bf16* ab = nullptr;
    if (smp) { const int db = grp >> 1, k = grp & 1;
#pragma unroll
        for (int i = 0; i < 4; ++i) { const int tt0 = (n00 + 32 * rg + 16 * ch + 4 * i + (lane >> 4)) * 16; const int page = ((const int*)F.a->in[I_PT])[db * NPG + (tt0 >> 7)];
            rp[i] = FIN(I_CACHE) + (((((size_t)l * NPHYS + page) * PAGE + (tt0 & 127)) * 4 + j) * 2 + k) * 64 + (lane & 15) * 4; } }
    else {
        ab = WSP(bf16, WS_ACMP) + ((size_t)(l * 2 + j) * CMP_ROWS_J + 32768 + grp * 256 + n00 + 32 * rg + 16 * ch + (lane >> 3)) * 1024 + (lane & 7) * 8;
#pragma unroll
        for (int i = 0; i < 4; ++i) rp[i] = nullptr; }
    const bf16* Bg = WSP(bf16, WS_SMALLW + SW_W1T) + (size_t)(l * 2 + j) * 256 * 1024;
    f32x16 acc[4];
#pragma unroll
    for (int ct = 0; ct < 4; ++ct) acc[ct] = (f32x16){};
    const bf16* bsrc = Bg + (size_t)(tid >> 1) * 1024 + (tid & 1) * 32; LAS unsigned char* bdst = F.lds + (tid >> 1) * CG_RS + (tid & 1) * 64;
    v4u bst[2][4]; f32x4 an[4][4]; v4u anb[4][2];
    __syncthreads();
#pragma unroll
    for (int x = 0; x < 4; ++x) bst[0][x] = *(const v4u*)(bsrc + 8 * x);
#pragma unroll
    for (int x = 0; x < 4; ++x) bst[1][x] = *(const v4u*)(bsrc + 64 + 8 * x);
#pragma unroll
    for (int d = 0; d < 4; ++d) {
        if (smp) {
#pragma unroll
            for (int i = 0; i < 4; ++i) an[d][i] = __builtin_nontemporal_load((const f32x4*)(rp[i] + (size_t)d * 512)); }
        else {
#pragma unroll
            for (int i = 0; i < 2; ++i) anb[d][i] = *(const v4u*)(ab + (size_t)(8 * i) * 1024 + d * 64); } }
#pragma unroll
    for (int x = 0; x < 4; ++x) *(LAS v4u*)(bdst + x * 16) = bst[0][x];
#define CG_CHUNK(d, LAST_) { const int kc = kc4 + (d); \
            LAS unsigned char* At = F.lds + CG_AW + (((d) & 1) * 4 + rg) * CG_AT; \
            if (!(LAST_) || (d) < 2) {                                   \
                _Pragma("unroll") for (int x = 0; x < 4; ++x) bst[(d) & 1][x] = *(const v4u*)(bsrc + (kc + 2) * 64 + 8 * x); } \
            if (smp) { \
                _Pragma("unroll") for (int i = 0; i < 4; ++i) { v2u o; o.x = pk2(an[d][i][0], an[d][i][1]); o.y = pk2(an[d][i][2], an[d][i][3]); *(LAS v2u*)(At + (16 * ch + 4 * i + (lane >> 4)) * CG_RS + (lane & 15) * 8) = o; } \
                if (!(LAST_)) { _Pragma("unroll") for (int i = 0; i < 4; ++i) an[d][i] = __builtin_nontemporal_load((const f32x4*)(rp[i] + (size_t)(kc + 4) * 512)); } \
            } else { \
                _Pragma("unroll") for (int i = 0; i < 2; ++i) *(LAS v4u*)(At + (16 * ch + 8 * i + (lane >> 3)) * CG_RS + (lane & 7) * 16) = anb[d][i]; \
                if (!(LAST_)) { _Pragma("unroll") for (int i = 0; i < 2; ++i) anb[d][i] = *(const v4u*)(ab + (size_t)(8 * i) * 1024 + (kc + 4) * 64); } \
            } \
            __syncthreads();                                           \
            bf16x8 ac[4]; \
            _Pragma("unroll") for (int ks = 0; ks < 4; ++ks) ac[ks] = *(const LAS bf16x8*)(At + q * CG_RS + ks * 32 + 16 * h_); \
            const LAS unsigned char* bb = F.lds + ((d) & 1) * CG_BUF + (128 * ch + q) * CG_RS + 16 * h_; \
            _Pragma("unroll") for (int ks = 0; ks < 4; ++ks) \
                _Pragma("unroll") for (int ct = 0; ct < 4; ++ct) { const bf16x8 bf = *(const LAS bf16x8*)(bb + ct * 32 * CG_RS + ks * 32); acc[ct] = mfma32(bf, ac[ks], acc[ct]); } \
            if (!(LAST_) || (d) < 3) { _Pragma("unroll") for (int x = 0; x < 4; ++x) *(LAS v4u*)(bdst + (((d) + 1) & 1) * CG_BUF + x * 16) = bst[((d) + 1) & 1][x]; } }
    int kc4 = 0;
#pragma unroll 1
    for (; kc4 < 12; kc4 += 4) { CG_CHUNK(0, false) CG_CHUNK(1, false) CG_CHUNK(2, false) CG_CHUNK(3, false) }
    { CG_CHUNK(0, true) CG_CHUNK(1, true) CG_CHUNK(2, true) CG_CHUNK(3, true) }
#undef CG_CHUNK
    bf16* LH = WSP(bf16, WS_LH) + ((size_t)j * CMP_ROWS_J + (smp ? grp * 512 : 32768 + grp * 256) + n00 + 32 * rg + q) * 256 + 128 * ch;
#pragma unroll
    for (int ct = 0; ct < 4; ++ct)
#pragma unroll
        for (int r4 = 0; r4 < 4; ++r4) { v2u o; o.x = pk2(acc[ct][4 * r4 + 0], acc[ct][4 * r4 + 1]); o.y = pk2(acc[ct][4 * r4 + 2], acc[ct][4 * r4 + 3]); *(v2u*)(LH + ct * 32 + 8 * r4 + 4 * h_) = o; }
}

constexpr int RS_KV = 272;
__device__ __forceinline__ void ret_local_unit(Frame& F, int unit) {
    const int bh = unit >> 5, c = unit & 31, b = bh >> 2, h = bh & 3, lane = F.lane, w = F.wave;
    const float lg = ret_log_g(h);
    LAS unsigned char* KS = F.lds; LAS unsigned char* VS = F.lds + 128 * RS_KV;
    const bf16* RK = WSP(bf16, WS_RQ) + (size_t)MT * 512; const bf16* RV = WSP(bf16, WS_RQ) + (size_t)2 * MT * 512;
    __syncthreads();
#pragma unroll
    for (int i = 0; i < 4; ++i) { const int p = F.tid + NTHR * i, j = p >> 4, ch = p & 15; const size_t go = (size_t)(b * PT + 128 * c + j) * 512 + h * 128 + ch * 8;
        f32x4 k0, k1; unpack8(*(const v4u*)(RK + go), k0, k1); const float kw = fexp((float)(127 - j) * lg);
        *(LAS v4u*)(KS + j * RS_KV + ch * 16) = pack8(k0 * kw, k1 * kw);
        *(LAS v4u*)(VS + j * RS_KV + ch * 16) = *(const v4u*)(RV + go); }
    __syncthreads();
    const int et = w >> 1, dt0 = 2 * (w & 1), h_ = lane >> 5, blk = (lane >> 4) & 1;
    f32x16 acc[2]; acc[0] = (f32x16){}; acc[1] = (f32x16){};
#pragma unroll
    for (int ks = 0; ks < 8; ++ks) {
        const int rA = 16 * ks + 8 * h_;
        const bf16x8 af = tr_frag(VS, RS_KV, rA, rA + 4, 32 * et + 16 * blk, lane);
#pragma unroll
        for (int dd = 0; dd < 2; ++dd) { const bf16x8 bfr = tr_frag(KS, RS_KV, rA, rA + 4, 32 * (dt0 + dd) + 16 * blk, lane); acc[dd] = mfma32(af, bfr, acc[dd]); }
    }
    bf16* LT = WSP(bf16, WS_LT) + ((size_t)bh * 32 + c) * 16384;
#pragma unroll
    for (int dd = 0; dd < 2; ++dd)
#pragma unroll
        for (int r = 0; r < 16; ++r) { const int e = 32 * et + (r & 3) + 8 * (r >> 2) + 4 * h_; LT[e * 128 + 32 * (dt0 + dd) + (lane & 31)] = (bf16)(pk2(acc[dd][r], 0.f) & 0xffffu); }
}
__device__ __forceinline__ void ret_scan_phase(Frame& F, int l) {
    const bf16* LT = WSP(bf16, WS_LT); bf16* SPT = WSP(bf16, WS_SPT);
    for (int idx = F.bid * NTHR + F.tid; idx < 16 * 16384; idx += F.G * NTHR) {
        const int bh = idx >> 14, ed = idx & 16383, e = ed >> 7, d = ed & 127, h = bh & 3; const float g128 = fexp(128.0f * ret_log_g(h));
        float S = 0.f;
        for (int c = 0; c < 32; ++c) { const size_t o = ((size_t)bh * 32 + c) * 16384 + ed; SPT[o] = (bf16)(pk2(S, 0.f) & 0xffffu); S = S * g128 + bf1(LT[o]); }
        F.out[OUT_RET_P + ((size_t)l * 16 + bh) * 16384 + d * 128 + e] = S;
    }
}
__device__ __forceinline__ void ret_out_unit(Frame& F, int l, int unit) {
    const int bh = unit >> 5, c = unit & 31, b = bh >> 2, h = bh & 3, lane = F.lane, w = F.wave, tid = F.tid;
    const float lg = ret_log_g(h);
    LAS unsigned char* KS = F.lds; LAS unsigned char* VS = F.lds + 128 * RS_KV; LAS float* OT = (LAS float*)F.lds; LAS float* STAT = (LAS float*)(F.lds + 2 * 128 * RS_KV);
    const bf16* RQ = WSP(bf16, WS_RQ); const bf16* RK = RQ + (size_t)MT * 512; const bf16* RV = RQ + (size_t)2 * MT * 512; const bf16* RG = RQ + (size_t)3 * MT * 512;
    const size_t row0 = (size_t)b * PT + 128 * c;
    __syncthreads();
#pragma unroll
    for (int i = 0; i < 4; ++i) { const int p = tid + NTHR * i, j = p >> 4, ch = p & 15; const size_t go = (row0 + j) * 512 + h * 128 + ch * 8;
        *(LAS v4u*)(KS + j * RS_KV + ch * 16) = *(const v4u*)(RK + go); *(LAS v4u*)(VS + j * RS_KV + ch * 16) = *(const v4u*)(RV + go); }
    const int it = w & 3, eh = w >> 2, h_ = lane >> 5, blk = (lane >> 4) & 1, il = 32 * it + (lane & 31);
    bf16x8 qf[8];
#pragma unroll
    for (int ks = 0; ks < 8; ++ks) qf[ks] = *(const bf16x8*)(RQ + (row0 + il) * 512 + h * 128 + 16 * ks + 8 * h_);
    f32x16 acc[2]; acc[0] = (f32x16){}; acc[1] = (f32x16){};
    const bf16* SP = WSP(bf16, WS_SPT) + ((size_t)bh * 32 + c) * 16384;
#pragma unroll
    for (int kb4 = 0; kb4 < 8; kb4 += 4) {
        bf16x8 af[4][2];
#pragma unroll
        for (int ks = 0; ks < 4; ++ks)
#pragma unroll
            for (int e2 = 0; e2 < 2; ++e2) af[ks][e2] = *(const bf16x8*)(SP + (size_t)(32 * (2 * eh + e2) + (lane & 31)) * 128 + 16 * (kb4 + ks) + 8 * h_);
#pragma unroll
        for (int ks = 0; ks < 4; ++ks)
#pragma unroll
            for (int e2 = 0; e2 < 2; ++e2) acc[e2] = mfma32(af[ks][e2], qf[kb4 + ks], acc[e2]);
    }
    { const float cr = fexp((float)(il + 1) * lg); acc[0] *= cr; acc[1] *= cr; }
    __syncthreads();
    for (int jt = 0; jt <= it; ++jt) {
        f32x16 s = (f32x16){};
#pragma unroll
        for (int ks = 0; ks < 8; ++ks) { const bf16x8 kf = *(const LAS bf16x8*)(KS + (32 * jt + (lane & 31)) * RS_KV + (16 * ks + 8 * h_) * 2); s = mfma32(kf, qf[ks], s); }
#pragma unroll
        for (int r = 0; r < 16; ++r) { const int j = 32 * jt + (r & 3) + 8 * (r >> 2) + 4 * h_; const int df = il - j; s[r] = (df >= 0) ? s[r] * fexp((float)df * lg) : 0.f; }
#pragma unroll
        for (int s2 = 0; s2 < 2; ++s2) { const bf16x8 pf = cvt_frag(s, s2); const int rA = 32 * jt + 16 * s2 + 4 * h_;
#pragma unroll
            for (int e2 = 0; e2 < 2; ++e2) { const bf16x8 vf = tr_frag(VS, RS_KV, rA, rA + 8, 32 * (2 * eh + e2) + 16 * blk, lane); acc[e2] = mfma32(vf, pf, acc[e2]); } }
    }
    float s1 = 0.f, s2 = 0.f;
#pragma unroll
    for (int e2 = 0; e2 < 2; ++e2)
#pragma unroll
        for (int r = 0; r < 16; ++r) { const float v = acc[e2][r]; s1 += v; s2 += v * v; }
    s1 += __shfl_xor(s1, 32); s2 += __shfl_xor(s2, 32);
    if (lane < 32) { STAT[(w * 32 + lane) * 2] = s1; STAT[(w * 32 + lane) * 2 + 1] = s2; }
    __syncthreads();
    { const int pw = w ^ 4; s1 += STAT[(pw * 32 + (lane & 31)) * 2]; s2 += STAT[(pw * 32 + (lane & 31)) * 2 + 1]; }
    const float mean = s1 * (1.0f / 128.0f), var = fmaxf(s2 * (1.0f / 128.0f) - mean * mean, 0.f), rstd = 1.0f / sqrtf(var + EPS);
#pragma unroll
    for (int e2 = 0; e2 < 2; ++e2)
#pragma unroll
        for (int r4 = 0; r4 < 4; ++r4) { const int e = 32 * (2 * eh + e2) + 8 * r4 + 4 * h_;
            f32x4 v; v[0] = (acc[e2][4 * r4 + 0] - mean) * rstd; v[1] = (acc[e2][4 * r4 + 1] - mean) * rstd; v[2] = (acc[e2][4 * r4 + 2] - mean) * rstd; v[3] = (acc[e2][4 * r4 + 3] - mean) * rstd;
            *(LAS f32x4*)(OT + il * 132 + e) = v; }
    __syncthreads();
    const float* GN = FIN(I_GNG) + l * 512 + h * 128; bf16* OR_ = WSP(bf16, WS_OA) + (size_t)MT * 512;
    {   const int ch = tid & 15; const f32x4 g0 = *(const f32x4*)(GN + 8 * ch), g1 = *(const f32x4*)(GN + 8 * ch + 4);
        v4u rgw[4];
#pragma unroll
        for (int k = 0; k < 4; ++k) { const int i = (tid + NTHR * k) >> 4; rgw[k] = *(const v4u*)(RG + (row0 + i) * 512 + h * 128 + 8 * ch); }
#pragma unroll
        for (int k = 0; k < 4; ++k) { const int i = (tid + NTHR * k) >> 4;
            const f32x4 o0 = *(const LAS f32x4*)(OT + i * 132 + 8 * ch), o1 = *(const LAS f32x4*)(OT + i * 132 + 8 * ch + 4);
            f32x4 r0, r1; unpack8(rgw[k], r0, r1);
            f32x4 y0, y1;
#pragma unroll
            for (int x = 0; x < 4; ++x) { y0[x] = o0[x] * g0[x] * siluf_(r0[x]); y1[x] = o1[x] * g1[x] * siluf_(r1[x]); }
            *(v4u*)(OR_ + (row0 + i) * 512 + h * 128 + 8 * ch) = pack8(y0, y1); }
    }
}
__device__ __forceinline__ void ret_sample_unit(Frame& F, int l, int unit) {
    const int db = unit >> 2, h = unit & 3, tid = F.tid, e = tid & 127, dp = tid >> 7;
    const float lg = ret_log_g(h);
    LAS float* Q = (LAS float*)F.lds; LAS float* K = Q + 1024; LAS float* V = K + 1024; LAS float* GT = V + 1024; LAS float* CR = GT + 1024;
    LAS float* SC = CR + 4096; LAS float* RED = SC + 64;
    const bf16* RQ = WSP(bf16, WS_RQ); const size_t row0 = (size_t)PM + db * 8;
    __syncthreads();
    for (int i = tid; i < 4096; i += NTHR) { const int which = i >> 10, r = (i >> 7) & 7, d = i & 127; const float v = bf1(RQ[(size_t)which * MT * 512 + (row0 + r) * 512 + h * 128 + d]); Q[which * 1024 + r * 128 + d] = v; }
    __syncthreads();
    const float* S0 = FIN(I_SRET) + (((size_t)l * SB + db) * 4 + h) * 16384; float* SN = F.out + OUT_RET_S + (((size_t)l * SB + db) * 4 + h) * 16384;
    float kwv[8], cr[8];
#pragma unroll
    for (int j = 0; j < 8; ++j) { kwv[j] = V[j * 128 + e] * fexp((float)(7 - j) * lg); cr[j] = 0.f; }
    const float g8 = fexp(8.0f * lg);
    {   float s0v[32];
#pragma unroll
        for (int dd = 0; dd < 32; ++dd) s0v[dd] = S0[(dp * 32 + dd) * 128 + e];
#pragma unroll
        for (int dd = 0; dd < 32; ++dd) { const int d = dp * 32 + dd; const float s0 = s0v[dd]; float sn = g8 * s0;
#pragma unroll
            for (int j = 0; j < 8; ++j) { cr[j] += Q[j * 128 + d] * s0; sn += K[j * 128 + d] * kwv[j]; }
            SN[d * 128 + e] = sn; }
    }
#pragma unroll
    for (int i = 0; i < 8; ++i) CR[(dp * 8 + i) * 128 + e] = cr[i];
    if (tid < 64) { const int i = tid >> 3, j = tid & 7; float s = 0.f; if (j <= i) { for (int d = 0; d < 128; ++d) s += Q[i * 128 + d] * K[j * 128 + d]; s *= fexp((float)(i - j) * lg); } SC[tid] = s; }
    __syncthreads();
    float o[2];
#pragma unroll
    for (int ii = 0; ii < 2; ++ii) { const int i = 2 * dp + ii; float x = (CR[(0 * 8 + i) * 128 + e] + CR[(1 * 8 + i) * 128 + e] + CR[(2 * 8 + i) * 128 + e] + CR[(3 * 8 + i) * 128 + e]) * fexp((float)(i + 1) * lg);
        for (int j = 0; j <= i; ++j) x += SC[i * 8 + j] * V[j * 128 + e];
        o[ii] = x; }
#pragma unroll
    for (int ii = 0; ii < 2; ++ii) { const float a = wave_sum(o[ii]), q = wave_sum(o[ii] * o[ii]); if (F.lane == 0) { RED[(F.wave * 2 + ii) * 2] = a; RED[(F.wave * 2 + ii) * 2 + 1] = q; } }
    __syncthreads();
    const float* GN = FIN(I_GNG) + l * 512 + h * 128; bf16* OR_ = WSP(bf16, WS_OA) + (size_t)MT * 512;
#pragma unroll
    for (int ii = 0; ii < 2; ++ii) { const int i = 2 * dp + ii, w0 = 2 * dp; const float s1 = RED[(w0 * 2 + ii) * 2] + RED[((w0 + 1) * 2 + ii) * 2], s2 = RED[(w0 * 2 + ii) * 2 + 1] + RED[((w0 + 1) * 2 + ii) * 2 + 1];
        const float mean = s1 * (1.0f / 128.0f), var = fmaxf(s2 * (1.0f / 128.0f) - mean * mean, 0.f), rstd = 1.0f / sqrtf(var + EPS);
        const float y = (o[ii] - mean) * rstd * GN[e] * siluf_(GT[i * 128 + e]);
        OR_[(row0 + i) * 512 + h * 128 + e] = (bf16)(pk2(y, 0.f) & 0xffffu); }
}

template <int MODE> __device__ __forceinline__ void rglru_unit(Frame& F, int l, int unit) {
    const int tid = F.tid, c = tid, lane = F.lane, w = F.wave;
    LAS bf16* XC = (LAS bf16*)F.lds; LAS float* G = (LAS float*)(F.lds + 16384);
    const int seq = (MODE == 2) ? unit : (unit >> 6), tile = (MODE == 2) ? 0 : (unit & 63);
    const size_t row0 = (MODE == 2) ? (size_t)PM + seq * 8 : (size_t)seq * PT + tile * 64;
    const int ntok = (MODE == 2) ? 8 : 64, nsub = (MODE == 2) ? 1 : 4;
    const float* RX = WSP(float, WS_RX);
    const float w0 = FIN(I_RCW)[(l * 4 + 0) * 512 + c], w1 = FIN(I_RCW)[(l * 4 + 1) * 512 + c], w2 = FIN(I_RCW)[(l * 4 + 2) * 512 + c], w3 = FIN(I_RCW)[(l * 4 + 3) * 512 + c], cb = FIN(I_RCB)[l * 512 + c];
    const float ba = FIN(I_RBA)[l * 512 + c], bx = FIN(I_RBX)[l * 512 + c], sp = WSP(float, WS_SMALLW + SW_SP)[l * 512 + c];
    float x3, x2, x1;
    if (MODE == 2) { const float* cv = FIN(I_SCONV) + ((size_t)l * SB + seq) * 3 * 512; x3 = cv[c]; x2 = cv[512 + c]; x1 = cv[1024 + c]; }
    else if (tile == 0) { x3 = 0.f; x2 = 0.f; x1 = 0.f; }
    else { x3 = RX[(row0 - 3) * 512 + c]; x2 = RX[(row0 - 2) * 512 + c]; x1 = RX[(row0 - 1) * 512 + c]; }
    float h = (MODE == 0) ? 0.f : (MODE == 1) ? WSP(float, WS_CAR)[(size_t)4 * 64 * 2 * 512 + ((size_t)seq * 64 + tile) * 512 + c] : FIN(I_SH)[((size_t)l * SB + seq) * 512 + c];
    float aprod = 1.f;
    const int r16 = lane & 15, g4 = lane >> 4;
    bf16x8 wa[4][2], wx[4][2];
    { const bf16* WA = WSP(bf16, WS_SMALLW + SW_WAT) + ((size_t)(l * 2 + 0) * 8 + w) * 4096; const bf16* WX = WSP(bf16, WS_SMALLW + SW_WAT) + ((size_t)(l * 2 + 1) * 8 + w) * 4096;
#pragma unroll
      for (int ct = 0; ct < 4; ++ct)
#pragma unroll
          for (int ks = 0; ks < 2; ++ks) { wa[ct][ks] = *(const bf16x8*)(WA + (16 * ct + r16) * 64 + 32 * ks + 8 * g4); wx[ct][ks] = *(const bf16x8*)(WX + (16 * ct + r16) * 64 + 32 * ks + 8 * g4); } }
    const bf16* GG = WSP(bf16, WS_GG); bf16* OC = WSP(bf16, WS_OA) + (size_t)2 * MT * 512;
    __syncthreads();
    float xn[16]; bf16 gn[16];
#pragma unroll
    for (int tt = 0; tt < 16; ++tt) { xn[tt] = (tt < ntok) ? RX[(row0 + tt) * 512 + c] : 0.f; gn[tt] = (MODE != 0 && tt < ntok) ? GG[(row0 + tt) * 512 + c] : (bf16)0; }
    for (int s = 0; s < nsub; ++s) {
        float xc[16], gg[16];
#pragma unroll
        for (int tt = 0; tt < 16; ++tt) { xc[tt] = xn[tt]; gg[tt] = bf1(gn[tt]); }
        if (s + 1 < nsub) {
#pragma unroll
            for (int tt = 0; tt < 16; ++tt) { const int t = (s + 1) * 16 + tt; xn[tt] = RX[(row0 + t) * 512 + c]; gn[tt] = (MODE != 0) ? GG[(row0 + t) * 512 + c] : (bf16)0; } }
#pragma unroll
        for (int tt = 0; tt < 16; ++tt) { const float x0 = xc[tt];
            xc[tt] = cb + w0 * x3 + w1 * x2 + w2 * x1 + w3 * x0; x3 = x2; x2 = x1; x1 = x0; XC[tt * 512 + c] = (bf16)(pk2(xc[tt], 0.f) & 0xffffu); }
        LDS_WAIT(); asm volatile("" ::: "memory");
        {
            bf16x8 xf[2];
#pragma unroll
            for (int ks = 0; ks < 2; ++ks) xf[ks] = *(const LAS bf16x8*)(XC + r16 * 512 + w * 64 + 32 * ks + 8 * g4);
#pragma unroll
            for (int ct = 0; ct < 4; ++ct) { f32x4 da = (f32x4){0.f, 0.f, 0.f, 0.f}, dx = da;
#pragma unroll
                for (int ks = 0; ks < 2; ++ks) { da = mfma16(wa[ct][ks], xf[ks], da); dx = mfma16(wx[ct][ks], xf[ks], dx); }
                *(LAS f32x4*)(G + r16 * 512 + w * 64 + 16 * ct + 4 * g4) = da; *(LAS f32x4*)(G + 8192 + r16 * 512 + w * 64 + 16 * ct + 4 * g4) = dx; }
        }
        LDS_WAIT(); asm volatile("" ::: "memory");
#pragma unroll
        for (int tt = 0; tt < 16; ++tt) { const int t = s * 16 + tt;
            if (t < ntok) {
                const float r = sigmoidf_(G[tt * 512 + c] + ba), ig = sigmoidf_(G[8192 + tt * 512 + c] + bx);
                const float la = -8.0f * r * sp, a = fexp(la), bt = sqrtf(fmaxf(1.0f - a * a, 0.f)) * (ig * xc[tt]);
                h = a * h + bt; aprod *= a;
                if (MODE != 0) { const size_t o = (row0 + t) * 512 + c; OC[o] = (bf16)(pk2(h * gg[tt], 0.f) & 0xffffu); }
            } }
    }
    if (MODE == 0) { float* CAR = WSP(float, WS_CAR) + ((size_t)seq * 64 + tile) * 1024; CAR[c] = aprod; CAR[512 + c] = h; }
    if (MODE == 2) F.out[OUT_H_S + ((size_t)l * SB + seq) * 512 + c] = h;
}
__device__ __forceinline__ void rglru_carry_phase(Frame& F, int l) {
    const float* CAR = WSP(float, WS_CAR); float* HIN = WSP(float, WS_CAR) + (size_t)4 * 64 * 2 * 512;
    for (int idx = F.bid * NTHR + F.tid; idx < PB * 512; idx += F.G * NTHR) {
        const int b = idx >> 9, c = idx & 511; float h = 0.f;
#pragma unroll 1
        for (int t0 = 0; t0 < 64; t0 += 32) {
            float ca[32], cb[32];
#pragma unroll
            for (int t = 0; t < 32; ++t) { const float* cr = CAR + ((size_t)b * 64 + t0 + t) * 1024; ca[t] = cr[c]; cb[t] = cr[512 + c]; }
#pragma unroll
            for (int t = 0; t < 32; ++t) { HIN[((size_t)b * 64 + t0 + t) * 512 + c] = h; h = ca[t] * h + cb[t]; }
        }
        F.out[OUT_H_P + ((size_t)l * PB + b) * 512 + c] = h;
    }
}

__device__ __forceinline__ void convact_rows(Frame& F, int l, size_t row0, int nrows, bool smp) {
    const bf16* GP = WSP(bf16, WS_GP); const bf16* VAL = GP + (size_t)MT * DFF; bf16* ACT = WSP(bf16, WS_GP) + (size_t)2 * MT * DFF;
    const float* CW = FIN(I_FCW) + (size_t)l * 3 * DFF; const float* CBI = FIN(I_FCB) + (size_t)l * DFF;
    constexpr int NCG = DFF / 8;
    for (int it = F.tid; it < nrows * NCG; it += NTHR) {
        const int rr = it / NCG, c = (it % NCG) * 8; const size_t row = row0 + rr;
        f32x4 xa, xb, p1a, p1b, p2a, p2b, va, vb;
        const v4u gx = *(const v4u*)(GP + row * DFF + c), vx = *(const v4u*)(VAL + row * DFF + c);
        if (!smp) { v4u g1 = *(const v4u*)(GP + (row - 1) * DFF + c), g2 = *(const v4u*)(GP + (row - 2) * DFF + c); unpack8(g1, p1a, p1b); unpack8(g2, p2a, p2b); }
        else { const int sr = (int)(row - PM), seq = sr >> 3, i = sr & 7; const float* st = FIN(I_SFFN) + (((size_t)l * SB + seq) * 2) * DFF + c;
            if (i >= 1) unpack8(*(const v4u*)(GP + (row - 1) * DFF + c), p1a, p1b); else { p1a = *(const f32x4*)(st + DFF); p1b = *(const f32x4*)(st + DFF + 4); }
            if (i >= 2) unpack8(*(const v4u*)(GP + (row - 2) * DFF + c), p2a, p2b); else { const float* s2 = st + (i == 1 ? DFF : 0); p2a = *(const f32x4*)s2; p2b = *(const f32x4*)(s2 + 4); } }
        unpack8(gx, xa, xb); unpack8(vx, va, vb);
        const f32x4 w0a = *(const f32x4*)(CW + c), w0b = *(const f32x4*)(CW + c + 4), w1a = *(const f32x4*)(CW + DFF + c), w1b = *(const f32x4*)(CW + DFF + c + 4), w2a = *(const f32x4*)(CW + 2 * DFF + c), w2b = *(const f32x4*)(CW + 2 * DFF + c + 4);
        f32x4 ya = *(const f32x4*)(CBI + c) + w0a * p2a + w1a * p1a + w2a * xa, yb = *(const f32x4*)(CBI + c + 4) + w0b * p2b + w1b * p1b + w2b * xb;
#pragma unroll
        for (int k = 0; k < 4; ++k) { ya[k] = siluf_(ya[k]) * va[k]; yb[k] = siluf_(yb[k]) * vb[k]; }
        *(v4u*)(ACT + row * DFF + c) = pack8(ya, yb);
    }
}

constexpr int AT_RS = 144;
constexpr int AT_K0 = 0, AT_V0 = 2 * 64 * AT_RS, AT_PS = 4 * 64 * AT_RS, AT_IMP = AT_PS + 69632, AT_MASK = AT_IMP + 6144, AT_LIST = AT_MASK + 2048, AT_NL = AT_LIST + 1024;
constexpr unsigned AT_MARK = 0xFFFFu;
static_assert(AT_NL + 64 <= RING_BYTES, "attention LDS map");

struct TileRegs { v4u a, b, c, d; int mode; };

template <bool SMP> __device__ __forceinline__ void at_prefetch(const Frame& F, int l, int seq, int kvh, unsigned e, TileRegs& R) {
    const int kind = (int)(e >> 14), ti = (int)(e & 0x3fffu), rr = F.tid >> 3, pc = F.tid & 7;
    R.mode = 0;
    if (kind < 2) {
        const size_t rb = SMP ? (size_t)(seq * 2 + kvh) * 512 : (size_t)32768 + (size_t)(seq * 2 + kvh) * 256;
        const bf16* ck = WSP(bf16, WS_CK) + (rb + ti * 64 + rr) * 64 + pc * 8;
        R.a = *(const v4u*)ck; R.c = *(const v4u*)(ck + (size_t)CMP_ROWS_J * 64);
    } else if (!SMP) {
        const int jb = (kind == 2) ? 0 : 2;
        const bf16* kp = WSP(bf16, WS_KVB) + ((((size_t)jb * PB + seq) * 2 + kvh) * PT + ti * 64 + rr) * 64 + pc * 8;
        R.a = *(const v4u*)kp; R.c = *(const v4u*)(kp + (size_t)PB * 2 * PT * 64);
    } else if (kind == 2) {
        if (ti < 128) {
            const int page = ((const int*)F.a->in[I_PT])[seq * NPG + (ti >> 1)], slot = (ti & 1) * 64 + rr;
            const float* kp = FIN(I_CACHE) + (((((size_t)l * NPHYS + page) * PAGE + slot) * 4 + 2) * 2 + kvh) * 64 + pc * 8;
            R.a = *(const v4u*)kp; R.b = *(const v4u*)(kp + 4); R.c = *(const v4u*)(kp + 128); R.d = *(const v4u*)(kp + 132); R.mode = 1;
        } else if (rr < ST) {
            const bf16* kp = WSP(bf16, WS_KVS) + ((((size_t)0 * SB + seq) * 2 + kvh) * ST + rr) * 64 + pc * 8;
            R.a = *(const v4u*)kp; R.c = *(const v4u*)(kp + (size_t)SB * 2 * ST * 64);
        } else R.mode = 2;
    } else {
        if (ti < 8) {
            const float* kp = FIN(I_CWIN) + (((((size_t)l * SB + seq) * WINB + ti * 64 + rr) * 2 + 0) * 2 + kvh) * 64 + pc * 8;
            R.a = *(const v4u*)kp; R.b = *(const v4u*)(kp + 4); R.c = *(const v4u*)(kp + 128); R.d = *(const v4u*)(kp + 132); R.mode = 1;
        } else if (rr < ST) {
            const bf16* kp = WSP(bf16, WS_KVS) + ((((size_t)2 * SB + seq) * 2 + kvh) * ST + rr) * 64 + pc * 8;
            R.a = *(const v4u*)kp; R.c = *(const v4u*)(kp + (size_t)SB * 2 * ST * 64);
        } else R.mode = 2;
    }
}
__device__ __forceinline__ void at_store(const Frame& F, int buf, const TileRegs& R) {
    const int rr = F.tid >> 3, pc = F.tid & 7; v4u k, v;
    if (R.mode == 0) { k = R.a; v = R.c; }
    else if (R.mode == 1) { k = pack8(__builtin_bit_cast(f32x4, R.a), __builtin_bit_cast(f32x4, R.b)); v = pack8(__builtin_bit_cast(f32x4, R.c), __builtin_bit_cast(f32x4, R.d)); }
    else { k = (v4u){0u, 0u, 0u, 0u}; v = k; }
    *(LAS v4u*)(F.lds + AT_K0 + buf * 64 * AT_RS + rr * AT_RS + pc * 16) = k;
    *(LAS v4u*)(F.lds + AT_V0 + buf * 64 * AT_RS + rr * AT_RS + pc * 16) = v;
}

template <bool SMP> __device__ __forceinline__ void attn_unit(Frame& F, int l, int unit) {
    const int tid = F.tid, lane = F.lane, w = F.wave;
    const int q = lane & 31, h_ = lane >> 5, blk = (lane >> 4) & 1, tl = q >> 2, hr = q & 3;
    int seq, kvh, qt;
    if (SMP) { seq = unit >> 1; kvh = unit & 1; qt = 128; } else { seq = unit >> 7; kvh = (unit >> 6) & 1; qt = unit & 63; }
    const int t0 = SMP ? PAST : qt * 64;
    const int tokl = SMP ? tl : 8 * w + tl, t = t0 + tokl;
    const size_t row = SMP ? (size_t)PM + seq * ST + tl : (size_t)seq * PT + t;
    const int head = kvh * 4 + hr;
    LAS float* PS = (LAS float*)(F.lds + AT_PS); LAS float* IMPw = (LAS float*)(F.lds + AT_IMP) + w * 192;
    LAS unsigned long long* MASKS = (LAS unsigned long long*)(F.lds + AT_MASK); LAS unsigned short* LIST = (LAS unsigned short*)(F.lds + AT_LIST); LAS int* NL = (LAS int*)(F.lds + AT_NL);
    constexpr int PSS = SMP ? 520 : 264;
    LAS float* PSw = SMP ? PS : PS + w * 8 * PSS;
    __syncthreads();
    bf16x8 qf[4];
    { const bf16* qp = WSP(bf16, WS_QN) + row * 512 + head * 64 + 8 * h_;
#pragma unroll
      for (int kk = 0; kk < 4; ++kk) qf[kk] = *(const bf16x8*)(qp + 16 * kk); }
    const float* ngp = WSP(float, WS_NG) + row * 24 + head * 3; const float g0 = ngp[0], g1 = ngp[1], g2 = ngp[2];
    if (!SMP) { for (int i = lane; i < 8 * PSS; i += 64) PSw[i] = 0.f; }
    const int ntc = SMP ? 8 : ((t0 + 32) >> 10) + 1;
    if (tid < 2 * ntc) LIST[tid] = (unsigned short)(((tid >= ntc ? 1u : 0u) << 14) | (unsigned)(tid >= ntc ? tid - ntc : tid));
    if (tid == 0) LIST[2 * ntc] = (unsigned short)AT_MARK;
    int nl = 2 * ntc + 1;
    TileRegs R;
    at_prefetch<SMP>(F, l, seq, kvh, (unsigned)0, R);
    at_store(F, 0, R);
    __syncthreads();
    float m = -INFINITY, lsum = 0.f, invden = 0.f;
    f32x16 O[2]; O[0] = (f32x16){}; O[1] = (f32x16){};
    LAS float* OAw = (LAS float*)(F.lds + AT_PS) + w * (SMP ? 2048 : 8 * PSS) + lane;
    unsigned long long mk0 = 0ull, mk1 = 0ull, wu = ~0ull;
    int cur_kind = -1, idx = 0;
#define AT_FINALIZE(kind) do { \
        if ((kind) == 0) { const float lt = lsum + __shfl_xor(lsum, 32); invden = lt > 0.f ? 1.0f / lt : 0.f; } \
        else if ((kind) == 1) { const float sc = g0 * invden; O[0] *= sc; O[1] *= sc; } \
        else if ((kind) == 2) { const float lt = lsum + __shfl_xor(lsum, 32); const float sc = (lt > 0.f ? 1.0f / lt : 0.f) * g1; \
            _Pragma("unroll") for (int r_ = 0; r_ < 16; ++r_) { OAw[r_ * 64] += O[0][r_] * sc; OAw[(16 + r_) * 64] += O[1][r_] * sc; } } } while (0)
    while (idx < nl) {
        const unsigned e = (unsigned)__builtin_amdgcn_readfirstlane((int)LIST[idx]);
        if (e == AT_MARK) {
            AT_FINALIZE(cur_kind); cur_kind = -1;
            LDS_WAIT(); asm volatile("" ::: "memory");
#pragma unroll 1
            for (int tk = 0; tk < 8; ++tk) {
                const LAS float* pr = PSw + tk * PSS;
                if (!SMP) {
                    const int s = lane; float imp = 0.f;
#pragma unroll
                    for (int n = 4 * s - 1; n <= 4 * s + 3; ++n) if (n >= 0) imp += pr[n];
                    const bool forced = (s == 0) || (s == qt) || (s == qt - 1), avail = s <= qt;
                    const float val = avail ? (forced ? 1e4f : imp) : -1e4f;
                    IMPw[s] = val; LDS_WAIT(); asm volatile("" ::: "memory");
                    int rank = 0;
#pragma unroll 8
                    for (int i = 0; i < 64; ++i) { const float v = IMPw[i]; rank += (v > val || (v == val && i < s)) ? 1 : 0; }
                    const unsigned long long mk = __ballot(rank < 16);
                    if (lane == 0) MASKS[(8 * w + tk) * 4] = mk;
                    LDS_WAIT(); asm volatile("" ::: "memory");
                } else {
                    const int sa = lane, sb = lane + 64; float ia = 0.f, ib = 0.f;
#pragma unroll
                    for (int n = 4 * sa - 1; n <= 4 * sa + 3; ++n) if (n >= 0) ia += pr[n];
#pragma unroll
                    for (int n = 4 * sb - 1; n <= 4 * sb + 3; ++n) ib += pr[n];
                    const bool fa = (sa == 0), fb = (sb == 127);
                    const float va = fa ? 1e4f : ia, vb = fb ? 1e4f : ib;
                    IMPw[sa] = va; IMPw[sb] = vb; LDS_WAIT(); asm volatile("" ::: "memory");
                    int ra = fa ? 0 : 1, rb = fb ? 0 : 1;
#pragma unroll 8
                    for (int i = 0; i < 128; ++i) { const float v = IMPw[i]; ra += (v > va || (v == va && i < sa)) ? 1 : 0; rb += (v > vb || (v == vb && i < sb)) ? 1 : 0; }
                    const unsigned long long ma = __ballot(ra < 16), mb = __ballot(rb < 16);
                    if (lane == 0) { MASKS[tk * 4] = ma; MASKS[tk * 4 + 1] = mb; MASKS[tk * 4 + 2] = 1ull; }
                    LDS_WAIT(); asm volatile("" ::: "memory");
                }
            }
            __syncthreads();
#pragma unroll
            for (int r_ = 0; r_ < 16; ++r_) { OAw[r_ * 64] = O[0][r_]; OAw[(16 + r_) * 64] = O[1][r_]; }
            if (tid == 0) {
                int n = idx + 1;
                if (!SMP) { unsigned long long U = 0ull; for (int i = 0; i < 64; ++i) U |= MASKS[i * 4];
                    for (int s = 0; s <= qt; ++s) if ((U >> s) & 1ull) LIST[n++] = (unsigned short)((2u << 14) | (unsigned)s);
                    for (int s = (qt > 8 ? qt - 8 : 0); s <= qt; ++s) LIST[n++] = (unsigned short)((3u << 14) | (unsigned)s);
                } else { unsigned long long U0 = 0ull, U1 = 0ull; for (int i = 0; i < 8; ++i) { U0 |= MASKS[i * 4]; U1 |= MASKS[i * 4 + 1]; }
                    for (int s = 0; s < 64; ++s) if ((U0 >> s) & 1ull) LIST[n++] = (unsigned short)((2u << 14) | (unsigned)s);
                    for (int s = 0; s < 64; ++s) if ((U1 >> s) & 1ull) LIST[n++] = (unsigned short)((2u << 14) | (unsigned)(64 + s));
                    LIST[n++] = (unsigned short)((2u << 14) | 128u);
                    for (int s = 0; s <= 8; ++s) LIST[n++] = (unsigned short)((3u << 14) | (unsigned)s); }
                NL[0] = n;
            }
            __syncthreads();
            nl = __builtin_amdgcn_readfirstlane(NL[0]);
            mk0 = MASKS[tokl * 4]; if (SMP) { mk1 = MASKS[tokl * 4 + 1]; }
            if (!SMP) { unsigned long long u = 0ull; for (int i = 0; i < 8; ++i) u |= MASKS[(8 * w + i) * 4]; wu = u; }
            if (idx + 1 < nl) { at_prefetch<SMP>(F, l, seq, kvh, (unsigned)LIST[idx + 1], R); at_store(F, (idx + 1) & 1, R); }
            __syncthreads();
            ++idx; continue;
        }
        const int kind = (int)(e >> 14), ti = (int)(e & 0x3fffu);
        if (kind != cur_kind) {
            if (cur_kind >= 0) AT_FINALIZE(cur_kind);
            if (kind != 1) m = -INFINITY;
            lsum = 0.f; O[0] = (f32x16){}; O[1] = (f32x16){}; cur_kind = kind;
        }
        const unsigned en = (idx + 1 < nl) ? (unsigned)__builtin_amdgcn_readfirstlane((int)LIST[idx + 1]) : AT_MARK;
        const bool have_next = (en != AT_MARK);
        if (have_next) at_prefetch<SMP>(F, l, seq, kvh, en, R);
        bool active = true;
        if (!SMP && kind == 2) active = ((wu >> ti) & 1ull) != 0ull;
        if (active) {
            const LAS unsigned char* Kb = F.lds + AT_K0 + (idx & 1) * 64 * AT_RS; const LAS unsigned char* Vb = F.lds + AT_V0 + (idx & 1) * 64 * AT_RS;
            int lo, hi; const int kb = 64 * ti;
            if (kind < 2) { lo = 0; hi = SMP ? 510 : ((t >= 31) ? ((t - 31) >> 4) : -1); }
            else if (kind == 2) { lo = 0; const unsigned long long mw = (ti < 64) ? mk0 : ((ti < 128) ? mk1 : 1ull); hi = ((mw >> (ti & 63)) & 1ull) ? t : -1; }
            else { if (SMP) { lo = tl; hi = WINB + tl; } else { lo = t - WINB; hi = t; } }
            f32x16 s0 = (f32x16){}, s1 = (f32x16){};
#pragma unroll
            for (int kk = 0; kk < 4; ++kk) {
                const bf16x8 k0 = *(const LAS bf16x8*)(Kb + q * AT_RS + (16 * kk + 8 * h_) * 2), k1 = *(const LAS bf16x8*)(Kb + (32 + q) * AT_RS + (16 * kk + 8 * h_) * 2);
                s0 = mfma32(k0, qf[kk], s0); s1 = mfma32(k1, qf[kk], s1);
            }
            float tmax = -INFINITY;
#pragma unroll
            for (int r = 0; r < 16; ++r) { const int key = kb + (r & 3) + 8 * (r >> 2) + 4 * h_;
                s0[r] = (key >= lo && key <= hi) ? s0[r] : -INFINITY; s1[r] = (key + 32 >= lo && key + 32 <= hi) ? s1[r] : -INFINITY;
                tmax = fmaxf(tmax, fmaxf(s0[r], s1[r])); }
            tmax = fmaxf(tmax, __shfl_xor(tmax, 32));
            const float m_new = fmaxf(m, tmax), m_use = (m_new == -INFINITY) ? 0.f : m_new;
            const float alpha = fexp2(m - m_use);
            float ps = 0.f;
#pragma unroll
            for (int r = 0; r < 16; ++r) { s0[r] = fexp2(s0[r] - m_use); s1[r] = fexp2(s1[r] - m_use); ps += s0[r] + s1[r]; }
            lsum = lsum * alpha + ps; m = m_new;
            if (kind != 0) {
                O[0] *= alpha; O[1] *= alpha;
#pragma unroll
                for (int kt2 = 0; kt2 < 2; ++kt2)
#pragma unroll
                    for (int s2 = 0; s2 < 2; ++s2) { const bf16x8 pf = cvt_frag(kt2 ? s1 : s0, s2); const int rA = 32 * kt2 + 16 * s2 + 4 * h_;
#pragma unroll
                        for (int dt = 0; dt < 2; ++dt) { const bf16x8 vf = tr_frag(Vb, AT_RS, rA, rA + 8, 32 * dt + 16 * blk, lane); O[dt] = mfma32(vf, pf, O[dt]); } }
            }
            if (kind == 1) {
#pragma unroll
                for (int r = 0; r < 16; ++r) { const int n = kb + (r & 3) + 8 * (r >> 2) + 4 * h_;
                    float a = s0[r] * invden, b = s1[r] * invden; a += __shfl_xor(a, 1); b += __shfl_xor(b, 1); a += __shfl_xor(a, 2); b += __shfl_xor(b, 2);
                    if (hr == 0) { PSw[tl * PSS + n] = a; PSw[tl * PSS + n + 32] = b; } }
            }
        }
        if (have_next) at_store(F, (idx + 1) & 1, R);
        __syncthreads();
        ++idx;
    }
#undef AT_FINALIZE
    {
        const float lt = lsum + __shfl_xor(lsum, 32); const float sc = (lt > 0.f ? 1.0f / lt : 0.f) * g2;
        if (!SMP || w == 0) {
            bf16* op = WSP(bf16, WS_OA) + row * 512 + head * 64;
#pragma unroll
            for (int dt = 0; dt < 2; ++dt)
#pragma unroll
                for (int r4 = 0; r4 < 4; ++r4) { float o_[4];
#pragma unroll
                    for (int x = 0; x < 4; ++x) o_[x] = OAw[(dt * 16 + 4 * r4 + x) * 64] + O[dt][4 * r4 + x] * sc;
                    v2u wv; wv.x = pk2(o_[0], o_[1]); wv.y = pk2(o_[2], o_[3]); *(v2u*)(op + 32 * dt + 8 * r4 + 4 * h_) = wv; }
        }
    }
}

constexpr int AS_RS = 144;
constexpr int AS_V = 0, AS_VW = 32 * AS_RS, AS_MRG = 0, AS_PS = 73728, AS_IMP = AS_PS + 16640, AS_MASK = AS_IMP + 6144, AS_OA = AS_MASK + 512;
static_assert(8 * 34 * 64 * 4 <= AS_PS && AS_OA + 32 * 64 * 4 <= RING_BYTES, "sample attention LDS map");

__device__ __forceinline__ float xhalf_max(float x) { auto t_ = __builtin_amdgcn_permlane32_swap(__float_as_uint(x), __float_as_uint(x), false, false); return fmaxf(__uint_as_float(t_[0]), __uint_as_float(t_[1])); }
__device__ __forceinline__ float xhalf_sum(float x) { auto t_ = __builtin_amdgcn_permlane32_swap(__float_as_uint(x), __float_as_uint(x), false, false); return __uint_as_float(t_[0]) + __uint_as_float(t_[1]); }
struct ASrc { const float* kf; const float* vf; const bf16* kb; const bf16* vb; int rs; int nvalid; };
#define AS_TILE(SRC, KB0, LO_, HI_, DO_PV, DO_PS, m, lsum, O0, O1, invden, PSS_) do { \
        bf16x8 kfr[4]; f32x4 vx_[8]; \
        if ((SRC).kb) { const bf16* kp_ = (SRC).kb + (size_t)q * (SRC).rs + 8 * h_; _Pragma("unroll") for (int kk = 0; kk < 4; ++kk) kfr[kk] = *(const bf16x8*)(kp_ + 16 * kk); } \
        else {   \
            f32x4 kx_[8]; _Pragma("unroll") for (int x = 0; x < 8; ++x) kx_[x] = *(const f32x4*)((SRC).kf + (size_t)(4 * x + (lane >> 4)) * (SRC).rs + (lane & 15) * 4); \
            _Pragma("unroll") for (int x = 0; x < 8; ++x) { v2u o_; o_.x = pk2(kx_[x][0], kx_[x][1]); o_.y = pk2(kx_[x][2], kx_[x][3]); *(LAS v2u*)(Vw + (4 * x + (lane >> 4)) * AS_RS + (lane & 15) * 8) = o_; } \
            LDS_WAIT(); asm volatile("" ::: "memory"); \
            _Pragma("unroll") for (int kk = 0; kk < 4; ++kk) kfr[kk] = *(const LAS bf16x8*)(Vw + q * AS_RS + (16 * kk + 8 * h_) * 2); \
            LDS_WAIT(); asm volatile("" ::: "memory"); \
            if (DO_PV) { _Pragma("unroll") for (int x = 0; x < 8; ++x) vx_[x] = *(const f32x4*)((SRC).vf + (size_t)(4 * x + (lane >> 4)) * (SRC).rs + (lane & 15) * 4); } }     \
        if (DO_PV) { const int vr_ = lane >> 1, vh_ = lane & 1; v4u vv_[4]; \
            if (vr_ >= (SRC).nvalid) { _Pragma("unroll") for (int x = 0; x < 4; ++x) vv_[x] = (v4u){0u, 0u, 0u, 0u}; } \
            else if ((SRC).vb) { const bf16* vp_ = (SRC).vb + (size_t)vr_ * (SRC).rs + 32 * vh_; _Pragma("unroll") for (int x = 0; x < 4; ++x) vv_[x] = *(const v4u*)(vp_ + 8 * x); } \
            if ((SRC).vb || vr_ >= (SRC).nvalid) { _Pragma("unroll") for (int x = 0; x < 4; ++x) *(LAS v4u*)(Vw + vr_ * AS_RS + vh_ * 64 + x * 16) = vv_[x]; } } \
        f32x16 s_ = (f32x16){}; \
        _Pragma("unroll") for (int kk = 0; kk < 4; ++kk) s_ = mfma32(kfr[kk], qf[kk], s_); \
        float tmax_ = -INFINITY; \
        _Pragma("unroll") for (int r = 0; r < 16; ++r) { const int key_ = (KB0) + (r & 3) + 8 * (r >> 2) + 4 * h_; s_[r] = (key_ >= (LO_) && key_ <= (HI_)) ? s_[r] : -INFINITY; tmax_ = fmaxf(tmax_, s_[r]); } \
        tmax_ = xhalf_max(tmax_); \
        const float mn_ = fmaxf(m, tmax_), mu_ = (mn_ == -INFINITY) ? 0.f : mn_, al_ = fexp2(m - mu_); float ps_ = 0.f; \
        _Pragma("unroll") for (int r = 0; r < 16; ++r) { s_[r] = fexp2(s_[r] - mu_); ps_ += s_[r]; } \
        lsum = lsum * al_ + ps_; m = mn_; \
        if (DO_PV) { O0 *= al_; O1 *= al_; \
            if (!(SRC).vb) { _Pragma("unroll") for (int x = 0; x < 8; ++x) { v2u o_; o_.x = pk2(vx_[x][0], vx_[x][1]); o_.y = pk2(vx_[x][2], vx_[x][3]); *(LAS v2u*)(Vw + (4 * x + (lane >> 4)) * AS_RS + (lane & 15) * 8) = o_; } } \
            LDS_WAIT(); asm volatile("" ::: "memory"); \
            _Pragma("unroll") for (int s2 = 0; s2 < 2; ++s2) { const bf16x8 pf_ = cvt_frag(s_, s2); const int rA_ = 16 * s2 + 4 * h_; \
                O0 = mfma32(tr_frag(Vw, AS_RS, rA_, rA_ + 8, 16 * blk, lane), pf_, O0); O1 = mfma32(tr_frag(Vw, AS_RS, rA_, rA_ + 8, 32 + 16 * blk, lane), pf_, O1); } \
            LDS_WAIT(); asm volatile("" ::: "memory"); } \
        if (DO_PS) { _Pragma("unroll") for (int r = 0; r < 16; ++r) { const int n_ = (KB0) + (r & 3) + 8 * (r >> 2) + 4 * h_; float a_ = s_[r] * (invden); a_ += __shfl_xor(a_, 1); a_ += __shfl_xor(a_, 2); if (hr == 0) PS[tl * (PSS_) + n_] = a_; } } \
    } while (0)

__device__ __forceinline__ void attn_sample_unit(Frame& F, int l, int unit) {
    const int lane = F.lane, w = F.wave, tid = F.tid;
    const int q = lane & 31, h_ = lane >> 5, blk = (lane >> 4) & 1, tl = q >> 2, hr = q & 3;
    const int seq = unit >> 1, kvh = unit & 1, head = kvh * 4 + hr;
    const size_t row = (size_t)PM + seq * ST + tl;
    LAS unsigned char* Vw = F.lds + AS_V + w * AS_VW;
    LAS float* MRG = (LAS float*)(F.lds + AS_MRG);
    LAS float* PS = (LAS float*)(F.lds + AS_PS);
    LAS float* IMPw = (LAS float*)(F.lds + AS_IMP) + w * 192;
    LAS unsigned long long* MASKS = (LAS unsigned long long*)(F.lds + AS_MASK);
    __syncthreads();
    bf16x8 qf[4];
    { const bf16* qp = WSP(bf16, WS_QN) + row * 512 + head * 64 + 8 * h_;
#pragma unroll
      for (int kk = 0; kk < 4; ++kk) qf[kk] = *(const bf16x8*)(qp + 16 * kk); }
    const float* ngp = WSP(float, WS_NG) + row * 24 + head * 3; const float g0 = ngp[0], g1 = ngp[1], g2 = ngp[2];
    const int* ptab = (const int*)F.a->in[I_PT] + seq * NPG;
    LAS float* OAL = (LAS float*)(F.lds + AS_OA) + lane;

#define AS_PUBLISH(m, lsum, O0, O1) do { __syncthreads(); LAS float* mp_ = MRG + w * 34 * 64 + lane; mp_[0] = m; mp_[64] = lsum; \
        _Pragma("unroll") for (int r = 0; r < 16; ++r) { mp_[(2 + r) * 64] = O0[r]; mp_[(18 + r) * 64] = O1[r]; } __syncthreads(); } while (0)

    const bf16* CKk = WSP(bf16, WS_CK) + ((size_t)(seq * 2 + kvh) * 512) * 64; const bf16* CKv = CKk + (size_t)CMP_ROWS_J * 64;
    float mC = -INFINITY, lC = 0.f; f32x16 D0 = (f32x16){}, D1 = (f32x16){};
#pragma unroll 1
    for (int ti = w; ti < 16; ti += 8) { ASrc S{nullptr, nullptr, CKk + (size_t)ti * 32 * 64, CKv + (size_t)ti * 32 * 64, 64, 32}; AS_TILE(S, ti * 32, 0, 510, false, false, mC, lC, D0, D1, 0.f, 520); }
    { __syncthreads(); MRG[w * 128 + lane] = mC; MRG[w * 128 + 64 + lane] = xhalf_sum(lC); __syncthreads(); }
    float mT = -INFINITY;
#pragma unroll
    for (int x = 0; x < 8; ++x) mT = fmaxf(mT, MRG[x * 128 + lane]);
    float lT = 0.f;
#pragma unroll
    for (int x = 0; x < 8; ++x) { const float mx_ = MRG[x * 128 + lane]; lT += (mx_ == -INFINITY) ? 0.f : MRG[x * 128 + 64 + lane] * fexp2(mx_ - mT); }
    const float invC = lT > 0.f ? 1.0f / lT : 0.f;
    __syncthreads();
    { float mB = mT, lB = 0.f;
#pragma unroll 1
      for (int ti = w; ti < 16; ti += 8) { ASrc S{nullptr, nullptr, CKk + (size_t)ti * 32 * 64, CKv + (size_t)ti * 32 * 64, 64, 32}; AS_TILE(S, ti * 32, 0, 510, true, true, mB, lB, D0, D1, invC, 520); }
      AS_PUBLISH(mB, lB, D0, D1); }
    if (w == 0) { const float sc = g0 * invC; f32x16 T0 = (f32x16){}, T1 = (f32x16){};
#pragma unroll 1
      for (int x = 0; x < 8; ++x) { const LAS float* mp = MRG + x * 34 * 64 + lane;
#pragma unroll
          for (int r = 0; r < 16; ++r) { T0[r] += mp[(2 + r) * 64] * sc; T1[r] += mp[(18 + r) * 64] * sc; } }
#pragma unroll
      for (int r = 0; r < 16; ++r) { OAL[r * 64] = T0[r]; OAL[(16 + r) * 64] = T1[r]; } }
    {
        const LAS float* pr = PS + w * 520; const int sa = lane, sb = lane + 64; float ia = 0.f, ib = 0.f;
#pragma unroll
        for (int n = 4 * sa - 1; n <= 4 * sa + 3; ++n) if (n >= 0) ia += pr[n];
#pragma unroll
        for (int n = 4 * sb - 1; n <= 4 * sb + 3; ++n) ib += pr[n];
        const bool fa = (sa == 0), fb = (sb == 127); const float va = fa ? 1e4f : ia, vb = fb ? 1e4f : ib;
        IMPw[sa] = va; IMPw[sb] = vb; LDS_WAIT(); asm volatile("" ::: "memory");
        int ra = fa ? 0 : 1, rb = fb ? 0 : 1;
#pragma unroll 8
        for (int i = 0; i < 128; ++i) { const float v = IMPw[i]; ra += (v > va || (v == va && i < sa)) ? 1 : 0; rb += (v > vb || (v == vb && i < sb)) ? 1 : 0; }
        const unsigned long long ma = __ballot(ra < 16), mb = __ballot(rb < 16);
        if (lane == 0) { MASKS[w * 4] = ma; MASKS[w * 4 + 1] = mb; }
    }
    __syncthreads();
    const unsigned long long mk0 = MASKS[tl * 4], mk1 = MASKS[tl * 4 + 1];
    unsigned long long U0 = 0ull, U1 = 0ull;
#pragma unroll
    for (int x = 0; x < 8; ++x) { U0 |= MASKS[x * 4]; U1 |= MASKS[x * 4 + 1]; }
    {
        float m = -INFINITY, ls = 0.f; D0 = (f32x16){}; D1 = (f32x16){};
        const int t = PAST + tl; int cnt = 0;
#pragma unroll 1
        for (int s = 0; s <= 128; ++s) {
            const bool in_u = (s < 64) ? ((U0 >> s) & 1ull) : ((s < 128) ? ((U1 >> (s - 64)) & 1ull) : true);
            if (!in_u) continue;
            const bool selb = (s < 64) ? ((mk0 >> s) & 1ull) : ((s < 128) ? ((mk1 >> (s - 64)) & 1ull) : true);
            const int nh = (s < 128) ? 2 : 1;
            for (int hf = 0; hf < nh; ++hf, ++cnt) {
                if ((cnt & 7) != w) continue;
                const int hi = selb ? t : -1;
                if (s < 128) { const int page = ptab[s >> 1], slot = (s & 1) * 64 + hf * 32;
                    const float* kp = FIN(I_CACHE) + (((((size_t)l * NPHYS + page) * PAGE + slot) * 4 + 2) * 2 + kvh) * 64;
                    ASrc S{kp, kp + 128, nullptr, nullptr, 512, 32}; AS_TILE(S, s * 64 + hf * 32, 0, hi, true, false, m, ls, D0, D1, 0.f, 520); }
                else { const bf16* kp = WSP(bf16, WS_KVS) + ((((size_t)0 * SB + seq) * 2 + kvh) * ST) * 64;
                    ASrc S{nullptr, nullptr, kp, kp + (size_t)SB * 2 * ST * 64, 64, ST}; AS_TILE(S, PAST, 0, hi, true, false, m, ls, D0, D1, 0.f, 520); }
            }
        }
        AS_PUBLISH(m, ls, D0, D1);
        float mt = -INFINITY;
#pragma unroll
        for (int x = 0; x < 8; ++x) mt = fmaxf(mt, MRG[x * 34 * 64 + lane]);
        float lt = 0.f; f32x16 T0 = (f32x16){}, T1 = (f32x16){};
#pragma unroll 1
        for (int x = 0; x < 8; ++x) { const LAS float* mp = MRG + x * 34 * 64 + lane; const float mx_ = mp[0]; const float f = (mx_ == -INFINITY) ? 0.f : fexp2(mx_ - mt); lt += mp[64] * f;
#pragma unroll
            for (int r = 0; r < 16; ++r) { T0[r] += mp[(2 + r) * 64] * f; T1[r] += mp[(18 + r) * 64] * f; } }
        lt = xhalf_sum(lt); const float sc = (lt > 0.f ? 1.0f / lt : 0.f) * g1;
        if (w == 0) {
#pragma unroll
            for (int r = 0; r < 16; ++r) { OAL[r * 64] += T0[r] * sc; OAL[(16 + r) * 64] += T1[r] * sc; } }
    }
    {
        float m = -INFINITY, ls = 0.f; D0 = (f32x16){}; D1 = (f32x16){};
#pragma unroll 1
        for (int ti = w; ti < 17; ti += 8) {
            if (ti < 16) { const float* kp = FIN(I_CWIN) + (((((size_t)l * SB + seq) * WINB + ti * 32) * 2 + 0) * 2 + kvh) * 64;
                ASrc S{kp, kp + 128, nullptr, nullptr, 256, 32}; AS_TILE(S, ti * 32, tl, WINB + tl, true, false, m, ls, D0, D1, 0.f, 520); }
            else { const bf16* kp = WSP(bf16, WS_KVS) + ((((size_t)2 * SB + seq) * 2 + kvh) * ST) * 64;
                ASrc S{nullptr, nullptr, kp, kp + (size_t)SB * 2 * ST * 64, 64, ST}; AS_TILE(S, WINB, tl, WINB + tl, true, false, m, ls, D0, D1, 0.f, 520); }
        }
        AS_PUBLISH(m, ls, D0, D1);
        float mt = -INFINITY;
#pragma unroll
        for (int x = 0; x < 8; ++x) mt = fmaxf(mt, MRG[x * 34 * 64 + lane]);
        float lt = 0.f; f32x16 T0 = (f32x16){}, T1 = (f32x16){};
#pragma unroll 1
        for (int x = 0; x < 8; ++x) { const LAS float* mp = MRG + x * 34 * 64 + lane; const float mx_ = mp[0]; const float f = (mx_ == -INFINITY) ? 0.f : fexp2(mx_ - mt); lt += mp[64] * f;
#pragma unroll
            for (int r = 0; r < 16; ++r) { T0[r] += mp[(2 + r) * 64] * f; T1[r] += mp[(18 + r) * 64] * f; } }
        lt = xhalf_sum(lt); const float sc = (lt > 0.f ? 1.0f / lt : 0.f) * g2;
        if (w == 0) {
#pragma unroll
            for (int r = 0; r < 16; ++r) { OAL[r * 64] += T0[r] * sc; OAL[(16 + r) * 64] += T1[r] * sc; } }
    }
#undef AS_PUBLISH
    if (w == 0) {
        bf16* op = WSP(bf16, WS_OA) + row * 512 + head * 64;
#pragma unroll
        for (int r4 = 0; r4 < 4; ++r4) { float a_[4], b_[4];
#pragma unroll
            for (int x = 0; x < 4; ++x) { a_[x] = OAL[(4 * r4 + x) * 64]; b_[x] = OAL[(16 + 4 * r4 + x) * 64]; }
            v2u a, b; a.x = pk2(a_[0], a_[1]); a.y = pk2(a_[2], a_[3]); b.x = pk2(b_[0], b_[1]); b.y = pk2(b_[2], b_[3]);
            *(v2u*)(op + 8 * r4 + 4 * h_) = a; *(v2u*)(op + 32 + 8 * r4 + 4 * h_) = b; }
    }
}

#ifndef DBG_DUP
#define DBG_DUP 0
#endif
#if DBG_DUP == 1
#define AP_DUP_QK(NK) { f32x16 d_ = (f32x16){}; _Pragma("unroll") for (int kk = 0; kk < 4; ++kk) d_ = mfma32(NK[kk], qf[(kk + 1) & 3], d_); _Pragma("unroll") for (int r = 0; r < 16; ++r) s_[r] += zf * d_[r]; }
#else
#define AP_DUP_QK(NK)
#endif
#if DBG_DUP == 2
#define AP_DUP_EXP() { float acc_ = 0.f; _Pragma("unroll") for (int r = 0; r < 16; ++r) acc_ += fexp2(s_[r] * 0.5f - 3.0f); lsum += zf * acc_; }
#else
#define AP_DUP_EXP()
#endif
#if DBG_DUP == 3
#define AP_DUP_PV() { f32x16 e0_ = (f32x16){}, e1_ = (f32x16){}; _Pragma("unroll") for (int s2 = 0; s2 < 2; ++s2) { const bf16x8 pf_ = cvt_frag(s_, 1 - s2); const int rA_ = 16 * s2 + 4 * h_; \
        e0_ = mfma32(tr_frag(Vw, AS_RS, rA_ + 8, rA_, 16 * blk, lane), pf_, e0_); e1_ = mfma32(tr_frag(Vw, AS_RS, rA_ + 8, rA_, 32 + 16 * blk, lane), pf_, e1_); } D0 += e0_ * zf; D1 += e1_ * zf; }
#else
#define AP_DUP_PV()
#endif
constexpr int AP_WS = 14336, AP_V = 0, AP_PS = 4608, AP_IMP = AP_PS + 8 * 264 * 4, AP_MASK = AP_IMP + 256, AP_LIST = AP_MASK + 64;
static_assert(AP_LIST + 2 * 192 <= AP_WS && 8 * AP_WS <= RING_BYTES, "prompt attention LDS map");
__device__ __forceinline__ void attn_prompt_unit(Frame& F, int l, int unit) {
    const int lane = F.lane, w = F.wave;
    const int q = lane & 31, h_ = lane >> 5, blk = (lane >> 4) & 1, tl = q >> 2, hr = q & 3;
    const int seq = unit >> 7, kvh = (unit >> 6) & 1, qt = unit & 63, head = kvh * 4 + hr;
    const int t0w = qt * 64 + 8 * w, t = t0w + tl; const size_t row = (size_t)seq * PT + t;
    LAS unsigned char* Vw = F.lds + w * AP_WS + AP_V; LAS float* PS = (LAS float*)(F.lds + w * AP_WS + AP_PS); LAS float* IMPw = (LAS float*)(F.lds + w * AP_WS + AP_IMP);
    LAS unsigned long long* MASKS = (LAS unsigned long long*)(F.lds + w * AP_WS + AP_MASK); LAS unsigned short* LIST = (LAS unsigned short*)(F.lds + w * AP_WS + AP_LIST);
    __syncthreads();
    bf16x8 qf[4];
    { const bf16* qp = WSP(bf16, WS_QN) + row * 512 + head * 64 + 8 * h_;
#pragma unroll
      for (int kk = 0; kk < 4; ++kk) qf[kk] = *(const bf16x8*)(qp + 16 * kk); }
    const float* ngp = WSP(float, WS_NG) + row * 24 + head * 3; const float g0 = ngp[0], g1 = ngp[1], g2 = ngp[2];
    for (int i = lane; i < 8 * 264; i += 64) PS[i] = 0.f;
    const bf16* CKk = WSP(bf16, WS_CK) + ((size_t)32768 + (seq * 2 + kvh) * 256) * 64; const bf16* CKv = CKk + (size_t)CMP_ROWS_J * 64;
    const bf16* KS = WSP(bf16, WS_KVB) + ((((size_t)0 * PB + seq) * 2 + kvh) * PT) * 64; const bf16* VS = KS + (size_t)PB * 2 * PT * 64;
    const bf16* KW = KS + (size_t)2 * PB * 2 * PT * 64; const bf16* VW = KW + (size_t)PB * 2 * PT * 64;
    const int hiCmin = (t0w >= 31) ? ((t0w - 31) >> 4) : -1;
    const int hiC = (t >= 31) ? ((t - 31) >> 4) : -1; const int nmaxw = (t0w + 7 >= 31) ? ((t0w + 7 - 31) >> 4) : -1; const int ntc = (nmaxw >= 0) ? (nmaxw >> 5) + 1 : 0;
    f32x16 D0 = (f32x16){}, D1 = (f32x16){};
    LAS float* OAG = PS + lane;
    float m = -INFINITY, lsum = 0.f, invC = 0.f; unsigned long long mk0 = 0ull;
    const float zf = (F.G == 12345) ? 1.0f : 0.0f;
    bf16x8 nk0[4]; v4u nv0[4], nv1[4];
#define AP_LOADK(e_, NK) do { const int kd_ = (int)((e_) >> 12), ti_ = (int)((e_) & 0xfffu); const bf16* kb_ = (kd_ < 2 ? CKk : (kd_ == 2 ? KS : KW)) + (size_t)ti_ * 32 * 64; \
        const int ko_ = kd_ < 2 ? q * 64 + 8 * h_ : lane * 8, ks_ = kd_ < 2 ? 16 : 512;     \
        _Pragma("unroll") for (int kk = 0; kk < 4; ++kk) NK[kk] = *(const bf16x8*)(kb_ + ko_ + ks_ * kk); } while (0)
#define AP_LOADV(e_, NV) do { const int kd_ = (int)((e_) >> 12), ti_ = (int)((e_) & 0xfffu); const bf16* vb_ = (kd_ < 2 ? CKv : (kd_ == 2 ? VS : VW)) + (size_t)ti_ * 32 * 64; \
        _Pragma("unroll") for (int x = 0; x < 4; ++x) NV[x] = *(const v4u*)(vb_ + 512 * x + lane * 8); } while (0)
#define AP_LOADT(e_, NK, NV) do { AP_LOADK(e_, NK); AP_LOADV(e_, NV); } while (0)
#define AP_STEP(i_, n_, NK, NV, NVN, EC, ECN) do { \
        const unsigned e_ = EC; const int kind = (int)(e_ >> 12), ti = (int)(e_ & 0xfffu); \
        if (kind == 1) { _Pragma("unroll") for (int x = 0; x < 4; ++x) *(LAS v4u*)(Vw + (8 * x + (lane >> 3)) * AS_RS + (lane & 7) * 16) = NV[x]; }     \
        f32x16 s_ = (f32x16){}; \
        _Pragma("unroll") for (int kk = 0; kk < 4; ++kk) s_ = mfma32(NK[kk], qf[kk], s_); \
        AP_DUP_QK(NK) \
          \
        if ((i_) + 1 < (n_)) { AP_LOADK(ECN, NK); AP_LOADV(ECN, NVN); if ((i_) + 2 < (n_)) EC = (unsigned)__builtin_amdgcn_readfirstlane((int)LIST[(i_) + 2]); } \
        if (kind != cur_kind) { \
            if (cur_kind == 0) { const float lt_ = xhalf_sum(lsum); invC = lt_ > 0.f ? 1.0f / lt_ : 0.f; } \
            else if (cur_kind == 2) { const float lt_ = xhalf_sum(lsum); const float sc_ = (lt_ > 0.f ? 1.0f / lt_ : 0.f) * g1; \
                _Pragma("unroll") for (int r = 0; r < 16; ++r) { OAG[r * 64] += D0[r] * sc_; OAG[(16 + r) * 64] += D1[r] * sc_; } } \
            if (kind != 1) m = -INFINITY; lsum = 0.f; D0 = (f32x16){}; D1 = (f32x16){}; cur_kind = kind; } \
        const int kb = ti * 32; int lo, hi; \
        if (kind < 2) { lo = 0; hi = hiC; } else if (kind == 2) { lo = 0; hi = ((mk0 >> (ti >> 1)) & 1ull) ? t : -1; } else { lo = t - WINB; hi = t; } \
          \
        const bool interior = (kind < 2) ? (hiCmin >= 0 && kb + 31 <= hiCmin) : ((kind == 2) ? (kb + 31 <= t0w) : (kb >= t0w + 7 - WINB && kb + 31 <= t0w)); \
        float tmax_ = -INFINITY, mu_, mn_; \
        if (interior) { const bool on_ = hi >= 0; \
            _Pragma("unroll") for (int r = 0; r < 16; ++r) tmax_ = fmaxf(tmax_, s_[r]); \
            tmax_ = on_ ? tmax_ : -INFINITY; tmax_ = xhalf_max(tmax_); \
            mn_ = fmaxf(m, tmax_); mu_ = (mn_ == -INFINITY) ? 0.f : mn_; const float mr_ = on_ ? mu_ : INFINITY; \
            _Pragma("unroll") for (int r = 0; r < 16; ++r) s_[r] = fexp2(s_[r] - mr_); \
        } else { \
            _Pragma("unroll") for (int r = 0; r < 16; ++r) { const int key_ = kb + (r & 3) + 8 * (r >> 2) + 4 * h_; s_[r] = (key_ >= lo && key_ <= hi) ? s_[r] : -INFINITY; tmax_ = fmaxf(tmax_, s_[r]); } \
            tmax_ = xhalf_max(tmax_); \
            mn_ = fmaxf(m, tmax_); mu_ = (mn_ == -INFINITY) ? 0.f : mn_; \
            _Pragma("unroll") for (int r = 0; r < 16; ++r) s_[r] = fexp2(s_[r] - mu_); \
        } \
        AP_DUP_EXP() \
        const float al_ = fexp2(m - mu_); float ps_ = 0.f; \
        _Pragma("unroll") for (int r = 0; r < 16; ++r) ps_ += s_[r]; \
        lsum = lsum * al_ + ps_; m = mn_; \
        if (kind >= 2) { if (__ballot(al_ != 1.0f) != 0ull) { D0 *= al_; D1 *= al_; } \
            const bf16x8 pf0_ = cvt_frag(s_, 0), pf1_ = cvt_frag(s_, 1); \
            D0 = mfma32(__builtin_bit_cast(bf16x8, NV[0]), pf0_, D0); D1 = mfma32(__builtin_bit_cast(bf16x8, NV[2]), pf0_, D1); D0 = mfma32(__builtin_bit_cast(bf16x8, NV[1]), pf1_, D0); D1 = mfma32(__builtin_bit_cast(bf16x8, NV[3]), pf1_, D1); \
        } else if (kind == 1) { if (__ballot(al_ != 1.0f) != 0ull) { D0 *= al_; D1 *= al_; } asm volatile("" ::: "memory");   \
            { const bf16x8 va0_ = tr_frag(Vw, AS_RS, 4 * h_, 4 * h_ + 8, 16 * blk, lane), va1_ = tr_frag(Vw, AS_RS, 4 * h_, 4 * h_ + 8, 32 + 16 * blk, lane), \
                           vb0_ = tr_frag(Vw, AS_RS, 16 + 4 * h_, 24 + 4 * h_, 16 * blk, lane), vb1_ = tr_frag(Vw, AS_RS, 16 + 4 * h_, 24 + 4 * h_, 32 + 16 * blk, lane);   \
              const bf16x8 pf0_ = cvt_frag(s_, 0), pf1_ = cvt_frag(s_, 1); \
              D0 = mfma32(va0_, pf0_, D0); D1 = mfma32(va1_, pf0_, D1); D0 = mfma32(vb0_, pf1_, D0); D1 = mfma32(vb1_, pf1_, D1); } \
            AP_DUP_PV() \
            asm volatile("" ::: "memory"); } \
        if (kind == 1) { _Pragma("unroll") for (int r = 0; r < 16; ++r) { const int n2_ = kb + (r & 3) + 8 * (r >> 2) + 4 * h_; float a_ = s_[r] * invC; a_ += __shfl_xor(a_, 1); a_ += __shfl_xor(a_, 2); if (hr == 0) PS[tl * 264 + n2_] = a_; } } \
    } while (0)
#define AP_RUN(N_) do { const int n_ = (N_); unsigned ec0_ = 0u, ec1_ = 0u;                  \
      if (n_ > 0) { ec0_ = (unsigned)__builtin_amdgcn_readfirstlane((int)LIST[0]); AP_LOADK(ec0_, nk0); AP_LOADV(ec0_, nv0); } \
      if (n_ > 1) { ec1_ = (unsigned)__builtin_amdgcn_readfirstlane((int)LIST[1]); } \
      _Pragma("unroll 1") for (int i_ = 0; i_ < n_; i_ += 2) { AP_STEP(i_, n_, nk0, nv0, nv1, ec0_, ec1_); if (i_ + 1 < n_) AP_STEP(i_ + 1, n_, nk0, nv1, nv0, ec1_, ec0_); } } while (0)
    int cur_kind = -1;
    if (lane < 2 * ntc) LIST[lane] = (unsigned short)(((lane >= ntc ? 1u : 0u) << 12) | (unsigned)(lane >= ntc ? lane - ntc : lane));
    LDS_WAIT(); asm volatile("" ::: "memory");
    AP_RUN(2 * ntc);
    { const float sc = (cur_kind == 1) ? g0 * invC : 0.f; D0 *= sc; D1 *= sc; }
    LDS_WAIT(); asm volatile("" ::: "memory");
#pragma unroll 1
    for (int tk = 0; tk < 8; ++tk) {
        const LAS float* pr = PS + tk * 264; const int s = lane; float imp = 0.f;
#pragma unroll
        for (int n = 4 * s - 1; n <= 4 * s + 3; ++n) if (n >= 0) imp += pr[n];
        const bool forced = (s == 0) || (s == qt) || (s == qt - 1), avail = s <= qt;
        const unsigned key = avail ? (forced ? 0x7fffffffu : (imp > 0.f ? __float_as_uint(imp) + 1u : 1u)) : 0u;
        unsigned thr = 0u;
#pragma unroll
        for (int bit = 30; bit >= 0; --bit) { const unsigned cand = thr | (1u << bit); const int cnt = __popcll(__ballot(key >= cand)); thr = (cnt >= 16) ? cand : thr; }
        const unsigned long long gt = __ballot(key > thr), eq = __ballot(key == thr); const int need = 16 - __popcll(gt);
        const int below = __builtin_amdgcn_mbcnt_hi((unsigned)(eq >> 32), __builtin_amdgcn_mbcnt_lo((unsigned)eq, 0u));
        const unsigned long long mk = gt | __ballot(key == thr && below < need);
        if (lane == 0) MASKS[tk] = mk;
        LDS_WAIT(); asm volatile("" ::: "memory");
    }
#pragma unroll
    for (int r = 0; r < 16; ++r) { OAG[r * 64] = D0[r]; OAG[(16 + r) * 64] = D1[r]; }
    mk0 = MASKS[tl]; unsigned long long wu = 0ull;
#pragma unroll
    for (int i = 0; i < 8; ++i) wu |= MASKS[i];
    wu &= (qt >= 63) ? ~0ull : ((1ull << (qt + 1)) - 1ull);
    const int nsel = 2 * __popcll(wu); const int tiLo = (t0w > WINB) ? ((t0w - WINB) >> 5) : 0, tiHi = (t0w + 7) >> 5, nwin = tiHi - tiLo + 1;
    if ((wu >> lane) & 1ull) { const int pos = 2 * __popcll(wu & ((1ull << lane) - 1ull)); LIST[pos] = (unsigned short)((2u << 12) | (unsigned)(2 * lane)); LIST[pos + 1] = (unsigned short)((2u << 12) | (unsigned)(2 * lane + 1)); }
    if (lane < nwin) LIST[nsel + lane] = (unsigned short)((3u << 12) | (unsigned)(tiLo + lane));
    LDS_WAIT(); asm volatile("" ::: "memory");
#ifdef DBG_COUNT
    if (lane == 0) { unsigned* CNT = (unsigned*)(F.ws + WS_CTL) + 3000; atomicAdd(CNT + 0, (unsigned)nsel); atomicAdd(CNT + 1, (unsigned)nwin); atomicAdd(CNT + 2, (unsigned)(2 * ntc)); atomicAdd(CNT + 3, 1u); }
#endif
    cur_kind = -1;
    AP_RUN(nsel + nwin);
    const float ltw = xhalf_sum(lsum); const float scw = (ltw > 0.f ? 1.0f / ltw : 0.f) * g2;
#undef AP_RUN
#undef AP_STEP
#undef AP_LOADT
#undef AP_LOADK
#undef AP_LOADV
    {
        bf16* op = WSP(bf16, WS_OA) + row * 512 + head * 64;
#pragma unroll
        for (int r4 = 0; r4 < 4; ++r4) { float a_[4], b_[4];
#pragma unroll
            for (int x = 0; x < 4; ++x) { a_[x] = OAG[(4 * r4 + x) * 64] + D0[4 * r4 + x] * scw; b_[x] = OAG[(16 + 4 * r4 + x) * 64] + D1[4 * r4 + x] * scw; }
            v2u a, b; a.x = pk2(a_[0], a_[1]); a.y = pk2(a_[2], a_[3]); b.x = pk2(b_[0], b_[1]); b.y = pk2(b_[2], b_[3]);
            *(v2u*)(op + 8 * r4 + 4 * h_) = a; *(v2u*)(op + 32 + 8 * r4 + 4 * h_) = b; }
    }
}
#undef AS_TILE

#ifdef DBG_CHECK
__device__ __forceinline__ unsigned dbg_rand(unsigned x) { x ^= x >> 16; x *= 0x7feb352du; x ^= x >> 15; x *= 0x846ca68bu; x ^= x >> 16; return x; }
__device__ __forceinline__ bool dbg_bad(float got, float exp_, float rtol, float atol) { return !(fabsf(got - exp_) <= rtol * fabsf(exp_) + atol); }
__device__ __forceinline__ float bfr(float x) { return __uint_as_float(pk2(x, 0.f) << 16); }
__device__ __forceinline__ int dbg_row(unsigned r) { const unsigned k = r % 20u; if (k == 0) return (int)(PM + (r >> 8) % SM); if (k == 1) return (int)(((r >> 8) % PB) * PT + ((r >> 12) % 8)); if (k == 2) return (int)(((r >> 8) % PB) * PT + PT - 1 - ((r >> 12) % 8)); return (int)((r >> 5) % PM); }
__device__ __forceinline__ float dbg_rs(const Frame& F, int row, int lane) { const float* xr = xrow_in(F, 0, row); float ss = 0.f; for (int d = lane; d < DM; d += 64) ss += xr[d] * xr[d]; return 1.0f / sqrtf(wave_sum(ss) * (1.0f / DM) + EPS); }
__device__ __forceinline__ float dbg_h(const Frame& F, int row, int d, float rs) { const float* mod = WSP(float, WS_MOD) + (size_t)row_bb(row) * 6144; return bfr(xrow_in(F, 0, row)[d] * rs * FIN(I_N1G)[d] * (1.0f + mod[1024 + d]) + mod[d]); }

__device__ __forceinline__ void dbg_check_phase(Frame& F) {
    const int gw = F.bid * NWAVES + F.wave, NGW = F.G * NWAVES, lane = F.lane;
    unsigned* CNT = (unsigned*)(F.ws + WS_CTL) + 3000;
    LAS float* L = (LAS float*)(F.lds + F.wave * 16384);
#define DBG_FLAG(ch, cond) do { if (__any(cond) && lane == 0) atomicAdd(CNT + (ch), 1u); } while (0)
    for (int s = gw; s < 1536; s += NGW) {
        const unsigned r = dbg_rand(1000u + s); const int row = dbg_row(r); const float rs = dbg_rs(F, row, lane); const int kind = s % 6;
        const bool isp = row < PM; const int b = isp ? (row >> 12) : ((row - PM) >> 3), t = isp ? (row & (PT - 1)) : ((row - PM) & 7);
#define DBG_U(col, dst) do { float a_ = 0.f; for (int d_ = lane; d_ < DM; d_ += 64) a_ += dbg_h(F, row, d_, rs) * bfr(FIN(I_WIN)[(size_t)d_ * D_IN + (col)]); dst = wave_sum(a_); } while (0)
        if (kind == 0) {
            const int c = (r >> 3) % 768, j = c >> 7, k = (c >> 6) & 1, dd = c & 63; float u; DBG_U(O_NKV + c, u); bool bad = false;
            if (j < 4) bad = dbg_bad(F.out[(isp ? OUT_ROWS_P + (size_t)row * 512 : OUT_ROWS_S + (size_t)(row - PM) * 512) + c], u, 0.01f, 0.01f);
            else if (isp) { if (t >= PT - WINB) bad = dbg_bad(F.out[OUT_WIN_P + ((size_t)b * WINB + (t - (PT - WINB))) * 256 + (c - 512)], u, 0.01f, 0.01f); }
            else bad = dbg_bad(F.out[OUT_WIN_S + ((size_t)b * WINB + (WINB - ST) + t) * 256 + (c - 512)], u, 0.01f, 0.01f);
            if (isp) { if (j < 2) bad = bad || dbg_bad(bf1(WSP(bf16, WS_ACMP)[((size_t)j * CMP_ROWS_J + 32768 + (b * 2 + k) * 256 + (t >> 4)) * 1024 + (t & 15) * 64 + dd]), u, 0.01f, 0.01f);
                       else bad = bad || dbg_bad(bf1(WSP(bf16, WS_KVB)[((((size_t)(j - 2) * PB + b) * 2 + k) * PT + t) * 64 + dd]), u, 0.01f, 0.01f); }
            else if (j >= 2) bad = bad || dbg_bad(bf1(WSP(bf16, WS_KVS)[((((size_t)(j - 2) * SB + b) * 2 + k) * ST + t) * 64 + dd]), u, 0.01f, 0.01f);
            DBG_FLAG(0, bad);
        } else if (kind == 1) {
            const int gi = (r >> 3) % 24, c5 = (r >> 8) % 512, cm = (r >> 8) % 3072; float u0, u1, u2, u3; DBG_U(O_NG + gi, u0); DBG_U(O_RX + c5, u1); DBG_U(O_RGATE + c5, u2); DBG_U(O_MG + cm, u3);
            bool bad = dbg_bad(WSP(float, WS_NG)[(size_t)row * 24 + gi], 1.0f / (1.0f + expf(-u0)), 0.01f, 0.005f);
            bad = bad || dbg_bad(WSP(float, WS_RX)[(size_t)row * 512 + c5], u1, 0.01f, 0.01f);
            bad = bad || dbg_bad(bf1(WSP(bf16, WS_GG)[(size_t)row * 512 + c5]), gelu_tanh(u2), 0.02f, 0.01f);
            bad = bad || dbg_bad(bf1(WSP(bf16, WS_MGS)[(size_t)row * 3072 + cm]), 1.0f / (1.0f + expf(-u3)), 0.01f, 0.005f);
            DBG_FLAG(1, bad);
        } else if (kind == 2) {
            const int head = (r >> 13) % 4, dim = (r >> 16) % 64, c5 = (r >> 3) % 512; float x1, x2, uv, ug, uq; DBG_U(O_RQ + head * 128 + dim, x1); DBG_U(O_RQ + head * 128 + 64 + dim, x2); DBG_U(O_RV + c5, uv); DBG_U(O_RG + c5, ug); DBG_U(O_NQ + c5, uq);
            const float pos = (float)(isp ? t : PAST + t); const float ang = pos * (float)pow(10000.0, -(double)dim / 64.0); float sn, cs; sincos_acc(ang, sn, cs);
            const bf16* RQ = WSP(bf16, WS_RQ);
            bool bad = dbg_bad(bf1(RQ[(size_t)row * 512 + head * 128 + dim]), x1 * cs - x2 * sn, 0.02f, 0.02f) || dbg_bad(bf1(RQ[(size_t)row * 512 + head * 128 + 64 + dim]), x1 * sn + x2 * cs, 0.02f, 0.02f);
            bad = bad || dbg_bad(bf1(RQ[(size_t)2 * MT * 512 + (size_t)row * 512 + c5]), uv, 0.01f, 0.01f) || dbg_bad(bf1(RQ[(size_t)3 * MT * 512 + (size_t)row * 512 + c5]), ug, 0.01f, 0.01f);
            bad = bad || dbg_bad(bf1(WSP(bf16, WS_QN)[(size_t)row * 512 + c5]), uq * QSCALE, 0.01f, 0.005f);
            DBG_FLAG(2, bad);
        }
#undef DBG_U
    }
    for (int s = gw; s < 128; s += NGW) {
        const unsigned r = dbg_rand(3000u + s); const int j = r & 1; const bool smp = ((r >> 1) & 3) != 0;
        const int grp = smp ? (int)((r >> 3) % 64) : (int)((r >> 3) % 8), nmax = smp ? 511 : 255; int n = (r >> 10) % nmax; if (((r >> 20) & 7) == 0) n = nmax - 1;
        const size_t rj = smp ? (size_t)grp * 512 + n : (size_t)32768 + grp * 256 + n;
        const bf16* A = WSP(bf16, WS_ACMP) + ((size_t)j * CMP_ROWS_J + rj) * 1024;
        const float* w1 = FIN(I_W1) + (size_t)j * 2048 * 128; const float* pe = FIN(I_PE) + j * 2048;
        for (int hh = 0; hh < 2; ++hh) { const int h = lane + 64 * hh; float a = FIN(I_B1)[j * 128 + h];
            for (int i = 0; i < 1024; ++i) a += (bf1(A[i]) + pe[i]) * w1[(size_t)i * 128 + h] + (bf1(A[1024 + i]) + pe[1024 + i]) * w1[(size_t)(1024 + i) * 128 + h];
            L[h] = gelu_tanh(a); }
        LDS_WAIT(); asm volatile("" ::: "memory");
        float o = 0.f; for (int h = 0; h < 128; ++h) o += L[h] * FIN(I_W2)[((size_t)j * 128 + h) * 64 + lane];
        const float got = bf1(WSP(bf16, WS_CK)[((size_t)j * CMP_ROWS_J + rj) * 64 + lane]);
        { const bool bd = dbg_bad(got, o, 0.05f, 0.03f); const unsigned long long mk = __ballot(bd); if (lane == 0 && mk) atomicAdd(CNT + 3, (unsigned)__popcll(mk)); }
        LDS_WAIT(); asm volatile("" ::: "memory");
    }
    for (int s = gw; s < 128; s += NGW) {
        const unsigned r = dbg_rand(3500u + s); const int j = r & 1; const bool smp = ((r >> 1) & 3) != 0;
        const int grp = smp ? (int)((r >> 3) % 64) : (int)((r >> 3) % 8), nmax = smp ? 511 : 255; const int n = (r >> 10) % nmax;
        const size_t rj = smp ? (size_t)grp * 512 + n : (size_t)32768 + grp * 256 + n, row = (size_t)j * CMP_ROWS_J + rj;
        const bf16* A = WSP(bf16, WS_ACMP) + row * 1024; const float* w1 = FIN(I_W1) + (size_t)j * 2048 * 128; const bf16* LH = WSP(bf16, WS_LH);
        unsigned nb = 0;
        for (int hh = 0; hh < 2; ++hh) { const int h = lane + 64 * hh; float lo = 0.f, hi = 0.f;
            for (int i = 0; i < 1024; ++i) { const float av = bf1(A[i]); lo += av * bfr(w1[(size_t)i * 128 + h]); hi += av * bfr(w1[(size_t)(1024 + i) * 128 + h]); }
            const bool bd = dbg_bad(bf1(LH[row * 256 + h]), lo, 0.02f, 0.02f) || dbg_bad(bf1(LH[row * 256 + 128 + h]), hi, 0.02f, 0.02f); nb += (unsigned)__popcll(__ballot(bd)); }
        if (lane == 0 && nb) atomicAdd(CNT + 9, nb);
        for (int hh = 0; hh < 2; ++hh) { const int h = lane + 64 * hh; L[h] = gelu_tanh(bf1(LH[row * 256 + h]) + bf1(LH[(row + 1) * 256 + 128 + h]) + WSP(float, WS_SMALLW + SW_CB)[j * 128 + h]); }
        LDS_WAIT(); asm volatile("" ::: "memory");
        float o = 0.f; for (int h = 0; h < 128; ++h) o += bfr(L[h]) * bfr(FIN(I_W2)[((size_t)j * 128 + h) * 64 + lane]);
        { const bool bd = dbg_bad(bf1(WSP(bf16, WS_CK)[row * 64 + lane]), o, 0.03f, 0.01f); const unsigned long long mk = __ballot(bd); if (lane == 0 && mk) atomicAdd(CNT + 11, (unsigned)__popcll(mk)); }
        LDS_WAIT(); asm volatile("" ::: "memory");
    }
    for (int s = gw; s < 64; s += NGW) {
        const unsigned r = dbg_rand(3700u + s); const int j = r & 1, half = (r >> 1) & 1, h = (r >> 2) % 128; const bf16* W1T = WSP(bf16, WS_SMALLW + SW_W1T) + ((size_t)j * 256 + half * 128 + h) * 1024;
        const float* w1 = FIN(I_W1) + ((size_t)j * 32 + half * 16) * 64 * 128 + h; unsigned nb = 0;
        for (int k = lane; k < 1024; k += 64) nb += (unsigned)__popcll(__ballot(dbg_bad(bf1(W1T[k]), w1[(size_t)k * 128], 0.01f, 0.0001f)));
        if (lane == 0 && nb) atomicAdd(CNT + 12, nb);
        const bool smp = ((r >> 9) & 3) != 0; const int grp = smp ? (int)((r >> 11) % 64) : (int)((r >> 11) % 8), n = (r >> 17) % (smp ? 511 : 255);
        const size_t row = (size_t)j * CMP_ROWS_J + (smp ? (size_t)grp * 512 + n : (size_t)32768 + grp * 256 + n); const bf16* A = WSP(bf16, WS_ACMP) + row * 1024;
        float a = 0.f; for (int k = lane; k < 1024; k += 64) a += bf1(A[k]) * bf1(W1T[k]); a = wave_sum(a);
        DBG_FLAG(13, dbg_bad(bf1(WSP(bf16, WS_LH)[row * 256 + half * 128 + h]), a, 0.02f, 0.02f));
    }
    for (int s = gw; s < 4; s += NGW) {
        const int j = s >> 1, h = (s & 1) * 64 + lane; const float* w1 = FIN(I_W1) + (size_t)j * 2048 * 128; const float* pe = FIN(I_PE) + j * 2048;
        float a = FIN(I_B1)[j * 128 + h]; for (int i = 0; i < 2048; ++i) a += pe[i] * w1[(size_t)i * 128 + h];
        const unsigned long long mk = __ballot(dbg_bad(WSP(float, WS_SMALLW + SW_CB)[j * 128 + h], a, 0.001f, 0.0005f)); if (lane == 0 && mk) atomicAdd(CNT + 10, (unsigned)__popcll(mk));
    }
    for (int s = gw; s < 96; s += NGW) {
        const unsigned r = dbg_rand(4000u + s); const bool smp = (s % 3) == 2;
        int seq, kvh = (r >> 4) & 1, t, tl = 0; size_t row;
        if (smp) { seq = (r >> 5) % SB; tl = (r >> 10) % ST; t = PAST + tl; row = (size_t)PM + seq * ST + tl; }
        else { seq = (r >> 5) % PB; const unsigned k = (r >> 8) % 8u; t = (k == 0) ? (int)((r >> 12) % 40) : (k == 1) ? PT - 1 - (int)((r >> 12) % 70) : (int)((r >> 12) % PT); row = (size_t)seq * PT + t; }
        const int N = smp ? 511 : 255, NS = smp ? 129 : 64, cur = t >> 6;
        LAS float* Q = L; LAS float* SC = L + 256; LAS float* PSUM = L + 256 + 2048; LAS float* OUT = L + 256 + 2048 + 512;
        for (int i = lane; i < 256; i += 64) Q[i] = bf1(WSP(bf16, WS_QN)[row * 512 + (kvh * 4 + (i >> 6)) * 64 + (i & 63)]);
        for (int i = lane; i < 768; i += 64) OUT[i] = 0.f;
        LDS_WAIT(); asm volatile("" ::: "memory");
        const bf16* CKk = WSP(bf16, WS_CK) + (smp ? (size_t)(seq * 2 + kvh) * 512 : (size_t)32768 + (seq * 2 + kvh) * 256) * 64; const bf16* CKv = CKk + (size_t)CMP_ROWS_J * 64;
        const int nvis = smp ? 511 : ((t >= 31) ? ((t - 31) >> 4) + 1 : 0);
        for (int i = lane; i < 512; i += 64) PSUM[i] = 0.f;
        for (int hr = 0; hr < 4; ++hr) {
            float mx = -INFINITY; for (int n = lane; n < nvis; n += 64) { float a = 0.f; for (int d = 0; d < 64; ++d) a += Q[hr * 64 + d] * bf1(CKk[(size_t)n * 64 + d]); SC[n] = a; mx = fmaxf(mx, a); }
            for (int o = 1; o < 64; o <<= 1) mx = fmaxf(mx, __shfl_xor(mx, o));
            float den = 0.f; for (int n = lane; n < nvis; n += 64) { const float e = exp2f(SC[n] - mx); SC[n] = e; den += e; } den = wave_sum(den);
            LDS_WAIT(); asm volatile("" ::: "memory");
            if (nvis > 0) { float o = 0.f; for (int n = 0; n < nvis; ++n) o += SC[n] * bf1(CKv[(size_t)n * 64 + lane]); OUT[hr * 64 + lane] = o / den;
                for (int n = lane; n < nvis; n += 64) PSUM[n] += SC[n] / den; }
            LDS_WAIT(); asm volatile("" ::: "memory");
        }
        LAS float* IMP = SC; LAS float* SELB = SC + 256;
        for (int sblk = lane; sblk < NS; sblk += 64) { float imp = 0.f; for (int n = 4 * sblk - 1; n <= 4 * sblk + 3; ++n) if (n >= 0 && n < N) imp += PSUM[n];
            const bool forced = sblk == 0 || sblk == cur || sblk == cur - 1, avail = sblk * 64 <= t; IMP[sblk] = avail ? (forced ? 1e4f : imp) : -1e4f; SELB[sblk] = 0.f; }
        LDS_WAIT(); asm volatile("" ::: "memory");
        for (int pick = 0; pick < 16 && pick < NS; ++pick) { float bv = -INFINITY; int bi = 1 << 30;
            for (int sblk = lane; sblk < NS; sblk += 64) { const float v = (SELB[sblk] != 0.f) ? -INFINITY : IMP[sblk]; if (v > bv || (v == bv && sblk < bi)) { bv = v; bi = sblk; } }
            for (int o = 1; o < 64; o <<= 1) { const float ov = __shfl_xor(bv, o); const int oi = __shfl_xor(bi, o); if (ov > bv || (ov == bv && oi < bi)) { bv = ov; bi = oi; } }
            if (lane == 0) SELB[bi] = 1.f; LDS_WAIT(); asm volatile("" ::: "memory"); }
        for (int br = 1; br < 3; ++br) for (int hr = 0; hr < 4; ++hr) {
            float mx = -INFINITY, den = 0.f, o = 0.f;
            const int plo = (br == 1) ? 0 : (t - WINB < 0 ? 0 : t - WINB), phi = t;
            for (int p = plo; p <= phi; ++p) {
                if (br == 1 && SELB[p >> 6] == 0.f) { p |= 63; continue; }
                const float* kf = nullptr; const bf16* kb = nullptr; const float* vf = nullptr; const bf16* vb = nullptr;
                const int jk = (br == 1) ? 2 : 4;
                if (!smp) { kb = WSP(bf16, WS_KVB) + ((((size_t)(jk - 2) * PB + seq) * 2 + kvh) * PT + p) * 64; vb = kb + (size_t)PB * 2 * PT * 64; }
                else if (p >= PAST) { kb = WSP(bf16, WS_KVS) + ((((size_t)(jk - 2) * SB + seq) * 2 + kvh) * ST + (p - PAST)) * 64; vb = kb + (size_t)SB * 2 * ST * 64; }
                else if (br == 1) { const int page = ((const int*)F.a->in[I_PT])[seq * NPG + (p >> 7)]; kf = FIN(I_CACHE) + ((((size_t)page * PAGE + (p & 127)) * 4 + 2) * 2 + kvh) * 64; vf = kf + 128; }
                else { kf = FIN(I_CWIN) + ((((size_t)seq * WINB + (p - (PAST - WINB))) * 2 + 0) * 2 + kvh) * 64; vf = kf + 128; }
                float a = 0.f; for (int d = 0; d < 64; ++d) a += Q[hr * 64 + d] * (kb ? bf1(kb[d]) : bfr(kf[d]));
                const float vv = vb ? bf1(vb[lane]) : bfr(vf[lane]);
                const float mn = fmaxf(mx, a), al = exp2f(mx - mn), e = exp2f(a - mn); den = den * al + e; o = o * al + e * vv; mx = mn;
            }
            OUT[(br * 4 + hr) * 64 + lane] = (den > 0.f) ? o / den : 0.f;
        }
        LDS_WAIT(); asm volatile("" ::: "memory");
        bool bad = false;
        for (int hr = 0; hr < 4; ++hr) { const float* ng = WSP(float, WS_NG) + row * 24 + (kvh * 4 + hr) * 3;
            const float e = ng[0] * OUT[(0 * 4 + hr) * 64 + lane] + ng[1] * OUT[(1 * 4 + hr) * 64 + lane] + ng[2] * OUT[(2 * 4 + hr) * 64 + lane];
            bad = bad || dbg_bad(bf1(WSP(bf16, WS_OA)[row * 512 + (kvh * 4 + hr) * 64 + lane]), e, 0.04f, 0.004f); }
        DBG_FLAG(smp ? 5 : 4, bad);
        LDS_WAIT(); asm volatile("" ::: "memory");
    }
    for (int s = gw; s < 96; s += NGW) {
        const unsigned r = dbg_rand(6000u + s); const bool smp = (s % 3) == 2; const int h = (r >> 3) & 3; const float lg = ret_log_g(h);
        const bf16* RQ = WSP(bf16, WS_RQ); const bf16* RK = RQ + (size_t)MT * 512; const bf16* RV = RQ + (size_t)2 * MT * 512; const bf16* RG = RQ + (size_t)3 * MT * 512;
        int seq, t; size_t row0; if (smp) { seq = (r >> 5) % SB; t = (r >> 10) % ST; row0 = (size_t)PM + seq * ST; } else { seq = (r >> 5) % PB; const unsigned k = (r >> 8) % 4u; t = (k == 0) ? (int)((r >> 12) % 300) : (int)((r >> 12) % PT); row0 = (size_t)seq * PT; }
        float o0 = 0.f, o1 = 0.f;
        for (int d = lane; d < 128; d += 64) L[d] = bf1(RQ[(row0 + t) * 512 + h * 128 + d]);
        LDS_WAIT(); asm volatile("" ::: "memory");
        for (int j = 0; j <= t; ++j) { float a = 0.f; for (int d = 0; d < 128; ++d) a += L[d] * bf1(RK[(row0 + j) * 512 + h * 128 + d]);
            a *= expf((float)(t - j) * lg); o0 += a * bf1(RV[(row0 + j) * 512 + h * 128 + lane]); o1 += a * bf1(RV[(row0 + j) * 512 + h * 128 + 64 + lane]); }
        if (smp) { const float* S0 = FIN(I_SRET) + (((size_t)0 * SB + seq) * 4 + h) * 16384; const float cr = expf((float)(t + 1) * lg);
            for (int d = 0; d < 128; ++d) { o0 += L[d] * S0[d * 128 + lane] * cr; o1 += L[d] * S0[d * 128 + 64 + lane] * cr; } }
        const float mean = wave_sum(o0 + o1) * (1.0f / 128.0f); const float var = wave_sum((o0 - mean) * (o0 - mean) + (o1 - mean) * (o1 - mean)) * (1.0f / 128.0f), rstd = 1.0f / sqrtf(var + EPS);
        const float* GN = FIN(I_GNG) + h * 128; const bf16* OR_ = WSP(bf16, WS_OA) + (size_t)MT * 512;
        const float g0 = bf1(RG[(row0 + t) * 512 + h * 128 + lane]), g1 = bf1(RG[(row0 + t) * 512 + h * 128 + 64 + lane]);
        const float e0 = (o0 - mean) * rstd * GN[lane] * (g0 / (1.0f + expf(-g0))), e1 = (o1 - mean) * rstd * GN[64 + lane] * (g1 / (1.0f + expf(-g1)));
        DBG_FLAG(6, dbg_bad(bf1(OR_[(row0 + t) * 512 + h * 128 + lane]), e0, 0.04f, 0.02f) || dbg_bad(bf1(OR_[(row0 + t) * 512 + h * 128 + 64 + lane]), e1, 0.04f, 0.02f));
        const int d = (r >> 20) % 128, T = smp ? ST : PT; float s0 = 0.f, s1 = 0.f;
        for (int j = 0; j < T; ++j) { const float kk = bf1(RK[(row0 + j) * 512 + h * 128 + d]) * expf((float)(T - 1 - j) * lg); s0 += kk * bf1(RV[(row0 + j) * 512 + h * 128 + lane]); s1 += kk * bf1(RV[(row0 + j) * 512 + h * 128 + 64 + lane]); }
        const float* SO;
        if (smp) { const float* S0 = FIN(I_SRET) + (((size_t)0 * SB + seq) * 4 + h) * 16384; const float g8 = expf(8.0f * lg); s0 += g8 * S0[d * 128 + lane]; s1 += g8 * S0[d * 128 + 64 + lane]; SO = F.out + OUT_RET_S + (((size_t)0 * SB + seq) * 4 + h) * 16384; }
        else SO = F.out + OUT_RET_P + (((size_t)0 * PB + seq) * 4 + h) * 16384;
        DBG_FLAG(7, dbg_bad(SO[d * 128 + lane], s0, 0.02f, 0.02f) || dbg_bad(SO[d * 128 + 64 + lane], s1, 0.02f, 0.02f));
        LDS_WAIT(); asm volatile("" ::: "memory");
    }
    for (int s = gw; s < 48; s += NGW) {
        const unsigned r = dbg_rand(8000u + s); const bool smp = (s % 3) == 2; const int blk = (r >> 3) & 7, c = blk * 64 + lane;
        int seq, T; size_t row0; if (smp) { seq = (r >> 6) % SB; T = ST; row0 = (size_t)PM + seq * ST; } else { seq = (r >> 6) % PB; T = 1 + (int)((r >> 10) % ((s & 1) ? 200 : PT)); row0 = (size_t)seq * PT; }
        const float* RX = WSP(float, WS_RX); const float* cw = FIN(I_RCW); const float cb = FIN(I_RCB)[c];
        float x3 = 0.f, x2 = 0.f, x1 = 0.f, h = 0.f;
        if (smp) { const float* cv = FIN(I_SCONV) + (size_t)seq * 3 * 512; x3 = cv[c]; x2 = cv[512 + c]; x1 = cv[1024 + c]; h = FIN(I_SH)[(size_t)seq * 512 + c]; }
        const float sp = log1pf(expf(-FIN(I_LAM)[c])); const float* wa = FIN(I_RWA) + (size_t)blk * 4096; const float* wx = FIN(I_RWX) + (size_t)blk * 4096;
        for (int t = 0; t < T; ++t) { const float x0 = RX[(row0 + t) * 512 + c]; const float xc = cb + cw[c] * x3 + cw[512 + c] * x2 + cw[1024 + c] * x1 + cw[1536 + c] * x0; x3 = x2; x2 = x1; x1 = x0;
            L[lane] = xc; LDS_WAIT(); asm volatile("" ::: "memory");
            float ra = FIN(I_RBA)[c], ri = FIN(I_RBX)[c]; for (int i = 0; i < 64; ++i) { ra += L[i] * wa[i * 64 + lane]; ri += L[i] * wx[i * 64 + lane]; }
            LDS_WAIT(); asm volatile("" ::: "memory");
            const float rr = 1.0f / (1.0f + expf(-ra)), ii = 1.0f / (1.0f + expf(-ri)), la = -8.0f * rr * sp, a = expf(la); h = a * h + sqrtf(-expm1f(2.0f * la)) * (ii * xc); }
        const size_t o = (row0 + T - 1) * 512 + c; const float e = h * bf1(WSP(bf16, WS_GG)[o]);
        DBG_FLAG(8, dbg_bad(bf1((WSP(bf16, WS_OA) + (size_t)2 * MT * 512)[o]), e, 0.04f, 0.01f));
    }
    for (int s = gw; s < 512; s += NGW) {
        const unsigned r = dbg_rand(9000u + s); const int row = dbg_row(r), col = (r >> 7) % DM;
        float e = 0.f;
        for (int br = 0; br < 3; ++br) { const bf16* O = WSP(bf16, WS_OA) + (size_t)br * MT * 512 + (size_t)row * 512; const float* W = FIN(br == 0 ? I_WBRA : (br == 1 ? I_WBRB : I_WBRC));
            float a = 0.f; for (int k = lane; k < 512; k += 64) a += bf1(O[k]) * bfr(W[(size_t)k * DM + col]); a = wave_sum(a); e += bf1(WSP(bf16, WS_MGS)[(size_t)row * 3072 + br * 1024 + col]) * a; }
        DBG_FLAG(20, dbg_bad(bf1(WSP(bf16, WS_MRG)[(size_t)row * DM + col]), e, 0.03f, 0.01f));
        const float* mod = WSP(float, WS_MOD) + (size_t)row_bb(row) * 6144;
        { float a = 0.f; for (int k = lane; k < DM; k += 64) a += bf1(WSP(bf16, WS_MRG)[(size_t)row * DM + k]) * bfr(FIN(I_WOUT)[(size_t)k * DM + col]); a = wave_sum(a);
          const float ex = xrow_in(F, 0, row)[col] + mod[2048 + col] * a; DBG_FLAG(21, dbg_bad(WSP(float, WS_X1)[(size_t)row * DM + col], ex, 0.005f, 0.005f)); }
        { const float* xr = WSP(float, WS_X1) + (size_t)row * DM; float ss = 0.f; for (int d = lane; d < DM; d += 64) ss += xr[d] * xr[d]; const float rs = 1.0f / sqrtf(wave_sum(ss) * (1.0f / DM) + EPS);
          const int c2 = (r >> 9) % NUP; float a = 0.f; for (int d = lane; d < DM; d += 64) a += bfr(xr[d] * rs * FIN(I_N2G)[d] * (1.0f + mod[4096 + d]) + mod[3072 + d]) * bfr(FIN(I_WUP)[(size_t)d * NUP + c2]); a = wave_sum(a);
          const float got = c2 < DFF ? bf1(WSP(bf16, WS_GP)[(size_t)row * DFF + c2]) : bf1((WSP(bf16, WS_GP) + (size_t)MT * DFF)[(size_t)row * DFF + c2 - DFF]); DBG_FLAG(22, dbg_bad(got, a, 0.02f, 0.01f)); }
        { const int c3 = (r >> 11) % DFF; const bf16* GP = WSP(bf16, WS_GP); const bf16* VAL = GP + (size_t)MT * DFF; const float* cw = FIN(I_FCW);
          const bool isp = row < PM; const int t = isp ? (row & (PT - 1)) : ((row - PM) & 7); float xm2, xm1;
          if (t >= 2) { xm2 = bf1(GP[(size_t)(row - 2) * DFF + c3]); xm1 = bf1(GP[(size_t)(row - 1) * DFF + c3]); }
          else if (isp) { xm2 = 0.f; xm1 = (t == 1) ? bf1(GP[(size_t)(row - 1) * DFF + c3]) : 0.f; }
          else { const float* st = FIN(I_SFFN) + ((size_t)((row - PM) >> 3) * 2) * DFF + c3; xm2 = (t == 0) ? st[0] : st[DFF]; xm1 = (t == 0) ? st[DFF] : bf1(GP[(size_t)(row - 1) * DFF + c3]); }
          const float y = FIN(I_FCB)[c3] + cw[c3] * xm2 + cw[DFF + c3] * xm1 + cw[2 * DFF + c3] * bf1(GP[(size_t)row * DFF + c3]); const float ex = (y / (1.0f + expf(-y))) * bf1(VAL[(size_t)row * DFF + c3]);
          DBG_FLAG(23, dbg_bad(bf1((GP + (size_t)2 * MT * DFF)[(size_t)row * DFF + c3]), ex, 0.02f, 0.005f)); }
        { const bf16* ACT = WSP(bf16, WS_GP) + (size_t)2 * MT * DFF + (size_t)row * DFF; float a = 0.f; for (int k = lane; k < DFF; k += 64) a += bf1(ACT[k]) * bfr(FIN(I_WDN)[(size_t)k * DM + col]); a = wave_sum(a);
          const float ex = WSP(float, WS_X1)[(size_t)row * DM + col] + mod[5120 + col] * a; DBG_FLAG(24, dbg_bad(WSP(float, WS_X2)[(size_t)row * DM + col], ex, 0.005f, 0.005f)); }
    }
#undef DBG_FLAG
}
__device__ __forceinline__ void dbg_report_phase(Frame& F) {
    const unsigned* CNT = (const unsigned*)(F.ws + WS_CTL) + 3000;
    const size_t ooff[14] = {OUT_Y, OUT_Y + (size_t)PM * DM, OUT_ROWS_P, OUT_ROWS_S, OUT_WIN_P, OUT_WIN_S, OUT_RET_P, OUT_RET_S, OUT_H_P, OUT_H_S, OUT_CV_P, OUT_CV_S, OUT_FC_P, OUT_FC_S};
    if (F.bid == 0 && F.tid < 14) { const int b = F.tid; const unsigned c = CNT[b]; const int cnt = 1 + (int)(c > 1000u ? 1000u : c);
        for (int i = 0; i < cnt; ++i) ((unsigned*)F.out)[ooff[b] + 7 + 2 * i] = 0xAAAAAAAAu; }
}
#endif

#ifndef DBG_SUB
#define DBG_SUB 0xFFFF
#endif
#ifndef DBG_MAXPH
#define DBG_MAXPH N_PHASES
#endif
#ifndef DBG_REPEAT
#define DBG_REPEAT 0
#endif
#ifndef DBG_MASK
#define DBG_MASK 0xFFFF
#endif
#define IN(k) (lo <= (k) && (k) < hi)
#ifdef DBG_TIME
#define SEAM(k) do { if ((k) + 1 < hi) { if (MK_N_LAUNCHES == 1) xcd_barrier(bar); } if (F.bid == 0 && F.tid == 0) ((unsigned long long*)(F.ws + WS_CTL))[2048 + (k) + 1] = __builtin_amdgcn_s_memrealtime(); } while (0)
#else
#define SEAM(k) do { if ((k) + 1 < hi) { if (MK_N_LAUNCHES == 1) xcd_barrier(bar); } } while (0)
#endif
template <int l> __device__ __forceinline__ void ph_win(Frame& F) { unsigned char* ws = F.ws;
    pg8::Gemm g{(const pg8::bf16_t*)(ws + WS_H), (const pg8::bf16_t*)(ws + WS_WIN) + (size_t)l * NIN * DM, MT, NIN, DM};
    pg8::StaticOrder S; S.init(MT, NIN, F.G, F.bid); EpiWin E{ws, F.out, l};
    pg8::gemm_phase<EpiWin, pg8::StaticOrder, true, true>(F.lds, g, S, E); }
template <int l> __device__ __forceinline__ void ph_mix1(Frame& F) {
    for (int x = F.bid; x < 512; x += F.G) { launder(F); cmp_gemm_unit<true>(F, l, x >> 8, (x & 255) >> 2, (x & 3) * 128); }
    {
        unsigned* ctr = (unsigned*)(F.ws + WS_CTL) + 3210 + l; volatile LAS int* QI = (volatile LAS int*)(F.lds + MISC_OFF + 128);
#pragma unroll 1
        for (;;) {
            __syncthreads();
            if (F.tid == 0) QI[0] = (int)__hip_atomic_fetch_add(ctr, 1u, __ATOMIC_RELAXED, __HIP_MEMORY_SCOPE_AGENT);
            __syncthreads();
            const int u = __builtin_amdgcn_readfirstlane(QI[0]);
            if (u >= 32 + 768) break;
            launder(F);
            if (u < 32) cmp_gemm_unit<false>(F, l, u >> 4, (u >> 1) & 7, (u & 1) * 128); else if (u < 32 + 256) rglru_unit<0>(F, l, u - 32); else ret_local_unit(F, u - 32 - 256);
        }
        __syncthreads();
    } }
template <int l> __device__ __forceinline__ void ph_mix2(Frame& F) { cmp2_phase(F, l); ret_scan_phase(F, l); rglru_carry_phase(F, l); }
#ifndef DBG_REPQ
#define DBG_REPQ 0
#endif
constexpr int MQ_SA = 64, MQ_PA = MQ_SA + 512, MQ_RG1 = MQ_PA + 256, MQ_RO = MQ_RG1 + 512, MQ_RS = MQ_RO + 128, MQ_RG2 = MQ_RS + 32;
template <int l> __device__ __forceinline__ void ph_mix3(Frame& F) {
    unsigned* ctr = (unsigned*)(F.ws + WS_CTL) + 3200 + l;
    volatile LAS int* QI = (volatile LAS int*)(F.lds + MISC_OFF + 128);
#pragma unroll 1
    for (;;) {
        __syncthreads();
        if (F.tid == 0) QI[0] = (int)__hip_atomic_fetch_add(ctr, 1u, __ATOMIC_RELAXED, __HIP_MEMORY_SCOPE_AGENT);
        __syncthreads();
        const int u = __builtin_amdgcn_readfirstlane(QI[0]);
        if (u >= MQ_RG2) break;
        launder(F);
        if (u < MQ_SA) { attn_sample_unit(F, l, u); if (DBG_REPQ & 2) { launder(F); attn_sample_unit(F, l, u); } }
        else if (u < MQ_PA) { const int v = u - MQ_SA; attn_prompt_unit(F, l, (v & 7) * 64 + 63 - (v >> 3)); if (DBG_REPQ & 1) { launder(F); attn_prompt_unit(F, l, (v & 7) * 64 + 63 - (v >> 3)); } }
        else if (u < MQ_RG1) { rglru_unit<1>(F, l, u - MQ_PA); }
        else if (u < MQ_RO) { ret_out_unit(F, l, u - MQ_RG1); }
        else if (u < MQ_RS) { ret_sample_unit(F, l, u - MQ_RO); }
        else { rglru_unit<2>(F, l, u - MQ_RS); }
    }
    __syncthreads(); }
__device__ __forceinline__ f32x16 smp_tile_acc(Frame& F, const bf16* A, const bf16* Wt, int K, int tile) {
    const int q = F.lane & 31, h_ = F.lane >> 5, ks8 = K / 8, kb = F.wave * ks8;
    const bf16* ap = A + (size_t)((tile >> 5) * 32 + q) * K + kb + 8 * h_; const bf16* bp = Wt + (size_t)((tile & 31) * 32 + q) * K + kb + 8 * h_; f32x16 acc = (f32x16){};
#pragma unroll 11
    for (int kk = 0; kk < ks8 / 16; ++kk) acc = mfma32(*(const bf16x8*)(ap + 16 * kk), *(const bf16x8*)(bp + 16 * kk), acc);
    return acc;
}
__device__ __forceinline__ void smp_tile_put(Frame& F, const f32x16& acc, int slot) { LAS float* R = (LAS float*)(F.lds + slot * 32768) + F.wave * 1024 + F.lane;
#pragma unroll
    for (int r = 0; r < 16; ++r) R[r * 64] = acc[r]; }
__device__ __forceinline__ float smp_tile_get(Frame& F, int slot, int o) { const LAS float* R = (const LAS float*)(F.lds + slot * 32768) + o; float s = 0.f;
#pragma unroll
    for (int w = 0; w < 8; ++w) s += R[w * 1024];
    return s; }
template <int l> __device__ __forceinline__ void ph_br(Frame& F) { unsigned char* ws = F.ws;
    const pg8::bf16_t* wbr = (const pg8::bf16_t*)(ws + WS_WBR) + (size_t)l * 3 * 1024 * 512;
    for (int tile = F.bid; tile < 256; tile += F.G) {
        const f32x16 a0 = smp_tile_acc(F, (const bf16*)(ws + WS_OA) + (size_t)PM * 512, wbr, 512, tile), a1 = smp_tile_acc(F, (const bf16*)(ws + WS_OA) + (size_t)(MT + PM) * 512, wbr + (size_t)1024 * 512, 512, tile),
                     a2 = smp_tile_acc(F, (const bf16*)(ws + WS_OA) + (size_t)(2 * MT + PM) * 512, wbr + (size_t)2 * 1024 * 512, 512, tile);
        __syncthreads(); smp_tile_put(F, a0, 0); smp_tile_put(F, a1, 1); smp_tile_put(F, a2, 2); __syncthreads();
        const bf16* MG = (const bf16*)(ws + WS_MGS); bf16* MR = (bf16*)(ws + WS_MRG);
        bf16 gq[2][3];
#pragma unroll
        for (int e = 0; e < 2; ++e) { const int o = F.tid * 2 + e, r = o >> 6, ln = o & 63; const size_t row = (size_t)PM + (tile >> 5) * 32 + (r & 3) + 8 * (r >> 2) + 4 * (ln >> 5); const int col = (tile & 31) * 32 + (ln & 31);
            const bf16* g = MG + row * 3072 + col; gq[e][0] = g[0]; gq[e][1] = g[1024]; gq[e][2] = g[2048]; }
#pragma unroll
        for (int e = 0; e < 2; ++e) { const int o = F.tid * 2 + e, r = o >> 6, ln = o & 63; const size_t row = (size_t)PM + (tile >> 5) * 32 + (r & 3) + 8 * (r >> 2) + 4 * (ln >> 5); const int col = (tile & 31) * 32 + (ln & 31);
            MR[row * DM + col] = (bf16)(pk2(bf1(gq[e][0]) * smp_tile_get(F, 0, o) + bf1(gq[e][1]) * smp_tile_get(F, 1, o) + bf1(gq[e][2]) * smp_tile_get(F, 2, o), 0.f) & 0xffffu); }
    }
    __syncthreads();
    BrOrder S; S.S.init(PM, DM, F.G, F.bid);
    pg8::Gemm g{(const pg8::bf16_t*)(ws + WS_OA), wbr, 3 * MT, 3 * DM, 512}; EpiBrAll E{ws};
    pg8::gemm_phase<EpiBrAll, BrOrder, true, true>(F.lds, g, S, E); }
template <bool INF32> __device__ __forceinline__ void smp_res(Frame& F, const bf16* A, const bf16* Wt, int K, const void* xin  , bf16* xout  , const float* mod, int gofs) {
    for (int tile = F.bid; tile < 256; tile += F.G) {
        const f32x16 a = smp_tile_acc(F, A, Wt, K, tile);
        __syncthreads(); smp_tile_put(F, a, 0); __syncthreads();
        float xi[2], gm[2];
#pragma unroll
        for (int e = 0; e < 2; ++e) { const int o = F.tid * 2 + e, r = o >> 6, ln = o & 63; const int rr = (tile >> 5) * 32 + (r & 3) + 8 * (r >> 2) + 4 * (ln >> 5), col = (tile & 31) * 32 + (ln & 31);
            xi[e] = INF32 ? ((const float*)xin)[(size_t)rr * DM + col] : bf1(((const bf16*)xin)[(size_t)rr * DM + col]); gm[e] = mod[(size_t)(4 + (rr >> 3)) * 6144 + gofs + col]; }
#pragma unroll
        for (int e = 0; e < 2; ++e) { const int o = F.tid * 2 + e, r = o >> 6, ln = o & 63; const int rr = (tile >> 5) * 32 + (r & 3) + 8 * (r >> 2) + 4 * (ln >> 5), col = (tile & 31) * 32 + (ln & 31);
            xout[(size_t)rr * DM + col] = (bf16)(pk2(xi[e] + gm[e] * smp_tile_get(F, 0, o), 0.f) & 0xffffu); }
    }
    __syncthreads();
}
template <int l> __device__ __forceinline__ void ph_out(Frame& F) { unsigned char* ws = F.ws;
    const float* mod = (const float*)(ws + WS_MOD) + (size_t)l * 36 * 6144;
    smp_res<l == 0>(F, (const bf16*)(ws + WS_MRG) + (size_t)PM * DM, (const bf16*)(ws + WS_WOUT) + (size_t)l * DM * DM, DM, l == 0 ? (const void*)FIN(I_XS) : (const void*)((const bf16*)(ws + WS_X2) + (size_t)PM * DM), (bf16*)(ws + WS_X1) + (size_t)PM * DM, mod, 2048);
    pg8::Gemm g{(const pg8::bf16_t*)(ws + WS_MRG), (const pg8::bf16_t*)(ws + WS_WOUT) + (size_t)l * DM * DM, PM, DM, DM};
    pg8::StaticOrder S; S.init(PM, DM, F.G, F.bid);
    EpiRes<l == 0> E{l == 0 ? (const void*)FIN(I_XP) : (const void*)(ws + WS_X2), (bf16*)(ws + WS_X1), mod, 2048};
    pg8::gemm_phase<EpiRes<l == 0>, pg8::StaticOrder, true, true>(F.lds, g, S, E); }
template <int l> __device__ __forceinline__ void ph_down(Frame& F) { unsigned char* ws = F.ws;
    const float* mod = (const float*)(ws + WS_MOD) + (size_t)l * 36 * 6144;
    {
        pg8::StaticOrder S0; S0.init(PM, DM, F.G, F.bid); pg8::Unit u0;
        for (int i = 0; S0.next(i, u0); ++i) if ((u0.pm & 15) != 0) convact_rows(F, l, (size_t)u0.pm * 256, 2, false);
        asm volatile("s_waitcnt vmcnt(0)" ::: "memory"); __syncthreads();
    }
    smp_res<false>(F, (const bf16*)(ws + WS_GP) + (size_t)2 * MT * DFF + (size_t)PM * DFF, (const bf16*)(ws + WS_WDN) + (size_t)l * DM * DFF, DFF, (const void*)((const bf16*)(ws + WS_X1) + (size_t)PM * DM), (bf16*)(ws + WS_X2) + (size_t)PM * DM, mod, 5120);
    pg8::Gemm g{(const pg8::bf16_t*)(ws + WS_GP) + (size_t)2 * MT * DFF, (const pg8::bf16_t*)(ws + WS_WDN) + (size_t)l * DM * DFF, PM, DM, DFF};
    pg8::StaticOrder S; S.init(PM, DM, F.G, F.bid);
    EpiRes<false> E{(const void*)(ws + WS_X1), (bf16*)(ws + WS_X2), mod, 5120};
    pg8::gemm_phase<EpiRes<false>, pg8::StaticOrder, true, true>(F.lds, g, S, E); }
template <int l> __device__ __forceinline__ void ph_up(Frame& F) { unsigned char* ws = F.ws;
    pg8::Gemm g{(const pg8::bf16_t*)(ws + WS_H), (const pg8::bf16_t*)(ws + WS_WUP) + (size_t)l * NUP * DM, MT, NUP, DM};
    UpOrder S; S.S.init(MT, DFF, F.G, F.bid); EpiUp E{ws, F.out, l, FIN(I_FCW) + (size_t)l * 3 * DFF, FIN(I_FCB) + (size_t)l * DFF, (const bf16*)(ws + WS_SFB) + (size_t)l * SB * 2 * DFF};
    pg8::gemm_phase<EpiUp, UpOrder, true, true>(F.lds, g, S, E); }
#ifdef DBG_AMP_BIT
#define AMP_T0(bit) unsigned long long amp_t0_ = 0ull; if ((bit) == DBG_AMP_BIT) amp_t0_ = __builtin_amdgcn_s_memrealtime();
#define AMP_T1(bit) if ((bit) == DBG_AMP_BIT && F.tid == 0) { volatile LAS unsigned* AM = (volatile LAS unsigned*)(F.lds + MISC_OFF + 192); AM[0] += (unsigned)(__builtin_amdgcn_s_memrealtime() - amp_t0_); }
#else
#define AMP_T0(bit)
#define AMP_T1(bit)
#endif
#define RUNPH(bit, ph, CALL) do { if (((DBG_MASK >> (bit)) & 1) && IN(ph)) { AMP_T0(bit) launder(F); CALL; if ((DBG_REPEAT >> (bit)) & 1) { launder(F); CALL; } SEAM(ph); AMP_T1(bit) } } while (0)
template <int l> __device__ __forceinline__ void layer_phases(Frame& F, const XcdBarrier& bar, int lo, int hi) {
    constexpr int pb = PH_L0 + l * PH_PER_LAYER;
    RUNPH(1, pb + LP_N1, norm_phase(F, l, 0));
    RUNPH(2, pb + LP_WIN, ph_win<l>(F));
    RUNPH(3, pb + LP_MIX1, ph_mix1<l>(F));
    RUNPH(4, pb + LP_MIX2, ph_mix2<l>(F));
    RUNPH(5, pb + LP_MIX3, ph_mix3<l>(F));
    RUNPH(6, pb + LP_BR, ph_br<l>(F));
    RUNPH(7, pb + LP_OUT, ph_out<l>(F));
    RUNPH(8, pb + LP_N2, norm_phase(F, l, 1));
    RUNPH(9, pb + LP_UP, ph_up<l>(F));
    RUNPH(11, pb + LP_DOWN, ph_down<l>(F));
}
__global__ void __launch_bounds__(NTHR, 2) trunk_fwd(Args args) {
    extern __shared__ __attribute__((aligned(16))) unsigned char lds_raw[];
    Frame F;
    F.lds = (LAS unsigned char*)lds_raw;
    F.tid = threadIdx.x; F.lane = F.tid & 63; F.wave = __builtin_amdgcn_readfirstlane(F.tid >> 6);
    F.G = gridDim.x; F.bid = blockIdx.x; F.a = &args; F.ws = args.ws; F.out = args.out;
    volatile LAS unsigned* MISC = (volatile LAS unsigned*)(F.lds + MISC_OFF);
    for (int u = F.tid; u < 64; u += NTHR) MISC[u] = 0u;
    __syncthreads();
    unsigned* barw = (unsigned*)(F.ws + WS_CTL) + CW_BAR;
    XcdBarrier bar; bar.bar = barw; bar.x = 0; bar.st = nullptr;
    if (MK_N_LAUNCHES == 1) bar = xcd_barrier_post(barw, MISC + 8);
    const int lo = args.ph_lo, hi = args.ph_hi;
    unsigned char* ws = F.ws;

#ifdef DBG_TIME
    if (F.bid == 0 && F.tid == 0) ((unsigned long long*)(F.ws + WS_CTL))[2048] = __builtin_amdgcn_s_memrealtime();
#endif
    RUNPH(0, PH_P0, p0_prologue(F));

    layer_phases<0>(F, bar, lo, hi);
    layer_phases<1>(F, bar, lo, hi);
    if (((DBG_MASK >> 12) & 1) && IN(PH_FINAL)) { launder(F); final_phase(F); if ((DBG_REPEAT >> 12) & 1) { launder(F); final_phase(F); } }
#ifdef DBG_AMP_BIT
    if (F.tid == 0) { volatile LAS unsigned* AM = (volatile LAS unsigned*)(F.lds + MISC_OFF + 192); const unsigned long long tot = (unsigned long long)AM[0] * DBG_AMP, ts = __builtin_amdgcn_s_memrealtime();
        while (__builtin_amdgcn_s_memrealtime() - ts < tot) __builtin_amdgcn_s_sleep(8); }
    __syncthreads();
#endif
#ifdef DBG_TIME
    {
        xcd_barrier(bar);
        if (F.bid == 0 && F.tid < 14) {
            const unsigned long long* ts = (const unsigned long long*)(F.ws + WS_CTL) + 2048; const unsigned long long tend = __builtin_amdgcn_s_memrealtime();
            const size_t ooff[14] = {OUT_Y, OUT_Y + (size_t)PM * DM, OUT_ROWS_P, OUT_ROWS_S, OUT_WIN_P, OUT_WIN_S, OUT_RET_P, OUT_RET_S, OUT_H_P, OUT_H_S, OUT_CV_P, OUT_CV_S, OUT_FC_P, OUT_FC_S};
            const int b = F.tid; unsigned long long d;
            if (b == 0) d = tend - ts[0]; else if (b == 1) d = ts[1] - ts[0]; else if (b == 13) d = tend - ts[PH_FINAL];
            else { const int ph = PH_L0 + DBG_TIME_LAYER * PH_PER_LAYER + (b - 2); d = ts[ph + 1] - ts[ph]; }
            int cnt = (int)(d / 100ull); if (cnt < 1) cnt = 1; if (cnt > 2000 && b != 0) cnt = 2000;
            for (int i = 0; i < cnt; ++i) ((unsigned*)F.out)[ooff[b] + 7 + 2 * i] = 0xAAAAAAAAu;
        }
    }
#endif
#ifdef DBG_COUNT
    {
        xcd_barrier(bar);
        if (F.bid == 0 && F.tid < 3) { const unsigned* CNT = (const unsigned*)(F.ws + WS_CTL) + 3000; const size_t ooff[3] = {OUT_Y, OUT_Y + (size_t)PM * DM, OUT_ROWS_P};
            const int cnt = (int)((unsigned long long)CNT[F.tid] * 10ull / (CNT[3] ? CNT[3] : 1u)); for (int i = 0; i < cnt; ++i) ((unsigned*)F.out)[ooff[F.tid] + 7 + 2 * i] = 0xAAAAAAAAu; }
    }
#endif
#ifdef DBG_CHECK
    if (lo == 100) { launder(F); dbg_check_phase(F); }
    if (lo == 101) { for (size_t i = (size_t)F.bid * NTHR + F.tid; i < OUT_END; i += (size_t)F.G * NTHR) F.out[i] = 0.f; }
    if (lo == 102) { launder(F); dbg_report_phase(F); }
#endif
}

extern "C" void kernel_launch(void* const* d_in, const int* in_sizes, int n_in, void* d_out, int out_size, void* d_ws, size_t ws_size, hipStream_t stream) {
    static int grid = 0;
    if (grid == 0) {
        if (n_in != 37 || (size_t)out_size != OUT_END || ws_size < WS_END) { fprintf(stderr, "kernel_launch: unexpected shapes: n_in %d out %d (want %zu) ws %zu (want %zu)\n", n_in, out_size, (size_t)OUT_END, ws_size, (size_t)WS_END); grid = -1; return; }
        int dev = 0, cus = 0, per_cu = 0;
        if (hipGetDevice(&dev) != hipSuccess || hipDeviceGetAttribute(&cus, hipDeviceAttributeMultiprocessorCount, dev) != hipSuccess) { grid = -1; return; }
        if (hipFuncSetAttribute((const void*)trunk_fwd, hipFuncAttributeMaxDynamicSharedMemorySize, LDS_BYTES) != hipSuccess) { fprintf(stderr, "kernel_launch: hipFuncSetAttribute failed\n"); grid = -1; return; }
        if (hipOccupancyMaxActiveBlocksPerMultiprocessor(&per_cu, (const void*)trunk_fwd, NTHR, LDS_BYTES) != hipSuccess || per_cu < 1) fprintf(stderr, "kernel_launch: occupancy query reports %d\n", per_cu);
        (void)hipGetLastError();
        grid = cus;
    }
    if (grid < 0) return;
    if (hipMemsetAsync((char*)d_ws + WS_CTL, 0, CTL_ZERO_BYTES, stream) != hipSuccess) return;
#ifdef DBG_POISON
    (void)hipMemsetAsync((char*)d_ws + CTL_ZERO_BYTES, 0xAA, WS_END - CTL_ZERO_BYTES, stream);
    (void)hipMemsetAsync(d_out, 0xAA, (size_t)OUT_END * 4, stream);
#endif
    Args a{};
    for (int i = 0; i < 37; ++i) a.in[i] = d_in[i];
    a.out = (float*)d_out; a.ws = (unsigned char*)d_ws;
#if MK_N_LAUNCHES == 1
    a.ph_lo = 0; a.ph_hi = N_PHASES;
    hipLaunchKernelGGL(trunk_fwd, dim3(grid), dim3(NTHR), LDS_BYTES, stream, a);
#else
    for (int p = 0; p < DBG_MAXPH; ++p) { a.ph_lo = p; a.ph_hi = p + 1; hipLaunchKernelGGL(trunk_fwd, dim3(grid), dim3(NTHR), LDS_BYTES, stream, a); }
#ifdef DBG_CHECK
    for (int p = 100; p < 103; ++p) { a.ph_lo = p; a.ph_hi = p + 1; hipLaunchKernelGGL(trunk_fwd, dim3(grid), dim3(NTHR), LDS_BYTES, stream, a); }
#endif
#endif
    (void)in_sizes;
}
```

```cpp
#include <hip/hip_runtime.h>
#include <cstdio>
#include <cstdint>

#ifndef MK_N_LAUNCHES
#define MK_N_LAUNCHES 1
#endif

constexpr int DM = 1024, PB = 4, PT = 4096, PM = PB * PT, SB = 32, ST = 8, SM = SB * ST, MT = PM + SM;
constexpr int DEPTH = 2, PAST = 8192, PAGE = 128, NPG = PAST / PAGE, NPHYS = 2560;
constexpr int D_IN = 7448, NIN = 7680, DFF = 2816, NUP = 2 * DFF;
constexpr int WINB = 512;
constexpr float EPS = 1e-6f;
constexpr float QSCALE = 0.125f * 1.4426950408889634f;

constexpr int O_NQ = 0, O_NKV = 512, O_NG = 1280, O_RQ = 1304, O_RK = 1816, O_RV = 2328, O_RG = 2840, O_RX = 3352, O_RGATE = 3864, O_MG = 4376;

constexpr size_t OUT_Y = 0;
constexpr size_t OUT_ROWS_P = OUT_Y + (size_t)MT * DM;
constexpr size_t OUT_ROWS_S = OUT_ROWS_P + (size_t)DEPTH * PM * 512;
constexpr size_t OUT_WIN_P = OUT_ROWS_S + (size_t)DEPTH * SM * 512;
constexpr size_t OUT_WIN_S = OUT_WIN_P + (size_t)DEPTH * PB * WINB * 256;
constexpr size_t OUT_RET_P = OUT_WIN_S + (size_t)DEPTH * SB * WINB * 256;
constexpr size_t OUT_RET_S = OUT_RET_P + (size_t)DEPTH * PB * 4 * 16384;
constexpr size_t OUT_H_P = OUT_RET_S + (size_t)DEPTH * SB * 4 * 16384;
constexpr size_t OUT_H_S = OUT_H_P + (size_t)DEPTH * PB * 512;
constexpr size_t OUT_CV_P = OUT_H_S + (size_t)DEPTH * SB * 512;
constexpr size_t OUT_CV_S = OUT_CV_P + (size_t)DEPTH * PB * 3 * 512;
constexpr size_t OUT_FC_P = OUT_CV_S + (size_t)DEPTH * SB * 3 * 512;
constexpr size_t OUT_FC_S = OUT_FC_P + (size_t)DEPTH * PB * 2 * DFF;
constexpr size_t OUT_END = OUT_FC_S + (size_t)DEPTH * SB * 2 * DFF;

constexpr size_t MiB = 1u << 20;
constexpr size_t WS_CTL = 0, CTL_ZERO_BYTES = 4 * MiB;
constexpr size_t WS_MOD = 1 * MiB;
constexpr size_t WS_ROT = 4 * MiB;
constexpr size_t WS_SMALLW = 8 * MiB;
constexpr size_t WS_SFB = 12 * MiB;
constexpr size_t WS_WIN = 16 * MiB;
constexpr size_t WS_WBR = WS_WIN + (size_t)2 * NIN * DM * 2;
constexpr size_t WS_WOUT = WS_WBR + (size_t)2 * 3 * 1024 * 512 * 2;
constexpr size_t WS_WUP = WS_WOUT + (size_t)2 * 1024 * 1024 * 2;
constexpr size_t WS_WDN = WS_WUP + (size_t)2 * NUP * DM * 2;
constexpr size_t WS_WEND = WS_WDN + (size_t)2 * DM * DFF * 2;
constexpr size_t WS_H = 128 * MiB;
constexpr size_t WS_QN = WS_H + (size_t)MT * DM * 2;
constexpr size_t WS_KVB = WS_QN + (size_t)MT * 512 * 2;
constexpr size_t WS_KVS = WS_KVB + (size_t)4 * PB * 2 * PT * 64 * 2;
constexpr size_t WS_RQ = WS_KVS + (size_t)4 * SB * 2 * ST * 64 * 2;
constexpr size_t WS_RX = WS_RQ + (size_t)4 * MT * 512 * 2;
constexpr size_t WS_GG = WS_RX + (size_t)MT * 512 * 4;
constexpr size_t WS_MGS = WS_GG + (size_t)MT * 512 * 2;
constexpr size_t WS_NG = WS_MGS + (size_t)MT * 3072 * 2;
constexpr size_t WS_OA = WS_NG + (size_t)MT * 24 * 4;
constexpr size_t WS_MRG = WS_OA + (size_t)3 * MT * 512 * 2;
constexpr size_t WS_X1 = WS_MRG + (size_t)MT * DM * 2;
constexpr size_t WS_X2 = WS_X1 + (size_t)MT * DM * 4;
constexpr size_t WS_GP = WS_X2 + (size_t)MT * DM * 4;
constexpr size_t WS_ACMP = WS_GP + (size_t)3 * MT * DFF * 2;
constexpr int CMP_ROWS_J = 34816, CMP_ROWS = 2 * CMP_ROWS_J;
constexpr size_t WS_LH = WS_ACMP + (size_t)2 * CMP_ROWS * 1024 * 2 + 4096;
constexpr size_t WS_CK = WS_LH + (size_t)(CMP_ROWS + 16) * 256 * 2;
constexpr size_t WS_LT = WS_CK + (size_t)CMP_ROWS * 64 * 2;
constexpr size_t WS_SPT = WS_LT + (size_t)16 * 32 * 16384 * 4;
constexpr size_t WS_CAR = WS_SPT + (size_t)16 * 32 * 16384 * 2;
constexpr size_t WS_OAG = WS_CAR + (size_t)4 * 64 * 3 * 512 * 4 + MiB;
constexpr size_t WS_END = WS_OAG + (size_t)2048 * 32 * 64 * 4 + MiB;
static_assert(WS_WEND <= WS_H, "weights fit below WS_H");

constexpr size_t SW_W1T = 0;
constexpr size_t SW_W2T = SW_W1T + (size_t)2 * 2 * 256 * 1024 * 2;
constexpr size_t SW_CB = SW_W2T + (size_t)2 * 2 * 64 * 128 * 2;
constexpr size_t SW_WAT = SW_CB + (size_t)2 * 2 * 128 * 4;
constexpr size_t SW_SP = SW_WAT + (size_t)2 * 2 * 8 * 64 * 64 * 2;
constexpr size_t SW_END = SW_SP + 2 * 512 * 4;
static_assert(SW_END <= 8 * MiB, "small weights fit");

constexpr int CW_TMO = 0;
constexpr int CW_BAR = 4096;

constexpr int PH_P0 = 0, PH_L0 = 1, PH_PER_LAYER = 11, PH_FINAL = PH_L0 + DEPTH * PH_PER_LAYER, N_PHASES = PH_FINAL + 1;
enum { LP_N1 = 0, LP_WIN, LP_MIX1, LP_MIX2, LP_MIX3, LP_BR, LP_OUT, LP_N2, LP_UP, LP_CONV, LP_DOWN };

constexpr int RING_BYTES = 131072;
constexpr int MISC_OFF = RING_BYTES;
constexpr int LDS_BYTES = RING_BYTES + 1024;
constexpr int NWAVES = 8, NTHR = 512;

#define GAS __attribute__((address_space(1)))
#define LAS __attribute__((address_space(3)))
typedef unsigned short bf16;
typedef unsigned v4u __attribute__((ext_vector_type(4)));
typedef unsigned v2u __attribute__((ext_vector_type(2)));
typedef float f32x16 __attribute__((ext_vector_type(16)));
typedef short s16x4 __attribute__((ext_vector_type(4)));
namespace pg8 {
#define PG8_LAS __attribute__((address_space(3)))
typedef unsigned short bf16_t;
typedef short bf16x8 __attribute__((ext_vector_type(8)));
typedef float f32x4 __attribute__((ext_vector_type(4)));
typedef unsigned u32x4 __attribute__((ext_vector_type(4)));
constexpr int BM = 256, BK = 64, HALF = 128, HTB = HALF * BK * 2  , STAGE_BYTES = 8 * HTB, NXCD = 8, WGM = 8;

__host__ __device__ __forceinline__ int lds_byte(int r, int c) { const int st = (r >> 4) * 2 + (c >> 5), rr = r & 15, cc = c & 31, ob = rr * 64 + cc * 2; return st * 1024 + (ob ^ (((ob >> 9) & 1) << 5)); }
__host__ __device__ __forceinline__ void stage_rc(int b, int& R, int& C) { const int st = b / 1024, sb = b % 1024, swz = sb ^ (((sb >> 9) & 1) << 5); R = (st >> 1) * 16 + swz / 64; C = (st & 1) * 32 + (swz % 64) / 2; }
__host__ __device__ __forceinline__ int perm32(int rho) { const int n = rho >> 4, i = rho & 15; return 8 * (i >> 2) + 4 * n + (i & 3); }

struct Unit { int pm, pn; };
struct Gemm { const bf16_t* A; const bf16_t* Bt; int M, N, K; };

struct StaticOrder {
    int nM, nN, nwg, G, c;
    __host__ __device__ void init(int M, int N, int G_, int c_) { nM = M / BM; nN = N / BM; nwg = nM * nN; G = G_; c = c_; }
    __host__ __device__ bool next(int i, Unit& u) const {
        const long L = (long)i * G + c; if (L >= nwg) return false;
        int wgid = (int)L; { const int q = nwg / NXCD, r = nwg % NXCD, xcd = wgid % NXCD, off = wgid / NXCD; wgid = (xcd < r ? xcd * (q + 1) : r * (q + 1) + (xcd - r) * q) + off; }
        const int nig = WGM * nN, gid = wgid / nig, fm = gid * WGM, gsz = (nM - fm) < WGM ? (nM - fm) : WGM;
        u.pm = fm + ((wgid % nig) % gsz); u.pn = (wgid % nig) / gsz; return true;
    }
    __device__ __forceinline__ void a_ready(const Unit&) const {}
    __device__ __forceinline__ void done(const Unit&) const {}
};
__device__ __forceinline__ unsigned cvt_pk_bf16(float lo, float hi) { unsigned r; asm volatile("v_cvt_pk_bf16_f32 %0, %1, %2" : "=v"(r) : "v"(lo), "v"(hi)); return r; }
typedef float f32x2 __attribute__((ext_vector_type(2)));
template <class Epi, class Sched, bool ALIGN_EPI = false, bool SP2 = false>
__device__ __forceinline__ void gemm_phase(PG8_LAS unsigned char* lds, const Gemm g, const Sched& S, const Epi& E) {
    const int tid = threadIdx.x, wid = __builtin_amdgcn_readfirstlane(tid >> 6), lane = tid & 63, wr = wid >> 2, wc = wid & 3, fr = lane & 15, fq = lane >> 4;
    const int K = g.K, nt = K / BK;
    unsigned voffA[2], voffB[2];
#pragma unroll
    for (int i = 0; i < 2; ++i) { int R, C; stage_rc(tid * 16 + i * 8192, R, C); const int Rb = Epi::PERM ? ((R & ~31) + perm32(R & 31)) : R;
        voffA[i] = (unsigned)(R * K + C) * 2u; voffB[i] = (unsigned)(Rb * K + C) * 2u; }
    const size_t kstep = (size_t)(BK * 2);
    const size_t hstep = (size_t)HALF * K * 2;
    const size_t tstep = 2 * hstep;
    const unsigned ldsw = (unsigned)wid * 1024u;
    const int aoff = lds_byte(wr * 64 + fr, fq * 8), boff = lds_byte(wc * 32 + fr, fq * 8);
#define PG8_SA(b, h) (((b) * 2 + (h)) * HTB)
#define PG8_SB(b, h) ((4 + (b) * 2 + (h)) * HTB)
#define PG8_STAGE(bufoff, gbase, voff) do { _Pragma("unroll") for (int _i = 0; _i < 2; ++_i) \
        __builtin_amdgcn_global_load_lds((const unsigned*)((const char*)(gbase) + (voff)[_i]), (PG8_LAS unsigned*)(lds + (bufoff) + ldsw + _i * 8192), 16, 0, 0); } while (0)
#define PG8_LDA(dst, b, h) do { _Pragma("unroll") for (int m = 0; m < 4; ++m) _Pragma("unroll") for (int k = 0; k < 2; ++k) dst[m][k] = *(const PG8_LAS bf16x8*)(lds + PG8_SA(b, h) + aoff + m * 2048 + k * 1024); } while (0)
#define PG8_LDB(dst, b, h) do { _Pragma("unroll") for (int n = 0; n < 2; ++n) _Pragma("unroll") for (int k = 0; k < 2; ++k) dst[n][k] = *(const PG8_LAS bf16x8*)(lds + PG8_SB(b, h) + boff + n * 2048 + k * 1024); } while (0)
#define PG8_MMA(ai, bj, At, Bt) do { __builtin_amdgcn_s_setprio(1); _Pragma("unroll") for (int m = 0; m < 4; ++m) _Pragma("unroll") for (int n = 0; n < 2; ++n) _Pragma("unroll") for (int k = 0; k < 2; ++k) \
        acc[ai][bj][m][n] = __builtin_amdgcn_mfma_f32_16x16x32_bf16(Bt[n][k], At[m][k], acc[ai][bj][m][n], 0, 0, 0); __builtin_amdgcn_s_setprio(0); } while (0)
#define PG8_WAIT_V(n) asm volatile("s_waitcnt vmcnt(" #n ")" ::: "memory")
#define PG8_WAIT_L(n) asm volatile("s_waitcnt lgkmcnt(" #n ")" ::: "memory")
#define PG8_BAR __builtin_amdgcn_s_barrier()
#define PG8_SCHED __builtin_amdgcn_sched_barrier(0)
    Unit cur, nxt; int ui = 0;
    if (!S.next(0, cur)) return;
    f32x4 acc[2][2][4][2];
#pragma unroll
    for (int a = 0; a < 2; ++a)
#pragma unroll
        for (int b = 0; b < 2; ++b)
#pragma unroll
            for (int m = 0; m < 4; ++m)
#pragma unroll
                for (int n = 0; n < 2; ++n) acc[a][b][m][n] = (f32x4){0.f, 0.f, 0.f, 0.f};
    bf16x8 At[4][2], B0[2][2], B1[2][2];
    const char* cA = (const char*)g.A + (size_t)cur.pm * tstep; const char* cB = (const char*)g.Bt + (size_t)cur.pn * tstep;
    S.a_ready(cur);
    if constexpr (SP2) {
        PG8_STAGE(PG8_SB(0, 0), cB, voffB); PG8_STAGE(PG8_SB(0, 1), cB + hstep, voffB); PG8_STAGE(PG8_SA(0, 0), cA, voffA); PG8_STAGE(PG8_SA(0, 1), cA + hstep, voffA);
        if (wr == 1) PG8_BAR;
        PG8_WAIT_V(2); PG8_BAR;
        PG8_STAGE(PG8_SB(1, 0), cB + kstep, voffB); PG8_STAGE(PG8_SA(1, 0), cA + kstep, voffA); PG8_STAGE(PG8_SB(1, 1), cB + hstep + kstep, voffB);
        PG8_WAIT_V(6); PG8_BAR;
    } else {
        PG8_STAGE(PG8_SB(0, 0), cB, voffB); PG8_STAGE(PG8_SA(0, 0), cA, voffA); PG8_STAGE(PG8_SB(0, 1), cB + hstep, voffB); PG8_STAGE(PG8_SA(0, 1), cA + hstep, voffA);
        if (wr == 1) PG8_BAR;
        PG8_WAIT_V(4); PG8_BAR;
        PG8_STAGE(PG8_SB(1, 0), cB + kstep, voffB); PG8_STAGE(PG8_SA(1, 0), cA + kstep, voffA); PG8_STAGE(PG8_SB(1, 1), cB + hstep + kstep, voffB);
        PG8_WAIT_V(6); PG8_BAR;
    }
    for (;;) {
        const bool has_next = S.next(ui + 1, nxt);
        const char* nA = has_next ? (const char*)g.A + (size_t)nxt.pm * tstep : cA; const char* nB = has_next ? (const char*)g.Bt + (size_t)nxt.pn * tstep : cB;
        for (int t = 0; t < nt; t += 2) {
            const bool last = (t == nt - 2);
            const char* a1 = cA + (size_t)(t + 1) * kstep;
            const char* a2 = last ? nA : cA + (size_t)(t + 2) * kstep; const char* b2 = last ? nB : cB + (size_t)(t + 2) * kstep;
            const char* a3 = a2 + kstep; const char* b3 = b2 + kstep;
            if (last && has_next) S.a_ready(nxt);
            if constexpr (SP2) {
            PG8_LDB(B0, 0, 0); PG8_LDB(B1, 0, 1); PG8_SCHED; PG8_LDA(At, 0, 0); PG8_STAGE(PG8_SA(1, 1), a1 + hstep, voffA);
            PG8_WAIT_V(8); PG8_WAIT_L(0); PG8_BAR; PG8_MMA(0, 0, At, B0); PG8_MMA(0, 1, At, B1); PG8_BAR; PG8_SCHED;
            PG8_LDA(At, 0, 1); PG8_STAGE(PG8_SB(0, 0), b2, voffB); PG8_STAGE(PG8_SB(0, 1), b2 + hstep, voffB); PG8_STAGE(PG8_SA(0, 0), a2, voffA);
            PG8_WAIT_V(8); PG8_WAIT_L(0); PG8_BAR; PG8_MMA(1, 0, At, B0); PG8_MMA(1, 1, At, B1); PG8_BAR; PG8_SCHED;
            PG8_LDB(B0, 1, 0); PG8_LDB(B1, 1, 1); PG8_SCHED; PG8_LDA(At, 1, 0); PG8_STAGE(PG8_SA(0, 1), a2 + hstep, voffA);
            PG8_WAIT_V(8); PG8_WAIT_L(0); PG8_BAR; PG8_MMA(0, 0, At, B0); PG8_MMA(0, 1, At, B1); PG8_BAR; PG8_SCHED;
            PG8_LDA(At, 1, 1); PG8_STAGE(PG8_SB(1, 0), b3, voffB); PG8_STAGE(PG8_SB(1, 1), b3 + hstep, voffB); PG8_STAGE(PG8_SA(1, 0), a3, voffA);
            PG8_WAIT_V(8); PG8_WAIT_L(0); PG8_BAR; PG8_MMA(1, 0, At, B0); PG8_MMA(1, 1, At, B1); PG8_BAR; PG8_SCHED;
            } else {
            PG8_LDB(B0, 0, 0); PG8_SCHED; PG8_LDA(At, 0, 0); PG8_STAGE(PG8_SA(1, 1), a1 + hstep, voffA);
            PG8_WAIT_L(8); PG8_BAR; PG8_WAIT_L(0); PG8_MMA(0, 0, At, B0); PG8_BAR; PG8_SCHED;
            PG8_LDB(B1, 0, 1); PG8_STAGE(PG8_SB(0, 0), b2, voffB);
            PG8_BAR; PG8_WAIT_L(0); PG8_MMA(0, 1, At, B1); PG8_BAR;
            PG8_LDA(At, 0, 1); PG8_STAGE(PG8_SA(0, 0), a2, voffA);
            PG8_BAR; PG8_WAIT_L(0); PG8_MMA(1, 0, At, B0); PG8_BAR; PG8_SCHED;
            PG8_STAGE(PG8_SB(0, 1), b2 + hstep, voffB);
            PG8_WAIT_V(6); PG8_BAR; PG8_MMA(1, 1, At, B1); PG8_BAR;
            PG8_LDB(B0, 1, 0); PG8_SCHED; PG8_LDA(At, 1, 0); PG8_STAGE(PG8_SA(0, 1), a2 + hstep, voffA);
            PG8_WAIT_L(8); PG8_BAR; PG8_WAIT_L(0); PG8_MMA(0, 0, At, B0); PG8_BAR; PG8_SCHED;
            PG8_LDB(B1, 1, 1); PG8_STAGE(PG8_SB(1, 0), b3, voffB);
            PG8_BAR; PG8_WAIT_L(0); PG8_MMA(0, 1, At, B1); PG8_BAR;
            PG8_LDA(At, 1, 1); PG8_STAGE(PG8_SA(1, 0), a3, voffA);
            PG8_BAR; PG8_WAIT_L(0); PG8_MMA(1, 0, At, B0); PG8_BAR; PG8_SCHED;
            PG8_STAGE(PG8_SB(1, 1), b3 + hstep, voffB);
            PG8_WAIT_V(6); PG8_BAR; PG8_MMA(1, 1, At, B1); PG8_BAR;
            }
        }
        if constexpr (ALIGN_EPI) { if (wr == 0) PG8_BAR; }
        if constexpr (!Epi::AFTER_DRAIN) { E(acc, cur, wr, wc, fr, fq); S.done(cur); }
        if (!has_next) break;
#pragma unroll
        for (int a = 0; a < 2; ++a)
#pragma unroll
            for (int b = 0; b < 2; ++b)
#pragma unroll
                for (int m = 0; m < 4; ++m)
#pragma unroll
                    for (int n = 0; n < 2; ++n) acc[a][b][m][n] = (f32x4){0.f, 0.f, 0.f, 0.f};
        cur = nxt; cA = nA; cB = nB; ++ui;
        if constexpr (ALIGN_EPI) { if (wr == 1) PG8_BAR; }
    }
    PG8_WAIT_V(0);
    if constexpr (!ALIGN_EPI) { if (wr == 0) PG8_BAR; }
    PG8_BAR;
    if constexpr (Epi::AFTER_DRAIN) { E.fused(acc, cur, wr, wc, fr, fq, lds, wid, lane); S.done(cur); }
#undef PG8_SA
#undef PG8_SB
#undef PG8_STAGE
#undef PG8_LDA
#undef PG8_LDB
#undef PG8_MMA
#undef PG8_WAIT_V
#undef PG8_WAIT_L
#undef PG8_BAR
#undef PG8_SCHED
}
}

using pg8::bf16x8; using pg8::f32x4; using pg8::u32x4;
#define LDS_WAIT() asm volatile("s_waitcnt lgkmcnt(0)" ::: "memory")
#define VM_WAIT() asm volatile("s_waitcnt vmcnt(0)" ::: "memory")
typedef float f32x2_t __attribute__((ext_vector_type(2))); typedef __bf16 bf16x2_t __attribute__((ext_vector_type(2)));
__device__ __forceinline__ unsigned pk2(float lo, float hi) { f32x2_t v = {lo, hi}; bf16x2_t b = __builtin_convertvector(v, bf16x2_t); return __builtin_bit_cast(unsigned, b); }
__device__ __forceinline__ float bf_lo(unsigned w) { return __uint_as_float(w << 16); }
__device__ __forceinline__ float bf_hi(unsigned w) { return __uint_as_float(w & 0xffff0000u); }
__device__ __forceinline__ float bf1(bf16 b) { return __uint_as_float(((unsigned)b) << 16); }
__device__ __forceinline__ float fexp2(float x) { return __builtin_amdgcn_exp2f(x); }
__device__ __forceinline__ float fexp(float x) { return __builtin_amdgcn_exp2f(x * 1.4426950408889634f); }
__device__ __forceinline__ float frcp(float x) { return __builtin_amdgcn_rcpf(x); }
__device__ __forceinline__ float sigmoidf_(float x) { return frcp(1.0f + fexp(-x)); }
__device__ __forceinline__ float siluf_(float x) { return x * sigmoidf_(x); }
__device__ __forceinline__ float gelu_tanh(float x) {
    const float u = 0.7978845608028654f * (x + 0.044715f * x * x * x);
    const float e = fexp(2.0f * u);
    const float t = 1.0f - 2.0f * frcp(e + 1.0f);
    return 0.5f * x * (1.0f + t);
}
__device__ __forceinline__ float wave_sum(float v) {
#pragma unroll
    for (int o = 1; o < 64; o <<= 1) v += __shfl_xor(v, o);
    return v;
}
__device__ __forceinline__ v4u pack8(const f32x4 a, const f32x4 b) { v4u w; w.x = pk2(a[0], a[1]); w.y = pk2(a[2], a[3]); w.z = pk2(b[0], b[1]); w.w = pk2(b[2], b[3]); return w; }
__device__ __forceinline__ void unpack8(const v4u w, f32x4& a, f32x4& b) { a = (f32x4){bf_lo(w.x), bf_hi(w.x), bf_lo(w.y), bf_hi(w.y)}; b = (f32x4){bf_lo(w.z), bf_hi(w.z), bf_lo(w.w), bf_hi(w.w)}; }

#define XB_TMO      128
#define XB_XCNT(j)  (256  + 64 * (j))
#define XB_XSUB(j)  (1280 + 64 * (j))
#define XB_XGEN(j)  (2304 + 64 * (j))
#define XB_TOP      3328
#define XB_TOPGEN   3392
#define XCD_BAR_WORDS 3456
#define XB_SPIN_CAP (1u << 18)

__device__ __forceinline__ unsigned xb_ld(unsigned* p)              { return __hip_atomic_load(p, __ATOMIC_RELAXED, __HIP_MEMORY_SCOPE_AGENT); }
__device__ __forceinline__ unsigned xb_add(unsigned* p, unsigned v) { return __hip_atomic_fetch_add(p, v, __ATOMIC_RELAXED, __HIP_MEMORY_SCOPE_AGENT); }
__device__ __forceinline__ unsigned xb_xcc_id() { return (unsigned)__builtin_amdgcn_s_getreg((3 << 11) | 20) & 0xFu; }
#define XB_SPIN(cond, bar) do { unsigned _sp = 0; while (cond) { __builtin_amdgcn_s_sleep(1); \
    if ((++_sp & 255u) == 0u) { if (xb_ld(&(bar)[XB_TMO])) break; if (_sp > XB_SPIN_CAP) { atomicAdd(&(bar)[XB_TMO], 1u); break; } } } } while (0)

struct XcdBarrier {
    unsigned* bar; unsigned x;
    volatile LAS unsigned* st;
};

__device__ __forceinline__ XcdBarrier xcd_barrier_post(unsigned* bar, volatile LAS unsigned* st) {
    XcdBarrier b; b.bar = bar; b.x = xb_xcc_id(); b.st = st;
    if (threadIdx.x == 0) (void)xb_add(&bar[XB_XCNT(b.x)], 1u);
    return b;
}
__device__ __forceinline__ void xcd_barrier_complete(unsigned* bar, unsigned x, unsigned& nloc, unsigned& nx) {
    const unsigned G = gridDim.x * gridDim.y * gridDim.z;
    unsigned sum, cnt, mine, sp = 0u;
    for (;;) {
        sum = 0u; cnt = 0u; mine = 0u;
#pragma unroll
        for (unsigned j = 0; j < 16; ++j) { const unsigned c = xb_ld(&bar[XB_XCNT(j)]); sum += c; cnt += (c > 0u) ? 1u : 0u; mine = (j == x) ? c : mine; }
        if (sum == G) break;
        __builtin_amdgcn_s_sleep(1);
        if ((++sp & 255u) == 0u) { if (xb_ld(&bar[XB_TMO])) break; if (sp > XB_SPIN_CAP) { atomicAdd(&bar[XB_TMO], 1u); break; } }
    }
    nloc = mine > 0u ? mine : 1u; nx = cnt > 0u ? cnt : 1u;
}

__device__ __forceinline__ void xcd_barrier(const XcdBarrier& b) {
    asm volatile("s_waitcnt vmcnt(0)" ::: "memory");
    __syncthreads();
    if (threadIdx.x == 0) {
        unsigned* bar = b.bar;
        __builtin_amdgcn_s_waitcnt(0);
        unsigned nloc = b.st[0], nx = b.st[1];
        if (nloc == 0u) { xcd_barrier_complete(bar, b.x, nloc, nx); b.st[0] = nloc; b.st[1] = nx; }
        const unsigned old = xb_add(&bar[XB_XSUB(b.x)], 1u);
        const unsigned gen = old / nloc;
        if (old + 1u == (gen + 1u) * nloc) {
            __builtin_amdgcn_fence(__ATOMIC_RELEASE, "agent");
            asm volatile("s_waitcnt vmcnt(0)" ::: "memory");
            const unsigned og = xb_add(&bar[XB_TOP], 1u);
            const unsigned tg = og / nx;
            if (og + 1u == (tg + 1u) * nx) xb_add(&bar[XB_TOPGEN], 1u);
            else XB_SPIN(xb_ld(&bar[XB_TOPGEN]) == tg, bar);
            __builtin_amdgcn_fence(__ATOMIC_ACQUIRE, "agent");
            xb_add(&bar[XB_XGEN(b.x)], 1u);
            asm volatile("s_waitcnt vmcnt(0)" ::: "memory");
        } else {
            XB_SPIN(xb_ld(&bar[XB_XGEN(b.x)]) == gen, bar);
            __builtin_amdgcn_fence(__ATOMIC_ACQUIRE, "agent");
            asm volatile("s_waitcnt vmcnt(0)" ::: "memory");
        }
    }
    __syncthreads();
}

struct Args { const void* in[37]; float* out; unsigned char* ws; int ph_lo, ph_hi; };
enum { I_XP = 0, I_XS, I_CACHE, I_CWIN, I_SRET, I_SH, I_SCONV, I_SFFN, I_PT, I_CP, I_CS, I_N1G, I_N2G, I_WADA, I_BADA, I_WIN, I_PE, I_W1, I_B1, I_W2,
       I_GNG, I_RCW, I_RCB, I_RWA, I_RBA, I_RWX, I_RBX, I_LAM, I_WBRA, I_WBRB, I_WBRC, I_WOUT, I_WUP, I_FCW, I_FCB, I_WDN, I_FNG };

struct Frame {
    LAS unsigned char* lds;
    int tid, lane, wave, G, bid;
    const Args* a;
    unsigned char* ws;
    float* out;
};
__device__ __forceinline__ void launder(Frame& F) { asm volatile("" : "+v"(F.tid), "+v"(F.lane)); int w_ = __builtin_amdgcn_readfirstlane(F.wave), b_ = __builtin_amdgcn_readfirstlane(F.bid), g_ = __builtin_amdgcn_readfirstlane(F.G); asm volatile("" : "+s"(w_), "+s"(b_), "+s"(g_)); F.wave = w_; F.bid = b_; F.G = g_; }
#define FIN(i) ((const float*)F.a->in[i])
#define WSP(T, off) ((T*)(F.ws + (off)))

__device__ __forceinline__ int row_bb(int row) { return row < PM ? (row >> 12) : 4 + ((row - PM) >> 3); }
__device__ __forceinline__ int row_pos(int row) { return row < PM ? (row & (PT - 1)) : PT + ((row - PM) & 7); }

__device__ __forceinline__ int win_cmap(int n) {
    if (n < 1280) return n;
    if (n < 2304) { const int c = n - 1280, isk = c >> 9, hc = c & 511, head = hc >> 7, s = hc & 127;
        const int g = s >> 3, w = s & 7, dim = (w < 4) ? (4 * g + w) : (64 + 4 * g + (w - 4)); return (isk ? O_RK : O_RQ) + head * 128 + dim; }
    if (n < 2816) return O_RV + (n - 2304);
    if (n < 3328) return O_RG + (n - 2816);
    if (n < 3840) return O_RX + (n - 3328);
    if (n < 4352) return O_RGATE + (n - 3840);
    if (n < 7424) return O_MG + (n - 4352);
    if (n < 7448) return O_NG + (n - 7424);
    return -1;
}

struct TrItem { const float* W; bf16* WT; int ldw, ldt, k0, n0; bool map; };
__device__ __forceinline__ void p0_tr_load(const TrItem& I, float (&tv)[32], int lane) {
    const int nd = I.n0 + (lane & 31); const int sc = I.map ? win_cmap(nd) : nd;
#pragma unroll
    for (int i = 0; i < 32; ++i) { const int kk = 2 * i + (lane >> 5); tv[i] = (sc >= 0) ? I.W[(size_t)(I.k0 + kk) * I.ldw + sc] : 0.f; }
}
__device__ __forceinline__ void p0_tr_finish(const TrItem& I, const float (&tv)[32], LAS float* scr, int lane) {
#pragma unroll
    for (int i = 0; i < 32; ++i) { const int kk = 2 * i + (lane >> 5); scr[kk * 33 + (lane & 31)] = tv[i]; }
    LDS_WAIT(); asm volatile("" ::: "memory");
    const int c = lane & 7;
#pragma unroll
    for (int j = 0; j < 4; ++j) { const int n = (lane >> 3) + 8 * j; const LAS float* s = scr + (8 * c) * 33 + n;
        v4u o; o.x = pk2(s[0 * 33], s[1 * 33]); o.y = pk2(s[2 * 33], s[3 * 33]); o.z = pk2(s[4 * 33], s[5 * 33]); o.w = pk2(s[6 * 33], s[7 * 33]);
        *(v4u*)(I.WT + (size_t)(I.n0 + n) * I.ldt + I.k0 + 8 * c) = o; }
    LDS_WAIT(); asm volatile("" ::: "memory");
}
template <bool MAP> __device__ __forceinline__ void p0_tr_item(const float* W, int ldw, bf16* WT, int ldt, int k0, int n0, LAS float* scr, int lane) {
    TrItem I{W, WT, ldw, ldt, k0, n0, MAP}; float tv[32]; p0_tr_load(I, tv, lane); p0_tr_finish(I, tv, scr, lane);
}
template <bool MAP> __device__ __forceinline__ void p0_tr_item2(const float* W, int ldw, bf16* WT, int ldt, int k0, int n0, LAS float* scr, int lane) {
    TrItem I0{W, WT, ldw, ldt, k0, n0, MAP}, I1{W, WT, ldw, ldt, k0, n0 + 32, MAP}; float t0[32], t1[32];
    p0_tr_load(I0, t0, lane); p0_tr_load(I1, t1, lane); p0_tr_finish(I0, t0, scr, lane); p0_tr_finish(I1, t1, scr, lane);
}
__device__ __forceinline__ void sincos_acc(float ang, float& s, float& c) {
    const double a = (double)ang; const double kq = rint(a * 0.63661977236758134308); const double r = fma(-kq, 1.57079632679489661923, a);
    const double r2 = r * r;
    const double sp = r * (1.0 + r2 * (-1.6666666666666666e-1 + r2 * (8.3333333333333332e-3 + r2 * (-1.9841269841269841e-4 + r2 * (2.7557319223985893e-6 + r2 * (-2.5052108385441720e-8))))));
    const double cp = 1.0 + r2 * (-0.5 + r2 * (4.1666666666666664e-2 + r2 * (-1.3888888888888889e-3 + r2 * (2.4801587301587302e-5 + r2 * (-2.7557319223985888e-7 + r2 * 2.0876756987868099e-9)))));
    const int q = ((int)kq) & 3;
    const double ss = (q == 0) ? sp : (q == 1) ? cp : (q == 2) ? -sp : -cp;
    const double cc = (q == 0) ? cp : (q == 1) ? -sp : (q == 2) ? -cp : sp;
    s = (float)ss; c = (float)cc;
}

__device__ __forceinline__ void p0_prologue(Frame& F) {
    const int gw = F.bid * NWAVES + F.wave, NGW = F.G * NWAVES, lane = F.lane;
    LAS float* scr = (LAS float*)(F.lds + F.wave * 16384);
    {
        constexpr int I_IN = 16 * 240, I_BR = 8 * 32, I_OUT = 16 * 32, I_UP = 16 * 176, I_DN = 44 * 32, I_L = I_IN + 3 * I_BR + I_OUT + I_UP + I_DN;
        for (int it = gw; it < 2 * I_L; it += NGW) {
            const int l = it / I_L; int r = it % I_L;
            if (r < I_IN) { p0_tr_item<true>(FIN(I_WIN) + (size_t)l * DM * D_IN, D_IN, WSP(bf16, WS_WIN) + (size_t)l * NIN * DM, DM, 64 * (r / 240), 32 * (r % 240), scr, lane); continue; } r -= I_IN;
            if (r < 3 * I_BR) { const int w = r / I_BR, q = r % I_BR; const float* src = FIN(w == 0 ? I_WBRA : (w == 1 ? I_WBRB : I_WBRC)) + (size_t)l * 512 * 1024;
                p0_tr_item<false>(src, 1024, WSP(bf16, WS_WBR) + (size_t)(l * 3 + w) * 1024 * 512, 512, 64 * (q / 32), 32 * (q % 32), scr, lane); continue; } r -= 3 * I_BR;
            if (r < I_OUT) { p0_tr_item<false>(FIN(I_WOUT) + (size_t)l * 1024 * 1024, 1024, WSP(bf16, WS_WOUT) + (size_t)l * 1024 * 1024, 1024, 64 * (r / 32), 32 * (r % 32), scr, lane); continue; } r -= I_OUT;
            if (r < I_UP) { p0_tr_item<false>(FIN(I_WUP) + (size_t)l * DM * NUP, NUP, WSP(bf16, WS_WUP) + (size_t)l * NUP * DM, DM, 64 * (r / 176), 32 * (r % 176), scr, lane); continue; } r -= I_UP;
            p0_tr_item<false>(FIN(I_WDN) + (size_t)l * DFF * DM, DM, WSP(bf16, WS_WDN) + (size_t)l * DM * DFF, DFF, 64 * (r / 32), 32 * (r % 32), scr, lane);
        }
    }
    {
        constexpr int NI_W1 = 8 * 16 * 4, NI_W2 = 4 * 2 * 2, NI_RG = 32 * 2;
        for (int it = NGW - 1 - gw; it < NI_W1 + NI_W2 + NI_RG; it += NGW) {
            int r = it;
            if (r < NI_W1) { const int m = r / 64, q = r % 64, lk = m >> 1, half = m & 1;
                p0_tr_item<false>(FIN(I_W1) + ((size_t)lk * 32 + half * 16) * 64 * 128, 128, WSP(bf16, WS_SMALLW + SW_W1T) + ((size_t)lk * 256 + half * 128) * 1024, 1024, 64 * (q / 4), 32 * (q % 4), scr, lane); continue; } r -= NI_W1;
            if (r < NI_W2) { const int lk = r / 4, q = r % 4;
                p0_tr_item<false>(FIN(I_W2) + (size_t)lk * 128 * 64, 64, WSP(bf16, WS_SMALLW + SW_W2T) + (size_t)lk * 64 * 128, 128, 64 * (q / 2), 32 * (q % 2), scr, lane); continue; } r -= NI_W2;
            { const int m = r / 2, q = r % 2, l = m >> 4, which = (m >> 3) & 1, blk = m & 7;
                p0_tr_item<false>(FIN(which ? I_RWX : I_RWA) + ((size_t)l * 8 + blk) * 4096, 64, WSP(bf16, WS_SMALLW + SW_WAT) + (size_t)m * 4096, 64, 0, 32 * q, scr, lane); }
        }
    }
    for (int it = NGW - 1 - gw; it < 64; it += NGW) {
        const int lk = it >> 4, h0 = (it & 15) * 8; const float* pe = FIN(I_PE) + (size_t)lk * 2048; const float* w1 = FIN(I_W1) + (size_t)lk * 2048 * 128 + h0;
        f32x4 a0 = (f32x4){0.f, 0.f, 0.f, 0.f}, a1 = a0;
#pragma unroll 8
        for (int i = lane; i < 2048; i += 64) { const float p = pe[i]; a0 += *(const f32x4*)(w1 + (size_t)i * 128) * p; a1 += *(const f32x4*)(w1 + (size_t)i * 128 + 4) * p; }
#pragma unroll
        for (int x = 0; x < 4; ++x) { a0[x] = wave_sum(a0[x]); a1[x] = wave_sum(a1[x]); }
        if (lane == 0) { float* cb = WSP(float, WS_SMALLW + SW_CB) + lk * 128 + h0; const float* b1 = FIN(I_B1) + lk * 128 + h0;
#pragma unroll
            for (int x = 0; x < 4; ++x) { cb[x] = a0[x] + b1[x]; cb[4 + x] = a1[x] + b1[4 + x]; } }
    }
    for (int i = F.bid * NTHR + F.tid; i < 1024; i += F.G * NTHR) { const float lam = FIN(I_LAM)[i]; WSP(float, WS_SMALLW + SW_SP)[i] = log1pf(expf(-lam)); }
    for (int i = F.bid * NTHR + F.tid; i < 2 * SB * 2 * DFF; i += F.G * NTHR) WSP(bf16, WS_SFB)[i] = (bf16)(pk2(FIN(I_SFFN)[i], 0.f) & 0xffffu);
    for (int i = F.bid * NTHR + F.tid; i < 4104 * 64; i += F.G * NTHR) {
        const int pi = i >> 6, fi = i & 63; const float pos = (float)(pi < PT ? pi : PAST + (pi - PT));
        const float freq = (float)pow(10000.0, -(double)fi / 64.0); const float ang = pos * freq; float s, c; sincos_acc(ang, s, c);
        WSP(float, WS_ROT)[i] = c; WSP(float, WS_ROT)[4104 * 64 + i] = s;
    }
    {
        LAS float* SC = (LAS float*)(F.lds + 0);
        LAS float* RED = (LAS float*)(F.lds + 36864);
        for (int u = F.bid; u < 2 * 96; u += F.G) {
            const int l = u / 96, cg = u % 96; float acc[36];
#pragma unroll
            for (int b = 0; b < 36; ++b) acc[b] = 0.f;
#pragma unroll 1
            for (int kq = 0; kq < 4; ++kq) { const int kh = (kq + u) & 3;
                __syncthreads();
                {   float cv[18];
                    const float* cpp = FIN(I_CP); const float* csp = FIN(I_CS);
#pragma unroll
                    for (int it = 0; it < 18; ++it) { const int i = F.tid + NTHR * it, bb = i >> 8, d = i & 255;
                        cv[it] = (bb < 4) ? cpp[bb * DM + kh * 256 + d] : csp[(bb - 4) * DM + kh * 256 + d]; }
#pragma unroll
                    for (int it = 0; it < 18; ++it) { const int i = F.tid + NTHR * it, bb = i >> 8, d = i & 255; SC[d * 36 + bb] = siluf_(cv[it]); }
                }
                __syncthreads();
                const float* wp = FIN(I_WADA) + ((size_t)l * DM + kh * 256 + F.wave * 32) * 6144 + cg * 64 + lane;
                {
                    float wv[32];
#pragma unroll
                    for (int k = 0; k < 32; ++k) wv[k] = wp[(size_t)k * 6144];
                    const LAS f32x4* scb = (const LAS f32x4*)(SC + (F.wave * 32) * 36);
                    f32x4 sa[9], sb[9];
#pragma unroll
                    for (int g = 0; g < 9; ++g) sa[g] = scb[g];
#pragma unroll
                    for (int k = 0; k < 32; k += 2) {
#pragma unroll
                        for (int g = 0; g < 9; ++g) sb[g] = scb[(k + 1) * 9 + g];
#pragma unroll
                        for (int g = 0; g < 9; ++g) { acc[4 * g + 0] += wv[k] * sa[g][0]; acc[4 * g + 1] += wv[k] * sa[g][1]; acc[4 * g + 2] += wv[k] * sa[g][2]; acc[4 * g + 3] += wv[k] * sa[g][3]; }
                        if (k + 2 < 32) {
#pragma unroll
                            for (int g = 0; g < 9; ++g) sa[g] = scb[(k + 2) * 9 + g]; }
#pragma unroll
                        for (int g = 0; g < 9; ++g) { acc[4 * g + 0] += wv[k + 1] * sb[g][0]; acc[4 * g + 1] += wv[k + 1] * sb[g][1]; acc[4 * g + 2] += wv[k + 1] * sb[g][2]; acc[4 * g + 3] += wv[k + 1] * sb[g][3]; }
                    }
                }
            }
#pragma unroll
            for (int b = 0; b < 36; ++b) RED[(F.wave * 36 + b) * 64 + lane] = acc[b];
            __syncthreads();
            for (int o = F.tid; o < 36 * 64; o += NTHR) { const int b = o >> 6, col = o & 63; float sm = FIN(I_BADA)[l * 6144 + cg * 64 + col];
#pragma unroll
                for (int w = 0; w < 8; ++w) sm += RED[(w * 36 + b) * 64 + col];
                WSP(float, WS_MOD)[((size_t)l * 36 + b) * 6144 + cg * 64 + col] = sm; }
        }
        __syncthreads();
    }
    {   constexpr size_t NV4 = (size_t)2 * SB * 504 * 64; const size_t stride = (size_t)F.G * NTHR;
        for (size_t i0 = (size_t)F.bid * NTHR + F.tid; i0 < NV4; i0 += 8 * stride) {
            f32x4 v[8];
#pragma unroll
            for (int k = 0; k < 8; ++k) { const size_t i = i0 + k * stride; if (i < NV4) { const size_t seq = i / (504 * 64), r = i % (504 * 64); v[k] = __builtin_nontemporal_load((const f32x4*)(FIN(I_CWIN) + (seq * 512 + 8) * 256 + r * 4)); } }
#pragma unroll
            for (int k = 0; k < 8; ++k) { const size_t i = i0 + k * stride; if (i < NV4) { const size_t seq = i / (504 * 64), r = i % (504 * 64); *(f32x4*)(F.out + OUT_WIN_S + seq * 512 * 256 + r * 4) = v[k]; } }
        }
    }
}

__device__ __forceinline__ f32x4 ld4_bf(const bf16* p) { const v2u w = *(const v2u*)p; return (f32x4){bf_lo(w.x), bf_hi(w.x), bf_lo(w.y), bf_hi(w.y)}; }
template <int NR> __device__ __forceinline__ void norm_rows(Frame& F, int l, int which, const float* g, int row0) {
    const int lane = F.lane;
        f32x4 v[NR][4]; float ss[NR];
#pragma unroll
        for (int rr = 0; rr < NR; ++rr) { const int row = row0 + rr;
            if (which == 0 && l == 0) { const float* xr = row < PM ? FIN(I_XP) + (size_t)row * DM : FIN(I_XS) + (size_t)(row - PM) * DM;
#pragma unroll
                for (int j = 0; j < 4; ++j) v[rr][j] = *(const f32x4*)(xr + lane * 4 + 256 * j); }
            else { const bf16* xr = WSP(bf16, which ? WS_X1 : WS_X2) + (size_t)row * DM;
#pragma unroll
                for (int j = 0; j < 4; ++j) v[rr][j] = ld4_bf(xr + lane * 4 + 256 * j); } }
#pragma unroll
        for (int rr = 0; rr < NR; ++rr) { float a = 0.f;
#pragma unroll
            for (int j = 0; j < 4; ++j) a += (v[rr][j][0] * v[rr][j][0] + v[rr][j][1] * v[rr][j][1]) + (v[rr][j][2] * v[rr][j][2] + v[rr][j][3] * v[rr][j][3]);
            ss[rr] = a; }
#pragma unroll
        for (int o = 1; o < 64; o <<= 1) {
#pragma unroll
            for (int rr = 0; rr < NR; ++rr) ss[rr] += __shfl_xor(ss[rr], o); }
#pragma unroll
        for (int rr = 0; rr < NR; ++rr) { const int row = row0 + rr; const float rs = 1.0f / sqrtf(ss[rr] * (1.0f / DM) + EPS);
            const float* mod = WSP(float, WS_MOD) + ((size_t)l * 36 + row_bb(row)) * 6144 + (which ? 3072 : 0); bf16* o = WSP(bf16, WS_H) + (size_t)row * DM;
#pragma unroll
            for (int j = 0; j < 4; ++j) { const int c = lane * 4 + 256 * j; const f32x4 gg = *(const f32x4*)(g + c), sh = *(const f32x4*)(mod + c), sc = *(const f32x4*)(mod + 1024 + c);
                const f32x4 y = (v[rr][j] * rs) * gg * (sc + 1.0f) + sh; v2u w; w.x = pk2(y[0], y[1]); w.y = pk2(y[2], y[3]); *(v2u*)(o + c) = w; } }
    }
__device__ __forceinline__ void norm_phase(Frame& F, int l, int which) {
    const int gw = F.bid * NWAVES + F.wave, NGW = F.G * NWAVES;
    const float* g = FIN(which ? I_N2G : I_N1G) + l * DM;
    for (int row0 = gw * 4; row0 < PM; row0 += NGW * 4) norm_rows<4>(F, l, which, g, row0);
    for (int row = PM + gw; row < MT; row += NGW) norm_rows<1>(F, l, which, g, row);
}
template <int NR> __device__ __forceinline__ void final_rows(Frame& F, const float* g, int row0) {
    const int lane = F.lane; f32x4 v[NR][4]; float ss[NR];
#pragma unroll
    for (int rr = 0; rr < NR; ++rr) { const bf16* xr = WSP(bf16, WS_X2) + (size_t)(row0 + rr) * DM; float a = 0.f;
#pragma unroll
        for (int j = 0; j < 4; ++j) { v[rr][j] = ld4_bf(xr + lane * 4 + 256 * j); a += (v[rr][j][0] * v[rr][j][0] + v[rr][j][1] * v[rr][j][1]) + (v[rr][j][2] * v[rr][j][2] + v[rr][j][3] * v[rr][j][3]); }
        ss[rr] = a; }
#pragma unroll
    for (int rr = 0; rr < NR; ++rr) { const float rs = 1.0f / sqrtf(wave_sum(ss[rr]) * (1.0f / DM) + EPS);
        float* o = F.out + OUT_Y + (size_t)(row0 + rr) * DM;
#pragma unroll
        for (int j = 0; j < 4; ++j) { const int c = lane * 4 + 256 * j; *(f32x4*)(o + c) = (v[rr][j] * rs) * *(const f32x4*)(g + c); } }
}
__device__ __forceinline__ void final_phase(Frame& F) {
    const int gw = F.bid * NWAVES + F.wave, NGW = F.G * NWAVES;
    const float* g = FIN(I_FNG);
    for (int row0 = gw * 4; row0 < PM; row0 += NGW * 4) final_rows<4>(F, g, row0);
    for (int row = PM + gw; row < MT; row += NGW) final_rows<1>(F, g, row);
}

#define EPI_LOOP_BEGIN \
    _Pragma("unroll") for (int ai = 0; ai < 2; ++ai) _Pragma("unroll") for (int m = 0; m < 4; ++m) { const int row = u.pm * 256 + ai * 128 + wr * 64 + m * 16 + fr; \
    _Pragma("unroll") for (int bj = 0; bj < 2; ++bj) { const int ct = bj * 128 + wc * 32 + 8 * fq; const f32x4 v0 = acc[ai][bj][m][0], v1 = acc[ai][bj][m][1];
#define EPI_LOOP_END } }

struct EpiWin {
    static constexpr bool PERM = true, AFTER_DRAIN = false;
    unsigned char* ws; float* out; int l;
    __device__ __forceinline__ void operator()(const f32x4 (&acc)[2][2][4][2], const pg8::Unit& u, int wr, int wc, int fr0, int fq0) const {
        int fr = fr0, fq = fq0; asm volatile("" : "+v"(fr), "+v"(fq));
        const int pn = u.pn;
        if (pn < 2) {
            bf16* QN = (bf16*)(ws + WS_QN);
            EPI_LOOP_BEGIN *(v4u*)(QN + (size_t)row * 512 + pn * 256 + ct) = pack8(v0 * QSCALE, v1 * QSCALE); EPI_LOOP_END
        } else if (pn < 5) {
            EPI_LOOP_BEGIN
                const int c = (pn - 2) * 256 + ct, j = c >> 7, k = (c >> 6) & 1, d = c & 63;
                const bool isp = row < PM; const int b = isp ? (row >> 12) : ((row - PM) >> 3), t = isp ? (row & (PT - 1)) : ((row - PM) & 7);
                if (j < 4) { float* o = out + (isp ? OUT_ROWS_P + ((size_t)l * PM + row) * 512 : OUT_ROWS_S + ((size_t)l * SM + (row - PM)) * 512) + c; *(f32x4*)o = v0; *(f32x4*)(o + 4) = v1; }
                else if (isp) { if (t >= PT - WINB) { float* o = out + OUT_WIN_P + (((size_t)l * PB + b) * WINB + (t - (PT - WINB))) * 256 + (c - 512); *(f32x4*)o = v0; *(f32x4*)(o + 4) = v1; } }
                else { float* o = out + OUT_WIN_S + (((size_t)l * SB + b) * WINB + (WINB - ST) + t) * 256 + (c - 512); *(f32x4*)o = v0; *(f32x4*)(o + 4) = v1; }
                const v4u w = pack8(v0, v1);
                if (isp) {
                    if (j < 2) *(v4u*)((bf16*)(ws + WS_ACMP) + ((size_t)(l * 2 + j) * CMP_ROWS_J + 32768 + (b * 2 + k) * 256) * 1024 + (size_t)t * 64 + d) = w;
                    else if (j & 1) {
                        const int tq = t & 31, s2 = tq >> 4, hh = (tq >> 2) & 1, ii = (tq & 3) + 4 * ((tq >> 3) & 1);
                        bf16* vt = (bf16*)(ws + WS_KVB) + (((size_t)(j - 2) * PB + b) * 2 + k) * PT * 64 + (size_t)(t >> 5) * 2048 + ((((d >> 5) * 2 + s2) * 2 + hh) * 32 + (d & 31)) * 8 + ii;
                        vt[0] = (bf16)(w.x & 0xffffu); vt[8] = (bf16)(w.x >> 16); vt[16] = (bf16)(w.y & 0xffffu); vt[24] = (bf16)(w.y >> 16);
                        vt[32] = (bf16)(w.z & 0xffffu); vt[40] = (bf16)(w.z >> 16); vt[48] = (bf16)(w.w & 0xffffu); vt[56] = (bf16)(w.w >> 16); }
                    else *(v4u*)((bf16*)(ws + WS_KVB) + (((size_t)(j - 2) * PB + b) * 2 + k) * PT * 64 + (size_t)(t >> 5) * 2048 + ((d >> 3) * 32 + (t & 31)) * 8) = w;
                } else if (j >= 2) *(v4u*)((bf16*)(ws + WS_KVS) + ((((size_t)(j - 2) * SB + b) * 2 + k) * ST + t) * 64 + d) = w;
            EPI_LOOP_END
        } else if (pn < 9) {
            const float* ROTC = (const float*)(ws + WS_ROT); const float* ROTS = ROTC + 4104 * 64;
#pragma unroll
            for (int ai = 0; ai < 2; ++ai) {
                f32x4 cs[4][2], sn[4][2];
#pragma unroll
                for (int m = 0; m < 4; ++m) { const int row = u.pm * 256 + ai * 128 + wr * 64 + m * 16 + fr; const int pi = row_pos(row);
#pragma unroll
                    for (int bj = 0; bj < 2; ++bj) { const int ct = bj * 128 + wc * 32 + 8 * fq; const int c = (pn - 5) * 256 + ct, d0 = (((c & 511) & 127) >> 3) * 4; cs[m][bj] = *(const f32x4*)(ROTC + pi * 64 + d0); sn[m][bj] = *(const f32x4*)(ROTS + pi * 64 + d0); } }
#pragma unroll
                for (int m = 0; m < 4; ++m) { const int row = u.pm * 256 + ai * 128 + wr * 64 + m * 16 + fr;
#pragma unroll
                    for (int bj = 0; bj < 2; ++bj) { const int ct = bj * 128 + wc * 32 + 8 * fq; const f32x4 v0 = acc[ai][bj][m][0], v1 = acc[ai][bj][m][1];
                        const int c = (pn - 5) * 256 + ct, isk = c >> 9, hc = c & 511, head = hc >> 7, d0 = ((hc & 127) >> 3) * 4;
                        const float sc = isk ? 0.08838834764831845f : 1.0f;
                        const f32x4 o1 = (v0 * cs[m][bj] - v1 * sn[m][bj]) * sc, o2 = (v0 * sn[m][bj] + v1 * cs[m][bj]) * sc;
                        bf16* o = (bf16*)(ws + WS_RQ) + (size_t)isk * MT * 512 + (size_t)row * 512 + head * 128 + d0;
                        v2u w1; w1.x = pk2(o1[0], o1[1]); w1.y = pk2(o1[2], o1[3]); *(v2u*)o = w1;
                        v2u w2; w2.x = pk2(o2[0], o2[1]); w2.y = pk2(o2[2], o2[3]); *(v2u*)(o + 64) = w2; } }
            }
        } else if (pn < 13) {
            bf16* RV = (bf16*)(ws + WS_RQ) + (size_t)2 * MT * 512;
            EPI_LOOP_BEGIN const int c = (pn - 9) * 256 + ct; *(v4u*)(RV + (size_t)(c >> 9) * MT * 512 + (size_t)row * 512 + (c & 511)) = pack8(v0, v1); EPI_LOOP_END
        } else if (pn < 15) {
            float* RX = (float*)(ws + WS_RX);
            EPI_LOOP_BEGIN
                const int c = (pn - 13) * 256 + ct; float* o = RX + (size_t)row * 512 + c; *(f32x4*)o = v0; *(f32x4*)(o + 4) = v1;
                if (row < PM) { const int t = row & (PT - 1); if (t >= PT - 3) { float* q = out + OUT_CV_P + (((size_t)l * PB + (row >> 12)) * 3 + (t - (PT - 3))) * 512 + c; *(f32x4*)q = v0; *(f32x4*)(q + 4) = v1; } }
                else { const int i = (row - PM) & 7; if (i >= ST - 3) { float* q = out + OUT_CV_S + (((size_t)l * SB + ((row - PM) >> 3)) * 3 + (i - (ST - 3))) * 512 + c; *(f32x4*)q = v0; *(f32x4*)(q + 4) = v1; } }
            EPI_LOOP_END
        } else if (pn < 17) {
            bf16* GG = (bf16*)(ws + WS_GG);
            EPI_LOOP_BEGIN const int c = (pn - 15) * 256 + ct;
                f32x4 a, b;
#pragma unroll
                for (int i = 0; i < 4; ++i) { a[i] = gelu_tanh(v0[i]); b[i] = gelu_tanh(v1[i]); }
                *(v4u*)(GG + (size_t)row * 512 + c) = pack8(a, b); EPI_LOOP_END
        } else if (pn < 29) {
            bf16* MG = (bf16*)(ws + WS_MGS);
            EPI_LOOP_BEGIN const int c = (pn - 17) * 256 + ct;
                f32x4 a, b;
#pragma unroll
                for (int i = 0; i < 4; ++i) { a[i] = sigmoidf_(v0[i]); b[i] = sigmoidf_(v1[i]); }
                *(v4u*)(MG + (size_t)row * 3072 + c) = pack8(a, b); EPI_LOOP_END
        } else {
            float* NG = (float*)(ws + WS_NG);
            EPI_LOOP_BEGIN if (ct < 24) { f32x4 a, b;
#pragma unroll
                for (int i = 0; i < 4; ++i) { a[i] = sigmoidf_(v0[i]); b[i] = sigmoidf_(v1[i]); }
                float* o = NG + (size_t)row * 24 + ct; *(f32x4*)o = a; *(f32x4*)(o + 4) = b; } EPI_LOOP_END
        }
    }
};

struct EpiLH {
    static constexpr bool PERM = true, AFTER_DRAIN = false;
    bf16* LH;
    __device__ __forceinline__ void operator()(const f32x4 (&acc)[2][2][4][2], const pg8::Unit& u, int wr, int wc, int fr0, int fq0) const {
        int fr = fr0, fq = fq0; asm volatile("" : "+v"(fr), "+v"(fq));
        EPI_LOOP_BEGIN *(v4u*)(LH + (size_t)row * 256 + ct) = pack8(v0, v1); EPI_LOOP_END
    }
};
struct CmpOrder {
    int G, c;
    __device__ bool next(int i, pg8::Unit& u) const { const int L = i * G + c; if (L >= CMP_ROWS / 256) return false; u.pm = L; u.pn = L / (CMP_ROWS_J / 256); return true; }
    __device__ __forceinline__ void a_ready(const pg8::Unit&) const {}
    __device__ __forceinline__ void done(const pg8::Unit&) const {}
};

template <int BR> struct EpiBr {
    static constexpr bool PERM = true, AFTER_DRAIN = false;
    unsigned char* ws;
    __device__ __forceinline__ void operator()(const f32x4 (&acc)[2][2][4][2], const pg8::Unit& u, int wr, int wc, int fr0, int fq0) const {
        int fr = fr0, fq = fq0; asm volatile("" : "+v"(fr), "+v"(fq));
        const bf16* MG = (const bf16*)(ws + WS_MGS); bf16* MR = (bf16*)(ws + WS_MRG);
        EPI_LOOP_BEGIN
            const int col = u.pn * 256 + ct; f32x4 g0, g1; unpack8(*(const v4u*)(MG + (size_t)row * 3072 + BR * 1024 + col), g0, g1);
            f32x4 r0 = v0 * g0, r1 = v1 * g1; bf16* o = MR + (size_t)row * DM + col;
            if (BR > 0) { f32x4 p0, p1; unpack8(*(const v4u*)o, p0, p1); r0 += p0; r1 += p1; }
            *(v4u*)o = pack8(r0, r1);
        EPI_LOOP_END
    }
};

struct BrOrder {
    pg8::StaticOrder S;
    __device__ bool next(int i, pg8::Unit& u) const { pg8::Unit t; if (!S.next(i / 3, t)) return false; const int br = i % 3; u.pm = br * (MT / 256) + t.pm; u.pn = br * 4 + t.pn; return true; }
    __device__ __forceinline__ void a_ready(const pg8::Unit&) const {}
    __device__ __forceinline__ void done(const pg8::Unit&) const {}
};
struct EpiBrAll {
    static constexpr bool PERM = true, AFTER_DRAIN = false;
    unsigned char* ws;
    __device__ __forceinline__ void operator()(const f32x4 (&acc)[2][2][4][2], const pg8::Unit& u0, int wr, int wc, int fr0, int fq0) const {
        int fr = fr0, fq = fq0; asm volatile("" : "+v"(fr), "+v"(fq));
        const int br = u0.pn >> 2; const pg8::Unit u{u0.pm - br * (MT / 256), u0.pn & 3};
        const bf16* MG = (const bf16*)(ws + WS_MGS) + br * 1024; bf16* MR = (bf16*)(ws + WS_MRG);
#pragma unroll
        for (int ai = 0; ai < 2; ++ai) {
            v4u gw[4][2], pw[4][2];
#pragma unroll
            for (int m = 0; m < 4; ++m) { const int row = u.pm * 256 + ai * 128 + wr * 64 + m * 16 + fr;
#pragma unroll
                for (int bj = 0; bj < 2; ++bj) { const int col = u.pn * 256 + bj * 128 + wc * 32 + 8 * fq; gw[m][bj] = *(const v4u*)(MG + (size_t)row * 3072 + col); if (br != 0) pw[m][bj] = *(const v4u*)(MR + (size_t)row * DM + col); } }
#pragma unroll
            for (int m = 0; m < 4; ++m) { const int row = u.pm * 256 + ai * 128 + wr * 64 + m * 16 + fr;
#pragma unroll
                for (int bj = 0; bj < 2; ++bj) { const int col = u.pn * 256 + bj * 128 + wc * 32 + 8 * fq; const f32x4 v0 = acc[ai][bj][m][0], v1 = acc[ai][bj][m][1];
                    f32x4 g0, g1; unpack8(gw[m][bj], g0, g1); f32x4 r0 = v0 * g0, r1 = v1 * g1;
                    if (br != 0) { f32x4 p0, p1; unpack8(pw[m][bj], p0, p1); r0 += p0; r1 += p1; }
                    *(v4u*)(MR + (size_t)row * DM + col) = pack8(r0, r1); } }
        }
    }
};

template <bool INF32> struct EpiRes {
    static constexpr bool PERM = true, AFTER_DRAIN = false;
    const void* xin_p; bf16* xout; const float* mod; int gofs;
    __device__ __forceinline__ void operator()(const f32x4 (&acc)[2][2][4][2], const pg8::Unit& u, int wr, int wc, int fr0, int fq0) const {
        int fr = fr0, fq = fq0; asm volatile("" : "+v"(fr), "+v"(fq));
#pragma unroll
        for (int ai = 0; ai < 2; ++ai) {
            const float* gp = mod + (size_t)row_bb(u.pm * 256 + ai * 128) * 6144 + gofs + u.pn * 256 + wc * 32 + 8 * fq;
            f32x4 g[2][2];
#pragma unroll
            for (int bj = 0; bj < 2; ++bj) { g[bj][0] = *(const f32x4*)(gp + 128 * bj); g[bj][1] = *(const f32x4*)(gp + 128 * bj + 4); }
            if (INF32) {
#pragma unroll
                for (int mh = 0; mh < 2; ++mh) {
                    f32x4 xv[2][2][2];
#pragma unroll
                    for (int m2 = 0; m2 < 2; ++m2) { const int row = u.pm * 256 + ai * 128 + wr * 64 + (2 * mh + m2) * 16 + fr;
#pragma unroll
                        for (int bj = 0; bj < 2; ++bj) { const float* xi = (const float*)xin_p + (size_t)row * DM + u.pn * 256 + bj * 128 + wc * 32 + 8 * fq; xv[m2][bj][0] = *(const f32x4*)xi; xv[m2][bj][1] = *(const f32x4*)(xi + 4); } }
#pragma unroll
                    for (int m2 = 0; m2 < 2; ++m2) { const int m = 2 * mh + m2; const int row = u.pm * 256 + ai * 128 + wr * 64 + m * 16 + fr;
#pragma unroll
                        for (int bj = 0; bj < 2; ++bj) { const int col = u.pn * 256 + bj * 128 + wc * 32 + 8 * fq;
                            *(v4u*)(xout + (size_t)row * DM + col) = pack8(xv[m2][bj][0] + g[bj][0] * acc[ai][bj][m][0], xv[m2][bj][1] + g[bj][1] * acc[ai][bj][m][1]); } }
                }
            } else {
                v4u xw[4][2];
#pragma unroll
                for (int m = 0; m < 4; ++m) { const int row = u.pm * 256 + ai * 128 + wr * 64 + m * 16 + fr;
#pragma unroll
                    for (int bj = 0; bj < 2; ++bj) xw[m][bj] = *(const v4u*)((const bf16*)xin_p + (size_t)row * DM + u.pn * 256 + bj * 128 + wc * 32 + 8 * fq); }
#pragma unroll
                for (int m = 0; m < 4; ++m) { const int row = u.pm * 256 + ai * 128 + wr * 64 + m * 16 + fr;
#pragma unroll
                    for (int bj = 0; bj < 2; ++bj) { const int col = u.pn * 256 + bj * 128 + wc * 32 + 8 * fq; f32x4 x0, x1; unpack8(xw[m][bj], x0, x1);
                        *(v4u*)(xout + (size_t)row * DM + col) = pack8(x0 + g[bj][0] * acc[ai][bj][m][0], x1 + g[bj][1] * acc[ai][bj][m][1]); } }
            }
        }
    }
};

template <int CTRL> __device__ __forceinline__ v4u dpp4(const v4u old, const v4u src) {
    v4u r; r.x = (unsigned)__builtin_amdgcn_update_dpp((int)old.x, (int)src.x, CTRL, 0xf, 0xf, false); r.y = (unsigned)__builtin_amdgcn_update_dpp((int)old.y, (int)src.y, CTRL, 0xf, 0xf, false);
    r.z = (unsigned)__builtin_amdgcn_update_dpp((int)old.z, (int)src.z, CTRL, 0xf, 0xf, false); r.w = (unsigned)__builtin_amdgcn_update_dpp((int)old.w, (int)src.w, CTRL, 0xf, 0xf, false); return r; }
struct UpOrder {
    pg8::StaticOrder S;
    __device__ bool next(int i, pg8::Unit& u) const { pg8::Unit t; if (!S.next(i >> 1, t)) return false; u.pm = t.pm; u.pn = t.pn + 11 * (i & 1); return true; }
    __device__ __forceinline__ void a_ready(const pg8::Unit&) const {}
    __device__ __forceinline__ void done(const pg8::Unit&) const {}
};
struct EpiUp {
    static constexpr bool PERM = true, AFTER_DRAIN = false;
    unsigned char* ws; float* out; int l; const float* cw; const float* cbi; const bf16* sfb;
    __device__ __forceinline__ void operator()(const f32x4 (&acc)[2][2][4][2], const pg8::Unit& u, int wr, int wc, int fr0, int fq0) const {
        int fr = fr0, fq = fq0; asm volatile("" : "+v"(fr), "+v"(fq));
        bf16* GP = (bf16*)(ws + WS_GP); bf16* VAL = GP + (size_t)MT * DFF; bf16* ACT = GP + (size_t)2 * MT * DFF;
        if (u.pn < 11) {
            EPI_LOOP_BEGIN const int c = u.pn * 256 + ct; *(v4u*)(GP + (size_t)row * DFF + c) = pack8(v0, v1);
                if (row < PM) { const int t = row & (PT - 1); if (t >= PT - 2) { float* q = out + OUT_FC_P + (((size_t)l * PB + (row >> 12)) * 2 + (t - (PT - 2))) * DFF + c; *(f32x4*)q = v0; *(f32x4*)(q + 4) = v1; } }
                else { const int i = (row - PM) & 7; if (i >= ST - 2) { float* q = out + OUT_FC_S + (((size_t)l * SB + ((row - PM) >> 3)) * 2 + (i - (ST - 2))) * DFF + c; *(f32x4*)q = v0; *(f32x4*)(q + 4) = v1; } }
            EPI_LOOP_END
        } else if (u.pm * 256 >= PM) {
#pragma unroll
            for (int bj = 0; bj < 2; ++bj) { const int c = (u.pn - 11) * 256 + bj * 128 + wc * 32 + 8 * fq;
                const f32x4 w0a = *(const f32x4*)(cw + c), w0b = *(const f32x4*)(cw + c + 4), w1a = *(const f32x4*)(cw + DFF + c), w1b = *(const f32x4*)(cw + DFF + c + 4);
                const f32x4 w2a = *(const f32x4*)(cw + 2 * DFF + c), w2b = *(const f32x4*)(cw + 2 * DFF + c + 4), ba = *(const f32x4*)(cbi + c), bb = *(const f32x4*)(cbi + c + 4);
#pragma unroll
                for (int ai = 0; ai < 2; ++ai)
#pragma unroll
                  for (int mh = 0; mh < 2; ++mh) {
                    v4u g0[2], g1[2], g2[2];
#pragma unroll
                    for (int m2 = 0; m2 < 2; ++m2) { const int row = u.pm * 256 + ai * 128 + wr * 64 + (2 * mh + m2) * 16 + fr; const bf16* gp = GP + (size_t)row * DFF + c;
                        const bf16* sb = sfb + (size_t)((row - PM) >> 3) * 2 * DFF + c; const int i = (row - PM) & 7;
                        const bf16* q1 = (i < 1) ? sb + DFF : gp - DFF; const bf16* q2 = (i < 2) ? (i == 1 ? sb + DFF : sb) : gp - 2 * DFF;
                        g0[m2] = *(const v4u*)gp; g1[m2] = *(const v4u*)q1; g2[m2] = *(const v4u*)q2; }
#pragma unroll
                    for (int m2 = 0; m2 < 2; ++m2) { const int m = 2 * mh + m2; const int row = u.pm * 256 + ai * 128 + wr * 64 + m * 16 + fr; const int t = row & (PT - 1);
                        const f32x4 v0 = acc[ai][bj][m][0], v1 = acc[ai][bj][m][1];
                        if (false) { *(v4u*)(VAL + (size_t)row * DFF + c) = pack8(v0, v1); }
                        else { f32x4 xa, xb, pa, pb, qa, qb; unpack8(g0[m2], xa, xb); unpack8(g1[m2], pa, pb); unpack8(g2[m2], qa, qb);
                            f32x4 ya = ba + w0a * qa + w1a * pa + w2a * xa, yb = bb + w0b * qb + w1b * pb + w2b * xb;
#pragma unroll
                            for (int i = 0; i < 4; ++i) { ya[i] = siluf_(ya[i]) * v0[i]; yb[i] = siluf_(yb[i]) * v1[i]; }
                            *(v4u*)(ACT + (size_t)row * DFF + c) = pack8(ya, yb); } }
                  }
            }
                } else {
#pragma unroll
            for (int bj = 0; bj < 2; ++bj) { const int c = (u.pn - 11) * 256 + bj * 128 + wc * 32 + 8 * fq;
                const f32x4 w0a = *(const f32x4*)(cw + c), w0b = *(const f32x4*)(cw + c + 4), w1a = *(const f32x4*)(cw + DFF + c), w1b = *(const f32x4*)(cw + DFF + c + 4);
                const f32x4 w2a = *(const f32x4*)(cw + 2 * DFF + c), w2b = *(const f32x4*)(cw + 2 * DFF + c + 4), ba = *(const f32x4*)(cbi + c), bb = *(const f32x4*)(cbi + c + 4);
#pragma unroll
                for (int ai = 0; ai < 2; ++ai) {
                    v4u g[4], gm;
                    const int rowb = u.pm * 256 + ai * 128 + wr * 64 + fr;
#pragma unroll
                    for (int m = 0; m < 4; ++m) g[m] = *(const v4u*)(GP + (size_t)(rowb + m * 16) * DFF + c);
                    gm = (fr >= 14 && ((rowb - fr) & (PT - 1)) != 0) ? *(const v4u*)(GP + (size_t)(rowb - 16) * DFF + c) : (v4u){0u, 0u, 0u, 0u};
#pragma unroll
                    for (int m = 0; m < 4; ++m) { const int row = rowb + m * 16; const int t = row & (PT - 1);
                        const v4u pv = (m == 0) ? gm : g[m - 1];
                        const v4u t1 = dpp4<0x111>(dpp4<0x121>(pv, pv), g[m]), t2 = dpp4<0x112>(dpp4<0x122>(pv, pv), g[m]);
                        const f32x4 v0 = acc[ai][bj][m][0], v1 = acc[ai][bj][m][1];
                        if ((t & 255) < 2 && t >= 2) { *(v4u*)(VAL + (size_t)row * DFF + c) = pack8(v0, v1); }
                        else { f32x4 xa, xb, pa, pb, qa, qb; unpack8(g[m], xa, xb); unpack8(t1, pa, pb); unpack8(t2, qa, qb);
                            f32x4 ya = ba + w0a * qa + w1a * pa + w2a * xa, yb = bb + w0b * qb + w1b * pb + w2b * xb;
#pragma unroll
                            for (int i = 0; i < 4; ++i) { ya[i] = siluf_(ya[i]) * v0[i]; yb[i] = siluf_(yb[i]) * v1[i]; }
                            *(v4u*)(ACT + (size_t)row * DFF + c) = pack8(ya, yb); } }
                }
            }
        }
    }
};

__device__ __forceinline__ f32x16 mfma32(bf16x8 a, bf16x8 b, f32x16 c) { return __builtin_amdgcn_mfma_f32_32x32x16_bf16(a, b, c, 0, 0, 0); }
__device__ __forceinline__ f32x4 mfma16(bf16x8 a, bf16x8 b, f32x4 c) { return __builtin_amdgcn_mfma_f32_16x16x32_bf16(a, b, c, 0, 0, 0); }
__device__ __forceinline__ float ret_log_g(int h) { return log1pf(-exp2f(-5.0f - (float)h)); }
__device__ __forceinline__ bf16x8 tr_frag(const LAS unsigned char* base, int rs_bytes, int rowA, int rowB, int colbase, int lane) {
    const int q = (lane & 15) >> 2, p = lane & 3;
    const LAS unsigned char* pa = base + (rowA + q) * rs_bytes + (colbase + 4 * p) * 2;
    const LAS unsigned char* pb = base + (rowB + q) * rs_bytes + (colbase + 4 * p) * 2;
    const s16x4 a = __builtin_bit_cast(s16x4, __builtin_amdgcn_ds_read_tr16_b64_v4i16((LAS s16x4*)pa));
    const s16x4 b = __builtin_bit_cast(s16x4, __builtin_amdgcn_ds_read_tr16_b64_v4i16((LAS s16x4*)pb));
    return (bf16x8){a[0], a[1], a[2], a[3], b[0], b[1], b[2], b[3]};
}
__device__ __forceinline__ bf16x8 cvt_frag(const f32x16& p, int s2) {
    u32x4 w; w.x = pk2(p[8 * s2 + 0], p[8 * s2 + 1]); w.y = pk2(p[8 * s2 + 2], p[8 * s2 + 3]); w.z = pk2(p[8 * s2 + 4], p[8 * s2 + 5]); w.w = pk2(p[8 * s2 + 6], p[8 * s2 + 7]);
    return __builtin_bit_cast(bf16x8, w);
}

__device__ __forceinline__ void cmp2_phase(Frame& F, int l) {
    const int gw = F.bid * NWAVES + F.wave, NGW = F.G * NWAVES, lane = F.lane, r = lane & 15, g = lane >> 4;
    const bf16* LH = WSP(bf16, WS_LH); bf16* CK = WSP(bf16, WS_CK);
    const int j = gw & 1, gwj = gw >> 1, NGJ = NGW >> 1;
    const bf16* W2T = WSP(bf16, WS_SMALLW + SW_W2T) + (size_t)(l * 2 + j) * 64 * 128; const float* CB = WSP(float, WS_SMALLW + SW_CB) + (l * 2 + j) * 128;
    bf16x8 wf[4][4];
#pragma unroll
    for (int ks = 0; ks < 4; ++ks)
#pragma unroll
        for (int ct = 0; ct < 4; ++ct) wf[ks][ct] = *(const bf16x8*)(W2T + (size_t)(16 * ct + r) * 128 + 32 * ks + 8 * g);
    for (int wu = gwj; wu < CMP_ROWS_J / 16; wu += NGJ) {
        const int rj0 = wu * 16, rj = rj0 + r; const size_t row = (size_t)j * CMP_ROWS_J + rj;
        const bool valid = (rj < 32768) ? ((rj & 511) < 511) : (((rj - 32768) & 255) < 255);
        v4u la[4], lb[4];
#pragma unroll
        for (int ks = 0; ks < 4; ++ks) { const int h0 = 32 * ks + 8 * g; la[ks] = *(const v4u*)(LH + row * 256 + h0); lb[ks] = *(const v4u*)(LH + (row + 1) * 256 + 128 + h0); }
        f32x4 acc[4];
#pragma unroll
        for (int ct = 0; ct < 4; ++ct) acc[ct] = (f32x4){0.f, 0.f, 0.f, 0.f};
#pragma unroll
        for (int ks = 0; ks < 4; ++ks) {
            const int h0 = 32 * ks + 8 * g; f32x4 a0, a1, b0, b1;
            unpack8(la[ks], a0, a1); unpack8(lb[ks], b0, b1);
            const f32x4 c0 = *(const f32x4*)(CB + h0), c1 = *(const f32x4*)(CB + h0 + 4);
            f32x4 x0 = a0 + b0 + c0, x1 = a1 + b1 + c1;
#pragma unroll
            for (int i = 0; i < 4; ++i) { x0[i] = gelu_tanh(x0[i]); x1[i] = gelu_tanh(x1[i]); }
            const bf16x8 hf = __builtin_bit_cast(bf16x8, pack8(x0, x1));
#pragma unroll
            for (int ct = 0; ct < 4; ++ct) acc[ct] = mfma16(wf[ks][ct], hf, acc[ct]);
        }
#pragma unroll
        for (int ct = 0; ct < 4; ++ct) { const f32x4 v = valid ? acc[ct] : (f32x4){0.f, 0.f, 0.f, 0.f}; v2u w; w.x = pk2(v[0], v[1]); w.y = pk2(v[2], v[3]);
            *(v2u*)(CK + row * 64 + 16 * ct + 4 * g) = w; }
    }
}

constexpr int CG_RS = 144, CG_BUF = 256 * CG_RS, CG_AW = 2 * CG_BUF, CG_AT = 32 * CG_RS;
static_assert(CG_AW + 2 * 4 * CG_AT <= RING_BYTES, "compress GEMM LDS map");
template <bool smp> __device__ __forceinline__ void cmp_gemm_unit(Frame& F, int l, int j, int grp, int n00) {
    const int tid = F.tid, lane = F.lane, w = F.wave, q = lane & 31, h_ = lane >> 5, rg = w >> 1, ch = w & 1;
    const float* rp[4]; const bf16* ab = nullptr;
    if (smp) { const int db = grp >> 1, k = grp & 1;
#pragma unroll
        for (int i = 0; i < 4; ++i) { const int tt0 = (n00 + 32 * rg + 16 * ch + 4 * i + (lane >> 4)) * 16; const int page = ((const int*)F.a->in[I_PT])[db * NPG + (tt0 >> 7)];
            rp[i] = FIN(I_CACHE) + (((((size_t)l * NPHYS + page) * PAGE + (tt0 & 127)) * 4 + j) * 2 + k) * 64 + (lane & 15) * 4; } }
    else {
        ab = WSP(bf16, WS_ACMP) + ((size_t)(l * 2 + j) * CMP_ROWS_J + 32768 + grp * 256 + n00 + 32 * rg + 16 * ch + (lane >> 3)) * 1024 + (lane & 7) * 8;
#pragma unroll
        for (int i = 0; i < 4; ++i) rp[i] = nullptr; }
    const bf16* Bg = WSP(bf16, WS_SMALLW + SW_W1T) + (size_t)(l * 2 + j) * 256 * 1024;
    f32x16 acc[4];
#pragma unroll
    for (int ct = 0; ct < 4; ++ct) acc[ct] = (f32x16){};
    const bf16* bsrc = Bg + (size_t)(tid >> 1) * 1024 + (tid & 1) * 32; LAS unsigned char* bdst = F.lds + (tid >> 1) * CG_RS + (tid & 1) * 64;
    v4u bst[2][4]; f32x4 an[4][4]; v4u anb[4][2];
    __syncthreads();
#pragma unroll
    for (int x = 0; x < 4; ++x) bst[0][x] = *(const v4u*)(bsrc + 8 * x);
#pragma unroll
    for (int x = 0; x < 4; ++x) bst[1][x] = *(const v4u*)(bsrc + 64 + 8 * x);
#pragma unroll
    for (int d = 0; d < 4; ++d) {
        if (smp) {
#pragma unroll
            for (int i = 0; i < 4; ++i) an[d][i] = __builtin_nontemporal_load((const f32x4*)(rp[i] + (size_t)d * 512)); }
        else {
#pragma unroll
            for (int i = 0; i < 2; ++i) anb[d][i] = *(const v4u*)(ab + (size_t)(8 * i) * 1024 + d * 64); } }
#pragma unroll
    for (int x = 0; x < 4; ++x) *(LAS v4u*)(bdst + x * 16) = bst[0][x];
#define CG_CHUNK(d, LAST_) { const int kc = kc4 + (d); \
            LAS unsigned char* At = F.lds + CG_AW + (((d) & 1) * 4 + rg) * CG_AT; \
            if (!(LAST_) || (d) < 2) {                                   \
                _Pragma("unroll") for (int x = 0; x < 4; ++x) bst[(d) & 1][x] = *(const v4u*)(bsrc + (kc + 2) * 64 + 8 * x); } \
            if (smp) { \
                _Pragma("unroll") for (int i = 0; i < 4; ++i) { v2u o; o.x = pk2(an[d][i][0], an[d][i][1]); o.y = pk2(an[d][i][2], an[d][i][3]); *(LAS v2u*)(At + (16 * ch + 4 * i + (lane >> 4)) * CG_RS + (lane & 15) * 8) = o; } \
                if (!(LAST_)) { _Pragma("unroll") for (int i = 0; i < 4; ++i) an[d][i] = __builtin_nontemporal_load((const f32x4*)(rp[i] + (size_t)(kc + 4) * 512)); } \
            } else { \
                _Pragma("unroll") for (int i = 0; i < 2; ++i) *(LAS v4u*)(At + (16 * ch + 8 * i + (lane >> 3)) * CG_RS + (lane & 7) * 16) = anb[d][i]; \
                if (!(LAST_)) { _Pragma("unroll") for (int i = 0; i < 2; ++i) anb[d][i] = *(const v4u*)(ab + (size_t)(8 * i) * 1024 + (kc + 4) * 64); } \
            } \
            __syncthreads();                                           \
            bf16x8 ac[4]; \
            _Pragma("unroll") for (int ks = 0; ks < 4; ++ks) ac[ks] = *(const LAS bf16x8*)(At + q * CG_RS + ks * 32 + 16 * h_); \
            const LAS unsigned char* bb = F.lds + ((d) & 1) * CG_BUF + (128 * ch + q) * CG_RS + 16 * h_; \
            _Pragma("unroll") for (int ks = 0; ks < 4; ++ks) \
                _Pragma("unroll") for (int ct = 0; ct < 4; ++ct) { const bf16x8 bf = *(const LAS bf16x8*)(bb + ct * 32 * CG_RS + ks * 32); acc[ct] = mfma32(bf, ac[ks], acc[ct]); } \
            if (!(LAST_) || (d) < 3) { _Pragma("unroll") for (int x = 0; x < 4; ++x) *(LAS v4u*)(bdst + (((d) + 1) & 1) * CG_BUF + x * 16) = bst[((d) + 1) & 1][x]; } }
    int kc4 = 0;
#pragma unroll 1
    for (; kc4 < 12; kc4 += 4) { CG_CHUNK(0, false) CG_CHUNK(1, false) CG_CHUNK(2, false) CG_CHUNK(3, false) }
    { CG_CHUNK(0, true) CG_CHUNK(1, true) CG_CHUNK(2, true) CG_CHUNK(3, true) }
#undef CG_CHUNK
    bf16* LH = WSP(bf16, WS_LH) + ((size_t)j * CMP_ROWS_J + (smp ? grp * 512 : 32768 + grp * 256) + n00 + 32 * rg + q) * 256 + 128 * ch;
#pragma unroll
    for (int ct = 0; ct < 4; ++ct)
#pragma unroll
        for (int r4 = 0; r4 < 4; ++r4) { v2u o; o.x = pk2(acc[ct][4 * r4 + 0], acc[ct][4 * r4 + 1]); o.y = pk2(acc[ct][4 * r4 + 2], acc[ct][4 * r4 + 3]); *(v2u*)(LH + ct * 32 + 8 * r4 + 4 * h_) = o; }
}

constexpr int RS_KV = 272;
__device__ __forceinline__ void ret_local_unit(Frame& F, int unit) {
    const int bh = unit >> 5, c = unit & 31, b = bh >> 2, h = bh & 3, lane = F.lane, w = F.wave;
    const float lg = ret_log_g(h);
    LAS unsigned char* KS = F.lds; LAS unsigned char* VS = F.lds + 128 * RS_KV;
    const bf16* RK = WSP(bf16, WS_RQ) + (size_t)MT * 512; const bf16* RV = WSP(bf16, WS_RQ) + (size_t)2 * MT * 512;
    __syncthreads();
#pragma unroll
    for (int i = 0; i < 4; ++i) { const int p = F.tid + NTHR * i, j = p >> 4, ch = p & 15; const size_t go = (size_t)(b * PT + 128 * c + j) * 512 + h * 128 + ch * 8;
        f32x4 k0, k1; unpack8(*(const v4u*)(RK + go), k0, k1); const float kw = fexp((float)(127 - j) * lg);
        *(LAS v4u*)(KS + j * RS_KV + ch * 16) = pack8(k0 * kw, k1 * kw);
        *(LAS v4u*)(VS + j * RS_KV + ch * 16) = *(const v4u*)(RV + go); }
    __syncthreads();
    const int et = w >> 1, dt0 = 2 * (w & 1), h_ = lane >> 5, blk = (lane >> 4) & 1;
    f32x16 acc[2]; acc[0] = (f32x16){}; acc[1] = (f32x16){};
#pragma unroll
    for (int ks = 0; ks < 8; ++ks) {
        const int rA = 16 * ks + 8 * h_;
        const bf16x8 af = tr_frag(VS, RS_KV, rA, rA + 4, 32 * et + 16 * blk, lane);
#pragma unroll
        for (int dd = 0; dd < 2; ++dd) { const bf16x8 bfr = tr_frag(KS, RS_KV, rA, rA + 4, 32 * (dt0 + dd) + 16 * blk, lane); acc[dd] = mfma32(af, bfr, acc[dd]); }
    }
    bf16* LT = WSP(bf16, WS_LT) + ((size_t)bh * 32 + c) * 16384;
#pragma unroll
    for (int dd = 0; dd < 2; ++dd)
#pragma unroll
        for (int r = 0; r < 16; ++r) { const int e = 32 * et + (r & 3) + 8 * (r >> 2) + 4 * h_; LT[e * 128 + 32 * (dt0 + dd) + (lane & 31)] = (bf16)(pk2(acc[dd][r], 0.f) & 0xffffu); }
}
__device__ __forceinline__ void ret_scan_phase(Frame& F, int l) {
    const bf16* LT = WSP(bf16, WS_LT); bf16* SPT = WSP(bf16, WS_SPT);
    for (int idx = F.bid * NTHR + F.tid; idx < 16 * 16384; idx += F.G * NTHR) {
        const int bh = idx >> 14, ed = idx & 16383, e = ed >> 7, d = ed & 127, h = bh & 3; const float g128 = fexp(128.0f * ret_log_g(h));
        float S = 0.f;
        for (int c = 0; c < 32; ++c) { const size_t o = ((size_t)bh * 32 + c) * 16384 + ed; SPT[o] = (bf16)(pk2(S, 0.f) & 0xffffu); S = S * g128 + bf1(LT[o]); }
        F.out[OUT_RET_P + ((size_t)l * 16 + bh) * 16384 + d * 128 + e] = S;
    }
}
__device__ __forceinline__ void ret_out_unit(Frame& F, int l, int unit) {
    const int bh = unit >> 5, c = unit & 31, b = bh >> 2, h = bh & 3, lane = F.lane, w = F.wave, tid = F.tid;
    const float lg = ret_log_g(h);
    LAS unsigned char* KS = F.lds; LAS unsigned char* VS = F.lds + 128 * RS_KV; LAS float* OT = (LAS float*)F.lds; LAS float* STAT = (LAS float*)(F.lds + 2 * 128 * RS_KV);
    const bf16* RQ = WSP(bf16, WS_RQ); const bf16* RK = RQ + (size_t)MT * 512; const bf16* RV = RQ + (size_t)2 * MT * 512; const bf16* RG = RQ + (size_t)3 * MT * 512;
    const size_t row0 = (size_t)b * PT + 128 * c;
    __syncthreads();
#pragma unroll
    for (int i = 0; i < 4; ++i) { const int p = tid + NTHR * i, j = p >> 4, ch = p & 15; const size_t go = (row0 + j) * 512 + h * 128 + ch * 8;
        *(LAS v4u*)(KS + j * RS_KV + ch * 16) = *(const v4u*)(RK + go); *(LAS v4u*)(VS + j * RS_KV + ch * 16) = *(const v4u*)(RV + go); }
    const int it = w & 3, eh = w >> 2, h_ = lane >> 5, blk = (lane >> 4) & 1, il = 32 * it + (lane & 31);
    bf16x8 qf[8];
#pragma unroll
    for (int ks = 0; ks < 8; ++ks) qf[ks] = *(const bf16x8*)(RQ + (row0 + il) * 512 + h * 128 + 16 * ks + 8 * h_);
    f32x16 acc[2]; acc[0] = (f32x16){}; acc[1] = (f32x16){};
    const bf16* SP = WSP(bf16, WS_SPT) + ((size_t)bh * 32 + c) * 16384;
#pragma unroll
    for (int kb4 = 0; kb4 < 8; kb4 += 4) {
        bf16x8 af[4][2];
#pragma unroll
        for (int ks = 0; ks < 4; ++ks)
#pragma unroll
            for (int e2 = 0; e2 < 2; ++e2) af[ks][e2] = *(const bf16x8*)(SP + (size_t)(32 * (2 * eh + e2) + (lane & 31)) * 128 + 16 * (kb4 + ks) + 8 * h_);
#pragma unroll
        for (int ks = 0; ks < 4; ++ks)
#pragma unroll
            for (int e2 = 0; e2 < 2; ++e2) acc[e2] = mfma32(af[ks][e2], qf[kb4 + ks], acc[e2]);
    }
    { const float cr = fexp((float)(il + 1) * lg); acc[0] *= cr; acc[1] *= cr; }
    __syncthreads();
    for (int jt = 0; jt <= it; ++jt) {
        f32x16 s = (f32x16){};
#pragma unroll
        for (int ks = 0; ks < 8; ++ks) { const bf16x8 kf = *(const LAS bf16x8*)(KS + (32 * jt + (lane & 31)) * RS_KV + (16 * ks + 8 * h_) * 2); s = mfma32(kf, qf[ks], s); }
#pragma unroll
        for (int r = 0; r < 16; ++r) { const int j = 32 * jt + (r & 3) + 8 * (r >> 2) + 4 * h_; const int df = il - j; s[r] = (df >= 0) ? s[r] * fexp((float)df * lg) : 0.f; }
#pragma unroll
        for (int s2 = 0; s2 < 2; ++s2) { const bf16x8 pf = cvt_frag(s, s2); const int rA = 32 * jt + 16 * s2 + 4 * h_;
#pragma unroll
            for (int e2 = 0; e2 < 2; ++e2) { const bf16x8 vf = tr_frag(VS, RS_KV, rA, rA + 8, 32 * (2 * eh + e2) + 16 * blk, lane); acc[e2] = mfma32(vf, pf, acc[e2]); } }
    }
    float s1 = 0.f, s2 = 0.f;
#pragma unroll
    for (int e2 = 0; e2 < 2; ++e2)
#pragma unroll
        for (int r = 0; r < 16; ++r) { const float v = acc[e2][r]; s1 += v; s2 += v * v; }
    s1 += __shfl_xor(s1, 32); s2 += __shfl_xor(s2, 32);
    if (lane < 32) { STAT[(w * 32 + lane) * 2] = s1; STAT[(w * 32 + lane) * 2 + 1] = s2; }
    __syncthreads();
    { const int pw = w ^ 4; s1 += STAT[(pw * 32 + (lane & 31)) * 2]; s2 += STAT[(pw * 32 + (lane & 31)) * 2 + 1]; }
    const float mean = s1 * (1.0f / 128.0f), var = fmaxf(s2 * (1.0f / 128.0f) - mean * mean, 0.f), rstd = 1.0f / sqrtf(var + EPS);
#pragma unroll
    for (int e2 = 0; e2 < 2; ++e2)
#pragma unroll
        for (int r4 = 0; r4 < 4; ++r4) { const int e = 32 * (2 * eh + e2) + 8 * r4 + 4 * h_;
            f32x4 v; v[0] = (acc[e2][4 * r4 + 0] - mean) * rstd; v[1] = (acc[e2][4 * r4 + 1] - mean) * rstd; v[2] = (acc[e2][4 * r4 + 2] - mean) * rstd; v[3] = (acc[e2][4 * r4 + 3] - mean) * rstd;
            *(LAS f32x4*)(OT + il * 132 + e) = v; }
    __syncthreads();
    const float* GN = FIN(I_GNG) + l * 512 + h * 128; bf16* OR_ = WSP(bf16, WS_OA) + (size_t)MT * 512;
    {   const int ch = tid & 15; const f32x4 g0 = *(const f32x4*)(GN + 8 * ch), g1 = *(const f32x4*)(GN + 8 * ch + 4);
        v4u rgw[4];
#pragma unroll
        for (int k = 0; k < 4; ++k) { const int i = (tid + NTHR * k) >> 4; rgw[k] = *(const v4u*)(RG + (row0 + i) * 512 + h * 128 + 8 * ch); }
#pragma unroll
        for (int k = 0; k < 4; ++k) { const int i = (tid + NTHR * k) >> 4;
            const f32x4 o0 = *(const LAS f32x4*)(OT + i * 132 + 8 * ch), o1 = *(const LAS f32x4*)(OT + i * 132 + 8 * ch + 4);
            f32x4 r0, r1; unpack8(rgw[k], r0, r1);
            f32x4 y0, y1;
#pragma unroll
            for (int x = 0; x < 4; ++x) { y0[x] = o0[x] * g0[x] * siluf_(r0[x]); y1[x] = o1[x] * g1[x] * siluf_(r1[x]); }
            *(v4u*)(OR_ + (row0 + i) * 512 + h * 128 + 8 * ch) = pack8(y0, y1); }
    }
}
__device__ __forceinline__ void ret_sample_unit(Frame& F, int l, int unit) {
    const int db = unit >> 2, h = unit & 3, tid = F.tid, e = tid & 127, dp = tid >> 7;
    const float lg = ret_log_g(h);
    LAS float* Q = (LAS float*)F.lds; LAS float* K = Q + 1024; LAS float* V = K + 1024; LAS float* GT = V + 1024; LAS float* CR = GT + 1024;
    LAS float* SC = CR + 4096; LAS float* RED = SC + 64;
    const bf16* RQ = WSP(bf16, WS_RQ); const size_t row0 = (size_t)PM + db * 8;
    __syncthreads();
    for (int i = tid; i < 4096; i += NTHR) { const int which = i >> 10, r = (i >> 7) & 7, d = i & 127; const float v = bf1(RQ[(size_t)which * MT * 512 + (row0 + r) * 512 + h * 128 + d]); Q[which * 1024 + r * 128 + d] = v; }
    __syncthreads();
    const float* S0 = FIN(I_SRET) + (((size_t)l * SB + db) * 4 + h) * 16384; float* SN = F.out + OUT_RET_S + (((size_t)l * SB + db) * 4 + h) * 16384;
    float kwv[8], cr[8];
#pragma unroll
    for (int j = 0; j < 8; ++j) { kwv[j] = V[j * 128 + e] * fexp((float)(7 - j) * lg); cr[j] = 0.f; }
    const float g8 = fexp(8.0f * lg);
    {   float s0v[32];
#pragma unroll
        for (int dd = 0; dd < 32; ++dd) s0v[dd] = S0[(dp * 32 + dd) * 128 + e];
#pragma unroll
        for (int dd = 0; dd < 32; ++dd) { const int d = dp * 32 + dd; const float s0 = s0v[dd]; float sn = g8 * s0;
#pragma unroll
            for (int j = 0; j < 8; ++j) { cr[j] += Q[j * 128 + d] * s0; sn += K[j * 128 + d] * kwv[j]; }
            SN[d * 128 + e] = sn; }
    }
#pragma unroll
    for (int i = 0; i < 8; ++i) CR[(dp * 8 + i) * 128 + e] = cr[i];
    if (tid < 64) { const int i = tid >> 3, j = tid & 7; float s = 0.f; if (j <= i) { for (int d = 0; d < 128; ++d) s += Q[i * 128 + d] * K[j * 128 + d]; s *= fexp((float)(i - j) * lg); } SC[tid] = s; }
    __syncthreads();
    float o[2];
#pragma unroll
    for (int ii = 0; ii < 2; ++ii) { const int i = 2 * dp + ii; float x = (CR[(0 * 8 + i) * 128 + e] + CR[(1 * 8 + i) * 128 + e] + CR[(2 * 8 + i) * 128 + e] + CR[(3 * 8 + i) * 128 + e]) * fexp((float)(i + 1) * lg);
        for (int j = 0; j <= i; ++j) x += SC[i * 8 + j] * V[j * 128 + e];
        o[ii] = x; }
#pragma unroll
    for (int ii = 0; ii < 2; ++ii) { const float a = wave_sum(o[ii]), q = wave_sum(o[ii] * o[ii]); if (F.lane == 0) { RED[(F.wave * 2 + ii) * 2] = a; RED[(F.wave * 2 + ii) * 2 + 1] = q; } }
    __syncthreads();
    const float* GN = FIN(I_GNG) + l * 512 + h * 128; bf16* OR_ = WSP(bf16, WS_OA) + (size_t)MT * 512;
#pragma unroll
    for (int ii = 0; ii < 2; ++ii) { const int i = 2 * dp + ii, w0 = 2 * dp; const float s1 = RED[(w0 * 2 + ii) * 2] + RED[((w0 + 1) * 2 + ii) * 2], s2 = RED[(w0 * 2 + ii) * 2 + 1] + RED[((w0 + 1) * 2 + ii) * 2 + 1];
        const float mean = s1 * (1.0f / 128.0f), var = fmaxf(s2 * (1.0f / 128.0f) - mean * mean, 0.f), rstd = 1.0f / sqrtf(var + EPS);
        const float y = (o[ii] - mean) * rstd * GN[e] * siluf_(GT[i * 128 + e]);
        OR_[(row0 + i) * 512 + h * 128 + e] = (bf16)(pk2(y, 0.f) & 0xffffu); }
}

template <int MODE> __device__ __forceinline__ void rglru_unit(Frame& F, int l, int unit) {
    const int tid = F.tid, c = tid, lane = F.lane, w = F.wave;
    LAS bf16* XC = (LAS bf16*)F.lds; LAS float* G = (LAS float*)(F.lds + 16384);
    const int seq = (MODE == 2) ? unit : (unit >> 6), tile = (MODE == 2) ? 0 : (unit & 63);
    const size_t row0 = (MODE == 2) ? (size_t)PM + seq * 8 : (size_t)seq * PT + tile * 64;
    const int ntok = (MODE == 2) ? 8 : 64, nsub = (MODE == 2) ? 1 : 4;
    const float* RX = WSP(float, WS_RX);
    const float w0 = FIN(I_RCW)[(l * 4 + 0) * 512 + c], w1 = FIN(I_RCW)[(l * 4 + 1) * 512 + c], w2 = FIN(I_RCW)[(l * 4 + 2) * 512 + c], w3 = FIN(I_RCW)[(l * 4 + 3) * 512 + c], cb = FIN(I_RCB)[l * 512 + c];
    const float ba = FIN(I_RBA)[l * 512 + c], bx = FIN(I_RBX)[l * 512 + c], sp = WSP(float, WS_SMALLW + SW_SP)[l * 512 + c];
    float x3, x2, x1;
    if (MODE == 2) { const float* cv = FIN(I_SCONV) + ((size_t)l * SB + seq) * 3 * 512; x3 = cv[c]; x2 = cv[512 + c]; x1 = cv[1024 + c]; }
    else if (tile == 0) { x3 = 0.f; x2 = 0.f; x1 = 0.f; }
    else { x3 = RX[(row0 - 3) * 512 + c]; x2 = RX[(row0 - 2) * 512 + c]; x1 = RX[(row0 - 1) * 512 + c]; }
    float h = (MODE == 0) ? 0.f : (MODE == 1) ? WSP(float, WS_CAR)[(size_t)4 * 64 * 2 * 512 + ((size_t)seq * 64 + tile) * 512 + c] : FIN(I_SH)[((size_t)l * SB + seq) * 512 + c];
    float aprod = 1.f;
    const int r16 = lane & 15, g4 = lane >> 4;
    bf16x8 wa[4][2], wx[4][2];
    { const bf16* WA = WSP(bf16, WS_SMALLW + SW_WAT) + ((size_t)(l * 2 + 0) * 8 + w) * 4096; const bf16* WX = WSP(bf16, WS_SMALLW + SW_WAT) + ((size_t)(l * 2 + 1) * 8 + w) * 4096;
#pragma unroll
      for (int ct = 0; ct < 4; ++ct)
#pragma unroll
          for (int ks = 0; ks < 2; ++ks) { wa[ct][ks] = *(const bf16x8*)(WA + (16 * ct + r16) * 64 + 32 * ks + 8 * g4); wx[ct][ks] = *(const bf16x8*)(WX + (16 * ct + r16) * 64 + 32 * ks + 8 * g4); } }
    const bf16* GG = WSP(bf16, WS_GG); bf16* OC = WSP(bf16, WS_OA) + (size_t)2 * MT * 512;
    __syncthreads();
    float xn[16]; bf16 gn[16];
#pragma unroll
    for (int tt = 0; tt < 16; ++tt) { xn[tt] = (tt < ntok) ? RX[(row0 + tt) * 512 + c] : 0.f; gn[tt] = (MODE != 0 && tt < ntok) ? GG[(row0 + tt) * 512 + c] : (bf16)0; }
    for (int s = 0; s < nsub; ++s) {
        float xc[16], gg[16];
#pragma unroll
        for (int tt = 0; tt < 16; ++tt) { xc[tt] = xn[tt]; gg[tt] = bf1(gn[tt]); }
        if (s + 1 < nsub) {
#pragma unroll
            for (int tt = 0; tt < 16; ++tt) { const int t = (s + 1) * 16 + tt; xn[tt] = RX[(row0 + t) * 512 + c]; gn[tt] = (MODE != 0) ? GG[(row0 + t) * 512 + c] : (bf16)0; } }
#pragma unroll
        for (int tt = 0; tt < 16; ++tt) { const float x0 = xc[tt];
            xc[tt] = cb + w0 * x3 + w1 * x2 + w2 * x1 + w3 * x0; x3 = x2; x2 = x1; x1 = x0; XC[tt * 512 + c] = (bf16)(pk2(xc[tt], 0.f) & 0xffffu); }
        LDS_WAIT(); asm volatile("" ::: "memory");
        {
            bf16x8 xf[2];
#pragma unroll
            for (int ks = 0; ks < 2; ++ks) xf[ks] = *(const LAS bf16x8*)(XC + r16 * 512 + w * 64 + 32 * ks + 8 * g4);
#pragma unroll
            for (int ct = 0; ct < 4; ++ct) { f32x4 da = (f32x4){0.f, 0.f, 0.f, 0.f}, dx = da;
#pragma unroll
                for (int ks = 0; ks < 2; ++ks) { da = mfma16(wa[ct][ks], xf[ks], da); dx = mfma16(wx[ct][ks], xf[ks], dx); }
                *(LAS f32x4*)(G + r16 * 512 + w * 64 + 16 * ct + 4 * g4) = da; *(LAS f32x4*)(G + 8192 + r16 * 512 + w * 64 + 16 * ct + 4 * g4) = dx; }
        }
        LDS_WAIT(); asm volatile("" ::: "memory");
#pragma unroll
        for (int tt = 0; tt < 16; ++tt) { const int t = s * 16 + tt;
            if (t < ntok) {
                const float r = sigmoidf_(G[tt * 512 + c] + ba), ig = sigmoidf_(G[8192 + tt * 512 + c] + bx);
                const float la = -8.0f * r * sp, a = fexp(la), bt = sqrtf(fmaxf(1.0f - a * a, 0.f)) * (ig * xc[tt]);
                h = a * h + bt; aprod *= a;
                if (MODE != 0) { const size_t o = (row0 + t) * 512 + c; OC[o] = (bf16)(pk2(h * gg[tt], 0.f) & 0xffffu); }
            } }
    }
    if (MODE == 0) { float* CAR = WSP(float, WS_CAR) + ((size_t)seq * 64 + tile) * 1024; CAR[c] = aprod; CAR[512 + c] = h; }
    if (MODE == 2) F.out[OUT_H_S + ((size_t)l * SB + seq) * 512 + c] = h;
}
__device__ __forceinline__ void rglru_carry_phase(Frame& F, int l) {
    const float* CAR = WSP(float, WS_CAR); float* HIN = WSP(float, WS_CAR) + (size_t)4 * 64 * 2 * 512;
    for (int idx = F.bid * NTHR + F.tid; idx < PB * 512; idx += F.G * NTHR) {
        const int b = idx >> 9, c = idx & 511; float h = 0.f;
#pragma unroll 1
        for (int t0 = 0; t0 < 64; t0 += 32) {
            float ca[32], cb[32];
#pragma unroll
            for (int t = 0; t < 32; ++t) { const float* cr = CAR + ((size_t)b * 64 + t0 + t) * 1024; ca[t] = cr[c]; cb[t] = cr[512 + c]; }
#pragma unroll
            for (int t = 0; t < 32; ++t) { HIN[((size_t)b * 64 + t0 + t) * 512 + c] = h; h = ca[t] * h + cb[t]; }
        }
        F.out[OUT_H_P + ((size_t)l * PB + b) * 512 + c] = h;
    }
}

__device__ __forceinline__ void convact_rows(Frame& F, int l, size_t row0, int nrows, bool smp) {
    const bf16* GP = WSP(bf16, WS_GP); const bf16* VAL = GP + (size_t)MT * DFF; bf16* ACT = WSP(bf16, WS_GP) + (size_t)2 * MT * DFF;
    const float* CW = FIN(I_FCW) + (size_t)l * 3 * DFF; const float* CBI = FIN(I_FCB) + (size_t)l * DFF;
    constexpr int NCG = DFF / 8;
    for (int it = F.tid; it < nrows * NCG; it += NTHR) {
        const int rr = it / NCG, c = (it % NCG) * 8; const size_t row = row0 + rr;
        f32x4 xa, xb, p1a, p1b, p2a, p2b, va, vb;
        const v4u gx = *(const v4u*)(GP + row * DFF + c), vx = *(const v4u*)(VAL + row * DFF + c);
        if (!smp) { v4u g1 = *(const v4u*)(GP + (row - 1) * DFF + c), g2 = *(const v4u*)(GP + (row - 2) * DFF + c); unpack8(g1, p1a, p1b); unpack8(g2, p2a, p2b); }
        else { const int sr = (int)(row - PM), seq = sr >> 3, i = sr & 7; const float* st = FIN(I_SFFN) + (((size_t)l * SB + seq) * 2) * DFF + c;
            if (i >= 1) unpack8(*(const v4u*)(GP + (row - 1) * DFF + c), p1a, p1b); else { p1a = *(const f32x4*)(st + DFF); p1b = *(const f32x4*)(st + DFF + 4); }
            if (i >= 2) unpack8(*(const v4u*)(GP + (row - 2) * DFF + c), p2a, p2b); else { const float* s2 = st + (i == 1 ? DFF : 0); p2a = *(const f32x4*)s2; p2b = *(const f32x4*)(s2 + 4); } }
        unpack8(gx, xa, xb); unpack8(vx, va, vb);
        const f32x4 w0a = *(const f32x4*)(CW + c), w0b = *(const f32x4*)(CW + c + 4), w1a = *(const f32x4*)(CW + DFF + c), w1b = *(const f32x4*)(CW + DFF + c + 4), w2a = *(const f32x4*)(CW + 2 * DFF + c), w2b = *(const f32x4*)(CW + 2 * DFF + c + 4);
        f32x4 ya = *(const f32x4*)(CBI + c) + w0a * p2a + w1a * p1a + w2a * xa, yb = *(const f32x4*)(CBI + c + 4) + w0b * p2b + w1b * p1b + w2b * xb;
#pragma unroll
        for (int k = 0; k < 4; ++k) { ya[k] = siluf_(ya[k]) * va[k]; yb[k] = siluf_(yb[k]) * vb[k]; }
        *(v4u*)(ACT + row * DFF + c) = pack8(ya, yb);
    }
}

constexpr int AT_RS = 144;
constexpr int AT_K0 = 0, AT_V0 = 2 * 64 * AT_RS, AT_PS = 4 * 64 * AT_RS, AT_IMP = AT_PS + 69632, AT_MASK = AT_IMP + 6144, AT_LIST = AT_MASK + 2048, AT_NL = AT_LIST + 1024;
constexpr unsigned AT_MARK = 0xFFFFu;
static_assert(AT_NL + 64 <= RING_BYTES, "attention LDS map");

struct TileRegs { v4u a, b, c, d; int mode; };

template <bool SMP> __device__ __forceinline__ void at_prefetch(const Frame& F, int l, int seq, int kvh, unsigned e, TileRegs& R) {
    const int kind = (int)(e >> 14), ti = (int)(e & 0x3fffu), rr = F.tid >> 3, pc = F.tid & 7;
    R.mode = 0;
    if (kind < 2) {
        const size_t rb = SMP ? (size_t)(seq * 2 + kvh) * 512 : (size_t)32768 + (size_t)(seq * 2 + kvh) * 256;
        const bf16* ck = WSP(bf16, WS_CK) + (rb + ti * 64 + rr) * 64 + pc * 8;
        R.a = *(const v4u*)ck; R.c = *(const v4u*)(ck + (size_t)CMP_ROWS_J * 64);
    } else if (!SMP) {
        const int jb = (kind == 2) ? 0 : 2;
        const bf16* kp = WSP(bf16, WS_KVB) + ((((size_t)jb * PB + seq) * 2 + kvh) * PT + ti * 64 + rr) * 64 + pc * 8;
        R.a = *(const v4u*)kp; R.c = *(const v4u*)(kp + (size_t)PB * 2 * PT * 64);
    } else if (kind == 2) {
        if (ti < 128) {
            const int page = ((const int*)F.a->in[I_PT])[seq * NPG + (ti >> 1)], slot = (ti & 1) * 64 + rr;
            const float* kp = FIN(I_CACHE) + (((((size_t)l * NPHYS + page) * PAGE + slot) * 4 + 2) * 2 + kvh) * 64 + pc * 8;
            R.a = *(const v4u*)kp; R.b = *(const v4u*)(kp + 4); R.c = *(const v4u*)(kp + 128); R.d = *(const v4u*)(kp + 132); R.mode = 1;
        } else if (rr < ST) {
            const bf16* kp = WSP(bf16, WS_KVS) + ((((size_t)0 * SB + seq) * 2 + kvh) * ST + rr) * 64 + pc * 8;
            R.a = *(const v4u*)kp; R.c = *(const v4u*)(kp + (size_t)SB * 2 * ST * 64);
        } else R.mode = 2;
    } else {
        if (ti < 8) {
            const float* kp = FIN(I_CWIN) + (((((size_t)l * SB + seq) * WINB + ti * 64 + rr) * 2 + 0) * 2 + kvh) * 64 + pc * 8;
            R.a = *(const v4u*)kp; R.b = *(const v4u*)(kp + 4); R.c = *(const v4u*)(kp + 128); R.d = *(const v4u*)(kp + 132); R.mode = 1;
        } else if (rr < ST) {
            const bf16* kp = WSP(bf16, WS_KVS) + ((((size_t)2 * SB + seq) * 2 + kvh) * ST + rr) * 64 + pc * 8;
            R.a = *(const v4u*)kp; R.c = *(const v4u*)(kp + (size_t)SB * 2 * ST * 64);
        } else R.mode = 2;
    }
}
__device__ __forceinline__ void at_store(const Frame& F, int buf, const TileRegs& R) {
    const int rr = F.tid >> 3, pc = F.tid & 7; v4u k, v;
    if (R.mode == 0) { k = R.a; v = R.c; }
    else if (R.mode == 1) { k = pack8(__builtin_bit_cast(f32x4, R.a), __builtin_bit_cast(f32x4, R.b)); v = pack8(__builtin_bit_cast(f32x4, R.c), __builtin_bit_cast(f32x4, R.d)); }
    else { k = (v4u){0u, 0u, 0u, 0u}; v = k; }
    *(LAS v4u*)(F.lds + AT_K0 + buf * 64 * AT_RS + rr * AT_RS + pc * 16) = k;
    *(LAS v4u*)(F.lds + AT_V0 + buf * 64 * AT_RS + rr * AT_RS + pc * 16) = v;
}

template <bool SMP> __device__ __forceinline__ void attn_unit(Frame& F, int l, int unit) {
    const int tid = F.tid, lane = F.lane, w = F.wave;
    const int q = lane & 31, h_ = lane >> 5, blk = (lane >> 4) & 1, tl = q >> 2, hr = q & 3;
    int seq, kvh, qt;
    if (SMP) { seq = unit >> 1; kvh = unit & 1; qt = 128; } else { seq = unit >> 7; kvh = (unit >> 6) & 1; qt = unit & 63; }
    const int t0 = SMP ? PAST : qt * 64;
    const int tokl = SMP ? tl : 8 * w + tl, t = t0 + tokl;
    const size_t row = SMP ? (size_t)PM + seq * ST + tl : (size_t)seq * PT + t;
    const int head = kvh * 4 + hr;
    LAS float* PS = (LAS float*)(F.lds + AT_PS); LAS float* IMPw = (LAS float*)(F.lds + AT_IMP) + w * 192;
    LAS unsigned long long* MASKS = (LAS unsigned long long*)(F.lds + AT_MASK); LAS unsigned short* LIST = (LAS unsigned short*)(F.lds + AT_LIST); LAS int* NL = (LAS int*)(F.lds + AT_NL);
    constexpr int PSS = SMP ? 520 : 264;
    LAS float* PSw = SMP ? PS : PS + w * 8 * PSS;
    __syncthreads();
    bf16x8 qf[4];
    { const bf16* qp = WSP(bf16, WS_QN) + row * 512 + head * 64 + 8 * h_;
#pragma unroll
      for (int kk = 0; kk < 4; ++kk) qf[kk] = *(const bf16x8*)(qp + 16 * kk); }
    const float* ngp = WSP(float, WS_NG) + row * 24 + head * 3; const float g0 = ngp[0], g1 = ngp[1], g2 = ngp[2];
    if (!SMP) { for (int i = lane; i < 8 * PSS; i += 64) PSw[i] = 0.f; }
    const int ntc = SMP ? 8 : ((t0 + 32) >> 10) + 1;
    if (tid < 2 * ntc) LIST[tid] = (unsigned short)(((tid >= ntc ? 1u : 0u) << 14) | (unsigned)(tid >= ntc ? tid - ntc : tid));
    if (tid == 0) LIST[2 * ntc] = (unsigned short)AT_MARK;
    int nl = 2 * ntc + 1;
    TileRegs R;
    at_prefetch<SMP>(F, l, seq, kvh, (unsigned)0, R);
    at_store(F, 0, R);
    __syncthreads();
    float m = -INFINITY, lsum = 0.f, invden = 0.f;
    f32x16 O[2]; O[0] = (f32x16){}; O[1] = (f32x16){};
    LAS float* OAw = (LAS float*)(F.lds + AT_PS) + w * (SMP ? 2048 : 8 * PSS) + lane;
    unsigned long long mk0 = 0ull, mk1 = 0ull, wu = ~0ull;
    int cur_kind = -1, idx = 0;
#define AT_FINALIZE(kind) do { \
        if ((kind) == 0) { const float lt = lsum + __shfl_xor(lsum, 32); invden = lt > 0.f ? 1.0f / lt : 0.f; } \
        else if ((kind) == 1) { const float sc = g0 * invden; O[0] *= sc; O[1] *= sc; } \
        else if ((kind) == 2) { const float lt = lsum + __shfl_xor(lsum, 32); const float sc = (lt > 0.f ? 1.0f / lt : 0.f) * g1; \
            _Pragma("unroll") for (int r_ = 0; r_ < 16; ++r_) { OAw[r_ * 64] += O[0][r_] * sc; OAw[(16 + r_) * 64] += O[1][r_] * sc; } } } while (0)
    while (idx < nl) {
        const unsigned e = (unsigned)__builtin_amdgcn_readfirstlane((int)LIST[idx]);
        if (e == AT_MARK) {
            AT_FINALIZE(cur_kind); cur_kind = -1;
            LDS_WAIT(); asm volatile("" ::: "memory");
#pragma unroll 1
            for (int tk = 0; tk < 8; ++tk) {
                const LAS float* pr = PSw + tk * PSS;
                if (!SMP) {
                    const int s = lane; float imp = 0.f;
#pragma unroll
                    for (int n = 4 * s - 1; n <= 4 * s + 3; ++n) if (n >= 0) imp += pr[n];
                    const bool forced = (s == 0) || (s == qt) || (s == qt - 1), avail = s <= qt;
                    const float val = avail ? (forced ? 1e4f : imp) : -1e4f;
                    IMPw[s] = val; LDS_WAIT(); asm volatile("" ::: "memory");
                    int rank = 0;
#pragma unroll 8
                    for (int i = 0; i < 64; ++i) { const float v = IMPw[i]; rank += (v > val || (v == val && i < s)) ? 1 : 0; }
                    const unsigned long long mk = __ballot(rank < 16);
                    if (lane == 0) MASKS[(8 * w + tk) * 4] = mk;
                    LDS_WAIT(); asm volatile("" ::: "memory");
                } else {
                    const int sa = lane, sb = lane + 64; float ia = 0.f, ib = 0.f;
#pragma unroll
                    for (int n = 4 * sa - 1; n <= 4 * sa + 3; ++n) if (n >= 0) ia += pr[n];
#pragma unroll
                    for (int n = 4 * sb - 1; n <= 4 * sb + 3; ++n) ib += pr[n];
                    const bool fa = (sa == 0), fb = (sb == 127);
                    const float va = fa ? 1e4f : ia, vb = fb ? 1e4f : ib;
                    IMPw[sa] = va; IMPw[sb] = vb; LDS_WAIT(); asm volatile("" ::: "memory");
                    int ra = fa ? 0 : 1, rb = fb ? 0 : 1;
#pragma unroll 8
                    for (int i = 0; i < 128; ++i) { const float v = IMPw[i]; ra += (v > va || (v == va && i < sa)) ? 1 : 0; rb += (v > vb || (v == vb && i < sb)) ? 1 : 0; }
                    const unsigned long long ma = __ballot(ra < 16), mb = __ballot(rb < 16);
                    if (lane == 0) { MASKS[tk * 4] = ma; MASKS[tk * 4 + 1] = mb; MASKS[tk * 4 + 2] = 1ull; }
                    LDS_WAIT(); asm volatile("" ::: "memory");
                }
            }
            __syncthreads();
#pragma unroll
            for (int r_ = 0; r_ < 16; ++r_) { OAw[r_ * 64] = O[0][r_]; OAw[(16 + r_) * 64] = O[1][r_]; }
            if (tid == 0) {
                int n = idx + 1;
                if (!SMP) { unsigned long long U = 0ull; for (int i = 0; i < 64; ++i) U |= MASKS[i * 4];
                    for (int s = 0; s <= qt; ++s) if ((U >> s) & 1ull) LIST[n++] = (unsigned short)((2u << 14) | (unsigned)s);
                    for (int s = (qt > 8 ? qt - 8 : 0); s <= qt; ++s) LIST[n++] = (unsigned short)((3u << 14) | (unsigned)s);
                } else { unsigned long long U0 = 0ull, U1 = 0ull; for (int i = 0; i < 8; ++i) { U0 |= MASKS[i * 4]; U1 |= MASKS[i * 4 + 1]; }
                    for (int s = 0; s < 64; ++s) if ((U0 >> s) & 1ull) LIST[n++] = (unsigned short)((2u << 14) | (unsigned)s);
                    for (int s = 0; s < 64; ++s) if ((U1 >> s) & 1ull) LIST[n++] = (unsigned short)((2u << 14) | (unsigned)(64 + s));
                    LIST[n++] = (unsigned short)((2u << 14) | 128u);
                    for (int s = 0; s <= 8; ++s) LIST[n++] = (unsigned short)((3u << 14) | (unsigned)s); }
                NL[0] = n;
            }
            __syncthreads();
            nl = __builtin_amdgcn_readfirstlane(NL[0]);
            mk0 = MASKS[tokl * 4]; if (SMP) { mk1 = MASKS[tokl * 4 + 1]; }
            if (!SMP) { unsigned long long u = 0ull; for (int i = 0; i < 8; ++i) u |= MASKS[(8 * w + i) * 4]; wu = u; }
            if (idx + 1 < nl) { at_prefetch<SMP>(F, l, seq, kvh, (unsigned)LIST[idx + 1], R); at_store(F, (idx + 1) & 1, R); }
            __syncthreads();
            ++idx; continue;
        }
        const int kind = (int)(e >> 14), ti = (int)(e & 0x3fffu);
        if (kind != cur_kind) {
            if (cur_kind >= 0) AT_FINALIZE(cur_kind);
            if (kind != 1) m = -INFINITY;
            lsum = 0.f; O[0] = (f32x16){}; O[1] = (f32x16){}; cur_kind = kind;
        }
        const unsigned en = (idx + 1 < nl) ? (unsigned)__builtin_amdgcn_readfirstlane((int)LIST[idx + 1]) : AT_MARK;
        const bool have_next = (en != AT_MARK);
        if (have_next) at_prefetch<SMP>(F, l, seq, kvh, en, R);
        bool active = true;
        if (!SMP && kind == 2) active = ((wu >> ti) & 1ull) != 0ull;
        if (active) {
            const LAS unsigned char* Kb = F.lds + AT_K0 + (idx & 1) * 64 * AT_RS; const LAS unsigned char* Vb = F.lds + AT_V0 + (idx & 1) * 64 * AT_RS;
            int lo, hi; const int kb = 64 * ti;
            if (kind < 2) { lo = 0; hi = SMP ? 510 : ((t >= 31) ? ((t - 31) >> 4) : -1); }
            else if (kind == 2) { lo = 0; const unsigned long long mw = (ti < 64) ? mk0 : ((ti < 128) ? mk1 : 1ull); hi = ((mw >> (ti & 63)) & 1ull) ? t : -1; }
            else { if (SMP) { lo = tl; hi = WINB + tl; } else { lo = t - WINB; hi = t; } }
            f32x16 s0 = (f32x16){}, s1 = (f32x16){};
#pragma unroll
            for (int kk = 0; kk < 4; ++kk) {
                const bf16x8 k0 = *(const LAS bf16x8*)(Kb + q * AT_RS + (16 * kk + 8 * h_) * 2), k1 = *(const LAS bf16x8*)(Kb + (32 + q) * AT_RS + (16 * kk + 8 * h_) * 2);
                s0 = mfma32(k0, qf[kk], s0); s1 = mfma32(k1, qf[kk], s1);
            }
            float tmax = -INFINITY;
#pragma unroll
            for (int r = 0; r < 16; ++r) { const int key = kb + (r & 3) + 8 * (r >> 2) + 4 * h_;
                s0[r] = (key >= lo && key <= hi) ? s0[r] : -INFINITY; s1[r] = (key + 32 >= lo && key + 32 <= hi) ? s1[r] : -INFINITY;
                tmax = fmaxf(tmax, fmaxf(s0[r], s1[r])); }
            tmax = fmaxf(tmax, __shfl_xor(tmax, 32));
            const float m_new = fmaxf(m, tmax), m_use = (m_new == -INFINITY) ? 0.f : m_new;
            const float alpha = fexp2(m - m_use);
            float ps = 0.f;
#pragma unroll
            for (int r = 0; r < 16; ++r) { s0[r] = fexp2(s0[r] - m_use); s1[r] = fexp2(s1[r] - m_use); ps += s0[r] + s1[r]; }
            lsum = lsum * alpha + ps; m = m_new;
            if (kind != 0) {
                O[0] *= alpha; O[1] *= alpha;
#pragma unroll
                for (int kt2 = 0; kt2 < 2; ++kt2)
#pragma unroll
                    for (int s2 = 0; s2 < 2; ++s2) { const bf16x8 pf = cvt_frag(kt2 ? s1 : s0, s2); const int rA = 32 * kt2 + 16 * s2 + 4 * h_;
#pragma unroll
                        for (int dt = 0; dt < 2; ++dt) { const bf16x8 vf = tr_frag(Vb, AT_RS, rA, rA + 8, 32 * dt + 16 * blk, lane); O[dt] = mfma32(vf, pf, O[dt]); } }
            }
            if (kind == 1) {
#pragma unroll
                for (int r = 0; r < 16; ++r) { const int n = kb + (r & 3) + 8 * (r >> 2) + 4 * h_;
                    float a = s0[r] * invden, b = s1[r] * invden; a += __shfl_xor(a, 1); b += __shfl_xor(b, 1); a += __shfl_xor(a, 2); b += __shfl_xor(b, 2);
                    if (hr == 0) { PSw[tl * PSS + n] = a; PSw[tl * PSS + n + 32] = b; } }
            }
        }
        if (have_next) at_store(F, (idx + 1) & 1, R);
        __syncthreads();
        ++idx;
    }
#undef AT_FINALIZE
    {
        const float lt = lsum + __shfl_xor(lsum, 32); const float sc = (lt > 0.f ? 1.0f / lt : 0.f) * g2;
        if (!SMP || w == 0) {
            bf16* op = WSP(bf16, WS_OA) + row * 512 + head * 64;
#pragma unroll
            for (int dt = 0; dt < 2; ++dt)
#pragma unroll
                for (int r4 = 0; r4 < 4; ++r4) { float o_[4];
#pragma unroll
                    for (int x = 0; x < 4; ++x) o_[x] = OAw[(dt * 16 + 4 * r4 + x) * 64] + O[dt][4 * r4 + x] * sc;
                    v2u wv; wv.x = pk2(o_[0], o_[1]); wv.y = pk2(o_[2], o_[3]); *(v2u*)(op + 32 * dt + 8 * r4 + 4 * h_) = wv; }
        }
    }
}

constexpr int AS_RS = 144;
constexpr int AS_V = 0, AS_VW = 32 * AS_RS, AS_MRG = 0, AS_PS = 73728, AS_IMP = AS_PS + 16640, AS_MASK = AS_IMP + 6144, AS_OA = AS_MASK + 512;
static_assert(8 * 34 * 64 * 4 <= AS_PS && AS_OA + 32 * 64 * 4 <= RING_BYTES, "sample attention LDS map");

__device__ __forceinline__ float xhalf_max(float x) { auto t_ = __builtin_amdgcn_permlane32_swap(__float_as_uint(x), __float_as_uint(x), false, false); return fmaxf(__uint_as_float(t_[0]), __uint_as_float(t_[1])); }
__device__ __forceinline__ float xhalf_sum(float x) { auto t_ = __builtin_amdgcn_permlane32_swap(__float_as_uint(x), __float_as_uint(x), false, false); return __uint_as_float(t_[0]) + __uint_as_float(t_[1]); }
struct ASrc { const float* kf; const float* vf; const bf16* kb; const bf16* vb; int rs; int nvalid; };
#define AS_TILE(SRC, KB0, LO_, HI_, DO_PV, DO_PS, m, lsum, O0, O1, invden, PSS_) do { \
        bf16x8 kfr[4]; f32x4 vx_[8]; \
        if ((SRC).kb) { const bf16* kp_ = (SRC).kb + (size_t)q * (SRC).rs + 8 * h_; _Pragma("unroll") for (int kk = 0; kk < 4; ++kk) kfr[kk] = *(const bf16x8*)(kp_ + 16 * kk); } \
        else {   \
            f32x4 kx_[8]; _Pragma("unroll") for (int x = 0; x < 8; ++x) kx_[x] = *(const f32x4*)((SRC).kf + (size_t)(4 * x + (lane >> 4)) * (SRC).rs + (lane & 15) * 4); \
            _Pragma("unroll") for (int x = 0; x < 8; ++x) { v2u o_; o_.x = pk2(kx_[x][0], kx_[x][1]); o_.y = pk2(kx_[x][2], kx_[x][3]); *(LAS v2u*)(Vw + (4 * x + (lane >> 4)) * AS_RS + (lane & 15) * 8) = o_; } \
            LDS_WAIT(); asm volatile("" ::: "memory"); \
            _Pragma("unroll") for (int kk = 0; kk < 4; ++kk) kfr[kk] = *(const LAS bf16x8*)(Vw + q * AS_RS + (16 * kk + 8 * h_) * 2); \
            LDS_WAIT(); asm volatile("" ::: "memory"); \
            if (DO_PV) { _Pragma("unroll") for (int x = 0; x < 8; ++x) vx_[x] = *(const f32x4*)((SRC).vf + (size_t)(4 * x + (lane >> 4)) * (SRC).rs + (lane & 15) * 4); } }     \
        if (DO_PV) { const int vr_ = lane >> 1, vh_ = lane & 1; v4u vv_[4]; \
            if (vr_ >= (SRC).nvalid) { _Pragma("unroll") for (int x = 0; x < 4; ++x) vv_[x] = (v4u){0u, 0u, 0u, 0u}; } \
            else if ((SRC).vb) { const bf16* vp_ = (SRC).vb + (size_t)vr_ * (SRC).rs + 32 * vh_; _Pragma("unroll") for (int x = 0; x < 4; ++x) vv_[x] = *(const v4u*)(vp_ + 8 * x); } \
            if ((SRC).vb || vr_ >= (SRC).nvalid) { _Pragma("unroll") for (int x = 0; x < 4; ++x) *(LAS v4u*)(Vw + vr_ * AS_RS + vh_ * 64 + x * 16) = vv_[x]; } } \
        f32x16 s_ = (f32x16){}; \
        _Pragma("unroll") for (int kk = 0; kk < 4; ++kk) s_ = mfma32(kfr[kk], qf[kk], s_); \
        float tmax_ = -INFINITY; \
        _Pragma("unroll") for (int r = 0; r < 16; ++r) { const int key_ = (KB0) + (r & 3) + 8 * (r >> 2) + 4 * h_; s_[r] = (key_ >= (LO_) && key_ <= (HI_)) ? s_[r] : -INFINITY; tmax_ = fmaxf(tmax_, s_[r]); } \
        tmax_ = xhalf_max(tmax_); \
        const float mn_ = fmaxf(m, tmax_), mu_ = (mn_ == -INFINITY) ? 0.f : mn_, al_ = fexp2(m - mu_); float ps_ = 0.f; \
        _Pragma("unroll") for (int r = 0; r < 16; ++r) { s_[r] = fexp2(s_[r] - mu_); ps_ += s_[r]; } \
        lsum = lsum * al_ + ps_; m = mn_; \
        if (DO_PV) { O0 *= al_; O1 *= al_; \
            if (!(SRC).vb) { _Pragma("unroll") for (int x = 0; x < 8; ++x) { v2u o_; o_.x = pk2(vx_[x][0], vx_[x][1]); o_.y = pk2(vx_[x][2], vx_[x][3]); *(LAS v2u*)(Vw + (4 * x + (lane >> 4)) * AS_RS + (lane & 15) * 8) = o_; } } \
            LDS_WAIT(); asm volatile("" ::: "memory"); \
            _Pragma("unroll") for (int s2 = 0; s2 < 2; ++s2) { const bf16x8 pf_ = cvt_frag(s_, s2); const int rA_ = 16 * s2 + 4 * h_; \
                O0 = mfma32(tr_frag(Vw, AS_RS, rA_, rA_ + 8, 16 * blk, lane), pf_, O0); O1 = mfma32(tr_frag(Vw, AS_RS, rA_, rA_ + 8, 32 + 16 * blk, lane), pf_, O1); } \
            LDS_WAIT(); asm volatile("" ::: "memory"); } \
        if (DO_PS) { _Pragma("unroll") for (int r = 0; r < 16; ++r) { const int n_ = (KB0) + (r & 3) + 8 * (r >> 2) + 4 * h_; float a_ = s_[r] * (invden); a_ += __shfl_xor(a_, 1); a_ += __shfl_xor(a_, 2); if (hr == 0) PS[tl * (PSS_) + n_] = a_; } } \
    } while (0)

__device__ __forceinline__ void attn_sample_unit(Frame& F, int l, int unit) {
    const int lane = F.lane, w = F.wave, tid = F.tid;
    const int q = lane & 31, h_ = lane >> 5, blk = (lane >> 4) & 1, tl = q >> 2, hr = q & 3;
    const int seq = unit >> 1, kvh = unit & 1, head = kvh * 4 + hr;
    const size_t row = (size_t)PM + seq * ST + tl;
    LAS unsigned char* Vw = F.lds + AS_V + w * AS_VW;
    LAS float* MRG = (LAS float*)(F.lds + AS_MRG);
    LAS float* PS = (LAS float*)(F.lds + AS_PS);
    LAS float* IMPw = (LAS float*)(F.lds + AS_IMP) + w * 192;
    LAS unsigned long long* MASKS = (LAS unsigned long long*)(F.lds + AS_MASK);
    __syncthreads();
    bf16x8 qf[4];
    { const bf16* qp = WSP(bf16, WS_QN) + row * 512 + head * 64 + 8 * h_;
#pragma unroll
      for (int kk = 0; kk < 4; ++kk) qf[kk] = *(const bf16x8*)(qp + 16 * kk); }
    const float* ngp = WSP(float, WS_NG) + row * 24 + head * 3; const float g0 = ngp[0], g1 = ngp[1], g2 = ngp[2];
    const int* ptab = (const int*)F.a->in[I_PT] + seq * NPG;
    LAS float* OAL = (LAS float*)(F.lds + AS_OA) + lane;

#define AS_PUBLISH(m, lsum, O0, O1) do { __syncthreads(); LAS float* mp_ = MRG + w * 34 * 64 + lane; mp_[0] = m; mp_[64] = lsum; \
        _Pragma("unroll") for (int r = 0; r < 16; ++r) { mp_[(2 + r) * 64] = O0[r]; mp_[(18 + r) * 64] = O1[r]; } __syncthreads(); } while (0)

    const bf16* CKk = WSP(bf16, WS_CK) + ((size_t)(seq * 2 + kvh) * 512) * 64; const bf16* CKv = CKk + (size_t)CMP_ROWS_J * 64;
    float mC = -INFINITY, lC = 0.f; f32x16 D0 = (f32x16){}, D1 = (f32x16){};
#pragma unroll 1
    for (int ti = w; ti < 16; ti += 8) { ASrc S{nullptr, nullptr, CKk + (size_t)ti * 32 * 64, CKv + (size_t)ti * 32 * 64, 64, 32}; AS_TILE(S, ti * 32, 0, 510, false, false, mC, lC, D0, D1, 0.f, 520); }
    { __syncthreads(); MRG[w * 128 + lane] = mC; MRG[w * 128 + 64 + lane] = xhalf_sum(lC); __syncthreads(); }
    float mT = -INFINITY;
#pragma unroll
    for (int x = 0; x < 8; ++x) mT = fmaxf(mT, MRG[x * 128 + lane]);
    float lT = 0.f;
#pragma unroll
    for (int x = 0; x < 8; ++x) { const float mx_ = MRG[x * 128 + lane]; lT += (mx_ == -INFINITY) ? 0.f : MRG[x * 128 + 64 + lane] * fexp2(mx_ - mT); }
    const float invC = lT > 0.f ? 1.0f / lT : 0.f;
    __syncthreads();
    { float mB = mT, lB = 0.f;
#pragma unroll 1
      for (int ti = w; ti < 16; ti += 8) { ASrc S{nullptr, nullptr, CKk + (size_t)ti * 32 * 64, CKv + (size_t)ti * 32 * 64, 64, 32}; AS_TILE(S, ti * 32, 0, 510, true, true, mB, lB, D0, D1, invC, 520); }
      AS_PUBLISH(mB, lB, D0, D1); }
    if (w == 0) { const float sc = g0 * invC; f32x16 T0 = (f32x16){}, T1 = (f32x16){};
#pragma unroll 1
      for (int x = 0; x < 8; ++x) { const LAS float* mp = MRG + x * 34 * 64 + lane;
#pragma unroll
          for (int r = 0; r < 16; ++r) { T0[r] += mp[(2 + r) * 64] * sc; T1[r] += mp[(18 + r) * 64] * sc; } }
#pragma unroll
      for (int r = 0; r < 16; ++r) { OAL[r * 64] = T0[r]; OAL[(16 + r) * 64] = T1[r]; } }
    {
        const LAS float* pr = PS + w * 520; const int sa = lane, sb = lane + 64; float ia = 0.f, ib = 0.f;
#pragma unroll
        for (int n = 4 * sa - 1; n <= 4 * sa + 3; ++n) if (n >= 0) ia += pr[n];
#pragma unroll
        for (int n = 4 * sb - 1; n <= 4 * sb + 3; ++n) ib += pr[n];
        const bool fa = (sa == 0), fb = (sb == 127); const float va = fa ? 1e4f : ia, vb = fb ? 1e4f : ib;
        IMPw[sa] = va; IMPw[sb] = vb; LDS_WAIT(); asm volatile("" ::: "memory");
        int ra = fa ? 0 : 1, rb = fb ? 0 : 1;
#pragma unroll 8
        for (int i = 0; i < 128; ++i) { const float v = IMPw[i]; ra += (v > va || (v == va && i < sa)) ? 1 : 0; rb += (v > vb || (v == vb && i < sb)) ? 1 : 0; }
        const unsigned long long ma = __ballot(ra < 16), mb = __ballot(rb < 16);
        if (lane == 0) { MASKS[w * 4] = ma; MASKS[w * 4 + 1] = mb; }
    }
    __syncthreads();
    const unsigned long long mk0 = MASKS[tl * 4], mk1 = MASKS[tl * 4 + 1];
    unsigned long long U0 = 0ull, U1 = 0ull;
#pragma unroll
    for (int x = 0; x < 8; ++x) { U0 |= MASKS[x * 4]; U1 |= MASKS[x * 4 + 1]; }
    {
        float m = -INFINITY, ls = 0.f; D0 = (f32x16){}; D1 = (f32x16){};
        const int t = PAST + tl; int cnt = 0;
#pragma unroll 1
        for (int s = 0; s <= 128; ++s) {
            const bool in_u = (s < 64) ? ((U0 >> s) & 1ull) : ((s < 128) ? ((U1 >> (s - 64)) & 1ull) : true);
            if (!in_u) continue;
            const bool selb = (s < 64) ? ((mk0 >> s) & 1ull) : ((s < 128) ? ((mk1 >> (s - 64)) & 1ull) : true);
            const int nh = (s < 128) ? 2 : 1;
            for (int hf = 0; hf < nh; ++hf, ++cnt) {
                if ((cnt & 7) != w) continue;
                const int hi = selb ? t : -1;
                if (s < 128) { const int page = ptab[s >> 1], slot = (s & 1) * 64 + hf * 32;
                    const float* kp = FIN(I_CACHE) + (((((size_t)l * NPHYS + page) * PAGE + slot) * 4 + 2) * 2 + kvh) * 64;
                    ASrc S{kp, kp + 128, nullptr, nullptr, 512, 32}; AS_TILE(S, s * 64 + hf * 32, 0, hi, true, false, m, ls, D0, D1, 0.f, 520); }
                else { const bf16* kp = WSP(bf16, WS_KVS) + ((((size_t)0 * SB + seq) * 2 + kvh) * ST) * 64;
                    ASrc S{nullptr, nullptr, kp, kp + (size_t)SB * 2 * ST * 64, 64, ST}; AS_TILE(S, PAST, 0, hi, true, false, m, ls, D0, D1, 0.f, 520); }
            }
        }
        AS_PUBLISH(m, ls, D0, D1);
        float mt = -INFINITY;
#pragma unroll
        for (int x = 0; x < 8; ++x) mt = fmaxf(mt, MRG[x * 34 * 64 + lane]);
        float lt = 0.f; f32x16 T0 = (f32x16){}, T1 = (f32x16){};
#pragma unroll 1
        for (int x = 0; x < 8; ++x) { const LAS float* mp = MRG + x * 34 * 64 + lane; const float mx_ = mp[0]; const float f = (mx_ == -INFINITY) ? 0.f : fexp2(mx_ - mt); lt += mp[64] * f;
#pragma unroll
            for (int r = 0; r < 16; ++r) { T0[r] += mp[(2 + r) * 64] * f; T1[r] += mp[(18 + r) * 64] * f; } }
        lt = xhalf_sum(lt); const float sc = (lt > 0.f ? 1.0f / lt : 0.f) * g1;
        if (w == 0) {
#pragma unroll
            for (int r = 0; r < 16; ++r) { OAL[r * 64] += T0[r] * sc; OAL[(16 + r) * 64] += T1[r] * sc; } }
    }
    {
        float m = -INFINITY, ls = 0.f; D0 = (f32x16){}; D1 = (f32x16){};
#pragma unroll 1
        for (int ti = w; ti < 17; ti += 8) {
            if (ti < 16) { const float* kp = FIN(I_CWIN) + (((((size_t)l * SB + seq) * WINB + ti * 32) * 2 + 0) * 2 + kvh) * 64;
                ASrc S{kp, kp + 128, nullptr, nullptr, 256, 32}; AS_TILE(S, ti * 32, tl, WINB + tl, true, false, m, ls, D0, D1, 0.f, 520); }
            else { const bf16* kp = WSP(bf16, WS_KVS) + ((((size_t)2 * SB + seq) * 2 + kvh) * ST) * 64;
                ASrc S{nullptr, nullptr, kp, kp + (size_t)SB * 2 * ST * 64, 64, ST}; AS_TILE(S, WINB, tl, WINB + tl, true, false, m, ls, D0, D1, 0.f, 520); }
        }
        AS_PUBLISH(m, ls, D0, D1);
        float mt = -INFINITY;
#pragma unroll
        for (int x = 0; x < 8; ++x) mt = fmaxf(mt, MRG[x * 34 * 64 + lane]);
        float lt = 0.f; f32x16 T0 = (f32x16){}, T1 = (f32x16){};
#pragma unroll 1
        for (int x = 0; x < 8; ++x) { const LAS float* mp = MRG + x * 34 * 64 + lane; const float mx_ = mp[0]; const float f = (mx_ == -INFINITY) ? 0.f : fexp2(mx_ - mt); lt += mp[64] * f;
#pragma unroll
            for (int r = 0; r < 16; ++r) { T0[r] += mp[(2 + r) * 64] * f; T1[r] += mp[(18 + r) * 64] * f; } }
        lt = xhalf_sum(lt); const float sc = (lt > 0.f ? 1.0f / lt : 0.f) * g2;
        if (w == 0) {
#pragma unroll
            for (int r = 0; r < 16; ++r) { OAL[r * 64] += T0[r] * sc; OAL[(16 + r) * 64] += T1[r] * sc; } }
    }
#undef AS_PUBLISH
    if (w == 0) {
        bf16* op = WSP(bf16, WS_OA) + row * 512 + head * 64;
#pragma unroll
        for (int r4 = 0; r4 < 4; ++r4) { float a_[4], b_[4];
#pragma unroll
            for (int x = 0; x < 4; ++x) { a_[x] = OAL[(4 * r4 + x) * 64]; b_[x] = OAL[(16 + 4 * r4 + x) * 64]; }
            v2u a, b; a.x = pk2(a_[0], a_[1]); a.y = pk2(a_[2], a_[3]); b.x = pk2(b_[0], b_[1]); b.y = pk2(b_[2], b_[3]);
            *(v2u*)(op + 8 * r4 + 4 * h_) = a; *(v2u*)(op + 32 + 8 * r4 + 4 * h_) = b; }
    }
}

#ifndef DBG_DUP
#define DBG_DUP 0
#endif
#if DBG_DUP == 1
#define AP_DUP_QK(NK) { f32x16 d_ = (f32x16){}; _Pragma("unroll") for (int kk = 0; kk < 4; ++kk) d_ = mfma32(NK[kk], qf[(kk + 1) & 3], d_); _Pragma("unroll") for (int r = 0; r < 16; ++r) s_[r] += zf * d_[r]; }
#else
#define AP_DUP_QK(NK)
#endif
#if DBG_DUP == 2
#define AP_DUP_EXP() { float acc_ = 0.f; _Pragma("unroll") for (int r = 0; r < 16; ++r) acc_ += fexp2(s_[r] * 0.5f - 3.0f); lsum += zf * acc_; }
#else
#define AP_DUP_EXP()
#endif
#if DBG_DUP == 3
#define AP_DUP_PV() { f32x16 e0_ = (f32x16){}, e1_ = (f32x16){}; _Pragma("unroll") for (int s2 = 0; s2 < 2; ++s2) { const bf16x8 pf_ = cvt_frag(s_, 1 - s2); const int rA_ = 16 * s2 + 4 * h_; \
        e0_ = mfma32(tr_frag(Vw, AS_RS, rA_ + 8, rA_, 16 * blk, lane), pf_, e0_); e1_ = mfma32(tr_frag(Vw, AS_RS, rA_ + 8, rA_, 32 + 16 * blk, lane), pf_, e1_); } D0 += e0_ * zf; D1 += e1_ * zf; }
#else
#define AP_DUP_PV()
#endif
constexpr int AP_WS = 14336, AP_V = 0, AP_PS = 4608, AP_IMP = AP_PS + 8 * 264 * 4, AP_MASK = AP_IMP + 256, AP_LIST = AP_MASK + 64;
static_assert(AP_LIST + 2 * 192 <= AP_WS && 8 * AP_WS <= RING_BYTES, "prompt attention LDS map");
__device__ __forceinline__ void attn_prompt_unit(Frame& F, int l, int unit) {
    const int lane = F.lane, w = F.wave;
    const int q = lane & 31, h_ = lane >> 5, blk = (lane >> 4) & 1, tl = q >> 2, hr = q & 3;
    const int seq = unit >> 7, kvh = (unit >> 6) & 1, qt = unit & 63, head = kvh * 4 + hr;
    const int t0w = qt * 64 + 8 * w, t = t0w + tl; const size_t row = (size_t)seq * PT + t;
    LAS unsigned char* Vw = F.lds + w * AP_WS + AP_V; LAS float* PS = (LAS float*)(F.lds + w * AP_WS + AP_PS); LAS float* IMPw = (LAS float*)(F.lds + w * AP_WS + AP_IMP);
    LAS unsigned long long* MASKS = (LAS unsigned long long*)(F.lds + w * AP_WS + AP_MASK); LAS unsigned short* LIST = (LAS unsigned short*)(F.lds + w * AP_WS + AP_LIST);
    __syncthreads();
    bf16x8 qf[4];
    { const bf16* qp = WSP(bf16, WS_QN) + row * 512 + head * 64 + 8 * h_;
#pragma unroll
      for (int kk = 0; kk < 4; ++kk) qf[kk] = *(const bf16x8*)(qp + 16 * kk); }
    const float* ngp = WSP(float, WS_NG) + row * 24 + head * 3; const float g0 = ngp[0], g1 = ngp[1], g2 = ngp[2];
    for (int i = lane; i < 8 * 264; i += 64) PS[i] = 0.f;
    const bf16* CKk = WSP(bf16, WS_CK) + ((size_t)32768 + (seq * 2 + kvh) * 256) * 64; const bf16* CKv = CKk + (size_t)CMP_ROWS_J * 64;
    const bf16* KS = WSP(bf16, WS_KVB) + ((((size_t)0 * PB + seq) * 2 + kvh) * PT) * 64; const bf16* VS = KS + (size_t)PB * 2 * PT * 64;
    const bf16* KW = KS + (size_t)2 * PB * 2 * PT * 64; const bf16* VW = KW + (size_t)PB * 2 * PT * 64;
    const int hiCmin = (t0w >= 31) ? ((t0w - 31) >> 4) : -1;
    const int hiC = (t >= 31) ? ((t - 31) >> 4) : -1; const int nmaxw = (t0w + 7 >= 31) ? ((t0w + 7 - 31) >> 4) : -1; const int ntc = (nmaxw >= 0) ? (nmaxw >> 5) + 1 : 0;
    f32x16 D0 = (f32x16){}, D1 = (f32x16){};
    LAS float* OAG = PS + lane;
    float m = -INFINITY, lsum = 0.f, invC = 0.f; unsigned long long mk0 = 0ull;
    const float zf = (F.G == 12345) ? 1.0f : 0.0f;
    bf16x8 nk0[4]; v4u nv0[4], nv1[4];
#define AP_LOADK(e_, NK) do { const int kd_ = (int)((e_) >> 12), ti_ = (int)((e_) & 0xfffu); const bf16* kb_ = (kd_ < 2 ? CKk : (kd_ == 2 ? KS : KW)) + (size_t)ti_ * 32 * 64; \
        const int ko_ = kd_ < 2 ? q * 64 + 8 * h_ : lane * 8, ks_ = kd_ < 2 ? 16 : 512;     \
        _Pragma("unroll") for (int kk = 0; kk < 4; ++kk) NK[kk] = *(const bf16x8*)(kb_ + ko_ + ks_ * kk); } while (0)
#define AP_LOADV(e_, NV) do { const int kd_ = (int)((e_) >> 12), ti_ = (int)((e_) & 0xfffu); const bf16* vb_ = (kd_ < 2 ? CKv : (kd_ == 2 ? VS : VW)) + (size_t)ti_ * 32 * 64; \
        _Pragma("unroll") for (int x = 0; x < 4; ++x) NV[x] = *(const v4u*)(vb_ + 512 * x + lane * 8); } while (0)
#define AP_LOADT(e_, NK, NV) do { AP_LOADK(e_, NK); AP_LOADV(e_, NV); } while (0)
#define AP_STEP(i_, n_, NK, NV, NVN, EC, ECN) do { \
        const unsigned e_ = EC; const int kind = (int)(e_ >> 12), ti = (int)(e_ & 0xfffu); \
        if (kind == 1) { _Pragma("unroll") for (int x = 0; x < 4; ++x) *(LAS v4u*)(Vw + (8 * x + (lane >> 3)) * AS_RS + (lane & 7) * 16) = NV[x]; }     \
        f32x16 s_ = (f32x16){}; \
        _Pragma("unroll") for (int kk = 0; kk < 4; ++kk) s_ = mfma32(NK[kk], qf[kk], s_); \
        AP_DUP_QK(NK) \
          \
        if ((i_) + 1 < (n_)) { AP_LOADK(ECN, NK); AP_LOADV(ECN, NVN); if ((i_) + 2 < (n_)) EC = (unsigned)__builtin_amdgcn_readfirstlane((int)LIST[(i_) + 2]); } \
        if (kind != cur_kind) { \
            if (cur_kind == 0) { const float lt_ = xhalf_sum(lsum); invC = lt_ > 0.f ? 1.0f / lt_ : 0.f; } \
            else if (cur_kind == 2) { const float lt_ = xhalf_sum(lsum); const float sc_ = (lt_ > 0.f ? 1.0f / lt_ : 0.f) * g1; \
                _Pragma("unroll") for (int r = 0; r < 16; ++r) { OAG[r * 64] += D0[r] * sc_; OAG[(16 + r) * 64] += D1[r] * sc_; } } \
            if (kind != 1) m = -INFINITY; lsum = 0.f; D0 = (f32x16){}; D1 = (f32x16){}; cur_kind = kind; } \
        const int kb = ti * 32; int lo, hi; \
        if (kind < 2) { lo = 0; hi = hiC; } else if (kind == 2) { lo = 0; hi = ((mk0 >> (ti >> 1)) & 1ull) ? t : -1; } else { lo = t - WINB; hi = t; } \
          \
        const bool interior = (kind < 2) ? (hiCmin >= 0 && kb + 31 <= hiCmin) : ((kind == 2) ? (kb + 31 <= t0w) : (kb >= t0w + 7 - WINB && kb + 31 <= t0w)); \
        float tmax_ = -INFINITY, mu_, mn_; \
        if (interior) { const bool on_ = hi >= 0; \
            _Pragma("unroll") for (int r = 0; r < 16; ++r) tmax_ = fmaxf(tmax_, s_[r]); \
            tmax_ = on_ ? tmax_ : -INFINITY; tmax_ = xhalf_max(tmax_); \
            mn_ = fmaxf(m, tmax_); mu_ = (mn_ == -INFINITY) ? 0.f : mn_; const float mr_ = on_ ? mu_ : INFINITY; \
            _Pragma("unroll") for (int r = 0; r < 16; ++r) s_[r] = fexp2(s_[r] - mr_); \
        } else { \
            _Pragma("unroll") for (int r = 0; r < 16; ++r) { const int key_ = kb + (r & 3) + 8 * (r >> 2) + 4 * h_; s_[r] = (key_ >= lo && key_ <= hi) ? s_[r] : -INFINITY; tmax_ = fmaxf(tmax_, s_[r]); } \
            tmax_ = xhalf_max(tmax_); \
            mn_ = fmaxf(m, tmax_); mu_ = (mn_ == -INFINITY) ? 0.f : mn_; \
            _Pragma("unroll") for (int r = 0; r < 16; ++r) s_[r] = fexp2(s_[r] - mu_); \
        } \
        AP_DUP_EXP() \
        const float al_ = fexp2(m - mu_); float ps_ = 0.f; \
        _Pragma("unroll") for (int r = 0; r < 16; ++r) ps_ += s_[r]; \
        lsum = lsum * al_ + ps_; m = mn_; \
        if (kind >= 2) { if (__ballot(al_ != 1.0f) != 0ull) { D0 *= al_; D1 *= al_; } \
            const bf16x8 pf0_ = cvt_frag(s_, 0), pf1_ = cvt_frag(s_, 1); \
            D0 = mfma32(__builtin_bit_cast(bf16x8, NV[0]), pf0_, D0); D1 = mfma32(__builtin_bit_cast(bf16x8, NV[2]), pf0_, D1); D0 = mfma32(__builtin_bit_cast(bf16x8, NV[1]), pf1_, D0); D1 = mfma32(__builtin_bit_cast(bf16x8, NV[3]), pf1_, D1); \
        } else if (kind == 1) { if (__ballot(al_ != 1.0f) != 0ull) { D0 *= al_; D1 *= al_; } asm volatile("" ::: "memory");   \
            { const bf16x8 va0_ = tr_frag(Vw, AS_RS, 4 * h_, 4 * h_ + 8, 16 * blk, lane), va1_ = tr_frag(Vw, AS_RS, 4 * h_, 4 * h_ + 8, 32 + 16 * blk, lane), \
                           vb0_ = tr_frag(Vw, AS_RS, 16 + 4 * h_, 24 + 4 * h_, 16 * blk, lane), vb1_ = tr_frag(Vw, AS_RS, 16 + 4 * h_, 24 + 4 * h_, 32 + 16 * blk, lane);   \
              const bf16x8 pf0_ = cvt_frag(s_, 0), pf1_ = cvt_frag(s_, 1); \
              D0 = mfma32(va0_, pf0_, D0); D1 = mfma32(va1_, pf0_, D1); D0 = mfma32(vb0_, pf1_, D0); D1 = mfma32(vb1_, pf1_, D1); } \
            AP_DUP_PV() \
            asm volatile("" ::: "memory"); } \
        if (kind == 1) { _Pragma("unroll") for (int r = 0; r < 16; ++r) { const int n2_ = kb + (r & 3) + 8 * (r >> 2) + 4 * h_; float a_ = s_[r] * invC; a_ += __shfl_xor(a_, 1); a_ += __shfl_xor(a_, 2); if (hr == 0) PS[tl * 264 + n2_] = a_; } } \
    } while (0)
#define AP_RUN(N_) do { const int n_ = (N_); unsigned ec0_ = 0u, ec1_ = 0u;                  \
      if (n_ > 0) { ec0_ = (unsigned)__builtin_amdgcn_readfirstlane((int)LIST[0]); AP_LOADK(ec0_, nk0); AP_LOADV(ec0_, nv0); } \
      if (n_ > 1) { ec1_ = (unsigned)__builtin_amdgcn_readfirstlane((int)LIST[1]); } \
      _Pragma("unroll 1") for (int i_ = 0; i_ < n_; i_ += 2) { AP_STEP(i_, n_, nk0, nv0, nv1, ec0_, ec1_); if (i_ + 1 < n_) AP_STEP(i_ + 1, n_, nk0, nv1, nv0, ec1_, ec0_); } } while (0)
    int cur_kind = -1;
    if (lane < 2 * ntc) LIST[lane] = (unsigned short)(((lane >= ntc ? 1u : 0u) << 12) | (unsigned)(lane >= ntc ? lane - ntc : lane));
    LDS_WAIT(); asm volatile("" ::: "memory");
    AP_RUN(2 * ntc);
    { const float sc = (cur_kind == 1) ? g0 * invC : 0.f; D0 *= sc; D1 *= sc; }
    LDS_WAIT(); asm volatile("" ::: "memory");
#pragma unroll 1
    for (int tk = 0; tk < 8; ++tk) {
        const LAS float* pr = PS + tk * 264; const int s = lane; float imp = 0.f;
#pragma unroll
        for (int n = 4 * s - 1; n <= 4 * s + 3; ++n) if (n >= 0) imp += pr[n];
        const bool forced = (s == 0) || (s == qt) || (s == qt - 1), avail = s <= qt;
        const unsigned key = avail ? (forced ? 0x7fffffffu : (imp > 0.f ? __float_as_uint(imp) + 1u : 1u)) : 0u;
        unsigned thr = 0u;
#pragma unroll
        for (int bit = 30; bit >= 0; --bit) { const unsigned cand = thr | (1u << bit); const int cnt = __popcll(__ballot(key >= cand)); thr = (cnt >= 16) ? cand : thr; }
        const unsigned long long gt = __ballot(key > thr), eq = __ballot(key == thr); const int need = 16 - __popcll(gt);
        const int below = __builtin_amdgcn_mbcnt_hi((unsigned)(eq >> 32), __builtin_amdgcn_mbcnt_lo((unsigned)eq, 0u));
        const unsigned long long mk = gt | __ballot(key == thr && below < need);
        if (lane == 0) MASKS[tk] = mk;
        LDS_WAIT(); asm volatile("" ::: "memory");
    }
#pragma unroll
    for (int r = 0; r < 16; ++r) { OAG[r * 64] = D0[r]; OAG[(16 + r) * 64] = D1[r]; }
    mk0 = MASKS[tl]; unsigned long long wu = 0ull;
#pragma unroll
    for (int i = 0; i < 8; ++i) wu |= MASKS[i];
    wu &= (qt >= 63) ? ~0ull : ((1ull << (qt + 1)) - 1ull);
    const int nsel = 2 * __popcll(wu); const int tiLo = (t0w > WINB) ? ((t0w - WINB) >> 5) : 0, tiHi = (t0w + 7) >> 5, nwin = tiHi - tiLo + 1;
    if ((wu >> lane) & 1ull) { const int pos = 2 * __popcll(wu & ((1ull << lane) - 1ull)); LIST[pos] = (unsigned short)((2u << 12) | (unsigned)(2 * lane)); LIST[pos + 1] = (unsigned short)((2u << 12) | (unsigned)(2 * lane + 1)); }
    if (lane < nwin) LIST[nsel + lane] = (unsigned short)((3u << 12) | (unsigned)(tiLo + lane));
    LDS_WAIT(); asm volatile("" ::: "memory");
#ifdef DBG_COUNT
    if (lane == 0) { unsigned* CNT = (unsigned*)(F.ws + WS_CTL) + 3000; atomicAdd(CNT + 0, (unsigned)nsel); atomicAdd(CNT + 1, (unsigned)nwin); atomicAdd(CNT + 2, (unsigned)(2 * ntc)); atomicAdd(CNT + 3, 1u); }
#endif
    cur_kind = -1;
    AP_RUN(nsel + nwin);
    const float ltw = xhalf_sum(lsum); const float scw = (ltw > 0.f ? 1.0f / ltw : 0.f) * g2;
#undef AP_RUN
#undef AP_STEP
#undef AP_LOADT
#undef AP_LOADK
#undef AP_LOADV
    {
        bf16* op = WSP(bf16, WS_OA) + row * 512 + head * 64;
#pragma unroll
        for (int r4 = 0; r4 < 4; ++r4) { float a_[4], b_[4];
#pragma unroll
            for (int x = 0; x < 4; ++x) { a_[x] = OAG[(4 * r4 + x) * 64] + D0[4 * r4 + x] * scw; b_[x] = OAG[(16 + 4 * r4 + x) * 64] + D1[4 * r4 + x] * scw; }
            v2u a, b; a.x = pk2(a_[0], a_[1]); a.y = pk2(a_[2], a_[3]); b.x = pk2(b_[0], b_[1]); b.y = pk2(b_[2], b_[3]);
            *(v2u*)(op + 8 * r4 + 4 * h_) = a; *(v2u*)(op + 32 + 8 * r4 + 4 * h_) = b; }
    }
}
#undef AS_TILE

#ifdef DBG_CHECK
__device__ __forceinline__ unsigned dbg_rand(unsigned x) { x ^= x >> 16; x *= 0x7feb352du; x ^= x >> 15; x *= 0x846ca68bu; x ^= x >> 16; return x; }
__device__ __forceinline__ bool dbg_bad(float got, float exp_, float rtol, float atol) { return !(fabsf(got - exp_) <= rtol * fabsf(exp_) + atol); }
__device__ __forceinline__ float bfr(float x) { return __uint_as_float(pk2(x, 0.f) << 16); }
__device__ __forceinline__ int dbg_row(unsigned r) { const unsigned k = r % 20u; if (k == 0) return (int)(PM + (r >> 8) % SM); if (k == 1) return (int)(((r >> 8) % PB) * PT + ((r >> 12) % 8)); if (k == 2) return (int)(((r >> 8) % PB) * PT + PT - 1 - ((r >> 12) % 8)); return (int)((r >> 5) % PM); }
__device__ __forceinline__ float dbg_rs(const Frame& F, int row, int lane) { const float* xr = xrow_in(F, 0, row); float ss = 0.f; for (int d = lane; d < DM; d += 64) ss += xr[d] * xr[d]; return 1.0f / sqrtf(wave_sum(ss) * (1.0f / DM) + EPS); }
__device__ __forceinline__ float dbg_h(const Frame& F, int row, int d, float rs) { const float* mod = WSP(float, WS_MOD) + (size_t)row_bb(row) * 6144; return bfr(xrow_in(F, 0, row)[d] * rs * FIN(I_N1G)[d] * (1.0f + mod[1024 + d]) + mod[d]); }

__device__ __forceinline__ void dbg_check_phase(Frame& F) {
    const int gw = F.bid * NWAVES + F.wave, NGW = F.G * NWAVES, lane = F.lane;
    unsigned* CNT = (unsigned*)(F.ws + WS_CTL) + 3000;
    LAS float* L = (LAS float*)(F.lds + F.wave * 16384);
#define DBG_FLAG(ch, cond) do { if (__any(cond) && lane == 0) atomicAdd(CNT + (ch), 1u); } while (0)
    for (int s = gw; s < 1536; s += NGW) {
        const unsigned r = dbg_rand(1000u + s); const int row = dbg_row(r); const float rs = dbg_rs(F, row, lane); const int kind = s % 6;
        const bool isp = row < PM; const int b = isp ? (row >> 12) : ((row - PM) >> 3), t = isp ? (row & (PT - 1)) : ((row - PM) & 7);
#define DBG_U(col, dst) do { float a_ = 0.f; for (int d_ = lane; d_ < DM; d_ += 64) a_ += dbg_h(F, row, d_, rs) * bfr(FIN(I_WIN)[(size_t)d_ * D_IN + (col)]); dst = wave_sum(a_); } while (0)
        if (kind == 0) {
            const int c = (r >> 3) % 768, j = c >> 7, k = (c >> 6) & 1, dd = c & 63; float u; DBG_U(O_NKV + c, u); bool bad = false;
            if (j < 4) bad = dbg_bad(F.out[(isp ? OUT_ROWS_P + (size_t)row * 512 : OUT_ROWS_S + (size_t)(row - PM) * 512) + c], u, 0.01f, 0.01f);
            else if (isp) { if (t >= PT - WINB) bad = dbg_bad(F.out[OUT_WIN_P + ((size_t)b * WINB + (t - (PT - WINB))) * 256 + (c - 512)], u, 0.01f, 0.01f); }
            else bad = dbg_bad(F.out[OUT_WIN_S + ((size_t)b * WINB + (WINB - ST) + t) * 256 + (c - 512)], u, 0.01f, 0.01f);
            if (isp) { if (j < 2) bad = bad || dbg_bad(bf1(WSP(bf16, WS_ACMP)[((size_t)j * CMP_ROWS_J + 32768 + (b * 2 + k) * 256 + (t >> 4)) * 1024 + (t & 15) * 64 + dd]), u, 0.01f, 0.01f);
                       else bad = bad || dbg_bad(bf1(WSP(bf16, WS_KVB)[((((size_t)(j - 2) * PB + b) * 2 + k) * PT + t) * 64 + dd]), u, 0.01f, 0.01f); }
            else if (j >= 2) bad = bad || dbg_bad(bf1(WSP(bf16, WS_KVS)[((((size_t)(j - 2) * SB + b) * 2 + k) * ST + t) * 64 + dd]), u, 0.01f, 0.01f);
            DBG_FLAG(0, bad);
        } else if (kind == 1) {
            const int gi = (r >> 3) % 24, c5 = (r >> 8) % 512, cm = (r >> 8) % 3072; float u0, u1, u2, u3; DBG_U(O_NG + gi, u0); DBG_U(O_RX + c5, u1); DBG_U(O_RGATE + c5, u2); DBG_U(O_MG + cm, u3);
            bool bad = dbg_bad(WSP(float, WS_NG)[(size_t)row * 24 + gi], 1.0f / (1.0f + expf(-u0)), 0.01f, 0.005f);
            bad = bad || dbg_bad(WSP(float, WS_RX)[(size_t)row * 512 + c5], u1, 0.01f, 0.01f);
            bad = bad || dbg_bad(bf1(WSP(bf16, WS_GG)[(size_t)row * 512 + c5]), gelu_tanh(u2), 0.02f, 0.01f);
            bad = bad || dbg_bad(bf1(WSP(bf16, WS_MGS)[(size_t)row * 3072 + cm]), 1.0f / (1.0f + expf(-u3)), 0.01f, 0.005f);
            DBG_FLAG(1, bad);
        } else if (kind == 2) {
            const int head = (r >> 13) % 4, dim = (r >> 16) % 64, c5 = (r >> 3) % 512; float x1, x2, uv, ug, uq; DBG_U(O_RQ + head * 128 + dim, x1); DBG_U(O_RQ + head * 128 + 64 + dim, x2); DBG_U(O_RV + c5, uv); DBG_U(O_RG + c5, ug); DBG_U(O_NQ + c5, uq);
            const float pos = (float)(isp ? t : PAST + t); const float ang = pos * (float)pow(10000.0, -(double)dim / 64.0); float sn, cs; sincos_acc(ang, sn, cs);
            const bf16* RQ = WSP(bf16, WS_RQ);
            bool bad = dbg_bad(bf1(RQ[(size_t)row * 512 + head * 128 + dim]), x1 * cs - x2 * sn, 0.02f, 0.02f) || dbg_bad(bf1(RQ[(size_t)row * 512 + head * 128 + 64 + dim]), x1 * sn + x2 * cs, 0.02f, 0.02f);
            bad = bad || dbg_bad(bf1(RQ[(size_t)2 * MT * 512 + (size_t)row * 512 + c5]), uv, 0.01f, 0.01f) || dbg_bad(bf1(RQ[(size_t)3 * MT * 512 + (size_t)row * 512 + c5]), ug, 0.01f, 0.01f);
            bad = bad || dbg_bad(bf1(WSP(bf16, WS_QN)[(size_t)row * 512 + c5]), uq * QSCALE, 0.01f, 0.005f);
            DBG_FLAG(2, bad);
        }
#undef DBG_U
    }
    for (int s = gw; s < 128; s += NGW) {
        const unsigned r = dbg_rand(3000u + s); const int j = r & 1; const bool smp = ((r >> 1) & 3) != 0;
        const int grp = smp ? (int)((r >> 3) % 64) : (int)((r >> 3) % 8), nmax = smp ? 511 : 255; int n = (r >> 10) % nmax; if (((r >> 20) & 7) == 0) n = nmax - 1;
        const size_t rj = smp ? (size_t)grp * 512 + n : (size_t)32768 + grp * 256 + n;
        const bf16* A = WSP(bf16, WS_ACMP) + ((size_t)j * CMP_ROWS_J + rj) * 1024;
        const float* w1 = FIN(I_W1) + (size_t)j * 2048 * 128; const float* pe = FIN(I_PE) + j * 2048;
        for (int hh = 0; hh < 2; ++hh) { const int h = lane + 64 * hh; float a = FIN(I_B1)[j * 128 + h];
            for (int i = 0; i < 1024; ++i) a += (bf1(A[i]) + pe[i]) * w1[(size_t)i * 128 + h] + (bf1(A[1024 + i]) + pe[1024 + i]) * w1[(size_t)(1024 + i) * 128 + h];
            L[h] = gelu_tanh(a); }
        LDS_WAIT(); asm volatile("" ::: "memory");
        float o = 0.f; for (int h = 0; h < 128; ++h) o += L[h] * FIN(I_W2)[((size_t)j * 128 + h) * 64 + lane];
        const float got = bf1(WSP(bf16, WS_CK)[((size_t)j * CMP_ROWS_J + rj) * 64 + lane]);
        { const bool bd = dbg_bad(got, o, 0.05f, 0.03f); const unsigned long long mk = __ballot(bd); if (lane == 0 && mk) atomicAdd(CNT + 3, (unsigned)__popcll(mk)); }
        LDS_WAIT(); asm volatile("" ::: "memory");
    }
    for (int s = gw; s < 128; s += NGW) {
        const unsigned r = dbg_rand(3500u + s); const int j = r & 1; const bool smp = ((r >> 1) & 3) != 0;
        const int grp = smp ? (int)((r >> 3) % 64) : (int)((r >> 3) % 8), nmax = smp ? 511 : 255; const int n = (r >> 10) % nmax;
        const size_t rj = smp ? (size_t)grp * 512 + n : (size_t)32768 + grp * 256 + n, row = (size_t)j * CMP_ROWS_J + rj;
        const bf16* A = WSP(bf16, WS_ACMP) + row * 1024; const float* w1 = FIN(I_W1) + (size_t)j * 2048 * 128; const bf16* LH = WSP(bf16, WS_LH);
        unsigned nb = 0;
        for (int hh = 0; hh < 2; ++hh) { const int h = lane + 64 * hh; float lo = 0.f, hi = 0.f;
            for (int i = 0; i < 1024; ++i) { const float av = bf1(A[i]); lo += av * bfr(w1[(size_t)i * 128 + h]); hi += av * bfr(w1[(size_t)(1024 + i) * 128 + h]); }
            const bool bd = dbg_bad(bf1(LH[row * 256 + h]), lo, 0.02f, 0.02f) || dbg_bad(bf1(LH[row * 256 + 128 + h]), hi, 0.02f, 0.02f); nb += (unsigned)__popcll(__ballot(bd)); }
        if (lane == 0 && nb) atomicAdd(CNT + 9, nb);
        for (int hh = 0; hh < 2; ++hh) { const int h = lane + 64 * hh; L[h] = gelu_tanh(bf1(LH[row * 256 + h]) + bf1(LH[(row + 1) * 256 + 128 + h]) + WSP(float, WS_SMALLW + SW_CB)[j * 128 + h]); }
        LDS_WAIT(); asm volatile("" ::: "memory");
        float o = 0.f; for (int h = 0; h < 128; ++h) o += bfr(L[h]) * bfr(FIN(I_W2)[((size_t)j * 128 + h) * 64 + lane]);
        { const bool bd = dbg_bad(bf1(WSP(bf16, WS_CK)[row * 64 + lane]), o, 0.03f, 0.01f); const unsigned long long mk = __ballot(bd); if (lane == 0 && mk) atomicAdd(CNT + 11, (unsigned)__popcll(mk)); }
        LDS_WAIT(); asm volatile("" ::: "memory");
    }
    for (int s = gw; s < 64; s += NGW) {
        const unsigned r = dbg_rand(3700u + s); const int j = r & 1, half = (r >> 1) & 1, h = (r >> 2) % 128; const bf16* W1T = WSP(bf16, WS_SMALLW + SW_W1T) + ((size_t)j * 256 + half * 128 + h) * 1024;
        const float* w1 = FIN(I_W1) + ((size_t)j * 32 + half * 16) * 64 * 128 + h; unsigned nb = 0;
        for (int k = lane; k < 1024; k += 64) nb += (unsigned)__popcll(__ballot(dbg_bad(bf1(W1T[k]), w1[(size_t)k * 128], 0.01f, 0.0001f)));
        if (lane == 0 && nb) atomicAdd(CNT + 12, nb);
        const bool smp = ((r >> 9) & 3) != 0; const int grp = smp ? (int)((r >> 11) % 64) : (int)((r >> 11) % 8), n = (r >> 17) % (smp ? 511 : 255);
        const size_t row = (size_t)j * CMP_ROWS_J + (smp ? (size_t)grp * 512 + n : (size_t)32768 + grp * 256 + n); const bf16* A = WSP(bf16, WS_ACMP) + row * 1024;
        float a = 0.f; for (int k = lane; k < 1024; k += 64) a += bf1(A[k]) * bf1(W1T[k]); a = wave_sum(a);
        DBG_FLAG(13, dbg_bad(bf1(WSP(bf16, WS_LH)[row * 256 + half * 128 + h]), a, 0.02f, 0.02f));
    }
    for (int s = gw; s < 4; s += NGW) {
        const int j = s >> 1, h = (s & 1) * 64 + lane; const float* w1 = FIN(I_W1) + (size_t)j * 2048 * 128; const float* pe = FIN(I_PE) + j * 2048;
        float a = FIN(I_B1)[j * 128 + h]; for (int i = 0; i < 2048; ++i) a += pe[i] * w1[(size_t)i * 128 + h];
        const unsigned long long mk = __ballot(dbg_bad(WSP(float, WS_SMALLW + SW_CB)[j * 128 + h], a, 0.001f, 0.0005f)); if (lane == 0 && mk) atomicAdd(CNT + 10, (unsigned)__popcll(mk));
    }
    for (int s = gw; s < 96; s += NGW) {
        const unsigned r = dbg_rand(4000u + s); const bool smp = (s % 3) == 2;
        int seq, kvh = (r >> 4) & 1, t, tl = 0; size_t row;
        if (smp) { seq = (r >> 5) % SB; tl = (r >> 10) % ST; t = PAST + tl; row = (size_t)PM + seq * ST + tl; }
        else { seq = (r >> 5) % PB; const unsigned k = (r >> 8) % 8u; t = (k == 0) ? (int)((r >> 12) % 40) : (k == 1) ? PT - 1 - (int)((r >> 12) % 70) : (int)((r >> 12) % PT); row = (size_t)seq * PT + t; }
        const int N = smp ? 511 : 255, NS = smp ? 129 : 64, cur = t >> 6;
        LAS float* Q = L; LAS float* SC = L + 256; LAS float* PSUM = L + 256 + 2048; LAS float* OUT = L + 256 + 2048 + 512;
        for (int i = lane; i < 256; i += 64) Q[i] = bf1(WSP(bf16, WS_QN)[row * 512 + (kvh * 4 + (i >> 6)) * 64 + (i & 63)]);
        for (int i = lane; i < 768; i += 64) OUT[i] = 0.f;
        LDS_WAIT(); asm volatile("" ::: "memory");
        const bf16* CKk = WSP(bf16, WS_CK) + (smp ? (size_t)(seq * 2 + kvh) * 512 : (size_t)32768 + (seq * 2 + kvh) * 256) * 64; const bf16* CKv = CKk + (size_t)CMP_ROWS_J * 64;
        const int nvis = smp ? 511 : ((t >= 31) ? ((t - 31) >> 4) + 1 : 0);
        for (int i = lane; i < 512; i += 64) PSUM[i] = 0.f;
        for (int hr = 0; hr < 4; ++hr) {
            float mx = -INFINITY; for (int n = lane; n < nvis; n += 64) { float a = 0.f; for (int d = 0; d < 64; ++d) a += Q[hr * 64 + d] * bf1(CKk[(size_t)n * 64 + d]); SC[n] = a; mx = fmaxf(mx, a); }
            for (int o = 1; o < 64; o <<= 1) mx = fmaxf(mx, __shfl_xor(mx, o));
            float den = 0.f; for (int n = lane; n < nvis; n += 64) { const float e = exp2f(SC[n] - mx); SC[n] = e; den += e; } den = wave_sum(den);
            LDS_WAIT(); asm volatile("" ::: "memory");
            if (nvis > 0) { float o = 0.f; for (int n = 0; n < nvis; ++n) o += SC[n] * bf1(CKv[(size_t)n * 64 + lane]); OUT[hr * 64 + lane] = o / den;
                for (int n = lane; n < nvis; n += 64) PSUM[n] += SC[n] / den; }
            LDS_WAIT(); asm volatile("" ::: "memory");
        }
        LAS float* IMP = SC; LAS float* SELB = SC + 256;
        for (int sblk = lane; sblk < NS; sblk += 64) { float imp = 0.f; for (int n = 4 * sblk - 1; n <= 4 * sblk + 3; ++n) if (n >= 0 && n < N) imp += PSUM[n];
            const bool forced = sblk == 0 || sblk == cur || sblk == cur - 1, avail = sblk * 64 <= t; IMP[sblk] = avail ? (forced ? 1e4f : imp) : -1e4f; SELB[sblk] = 0.f; }
        LDS_WAIT(); asm volatile("" ::: "memory");
        for (int pick = 0; pick < 16 && pick < NS; ++pick) { float bv = -INFINITY; int bi = 1 << 30;
            for (int sblk = lane; sblk < NS; sblk += 64) { const float v = (SELB[sblk] != 0.f) ? -INFINITY : IMP[sblk]; if (v > bv || (v == bv && sblk < bi)) { bv = v; bi = sblk; } }
            for (int o = 1; o < 64; o <<= 1) { const float ov = __shfl_xor(bv, o); const int oi = __shfl_xor(bi, o); if (ov > bv || (ov == bv && oi < bi)) { bv = ov; bi = oi; } }
            if (lane == 0) SELB[bi] = 1.f; LDS_WAIT(); asm volatile("" ::: "memory"); }
        for (int br = 1; br < 3; ++br) for (int hr = 0; hr < 4; ++hr) {
            float mx = -INFINITY, den = 0.f, o = 0.f;
            const int plo = (br == 1) ? 0 : (t - WINB < 0 ? 0 : t - WINB), phi = t;
            for (int p = plo; p <= phi; ++p) {
                if (br == 1 && SELB[p >> 6] == 0.f) { p |= 63; continue; }
                const float* kf = nullptr; const bf16* kb = nullptr; const float* vf = nullptr; const bf16* vb = nullptr;
                const int jk = (br == 1) ? 2 : 4;
                if (!smp) { kb = WSP(bf16, WS_KVB) + ((((size_t)(jk - 2) * PB + seq) * 2 + kvh) * PT + p) * 64; vb = kb + (size_t)PB * 2 * PT * 64; }
                else if (p >= PAST) { kb = WSP(bf16, WS_KVS) + ((((size_t)(jk - 2) * SB + seq) * 2 + kvh) * ST + (p - PAST)) * 64; vb = kb + (size_t)SB * 2 * ST * 64; }
                else if (br == 1) { const int page = ((const int*)F.a->in[I_PT])[seq * NPG + (p >> 7)]; kf = FIN(I_CACHE) + ((((size_t)page * PAGE + (p & 127)) * 4 + 2) * 2 + kvh) * 64; vf = kf + 128; }
                else { kf = FIN(I_CWIN) + ((((size_t)seq * WINB + (p - (PAST - WINB))) * 2 + 0) * 2 + kvh) * 64; vf = kf + 128; }
                float a = 0.f; for (int d = 0; d < 64; ++d) a += Q[hr * 64 + d] * (kb ? bf1(kb[d]) : bfr(kf[d]));
                const float vv = vb ? bf1(vb[lane]) : bfr(vf[lane]);
                const float mn = fmaxf(mx, a), al = exp2f(mx - mn), e = exp2f(a - mn); den = den * al + e; o = o * al + e * vv; mx = mn;
            }
            OUT[(br * 4 + hr) * 64 + lane] = (den > 0.f) ? o / den : 0.f;
        }
        LDS_WAIT(); asm volatile("" ::: "memory");
        bool bad = false;
        for (int hr = 0; hr < 4; ++hr) { const float* ng = WSP(float, WS_NG) + row * 24 + (kvh * 4 + hr) * 3;
            const float e = ng[0] * OUT[(0 * 4 + hr) * 64 + lane] + ng[1] * OUT[(1 * 4 + hr) * 64 + lane] + ng[2] * OUT[(2 * 4 + hr) * 64 + lane];
            bad = bad || dbg_bad(bf1(WSP(bf16, WS_OA)[row * 512 + (kvh * 4 + hr) * 64 + lane]), e, 0.04f, 0.004f); }
        DBG_FLAG(smp ? 5 : 4, bad);
        LDS_WAIT(); asm volatile("" ::: "memory");
    }
    for (int s = gw; s < 96; s += NGW) {
        const unsigned r = dbg_rand(6000u + s); const bool smp = (s % 3) == 2; const int h = (r >> 3) & 3; const float lg = ret_log_g(h);
        const bf16* RQ = WSP(bf16, WS_RQ); const bf16* RK = RQ + (size_t)MT * 512; const bf16* RV = RQ + (size_t)2 * MT * 512; const bf16* RG = RQ + (size_t)3 * MT * 512;
        int seq, t; size_t row0; if (smp) { seq = (r >> 5) % SB; t = (r >> 10) % ST; row0 = (size_t)PM + seq * ST; } else { seq = (r >> 5) % PB; const unsigned k = (r >> 8) % 4u; t = (k == 0) ? (int)((r >> 12) % 300) : (int)((r >> 12) % PT); row0 = (size_t)seq * PT; }
        float o0 = 0.f, o1 = 0.f;
        for (int d = lane; d < 128; d += 64) L[d] = bf1(RQ[(row0 + t) * 512 + h * 128 + d]);
        LDS_WAIT(); asm volatile("" ::: "memory");
        for (int j = 0; j <= t; ++j) { float a = 0.f; for (int d = 0; d < 128; ++d) a += L[d] * bf1(RK[(row0 + j) * 512 + h * 128 + d]);
            a *= expf((float)(t - j) * lg); o0 += a * bf1(RV[(row0 + j) * 512 + h * 128 + lane]); o1 += a * bf1(RV[(row0 + j) * 512 + h * 128 + 64 + lane]); }
        if (smp) { const float* S0 = FIN(I_SRET) + (((size_t)0 * SB + seq) * 4 + h) * 16384; const float cr = expf((float)(t + 1) * lg);
            for (int d = 0; d < 128; ++d) { o0 += L[d] * S0[d * 128 + lane] * cr; o1 += L[d] * S0[d * 128 + 64 + lane] * cr; } }
        const float mean = wave_sum(o0 + o1) * (1.0f / 128.0f); const float var = wave_sum((o0 - mean) * (o0 - mean) + (o1 - mean) * (o1 - mean)) * (1.0f / 128.0f), rstd = 1.0f / sqrtf(var + EPS);
        const float* GN = FIN(I_GNG) + h * 128; const bf16* OR_ = WSP(bf16, WS_OA) + (size_t)MT * 512;
        const float g0 = bf1(RG[(row0 + t) * 512 + h * 128 + lane]), g1 = bf1(RG[(row0 + t) * 512 + h * 128 + 64 + lane]);
        const float e0 = (o0 - mean) * rstd * GN[lane] * (g0 / (1.0f + expf(-g0))), e1 = (o1 - mean) * rstd * GN[64 + lane] * (g1 / (1.0f + expf(-g1)));
        DBG_FLAG(6, dbg_bad(bf1(OR_[(row0 + t) * 512 + h * 128 + lane]), e0, 0.04f, 0.02f) || dbg_bad(bf1(OR_[(row0 + t) * 512 + h * 128 + 64 + lane]), e1, 0.04f, 0.02f));
        const int d = (r >> 20) % 128, T = smp ? ST : PT; float s0 = 0.f, s1 = 0.f;
        for (int j = 0; j < T; ++j) { const float kk = bf1(RK[(row0 + j) * 512 + h * 128 + d]) * expf((float)(T - 1 - j) * lg); s0 += kk * bf1(RV[(row0 + j) * 512 + h * 128 + lane]); s1 += kk * bf1(RV[(row0 + j) * 512 + h * 128 + 64 + lane]); }
        const float* SO;
        if (smp) { const float* S0 = FIN(I_SRET) + (((size_t)0 * SB + seq) * 4 + h) * 16384; const float g8 = expf(8.0f * lg); s0 += g8 * S0[d * 128 + lane]; s1 += g8 * S0[d * 128 + 64 + lane]; SO = F.out + OUT_RET_S + (((size_t)0 * SB + seq) * 4 + h) * 16384; }
        else SO = F.out + OUT_RET_P + (((size_t)0 * PB + seq) * 4 + h) * 16384;
        DBG_FLAG(7, dbg_bad(SO[d * 128 + lane], s0, 0.02f, 0.02f) || dbg_bad(SO[d * 128 + 64 + lane], s1, 0.02f, 0.02f));
        LDS_WAIT(); asm volatile("" ::: "memory");
    }
    for (int s = gw; s < 48; s += NGW) {
        const unsigned r = dbg_rand(8000u + s); const bool smp = (s % 3) == 2; const int blk = (r >> 3) & 7, c = blk * 64 + lane;
        int seq, T; size_t row0; if (smp) { seq = (r >> 6) % SB; T = ST; row0 = (size_t)PM + seq * ST; } else { seq = (r >> 6) % PB; T = 1 + (int)((r >> 10) % ((s & 1) ? 200 : PT)); row0 = (size_t)seq * PT; }
        const float* RX = WSP(float, WS_RX); const float* cw = FIN(I_RCW); const float cb = FIN(I_RCB)[c];
        float x3 = 0.f, x2 = 0.f, x1 = 0.f, h = 0.f;
        if (smp) { const float* cv = FIN(I_SCONV) + (size_t)seq * 3 * 512; x3 = cv[c]; x2 = cv[512 + c]; x1 = cv[1024 + c]; h = FIN(I_SH)[(size_t)seq * 512 + c]; }
        const float sp = log1pf(expf(-FIN(I_LAM)[c])); const float* wa = FIN(I_RWA) + (size_t)blk * 4096; const float* wx = FIN(I_RWX) + (size_t)blk * 4096;
        for (int t = 0; t < T; ++t) { const float x0 = RX[(row0 + t) * 512 + c]; const float xc = cb + cw[c] * x3 + cw[512 + c] * x2 + cw[1024 + c] * x1 + cw[1536 + c] * x0; x3 = x2; x2 = x1; x1 = x0;
            L[lane] = xc; LDS_WAIT(); asm volatile("" ::: "memory");
            float ra = FIN(I_RBA)[c], ri = FIN(I_RBX)[c]; for (int i = 0; i < 64; ++i) { ra += L[i] * wa[i * 64 + lane]; ri += L[i] * wx[i * 64 + lane]; }
            LDS_WAIT(); asm volatile("" ::: "memory");
            const float rr = 1.0f / (1.0f + expf(-ra)), ii = 1.0f / (1.0f + expf(-ri)), la = -8.0f * rr * sp, a = expf(la); h = a * h + sqrtf(-expm1f(2.0f * la)) * (ii * xc); }
        const size_t o = (row0 + T - 1) * 512 + c; const float e = h * bf1(WSP(bf16, WS_GG)[o]);
        DBG_FLAG(8, dbg_bad(bf1((WSP(bf16, WS_OA) + (size_t)2 * MT * 512)[o]), e, 0.04f, 0.01f));
    }
    for (int s = gw; s < 512; s += NGW) {
        const unsigned r = dbg_rand(9000u + s); const int row = dbg_row(r), col = (r >> 7) % DM;
        float e = 0.f;
        for (int br = 0; br < 3; ++br) { const bf16* O = WSP(bf16, WS_OA) + (size_t)br * MT * 512 + (size_t)row * 512; const float* W = FIN(br == 0 ? I_WBRA : (br == 1 ? I_WBRB : I_WBRC));
            float a = 0.f; for (int k = lane; k < 512; k += 64) a += bf1(O[k]) * bfr(W[(size_t)k * DM + col]); a = wave_sum(a); e += bf1(WSP(bf16, WS_MGS)[(size_t)row * 3072 + br * 1024 + col]) * a; }
        DBG_FLAG(20, dbg_bad(bf1(WSP(bf16, WS_MRG)[(size_t)row * DM + col]), e, 0.03f, 0.01f));
        const float* mod = WSP(float, WS_MOD) + (size_t)row_bb(row) * 6144;
        { float a = 0.f; for (int k = lane; k < DM; k += 64) a += bf1(WSP(bf16, WS_MRG)[(size_t)row * DM + k]) * bfr(FIN(I_WOUT)[(size_t)k * DM + col]); a = wave_sum(a);
          const float ex = xrow_in(F, 0, row)[col] + mod[2048 + col] * a; DBG_FLAG(21, dbg_bad(WSP(float, WS_X1)[(size_t)row * DM + col], ex, 0.005f, 0.005f)); }
        { const float* xr = WSP(float, WS_X1) + (size_t)row * DM; float ss = 0.f; for (int d = lane; d < DM; d += 64) ss += xr[d] * xr[d]; const float rs = 1.0f / sqrtf(wave_sum(ss) * (1.0f / DM) + EPS);
          const int c2 = (r >> 9) % NUP; float a = 0.f; for (int d = lane; d < DM; d += 64) a += bfr(xr[d] * rs * FIN(I_N2G)[d] * (1.0f + mod[4096 + d]) + mod[3072 + d]) * bfr(FIN(I_WUP)[(size_t)d * NUP + c2]); a = wave_sum(a);
          const float got = c2 < DFF ? bf1(WSP(bf16, WS_GP)[(size_t)row * DFF + c2]) : bf1((WSP(bf16, WS_GP) + (size_t)MT * DFF)[(size_t)row * DFF + c2 - DFF]); DBG_FLAG(22, dbg_bad(got, a, 0.02f, 0.01f)); }
        { const int c3 = (r >> 11) % DFF; const bf16* GP = WSP(bf16, WS_GP); const bf16* VAL = GP + (size_t)MT * DFF; const float* cw = FIN(I_FCW);
          const bool isp = row < PM; const int t = isp ? (row & (PT - 1)) : ((row - PM) & 7); float xm2, xm1;
          if (t >= 2) { xm2 = bf1(GP[(size_t)(row - 2) * DFF + c3]); xm1 = bf1(GP[(size_t)(row - 1) * DFF + c3]); }
          else if (isp) { xm2 = 0.f; xm1 = (t == 1) ? bf1(GP[(size_t)(row - 1) * DFF + c3]) : 0.f; }
          else { const float* st = FIN(I_SFFN) + ((size_t)((row - PM) >> 3) * 2) * DFF + c3; xm2 = (t == 0) ? st[0] : st[DFF]; xm1 = (t == 0) ? st[DFF] : bf1(GP[(size_t)(row - 1) * DFF + c3]); }
          const float y = FIN(I_FCB)[c3] + cw[c3] * xm2 + cw[DFF + c3] * xm1 + cw[2 * DFF + c3] * bf1(GP[(size_t)row * DFF + c3]); const float ex = (y / (1.0f + expf(-y))) * bf1(VAL[(size_t)row * DFF + c3]);
          DBG_FLAG(23, dbg_bad(bf1((GP + (size_t)2 * MT * DFF)[(size_t)row * DFF + c3]), ex, 0.02f, 0.005f)); }
        { const bf16* ACT = WSP(bf16, WS_GP) + (size_t)2 * MT * DFF + (size_t)row * DFF; float a = 0.f; for (int k = lane; k < DFF; k += 64) a += bf1(ACT[k]) * bfr(FIN(I_WDN)[(size_t)k * DM + col]); a = wave_sum(a);
          const float ex = WSP(float, WS_X1)[(size_t)row * DM + col] + mod[5120 + col] * a; DBG_FLAG(24, dbg_bad(WSP(float, WS_X2)[(size_t)row * DM + col], ex, 0.005f, 0.005f)); }
    }
#undef DBG_FLAG
}
__device__ __forceinline__ void dbg_report_phase(Frame& F) {
    const unsigned* CNT = (const unsigned*)(F.ws + WS_CTL) + 3000;
    const size_t ooff[14] = {OUT_Y, OUT_Y + (size_t)PM * DM, OUT_ROWS_P, OUT_ROWS_S, OUT_WIN_P, OUT_WIN_S, OUT_RET_P, OUT_RET_S, OUT_H_P, OUT_H_S, OUT_CV_P, OUT_CV_S, OUT_FC_P, OUT_FC_S};
    if (F.bid == 0 && F.tid < 14) { const int b = F.tid; const unsigned c = CNT[b]; const int cnt = 1 + (int)(c > 1000u ? 1000u : c);
        for (int i = 0; i < cnt; ++i) ((unsigned*)F.out)[ooff[b] + 7 + 2 * i] = 0xAAAAAAAAu; }
}
#endif

#ifndef DBG_SUB
#define DBG_SUB 0xFFFF
#endif
#ifndef DBG_MAXPH
#define DBG_MAXPH N_PHASES
#endif
#ifndef DBG_REPEAT
#define DBG_REPEAT 0
#endif
#ifndef DBG_MASK
#define DBG_MASK 0xFFFF
#endif
#define IN(k) (lo <= (k) && (k) < hi)
#ifdef DBG_TIME
#define SEAM(k) do { if ((k) + 1 < hi) { if (MK_N_LAUNCHES == 1) xcd_barrier(bar); } if (F.bid == 0 && F.tid == 0) ((unsigned long long*)(F.ws + WS_CTL))[2048 + (k) + 1] = __builtin_amdgcn_s_memrealtime(); } while (0)
#else
#define SEAM(k) do { if ((k) + 1 < hi) { if (MK_N_LAUNCHES == 1) xcd_barrier(bar); } } while (0)
#endif
template <int l> __device__ __forceinline__ void ph_win(Frame& F) { unsigned char* ws = F.ws;
    pg8::Gemm g{(const pg8::bf16_t*)(ws + WS_H), (const pg8::bf16_t*)(ws + WS_WIN) + (size_t)l * NIN * DM, MT, NIN, DM};
    pg8::StaticOrder S; S.init(MT, NIN, F.G, F.bid); EpiWin E{ws, F.out, l};
    pg8::gemm_phase<EpiWin, pg8::StaticOrder, true, true>(F.lds, g, S, E); }
template <int l> __device__ __forceinline__ void ph_mix1(Frame& F) {
    for (int x = F.bid; x < 512; x += F.G) { launder(F); cmp_gemm_unit<true>(F, l, x >> 8, (x & 255) >> 2, (x & 3) * 128); }
    {
        unsigned* ctr = (unsigned*)(F.ws + WS_CTL) + 3210 + l; volatile LAS int* QI = (volatile LAS int*)(F.lds + MISC_OFF + 128);
#pragma unroll 1
        for (;;) {
            __syncthreads();
            if (F.tid == 0) QI[0] = (int)__hip_atomic_fetch_add(ctr, 1u, __ATOMIC_RELAXED, __HIP_MEMORY_SCOPE_AGENT);
            __syncthreads();
            const int u = __builtin_amdgcn_readfirstlane(QI[0]);
            if (u >= 32 + 768) break;
            launder(F);
            if (u < 32) cmp_gemm_unit<false>(F, l, u >> 4, (u >> 1) & 7, (u & 1) * 128); else if (u < 32 + 256) rglru_unit<0>(F, l, u - 32); else ret_local_unit(F, u - 32 - 256);
        }
        __syncthreads();
    } }
template <int l> __device__ __forceinline__ void ph_mix2(Frame& F) { cmp2_phase(F, l); ret_scan_phase(F, l); rglru_carry_phase(F, l); }
#ifndef DBG_REPQ
#define DBG_REPQ 0
#endif
constexpr int MQ_SA = 64, MQ_PA = MQ_SA + 512, MQ_RG1 = MQ_PA + 256, MQ_RO = MQ_RG1 + 512, MQ_RS = MQ_RO + 128, MQ_RG2 = MQ_RS + 32;
template <int l> __device__ __forceinline__ void ph_mix3(Frame& F) {
    unsigned* ctr = (unsigned*)(F.ws + WS_CTL) + 3200 + l;
    volatile LAS int* QI = (volatile LAS int*)(F.lds + MISC_OFF + 128);
#pragma unroll 1
    for (;;) {
        __syncthreads();
        if (F.tid == 0) QI[0] = (int)__hip_atomic_fetch_add(ctr, 1u, __ATOMIC_RELAXED, __HIP_MEMORY_SCOPE_AGENT);
        __syncthreads();
        const int u = __builtin_amdgcn_readfirstlane(QI[0]);
        if (u >= MQ_RG2) break;
        launder(F);
        if (u < MQ_SA) { attn_sample_unit(F, l, u); if (DBG_REPQ & 2) { launder(F); attn_sample_unit(F, l, u); } }
        else if (u < MQ_PA) { const int v = u - MQ_SA; attn_prompt_unit(F, l, (v & 7) * 64 + 63 - (v >> 3)); if (DBG_REPQ & 1) { launder(F); attn_prompt_unit(F, l, (v & 7) * 64 + 63 - (v >> 3)); } }
        else if (u < MQ_RG1) { rglru_unit<1>(F, l, u - MQ_PA); }
        else if (u < MQ_RO) { ret_out_unit(F, l, u - MQ_RG1); }
        else if (u < MQ_RS) { ret_sample_unit(F, l, u - MQ_RO); }
        else { rglru_unit<2>(F, l, u - MQ_RS); }
    }
    __syncthreads(); }
__device__ __forceinline__ f32x16 smp_tile_acc(Frame& F, const bf16* A, const bf16* Wt, int K, int tile) {
    const int q = F.lane & 31, h_ = F.lane >> 5, ks8 = K / 8, kb = F.wave * ks8;
    const bf16* ap = A + (size_t)((tile >> 5) * 32 + q) * K + kb + 8 * h_; const bf16* bp = Wt + (size_t)((tile & 31) * 32 + q) * K + kb + 8 * h_; f32x16 acc = (f32x16){};
#pragma unroll 11
    for (int kk = 0; kk < ks8 / 16; ++kk) acc = mfma32(*(const bf16x8*)(ap + 16 * kk), *(const bf16x8*)(bp + 16 * kk), acc);
    return acc;
}
__device__ __forceinline__ void smp_tile_put(Frame& F, const f32x16& acc, int slot) { LAS float* R = (LAS float*)(F.lds + slot * 32768) + F.wave * 1024 + F.lane;
#pragma unroll
    for (int r = 0; r < 16; ++r) R[r * 64] = acc[r]; }
__device__ __forceinline__ float smp_tile_get(Frame& F, int slot, int o) { const LAS float* R = (const LAS float*)(F.lds + slot * 32768) + o; float s = 0.f;
#pragma unroll
    for (int w = 0; w < 8; ++w) s += R[w * 1024];
    return s; }
template <int l> __device__ __forceinline__ void ph_br(Frame& F) { unsigned char* ws = F.ws;
    const pg8::bf16_t* wbr = (const pg8::bf16_t*)(ws + WS_WBR) + (size_t)l * 3 * 1024 * 512;
    for (int tile = F.bid; tile < 256; tile += F.G) {
        const f32x16 a0 = smp_tile_acc(F, (const bf16*)(ws + WS_OA) + (size_t)PM * 512, wbr, 512, tile), a1 = smp_tile_acc(F, (const bf16*)(ws + WS_OA) + (size_t)(MT + PM) * 512, wbr + (size_t)1024 * 512, 512, tile),
                     a2 = smp_tile_acc(F, (const bf16*)(ws + WS_OA) + (size_t)(2 * MT + PM) * 512, wbr + (size_t)2 * 1024 * 512, 512, tile);
        __syncthreads(); smp_tile_put(F, a0, 0); smp_tile_put(F, a1, 1); smp_tile_put(F, a2, 2); __syncthreads();
        const bf16* MG = (const bf16*)(ws + WS_MGS); bf16* MR = (bf16*)(ws + WS_MRG);
        bf16 gq[2][3];
#pragma unroll
        for (int e = 0; e < 2; ++e) { const int o = F.tid * 2 + e, r = o >> 6, ln = o & 63; const size_t row = (size_t)PM + (tile >> 5) * 32 + (r & 3) + 8 * (r >> 2) + 4 * (ln >> 5); const int col = (tile & 31) * 32 + (ln & 31);
            const bf16* g = MG + row * 3072 + col; gq[e][0] = g[0]; gq[e][1] = g[1024]; gq[e][2] = g[2048]; }
#pragma unroll
        for (int e = 0; e < 2; ++e) { const int o = F.tid * 2 + e, r = o >> 6, ln = o & 63; const size_t row = (size_t)PM + (tile >> 5) * 32 + (r & 3) + 8 * (r >> 2) + 4 * (ln >> 5); const int col = (tile & 31) * 32 + (ln & 31);
            MR[row * DM + col] = (bf16)(pk2(bf1(gq[e][0]) * smp_tile_get(F, 0, o) + bf1(gq[e][1]) * smp_tile_get(F, 1, o) + bf1(gq[e][2]) * smp_tile_get(F, 2, o), 0.f) & 0xffffu); }
    }
    __syncthreads();
    BrOrder S; S.S.init(PM, DM, F.G, F.bid);
    pg8::Gemm g{(const pg8::bf16_t*)(ws + WS_OA), wbr, 3 * MT, 3 * DM, 512}; EpiBrAll E{ws};
    pg8::gemm_phase<EpiBrAll, BrOrder, true, true>(F.lds, g, S, E); }
template <bool INF32> __device__ __forceinline__ void smp_res(Frame& F, const bf16* A, const bf16* Wt, int K, const void* xin  , bf16* xout  , const float* mod, int gofs) {
    for (int tile = F.bid; tile < 256; tile += F.G) {
        const f32x16 a = smp_tile_acc(F, A, Wt, K, tile);
        __syncthreads(); smp_tile_put(F, a, 0); __syncthreads();
        float xi[2], gm[2];
#pragma unroll
        for (int e = 0; e < 2; ++e) { const int o = F.tid * 2 + e, r = o >> 6, ln = o & 63; const int rr = (tile >> 5) * 32 + (r & 3) + 8 * (r >> 2) + 4 * (ln >> 5), col = (tile & 31) * 32 + (ln & 31);
            xi[e] = INF32 ? ((const float*)xin)[(size_t)rr * DM + col] : bf1(((const bf16*)xin)[(size_t)rr * DM + col]); gm[e] = mod[(size_t)(4 + (rr >> 3)) * 6144 + gofs + col]; }
#pragma unroll
        for (int e = 0; e < 2; ++e) { const int o = F.tid * 2 + e, r = o >> 6, ln = o & 63; const int rr = (tile >> 5) * 32 + (r & 3) + 8 * (r >> 2) + 4 * (ln >> 5), col = (tile & 31) * 32 + (ln & 31);
            xout[(size_t)rr * DM + col] = (bf16)(pk2(xi[e] + gm[e] * smp_tile_get(F, 0, o), 0.f) & 0xffffu); }
    }
    __syncthreads();
}
template <int l> __device__ __forceinline__ void ph_out(Frame& F) { unsigned char* ws = F.ws;
    const float* mod = (const float*)(ws + WS_MOD) + (size_t)l * 36 * 6144;
    smp_res<l == 0>(F, (const bf16*)(ws + WS_MRG) + (size_t)PM * DM, (const bf16*)(ws + WS_WOUT) + (size_t)l * DM * DM, DM, l == 0 ? (const void*)FIN(I_XS) : (const void*)((const bf16*)(ws + WS_X2) + (size_t)PM * DM), (bf16*)(ws + WS_X1) + (size_t)PM * DM, mod, 2048);
    pg8::Gemm g{(const pg8::bf16_t*)(ws + WS_MRG), (const pg8::bf16_t*)(ws + WS_WOUT) + (size_t)l * DM * DM, PM, DM, DM};
    pg8::StaticOrder S; S.init(PM, DM, F.G, F.bid);
    EpiRes<l == 0> E{l == 0 ? (const void*)FIN(I_XP) : (const void*)(ws + WS_X2), (bf16*)(ws + WS_X1), mod, 2048};
    pg8::gemm_phase<EpiRes<l == 0>, pg8::StaticOrder, true, true>(F.lds, g, S, E); }
template <int l> __device__ __forceinline__ void ph_down(Frame& F) { unsigned char* ws = F.ws;
    const float* mod = (const float*)(ws + WS_MOD) + (size_t)l * 36 * 6144;
    {
        pg8::StaticOrder S0; S0.init(PM, DM, F.G, F.bid); pg8::Unit u0;
        for (int i = 0; S0.next(i, u0); ++i) if ((u0.pm & 15) != 0) convact_rows(F, l, (size_t)u0.pm * 256, 2, false);
        asm volatile("s_waitcnt vmcnt(0)" ::: "memory"); __syncthreads();
    }
    smp_res<false>(F, (const bf16*)(ws + WS_GP) + (size_t)2 * MT * DFF + (size_t)PM * DFF, (const bf16*)(ws + WS_WDN) + (size_t)l * DM * DFF, DFF, (const void*)((const bf16*)(ws + WS_X1) + (size_t)PM * DM), (bf16*)(ws + WS_X2) + (size_t)PM * DM, mod, 5120);
    pg8::Gemm g{(const pg8::bf16_t*)(ws + WS_GP) + (size_t)2 * MT * DFF, (const pg8::bf16_t*)(ws + WS_WDN) + (size_t)l * DM * DFF, PM, DM, DFF};
    pg8::StaticOrder S; S.init(PM, DM, F.G, F.bid);
    EpiRes<false> E{(const void*)(ws + WS_X1), (bf16*)(ws + WS_X2), mod, 5120};
    pg8::gemm_phase<EpiRes<false>, pg8::StaticOrder, true, true>(F.lds, g, S, E); }
template <int l> __device__ __forceinline__ void ph_up(Frame& F) { unsigned char* ws = F.ws;
    pg8::Gemm g{(const pg8::bf16_t*)(ws + WS_H), (const pg8::bf16_t*)(ws + WS_WUP) + (size_t)l * NUP * DM, MT, NUP, DM};
    UpOrder S; S.S.init(MT, DFF, F.G, F.bid); EpiUp E{ws, F.out, l, FIN(I_FCW) + (size_t)l * 3 * DFF, FIN(I_FCB) + (size_t)l * DFF, (const bf16*)(ws + WS_SFB) + (size_t)l * SB * 2 * DFF};
    pg8::gemm_phase<EpiUp, UpOrder, true, true>(F.lds, g, S, E); }
#ifdef DBG_AMP_BIT
#define AMP_T0(bit) unsigned long long amp_t0_ = 0ull; if ((bit) == DBG_AMP_BIT) amp_t0_ = __builtin_amdgcn_s_memrealtime();
#define AMP_T1(bit) if ((bit) == DBG_AMP_BIT && F.tid == 0) { volatile LAS unsigned* AM = (volatile LAS unsigned*)(F.lds + MISC_OFF + 192); AM[0] += (unsigned)(__builtin_amdgcn_s_memrealtime() - amp_t0_); }
#else
#define AMP_T0(bit)
#define AMP_T1(bit)
#endif
#define RUNPH(bit, ph, CALL) do { if (((DBG_MASK >> (bit)) & 1) && IN(ph)) { AMP_T0(bit) launder(F); CALL; if ((DBG_REPEAT >> (bit)) & 1) { launder(F); CALL; } SEAM(ph); AMP_T1(bit) } } while (0)
template <int l> __device__ __forceinline__ void layer_phases(Frame& F, const XcdBarrier& bar, int lo, int hi) {
    constexpr int pb = PH_L0 + l * PH_PER_LAYER;
    RUNPH(1, pb + LP_N1, norm_phase(F, l, 0));
    RUNPH(2, pb + LP_WIN, ph_win<l>(F));
    RUNPH(3, pb + LP_MIX1, ph_mix1<l>(F));
    RUNPH(4, pb + LP_MIX2, ph_mix2<l>(F));
    RUNPH(5, pb + LP_MIX3, ph_mix3<l>(F));
    RUNPH(6, pb + LP_BR, ph_br<l>(F));
    RUNPH(7, pb + LP_OUT, ph_out<l>(F));
    RUNPH(8, pb + LP_N2, norm_phase(F, l, 1));
    RUNPH(9, pb + LP_UP, ph_up<l>(F));
    RUNPH(11, pb + LP_DOWN, ph_down<l>(F));
}
__global__ void __launch_bounds__(NTHR, 2) trunk_fwd(Args args) {
    extern __shared__ __attribute__((aligned(16))) unsigned char lds_raw[];
    Frame F;
    F.lds = (LAS unsigned char*)lds_raw;
    F.tid = threadIdx.x; F.lane = F.tid & 63; F.wave = __builtin_amdgcn_readfirstlane(F.tid >> 6);
    F.G = gridDim.x; F.bid = blockIdx.x; F.a = &args; F.ws = args.ws; F.out = args.out;
    volatile LAS unsigned* MISC = (volatile LAS unsigned*)(F.lds + MISC_OFF);
    for (int u = F.tid; u < 64; u += NTHR) MISC[u] = 0u;
    __syncthreads();
    unsigned* barw = (unsigned*)(F.ws + WS_CTL) + CW_BAR;
    XcdBarrier bar; bar.bar = barw; bar.x = 0; bar.st = nullptr;
    if (MK_N_LAUNCHES == 1) bar = xcd_barrier_post(barw, MISC + 8);
    const int lo = args.ph_lo, hi = args.ph_hi;
    unsigned char* ws = F.ws;

#ifdef DBG_TIME
    if (F.bid == 0 && F.tid == 0) ((unsigned long long*)(F.ws + WS_CTL))[2048] = __builtin_amdgcn_s_memrealtime();
#endif
    RUNPH(0, PH_P0, p0_prologue(F));

    layer_phases<0>(F, bar, lo, hi);
    layer_phases<1>(F, bar, lo, hi);
    if (((DBG_MASK >> 12) & 1) && IN(PH_FINAL)) { launder(F); final_phase(F); if ((DBG_REPEAT >> 12) & 1) { launder(F); final_phase(F); } }
#ifdef DBG_AMP_BIT
    if (F.tid == 0) { volatile LAS unsigned* AM = (volatile LAS unsigned*)(F.lds + MISC_OFF + 192); const unsigned long long tot = (unsigned long long)AM[0] * DBG_AMP, ts = __builtin_amdgcn_s_memrealtime();
        while (__builtin_amdgcn_s_memrealtime() - ts < tot) __builtin_amdgcn_s_sleep(8); }
    __syncthreads();
#endif
#ifdef DBG_TIME
    {
        xcd_barrier(bar);
        if (F.bid == 0 && F.tid < 14) {
            const unsigned long long* ts = (const unsigned long long*)(F.ws + WS_CTL) + 2048; const unsigned long long tend = __builtin_amdgcn_s_memrealtime();
            const size_t ooff[14] = {OUT_Y, OUT_Y + (size_t)PM * DM, OUT_ROWS_P, OUT_ROWS_S, OUT_WIN_P, OUT_WIN_S, OUT_RET_P, OUT_RET_S, OUT_H_P, OUT_H_S, OUT_CV_P, OUT_CV_S, OUT_FC_P, OUT_FC_S};
            const int b = F.tid; unsigned long long d;
            if (b == 0) d = tend - ts[0]; else if (b == 1) d = ts[1] - ts[0]; else if (b == 13) d = tend - ts[PH_FINAL];
            else { const int ph = PH_L0 + DBG_TIME_LAYER * PH_PER_LAYER + (b - 2); d = ts[ph + 1] - ts[ph]; }
            int cnt = (int)(d / 100ull); if (cnt < 1) cnt = 1; if (cnt > 2000 && b != 0) cnt = 2000;
            for (int i = 0; i < cnt; ++i) ((unsigned*)F.out)[ooff[b] + 7 + 2 * i] = 0xAAAAAAAAu;
        }
    }
#endif
#ifdef DBG_COUNT
    {
        xcd_barrier(bar);
        if (F.bid == 0 && F.tid < 3) { const unsigned* CNT = (const unsigned*)(F.ws + WS_CTL) + 3000; const size_t ooff[3] = {OUT_Y, OUT_Y + (size_t)PM * DM, OUT_ROWS_P};
            const int cnt = (int)((unsigned long long)CNT[F.tid] * 10ull / (CNT[3] ? CNT[3] : 1u)); for (int i = 0; i < cnt; ++i) ((unsigned*)F.out)[ooff[F.tid] + 7 + 2 * i] = 0xAAAAAAAAu; }
    }
#endif
#ifdef DBG_CHECK
    if (lo == 100) { launder(F); dbg_check_phase(F); }
    if (lo == 101) { for (size_t i = (size_t)F.bid * NTHR + F.tid; i < OUT_END; i += (size_t)F.G * NTHR) F.out[i] = 0.f; }
    if (lo == 102) { launder(F); dbg_report_phase(F); }
#endif
}

extern "C" void kernel_launch(void* const* d_in, const int* in_sizes, int n_in, void* d_out, int out_size, void* d_ws, size_t ws_size, hipStream_t stream) {
    static int grid = 0;
    if (grid == 0) {
        if (n_in != 37 || (size_t)out_size != OUT_END || ws_size < WS_END) { fprintf(stderr, "kernel_launch: unexpected shapes: n_in %d out %d (want %zu) ws %zu (want %zu)\n", n_in, out_size, (size_t)OUT_END, ws_size, (size_t)WS_END); grid = -1; return; }
        int dev = 0, cus = 0, per_cu = 0;
        if (hipGetDevice(&dev) != hipSuccess || hipDeviceGetAttribute(&cus, hipDeviceAttributeMultiprocessorCount, dev) != hipSuccess) { grid = -1; return; }
        if (hipFuncSetAttribute((const void*)trunk_fwd, hipFuncAttributeMaxDynamicSharedMemorySize, LDS_BYTES) != hipSuccess) { fprintf(stderr, "kernel_launch: hipFuncSetAttribute failed\n"); grid = -1; return; }
        if (hipOccupancyMaxActiveBlocksPerMultiprocessor(&per_cu, (const void*)trunk_fwd, NTHR, LDS_BYTES) != hipSuccess || per_cu < 1) fprintf(stderr, "kernel_launch: occupancy query reports %d\n", per_cu);
        (void)hipGetLastError();
        grid = cus;
    }
    if (grid < 0) return;
    if (hipMemsetAsync((char*)d_ws + WS_CTL, 0, CTL_ZERO_BYTES, stream) != hipSuccess) return;
#ifdef DBG_POISON
    (void)hipMemsetAsync((char*)d_ws + CTL_ZERO_BYTES, 0xAA, WS_END - CTL_ZERO_BYTES, stream);
    (void)hipMemsetAsync(d_out, 0xAA, (size_t)OUT_END * 4, stream);
#endif
    Args a{};
    for (int i = 0; i < 37; ++i) a.in[i] = d_in[i];
    a.out = (float*)d_out; a.ws = (unsigned char*)d_ws;
#if MK_N_LAUNCHES == 1
    a.ph_lo = 0; a.ph_hi = N_PHASES;
    hipLaunchKernelGGL(trunk_fwd, dim3(grid), dim3(NTHR), LDS_BYTES, stream, a);
#else
    for (int p = 0; p < DBG_MAXPH; ++p) { a.ph_lo = p; a.ph_hi = p + 1; hipLaunchKernelGGL(trunk_fwd, dim3(grid), dim3(NTHR), LDS_BYTES, stream, a); }
#ifdef DBG_CHECK
    for (int p = 100; p < 103; ++p) { a.ph_lo = p; a.ph_hi = p + 1; hipLaunchKernelGGL(trunk_fwd, dim3(grid), dim3(NTHR), LDS_BYTES, stream, a); }
#endif
#endif
    (void)in_sizes;
}
```
